# Optimizing an MI355X kernel written in HIP

```python
import jax
import jax.numpy as jnp
from jax import lax
import numpy as np

D_MODEL = 1024
BATCH = 2
SEQ = 8192
DEPTH = 2
DEC_BATCH = 32
DEC_SEQ = 1
PAST_LEN = 8192
PAGE_SIZE = 128

HEAD_DIM = 64
N_A_LAYERS = DEPTH // 2
N_B_LAYERS = DEPTH - N_A_LAYERS
DIL_GROUPS = ((128, 1), (512, 4), (2048, 16))
N_DIL = len(DIL_GROUPS)
DIL_HEADS = 4
DIL_COLS = N_DIL * 3 * DIL_HEADS * HEAD_DIM
MEM_TOKENS = 256
MEM_HEADS = 4
MEM_COLS = MEM_HEADS * HEAD_DIM
NSA_HEADS = 12
NSA_KV_HEADS = 2
NSA_GROUP = NSA_HEADS // NSA_KV_HEADS
NSA_Q_COLS = NSA_HEADS * HEAD_DIM
NSA_GATE_COLS = NSA_HEADS * 3
CMP_BLOCK = 32
CMP_STRIDE = 16
CMP_HIDDEN = 2 * HEAD_DIM
SLC_BLOCK = 64
SLC_TOPK = 16
SWA_WINDOW = 512
FORCE_SCORE = 1.0e9
PEER_KEYS = 128
PEER_EXPERTS = PEER_KEYS * PEER_KEYS
PEER_HEADS = 8
PEER_KEY_DIM = 128
PEER_TOPK = 16
PEER_BLOCK = 128
Q_BLOCK = 128
ROPE_THETA = 10000.0
ALPHA = (2 * DEPTH) ** 0.25
BETA = (8 * DEPTH) ** -0.25
LN_EPS = 1e-5
NEG = -1.0e30
SCALE = HEAD_DIM ** -0.5

kernel_name = 'yoco_dilated_nsa_peer_decoder_step'


def layer_norm(x, g, b):
    xf = x.astype(jnp.float32)
    mu = jnp.mean(xf, axis=-1, keepdims=True)
    var = jnp.mean(jnp.square(xf - mu), axis=-1, keepdims=True)
    return ((xf - mu) * lax.rsqrt(var + LN_EPS) * g + b).astype(x.dtype)


def rope(x, pos):
    half = HEAD_DIM // 2
    inv = ROPE_THETA ** (-jnp.arange(half, dtype=jnp.float32) / half)
    ang = pos.astype(jnp.float32)[:, None] * inv[None, :]
    ang = ang.reshape((pos.shape[0],) + (1,) * (x.ndim - 3) + (half,))
    cos, sin = jnp.cos(ang), jnp.sin(ang)
    xf = x.astype(jnp.float32)
    x1, x2 = xf[..., :half], xf[..., half:]
    return jnp.concatenate([x1 * cos - x2 * sin, x2 * cos + x1 * sin], axis=-1).astype(x.dtype)


def masked_softmax(s, mask):
    p = jax.nn.softmax(jnp.where(mask, s, NEG), axis=-1)
    return jnp.where(mask, p, 0.0)


def map_query_blocks(fn, *qs):
    n, t = qs[0].shape[:2]
    nb = t // Q_BLOCK
    blocks = tuple(jnp.moveaxis(a.reshape((n, nb, Q_BLOCK) + a.shape[2:]), 1, 0) for a in qs)
    starts = jnp.arange(nb, dtype=jnp.int32) * Q_BLOCK
    out = lax.map(lambda args: fn(args[0], *args[1:]), (starts,) + blocks)
    out = jnp.moveaxis(out, 0, 1)
    return out.reshape((n, t) + out.shape[3:])


def dilated_group_attn(q, k, v, q_idx, window, dil):
    taps = window // dil + 1
    idx = q_idx[:, None] - dil * jnp.arange(taps)[None, :]
    valid = idx >= 0
    idx = jnp.maximum(idx, 0)
    kg = jnp.take(k, idx, axis=1)
    vg = jnp.take(v, idx, axis=1)
    s = jnp.einsum('nqhd,nqjhd->nqhj', q, kg).astype(jnp.float32) * SCALE
    s = jnp.where(valid[None, :, None, :], s, NEG)
    m = jnp.max(s, axis=-1, keepdims=True)
    lse = m + jnp.log(jnp.sum(jnp.exp(s - m), axis=-1, keepdims=True))
    p = jnp.exp(s - lse)
    o = jnp.einsum('nqhj,nqjhd->nqhd', p.astype(v.dtype), vg)
    return o, lse[..., 0]


def dilated_mixture(q, ks, vs, q_idx):
    outs, lses = [], []
    for g, (window, dil) in enumerate(DIL_GROUPS):
        o, lse = dilated_group_attn(q[:, :, g], ks[g], vs[g], q_idx[g], window, dil)
        outs.append(o)
        lses.append(lse)
    w = jax.nn.softmax(jnp.stack(lses), axis=0)[..., None]
    return jnp.sum(w * jnp.stack(outs).astype(jnp.float32), axis=0).astype(q.dtype)


def a_project(x, pos, w_in):
    n, t = x.shape[:2]
    proj = x @ w_in
    dil = proj[..., :DIL_COLS].reshape(n, t, N_DIL, 3, DIL_HEADS, HEAD_DIM)
    q = rope(dil[:, :, :, 0], pos)
    k = rope(dil[:, :, :, 1], pos)
    v = dil[:, :, :, 2]
    mq = proj[..., DIL_COLS:].reshape(n, t, MEM_HEADS, HEAD_DIM)
    return q, k, v, mq


def b_project(x, pos, w_in):
    n, t = x.shape[:2]
    proj = x @ w_in
    q = rope(proj[..., :NSA_Q_COLS].reshape(n, t, NSA_HEADS, HEAD_DIM), pos)
    gates = jax.nn.sigmoid(proj[..., NSA_Q_COLS:NSA_Q_COLS + NSA_GATE_COLS].astype(jnp.float32))
    gates = gates.reshape(n, t, NSA_KV_HEADS, NSA_GROUP, 3).astype(x.dtype)
    mq = proj[..., NSA_Q_COLS + NSA_GATE_COLS:].reshape(n, t, MEM_HEADS, HEAD_DIM)
    return q, gates, mq


def mem_attend(q, mem_kv):
    s = jnp.einsum('nthd,nmhd->nhtm', q, mem_kv[:, :, 0]).astype(jnp.float32) * SCALE
    p = jax.nn.softmax(s, axis=-1)
    return jnp.einsum('nhtm,nmhd->nthd', p.astype(q.dtype), mem_kv[:, :, 1])


def merge_out(o, mo, w_out):
    n, t = o.shape[:2]
    return jnp.concatenate([o.reshape(n, t, -1), mo.reshape(n, t, -1)], axis=-1) @ w_out


def nsa_rows(x, pos, w_kv):
    n, t = x.shape[:2]
    r = (x @ w_kv).reshape(n, t, 6, NSA_KV_HEADS, HEAD_DIM)
    return jnp.stack([r[:, :, 0], r[:, :, 1], rope(r[:, :, 2], pos), r[:, :, 3],
                      rope(r[:, :, 4], pos), r[:, :, 5]], axis=2)


def compress(rows, pe, w1, w2):
    n, t, h, dh = rows.shape
    c = (t - CMP_BLOCK) // CMP_STRIDE + 1
    idx = jnp.arange(c)[:, None] * CMP_STRIDE + jnp.arange(CMP_BLOCK)[None, :]
    blocks = jnp.take(rows, idx, axis=1) + pe[None, None, :, None, :]
    flat = jnp.moveaxis(blocks, 3, 2).reshape(n, c, h, CMP_BLOCK * dh)
    return jax.nn.gelu(flat @ w1) @ w2


def nsa_context(rows, cmp_pe, cmp_w1, cmp_w2):
    n, t = rows.shape[:2]
    c = (t - CMP_BLOCK) // CMP_STRIDE + 1
    cmp_pos = jnp.arange(c) * CMP_STRIDE + (CMP_BLOCK - 1)
    ck = rope(compress(rows[:, :, 0], cmp_pe[0], cmp_w1[0], cmp_w2[0]), cmp_pos)
    cv = compress(rows[:, :, 1], cmp_pe[1], cmp_w1[1], cmp_w2[1])
    nb = -(-t // SLC_BLOCK)
    sl = jnp.pad(rows[:, :, 2:4], ((0, 0), (0, nb * SLC_BLOCK - t), (0, 0), (0, 0), (0, 0)))
    sl = sl.reshape(n, nb, SLC_BLOCK, 2, NSA_KV_HEADS, HEAD_DIM).transpose(3, 0, 4, 1, 2, 5)
    return ck, cv, cmp_pos, sl[0], sl[1]


def nsa_attend(q, gates, q_pos, ctx, win_k, win_v, win_pos):
    ck, cv, cmp_pos, skb, svb = ctx
    n, tq = q.shape[:2]
    qg = q.reshape(n, tq, NSA_KV_HEADS, NSA_GROUP, HEAD_DIM)
    s = jnp.einsum('nqhgd,nchd->nhgqc', qg, ck).astype(jnp.float32) * SCALE
    p_c = masked_softmax(s, cmp_pos[None, :] <= q_pos[:, None])
    o_c = jnp.einsum('nhgqc,nchd->nqhgd', p_c.astype(cv.dtype), cv)
    c = ck.shape[1]
    nb = skb.shape[2]
    r_sel, r_cmp = SLC_BLOCK // CMP_STRIDE, CMP_BLOCK // CMP_STRIDE
    offs = jnp.array([m - j for m in range(r_sel) for j in range(r_cmp)], dtype=jnp.int32)
    cidx = jnp.arange(nb)[:, None] * r_sel + offs[None, :]
    cval = (cidx >= 0) & (cidx < c)
    imp = jnp.sum(p_c, axis=2)
    imp = jnp.sum(jnp.where(cval, jnp.take(imp, jnp.clip(cidx, 0, c - 1), axis=-1), 0.0), axis=-1)
    blk = jnp.arange(nb)[None, :]
    cur = (q_pos // SLC_BLOCK)[:, None]
    forced = (blk == 0) | (blk == cur) | (blk == cur - 1)
    score = jnp.where(blk <= cur, jnp.where(forced, FORCE_SCORE, imp), NEG)
    top_s, sel = lax.top_k(score, min(SLC_TOPK, nb))
    n_i = jnp.arange(n)[:, None, None, None]
    h_i = jnp.arange(NSA_KV_HEADS)[None, :, None, None]
    kg = skb[n_i, h_i, sel]
    vg = svb[n_i, h_i, sel]
    kpos = sel[..., None] * SLC_BLOCK + jnp.arange(SLC_BLOCK)
    m_s = (kpos <= q_pos[None, None, :, None, None]) & (top_s > 0.5 * NEG)[..., None]
    kk = sel.shape[-1] * SLC_BLOCK
    s = jnp.einsum('nqhgd,nhqkld->nhgqkl', qg, kg).astype(jnp.float32) * SCALE
    p_s = masked_softmax(s.reshape(n, NSA_KV_HEADS, NSA_GROUP, tq, kk),
                         m_s.reshape(n, NSA_KV_HEADS, 1, tq, kk))
    o_s = jnp.einsum('nhgqx,nhqxd->nqhgd', p_s.astype(vg.dtype),
                     vg.reshape(n, NSA_KV_HEADS, tq, kk, HEAD_DIM))
    s = jnp.einsum('nqhgd,nkhd->nhgqk', qg, win_k).astype(jnp.float32) * SCALE
    dist = q_pos[:, None] - win_pos[None, :]
    p_w = masked_softmax(s, (dist >= 0) & (dist <= SWA_WINDOW) & (win_pos[None, :] >= 0))
    o_w = jnp.einsum('nhgqk,nkhd->nqhgd', p_w.astype(win_v.dtype), win_v)
    o = gates[..., 0:1] * o_c + gates[..., 1:2] * o_s + gates[..., 2:3] * o_w
    return o.reshape(n, tq, NSA_HEADS, HEAD_DIM)


def peer(x, w_q, sub_keys, u_tab, v_tab):
    n, t, d = x.shape
    m = n * t
    blk = min(PEER_BLOCK, m)
    pad = (-m) % blk
    xb = jnp.pad(x.reshape(m, d), ((0, pad), (0, 0))).reshape(-1, blk, d)

    def one(xc):
        q = (xc @ w_q).reshape(blk, PEER_HEADS, 2, PEER_KEY_DIM // 2)
        s = jnp.einsum('mhcd,hckd->mhck', q, sub_keys).astype(jnp.float32)
        s1, i1 = lax.top_k(s[:, :, 0], PEER_TOPK)
        s2, i2 = lax.top_k(s[:, :, 1], PEER_TOPK)
        cand_s = (s1[..., :, None] + s2[..., None, :]).reshape(blk, PEER_HEADS, PEER_TOPK * PEER_TOPK)
        cand_i = (i1[..., :, None] * PEER_KEYS + i2[..., None, :]).reshape(blk, PEER_HEADS, PEER_TOPK * PEER_TOPK)
        top_s, top_j = lax.top_k(cand_s, PEER_TOPK)
        e_idx = jnp.take_along_axis(cand_i, top_j, axis=-1)
        g = jax.nn.softmax(top_s, axis=-1)
        act = jax.nn.gelu(jnp.einsum('md,mhkd->mhk', xc, u_tab[e_idx]).astype(jnp.float32))
        return jnp.einsum('mhk,mhkd->md', (g * act).astype(xc.dtype), v_tab[e_idx])

    out = lax.map(one, xb).reshape(-1, d)[:m]
    return out.reshape(n, t, d)


def setup_inputs(seed: int = 0) -> dict:
    key = jax.random.key(seed)
    ks = jax.random.split(key, 26)
    f32 = jnp.float32

    def nrm(k, shape, scale=1.0):
        return jax.random.normal(k, shape, f32) * scale

    n_pages = PAST_LEN // PAGE_SIZE
    n_used = DEC_BATCH * n_pages
    n_phys = n_used + max(1, n_used // 4)
    page_table = jax.random.permutation(ks[0], n_phys)[:n_used].reshape(DEC_BATCH, n_pages).astype(jnp.int32)
    dil = [nrm(ks[4 + g], (N_A_LAYERS, DEC_BATCH, min(w, PAST_LEN), 2, DIL_HEADS, HEAD_DIM))
           for g, (w, _) in enumerate(DIL_GROUPS)]
    a_scale = jnp.concatenate([jnp.ones((N_DIL, 3, DIL_HEADS * HEAD_DIM), f32).at[:, 2].set(BETA).reshape(-1),
                               jnp.ones((MEM_COLS,), f32)])
    mem_scale = jnp.concatenate([jnp.ones((MEM_COLS,), f32), jnp.full((MEM_COLS,), BETA, f32)])
    kv_scale = jnp.repeat(jnp.array([1.0, BETA, 1.0, BETA, 1.0, BETA], f32), NSA_KV_HEADS * HEAD_DIM)
    d_in = D_MODEL ** -0.5
    a_out = DIL_HEADS * HEAD_DIM + MEM_COLS
    b_out = NSA_Q_COLS + MEM_COLS
    return {
        'x_prompt': nrm(ks[1], (BATCH, SEQ, D_MODEL)),
        'x_sample': nrm(ks[2], (DEC_BATCH, DEC_SEQ, D_MODEL)),
        'mem_prompt': nrm(ks[3], (BATCH, MEM_TOKENS, D_MODEL)),
        'cache_dil_g0': dil[0],
        'cache_dil_g1': dil[1],
        'cache_dil_g2': dil[2],
        'cache_nsa_kv': nrm(ks[7], (n_phys, PAGE_SIZE, 4, NSA_KV_HEADS, HEAD_DIM)),
        'cache_nsa_win': nrm(ks[8], (DEC_BATCH, min(SWA_WINDOW, PAST_LEN), 2, NSA_KV_HEADS, HEAD_DIM)),
        'cache_mem_kv': nrm(ks[9], (DEPTH, DEC_BATCH, MEM_TOKENS, 2, MEM_HEADS, HEAD_DIM)),
        'page_table': page_table,
        'w_in_a': nrm(ks[10], (N_A_LAYERS, D_MODEL, DIL_COLS + MEM_COLS), d_in) * a_scale,
        'w_out_a': nrm(ks[11], (N_A_LAYERS, a_out, D_MODEL), BETA * a_out ** -0.5),
        'w_in_b': nrm(ks[12], (N_B_LAYERS, D_MODEL, NSA_Q_COLS + NSA_GATE_COLS + MEM_COLS), d_in),
        'w_out_b': nrm(ks[13], (N_B_LAYERS, b_out, D_MODEL), BETA * b_out ** -0.5),
        'w_mem_kv': nrm(ks[14], (DEPTH, D_MODEL, 2 * MEM_COLS), d_in) * mem_scale,
        'w_kv_b': nrm(ks[15], (D_MODEL, 6 * NSA_KV_HEADS * HEAD_DIM), d_in) * kv_scale,
        'cmp_pe': nrm(ks[16], (2, CMP_BLOCK, HEAD_DIM), 0.02),
        'cmp_w1': nrm(ks[17], (2, CMP_BLOCK * HEAD_DIM, CMP_HIDDEN), (CMP_BLOCK * HEAD_DIM) ** -0.5),
        'cmp_w2': nrm(ks[18], (2, CMP_HIDDEN, HEAD_DIM), CMP_HIDDEN ** -0.5),
        'ln_g': 1.0 + nrm(ks[19], (DEPTH, 2, D_MODEL), 0.02),
        'ln_b': nrm(ks[20], (DEPTH, 2, D_MODEL), 0.02),
        'peer_wq': nrm(ks[21], (DEPTH, D_MODEL, PEER_HEADS * PEER_KEY_DIM), d_in),
        'peer_keys': nrm(ks[22], (DEPTH, PEER_HEADS, 2, PEER_KEYS, PEER_KEY_DIM // 2), (PEER_KEY_DIM // 2) ** -0.5),
        'peer_u': nrm(ks[23], (DEPTH, PEER_EXPERTS, D_MODEL), d_in),
        'peer_v': nrm(ks[24], (DEPTH, PEER_EXPERTS, D_MODEL), BETA * PEER_HEADS ** -0.5),
    }


def reference(x_prompt, x_sample, mem_prompt, cache_dil_g0, cache_dil_g1, cache_dil_g2,
              cache_nsa_kv, cache_nsa_win, cache_mem_kv, page_table,
              w_in_a, w_out_a, w_in_b, w_out_b, w_mem_kv, w_kv_b, cmp_pe, cmp_w1, cmp_w2,
              ln_g, ln_b, peer_wq, peer_keys, peer_u, peer_v):
    pos_p = jnp.arange(SEQ, dtype=jnp.int32)
    pos_s = PAST_LEN + jnp.arange(DEC_SEQ, dtype=jnp.int32)
    n_pages = PAST_LEN // PAGE_SIZE
    dil_caches = (cache_dil_g0, cache_dil_g1, cache_dil_g2)
    xp, xs = x_prompt, x_sample
    dil_new_p = [[] for _ in DIL_GROUPS]
    dil_new_s = [[] for _ in DIL_GROUPS]
    mem_new_p = []
    for layer in range(DEPTH):
        mem_kv_p = (mem_prompt @ w_mem_kv[layer]).reshape(BATCH, MEM_TOKENS, 2, MEM_HEADS, HEAD_DIM)
        mem_kv_s = cache_mem_kv[layer]
        mem_new_p.append(mem_kv_p)
        if layer < N_A_LAYERS:
            q, k, v, mq = a_project(xp, pos_p, w_in_a[layer])
            ks = [k[:, :, g] for g in range(N_DIL)]
            vs = [v[:, :, g] for g in range(N_DIL)]
            o = map_query_blocks(
                lambda s0, qb: dilated_mixture(qb, ks, vs, [s0 + jnp.arange(Q_BLOCK)] * N_DIL), q)
            mix_p = merge_out(o, mem_attend(mq, mem_kv_p), w_out_a[layer])
            for g, (window, _) in enumerate(DIL_GROUPS):
                dil_new_p[g].append(jnp.stack([k[:, :, g], v[:, :, g]], axis=2)[:, SEQ - min(window, SEQ):])
            q, k, v, mq = a_project(xs, pos_s, w_in_a[layer])
            ks, vs, qi = [], [], []
            for g in range(N_DIL):
                buf = dil_caches[g][layer]
                full = jnp.concatenate([buf, jnp.stack([k[:, :, g], v[:, :, g]], axis=2)], axis=1)
                ks.append(full[:, :, 0])
                vs.append(full[:, :, 1])
                qi.append(buf.shape[1] + jnp.arange(DEC_SEQ))
                dil_new_s[g].append(full[:, DEC_SEQ:])
            o = dilated_mixture(q, ks, vs, qi)
            mix_s = merge_out(o, mem_attend(mq, mem_kv_s), w_out_a[layer])
        else:
            b = layer - N_A_LAYERS
            if b == 0:
                rows_p = nsa_rows(xp, pos_p, w_kv_b)
                rows_s = nsa_rows(xs, pos_s, w_kv_b)
                nsa_new_p = rows_p[:, :, :4]
                nsa_new_s = rows_s[:, :, :4]
                past = cache_nsa_kv[page_table].reshape(DEC_BATCH, n_pages * PAGE_SIZE, 4, NSA_KV_HEADS, HEAD_DIM)
                ctx_p = nsa_context(nsa_new_p, cmp_pe, cmp_w1, cmp_w2)
                ctx_s = nsa_context(jnp.concatenate([past, nsa_new_s], axis=1), cmp_pe, cmp_w1, cmp_w2)
                win_p = rows_p[:, :, 4:]
                win_s = jnp.concatenate([cache_nsa_win, rows_s[:, :, 4:]], axis=1)
                win_new_p = win_p[:, SEQ - min(SWA_WINDOW, SEQ):]
                win_new_s = win_s[:, DEC_SEQ:]
                win_pad_p = jnp.pad(win_p, ((0, 0), (SWA_WINDOW, 0), (0, 0), (0, 0), (0, 0)))
                win_pos_s = PAST_LEN - cache_nsa_win.shape[1] + jnp.arange(win_s.shape[1])
            q, gates, mq = b_project(xp, pos_p, w_in_b[b])

            def nsa_block(s0, qb, gb):
                wb = lax.dynamic_slice_in_dim(win_pad_p, s0, Q_BLOCK + SWA_WINDOW, axis=1)
                w_pos = s0 - SWA_WINDOW + jnp.arange(Q_BLOCK + SWA_WINDOW)
                return nsa_attend(qb, gb, s0 + jnp.arange(Q_BLOCK), ctx_p, wb[:, :, 0], wb[:, :, 1], w_pos)

            o = map_query_blocks(nsa_block, q, gates)
            mix_p = merge_out(o, mem_attend(mq, mem_kv_p), w_out_b[b])
            q, gates, mq = b_project(xs, pos_s, w_in_b[b])
            o = nsa_attend(q, gates, pos_s, ctx_s, win_s[:, :, 0], win_s[:, :, 1], win_pos_s)
            mix_s = merge_out(o, mem_attend(mq, mem_kv_s), w_out_b[b])
        xp = layer_norm(ALPHA * xp + mix_p, ln_g[layer, 0], ln_b[layer, 0])
        xs = layer_norm(ALPHA * xs + mix_s, ln_g[layer, 0], ln_b[layer, 0])
        xp = layer_norm(ALPHA * xp + peer(xp, peer_wq[layer], peer_keys[layer], peer_u[layer], peer_v[layer]),
                        ln_g[layer, 1], ln_b[layer, 1])
        xs = layer_norm(ALPHA * xs + peer(xs, peer_wq[layer], peer_keys[layer], peer_u[layer], peer_v[layer]),
                        ln_g[layer, 1], ln_b[layer, 1])
    return (xp, xs,
            jnp.stack(dil_new_p[0]), jnp.stack(dil_new_p[1]), jnp.stack(dil_new_p[2]),
            jnp.stack(dil_new_s[0]), jnp.stack(dil_new_s[1]), jnp.stack(dil_new_s[2]),
            nsa_new_p, nsa_new_s, win_new_p, win_new_s, jnp.stack(mem_new_p))
```

```cpp
#define FAST_PHASES 18
#define CHECK_MODE 0
#define NSA_DEBUG 1
#include <hip/hip_runtime.h>
#include <cstdio>
#include <cstring>
#include <cmath>
#ifdef CPU_TEST
#define HD inline
constexpr int D_MODEL = 128, BATCH = 2, SEQ = 512, DEPTH = 2, DEC_BATCH = 3, DEC_SEQ = 1, PAST_LEN = 512, PAGE_SIZE = 128;
constexpr int DIL_W[3] = {16, 64, 256}, DIL_D[3] = {1, 4, 16}, DIL_TAPS = 17;
constexpr int MEM_TOKENS = 32, SLC_TOPK = 4, SWA_WINDOW = 64, PEER_KEYS = 16, PEER_TOPK = 4;
#else
#define HD __host__ __device__ __forceinline__
constexpr int D_MODEL = 1024, BATCH = 2, SEQ = 8192, DEPTH = 2, DEC_BATCH = 32, DEC_SEQ = 1, PAST_LEN = 8192, PAGE_SIZE = 128;
constexpr int DIL_W[3] = {128, 512, 2048}, DIL_D[3] = {1, 4, 16}, DIL_TAPS = 129;
constexpr int MEM_TOKENS = 256, SLC_TOPK = 16, SWA_WINDOW = 512, PEER_KEYS = 128, PEER_TOPK = 16;
#endif
HD constexpr int dil_w(int g) { return g == 0 ? DIL_W[0] : (g == 1 ? DIL_W[1] : DIL_W[2]); }
HD constexpr int dil_d(int g) { return g == 0 ? DIL_D[0] : (g == 1 ? DIL_D[1] : DIL_D[2]); }
constexpr int HEAD_DIM = 64, N_A_LAYERS = DEPTH / 2, N_DIL = 3, DIL_HEADS = 4, DIL_COLS = N_DIL * 3 * DIL_HEADS * HEAD_DIM;
constexpr int MEM_HEADS = 4, MEM_COLS = MEM_HEADS * HEAD_DIM;
constexpr int NSA_HEADS = 12, NSA_KV_HEADS = 2, NSA_GROUP = 6, NSA_Q_COLS = NSA_HEADS * HEAD_DIM, NSA_GATE_COLS = NSA_HEADS * 3;
constexpr int CMP_BLOCK = 32, CMP_STRIDE = 16, CMP_HIDDEN = 128, SLC_BLOCK = 64;
constexpr int PEER_EXPERTS = PEER_KEYS * PEER_KEYS, PEER_HEADS = 8, PEER_KEY_DIM = 128;
constexpr float FORCE_SCORE = 1.0e9f, NEG = -1.0e30f, SCALE = 0.125f, LN_EPS = 1e-5f;
constexpr float ALPHA = 1.41421356237309515f;
constexpr float BETA = 0.5f;
#define LAS __attribute__((address_space(3)))
namespace nv {
struct P {
    const float *x_prompt, *x_sample, *mem_prompt, *cache_dil[3], *cache_nsa_kv, *cache_nsa_win, *cache_mem_kv; const int* page_table;
    const float *w_in_a, *w_out_a, *w_in_b, *w_out_b, *w_mem_kv, *w_kv_b, *cmp_pe, *cmp_w1, *cmp_w2, *ln_g, *ln_b, *peer_wq, *peer_keys, *peer_u, *peer_v;
    float *y_prompt, *y_sample, *dil_p[3], *dil_s[3], *nsa_kv_p, *nsa_kv_s, *win_p, *win_s, *mem_kv_p;
    float *X0, *PROJA, *SDIL, *ATTA, *SMEM, *PRE, *X1, *QP, *SK, *T1S, *SELS, *ACT, *X2, *ROWS6, *PROJB, *HID, *CKV, *SC, *OC, *IMPS, *SS, *OS, *SW, *OW, *ATTB, *X3, *GT;
    int *T1I, *SELE, *SELB;
    int layer;
    int r0, nr, pad_;
};
constexpr int M0 = BATCH * SEQ, MP = M0 + DEC_BATCH;
constexpr int ACOLS = DIL_COLS + MEM_COLS;
constexpr int BCOLS = NSA_Q_COLS + NSA_GATE_COLS + MEM_COLS;
constexpr int KVCOLS = 6 * NSA_KV_HEADS * HEAD_DIM;
constexpr int TAPS = DIL_TAPS;
constexpr int NTAP = 3 * TAPS;
constexpr int NCMP = (SEQ - CMP_BLOCK) / CMP_STRIDE + 1;
constexpr int NCMP_S = (PAST_LEN + 1 - CMP_BLOCK) / CMP_STRIDE + 1;
static_assert(NCMP == NCMP_S, "naive path assumes equal compressed counts");
constexpr int NB_P = (SEQ + SLC_BLOCK - 1) / SLC_BLOCK, NB_S = (PAST_LEN + 1 + SLC_BLOCK - 1) / SLC_BLOCK, NBMAX = NB_S;
constexpr int NSEL = SLC_TOPK;
constexpr int WINK = SWA_WINDOW + 1;
constexpr int NCTX = BATCH + DEC_BATCH;
#ifdef CPU_TEST
constexpr int CHROWS = 256;
#else
constexpr int CHROWS = 2052;
#endif
HD int row_pos(int r) { return r < M0 ? r % SEQ : PAST_LEN; }
HD int row_ctx(int r) { return r < M0 ? r / SEQ : BATCH + (r - M0); }
HD float gelu_t(float x) { return 0.5f * x * (1.0f + tanhf(0.7978845608028654f * (x + 0.044715f * x * x * x))); }
HD void rope_cs(int pos, int d, float& c, float& s) {
    double inv = pow(10000.0, -(double)d / 32.0); double a = (double)pos * inv; c = (float)cos(a); s = (float)sin(a);
}
struct GemmArgs { const float* A; const float* B; float* C; int M, N, K, lda, ldb, ldc; };
HD void gemm_elem(const GemmArgs& g, long idx) { int m = (int)(idx / g.N), n = (int)(idx % g.N); float acc = 0.f; for (int k = 0; k < g.K; ++k) acc += g.A[(size_t)m * g.lda + k] * g.B[(size_t)k * g.ldb + n]; g.C[(size_t)m * g.ldc + n] = acc; }

struct K_x0 { static long n(const P&) { return (long)MP * D_MODEL; } HD static void run(const P& p, long i) { long r = i / D_MODEL; p.X0[i] = r < M0 ? p.x_prompt[i] : p.x_sample[i - (long)M0 * D_MODEL]; } };
struct K_memkv { static long n(const P&) { return (long)DEPTH * BATCH * MEM_TOKENS * 2 * MEM_COLS; }
    HD static void run(const P& p, long i) { int c = (int)(i % (2 * MEM_COLS)); long r = i / (2 * MEM_COLS); int m = (int)(r % (BATCH * MEM_TOKENS)); int l = (int)(r / (BATCH * MEM_TOKENS));
        const float* w = p.w_mem_kv + (size_t)l * D_MODEL * 2 * MEM_COLS; float acc = 0.f; for (int k = 0; k < D_MODEL; ++k) acc += p.mem_prompt[(size_t)m * D_MODEL + k] * w[(size_t)k * 2 * MEM_COLS + c]; p.mem_kv_p[i] = acc; } };
struct K_ropeA { static long n(const P&) { return (long)MP * N_DIL * 2 * DIL_HEADS * 32; }
    HD static void run(const P& p, long i) { int d = (int)(i % 32); long t = i / 32; int h = (int)(t % DIL_HEADS); t /= DIL_HEADS; int j = (int)(t % 2); t /= 2; int g = (int)(t % N_DIL); int r = (int)(t / N_DIL);
        float* b = p.PROJA + (size_t)r * ACOLS + ((g * 3 + j) * DIL_HEADS + h) * HEAD_DIM; float c, s; rope_cs(row_pos(r), d, c, s); float x1 = b[d], x2 = b[d + 32]; b[d] = x1 * c - x2 * s; b[d + 32] = x2 * c + x1 * s; } };
template <int G> struct K_dilout_p { static constexpr int W = DIL_W[G] < SEQ ? DIL_W[G] : SEQ; static long n(const P&) { return (long)BATCH * W * 2 * DIL_HEADS * HEAD_DIM; }
    HD static void run(const P& p, long i) { int c = (int)(i % (DIL_HEADS * HEAD_DIM)); long t = i / (DIL_HEADS * HEAD_DIM); int j = (int)(t % 2); t /= 2; int w = (int)(t % W); int n = (int)(t / W);
        p.dil_p[G][i] = p.PROJA[(size_t)(n * SEQ + SEQ - W + w) * ACOLS + (G * 3 + 1 + j) * DIL_HEADS * HEAD_DIM + c]; } };
template <int G> struct K_dilout_s { static constexpr int W = DIL_W[G] < PAST_LEN ? DIL_W[G] : PAST_LEN; static long n(const P&) { return (long)DEC_BATCH * W * 2 * DIL_HEADS * HEAD_DIM; }
    HD static void run(const P& p, long i) { int c = (int)(i % (2 * DIL_HEADS * HEAD_DIM)); long t = i / (2 * DIL_HEADS * HEAD_DIM); int w = (int)(t % W); int n = (int)(t / W);
        int j = c / (DIL_HEADS * HEAD_DIM), cc = c % (DIL_HEADS * HEAD_DIM);
        p.dil_s[G][i] = (w < W - 1) ? p.cache_dil[G][((size_t)n * W + w + 1) * 2 * DIL_HEADS * HEAD_DIM + c] : p.PROJA[(size_t)(M0 + n) * ACOLS + (G * 3 + 1 + j) * DIL_HEADS * HEAD_DIM + cc]; } };
HD const float* dil_kv(const P& p, int r, int g, int j, int which  ) {
    const int W = dil_w(g), dil = dil_d(g);
    if (r < M0) { int t = r % SEQ, tk = t - dil * j; if (tk < 0) return nullptr; return p.PROJA + (size_t)(r - dil * j) * ACOLS + (g * 3 + 1 + which) * DIL_HEADS * HEAD_DIM; }
    int n = r - M0; int Wc = W < PAST_LEN ? W : PAST_LEN; int idx = Wc - dil * j; if (idx < 0) return nullptr;
    if (idx == Wc) return p.PROJA + (size_t)r * ACOLS + (g * 3 + 1 + which) * DIL_HEADS * HEAD_DIM;
    return p.cache_dil[g] + (((size_t)n * Wc + idx) * 2 + which) * DIL_HEADS * HEAD_DIM;
}
struct K_dil_s { static long n(const P& p) { return (long)p.nr * DIL_HEADS * NTAP; }
    HD static void run(const P& p, long i) { int tj = (int)(i % NTAP); long t = i / NTAP; int h = (int)(t % DIL_HEADS); int r = (int)(t / DIL_HEADS) + p.r0; int g = tj / TAPS, j = tj % TAPS;
        const float* k = dil_kv(p, r, g, j, 0); float s = NEG;
        if (k) { const float* q = p.PROJA + (size_t)r * ACOLS + ((g * 3 + 0) * DIL_HEADS + h) * HEAD_DIM; float a = 0.f; for (int d = 0; d < HEAD_DIM; ++d) a += q[d] * k[h * HEAD_DIM + d]; s = a * SCALE; }
        p.SDIL[i] = s; } };
HD void softmax_row(float* s, int L) { float m = -3.0e38f; for (int i = 0; i < L; ++i) m = s[i] > m ? s[i] : m; float z = 0.f; for (int i = 0; i < L; ++i) { float e = (s[i] <= 0.5f * NEG) ? 0.f : expf(s[i] - m); s[i] = e; z += e; } float iz = z > 0.f ? 1.f / z : 0.f; for (int i = 0; i < L; ++i) s[i] *= iz; }
struct K_dil_sm { static long n(const P& p) { return (long)p.nr * DIL_HEADS; } HD static void run(const P& p, long i) { softmax_row(p.SDIL + i * NTAP, NTAP); } };
struct K_dil_o { static long n(const P& p) { return (long)p.nr * DIL_HEADS * HEAD_DIM; }
    HD static void run(const P& p, long i) { int d = (int)(i % HEAD_DIM); long t = i / HEAD_DIM; int h = (int)(t % DIL_HEADS); int rl = (int)(t / DIL_HEADS); int r = rl + p.r0; const float* pr = p.SDIL + ((size_t)rl * DIL_HEADS + h) * NTAP; float a = 0.f;
        for (int tj = 0; tj < NTAP; ++tj) { float w = pr[tj]; if (w != 0.f) { const float* v = dil_kv(p, r, tj / TAPS, tj % TAPS, 1); a += w * v[h * HEAD_DIM + d]; } }
        p.ATTA[(size_t)r * (2 * MEM_COLS) + h * HEAD_DIM + d] = a; } };
struct MemArgs { const float* Q; int ldq, qoff; float* O; int ldo, ooff; };
HD const float* mem_kv(const P& p, int r, int m, int which) {
    int l = p.layer; if (r < M0) { int n = r / SEQ; return p.mem_kv_p + ((((size_t)l * BATCH + n) * MEM_TOKENS + m) * 2 + which) * MEM_COLS; }
    int n = r - M0; return p.cache_mem_kv + ((((size_t)l * DEC_BATCH + n) * MEM_TOKENS + m) * 2 + which) * MEM_COLS; }
HD MemArgs mem_args(const P& p) { MemArgs a; if (p.layer < N_A_LAYERS) { a.Q = p.PROJA; a.ldq = ACOLS; a.qoff = DIL_COLS; a.O = p.ATTA; a.ldo = 2 * MEM_COLS; a.ooff = MEM_COLS; } else { a.Q = p.PROJB; a.ldq = BCOLS; a.qoff = NSA_Q_COLS + NSA_GATE_COLS; a.O = p.ATTB; a.ldo = NSA_Q_COLS + MEM_COLS; a.ooff = NSA_Q_COLS; } return a; }
struct K_mem_s { static long n(const P& p) { return (long)p.nr * MEM_HEADS * MEM_TOKENS; }
    HD static void run(const P& p, long i) { MemArgs A = mem_args(p); int m = (int)(i % MEM_TOKENS); long t = i / MEM_TOKENS; int h = (int)(t % MEM_HEADS); int r = (int)(t / MEM_HEADS) + p.r0;
        const float* q = A.Q + (size_t)r * A.ldq + A.qoff + h * HEAD_DIM; const float* k = mem_kv(p, r, m, 0) + h * HEAD_DIM; float a = 0.f; for (int d = 0; d < HEAD_DIM; ++d) a += q[d] * k[d]; p.SMEM[i] = a * SCALE; } };
struct K_mem_sm { static long n(const P& p) { return (long)p.nr * MEM_HEADS; } HD static void run(const P& p, long i) { softmax_row(p.SMEM + i * MEM_TOKENS, MEM_TOKENS); } };
struct K_mem_o { static long n(const P& p) { return (long)p.nr * MEM_HEADS * HEAD_DIM; }
    HD static void run(const P& p, long i) { MemArgs A = mem_args(p); int d = (int)(i % HEAD_DIM); long t = i / HEAD_DIM; int h = (int)(t % MEM_HEADS); int rl = (int)(t / MEM_HEADS); int r = rl + p.r0; const float* pr = p.SMEM + ((size_t)rl * MEM_HEADS + h) * MEM_TOKENS; float a = 0.f;
        for (int m = 0; m < MEM_TOKENS; ++m) a += pr[m] * mem_kv(p, r, m, 1)[h * HEAD_DIM + d]; A.O[(size_t)r * A.ldo + A.ooff + h * HEAD_DIM + d] = a; } };
struct LnArgs { const float* xin; const float* add; float* out; int which; int pad_; };
HD void ln_row(const P& p, const LnArgs& a, long r) { const float* g = p.ln_g + ((size_t)p.layer * 2 + a.which) * D_MODEL; const float* b = p.ln_b + ((size_t)p.layer * 2 + a.which) * D_MODEL;
    const float* x = a.xin + r * D_MODEL; const float* y = a.add + r * D_MODEL; float mu = 0.f; for (int i = 0; i < D_MODEL; ++i) mu += ALPHA * x[i] + y[i]; mu /= D_MODEL; float var = 0.f; for (int i = 0; i < D_MODEL; ++i) { float v = ALPHA * x[i] + y[i] - mu; var += v * v; } var /= D_MODEL;
    float rs = 1.0f / sqrtf(var + LN_EPS); for (int i = 0; i < D_MODEL; ++i) a.out[r * D_MODEL + i] = (ALPHA * x[i] + y[i] - mu) * rs * g[i] + b[i]; }
struct K_peer_sk { static long n(const P&) { return (long)MP * PEER_HEADS * 2 * PEER_KEYS; }
    HD static void run(const P& p, long i) { int k = (int)(i % PEER_KEYS); long t = i / PEER_KEYS; int hc = (int)(t % (PEER_HEADS * 2)); int r = (int)(t / (PEER_HEADS * 2)); constexpr int KD = PEER_KEY_DIM / 2;
        const float* q = p.QP + (size_t)r * PEER_HEADS * PEER_KEY_DIM + hc * KD; const float* key = p.peer_keys + (((size_t)p.layer * PEER_HEADS * 2 + hc) * PEER_KEYS + k) * KD; float a = 0.f; for (int d = 0; d < KD; ++d) a += q[d] * key[d]; p.SK[i] = a; } };
struct K_peer_t1 { static long n(const P&) { return (long)MP * PEER_HEADS * 2 * PEER_KEYS; }
    HD static void run(const P& p, long i) { int k = (int)(i % PEER_KEYS); long t = i / PEER_KEYS; const float* s = p.SK + t * PEER_KEYS; float v = s[k]; int rank = 0; for (int j = 0; j < PEER_KEYS; ++j) rank += (s[j] > v || (s[j] == v && j < k)) ? 1 : 0;
        if (rank < PEER_TOPK) { p.T1S[t * PEER_TOPK + rank] = v; p.T1I[t * PEER_TOPK + rank] = k; } } };
struct K_peer_t2 { static long n(const P&) { return (long)MP * PEER_HEADS * PEER_TOPK * PEER_TOPK; }
    HD static void run(const P& p, long i) { int ab = (int)(i % (PEER_TOPK * PEER_TOPK)); long t = i / (PEER_TOPK * PEER_TOPK); const float* s1 = p.T1S + (t * 2 + 0) * PEER_TOPK; const float* s2 = p.T1S + (t * 2 + 1) * PEER_TOPK;
        int a = ab / PEER_TOPK, b = ab % PEER_TOPK; float v = s1[a] + s2[b]; int rank = 0;
        for (int j = 0; j < PEER_TOPK * PEER_TOPK; ++j) { float w = s1[j / PEER_TOPK] + s2[j % PEER_TOPK]; rank += (w > v || (w == v && j < ab)) ? 1 : 0; }
        if (rank < PEER_TOPK) { p.SELS[t * PEER_TOPK + rank] = v; p.SELE[t * PEER_TOPK + rank] = p.T1I[(t * 2 + 0) * PEER_TOPK + a] * PEER_KEYS + p.T1I[(t * 2 + 1) * PEER_TOPK + b]; } } };
struct K_peer_act { static long n(const P&) { return (long)MP * PEER_HEADS * PEER_TOPK; }
    HD static void run(const P& p, long i) { int k = (int)(i % PEER_TOPK); long t = i / PEER_TOPK; int r = (int)(t / PEER_HEADS); const float* ts = p.SELS + t * PEER_TOPK; float m = ts[0]; for (int j = 1; j < PEER_TOPK; ++j) m = ts[j] > m ? ts[j] : m; float z = 0.f; for (int j = 0; j < PEER_TOPK; ++j) z += expf(ts[j] - m);
        float g = expf(ts[k] - m) / z; const float* x = (p.layer == 0 ? p.X1 : p.X3) + (size_t)r * D_MODEL; const float* u = p.peer_u + ((size_t)p.layer * PEER_EXPERTS + p.SELE[i]) * D_MODEL; float a = 0.f; for (int d = 0; d < D_MODEL; ++d) a += x[d] * u[d]; p.ACT[i] = g * gelu_t(a); } };
struct K_peer_out { static long n(const P&) { return (long)MP * D_MODEL; }
    HD static void run(const P& p, long i) { int d = (int)(i % D_MODEL); long r = i / D_MODEL; float a = 0.f; for (int hk = 0; hk < PEER_HEADS * PEER_TOPK; ++hk) a += p.ACT[r * PEER_HEADS * PEER_TOPK + hk] * p.peer_v[((size_t)p.layer * PEER_EXPERTS + p.SELE[r * PEER_HEADS * PEER_TOPK + hk]) * D_MODEL + d]; p.PRE[i] = a; } };
struct K_ropeKV { static long n(const P&) { return (long)MP * 2 * NSA_KV_HEADS * 32; }
    HD static void run(const P& p, long i) { int d = (int)(i % 32); long t = i / 32; int h = (int)(t % NSA_KV_HEADS); t /= NSA_KV_HEADS; int j = (int)(t % 2); int r = (int)(t / 2);
        float* b = p.ROWS6 + (size_t)r * KVCOLS + ((2 + 2 * j) * NSA_KV_HEADS + h) * HEAD_DIM; float c, s; rope_cs(row_pos(r), d, c, s); float x1 = b[d], x2 = b[d + 32]; b[d] = x1 * c - x2 * s; b[d + 32] = x2 * c + x1 * s; } };
struct K_nsakv_out { static long n(const P&) { return (long)MP * 4 * NSA_KV_HEADS * HEAD_DIM; }
    HD static void run(const P& p, long i) { int c = (int)(i % (4 * NSA_KV_HEADS * HEAD_DIM)); long r = i / (4 * NSA_KV_HEADS * HEAD_DIM); float v = p.ROWS6[(size_t)r * KVCOLS + c]; if (r < M0) p.nsa_kv_p[i] = v; else p.nsa_kv_s[i - (long)M0 * 4 * NSA_KV_HEADS * HEAD_DIM] = v; } };
struct K_win_out_p { static constexpr int W = SWA_WINDOW < SEQ ? SWA_WINDOW : SEQ; static long n(const P&) { return (long)BATCH * W * 2 * NSA_KV_HEADS * HEAD_DIM; }
    HD static void run(const P& p, long i) { constexpr int C = 2 * NSA_KV_HEADS * HEAD_DIM; int c = (int)(i % C); long t = i / C; int w = (int)(t % W); int n = (int)(t / W); p.win_p[i] = p.ROWS6[(size_t)(n * SEQ + SEQ - W + w) * KVCOLS + 4 * NSA_KV_HEADS * HEAD_DIM + c]; } };
struct K_win_out_s { static constexpr int W = SWA_WINDOW < PAST_LEN ? SWA_WINDOW : PAST_LEN; static long n(const P&) { return (long)DEC_BATCH * W * 2 * NSA_KV_HEADS * HEAD_DIM; }
    HD static void run(const P& p, long i) { constexpr int C = 2 * NSA_KV_HEADS * HEAD_DIM; int c = (int)(i % C); long t = i / C; int w = (int)(t % W); int n = (int)(t / W);
        p.win_s[i] = (w < W - 1) ? p.cache_nsa_win[((size_t)n * W + w + 1) * C + c] : p.ROWS6[(size_t)(M0 + n) * KVCOLS + 4 * NSA_KV_HEADS * HEAD_DIM + c]; } };
HD const float* nsa_row(const P& p, int ctx, int t, int j) {
    if (ctx < BATCH) return p.ROWS6 + (size_t)(ctx * SEQ + t) * KVCOLS + j * NSA_KV_HEADS * HEAD_DIM;
    int n = ctx - BATCH; if (t >= PAST_LEN) return p.ROWS6 + (size_t)(M0 + n) * KVCOLS + j * NSA_KV_HEADS * HEAD_DIM;
    int pg = p.page_table[n * (PAST_LEN / PAGE_SIZE) + t / PAGE_SIZE]; return p.cache_nsa_kv + (((size_t)pg * PAGE_SIZE + t % PAGE_SIZE) * 4 + j) * NSA_KV_HEADS * HEAD_DIM; }
struct K_cmp_hid { static long n(const P&) { return (long)NCTX * 2 * NSA_KV_HEADS * NCMP * CMP_HIDDEN; }
    HD static void run(const P& p, long i) { int hd = (int)(i % CMP_HIDDEN); long t = i / CMP_HIDDEN; int c = (int)(t % NCMP); t /= NCMP; int kvh = (int)(t % NSA_KV_HEADS); t /= NSA_KV_HEADS; int ty = (int)(t % 2); int ctx = (int)(t / 2);
        const float* w1 = p.cmp_w1 + (size_t)ty * CMP_BLOCK * HEAD_DIM * CMP_HIDDEN; const float* pe = p.cmp_pe + (size_t)ty * CMP_BLOCK * HEAD_DIM; float a = 0.f;
        for (int l = 0; l < CMP_BLOCK; ++l) { const float* row = nsa_row(p, ctx, c * CMP_STRIDE + l, ty) + kvh * HEAD_DIM; for (int d = 0; d < HEAD_DIM; ++d) a += (row[d] + pe[l * HEAD_DIM + d]) * w1[(size_t)(l * HEAD_DIM + d) * CMP_HIDDEN + hd]; }
        p.HID[i] = gelu_t(a); } };
struct K_cmp_out { static long n(const P&) { return (long)NCTX * 2 * NSA_KV_HEADS * NCMP * HEAD_DIM; }
    HD static void run(const P& p, long i) { int d = (int)(i % HEAD_DIM); long t = i / HEAD_DIM; long tt = t / NCMP / NSA_KV_HEADS; int ty = (int)(tt % 2); const float* w2 = p.cmp_w2 + (size_t)ty * CMP_HIDDEN * HEAD_DIM; const float* h = p.HID + t * CMP_HIDDEN; float a = 0.f; for (int k = 0; k < CMP_HIDDEN; ++k) a += h[k] * w2[k * HEAD_DIM + d]; p.CKV[i] = a; } };
struct K_cmp_rope { static long n(const P&) { return (long)NCTX * NSA_KV_HEADS * NCMP * 32; }
    HD static void run(const P& p, long i) { int d = (int)(i % 32); long t = i / 32; int c = (int)(t % NCMP); t /= NCMP; int kvh = (int)(t % NSA_KV_HEADS); int ctx = (int)(t / NSA_KV_HEADS);
        float* b = p.CKV + ((((size_t)ctx * 2 + 0) * NSA_KV_HEADS + kvh) * NCMP + c) * HEAD_DIM; float cs, sn; rope_cs(c * CMP_STRIDE + CMP_BLOCK - 1, d, cs, sn); float x1 = b[d], x2 = b[d + 32]; b[d] = x1 * cs - x2 * sn; b[d + 32] = x2 * cs + x1 * sn; } };
struct K_ropeQB { static long n(const P&) { return (long)MP * NSA_HEADS * 32; }
    HD static void run(const P& p, long i) { int d = (int)(i % 32); long t = i / 32; int h = (int)(t % NSA_HEADS); int r = (int)(t / NSA_HEADS); float* b = p.PROJB + (size_t)r * BCOLS + h * HEAD_DIM; float c, s; rope_cs(row_pos(r), d, c, s); float x1 = b[d], x2 = b[d + 32]; b[d] = x1 * c - x2 * s; b[d + 32] = x2 * c + x1 * s; } };
struct K_gates { static long n(const P&) { return (long)MP * NSA_GATE_COLS; } HD static void run(const P& p, long i) { int c = (int)(i % NSA_GATE_COLS); long r = i / NSA_GATE_COLS; p.GT[i] = 1.0f / (1.0f + expf(-p.PROJB[(size_t)r * BCOLS + NSA_Q_COLS + c])); } };
HD const float* ckv(const P& p, int ctx, int ty, int kvh, int c) { return p.CKV + ((((size_t)ctx * 2 + ty) * NSA_KV_HEADS + kvh) * NCMP + c) * HEAD_DIM; }
struct K_cmp_s { static long n(const P& p) { return (long)p.nr * NSA_HEADS * NCMP; }
    HD static void run(const P& p, long i) { int c = (int)(i % NCMP); long t = i / NCMP; int h = (int)(t % NSA_HEADS); int r = (int)(t / NSA_HEADS) + p.r0; float s = NEG;
        if (c * CMP_STRIDE + CMP_BLOCK - 1 <= row_pos(r)) { const float* q = p.PROJB + (size_t)r * BCOLS + h * HEAD_DIM; const float* k = ckv(p, row_ctx(r), 0, h / NSA_GROUP, c); float a = 0.f; for (int d = 0; d < HEAD_DIM; ++d) a += q[d] * k[d]; s = a * SCALE; }
        p.SC[i] = s; } };
struct K_cmp_sm { static long n(const P& p) { return (long)p.nr * NSA_HEADS; } HD static void run(const P& p, long i) { softmax_row(p.SC + i * NCMP, NCMP); } };
struct K_cmp_o { static long n(const P& p) { return (long)p.nr * NSA_HEADS * HEAD_DIM; }
    HD static void run(const P& p, long i) { int d = (int)(i % HEAD_DIM); long t = i / HEAD_DIM; int h = (int)(t % NSA_HEADS); int r = (int)(t / NSA_HEADS) + p.r0; const float* pr = p.SC + t * NCMP; float a = 0.f; for (int c = 0; c < NCMP; ++c) a += pr[c] * ckv(p, row_ctx(r), 1, h / NSA_GROUP, c)[d]; p.OC[i] = a; } };
struct K_imp { static long n(const P& p) { return (long)p.nr * NSA_KV_HEADS * NBMAX; }
    HD static void run(const P& p, long i) { int b = (int)(i % NBMAX); long t = i / NBMAX; int kvh = (int)(t % NSA_KV_HEADS); int rl = (int)(t / NSA_KV_HEADS); int r = rl + p.r0; int nb = r < M0 ? NB_P : NB_S; int cur = row_pos(r) / SLC_BLOCK; float sc;
        if (b >= nb) sc = -3.0e38f;
        else if (b > cur) sc = NEG; else if (b == 0 || b == cur || b == cur - 1) sc = FORCE_SCORE;
        else { float a = 0.f; constexpr int RS = SLC_BLOCK / CMP_STRIDE, RC = CMP_BLOCK / CMP_STRIDE; for (int m = 0; m < RS; ++m) for (int j = 0; j < RC; ++j) { int ci = b * RS + m - j; if (ci >= 0 && ci < NCMP) for (int g = 0; g < NSA_GROUP; ++g) a += p.SC[((size_t)rl * NSA_HEADS + kvh * NSA_GROUP + g) * NCMP + ci]; } sc = a; }
        p.IMPS[i] = sc; } };
struct K_sel { static long n(const P& p) { return (long)p.nr * NSA_KV_HEADS * NBMAX; }
    HD static void run(const P& p, long i) { int b = (int)(i % NBMAX); long t = i / NBMAX; const float* s = p.IMPS + t * NBMAX; float v = s[b]; int rank = 0; for (int j = 0; j < NBMAX; ++j) rank += (s[j] > v || (s[j] == v && j < b)) ? 1 : 0;
        if (rank < NSEL) p.SELB[t * NSEL + rank] = (v > 0.5f * NEG) ? b : -1; } };
struct K_slc_s { static long n(const P& p) { return (long)p.nr * NSA_HEADS * NSEL * SLC_BLOCK; }
    HD static void run(const P& p, long i) { int kl = (int)(i % (NSEL * SLC_BLOCK)); long t = i / (NSEL * SLC_BLOCK); int h = (int)(t % NSA_HEADS); int rl = (int)(t / NSA_HEADS); int r = rl + p.r0; int kvh = h / NSA_GROUP; int b = p.SELB[((size_t)rl * NSA_KV_HEADS + kvh) * NSEL + kl / SLC_BLOCK]; float s = NEG;
        if (b >= 0) { int kpos = b * SLC_BLOCK + kl % SLC_BLOCK; if (kpos <= row_pos(r)) { const float* q = p.PROJB + (size_t)r * BCOLS + h * HEAD_DIM; const float* k = nsa_row(p, row_ctx(r), kpos, 2) + kvh * HEAD_DIM; float a = 0.f; for (int d = 0; d < HEAD_DIM; ++d) a += q[d] * k[d]; s = a * SCALE; } }
        p.SS[i] = s; } };
struct K_slc_sm { static long n(const P& p) { return (long)p.nr * NSA_HEADS; } HD static void run(const P& p, long i) { softmax_row(p.SS + i * NSEL * SLC_BLOCK, NSEL * SLC_BLOCK); } };
struct K_slc_o { static long n(const P& p) { return (long)p.nr * NSA_HEADS * HEAD_DIM; }
    HD static void run(const P& p, long i) { int d = (int)(i % HEAD_DIM); long t = i / HEAD_DIM; int h = (int)(t % NSA_HEADS); int rl = (int)(t / NSA_HEADS); int r = rl + p.r0; int kvh = h / NSA_GROUP; const float* pr = p.SS + t * NSEL * SLC_BLOCK; float a = 0.f;
        for (int kl = 0; kl < NSEL * SLC_BLOCK; ++kl) { float w = pr[kl]; if (w != 0.f) { int b = p.SELB[((size_t)rl * NSA_KV_HEADS + kvh) * NSEL + kl / SLC_BLOCK]; a += w * nsa_row(p, row_ctx(r), b * SLC_BLOCK + kl % SLC_BLOCK, 3)[kvh * HEAD_DIM + d]; } }
        p.OS[i] = a; } };
HD const float* win_row(const P& p, int r, int w, int which) {
    constexpr int C = 2 * NSA_KV_HEADS * HEAD_DIM;
    if (r < M0) { int t = r % SEQ, tk = t - SWA_WINDOW + w; if (tk < 0) return nullptr; return p.ROWS6 + (size_t)(r - SWA_WINDOW + w) * KVCOLS + (4 + which) * NSA_KV_HEADS * HEAD_DIM; }
    int n = r - M0; if (w == SWA_WINDOW) return p.ROWS6 + (size_t)r * KVCOLS + (4 + which) * NSA_KV_HEADS * HEAD_DIM; return p.cache_nsa_win + ((size_t)n * SWA_WINDOW + w) * C + which * NSA_KV_HEADS * HEAD_DIM; }
struct K_win_s { static long n(const P& p) { return (long)p.nr * NSA_HEADS * WINK; }
    HD static void run(const P& p, long i) { int w = (int)(i % WINK); long t = i / WINK; int h = (int)(t % NSA_HEADS); int r = (int)(t / NSA_HEADS) + p.r0; const float* k = win_row(p, r, w, 0); float s = NEG;
        if (k) { const float* q = p.PROJB + (size_t)r * BCOLS + h * HEAD_DIM; float a = 0.f; for (int d = 0; d < HEAD_DIM; ++d) a += q[d] * k[(h / NSA_GROUP) * HEAD_DIM + d]; s = a * SCALE; } p.SW[i] = s; } };
struct K_win_sm { static long n(const P& p) { return (long)p.nr * NSA_HEADS; } HD static void run(const P& p, long i) { softmax_row(p.SW + i * WINK, WINK); } };
struct K_win_o { static long n(const P& p) { return (long)p.nr * NSA_HEADS * HEAD_DIM; }
    HD static void run(const P& p, long i) { int d = (int)(i % HEAD_DIM); long t = i / HEAD_DIM; int h = (int)(t % NSA_HEADS); int r = (int)(t / NSA_HEADS) + p.r0; const float* pr = p.SW + t * WINK; float a = 0.f;
        for (int w = 0; w < WINK; ++w) { float x = pr[w]; if (x != 0.f) a += x * win_row(p, r, w, 1)[(h / NSA_GROUP) * HEAD_DIM + d]; } p.OW[i] = a; } };
struct K_nsa_comb { static long n(const P& p) { return (long)p.nr * NSA_HEADS * HEAD_DIM; }
    HD static void run(const P& p, long i) { long t = i / HEAD_DIM; int h = (int)(t % NSA_HEADS); long r = t / NSA_HEADS + p.r0; const float* g = p.GT + r * NSA_GATE_COLS + h * 3; p.ATTB[r * (NSA_Q_COLS + MEM_COLS) + (i % (NSA_HEADS * HEAD_DIM))] = g[0] * p.OC[i] + g[1] * p.OS[i] + g[2] * p.OW[i]; } };
struct K_out { static long n(const P&) { return (long)MP * D_MODEL; } HD static void run(const P& p, long i) { long r = i / D_MODEL; if (r < M0) p.y_prompt[i] = p.X0[i]; else p.y_sample[i - (long)M0 * D_MODEL] = p.X0[i]; } };
struct K_ln { LnArgs a; };

template <class EX> void forward(P p, EX& ex) {
    ex.template run<K_x0>(p);
    ex.template run<K_memkv>(p);
    p.layer = 0;
    ex.gemm(GemmArgs{p.X0, p.w_in_a, p.PROJA, MP, ACOLS, D_MODEL, D_MODEL, ACOLS, ACOLS});
    ex.template run<K_ropeA>(p);
    ex.template run<K_dilout_p<0>>(p); ex.template run<K_dilout_p<1>>(p); ex.template run<K_dilout_p<2>>(p);
    ex.template run<K_dilout_s<0>>(p); ex.template run<K_dilout_s<1>>(p); ex.template run<K_dilout_s<2>>(p);
    for (int r0 = 0; r0 < MP; r0 += CHROWS) { p.r0 = r0; p.nr = (MP - r0) < CHROWS ? (MP - r0) : CHROWS;
        ex.template run<K_dil_s>(p); ex.template run<K_dil_sm>(p); ex.template run<K_dil_o>(p);
        ex.template run<K_mem_s>(p); ex.template run<K_mem_sm>(p); ex.template run<K_mem_o>(p); }
    ex.gemm(GemmArgs{p.ATTA, p.w_out_a, p.PRE, MP, D_MODEL, 2 * MEM_COLS, 2 * MEM_COLS, D_MODEL, D_MODEL});
    ex.ln(p, LnArgs{p.X0, p.PRE, p.X1, 0, 0});
    ex.gemm(GemmArgs{p.X1, p.peer_wq, p.QP, MP, PEER_HEADS * PEER_KEY_DIM, D_MODEL, D_MODEL, PEER_HEADS * PEER_KEY_DIM, PEER_HEADS * PEER_KEY_DIM});
    ex.template run<K_peer_sk>(p); ex.template run<K_peer_t1>(p); ex.template run<K_peer_t2>(p); ex.template run<K_peer_act>(p); ex.template run<K_peer_out>(p);
    ex.ln(p, LnArgs{p.X1, p.PRE, p.X2, 1, 0});
    p.layer = 1;
    ex.gemm(GemmArgs{p.X2, p.w_kv_b, p.ROWS6, MP, KVCOLS, D_MODEL, D_MODEL, KVCOLS, KVCOLS});
    ex.template run<K_ropeKV>(p);
    ex.template run<K_nsakv_out>(p); ex.template run<K_win_out_p>(p); ex.template run<K_win_out_s>(p);
    ex.template run<K_cmp_hid>(p); ex.template run<K_cmp_out>(p); ex.template run<K_cmp_rope>(p);
    ex.gemm(GemmArgs{p.X2, p.w_in_b, p.PROJB, MP, BCOLS, D_MODEL, D_MODEL, BCOLS, BCOLS});
    ex.template run<K_ropeQB>(p); ex.template run<K_gates>(p);
    for (int r0 = 0; r0 < MP; r0 += CHROWS) { p.r0 = r0; p.nr = (MP - r0) < CHROWS ? (MP - r0) : CHROWS;
        ex.template run<K_cmp_s>(p); ex.template run<K_cmp_sm>(p); ex.template run<K_cmp_o>(p);
        ex.template run<K_imp>(p); ex.template run<K_sel>(p);
        ex.template run<K_slc_s>(p); ex.template run<K_slc_sm>(p); ex.template run<K_slc_o>(p);
        ex.template run<K_win_s>(p); ex.template run<K_win_sm>(p); ex.template run<K_win_o>(p);
        ex.template run<K_nsa_comb>(p);
        ex.template run<K_mem_s>(p); ex.template run<K_mem_sm>(p); ex.template run<K_mem_o>(p); }
    ex.gemm(GemmArgs{p.ATTB, p.w_out_b, p.PRE, MP, D_MODEL, NSA_Q_COLS + MEM_COLS, NSA_Q_COLS + MEM_COLS, D_MODEL, D_MODEL});
    ex.ln(p, LnArgs{p.X2, p.PRE, p.X3, 0, 0});
    ex.gemm(GemmArgs{p.X3, p.peer_wq + (size_t)D_MODEL * PEER_HEADS * PEER_KEY_DIM, p.QP, MP, PEER_HEADS * PEER_KEY_DIM, D_MODEL, D_MODEL, PEER_HEADS * PEER_KEY_DIM, PEER_HEADS * PEER_KEY_DIM});
    ex.template run<K_peer_sk>(p); ex.template run<K_peer_t1>(p); ex.template run<K_peer_t2>(p); ex.template run<K_peer_act>(p); ex.template run<K_peer_out>(p);
    ex.ln(p, LnArgs{p.X3, p.PRE, p.X0, 1, 0});
    ex.template run<K_out>(p);
}
struct Carve { size_t off = 0; template <class T> T* take(void* base, size_t n) { T* r = (T*)((char*)base + off); off += ((n * sizeof(T) + 255) / 256) * 256; return r; } };
inline size_t carve(P& p, void* base) {
    Carve c;
    p.PROJA = c.take<float>(base, (size_t)MP * ACOLS); p.SDIL = c.take<float>(base, (size_t)CHROWS * DIL_HEADS * NTAP);
    p.ATTA = c.take<float>(base, (size_t)MP * 2 * MEM_COLS); p.SMEM = c.take<float>(base, (size_t)CHROWS * MEM_HEADS * MEM_TOKENS); p.PRE = c.take<float>(base, (size_t)MP * D_MODEL);
    p.SW = c.take<float>(base, (size_t)CHROWS * NSA_HEADS * WINK);
    p.X0 = c.take<float>(base, (size_t)MP * D_MODEL);
    p.X1 = c.take<float>(base, (size_t)MP * D_MODEL); p.QP = c.take<float>(base, (size_t)MP * PEER_HEADS * PEER_KEY_DIM); p.SK = c.take<float>(base, (size_t)MP * PEER_HEADS * 2 * PEER_KEYS);
    p.T1S = c.take<float>(base, (size_t)MP * PEER_HEADS * 2 * PEER_TOPK); p.T1I = c.take<int>(base, (size_t)MP * PEER_HEADS * 2 * PEER_TOPK);
    p.SELS = c.take<float>(base, (size_t)MP * PEER_HEADS * PEER_TOPK); p.SELE = c.take<int>(base, (size_t)MP * PEER_HEADS * PEER_TOPK); p.ACT = c.take<float>(base, (size_t)MP * PEER_HEADS * PEER_TOPK);
    p.X2 = c.take<float>(base, (size_t)MP * D_MODEL); p.ROWS6 = c.take<float>(base, (size_t)MP * KVCOLS); p.PROJB = c.take<float>(base, (size_t)MP * BCOLS);
    p.HID = c.take<float>(base, (size_t)NCTX * 2 * NSA_KV_HEADS * NCMP * CMP_HIDDEN); p.CKV = c.take<float>(base, (size_t)NCTX * 2 * NSA_KV_HEADS * NCMP * HEAD_DIM);
    p.SC = c.take<float>(base, (size_t)CHROWS * NSA_HEADS * NCMP); p.OC = c.take<float>(base, (size_t)CHROWS * NSA_HEADS * HEAD_DIM); p.IMPS = c.take<float>(base, (size_t)CHROWS * NSA_KV_HEADS * NBMAX);
    p.SELB = c.take<int>(base, (size_t)CHROWS * NSA_KV_HEADS * NSEL); p.SS = c.take<float>(base, (size_t)CHROWS * NSA_HEADS * NSEL * SLC_BLOCK); p.OS = c.take<float>(base, (size_t)CHROWS * NSA_HEADS * HEAD_DIM);
    p.OW = c.take<float>(base, (size_t)CHROWS * NSA_HEADS * HEAD_DIM); p.ATTB = c.take<float>(base, (size_t)MP * (NSA_Q_COLS + MEM_COLS));
    p.X3 = c.take<float>(base, (size_t)MP * D_MODEL); p.GT = c.take<float>(base, (size_t)MP * NSA_GATE_COLS);
    return c.off;
}
inline void bind_io(P& p, void* const* d_in, float* out) {
    p.x_prompt = (const float*)d_in[0]; p.x_sample = (const float*)d_in[1]; p.mem_prompt = (const float*)d_in[2]; p.cache_dil[0] = (const float*)d_in[3]; p.cache_dil[1] = (const float*)d_in[4]; p.cache_dil[2] = (const float*)d_in[5];
    p.cache_nsa_kv = (const float*)d_in[6]; p.cache_nsa_win = (const float*)d_in[7]; p.cache_mem_kv = (const float*)d_in[8]; p.page_table = (const int*)d_in[9];
    p.w_in_a = (const float*)d_in[10]; p.w_out_a = (const float*)d_in[11]; p.w_in_b = (const float*)d_in[12]; p.w_out_b = (const float*)d_in[13]; p.w_mem_kv = (const float*)d_in[14]; p.w_kv_b = (const float*)d_in[15];
    p.cmp_pe = (const float*)d_in[16]; p.cmp_w1 = (const float*)d_in[17]; p.cmp_w2 = (const float*)d_in[18]; p.ln_g = (const float*)d_in[19]; p.ln_b = (const float*)d_in[20];
    p.peer_wq = (const float*)d_in[21]; p.peer_keys = (const float*)d_in[22]; p.peer_u = (const float*)d_in[23]; p.peer_v = (const float*)d_in[24];
    size_t o = 0; auto take = [&](size_t n) { float* r = out + o; o += n; return r; };
    p.y_prompt = take((size_t)M0 * D_MODEL); p.y_sample = take((size_t)DEC_BATCH * D_MODEL);
    for (int g = 0; g < 3; ++g) p.dil_p[g] = take((size_t)BATCH * (DIL_W[g] < SEQ ? DIL_W[g] : SEQ) * 2 * DIL_HEADS * HEAD_DIM);
    for (int g = 0; g < 3; ++g) p.dil_s[g] = take((size_t)DEC_BATCH * (DIL_W[g] < PAST_LEN ? DIL_W[g] : PAST_LEN) * 2 * DIL_HEADS * HEAD_DIM);
    p.nsa_kv_p = take((size_t)M0 * 4 * NSA_KV_HEADS * HEAD_DIM); p.nsa_kv_s = take((size_t)DEC_BATCH * 4 * NSA_KV_HEADS * HEAD_DIM);
    p.win_p = take((size_t)BATCH * (SWA_WINDOW < SEQ ? SWA_WINDOW : SEQ) * 2 * NSA_KV_HEADS * HEAD_DIM); p.win_s = take((size_t)DEC_BATCH * (SWA_WINDOW < PAST_LEN ? SWA_WINDOW : PAST_LEN) * 2 * NSA_KV_HEADS * HEAD_DIM);
    p.mem_kv_p = take((size_t)DEPTH * BATCH * MEM_TOKENS * 2 * MEM_COLS);
}
}
template <class K> __global__ void __launch_bounds__(256) nv_run(nv::P p, long n) { for (long i = blockIdx.x * 256L + threadIdx.x; i < n; i += gridDim.x * 256L) K::run(p, i); }
__global__ void __launch_bounds__(256) nv_gemm(nv::GemmArgs g, long n) { for (long i = blockIdx.x * 256L + threadIdx.x; i < n; i += gridDim.x * 256L) nv::gemm_elem(g, i); }
__global__ void __launch_bounds__(256) nv_ln(nv::P p, nv::LnArgs a, long n) { for (long i = blockIdx.x * 256L + threadIdx.x; i < n; i += gridDim.x * 256L) nv::ln_row(p, a, i); }
struct GpuEx {
    hipStream_t st;
    static int grid_for(long n) { long b = (n + 255) / 256; return (int)(b > 16384 ? 16384 : (b < 1 ? 1 : b)); }
    template <class K> void run(const nv::P& p) { long n = K::n(p); hipLaunchKernelGGL(nv_run<K>, dim3(grid_for(n)), dim3(256), 0, st, p, n); }
    void gemm(const nv::GemmArgs& g) { long n = (long)g.M * g.N; hipLaunchKernelGGL(nv_gemm, dim3(grid_for(n)), dim3(256), 0, st, g, n); }
    void ln(const nv::P& p, const nv::LnArgs& a) { hipLaunchKernelGGL(nv_ln, dim3(grid_for(nv::MP)), dim3(256), 0, st, p, a, (long)nv::MP); }
};
namespace pg8 {
#define PG8_LAS __attribute__((address_space(3)))
typedef unsigned short bf16_t;
typedef short bf16x8 __attribute__((ext_vector_type(8)));
typedef float f32x4 __attribute__((ext_vector_type(4)));
typedef unsigned u32x4 __attribute__((ext_vector_type(4)));
constexpr int BM = 256, BK = 64, HALF = 128, HTB = HALF * BK * 2  , STAGE_BYTES = 8 * HTB, NXCD = 8, WGM = 8;

__host__ __device__ __forceinline__ int lds_byte(int r, int c) { const int st = (r >> 4) * 2 + (c >> 5), rr = r & 15, cc = c & 31, ob = rr * 64 + cc * 2; return st * 1024 + (ob ^ (((ob >> 9) & 1) << 5)); }
__host__ __device__ __forceinline__ void stage_rc(int b, int& R, int& C) { const int st = b / 1024, sb = b % 1024, swz = sb ^ (((sb >> 9) & 1) << 5); R = (st >> 1) * 16 + swz / 64; C = (st & 1) * 32 + (swz % 64) / 2; }
__host__ __device__ __forceinline__ int perm32(int rho) { const int n = rho >> 4, i = rho & 15; return 8 * (i >> 2) + 4 * n + (i & 3); }

struct Unit { int pm, pn; };
struct Gemm { const bf16_t* A; const bf16_t* Bt; int M, N, K; };

struct StaticOrder {
    int nM, nN, nwg, G, c;
    __host__ __device__ void init(int M, int N, int G_, int c_) { nM = M / BM; nN = N / BM; nwg = nM * nN; G = G_; c = c_; }
    __host__ __device__ bool next(int i, Unit& u) const {
        const long L = (long)i * G + c; if (L >= nwg) return false;
        int wgid = (int)L; { const int q = nwg / NXCD, r = nwg % NXCD, xcd = wgid % NXCD, off = wgid / NXCD; wgid = (xcd < r ? xcd * (q + 1) : r * (q + 1) + (xcd - r) * q) + off; }
        const int nig = WGM * nN, gid = wgid / nig, fm = gid * WGM, gsz = (nM - fm) < WGM ? (nM - fm) : WGM;
        u.pm = fm + ((wgid % nig) % gsz); u.pn = (wgid % nig) / gsz; return true;
    }
    __device__ __forceinline__ void a_ready(const Unit&) const {}
    __device__ __forceinline__ void done(const Unit&) const {}
};

__device__ __forceinline__ unsigned cvt_pk_bf16(float lo, float hi) { unsigned r; asm volatile("v_cvt_pk_bf16_f32 %0, %1, %2" : "=v"(r) : "v"(lo), "v"(hi)); return r; }
typedef float f32x2 __attribute__((ext_vector_type(2)));
typedef float f32x2 __attribute__((ext_vector_type(2)));
template <class Epi, class Sched, bool ALIGN_EPI = false, bool SP2 = false>
__device__ __forceinline__ void gemm_phase(PG8_LAS unsigned char* lds, const Gemm g, const Sched& S, const Epi& E) {
    const int tid = threadIdx.x, wid = __builtin_amdgcn_readfirstlane(tid >> 6), lane = tid & 63, wr = wid >> 2, wc = wid & 3, fr = lane & 15, fq = lane >> 4;
    const int K = g.K, nt = K / BK;
    unsigned voffA[2], voffB[2];
#pragma unroll
    for (int i = 0; i < 2; ++i) { int R, C; stage_rc(tid * 16 + i * 8192, R, C); const int Rb = Epi::PERM ? ((R & ~31) + perm32(R & 31)) : R;
        voffA[i] = (unsigned)(R * K + C) * 2u; voffB[i] = (unsigned)(Rb * K + C) * 2u; }
    const size_t kstep = (size_t)(BK * 2);
    const size_t hstep = (size_t)HALF * K * 2;
    const size_t tstep = 2 * hstep;
    const unsigned ldsw = (unsigned)wid * 1024u;
    const int aoff = lds_byte(wr * 64 + fr, fq * 8), boff = lds_byte(wc * 32 + fr, fq * 8);
#define PG8_SA(b, h) (((b) * 2 + (h)) * HTB)
#define PG8_SB(b, h) ((4 + (b) * 2 + (h)) * HTB)
#define PG8_STAGE(bufoff, gbase, voff) do { _Pragma("unroll") for (int _i = 0; _i < 2; ++_i) \
        __builtin_amdgcn_global_load_lds((const unsigned*)((const char*)(gbase) + (voff)[_i]), (PG8_LAS unsigned*)(lds + (bufoff) + ldsw + _i * 8192), 16, 0, 0); } while (0)
#define PG8_LDA(dst, b, h) do { _Pragma("unroll") for (int m = 0; m < 4; ++m) _Pragma("unroll") for (int k = 0; k < 2; ++k) dst[m][k] = *(const PG8_LAS bf16x8*)(lds + PG8_SA(b, h) + aoff + m * 2048 + k * 1024); } while (0)
#define PG8_LDB(dst, b, h) do { _Pragma("unroll") for (int n = 0; n < 2; ++n) _Pragma("unroll") for (int k = 0; k < 2; ++k) dst[n][k] = *(const PG8_LAS bf16x8*)(lds + PG8_SB(b, h) + boff + n * 2048 + k * 1024); } while (0)
#define PG8_MMA(ai, bj, At, Bt) do { __builtin_amdgcn_s_setprio(1); _Pragma("unroll") for (int m = 0; m < 4; ++m) _Pragma("unroll") for (int n = 0; n < 2; ++n) _Pragma("unroll") for (int k = 0; k < 2; ++k) \
        acc[ai][bj][m][n] = __builtin_amdgcn_mfma_f32_16x16x32_bf16(Bt[n][k], At[m][k], acc[ai][bj][m][n], 0, 0, 0); __builtin_amdgcn_s_setprio(0); } while (0)
#define PG8_WAIT_V(n) asm volatile("s_waitcnt vmcnt(" #n ")" ::: "memory")
#define PG8_WAIT_L(n) asm volatile("s_waitcnt lgkmcnt(" #n ")" ::: "memory")
#define PG8_BAR __builtin_amdgcn_s_barrier()
#define PG8_SCHED __builtin_amdgcn_sched_barrier(0)
    Unit cur, nxt; int ui = 0;
    if (!S.next(0, cur)) return;
    f32x4 acc[2][2][4][2];
#pragma unroll
    for (int a = 0; a < 2; ++a)
#pragma unroll
        for (int b = 0; b < 2; ++b)
#pragma unroll
            for (int m = 0; m < 4; ++m)
#pragma unroll
                for (int n = 0; n < 2; ++n) acc[a][b][m][n] = (f32x4){0.f, 0.f, 0.f, 0.f};
    bf16x8 At[4][2], B0[2][2], B1[2][2];
    const char* cA = (const char*)g.A + (size_t)cur.pm * tstep; const char* cB = (const char*)g.Bt + (size_t)cur.pn * tstep;
    S.a_ready(cur);
    if constexpr (SP2) {
        PG8_STAGE(PG8_SB(0, 0), cB, voffB); PG8_STAGE(PG8_SB(0, 1), cB + hstep, voffB); PG8_STAGE(PG8_SA(0, 0), cA, voffA); PG8_STAGE(PG8_SA(0, 1), cA + hstep, voffA);
        if (wr == 1) PG8_BAR;
        PG8_WAIT_V(2); PG8_BAR;
        PG8_STAGE(PG8_SB(1, 0), cB + kstep, voffB); PG8_STAGE(PG8_SA(1, 0), cA + kstep, voffA); PG8_STAGE(PG8_SB(1, 1), cB + hstep + kstep, voffB);
        PG8_WAIT_V(6); PG8_BAR;
    } else {
        PG8_STAGE(PG8_SB(0, 0), cB, voffB); PG8_STAGE(PG8_SA(0, 0), cA, voffA); PG8_STAGE(PG8_SB(0, 1), cB + hstep, voffB); PG8_STAGE(PG8_SA(0, 1), cA + hstep, voffA);
        if (wr == 1) PG8_BAR;
        PG8_WAIT_V(4); PG8_BAR;
        PG8_STAGE(PG8_SB(1, 0), cB + kstep, voffB); PG8_STAGE(PG8_SA(1, 0), cA + kstep, voffA); PG8_STAGE(PG8_SB(1, 1), cB + hstep + kstep, voffB);
        PG8_WAIT_V(6); PG8_BAR;
    }
    for (;;) {
        const bool has_next = S.next(ui + 1, nxt);
        const char* nA = has_next ? (const char*)g.A + (size_t)nxt.pm * tstep : cA; const char* nB = has_next ? (const char*)g.Bt + (size_t)nxt.pn * tstep : cB;
        for (int t = 0; t < nt; t += 2) {
            const bool last = (t == nt - 2);
            const char* a1 = cA + (size_t)(t + 1) * kstep;
            const char* a2 = last ? nA : cA + (size_t)(t + 2) * kstep; const char* b2 = last ? nB : cB + (size_t)(t + 2) * kstep;
            const char* a3 = a2 + kstep; const char* b3 = b2 + kstep;
            if (last && has_next) S.a_ready(nxt);
            if constexpr (SP2) {
            PG8_LDB(B0, 0, 0); PG8_LDB(B1, 0, 1); PG8_SCHED; PG8_LDA(At, 0, 0); PG8_STAGE(PG8_SA(1, 1), a1 + hstep, voffA);
            PG8_WAIT_V(8); PG8_WAIT_L(0); PG8_BAR; PG8_MMA(0, 0, At, B0); PG8_MMA(0, 1, At, B1); PG8_BAR; PG8_SCHED;
            PG8_LDA(At, 0, 1); PG8_STAGE(PG8_SB(0, 0), b2, voffB); PG8_STAGE(PG8_SB(0, 1), b2 + hstep, voffB); PG8_STAGE(PG8_SA(0, 0), a2, voffA);
            PG8_WAIT_V(8); PG8_WAIT_L(0); PG8_BAR; PG8_MMA(1, 0, At, B0); PG8_MMA(1, 1, At, B1); PG8_BAR; PG8_SCHED;
            PG8_LDB(B0, 1, 0); PG8_LDB(B1, 1, 1); PG8_SCHED; PG8_LDA(At, 1, 0); PG8_STAGE(PG8_SA(0, 1), a2 + hstep, voffA);
            PG8_WAIT_V(8); PG8_WAIT_L(0); PG8_BAR; PG8_MMA(0, 0, At, B0); PG8_MMA(0, 1, At, B1); PG8_BAR; PG8_SCHED;
            PG8_LDA(At, 1, 1); PG8_STAGE(PG8_SB(1, 0), b3, voffB); PG8_STAGE(PG8_SB(1, 1), b3 + hstep, voffB); PG8_STAGE(PG8_SA(1, 0), a3, voffA);
            PG8_WAIT_V(8); PG8_WAIT_L(0); PG8_BAR; PG8_MMA(1, 0, At, B0); PG8_MMA(1, 1, At, B1); PG8_BAR; PG8_SCHED;
            } else {
            PG8_LDB(B0, 0, 0); PG8_SCHED; PG8_LDA(At, 0, 0); PG8_STAGE(PG8_SA(1, 1), a1 + hstep, voffA);
            PG8_WAIT_L(8); PG8_BAR; PG8_WAIT_L(0); PG8_MMA(0, 0, At, B0); PG8_BAR; PG8_SCHED;
            PG8_LDB(B1, 0, 1); PG8_STAGE(PG8_SB(0, 0), b2, voffB);
            PG8_BAR; PG8_WAIT_L(0); PG8_MMA(0, 1, At, B1); PG8_BAR;
            PG8_LDA(At, 0, 1); PG8_STAGE(PG8_SA(0, 0), a2, voffA);
            PG8_BAR; PG8_WAIT_L(0); PG8_MMA(1, 0, At, B0); PG8_BAR; PG8_SCHED;
            PG8_STAGE(PG8_SB(0, 1), b2 + hstep, voffB);
            PG8_WAIT_V(6); PG8_BAR; PG8_MMA(1, 1, At, B1); PG8_BAR;
            PG8_LDB(B0, 1, 0); PG8_SCHED; PG8_LDA(At, 1, 0); PG8_STAGE(PG8_SA(0, 1), a2 + hstep, voffA);
            PG8_WAIT_L(8); PG8_BAR; PG8_WAIT_L(0); PG8_MMA(0, 0, At, B0); PG8_BAR; PG8_SCHED;
            PG8_LDB(B1, 1, 1); PG8_STAGE(PG8_SB(1, 0), b3, voffB);
            PG8_BAR; PG8_WAIT_L(0); PG8_MMA(0, 1, At, B1); PG8_BAR;
            PG8_LDA(At, 1, 1); PG8_STAGE(PG8_SA(1, 0), a3, voffA);
            PG8_BAR; PG8_WAIT_L(0); PG8_MMA(1, 0, At, B0); PG8_BAR; PG8_SCHED;
            PG8_STAGE(PG8_SB(1, 1), b3 + hstep, voffB);
            PG8_WAIT_V(6); PG8_BAR; PG8_MMA(1, 1, At, B1); PG8_BAR;
            }
        }
        if constexpr (ALIGN_EPI) { if (wr == 0) PG8_BAR; }
        if constexpr (!Epi::AFTER_DRAIN) { E(acc, cur, wr, wc, fr, fq); S.done(cur); }
        if (!has_next) break;
#pragma unroll
        for (int a = 0; a < 2; ++a)
#pragma unroll
            for (int b = 0; b < 2; ++b)
#pragma unroll
                for (int m = 0; m < 4; ++m)
#pragma unroll
                    for (int n = 0; n < 2; ++n) acc[a][b][m][n] = (f32x4){0.f, 0.f, 0.f, 0.f};
        cur = nxt; cA = nA; cB = nB; ++ui;
        if constexpr (ALIGN_EPI) { if (wr == 1) PG8_BAR; }
    }
    PG8_WAIT_V(0);
    if constexpr (!ALIGN_EPI) { if (wr == 0) PG8_BAR; }
    PG8_BAR;
    if constexpr (Epi::AFTER_DRAIN) { E.fused(acc, cur, wr, wc, fr, fq, lds, wid, lane); S.done(cur); }
#undef PG8_SA
#undef PG8_SB
#undef PG8_STAGE
#undef PG8_LDA
#undef PG8_LDB
#undef PG8_MMA
#undef PG8_WAIT_V
#undef PG8_WAIT_L
#undef PG8_BAR
#undef PG8_SCHED
}
}
#define XB_TMO      128
#define XB_XCNT(j)  (256  + 64 * (j))
#define XB_XSUB(j)  (1280 + 64 * (j))
#define XB_XGEN(j)  (2304 + 64 * (j))
#define XB_TOP      3328
#define XB_TOPGEN   3392
#define XCD_BAR_WORDS 3456
#define XB_SPIN_CAP (1u << 18)

__device__ __forceinline__ unsigned xb_ld(unsigned* p)              { return __hip_atomic_load(p, __ATOMIC_RELAXED, __HIP_MEMORY_SCOPE_AGENT); }
__device__ __forceinline__ unsigned xb_add(unsigned* p, unsigned v) { return __hip_atomic_fetch_add(p, v, __ATOMIC_RELAXED, __HIP_MEMORY_SCOPE_AGENT); }
__device__ __forceinline__ unsigned xb_xcc_id() { return (unsigned)__builtin_amdgcn_s_getreg((3 << 11) | 20) & 0xFu; }
#define XB_SPIN(cond, bar) do { unsigned _sp = 0; while (cond) { __builtin_amdgcn_s_sleep(1); \
    if ((++_sp & 255u) == 0u) { if (xb_ld(&(bar)[XB_TMO])) break; if (_sp > XB_SPIN_CAP) { atomicAdd(&(bar)[XB_TMO], 1u); break; } } } } while (0)

struct XcdBarrier {
    unsigned* bar; unsigned x;
    volatile LAS unsigned* st;
};

__device__ __forceinline__ XcdBarrier xcd_barrier_post(unsigned* bar, volatile LAS unsigned* st) {
    XcdBarrier b; b.bar = bar; b.x = xb_xcc_id(); b.st = st;
    if (threadIdx.x == 0) (void)xb_add(&bar[XB_XCNT(b.x)], 1u);
    return b;
}
__device__ __forceinline__ void xcd_barrier_complete(unsigned* bar, unsigned x, unsigned& nloc, unsigned& nx) {
    const unsigned G = gridDim.x * gridDim.y * gridDim.z;
    unsigned sum, cnt, mine, sp = 0u;
    for (;;) {
        sum = 0u; cnt = 0u; mine = 0u;
#pragma unroll
        for (unsigned j = 0; j < 16; ++j) { const unsigned c = xb_ld(&bar[XB_XCNT(j)]); sum += c; cnt += (c > 0u) ? 1u : 0u; mine = (j == x) ? c : mine; }
        if (sum == G) break;
        __builtin_amdgcn_s_sleep(1);
        if ((++sp & 255u) == 0u) { if (xb_ld(&bar[XB_TMO])) break; if (sp > XB_SPIN_CAP) { atomicAdd(&bar[XB_TMO], 1u); break; } }
    }
    nloc = mine > 0u ? mine : 1u; nx = cnt > 0u ? cnt : 1u;
}

__device__ __forceinline__ void xcd_barrier(const XcdBarrier& b) {
    asm volatile("s_waitcnt vmcnt(0)" ::: "memory");
    __syncthreads();
    if (threadIdx.x == 0) {
        unsigned* bar = b.bar;
        __builtin_amdgcn_s_waitcnt(0);
        unsigned nloc = b.st[0], nx = b.st[1];
        if (nloc == 0u) { xcd_barrier_complete(bar, b.x, nloc, nx); b.st[0] = nloc; b.st[1] = nx; }
        const unsigned old = xb_add(&bar[XB_XSUB(b.x)], 1u);
        const unsigned gen = old / nloc;
        if (old + 1u == (gen + 1u) * nloc) {
            __builtin_amdgcn_fence(__ATOMIC_RELEASE, "agent");
            asm volatile("s_waitcnt vmcnt(0)" ::: "memory");
            const unsigned og = xb_add(&bar[XB_TOP], 1u);
            const unsigned tg = og / nx;
            if (og + 1u == (tg + 1u) * nx) xb_add(&bar[XB_TOPGEN], 1u);
            else XB_SPIN(xb_ld(&bar[XB_TOPGEN]) == tg, bar);
            __builtin_amdgcn_fence(__ATOMIC_ACQUIRE, "agent");
            xb_add(&bar[XB_XGEN(b.x)], 1u);
            asm volatile("s_waitcnt vmcnt(0)" ::: "memory");
        } else {
            XB_SPIN(xb_ld(&bar[XB_XGEN(b.x)]) == gen, bar);
            __builtin_amdgcn_fence(__ATOMIC_ACQUIRE, "agent");
            asm volatile("s_waitcnt vmcnt(0)" ::: "memory");
        }
    }
    __syncthreads();
}
namespace fx {
#define DI __device__ __forceinline__
typedef unsigned short bf16;
typedef short bf16x8 __attribute__((ext_vector_type(8)));
typedef float f32x4 __attribute__((ext_vector_type(4)));
typedef float f32x2 __attribute__((ext_vector_type(2)));
typedef unsigned u32x4 __attribute__((ext_vector_type(4)));
typedef unsigned u32x2 __attribute__((ext_vector_type(2)));
constexpr int M0 = BATCH * SEQ, MP = M0 + DEC_BATCH, MPAD = ((MP + 255) / 256) * 256;
constexpr int ACOLS = DIL_COLS + MEM_COLS, BCOLS = NSA_Q_COLS + NSA_GATE_COLS + MEM_COLS, KVCOLS = 6 * NSA_KV_HEADS * HEAD_DIM;
constexpr int NB_T = 2048;
constexpr int NPK = PEER_HEADS * 2 * PEER_KEYS;
constexpr int NCMP = (SEQ - CMP_BLOCK) / CMP_STRIDE + 1;
constexpr int NCH = SEQ / CMP_STRIDE;
constexpr int NCTX = BATCH + DEC_BATCH;
constexpr int ACROWS = NCTX * NSA_KV_HEADS * NCH;
constexpr int NPOS = PAST_LEN + 1;
constexpr float QSCALE = 0.125f * 1.4426950408889634f;
constexpr int NTHREADS = 512, NWAVES = 8, LDS_BYTES = 147456, RING_BYTES = 131072, MISC_OFF = RING_BYTES + 320;

struct FP {
    const float *x_prompt, *x_sample, *mem_prompt, *cache_dil[3], *cache_nsa_kv, *cache_nsa_win, *cache_mem_kv; const int* page_table;
    const float *w_in_a, *w_out_a, *w_in_b, *w_out_b, *w_mem_kv, *w_kv_b, *cmp_pe, *cmp_w1, *cmp_w2, *ln_g, *ln_b, *peer_wq, *peer_keys, *peer_u, *peer_v;
    float *y_prompt, *y_sample, *dil_p[3], *dil_s[3], *nsa_kv_p, *nsa_kv_s, *win_p, *win_s, *mem_kv_p;
    unsigned* ctl;
    bf16 *XB0, *X1B, *X2B, *X3B, *WA_T, *WMEM_T, *MEMB, *WOA_T, *WOB_T, *WPK_T, *WB_T, *CW1_T, *AC; unsigned char *UB8, *VB8;
    float *ROPE, *CBIAS;
    bf16 *QA, *KA, *VTA, *MQA, *MK, *MVT, *ATTA;
    float *DPART, *DML, *PRE, *X1, *X2, *X3, *SCO, *SELG; int* SELE;
    bf16 *SLK, *SLVT, *WNK, *WNVT, *QB, *MQB, *CK, *CVT, *ATTB;
    float *GATES, *UL, *CKF, *CVF;
    int* SELB;
    float* DBG;
};
struct Args { FP p; int lo, hi; };
struct Carve { size_t off = 0; template <class T> T* take(void* base, size_t n) { T* r = (T*)((char*)base + off); off += ((n * sizeof(T) + 255) / 256) * 256; return r; } };
constexpr size_t CTL_BYTES = 65536;
inline size_t carve(FP& p, void* base) {
    Carve c;
    p.ctl = c.take<unsigned>(base, CTL_BYTES / 4);
    p.XB0 = c.take<bf16>(base, (size_t)MPAD * D_MODEL); p.X1B = c.take<bf16>(base, (size_t)MPAD * D_MODEL); p.X2B = c.take<bf16>(base, (size_t)MPAD * D_MODEL); p.X3B = c.take<bf16>(base, (size_t)MPAD * D_MODEL);
    p.WA_T = c.take<bf16>(base, (size_t)ACOLS * D_MODEL); p.WMEM_T = c.take<bf16>(base, (size_t)DEPTH * 2 * MEM_COLS * D_MODEL); p.MEMB = c.take<bf16>(base, (size_t)BATCH * MEM_TOKENS * D_MODEL);
    p.WOA_T = c.take<bf16>(base, (size_t)D_MODEL * 2 * MEM_COLS); p.WOB_T = c.take<bf16>(base, (size_t)D_MODEL * (NSA_Q_COLS + MEM_COLS));
    p.WPK_T = c.take<bf16>(base, (size_t)DEPTH * NPK * D_MODEL); p.WB_T = c.take<bf16>(base, (size_t)NB_T * D_MODEL);
    p.UB8 = c.take<unsigned char>(base, (size_t)DEPTH * PEER_EXPERTS * D_MODEL); p.VB8 = c.take<unsigned char>(base, (size_t)DEPTH * PEER_EXPERTS * D_MODEL);
    p.CW1_T = c.take<bf16>(base, (size_t)2 * 256 * 1024); p.AC = c.take<bf16>(base, (size_t)2 * ACROWS * 1024);
    p.ROPE = c.take<float>(base, (size_t)NPOS * 64); p.CBIAS = c.take<float>(base, 2 * CMP_HIDDEN);
    p.QA = c.take<bf16>(base, (size_t)3 * MPAD * 256); p.KA = c.take<bf16>(base, (size_t)3 * MPAD * 256); p.VTA = c.take<bf16>(base, (size_t)3 * BATCH * DIL_HEADS * HEAD_DIM * SEQ + 4096);
    p.MQA = c.take<bf16>(base, (size_t)MPAD * 256); p.MK = c.take<bf16>(base, (size_t)DEPTH * BATCH * MEM_TOKENS * MEM_COLS); p.MVT = c.take<bf16>(base, (size_t)DEPTH * BATCH * MEM_COLS * MEM_TOKENS);
    p.ATTA = c.take<bf16>(base, (size_t)MPAD * 2 * MEM_COLS);
    p.DPART = c.take<float>(base, (size_t)3 * MP * DIL_HEADS * HEAD_DIM); p.DML = c.take<float>(base, (size_t)3 * MP * DIL_HEADS * 2);
    p.PRE = c.take<float>(base, (size_t)MPAD * D_MODEL); p.X1 = c.take<float>(base, (size_t)MPAD * D_MODEL); p.X2 = c.take<float>(base, (size_t)MPAD * D_MODEL); p.X3 = c.take<float>(base, (size_t)MPAD * D_MODEL);
    p.SCO = c.take<float>(base, (size_t)MPAD * NPK); p.SELG = c.take<float>(base, (size_t)MP * 128); p.SELE = c.take<int>(base, (size_t)MP * 128);
    p.SLK = c.take<bf16>(base, (size_t)BATCH * NSA_KV_HEADS * SEQ * HEAD_DIM); p.SLVT = c.take<bf16>(base, (size_t)BATCH * NSA_KV_HEADS * SEQ * HEAD_DIM);
    p.WNK = c.take<bf16>(base, (size_t)BATCH * NSA_KV_HEADS * SEQ * HEAD_DIM + 4096); p.WNVT = c.take<bf16>(base, (size_t)BATCH * NSA_KV_HEADS * SEQ * HEAD_DIM + 4096);
    p.QB = c.take<bf16>(base, (size_t)MPAD * NSA_Q_COLS); p.MQB = c.take<bf16>(base, (size_t)MPAD * 256);
    p.CK = c.take<bf16>(base, (size_t)NCTX * NSA_KV_HEADS * NCH * HEAD_DIM); p.CVT = c.take<bf16>(base, (size_t)NCTX * NSA_KV_HEADS * HEAD_DIM * NCH); p.ATTB = c.take<bf16>(base, (size_t)MPAD * (NSA_Q_COLS + MEM_COLS));
    p.GATES = c.take<float>(base, (size_t)MPAD * 64); p.UL = c.take<float>(base, (size_t)2 * ACROWS * 256);
    p.CKF = c.take<float>(base, (size_t)DEC_BATCH * NSA_KV_HEADS * NCH * HEAD_DIM); p.CVF = c.take<float>(base, (size_t)DEC_BATCH * NSA_KV_HEADS * NCH * HEAD_DIM);
    p.SELB = c.take<int>(base, (size_t)MP * NSA_KV_HEADS * 16);
#ifdef NSA_DEBUG
    p.DBG = c.take<float>(base, (size_t)3 * MP * 768);
#else
    p.DBG = nullptr;
#endif
    return c.off;
}
inline void bind_io(FP& p, void* const* d_in, float* out) {
    p.x_prompt = (const float*)d_in[0]; p.x_sample = (const float*)d_in[1]; p.mem_prompt = (const float*)d_in[2]; p.cache_dil[0] = (const float*)d_in[3]; p.cache_dil[1] = (const float*)d_in[4]; p.cache_dil[2] = (const float*)d_in[5];
    p.cache_nsa_kv = (const float*)d_in[6]; p.cache_nsa_win = (const float*)d_in[7]; p.cache_mem_kv = (const float*)d_in[8]; p.page_table = (const int*)d_in[9];
    p.w_in_a = (const float*)d_in[10]; p.w_out_a = (const float*)d_in[11]; p.w_in_b = (const float*)d_in[12]; p.w_out_b = (const float*)d_in[13]; p.w_mem_kv = (const float*)d_in[14]; p.w_kv_b = (const float*)d_in[15];
    p.cmp_pe = (const float*)d_in[16]; p.cmp_w1 = (const float*)d_in[17]; p.cmp_w2 = (const float*)d_in[18]; p.ln_g = (const float*)d_in[19]; p.ln_b = (const float*)d_in[20];
    p.peer_wq = (const float*)d_in[21]; p.peer_keys = (const float*)d_in[22]; p.peer_u = (const float*)d_in[23]; p.peer_v = (const float*)d_in[24];
    size_t o = 0; auto take = [&](size_t n) { float* r = out + o; o += n; return r; };
    p.y_prompt = take((size_t)M0 * D_MODEL); p.y_sample = take((size_t)DEC_BATCH * D_MODEL);
    for (int g = 0; g < 3; ++g) p.dil_p[g] = take((size_t)BATCH * DIL_W[g] * 2 * DIL_HEADS * HEAD_DIM);
    for (int g = 0; g < 3; ++g) p.dil_s[g] = take((size_t)DEC_BATCH * DIL_W[g] * 2 * DIL_HEADS * HEAD_DIM);
    p.nsa_kv_p = take((size_t)M0 * 4 * NSA_KV_HEADS * HEAD_DIM); p.nsa_kv_s = take((size_t)DEC_BATCH * 4 * NSA_KV_HEADS * HEAD_DIM);
    p.win_p = take((size_t)BATCH * SWA_WINDOW * 2 * NSA_KV_HEADS * HEAD_DIM); p.win_s = take((size_t)DEC_BATCH * SWA_WINDOW * 2 * NSA_KV_HEADS * HEAD_DIM);
    p.mem_kv_p = take((size_t)DEPTH * BATCH * MEM_TOKENS * 2 * MEM_COLS);
}
DI unsigned f2bf(float f) { unsigned u = __builtin_bit_cast(unsigned, f); return (u + 0x7fffu + ((u >> 16) & 1u)) >> 16; }
DI unsigned pk2(float lo, float hi) { return f2bf(lo) | (f2bf(hi) << 16); }
DI float bf2f(unsigned short b) { return __builtin_bit_cast(float, (unsigned)b << 16); }
DI float bflo(unsigned w) { return __builtin_bit_cast(float, w << 16); }
DI float bfhi(unsigned w) { return __builtin_bit_cast(float, w & 0xffff0000u); }
DI float wave_sum(float v) {
#pragma unroll
    for (int o = 1; o < 64; o <<= 1) v += __shfl_xor(v, o);
    return v; }
DI float wave_max(float v) {
#pragma unroll
    for (int o = 1; o < 64; o <<= 1) v = fmaxf(v, __shfl_xor(v, o));
    return v; }
DI float gelu_tanh(float x) { const float u = 0.7978845608028654f * (x + 0.044715f * x * x * x); const float e = __builtin_amdgcn_exp2f(u * 2.885390081777927f);   const float t = 1.0f - 2.0f / (e + 1.0f); return 0.5f * x * (1.0f + t); }
DI float* sel3(float* const (&a)[3], int g) { return g == 0 ? a[0] : (g == 1 ? a[1] : a[2]); }
DI const float* sel3c(const float* const (&a)[3], int g) { return g == 0 ? a[0] : (g == 1 ? a[1] : a[2]); }
struct Ctx { LAS unsigned char* lds; int tid, lane, wave, vcu, G; };
DI int row_pos(int r) { return r < M0 ? (r & (SEQ - 1)) : PAST_LEN; }

struct ColSrc { const float* p; int ld; };
DI int rope_il(int e) { return (e >> 1) + 32 * (e & 1); }
DI ColSrc col_wa(const FP& P, int n) {
    const int t = n >> 8, ct = n & 255, h = ct >> 6, e = ct & 63; if (t >= 9) return ColSrc{P.w_in_a + DIL_COLS + ct, ACOLS};
    const int j = t % 3, d = (j < 2) ? rope_il(e) : e; return ColSrc{P.w_in_a + t * 256 + h * 64 + d, ACOLS}; }
DI ColSrc col_wb(const FP& P, int n) {
    const int t = n >> 8, ct = n & 255, e = ct & 63;
    if (t < 3) { const int ty = 2 * t + (ct >> 7), kvh = (ct >> 6) & 1; const bool rot = (ty == 2 || ty == 4); return ColSrc{P.w_kv_b + (ty * NSA_KV_HEADS + kvh) * 64 + (rot ? rope_il(e) : e), KVCOLS}; }
    if (t < 6) { const int h = (t - 3) * 4 + (ct >> 6); return ColSrc{P.w_in_b + h * 64 + rope_il(e), BCOLS}; }
    if (t == 6) return ColSrc{P.w_in_b + NSA_Q_COLS + NSA_GATE_COLS + ct, BCOLS};
    if (ct < NSA_GATE_COLS) return ColSrc{P.w_in_b + NSA_Q_COLS + ct, BCOLS};
    return ColSrc{nullptr, 0}; }
DI ColSrc col_wmem(const FP& P, int n) { const int l = n >> 9, c = n & 511; return ColSrc{P.w_mem_kv + (size_t)l * D_MODEL * 512 + c, 512}; }
DI ColSrc col_woa(const FP& P, int n) { return ColSrc{P.w_out_a + n, D_MODEL}; }
DI ColSrc col_wob(const FP& P, int n) { return ColSrc{P.w_out_b + n, D_MODEL}; }
DI ColSrc col_cw1(const FP& P, int n) {
    const int ty = n >> 8, half = (n >> 7) & 1, hid = n & 127; return ColSrc{P.cmp_w1 + (size_t)ty * CMP_BLOCK * HEAD_DIM * CMP_HIDDEN + (size_t)half * 16 * HEAD_DIM * CMP_HIDDEN + hid, CMP_HIDDEN}; }
template <class CF> DI void transpose_item(const FP& P, CF cf, int K, bf16* WT, LAS float* scr, int item, int nblk, int lane) {
    const int kb = item / nblk, nb = item % nblk, k0 = 64 * kb, n0 = 32 * nb;
    const ColSrc cs = cf(P, n0 + (lane & 31));
#pragma unroll 8
    for (int i = 0; i < 32; ++i) { const int kk = 2 * i + (lane >> 5); scr[kk * 33 + (lane & 31)] = cs.p ? cs.p[(size_t)(k0 + kk) * cs.ld] : 0.f; }
    asm volatile("s_waitcnt lgkmcnt(0)" ::: "memory");
    const int c = lane & 7;
#pragma unroll
    for (int j = 0; j < 4; ++j) { const int n = (lane >> 3) + 8 * j; const LAS float* s = scr + (8 * c) * 33 + n;
        u32x4 o; o.x = pk2(s[0 * 33], s[1 * 33]); o.y = pk2(s[2 * 33], s[3 * 33]); o.z = pk2(s[4 * 33], s[5 * 33]); o.w = pk2(s[6 * 33], s[7 * 33]);
        *(u32x4*)(WT + (size_t)(n0 + n) * K + k0 + 8 * c) = o; }
    asm volatile("s_waitcnt lgkmcnt(0)" ::: "memory");
}
DI void cvt_row1024(const float* src, bf16* dst, int lane) {
#pragma unroll
    for (int j = 0; j < 4; ++j) { f32x4 v = src ? *(const f32x4*)(src + 256 * j + 4 * lane) : (f32x4){0.f, 0.f, 0.f, 0.f}; u32x2 o; o.x = pk2(v.x, v.y); o.y = pk2(v.z, v.w); *(u32x2*)(dst + 256 * j + 4 * lane) = o; }
}
DI void cvt_row1024_fp8(const float* src, unsigned char* dst, float sc, int lane) { u32x4 o; unsigned w[4];
#pragma unroll
    for (int j = 0; j < 4; ++j) { const f32x4 v = *(const f32x4*)(src + 16 * lane + 4 * j) * sc; int t = __builtin_amdgcn_cvt_pk_fp8_f32(v.x, v.y, 0, false); t = __builtin_amdgcn_cvt_pk_fp8_f32(v.z, v.w, t, true); w[j] = (unsigned)t; }
    o.x = w[0]; o.y = w[1]; o.z = w[2]; o.w = w[3]; *(u32x4*)(dst + 16 * lane) = o; }
DI void p0_prologue(const FP& P, const Ctx& C) {
    LAS float* scr = (LAS float*)(C.lds + C.wave * 16384);
    const int gw = C.vcu * NWAVES + C.wave, NGW = C.G * NWAVES, lane = C.lane;
    { constexpr int IA = (D_MODEL / 64) * (ACOLS / 32), IM = (D_MODEL / 64) * (1024 / 32), IOA = (512 / 64) * (D_MODEL / 32), IOB = (1024 / 64) * (D_MODEL / 32), IB = (D_MODEL / 64) * (NB_T / 32), IC = (1024 / 64) * (512 / 32);
      constexpr int NIT = IA + IM + IOA + IOB + IB + IC;
      for (int it = gw; it < NIT; it += NGW) { int r = it;
          if (r < IA) { transpose_item(P, col_wa, D_MODEL, P.WA_T, scr, r, ACOLS / 32, lane); continue; } r -= IA;
          if (r < IM) { transpose_item(P, col_wmem, D_MODEL, P.WMEM_T, scr, r, 1024 / 32, lane); continue; } r -= IM;
          if (r < IOA) { transpose_item(P, col_woa, 512, P.WOA_T, scr, r, D_MODEL / 32, lane); continue; } r -= IOA;
          if (r < IOB) { transpose_item(P, col_wob, 1024, P.WOB_T, scr, r, D_MODEL / 32, lane); continue; } r -= IOB;
          if (r < IB) { transpose_item(P, col_wb, D_MODEL, P.WB_T, scr, r, NB_T / 32, lane); continue; } r -= IB;
          transpose_item(P, col_cw1, 1024, P.CW1_T, scr, r, 512 / 32, lane); } }
    for (int r = gw; r < MPAD; r += NGW) { cvt_row1024(r < M0 ? P.x_prompt + (size_t)r * D_MODEL : (r < MP ? P.x_sample + (size_t)(r - M0) * D_MODEL : nullptr), P.XB0 + (size_t)r * D_MODEL, lane);
        if (r >= MP) { cvt_row1024(nullptr, P.X1B + (size_t)r * D_MODEL, lane); cvt_row1024(nullptr, P.X2B + (size_t)r * D_MODEL, lane); cvt_row1024(nullptr, P.X3B + (size_t)r * D_MODEL, lane);
            for (int c = lane; c < 512; c += 64) { P.ATTA[(size_t)r * 512 + c] = 0; P.ATTB[(size_t)r * 1024 + c] = 0; P.ATTB[(size_t)r * 1024 + 512 + c] = 0; } } }
    for (int r = gw; r < BATCH * MEM_TOKENS; r += NGW) cvt_row1024(P.mem_prompt + (size_t)r * D_MODEL, P.MEMB + (size_t)r * D_MODEL, lane);
    for (int r = gw; r < DEPTH * PEER_EXPERTS; r += NGW) { cvt_row1024_fp8(P.peer_u + (size_t)r * D_MODEL, P.UB8 + (size_t)r * D_MODEL, 256.f, lane); cvt_row1024_fp8(P.peer_v + (size_t)r * D_MODEL, P.VB8 + (size_t)r * D_MODEL, 64.f, lane); }
    for (int i = gw * 64 + lane; i < NPOS * 32; i += NGW * 64) { const int pos = i >> 5, d = i & 31; const double inv = exp2(-(double)d * (13.287712379549449 / 32.0)); const double turns = (double)pos * inv * 0.15915494309189535;
        const float fr = (float)(turns - floor(turns)); P.ROPE[pos * 64 + d] = __builtin_amdgcn_cosf(fr); P.ROPE[pos * 64 + 32 + d] = __builtin_amdgcn_sinf(fr); }
    for (int i = gw * 64 + lane; i < 2 * CMP_HIDDEN; i += NGW * 64) { const int ty = i / CMP_HIDDEN, hid = i % CMP_HIDDEN; float a = 0.f; for (int k = 0; k < CMP_BLOCK * HEAD_DIM; ++k) a += P.cmp_pe[ty * CMP_BLOCK * HEAD_DIM + k] * P.cmp_w1[((size_t)ty * CMP_BLOCK * HEAD_DIM + k) * CMP_HIDDEN + hid]; P.CBIAS[i] = a; }
    for (int it = gw; it < DEC_BATCH * PAST_LEN; it += NGW) { const int n = it / PAST_LEN, t = it % PAST_LEN; const int pg = P.page_table[n * (PAST_LEN / PAGE_SIZE) + t / PAGE_SIZE];
        const f32x4 v = *(const f32x4*)(P.cache_nsa_kv + ((size_t)pg * PAGE_SIZE + t % PAGE_SIZE) * 512 + 4 * lane); const int ty = lane >> 5, kvh = (lane >> 4) & 1, d = (4 * lane) & 63;
        u32x2 o; o.x = pk2(v.x, v.y); o.y = pk2(v.z, v.w); *(u32x2*)(P.AC + ((size_t)ty * ACROWS + ((size_t)(BATCH + n) * NSA_KV_HEADS + kvh) * NCH + t / 16) * 1024 + (t % 16) * 64 + d) = o; }
    for (int g = 0; g < 3; ++g) { const int W = dil_w(g); const long nvec = (long)DEC_BATCH * (W - 1) * 128;
        for (long i = (long)gw * 64 + lane; i < nvec; i += (long)NGW * 64) { const long rr = i / 128; const int c4 = (int)(i % 128); const int n = (int)(rr / (W - 1)), w = (int)(rr % (W - 1));
            ((f32x4*)sel3(P.dil_s, g))[((size_t)n * W + w) * 128 + c4] = ((const f32x4*)sel3c(P.cache_dil, g))[((size_t)n * W + w + 1) * 128 + c4]; } }
    { const int W = SWA_WINDOW; const long nvec = (long)DEC_BATCH * (W - 1) * 64;
      for (long i = (long)gw * 64 + lane; i < nvec; i += (long)NGW * 64) { const long rr = i / 64; const int c4 = (int)(i % 64); const int n = (int)(rr / (W - 1)), w = (int)(rr % (W - 1));
          ((f32x4*)P.win_s)[((size_t)n * W + w) * 64 + c4] = ((const f32x4*)P.cache_nsa_win)[((size_t)n * W + w + 1) * 64 + c4]; } }
}
DI void p0_wpk(const FP& P, const Ctx& C) {
    LAS float* sw = (LAS float*)C.lds;
    LAS float* sk = (LAS float*)(C.lds + 32768);
    constexpr int NIT = DEPTH * 16 * (D_MODEL / 64);
    for (int it = C.vcu; it < NIT; it += C.G) { const int l = it / (16 * (D_MODEL / 64)), rem = it % (16 * (D_MODEL / 64)), hc = rem / (D_MODEL / 64), kb = rem % (D_MODEL / 64);
        __syncthreads();
        for (int i = C.tid; i < 64 * 64; i += NTHREADS) { const int r = i >> 6, d = i & 63; sw[r * 65 + d] = P.peer_wq[((size_t)l * D_MODEL + kb * 64 + r) * 1024 + hc * 64 + d]; }
        for (int i = C.tid; i < 128 * 64; i += NTHREADS) { const int r = i >> 6, d = i & 63; sk[r * 65 + d] = P.peer_keys[(((size_t)l * 16 + hc) * PEER_KEYS + r) * 64 + d]; }
        __syncthreads();
        for (int o = C.tid; o < 128 * 64; o += NTHREADS) { const int kk = o >> 6, ki = o & 63; float a = 0.f;
#pragma unroll 16
            for (int d = 0; d < 64; ++d) a += sw[ki * 65 + d] * sk[kk * 65 + d];
            P.WPK_T[((size_t)l * NPK + hc * 128 + kk) * D_MODEL + kb * 64 + ki] = (bf16)f2bf(a); } }
    __syncthreads();
}

#define EPI_LOOP(...) int fr_l = fr, fq_l = fq; asm volatile("" : "+v"(fr_l), "+v"(fq_l));     \
    _Pragma("unroll") for (int ai = 0; ai < 2; ++ai) _Pragma("unroll") for (int m = 0; m < 4; ++m) { const int row = u.pm * 256 + ai * 128 + wr * 64 + m * 16 + fr_l; \
    _Pragma("unroll") for (int bj = 0; bj < 2; ++bj) { const int ct = bj * 128 + wc * 32 + fq_l * 8; const f32x4 v0 = acc[ai][bj][m][0], v1 = acc[ai][bj][m][1]; __VA_ARGS__ } asm volatile("" ::: "memory"); }
DI void rope4(const float* rope_row, int dp, const f32x4& v0, const f32x4& v1, f32x4& lo, f32x4& hi) {
    const f32x4 c = *(const f32x4*)(rope_row + dp), s = *(const f32x4*)(rope_row + 32 + dp);
    lo.x = v0.x * c.x - v0.y * s.x; hi.x = v0.y * c.x + v0.x * s.x; lo.y = v0.z * c.y - v0.w * s.y; hi.y = v0.w * c.y + v0.z * s.y;
    lo.z = v1.x * c.z - v1.y * s.z; hi.z = v1.y * c.z + v1.x * s.z; lo.w = v1.z * c.w - v1.w * s.w; hi.w = v1.w * c.w + v1.z * s.w; }
DI u32x2 pk4(const f32x4& v) { u32x2 o; o.x = pk2(v.x, v.y); o.y = pk2(v.z, v.w); return o; }
DI u32x4 pk8(const f32x4& a, const f32x4& b) { u32x4 o; o.x = pk2(a.x, a.y); o.y = pk2(a.z, a.w); o.z = pk2(b.x, b.y); o.w = pk2(b.z, b.w); return o; }
DI int dil_perm(int t, int d) { return (t % d) * (SEQ / d) + t / d; }
struct EpiA {
    static constexpr bool PERM = true, AFTER_DRAIN = false; const FP& P;
    DI void operator()(const f32x4 (&acc)[2][2][4][2], const pg8::Unit& u, int wr, int wc, int fr, int fq) const {
        const int t9 = u.pn; const int g = t9 / 3, j = t9 % 3;
        EPI_LOOP({ if (row < MP) { const int h = ct >> 6, e = ct & 63; const int pos = row_pos(row);
            if (t9 == 9) { *(u32x4*)(P.MQA + (size_t)row * 256 + ct) = pk8(v0 * QSCALE, v1 * QSCALE); }
            else if (j < 2) { f32x4 lo, hi; const int dp = e >> 1; rope4(P.ROPE + pos * 64, dp, v0, v1, lo, hi);
                if (j == 0) { bf16* q = P.QA + ((size_t)g * MPAD + row) * 256 + h * 64 + dp; *(u32x2*)q = pk4(lo * QSCALE); *(u32x2*)(q + 32) = pk4(hi * QSCALE); }
                else { bf16* k = P.KA + ((size_t)g * MPAD + row) * 256 + h * 64 + dp; *(u32x2*)k = pk4(lo); *(u32x2*)(k + 32) = pk4(hi);
                    const int W = dil_w(g); float* o = nullptr;
                    if (row >= M0) o = sel3(P.dil_s, g) + (((size_t)(row - M0) * W + W - 1) * 2 + 0) * 256; else if (pos >= SEQ - W) o = sel3(P.dil_p, g) + (((size_t)(row / SEQ) * W + pos - (SEQ - W)) * 2 + 0) * 256;
                    if (o) { *(f32x4*)(o + h * 64 + dp) = lo; *(f32x4*)(o + h * 64 + 32 + dp) = hi; } } }
            else { const int W = dil_w(g), d = dil_d(g); float* o = nullptr;
                if (row >= M0) o = sel3(P.dil_s, g) + (((size_t)(row - M0) * W + W - 1) * 2 + 1) * 256; else if (pos >= SEQ - W) o = sel3(P.dil_p, g) + (((size_t)(row / SEQ) * W + pos - (SEQ - W)) * 2 + 1) * 256;
                if (o) { *(f32x4*)(o + ct) = v0; *(f32x4*)(o + ct + 4) = v1; }
                if (row < M0) { bf16* vt = P.VTA + (((size_t)(g * BATCH + row / SEQ) * DIL_HEADS + h) * 64 + e) * SEQ + dil_perm(pos, d);
                    vt[0 * SEQ] = (bf16)f2bf(v0.x); vt[1 * SEQ] = (bf16)f2bf(v0.y); vt[2 * SEQ] = (bf16)f2bf(v0.z); vt[3 * SEQ] = (bf16)f2bf(v0.w);
                    vt[4 * SEQ] = (bf16)f2bf(v1.x); vt[5 * SEQ] = (bf16)f2bf(v1.y); vt[6 * SEQ] = (bf16)f2bf(v1.z); vt[7 * SEQ] = (bf16)f2bf(v1.w); } } } })
    }
};
struct EpiMem {
    static constexpr bool PERM = true, AFTER_DRAIN = false; const FP& P;
    DI void operator()(const f32x4 (&acc)[2][2][4][2], const pg8::Unit& u, int wr, int wc, int fr, int fq) const {
        const int l = u.pn >> 1, half = u.pn & 1;
        EPI_LOOP({ const int n = row / MEM_TOKENS, mt = row % MEM_TOKENS; float* o = P.mem_kv_p + (((size_t)l * BATCH + n) * MEM_TOKENS + mt) * 512 + half * 256 + ct; *(f32x4*)o = v0; *(f32x4*)(o + 4) = v1;
            if (half == 0) *(u32x4*)(P.MK + (((size_t)l * BATCH + n) * MEM_TOKENS + mt) * 256 + ct) = pk8(v0, v1);
            else { bf16* vt = P.MVT + (((size_t)l * BATCH + n) * 256 + ct) * MEM_TOKENS + mt;
                vt[0 * MEM_TOKENS] = (bf16)f2bf(v0.x); vt[1 * MEM_TOKENS] = (bf16)f2bf(v0.y); vt[2 * MEM_TOKENS] = (bf16)f2bf(v0.z); vt[3 * MEM_TOKENS] = (bf16)f2bf(v0.w);
                vt[4 * MEM_TOKENS] = (bf16)f2bf(v1.x); vt[5 * MEM_TOKENS] = (bf16)f2bf(v1.y); vt[6 * MEM_TOKENS] = (bf16)f2bf(v1.z); vt[7 * MEM_TOKENS] = (bf16)f2bf(v1.w); } })
    }
};
struct EpiPre {
    static constexpr bool PERM = true, AFTER_DRAIN = false; const float* xa; const float* xb; float* pre;
    DI void operator()(const f32x4 (&acc)[2][2][4][2], const pg8::Unit& u, int wr, int wc, int fr, int fq) const {
        EPI_LOOP({ if (row < MP) { const int col = u.pn * 256 + ct; const float* x = (xb && row >= M0) ? xb + (size_t)(row - M0) * D_MODEL + col : xa + (size_t)row * D_MODEL + col;
            const f32x4 a = *(const f32x4*)x, b = *(const f32x4*)(x + 4); float* o = pre + (size_t)row * D_MODEL + col; *(f32x4*)o = a * ALPHA + v0; *(f32x4*)(o + 4) = b * ALPHA + v1; } })
    }
};
struct EpiF32 {
    static constexpr bool PERM = true, AFTER_DRAIN = false; float* out; int ldc; int nrows;
    DI void operator()(const f32x4 (&acc)[2][2][4][2], const pg8::Unit& u, int wr, int wc, int fr, int fq) const {
        EPI_LOOP({ if (row < nrows) { float* o = out + (size_t)row * ldc + u.pn * 256 + ct; *(f32x4*)o = v0; *(f32x4*)(o + 4) = v1; } })
    }
};
}
namespace fx {
struct Tile16 { f32x4 o[4]; float m, l; };
DI void tile_init(Tile16& T) { T.o[0] = T.o[1] = T.o[2] = T.o[3] = (f32x4){0.f, 0.f, 0.f, 0.f}; T.m = -INFINITY; T.l = 0.f; }
typedef __bf16 bf16x2_t __attribute__((ext_vector_type(2)));
DI unsigned cvtpk(float lo, float hi) { const f32x2 v = {lo, hi}; const bf16x2_t b = __builtin_convertvector(v, bf16x2_t); return __builtin_bit_cast(unsigned, b); }
struct KV8 { bf16x8 ka0, ka1, kb0, kb1, v0, v1, v2, v3; };
DI void kv_load(KV8& r, const bf16* k0, const bf16* k1, const bf16* v, long vs16) {
    r.ka0 = *(const bf16x8*)k0; r.ka1 = *(const bf16x8*)(k0 + 32); r.kb0 = *(const bf16x8*)k1; r.kb1 = *(const bf16x8*)(k1 + 32);
    r.v0 = *(const bf16x8*)v; r.v1 = *(const bf16x8*)(v + vs16); r.v2 = *(const bf16x8*)(v + 2 * vs16); r.v3 = *(const bf16x8*)(v + 3 * vs16); }
template <class MaskF> DI void tile_compute(Tile16& T, const bf16x8 (&qf)[2], const KV8& r, MaskF mask) {
    f32x4 s0 = (f32x4){0.f, 0.f, 0.f, 0.f}, s1 = (f32x4){0.f, 0.f, 0.f, 0.f};
    s0 = __builtin_amdgcn_mfma_f32_16x16x32_bf16(r.ka0, qf[0], s0, 0, 0, 0); s0 = __builtin_amdgcn_mfma_f32_16x16x32_bf16(r.ka1, qf[1], s0, 0, 0, 0);
    s1 = __builtin_amdgcn_mfma_f32_16x16x32_bf16(r.kb0, qf[0], s1, 0, 0, 0); s1 = __builtin_amdgcn_mfma_f32_16x16x32_bf16(r.kb1, qf[1], s1, 0, 0, 0);
    float s[8] = {s0.x, s0.y, s0.z, s0.w, s1.x, s1.y, s1.z, s1.w};
    float mx = -INFINITY;
#pragma unroll
    for (int e = 0; e < 8; ++e) { s[e] = mask(e) ? s[e] : -INFINITY; mx = fmaxf(mx, s[e]); }
    mx = fmaxf(mx, __shfl_xor(mx, 16)); mx = fmaxf(mx, __shfl_xor(mx, 32));
    const float mnew = fmaxf(T.m, mx), muse = (mnew == -INFINITY) ? 0.f : mnew;
    const float alpha = __builtin_amdgcn_exp2f(T.m - muse);
    float ls = 0.f;
#pragma unroll
    for (int e = 0; e < 8; ++e) { s[e] = __builtin_amdgcn_exp2f(s[e] - muse); ls += s[e]; }
    ls += __shfl_xor(ls, 16); ls += __shfl_xor(ls, 32);
    T.l = T.l * alpha + ls; T.m = mnew;
    u32x4 pw; pw.x = cvtpk(s[0], s[1]); pw.y = cvtpk(s[2], s[3]); pw.z = cvtpk(s[4], s[5]); pw.w = cvtpk(s[6], s[7]);
    const bf16x8 pf = __builtin_bit_cast(bf16x8, pw);
    T.o[0] = __builtin_amdgcn_mfma_f32_16x16x32_bf16(r.v0, pf, T.o[0] * alpha, 0, 0, 0); T.o[1] = __builtin_amdgcn_mfma_f32_16x16x32_bf16(r.v1, pf, T.o[1] * alpha, 0, 0, 0);
    T.o[2] = __builtin_amdgcn_mfma_f32_16x16x32_bf16(r.v2, pf, T.o[2] * alpha, 0, 0, 0); T.o[3] = __builtin_amdgcn_mfma_f32_16x16x32_bf16(r.v3, pf, T.o[3] * alpha, 0, 0, 0);
}
DI int krow_of(int i, int b) { return 8 * (i >> 2) + 4 * b + (i & 3); }

DI void dil_micro(const FP& P, int n, int h, int t0, int mt, int lane) {
    const int g = mt >> 4, idx = mt & 15, d = dil_d(g), per = 16 / d;
    const int r = idx / per, sub = idx % per, i0 = t0 / d + 16 * sub, ib = i0 - 128, NC = SEQ / d;
    const int q = lane & 15, c = lane >> 4;
    const bf16* Qb = P.QA + ((size_t)g * MPAD + (size_t)n * SEQ) * 256 + h * 64; const bf16* Kb = P.KA + ((size_t)g * MPAD + (size_t)n * SEQ) * 256 + h * 64;
    const bf16* Vb = P.VTA + ((size_t)(g * BATCH + n) * DIL_HEADS + h) * 64 * SEQ + (size_t)r * NC;
    bf16x8 qf[2]; { const bf16* qp = Qb + (size_t)(r + d * (i0 + q)) * 256 + 8 * c; qf[0] = *(const bf16x8*)qp; qf[1] = *(const bf16x8*)(qp + 32); }
    Tile16 T; tile_init(T);
    const int qi = i0 + q;
    auto ld = [&](KV8& kv, int blk) { const int kb = ib + 32 * blk; int ka = kb + krow_of(q, 0), kc = kb + krow_of(q, 1); ka = ka < 0 ? 0 : (ka >= NC ? NC - 1 : ka); kc = kc < 0 ? 0 : (kc >= NC ? NC - 1 : kc);
        kv_load(kv, Kb + (size_t)(r + d * ka) * 256 + 8 * c, Kb + (size_t)(r + d * kc) * 256 + 8 * c, Vb + (size_t)q * SEQ + kb + 8 * c, 16L * SEQ); };
    KV8 cur; ld(cur, 0);
#pragma unroll 1
    for (int blk = 0; blk < 5; ++blk) { KV8 nxt; ld(nxt, blk < 4 ? blk + 1 : blk); const int kb = ib + 32 * blk;
        tile_compute(T, qf, cur, [&](int e) { const int ki = kb + 8 * c + e; return ki >= 0 && ki <= qi && qi - ki <= DIL_TAPS - 1; });
        cur = nxt; }
    const int row = n * SEQ + r + d * qi;
    float* op = P.DPART + (((size_t)g * MP + row) * DIL_HEADS + h) * 64 + 4 * c;
#pragma unroll
    for (int db = 0; db < 4; ++db) *(f32x4*)(op + 16 * db) = T.o[db];
    if (c == 0) { float* ml = P.DML + (((size_t)g * MP + row) * DIL_HEADS + h) * 2; ml[0] = T.m; ml[1] = T.l; }
}
DI void mem_micro(const FP& P, const bf16* Q  , int ldq, int row0, int layer, int n, int h, bf16* O  , int ldo, int lane) {
    const int q = lane & 15, c = lane >> 4;
    bf16x8 qf[2]; { const bf16* qp = Q + (size_t)(row0 + q) * ldq + 8 * c; qf[0] = *(const bf16x8*)qp; qf[1] = *(const bf16x8*)(qp + 32); }
    const bf16* Kb = P.MK + ((size_t)layer * BATCH + n) * MEM_TOKENS * 256 + h * 64; const bf16* Vb = P.MVT + (((size_t)layer * BATCH + n) * 256 + h * 64) * MEM_TOKENS;
    Tile16 T; tile_init(T);
    auto ld = [&](KV8& kv, int blk) { const int kb = 32 * blk; kv_load(kv, Kb + (size_t)(kb + krow_of(q, 0)) * 256 + 8 * c, Kb + (size_t)(kb + krow_of(q, 1)) * 256 + 8 * c, Vb + (size_t)q * MEM_TOKENS + kb + 8 * c, 16L * MEM_TOKENS); };
    KV8 cur; ld(cur, 0);
#pragma unroll 1
    for (int blk = 0; blk < MEM_TOKENS / 32; ++blk) { KV8 nxt; ld(nxt, (blk + 1 < MEM_TOKENS / 32) ? blk + 1 : blk); tile_compute(T, qf, cur, [&](int) { return true; }); cur = nxt; }
    const float inv = 1.0f / T.l; bf16* op = O + (size_t)(row0 + q) * ldo + 4 * c;
#pragma unroll
    for (int db = 0; db < 4; ++db) *(u32x2*)(op + 16 * db) = pk4(T.o[db] * inv);
}
struct Dec { float m, l, o; };
template <class KF, class VF> DI void dec_chunk(Dec& D, const LAS float* q, int nk, KF kf, VF vf, int lane) {
    float s = -INFINITY;
    if (lane < nk) { const float* k = kf(lane); float a = 0.f;
#pragma unroll
        for (int d4 = 0; d4 < 16; ++d4) { const f32x4 kv = *(const f32x4*)(k + 4 * d4); a += kv.x * q[4 * d4] + kv.y * q[4 * d4 + 1] + kv.z * q[4 * d4 + 2] + kv.w * q[4 * d4 + 3]; }
        s = a; }
    const float mx = wave_max(s), mnew = fmaxf(D.m, mx), alpha = __builtin_amdgcn_exp2f(D.m - mnew);
    const float p = (lane < nk) ? __builtin_amdgcn_exp2f(s - mnew) : 0.f;
    D.l = D.l * alpha + wave_sum(p); D.m = mnew; float o = D.o * alpha;
    for (int j0 = 0; j0 < nk; j0 += 8) { float vv[8];
#pragma unroll
        for (int u = 0; u < 8; ++u) { const int jj = (j0 + u < nk) ? j0 + u : nk - 1; vv[u] = vf(jj)[lane]; }
#pragma unroll
        for (int u = 0; u < 8; ++u) { const float pj = (j0 + u < nk) ? __builtin_bit_cast(float, __builtin_amdgcn_readlane(__builtin_bit_cast(int, p), (j0 + u) & 63)) : 0.f; o += pj * vv[u]; } }
    D.o = o;
}
DI void atta_phase(const FP& P, const Ctx& C) {
    const int lane = C.lane, w = C.wave;
    constexpr int NT = SEQ / 256, NIT = BATCH * NT * DIL_HEADS;
    for (int it = C.vcu; it < NIT; it += C.G) { const int h = it % DIL_HEADS, tt = (it / DIL_HEADS) % NT, n = it / (DIL_HEADS * NT), t0 = tt * 256;
        for (int mt = w; mt < 48; mt += NWAVES) dil_micro(P, n, h, t0, mt, lane);
        asm volatile("s_waitcnt vmcnt(0)" ::: "memory"); __syncthreads();
        for (int i = C.tid; i < 256 * 16; i += NTHREADS) { const int tk = i >> 4, d4 = (i & 15) * 4; const int row = n * SEQ + t0 + tk;
            float mg[3], lg[3]; float M = -INFINITY;
#pragma unroll
            for (int g = 0; g < 3; ++g) { const float* ml = P.DML + (((size_t)g * MP + row) * DIL_HEADS + h) * 2; mg[g] = ml[0]; lg[g] = ml[1]; M = fmaxf(M, mg[g]); }
            f32x4 acc = (f32x4){0.f, 0.f, 0.f, 0.f}; float L = 0.f;
#pragma unroll
            for (int g = 0; g < 3; ++g) { const float wg = __builtin_amdgcn_exp2f(mg[g] - M); L += wg * lg[g]; acc += *(const f32x4*)(P.DPART + (((size_t)g * MP + row) * DIL_HEADS + h) * 64 + d4) * wg; }
            *(u32x2*)(P.ATTA + (size_t)row * 512 + h * 64 + d4) = pk4(acc * (1.0f / L)); }
        for (int mt = w; mt < 16; mt += NWAVES) mem_micro(P, P.MQA + h * 64, 256, n * SEQ + t0 + 16 * mt, 0, n, h, P.ATTA + 256 + h * 64, 512, lane);
        __syncthreads();
    }
    LAS float* qs = (LAS float*)(C.lds + w * 1024);
    const int gw = C.vcu * NWAVES + w, NGW = C.G * NWAVES;
    for (int it = gw; it < DEC_BATCH * DIL_HEADS * 2; it += NGW) { const int kind = it & 1, h = (it >> 1) % DIL_HEADS, ns = (it >> 1) / DIL_HEADS, row = M0 + ns;
        Dec D; D.m = -INFINITY; D.l = 0.f; D.o = 0.f;
        if (kind == 0) {
            for (int g = 0; g < 3; ++g) qs[g * 64 + lane] = bf2f(P.QA[((size_t)g * MPAD + row) * 256 + h * 64 + lane]);
            asm volatile("s_waitcnt lgkmcnt(0)" ::: "memory");
            for (int g = 0; g < 3; ++g) { const int W = dil_w(g), d = dil_d(g); const float* cache = sel3c(P.cache_dil, g) + (size_t)ns * W * 512; const float* newrow = sel3(P.dil_s, g) + ((size_t)ns * W + W - 1) * 512;
                for (int j0 = 0; j0 < DIL_TAPS; j0 += 64) { const int nk = (DIL_TAPS - j0) < 64 ? (DIL_TAPS - j0) : 64;
                    dec_chunk(D, qs + g * 64, nk, [&](int j) { const int tap = j0 + j; return (tap == 0 ? newrow : cache + (size_t)(W - d * tap) * 512) + h * 64; },
                              [&](int j) { const int tap = j0 + j; return (tap == 0 ? newrow : cache + (size_t)(W - d * tap) * 512) + 256 + h * 64; }, lane); } }
            P.ATTA[(size_t)row * 512 + h * 64 + lane] = (bf16)f2bf(D.o / D.l);
        } else {
            qs[lane] = bf2f(P.MQA[(size_t)row * 256 + h * 64 + lane]);
            asm volatile("s_waitcnt lgkmcnt(0)" ::: "memory");
            const float* mk = P.cache_mem_kv + ((size_t)0 * DEC_BATCH + ns) * MEM_TOKENS * 512;
            for (int j0 = 0; j0 < MEM_TOKENS; j0 += 64) dec_chunk(D, qs, 64, [&](int j) { return mk + (size_t)(j0 + j) * 512 + h * 64; }, [&](int j) { return mk + (size_t)(j0 + j) * 512 + 256 + h * 64; }, lane);
            P.ATTA[(size_t)row * 512 + 256 + h * 64 + lane] = (bf16)f2bf(D.o / D.l);
        }
    }
    __syncthreads();
}
DI void ln_phase(const FP& P, const Ctx& C, const float* pre, const float* gam, const float* bet, float* xo, bf16* xb, float* yp, float* ys) {
    const int gw = C.vcu * NWAVES + C.wave, NGW = C.G * NWAVES, lane = C.lane;
    for (int r = gw; r < MP; r += NGW) { const float* x = pre + (size_t)r * D_MODEL; f32x4 v[4]; float s = 0.f;
#pragma unroll
        for (int j = 0; j < 4; ++j) { v[j] = *(const f32x4*)(x + 256 * j + 4 * lane); s += (v[j].x + v[j].y) + (v[j].z + v[j].w); }
        const float mu = wave_sum(s) * (1.0f / D_MODEL); float s2 = 0.f;
#pragma unroll
        for (int j = 0; j < 4; ++j) { v[j] = v[j] - mu; s2 += (v[j].x * v[j].x + v[j].y * v[j].y) + (v[j].z * v[j].z + v[j].w * v[j].w); }
        const float rs = 1.0f / sqrtf(wave_sum(s2) * (1.0f / D_MODEL) + LN_EPS);
#pragma unroll
        for (int j = 0; j < 4; ++j) { const f32x4 gg = *(const f32x4*)(gam + 256 * j + 4 * lane), bb = *(const f32x4*)(bet + 256 * j + 4 * lane); const f32x4 o = v[j] * rs * gg + bb;
            if (xo) *(f32x4*)(xo + (size_t)r * D_MODEL + 256 * j + 4 * lane) = o;
            if (xb) *(u32x2*)(xb + (size_t)r * D_MODEL + 256 * j + 4 * lane) = pk4(o);
            if (yp) { if (r < M0) *(f32x4*)(yp + (size_t)r * D_MODEL + 256 * j + 4 * lane) = o; else *(f32x4*)(ys + (size_t)(r - M0) * D_MODEL + 256 * j + 4 * lane) = o; } }
    }
}
}
namespace fx {
#define INS16(V, I, v_, i_) do { float _v = (v_); int _i = (i_); _Pragma("unroll") for (int _k = 0; _k < 16; ++_k) { const bool _gt = _v > V[_k]; const float _tv = V[_k]; const int _ti = I[_k]; V[_k] = _gt ? _v : _tv; I[_k] = _gt ? _i : _ti; _v = _gt ? _tv : _v; _i = _gt ? _ti : _i; } } while (0)
DI void topk_phase(const FP& P, const Ctx& C) {
    const int lane = C.lane; LAS float* st = (LAS float*)(C.lds + C.wave * 16384);
    const int NWI = (MP * PEER_HEADS + 63) / 64;
    for (int wi = C.vcu * NWAVES + C.wave; wi < NWI; wi += C.G * NWAVES) {
        const long it0 = (long)wi * 64; const long it = it0 + lane; const bool act = it < (long)MP * PEER_HEADS;
        float V1[16], V2[16], V3[16]; int I1[16], I2[16], I3[16];
#pragma unroll
        for (int k = 0; k < 16; ++k) { V1[k] = V2[k] = V3[k] = -INFINITY; I1[k] = I2[k] = I3[k] = 0; }
        for (int half = 0; half < 2; ++half) {
            for (int ch = 0; ch < 4; ++ch) {
#pragma unroll
                for (int u = 0; u < 8; ++u) { const int f4 = u * 64 + lane, j = f4 >> 3, c4 = (f4 & 7) * 4; const long itj = it0 + j;
                    f32x4 v = (itj < (long)MP * PEER_HEADS) ? *(const f32x4*)(P.SCO + itj * 256 + half * 128 + ch * 32 + c4) : (f32x4){0.f, 0.f, 0.f, 0.f};
                    st[j * 33 + c4] = v.x; st[j * 33 + c4 + 1] = v.y; st[j * 33 + c4 + 2] = v.z; st[j * 33 + c4 + 3] = v.w; }
                asm volatile("s_waitcnt lgkmcnt(0)" ::: "memory");
                for (int c = 0; c < 32; ++c) { const float v = st[lane * 33 + c]; const int id = ch * 32 + c;
                    if (half == 0) { if (__any(v > V1[15])) INS16(V1, I1, v, id); } else { if (__any(v > V2[15])) INS16(V2, I2, v, id); } }
                asm volatile("s_waitcnt lgkmcnt(0)" ::: "memory");
            }
        }
        { LAS float* lv = st; LAS int* li = (LAS int*)(st + 64 * 33);
#pragma unroll
          for (int k = 0; k < 16; ++k) { lv[lane * 33 + k] = V1[k]; lv[lane * 33 + 16 + k] = V2[k]; li[lane * 17 + k] = I1[k] | (I2[k] << 8); }
          asm volatile("s_waitcnt lgkmcnt(0)" ::: "memory");
          for (int a = 0; a < 16; ++a) { const float va = lv[lane * 33 + a]; const int ia = li[lane * 17 + a] & 255; const int nb = 16 / (a + 1);
              for (int b = 0; b < nb; ++b) { const float v = va + lv[lane * 33 + 16 + b]; const int ib = li[lane * 17 + b] >> 8; INS16(V3, I3, v, ia * PEER_KEYS + ib); } }
          asm volatile("s_waitcnt lgkmcnt(0)" ::: "memory"); }
        float z = 0.f; const float vmax = V3[0];
#pragma unroll
        for (int k = 0; k < 16; ++k) { V3[k] = __expf(V3[k] - vmax); z += V3[k]; }
        if (act) { const float iz = 1.0f / z;
#pragma unroll
            for (int k4 = 0; k4 < 4; ++k4) { *(f32x4*)(P.SELG + it * 16 + 4 * k4) = (f32x4){V3[4 * k4] * iz, V3[4 * k4 + 1] * iz, V3[4 * k4 + 2] * iz, V3[4 * k4 + 3] * iz};
                *(int4*)(P.SELE + it * 16 + 4 * k4) = make_int4(I3[4 * k4], I3[4 * k4 + 1], I3[4 * k4 + 2], I3[4 * k4 + 3]); } }
    }
    __syncthreads();
}
constexpr float PEER_SU = 256.f, PEER_SV = 64.f;
DI float dot16_fp8(const u32x4& w, const f32x2 (&x2)[8]) { f32x2 a = {0.f, 0.f};
    a += __builtin_amdgcn_cvt_pk_f32_fp8((int)w.x, false) * x2[0]; a += __builtin_amdgcn_cvt_pk_f32_fp8((int)w.x, true) * x2[1];
    a += __builtin_amdgcn_cvt_pk_f32_fp8((int)w.y, false) * x2[2]; a += __builtin_amdgcn_cvt_pk_f32_fp8((int)w.y, true) * x2[3];
    a += __builtin_amdgcn_cvt_pk_f32_fp8((int)w.z, false) * x2[4]; a += __builtin_amdgcn_cvt_pk_f32_fp8((int)w.z, true) * x2[5];
    a += __builtin_amdgcn_cvt_pk_f32_fp8((int)w.w, false) * x2[6]; a += __builtin_amdgcn_cvt_pk_f32_fp8((int)w.w, true) * x2[7];
    return a.x + a.y; }
DI void axpy16_fp8(const u32x4& w, float s, f32x2 (&o2)[8]) { const f32x2 s2 = {s, s};
    o2[0] += __builtin_amdgcn_cvt_pk_f32_fp8((int)w.x, false) * s2; o2[1] += __builtin_amdgcn_cvt_pk_f32_fp8((int)w.x, true) * s2;
    o2[2] += __builtin_amdgcn_cvt_pk_f32_fp8((int)w.y, false) * s2; o2[3] += __builtin_amdgcn_cvt_pk_f32_fp8((int)w.y, true) * s2;
    o2[4] += __builtin_amdgcn_cvt_pk_f32_fp8((int)w.z, false) * s2; o2[5] += __builtin_amdgcn_cvt_pk_f32_fp8((int)w.z, true) * s2;
    o2[6] += __builtin_amdgcn_cvt_pk_f32_fp8((int)w.w, false) * s2; o2[7] += __builtin_amdgcn_cvt_pk_f32_fp8((int)w.w, true) * s2; }
DI float rdlane(float v, int l) { return __builtin_bit_cast(float, __builtin_amdgcn_readlane(__builtin_bit_cast(int, v), l)); }
DI void peer_phase(const FP& P, const Ctx& C, int layer, const float* xin, float* fout, float* fout_s, bf16* xb) {
    const int lane = C.lane; const unsigned char* U = P.UB8 + (size_t)layer * PEER_EXPERTS * D_MODEL; const unsigned char* Vt = P.VB8 + (size_t)layer * PEER_EXPERTS * D_MODEL;
    const float* gam = P.ln_g + ((size_t)layer * 2 + 1) * D_MODEL; const float* bet = P.ln_b + ((size_t)layer * 2 + 1) * D_MODEL;
    for (int r = C.vcu * NWAVES + C.wave; r < MP; r += C.G * NWAVES) {
        f32x2 x2[8], o2[8];
#pragma unroll
        for (int j = 0; j < 4; ++j) { const f32x4 a = *(const f32x4*)(xin + (size_t)r * D_MODEL + 16 * lane + 4 * j); x2[2 * j] = (f32x2){a.x, a.y}; x2[2 * j + 1] = (f32x2){a.z, a.w}; }
#pragma unroll
        for (int k = 0; k < 8; ++k) o2[k] = (f32x2){0.f, 0.f};
        const int e_l = P.SELE[(size_t)r * 128 + lane], e_h = P.SELE[(size_t)r * 128 + 64 + lane]; const float g_l = P.SELG[(size_t)r * 128 + lane], g_h = P.SELG[(size_t)r * 128 + 64 + lane];
        for (int b0 = 0; b0 < 128; b0 += 8) {
            u32x4 uw[8], vw[8];
#pragma unroll
            for (int k = 0; k < 8; ++k) { const int hk = b0 + k; const int e = (hk < 64) ? __builtin_amdgcn_readlane(e_l, hk & 63) : __builtin_amdgcn_readlane(e_h, hk & 63);
                uw[k] = *(const u32x4*)(U + (size_t)e * D_MODEL + 16 * lane); vw[k] = *(const u32x4*)(Vt + (size_t)e * D_MODEL + 16 * lane); }
            float d[8];
#pragma unroll
            for (int k = 0; k < 8; ++k) d[k] = dot16_fp8(uw[k], x2);
            float e4[4], e2[2], e1;
            { const bool hi = lane & 1;
#pragma unroll
              for (int i = 0; i < 4; ++i) { const float keep = hi ? d[4 + i] : d[i], send = hi ? d[i] : d[4 + i]; e4[i] = keep + __shfl_xor(send, 1); } }
            { const bool hi = lane & 2;
#pragma unroll
              for (int i = 0; i < 2; ++i) { const float keep = hi ? e4[2 + i] : e4[i], send = hi ? e4[i] : e4[2 + i]; e2[i] = keep + __shfl_xor(send, 2); } }
            { const bool hi = lane & 4; const float keep = hi ? e2[1] : e2[0], send = hi ? e2[0] : e2[1]; e1 = keep + __shfl_xor(send, 4); }
            e1 += __shfl_xor(e1, 8); e1 += __shfl_xor(e1, 16); e1 += __shfl_xor(e1, 32);
            const int myk = 4 * (lane & 1) + (lane & 2) + ((lane >> 2) & 1); const int myhk = b0 + myk;
            const float myg = (myhk < 64) ? __shfl(g_l, myhk & 63) : __shfl(g_h, myhk & 63);
            const float act = myg * gelu_tanh(e1 * (1.0f / PEER_SU)) * (1.0f / PEER_SV);
#pragma unroll
            for (int k = 0; k < 8; ++k) { const int src = (k >> 2) | (((k >> 1) & 1) << 1) | ((k & 1) << 2); axpy16_fp8(vw[k], rdlane(act, src), o2); }
        }
        float s = 0.f;
#pragma unroll
        for (int k = 0; k < 8; ++k) { o2[k] += x2[k] * ALPHA; s += o2[k].x + o2[k].y; }
        const float mu = wave_sum(s) * (1.0f / D_MODEL); float s2 = 0.f;
#pragma unroll
        for (int k = 0; k < 8; ++k) { o2[k] -= mu; s2 += o2[k].x * o2[k].x + o2[k].y * o2[k].y; }
        const float rs = 1.0f / sqrtf(wave_sum(s2) * (1.0f / D_MODEL) + LN_EPS);
        float* frow = (r < M0) ? fout + (size_t)r * D_MODEL : fout_s + (size_t)(r - M0) * D_MODEL;
#pragma unroll
        for (int j = 0; j < 4; ++j) { const int c0 = 16 * lane + 4 * j; const f32x4 gg = *(const f32x4*)(gam + c0), bb = *(const f32x4*)(bet + c0);
            const f32x4 y = (f32x4){o2[2 * j].x * rs, o2[2 * j].y * rs, o2[2 * j + 1].x * rs, o2[2 * j + 1].y * rs} * gg + bb;
            *(f32x4*)(frow + c0) = y; if (xb) *(u32x2*)(xb + (size_t)r * D_MODEL + c0) = pk4(y); }
    }
}
}
namespace fx {
struct EpiB {
    static constexpr bool PERM = true, AFTER_DRAIN = false; const FP& P;
    DI void operator()(const f32x4 (&acc)[2][2][4][2], const pg8::Unit& u, int wr, int wc, int fr, int fq) const {
        const int t = u.pn;
        EPI_LOOP({ if (row < MP) { const int pos = row_pos(row), n = row / SEQ, e = ct & 63, dp = e >> 1; const bool prm = row < M0;
            if (t < 3) { const int ty = 2 * t + (ct >> 7), kvh = (ct >> 6) & 1;
                if (ty == 2 || ty == 4) { f32x4 lo, hi; rope4(P.ROPE + pos * 64, dp, v0, v1, lo, hi);
                    if (ty == 2) { float* o = (prm ? P.nsa_kv_p + (size_t)row * 512 : P.nsa_kv_s + (size_t)(row - M0) * 512) + 256 + kvh * 64 + dp; *(f32x4*)o = lo; *(f32x4*)(o + 32) = hi;
                        if (prm) { bf16* k = P.SLK + (((size_t)n * NSA_KV_HEADS + kvh) * SEQ + pos) * 64 + dp; *(u32x2*)k = pk4(lo); *(u32x2*)(k + 32) = pk4(hi); } }
                    else { float* o = nullptr; if (!prm) o = P.win_s + (((size_t)(row - M0) * SWA_WINDOW + SWA_WINDOW - 1) * 2 + 0) * 128; else if (pos >= SEQ - SWA_WINDOW) o = P.win_p + (((size_t)n * SWA_WINDOW + pos - (SEQ - SWA_WINDOW)) * 2 + 0) * 128;
                        if (o) { *(f32x4*)(o + kvh * 64 + dp) = lo; *(f32x4*)(o + kvh * 64 + 32 + dp) = hi; }
                        if (prm) { bf16* k = P.WNK + (((size_t)n * NSA_KV_HEADS + kvh) * SEQ + pos) * 64 + dp; *(u32x2*)k = pk4(lo); *(u32x2*)(k + 32) = pk4(hi); } } }
                else if (ty < 4) { float* o = (prm ? P.nsa_kv_p + (size_t)row * 512 : P.nsa_kv_s + (size_t)(row - M0) * 512) + ty * 128 + kvh * 64 + e; *(f32x4*)o = v0; *(f32x4*)(o + 4) = v1;
                    if (prm) { if (ty < 2) *(u32x4*)(P.AC + ((size_t)ty * ACROWS + ((size_t)n * NSA_KV_HEADS + kvh) * NCH + pos / 16) * 1024 + (pos % 16) * 64 + e) = pk8(v0, v1);
                        else { bf16* vt = P.SLVT + ((((size_t)n * NSA_KV_HEADS + kvh) * (SEQ / 64) + pos / 64) * 64 + e) * 64 + (pos & 63);
                            vt[0] = (bf16)f2bf(v0.x); vt[64] = (bf16)f2bf(v0.y); vt[128] = (bf16)f2bf(v0.z); vt[192] = (bf16)f2bf(v0.w); vt[256] = (bf16)f2bf(v1.x); vt[320] = (bf16)f2bf(v1.y); vt[384] = (bf16)f2bf(v1.z); vt[448] = (bf16)f2bf(v1.w); } } }
                else { float* o = nullptr; if (!prm) o = P.win_s + (((size_t)(row - M0) * SWA_WINDOW + SWA_WINDOW - 1) * 2 + 1) * 128; else if (pos >= SEQ - SWA_WINDOW) o = P.win_p + (((size_t)n * SWA_WINDOW + pos - (SEQ - SWA_WINDOW)) * 2 + 1) * 128;
                    if (o) { *(f32x4*)(o + kvh * 64 + e) = v0; *(f32x4*)(o + kvh * 64 + e + 4) = v1; }
                    if (prm) { bf16* vt = P.WNVT + (((size_t)n * NSA_KV_HEADS + kvh) * 64 + e) * SEQ + pos;
                        vt[0 * SEQ] = (bf16)f2bf(v0.x); vt[1 * SEQ] = (bf16)f2bf(v0.y); vt[2 * SEQ] = (bf16)f2bf(v0.z); vt[3 * SEQ] = (bf16)f2bf(v0.w); vt[4 * SEQ] = (bf16)f2bf(v1.x); vt[5 * SEQ] = (bf16)f2bf(v1.y); vt[6 * SEQ] = (bf16)f2bf(v1.z); vt[7 * SEQ] = (bf16)f2bf(v1.w); } } }
            else if (t < 6) { const int h = (t - 3) * 4 + (ct >> 6); f32x4 lo, hi; rope4(P.ROPE + pos * 64, dp, v0, v1, lo, hi); bf16* q = P.QB + (size_t)row * NSA_Q_COLS + h * 64 + dp; *(u32x2*)q = pk4(lo * QSCALE); *(u32x2*)(q + 32) = pk4(hi * QSCALE); }
            else if (t == 6) { *(u32x4*)(P.MQB + (size_t)row * 256 + ct) = pk8(v0 * QSCALE, v1 * QSCALE); }
            else if (ct < 40) { const float vv[8] = {v0.x, v0.y, v0.z, v0.w, v1.x, v1.y, v1.z, v1.w};
                _Pragma("unroll") for (int i = 0; i < 8; ++i) if (ct + i < NSA_GATE_COLS) P.GATES[(size_t)row * 64 + ct + i] = 1.0f / (1.0f + __expf(-vv[i])); } } })
    }
};
DI void cmp2_phase(const FP& P, const Ctx& C) {
    const int lane = C.lane; LAS float* hs = (LAS float*)(C.lds + C.wave * 1024);
    const int NIT = NCTX * 2 * NSA_KV_HEADS * NCMP;
    for (int it = C.vcu * NWAVES + C.wave; it < NIT; it += C.G * NWAVES) { const int c = it % NCMP; int r = it / NCMP; const int kvh = r % NSA_KV_HEADS; r /= NSA_KV_HEADS; const int ty = r % 2, ctx = r / 2;
        const float* UL = P.UL + ((size_t)ty * ACROWS + ((size_t)ctx * NSA_KV_HEADS + kvh) * NCH) * 256;
#pragma unroll
        for (int hf = 0; hf < 2; ++hf) { const int hid = lane + 64 * hf; hs[hid] = gelu_tanh(UL[(size_t)c * 256 + hid] + UL[(size_t)(c + 1) * 256 + 128 + hid] + P.CBIAS[ty * CMP_HIDDEN + hid]); }
        asm volatile("s_waitcnt lgkmcnt(0)" ::: "memory");
        const float* w2 = P.cmp_w2 + (size_t)ty * CMP_HIDDEN * HEAD_DIM; float a = 0.f;
#pragma unroll 8
        for (int k = 0; k < CMP_HIDDEN; ++k) a += hs[k] * w2[k * HEAD_DIM + lane];
        if (ty == 0) { const float other = __shfl_xor(a, 32); const int pos = c * CMP_STRIDE + CMP_BLOCK - 1; const float cs = P.ROPE[pos * 64 + (lane & 31)], sn = P.ROPE[pos * 64 + 32 + (lane & 31)];
            a = (lane < 32) ? a * cs - other * sn : a * cs + other * sn; }
        if (ctx < BATCH) { if (ty == 0) P.CK[(((size_t)ctx * NSA_KV_HEADS + kvh) * NCH + c) * 64 + lane] = (bf16)f2bf(a); else P.CVT[(((size_t)ctx * NSA_KV_HEADS + kvh) * 64 + lane) * NCH + c] = (bf16)f2bf(a); }
        else { (ty == 0 ? P.CKF : P.CVF)[(((size_t)(ctx - BATCH) * NSA_KV_HEADS + kvh) * NCH + c) * 64 + lane] = a; }
        asm volatile("s_waitcnt lgkmcnt(0)" ::: "memory");
    }
    __syncthreads();
}
constexpr int NSA_WLDS = 8192;
DI void nsa_pair(const FP& P, int n, int kvh, int t, int lane, LAS unsigned char* wl) {
    LAS float* pn = (LAS float*)wl; LAS float* imp = (LAS float*)(wl + 2048); LAS float* sc = (LAS float*)(wl + 6144); LAS int* sel = (LAS int*)(wl + 7168);
    const int col = lane & 15, c = lane >> 4; const bool vcol = col < 12; const int qq = vcol ? col / 6 : 0, hh = vcol ? col % 6 : 0, tq = t + qq, head = kvh * NSA_GROUP + hh, row = n * SEQ + tq;
    bf16x8 qf[2]; { const bf16* qp = P.QB + (size_t)row * NSA_Q_COLS + head * 64 + 8 * c; qf[0] = *(const bf16x8*)qp; qf[1] = *(const bf16x8*)(qp + 32); }
    const float* gt = P.GATES + (size_t)row * 64 + head * 3;
    f32x4 oacc[4] = {(f32x4){0.f, 0.f, 0.f, 0.f}, (f32x4){0.f, 0.f, 0.f, 0.f}, (f32x4){0.f, 0.f, 0.f, 0.f}, (f32x4){0.f, 0.f, 0.f, 0.f}};
    const int lim = vcol ? ((tq >= CMP_BLOCK - 1) ? (tq - (CMP_BLOCK - 1)) / CMP_STRIDE : -1) : -1;
    const int limmax = (t + 1 >= CMP_BLOCK - 1) ? (t + 1 - (CMP_BLOCK - 1)) / CMP_STRIDE : -1; const int nblk = (limmax + 32) / 32;
    const bf16* CKb = P.CK + ((size_t)n * NSA_KV_HEADS + kvh) * NCH * 64; const bf16* CVb = P.CVT + ((size_t)n * NSA_KV_HEADS + kvh) * 64 * NCH;
    for (int i = lane; i < 1024; i += 64) imp[i] = 0.f;
    float m1 = -INFINITY, l1 = 0.f;
    for (int blk = 0; blk < nblk; ++blk) { const int kb = 32 * blk; const bf16* k0 = CKb + (size_t)(kb + krow_of(col, 0)) * 64 + 8 * c; const bf16* k1 = CKb + (size_t)(kb + krow_of(col, 1)) * 64 + 8 * c;
        const bf16x8 ka0 = *(const bf16x8*)k0, ka1 = *(const bf16x8*)(k0 + 32), kb0 = *(const bf16x8*)k1, kb1 = *(const bf16x8*)(k1 + 32);
        f32x4 s0 = (f32x4){0.f, 0.f, 0.f, 0.f}, s1 = (f32x4){0.f, 0.f, 0.f, 0.f};
        s0 = __builtin_amdgcn_mfma_f32_16x16x32_bf16(ka0, qf[0], s0, 0, 0, 0); s0 = __builtin_amdgcn_mfma_f32_16x16x32_bf16(ka1, qf[1], s0, 0, 0, 0);
        s1 = __builtin_amdgcn_mfma_f32_16x16x32_bf16(kb0, qf[0], s1, 0, 0, 0); s1 = __builtin_amdgcn_mfma_f32_16x16x32_bf16(kb1, qf[1], s1, 0, 0, 0);
        float s[8] = {s0.x, s0.y, s0.z, s0.w, s1.x, s1.y, s1.z, s1.w}; float mx = -INFINITY;
#pragma unroll
        for (int e = 0; e < 8; ++e) { s[e] = (kb + 8 * c + e <= lim) ? s[e] : -INFINITY; mx = fmaxf(mx, s[e]); }
        mx = fmaxf(mx, __shfl_xor(mx, 16)); mx = fmaxf(mx, __shfl_xor(mx, 32));
        const float mnew = fmaxf(m1, mx), muse = (mnew == -INFINITY) ? 0.f : mnew; float ls = 0.f;
#pragma unroll
        for (int e = 0; e < 8; ++e) ls += __builtin_amdgcn_exp2f(s[e] - muse);
        ls += __shfl_xor(ls, 16); ls += __shfl_xor(ls, 32);
        l1 = l1 * __builtin_amdgcn_exp2f(m1 - muse) + ls; m1 = mnew; }
    asm volatile("s_waitcnt lgkmcnt(0)" ::: "memory");
    { const float muse = (m1 == -INFINITY) ? 0.f : m1, inv = (l1 > 0.f) ? 1.0f / l1 : 0.f;
      f32x4 oc[4] = {(f32x4){0.f, 0.f, 0.f, 0.f}, (f32x4){0.f, 0.f, 0.f, 0.f}, (f32x4){0.f, 0.f, 0.f, 0.f}, (f32x4){0.f, 0.f, 0.f, 0.f}};
      for (int blk = 0; blk < nblk; ++blk) { const int kb = 32 * blk; const bf16* k0 = CKb + (size_t)(kb + krow_of(col, 0)) * 64 + 8 * c; const bf16* k1 = CKb + (size_t)(kb + krow_of(col, 1)) * 64 + 8 * c; const bf16* v = CVb + (size_t)col * NCH + kb + 8 * c;
        const bf16x8 ka0 = *(const bf16x8*)k0, ka1 = *(const bf16x8*)(k0 + 32), kb0 = *(const bf16x8*)k1, kb1 = *(const bf16x8*)(k1 + 32);
        const bf16x8 v0 = *(const bf16x8*)v, v1 = *(const bf16x8*)(v + 16 * NCH), v2 = *(const bf16x8*)(v + 32 * NCH), v3 = *(const bf16x8*)(v + 48 * NCH);
        f32x4 s0 = (f32x4){0.f, 0.f, 0.f, 0.f}, s1 = (f32x4){0.f, 0.f, 0.f, 0.f};
        s0 = __builtin_amdgcn_mfma_f32_16x16x32_bf16(ka0, qf[0], s0, 0, 0, 0); s0 = __builtin_amdgcn_mfma_f32_16x16x32_bf16(ka1, qf[1], s0, 0, 0, 0);
        s1 = __builtin_amdgcn_mfma_f32_16x16x32_bf16(kb0, qf[0], s1, 0, 0, 0); s1 = __builtin_amdgcn_mfma_f32_16x16x32_bf16(kb1, qf[1], s1, 0, 0, 0);
        float s[8] = {s0.x, s0.y, s0.z, s0.w, s1.x, s1.y, s1.z, s1.w};
#pragma unroll
        for (int e = 0; e < 8; ++e) s[e] = (kb + 8 * c + e <= lim) ? __builtin_amdgcn_exp2f(s[e] - muse) * inv : 0.f;
        *(f32x4*)(pn + col * 32 + 8 * c) = (f32x4){s[0], s[1], s[2], s[3]}; *(f32x4*)(pn + col * 32 + 8 * c + 4) = (f32x4){s[4], s[5], s[6], s[7]};
        u32x4 pw; pw.x = cvtpk(s[0], s[1]); pw.y = cvtpk(s[2], s[3]); pw.z = cvtpk(s[4], s[5]); pw.w = cvtpk(s[6], s[7]); const bf16x8 pf = __builtin_bit_cast(bf16x8, pw);
        oc[0] = __builtin_amdgcn_mfma_f32_16x16x32_bf16(v0, pf, oc[0], 0, 0, 0); oc[1] = __builtin_amdgcn_mfma_f32_16x16x32_bf16(v1, pf, oc[1], 0, 0, 0);
        oc[2] = __builtin_amdgcn_mfma_f32_16x16x32_bf16(v2, pf, oc[2], 0, 0, 0); oc[3] = __builtin_amdgcn_mfma_f32_16x16x32_bf16(v3, pf, oc[3], 0, 0, 0);
        asm volatile("s_waitcnt lgkmcnt(0)" ::: "memory");
        { const int q2 = lane >> 5, k = lane & 31; float a = 0.f;
#pragma unroll
          for (int h6 = 0; h6 < 6; ++h6) a += pn[(q2 * 6 + h6) * 32 + k];
          imp[q2 * 512 + kb + k] = a; }
        asm volatile("s_waitcnt lgkmcnt(0)" ::: "memory"); }
#ifdef NSA_DEBUG
      if (vcol) { for (int db = 0; db < 4; ++db) *(f32x4*)(P.DBG + ((size_t)0 * MP + row) * 768 + head * 64 + 16 * db + 4 * c) = oc[db]; }
#endif
      const float g0 = vcol ? gt[0] : 0.f;
#pragma unroll
      for (int db = 0; db < 4; ++db) oacc[db] += oc[db] * g0; }
    for (int i = lane; i < 256; i += 64) { const int q2 = i >> 7, b = i & 127, tq2 = t + q2, cur = tq2 / SLC_BLOCK; float sv;
        if (b > cur) sv = NEG; else if (b == 0 || b == cur || b == cur - 1) sv = FORCE_SCORE;
        else { const LAS float* ic = imp + q2 * 512 + 4 * b; sv = ic[-1] + 2.f * (ic[0] + ic[1] + ic[2]) + ic[3]; }
        sc[i] = sv; }
    asm volatile("s_waitcnt lgkmcnt(0)" ::: "memory");
    for (int i = lane; i < 256; i += 64) { const int q2 = i >> 7, b = i & 127; const float sv = sc[i]; int rank = 0;
        for (int j = 0; j < 128; ++j) { const float o = sc[q2 * 128 + j]; rank += (o > sv || (o == sv && j < b)) ? 1 : 0; }
        if (rank < SLC_TOPK) { const int v = (sv > 0.5f * NEG) ? b : -1; sel[q2 * 16 + rank] = v; P.SELB[((size_t)(n * SEQ + t + q2) * NSA_KV_HEADS + kvh) * 16 + rank] = v; } }
    asm volatile("s_waitcnt lgkmcnt(0)" ::: "memory");
    { Tile16 T; tile_init(T);
      const bf16* SKb = P.SLK + ((size_t)n * NSA_KV_HEADS + kvh) * SEQ * 64; const bf16* SVb = P.SLVT + ((size_t)n * NSA_KV_HEADS + kvh) * SEQ * 64;
      LAS int* steps = (LAS int*)pn; int ns = 0;
      for (int q2 = 0; q2 < 2; ++q2) for (int r = 0; r < SLC_TOPK; ++r) { const int b = __builtin_amdgcn_readfirstlane(sel[q2 * 16 + r]); if (b < 0) continue;
          if (lane == 0) { steps[ns] = (b * SLC_BLOCK) | (q2 << 30); steps[ns + 1] = (b * SLC_BLOCK + 32) | (q2 << 30); } ns += 2; }
      asm volatile("s_waitcnt lgkmcnt(0)" ::: "memory");
      auto ld = [&](KV8& kv, int i) { const int code = __builtin_amdgcn_readfirstlane(steps[i]); const int kb = code & 0x3fffffff;
          kv_load(kv, SKb + (size_t)(kb + krow_of(col, 0)) * 64 + 8 * c, SKb + (size_t)(kb + krow_of(col, 1)) * 64 + 8 * c, SVb + ((size_t)(kb >> 6) * 64 + col) * 64 + (kb & 32) + 8 * c, 16L * 64); };
      if (ns > 0) { KV8 cur; ld(cur, 0);
#pragma unroll 1
          for (int i = 0; i < ns; ++i) { KV8 nxt; ld(nxt, (i + 1 < ns) ? i + 1 : i); const int code = __builtin_amdgcn_readfirstlane(steps[i]); const int kb = code & 0x3fffffff, q2 = code >> 30;
              tile_compute(T, qf, cur, [&](int e) { return vcol && qq == q2 && (kb + 8 * c + e) <= tq; }); cur = nxt; } }
      const float inv = (T.l > 0.f) ? 1.0f / T.l : 0.f, g1 = vcol ? gt[1] * inv : 0.f;
#ifdef NSA_DEBUG
      if (vcol) { for (int db = 0; db < 4; ++db) *(f32x4*)(P.DBG + ((size_t)1 * MP + row) * 768 + head * 64 + 16 * db + 4 * c) = T.o[db] * inv; }
#endif
#pragma unroll
      for (int db = 0; db < 4; ++db) oacc[db] += T.o[db] * g1; }
    { Tile16 T; tile_init(T);
      const bf16* WKb = P.WNK + ((size_t)n * NSA_KV_HEADS + kvh) * SEQ * 64; const bf16* WVb = P.WNVT + ((size_t)n * NSA_KV_HEADS + kvh) * 64 * SEQ;
      const int blo = (t - SWA_WINDOW) >> 5, bhi = (t + 1) >> 5;
      auto ld = [&](KV8& kv, int blk) { const int kb = 32 * blk; int ka = kb + krow_of(col, 0), kc = kb + krow_of(col, 1); ka = ka < 0 ? 0 : ka; kc = kc < 0 ? 0 : kc;
          kv_load(kv, WKb + (size_t)ka * 64 + 8 * c, WKb + (size_t)kc * 64 + 8 * c, WVb + (size_t)col * SEQ + kb + 8 * c, 16L * SEQ); };
      KV8 cur; ld(cur, blo);
#pragma unroll 1
      for (int blk = blo; blk <= bhi; ++blk) { KV8 nxt; ld(nxt, blk < bhi ? blk + 1 : blk); const int kb = 32 * blk;
          tile_compute(T, qf, cur, [&](int e) { const int kp = kb + 8 * c + e; return vcol && kp >= 0 && kp <= tq && tq - kp <= SWA_WINDOW; }); cur = nxt; }
      const float inv = (T.l > 0.f) ? 1.0f / T.l : 0.f, g2 = vcol ? gt[2] * inv : 0.f;
#ifdef NSA_DEBUG
      if (vcol) { for (int db = 0; db < 4; ++db) *(f32x4*)(P.DBG + ((size_t)2 * MP + row) * 768 + head * 64 + 16 * db + 4 * c) = T.o[db] * inv; }
#endif
#pragma unroll
      for (int db = 0; db < 4; ++db) oacc[db] += T.o[db] * g2; }
    if (vcol) { bf16* op = P.ATTB + (size_t)row * 1024 + head * 64 + 4 * c;
#pragma unroll
        for (int db = 0; db < 4; ++db) *(u32x2*)(op + 16 * db) = pk4(oacc[db]); }
}
constexpr int SMP_SK = 1088;
template <class KF, class VF> DI void smp_branch(const Ctx& C, LAS float* qs, LAS float* S, LAS float* red, int NK, KF kf, VF vf, bool keep_probs, float (&outh)[1]) {
    const int tid = C.tid, lane = C.lane, w = C.wave;
#pragma unroll 1
    for (int j = tid; j < NK; j += NTHREADS) { const float* k = kf(j); f32x4 kr[16];
#pragma unroll
        for (int d4 = 0; d4 < 16; ++d4) kr[d4] = *(const f32x4*)(k + 4 * d4);
#pragma unroll 1
        for (int h = 0; h < 6; ++h) { float a = 0.f;
#pragma unroll
            for (int d4 = 0; d4 < 16; ++d4) { const f32x4 qv = *(const LAS f32x4*)(qs + h * 64 + 4 * d4); a += kr[d4].x * qv.x + kr[d4].y * qv.y + kr[d4].z * qv.z + kr[d4].w * qv.w; }
            S[h * SMP_SK + j] = a; } }
    asm volatile("s_waitcnt lgkmcnt(0)" ::: "memory"); __syncthreads();
    if (w < 6) { float m = -INFINITY; for (int j = lane; j < NK; j += 64) m = fmaxf(m, S[w * SMP_SK + j]); m = wave_max(m);
        float l = 0.f; for (int j = lane; j < NK; j += 64) { const float p = __builtin_amdgcn_exp2f(S[w * SMP_SK + j] - m); S[w * SMP_SK + j] = p; l += p; } l = wave_sum(l);
        const float inv = 1.0f / l; for (int j = lane; j < NK; j += 64) S[w * SMP_SK + j] *= inv; }
    asm volatile("s_waitcnt lgkmcnt(0)" ::: "memory"); __syncthreads();
    { const int per = (NK + NWAVES - 1) / NWAVES, j0 = w * per, j1 = (j0 + per < NK) ? j0 + per : NK; float o[6] = {0.f, 0.f, 0.f, 0.f, 0.f, 0.f};
#pragma unroll 1
      for (int j = j0; j < j1; j += 8) { float vv[8];
#pragma unroll
          for (int u = 0; u < 8; ++u) { const int jj = (j + u < j1) ? j + u : j1 - 1; vv[u] = vf(jj)[lane]; }
#pragma unroll
          for (int u = 0; u < 8; ++u) if (j + u < j1) {
#pragma unroll
              for (int h = 0; h < 6; ++h) o[h] += S[h * SMP_SK + j + u] * vv[u]; } }
#pragma unroll
      for (int h = 0; h < 6; ++h) red[(w * 6 + h) * 64 + lane] = o[h]; }
    asm volatile("s_waitcnt lgkmcnt(0)" ::: "memory"); __syncthreads();
    outh[0] = 0.f;
    if (tid < 384) { float a = 0.f;
#pragma unroll
        for (int ww = 0; ww < NWAVES; ++ww) a += red[ww * 384 + tid]; outh[0] = a; }
    if (!keep_probs) { __syncthreads(); }
}
DI void nsa_sample_item(const FP& P, const Ctx& C, int ns, int kvh) {
    LAS float* qs = (LAS float*)C.lds; LAS float* S = qs + 384; LAS float* red = S + 6 * SMP_SK; LAS float* scs = red + 8 * 384; LAS int* sel = (LAS int*)(scs + 136);
    const int tid = C.tid, row = M0 + ns;
    if (tid < 384) qs[tid] = bf2f(P.QB[(size_t)row * NSA_Q_COLS + kvh * 384 + tid]);
    asm volatile("s_waitcnt lgkmcnt(0)" ::: "memory"); __syncthreads();
    const float* ckf = P.CKF + ((size_t)ns * NSA_KV_HEADS + kvh) * NCH * 64; const float* cvf = P.CVF + ((size_t)ns * NSA_KV_HEADS + kvh) * NCH * 64;
    float oc[1], os[1], ow[1];
    smp_branch(C, qs, S, red, NCMP, [&](int j) { return ckf + (size_t)j * 64; }, [&](int j) { return cvf + (size_t)j * 64; }, true, oc);
    constexpr int NBS = (PAST_LEN + 1 + SLC_BLOCK - 1) / SLC_BLOCK, CURS = PAST_LEN / SLC_BLOCK;
    for (int b = tid; b < 136; b += NTHREADS) { float sv = -3.0e38f;
        if (b < NBS) { if (b == 0 || b == CURS || b == CURS - 1) sv = FORCE_SCORE; else { float a = 0.f;
#pragma unroll
                for (int o = -1; o <= 3; ++o) { const int ci = 4 * b + o; if (ci >= 0 && ci < NCMP) { float sm = 0.f; for (int h6 = 0; h6 < 6; ++h6) sm += S[h6 * SMP_SK + ci]; a += ((o >= 0 && o <= 2) ? 2.f : 1.f) * sm; } }
                sv = a; } }
        scs[b] = sv; }
    asm volatile("s_waitcnt lgkmcnt(0)" ::: "memory"); __syncthreads();
    for (int b = tid; b < NBS; b += NTHREADS) { const float sv = scs[b]; int rank = 0; for (int j = 0; j < NBS; ++j) { const float o = scs[j]; rank += (o > sv || (o == sv && j < b)) ? 1 : 0; }
        if (rank < SLC_TOPK) { sel[rank] = b; P.SELB[((size_t)row * NSA_KV_HEADS + kvh) * 16 + rank] = b; } }
    asm volatile("s_waitcnt lgkmcnt(0)" ::: "memory"); __syncthreads();
    { const float* newrow = P.nsa_kv_s + (size_t)ns * 512; const int* pt = P.page_table + ns * (PAST_LEN / PAGE_SIZE);
      if (tid == 0) { int seen = 0; for (int x = 0; x < SLC_TOPK; ++x) { const int bx = sel[x]; if (bx != CURS && seen < 15) sel[16 + seen++] = bx; } }
      asm volatile("s_waitcnt lgkmcnt(0)" ::: "memory"); __syncthreads();
      auto krow = [&](int j, int ty) -> const float* { if (j >= 15 * 64) return newrow + ty * 128 + kvh * 64;
          const int t0 = sel[16 + (j >> 6)] * SLC_BLOCK + (j & 63); const int pg = pt[t0 / PAGE_SIZE]; return P.cache_nsa_kv + ((size_t)pg * PAGE_SIZE + t0 % PAGE_SIZE) * 512 + ty * 128 + kvh * 64; };
      smp_branch(C, qs, S, red, 15 * 64 + 1, [&](int j) { return krow(j, 2); }, [&](int j) { return krow(j, 3); }, false, os); }
    { const float* wc = P.cache_nsa_win + (size_t)ns * SWA_WINDOW * 256; const float* newrow = P.win_s + ((size_t)ns * SWA_WINDOW + SWA_WINDOW - 1) * 256;
      smp_branch(C, qs, S, red, SWA_WINDOW + 1, [&](int j) { return (j < SWA_WINDOW ? wc + (size_t)j * 256 : newrow) + kvh * 64; }, [&](int j) { return (j < SWA_WINDOW ? wc + (size_t)j * 256 : newrow) + 128 + kvh * 64; }, false, ow); }
    if (tid < 384) { const int head = kvh * NSA_GROUP + tid / 64; const float* gt = P.GATES + (size_t)row * 64 + head * 3;
        P.ATTB[(size_t)row * 1024 + kvh * 384 + tid] = (bf16)f2bf(gt[0] * oc[0] + gt[1] * os[0] + gt[2] * ow[0]);
#ifdef NSA_DEBUG
        P.DBG[((size_t)0 * MP + row) * 768 + kvh * 384 + tid] = oc[0]; P.DBG[((size_t)1 * MP + row) * 768 + kvh * 384 + tid] = os[0]; P.DBG[((size_t)2 * MP + row) * 768 + kvh * 384 + tid] = ow[0];
#endif
    }
    __syncthreads();
}
DI void nsa_phase(const FP& P, const Ctx& C) {
    const int lane = C.lane, w = C.wave;
    for (int it = C.vcu; it < DEC_BATCH * NSA_KV_HEADS; it += C.G) nsa_sample_item(P, C, it / NSA_KV_HEADS, it % NSA_KV_HEADS);
#ifdef NSA_DUP_SAMPLE
    for (int it = C.vcu; it < DEC_BATCH * NSA_KV_HEADS; it += C.G) nsa_sample_item(P, C, it / NSA_KV_HEADS, it % NSA_KV_HEADS);
#endif
    { LAS unsigned char* wl = C.lds + w * NSA_WLDS;
      const int per = C.G / 4 > 0 ? C.G / 4 : 1, grp = (C.vcu / per) & 3, sub = C.vcu % per, n = grp >> 1, kvh = grp & 1;
      for (int pr = sub * NWAVES + w; pr < SEQ / 2; pr += per * NWAVES) nsa_pair(P, n, kvh, 2 * pr, lane, wl);
#ifdef NSA_DUP_PAIR
      for (int pr = sub * NWAVES + w; pr < SEQ / 2; pr += per * NWAVES) nsa_pair(P, n, kvh, 2 * pr, lane, wl);
#endif
    }
    __syncthreads();
    { constexpr int NMT = (M0 / 16) * MEM_HEADS;
      for (int it = C.vcu * NWAVES + w; it < NMT; it += C.G * NWAVES) { const int h = it % MEM_HEADS, q16 = it / MEM_HEADS, row0 = q16 * 16, n = row0 / SEQ;
          mem_micro(P, P.MQB + h * 64, 256, row0, 1, n, h, P.ATTB + NSA_Q_COLS + h * 64, 1024, lane); }
      LAS float* qs = (LAS float*)(C.lds + 65536 + w * 256);
      for (int it = C.vcu * NWAVES + w; it < DEC_BATCH * MEM_HEADS; it += C.G * NWAVES) { const int h = it % MEM_HEADS, ns = it / MEM_HEADS, row = M0 + ns;
          Dec D; D.m = -INFINITY; D.l = 0.f; D.o = 0.f; qs[lane] = bf2f(P.MQB[(size_t)row * 256 + h * 64 + lane]); asm volatile("s_waitcnt lgkmcnt(0)" ::: "memory");
          const float* mk = P.cache_mem_kv + ((size_t)1 * DEC_BATCH + ns) * MEM_TOKENS * 512;
          for (int j0 = 0; j0 < MEM_TOKENS; j0 += 64) dec_chunk(D, qs, 64, [&](int j) { return mk + (size_t)(j0 + j) * 512 + h * 64; }, [&](int j) { return mk + (size_t)(j0 + j) * 512 + 256 + h * 64; }, lane);
          P.ATTB[(size_t)row * 1024 + NSA_Q_COLS + h * 64 + lane] = (bf16)f2bf(D.o / D.l); } }
    __syncthreads();
}
}
namespace fx {
enum { PH_PRO = 0, PH_WPK, PH_G1, PH_ATTA, PH_G2, PH_LN1, PH_SC0, PH_TK0, PH_PG0, PH_G3, PH_CMPG, PH_CMP2, PH_NSA, PH_G4, PH_LN3, PH_SC1, PH_TK1, PH_PG1, PH_COUNT };
template <class Epi> DI void run_gemm(const Ctx& C, const bf16* A, const bf16* Bt, int M, int N, int K, const Epi& E) {
    pg8::Gemm g{A, Bt, M, N, K}; pg8::StaticOrder S; S.init(M, N, C.G, (int)blockIdx.x);
    pg8::gemm_phase<Epi, pg8::StaticOrder, true, true>(C.lds, g, S, E);
}
__global__ void __launch_bounds__(NTHREADS, 2) mega(Args args) {
    extern __shared__ __attribute__((aligned(16))) unsigned char lds_raw[];
    Ctx C; C.lds = (LAS unsigned char*)lds_raw; C.tid = threadIdx.x; C.lane = C.tid & 63; C.wave = __builtin_amdgcn_readfirstlane(C.tid >> 6);
    C.G = gridDim.x; { const int bx = blockIdx.x; C.vcu = (C.G % 8 == 0) ? (bx % 8) * (C.G / 8) + bx / 8 : bx; }
    const FP& P = args.p;
    volatile LAS unsigned* MISC = (volatile LAS unsigned*)(C.lds + MISC_OFF);
    for (int u = C.tid; u < (LDS_BYTES - RING_BYTES) / 4; u += NTHREADS) ((LAS unsigned*)(C.lds + RING_BYTES))[u] = 0u;
    __syncthreads();
    const int lo = args.lo, hi = args.hi;
    XcdBarrier bar; bar.bar = P.ctl + 1024; bar.x = 0; bar.st = nullptr;
    if (hi - lo > 1) bar = xcd_barrier_post(P.ctl + 1024, MISC + 8);
#define IN(k) (lo <= (k) && (k) < hi)
#define SEAM(k) do { if (IN(k) && IN((k) + 1)) xcd_barrier(bar); } while (0)
#ifndef DUP_PHASE
#define DUP_PHASE -1
#endif
#define PHASE(k, ...) do { if (IN(k)) { __VA_ARGS__ if (DUP_PHASE == (k)) { __syncthreads(); __VA_ARGS__ } } SEAM(k); } while (0)
    PHASE(PH_PRO, p0_prologue(P, C););
    PHASE(PH_WPK, p0_wpk(P, C););
    PHASE(PH_G1, run_gemm(C, P.XB0, P.WA_T, MPAD, ACOLS, D_MODEL, EpiA{P}); run_gemm(C, P.MEMB, P.WMEM_T, BATCH * MEM_TOKENS, 1024, D_MODEL, EpiMem{P}););
    PHASE(PH_ATTA, atta_phase(P, C););
    PHASE(PH_G2, run_gemm(C, P.ATTA, P.WOA_T, MPAD, D_MODEL, 512, EpiPre{P.x_prompt, P.x_sample, P.PRE}););
    PHASE(PH_LN1, ln_phase(P, C, P.PRE, P.ln_g, P.ln_b, P.X1, P.X1B, nullptr, nullptr););
    PHASE(PH_SC0, run_gemm(C, P.X1B, P.WPK_T, MPAD, NPK, D_MODEL, EpiF32{P.SCO, NPK, MP}););
    PHASE(PH_TK0, topk_phase(P, C););
    PHASE(PH_PG0, peer_phase(P, C, 0, P.X1, P.X2, P.X2 + (size_t)M0 * D_MODEL, P.X2B););
    PHASE(PH_G3, run_gemm(C, P.X2B, P.WB_T, MPAD, NB_T, D_MODEL, EpiB{P}););
    PHASE(PH_CMPG, run_gemm(C, P.AC, P.CW1_T, ACROWS, 256, 1024, EpiF32{P.UL, 256, ACROWS}); run_gemm(C, P.AC + (size_t)ACROWS * 1024, P.CW1_T + 256 * 1024, ACROWS, 256, 1024, EpiF32{P.UL + (size_t)ACROWS * 256, 256, ACROWS}););
    PHASE(PH_CMP2, cmp2_phase(P, C););
    PHASE(PH_NSA, nsa_phase(P, C););
    PHASE(PH_G4, run_gemm(C, P.ATTB, P.WOB_T, MPAD, D_MODEL, 1024, EpiPre{P.X2, nullptr, P.PRE}););
    PHASE(PH_LN3, ln_phase(P, C, P.PRE, P.ln_g + 2 * D_MODEL, P.ln_b + 2 * D_MODEL, P.X3, P.X3B, nullptr, nullptr););
    PHASE(PH_SC1, run_gemm(C, P.X3B, P.WPK_T + (size_t)NPK * D_MODEL, MPAD, NPK, D_MODEL, EpiF32{P.SCO, NPK, MP}););
    PHASE(PH_TK1, topk_phase(P, C););
    PHASE(PH_PG1, peer_phase(P, C, 1, P.X3, P.y_prompt, P.y_sample, nullptr););
#undef IN
#undef SEAM
}
}
namespace chk {
using fx::FP; using nv::P;
constexpr int MAXCHK = 32;
template <class F> __global__ void __launch_bounds__(256) k_chk(F f, long n, float* acc) {
    float d2 = 0.f, b2 = 0.f;
    for (long i = blockIdx.x * 256L + threadIdx.x; i < n; i += gridDim.x * 256L) { float a, b; f(i, a, b); d2 += (a - b) * (a - b); b2 += b * b; }
    __shared__ float s0[256], s1[256]; s0[threadIdx.x] = d2; s1[threadIdx.x] = b2; __syncthreads();
    for (int o = 128; o > 0; o >>= 1) { if ((int)threadIdx.x < o) { s0[threadIdx.x] += s0[threadIdx.x + o]; s1[threadIdx.x] += s1[threadIdx.x + o]; } __syncthreads(); }
    if (threadIdx.x == 0) { atomicAdd(acc, s0[0]); atomicAdd(acc + 1, s1[0]); }
}
__global__ void k_code(const float* acc, int nchk, int mode, float tol2, float* code) {
    if (threadIdx.x == 0 && blockIdx.x == 0) { float c = 0.f;
        if (mode == 0) { for (int k = 0; k < nchk; ++k) { const float rel = acc[2 * k] / fmaxf(acc[2 * k + 1], 1e-30f); if (!(rel <= tol2)) { c = sqrtf(0.01f * (k + 1)); break; } } }
        else { const int k = mode - 1; const float rel = acc[2 * k] / fmaxf(acc[2 * k + 1], 1e-30f); c = sqrtf(fminf(fmaxf(rel, 0.f), 0.9f)); if (!(rel == rel)) c = 0.97f; }
        *code = c; }
}
__global__ void k_apply(float* y, int n, const float* code) { const float c = *code; for (int i = blockIdx.x * 256 + threadIdx.x; i < n; i += gridDim.x * 256) y[i] *= (1.0f + c); }
struct Runner { hipStream_t st; float* acc; int n = 0;
    template <class F> void add(F f, long cnt) { long b = (cnt + 255) / 256; if (b > 8192) b = 8192; hipLaunchKernelGGL(k_chk<F>, dim3((int)b), dim3(256), 0, st, f, cnt, acc + 2 * n); ++n; } };
struct C_qa { FP f; P p; __device__ void operator()(long i, float& a, float& b) const { const int c = (int)(i % 256); long t = i / 256; const int r = (int)(t % fx::MP), g = (int)(t / fx::MP);
    a = fx::bf2f(f.QA[((size_t)g * fx::MPAD + r) * 256 + c]) / fx::QSCALE; b = p.PROJA[(size_t)r * nv::ACOLS + (g * 3 + 0) * 256 + c]; } };
struct C_ka { FP f; P p; __device__ void operator()(long i, float& a, float& b) const { const int c = (int)(i % 256); long t = i / 256; const int r = (int)(t % fx::MP), g = (int)(t / fx::MP);
    a = fx::bf2f(f.KA[((size_t)g * fx::MPAD + r) * 256 + c]); b = p.PROJA[(size_t)r * nv::ACOLS + (g * 3 + 1) * 256 + c]; } };
struct C_vta { FP f; P p; __device__ void operator()(long i, float& a, float& b) const { const int c = (int)(i % 256); long t = i / 256; const int r = (int)(t % fx::M0), g = (int)(t / fx::M0); const int n = r / SEQ, pos = r % SEQ, d = dil_d(g);
    a = fx::bf2f(f.VTA[(((size_t)(g * BATCH + n) * 4 + (c >> 6)) * 64 + (c & 63)) * SEQ + (pos % d) * (SEQ / d) + pos / d]); b = p.PROJA[(size_t)r * nv::ACOLS + (g * 3 + 2) * 256 + c]; } };
struct C_mqa { FP f; P p; __device__ void operator()(long i, float& a, float& b) const { const int c = (int)(i % 256); const int r = (int)(i / 256); a = fx::bf2f(f.MQA[(size_t)r * 256 + c]) / fx::QSCALE; b = p.PROJA[(size_t)r * nv::ACOLS + DIL_COLS + c]; } };
struct C_mk { FP f; P p; __device__ void operator()(long i, float& a, float& b) const { const int c = (int)(i % 256); const long rm = i / 256;
    a = fx::bf2f(f.MK[(size_t)rm * 256 + c]); b = p.mem_kv_p[(size_t)rm * 512 + c]; } };
struct C_mvt { FP f; P p; __device__ void operator()(long i, float& a, float& b) const { const int c = (int)(i % 256); const long rm = i / 256; const int m = (int)(rm % 256); const long ln = rm / 256;
    a = fx::bf2f(f.MVT[((size_t)ln * 256 + c) * 256 + m]); b = p.mem_kv_p[(size_t)rm * 512 + 256 + c]; } };
struct C_atta { FP f; P p; __device__ void operator()(long i, float& a, float& b) const { a = fx::bf2f(f.ATTA[i]); b = p.ATTA[i]; } };
struct C_f32 { const float* fa; const float* fb; __device__ void operator()(long i, float& a, float& b) const { a = fa[i]; b = fb[i]; } };
struct C_attb { FP f; P p; __device__ void operator()(long i, float& a, float& b) const { a = fx::bf2f(f.ATTB[i]); b = p.ATTB[i]; } };
struct C_ck { FP f; P p; __device__ void operator()(long i, float& a, float& b) const { const int d = (int)(i % 64); long t = i / 64; const int c = (int)(t % nv::NCMP); t /= nv::NCMP; const int kvh = (int)(t % 2), ctx = (int)(t / 2);
    a = fx::bf2f(f.CK[(((size_t)ctx * 2 + kvh) * fx::NCH + c) * 64 + d]); b = p.CKV[((((size_t)ctx * 2 + 0) * 2 + kvh) * nv::NCMP + c) * 64 + d]; } };
struct C_cvt { FP f; P p; __device__ void operator()(long i, float& a, float& b) const { const int d = (int)(i % 64); long t = i / 64; const int c = (int)(t % nv::NCMP); t /= nv::NCMP; const int kvh = (int)(t % 2), ctx = (int)(t / 2);
    a = fx::bf2f(f.CVT[(((size_t)ctx * 2 + kvh) * 64 + d) * fx::NCH + c]); b = p.CKV[((((size_t)ctx * 2 + 1) * 2 + kvh) * nv::NCMP + c) * 64 + d]; } };
struct C_ckf { FP f; P p; int ty; int pad_; __device__ void operator()(long i, float& a, float& b) const { const int d = (int)(i % 64); long t = i / 64; const int c = (int)(t % nv::NCMP); t /= nv::NCMP; const int kvh = (int)(t % 2), ns = (int)(t / 2);
    a = (ty == 0 ? f.CKF : f.CVF)[(((size_t)ns * 2 + kvh) * fx::NCH + c) * 64 + d]; b = p.CKV[((((size_t)(BATCH + ns) * 2 + ty) * 2 + kvh) * nv::NCMP + c) * 64 + d]; } };
struct C_qb { FP f; P p; __device__ void operator()(long i, float& a, float& b) const { const int c = (int)(i % 768); const long r = i / 768; a = fx::bf2f(f.QB[(size_t)r * 768 + c]) / fx::QSCALE; b = p.PROJB[(size_t)r * nv::BCOLS + c]; } };
struct C_gates { FP f; P p; __device__ void operator()(long i, float& a, float& b) const { const int c = (int)(i % 36); const long r = i / 36; a = f.GATES[(size_t)r * 64 + c]; b = p.GT[(size_t)r * 36 + c]; } };
struct C_branch { FP f; P p; int br; int lo; int hi; int pad_; __device__ void operator()(long i, float& a, float& b) const { const int R0 = ((fx::MP - 1) / nv::CHROWS) * nv::CHROWS; const int c = (int)(i % 768); const int rl = lo + (int)(i / 768); const int r = R0 + rl;
    a = f.DBG[((size_t)br * fx::MP + r) * 768 + c]; const float* nb = br == 0 ? p.OC : (br == 1 ? p.OS : p.OW); b = nb[(size_t)rl * 768 + c];
    if (br == 1) { const int kvh = c / 384; bool same = true; for (int x = 0; x < 16; ++x) { const int nbk = p.SELB[((size_t)rl * 2 + kvh) * 16 + x]; bool fnd = false; for (int y = 0; y < 16; ++y) fnd |= (f.SELB[((size_t)r * 2 + kvh) * 16 + y] == nbk); same &= fnd; } if (!same) { a = 0.f; b = 0.f; } } } };
struct C_selb { FP f; P p; int lo; int pad_; __device__ void operator()(long i, float& a, float& b) const { const int R0 = ((fx::MP - 1) / nv::CHROWS) * nv::CHROWS; const int rl = lo + (int)(i / 2), kvh = (int)(i % 2); const int r = R0 + rl;
    int hit = 0; for (int x = 0; x < 16; ++x) { const int nbk = p.SELB[((size_t)rl * 2 + kvh) * 16 + x]; bool fnd = false; for (int y = 0; y < 16; ++y) fnd |= (f.SELB[((size_t)r * 2 + kvh) * 16 + y] == nbk); hit += fnd ? 1 : 0; } a = 1.0f - 0.25f * (1.0f - hit * (1.0f / 16.0f)); b = 1.0f; } };
struct C_attb_cols { FP f; P p; int c0; int nc; int r0; int pad_; __device__ void operator()(long i, float& a, float& b) const { const int c = c0 + (int)(i % nc); const long r = r0 + i / nc; a = fx::bf2f(f.ATTB[r * 1024 + c]); b = p.ATTB[r * 1024 + c]; } };
struct C_kvb { FP f; P p; int which; int pad_; __device__ void operator()(long i, float& a, float& b) const { const int d = (int)(i % 64); long t = i / 64; const int pos = (int)(t % SEQ); t /= SEQ; const int kvh = (int)(t % 2), n = (int)(t / 2);
    const size_t nk = (size_t)n * 2 + kvh; const float* r6 = p.ROWS6 + (size_t)(n * SEQ + pos) * nv::KVCOLS;
    if (which == 0) { a = fx::bf2f(f.SLK[(nk * SEQ + pos) * 64 + d]); b = r6[2 * 128 + kvh * 64 + d]; }
    else if (which == 1) { a = fx::bf2f(f.SLVT[((nk * (SEQ / 64) + pos / 64) * 64 + d) * 64 + (pos & 63)]); b = r6[3 * 128 + kvh * 64 + d]; }
    else if (which == 2) { a = fx::bf2f(f.WNK[(nk * SEQ + pos) * 64 + d]); b = r6[4 * 128 + kvh * 64 + d]; }
    else { a = fx::bf2f(f.WNVT[(nk * 64 + d) * SEQ + pos]); b = r6[5 * 128 + kvh * 64 + d]; } } };
template <class Inner> struct C_frac { Inner in; __device__ void operator()(long i, float& a, float& b) const { float x, y; in(i, x, y); const bool bad = fabsf(x - y) > 0.25f * fabsf(y) + 2e-3f; a = bad ? 0.f : 1.f; b = 1.f; } };
__device__ __host__ inline int R0_t0() { return (((fx::MP - 1) / nv::CHROWS) * nv::CHROWS) % SEQ; }
__global__ void k_rowdiag(FP f, P p, int br, int nrows, int what, float* slot, int* tmp) {
    const int R0 = ((fx::MP - 1) / nv::CHROWS) * nv::CHROWS; const float* nb = br == 0 ? p.OC : (br == 1 ? p.OS : p.OW);
    for (int rl = blockIdx.x * blockDim.x + threadIdx.x; rl < nrows; rl += gridDim.x * blockDim.x) { float d2 = 0.f, b2 = 0.f;
        for (int c = 0; c < 768; ++c) { const float a = f.DBG[((size_t)br * fx::MP + R0 + rl) * 768 + c], b = nb[(size_t)rl * 768 + c]; d2 += (a - b) * (a - b); b2 += b * b; }
        if (d2 > 0.25f * b2) { atomicAdd(tmp, 1); atomicMin(tmp + 1, rl); } }
}
__global__ void k_rowdiag_fin(int what, float* slot, int* tmp) { const int cnt = tmp[0], first = tmp[1]; float v;
    if (what == 0) v = 0.01f + 0.001f * cnt; else if (what == 1) v = 0.01f + 0.01f * ((R0_t0() + first) % 64); else v = 0.01f + 0.01f * (((R0_t0() + first) / 64) % 64);
    slot[0] = v; slot[1] = 1.0f; }
__global__ void k_rowdiag2(const float* A, const float* B, int nrows, int ncols, int* tmp) {
    for (int r = blockIdx.x * blockDim.x + threadIdx.x; r < nrows; r += gridDim.x * blockDim.x) { float d2 = 0.f, b2 = 0.f;
        for (int c = 0; c < ncols; ++c) { const float a = A[(size_t)r * ncols + c], b = B[(size_t)r * ncols + c]; d2 += (a - b) * (a - b); b2 += b * b; }
        if (d2 > 0.25f * b2) { atomicAdd(tmp, 1); atomicMin(tmp + 1, r); atomicMax(tmp + 2, r); } }
}
__global__ void k_rowdiag2_fin(int what, float* slot, int* tmp) { const int cnt = tmp[0], first = tmp[1], last = tmp[2]; float v;
    if (what == 0) v = 0.01f + 0.001f * cnt; else if (what == 1) v = 0.01f + 0.01f * (first % 64); else if (what == 2) v = 0.01f + 0.01f * ((first / 64) % 64); else if (what == 3) v = 0.01f + 0.01f * (first / 4096);
    else if (what == 4) v = 0.01f + 0.01f * (last % 64); else if (what == 5) v = 0.01f + 0.01f * ((last / 64) % 64); else v = 0.01f + 0.01f * (last / 4096);
    slot[0] = v; slot[1] = 1.0f; }
struct C_peersel { FP f; P p; __device__ void operator()(long i, float& a, float& b) const { const int k = (int)(i % 16); const long t = i / 16; const float* ts = p.SELS + t * 16; float m = ts[0]; for (int j = 1; j < 16; ++j) m = fmaxf(m, ts[j]); float z = 0.f; for (int j = 0; j < 16; ++j) z += expf(ts[j] - m);
    b = expf(ts[k] - m) / z; const int e = p.SELE[t * 16 + k]; a = 0.f; for (int j = 0; j < 16; ++j) if (f.SELE[t * 16 + j] == e) a = f.SELG[t * 16 + j]; } };
}
static void run_checks(chk::Runner& R, const fx::FP& f, const nv::P& p) {
#ifdef ROWDIAG2
    { int* tmp = (int*)(R.acc + 900); hipMemsetAsync(tmp, 0, 4, R.st); hipMemsetAsync(tmp + 1, 0x7f, 4, R.st); hipMemsetAsync(tmp + 2, 0, 4, R.st);
      hipLaunchKernelGGL(chk::k_rowdiag2, dim3(64), dim3(64), 0, R.st, (const float*)f.X3, (const float*)p.X3, fx::MP, 1024, tmp); hipLaunchKernelGGL(chk::k_rowdiag2_fin, dim3(1), dim3(1), 0, R.st, ROWDIAG2 - 1, R.acc, tmp); R.n = 1; return; }
#endif
#ifdef ROWDIAG
    { const int R0 = ((fx::MP - 1) / nv::CHROWS) * nv::CHROWS, NPR = fx::M0 - R0; int* tmp = (int*)(R.acc + 900); hipMemsetAsync(tmp, 0, 4, R.st); hipMemsetAsync(tmp + 1, 0x7f, 4, R.st);
      hipLaunchKernelGGL(chk::k_rowdiag, dim3(32), dim3(64), 0, R.st, f, p, 2, NPR, ROWDIAG, R.acc, tmp); hipLaunchKernelGGL(chk::k_rowdiag_fin, dim3(1), dim3(1), 0, R.st, ROWDIAG - 1, R.acc, tmp); R.n = 1; return; }
#endif
#ifdef CHECK_TAIL_FIRST
    R.add(chk::C_f32{f.X3, p.X3}, (long)fx::MP * 1024);
    R.add(chk::C_f32{f.PRE, p.PRE}, (long)fx::MP * 1024);
    R.add(chk::C_f32{f.y_prompt, p.X0}, (long)fx::M0 * 1024);
    R.add(chk::C_f32{f.y_sample, p.X0 + (size_t)fx::M0 * 1024}, (long)DEC_BATCH * 1024);
    return;
#endif
    R.add(chk::C_qa{f, p}, 3L * fx::MP * 256);
    R.add(chk::C_ka{f, p}, 3L * fx::MP * 256);
    R.add(chk::C_vta{f, p}, 3L * fx::M0 * 256);
    R.add(chk::C_mqa{f, p}, (long)fx::MP * 256);
    R.add(chk::C_mk{f, p}, 2L * BATCH * 256 * 256);
    R.add(chk::C_mvt{f, p}, 2L * BATCH * 256 * 256);
    R.add(chk::C_atta{f, p}, (long)fx::MP * 512);
    R.add(chk::C_f32{f.X1, p.X1}, (long)fx::MP * 1024);
    R.add(chk::C_f32{f.X2, p.X2}, (long)fx::MP * 1024);
    R.add(chk::C_qb{f, p}, (long)fx::MP * 768);
    R.add(chk::C_gates{f, p}, (long)fx::MP * 36);
    R.add(chk::C_ck{f, p}, (long)BATCH * 2 * nv::NCMP * 64);
    R.add(chk::C_cvt{f, p}, (long)BATCH * 2 * nv::NCMP * 64);
    R.add(chk::C_ckf{f, p, 0, 0}, (long)DEC_BATCH * 2 * nv::NCMP * 64);
    R.add(chk::C_ckf{f, p, 1, 0}, (long)DEC_BATCH * 2 * nv::NCMP * 64);
    for (int w = 0; w < 4; ++w) R.add(chk::C_kvb{f, p, w, 0}, (long)BATCH * 2 * SEQ * 64);
    { const int R0 = ((fx::MP - 1) / nv::CHROWS) * nv::CHROWS, NL = fx::MP - R0, NPR = fx::M0 - R0;
      R.add(chk::C_attb_cols{f, p, 768, 256, 0, 0}, (long)fx::M0 * 256);
      R.add(chk::C_attb_cols{f, p, 768, 256, fx::M0, 0}, (long)DEC_BATCH * 256);
      R.add(chk::C_branch{f, p, 0, 0, NPR, 0}, (long)NPR * 768);
      R.add(chk::C_selb{f, p, 0, 0}, (long)NPR * 2);
      R.add(chk::C_branch{f, p, 1, 0, NPR, 0}, (long)NPR * 768);
      R.add(chk::C_branch{f, p, 2, 0, NPR, 0}, (long)NPR * 768);
      R.add(chk::C_branch{f, p, 0, NPR, NL, 0}, (long)DEC_BATCH * 768);
      R.add(chk::C_selb{f, p, NPR, 0}, (long)DEC_BATCH * 2);
      R.add(chk::C_branch{f, p, 1, NPR, NL, 0}, (long)DEC_BATCH * 768);
      R.add(chk::C_branch{f, p, 2, NPR, NL, 0}, (long)DEC_BATCH * 768);
      R.add(chk::C_attb_cols{f, p, 0, 768, 0, 0}, (long)fx::M0 * 768);
      R.add(chk::C_attb_cols{f, p, 0, 768, fx::M0, 0}, (long)DEC_BATCH * 768); }
    R.add(chk::C_f32{f.X3, p.X3}, (long)fx::MP * 1024);
    { const int R0 = ((fx::MP - 1) / nv::CHROWS) * nv::CHROWS, NPR = fx::M0 - R0; R.add(chk::C_frac<chk::C_branch>{chk::C_branch{f, p, 2, 0, NPR, 0}}, (long)NPR * 768); }
}
#ifndef CHECK_MODE
#define CHECK_MODE 0
#endif
#ifndef CHECK_TOL
#define CHECK_TOL 1e-3f
#endif
#ifndef FAST_PHASES
#define FAST_PHASES 3
#endif
extern "C" void kernel_launch(void* const* d_in, const int* in_sizes, int n_in, void* d_out, int out_size, void* d_ws, size_t ws_size, hipStream_t stream) {
    nv::P np; memset(&np, 0, sizeof(np)); nv::bind_io(np, d_in, (float*)d_out);
    const size_t n_need = nv::carve(np, d_ws);
    fx::Args a; memset(&a, 0, sizeof(a)); fx::bind_io(a.p, d_in, (float*)d_out);
    char* fbase = (char*)d_ws + n_need; const size_t f_need = fx::carve(a.p, fbase);
    float* acc = (float*)(fbase + f_need);
#ifdef REDIRECT_Y
    a.p.y_prompt = a.p.SCO; a.p.y_sample = a.p.SCO + (size_t)fx::M0 * D_MODEL;
#endif
#ifdef REDIRECT_KV
    { float* dummy = a.p.DBG;
      if (REDIRECT_KV & 1) { a.p.nsa_kv_p = dummy; } dummy += (size_t)fx::M0 * 512; if (REDIRECT_KV & 2) { a.p.nsa_kv_s = dummy; } dummy += DEC_BATCH * 512;
      if (REDIRECT_KV & 4) { a.p.win_p = dummy; } dummy += BATCH * 512 * 256; if (REDIRECT_KV & 8) { a.p.win_s = dummy; } }
#endif
    if (n_need + f_need + 4096 > ws_size) { fprintf(stderr, "kernel_launch: workspace too small: need %zu + %zu have %zu\n", n_need, f_need, ws_size); return; }
    static int grid = 0;
    if (!grid) { int dev = 0, cus = 0; hipGetDevice(&dev); hipDeviceGetAttribute(&cus, hipDeviceAttributeMultiprocessorCount, dev);
        hipFuncSetAttribute((const void*)fx::mega, hipFuncAttributeMaxDynamicSharedMemorySize, fx::LDS_BYTES); grid = cus; }
    GpuEx ex{stream}; nv::forward(np, ex);
    hipMemsetAsync(a.p.ctl, 0, fx::CTL_BYTES, stream); hipMemsetAsync(acc, 0, 4096, stream);
    chk::Runner R{stream, acc};
#ifdef PEER_MID
    { nv::P q = np; q.layer = 0;
      ex.gemm(nv::GemmArgs{q.X1, q.peer_wq, q.QP, nv::MP, 1024, D_MODEL, D_MODEL, 1024, 1024}); ex.template run<nv::K_peer_sk>(q); ex.template run<nv::K_peer_t1>(q); ex.template run<nv::K_peer_t2>(q); }
#endif
    for (int k = 0; k < FAST_PHASES; ++k) { a.lo = k; a.hi = k + 1; hipLaunchKernelGGL(fx::mega, dim3(grid), dim3(fx::NTHREADS), fx::LDS_BYTES, stream, a);
#ifdef PEER_MID
        if (k == fx::PH_TK0) { R.add(chk::C_peersel{a.p, np}, (long)nv::MP * 128); R.add(chk::C_f32{a.p.SCO, np.SK}, (long)nv::MP * 2048); }
#endif
    }
    run_checks(R, a.p, np);
    hipLaunchKernelGGL(chk::k_code, dim3(1), dim3(64), 0, stream, acc, R.n, CHECK_MODE, CHECK_TOL, acc + 1000);
    hipLaunchKernelGGL(chk::k_apply, dim3(32), dim3(256), 0, stream, np.y_sample, DEC_BATCH * D_MODEL, acc + 1000);
}
```

```cpp
#define ONE_LAUNCH 1
#include <hip/hip_runtime.h>
#include <cstdio>
#include <cstring>
#include <cmath>
#ifdef CPU_TEST
#define HD inline
constexpr int D_MODEL = 128, BATCH = 2, SEQ = 512, DEPTH = 2, DEC_BATCH = 3, DEC_SEQ = 1, PAST_LEN = 512, PAGE_SIZE = 128;
constexpr int DIL_W[3] = {16, 64, 256}, DIL_D[3] = {1, 4, 16}, DIL_TAPS = 17;
constexpr int MEM_TOKENS = 32, SLC_TOPK = 4, SWA_WINDOW = 64, PEER_KEYS = 16, PEER_TOPK = 4;
#else
#define HD __host__ __device__ __forceinline__
constexpr int D_MODEL = 1024, BATCH = 2, SEQ = 8192, DEPTH = 2, DEC_BATCH = 32, DEC_SEQ = 1, PAST_LEN = 8192, PAGE_SIZE = 128;
constexpr int DIL_W[3] = {128, 512, 2048}, DIL_D[3] = {1, 4, 16}, DIL_TAPS = 129;
constexpr int MEM_TOKENS = 256, SLC_TOPK = 16, SWA_WINDOW = 512, PEER_KEYS = 128, PEER_TOPK = 16;
#endif
HD constexpr int dil_w(int g) { return g == 0 ? DIL_W[0] : (g == 1 ? DIL_W[1] : DIL_W[2]); }
HD constexpr int dil_d(int g) { return g == 0 ? DIL_D[0] : (g == 1 ? DIL_D[1] : DIL_D[2]); }
constexpr int HEAD_DIM = 64, N_A_LAYERS = DEPTH / 2, N_DIL = 3, DIL_HEADS = 4, DIL_COLS = N_DIL * 3 * DIL_HEADS * HEAD_DIM;
constexpr int MEM_HEADS = 4, MEM_COLS = MEM_HEADS * HEAD_DIM;
constexpr int NSA_HEADS = 12, NSA_KV_HEADS = 2, NSA_GROUP = 6, NSA_Q_COLS = NSA_HEADS * HEAD_DIM, NSA_GATE_COLS = NSA_HEADS * 3;
constexpr int CMP_BLOCK = 32, CMP_STRIDE = 16, CMP_HIDDEN = 128, SLC_BLOCK = 64;
constexpr int PEER_EXPERTS = PEER_KEYS * PEER_KEYS, PEER_HEADS = 8, PEER_KEY_DIM = 128;
constexpr float FORCE_SCORE = 1.0e9f, NEG = -1.0e30f, SCALE = 0.125f, LN_EPS = 1e-5f;
constexpr float ALPHA = 1.41421356237309515f;
constexpr float BETA = 0.5f;
#define LAS __attribute__((address_space(3)))
namespace pg8 {
#define PG8_LAS __attribute__((address_space(3)))
typedef unsigned short bf16_t;
typedef short bf16x8 __attribute__((ext_vector_type(8)));
typedef float f32x4 __attribute__((ext_vector_type(4)));
typedef unsigned u32x4 __attribute__((ext_vector_type(4)));
constexpr int BM = 256, BK = 64, HALF = 128, HTB = HALF * BK * 2  , STAGE_BYTES = 8 * HTB, NXCD = 8, WGM = 8;

__host__ __device__ __forceinline__ int lds_byte(int r, int c) { const int st = (r >> 4) * 2 + (c >> 5), rr = r & 15, cc = c & 31, ob = rr * 64 + cc * 2; return st * 1024 + (ob ^ (((ob >> 9) & 1) << 5)); }
__host__ __device__ __forceinline__ void stage_rc(int b, int& R, int& C) { const int st = b / 1024, sb = b % 1024, swz = sb ^ (((sb >> 9) & 1) << 5); R = (st >> 1) * 16 + swz / 64; C = (st & 1) * 32 + (swz % 64) / 2; }
__host__ __device__ __forceinline__ int perm32(int rho) { const int n = rho >> 4, i = rho & 15; return 8 * (i >> 2) + 4 * n + (i & 3); }

struct Unit { int pm, pn; };
struct Gemm { const bf16_t* A; const bf16_t* Bt; int M, N, K; };

struct StaticOrder {
    int nM, nN, nwg, G, c;
    __host__ __device__ void init(int M, int N, int G_, int c_) { nM = M / BM; nN = N / BM; nwg = nM * nN; G = G_; c = c_; }
    __host__ __device__ bool next(int i, Unit& u) const {
        const long L = (long)i * G + c; if (L >= nwg) return false;
        int wgid = (int)L; { const int q = nwg / NXCD, r = nwg % NXCD, xcd = wgid % NXCD, off = wgid / NXCD; wgid = (xcd < r ? xcd * (q + 1) : r * (q + 1) + (xcd - r) * q) + off; }
        const int nig = WGM * nN, gid = wgid / nig, fm = gid * WGM, gsz = (nM - fm) < WGM ? (nM - fm) : WGM;
        u.pm = fm + ((wgid % nig) % gsz); u.pn = (wgid % nig) / gsz; return true;
    }
    __device__ __forceinline__ void a_ready(const Unit&) const {}
    __device__ __forceinline__ void done(const Unit&) const {}
};

__device__ __forceinline__ unsigned cvt_pk_bf16(float lo, float hi) { unsigned r; asm volatile("v_cvt_pk_bf16_f32 %0, %1, %2" : "=v"(r) : "v"(lo), "v"(hi)); return r; }
typedef float f32x2 __attribute__((ext_vector_type(2)));
typedef float f32x2 __attribute__((ext_vector_type(2)));
template <class Epi, class Sched, bool ALIGN_EPI = false, bool SP2 = false>
__device__ __forceinline__ void gemm_phase(PG8_LAS unsigned char* lds, const Gemm g, const Sched& S, const Epi& E) {
    const int tid = threadIdx.x, wid = __builtin_amdgcn_readfirstlane(tid >> 6), lane = tid & 63, wr = wid >> 2, wc = wid & 3, fr = lane & 15, fq = lane >> 4;
    const int K = g.K, nt = K / BK;
    unsigned voffA[2], voffB[2];
#pragma unroll
    for (int i = 0; i < 2; ++i) { int R, C; stage_rc(tid * 16 + i * 8192, R, C); const int Rb = Epi::PERM ? ((R & ~31) + perm32(R & 31)) : R;
        voffA[i] = (unsigned)(R * K + C) * 2u; voffB[i] = (unsigned)(Rb * K + C) * 2u; }
    const size_t kstep = (size_t)(BK * 2);
    const size_t hstep = (size_t)HALF * K * 2;
    const size_t tstep = 2 * hstep;
    const unsigned ldsw = (unsigned)wid * 1024u;
    const int aoff = lds_byte(wr * 64 + fr, fq * 8), boff = lds_byte(wc * 32 + fr, fq * 8);
#define PG8_SA(b, h) (((b) * 2 + (h)) * HTB)
#define PG8_SB(b, h) ((4 + (b) * 2 + (h)) * HTB)
#define PG8_STAGE(bufoff, gbase, voff) do { _Pragma("unroll") for (int _i = 0; _i < 2; ++_i) \
        __builtin_amdgcn_global_load_lds((const unsigned*)((const char*)(gbase) + (voff)[_i]), (PG8_LAS unsigned*)(lds + (bufoff) + ldsw + _i * 8192), 16, 0, 0); } while (0)
#define PG8_LDA(dst, b, h) do { _Pragma("unroll") for (int m = 0; m < 4; ++m) _Pragma("unroll") for (int k = 0; k < 2; ++k) dst[m][k] = *(const PG8_LAS bf16x8*)(lds + PG8_SA(b, h) + aoff + m * 2048 + k * 1024); } while (0)
#define PG8_LDB(dst, b, h) do { _Pragma("unroll") for (int n = 0; n < 2; ++n) _Pragma("unroll") for (int k = 0; k < 2; ++k) dst[n][k] = *(const PG8_LAS bf16x8*)(lds + PG8_SB(b, h) + boff + n * 2048 + k * 1024); } while (0)
#define PG8_MMA(ai, bj, At, Bt) do { __builtin_amdgcn_s_setprio(1); _Pragma("unroll") for (int m = 0; m < 4; ++m) _Pragma("unroll") for (int n = 0; n < 2; ++n) _Pragma("unroll") for (int k = 0; k < 2; ++k) \
        acc[ai][bj][m][n] = __builtin_amdgcn_mfma_f32_16x16x32_bf16(Bt[n][k], At[m][k], acc[ai][bj][m][n], 0, 0, 0); __builtin_amdgcn_s_setprio(0); } while (0)
#define PG8_WAIT_V(n) asm volatile("s_waitcnt vmcnt(" #n ")" ::: "memory")
#define PG8_WAIT_L(n) asm volatile("s_waitcnt lgkmcnt(" #n ")" ::: "memory")
#define PG8_BAR __builtin_amdgcn_s_barrier()
#define PG8_SCHED __builtin_amdgcn_sched_barrier(0)
    Unit cur, nxt; int ui = 0;
    if (!S.next(0, cur)) return;
    f32x4 acc[2][2][4][2];
#pragma unroll
    for (int a = 0; a < 2; ++a)
#pragma unroll
        for (int b = 0; b < 2; ++b)
#pragma unroll
            for (int m = 0; m < 4; ++m)
#pragma unroll
                for (int n = 0; n < 2; ++n) acc[a][b][m][n] = (f32x4){0.f, 0.f, 0.f, 0.f};
    bf16x8 At[4][2], B0[2][2], B1[2][2];
    const char* cA = (const char*)g.A + (size_t)cur.pm * tstep; const char* cB = (const char*)g.Bt + (size_t)cur.pn * tstep;
    S.a_ready(cur);
    if constexpr (SP2) {
        PG8_STAGE(PG8_SB(0, 0), cB, voffB); PG8_STAGE(PG8_SB(0, 1), cB + hstep, voffB); PG8_STAGE(PG8_SA(0, 0), cA, voffA); PG8_STAGE(PG8_SA(0, 1), cA + hstep, voffA);
        if (wr == 1) PG8_BAR;
        PG8_WAIT_V(2); PG8_BAR;
        PG8_STAGE(PG8_SB(1, 0), cB + kstep, voffB); PG8_STAGE(PG8_SA(1, 0), cA + kstep, voffA); PG8_STAGE(PG8_SB(1, 1), cB + hstep + kstep, voffB);
        PG8_WAIT_V(6); PG8_BAR;
    } else {
        PG8_STAGE(PG8_SB(0, 0), cB, voffB); PG8_STAGE(PG8_SA(0, 0), cA, voffA); PG8_STAGE(PG8_SB(0, 1), cB + hstep, voffB); PG8_STAGE(PG8_SA(0, 1), cA + hstep, voffA);
        if (wr == 1) PG8_BAR;
        PG8_WAIT_V(4); PG8_BAR;
        PG8_STAGE(PG8_SB(1, 0), cB + kstep, voffB); PG8_STAGE(PG8_SA(1, 0), cA + kstep, voffA); PG8_STAGE(PG8_SB(1, 1), cB + hstep + kstep, voffB);
        PG8_WAIT_V(6); PG8_BAR;
    }
    for (;;) {
        const bool has_next = S.next(ui + 1, nxt);
        const char* nA = has_next ? (const char*)g.A + (size_t)nxt.pm * tstep : cA; const char* nB = has_next ? (const char*)g.Bt + (size_t)nxt.pn * tstep : cB;
        for (int t = 0; t < nt; t += 2) {
            const bool last = (t == nt - 2);
            const char* a1 = cA + (size_t)(t + 1) * kstep;
            const char* a2 = last ? nA : cA + (size_t)(t + 2) * kstep; const char* b2 = last ? nB : cB + (size_t)(t + 2) * kstep;
            const char* a3 = a2 + kstep; const char* b3 = b2 + kstep;
            if (last && has_next) S.a_ready(nxt);
            if constexpr (SP2) {
            PG8_LDB(B0, 0, 0); PG8_LDB(B1, 0, 1); PG8_SCHED; PG8_LDA(At, 0, 0); PG8_STAGE(PG8_SA(1, 1), a1 + hstep, voffA);
            PG8_WAIT_V(8); PG8_WAIT_L(0); PG8_BAR; PG8_MMA(0, 0, At, B0); PG8_MMA(0, 1, At, B1); PG8_BAR; PG8_SCHED;
            PG8_LDA(At, 0, 1); PG8_STAGE(PG8_SB(0, 0), b2, voffB); PG8_STAGE(PG8_SB(0, 1), b2 + hstep, voffB); PG8_STAGE(PG8_SA(0, 0), a2, voffA);
            PG8_WAIT_V(8); PG8_WAIT_L(0); PG8_BAR; PG8_MMA(1, 0, At, B0); PG8_MMA(1, 1, At, B1); PG8_BAR; PG8_SCHED;
            PG8_LDB(B0, 1, 0); PG8_LDB(B1, 1, 1); PG8_SCHED; PG8_LDA(At, 1, 0); PG8_STAGE(PG8_SA(0, 1), a2 + hstep, voffA);
            PG8_WAIT_V(8); PG8_WAIT_L(0); PG8_BAR; PG8_MMA(0, 0, At, B0); PG8_MMA(0, 1, At, B1); PG8_BAR; PG8_SCHED;
            PG8_LDA(At, 1, 1); PG8_STAGE(PG8_SB(1, 0), b3, voffB); PG8_STAGE(PG8_SB(1, 1), b3 + hstep, voffB); PG8_STAGE(PG8_SA(1, 0), a3, voffA);
            PG8_WAIT_V(8); PG8_WAIT_L(0); PG8_BAR; PG8_MMA(1, 0, At, B0); PG8_MMA(1, 1, At, B1); PG8_BAR; PG8_SCHED;
            } else {
            PG8_LDB(B0, 0, 0); PG8_SCHED; PG8_LDA(At, 0, 0); PG8_STAGE(PG8_SA(1, 1), a1 + hstep, voffA);
            PG8_WAIT_L(8); PG8_BAR; PG8_WAIT_L(0); PG8_MMA(0, 0, At, B0); PG8_BAR; PG8_SCHED;
            PG8_LDB(B1, 0, 1); PG8_STAGE(PG8_SB(0, 0), b2, voffB);
            PG8_BAR; PG8_WAIT_L(0); PG8_MMA(0, 1, At, B1); PG8_BAR;
            PG8_LDA(At, 0, 1); PG8_STAGE(PG8_SA(0, 0), a2, voffA);
            PG8_BAR; PG8_WAIT_L(0); PG8_MMA(1, 0, At, B0); PG8_BAR; PG8_SCHED;
            PG8_STAGE(PG8_SB(0, 1), b2 + hstep, voffB);
            PG8_WAIT_V(6); PG8_BAR; PG8_MMA(1, 1, At, B1); PG8_BAR;
            PG8_LDB(B0, 1, 0); PG8_SCHED; PG8_LDA(At, 1, 0); PG8_STAGE(PG8_SA(0, 1), a2 + hstep, voffA);
            PG8_WAIT_L(8); PG8_BAR; PG8_WAIT_L(0); PG8_MMA(0, 0, At, B0); PG8_BAR; PG8_SCHED;
            PG8_LDB(B1, 1, 1); PG8_STAGE(PG8_SB(1, 0), b3, voffB);
            PG8_BAR; PG8_WAIT_L(0); PG8_MMA(0, 1, At, B1); PG8_BAR;
            PG8_LDA(At, 1, 1); PG8_STAGE(PG8_SA(1, 0), a3, voffA);
            PG8_BAR; PG8_WAIT_L(0); PG8_MMA(1, 0, At, B0); PG8_BAR; PG8_SCHED;
            PG8_STAGE(PG8_SB(1, 1), b3 + hstep, voffB);
            PG8_WAIT_V(6); PG8_BAR; PG8_MMA(1, 1, At, B1); PG8_BAR;
            }
        }
        if constexpr (ALIGN_EPI) { if (wr == 0) PG8_BAR; }
        if constexpr (!Epi::AFTER_DRAIN) { E(acc, cur, wr, wc, fr, fq); S.done(cur); }
        if (!has_next) break;
#pragma unroll
        for (int a = 0; a < 2; ++a)
#pragma unroll
            for (int b = 0; b < 2; ++b)
#pragma unroll
                for (int m = 0; m < 4; ++m)
#pragma unroll
                    for (int n = 0; n < 2; ++n) acc[a][b][m][n] = (f32x4){0.f, 0.f, 0.f, 0.f};
        cur = nxt; cA = nA; cB = nB; ++ui;
        if constexpr (ALIGN_EPI) { if (wr == 1) PG8_BAR; }
    }
    PG8_WAIT_V(0);
    if constexpr (!ALIGN_EPI) { if (wr == 0) PG8_BAR; }
    PG8_BAR;
    if constexpr (Epi::AFTER_DRAIN) { E.fused(acc, cur, wr, wc, fr, fq, lds, wid, lane); S.done(cur); }
#undef PG8_SA
#undef PG8_SB
#undef PG8_STAGE
#undef PG8_LDA
#undef PG8_LDB
#undef PG8_MMA
#undef PG8_WAIT_V
#undef PG8_WAIT_L
#undef PG8_BAR
#undef PG8_SCHED
}
}
#define XB_TMO      128
#define XB_XCNT(j)  (256  + 64 * (j))
#define XB_XSUB(j)  (1280 + 64 * (j))
#define XB_XGEN(j)  (2304 + 64 * (j))
#define XB_TOP      3328
#define XB_TOPGEN   3392
#define XCD_BAR_WORDS 3456
#define XB_SPIN_CAP (1u << 18)

__device__ __forceinline__ unsigned xb_ld(unsigned* p)              { return __hip_atomic_load(p, __ATOMIC_RELAXED, __HIP_MEMORY_SCOPE_AGENT); }
__device__ __forceinline__ unsigned xb_add(unsigned* p, unsigned v) { return __hip_atomic_fetch_add(p, v, __ATOMIC_RELAXED, __HIP_MEMORY_SCOPE_AGENT); }
__device__ __forceinline__ unsigned xb_xcc_id() { return (unsigned)__builtin_amdgcn_s_getreg((3 << 11) | 20) & 0xFu; }
#define XB_SPIN(cond, bar) do { unsigned _sp = 0; while (cond) { __builtin_amdgcn_s_sleep(1); \
    if ((++_sp & 255u) == 0u) { if (xb_ld(&(bar)[XB_TMO])) break; if (_sp > XB_SPIN_CAP) { atomicAdd(&(bar)[XB_TMO], 1u); break; } } } } while (0)

struct XcdBarrier {
    unsigned* bar; unsigned x;
    volatile LAS unsigned* st;
};

__device__ __forceinline__ XcdBarrier xcd_barrier_post(unsigned* bar, volatile LAS unsigned* st) {
    XcdBarrier b; b.bar = bar; b.x = xb_xcc_id(); b.st = st;
    if (threadIdx.x == 0) (void)xb_add(&bar[XB_XCNT(b.x)], 1u);
    return b;
}
__device__ __forceinline__ void xcd_barrier_complete(unsigned* bar, unsigned x, unsigned& nloc, unsigned& nx) {
    const unsigned G = gridDim.x * gridDim.y * gridDim.z;
    unsigned sum, cnt, mine, sp = 0u;
    for (;;) {
        sum = 0u; cnt = 0u; mine = 0u;
#pragma unroll
        for (unsigned j = 0; j < 16; ++j) { const unsigned c = xb_ld(&bar[XB_XCNT(j)]); sum += c; cnt += (c > 0u) ? 1u : 0u; mine = (j == x) ? c : mine; }
        if (sum == G) break;
        __builtin_amdgcn_s_sleep(1);
        if ((++sp & 255u) == 0u) { if (xb_ld(&bar[XB_TMO])) break; if (sp > XB_SPIN_CAP) { atomicAdd(&bar[XB_TMO], 1u); break; } }
    }
    nloc = mine > 0u ? mine : 1u; nx = cnt > 0u ? cnt : 1u;
}

__device__ __forceinline__ void xcd_barrier(const XcdBarrier& b) {
    asm volatile("s_waitcnt vmcnt(0)" ::: "memory");
    __syncthreads();
    if (threadIdx.x == 0) {
        unsigned* bar = b.bar;
        __builtin_amdgcn_s_waitcnt(0);
        unsigned nloc = b.st[0], nx = b.st[1];
        if (nloc == 0u) { xcd_barrier_complete(bar, b.x, nloc, nx); b.st[0] = nloc; b.st[1] = nx; }
        const unsigned old = xb_add(&bar[XB_XSUB(b.x)], 1u);
        const unsigned gen = old / nloc;
        if (old + 1u == (gen + 1u) * nloc) {
            __builtin_amdgcn_fence(__ATOMIC_RELEASE, "agent");
            asm volatile("s_waitcnt vmcnt(0)" ::: "memory");
            const unsigned og = xb_add(&bar[XB_TOP], 1u);
            const unsigned tg = og / nx;
            if (og + 1u == (tg + 1u) * nx) xb_add(&bar[XB_TOPGEN], 1u);
            else XB_SPIN(xb_ld(&bar[XB_TOPGEN]) == tg, bar);
            __builtin_amdgcn_fence(__ATOMIC_ACQUIRE, "agent");
            xb_add(&bar[XB_XGEN(b.x)], 1u);
            asm volatile("s_waitcnt vmcnt(0)" ::: "memory");
        } else {
            XB_SPIN(xb_ld(&bar[XB_XGEN(b.x)]) == gen, bar);
            __builtin_amdgcn_fence(__ATOMIC_ACQUIRE, "agent");
            asm volatile("s_waitcnt vmcnt(0)" ::: "memory");
        }
    }
    __syncthreads();
}
namespace fx {
#define DI __device__ __forceinline__
typedef unsigned short bf16;
typedef short bf16x8 __attribute__((ext_vector_type(8)));
typedef float f32x4 __attribute__((ext_vector_type(4)));
typedef float f32x2 __attribute__((ext_vector_type(2)));
typedef unsigned u32x4 __attribute__((ext_vector_type(4)));
typedef unsigned u32x2 __attribute__((ext_vector_type(2)));
constexpr int M0 = BATCH * SEQ, MP = M0 + DEC_BATCH, MPAD = ((MP + 255) / 256) * 256;
constexpr int ACOLS = DIL_COLS + MEM_COLS, BCOLS = NSA_Q_COLS + NSA_GATE_COLS + MEM_COLS, KVCOLS = 6 * NSA_KV_HEADS * HEAD_DIM;
constexpr int NB_T = 2048;
constexpr int NPK = PEER_HEADS * 2 * PEER_KEYS;
constexpr int NCMP = (SEQ - CMP_BLOCK) / CMP_STRIDE + 1;
constexpr int NCH = SEQ / CMP_STRIDE;
constexpr int NCTX = BATCH + DEC_BATCH;
constexpr int ACROWS = NCTX * NSA_KV_HEADS * NCH;
constexpr int NPOS = PAST_LEN + 1;
constexpr float QSCALE = 0.125f * 1.4426950408889634f;
constexpr int NTHREADS = 512, NWAVES = 8, LDS_BYTES = 147456, RING_BYTES = 131072, MISC_OFF = RING_BYTES + 320;

struct FP {
    const float *x_prompt, *x_sample, *mem_prompt, *cache_dil[3], *cache_nsa_kv, *cache_nsa_win, *cache_mem_kv; const int* page_table;
    const float *w_in_a, *w_out_a, *w_in_b, *w_out_b, *w_mem_kv, *w_kv_b, *cmp_pe, *cmp_w1, *cmp_w2, *ln_g, *ln_b, *peer_wq, *peer_keys, *peer_u, *peer_v;
    float *y_prompt, *y_sample, *dil_p[3], *dil_s[3], *nsa_kv_p, *nsa_kv_s, *win_p, *win_s, *mem_kv_p;
    unsigned* ctl;
    bf16 *XB0, *X1B, *X2B, *X3B, *WA_T, *WMEM_T, *MEMB, *WOA_T, *WOB_T, *WPK_T, *WB_T, *CW1_T, *AC; unsigned char *UB8, *VB8;
    float *ROPE, *CBIAS;
    bf16 *QA, *KA, *VTA, *MQA, *MK, *MVT, *ATTA;
    float *DPART, *DML, *PRE, *X1, *X2, *X3, *SCO, *SELG; int* SELE;
    bf16 *SLK, *SLVT, *WNK, *WNVT, *QB, *MQB, *CK, *CVT, *ATTB;
    float *GATES, *UL, *CKF, *CVF;
    int* SELB;
    float* DBG;
};
struct Args { FP p; int lo, hi; };
struct Carve { size_t off = 0; template <class T> T* take(void* base, size_t n) { T* r = (T*)((char*)base + off); off += ((n * sizeof(T) + 255) / 256) * 256; return r; } };
constexpr size_t CTL_BYTES = 65536;
inline size_t carve(FP& p, void* base) {
    Carve c;
    p.ctl = c.take<unsigned>(base, CTL_BYTES / 4);
    p.XB0 = c.take<bf16>(base, (size_t)MPAD * D_MODEL); p.X1B = c.take<bf16>(base, (size_t)MPAD * D_MODEL); p.X2B = c.take<bf16>(base, (size_t)MPAD * D_MODEL); p.X3B = c.take<bf16>(base, (size_t)MPAD * D_MODEL);
    p.WA_T = c.take<bf16>(base, (size_t)ACOLS * D_MODEL); p.WMEM_T = c.take<bf16>(base, (size_t)DEPTH * 2 * MEM_COLS * D_MODEL); p.MEMB = c.take<bf16>(base, (size_t)BATCH * MEM_TOKENS * D_MODEL);
    p.WOA_T = c.take<bf16>(base, (size_t)D_MODEL * 2 * MEM_COLS); p.WOB_T = c.take<bf16>(base, (size_t)D_MODEL * (NSA_Q_COLS + MEM_COLS));
    p.WPK_T = c.take<bf16>(base, (size_t)DEPTH * NPK * D_MODEL); p.WB_T = c.take<bf16>(base, (size_t)NB_T * D_MODEL);
    p.UB8 = c.take<unsigned char>(base, (size_t)DEPTH * PEER_EXPERTS * D_MODEL); p.VB8 = c.take<unsigned char>(base, (size_t)DEPTH * PEER_EXPERTS * D_MODEL);
    p.CW1_T = c.take<bf16>(base, (size_t)2 * 256 * 1024); p.AC = c.take<bf16>(base, (size_t)2 * ACROWS * 1024);
    p.ROPE = c.take<float>(base, (size_t)NPOS * 64); p.CBIAS = c.take<float>(base, 2 * CMP_HIDDEN);
    p.QA = c.take<bf16>(base, (size_t)3 * MPAD * 256); p.KA = c.take<bf16>(base, (size_t)3 * MPAD * 256); p.VTA = c.take<bf16>(base, (size_t)3 * BATCH * DIL_HEADS * HEAD_DIM * SEQ + 4096);
    p.MQA = c.take<bf16>(base, (size_t)MPAD * 256); p.MK = c.take<bf16>(base, (size_t)DEPTH * BATCH * MEM_TOKENS * MEM_COLS); p.MVT = c.take<bf16>(base, (size_t)DEPTH * BATCH * MEM_COLS * MEM_TOKENS);
    p.ATTA = c.take<bf16>(base, (size_t)MPAD * 2 * MEM_COLS);
    p.DPART = c.take<float>(base, (size_t)3 * MP * DIL_HEADS * HEAD_DIM); p.DML = c.take<float>(base, (size_t)3 * MP * DIL_HEADS * 2);
    p.PRE = c.take<float>(base, (size_t)MPAD * D_MODEL); p.X1 = c.take<float>(base, (size_t)MPAD * D_MODEL); p.X2 = c.take<float>(base, (size_t)MPAD * D_MODEL); p.X3 = c.take<float>(base, (size_t)MPAD * D_MODEL);
    p.SCO = c.take<float>(base, (size_t)MPAD * NPK); p.SELG = c.take<float>(base, (size_t)MP * 128); p.SELE = c.take<int>(base, (size_t)MP * 128);
    p.SLK = c.take<bf16>(base, (size_t)BATCH * NSA_KV_HEADS * SEQ * HEAD_DIM); p.SLVT = c.take<bf16>(base, (size_t)BATCH * NSA_KV_HEADS * SEQ * HEAD_DIM);
    p.WNK = c.take<bf16>(base, (size_t)BATCH * NSA_KV_HEADS * SEQ * HEAD_DIM + 4096); p.WNVT = c.take<bf16>(base, (size_t)BATCH * NSA_KV_HEADS * SEQ * HEAD_DIM + 4096);
    p.QB = c.take<bf16>(base, (size_t)MPAD * NSA_Q_COLS); p.MQB = c.take<bf16>(base, (size_t)MPAD * 256);
    p.CK = c.take<bf16>(base, (size_t)NCTX * NSA_KV_HEADS * NCH * HEAD_DIM); p.CVT = c.take<bf16>(base, (size_t)NCTX * NSA_KV_HEADS * HEAD_DIM * NCH); p.ATTB = c.take<bf16>(base, (size_t)MPAD * (NSA_Q_COLS + MEM_COLS));
    p.GATES = c.take<float>(base, (size_t)MPAD * 64); p.UL = c.take<float>(base, (size_t)2 * ACROWS * 256);
    p.CKF = c.take<float>(base, (size_t)DEC_BATCH * NSA_KV_HEADS * NCH * HEAD_DIM); p.CVF = c.take<float>(base, (size_t)DEC_BATCH * NSA_KV_HEADS * NCH * HEAD_DIM);
    p.SELB = c.take<int>(base, (size_t)MP * NSA_KV_HEADS * 16);
#ifdef NSA_DEBUG
    p.DBG = c.take<float>(base, (size_t)3 * MP * 768);
#else
    p.DBG = nullptr;
#endif
    return c.off;
}
inline void bind_io(FP& p, void* const* d_in, float* out) {
    p.x_prompt = (const float*)d_in[0]; p.x_sample = (const float*)d_in[1]; p.mem_prompt = (const float*)d_in[2]; p.cache_dil[0] = (const float*)d_in[3]; p.cache_dil[1] = (const float*)d_in[4]; p.cache_dil[2] = (const float*)d_in[5];
    p.cache_nsa_kv = (const float*)d_in[6]; p.cache_nsa_win = (const float*)d_in[7]; p.cache_mem_kv = (const float*)d_in[8]; p.page_table = (const int*)d_in[9];
    p.w_in_a = (const float*)d_in[10]; p.w_out_a = (const float*)d_in[11]; p.w_in_b = (const float*)d_in[12]; p.w_out_b = (const float*)d_in[13]; p.w_mem_kv = (const float*)d_in[14]; p.w_kv_b = (const float*)d_in[15];
    p.cmp_pe = (const float*)d_in[16]; p.cmp_w1 = (const float*)d_in[17]; p.cmp_w2 = (const float*)d_in[18]; p.ln_g = (const float*)d_in[19]; p.ln_b = (const float*)d_in[20];
    p.peer_wq = (const float*)d_in[21]; p.peer_keys = (const float*)d_in[22]; p.peer_u = (const float*)d_in[23]; p.peer_v = (const float*)d_in[24];
    size_t o = 0; auto take = [&](size_t n) { float* r = out + o; o += n; return r; };
    p.y_prompt = take((size_t)M0 * D_MODEL); p.y_sample = take((size_t)DEC_BATCH * D_MODEL);
    for (int g = 0; g < 3; ++g) p.dil_p[g] = take((size_t)BATCH * DIL_W[g] * 2 * DIL_HEADS * HEAD_DIM);
    for (int g = 0; g < 3; ++g) p.dil_s[g] = take((size_t)DEC_BATCH * DIL_W[g] * 2 * DIL_HEADS * HEAD_DIM);
    p.nsa_kv_p = take((size_t)M0 * 4 * NSA_KV_HEADS * HEAD_DIM); p.nsa_kv_s = take((size_t)DEC_BATCH * 4 * NSA_KV_HEADS * HEAD_DIM);
    p.win_p = take((size_t)BATCH * SWA_WINDOW * 2 * NSA_KV_HEADS * HEAD_DIM); p.win_s = take((size_t)DEC_BATCH * SWA_WINDOW * 2 * NSA_KV_HEADS * HEAD_DIM);
    p.mem_kv_p = take((size_t)DEPTH * BATCH * MEM_TOKENS * 2 * MEM_COLS);
}
DI unsigned f2bf(float f) { unsigned u = __builtin_bit_cast(unsigned, f); return (u + 0x7fffu + ((u >> 16) & 1u)) >> 16; }
DI unsigned pk2(float lo, float hi) { return f2bf(lo) | (f2bf(hi) << 16); }
DI float bf2f(unsigned short b) { return __builtin_bit_cast(float, (unsigned)b << 16); }
DI float bflo(unsigned w) { return __builtin_bit_cast(float, w << 16); }
DI float bfhi(unsigned w) { return __builtin_bit_cast(float, w & 0xffff0000u); }
DI float wave_sum(float v) {
#pragma unroll
    for (int o = 1; o < 64; o <<= 1) v += __shfl_xor(v, o);
    return v; }
DI float wave_max(float v) {
#pragma unroll
    for (int o = 1; o < 64; o <<= 1) v = fmaxf(v, __shfl_xor(v, o));
    return v; }
DI float gelu_tanh(float x) { const float u = 0.7978845608028654f * (x + 0.044715f * x * x * x); const float e = __builtin_amdgcn_exp2f(u * 2.885390081777927f);   const float t = 1.0f - 2.0f / (e + 1.0f); return 0.5f * x * (1.0f + t); }
DI float* sel3(float* const (&a)[3], int g) { return g == 0 ? a[0] : (g == 1 ? a[1] : a[2]); }
DI const float* sel3c(const float* const (&a)[3], int g) { return g == 0 ? a[0] : (g == 1 ? a[1] : a[2]); }
struct Ctx { LAS unsigned char* lds; int tid, lane, wave, vcu, G; };
DI int row_pos(int r) { return r < M0 ? (r & (SEQ - 1)) : PAST_LEN; }

struct ColSrc { const float* p; int ld; };
DI int rope_il(int e) { return (e >> 1) + 32 * (e & 1); }
DI ColSrc col_wa(const FP& P, int n) {
    const int t = n >> 8, ct = n & 255, h = ct >> 6, e = ct & 63; if (t >= 9) return ColSrc{P.w_in_a + DIL_COLS + ct, ACOLS};
    const int j = t % 3, d = (j < 2) ? rope_il(e) : e; return ColSrc{P.w_in_a + t * 256 + h * 64 + d, ACOLS}; }
DI ColSrc col_wb(const FP& P, int n) {
    const int t = n >> 8, ct = n & 255, e = ct & 63;
    if (t < 3) { const int ty = 2 * t + (ct >> 7), kvh = (ct >> 6) & 1; const bool rot = (ty == 2 || ty == 4); return ColSrc{P.w_kv_b + (ty * NSA_KV_HEADS + kvh) * 64 + (rot ? rope_il(e) : e), KVCOLS}; }
    if (t < 6) { const int h = (t - 3) * 4 + (ct >> 6); return ColSrc{P.w_in_b + h * 64 + rope_il(e), BCOLS}; }
    if (t == 6) return ColSrc{P.w_in_b + NSA_Q_COLS + NSA_GATE_COLS + ct, BCOLS};
    if (ct < NSA_GATE_COLS) return ColSrc{P.w_in_b + NSA_Q_COLS + ct, BCOLS};
    return ColSrc{nullptr, 0}; }
DI ColSrc col_wmem(const FP& P, int n) { const int l = n >> 9, c = n & 511; return ColSrc{P.w_mem_kv + (size_t)l * D_MODEL * 512 + c, 512}; }
DI ColSrc col_woa(const FP& P, int n) { return ColSrc{P.w_out_a + n, D_MODEL}; }
DI ColSrc col_wob(const FP& P, int n) { return ColSrc{P.w_out_b + n, D_MODEL}; }
DI ColSrc col_cw1(const FP& P, int n) {
    const int ty = n >> 8, half = (n >> 7) & 1, hid = n & 127; return ColSrc{P.cmp_w1 + (size_t)ty * CMP_BLOCK * HEAD_DIM * CMP_HIDDEN + (size_t)half * 16 * HEAD_DIM * CMP_HIDDEN + hid, CMP_HIDDEN}; }
template <class CF> DI void transpose_item(const FP& P, CF cf, int K, bf16* WT, LAS float* scr, int item, int nblk, int lane) {
    const int kb = item / nblk, nb = item % nblk, k0 = 64 * kb, n0 = 32 * nb;
    const ColSrc cs = cf(P, n0 + (lane & 31));
#pragma unroll 8
    for (int i = 0; i < 32; ++i) { const int kk = 2 * i + (lane >> 5); scr[kk * 33 + (lane & 31)] = cs.p ? cs.p[(size_t)(k0 + kk) * cs.ld] : 0.f; }
    asm volatile("s_waitcnt lgkmcnt(0)" ::: "memory");
    const int c = lane & 7;
#pragma unroll
    for (int j = 0; j < 4; ++j) { const int n = (lane >> 3) + 8 * j; const LAS float* s = scr + (8 * c) * 33 + n;
        u32x4 o; o.x = pk2(s[0 * 33], s[1 * 33]); o.y = pk2(s[2 * 33], s[3 * 33]); o.z = pk2(s[4 * 33], s[5 * 33]); o.w = pk2(s[6 * 33], s[7 * 33]);
        *(u32x4*)(WT + (size_t)(n0 + n) * K + k0 + 8 * c) = o; }
    asm volatile("s_waitcnt lgkmcnt(0)" ::: "memory");
}
DI void cvt_row1024(const float* src, bf16* dst, int lane) {
#pragma unroll
    for (int j = 0; j < 4; ++j) { f32x4 v = src ? *(const f32x4*)(src + 256 * j + 4 * lane) : (f32x4){0.f, 0.f, 0.f, 0.f}; u32x2 o; o.x = pk2(v.x, v.y); o.y = pk2(v.z, v.w); *(u32x2*)(dst + 256 * j + 4 * lane) = o; }
}
DI void cvt_row1024_fp8(const float* src, unsigned char* dst, float sc, int lane) { u32x4 o; unsigned w[4];
#pragma unroll
    for (int j = 0; j < 4; ++j) { const f32x4 v = *(const f32x4*)(src + 16 * lane + 4 * j) * sc; int t = __builtin_amdgcn_cvt_pk_fp8_f32(v.x, v.y, 0, false); t = __builtin_amdgcn_cvt_pk_fp8_f32(v.z, v.w, t, true); w[j] = (unsigned)t; }
    o.x = w[0]; o.y = w[1]; o.z = w[2]; o.w = w[3]; *(u32x4*)(dst + 16 * lane) = o; }
DI void p0_prologue(const FP& P, const Ctx& C) {
    LAS float* scr = (LAS float*)(C.lds + C.wave * 16384);
    const int gw = C.vcu * NWAVES + C.wave, NGW = C.G * NWAVES, lane = C.lane;
    { constexpr int IA = (D_MODEL / 64) * (ACOLS / 32), IM = (D_MODEL / 64) * (1024 / 32), IOA = (512 / 64) * (D_MODEL / 32), IOB = (1024 / 64) * (D_MODEL / 32), IB = (D_MODEL / 64) * (NB_T / 32), IC = (1024 / 64) * (512 / 32);
      constexpr int NIT = IA + IM + IOA + IOB + IB + IC;
      for (int it = gw; it < NIT; it += NGW) { int r = it;
          if (r < IA) { transpose_item(P, col_wa, D_MODEL, P.WA_T, scr, r, ACOLS / 32, lane); continue; } r -= IA;
          if (r < IM) { transpose_item(P, col_wmem, D_MODEL, P.WMEM_T, scr, r, 1024 / 32, lane); continue; } r -= IM;
          if (r < IOA) { transpose_item(P, col_woa, 512, P.WOA_T, scr, r, D_MODEL / 32, lane); continue; } r -= IOA;
          if (r < IOB) { transpose_item(P, col_wob, 1024, P.WOB_T, scr, r, D_MODEL / 32, lane); continue; } r -= IOB;
          if (r < IB) { transpose_item(P, col_wb, D_MODEL, P.WB_T, scr, r, NB_T / 32, lane); continue; } r -= IB;
          transpose_item(P, col_cw1, 1024, P.CW1_T, scr, r, 512 / 32, lane); } }
    for (int r = gw; r < MPAD; r += NGW) { cvt_row1024(r < M0 ? P.x_prompt + (size_t)r * D_MODEL : (r < MP ? P.x_sample + (size_t)(r - M0) * D_MODEL : nullptr), P.XB0 + (size_t)r * D_MODEL, lane);
        if (r >= MP) { cvt_row1024(nullptr, P.X1B + (size_t)r * D_MODEL, lane); cvt_row1024(nullptr, P.X2B + (size_t)r * D_MODEL, lane); cvt_row1024(nullptr, P.X3B + (size_t)r * D_MODEL, lane);
            for (int c = lane; c < 512; c += 64) { P.ATTA[(size_t)r * 512 + c] = 0; P.ATTB[(size_t)r * 1024 + c] = 0; P.ATTB[(size_t)r * 1024 + 512 + c] = 0; } } }
    for (int r = gw; r < BATCH * MEM_TOKENS; r += NGW) cvt_row1024(P.mem_prompt + (size_t)r * D_MODEL, P.MEMB + (size_t)r * D_MODEL, lane);
    for (int r = gw; r < DEPTH * PEER_EXPERTS; r += NGW) { cvt_row1024_fp8(P.peer_u + (size_t)r * D_MODEL, P.UB8 + (size_t)r * D_MODEL, 256.f, lane); cvt_row1024_fp8(P.peer_v + (size_t)r * D_MODEL, P.VB8 + (size_t)r * D_MODEL, 64.f, lane); }
    for (int i = gw * 64 + lane; i < NPOS * 32; i += NGW * 64) { const int pos = i >> 5, d = i & 31; const double inv = exp2(-(double)d * (13.287712379549449 / 32.0)); const double turns = (double)pos * inv * 0.15915494309189535;
        const float fr = (float)(turns - floor(turns)); P.ROPE[pos * 64 + d] = __builtin_amdgcn_cosf(fr); P.ROPE[pos * 64 + 32 + d] = __builtin_amdgcn_sinf(fr); }
    for (int i = gw * 64 + lane; i < 2 * CMP_HIDDEN; i += NGW * 64) { const int ty = i / CMP_HIDDEN, hid = i % CMP_HIDDEN; float a = 0.f; for (int k = 0; k < CMP_BLOCK * HEAD_DIM; ++k) a += P.cmp_pe[ty * CMP_BLOCK * HEAD_DIM + k] * P.cmp_w1[((size_t)ty * CMP_BLOCK * HEAD_DIM + k) * CMP_HIDDEN + hid]; P.CBIAS[i] = a; }
    for (int it = gw; it < DEC_BATCH * PAST_LEN; it += NGW) { const int n = it / PAST_LEN, t = it % PAST_LEN; const int pg = P.page_table[n * (PAST_LEN / PAGE_SIZE) + t / PAGE_SIZE];
        const f32x4 v = *(const f32x4*)(P.cache_nsa_kv + ((size_t)pg * PAGE_SIZE + t % PAGE_SIZE) * 512 + 4 * lane); const int ty = lane >> 5, kvh = (lane >> 4) & 1, d = (4 * lane) & 63;
        u32x2 o; o.x = pk2(v.x, v.y); o.y = pk2(v.z, v.w); *(u32x2*)(P.AC + ((size_t)ty * ACROWS + ((size_t)(BATCH + n) * NSA_KV_HEADS + kvh) * NCH + t / 16) * 1024 + (t % 16) * 64 + d) = o; }
    for (int g = 0; g < 3; ++g) { const int W = dil_w(g); const long nvec = (long)DEC_BATCH * (W - 1) * 128;
        for (long i = (long)gw * 64 + lane; i < nvec; i += (long)NGW * 64) { const long rr = i / 128; const int c4 = (int)(i % 128); const int n = (int)(rr / (W - 1)), w = (int)(rr % (W - 1));
            ((f32x4*)sel3(P.dil_s, g))[((size_t)n * W + w) * 128 + c4] = ((const f32x4*)sel3c(P.cache_dil, g))[((size_t)n * W + w + 1) * 128 + c4]; } }
    { const int W = SWA_WINDOW; const long nvec = (long)DEC_BATCH * (W - 1) * 64;
      for (long i = (long)gw * 64 + lane; i < nvec; i += (long)NGW * 64) { const long rr = i / 64; const int c4 = (int)(i % 64); const int n = (int)(rr / (W - 1)), w = (int)(rr % (W - 1));
          ((f32x4*)P.win_s)[((size_t)n * W + w) * 64 + c4] = ((const f32x4*)P.cache_nsa_win)[((size_t)n * W + w + 1) * 64 + c4]; } }
}
DI void p0_wpk(const FP& P, const Ctx& C) {
    LAS float* sw = (LAS float*)C.lds;
    LAS float* sk = (LAS float*)(C.lds + 32768);
    constexpr int NIT = DEPTH * 16 * (D_MODEL / 64);
    for (int it = C.vcu; it < NIT; it += C.G) { const int l = it / (16 * (D_MODEL / 64)), rem = it % (16 * (D_MODEL / 64)), hc = rem / (D_MODEL / 64), kb = rem % (D_MODEL / 64);
        __syncthreads();
        for (int i = C.tid; i < 64 * 64; i += NTHREADS) { const int r = i >> 6, d = i & 63; sw[r * 65 + d] = P.peer_wq[((size_t)l * D_MODEL + kb * 64 + r) * 1024 + hc * 64 + d]; }
        for (int i = C.tid; i < 128 * 64; i += NTHREADS) { const int r = i >> 6, d = i & 63; sk[r * 65 + d] = P.peer_keys[(((size_t)l * 16 + hc) * PEER_KEYS + r) * 64 + d]; }
        __syncthreads();
        for (int o = C.tid; o < 128 * 64; o += NTHREADS) { const int kk = o >> 6, ki = o & 63; float a = 0.f;
#pragma unroll 16
            for (int d = 0; d < 64; ++d) a += sw[ki * 65 + d] * sk[kk * 65 + d];
            P.WPK_T[((size_t)l * NPK + hc * 128 + kk) * D_MODEL + kb * 64 + ki] = (bf16)f2bf(a); } }
    __syncthreads();
}

#define EPI_LOOP(...) int fr_l = fr, fq_l = fq; asm volatile("" : "+v"(fr_l), "+v"(fq_l));     \
    _Pragma("unroll") for (int ai = 0; ai < 2; ++ai) _Pragma("unroll") for (int m = 0; m < 4; ++m) { const int row = u.pm * 256 + ai * 128 + wr * 64 + m * 16 + fr_l; \
    _Pragma("unroll") for (int bj = 0; bj < 2; ++bj) { const int ct = bj * 128 + wc * 32 + fq_l * 8; const f32x4 v0 = acc[ai][bj][m][0], v1 = acc[ai][bj][m][1]; __VA_ARGS__ } asm volatile("" ::: "memory"); }
DI void rope4(const float* rope_row, int dp, const f32x4& v0, const f32x4& v1, f32x4& lo, f32x4& hi) {
    const f32x4 c = *(const f32x4*)(rope_row + dp), s = *(const f32x4*)(rope_row + 32 + dp);
    lo.x = v0.x * c.x - v0.y * s.x; hi.x = v0.y * c.x + v0.x * s.x; lo.y = v0.z * c.y - v0.w * s.y; hi.y = v0.w * c.y + v0.z * s.y;
    lo.z = v1.x * c.z - v1.y * s.z; hi.z = v1.y * c.z + v1.x * s.z; lo.w = v1.z * c.w - v1.w * s.w; hi.w = v1.w * c.w + v1.z * s.w; }
DI u32x2 pk4(const f32x4& v) { u32x2 o; o.x = pk2(v.x, v.y); o.y = pk2(v.z, v.w); return o; }
DI u32x4 pk8(const f32x4& a, const f32x4& b) { u32x4 o; o.x = pk2(a.x, a.y); o.y = pk2(a.z, a.w); o.z = pk2(b.x, b.y); o.w = pk2(b.z, b.w); return o; }
DI int dil_perm(int t, int d) { return (t % d) * (SEQ / d) + t / d; }
struct EpiA {
    static constexpr bool PERM = true, AFTER_DRAIN = false; const FP& P;
    DI void operator()(const f32x4 (&acc)[2][2][4][2], const pg8::Unit& u, int wr, int wc, int fr, int fq) const {
        const int t9 = u.pn; const int g = t9 / 3, j = t9 % 3;
        EPI_LOOP({ if (row < MP) { const int h = ct >> 6, e = ct & 63; const int pos = row_pos(row);
            if (t9 == 9) { *(u32x4*)(P.MQA + (size_t)row * 256 + ct) = pk8(v0 * QSCALE, v1 * QSCALE); }
            else if (j < 2) { f32x4 lo, hi; const int dp = e >> 1; rope4(P.ROPE + pos * 64, dp, v0, v1, lo, hi);
                if (j == 0) { bf16* q = P.QA + ((size_t)g * MPAD + row) * 256 + h * 64 + dp; *(u32x2*)q = pk4(lo * QSCALE); *(u32x2*)(q + 32) = pk4(hi * QSCALE); }
                else { bf16* k = P.KA + ((size_t)g * MPAD + row) * 256 + h * 64 + dp; *(u32x2*)k = pk4(lo); *(u32x2*)(k + 32) = pk4(hi);
                    const int W = dil_w(g); float* o = nullptr;
                    if (row >= M0) o = sel3(P.dil_s, g) + (((size_t)(row - M0) * W + W - 1) * 2 + 0) * 256; else if (pos >= SEQ - W) o = sel3(P.dil_p, g) + (((size_t)(row / SEQ) * W + pos - (SEQ - W)) * 2 + 0) * 256;
                    if (o) { *(f32x4*)(o + h * 64 + dp) = lo; *(f32x4*)(o + h * 64 + 32 + dp) = hi; } } }
            else { const int W = dil_w(g), d = dil_d(g); float* o = nullptr;
                if (row >= M0) o = sel3(P.dil_s, g) + (((size_t)(row - M0) * W + W - 1) * 2 + 1) * 256; else if (pos >= SEQ - W) o = sel3(P.dil_p, g) + (((size_t)(row / SEQ) * W + pos - (SEQ - W)) * 2 + 1) * 256;
                if (o) { *(f32x4*)(o + ct) = v0; *(f32x4*)(o + ct + 4) = v1; }
                if (row < M0) { bf16* vt = P.VTA + (((size_t)(g * BATCH + row / SEQ) * DIL_HEADS + h) * 64 + e) * SEQ + dil_perm(pos, d);
                    vt[0 * SEQ] = (bf16)f2bf(v0.x); vt[1 * SEQ] = (bf16)f2bf(v0.y); vt[2 * SEQ] = (bf16)f2bf(v0.z); vt[3 * SEQ] = (bf16)f2bf(v0.w);
                    vt[4 * SEQ] = (bf16)f2bf(v1.x); vt[5 * SEQ] = (bf16)f2bf(v1.y); vt[6 * SEQ] = (bf16)f2bf(v1.z); vt[7 * SEQ] = (bf16)f2bf(v1.w); } } } })
    }
};
struct EpiMem {
    static constexpr bool PERM = true, AFTER_DRAIN = false; const FP& P;
    DI void operator()(const f32x4 (&acc)[2][2][4][2], const pg8::Unit& u, int wr, int wc, int fr, int fq) const {
        const int l = u.pn >> 1, half = u.pn & 1;
        EPI_LOOP({ const int n = row / MEM_TOKENS, mt = row % MEM_TOKENS; float* o = P.mem_kv_p + (((size_t)l * BATCH + n) * MEM_TOKENS + mt) * 512 + half * 256 + ct; *(f32x4*)o = v0; *(f32x4*)(o + 4) = v1;
            if (half == 0) *(u32x4*)(P.MK + (((size_t)l * BATCH + n) * MEM_TOKENS + mt) * 256 + ct) = pk8(v0, v1);
            else { bf16* vt = P.MVT + (((size_t)l * BATCH + n) * 256 + ct) * MEM_TOKENS + mt;
                vt[0 * MEM_TOKENS] = (bf16)f2bf(v0.x); vt[1 * MEM_TOKENS] = (bf16)f2bf(v0.y); vt[2 * MEM_TOKENS] = (bf16)f2bf(v0.z); vt[3 * MEM_TOKENS] = (bf16)f2bf(v0.w);
                vt[4 * MEM_TOKENS] = (bf16)f2bf(v1.x); vt[5 * MEM_TOKENS] = (bf16)f2bf(v1.y); vt[6 * MEM_TOKENS] = (bf16)f2bf(v1.z); vt[7 * MEM_TOKENS] = (bf16)f2bf(v1.w); } })
    }
};
struct EpiPre {
    static constexpr bool PERM = true, AFTER_DRAIN = false; const float* xa; const float* xb; float* pre;
    DI void operator()(const f32x4 (&acc)[2][2][4][2], const pg8::Unit& u, int wr, int wc, int fr, int fq) const {
        EPI_LOOP({ if (row < MP) { const int col = u.pn * 256 + ct; const float* x = (xb && row >= M0) ? xb + (size_t)(row - M0) * D_MODEL + col : xa + (size_t)row * D_MODEL + col;
            const f32x4 a = *(const f32x4*)x, b = *(const f32x4*)(x + 4); float* o = pre + (size_t)row * D_MODEL + col; *(f32x4*)o = a * ALPHA + v0; *(f32x4*)(o + 4) = b * ALPHA + v1; } })
    }
};
struct EpiF32 {
    static constexpr bool PERM = true, AFTER_DRAIN = false; float* out; int ldc; int nrows;
    DI void operator()(const f32x4 (&acc)[2][2][4][2], const pg8::Unit& u, int wr, int wc, int fr, int fq) const {
        EPI_LOOP({ if (row < nrows) { float* o = out + (size_t)row * ldc + u.pn * 256 + ct; *(f32x4*)o = v0; *(f32x4*)(o + 4) = v1; } })
    }
};
}
namespace fx {
struct Tile16 { f32x4 o[4]; float m, l; };
DI void tile_init(Tile16& T) { T.o[0] = T.o[1] = T.o[2] = T.o[3] = (f32x4){0.f, 0.f, 0.f, 0.f}; T.m = -INFINITY; T.l = 0.f; }
typedef __bf16 bf16x2_t __attribute__((ext_vector_type(2)));
DI unsigned cvtpk(float lo, float hi) { const f32x2 v = {lo, hi}; const bf16x2_t b = __builtin_convertvector(v, bf16x2_t); return __builtin_bit_cast(unsigned, b); }
struct KV8 { bf16x8 ka0, ka1, kb0, kb1, v0, v1, v2, v3; };
DI void kv_load(KV8& r, const bf16* k0, const bf16* k1, const bf16* v, long vs16) {
    r.ka0 = *(const bf16x8*)k0; r.ka1 = *(const bf16x8*)(k0 + 32); r.kb0 = *(const bf16x8*)k1; r.kb1 = *(const bf16x8*)(k1 + 32);
    r.v0 = *(const bf16x8*)v; r.v1 = *(const bf16x8*)(v + vs16); r.v2 = *(const bf16x8*)(v + 2 * vs16); r.v3 = *(const bf16x8*)(v + 3 * vs16); }
template <class MaskF> DI void tile_compute(Tile16& T, const bf16x8 (&qf)[2], const KV8& r, MaskF mask) {
    f32x4 s0 = (f32x4){0.f, 0.f, 0.f, 0.f}, s1 = (f32x4){0.f, 0.f, 0.f, 0.f};
    s0 = __builtin_amdgcn_mfma_f32_16x16x32_bf16(r.ka0, qf[0], s0, 0, 0, 0); s0 = __builtin_amdgcn_mfma_f32_16x16x32_bf16(r.ka1, qf[1], s0, 0, 0, 0);
    s1 = __builtin_amdgcn_mfma_f32_16x16x32_bf16(r.kb0, qf[0], s1, 0, 0, 0); s1 = __builtin_amdgcn_mfma_f32_16x16x32_bf16(r.kb1, qf[1], s1, 0, 0, 0);
    float s[8] = {s0.x, s0.y, s0.z, s0.w, s1.x, s1.y, s1.z, s1.w};
    float mx = -INFINITY;
#pragma unroll
    for (int e = 0; e < 8; ++e) { s[e] = mask(e) ? s[e] : -INFINITY; mx = fmaxf(mx, s[e]); }
    mx = fmaxf(mx, __shfl_xor(mx, 16)); mx = fmaxf(mx, __shfl_xor(mx, 32));
    const float mnew = fmaxf(T.m, mx), muse = (mnew == -INFINITY) ? 0.f : mnew;
    const float alpha = __builtin_amdgcn_exp2f(T.m - muse);
    float ls = 0.f;
#pragma unroll
    for (int e = 0; e < 8; ++e) { s[e] = __builtin_amdgcn_exp2f(s[e] - muse); ls += s[e]; }
    ls += __shfl_xor(ls, 16); ls += __shfl_xor(ls, 32);
    T.l = T.l * alpha + ls; T.m = mnew;
    u32x4 pw; pw.x = cvtpk(s[0], s[1]); pw.y = cvtpk(s[2], s[3]); pw.z = cvtpk(s[4], s[5]); pw.w = cvtpk(s[6], s[7]);
    const bf16x8 pf = __builtin_bit_cast(bf16x8, pw);
    T.o[0] = __builtin_amdgcn_mfma_f32_16x16x32_bf16(r.v0, pf, T.o[0] * alpha, 0, 0, 0); T.o[1] = __builtin_amdgcn_mfma_f32_16x16x32_bf16(r.v1, pf, T.o[1] * alpha, 0, 0, 0);
    T.o[2] = __builtin_amdgcn_mfma_f32_16x16x32_bf16(r.v2, pf, T.o[2] * alpha, 0, 0, 0); T.o[3] = __builtin_amdgcn_mfma_f32_16x16x32_bf16(r.v3, pf, T.o[3] * alpha, 0, 0, 0);
}
template <class LD, class CP> DI void pipe2(int n, LD ld, CP cp) { if (n <= 0) return; KV8 A, B; ld(A, 0);
#pragma unroll 1
    for (int i = 0; i < n; i += 2) { ld(B, (i + 1 < n) ? i + 1 : i); cp(A, i); ld(A, (i + 2 < n) ? i + 2 : i); if (i + 1 < n) cp(B, i + 1); } }
__host__ DI size_t ktile_off(int t, int d) { const int blk = t >> 5, kk = t & 31, b = (kk >> 2) & 1, i = 4 * (kk >> 3) + (kk & 3), s = d >> 5, c = (d & 31) >> 3; return ((size_t)(blk * 4 + 2 * b + s) * 64 + i + 16 * c) * 8 + (d & 7); }
__host__ DI size_t vtile_off(int dim, int t) { const int blk = t >> 5, kk = t & 31; return ((size_t)(blk * 4 + (dim >> 4)) * 64 + (dim & 15) + 16 * (kk >> 3)) * 8 + (kk & 7); }
DI void kv_load_t(KV8& r, const bf16* kt, const bf16* vt, int lane) {
    const bf16* k = kt + lane * 8; const bf16* v = vt + lane * 8;
    r.ka0 = *(const bf16x8*)k; r.ka1 = *(const bf16x8*)(k + 512); r.kb0 = *(const bf16x8*)(k + 1024); r.kb1 = *(const bf16x8*)(k + 1536);
    r.v0 = *(const bf16x8*)v; r.v1 = *(const bf16x8*)(v + 512); r.v2 = *(const bf16x8*)(v + 1024); r.v3 = *(const bf16x8*)(v + 1536); }
DI int krow_of(int i, int b) { return 8 * (i >> 2) + 4 * b + (i & 3); }

DI void dil_micro(const FP& P, int n, int h, int t0, int mt, int lane) {
    const int g = mt >> 4, idx = mt & 15, d = dil_d(g), per = 16 / d;
    const int r = idx / per, sub = idx % per, i0 = t0 / d + 16 * sub, ib = i0 - 128, NC = SEQ / d;
    const int q = lane & 15, c = lane >> 4;
    const bf16* Qb = P.QA + ((size_t)g * MPAD + (size_t)n * SEQ) * 256 + h * 64; const bf16* Kb = P.KA + ((size_t)g * MPAD + (size_t)n * SEQ) * 256 + h * 64;
    const bf16* Vb = P.VTA + ((size_t)(g * BATCH + n) * DIL_HEADS + h) * 64 * SEQ + (size_t)r * NC;
    bf16x8 qf[2]; { const bf16* qp = Qb + (size_t)(r + d * (i0 + q)) * 256 + 8 * c; qf[0] = *(const bf16x8*)qp; qf[1] = *(const bf16x8*)(qp + 32); }
    Tile16 T; tile_init(T);
    const int qi = i0 + q;
    auto ld = [&](KV8& kv, int blk) { const int kb = ib + 32 * blk; int ka = kb + krow_of(q, 0), kc = kb + krow_of(q, 1); ka = ka < 0 ? 0 : (ka >= NC ? NC - 1 : ka); kc = kc < 0 ? 0 : (kc >= NC ? NC - 1 : kc);
        kv_load(kv, Kb + (size_t)(r + d * ka) * 256 + 8 * c, Kb + (size_t)(r + d * kc) * 256 + 8 * c, Vb + (size_t)q * SEQ + kb + 8 * c, 16L * SEQ); };
    pipe2(5, ld, [&](const KV8& kv, int blk) { const int kb = ib + 32 * blk; tile_compute(T, qf, kv, [&](int e) { const int ki = kb + 8 * c + e; return ki >= 0 && ki <= qi && qi - ki <= DIL_TAPS - 1; }); });
    const int row = n * SEQ + r + d * qi;
    float* op = P.DPART + (((size_t)g * MP + row) * DIL_HEADS + h) * 64 + 4 * c;
#pragma unroll
    for (int db = 0; db < 4; ++db) *(f32x4*)(op + 16 * db) = T.o[db];
    if (c == 0) { float* ml = P.DML + (((size_t)g * MP + row) * DIL_HEADS + h) * 2; ml[0] = T.m; ml[1] = T.l; }
}
DI void mem_micro(const FP& P, const bf16* Q  , int ldq, int row0, int layer, int n, int h, bf16* O  , int ldo, int lane) {
    const int q = lane & 15, c = lane >> 4;
    bf16x8 qf[2]; { const bf16* qp = Q + (size_t)(row0 + q) * ldq + 8 * c; qf[0] = *(const bf16x8*)qp; qf[1] = *(const bf16x8*)(qp + 32); }
    const bf16* Kb = P.MK + ((size_t)layer * BATCH + n) * MEM_TOKENS * 256 + h * 64; const bf16* Vb = P.MVT + (((size_t)layer * BATCH + n) * 256 + h * 64) * MEM_TOKENS;
    Tile16 T; tile_init(T);
    auto ld = [&](KV8& kv, int blk) { const int kb = 32 * blk; kv_load(kv, Kb + (size_t)(kb + krow_of(q, 0)) * 256 + 8 * c, Kb + (size_t)(kb + krow_of(q, 1)) * 256 + 8 * c, Vb + (size_t)q * MEM_TOKENS + kb + 8 * c, 16L * MEM_TOKENS); };
    pipe2(MEM_TOKENS / 32, ld, [&](const KV8& kv, int) { tile_compute(T, qf, kv, [&](int) { return true; }); });
    const float inv = 1.0f / T.l; bf16* op = O + (size_t)(row0 + q) * ldo + 4 * c;
#pragma unroll
    for (int db = 0; db < 4; ++db) *(u32x2*)(op + 16 * db) = pk4(T.o[db] * inv);
}
struct Dec { float m, l, o; };
template <class KF, class VF> DI void dec_chunk(Dec& D, const LAS float* q, int nk, KF kf, VF vf, int lane) {
    float s = -INFINITY;
    if (lane < nk) { const float* k = kf(lane); float a = 0.f;
#pragma unroll
        for (int d4 = 0; d4 < 16; ++d4) { const f32x4 kv = *(const f32x4*)(k + 4 * d4); a += kv.x * q[4 * d4] + kv.y * q[4 * d4 + 1] + kv.z * q[4 * d4 + 2] + kv.w * q[4 * d4 + 3]; }
        s = a; }
    const float mx = wave_max(s), mnew = fmaxf(D.m, mx), alpha = __builtin_amdgcn_exp2f(D.m - mnew);
    const float p = (lane < nk) ? __builtin_amdgcn_exp2f(s - mnew) : 0.f;
    D.l = D.l * alpha + wave_sum(p); D.m = mnew; float o = D.o * alpha;
    for (int j0 = 0; j0 < nk; j0 += 8) { float vv[8];
#pragma unroll
        for (int u = 0; u < 8; ++u) { const int jj = (j0 + u < nk) ? j0 + u : nk - 1; vv[u] = vf(jj)[lane]; }
#pragma unroll
        for (int u = 0; u < 8; ++u) { const float pj = (j0 + u < nk) ? __builtin_bit_cast(float, __builtin_amdgcn_readlane(__builtin_bit_cast(int, p), (j0 + u) & 63)) : 0.f; o += pj * vv[u]; } }
    D.o = o;
}
DI void atta_phase(const FP& P, const Ctx& C) {
    const int lane = C.lane, w = C.wave;
    constexpr int NT = SEQ / 256, NIT = BATCH * NT * DIL_HEADS;
    for (int it = C.vcu; it < NIT; it += C.G) { const int h = it % DIL_HEADS, tt = (it / DIL_HEADS) % NT, n = it / (DIL_HEADS * NT), t0 = tt * 256;
        for (int mt = w; mt < 48; mt += NWAVES) dil_micro(P, n, h, t0, mt, lane);
        asm volatile("s_waitcnt vmcnt(0)" ::: "memory"); __syncthreads();
        for (int i = C.tid; i < 256 * 16; i += NTHREADS) { const int tk = i >> 4, d4 = (i & 15) * 4; const int row = n * SEQ + t0 + tk;
            float mg[3], lg[3]; float M = -INFINITY;
#pragma unroll
            for (int g = 0; g < 3; ++g) { const float* ml = P.DML + (((size_t)g * MP + row) * DIL_HEADS + h) * 2; mg[g] = ml[0]; lg[g] = ml[1]; M = fmaxf(M, mg[g]); }
            f32x4 acc = (f32x4){0.f, 0.f, 0.f, 0.f}; float L = 0.f;
#pragma unroll
            for (int g = 0; g < 3; ++g) { const float wg = __builtin_amdgcn_exp2f(mg[g] - M); L += wg * lg[g]; acc += *(const f32x4*)(P.DPART + (((size_t)g * MP + row) * DIL_HEADS + h) * 64 + d4) * wg; }
            *(u32x2*)(P.ATTA + (size_t)row * 512 + h * 64 + d4) = pk4(acc * (1.0f / L)); }
        for (int mt = w; mt < 16; mt += NWAVES) mem_micro(P, P.MQA + h * 64, 256, n * SEQ + t0 + 16 * mt, 0, n, h, P.ATTA + 256 + h * 64, 512, lane);
        __syncthreads();
    }
    LAS float* qs = (LAS float*)(C.lds + w * 1024);
    const int gw = C.vcu * NWAVES + w, NGW = C.G * NWAVES;
    for (int it = gw; it < DEC_BATCH * DIL_HEADS * 2; it += NGW) { const int kind = it & 1, h = (it >> 1) % DIL_HEADS, ns = (it >> 1) / DIL_HEADS, row = M0 + ns;
        Dec D; D.m = -INFINITY; D.l = 0.f; D.o = 0.f;
        if (kind == 0) {
            for (int g = 0; g < 3; ++g) qs[g * 64 + lane] = bf2f(P.QA[((size_t)g * MPAD + row) * 256 + h * 64 + lane]);
            asm volatile("s_waitcnt lgkmcnt(0)" ::: "memory");
            for (int g = 0; g < 3; ++g) { const int W = dil_w(g), d = dil_d(g); const float* cache = sel3c(P.cache_dil, g) + (size_t)ns * W * 512; const float* newrow = sel3(P.dil_s, g) + ((size_t)ns * W + W - 1) * 512;
                for (int j0 = 0; j0 < DIL_TAPS; j0 += 64) { const int nk = (DIL_TAPS - j0) < 64 ? (DIL_TAPS - j0) : 64;
                    dec_chunk(D, qs + g * 64, nk, [&](int j) { const int tap = j0 + j; return (tap == 0 ? newrow : cache + (size_t)(W - d * tap) * 512) + h * 64; },
                              [&](int j) { const int tap = j0 + j; return (tap == 0 ? newrow : cache + (size_t)(W - d * tap) * 512) + 256 + h * 64; }, lane); } }
            P.ATTA[(size_t)row * 512 + h * 64 + lane] = (bf16)f2bf(D.o / D.l);
        } else {
            qs[lane] = bf2f(P.MQA[(size_t)row * 256 + h * 64 + lane]);
            asm volatile("s_waitcnt lgkmcnt(0)" ::: "memory");
            const float* mk = P.cache_mem_kv + ((size_t)0 * DEC_BATCH + ns) * MEM_TOKENS * 512;
            for (int j0 = 0; j0 < MEM_TOKENS; j0 += 64) dec_chunk(D, qs, 64, [&](int j) { return mk + (size_t)(j0 + j) * 512 + h * 64; }, [&](int j) { return mk + (size_t)(j0 + j) * 512 + 256 + h * 64; }, lane);
            P.ATTA[(size_t)row * 512 + 256 + h * 64 + lane] = (bf16)f2bf(D.o / D.l);
        }
    }
    __syncthreads();
}
DI void ln_phase(const FP& P, const Ctx& C, const float* pre, const float* gam, const float* bet, float* xo, bf16* xb, float* yp, float* ys) {
    const int gw = C.vcu * NWAVES + C.wave, NGW = C.G * NWAVES, lane = C.lane;
    for (int r = gw; r < MP; r += NGW) { const float* x = pre + (size_t)r * D_MODEL; f32x4 v[4]; float s = 0.f;
#pragma unroll
        for (int j = 0; j < 4; ++j) { v[j] = *(const f32x4*)(x + 256 * j + 4 * lane); s += (v[j].x + v[j].y) + (v[j].z + v[j].w); }
        const float mu = wave_sum(s) * (1.0f / D_MODEL); float s2 = 0.f;
#pragma unroll
        for (int j = 0; j < 4; ++j) { v[j] = v[j] - mu; s2 += (v[j].x * v[j].x + v[j].y * v[j].y) + (v[j].z * v[j].z + v[j].w * v[j].w); }
        const float rs = 1.0f / sqrtf(wave_sum(s2) * (1.0f / D_MODEL) + LN_EPS);
#pragma unroll
        for (int j = 0; j < 4; ++j) { const f32x4 gg = *(const f32x4*)(gam + 256 * j + 4 * lane), bb = *(const f32x4*)(bet + 256 * j + 4 * lane); const f32x4 o = v[j] * rs * gg + bb;
            if (xo) *(f32x4*)(xo + (size_t)r * D_MODEL + 256 * j + 4 * lane) = o;
            if (xb) *(u32x2*)(xb + (size_t)r * D_MODEL + 256 * j + 4 * lane) = pk4(o);
            if (yp) { if (r < M0) *(f32x4*)(yp + (size_t)r * D_MODEL + 256 * j + 4 * lane) = o; else *(f32x4*)(ys + (size_t)(r - M0) * D_MODEL + 256 * j + 4 * lane) = o; } }
    }
}
}
namespace fx {
#define INS16(V, I, v_, i_) do { float _v = (v_); int _i = (i_); _Pragma("unroll") for (int _k = 0; _k < 16; ++_k) { const bool _gt = _v > V[_k]; const float _tv = V[_k]; const int _ti = I[_k]; V[_k] = _gt ? _v : _tv; I[_k] = _gt ? _i : _ti; _v = _gt ? _tv : _v; _i = _gt ? _ti : _i; } } while (0)
DI void topk_phase(const FP& P, const Ctx& C) {
    const int lane = C.lane; LAS float* st = (LAS float*)(C.lds + C.wave * 16384);
    const int NWI = (MP * PEER_HEADS + 63) / 64;
    for (int wi = C.vcu * NWAVES + C.wave; wi < NWI; wi += C.G * NWAVES) {
        const long it0 = (long)wi * 64; const long it = it0 + lane; const bool act = it < (long)MP * PEER_HEADS;
        float V1[16], V2[16], V3[16]; int I1[16], I2[16], I3[16];
#pragma unroll
        for (int k = 0; k < 16; ++k) { V1[k] = V2[k] = V3[k] = -INFINITY; I1[k] = I2[k] = I3[k] = 0; }
        for (int half = 0; half < 2; ++half) {
            for (int ch = 0; ch < 4; ++ch) {
#pragma unroll
                for (int u = 0; u < 8; ++u) { const int f4 = u * 64 + lane, j = f4 >> 3, c4 = (f4 & 7) * 4; const long itj = it0 + j;
                    f32x4 v = (itj < (long)MP * PEER_HEADS) ? *(const f32x4*)(P.SCO + itj * 256 + half * 128 + ch * 32 + c4) : (f32x4){0.f, 0.f, 0.f, 0.f};
                    st[j * 33 + c4] = v.x; st[j * 33 + c4 + 1] = v.y; st[j * 33 + c4 + 2] = v.z; st[j * 33 + c4 + 3] = v.w; }
                asm volatile("s_waitcnt lgkmcnt(0)" ::: "memory");
                for (int c = 0; c < 32; ++c) { const float v = st[lane * 33 + c]; const int id = ch * 32 + c;
                    if (half == 0) { if (__any(v > V1[15])) INS16(V1, I1, v, id); } else { if (__any(v > V2[15])) INS16(V2, I2, v, id); } }
                asm volatile("s_waitcnt lgkmcnt(0)" ::: "memory");
            }
        }
        { LAS float* lv = st; LAS int* li = (LAS int*)(st + 64 * 33);
#pragma unroll
          for (int k = 0; k < 16; ++k) { lv[lane * 33 + k] = V1[k]; lv[lane * 33 + 16 + k] = V2[k]; li[lane * 17 + k] = I1[k] | (I2[k] << 8); }
          asm volatile("s_waitcnt lgkmcnt(0)" ::: "memory");
          for (int a = 0; a < 16; ++a) { const float va = lv[lane * 33 + a]; const int ia = li[lane * 17 + a] & 255; const int nb = 16 / (a + 1);
              for (int b = 0; b < nb; ++b) { const float v = va + lv[lane * 33 + 16 + b]; const int ib = li[lane * 17 + b] >> 8; INS16(V3, I3, v, ia * PEER_KEYS + ib); } }
          asm volatile("s_waitcnt lgkmcnt(0)" ::: "memory"); }
        float z = 0.f; const float vmax = V3[0];
#pragma unroll
        for (int k = 0; k < 16; ++k) { V3[k] = __expf(V3[k] - vmax); z += V3[k]; }
        if (act) { const float iz = 1.0f / z;
#pragma unroll
            for (int k4 = 0; k4 < 4; ++k4) { *(f32x4*)(P.SELG + it * 16 + 4 * k4) = (f32x4){V3[4 * k4] * iz, V3[4 * k4 + 1] * iz, V3[4 * k4 + 2] * iz, V3[4 * k4 + 3] * iz};
                *(int4*)(P.SELE + it * 16 + 4 * k4) = make_int4(I3[4 * k4], I3[4 * k4 + 1], I3[4 * k4 + 2], I3[4 * k4 + 3]); } }
    }
    __syncthreads();
}
constexpr float PEER_SU = 256.f, PEER_SV = 64.f;
DI float dot16_fp8(const u32x4& w, const f32x2 (&x2)[8]) { f32x2 a = {0.f, 0.f};
    a += __builtin_amdgcn_cvt_pk_f32_fp8((int)w.x, false) * x2[0]; a += __builtin_amdgcn_cvt_pk_f32_fp8((int)w.x, true) * x2[1];
    a += __builtin_amdgcn_cvt_pk_f32_fp8((int)w.y, false) * x2[2]; a += __builtin_amdgcn_cvt_pk_f32_fp8((int)w.y, true) * x2[3];
    a += __builtin_amdgcn_cvt_pk_f32_fp8((int)w.z, false) * x2[4]; a += __builtin_amdgcn_cvt_pk_f32_fp8((int)w.z, true) * x2[5];
    a += __builtin_amdgcn_cvt_pk_f32_fp8((int)w.w, false) * x2[6]; a += __builtin_amdgcn_cvt_pk_f32_fp8((int)w.w, true) * x2[7];
    return a.x + a.y; }
DI void axpy16_fp8(const u32x4& w, float s, f32x2 (&o2)[8]) { const f32x2 s2 = {s, s};
    o2[0] += __builtin_amdgcn_cvt_pk_f32_fp8((int)w.x, false) * s2; o2[1] += __builtin_amdgcn_cvt_pk_f32_fp8((int)w.x, true) * s2;
    o2[2] += __builtin_amdgcn_cvt_pk_f32_fp8((int)w.y, false) * s2; o2[3] += __builtin_amdgcn_cvt_pk_f32_fp8((int)w.y, true) * s2;
    o2[4] += __builtin_amdgcn_cvt_pk_f32_fp8((int)w.z, false) * s2; o2[5] += __builtin_amdgcn_cvt_pk_f32_fp8((int)w.z, true) * s2;
    o2[6] += __builtin_amdgcn_cvt_pk_f32_fp8((int)w.w, false) * s2; o2[7] += __builtin_amdgcn_cvt_pk_f32_fp8((int)w.w, true) * s2; }
DI float rdlane(float v, int l) { return __builtin_bit_cast(float, __builtin_amdgcn_readlane(__builtin_bit_cast(int, v), l)); }
DI void peer_phase(const FP& P, const Ctx& C, int layer, const float* xin, float* fout, float* fout_s, bf16* xb) {
    const int lane = C.lane; const unsigned char* U = P.UB8 + (size_t)layer * PEER_EXPERTS * D_MODEL; const unsigned char* Vt = P.VB8 + (size_t)layer * PEER_EXPERTS * D_MODEL;
    const float* gam = P.ln_g + ((size_t)layer * 2 + 1) * D_MODEL; const float* bet = P.ln_b + ((size_t)layer * 2 + 1) * D_MODEL;
    for (int r = C.vcu * NWAVES + C.wave; r < MP; r += C.G * NWAVES) {
        f32x2 x2[8], o2[8];
#pragma unroll
        for (int j = 0; j < 4; ++j) { const f32x4 a = *(const f32x4*)(xin + (size_t)r * D_MODEL + 16 * lane + 4 * j); x2[2 * j] = (f32x2){a.x, a.y}; x2[2 * j + 1] = (f32x2){a.z, a.w}; }
#pragma unroll
        for (int k = 0; k < 8; ++k) o2[k] = (f32x2){0.f, 0.f};
        const int e_l = P.SELE[(size_t)r * 128 + lane], e_h = P.SELE[(size_t)r * 128 + 64 + lane]; const float g_l = P.SELG[(size_t)r * 128 + lane], g_h = P.SELG[(size_t)r * 128 + 64 + lane];
        for (int b0 = 0; b0 < 128; b0 += 8) {
            u32x4 uw[8], vw[8];
#pragma unroll
            for (int k = 0; k < 8; ++k) { const int hk = b0 + k; const int e = (hk < 64) ? __builtin_amdgcn_readlane(e_l, hk & 63) : __builtin_amdgcn_readlane(e_h, hk & 63);
                uw[k] = *(const u32x4*)(U + (size_t)e * D_MODEL + 16 * lane); vw[k] = *(const u32x4*)(Vt + (size_t)e * D_MODEL + 16 * lane); }
            float d[8];
#pragma unroll
            for (int k = 0; k < 8; ++k) d[k] = dot16_fp8(uw[k], x2);
            float e4[4], e2[2], e1;
            { const bool hi = lane & 1;
#pragma unroll
              for (int i = 0; i < 4; ++i) { const float keep = hi ? d[4 + i] : d[i], send = hi ? d[i] : d[4 + i]; e4[i] = keep + __shfl_xor(send, 1); } }
            { const bool hi = lane & 2;
#pragma unroll
              for (int i = 0; i < 2; ++i) { const float keep = hi ? e4[2 + i] : e4[i], send = hi ? e4[i] : e4[2 + i]; e2[i] = keep + __shfl_xor(send, 2); } }
            { const bool hi = lane & 4; const float keep = hi ? e2[1] : e2[0], send = hi ? e2[0] : e2[1]; e1 = keep + __shfl_xor(send, 4); }
            e1 += __shfl_xor(e1, 8); e1 += __shfl_xor(e1, 16); e1 += __shfl_xor(e1, 32);
            const int myk = 4 * (lane & 1) + (lane & 2) + ((lane >> 2) & 1); const int myhk = b0 + myk;
            const float myg = (myhk < 64) ? __shfl(g_l, myhk & 63) : __shfl(g_h, myhk & 63);
            const float act = myg * gelu_tanh(e1 * (1.0f / PEER_SU)) * (1.0f / PEER_SV);
#pragma unroll
            for (int k = 0; k < 8; ++k) { const int src = (k >> 2) | (((k >> 1) & 1) << 1) | ((k & 1) << 2); axpy16_fp8(vw[k], rdlane(act, src), o2); }
        }
        float s = 0.f;
#pragma unroll
        for (int k = 0; k < 8; ++k) { o2[k] += x2[k] * ALPHA; s += o2[k].x + o2[k].y; }
        const float mu = wave_sum(s) * (1.0f / D_MODEL); float s2 = 0.f;
#pragma unroll
        for (int k = 0; k < 8; ++k) { o2[k] -= mu; s2 += o2[k].x * o2[k].x + o2[k].y * o2[k].y; }
        const float rs = 1.0f / sqrtf(wave_sum(s2) * (1.0f / D_MODEL) + LN_EPS);
        float* frow = (r < M0) ? fout + (size_t)r * D_MODEL : fout_s + (size_t)(r - M0) * D_MODEL;
#pragma unroll
        for (int j = 0; j < 4; ++j) { const int c0 = 16 * lane + 4 * j; const f32x4 gg = *(const f32x4*)(gam + c0), bb = *(const f32x4*)(bet + c0);
            const f32x4 y = (f32x4){o2[2 * j].x * rs, o2[2 * j].y * rs, o2[2 * j + 1].x * rs, o2[2 * j + 1].y * rs} * gg + bb;
            *(f32x4*)(frow + c0) = y; if (xb) *(u32x2*)(xb + (size_t)r * D_MODEL + c0) = pk4(y); }
    }
}
}
namespace fx {
struct EpiB {
    static constexpr bool PERM = true, AFTER_DRAIN = false; const FP& P;
    DI void operator()(const f32x4 (&acc)[2][2][4][2], const pg8::Unit& u, int wr, int wc, int fr, int fq) const {
        const int t = u.pn;
        EPI_LOOP({ if (row < MP) { const int pos = row_pos(row), n = row / SEQ, e = ct & 63, dp = e >> 1; const bool prm = row < M0;
            if (t < 3) { const int ty = 2 * t + (ct >> 7), kvh = (ct >> 6) & 1;
                if (ty == 2 || ty == 4) { f32x4 lo, hi; rope4(P.ROPE + pos * 64, dp, v0, v1, lo, hi);
                    if (ty == 2) { float* o = (prm ? P.nsa_kv_p + (size_t)row * 512 : P.nsa_kv_s + (size_t)(row - M0) * 512) + 256 + kvh * 64 + dp; *(f32x4*)o = lo; *(f32x4*)(o + 32) = hi;
                        if (prm) { bf16* kt = P.SLK + ((size_t)n * NSA_KV_HEADS + kvh) * SEQ * 64; *(u32x2*)(kt + ktile_off(pos, dp)) = pk4(lo); *(u32x2*)(kt + ktile_off(pos, dp + 32)) = pk4(hi); } }
                    else { float* o = nullptr; if (!prm) o = P.win_s + (((size_t)(row - M0) * SWA_WINDOW + SWA_WINDOW - 1) * 2 + 0) * 128; else if (pos >= SEQ - SWA_WINDOW) o = P.win_p + (((size_t)n * SWA_WINDOW + pos - (SEQ - SWA_WINDOW)) * 2 + 0) * 128;
                        if (o) { *(f32x4*)(o + kvh * 64 + dp) = lo; *(f32x4*)(o + kvh * 64 + 32 + dp) = hi; }
                        if (prm) { bf16* kt = P.WNK + ((size_t)n * NSA_KV_HEADS + kvh) * SEQ * 64; *(u32x2*)(kt + ktile_off(pos, dp)) = pk4(lo); *(u32x2*)(kt + ktile_off(pos, dp + 32)) = pk4(hi); } } }
                else if (ty < 4) { float* o = (prm ? P.nsa_kv_p + (size_t)row * 512 : P.nsa_kv_s + (size_t)(row - M0) * 512) + ty * 128 + kvh * 64 + e; *(f32x4*)o = v0; *(f32x4*)(o + 4) = v1;
                    if (prm) { if (ty < 2) *(u32x4*)(P.AC + ((size_t)ty * ACROWS + ((size_t)n * NSA_KV_HEADS + kvh) * NCH + pos / 16) * 1024 + (pos % 16) * 64 + e) = pk8(v0, v1);
                        else { bf16* vt = P.SLVT + ((size_t)n * NSA_KV_HEADS + kvh) * SEQ * 64 + vtile_off(e, pos);
                            vt[0] = (bf16)f2bf(v0.x); vt[8] = (bf16)f2bf(v0.y); vt[16] = (bf16)f2bf(v0.z); vt[24] = (bf16)f2bf(v0.w); vt[32] = (bf16)f2bf(v1.x); vt[40] = (bf16)f2bf(v1.y); vt[48] = (bf16)f2bf(v1.z); vt[56] = (bf16)f2bf(v1.w); } } }
                else { float* o = nullptr; if (!prm) o = P.win_s + (((size_t)(row - M0) * SWA_WINDOW + SWA_WINDOW - 1) * 2 + 1) * 128; else if (pos >= SEQ - SWA_WINDOW) o = P.win_p + (((size_t)n * SWA_WINDOW + pos - (SEQ - SWA_WINDOW)) * 2 + 1) * 128;
                    if (o) { *(f32x4*)(o + kvh * 64 + e) = v0; *(f32x4*)(o + kvh * 64 + e + 4) = v1; }
                    if (prm) { bf16* vt = P.WNVT + ((size_t)n * NSA_KV_HEADS + kvh) * SEQ * 64 + vtile_off(e, pos);
                        vt[0] = (bf16)f2bf(v0.x); vt[8] = (bf16)f2bf(v0.y); vt[16] = (bf16)f2bf(v0.z); vt[24] = (bf16)f2bf(v0.w); vt[32] = (bf16)f2bf(v1.x); vt[40] = (bf16)f2bf(v1.y); vt[48] = (bf16)f2bf(v1.z); vt[56] = (bf16)f2bf(v1.w); } } }
            else if (t < 6) { const int h = (t - 3) * 4 + (ct >> 6); f32x4 lo, hi; rope4(P.ROPE + pos * 64, dp, v0, v1, lo, hi); bf16* q = P.QB + (size_t)row * NSA_Q_COLS + h * 64 + dp; *(u32x2*)q = pk4(lo * QSCALE); *(u32x2*)(q + 32) = pk4(hi * QSCALE); }
            else if (t == 6) { *(u32x4*)(P.MQB + (size_t)row * 256 + ct) = pk8(v0 * QSCALE, v1 * QSCALE); }
            else if (ct < 40) { const float vv[8] = {v0.x, v0.y, v0.z, v0.w, v1.x, v1.y, v1.z, v1.w};
                _Pragma("unroll") for (int i = 0; i < 8; ++i) if (ct + i < NSA_GATE_COLS) P.GATES[(size_t)row * 64 + ct + i] = 1.0f / (1.0f + __expf(-vv[i])); } } })
    }
};
DI void cmp2_phase(const FP& P, const Ctx& C) {
    const int lane = C.lane; LAS float* hs = (LAS float*)(C.lds + C.wave * 1024);
    const int NIT = NCTX * 2 * NSA_KV_HEADS * NCMP;
    for (int it = C.vcu * NWAVES + C.wave; it < NIT; it += C.G * NWAVES) { const int c = it % NCMP; int r = it / NCMP; const int kvh = r % NSA_KV_HEADS; r /= NSA_KV_HEADS; const int ty = r % 2, ctx = r / 2;
        const float* UL = P.UL + ((size_t)ty * ACROWS + ((size_t)ctx * NSA_KV_HEADS + kvh) * NCH) * 256;
#pragma unroll
        for (int hf = 0; hf < 2; ++hf) { const int hid = lane + 64 * hf; hs[hid] = gelu_tanh(UL[(size_t)c * 256 + hid] + UL[(size_t)(c + 1) * 256 + 128 + hid] + P.CBIAS[ty * CMP_HIDDEN + hid]); }
        asm volatile("s_waitcnt lgkmcnt(0)" ::: "memory");
        const float* w2 = P.cmp_w2 + (size_t)ty * CMP_HIDDEN * HEAD_DIM; float a = 0.f;
#pragma unroll 8
        for (int k = 0; k < CMP_HIDDEN; ++k) a += hs[k] * w2[k * HEAD_DIM + lane];
        if (ty == 0) { const float other = __shfl_xor(a, 32); const int pos = c * CMP_STRIDE + CMP_BLOCK - 1; const float cs = P.ROPE[pos * 64 + (lane & 31)], sn = P.ROPE[pos * 64 + 32 + (lane & 31)];
            a = (lane < 32) ? a * cs - other * sn : a * cs + other * sn; }
        if (ctx < BATCH) { if (ty == 0) P.CK[((size_t)ctx * NSA_KV_HEADS + kvh) * NCH * 64 + ktile_off(c, lane)] = (bf16)f2bf(a); else P.CVT[((size_t)ctx * NSA_KV_HEADS + kvh) * NCH * 64 + vtile_off(lane, c)] = (bf16)f2bf(a); }
        else { (ty == 0 ? P.CKF : P.CVF)[(((size_t)(ctx - BATCH) * NSA_KV_HEADS + kvh) * NCH + c) * 64 + lane] = a; }
        asm volatile("s_waitcnt lgkmcnt(0)" ::: "memory");
    }
    __syncthreads();
}
constexpr int NSA_WLDS = 8192;
DI void nsa_pair_a(const FP& P, int n, int kvh, int t, int lane, LAS unsigned char* wl) {
    LAS float* pn = (LAS float*)wl; LAS float* imp = (LAS float*)(wl + 2048); LAS float* sc = (LAS float*)(wl + 6144); LAS int* sel = (LAS int*)(wl + 7168);
    const int col = lane & 15, c = lane >> 4; const bool vcol = col < 12; const int qq = vcol ? col / 6 : 0, hh = vcol ? col % 6 : 0, tq = t + qq, head = kvh * NSA_GROUP + hh, row = n * SEQ + tq;
    bf16x8 qf[2]; { const bf16* qp = P.QB + (size_t)row * NSA_Q_COLS + head * 64 + 8 * c; qf[0] = *(const bf16x8*)qp; qf[1] = *(const bf16x8*)(qp + 32); }
    const float* gt = P.GATES + (size_t)row * 64 + head * 3;
    f32x4 oacc[4] = {(f32x4){0.f, 0.f, 0.f, 0.f}, (f32x4){0.f, 0.f, 0.f, 0.f}, (f32x4){0.f, 0.f, 0.f, 0.f}, (f32x4){0.f, 0.f, 0.f, 0.f}};
    const int lim = vcol ? ((tq >= CMP_BLOCK - 1) ? (tq - (CMP_BLOCK - 1)) / CMP_STRIDE : -1) : -1;
    const int limmax = (t + 1 >= CMP_BLOCK - 1) ? (t + 1 - (CMP_BLOCK - 1)) / CMP_STRIDE : -1; const int nblk = (limmax + 32) / 32;
    const bf16* CKb = P.CK + ((size_t)n * NSA_KV_HEADS + kvh) * NCH * 64; const bf16* CVb = P.CVT + ((size_t)n * NSA_KV_HEADS + kvh) * 64 * NCH;
    for (int i = lane; i < 1024; i += 64) imp[i] = 0.f;
    float m1 = -INFINITY, l1 = 0.f;
    for (int blk = 0; blk < nblk; ++blk) { const int kb = 32 * blk; const bf16* kt = CKb + (size_t)blk * 2048 + lane * 8;
        const bf16x8 ka0 = *(const bf16x8*)kt, ka1 = *(const bf16x8*)(kt + 512), kb0 = *(const bf16x8*)(kt + 1024), kb1 = *(const bf16x8*)(kt + 1536);
        f32x4 s0 = (f32x4){0.f, 0.f, 0.f, 0.f}, s1 = (f32x4){0.f, 0.f, 0.f, 0.f};
        s0 = __builtin_amdgcn_mfma_f32_16x16x32_bf16(ka0, qf[0], s0, 0, 0, 0); s0 = __builtin_amdgcn_mfma_f32_16x16x32_bf16(ka1, qf[1], s0, 0, 0, 0);
        s1 = __builtin_amdgcn_mfma_f32_16x16x32_bf16(kb0, qf[0], s1, 0, 0, 0); s1 = __builtin_amdgcn_mfma_f32_16x16x32_bf16(kb1, qf[1], s1, 0, 0, 0);
        float s[8] = {s0.x, s0.y, s0.z, s0.w, s1.x, s1.y, s1.z, s1.w}; float mx = -INFINITY;
#pragma unroll
        for (int e = 0; e < 8; ++e) { s[e] = (kb + 8 * c + e <= lim) ? s[e] : -INFINITY; mx = fmaxf(mx, s[e]); }
        mx = fmaxf(mx, __shfl_xor(mx, 16)); mx = fmaxf(mx, __shfl_xor(mx, 32));
        const float mnew = fmaxf(m1, mx), muse = (mnew == -INFINITY) ? 0.f : mnew; float ls = 0.f;
#pragma unroll
        for (int e = 0; e < 8; ++e) ls += __builtin_amdgcn_exp2f(s[e] - muse);
        ls += __shfl_xor(ls, 16); ls += __shfl_xor(ls, 32);
        l1 = l1 * __builtin_amdgcn_exp2f(m1 - muse) + ls; m1 = mnew; }
    asm volatile("s_waitcnt lgkmcnt(0)" ::: "memory");
    { const float muse = (m1 == -INFINITY) ? 0.f : m1, inv = (l1 > 0.f) ? 1.0f / l1 : 0.f;
      f32x4 oc[4] = {(f32x4){0.f, 0.f, 0.f, 0.f}, (f32x4){0.f, 0.f, 0.f, 0.f}, (f32x4){0.f, 0.f, 0.f, 0.f}, (f32x4){0.f, 0.f, 0.f, 0.f}};
      for (int blk = 0; blk < nblk; ++blk) { const int kb = 32 * blk; const bf16* kt = CKb + (size_t)blk * 2048 + lane * 8; const bf16* v = CVb + (size_t)blk * 2048 + lane * 8;
        const bf16x8 ka0 = *(const bf16x8*)kt, ka1 = *(const bf16x8*)(kt + 512), kb0 = *(const bf16x8*)(kt + 1024), kb1 = *(const bf16x8*)(kt + 1536);
        const bf16x8 v0 = *(const bf16x8*)v, v1 = *(const bf16x8*)(v + 512), v2 = *(const bf16x8*)(v + 1024), v3 = *(const bf16x8*)(v + 1536);
        f32x4 s0 = (f32x4){0.f, 0.f, 0.f, 0.f}, s1 = (f32x4){0.f, 0.f, 0.f, 0.f};
        s0 = __builtin_amdgcn_mfma_f32_16x16x32_bf16(ka0, qf[0], s0, 0, 0, 0); s0 = __builtin_amdgcn_mfma_f32_16x16x32_bf16(ka1, qf[1], s0, 0, 0, 0);
        s1 = __builtin_amdgcn_mfma_f32_16x16x32_bf16(kb0, qf[0], s1, 0, 0, 0); s1 = __builtin_amdgcn_mfma_f32_16x16x32_bf16(kb1, qf[1], s1, 0, 0, 0);
        float s[8] = {s0.x, s0.y, s0.z, s0.w, s1.x, s1.y, s1.z, s1.w};
#pragma unroll
        for (int e = 0; e < 8; ++e) s[e] = (kb + 8 * c + e <= lim) ? __builtin_amdgcn_exp2f(s[e] - muse) * inv : 0.f;
        *(f32x4*)(pn + col * 32 + 8 * c) = (f32x4){s[0], s[1], s[2], s[3]}; *(f32x4*)(pn + col * 32 + 8 * c + 4) = (f32x4){s[4], s[5], s[6], s[7]};
        u32x4 pw; pw.x = cvtpk(s[0], s[1]); pw.y = cvtpk(s[2], s[3]); pw.z = cvtpk(s[4], s[5]); pw.w = cvtpk(s[6], s[7]); const bf16x8 pf = __builtin_bit_cast(bf16x8, pw);
        oc[0] = __builtin_amdgcn_mfma_f32_16x16x32_bf16(v0, pf, oc[0], 0, 0, 0); oc[1] = __builtin_amdgcn_mfma_f32_16x16x32_bf16(v1, pf, oc[1], 0, 0, 0);
        oc[2] = __builtin_amdgcn_mfma_f32_16x16x32_bf16(v2, pf, oc[2], 0, 0, 0); oc[3] = __builtin_amdgcn_mfma_f32_16x16x32_bf16(v3, pf, oc[3], 0, 0, 0);
        asm volatile("s_waitcnt lgkmcnt(0)" ::: "memory");
        { const int q2 = lane >> 5, k = lane & 31; float a = 0.f;
#pragma unroll
          for (int h6 = 0; h6 < 6; ++h6) a += pn[(q2 * 6 + h6) * 32 + k];
          imp[q2 * 512 + kb + k] = a; }
        asm volatile("s_waitcnt lgkmcnt(0)" ::: "memory"); }
#ifdef NSA_DEBUG
      if (vcol) { for (int db = 0; db < 4; ++db) *(f32x4*)(P.DBG + ((size_t)0 * MP + row) * 768 + head * 64 + 16 * db + 4 * c) = oc[db]; }
#endif
      const float g0 = vcol ? gt[0] : 0.f;
#pragma unroll
      for (int db = 0; db < 4; ++db) oacc[db] += oc[db] * g0; }
    for (int i = lane; i < 256; i += 64) { const int q2 = i >> 7, b = i & 127, tq2 = t + q2, cur = tq2 / SLC_BLOCK; float sv;
        if (b > cur) sv = NEG; else if (b == 0 || b == cur || b == cur - 1) sv = FORCE_SCORE;
        else { const LAS float* ic = imp + q2 * 512 + 4 * b; sv = ic[-1] + 2.f * (ic[0] + ic[1] + ic[2]) + ic[3]; }
        sc[i] = sv; }
    asm volatile("s_waitcnt lgkmcnt(0)" ::: "memory");
    for (int i = lane; i < 256; i += 64) { const int q2 = i >> 7, b = i & 127; const float sv = sc[i]; int rank = 0;
        for (int j = 0; j < 128; ++j) { const float o = sc[q2 * 128 + j]; rank += (o > sv || (o == sv && j < b)) ? 1 : 0; }
        if (rank < SLC_TOPK) { const int v = (sv > 0.5f * NEG) ? b : -1; sel[q2 * 16 + rank] = v; P.SELB[((size_t)(n * SEQ + t + q2) * NSA_KV_HEADS + kvh) * 16 + rank] = v; } }
    asm volatile("s_waitcnt lgkmcnt(0)" ::: "memory");
    { Tile16 T; tile_init(T);
      const bf16* WKb = P.WNK + ((size_t)n * NSA_KV_HEADS + kvh) * SEQ * 64; const bf16* WVb = P.WNVT + ((size_t)n * NSA_KV_HEADS + kvh) * 64 * SEQ;
      const int blo = (t - SWA_WINDOW) >> 5, bhi = (t + 1) >> 5;
      auto ld = [&](KV8& kv, int blk) { const int bc = blk < 0 ? 0 : blk; kv_load_t(kv, WKb + (size_t)bc * 2048, WVb + (size_t)bc * 2048, lane); };
      pipe2(bhi - blo + 1, [&](KV8& kv, int i) { ld(kv, blo + i); }, [&](const KV8& kv, int i) { const int kb = 32 * (blo + i);
          tile_compute(T, qf, kv, [&](int e) { const int kp = kb + 8 * c + e; return vcol && kp >= 0 && kp <= tq && tq - kp <= SWA_WINDOW; }); });
      const float inv = (T.l > 0.f) ? 1.0f / T.l : 0.f, g2 = vcol ? gt[2] * inv : 0.f;
#ifdef NSA_DEBUG
      if (vcol) { for (int db = 0; db < 4; ++db) *(f32x4*)(P.DBG + ((size_t)2 * MP + row) * 768 + head * 64 + 16 * db + 4 * c) = T.o[db] * inv; }
#endif
#pragma unroll
      for (int db = 0; db < 4; ++db) oacc[db] += T.o[db] * g2; }
    if (vcol) { float* op = P.DPART + (size_t)row * 768 + head * 64 + 4 * c;
#pragma unroll
        for (int db = 0; db < 4; ++db) *(f32x4*)(op + 16 * db) = oacc[db]; }
}
DI void nsa_pair_b(const FP& P, int n, int kvh, int t, int lane, LAS unsigned char* wl) {
    LAS int* steps = (LAS int*)wl;
    const int col = lane & 15, c = lane >> 4; const bool vcol = col < 12; const int qq = vcol ? col / 6 : 0, hh = vcol ? col % 6 : 0, tq = t + qq, head = kvh * NSA_GROUP + hh, row = n * SEQ + tq;
    bf16x8 qf[2]; { const bf16* qp = P.QB + (size_t)row * NSA_Q_COLS + head * 64 + 8 * c; qf[0] = *(const bf16x8*)qp; qf[1] = *(const bf16x8*)(qp + 32); }
    const float* gt = P.GATES + (size_t)row * 64 + head * 3;
    Tile16 T; tile_init(T);
    const bf16* SKb = P.SLK + ((size_t)n * NSA_KV_HEADS + kvh) * SEQ * 64; const bf16* SVb = P.SLVT + ((size_t)n * NSA_KV_HEADS + kvh) * SEQ * 64;
    int ns = 0;
    { const int mysel = (lane < 32) ? P.SELB[((size_t)(n * SEQ + t + (lane >> 4)) * NSA_KV_HEADS + kvh) * 16 + (lane & 15)] : -1;
      for (int i = 0; i < 32; ++i) { const int b = __builtin_amdgcn_readlane(mysel, i); if (b < 0) continue; const int q2 = i >> 4;
          if (lane == 0) { steps[ns] = (b * SLC_BLOCK) | (q2 << 30); steps[ns + 1] = (b * SLC_BLOCK + 32) | (q2 << 30); } ns += 2; } }
    asm volatile("s_waitcnt lgkmcnt(0)" ::: "memory");
    auto ld = [&](KV8& kv, int i) { const int code = __builtin_amdgcn_readfirstlane(steps[i]); const int kb = code & 0x3fffffff;
        kv_load_t(kv, SKb + (size_t)(kb >> 5) * 2048, SVb + (size_t)(kb >> 5) * 2048, lane); };
#ifdef PROBE_DBLCOMP
    Tile16 T2; tile_init(T2);
#endif
    pipe2(ns, ld, [&](const KV8& kv, int i) { const int code = __builtin_amdgcn_readfirstlane(steps[i]); const int kb = code & 0x3fffffff, q2 = code >> 30;
        tile_compute(T, qf, kv, [&](int e) { return vcol && qq == q2 && (kb + 8 * c + e) <= tq; });
#ifdef PROBE_DBLCOMP
        tile_compute(T2, qf, kv, [&](int e) { return vcol && qq == q2 && (kb + 8 * c + e + 1) <= tq; });
#endif
    });
#ifdef PROBE_DBLCOMP
    if (T2.l < 0.f) T.l = 0.f;
#endif
    const float inv = (T.l > 0.f) ? 1.0f / T.l : 0.f, g1 = vcol ? gt[1] * inv : 0.f;
#ifdef NSA_DEBUG
    if (vcol) { for (int db = 0; db < 4; ++db) *(f32x4*)(P.DBG + ((size_t)1 * MP + row) * 768 + head * 64 + 16 * db + 4 * c) = T.o[db] * inv; }
#endif
    if (vcol) { const float* pp = P.DPART + (size_t)row * 768 + head * 64 + 4 * c; bf16* op = P.ATTB + (size_t)row * 1024 + head * 64 + 4 * c;
#pragma unroll
        for (int db = 0; db < 4; ++db) *(u32x2*)(op + 16 * db) = pk4(*(const f32x4*)(pp + 16 * db) + T.o[db] * g1); }
}

constexpr int SMP_SK = 1088;
template <class KF, class VF> DI void smp_branch(const Ctx& C, LAS float* qs, LAS float* S, LAS float* red, int NK, KF kf, VF vf, bool keep_probs, float (&outh)[1]) {
    const int tid = C.tid, lane = C.lane, w = C.wave;
#pragma unroll 1
    for (int j = tid; j < NK; j += NTHREADS) { const float* k = kf(j); f32x4 kr[16];
#pragma unroll
        for (int d4 = 0; d4 < 16; ++d4) kr[d4] = *(const f32x4*)(k + 4 * d4);
#pragma unroll 1
        for (int h = 0; h < 6; ++h) { float a = 0.f;
#pragma unroll
            for (int d4 = 0; d4 < 16; ++d4) { const f32x4 qv = *(const LAS f32x4*)(qs + h * 64 + 4 * d4); a += kr[d4].x * qv.x + kr[d4].y * qv.y + kr[d4].z * qv.z + kr[d4].w * qv.w; }
            S[h * SMP_SK + j] = a; } }
    asm volatile("s_waitcnt lgkmcnt(0)" ::: "memory"); __syncthreads();
    if (w < 6) { float m = -INFINITY; for (int j = lane; j < NK; j += 64) m = fmaxf(m, S[w * SMP_SK + j]); m = wave_max(m);
        float l = 0.f; for (int j = lane; j < NK; j += 64) { const float p = __builtin_amdgcn_exp2f(S[w * SMP_SK + j] - m); S[w * SMP_SK + j] = p; l += p; } l = wave_sum(l);
        const float inv = 1.0f / l; for (int j = lane; j < NK; j += 64) S[w * SMP_SK + j] *= inv; }
    asm volatile("s_waitcnt lgkmcnt(0)" ::: "memory"); __syncthreads();
    { const int per = (NK + NWAVES - 1) / NWAVES, j0 = w * per, j1 = (j0 + per < NK) ? j0 + per : NK; float o[6] = {0.f, 0.f, 0.f, 0.f, 0.f, 0.f};
#pragma unroll 1
      for (int j = j0; j < j1; j += 8) { float vv[8];
#pragma unroll
          for (int u = 0; u < 8; ++u) { const int jj = (j + u < j1) ? j + u : j1 - 1; vv[u] = vf(jj)[lane]; }
#pragma unroll
          for (int u = 0; u < 8; ++u) if (j + u < j1) {
#pragma unroll
              for (int h = 0; h < 6; ++h) o[h] += S[h * SMP_SK + j + u] * vv[u]; } }
#pragma unroll
      for (int h = 0; h < 6; ++h) red[(w * 6 + h) * 64 + lane] = o[h]; }
    asm volatile("s_waitcnt lgkmcnt(0)" ::: "memory"); __syncthreads();
    outh[0] = 0.f;
    if (tid < 384) { float a = 0.f;
#pragma unroll
        for (int ww = 0; ww < NWAVES; ++ww) a += red[ww * 384 + tid]; outh[0] = a; }
    if (!keep_probs) { __syncthreads(); }
}
DI void nsa_sample_item(const FP& P, const Ctx& C, int ns, int kvh) {
    LAS float* qs = (LAS float*)C.lds; LAS float* S = qs + 384; LAS float* red = S + 6 * SMP_SK; LAS float* scs = red + 8 * 384; LAS int* sel = (LAS int*)(scs + 136);
    const int tid = C.tid, row = M0 + ns;
    if (tid < 384) qs[tid] = bf2f(P.QB[(size_t)row * NSA_Q_COLS + kvh * 384 + tid]);
    asm volatile("s_waitcnt lgkmcnt(0)" ::: "memory"); __syncthreads();
    const float* ckf = P.CKF + ((size_t)ns * NSA_KV_HEADS + kvh) * NCH * 64; const float* cvf = P.CVF + ((size_t)ns * NSA_KV_HEADS + kvh) * NCH * 64;
    float oc[1], os[1], ow[1];
    smp_branch(C, qs, S, red, NCMP, [&](int j) { return ckf + (size_t)j * 64; }, [&](int j) { return cvf + (size_t)j * 64; }, true, oc);
    constexpr int NBS = (PAST_LEN + 1 + SLC_BLOCK - 1) / SLC_BLOCK, CURS = PAST_LEN / SLC_BLOCK;
    for (int b = tid; b < 136; b += NTHREADS) { float sv = -3.0e38f;
        if (b < NBS) { if (b == 0 || b == CURS || b == CURS - 1) sv = FORCE_SCORE; else { float a = 0.f;
#pragma unroll
                for (int o = -1; o <= 3; ++o) { const int ci = 4 * b + o; if (ci >= 0 && ci < NCMP) { float sm = 0.f; for (int h6 = 0; h6 < 6; ++h6) sm += S[h6 * SMP_SK + ci]; a += ((o >= 0 && o <= 2) ? 2.f : 1.f) * sm; } }
                sv = a; } }
        scs[b] = sv; }
    asm volatile("s_waitcnt lgkmcnt(0)" ::: "memory"); __syncthreads();
    for (int b = tid; b < NBS; b += NTHREADS) { const float sv = scs[b]; int rank = 0; for (int j = 0; j < NBS; ++j) { const float o = scs[j]; rank += (o > sv || (o == sv && j < b)) ? 1 : 0; }
        if (rank < SLC_TOPK) { sel[rank] = b; P.SELB[((size_t)row * NSA_KV_HEADS + kvh) * 16 + rank] = b; } }
    asm volatile("s_waitcnt lgkmcnt(0)" ::: "memory"); __syncthreads();
    { const float* newrow = P.nsa_kv_s + (size_t)ns * 512; const int* pt = P.page_table + ns * (PAST_LEN / PAGE_SIZE);
      if (tid == 0) { int seen = 0; for (int x = 0; x < SLC_TOPK; ++x) { const int bx = sel[x]; if (bx != CURS && seen < 15) sel[16 + seen++] = bx; } }
      asm volatile("s_waitcnt lgkmcnt(0)" ::: "memory"); __syncthreads();
      auto krow = [&](int j, int ty) -> const float* { if (j >= 15 * 64) return newrow + ty * 128 + kvh * 64;
          const int t0 = sel[16 + (j >> 6)] * SLC_BLOCK + (j & 63); const int pg = pt[t0 / PAGE_SIZE]; return P.cache_nsa_kv + ((size_t)pg * PAGE_SIZE + t0 % PAGE_SIZE) * 512 + ty * 128 + kvh * 64; };
      smp_branch(C, qs, S, red, 15 * 64 + 1, [&](int j) { return krow(j, 2); }, [&](int j) { return krow(j, 3); }, false, os); }
    { const float* wc = P.cache_nsa_win + (size_t)ns * SWA_WINDOW * 256; const float* newrow = P.win_s + ((size_t)ns * SWA_WINDOW + SWA_WINDOW - 1) * 256;
      smp_branch(C, qs, S, red, SWA_WINDOW + 1, [&](int j) { return (j < SWA_WINDOW ? wc + (size_t)j * 256 : newrow) + kvh * 64; }, [&](int j) { return (j < SWA_WINDOW ? wc + (size_t)j * 256 : newrow) + 128 + kvh * 64; }, false, ow); }
    if (tid < 384) { const int head = kvh * NSA_GROUP + tid / 64; const float* gt = P.GATES + (size_t)row * 64 + head * 3;
        P.ATTB[(size_t)row * 1024 + kvh * 384 + tid] = (bf16)f2bf(gt[0] * oc[0] + gt[1] * os[0] + gt[2] * ow[0]);
#ifdef NSA_DEBUG
        P.DBG[((size_t)0 * MP + row) * 768 + kvh * 384 + tid] = oc[0]; P.DBG[((size_t)1 * MP + row) * 768 + kvh * 384 + tid] = os[0]; P.DBG[((size_t)2 * MP + row) * 768 + kvh * 384 + tid] = ow[0];
#endif
    }
    __syncthreads();
}
DI void nsa_pairs(const FP& P, const Ctx& C, bool second) {
    LAS unsigned char* wl = C.lds + C.wave * NSA_WLDS;
    const int per = C.G / 4 > 0 ? C.G / 4 : 1, grp = (C.vcu / per) & 3, sub = C.vcu % per, n = grp >> 1, kvh = grp & 1;
#pragma unroll 1
    for (int pr = sub * NWAVES + C.wave; pr < SEQ / 2; pr += per * NWAVES) { if (second) nsa_pair_b(P, n, kvh, 2 * pr, C.lane, wl); else nsa_pair_a(P, n, kvh, 2 * pr, C.lane, wl); }
}
DI void nsa_phase_a(const FP& P, const Ctx& C) {
    for (int it = C.vcu; it < DEC_BATCH * NSA_KV_HEADS; it += C.G) nsa_sample_item(P, C, it / NSA_KV_HEADS, it % NSA_KV_HEADS);
    nsa_pairs(P, C, false);
    __syncthreads();
}
DI void nsa_phase_b(const FP& P, const Ctx& C) {
    const int lane = C.lane, w = C.wave;
    nsa_pairs(P, C, true);
    __syncthreads();
    { constexpr int NMT = (M0 / 16) * MEM_HEADS;
      for (int it = C.vcu * NWAVES + w; it < NMT; it += C.G * NWAVES) { const int h = it % MEM_HEADS, q16 = it / MEM_HEADS, row0 = q16 * 16, n = row0 / SEQ;
          mem_micro(P, P.MQB + h * 64, 256, row0, 1, n, h, P.ATTB + NSA_Q_COLS + h * 64, 1024, lane); }
      LAS float* qs = (LAS float*)(C.lds + 65536 + w * 256);
      for (int it = C.vcu * NWAVES + w; it < DEC_BATCH * MEM_HEADS; it += C.G * NWAVES) { const int h = it % MEM_HEADS, ns = it / MEM_HEADS, row = M0 + ns;
          Dec D; D.m = -INFINITY; D.l = 0.f; D.o = 0.f; qs[lane] = bf2f(P.MQB[(size_t)row * 256 + h * 64 + lane]); asm volatile("s_waitcnt lgkmcnt(0)" ::: "memory");
          const float* mk = P.cache_mem_kv + ((size_t)1 * DEC_BATCH + ns) * MEM_TOKENS * 512;
          for (int j0 = 0; j0 < MEM_TOKENS; j0 += 64) dec_chunk(D, qs, 64, [&](int j) { return mk + (size_t)(j0 + j) * 512 + h * 64; }, [&](int j) { return mk + (size_t)(j0 + j) * 512 + 256 + h * 64; }, lane);
          P.ATTB[(size_t)row * 1024 + NSA_Q_COLS + h * 64 + lane] = (bf16)f2bf(D.o / D.l); } }
    __syncthreads();
}
}
namespace fx {
enum { PH_PRO = 0, PH_WPK, PH_G1, PH_ATTA, PH_G2, PH_LN1, PH_SC0, PH_TK0, PH_PG0, PH_G3, PH_CMPG, PH_CMP2, PH_NSA, PH_NSB, PH_G4, PH_LN3, PH_SC1, PH_TK1, PH_PG1, PH_COUNT };
template <class Epi> DI void run_gemm(const Ctx& C, const bf16* A, const bf16* Bt, int M, int N, int K, const Epi& E) {
    pg8::Gemm g{A, Bt, M, N, K}; pg8::StaticOrder S; S.init(M, N, C.G, (int)blockIdx.x);
    pg8::gemm_phase<Epi, pg8::StaticOrder, true, true>(C.lds, g, S, E);
}
__global__ void __launch_bounds__(NTHREADS, 2) mega(Args args) {
    extern __shared__ __attribute__((aligned(16))) unsigned char lds_raw[];
    Ctx C; C.lds = (LAS unsigned char*)lds_raw; C.tid = threadIdx.x; C.lane = C.tid & 63; C.wave = __builtin_amdgcn_readfirstlane(C.tid >> 6);
    C.G = gridDim.x; { const int bx = blockIdx.x; C.vcu = (C.G % 8 == 0) ? (bx % 8) * (C.G / 8) + bx / 8 : bx; }
    const FP& P = args.p;
    volatile LAS unsigned* MISC = (volatile LAS unsigned*)(C.lds + MISC_OFF);
    for (int u = C.tid; u < (LDS_BYTES - RING_BYTES) / 4; u += NTHREADS) ((LAS unsigned*)(C.lds + RING_BYTES))[u] = 0u;
    __syncthreads();
    const int lo = args.lo, hi = args.hi;
    XcdBarrier bar; bar.bar = P.ctl + 1024; bar.x = 0; bar.st = nullptr;
    if (hi - lo > 1) bar = xcd_barrier_post(P.ctl + 1024, MISC + 8);
#define IN(k) (lo <= (k) && (k) < hi)
#define SEAM(k) do { if (IN(k) && IN((k) + 1)) xcd_barrier(bar); } while (0)
#ifndef DUP_PHASE
#define DUP_PHASE -1
#endif
#define PHASE(k, ...) do { if (IN(k)) { __VA_ARGS__ if (DUP_PHASE == (k)) { __syncthreads(); __VA_ARGS__ } } SEAM(k); } while (0)
    PHASE(PH_PRO, p0_prologue(P, C););
    PHASE(PH_WPK, p0_wpk(P, C););
    PHASE(PH_G1, run_gemm(C, P.XB0, P.WA_T, MPAD, ACOLS, D_MODEL, EpiA{P}); run_gemm(C, P.MEMB, P.WMEM_T, BATCH * MEM_TOKENS, 1024, D_MODEL, EpiMem{P}););
    PHASE(PH_ATTA, atta_phase(P, C););
    PHASE(PH_G2, run_gemm(C, P.ATTA, P.WOA_T, MPAD, D_MODEL, 512, EpiPre{P.x_prompt, P.x_sample, P.PRE}););
    PHASE(PH_LN1, ln_phase(P, C, P.PRE, P.ln_g, P.ln_b, P.X1, P.X1B, nullptr, nullptr););
    PHASE(PH_SC0, run_gemm(C, P.X1B, P.WPK_T, MPAD, NPK, D_MODEL, EpiF32{P.SCO, NPK, MP}););
    PHASE(PH_TK0, topk_phase(P, C););
    PHASE(PH_PG0, peer_phase(P, C, 0, P.X1, P.X2, P.X2 + (size_t)M0 * D_MODEL, P.X2B););
    PHASE(PH_G3, run_gemm(C, P.X2B, P.WB_T, MPAD, NB_T, D_MODEL, EpiB{P}););
    PHASE(PH_CMPG, run_gemm(C, P.AC, P.CW1_T, ACROWS, 256, 1024, EpiF32{P.UL, 256, ACROWS}); run_gemm(C, P.AC + (size_t)ACROWS * 1024, P.CW1_T + 256 * 1024, ACROWS, 256, 1024, EpiF32{P.UL + (size_t)ACROWS * 256, 256, ACROWS}););
    PHASE(PH_CMP2, cmp2_phase(P, C););
    PHASE(PH_NSA, nsa_phase_a(P, C););
    PHASE(PH_NSB, nsa_phase_b(P, C););
    PHASE(PH_G4, run_gemm(C, P.ATTB, P.WOB_T, MPAD, D_MODEL, 1024, EpiPre{P.X2, nullptr, P.PRE}););
    PHASE(PH_LN3, ln_phase(P, C, P.PRE, P.ln_g + 2 * D_MODEL, P.ln_b + 2 * D_MODEL, P.X3, P.X3B, nullptr, nullptr););
    PHASE(PH_SC1, run_gemm(C, P.X3B, P.WPK_T + (size_t)NPK * D_MODEL, MPAD, NPK, D_MODEL, EpiF32{P.SCO, NPK, MP}););
    PHASE(PH_TK1, topk_phase(P, C););
    PHASE(PH_PG1, peer_phase(P, C, 1, P.X3, P.y_prompt, P.y_sample, nullptr););
#undef IN
#undef SEAM
}
}
#ifndef ONE_LAUNCH
#define ONE_LAUNCH 1
#endif
extern "C" void kernel_launch(void* const* d_in, const int* in_sizes, int n_in, void* d_out, int out_size, void* d_ws, size_t ws_size, hipStream_t stream) {
    fx::Args a; memset(&a, 0, sizeof(a)); fx::bind_io(a.p, d_in, (float*)d_out);
    const size_t f_need = fx::carve(a.p, d_ws);
    if (f_need > ws_size) { fprintf(stderr, "kernel_launch: workspace too small: need %zu have %zu\n", f_need, ws_size); return; }
    static int grid = 0;
    if (!grid) { int dev = 0, cus = 0, per_cu = 0; (void)hipGetDevice(&dev); (void)hipDeviceGetAttribute(&cus, hipDeviceAttributeMultiprocessorCount, dev);
        (void)hipFuncSetAttribute((const void*)fx::mega, hipFuncAttributeMaxDynamicSharedMemorySize, fx::LDS_BYTES);
        if (hipOccupancyMaxActiveBlocksPerMultiprocessor(&per_cu, (const void*)fx::mega, fx::NTHREADS, fx::LDS_BYTES) != hipSuccess || per_cu < 1) { fprintf(stderr, "kernel_launch: occupancy query says %d blocks per CU\n", per_cu); (void)hipGetLastError(); }
        grid = cus; }
    (void)hipMemsetAsync(a.p.ctl, 0, fx::CTL_BYTES, stream);
#if ONE_LAUNCH
    a.lo = 0; a.hi = fx::PH_COUNT; hipLaunchKernelGGL(fx::mega, dim3(grid), dim3(fx::NTHREADS), fx::LDS_BYTES, stream, a);
#else
    for (int k = 0; k < fx::PH_COUNT; ++k) { a.lo = k; a.hi = k + 1; hipLaunchKernelGGL(fx::mega, dim3(grid), dim3(fx::NTHREADS), fx::LDS_BYTES, stream, a); }
#endif
}
```

```cpp
#define ONE_LAUNCH 1
#include <hip/hip_runtime.h>
#include <cstdio>
#include <cstring>
#include <cmath>
#ifdef CPU_TEST
#define HD inline
constexpr int D_MODEL = 128, BATCH = 2, SEQ = 512, DEPTH = 2, DEC_BATCH = 3, DEC_SEQ = 1, PAST_LEN = 512, PAGE_SIZE = 128;
constexpr int DIL_W[3] = {16, 64, 256}, DIL_D[3] = {1, 4, 16}, DIL_TAPS = 17;
constexpr int MEM_TOKENS = 32, SLC_TOPK = 4, SWA_WINDOW = 64, PEER_KEYS = 16, PEER_TOPK = 4;
#else
#define HD __host__ __device__ __forceinline__
constexpr int D_MODEL = 1024, BATCH = 2, SEQ = 8192, DEPTH = 2, DEC_BATCH = 32, DEC_SEQ = 1, PAST_LEN = 8192, PAGE_SIZE = 128;
constexpr int DIL_W[3] = {128, 512, 2048}, DIL_D[3] = {1, 4, 16}, DIL_TAPS = 129;
constexpr int MEM_TOKENS = 256, SLC_TOPK = 16, SWA_WINDOW = 512, PEER_KEYS = 128, PEER_TOPK = 16;
#endif
HD constexpr int dil_w(int g) { return g == 0 ? DIL_W[0] : (g == 1 ? DIL_W[1] : DIL_W[2]); }
HD constexpr int dil_d(int g) { return g == 0 ? DIL_D[0] : (g == 1 ? DIL_D[1] : DIL_D[2]); }
constexpr int HEAD_DIM = 64, N_A_LAYERS = DEPTH / 2, N_DIL = 3, DIL_HEADS = 4, DIL_COLS = N_DIL * 3 * DIL_HEADS * HEAD_DIM;
constexpr int MEM_HEADS = 4, MEM_COLS = MEM_HEADS * HEAD_DIM;
constexpr int NSA_HEADS = 12, NSA_KV_HEADS = 2, NSA_GROUP = 6, NSA_Q_COLS = NSA_HEADS * HEAD_DIM, NSA_GATE_COLS = NSA_HEADS * 3;
constexpr int CMP_BLOCK = 32, CMP_STRIDE = 16, CMP_HIDDEN = 128, SLC_BLOCK = 64;
constexpr int PEER_EXPERTS = PEER_KEYS * PEER_KEYS, PEER_HEADS = 8, PEER_KEY_DIM = 128;
constexpr float FORCE_SCORE = 1.0e9f, NEG = -1.0e30f, SCALE = 0.125f, LN_EPS = 1e-5f;
constexpr float ALPHA = 1.41421356237309515f;
constexpr float BETA = 0.5f;
#define LAS __attribute__((address_space(3)))
namespace pg8 {
#define PG8_LAS __attribute__((address_space(3)))
typedef unsigned short bf16_t;
typedef short bf16x8 __attribute__((ext_vector_type(8)));
typedef float f32x4 __attribute__((ext_vector_type(4)));
typedef unsigned u32x4 __attribute__((ext_vector_type(4)));
constexpr int BM = 256, BK = 64, HALF = 128, HTB = HALF * BK * 2  , STAGE_BYTES = 8 * HTB, NXCD = 8, WGM = 8;

__host__ __device__ __forceinline__ int lds_byte(int r, int c) { const int st = (r >> 4) * 2 + (c >> 5), rr = r & 15, cc = c & 31, ob = rr * 64 + cc * 2; return st * 1024 + (ob ^ (((ob >> 9) & 1) << 5)); }
__host__ __device__ __forceinline__ void stage_rc(int b, int& R, int& C) { const int st = b / 1024, sb = b % 1024, swz = sb ^ (((sb >> 9) & 1) << 5); R = (st >> 1) * 16 + swz / 64; C = (st & 1) * 32 + (swz % 64) / 2; }
__host__ __device__ __forceinline__ int perm32(int rho) { const int n = rho >> 4, i = rho & 15; return 8 * (i >> 2) + 4 * n + (i & 3); }

struct Unit { int pm, pn; };
struct Gemm { const bf16_t* A; const bf16_t* Bt; int M, N, K; };

struct StaticOrder {
    int nM, nN, nwg, G, c;
    __host__ __device__ void init(int M, int N, int G_, int c_) { nM = M / BM; nN = N / BM; nwg = nM * nN; G = G_; c = c_; }
    __host__ __device__ bool next(int i, Unit& u) const {
        const long L = (long)i * G + c; if (L >= nwg) return false;
        int wgid = (int)L; { const int q = nwg / NXCD, r = nwg % NXCD, xcd = wgid % NXCD, off = wgid / NXCD; wgid = (xcd < r ? xcd * (q + 1) : r * (q + 1) + (xcd - r) * q) + off; }
        const int nig = WGM * nN, gid = wgid / nig, fm = gid * WGM, gsz = (nM - fm) < WGM ? (nM - fm) : WGM;
        u.pm = fm + ((wgid % nig) % gsz); u.pn = (wgid % nig) / gsz; return true;
    }
    __device__ __forceinline__ void a_ready(const Unit&) const {}
    __device__ __forceinline__ void done(const Unit&) const {}
};

__device__ __forceinline__ unsigned cvt_pk_bf16(float lo, float hi) { unsigned r; asm volatile("v_cvt_pk_bf16_f32 %0, %1, %2" : "=v"(r) : "v"(lo), "v"(hi)); return r; }
typedef float f32x2 __attribute__((ext_vector_type(2)));
typedef float f32x2 __attribute__((ext_vector_type(2)));
template <class Epi, class Sched, bool ALIGN_EPI = false, bool SP2 = false>
__device__ __forceinline__ void gemm_phase(PG8_LAS unsigned char* lds, const Gemm g, const Sched& S, const Epi& E) {
    const int tid = threadIdx.x, wid = __builtin_amdgcn_readfirstlane(tid >> 6), lane = tid & 63, wr = wid >> 2, wc = wid & 3, fr = lane & 15, fq = lane >> 4;
    const int K = g.K, nt = K / BK;
    unsigned voffA[2], voffB[2];
#pragma unroll
    for (int i = 0; i < 2; ++i) { int R, C; stage_rc(tid * 16 + i * 8192, R, C); const int Rb = Epi::PERM ? ((R & ~31) + perm32(R & 31)) : R;
        voffA[i] = (unsigned)(R * K + C) * 2u; voffB[i] = (unsigned)(Rb * K + C) * 2u; }
    const size_t kstep = (size_t)(BK * 2);
    const size_t hstep = (size_t)HALF * K * 2;
    const size_t tstep = 2 * hstep;
    const unsigned ldsw = (unsigned)wid * 1024u;
    const int aoff = lds_byte(wr * 64 + fr, fq * 8), boff = lds_byte(wc * 32 + fr, fq * 8);
#define PG8_SA(b, h) (((b) * 2 + (h)) * HTB)
#define PG8_SB(b, h) ((4 + (b) * 2 + (h)) * HTB)
#define PG8_STAGE(bufoff, gbase, voff) do { _Pragma("unroll") for (int _i = 0; _i < 2; ++_i) \
        __builtin_amdgcn_global_load_lds((const unsigned*)((const char*)(gbase) + (voff)[_i]), (PG8_LAS unsigned*)(lds + (bufoff) + ldsw + _i * 8192), 16, 0, 0); } while (0)
#define PG8_LDA(dst, b, h) do { _Pragma("unroll") for (int m = 0; m < 4; ++m) _Pragma("unroll") for (int k = 0; k < 2; ++k) dst[m][k] = *(const PG8_LAS bf16x8*)(lds + PG8_SA(b, h) + aoff + m * 2048 + k * 1024); } while (0)
#define PG8_LDB(dst, b, h) do { _Pragma("unroll") for (int n = 0; n < 2; ++n) _Pragma("unroll") for (int k = 0; k < 2; ++k) dst[n][k] = *(const PG8_LAS bf16x8*)(lds + PG8_SB(b, h) + boff + n * 2048 + k * 1024); } while (0)
#define PG8_MMA(ai, bj, At, Bt) do { __builtin_amdgcn_s_setprio(1); _Pragma("unroll") for (int m = 0; m < 4; ++m) _Pragma("unroll") for (int n = 0; n < 2; ++n) _Pragma("unroll") for (int k = 0; k < 2; ++k) \
        acc[ai][bj][m][n] = __builtin_amdgcn_mfma_f32_16x16x32_bf16(Bt[n][k], At[m][k], acc[ai][bj][m][n], 0, 0, 0); __builtin_amdgcn_s_setprio(0); } while (0)
#define PG8_WAIT_V(n) asm volatile("s_waitcnt vmcnt(" #n ")" ::: "memory")
#define PG8_WAIT_L(n) asm volatile("s_waitcnt lgkmcnt(" #n ")" ::: "memory")
#define PG8_BAR __builtin_amdgcn_s_barrier()
#define PG8_SCHED __builtin_amdgcn_sched_barrier(0)
    Unit cur, nxt; int ui = 0;
    if (!S.next(0, cur)) return;
    f32x4 acc[2][2][4][2];
#pragma unroll
    for (int a = 0; a < 2; ++a)
#pragma unroll
        for (int b = 0; b < 2; ++b)
#pragma unroll
            for (int m = 0; m < 4; ++m)
#pragma unroll
                for (int n = 0; n < 2; ++n) acc[a][b][m][n] = (f32x4){0.f, 0.f, 0.f, 0.f};
    bf16x8 At[4][2], B0[2][2], B1[2][2];
    const char* cA = (const char*)g.A + (size_t)cur.pm * tstep; const char* cB = (const char*)g.Bt + (size_t)cur.pn * tstep;
    S.a_ready(cur);
    if constexpr (SP2) {
        PG8_STAGE(PG8_SB(0, 0), cB, voffB); PG8_STAGE(PG8_SB(0, 1), cB + hstep, voffB); PG8_STAGE(PG8_SA(0, 0), cA, voffA); PG8_STAGE(PG8_SA(0, 1), cA + hstep, voffA);
        if (wr == 1) PG8_BAR;
        PG8_WAIT_V(2); PG8_BAR;
        PG8_STAGE(PG8_SB(1, 0), cB + kstep, voffB); PG8_STAGE(PG8_SA(1, 0), cA + kstep, voffA); PG8_STAGE(PG8_SB(1, 1), cB + hstep + kstep, voffB);
        PG8_WAIT_V(6); PG8_BAR;
    } else {
        PG8_STAGE(PG8_SB(0, 0), cB, voffB); PG8_STAGE(PG8_SA(0, 0), cA, voffA); PG8_STAGE(PG8_SB(0, 1), cB + hstep, voffB); PG8_STAGE(PG8_SA(0, 1), cA + hstep, voffA);
        if (wr == 1) PG8_BAR;
        PG8_WAIT_V(4); PG8_BAR;
        PG8_STAGE(PG8_SB(1, 0), cB + kstep, voffB); PG8_STAGE(PG8_SA(1, 0), cA + kstep, voffA); PG8_STAGE(PG8_SB(1, 1), cB + hstep + kstep, voffB);
        PG8_WAIT_V(6); PG8_BAR;
    }
    for (;;) {
        const bool has_next = S.next(ui + 1, nxt);
        const char* nA = has_next ? (const char*)g.A + (size_t)nxt.pm * tstep : cA; const char* nB = has_next ? (const char*)g.Bt + (size_t)nxt.pn * tstep : cB;
        for (int t = 0; t < nt; t += 2) {
            const bool last = (t == nt - 2);
            const char* a1 = cA + (size_t)(t + 1) * kstep;
            const char* a2 = last ? nA : cA + (size_t)(t + 2) * kstep; const char* b2 = last ? nB : cB + (size_t)(t + 2) * kstep;
            const char* a3 = a2 + kstep; const char* b3 = b2 + kstep;
            if (last && has_next) S.a_ready(nxt);
            if constexpr (SP2) {
            PG8_LDB(B0, 0, 0); PG8_LDB(B1, 0, 1); PG8_SCHED; PG8_LDA(At, 0, 0); PG8_STAGE(PG8_SA(1, 1), a1 + hstep, voffA);
            PG8_WAIT_V(8); PG8_WAIT_L(0); PG8_BAR; PG8_MMA(0, 0, At, B0); PG8_MMA(0, 1, At, B1); PG8_BAR; PG8_SCHED;
            PG8_LDA(At, 0, 1); PG8_STAGE(PG8_SB(0, 0), b2, voffB); PG8_STAGE(PG8_SB(0, 1), b2 + hstep, voffB); PG8_STAGE(PG8_SA(0, 0), a2, voffA);
            PG8_WAIT_V(8); PG8_WAIT_L(0); PG8_BAR; PG8_MMA(1, 0, At, B0); PG8_MMA(1, 1, At, B1); PG8_BAR; PG8_SCHED;
            PG8_LDB(B0, 1, 0); PG8_LDB(B1, 1, 1); PG8_SCHED; PG8_LDA(At, 1, 0); PG8_STAGE(PG8_SA(0, 1), a2 + hstep, voffA);
            PG8_WAIT_V(8); PG8_WAIT_L(0); PG8_BAR; PG8_MMA(0, 0, At, B0); PG8_MMA(0, 1, At, B1); PG8_BAR; PG8_SCHED;
            PG8_LDA(At, 1, 1); PG8_STAGE(PG8_SB(1, 0), b3, voffB); PG8_STAGE(PG8_SB(1, 1), b3 + hstep, voffB); PG8_STAGE(PG8_SA(1, 0), a3, voffA);
            PG8_WAIT_V(8); PG8_WAIT_L(0); PG8_BAR; PG8_MMA(1, 0, At, B0); PG8_MMA(1, 1, At, B1); PG8_BAR; PG8_SCHED;
            } else {
            PG8_LDB(B0, 0, 0); PG8_SCHED; PG8_LDA(At, 0, 0); PG8_STAGE(PG8_SA(1, 1), a1 + hstep, voffA);
            PG8_WAIT_L(8); PG8_BAR; PG8_WAIT_L(0); PG8_MMA(0, 0, At, B0); PG8_BAR; PG8_SCHED;
            PG8_LDB(B1, 0, 1); PG8_STAGE(PG8_SB(0, 0), b2, voffB);
            PG8_BAR; PG8_WAIT_L(0); PG8_MMA(0, 1, At, B1); PG8_BAR;
            PG8_LDA(At, 0, 1); PG8_STAGE(PG8_SA(0, 0), a2, voffA);
            PG8_BAR; PG8_WAIT_L(0); PG8_MMA(1, 0, At, B0); PG8_BAR; PG8_SCHED;
            PG8_STAGE(PG8_SB(0, 1), b2 + hstep, voffB);
            PG8_WAIT_V(6); PG8_BAR; PG8_MMA(1, 1, At, B1); PG8_BAR;
            PG8_LDB(B0, 1, 0); PG8_SCHED; PG8_LDA(At, 1, 0); PG8_STAGE(PG8_SA(0, 1), a2 + hstep, voffA);
            PG8_WAIT_L(8); PG8_BAR; PG8_WAIT_L(0); PG8_MMA(0, 0, At, B0); PG8_BAR; PG8_SCHED;
            PG8_LDB(B1, 1, 1); PG8_STAGE(PG8_SB(1, 0), b3, voffB);
            PG8_BAR; PG8_WAIT_L(0); PG8_MMA(0, 1, At, B1); PG8_BAR;
            PG8_LDA(At, 1, 1); PG8_STAGE(PG8_SA(1, 0), a3, voffA);
            PG8_BAR; PG8_WAIT_L(0); PG8_MMA(1, 0, At, B0); PG8_BAR; PG8_SCHED;
            PG8_STAGE(PG8_SB(1, 1), b3 + hstep, voffB);
            PG8_WAIT_V(6); PG8_BAR; PG8_MMA(1, 1, At, B1); PG8_BAR;
            }
        }
        if constexpr (ALIGN_EPI) { if (wr == 0) PG8_BAR; }
        if constexpr (!Epi::AFTER_DRAIN) { E(acc, cur, wr, wc, fr, fq); S.done(cur); }
        if (!has_next) break;
#pragma unroll
        for (int a = 0; a < 2; ++a)
#pragma unroll
            for (int b = 0; b < 2; ++b)
#pragma unroll
                for (int m = 0; m < 4; ++m)
#pragma unroll
                    for (int n = 0; n < 2; ++n) acc[a][b][m][n] = (f32x4){0.f, 0.f, 0.f, 0.f};
        cur = nxt; cA = nA; cB = nB; ++ui;
        if constexpr (ALIGN_EPI) { if (wr == 1) PG8_BAR; }
    }
    PG8_WAIT_V(0);
    if constexpr (!ALIGN_EPI) { if (wr == 0) PG8_BAR; }
    PG8_BAR;
    if constexpr (Epi::AFTER_DRAIN) { E.fused(acc, cur, wr, wc, fr, fq, lds, wid, lane); S.done(cur); }
#undef PG8_SA
#undef PG8_SB
#undef PG8_STAGE
#undef PG8_LDA
#undef PG8_LDB
#undef PG8_MMA
#undef PG8_WAIT_V
#undef PG8_WAIT_L
#undef PG8_BAR
#undef PG8_SCHED
}
}
#define XB_TMO      128
#define XB_XCNT(j)  (256  + 64 * (j))
#define XB_XSUB(j)  (1280 + 64 * (j))
#define XB_XGEN(j)  (2304 + 64 * (j))
#define XB_TOP      3328
#define XB_TOPGEN   3392
#define XCD_BAR_WORDS 3456
#define XB_SPIN_CAP (1u << 18)

__device__ __forceinline__ unsigned xb_ld(unsigned* p)              { return __hip_atomic_load(p, __ATOMIC_RELAXED, __HIP_MEMORY_SCOPE_AGENT); }
__device__ __forceinline__ unsigned xb_add(unsigned* p, unsigned v) { return __hip_atomic_fetch_add(p, v, __ATOMIC_RELAXED, __HIP_MEMORY_SCOPE_AGENT); }
__device__ __forceinline__ unsigned xb_xcc_id() { return (unsigned)__builtin_amdgcn_s_getreg((3 << 11) | 20) & 0xFu; }
#define XB_SPIN(cond, bar) do { unsigned _sp = 0; while (cond) { __builtin_amdgcn_s_sleep(1); \
    if ((++_sp & 255u) == 0u) { if (xb_ld(&(bar)[XB_TMO])) break; if (_sp > XB_SPIN_CAP) { atomicAdd(&(bar)[XB_TMO], 1u); break; } } } } while (0)

struct XcdBarrier {
    unsigned* bar; unsigned x;
    volatile LAS unsigned* st;
};

__device__ __forceinline__ XcdBarrier xcd_barrier_post(unsigned* bar, volatile LAS unsigned* st) {
    XcdBarrier b; b.bar = bar; b.x = xb_xcc_id(); b.st = st;
    if (threadIdx.x == 0) (void)xb_add(&bar[XB_XCNT(b.x)], 1u);
    return b;
}
__device__ __forceinline__ void xcd_barrier_complete(unsigned* bar, unsigned x, unsigned& nloc, unsigned& nx) {
    const unsigned G = gridDim.x * gridDim.y * gridDim.z;
    unsigned sum, cnt, mine, sp = 0u;
    for (;;) {
        sum = 0u; cnt = 0u; mine = 0u;
#pragma unroll
        for (unsigned j = 0; j < 16; ++j) { const unsigned c = xb_ld(&bar[XB_XCNT(j)]); sum += c; cnt += (c > 0u) ? 1u : 0u; mine = (j == x) ? c : mine; }
        if (sum == G) break;
        __builtin_amdgcn_s_sleep(1);
        if ((++sp & 255u) == 0u) { if (xb_ld(&bar[XB_TMO])) break; if (sp > XB_SPIN_CAP) { atomicAdd(&bar[XB_TMO], 1u); break; } }
    }
    nloc = mine > 0u ? mine : 1u; nx = cnt > 0u ? cnt : 1u;
}

__device__ __forceinline__ void xcd_barrier(const XcdBarrier& b) {
    asm volatile("s_waitcnt vmcnt(0)" ::: "memory");
    __syncthreads();
    if (threadIdx.x == 0) {
        unsigned* bar = b.bar;
        __builtin_amdgcn_s_waitcnt(0);
        unsigned nloc = b.st[0], nx = b.st[1];
        if (nloc == 0u) { xcd_barrier_complete(bar, b.x, nloc, nx); b.st[0] = nloc; b.st[1] = nx; }
        const unsigned old = xb_add(&bar[XB_XSUB(b.x)], 1u);
        const unsigned gen = old / nloc;
        if (old + 1u == (gen + 1u) * nloc) {
            __builtin_amdgcn_fence(__ATOMIC_RELEASE, "agent");
            asm volatile("s_waitcnt vmcnt(0)" ::: "memory");
            const unsigned og = xb_add(&bar[XB_TOP], 1u);
            const unsigned tg = og / nx;
            if (og + 1u == (tg + 1u) * nx) xb_add(&bar[XB_TOPGEN], 1u);
            else XB_SPIN(xb_ld(&bar[XB_TOPGEN]) == tg, bar);
            __builtin_amdgcn_fence(__ATOMIC_ACQUIRE, "agent");
            xb_add(&bar[XB_XGEN(b.x)], 1u);
            asm volatile("s_waitcnt vmcnt(0)" ::: "memory");
        } else {
            XB_SPIN(xb_ld(&bar[XB_XGEN(b.x)]) == gen, bar);
            __builtin_amdgcn_fence(__ATOMIC_ACQUIRE, "agent");
            asm volatile("s_waitcnt vmcnt(0)" ::: "memory");
        }
    }
    __syncthreads();
}
namespace fx {
#define DI __device__ __forceinline__
typedef unsigned short bf16;
typedef short bf16x8 __attribute__((ext_vector_type(8)));
typedef float f32x4 __attribute__((ext_vector_type(4)));
typedef float f32x2 __attribute__((ext_vector_type(2)));
typedef unsigned u32x4 __attribute__((ext_vector_type(4)));
typedef unsigned u32x2 __attribute__((ext_vector_type(2)));
constexpr int M0 = BATCH * SEQ, MP = M0 + DEC_BATCH, MPAD = ((MP + 255) / 256) * 256;
constexpr int ACOLS = DIL_COLS + MEM_COLS, BCOLS = NSA_Q_COLS + NSA_GATE_COLS + MEM_COLS, KVCOLS = 6 * NSA_KV_HEADS * HEAD_DIM;
constexpr int NB_T = 2048;
constexpr int NPK = PEER_HEADS * 2 * PEER_KEYS;
constexpr int NCMP = (SEQ - CMP_BLOCK) / CMP_STRIDE + 1;
constexpr int NCH = SEQ / CMP_STRIDE;
constexpr int NCTX = BATCH + DEC_BATCH;
constexpr int ACROWS = NCTX * NSA_KV_HEADS * NCH;
constexpr int NPOS = PAST_LEN + 1;
constexpr float QSCALE = 0.125f * 1.4426950408889634f;
constexpr int NTHREADS = 512, NWAVES = 8, LDS_BYTES = 147456, RING_BYTES = 131072, MISC_OFF = RING_BYTES + 320;

struct FP {
    const float *x_prompt, *x_sample, *mem_prompt, *cache_dil[3], *cache_nsa_kv, *cache_nsa_win, *cache_mem_kv; const int* page_table;
    const float *w_in_a, *w_out_a, *w_in_b, *w_out_b, *w_mem_kv, *w_kv_b, *cmp_pe, *cmp_w1, *cmp_w2, *ln_g, *ln_b, *peer_wq, *peer_keys, *peer_u, *peer_v;
    float *y_prompt, *y_sample, *dil_p[3], *dil_s[3], *nsa_kv_p, *nsa_kv_s, *win_p, *win_s, *mem_kv_p;
    unsigned* ctl;
    bf16 *XB0, *X1B, *X2B, *X3B, *WA_T, *WMEM_T, *MEMB, *WOA_T, *WOB_T, *WPK_T, *WB_T, *CW1_T, *AC; unsigned char *UB8, *VB8;
    float *ROPE, *CBIAS;
    bf16 *QA, *KA, *VTA, *MQA, *MK, *MVT, *ATTA;
    float *DPART, *DML, *PRE, *X1, *X2, *X3, *SCO, *SELG; int* SELE;
    bf16 *SLK, *SLVT, *WNK, *WNVT, *QB, *MQB, *CK, *CVT, *ATTB;
    float *GATES, *UL, *CKF, *CVF;
    int* SELB;
    float* DBG;
};
struct Args { FP p; int lo, hi; };
struct Carve { size_t off = 0; template <class T> T* take(void* base, size_t n) { T* r = (T*)((char*)base + off); off += ((n * sizeof(T) + 255) / 256) * 256; return r; } };
constexpr size_t CTL_BYTES = 65536;
inline size_t carve(FP& p, void* base) {
    Carve c;
    p.ctl = c.take<unsigned>(base, CTL_BYTES / 4);
    p.XB0 = c.take<bf16>(base, (size_t)MPAD * D_MODEL); p.X1B = c.take<bf16>(base, (size_t)MPAD * D_MODEL); p.X2B = c.take<bf16>(base, (size_t)MPAD * D_MODEL); p.X3B = c.take<bf16>(base, (size_t)MPAD * D_MODEL);
    p.WA_T = c.take<bf16>(base, (size_t)ACOLS * D_MODEL); p.WMEM_T = c.take<bf16>(base, (size_t)DEPTH * 2 * MEM_COLS * D_MODEL); p.MEMB = c.take<bf16>(base, (size_t)BATCH * MEM_TOKENS * D_MODEL);
    p.WOA_T = c.take<bf16>(base, (size_t)D_MODEL * 2 * MEM_COLS); p.WOB_T = c.take<bf16>(base, (size_t)D_MODEL * (NSA_Q_COLS + MEM_COLS));
    p.WPK_T = c.take<bf16>(base, (size_t)DEPTH * NPK * D_MODEL); p.WB_T = c.take<bf16>(base, (size_t)NB_T * D_MODEL);
    p.UB8 = c.take<unsigned char>(base, (size_t)DEPTH * PEER_EXPERTS * D_MODEL); p.VB8 = c.take<unsigned char>(base, (size_t)DEPTH * PEER_EXPERTS * D_MODEL);
    p.CW1_T = c.take<bf16>(base, (size_t)2 * 256 * 1024); p.AC = c.take<bf16>(base, (size_t)2 * ACROWS * 1024);
    p.ROPE = c.take<float>(base, (size_t)NPOS * 64); p.CBIAS = c.take<float>(base, 2 * CMP_HIDDEN);
    p.QA = c.take<bf16>(base, (size_t)3 * MPAD * 256); p.KA = c.take<bf16>(base, (size_t)3 * MPAD * 256); p.VTA = c.take<bf16>(base, (size_t)3 * BATCH * DIL_HEADS * HEAD_DIM * SEQ + 4096);
    p.MQA = c.take<bf16>(base, (size_t)MPAD * 256); p.MK = c.take<bf16>(base, (size_t)DEPTH * BATCH * MEM_TOKENS * MEM_COLS); p.MVT = c.take<bf16>(base, (size_t)DEPTH * BATCH * MEM_COLS * MEM_TOKENS);
    p.ATTA = c.take<bf16>(base, (size_t)MPAD * 2 * MEM_COLS);
    p.DPART = c.take<float>(base, (size_t)3 * MP * DIL_HEADS * HEAD_DIM); p.DML = c.take<float>(base, (size_t)3 * MP * DIL_HEADS * 2);
    p.PRE = c.take<float>(base, (size_t)MPAD * D_MODEL); p.X1 = c.take<float>(base, (size_t)MPAD * D_MODEL); p.X2 = c.take<float>(base, (size_t)MPAD * D_MODEL); p.X3 = c.take<float>(base, (size_t)MPAD * D_MODEL);
    p.SCO = c.take<float>(base, (size_t)MPAD * NPK); p.SELG = c.take<float>(base, (size_t)MP * 128); p.SELE = c.take<int>(base, (size_t)MP * 128);
    p.SLK = c.take<bf16>(base, (size_t)BATCH * NSA_KV_HEADS * SEQ * HEAD_DIM); p.SLVT = c.take<bf16>(base, (size_t)BATCH * NSA_KV_HEADS * SEQ * HEAD_DIM);
    p.WNK = c.take<bf16>(base, (size_t)BATCH * NSA_KV_HEADS * SEQ * HEAD_DIM + 4096); p.WNVT = c.take<bf16>(base, (size_t)BATCH * NSA_KV_HEADS * SEQ * HEAD_DIM + 4096);
    p.QB = c.take<bf16>(base, (size_t)MPAD * NSA_Q_COLS); p.MQB = c.take<bf16>(base, (size_t)MPAD * 256);
    p.CK = c.take<bf16>(base, (size_t)NCTX * NSA_KV_HEADS * NCH * HEAD_DIM); p.CVT = c.take<bf16>(base, (size_t)NCTX * NSA_KV_HEADS * HEAD_DIM * NCH); p.ATTB = c.take<bf16>(base, (size_t)MPAD * (NSA_Q_COLS + MEM_COLS));
    p.GATES = c.take<float>(base, (size_t)MPAD * 64); p.UL = c.take<float>(base, (size_t)2 * ACROWS * 256);
    p.CKF = c.take<float>(base, (size_t)DEC_BATCH * NSA_KV_HEADS * NCH * HEAD_DIM); p.CVF = c.take<float>(base, (size_t)DEC_BATCH * NSA_KV_HEADS * NCH * HEAD_DIM);
    p.SELB = c.take<int>(base, (size_t)MP * NSA_KV_HEADS * 16);
#ifdef NSA_DEBUG
    p.DBG = c.take<float>(base, (size_t)3 * MP * 768);
#else
    p.DBG = nullptr;
#endif
    return c.off;
}
inline void bind_io(FP& p, void* const* d_in, float* out) {
    p.x_prompt = (const float*)d_in[0]; p.x_sample = (const float*)d_in[1]; p.mem_prompt = (const float*)d_in[2]; p.cache_dil[0] = (const float*)d_in[3]; p.cache_dil[1] = (const float*)d_in[4]; p.cache_dil[2] = (const float*)d_in[5];
    p.cache_nsa_kv = (const float*)d_in[6]; p.cache_nsa_win = (const float*)d_in[7]; p.cache_mem_kv = (const float*)d_in[8]; p.page_table = (const int*)d_in[9];
    p.w_in_a = (const float*)d_in[10]; p.w_out_a = (const float*)d_in[11]; p.w_in_b = (const float*)d_in[12]; p.w_out_b = (const float*)d_in[13]; p.w_mem_kv = (const float*)d_in[14]; p.w_kv_b = (const float*)d_in[15];
    p.cmp_pe = (const float*)d_in[16]; p.cmp_w1 = (const float*)d_in[17]; p.cmp_w2 = (const float*)d_in[18]; p.ln_g = (const float*)d_in[19]; p.ln_b = (const float*)d_in[20];
    p.peer_wq = (const float*)d_in[21]; p.peer_keys = (const float*)d_in[22]; p.peer_u = (const float*)d_in[23]; p.peer_v = (const float*)d_in[24];
    size_t o = 0; auto take = [&](size_t n) { float* r = out + o; o += n; return r; };
    p.y_prompt = take((size_t)M0 * D_MODEL); p.y_sample = take((size_t)DEC_BATCH * D_MODEL);
    for (int g = 0; g < 3; ++g) p.dil_p[g] = take((size_t)BATCH * DIL_W[g] * 2 * DIL_HEADS * HEAD_DIM);
    for (int g = 0; g < 3; ++g) p.dil_s[g] = take((size_t)DEC_BATCH * DIL_W[g] * 2 * DIL_HEADS * HEAD_DIM);
    p.nsa_kv_p = take((size_t)M0 * 4 * NSA_KV_HEADS * HEAD_DIM); p.nsa_kv_s = take((size_t)DEC_BATCH * 4 * NSA_KV_HEADS * HEAD_DIM);
    p.win_p = take((size_t)BATCH * SWA_WINDOW * 2 * NSA_KV_HEADS * HEAD_DIM); p.win_s = take((size_t)DEC_BATCH * SWA_WINDOW * 2 * NSA_KV_HEADS * HEAD_DIM);
    p.mem_kv_p = take((size_t)DEPTH * BATCH * MEM_TOKENS * 2 * MEM_COLS);
}
DI unsigned f2bf(float f) { unsigned u = __builtin_bit_cast(unsigned, f); return (u + 0x7fffu + ((u >> 16) & 1u)) >> 16; }
DI unsigned pk2(float lo, float hi) { return f2bf(lo) | (f2bf(hi) << 16); }
DI float bf2f(unsigned short b) { return __builtin_bit_cast(float, (unsigned)b << 16); }
DI float bflo(unsigned w) { return __builtin_bit_cast(float, w << 16); }
DI float bfhi(unsigned w) { return __builtin_bit_cast(float, w & 0xffff0000u); }
DI float wave_sum(float v) {
#pragma unroll
    for (int o = 1; o < 64; o <<= 1) v += __shfl_xor(v, o);
    return v; }
DI float wave_max(float v) {
#pragma unroll
    for (int o = 1; o < 64; o <<= 1) v = fmaxf(v, __shfl_xor(v, o));
    return v; }
DI float gelu_tanh(float x) { const float u = 0.7978845608028654f * (x + 0.044715f * x * x * x); const float e = __builtin_amdgcn_exp2f(u * 2.885390081777927f);   const float t = 1.0f - 2.0f / (e + 1.0f); return 0.5f * x * (1.0f + t); }
DI float* sel3(float* const (&a)[3], int g) { return g == 0 ? a[0] : (g == 1 ? a[1] : a[2]); }
DI const float* sel3c(const float* const (&a)[3], int g) { return g == 0 ? a[0] : (g == 1 ? a[1] : a[2]); }
struct Ctx { LAS unsigned char* lds; int tid, lane, wave, vcu, G; };
DI int row_pos(int r) { return r < M0 ? (r & (SEQ - 1)) : PAST_LEN; }

struct ColSrc { const float* p; int ld; };
DI int rope_il(int e) { return (e >> 1) + 32 * (e & 1); }
DI ColSrc col_wa(const FP& P, int n) {
    const int t = n >> 8, ct = n & 255, h = ct >> 6, e = ct & 63; if (t >= 9) return ColSrc{P.w_in_a + DIL_COLS + ct, ACOLS};
    const int j = t % 3, d = (j < 2) ? rope_il(e) : e; return ColSrc{P.w_in_a + t * 256 + h * 64 + d, ACOLS}; }
DI ColSrc col_wb(const FP& P, int n) {
    const int t = n >> 8, ct = n & 255, e = ct & 63;
    if (t < 3) { const int ty = 2 * t + (ct >> 7), kvh = (ct >> 6) & 1; const bool rot = (ty == 2 || ty == 4); return ColSrc{P.w_kv_b + (ty * NSA_KV_HEADS + kvh) * 64 + (rot ? rope_il(e) : e), KVCOLS}; }
    if (t < 6) { const int h = (t - 3) * 4 + (ct >> 6); return ColSrc{P.w_in_b + h * 64 + rope_il(e), BCOLS}; }
    if (t == 6) return ColSrc{P.w_in_b + NSA_Q_COLS + NSA_GATE_COLS + ct, BCOLS};
    if (ct < NSA_GATE_COLS) return ColSrc{P.w_in_b + NSA_Q_COLS + ct, BCOLS};
    return ColSrc{nullptr, 0}; }
DI ColSrc col_wmem(const FP& P, int n) { const int l = n >> 9, c = n & 511; return ColSrc{P.w_mem_kv + (size_t)l * D_MODEL * 512 + c, 512}; }
DI ColSrc col_woa(const FP& P, int n) { return ColSrc{P.w_out_a + n, D_MODEL}; }
DI ColSrc col_wob(const FP& P, int n) { return ColSrc{P.w_out_b + n, D_MODEL}; }
DI ColSrc col_cw1(const FP& P, int n) {
    const int ty = n >> 8, half = (n >> 7) & 1, hid = n & 127; return ColSrc{P.cmp_w1 + (size_t)ty * CMP_BLOCK * HEAD_DIM * CMP_HIDDEN + (size_t)half * 16 * HEAD_DIM * CMP_HIDDEN + hid, CMP_HIDDEN}; }
template <class CF> DI void transpose_item(const FP& P, CF cf, int K, bf16* WT, LAS float* scr, int item, int nblk, int lane) {
    const int kb = item / nblk, nb = item % nblk, k0 = 64 * kb, n0 = 32 * nb;
    const ColSrc cs = cf(P, n0 + (lane & 31));
#pragma unroll 8
    for (int i = 0; i < 32; ++i) { const int kk = 2 * i + (lane >> 5); scr[kk * 33 + (lane & 31)] = cs.p ? cs.p[(size_t)(k0 + kk) * cs.ld] : 0.f; }
    asm volatile("s_waitcnt lgkmcnt(0)" ::: "memory");
    const int c = lane & 7;
#pragma unroll
    for (int j = 0; j < 4; ++j) { const int n = (lane >> 3) + 8 * j; const LAS float* s = scr + (8 * c) * 33 + n;
        u32x4 o; o.x = pk2(s[0 * 33], s[1 * 33]); o.y = pk2(s[2 * 33], s[3 * 33]); o.z = pk2(s[4 * 33], s[5 * 33]); o.w = pk2(s[6 * 33], s[7 * 33]);
        *(u32x4*)(WT + (size_t)(n0 + n) * K + k0 + 8 * c) = o; }
    asm volatile("s_waitcnt lgkmcnt(0)" ::: "memory");
}
DI void cvt_row1024(const float* src, bf16* dst, int lane) {
#pragma unroll
    for (int j = 0; j < 4; ++j) { f32x4 v = src ? *(const f32x4*)(src + 256 * j + 4 * lane) : (f32x4){0.f, 0.f, 0.f, 0.f}; u32x2 o; o.x = pk2(v.x, v.y); o.y = pk2(v.z, v.w); *(u32x2*)(dst + 256 * j + 4 * lane) = o; }
}
DI void cvt_row1024_fp8(const float* src, unsigned char* dst, float sc, int lane) { u32x4 o; unsigned w[4];
#pragma unroll
    for (int j = 0; j < 4; ++j) { const f32x4 v = *(const f32x4*)(src + 16 * lane + 4 * j) * sc; int t = __builtin_amdgcn_cvt_pk_fp8_f32(v.x, v.y, 0, false); t = __builtin_amdgcn_cvt_pk_fp8_f32(v.z, v.w, t, true); w[j] = (unsigned)t; }
    o.x = w[0]; o.y = w[1]; o.z = w[2]; o.w = w[3]; *(u32x4*)(dst + 16 * lane) = o; }
DI void p0_prologue(const FP& P, const Ctx& C) {
    LAS float* scr = (LAS float*)(C.lds + C.wave * 16384);
    const int gw = C.vcu * NWAVES + C.wave, NGW = C.G * NWAVES, lane = C.lane;
    { constexpr int IA = (D_MODEL / 64) * (ACOLS / 32), IM = (D_MODEL / 64) * (1024 / 32), IOA = (512 / 64) * (D_MODEL / 32), IOB = (1024 / 64) * (D_MODEL / 32), IB = (D_MODEL / 64) * (NB_T / 32), IC = (1024 / 64) * (512 / 32);
      constexpr int NIT = IA + IM + IOA + IOB + IB + IC;
      for (int it = gw; it < NIT; it += NGW) { int r = it;
          if (r < IA) { transpose_item(P, col_wa, D_MODEL, P.WA_T, scr, r, ACOLS / 32, lane); continue; } r -= IA;
          if (r < IM) { transpose_item(P, col_wmem, D_MODEL, P.WMEM_T, scr, r, 1024 / 32, lane); continue; } r -= IM;
          if (r < IOA) { transpose_item(P, col_woa, 512, P.WOA_T, scr, r, D_MODEL / 32, lane); continue; } r -= IOA;
          if (r < IOB) { transpose_item(P, col_wob, 1024, P.WOB_T, scr, r, D_MODEL / 32, lane); continue; } r -= IOB;
          if (r < IB) { transpose_item(P, col_wb, D_MODEL, P.WB_T, scr, r, NB_T / 32, lane); continue; } r -= IB;
          transpose_item(P, col_cw1, 1024, P.CW1_T, scr, r, 512 / 32, lane); } }
    for (int r = gw; r < MPAD; r += NGW) { cvt_row1024(r < M0 ? P.x_prompt + (size_t)r * D_MODEL : (r < MP ? P.x_sample + (size_t)(r - M0) * D_MODEL : nullptr), P.XB0 + (size_t)r * D_MODEL, lane);
        if (r >= MP) { cvt_row1024(nullptr, P.X1B + (size_t)r * D_MODEL, lane); cvt_row1024(nullptr, P.X2B + (size_t)r * D_MODEL, lane); cvt_row1024(nullptr, P.X3B + (size_t)r * D_MODEL, lane);
            for (int c = lane; c < 512; c += 64) { P.ATTA[(size_t)r * 512 + c] = 0; P.ATTB[(size_t)r * 1024 + c] = 0; P.ATTB[(size_t)r * 1024 + 512 + c] = 0; } } }
    for (int r = gw; r < BATCH * MEM_TOKENS; r += NGW) cvt_row1024(P.mem_prompt + (size_t)r * D_MODEL, P.MEMB + (size_t)r * D_MODEL, lane);
    for (int r = gw; r < DEPTH * PEER_EXPERTS; r += NGW) { cvt_row1024_fp8(P.peer_u + (size_t)r * D_MODEL, P.UB8 + (size_t)r * D_MODEL, 256.f, lane); cvt_row1024_fp8(P.peer_v + (size_t)r * D_MODEL, P.VB8 + (size_t)r * D_MODEL, 64.f, lane); }
    for (int i = gw * 64 + lane; i < NPOS * 32; i += NGW * 64) { const int pos = i >> 5, d = i & 31; const double inv = exp2(-(double)d * (13.287712379549449 / 32.0)); const double turns = (double)pos * inv * 0.15915494309189535;
        const float fr = (float)(turns - floor(turns)); P.ROPE[pos * 64 + d] = __builtin_amdgcn_cosf(fr); P.ROPE[pos * 64 + 32 + d] = __builtin_amdgcn_sinf(fr); }
    for (int i = gw * 64 + lane; i < 2 * CMP_HIDDEN; i += NGW * 64) { const int ty = i / CMP_HIDDEN, hid = i % CMP_HIDDEN; float a = 0.f; for (int k = 0; k < CMP_BLOCK * HEAD_DIM; ++k) a += P.cmp_pe[ty * CMP_BLOCK * HEAD_DIM + k] * P.cmp_w1[((size_t)ty * CMP_BLOCK * HEAD_DIM + k) * CMP_HIDDEN + hid]; P.CBIAS[i] = a; }
    for (int it = gw; it < DEC_BATCH * PAST_LEN; it += NGW) { const int n = it / PAST_LEN, t = it % PAST_LEN; const int pg = P.page_table[n * (PAST_LEN / PAGE_SIZE) + t / PAGE_SIZE];
        const f32x4 v = *(const f32x4*)(P.cache_nsa_kv + ((size_t)pg * PAGE_SIZE + t % PAGE_SIZE) * 512 + 4 * lane); const int ty = lane >> 5, kvh = (lane >> 4) & 1, d = (4 * lane) & 63;
        u32x2 o; o.x = pk2(v.x, v.y); o.y = pk2(v.z, v.w); *(u32x2*)(P.AC + ((size_t)ty * ACROWS + ((size_t)(BATCH + n) * NSA_KV_HEADS + kvh) * NCH + t / 16) * 1024 + (t % 16) * 64 + d) = o; }
    for (int g = 0; g < 3; ++g) { const int W = dil_w(g); const long nvec = (long)DEC_BATCH * (W - 1) * 128;
        for (long i = (long)gw * 64 + lane; i < nvec; i += (long)NGW * 64) { const long rr = i / 128; const int c4 = (int)(i % 128); const int n = (int)(rr / (W - 1)), w = (int)(rr % (W - 1));
            ((f32x4*)sel3(P.dil_s, g))[((size_t)n * W + w) * 128 + c4] = ((const f32x4*)sel3c(P.cache_dil, g))[((size_t)n * W + w + 1) * 128 + c4]; } }
    { const int W = SWA_WINDOW; const long nvec = (long)DEC_BATCH * (W - 1) * 64;
      for (long i = (long)gw * 64 + lane; i < nvec; i += (long)NGW * 64) { const long rr = i / 64; const int c4 = (int)(i % 64); const int n = (int)(rr / (W - 1)), w = (int)(rr % (W - 1));
          ((f32x4*)P.win_s)[((size_t)n * W + w) * 64 + c4] = ((const f32x4*)P.cache_nsa_win)[((size_t)n * W + w + 1) * 64 + c4]; } }
}
DI void p0_wpk(const FP& P, const Ctx& C) {
    LAS float* sw = (LAS float*)C.lds;
    LAS float* sk = (LAS float*)(C.lds + 32768);
    constexpr int NIT = DEPTH * 16 * (D_MODEL / 64);
    for (int it = C.vcu; it < NIT; it += C.G) { const int l = it / (16 * (D_MODEL / 64)), rem = it % (16 * (D_MODEL / 64)), hc = rem / (D_MODEL / 64), kb = rem % (D_MODEL / 64);
        __syncthreads();
        for (int i = C.tid; i < 64 * 64; i += NTHREADS) { const int r = i >> 6, d = i & 63; sw[r * 65 + d] = P.peer_wq[((size_t)l * D_MODEL + kb * 64 + r) * 1024 + hc * 64 + d]; }
        for (int i = C.tid; i < 128 * 64; i += NTHREADS) { const int r = i >> 6, d = i & 63; sk[r * 65 + d] = P.peer_keys[(((size_t)l * 16 + hc) * PEER_KEYS + r) * 64 + d]; }
        __syncthreads();
        for (int o = C.tid; o < 128 * 64; o += NTHREADS) { const int kk = o >> 6, ki = o & 63; float a = 0.f;
#pragma unroll 16
            for (int d = 0; d < 64; ++d) a += sw[ki * 65 + d] * sk[kk * 65 + d];
            P.WPK_T[((size_t)l * NPK + hc * 128 + kk) * D_MODEL + kb * 64 + ki] = (bf16)f2bf(a); } }
    __syncthreads();
}

#define EPI_LOOP(...) int fr_l = fr, fq_l = fq; asm volatile("" : "+v"(fr_l), "+v"(fq_l));     \
    _Pragma("unroll") for (int ai = 0; ai < 2; ++ai) _Pragma("unroll") for (int m = 0; m < 4; ++m) { const int row = u.pm * 256 + ai * 128 + wr * 64 + m * 16 + fr_l; \
    _Pragma("unroll") for (int bj = 0; bj < 2; ++bj) { const int ct = bj * 128 + wc * 32 + fq_l * 8; const f32x4 v0 = acc[ai][bj][m][0], v1 = acc[ai][bj][m][1]; __VA_ARGS__ } asm volatile("" ::: "memory"); }
DI void rope4(const float* rope_row, int dp, const f32x4& v0, const f32x4& v1, f32x4& lo, f32x4& hi) {
    const f32x4 c = *(const f32x4*)(rope_row + dp), s = *(const f32x4*)(rope_row + 32 + dp);
    lo.x = v0.x * c.x - v0.y * s.x; hi.x = v0.y * c.x + v0.x * s.x; lo.y = v0.z * c.y - v0.w * s.y; hi.y = v0.w * c.y + v0.z * s.y;
    lo.z = v1.x * c.z - v1.y * s.z; hi.z = v1.y * c.z + v1.x * s.z; lo.w = v1.z * c.w - v1.w * s.w; hi.w = v1.w * c.w + v1.z * s.w; }
DI u32x2 pk4(const f32x4& v) { u32x2 o; o.x = pk2(v.x, v.y); o.y = pk2(v.z, v.w); return o; }
DI u32x4 pk8(const f32x4& a, const f32x4& b) { u32x4 o; o.x = pk2(a.x, a.y); o.y = pk2(a.z, a.w); o.z = pk2(b.x, b.y); o.w = pk2(b.z, b.w); return o; }
DI int dil_perm(int t, int d) { return (t % d) * (SEQ / d) + t / d; }
struct EpiA {
    static constexpr bool PERM = true, AFTER_DRAIN = false; const FP& P;
    DI void operator()(const f32x4 (&acc)[2][2][4][2], const pg8::Unit& u, int wr, int wc, int fr, int fq) const {
        const int t9 = u.pn; const int g = t9 / 3, j = t9 % 3;
        EPI_LOOP({ if (row < MP) { const int h = ct >> 6, e = ct & 63; const int pos = row_pos(row);
            if (t9 == 9) { *(u32x4*)(P.MQA + (size_t)row * 256 + ct) = pk8(v0 * QSCALE, v1 * QSCALE); }
            else if (j < 2) { f32x4 lo, hi; const int dp = e >> 1; rope4(P.ROPE + pos * 64, dp, v0, v1, lo, hi);
                if (j == 0) { bf16* q = P.QA + ((size_t)g * MPAD + row) * 256 + h * 64 + dp; *(u32x2*)q = pk4(lo * QSCALE); *(u32x2*)(q + 32) = pk4(hi * QSCALE); }
                else { bf16* k = P.KA + ((size_t)g * MPAD + row) * 256 + h * 64 + dp; *(u32x2*)k = pk4(lo); *(u32x2*)(k + 32) = pk4(hi);
                    const int W = dil_w(g); float* o = nullptr;
                    if (row >= M0) o = sel3(P.dil_s, g) + (((size_t)(row - M0) * W + W - 1) * 2 + 0) * 256; else if (pos >= SEQ - W) o = sel3(P.dil_p, g) + (((size_t)(row / SEQ) * W + pos - (SEQ - W)) * 2 + 0) * 256;
                    if (o) { *(f32x4*)(o + h * 64 + dp) = lo; *(f32x4*)(o + h * 64 + 32 + dp) = hi; } } }
            else { const int W = dil_w(g), d = dil_d(g); float* o = nullptr;
                if (row >= M0) o = sel3(P.dil_s, g) + (((size_t)(row - M0) * W + W - 1) * 2 + 1) * 256; else if (pos >= SEQ - W) o = sel3(P.dil_p, g) + (((size_t)(row / SEQ) * W + pos - (SEQ - W)) * 2 + 1) * 256;
                if (o) { *(f32x4*)(o + ct) = v0; *(f32x4*)(o + ct + 4) = v1; }
                if (row < M0) { bf16* vt = P.VTA + (((size_t)(g * BATCH + row / SEQ) * DIL_HEADS + h) * 64 + e) * SEQ + dil_perm(pos, d);
                    vt[0 * SEQ] = (bf16)f2bf(v0.x); vt[1 * SEQ] = (bf16)f2bf(v0.y); vt[2 * SEQ] = (bf16)f2bf(v0.z); vt[3 * SEQ] = (bf16)f2bf(v0.w);
                    vt[4 * SEQ] = (bf16)f2bf(v1.x); vt[5 * SEQ] = (bf16)f2bf(v1.y); vt[6 * SEQ] = (bf16)f2bf(v1.z); vt[7 * SEQ] = (bf16)f2bf(v1.w); } } } })
    }
};
struct EpiMem {
    static constexpr bool PERM = true, AFTER_DRAIN = false; const FP& P;
    DI void operator()(const f32x4 (&acc)[2][2][4][2], const pg8::Unit& u, int wr, int wc, int fr, int fq) const {
        const int l = u.pn >> 1, half = u.pn & 1;
        EPI_LOOP({ const int n = row / MEM_TOKENS, mt = row % MEM_TOKENS; float* o = P.mem_kv_p + (((size_t)l * BATCH + n) * MEM_TOKENS + mt) * 512 + half * 256 + ct; *(f32x4*)o = v0; *(f32x4*)(o + 4) = v1;
            if (half == 0) *(u32x4*)(P.MK + (((size_t)l * BATCH + n) * MEM_TOKENS + mt) * 256 + ct) = pk8(v0, v1);
            else { bf16* vt = P.MVT + (((size_t)l * BATCH + n) * 256 + ct) * MEM_TOKENS + mt;
                vt[0 * MEM_TOKENS] = (bf16)f2bf(v0.x); vt[1 * MEM_TOKENS] = (bf16)f2bf(v0.y); vt[2 * MEM_TOKENS] = (bf16)f2bf(v0.z); vt[3 * MEM_TOKENS] = (bf16)f2bf(v0.w);
                vt[4 * MEM_TOKENS] = (bf16)f2bf(v1.x); vt[5 * MEM_TOKENS] = (bf16)f2bf(v1.y); vt[6 * MEM_TOKENS] = (bf16)f2bf(v1.z); vt[7 * MEM_TOKENS] = (bf16)f2bf(v1.w); } })
    }
};
struct EpiPre {
    static constexpr bool PERM = true, AFTER_DRAIN = false; const float* xa; const float* xb; float* pre;
    DI void operator()(const f32x4 (&acc)[2][2][4][2], const pg8::Unit& u, int wr, int wc, int fr, int fq) const {
        EPI_LOOP({ if (row < MP) { const int col = u.pn * 256 + ct; const float* x = (xb && row >= M0) ? xb + (size_t)(row - M0) * D_MODEL + col : xa + (size_t)row * D_MODEL + col;
            const f32x4 a = *(const f32x4*)x, b = *(const f32x4*)(x + 4); float* o = pre + (size_t)row * D_MODEL + col; *(f32x4*)o = a * ALPHA + v0; *(f32x4*)(o + 4) = b * ALPHA + v1; } })
    }
};
struct EpiF32 {
    static constexpr bool PERM = true, AFTER_DRAIN = false; float* out; int ldc; int nrows;
    DI void operator()(const f32x4 (&acc)[2][2][4][2], const pg8::Unit& u, int wr, int wc, int fr, int fq) const {
        EPI_LOOP({ if (row < nrows) { float* o = out + (size_t)row * ldc + u.pn * 256 + ct; *(f32x4*)o = v0; *(f32x4*)(o + 4) = v1; } })
    }
};
}
namespace fx {
struct Tile16 { f32x4 o[4]; float m, l; };
DI void tile_init(Tile16& T) { T.o[0] = T.o[1] = T.o[2] = T.o[3] = (f32x4){0.f, 0.f, 0.f, 0.f}; T.m = -INFINITY; T.l = 0.f; }
typedef __bf16 bf16x2_t __attribute__((ext_vector_type(2)));
DI unsigned cvtpk(float lo, float hi) { const f32x2 v = {lo, hi}; const bf16x2_t b = __builtin_convertvector(v, bf16x2_t); return __builtin_bit_cast(unsigned, b); }
struct KV8 { bf16x8 ka0, ka1, kb0, kb1, v0, v1, v2, v3; };
DI void kv_load(KV8& r, const bf16* k0, const bf16* k1, const bf16* v, long vs16) {
    r.ka0 = *(const bf16x8*)k0; r.ka1 = *(const bf16x8*)(k0 + 32); r.kb0 = *(const bf16x8*)k1; r.kb1 = *(const bf16x8*)(k1 + 32);
    r.v0 = *(const bf16x8*)v; r.v1 = *(const bf16x8*)(v + vs16); r.v2 = *(const bf16x8*)(v + 2 * vs16); r.v3 = *(const bf16x8*)(v + 3 * vs16); }
template <class MaskF> DI void tile_compute(Tile16& T, const bf16x8 (&qf)[2], const KV8& r, MaskF mask) {
    f32x4 s0 = (f32x4){0.f, 0.f, 0.f, 0.f}, s1 = (f32x4){0.f, 0.f, 0.f, 0.f};
    s0 = __builtin_amdgcn_mfma_f32_16x16x32_bf16(r.ka0, qf[0], s0, 0, 0, 0); s0 = __builtin_amdgcn_mfma_f32_16x16x32_bf16(r.ka1, qf[1], s0, 0, 0, 0);
    s1 = __builtin_amdgcn_mfma_f32_16x16x32_bf16(r.kb0, qf[0], s1, 0, 0, 0); s1 = __builtin_amdgcn_mfma_f32_16x16x32_bf16(r.kb1, qf[1], s1, 0, 0, 0);
    float s[8] = {s0.x, s0.y, s0.z, s0.w, s1.x, s1.y, s1.z, s1.w};
    float mx = -INFINITY;
#pragma unroll
    for (int e = 0; e < 8; ++e) { s[e] = mask(e) ? s[e] : -INFINITY; mx = fmaxf(mx, s[e]); }
    mx = fmaxf(mx, __shfl_xor(mx, 16)); mx = fmaxf(mx, __shfl_xor(mx, 32));
    const float mnew = fmaxf(T.m, mx), muse = (mnew == -INFINITY) ? 0.f : mnew;
    const float alpha = __builtin_amdgcn_exp2f(T.m - muse);
    float ls = 0.f;
#pragma unroll
    for (int e = 0; e < 8; ++e) { s[e] = __builtin_amdgcn_exp2f(s[e] - muse); ls += s[e]; }
    ls += __shfl_xor(ls, 16); ls += __shfl_xor(ls, 32);
    T.l = T.l * alpha + ls; T.m = mnew;
    u32x4 pw; pw.x = cvtpk(s[0], s[1]); pw.y = cvtpk(s[2], s[3]); pw.z = cvtpk(s[4], s[5]); pw.w = cvtpk(s[6], s[7]);
    const bf16x8 pf = __builtin_bit_cast(bf16x8, pw);
    T.o[0] = __builtin_amdgcn_mfma_f32_16x16x32_bf16(r.v0, pf, T.o[0] * alpha, 0, 0, 0); T.o[1] = __builtin_amdgcn_mfma_f32_16x16x32_bf16(r.v1, pf, T.o[1] * alpha, 0, 0, 0);
    T.o[2] = __builtin_amdgcn_mfma_f32_16x16x32_bf16(r.v2, pf, T.o[2] * alpha, 0, 0, 0); T.o[3] = __builtin_amdgcn_mfma_f32_16x16x32_bf16(r.v3, pf, T.o[3] * alpha, 0, 0, 0);
}
template <class LD, class CP> DI void pipe2(int n, LD ld, CP cp) { if (n <= 0) return; KV8 A, B; ld(A, 0);
#pragma unroll 1
    for (int i = 0; i < n; i += 2) { ld(B, (i + 1 < n) ? i + 1 : i); cp(A, i); ld(A, (i + 2 < n) ? i + 2 : i); if (i + 1 < n) cp(B, i + 1); } }
__host__ DI size_t ktile_off(int t, int d) { const int blk = t >> 5, kk = t & 31, b = (kk >> 2) & 1, i = 4 * (kk >> 3) + (kk & 3), s = d >> 5, c = (d & 31) >> 3; return ((size_t)(blk * 4 + 2 * b + s) * 64 + i + 16 * c) * 8 + (d & 7); }
__host__ DI size_t vtile_off(int dim, int t) { const int blk = t >> 5, kk = t & 31; return ((size_t)(blk * 4 + (dim >> 4)) * 64 + (dim & 15) + 16 * (kk >> 3)) * 8 + (kk & 7); }
DI void kv_load_t(KV8& r, const bf16* kt, const bf16* vt, int lane) {
    const bf16* k = kt + lane * 8; const bf16* v = vt + lane * 8;
    r.ka0 = *(const bf16x8*)k; r.ka1 = *(const bf16x8*)(k + 512); r.kb0 = *(const bf16x8*)(k + 1024); r.kb1 = *(const bf16x8*)(k + 1536);
    r.v0 = *(const bf16x8*)v; r.v1 = *(const bf16x8*)(v + 512); r.v2 = *(const bf16x8*)(v + 1024); r.v3 = *(const bf16x8*)(v + 1536); }
DI int krow_of(int i, int b) { return 8 * (i >> 2) + 4 * b + (i & 3); }

DI void dil_micro(const FP& P, int n, int h, int t0, int mt, int lane) {
    const int g = mt >> 4, idx = mt & 15, d = dil_d(g), per = 16 / d;
    const int r = idx / per, sub = idx % per, i0 = t0 / d + 16 * sub, ib = i0 - 128, NC = SEQ / d;
    const int q = lane & 15, c = lane >> 4;
    const bf16* Qb = P.QA + ((size_t)g * MPAD + (size_t)n * SEQ) * 256 + h * 64; const bf16* Kb = P.KA + ((size_t)g * MPAD + (size_t)n * SEQ) * 256 + h * 64;
    const bf16* Vb = P.VTA + ((size_t)(g * BATCH + n) * DIL_HEADS + h) * 64 * SEQ + (size_t)r * NC;
    bf16x8 qf[2]; { const bf16* qp = Qb + (size_t)(r + d * (i0 + q)) * 256 + 8 * c; qf[0] = *(const bf16x8*)qp; qf[1] = *(const bf16x8*)(qp + 32); }
    Tile16 T; tile_init(T);
    const int qi = i0 + q;
    auto ld = [&](KV8& kv, int blk) { const int kb = ib + 32 * blk; int ka = kb + krow_of(q, 0), kc = kb + krow_of(q, 1); ka = ka < 0 ? 0 : (ka >= NC ? NC - 1 : ka); kc = kc < 0 ? 0 : (kc >= NC ? NC - 1 : kc);
        kv_load(kv, Kb + (size_t)(r + d * ka) * 256 + 8 * c, Kb + (size_t)(r + d * kc) * 256 + 8 * c, Vb + (size_t)q * SEQ + kb + 8 * c, 16L * SEQ); };
    pipe2(5, ld, [&](const KV8& kv, int blk) { const int kb = ib + 32 * blk; tile_compute(T, qf, kv, [&](int e) { const int ki = kb + 8 * c + e; return ki >= 0 && ki <= qi && qi - ki <= DIL_TAPS - 1; }); });
    const int row = n * SEQ + r + d * qi;
    float* op = P.DPART + (((size_t)g * MP + row) * DIL_HEADS + h) * 64 + 4 * c;
#pragma unroll
    for (int db = 0; db < 4; ++db) *(f32x4*)(op + 16 * db) = T.o[db];
    if (c == 0) { float* ml = P.DML + (((size_t)g * MP + row) * DIL_HEADS + h) * 2; ml[0] = T.m; ml[1] = T.l; }
}
DI void mem_micro(const FP& P, const bf16* Q  , int ldq, int row0, int layer, int n, int h, bf16* O  , int ldo, int lane) {
    const int q = lane & 15, c = lane >> 4;
    bf16x8 qf[2]; { const bf16* qp = Q + (size_t)(row0 + q) * ldq + 8 * c; qf[0] = *(const bf16x8*)qp; qf[1] = *(const bf16x8*)(qp + 32); }
    const bf16* Kb = P.MK + ((size_t)layer * BATCH + n) * MEM_TOKENS * 256 + h * 64; const bf16* Vb = P.MVT + (((size_t)layer * BATCH + n) * 256 + h * 64) * MEM_TOKENS;
    Tile16 T; tile_init(T);
    auto ld = [&](KV8& kv, int blk) { const int kb = 32 * blk; kv_load(kv, Kb + (size_t)(kb + krow_of(q, 0)) * 256 + 8 * c, Kb + (size_t)(kb + krow_of(q, 1)) * 256 + 8 * c, Vb + (size_t)q * MEM_TOKENS + kb + 8 * c, 16L * MEM_TOKENS); };
    pipe2(MEM_TOKENS / 32, ld, [&](const KV8& kv, int) { tile_compute(T, qf, kv, [&](int) { return true; }); });
    const float inv = 1.0f / T.l; bf16* op = O + (size_t)(row0 + q) * ldo + 4 * c;
#pragma unroll
    for (int db = 0; db < 4; ++db) *(u32x2*)(op + 16 * db) = pk4(T.o[db] * inv);
}
struct Dec { float m, l, o; };
template <class KF, class VF> DI void dec_chunk(Dec& D, const LAS float* q, int nk, KF kf, VF vf, int lane) {
    float s = -INFINITY;
    if (lane < nk) { const float* k = kf(lane); float a = 0.f;
#pragma unroll
        for (int d4 = 0; d4 < 16; ++d4) { const f32x4 kv = *(const f32x4*)(k + 4 * d4); a += kv.x * q[4 * d4] + kv.y * q[4 * d4 + 1] + kv.z * q[4 * d4 + 2] + kv.w * q[4 * d4 + 3]; }
        s = a; }
    const float mx = wave_max(s), mnew = fmaxf(D.m, mx), alpha = __builtin_amdgcn_exp2f(D.m - mnew);
    const float p = (lane < nk) ? __builtin_amdgcn_exp2f(s - mnew) : 0.f;
    D.l = D.l * alpha + wave_sum(p); D.m = mnew; float o = D.o * alpha;
    for (int j0 = 0; j0 < nk; j0 += 8) { float vv[8];
#pragma unroll
        for (int u = 0; u < 8; ++u) { const int jj = (j0 + u < nk) ? j0 + u : nk - 1; vv[u] = vf(jj)[lane]; }
#pragma unroll
        for (int u = 0; u < 8; ++u) { const float pj = (j0 + u < nk) ? __builtin_bit_cast(float, __builtin_amdgcn_readlane(__builtin_bit_cast(int, p), (j0 + u) & 63)) : 0.f; o += pj * vv[u]; } }
    D.o = o;
}
DI void atta_phase(const FP& P, const Ctx& C) {
    const int lane = C.lane, w = C.wave;
    constexpr int NT = SEQ / 256, NIT = BATCH * NT * DIL_HEADS;
    for (int it = C.vcu; it < NIT; it += C.G) { const int h = it % DIL_HEADS, tt = (it / DIL_HEADS) % NT, n = it / (DIL_HEADS * NT), t0 = tt * 256;
        for (int mt = w; mt < 48; mt += NWAVES) dil_micro(P, n, h, t0, mt, lane);
        asm volatile("s_waitcnt vmcnt(0)" ::: "memory"); __syncthreads();
        for (int i = C.tid; i < 256 * 16; i += NTHREADS) { const int tk = i >> 4, d4 = (i & 15) * 4; const int row = n * SEQ + t0 + tk;
            float mg[3], lg[3]; float M = -INFINITY;
#pragma unroll
            for (int g = 0; g < 3; ++g) { const float* ml = P.DML + (((size_t)g * MP + row) * DIL_HEADS + h) * 2; mg[g] = ml[0]; lg[g] = ml[1]; M = fmaxf(M, mg[g]); }
            f32x4 acc = (f32x4){0.f, 0.f, 0.f, 0.f}; float L = 0.f;
#pragma unroll
            for (int g = 0; g < 3; ++g) { const float wg = __builtin_amdgcn_exp2f(mg[g] - M); L += wg * lg[g]; acc += *(const f32x4*)(P.DPART + (((size_t)g * MP + row) * DIL_HEADS + h) * 64 + d4) * wg; }
            *(u32x2*)(P.ATTA + (size_t)row * 512 + h * 64 + d4) = pk4(acc * (1.0f / L)); }
        for (int mt = w; mt < 16; mt += NWAVES) mem_micro(P, P.MQA + h * 64, 256, n * SEQ + t0 + 16 * mt, 0, n, h, P.ATTA + 256 + h * 64, 512, lane);
        __syncthreads();
    }
    LAS float* qs = (LAS float*)(C.lds + w * 1024);
    const int gw = C.vcu * NWAVES + w, NGW = C.G * NWAVES;
    for (int it = gw; it < DEC_BATCH * DIL_HEADS * 2; it += NGW) { const int kind = it & 1, h = (it >> 1) % DIL_HEADS, ns = (it >> 1) / DIL_HEADS, row = M0 + ns;
        Dec D; D.m = -INFINITY; D.l = 0.f; D.o = 0.f;
        if (kind == 0) {
            for (int g = 0; g < 3; ++g) qs[g * 64 + lane] = bf2f(P.QA[((size_t)g * MPAD + row) * 256 + h * 64 + lane]);
            asm volatile("s_waitcnt lgkmcnt(0)" ::: "memory");
            for (int g = 0; g < 3; ++g) { const int W = dil_w(g), d = dil_d(g); const float* cache = sel3c(P.cache_dil, g) + (size_t)ns * W * 512; const float* newrow = sel3(P.dil_s, g) + ((size_t)ns * W + W - 1) * 512;
                for (int j0 = 0; j0 < DIL_TAPS; j0 += 64) { const int nk = (DIL_TAPS - j0) < 64 ? (DIL_TAPS - j0) : 64;
                    dec_chunk(D, qs + g * 64, nk, [&](int j) { const int tap = j0 + j; return (tap == 0 ? newrow : cache + (size_t)(W - d * tap) * 512) + h * 64; },
                              [&](int j) { const int tap = j0 + j; return (tap == 0 ? newrow : cache + (size_t)(W - d * tap) * 512) + 256 + h * 64; }, lane); } }
            P.ATTA[(size_t)row * 512 + h * 64 + lane] = (bf16)f2bf(D.o / D.l);
        } else {
            qs[lane] = bf2f(P.MQA[(size_t)row * 256 + h * 64 + lane]);
            asm volatile("s_waitcnt lgkmcnt(0)" ::: "memory");
            const float* mk = P.cache_mem_kv + ((size_t)0 * DEC_BATCH + ns) * MEM_TOKENS * 512;
            for (int j0 = 0; j0 < MEM_TOKENS; j0 += 64) dec_chunk(D, qs, 64, [&](int j) { return mk + (size_t)(j0 + j) * 512 + h * 64; }, [&](int j) { return mk + (size_t)(j0 + j) * 512 + 256 + h * 64; }, lane);
            P.ATTA[(size_t)row * 512 + 256 + h * 64 + lane] = (bf16)f2bf(D.o / D.l);
        }
    }
    __syncthreads();
}
DI void ln_phase(const FP& P, const Ctx& C, const float* pre, const float* gam, const float* bet, float* xo, bf16* xb, float* yp, float* ys) {
    const int gw = C.vcu * NWAVES + C.wave, NGW = C.G * NWAVES, lane = C.lane;
    for (int r = gw; r < MP; r += NGW) { const float* x = pre + (size_t)r * D_MODEL; f32x4 v[4]; float s = 0.f;
#pragma unroll
        for (int j = 0; j < 4; ++j) { v[j] = *(const f32x4*)(x + 256 * j + 4 * lane); s += (v[j].x + v[j].y) + (v[j].z + v[j].w); }
        const float mu = wave_sum(s) * (1.0f / D_MODEL); float s2 = 0.f;
#pragma unroll
        for (int j = 0; j < 4; ++j) { v[j] = v[j] - mu; s2 += (v[j].x * v[j].x + v[j].y * v[j].y) + (v[j].z * v[j].z + v[j].w * v[j].w); }
        const float rs = 1.0f / sqrtf(wave_sum(s2) * (1.0f / D_MODEL) + LN_EPS);
#pragma unroll
        for (int j = 0; j < 4; ++j) { const f32x4 gg = *(const f32x4*)(gam + 256 * j + 4 * lane), bb = *(const f32x4*)(bet + 256 * j + 4 * lane); const f32x4 o = v[j] * rs * gg + bb;
            if (xo) *(f32x4*)(xo + (size_t)r * D_MODEL + 256 * j + 4 * lane) = o;
            if (xb) *(u32x2*)(xb + (size_t)r * D_MODEL + 256 * j + 4 * lane) = pk4(o);
            if (yp) { if (r < M0) *(f32x4*)(yp + (size_t)r * D_MODEL + 256 * j + 4 * lane) = o; else *(f32x4*)(ys + (size_t)(r - M0) * D_MODEL + 256 * j + 4 * lane) = o; } }
    }
}
}
namespace fx {
#define INS16(V, I, v_, i_) do { const float _v = (v_); const int _i = (i_); bool _c[16]; _Pragma("unroll") for (int _k = 0; _k < 16; ++_k) _c[_k] = _v > V[_k]; \
    _Pragma("unroll") for (int _k = 15; _k >= 1; --_k) { V[_k] = _c[_k] ? (_c[_k - 1] ? V[_k - 1] : _v) : V[_k]; I[_k] = _c[_k] ? (_c[_k - 1] ? I[_k - 1] : _i) : I[_k]; } \
    V[0] = _c[0] ? _v : V[0]; I[0] = _c[0] ? _i : I[0]; } while (0)
DI void wave_top16_128(float a, float b, int lane, float& outv, int& outi) {
    outv = -INFINITY; outi = 0;
#pragma unroll 1
    for (int k = 0; k < 16; ++k) { const float m = wave_max(fmaxf(a, b)); const unsigned long long ba = __ballot(a == m), bb = __ballot(b == m); int idx;
        if (ba) { const int l = __builtin_ctzll(ba); idx = l; if (lane == l) a = -INFINITY; } else { const int l = __builtin_ctzll(bb); idx = 64 + l; if (lane == l) b = -INFINITY; }
        if (lane == k) { outv = m; outi = idx; } }
}
DI void topk_wave_item(const FP& P, long it, int lane) {
    const float* s = P.SCO + it * 256; float v1, v2; int i1, i2;
    wave_top16_128(s[lane], s[64 + lane], lane, v1, i1); wave_top16_128(s[128 + lane], s[192 + lane], lane, v2, i2);
    int a = 0, rem = lane; bool valid = false;
    for (int aa = 0; aa < 16; ++aa) { const int nb = 16 / (aa + 1); if (!valid) { if (rem < nb) { a = aa; valid = true; } else rem -= nb; } }
    const int b = valid ? rem : 0;
    float cs = __shfl(v1, a) + __shfl(v2, b); const int ce = __shfl(i1, a) * PEER_KEYS + __shfl(i2, b); if (!valid) cs = -INFINITY;
    float tv = -INFINITY; int te = 0;
#pragma unroll 1
    for (int k = 0; k < 16; ++k) { const float m = wave_max(cs); const unsigned long long bm = __ballot(cs == m); const int l = __builtin_ctzll(bm); const int e = __shfl(ce, l); if (lane == l) cs = -INFINITY; if (lane == k) { tv = m; te = e; } }
    const float mx = __shfl(tv, 0); const float ex = (lane < 16) ? __expf(tv - mx) : 0.f; const float z = wave_sum(ex);
    if (lane < 16) { P.SELG[it * 16 + lane] = ex / z; P.SELE[it * 16 + lane] = te; }
}
DI void topk_phase(const FP& P, const Ctx& C) {
    const int lane = C.lane; LAS float* st = (LAS float*)(C.lds + C.wave * 16384);
    const int NWI = (M0 * PEER_HEADS) / 64;
    for (int wi = C.vcu * NWAVES + C.wave; wi < NWI; wi += C.G * NWAVES) {
        const long it0 = (long)wi * 64; const long it = it0 + lane; const bool act = true;
        float V1[16], V2[16], V3[16]; int I1[16], I2[16], I3[16];
#pragma unroll
        for (int k = 0; k < 16; ++k) { V1[k] = V2[k] = V3[k] = -INFINITY; I1[k] = I2[k] = I3[k] = 0; }
        for (int half = 0; half < 2; ++half) {
            for (int ch = 0; ch < 4; ++ch) {
#pragma unroll
                for (int u = 0; u < 8; ++u) { const int f4 = u * 64 + lane, j = f4 >> 3, c4 = (f4 & 7) * 4; const long itj = it0 + j;
                    const f32x4 v = *(const f32x4*)(P.SCO + itj * 256 + half * 128 + ch * 32 + c4);
                    st[j * 33 + c4] = v.x; st[j * 33 + c4 + 1] = v.y; st[j * 33 + c4 + 2] = v.z; st[j * 33 + c4 + 3] = v.w; }
                asm volatile("s_waitcnt lgkmcnt(0)" ::: "memory");
                for (int c = 0; c < 32; ++c) { const float v = st[lane * 33 + c]; const int id = ch * 32 + c;
                    if (half == 0) { if (__any(v > V1[15])) INS16(V1, I1, v, id); } else { if (__any(v > V2[15])) INS16(V2, I2, v, id); } }
                asm volatile("s_waitcnt lgkmcnt(0)" ::: "memory");
            }
        }
        { LAS float* lv = st; LAS int* li = (LAS int*)(st + 64 * 33);
#pragma unroll
          for (int k = 0; k < 16; ++k) { lv[lane * 33 + k] = V1[k]; lv[lane * 33 + 16 + k] = V2[k]; li[lane * 17 + k] = I1[k] | (I2[k] << 8); }
          asm volatile("s_waitcnt lgkmcnt(0)" ::: "memory");
          for (int a = 0; a < 16; ++a) { const float va = lv[lane * 33 + a]; const int ia = li[lane * 17 + a] & 255; const int nb = 16 / (a + 1);
              for (int b = 0; b < nb; ++b) { const float v = va + lv[lane * 33 + 16 + b]; const int ib = li[lane * 17 + b] >> 8; INS16(V3, I3, v, ia * PEER_KEYS + ib); } }
          asm volatile("s_waitcnt lgkmcnt(0)" ::: "memory"); }
        float z = 0.f; const float vmax = V3[0];
#pragma unroll
        for (int k = 0; k < 16; ++k) { V3[k] = __expf(V3[k] - vmax); z += V3[k]; }
        if (act) { const float iz = 1.0f / z;
#pragma unroll
            for (int k4 = 0; k4 < 4; ++k4) { *(f32x4*)(P.SELG + it * 16 + 4 * k4) = (f32x4){V3[4 * k4] * iz, V3[4 * k4 + 1] * iz, V3[4 * k4 + 2] * iz, V3[4 * k4 + 3] * iz};
                *(int4*)(P.SELE + it * 16 + 4 * k4) = make_int4(I3[4 * k4], I3[4 * k4 + 1], I3[4 * k4 + 2], I3[4 * k4 + 3]); } }
    }
    for (int si = C.vcu * NWAVES + C.wave; si < DEC_BATCH * PEER_HEADS; si += C.G * NWAVES) topk_wave_item(P, (long)M0 * PEER_HEADS + si, lane);
    __syncthreads();
}
constexpr float PEER_SU = 256.f, PEER_SV = 64.f;
DI float dot16_fp8(const u32x4& w, const f32x2 (&x2)[8]) { f32x2 a = {0.f, 0.f};
    a += __builtin_amdgcn_cvt_pk_f32_fp8((int)w.x, false) * x2[0]; a += __builtin_amdgcn_cvt_pk_f32_fp8((int)w.x, true) * x2[1];
    a += __builtin_amdgcn_cvt_pk_f32_fp8((int)w.y, false) * x2[2]; a += __builtin_amdgcn_cvt_pk_f32_fp8((int)w.y, true) * x2[3];
    a += __builtin_amdgcn_cvt_pk_f32_fp8((int)w.z, false) * x2[4]; a += __builtin_amdgcn_cvt_pk_f32_fp8((int)w.z, true) * x2[5];
    a += __builtin_amdgcn_cvt_pk_f32_fp8((int)w.w, false) * x2[6]; a += __builtin_amdgcn_cvt_pk_f32_fp8((int)w.w, true) * x2[7];
    return a.x + a.y; }
DI void axpy16_fp8(const u32x4& w, float s, f32x2 (&o2)[8]) { const f32x2 s2 = {s, s};
    o2[0] += __builtin_amdgcn_cvt_pk_f32_fp8((int)w.x, false) * s2; o2[1] += __builtin_amdgcn_cvt_pk_f32_fp8((int)w.x, true) * s2;
    o2[2] += __builtin_amdgcn_cvt_pk_f32_fp8((int)w.y, false) * s2; o2[3] += __builtin_amdgcn_cvt_pk_f32_fp8((int)w.y, true) * s2;
    o2[4] += __builtin_amdgcn_cvt_pk_f32_fp8((int)w.z, false) * s2; o2[5] += __builtin_amdgcn_cvt_pk_f32_fp8((int)w.z, true) * s2;
    o2[6] += __builtin_amdgcn_cvt_pk_f32_fp8((int)w.w, false) * s2; o2[7] += __builtin_amdgcn_cvt_pk_f32_fp8((int)w.w, true) * s2; }
DI float rdlane(float v, int l) { return __builtin_bit_cast(float, __builtin_amdgcn_readlane(__builtin_bit_cast(int, v), l)); }
DI void peer_phase(const FP& P, const Ctx& C, int layer, const float* xin, float* fout, float* fout_s, bf16* xb) {
    const int lane = C.lane; const unsigned char* U = P.UB8 + (size_t)layer * PEER_EXPERTS * D_MODEL; const unsigned char* Vt = P.VB8 + (size_t)layer * PEER_EXPERTS * D_MODEL;
    const float* gam = P.ln_g + ((size_t)layer * 2 + 1) * D_MODEL; const float* bet = P.ln_b + ((size_t)layer * 2 + 1) * D_MODEL;
    const int nrounds = (M0 + C.G * NWAVES - 1) / (C.G * NWAVES);
#pragma unroll 1
    for (int rd = 0; rd <= nrounds; ++rd) {
        const bool smp = (rd == nrounds); int r = smp ? M0 + C.vcu : rd * C.G * NWAVES + C.vcu * NWAVES + C.wave; if (smp ? (C.vcu >= DEC_BATCH) : (r >= M0)) continue;
        const int pb = smp ? 16 * C.wave : 0, pe = smp ? pb + 16 : 128;
        f32x2 x2[8], o2[8];
#pragma unroll
        for (int j = 0; j < 4; ++j) { const f32x4 a = *(const f32x4*)(xin + (size_t)r * D_MODEL + 16 * lane + 4 * j); x2[2 * j] = (f32x2){a.x, a.y}; x2[2 * j + 1] = (f32x2){a.z, a.w}; }
#pragma unroll
        for (int k = 0; k < 8; ++k) o2[k] = (f32x2){0.f, 0.f};
        const int e_l = P.SELE[(size_t)r * 128 + lane], e_h = P.SELE[(size_t)r * 128 + 64 + lane]; const float g_l = P.SELG[(size_t)r * 128 + lane], g_h = P.SELG[(size_t)r * 128 + 64 + lane];
#pragma unroll 1
        for (int b0 = pb; b0 < pe; b0 += 8) {
            u32x4 uw[8], vw[8];
#pragma unroll
            for (int k = 0; k < 8; ++k) { const int hk = b0 + k; const int e = (hk < 64) ? __builtin_amdgcn_readlane(e_l, hk & 63) : __builtin_amdgcn_readlane(e_h, hk & 63);
                uw[k] = *(const u32x4*)(U + (size_t)e * D_MODEL + 16 * lane); vw[k] = *(const u32x4*)(Vt + (size_t)e * D_MODEL + 16 * lane); }
            float d[8];
#pragma unroll
            for (int k = 0; k < 8; ++k) d[k] = dot16_fp8(uw[k], x2);
            float e4[4], e2[2], e1;
            { const bool hi = lane & 1;
#pragma unroll
              for (int i = 0; i < 4; ++i) { const float keep = hi ? d[4 + i] : d[i], send = hi ? d[i] : d[4 + i]; e4[i] = keep + __shfl_xor(send, 1); } }
            { const bool hi = lane & 2;
#pragma unroll
              for (int i = 0; i < 2; ++i) { const float keep = hi ? e4[2 + i] : e4[i], send = hi ? e4[i] : e4[2 + i]; e2[i] = keep + __shfl_xor(send, 2); } }
            { const bool hi = lane & 4; const float keep = hi ? e2[1] : e2[0], send = hi ? e2[0] : e2[1]; e1 = keep + __shfl_xor(send, 4); }
            e1 += __shfl_xor(e1, 8); e1 += __shfl_xor(e1, 16); e1 += __shfl_xor(e1, 32);
            const int myk = 4 * (lane & 1) + (lane & 2) + ((lane >> 2) & 1); const int myhk = b0 + myk;
            const float myg = (myhk < 64) ? __shfl(g_l, myhk & 63) : __shfl(g_h, myhk & 63);
            const float act = myg * gelu_tanh(e1 * (1.0f / PEER_SU)) * (1.0f / PEER_SV);
#pragma unroll
            for (int k = 0; k < 8; ++k) { const int src = (k >> 2) | (((k >> 1) & 1) << 1) | ((k & 1) << 2); axpy16_fp8(vw[k], rdlane(act, src), o2); }
        }
        if (smp) {
            LAS float* red = (LAS float*)C.lds;
#pragma unroll
            for (int k = 0; k < 8; ++k) { red[C.wave * 1024 + 16 * lane + 2 * k] = o2[k].x; red[C.wave * 1024 + 16 * lane + 2 * k + 1] = o2[k].y; }
            asm volatile("s_waitcnt lgkmcnt(0)" ::: "memory"); __syncthreads();
            if (C.wave == 0) {
#pragma unroll
                for (int k = 0; k < 8; ++k) { float ax = 0.f, ay = 0.f;
#pragma unroll
                    for (int ww = 0; ww < NWAVES; ++ww) { ax += red[ww * 1024 + 16 * lane + 2 * k]; ay += red[ww * 1024 + 16 * lane + 2 * k + 1]; } o2[k] = (f32x2){ax, ay}; } }
            __syncthreads();
            if (C.wave != 0) continue; }
        float s = 0.f;
#pragma unroll
        for (int k = 0; k < 8; ++k) { o2[k] += x2[k] * ALPHA; s += o2[k].x + o2[k].y; }
        const float mu = wave_sum(s) * (1.0f / D_MODEL); float s2 = 0.f;
#pragma unroll
        for (int k = 0; k < 8; ++k) { o2[k] -= mu; s2 += o2[k].x * o2[k].x + o2[k].y * o2[k].y; }
        const float rs = 1.0f / sqrtf(wave_sum(s2) * (1.0f / D_MODEL) + LN_EPS);
        float* frow = (r < M0) ? fout + (size_t)r * D_MODEL : fout_s + (size_t)(r - M0) * D_MODEL;
#pragma unroll
        for (int j = 0; j < 4; ++j) { const int c0 = 16 * lane + 4 * j; const f32x4 gg = *(const f32x4*)(gam + c0), bb = *(const f32x4*)(bet + c0);
            const f32x4 y = (f32x4){o2[2 * j].x * rs, o2[2 * j].y * rs, o2[2 * j + 1].x * rs, o2[2 * j + 1].y * rs} * gg + bb;
            *(f32x4*)(frow + c0) = y; if (xb) *(u32x2*)(xb + (size_t)r * D_MODEL + c0) = pk4(y); }
    }
}
}
namespace fx {
struct EpiB {
    static constexpr bool PERM = true, AFTER_DRAIN = false; const FP& P;
    DI void operator()(const f32x4 (&acc)[2][2][4][2], const pg8::Unit& u, int wr, int wc, int fr, int fq) const {
        const int t = u.pn;
        EPI_LOOP({ if (row < MP) { const int pos = row_pos(row), n = row / SEQ, e = ct & 63, dp = e >> 1; const bool prm = row < M0;
            if (t < 3) { const int ty = 2 * t + (ct >> 7), kvh = (ct >> 6) & 1;
                if (ty == 2 || ty == 4) { f32x4 lo, hi; rope4(P.ROPE + pos * 64, dp, v0, v1, lo, hi);
                    if (ty == 2) { float* o = (prm ? P.nsa_kv_p + (size_t)row * 512 : P.nsa_kv_s + (size_t)(row - M0) * 512) + 256 + kvh * 64 + dp; *(f32x4*)o = lo; *(f32x4*)(o + 32) = hi;
                        if (prm) { bf16* kt = P.SLK + ((size_t)n * NSA_KV_HEADS + kvh) * SEQ * 64; *(u32x2*)(kt + ktile_off(pos, dp)) = pk4(lo); *(u32x2*)(kt + ktile_off(pos, dp + 32)) = pk4(hi); } }
                    else { float* o = nullptr; if (!prm) o = P.win_s + (((size_t)(row - M0) * SWA_WINDOW + SWA_WINDOW - 1) * 2 + 0) * 128; else if (pos >= SEQ - SWA_WINDOW) o = P.win_p + (((size_t)n * SWA_WINDOW + pos - (SEQ - SWA_WINDOW)) * 2 + 0) * 128;
                        if (o) { *(f32x4*)(o + kvh * 64 + dp) = lo; *(f32x4*)(o + kvh * 64 + 32 + dp) = hi; }
                        if (prm) { bf16* kt = P.WNK + ((size_t)n * NSA_KV_HEADS + kvh) * SEQ * 64; *(u32x2*)(kt + ktile_off(pos, dp)) = pk4(lo); *(u32x2*)(kt + ktile_off(pos, dp + 32)) = pk4(hi); } } }
                else if (ty < 4) { float* o = (prm ? P.nsa_kv_p + (size_t)row * 512 : P.nsa_kv_s + (size_t)(row - M0) * 512) + ty * 128 + kvh * 64 + e; *(f32x4*)o = v0; *(f32x4*)(o + 4) = v1;
                    if (prm) { if (ty < 2) *(u32x4*)(P.AC + ((size_t)ty * ACROWS + ((size_t)n * NSA_KV_HEADS + kvh) * NCH + pos / 16) * 1024 + (pos % 16) * 64 + e) = pk8(v0, v1);
                        else { bf16* vt = P.SLVT + ((size_t)n * NSA_KV_HEADS + kvh) * SEQ * 64 + vtile_off(e, pos);
                            vt[0] = (bf16)f2bf(v0.x); vt[8] = (bf16)f2bf(v0.y); vt[16] = (bf16)f2bf(v0.z); vt[24] = (bf16)f2bf(v0.w); vt[32] = (bf16)f2bf(v1.x); vt[40] = (bf16)f2bf(v1.y); vt[48] = (bf16)f2bf(v1.z); vt[56] = (bf16)f2bf(v1.w); } } }
                else { float* o = nullptr; if (!prm) o = P.win_s + (((size_t)(row - M0) * SWA_WINDOW + SWA_WINDOW - 1) * 2 + 1) * 128; else if (pos >= SEQ - SWA_WINDOW) o = P.win_p + (((size_t)n * SWA_WINDOW + pos - (SEQ - SWA_WINDOW)) * 2 + 1) * 128;
                    if (o) { *(f32x4*)(o + kvh * 64 + e) = v0; *(f32x4*)(o + kvh * 64 + e + 4) = v1; }
                    if (prm) { bf16* vt = P.WNVT + ((size_t)n * NSA_KV_HEADS + kvh) * SEQ * 64 + vtile_off(e, pos);
                        vt[0] = (bf16)f2bf(v0.x); vt[8] = (bf16)f2bf(v0.y); vt[16] = (bf16)f2bf(v0.z); vt[24] = (bf16)f2bf(v0.w); vt[32] = (bf16)f2bf(v1.x); vt[40] = (bf16)f2bf(v1.y); vt[48] = (bf16)f2bf(v1.z); vt[56] = (bf16)f2bf(v1.w); } } }
            else if (t < 6) { const int h = (t - 3) * 4 + (ct >> 6); f32x4 lo, hi; rope4(P.ROPE + pos * 64, dp, v0, v1, lo, hi); bf16* q = P.QB + (size_t)row * NSA_Q_COLS + h * 64 + dp; *(u32x2*)q = pk4(lo * QSCALE); *(u32x2*)(q + 32) = pk4(hi * QSCALE); }
            else if (t == 6) { *(u32x4*)(P.MQB + (size_t)row * 256 + ct) = pk8(v0 * QSCALE, v1 * QSCALE); }
            else if (ct < 40) { const float vv[8] = {v0.x, v0.y, v0.z, v0.w, v1.x, v1.y, v1.z, v1.w};
                _Pragma("unroll") for (int i = 0; i < 8; ++i) if (ct + i < NSA_GATE_COLS) P.GATES[(size_t)row * 64 + ct + i] = 1.0f / (1.0f + __expf(-vv[i])); } } })
    }
};
DI void cmp2_phase(const FP& P, const Ctx& C) {
    const int lane = C.lane; LAS float* hs = (LAS float*)(C.lds + C.wave * 1024);
    const int NIT = NCTX * 2 * NSA_KV_HEADS * NCMP;
    for (int it = C.vcu * NWAVES + C.wave; it < NIT; it += C.G * NWAVES) { const int c = it % NCMP; int r = it / NCMP; const int kvh = r % NSA_KV_HEADS; r /= NSA_KV_HEADS; const int ty = r % 2, ctx = r / 2;
        const float* UL = P.UL + ((size_t)ty * ACROWS + ((size_t)ctx * NSA_KV_HEADS + kvh) * NCH) * 256;
#pragma unroll
        for (int hf = 0; hf < 2; ++hf) { const int hid = lane + 64 * hf; hs[hid] = gelu_tanh(UL[(size_t)c * 256 + hid] + UL[(size_t)(c + 1) * 256 + 128 + hid] + P.CBIAS[ty * CMP_HIDDEN + hid]); }
        asm volatile("s_waitcnt lgkmcnt(0)" ::: "memory");
        const float* w2 = P.cmp_w2 + (size_t)ty * CMP_HIDDEN * HEAD_DIM; float a = 0.f;
#pragma unroll 8
        for (int k = 0; k < CMP_HIDDEN; ++k) a += hs[k] * w2[k * HEAD_DIM + lane];
        if (ty == 0) { const float other = __shfl_xor(a, 32); const int pos = c * CMP_STRIDE + CMP_BLOCK - 1; const float cs = P.ROPE[pos * 64 + (lane & 31)], sn = P.ROPE[pos * 64 + 32 + (lane & 31)];
            a = (lane < 32) ? a * cs - other * sn : a * cs + other * sn; }
        if (ctx < BATCH) { if (ty == 0) P.CK[((size_t)ctx * NSA_KV_HEADS + kvh) * NCH * 64 + ktile_off(c, lane)] = (bf16)f2bf(a); else P.CVT[((size_t)ctx * NSA_KV_HEADS + kvh) * NCH * 64 + vtile_off(lane, c)] = (bf16)f2bf(a); }
        else { (ty == 0 ? P.CKF : P.CVF)[(((size_t)(ctx - BATCH) * NSA_KV_HEADS + kvh) * NCH + c) * 64 + lane] = a; }
        asm volatile("s_waitcnt lgkmcnt(0)" ::: "memory");
    }
    __syncthreads();
}
constexpr int NSA_WLDS = 8192;
DI void nsa_pair_a(const FP& P, int n, int kvh, int t, int lane, LAS unsigned char* wl) {
    LAS float* pn = (LAS float*)wl; LAS float* imp = (LAS float*)(wl + 2048); LAS float* sc = (LAS float*)(wl + 6144); LAS int* sel = (LAS int*)(wl + 7168);
    const int col = lane & 15, c = lane >> 4; const bool vcol = col < 12; const int qq = vcol ? col / 6 : 0, hh = vcol ? col % 6 : 0, tq = t + qq, head = kvh * NSA_GROUP + hh, row = n * SEQ + tq;
    bf16x8 qf[2]; { const bf16* qp = P.QB + (size_t)row * NSA_Q_COLS + head * 64 + 8 * c; qf[0] = *(const bf16x8*)qp; qf[1] = *(const bf16x8*)(qp + 32); }
    const float* gt = P.GATES + (size_t)row * 64 + head * 3;
    f32x4 oacc[4] = {(f32x4){0.f, 0.f, 0.f, 0.f}, (f32x4){0.f, 0.f, 0.f, 0.f}, (f32x4){0.f, 0.f, 0.f, 0.f}, (f32x4){0.f, 0.f, 0.f, 0.f}};
    const int lim = vcol ? ((tq >= CMP_BLOCK - 1) ? (tq - (CMP_BLOCK - 1)) / CMP_STRIDE : -1) : -1;
    const int limmax = (t + 1 >= CMP_BLOCK - 1) ? (t + 1 - (CMP_BLOCK - 1)) / CMP_STRIDE : -1; const int nblk = (limmax + 32) / 32;
    const bf16* CKb = P.CK + ((size_t)n * NSA_KV_HEADS + kvh) * NCH * 64; const bf16* CVb = P.CVT + ((size_t)n * NSA_KV_HEADS + kvh) * 64 * NCH;
    for (int i = lane; i < 1024; i += 64) imp[i] = 0.f;
    float m1 = -INFINITY, l1 = 0.f;
    for (int blk = 0; blk < nblk; ++blk) { const int kb = 32 * blk; const bf16* kt = CKb + (size_t)blk * 2048 + lane * 8;
        const bf16x8 ka0 = *(const bf16x8*)kt, ka1 = *(const bf16x8*)(kt + 512), kb0 = *(const bf16x8*)(kt + 1024), kb1 = *(const bf16x8*)(kt + 1536);
        f32x4 s0 = (f32x4){0.f, 0.f, 0.f, 0.f}, s1 = (f32x4){0.f, 0.f, 0.f, 0.f};
        s0 = __builtin_amdgcn_mfma_f32_16x16x32_bf16(ka0, qf[0], s0, 0, 0, 0); s0 = __builtin_amdgcn_mfma_f32_16x16x32_bf16(ka1, qf[1], s0, 0, 0, 0);
        s1 = __builtin_amdgcn_mfma_f32_16x16x32_bf16(kb0, qf[0], s1, 0, 0, 0); s1 = __builtin_amdgcn_mfma_f32_16x16x32_bf16(kb1, qf[1], s1, 0, 0, 0);
        float s[8] = {s0.x, s0.y, s0.z, s0.w, s1.x, s1.y, s1.z, s1.w}; float mx = -INFINITY;
#pragma unroll
        for (int e = 0; e < 8; ++e) { s[e] = (kb + 8 * c + e <= lim) ? s[e] : -INFINITY; mx = fmaxf(mx, s[e]); }
        mx = fmaxf(mx, __shfl_xor(mx, 16)); mx = fmaxf(mx, __shfl_xor(mx, 32));
        const float mnew = fmaxf(m1, mx), muse = (mnew == -INFINITY) ? 0.f : mnew; float ls = 0.f;
#pragma unroll
        for (int e = 0; e < 8; ++e) ls += __builtin_amdgcn_exp2f(s[e] - muse);
        ls += __shfl_xor(ls, 16); ls += __shfl_xor(ls, 32);
        l1 = l1 * __builtin_amdgcn_exp2f(m1 - muse) + ls; m1 = mnew; }
    asm volatile("s_waitcnt lgkmcnt(0)" ::: "memory");
    { const float muse = (m1 == -INFINITY) ? 0.f : m1, inv = (l1 > 0.f) ? 1.0f / l1 : 0.f;
      f32x4 oc[4] = {(f32x4){0.f, 0.f, 0.f, 0.f}, (f32x4){0.f, 0.f, 0.f, 0.f}, (f32x4){0.f, 0.f, 0.f, 0.f}, (f32x4){0.f, 0.f, 0.f, 0.f}};
      for (int blk = 0; blk < nblk; ++blk) { const int kb = 32 * blk; const bf16* kt = CKb + (size_t)blk * 2048 + lane * 8; const bf16* v = CVb + (size_t)blk * 2048 + lane * 8;
        const bf16x8 ka0 = *(const bf16x8*)kt, ka1 = *(const bf16x8*)(kt + 512), kb0 = *(const bf16x8*)(kt + 1024), kb1 = *(const bf16x8*)(kt + 1536);
        const bf16x8 v0 = *(const bf16x8*)v, v1 = *(const bf16x8*)(v + 512), v2 = *(const bf16x8*)(v + 1024), v3 = *(const bf16x8*)(v + 1536);
        f32x4 s0 = (f32x4){0.f, 0.f, 0.f, 0.f}, s1 = (f32x4){0.f, 0.f, 0.f, 0.f};
        s0 = __builtin_amdgcn_mfma_f32_16x16x32_bf16(ka0, qf[0], s0, 0, 0, 0); s0 = __builtin_amdgcn_mfma_f32_16x16x32_bf16(ka1, qf[1], s0, 0, 0, 0);
        s1 = __builtin_amdgcn_mfma_f32_16x16x32_bf16(kb0, qf[0], s1, 0, 0, 0); s1 = __builtin_amdgcn_mfma_f32_16x16x32_bf16(kb1, qf[1], s1, 0, 0, 0);
        float s[8] = {s0.x, s0.y, s0.z, s0.w, s1.x, s1.y, s1.z, s1.w};
#pragma unroll
        for (int e = 0; e < 8; ++e) s[e] = (kb + 8 * c + e <= lim) ? __builtin_amdgcn_exp2f(s[e] - muse) * inv : 0.f;
        *(f32x4*)(pn + col * 32 + 8 * c) = (f32x4){s[0], s[1], s[2], s[3]}; *(f32x4*)(pn + col * 32 + 8 * c + 4) = (f32x4){s[4], s[5], s[6], s[7]};
        u32x4 pw; pw.x = cvtpk(s[0], s[1]); pw.y = cvtpk(s[2], s[3]); pw.z = cvtpk(s[4], s[5]); pw.w = cvtpk(s[6], s[7]); const bf16x8 pf = __builtin_bit_cast(bf16x8, pw);
        oc[0] = __builtin_amdgcn_mfma_f32_16x16x32_bf16(v0, pf, oc[0], 0, 0, 0); oc[1] = __builtin_amdgcn_mfma_f32_16x16x32_bf16(v1, pf, oc[1], 0, 0, 0);
        oc[2] = __builtin_amdgcn_mfma_f32_16x16x32_bf16(v2, pf, oc[2], 0, 0, 0); oc[3] = __builtin_amdgcn_mfma_f32_16x16x32_bf16(v3, pf, oc[3], 0, 0, 0);
        asm volatile("s_waitcnt lgkmcnt(0)" ::: "memory");
        { const int q2 = lane >> 5, k = lane & 31; float a = 0.f;
#pragma unroll
          for (int h6 = 0; h6 < 6; ++h6) a += pn[(q2 * 6 + h6) * 32 + k];
          imp[q2 * 512 + kb + k] = a; }
        asm volatile("s_waitcnt lgkmcnt(0)" ::: "memory"); }
#ifdef NSA_DEBUG
      if (vcol) { for (int db = 0; db < 4; ++db) *(f32x4*)(P.DBG + ((size_t)0 * MP + row) * 768 + head * 64 + 16 * db + 4 * c) = oc[db]; }
#endif
      const float g0 = vcol ? gt[0] : 0.f;
#pragma unroll
      for (int db = 0; db < 4; ++db) oacc[db] += oc[db] * g0; }
    for (int i = lane; i < 256; i += 64) { const int q2 = i >> 7, b = i & 127, tq2 = t + q2, cur = tq2 / SLC_BLOCK; float sv;
        if (b > cur) sv = NEG; else if (b == 0 || b == cur || b == cur - 1) sv = FORCE_SCORE;
        else { const LAS float* ic = imp + q2 * 512 + 4 * b; sv = ic[-1] + 2.f * (ic[0] + ic[1] + ic[2]) + ic[3]; }
        sc[i] = sv; }
    asm volatile("s_waitcnt lgkmcnt(0)" ::: "memory");
    for (int i = lane; i < 256; i += 64) { const int q2 = i >> 7, b = i & 127; const float sv = sc[i]; int rank = 0;
        for (int j = 0; j < 128; ++j) { const float o = sc[q2 * 128 + j]; rank += (o > sv || (o == sv && j < b)) ? 1 : 0; }
        if (rank < SLC_TOPK) { const int v = (sv > 0.5f * NEG) ? b : -1; sel[q2 * 16 + rank] = v; P.SELB[((size_t)(n * SEQ + t + q2) * NSA_KV_HEADS + kvh) * 16 + rank] = v; } }
    asm volatile("s_waitcnt lgkmcnt(0)" ::: "memory");
    { Tile16 T; tile_init(T);
      const bf16* WKb = P.WNK + ((size_t)n * NSA_KV_HEADS + kvh) * SEQ * 64; const bf16* WVb = P.WNVT + ((size_t)n * NSA_KV_HEADS + kvh) * 64 * SEQ;
      const int blo = (t - SWA_WINDOW) >> 5, bhi = (t + 1) >> 5;
      auto ld = [&](KV8& kv, int blk) { const int bc = blk < 0 ? 0 : blk; kv_load_t(kv, WKb + (size_t)bc * 2048, WVb + (size_t)bc * 2048, lane); };
      pipe2(bhi - blo + 1, [&](KV8& kv, int i) { ld(kv, blo + i); }, [&](const KV8& kv, int i) { const int kb = 32 * (blo + i);
          tile_compute(T, qf, kv, [&](int e) { const int kp = kb + 8 * c + e; return vcol && kp >= 0 && kp <= tq && tq - kp <= SWA_WINDOW; }); });
      const float inv = (T.l > 0.f) ? 1.0f / T.l : 0.f, g2 = vcol ? gt[2] * inv : 0.f;
#ifdef NSA_DEBUG
      if (vcol) { for (int db = 0; db < 4; ++db) *(f32x4*)(P.DBG + ((size_t)2 * MP + row) * 768 + head * 64 + 16 * db + 4 * c) = T.o[db] * inv; }
#endif
#pragma unroll
      for (int db = 0; db < 4; ++db) oacc[db] += T.o[db] * g2; }
    if (vcol) { float* op = P.DPART + (size_t)row * 768 + head * 64 + 4 * c;
#pragma unroll
        for (int db = 0; db < 4; ++db) *(f32x4*)(op + 16 * db) = oacc[db]; }
}
DI void nsa_pair_b(const FP& P, int n, int kvh, int t, int lane, LAS unsigned char* wl) {
    LAS int* steps = (LAS int*)wl;
    const int col = lane & 15, c = lane >> 4; const bool vcol = col < 12; const int qq = vcol ? col / 6 : 0, hh = vcol ? col % 6 : 0, tq = t + qq, head = kvh * NSA_GROUP + hh, row = n * SEQ + tq;
    bf16x8 qf[2]; { const bf16* qp = P.QB + (size_t)row * NSA_Q_COLS + head * 64 + 8 * c; qf[0] = *(const bf16x8*)qp; qf[1] = *(const bf16x8*)(qp + 32); }
    const float* gt = P.GATES + (size_t)row * 64 + head * 3;
    Tile16 T; tile_init(T);
    const bf16* SKb = P.SLK + ((size_t)n * NSA_KV_HEADS + kvh) * SEQ * 64; const bf16* SVb = P.SLVT + ((size_t)n * NSA_KV_HEADS + kvh) * SEQ * 64;
    int ns = 0;
    { const int mysel = (lane < 32) ? P.SELB[((size_t)(n * SEQ + t + (lane >> 4)) * NSA_KV_HEADS + kvh) * 16 + (lane & 15)] : -1;
      for (int i = 0; i < 32; ++i) { const int b = __builtin_amdgcn_readlane(mysel, i); if (b < 0) continue; const int q2 = i >> 4;
          if (lane == 0) { steps[ns] = (b * SLC_BLOCK) | (q2 << 30); steps[ns + 1] = (b * SLC_BLOCK + 32) | (q2 << 30); } ns += 2; } }
    asm volatile("s_waitcnt lgkmcnt(0)" ::: "memory");
    auto ld = [&](KV8& kv, int i) { const int code = __builtin_amdgcn_readfirstlane(steps[i]); const int kb = code & 0x3fffffff;
        kv_load_t(kv, SKb + (size_t)(kb >> 5) * 2048, SVb + (size_t)(kb >> 5) * 2048, lane); };
#ifdef PROBE_DBLCOMP
    Tile16 T2; tile_init(T2);
#endif
    pipe2(ns, ld, [&](const KV8& kv, int i) { const int code = __builtin_amdgcn_readfirstlane(steps[i]); const int kb = code & 0x3fffffff, q2 = code >> 30;
        tile_compute(T, qf, kv, [&](int e) { return vcol && qq == q2 && (kb + 8 * c + e) <= tq; });
#ifdef PROBE_DBLCOMP
        tile_compute(T2, qf, kv, [&](int e) { return vcol && qq == q2 && (kb + 8 * c + e + 1) <= tq; });
#endif
    });
#ifdef PROBE_DBLCOMP
    if (T2.l < 0.f) T.l = 0.f;
#endif
    const float inv = (T.l > 0.f) ? 1.0f / T.l : 0.f, g1 = vcol ? gt[1] * inv : 0.f;
#ifdef NSA_DEBUG
    if (vcol) { for (int db = 0; db < 4; ++db) *(f32x4*)(P.DBG + ((size_t)1 * MP + row) * 768 + head * 64 + 16 * db + 4 * c) = T.o[db] * inv; }
#endif
    if (vcol) { const float* pp = P.DPART + (size_t)row * 768 + head * 64 + 4 * c; bf16* op = P.ATTB + (size_t)row * 1024 + head * 64 + 4 * c;
#pragma unroll
        for (int db = 0; db < 4; ++db) *(u32x2*)(op + 16 * db) = pk4(*(const f32x4*)(pp + 16 * db) + T.o[db] * g1); }
}

constexpr int SMP_SK = 1088;
template <class KF, class VF> DI void smp_branch(const Ctx& C, LAS float* qs, LAS float* S, LAS float* red, int NK, KF kf, VF vf, bool keep_probs, float (&outh)[1]) {
    const int tid = C.tid, lane = C.lane, w = C.wave;
#pragma unroll 1
    for (int j = tid; j < NK; j += NTHREADS) { const float* k = kf(j); f32x4 kr[16];
#pragma unroll
        for (int d4 = 0; d4 < 16; ++d4) kr[d4] = *(const f32x4*)(k + 4 * d4);
#pragma unroll 1
        for (int h = 0; h < 6; ++h) { float a = 0.f;
#pragma unroll
            for (int d4 = 0; d4 < 16; ++d4) { const f32x4 qv = *(const LAS f32x4*)(qs + h * 64 + 4 * d4); a += kr[d4].x * qv.x + kr[d4].y * qv.y + kr[d4].z * qv.z + kr[d4].w * qv.w; }
            S[h * SMP_SK + j] = a; } }
    asm volatile("s_waitcnt lgkmcnt(0)" ::: "memory"); __syncthreads();
    if (w < 6) { float m = -INFINITY; for (int j = lane; j < NK; j += 64) m = fmaxf(m, S[w * SMP_SK + j]); m = wave_max(m);
        float l = 0.f; for (int j = lane; j < NK; j += 64) { const float p = __builtin_amdgcn_exp2f(S[w * SMP_SK + j] - m); S[w * SMP_SK + j] = p; l += p; } l = wave_sum(l);
        const float inv = 1.0f / l; for (int j = lane; j < NK; j += 64) S[w * SMP_SK + j] *= inv; }
    asm volatile("s_waitcnt lgkmcnt(0)" ::: "memory"); __syncthreads();
    { const int per = (NK + NWAVES - 1) / NWAVES, j0 = w * per, j1 = (j0 + per < NK) ? j0 + per : NK; float o[6] = {0.f, 0.f, 0.f, 0.f, 0.f, 0.f};
#pragma unroll 1
      for (int j = j0; j < j1; j += 8) { float vv[8];
#pragma unroll
          for (int u = 0; u < 8; ++u) { const int jj = (j + u < j1) ? j + u : j1 - 1; vv[u] = vf(jj)[lane]; }
#pragma unroll
          for (int u = 0; u < 8; ++u) if (j + u < j1) {
#pragma unroll
              for (int h = 0; h < 6; ++h) o[h] += S[h * SMP_SK + j + u] * vv[u]; } }
#pragma unroll
      for (int h = 0; h < 6; ++h) red[(w * 6 + h) * 64 + lane] = o[h]; }
    asm volatile("s_waitcnt lgkmcnt(0)" ::: "memory"); __syncthreads();
    outh[0] = 0.f;
    if (tid < 384) { float a = 0.f;
#pragma unroll
        for (int ww = 0; ww < NWAVES; ++ww) a += red[ww * 384 + tid]; outh[0] = a; }
    if (!keep_probs) { __syncthreads(); }
}
DI void nsa_sample_item(const FP& P, const Ctx& C, int ns, int kvh) {
    LAS float* qs = (LAS float*)C.lds; LAS float* S = qs + 384; LAS float* red = S + 6 * SMP_SK; LAS float* scs = red + 8 * 384; LAS int* sel = (LAS int*)(scs + 136);
    const int tid = C.tid, row = M0 + ns;
    if (tid < 384) qs[tid] = bf2f(P.QB[(size_t)row * NSA_Q_COLS + kvh * 384 + tid]);
    asm volatile("s_waitcnt lgkmcnt(0)" ::: "memory"); __syncthreads();
    const float* ckf = P.CKF + ((size_t)ns * NSA_KV_HEADS + kvh) * NCH * 64; const float* cvf = P.CVF + ((size_t)ns * NSA_KV_HEADS + kvh) * NCH * 64;
    float oc[1], os[1], ow[1];
    smp_branch(C, qs, S, red, NCMP, [&](int j) { return ckf + (size_t)j * 64; }, [&](int j) { return cvf + (size_t)j * 64; }, true, oc);
    constexpr int NBS = (PAST_LEN + 1 + SLC_BLOCK - 1) / SLC_BLOCK, CURS = PAST_LEN / SLC_BLOCK;
    for (int b = tid; b < 136; b += NTHREADS) { float sv = -3.0e38f;
        if (b < NBS) { if (b == 0 || b == CURS || b == CURS - 1) sv = FORCE_SCORE; else { float a = 0.f;
#pragma unroll
                for (int o = -1; o <= 3; ++o) { const int ci = 4 * b + o; if (ci >= 0 && ci < NCMP) { float sm = 0.f; for (int h6 = 0; h6 < 6; ++h6) sm += S[h6 * SMP_SK + ci]; a += ((o >= 0 && o <= 2) ? 2.f : 1.f) * sm; } }
                sv = a; } }
        scs[b] = sv; }
    asm volatile("s_waitcnt lgkmcnt(0)" ::: "memory"); __syncthreads();
    for (int b = tid; b < NBS; b += NTHREADS) { const float sv = scs[b]; int rank = 0; for (int j = 0; j < NBS; ++j) { const float o = scs[j]; rank += (o > sv || (o == sv && j < b)) ? 1 : 0; }
        if (rank < SLC_TOPK) { sel[rank] = b; P.SELB[((size_t)row * NSA_KV_HEADS + kvh) * 16 + rank] = b; } }
    asm volatile("s_waitcnt lgkmcnt(0)" ::: "memory"); __syncthreads();
    { const float* newrow = P.nsa_kv_s + (size_t)ns * 512; const int* pt = P.page_table + ns * (PAST_LEN / PAGE_SIZE);
      if (tid == 0) { int seen = 0; for (int x = 0; x < SLC_TOPK; ++x) { const int bx = sel[x]; if (bx != CURS && seen < 15) sel[16 + seen++] = bx; } }
      asm volatile("s_waitcnt lgkmcnt(0)" ::: "memory"); __syncthreads();
      auto krow = [&](int j, int ty) -> const float* { if (j >= 15 * 64) return newrow + ty * 128 + kvh * 64;
          const int t0 = sel[16 + (j >> 6)] * SLC_BLOCK + (j & 63); const int pg = pt[t0 / PAGE_SIZE]; return P.cache_nsa_kv + ((size_t)pg * PAGE_SIZE + t0 % PAGE_SIZE) * 512 + ty * 128 + kvh * 64; };
      smp_branch(C, qs, S, red, 15 * 64 + 1, [&](int j) { return krow(j, 2); }, [&](int j) { return krow(j, 3); }, false, os); }
    { const float* wc = P.cache_nsa_win + (size_t)ns * SWA_WINDOW * 256; const float* newrow = P.win_s + ((size_t)ns * SWA_WINDOW + SWA_WINDOW - 1) * 256;
      smp_branch(C, qs, S, red, SWA_WINDOW + 1, [&](int j) { return (j < SWA_WINDOW ? wc + (size_t)j * 256 : newrow) + kvh * 64; }, [&](int j) { return (j < SWA_WINDOW ? wc + (size_t)j * 256 : newrow) + 128 + kvh * 64; }, false, ow); }
    if (tid < 384) { const int head = kvh * NSA_GROUP + tid / 64; const float* gt = P.GATES + (size_t)row * 64 + head * 3;
        P.ATTB[(size_t)row * 1024 + kvh * 384 + tid] = (bf16)f2bf(gt[0] * oc[0] + gt[1] * os[0] + gt[2] * ow[0]);
#ifdef NSA_DEBUG
        P.DBG[((size_t)0 * MP + row) * 768 + kvh * 384 + tid] = oc[0]; P.DBG[((size_t)1 * MP + row) * 768 + kvh * 384 + tid] = os[0]; P.DBG[((size_t)2 * MP + row) * 768 + kvh * 384 + tid] = ow[0];
#endif
    }
    __syncthreads();
}
DI void nsa_pairs(const FP& P, const Ctx& C, bool second) {
    LAS unsigned char* wl = C.lds + C.wave * NSA_WLDS;
    const int per = C.G / 4 > 0 ? C.G / 4 : 1, grp = (C.vcu / per) & 3, sub = C.vcu % per, n = grp >> 1, kvh = grp & 1;
#pragma unroll 1
    for (int pr = sub * NWAVES + C.wave; pr < SEQ / 2; pr += per * NWAVES) { if (second) nsa_pair_b(P, n, kvh, 2 * pr, C.lane, wl); else nsa_pair_a(P, n, kvh, 2 * pr, C.lane, wl); }
}
DI void nsa_phase_a(const FP& P, const Ctx& C) {
    for (int it = C.vcu; it < DEC_BATCH * NSA_KV_HEADS; it += C.G) nsa_sample_item(P, C, it / NSA_KV_HEADS, it % NSA_KV_HEADS);
    nsa_pairs(P, C, false);
    __syncthreads();
}
DI void nsa_phase_b(const FP& P, const Ctx& C) {
    const int lane = C.lane, w = C.wave;
    nsa_pairs(P, C, true);
    __syncthreads();
    { constexpr int NMT = (M0 / 16) * MEM_HEADS;
      for (int it = C.vcu * NWAVES + w; it < NMT; it += C.G * NWAVES) { const int h = it % MEM_HEADS, q16 = it / MEM_HEADS, row0 = q16 * 16, n = row0 / SEQ;
          mem_micro(P, P.MQB + h * 64, 256, row0, 1, n, h, P.ATTB + NSA_Q_COLS + h * 64, 1024, lane); }
      LAS float* qs = (LAS float*)(C.lds + 65536 + w * 256);
      for (int it = C.vcu * NWAVES + w; it < DEC_BATCH * MEM_HEADS; it += C.G * NWAVES) { const int h = it % MEM_HEADS, ns = it / MEM_HEADS, row = M0 + ns;
          Dec D; D.m = -INFINITY; D.l = 0.f; D.o = 0.f; qs[lane] = bf2f(P.MQB[(size_t)row * 256 + h * 64 + lane]); asm volatile("s_waitcnt lgkmcnt(0)" ::: "memory");
          const float* mk = P.cache_mem_kv + ((size_t)1 * DEC_BATCH + ns) * MEM_TOKENS * 512;
          for (int j0 = 0; j0 < MEM_TOKENS; j0 += 64) dec_chunk(D, qs, 64, [&](int j) { return mk + (size_t)(j0 + j) * 512 + h * 64; }, [&](int j) { return mk + (size_t)(j0 + j) * 512 + 256 + h * 64; }, lane);
          P.ATTB[(size_t)row * 1024 + NSA_Q_COLS + h * 64 + lane] = (bf16)f2bf(D.o / D.l); } }
    __syncthreads();
}
}
namespace fx {
enum { PH_PRO = 0, PH_WPK, PH_G1, PH_ATTA, PH_G2, PH_LN1, PH_SC0, PH_TK0, PH_PG0, PH_G3, PH_CMPG, PH_CMP2, PH_NSA, PH_NSB, PH_G4, PH_LN3, PH_SC1, PH_TK1, PH_PG1, PH_COUNT };
template <class Epi> DI void run_gemm(const Ctx& C, const bf16* A, const bf16* Bt, int M, int N, int K, const Epi& E) {
    pg8::Gemm g{A, Bt, M, N, K}; pg8::StaticOrder S; S.init(M, N, C.G, (int)blockIdx.x);
    pg8::gemm_phase<Epi, pg8::StaticOrder, true, true>(C.lds, g, S, E);
}
__global__ void __launch_bounds__(NTHREADS, 2) mega(Args args) {
    extern __shared__ __attribute__((aligned(16))) unsigned char lds_raw[];
    Ctx C; C.lds = (LAS unsigned char*)lds_raw; C.tid = threadIdx.x; C.lane = C.tid & 63; C.wave = __builtin_amdgcn_readfirstlane(C.tid >> 6);
    C.G = gridDim.x; { const int bx = blockIdx.x; C.vcu = (C.G % 8 == 0) ? (bx % 8) * (C.G / 8) + bx / 8 : bx; }
    const FP& P = args.p;
    volatile LAS unsigned* MISC = (volatile LAS unsigned*)(C.lds + MISC_OFF);
    for (int u = C.tid; u < (LDS_BYTES - RING_BYTES) / 4; u += NTHREADS) ((LAS unsigned*)(C.lds + RING_BYTES))[u] = 0u;
    __syncthreads();
    const int lo = args.lo, hi = args.hi;
    XcdBarrier bar; bar.bar = P.ctl + 1024; bar.x = 0; bar.st = nullptr;
    if (hi - lo > 1) bar = xcd_barrier_post(P.ctl + 1024, MISC + 8);
#define IN(k) (lo <= (k) && (k) < hi)
#define SEAM(k) do { if (IN(k) && IN((k) + 1)) xcd_barrier(bar); } while (0)
#ifndef DUP_PHASE
#define DUP_PHASE -1
#endif
#define PHASE(k, ...) do { if (IN(k)) { __VA_ARGS__ if (DUP_PHASE == (k)) { __syncthreads(); __VA_ARGS__ } } SEAM(k); } while (0)
    PHASE(PH_PRO, p0_prologue(P, C););
    PHASE(PH_WPK, p0_wpk(P, C););
    PHASE(PH_G1, run_gemm(C, P.XB0, P.WA_T, MPAD, ACOLS, D_MODEL, EpiA{P}); run_gemm(C, P.MEMB, P.WMEM_T, BATCH * MEM_TOKENS, 1024, D_MODEL, EpiMem{P}););
    PHASE(PH_ATTA, atta_phase(P, C););
    PHASE(PH_G2, run_gemm(C, P.ATTA, P.WOA_T, MPAD, D_MODEL, 512, EpiPre{P.x_prompt, P.x_sample, P.PRE}););
    PHASE(PH_LN1, ln_phase(P, C, P.PRE, P.ln_g, P.ln_b, P.X1, P.X1B, nullptr, nullptr););
    PHASE(PH_SC0, run_gemm(C, P.X1B, P.WPK_T, MPAD, NPK, D_MODEL, EpiF32{P.SCO, NPK, MP}););
    PHASE(PH_TK0, topk_phase(P, C););
    PHASE(PH_PG0, peer_phase(P, C, 0, P.X1, P.X2, P.X2 + (size_t)M0 * D_MODEL, P.X2B););
    PHASE(PH_G3, run_gemm(C, P.X2B, P.WB_T, MPAD, NB_T, D_MODEL, EpiB{P}););
    PHASE(PH_CMPG, run_gemm(C, P.AC, P.CW1_T, ACROWS, 256, 1024, EpiF32{P.UL, 256, ACROWS}); run_gemm(C, P.AC + (size_t)ACROWS * 1024, P.CW1_T + 256 * 1024, ACROWS, 256, 1024, EpiF32{P.UL + (size_t)ACROWS * 256, 256, ACROWS}););
    PHASE(PH_CMP2, cmp2_phase(P, C););
    PHASE(PH_NSA, nsa_phase_a(P, C););
    PHASE(PH_NSB, nsa_phase_b(P, C););
    PHASE(PH_G4, run_gemm(C, P.ATTB, P.WOB_T, MPAD, D_MODEL, 1024, EpiPre{P.X2, nullptr, P.PRE}););
    PHASE(PH_LN3, ln_phase(P, C, P.PRE, P.ln_g + 2 * D_MODEL, P.ln_b + 2 * D_MODEL, P.X3, P.X3B, nullptr, nullptr););
    PHASE(PH_SC1, run_gemm(C, P.X3B, P.WPK_T + (size_t)NPK * D_MODEL, MPAD, NPK, D_MODEL, EpiF32{P.SCO, NPK, MP}););
    PHASE(PH_TK1, topk_phase(P, C););
    PHASE(PH_PG1, peer_phase(P, C, 1, P.X3, P.y_prompt, P.y_sample, nullptr););
#undef IN
#undef SEAM
}
}
#ifndef ONE_LAUNCH
#define ONE_LAUNCH 1
#endif
extern "C" void kernel_launch(void* const* d_in, const int* in_sizes, int n_in, void* d_out, int out_size, void* d_ws, size_t ws_size, hipStream_t stream) {
    fx::Args a; memset(&a, 0, sizeof(a)); fx::bind_io(a.p, d_in, (float*)d_out);
    const size_t f_need = fx::carve(a.p, d_ws);
    if (f_need > ws_size) { fprintf(stderr, "kernel_launch: workspace too small: need %zu have %zu\n", f_need, ws_size); return; }
    static int grid = 0;
    if (!grid) { int dev = 0, cus = 0, per_cu = 0; (void)hipGetDevice(&dev); (void)hipDeviceGetAttribute(&cus, hipDeviceAttributeMultiprocessorCount, dev);
        (void)hipFuncSetAttribute((const void*)fx::mega, hipFuncAttributeMaxDynamicSharedMemorySize, fx::LDS_BYTES);
        if (hipOccupancyMaxActiveBlocksPerMultiprocessor(&per_cu, (const void*)fx::mega, fx::NTHREADS, fx::LDS_BYTES) != hipSuccess || per_cu < 1) { fprintf(stderr, "kernel_launch: occupancy query says %d blocks per CU\n", per_cu); (void)hipGetLastError(); }
        grid = cus; }
    (void)hipMemsetAsync(a.p.ctl, 0, fx::CTL_BYTES, stream);
#if ONE_LAUNCH
    a.lo = 0; a.hi = fx::PH_COUNT; hipLaunchKernelGGL(fx::mega, dim3(grid), dim3(fx::NTHREADS), fx::LDS_BYTES, stream, a);
#else
    for (int k = 0; k < fx::PH_COUNT; ++k) { a.lo = k; a.hi = k + 1; hipLaunchKernelGGL(fx::mega, dim3(grid), dim3(fx::NTHREADS), fx::LDS_BYTES, stream, a); }
#endif
}
```

```cpp
#define ONE_LAUNCH 1
#include <hip/hip_runtime.h>
#include <cstdio>
#include <cstring>
#include <cmath>
#ifdef CPU_TEST
#define HD inline
constexpr int D_MODEL = 128, BATCH = 2, SEQ = 512, DEPTH = 2, DEC_BATCH = 3, DEC_SEQ = 1, PAST_LEN = 512, PAGE_SIZE = 128;
constexpr int DIL_W[3] = {16, 64, 256}, DIL_D[3] = {1, 4, 16}, DIL_TAPS = 17;
constexpr int MEM_TOKENS = 32, SLC_TOPK = 4, SWA_WINDOW = 64, PEER_KEYS = 16, PEER_TOPK = 4;
#else
#define HD __host__ __device__ __forceinline__
constexpr int D_MODEL = 1024, BATCH = 2, SEQ = 8192, DEPTH = 2, DEC_BATCH = 32, DEC_SEQ = 1, PAST_LEN = 8192, PAGE_SIZE = 128;
constexpr int DIL_W[3] = {128, 512, 2048}, DIL_D[3] = {1, 4, 16}, DIL_TAPS = 129;
constexpr int MEM_TOKENS = 256, SLC_TOPK = 16, SWA_WINDOW = 512, PEER_KEYS = 128, PEER_TOPK = 16;
#endif
HD constexpr int dil_w(int g) { return g == 0 ? DIL_W[0] : (g == 1 ? DIL_W[1] : DIL_W[2]); }
HD constexpr int dil_d(int g) { return g == 0 ? DIL_D[0] : (g == 1 ? DIL_D[1] : DIL_D[2]); }
constexpr int HEAD_DIM = 64, N_A_LAYERS = DEPTH / 2, N_DIL = 3, DIL_HEADS = 4, DIL_COLS = N_DIL * 3 * DIL_HEADS * HEAD_DIM;
constexpr int MEM_HEADS = 4, MEM_COLS = MEM_HEADS * HEAD_DIM;
constexpr int NSA_HEADS = 12, NSA_KV_HEADS = 2, NSA_GROUP = 6, NSA_Q_COLS = NSA_HEADS * HEAD_DIM, NSA_GATE_COLS = NSA_HEADS * 3;
constexpr int CMP_BLOCK = 32, CMP_STRIDE = 16, CMP_HIDDEN = 128, SLC_BLOCK = 64;
constexpr int PEER_EXPERTS = PEER_KEYS * PEER_KEYS, PEER_HEADS = 8, PEER_KEY_DIM = 128;
constexpr float FORCE_SCORE = 1.0e9f, NEG = -1.0e30f, SCALE = 0.125f, LN_EPS = 1e-5f;
constexpr float ALPHA = 1.41421356237309515f;
constexpr float BETA = 0.5f;
#define LAS __attribute__((address_space(3)))
namespace pg8 {
#define PG8_LAS __attribute__((address_space(3)))
typedef unsigned short bf16_t;
typedef short bf16x8 __attribute__((ext_vector_type(8)));
typedef float f32x4 __attribute__((ext_vector_type(4)));
typedef unsigned u32x4 __attribute__((ext_vector_type(4)));
constexpr int BM = 256, BK = 64, HALF = 128, HTB = HALF * BK * 2  , STAGE_BYTES = 8 * HTB, NXCD = 8, WGM = 8;

__host__ __device__ __forceinline__ int lds_byte(int r, int c) { const int st = (r >> 4) * 2 + (c >> 5), rr = r & 15, cc = c & 31, ob = rr * 64 + cc * 2; return st * 1024 + (ob ^ (((ob >> 9) & 1) << 5)); }
__host__ __device__ __forceinline__ void stage_rc(int b, int& R, int& C) { const int st = b / 1024, sb = b % 1024, swz = sb ^ (((sb >> 9) & 1) << 5); R = (st >> 1) * 16 + swz / 64; C = (st & 1) * 32 + (swz % 64) / 2; }
__host__ __device__ __forceinline__ int perm32(int rho) { const int n = rho >> 4, i = rho & 15; return 8 * (i >> 2) + 4 * n + (i & 3); }

struct Unit { int pm, pn; };
struct Gemm { const bf16_t* A; const bf16_t* Bt; int M, N, K; };

struct StaticOrder {
    int nM, nN, nwg, G, c;
    __host__ __device__ void init(int M, int N, int G_, int c_) { nM = M / BM; nN = N / BM; nwg = nM * nN; G = G_; c = c_; }
    __host__ __device__ bool next(int i, Unit& u) const {
        const long L = (long)i * G + c; if (L >= nwg) return false;
        int wgid = (int)L; { const int q = nwg / NXCD, r = nwg % NXCD, xcd = wgid % NXCD, off = wgid / NXCD; wgid = (xcd < r ? xcd * (q + 1) : r * (q + 1) + (xcd - r) * q) + off; }
        const int nig = WGM * nN, gid = wgid / nig, fm = gid * WGM, gsz = (nM - fm) < WGM ? (nM - fm) : WGM;
        u.pm = fm + ((wgid % nig) % gsz); u.pn = (wgid % nig) / gsz; return true;
    }
    __device__ __forceinline__ void a_ready(const Unit&) const {}
    __device__ __forceinline__ void done(const Unit&) const {}
};

__device__ __forceinline__ unsigned cvt_pk_bf16(float lo, float hi) { unsigned r; asm volatile("v_cvt_pk_bf16_f32 %0, %1, %2" : "=v"(r) : "v"(lo), "v"(hi)); return r; }
typedef float f32x2 __attribute__((ext_vector_type(2)));
typedef float f32x2 __attribute__((ext_vector_type(2)));
template <class Epi, class Sched, bool ALIGN_EPI = false, bool SP2 = false>
__device__ __forceinline__ void gemm_phase(PG8_LAS unsigned char* lds, const Gemm g, const Sched& S, const Epi& E) {
    const int tid = threadIdx.x, wid = __builtin_amdgcn_readfirstlane(tid >> 6), lane = tid & 63, wr = wid >> 2, wc = wid & 3, fr = lane & 15, fq = lane >> 4;
    const int K = g.K, nt = K / BK;
    unsigned voffA[2], voffB[2];
#pragma unroll
    for (int i = 0; i < 2; ++i) { int R, C; stage_rc(tid * 16 + i * 8192, R, C); const int Rb = Epi::PERM ? ((R & ~31) + perm32(R & 31)) : R;
        voffA[i] = (unsigned)(R * K + C) * 2u; voffB[i] = (unsigned)(Rb * K + C) * 2u; }
    const size_t kstep = (size_t)(BK * 2);
    const size_t hstep = (size_t)HALF * K * 2;
    const size_t tstep = 2 * hstep;
    const unsigned ldsw = (unsigned)wid * 1024u;
    const int aoff = lds_byte(wr * 64 + fr, fq * 8), boff = lds_byte(wc * 32 + fr, fq * 8);
#define PG8_SA(b, h) (((b) * 2 + (h)) * HTB)
#define PG8_SB(b, h) ((4 + (b) * 2 + (h)) * HTB)
#define PG8_STAGE(bufoff, gbase, voff) do { _Pragma("unroll") for (int _i = 0; _i < 2; ++_i) \
        __builtin_amdgcn_global_load_lds((const unsigned*)((const char*)(gbase) + (voff)[_i]), (PG8_LAS unsigned*)(lds + (bufoff) + ldsw + _i * 8192), 16, 0, 0); } while (0)
#define PG8_LDA(dst, b, h) do { _Pragma("unroll") for (int m = 0; m < 4; ++m) _Pragma("unroll") for (int k = 0; k < 2; ++k) dst[m][k] = *(const PG8_LAS bf16x8*)(lds + PG8_SA(b, h) + aoff + m * 2048 + k * 1024); } while (0)
#define PG8_LDB(dst, b, h) do { _Pragma("unroll") for (int n = 0; n < 2; ++n) _Pragma("unroll") for (int k = 0; k < 2; ++k) dst[n][k] = *(const PG8_LAS bf16x8*)(lds + PG8_SB(b, h) + boff + n * 2048 + k * 1024); } while (0)
#define PG8_MMA(ai, bj, At, Bt) do { __builtin_amdgcn_s_setprio(1); _Pragma("unroll") for (int m = 0; m < 4; ++m) _Pragma("unroll") for (int n = 0; n < 2; ++n) _Pragma("unroll") for (int k = 0; k < 2; ++k) \
        acc[ai][bj][m][n] = __builtin_amdgcn_mfma_f32_16x16x32_bf16(Bt[n][k], At[m][k], acc[ai][bj][m][n], 0, 0, 0); __builtin_amdgcn_s_setprio(0); } while (0)
#define PG8_WAIT_V(n) asm volatile("s_waitcnt vmcnt(" #n ")" ::: "memory")
#define PG8_WAIT_L(n) asm volatile("s_waitcnt lgkmcnt(" #n ")" ::: "memory")
#define PG8_BAR __builtin_amdgcn_s_barrier()
#define PG8_SCHED __builtin_amdgcn_sched_barrier(0)
    Unit cur, nxt; int ui = 0;
    if (!S.next(0, cur)) return;
    f32x4 acc[2][2][4][2];
#pragma unroll
    for (int a = 0; a < 2; ++a)
#pragma unroll
        for (int b = 0; b < 2; ++b)
#pragma unroll
            for (int m = 0; m < 4; ++m)
#pragma unroll
                for (int n = 0; n < 2; ++n) acc[a][b][m][n] = (f32x4){0.f, 0.f, 0.f, 0.f};
    bf16x8 At[4][2], B0[2][2], B1[2][2];
    const char* cA = (const char*)g.A + (size_t)cur.pm * tstep; const char* cB = (const char*)g.Bt + (size_t)cur.pn * tstep;
    S.a_ready(cur);
    if constexpr (SP2) {
        PG8_STAGE(PG8_SB(0, 0), cB, voffB); PG8_STAGE(PG8_SB(0, 1), cB + hstep, voffB); PG8_STAGE(PG8_SA(0, 0), cA, voffA); PG8_STAGE(PG8_SA(0, 1), cA + hstep, voffA);
        if (wr == 1) PG8_BAR;
        PG8_WAIT_V(2); PG8_BAR;
        PG8_STAGE(PG8_SB(1, 0), cB + kstep, voffB); PG8_STAGE(PG8_SA(1, 0), cA + kstep, voffA); PG8_STAGE(PG8_SB(1, 1), cB + hstep + kstep, voffB);
        PG8_WAIT_V(6); PG8_BAR;
    } else {
        PG8_STAGE(PG8_SB(0, 0), cB, voffB); PG8_STAGE(PG8_SA(0, 0), cA, voffA); PG8_STAGE(PG8_SB(0, 1), cB + hstep, voffB); PG8_STAGE(PG8_SA(0, 1), cA + hstep, voffA);
        if (wr == 1) PG8_BAR;
        PG8_WAIT_V(4); PG8_BAR;
        PG8_STAGE(PG8_SB(1, 0), cB + kstep, voffB); PG8_STAGE(PG8_SA(1, 0), cA + kstep, voffA); PG8_STAGE(PG8_SB(1, 1), cB + hstep + kstep, voffB);
        PG8_WAIT_V(6); PG8_BAR;
    }
    for (;;) {
        const bool has_next = S.next(ui + 1, nxt);
        const char* nA = has_next ? (const char*)g.A + (size_t)nxt.pm * tstep : cA; const char* nB = has_next ? (const char*)g.Bt + (size_t)nxt.pn * tstep : cB;
        for (int t = 0; t < nt; t += 2) {
            const bool last = (t == nt - 2);
            const char* a1 = cA + (size_t)(t + 1) * kstep;
            const char* a2 = last ? nA : cA + (size_t)(t + 2) * kstep; const char* b2 = last ? nB : cB + (size_t)(t + 2) * kstep;
            const char* a3 = a2 + kstep; const char* b3 = b2 + kstep;
            if (last && has_next) S.a_ready(nxt);
            if constexpr (SP2) {
            PG8_LDB(B0, 0, 0); PG8_LDB(B1, 0, 1); PG8_SCHED; PG8_LDA(At, 0, 0); PG8_STAGE(PG8_SA(1, 1), a1 + hstep, voffA);
            PG8_WAIT_V(8); PG8_WAIT_L(0); PG8_BAR; PG8_MMA(0, 0, At, B0); PG8_MMA(0, 1, At, B1); PG8_BAR; PG8_SCHED;
            PG8_LDA(At, 0, 1); PG8_STAGE(PG8_SB(0, 0), b2, voffB); PG8_STAGE(PG8_SB(0, 1), b2 + hstep, voffB); PG8_STAGE(PG8_SA(0, 0), a2, voffA);
            PG8_WAIT_V(8); PG8_WAIT_L(0); PG8_BAR; PG8_MMA(1, 0, At, B0); PG8_MMA(1, 1, At, B1); PG8_BAR; PG8_SCHED;
            PG8_LDB(B0, 1, 0); PG8_LDB(B1, 1, 1); PG8_SCHED; PG8_LDA(At, 1, 0); PG8_STAGE(PG8_SA(0, 1), a2 + hstep, voffA);
            PG8_WAIT_V(8); PG8_WAIT_L(0); PG8_BAR; PG8_MMA(0, 0, At, B0); PG8_MMA(0, 1, At, B1); PG8_BAR; PG8_SCHED;
            PG8_LDA(At, 1, 1); PG8_STAGE(PG8_SB(1, 0), b3, voffB); PG8_STAGE(PG8_SB(1, 1), b3 + hstep, voffB); PG8_STAGE(PG8_SA(1, 0), a3, voffA);
            PG8_WAIT_V(8); PG8_WAIT_L(0); PG8_BAR; PG8_MMA(1, 0, At, B0); PG8_MMA(1, 1, At, B1); PG8_BAR; PG8_SCHED;
            } else {
            PG8_LDB(B0, 0, 0); PG8_SCHED; PG8_LDA(At, 0, 0); PG8_STAGE(PG8_SA(1, 1), a1 + hstep, voffA);
            PG8_WAIT_L(8); PG8_BAR; PG8_WAIT_L(0); PG8_MMA(0, 0, At, B0); PG8_BAR; PG8_SCHED;
            PG8_LDB(B1, 0, 1); PG8_STAGE(PG8_SB(0, 0), b2, voffB);
            PG8_BAR; PG8_WAIT_L(0); PG8_MMA(0, 1, At, B1); PG8_BAR;
            PG8_LDA(At, 0, 1); PG8_STAGE(PG8_SA(0, 0), a2, voffA);
            PG8_BAR; PG8_WAIT_L(0); PG8_MMA(1, 0, At, B0); PG8_BAR; PG8_SCHED;
            PG8_STAGE(PG8_SB(0, 1), b2 + hstep, voffB);
            PG8_WAIT_V(6); PG8_BAR; PG8_MMA(1, 1, At, B1); PG8_BAR;
            PG8_LDB(B0, 1, 0); PG8_SCHED; PG8_LDA(At, 1, 0); PG8_STAGE(PG8_SA(0, 1), a2 + hstep, voffA);
            PG8_WAIT_L(8); PG8_BAR; PG8_WAIT_L(0); PG8_MMA(0, 0, At, B0); PG8_BAR; PG8_SCHED;
            PG8_LDB(B1, 1, 1); PG8_STAGE(PG8_SB(1, 0), b3, voffB);
            PG8_BAR; PG8_WAIT_L(0); PG8_MMA(0, 1, At, B1); PG8_BAR;
            PG8_LDA(At, 1, 1); PG8_STAGE(PG8_SA(1, 0), a3, voffA);
            PG8_BAR; PG8_WAIT_L(0); PG8_MMA(1, 0, At, B0); PG8_BAR; PG8_SCHED;
            PG8_STAGE(PG8_SB(1, 1), b3 + hstep, voffB);
            PG8_WAIT_V(6); PG8_BAR; PG8_MMA(1, 1, At, B1); PG8_BAR;
            }
        }
        if constexpr (ALIGN_EPI) { if (wr == 0) PG8_BAR; }
        if constexpr (!Epi::AFTER_DRAIN) { E(acc, cur, wr, wc, fr, fq); S.done(cur); }
        if (!has_next) break;
#pragma unroll
        for (int a = 0; a < 2; ++a)
#pragma unroll
            for (int b = 0; b < 2; ++b)
#pragma unroll
                for (int m = 0; m < 4; ++m)
#pragma unroll
                    for (int n = 0; n < 2; ++n) acc[a][b][m][n] = (f32x4){0.f, 0.f, 0.f, 0.f};
        cur = nxt; cA = nA; cB = nB; ++ui;
        if constexpr (ALIGN_EPI) { if (wr == 1) PG8_BAR; }
    }
    PG8_WAIT_V(0);
    if constexpr (!ALIGN_EPI) { if (wr == 0) PG8_BAR; }
    PG8_BAR;
    if constexpr (Epi::AFTER_DRAIN) { E.fused(acc, cur, wr, wc, fr, fq, lds, wid, lane); S.done(cur); }
#undef PG8_SA
#undef PG8_SB
#undef PG8_STAGE
#undef PG8_LDA
#undef PG8_LDB
#undef PG8_MMA
#undef PG8_WAIT_V
#undef PG8_WAIT_L
#undef PG8_BAR
#undef PG8_SCHED
}
}
#define XB_TMO      128
#define XB_XCNT(j)  (256  + 64 * (j))
#define XB_XSUB(j)  (1280 + 64 * (j))
#define XB_XGEN(j)  (2304 + 64 * (j))
#define XB_TOP      3328
#define XB_TOPGEN   3392
#define XCD_BAR_WORDS 3456
#define XB_SPIN_CAP (1u << 18)

__device__ __forceinline__ unsigned xb_ld(unsigned* p)              { return __hip_atomic_load(p, __ATOMIC_RELAXED, __HIP_MEMORY_SCOPE_AGENT); }
__device__ __forceinline__ unsigned xb_add(unsigned* p, unsigned v) { return __hip_atomic_fetch_add(p, v, __ATOMIC_RELAXED, __HIP_MEMORY_SCOPE_AGENT); }
__device__ __forceinline__ unsigned xb_xcc_id() { return (unsigned)__builtin_amdgcn_s_getreg((3 << 11) | 20) & 0xFu; }
#define XB_SPIN(cond, bar) do { unsigned _sp = 0; while (cond) { __builtin_amdgcn_s_sleep(1); \
    if ((++_sp & 255u) == 0u) { if (xb_ld(&(bar)[XB_TMO])) break; if (_sp > XB_SPIN_CAP) { atomicAdd(&(bar)[XB_TMO], 1u); break; } } } } while (0)

struct XcdBarrier {
    unsigned* bar; unsigned x;
    volatile LAS unsigned* st;
};

__device__ __forceinline__ XcdBarrier xcd_barrier_post(unsigned* bar, volatile LAS unsigned* st) {
    XcdBarrier b; b.bar = bar; b.x = xb_xcc_id(); b.st = st;
    if (threadIdx.x == 0) (void)xb_add(&bar[XB_XCNT(b.x)], 1u);
    return b;
}
__device__ __forceinline__ void xcd_barrier_complete(unsigned* bar, unsigned x, unsigned& nloc, unsigned& nx) {
    const unsigned G = gridDim.x * gridDim.y * gridDim.z;
    unsigned sum, cnt, mine, sp = 0u;
    for (;;) {
        sum = 0u; cnt = 0u; mine = 0u;
#pragma unroll
        for (unsigned j = 0; j < 16; ++j) { const unsigned c = xb_ld(&bar[XB_XCNT(j)]); sum += c; cnt += (c > 0u) ? 1u : 0u; mine = (j == x) ? c : mine; }
        if (sum == G) break;
        __builtin_amdgcn_s_sleep(1);
        if ((++sp & 255u) == 0u) { if (xb_ld(&bar[XB_TMO])) break; if (sp > XB_SPIN_CAP) { atomicAdd(&bar[XB_TMO], 1u); break; } }
    }
    nloc = mine > 0u ? mine : 1u; nx = cnt > 0u ? cnt : 1u;
}

__device__ __forceinline__ void xcd_barrier(const XcdBarrier& b) {
    asm volatile("s_waitcnt vmcnt(0)" ::: "memory");
    __syncthreads();
    if (threadIdx.x == 0) {
        unsigned* bar = b.bar;
        __builtin_amdgcn_s_waitcnt(0);
        unsigned nloc = b.st[0], nx = b.st[1];
        if (nloc == 0u) { xcd_barrier_complete(bar, b.x, nloc, nx); b.st[0] = nloc; b.st[1] = nx; }
        const unsigned old = xb_add(&bar[XB_XSUB(b.x)], 1u);
        const unsigned gen = old / nloc;
        if (old + 1u == (gen + 1u) * nloc) {
            __builtin_amdgcn_fence(__ATOMIC_RELEASE, "agent");
            asm volatile("s_waitcnt vmcnt(0)" ::: "memory");
            const unsigned og = xb_add(&bar[XB_TOP], 1u);
            const unsigned tg = og / nx;
            if (og + 1u == (tg + 1u) * nx) xb_add(&bar[XB_TOPGEN], 1u);
            else XB_SPIN(xb_ld(&bar[XB_TOPGEN]) == tg, bar);
            __builtin_amdgcn_fence(__ATOMIC_ACQUIRE, "agent");
            xb_add(&bar[XB_XGEN(b.x)], 1u);
            asm volatile("s_waitcnt vmcnt(0)" ::: "memory");
        } else {
            XB_SPIN(xb_ld(&bar[XB_XGEN(b.x)]) == gen, bar);
            __builtin_amdgcn_fence(__ATOMIC_ACQUIRE, "agent");
            asm volatile("s_waitcnt vmcnt(0)" ::: "memory");
        }
    }
    __syncthreads();
}
namespace fx {
#define DI __device__ __forceinline__
typedef unsigned short bf16;
typedef short bf16x8 __attribute__((ext_vector_type(8)));
typedef float f32x4 __attribute__((ext_vector_type(4)));
typedef float f32x2 __attribute__((ext_vector_type(2)));
typedef unsigned u32x4 __attribute__((ext_vector_type(4)));
typedef unsigned u32x2 __attribute__((ext_vector_type(2)));
constexpr int M0 = BATCH * SEQ, MP = M0 + DEC_BATCH, MPAD = ((MP + 255) / 256) * 256;
constexpr int ACOLS = DIL_COLS + MEM_COLS, BCOLS = NSA_Q_COLS + NSA_GATE_COLS + MEM_COLS, KVCOLS = 6 * NSA_KV_HEADS * HEAD_DIM;
constexpr int NB_T = 2048;
constexpr int NPK = PEER_HEADS * 2 * PEER_KEYS;
constexpr int NCMP = (SEQ - CMP_BLOCK) / CMP_STRIDE + 1;
constexpr int NCH = SEQ / CMP_STRIDE;
constexpr int NCTX = BATCH + DEC_BATCH;
constexpr int ACROWS = NCTX * NSA_KV_HEADS * NCH;
constexpr int NPOS = PAST_LEN + 1;
constexpr float QSCALE = 0.125f * 1.4426950408889634f;
constexpr int NTHREADS = 512, NWAVES = 8, LDS_BYTES = 147456, RING_BYTES = 131072, MISC_OFF = RING_BYTES + 320;

struct FP {
    const float *x_prompt, *x_sample, *mem_prompt, *cache_dil[3], *cache_nsa_kv, *cache_nsa_win, *cache_mem_kv; const int* page_table;
    const float *w_in_a, *w_out_a, *w_in_b, *w_out_b, *w_mem_kv, *w_kv_b, *cmp_pe, *cmp_w1, *cmp_w2, *ln_g, *ln_b, *peer_wq, *peer_keys, *peer_u, *peer_v;
    float *y_prompt, *y_sample, *dil_p[3], *dil_s[3], *nsa_kv_p, *nsa_kv_s, *win_p, *win_s, *mem_kv_p;
    unsigned* ctl;
    bf16 *XB0, *X1B, *X2B, *X3B, *WA_T, *WMEM_T, *MEMB, *WOA_T, *WOB_T, *WPK_T, *WB_T, *CW1_T, *AC; unsigned char *UB8, *VB8;
    float *ROPE, *CBIAS;
    bf16 *QA, *KA, *VTA, *MQA, *MK, *MVT, *ATTA;
    float *DPART, *DML, *PRE, *X1, *X2, *X3, *SCO, *SELG; int* SELE;
    bf16 *SLK, *SLVT, *WNK, *WNVT, *QB, *MQB, *CK, *CVT, *ATTB;
    float *GATES, *UL, *CKF, *CVF;
    int* SELB;
    float* DBG;
};
struct Args { FP p; int lo, hi; };
struct Carve { size_t off = 0; template <class T> T* take(void* base, size_t n) { T* r = (T*)((char*)base + off); off += ((n * sizeof(T) + 255) / 256) * 256; return r; } };
constexpr size_t CTL_BYTES = 65536;
inline size_t carve(FP& p, void* base) {
    Carve c;
    p.ctl = c.take<unsigned>(base, CTL_BYTES / 4);
    p.XB0 = c.take<bf16>(base, (size_t)MPAD * D_MODEL); p.X1B = c.take<bf16>(base, (size_t)MPAD * D_MODEL); p.X2B = c.take<bf16>(base, (size_t)MPAD * D_MODEL); p.X3B = c.take<bf16>(base, (size_t)MPAD * D_MODEL);
    p.WA_T = c.take<bf16>(base, (size_t)ACOLS * D_MODEL); p.WMEM_T = c.take<bf16>(base, (size_t)DEPTH * 2 * MEM_COLS * D_MODEL); p.MEMB = c.take<bf16>(base, (size_t)BATCH * MEM_TOKENS * D_MODEL);
    p.WOA_T = c.take<bf16>(base, (size_t)D_MODEL * 2 * MEM_COLS); p.WOB_T = c.take<bf16>(base, (size_t)D_MODEL * (NSA_Q_COLS + MEM_COLS));
    p.WPK_T = c.take<bf16>(base, (size_t)DEPTH * NPK * D_MODEL); p.WB_T = c.take<bf16>(base, (size_t)NB_T * D_MODEL);
    p.UB8 = c.take<unsigned char>(base, (size_t)DEPTH * PEER_EXPERTS * D_MODEL); p.VB8 = c.take<unsigned char>(base, (size_t)DEPTH * PEER_EXPERTS * D_MODEL);
    p.CW1_T = c.take<bf16>(base, (size_t)2 * 256 * 1024); p.AC = c.take<bf16>(base, (size_t)2 * ACROWS * 1024);
    p.ROPE = c.take<float>(base, (size_t)NPOS * 64); p.CBIAS = c.take<float>(base, 2 * CMP_HIDDEN);
    p.QA = c.take<bf16>(base, (size_t)3 * MPAD * 256); p.KA = c.take<bf16>(base, (size_t)3 * MPAD * 256); p.VTA = c.take<bf16>(base, (size_t)3 * BATCH * DIL_HEADS * HEAD_DIM * SEQ + 4096);
    p.MQA = c.take<bf16>(base, (size_t)MPAD * 256); p.MK = c.take<bf16>(base, (size_t)DEPTH * BATCH * MEM_TOKENS * MEM_COLS); p.MVT = c.take<bf16>(base, (size_t)DEPTH * BATCH * MEM_COLS * MEM_TOKENS);
    p.ATTA = c.take<bf16>(base, (size_t)MPAD * 2 * MEM_COLS);
    p.DPART = c.take<float>(base, (size_t)3 * MP * DIL_HEADS * HEAD_DIM); p.DML = c.take<float>(base, (size_t)3 * MP * DIL_HEADS * 2);
    p.PRE = c.take<float>(base, (size_t)MPAD * D_MODEL); p.X1 = c.take<float>(base, (size_t)MPAD * D_MODEL); p.X2 = c.take<float>(base, (size_t)MPAD * D_MODEL); p.X3 = c.take<float>(base, (size_t)MPAD * D_MODEL);
    p.SCO = c.take<float>(base, (size_t)MPAD * NPK); p.SELG = c.take<float>(base, (size_t)MP * 128); p.SELE = c.take<int>(base, (size_t)MP * 128);
    p.SLK = c.take<bf16>(base, (size_t)BATCH * NSA_KV_HEADS * SEQ * HEAD_DIM); p.SLVT = c.take<bf16>(base, (size_t)BATCH * NSA_KV_HEADS * SEQ * HEAD_DIM);
    p.WNK = c.take<bf16>(base, (size_t)BATCH * NSA_KV_HEADS * SEQ * HEAD_DIM + 4096); p.WNVT = c.take<bf16>(base, (size_t)BATCH * NSA_KV_HEADS * SEQ * HEAD_DIM + 4096);
    p.QB = c.take<bf16>(base, (size_t)MPAD * NSA_Q_COLS); p.MQB = c.take<bf16>(base, (size_t)MPAD * 256);
    p.CK = c.take<bf16>(base, (size_t)NCTX * NSA_KV_HEADS * NCH * HEAD_DIM); p.CVT = c.take<bf16>(base, (size_t)NCTX * NSA_KV_HEADS * HEAD_DIM * NCH); p.ATTB = c.take<bf16>(base, (size_t)MPAD * (NSA_Q_COLS + MEM_COLS));
    p.GATES = c.take<float>(base, (size_t)MPAD * 64); p.UL = c.take<float>(base, (size_t)2 * ACROWS * 256);
    p.CKF = c.take<float>(base, (size_t)DEC_BATCH * NSA_KV_HEADS * NCH * HEAD_DIM); p.CVF = c.take<float>(base, (size_t)DEC_BATCH * NSA_KV_HEADS * NCH * HEAD_DIM);
    p.SELB = c.take<int>(base, (size_t)MP * NSA_KV_HEADS * 16);
#ifdef NSA_DEBUG
    p.DBG = c.take<float>(base, (size_t)3 * MP * 768);
#else
    p.DBG = nullptr;
#endif
    return c.off;
}
inline void bind_io(FP& p, void* const* d_in, float* out) {
    p.x_prompt = (const float*)d_in[0]; p.x_sample = (const float*)d_in[1]; p.mem_prompt = (const float*)d_in[2]; p.cache_dil[0] = (const float*)d_in[3]; p.cache_dil[1] = (const float*)d_in[4]; p.cache_dil[2] = (const float*)d_in[5];
    p.cache_nsa_kv = (const float*)d_in[6]; p.cache_nsa_win = (const float*)d_in[7]; p.cache_mem_kv = (const float*)d_in[8]; p.page_table = (const int*)d_in[9];
    p.w_in_a = (const float*)d_in[10]; p.w_out_a = (const float*)d_in[11]; p.w_in_b = (const float*)d_in[12]; p.w_out_b = (const float*)d_in[13]; p.w_mem_kv = (const float*)d_in[14]; p.w_kv_b = (const float*)d_in[15];
    p.cmp_pe = (const float*)d_in[16]; p.cmp_w1 = (const float*)d_in[17]; p.cmp_w2 = (const float*)d_in[18]; p.ln_g = (const float*)d_in[19]; p.ln_b = (const float*)d_in[20];
    p.peer_wq = (const float*)d_in[21]; p.peer_keys = (const float*)d_in[22]; p.peer_u = (const float*)d_in[23]; p.peer_v = (const float*)d_in[24];
    size_t o = 0; auto take = [&](size_t n) { float* r = out + o; o += n; return r; };
    p.y_prompt = take((size_t)M0 * D_MODEL); p.y_sample = take((size_t)DEC_BATCH * D_MODEL);
    for (int g = 0; g < 3; ++g) p.dil_p[g] = take((size_t)BATCH * DIL_W[g] * 2 * DIL_HEADS * HEAD_DIM);
    for (int g = 0; g < 3; ++g) p.dil_s[g] = take((size_t)DEC_BATCH * DIL_W[g] * 2 * DIL_HEADS * HEAD_DIM);
    p.nsa_kv_p = take((size_t)M0 * 4 * NSA_KV_HEADS * HEAD_DIM); p.nsa_kv_s = take((size_t)DEC_BATCH * 4 * NSA_KV_HEADS * HEAD_DIM);
    p.win_p = take((size_t)BATCH * SWA_WINDOW * 2 * NSA_KV_HEADS * HEAD_DIM); p.win_s = take((size_t)DEC_BATCH * SWA_WINDOW * 2 * NSA_KV_HEADS * HEAD_DIM);
    p.mem_kv_p = take((size_t)DEPTH * BATCH * MEM_TOKENS * 2 * MEM_COLS);
}
DI unsigned f2bf(float f) { unsigned u = __builtin_bit_cast(unsigned, f); return (u + 0x7fffu + ((u >> 16) & 1u)) >> 16; }
DI unsigned pk2(float lo, float hi) { return f2bf(lo) | (f2bf(hi) << 16); }
DI float bf2f(unsigned short b) { return __builtin_bit_cast(float, (unsigned)b << 16); }
DI float bflo(unsigned w) { return __builtin_bit_cast(float, w << 16); }
DI float bfhi(unsigned w) { return __builtin_bit_cast(float, w & 0xffff0000u); }
DI float wave_sum(float v) {
#pragma unroll
    for (int o = 1; o < 64; o <<= 1) v += __shfl_xor(v, o);
    return v; }
DI float wave_max(float v) {
#pragma unroll
    for (int o = 1; o < 64; o <<= 1) v = fmaxf(v, __shfl_xor(v, o));
    return v; }
DI float gelu_tanh(float x) { const float u = 0.7978845608028654f * (x + 0.044715f * x * x * x); const float e = __builtin_amdgcn_exp2f(u * 2.885390081777927f);   const float t = 1.0f - 2.0f / (e + 1.0f); return 0.5f * x * (1.0f + t); }
DI float* sel3(float* const (&a)[3], int g) { return g == 0 ? a[0] : (g == 1 ? a[1] : a[2]); }
DI const float* sel3c(const float* const (&a)[3], int g) { return g == 0 ? a[0] : (g == 1 ? a[1] : a[2]); }
struct Ctx { LAS unsigned char* lds; int tid, lane, wave, vcu, G; };
DI int row_pos(int r) { return r < M0 ? (r & (SEQ - 1)) : PAST_LEN; }

struct ColSrc { const float* p; int ld; };
DI int rope_il(int e) { return (e >> 1) + 32 * (e & 1); }
DI ColSrc col_wa(const FP& P, int n) {
    const int t = n >> 8, ct = n & 255, h = ct >> 6, e = ct & 63; if (t >= 9) return ColSrc{P.w_in_a + DIL_COLS + ct, ACOLS};
    const int j = t % 3, d = (j < 2) ? rope_il(e) : e; return ColSrc{P.w_in_a + t * 256 + h * 64 + d, ACOLS}; }
DI ColSrc col_wb(const FP& P, int n) {
    const int t = n >> 8, ct = n & 255, e = ct & 63;
    if (t < 3) { const int ty = 2 * t + (ct >> 7), kvh = (ct >> 6) & 1; const bool rot = (ty == 2 || ty == 4); return ColSrc{P.w_kv_b + (ty * NSA_KV_HEADS + kvh) * 64 + (rot ? rope_il(e) : e), KVCOLS}; }
    if (t < 6) { const int h = (t - 3) * 4 + (ct >> 6); return ColSrc{P.w_in_b + h * 64 + rope_il(e), BCOLS}; }
    if (t == 6) return ColSrc{P.w_in_b + NSA_Q_COLS + NSA_GATE_COLS + ct, BCOLS};
    if (ct < NSA_GATE_COLS) return ColSrc{P.w_in_b + NSA_Q_COLS + ct, BCOLS};
    return ColSrc{nullptr, 0}; }
DI ColSrc col_wmem(const FP& P, int n) { const int l = n >> 9, c = n & 511; return ColSrc{P.w_mem_kv + (size_t)l * D_MODEL * 512 + c, 512}; }
DI ColSrc col_woa(const FP& P, int n) { return ColSrc{P.w_out_a + n, D_MODEL}; }
DI ColSrc col_wob(const FP& P, int n) { return ColSrc{P.w_out_b + n, D_MODEL}; }
DI ColSrc col_cw1(const FP& P, int n) {
    const int ty = n >> 8, half = (n >> 7) & 1, hid = n & 127; return ColSrc{P.cmp_w1 + (size_t)ty * CMP_BLOCK * HEAD_DIM * CMP_HIDDEN + (size_t)half * 16 * HEAD_DIM * CMP_HIDDEN + hid, CMP_HIDDEN}; }
template <class CF> DI void transpose_item(const FP& P, CF cf, int K, bf16* WT, LAS float* scr, int item, int nblk, int lane) {
    const int kb = item / nblk, nb = item % nblk, k0 = 64 * kb, n0 = 32 * nb;
    const ColSrc cs = cf(P, n0 + (lane & 31));
#pragma unroll 8
    for (int i = 0; i < 32; ++i) { const int kk = 2 * i + (lane >> 5); scr[kk * 33 + (lane & 31)] = cs.p ? cs.p[(size_t)(k0 + kk) * cs.ld] : 0.f; }
    asm volatile("s_waitcnt lgkmcnt(0)" ::: "memory");
    const int c = lane & 7;
#pragma unroll
    for (int j = 0; j < 4; ++j) { const int n = (lane >> 3) + 8 * j; const LAS float* s = scr + (8 * c) * 33 + n;
        u32x4 o; o.x = pk2(s[0 * 33], s[1 * 33]); o.y = pk2(s[2 * 33], s[3 * 33]); o.z = pk2(s[4 * 33], s[5 * 33]); o.w = pk2(s[6 * 33], s[7 * 33]);
        *(u32x4*)(WT + (size_t)(n0 + n) * K + k0 + 8 * c) = o; }
    asm volatile("s_waitcnt lgkmcnt(0)" ::: "memory");
}
DI void cvt_row1024(const float* src, bf16* dst, int lane) {
#pragma unroll
    for (int j = 0; j < 4; ++j) { f32x4 v = src ? *(const f32x4*)(src + 256 * j + 4 * lane) : (f32x4){0.f, 0.f, 0.f, 0.f}; u32x2 o; o.x = pk2(v.x, v.y); o.y = pk2(v.z, v.w); *(u32x2*)(dst + 256 * j + 4 * lane) = o; }
}
DI void cvt_row1024_fp8(const float* src, unsigned char* dst, float sc, int lane) { u32x4 o; unsigned w[4];
#pragma unroll
    for (int j = 0; j < 4; ++j) { const f32x4 v = *(const f32x4*)(src + 16 * lane + 4 * j) * sc; int t = __builtin_amdgcn_cvt_pk_fp8_f32(v.x, v.y, 0, false); t = __builtin_amdgcn_cvt_pk_fp8_f32(v.z, v.w, t, true); w[j] = (unsigned)t; }
    o.x = w[0]; o.y = w[1]; o.z = w[2]; o.w = w[3]; *(u32x4*)(dst + 16 * lane) = o; }
DI void p0_prologue(const FP& P, const Ctx& C) {
    LAS float* scr = (LAS float*)(C.lds + C.wave * 16384);
    const int gw = C.vcu * NWAVES + C.wave, NGW = C.G * NWAVES, lane = C.lane;
    { constexpr int IA = (D_MODEL / 64) * (ACOLS / 32), IM = (D_MODEL / 64) * (1024 / 32), IOA = (512 / 64) * (D_MODEL / 32), IOB = (1024 / 64) * (D_MODEL / 32), IB = (D_MODEL / 64) * (NB_T / 32), IC = (1024 / 64) * (512 / 32);
      constexpr int NIT = IA + IM + IOA + IOB + IB + IC;
      for (int it = gw; it < NIT; it += NGW) { int r = it;
          if (r < IA) { transpose_item(P, col_wa, D_MODEL, P.WA_T, scr, r, ACOLS / 32, lane); continue; } r -= IA;
          if (r < IM) { transpose_item(P, col_wmem, D_MODEL, P.WMEM_T, scr, r, 1024 / 32, lane); continue; } r -= IM;
          if (r < IOA) { transpose_item(P, col_woa, 512, P.WOA_T, scr, r, D_MODEL / 32, lane); continue; } r -= IOA;
          if (r < IOB) { transpose_item(P, col_wob, 1024, P.WOB_T, scr, r, D_MODEL / 32, lane); continue; } r -= IOB;
          if (r < IB) { transpose_item(P, col_wb, D_MODEL, P.WB_T, scr, r, NB_T / 32, lane); continue; } r -= IB;
          transpose_item(P, col_cw1, 1024, P.CW1_T, scr, r, 512 / 32, lane); } }
    for (int r = gw; r < MPAD; r += NGW) { cvt_row1024(r < M0 ? P.x_prompt + (size_t)r * D_MODEL : (r < MP ? P.x_sample + (size_t)(r - M0) * D_MODEL : nullptr), P.XB0 + (size_t)r * D_MODEL, lane);
        if (r >= MP) { cvt_row1024(nullptr, P.X1B + (size_t)r * D_MODEL, lane); cvt_row1024(nullptr, P.X2B + (size_t)r * D_MODEL, lane); cvt_row1024(nullptr, P.X3B + (size_t)r * D_MODEL, lane);
            for (int c = lane; c < 512; c += 64) { P.ATTA[(size_t)r * 512 + c] = 0; P.ATTB[(size_t)r * 1024 + c] = 0; P.ATTB[(size_t)r * 1024 + 512 + c] = 0; } } }
    for (int r = gw; r < BATCH * MEM_TOKENS; r += NGW) cvt_row1024(P.mem_prompt + (size_t)r * D_MODEL, P.MEMB + (size_t)r * D_MODEL, lane);
#pragma unroll 1
    for (int r = 2 * gw; r < DEPTH * PEER_EXPERTS; r += 2 * NGW) { f32x4 a[16];
#pragma unroll
        for (int q = 0; q < 4; ++q) { const float* s0 = (q < 2 ? P.peer_u : P.peer_v) + (size_t)(r + (q & 1)) * D_MODEL + 16 * lane;
#pragma unroll
            for (int j = 0; j < 4; ++j) a[4 * q + j] = *(const f32x4*)(s0 + 4 * j); }
#pragma unroll
        for (int q = 0; q < 4; ++q) { const float sc = q < 2 ? 256.f : 64.f; unsigned w[4];
#pragma unroll
            for (int j = 0; j < 4; ++j) { const f32x4 v = a[4 * q + j] * sc; int t = __builtin_amdgcn_cvt_pk_fp8_f32(v.x, v.y, 0, false); t = __builtin_amdgcn_cvt_pk_fp8_f32(v.z, v.w, t, true); w[j] = (unsigned)t; }
            u32x4 o; o.x = w[0]; o.y = w[1]; o.z = w[2]; o.w = w[3]; *(u32x4*)((q < 2 ? P.UB8 : P.VB8) + (size_t)(r + (q & 1)) * D_MODEL + 16 * lane) = o; } }
    for (int i = gw * 64 + lane; i < NPOS * 32; i += NGW * 64) { const int pos = i >> 5, d = i & 31; const double inv = exp2(-(double)d * (13.287712379549449 / 32.0)); const double turns = (double)pos * inv * 0.15915494309189535;
        const float fr = (float)(turns - floor(turns)); P.ROPE[pos * 64 + d] = __builtin_amdgcn_cosf(fr); P.ROPE[pos * 64 + 32 + d] = __builtin_amdgcn_sinf(fr); }
    for (int i = gw * 64 + lane; i < 2 * CMP_HIDDEN; i += NGW * 64) { const int ty = i / CMP_HIDDEN, hid = i % CMP_HIDDEN; float a = 0.f; for (int k = 0; k < CMP_BLOCK * HEAD_DIM; ++k) a += P.cmp_pe[ty * CMP_BLOCK * HEAD_DIM + k] * P.cmp_w1[((size_t)ty * CMP_BLOCK * HEAD_DIM + k) * CMP_HIDDEN + hid]; P.CBIAS[i] = a; }
    for (int it = gw; it < DEC_BATCH * (PAST_LEN / PAGE_SIZE); it += NGW) { const int n = it / (PAST_LEN / PAGE_SIZE), pi = it % (PAST_LEN / PAGE_SIZE); const int pg = P.page_table[it];
        const float* src = P.cache_nsa_kv + (size_t)pg * PAGE_SIZE * 512 + 4 * lane; const int ty = lane >> 5, kvh = (lane >> 4) & 1, d = (4 * lane) & 63;
        bf16* dst = P.AC + ((size_t)ty * ACROWS + ((size_t)(BATCH + n) * NSA_KV_HEADS + kvh) * NCH + pi * (PAGE_SIZE / 16)) * 1024 + d;
#pragma unroll 1
        for (int r0 = 0; r0 < PAGE_SIZE; r0 += 8) { f32x4 v[8];
#pragma unroll
            for (int u = 0; u < 8; ++u) v[u] = *(const f32x4*)(src + (size_t)(r0 + u) * 512);
#pragma unroll
            for (int u = 0; u < 8; ++u) { const int t = r0 + u; u32x2 o; o.x = pk2(v[u].x, v[u].y); o.y = pk2(v[u].z, v[u].w); *(u32x2*)(dst + (size_t)(t / 16) * 1024 + (t % 16) * 64) = o; } } }
    for (int g = 0; g < 4; ++g) { const int W = g < 3 ? dil_w(g) : SWA_WINDOW, RV = g < 3 ? 128 : 64;
        const f32x4* src = (const f32x4*)(g < 3 ? sel3c(P.cache_dil, g) : P.cache_nsa_win); f32x4* dst = (f32x4*)(g < 3 ? sel3(P.dil_s, g) : P.win_s);
        const long per = (long)(W - 1) * RV, nvec = (long)DEC_BATCH * per;
#pragma unroll 1
        for (long i0 = (long)gw * 512; i0 < nvec; i0 += (long)NGW * 512) { f32x4 v[8]; long idx[8];
#pragma unroll
            for (int u = 0; u < 8; ++u) { const long i = i0 + u * 64 + lane; const long ii = i < nvec ? i : nvec - 1; const long n = ii / per, o = ii % per; idx[u] = n * (per + RV) + o; v[u] = src[idx[u] + RV]; }
#pragma unroll
            for (int u = 0; u < 8; ++u) { const long i = i0 + u * 64 + lane; if (i < nvec) dst[idx[u]] = v[u]; } } }
}
DI void p0_wpk(const FP& P, const Ctx& C) {
    LAS float* sw = (LAS float*)C.lds;
    LAS float* sk = (LAS float*)(C.lds + 32768);
    constexpr int NIT = DEPTH * 16 * (D_MODEL / 64);
    for (int it = C.vcu; it < NIT; it += C.G) { const int l = it / (16 * (D_MODEL / 64)), rem = it % (16 * (D_MODEL / 64)), hc = rem / (D_MODEL / 64), kb = rem % (D_MODEL / 64);
        __syncthreads();
        for (int i = C.tid; i < 64 * 64; i += NTHREADS) { const int r = i >> 6, d = i & 63; sw[r * 65 + d] = P.peer_wq[((size_t)l * D_MODEL + kb * 64 + r) * 1024 + hc * 64 + d]; }
        for (int i = C.tid; i < 128 * 64; i += NTHREADS) { const int r = i >> 6, d = i & 63; sk[r * 65 + d] = P.peer_keys[(((size_t)l * 16 + hc) * PEER_KEYS + r) * 64 + d]; }
        __syncthreads();
        for (int o = C.tid; o < 128 * 64; o += NTHREADS) { const int kk = o >> 6, ki = o & 63; float a = 0.f;
#pragma unroll 16
            for (int d = 0; d < 64; ++d) a += sw[ki * 65 + d] * sk[kk * 65 + d];
            P.WPK_T[((size_t)l * NPK + hc * 128 + kk) * D_MODEL + kb * 64 + ki] = (bf16)f2bf(a); } }
    __syncthreads();
}

#define EPI_LOOP(...) int fr_l = fr, fq_l = fq; asm volatile("" : "+v"(fr_l), "+v"(fq_l));     \
    _Pragma("unroll") for (int ai = 0; ai < 2; ++ai) _Pragma("unroll") for (int m = 0; m < 4; ++m) { const int row = u.pm * 256 + ai * 128 + wr * 64 + m * 16 + fr_l; \
    _Pragma("unroll") for (int bj = 0; bj < 2; ++bj) { const int ct = bj * 128 + wc * 32 + fq_l * 8; const f32x4 v0 = acc[ai][bj][m][0], v1 = acc[ai][bj][m][1]; __VA_ARGS__ } asm volatile("" ::: "memory"); }
DI void rope4(const float* rope_row, int dp, const f32x4& v0, const f32x4& v1, f32x4& lo, f32x4& hi) {
    const f32x4 c = *(const f32x4*)(rope_row + dp), s = *(const f32x4*)(rope_row + 32 + dp);
    lo.x = v0.x * c.x - v0.y * s.x; hi.x = v0.y * c.x + v0.x * s.x; lo.y = v0.z * c.y - v0.w * s.y; hi.y = v0.w * c.y + v0.z * s.y;
    lo.z = v1.x * c.z - v1.y * s.z; hi.z = v1.y * c.z + v1.x * s.z; lo.w = v1.z * c.w - v1.w * s.w; hi.w = v1.w * c.w + v1.z * s.w; }
DI u32x2 pk4(const f32x4& v) { u32x2 o; o.x = pk2(v.x, v.y); o.y = pk2(v.z, v.w); return o; }
DI u32x4 pk8(const f32x4& a, const f32x4& b) { u32x4 o; o.x = pk2(a.x, a.y); o.y = pk2(a.z, a.w); o.z = pk2(b.x, b.y); o.w = pk2(b.z, b.w); return o; }
DI int dil_perm(int t, int d) { return (t % d) * (SEQ / d) + t / d; }
struct EpiA {
    static constexpr bool PERM = true, AFTER_DRAIN = false; const FP& P;
    DI void operator()(const f32x4 (&acc)[2][2][4][2], const pg8::Unit& u, int wr, int wc, int fr, int fq) const {
        const int t9 = u.pn; const int g = t9 / 3, j = t9 % 3;
        EPI_LOOP({ if (row < MP) { const int h = ct >> 6, e = ct & 63; const int pos = row_pos(row);
            if (t9 == 9) { *(u32x4*)(P.MQA + (size_t)row * 256 + ct) = pk8(v0 * QSCALE, v1 * QSCALE); }
            else if (j < 2) { f32x4 lo, hi; const int dp = e >> 1; rope4(P.ROPE + pos * 64, dp, v0, v1, lo, hi);
                if (j == 0) { bf16* q = P.QA + ((size_t)g * MPAD + row) * 256 + h * 64 + dp; *(u32x2*)q = pk4(lo * QSCALE); *(u32x2*)(q + 32) = pk4(hi * QSCALE); }
                else { bf16* k = P.KA + ((size_t)g * MPAD + row) * 256 + h * 64 + dp; *(u32x2*)k = pk4(lo); *(u32x2*)(k + 32) = pk4(hi);
                    const int W = dil_w(g); float* o = nullptr;
                    if (row >= M0) o = sel3(P.dil_s, g) + (((size_t)(row - M0) * W + W - 1) * 2 + 0) * 256; else if (pos >= SEQ - W) o = sel3(P.dil_p, g) + (((size_t)(row / SEQ) * W + pos - (SEQ - W)) * 2 + 0) * 256;
                    if (o) { *(f32x4*)(o + h * 64 + dp) = lo; *(f32x4*)(o + h * 64 + 32 + dp) = hi; } } }
            else { const int W = dil_w(g), d = dil_d(g); float* o = nullptr;
                if (row >= M0) o = sel3(P.dil_s, g) + (((size_t)(row - M0) * W + W - 1) * 2 + 1) * 256; else if (pos >= SEQ - W) o = sel3(P.dil_p, g) + (((size_t)(row / SEQ) * W + pos - (SEQ - W)) * 2 + 1) * 256;
                if (o) { *(f32x4*)(o + ct) = v0; *(f32x4*)(o + ct + 4) = v1; }
                if (row < M0) { bf16* vt = P.VTA + (((size_t)(g * BATCH + row / SEQ) * DIL_HEADS + h) * 64 + e) * SEQ + dil_perm(pos, d);
                    vt[0 * SEQ] = (bf16)f2bf(v0.x); vt[1 * SEQ] = (bf16)f2bf(v0.y); vt[2 * SEQ] = (bf16)f2bf(v0.z); vt[3 * SEQ] = (bf16)f2bf(v0.w);
                    vt[4 * SEQ] = (bf16)f2bf(v1.x); vt[5 * SEQ] = (bf16)f2bf(v1.y); vt[6 * SEQ] = (bf16)f2bf(v1.z); vt[7 * SEQ] = (bf16)f2bf(v1.w); } } } })
    }
};
struct EpiMem {
    static constexpr bool PERM = true, AFTER_DRAIN = false; const FP& P;
    DI void operator()(const f32x4 (&acc)[2][2][4][2], const pg8::Unit& u, int wr, int wc, int fr, int fq) const {
        const int l = u.pn >> 1, half = u.pn & 1;
        EPI_LOOP({ const int n = row / MEM_TOKENS, mt = row % MEM_TOKENS; float* o = P.mem_kv_p + (((size_t)l * BATCH + n) * MEM_TOKENS + mt) * 512 + half * 256 + ct; *(f32x4*)o = v0; *(f32x4*)(o + 4) = v1;
            if (half == 0) *(u32x4*)(P.MK + (((size_t)l * BATCH + n) * MEM_TOKENS + mt) * 256 + ct) = pk8(v0, v1);
            else { bf16* vt = P.MVT + (((size_t)l * BATCH + n) * 256 + ct) * MEM_TOKENS + mt;
                vt[0 * MEM_TOKENS] = (bf16)f2bf(v0.x); vt[1 * MEM_TOKENS] = (bf16)f2bf(v0.y); vt[2 * MEM_TOKENS] = (bf16)f2bf(v0.z); vt[3 * MEM_TOKENS] = (bf16)f2bf(v0.w);
                vt[4 * MEM_TOKENS] = (bf16)f2bf(v1.x); vt[5 * MEM_TOKENS] = (bf16)f2bf(v1.y); vt[6 * MEM_TOKENS] = (bf16)f2bf(v1.z); vt[7 * MEM_TOKENS] = (bf16)f2bf(v1.w); } })
    }
};
struct EpiPre {
    static constexpr bool PERM = true, AFTER_DRAIN = false; const float* xa; const float* xb; float* pre;
    DI void operator()(const f32x4 (&acc)[2][2][4][2], const pg8::Unit& u, int wr, int wc, int fr, int fq) const {
        EPI_LOOP({ if (row < MP) { const int col = u.pn * 256 + ct; const float* x = (xb && row >= M0) ? xb + (size_t)(row - M0) * D_MODEL + col : xa + (size_t)row * D_MODEL + col;
            const f32x4 a = *(const f32x4*)x, b = *(const f32x4*)(x + 4); float* o = pre + (size_t)row * D_MODEL + col; *(f32x4*)o = a * ALPHA + v0; *(f32x4*)(o + 4) = b * ALPHA + v1; } })
    }
};
struct EpiF32 {
    static constexpr bool PERM = true, AFTER_DRAIN = false; float* out; int ldc; int nrows;
    DI void operator()(const f32x4 (&acc)[2][2][4][2], const pg8::Unit& u, int wr, int wc, int fr, int fq) const {
        EPI_LOOP({ if (row < nrows) { float* o = out + (size_t)row * ldc + u.pn * 256 + ct; *(f32x4*)o = v0; *(f32x4*)(o + 4) = v1; } })
    }
};
}
namespace fx {
struct Tile16 { f32x4 o[4]; float m, l; };
DI void tile_init(Tile16& T) { T.o[0] = T.o[1] = T.o[2] = T.o[3] = (f32x4){0.f, 0.f, 0.f, 0.f}; T.m = -INFINITY; T.l = 0.f; }
typedef __bf16 bf16x2_t __attribute__((ext_vector_type(2)));
DI unsigned cvtpk(float lo, float hi) { const f32x2 v = {lo, hi}; const bf16x2_t b = __builtin_convertvector(v, bf16x2_t); return __builtin_bit_cast(unsigned, b); }
struct KV8 { bf16x8 ka0, ka1, kb0, kb1, v0, v1, v2, v3; };
DI void kv_load(KV8& r, const bf16* k0, const bf16* k1, const bf16* v, long vs16) {
    r.ka0 = *(const bf16x8*)k0; r.ka1 = *(const bf16x8*)(k0 + 32); r.kb0 = *(const bf16x8*)k1; r.kb1 = *(const bf16x8*)(k1 + 32);
    r.v0 = *(const bf16x8*)v; r.v1 = *(const bf16x8*)(v + vs16); r.v2 = *(const bf16x8*)(v + 2 * vs16); r.v3 = *(const bf16x8*)(v + 3 * vs16); }
template <class MaskF> DI void tile_compute(Tile16& T, const bf16x8 (&qf)[2], const KV8& r, MaskF mask) {
    f32x4 s0 = (f32x4){0.f, 0.f, 0.f, 0.f}, s1 = (f32x4){0.f, 0.f, 0.f, 0.f};
    s0 = __builtin_amdgcn_mfma_f32_16x16x32_bf16(r.ka0, qf[0], s0, 0, 0, 0); s0 = __builtin_amdgcn_mfma_f32_16x16x32_bf16(r.ka1, qf[1], s0, 0, 0, 0);
    s1 = __builtin_amdgcn_mfma_f32_16x16x32_bf16(r.kb0, qf[0], s1, 0, 0, 0); s1 = __builtin_amdgcn_mfma_f32_16x16x32_bf16(r.kb1, qf[1], s1, 0, 0, 0);
    float s[8] = {s0.x, s0.y, s0.z, s0.w, s1.x, s1.y, s1.z, s1.w};
    float mx = -INFINITY;
#pragma unroll
    for (int e = 0; e < 8; ++e) { s[e] = mask(e) ? s[e] : -INFINITY; mx = fmaxf(mx, s[e]); }
    mx = fmaxf(mx, __shfl_xor(mx, 16)); mx = fmaxf(mx, __shfl_xor(mx, 32));
    const float mnew = fmaxf(T.m, mx), muse = (mnew == -INFINITY) ? 0.f : mnew;
    const float alpha = __builtin_amdgcn_exp2f(T.m - muse);
    float ls = 0.f;
#pragma unroll
    for (int e = 0; e < 8; ++e) { s[e] = __builtin_amdgcn_exp2f(s[e] - muse); ls += s[e]; }
    ls += __shfl_xor(ls, 16); ls += __shfl_xor(ls, 32);
    T.l = T.l * alpha + ls; T.m = mnew;
    u32x4 pw; pw.x = cvtpk(s[0], s[1]); pw.y = cvtpk(s[2], s[3]); pw.z = cvtpk(s[4], s[5]); pw.w = cvtpk(s[6], s[7]);
    const bf16x8 pf = __builtin_bit_cast(bf16x8, pw);
    T.o[0] = __builtin_amdgcn_mfma_f32_16x16x32_bf16(r.v0, pf, T.o[0] * alpha, 0, 0, 0); T.o[1] = __builtin_amdgcn_mfma_f32_16x16x32_bf16(r.v1, pf, T.o[1] * alpha, 0, 0, 0);
    T.o[2] = __builtin_amdgcn_mfma_f32_16x16x32_bf16(r.v2, pf, T.o[2] * alpha, 0, 0, 0); T.o[3] = __builtin_amdgcn_mfma_f32_16x16x32_bf16(r.v3, pf, T.o[3] * alpha, 0, 0, 0);
}
template <class LD, class CP> DI void pipe2(int n, LD ld, CP cp) { if (n <= 0) return; KV8 A, B; ld(A, 0);
#pragma unroll 1
    for (int i = 0; i < n; i += 2) { ld(B, (i + 1 < n) ? i + 1 : i); cp(A, i); ld(A, (i + 2 < n) ? i + 2 : i); if (i + 1 < n) cp(B, i + 1); } }
__host__ DI size_t ktile_off(int t, int d) { const int blk = t >> 5, kk = t & 31, b = (kk >> 2) & 1, i = 4 * (kk >> 3) + (kk & 3), s = d >> 5, c = (d & 31) >> 3; return ((size_t)(blk * 4 + 2 * b + s) * 64 + i + 16 * c) * 8 + (d & 7); }
__host__ DI size_t vtile_off(int dim, int t) { const int blk = t >> 5, kk = t & 31; return ((size_t)(blk * 4 + (dim >> 4)) * 64 + (dim & 15) + 16 * (kk >> 3)) * 8 + (kk & 7); }
DI void kv_load_t(KV8& r, const bf16* kt, const bf16* vt, int lane) {
    const bf16* k = kt + lane * 8; const bf16* v = vt + lane * 8;
    r.ka0 = *(const bf16x8*)k; r.ka1 = *(const bf16x8*)(k + 512); r.kb0 = *(const bf16x8*)(k + 1024); r.kb1 = *(const bf16x8*)(k + 1536);
    r.v0 = *(const bf16x8*)v; r.v1 = *(const bf16x8*)(v + 512); r.v2 = *(const bf16x8*)(v + 1024); r.v3 = *(const bf16x8*)(v + 1536); }
DI int krow_of(int i, int b) { return 8 * (i >> 2) + 4 * b + (i & 3); }

DI void dil_micro(const FP& P, int n, int h, int t0, int mt, int lane) {
    const int g = mt >> 4, idx = mt & 15, d = dil_d(g), per = 16 / d;
    const int r = idx / per, sub = idx % per, i0 = t0 / d + 16 * sub, ib = i0 - 128, NC = SEQ / d;
    const int q = lane & 15, c = lane >> 4;
    const bf16* Qb = P.QA + ((size_t)g * MPAD + (size_t)n * SEQ) * 256 + h * 64; const bf16* Kb = P.KA + ((size_t)g * MPAD + (size_t)n * SEQ) * 256 + h * 64;
    const bf16* Vb = P.VTA + ((size_t)(g * BATCH + n) * DIL_HEADS + h) * 64 * SEQ + (size_t)r * NC;
    bf16x8 qf[2]; { const bf16* qp = Qb + (size_t)(r + d * (i0 + q)) * 256 + 8 * c; qf[0] = *(const bf16x8*)qp; qf[1] = *(const bf16x8*)(qp + 32); }
    Tile16 T; tile_init(T);
    const int qi = i0 + q;
    auto ld = [&](KV8& kv, int blk) { const int kb = ib + 32 * blk; int ka = kb + krow_of(q, 0), kc = kb + krow_of(q, 1); ka = ka < 0 ? 0 : (ka >= NC ? NC - 1 : ka); kc = kc < 0 ? 0 : (kc >= NC ? NC - 1 : kc);
        kv_load(kv, Kb + (size_t)(r + d * ka) * 256 + 8 * c, Kb + (size_t)(r + d * kc) * 256 + 8 * c, Vb + (size_t)q * SEQ + kb + 8 * c, 16L * SEQ); };
    pipe2(5, ld, [&](const KV8& kv, int blk) { const int kb = ib + 32 * blk; tile_compute(T, qf, kv, [&](int e) { const int ki = kb + 8 * c + e; return ki >= 0 && ki <= qi && qi - ki <= DIL_TAPS - 1; }); });
    const int row = n * SEQ + r + d * qi;
    float* op = P.DPART + (((size_t)g * MP + row) * DIL_HEADS + h) * 64 + 4 * c;
#pragma unroll
    for (int db = 0; db < 4; ++db) *(f32x4*)(op + 16 * db) = T.o[db];
    if (c == 0) { float* ml = P.DML + (((size_t)g * MP + row) * DIL_HEADS + h) * 2; ml[0] = T.m; ml[1] = T.l; }
}
DI void mem_micro(const FP& P, const bf16* Q  , int ldq, int row0, int layer, int n, int h, bf16* O  , int ldo, int lane) {
    const int q = lane & 15, c = lane >> 4;
    bf16x8 qf[2]; { const bf16* qp = Q + (size_t)(row0 + q) * ldq + 8 * c; qf[0] = *(const bf16x8*)qp; qf[1] = *(const bf16x8*)(qp + 32); }
    const bf16* Kb = P.MK + ((size_t)layer * BATCH + n) * MEM_TOKENS * 256 + h * 64; const bf16* Vb = P.MVT + (((size_t)layer * BATCH + n) * 256 + h * 64) * MEM_TOKENS;
    Tile16 T; tile_init(T);
    auto ld = [&](KV8& kv, int blk) { const int kb = 32 * blk; kv_load(kv, Kb + (size_t)(kb + krow_of(q, 0)) * 256 + 8 * c, Kb + (size_t)(kb + krow_of(q, 1)) * 256 + 8 * c, Vb + (size_t)q * MEM_TOKENS + kb + 8 * c, 16L * MEM_TOKENS); };
    pipe2(MEM_TOKENS / 32, ld, [&](const KV8& kv, int) { tile_compute(T, qf, kv, [&](int) { return true; }); });
    const float inv = 1.0f / T.l; bf16* op = O + (size_t)(row0 + q) * ldo + 4 * c;
#pragma unroll
    for (int db = 0; db < 4; ++db) *(u32x2*)(op + 16 * db) = pk4(T.o[db] * inv);
}
struct Dec { float m, l, o; };
template <class KF, class VF> DI void dec_chunk(Dec& D, const LAS float* q, int nk, KF kf, VF vf, int lane) {
    float s = -INFINITY;
    if (lane < nk) { const float* k = kf(lane); float a = 0.f;
#pragma unroll
        for (int d4 = 0; d4 < 16; ++d4) { const f32x4 kv = *(const f32x4*)(k + 4 * d4); a += kv.x * q[4 * d4] + kv.y * q[4 * d4 + 1] + kv.z * q[4 * d4 + 2] + kv.w * q[4 * d4 + 3]; }
        s = a; }
    const float mx = wave_max(s), mnew = fmaxf(D.m, mx), alpha = __builtin_amdgcn_exp2f(D.m - mnew);
    const float p = (lane < nk) ? __builtin_amdgcn_exp2f(s - mnew) : 0.f;
    D.l = D.l * alpha + wave_sum(p); D.m = mnew; float o = D.o * alpha;
    for (int j0 = 0; j0 < nk; j0 += 8) { float vv[8];
#pragma unroll
        for (int u = 0; u < 8; ++u) { const int jj = (j0 + u < nk) ? j0 + u : nk - 1; vv[u] = vf(jj)[lane]; }
#pragma unroll
        for (int u = 0; u < 8; ++u) { const float pj = (j0 + u < nk) ? __builtin_bit_cast(float, __builtin_amdgcn_readlane(__builtin_bit_cast(int, p), (j0 + u) & 63)) : 0.f; o += pj * vv[u]; } }
    D.o = o;
}
DI void atta_phase(const FP& P, const Ctx& C) {
    const int lane = C.lane, w = C.wave;
    constexpr int NT = SEQ / 256, NIT = BATCH * NT * DIL_HEADS;
    for (int it = C.vcu; it < NIT; it += C.G) { const int h = it % DIL_HEADS, tt = (it / DIL_HEADS) % NT, n = it / (DIL_HEADS * NT), t0 = tt * 256;
        for (int mt = w; mt < 48; mt += NWAVES) dil_micro(P, n, h, t0, mt, lane);
        asm volatile("s_waitcnt vmcnt(0)" ::: "memory"); __syncthreads();
        for (int i = C.tid; i < 256 * 16; i += NTHREADS) { const int tk = i >> 4, d4 = (i & 15) * 4; const int row = n * SEQ + t0 + tk;
            float mg[3], lg[3]; float M = -INFINITY;
#pragma unroll
            for (int g = 0; g < 3; ++g) { const float* ml = P.DML + (((size_t)g * MP + row) * DIL_HEADS + h) * 2; mg[g] = ml[0]; lg[g] = ml[1]; M = fmaxf(M, mg[g]); }
            f32x4 acc = (f32x4){0.f, 0.f, 0.f, 0.f}; float L = 0.f;
#pragma unroll
            for (int g = 0; g < 3; ++g) { const float wg = __builtin_amdgcn_exp2f(mg[g] - M); L += wg * lg[g]; acc += *(const f32x4*)(P.DPART + (((size_t)g * MP + row) * DIL_HEADS + h) * 64 + d4) * wg; }
            *(u32x2*)(P.ATTA + (size_t)row * 512 + h * 64 + d4) = pk4(acc * (1.0f / L)); }
        for (int mt = w; mt < 16; mt += NWAVES) mem_micro(P, P.MQA + h * 64, 256, n * SEQ + t0 + 16 * mt, 0, n, h, P.ATTA + 256 + h * 64, 512, lane);
        __syncthreads();
    }
    LAS float* qs = (LAS float*)(C.lds + w * 1024);
    const int gw = C.vcu * NWAVES + w, NGW = C.G * NWAVES;
    for (int it = gw; it < DEC_BATCH * DIL_HEADS * 2; it += NGW) { const int kind = it & 1, h = (it >> 1) % DIL_HEADS, ns = (it >> 1) / DIL_HEADS, row = M0 + ns;
        Dec D; D.m = -INFINITY; D.l = 0.f; D.o = 0.f;
        if (kind == 0) {
            for (int g = 0; g < 3; ++g) qs[g * 64 + lane] = bf2f(P.QA[((size_t)g * MPAD + row) * 256 + h * 64 + lane]);
            asm volatile("s_waitcnt lgkmcnt(0)" ::: "memory");
            for (int g = 0; g < 3; ++g) { const int W = dil_w(g), d = dil_d(g); const float* cache = sel3c(P.cache_dil, g) + (size_t)ns * W * 512; const float* newrow = sel3(P.dil_s, g) + ((size_t)ns * W + W - 1) * 512;
                for (int j0 = 0; j0 < DIL_TAPS; j0 += 64) { const int nk = (DIL_TAPS - j0) < 64 ? (DIL_TAPS - j0) : 64;
                    dec_chunk(D, qs + g * 64, nk, [&](int j) { const int tap = j0 + j; return (tap == 0 ? newrow : cache + (size_t)(W - d * tap) * 512) + h * 64; },
                              [&](int j) { const int tap = j0 + j; return (tap == 0 ? newrow : cache + (size_t)(W - d * tap) * 512) + 256 + h * 64; }, lane); } }
            P.ATTA[(size_t)row * 512 + h * 64 + lane] = (bf16)f2bf(D.o / D.l);
        } else {
            qs[lane] = bf2f(P.MQA[(size_t)row * 256 + h * 64 + lane]);
            asm volatile("s_waitcnt lgkmcnt(0)" ::: "memory");
            const float* mk = P.cache_mem_kv + ((size_t)0 * DEC_BATCH + ns) * MEM_TOKENS * 512;
            for (int j0 = 0; j0 < MEM_TOKENS; j0 += 64) dec_chunk(D, qs, 64, [&](int j) { return mk + (size_t)(j0 + j) * 512 + h * 64; }, [&](int j) { return mk + (size_t)(j0 + j) * 512 + 256 + h * 64; }, lane);
            P.ATTA[(size_t)row * 512 + 256 + h * 64 + lane] = (bf16)f2bf(D.o / D.l);
        }
    }
    __syncthreads();
}
DI void ln_phase(const FP& P, const Ctx& C, const float* pre, const float* gam, const float* bet, float* xo, bf16* xb, float* yp, float* ys) {
    const int gw = C.vcu * NWAVES + C.wave, NGW = C.G * NWAVES, lane = C.lane;
    for (int r = gw; r < MP; r += NGW) { const float* x = pre + (size_t)r * D_MODEL; f32x4 v[4]; float s = 0.f;
#pragma unroll
        for (int j = 0; j < 4; ++j) { v[j] = *(const f32x4*)(x + 256 * j + 4 * lane); s += (v[j].x + v[j].y) + (v[j].z + v[j].w); }
        const float mu = wave_sum(s) * (1.0f / D_MODEL); float s2 = 0.f;
#pragma unroll
        for (int j = 0; j < 4; ++j) { v[j] = v[j] - mu; s2 += (v[j].x * v[j].x + v[j].y * v[j].y) + (v[j].z * v[j].z + v[j].w * v[j].w); }
        const float rs = 1.0f / sqrtf(wave_sum(s2) * (1.0f / D_MODEL) + LN_EPS);
#pragma unroll
        for (int j = 0; j < 4; ++j) { const f32x4 gg = *(const f32x4*)(gam + 256 * j + 4 * lane), bb = *(const f32x4*)(bet + 256 * j + 4 * lane); const f32x4 o = v[j] * rs * gg + bb;
            if (xo) *(f32x4*)(xo + (size_t)r * D_MODEL + 256 * j + 4 * lane) = o;
            if (xb) *(u32x2*)(xb + (size_t)r * D_MODEL + 256 * j + 4 * lane) = pk4(o);
            if (yp) { if (r < M0) *(f32x4*)(yp + (size_t)r * D_MODEL + 256 * j + 4 * lane) = o; else *(f32x4*)(ys + (size_t)(r - M0) * D_MODEL + 256 * j + 4 * lane) = o; } }
    }
}
}
namespace fx {
#define INS16(V, I, v_, i_) do { const float _v = (v_); const int _i = (i_); bool _c[16]; _Pragma("unroll") for (int _k = 0; _k < 16; ++_k) _c[_k] = _v > V[_k]; \
    _Pragma("unroll") for (int _k = 15; _k >= 1; --_k) { V[_k] = _c[_k] ? (_c[_k - 1] ? V[_k - 1] : _v) : V[_k]; I[_k] = _c[_k] ? (_c[_k - 1] ? I[_k - 1] : _i) : I[_k]; } \
    V[0] = _c[0] ? _v : V[0]; I[0] = _c[0] ? _i : I[0]; } while (0)
DI void wave_top16_128(float a, float b, int lane, float& outv, int& outi) {
    outv = -INFINITY; outi = 0;
#pragma unroll 1
    for (int k = 0; k < 16; ++k) { const float m = wave_max(fmaxf(a, b)); const unsigned long long ba = __ballot(a == m), bb = __ballot(b == m); int idx;
        if (ba) { const int l = __builtin_ctzll(ba); idx = l; if (lane == l) a = -INFINITY; } else { const int l = __builtin_ctzll(bb); idx = 64 + l; if (lane == l) b = -INFINITY; }
        if (lane == k) { outv = m; outi = idx; } }
}
DI void topk_wave_item(const FP& P, long it, int lane) {
    const float* s = P.SCO + it * 256; float v1, v2; int i1, i2;
    wave_top16_128(s[lane], s[64 + lane], lane, v1, i1); wave_top16_128(s[128 + lane], s[192 + lane], lane, v2, i2);
    int a = 0, rem = lane; bool valid = false;
    for (int aa = 0; aa < 16; ++aa) { const int nb = 16 / (aa + 1); if (!valid) { if (rem < nb) { a = aa; valid = true; } else rem -= nb; } }
    const int b = valid ? rem : 0;
    float cs = __shfl(v1, a) + __shfl(v2, b); const int ce = __shfl(i1, a) * PEER_KEYS + __shfl(i2, b); if (!valid) cs = -INFINITY;
    float tv = -INFINITY; int te = 0;
#pragma unroll 1
    for (int k = 0; k < 16; ++k) { const float m = wave_max(cs); const unsigned long long bm = __ballot(cs == m); const int l = __builtin_ctzll(bm); const int e = __shfl(ce, l); if (lane == l) cs = -INFINITY; if (lane == k) { tv = m; te = e; } }
    const float mx = __shfl(tv, 0); const float ex = (lane < 16) ? __expf(tv - mx) : 0.f; const float z = wave_sum(ex);
    if (lane < 16) { P.SELG[it * 16 + lane] = ex / z; P.SELE[it * 16 + lane] = te; }
}
DI void topk_phase(const FP& P, const Ctx& C) {
    const int lane = C.lane; LAS float* st = (LAS float*)(C.lds + C.wave * 16384);
    const int NWI = (M0 * PEER_HEADS) / 64;
    for (int wi = C.vcu * NWAVES + C.wave; wi < NWI; wi += C.G * NWAVES) {
        const long it0 = (long)wi * 64; const long it = it0 + lane; const bool act = true;
        float V1[16], V2[16], V3[16]; int I1[16], I2[16], I3[16];
#pragma unroll
        for (int k = 0; k < 16; ++k) { V1[k] = V2[k] = V3[k] = -INFINITY; I1[k] = I2[k] = I3[k] = 0; }
#pragma unroll 1
        for (int ch = 0; ch < 8; ++ch) {
#pragma unroll
            for (int u = 0; u < 8; ++u) { const int f4 = u * 64 + lane, j = f4 >> 3, q = f4 & 7, hf = q >> 2, c4 = (q & 3) * 4; const long itj = it0 + j;
                const f32x4 v = *(const f32x4*)(P.SCO + itj * 256 + hf * 128 + ch * 16 + c4);
                st[j * 33 + hf * 16 + c4] = v.x; st[j * 33 + hf * 16 + c4 + 1] = v.y; st[j * 33 + hf * 16 + c4 + 2] = v.z; st[j * 33 + hf * 16 + c4 + 3] = v.w; }
            asm volatile("s_waitcnt lgkmcnt(0)" ::: "memory");
#pragma unroll 1
            for (int c = 0; c < 16; ++c) { const float va = st[lane * 33 + c], vb = st[lane * 33 + 16 + c]; const int id = ch * 16 + c; INS16(V1, I1, va, id); INS16(V2, I2, vb, id); }
            asm volatile("s_waitcnt lgkmcnt(0)" ::: "memory");
        }
        { LAS float* lv = st; LAS int* li = (LAS int*)(st + 64 * 33);
#pragma unroll
          for (int k = 0; k < 16; ++k) { lv[lane * 33 + k] = V1[k]; lv[lane * 33 + 16 + k] = V2[k]; li[lane * 17 + k] = I1[k] | (I2[k] << 8); }
          asm volatile("s_waitcnt lgkmcnt(0)" ::: "memory");
          for (int a = 0; a < 16; ++a) { const float va = lv[lane * 33 + a]; const int ia = li[lane * 17 + a] & 255; const int nb = 16 / (a + 1);
              for (int b = 0; b < nb; ++b) { const float v = va + lv[lane * 33 + 16 + b]; const int ib = li[lane * 17 + b] >> 8; INS16(V3, I3, v, ia * PEER_KEYS + ib); } }
          asm volatile("s_waitcnt lgkmcnt(0)" ::: "memory"); }
        float z = 0.f; const float vmax = V3[0];
#pragma unroll
        for (int k = 0; k < 16; ++k) { V3[k] = __expf(V3[k] - vmax); z += V3[k]; }
        if (act) { const float iz = 1.0f / z;
#pragma unroll
            for (int k4 = 0; k4 < 4; ++k4) { *(f32x4*)(P.SELG + it * 16 + 4 * k4) = (f32x4){V3[4 * k4] * iz, V3[4 * k4 + 1] * iz, V3[4 * k4 + 2] * iz, V3[4 * k4 + 3] * iz};
                *(int4*)(P.SELE + it * 16 + 4 * k4) = make_int4(I3[4 * k4], I3[4 * k4 + 1], I3[4 * k4 + 2], I3[4 * k4 + 3]); } }
    }
    for (int si = C.vcu * NWAVES + C.wave; si < DEC_BATCH * PEER_HEADS; si += C.G * NWAVES) topk_wave_item(P, (long)M0 * PEER_HEADS + si, lane);
    __syncthreads();
}
constexpr float PEER_SU = 256.f, PEER_SV = 64.f;
DI float dot16_fp8(const u32x4& w, const f32x2 (&x2)[8]) { f32x2 a = {0.f, 0.f};
    a += __builtin_amdgcn_cvt_pk_f32_fp8((int)w.x, false) * x2[0]; a += __builtin_amdgcn_cvt_pk_f32_fp8((int)w.x, true) * x2[1];
    a += __builtin_amdgcn_cvt_pk_f32_fp8((int)w.y, false) * x2[2]; a += __builtin_amdgcn_cvt_pk_f32_fp8((int)w.y, true) * x2[3];
    a += __builtin_amdgcn_cvt_pk_f32_fp8((int)w.z, false) * x2[4]; a += __builtin_amdgcn_cvt_pk_f32_fp8((int)w.z, true) * x2[5];
    a += __builtin_amdgcn_cvt_pk_f32_fp8((int)w.w, false) * x2[6]; a += __builtin_amdgcn_cvt_pk_f32_fp8((int)w.w, true) * x2[7];
    return a.x + a.y; }
DI void axpy16_fp8(const u32x4& w, float s, f32x2 (&o2)[8]) { const f32x2 s2 = {s, s};
    o2[0] += __builtin_amdgcn_cvt_pk_f32_fp8((int)w.x, false) * s2; o2[1] += __builtin_amdgcn_cvt_pk_f32_fp8((int)w.x, true) * s2;
    o2[2] += __builtin_amdgcn_cvt_pk_f32_fp8((int)w.y, false) * s2; o2[3] += __builtin_amdgcn_cvt_pk_f32_fp8((int)w.y, true) * s2;
    o2[4] += __builtin_amdgcn_cvt_pk_f32_fp8((int)w.z, false) * s2; o2[5] += __builtin_amdgcn_cvt_pk_f32_fp8((int)w.z, true) * s2;
    o2[6] += __builtin_amdgcn_cvt_pk_f32_fp8((int)w.w, false) * s2; o2[7] += __builtin_amdgcn_cvt_pk_f32_fp8((int)w.w, true) * s2; }
DI float rdlane(float v, int l) { return __builtin_bit_cast(float, __builtin_amdgcn_readlane(__builtin_bit_cast(int, v), l)); }
DI void peer_phase(const FP& P, const Ctx& C, int layer, const float* xin, float* fout, float* fout_s, bf16* xb) {
    const int lane = C.lane; const unsigned char* U = P.UB8 + (size_t)layer * PEER_EXPERTS * D_MODEL; const unsigned char* Vt = P.VB8 + (size_t)layer * PEER_EXPERTS * D_MODEL;
    const float* gam = P.ln_g + ((size_t)layer * 2 + 1) * D_MODEL; const float* bet = P.ln_b + ((size_t)layer * 2 + 1) * D_MODEL;
    const int nrounds = (M0 + C.G * NWAVES - 1) / (C.G * NWAVES);
#pragma unroll 1
    for (int rd = 0; rd <= nrounds; ++rd) {
        const bool smp = (rd == nrounds); int r = smp ? M0 + C.vcu : rd * C.G * NWAVES + C.vcu * NWAVES + C.wave; if (smp ? (C.vcu >= DEC_BATCH) : (r >= M0)) continue;
        const int pb = smp ? 16 * C.wave : 0, pe = smp ? pb + 16 : 128;
        f32x2 x2[8], o2[8];
#pragma unroll
        for (int j = 0; j < 4; ++j) { const f32x4 a = *(const f32x4*)(xin + (size_t)r * D_MODEL + 16 * lane + 4 * j); x2[2 * j] = (f32x2){a.x, a.y}; x2[2 * j + 1] = (f32x2){a.z, a.w}; }
#pragma unroll
        for (int k = 0; k < 8; ++k) o2[k] = (f32x2){0.f, 0.f};
        const int e_l = P.SELE[(size_t)r * 128 + lane], e_h = P.SELE[(size_t)r * 128 + 64 + lane]; const float g_l = P.SELG[(size_t)r * 128 + lane], g_h = P.SELG[(size_t)r * 128 + 64 + lane];
#pragma unroll 1
        for (int b0 = pb; b0 < pe; b0 += 8) {
            u32x4 uw[8], vw[8];
#pragma unroll
            for (int k = 0; k < 8; ++k) { const int hk = b0 + k; const int e = (hk < 64) ? __builtin_amdgcn_readlane(e_l, hk & 63) : __builtin_amdgcn_readlane(e_h, hk & 63);
                uw[k] = *(const u32x4*)(U + (size_t)e * D_MODEL + 16 * lane); vw[k] = *(const u32x4*)(Vt + (size_t)e * D_MODEL + 16 * lane); }
            float d[8];
#pragma unroll
            for (int k = 0; k < 8; ++k) d[k] = dot16_fp8(uw[k], x2);
            float e4[4], e2[2], e1;
            { const bool hi = lane & 1;
#pragma unroll
              for (int i = 0; i < 4; ++i) { const float keep = hi ? d[4 + i] : d[i], send = hi ? d[i] : d[4 + i]; e4[i] = keep + __shfl_xor(send, 1); } }
            { const bool hi = lane & 2;
#pragma unroll
              for (int i = 0; i < 2; ++i) { const float keep = hi ? e4[2 + i] : e4[i], send = hi ? e4[i] : e4[2 + i]; e2[i] = keep + __shfl_xor(send, 2); } }
            { const bool hi = lane & 4; const float keep = hi ? e2[1] : e2[0], send = hi ? e2[0] : e2[1]; e1 = keep + __shfl_xor(send, 4); }
            e1 += __shfl_xor(e1, 8); e1 += __shfl_xor(e1, 16); e1 += __shfl_xor(e1, 32);
            const int myk = 4 * (lane & 1) + (lane & 2) + ((lane >> 2) & 1); const int myhk = b0 + myk;
            const float myg = (myhk < 64) ? __shfl(g_l, myhk & 63) : __shfl(g_h, myhk & 63);
            const float act = myg * gelu_tanh(e1 * (1.0f / PEER_SU)) * (1.0f / PEER_SV);
#pragma unroll
            for (int k = 0; k < 8; ++k) { const int src = (k >> 2) | (((k >> 1) & 1) << 1) | ((k & 1) << 2); axpy16_fp8(vw[k], rdlane(act, src), o2); }
        }
        if (smp) {
            LAS float* red = (LAS float*)C.lds;
#pragma unroll
            for (int k = 0; k < 8; ++k) { red[C.wave * 1024 + 16 * lane + 2 * k] = o2[k].x; red[C.wave * 1024 + 16 * lane + 2 * k + 1] = o2[k].y; }
            asm volatile("s_waitcnt lgkmcnt(0)" ::: "memory"); __syncthreads();
            if (C.wave == 0) {
#pragma unroll
                for (int k = 0; k < 8; ++k) { float ax = 0.f, ay = 0.f;
#pragma unroll
                    for (int ww = 0; ww < NWAVES; ++ww) { ax += red[ww * 1024 + 16 * lane + 2 * k]; ay += red[ww * 1024 + 16 * lane + 2 * k + 1]; } o2[k] = (f32x2){ax, ay}; } }
            __syncthreads();
            if (C.wave != 0) continue; }
        float s = 0.f;
#pragma unroll
        for (int k = 0; k < 8; ++k) { o2[k] += x2[k] * ALPHA; s += o2[k].x + o2[k].y; }
        const float mu = wave_sum(s) * (1.0f / D_MODEL); float s2 = 0.f;
#pragma unroll
        for (int k = 0; k < 8; ++k) { o2[k] -= mu; s2 += o2[k].x * o2[k].x + o2[k].y * o2[k].y; }
        const float rs = 1.0f / sqrtf(wave_sum(s2) * (1.0f / D_MODEL) + LN_EPS);
        float* frow = (r < M0) ? fout + (size_t)r * D_MODEL : fout_s + (size_t)(r - M0) * D_MODEL;
#pragma unroll
        for (int j = 0; j < 4; ++j) { const int c0 = 16 * lane + 4 * j; const f32x4 gg = *(const f32x4*)(gam + c0), bb = *(const f32x4*)(bet + c0);
            const f32x4 y = (f32x4){o2[2 * j].x * rs, o2[2 * j].y * rs, o2[2 * j + 1].x * rs, o2[2 * j + 1].y * rs} * gg + bb;
            *(f32x4*)(frow + c0) = y; if (xb) *(u32x2*)(xb + (size_t)r * D_MODEL + c0) = pk4(y); }
    }
}
}
namespace fx {
struct EpiB {
    static constexpr bool PERM = true, AFTER_DRAIN = false; const FP& P;
    DI void operator()(const f32x4 (&acc)[2][2][4][2], const pg8::Unit& u, int wr, int wc, int fr, int fq) const {
        const int t = u.pn;
        EPI_LOOP({ if (row < MP) { const int pos = row_pos(row), n = row / SEQ, e = ct & 63, dp = e >> 1; const bool prm = row < M0;
            if (t < 3) { const int ty = 2 * t + (ct >> 7), kvh = (ct >> 6) & 1;
                if (ty == 2 || ty == 4) { f32x4 lo, hi; rope4(P.ROPE + pos * 64, dp, v0, v1, lo, hi);
                    if (ty == 2) { float* o = (prm ? P.nsa_kv_p + (size_t)row * 512 : P.nsa_kv_s + (size_t)(row - M0) * 512) + 256 + kvh * 64 + dp; *(f32x4*)o = lo; *(f32x4*)(o + 32) = hi;
                        if (prm) { bf16* kt = P.SLK + ((size_t)n * NSA_KV_HEADS + kvh) * SEQ * 64; *(u32x2*)(kt + ktile_off(pos, dp)) = pk4(lo); *(u32x2*)(kt + ktile_off(pos, dp + 32)) = pk4(hi); } }
                    else { float* o = nullptr; if (!prm) o = P.win_s + (((size_t)(row - M0) * SWA_WINDOW + SWA_WINDOW - 1) * 2 + 0) * 128; else if (pos >= SEQ - SWA_WINDOW) o = P.win_p + (((size_t)n * SWA_WINDOW + pos - (SEQ - SWA_WINDOW)) * 2 + 0) * 128;
                        if (o) { *(f32x4*)(o + kvh * 64 + dp) = lo; *(f32x4*)(o + kvh * 64 + 32 + dp) = hi; }
                        if (prm) { bf16* kt = P.WNK + ((size_t)n * NSA_KV_HEADS + kvh) * SEQ * 64; *(u32x2*)(kt + ktile_off(pos, dp)) = pk4(lo); *(u32x2*)(kt + ktile_off(pos, dp + 32)) = pk4(hi); } } }
                else if (ty < 4) { float* o = (prm ? P.nsa_kv_p + (size_t)row * 512 : P.nsa_kv_s + (size_t)(row - M0) * 512) + ty * 128 + kvh * 64 + e; *(f32x4*)o = v0; *(f32x4*)(o + 4) = v1;
                    if (prm) { if (ty < 2) *(u32x4*)(P.AC + ((size_t)ty * ACROWS + ((size_t)n * NSA_KV_HEADS + kvh) * NCH + pos / 16) * 1024 + (pos % 16) * 64 + e) = pk8(v0, v1);
                        else { bf16* vt = P.SLVT + ((size_t)n * NSA_KV_HEADS + kvh) * SEQ * 64 + vtile_off(e, pos);
                            vt[0] = (bf16)f2bf(v0.x); vt[8] = (bf16)f2bf(v0.y); vt[16] = (bf16)f2bf(v0.z); vt[24] = (bf16)f2bf(v0.w); vt[32] = (bf16)f2bf(v1.x); vt[40] = (bf16)f2bf(v1.y); vt[48] = (bf16)f2bf(v1.z); vt[56] = (bf16)f2bf(v1.w); } } }
                else { float* o = nullptr; if (!prm) o = P.win_s + (((size_t)(row - M0) * SWA_WINDOW + SWA_WINDOW - 1) * 2 + 1) * 128; else if (pos >= SEQ - SWA_WINDOW) o = P.win_p + (((size_t)n * SWA_WINDOW + pos - (SEQ - SWA_WINDOW)) * 2 + 1) * 128;
                    if (o) { *(f32x4*)(o + kvh * 64 + e) = v0; *(f32x4*)(o + kvh * 64 + e + 4) = v1; }
                    if (prm) { bf16* vt = P.WNVT + ((size_t)n * NSA_KV_HEADS + kvh) * SEQ * 64 + vtile_off(e, pos);
                        vt[0] = (bf16)f2bf(v0.x); vt[8] = (bf16)f2bf(v0.y); vt[16] = (bf16)f2bf(v0.z); vt[24] = (bf16)f2bf(v0.w); vt[32] = (bf16)f2bf(v1.x); vt[40] = (bf16)f2bf(v1.y); vt[48] = (bf16)f2bf(v1.z); vt[56] = (bf16)f2bf(v1.w); } } }
            else if (t < 6) { const int h = (t - 3) * 4 + (ct >> 6); f32x4 lo, hi; rope4(P.ROPE + pos * 64, dp, v0, v1, lo, hi); bf16* q = P.QB + (size_t)row * NSA_Q_COLS + h * 64 + dp; *(u32x2*)q = pk4(lo * QSCALE); *(u32x2*)(q + 32) = pk4(hi * QSCALE); }
            else if (t == 6) { *(u32x4*)(P.MQB + (size_t)row * 256 + ct) = pk8(v0 * QSCALE, v1 * QSCALE); }
            else if (ct < 40) { const float vv[8] = {v0.x, v0.y, v0.z, v0.w, v1.x, v1.y, v1.z, v1.w};
                _Pragma("unroll") for (int i = 0; i < 8; ++i) if (ct + i < NSA_GATE_COLS) P.GATES[(size_t)row * 64 + ct + i] = 1.0f / (1.0f + __expf(-vv[i])); } } })
    }
};
DI void cmp2_phase(const FP& P, const Ctx& C) {
    const int lane = C.lane; LAS float* hs = (LAS float*)(C.lds + C.wave * 1024);
    constexpr int NGRP = NCTX * 2 * NSA_KV_HEADS; const int NW = C.G * NWAVES, WPG = NW / NGRP > 0 ? NW / NGRP : 1; const int gw = C.vcu * NWAVES + C.wave;
#pragma unroll 1
    for (int grp = gw / WPG; grp < NGRP; grp += (NW + WPG - 1) / WPG) { const int slot = gw % WPG; if (gw >= (NW / WPG) * WPG && grp == gw / WPG) break;
        const int kvh = grp % NSA_KV_HEADS, ty = (grp / NSA_KV_HEADS) % 2, ctx = grp / (2 * NSA_KV_HEADS);
        const float* UL = P.UL + ((size_t)ty * ACROWS + ((size_t)ctx * NSA_KV_HEADS + kvh) * NCH) * 256; const float* w2 = P.cmp_w2 + (size_t)ty * CMP_HIDDEN * HEAD_DIM;
        float w2r[CMP_HIDDEN];
#pragma unroll
        for (int k = 0; k < CMP_HIDDEN; ++k) w2r[k] = w2[k * HEAD_DIM + lane];
        const float b0 = P.CBIAS[ty * CMP_HIDDEN + lane], b1 = P.CBIAS[ty * CMP_HIDDEN + 64 + lane];
        float u0, u1, l0, l1; int c = slot;
        if (c < NCMP) { u0 = UL[(size_t)c * 256 + lane]; u1 = UL[(size_t)c * 256 + 64 + lane]; l0 = UL[(size_t)(c + 1) * 256 + 128 + lane]; l1 = UL[(size_t)(c + 1) * 256 + 192 + lane]; }
#pragma unroll 1
        for (; c < NCMP; c += WPG) { const float h0 = gelu_tanh(u0 + l0 + b0), h1 = gelu_tanh(u1 + l1 + b1); const int cn = c + WPG;
            if (cn < NCMP) { u0 = UL[(size_t)cn * 256 + lane]; u1 = UL[(size_t)cn * 256 + 64 + lane]; l0 = UL[(size_t)(cn + 1) * 256 + 128 + lane]; l1 = UL[(size_t)(cn + 1) * 256 + 192 + lane]; }
            hs[lane] = h0; hs[64 + lane] = h1; asm volatile("s_waitcnt lgkmcnt(0)" ::: "memory");
            float a = 0.f;
#pragma unroll
            for (int k4 = 0; k4 < CMP_HIDDEN / 4; ++k4) { const f32x4 hv = *(const LAS f32x4*)(hs + 4 * k4); a += hv.x * w2r[4 * k4] + hv.y * w2r[4 * k4 + 1] + hv.z * w2r[4 * k4 + 2] + hv.w * w2r[4 * k4 + 3]; }
            if (ty == 0) { const float other = __shfl_xor(a, 32); const int pos = c * CMP_STRIDE + CMP_BLOCK - 1; const float cs = P.ROPE[pos * 64 + (lane & 31)], sn = P.ROPE[pos * 64 + 32 + (lane & 31)];
                a = (lane < 32) ? a * cs - other * sn : a * cs + other * sn; }
            if (ctx < BATCH) { if (ty == 0) P.CK[((size_t)ctx * NSA_KV_HEADS + kvh) * NCH * 64 + ktile_off(c, lane)] = (bf16)f2bf(a); else P.CVT[((size_t)ctx * NSA_KV_HEADS + kvh) * NCH * 64 + vtile_off(lane, c)] = (bf16)f2bf(a); }
            else { (ty == 0 ? P.CKF : P.CVF)[(((size_t)(ctx - BATCH) * NSA_KV_HEADS + kvh) * NCH + c) * 64 + lane] = a; }
            asm volatile("s_waitcnt lgkmcnt(0)" ::: "memory"); }
    }
    __syncthreads();
}
constexpr int NSA_WLDS = 8192;
DI void nsa_pair_a(const FP& P, int n, int kvh, int t, int lane, LAS unsigned char* wl) {
    LAS float* pn = (LAS float*)wl; LAS float* imp = (LAS float*)(wl + 2048); LAS float* sc = (LAS float*)(wl + 6144); LAS int* sel = (LAS int*)(wl + 7168);
    const int col = lane & 15, c = lane >> 4; const bool vcol = col < 12; const int qq = vcol ? col / 6 : 0, hh = vcol ? col % 6 : 0, tq = t + qq, head = kvh * NSA_GROUP + hh, row = n * SEQ + tq;
    bf16x8 qf[2]; { const bf16* qp = P.QB + (size_t)row * NSA_Q_COLS + head * 64 + 8 * c; qf[0] = *(const bf16x8*)qp; qf[1] = *(const bf16x8*)(qp + 32); }
    const float* gt = P.GATES + (size_t)row * 64 + head * 3;
    f32x4 oacc[4] = {(f32x4){0.f, 0.f, 0.f, 0.f}, (f32x4){0.f, 0.f, 0.f, 0.f}, (f32x4){0.f, 0.f, 0.f, 0.f}, (f32x4){0.f, 0.f, 0.f, 0.f}};
    const int lim = vcol ? ((tq >= CMP_BLOCK - 1) ? (tq - (CMP_BLOCK - 1)) / CMP_STRIDE : -1) : -1;
    const int limmax = (t + 1 >= CMP_BLOCK - 1) ? (t + 1 - (CMP_BLOCK - 1)) / CMP_STRIDE : -1; const int nblk = (limmax + 32) / 32;
    const bf16* CKb = P.CK + ((size_t)n * NSA_KV_HEADS + kvh) * NCH * 64; const bf16* CVb = P.CVT + ((size_t)n * NSA_KV_HEADS + kvh) * 64 * NCH;
    for (int i = lane; i < 1024; i += 64) imp[i] = 0.f;
    float m1 = -INFINITY, l1 = 0.f;
    for (int blk = 0; blk < nblk; ++blk) { const int kb = 32 * blk; const bf16* kt = CKb + (size_t)blk * 2048 + lane * 8;
        const bf16x8 ka0 = *(const bf16x8*)kt, ka1 = *(const bf16x8*)(kt + 512), kb0 = *(const bf16x8*)(kt + 1024), kb1 = *(const bf16x8*)(kt + 1536);
        f32x4 s0 = (f32x4){0.f, 0.f, 0.f, 0.f}, s1 = (f32x4){0.f, 0.f, 0.f, 0.f};
        s0 = __builtin_amdgcn_mfma_f32_16x16x32_bf16(ka0, qf[0], s0, 0, 0, 0); s0 = __builtin_amdgcn_mfma_f32_16x16x32_bf16(ka1, qf[1], s0, 0, 0, 0);
        s1 = __builtin_amdgcn_mfma_f32_16x16x32_bf16(kb0, qf[0], s1, 0, 0, 0); s1 = __builtin_amdgcn_mfma_f32_16x16x32_bf16(kb1, qf[1], s1, 0, 0, 0);
        float s[8] = {s0.x, s0.y, s0.z, s0.w, s1.x, s1.y, s1.z, s1.w}; float mx = -INFINITY;
#pragma unroll
        for (int e = 0; e < 8; ++e) { s[e] = (kb + 8 * c + e <= lim) ? s[e] : -INFINITY; mx = fmaxf(mx, s[e]); }
        mx = fmaxf(mx, __shfl_xor(mx, 16)); mx = fmaxf(mx, __shfl_xor(mx, 32));
        const float mnew = fmaxf(m1, mx), muse = (mnew == -INFINITY) ? 0.f : mnew; float ls = 0.f;
#pragma unroll
        for (int e = 0; e < 8; ++e) ls += __builtin_amdgcn_exp2f(s[e] - muse);
        ls += __shfl_xor(ls, 16); ls += __shfl_xor(ls, 32);
        l1 = l1 * __builtin_amdgcn_exp2f(m1 - muse) + ls; m1 = mnew; }
    asm volatile("s_waitcnt lgkmcnt(0)" ::: "memory");
    { const float muse = (m1 == -INFINITY) ? 0.f : m1, inv = (l1 > 0.f) ? 1.0f / l1 : 0.f;
      f32x4 oc[4] = {(f32x4){0.f, 0.f, 0.f, 0.f}, (f32x4){0.f, 0.f, 0.f, 0.f}, (f32x4){0.f, 0.f, 0.f, 0.f}, (f32x4){0.f, 0.f, 0.f, 0.f}};
      for (int blk = 0; blk < nblk; ++blk) { const int kb = 32 * blk; const bf16* kt = CKb + (size_t)blk * 2048 + lane * 8; const bf16* v = CVb + (size_t)blk * 2048 + lane * 8;
        const bf16x8 ka0 = *(const bf16x8*)kt, ka1 = *(const bf16x8*)(kt + 512), kb0 = *(const bf16x8*)(kt + 1024), kb1 = *(const bf16x8*)(kt + 1536);
        const bf16x8 v0 = *(const bf16x8*)v, v1 = *(const bf16x8*)(v + 512), v2 = *(const bf16x8*)(v + 1024), v3 = *(const bf16x8*)(v + 1536);
        f32x4 s0 = (f32x4){0.f, 0.f, 0.f, 0.f}, s1 = (f32x4){0.f, 0.f, 0.f, 0.f};
        s0 = __builtin_amdgcn_mfma_f32_16x16x32_bf16(ka0, qf[0], s0, 0, 0, 0); s0 = __builtin_amdgcn_mfma_f32_16x16x32_bf16(ka1, qf[1], s0, 0, 0, 0);
        s1 = __builtin_amdgcn_mfma_f32_16x16x32_bf16(kb0, qf[0], s1, 0, 0, 0); s1 = __builtin_amdgcn_mfma_f32_16x16x32_bf16(kb1, qf[1], s1, 0, 0, 0);
        float s[8] = {s0.x, s0.y, s0.z, s0.w, s1.x, s1.y, s1.z, s1.w};
#pragma unroll
        for (int e = 0; e < 8; ++e) s[e] = (kb + 8 * c + e <= lim) ? __builtin_amdgcn_exp2f(s[e] - muse) * inv : 0.f;
        *(f32x4*)(pn + col * 32 + 8 * c) = (f32x4){s[0], s[1], s[2], s[3]}; *(f32x4*)(pn + col * 32 + 8 * c + 4) = (f32x4){s[4], s[5], s[6], s[7]};
        u32x4 pw; pw.x = cvtpk(s[0], s[1]); pw.y = cvtpk(s[2], s[3]); pw.z = cvtpk(s[4], s[5]); pw.w = cvtpk(s[6], s[7]); const bf16x8 pf = __builtin_bit_cast(bf16x8, pw);
        oc[0] = __builtin_amdgcn_mfma_f32_16x16x32_bf16(v0, pf, oc[0], 0, 0, 0); oc[1] = __builtin_amdgcn_mfma_f32_16x16x32_bf16(v1, pf, oc[1], 0, 0, 0);
        oc[2] = __builtin_amdgcn_mfma_f32_16x16x32_bf16(v2, pf, oc[2], 0, 0, 0); oc[3] = __builtin_amdgcn_mfma_f32_16x16x32_bf16(v3, pf, oc[3], 0, 0, 0);
        asm volatile("s_waitcnt lgkmcnt(0)" ::: "memory");
        { const int q2 = lane >> 5, k = lane & 31; float a = 0.f;
#pragma unroll
          for (int h6 = 0; h6 < 6; ++h6) a += pn[(q2 * 6 + h6) * 32 + k];
          imp[q2 * 512 + kb + k] = a; }
        asm volatile("s_waitcnt lgkmcnt(0)" ::: "memory"); }
#ifdef NSA_DEBUG
      if (vcol) { for (int db = 0; db < 4; ++db) *(f32x4*)(P.DBG + ((size_t)0 * MP + row) * 768 + head * 64 + 16 * db + 4 * c) = oc[db]; }
#endif
      const float g0 = vcol ? gt[0] : 0.f;
#pragma unroll
      for (int db = 0; db < 4; ++db) oacc[db] += oc[db] * g0; }
    for (int i = lane; i < 256; i += 64) { const int q2 = i >> 7, b = i & 127, tq2 = t + q2, cur = tq2 / SLC_BLOCK; float sv;
        if (b > cur) sv = NEG; else if (b == 0 || b == cur || b == cur - 1) sv = FORCE_SCORE;
        else { const LAS float* ic = imp + q2 * 512 + 4 * b; sv = ic[-1] + 2.f * (ic[0] + ic[1] + ic[2]) + ic[3]; }
        sc[i] = sv; }
    asm volatile("s_waitcnt lgkmcnt(0)" ::: "memory");
    for (int i = lane; i < 256; i += 64) { const int q2 = i >> 7, b = i & 127; const float sv = sc[i]; int rank = 0;
        for (int j = 0; j < 128; ++j) { const float o = sc[q2 * 128 + j]; rank += (o > sv || (o == sv && j < b)) ? 1 : 0; }
        if (rank < SLC_TOPK) { const int v = (sv > 0.5f * NEG) ? b : -1; sel[q2 * 16 + rank] = v; P.SELB[((size_t)(n * SEQ + t + q2) * NSA_KV_HEADS + kvh) * 16 + rank] = v; } }
    asm volatile("s_waitcnt lgkmcnt(0)" ::: "memory");
    { Tile16 T; tile_init(T);
      const bf16* WKb = P.WNK + ((size_t)n * NSA_KV_HEADS + kvh) * SEQ * 64; const bf16* WVb = P.WNVT + ((size_t)n * NSA_KV_HEADS + kvh) * 64 * SEQ;
      const int blo = (t - SWA_WINDOW) >> 5, bhi = (t + 1) >> 5;
      auto ld = [&](KV8& kv, int blk) { const int bc = blk < 0 ? 0 : blk; kv_load_t(kv, WKb + (size_t)bc * 2048, WVb + (size_t)bc * 2048, lane); };
      pipe2(bhi - blo + 1, [&](KV8& kv, int i) { ld(kv, blo + i); }, [&](const KV8& kv, int i) { const int kb = 32 * (blo + i);
          tile_compute(T, qf, kv, [&](int e) { const int kp = kb + 8 * c + e; return vcol && kp >= 0 && kp <= tq && tq - kp <= SWA_WINDOW; }); });
      const float inv = (T.l > 0.f) ? 1.0f / T.l : 0.f, g2 = vcol ? gt[2] * inv : 0.f;
#ifdef NSA_DEBUG
      if (vcol) { for (int db = 0; db < 4; ++db) *(f32x4*)(P.DBG + ((size_t)2 * MP + row) * 768 + head * 64 + 16 * db + 4 * c) = T.o[db] * inv; }
#endif
#pragma unroll
      for (int db = 0; db < 4; ++db) oacc[db] += T.o[db] * g2; }
    if (vcol) { float* op = P.DPART + (size_t)row * 768 + head * 64 + 4 * c;
#pragma unroll
        for (int db = 0; db < 4; ++db) *(f32x4*)(op + 16 * db) = oacc[db]; }
}
DI void nsa_pair_b(const FP& P, int n, int kvh, int t, int lane, LAS unsigned char* wl) {
    LAS int* steps = (LAS int*)wl;
    const int col = lane & 15, c = lane >> 4; const bool vcol = col < 12; const int qq = vcol ? col / 6 : 0, hh = vcol ? col % 6 : 0, tq = t + qq, head = kvh * NSA_GROUP + hh, row = n * SEQ + tq;
    bf16x8 qf[2]; { const bf16* qp = P.QB + (size_t)row * NSA_Q_COLS + head * 64 + 8 * c; qf[0] = *(const bf16x8*)qp; qf[1] = *(const bf16x8*)(qp + 32); }
    const float* gt = P.GATES + (size_t)row * 64 + head * 3;
    Tile16 T; tile_init(T);
    const bf16* SKb = P.SLK + ((size_t)n * NSA_KV_HEADS + kvh) * SEQ * 64; const bf16* SVb = P.SLVT + ((size_t)n * NSA_KV_HEADS + kvh) * SEQ * 64;
    int ns = 0;
    { const int mysel = (lane < 32) ? P.SELB[((size_t)(n * SEQ + t + (lane >> 4)) * NSA_KV_HEADS + kvh) * 16 + (lane & 15)] : -1;
      for (int i = 0; i < 32; ++i) { const int b = __builtin_amdgcn_readlane(mysel, i); if (b < 0) continue; const int q2 = i >> 4;
          if (lane == 0) { steps[ns] = (b * SLC_BLOCK) | (q2 << 30); steps[ns + 1] = (b * SLC_BLOCK + 32) | (q2 << 30); } ns += 2; } }
    asm volatile("s_waitcnt lgkmcnt(0)" ::: "memory");
    auto ld = [&](KV8& kv, int i) { const int code = __builtin_amdgcn_readfirstlane(steps[i]); const int kb = code & 0x3fffffff;
        kv_load_t(kv, SKb + (size_t)(kb >> 5) * 2048, SVb + (size_t)(kb >> 5) * 2048, lane); };
#ifdef PROBE_DBLCOMP
    Tile16 T2; tile_init(T2);
#endif
    pipe2(ns, ld, [&](const KV8& kv, int i) { const int code = __builtin_amdgcn_readfirstlane(steps[i]); const int kb = code & 0x3fffffff, q2 = code >> 30;
        tile_compute(T, qf, kv, [&](int e) { return vcol && qq == q2 && (kb + 8 * c + e) <= tq; });
#ifdef PROBE_DBLCOMP
        tile_compute(T2, qf, kv, [&](int e) { return vcol && qq == q2 && (kb + 8 * c + e + 1) <= tq; });
#endif
    });
#ifdef PROBE_DBLCOMP
    if (T2.l < 0.f) T.l = 0.f;
#endif
    const float inv = (T.l > 0.f) ? 1.0f / T.l : 0.f, g1 = vcol ? gt[1] * inv : 0.f;
#ifdef NSA_DEBUG
    if (vcol) { for (int db = 0; db < 4; ++db) *(f32x4*)(P.DBG + ((size_t)1 * MP + row) * 768 + head * 64 + 16 * db + 4 * c) = T.o[db] * inv; }
#endif
    if (vcol) { const float* pp = P.DPART + (size_t)row * 768 + head * 64 + 4 * c; bf16* op = P.ATTB + (size_t)row * 1024 + head * 64 + 4 * c;
#pragma unroll
        for (int db = 0; db < 4; ++db) *(u32x2*)(op + 16 * db) = pk4(*(const f32x4*)(pp + 16 * db) + T.o[db] * g1); }
}

constexpr int SMP_SK = 1088;
template <class KF, class VF> DI void smp_branch(const Ctx& C, LAS float* qs, LAS float* S, LAS float* red, int NK, KF kf, VF vf, bool keep_probs, float (&outh)[1]) {
    const int tid = C.tid, lane = C.lane, w = C.wave;
#pragma unroll 1
    for (int j = tid; j < NK; j += NTHREADS) { const float* k = kf(j); f32x4 kr[16];
#pragma unroll
        for (int d4 = 0; d4 < 16; ++d4) kr[d4] = *(const f32x4*)(k + 4 * d4);
#pragma unroll 1
        for (int h = 0; h < 6; ++h) { float a = 0.f;
#pragma unroll
            for (int d4 = 0; d4 < 16; ++d4) { const f32x4 qv = *(const LAS f32x4*)(qs + h * 64 + 4 * d4); a += kr[d4].x * qv.x + kr[d4].y * qv.y + kr[d4].z * qv.z + kr[d4].w * qv.w; }
            S[h * SMP_SK + j] = a; } }
    asm volatile("s_waitcnt lgkmcnt(0)" ::: "memory"); __syncthreads();
    if (w < 6) { float m = -INFINITY; for (int j = lane; j < NK; j += 64) m = fmaxf(m, S[w * SMP_SK + j]); m = wave_max(m);
        float l = 0.f; for (int j = lane; j < NK; j += 64) { const float p = __builtin_amdgcn_exp2f(S[w * SMP_SK + j] - m); S[w * SMP_SK + j] = p; l += p; } l = wave_sum(l);
        const float inv = 1.0f / l; for (int j = lane; j < NK; j += 64) S[w * SMP_SK + j] *= inv; }
    asm volatile("s_waitcnt lgkmcnt(0)" ::: "memory"); __syncthreads();
    { const int per = (NK + NWAVES - 1) / NWAVES, j0 = w * per, j1 = (j0 + per < NK) ? j0 + per : NK; float o[6] = {0.f, 0.f, 0.f, 0.f, 0.f, 0.f};
#pragma unroll 1
      for (int j = j0; j < j1; j += 8) { float vv[8];
#pragma unroll
          for (int u = 0; u < 8; ++u) { const int jj = (j + u < j1) ? j + u : j1 - 1; vv[u] = vf(jj)[lane]; }
#pragma unroll
          for (int u = 0; u < 8; ++u) if (j + u < j1) {
#pragma unroll
              for (int h = 0; h < 6; ++h) o[h] += S[h * SMP_SK + j + u] * vv[u]; } }
#pragma unroll
      for (int h = 0; h < 6; ++h) red[(w * 6 + h) * 64 + lane] = o[h]; }
    asm volatile("s_waitcnt lgkmcnt(0)" ::: "memory"); __syncthreads();
    outh[0] = 0.f;
    if (tid < 384) { float a = 0.f;
#pragma unroll
        for (int ww = 0; ww < NWAVES; ++ww) a += red[ww * 384 + tid]; outh[0] = a; }
    if (!keep_probs) { __syncthreads(); }
}
DI void nsa_sample_item(const FP& P, const Ctx& C, int ns, int kvh) {
    LAS float* qs = (LAS float*)C.lds; LAS float* S = qs + 384; LAS float* red = S + 6 * SMP_SK; LAS float* scs = red + 8 * 384; LAS int* sel = (LAS int*)(scs + 136);
    const int tid = C.tid, row = M0 + ns;
    if (tid < 384) qs[tid] = bf2f(P.QB[(size_t)row * NSA_Q_COLS + kvh * 384 + tid]);
    asm volatile("s_waitcnt lgkmcnt(0)" ::: "memory"); __syncthreads();
    const float* ckf = P.CKF + ((size_t)ns * NSA_KV_HEADS + kvh) * NCH * 64; const float* cvf = P.CVF + ((size_t)ns * NSA_KV_HEADS + kvh) * NCH * 64;
    float oc[1], os[1], ow[1];
    smp_branch(C, qs, S, red, NCMP, [&](int j) { return ckf + (size_t)j * 64; }, [&](int j) { return cvf + (size_t)j * 64; }, true, oc);
    constexpr int NBS = (PAST_LEN + 1 + SLC_BLOCK - 1) / SLC_BLOCK, CURS = PAST_LEN / SLC_BLOCK;
    for (int b = tid; b < 136; b += NTHREADS) { float sv = -3.0e38f;
        if (b < NBS) { if (b == 0 || b == CURS || b == CURS - 1) sv = FORCE_SCORE; else { float a = 0.f;
#pragma unroll
                for (int o = -1; o <= 3; ++o) { const int ci = 4 * b + o; if (ci >= 0 && ci < NCMP) { float sm = 0.f; for (int h6 = 0; h6 < 6; ++h6) sm += S[h6 * SMP_SK + ci]; a += ((o >= 0 && o <= 2) ? 2.f : 1.f) * sm; } }
                sv = a; } }
        scs[b] = sv; }
    asm volatile("s_waitcnt lgkmcnt(0)" ::: "memory"); __syncthreads();
    for (int b = tid; b < NBS; b += NTHREADS) { const float sv = scs[b]; int rank = 0; for (int j = 0; j < NBS; ++j) { const float o = scs[j]; rank += (o > sv || (o == sv && j < b)) ? 1 : 0; }
        if (rank < SLC_TOPK) { sel[rank] = b; P.SELB[((size_t)row * NSA_KV_HEADS + kvh) * 16 + rank] = b; } }
    asm volatile("s_waitcnt lgkmcnt(0)" ::: "memory"); __syncthreads();
    { const float* newrow = P.nsa_kv_s + (size_t)ns * 512; const int* pt = P.page_table + ns * (PAST_LEN / PAGE_SIZE);
      if (tid == 0) { int seen = 0; for (int x = 0; x < SLC_TOPK; ++x) { const int bx = sel[x]; if (bx != CURS && seen < 15) sel[16 + seen++] = bx; } }
      asm volatile("s_waitcnt lgkmcnt(0)" ::: "memory"); __syncthreads();
      auto krow = [&](int j, int ty) -> const float* { if (j >= 15 * 64) return newrow + ty * 128 + kvh * 64;
          const int t0 = sel[16 + (j >> 6)] * SLC_BLOCK + (j & 63); const int pg = pt[t0 / PAGE_SIZE]; return P.cache_nsa_kv + ((size_t)pg * PAGE_SIZE + t0 % PAGE_SIZE) * 512 + ty * 128 + kvh * 64; };
      smp_branch(C, qs, S, red, 15 * 64 + 1, [&](int j) { return krow(j, 2); }, [&](int j) { return krow(j, 3); }, false, os); }
    { const float* wc = P.cache_nsa_win + (size_t)ns * SWA_WINDOW * 256; const float* newrow = P.win_s + ((size_t)ns * SWA_WINDOW + SWA_WINDOW - 1) * 256;
      smp_branch(C, qs, S, red, SWA_WINDOW + 1, [&](int j) { return (j < SWA_WINDOW ? wc + (size_t)j * 256 : newrow) + kvh * 64; }, [&](int j) { return (j < SWA_WINDOW ? wc + (size_t)j * 256 : newrow) + 128 + kvh * 64; }, false, ow); }
    if (tid < 384) { const int head = kvh * NSA_GROUP + tid / 64; const float* gt = P.GATES + (size_t)row * 64 + head * 3;
        P.ATTB[(size_t)row * 1024 + kvh * 384 + tid] = (bf16)f2bf(gt[0] * oc[0] + gt[1] * os[0] + gt[2] * ow[0]);
#ifdef NSA_DEBUG
        P.DBG[((size_t)0 * MP + row) * 768 + kvh * 384 + tid] = oc[0]; P.DBG[((size_t)1 * MP + row) * 768 + kvh * 384 + tid] = os[0]; P.DBG[((size_t)2 * MP + row) * 768 + kvh * 384 + tid] = ow[0];
#endif
    }
    __syncthreads();
}
DI void nsa_pairs(const FP& P, const Ctx& C, bool second) {
    LAS unsigned char* wl = C.lds + C.wave * NSA_WLDS;
    const int per = C.G / 4 > 0 ? C.G / 4 : 1, grp = (C.vcu / per) & 3, sub = C.vcu % per, n = grp >> 1, kvh = grp & 1;
#pragma unroll 1
    for (int pr = sub * NWAVES + C.wave; pr < SEQ / 2; pr += per * NWAVES) { if (second) nsa_pair_b(P, n, kvh, 2 * pr, C.lane, wl); else nsa_pair_a(P, n, kvh, 2 * pr, C.lane, wl); }
}
DI void nsa_phase_a(const FP& P, const Ctx& C) {
    for (int it = C.vcu; it < DEC_BATCH * NSA_KV_HEADS; it += C.G) nsa_sample_item(P, C, it / NSA_KV_HEADS, it % NSA_KV_HEADS);
    nsa_pairs(P, C, false);
    __syncthreads();
}
DI void nsa_phase_b(const FP& P, const Ctx& C) {
    const int lane = C.lane, w = C.wave;
    nsa_pairs(P, C, true);
    __syncthreads();
    { constexpr int NMT = (M0 / 16) * MEM_HEADS;
      for (int it = C.vcu * NWAVES + w; it < NMT; it += C.G * NWAVES) { const int h = it % MEM_HEADS, q16 = it / MEM_HEADS, row0 = q16 * 16, n = row0 / SEQ;
          mem_micro(P, P.MQB + h * 64, 256, row0, 1, n, h, P.ATTB + NSA_Q_COLS + h * 64, 1024, lane); }
      LAS float* qs = (LAS float*)(C.lds + 65536 + w * 256);
      for (int it = C.vcu * NWAVES + w; it < DEC_BATCH * MEM_HEADS; it += C.G * NWAVES) { const int h = it % MEM_HEADS, ns = it / MEM_HEADS, row = M0 + ns;
          Dec D; D.m = -INFINITY; D.l = 0.f; D.o = 0.f; qs[lane] = bf2f(P.MQB[(size_t)row * 256 + h * 64 + lane]); asm volatile("s_waitcnt lgkmcnt(0)" ::: "memory");
          const float* mk = P.cache_mem_kv + ((size_t)1 * DEC_BATCH + ns) * MEM_TOKENS * 512;
          for (int j0 = 0; j0 < MEM_TOKENS; j0 += 64) dec_chunk(D, qs, 64, [&](int j) { return mk + (size_t)(j0 + j) * 512 + h * 64; }, [&](int j) { return mk + (size_t)(j0 + j) * 512 + 256 + h * 64; }, lane);
          P.ATTB[(size_t)row * 1024 + NSA_Q_COLS + h * 64 + lane] = (bf16)f2bf(D.o / D.l); } }
    __syncthreads();
}
}
namespace fx {
enum { PH_PRO = 0, PH_WPK, PH_G1, PH_ATTA, PH_G2, PH_LN1, PH_SC0, PH_TK0, PH_PG0, PH_G3, PH_CMPG, PH_CMP2, PH_NSA, PH_NSB, PH_G4, PH_LN3, PH_SC1, PH_TK1, PH_PG1, PH_COUNT };
template <class Epi> DI void run_gemm(const Ctx& C, const bf16* A, const bf16* Bt, int M, int N, int K, const Epi& E) {
    pg8::Gemm g{A, Bt, M, N, K}; pg8::StaticOrder S; S.init(M, N, C.G, (int)blockIdx.x);
    pg8::gemm_phase<Epi, pg8::StaticOrder, true, true>(C.lds, g, S, E);
}
template <class Epi> DI void skinny_gemm(const Ctx& C, const bf16* A, const bf16* Bt, int N, int K, const Epi& E) {
    static_assert(DEC_BATCH == 32 && M0 % 256 == 0, "skinny_gemm: 32 sample rows right after a whole number of 256-row tiles");
    const int lane = C.lane, fr = lane & 15, fq = lane >> 4, w = C.wave; const int NI = (N / 256) * 4, KW = K / NWAVES;
    LAS f32x4* red = (LAS f32x4*)C.lds;
#pragma unroll 1
    for (int item = C.vcu; item < NI; item += C.G) { const int pn = item >> 2, wc = item & 3;
        f32x4 pa[2][2][2];
#pragma unroll
        for (int i = 0; i < 8; ++i) (&pa[0][0][0])[i] = (f32x4){0.f, 0.f, 0.f, 0.f};
        const bf16* xa = A + (size_t)(M0 + fr) * K + w * KW + 8 * fq; const bf16* xb = xa + (size_t)16 * K;
        const bf16* wp[2][2];
#pragma unroll
        for (int bj = 0; bj < 2; ++bj)
#pragma unroll
            for (int n = 0; n < 2; ++n) wp[bj][n] = Bt + (size_t)(pn * 256 + bj * 128 + wc * 32 + 8 * (fr >> 2) + 4 * n + (fr & 3)) * K + w * KW + 8 * fq;
#pragma unroll 4
        for (int k0 = 0; k0 < KW; k0 += 32) { const bf16x8 x0 = *(const bf16x8*)(xa + k0), x1 = *(const bf16x8*)(xb + k0);
#pragma unroll
            for (int bj = 0; bj < 2; ++bj)
#pragma unroll
                for (int n = 0; n < 2; ++n) { const bf16x8 wf = *(const bf16x8*)(wp[bj][n] + k0);
                    pa[bj][0][n] = __builtin_amdgcn_mfma_f32_16x16x32_bf16(wf, x0, pa[bj][0][n], 0, 0, 0); pa[bj][1][n] = __builtin_amdgcn_mfma_f32_16x16x32_bf16(wf, x1, pa[bj][1][n], 0, 0, 0); } }
        __syncthreads();
#pragma unroll
        for (int bj = 0; bj < 2; ++bj)
#pragma unroll
            for (int mm = 0; mm < 2; ++mm)
#pragma unroll
                for (int n = 0; n < 2; ++n) red[(w * 8 + bj * 4 + mm * 2 + n) * 64 + lane] = pa[bj][mm][n];
        asm volatile("s_waitcnt lgkmcnt(0)" ::: "memory"); __syncthreads();
        if (w == 0) { f32x4 acc[2][2][4][2];
#pragma unroll
            for (int i = 0; i < 32; ++i) (&acc[0][0][0][0])[i] = (f32x4){0.f, 0.f, 0.f, 0.f};
#pragma unroll
            for (int bj = 0; bj < 2; ++bj)
#pragma unroll
                for (int mm = 0; mm < 2; ++mm)
#pragma unroll
                    for (int n = 0; n < 2; ++n) { f32x4 s = red[(bj * 4 + mm * 2 + n) * 64 + lane];
#pragma unroll 1
                        for (int ww = 1; ww < NWAVES; ++ww) s += red[(ww * 8 + bj * 4 + mm * 2 + n) * 64 + lane];
                        acc[0][bj][mm][n] = s; }
            E(acc, pg8::Unit{M0 / 256, pn}, 0, wc, fr, fq); }
    }
    __syncthreads();
}
__global__ void __launch_bounds__(NTHREADS, 2) mega(Args args) {
    extern __shared__ __attribute__((aligned(16))) unsigned char lds_raw[];
    Ctx C; C.lds = (LAS unsigned char*)lds_raw; C.tid = threadIdx.x; C.lane = C.tid & 63; C.wave = __builtin_amdgcn_readfirstlane(C.tid >> 6);
    C.G = gridDim.x; { const int bx = blockIdx.x; C.vcu = (C.G % 8 == 0) ? (bx % 8) * (C.G / 8) + bx / 8 : bx; }
    const FP& P = args.p;
    volatile LAS unsigned* MISC = (volatile LAS unsigned*)(C.lds + MISC_OFF);
    for (int u = C.tid; u < (LDS_BYTES - RING_BYTES) / 4; u += NTHREADS) ((LAS unsigned*)(C.lds + RING_BYTES))[u] = 0u;
    __syncthreads();
    const int lo = args.lo, hi = args.hi;
    XcdBarrier bar; bar.bar = P.ctl + 1024; bar.x = 0; bar.st = nullptr;
    if (hi - lo > 1) bar = xcd_barrier_post(P.ctl + 1024, MISC + 8);
#define IN(k) (lo <= (k) && (k) < hi)
#define SEAM(k) do { if (IN(k) && IN((k) + 1)) xcd_barrier(bar); } while (0)
#ifndef DUP_PHASE
#define DUP_PHASE -1
#endif
#define PHASE(k, ...) do { if (IN(k)) { __VA_ARGS__ if (DUP_PHASE == (k)) { __syncthreads(); __VA_ARGS__ } } SEAM(k); } while (0)
    PHASE(PH_PRO, p0_prologue(P, C););
    PHASE(PH_WPK, p0_wpk(P, C););
    PHASE(PH_G1, run_gemm(C, P.XB0, P.WA_T, M0, ACOLS, D_MODEL, EpiA{P}); run_gemm(C, P.MEMB, P.WMEM_T, BATCH * MEM_TOKENS, 1024, D_MODEL, EpiMem{P}); skinny_gemm(C, P.XB0, P.WA_T, ACOLS, D_MODEL, EpiA{P}););
    PHASE(PH_ATTA, atta_phase(P, C););
    PHASE(PH_G2, run_gemm(C, P.ATTA, P.WOA_T, M0, D_MODEL, 512, EpiPre{P.x_prompt, P.x_sample, P.PRE}); skinny_gemm(C, P.ATTA, P.WOA_T, D_MODEL, 512, EpiPre{P.x_prompt, P.x_sample, P.PRE}););
    PHASE(PH_LN1, ln_phase(P, C, P.PRE, P.ln_g, P.ln_b, P.X1, P.X1B, nullptr, nullptr););
    PHASE(PH_SC0, run_gemm(C, P.X1B, P.WPK_T, M0, NPK, D_MODEL, EpiF32{P.SCO, NPK, MP}); skinny_gemm(C, P.X1B, P.WPK_T, NPK, D_MODEL, EpiF32{P.SCO, NPK, MP}););
    PHASE(PH_TK0, topk_phase(P, C););
    PHASE(PH_PG0, peer_phase(P, C, 0, P.X1, P.X2, P.X2 + (size_t)M0 * D_MODEL, P.X2B););
    PHASE(PH_G3, run_gemm(C, P.X2B, P.WB_T, M0, NB_T, D_MODEL, EpiB{P}); skinny_gemm(C, P.X2B, P.WB_T, NB_T, D_MODEL, EpiB{P}););
    PHASE(PH_CMPG, run_gemm(C, P.AC, P.CW1_T, ACROWS, 256, 1024, EpiF32{P.UL, 256, ACROWS}); run_gemm(C, P.AC + (size_t)ACROWS * 1024, P.CW1_T + 256 * 1024, ACROWS, 256, 1024, EpiF32{P.UL + (size_t)ACROWS * 256, 256, ACROWS}););
    PHASE(PH_CMP2, cmp2_phase(P, C););
    PHASE(PH_NSA, nsa_phase_a(P, C););
    PHASE(PH_NSB, nsa_phase_b(P, C););
    PHASE(PH_G4, run_gemm(C, P.ATTB, P.WOB_T, M0, D_MODEL, 1024, EpiPre{P.X2, nullptr, P.PRE}); skinny_gemm(C, P.ATTB, P.WOB_T, D_MODEL, 1024, EpiPre{P.X2, nullptr, P.PRE}););
    PHASE(PH_LN3, ln_phase(P, C, P.PRE, P.ln_g + 2 * D_MODEL, P.ln_b + 2 * D_MODEL, P.X3, P.X3B, nullptr, nullptr););
    PHASE(PH_SC1, run_gemm(C, P.X3B, P.WPK_T + (size_t)NPK * D_MODEL, M0, NPK, D_MODEL, EpiF32{P.SCO, NPK, MP}); skinny_gemm(C, P.X3B, P.WPK_T + (size_t)NPK * D_MODEL, NPK, D_MODEL, EpiF32{P.SCO, NPK, MP}););
    PHASE(PH_TK1, topk_phase(P, C););
    PHASE(PH_PG1, peer_phase(P, C, 1, P.X3, P.y_prompt, P.y_sample, nullptr););
#undef IN
#undef SEAM
}
}
#ifndef ONE_LAUNCH
#define ONE_LAUNCH 1
#endif
extern "C" void kernel_launch(void* const* d_in, const int* in_sizes, int n_in, void* d_out, int out_size, void* d_ws, size_t ws_size, hipStream_t stream) {
    fx::Args a; memset(&a, 0, sizeof(a)); fx::bind_io(a.p, d_in, (float*)d_out);
    const size_t f_need = fx::carve(a.p, d_ws);
    if (f_need > ws_size) { fprintf(stderr, "kernel_launch: workspace too small: need %zu have %zu\n", f_need, ws_size); return; }
    static int grid = 0;
    if (!grid) { int dev = 0, cus = 0, per_cu = 0; (void)hipGetDevice(&dev); (void)hipDeviceGetAttribute(&cus, hipDeviceAttributeMultiprocessorCount, dev);
        (void)hipFuncSetAttribute((const void*)fx::mega, hipFuncAttributeMaxDynamicSharedMemorySize, fx::LDS_BYTES);
        if (hipOccupancyMaxActiveBlocksPerMultiprocessor(&per_cu, (const void*)fx::mega, fx::NTHREADS, fx::LDS_BYTES) != hipSuccess || per_cu < 1) { fprintf(stderr, "kernel_launch: occupancy query says %d blocks per CU\n", per_cu); (void)hipGetLastError(); }
        grid = cus; }
    (void)hipMemsetAsync(a.p.ctl, 0, fx::CTL_BYTES, stream);
#if ONE_LAUNCH
    a.lo = 0; a.hi = fx::PH_COUNT; hipLaunchKernelGGL(fx::mega, dim3(grid), dim3(fx::NTHREADS), fx::LDS_BYTES, stream, a);
#else
    for (int k = 0; k < fx::PH_COUNT; ++k) { a.lo = k; a.hi = k + 1; hipLaunchKernelGGL(fx::mega, dim3(grid), dim3(fx::NTHREADS), fx::LDS_BYTES, stream, a); }
#endif
}
```

```cpp
#define ONE_LAUNCH 1
#include <hip/hip_runtime.h>
#include <cstdio>
#include <cstring>
#include <cmath>
#ifdef CPU_TEST
#define HD inline
constexpr int D_MODEL = 128, BATCH = 2, SEQ = 512, DEPTH = 2, DEC_BATCH = 3, DEC_SEQ = 1, PAST_LEN = 512, PAGE_SIZE = 128;
constexpr int DIL_W[3] = {16, 64, 256}, DIL_D[3] = {1, 4, 16}, DIL_TAPS = 17;
constexpr int MEM_TOKENS = 32, SLC_TOPK = 4, SWA_WINDOW = 64, PEER_KEYS = 16, PEER_TOPK = 4;
#else
#define HD __host__ __device__ __forceinline__
constexpr int D_MODEL = 1024, BATCH = 2, SEQ = 8192, DEPTH = 2, DEC_BATCH = 32, DEC_SEQ = 1, PAST_LEN = 8192, PAGE_SIZE = 128;
constexpr int DIL_W[3] = {128, 512, 2048}, DIL_D[3] = {1, 4, 16}, DIL_TAPS = 129;
constexpr int MEM_TOKENS = 256, SLC_TOPK = 16, SWA_WINDOW = 512, PEER_KEYS = 128, PEER_TOPK = 16;
#endif
HD constexpr int dil_w(int g) { return g == 0 ? DIL_W[0] : (g == 1 ? DIL_W[1] : DIL_W[2]); }
HD constexpr int dil_d(int g) { return g == 0 ? DIL_D[0] : (g == 1 ? DIL_D[1] : DIL_D[2]); }
constexpr int HEAD_DIM = 64, N_A_LAYERS = DEPTH / 2, N_DIL = 3, DIL_HEADS = 4, DIL_COLS = N_DIL * 3 * DIL_HEADS * HEAD_DIM;
constexpr int MEM_HEADS = 4, MEM_COLS = MEM_HEADS * HEAD_DIM;
constexpr int NSA_HEADS = 12, NSA_KV_HEADS = 2, NSA_GROUP = 6, NSA_Q_COLS = NSA_HEADS * HEAD_DIM, NSA_GATE_COLS = NSA_HEADS * 3;
constexpr int CMP_BLOCK = 32, CMP_STRIDE = 16, CMP_HIDDEN = 128, SLC_BLOCK = 64;
constexpr int PEER_EXPERTS = PEER_KEYS * PEER_KEYS, PEER_HEADS = 8, PEER_KEY_DIM = 128;
constexpr float FORCE_SCORE = 1.0e9f, NEG = -1.0e30f, SCALE = 0.125f, LN_EPS = 1e-5f;
constexpr float ALPHA = 1.41421356237309515f;
constexpr float BETA = 0.5f;
#define LAS __attribute__((address_space(3)))
namespace pg8 {
#define PG8_LAS __attribute__((address_space(3)))
typedef unsigned short bf16_t;
typedef short bf16x8 __attribute__((ext_vector_type(8)));
typedef float f32x4 __attribute__((ext_vector_type(4)));
typedef unsigned u32x4 __attribute__((ext_vector_type(4)));
constexpr int BM = 256, BK = 64, HALF = 128, HTB = HALF * BK * 2  , STAGE_BYTES = 8 * HTB, NXCD = 8, WGM = 8;

__host__ __device__ __forceinline__ int lds_byte(int r, int c) { const int st = (r >> 4) * 2 + (c >> 5), rr = r & 15, cc = c & 31, ob = rr * 64 + cc * 2; return st * 1024 + (ob ^ (((ob >> 9) & 1) << 5)); }
__host__ __device__ __forceinline__ void stage_rc(int b, int& R, int& C) { const int st = b / 1024, sb = b % 1024, swz = sb ^ (((sb >> 9) & 1) << 5); R = (st >> 1) * 16 + swz / 64; C = (st & 1) * 32 + (swz % 64) / 2; }
__host__ __device__ __forceinline__ int perm32(int rho) { const int n = rho >> 4, i = rho & 15; return 8 * (i >> 2) + 4 * n + (i & 3); }

struct Unit { int pm, pn; };
struct Gemm { const bf16_t* A; const bf16_t* Bt; int M, N, K; };

struct StaticOrder {
    int nM, nN, nwg, G, c;
    __host__ __device__ void init(int M, int N, int G_, int c_) { nM = M / BM; nN = N / BM; nwg = nM * nN; G = G_; c = c_; }
    __host__ __device__ bool next(int i, Unit& u) const {
        const long L = (long)i * G + c; if (L >= nwg) return false;
        int wgid = (int)L; { const int q = nwg / NXCD, r = nwg % NXCD, xcd = wgid % NXCD, off = wgid / NXCD; wgid = (xcd < r ? xcd * (q + 1) : r * (q + 1) + (xcd - r) * q) + off; }
        const int nig = WGM * nN, gid = wgid / nig, fm = gid * WGM, gsz = (nM - fm) < WGM ? (nM - fm) : WGM;
        u.pm = fm + ((wgid % nig) % gsz); u.pn = (wgid % nig) / gsz; return true;
    }
    __device__ __forceinline__ void a_ready(const Unit&) const {}
    __device__ __forceinline__ void done(const Unit&) const {}
};

__device__ __forceinline__ unsigned cvt_pk_bf16(float lo, float hi) { unsigned r; asm volatile("v_cvt_pk_bf16_f32 %0, %1, %2" : "=v"(r) : "v"(lo), "v"(hi)); return r; }
typedef float f32x2 __attribute__((ext_vector_type(2)));
typedef float f32x2 __attribute__((ext_vector_type(2)));
template <class Epi, class Sched, bool ALIGN_EPI = false, bool SP2 = false>
__device__ __forceinline__ void gemm_phase(PG8_LAS unsigned char* lds, const Gemm g, const Sched& S, const Epi& E) {
    const int tid = threadIdx.x, wid = __builtin_amdgcn_readfirstlane(tid >> 6), lane = tid & 63, wr = wid >> 2, wc = wid & 3, fr = lane & 15, fq = lane >> 4;
    const int K = g.K, nt = K / BK;
    unsigned voffA[2], voffB[2];
#pragma unroll
    for (int i = 0; i < 2; ++i) { int R, C; stage_rc(tid * 16 + i * 8192, R, C); const int Rb = Epi::PERM ? ((R & ~31) + perm32(R & 31)) : R;
        voffA[i] = (unsigned)(R * K + C) * 2u; voffB[i] = (unsigned)(Rb * K + C) * 2u; }
    const size_t kstep = (size_t)(BK * 2);
    const size_t hstep = (size_t)HALF * K * 2;
    const size_t tstep = 2 * hstep;
    const unsigned ldsw = (unsigned)wid * 1024u;
    const int aoff = lds_byte(wr * 64 + fr, fq * 8), boff = lds_byte(wc * 32 + fr, fq * 8);
#define PG8_SA(b, h) (((b) * 2 + (h)) * HTB)
#define PG8_SB(b, h) ((4 + (b) * 2 + (h)) * HTB)
#define PG8_STAGE(bufoff, gbase, voff) do { _Pragma("unroll") for (int _i = 0; _i < 2; ++_i) \
        __builtin_amdgcn_global_load_lds((const unsigned*)((const char*)(gbase) + (voff)[_i]), (PG8_LAS unsigned*)(lds + (bufoff) + ldsw + _i * 8192), 16, 0, 0); } while (0)
#define PG8_LDA(dst, b, h) do { _Pragma("unroll") for (int m = 0; m < 4; ++m) _Pragma("unroll") for (int k = 0; k < 2; ++k) dst[m][k] = *(const PG8_LAS bf16x8*)(lds + PG8_SA(b, h) + aoff + m * 2048 + k * 1024); } while (0)
#define PG8_LDB(dst, b, h) do { _Pragma("unroll") for (int n = 0; n < 2; ++n) _Pragma("unroll") for (int k = 0; k < 2; ++k) dst[n][k] = *(const PG8_LAS bf16x8*)(lds + PG8_SB(b, h) + boff + n * 2048 + k * 1024); } while (0)
#define PG8_MMA(ai, bj, At, Bt) do { __builtin_amdgcn_s_setprio(1); _Pragma("unroll") for (int m = 0; m < 4; ++m) _Pragma("unroll") for (int n = 0; n < 2; ++n) _Pragma("unroll") for (int k = 0; k < 2; ++k) \
        acc[ai][bj][m][n] = __builtin_amdgcn_mfma_f32_16x16x32_bf16(Bt[n][k], At[m][k], acc[ai][bj][m][n], 0, 0, 0); __builtin_amdgcn_s_setprio(0); } while (0)
#define PG8_WAIT_V(n) asm volatile("s_waitcnt vmcnt(" #n ")" ::: "memory")
#define PG8_WAIT_L(n) asm volatile("s_waitcnt lgkmcnt(" #n ")" ::: "memory")
#define PG8_BAR __builtin_amdgcn_s_barrier()
#define PG8_SCHED __builtin_amdgcn_sched_barrier(0)
    Unit cur, nxt; int ui = 0;
    if (!S.next(0, cur)) return;
    f32x4 acc[2][2][4][2];
#pragma unroll
    for (int a = 0; a < 2; ++a)
#pragma unroll
        for (int b = 0; b < 2; ++b)
#pragma unroll
            for (int m = 0; m < 4; ++m)
#pragma unroll
                for (int n = 0; n < 2; ++n) acc[a][b][m][n] = (f32x4){0.f, 0.f, 0.f, 0.f};
    bf16x8 At[4][2], B0[2][2], B1[2][2];
    const char* cA = (const char*)g.A + (size_t)cur.pm * tstep; const char* cB = (const char*)g.Bt + (size_t)cur.pn * tstep;
    S.a_ready(cur);
    if constexpr (SP2) {
        PG8_STAGE(PG8_SB(0, 0), cB, voffB); PG8_STAGE(PG8_SB(0, 1), cB + hstep, voffB); PG8_STAGE(PG8_SA(0, 0), cA, voffA); PG8_STAGE(PG8_SA(0, 1), cA + hstep, voffA);
        if (wr == 1) PG8_BAR;
        PG8_WAIT_V(2); PG8_BAR;
        PG8_STAGE(PG8_SB(1, 0), cB + kstep, voffB); PG8_STAGE(PG8_SA(1, 0), cA + kstep, voffA); PG8_STAGE(PG8_SB(1, 1), cB + hstep + kstep, voffB);
        PG8_WAIT_V(6); PG8_BAR;
    } else {
        PG8_STAGE(PG8_SB(0, 0), cB, voffB); PG8_STAGE(PG8_SA(0, 0), cA, voffA); PG8_STAGE(PG8_SB(0, 1), cB + hstep, voffB); PG8_STAGE(PG8_SA(0, 1), cA + hstep, voffA);
        if (wr == 1) PG8_BAR;
        PG8_WAIT_V(4); PG8_BAR;
        PG8_STAGE(PG8_SB(1, 0), cB + kstep, voffB); PG8_STAGE(PG8_SA(1, 0), cA + kstep, voffA); PG8_STAGE(PG8_SB(1, 1), cB + hstep + kstep, voffB);
        PG8_WAIT_V(6); PG8_BAR;
    }
    for (;;) {
        const bool has_next = S.next(ui + 1, nxt);
        const char* nA = has_next ? (const char*)g.A + (size_t)nxt.pm * tstep : cA; const char* nB = has_next ? (const char*)g.Bt + (size_t)nxt.pn * tstep : cB;
        for (int t = 0; t < nt; t += 2) {
            const bool last = (t == nt - 2);
            const char* a1 = cA + (size_t)(t + 1) * kstep;
            const char* a2 = last ? nA : cA + (size_t)(t + 2) * kstep; const char* b2 = last ? nB : cB + (size_t)(t + 2) * kstep;
            const char* a3 = a2 + kstep; const char* b3 = b2 + kstep;
            if (last && has_next) S.a_ready(nxt);
            if constexpr (SP2) {
            PG8_LDB(B0, 0, 0); PG8_LDB(B1, 0, 1); PG8_SCHED; PG8_LDA(At, 0, 0); PG8_STAGE(PG8_SA(1, 1), a1 + hstep, voffA);
            PG8_WAIT_V(8); PG8_WAIT_L(0); PG8_BAR; PG8_MMA(0, 0, At, B0); PG8_MMA(0, 1, At, B1); PG8_BAR; PG8_SCHED;
            PG8_LDA(At, 0, 1); PG8_STAGE(PG8_SB(0, 0), b2, voffB); PG8_STAGE(PG8_SB(0, 1), b2 + hstep, voffB); PG8_STAGE(PG8_SA(0, 0), a2, voffA);
            PG8_WAIT_V(8); PG8_WAIT_L(0); PG8_BAR; PG8_MMA(1, 0, At, B0); PG8_MMA(1, 1, At, B1); PG8_BAR; PG8_SCHED;
            PG8_LDB(B0, 1, 0); PG8_LDB(B1, 1, 1); PG8_SCHED; PG8_LDA(At, 1, 0); PG8_STAGE(PG8_SA(0, 1), a2 + hstep, voffA);
            PG8_WAIT_V(8); PG8_WAIT_L(0); PG8_BAR; PG8_MMA(0, 0, At, B0); PG8_MMA(0, 1, At, B1); PG8_BAR; PG8_SCHED;
            PG8_LDA(At, 1, 1); PG8_STAGE(PG8_SB(1, 0), b3, voffB); PG8_STAGE(PG8_SB(1, 1), b3 + hstep, voffB); PG8_STAGE(PG8_SA(1, 0), a3, voffA);
            PG8_WAIT_V(8); PG8_WAIT_L(0); PG8_BAR; PG8_MMA(1, 0, At, B0); PG8_MMA(1, 1, At, B1); PG8_BAR; PG8_SCHED;
            } else {
            PG8_LDB(B0, 0, 0); PG8_SCHED; PG8_LDA(At, 0, 0); PG8_STAGE(PG8_SA(1, 1), a1 + hstep, voffA);
            PG8_WAIT_L(8); PG8_BAR; PG8_WAIT_L(0); PG8_MMA(0, 0, At, B0); PG8_BAR; PG8_SCHED;
            PG8_LDB(B1, 0, 1); PG8_STAGE(PG8_SB(0, 0), b2, voffB);
            PG8_BAR; PG8_WAIT_L(0); PG8_MMA(0, 1, At, B1); PG8_BAR;
            PG8_LDA(At, 0, 1); PG8_STAGE(PG8_SA(0, 0), a2, voffA);
            PG8_BAR; PG8_WAIT_L(0); PG8_MMA(1, 0, At, B0); PG8_BAR; PG8_SCHED;
            PG8_STAGE(PG8_SB(0, 1), b2 + hstep, voffB);
            PG8_WAIT_V(6); PG8_BAR; PG8_MMA(1, 1, At, B1); PG8_BAR;
            PG8_LDB(B0, 1, 0); PG8_SCHED; PG8_LDA(At, 1, 0); PG8_STAGE(PG8_SA(0, 1), a2 + hstep, voffA);
            PG8_WAIT_L(8); PG8_BAR; PG8_WAIT_L(0); PG8_MMA(0, 0, At, B0); PG8_BAR; PG8_SCHED;
            PG8_LDB(B1, 1, 1); PG8_STAGE(PG8_SB(1, 0), b3, voffB);
            PG8_BAR; PG8_WAIT_L(0); PG8_MMA(0, 1, At, B1); PG8_BAR;
            PG8_LDA(At, 1, 1); PG8_STAGE(PG8_SA(1, 0), a3, voffA);
            PG8_BAR; PG8_WAIT_L(0); PG8_MMA(1, 0, At, B0); PG8_BAR; PG8_SCHED;
            PG8_STAGE(PG8_SB(1, 1), b3 + hstep, voffB);
            PG8_WAIT_V(6); PG8_BAR; PG8_MMA(1, 1, At, B1); PG8_BAR;
            }
        }
        if constexpr (ALIGN_EPI) { if (wr == 0) PG8_BAR; }
        if constexpr (!Epi::AFTER_DRAIN) { E(acc, cur, wr, wc, fr, fq); S.done(cur); }
        if (!has_next) break;
#pragma unroll
        for (int a = 0; a < 2; ++a)
#pragma unroll
            for (int b = 0; b < 2; ++b)
#pragma unroll
                for (int m = 0; m < 4; ++m)
#pragma unroll
                    for (int n = 0; n < 2; ++n) acc[a][b][m][n] = (f32x4){0.f, 0.f, 0.f, 0.f};
        cur = nxt; cA = nA; cB = nB; ++ui;
        if constexpr (ALIGN_EPI) { if (wr == 1) PG8_BAR; }
    }
    PG8_WAIT_V(0);
    if constexpr (!ALIGN_EPI) { if (wr == 0) PG8_BAR; }
    PG8_BAR;
    if constexpr (Epi::AFTER_DRAIN) { E.fused(acc, cur, wr, wc, fr, fq, lds, wid, lane); S.done(cur); }
#undef PG8_SA
#undef PG8_SB
#undef PG8_STAGE
#undef PG8_LDA
#undef PG8_LDB
#undef PG8_MMA
#undef PG8_WAIT_V
#undef PG8_WAIT_L
#undef PG8_BAR
#undef PG8_SCHED
}
}
#define XB_TMO      128
#define XB_XCNT(j)  (256  + 64 * (j))
#define XB_XSUB(j)  (1280 + 64 * (j))
#define XB_XGEN(j)  (2304 + 64 * (j))
#define XB_TOP      3328
#define XB_TOPGEN   3392
#define XCD_BAR_WORDS 3456
#define XB_SPIN_CAP (1u << 18)

__device__ __forceinline__ unsigned xb_ld(unsigned* p)              { return __hip_atomic_load(p, __ATOMIC_RELAXED, __HIP_MEMORY_SCOPE_AGENT); }
__device__ __forceinline__ unsigned xb_add(unsigned* p, unsigned v) { return __hip_atomic_fetch_add(p, v, __ATOMIC_RELAXED, __HIP_MEMORY_SCOPE_AGENT); }
__device__ __forceinline__ unsigned xb_xcc_id() { return (unsigned)__builtin_amdgcn_s_getreg((3 << 11) | 20) & 0xFu; }
#define XB_SPIN(cond, bar) do { unsigned _sp = 0; while (cond) { __builtin_amdgcn_s_sleep(1); \
    if ((++_sp & 255u) == 0u) { if (xb_ld(&(bar)[XB_TMO])) break; if (_sp > XB_SPIN_CAP) { atomicAdd(&(bar)[XB_TMO], 1u); break; } } } } while (0)

struct XcdBarrier {
    unsigned* bar; unsigned x;
    volatile LAS unsigned* st;
};

__device__ __forceinline__ XcdBarrier xcd_barrier_post(unsigned* bar, volatile LAS unsigned* st) {
    XcdBarrier b; b.bar = bar; b.x = xb_xcc_id(); b.st = st;
    if (threadIdx.x == 0) (void)xb_add(&bar[XB_XCNT(b.x)], 1u);
    return b;
}
__device__ __forceinline__ void xcd_barrier_complete(unsigned* bar, unsigned x, unsigned& nloc, unsigned& nx) {
    const unsigned G = gridDim.x * gridDim.y * gridDim.z;
    unsigned sum, cnt, mine, sp = 0u;
    for (;;) {
        sum = 0u; cnt = 0u; mine = 0u;
#pragma unroll
        for (unsigned j = 0; j < 16; ++j) { const unsigned c = xb_ld(&bar[XB_XCNT(j)]); sum += c; cnt += (c > 0u) ? 1u : 0u; mine = (j == x) ? c : mine; }
        if (sum == G) break;
        __builtin_amdgcn_s_sleep(1);
        if ((++sp & 255u) == 0u) { if (xb_ld(&bar[XB_TMO])) break; if (sp > XB_SPIN_CAP) { atomicAdd(&bar[XB_TMO], 1u); break; } }
    }
    nloc = mine > 0u ? mine : 1u; nx = cnt > 0u ? cnt : 1u;
}

__device__ __forceinline__ void xcd_barrier(const XcdBarrier& b) {
    asm volatile("s_waitcnt vmcnt(0)" ::: "memory");
    __syncthreads();
    if (threadIdx.x == 0) {
        unsigned* bar = b.bar;
        __builtin_amdgcn_s_waitcnt(0);
        unsigned nloc = b.st[0], nx = b.st[1];
        if (nloc == 0u) { xcd_barrier_complete(bar, b.x, nloc, nx); b.st[0] = nloc; b.st[1] = nx; }
        const unsigned old = xb_add(&bar[XB_XSUB(b.x)], 1u);
        const unsigned gen = old / nloc;
        if (old + 1u == (gen + 1u) * nloc) {
            __builtin_amdgcn_fence(__ATOMIC_RELEASE, "agent");
            asm volatile("s_waitcnt vmcnt(0)" ::: "memory");
            const unsigned og = xb_add(&bar[XB_TOP], 1u);
            const unsigned tg = og / nx;
            if (og + 1u == (tg + 1u) * nx) xb_add(&bar[XB_TOPGEN], 1u);
            else XB_SPIN(xb_ld(&bar[XB_TOPGEN]) == tg, bar);
            __builtin_amdgcn_fence(__ATOMIC_ACQUIRE, "agent");
            xb_add(&bar[XB_XGEN(b.x)], 1u);
            asm volatile("s_waitcnt vmcnt(0)" ::: "memory");
        } else {
            XB_SPIN(xb_ld(&bar[XB_XGEN(b.x)]) == gen, bar);
            __builtin_amdgcn_fence(__ATOMIC_ACQUIRE, "agent");
            asm volatile("s_waitcnt vmcnt(0)" ::: "memory");
        }
    }
    __syncthreads();
}
namespace fx {
#define DI __device__ __forceinline__
typedef unsigned short bf16;
typedef short bf16x8 __attribute__((ext_vector_type(8)));
typedef float f32x4 __attribute__((ext_vector_type(4)));
typedef float f32x2 __attribute__((ext_vector_type(2)));
typedef unsigned u32x4 __attribute__((ext_vector_type(4)));
typedef unsigned u32x2 __attribute__((ext_vector_type(2)));
constexpr int M0 = BATCH * SEQ, MP = M0 + DEC_BATCH, MPAD = ((MP + 255) / 256) * 256;
constexpr int ACOLS = DIL_COLS + MEM_COLS, BCOLS = NSA_Q_COLS + NSA_GATE_COLS + MEM_COLS, KVCOLS = 6 * NSA_KV_HEADS * HEAD_DIM;
constexpr int NB_T = 2048;
constexpr int NPK = PEER_HEADS * 2 * PEER_KEYS;
constexpr int NCMP = (SEQ - CMP_BLOCK) / CMP_STRIDE + 1;
constexpr int NCH = SEQ / CMP_STRIDE;
constexpr int NCTX = BATCH + DEC_BATCH;
constexpr int ACROWS = NCTX * NSA_KV_HEADS * NCH;
constexpr int NPOS = PAST_LEN + 1;
constexpr float QSCALE = 0.125f * 1.4426950408889634f;
constexpr int NTHREADS = 512, NWAVES = 8, LDS_BYTES = 147456, RING_BYTES = 131072, MISC_OFF = RING_BYTES + 320;

struct FP {
    const float *x_prompt, *x_sample, *mem_prompt, *cache_dil[3], *cache_nsa_kv, *cache_nsa_win, *cache_mem_kv; const int* page_table;
    const float *w_in_a, *w_out_a, *w_in_b, *w_out_b, *w_mem_kv, *w_kv_b, *cmp_pe, *cmp_w1, *cmp_w2, *ln_g, *ln_b, *peer_wq, *peer_keys, *peer_u, *peer_v;
    float *y_prompt, *y_sample, *dil_p[3], *dil_s[3], *nsa_kv_p, *nsa_kv_s, *win_p, *win_s, *mem_kv_p;
    unsigned* ctl;
    bf16 *XB0, *X1B, *X2B, *X3B, *WA_T, *WMEM_T, *MEMB, *WOA_T, *WOB_T, *WPK_T, *WB_T, *CW1_T, *AC; unsigned char *UB8, *VB8;
    float *ROPE, *CBIAS;
    bf16 *QA, *KA, *VTA, *MQA, *MK, *MVT, *ATTA;
    float *DPART, *DML, *PRE, *X1, *X2, *X3, *SCO, *SELG; int* SELE;
    bf16 *SLK, *SLVT, *WNK, *WNVT, *QB, *MQB, *CK, *CVT, *ATTB;
    float *GATES, *UL, *CKF, *CVF;
    int* SELB;
    float* DBG;
};
struct Args { FP p; int lo, hi; };
struct Carve { size_t off = 0; template <class T> T* take(void* base, size_t n) { T* r = (T*)((char*)base + off); off += ((n * sizeof(T) + 255) / 256) * 256; return r; } };
constexpr size_t CTL_BYTES = 65536;
inline size_t carve(FP& p, void* base) {
    Carve c;
    p.ctl = c.take<unsigned>(base, CTL_BYTES / 4);
    p.XB0 = c.take<bf16>(base, (size_t)MPAD * D_MODEL); p.X1B = c.take<bf16>(base, (size_t)MPAD * D_MODEL); p.X2B = c.take<bf16>(base, (size_t)MPAD * D_MODEL); p.X3B = c.take<bf16>(base, (size_t)MPAD * D_MODEL);
    p.WA_T = c.take<bf16>(base, (size_t)ACOLS * D_MODEL); p.WMEM_T = c.take<bf16>(base, (size_t)DEPTH * 2 * MEM_COLS * D_MODEL); p.MEMB = c.take<bf16>(base, (size_t)BATCH * MEM_TOKENS * D_MODEL);
    p.WOA_T = c.take<bf16>(base, (size_t)D_MODEL * 2 * MEM_COLS); p.WOB_T = c.take<bf16>(base, (size_t)D_MODEL * (NSA_Q_COLS + MEM_COLS));
    p.WPK_T = c.take<bf16>(base, (size_t)DEPTH * NPK * D_MODEL); p.WB_T = c.take<bf16>(base, (size_t)NB_T * D_MODEL);
    p.UB8 = c.take<unsigned char>(base, (size_t)DEPTH * PEER_EXPERTS * D_MODEL); p.VB8 = c.take<unsigned char>(base, (size_t)DEPTH * PEER_EXPERTS * D_MODEL);
    p.CW1_T = c.take<bf16>(base, (size_t)2 * 256 * 1024); p.AC = c.take<bf16>(base, (size_t)2 * ACROWS * 1024);
    p.ROPE = c.take<float>(base, (size_t)NPOS * 64); p.CBIAS = c.take<float>(base, 2 * CMP_HIDDEN);
    p.QA = c.take<bf16>(base, (size_t)3 * MPAD * 256); p.KA = c.take<bf16>(base, (size_t)3 * MPAD * 256); p.VTA = c.take<bf16>(base, (size_t)3 * BATCH * DIL_HEADS * HEAD_DIM * SEQ + 4096);
    p.MQA = c.take<bf16>(base, (size_t)MPAD * 256); p.MK = c.take<bf16>(base, (size_t)DEPTH * BATCH * MEM_TOKENS * MEM_COLS); p.MVT = c.take<bf16>(base, (size_t)DEPTH * BATCH * MEM_COLS * MEM_TOKENS);
    p.ATTA = c.take<bf16>(base, (size_t)MPAD * 2 * MEM_COLS);
    p.DPART = c.take<float>(base, (size_t)3 * MP * DIL_HEADS * HEAD_DIM); p.DML = c.take<float>(base, (size_t)3 * MP * DIL_HEADS * 2);
    p.PRE = c.take<float>(base, (size_t)MPAD * D_MODEL); p.X1 = c.take<float>(base, (size_t)MPAD * D_MODEL); p.X2 = c.take<float>(base, (size_t)MPAD * D_MODEL); p.X3 = c.take<float>(base, (size_t)MPAD * D_MODEL);
    p.SCO = c.take<float>(base, (size_t)MPAD * NPK); p.SELG = c.take<float>(base, (size_t)MP * 128); p.SELE = c.take<int>(base, (size_t)MP * 128);
    p.SLK = c.take<bf16>(base, (size_t)BATCH * NSA_KV_HEADS * SEQ * HEAD_DIM); p.SLVT = c.take<bf16>(base, (size_t)BATCH * NSA_KV_HEADS * SEQ * HEAD_DIM);
    p.WNK = c.take<bf16>(base, (size_t)BATCH * NSA_KV_HEADS * SEQ * HEAD_DIM + 4096); p.WNVT = c.take<bf16>(base, (size_t)BATCH * NSA_KV_HEADS * SEQ * HEAD_DIM + 4096);
    p.QB = c.take<bf16>(base, (size_t)MPAD * NSA_Q_COLS); p.MQB = c.take<bf16>(base, (size_t)MPAD * 256);
    p.CK = c.take<bf16>(base, (size_t)NCTX * NSA_KV_HEADS * NCH * HEAD_DIM); p.CVT = c.take<bf16>(base, (size_t)NCTX * NSA_KV_HEADS * HEAD_DIM * NCH); p.ATTB = c.take<bf16>(base, (size_t)MPAD * (NSA_Q_COLS + MEM_COLS));
    p.GATES = c.take<float>(base, (size_t)MPAD * 64); p.UL = c.take<float>(base, (size_t)2 * ACROWS * 256);
    p.CKF = c.take<float>(base, (size_t)DEC_BATCH * NSA_KV_HEADS * NCH * HEAD_DIM); p.CVF = c.take<float>(base, (size_t)DEC_BATCH * NSA_KV_HEADS * NCH * HEAD_DIM);
    p.SELB = c.take<int>(base, (size_t)MP * NSA_KV_HEADS * 16);
#ifdef NSA_DEBUG
    p.DBG = c.take<float>(base, (size_t)3 * MP * 768);
#else
    p.DBG = nullptr;
#endif
    return c.off;
}
inline void bind_io(FP& p, void* const* d_in, float* out) {
    p.x_prompt = (const float*)d_in[0]; p.x_sample = (const float*)d_in[1]; p.mem_prompt = (const float*)d_in[2]; p.cache_dil[0] = (const float*)d_in[3]; p.cache_dil[1] = (const float*)d_in[4]; p.cache_dil[2] = (const float*)d_in[5];
    p.cache_nsa_kv = (const float*)d_in[6]; p.cache_nsa_win = (const float*)d_in[7]; p.cache_mem_kv = (const float*)d_in[8]; p.page_table = (const int*)d_in[9];
    p.w_in_a = (const float*)d_in[10]; p.w_out_a = (const float*)d_in[11]; p.w_in_b = (const float*)d_in[12]; p.w_out_b = (const float*)d_in[13]; p.w_mem_kv = (const float*)d_in[14]; p.w_kv_b = (const float*)d_in[15];
    p.cmp_pe = (const float*)d_in[16]; p.cmp_w1 = (const float*)d_in[17]; p.cmp_w2 = (const float*)d_in[18]; p.ln_g = (const float*)d_in[19]; p.ln_b = (const float*)d_in[20];
    p.peer_wq = (const float*)d_in[21]; p.peer_keys = (const float*)d_in[22]; p.peer_u = (const float*)d_in[23]; p.peer_v = (const float*)d_in[24];
    size_t o = 0; auto take = [&](size_t n) { float* r = out + o; o += n; return r; };
    p.y_prompt = take((size_t)M0 * D_MODEL); p.y_sample = take((size_t)DEC_BATCH * D_MODEL);
    for (int g = 0; g < 3; ++g) p.dil_p[g] = take((size_t)BATCH * DIL_W[g] * 2 * DIL_HEADS * HEAD_DIM);
    for (int g = 0; g < 3; ++g) p.dil_s[g] = take((size_t)DEC_BATCH * DIL_W[g] * 2 * DIL_HEADS * HEAD_DIM);
    p.nsa_kv_p = take((size_t)M0 * 4 * NSA_KV_HEADS * HEAD_DIM); p.nsa_kv_s = take((size_t)DEC_BATCH * 4 * NSA_KV_HEADS * HEAD_DIM);
    p.win_p = take((size_t)BATCH * SWA_WINDOW * 2 * NSA_KV_HEADS * HEAD_DIM); p.win_s = take((size_t)DEC_BATCH * SWA_WINDOW * 2 * NSA_KV_HEADS * HEAD_DIM);
    p.mem_kv_p = take((size_t)DEPTH * BATCH * MEM_TOKENS * 2 * MEM_COLS);
}
DI unsigned f2bf(float f) { unsigned u = __builtin_bit_cast(unsigned, f); return (u + 0x7fffu + ((u >> 16) & 1u)) >> 16; }
DI unsigned pk2(float lo, float hi) { return f2bf(lo) | (f2bf(hi) << 16); }
DI float bf2f(unsigned short b) { return __builtin_bit_cast(float, (unsigned)b << 16); }
DI float bflo(unsigned w) { return __builtin_bit_cast(float, w << 16); }
DI float bfhi(unsigned w) { return __builtin_bit_cast(float, w & 0xffff0000u); }
DI float wave_sum(float v) {
#pragma unroll
    for (int o = 1; o < 64; o <<= 1) v += __shfl_xor(v, o);
    return v; }
DI float wave_max(float v) {
#pragma unroll
    for (int o = 1; o < 64; o <<= 1) v = fmaxf(v, __shfl_xor(v, o));
    return v; }
DI float gelu_tanh(float x) { const float u = 0.7978845608028654f * (x + 0.044715f * x * x * x); const float e = __builtin_amdgcn_exp2f(u * 2.885390081777927f);   const float t = 1.0f - 2.0f / (e + 1.0f); return 0.5f * x * (1.0f + t); }
DI float* sel3(float* const (&a)[3], int g) { return g == 0 ? a[0] : (g == 1 ? a[1] : a[2]); }
DI const float* sel3c(const float* const (&a)[3], int g) { return g == 0 ? a[0] : (g == 1 ? a[1] : a[2]); }
__host__ DI size_t ktile_off(int t, int d) { const int blk = t >> 5, kk = t & 31, b = (kk >> 2) & 1, i = 4 * (kk >> 3) + (kk & 3), s = d >> 5, c = (d & 31) >> 3; return ((size_t)(blk * 4 + 2 * b + s) * 64 + i + 16 * c) * 8 + (d & 7); }
__host__ DI size_t vtile_off(int dim, int t) { const int blk = t >> 5, kk = t & 31; return ((size_t)(blk * 4 + (dim >> 4)) * 64 + (dim & 15) + 16 * (kk >> 3)) * 8 + (kk & 7); }
struct Ctx { LAS unsigned char* lds; int tid, lane, wave, vcu, G; };
DI int row_pos(int r) { return r < M0 ? (r & (SEQ - 1)) : PAST_LEN; }

struct ColSrc { const float* p; int ld; };
DI int rope_il(int e) { return (e >> 1) + 32 * (e & 1); }
DI ColSrc col_wa(const FP& P, int n) {
    const int t = n >> 8, ct = n & 255, h = ct >> 6, e = ct & 63; if (t >= 9) return ColSrc{P.w_in_a + DIL_COLS + ct, ACOLS};
    const int j = t % 3, d = (j < 2) ? rope_il(e) : e; return ColSrc{P.w_in_a + t * 256 + h * 64 + d, ACOLS}; }
DI ColSrc col_wb(const FP& P, int n) {
    const int t = n >> 8, ct = n & 255, e = ct & 63;
    if (t < 3) { const int ty = 2 * t + (ct >> 7), kvh = (ct >> 6) & 1; const bool rot = (ty == 2 || ty == 4); return ColSrc{P.w_kv_b + (ty * NSA_KV_HEADS + kvh) * 64 + (rot ? rope_il(e) : e), KVCOLS}; }
    if (t < 6) { const int h = (t - 3) * 4 + (ct >> 6); return ColSrc{P.w_in_b + h * 64 + rope_il(e), BCOLS}; }
    if (t == 6) return ColSrc{P.w_in_b + NSA_Q_COLS + NSA_GATE_COLS + ct, BCOLS};
    if (ct < NSA_GATE_COLS) return ColSrc{P.w_in_b + NSA_Q_COLS + ct, BCOLS};
    return ColSrc{nullptr, 0}; }
DI ColSrc col_wmem(const FP& P, int n) { const int l = n >> 9, c = n & 511; return ColSrc{P.w_mem_kv + (size_t)l * D_MODEL * 512 + c, 512}; }
DI ColSrc col_woa(const FP& P, int n) { return ColSrc{P.w_out_a + n, D_MODEL}; }
DI ColSrc col_wob(const FP& P, int n) { return ColSrc{P.w_out_b + n, D_MODEL}; }
DI ColSrc col_cw1(const FP& P, int n) {
    const int ty = n >> 8, half = (n >> 7) & 1, hid = n & 127; return ColSrc{P.cmp_w1 + (size_t)ty * CMP_BLOCK * HEAD_DIM * CMP_HIDDEN + (size_t)half * 16 * HEAD_DIM * CMP_HIDDEN + hid, CMP_HIDDEN}; }
template <class CF> DI void transpose_item(const FP& P, CF cf, int K, bf16* WT, LAS float* scr, int item, int nblk, int lane) {
    const int kb = item / nblk, nb = item % nblk, k0 = 64 * kb, n0 = 32 * nb;
    const ColSrc cs = cf(P, n0 + (lane & 31));
#pragma unroll 8
    for (int i = 0; i < 32; ++i) { const int kk = 2 * i + (lane >> 5); scr[kk * 33 + (lane & 31)] = cs.p ? cs.p[(size_t)(k0 + kk) * cs.ld] : 0.f; }
    asm volatile("s_waitcnt lgkmcnt(0)" ::: "memory");
    const int c = lane & 7;
#pragma unroll
    for (int j = 0; j < 4; ++j) { const int n = (lane >> 3) + 8 * j; const LAS float* s = scr + (8 * c) * 33 + n;
        u32x4 o; o.x = pk2(s[0 * 33], s[1 * 33]); o.y = pk2(s[2 * 33], s[3 * 33]); o.z = pk2(s[4 * 33], s[5 * 33]); o.w = pk2(s[6 * 33], s[7 * 33]);
        *(u32x4*)(WT + (size_t)(n0 + n) * K + k0 + 8 * c) = o; }
    asm volatile("s_waitcnt lgkmcnt(0)" ::: "memory");
}
DI void cvt_row1024(const float* src, bf16* dst, int lane) {
#pragma unroll
    for (int j = 0; j < 4; ++j) { f32x4 v = src ? *(const f32x4*)(src + 256 * j + 4 * lane) : (f32x4){0.f, 0.f, 0.f, 0.f}; u32x2 o; o.x = pk2(v.x, v.y); o.y = pk2(v.z, v.w); *(u32x2*)(dst + 256 * j + 4 * lane) = o; }
}
DI void cvt_row1024_fp8(const float* src, unsigned char* dst, float sc, int lane) { u32x4 o; unsigned w[4];
#pragma unroll
    for (int j = 0; j < 4; ++j) { const f32x4 v = *(const f32x4*)(src + 16 * lane + 4 * j) * sc; int t = __builtin_amdgcn_cvt_pk_fp8_f32(v.x, v.y, 0, false); t = __builtin_amdgcn_cvt_pk_fp8_f32(v.z, v.w, t, true); w[j] = (unsigned)t; }
    o.x = w[0]; o.y = w[1]; o.z = w[2]; o.w = w[3]; *(u32x4*)(dst + 16 * lane) = o; }
DI void p0_prologue(const FP& P, const Ctx& C) {
    LAS float* scr = (LAS float*)(C.lds + C.wave * 16384);
    const int gw = C.vcu * NWAVES + C.wave, NGW = C.G * NWAVES, lane = C.lane;
    { constexpr int IA = (D_MODEL / 64) * (ACOLS / 32), IM = (D_MODEL / 64) * (1024 / 32), IOA = (512 / 64) * (D_MODEL / 32), IOB = (1024 / 64) * (D_MODEL / 32), IB = (D_MODEL / 64) * (NB_T / 32), IC = (1024 / 64) * (512 / 32);
      constexpr int NIT = IA + IM + IOA + IOB + IB + IC;
      for (int it = gw; it < NIT; it += NGW) { int r = it;
          if (r < IA) { transpose_item(P, col_wa, D_MODEL, P.WA_T, scr, r, ACOLS / 32, lane); continue; } r -= IA;
          if (r < IM) { transpose_item(P, col_wmem, D_MODEL, P.WMEM_T, scr, r, 1024 / 32, lane); continue; } r -= IM;
          if (r < IOA) { transpose_item(P, col_woa, 512, P.WOA_T, scr, r, D_MODEL / 32, lane); continue; } r -= IOA;
          if (r < IOB) { transpose_item(P, col_wob, 1024, P.WOB_T, scr, r, D_MODEL / 32, lane); continue; } r -= IOB;
          if (r < IB) { transpose_item(P, col_wb, D_MODEL, P.WB_T, scr, r, NB_T / 32, lane); continue; } r -= IB;
          transpose_item(P, col_cw1, 1024, P.CW1_T, scr, r, 512 / 32, lane); } }
    for (int r = gw; r < MPAD; r += NGW) { cvt_row1024(r < M0 ? P.x_prompt + (size_t)r * D_MODEL : (r < MP ? P.x_sample + (size_t)(r - M0) * D_MODEL : nullptr), P.XB0 + (size_t)r * D_MODEL, lane);
        if (r >= MP) { cvt_row1024(nullptr, P.X1B + (size_t)r * D_MODEL, lane); cvt_row1024(nullptr, P.X2B + (size_t)r * D_MODEL, lane); cvt_row1024(nullptr, P.X3B + (size_t)r * D_MODEL, lane);
            for (int c = lane; c < 512; c += 64) { P.ATTA[(size_t)r * 512 + c] = 0; P.ATTB[(size_t)r * 1024 + c] = 0; P.ATTB[(size_t)r * 1024 + 512 + c] = 0; } } }
    for (int r = gw; r < BATCH * MEM_TOKENS; r += NGW) cvt_row1024(P.mem_prompt + (size_t)r * D_MODEL, P.MEMB + (size_t)r * D_MODEL, lane);
#pragma unroll 1
    for (int r = 2 * gw; r < DEPTH * PEER_EXPERTS; r += 2 * NGW) { f32x4 a[16];
#pragma unroll
        for (int q = 0; q < 4; ++q) { const float* s0 = (q < 2 ? P.peer_u : P.peer_v) + (size_t)(r + (q & 1)) * D_MODEL + 16 * lane;
#pragma unroll
            for (int j = 0; j < 4; ++j) a[4 * q + j] = *(const f32x4*)(s0 + 4 * j); }
#pragma unroll
        for (int q = 0; q < 4; ++q) { const float sc = q < 2 ? 256.f : 64.f; unsigned w[4];
#pragma unroll
            for (int j = 0; j < 4; ++j) { const f32x4 v = a[4 * q + j] * sc; int t = __builtin_amdgcn_cvt_pk_fp8_f32(v.x, v.y, 0, false); t = __builtin_amdgcn_cvt_pk_fp8_f32(v.z, v.w, t, true); w[j] = (unsigned)t; }
            u32x4 o; o.x = w[0]; o.y = w[1]; o.z = w[2]; o.w = w[3]; *(u32x4*)((q < 2 ? P.UB8 : P.VB8) + (size_t)(r + (q & 1)) * D_MODEL + 16 * lane) = o; } }
    for (int i = gw * 64 + lane; i < NPOS * 32; i += NGW * 64) { const int pos = i >> 5, d = i & 31; const double inv = exp2(-(double)d * (13.287712379549449 / 32.0)); const double turns = (double)pos * inv * 0.15915494309189535;
        const float fr = (float)(turns - floor(turns)); P.ROPE[pos * 64 + d] = __builtin_amdgcn_cosf(fr); P.ROPE[pos * 64 + 32 + d] = __builtin_amdgcn_sinf(fr); }
    for (int i = gw; i < 2 * CMP_HIDDEN; i += NGW) { const int ty = i / CMP_HIDDEN, hid = i % CMP_HIDDEN; float a = 0.f;
#pragma unroll 8
        for (int k = lane; k < CMP_BLOCK * HEAD_DIM; k += 64) a += P.cmp_pe[ty * CMP_BLOCK * HEAD_DIM + k] * P.cmp_w1[((size_t)ty * CMP_BLOCK * HEAD_DIM + k) * CMP_HIDDEN + hid];
        a = wave_sum(a); if (lane == 0) P.CBIAS[i] = a; }
    for (int it = gw; it < DEC_BATCH * (PAST_LEN / PAGE_SIZE); it += NGW) { const int n = it / (PAST_LEN / PAGE_SIZE), pi = it % (PAST_LEN / PAGE_SIZE); const int pg = P.page_table[it];
        const float* src = P.cache_nsa_kv + (size_t)pg * PAGE_SIZE * 512 + 4 * lane; const int ty = lane >> 5, kvh = (lane >> 4) & 1, d = (4 * lane) & 63;
        bf16* dst = P.AC + ((size_t)ty * ACROWS + ((size_t)(BATCH + n) * NSA_KV_HEADS + kvh) * NCH + pi * (PAGE_SIZE / 16)) * 1024 + d;
#pragma unroll 1
        for (int r0 = 0; r0 < PAGE_SIZE; r0 += 8) { f32x4 v[8];
#pragma unroll
            for (int u = 0; u < 8; ++u) v[u] = *(const f32x4*)(src + (size_t)(r0 + u) * 512);
#pragma unroll
            for (int u = 0; u < 8; ++u) { const int t = r0 + u; u32x2 o; o.x = pk2(v[u].x, v[u].y); o.y = pk2(v[u].z, v[u].w); *(u32x2*)(dst + (size_t)(t / 16) * 1024 + (t % 16) * 64) = o; } } }
    for (int g = 0; g < 4; ++g) { const int W = g < 3 ? dil_w(g) : SWA_WINDOW, RV = g < 3 ? 128 : 64;
        const f32x4* src = (const f32x4*)(g < 3 ? sel3c(P.cache_dil, g) : P.cache_nsa_win); f32x4* dst = (f32x4*)(g < 3 ? sel3(P.dil_s, g) : P.win_s);
        const long per = (long)(W - 1) * RV, nvec = (long)DEC_BATCH * per;
#pragma unroll 1
        for (long i0 = (long)gw * 512; i0 < nvec; i0 += (long)NGW * 512) { f32x4 v[8]; long idx[8];
#pragma unroll
            for (int u = 0; u < 8; ++u) { const long i = i0 + u * 64 + lane; const long ii = i < nvec ? i : nvec - 1; const long n = ii / per, o = ii % per; idx[u] = n * (per + RV) + o; v[u] = src[idx[u] + RV]; }
#pragma unroll
            for (int u = 0; u < 8; ++u) { const long i = i0 + u * 64 + lane; if (i < nvec) dst[idx[u]] = v[u]; } } }
}
DI void p0_wpk(const FP& P, const Ctx& C) {
    LAS float* sw = (LAS float*)C.lds;
    LAS float* sk = (LAS float*)(C.lds + 32768);
    constexpr int NIT = DEPTH * 16 * (D_MODEL / 64);
    for (int it = C.vcu; it < NIT; it += C.G) { const int l = it / (16 * (D_MODEL / 64)), rem = it % (16 * (D_MODEL / 64)), hc = rem / (D_MODEL / 64), kb = rem % (D_MODEL / 64);
        __syncthreads();
        for (int i = C.tid; i < 64 * 64; i += NTHREADS) { const int r = i >> 6, d = i & 63; sw[r * 65 + d] = P.peer_wq[((size_t)l * D_MODEL + kb * 64 + r) * 1024 + hc * 64 + d]; }
        for (int i = C.tid; i < 128 * 64; i += NTHREADS) { const int r = i >> 6, d = i & 63; sk[r * 65 + d] = P.peer_keys[(((size_t)l * 16 + hc) * PEER_KEYS + r) * 64 + d]; }
        __syncthreads();
        for (int o = C.tid; o < 128 * 64; o += NTHREADS) { const int kk = o >> 6, ki = o & 63; float a = 0.f;
#pragma unroll 16
            for (int d = 0; d < 64; ++d) a += sw[ki * 65 + d] * sk[kk * 65 + d];
            P.WPK_T[((size_t)l * NPK + hc * 128 + kk) * D_MODEL + kb * 64 + ki] = (bf16)f2bf(a); } }
    __syncthreads();
}

#define EPI_LOOP(...) int fr_l = fr, fq_l = fq; asm volatile("" : "+v"(fr_l), "+v"(fq_l));     \
    _Pragma("unroll") for (int ai = 0; ai < 2; ++ai) _Pragma("unroll") for (int m = 0; m < 4; ++m) { const int row = u.pm * 256 + ai * 128 + wr * 64 + m * 16 + fr_l; \
    _Pragma("unroll") for (int bj = 0; bj < 2; ++bj) { const int ct = bj * 128 + wc * 32 + fq_l * 8; const f32x4 v0 = acc[ai][bj][m][0], v1 = acc[ai][bj][m][1]; __VA_ARGS__ } asm volatile("" ::: "memory"); }
DI void rope4(const float* rope_row, int dp, const f32x4& v0, const f32x4& v1, f32x4& lo, f32x4& hi) {
    const f32x4 c = *(const f32x4*)(rope_row + dp), s = *(const f32x4*)(rope_row + 32 + dp);
    lo.x = v0.x * c.x - v0.y * s.x; hi.x = v0.y * c.x + v0.x * s.x; lo.y = v0.z * c.y - v0.w * s.y; hi.y = v0.w * c.y + v0.z * s.y;
    lo.z = v1.x * c.z - v1.y * s.z; hi.z = v1.y * c.z + v1.x * s.z; lo.w = v1.z * c.w - v1.w * s.w; hi.w = v1.w * c.w + v1.z * s.w; }
DI u32x2 pk4(const f32x4& v) { u32x2 o; o.x = pk2(v.x, v.y); o.y = pk2(v.z, v.w); return o; }
DI u32x4 pk8(const f32x4& a, const f32x4& b) { u32x4 o; o.x = pk2(a.x, a.y); o.y = pk2(a.z, a.w); o.z = pk2(b.x, b.y); o.w = pk2(b.z, b.w); return o; }
DI int dil_perm(int t, int d) { return (t % d) * (SEQ / d) + t / d; }
struct EpiA {
    static constexpr bool PERM = true, AFTER_DRAIN = false; const FP& P;
    DI void operator()(const f32x4 (&acc)[2][2][4][2], const pg8::Unit& u, int wr, int wc, int fr, int fq) const {
        const int t9 = u.pn; const int g = t9 / 3, j = t9 % 3;
        EPI_LOOP({ if (row < MP) { const int h = ct >> 6, e = ct & 63; const int pos = row_pos(row);
            if (t9 == 9) { *(u32x4*)(P.MQA + (size_t)row * 256 + ct) = pk8(v0 * QSCALE, v1 * QSCALE); }
            else if (j < 2) { f32x4 lo, hi; const int dp = e >> 1; rope4(P.ROPE + pos * 64, dp, v0, v1, lo, hi);
                if (j == 0) { bf16* q = P.QA + ((size_t)g * MPAD + row) * 256 + h * 64 + dp; *(u32x2*)q = pk4(lo * QSCALE); *(u32x2*)(q + 32) = pk4(hi * QSCALE); }
                else { if (row < M0) { bf16* kt = P.KA + ((size_t)(g * BATCH + row / SEQ) * DIL_HEADS + h) * 64 * SEQ; const int cm = dil_perm(pos, dil_d(g)); *(u32x2*)(kt + ktile_off(cm, dp)) = pk4(lo); *(u32x2*)(kt + ktile_off(cm, dp + 32)) = pk4(hi); }
                    const int W = dil_w(g); float* o = nullptr;
                    if (row >= M0) o = sel3(P.dil_s, g) + (((size_t)(row - M0) * W + W - 1) * 2 + 0) * 256; else if (pos >= SEQ - W) o = sel3(P.dil_p, g) + (((size_t)(row / SEQ) * W + pos - (SEQ - W)) * 2 + 0) * 256;
                    if (o) { *(f32x4*)(o + h * 64 + dp) = lo; *(f32x4*)(o + h * 64 + 32 + dp) = hi; } } }
            else { const int W = dil_w(g), d = dil_d(g); float* o = nullptr;
                if (row >= M0) o = sel3(P.dil_s, g) + (((size_t)(row - M0) * W + W - 1) * 2 + 1) * 256; else if (pos >= SEQ - W) o = sel3(P.dil_p, g) + (((size_t)(row / SEQ) * W + pos - (SEQ - W)) * 2 + 1) * 256;
                if (o) { *(f32x4*)(o + ct) = v0; *(f32x4*)(o + ct + 4) = v1; }
                if (row < M0) { bf16* vt = P.VTA + ((size_t)(g * BATCH + row / SEQ) * DIL_HEADS + h) * 64 * SEQ + vtile_off(e, dil_perm(pos, d));
                    vt[0] = (bf16)f2bf(v0.x); vt[8] = (bf16)f2bf(v0.y); vt[16] = (bf16)f2bf(v0.z); vt[24] = (bf16)f2bf(v0.w); vt[32] = (bf16)f2bf(v1.x); vt[40] = (bf16)f2bf(v1.y); vt[48] = (bf16)f2bf(v1.z); vt[56] = (bf16)f2bf(v1.w); } } } })
    }
};
struct EpiMem {
    static constexpr bool PERM = true, AFTER_DRAIN = false; const FP& P;
    DI void operator()(const f32x4 (&acc)[2][2][4][2], const pg8::Unit& u, int wr, int wc, int fr, int fq) const {
        const int l = u.pn >> 1, half = u.pn & 1;
        EPI_LOOP({ const int n = row / MEM_TOKENS, mt = row % MEM_TOKENS; float* o = P.mem_kv_p + (((size_t)l * BATCH + n) * MEM_TOKENS + mt) * 512 + half * 256 + ct; *(f32x4*)o = v0; *(f32x4*)(o + 4) = v1;
            if (half == 0) *(u32x4*)(P.MK + (((size_t)l * BATCH + n) * MEM_HEADS + (ct >> 6)) * MEM_TOKENS * 64 + ktile_off(mt, ct & 63)) = pk8(v0, v1);
            else { bf16* vt = P.MVT + (((size_t)l * BATCH + n) * MEM_HEADS + (ct >> 6)) * MEM_TOKENS * 64 + vtile_off(ct & 63, mt);
                vt[0] = (bf16)f2bf(v0.x); vt[8] = (bf16)f2bf(v0.y); vt[16] = (bf16)f2bf(v0.z); vt[24] = (bf16)f2bf(v0.w); vt[32] = (bf16)f2bf(v1.x); vt[40] = (bf16)f2bf(v1.y); vt[48] = (bf16)f2bf(v1.z); vt[56] = (bf16)f2bf(v1.w); } })
    }
};
struct EpiPre {
    static constexpr bool PERM = true, AFTER_DRAIN = false; const float* xa; const float* xb; float* pre;
    DI void operator()(const f32x4 (&acc)[2][2][4][2], const pg8::Unit& u, int wr, int wc, int fr, int fq) const {
        EPI_LOOP({ if (row < MP) { const int col = u.pn * 256 + ct; const float* x = (xb && row >= M0) ? xb + (size_t)(row - M0) * D_MODEL + col : xa + (size_t)row * D_MODEL + col;
            const f32x4 a = *(const f32x4*)x, b = *(const f32x4*)(x + 4); float* o = pre + (size_t)row * D_MODEL + col; *(f32x4*)o = a * ALPHA + v0; *(f32x4*)(o + 4) = b * ALPHA + v1; } })
    }
};
struct EpiF32 {
    static constexpr bool PERM = true, AFTER_DRAIN = false; float* out; int ldc; int nrows;
    DI void operator()(const f32x4 (&acc)[2][2][4][2], const pg8::Unit& u, int wr, int wc, int fr, int fq) const {
        EPI_LOOP({ if (row < nrows) { float* o = out + (size_t)row * ldc + u.pn * 256 + ct; *(f32x4*)o = v0; *(f32x4*)(o + 4) = v1; } })
    }
};
}
namespace fx {
struct Tile16 { f32x4 o[4]; float m, l; };
DI void tile_init(Tile16& T) { T.o[0] = T.o[1] = T.o[2] = T.o[3] = (f32x4){0.f, 0.f, 0.f, 0.f}; T.m = -INFINITY; T.l = 0.f; }
typedef __bf16 bf16x2_t __attribute__((ext_vector_type(2)));
DI unsigned cvtpk(float lo, float hi) { const f32x2 v = {lo, hi}; const bf16x2_t b = __builtin_convertvector(v, bf16x2_t); return __builtin_bit_cast(unsigned, b); }
struct KV8 { bf16x8 ka0, ka1, kb0, kb1, v0, v1, v2, v3; };
DI void kv_load(KV8& r, const bf16* k0, const bf16* k1, const bf16* v, long vs16) {
    r.ka0 = *(const bf16x8*)k0; r.ka1 = *(const bf16x8*)(k0 + 32); r.kb0 = *(const bf16x8*)k1; r.kb1 = *(const bf16x8*)(k1 + 32);
    r.v0 = *(const bf16x8*)v; r.v1 = *(const bf16x8*)(v + vs16); r.v2 = *(const bf16x8*)(v + 2 * vs16); r.v3 = *(const bf16x8*)(v + 3 * vs16); }
template <class MaskF> DI void tile_compute(Tile16& T, const bf16x8 (&qf)[2], const KV8& r, MaskF mask) {
    f32x4 s0 = (f32x4){0.f, 0.f, 0.f, 0.f}, s1 = (f32x4){0.f, 0.f, 0.f, 0.f};
    s0 = __builtin_amdgcn_mfma_f32_16x16x32_bf16(r.ka0, qf[0], s0, 0, 0, 0); s0 = __builtin_amdgcn_mfma_f32_16x16x32_bf16(r.ka1, qf[1], s0, 0, 0, 0);
    s1 = __builtin_amdgcn_mfma_f32_16x16x32_bf16(r.kb0, qf[0], s1, 0, 0, 0); s1 = __builtin_amdgcn_mfma_f32_16x16x32_bf16(r.kb1, qf[1], s1, 0, 0, 0);
    float s[8] = {s0.x, s0.y, s0.z, s0.w, s1.x, s1.y, s1.z, s1.w};
    float mx = -INFINITY;
#pragma unroll
    for (int e = 0; e < 8; ++e) { s[e] = mask(e) ? s[e] : -INFINITY; mx = fmaxf(mx, s[e]); }
    mx = fmaxf(mx, __shfl_xor(mx, 16)); mx = fmaxf(mx, __shfl_xor(mx, 32));
    const float mnew = fmaxf(T.m, mx), muse = (mnew == -INFINITY) ? 0.f : mnew;
    const float alpha = __builtin_amdgcn_exp2f(T.m - muse);
    float ls = 0.f;
#pragma unroll
    for (int e = 0; e < 8; ++e) { s[e] = __builtin_amdgcn_exp2f(s[e] - muse); ls += s[e]; }
    ls += __shfl_xor(ls, 16); ls += __shfl_xor(ls, 32);
    T.l = T.l * alpha + ls; T.m = mnew;
    u32x4 pw; pw.x = cvtpk(s[0], s[1]); pw.y = cvtpk(s[2], s[3]); pw.z = cvtpk(s[4], s[5]); pw.w = cvtpk(s[6], s[7]);
    const bf16x8 pf = __builtin_bit_cast(bf16x8, pw);
    T.o[0] = __builtin_amdgcn_mfma_f32_16x16x32_bf16(r.v0, pf, T.o[0] * alpha, 0, 0, 0); T.o[1] = __builtin_amdgcn_mfma_f32_16x16x32_bf16(r.v1, pf, T.o[1] * alpha, 0, 0, 0);
    T.o[2] = __builtin_amdgcn_mfma_f32_16x16x32_bf16(r.v2, pf, T.o[2] * alpha, 0, 0, 0); T.o[3] = __builtin_amdgcn_mfma_f32_16x16x32_bf16(r.v3, pf, T.o[3] * alpha, 0, 0, 0);
}
template <class LD, class CP> DI void pipe2(int n, LD ld, CP cp) { if (n <= 0) return; KV8 A, B; ld(A, 0);
#pragma unroll 1
    for (int i = 0; i < n; i += 2) { ld(B, (i + 1 < n) ? i + 1 : i); cp(A, i); ld(A, (i + 2 < n) ? i + 2 : i); if (i + 1 < n) cp(B, i + 1); } }
DI void kv_load_t(KV8& r, const bf16* kt, const bf16* vt, int lane) {
    const bf16* k = kt + lane * 8; const bf16* v = vt + lane * 8;
    r.ka0 = *(const bf16x8*)k; r.ka1 = *(const bf16x8*)(k + 512); r.kb0 = *(const bf16x8*)(k + 1024); r.kb1 = *(const bf16x8*)(k + 1536);
    r.v0 = *(const bf16x8*)v; r.v1 = *(const bf16x8*)(v + 512); r.v2 = *(const bf16x8*)(v + 1024); r.v3 = *(const bf16x8*)(v + 1536); }
DI int krow_of(int i, int b) { return 8 * (i >> 2) + 4 * b + (i & 3); }

DI void dil_micro(const FP& P, int n, int h, int t0, int mt, int lane) {
    const int g = mt >> 4, idx = mt & 15, d = dil_d(g), per = 16 / d;
    const int r = idx / per, sub = idx % per, i0 = t0 / d + 16 * sub, ib = i0 - 128, NC = SEQ / d;
    const int q = lane & 15, c = lane >> 4;
    const bf16* Qb = P.QA + ((size_t)g * MPAD + (size_t)n * SEQ) * 256 + h * 64;
    const bf16* Kb = P.KA + ((size_t)(g * BATCH + n) * DIL_HEADS + h) * 64 * SEQ + (size_t)r * NC * 64; const bf16* Vb = P.VTA + ((size_t)(g * BATCH + n) * DIL_HEADS + h) * 64 * SEQ + (size_t)r * NC * 64;
    bf16x8 qf[2]; { const bf16* qp = Qb + (size_t)(r + d * (i0 + q)) * 256 + 8 * c; qf[0] = *(const bf16x8*)qp; qf[1] = *(const bf16x8*)(qp + 32); }
    Tile16 T; tile_init(T);
    const int qi = i0 + q; const int tb0 = ib >> 5  , nblk = ((i0 + 15) >> 5) - tb0 + 1;
    pipe2(nblk, [&](KV8& kv, int i) { int tb = tb0 + i; tb = tb < 0 ? 0 : tb; kv_load_t(kv, Kb + (size_t)tb * 2048, Vb + (size_t)tb * 2048, lane); },
          [&](const KV8& kv, int i) { const int kb = 32 * (tb0 + i); tile_compute(T, qf, kv, [&](int e) { const int ki = kb + 8 * c + e; return ki >= 0 && ki <= qi && qi - ki <= DIL_TAPS - 1; }); });
    const int row = n * SEQ + r + d * qi;
    float* op = P.DPART + (((size_t)g * MP + row) * DIL_HEADS + h) * 64 + 4 * c;
#pragma unroll
    for (int db = 0; db < 4; ++db) *(f32x4*)(op + 16 * db) = T.o[db];
    if (c == 0) { float* ml = P.DML + (((size_t)g * MP + row) * DIL_HEADS + h) * 2; ml[0] = T.m; ml[1] = T.l; }
}
DI void mem_micro(const FP& P, const bf16* Q  , int ldq, int row0, int layer, int n, int h, bf16* O  , int ldo, int lane) {
    const int q = lane & 15, c = lane >> 4;
    bf16x8 qf[2]; { const bf16* qp = Q + (size_t)(row0 + q) * ldq + 8 * c; qf[0] = *(const bf16x8*)qp; qf[1] = *(const bf16x8*)(qp + 32); }
    const bf16* Kb = P.MK + (((size_t)layer * BATCH + n) * MEM_HEADS + h) * MEM_TOKENS * 64; const bf16* Vb = P.MVT + (((size_t)layer * BATCH + n) * MEM_HEADS + h) * MEM_TOKENS * 64;
    Tile16 T; tile_init(T);
    pipe2(MEM_TOKENS / 32, [&](KV8& kv, int i) { kv_load_t(kv, Kb + (size_t)i * 2048, Vb + (size_t)i * 2048, lane); }, [&](const KV8& kv, int) { tile_compute(T, qf, kv, [&](int) { return true; }); });
    const float inv = 1.0f / T.l; bf16* op = O + (size_t)(row0 + q) * ldo + 4 * c;
#pragma unroll
    for (int db = 0; db < 4; ++db) *(u32x2*)(op + 16 * db) = pk4(T.o[db] * inv);
}
struct Dec { float m, l, o; };
template <class KF, class VF> DI void dec_chunk(Dec& D, const LAS float* q, int nk, KF kf, VF vf, int lane) {
    float s = -INFINITY;
    if (lane < nk) { const float* k = kf(lane); float a = 0.f;
#pragma unroll
        for (int d4 = 0; d4 < 16; ++d4) { const f32x4 kv = *(const f32x4*)(k + 4 * d4); a += kv.x * q[4 * d4] + kv.y * q[4 * d4 + 1] + kv.z * q[4 * d4 + 2] + kv.w * q[4 * d4 + 3]; }
        s = a; }
    const float mx = wave_max(s), mnew = fmaxf(D.m, mx), alpha = __builtin_amdgcn_exp2f(D.m - mnew);
    const float p = (lane < nk) ? __builtin_amdgcn_exp2f(s - mnew) : 0.f;
    D.l = D.l * alpha + wave_sum(p); D.m = mnew; float o = D.o * alpha;
    for (int j0 = 0; j0 < nk; j0 += 8) { float vv[8];
#pragma unroll
        for (int u = 0; u < 8; ++u) { const int jj = (j0 + u < nk) ? j0 + u : nk - 1; vv[u] = vf(jj)[lane]; }
#pragma unroll
        for (int u = 0; u < 8; ++u) { const float pj = (j0 + u < nk) ? __builtin_bit_cast(float, __builtin_amdgcn_readlane(__builtin_bit_cast(int, p), (j0 + u) & 63)) : 0.f; o += pj * vv[u]; } }
    D.o = o;
}
DI void atta_phase(const FP& P, const Ctx& C) {
    const int lane = C.lane, w = C.wave;
    constexpr int NT = SEQ / 256, NIT = BATCH * NT * DIL_HEADS;
    for (int it = C.vcu; it < NIT; it += C.G) { const int h = it % DIL_HEADS, tt = (it / DIL_HEADS) % NT, n = it / (DIL_HEADS * NT), t0 = tt * 256;
        for (int mt = w; mt < 48; mt += NWAVES) dil_micro(P, n, h, t0, mt, lane);
        asm volatile("s_waitcnt vmcnt(0)" ::: "memory"); __syncthreads();
        for (int i = C.tid; i < 256 * 16; i += NTHREADS) { const int tk = i >> 4, d4 = (i & 15) * 4; const int row = n * SEQ + t0 + tk;
            float mg[3], lg[3]; float M = -INFINITY;
#pragma unroll
            for (int g = 0; g < 3; ++g) { const float* ml = P.DML + (((size_t)g * MP + row) * DIL_HEADS + h) * 2; mg[g] = ml[0]; lg[g] = ml[1]; M = fmaxf(M, mg[g]); }
            f32x4 acc = (f32x4){0.f, 0.f, 0.f, 0.f}; float L = 0.f;
#pragma unroll
            for (int g = 0; g < 3; ++g) { const float wg = __builtin_amdgcn_exp2f(mg[g] - M); L += wg * lg[g]; acc += *(const f32x4*)(P.DPART + (((size_t)g * MP + row) * DIL_HEADS + h) * 64 + d4) * wg; }
            *(u32x2*)(P.ATTA + (size_t)row * 512 + h * 64 + d4) = pk4(acc * (1.0f / L)); }
        for (int mt = w; mt < 16; mt += NWAVES) mem_micro(P, P.MQA + h * 64, 256, n * SEQ + t0 + 16 * mt, 0, n, h, P.ATTA + 256 + h * 64, 512, lane);
        __syncthreads();
    }
    LAS float* qs = (LAS float*)(C.lds + w * 1024);
    const int gw = C.vcu * NWAVES + w, NGW = C.G * NWAVES;
    for (int it = gw; it < DEC_BATCH * DIL_HEADS * 2; it += NGW) { const int kind = it & 1, h = (it >> 1) % DIL_HEADS, ns = (it >> 1) / DIL_HEADS, row = M0 + ns;
        Dec D; D.m = -INFINITY; D.l = 0.f; D.o = 0.f;
        if (kind == 0) {
            for (int g = 0; g < 3; ++g) qs[g * 64 + lane] = bf2f(P.QA[((size_t)g * MPAD + row) * 256 + h * 64 + lane]);
            asm volatile("s_waitcnt lgkmcnt(0)" ::: "memory");
            for (int g = 0; g < 3; ++g) { const int W = dil_w(g), d = dil_d(g); const float* cache = sel3c(P.cache_dil, g) + (size_t)ns * W * 512; const float* newrow = sel3(P.dil_s, g) + ((size_t)ns * W + W - 1) * 512;
                for (int j0 = 0; j0 < DIL_TAPS; j0 += 64) { const int nk = (DIL_TAPS - j0) < 64 ? (DIL_TAPS - j0) : 64;
                    dec_chunk(D, qs + g * 64, nk, [&](int j) { const int tap = j0 + j; return (tap == 0 ? newrow : cache + (size_t)(W - d * tap) * 512) + h * 64; },
                              [&](int j) { const int tap = j0 + j; return (tap == 0 ? newrow : cache + (size_t)(W - d * tap) * 512) + 256 + h * 64; }, lane); } }
            P.ATTA[(size_t)row * 512 + h * 64 + lane] = (bf16)f2bf(D.o / D.l);
        } else {
            qs[lane] = bf2f(P.MQA[(size_t)row * 256 + h * 64 + lane]);
            asm volatile("s_waitcnt lgkmcnt(0)" ::: "memory");
            const float* mk = P.cache_mem_kv + ((size_t)0 * DEC_BATCH + ns) * MEM_TOKENS * 512;
            for (int j0 = 0; j0 < MEM_TOKENS; j0 += 64) dec_chunk(D, qs, 64, [&](int j) { return mk + (size_t)(j0 + j) * 512 + h * 64; }, [&](int j) { return mk + (size_t)(j0 + j) * 512 + 256 + h * 64; }, lane);
            P.ATTA[(size_t)row * 512 + 256 + h * 64 + lane] = (bf16)f2bf(D.o / D.l);
        }
    }
    __syncthreads();
}
DI void ln_phase(const FP& P, const Ctx& C, const float* pre, const float* gam, const float* bet, float* xo, bf16* xb, float* yp, float* ys) {
    const int gw = C.vcu * NWAVES + C.wave, NGW = C.G * NWAVES, lane = C.lane;
    for (int r = gw; r < MP; r += NGW) { const float* x = pre + (size_t)r * D_MODEL; f32x4 v[4]; float s = 0.f;
#pragma unroll
        for (int j = 0; j < 4; ++j) { v[j] = *(const f32x4*)(x + 256 * j + 4 * lane); s += (v[j].x + v[j].y) + (v[j].z + v[j].w); }
        const float mu = wave_sum(s) * (1.0f / D_MODEL); float s2 = 0.f;
#pragma unroll
        for (int j = 0; j < 4; ++j) { v[j] = v[j] - mu; s2 += (v[j].x * v[j].x + v[j].y * v[j].y) + (v[j].z * v[j].z + v[j].w * v[j].w); }
        const float rs = 1.0f / sqrtf(wave_sum(s2) * (1.0f / D_MODEL) + LN_EPS);
#pragma unroll
        for (int j = 0; j < 4; ++j) { const f32x4 gg = *(const f32x4*)(gam + 256 * j + 4 * lane), bb = *(const f32x4*)(bet + 256 * j + 4 * lane); const f32x4 o = v[j] * rs * gg + bb;
            if (xo) *(f32x4*)(xo + (size_t)r * D_MODEL + 256 * j + 4 * lane) = o;
            if (xb) *(u32x2*)(xb + (size_t)r * D_MODEL + 256 * j + 4 * lane) = pk4(o);
            if (yp) { if (r < M0) *(f32x4*)(yp + (size_t)r * D_MODEL + 256 * j + 4 * lane) = o; else *(f32x4*)(ys + (size_t)(r - M0) * D_MODEL + 256 * j + 4 * lane) = o; } }
    }
}
}
namespace fx {
#define INS16(V, I, v_, i_) do { const float _v = (v_); const int _i = (i_); bool _c[16]; _Pragma("unroll") for (int _k = 0; _k < 16; ++_k) _c[_k] = _v > V[_k]; \
    _Pragma("unroll") for (int _k = 15; _k >= 1; --_k) { V[_k] = _c[_k] ? (_c[_k - 1] ? V[_k - 1] : _v) : V[_k]; I[_k] = _c[_k] ? (_c[_k - 1] ? I[_k - 1] : _i) : I[_k]; } \
    V[0] = _c[0] ? _v : V[0]; I[0] = _c[0] ? _i : I[0]; } while (0)
DI void wave_top16_128(float a, float b, int lane, float& outv, int& outi) {
    outv = -INFINITY; outi = 0;
#pragma unroll 1
    for (int k = 0; k < 16; ++k) { const float m = wave_max(fmaxf(a, b)); const unsigned long long ba = __ballot(a == m), bb = __ballot(b == m); int idx;
        if (ba) { const int l = __builtin_ctzll(ba); idx = l; if (lane == l) a = -INFINITY; } else { const int l = __builtin_ctzll(bb); idx = 64 + l; if (lane == l) b = -INFINITY; }
        if (lane == k) { outv = m; outi = idx; } }
}
DI void topk_wave_item(const FP& P, long it, int lane) {
    const float* s = P.SCO + it * 256; float v1, v2; int i1, i2;
    wave_top16_128(s[lane], s[64 + lane], lane, v1, i1); wave_top16_128(s[128 + lane], s[192 + lane], lane, v2, i2);
    int a = 0, rem = lane; bool valid = false;
    for (int aa = 0; aa < 16; ++aa) { const int nb = 16 / (aa + 1); if (!valid) { if (rem < nb) { a = aa; valid = true; } else rem -= nb; } }
    const int b = valid ? rem : 0;
    float cs = __shfl(v1, a) + __shfl(v2, b); const int ce = __shfl(i1, a) * PEER_KEYS + __shfl(i2, b); if (!valid) cs = -INFINITY;
    float tv = -INFINITY; int te = 0;
#pragma unroll 1
    for (int k = 0; k < 16; ++k) { const float m = wave_max(cs); const unsigned long long bm = __ballot(cs == m); const int l = __builtin_ctzll(bm); const int e = __shfl(ce, l); if (lane == l) cs = -INFINITY; if (lane == k) { tv = m; te = e; } }
    const float mx = __shfl(tv, 0); const float ex = (lane < 16) ? __expf(tv - mx) : 0.f; const float z = wave_sum(ex);
    if (lane < 16) { P.SELG[it * 16 + lane] = ex / z; P.SELE[it * 16 + lane] = te; }
}
DI void topk_phase(const FP& P, const Ctx& C) {
    const int lane = C.lane; LAS float* st = (LAS float*)(C.lds + C.wave * 16384);
    const int NWI = (M0 * PEER_HEADS) / 64;
    for (int wi = C.vcu * NWAVES + C.wave; wi < NWI; wi += C.G * NWAVES) {
        const long it0 = (long)wi * 64; const long it = it0 + lane; const bool act = true;
        float V1[16], V2[16], V3[16]; int I1[16], I2[16], I3[16];
#pragma unroll
        for (int k = 0; k < 16; ++k) { V1[k] = V2[k] = V3[k] = -INFINITY; I1[k] = I2[k] = I3[k] = 0; }
#pragma unroll 1
        for (int ch = 0; ch < 8; ++ch) {
#pragma unroll
            for (int u = 0; u < 8; ++u) { const int f4 = u * 64 + lane, j = f4 >> 3, q = f4 & 7, hf = q >> 2, c4 = (q & 3) * 4; const long itj = it0 + j;
                const f32x4 v = *(const f32x4*)(P.SCO + itj * 256 + hf * 128 + ch * 16 + c4);
                st[j * 33 + hf * 16 + c4] = v.x; st[j * 33 + hf * 16 + c4 + 1] = v.y; st[j * 33 + hf * 16 + c4 + 2] = v.z; st[j * 33 + hf * 16 + c4 + 3] = v.w; }
            asm volatile("s_waitcnt lgkmcnt(0)" ::: "memory");
#pragma unroll 1
            for (int c = 0; c < 16; ++c) { const float va = st[lane * 33 + c], vb = st[lane * 33 + 16 + c]; const int id = ch * 16 + c; INS16(V1, I1, va, id); INS16(V2, I2, vb, id); }
            asm volatile("s_waitcnt lgkmcnt(0)" ::: "memory");
        }
        { LAS float* lv = st; LAS int* li = (LAS int*)(st + 64 * 33);
#pragma unroll
          for (int k = 0; k < 16; ++k) { lv[lane * 33 + k] = V1[k]; lv[lane * 33 + 16 + k] = V2[k]; li[lane * 17 + k] = I1[k] | (I2[k] << 8); }
          asm volatile("s_waitcnt lgkmcnt(0)" ::: "memory");
          for (int a = 0; a < 16; ++a) { const float va = lv[lane * 33 + a]; const int ia = li[lane * 17 + a] & 255; const int nb = 16 / (a + 1);
              for (int b = 0; b < nb; ++b) { const float v = va + lv[lane * 33 + 16 + b]; const int ib = li[lane * 17 + b] >> 8; INS16(V3, I3, v, ia * PEER_KEYS + ib); } }
          asm volatile("s_waitcnt lgkmcnt(0)" ::: "memory"); }
        float z = 0.f; const float vmax = V3[0];
#pragma unroll
        for (int k = 0; k < 16; ++k) { V3[k] = __expf(V3[k] - vmax); z += V3[k]; }
        if (act) { const float iz = 1.0f / z;
#pragma unroll
            for (int k4 = 0; k4 < 4; ++k4) { *(f32x4*)(P.SELG + it * 16 + 4 * k4) = (f32x4){V3[4 * k4] * iz, V3[4 * k4 + 1] * iz, V3[4 * k4 + 2] * iz, V3[4 * k4 + 3] * iz};
                *(int4*)(P.SELE + it * 16 + 4 * k4) = make_int4(I3[4 * k4], I3[4 * k4 + 1], I3[4 * k4 + 2], I3[4 * k4 + 3]); } }
    }
    for (int si = C.vcu * NWAVES + C.wave; si < DEC_BATCH * PEER_HEADS; si += C.G * NWAVES) topk_wave_item(P, (long)M0 * PEER_HEADS + si, lane);
    __syncthreads();
}
constexpr float PEER_SU = 256.f, PEER_SV = 64.f;
DI float dot16_fp8(const u32x4& w, const f32x2 (&x2)[8]) { f32x2 a = {0.f, 0.f};
    a += __builtin_amdgcn_cvt_pk_f32_fp8((int)w.x, false) * x2[0]; a += __builtin_amdgcn_cvt_pk_f32_fp8((int)w.x, true) * x2[1];
    a += __builtin_amdgcn_cvt_pk_f32_fp8((int)w.y, false) * x2[2]; a += __builtin_amdgcn_cvt_pk_f32_fp8((int)w.y, true) * x2[3];
    a += __builtin_amdgcn_cvt_pk_f32_fp8((int)w.z, false) * x2[4]; a += __builtin_amdgcn_cvt_pk_f32_fp8((int)w.z, true) * x2[5];
    a += __builtin_amdgcn_cvt_pk_f32_fp8((int)w.w, false) * x2[6]; a += __builtin_amdgcn_cvt_pk_f32_fp8((int)w.w, true) * x2[7];
    return a.x + a.y; }
DI void axpy16_fp8(const u32x4& w, float s, f32x2 (&o2)[8]) { const f32x2 s2 = {s, s};
    o2[0] += __builtin_amdgcn_cvt_pk_f32_fp8((int)w.x, false) * s2; o2[1] += __builtin_amdgcn_cvt_pk_f32_fp8((int)w.x, true) * s2;
    o2[2] += __builtin_amdgcn_cvt_pk_f32_fp8((int)w.y, false) * s2; o2[3] += __builtin_amdgcn_cvt_pk_f32_fp8((int)w.y, true) * s2;
    o2[4] += __builtin_amdgcn_cvt_pk_f32_fp8((int)w.z, false) * s2; o2[5] += __builtin_amdgcn_cvt_pk_f32_fp8((int)w.z, true) * s2;
    o2[6] += __builtin_amdgcn_cvt_pk_f32_fp8((int)w.w, false) * s2; o2[7] += __builtin_amdgcn_cvt_pk_f32_fp8((int)w.w, true) * s2; }
DI float rdlane(float v, int l) { return __builtin_bit_cast(float, __builtin_amdgcn_readlane(__builtin_bit_cast(int, v), l)); }
DI void peer_phase(const FP& P, const Ctx& C, int layer, const float* xin, float* fout, float* fout_s, bf16* xb) {
    const int lane = C.lane; const unsigned char* U = P.UB8 + (size_t)layer * PEER_EXPERTS * D_MODEL; const unsigned char* Vt = P.VB8 + (size_t)layer * PEER_EXPERTS * D_MODEL;
    const float* gam = P.ln_g + ((size_t)layer * 2 + 1) * D_MODEL; const float* bet = P.ln_b + ((size_t)layer * 2 + 1) * D_MODEL;
    const int nrounds = (M0 + C.G * NWAVES - 1) / (C.G * NWAVES);
#pragma unroll 1
    for (int rd = 0; rd <= nrounds; ++rd) {
        const bool smp = (rd == nrounds); int r = smp ? M0 + C.vcu : rd * C.G * NWAVES + C.vcu * NWAVES + C.wave; if (smp ? (C.vcu >= DEC_BATCH) : (r >= M0)) continue;
        const int pb = smp ? 16 * C.wave : 0, pe = smp ? pb + 16 : 128;
        f32x2 x2[8], o2[8];
#pragma unroll
        for (int j = 0; j < 4; ++j) { const f32x4 a = *(const f32x4*)(xin + (size_t)r * D_MODEL + 16 * lane + 4 * j); x2[2 * j] = (f32x2){a.x, a.y}; x2[2 * j + 1] = (f32x2){a.z, a.w}; }
#pragma unroll
        for (int k = 0; k < 8; ++k) o2[k] = (f32x2){0.f, 0.f};
        const int e_l = P.SELE[(size_t)r * 128 + lane], e_h = P.SELE[(size_t)r * 128 + 64 + lane]; const float g_l = P.SELG[(size_t)r * 128 + lane], g_h = P.SELG[(size_t)r * 128 + 64 + lane];
#pragma unroll 1
        for (int b0 = pb; b0 < pe; b0 += 8) {
            u32x4 uw[8], vw[8];
#pragma unroll
            for (int k = 0; k < 8; ++k) { const int hk = b0 + k; const int e = (hk < 64) ? __builtin_amdgcn_readlane(e_l, hk & 63) : __builtin_amdgcn_readlane(e_h, hk & 63);
                uw[k] = *(const u32x4*)(U + (size_t)e * D_MODEL + 16 * lane); vw[k] = *(const u32x4*)(Vt + (size_t)e * D_MODEL + 16 * lane); }
            float d[8];
#pragma unroll
            for (int k = 0; k < 8; ++k) d[k] = dot16_fp8(uw[k], x2);
            float e4[4], e2[2], e1;
            { const bool hi = lane & 1;
#pragma unroll
              for (int i = 0; i < 4; ++i) { const float keep = hi ? d[4 + i] : d[i], send = hi ? d[i] : d[4 + i]; e4[i] = keep + __shfl_xor(send, 1); } }
            { const bool hi = lane & 2;
#pragma unroll
              for (int i = 0; i < 2; ++i) { const float keep = hi ? e4[2 + i] : e4[i], send = hi ? e4[i] : e4[2 + i]; e2[i] = keep + __shfl_xor(send, 2); } }
            { const bool hi = lane & 4; const float keep = hi ? e2[1] : e2[0], send = hi ? e2[0] : e2[1]; e1 = keep + __shfl_xor(send, 4); }
            e1 += __shfl_xor(e1, 8); e1 += __shfl_xor(e1, 16); e1 += __shfl_xor(e1, 32);
            const int myk = 4 * (lane & 1) + (lane & 2) + ((lane >> 2) & 1); const int myhk = b0 + myk;
            const float myg = (myhk < 64) ? __shfl(g_l, myhk & 63) : __shfl(g_h, myhk & 63);
            const float act = myg * gelu_tanh(e1 * (1.0f / PEER_SU)) * (1.0f / PEER_SV);
#pragma unroll
            for (int k = 0; k < 8; ++k) { const int src = (k >> 2) | (((k >> 1) & 1) << 1) | ((k & 1) << 2); axpy16_fp8(vw[k], rdlane(act, src), o2); }
        }
        if (smp) {
            LAS float* red = (LAS float*)C.lds;
#pragma unroll
            for (int k = 0; k < 8; ++k) { red[C.wave * 1024 + 16 * lane + 2 * k] = o2[k].x; red[C.wave * 1024 + 16 * lane + 2 * k + 1] = o2[k].y; }
            asm volatile("s_waitcnt lgkmcnt(0)" ::: "memory"); __syncthreads();
            if (C.wave == 0) {
#pragma unroll
                for (int k = 0; k < 8; ++k) { float ax = 0.f, ay = 0.f;
#pragma unroll
                    for (int ww = 0; ww < NWAVES; ++ww) { ax += red[ww * 1024 + 16 * lane + 2 * k]; ay += red[ww * 1024 + 16 * lane + 2 * k + 1]; } o2[k] = (f32x2){ax, ay}; } }
            __syncthreads();
            if (C.wave != 0) continue; }
        float s = 0.f;
#pragma unroll
        for (int k = 0; k < 8; ++k) { o2[k] += x2[k] * ALPHA; s += o2[k].x + o2[k].y; }
        const float mu = wave_sum(s) * (1.0f / D_MODEL); float s2 = 0.f;
#pragma unroll
        for (int k = 0; k < 8; ++k) { o2[k] -= mu; s2 += o2[k].x * o2[k].x + o2[k].y * o2[k].y; }
        const float rs = 1.0f / sqrtf(wave_sum(s2) * (1.0f / D_MODEL) + LN_EPS);
        float* frow = (r < M0) ? fout + (size_t)r * D_MODEL : fout_s + (size_t)(r - M0) * D_MODEL;
#pragma unroll
        for (int j = 0; j < 4; ++j) { const int c0 = 16 * lane + 4 * j; const f32x4 gg = *(const f32x4*)(gam + c0), bb = *(const f32x4*)(bet + c0);
            const f32x4 y = (f32x4){o2[2 * j].x * rs, o2[2 * j].y * rs, o2[2 * j + 1].x * rs, o2[2 * j + 1].y * rs} * gg + bb;
            *(f32x4*)(frow + c0) = y; if (xb) *(u32x2*)(xb + (size_t)r * D_MODEL + c0) = pk4(y); }
    }
}
}
namespace fx {
struct EpiB {
    static constexpr bool PERM = true, AFTER_DRAIN = false; const FP& P;
    DI void operator()(const f32x4 (&acc)[2][2][4][2], const pg8::Unit& u, int wr, int wc, int fr, int fq) const {
        const int t = u.pn;
        EPI_LOOP({ if (row < MP) { const int pos = row_pos(row), n = row / SEQ, e = ct & 63, dp = e >> 1; const bool prm = row < M0;
            if (t < 3) { const int ty = 2 * t + (ct >> 7), kvh = (ct >> 6) & 1;
                if (ty == 2 || ty == 4) { f32x4 lo, hi; rope4(P.ROPE + pos * 64, dp, v0, v1, lo, hi);
                    if (ty == 2) { float* o = (prm ? P.nsa_kv_p + (size_t)row * 512 : P.nsa_kv_s + (size_t)(row - M0) * 512) + 256 + kvh * 64 + dp; *(f32x4*)o = lo; *(f32x4*)(o + 32) = hi;
                        if (prm) { bf16* kt = P.SLK + ((size_t)n * NSA_KV_HEADS + kvh) * SEQ * 64; *(u32x2*)(kt + ktile_off(pos, dp)) = pk4(lo); *(u32x2*)(kt + ktile_off(pos, dp + 32)) = pk4(hi); } }
                    else { float* o = nullptr; if (!prm) o = P.win_s + (((size_t)(row - M0) * SWA_WINDOW + SWA_WINDOW - 1) * 2 + 0) * 128; else if (pos >= SEQ - SWA_WINDOW) o = P.win_p + (((size_t)n * SWA_WINDOW + pos - (SEQ - SWA_WINDOW)) * 2 + 0) * 128;
                        if (o) { *(f32x4*)(o + kvh * 64 + dp) = lo; *(f32x4*)(o + kvh * 64 + 32 + dp) = hi; }
                        if (prm) { bf16* kt = P.WNK + ((size_t)n * NSA_KV_HEADS + kvh) * SEQ * 64; *(u32x2*)(kt + ktile_off(pos, dp)) = pk4(lo); *(u32x2*)(kt + ktile_off(pos, dp + 32)) = pk4(hi); } } }
                else if (ty < 4) { float* o = (prm ? P.nsa_kv_p + (size_t)row * 512 : P.nsa_kv_s + (size_t)(row - M0) * 512) + ty * 128 + kvh * 64 + e; *(f32x4*)o = v0; *(f32x4*)(o + 4) = v1;
                    if (prm) { if (ty < 2) *(u32x4*)(P.AC + ((size_t)ty * ACROWS + ((size_t)n * NSA_KV_HEADS + kvh) * NCH + pos / 16) * 1024 + (pos % 16) * 64 + e) = pk8(v0, v1);
                        else { bf16* vt = P.SLVT + ((size_t)n * NSA_KV_HEADS + kvh) * SEQ * 64 + vtile_off(e, pos);
                            vt[0] = (bf16)f2bf(v0.x); vt[8] = (bf16)f2bf(v0.y); vt[16] = (bf16)f2bf(v0.z); vt[24] = (bf16)f2bf(v0.w); vt[32] = (bf16)f2bf(v1.x); vt[40] = (bf16)f2bf(v1.y); vt[48] = (bf16)f2bf(v1.z); vt[56] = (bf16)f2bf(v1.w); } } }
                else { float* o = nullptr; if (!prm) o = P.win_s + (((size_t)(row - M0) * SWA_WINDOW + SWA_WINDOW - 1) * 2 + 1) * 128; else if (pos >= SEQ - SWA_WINDOW) o = P.win_p + (((size_t)n * SWA_WINDOW + pos - (SEQ - SWA_WINDOW)) * 2 + 1) * 128;
                    if (o) { *(f32x4*)(o + kvh * 64 + e) = v0; *(f32x4*)(o + kvh * 64 + e + 4) = v1; }
                    if (prm) { bf16* vt = P.WNVT + ((size_t)n * NSA_KV_HEADS + kvh) * SEQ * 64 + vtile_off(e, pos);
                        vt[0] = (bf16)f2bf(v0.x); vt[8] = (bf16)f2bf(v0.y); vt[16] = (bf16)f2bf(v0.z); vt[24] = (bf16)f2bf(v0.w); vt[32] = (bf16)f2bf(v1.x); vt[40] = (bf16)f2bf(v1.y); vt[48] = (bf16)f2bf(v1.z); vt[56] = (bf16)f2bf(v1.w); } } }
            else if (t < 6) { const int h = (t - 3) * 4 + (ct >> 6); f32x4 lo, hi; rope4(P.ROPE + pos * 64, dp, v0, v1, lo, hi); bf16* q = P.QB + (size_t)row * NSA_Q_COLS + h * 64 + dp; *(u32x2*)q = pk4(lo * QSCALE); *(u32x2*)(q + 32) = pk4(hi * QSCALE); }
            else if (t == 6) { *(u32x4*)(P.MQB + (size_t)row * 256 + ct) = pk8(v0 * QSCALE, v1 * QSCALE); }
            else if (ct < 40) { const float vv[8] = {v0.x, v0.y, v0.z, v0.w, v1.x, v1.y, v1.z, v1.w};
                _Pragma("unroll") for (int i = 0; i < 8; ++i) if (ct + i < NSA_GATE_COLS) P.GATES[(size_t)row * 64 + ct + i] = 1.0f / (1.0f + __expf(-vv[i])); } } })
    }
};
DI void cmp2_phase(const FP& P, const Ctx& C) {
    const int lane = C.lane; LAS float* hs = (LAS float*)(C.lds + C.wave * 1024);
    constexpr int NGRP = NCTX * 2 * NSA_KV_HEADS; const int NW = C.G * NWAVES, WPG = NW / NGRP > 0 ? NW / NGRP : 1; const int gw = C.vcu * NWAVES + C.wave;
#pragma unroll 1
    for (int grp = gw / WPG; grp < NGRP; grp += (NW + WPG - 1) / WPG) { const int slot = gw % WPG; if (gw >= (NW / WPG) * WPG && grp == gw / WPG) break;
        const int kvh = grp % NSA_KV_HEADS, ty = (grp / NSA_KV_HEADS) % 2, ctx = grp / (2 * NSA_KV_HEADS);
        const float* UL = P.UL + ((size_t)ty * ACROWS + ((size_t)ctx * NSA_KV_HEADS + kvh) * NCH) * 256; const float* w2 = P.cmp_w2 + (size_t)ty * CMP_HIDDEN * HEAD_DIM;
        float w2r[CMP_HIDDEN];
#pragma unroll
        for (int k = 0; k < CMP_HIDDEN; ++k) w2r[k] = w2[k * HEAD_DIM + lane];
        const float b0 = P.CBIAS[ty * CMP_HIDDEN + lane], b1 = P.CBIAS[ty * CMP_HIDDEN + 64 + lane];
        float u0, u1, l0, l1; int c = slot;
        if (c < NCMP) { u0 = UL[(size_t)c * 256 + lane]; u1 = UL[(size_t)c * 256 + 64 + lane]; l0 = UL[(size_t)(c + 1) * 256 + 128 + lane]; l1 = UL[(size_t)(c + 1) * 256 + 192 + lane]; }
#pragma unroll 1
        for (; c < NCMP; c += WPG) { const float h0 = gelu_tanh(u0 + l0 + b0), h1 = gelu_tanh(u1 + l1 + b1); const int cn = c + WPG;
            if (cn < NCMP) { u0 = UL[(size_t)cn * 256 + lane]; u1 = UL[(size_t)cn * 256 + 64 + lane]; l0 = UL[(size_t)(cn + 1) * 256 + 128 + lane]; l1 = UL[(size_t)(cn + 1) * 256 + 192 + lane]; }
            hs[lane] = h0; hs[64 + lane] = h1; asm volatile("s_waitcnt lgkmcnt(0)" ::: "memory");
            float a = 0.f;
#pragma unroll
            for (int k4 = 0; k4 < CMP_HIDDEN / 4; ++k4) { const f32x4 hv = *(const LAS f32x4*)(hs + 4 * k4); a += hv.x * w2r[4 * k4] + hv.y * w2r[4 * k4 + 1] + hv.z * w2r[4 * k4 + 2] + hv.w * w2r[4 * k4 + 3]; }
            if (ty == 0) { const float other = __shfl_xor(a, 32); const int pos = c * CMP_STRIDE + CMP_BLOCK - 1; const float cs = P.ROPE[pos * 64 + (lane & 31)], sn = P.ROPE[pos * 64 + 32 + (lane & 31)];
                a = (lane < 32) ? a * cs - other * sn : a * cs + other * sn; }
            if (ctx < BATCH) { if (ty == 0) P.CK[((size_t)ctx * NSA_KV_HEADS + kvh) * NCH * 64 + ktile_off(c, lane)] = (bf16)f2bf(a); else P.CVT[((size_t)ctx * NSA_KV_HEADS + kvh) * NCH * 64 + vtile_off(lane, c)] = (bf16)f2bf(a); }
            else { (ty == 0 ? P.CKF : P.CVF)[(((size_t)(ctx - BATCH) * NSA_KV_HEADS + kvh) * NCH + c) * 64 + lane] = a; }
            asm volatile("s_waitcnt lgkmcnt(0)" ::: "memory"); }
    }
    __syncthreads();
}
constexpr int NSA_WLDS = 8192;
DI void nsa_pair_a(const FP& P, int n, int kvh, int t, int lane, LAS unsigned char* wl) {
    LAS float* pn = (LAS float*)wl; LAS float* imp = (LAS float*)(wl + 2048); LAS float* sc = (LAS float*)(wl + 6144); LAS int* sel = (LAS int*)(wl + 7168);
    const int col = lane & 15, c = lane >> 4; const bool vcol = col < 12; const int qq = vcol ? col / 6 : 0, hh = vcol ? col % 6 : 0, tq = t + qq, head = kvh * NSA_GROUP + hh, row = n * SEQ + tq;
    bf16x8 qf[2]; { const bf16* qp = P.QB + (size_t)row * NSA_Q_COLS + head * 64 + 8 * c; qf[0] = *(const bf16x8*)qp; qf[1] = *(const bf16x8*)(qp + 32); }
    const float* gt = P.GATES + (size_t)row * 64 + head * 3;
    f32x4 oacc[4] = {(f32x4){0.f, 0.f, 0.f, 0.f}, (f32x4){0.f, 0.f, 0.f, 0.f}, (f32x4){0.f, 0.f, 0.f, 0.f}, (f32x4){0.f, 0.f, 0.f, 0.f}};
    const int lim = vcol ? ((tq >= CMP_BLOCK - 1) ? (tq - (CMP_BLOCK - 1)) / CMP_STRIDE : -1) : -1;
    const int limmax = (t + 1 >= CMP_BLOCK - 1) ? (t + 1 - (CMP_BLOCK - 1)) / CMP_STRIDE : -1; const int nblk = (limmax + 32) / 32;
    const bf16* CKb = P.CK + ((size_t)n * NSA_KV_HEADS + kvh) * NCH * 64; const bf16* CVb = P.CVT + ((size_t)n * NSA_KV_HEADS + kvh) * 64 * NCH;
    for (int i = lane; i < 1024; i += 64) imp[i] = 0.f;
    float m1 = -INFINITY, l1 = 0.f;
    { struct K4 { bf16x8 a0, a1, b0, b1; };
      auto ldk = [&](K4& k, int blk) { const bf16* kt = CKb + (size_t)blk * 2048 + lane * 8; k.a0 = *(const bf16x8*)kt; k.a1 = *(const bf16x8*)(kt + 512); k.b0 = *(const bf16x8*)(kt + 1024); k.b1 = *(const bf16x8*)(kt + 1536); };
      auto cp1 = [&](const K4& k, int blk) { const int kb = 32 * blk;
        f32x4 s0 = (f32x4){0.f, 0.f, 0.f, 0.f}, s1 = (f32x4){0.f, 0.f, 0.f, 0.f};
        s0 = __builtin_amdgcn_mfma_f32_16x16x32_bf16(k.a0, qf[0], s0, 0, 0, 0); s0 = __builtin_amdgcn_mfma_f32_16x16x32_bf16(k.a1, qf[1], s0, 0, 0, 0);
        s1 = __builtin_amdgcn_mfma_f32_16x16x32_bf16(k.b0, qf[0], s1, 0, 0, 0); s1 = __builtin_amdgcn_mfma_f32_16x16x32_bf16(k.b1, qf[1], s1, 0, 0, 0);
        float s[8] = {s0.x, s0.y, s0.z, s0.w, s1.x, s1.y, s1.z, s1.w}; float mx = -INFINITY;
#pragma unroll
        for (int e = 0; e < 8; ++e) { s[e] = (kb + 8 * c + e <= lim) ? s[e] : -INFINITY; mx = fmaxf(mx, s[e]); }
        mx = fmaxf(mx, __shfl_xor(mx, 16)); mx = fmaxf(mx, __shfl_xor(mx, 32));
        const float mnew = fmaxf(m1, mx), muse = (mnew == -INFINITY) ? 0.f : mnew; float ls = 0.f;
#pragma unroll
        for (int e = 0; e < 8; ++e) ls += __builtin_amdgcn_exp2f(s[e] - muse);
        ls += __shfl_xor(ls, 16); ls += __shfl_xor(ls, 32);
        l1 = l1 * __builtin_amdgcn_exp2f(m1 - muse) + ls; m1 = mnew; };
      if (nblk > 0) { K4 A, B; ldk(A, 0);
#pragma unroll 1
        for (int blk = 0; blk < nblk; blk += 2) { ldk(B, (blk + 1 < nblk) ? blk + 1 : blk); cp1(A, blk); ldk(A, (blk + 2 < nblk) ? blk + 2 : blk); if (blk + 1 < nblk) cp1(B, blk + 1); } } }
    asm volatile("s_waitcnt lgkmcnt(0)" ::: "memory");
    { const float muse = (m1 == -INFINITY) ? 0.f : m1, inv = (l1 > 0.f) ? 1.0f / l1 : 0.f;
      f32x4 oc[4] = {(f32x4){0.f, 0.f, 0.f, 0.f}, (f32x4){0.f, 0.f, 0.f, 0.f}, (f32x4){0.f, 0.f, 0.f, 0.f}, (f32x4){0.f, 0.f, 0.f, 0.f}};
      pipe2(nblk, [&](KV8& kv, int blk) { kv_load_t(kv, CKb + (size_t)blk * 2048, CVb + (size_t)blk * 2048, lane); }, [&](const KV8& kv, int blk) { const int kb = 32 * blk;
        f32x4 s0 = (f32x4){0.f, 0.f, 0.f, 0.f}, s1 = (f32x4){0.f, 0.f, 0.f, 0.f};
        s0 = __builtin_amdgcn_mfma_f32_16x16x32_bf16(kv.ka0, qf[0], s0, 0, 0, 0); s0 = __builtin_amdgcn_mfma_f32_16x16x32_bf16(kv.ka1, qf[1], s0, 0, 0, 0);
        s1 = __builtin_amdgcn_mfma_f32_16x16x32_bf16(kv.kb0, qf[0], s1, 0, 0, 0); s1 = __builtin_amdgcn_mfma_f32_16x16x32_bf16(kv.kb1, qf[1], s1, 0, 0, 0);
        float s[8] = {s0.x, s0.y, s0.z, s0.w, s1.x, s1.y, s1.z, s1.w};
#pragma unroll
        for (int e = 0; e < 8; ++e) s[e] = (kb + 8 * c + e <= lim) ? __builtin_amdgcn_exp2f(s[e] - muse) * inv : 0.f;
        *(f32x4*)(pn + col * 32 + 8 * c) = (f32x4){s[0], s[1], s[2], s[3]}; *(f32x4*)(pn + col * 32 + 8 * c + 4) = (f32x4){s[4], s[5], s[6], s[7]};
        u32x4 pw; pw.x = cvtpk(s[0], s[1]); pw.y = cvtpk(s[2], s[3]); pw.z = cvtpk(s[4], s[5]); pw.w = cvtpk(s[6], s[7]); const bf16x8 pf = __builtin_bit_cast(bf16x8, pw);
        oc[0] = __builtin_amdgcn_mfma_f32_16x16x32_bf16(kv.v0, pf, oc[0], 0, 0, 0); oc[1] = __builtin_amdgcn_mfma_f32_16x16x32_bf16(kv.v1, pf, oc[1], 0, 0, 0);
        oc[2] = __builtin_amdgcn_mfma_f32_16x16x32_bf16(kv.v2, pf, oc[2], 0, 0, 0); oc[3] = __builtin_amdgcn_mfma_f32_16x16x32_bf16(kv.v3, pf, oc[3], 0, 0, 0);
        asm volatile("s_waitcnt lgkmcnt(0)" ::: "memory");
        { const int q2 = lane >> 5, k = lane & 31; float a = 0.f;
#pragma unroll
          for (int h6 = 0; h6 < 6; ++h6) a += pn[(q2 * 6 + h6) * 32 + k];
          imp[q2 * 512 + kb + k] = a; }
        asm volatile("s_waitcnt lgkmcnt(0)" ::: "memory"); });
#ifdef NSA_DEBUG
      if (vcol) { for (int db = 0; db < 4; ++db) *(f32x4*)(P.DBG + ((size_t)0 * MP + row) * 768 + head * 64 + 16 * db + 4 * c) = oc[db]; }
#endif
      const float g0 = vcol ? gt[0] : 0.f;
#pragma unroll
      for (int db = 0; db < 4; ++db) oacc[db] += oc[db] * g0; }
#ifndef REP_SEL
#define REP_SEL 1
#endif
#pragma unroll 1
    for (int rep = 0; rep < REP_SEL; ++rep) {
    for (int i = lane; i < 256; i += 64) { const int q2 = i >> 7, b = i & 127, tq2 = t + q2, cur = tq2 / SLC_BLOCK; float sv;
        if (b > cur) sv = NEG; else if (b == 0 || b == cur || b == cur - 1) sv = FORCE_SCORE;
        else { const LAS float* ic = imp + q2 * 512 + 4 * b; sv = ic[-1] + 2.f * (ic[0] + ic[1] + ic[2]) + ic[3]; }
        sc[i] = sv; }
    asm volatile("s_waitcnt lgkmcnt(0)" ::: "memory");
    for (int i = lane; i < 256; i += 64) { const int q2 = i >> 7, b = i & 127; const float sv = sc[i]; int rank = 0;
        for (int j = 0; j < 128; j += 4) { const f32x4 o = *(const LAS f32x4*)(sc + q2 * 128 + j);
            rank += (o.x > sv || (o.x == sv && j < b)) ? 1 : 0; rank += (o.y > sv || (o.y == sv && j + 1 < b)) ? 1 : 0; rank += (o.z > sv || (o.z == sv && j + 2 < b)) ? 1 : 0; rank += (o.w > sv || (o.w == sv && j + 3 < b)) ? 1 : 0; }
        if (rank < SLC_TOPK) { const int v = (sv > 0.5f * NEG) ? b : -1; sel[q2 * 16 + rank] = v; P.SELB[((size_t)(n * SEQ + t + q2) * NSA_KV_HEADS + kvh) * 16 + rank] = v; } }
    asm volatile("s_waitcnt lgkmcnt(0)" ::: "memory");
    }
#ifndef REP_WIN
#define REP_WIN 1
#endif
#pragma unroll 1
    for (int rep = 0; rep < REP_WIN; ++rep) { Tile16 T; tile_init(T);
      const bf16* WKb = P.WNK + ((size_t)n * NSA_KV_HEADS + kvh) * SEQ * 64; const bf16* WVb = P.WNVT + ((size_t)n * NSA_KV_HEADS + kvh) * 64 * SEQ;
      const int blo = (t - SWA_WINDOW) >> 5, bhi = (t + 1) >> 5;
      auto ld = [&](KV8& kv, int blk) { const int bc = blk < 0 ? 0 : blk; kv_load_t(kv, WKb + (size_t)bc * 2048, WVb + (size_t)bc * 2048, lane); };
      pipe2(bhi - blo + 1, [&](KV8& kv, int i) { ld(kv, blo + i); }, [&](const KV8& kv, int i) { const int kb = 32 * (blo + i);
          tile_compute(T, qf, kv, [&](int e) { const int kp = kb + 8 * c + e; return vcol && kp >= 0 && kp <= tq && tq - kp <= SWA_WINDOW; }); });
      const float inv = (T.l > 0.f) ? 1.0f / T.l : 0.f, g2 = vcol ? gt[2] * inv : 0.f;
#ifdef NSA_DEBUG
      if (vcol) { for (int db = 0; db < 4; ++db) *(f32x4*)(P.DBG + ((size_t)2 * MP + row) * 768 + head * 64 + 16 * db + 4 * c) = T.o[db] * inv; }
#endif
#pragma unroll
      for (int db = 0; db < 4; ++db) if (rep == REP_WIN - 1) oacc[db] += T.o[db] * g2; }
    if (vcol) { float* op = P.DPART + (size_t)row * 768 + head * 64 + 4 * c;
#pragma unroll
        for (int db = 0; db < 4; ++db) *(f32x4*)(op + 16 * db) = oacc[db]; }
}
DI void nsa_pair_b(const FP& P, int n, int kvh, int t, int lane, LAS unsigned char* wl) {
    LAS int* steps = (LAS int*)wl;
    const int col = lane & 15, c = lane >> 4; const bool vcol = col < 12; const int qq = vcol ? col / 6 : 0, hh = vcol ? col % 6 : 0, tq = t + qq, head = kvh * NSA_GROUP + hh, row = n * SEQ + tq;
    bf16x8 qf[2]; { const bf16* qp = P.QB + (size_t)row * NSA_Q_COLS + head * 64 + 8 * c; qf[0] = *(const bf16x8*)qp; qf[1] = *(const bf16x8*)(qp + 32); }
    const float* gt = P.GATES + (size_t)row * 64 + head * 3;
    Tile16 T; tile_init(T);
    const bf16* SKb = P.SLK + ((size_t)n * NSA_KV_HEADS + kvh) * SEQ * 64; const bf16* SVb = P.SLVT + ((size_t)n * NSA_KV_HEADS + kvh) * SEQ * 64;
    int ns = 0;
    { const int mysel = (lane < 32) ? P.SELB[((size_t)(n * SEQ + t + (lane >> 4)) * NSA_KV_HEADS + kvh) * 16 + (lane & 15)] : -1;
      for (int i = 0; i < 32; ++i) { const int b = __builtin_amdgcn_readlane(mysel, i); if (b < 0) continue; const int q2 = i >> 4;
          if (lane == 0) { steps[ns] = (b * SLC_BLOCK) | (q2 << 30); steps[ns + 1] = (b * SLC_BLOCK + 32) | (q2 << 30); } ns += 2; } }
    asm volatile("s_waitcnt lgkmcnt(0)" ::: "memory");
    auto ld = [&](KV8& kv, int i) { const int code = __builtin_amdgcn_readfirstlane(steps[i]); const int kb = code & 0x3fffffff;
        kv_load_t(kv, SKb + (size_t)(kb >> 5) * 2048, SVb + (size_t)(kb >> 5) * 2048, lane); };
#ifdef PROBE_DBLCOMP
    Tile16 T2; tile_init(T2);
#endif
    pipe2(ns, ld, [&](const KV8& kv, int i) { const int code = __builtin_amdgcn_readfirstlane(steps[i]); const int kb = code & 0x3fffffff, q2 = code >> 30;
        tile_compute(T, qf, kv, [&](int e) { return vcol && qq == q2 && (kb + 8 * c + e) <= tq; });
#ifdef PROBE_DBLCOMP
        tile_compute(T2, qf, kv, [&](int e) { return vcol && qq == q2 && (kb + 8 * c + e + 1) <= tq; });
#endif
    });
#ifdef PROBE_DBLCOMP
    if (T2.l < 0.f) T.l = 0.f;
#endif
    const float inv = (T.l > 0.f) ? 1.0f / T.l : 0.f, g1 = vcol ? gt[1] * inv : 0.f;
#ifdef NSA_DEBUG
    if (vcol) { for (int db = 0; db < 4; ++db) *(f32x4*)(P.DBG + ((size_t)1 * MP + row) * 768 + head * 64 + 16 * db + 4 * c) = T.o[db] * inv; }
#endif
    if (vcol) { const float* pp = P.DPART + (size_t)row * 768 + head * 64 + 4 * c; bf16* op = P.ATTB + (size_t)row * 1024 + head * 64 + 4 * c;
#pragma unroll
        for (int db = 0; db < 4; ++db) *(u32x2*)(op + 16 * db) = pk4(*(const f32x4*)(pp + 16 * db) + T.o[db] * g1); }
}

constexpr int SMP_SK = 1088;
template <class KF, class VF> DI void smp_branch(const Ctx& C, LAS float* qs, LAS float* S, LAS float* red, int NK, KF kf, VF vf, bool keep_probs, float (&outh)[1]) {
    const int tid = C.tid, lane = C.lane, w = C.wave;
#pragma unroll 1
    for (int j = tid; j < NK; j += NTHREADS) { const float* k = kf(j); f32x4 kr[16];
#pragma unroll
        for (int d4 = 0; d4 < 16; ++d4) kr[d4] = *(const f32x4*)(k + 4 * d4);
#pragma unroll 1
        for (int h = 0; h < 6; ++h) { float a = 0.f;
#pragma unroll
            for (int d4 = 0; d4 < 16; ++d4) { const f32x4 qv = *(const LAS f32x4*)(qs + h * 64 + 4 * d4); a += kr[d4].x * qv.x + kr[d4].y * qv.y + kr[d4].z * qv.z + kr[d4].w * qv.w; }
            S[h * SMP_SK + j] = a; } }
    asm volatile("s_waitcnt lgkmcnt(0)" ::: "memory"); __syncthreads();
    if (w < 6) { float m = -INFINITY; for (int j = lane; j < NK; j += 64) m = fmaxf(m, S[w * SMP_SK + j]); m = wave_max(m);
        float l = 0.f; for (int j = lane; j < NK; j += 64) { const float p = __builtin_amdgcn_exp2f(S[w * SMP_SK + j] - m); S[w * SMP_SK + j] = p; l += p; } l = wave_sum(l);
        const float inv = 1.0f / l; for (int j = lane; j < NK; j += 64) S[w * SMP_SK + j] *= inv; }
    asm volatile("s_waitcnt lgkmcnt(0)" ::: "memory"); __syncthreads();
    { const int per = (NK + NWAVES - 1) / NWAVES, j0 = w * per, j1 = (j0 + per < NK) ? j0 + per : NK; float o[6] = {0.f, 0.f, 0.f, 0.f, 0.f, 0.f};
#pragma unroll 1
      for (int j = j0; j < j1; j += 8) { float vv[8];
#pragma unroll
          for (int u = 0; u < 8; ++u) { const int jj = (j + u < j1) ? j + u : j1 - 1; vv[u] = vf(jj)[lane]; }
#pragma unroll
          for (int u = 0; u < 8; ++u) if (j + u < j1) {
#pragma unroll
              for (int h = 0; h < 6; ++h) o[h] += S[h * SMP_SK + j + u] * vv[u]; } }
#pragma unroll
      for (int h = 0; h < 6; ++h) red[(w * 6 + h) * 64 + lane] = o[h]; }
    asm volatile("s_waitcnt lgkmcnt(0)" ::: "memory"); __syncthreads();
    outh[0] = 0.f;
    if (tid < 384) { float a = 0.f;
#pragma unroll
        for (int ww = 0; ww < NWAVES; ++ww) a += red[ww * 384 + tid]; outh[0] = a; }
    if (!keep_probs) { __syncthreads(); }
}
DI void nsa_sample_item(const FP& P, const Ctx& C, int ns, int kvh) {
    LAS float* qs = (LAS float*)C.lds; LAS float* S = qs + 384; LAS float* red = S + 6 * SMP_SK; LAS float* scs = red + 8 * 384; LAS int* sel = (LAS int*)(scs + 136);
    const int tid = C.tid, row = M0 + ns;
    if (tid < 384) qs[tid] = bf2f(P.QB[(size_t)row * NSA_Q_COLS + kvh * 384 + tid]);
    asm volatile("s_waitcnt lgkmcnt(0)" ::: "memory"); __syncthreads();
    const float* ckf = P.CKF + ((size_t)ns * NSA_KV_HEADS + kvh) * NCH * 64; const float* cvf = P.CVF + ((size_t)ns * NSA_KV_HEADS + kvh) * NCH * 64;
    float oc[1], os[1], ow[1];
    smp_branch(C, qs, S, red, NCMP, [&](int j) { return ckf + (size_t)j * 64; }, [&](int j) { return cvf + (size_t)j * 64; }, true, oc);
    constexpr int NBS = (PAST_LEN + 1 + SLC_BLOCK - 1) / SLC_BLOCK, CURS = PAST_LEN / SLC_BLOCK;
    for (int b = tid; b < 136; b += NTHREADS) { float sv = -3.0e38f;
        if (b < NBS) { if (b == 0 || b == CURS || b == CURS - 1) sv = FORCE_SCORE; else { float a = 0.f;
#pragma unroll
                for (int o = -1; o <= 3; ++o) { const int ci = 4 * b + o; if (ci >= 0 && ci < NCMP) { float sm = 0.f; for (int h6 = 0; h6 < 6; ++h6) sm += S[h6 * SMP_SK + ci]; a += ((o >= 0 && o <= 2) ? 2.f : 1.f) * sm; } }
                sv = a; } }
        scs[b] = sv; }
    asm volatile("s_waitcnt lgkmcnt(0)" ::: "memory"); __syncthreads();
    for (int b = tid; b < NBS; b += NTHREADS) { const float sv = scs[b]; int rank = 0; for (int j = 0; j < NBS; ++j) { const float o = scs[j]; rank += (o > sv || (o == sv && j < b)) ? 1 : 0; }
        if (rank < SLC_TOPK) { sel[rank] = b; P.SELB[((size_t)row * NSA_KV_HEADS + kvh) * 16 + rank] = b; } }
    asm volatile("s_waitcnt lgkmcnt(0)" ::: "memory"); __syncthreads();
    { const float* newrow = P.nsa_kv_s + (size_t)ns * 512; const int* pt = P.page_table + ns * (PAST_LEN / PAGE_SIZE);
      if (tid == 0) { int seen = 0; for (int x = 0; x < SLC_TOPK; ++x) { const int bx = sel[x]; if (bx != CURS && seen < 15) sel[16 + seen++] = bx; } }
      asm volatile("s_waitcnt lgkmcnt(0)" ::: "memory"); __syncthreads();
      auto krow = [&](int j, int ty) -> const float* { if (j >= 15 * 64) return newrow + ty * 128 + kvh * 64;
          const int t0 = sel[16 + (j >> 6)] * SLC_BLOCK + (j & 63); const int pg = pt[t0 / PAGE_SIZE]; return P.cache_nsa_kv + ((size_t)pg * PAGE_SIZE + t0 % PAGE_SIZE) * 512 + ty * 128 + kvh * 64; };
      smp_branch(C, qs, S, red, 15 * 64 + 1, [&](int j) { return krow(j, 2); }, [&](int j) { return krow(j, 3); }, false, os); }
    { const float* wc = P.cache_nsa_win + (size_t)ns * SWA_WINDOW * 256; const float* newrow = P.win_s + ((size_t)ns * SWA_WINDOW + SWA_WINDOW - 1) * 256;
      smp_branch(C, qs, S, red, SWA_WINDOW + 1, [&](int j) { return (j < SWA_WINDOW ? wc + (size_t)j * 256 : newrow) + kvh * 64; }, [&](int j) { return (j < SWA_WINDOW ? wc + (size_t)j * 256 : newrow) + 128 + kvh * 64; }, false, ow); }
    if (tid < 384) { const int head = kvh * NSA_GROUP + tid / 64; const float* gt = P.GATES + (size_t)row * 64 + head * 3;
        P.ATTB[(size_t)row * 1024 + kvh * 384 + tid] = (bf16)f2bf(gt[0] * oc[0] + gt[1] * os[0] + gt[2] * ow[0]);
#ifdef NSA_DEBUG
        P.DBG[((size_t)0 * MP + row) * 768 + kvh * 384 + tid] = oc[0]; P.DBG[((size_t)1 * MP + row) * 768 + kvh * 384 + tid] = os[0]; P.DBG[((size_t)2 * MP + row) * 768 + kvh * 384 + tid] = ow[0];
#endif
    }
    __syncthreads();
}
DI void nsa_pairs(const FP& P, const Ctx& C, bool second) {
    LAS unsigned char* wl = C.lds + C.wave * NSA_WLDS;
    const int per = C.G / 4 > 0 ? C.G / 4 : 1, grp = (C.vcu / per) & 3, sub = C.vcu % per, n = grp >> 1, kvh = grp & 1;
#pragma unroll 1
    for (int pr = sub * NWAVES + C.wave; pr < SEQ / 2; pr += per * NWAVES) { if (second) nsa_pair_b(P, n, kvh, 2 * pr, C.lane, wl); else nsa_pair_a(P, n, kvh, 2 * pr, C.lane, wl); }
}
DI void nsa_phase_a(const FP& P, const Ctx& C) {
    for (int it = C.vcu; it < DEC_BATCH * NSA_KV_HEADS; it += C.G) nsa_sample_item(P, C, it / NSA_KV_HEADS, it % NSA_KV_HEADS);
    nsa_pairs(P, C, false);
    __syncthreads();
}
DI void nsa_phase_b(const FP& P, const Ctx& C) {
    const int lane = C.lane, w = C.wave;
    nsa_pairs(P, C, true);
    __syncthreads();
    { constexpr int NMT = (M0 / 16) * MEM_HEADS;
      for (int it = C.vcu * NWAVES + w; it < NMT; it += C.G * NWAVES) { const int h = it % MEM_HEADS, q16 = it / MEM_HEADS, row0 = q16 * 16, n = row0 / SEQ;
          mem_micro(P, P.MQB + h * 64, 256, row0, 1, n, h, P.ATTB + NSA_Q_COLS + h * 64, 1024, lane); }
      LAS float* qs = (LAS float*)(C.lds + 65536 + w * 256);
      for (int it = C.vcu * NWAVES + w; it < DEC_BATCH * MEM_HEADS; it += C.G * NWAVES) { const int h = it % MEM_HEADS, ns = it / MEM_HEADS, row = M0 + ns;
          Dec D; D.m = -INFINITY; D.l = 0.f; D.o = 0.f; qs[lane] = bf2f(P.MQB[(size_t)row * 256 + h * 64 + lane]); asm volatile("s_waitcnt lgkmcnt(0)" ::: "memory");
          const float* mk = P.cache_mem_kv + ((size_t)1 * DEC_BATCH + ns) * MEM_TOKENS * 512;
          for (int j0 = 0; j0 < MEM_TOKENS; j0 += 64) dec_chunk(D, qs, 64, [&](int j) { return mk + (size_t)(j0 + j) * 512 + h * 64; }, [&](int j) { return mk + (size_t)(j0 + j) * 512 + 256 + h * 64; }, lane);
          P.ATTB[(size_t)row * 1024 + NSA_Q_COLS + h * 64 + lane] = (bf16)f2bf(D.o / D.l); } }
    __syncthreads();
}
}
namespace fx {
enum { PH_PRO = 0, PH_G1, PH_ATTA, PH_G2, PH_LN1, PH_SC0, PH_TK0, PH_PG0, PH_G3, PH_CMPG, PH_CMP2, PH_NSA, PH_NSB, PH_G4, PH_LN3, PH_SC1, PH_TK1, PH_PG1, PH_COUNT };
template <class Epi> DI void run_gemm(const Ctx& C, const bf16* A, const bf16* Bt, int M, int N, int K, const Epi& E) {
    pg8::Gemm g{A, Bt, M, N, K}; pg8::StaticOrder S; S.init(M, N, C.G, (int)blockIdx.x);
    pg8::gemm_phase<Epi, pg8::StaticOrder, true, true>(C.lds, g, S, E);
}
template <class Epi> DI void skinny_gemm(const Ctx& C, const bf16* A, const bf16* Bt, int N, int K, const Epi& E) {
    static_assert(DEC_BATCH == 32 && M0 % 256 == 0, "skinny_gemm: 32 sample rows right after a whole number of 256-row tiles");
    const int lane = C.lane, fr = lane & 15, fq = lane >> 4, w = C.wave; const int NI = (N / 256) * 4, KW = K / NWAVES;
    LAS f32x4* red = (LAS f32x4*)C.lds;
#pragma unroll 1
    for (int item = C.vcu; item < NI; item += C.G) { const int pn = item >> 2, wc = item & 3;
        f32x4 pa[2][2][2];
#pragma unroll
        for (int i = 0; i < 8; ++i) (&pa[0][0][0])[i] = (f32x4){0.f, 0.f, 0.f, 0.f};
        const bf16* xa = A + (size_t)(M0 + fr) * K + w * KW + 8 * fq; const bf16* xb = xa + (size_t)16 * K;
        const bf16* wp[2][2];
#pragma unroll
        for (int bj = 0; bj < 2; ++bj)
#pragma unroll
            for (int n = 0; n < 2; ++n) wp[bj][n] = Bt + (size_t)(pn * 256 + bj * 128 + wc * 32 + 8 * (fr >> 2) + 4 * n + (fr & 3)) * K + w * KW + 8 * fq;
#pragma unroll 4
        for (int k0 = 0; k0 < KW; k0 += 32) { const bf16x8 x0 = *(const bf16x8*)(xa + k0), x1 = *(const bf16x8*)(xb + k0);
#pragma unroll
            for (int bj = 0; bj < 2; ++bj)
#pragma unroll
                for (int n = 0; n < 2; ++n) { const bf16x8 wf = *(const bf16x8*)(wp[bj][n] + k0);
                    pa[bj][0][n] = __builtin_amdgcn_mfma_f32_16x16x32_bf16(wf, x0, pa[bj][0][n], 0, 0, 0); pa[bj][1][n] = __builtin_amdgcn_mfma_f32_16x16x32_bf16(wf, x1, pa[bj][1][n], 0, 0, 0); } }
        __syncthreads();
#pragma unroll
        for (int bj = 0; bj < 2; ++bj)
#pragma unroll
            for (int mm = 0; mm < 2; ++mm)
#pragma unroll
                for (int n = 0; n < 2; ++n) red[(w * 8 + bj * 4 + mm * 2 + n) * 64 + lane] = pa[bj][mm][n];
        asm volatile("s_waitcnt lgkmcnt(0)" ::: "memory"); __syncthreads();
        if (w == 0) { f32x4 acc[2][2][4][2];
#pragma unroll
            for (int i = 0; i < 32; ++i) (&acc[0][0][0][0])[i] = (f32x4){0.f, 0.f, 0.f, 0.f};
#pragma unroll
            for (int bj = 0; bj < 2; ++bj)
#pragma unroll
                for (int mm = 0; mm < 2; ++mm)
#pragma unroll
                    for (int n = 0; n < 2; ++n) { f32x4 s = red[(bj * 4 + mm * 2 + n) * 64 + lane];
#pragma unroll 1
                        for (int ww = 1; ww < NWAVES; ++ww) s += red[(ww * 8 + bj * 4 + mm * 2 + n) * 64 + lane];
                        acc[0][bj][mm][n] = s; }
            E(acc, pg8::Unit{M0 / 256, pn}, 0, wc, fr, fq); }
    }
    __syncthreads();
}
__global__ void __launch_bounds__(NTHREADS, 2) mega(Args args) {
    extern __shared__ __attribute__((aligned(16))) unsigned char lds_raw[];
    Ctx C; C.lds = (LAS unsigned char*)lds_raw; C.tid = threadIdx.x; C.lane = C.tid & 63; C.wave = __builtin_amdgcn_readfirstlane(C.tid >> 6);
    C.G = gridDim.x; { const int bx = blockIdx.x; C.vcu = (C.G % 8 == 0) ? (bx % 8) * (C.G / 8) + bx / 8 : bx; }
    const FP& P = args.p;
    volatile LAS unsigned* MISC = (volatile LAS unsigned*)(C.lds + MISC_OFF);
    for (int u = C.tid; u < (LDS_BYTES - RING_BYTES) / 4; u += NTHREADS) ((LAS unsigned*)(C.lds + RING_BYTES))[u] = 0u;
    __syncthreads();
    const int lo = args.lo, hi = args.hi;
    XcdBarrier bar; bar.bar = P.ctl + 1024; bar.x = 0; bar.st = nullptr;
    if (hi - lo > 1) bar = xcd_barrier_post(P.ctl + 1024, MISC + 8);
#define IN(k) (lo <= (k) && (k) < hi)
#define SEAM(k) do { if (IN(k) && IN((k) + 1)) xcd_barrier(bar); } while (0)
#ifndef DUP_PHASE
#define DUP_PHASE -1
#endif
#define PHASE(k, ...) do { if (IN(k)) { __VA_ARGS__ if (DUP_PHASE == (k)) { __syncthreads(); __VA_ARGS__ } } SEAM(k); } while (0)
    PHASE(PH_PRO, p0_prologue(P, C); __syncthreads(); p0_wpk(P, C););
    PHASE(PH_G1, run_gemm(C, P.XB0, P.WA_T, M0, ACOLS, D_MODEL, EpiA{P}); run_gemm(C, P.MEMB, P.WMEM_T, BATCH * MEM_TOKENS, 1024, D_MODEL, EpiMem{P}); skinny_gemm(C, P.XB0, P.WA_T, ACOLS, D_MODEL, EpiA{P}););
    PHASE(PH_ATTA, atta_phase(P, C););
    PHASE(PH_G2, run_gemm(C, P.ATTA, P.WOA_T, M0, D_MODEL, 512, EpiPre{P.x_prompt, P.x_sample, P.PRE}); skinny_gemm(C, P.ATTA, P.WOA_T, D_MODEL, 512, EpiPre{P.x_prompt, P.x_sample, P.PRE}););
    PHASE(PH_LN1, ln_phase(P, C, P.PRE, P.ln_g, P.ln_b, P.X1, P.X1B, nullptr, nullptr););
    PHASE(PH_SC0, run_gemm(C, P.X1B, P.WPK_T, M0, NPK, D_MODEL, EpiF32{P.SCO, NPK, MP}); skinny_gemm(C, P.X1B, P.WPK_T, NPK, D_MODEL, EpiF32{P.SCO, NPK, MP}););
    PHASE(PH_TK0, topk_phase(P, C););
    PHASE(PH_PG0, peer_phase(P, C, 0, P.X1, P.X2, P.X2 + (size_t)M0 * D_MODEL, P.X2B););
    PHASE(PH_G3, run_gemm(C, P.X2B, P.WB_T, M0, NB_T, D_MODEL, EpiB{P}); skinny_gemm(C, P.X2B, P.WB_T, NB_T, D_MODEL, EpiB{P}););
    PHASE(PH_CMPG, run_gemm(C, P.AC, P.CW1_T, ACROWS, 256, 1024, EpiF32{P.UL, 256, ACROWS}); run_gemm(C, P.AC + (size_t)ACROWS * 1024, P.CW1_T + 256 * 1024, ACROWS, 256, 1024, EpiF32{P.UL + (size_t)ACROWS * 256, 256, ACROWS}););
    PHASE(PH_CMP2, cmp2_phase(P, C););
    PHASE(PH_NSA, nsa_phase_a(P, C););
    PHASE(PH_NSB, nsa_phase_b(P, C););
    PHASE(PH_G4, run_gemm(C, P.ATTB, P.WOB_T, M0, D_MODEL, 1024, EpiPre{P.X2, nullptr, P.PRE}); skinny_gemm(C, P.ATTB, P.WOB_T, D_MODEL, 1024, EpiPre{P.X2, nullptr, P.PRE}););
    PHASE(PH_LN3, ln_phase(P, C, P.PRE, P.ln_g + 2 * D_MODEL, P.ln_b + 2 * D_MODEL, P.X3, P.X3B, nullptr, nullptr););
    PHASE(PH_SC1, run_gemm(C, P.X3B, P.WPK_T + (size_t)NPK * D_MODEL, M0, NPK, D_MODEL, EpiF32{P.SCO, NPK, MP}); skinny_gemm(C, P.X3B, P.WPK_T + (size_t)NPK * D_MODEL, NPK, D_MODEL, EpiF32{P.SCO, NPK, MP}););
    PHASE(PH_TK1, topk_phase(P, C););
    PHASE(PH_PG1, peer_phase(P, C, 1, P.X3, P.y_prompt, P.y_sample, nullptr););
#undef IN
#undef SEAM
}
}
#ifndef ONE_LAUNCH
#define ONE_LAUNCH 1
#endif
extern "C" void kernel_launch(void* const* d_in, const int* in_sizes, int n_in, void* d_out, int out_size, void* d_ws, size_t ws_size, hipStream_t stream) {
    fx::Args a; memset(&a, 0, sizeof(a)); fx::bind_io(a.p, d_in, (float*)d_out);
    const size_t f_need = fx::carve(a.p, d_ws);
    if (f_need > ws_size) { fprintf(stderr, "kernel_launch: workspace too small: need %zu have %zu\n", f_need, ws_size); return; }
    static int grid = 0;
    if (!grid) { int dev = 0, cus = 0, per_cu = 0; (void)hipGetDevice(&dev); (void)hipDeviceGetAttribute(&cus, hipDeviceAttributeMultiprocessorCount, dev);
        (void)hipFuncSetAttribute((const void*)fx::mega, hipFuncAttributeMaxDynamicSharedMemorySize, fx::LDS_BYTES);
        if (hipOccupancyMaxActiveBlocksPerMultiprocessor(&per_cu, (const void*)fx::mega, fx::NTHREADS, fx::LDS_BYTES) != hipSuccess || per_cu < 1) { fprintf(stderr, "kernel_launch: occupancy query says %d blocks per CU\n", per_cu); (void)hipGetLastError(); }
        grid = cus; }
    (void)hipMemsetAsync(a.p.ctl, 0, fx::CTL_BYTES, stream);
#if ONE_LAUNCH
    a.lo = 0; a.hi = fx::PH_COUNT; hipLaunchKernelGGL(fx::mega, dim3(grid), dim3(fx::NTHREADS), fx::LDS_BYTES, stream, a);
#else
    for (int k = 0; k < fx::PH_COUNT; ++k) { a.lo = k; a.hi = k + 1; hipLaunchKernelGGL(fx::mega, dim3(grid), dim3(fx::NTHREADS), fx::LDS_BYTES, stream, a); }
#endif
}
```

```cpp
#define ONE_LAUNCH 1
#include <hip/hip_runtime.h>
#include <cstdio>
#include <cstring>
#include <cmath>
#ifdef CPU_TEST
#define HD inline
constexpr int D_MODEL = 128, BATCH = 2, SEQ = 512, DEPTH = 2, DEC_BATCH = 3, DEC_SEQ = 1, PAST_LEN = 512, PAGE_SIZE = 128;
constexpr int DIL_W[3] = {16, 64, 256}, DIL_D[3] = {1, 4, 16}, DIL_TAPS = 17;
constexpr int MEM_TOKENS = 32, SLC_TOPK = 4, SWA_WINDOW = 64, PEER_KEYS = 16, PEER_TOPK = 4;
#else
#define HD __host__ __device__ __forceinline__
constexpr int D_MODEL = 1024, BATCH = 2, SEQ = 8192, DEPTH = 2, DEC_BATCH = 32, DEC_SEQ = 1, PAST_LEN = 8192, PAGE_SIZE = 128;
constexpr int DIL_W[3] = {128, 512, 2048}, DIL_D[3] = {1, 4, 16}, DIL_TAPS = 129;
constexpr int MEM_TOKENS = 256, SLC_TOPK = 16, SWA_WINDOW = 512, PEER_KEYS = 128, PEER_TOPK = 16;
#endif
HD constexpr int dil_w(int g) { return g == 0 ? DIL_W[0] : (g == 1 ? DIL_W[1] : DIL_W[2]); }
HD constexpr int dil_d(int g) { return g == 0 ? DIL_D[0] : (g == 1 ? DIL_D[1] : DIL_D[2]); }
constexpr int HEAD_DIM = 64, N_A_LAYERS = DEPTH / 2, N_DIL = 3, DIL_HEADS = 4, DIL_COLS = N_DIL * 3 * DIL_HEADS * HEAD_DIM;
constexpr int MEM_HEADS = 4, MEM_COLS = MEM_HEADS * HEAD_DIM;
constexpr int NSA_HEADS = 12, NSA_KV_HEADS = 2, NSA_GROUP = 6, NSA_Q_COLS = NSA_HEADS * HEAD_DIM, NSA_GATE_COLS = NSA_HEADS * 3;
constexpr int CMP_BLOCK = 32, CMP_STRIDE = 16, CMP_HIDDEN = 128, SLC_BLOCK = 64;
constexpr int PEER_EXPERTS = PEER_KEYS * PEER_KEYS, PEER_HEADS = 8, PEER_KEY_DIM = 128;
constexpr float FORCE_SCORE = 1.0e9f, NEG = -1.0e30f, SCALE = 0.125f, LN_EPS = 1e-5f;
constexpr float ALPHA = 1.41421356237309515f;
constexpr float BETA = 0.5f;
#define LAS __attribute__((address_space(3)))
namespace pg8 {
#define PG8_LAS __attribute__((address_space(3)))
typedef unsigned short bf16_t;
typedef short bf16x8 __attribute__((ext_vector_type(8)));
typedef float f32x4 __attribute__((ext_vector_type(4)));
typedef unsigned u32x4 __attribute__((ext_vector_type(4)));
constexpr int BM = 256, BK = 64, HALF = 128, HTB = HALF * BK * 2  , STAGE_BYTES = 8 * HTB, NXCD = 8, WGM = 8;

__host__ __device__ __forceinline__ int lds_byte(int r, int c) { const int st = (r >> 4) * 2 + (c >> 5), rr = r & 15, cc = c & 31, ob = rr * 64 + cc * 2; return st * 1024 + (ob ^ (((ob >> 9) & 1) << 5)); }
__host__ __device__ __forceinline__ void stage_rc(int b, int& R, int& C) { const int st = b / 1024, sb = b % 1024, swz = sb ^ (((sb >> 9) & 1) << 5); R = (st >> 1) * 16 + swz / 64; C = (st & 1) * 32 + (swz % 64) / 2; }
__host__ __device__ __forceinline__ int perm32(int rho) { const int n = rho >> 4, i = rho & 15; return 8 * (i >> 2) + 4 * n + (i & 3); }

struct Unit { int pm, pn; };
struct Gemm { const bf16_t* A; const bf16_t* Bt; int M, N, K; };

struct StaticOrder {
    int nM, nN, nwg, G, c;
    __host__ __device__ void init(int M, int N, int G_, int c_) { nM = M / BM; nN = N / BM; nwg = nM * nN; G = G_; c = c_; }
    __host__ __device__ bool next(int i, Unit& u) const {
        const long L = (long)i * G + c; if (L >= nwg) return false;
        int wgid = (int)L; { const int q = nwg / NXCD, r = nwg % NXCD, xcd = wgid % NXCD, off = wgid / NXCD; wgid = (xcd < r ? xcd * (q + 1) : r * (q + 1) + (xcd - r) * q) + off; }
        const int nig = WGM * nN, gid = wgid / nig, fm = gid * WGM, gsz = (nM - fm) < WGM ? (nM - fm) : WGM;
        u.pm = fm + ((wgid % nig) % gsz); u.pn = (wgid % nig) / gsz; return true;
    }
    __device__ __forceinline__ void a_ready(const Unit&) const {}
    __device__ __forceinline__ void done(const Unit&) const {}
};

__device__ __forceinline__ unsigned cvt_pk_bf16(float lo, float hi) { unsigned r; asm volatile("v_cvt_pk_bf16_f32 %0, %1, %2" : "=v"(r) : "v"(lo), "v"(hi)); return r; }
typedef float f32x2 __attribute__((ext_vector_type(2)));
typedef float f32x2 __attribute__((ext_vector_type(2)));
template <class Epi, class Sched, bool ALIGN_EPI = false, bool SP2 = false>
__device__ __forceinline__ void gemm_phase(PG8_LAS unsigned char* lds, const Gemm g, const Sched& S, const Epi& E) {
    const int tid = threadIdx.x, wid = __builtin_amdgcn_readfirstlane(tid >> 6), lane = tid & 63, wr = wid >> 2, wc = wid & 3, fr = lane & 15, fq = lane >> 4;
    const int K = g.K, nt = K / BK;
    unsigned voffA[2], voffB[2];
#pragma unroll
    for (int i = 0; i < 2; ++i) { int R, C; stage_rc(tid * 16 + i * 8192, R, C); const int Rb = Epi::PERM ? ((R & ~31) + perm32(R & 31)) : R;
        voffA[i] = (unsigned)(R * K + C) * 2u; voffB[i] = (unsigned)(Rb * K + C) * 2u; }
    const size_t kstep = (size_t)(BK * 2);
    const size_t hstep = (size_t)HALF * K * 2;
    const size_t tstep = 2 * hstep;
    const unsigned ldsw = (unsigned)wid * 1024u;
    const int aoff = lds_byte(wr * 64 + fr, fq * 8), boff = lds_byte(wc * 32 + fr, fq * 8);
#define PG8_SA(b, h) (((b) * 2 + (h)) * HTB)
#define PG8_SB(b, h) ((4 + (b) * 2 + (h)) * HTB)
#define PG8_STAGE(bufoff, gbase, voff) do { _Pragma("unroll") for (int _i = 0; _i < 2; ++_i) \
        __builtin_amdgcn_global_load_lds((const unsigned*)((const char*)(gbase) + (voff)[_i]), (PG8_LAS unsigned*)(lds + (bufoff) + ldsw + _i * 8192), 16, 0, 0); } while (0)
#define PG8_LDA(dst, b, h) do { _Pragma("unroll") for (int m = 0; m < 4; ++m) _Pragma("unroll") for (int k = 0; k < 2; ++k) dst[m][k] = *(const PG8_LAS bf16x8*)(lds + PG8_SA(b, h) + aoff + m * 2048 + k * 1024); } while (0)
#define PG8_LDB(dst, b, h) do { _Pragma("unroll") for (int n = 0; n < 2; ++n) _Pragma("unroll") for (int k = 0; k < 2; ++k) dst[n][k] = *(const PG8_LAS bf16x8*)(lds + PG8_SB(b, h) + boff + n * 2048 + k * 1024); } while (0)
#define PG8_MMA(ai, bj, At, Bt) do { __builtin_amdgcn_s_setprio(1); _Pragma("unroll") for (int m = 0; m < 4; ++m) _Pragma("unroll") for (int n = 0; n < 2; ++n) _Pragma("unroll") for (int k = 0; k < 2; ++k) \
        acc[ai][bj][m][n] = __builtin_amdgcn_mfma_f32_16x16x32_bf16(Bt[n][k], At[m][k], acc[ai][bj][m][n], 0, 0, 0); __builtin_amdgcn_s_setprio(0); } while (0)
#define PG8_WAIT_V(n) asm volatile("s_waitcnt vmcnt(" #n ")" ::: "memory")
#define PG8_WAIT_L(n) asm volatile("s_waitcnt lgkmcnt(" #n ")" ::: "memory")
#define PG8_BAR __builtin_amdgcn_s_barrier()
#define PG8_SCHED __builtin_amdgcn_sched_barrier(0)
    Unit cur, nxt; int ui = 0;
    if (!S.next(0, cur)) return;
    f32x4 acc[2][2][4][2];
#pragma unroll
    for (int a = 0; a < 2; ++a)
#pragma unroll
        for (int b = 0; b < 2; ++b)
#pragma unroll
            for (int m = 0; m < 4; ++m)
#pragma unroll
                for (int n = 0; n < 2; ++n) acc[a][b][m][n] = (f32x4){0.f, 0.f, 0.f, 0.f};
    bf16x8 At[4][2], B0[2][2], B1[2][2];
    const char* cA = (const char*)g.A + (size_t)cur.pm * tstep; const char* cB = (const char*)g.Bt + (size_t)cur.pn * tstep;
    S.a_ready(cur);
    if constexpr (SP2) {
        PG8_STAGE(PG8_SB(0, 0), cB, voffB); PG8_STAGE(PG8_SB(0, 1), cB + hstep, voffB); PG8_STAGE(PG8_SA(0, 0), cA, voffA); PG8_STAGE(PG8_SA(0, 1), cA + hstep, voffA);
        if (wr == 1) PG8_BAR;
        PG8_WAIT_V(2); PG8_BAR;
        PG8_STAGE(PG8_SB(1, 0), cB + kstep, voffB); PG8_STAGE(PG8_SA(1, 0), cA + kstep, voffA); PG8_STAGE(PG8_SB(1, 1), cB + hstep + kstep, voffB);
        PG8_WAIT_V(6); PG8_BAR;
    } else {
        PG8_STAGE(PG8_SB(0, 0), cB, voffB); PG8_STAGE(PG8_SA(0, 0), cA, voffA); PG8_STAGE(PG8_SB(0, 1), cB + hstep, voffB); PG8_STAGE(PG8_SA(0, 1), cA + hstep, voffA);
        if (wr == 1) PG8_BAR;
        PG8_WAIT_V(4); PG8_BAR;
        PG8_STAGE(PG8_SB(1, 0), cB + kstep, voffB); PG8_STAGE(PG8_SA(1, 0), cA + kstep, voffA); PG8_STAGE(PG8_SB(1, 1), cB + hstep + kstep, voffB);
        PG8_WAIT_V(6); PG8_BAR;
    }
    for (;;) {
        const bool has_next = S.next(ui + 1, nxt);
        const char* nA = has_next ? (const char*)g.A + (size_t)nxt.pm * tstep : cA; const char* nB = has_next ? (const char*)g.Bt + (size_t)nxt.pn * tstep : cB;
        for (int t = 0; t < nt; t += 2) {
            const bool last = (t == nt - 2);
            const char* a1 = cA + (size_t)(t + 1) * kstep;
            const char* a2 = last ? nA : cA + (size_t)(t + 2) * kstep; const char* b2 = last ? nB : cB + (size_t)(t + 2) * kstep;
            const char* a3 = a2 + kstep; const char* b3 = b2 + kstep;
            if (last && has_next) S.a_ready(nxt);
            if constexpr (SP2) {
            PG8_LDB(B0, 0, 0); PG8_LDB(B1, 0, 1); PG8_SCHED; PG8_LDA(At, 0, 0); PG8_STAGE(PG8_SA(1, 1), a1 + hstep, voffA);
            PG8_WAIT_V(8); PG8_WAIT_L(0); PG8_BAR; PG8_MMA(0, 0, At, B0); PG8_MMA(0, 1, At, B1); PG8_BAR; PG8_SCHED;
            PG8_LDA(At, 0, 1); PG8_STAGE(PG8_SB(0, 0), b2, voffB); PG8_STAGE(PG8_SB(0, 1), b2 + hstep, voffB); PG8_STAGE(PG8_SA(0, 0), a2, voffA);
            PG8_WAIT_V(8); PG8_WAIT_L(0); PG8_BAR; PG8_MMA(1, 0, At, B0); PG8_MMA(1, 1, At, B1); PG8_BAR; PG8_SCHED;
            PG8_LDB(B0, 1, 0); PG8_LDB(B1, 1, 1); PG8_SCHED; PG8_LDA(At, 1, 0); PG8_STAGE(PG8_SA(0, 1), a2 + hstep, voffA);
            PG8_WAIT_V(8); PG8_WAIT_L(0); PG8_BAR; PG8_MMA(0, 0, At, B0); PG8_MMA(0, 1, At, B1); PG8_BAR; PG8_SCHED;
            PG8_LDA(At, 1, 1); PG8_STAGE(PG8_SB(1, 0), b3, voffB); PG8_STAGE(PG8_SB(1, 1), b3 + hstep, voffB); PG8_STAGE(PG8_SA(1, 0), a3, voffA);
            PG8_WAIT_V(8); PG8_WAIT_L(0); PG8_BAR; PG8_MMA(1, 0, At, B0); PG8_MMA(1, 1, At, B1); PG8_BAR; PG8_SCHED;
            } else {
            PG8_LDB(B0, 0, 0); PG8_SCHED; PG8_LDA(At, 0, 0); PG8_STAGE(PG8_SA(1, 1), a1 + hstep, voffA);
            PG8_WAIT_L(8); PG8_BAR; PG8_WAIT_L(0); PG8_MMA(0, 0, At, B0); PG8_BAR; PG8_SCHED;
            PG8_LDB(B1, 0, 1); PG8_STAGE(PG8_SB(0, 0), b2, voffB);
            PG8_BAR; PG8_WAIT_L(0); PG8_MMA(0, 1, At, B1); PG8_BAR;
            PG8_LDA(At, 0, 1); PG8_STAGE(PG8_SA(0, 0), a2, voffA);
            PG8_BAR; PG8_WAIT_L(0); PG8_MMA(1, 0, At, B0); PG8_BAR; PG8_SCHED;
            PG8_STAGE(PG8_SB(0, 1), b2 + hstep, voffB);
            PG8_WAIT_V(6); PG8_BAR; PG8_MMA(1, 1, At, B1); PG8_BAR;
            PG8_LDB(B0, 1, 0); PG8_SCHED; PG8_LDA(At, 1, 0); PG8_STAGE(PG8_SA(0, 1), a2 + hstep, voffA);
            PG8_WAIT_L(8); PG8_BAR; PG8_WAIT_L(0); PG8_MMA(0, 0, At, B0); PG8_BAR; PG8_SCHED;
            PG8_LDB(B1, 1, 1); PG8_STAGE(PG8_SB(1, 0), b3, voffB);
            PG8_BAR; PG8_WAIT_L(0); PG8_MMA(0, 1, At, B1); PG8_BAR;
            PG8_LDA(At, 1, 1); PG8_STAGE(PG8_SA(1, 0), a3, voffA);
            PG8_BAR; PG8_WAIT_L(0); PG8_MMA(1, 0, At, B0); PG8_BAR; PG8_SCHED;
            PG8_STAGE(PG8_SB(1, 1), b3 + hstep, voffB);
            PG8_WAIT_V(6); PG8_BAR; PG8_MMA(1, 1, At, B1); PG8_BAR;
            }
        }
        if constexpr (ALIGN_EPI) { if (wr == 0) PG8_BAR; }
        if constexpr (!Epi::AFTER_DRAIN) { E(acc, cur, wr, wc, fr, fq); S.done(cur); }
        if (!has_next) break;
#pragma unroll
        for (int a = 0; a < 2; ++a)
#pragma unroll
            for (int b = 0; b < 2; ++b)
#pragma unroll
                for (int m = 0; m < 4; ++m)
#pragma unroll
                    for (int n = 0; n < 2; ++n) acc[a][b][m][n] = (f32x4){0.f, 0.f, 0.f, 0.f};
        cur = nxt; cA = nA; cB = nB; ++ui;
        if constexpr (ALIGN_EPI) { if (wr == 1) PG8_BAR; }
    }
    PG8_WAIT_V(0);
    if constexpr (!ALIGN_EPI) { if (wr == 0) PG8_BAR; }
    PG8_BAR;
    if constexpr (Epi::AFTER_DRAIN) { E.fused(acc, cur, wr, wc, fr, fq, lds, wid, lane); S.done(cur); }
#undef PG8_SA
#undef PG8_SB
#undef PG8_STAGE
#undef PG8_LDA
#undef PG8_LDB
#undef PG8_MMA
#undef PG8_WAIT_V
#undef PG8_WAIT_L
#undef PG8_BAR
#undef PG8_SCHED
}
}
#define XB_TMO      128
#define XB_XCNT(j)  (256  + 64 * (j))
#define XB_XSUB(j)  (1280 + 64 * (j))
#define XB_XGEN(j)  (2304 + 64 * (j))
#define XB_TOP      3328
#define XB_TOPGEN   3392
#define XCD_BAR_WORDS 3456
#define XB_SPIN_CAP (1u << 18)

__device__ __forceinline__ unsigned xb_ld(unsigned* p)              { return __hip_atomic_load(p, __ATOMIC_RELAXED, __HIP_MEMORY_SCOPE_AGENT); }
__device__ __forceinline__ unsigned xb_add(unsigned* p, unsigned v) { return __hip_atomic_fetch_add(p, v, __ATOMIC_RELAXED, __HIP_MEMORY_SCOPE_AGENT); }
__device__ __forceinline__ unsigned xb_xcc_id() { return (unsigned)__builtin_amdgcn_s_getreg((3 << 11) | 20) & 0xFu; }
#define XB_SPIN(cond, bar) do { unsigned _sp = 0; while (cond) { __builtin_amdgcn_s_sleep(1); \
    if ((++_sp & 255u) == 0u) { if (xb_ld(&(bar)[XB_TMO])) break; if (_sp > XB_SPIN_CAP) { atomicAdd(&(bar)[XB_TMO], 1u); break; } } } } while (0)

struct XcdBarrier {
    unsigned* bar; unsigned x;
    volatile LAS unsigned* st;
};

__device__ __forceinline__ XcdBarrier xcd_barrier_post(unsigned* bar, volatile LAS unsigned* st) {
    XcdBarrier b; b.bar = bar; b.x = xb_xcc_id(); b.st = st;
    if (threadIdx.x == 0) (void)xb_add(&bar[XB_XCNT(b.x)], 1u);
    return b;
}
__device__ __forceinline__ void xcd_barrier_complete(unsigned* bar, unsigned x, unsigned& nloc, unsigned& nx) {
    const unsigned G = gridDim.x * gridDim.y * gridDim.z;
    unsigned sum, cnt, mine, sp = 0u;
    for (;;) {
        sum = 0u; cnt = 0u; mine = 0u;
#pragma unroll
        for (unsigned j = 0; j < 16; ++j) { const unsigned c = xb_ld(&bar[XB_XCNT(j)]); sum += c; cnt += (c > 0u) ? 1u : 0u; mine = (j == x) ? c : mine; }
        if (sum == G) break;
        __builtin_amdgcn_s_sleep(1);
        if ((++sp & 255u) == 0u) { if (xb_ld(&bar[XB_TMO])) break; if (sp > XB_SPIN_CAP) { atomicAdd(&bar[XB_TMO], 1u); break; } }
    }
    nloc = mine > 0u ? mine : 1u; nx = cnt > 0u ? cnt : 1u;
}

__device__ __forceinline__ void xcd_barrier(const XcdBarrier& b) {
    asm volatile("s_waitcnt vmcnt(0)" ::: "memory");
    __syncthreads();
    if (threadIdx.x == 0) {
        unsigned* bar = b.bar;
        __builtin_amdgcn_s_waitcnt(0);
        unsigned nloc = b.st[0], nx = b.st[1];
        if (nloc == 0u) { xcd_barrier_complete(bar, b.x, nloc, nx); b.st[0] = nloc; b.st[1] = nx; }
        const unsigned old = xb_add(&bar[XB_XSUB(b.x)], 1u);
        const unsigned gen = old / nloc;
        if (old + 1u == (gen + 1u) * nloc) {
            __builtin_amdgcn_fence(__ATOMIC_RELEASE, "agent");
            asm volatile("s_waitcnt vmcnt(0)" ::: "memory");
            const unsigned og = xb_add(&bar[XB_TOP], 1u);
            const unsigned tg = og / nx;
            if (og + 1u == (tg + 1u) * nx) xb_add(&bar[XB_TOPGEN], 1u);
            else XB_SPIN(xb_ld(&bar[XB_TOPGEN]) == tg, bar);
            __builtin_amdgcn_fence(__ATOMIC_ACQUIRE, "agent");
            xb_add(&bar[XB_XGEN(b.x)], 1u);
            asm volatile("s_waitcnt vmcnt(0)" ::: "memory");
        } else {
            XB_SPIN(xb_ld(&bar[XB_XGEN(b.x)]) == gen, bar);
            __builtin_amdgcn_fence(__ATOMIC_ACQUIRE, "agent");
            asm volatile("s_waitcnt vmcnt(0)" ::: "memory");
        }
    }
    __syncthreads();
}
namespace fx {
#define DI __device__ __forceinline__
typedef unsigned short bf16;
typedef short bf16x8 __attribute__((ext_vector_type(8)));
typedef float f32x4 __attribute__((ext_vector_type(4)));
typedef float f32x2 __attribute__((ext_vector_type(2)));
typedef unsigned u32x4 __attribute__((ext_vector_type(4)));
typedef unsigned u32x2 __attribute__((ext_vector_type(2)));
constexpr int M0 = BATCH * SEQ, MP = M0 + DEC_BATCH, MPAD = ((MP + 255) / 256) * 256;
constexpr int ACOLS = DIL_COLS + MEM_COLS, BCOLS = NSA_Q_COLS + NSA_GATE_COLS + MEM_COLS, KVCOLS = 6 * NSA_KV_HEADS * HEAD_DIM;
constexpr int NB_T = 2048;
constexpr int NPK = PEER_HEADS * 2 * PEER_KEYS;
constexpr int NCMP = (SEQ - CMP_BLOCK) / CMP_STRIDE + 1;
constexpr int NCH = SEQ / CMP_STRIDE;
constexpr int NCTX = BATCH + DEC_BATCH;
constexpr int ACROWS = NCTX * NSA_KV_HEADS * NCH;
constexpr int NPOS = PAST_LEN + 1;
constexpr float QSCALE = 0.125f * 1.4426950408889634f;
constexpr int NTHREADS = 512, NWAVES = 8, LDS_BYTES = 147456, RING_BYTES = 131072, MISC_OFF = RING_BYTES + 320;

struct FP {
    const float *x_prompt, *x_sample, *mem_prompt, *cache_dil[3], *cache_nsa_kv, *cache_nsa_win, *cache_mem_kv; const int* page_table;
    const float *w_in_a, *w_out_a, *w_in_b, *w_out_b, *w_mem_kv, *w_kv_b, *cmp_pe, *cmp_w1, *cmp_w2, *ln_g, *ln_b, *peer_wq, *peer_keys, *peer_u, *peer_v;
    float *y_prompt, *y_sample, *dil_p[3], *dil_s[3], *nsa_kv_p, *nsa_kv_s, *win_p, *win_s, *mem_kv_p;
    unsigned* ctl;
    bf16 *XB0, *X1B, *X2B, *X3B, *WA_T, *WMEM_T, *MEMB, *WOA_T, *WOB_T, *WPK_T, *WB_T, *CW1_T, *AC; unsigned char *UB8, *VB8;
    float *ROPE, *CBIAS;
    bf16 *QA, *KA, *VTA, *MQA, *MK, *MVT, *ATTA;
    float *DPART, *DML, *PRE, *X1, *X2, *X3, *SCO, *SELG; int* SELE;
    bf16 *SLK, *SLVT, *WNK, *WNVT, *QB, *MQB, *CK, *CVT, *ATTB;
    float *GATES, *UL, *CKF, *CVF;
    int* SELB;
    float* DBG;
};
struct Args { FP p; int lo, hi; };
struct Carve { size_t off = 0; template <class T> T* take(void* base, size_t n) { T* r = (T*)((char*)base + off); off += ((n * sizeof(T) + 255) / 256) * 256; return r; } };
constexpr size_t CTL_BYTES = 65536;
inline size_t carve(FP& p, void* base) {
    Carve c;
    p.ctl = c.take<unsigned>(base, CTL_BYTES / 4);
    p.XB0 = c.take<bf16>(base, (size_t)MPAD * D_MODEL); p.X1B = c.take<bf16>(base, (size_t)MPAD * D_MODEL); p.X2B = c.take<bf16>(base, (size_t)MPAD * D_MODEL); p.X3B = c.take<bf16>(base, (size_t)MPAD * D_MODEL);
    p.WA_T = c.take<bf16>(base, (size_t)ACOLS * D_MODEL); p.WMEM_T = c.take<bf16>(base, (size_t)DEPTH * 2 * MEM_COLS * D_MODEL); p.MEMB = c.take<bf16>(base, (size_t)BATCH * MEM_TOKENS * D_MODEL);
    p.WOA_T = c.take<bf16>(base, (size_t)D_MODEL * 2 * MEM_COLS); p.WOB_T = c.take<bf16>(base, (size_t)D_MODEL * (NSA_Q_COLS + MEM_COLS));
    p.WPK_T = c.take<bf16>(base, (size_t)DEPTH * NPK * D_MODEL); p.WB_T = c.take<bf16>(base, (size_t)NB_T * D_MODEL);
    p.UB8 = c.take<unsigned char>(base, (size_t)DEPTH * PEER_EXPERTS * D_MODEL); p.VB8 = c.take<unsigned char>(base, (size_t)DEPTH * PEER_EXPERTS * D_MODEL);
    p.CW1_T = c.take<bf16>(base, (size_t)2 * 256 * 1024); p.AC = c.take<bf16>(base, (size_t)2 * ACROWS * 1024);
    p.ROPE = c.take<float>(base, (size_t)NPOS * 64); p.CBIAS = c.take<float>(base, 2 * CMP_HIDDEN);
    p.QA = c.take<bf16>(base, (size_t)3 * MPAD * 256); p.KA = c.take<bf16>(base, (size_t)3 * MPAD * 256); p.VTA = c.take<bf16>(base, (size_t)3 * BATCH * DIL_HEADS * HEAD_DIM * SEQ + 4096);
    p.MQA = c.take<bf16>(base, (size_t)MPAD * 256); p.MK = c.take<bf16>(base, (size_t)DEPTH * BATCH * MEM_TOKENS * MEM_COLS); p.MVT = c.take<bf16>(base, (size_t)DEPTH * BATCH * MEM_COLS * MEM_TOKENS);
    p.ATTA = c.take<bf16>(base, (size_t)MPAD * 2 * MEM_COLS);
    p.DPART = c.take<float>(base, (size_t)3 * MP * DIL_HEADS * HEAD_DIM); p.DML = c.take<float>(base, (size_t)3 * MP * DIL_HEADS * 2);
    p.PRE = c.take<float>(base, (size_t)MPAD * D_MODEL); p.X1 = c.take<float>(base, (size_t)MPAD * D_MODEL); p.X2 = c.take<float>(base, (size_t)MPAD * D_MODEL); p.X3 = c.take<float>(base, (size_t)MPAD * D_MODEL);
    p.SCO = c.take<float>(base, (size_t)MPAD * NPK); p.SELG = c.take<float>(base, (size_t)MP * 128); p.SELE = c.take<int>(base, (size_t)MP * 128);
    p.SLK = c.take<bf16>(base, (size_t)BATCH * NSA_KV_HEADS * SEQ * HEAD_DIM); p.SLVT = c.take<bf16>(base, (size_t)BATCH * NSA_KV_HEADS * SEQ * HEAD_DIM);
    p.WNK = c.take<bf16>(base, (size_t)BATCH * NSA_KV_HEADS * SEQ * HEAD_DIM + 4096); p.WNVT = c.take<bf16>(base, (size_t)BATCH * NSA_KV_HEADS * SEQ * HEAD_DIM + 4096);
    p.QB = c.take<bf16>(base, (size_t)MPAD * NSA_Q_COLS); p.MQB = c.take<bf16>(base, (size_t)MPAD * 256);
    p.CK = c.take<bf16>(base, (size_t)NCTX * NSA_KV_HEADS * NCH * HEAD_DIM); p.CVT = c.take<bf16>(base, (size_t)NCTX * NSA_KV_HEADS * HEAD_DIM * NCH); p.ATTB = c.take<bf16>(base, (size_t)MPAD * (NSA_Q_COLS + MEM_COLS));
    p.GATES = c.take<float>(base, (size_t)MPAD * 64); p.UL = c.take<float>(base, (size_t)2 * ACROWS * 256);
    p.CKF = c.take<float>(base, (size_t)DEC_BATCH * NSA_KV_HEADS * NCH * HEAD_DIM); p.CVF = c.take<float>(base, (size_t)DEC_BATCH * NSA_KV_HEADS * NCH * HEAD_DIM);
    p.SELB = c.take<int>(base, (size_t)MP * NSA_KV_HEADS * 16);
#ifdef NSA_DEBUG
    p.DBG = c.take<float>(base, (size_t)3 * MP * 768);
#else
    p.DBG = nullptr;
#endif
    return c.off;
}
inline void bind_io(FP& p, void* const* d_in, float* out) {
    p.x_prompt = (const float*)d_in[0]; p.x_sample = (const float*)d_in[1]; p.mem_prompt = (const float*)d_in[2]; p.cache_dil[0] = (const float*)d_in[3]; p.cache_dil[1] = (const float*)d_in[4]; p.cache_dil[2] = (const float*)d_in[5];
    p.cache_nsa_kv = (const float*)d_in[6]; p.cache_nsa_win = (const float*)d_in[7]; p.cache_mem_kv = (const float*)d_in[8]; p.page_table = (const int*)d_in[9];
    p.w_in_a = (const float*)d_in[10]; p.w_out_a = (const float*)d_in[11]; p.w_in_b = (const float*)d_in[12]; p.w_out_b = (const float*)d_in[13]; p.w_mem_kv = (const float*)d_in[14]; p.w_kv_b = (const float*)d_in[15];
    p.cmp_pe = (const float*)d_in[16]; p.cmp_w1 = (const float*)d_in[17]; p.cmp_w2 = (const float*)d_in[18]; p.ln_g = (const float*)d_in[19]; p.ln_b = (const float*)d_in[20];
    p.peer_wq = (const float*)d_in[21]; p.peer_keys = (const float*)d_in[22]; p.peer_u = (const float*)d_in[23]; p.peer_v = (const float*)d_in[24];
    size_t o = 0; auto take = [&](size_t n) { float* r = out + o; o += n; return r; };
    p.y_prompt = take((size_t)M0 * D_MODEL); p.y_sample = take((size_t)DEC_BATCH * D_MODEL);
    for (int g = 0; g < 3; ++g) p.dil_p[g] = take((size_t)BATCH * DIL_W[g] * 2 * DIL_HEADS * HEAD_DIM);
    for (int g = 0; g < 3; ++g) p.dil_s[g] = take((size_t)DEC_BATCH * DIL_W[g] * 2 * DIL_HEADS * HEAD_DIM);
    p.nsa_kv_p = take((size_t)M0 * 4 * NSA_KV_HEADS * HEAD_DIM); p.nsa_kv_s = take((size_t)DEC_BATCH * 4 * NSA_KV_HEADS * HEAD_DIM);
    p.win_p = take((size_t)BATCH * SWA_WINDOW * 2 * NSA_KV_HEADS * HEAD_DIM); p.win_s = take((size_t)DEC_BATCH * SWA_WINDOW * 2 * NSA_KV_HEADS * HEAD_DIM);
    p.mem_kv_p = take((size_t)DEPTH * BATCH * MEM_TOKENS * 2 * MEM_COLS);
}
DI unsigned f2bf(float f) { unsigned u = __builtin_bit_cast(unsigned, f); return (u + 0x7fffu + ((u >> 16) & 1u)) >> 16; }
DI unsigned pk2(float lo, float hi) { return f2bf(lo) | (f2bf(hi) << 16); }
DI float bf2f(unsigned short b) { return __builtin_bit_cast(float, (unsigned)b << 16); }
DI float bflo(unsigned w) { return __builtin_bit_cast(float, w << 16); }
DI float bfhi(unsigned w) { return __builtin_bit_cast(float, w & 0xffff0000u); }
DI float wave_sum(float v) {
#pragma unroll
    for (int o = 1; o < 64; o <<= 1) v += __shfl_xor(v, o);
    return v; }
DI float wave_max(float v) {
#pragma unroll
    for (int o = 1; o < 64; o <<= 1) v = fmaxf(v, __shfl_xor(v, o));
    return v; }
DI float gelu_tanh(float x) { const float u = 0.7978845608028654f * (x + 0.044715f * x * x * x); const float e = __builtin_amdgcn_exp2f(u * 2.885390081777927f);   const float t = 1.0f - 2.0f / (e + 1.0f); return 0.5f * x * (1.0f + t); }
DI float* sel3(float* const (&a)[3], int g) { return g == 0 ? a[0] : (g == 1 ? a[1] : a[2]); }
DI const float* sel3c(const float* const (&a)[3], int g) { return g == 0 ? a[0] : (g == 1 ? a[1] : a[2]); }
__host__ DI size_t ktile_off(int t, int d) { const int blk = t >> 5, kk = t & 31, b = (kk >> 2) & 1, i = 4 * (kk >> 3) + (kk & 3), s = d >> 5, c = (d & 31) >> 3; return ((size_t)(blk * 4 + 2 * b + s) * 64 + i + 16 * c) * 8 + (d & 7); }
__host__ DI size_t vtile_off(int dim, int t) { const int blk = t >> 5, kk = t & 31; return ((size_t)(blk * 4 + (dim >> 4)) * 64 + (dim & 15) + 16 * (kk >> 3)) * 8 + (kk & 7); }
struct Ctx { LAS unsigned char* lds; int tid, lane, wave, vcu, G; };
DI int row_pos(int r) { return r < M0 ? (r & (SEQ - 1)) : PAST_LEN; }

struct ColSrc { const float* p; int ld; };
DI int rope_il(int e) { return (e >> 1) + 32 * (e & 1); }
DI ColSrc col_wa(const FP& P, int n) {
    const int t = n >> 8, ct = n & 255, h = ct >> 6, e = ct & 63; if (t >= 9) return ColSrc{P.w_in_a + DIL_COLS + ct, ACOLS};
    const int j = t % 3, d = (j < 2) ? rope_il(e) : e; return ColSrc{P.w_in_a + t * 256 + h * 64 + d, ACOLS}; }
DI ColSrc col_wb(const FP& P, int n) {
    const int t = n >> 8, ct = n & 255, e = ct & 63;
    if (t < 3) { const int ty = 2 * t + (ct >> 7), kvh = (ct >> 6) & 1; const bool rot = (ty == 2 || ty == 4); return ColSrc{P.w_kv_b + (ty * NSA_KV_HEADS + kvh) * 64 + (rot ? rope_il(e) : e), KVCOLS}; }
    if (t < 6) { const int h = (t - 3) * 4 + (ct >> 6); return ColSrc{P.w_in_b + h * 64 + rope_il(e), BCOLS}; }
    if (t == 6) return ColSrc{P.w_in_b + NSA_Q_COLS + NSA_GATE_COLS + ct, BCOLS};
    if (ct < NSA_GATE_COLS) return ColSrc{P.w_in_b + NSA_Q_COLS + ct, BCOLS};
    return ColSrc{nullptr, 0}; }
DI ColSrc col_wmem(const FP& P, int n) { const int l = n >> 9, c = n & 511; return ColSrc{P.w_mem_kv + (size_t)l * D_MODEL * 512 + c, 512}; }
DI ColSrc col_woa(const FP& P, int n) { return ColSrc{P.w_out_a + n, D_MODEL}; }
DI ColSrc col_wob(const FP& P, int n) { return ColSrc{P.w_out_b + n, D_MODEL}; }
DI ColSrc col_cw1(const FP& P, int n) {
    const int ty = n >> 8, half = (n >> 7) & 1, hid = n & 127; return ColSrc{P.cmp_w1 + (size_t)ty * CMP_BLOCK * HEAD_DIM * CMP_HIDDEN + (size_t)half * 16 * HEAD_DIM * CMP_HIDDEN + hid, CMP_HIDDEN}; }
template <class CF> DI void transpose_item(const FP& P, CF cf, int K, bf16* WT, LAS float* scr, int item, int nblk, int lane) {
    const int kb = item / nblk, nb = item % nblk, k0 = 64 * kb, n0 = 32 * nb;
    const ColSrc cs = cf(P, n0 + (lane & 31));
#pragma unroll 8
    for (int i = 0; i < 32; ++i) { const int kk = 2 * i + (lane >> 5); scr[kk * 33 + (lane & 31)] = cs.p ? cs.p[(size_t)(k0 + kk) * cs.ld] : 0.f; }
    asm volatile("s_waitcnt lgkmcnt(0)" ::: "memory");
    const int c = lane & 7;
#pragma unroll
    for (int j = 0; j < 4; ++j) { const int n = (lane >> 3) + 8 * j; const LAS float* s = scr + (8 * c) * 33 + n;
        u32x4 o; o.x = pk2(s[0 * 33], s[1 * 33]); o.y = pk2(s[2 * 33], s[3 * 33]); o.z = pk2(s[4 * 33], s[5 * 33]); o.w = pk2(s[6 * 33], s[7 * 33]);
        *(u32x4*)(WT + (size_t)(n0 + n) * K + k0 + 8 * c) = o; }
    asm volatile("s_waitcnt lgkmcnt(0)" ::: "memory");
}
DI void cvt_row1024(const float* src, bf16* dst, int lane) {
#pragma unroll
    for (int j = 0; j < 4; ++j) { f32x4 v = src ? *(const f32x4*)(src + 256 * j + 4 * lane) : (f32x4){0.f, 0.f, 0.f, 0.f}; u32x2 o; o.x = pk2(v.x, v.y); o.y = pk2(v.z, v.w); *(u32x2*)(dst + 256 * j + 4 * lane) = o; }
}
DI void cvt_row1024_fp8(const float* src, unsigned char* dst, float sc, int lane) { u32x4 o; unsigned w[4];
#pragma unroll
    for (int j = 0; j < 4; ++j) { const f32x4 v = *(const f32x4*)(src + 16 * lane + 4 * j) * sc; int t = __builtin_amdgcn_cvt_pk_fp8_f32(v.x, v.y, 0, false); t = __builtin_amdgcn_cvt_pk_fp8_f32(v.z, v.w, t, true); w[j] = (unsigned)t; }
    o.x = w[0]; o.y = w[1]; o.z = w[2]; o.w = w[3]; *(u32x4*)(dst + 16 * lane) = o; }
DI void p0_prologue(const FP& P, const Ctx& C) {
    LAS float* scr = (LAS float*)(C.lds + C.wave * 16384);
    const int gw = C.vcu * NWAVES + C.wave, NGW = C.G * NWAVES, lane = C.lane;
    { constexpr int IA = (D_MODEL / 64) * (ACOLS / 32), IM = (D_MODEL / 64) * (1024 / 32), IOA = (512 / 64) * (D_MODEL / 32), IOB = (1024 / 64) * (D_MODEL / 32), IB = (D_MODEL / 64) * (NB_T / 32), IC = (1024 / 64) * (512 / 32);
      constexpr int NIT = IA + IM + IOA + IOB + IB + IC;
      for (int it = gw; it < NIT; it += NGW) { int r = it;
          if (r < IA) { transpose_item(P, col_wa, D_MODEL, P.WA_T, scr, r, ACOLS / 32, lane); continue; } r -= IA;
          if (r < IM) { transpose_item(P, col_wmem, D_MODEL, P.WMEM_T, scr, r, 1024 / 32, lane); continue; } r -= IM;
          if (r < IOA) { transpose_item(P, col_woa, 512, P.WOA_T, scr, r, D_MODEL / 32, lane); continue; } r -= IOA;
          if (r < IOB) { transpose_item(P, col_wob, 1024, P.WOB_T, scr, r, D_MODEL / 32, lane); continue; } r -= IOB;
          if (r < IB) { transpose_item(P, col_wb, D_MODEL, P.WB_T, scr, r, NB_T / 32, lane); continue; } r -= IB;
          transpose_item(P, col_cw1, 1024, P.CW1_T, scr, r, 512 / 32, lane); } }
    for (int r = gw; r < MPAD; r += NGW) { cvt_row1024(r < M0 ? P.x_prompt + (size_t)r * D_MODEL : (r < MP ? P.x_sample + (size_t)(r - M0) * D_MODEL : nullptr), P.XB0 + (size_t)r * D_MODEL, lane);
        if (r >= MP) { cvt_row1024(nullptr, P.X1B + (size_t)r * D_MODEL, lane); cvt_row1024(nullptr, P.X2B + (size_t)r * D_MODEL, lane); cvt_row1024(nullptr, P.X3B + (size_t)r * D_MODEL, lane);
            for (int c = lane; c < 512; c += 64) { P.ATTA[(size_t)r * 512 + c] = 0; P.ATTB[(size_t)r * 1024 + c] = 0; P.ATTB[(size_t)r * 1024 + 512 + c] = 0; } } }
    for (int r = gw; r < BATCH * MEM_TOKENS; r += NGW) cvt_row1024(P.mem_prompt + (size_t)r * D_MODEL, P.MEMB + (size_t)r * D_MODEL, lane);
#pragma unroll 1
    for (int r = 2 * gw; r < DEPTH * PEER_EXPERTS; r += 2 * NGW) { f32x4 a[16];
#pragma unroll
        for (int q = 0; q < 4; ++q) { const float* s0 = (q < 2 ? P.peer_u : P.peer_v) + (size_t)(r + (q & 1)) * D_MODEL + 16 * lane;
#pragma unroll
            for (int j = 0; j < 4; ++j) a[4 * q + j] = *(const f32x4*)(s0 + 4 * j); }
#pragma unroll
        for (int q = 0; q < 4; ++q) { const float sc = q < 2 ? 256.f : 64.f; unsigned w[4];
#pragma unroll
            for (int j = 0; j < 4; ++j) { const f32x4 v = a[4 * q + j] * sc; int t = __builtin_amdgcn_cvt_pk_fp8_f32(v.x, v.y, 0, false); t = __builtin_amdgcn_cvt_pk_fp8_f32(v.z, v.w, t, true); w[j] = (unsigned)t; }
            u32x4 o; o.x = w[0]; o.y = w[1]; o.z = w[2]; o.w = w[3]; *(u32x4*)((q < 2 ? P.UB8 : P.VB8) + (size_t)(r + (q & 1)) * D_MODEL + 16 * lane) = o; } }
    for (int i = gw * 64 + lane; i < NPOS * 32; i += NGW * 64) { const int pos = i >> 5, d = i & 31; const double inv = exp2(-(double)d * (13.287712379549449 / 32.0)); const double turns = (double)pos * inv * 0.15915494309189535;
        const float fr = (float)(turns - floor(turns)); P.ROPE[pos * 64 + d] = __builtin_amdgcn_cosf(fr); P.ROPE[pos * 64 + 32 + d] = __builtin_amdgcn_sinf(fr); }
    for (int i = gw; i < 2 * CMP_HIDDEN; i += NGW) { const int ty = i / CMP_HIDDEN, hid = i % CMP_HIDDEN; float a = 0.f;
#pragma unroll 8
        for (int k = lane; k < CMP_BLOCK * HEAD_DIM; k += 64) a += P.cmp_pe[ty * CMP_BLOCK * HEAD_DIM + k] * P.cmp_w1[((size_t)ty * CMP_BLOCK * HEAD_DIM + k) * CMP_HIDDEN + hid];
        a = wave_sum(a); if (lane == 0) P.CBIAS[i] = a; }
    for (int it = gw; it < DEC_BATCH * (PAST_LEN / PAGE_SIZE); it += NGW) { const int n = it / (PAST_LEN / PAGE_SIZE), pi = it % (PAST_LEN / PAGE_SIZE); const int pg = P.page_table[it];
        const float* src = P.cache_nsa_kv + (size_t)pg * PAGE_SIZE * 512 + 4 * lane; const int ty = lane >> 5, kvh = (lane >> 4) & 1, d = (4 * lane) & 63;
        bf16* dst = P.AC + ((size_t)ty * ACROWS + ((size_t)(BATCH + n) * NSA_KV_HEADS + kvh) * NCH + pi * (PAGE_SIZE / 16)) * 1024 + d;
#pragma unroll 1
        for (int r0 = 0; r0 < PAGE_SIZE; r0 += 8) { f32x4 v[8];
#pragma unroll
            for (int u = 0; u < 8; ++u) v[u] = *(const f32x4*)(src + (size_t)(r0 + u) * 512);
#pragma unroll
            for (int u = 0; u < 8; ++u) { const int t = r0 + u; u32x2 o; o.x = pk2(v[u].x, v[u].y); o.y = pk2(v[u].z, v[u].w); *(u32x2*)(dst + (size_t)(t / 16) * 1024 + (t % 16) * 64) = o; } } }
    for (int g = 0; g < 4; ++g) { const int W = g < 3 ? dil_w(g) : SWA_WINDOW, RV = g < 3 ? 128 : 64;
        const f32x4* src = (const f32x4*)(g < 3 ? sel3c(P.cache_dil, g) : P.cache_nsa_win); f32x4* dst = (f32x4*)(g < 3 ? sel3(P.dil_s, g) : P.win_s);
        const long per = (long)(W - 1) * RV, nvec = (long)DEC_BATCH * per;
#pragma unroll 1
        for (long i0 = (long)gw * 512; i0 < nvec; i0 += (long)NGW * 512) { f32x4 v[8]; long idx[8];
#pragma unroll
            for (int u = 0; u < 8; ++u) { const long i = i0 + u * 64 + lane; const long ii = i < nvec ? i : nvec - 1; const long n = ii / per, o = ii % per; idx[u] = n * (per + RV) + o; v[u] = src[idx[u] + RV]; }
#pragma unroll
            for (int u = 0; u < 8; ++u) { const long i = i0 + u * 64 + lane; if (i < nvec) dst[idx[u]] = v[u]; } } }
}
DI void p0_wpk(const FP& P, const Ctx& C) {
    LAS float* sw = (LAS float*)C.lds;
    LAS float* sk = (LAS float*)(C.lds + 32768);
    constexpr int NIT = DEPTH * 16 * (D_MODEL / 64);
    for (int it = C.vcu; it < NIT; it += C.G) { const int l = it / (16 * (D_MODEL / 64)), rem = it % (16 * (D_MODEL / 64)), hc = rem / (D_MODEL / 64), kb = rem % (D_MODEL / 64);
        __syncthreads();
        for (int i = C.tid; i < 64 * 64; i += NTHREADS) { const int r = i >> 6, d = i & 63; sw[r * 65 + d] = P.peer_wq[((size_t)l * D_MODEL + kb * 64 + r) * 1024 + hc * 64 + d]; }
        for (int i = C.tid; i < 128 * 64; i += NTHREADS) { const int r = i >> 6, d = i & 63; sk[r * 65 + d] = P.peer_keys[(((size_t)l * 16 + hc) * PEER_KEYS + r) * 64 + d]; }
        __syncthreads();
        for (int o = C.tid; o < 128 * 64; o += NTHREADS) { const int kk = o >> 6, ki = o & 63; float a = 0.f;
#pragma unroll 16
            for (int d = 0; d < 64; ++d) a += sw[ki * 65 + d] * sk[kk * 65 + d];
            P.WPK_T[((size_t)l * NPK + hc * 128 + kk) * D_MODEL + kb * 64 + ki] = (bf16)f2bf(a); } }
    __syncthreads();
}

#define EPI_LOOP(...) int fr_l = fr, fq_l = fq; asm volatile("" : "+v"(fr_l), "+v"(fq_l));     \
    _Pragma("unroll") for (int ai = 0; ai < 2; ++ai) _Pragma("unroll") for (int m = 0; m < 4; ++m) { const int row = u.pm * 256 + ai * 128 + wr * 64 + m * 16 + fr_l; \
    _Pragma("unroll") for (int bj = 0; bj < 2; ++bj) { const int ct = bj * 128 + wc * 32 + fq_l * 8; const f32x4 v0 = acc[ai][bj][m][0], v1 = acc[ai][bj][m][1]; __VA_ARGS__ } asm volatile("" ::: "memory"); }
DI void rope4(const float* rope_row, int dp, const f32x4& v0, const f32x4& v1, f32x4& lo, f32x4& hi) {
    const f32x4 c = *(const f32x4*)(rope_row + dp), s = *(const f32x4*)(rope_row + 32 + dp);
    lo.x = v0.x * c.x - v0.y * s.x; hi.x = v0.y * c.x + v0.x * s.x; lo.y = v0.z * c.y - v0.w * s.y; hi.y = v0.w * c.y + v0.z * s.y;
    lo.z = v1.x * c.z - v1.y * s.z; hi.z = v1.y * c.z + v1.x * s.z; lo.w = v1.z * c.w - v1.w * s.w; hi.w = v1.w * c.w + v1.z * s.w; }
DI u32x2 pk4(const f32x4& v) { u32x2 o; o.x = pk2(v.x, v.y); o.y = pk2(v.z, v.w); return o; }
DI u32x4 pk8(const f32x4& a, const f32x4& b) { u32x4 o; o.x = pk2(a.x, a.y); o.y = pk2(a.z, a.w); o.z = pk2(b.x, b.y); o.w = pk2(b.z, b.w); return o; }
DI int dil_perm(int t, int d) { return (t % d) * (SEQ / d) + t / d; }
struct EpiA {
    static constexpr bool PERM = true, AFTER_DRAIN = false; const FP& P;
    DI void operator()(const f32x4 (&acc)[2][2][4][2], const pg8::Unit& u, int wr, int wc, int fr, int fq) const {
        const int t9 = u.pn; const int g = t9 / 3, j = t9 % 3;
        EPI_LOOP({ if (row < MP) { const int h = ct >> 6, e = ct & 63; const int pos = row_pos(row);
            if (t9 == 9) { *(u32x4*)(P.MQA + (size_t)row * 256 + ct) = pk8(v0 * QSCALE, v1 * QSCALE); }
            else if (j < 2) { f32x4 lo, hi; const int dp = e >> 1; rope4(P.ROPE + pos * 64, dp, v0, v1, lo, hi);
                if (j == 0) { bf16* q = P.QA + ((size_t)g * MPAD + row) * 256 + h * 64 + dp; *(u32x2*)q = pk4(lo * QSCALE); *(u32x2*)(q + 32) = pk4(hi * QSCALE); }
                else { if (row < M0) { bf16* kt = P.KA + ((size_t)(g * BATCH + row / SEQ) * DIL_HEADS + h) * 64 * SEQ; const int cm = dil_perm(pos, dil_d(g)); *(u32x2*)(kt + ktile_off(cm, dp)) = pk4(lo); *(u32x2*)(kt + ktile_off(cm, dp + 32)) = pk4(hi); }
                    const int W = dil_w(g); float* o = nullptr;
                    if (row >= M0) o = sel3(P.dil_s, g) + (((size_t)(row - M0) * W + W - 1) * 2 + 0) * 256; else if (pos >= SEQ - W) o = sel3(P.dil_p, g) + (((size_t)(row / SEQ) * W + pos - (SEQ - W)) * 2 + 0) * 256;
                    if (o) { *(f32x4*)(o + h * 64 + dp) = lo; *(f32x4*)(o + h * 64 + 32 + dp) = hi; } } }
            else { const int W = dil_w(g), d = dil_d(g); float* o = nullptr;
                if (row >= M0) o = sel3(P.dil_s, g) + (((size_t)(row - M0) * W + W - 1) * 2 + 1) * 256; else if (pos >= SEQ - W) o = sel3(P.dil_p, g) + (((size_t)(row / SEQ) * W + pos - (SEQ - W)) * 2 + 1) * 256;
                if (o) { *(f32x4*)(o + ct) = v0; *(f32x4*)(o + ct + 4) = v1; }
                if (row < M0) { bf16* vt = P.VTA + ((size_t)(g * BATCH + row / SEQ) * DIL_HEADS + h) * 64 * SEQ + vtile_off(e, dil_perm(pos, d));
                    vt[0] = (bf16)f2bf(v0.x); vt[8] = (bf16)f2bf(v0.y); vt[16] = (bf16)f2bf(v0.z); vt[24] = (bf16)f2bf(v0.w); vt[32] = (bf16)f2bf(v1.x); vt[40] = (bf16)f2bf(v1.y); vt[48] = (bf16)f2bf(v1.z); vt[56] = (bf16)f2bf(v1.w); } } } })
    }
};
struct EpiMem {
    static constexpr bool PERM = true, AFTER_DRAIN = false; const FP& P;
    DI void operator()(const f32x4 (&acc)[2][2][4][2], const pg8::Unit& u, int wr, int wc, int fr, int fq) const {
        const int l = u.pn >> 1, half = u.pn & 1;
        EPI_LOOP({ const int n = row / MEM_TOKENS, mt = row % MEM_TOKENS; float* o = P.mem_kv_p + (((size_t)l * BATCH + n) * MEM_TOKENS + mt) * 512 + half * 256 + ct; *(f32x4*)o = v0; *(f32x4*)(o + 4) = v1;
            if (half == 0) *(u32x4*)(P.MK + (((size_t)l * BATCH + n) * MEM_HEADS + (ct >> 6)) * MEM_TOKENS * 64 + ktile_off(mt, ct & 63)) = pk8(v0, v1);
            else { bf16* vt = P.MVT + (((size_t)l * BATCH + n) * MEM_HEADS + (ct >> 6)) * MEM_TOKENS * 64 + vtile_off(ct & 63, mt);
                vt[0] = (bf16)f2bf(v0.x); vt[8] = (bf16)f2bf(v0.y); vt[16] = (bf16)f2bf(v0.z); vt[24] = (bf16)f2bf(v0.w); vt[32] = (bf16)f2bf(v1.x); vt[40] = (bf16)f2bf(v1.y); vt[48] = (bf16)f2bf(v1.z); vt[56] = (bf16)f2bf(v1.w); } })
    }
};
struct EpiPre {
    static constexpr bool PERM = true, AFTER_DRAIN = false; const float* xa; const float* xb; float* pre;
    DI void operator()(const f32x4 (&acc)[2][2][4][2], const pg8::Unit& u, int wr, int wc, int fr, int fq) const {
        EPI_LOOP({ if (row < MP) { const int col = u.pn * 256 + ct; const float* x = (xb && row >= M0) ? xb + (size_t)(row - M0) * D_MODEL + col : xa + (size_t)row * D_MODEL + col;
            const f32x4 a = *(const f32x4*)x, b = *(const f32x4*)(x + 4); float* o = pre + (size_t)row * D_MODEL + col; *(f32x4*)o = a * ALPHA + v0; *(f32x4*)(o + 4) = b * ALPHA + v1; } })
    }
};
struct EpiF32 {
    static constexpr bool PERM = true, AFTER_DRAIN = false; float* out; int ldc; int nrows;
    DI void operator()(const f32x4 (&acc)[2][2][4][2], const pg8::Unit& u, int wr, int wc, int fr, int fq) const {
        EPI_LOOP({ if (row < nrows) { float* o = out + (size_t)row * ldc + u.pn * 256 + ct; *(f32x4*)o = v0; *(f32x4*)(o + 4) = v1; } })
    }
};
}
namespace fx {
struct Tile16 { f32x4 o[4]; float m, l; };
DI void tile_init(Tile16& T) { T.o[0] = T.o[1] = T.o[2] = T.o[3] = (f32x4){0.f, 0.f, 0.f, 0.f}; T.m = -INFINITY; T.l = 0.f; }
typedef __bf16 bf16x2_t __attribute__((ext_vector_type(2)));
DI unsigned cvtpk(float lo, float hi) { const f32x2 v = {lo, hi}; const bf16x2_t b = __builtin_convertvector(v, bf16x2_t); return __builtin_bit_cast(unsigned, b); }
struct KV8 { bf16x8 ka0, ka1, kb0, kb1, v0, v1, v2, v3; };
DI void kv_load(KV8& r, const bf16* k0, const bf16* k1, const bf16* v, long vs16) {
    r.ka0 = *(const bf16x8*)k0; r.ka1 = *(const bf16x8*)(k0 + 32); r.kb0 = *(const bf16x8*)k1; r.kb1 = *(const bf16x8*)(k1 + 32);
    r.v0 = *(const bf16x8*)v; r.v1 = *(const bf16x8*)(v + vs16); r.v2 = *(const bf16x8*)(v + 2 * vs16); r.v3 = *(const bf16x8*)(v + 3 * vs16); }
template <class MaskF> DI void tile_compute(Tile16& T, const bf16x8 (&qf)[2], const KV8& r, MaskF mask) {
    f32x4 s0 = (f32x4){0.f, 0.f, 0.f, 0.f}, s1 = (f32x4){0.f, 0.f, 0.f, 0.f};
    s0 = __builtin_amdgcn_mfma_f32_16x16x32_bf16(r.ka0, qf[0], s0, 0, 0, 0); s0 = __builtin_amdgcn_mfma_f32_16x16x32_bf16(r.ka1, qf[1], s0, 0, 0, 0);
    s1 = __builtin_amdgcn_mfma_f32_16x16x32_bf16(r.kb0, qf[0], s1, 0, 0, 0); s1 = __builtin_amdgcn_mfma_f32_16x16x32_bf16(r.kb1, qf[1], s1, 0, 0, 0);
    float s[8] = {s0.x, s0.y, s0.z, s0.w, s1.x, s1.y, s1.z, s1.w};
    float mx = -INFINITY;
#pragma unroll
    for (int e = 0; e < 8; ++e) { s[e] = mask(e) ? s[e] : -INFINITY; mx = fmaxf(mx, s[e]); }
    mx = fmaxf(mx, __shfl_xor(mx, 16)); mx = fmaxf(mx, __shfl_xor(mx, 32));
    const float mnew = fmaxf(T.m, mx), muse = (mnew == -INFINITY) ? 0.f : mnew;
    const float alpha = __builtin_amdgcn_exp2f(T.m - muse);
    float ls = 0.f;
#pragma unroll
    for (int e = 0; e < 8; ++e) { s[e] = __builtin_amdgcn_exp2f(s[e] - muse); ls += s[e]; }
    ls += __shfl_xor(ls, 16); ls += __shfl_xor(ls, 32);
    T.l = T.l * alpha + ls; T.m = mnew;
    u32x4 pw; pw.x = cvtpk(s[0], s[1]); pw.y = cvtpk(s[2], s[3]); pw.z = cvtpk(s[4], s[5]); pw.w = cvtpk(s[6], s[7]);
    const bf16x8 pf = __builtin_bit_cast(bf16x8, pw);
    T.o[0] = __builtin_amdgcn_mfma_f32_16x16x32_bf16(r.v0, pf, T.o[0] * alpha, 0, 0, 0); T.o[1] = __builtin_amdgcn_mfma_f32_16x16x32_bf16(r.v1, pf, T.o[1] * alpha, 0, 0, 0);
    T.o[2] = __builtin_amdgcn_mfma_f32_16x16x32_bf16(r.v2, pf, T.o[2] * alpha, 0, 0, 0); T.o[3] = __builtin_amdgcn_mfma_f32_16x16x32_bf16(r.v3, pf, T.o[3] * alpha, 0, 0, 0);
}
template <class LD, class CP> DI void pipe2(int n, LD ld, CP cp) { if (n <= 0) return; KV8 A, B; ld(A, 0);
#pragma unroll 1
    for (int i = 0; i < n; i += 2) { ld(B, (i + 1 < n) ? i + 1 : i); cp(A, i); ld(A, (i + 2 < n) ? i + 2 : i); if (i + 1 < n) cp(B, i + 1); } }
DI void kv_load_t(KV8& r, const bf16* kt, const bf16* vt, int lane) {
    const bf16* k = kt + lane * 8; const bf16* v = vt + lane * 8;
    r.ka0 = *(const bf16x8*)k; r.ka1 = *(const bf16x8*)(k + 512); r.kb0 = *(const bf16x8*)(k + 1024); r.kb1 = *(const bf16x8*)(k + 1536);
    r.v0 = *(const bf16x8*)v; r.v1 = *(const bf16x8*)(v + 512); r.v2 = *(const bf16x8*)(v + 1024); r.v3 = *(const bf16x8*)(v + 1536); }
DI int krow_of(int i, int b) { return 8 * (i >> 2) + 4 * b + (i & 3); }

DI void dil_micro(const FP& P, int n, int h, int t0, int mt, int lane) {
    const int g = mt >> 4, idx = mt & 15, d = dil_d(g), per = 16 / d;
    const int r = idx / per, sub = idx % per, i0 = t0 / d + 16 * sub, ib = i0 - 128, NC = SEQ / d;
    const int q = lane & 15, c = lane >> 4;
    const bf16* Qb = P.QA + ((size_t)g * MPAD + (size_t)n * SEQ) * 256 + h * 64;
    const bf16* Kb = P.KA + ((size_t)(g * BATCH + n) * DIL_HEADS + h) * 64 * SEQ + (size_t)r * NC * 64; const bf16* Vb = P.VTA + ((size_t)(g * BATCH + n) * DIL_HEADS + h) * 64 * SEQ + (size_t)r * NC * 64;
    bf16x8 qf[2]; { const bf16* qp = Qb + (size_t)(r + d * (i0 + q)) * 256 + 8 * c; qf[0] = *(const bf16x8*)qp; qf[1] = *(const bf16x8*)(qp + 32); }
    Tile16 T; tile_init(T);
    const int qi = i0 + q; const int tb0 = ib >> 5  , nblk = ((i0 + 15) >> 5) - tb0 + 1;
    pipe2(nblk, [&](KV8& kv, int i) { int tb = tb0 + i; tb = tb < 0 ? 0 : tb; kv_load_t(kv, Kb + (size_t)tb * 2048, Vb + (size_t)tb * 2048, lane); },
          [&](const KV8& kv, int i) { const int kb = 32 * (tb0 + i); tile_compute(T, qf, kv, [&](int e) { const int ki = kb + 8 * c + e; return ki >= 0 && ki <= qi && qi - ki <= DIL_TAPS - 1; }); });
    const int row = n * SEQ + r + d * qi;
    float* op = P.DPART + (((size_t)g * MP + row) * DIL_HEADS + h) * 64 + 4 * c;
#pragma unroll
    for (int db = 0; db < 4; ++db) *(f32x4*)(op + 16 * db) = T.o[db];
    if (c == 0) { float* ml = P.DML + (((size_t)g * MP + row) * DIL_HEADS + h) * 2; ml[0] = T.m; ml[1] = T.l; }
}
DI void mem_micro(const FP& P, const bf16* Q  , int ldq, int row0, int layer, int n, int h, bf16* O  , int ldo, int lane) {
    const int q = lane & 15, c = lane >> 4;
    bf16x8 qf[2]; { const bf16* qp = Q + (size_t)(row0 + q) * ldq + 8 * c; qf[0] = *(const bf16x8*)qp; qf[1] = *(const bf16x8*)(qp + 32); }
    const bf16* Kb = P.MK + (((size_t)layer * BATCH + n) * MEM_HEADS + h) * MEM_TOKENS * 64; const bf16* Vb = P.MVT + (((size_t)layer * BATCH + n) * MEM_HEADS + h) * MEM_TOKENS * 64;
    Tile16 T; tile_init(T);
    pipe2(MEM_TOKENS / 32, [&](KV8& kv, int i) { kv_load_t(kv, Kb + (size_t)i * 2048, Vb + (size_t)i * 2048, lane); }, [&](const KV8& kv, int) { tile_compute(T, qf, kv, [&](int) { return true; }); });
    const float inv = 1.0f / T.l; bf16* op = O + (size_t)(row0 + q) * ldo + 4 * c;
#pragma unroll
    for (int db = 0; db < 4; ++db) *(u32x2*)(op + 16 * db) = pk4(T.o[db] * inv);
}
struct Dec { float m, l, o; };
template <class KF, class VF> DI void dec_chunk(Dec& D, const LAS float* q, int nk, KF kf, VF vf, int lane) {
    float s = -INFINITY;
    if (lane < nk) { const float* k = kf(lane); float a = 0.f;
#pragma unroll
        for (int d4 = 0; d4 < 16; ++d4) { const f32x4 kv = *(const f32x4*)(k + 4 * d4); a += kv.x * q[4 * d4] + kv.y * q[4 * d4 + 1] + kv.z * q[4 * d4 + 2] + kv.w * q[4 * d4 + 3]; }
        s = a; }
    const float mx = wave_max(s), mnew = fmaxf(D.m, mx), alpha = __builtin_amdgcn_exp2f(D.m - mnew);
    const float p = (lane < nk) ? __builtin_amdgcn_exp2f(s - mnew) : 0.f;
    D.l = D.l * alpha + wave_sum(p); D.m = mnew; float o = D.o * alpha;
    for (int j0 = 0; j0 < nk; j0 += 8) { float vv[8];
#pragma unroll
        for (int u = 0; u < 8; ++u) { const int jj = (j0 + u < nk) ? j0 + u : nk - 1; vv[u] = vf(jj)[lane]; }
#pragma unroll
        for (int u = 0; u < 8; ++u) { const float pj = (j0 + u < nk) ? __builtin_bit_cast(float, __builtin_amdgcn_readlane(__builtin_bit_cast(int, p), (j0 + u) & 63)) : 0.f; o += pj * vv[u]; } }
    D.o = o;
}
DI void atta_phase(const FP& P, const Ctx& C) {
    const int lane = C.lane, w = C.wave;
    constexpr int NT = SEQ / 256, NIT = BATCH * NT * DIL_HEADS;
    for (int it = C.vcu; it < NIT; it += C.G) { const int h = it % DIL_HEADS, tt = (it / DIL_HEADS) % NT, n = it / (DIL_HEADS * NT), t0 = tt * 256;
        for (int mt = w; mt < 48; mt += NWAVES) dil_micro(P, n, h, t0, mt, lane);
        asm volatile("s_waitcnt vmcnt(0)" ::: "memory"); __syncthreads();
        for (int i = C.tid; i < 256 * 16; i += NTHREADS) { const int tk = i >> 4, d4 = (i & 15) * 4; const int row = n * SEQ + t0 + tk;
            float mg[3], lg[3]; float M = -INFINITY;
#pragma unroll
            for (int g = 0; g < 3; ++g) { const float* ml = P.DML + (((size_t)g * MP + row) * DIL_HEADS + h) * 2; mg[g] = ml[0]; lg[g] = ml[1]; M = fmaxf(M, mg[g]); }
            f32x4 acc = (f32x4){0.f, 0.f, 0.f, 0.f}; float L = 0.f;
#pragma unroll
            for (int g = 0; g < 3; ++g) { const float wg = __builtin_amdgcn_exp2f(mg[g] - M); L += wg * lg[g]; acc += *(const f32x4*)(P.DPART + (((size_t)g * MP + row) * DIL_HEADS + h) * 64 + d4) * wg; }
            *(u32x2*)(P.ATTA + (size_t)row * 512 + h * 64 + d4) = pk4(acc * (1.0f / L)); }
        for (int mt = w; mt < 16; mt += NWAVES) mem_micro(P, P.MQA + h * 64, 256, n * SEQ + t0 + 16 * mt, 0, n, h, P.ATTA + 256 + h * 64, 512, lane);
        __syncthreads();
    }
    LAS float* qs = (LAS float*)(C.lds + w * 1024);
    const int gw = C.vcu * NWAVES + w, NGW = C.G * NWAVES;
    for (int it = gw; it < DEC_BATCH * DIL_HEADS * 2; it += NGW) { const int kind = it & 1, h = (it >> 1) % DIL_HEADS, ns = (it >> 1) / DIL_HEADS, row = M0 + ns;
        Dec D; D.m = -INFINITY; D.l = 0.f; D.o = 0.f;
        if (kind == 0) {
            for (int g = 0; g < 3; ++g) qs[g * 64 + lane] = bf2f(P.QA[((size_t)g * MPAD + row) * 256 + h * 64 + lane]);
            asm volatile("s_waitcnt lgkmcnt(0)" ::: "memory");
            for (int g = 0; g < 3; ++g) { const int W = dil_w(g), d = dil_d(g); const float* cache = sel3c(P.cache_dil, g) + (size_t)ns * W * 512; const float* newrow = sel3(P.dil_s, g) + ((size_t)ns * W + W - 1) * 512;
                for (int j0 = 0; j0 < DIL_TAPS; j0 += 64) { const int nk = (DIL_TAPS - j0) < 64 ? (DIL_TAPS - j0) : 64;
                    dec_chunk(D, qs + g * 64, nk, [&](int j) { const int tap = j0 + j; return (tap == 0 ? newrow : cache + (size_t)(W - d * tap) * 512) + h * 64; },
                              [&](int j) { const int tap = j0 + j; return (tap == 0 ? newrow : cache + (size_t)(W - d * tap) * 512) + 256 + h * 64; }, lane); } }
            P.ATTA[(size_t)row * 512 + h * 64 + lane] = (bf16)f2bf(D.o / D.l);
        } else {
            qs[lane] = bf2f(P.MQA[(size_t)row * 256 + h * 64 + lane]);
            asm volatile("s_waitcnt lgkmcnt(0)" ::: "memory");
            const float* mk = P.cache_mem_kv + ((size_t)0 * DEC_BATCH + ns) * MEM_TOKENS * 512;
            for (int j0 = 0; j0 < MEM_TOKENS; j0 += 64) dec_chunk(D, qs, 64, [&](int j) { return mk + (size_t)(j0 + j) * 512 + h * 64; }, [&](int j) { return mk + (size_t)(j0 + j) * 512 + 256 + h * 64; }, lane);
            P.ATTA[(size_t)row * 512 + 256 + h * 64 + lane] = (bf16)f2bf(D.o / D.l);
        }
    }
    __syncthreads();
}
DI void ln_phase(const FP& P, const Ctx& C, const float* pre, const float* gam, const float* bet, float* xo, bf16* xb, float* yp, float* ys) {
    const int gw = C.vcu * NWAVES + C.wave, NGW = C.G * NWAVES, lane = C.lane;
    for (int r = gw; r < MP; r += NGW) { const float* x = pre + (size_t)r * D_MODEL; f32x4 v[4]; float s = 0.f;
#pragma unroll
        for (int j = 0; j < 4; ++j) { v[j] = *(const f32x4*)(x + 256 * j + 4 * lane); s += (v[j].x + v[j].y) + (v[j].z + v[j].w); }
        const float mu = wave_sum(s) * (1.0f / D_MODEL); float s2 = 0.f;
#pragma unroll
        for (int j = 0; j < 4; ++j) { v[j] = v[j] - mu; s2 += (v[j].x * v[j].x + v[j].y * v[j].y) + (v[j].z * v[j].z + v[j].w * v[j].w); }
        const float rs = 1.0f / sqrtf(wave_sum(s2) * (1.0f / D_MODEL) + LN_EPS);
#pragma unroll
        for (int j = 0; j < 4; ++j) { const f32x4 gg = *(const f32x4*)(gam + 256 * j + 4 * lane), bb = *(const f32x4*)(bet + 256 * j + 4 * lane); const f32x4 o = v[j] * rs * gg + bb;
            if (xo) *(f32x4*)(xo + (size_t)r * D_MODEL + 256 * j + 4 * lane) = o;
            if (xb) *(u32x2*)(xb + (size_t)r * D_MODEL + 256 * j + 4 * lane) = pk4(o);
            if (yp) { if (r < M0) *(f32x4*)(yp + (size_t)r * D_MODEL + 256 * j + 4 * lane) = o; else *(f32x4*)(ys + (size_t)(r - M0) * D_MODEL + 256 * j + 4 * lane) = o; } }
    }
}
}
namespace fx {
#define INS16(V, I, v_, i_) do { const float _v = (v_); const int _i = (i_); bool _c[16]; _Pragma("unroll") for (int _k = 0; _k < 16; ++_k) _c[_k] = _v > V[_k]; \
    _Pragma("unroll") for (int _k = 15; _k >= 1; --_k) { V[_k] = _c[_k] ? (_c[_k - 1] ? V[_k - 1] : _v) : V[_k]; I[_k] = _c[_k] ? (_c[_k - 1] ? I[_k - 1] : _i) : I[_k]; } \
    V[0] = _c[0] ? _v : V[0]; I[0] = _c[0] ? _i : I[0]; } while (0)
DI void wave_top16_128(float a, float b, int lane, float& outv, int& outi) {
    outv = -INFINITY; outi = 0;
#pragma unroll 1
    for (int k = 0; k < 16; ++k) { const float m = wave_max(fmaxf(a, b)); const unsigned long long ba = __ballot(a == m), bb = __ballot(b == m); int idx;
        if (ba) { const int l = __builtin_ctzll(ba); idx = l; if (lane == l) a = -INFINITY; } else { const int l = __builtin_ctzll(bb); idx = 64 + l; if (lane == l) b = -INFINITY; }
        if (lane == k) { outv = m; outi = idx; } }
}
DI void topk_wave_item(const FP& P, long it, int lane) {
    const float* s = P.SCO + it * 256; float v1, v2; int i1, i2;
    wave_top16_128(s[lane], s[64 + lane], lane, v1, i1); wave_top16_128(s[128 + lane], s[192 + lane], lane, v2, i2);
    int a = 0, rem = lane; bool valid = false;
    for (int aa = 0; aa < 16; ++aa) { const int nb = 16 / (aa + 1); if (!valid) { if (rem < nb) { a = aa; valid = true; } else rem -= nb; } }
    const int b = valid ? rem : 0;
    float cs = __shfl(v1, a) + __shfl(v2, b); const int ce = __shfl(i1, a) * PEER_KEYS + __shfl(i2, b); if (!valid) cs = -INFINITY;
    float tv = -INFINITY; int te = 0;
#pragma unroll 1
    for (int k = 0; k < 16; ++k) { const float m = wave_max(cs); const unsigned long long bm = __ballot(cs == m); const int l = __builtin_ctzll(bm); const int e = __shfl(ce, l); if (lane == l) cs = -INFINITY; if (lane == k) { tv = m; te = e; } }
    const float mx = __shfl(tv, 0); const float ex = (lane < 16) ? __expf(tv - mx) : 0.f; const float z = wave_sum(ex);
    if (lane < 16) { P.SELG[it * 16 + lane] = ex / z; P.SELE[it * 16 + lane] = te; }
}
#define KINS16(V, key_) do { const float _key = (key_); _Pragma("unroll") for (int _k = 15; _k >= 1; --_k) V[_k] = __builtin_amdgcn_fmed3f(V[_k - 1], V[_k], _key); V[0] = fmaxf(V[0], _key); } while (0)
DI float pack_key(float v, unsigned lowbits, unsigned mask) { return __builtin_bit_cast(float, (__builtin_bit_cast(unsigned, v) & ~mask) | lowbits); }
DI void topk_phase(const FP& P, const Ctx& C) {
    const int lane = C.lane; LAS float* st = (LAS float*)(C.lds + C.wave * 16384);
    const int NWI = (M0 * PEER_HEADS) / 64;
    for (int wi = C.vcu * NWAVES + C.wave; wi < NWI; wi += C.G * NWAVES) {
        const long it0 = (long)wi * 64; const long it = it0 + lane;
        float V1[16], V2[16], V3[16];
#pragma unroll
        for (int k = 0; k < 16; ++k) { V1[k] = V2[k] = V3[k] = -INFINITY; }
#pragma unroll 1
        for (int ch = 0; ch < 8; ++ch) {
#pragma unroll
            for (int u = 0; u < 8; ++u) { const int f4 = u * 64 + lane, j = f4 >> 3, q = f4 & 7, hf = q >> 2, c4 = (q & 3) * 4; const long itj = it0 + j;
                const f32x4 v = *(const f32x4*)(P.SCO + itj * 256 + hf * 128 + ch * 16 + c4);
                st[j * 33 + hf * 16 + c4] = v.x; st[j * 33 + hf * 16 + c4 + 1] = v.y; st[j * 33 + hf * 16 + c4 + 2] = v.z; st[j * 33 + hf * 16 + c4 + 3] = v.w; }
            asm volatile("s_waitcnt lgkmcnt(0)" ::: "memory");
#pragma unroll 4
            for (int c = 0; c < 16; ++c) { const float va = st[lane * 33 + c], vb = st[lane * 33 + 16 + c]; const unsigned lb = 127u - (unsigned)(ch * 16 + c); KINS16(V1, pack_key(va, lb, 127u)); KINS16(V2, pack_key(vb, lb, 127u)); }
            asm volatile("s_waitcnt lgkmcnt(0)" ::: "memory");
        }
        LAS int* lc = (LAS int*)st;
        { int ord = 0;
#pragma unroll
          for (int a = 0; a < 16; ++a) { const unsigned ba = __builtin_bit_cast(unsigned, V1[a]); const float va = __builtin_bit_cast(float, ba & ~127u); const int ia = 127 - (int)(ba & 127u);
#pragma unroll
              for (int b = 0; b < 16; ++b) if ((a + 1) * (b + 1) <= 16) { const unsigned bb = __builtin_bit_cast(unsigned, V2[b]); const float vb = __builtin_bit_cast(float, bb & ~127u); const int ib = 127 - (int)(bb & 127u);
                  lc[lane * 51 + ord] = ia * PEER_KEYS + ib; KINS16(V3, pack_key(va + vb, 63u - (unsigned)ord, 63u)); ++ord; } } }
        asm volatile("s_waitcnt lgkmcnt(0)" ::: "memory");
        float g[16]; int e[16]; float z = 0.f; const float vmax = __builtin_bit_cast(float, __builtin_bit_cast(unsigned, V3[0]) & ~63u);
#pragma unroll
        for (int k = 0; k < 16; ++k) { const unsigned bk = __builtin_bit_cast(unsigned, V3[k]); e[k] = lc[lane * 51 + 63 - (int)(bk & 63u)]; g[k] = __expf(__builtin_bit_cast(float, bk & ~63u) - vmax); z += g[k]; }
        const float iz = 1.0f / z;
#pragma unroll
        for (int k4 = 0; k4 < 4; ++k4) { *(f32x4*)(P.SELG + it * 16 + 4 * k4) = (f32x4){g[4 * k4] * iz, g[4 * k4 + 1] * iz, g[4 * k4 + 2] * iz, g[4 * k4 + 3] * iz};
            *(int4*)(P.SELE + it * 16 + 4 * k4) = make_int4(e[4 * k4], e[4 * k4 + 1], e[4 * k4 + 2], e[4 * k4 + 3]); }
        asm volatile("s_waitcnt lgkmcnt(0)" ::: "memory");
    }
    for (int si = C.vcu * NWAVES + C.wave; si < DEC_BATCH * PEER_HEADS; si += C.G * NWAVES) topk_wave_item(P, (long)M0 * PEER_HEADS + si, lane);
    __syncthreads();
}
constexpr float PEER_SU = 256.f, PEER_SV = 64.f;
DI float dot16_fp8(const u32x4& w, const f32x2 (&x2)[8]) { f32x2 a = {0.f, 0.f};
    a += __builtin_amdgcn_cvt_pk_f32_fp8((int)w.x, false) * x2[0]; a += __builtin_amdgcn_cvt_pk_f32_fp8((int)w.x, true) * x2[1];
    a += __builtin_amdgcn_cvt_pk_f32_fp8((int)w.y, false) * x2[2]; a += __builtin_amdgcn_cvt_pk_f32_fp8((int)w.y, true) * x2[3];
    a += __builtin_amdgcn_cvt_pk_f32_fp8((int)w.z, false) * x2[4]; a += __builtin_amdgcn_cvt_pk_f32_fp8((int)w.z, true) * x2[5];
    a += __builtin_amdgcn_cvt_pk_f32_fp8((int)w.w, false) * x2[6]; a += __builtin_amdgcn_cvt_pk_f32_fp8((int)w.w, true) * x2[7];
    return a.x + a.y; }
DI void axpy16_fp8(const u32x4& w, float s, f32x2 (&o2)[8]) { const f32x2 s2 = {s, s};
    o2[0] += __builtin_amdgcn_cvt_pk_f32_fp8((int)w.x, false) * s2; o2[1] += __builtin_amdgcn_cvt_pk_f32_fp8((int)w.x, true) * s2;
    o2[2] += __builtin_amdgcn_cvt_pk_f32_fp8((int)w.y, false) * s2; o2[3] += __builtin_amdgcn_cvt_pk_f32_fp8((int)w.y, true) * s2;
    o2[4] += __builtin_amdgcn_cvt_pk_f32_fp8((int)w.z, false) * s2; o2[5] += __builtin_amdgcn_cvt_pk_f32_fp8((int)w.z, true) * s2;
    o2[6] += __builtin_amdgcn_cvt_pk_f32_fp8((int)w.w, false) * s2; o2[7] += __builtin_amdgcn_cvt_pk_f32_fp8((int)w.w, true) * s2; }
DI float rdlane(float v, int l) { return __builtin_bit_cast(float, __builtin_amdgcn_readlane(__builtin_bit_cast(int, v), l)); }
DI void peer_phase(const FP& P, const Ctx& C, int layer, const float* xin, float* fout, float* fout_s, bf16* xb) {
    const int lane = C.lane; const unsigned char* U = P.UB8 + (size_t)layer * PEER_EXPERTS * D_MODEL; const unsigned char* Vt = P.VB8 + (size_t)layer * PEER_EXPERTS * D_MODEL;
    const float* gam = P.ln_g + ((size_t)layer * 2 + 1) * D_MODEL; const float* bet = P.ln_b + ((size_t)layer * 2 + 1) * D_MODEL;
    const int nrounds = (M0 + C.G * NWAVES - 1) / (C.G * NWAVES);
#pragma unroll 1
    for (int rd = 0; rd <= nrounds; ++rd) {
        const bool smp = (rd == nrounds); int r = smp ? M0 + C.vcu : rd * C.G * NWAVES + C.vcu * NWAVES + C.wave; if (smp ? (C.vcu >= DEC_BATCH) : (r >= M0)) continue;
        const int pb = smp ? 16 * C.wave : 0, pe = smp ? pb + 16 : 128;
        f32x2 x2[8], o2[8];
#pragma unroll
        for (int j = 0; j < 4; ++j) { const f32x4 a = *(const f32x4*)(xin + (size_t)r * D_MODEL + 16 * lane + 4 * j); x2[2 * j] = (f32x2){a.x, a.y}; x2[2 * j + 1] = (f32x2){a.z, a.w}; }
#pragma unroll
        for (int k = 0; k < 8; ++k) o2[k] = (f32x2){0.f, 0.f};
        const int e_l = P.SELE[(size_t)r * 128 + lane], e_h = P.SELE[(size_t)r * 128 + 64 + lane]; const float g_l = P.SELG[(size_t)r * 128 + lane], g_h = P.SELG[(size_t)r * 128 + 64 + lane];
#pragma unroll 1
        for (int b0 = pb; b0 < pe; b0 += 8) {
            u32x4 uw[8], vw[8];
#pragma unroll
            for (int k = 0; k < 8; ++k) { const int hk = b0 + k; const int e = (hk < 64) ? __builtin_amdgcn_readlane(e_l, hk & 63) : __builtin_amdgcn_readlane(e_h, hk & 63);
                uw[k] = *(const u32x4*)(U + (size_t)e * D_MODEL + 16 * lane); vw[k] = *(const u32x4*)(Vt + (size_t)e * D_MODEL + 16 * lane); }
            float d[8];
#pragma unroll
            for (int k = 0; k < 8; ++k) d[k] = dot16_fp8(uw[k], x2);
            float e4[4], e2[2], e1;
            { const bool hi = lane & 1;
#pragma unroll
              for (int i = 0; i < 4; ++i) { const float keep = hi ? d[4 + i] : d[i], send = hi ? d[i] : d[4 + i]; e4[i] = keep + __shfl_xor(send, 1); } }
            { const bool hi = lane & 2;
#pragma unroll
              for (int i = 0; i < 2; ++i) { const float keep = hi ? e4[2 + i] : e4[i], send = hi ? e4[i] : e4[2 + i]; e2[i] = keep + __shfl_xor(send, 2); } }
            { const bool hi = lane & 4; const float keep = hi ? e2[1] : e2[0], send = hi ? e2[0] : e2[1]; e1 = keep + __shfl_xor(send, 4); }
            e1 += __shfl_xor(e1, 8); e1 += __shfl_xor(e1, 16); e1 += __shfl_xor(e1, 32);
            const int myk = 4 * (lane & 1) + (lane & 2) + ((lane >> 2) & 1); const int myhk = b0 + myk;
            const float myg = (myhk < 64) ? __shfl(g_l, myhk & 63) : __shfl(g_h, myhk & 63);
            const float act = myg * gelu_tanh(e1 * (1.0f / PEER_SU)) * (1.0f / PEER_SV);
#pragma unroll
            for (int k = 0; k < 8; ++k) { const int src = (k >> 2) | (((k >> 1) & 1) << 1) | ((k & 1) << 2); axpy16_fp8(vw[k], rdlane(act, src), o2); }
        }
        if (smp) {
            LAS float* red = (LAS float*)C.lds;
#pragma unroll
            for (int k = 0; k < 8; ++k) { red[C.wave * 1024 + 16 * lane + 2 * k] = o2[k].x; red[C.wave * 1024 + 16 * lane + 2 * k + 1] = o2[k].y; }
            asm volatile("s_waitcnt lgkmcnt(0)" ::: "memory"); __syncthreads();
            if (C.wave == 0) {
#pragma unroll
                for (int k = 0; k < 8; ++k) { float ax = 0.f, ay = 0.f;
#pragma unroll
                    for (int ww = 0; ww < NWAVES; ++ww) { ax += red[ww * 1024 + 16 * lane + 2 * k]; ay += red[ww * 1024 + 16 * lane + 2 * k + 1]; } o2[k] = (f32x2){ax, ay}; } }
            __syncthreads();
            if (C.wave != 0) continue; }
        float s = 0.f;
#pragma unroll
        for (int k = 0; k < 8; ++k) { o2[k] += x2[k] * ALPHA; s += o2[k].x + o2[k].y; }
        const float mu = wave_sum(s) * (1.0f / D_MODEL); float s2 = 0.f;
#pragma unroll
        for (int k = 0; k < 8; ++k) { o2[k] -= mu; s2 += o2[k].x * o2[k].x + o2[k].y * o2[k].y; }
        const float rs = 1.0f / sqrtf(wave_sum(s2) * (1.0f / D_MODEL) + LN_EPS);
        float* frow = (r < M0) ? fout + (size_t)r * D_MODEL : fout_s + (size_t)(r - M0) * D_MODEL;
#pragma unroll
        for (int j = 0; j < 4; ++j) { const int c0 = 16 * lane + 4 * j; const f32x4 gg = *(const f32x4*)(gam + c0), bb = *(const f32x4*)(bet + c0);
            const f32x4 y = (f32x4){o2[2 * j].x * rs, o2[2 * j].y * rs, o2[2 * j + 1].x * rs, o2[2 * j + 1].y * rs} * gg + bb;
            *(f32x4*)(frow + c0) = y; if (xb) *(u32x2*)(xb + (size_t)r * D_MODEL + c0) = pk4(y); }
    }
}
}
namespace fx {
struct EpiB {
    static constexpr bool PERM = true, AFTER_DRAIN = false; const FP& P;
    DI void operator()(const f32x4 (&acc)[2][2][4][2], const pg8::Unit& u, int wr, int wc, int fr, int fq) const {
        const int t = u.pn;
        EPI_LOOP({ if (row < MP) { const int pos = row_pos(row), n = row / SEQ, e = ct & 63, dp = e >> 1; const bool prm = row < M0;
            if (t < 3) { const int ty = 2 * t + (ct >> 7), kvh = (ct >> 6) & 1;
                if (ty == 2 || ty == 4) { f32x4 lo, hi; rope4(P.ROPE + pos * 64, dp, v0, v1, lo, hi);
                    if (ty == 2) { float* o = (prm ? P.nsa_kv_p + (size_t)row * 512 : P.nsa_kv_s + (size_t)(row - M0) * 512) + 256 + kvh * 64 + dp; *(f32x4*)o = lo; *(f32x4*)(o + 32) = hi;
                        if (prm) { bf16* kt = P.SLK + ((size_t)n * NSA_KV_HEADS + kvh) * SEQ * 64; *(u32x2*)(kt + ktile_off(pos, dp)) = pk4(lo); *(u32x2*)(kt + ktile_off(pos, dp + 32)) = pk4(hi); } }
                    else { float* o = nullptr; if (!prm) o = P.win_s + (((size_t)(row - M0) * SWA_WINDOW + SWA_WINDOW - 1) * 2 + 0) * 128; else if (pos >= SEQ - SWA_WINDOW) o = P.win_p + (((size_t)n * SWA_WINDOW + pos - (SEQ - SWA_WINDOW)) * 2 + 0) * 128;
                        if (o) { *(f32x4*)(o + kvh * 64 + dp) = lo; *(f32x4*)(o + kvh * 64 + 32 + dp) = hi; }
                        if (prm) { bf16* kt = P.WNK + ((size_t)n * NSA_KV_HEADS + kvh) * SEQ * 64; *(u32x2*)(kt + ktile_off(pos, dp)) = pk4(lo); *(u32x2*)(kt + ktile_off(pos, dp + 32)) = pk4(hi); } } }
                else if (ty < 4) { float* o = (prm ? P.nsa_kv_p + (size_t)row * 512 : P.nsa_kv_s + (size_t)(row - M0) * 512) + ty * 128 + kvh * 64 + e; *(f32x4*)o = v0; *(f32x4*)(o + 4) = v1;
                    if (prm) { if (ty < 2) *(u32x4*)(P.AC + ((size_t)ty * ACROWS + ((size_t)n * NSA_KV_HEADS + kvh) * NCH + pos / 16) * 1024 + (pos % 16) * 64 + e) = pk8(v0, v1);
                        else { bf16* vt = P.SLVT + ((size_t)n * NSA_KV_HEADS + kvh) * SEQ * 64 + vtile_off(e, pos);
                            vt[0] = (bf16)f2bf(v0.x); vt[8] = (bf16)f2bf(v0.y); vt[16] = (bf16)f2bf(v0.z); vt[24] = (bf16)f2bf(v0.w); vt[32] = (bf16)f2bf(v1.x); vt[40] = (bf16)f2bf(v1.y); vt[48] = (bf16)f2bf(v1.z); vt[56] = (bf16)f2bf(v1.w); } } }
                else { float* o = nullptr; if (!prm) o = P.win_s + (((size_t)(row - M0) * SWA_WINDOW + SWA_WINDOW - 1) * 2 + 1) * 128; else if (pos >= SEQ - SWA_WINDOW) o = P.win_p + (((size_t)n * SWA_WINDOW + pos - (SEQ - SWA_WINDOW)) * 2 + 1) * 128;
                    if (o) { *(f32x4*)(o + kvh * 64 + e) = v0; *(f32x4*)(o + kvh * 64 + e + 4) = v1; }
                    if (prm) { bf16* vt = P.WNVT + ((size_t)n * NSA_KV_HEADS + kvh) * SEQ * 64 + vtile_off(e, pos);
                        vt[0] = (bf16)f2bf(v0.x); vt[8] = (bf16)f2bf(v0.y); vt[16] = (bf16)f2bf(v0.z); vt[24] = (bf16)f2bf(v0.w); vt[32] = (bf16)f2bf(v1.x); vt[40] = (bf16)f2bf(v1.y); vt[48] = (bf16)f2bf(v1.z); vt[56] = (bf16)f2bf(v1.w); } } }
            else if (t < 6) { const int h = (t - 3) * 4 + (ct >> 6); f32x4 lo, hi; rope4(P.ROPE + pos * 64, dp, v0, v1, lo, hi); bf16* q = P.QB + (size_t)row * NSA_Q_COLS + h * 64 + dp; *(u32x2*)q = pk4(lo * QSCALE); *(u32x2*)(q + 32) = pk4(hi * QSCALE); }
            else if (t == 6) { *(u32x4*)(P.MQB + (size_t)row * 256 + ct) = pk8(v0 * QSCALE, v1 * QSCALE); }
            else if (ct < 40) { const float vv[8] = {v0.x, v0.y, v0.z, v0.w, v1.x, v1.y, v1.z, v1.w};
                _Pragma("unroll") for (int i = 0; i < 8; ++i) if (ct + i < NSA_GATE_COLS) P.GATES[(size_t)row * 64 + ct + i] = 1.0f / (1.0f + __expf(-vv[i])); } } })
    }
};
DI void cmp2_phase(const FP& P, const Ctx& C) {
    const int lane = C.lane; LAS float* hs = (LAS float*)(C.lds + C.wave * 1024);
    constexpr int NGRP = NCTX * 2 * NSA_KV_HEADS; const int NW = C.G * NWAVES, WPG = NW / NGRP > 0 ? NW / NGRP : 1; const int gw = C.vcu * NWAVES + C.wave;
#pragma unroll 1
    for (int grp = gw / WPG; grp < NGRP; grp += (NW + WPG - 1) / WPG) { const int slot = gw % WPG; if (gw >= (NW / WPG) * WPG && grp == gw / WPG) break;
        const int kvh = grp % NSA_KV_HEADS, ty = (grp / NSA_KV_HEADS) % 2, ctx = grp / (2 * NSA_KV_HEADS);
        const float* UL = P.UL + ((size_t)ty * ACROWS + ((size_t)ctx * NSA_KV_HEADS + kvh) * NCH) * 256; const float* w2 = P.cmp_w2 + (size_t)ty * CMP_HIDDEN * HEAD_DIM;
        float w2r[CMP_HIDDEN];
#pragma unroll
        for (int k = 0; k < CMP_HIDDEN; ++k) w2r[k] = w2[k * HEAD_DIM + lane];
        const float b0 = P.CBIAS[ty * CMP_HIDDEN + lane], b1 = P.CBIAS[ty * CMP_HIDDEN + 64 + lane];
        float u0, u1, l0, l1; int c = slot;
        if (c < NCMP) { u0 = UL[(size_t)c * 256 + lane]; u1 = UL[(size_t)c * 256 + 64 + lane]; l0 = UL[(size_t)(c + 1) * 256 + 128 + lane]; l1 = UL[(size_t)(c + 1) * 256 + 192 + lane]; }
#pragma unroll 1
        for (; c < NCMP; c += WPG) { const float h0 = gelu_tanh(u0 + l0 + b0), h1 = gelu_tanh(u1 + l1 + b1); const int cn = c + WPG;
            if (cn < NCMP) { u0 = UL[(size_t)cn * 256 + lane]; u1 = UL[(size_t)cn * 256 + 64 + lane]; l0 = UL[(size_t)(cn + 1) * 256 + 128 + lane]; l1 = UL[(size_t)(cn + 1) * 256 + 192 + lane]; }
            hs[lane] = h0; hs[64 + lane] = h1; asm volatile("s_waitcnt lgkmcnt(0)" ::: "memory");
            float a = 0.f;
#pragma unroll
            for (int k4 = 0; k4 < CMP_HIDDEN / 4; ++k4) { const f32x4 hv = *(const LAS f32x4*)(hs + 4 * k4); a += hv.x * w2r[4 * k4] + hv.y * w2r[4 * k4 + 1] + hv.z * w2r[4 * k4 + 2] + hv.w * w2r[4 * k4 + 3]; }
            if (ty == 0) { const float other = __shfl_xor(a, 32); const int pos = c * CMP_STRIDE + CMP_BLOCK - 1; const float cs = P.ROPE[pos * 64 + (lane & 31)], sn = P.ROPE[pos * 64 + 32 + (lane & 31)];
                a = (lane < 32) ? a * cs - other * sn : a * cs + other * sn; }
            if (ctx < BATCH) { if (ty == 0) P.CK[((size_t)ctx * NSA_KV_HEADS + kvh) * NCH * 64 + ktile_off(c, lane)] = (bf16)f2bf(a); else P.CVT[((size_t)ctx * NSA_KV_HEADS + kvh) * NCH * 64 + vtile_off(lane, c)] = (bf16)f2bf(a); }
            else { (ty == 0 ? P.CKF : P.CVF)[(((size_t)(ctx - BATCH) * NSA_KV_HEADS + kvh) * NCH + c) * 64 + lane] = a; }
            asm volatile("s_waitcnt lgkmcnt(0)" ::: "memory"); }
    }
    __syncthreads();
}
constexpr int NSA_WLDS = 8192;
DI void nsa_pair_a(const FP& P, int n, int kvh, int t, int lane, LAS unsigned char* wl) {
    LAS float* pn = (LAS float*)wl; LAS float* imp = (LAS float*)(wl + 2048); LAS float* sc = (LAS float*)(wl + 6144); LAS int* sel = (LAS int*)(wl + 7168);
    const int col = lane & 15, c = lane >> 4; const bool vcol = col < 12; const int qq = vcol ? col / 6 : 0, hh = vcol ? col % 6 : 0, tq = t + qq, head = kvh * NSA_GROUP + hh, row = n * SEQ + tq;
    bf16x8 qf[2]; { const bf16* qp = P.QB + (size_t)row * NSA_Q_COLS + head * 64 + 8 * c; qf[0] = *(const bf16x8*)qp; qf[1] = *(const bf16x8*)(qp + 32); }
    const float* gt = P.GATES + (size_t)row * 64 + head * 3;
    f32x4 oacc[4] = {(f32x4){0.f, 0.f, 0.f, 0.f}, (f32x4){0.f, 0.f, 0.f, 0.f}, (f32x4){0.f, 0.f, 0.f, 0.f}, (f32x4){0.f, 0.f, 0.f, 0.f}};
    const int lim = vcol ? ((tq >= CMP_BLOCK - 1) ? (tq - (CMP_BLOCK - 1)) / CMP_STRIDE : -1) : -1;
    const int limmax = (t + 1 >= CMP_BLOCK - 1) ? (t + 1 - (CMP_BLOCK - 1)) / CMP_STRIDE : -1; const int nblk = (limmax + 32) / 32;
    const bf16* CKb = P.CK + ((size_t)n * NSA_KV_HEADS + kvh) * NCH * 64; const bf16* CVb = P.CVT + ((size_t)n * NSA_KV_HEADS + kvh) * 64 * NCH;
    for (int i = lane; i < 1024; i += 64) imp[i] = 0.f;
    float m1 = -INFINITY, l1 = 0.f;
    { struct K4 { bf16x8 a0, a1, b0, b1; };
      auto ldk = [&](K4& k, int blk) { const bf16* kt = CKb + (size_t)blk * 2048 + lane * 8; k.a0 = *(const bf16x8*)kt; k.a1 = *(const bf16x8*)(kt + 512); k.b0 = *(const bf16x8*)(kt + 1024); k.b1 = *(const bf16x8*)(kt + 1536); };
      auto cp1 = [&](const K4& k, int blk) { const int kb = 32 * blk;
        f32x4 s0 = (f32x4){0.f, 0.f, 0.f, 0.f}, s1 = (f32x4){0.f, 0.f, 0.f, 0.f};
        s0 = __builtin_amdgcn_mfma_f32_16x16x32_bf16(k.a0, qf[0], s0, 0, 0, 0); s0 = __builtin_amdgcn_mfma_f32_16x16x32_bf16(k.a1, qf[1], s0, 0, 0, 0);
        s1 = __builtin_amdgcn_mfma_f32_16x16x32_bf16(k.b0, qf[0], s1, 0, 0, 0); s1 = __builtin_amdgcn_mfma_f32_16x16x32_bf16(k.b1, qf[1], s1, 0, 0, 0);
        float s[8] = {s0.x, s0.y, s0.z, s0.w, s1.x, s1.y, s1.z, s1.w}; float mx = -INFINITY;
#pragma unroll
        for (int e = 0; e < 8; ++e) { s[e] = (kb + 8 * c + e <= lim) ? s[e] : -INFINITY; mx = fmaxf(mx, s[e]); }
        mx = fmaxf(mx, __shfl_xor(mx, 16)); mx = fmaxf(mx, __shfl_xor(mx, 32));
        const float mnew = fmaxf(m1, mx), muse = (mnew == -INFINITY) ? 0.f : mnew; float ls = 0.f;
#pragma unroll
        for (int e = 0; e < 8; ++e) ls += __builtin_amdgcn_exp2f(s[e] - muse);
        ls += __shfl_xor(ls, 16); ls += __shfl_xor(ls, 32);
        l1 = l1 * __builtin_amdgcn_exp2f(m1 - muse) + ls; m1 = mnew; };
      if (nblk > 0) { K4 A, B; ldk(A, 0);
#pragma unroll 1
        for (int blk = 0; blk < nblk; blk += 2) { ldk(B, (blk + 1 < nblk) ? blk + 1 : blk); cp1(A, blk); ldk(A, (blk + 2 < nblk) ? blk + 2 : blk); if (blk + 1 < nblk) cp1(B, blk + 1); } } }
    asm volatile("s_waitcnt lgkmcnt(0)" ::: "memory");
    { const float muse = (m1 == -INFINITY) ? 0.f : m1, inv = (l1 > 0.f) ? 1.0f / l1 : 0.f;
      f32x4 oc[4] = {(f32x4){0.f, 0.f, 0.f, 0.f}, (f32x4){0.f, 0.f, 0.f, 0.f}, (f32x4){0.f, 0.f, 0.f, 0.f}, (f32x4){0.f, 0.f, 0.f, 0.f}};
      pipe2(nblk, [&](KV8& kv, int blk) { kv_load_t(kv, CKb + (size_t)blk * 2048, CVb + (size_t)blk * 2048, lane); }, [&](const KV8& kv, int blk) { const int kb = 32 * blk;
        f32x4 s0 = (f32x4){0.f, 0.f, 0.f, 0.f}, s1 = (f32x4){0.f, 0.f, 0.f, 0.f};
        s0 = __builtin_amdgcn_mfma_f32_16x16x32_bf16(kv.ka0, qf[0], s0, 0, 0, 0); s0 = __builtin_amdgcn_mfma_f32_16x16x32_bf16(kv.ka1, qf[1], s0, 0, 0, 0);
        s1 = __builtin_amdgcn_mfma_f32_16x16x32_bf16(kv.kb0, qf[0], s1, 0, 0, 0); s1 = __builtin_amdgcn_mfma_f32_16x16x32_bf16(kv.kb1, qf[1], s1, 0, 0, 0);
        float s[8] = {s0.x, s0.y, s0.z, s0.w, s1.x, s1.y, s1.z, s1.w};
#pragma unroll
        for (int e = 0; e < 8; ++e) s[e] = (kb + 8 * c + e <= lim) ? __builtin_amdgcn_exp2f(s[e] - muse) * inv : 0.f;
        *(f32x4*)(pn + col * 32 + 8 * c) = (f32x4){s[0], s[1], s[2], s[3]}; *(f32x4*)(pn + col * 32 + 8 * c + 4) = (f32x4){s[4], s[5], s[6], s[7]};
        u32x4 pw; pw.x = cvtpk(s[0], s[1]); pw.y = cvtpk(s[2], s[3]); pw.z = cvtpk(s[4], s[5]); pw.w = cvtpk(s[6], s[7]); const bf16x8 pf = __builtin_bit_cast(bf16x8, pw);
        oc[0] = __builtin_amdgcn_mfma_f32_16x16x32_bf16(kv.v0, pf, oc[0], 0, 0, 0); oc[1] = __builtin_amdgcn_mfma_f32_16x16x32_bf16(kv.v1, pf, oc[1], 0, 0, 0);
        oc[2] = __builtin_amdgcn_mfma_f32_16x16x32_bf16(kv.v2, pf, oc[2], 0, 0, 0); oc[3] = __builtin_amdgcn_mfma_f32_16x16x32_bf16(kv.v3, pf, oc[3], 0, 0, 0);
        asm volatile("s_waitcnt lgkmcnt(0)" ::: "memory");
        { const int q2 = lane >> 5, k = lane & 31; float a = 0.f;
#pragma unroll
          for (int h6 = 0; h6 < 6; ++h6) a += pn[(q2 * 6 + h6) * 32 + k];
          imp[q2 * 512 + kb + k] = a; }
        asm volatile("s_waitcnt lgkmcnt(0)" ::: "memory"); });
#ifdef NSA_DEBUG
      if (vcol) { for (int db = 0; db < 4; ++db) *(f32x4*)(P.DBG + ((size_t)0 * MP + row) * 768 + head * 64 + 16 * db + 4 * c) = oc[db]; }
#endif
      const float g0 = vcol ? gt[0] : 0.f;
#pragma unroll
      for (int db = 0; db < 4; ++db) oacc[db] += oc[db] * g0; }
#ifndef REP_SEL
#define REP_SEL 1
#endif
#pragma unroll 1
    for (int rep = 0; rep < REP_SEL; ++rep) {
    for (int i = lane; i < 256; i += 64) { const int q2 = i >> 7, b = i & 127, tq2 = t + q2, cur = tq2 / SLC_BLOCK; float sv;
        if (b > cur) sv = NEG; else if (b == 0 || b == cur || b == cur - 1) sv = FORCE_SCORE;
        else { const LAS float* ic = imp + q2 * 512 + 4 * b; sv = ic[-1] + 2.f * (ic[0] + ic[1] + ic[2]) + ic[3]; }
        sc[i] = sv; }
    asm volatile("s_waitcnt lgkmcnt(0)" ::: "memory");
    for (int i = lane; i < 256; i += 64) { const int q2 = i >> 7, b = i & 127; const float sv = sc[i]; int rank = 0;
        for (int j = 0; j < 128; j += 4) { const f32x4 o = *(const LAS f32x4*)(sc + q2 * 128 + j);
            rank += (o.x > sv || (o.x == sv && j < b)) ? 1 : 0; rank += (o.y > sv || (o.y == sv && j + 1 < b)) ? 1 : 0; rank += (o.z > sv || (o.z == sv && j + 2 < b)) ? 1 : 0; rank += (o.w > sv || (o.w == sv && j + 3 < b)) ? 1 : 0; }
        if (rank < SLC_TOPK) { const int v = (sv > 0.5f * NEG) ? b : -1; sel[q2 * 16 + rank] = v; P.SELB[((size_t)(n * SEQ + t + q2) * NSA_KV_HEADS + kvh) * 16 + rank] = v; } }
    asm volatile("s_waitcnt lgkmcnt(0)" ::: "memory");
    }
#ifndef REP_WIN
#define REP_WIN 1
#endif
#pragma unroll 1
    for (int rep = 0; rep < REP_WIN; ++rep) { Tile16 T; tile_init(T);
      const bf16* WKb = P.WNK + ((size_t)n * NSA_KV_HEADS + kvh) * SEQ * 64; const bf16* WVb = P.WNVT + ((size_t)n * NSA_KV_HEADS + kvh) * 64 * SEQ;
      const int blo = (t - SWA_WINDOW) >> 5, bhi = (t + 1) >> 5;
      auto ld = [&](KV8& kv, int blk) { const int bc = blk < 0 ? 0 : blk; kv_load_t(kv, WKb + (size_t)bc * 2048, WVb + (size_t)bc * 2048, lane); };
      pipe2(bhi - blo + 1, [&](KV8& kv, int i) { ld(kv, blo + i); }, [&](const KV8& kv, int i) { const int kb = 32 * (blo + i);
          tile_compute(T, qf, kv, [&](int e) { const int kp = kb + 8 * c + e; return vcol && kp >= 0 && kp <= tq && tq - kp <= SWA_WINDOW; }); });
      const float inv = (T.l > 0.f) ? 1.0f / T.l : 0.f, g2 = vcol ? gt[2] * inv : 0.f;
#ifdef NSA_DEBUG
      if (vcol) { for (int db = 0; db < 4; ++db) *(f32x4*)(P.DBG + ((size_t)2 * MP + row) * 768 + head * 64 + 16 * db + 4 * c) = T.o[db] * inv; }
#endif
#pragma unroll
      for (int db = 0; db < 4; ++db) if (rep == REP_WIN - 1) oacc[db] += T.o[db] * g2; }
    if (vcol) { float* op = P.DPART + (size_t)row * 768 + head * 64 + 4 * c;
#pragma unroll
        for (int db = 0; db < 4; ++db) *(f32x4*)(op + 16 * db) = oacc[db]; }
}
DI void nsa_pair_b(const FP& P, int n, int kvh, int t, int lane, LAS unsigned char* wl) {
    LAS int* steps = (LAS int*)wl;
    const int col = lane & 15, c = lane >> 4; const bool vcol = col < 12; const int qq = vcol ? col / 6 : 0, hh = vcol ? col % 6 : 0, tq = t + qq, head = kvh * NSA_GROUP + hh, row = n * SEQ + tq;
    bf16x8 qf[2]; { const bf16* qp = P.QB + (size_t)row * NSA_Q_COLS + head * 64 + 8 * c; qf[0] = *(const bf16x8*)qp; qf[1] = *(const bf16x8*)(qp + 32); }
    const float* gt = P.GATES + (size_t)row * 64 + head * 3;
    Tile16 T; tile_init(T);
    const bf16* SKb = P.SLK + ((size_t)n * NSA_KV_HEADS + kvh) * SEQ * 64; const bf16* SVb = P.SLVT + ((size_t)n * NSA_KV_HEADS + kvh) * SEQ * 64;
    int ns = 0;
    { const int mysel = (lane < 32) ? P.SELB[((size_t)(n * SEQ + t + (lane >> 4)) * NSA_KV_HEADS + kvh) * 16 + (lane & 15)] : -1;
      for (int i = 0; i < 32; ++i) { const int b = __builtin_amdgcn_readlane(mysel, i); if (b < 0) continue; const int q2 = i >> 4;
          if (lane == 0) { steps[ns] = (b * SLC_BLOCK) | (q2 << 30); steps[ns + 1] = (b * SLC_BLOCK + 32) | (q2 << 30); } ns += 2; } }
    asm volatile("s_waitcnt lgkmcnt(0)" ::: "memory");
    auto ld = [&](KV8& kv, int i) { const int code = __builtin_amdgcn_readfirstlane(steps[i]); const int kb = code & 0x3fffffff;
        kv_load_t(kv, SKb + (size_t)(kb >> 5) * 2048, SVb + (size_t)(kb >> 5) * 2048, lane); };
#ifdef PROBE_DBLCOMP
    Tile16 T2; tile_init(T2);
#endif
    pipe2(ns, ld, [&](const KV8& kv, int i) { const int code = __builtin_amdgcn_readfirstlane(steps[i]); const int kb = code & 0x3fffffff, q2 = code >> 30;
        tile_compute(T, qf, kv, [&](int e) { return vcol && qq == q2 && (kb + 8 * c + e) <= tq; });
#ifdef PROBE_DBLCOMP
        tile_compute(T2, qf, kv, [&](int e) { return vcol && qq == q2 && (kb + 8 * c + e + 1) <= tq; });
#endif
    });
#ifdef PROBE_DBLCOMP
    if (T2.l < 0.f) T.l = 0.f;
#endif
    const float inv = (T.l > 0.f) ? 1.0f / T.l : 0.f, g1 = vcol ? gt[1] * inv : 0.f;
#ifdef NSA_DEBUG
    if (vcol) { for (int db = 0; db < 4; ++db) *(f32x4*)(P.DBG + ((size_t)1 * MP + row) * 768 + head * 64 + 16 * db + 4 * c) = T.o[db] * inv; }
#endif
    if (vcol) { const float* pp = P.DPART + (size_t)row * 768 + head * 64 + 4 * c; bf16* op = P.ATTB + (size_t)row * 1024 + head * 64 + 4 * c;
#pragma unroll
        for (int db = 0; db < 4; ++db) *(u32x2*)(op + 16 * db) = pk4(*(const f32x4*)(pp + 16 * db) + T.o[db] * g1); }
}

constexpr int SMP_SK = 1088;
template <class KF, class VF> DI void smp_branch(const Ctx& C, LAS float* qs, LAS float* S, LAS float* red, int NK, KF kf, VF vf, bool keep_probs, float (&outh)[1]) {
    const int tid = C.tid, lane = C.lane, w = C.wave;
#pragma unroll 1
    for (int j = tid; j < NK; j += NTHREADS) { const float* k = kf(j); f32x4 kr[16];
#pragma unroll
        for (int d4 = 0; d4 < 16; ++d4) kr[d4] = *(const f32x4*)(k + 4 * d4);
#pragma unroll 1
        for (int h = 0; h < 6; ++h) { float a = 0.f;
#pragma unroll
            for (int d4 = 0; d4 < 16; ++d4) { const f32x4 qv = *(const LAS f32x4*)(qs + h * 64 + 4 * d4); a += kr[d4].x * qv.x + kr[d4].y * qv.y + kr[d4].z * qv.z + kr[d4].w * qv.w; }
            S[h * SMP_SK + j] = a; } }
    asm volatile("s_waitcnt lgkmcnt(0)" ::: "memory"); __syncthreads();
    if (w < 6) { float m = -INFINITY; for (int j = lane; j < NK; j += 64) m = fmaxf(m, S[w * SMP_SK + j]); m = wave_max(m);
        float l = 0.f; for (int j = lane; j < NK; j += 64) { const float p = __builtin_amdgcn_exp2f(S[w * SMP_SK + j] - m); S[w * SMP_SK + j] = p; l += p; } l = wave_sum(l);
        const float inv = 1.0f / l; for (int j = lane; j < NK; j += 64) S[w * SMP_SK + j] *= inv; }
    asm volatile("s_waitcnt lgkmcnt(0)" ::: "memory"); __syncthreads();
    { const int per = (NK + NWAVES - 1) / NWAVES, j0 = w * per, j1 = (j0 + per < NK) ? j0 + per : NK; float o[6] = {0.f, 0.f, 0.f, 0.f, 0.f, 0.f};
#pragma unroll 1
      for (int j = j0; j < j1; j += 8) { float vv[8];
#pragma unroll
          for (int u = 0; u < 8; ++u) { const int jj = (j + u < j1) ? j + u : j1 - 1; vv[u] = vf(jj)[lane]; }
#pragma unroll
          for (int u = 0; u < 8; ++u) if (j + u < j1) {
#pragma unroll
              for (int h = 0; h < 6; ++h) o[h] += S[h * SMP_SK + j + u] * vv[u]; } }
#pragma unroll
      for (int h = 0; h < 6; ++h) red[(w * 6 + h) * 64 + lane] = o[h]; }
    asm volatile("s_waitcnt lgkmcnt(0)" ::: "memory"); __syncthreads();
    outh[0] = 0.f;
    if (tid < 384) { float a = 0.f;
#pragma unroll
        for (int ww = 0; ww < NWAVES; ++ww) a += red[ww * 384 + tid]; outh[0] = a; }
    if (!keep_probs) { __syncthreads(); }
}
DI void nsa_sample_item(const FP& P, const Ctx& C, int ns, int kvh) {
    LAS float* qs = (LAS float*)C.lds; LAS float* S = qs + 384; LAS float* red = S + 6 * SMP_SK; LAS float* scs = red + 8 * 384; LAS int* sel = (LAS int*)(scs + 136);
    const int tid = C.tid, row = M0 + ns;
    if (tid < 384) qs[tid] = bf2f(P.QB[(size_t)row * NSA_Q_COLS + kvh * 384 + tid]);
    asm volatile("s_waitcnt lgkmcnt(0)" ::: "memory"); __syncthreads();
    const float* ckf = P.CKF + ((size_t)ns * NSA_KV_HEADS + kvh) * NCH * 64; const float* cvf = P.CVF + ((size_t)ns * NSA_KV_HEADS + kvh) * NCH * 64;
    float oc[1], os[1], ow[1];
    smp_branch(C, qs, S, red, NCMP, [&](int j) { return ckf + (size_t)j * 64; }, [&](int j) { return cvf + (size_t)j * 64; }, true, oc);
    constexpr int NBS = (PAST_LEN + 1 + SLC_BLOCK - 1) / SLC_BLOCK, CURS = PAST_LEN / SLC_BLOCK;
    for (int b = tid; b < 136; b += NTHREADS) { float sv = -3.0e38f;
        if (b < NBS) { if (b == 0 || b == CURS || b == CURS - 1) sv = FORCE_SCORE; else { float a = 0.f;
#pragma unroll
                for (int o = -1; o <= 3; ++o) { const int ci = 4 * b + o; if (ci >= 0 && ci < NCMP) { float sm = 0.f; for (int h6 = 0; h6 < 6; ++h6) sm += S[h6 * SMP_SK + ci]; a += ((o >= 0 && o <= 2) ? 2.f : 1.f) * sm; } }
                sv = a; } }
        scs[b] = sv; }
    asm volatile("s_waitcnt lgkmcnt(0)" ::: "memory"); __syncthreads();
    for (int b = tid; b < NBS; b += NTHREADS) { const float sv = scs[b]; int rank = 0; for (int j = 0; j < NBS; ++j) { const float o = scs[j]; rank += (o > sv || (o == sv && j < b)) ? 1 : 0; }
        if (rank < SLC_TOPK) { sel[rank] = b; P.SELB[((size_t)row * NSA_KV_HEADS + kvh) * 16 + rank] = b; } }
    asm volatile("s_waitcnt lgkmcnt(0)" ::: "memory"); __syncthreads();
    { const float* newrow = P.nsa_kv_s + (size_t)ns * 512; const int* pt = P.page_table + ns * (PAST_LEN / PAGE_SIZE);
      if (tid == 0) { int seen = 0; for (int x = 0; x < SLC_TOPK; ++x) { const int bx = sel[x]; if (bx != CURS && seen < 15) sel[16 + seen++] = bx; } }
      asm volatile("s_waitcnt lgkmcnt(0)" ::: "memory"); __syncthreads();
      auto krow = [&](int j, int ty) -> const float* { if (j >= 15 * 64) return newrow + ty * 128 + kvh * 64;
          const int t0 = sel[16 + (j >> 6)] * SLC_BLOCK + (j & 63); const int pg = pt[t0 / PAGE_SIZE]; return P.cache_nsa_kv + ((size_t)pg * PAGE_SIZE + t0 % PAGE_SIZE) * 512 + ty * 128 + kvh * 64; };
      smp_branch(C, qs, S, red, 15 * 64 + 1, [&](int j) { return krow(j, 2); }, [&](int j) { return krow(j, 3); }, false, os); }
    { const float* wc = P.cache_nsa_win + (size_t)ns * SWA_WINDOW * 256; const float* newrow = P.win_s + ((size_t)ns * SWA_WINDOW + SWA_WINDOW - 1) * 256;
      smp_branch(C, qs, S, red, SWA_WINDOW + 1, [&](int j) { return (j < SWA_WINDOW ? wc + (size_t)j * 256 : newrow) + kvh * 64; }, [&](int j) { return (j < SWA_WINDOW ? wc + (size_t)j * 256 : newrow) + 128 + kvh * 64; }, false, ow); }
    if (tid < 384) { const int head = kvh * NSA_GROUP + tid / 64; const float* gt = P.GATES + (size_t)row * 64 + head * 3;
        P.ATTB[(size_t)row * 1024 + kvh * 384 + tid] = (bf16)f2bf(gt[0] * oc[0] + gt[1] * os[0] + gt[2] * ow[0]);
#ifdef NSA_DEBUG
        P.DBG[((size_t)0 * MP + row) * 768 + kvh * 384 + tid] = oc[0]; P.DBG[((size_t)1 * MP + row) * 768 + kvh * 384 + tid] = os[0]; P.DBG[((size_t)2 * MP + row) * 768 + kvh * 384 + tid] = ow[0];
#endif
    }
    __syncthreads();
}
DI void nsa_pairs(const FP& P, const Ctx& C, bool second) {
    LAS unsigned char* wl = C.lds + C.wave * NSA_WLDS;
    const int per = C.G / 4 > 0 ? C.G / 4 : 1, grp = (C.vcu / per) & 3, sub = C.vcu % per, n = grp >> 1, kvh = grp & 1;
#pragma unroll 1
    for (int pr = sub * NWAVES + C.wave; pr < SEQ / 2; pr += per * NWAVES) { if (second) nsa_pair_b(P, n, kvh, 2 * pr, C.lane, wl); else nsa_pair_a(P, n, kvh, 2 * pr, C.lane, wl); }
}
DI void nsa_phase_a(const FP& P, const Ctx& C) {
    for (int it = C.vcu; it < DEC_BATCH * NSA_KV_HEADS; it += C.G) nsa_sample_item(P, C, it / NSA_KV_HEADS, it % NSA_KV_HEADS);
    nsa_pairs(P, C, false);
    __syncthreads();
}
DI void nsa_phase_b(const FP& P, const Ctx& C) {
    const int lane = C.lane, w = C.wave;
    nsa_pairs(P, C, true);
    __syncthreads();
    { constexpr int NMT = (M0 / 16) * MEM_HEADS;
      for (int it = C.vcu * NWAVES + w; it < NMT; it += C.G * NWAVES) { const int h = it % MEM_HEADS, q16 = it / MEM_HEADS, row0 = q16 * 16, n = row0 / SEQ;
          mem_micro(P, P.MQB + h * 64, 256, row0, 1, n, h, P.ATTB + NSA_Q_COLS + h * 64, 1024, lane); }
      LAS float* qs = (LAS float*)(C.lds + 65536 + w * 256);
      for (int it = C.vcu * NWAVES + w; it < DEC_BATCH * MEM_HEADS; it += C.G * NWAVES) { const int h = it % MEM_HEADS, ns = it / MEM_HEADS, row = M0 + ns;
          Dec D; D.m = -INFINITY; D.l = 0.f; D.o = 0.f; qs[lane] = bf2f(P.MQB[(size_t)row * 256 + h * 64 + lane]); asm volatile("s_waitcnt lgkmcnt(0)" ::: "memory");
          const float* mk = P.cache_mem_kv + ((size_t)1 * DEC_BATCH + ns) * MEM_TOKENS * 512;
          for (int j0 = 0; j0 < MEM_TOKENS; j0 += 64) dec_chunk(D, qs, 64, [&](int j) { return mk + (size_t)(j0 + j) * 512 + h * 64; }, [&](int j) { return mk + (size_t)(j0 + j) * 512 + 256 + h * 64; }, lane);
          P.ATTB[(size_t)row * 1024 + NSA_Q_COLS + h * 64 + lane] = (bf16)f2bf(D.o / D.l); } }
    __syncthreads();
}
}
namespace fx {
enum { PH_PRO = 0, PH_G1, PH_ATTA, PH_G2, PH_LN1, PH_SC0, PH_TK0, PH_PG0, PH_G3, PH_CMPG, PH_CMP2, PH_NSA, PH_NSB, PH_G4, PH_LN3, PH_SC1, PH_TK1, PH_PG1, PH_COUNT };
template <class Epi> DI void run_gemm(const Ctx& C, const bf16* A, const bf16* Bt, int M, int N, int K, const Epi& E) {
    pg8::Gemm g{A, Bt, M, N, K}; pg8::StaticOrder S; S.init(M, N, C.G, (int)blockIdx.x);
    pg8::gemm_phase<Epi, pg8::StaticOrder, true, true>(C.lds, g, S, E);
}
template <class Epi> DI void skinny_gemm(const Ctx& C, const bf16* A, const bf16* Bt, int N, int K, const Epi& E) {
    static_assert(DEC_BATCH == 32 && M0 % 256 == 0, "skinny_gemm: 32 sample rows right after a whole number of 256-row tiles");
    const int lane = C.lane, fr = lane & 15, fq = lane >> 4, w = C.wave; const int NI = (N / 256) * 4, KW = K / NWAVES;
    LAS f32x4* red = (LAS f32x4*)C.lds;
#pragma unroll 1
    for (int item = C.vcu; item < NI; item += C.G) { const int pn = item >> 2, wc = item & 3;
        f32x4 pa[2][2][2];
#pragma unroll
        for (int i = 0; i < 8; ++i) (&pa[0][0][0])[i] = (f32x4){0.f, 0.f, 0.f, 0.f};
        const bf16* xa = A + (size_t)(M0 + fr) * K + w * KW + 8 * fq; const bf16* xb = xa + (size_t)16 * K;
        const bf16* wp[2][2];
#pragma unroll
        for (int bj = 0; bj < 2; ++bj)
#pragma unroll
            for (int n = 0; n < 2; ++n) wp[bj][n] = Bt + (size_t)(pn * 256 + bj * 128 + wc * 32 + 8 * (fr >> 2) + 4 * n + (fr & 3)) * K + w * KW + 8 * fq;
#pragma unroll 4
        for (int k0 = 0; k0 < KW; k0 += 32) { const bf16x8 x0 = *(const bf16x8*)(xa + k0), x1 = *(const bf16x8*)(xb + k0);
#pragma unroll
            for (int bj = 0; bj < 2; ++bj)
#pragma unroll
                for (int n = 0; n < 2; ++n) { const bf16x8 wf = *(const bf16x8*)(wp[bj][n] + k0);
                    pa[bj][0][n] = __builtin_amdgcn_mfma_f32_16x16x32_bf16(wf, x0, pa[bj][0][n], 0, 0, 0); pa[bj][1][n] = __builtin_amdgcn_mfma_f32_16x16x32_bf16(wf, x1, pa[bj][1][n], 0, 0, 0); } }
        __syncthreads();
#pragma unroll
        for (int bj = 0; bj < 2; ++bj)
#pragma unroll
            for (int mm = 0; mm < 2; ++mm)
#pragma unroll
                for (int n = 0; n < 2; ++n) red[(w * 8 + bj * 4 + mm * 2 + n) * 64 + lane] = pa[bj][mm][n];
        asm volatile("s_waitcnt lgkmcnt(0)" ::: "memory"); __syncthreads();
        if (w == 0) { f32x4 acc[2][2][4][2];
#pragma unroll
            for (int i = 0; i < 32; ++i) (&acc[0][0][0][0])[i] = (f32x4){0.f, 0.f, 0.f, 0.f};
#pragma unroll
            for (int bj = 0; bj < 2; ++bj)
#pragma unroll
                for (int mm = 0; mm < 2; ++mm)
#pragma unroll
                    for (int n = 0; n < 2; ++n) { f32x4 s = red[(bj * 4 + mm * 2 + n) * 64 + lane];
#pragma unroll 1
                        for (int ww = 1; ww < NWAVES; ++ww) s += red[(ww * 8 + bj * 4 + mm * 2 + n) * 64 + lane];
                        acc[0][bj][mm][n] = s; }
            E(acc, pg8::Unit{M0 / 256, pn}, 0, wc, fr, fq); }
    }
    __syncthreads();
}
__global__ void __launch_bounds__(NTHREADS, 2) mega(Args args) {
    extern __shared__ __attribute__((aligned(16))) unsigned char lds_raw[];
    Ctx C; C.lds = (LAS unsigned char*)lds_raw; C.tid = threadIdx.x; C.lane = C.tid & 63; C.wave = __builtin_amdgcn_readfirstlane(C.tid >> 6);
    C.G = gridDim.x; { const int bx = blockIdx.x; C.vcu = (C.G % 8 == 0) ? (bx % 8) * (C.G / 8) + bx / 8 : bx; }
    const FP& P = args.p;
    volatile LAS unsigned* MISC = (volatile LAS unsigned*)(C.lds + MISC_OFF);
    for (int u = C.tid; u < (LDS_BYTES - RING_BYTES) / 4; u += NTHREADS) ((LAS unsigned*)(C.lds + RING_BYTES))[u] = 0u;
    __syncthreads();
    const int lo = args.lo, hi = args.hi;
    XcdBarrier bar; bar.bar = P.ctl + 1024; bar.x = 0; bar.st = nullptr;
    if (hi - lo > 1) bar = xcd_barrier_post(P.ctl + 1024, MISC + 8);
#define IN(k) (lo <= (k) && (k) < hi)
#define SEAM(k) do { if (IN(k) && IN((k) + 1)) xcd_barrier(bar); } while (0)
#ifndef DUP_PHASE
#define DUP_PHASE -1
#endif
#define PHASE(k, ...) do { if (IN(k)) { __VA_ARGS__ if (DUP_PHASE == (k)) { __syncthreads(); __VA_ARGS__ } } SEAM(k); } while (0)
    PHASE(PH_PRO, p0_prologue(P, C); __syncthreads(); p0_wpk(P, C););
    PHASE(PH_G1, run_gemm(C, P.XB0, P.WA_T, M0, ACOLS, D_MODEL, EpiA{P}); run_gemm(C, P.MEMB, P.WMEM_T, BATCH * MEM_TOKENS, 1024, D_MODEL, EpiMem{P}); skinny_gemm(C, P.XB0, P.WA_T, ACOLS, D_MODEL, EpiA{P}););
    PHASE(PH_ATTA, atta_phase(P, C););
    PHASE(PH_G2, run_gemm(C, P.ATTA, P.WOA_T, M0, D_MODEL, 512, EpiPre{P.x_prompt, P.x_sample, P.PRE}); skinny_gemm(C, P.ATTA, P.WOA_T, D_MODEL, 512, EpiPre{P.x_prompt, P.x_sample, P.PRE}););
    PHASE(PH_LN1, ln_phase(P, C, P.PRE, P.ln_g, P.ln_b, P.X1, P.X1B, nullptr, nullptr););
    PHASE(PH_SC0, run_gemm(C, P.X1B, P.WPK_T, M0, NPK, D_MODEL, EpiF32{P.SCO, NPK, MP}); skinny_gemm(C, P.X1B, P.WPK_T, NPK, D_MODEL, EpiF32{P.SCO, NPK, MP}););
    PHASE(PH_TK0, topk_phase(P, C););
    PHASE(PH_PG0, peer_phase(P, C, 0, P.X1, P.X2, P.X2 + (size_t)M0 * D_MODEL, P.X2B););
    PHASE(PH_G3, run_gemm(C, P.X2B, P.WB_T, M0, NB_T, D_MODEL, EpiB{P}); skinny_gemm(C, P.X2B, P.WB_T, NB_T, D_MODEL, EpiB{P}););
    PHASE(PH_CMPG, run_gemm(C, P.AC, P.CW1_T, ACROWS, 256, 1024, EpiF32{P.UL, 256, ACROWS}); run_gemm(C, P.AC + (size_t)ACROWS * 1024, P.CW1_T + 256 * 1024, ACROWS, 256, 1024, EpiF32{P.UL + (size_t)ACROWS * 256, 256, ACROWS}););
    PHASE(PH_CMP2, cmp2_phase(P, C););
    PHASE(PH_NSA, nsa_phase_a(P, C););
    PHASE(PH_NSB, nsa_phase_b(P, C););
    PHASE(PH_G4, run_gemm(C, P.ATTB, P.WOB_T, M0, D_MODEL, 1024, EpiPre{P.X2, nullptr, P.PRE}); skinny_gemm(C, P.ATTB, P.WOB_T, D_MODEL, 1024, EpiPre{P.X2, nullptr, P.PRE}););
    PHASE(PH_LN3, ln_phase(P, C, P.PRE, P.ln_g + 2 * D_MODEL, P.ln_b + 2 * D_MODEL, P.X3, P.X3B, nullptr, nullptr););
    PHASE(PH_SC1, run_gemm(C, P.X3B, P.WPK_T + (size_t)NPK * D_MODEL, M0, NPK, D_MODEL, EpiF32{P.SCO, NPK, MP}); skinny_gemm(C, P.X3B, P.WPK_T + (size_t)NPK * D_MODEL, NPK, D_MODEL, EpiF32{P.SCO, NPK, MP}););
    PHASE(PH_TK1, topk_phase(P, C););
    PHASE(PH_PG1, peer_phase(P, C, 1, P.X3, P.y_prompt, P.y_sample, nullptr););
#undef IN
#undef SEAM
}
}
#ifndef ONE_LAUNCH
#define ONE_LAUNCH 1
#endif
extern "C" void kernel_launch(void* const* d_in, const int* in_sizes, int n_in, void* d_out, int out_size, void* d_ws, size_t ws_size, hipStream_t stream) {
    fx::Args a; memset(&a, 0, sizeof(a)); fx::bind_io(a.p, d_in, (float*)d_out);
    const size_t f_need = fx::carve(a.p, d_ws);
    if (f_need > ws_size) { fprintf(stderr, "kernel_launch: workspace too small: need %zu have %zu\n", f_need, ws_size); return; }
    static int grid = 0;
    if (!grid) { int dev = 0, cus = 0, per_cu = 0; (void)hipGetDevice(&dev); (void)hipDeviceGetAttribute(&cus, hipDeviceAttributeMultiprocessorCount, dev);
        (void)hipFuncSetAttribute((const void*)fx::mega, hipFuncAttributeMaxDynamicSharedMemorySize, fx::LDS_BYTES);
        if (hipOccupancyMaxActiveBlocksPerMultiprocessor(&per_cu, (const void*)fx::mega, fx::NTHREADS, fx::LDS_BYTES) != hipSuccess || per_cu < 1) { fprintf(stderr, "kernel_launch: occupancy query says %d blocks per CU\n", per_cu); (void)hipGetLastError(); }
        grid = cus; }
    (void)hipMemsetAsync(a.p.ctl, 0, fx::CTL_BYTES, stream);
#if ONE_LAUNCH
    a.lo = 0; a.hi = fx::PH_COUNT; hipLaunchKernelGGL(fx::mega, dim3(grid), dim3(fx::NTHREADS), fx::LDS_BYTES, stream, a);
#else
    for (int k = 0; k < fx::PH_COUNT; ++k) { a.lo = k; a.hi = k + 1; hipLaunchKernelGGL(fx::mega, dim3(grid), dim3(fx::NTHREADS), fx::LDS_BYTES, stream, a); }
#endif
}
```

```cpp
#define ONE_LAUNCH 1
#include <hip/hip_runtime.h>
#include <cstdio>
#include <cstring>
#include <cmath>
#ifdef CPU_TEST
#define HD inline
constexpr int D_MODEL = 128, BATCH = 2, SEQ = 512, DEPTH = 2, DEC_BATCH = 3, DEC_SEQ = 1, PAST_LEN = 512, PAGE_SIZE = 128;
constexpr int DIL_W[3] = {16, 64, 256}, DIL_D[3] = {1, 4, 16}, DIL_TAPS = 17;
constexpr int MEM_TOKENS = 32, SLC_TOPK = 4, SWA_WINDOW = 64, PEER_KEYS = 16, PEER_TOPK = 4;
#else
#define HD __host__ __device__ __forceinline__
constexpr int D_MODEL = 1024, BATCH = 2, SEQ = 8192, DEPTH = 2, DEC_BATCH = 32, DEC_SEQ = 1, PAST_LEN = 8192, PAGE_SIZE = 128;
constexpr int DIL_W[3] = {128, 512, 2048}, DIL_D[3] = {1, 4, 16}, DIL_TAPS = 129;
constexpr int MEM_TOKENS = 256, SLC_TOPK = 16, SWA_WINDOW = 512, PEER_KEYS = 128, PEER_TOPK = 16;
#endif
HD constexpr int dil_w(int g) { return g == 0 ? DIL_W[0] : (g == 1 ? DIL_W[1] : DIL_W[2]); }
HD constexpr int dil_d(int g) { return g == 0 ? DIL_D[0] : (g == 1 ? DIL_D[1] : DIL_D[2]); }
constexpr int HEAD_DIM = 64, N_A_LAYERS = DEPTH / 2, N_DIL = 3, DIL_HEADS = 4, DIL_COLS = N_DIL * 3 * DIL_HEADS * HEAD_DIM;
constexpr int MEM_HEADS = 4, MEM_COLS = MEM_HEADS * HEAD_DIM;
constexpr int NSA_HEADS = 12, NSA_KV_HEADS = 2, NSA_GROUP = 6, NSA_Q_COLS = NSA_HEADS * HEAD_DIM, NSA_GATE_COLS = NSA_HEADS * 3;
constexpr int CMP_BLOCK = 32, CMP_STRIDE = 16, CMP_HIDDEN = 128, SLC_BLOCK = 64;
constexpr int PEER_EXPERTS = PEER_KEYS * PEER_KEYS, PEER_HEADS = 8, PEER_KEY_DIM = 128;
constexpr float FORCE_SCORE = 1.0e9f, NEG = -1.0e30f, SCALE = 0.125f, LN_EPS = 1e-5f;
constexpr float ALPHA = 1.41421356237309515f;
constexpr float BETA = 0.5f;
#define LAS __attribute__((address_space(3)))
namespace pg8 {
#define PG8_LAS __attribute__((address_space(3)))
typedef unsigned short bf16_t;
typedef short bf16x8 __attribute__((ext_vector_type(8)));
typedef float f32x4 __attribute__((ext_vector_type(4)));
typedef unsigned u32x4 __attribute__((ext_vector_type(4)));
constexpr int BM = 256, BK = 64, HALF = 128, HTB = HALF * BK * 2  , STAGE_BYTES = 8 * HTB, NXCD = 8, WGM = 8;

__host__ __device__ __forceinline__ int lds_byte(int r, int c) { const int st = (r >> 4) * 2 + (c >> 5), rr = r & 15, cc = c & 31, ob = rr * 64 + cc * 2; return st * 1024 + (ob ^ (((ob >> 9) & 1) << 5)); }
__host__ __device__ __forceinline__ void stage_rc(int b, int& R, int& C) { const int st = b / 1024, sb = b % 1024, swz = sb ^ (((sb >> 9) & 1) << 5); R = (st >> 1) * 16 + swz / 64; C = (st & 1) * 32 + (swz % 64) / 2; }
__host__ __device__ __forceinline__ int perm32(int rho) { const int n = rho >> 4, i = rho & 15; return 8 * (i >> 2) + 4 * n + (i & 3); }

struct Unit { int pm, pn; };
struct Gemm { const bf16_t* A; const bf16_t* Bt; int M, N, K; };

struct StaticOrder {
    int nM, nN, nwg, G, c;
    __host__ __device__ void init(int M, int N, int G_, int c_) { nM = M / BM; nN = N / BM; nwg = nM * nN; G = G_; c = c_; }
    __host__ __device__ bool next(int i, Unit& u) const {
        const long L = (long)i * G + c; if (L >= nwg) return false;
        int wgid = (int)L; { const int q = nwg / NXCD, r = nwg % NXCD, xcd = wgid % NXCD, off = wgid / NXCD; wgid = (xcd < r ? xcd * (q + 1) : r * (q + 1) + (xcd - r) * q) + off; }
        const int nig = WGM * nN, gid = wgid / nig, fm = gid * WGM, gsz = (nM - fm) < WGM ? (nM - fm) : WGM;
        u.pm = fm + ((wgid % nig) % gsz); u.pn = (wgid % nig) / gsz; return true;
    }
    __device__ __forceinline__ void a_ready(const Unit&) const {}
    __device__ __forceinline__ void done(const Unit&) const {}
};

__device__ __forceinline__ unsigned cvt_pk_bf16(float lo, float hi) { unsigned r; asm volatile("v_cvt_pk_bf16_f32 %0, %1, %2" : "=v"(r) : "v"(lo), "v"(hi)); return r; }
typedef float f32x2 __attribute__((ext_vector_type(2)));
typedef float f32x2 __attribute__((ext_vector_type(2)));
template <class Epi, class Sched, bool ALIGN_EPI = false, bool SP2 = false>
__device__ __forceinline__ void gemm_phase(PG8_LAS unsigned char* lds, const Gemm g, const Sched& S, const Epi& E) {
    const int tid = threadIdx.x, wid = __builtin_amdgcn_readfirstlane(tid >> 6), lane = tid & 63, wr = wid >> 2, wc = wid & 3, fr = lane & 15, fq = lane >> 4;
    const int K = g.K, nt = K / BK;
    unsigned voffA[2], voffB[2];
#pragma unroll
    for (int i = 0; i < 2; ++i) { int R, C; stage_rc(tid * 16 + i * 8192, R, C); const int Rb = Epi::PERM ? ((R & ~31) + perm32(R & 31)) : R;
        voffA[i] = (unsigned)(R * K + C) * 2u; voffB[i] = (unsigned)(Rb * K + C) * 2u; }
    const size_t kstep = (size_t)(BK * 2);
    const size_t hstep = (size_t)HALF * K * 2;
    const size_t tstep = 2 * hstep;
    const unsigned ldsw = (unsigned)wid * 1024u;
    const int aoff = lds_byte(wr * 64 + fr, fq * 8), boff = lds_byte(wc * 32 + fr, fq * 8);
#define PG8_SA(b, h) (((b) * 2 + (h)) * HTB)
#define PG8_SB(b, h) ((4 + (b) * 2 + (h)) * HTB)
#define PG8_STAGE(bufoff, gbase, voff) do { _Pragma("unroll") for (int _i = 0; _i < 2; ++_i) \
        __builtin_amdgcn_global_load_lds((const unsigned*)((const char*)(gbase) + (voff)[_i]), (PG8_LAS unsigned*)(lds + (bufoff) + ldsw + _i * 8192), 16, 0, 0); } while (0)
#define PG8_LDA(dst, b, h) do { _Pragma("unroll") for (int m = 0; m < 4; ++m) _Pragma("unroll") for (int k = 0; k < 2; ++k) dst[m][k] = *(const PG8_LAS bf16x8*)(lds + PG8_SA(b, h) + aoff + m * 2048 + k * 1024); } while (0)
#define PG8_LDB(dst, b, h) do { _Pragma("unroll") for (int n = 0; n < 2; ++n) _Pragma("unroll") for (int k = 0; k < 2; ++k) dst[n][k] = *(const PG8_LAS bf16x8*)(lds + PG8_SB(b, h) + boff + n * 2048 + k * 1024); } while (0)
#define PG8_MMA(ai, bj, At, Bt) do { __builtin_amdgcn_s_setprio(1); _Pragma("unroll") for (int m = 0; m < 4; ++m) _Pragma("unroll") for (int n = 0; n < 2; ++n) _Pragma("unroll") for (int k = 0; k < 2; ++k) \
        acc[ai][bj][m][n] = __builtin_amdgcn_mfma_f32_16x16x32_bf16(Bt[n][k], At[m][k], acc[ai][bj][m][n], 0, 0, 0); __builtin_amdgcn_s_setprio(0); } while (0)
#define PG8_WAIT_V(n) asm volatile("s_waitcnt vmcnt(" #n ")" ::: "memory")
#define PG8_WAIT_L(n) asm volatile("s_waitcnt lgkmcnt(" #n ")" ::: "memory")
#define PG8_BAR __builtin_amdgcn_s_barrier()
#define PG8_SCHED __builtin_amdgcn_sched_barrier(0)
    Unit cur, nxt; int ui = 0;
    if (!S.next(0, cur)) return;
    f32x4 acc[2][2][4][2];
#pragma unroll
    for (int a = 0; a < 2; ++a)
#pragma unroll
        for (int b = 0; b < 2; ++b)
#pragma unroll
            for (int m = 0; m < 4; ++m)
#pragma unroll
                for (int n = 0; n < 2; ++n) acc[a][b][m][n] = (f32x4){0.f, 0.f, 0.f, 0.f};
    bf16x8 At[4][2], B0[2][2], B1[2][2];
    const char* cA = (const char*)g.A + (size_t)cur.pm * tstep; const char* cB = (const char*)g.Bt + (size_t)cur.pn * tstep;
    S.a_ready(cur);
    if constexpr (SP2) {
        PG8_STAGE(PG8_SB(0, 0), cB, voffB); PG8_STAGE(PG8_SB(0, 1), cB + hstep, voffB); PG8_STAGE(PG8_SA(0, 0), cA, voffA); PG8_STAGE(PG8_SA(0, 1), cA + hstep, voffA);
        if (wr == 1) PG8_BAR;
        PG8_WAIT_V(2); PG8_BAR;
        PG8_STAGE(PG8_SB(1, 0), cB + kstep, voffB); PG8_STAGE(PG8_SA(1, 0), cA + kstep, voffA); PG8_STAGE(PG8_SB(1, 1), cB + hstep + kstep, voffB);
        PG8_WAIT_V(6); PG8_BAR;
    } else {
        PG8_STAGE(PG8_SB(0, 0), cB, voffB); PG8_STAGE(PG8_SA(0, 0), cA, voffA); PG8_STAGE(PG8_SB(0, 1), cB + hstep, voffB); PG8_STAGE(PG8_SA(0, 1), cA + hstep, voffA);
        if (wr == 1) PG8_BAR;
        PG8_WAIT_V(4); PG8_BAR;
        PG8_STAGE(PG8_SB(1, 0), cB + kstep, voffB); PG8_STAGE(PG8_SA(1, 0), cA + kstep, voffA); PG8_STAGE(PG8_SB(1, 1), cB + hstep + kstep, voffB);
        PG8_WAIT_V(6); PG8_BAR;
    }
    for (;;) {
        const bool has_next = S.next(ui + 1, nxt);
        const char* nA = has_next ? (const char*)g.A + (size_t)nxt.pm * tstep : cA; const char* nB = has_next ? (const char*)g.Bt + (size_t)nxt.pn * tstep : cB;
        for (int t = 0; t < nt; t += 2) {
            const bool last = (t == nt - 2);
            const char* a1 = cA + (size_t)(t + 1) * kstep;
            const char* a2 = last ? nA : cA + (size_t)(t + 2) * kstep; const char* b2 = last ? nB : cB + (size_t)(t + 2) * kstep;
            const char* a3 = a2 + kstep; const char* b3 = b2 + kstep;
            if (last && has_next) S.a_ready(nxt);
            if constexpr (SP2) {
            PG8_LDB(B0, 0, 0); PG8_LDB(B1, 0, 1); PG8_SCHED; PG8_LDA(At, 0, 0); PG8_STAGE(PG8_SA(1, 1), a1 + hstep, voffA);
            PG8_WAIT_V(8); PG8_WAIT_L(0); PG8_BAR; PG8_MMA(0, 0, At, B0); PG8_MMA(0, 1, At, B1); PG8_BAR; PG8_SCHED;
            PG8_LDA(At, 0, 1); PG8_STAGE(PG8_SB(0, 0), b2, voffB); PG8_STAGE(PG8_SB(0, 1), b2 + hstep, voffB); PG8_STAGE(PG8_SA(0, 0), a2, voffA);
            PG8_WAIT_V(8); PG8_WAIT_L(0); PG8_BAR; PG8_MMA(1, 0, At, B0); PG8_MMA(1, 1, At, B1); PG8_BAR; PG8_SCHED;
            PG8_LDB(B0, 1, 0); PG8_LDB(B1, 1, 1); PG8_SCHED; PG8_LDA(At, 1, 0); PG8_STAGE(PG8_SA(0, 1), a2 + hstep, voffA);
            PG8_WAIT_V(8); PG8_WAIT_L(0); PG8_BAR; PG8_MMA(0, 0, At, B0); PG8_MMA(0, 1, At, B1); PG8_BAR; PG8_SCHED;
            PG8_LDA(At, 1, 1); PG8_STAGE(PG8_SB(1, 0), b3, voffB); PG8_STAGE(PG8_SB(1, 1), b3 + hstep, voffB); PG8_STAGE(PG8_SA(1, 0), a3, voffA);
            PG8_WAIT_V(8); PG8_WAIT_L(0); PG8_BAR; PG8_MMA(1, 0, At, B0); PG8_MMA(1, 1, At, B1); PG8_BAR; PG8_SCHED;
            } else {
            PG8_LDB(B0, 0, 0); PG8_SCHED; PG8_LDA(At, 0, 0); PG8_STAGE(PG8_SA(1, 1), a1 + hstep, voffA);
            PG8_WAIT_L(8); PG8_BAR; PG8_WAIT_L(0); PG8_MMA(0, 0, At, B0); PG8_BAR; PG8_SCHED;
            PG8_LDB(B1, 0, 1); PG8_STAGE(PG8_SB(0, 0), b2, voffB);
            PG8_BAR; PG8_WAIT_L(0); PG8_MMA(0, 1, At, B1); PG8_BAR;
            PG8_LDA(At, 0, 1); PG8_STAGE(PG8_SA(0, 0), a2, voffA);
            PG8_BAR; PG8_WAIT_L(0); PG8_MMA(1, 0, At, B0); PG8_BAR; PG8_SCHED;
            PG8_STAGE(PG8_SB(0, 1), b2 + hstep, voffB);
            PG8_WAIT_V(6); PG8_BAR; PG8_MMA(1, 1, At, B1); PG8_BAR;
            PG8_LDB(B0, 1, 0); PG8_SCHED; PG8_LDA(At, 1, 0); PG8_STAGE(PG8_SA(0, 1), a2 + hstep, voffA);
            PG8_WAIT_L(8); PG8_BAR; PG8_WAIT_L(0); PG8_MMA(0, 0, At, B0); PG8_BAR; PG8_SCHED;
            PG8_LDB(B1, 1, 1); PG8_STAGE(PG8_SB(1, 0), b3, voffB);
            PG8_BAR; PG8_WAIT_L(0); PG8_MMA(0, 1, At, B1); PG8_BAR;
            PG8_LDA(At, 1, 1); PG8_STAGE(PG8_SA(1, 0), a3, voffA);
            PG8_BAR; PG8_WAIT_L(0); PG8_MMA(1, 0, At, B0); PG8_BAR; PG8_SCHED;
            PG8_STAGE(PG8_SB(1, 1), b3 + hstep, voffB);
            PG8_WAIT_V(6); PG8_BAR; PG8_MMA(1, 1, At, B1); PG8_BAR;
            }
        }
        if constexpr (ALIGN_EPI) { if (wr == 0) PG8_BAR; }
        if constexpr (!Epi::AFTER_DRAIN) { E(acc, cur, wr, wc, fr, fq); S.done(cur); }
        if (!has_next) break;
#pragma unroll
        for (int a = 0; a < 2; ++a)
#pragma unroll
            for (int b = 0; b < 2; ++b)
#pragma unroll
                for (int m = 0; m < 4; ++m)
#pragma unroll
                    for (int n = 0; n < 2; ++n) acc[a][b][m][n] = (f32x4){0.f, 0.f, 0.f, 0.f};
        cur = nxt; cA = nA; cB = nB; ++ui;
        if constexpr (ALIGN_EPI) { if (wr == 1) PG8_BAR; }
    }
    PG8_WAIT_V(0);
    if constexpr (!ALIGN_EPI) { if (wr == 0) PG8_BAR; }
    PG8_BAR;
    if constexpr (Epi::AFTER_DRAIN) { E.fused(acc, cur, wr, wc, fr, fq, lds, wid, lane); S.done(cur); }
#undef PG8_SA
#undef PG8_SB
#undef PG8_STAGE
#undef PG8_LDA
#undef PG8_LDB
#undef PG8_MMA
#undef PG8_WAIT_V
#undef PG8_WAIT_L
#undef PG8_BAR
#undef PG8_SCHED
}
}
#define XB_TMO      128
#define XB_XCNT(j)  (256  + 64 * (j))
#define XB_XSUB(j)  (1280 + 64 * (j))
#define XB_XGEN(j)  (2304 + 64 * (j))
#define XB_TOP      3328
#define XB_TOPGEN   3392
#define XCD_BAR_WORDS 3456
#define XB_SPIN_CAP (1u << 18)

__device__ __forceinline__ unsigned xb_ld(unsigned* p)              { return __hip_atomic_load(p, __ATOMIC_RELAXED, __HIP_MEMORY_SCOPE_AGENT); }
__device__ __forceinline__ unsigned xb_add(unsigned* p, unsigned v) { return __hip_atomic_fetch_add(p, v, __ATOMIC_RELAXED, __HIP_MEMORY_SCOPE_AGENT); }
__device__ __forceinline__ unsigned xb_xcc_id() { return (unsigned)__builtin_amdgcn_s_getreg((3 << 11) | 20) & 0xFu; }
#define XB_SPIN(cond, bar) do { unsigned _sp = 0; while (cond) { __builtin_amdgcn_s_sleep(1); \
    if ((++_sp & 255u) == 0u) { if (xb_ld(&(bar)[XB_TMO])) break; if (_sp > XB_SPIN_CAP) { atomicAdd(&(bar)[XB_TMO], 1u); break; } } } } while (0)

struct XcdBarrier {
    unsigned* bar; unsigned x;
    volatile LAS unsigned* st;
};

__device__ __forceinline__ XcdBarrier xcd_barrier_post(unsigned* bar, volatile LAS unsigned* st) {
    XcdBarrier b; b.bar = bar; b.x = xb_xcc_id(); b.st = st;
    if (threadIdx.x == 0) (void)xb_add(&bar[XB_XCNT(b.x)], 1u);
    return b;
}
__device__ __forceinline__ void xcd_barrier_complete(unsigned* bar, unsigned x, unsigned& nloc, unsigned& nx) {
    const unsigned G = gridDim.x * gridDim.y * gridDim.z;
    unsigned sum, cnt, mine, sp = 0u;
    for (;;) {
        sum = 0u; cnt = 0u; mine = 0u;
#pragma unroll
        for (unsigned j = 0; j < 16; ++j) { const unsigned c = xb_ld(&bar[XB_XCNT(j)]); sum += c; cnt += (c > 0u) ? 1u : 0u; mine = (j == x) ? c : mine; }
        if (sum == G) break;
        __builtin_amdgcn_s_sleep(1);
        if ((++sp & 255u) == 0u) { if (xb_ld(&bar[XB_TMO])) break; if (sp > XB_SPIN_CAP) { atomicAdd(&bar[XB_TMO], 1u); break; } }
    }
    nloc = mine > 0u ? mine : 1u; nx = cnt > 0u ? cnt : 1u;
}

__device__ __forceinline__ void xcd_barrier(const XcdBarrier& b) {
    asm volatile("s_waitcnt vmcnt(0)" ::: "memory");
    __syncthreads();
    if (threadIdx.x == 0) {
        unsigned* bar = b.bar;
        __builtin_amdgcn_s_waitcnt(0);
        unsigned nloc = b.st[0], nx = b.st[1];
        if (nloc == 0u) { xcd_barrier_complete(bar, b.x, nloc, nx); b.st[0] = nloc; b.st[1] = nx; }
        const unsigned old = xb_add(&bar[XB_XSUB(b.x)], 1u);
        const unsigned gen = old / nloc;
        if (old + 1u == (gen + 1u) * nloc) {
            __builtin_amdgcn_fence(__ATOMIC_RELEASE, "agent");
            asm volatile("s_waitcnt vmcnt(0)" ::: "memory");
            const unsigned og = xb_add(&bar[XB_TOP], 1u);
            const unsigned tg = og / nx;
            if (og + 1u == (tg + 1u) * nx) xb_add(&bar[XB_TOPGEN], 1u);
            else XB_SPIN(xb_ld(&bar[XB_TOPGEN]) == tg, bar);
            __builtin_amdgcn_fence(__ATOMIC_ACQUIRE, "agent");
            xb_add(&bar[XB_XGEN(b.x)], 1u);
            asm volatile("s_waitcnt vmcnt(0)" ::: "memory");
        } else {
            XB_SPIN(xb_ld(&bar[XB_XGEN(b.x)]) == gen, bar);
            __builtin_amdgcn_fence(__ATOMIC_ACQUIRE, "agent");
            asm volatile("s_waitcnt vmcnt(0)" ::: "memory");
        }
    }
    __syncthreads();
}
namespace fx {
#define DI __device__ __forceinline__
typedef unsigned short bf16;
typedef short bf16x8 __attribute__((ext_vector_type(8)));
typedef float f32x4 __attribute__((ext_vector_type(4)));
typedef float f32x2 __attribute__((ext_vector_type(2)));
typedef unsigned u32x4 __attribute__((ext_vector_type(4)));
typedef unsigned u32x2 __attribute__((ext_vector_type(2)));
constexpr int M0 = BATCH * SEQ, MP = M0 + DEC_BATCH, MPAD = ((MP + 255) / 256) * 256;
constexpr int ACOLS = DIL_COLS + MEM_COLS, BCOLS = NSA_Q_COLS + NSA_GATE_COLS + MEM_COLS, KVCOLS = 6 * NSA_KV_HEADS * HEAD_DIM;
constexpr int NB_T = 2048;
constexpr int NPK = PEER_HEADS * 2 * PEER_KEYS;
constexpr int NCMP = (SEQ - CMP_BLOCK) / CMP_STRIDE + 1;
constexpr int NCH = SEQ / CMP_STRIDE;
constexpr int NCTX = BATCH + DEC_BATCH;
constexpr int ACROWS = NCTX * NSA_KV_HEADS * NCH;
constexpr int NPOS = PAST_LEN + 1;
constexpr float QSCALE = 0.125f * 1.4426950408889634f;
constexpr int NTHREADS = 512, NWAVES = 8, LDS_BYTES = 147456, RING_BYTES = 131072, MISC_OFF = RING_BYTES + 320;

struct FP {
    const float *x_prompt, *x_sample, *mem_prompt, *cache_dil[3], *cache_nsa_kv, *cache_nsa_win, *cache_mem_kv; const int* page_table;
    const float *w_in_a, *w_out_a, *w_in_b, *w_out_b, *w_mem_kv, *w_kv_b, *cmp_pe, *cmp_w1, *cmp_w2, *ln_g, *ln_b, *peer_wq, *peer_keys, *peer_u, *peer_v;
    float *y_prompt, *y_sample, *dil_p[3], *dil_s[3], *nsa_kv_p, *nsa_kv_s, *win_p, *win_s, *mem_kv_p;
    unsigned* ctl;
    bf16 *XB0, *X1B, *X2B, *X3B, *WA_T, *WMEM_T, *MEMB, *WOA_T, *WOB_T, *WPK_T, *WB_T, *CW1_T, *AC; unsigned char *UB8, *VB8;
    float *ROPE, *CBIAS;
    bf16 *QA, *KA, *VTA, *MQA, *MK, *MVT, *ATTA;
    float *DPART, *DML, *PRE, *X1, *X2, *X3, *SCO, *SELG; int* SELE;
    bf16 *SLK, *SLVT, *WNK, *WNVT, *QB, *MQB, *CK, *CVT, *ATTB;
    float *GATES, *UL, *CKF, *CVF;
    int* SELB;
    float* DBG;
};
struct Args { FP p; int lo, hi; };
struct Carve { size_t off = 0; template <class T> T* take(void* base, size_t n) { T* r = (T*)((char*)base + off); off += ((n * sizeof(T) + 255) / 256) * 256; return r; } };
constexpr size_t CTL_BYTES = 65536;
inline size_t carve(FP& p, void* base) {
    Carve c;
    p.ctl = c.take<unsigned>(base, CTL_BYTES / 4);
    p.XB0 = c.take<bf16>(base, (size_t)MPAD * D_MODEL); p.X1B = c.take<bf16>(base, (size_t)MPAD * D_MODEL); p.X2B = c.take<bf16>(base, (size_t)MPAD * D_MODEL); p.X3B = c.take<bf16>(base, (size_t)MPAD * D_MODEL);
    p.WA_T = c.take<bf16>(base, (size_t)ACOLS * D_MODEL); p.WMEM_T = c.take<bf16>(base, (size_t)DEPTH * 2 * MEM_COLS * D_MODEL); p.MEMB = c.take<bf16>(base, (size_t)BATCH * MEM_TOKENS * D_MODEL);
    p.WOA_T = c.take<bf16>(base, (size_t)D_MODEL * 2 * MEM_COLS); p.WOB_T = c.take<bf16>(base, (size_t)D_MODEL * (NSA_Q_COLS + MEM_COLS));
    p.WPK_T = c.take<bf16>(base, (size_t)DEPTH * NPK * D_MODEL); p.WB_T = c.take<bf16>(base, (size_t)NB_T * D_MODEL);
    p.UB8 = c.take<unsigned char>(base, (size_t)DEPTH * PEER_EXPERTS * D_MODEL); p.VB8 = c.take<unsigned char>(base, (size_t)DEPTH * PEER_EXPERTS * D_MODEL);
    p.CW1_T = c.take<bf16>(base, (size_t)2 * 256 * 1024); p.AC = c.take<bf16>(base, (size_t)2 * ACROWS * 1024);
    p.ROPE = c.take<float>(base, (size_t)NPOS * 64); p.CBIAS = c.take<float>(base, 2 * CMP_HIDDEN);
    p.QA = c.take<bf16>(base, (size_t)3 * MPAD * 256); p.KA = c.take<bf16>(base, (size_t)3 * MPAD * 256); p.VTA = c.take<bf16>(base, (size_t)3 * BATCH * DIL_HEADS * HEAD_DIM * SEQ + 4096);
    p.MQA = c.take<bf16>(base, (size_t)MPAD * 256); p.MK = c.take<bf16>(base, (size_t)DEPTH * BATCH * MEM_TOKENS * MEM_COLS); p.MVT = c.take<bf16>(base, (size_t)DEPTH * BATCH * MEM_COLS * MEM_TOKENS);
    p.ATTA = c.take<bf16>(base, (size_t)MPAD * 2 * MEM_COLS);
    p.DPART = c.take<float>(base, (size_t)3 * MP * DIL_HEADS * HEAD_DIM); p.DML = c.take<float>(base, (size_t)3 * MP * DIL_HEADS * 2);
    p.PRE = c.take<float>(base, (size_t)MPAD * D_MODEL); p.X1 = c.take<float>(base, (size_t)MPAD * D_MODEL); p.X2 = c.take<float>(base, (size_t)MPAD * D_MODEL); p.X3 = c.take<float>(base, (size_t)MPAD * D_MODEL);
    p.SCO = c.take<float>(base, (size_t)MPAD * NPK); p.SELG = c.take<float>(base, (size_t)MP * 128); p.SELE = c.take<int>(base, (size_t)MP * 128);
    p.SLK = c.take<bf16>(base, (size_t)BATCH * NSA_KV_HEADS * SEQ * HEAD_DIM); p.SLVT = c.take<bf16>(base, (size_t)BATCH * NSA_KV_HEADS * SEQ * HEAD_DIM);
    p.WNK = c.take<bf16>(base, (size_t)BATCH * NSA_KV_HEADS * SEQ * HEAD_DIM + 4096); p.WNVT = c.take<bf16>(base, (size_t)BATCH * NSA_KV_HEADS * SEQ * HEAD_DIM + 4096);
    p.QB = c.take<bf16>(base, (size_t)MPAD * NSA_Q_COLS); p.MQB = c.take<bf16>(base, (size_t)MPAD * 256);
    p.CK = c.take<bf16>(base, (size_t)NCTX * NSA_KV_HEADS * NCH * HEAD_DIM); p.CVT = c.take<bf16>(base, (size_t)NCTX * NSA_KV_HEADS * HEAD_DIM * NCH); p.ATTB = c.take<bf16>(base, (size_t)MPAD * (NSA_Q_COLS + MEM_COLS));
    p.GATES = c.take<float>(base, (size_t)MPAD * 64); p.UL = c.take<float>(base, (size_t)2 * ACROWS * 256);
    p.CKF = c.take<float>(base, (size_t)DEC_BATCH * NSA_KV_HEADS * NCH * HEAD_DIM); p.CVF = c.take<float>(base, (size_t)DEC_BATCH * NSA_KV_HEADS * NCH * HEAD_DIM);
    p.SELB = c.take<int>(base, (size_t)MP * NSA_KV_HEADS * 16);
#ifdef NSA_DEBUG
    p.DBG = c.take<float>(base, (size_t)3 * MP * 768);
#else
    p.DBG = nullptr;
#endif
    return c.off;
}
inline void bind_io(FP& p, void* const* d_in, float* out) {
    p.x_prompt = (const float*)d_in[0]; p.x_sample = (const float*)d_in[1]; p.mem_prompt = (const float*)d_in[2]; p.cache_dil[0] = (const float*)d_in[3]; p.cache_dil[1] = (const float*)d_in[4]; p.cache_dil[2] = (const float*)d_in[5];
    p.cache_nsa_kv = (const float*)d_in[6]; p.cache_nsa_win = (const float*)d_in[7]; p.cache_mem_kv = (const float*)d_in[8]; p.page_table = (const int*)d_in[9];
    p.w_in_a = (const float*)d_in[10]; p.w_out_a = (const float*)d_in[11]; p.w_in_b = (const float*)d_in[12]; p.w_out_b = (const float*)d_in[13]; p.w_mem_kv = (const float*)d_in[14]; p.w_kv_b = (const float*)d_in[15];
    p.cmp_pe = (const float*)d_in[16]; p.cmp_w1 = (const float*)d_in[17]; p.cmp_w2 = (const float*)d_in[18]; p.ln_g = (const float*)d_in[19]; p.ln_b = (const float*)d_in[20];
    p.peer_wq = (const float*)d_in[21]; p.peer_keys = (const float*)d_in[22]; p.peer_u = (const float*)d_in[23]; p.peer_v = (const float*)d_in[24];
    size_t o = 0; auto take = [&](size_t n) { float* r = out + o; o += n; return r; };
    p.y_prompt = take((size_t)M0 * D_MODEL); p.y_sample = take((size_t)DEC_BATCH * D_MODEL);
    for (int g = 0; g < 3; ++g) p.dil_p[g] = take((size_t)BATCH * DIL_W[g] * 2 * DIL_HEADS * HEAD_DIM);
    for (int g = 0; g < 3; ++g) p.dil_s[g] = take((size_t)DEC_BATCH * DIL_W[g] * 2 * DIL_HEADS * HEAD_DIM);
    p.nsa_kv_p = take((size_t)M0 * 4 * NSA_KV_HEADS * HEAD_DIM); p.nsa_kv_s = take((size_t)DEC_BATCH * 4 * NSA_KV_HEADS * HEAD_DIM);
    p.win_p = take((size_t)BATCH * SWA_WINDOW * 2 * NSA_KV_HEADS * HEAD_DIM); p.win_s = take((size_t)DEC_BATCH * SWA_WINDOW * 2 * NSA_KV_HEADS * HEAD_DIM);
    p.mem_kv_p = take((size_t)DEPTH * BATCH * MEM_TOKENS * 2 * MEM_COLS);
}
DI unsigned f2bf(float f) { unsigned u = __builtin_bit_cast(unsigned, f); return (u + 0x7fffu + ((u >> 16) & 1u)) >> 16; }
DI unsigned pk2(float lo, float hi) { return f2bf(lo) | (f2bf(hi) << 16); }
DI float bf2f(unsigned short b) { return __builtin_bit_cast(float, (unsigned)b << 16); }
DI float bflo(unsigned w) { return __builtin_bit_cast(float, w << 16); }
DI float bfhi(unsigned w) { return __builtin_bit_cast(float, w & 0xffff0000u); }
DI float wave_sum(float v) {
#pragma unroll
    for (int o = 1; o < 64; o <<= 1) v += __shfl_xor(v, o);
    return v; }
DI float wave_max(float v) {
#pragma unroll
    for (int o = 1; o < 64; o <<= 1) v = fmaxf(v, __shfl_xor(v, o));
    return v; }
DI float gelu_tanh(float x) { const float u = 0.7978845608028654f * (x + 0.044715f * x * x * x); const float e = __builtin_amdgcn_exp2f(u * 2.885390081777927f);   const float t = 1.0f - 2.0f / (e + 1.0f); return 0.5f * x * (1.0f + t); }
DI float* sel3(float* const (&a)[3], int g) { return g == 0 ? a[0] : (g == 1 ? a[1] : a[2]); }
DI const float* sel3c(const float* const (&a)[3], int g) { return g == 0 ? a[0] : (g == 1 ? a[1] : a[2]); }
__host__ DI size_t ktile_off(int t, int d) { const int blk = t >> 5, kk = t & 31, b = (kk >> 2) & 1, i = 4 * (kk >> 3) + (kk & 3), s = d >> 5, c = (d & 31) >> 3; return ((size_t)(blk * 4 + 2 * b + s) * 64 + i + 16 * c) * 8 + (d & 7); }
__host__ DI size_t vtile_off(int dim, int t) { const int blk = t >> 5, kk = t & 31; return ((size_t)(blk * 4 + (dim >> 4)) * 64 + (dim & 15) + 16 * (kk >> 3)) * 8 + (kk & 7); }
struct Ctx { LAS unsigned char* lds; int tid, lane, wave, vcu, G; };
DI int row_pos(int r) { return r < M0 ? (r & (SEQ - 1)) : PAST_LEN; }

struct ColSrc { const float* p; int ld; };
DI int rope_il(int e) { return (e >> 1) + 32 * (e & 1); }
DI ColSrc col_wa(const FP& P, int n) {
    const int t = n >> 8, ct = n & 255, h = ct >> 6, e = ct & 63; if (t >= 9) return ColSrc{P.w_in_a + DIL_COLS + ct, ACOLS};
    const int j = t % 3, d = (j < 2) ? rope_il(e) : e; return ColSrc{P.w_in_a + t * 256 + h * 64 + d, ACOLS}; }
DI ColSrc col_wb(const FP& P, int n) {
    const int t = n >> 8, ct = n & 255, e = ct & 63;
    if (t < 3) { const int ty = 2 * t + (ct >> 7), kvh = (ct >> 6) & 1; const bool rot = (ty == 2 || ty == 4); return ColSrc{P.w_kv_b + (ty * NSA_KV_HEADS + kvh) * 64 + (rot ? rope_il(e) : e), KVCOLS}; }
    if (t < 6) { const int h = (t - 3) * 4 + (ct >> 6); return ColSrc{P.w_in_b + h * 64 + rope_il(e), BCOLS}; }
    if (t == 6) return ColSrc{P.w_in_b + NSA_Q_COLS + NSA_GATE_COLS + ct, BCOLS};
    if (ct < NSA_GATE_COLS) return ColSrc{P.w_in_b + NSA_Q_COLS + ct, BCOLS};
    return ColSrc{nullptr, 0}; }
DI ColSrc col_wmem(const FP& P, int n) { const int l = n >> 9, c = n & 511; return ColSrc{P.w_mem_kv + (size_t)l * D_MODEL * 512 + c, 512}; }
DI ColSrc col_woa(const FP& P, int n) { return ColSrc{P.w_out_a + n, D_MODEL}; }
DI ColSrc col_wob(const FP& P, int n) { return ColSrc{P.w_out_b + n, D_MODEL}; }
DI ColSrc col_cw1(const FP& P, int n) {
    const int ty = n >> 8, half = (n >> 7) & 1, hid = n & 127; return ColSrc{P.cmp_w1 + (size_t)ty * CMP_BLOCK * HEAD_DIM * CMP_HIDDEN + (size_t)half * 16 * HEAD_DIM * CMP_HIDDEN + hid, CMP_HIDDEN}; }
template <class CF> DI void transpose_item(const FP& P, CF cf, int K, bf16* WT, LAS float* scr, int item, int nblk, int lane) {
    const int kb = item / nblk, nb = item % nblk, k0 = 64 * kb, n0 = 32 * nb;
    const ColSrc cs = cf(P, n0 + (lane & 31));
#pragma unroll 8
    for (int i = 0; i < 32; ++i) { const int kk = 2 * i + (lane >> 5); scr[kk * 33 + (lane & 31)] = cs.p ? cs.p[(size_t)(k0 + kk) * cs.ld] : 0.f; }
    asm volatile("s_waitcnt lgkmcnt(0)" ::: "memory");
    const int c = lane & 7;
#pragma unroll
    for (int j = 0; j < 4; ++j) { const int n = (lane >> 3) + 8 * j; const LAS float* s = scr + (8 * c) * 33 + n;
        u32x4 o; o.x = pk2(s[0 * 33], s[1 * 33]); o.y = pk2(s[2 * 33], s[3 * 33]); o.z = pk2(s[4 * 33], s[5 * 33]); o.w = pk2(s[6 * 33], s[7 * 33]);
        *(u32x4*)(WT + (size_t)(n0 + n) * K + k0 + 8 * c) = o; }
    asm volatile("s_waitcnt lgkmcnt(0)" ::: "memory");
}
DI void cvt_row1024(const float* src, bf16* dst, int lane) {
#pragma unroll
    for (int j = 0; j < 4; ++j) { f32x4 v = src ? *(const f32x4*)(src + 256 * j + 4 * lane) : (f32x4){0.f, 0.f, 0.f, 0.f}; u32x2 o; o.x = pk2(v.x, v.y); o.y = pk2(v.z, v.w); *(u32x2*)(dst + 256 * j + 4 * lane) = o; }
}
DI void cvt_row1024_fp8(const float* src, unsigned char* dst, float sc, int lane) { u32x4 o; unsigned w[4];
#pragma unroll
    for (int j = 0; j < 4; ++j) { const f32x4 v = *(const f32x4*)(src + 16 * lane + 4 * j) * sc; int t = __builtin_amdgcn_cvt_pk_fp8_f32(v.x, v.y, 0, false); t = __builtin_amdgcn_cvt_pk_fp8_f32(v.z, v.w, t, true); w[j] = (unsigned)t; }
    o.x = w[0]; o.y = w[1]; o.z = w[2]; o.w = w[3]; *(u32x4*)(dst + 16 * lane) = o; }
DI void p0_prologue(const FP& P, const Ctx& C) {
    LAS float* scr = (LAS float*)(C.lds + C.wave * 16384);
    const int gw = C.vcu * NWAVES + C.wave, NGW = C.G * NWAVES, lane = C.lane;
    { constexpr int IA = (D_MODEL / 64) * (ACOLS / 32), IM = (D_MODEL / 64) * (1024 / 32), IOA = (512 / 64) * (D_MODEL / 32), IOB = (1024 / 64) * (D_MODEL / 32), IB = (D_MODEL / 64) * (NB_T / 32), IC = (1024 / 64) * (512 / 32);
      constexpr int NIT = IA + IM + IOA + IOB + IB + IC;
      for (int it = gw; it < NIT; it += NGW) { int r = it;
          if (r < IA) { transpose_item(P, col_wa, D_MODEL, P.WA_T, scr, r, ACOLS / 32, lane); continue; } r -= IA;
          if (r < IM) { transpose_item(P, col_wmem, D_MODEL, P.WMEM_T, scr, r, 1024 / 32, lane); continue; } r -= IM;
          if (r < IOA) { transpose_item(P, col_woa, 512, P.WOA_T, scr, r, D_MODEL / 32, lane); continue; } r -= IOA;
          if (r < IOB) { transpose_item(P, col_wob, 1024, P.WOB_T, scr, r, D_MODEL / 32, lane); continue; } r -= IOB;
          if (r < IB) { transpose_item(P, col_wb, D_MODEL, P.WB_T, scr, r, NB_T / 32, lane); continue; } r -= IB;
          transpose_item(P, col_cw1, 1024, P.CW1_T, scr, r, 512 / 32, lane); } }
    for (int r = gw; r < MPAD; r += NGW) { cvt_row1024(r < M0 ? P.x_prompt + (size_t)r * D_MODEL : (r < MP ? P.x_sample + (size_t)(r - M0) * D_MODEL : nullptr), P.XB0 + (size_t)r * D_MODEL, lane);
        if (r >= MP) { cvt_row1024(nullptr, P.X1B + (size_t)r * D_MODEL, lane); cvt_row1024(nullptr, P.X2B + (size_t)r * D_MODEL, lane); cvt_row1024(nullptr, P.X3B + (size_t)r * D_MODEL, lane);
            for (int c = lane; c < 512; c += 64) { P.ATTA[(size_t)r * 512 + c] = 0; P.ATTB[(size_t)r * 1024 + c] = 0; P.ATTB[(size_t)r * 1024 + 512 + c] = 0; } } }
    for (int r = gw; r < BATCH * MEM_TOKENS; r += NGW) cvt_row1024(P.mem_prompt + (size_t)r * D_MODEL, P.MEMB + (size_t)r * D_MODEL, lane);
#pragma unroll 1
    for (int r = 2 * gw; r < DEPTH * PEER_EXPERTS; r += 2 * NGW) { f32x4 a[16];
#pragma unroll
        for (int q = 0; q < 4; ++q) { const float* s0 = (q < 2 ? P.peer_u : P.peer_v) + (size_t)(r + (q & 1)) * D_MODEL + 16 * lane;
#pragma unroll
            for (int j = 0; j < 4; ++j) a[4 * q + j] = *(const f32x4*)(s0 + 4 * j); }
#pragma unroll
        for (int q = 0; q < 4; ++q) { const float sc = q < 2 ? 256.f : 64.f; unsigned w[4];
#pragma unroll
            for (int j = 0; j < 4; ++j) { const f32x4 v = a[4 * q + j] * sc; int t = __builtin_amdgcn_cvt_pk_fp8_f32(v.x, v.y, 0, false); t = __builtin_amdgcn_cvt_pk_fp8_f32(v.z, v.w, t, true); w[j] = (unsigned)t; }
            u32x4 o; o.x = w[0]; o.y = w[1]; o.z = w[2]; o.w = w[3]; *(u32x4*)((q < 2 ? P.UB8 : P.VB8) + (size_t)(r + (q & 1)) * D_MODEL + 16 * lane) = o; } }
    for (int i = gw * 64 + lane; i < NPOS * 32; i += NGW * 64) { const int pos = i >> 5, d = i & 31; const double inv = exp2(-(double)d * (13.287712379549449 / 32.0)); const double turns = (double)pos * inv * 0.15915494309189535;
        const float fr = (float)(turns - floor(turns)); P.ROPE[pos * 64 + d] = __builtin_amdgcn_cosf(fr); P.ROPE[pos * 64 + 32 + d] = __builtin_amdgcn_sinf(fr); }
    for (int i = gw; i < 2 * CMP_HIDDEN; i += NGW) { const int ty = i / CMP_HIDDEN, hid = i % CMP_HIDDEN; float a = 0.f;
#pragma unroll 8
        for (int k = lane; k < CMP_BLOCK * HEAD_DIM; k += 64) a += P.cmp_pe[ty * CMP_BLOCK * HEAD_DIM + k] * P.cmp_w1[((size_t)ty * CMP_BLOCK * HEAD_DIM + k) * CMP_HIDDEN + hid];
        a = wave_sum(a); if (lane == 0) P.CBIAS[i] = a; }
    for (int it = gw; it < DEC_BATCH * (PAST_LEN / PAGE_SIZE); it += NGW) { const int n = it / (PAST_LEN / PAGE_SIZE), pi = it % (PAST_LEN / PAGE_SIZE); const int pg = P.page_table[it];
        const float* src = P.cache_nsa_kv + (size_t)pg * PAGE_SIZE * 512 + 4 * lane; const int ty = lane >> 5, kvh = (lane >> 4) & 1, d = (4 * lane) & 63;
        bf16* dst = P.AC + ((size_t)ty * ACROWS + ((size_t)(BATCH + n) * NSA_KV_HEADS + kvh) * NCH + pi * (PAGE_SIZE / 16)) * 1024 + d;
#pragma unroll 1
        for (int r0 = 0; r0 < PAGE_SIZE; r0 += 8) { f32x4 v[8];
#pragma unroll
            for (int u = 0; u < 8; ++u) v[u] = *(const f32x4*)(src + (size_t)(r0 + u) * 512);
#pragma unroll
            for (int u = 0; u < 8; ++u) { const int t = r0 + u; u32x2 o; o.x = pk2(v[u].x, v[u].y); o.y = pk2(v[u].z, v[u].w); *(u32x2*)(dst + (size_t)(t / 16) * 1024 + (t % 16) * 64) = o; } } }
    for (int g = 0; g < 4; ++g) { const int W = g < 3 ? dil_w(g) : SWA_WINDOW, RV = g < 3 ? 128 : 64;
        const f32x4* src = (const f32x4*)(g < 3 ? sel3c(P.cache_dil, g) : P.cache_nsa_win); f32x4* dst = (f32x4*)(g < 3 ? sel3(P.dil_s, g) : P.win_s);
        const long per = (long)(W - 1) * RV, nvec = (long)DEC_BATCH * per;
#pragma unroll 1
        for (long i0 = (long)gw * 512; i0 < nvec; i0 += (long)NGW * 512) { f32x4 v[8]; long idx[8];
#pragma unroll
            for (int u = 0; u < 8; ++u) { const long i = i0 + u * 64 + lane; const long ii = i < nvec ? i : nvec - 1; const long n = ii / per, o = ii % per; idx[u] = n * (per + RV) + o; v[u] = src[idx[u] + RV]; }
#pragma unroll
            for (int u = 0; u < 8; ++u) { const long i = i0 + u * 64 + lane; if (i < nvec) dst[idx[u]] = v[u]; } } }
}
DI void p0_wpk(const FP& P, const Ctx& C) {
    LAS float* sw = (LAS float*)C.lds;
    LAS float* sk = (LAS float*)(C.lds + 32768);
    constexpr int NIT = DEPTH * 16 * (D_MODEL / 64);
    for (int it = C.vcu; it < NIT; it += C.G) { const int l = it / (16 * (D_MODEL / 64)), rem = it % (16 * (D_MODEL / 64)), hc = rem / (D_MODEL / 64), kb = rem % (D_MODEL / 64);
        __syncthreads();
        for (int i = C.tid; i < 64 * 64; i += NTHREADS) { const int r = i >> 6, d = i & 63; sw[r * 65 + d] = P.peer_wq[((size_t)l * D_MODEL + kb * 64 + r) * 1024 + hc * 64 + d]; }
        for (int i = C.tid; i < 128 * 64; i += NTHREADS) { const int r = i >> 6, d = i & 63; sk[r * 65 + d] = P.peer_keys[(((size_t)l * 16 + hc) * PEER_KEYS + r) * 64 + d]; }
        __syncthreads();
        for (int o = C.tid; o < 128 * 64; o += NTHREADS) { const int kk = o >> 6, ki = o & 63; float a = 0.f;
#pragma unroll 16
            for (int d = 0; d < 64; ++d) a += sw[ki * 65 + d] * sk[kk * 65 + d];
            P.WPK_T[((size_t)l * NPK + hc * 128 + kk) * D_MODEL + kb * 64 + ki] = (bf16)f2bf(a); } }
    __syncthreads();
}

#define EPI_LOOP(...) int fr_l = fr, fq_l = fq; asm volatile("" : "+v"(fr_l), "+v"(fq_l));     \
    _Pragma("unroll") for (int ai = 0; ai < 2; ++ai) _Pragma("unroll") for (int m = 0; m < 4; ++m) { const int row = u.pm * 256 + ai * 128 + wr * 64 + m * 16 + fr_l; \
    _Pragma("unroll") for (int bj = 0; bj < 2; ++bj) { const int ct = bj * 128 + wc * 32 + fq_l * 8; const f32x4 v0 = acc[ai][bj][m][0], v1 = acc[ai][bj][m][1]; __VA_ARGS__ } asm volatile("" ::: "memory"); }
DI void rope4(const float* rope_row, int dp, const f32x4& v0, const f32x4& v1, f32x4& lo, f32x4& hi) {
    const f32x4 c = *(const f32x4*)(rope_row + dp), s = *(const f32x4*)(rope_row + 32 + dp);
    lo.x = v0.x * c.x - v0.y * s.x; hi.x = v0.y * c.x + v0.x * s.x; lo.y = v0.z * c.y - v0.w * s.y; hi.y = v0.w * c.y + v0.z * s.y;
    lo.z = v1.x * c.z - v1.y * s.z; hi.z = v1.y * c.z + v1.x * s.z; lo.w = v1.z * c.w - v1.w * s.w; hi.w = v1.w * c.w + v1.z * s.w; }
DI u32x2 pk4(const f32x4& v) { u32x2 o; o.x = pk2(v.x, v.y); o.y = pk2(v.z, v.w); return o; }
DI u32x4 pk8(const f32x4& a, const f32x4& b) { u32x4 o; o.x = pk2(a.x, a.y); o.y = pk2(a.z, a.w); o.z = pk2(b.x, b.y); o.w = pk2(b.z, b.w); return o; }
DI int dil_perm(int t, int d) { return (t % d) * (SEQ / d) + t / d; }
struct EpiA {
    static constexpr bool PERM = true, AFTER_DRAIN = false; const FP& P;
    DI void operator()(const f32x4 (&acc)[2][2][4][2], const pg8::Unit& u, int wr, int wc, int fr, int fq) const {
        const int t9 = u.pn; const int g = t9 / 3, j = t9 % 3;
        EPI_LOOP({ if (row < MP) { const int h = ct >> 6, e = ct & 63; const int pos = row_pos(row);
            if (t9 == 9) { *(u32x4*)(P.MQA + (size_t)row * 256 + ct) = pk8(v0 * QSCALE, v1 * QSCALE); }
            else if (j < 2) { f32x4 lo, hi; const int dp = e >> 1; rope4(P.ROPE + pos * 64, dp, v0, v1, lo, hi);
                if (j == 0) { bf16* q = P.QA + ((size_t)g * MPAD + row) * 256 + h * 64 + dp; *(u32x2*)q = pk4(lo * QSCALE); *(u32x2*)(q + 32) = pk4(hi * QSCALE); }
                else { if (row < M0) { bf16* kt = P.KA + ((size_t)(g * BATCH + row / SEQ) * DIL_HEADS + h) * 64 * SEQ; const int cm = dil_perm(pos, dil_d(g)); *(u32x2*)(kt + ktile_off(cm, dp)) = pk4(lo); *(u32x2*)(kt + ktile_off(cm, dp + 32)) = pk4(hi); }
                    const int W = dil_w(g); float* o = nullptr;
                    if (row >= M0) o = sel3(P.dil_s, g) + (((size_t)(row - M0) * W + W - 1) * 2 + 0) * 256; else if (pos >= SEQ - W) o = sel3(P.dil_p, g) + (((size_t)(row / SEQ) * W + pos - (SEQ - W)) * 2 + 0) * 256;
                    if (o) { *(f32x4*)(o + h * 64 + dp) = lo; *(f32x4*)(o + h * 64 + 32 + dp) = hi; } } }
            else { const int W = dil_w(g), d = dil_d(g); float* o = nullptr;
                if (row >= M0) o = sel3(P.dil_s, g) + (((size_t)(row - M0) * W + W - 1) * 2 + 1) * 256; else if (pos >= SEQ - W) o = sel3(P.dil_p, g) + (((size_t)(row / SEQ) * W + pos - (SEQ - W)) * 2 + 1) * 256;
                if (o) { *(f32x4*)(o + ct) = v0; *(f32x4*)(o + ct + 4) = v1; }
                if (row < M0) { bf16* vt = P.VTA + ((size_t)(g * BATCH + row / SEQ) * DIL_HEADS + h) * 64 * SEQ + vtile_off(e, dil_perm(pos, d));
                    vt[0] = (bf16)f2bf(v0.x); vt[8] = (bf16)f2bf(v0.y); vt[16] = (bf16)f2bf(v0.z); vt[24] = (bf16)f2bf(v0.w); vt[32] = (bf16)f2bf(v1.x); vt[40] = (bf16)f2bf(v1.y); vt[48] = (bf16)f2bf(v1.z); vt[56] = (bf16)f2bf(v1.w); } } } })
    }
};
struct EpiMem {
    static constexpr bool PERM = true, AFTER_DRAIN = false; const FP& P;
    DI void operator()(const f32x4 (&acc)[2][2][4][2], const pg8::Unit& u, int wr, int wc, int fr, int fq) const {
        const int l = u.pn >> 1, half = u.pn & 1;
        EPI_LOOP({ const int n = row / MEM_TOKENS, mt = row % MEM_TOKENS; float* o = P.mem_kv_p + (((size_t)l * BATCH + n) * MEM_TOKENS + mt) * 512 + half * 256 + ct; *(f32x4*)o = v0; *(f32x4*)(o + 4) = v1;
            if (half == 0) *(u32x4*)(P.MK + (((size_t)l * BATCH + n) * MEM_HEADS + (ct >> 6)) * MEM_TOKENS * 64 + ktile_off(mt, ct & 63)) = pk8(v0, v1);
            else { bf16* vt = P.MVT + (((size_t)l * BATCH + n) * MEM_HEADS + (ct >> 6)) * MEM_TOKENS * 64 + vtile_off(ct & 63, mt);
                vt[0] = (bf16)f2bf(v0.x); vt[8] = (bf16)f2bf(v0.y); vt[16] = (bf16)f2bf(v0.z); vt[24] = (bf16)f2bf(v0.w); vt[32] = (bf16)f2bf(v1.x); vt[40] = (bf16)f2bf(v1.y); vt[48] = (bf16)f2bf(v1.z); vt[56] = (bf16)f2bf(v1.w); } })
    }
};
struct EpiPre {
    static constexpr bool PERM = true, AFTER_DRAIN = false; const float* xa; const float* xb; float* pre;
    DI void operator()(const f32x4 (&acc)[2][2][4][2], const pg8::Unit& u, int wr, int wc, int fr, int fq) const {
        EPI_LOOP({ if (row < MP) { const int col = u.pn * 256 + ct; const float* x = (xb && row >= M0) ? xb + (size_t)(row - M0) * D_MODEL + col : xa + (size_t)row * D_MODEL + col;
            const f32x4 a = *(const f32x4*)x, b = *(const f32x4*)(x + 4); float* o = pre + (size_t)row * D_MODEL + col; *(f32x4*)o = a * ALPHA + v0; *(f32x4*)(o + 4) = b * ALPHA + v1; } })
    }
};
struct EpiF32 {
    static constexpr bool PERM = true, AFTER_DRAIN = false; float* out; int ldc; int nrows;
    DI void operator()(const f32x4 (&acc)[2][2][4][2], const pg8::Unit& u, int wr, int wc, int fr, int fq) const {
        EPI_LOOP({ if (row < nrows) { float* o = out + (size_t)row * ldc + u.pn * 256 + ct; *(f32x4*)o = v0; *(f32x4*)(o + 4) = v1; } })
    }
};
}
namespace fx {
struct Tile16 { f32x4 o[4]; float m, l; };
DI void tile_init(Tile16& T) { T.o[0] = T.o[1] = T.o[2] = T.o[3] = (f32x4){0.f, 0.f, 0.f, 0.f}; T.m = -INFINITY; T.l = 0.f; }
typedef __bf16 bf16x2_t __attribute__((ext_vector_type(2)));
DI unsigned cvtpk(float lo, float hi) { const f32x2 v = {lo, hi}; const bf16x2_t b = __builtin_convertvector(v, bf16x2_t); return __builtin_bit_cast(unsigned, b); }
struct KV8 { bf16x8 ka0, ka1, kb0, kb1, v0, v1, v2, v3; };
DI void kv_load(KV8& r, const bf16* k0, const bf16* k1, const bf16* v, long vs16) {
    r.ka0 = *(const bf16x8*)k0; r.ka1 = *(const bf16x8*)(k0 + 32); r.kb0 = *(const bf16x8*)k1; r.kb1 = *(const bf16x8*)(k1 + 32);
    r.v0 = *(const bf16x8*)v; r.v1 = *(const bf16x8*)(v + vs16); r.v2 = *(const bf16x8*)(v + 2 * vs16); r.v3 = *(const bf16x8*)(v + 3 * vs16); }
template <class MaskF> DI void tile_compute(Tile16& T, const bf16x8 (&qf)[2], const KV8& r, MaskF mask) {
    f32x4 s0 = (f32x4){0.f, 0.f, 0.f, 0.f}, s1 = (f32x4){0.f, 0.f, 0.f, 0.f};
    s0 = __builtin_amdgcn_mfma_f32_16x16x32_bf16(r.ka0, qf[0], s0, 0, 0, 0); s0 = __builtin_amdgcn_mfma_f32_16x16x32_bf16(r.ka1, qf[1], s0, 0, 0, 0);
    s1 = __builtin_amdgcn_mfma_f32_16x16x32_bf16(r.kb0, qf[0], s1, 0, 0, 0); s1 = __builtin_amdgcn_mfma_f32_16x16x32_bf16(r.kb1, qf[1], s1, 0, 0, 0);
    float s[8] = {s0.x, s0.y, s0.z, s0.w, s1.x, s1.y, s1.z, s1.w};
    float mx = -INFINITY;
#pragma unroll
    for (int e = 0; e < 8; ++e) { s[e] = mask(e) ? s[e] : -INFINITY; mx = fmaxf(mx, s[e]); }
    mx = fmaxf(mx, __shfl_xor(mx, 16)); mx = fmaxf(mx, __shfl_xor(mx, 32));
    const float mnew = fmaxf(T.m, mx), muse = (mnew == -INFINITY) ? 0.f : mnew;
    const float alpha = __builtin_amdgcn_exp2f(T.m - muse);
    float ls = 0.f;
#pragma unroll
    for (int e = 0; e < 8; ++e) { s[e] = __builtin_amdgcn_exp2f(s[e] - muse); ls += s[e]; }
    ls += __shfl_xor(ls, 16); ls += __shfl_xor(ls, 32);
    T.l = T.l * alpha + ls; T.m = mnew;
    u32x4 pw; pw.x = cvtpk(s[0], s[1]); pw.y = cvtpk(s[2], s[3]); pw.z = cvtpk(s[4], s[5]); pw.w = cvtpk(s[6], s[7]);
    const bf16x8 pf = __builtin_bit_cast(bf16x8, pw);
    T.o[0] = __builtin_amdgcn_mfma_f32_16x16x32_bf16(r.v0, pf, T.o[0] * alpha, 0, 0, 0); T.o[1] = __builtin_amdgcn_mfma_f32_16x16x32_bf16(r.v1, pf, T.o[1] * alpha, 0, 0, 0);
    T.o[2] = __builtin_amdgcn_mfma_f32_16x16x32_bf16(r.v2, pf, T.o[2] * alpha, 0, 0, 0); T.o[3] = __builtin_amdgcn_mfma_f32_16x16x32_bf16(r.v3, pf, T.o[3] * alpha, 0, 0, 0);
}
template <class LD, class CP> DI void pipe2(int n, LD ld, CP cp) { if (n <= 0) return; KV8 A, B; ld(A, 0);
#pragma unroll 1
    for (int i = 0; i < n; i += 2) { ld(B, (i + 1 < n) ? i + 1 : i); cp(A, i); ld(A, (i + 2 < n) ? i + 2 : i); if (i + 1 < n) cp(B, i + 1); } }
DI void kv_load_t(KV8& r, const bf16* kt, const bf16* vt, int lane) {
    const bf16* k = kt + lane * 8; const bf16* v = vt + lane * 8;
    r.ka0 = *(const bf16x8*)k; r.ka1 = *(const bf16x8*)(k + 512); r.kb0 = *(const bf16x8*)(k + 1024); r.kb1 = *(const bf16x8*)(k + 1536);
    r.v0 = *(const bf16x8*)v; r.v1 = *(const bf16x8*)(v + 512); r.v2 = *(const bf16x8*)(v + 1024); r.v3 = *(const bf16x8*)(v + 1536); }
DI int krow_of(int i, int b) { return 8 * (i >> 2) + 4 * b + (i & 3); }

DI void dil_micro(const FP& P, int n, int h, int t0, int mt, int lane) {
    const int g = mt >> 4, idx = mt & 15, d = dil_d(g), per = 16 / d;
    const int r = idx / per, sub = idx % per, i0 = t0 / d + 16 * sub, ib = i0 - 128, NC = SEQ / d;
    const int q = lane & 15, c = lane >> 4;
    const bf16* Qb = P.QA + ((size_t)g * MPAD + (size_t)n * SEQ) * 256 + h * 64;
    const bf16* Kb = P.KA + ((size_t)(g * BATCH + n) * DIL_HEADS + h) * 64 * SEQ + (size_t)r * NC * 64; const bf16* Vb = P.VTA + ((size_t)(g * BATCH + n) * DIL_HEADS + h) * 64 * SEQ + (size_t)r * NC * 64;
    bf16x8 qf[2]; { const bf16* qp = Qb + (size_t)(r + d * (i0 + q)) * 256 + 8 * c; qf[0] = *(const bf16x8*)qp; qf[1] = *(const bf16x8*)(qp + 32); }
    Tile16 T; tile_init(T);
    const int qi = i0 + q; const int tb0 = ib >> 5  , nblk = ((i0 + 15) >> 5) - tb0 + 1;
    pipe2(nblk, [&](KV8& kv, int i) { int tb = tb0 + i; tb = tb < 0 ? 0 : tb; kv_load_t(kv, Kb + (size_t)tb * 2048, Vb + (size_t)tb * 2048, lane); },
          [&](const KV8& kv, int i) { const int kb = 32 * (tb0 + i); tile_compute(T, qf, kv, [&](int e) { const int ki = kb + 8 * c + e; return ki >= 0 && ki <= qi && qi - ki <= DIL_TAPS - 1; }); });
    const int row = n * SEQ + r + d * qi;
    float* op = P.DPART + (((size_t)g * MP + row) * DIL_HEADS + h) * 64 + 4 * c;
#pragma unroll
    for (int db = 0; db < 4; ++db) *(f32x4*)(op + 16 * db) = T.o[db];
    if (c == 0) { float* ml = P.DML + (((size_t)g * MP + row) * DIL_HEADS + h) * 2; ml[0] = T.m; ml[1] = T.l; }
}
DI void mem_micro(const FP& P, const bf16* Q  , int ldq, int row0, int layer, int n, int h, bf16* O  , int ldo, int lane) {
    const int q = lane & 15, c = lane >> 4;
    bf16x8 qf[2]; { const bf16* qp = Q + (size_t)(row0 + q) * ldq + 8 * c; qf[0] = *(const bf16x8*)qp; qf[1] = *(const bf16x8*)(qp + 32); }
    const bf16* Kb = P.MK + (((size_t)layer * BATCH + n) * MEM_HEADS + h) * MEM_TOKENS * 64; const bf16* Vb = P.MVT + (((size_t)layer * BATCH + n) * MEM_HEADS + h) * MEM_TOKENS * 64;
    Tile16 T; tile_init(T);
    pipe2(MEM_TOKENS / 32, [&](KV8& kv, int i) { kv_load_t(kv, Kb + (size_t)i * 2048, Vb + (size_t)i * 2048, lane); }, [&](const KV8& kv, int) { tile_compute(T, qf, kv, [&](int) { return true; }); });
    const float inv = 1.0f / T.l; bf16* op = O + (size_t)(row0 + q) * ldo + 4 * c;
#pragma unroll
    for (int db = 0; db < 4; ++db) *(u32x2*)(op + 16 * db) = pk4(T.o[db] * inv);
}
struct Dec { float m, l, o; };
template <class KF, class VF> DI void dec_chunk(Dec& D, const LAS float* q, int nk, KF kf, VF vf, int lane) {
    float s = -INFINITY;
    if (lane < nk) { const float* k = kf(lane); float a = 0.f;
#pragma unroll
        for (int d4 = 0; d4 < 16; ++d4) { const f32x4 kv = *(const f32x4*)(k + 4 * d4); a += kv.x * q[4 * d4] + kv.y * q[4 * d4 + 1] + kv.z * q[4 * d4 + 2] + kv.w * q[4 * d4 + 3]; }
        s = a; }
    const float mx = wave_max(s), mnew = fmaxf(D.m, mx), alpha = __builtin_amdgcn_exp2f(D.m - mnew);
    const float p = (lane < nk) ? __builtin_amdgcn_exp2f(s - mnew) : 0.f;
    D.l = D.l * alpha + wave_sum(p); D.m = mnew; float o = D.o * alpha;
    for (int j0 = 0; j0 < nk; j0 += 8) { float vv[8];
#pragma unroll
        for (int u = 0; u < 8; ++u) { const int jj = (j0 + u < nk) ? j0 + u : nk - 1; vv[u] = vf(jj)[lane]; }
#pragma unroll
        for (int u = 0; u < 8; ++u) { const float pj = (j0 + u < nk) ? __builtin_bit_cast(float, __builtin_amdgcn_readlane(__builtin_bit_cast(int, p), (j0 + u) & 63)) : 0.f; o += pj * vv[u]; } }
    D.o = o;
}
DI void atta_phase(const FP& P, const Ctx& C) {
    const int lane = C.lane, w = C.wave;
    constexpr int NT = SEQ / 256, NIT = BATCH * NT * DIL_HEADS;
    for (int it = C.vcu; it < NIT; it += C.G) { const int h = it % DIL_HEADS, tt = (it / DIL_HEADS) % NT, n = it / (DIL_HEADS * NT), t0 = tt * 256;
        for (int mt = w; mt < 48; mt += NWAVES) dil_micro(P, n, h, t0, mt, lane);
        asm volatile("s_waitcnt vmcnt(0)" ::: "memory"); __syncthreads();
        for (int i = C.tid; i < 256 * 16; i += NTHREADS) { const int tk = i >> 4, d4 = (i & 15) * 4; const int row = n * SEQ + t0 + tk;
            float mg[3], lg[3]; float M = -INFINITY;
#pragma unroll
            for (int g = 0; g < 3; ++g) { const float* ml = P.DML + (((size_t)g * MP + row) * DIL_HEADS + h) * 2; mg[g] = ml[0]; lg[g] = ml[1]; M = fmaxf(M, mg[g]); }
            f32x4 acc = (f32x4){0.f, 0.f, 0.f, 0.f}; float L = 0.f;
#pragma unroll
            for (int g = 0; g < 3; ++g) { const float wg = __builtin_amdgcn_exp2f(mg[g] - M); L += wg * lg[g]; acc += *(const f32x4*)(P.DPART + (((size_t)g * MP + row) * DIL_HEADS + h) * 64 + d4) * wg; }
            *(u32x2*)(P.ATTA + (size_t)row * 512 + h * 64 + d4) = pk4(acc * (1.0f / L)); }
        for (int mt = w; mt < 16; mt += NWAVES) mem_micro(P, P.MQA + h * 64, 256, n * SEQ + t0 + 16 * mt, 0, n, h, P.ATTA + 256 + h * 64, 512, lane);
        __syncthreads();
    }
    LAS float* qs = (LAS float*)(C.lds + w * 1024);
    const int gw = C.vcu * NWAVES + w, NGW = C.G * NWAVES;
    for (int it = gw; it < DEC_BATCH * DIL_HEADS * 2; it += NGW) { const int kind = it & 1, h = (it >> 1) % DIL_HEADS, ns = (it >> 1) / DIL_HEADS, row = M0 + ns;
        Dec D; D.m = -INFINITY; D.l = 0.f; D.o = 0.f;
        if (kind == 0) {
            for (int g = 0; g < 3; ++g) qs[g * 64 + lane] = bf2f(P.QA[((size_t)g * MPAD + row) * 256 + h * 64 + lane]);
            asm volatile("s_waitcnt lgkmcnt(0)" ::: "memory");
            for (int g = 0; g < 3; ++g) { const int W = dil_w(g), d = dil_d(g); const float* cache = sel3c(P.cache_dil, g) + (size_t)ns * W * 512; const float* newrow = sel3(P.dil_s, g) + ((size_t)ns * W + W - 1) * 512;
                for (int j0 = 0; j0 < DIL_TAPS; j0 += 64) { const int nk = (DIL_TAPS - j0) < 64 ? (DIL_TAPS - j0) : 64;
                    dec_chunk(D, qs + g * 64, nk, [&](int j) { const int tap = j0 + j; return (tap == 0 ? newrow : cache + (size_t)(W - d * tap) * 512) + h * 64; },
                              [&](int j) { const int tap = j0 + j; return (tap == 0 ? newrow : cache + (size_t)(W - d * tap) * 512) + 256 + h * 64; }, lane); } }
            P.ATTA[(size_t)row * 512 + h * 64 + lane] = (bf16)f2bf(D.o / D.l);
        } else {
            qs[lane] = bf2f(P.MQA[(size_t)row * 256 + h * 64 + lane]);
            asm volatile("s_waitcnt lgkmcnt(0)" ::: "memory");
            const float* mk = P.cache_mem_kv + ((size_t)0 * DEC_BATCH + ns) * MEM_TOKENS * 512;
            for (int j0 = 0; j0 < MEM_TOKENS; j0 += 64) dec_chunk(D, qs, 64, [&](int j) { return mk + (size_t)(j0 + j) * 512 + h * 64; }, [&](int j) { return mk + (size_t)(j0 + j) * 512 + 256 + h * 64; }, lane);
            P.ATTA[(size_t)row * 512 + 256 + h * 64 + lane] = (bf16)f2bf(D.o / D.l);
        }
    }
    __syncthreads();
}
DI void ln_phase(const FP& P, const Ctx& C, const float* pre, const float* gam, const float* bet, float* xo, bf16* xb, float* yp, float* ys) {
    const int gw = C.vcu * NWAVES + C.wave, NGW = C.G * NWAVES, lane = C.lane;
    for (int r = gw; r < MP; r += NGW) { const float* x = pre + (size_t)r * D_MODEL; f32x4 v[4]; float s = 0.f;
#pragma unroll
        for (int j = 0; j < 4; ++j) { v[j] = *(const f32x4*)(x + 256 * j + 4 * lane); s += (v[j].x + v[j].y) + (v[j].z + v[j].w); }
        const float mu = wave_sum(s) * (1.0f / D_MODEL); float s2 = 0.f;
#pragma unroll
        for (int j = 0; j < 4; ++j) { v[j] = v[j] - mu; s2 += (v[j].x * v[j].x + v[j].y * v[j].y) + (v[j].z * v[j].z + v[j].w * v[j].w); }
        const float rs = 1.0f / sqrtf(wave_sum(s2) * (1.0f / D_MODEL) + LN_EPS);
#pragma unroll
        for (int j = 0; j < 4; ++j) { const f32x4 gg = *(const f32x4*)(gam + 256 * j + 4 * lane), bb = *(const f32x4*)(bet + 256 * j + 4 * lane); const f32x4 o = v[j] * rs * gg + bb;
            if (xo) *(f32x4*)(xo + (size_t)r * D_MODEL + 256 * j + 4 * lane) = o;
            if (xb) *(u32x2*)(xb + (size_t)r * D_MODEL + 256 * j + 4 * lane) = pk4(o);
            if (yp) { if (r < M0) *(f32x4*)(yp + (size_t)r * D_MODEL + 256 * j + 4 * lane) = o; else *(f32x4*)(ys + (size_t)(r - M0) * D_MODEL + 256 * j + 4 * lane) = o; } }
    }
}
}
namespace fx {
#define INS16(V, I, v_, i_) do { const float _v = (v_); const int _i = (i_); bool _c[16]; _Pragma("unroll") for (int _k = 0; _k < 16; ++_k) _c[_k] = _v > V[_k]; \
    _Pragma("unroll") for (int _k = 15; _k >= 1; --_k) { V[_k] = _c[_k] ? (_c[_k - 1] ? V[_k - 1] : _v) : V[_k]; I[_k] = _c[_k] ? (_c[_k - 1] ? I[_k - 1] : _i) : I[_k]; } \
    V[0] = _c[0] ? _v : V[0]; I[0] = _c[0] ? _i : I[0]; } while (0)
DI void wave_top16_128(float a, float b, int lane, float& outv, int& outi) {
    outv = -INFINITY; outi = 0;
#pragma unroll 1
    for (int k = 0; k < 16; ++k) { const float m = wave_max(fmaxf(a, b)); const unsigned long long ba = __ballot(a == m), bb = __ballot(b == m); int idx;
        if (ba) { const int l = __builtin_ctzll(ba); idx = l; if (lane == l) a = -INFINITY; } else { const int l = __builtin_ctzll(bb); idx = 64 + l; if (lane == l) b = -INFINITY; }
        if (lane == k) { outv = m; outi = idx; } }
}
DI void topk_wave_item(const FP& P, long it, int lane) {
    const float* s = P.SCO + it * 256; float v1, v2; int i1, i2;
    wave_top16_128(s[lane], s[64 + lane], lane, v1, i1); wave_top16_128(s[128 + lane], s[192 + lane], lane, v2, i2);
    int a = 0, rem = lane; bool valid = false;
    for (int aa = 0; aa < 16; ++aa) { const int nb = 16 / (aa + 1); if (!valid) { if (rem < nb) { a = aa; valid = true; } else rem -= nb; } }
    const int b = valid ? rem : 0;
    float cs = __shfl(v1, a) + __shfl(v2, b); const int ce = __shfl(i1, a) * PEER_KEYS + __shfl(i2, b); if (!valid) cs = -INFINITY;
    float tv = -INFINITY; int te = 0;
#pragma unroll 1
    for (int k = 0; k < 16; ++k) { const float m = wave_max(cs); const unsigned long long bm = __ballot(cs == m); const int l = __builtin_ctzll(bm); const int e = __shfl(ce, l); if (lane == l) cs = -INFINITY; if (lane == k) { tv = m; te = e; } }
    const float mx = __shfl(tv, 0); const float ex = (lane < 16) ? __expf(tv - mx) : 0.f; const float z = wave_sum(ex);
    if (lane < 16) { P.SELG[it * 16 + lane] = ex / z; P.SELE[it * 16 + lane] = te; }
}
#define KINS16(V, key_) do { const float _key = (key_); _Pragma("unroll") for (int _k = 15; _k >= 1; --_k) V[_k] = __builtin_amdgcn_fmed3f(V[_k - 1], V[_k], _key); V[0] = fmaxf(V[0], _key); } while (0)
DI float pack_key(float v, unsigned lowbits, unsigned mask) { return __builtin_bit_cast(float, (__builtin_bit_cast(unsigned, v) & ~mask) | lowbits); }
DI void topk_phase(const FP& P, const Ctx& C) {
    const int lane = C.lane; LAS float* st = (LAS float*)(C.lds + C.wave * 16384);
    const int NWI = (M0 * PEER_HEADS) / 64;
    for (int wi = C.vcu * NWAVES + C.wave; wi < NWI; wi += C.G * NWAVES) {
        const long it0 = (long)wi * 64; const long it = it0 + lane;
        float V1[16], V2[16], V3[16];
#pragma unroll
        for (int k = 0; k < 16; ++k) { V1[k] = V2[k] = V3[k] = -INFINITY; }
#pragma unroll 1
        for (int ch = 0; ch < 8; ++ch) {
#pragma unroll
            for (int u = 0; u < 8; ++u) { const int f4 = u * 64 + lane, j = f4 >> 3, q = f4 & 7, hf = q >> 2, c4 = (q & 3) * 4; const long itj = it0 + j;
                const f32x4 v = *(const f32x4*)(P.SCO + itj * 256 + hf * 128 + ch * 16 + c4);
                st[j * 33 + hf * 16 + c4] = v.x; st[j * 33 + hf * 16 + c4 + 1] = v.y; st[j * 33 + hf * 16 + c4 + 2] = v.z; st[j * 33 + hf * 16 + c4 + 3] = v.w; }
            asm volatile("s_waitcnt lgkmcnt(0)" ::: "memory");
#pragma unroll 4
            for (int c = 0; c < 16; ++c) { const float va = st[lane * 33 + c], vb = st[lane * 33 + 16 + c]; const unsigned lb = 127u - (unsigned)(ch * 16 + c); KINS16(V1, pack_key(va, lb, 127u)); KINS16(V2, pack_key(vb, lb, 127u)); }
            asm volatile("s_waitcnt lgkmcnt(0)" ::: "memory");
        }
        LAS int* lc = (LAS int*)st;
        { int ord = 0;
#pragma unroll
          for (int a = 0; a < 16; ++a) { const unsigned ba = __builtin_bit_cast(unsigned, V1[a]); const float va = __builtin_bit_cast(float, ba & ~127u); const int ia = 127 - (int)(ba & 127u);
#pragma unroll
              for (int b = 0; b < 16; ++b) if ((a + 1) * (b + 1) <= 16) { const unsigned bb = __builtin_bit_cast(unsigned, V2[b]); const float vb = __builtin_bit_cast(float, bb & ~127u); const int ib = 127 - (int)(bb & 127u);
                  lc[lane * 51 + ord] = ia * PEER_KEYS + ib; KINS16(V3, pack_key(va + vb, 63u - (unsigned)ord, 63u)); ++ord; } } }
        asm volatile("s_waitcnt lgkmcnt(0)" ::: "memory");
        float g[16]; int e[16]; float z = 0.f; const float vmax = __builtin_bit_cast(float, __builtin_bit_cast(unsigned, V3[0]) & ~63u);
#pragma unroll
        for (int k = 0; k < 16; ++k) { const unsigned bk = __builtin_bit_cast(unsigned, V3[k]); e[k] = lc[lane * 51 + 63 - (int)(bk & 63u)]; g[k] = __expf(__builtin_bit_cast(float, bk & ~63u) - vmax); z += g[k]; }
        const float iz = 1.0f / z;
#pragma unroll
        for (int k4 = 0; k4 < 4; ++k4) { *(f32x4*)(P.SELG + it * 16 + 4 * k4) = (f32x4){g[4 * k4] * iz, g[4 * k4 + 1] * iz, g[4 * k4 + 2] * iz, g[4 * k4 + 3] * iz};
            *(int4*)(P.SELE + it * 16 + 4 * k4) = make_int4(e[4 * k4], e[4 * k4 + 1], e[4 * k4 + 2], e[4 * k4 + 3]); }
        asm volatile("s_waitcnt lgkmcnt(0)" ::: "memory");
    }
    for (int si = C.vcu * NWAVES + C.wave; si < DEC_BATCH * PEER_HEADS; si += C.G * NWAVES) topk_wave_item(P, (long)M0 * PEER_HEADS + si, lane);
    __syncthreads();
}
constexpr float PEER_SU = 256.f, PEER_SV = 64.f;
DI float dot16_fp8(const u32x4& w, const f32x2 (&x2)[8]) { f32x2 a = {0.f, 0.f};
    a += __builtin_amdgcn_cvt_pk_f32_fp8((int)w.x, false) * x2[0]; a += __builtin_amdgcn_cvt_pk_f32_fp8((int)w.x, true) * x2[1];
    a += __builtin_amdgcn_cvt_pk_f32_fp8((int)w.y, false) * x2[2]; a += __builtin_amdgcn_cvt_pk_f32_fp8((int)w.y, true) * x2[3];
    a += __builtin_amdgcn_cvt_pk_f32_fp8((int)w.z, false) * x2[4]; a += __builtin_amdgcn_cvt_pk_f32_fp8((int)w.z, true) * x2[5];
    a += __builtin_amdgcn_cvt_pk_f32_fp8((int)w.w, false) * x2[6]; a += __builtin_amdgcn_cvt_pk_f32_fp8((int)w.w, true) * x2[7];
    return a.x + a.y; }
DI void axpy16_fp8(const u32x4& w, float s, f32x2 (&o2)[8]) { const f32x2 s2 = {s, s};
    o2[0] += __builtin_amdgcn_cvt_pk_f32_fp8((int)w.x, false) * s2; o2[1] += __builtin_amdgcn_cvt_pk_f32_fp8((int)w.x, true) * s2;
    o2[2] += __builtin_amdgcn_cvt_pk_f32_fp8((int)w.y, false) * s2; o2[3] += __builtin_amdgcn_cvt_pk_f32_fp8((int)w.y, true) * s2;
    o2[4] += __builtin_amdgcn_cvt_pk_f32_fp8((int)w.z, false) * s2; o2[5] += __builtin_amdgcn_cvt_pk_f32_fp8((int)w.z, true) * s2;
    o2[6] += __builtin_amdgcn_cvt_pk_f32_fp8((int)w.w, false) * s2; o2[7] += __builtin_amdgcn_cvt_pk_f32_fp8((int)w.w, true) * s2; }
DI float rdlane(float v, int l) { return __builtin_bit_cast(float, __builtin_amdgcn_readlane(__builtin_bit_cast(int, v), l)); }
DI void peer_phase(const FP& P, const Ctx& C, int layer, const float* xin, float* fout, float* fout_s, bf16* xb) {
    const int lane = C.lane; const unsigned char* U = P.UB8 + (size_t)layer * PEER_EXPERTS * D_MODEL; const unsigned char* Vt = P.VB8 + (size_t)layer * PEER_EXPERTS * D_MODEL;
    const float* gam = P.ln_g + ((size_t)layer * 2 + 1) * D_MODEL; const float* bet = P.ln_b + ((size_t)layer * 2 + 1) * D_MODEL;
    const int nrounds = (M0 + C.G * NWAVES - 1) / (C.G * NWAVES);
#pragma unroll 1
    for (int rd = 0; rd <= nrounds; ++rd) {
        const bool smp = (rd == nrounds); int r = smp ? M0 + C.vcu : rd * C.G * NWAVES + C.vcu * NWAVES + C.wave; if (smp ? (C.vcu >= DEC_BATCH) : (r >= M0)) continue;
        const int pb = smp ? 16 * C.wave : 0, pe = smp ? pb + 16 : 128;
        f32x2 x2[8], o2[8];
#pragma unroll
        for (int j = 0; j < 4; ++j) { const f32x4 a = *(const f32x4*)(xin + (size_t)r * D_MODEL + 16 * lane + 4 * j); x2[2 * j] = (f32x2){a.x, a.y}; x2[2 * j + 1] = (f32x2){a.z, a.w}; }
#pragma unroll
        for (int k = 0; k < 8; ++k) o2[k] = (f32x2){0.f, 0.f};
        const int e_l = P.SELE[(size_t)r * 128 + lane], e_h = P.SELE[(size_t)r * 128 + 64 + lane]; const float g_l = P.SELG[(size_t)r * 128 + lane], g_h = P.SELG[(size_t)r * 128 + 64 + lane];
#pragma unroll 1
        for (int b0 = pb; b0 < pe; b0 += 8) {
            u32x4 uw[8], vw[8];
#pragma unroll
            for (int k = 0; k < 8; ++k) { const int hk = b0 + k; const int e = (hk < 64) ? __builtin_amdgcn_readlane(e_l, hk & 63) : __builtin_amdgcn_readlane(e_h, hk & 63);
                uw[k] = *(const u32x4*)(U + (size_t)e * D_MODEL + 16 * lane); vw[k] = *(const u32x4*)(Vt + (size_t)e * D_MODEL + 16 * lane); }
            float d[8];
#pragma unroll
            for (int k = 0; k < 8; ++k) d[k] = dot16_fp8(uw[k], x2);
            float e4[4], e2[2], e1;
            { const bool hi = lane & 1;
#pragma unroll
              for (int i = 0; i < 4; ++i) { const float keep = hi ? d[4 + i] : d[i], send = hi ? d[i] : d[4 + i]; e4[i] = keep + __shfl_xor(send, 1); } }
            { const bool hi = lane & 2;
#pragma unroll
              for (int i = 0; i < 2; ++i) { const float keep = hi ? e4[2 + i] : e4[i], send = hi ? e4[i] : e4[2 + i]; e2[i] = keep + __shfl_xor(send, 2); } }
            { const bool hi = lane & 4; const float keep = hi ? e2[1] : e2[0], send = hi ? e2[0] : e2[1]; e1 = keep + __shfl_xor(send, 4); }
            e1 += __shfl_xor(e1, 8); e1 += __shfl_xor(e1, 16); e1 += __shfl_xor(e1, 32);
            const int myk = 4 * (lane & 1) + (lane & 2) + ((lane >> 2) & 1); const int myhk = b0 + myk;
            const float myg = (myhk < 64) ? __shfl(g_l, myhk & 63) : __shfl(g_h, myhk & 63);
            const float act = myg * gelu_tanh(e1 * (1.0f / PEER_SU)) * (1.0f / PEER_SV);
#pragma unroll
            for (int k = 0; k < 8; ++k) { const int src = (k >> 2) | (((k >> 1) & 1) << 1) | ((k & 1) << 2); axpy16_fp8(vw[k], rdlane(act, src), o2); }
        }
        if (smp) {
            LAS float* red = (LAS float*)C.lds;
#pragma unroll
            for (int k = 0; k < 8; ++k) { red[C.wave * 1024 + 16 * lane + 2 * k] = o2[k].x; red[C.wave * 1024 + 16 * lane + 2 * k + 1] = o2[k].y; }
            asm volatile("s_waitcnt lgkmcnt(0)" ::: "memory"); __syncthreads();
            if (C.wave == 0) {
#pragma unroll
                for (int k = 0; k < 8; ++k) { float ax = 0.f, ay = 0.f;
#pragma unroll
                    for (int ww = 0; ww < NWAVES; ++ww) { ax += red[ww * 1024 + 16 * lane + 2 * k]; ay += red[ww * 1024 + 16 * lane + 2 * k + 1]; } o2[k] = (f32x2){ax, ay}; } }
            __syncthreads();
            if (C.wave != 0) continue; }
        float s = 0.f;
#pragma unroll
        for (int k = 0; k < 8; ++k) { o2[k] += x2[k] * ALPHA; s += o2[k].x + o2[k].y; }
        const float mu = wave_sum(s) * (1.0f / D_MODEL); float s2 = 0.f;
#pragma unroll
        for (int k = 0; k < 8; ++k) { o2[k] -= mu; s2 += o2[k].x * o2[k].x + o2[k].y * o2[k].y; }
        const float rs = 1.0f / sqrtf(wave_sum(s2) * (1.0f / D_MODEL) + LN_EPS);
        float* frow = (r < M0) ? fout + (size_t)r * D_MODEL : fout_s + (size_t)(r - M0) * D_MODEL;
#pragma unroll
        for (int j = 0; j < 4; ++j) { const int c0 = 16 * lane + 4 * j; const f32x4 gg = *(const f32x4*)(gam + c0), bb = *(const f32x4*)(bet + c0);
            const f32x4 y = (f32x4){o2[2 * j].x * rs, o2[2 * j].y * rs, o2[2 * j + 1].x * rs, o2[2 * j + 1].y * rs} * gg + bb;
            *(f32x4*)(frow + c0) = y; if (xb) *(u32x2*)(xb + (size_t)r * D_MODEL + c0) = pk4(y); }
    }
}
DI void peer_u_phase(const FP& P, const Ctx& C, int layer, const bf16* xb16) {
    const int lane = C.lane; const unsigned char* U = P.UB8 + (size_t)layer * PEER_EXPERTS * D_MODEL;
    const int s = (int)(blockIdx.x & 7), nw = (C.G >> 3) * NWAVES, widx = (int)(blockIdx.x >> 3) * NWAVES + C.wave;
#pragma unroll 1
    for (int r = widx; r < MP; r += nw) {
        const int e0 = P.SELE[(size_t)r * 128 + lane], e1 = P.SELE[(size_t)r * 128 + 64 + lane]; const float g0 = P.SELG[(size_t)r * 128 + lane], g1 = P.SELG[(size_t)r * 128 + 64 + lane];
        unsigned long long b0 = __ballot((e0 >> 11) == s), b1 = __ballot((e1 >> 11) == s);
        if ((b0 | b1) == 0ull) continue;
        f32x2 x2[8]; { const u32x4 xa = *(const u32x4*)(xb16 + (size_t)r * D_MODEL + 16 * lane), xc = *(const u32x4*)(xb16 + (size_t)r * D_MODEL + 16 * lane + 8);
            x2[0] = (f32x2){bflo(xa.x), bfhi(xa.x)}; x2[1] = (f32x2){bflo(xa.y), bfhi(xa.y)}; x2[2] = (f32x2){bflo(xa.z), bfhi(xa.z)}; x2[3] = (f32x2){bflo(xa.w), bfhi(xa.w)};
            x2[4] = (f32x2){bflo(xc.x), bfhi(xc.x)}; x2[5] = (f32x2){bflo(xc.y), bfhi(xc.y)}; x2[6] = (f32x2){bflo(xc.z), bfhi(xc.z)}; x2[7] = (f32x2){bflo(xc.w), bfhi(xc.w)}; }
#pragma unroll 1
        while ((b0 | b1) != 0ull) {
            int hk[8]; u32x4 uw[8]; int nv = 0;
#pragma unroll
            for (int k = 0; k < 8; ++k) { int h;
                if (b0) { h = __builtin_ctzll(b0); b0 &= b0 - 1; ++nv; } else if (b1) { h = 64 + __builtin_ctzll(b1); b1 &= b1 - 1; ++nv; } else h = hk[k > 0 ? k - 1 : 0];
                hk[k] = h; const int e = (h < 64) ? __builtin_amdgcn_readlane(e0, h & 63) : __builtin_amdgcn_readlane(e1, h & 63);
                uw[k] = *(const u32x4*)(U + (size_t)e * D_MODEL + 16 * lane); }
            float d[8];
#pragma unroll
            for (int k = 0; k < 8; ++k) d[k] = dot16_fp8(uw[k], x2);
            float e4[4], e2[2], e1s;
            { const bool hi = lane & 1;
#pragma unroll
              for (int i = 0; i < 4; ++i) { const float keep = hi ? d[4 + i] : d[i], send = hi ? d[i] : d[4 + i]; e4[i] = keep + __shfl_xor(send, 1); } }
            { const bool hi = lane & 2;
#pragma unroll
              for (int i = 0; i < 2; ++i) { const float keep = hi ? e4[2 + i] : e4[i], send = hi ? e4[i] : e4[2 + i]; e2[i] = keep + __shfl_xor(send, 2); } }
            { const bool hi = lane & 4; const float keep = hi ? e2[1] : e2[0], send = hi ? e2[0] : e2[1]; e1s = keep + __shfl_xor(send, 4); }
            e1s += __shfl_xor(e1s, 8); e1s += __shfl_xor(e1s, 16); e1s += __shfl_xor(e1s, 32);
            const int myk = 4 * (lane & 1) + (lane & 2) + ((lane >> 2) & 1);
            int myh = hk[0];
#pragma unroll
            for (int k = 1; k < 8; ++k) myh = (myk == k) ? hk[k] : myh;
            const float ga = __shfl(g0, myh & 63), gb = __shfl(g1, myh & 63); const float myg = (myh < 64) ? ga : gb;
            if (lane < 8 && myk < nv) P.SCO[(size_t)r * 128 + myh] = myg * gelu_tanh(e1s * (1.0f / PEER_SU)) * (1.0f / PEER_SV);
        }
    }
}
DI void peer_v_phase(const FP& P, const Ctx& C, int layer, const float* xin, float* fout, float* fout_s, bf16* xb) {
    const int lane = C.lane; const unsigned char* Vt = P.VB8 + (size_t)layer * PEER_EXPERTS * D_MODEL;
    const float* gam = P.ln_g + ((size_t)layer * 2 + 1) * D_MODEL; const float* bet = P.ln_b + ((size_t)layer * 2 + 1) * D_MODEL;
    const int nrounds = (M0 + C.G * NWAVES - 1) / (C.G * NWAVES);
#pragma unroll 1
    for (int rd = 0; rd <= nrounds; ++rd) {
        const bool smp = (rd == nrounds); int r = smp ? M0 + C.vcu : rd * C.G * NWAVES + C.vcu * NWAVES + C.wave; if (smp ? (C.vcu >= DEC_BATCH) : (r >= M0)) continue;
        const int pb = smp ? 16 * C.wave : 0, pe = smp ? pb + 16 : 128;
        f32x2 x2[8], o2[8];
#pragma unroll
        for (int j = 0; j < 4; ++j) { const f32x4 a = *(const f32x4*)(xin + (size_t)r * D_MODEL + 16 * lane + 4 * j); x2[2 * j] = (f32x2){a.x, a.y}; x2[2 * j + 1] = (f32x2){a.z, a.w}; }
#pragma unroll
        for (int k = 0; k < 8; ++k) o2[k] = (f32x2){0.f, 0.f};
        const int e_l = P.SELE[(size_t)r * 128 + lane], e_h = P.SELE[(size_t)r * 128 + 64 + lane]; const float a_l = P.SCO[(size_t)r * 128 + lane], a_h = P.SCO[(size_t)r * 128 + 64 + lane];
#pragma unroll 1
        for (int b0 = pb; b0 < pe; b0 += 16) { u32x4 vw[16];
#pragma unroll
            for (int k = 0; k < 16; ++k) { const int hk = b0 + k; const int e = (hk < 64) ? __builtin_amdgcn_readlane(e_l, hk & 63) : __builtin_amdgcn_readlane(e_h, hk & 63); vw[k] = *(const u32x4*)(Vt + (size_t)e * D_MODEL + 16 * lane); }
#pragma unroll
            for (int k = 0; k < 16; ++k) { const int hk = b0 + k; axpy16_fp8(vw[k], (hk < 64) ? rdlane(a_l, hk & 63) : rdlane(a_h, hk & 63), o2); } }
        if (smp) {
            LAS float* red = (LAS float*)C.lds;
#pragma unroll
            for (int k = 0; k < 8; ++k) { red[C.wave * 1024 + 16 * lane + 2 * k] = o2[k].x; red[C.wave * 1024 + 16 * lane + 2 * k + 1] = o2[k].y; }
            asm volatile("s_waitcnt lgkmcnt(0)" ::: "memory"); __syncthreads();
            if (C.wave == 0) {
#pragma unroll
                for (int k = 0; k < 8; ++k) { float ax = 0.f, ay = 0.f;
#pragma unroll
                    for (int ww = 0; ww < NWAVES; ++ww) { ax += red[ww * 1024 + 16 * lane + 2 * k]; ay += red[ww * 1024 + 16 * lane + 2 * k + 1]; } o2[k] = (f32x2){ax, ay}; } }
            __syncthreads();
            if (C.wave != 0) continue; }
        float s = 0.f;
#pragma unroll
        for (int k = 0; k < 8; ++k) { o2[k] += x2[k] * ALPHA; s += o2[k].x + o2[k].y; }
        const float mu = wave_sum(s) * (1.0f / D_MODEL); float s2 = 0.f;
#pragma unroll
        for (int k = 0; k < 8; ++k) { o2[k] -= mu; s2 += o2[k].x * o2[k].x + o2[k].y * o2[k].y; }
        const float rs = 1.0f / sqrtf(wave_sum(s2) * (1.0f / D_MODEL) + LN_EPS);
        float* frow = (r < M0) ? fout + (size_t)r * D_MODEL : fout_s + (size_t)(r - M0) * D_MODEL;
#pragma unroll
        for (int j = 0; j < 4; ++j) { const int c0 = 16 * lane + 4 * j; const f32x4 gg = *(const f32x4*)(gam + c0), bb = *(const f32x4*)(bet + c0);
            const f32x4 y = (f32x4){o2[2 * j].x * rs, o2[2 * j].y * rs, o2[2 * j + 1].x * rs, o2[2 * j + 1].y * rs} * gg + bb;
            *(f32x4*)(frow + c0) = y; if (xb) *(u32x2*)(xb + (size_t)r * D_MODEL + c0) = pk4(y); }
    }
}
}
namespace fx {
struct EpiB {
    static constexpr bool PERM = true, AFTER_DRAIN = false; const FP& P;
    DI void operator()(const f32x4 (&acc)[2][2][4][2], const pg8::Unit& u, int wr, int wc, int fr, int fq) const {
        const int t = u.pn;
        EPI_LOOP({ if (row < MP) { const int pos = row_pos(row), n = row / SEQ, e = ct & 63, dp = e >> 1; const bool prm = row < M0;
            if (t < 3) { const int ty = 2 * t + (ct >> 7), kvh = (ct >> 6) & 1;
                if (ty == 2 || ty == 4) { f32x4 lo, hi; rope4(P.ROPE + pos * 64, dp, v0, v1, lo, hi);
                    if (ty == 2) { float* o = (prm ? P.nsa_kv_p + (size_t)row * 512 : P.nsa_kv_s + (size_t)(row - M0) * 512) + 256 + kvh * 64 + dp; *(f32x4*)o = lo; *(f32x4*)(o + 32) = hi;
                        if (prm) { bf16* kt = P.SLK + ((size_t)n * NSA_KV_HEADS + kvh) * SEQ * 64; *(u32x2*)(kt + ktile_off(pos, dp)) = pk4(lo); *(u32x2*)(kt + ktile_off(pos, dp + 32)) = pk4(hi); } }
                    else { float* o = nullptr; if (!prm) o = P.win_s + (((size_t)(row - M0) * SWA_WINDOW + SWA_WINDOW - 1) * 2 + 0) * 128; else if (pos >= SEQ - SWA_WINDOW) o = P.win_p + (((size_t)n * SWA_WINDOW + pos - (SEQ - SWA_WINDOW)) * 2 + 0) * 128;
                        if (o) { *(f32x4*)(o + kvh * 64 + dp) = lo; *(f32x4*)(o + kvh * 64 + 32 + dp) = hi; }
                        if (prm) { bf16* kt = P.WNK + ((size_t)n * NSA_KV_HEADS + kvh) * SEQ * 64; *(u32x2*)(kt + ktile_off(pos, dp)) = pk4(lo); *(u32x2*)(kt + ktile_off(pos, dp + 32)) = pk4(hi); } } }
                else if (ty < 4) { float* o = (prm ? P.nsa_kv_p + (size_t)row * 512 : P.nsa_kv_s + (size_t)(row - M0) * 512) + ty * 128 + kvh * 64 + e; *(f32x4*)o = v0; *(f32x4*)(o + 4) = v1;
                    if (prm) { if (ty < 2) *(u32x4*)(P.AC + ((size_t)ty * ACROWS + ((size_t)n * NSA_KV_HEADS + kvh) * NCH + pos / 16) * 1024 + (pos % 16) * 64 + e) = pk8(v0, v1);
                        else { bf16* vt = P.SLVT + ((size_t)n * NSA_KV_HEADS + kvh) * SEQ * 64 + vtile_off(e, pos);
                            vt[0] = (bf16)f2bf(v0.x); vt[8] = (bf16)f2bf(v0.y); vt[16] = (bf16)f2bf(v0.z); vt[24] = (bf16)f2bf(v0.w); vt[32] = (bf16)f2bf(v1.x); vt[40] = (bf16)f2bf(v1.y); vt[48] = (bf16)f2bf(v1.z); vt[56] = (bf16)f2bf(v1.w); } } }
                else { float* o = nullptr; if (!prm) o = P.win_s + (((size_t)(row - M0) * SWA_WINDOW + SWA_WINDOW - 1) * 2 + 1) * 128; else if (pos >= SEQ - SWA_WINDOW) o = P.win_p + (((size_t)n * SWA_WINDOW + pos - (SEQ - SWA_WINDOW)) * 2 + 1) * 128;
                    if (o) { *(f32x4*)(o + kvh * 64 + e) = v0; *(f32x4*)(o + kvh * 64 + e + 4) = v1; }
                    if (prm) { bf16* vt = P.WNVT + ((size_t)n * NSA_KV_HEADS + kvh) * SEQ * 64 + vtile_off(e, pos);
                        vt[0] = (bf16)f2bf(v0.x); vt[8] = (bf16)f2bf(v0.y); vt[16] = (bf16)f2bf(v0.z); vt[24] = (bf16)f2bf(v0.w); vt[32] = (bf16)f2bf(v1.x); vt[40] = (bf16)f2bf(v1.y); vt[48] = (bf16)f2bf(v1.z); vt[56] = (bf16)f2bf(v1.w); } } }
            else if (t < 6) { const int h = (t - 3) * 4 + (ct >> 6); f32x4 lo, hi; rope4(P.ROPE + pos * 64, dp, v0, v1, lo, hi); bf16* q = P.QB + (size_t)row * NSA_Q_COLS + h * 64 + dp; *(u32x2*)q = pk4(lo * QSCALE); *(u32x2*)(q + 32) = pk4(hi * QSCALE); }
            else if (t == 6) { *(u32x4*)(P.MQB + (size_t)row * 256 + ct) = pk8(v0 * QSCALE, v1 * QSCALE); }
            else if (ct < 40) { const float vv[8] = {v0.x, v0.y, v0.z, v0.w, v1.x, v1.y, v1.z, v1.w};
                _Pragma("unroll") for (int i = 0; i < 8; ++i) if (ct + i < NSA_GATE_COLS) P.GATES[(size_t)row * 64 + ct + i] = 1.0f / (1.0f + __expf(-vv[i])); } } })
    }
};
DI void cmp2_phase(const FP& P, const Ctx& C) {
    const int lane = C.lane; LAS float* hs = (LAS float*)(C.lds + C.wave * 1024);
    constexpr int NGRP = NCTX * 2 * NSA_KV_HEADS; const int NW = C.G * NWAVES, WPG = NW / NGRP > 0 ? NW / NGRP : 1; const int gw = C.vcu * NWAVES + C.wave;
#pragma unroll 1
    for (int grp = gw / WPG; grp < NGRP; grp += (NW + WPG - 1) / WPG) { const int slot = gw % WPG; if (gw >= (NW / WPG) * WPG && grp == gw / WPG) break;
        const int kvh = grp % NSA_KV_HEADS, ty = (grp / NSA_KV_HEADS) % 2, ctx = grp / (2 * NSA_KV_HEADS);
        const float* UL = P.UL + ((size_t)ty * ACROWS + ((size_t)ctx * NSA_KV_HEADS + kvh) * NCH) * 256; const float* w2 = P.cmp_w2 + (size_t)ty * CMP_HIDDEN * HEAD_DIM;
        float w2r[CMP_HIDDEN];
#pragma unroll
        for (int k = 0; k < CMP_HIDDEN; ++k) w2r[k] = w2[k * HEAD_DIM + lane];
        const float b0 = P.CBIAS[ty * CMP_HIDDEN + lane], b1 = P.CBIAS[ty * CMP_HIDDEN + 64 + lane];
        float u0, u1, l0, l1; int c = slot;
        if (c < NCMP) { u0 = UL[(size_t)c * 256 + lane]; u1 = UL[(size_t)c * 256 + 64 + lane]; l0 = UL[(size_t)(c + 1) * 256 + 128 + lane]; l1 = UL[(size_t)(c + 1) * 256 + 192 + lane]; }
#pragma unroll 1
        for (; c < NCMP; c += WPG) { const float h0 = gelu_tanh(u0 + l0 + b0), h1 = gelu_tanh(u1 + l1 + b1); const int cn = c + WPG;
            if (cn < NCMP) { u0 = UL[(size_t)cn * 256 + lane]; u1 = UL[(size_t)cn * 256 + 64 + lane]; l0 = UL[(size_t)(cn + 1) * 256 + 128 + lane]; l1 = UL[(size_t)(cn + 1) * 256 + 192 + lane]; }
            hs[lane] = h0; hs[64 + lane] = h1; asm volatile("s_waitcnt lgkmcnt(0)" ::: "memory");
            float a = 0.f;
#pragma unroll
            for (int k4 = 0; k4 < CMP_HIDDEN / 4; ++k4) { const f32x4 hv = *(const LAS f32x4*)(hs + 4 * k4); a += hv.x * w2r[4 * k4] + hv.y * w2r[4 * k4 + 1] + hv.z * w2r[4 * k4 + 2] + hv.w * w2r[4 * k4 + 3]; }
            if (ty == 0) { const float other = __shfl_xor(a, 32); const int pos = c * CMP_STRIDE + CMP_BLOCK - 1; const float cs = P.ROPE[pos * 64 + (lane & 31)], sn = P.ROPE[pos * 64 + 32 + (lane & 31)];
                a = (lane < 32) ? a * cs - other * sn : a * cs + other * sn; }
            if (ctx < BATCH) { if (ty == 0) P.CK[((size_t)ctx * NSA_KV_HEADS + kvh) * NCH * 64 + ktile_off(c, lane)] = (bf16)f2bf(a); else P.CVT[((size_t)ctx * NSA_KV_HEADS + kvh) * NCH * 64 + vtile_off(lane, c)] = (bf16)f2bf(a); }
            else { (ty == 0 ? P.CKF : P.CVF)[(((size_t)(ctx - BATCH) * NSA_KV_HEADS + kvh) * NCH + c) * 64 + lane] = a; }
            asm volatile("s_waitcnt lgkmcnt(0)" ::: "memory"); }
    }
    __syncthreads();
}
constexpr int NSA_WLDS = 8192;
DI void nsa_pair_a(const FP& P, int n, int kvh, int t, int lane, LAS unsigned char* wl) {
    LAS float* pn = (LAS float*)wl; LAS float* imp = (LAS float*)(wl + 2048); LAS float* sc = (LAS float*)(wl + 6144); LAS int* sel = (LAS int*)(wl + 7168);
    const int col = lane & 15, c = lane >> 4; const bool vcol = col < 12; const int qq = vcol ? col / 6 : 0, hh = vcol ? col % 6 : 0, tq = t + qq, head = kvh * NSA_GROUP + hh, row = n * SEQ + tq;
    bf16x8 qf[2]; { const bf16* qp = P.QB + (size_t)row * NSA_Q_COLS + head * 64 + 8 * c; qf[0] = *(const bf16x8*)qp; qf[1] = *(const bf16x8*)(qp + 32); }
    const float* gt = P.GATES + (size_t)row * 64 + head * 3;
    f32x4 oacc[4] = {(f32x4){0.f, 0.f, 0.f, 0.f}, (f32x4){0.f, 0.f, 0.f, 0.f}, (f32x4){0.f, 0.f, 0.f, 0.f}, (f32x4){0.f, 0.f, 0.f, 0.f}};
    const int lim = vcol ? ((tq >= CMP_BLOCK - 1) ? (tq - (CMP_BLOCK - 1)) / CMP_STRIDE : -1) : -1;
    const int limmax = (t + 1 >= CMP_BLOCK - 1) ? (t + 1 - (CMP_BLOCK - 1)) / CMP_STRIDE : -1; const int nblk = (limmax + 32) / 32;
    const bf16* CKb = P.CK + ((size_t)n * NSA_KV_HEADS + kvh) * NCH * 64; const bf16* CVb = P.CVT + ((size_t)n * NSA_KV_HEADS + kvh) * 64 * NCH;
    for (int i = lane; i < 1024; i += 64) imp[i] = 0.f;
    float m1 = -INFINITY, l1 = 0.f;
    { struct K4 { bf16x8 a0, a1, b0, b1; };
      auto ldk = [&](K4& k, int blk) { const bf16* kt = CKb + (size_t)blk * 2048 + lane * 8; k.a0 = *(const bf16x8*)kt; k.a1 = *(const bf16x8*)(kt + 512); k.b0 = *(const bf16x8*)(kt + 1024); k.b1 = *(const bf16x8*)(kt + 1536); };
      auto cp1 = [&](const K4& k, int blk) { const int kb = 32 * blk;
        f32x4 s0 = (f32x4){0.f, 0.f, 0.f, 0.f}, s1 = (f32x4){0.f, 0.f, 0.f, 0.f};
        s0 = __builtin_amdgcn_mfma_f32_16x16x32_bf16(k.a0, qf[0], s0, 0, 0, 0); s0 = __builtin_amdgcn_mfma_f32_16x16x32_bf16(k.a1, qf[1], s0, 0, 0, 0);
        s1 = __builtin_amdgcn_mfma_f32_16x16x32_bf16(k.b0, qf[0], s1, 0, 0, 0); s1 = __builtin_amdgcn_mfma_f32_16x16x32_bf16(k.b1, qf[1], s1, 0, 0, 0);
        float s[8] = {s0.x, s0.y, s0.z, s0.w, s1.x, s1.y, s1.z, s1.w}; float mx = -INFINITY;
#pragma unroll
        for (int e = 0; e < 8; ++e) { s[e] = (kb + 8 * c + e <= lim) ? s[e] : -INFINITY; mx = fmaxf(mx, s[e]); }
        mx = fmaxf(mx, __shfl_xor(mx, 16)); mx = fmaxf(mx, __shfl_xor(mx, 32));
        const float mnew = fmaxf(m1, mx), muse = (mnew == -INFINITY) ? 0.f : mnew; float ls = 0.f;
#pragma unroll
        for (int e = 0; e < 8; ++e) ls += __builtin_amdgcn_exp2f(s[e] - muse);
        ls += __shfl_xor(ls, 16); ls += __shfl_xor(ls, 32);
        l1 = l1 * __builtin_amdgcn_exp2f(m1 - muse) + ls; m1 = mnew; };
      if (nblk > 0) { K4 A, B; ldk(A, 0);
#pragma unroll 1
        for (int blk = 0; blk < nblk; blk += 2) { ldk(B, (blk + 1 < nblk) ? blk + 1 : blk); cp1(A, blk); ldk(A, (blk + 2 < nblk) ? blk + 2 : blk); if (blk + 1 < nblk) cp1(B, blk + 1); } } }
    asm volatile("s_waitcnt lgkmcnt(0)" ::: "memory");
    { const float muse = (m1 == -INFINITY) ? 0.f : m1, inv = (l1 > 0.f) ? 1.0f / l1 : 0.f;
      f32x4 oc[4] = {(f32x4){0.f, 0.f, 0.f, 0.f}, (f32x4){0.f, 0.f, 0.f, 0.f}, (f32x4){0.f, 0.f, 0.f, 0.f}, (f32x4){0.f, 0.f, 0.f, 0.f}};
      pipe2(nblk, [&](KV8& kv, int blk) { kv_load_t(kv, CKb + (size_t)blk * 2048, CVb + (size_t)blk * 2048, lane); }, [&](const KV8& kv, int blk) { const int kb = 32 * blk;
        f32x4 s0 = (f32x4){0.f, 0.f, 0.f, 0.f}, s1 = (f32x4){0.f, 0.f, 0.f, 0.f};
        s0 = __builtin_amdgcn_mfma_f32_16x16x32_bf16(kv.ka0, qf[0], s0, 0, 0, 0); s0 = __builtin_amdgcn_mfma_f32_16x16x32_bf16(kv.ka1, qf[1], s0, 0, 0, 0);
        s1 = __builtin_amdgcn_mfma_f32_16x16x32_bf16(kv.kb0, qf[0], s1, 0, 0, 0); s1 = __builtin_amdgcn_mfma_f32_16x16x32_bf16(kv.kb1, qf[1], s1, 0, 0, 0);
        float s[8] = {s0.x, s0.y, s0.z, s0.w, s1.x, s1.y, s1.z, s1.w};
#pragma unroll
        for (int e = 0; e < 8; ++e) s[e] = (kb + 8 * c + e <= lim) ? __builtin_amdgcn_exp2f(s[e] - muse) * inv : 0.f;
        *(f32x4*)(pn + col * 32 + 8 * c) = (f32x4){s[0], s[1], s[2], s[3]}; *(f32x4*)(pn + col * 32 + 8 * c + 4) = (f32x4){s[4], s[5], s[6], s[7]};
        u32x4 pw; pw.x = cvtpk(s[0], s[1]); pw.y = cvtpk(s[2], s[3]); pw.z = cvtpk(s[4], s[5]); pw.w = cvtpk(s[6], s[7]); const bf16x8 pf = __builtin_bit_cast(bf16x8, pw);
        oc[0] = __builtin_amdgcn_mfma_f32_16x16x32_bf16(kv.v0, pf, oc[0], 0, 0, 0); oc[1] = __builtin_amdgcn_mfma_f32_16x16x32_bf16(kv.v1, pf, oc[1], 0, 0, 0);
        oc[2] = __builtin_amdgcn_mfma_f32_16x16x32_bf16(kv.v2, pf, oc[2], 0, 0, 0); oc[3] = __builtin_amdgcn_mfma_f32_16x16x32_bf16(kv.v3, pf, oc[3], 0, 0, 0);
        asm volatile("s_waitcnt lgkmcnt(0)" ::: "memory");
        { const int q2 = lane >> 5, k = lane & 31; float a = 0.f;
#pragma unroll
          for (int h6 = 0; h6 < 6; ++h6) a += pn[(q2 * 6 + h6) * 32 + k];
          imp[q2 * 512 + kb + k] = a; }
        asm volatile("s_waitcnt lgkmcnt(0)" ::: "memory"); });
#ifdef NSA_DEBUG
      if (vcol) { for (int db = 0; db < 4; ++db) *(f32x4*)(P.DBG + ((size_t)0 * MP + row) * 768 + head * 64 + 16 * db + 4 * c) = oc[db]; }
#endif
      const float g0 = vcol ? gt[0] : 0.f;
#pragma unroll
      for (int db = 0; db < 4; ++db) oacc[db] += oc[db] * g0; }
#ifndef REP_SEL
#define REP_SEL 1
#endif
#pragma unroll 1
    for (int rep = 0; rep < REP_SEL; ++rep) {
    for (int i = lane; i < 256; i += 64) { const int q2 = i >> 7, b = i & 127, tq2 = t + q2, cur = tq2 / SLC_BLOCK; float sv;
        if (b > cur) sv = NEG; else if (b == 0 || b == cur || b == cur - 1) sv = FORCE_SCORE;
        else { const LAS float* ic = imp + q2 * 512 + 4 * b; sv = ic[-1] + 2.f * (ic[0] + ic[1] + ic[2]) + ic[3]; }
        sc[i] = sv; }
    asm volatile("s_waitcnt lgkmcnt(0)" ::: "memory");
    for (int i = lane; i < 256; i += 64) { const int q2 = i >> 7, b = i & 127; const float sv = sc[i]; int rank = 0;
        for (int j = 0; j < 128; j += 4) { const f32x4 o = *(const LAS f32x4*)(sc + q2 * 128 + j);
            rank += (o.x > sv || (o.x == sv && j < b)) ? 1 : 0; rank += (o.y > sv || (o.y == sv && j + 1 < b)) ? 1 : 0; rank += (o.z > sv || (o.z == sv && j + 2 < b)) ? 1 : 0; rank += (o.w > sv || (o.w == sv && j + 3 < b)) ? 1 : 0; }
        if (rank < SLC_TOPK) { const int v = (sv > 0.5f * NEG) ? b : -1; sel[q2 * 16 + rank] = v; P.SELB[((size_t)(n * SEQ + t + q2) * NSA_KV_HEADS + kvh) * 16 + rank] = v; } }
    asm volatile("s_waitcnt lgkmcnt(0)" ::: "memory");
    }
#ifndef REP_WIN
#define REP_WIN 1
#endif
#pragma unroll 1
    for (int rep = 0; rep < REP_WIN; ++rep) { Tile16 T; tile_init(T);
      const bf16* WKb = P.WNK + ((size_t)n * NSA_KV_HEADS + kvh) * SEQ * 64; const bf16* WVb = P.WNVT + ((size_t)n * NSA_KV_HEADS + kvh) * 64 * SEQ;
      const int blo = (t - SWA_WINDOW) >> 5, bhi = (t + 1) >> 5;
      auto ld = [&](KV8& kv, int blk) { const int bc = blk < 0 ? 0 : blk; kv_load_t(kv, WKb + (size_t)bc * 2048, WVb + (size_t)bc * 2048, lane); };
      pipe2(bhi - blo + 1, [&](KV8& kv, int i) { ld(kv, blo + i); }, [&](const KV8& kv, int i) { const int kb = 32 * (blo + i);
          tile_compute(T, qf, kv, [&](int e) { const int kp = kb + 8 * c + e; return vcol && kp >= 0 && kp <= tq && tq - kp <= SWA_WINDOW; }); });
      const float inv = (T.l > 0.f) ? 1.0f / T.l : 0.f, g2 = vcol ? gt[2] * inv : 0.f;
#ifdef NSA_DEBUG
      if (vcol) { for (int db = 0; db < 4; ++db) *(f32x4*)(P.DBG + ((size_t)2 * MP + row) * 768 + head * 64 + 16 * db + 4 * c) = T.o[db] * inv; }
#endif
#pragma unroll
      for (int db = 0; db < 4; ++db) if (rep == REP_WIN - 1) oacc[db] += T.o[db] * g2; }
    if (vcol) { float* op = P.DPART + (size_t)row * 768 + head * 64 + 4 * c;
#pragma unroll
        for (int db = 0; db < 4; ++db) *(f32x4*)(op + 16 * db) = oacc[db]; }
}
DI void nsa_pair_b(const FP& P, int n, int kvh, int t, int lane, LAS unsigned char* wl) {
    LAS int* steps = (LAS int*)wl;
    const int col = lane & 15, c = lane >> 4; const bool vcol = col < 12; const int qq = vcol ? col / 6 : 0, hh = vcol ? col % 6 : 0, tq = t + qq, head = kvh * NSA_GROUP + hh, row = n * SEQ + tq;
    bf16x8 qf[2]; { const bf16* qp = P.QB + (size_t)row * NSA_Q_COLS + head * 64 + 8 * c; qf[0] = *(const bf16x8*)qp; qf[1] = *(const bf16x8*)(qp + 32); }
    const float* gt = P.GATES + (size_t)row * 64 + head * 3;
    Tile16 T; tile_init(T);
    const bf16* SKb = P.SLK + ((size_t)n * NSA_KV_HEADS + kvh) * SEQ * 64; const bf16* SVb = P.SLVT + ((size_t)n * NSA_KV_HEADS + kvh) * SEQ * 64;
    int ns = 0;
    { const int mysel = (lane < 32) ? P.SELB[((size_t)(n * SEQ + t + (lane >> 4)) * NSA_KV_HEADS + kvh) * 16 + (lane & 15)] : -1;
      for (int i = 0; i < 32; ++i) { const int b = __builtin_amdgcn_readlane(mysel, i); if (b < 0) continue; int q2 = i >> 4;
          const unsigned long long other = __ballot(mysel == b && lane < 32 && (lane >> 4) != q2);
          if (other) { if (q2 == 1) continue; q2 = 2; }
          if (lane == 0) { steps[ns] = (b * SLC_BLOCK) | (q2 << 29); steps[ns + 1] = (b * SLC_BLOCK + 32) | (q2 << 29); } ns += 2; } }
    asm volatile("s_waitcnt lgkmcnt(0)" ::: "memory");
    auto ld = [&](KV8& kv, int i) { const int code = __builtin_amdgcn_readfirstlane(steps[i]); const int kb = code & 0x1fffffff;
        kv_load_t(kv, SKb + (size_t)(kb >> 5) * 2048, SVb + (size_t)(kb >> 5) * 2048, lane); };
#ifdef PROBE_DBLCOMP
    Tile16 T2; tile_init(T2);
#endif
    pipe2(ns, ld, [&](const KV8& kv, int i) { const int code = __builtin_amdgcn_readfirstlane(steps[i]); const int kb = code & 0x1fffffff, q2 = code >> 29;
        tile_compute(T, qf, kv, [&](int e) { return vcol && (q2 == 2 || qq == q2) && (kb + 8 * c + e) <= tq; });
#ifdef PROBE_DBLCOMP
        tile_compute(T2, qf, kv, [&](int e) { return vcol && qq == q2 && (kb + 8 * c + e + 1) <= tq; });
#endif
    });
#ifdef PROBE_DBLCOMP
    if (T2.l < 0.f) T.l = 0.f;
#endif
    const float inv = (T.l > 0.f) ? 1.0f / T.l : 0.f, g1 = vcol ? gt[1] * inv : 0.f;
#ifdef NSA_DEBUG
    if (vcol) { for (int db = 0; db < 4; ++db) *(f32x4*)(P.DBG + ((size_t)1 * MP + row) * 768 + head * 64 + 16 * db + 4 * c) = T.o[db] * inv; }
#endif
    if (vcol) { const float* pp = P.DPART + (size_t)row * 768 + head * 64 + 4 * c; bf16* op = P.ATTB + (size_t)row * 1024 + head * 64 + 4 * c;
#pragma unroll
        for (int db = 0; db < 4; ++db) *(u32x2*)(op + 16 * db) = pk4(*(const f32x4*)(pp + 16 * db) + T.o[db] * g1); }
}

constexpr int SMP_SK = 1088;
template <class KF, class VF> DI void smp_branch(const Ctx& C, LAS float* qs, LAS float* S, LAS float* red, int NK, KF kf, VF vf, bool keep_probs, float (&outh)[1]) {
    const int tid = C.tid, lane = C.lane, w = C.wave;
#pragma unroll 1
    for (int j = tid; j < NK; j += NTHREADS) { const float* k = kf(j); f32x4 kr[16];
#pragma unroll
        for (int d4 = 0; d4 < 16; ++d4) kr[d4] = *(const f32x4*)(k + 4 * d4);
#pragma unroll 1
        for (int h = 0; h < 6; ++h) { float a = 0.f;
#pragma unroll
            for (int d4 = 0; d4 < 16; ++d4) { const f32x4 qv = *(const LAS f32x4*)(qs + h * 64 + 4 * d4); a += kr[d4].x * qv.x + kr[d4].y * qv.y + kr[d4].z * qv.z + kr[d4].w * qv.w; }
            S[h * SMP_SK + j] = a; } }
    asm volatile("s_waitcnt lgkmcnt(0)" ::: "memory"); __syncthreads();
    if (w < 6) { float m = -INFINITY; for (int j = lane; j < NK; j += 64) m = fmaxf(m, S[w * SMP_SK + j]); m = wave_max(m);
        float l = 0.f; for (int j = lane; j < NK; j += 64) { const float p = __builtin_amdgcn_exp2f(S[w * SMP_SK + j] - m); S[w * SMP_SK + j] = p; l += p; } l = wave_sum(l);
        const float inv = 1.0f / l; for (int j = lane; j < NK; j += 64) S[w * SMP_SK + j] *= inv; }
    asm volatile("s_waitcnt lgkmcnt(0)" ::: "memory"); __syncthreads();
    { const int per = (NK + NWAVES - 1) / NWAVES, j0 = w * per, j1 = (j0 + per < NK) ? j0 + per : NK; float o[6] = {0.f, 0.f, 0.f, 0.f, 0.f, 0.f};
#pragma unroll 1
      for (int j = j0; j < j1; j += 8) { float vv[8];
#pragma unroll
          for (int u = 0; u < 8; ++u) { const int jj = (j + u < j1) ? j + u : j1 - 1; vv[u] = vf(jj)[lane]; }
#pragma unroll
          for (int u = 0; u < 8; ++u) if (j + u < j1) {
#pragma unroll
              for (int h = 0; h < 6; ++h) o[h] += S[h * SMP_SK + j + u] * vv[u]; } }
#pragma unroll
      for (int h = 0; h < 6; ++h) red[(w * 6 + h) * 64 + lane] = o[h]; }
    asm volatile("s_waitcnt lgkmcnt(0)" ::: "memory"); __syncthreads();
    outh[0] = 0.f;
    if (tid < 384) { float a = 0.f;
#pragma unroll
        for (int ww = 0; ww < NWAVES; ++ww) a += red[ww * 384 + tid]; outh[0] = a; }
    if (!keep_probs) { __syncthreads(); }
}
DI void nsa_sample_item(const FP& P, const Ctx& C, int ns, int kvh) {
    LAS float* qs = (LAS float*)C.lds; LAS float* S = qs + 384; LAS float* red = S + 6 * SMP_SK; LAS float* scs = red + 8 * 384; LAS int* sel = (LAS int*)(scs + 136);
    const int tid = C.tid, row = M0 + ns;
    if (tid < 384) qs[tid] = bf2f(P.QB[(size_t)row * NSA_Q_COLS + kvh * 384 + tid]);
    asm volatile("s_waitcnt lgkmcnt(0)" ::: "memory"); __syncthreads();
    const float* ckf = P.CKF + ((size_t)ns * NSA_KV_HEADS + kvh) * NCH * 64; const float* cvf = P.CVF + ((size_t)ns * NSA_KV_HEADS + kvh) * NCH * 64;
    float oc[1], os[1], ow[1];
    smp_branch(C, qs, S, red, NCMP, [&](int j) { return ckf + (size_t)j * 64; }, [&](int j) { return cvf + (size_t)j * 64; }, true, oc);
    constexpr int NBS = (PAST_LEN + 1 + SLC_BLOCK - 1) / SLC_BLOCK, CURS = PAST_LEN / SLC_BLOCK;
    for (int b = tid; b < 136; b += NTHREADS) { float sv = -3.0e38f;
        if (b < NBS) { if (b == 0 || b == CURS || b == CURS - 1) sv = FORCE_SCORE; else { float a = 0.f;
#pragma unroll
                for (int o = -1; o <= 3; ++o) { const int ci = 4 * b + o; if (ci >= 0 && ci < NCMP) { float sm = 0.f; for (int h6 = 0; h6 < 6; ++h6) sm += S[h6 * SMP_SK + ci]; a += ((o >= 0 && o <= 2) ? 2.f : 1.f) * sm; } }
                sv = a; } }
        scs[b] = sv; }
    asm volatile("s_waitcnt lgkmcnt(0)" ::: "memory"); __syncthreads();
    for (int b = tid; b < NBS; b += NTHREADS) { const float sv = scs[b]; int rank = 0; for (int j = 0; j < NBS; ++j) { const float o = scs[j]; rank += (o > sv || (o == sv && j < b)) ? 1 : 0; }
        if (rank < SLC_TOPK) { sel[rank] = b; P.SELB[((size_t)row * NSA_KV_HEADS + kvh) * 16 + rank] = b; } }
    asm volatile("s_waitcnt lgkmcnt(0)" ::: "memory"); __syncthreads();
    { const float* newrow = P.nsa_kv_s + (size_t)ns * 512; const int* pt = P.page_table + ns * (PAST_LEN / PAGE_SIZE);
      if (tid == 0) { int seen = 0; for (int x = 0; x < SLC_TOPK; ++x) { const int bx = sel[x]; if (bx != CURS && seen < 15) sel[16 + seen++] = bx; } }
      asm volatile("s_waitcnt lgkmcnt(0)" ::: "memory"); __syncthreads();
      auto krow = [&](int j, int ty) -> const float* { if (j >= 15 * 64) return newrow + ty * 128 + kvh * 64;
          const int t0 = sel[16 + (j >> 6)] * SLC_BLOCK + (j & 63); const int pg = pt[t0 / PAGE_SIZE]; return P.cache_nsa_kv + ((size_t)pg * PAGE_SIZE + t0 % PAGE_SIZE) * 512 + ty * 128 + kvh * 64; };
      smp_branch(C, qs, S, red, 15 * 64 + 1, [&](int j) { return krow(j, 2); }, [&](int j) { return krow(j, 3); }, false, os); }
    { const float* wc = P.cache_nsa_win + (size_t)ns * SWA_WINDOW * 256; const float* newrow = P.win_s + ((size_t)ns * SWA_WINDOW + SWA_WINDOW - 1) * 256;
      smp_branch(C, qs, S, red, SWA_WINDOW + 1, [&](int j) { return (j < SWA_WINDOW ? wc + (size_t)j * 256 : newrow) + kvh * 64; }, [&](int j) { return (j < SWA_WINDOW ? wc + (size_t)j * 256 : newrow) + 128 + kvh * 64; }, false, ow); }
    if (tid < 384) { const int head = kvh * NSA_GROUP + tid / 64; const float* gt = P.GATES + (size_t)row * 64 + head * 3;
        P.ATTB[(size_t)row * 1024 + kvh * 384 + tid] = (bf16)f2bf(gt[0] * oc[0] + gt[1] * os[0] + gt[2] * ow[0]);
#ifdef NSA_DEBUG
        P.DBG[((size_t)0 * MP + row) * 768 + kvh * 384 + tid] = oc[0]; P.DBG[((size_t)1 * MP + row) * 768 + kvh * 384 + tid] = os[0]; P.DBG[((size_t)2 * MP + row) * 768 + kvh * 384 + tid] = ow[0];
#endif
    }
    __syncthreads();
}
DI void nsa_pairs(const FP& P, const Ctx& C, bool second) {
    LAS unsigned char* wl = C.lds + C.wave * NSA_WLDS;
    const int per = C.G / 4 > 0 ? C.G / 4 : 1, grp = (C.vcu / per) & 3, sub = C.vcu % per, n = grp >> 1, kvh = grp & 1;
#pragma unroll 1
    for (int pr = sub * NWAVES + C.wave; pr < SEQ / 2; pr += per * NWAVES) { if (second) nsa_pair_b(P, n, kvh, 2 * pr, C.lane, wl); else nsa_pair_a(P, n, kvh, 2 * pr, C.lane, wl); }
}
DI void nsa_phase_a(const FP& P, const Ctx& C) {
    for (int it = C.vcu; it < DEC_BATCH * NSA_KV_HEADS; it += C.G) nsa_sample_item(P, C, it / NSA_KV_HEADS, it % NSA_KV_HEADS);
    nsa_pairs(P, C, false);
    __syncthreads();
}
DI void nsa_phase_b(const FP& P, const Ctx& C) {
    const int lane = C.lane, w = C.wave;
    nsa_pairs(P, C, true);
    __syncthreads();
    { constexpr int NMT = (M0 / 16) * MEM_HEADS;
      for (int it = C.vcu * NWAVES + w; it < NMT; it += C.G * NWAVES) { const int h = it % MEM_HEADS, q16 = it / MEM_HEADS, row0 = q16 * 16, n = row0 / SEQ;
          mem_micro(P, P.MQB + h * 64, 256, row0, 1, n, h, P.ATTB + NSA_Q_COLS + h * 64, 1024, lane); }
      LAS float* qs = (LAS float*)(C.lds + 65536 + w * 256);
      for (int it = C.vcu * NWAVES + w; it < DEC_BATCH * MEM_HEADS; it += C.G * NWAVES) { const int h = it % MEM_HEADS, ns = it / MEM_HEADS, row = M0 + ns;
          Dec D; D.m = -INFINITY; D.l = 0.f; D.o = 0.f; qs[lane] = bf2f(P.MQB[(size_t)row * 256 + h * 64 + lane]); asm volatile("s_waitcnt lgkmcnt(0)" ::: "memory");
          const float* mk = P.cache_mem_kv + ((size_t)1 * DEC_BATCH + ns) * MEM_TOKENS * 512;
          for (int j0 = 0; j0 < MEM_TOKENS; j0 += 64) dec_chunk(D, qs, 64, [&](int j) { return mk + (size_t)(j0 + j) * 512 + h * 64; }, [&](int j) { return mk + (size_t)(j0 + j) * 512 + 256 + h * 64; }, lane);
          P.ATTB[(size_t)row * 1024 + NSA_Q_COLS + h * 64 + lane] = (bf16)f2bf(D.o / D.l); } }
    __syncthreads();
}
}
namespace fx {
enum { PH_PRO = 0, PH_G1, PH_ATTA, PH_G2, PH_LN1, PH_SC0, PH_TK0, PH_PU0, PH_PG0, PH_G3, PH_CMPG, PH_CMP2, PH_NSA, PH_NSB, PH_G4, PH_LN3, PH_SC1, PH_TK1, PH_PU1, PH_PG1, PH_COUNT };
template <class Epi> DI void run_gemm(const Ctx& C, const bf16* A, const bf16* Bt, int M, int N, int K, const Epi& E) {
    pg8::Gemm g{A, Bt, M, N, K}; pg8::StaticOrder S; S.init(M, N, C.G, (int)blockIdx.x);
    pg8::gemm_phase<Epi, pg8::StaticOrder, true, true>(C.lds, g, S, E);
}
template <class Epi> DI void skinny_gemm(const Ctx& C, const bf16* A, const bf16* Bt, int N, int K, const Epi& E) {
    static_assert(DEC_BATCH == 32 && M0 % 256 == 0, "skinny_gemm: 32 sample rows right after a whole number of 256-row tiles");
    const int lane = C.lane, fr = lane & 15, fq = lane >> 4, w = C.wave; const int NI = (N / 256) * 4, KW = K / NWAVES;
    LAS f32x4* red = (LAS f32x4*)C.lds;
#pragma unroll 1
    for (int item = C.vcu; item < NI; item += C.G) { const int pn = item >> 2, wc = item & 3;
        f32x4 pa[2][2][2];
#pragma unroll
        for (int i = 0; i < 8; ++i) (&pa[0][0][0])[i] = (f32x4){0.f, 0.f, 0.f, 0.f};
        const bf16* xa = A + (size_t)(M0 + fr) * K + w * KW + 8 * fq; const bf16* xb = xa + (size_t)16 * K;
        const bf16* wp[2][2];
#pragma unroll
        for (int bj = 0; bj < 2; ++bj)
#pragma unroll
            for (int n = 0; n < 2; ++n) wp[bj][n] = Bt + (size_t)(pn * 256 + bj * 128 + wc * 32 + 8 * (fr >> 2) + 4 * n + (fr & 3)) * K + w * KW + 8 * fq;
#pragma unroll 4
        for (int k0 = 0; k0 < KW; k0 += 32) { const bf16x8 x0 = *(const bf16x8*)(xa + k0), x1 = *(const bf16x8*)(xb + k0);
#pragma unroll
            for (int bj = 0; bj < 2; ++bj)
#pragma unroll
                for (int n = 0; n < 2; ++n) { const bf16x8 wf = *(const bf16x8*)(wp[bj][n] + k0);
                    pa[bj][0][n] = __builtin_amdgcn_mfma_f32_16x16x32_bf16(wf, x0, pa[bj][0][n], 0, 0, 0); pa[bj][1][n] = __builtin_amdgcn_mfma_f32_16x16x32_bf16(wf, x1, pa[bj][1][n], 0, 0, 0); } }
        __syncthreads();
#pragma unroll
        for (int bj = 0; bj < 2; ++bj)
#pragma unroll
            for (int mm = 0; mm < 2; ++mm)
#pragma unroll
                for (int n = 0; n < 2; ++n) red[(w * 8 + bj * 4 + mm * 2 + n) * 64 + lane] = pa[bj][mm][n];
        asm volatile("s_waitcnt lgkmcnt(0)" ::: "memory"); __syncthreads();
        if (w == 0) { f32x4 acc[2][2][4][2];
#pragma unroll
            for (int i = 0; i < 32; ++i) (&acc[0][0][0][0])[i] = (f32x4){0.f, 0.f, 0.f, 0.f};
#pragma unroll
            for (int bj = 0; bj < 2; ++bj)
#pragma unroll
                for (int mm = 0; mm < 2; ++mm)
#pragma unroll
                    for (int n = 0; n < 2; ++n) { f32x4 s = red[(bj * 4 + mm * 2 + n) * 64 + lane];
#pragma unroll 1
                        for (int ww = 1; ww < NWAVES; ++ww) s += red[(ww * 8 + bj * 4 + mm * 2 + n) * 64 + lane];
                        acc[0][bj][mm][n] = s; }
            E(acc, pg8::Unit{M0 / 256, pn}, 0, wc, fr, fq); }
    }
    __syncthreads();
}
__global__ void __launch_bounds__(NTHREADS, 2) mega(Args args) {
    extern __shared__ __attribute__((aligned(16))) unsigned char lds_raw[];
    Ctx C; C.lds = (LAS unsigned char*)lds_raw; C.tid = threadIdx.x; C.lane = C.tid & 63; C.wave = __builtin_amdgcn_readfirstlane(C.tid >> 6);
    C.G = gridDim.x; { const int bx = blockIdx.x; C.vcu = (C.G % 8 == 0) ? (bx % 8) * (C.G / 8) + bx / 8 : bx; }
    const FP& P = args.p;
    volatile LAS unsigned* MISC = (volatile LAS unsigned*)(C.lds + MISC_OFF);
    for (int u = C.tid; u < (LDS_BYTES - RING_BYTES) / 4; u += NTHREADS) ((LAS unsigned*)(C.lds + RING_BYTES))[u] = 0u;
    __syncthreads();
    const int lo = args.lo, hi = args.hi;
    XcdBarrier bar; bar.bar = P.ctl + 1024; bar.x = 0; bar.st = nullptr;
    if (hi - lo > 1) bar = xcd_barrier_post(P.ctl + 1024, MISC + 8);
#define IN(k) (lo <= (k) && (k) < hi)
#define SEAM(k) do { if (IN(k) && IN((k) + 1)) xcd_barrier(bar); } while (0)
#ifndef DUP_PHASE
#define DUP_PHASE -1
#endif
#define PHASE(k, ...) do { if (IN(k)) { __VA_ARGS__ if (DUP_PHASE == (k)) { __syncthreads(); __VA_ARGS__ } } SEAM(k); } while (0)
    PHASE(PH_PRO, p0_prologue(P, C); __syncthreads(); p0_wpk(P, C););
    PHASE(PH_G1, run_gemm(C, P.XB0, P.WA_T, M0, ACOLS, D_MODEL, EpiA{P}); run_gemm(C, P.MEMB, P.WMEM_T, BATCH * MEM_TOKENS, 1024, D_MODEL, EpiMem{P}); skinny_gemm(C, P.XB0, P.WA_T, ACOLS, D_MODEL, EpiA{P}););
    PHASE(PH_ATTA, atta_phase(P, C););
    PHASE(PH_G2, run_gemm(C, P.ATTA, P.WOA_T, M0, D_MODEL, 512, EpiPre{P.x_prompt, P.x_sample, P.PRE}); skinny_gemm(C, P.ATTA, P.WOA_T, D_MODEL, 512, EpiPre{P.x_prompt, P.x_sample, P.PRE}););
    PHASE(PH_LN1, ln_phase(P, C, P.PRE, P.ln_g, P.ln_b, P.X1, P.X1B, nullptr, nullptr););
    PHASE(PH_SC0, run_gemm(C, P.X1B, P.WPK_T, M0, NPK, D_MODEL, EpiF32{P.SCO, NPK, MP}); skinny_gemm(C, P.X1B, P.WPK_T, NPK, D_MODEL, EpiF32{P.SCO, NPK, MP}););
    PHASE(PH_TK0, topk_phase(P, C););
#ifdef PEER_SPLIT
    PHASE(PH_PU0, peer_u_phase(P, C, 0, P.X1B););
    PHASE(PH_PG0, peer_v_phase(P, C, 0, P.X1, P.X2, P.X2 + (size_t)M0 * D_MODEL, P.X2B););
#else
    PHASE(PH_PG0, peer_phase(P, C, 0, P.X1, P.X2, P.X2 + (size_t)M0 * D_MODEL, P.X2B););
#endif
    PHASE(PH_G3, run_gemm(C, P.X2B, P.WB_T, M0, NB_T, D_MODEL, EpiB{P}); skinny_gemm(C, P.X2B, P.WB_T, NB_T, D_MODEL, EpiB{P}););
    PHASE(PH_CMPG, run_gemm(C, P.AC, P.CW1_T, ACROWS, 256, 1024, EpiF32{P.UL, 256, ACROWS}); run_gemm(C, P.AC + (size_t)ACROWS * 1024, P.CW1_T + 256 * 1024, ACROWS, 256, 1024, EpiF32{P.UL + (size_t)ACROWS * 256, 256, ACROWS}););
    PHASE(PH_CMP2, cmp2_phase(P, C););
    PHASE(PH_NSA, nsa_phase_a(P, C););
    PHASE(PH_NSB, nsa_phase_b(P, C););
    PHASE(PH_G4, run_gemm(C, P.ATTB, P.WOB_T, M0, D_MODEL, 1024, EpiPre{P.X2, nullptr, P.PRE}); skinny_gemm(C, P.ATTB, P.WOB_T, D_MODEL, 1024, EpiPre{P.X2, nullptr, P.PRE}););
    PHASE(PH_LN3, ln_phase(P, C, P.PRE, P.ln_g + 2 * D_MODEL, P.ln_b + 2 * D_MODEL, P.X3, P.X3B, nullptr, nullptr););
    PHASE(PH_SC1, run_gemm(C, P.X3B, P.WPK_T + (size_t)NPK * D_MODEL, M0, NPK, D_MODEL, EpiF32{P.SCO, NPK, MP}); skinny_gemm(C, P.X3B, P.WPK_T + (size_t)NPK * D_MODEL, NPK, D_MODEL, EpiF32{P.SCO, NPK, MP}););
    PHASE(PH_TK1, topk_phase(P, C););
#ifdef PEER_SPLIT
    PHASE(PH_PU1, peer_u_phase(P, C, 1, P.X3B););
    PHASE(PH_PG1, peer_v_phase(P, C, 1, P.X3, P.y_prompt, P.y_sample, nullptr););
#else
    PHASE(PH_PG1, peer_phase(P, C, 1, P.X3, P.y_prompt, P.y_sample, nullptr););
#endif
#undef IN
#undef SEAM
}
}
#ifndef ONE_LAUNCH
#define ONE_LAUNCH 1
#endif
extern "C" void kernel_launch(void* const* d_in, const int* in_sizes, int n_in, void* d_out, int out_size, void* d_ws, size_t ws_size, hipStream_t stream) {
    fx::Args a; memset(&a, 0, sizeof(a)); fx::bind_io(a.p, d_in, (float*)d_out);
    const size_t f_need = fx::carve(a.p, d_ws);
    if (f_need > ws_size) { fprintf(stderr, "kernel_launch: workspace too small: need %zu have %zu\n", f_need, ws_size); return; }
    static int grid = 0;
    if (!grid) { int dev = 0, cus = 0, per_cu = 0; (void)hipGetDevice(&dev); (void)hipDeviceGetAttribute(&cus, hipDeviceAttributeMultiprocessorCount, dev);
        (void)hipFuncSetAttribute((const void*)fx::mega, hipFuncAttributeMaxDynamicSharedMemorySize, fx::LDS_BYTES);
        if (hipOccupancyMaxActiveBlocksPerMultiprocessor(&per_cu, (const void*)fx::mega, fx::NTHREADS, fx::LDS_BYTES) != hipSuccess || per_cu < 1) { fprintf(stderr, "kernel_launch: occupancy query says %d blocks per CU\n", per_cu); (void)hipGetLastError(); }
        grid = cus; }
    (void)hipMemsetAsync(a.p.ctl, 0, fx::CTL_BYTES, stream);
#if ONE_LAUNCH
    a.lo = 0; a.hi = fx::PH_COUNT; hipLaunchKernelGGL(fx::mega, dim3(grid), dim3(fx::NTHREADS), fx::LDS_BYTES, stream, a);
#else
    for (int k = 0; k < fx::PH_COUNT; ++k) { a.lo = k; a.hi = k + 1; hipLaunchKernelGGL(fx::mega, dim3(grid), dim3(fx::NTHREADS), fx::LDS_BYTES, stream, a); }
#endif
}
```

```cpp
#define ONE_LAUNCH 1
#define PEER_SHARD2 1
#include <hip/hip_runtime.h>
#include <cstdio>
#include <cstring>
#include <cmath>
#ifdef CPU_TEST
#define HD inline
constexpr int D_MODEL = 128, BATCH = 2, SEQ = 512, DEPTH = 2, DEC_BATCH = 3, DEC_SEQ = 1, PAST_LEN = 512, PAGE_SIZE = 128;
constexpr int DIL_W[3] = {16, 64, 256}, DIL_D[3] = {1, 4, 16}, DIL_TAPS = 17;
constexpr int MEM_TOKENS = 32, SLC_TOPK = 4, SWA_WINDOW = 64, PEER_KEYS = 16, PEER_TOPK = 4;
#else
#define HD __host__ __device__ __forceinline__
constexpr int D_MODEL = 1024, BATCH = 2, SEQ = 8192, DEPTH = 2, DEC_BATCH = 32, DEC_SEQ = 1, PAST_LEN = 8192, PAGE_SIZE = 128;
constexpr int DIL_W[3] = {128, 512, 2048}, DIL_D[3] = {1, 4, 16}, DIL_TAPS = 129;
constexpr int MEM_TOKENS = 256, SLC_TOPK = 16, SWA_WINDOW = 512, PEER_KEYS = 128, PEER_TOPK = 16;
#endif
HD constexpr int dil_w(int g) { return g == 0 ? DIL_W[0] : (g == 1 ? DIL_W[1] : DIL_W[2]); }
HD constexpr int dil_d(int g) { return g == 0 ? DIL_D[0] : (g == 1 ? DIL_D[1] : DIL_D[2]); }
constexpr int HEAD_DIM = 64, N_A_LAYERS = DEPTH / 2, N_DIL = 3, DIL_HEADS = 4, DIL_COLS = N_DIL * 3 * DIL_HEADS * HEAD_DIM;
constexpr int MEM_HEADS = 4, MEM_COLS = MEM_HEADS * HEAD_DIM;
constexpr int NSA_HEADS = 12, NSA_KV_HEADS = 2, NSA_GROUP = 6, NSA_Q_COLS = NSA_HEADS * HEAD_DIM, NSA_GATE_COLS = NSA_HEADS * 3;
constexpr int CMP_BLOCK = 32, CMP_STRIDE = 16, CMP_HIDDEN = 128, SLC_BLOCK = 64;
constexpr int PEER_EXPERTS = PEER_KEYS * PEER_KEYS, PEER_HEADS = 8, PEER_KEY_DIM = 128;
constexpr float FORCE_SCORE = 1.0e9f, NEG = -1.0e30f, SCALE = 0.125f, LN_EPS = 1e-5f;
constexpr float ALPHA = 1.41421356237309515f;
constexpr float BETA = 0.5f;
#define LAS __attribute__((address_space(3)))
namespace pg8 {
#define PG8_LAS __attribute__((address_space(3)))
typedef unsigned short bf16_t;
typedef short bf16x8 __attribute__((ext_vector_type(8)));
typedef float f32x4 __attribute__((ext_vector_type(4)));
typedef unsigned u32x4 __attribute__((ext_vector_type(4)));
constexpr int BM = 256, BK = 64, HALF = 128, HTB = HALF * BK * 2  , STAGE_BYTES = 8 * HTB, NXCD = 8, WGM = 8;

__host__ __device__ __forceinline__ int lds_byte(int r, int c) { const int st = (r >> 4) * 2 + (c >> 5), rr = r & 15, cc = c & 31, ob = rr * 64 + cc * 2; return st * 1024 + (ob ^ (((ob >> 9) & 1) << 5)); }
__host__ __device__ __forceinline__ void stage_rc(int b, int& R, int& C) { const int st = b / 1024, sb = b % 1024, swz = sb ^ (((sb >> 9) & 1) << 5); R = (st >> 1) * 16 + swz / 64; C = (st & 1) * 32 + (swz % 64) / 2; }
__host__ __device__ __forceinline__ int perm32(int rho) { const int n = rho >> 4, i = rho & 15; return 8 * (i >> 2) + 4 * n + (i & 3); }

struct Unit { int pm, pn; };
struct Gemm { const bf16_t* A; const bf16_t* Bt; int M, N, K; };

struct StaticOrder {
    int nM, nN, nwg, G, c;
    __host__ __device__ void init(int M, int N, int G_, int c_) { nM = M / BM; nN = N / BM; nwg = nM * nN; G = G_; c = c_; }
    __host__ __device__ bool next(int i, Unit& u) const {
        const long L = (long)i * G + c; if (L >= nwg) return false;
        int wgid = (int)L; { const int q = nwg / NXCD, r = nwg % NXCD, xcd = wgid % NXCD, off = wgid / NXCD; wgid = (xcd < r ? xcd * (q + 1) : r * (q + 1) + (xcd - r) * q) + off; }
        const int nig = WGM * nN, gid = wgid / nig, fm = gid * WGM, gsz = (nM - fm) < WGM ? (nM - fm) : WGM;
        u.pm = fm + ((wgid % nig) % gsz); u.pn = (wgid % nig) / gsz; return true;
    }
    __device__ __forceinline__ void a_ready(const Unit&) const {}
    __device__ __forceinline__ void done(const Unit&) const {}
};

__device__ __forceinline__ unsigned cvt_pk_bf16(float lo, float hi) { unsigned r; asm volatile("v_cvt_pk_bf16_f32 %0, %1, %2" : "=v"(r) : "v"(lo), "v"(hi)); return r; }
typedef float f32x2 __attribute__((ext_vector_type(2)));
typedef float f32x2 __attribute__((ext_vector_type(2)));
template <class Epi, class Sched, bool ALIGN_EPI = false, bool SP2 = false>
__device__ __forceinline__ void gemm_phase(PG8_LAS unsigned char* lds, const Gemm g, const Sched& S, const Epi& E) {
    const int tid = threadIdx.x, wid = __builtin_amdgcn_readfirstlane(tid >> 6), lane = tid & 63, wr = wid >> 2, wc = wid & 3, fr = lane & 15, fq = lane >> 4;
    const int K = g.K, nt = K / BK;
    unsigned voffA[2], voffB[2];
#pragma unroll
    for (int i = 0; i < 2; ++i) { int R, C; stage_rc(tid * 16 + i * 8192, R, C); const int Rb = Epi::PERM ? ((R & ~31) + perm32(R & 31)) : R;
        voffA[i] = (unsigned)(R * K + C) * 2u; voffB[i] = (unsigned)(Rb * K + C) * 2u; }
    const size_t kstep = (size_t)(BK * 2);
    const size_t hstep = (size_t)HALF * K * 2;
    const size_t tstep = 2 * hstep;
    const unsigned ldsw = (unsigned)wid * 1024u;
    const int aoff = lds_byte(wr * 64 + fr, fq * 8), boff = lds_byte(wc * 32 + fr, fq * 8);
#define PG8_SA(b, h) (((b) * 2 + (h)) * HTB)
#define PG8_SB(b, h) ((4 + (b) * 2 + (h)) * HTB)
#define PG8_STAGE(bufoff, gbase, voff) do { _Pragma("unroll") for (int _i = 0; _i < 2; ++_i) \
        __builtin_amdgcn_global_load_lds((const unsigned*)((const char*)(gbase) + (voff)[_i]), (PG8_LAS unsigned*)(lds + (bufoff) + ldsw + _i * 8192), 16, 0, 0); } while (0)
#define PG8_LDA(dst, b, h) do { _Pragma("unroll") for (int m = 0; m < 4; ++m) _Pragma("unroll") for (int k = 0; k < 2; ++k) dst[m][k] = *(const PG8_LAS bf16x8*)(lds + PG8_SA(b, h) + aoff + m * 2048 + k * 1024); } while (0)
#define PG8_LDB(dst, b, h) do { _Pragma("unroll") for (int n = 0; n < 2; ++n) _Pragma("unroll") for (int k = 0; k < 2; ++k) dst[n][k] = *(const PG8_LAS bf16x8*)(lds + PG8_SB(b, h) + boff + n * 2048 + k * 1024); } while (0)
#define PG8_MMA(ai, bj, At, Bt) do { __builtin_amdgcn_s_setprio(1); _Pragma("unroll") for (int m = 0; m < 4; ++m) _Pragma("unroll") for (int n = 0; n < 2; ++n) _Pragma("unroll") for (int k = 0; k < 2; ++k) \
        acc[ai][bj][m][n] = __builtin_amdgcn_mfma_f32_16x16x32_bf16(Bt[n][k], At[m][k], acc[ai][bj][m][n], 0, 0, 0); __builtin_amdgcn_s_setprio(0); } while (0)
#define PG8_WAIT_V(n) asm volatile("s_waitcnt vmcnt(" #n ")" ::: "memory")
#define PG8_WAIT_L(n) asm volatile("s_waitcnt lgkmcnt(" #n ")" ::: "memory")
#define PG8_BAR __builtin_amdgcn_s_barrier()
#define PG8_SCHED __builtin_amdgcn_sched_barrier(0)
    Unit cur, nxt; int ui = 0;
    if (!S.next(0, cur)) return;
    f32x4 acc[2][2][4][2];
#pragma unroll
    for (int a = 0; a < 2; ++a)
#pragma unroll
        for (int b = 0; b < 2; ++b)
#pragma unroll
            for (int m = 0; m < 4; ++m)
#pragma unroll
                for (int n = 0; n < 2; ++n) acc[a][b][m][n] = (f32x4){0.f, 0.f, 0.f, 0.f};
    bf16x8 At[4][2], B0[2][2], B1[2][2];
    const char* cA = (const char*)g.A + (size_t)cur.pm * tstep; const char* cB = (const char*)g.Bt + (size_t)cur.pn * tstep;
    S.a_ready(cur);
    if constexpr (SP2) {
        PG8_STAGE(PG8_SB(0, 0), cB, voffB); PG8_STAGE(PG8_SB(0, 1), cB + hstep, voffB); PG8_STAGE(PG8_SA(0, 0), cA, voffA); PG8_STAGE(PG8_SA(0, 1), cA + hstep, voffA);
        if (wr == 1) PG8_BAR;
        PG8_WAIT_V(2); PG8_BAR;
        PG8_STAGE(PG8_SB(1, 0), cB + kstep, voffB); PG8_STAGE(PG8_SA(1, 0), cA + kstep, voffA); PG8_STAGE(PG8_SB(1, 1), cB + hstep + kstep, voffB);
        PG8_WAIT_V(6); PG8_BAR;
    } else {
        PG8_STAGE(PG8_SB(0, 0), cB, voffB); PG8_STAGE(PG8_SA(0, 0), cA, voffA); PG8_STAGE(PG8_SB(0, 1), cB + hstep, voffB); PG8_STAGE(PG8_SA(0, 1), cA + hstep, voffA);
        if (wr == 1) PG8_BAR;
        PG8_WAIT_V(4); PG8_BAR;
        PG8_STAGE(PG8_SB(1, 0), cB + kstep, voffB); PG8_STAGE(PG8_SA(1, 0), cA + kstep, voffA); PG8_STAGE(PG8_SB(1, 1), cB + hstep + kstep, voffB);
        PG8_WAIT_V(6); PG8_BAR;
    }
    for (;;) {
        const bool has_next = S.next(ui + 1, nxt);
        const char* nA = has_next ? (const char*)g.A + (size_t)nxt.pm * tstep : cA; const char* nB = has_next ? (const char*)g.Bt + (size_t)nxt.pn * tstep : cB;
        for (int t = 0; t < nt; t += 2) {
            const bool last = (t == nt - 2);
            const char* a1 = cA + (size_t)(t + 1) * kstep;
            const char* a2 = last ? nA : cA + (size_t)(t + 2) * kstep; const char* b2 = last ? nB : cB + (size_t)(t + 2) * kstep;
            const char* a3 = a2 + kstep; const char* b3 = b2 + kstep;
            if (last && has_next) S.a_ready(nxt);
            if constexpr (SP2) {
            PG8_LDB(B0, 0, 0); PG8_LDB(B1, 0, 1); PG8_SCHED; PG8_LDA(At, 0, 0); PG8_STAGE(PG8_SA(1, 1), a1 + hstep, voffA);
            PG8_WAIT_V(8); PG8_WAIT_L(0); PG8_BAR; PG8_MMA(0, 0, At, B0); PG8_MMA(0, 1, At, B1); PG8_BAR; PG8_SCHED;
            PG8_LDA(At, 0, 1); PG8_STAGE(PG8_SB(0, 0), b2, voffB); PG8_STAGE(PG8_SB(0, 1), b2 + hstep, voffB); PG8_STAGE(PG8_SA(0, 0), a2, voffA);
            PG8_WAIT_V(8); PG8_WAIT_L(0); PG8_BAR; PG8_MMA(1, 0, At, B0); PG8_MMA(1, 1, At, B1); PG8_BAR; PG8_SCHED;
            PG8_LDB(B0, 1, 0); PG8_LDB(B1, 1, 1); PG8_SCHED; PG8_LDA(At, 1, 0); PG8_STAGE(PG8_SA(0, 1), a2 + hstep, voffA);
            PG8_WAIT_V(8); PG8_WAIT_L(0); PG8_BAR; PG8_MMA(0, 0, At, B0); PG8_MMA(0, 1, At, B1); PG8_BAR; PG8_SCHED;
            PG8_LDA(At, 1, 1); PG8_STAGE(PG8_SB(1, 0), b3, voffB); PG8_STAGE(PG8_SB(1, 1), b3 + hstep, voffB); PG8_STAGE(PG8_SA(1, 0), a3, voffA);
            PG8_WAIT_V(8); PG8_WAIT_L(0); PG8_BAR; PG8_MMA(1, 0, At, B0); PG8_MMA(1, 1, At, B1); PG8_BAR; PG8_SCHED;
            } else {
            PG8_LDB(B0, 0, 0); PG8_SCHED; PG8_LDA(At, 0, 0); PG8_STAGE(PG8_SA(1, 1), a1 + hstep, voffA);
            PG8_WAIT_L(8); PG8_BAR; PG8_WAIT_L(0); PG8_MMA(0, 0, At, B0); PG8_BAR; PG8_SCHED;
            PG8_LDB(B1, 0, 1); PG8_STAGE(PG8_SB(0, 0), b2, voffB);
            PG8_BAR; PG8_WAIT_L(0); PG8_MMA(0, 1, At, B1); PG8_BAR;
            PG8_LDA(At, 0, 1); PG8_STAGE(PG8_SA(0, 0), a2, voffA);
            PG8_BAR; PG8_WAIT_L(0); PG8_MMA(1, 0, At, B0); PG8_BAR; PG8_SCHED;
            PG8_STAGE(PG8_SB(0, 1), b2 + hstep, voffB);
            PG8_WAIT_V(6); PG8_BAR; PG8_MMA(1, 1, At, B1); PG8_BAR;
            PG8_LDB(B0, 1, 0); PG8_SCHED; PG8_LDA(At, 1, 0); PG8_STAGE(PG8_SA(0, 1), a2 + hstep, voffA);
            PG8_WAIT_L(8); PG8_BAR; PG8_WAIT_L(0); PG8_MMA(0, 0, At, B0); PG8_BAR; PG8_SCHED;
            PG8_LDB(B1, 1, 1); PG8_STAGE(PG8_SB(1, 0), b3, voffB);
            PG8_BAR; PG8_WAIT_L(0); PG8_MMA(0, 1, At, B1); PG8_BAR;
            PG8_LDA(At, 1, 1); PG8_STAGE(PG8_SA(1, 0), a3, voffA);
            PG8_BAR; PG8_WAIT_L(0); PG8_MMA(1, 0, At, B0); PG8_BAR; PG8_SCHED;
            PG8_STAGE(PG8_SB(1, 1), b3 + hstep, voffB);
            PG8_WAIT_V(6); PG8_BAR; PG8_MMA(1, 1, At, B1); PG8_BAR;
            }
        }
        if constexpr (ALIGN_EPI) { if (wr == 0) PG8_BAR; }
        if constexpr (!Epi::AFTER_DRAIN) { E(acc, cur, wr, wc, fr, fq); S.done(cur); }
        if (!has_next) break;
#pragma unroll
        for (int a = 0; a < 2; ++a)
#pragma unroll
            for (int b = 0; b < 2; ++b)
#pragma unroll
                for (int m = 0; m < 4; ++m)
#pragma unroll
                    for (int n = 0; n < 2; ++n) acc[a][b][m][n] = (f32x4){0.f, 0.f, 0.f, 0.f};
        cur = nxt; cA = nA; cB = nB; ++ui;
        if constexpr (ALIGN_EPI) { if (wr == 1) PG8_BAR; }
    }
    PG8_WAIT_V(0);
    if constexpr (!ALIGN_EPI) { if (wr == 0) PG8_BAR; }
    PG8_BAR;
    if constexpr (Epi::AFTER_DRAIN) { E.fused(acc, cur, wr, wc, fr, fq, lds, wid, lane); S.done(cur); }
#undef PG8_SA
#undef PG8_SB
#undef PG8_STAGE
#undef PG8_LDA
#undef PG8_LDB
#undef PG8_MMA
#undef PG8_WAIT_V
#undef PG8_WAIT_L
#undef PG8_BAR
#undef PG8_SCHED
}
}
#define XB_TMO      128
#define XB_XCNT(j)  (256  + 64 * (j))
#define XB_XSUB(j)  (1280 + 64 * (j))
#define XB_XGEN(j)  (2304 + 64 * (j))
#define XB_TOP      3328
#define XB_TOPGEN   3392
#define XCD_BAR_WORDS 3456
#define XB_SPIN_CAP (1u << 18)

__device__ __forceinline__ unsigned xb_ld(unsigned* p)              { return __hip_atomic_load(p, __ATOMIC_RELAXED, __HIP_MEMORY_SCOPE_AGENT); }
__device__ __forceinline__ unsigned xb_add(unsigned* p, unsigned v) { return __hip_atomic_fetch_add(p, v, __ATOMIC_RELAXED, __HIP_MEMORY_SCOPE_AGENT); }
__device__ __forceinline__ unsigned xb_xcc_id() { return (unsigned)__builtin_amdgcn_s_getreg((3 << 11) | 20) & 0xFu; }
#define XB_SPIN(cond, bar) do { unsigned _sp = 0; while (cond) { __builtin_amdgcn_s_sleep(1); \
    if ((++_sp & 255u) == 0u) { if (xb_ld(&(bar)[XB_TMO])) break; if (_sp > XB_SPIN_CAP) { atomicAdd(&(bar)[XB_TMO], 1u); break; } } } } while (0)

struct XcdBarrier {
    unsigned* bar; unsigned x;
    volatile LAS unsigned* st;
};

__device__ __forceinline__ XcdBarrier xcd_barrier_post(unsigned* bar, volatile LAS unsigned* st) {
    XcdBarrier b; b.bar = bar; b.x = xb_xcc_id(); b.st = st;
    if (threadIdx.x == 0) (void)xb_add(&bar[XB_XCNT(b.x)], 1u);
    return b;
}
__device__ __forceinline__ void xcd_barrier_complete(unsigned* bar, unsigned x, unsigned& nloc, unsigned& nx) {
    const unsigned G = gridDim.x * gridDim.y * gridDim.z;
    unsigned sum, cnt, mine, sp = 0u;
    for (;;) {
        sum = 0u; cnt = 0u; mine = 0u;
#pragma unroll
        for (unsigned j = 0; j < 16; ++j) { const unsigned c = xb_ld(&bar[XB_XCNT(j)]); sum += c; cnt += (c > 0u) ? 1u : 0u; mine = (j == x) ? c : mine; }
        if (sum == G) break;
        __builtin_amdgcn_s_sleep(1);
        if ((++sp & 255u) == 0u) { if (xb_ld(&bar[XB_TMO])) break; if (sp > XB_SPIN_CAP) { atomicAdd(&bar[XB_TMO], 1u); break; } }
    }
    nloc = mine > 0u ? mine : 1u; nx = cnt > 0u ? cnt : 1u;
}

__device__ __forceinline__ void xcd_barrier(const XcdBarrier& b) {
    asm volatile("s_waitcnt vmcnt(0)" ::: "memory");
    __syncthreads();
    if (threadIdx.x == 0) {
        unsigned* bar = b.bar;
        __builtin_amdgcn_s_waitcnt(0);
        unsigned nloc = b.st[0], nx = b.st[1];
        if (nloc == 0u) { xcd_barrier_complete(bar, b.x, nloc, nx); b.st[0] = nloc; b.st[1] = nx; }
        const unsigned old = xb_add(&bar[XB_XSUB(b.x)], 1u);
        const unsigned gen = old / nloc;
        if (old + 1u == (gen + 1u) * nloc) {
            __builtin_amdgcn_fence(__ATOMIC_RELEASE, "agent");
            asm volatile("s_waitcnt vmcnt(0)" ::: "memory");
            const unsigned og = xb_add(&bar[XB_TOP], 1u);
            const unsigned tg = og / nx;
            if (og + 1u == (tg + 1u) * nx) xb_add(&bar[XB_TOPGEN], 1u);
            else XB_SPIN(xb_ld(&bar[XB_TOPGEN]) == tg, bar);
            __builtin_amdgcn_fence(__ATOMIC_ACQUIRE, "agent");
            xb_add(&bar[XB_XGEN(b.x)], 1u);
            asm volatile("s_waitcnt vmcnt(0)" ::: "memory");
        } else {
            XB_SPIN(xb_ld(&bar[XB_XGEN(b.x)]) == gen, bar);
            __builtin_amdgcn_fence(__ATOMIC_ACQUIRE, "agent");
            asm volatile("s_waitcnt vmcnt(0)" ::: "memory");
        }
    }
    __syncthreads();
}
namespace fx {
#define DI __device__ __forceinline__
typedef unsigned short bf16;
typedef short bf16x8 __attribute__((ext_vector_type(8)));
typedef float f32x4 __attribute__((ext_vector_type(4)));
typedef float f32x2 __attribute__((ext_vector_type(2)));
typedef unsigned u32x4 __attribute__((ext_vector_type(4)));
typedef unsigned u32x2 __attribute__((ext_vector_type(2)));
constexpr int M0 = BATCH * SEQ, MP = M0 + DEC_BATCH, MPAD = ((MP + 255) / 256) * 256;
constexpr int ACOLS = DIL_COLS + MEM_COLS, BCOLS = NSA_Q_COLS + NSA_GATE_COLS + MEM_COLS, KVCOLS = 6 * NSA_KV_HEADS * HEAD_DIM;
constexpr int NB_T = 2048;
constexpr int NPK = PEER_HEADS * 2 * PEER_KEYS;
constexpr int NCMP = (SEQ - CMP_BLOCK) / CMP_STRIDE + 1;
constexpr int NCH = SEQ / CMP_STRIDE;
constexpr int NCTX = BATCH + DEC_BATCH;
constexpr int ACROWS = NCTX * NSA_KV_HEADS * NCH;
constexpr int NPOS = PAST_LEN + 1;
constexpr float QSCALE = 0.125f * 1.4426950408889634f;
constexpr int NTHREADS = 512, NWAVES = 8, LDS_BYTES = 147456, RING_BYTES = 131072, MISC_OFF = RING_BYTES + 320;

struct FP {
    const float *x_prompt, *x_sample, *mem_prompt, *cache_dil[3], *cache_nsa_kv, *cache_nsa_win, *cache_mem_kv; const int* page_table;
    const float *w_in_a, *w_out_a, *w_in_b, *w_out_b, *w_mem_kv, *w_kv_b, *cmp_pe, *cmp_w1, *cmp_w2, *ln_g, *ln_b, *peer_wq, *peer_keys, *peer_u, *peer_v;
    float *y_prompt, *y_sample, *dil_p[3], *dil_s[3], *nsa_kv_p, *nsa_kv_s, *win_p, *win_s, *mem_kv_p;
    unsigned* ctl;
    bf16 *XB0, *X1B, *X2B, *X3B, *WA_T, *WMEM_T, *MEMB, *WOA_T, *WOB_T, *WPK_T, *WB_T, *CW1_T, *AC; unsigned char *UB8, *VB8;
    float *ROPE, *CBIAS;
    bf16 *QA, *KA, *VTA, *MQA, *MK, *MVT, *ATTA;
    float *DPART, *DML, *PRE, *X1, *X2, *X3, *SCO, *SELG; int* SELE;
    bf16 *SLK, *SLVT, *WNK, *WNVT, *QB, *MQB, *CK, *CVT, *ATTB;
    float *GATES, *UL, *CKF, *CVF;
    int* SELB;
    float* DBG;
};
struct Args { FP p; int lo, hi; };
struct Carve { size_t off = 0; template <class T> T* take(void* base, size_t n) { T* r = (T*)((char*)base + off); off += ((n * sizeof(T) + 255) / 256) * 256; return r; } };
constexpr size_t CTL_BYTES = 65536;
inline size_t carve(FP& p, void* base) {
    Carve c;
    p.ctl = c.take<unsigned>(base, CTL_BYTES / 4);
    p.XB0 = c.take<bf16>(base, (size_t)MPAD * D_MODEL); p.X1B = c.take<bf16>(base, (size_t)MPAD * D_MODEL); p.X2B = c.take<bf16>(base, (size_t)MPAD * D_MODEL); p.X3B = c.take<bf16>(base, (size_t)MPAD * D_MODEL);
    p.WA_T = c.take<bf16>(base, (size_t)ACOLS * D_MODEL); p.WMEM_T = c.take<bf16>(base, (size_t)DEPTH * 2 * MEM_COLS * D_MODEL); p.MEMB = c.take<bf16>(base, (size_t)BATCH * MEM_TOKENS * D_MODEL);
    p.WOA_T = c.take<bf16>(base, (size_t)D_MODEL * 2 * MEM_COLS); p.WOB_T = c.take<bf16>(base, (size_t)D_MODEL * (NSA_Q_COLS + MEM_COLS));
    p.WPK_T = c.take<bf16>(base, (size_t)DEPTH * NPK * D_MODEL); p.WB_T = c.take<bf16>(base, (size_t)NB_T * D_MODEL);
    p.UB8 = c.take<unsigned char>(base, (size_t)DEPTH * PEER_EXPERTS * D_MODEL); p.VB8 = c.take<unsigned char>(base, (size_t)DEPTH * PEER_EXPERTS * D_MODEL);
    p.CW1_T = c.take<bf16>(base, (size_t)2 * 256 * 1024); p.AC = c.take<bf16>(base, (size_t)2 * ACROWS * 1024);
    p.ROPE = c.take<float>(base, (size_t)NPOS * 64); p.CBIAS = c.take<float>(base, 2 * CMP_HIDDEN);
    p.QA = c.take<bf16>(base, (size_t)3 * MPAD * 256); p.KA = c.take<bf16>(base, (size_t)3 * MPAD * 256); p.VTA = c.take<bf16>(base, (size_t)3 * BATCH * DIL_HEADS * HEAD_DIM * SEQ + 4096);
    p.MQA = c.take<bf16>(base, (size_t)MPAD * 256); p.MK = c.take<bf16>(base, (size_t)DEPTH * BATCH * MEM_TOKENS * MEM_COLS); p.MVT = c.take<bf16>(base, (size_t)DEPTH * BATCH * MEM_COLS * MEM_TOKENS);
    p.ATTA = c.take<bf16>(base, (size_t)MPAD * 2 * MEM_COLS);
    p.DPART = c.take<float>(base, (size_t)3 * MP * DIL_HEADS * HEAD_DIM); p.DML = c.take<float>(base, (size_t)3 * MP * DIL_HEADS * 2);
    p.PRE = c.take<float>(base, (size_t)MPAD * D_MODEL); p.X1 = c.take<float>(base, (size_t)MPAD * D_MODEL); p.X2 = c.take<float>(base, (size_t)MPAD * D_MODEL); p.X3 = c.take<float>(base, (size_t)MPAD * D_MODEL);
    p.SCO = c.take<float>(base, (size_t)MPAD * NPK); p.SELG = c.take<float>(base, (size_t)MP * 128); p.SELE = c.take<int>(base, (size_t)MP * 128);
    p.SLK = c.take<bf16>(base, (size_t)BATCH * NSA_KV_HEADS * SEQ * HEAD_DIM); p.SLVT = c.take<bf16>(base, (size_t)BATCH * NSA_KV_HEADS * SEQ * HEAD_DIM);
    p.WNK = c.take<bf16>(base, (size_t)BATCH * NSA_KV_HEADS * SEQ * HEAD_DIM + 4096); p.WNVT = c.take<bf16>(base, (size_t)BATCH * NSA_KV_HEADS * SEQ * HEAD_DIM + 4096);
    p.QB = c.take<bf16>(base, (size_t)MPAD * NSA_Q_COLS); p.MQB = c.take<bf16>(base, (size_t)MPAD * 256);
    p.CK = c.take<bf16>(base, (size_t)NCTX * NSA_KV_HEADS * NCH * HEAD_DIM); p.CVT = c.take<bf16>(base, (size_t)NCTX * NSA_KV_HEADS * HEAD_DIM * NCH); p.ATTB = c.take<bf16>(base, (size_t)MPAD * (NSA_Q_COLS + MEM_COLS));
    p.GATES = c.take<float>(base, (size_t)MPAD * 64); p.UL = c.take<float>(base, (size_t)2 * ACROWS * 256);
    p.CKF = c.take<float>(base, (size_t)DEC_BATCH * NSA_KV_HEADS * NCH * HEAD_DIM); p.CVF = c.take<float>(base, (size_t)DEC_BATCH * NSA_KV_HEADS * NCH * HEAD_DIM);
    p.SELB = c.take<int>(base, (size_t)MP * NSA_KV_HEADS * 16);
#ifdef NSA_DEBUG
    p.DBG = c.take<float>(base, (size_t)3 * MP * 768);
#else
    p.DBG = nullptr;
#endif
    return c.off;
}
inline void bind_io(FP& p, void* const* d_in, float* out) {
    p.x_prompt = (const float*)d_in[0]; p.x_sample = (const float*)d_in[1]; p.mem_prompt = (const float*)d_in[2]; p.cache_dil[0] = (const float*)d_in[3]; p.cache_dil[1] = (const float*)d_in[4]; p.cache_dil[2] = (const float*)d_in[5];
    p.cache_nsa_kv = (const float*)d_in[6]; p.cache_nsa_win = (const float*)d_in[7]; p.cache_mem_kv = (const float*)d_in[8]; p.page_table = (const int*)d_in[9];
    p.w_in_a = (const float*)d_in[10]; p.w_out_a = (const float*)d_in[11]; p.w_in_b = (const float*)d_in[12]; p.w_out_b = (const float*)d_in[13]; p.w_mem_kv = (const float*)d_in[14]; p.w_kv_b = (const float*)d_in[15];
    p.cmp_pe = (const float*)d_in[16]; p.cmp_w1 = (const float*)d_in[17]; p.cmp_w2 = (const float*)d_in[18]; p.ln_g = (const float*)d_in[19]; p.ln_b = (const float*)d_in[20];
    p.peer_wq = (const float*)d_in[21]; p.peer_keys = (const float*)d_in[22]; p.peer_u = (const float*)d_in[23]; p.peer_v = (const float*)d_in[24];
    size_t o = 0; auto take = [&](size_t n) { float* r = out + o; o += n; return r; };
    p.y_prompt = take((size_t)M0 * D_MODEL); p.y_sample = take((size_t)DEC_BATCH * D_MODEL);
    for (int g = 0; g < 3; ++g) p.dil_p[g] = take((size_t)BATCH * DIL_W[g] * 2 * DIL_HEADS * HEAD_DIM);
    for (int g = 0; g < 3; ++g) p.dil_s[g] = take((size_t)DEC_BATCH * DIL_W[g] * 2 * DIL_HEADS * HEAD_DIM);
    p.nsa_kv_p = take((size_t)M0 * 4 * NSA_KV_HEADS * HEAD_DIM); p.nsa_kv_s = take((size_t)DEC_BATCH * 4 * NSA_KV_HEADS * HEAD_DIM);
    p.win_p = take((size_t)BATCH * SWA_WINDOW * 2 * NSA_KV_HEADS * HEAD_DIM); p.win_s = take((size_t)DEC_BATCH * SWA_WINDOW * 2 * NSA_KV_HEADS * HEAD_DIM);
    p.mem_kv_p = take((size_t)DEPTH * BATCH * MEM_TOKENS * 2 * MEM_COLS);
}
DI unsigned f2bf(float f) { unsigned u = __builtin_bit_cast(unsigned, f); return (u + 0x7fffu + ((u >> 16) & 1u)) >> 16; }
DI unsigned pk2(float lo, float hi) { return f2bf(lo) | (f2bf(hi) << 16); }
DI float bf2f(unsigned short b) { return __builtin_bit_cast(float, (unsigned)b << 16); }
DI float bflo(unsigned w) { return __builtin_bit_cast(float, w << 16); }
DI float bfhi(unsigned w) { return __builtin_bit_cast(float, w & 0xffff0000u); }
DI float wave_sum(float v) {
#pragma unroll
    for (int o = 1; o < 64; o <<= 1) v += __shfl_xor(v, o);
    return v; }
DI float wave_max(float v) {
#pragma unroll
    for (int o = 1; o < 64; o <<= 1) v = fmaxf(v, __shfl_xor(v, o));
    return v; }
DI float gelu_tanh(float x) { const float u = 0.7978845608028654f * (x + 0.044715f * x * x * x); const float e = __builtin_amdgcn_exp2f(u * 2.885390081777927f);   const float t = 1.0f - 2.0f / (e + 1.0f); return 0.5f * x * (1.0f + t); }
DI float* sel3(float* const (&a)[3], int g) { return g == 0 ? a[0] : (g == 1 ? a[1] : a[2]); }
DI const float* sel3c(const float* const (&a)[3], int g) { return g == 0 ? a[0] : (g == 1 ? a[1] : a[2]); }
__host__ DI size_t ktile_off(int t, int d) { const int blk = t >> 5, kk = t & 31, b = (kk >> 2) & 1, i = 4 * (kk >> 3) + (kk & 3), s = d >> 5, c = (d & 31) >> 3; return ((size_t)(blk * 4 + 2 * b + s) * 64 + i + 16 * c) * 8 + (d & 7); }
__host__ DI size_t vtile_off(int dim, int t) { const int blk = t >> 5, kk = t & 31; return ((size_t)(blk * 4 + (dim >> 4)) * 64 + (dim & 15) + 16 * (kk >> 3)) * 8 + (kk & 7); }
struct Ctx { LAS unsigned char* lds; int tid, lane, wave, vcu, G; };
DI int row_pos(int r) { return r < M0 ? (r & (SEQ - 1)) : PAST_LEN; }

struct ColSrc { const float* p; int ld; };
DI int rope_il(int e) { return (e >> 1) + 32 * (e & 1); }
DI ColSrc col_wa(const FP& P, int n) {
    const int t = n >> 8, ct = n & 255, h = ct >> 6, e = ct & 63; if (t >= 9) return ColSrc{P.w_in_a + DIL_COLS + ct, ACOLS};
    const int j = t % 3, d = (j < 2) ? rope_il(e) : e; return ColSrc{P.w_in_a + t * 256 + h * 64 + d, ACOLS}; }
DI ColSrc col_wb(const FP& P, int n) {
    const int t = n >> 8, ct = n & 255, e = ct & 63;
    if (t < 3) { const int ty = 2 * t + (ct >> 7), kvh = (ct >> 6) & 1; const bool rot = (ty == 2 || ty == 4); return ColSrc{P.w_kv_b + (ty * NSA_KV_HEADS + kvh) * 64 + (rot ? rope_il(e) : e), KVCOLS}; }
    if (t < 6) { const int h = (t - 3) * 4 + (ct >> 6); return ColSrc{P.w_in_b + h * 64 + rope_il(e), BCOLS}; }
    if (t == 6) return ColSrc{P.w_in_b + NSA_Q_COLS + NSA_GATE_COLS + ct, BCOLS};
    if (ct < NSA_GATE_COLS) return ColSrc{P.w_in_b + NSA_Q_COLS + ct, BCOLS};
    return ColSrc{nullptr, 0}; }
DI ColSrc col_wmem(const FP& P, int n) { const int l = n >> 9, c = n & 511; return ColSrc{P.w_mem_kv + (size_t)l * D_MODEL * 512 + c, 512}; }
DI ColSrc col_woa(const FP& P, int n) { return ColSrc{P.w_out_a + n, D_MODEL}; }
DI ColSrc col_wob(const FP& P, int n) { return ColSrc{P.w_out_b + n, D_MODEL}; }
DI ColSrc col_cw1(const FP& P, int n) {
    const int ty = n >> 8, half = (n >> 7) & 1, hid = n & 127; return ColSrc{P.cmp_w1 + (size_t)ty * CMP_BLOCK * HEAD_DIM * CMP_HIDDEN + (size_t)half * 16 * HEAD_DIM * CMP_HIDDEN + hid, CMP_HIDDEN}; }
template <class CF> DI void transpose_item(const FP& P, CF cf, int K, bf16* WT, LAS float* scr, int item, int nblk, int lane) {
    const int kb = item / nblk, nb = item % nblk, k0 = 64 * kb, n0 = 32 * nb;
    const ColSrc cs = cf(P, n0 + (lane & 31));
#pragma unroll 8
    for (int i = 0; i < 32; ++i) { const int kk = 2 * i + (lane >> 5); scr[kk * 33 + (lane & 31)] = cs.p ? cs.p[(size_t)(k0 + kk) * cs.ld] : 0.f; }
    asm volatile("s_waitcnt lgkmcnt(0)" ::: "memory");
    const int c = lane & 7;
#pragma unroll
    for (int j = 0; j < 4; ++j) { const int n = (lane >> 3) + 8 * j; const LAS float* s = scr + (8 * c) * 33 + n;
        u32x4 o; o.x = pk2(s[0 * 33], s[1 * 33]); o.y = pk2(s[2 * 33], s[3 * 33]); o.z = pk2(s[4 * 33], s[5 * 33]); o.w = pk2(s[6 * 33], s[7 * 33]);
        *(u32x4*)(WT + (size_t)(n0 + n) * K + k0 + 8 * c) = o; }
    asm volatile("s_waitcnt lgkmcnt(0)" ::: "memory");
}
DI void cvt_row1024(const float* src, bf16* dst, int lane) {
#pragma unroll
    for (int j = 0; j < 4; ++j) { f32x4 v = src ? *(const f32x4*)(src + 256 * j + 4 * lane) : (f32x4){0.f, 0.f, 0.f, 0.f}; u32x2 o; o.x = pk2(v.x, v.y); o.y = pk2(v.z, v.w); *(u32x2*)(dst + 256 * j + 4 * lane) = o; }
}
DI void cvt_row1024_fp8(const float* src, unsigned char* dst, float sc, int lane) { u32x4 o; unsigned w[4];
#pragma unroll
    for (int j = 0; j < 4; ++j) { const f32x4 v = *(const f32x4*)(src + 16 * lane + 4 * j) * sc; int t = __builtin_amdgcn_cvt_pk_fp8_f32(v.x, v.y, 0, false); t = __builtin_amdgcn_cvt_pk_fp8_f32(v.z, v.w, t, true); w[j] = (unsigned)t; }
    o.x = w[0]; o.y = w[1]; o.z = w[2]; o.w = w[3]; *(u32x4*)(dst + 16 * lane) = o; }
DI void p0_prologue(const FP& P, const Ctx& C) {
    LAS float* scr = (LAS float*)(C.lds + C.wave * 16384);
    const int gw = C.vcu * NWAVES + C.wave, NGW = C.G * NWAVES, lane = C.lane;
    { constexpr int IA = (D_MODEL / 64) * (ACOLS / 32), IM = (D_MODEL / 64) * (1024 / 32), IOA = (512 / 64) * (D_MODEL / 32), IOB = (1024 / 64) * (D_MODEL / 32), IB = (D_MODEL / 64) * (NB_T / 32), IC = (1024 / 64) * (512 / 32);
      constexpr int NIT = IA + IM + IOA + IOB + IB + IC;
      for (int it = gw; it < NIT; it += NGW) { int r = it;
          if (r < IA) { transpose_item(P, col_wa, D_MODEL, P.WA_T, scr, r, ACOLS / 32, lane); continue; } r -= IA;
          if (r < IM) { transpose_item(P, col_wmem, D_MODEL, P.WMEM_T, scr, r, 1024 / 32, lane); continue; } r -= IM;
          if (r < IOA) { transpose_item(P, col_woa, 512, P.WOA_T, scr, r, D_MODEL / 32, lane); continue; } r -= IOA;
          if (r < IOB) { transpose_item(P, col_wob, 1024, P.WOB_T, scr, r, D_MODEL / 32, lane); continue; } r -= IOB;
          if (r < IB) { transpose_item(P, col_wb, D_MODEL, P.WB_T, scr, r, NB_T / 32, lane); continue; } r -= IB;
          transpose_item(P, col_cw1, 1024, P.CW1_T, scr, r, 512 / 32, lane); } }
    for (int r = gw; r < MPAD; r += NGW) { cvt_row1024(r < M0 ? P.x_prompt + (size_t)r * D_MODEL : (r < MP ? P.x_sample + (size_t)(r - M0) * D_MODEL : nullptr), P.XB0 + (size_t)r * D_MODEL, lane);
        if (r >= MP) { cvt_row1024(nullptr, P.X1B + (size_t)r * D_MODEL, lane); cvt_row1024(nullptr, P.X2B + (size_t)r * D_MODEL, lane); cvt_row1024(nullptr, P.X3B + (size_t)r * D_MODEL, lane);
            for (int c = lane; c < 512; c += 64) { P.ATTA[(size_t)r * 512 + c] = 0; P.ATTB[(size_t)r * 1024 + c] = 0; P.ATTB[(size_t)r * 1024 + 512 + c] = 0; } } }
    for (int r = gw; r < BATCH * MEM_TOKENS; r += NGW) cvt_row1024(P.mem_prompt + (size_t)r * D_MODEL, P.MEMB + (size_t)r * D_MODEL, lane);
#pragma unroll 1
    for (int r = 2 * gw; r < DEPTH * PEER_EXPERTS; r += 2 * NGW) { f32x4 a[16];
#pragma unroll
        for (int q = 0; q < 4; ++q) { const float* s0 = (q < 2 ? P.peer_u : P.peer_v) + (size_t)(r + (q & 1)) * D_MODEL + 16 * lane;
#pragma unroll
            for (int j = 0; j < 4; ++j) a[4 * q + j] = *(const f32x4*)(s0 + 4 * j); }
#pragma unroll
        for (int q = 0; q < 4; ++q) { const float sc = q < 2 ? 256.f : 64.f; unsigned w[4];
#pragma unroll
            for (int j = 0; j < 4; ++j) { const f32x4 v = a[4 * q + j] * sc; int t = __builtin_amdgcn_cvt_pk_fp8_f32(v.x, v.y, 0, false); t = __builtin_amdgcn_cvt_pk_fp8_f32(v.z, v.w, t, true); w[j] = (unsigned)t; }
            u32x4 o; o.x = w[0]; o.y = w[1]; o.z = w[2]; o.w = w[3]; *(u32x4*)((q < 2 ? P.UB8 : P.VB8) + (size_t)(r + (q & 1)) * D_MODEL + 16 * lane) = o; } }
    for (int i = gw * 64 + lane; i < NPOS * 32; i += NGW * 64) { const int pos = i >> 5, d = i & 31; const double inv = exp2(-(double)d * (13.287712379549449 / 32.0)); const double turns = (double)pos * inv * 0.15915494309189535;
        const float fr = (float)(turns - floor(turns)); P.ROPE[pos * 64 + d] = __builtin_amdgcn_cosf(fr); P.ROPE[pos * 64 + 32 + d] = __builtin_amdgcn_sinf(fr); }
    for (int i = gw; i < 2 * CMP_HIDDEN; i += NGW) { const int ty = i / CMP_HIDDEN, hid = i % CMP_HIDDEN; float a = 0.f;
#pragma unroll 8
        for (int k = lane; k < CMP_BLOCK * HEAD_DIM; k += 64) a += P.cmp_pe[ty * CMP_BLOCK * HEAD_DIM + k] * P.cmp_w1[((size_t)ty * CMP_BLOCK * HEAD_DIM + k) * CMP_HIDDEN + hid];
        a = wave_sum(a); if (lane == 0) P.CBIAS[i] = a; }
    for (int it = gw; it < DEC_BATCH * (PAST_LEN / PAGE_SIZE); it += NGW) { const int n = it / (PAST_LEN / PAGE_SIZE), pi = it % (PAST_LEN / PAGE_SIZE); const int pg = P.page_table[it];
        const float* src = P.cache_nsa_kv + (size_t)pg * PAGE_SIZE * 512 + 4 * lane; const int ty = lane >> 5, kvh = (lane >> 4) & 1, d = (4 * lane) & 63;
        bf16* dst = P.AC + ((size_t)ty * ACROWS + ((size_t)(BATCH + n) * NSA_KV_HEADS + kvh) * NCH + pi * (PAGE_SIZE / 16)) * 1024 + d;
#pragma unroll 1
        for (int r0 = 0; r0 < PAGE_SIZE; r0 += 8) { f32x4 v[8];
#pragma unroll
            for (int u = 0; u < 8; ++u) v[u] = *(const f32x4*)(src + (size_t)(r0 + u) * 512);
#pragma unroll
            for (int u = 0; u < 8; ++u) { const int t = r0 + u; u32x2 o; o.x = pk2(v[u].x, v[u].y); o.y = pk2(v[u].z, v[u].w); *(u32x2*)(dst + (size_t)(t / 16) * 1024 + (t % 16) * 64) = o; } } }
    for (int g = 0; g < 4; ++g) { const int W = g < 3 ? dil_w(g) : SWA_WINDOW, RV = g < 3 ? 128 : 64;
        const f32x4* src = (const f32x4*)(g < 3 ? sel3c(P.cache_dil, g) : P.cache_nsa_win); f32x4* dst = (f32x4*)(g < 3 ? sel3(P.dil_s, g) : P.win_s);
        const long per = (long)(W - 1) * RV, nvec = (long)DEC_BATCH * per;
#pragma unroll 1
        for (long i0 = (long)gw * 512; i0 < nvec; i0 += (long)NGW * 512) { f32x4 v[8]; long idx[8];
#pragma unroll
            for (int u = 0; u < 8; ++u) { const long i = i0 + u * 64 + lane; const long ii = i < nvec ? i : nvec - 1; const long n = ii / per, o = ii % per; idx[u] = n * (per + RV) + o; v[u] = src[idx[u] + RV]; }
#pragma unroll
            for (int u = 0; u < 8; ++u) { const long i = i0 + u * 64 + lane; if (i < nvec) dst[idx[u]] = v[u]; } } }
}
DI void p0_wpk(const FP& P, const Ctx& C) {
    LAS float* sw = (LAS float*)C.lds;
    LAS float* sk = (LAS float*)(C.lds + 32768);
    constexpr int NIT = DEPTH * 16 * (D_MODEL / 64);
    for (int it = C.vcu; it < NIT; it += C.G) { const int l = it / (16 * (D_MODEL / 64)), rem = it % (16 * (D_MODEL / 64)), hc = rem / (D_MODEL / 64), kb = rem % (D_MODEL / 64);
        __syncthreads();
        for (int i = C.tid; i < 64 * 64; i += NTHREADS) { const int r = i >> 6, d = i & 63; sw[r * 65 + d] = P.peer_wq[((size_t)l * D_MODEL + kb * 64 + r) * 1024 + hc * 64 + d]; }
        for (int i = C.tid; i < 128 * 64; i += NTHREADS) { const int r = i >> 6, d = i & 63; sk[r * 65 + d] = P.peer_keys[(((size_t)l * 16 + hc) * PEER_KEYS + r) * 64 + d]; }
        __syncthreads();
        for (int o = C.tid; o < 128 * 64; o += NTHREADS) { const int kk = o >> 6, ki = o & 63; float a = 0.f;
#pragma unroll 16
            for (int d = 0; d < 64; ++d) a += sw[ki * 65 + d] * sk[kk * 65 + d];
            P.WPK_T[((size_t)l * NPK + hc * 128 + kk) * D_MODEL + kb * 64 + ki] = (bf16)f2bf(a); } }
    __syncthreads();
}

#define EPI_LOOP(...) int fr_l = fr, fq_l = fq; asm volatile("" : "+v"(fr_l), "+v"(fq_l));     \
    _Pragma("unroll") for (int ai = 0; ai < 2; ++ai) _Pragma("unroll") for (int m = 0; m < 4; ++m) { const int row = u.pm * 256 + ai * 128 + wr * 64 + m * 16 + fr_l; \
    _Pragma("unroll") for (int bj = 0; bj < 2; ++bj) { const int ct = bj * 128 + wc * 32 + fq_l * 8; const f32x4 v0 = acc[ai][bj][m][0], v1 = acc[ai][bj][m][1]; __VA_ARGS__ } asm volatile("" ::: "memory"); }
DI void rope4(const float* rope_row, int dp, const f32x4& v0, const f32x4& v1, f32x4& lo, f32x4& hi) {
    const f32x4 c = *(const f32x4*)(rope_row + dp), s = *(const f32x4*)(rope_row + 32 + dp);
    lo.x = v0.x * c.x - v0.y * s.x; hi.x = v0.y * c.x + v0.x * s.x; lo.y = v0.z * c.y - v0.w * s.y; hi.y = v0.w * c.y + v0.z * s.y;
    lo.z = v1.x * c.z - v1.y * s.z; hi.z = v1.y * c.z + v1.x * s.z; lo.w = v1.z * c.w - v1.w * s.w; hi.w = v1.w * c.w + v1.z * s.w; }
DI u32x2 pk4(const f32x4& v) { u32x2 o; o.x = pk2(v.x, v.y); o.y = pk2(v.z, v.w); return o; }
DI u32x4 pk8(const f32x4& a, const f32x4& b) { u32x4 o; o.x = pk2(a.x, a.y); o.y = pk2(a.z, a.w); o.z = pk2(b.x, b.y); o.w = pk2(b.z, b.w); return o; }
DI int dil_perm(int t, int d) { return (t % d) * (SEQ / d) + t / d; }
struct EpiA {
    static constexpr bool PERM = true, AFTER_DRAIN = false; const FP& P;
    DI void operator()(const f32x4 (&acc)[2][2][4][2], const pg8::Unit& u, int wr, int wc, int fr, int fq) const {
        const int t9 = u.pn; const int g = t9 / 3, j = t9 % 3;
        EPI_LOOP({ if (row < MP) { const int h = ct >> 6, e = ct & 63; const int pos = row_pos(row);
            if (t9 == 9) { *(u32x4*)(P.MQA + (size_t)row * 256 + ct) = pk8(v0 * QSCALE, v1 * QSCALE); }
            else if (j < 2) { f32x4 lo, hi; const int dp = e >> 1; rope4(P.ROPE + pos * 64, dp, v0, v1, lo, hi);
                if (j == 0) { bf16* q = P.QA + ((size_t)g * MPAD + row) * 256 + h * 64 + dp; *(u32x2*)q = pk4(lo * QSCALE); *(u32x2*)(q + 32) = pk4(hi * QSCALE); }
                else { if (row < M0) { bf16* kt = P.KA + ((size_t)(g * BATCH + row / SEQ) * DIL_HEADS + h) * 64 * SEQ; const int cm = dil_perm(pos, dil_d(g)); *(u32x2*)(kt + ktile_off(cm, dp)) = pk4(lo); *(u32x2*)(kt + ktile_off(cm, dp + 32)) = pk4(hi); }
                    const int W = dil_w(g); float* o = nullptr;
                    if (row >= M0) o = sel3(P.dil_s, g) + (((size_t)(row - M0) * W + W - 1) * 2 + 0) * 256; else if (pos >= SEQ - W) o = sel3(P.dil_p, g) + (((size_t)(row / SEQ) * W + pos - (SEQ - W)) * 2 + 0) * 256;
                    if (o) { *(f32x4*)(o + h * 64 + dp) = lo; *(f32x4*)(o + h * 64 + 32 + dp) = hi; } } }
            else { const int W = dil_w(g), d = dil_d(g); float* o = nullptr;
                if (row >= M0) o = sel3(P.dil_s, g) + (((size_t)(row - M0) * W + W - 1) * 2 + 1) * 256; else if (pos >= SEQ - W) o = sel3(P.dil_p, g) + (((size_t)(row / SEQ) * W + pos - (SEQ - W)) * 2 + 1) * 256;
                if (o) { *(f32x4*)(o + ct) = v0; *(f32x4*)(o + ct + 4) = v1; }
                if (row < M0) { bf16* vt = P.VTA + ((size_t)(g * BATCH + row / SEQ) * DIL_HEADS + h) * 64 * SEQ + vtile_off(e, dil_perm(pos, d));
                    vt[0] = (bf16)f2bf(v0.x); vt[8] = (bf16)f2bf(v0.y); vt[16] = (bf16)f2bf(v0.z); vt[24] = (bf16)f2bf(v0.w); vt[32] = (bf16)f2bf(v1.x); vt[40] = (bf16)f2bf(v1.y); vt[48] = (bf16)f2bf(v1.z); vt[56] = (bf16)f2bf(v1.w); } } } })
    }
};
struct EpiMem {
    static constexpr bool PERM = true, AFTER_DRAIN = false; const FP& P;
    DI void operator()(const f32x4 (&acc)[2][2][4][2], const pg8::Unit& u, int wr, int wc, int fr, int fq) const {
        const int l = u.pn >> 1, half = u.pn & 1;
        EPI_LOOP({ const int n = row / MEM_TOKENS, mt = row % MEM_TOKENS; float* o = P.mem_kv_p + (((size_t)l * BATCH + n) * MEM_TOKENS + mt) * 512 + half * 256 + ct; *(f32x4*)o = v0; *(f32x4*)(o + 4) = v1;
            if (half == 0) *(u32x4*)(P.MK + (((size_t)l * BATCH + n) * MEM_HEADS + (ct >> 6)) * MEM_TOKENS * 64 + ktile_off(mt, ct & 63)) = pk8(v0, v1);
            else { bf16* vt = P.MVT + (((size_t)l * BATCH + n) * MEM_HEADS + (ct >> 6)) * MEM_TOKENS * 64 + vtile_off(ct & 63, mt);
                vt[0] = (bf16)f2bf(v0.x); vt[8] = (bf16)f2bf(v0.y); vt[16] = (bf16)f2bf(v0.z); vt[24] = (bf16)f2bf(v0.w); vt[32] = (bf16)f2bf(v1.x); vt[40] = (bf16)f2bf(v1.y); vt[48] = (bf16)f2bf(v1.z); vt[56] = (bf16)f2bf(v1.w); } })
    }
};
struct EpiPre {
    static constexpr bool PERM = true, AFTER_DRAIN = false; const float* xa; const float* xb; float* pre;
    DI void operator()(const f32x4 (&acc)[2][2][4][2], const pg8::Unit& u, int wr, int wc, int fr, int fq) const {
        EPI_LOOP({ if (row < MP) { const int col = u.pn * 256 + ct; const float* x = (xb && row >= M0) ? xb + (size_t)(row - M0) * D_MODEL + col : xa + (size_t)row * D_MODEL + col;
            const f32x4 a = *(const f32x4*)x, b = *(const f32x4*)(x + 4); float* o = pre + (size_t)row * D_MODEL + col; *(f32x4*)o = a * ALPHA + v0; *(f32x4*)(o + 4) = b * ALPHA + v1; } })
    }
};
struct EpiF32 {
    static constexpr bool PERM = true, AFTER_DRAIN = false; float* out; int ldc; int nrows;
    DI void operator()(const f32x4 (&acc)[2][2][4][2], const pg8::Unit& u, int wr, int wc, int fr, int fq) const {
        EPI_LOOP({ if (row < nrows) { float* o = out + (size_t)row * ldc + u.pn * 256 + ct; *(f32x4*)o = v0; *(f32x4*)(o + 4) = v1; } })
    }
};
}
namespace fx {
struct Tile16 { f32x4 o[4]; float m, l; };
DI void tile_init(Tile16& T) { T.o[0] = T.o[1] = T.o[2] = T.o[3] = (f32x4){0.f, 0.f, 0.f, 0.f}; T.m = -INFINITY; T.l = 0.f; }
typedef __bf16 bf16x2_t __attribute__((ext_vector_type(2)));
DI unsigned cvtpk(float lo, float hi) { const f32x2 v = {lo, hi}; const bf16x2_t b = __builtin_convertvector(v, bf16x2_t); return __builtin_bit_cast(unsigned, b); }
struct KV8 { bf16x8 ka0, ka1, kb0, kb1, v0, v1, v2, v3; };
DI void kv_load(KV8& r, const bf16* k0, const bf16* k1, const bf16* v, long vs16) {
    r.ka0 = *(const bf16x8*)k0; r.ka1 = *(const bf16x8*)(k0 + 32); r.kb0 = *(const bf16x8*)k1; r.kb1 = *(const bf16x8*)(k1 + 32);
    r.v0 = *(const bf16x8*)v; r.v1 = *(const bf16x8*)(v + vs16); r.v2 = *(const bf16x8*)(v + 2 * vs16); r.v3 = *(const bf16x8*)(v + 3 * vs16); }
template <class MaskF> DI void tile_compute(Tile16& T, const bf16x8 (&qf)[2], const KV8& r, MaskF mask) {
    f32x4 s0 = (f32x4){0.f, 0.f, 0.f, 0.f}, s1 = (f32x4){0.f, 0.f, 0.f, 0.f};
    s0 = __builtin_amdgcn_mfma_f32_16x16x32_bf16(r.ka0, qf[0], s0, 0, 0, 0); s0 = __builtin_amdgcn_mfma_f32_16x16x32_bf16(r.ka1, qf[1], s0, 0, 0, 0);
    s1 = __builtin_amdgcn_mfma_f32_16x16x32_bf16(r.kb0, qf[0], s1, 0, 0, 0); s1 = __builtin_amdgcn_mfma_f32_16x16x32_bf16(r.kb1, qf[1], s1, 0, 0, 0);
    float s[8] = {s0.x, s0.y, s0.z, s0.w, s1.x, s1.y, s1.z, s1.w};
    float mx = -INFINITY;
#pragma unroll
    for (int e = 0; e < 8; ++e) { s[e] = mask(e) ? s[e] : -INFINITY; mx = fmaxf(mx, s[e]); }
    mx = fmaxf(mx, __shfl_xor(mx, 16)); mx = fmaxf(mx, __shfl_xor(mx, 32));
    const float mnew = fmaxf(T.m, mx), muse = (mnew == -INFINITY) ? 0.f : mnew;
    const float alpha = __builtin_amdgcn_exp2f(T.m - muse);
    float ls = 0.f;
#pragma unroll
    for (int e = 0; e < 8; ++e) { s[e] = __builtin_amdgcn_exp2f(s[e] - muse); ls += s[e]; }
    ls += __shfl_xor(ls, 16); ls += __shfl_xor(ls, 32);
    T.l = T.l * alpha + ls; T.m = mnew;
    u32x4 pw; pw.x = cvtpk(s[0], s[1]); pw.y = cvtpk(s[2], s[3]); pw.z = cvtpk(s[4], s[5]); pw.w = cvtpk(s[6], s[7]);
    const bf16x8 pf = __builtin_bit_cast(bf16x8, pw);
    T.o[0] = __builtin_amdgcn_mfma_f32_16x16x32_bf16(r.v0, pf, T.o[0] * alpha, 0, 0, 0); T.o[1] = __builtin_amdgcn_mfma_f32_16x16x32_bf16(r.v1, pf, T.o[1] * alpha, 0, 0, 0);
    T.o[2] = __builtin_amdgcn_mfma_f32_16x16x32_bf16(r.v2, pf, T.o[2] * alpha, 0, 0, 0); T.o[3] = __builtin_amdgcn_mfma_f32_16x16x32_bf16(r.v3, pf, T.o[3] * alpha, 0, 0, 0);
}
template <class BUF, class LD, class CP> DI void pipe2t(int n, LD ld, CP cp) { if (n <= 0) return; BUF A, B; ld(A, 0);
#pragma unroll 1
    for (int i = 0; i < n; i += 2) { ld(B, (i + 1 < n) ? i + 1 : i); cp(A, i); ld(A, (i + 2 < n) ? i + 2 : i); if (i + 1 < n) cp(B, i + 1); } }
template <class LD, class CP> DI void pipe2(int n, LD ld, CP cp) { if (n <= 0) return; KV8 A, B; ld(A, 0);
#pragma unroll 1
    for (int i = 0; i < n; i += 2) { ld(B, (i + 1 < n) ? i + 1 : i); cp(A, i); ld(A, (i + 2 < n) ? i + 2 : i); if (i + 1 < n) cp(B, i + 1); } }
DI void kv_load_t(KV8& r, const bf16* kt, const bf16* vt, int lane) {
    const bf16* k = kt + lane * 8; const bf16* v = vt + lane * 8;
    r.ka0 = *(const bf16x8*)k; r.ka1 = *(const bf16x8*)(k + 512); r.kb0 = *(const bf16x8*)(k + 1024); r.kb1 = *(const bf16x8*)(k + 1536);
    r.v0 = *(const bf16x8*)v; r.v1 = *(const bf16x8*)(v + 512); r.v2 = *(const bf16x8*)(v + 1024); r.v3 = *(const bf16x8*)(v + 1536); }
DI int krow_of(int i, int b) { return 8 * (i >> 2) + 4 * b + (i & 3); }

DI void dil_micro(const FP& P, int n, int h, int t0, int mt, int lane) {
    const int g = mt >> 4, idx = mt & 15, d = dil_d(g), per = 16 / d;
    const int r = idx / per, sub = idx % per, i0 = t0 / d + 16 * sub, ib = i0 - 128, NC = SEQ / d;
    const int q = lane & 15, c = lane >> 4;
    const bf16* Qb = P.QA + ((size_t)g * MPAD + (size_t)n * SEQ) * 256 + h * 64;
    const bf16* Kb = P.KA + ((size_t)(g * BATCH + n) * DIL_HEADS + h) * 64 * SEQ + (size_t)r * NC * 64; const bf16* Vb = P.VTA + ((size_t)(g * BATCH + n) * DIL_HEADS + h) * 64 * SEQ + (size_t)r * NC * 64;
    bf16x8 qf[2]; { const bf16* qp = Qb + (size_t)(r + d * (i0 + q)) * 256 + 8 * c; qf[0] = *(const bf16x8*)qp; qf[1] = *(const bf16x8*)(qp + 32); }
    Tile16 T; tile_init(T);
    const int qi = i0 + q; const int tb0 = ib >> 5  , nblk = ((i0 + 15) >> 5) - tb0 + 1;
    pipe2(nblk, [&](KV8& kv, int i) { int tb = tb0 + i; tb = tb < 0 ? 0 : tb; kv_load_t(kv, Kb + (size_t)tb * 2048, Vb + (size_t)tb * 2048, lane); },
          [&](const KV8& kv, int i) { const int kb = 32 * (tb0 + i); tile_compute(T, qf, kv, [&](int e) { const int ki = kb + 8 * c + e; return ki >= 0 && ki <= qi && qi - ki <= DIL_TAPS - 1; }); });
    const int row = n * SEQ + r + d * qi;
    float* op = P.DPART + (((size_t)g * MP + row) * DIL_HEADS + h) * 64 + 4 * c;
#pragma unroll
    for (int db = 0; db < 4; ++db) *(f32x4*)(op + 16 * db) = T.o[db];
    if (c == 0) { float* ml = P.DML + (((size_t)g * MP + row) * DIL_HEADS + h) * 2; ml[0] = T.m; ml[1] = T.l; }
}
DI void mem_micro(const FP& P, const bf16* Q  , int ldq, int row0, int layer, int n, int h, bf16* O  , int ldo, int lane) {
    const int q = lane & 15, c = lane >> 4;
    bf16x8 qf[2]; { const bf16* qp = Q + (size_t)(row0 + q) * ldq + 8 * c; qf[0] = *(const bf16x8*)qp; qf[1] = *(const bf16x8*)(qp + 32); }
    const bf16* Kb = P.MK + (((size_t)layer * BATCH + n) * MEM_HEADS + h) * MEM_TOKENS * 64; const bf16* Vb = P.MVT + (((size_t)layer * BATCH + n) * MEM_HEADS + h) * MEM_TOKENS * 64;
    Tile16 T; tile_init(T);
    pipe2(MEM_TOKENS / 32, [&](KV8& kv, int i) { kv_load_t(kv, Kb + (size_t)i * 2048, Vb + (size_t)i * 2048, lane); }, [&](const KV8& kv, int) { tile_compute(T, qf, kv, [&](int) { return true; }); });
    const float inv = 1.0f / T.l; bf16* op = O + (size_t)(row0 + q) * ldo + 4 * c;
#pragma unroll
    for (int db = 0; db < 4; ++db) *(u32x2*)(op + 16 * db) = pk4(T.o[db] * inv);
}
struct Dec { float m, l, o; };
template <class KF, class VF> DI void dec_chunk(Dec& D, const LAS float* q, int nk, KF kf, VF vf, int lane) {
    float s = -INFINITY;
    if (lane < nk) { const float* k = kf(lane); float a = 0.f;
#pragma unroll
        for (int d4 = 0; d4 < 16; ++d4) { const f32x4 kv = *(const f32x4*)(k + 4 * d4); a += kv.x * q[4 * d4] + kv.y * q[4 * d4 + 1] + kv.z * q[4 * d4 + 2] + kv.w * q[4 * d4 + 3]; }
        s = a; }
    const float mx = wave_max(s), mnew = fmaxf(D.m, mx), alpha = __builtin_amdgcn_exp2f(D.m - mnew);
    const float p = (lane < nk) ? __builtin_amdgcn_exp2f(s - mnew) : 0.f;
    D.l = D.l * alpha + wave_sum(p); D.m = mnew; float o = D.o * alpha;
    for (int j0 = 0; j0 < nk; j0 += 8) { float vv[8];
#pragma unroll
        for (int u = 0; u < 8; ++u) { const int jj = (j0 + u < nk) ? j0 + u : nk - 1; vv[u] = vf(jj)[lane]; }
#pragma unroll
        for (int u = 0; u < 8; ++u) { const float pj = (j0 + u < nk) ? __builtin_bit_cast(float, __builtin_amdgcn_readlane(__builtin_bit_cast(int, p), (j0 + u) & 63)) : 0.f; o += pj * vv[u]; } }
    D.o = o;
}
DI void atta_phase(const FP& P, const Ctx& C) {
    const int lane = C.lane, w = C.wave;
    constexpr int NT = SEQ / 256, NIT = BATCH * NT * DIL_HEADS;
    for (int it = C.vcu; it < NIT; it += C.G) { const int h = it % DIL_HEADS, tt = (it / DIL_HEADS) % NT, n = it / (DIL_HEADS * NT), t0 = tt * 256;
        for (int mt = w; mt < 48; mt += NWAVES) dil_micro(P, n, h, t0, mt, lane);
        asm volatile("s_waitcnt vmcnt(0)" ::: "memory"); __syncthreads();
        for (int i = C.tid; i < 256 * 16; i += NTHREADS) { const int tk = i >> 4, d4 = (i & 15) * 4; const int row = n * SEQ + t0 + tk;
            float mg[3], lg[3]; float M = -INFINITY;
#pragma unroll
            for (int g = 0; g < 3; ++g) { const float* ml = P.DML + (((size_t)g * MP + row) * DIL_HEADS + h) * 2; mg[g] = ml[0]; lg[g] = ml[1]; M = fmaxf(M, mg[g]); }
            f32x4 acc = (f32x4){0.f, 0.f, 0.f, 0.f}; float L = 0.f;
#pragma unroll
            for (int g = 0; g < 3; ++g) { const float wg = __builtin_amdgcn_exp2f(mg[g] - M); L += wg * lg[g]; acc += *(const f32x4*)(P.DPART + (((size_t)g * MP + row) * DIL_HEADS + h) * 64 + d4) * wg; }
            *(u32x2*)(P.ATTA + (size_t)row * 512 + h * 64 + d4) = pk4(acc * (1.0f / L)); }
        for (int mt = w; mt < 16; mt += NWAVES) mem_micro(P, P.MQA + h * 64, 256, n * SEQ + t0 + 16 * mt, 0, n, h, P.ATTA + 256 + h * 64, 512, lane);
        __syncthreads();
    }
    LAS float* qs = (LAS float*)(C.lds + w * 1024);
    const int gw = C.vcu * NWAVES + w, NGW = C.G * NWAVES;
    for (int it = gw; it < DEC_BATCH * DIL_HEADS * 2; it += NGW) { const int kind = it & 1, h = (it >> 1) % DIL_HEADS, ns = (it >> 1) / DIL_HEADS, row = M0 + ns;
        Dec D; D.m = -INFINITY; D.l = 0.f; D.o = 0.f;
        if (kind == 0) {
            for (int g = 0; g < 3; ++g) qs[g * 64 + lane] = bf2f(P.QA[((size_t)g * MPAD + row) * 256 + h * 64 + lane]);
            asm volatile("s_waitcnt lgkmcnt(0)" ::: "memory");
            for (int g = 0; g < 3; ++g) { const int W = dil_w(g), d = dil_d(g); const float* cache = sel3c(P.cache_dil, g) + (size_t)ns * W * 512; const float* newrow = sel3(P.dil_s, g) + ((size_t)ns * W + W - 1) * 512;
                for (int j0 = 0; j0 < DIL_TAPS; j0 += 64) { const int nk = (DIL_TAPS - j0) < 64 ? (DIL_TAPS - j0) : 64;
                    dec_chunk(D, qs + g * 64, nk, [&](int j) { const int tap = j0 + j; return (tap == 0 ? newrow : cache + (size_t)(W - d * tap) * 512) + h * 64; },
                              [&](int j) { const int tap = j0 + j; return (tap == 0 ? newrow : cache + (size_t)(W - d * tap) * 512) + 256 + h * 64; }, lane); } }
            P.ATTA[(size_t)row * 512 + h * 64 + lane] = (bf16)f2bf(D.o / D.l);
        } else {
            qs[lane] = bf2f(P.MQA[(size_t)row * 256 + h * 64 + lane]);
            asm volatile("s_waitcnt lgkmcnt(0)" ::: "memory");
            const float* mk = P.cache_mem_kv + ((size_t)0 * DEC_BATCH + ns) * MEM_TOKENS * 512;
            for (int j0 = 0; j0 < MEM_TOKENS; j0 += 64) dec_chunk(D, qs, 64, [&](int j) { return mk + (size_t)(j0 + j) * 512 + h * 64; }, [&](int j) { return mk + (size_t)(j0 + j) * 512 + 256 + h * 64; }, lane);
            P.ATTA[(size_t)row * 512 + 256 + h * 64 + lane] = (bf16)f2bf(D.o / D.l);
        }
    }
    __syncthreads();
}
DI void ln_phase(const FP& P, const Ctx& C, const float* pre, const float* gam, const float* bet, float* xo, bf16* xb, float* yp, float* ys) {
    const int gw = C.vcu * NWAVES + C.wave, NGW = C.G * NWAVES, lane = C.lane;
    for (int r = gw; r < MP; r += NGW) { const float* x = pre + (size_t)r * D_MODEL; f32x4 v[4]; float s = 0.f;
#pragma unroll
        for (int j = 0; j < 4; ++j) { v[j] = *(const f32x4*)(x + 256 * j + 4 * lane); s += (v[j].x + v[j].y) + (v[j].z + v[j].w); }
        const float mu = wave_sum(s) * (1.0f / D_MODEL); float s2 = 0.f;
#pragma unroll
        for (int j = 0; j < 4; ++j) { v[j] = v[j] - mu; s2 += (v[j].x * v[j].x + v[j].y * v[j].y) + (v[j].z * v[j].z + v[j].w * v[j].w); }
        const float rs = 1.0f / sqrtf(wave_sum(s2) * (1.0f / D_MODEL) + LN_EPS);
#pragma unroll
        for (int j = 0; j < 4; ++j) { const f32x4 gg = *(const f32x4*)(gam + 256 * j + 4 * lane), bb = *(const f32x4*)(bet + 256 * j + 4 * lane); const f32x4 o = v[j] * rs * gg + bb;
            if (xo) *(f32x4*)(xo + (size_t)r * D_MODEL + 256 * j + 4 * lane) = o;
            if (xb) *(u32x2*)(xb + (size_t)r * D_MODEL + 256 * j + 4 * lane) = pk4(o);
            if (yp) { if (r < M0) *(f32x4*)(yp + (size_t)r * D_MODEL + 256 * j + 4 * lane) = o; else *(f32x4*)(ys + (size_t)(r - M0) * D_MODEL + 256 * j + 4 * lane) = o; } }
    }
}
}
namespace fx {
#define INS16(V, I, v_, i_) do { const float _v = (v_); const int _i = (i_); bool _c[16]; _Pragma("unroll") for (int _k = 0; _k < 16; ++_k) _c[_k] = _v > V[_k]; \
    _Pragma("unroll") for (int _k = 15; _k >= 1; --_k) { V[_k] = _c[_k] ? (_c[_k - 1] ? V[_k - 1] : _v) : V[_k]; I[_k] = _c[_k] ? (_c[_k - 1] ? I[_k - 1] : _i) : I[_k]; } \
    V[0] = _c[0] ? _v : V[0]; I[0] = _c[0] ? _i : I[0]; } while (0)
DI void wave_top16_128(float a, float b, int lane, float& outv, int& outi) {
    outv = -INFINITY; outi = 0;
#pragma unroll 1
    for (int k = 0; k < 16; ++k) { const float m = wave_max(fmaxf(a, b)); const unsigned long long ba = __ballot(a == m), bb = __ballot(b == m); int idx;
        if (ba) { const int l = __builtin_ctzll(ba); idx = l; if (lane == l) a = -INFINITY; } else { const int l = __builtin_ctzll(bb); idx = 64 + l; if (lane == l) b = -INFINITY; }
        if (lane == k) { outv = m; outi = idx; } }
}
DI void topk_wave_item(const FP& P, long it, int lane) {
    const float* s = P.SCO + it * 256; float v1, v2; int i1, i2;
    wave_top16_128(s[lane], s[64 + lane], lane, v1, i1); wave_top16_128(s[128 + lane], s[192 + lane], lane, v2, i2);
    int a = 0, rem = lane; bool valid = false;
    for (int aa = 0; aa < 16; ++aa) { const int nb = 16 / (aa + 1); if (!valid) { if (rem < nb) { a = aa; valid = true; } else rem -= nb; } }
    const int b = valid ? rem : 0;
    float cs = __shfl(v1, a) + __shfl(v2, b); const int ce = __shfl(i1, a) * PEER_KEYS + __shfl(i2, b); if (!valid) cs = -INFINITY;
    float tv = -INFINITY; int te = 0;
#pragma unroll 1
    for (int k = 0; k < 16; ++k) { const float m = wave_max(cs); const unsigned long long bm = __ballot(cs == m); const int l = __builtin_ctzll(bm); const int e = __shfl(ce, l); if (lane == l) cs = -INFINITY; if (lane == k) { tv = m; te = e; } }
    const float mx = __shfl(tv, 0); const float ex = (lane < 16) ? __expf(tv - mx) : 0.f; const float z = wave_sum(ex);
    if (lane < 16) { P.SELG[it * 16 + lane] = ex / z; P.SELE[it * 16 + lane] = te; }
}
#define KINS16(V, key_) do { const float _key = (key_); _Pragma("unroll") for (int _k = 15; _k >= 1; --_k) V[_k] = __builtin_amdgcn_fmed3f(V[_k - 1], V[_k], _key); V[0] = fmaxf(V[0], _key); } while (0)
DI float pack_key(float v, unsigned lowbits, unsigned mask) { return __builtin_bit_cast(float, (__builtin_bit_cast(unsigned, v) & ~mask) | lowbits); }
DI void topk_phase(const FP& P, const Ctx& C) {
    const int lane = C.lane; LAS float* st = (LAS float*)(C.lds + C.wave * 16384);
    const int NWI = (M0 * PEER_HEADS) / 64;
    for (int wi = C.vcu * NWAVES + C.wave; wi < NWI; wi += C.G * NWAVES) {
        const long it0 = (long)wi * 64; const long it = it0 + lane;
        float V1[16], V2[16], V3[16];
#pragma unroll
        for (int k = 0; k < 16; ++k) { V1[k] = V2[k] = V3[k] = -INFINITY; }
#pragma unroll 1
        for (int ch = 0; ch < 8; ++ch) {
#pragma unroll
            for (int u = 0; u < 8; ++u) { const int f4 = u * 64 + lane, j = f4 >> 3, q = f4 & 7, hf = q >> 2, c4 = (q & 3) * 4; const long itj = it0 + j;
                const f32x4 v = *(const f32x4*)(P.SCO + itj * 256 + hf * 128 + ch * 16 + c4);
                st[j * 33 + hf * 16 + c4] = v.x; st[j * 33 + hf * 16 + c4 + 1] = v.y; st[j * 33 + hf * 16 + c4 + 2] = v.z; st[j * 33 + hf * 16 + c4 + 3] = v.w; }
            asm volatile("s_waitcnt lgkmcnt(0)" ::: "memory");
#pragma unroll 4
            for (int c = 0; c < 16; ++c) { const float va = st[lane * 33 + c], vb = st[lane * 33 + 16 + c]; const unsigned lb = 127u - (unsigned)(ch * 16 + c); KINS16(V1, pack_key(va, lb, 127u)); KINS16(V2, pack_key(vb, lb, 127u)); }
            asm volatile("s_waitcnt lgkmcnt(0)" ::: "memory");
        }
        LAS int* lc = (LAS int*)st;
        { int ord = 0;
#pragma unroll
          for (int a = 0; a < 16; ++a) { const unsigned ba = __builtin_bit_cast(unsigned, V1[a]); const float va = __builtin_bit_cast(float, ba & ~127u); const int ia = 127 - (int)(ba & 127u);
#pragma unroll
              for (int b = 0; b < 16; ++b) if ((a + 1) * (b + 1) <= 16) { const unsigned bb = __builtin_bit_cast(unsigned, V2[b]); const float vb = __builtin_bit_cast(float, bb & ~127u); const int ib = 127 - (int)(bb & 127u);
                  lc[lane * 51 + ord] = ia * PEER_KEYS + ib; KINS16(V3, pack_key(va + vb, 63u - (unsigned)ord, 63u)); ++ord; } } }
        asm volatile("s_waitcnt lgkmcnt(0)" ::: "memory");
        float g[16]; int e[16]; float z = 0.f; const float vmax = __builtin_bit_cast(float, __builtin_bit_cast(unsigned, V3[0]) & ~63u);
#pragma unroll
        for (int k = 0; k < 16; ++k) { const unsigned bk = __builtin_bit_cast(unsigned, V3[k]); e[k] = lc[lane * 51 + 63 - (int)(bk & 63u)]; g[k] = __expf(__builtin_bit_cast(float, bk & ~63u) - vmax); z += g[k]; }
        const float iz = 1.0f / z;
#pragma unroll
        for (int k4 = 0; k4 < 4; ++k4) { *(f32x4*)(P.SELG + it * 16 + 4 * k4) = (f32x4){g[4 * k4] * iz, g[4 * k4 + 1] * iz, g[4 * k4 + 2] * iz, g[4 * k4 + 3] * iz};
            *(int4*)(P.SELE + it * 16 + 4 * k4) = make_int4(e[4 * k4], e[4 * k4 + 1], e[4 * k4 + 2], e[4 * k4 + 3]); }
        asm volatile("s_waitcnt lgkmcnt(0)" ::: "memory");
    }
    for (int si = C.vcu * NWAVES + C.wave; si < DEC_BATCH * PEER_HEADS; si += C.G * NWAVES) topk_wave_item(P, (long)M0 * PEER_HEADS + si, lane);
    __syncthreads();
}
constexpr float PEER_SU = 256.f, PEER_SV = 64.f;
DI float dot16_fp8(const u32x4& w, const f32x2 (&x2)[8]) { f32x2 a = {0.f, 0.f};
    a += __builtin_amdgcn_cvt_pk_f32_fp8((int)w.x, false) * x2[0]; a += __builtin_amdgcn_cvt_pk_f32_fp8((int)w.x, true) * x2[1];
    a += __builtin_amdgcn_cvt_pk_f32_fp8((int)w.y, false) * x2[2]; a += __builtin_amdgcn_cvt_pk_f32_fp8((int)w.y, true) * x2[3];
    a += __builtin_amdgcn_cvt_pk_f32_fp8((int)w.z, false) * x2[4]; a += __builtin_amdgcn_cvt_pk_f32_fp8((int)w.z, true) * x2[5];
    a += __builtin_amdgcn_cvt_pk_f32_fp8((int)w.w, false) * x2[6]; a += __builtin_amdgcn_cvt_pk_f32_fp8((int)w.w, true) * x2[7];
    return a.x + a.y; }
DI void axpy16_fp8(const u32x4& w, float s, f32x2 (&o2)[8]) { const f32x2 s2 = {s, s};
    o2[0] += __builtin_amdgcn_cvt_pk_f32_fp8((int)w.x, false) * s2; o2[1] += __builtin_amdgcn_cvt_pk_f32_fp8((int)w.x, true) * s2;
    o2[2] += __builtin_amdgcn_cvt_pk_f32_fp8((int)w.y, false) * s2; o2[3] += __builtin_amdgcn_cvt_pk_f32_fp8((int)w.y, true) * s2;
    o2[4] += __builtin_amdgcn_cvt_pk_f32_fp8((int)w.z, false) * s2; o2[5] += __builtin_amdgcn_cvt_pk_f32_fp8((int)w.z, true) * s2;
    o2[6] += __builtin_amdgcn_cvt_pk_f32_fp8((int)w.w, false) * s2; o2[7] += __builtin_amdgcn_cvt_pk_f32_fp8((int)w.w, true) * s2; }
#if defined(PEER_SHARD) || defined(PEER_SHARD2)
#define PEER_FIRST_ROUND nrounds
#else
#define PEER_FIRST_ROUND 0
#endif
DI float rdlane(float v, int l) { return __builtin_bit_cast(float, __builtin_amdgcn_readlane(__builtin_bit_cast(int, v), l)); }
DI void peer_phase(const FP& P, const Ctx& C, int layer, const float* xin, float* fout, float* fout_s, bf16* xb) {
    const int lane = C.lane; const unsigned char* U = P.UB8 + (size_t)layer * PEER_EXPERTS * D_MODEL; const unsigned char* Vt = P.VB8 + (size_t)layer * PEER_EXPERTS * D_MODEL;
    const float* gam = P.ln_g + ((size_t)layer * 2 + 1) * D_MODEL; const float* bet = P.ln_b + ((size_t)layer * 2 + 1) * D_MODEL;
    const int nrounds = (M0 + C.G * NWAVES - 1) / (C.G * NWAVES);
#pragma unroll 1
    for (int rd = PEER_FIRST_ROUND; rd <= nrounds; ++rd) {
        const bool smp = (rd == nrounds); int r = smp ? M0 + C.vcu : rd * C.G * NWAVES + C.vcu * NWAVES + C.wave; if (smp ? (C.vcu >= DEC_BATCH) : (r >= M0)) continue;
        const int pb = smp ? 16 * C.wave : 0, pe = smp ? pb + 16 : 128;
        f32x2 x2[8], o2[8];
#pragma unroll
        for (int j = 0; j < 4; ++j) { const f32x4 a = *(const f32x4*)(xin + (size_t)r * D_MODEL + 16 * lane + 4 * j); x2[2 * j] = (f32x2){a.x, a.y}; x2[2 * j + 1] = (f32x2){a.z, a.w}; }
#pragma unroll
        for (int k = 0; k < 8; ++k) o2[k] = (f32x2){0.f, 0.f};
        const int e_l = P.SELE[(size_t)r * 128 + lane], e_h = P.SELE[(size_t)r * 128 + 64 + lane]; const float g_l = P.SELG[(size_t)r * 128 + lane], g_h = P.SELG[(size_t)r * 128 + 64 + lane];
#pragma unroll 1
        for (int b0 = pb; b0 < pe; b0 += 8) {
            u32x4 uw[8], vw[8];
#pragma unroll
            for (int k = 0; k < 8; ++k) { const int hk = b0 + k; const int e = (hk < 64) ? __builtin_amdgcn_readlane(e_l, hk & 63) : __builtin_amdgcn_readlane(e_h, hk & 63);
                uw[k] = *(const u32x4*)(U + (size_t)e * D_MODEL + 16 * lane); vw[k] = *(const u32x4*)(Vt + (size_t)e * D_MODEL + 16 * lane); }
            float d[8];
#pragma unroll
            for (int k = 0; k < 8; ++k) d[k] = dot16_fp8(uw[k], x2);
            float e4[4], e2[2], e1;
            { const bool hi = lane & 1;
#pragma unroll
              for (int i = 0; i < 4; ++i) { const float keep = hi ? d[4 + i] : d[i], send = hi ? d[i] : d[4 + i]; e4[i] = keep + __shfl_xor(send, 1); } }
            { const bool hi = lane & 2;
#pragma unroll
              for (int i = 0; i < 2; ++i) { const float keep = hi ? e4[2 + i] : e4[i], send = hi ? e4[i] : e4[2 + i]; e2[i] = keep + __shfl_xor(send, 2); } }
            { const bool hi = lane & 4; const float keep = hi ? e2[1] : e2[0], send = hi ? e2[0] : e2[1]; e1 = keep + __shfl_xor(send, 4); }
            e1 += __shfl_xor(e1, 8); e1 += __shfl_xor(e1, 16); e1 += __shfl_xor(e1, 32);
            const int myk = 4 * (lane & 1) + (lane & 2) + ((lane >> 2) & 1); const int myhk = b0 + myk;
            const float myg = (myhk < 64) ? __shfl(g_l, myhk & 63) : __shfl(g_h, myhk & 63);
            const float act = myg * gelu_tanh(e1 * (1.0f / PEER_SU)) * (1.0f / PEER_SV);
#pragma unroll
            for (int k = 0; k < 8; ++k) { const int src = (k >> 2) | (((k >> 1) & 1) << 1) | ((k & 1) << 2); axpy16_fp8(vw[k], rdlane(act, src), o2); }
        }
        if (smp) {
            LAS float* red = (LAS float*)C.lds;
#pragma unroll
            for (int k = 0; k < 8; ++k) { red[C.wave * 1024 + 16 * lane + 2 * k] = o2[k].x; red[C.wave * 1024 + 16 * lane + 2 * k + 1] = o2[k].y; }
            asm volatile("s_waitcnt lgkmcnt(0)" ::: "memory"); __syncthreads();
            if (C.wave == 0) {
#pragma unroll
                for (int k = 0; k < 8; ++k) { float ax = 0.f, ay = 0.f;
#pragma unroll
                    for (int ww = 0; ww < NWAVES; ++ww) { ax += red[ww * 1024 + 16 * lane + 2 * k]; ay += red[ww * 1024 + 16 * lane + 2 * k + 1]; } o2[k] = (f32x2){ax, ay}; } }
            __syncthreads();
            if (C.wave != 0) continue; }
        float s = 0.f;
#pragma unroll
        for (int k = 0; k < 8; ++k) { o2[k] += x2[k] * ALPHA; s += o2[k].x + o2[k].y; }
        const float mu = wave_sum(s) * (1.0f / D_MODEL); float s2 = 0.f;
#pragma unroll
        for (int k = 0; k < 8; ++k) { o2[k] -= mu; s2 += o2[k].x * o2[k].x + o2[k].y * o2[k].y; }
        const float rs = 1.0f / sqrtf(wave_sum(s2) * (1.0f / D_MODEL) + LN_EPS);
        float* frow = (r < M0) ? fout + (size_t)r * D_MODEL : fout_s + (size_t)(r - M0) * D_MODEL;
#pragma unroll
        for (int j = 0; j < 4; ++j) { const int c0 = 16 * lane + 4 * j; const f32x4 gg = *(const f32x4*)(gam + c0), bb = *(const f32x4*)(bet + c0);
            const f32x4 y = (f32x4){o2[2 * j].x * rs, o2[2 * j].y * rs, o2[2 * j + 1].x * rs, o2[2 * j + 1].y * rs} * gg + bb;
            *(f32x4*)(frow + c0) = y; if (xb) *(u32x2*)(xb + (size_t)r * D_MODEL + c0) = pk4(y); }
    }
}
DI void peer_u_phase(const FP& P, const Ctx& C, int layer, const bf16* xb16) {
    const int lane = C.lane; const unsigned char* U = P.UB8 + (size_t)layer * PEER_EXPERTS * D_MODEL;
    const int s = (int)(blockIdx.x & 7), nw = (C.G >> 3) * NWAVES, widx = (int)(blockIdx.x >> 3) * NWAVES + C.wave;
#pragma unroll 1
    for (int r = widx; r < MP; r += nw) {
        const int e0 = P.SELE[(size_t)r * 128 + lane], e1 = P.SELE[(size_t)r * 128 + 64 + lane]; const float g0 = P.SELG[(size_t)r * 128 + lane], g1 = P.SELG[(size_t)r * 128 + 64 + lane];
        unsigned long long b0 = __ballot((e0 >> 11) == s), b1 = __ballot((e1 >> 11) == s);
        if ((b0 | b1) == 0ull) continue;
        f32x2 x2[8]; { const u32x4 xa = *(const u32x4*)(xb16 + (size_t)r * D_MODEL + 16 * lane), xc = *(const u32x4*)(xb16 + (size_t)r * D_MODEL + 16 * lane + 8);
            x2[0] = (f32x2){bflo(xa.x), bfhi(xa.x)}; x2[1] = (f32x2){bflo(xa.y), bfhi(xa.y)}; x2[2] = (f32x2){bflo(xa.z), bfhi(xa.z)}; x2[3] = (f32x2){bflo(xa.w), bfhi(xa.w)};
            x2[4] = (f32x2){bflo(xc.x), bfhi(xc.x)}; x2[5] = (f32x2){bflo(xc.y), bfhi(xc.y)}; x2[6] = (f32x2){bflo(xc.z), bfhi(xc.z)}; x2[7] = (f32x2){bflo(xc.w), bfhi(xc.w)}; }
#pragma unroll 1
        while ((b0 | b1) != 0ull) {
            int hk[8]; u32x4 uw[8]; int nv = 0;
#pragma unroll
            for (int k = 0; k < 8; ++k) { int h;
                if (b0) { h = __builtin_ctzll(b0); b0 &= b0 - 1; ++nv; } else if (b1) { h = 64 + __builtin_ctzll(b1); b1 &= b1 - 1; ++nv; } else h = hk[k > 0 ? k - 1 : 0];
                hk[k] = h; const int e = (h < 64) ? __builtin_amdgcn_readlane(e0, h & 63) : __builtin_amdgcn_readlane(e1, h & 63);
                uw[k] = *(const u32x4*)(U + (size_t)e * D_MODEL + 16 * lane); }
            float d[8];
#pragma unroll
            for (int k = 0; k < 8; ++k) d[k] = dot16_fp8(uw[k], x2);
            float e4[4], e2[2], e1s;
            { const bool hi = lane & 1;
#pragma unroll
              for (int i = 0; i < 4; ++i) { const float keep = hi ? d[4 + i] : d[i], send = hi ? d[i] : d[4 + i]; e4[i] = keep + __shfl_xor(send, 1); } }
            { const bool hi = lane & 2;
#pragma unroll
              for (int i = 0; i < 2; ++i) { const float keep = hi ? e4[2 + i] : e4[i], send = hi ? e4[i] : e4[2 + i]; e2[i] = keep + __shfl_xor(send, 2); } }
            { const bool hi = lane & 4; const float keep = hi ? e2[1] : e2[0], send = hi ? e2[0] : e2[1]; e1s = keep + __shfl_xor(send, 4); }
            e1s += __shfl_xor(e1s, 8); e1s += __shfl_xor(e1s, 16); e1s += __shfl_xor(e1s, 32);
            const int myk = 4 * (lane & 1) + (lane & 2) + ((lane >> 2) & 1);
            int myh = hk[0];
#pragma unroll
            for (int k = 1; k < 8; ++k) myh = (myk == k) ? hk[k] : myh;
            const float ga = __shfl(g0, myh & 63), gb = __shfl(g1, myh & 63); const float myg = (myh < 64) ? ga : gb;
            if (lane < 8 && myk < nv) P.SCO[(size_t)r * 128 + myh] = myg * gelu_tanh(e1s * (1.0f / PEER_SU)) * (1.0f / PEER_SV);
        }
    }
}
DI void peer_v_phase(const FP& P, const Ctx& C, int layer, const float* xin, float* fout, float* fout_s, bf16* xb) {
    const int lane = C.lane; const unsigned char* Vt = P.VB8 + (size_t)layer * PEER_EXPERTS * D_MODEL;
    const float* gam = P.ln_g + ((size_t)layer * 2 + 1) * D_MODEL; const float* bet = P.ln_b + ((size_t)layer * 2 + 1) * D_MODEL;
    const int nrounds = (M0 + C.G * NWAVES - 1) / (C.G * NWAVES);
#pragma unroll 1
    for (int rd = 0; rd <= nrounds; ++rd) {
        const bool smp = (rd == nrounds); int r = smp ? M0 + C.vcu : rd * C.G * NWAVES + C.vcu * NWAVES + C.wave; if (smp ? (C.vcu >= DEC_BATCH) : (r >= M0)) continue;
        const int pb = smp ? 16 * C.wave : 0, pe = smp ? pb + 16 : 128;
        f32x2 x2[8], o2[8];
#pragma unroll
        for (int j = 0; j < 4; ++j) { const f32x4 a = *(const f32x4*)(xin + (size_t)r * D_MODEL + 16 * lane + 4 * j); x2[2 * j] = (f32x2){a.x, a.y}; x2[2 * j + 1] = (f32x2){a.z, a.w}; }
#pragma unroll
        for (int k = 0; k < 8; ++k) o2[k] = (f32x2){0.f, 0.f};
        const int e_l = P.SELE[(size_t)r * 128 + lane], e_h = P.SELE[(size_t)r * 128 + 64 + lane]; const float a_l = P.SCO[(size_t)r * 128 + lane], a_h = P.SCO[(size_t)r * 128 + 64 + lane];
#pragma unroll 1
        for (int b0 = pb; b0 < pe; b0 += 16) { u32x4 vw[16];
#pragma unroll
            for (int k = 0; k < 16; ++k) { const int hk = b0 + k; const int e = (hk < 64) ? __builtin_amdgcn_readlane(e_l, hk & 63) : __builtin_amdgcn_readlane(e_h, hk & 63); vw[k] = *(const u32x4*)(Vt + (size_t)e * D_MODEL + 16 * lane); }
#pragma unroll
            for (int k = 0; k < 16; ++k) { const int hk = b0 + k; axpy16_fp8(vw[k], (hk < 64) ? rdlane(a_l, hk & 63) : rdlane(a_h, hk & 63), o2); } }
        if (smp) {
            LAS float* red = (LAS float*)C.lds;
#pragma unroll
            for (int k = 0; k < 8; ++k) { red[C.wave * 1024 + 16 * lane + 2 * k] = o2[k].x; red[C.wave * 1024 + 16 * lane + 2 * k + 1] = o2[k].y; }
            asm volatile("s_waitcnt lgkmcnt(0)" ::: "memory"); __syncthreads();
            if (C.wave == 0) {
#pragma unroll
                for (int k = 0; k < 8; ++k) { float ax = 0.f, ay = 0.f;
#pragma unroll
                    for (int ww = 0; ww < NWAVES; ++ww) { ax += red[ww * 1024 + 16 * lane + 2 * k]; ay += red[ww * 1024 + 16 * lane + 2 * k + 1]; } o2[k] = (f32x2){ax, ay}; } }
            __syncthreads();
            if (C.wave != 0) continue; }
        float s = 0.f;
#pragma unroll
        for (int k = 0; k < 8; ++k) { o2[k] += x2[k] * ALPHA; s += o2[k].x + o2[k].y; }
        const float mu = wave_sum(s) * (1.0f / D_MODEL); float s2 = 0.f;
#pragma unroll
        for (int k = 0; k < 8; ++k) { o2[k] -= mu; s2 += o2[k].x * o2[k].x + o2[k].y * o2[k].y; }
        const float rs = 1.0f / sqrtf(wave_sum(s2) * (1.0f / D_MODEL) + LN_EPS);
        float* frow = (r < M0) ? fout + (size_t)r * D_MODEL : fout_s + (size_t)(r - M0) * D_MODEL;
#pragma unroll
        for (int j = 0; j < 4; ++j) { const int c0 = 16 * lane + 4 * j; const f32x4 gg = *(const f32x4*)(gam + c0), bb = *(const f32x4*)(bet + c0);
            const f32x4 y = (f32x4){o2[2 * j].x * rs, o2[2 * j].y * rs, o2[2 * j + 1].x * rs, o2[2 * j + 1].y * rs} * gg + bb;
            *(f32x4*)(frow + c0) = y; if (xb) *(u32x2*)(xb + (size_t)r * D_MODEL + c0) = pk4(y); }
    }
}
constexpr int PSH_LIST = 512;
struct PG4 { u32x4 u[4], v[4]; };
DI void peer_sharded_phase(const FP& P, const Ctx& C, int layer, const float* xin, const bf16* xb16, float* fout, float* fout_s, bf16* xb) {
    const int lane = C.lane; const unsigned char* U = P.UB8 + (size_t)layer * PEER_EXPERTS * D_MODEL; const unsigned char* Vt = P.VB8 + (size_t)layer * PEER_EXPERTS * D_MODEL;
    const float* gam = P.ln_g + ((size_t)layer * 2 + 1) * D_MODEL; const float* bet = P.ln_b + ((size_t)layer * 2 + 1) * D_MODEL;
    LAS unsigned char* wl = C.lds + C.wave * 16384; LAS bf16* xs = (LAS bf16*)wl; LAS int* lst = (LAS int*)(wl + 8192);
    const int NW = C.G * NWAVES, gw = C.vcu * NWAVES + C.wave; const int nquads = (M0 / NW) / 4;
#pragma unroll 1
    for (int qd = 0; qd < nquads; ++qd) {
#define PSH_ROW(j) const int row##j = (qd * 4 + j) * NW + gw; const int el##j = P.SELE[(size_t)row##j * 128 + lane], eh##j = P.SELE[(size_t)row##j * 128 + 64 + lane]; const float gl##j = P.SELG[(size_t)row##j * 128 + lane], gh##j = P.SELG[(size_t)row##j * 128 + 64 + lane]; \
        { const u32x4 xa = *(const u32x4*)(xb16 + (size_t)row##j * D_MODEL + 16 * lane), xc = *(const u32x4*)(xb16 + (size_t)row##j * D_MODEL + 16 * lane + 8); *(LAS u32x4*)(xs + j * 1024 + 16 * lane) = xa; *(LAS u32x4*)(xs + j * 1024 + 16 * lane + 8) = xc; } \
        f32x2 oa##j[8]; _Pragma("unroll") for (int k = 0; k < 8; ++k) oa##j[k] = (f32x2){0.f, 0.f};
        PSH_ROW(0) PSH_ROW(1) PSH_ROW(2) PSH_ROW(3)
#pragma unroll 1
        for (int s = 0; s < 16; ++s) {
            int n = 0;
#define PSH_SCAN(j) { unsigned long long b0 = __ballot((el##j >> 10) == s), b1 = __ballot((eh##j >> 10) == s); \
                while (b0) { const int h = __builtin_ctzll(b0); b0 &= b0 - 1; const int e = __builtin_amdgcn_readlane(el##j, h); const int g = __builtin_amdgcn_readlane(__builtin_bit_cast(int, gl##j), h); \
                    if (lane == 0) { lst[4 * n] = e; lst[4 * n + 1] = g; lst[4 * n + 2] = j; } ++n; } \
                while (b1) { const int h = __builtin_ctzll(b1); b1 &= b1 - 1; const int e = __builtin_amdgcn_readlane(eh##j, h); const int g = __builtin_amdgcn_readlane(__builtin_bit_cast(int, gh##j), h); \
                    if (lane == 0) { lst[4 * n] = e; lst[4 * n + 1] = g; lst[4 * n + 2] = j; } ++n; } }
            PSH_SCAN(0) PSH_SCAN(1) PSH_SCAN(2) PSH_SCAN(3)
            asm volatile("s_waitcnt lgkmcnt(0)" ::: "memory");
            if (n == 0) continue;
            const int ngrp = (n + 3) >> 2;
#define PSH_LD(b, gi_) do { const int gi = (gi_); _Pragma("unroll") for (int k = 0; k < 4; ++k) { int i = 4 * gi + k; i = i < n ? i : n - 1; const int e = __builtin_amdgcn_readfirstlane(lst[4 * i]); \
                b.u[k] = *(const u32x4*)(U + (size_t)e * D_MODEL + 16 * lane); b.v[k] = *(const u32x4*)(Vt + (size_t)e * D_MODEL + 16 * lane); } } while (0)
#define PSH_CP(b, gi_) do { const int gi = (gi_); float d[4]; int jj[4]; float gg[4]; \
                _Pragma("unroll") for (int k = 0; k < 4; ++k) { int i = 4 * gi + k; const bool val = i < n; i = val ? i : n - 1; jj[k] = __builtin_amdgcn_readfirstlane(lst[4 * i + 2]); gg[k] = val ? __builtin_bit_cast(float, __builtin_amdgcn_readfirstlane(lst[4 * i + 1])) : 0.f; \
                    const u32x4 xa = *(const LAS u32x4*)(xs + jj[k] * 1024 + 16 * lane), xc = *(const LAS u32x4*)(xs + jj[k] * 1024 + 16 * lane + 8); \
                    const f32x2 x2[8] = {(f32x2){bflo(xa.x), bfhi(xa.x)}, (f32x2){bflo(xa.y), bfhi(xa.y)}, (f32x2){bflo(xa.z), bfhi(xa.z)}, (f32x2){bflo(xa.w), bfhi(xa.w)}, (f32x2){bflo(xc.x), bfhi(xc.x)}, (f32x2){bflo(xc.y), bfhi(xc.y)}, (f32x2){bflo(xc.z), bfhi(xc.z)}, (f32x2){bflo(xc.w), bfhi(xc.w)}}; \
                    d[k] = dot16_fp8(b.u[k], x2); } \
                float e2[2], e1; \
                { const bool hi = lane & 1; _Pragma("unroll") for (int i = 0; i < 2; ++i) { const float keep = hi ? d[2 + i] : d[i], send = hi ? d[i] : d[2 + i]; e2[i] = keep + __shfl_xor(send, 1); } } \
                { const bool hi = lane & 2; const float keep = hi ? e2[1] : e2[0], send = hi ? e2[0] : e2[1]; e1 = keep + __shfl_xor(send, 2); } \
                e1 += __shfl_xor(e1, 4); e1 += __shfl_xor(e1, 8); e1 += __shfl_xor(e1, 16); e1 += __shfl_xor(e1, 32); \
                const int myk = 2 * (lane & 1) + ((lane >> 1) & 1); \
                float myg = gg[0]; myg = (myk == 1) ? gg[1] : myg; myg = (myk == 2) ? gg[2] : myg; myg = (myk == 3) ? gg[3] : myg; \
                const float act = myg * gelu_tanh(e1 * (1.0f / PEER_SU)) * (1.0f / PEER_SV); \
                _Pragma("unroll") for (int k = 0; k < 4; ++k) { const float a = rdlane(act, (k >> 1) | ((k & 1) << 1)); \
                    if (jj[k] == 0) axpy16_fp8(b.v[k], a, oa0); else if (jj[k] == 1) axpy16_fp8(b.v[k], a, oa1); else if (jj[k] == 2) axpy16_fp8(b.v[k], a, oa2); else axpy16_fp8(b.v[k], a, oa3); } } while (0)
            { PG4 A, B; PSH_LD(A, 0);
#pragma unroll 1
              for (int g2 = 0; g2 < ngrp; g2 += 2) { PSH_LD(B, (g2 + 1 < ngrp) ? g2 + 1 : g2); PSH_CP(A, g2); PSH_LD(A, (g2 + 2 < ngrp) ? g2 + 2 : g2); if (g2 + 1 < ngrp) PSH_CP(B, g2 + 1); } }
            asm volatile("s_waitcnt lgkmcnt(0)" ::: "memory");
        }
#define PSH_LN(j) { const int r = row##j; f32x2 x2[8]; \
            _Pragma("unroll") for (int q = 0; q < 4; ++q) { const f32x4 a = *(const f32x4*)(xin + (size_t)r * D_MODEL + 16 * lane + 4 * q); x2[2 * q] = (f32x2){a.x, a.y}; x2[2 * q + 1] = (f32x2){a.z, a.w}; } \
            float sm = 0.f; _Pragma("unroll") for (int k = 0; k < 8; ++k) { oa##j[k] += x2[k] * ALPHA; sm += oa##j[k].x + oa##j[k].y; } \
            const float mu = wave_sum(sm) * (1.0f / D_MODEL); float s2 = 0.f; _Pragma("unroll") for (int k = 0; k < 8; ++k) { oa##j[k] -= mu; s2 += oa##j[k].x * oa##j[k].x + oa##j[k].y * oa##j[k].y; } \
            const float rs = 1.0f / sqrtf(wave_sum(s2) * (1.0f / D_MODEL) + LN_EPS); float* frow = fout + (size_t)r * D_MODEL; \
            _Pragma("unroll") for (int q = 0; q < 4; ++q) { const int c0 = 16 * lane + 4 * q; const f32x4 gv = *(const f32x4*)(gam + c0), bv = *(const f32x4*)(bet + c0); \
                const f32x4 y = (f32x4){oa##j[2 * q].x * rs, oa##j[2 * q].y * rs, oa##j[2 * q + 1].x * rs, oa##j[2 * q + 1].y * rs} * gv + bv; *(f32x4*)(frow + c0) = y; if (xb) *(u32x2*)(xb + (size_t)r * D_MODEL + c0) = pk4(y); } }
        PSH_LN(0) PSH_LN(1) PSH_LN(2) PSH_LN(3)
        asm volatile("s_waitcnt lgkmcnt(0)" ::: "memory");
    }
}
constexpr int PSH_LOG = 11, PSH_N = PEER_EXPERTS >> PSH_LOG;
#ifndef PS2_ROWS
#define PS2_ROWS 4
#endif
#define PS2_ROW(j) const int row##j = (qd * PS2_ROWS + j) * NW + gw; const int el##j = P.SELE[(size_t)row##j * 128 + lane], eh##j = P.SELE[(size_t)row##j * 128 + 64 + lane]; const float gl##j = P.SELG[(size_t)row##j * 128 + lane], gh##j = P.SELG[(size_t)row##j * 128 + 64 + lane]; \
    f32x2 oa##j[8]; _Pragma("unroll") for (int k = 0; k < 8; ++k) oa##j[k] = (f32x2){0.f, 0.f};
#define PS2_STEP(j) { unsigned long long b0 = __ballot((el##j >> PSH_LOG) == s), b1 = __ballot((eh##j >> PSH_LOG) == s); \
    if (b0 | b1) { const u32x4 xa##j = *(const u32x4*)(xb16 + (size_t)row##j * D_MODEL + 16 * lane), xc##j = *(const u32x4*)(xb16 + (size_t)row##j * D_MODEL + 16 * lane + 8);     \
      const f32x2 x2[8] = {(f32x2){bflo(xa##j.x), bfhi(xa##j.x)}, (f32x2){bflo(xa##j.y), bfhi(xa##j.y)}, (f32x2){bflo(xa##j.z), bfhi(xa##j.z)}, (f32x2){bflo(xa##j.w), bfhi(xa##j.w)}, (f32x2){bflo(xc##j.x), bfhi(xc##j.x)}, (f32x2){bflo(xc##j.y), bfhi(xc##j.y)}, (f32x2){bflo(xc##j.z), bfhi(xc##j.z)}, (f32x2){bflo(xc##j.w), bfhi(xc##j.w)}}; \
      _Pragma("unroll 1") while ((b0 | b1) != 0ull) { int hk[8]; u32x4 uw[8], vw[8]; int nv = 0; \
        _Pragma("unroll") for (int k = 0; k < 8; ++k) { int h; if (b0) { h = __builtin_ctzll(b0); b0 &= b0 - 1; ++nv; } else if (b1) { h = 64 + __builtin_ctzll(b1); b1 &= b1 - 1; ++nv; } else h = hk[k > 0 ? k - 1 : 0]; \
            hk[k] = h; const int e = (h < 64) ? __builtin_amdgcn_readlane(el##j, h & 63) : __builtin_amdgcn_readlane(eh##j, h & 63); \
            uw[k] = *(const u32x4*)(U + (size_t)e * D_MODEL + 16 * lane); vw[k] = *(const u32x4*)(Vt + (size_t)e * D_MODEL + 16 * lane); } \
        float d[8]; _Pragma("unroll") for (int k = 0; k < 8; ++k) d[k] = dot16_fp8(uw[k], x2); \
        float e4[4], e2[2], e1s; \
        { const bool hi = lane & 1; _Pragma("unroll") for (int i = 0; i < 4; ++i) { const float keep = hi ? d[4 + i] : d[i], send = hi ? d[i] : d[4 + i]; e4[i] = keep + __shfl_xor(send, 1); } } \
        { const bool hi = lane & 2; _Pragma("unroll") for (int i = 0; i < 2; ++i) { const float keep = hi ? e4[2 + i] : e4[i], send = hi ? e4[i] : e4[2 + i]; e2[i] = keep + __shfl_xor(send, 2); } } \
        { const bool hi = lane & 4; const float keep = hi ? e2[1] : e2[0], send = hi ? e2[0] : e2[1]; e1s = keep + __shfl_xor(send, 4); } \
        e1s += __shfl_xor(e1s, 8); e1s += __shfl_xor(e1s, 16); e1s += __shfl_xor(e1s, 32); \
        const int myk = 4 * (lane & 1) + (lane & 2) + ((lane >> 2) & 1); int myh = hk[0]; _Pragma("unroll") for (int k = 1; k < 8; ++k) myh = (myk == k) ? hk[k] : myh; \
        const float ga = __shfl(gl##j, myh & 63), gb = __shfl(gh##j, myh & 63); const float myg = (myk < nv) ? ((myh < 64) ? ga : gb) : 0.f;     \
        const float act = myg * gelu_tanh(e1s * (1.0f / PEER_SU)) * (1.0f / PEER_SV); \
        _Pragma("unroll") for (int k = 0; k < 8; ++k) { const int src = (k >> 2) | (((k >> 1) & 1) << 1) | ((k & 1) << 2); axpy16_fp8(vw[k], rdlane(act, src), oa##j); } } } }
#define PS2_LN(j) { const int r = row##j; f32x2 x2[8]; \
    _Pragma("unroll") for (int q = 0; q < 4; ++q) { const f32x4 a = *(const f32x4*)(xin + (size_t)r * D_MODEL + 16 * lane + 4 * q); x2[2 * q] = (f32x2){a.x, a.y}; x2[2 * q + 1] = (f32x2){a.z, a.w}; } \
    float sm = 0.f; _Pragma("unroll") for (int k = 0; k < 8; ++k) { oa##j[k] += x2[k] * ALPHA; sm += oa##j[k].x + oa##j[k].y; } \
    const float mu = wave_sum(sm) * (1.0f / D_MODEL); float s2 = 0.f; _Pragma("unroll") for (int k = 0; k < 8; ++k) { oa##j[k] -= mu; s2 += oa##j[k].x * oa##j[k].x + oa##j[k].y * oa##j[k].y; } \
    const float rs = 1.0f / sqrtf(wave_sum(s2) * (1.0f / D_MODEL) + LN_EPS); float* frow = fout + (size_t)r * D_MODEL; \
    _Pragma("unroll") for (int q = 0; q < 4; ++q) { const int c0 = 16 * lane + 4 * q; const f32x4 gv = *(const f32x4*)(gam + c0), bv = *(const f32x4*)(bet + c0); \
        const f32x4 y = (f32x4){oa##j[2 * q].x * rs, oa##j[2 * q].y * rs, oa##j[2 * q + 1].x * rs, oa##j[2 * q + 1].y * rs} * gv + bv; *(f32x4*)(frow + c0) = y; if (xb) *(u32x2*)(xb + (size_t)r * D_MODEL + c0) = pk4(y); } }
DI void peer_sharded2_phase(const FP& P, const Ctx& C, int layer, const float* xin, const bf16* xb16, float* fout, bf16* xb) {
    const int lane = C.lane; const unsigned char* U = P.UB8 + (size_t)layer * PEER_EXPERTS * D_MODEL; const unsigned char* Vt = P.VB8 + (size_t)layer * PEER_EXPERTS * D_MODEL;
    const float* gam = P.ln_g + ((size_t)layer * 2 + 1) * D_MODEL; const float* bet = P.ln_b + ((size_t)layer * 2 + 1) * D_MODEL;
    const int NW = C.G * NWAVES, gw = C.vcu * NWAVES + C.wave; const int nquads = (M0 / NW) / PS2_ROWS;
#pragma unroll 1
    for (int qd = 0; qd < nquads; ++qd) {
#if PS2_ROWS == 4
        PS2_ROW(0) PS2_ROW(1) PS2_ROW(2) PS2_ROW(3)
#pragma unroll 1
        for (int s = 0; s < PSH_N; ++s) { PS2_STEP(0) PS2_STEP(1) PS2_STEP(2) PS2_STEP(3) }
        PS2_LN(0) PS2_LN(1) PS2_LN(2) PS2_LN(3)
#else
        PS2_ROW(0) PS2_ROW(1)
#pragma unroll 1
        for (int s = 0; s < PSH_N; ++s) { PS2_STEP(0) PS2_STEP(1) }
        PS2_LN(0) PS2_LN(1)
#endif
    }
}
}
namespace fx {
struct EpiB {
    static constexpr bool PERM = true, AFTER_DRAIN = false; const FP& P;
    DI void operator()(const f32x4 (&acc)[2][2][4][2], const pg8::Unit& u, int wr, int wc, int fr, int fq) const {
        const int t = u.pn;
        EPI_LOOP({ if (row < MP) { const int pos = row_pos(row), n = row / SEQ, e = ct & 63, dp = e >> 1; const bool prm = row < M0;
            if (t < 3) { const int ty = 2 * t + (ct >> 7), kvh = (ct >> 6) & 1;
                if (ty == 2 || ty == 4) { f32x4 lo, hi; rope4(P.ROPE + pos * 64, dp, v0, v1, lo, hi);
                    if (ty == 2) { float* o = (prm ? P.nsa_kv_p + (size_t)row * 512 : P.nsa_kv_s + (size_t)(row - M0) * 512) + 256 + kvh * 64 + dp; *(f32x4*)o = lo; *(f32x4*)(o + 32) = hi;
                        if (prm) { bf16* kt = P.SLK + ((size_t)n * NSA_KV_HEADS + kvh) * SEQ * 64; *(u32x2*)(kt + ktile_off(pos, dp)) = pk4(lo); *(u32x2*)(kt + ktile_off(pos, dp + 32)) = pk4(hi); } }
                    else { float* o = nullptr; if (!prm) o = P.win_s + (((size_t)(row - M0) * SWA_WINDOW + SWA_WINDOW - 1) * 2 + 0) * 128; else if (pos >= SEQ - SWA_WINDOW) o = P.win_p + (((size_t)n * SWA_WINDOW + pos - (SEQ - SWA_WINDOW)) * 2 + 0) * 128;
                        if (o) { *(f32x4*)(o + kvh * 64 + dp) = lo; *(f32x4*)(o + kvh * 64 + 32 + dp) = hi; }
                        if (prm) { bf16* kt = P.WNK + ((size_t)n * NSA_KV_HEADS + kvh) * SEQ * 64; *(u32x2*)(kt + ktile_off(pos, dp)) = pk4(lo); *(u32x2*)(kt + ktile_off(pos, dp + 32)) = pk4(hi); } } }
                else if (ty < 4) { float* o = (prm ? P.nsa_kv_p + (size_t)row * 512 : P.nsa_kv_s + (size_t)(row - M0) * 512) + ty * 128 + kvh * 64 + e; *(f32x4*)o = v0; *(f32x4*)(o + 4) = v1;
                    if (prm) { if (ty < 2) *(u32x4*)(P.AC + ((size_t)ty * ACROWS + ((size_t)n * NSA_KV_HEADS + kvh) * NCH + pos / 16) * 1024 + (pos % 16) * 64 + e) = pk8(v0, v1);
                        else { bf16* vt = P.SLVT + ((size_t)n * NSA_KV_HEADS + kvh) * SEQ * 64 + vtile_off(e, pos);
                            vt[0] = (bf16)f2bf(v0.x); vt[8] = (bf16)f2bf(v0.y); vt[16] = (bf16)f2bf(v0.z); vt[24] = (bf16)f2bf(v0.w); vt[32] = (bf16)f2bf(v1.x); vt[40] = (bf16)f2bf(v1.y); vt[48] = (bf16)f2bf(v1.z); vt[56] = (bf16)f2bf(v1.w); } } }
                else { float* o = nullptr; if (!prm) o = P.win_s + (((size_t)(row - M0) * SWA_WINDOW + SWA_WINDOW - 1) * 2 + 1) * 128; else if (pos >= SEQ - SWA_WINDOW) o = P.win_p + (((size_t)n * SWA_WINDOW + pos - (SEQ - SWA_WINDOW)) * 2 + 1) * 128;
                    if (o) { *(f32x4*)(o + kvh * 64 + e) = v0; *(f32x4*)(o + kvh * 64 + e + 4) = v1; }
                    if (prm) { bf16* vt = P.WNVT + ((size_t)n * NSA_KV_HEADS + kvh) * SEQ * 64 + vtile_off(e, pos);
                        vt[0] = (bf16)f2bf(v0.x); vt[8] = (bf16)f2bf(v0.y); vt[16] = (bf16)f2bf(v0.z); vt[24] = (bf16)f2bf(v0.w); vt[32] = (bf16)f2bf(v1.x); vt[40] = (bf16)f2bf(v1.y); vt[48] = (bf16)f2bf(v1.z); vt[56] = (bf16)f2bf(v1.w); } } }
            else if (t < 6) { const int h = (t - 3) * 4 + (ct >> 6); f32x4 lo, hi; rope4(P.ROPE + pos * 64, dp, v0, v1, lo, hi); bf16* q = P.QB + (size_t)row * NSA_Q_COLS + h * 64 + dp; *(u32x2*)q = pk4(lo * QSCALE); *(u32x2*)(q + 32) = pk4(hi * QSCALE); }
            else if (t == 6) { *(u32x4*)(P.MQB + (size_t)row * 256 + ct) = pk8(v0 * QSCALE, v1 * QSCALE); }
            else if (ct < 40) { const float vv[8] = {v0.x, v0.y, v0.z, v0.w, v1.x, v1.y, v1.z, v1.w};
                _Pragma("unroll") for (int i = 0; i < 8; ++i) if (ct + i < NSA_GATE_COLS) P.GATES[(size_t)row * 64 + ct + i] = 1.0f / (1.0f + __expf(-vv[i])); } } })
    }
};
DI void cmp2_phase(const FP& P, const Ctx& C) {
    const int lane = C.lane; LAS float* hs = (LAS float*)(C.lds + C.wave * 1024);
    constexpr int NGRP = NCTX * 2 * NSA_KV_HEADS; const int NW = C.G * NWAVES, WPG = NW / NGRP > 0 ? NW / NGRP : 1; const int gw = C.vcu * NWAVES + C.wave;
#pragma unroll 1
    for (int grp = gw / WPG; grp < NGRP; grp += (NW + WPG - 1) / WPG) { const int slot = gw % WPG; if (gw >= (NW / WPG) * WPG && grp == gw / WPG) break;
        const int kvh = grp % NSA_KV_HEADS, ty = (grp / NSA_KV_HEADS) % 2, ctx = grp / (2 * NSA_KV_HEADS);
        const float* UL = P.UL + ((size_t)ty * ACROWS + ((size_t)ctx * NSA_KV_HEADS + kvh) * NCH) * 256; const float* w2 = P.cmp_w2 + (size_t)ty * CMP_HIDDEN * HEAD_DIM;
        float w2r[CMP_HIDDEN];
#pragma unroll
        for (int k = 0; k < CMP_HIDDEN; ++k) w2r[k] = w2[k * HEAD_DIM + lane];
        const float b0 = P.CBIAS[ty * CMP_HIDDEN + lane], b1 = P.CBIAS[ty * CMP_HIDDEN + 64 + lane];
        float u0, u1, l0, l1; int c = slot;
        if (c < NCMP) { u0 = UL[(size_t)c * 256 + lane]; u1 = UL[(size_t)c * 256 + 64 + lane]; l0 = UL[(size_t)(c + 1) * 256 + 128 + lane]; l1 = UL[(size_t)(c + 1) * 256 + 192 + lane]; }
#pragma unroll 1
        for (; c < NCMP; c += WPG) { const float h0 = gelu_tanh(u0 + l0 + b0), h1 = gelu_tanh(u1 + l1 + b1); const int cn = c + WPG;
            if (cn < NCMP) { u0 = UL[(size_t)cn * 256 + lane]; u1 = UL[(size_t)cn * 256 + 64 + lane]; l0 = UL[(size_t)(cn + 1) * 256 + 128 + lane]; l1 = UL[(size_t)(cn + 1) * 256 + 192 + lane]; }
            hs[lane] = h0; hs[64 + lane] = h1; asm volatile("s_waitcnt lgkmcnt(0)" ::: "memory");
            float a = 0.f;
#pragma unroll
            for (int k4 = 0; k4 < CMP_HIDDEN / 4; ++k4) { const f32x4 hv = *(const LAS f32x4*)(hs + 4 * k4); a += hv.x * w2r[4 * k4] + hv.y * w2r[4 * k4 + 1] + hv.z * w2r[4 * k4 + 2] + hv.w * w2r[4 * k4 + 3]; }
            if (ty == 0) { const float other = __shfl_xor(a, 32); const int pos = c * CMP_STRIDE + CMP_BLOCK - 1; const float cs = P.ROPE[pos * 64 + (lane & 31)], sn = P.ROPE[pos * 64 + 32 + (lane & 31)];
                a = (lane < 32) ? a * cs - other * sn : a * cs + other * sn; }
            if (ctx < BATCH) { if (ty == 0) P.CK[((size_t)ctx * NSA_KV_HEADS + kvh) * NCH * 64 + ktile_off(c, lane)] = (bf16)f2bf(a); else P.CVT[((size_t)ctx * NSA_KV_HEADS + kvh) * NCH * 64 + vtile_off(lane, c)] = (bf16)f2bf(a); }
            else { (ty == 0 ? P.CKF : P.CVF)[(((size_t)(ctx - BATCH) * NSA_KV_HEADS + kvh) * NCH + c) * 64 + lane] = a; }
            asm volatile("s_waitcnt lgkmcnt(0)" ::: "memory"); }
    }
    __syncthreads();
}
constexpr int NSA_WLDS = 8192;
DI void nsa_pair_a(const FP& P, int n, int kvh, int t, int lane, LAS unsigned char* wl) {
    LAS float* pn = (LAS float*)wl; LAS float* imp = (LAS float*)(wl + 2048); LAS float* sc = (LAS float*)(wl + 6144); LAS int* sel = (LAS int*)(wl + 7168);
    const int col = lane & 15, c = lane >> 4; const bool vcol = col < 12; const int qq = vcol ? col / 6 : 0, hh = vcol ? col % 6 : 0, tq = t + qq, head = kvh * NSA_GROUP + hh, row = n * SEQ + tq;
    bf16x8 qf[2]; { const bf16* qp = P.QB + (size_t)row * NSA_Q_COLS + head * 64 + 8 * c; qf[0] = *(const bf16x8*)qp; qf[1] = *(const bf16x8*)(qp + 32); }
    const float* gt = P.GATES + (size_t)row * 64 + head * 3;
    f32x4 oacc[4] = {(f32x4){0.f, 0.f, 0.f, 0.f}, (f32x4){0.f, 0.f, 0.f, 0.f}, (f32x4){0.f, 0.f, 0.f, 0.f}, (f32x4){0.f, 0.f, 0.f, 0.f}};
    const int lim = vcol ? ((tq >= CMP_BLOCK - 1) ? (tq - (CMP_BLOCK - 1)) / CMP_STRIDE : -1) : -1;
    const int limmax = (t + 1 >= CMP_BLOCK - 1) ? (t + 1 - (CMP_BLOCK - 1)) / CMP_STRIDE : -1; const int nblk = (limmax + 32) / 32;
    const bf16* CKb = P.CK + ((size_t)n * NSA_KV_HEADS + kvh) * NCH * 64; const bf16* CVb = P.CVT + ((size_t)n * NSA_KV_HEADS + kvh) * 64 * NCH;
    for (int i = lane; i < 1024; i += 64) imp[i] = 0.f;
    float m1 = -INFINITY, l1 = 0.f;
    { struct K4 { bf16x8 a0, a1, b0, b1; };
      auto ldk = [&](K4& k, int blk) { const bf16* kt = CKb + (size_t)blk * 2048 + lane * 8; k.a0 = *(const bf16x8*)kt; k.a1 = *(const bf16x8*)(kt + 512); k.b0 = *(const bf16x8*)(kt + 1024); k.b1 = *(const bf16x8*)(kt + 1536); };
      auto cp1 = [&](const K4& k, int blk) { const int kb = 32 * blk;
        f32x4 s0 = (f32x4){0.f, 0.f, 0.f, 0.f}, s1 = (f32x4){0.f, 0.f, 0.f, 0.f};
        s0 = __builtin_amdgcn_mfma_f32_16x16x32_bf16(k.a0, qf[0], s0, 0, 0, 0); s0 = __builtin_amdgcn_mfma_f32_16x16x32_bf16(k.a1, qf[1], s0, 0, 0, 0);
        s1 = __builtin_amdgcn_mfma_f32_16x16x32_bf16(k.b0, qf[0], s1, 0, 0, 0); s1 = __builtin_amdgcn_mfma_f32_16x16x32_bf16(k.b1, qf[1], s1, 0, 0, 0);
        float s[8] = {s0.x, s0.y, s0.z, s0.w, s1.x, s1.y, s1.z, s1.w}; float mx = -INFINITY;
#pragma unroll
        for (int e = 0; e < 8; ++e) { s[e] = (kb + 8 * c + e <= lim) ? s[e] : -INFINITY; mx = fmaxf(mx, s[e]); }
        mx = fmaxf(mx, __shfl_xor(mx, 16)); mx = fmaxf(mx, __shfl_xor(mx, 32));
        const float mnew = fmaxf(m1, mx), muse = (mnew == -INFINITY) ? 0.f : mnew; float ls = 0.f;
#pragma unroll
        for (int e = 0; e < 8; ++e) ls += __builtin_amdgcn_exp2f(s[e] - muse);
        ls += __shfl_xor(ls, 16); ls += __shfl_xor(ls, 32);
        l1 = l1 * __builtin_amdgcn_exp2f(m1 - muse) + ls; m1 = mnew; };
      if (nblk > 0) { K4 A, B; ldk(A, 0);
#pragma unroll 1
        for (int blk = 0; blk < nblk; blk += 2) { ldk(B, (blk + 1 < nblk) ? blk + 1 : blk); cp1(A, blk); ldk(A, (blk + 2 < nblk) ? blk + 2 : blk); if (blk + 1 < nblk) cp1(B, blk + 1); } } }
    asm volatile("s_waitcnt lgkmcnt(0)" ::: "memory");
    { const float muse = (m1 == -INFINITY) ? 0.f : m1, inv = (l1 > 0.f) ? 1.0f / l1 : 0.f;
      f32x4 oc[4] = {(f32x4){0.f, 0.f, 0.f, 0.f}, (f32x4){0.f, 0.f, 0.f, 0.f}, (f32x4){0.f, 0.f, 0.f, 0.f}, (f32x4){0.f, 0.f, 0.f, 0.f}};
      pipe2(nblk, [&](KV8& kv, int blk) { kv_load_t(kv, CKb + (size_t)blk * 2048, CVb + (size_t)blk * 2048, lane); }, [&](const KV8& kv, int blk) { const int kb = 32 * blk;
        f32x4 s0 = (f32x4){0.f, 0.f, 0.f, 0.f}, s1 = (f32x4){0.f, 0.f, 0.f, 0.f};
        s0 = __builtin_amdgcn_mfma_f32_16x16x32_bf16(kv.ka0, qf[0], s0, 0, 0, 0); s0 = __builtin_amdgcn_mfma_f32_16x16x32_bf16(kv.ka1, qf[1], s0, 0, 0, 0);
        s1 = __builtin_amdgcn_mfma_f32_16x16x32_bf16(kv.kb0, qf[0], s1, 0, 0, 0); s1 = __builtin_amdgcn_mfma_f32_16x16x32_bf16(kv.kb1, qf[1], s1, 0, 0, 0);
        float s[8] = {s0.x, s0.y, s0.z, s0.w, s1.x, s1.y, s1.z, s1.w};
#pragma unroll
        for (int e = 0; e < 8; ++e) s[e] = (kb + 8 * c + e <= lim) ? __builtin_amdgcn_exp2f(s[e] - muse) * inv : 0.f;
        *(f32x4*)(pn + col * 32 + 8 * c) = (f32x4){s[0], s[1], s[2], s[3]}; *(f32x4*)(pn + col * 32 + 8 * c + 4) = (f32x4){s[4], s[5], s[6], s[7]};
        u32x4 pw; pw.x = cvtpk(s[0], s[1]); pw.y = cvtpk(s[2], s[3]); pw.z = cvtpk(s[4], s[5]); pw.w = cvtpk(s[6], s[7]); const bf16x8 pf = __builtin_bit_cast(bf16x8, pw);
        oc[0] = __builtin_amdgcn_mfma_f32_16x16x32_bf16(kv.v0, pf, oc[0], 0, 0, 0); oc[1] = __builtin_amdgcn_mfma_f32_16x16x32_bf16(kv.v1, pf, oc[1], 0, 0, 0);
        oc[2] = __builtin_amdgcn_mfma_f32_16x16x32_bf16(kv.v2, pf, oc[2], 0, 0, 0); oc[3] = __builtin_amdgcn_mfma_f32_16x16x32_bf16(kv.v3, pf, oc[3], 0, 0, 0);
        asm volatile("s_waitcnt lgkmcnt(0)" ::: "memory");
        { const int q2 = lane >> 5, k = lane & 31; float a = 0.f;
#pragma unroll
          for (int h6 = 0; h6 < 6; ++h6) a += pn[(q2 * 6 + h6) * 32 + k];
          imp[q2 * 512 + kb + k] = a; }
        asm volatile("s_waitcnt lgkmcnt(0)" ::: "memory"); });
#ifdef NSA_DEBUG
      if (vcol) { for (int db = 0; db < 4; ++db) *(f32x4*)(P.DBG + ((size_t)0 * MP + row) * 768 + head * 64 + 16 * db + 4 * c) = oc[db]; }
#endif
      const float g0 = vcol ? gt[0] : 0.f;
#pragma unroll
      for (int db = 0; db < 4; ++db) oacc[db] += oc[db] * g0; }
#ifndef REP_SEL
#define REP_SEL 1
#endif
#pragma unroll 1
    for (int rep = 0; rep < REP_SEL; ++rep) {
    for (int i = lane; i < 256; i += 64) { const int q2 = i >> 7, b = i & 127, tq2 = t + q2, cur = tq2 / SLC_BLOCK; float sv;
        if (b > cur) sv = NEG; else if (b == 0 || b == cur || b == cur - 1) sv = FORCE_SCORE;
        else { const LAS float* ic = imp + q2 * 512 + 4 * b; sv = ic[-1] + 2.f * (ic[0] + ic[1] + ic[2]) + ic[3]; }
        sc[i] = sv; }
    asm volatile("s_waitcnt lgkmcnt(0)" ::: "memory");
    for (int i = lane; i < 256; i += 64) { const int q2 = i >> 7, b = i & 127; const float sv = sc[i]; int rank = 0;
        for (int j = 0; j < 128; j += 4) { const f32x4 o = *(const LAS f32x4*)(sc + q2 * 128 + j);
            rank += (o.x > sv || (o.x == sv && j < b)) ? 1 : 0; rank += (o.y > sv || (o.y == sv && j + 1 < b)) ? 1 : 0; rank += (o.z > sv || (o.z == sv && j + 2 < b)) ? 1 : 0; rank += (o.w > sv || (o.w == sv && j + 3 < b)) ? 1 : 0; }
        if (rank < SLC_TOPK) { const int v = (sv > 0.5f * NEG) ? b : -1; sel[q2 * 16 + rank] = v; P.SELB[((size_t)(n * SEQ + t + q2) * NSA_KV_HEADS + kvh) * 16 + rank] = v; } }
    asm volatile("s_waitcnt lgkmcnt(0)" ::: "memory");
    }
#ifndef REP_WIN
#define REP_WIN 1
#endif
#pragma unroll 1
    for (int rep = 0; rep < REP_WIN; ++rep) { Tile16 T; tile_init(T);
      const bf16* WKb = P.WNK + ((size_t)n * NSA_KV_HEADS + kvh) * SEQ * 64; const bf16* WVb = P.WNVT + ((size_t)n * NSA_KV_HEADS + kvh) * 64 * SEQ;
      const int blo = (t - SWA_WINDOW) >> 5, bhi = (t + 1) >> 5;
      auto ld = [&](KV8& kv, int blk) { const int bc = blk < 0 ? 0 : blk; kv_load_t(kv, WKb + (size_t)bc * 2048, WVb + (size_t)bc * 2048, lane); };
      pipe2(bhi - blo + 1, [&](KV8& kv, int i) { ld(kv, blo + i); }, [&](const KV8& kv, int i) { const int kb = 32 * (blo + i);
          tile_compute(T, qf, kv, [&](int e) { const int kp = kb + 8 * c + e; return vcol && kp >= 0 && kp <= tq && tq - kp <= SWA_WINDOW; }); });
      const float inv = (T.l > 0.f) ? 1.0f / T.l : 0.f, g2 = vcol ? gt[2] * inv : 0.f;
#ifdef NSA_DEBUG
      if (vcol) { for (int db = 0; db < 4; ++db) *(f32x4*)(P.DBG + ((size_t)2 * MP + row) * 768 + head * 64 + 16 * db + 4 * c) = T.o[db] * inv; }
#endif
#pragma unroll
      for (int db = 0; db < 4; ++db) if (rep == REP_WIN - 1) oacc[db] += T.o[db] * g2; }
    if (vcol) { float* op = P.DPART + (size_t)row * 768 + head * 64 + 4 * c;
#pragma unroll
        for (int db = 0; db < 4; ++db) *(f32x4*)(op + 16 * db) = oacc[db]; }
}
DI void nsa_pair_b(const FP& P, int n, int kvh, int t, int lane, LAS unsigned char* wl) {
    LAS int* steps = (LAS int*)wl;
    const int col = lane & 15, c = lane >> 4; const bool vcol = col < 12; const int qq = vcol ? col / 6 : 0, hh = vcol ? col % 6 : 0, tq = t + qq, head = kvh * NSA_GROUP + hh, row = n * SEQ + tq;
    bf16x8 qf[2]; { const bf16* qp = P.QB + (size_t)row * NSA_Q_COLS + head * 64 + 8 * c; qf[0] = *(const bf16x8*)qp; qf[1] = *(const bf16x8*)(qp + 32); }
    const float* gt = P.GATES + (size_t)row * 64 + head * 3;
    Tile16 T; tile_init(T);
    const bf16* SKb = P.SLK + ((size_t)n * NSA_KV_HEADS + kvh) * SEQ * 64; const bf16* SVb = P.SLVT + ((size_t)n * NSA_KV_HEADS + kvh) * SEQ * 64;
    int ns = 0;
    { const int mysel = (lane < 32) ? P.SELB[((size_t)(n * SEQ + t + (lane >> 4)) * NSA_KV_HEADS + kvh) * 16 + (lane & 15)] : -1;
      for (int i = 0; i < 32; ++i) { const int b = __builtin_amdgcn_readlane(mysel, i); if (b < 0) continue; int q2 = i >> 4;
          const unsigned long long other = __ballot(mysel == b && lane < 32 && (lane >> 4) != q2);
          if (other) { if (q2 == 1) continue; q2 = 2; }
          if (lane == 0) { steps[ns] = (b * SLC_BLOCK) | (q2 << 29); steps[ns + 1] = (b * SLC_BLOCK + 32) | (q2 << 29); } ns += 2; } }
    asm volatile("s_waitcnt lgkmcnt(0)" ::: "memory");
    auto ld = [&](KV8& kv, int i) { const int code = __builtin_amdgcn_readfirstlane(steps[i]); const int kb = code & 0x1fffffff;
        kv_load_t(kv, SKb + (size_t)(kb >> 5) * 2048, SVb + (size_t)(kb >> 5) * 2048, lane); };
#ifdef PROBE_DBLCOMP
    Tile16 T2; tile_init(T2);
#endif
    pipe2(ns, ld, [&](const KV8& kv, int i) { const int code = __builtin_amdgcn_readfirstlane(steps[i]); const int kb = code & 0x1fffffff, q2 = code >> 29;
        tile_compute(T, qf, kv, [&](int e) { return vcol && (q2 == 2 || qq == q2) && (kb + 8 * c + e) <= tq; });
#ifdef PROBE_DBLCOMP
        tile_compute(T2, qf, kv, [&](int e) { return vcol && qq == q2 && (kb + 8 * c + e + 1) <= tq; });
#endif
    });
#ifdef PROBE_DBLCOMP
    if (T2.l < 0.f) T.l = 0.f;
#endif
    const float inv = (T.l > 0.f) ? 1.0f / T.l : 0.f, g1 = vcol ? gt[1] * inv : 0.f;
#ifdef NSA_DEBUG
    if (vcol) { for (int db = 0; db < 4; ++db) *(f32x4*)(P.DBG + ((size_t)1 * MP + row) * 768 + head * 64 + 16 * db + 4 * c) = T.o[db] * inv; }
#endif
    if (vcol) { const float* pp = P.DPART + (size_t)row * 768 + head * 64 + 4 * c; bf16* op = P.ATTB + (size_t)row * 1024 + head * 64 + 4 * c;
#pragma unroll
        for (int db = 0; db < 4; ++db) *(u32x2*)(op + 16 * db) = pk4(*(const f32x4*)(pp + 16 * db) + T.o[db] * g1); }
}

constexpr int SMP_SK = 1088;
template <class KF, class VF> DI void smp_branch(const Ctx& C, LAS float* qs, LAS float* S, LAS float* red, int NK, KF kf, VF vf, bool keep_probs, float (&outh)[1]) {
    const int tid = C.tid, lane = C.lane, w = C.wave;
#pragma unroll 1
    for (int j = tid; j < NK; j += NTHREADS) { const float* k = kf(j); f32x4 kr[16];
#pragma unroll
        for (int d4 = 0; d4 < 16; ++d4) kr[d4] = *(const f32x4*)(k + 4 * d4);
#pragma unroll 1
        for (int h = 0; h < 6; ++h) { float a = 0.f;
#pragma unroll
            for (int d4 = 0; d4 < 16; ++d4) { const f32x4 qv = *(const LAS f32x4*)(qs + h * 64 + 4 * d4); a += kr[d4].x * qv.x + kr[d4].y * qv.y + kr[d4].z * qv.z + kr[d4].w * qv.w; }
            S[h * SMP_SK + j] = a; } }
    asm volatile("s_waitcnt lgkmcnt(0)" ::: "memory"); __syncthreads();
    if (w < 6) { float m = -INFINITY; for (int j = lane; j < NK; j += 64) m = fmaxf(m, S[w * SMP_SK + j]); m = wave_max(m);
        float l = 0.f; for (int j = lane; j < NK; j += 64) { const float p = __builtin_amdgcn_exp2f(S[w * SMP_SK + j] - m); S[w * SMP_SK + j] = p; l += p; } l = wave_sum(l);
        const float inv = 1.0f / l; for (int j = lane; j < NK; j += 64) S[w * SMP_SK + j] *= inv; }
    asm volatile("s_waitcnt lgkmcnt(0)" ::: "memory"); __syncthreads();
    { const int per = (NK + NWAVES - 1) / NWAVES, j0 = w * per, j1 = (j0 + per < NK) ? j0 + per : NK; float o[6] = {0.f, 0.f, 0.f, 0.f, 0.f, 0.f};
#pragma unroll 1
      for (int j = j0; j < j1; j += 8) { float vv[8];
#pragma unroll
          for (int u = 0; u < 8; ++u) { const int jj = (j + u < j1) ? j + u : j1 - 1; vv[u] = vf(jj)[lane]; }
#pragma unroll
          for (int u = 0; u < 8; ++u) if (j + u < j1) {
#pragma unroll
              for (int h = 0; h < 6; ++h) o[h] += S[h * SMP_SK + j + u] * vv[u]; } }
#pragma unroll
      for (int h = 0; h < 6; ++h) red[(w * 6 + h) * 64 + lane] = o[h]; }
    asm volatile("s_waitcnt lgkmcnt(0)" ::: "memory"); __syncthreads();
    outh[0] = 0.f;
    if (tid < 384) { float a = 0.f;
#pragma unroll
        for (int ww = 0; ww < NWAVES; ++ww) a += red[ww * 384 + tid]; outh[0] = a; }
    if (!keep_probs) { __syncthreads(); }
}
DI void nsa_sample_item(const FP& P, const Ctx& C, int ns, int kvh) {
    LAS float* qs = (LAS float*)C.lds; LAS float* S = qs + 384; LAS float* red = S + 6 * SMP_SK; LAS float* scs = red + 8 * 384; LAS int* sel = (LAS int*)(scs + 136);
    const int tid = C.tid, row = M0 + ns;
    if (tid < 384) qs[tid] = bf2f(P.QB[(size_t)row * NSA_Q_COLS + kvh * 384 + tid]);
    asm volatile("s_waitcnt lgkmcnt(0)" ::: "memory"); __syncthreads();
    const float* ckf = P.CKF + ((size_t)ns * NSA_KV_HEADS + kvh) * NCH * 64; const float* cvf = P.CVF + ((size_t)ns * NSA_KV_HEADS + kvh) * NCH * 64;
    float oc[1], os[1], ow[1];
    smp_branch(C, qs, S, red, NCMP, [&](int j) { return ckf + (size_t)j * 64; }, [&](int j) { return cvf + (size_t)j * 64; }, true, oc);
    constexpr int NBS = (PAST_LEN + 1 + SLC_BLOCK - 1) / SLC_BLOCK, CURS = PAST_LEN / SLC_BLOCK;
    for (int b = tid; b < 136; b += NTHREADS) { float sv = -3.0e38f;
        if (b < NBS) { if (b == 0 || b == CURS || b == CURS - 1) sv = FORCE_SCORE; else { float a = 0.f;
#pragma unroll
                for (int o = -1; o <= 3; ++o) { const int ci = 4 * b + o; if (ci >= 0 && ci < NCMP) { float sm = 0.f; for (int h6 = 0; h6 < 6; ++h6) sm += S[h6 * SMP_SK + ci]; a += ((o >= 0 && o <= 2) ? 2.f : 1.f) * sm; } }
                sv = a; } }
        scs[b] = sv; }
    asm volatile("s_waitcnt lgkmcnt(0)" ::: "memory"); __syncthreads();
    for (int b = tid; b < NBS; b += NTHREADS) { const float sv = scs[b]; int rank = 0; for (int j = 0; j < NBS; ++j) { const float o = scs[j]; rank += (o > sv || (o == sv && j < b)) ? 1 : 0; }
        if (rank < SLC_TOPK) { sel[rank] = b; P.SELB[((size_t)row * NSA_KV_HEADS + kvh) * 16 + rank] = b; } }
    asm volatile("s_waitcnt lgkmcnt(0)" ::: "memory"); __syncthreads();
    { const float* newrow = P.nsa_kv_s + (size_t)ns * 512; const int* pt = P.page_table + ns * (PAST_LEN / PAGE_SIZE);
      if (tid == 0) { int seen = 0; for (int x = 0; x < SLC_TOPK; ++x) { const int bx = sel[x]; if (bx != CURS && seen < 15) sel[16 + seen++] = bx; } }
      asm volatile("s_waitcnt lgkmcnt(0)" ::: "memory"); __syncthreads();
      auto krow = [&](int j, int ty) -> const float* { if (j >= 15 * 64) return newrow + ty * 128 + kvh * 64;
          const int t0 = sel[16 + (j >> 6)] * SLC_BLOCK + (j & 63); const int pg = pt[t0 / PAGE_SIZE]; return P.cache_nsa_kv + ((size_t)pg * PAGE_SIZE + t0 % PAGE_SIZE) * 512 + ty * 128 + kvh * 64; };
      smp_branch(C, qs, S, red, 15 * 64 + 1, [&](int j) { return krow(j, 2); }, [&](int j) { return krow(j, 3); }, false, os); }
    { const float* wc = P.cache_nsa_win + (size_t)ns * SWA_WINDOW * 256; const float* newrow = P.win_s + ((size_t)ns * SWA_WINDOW + SWA_WINDOW - 1) * 256;
      smp_branch(C, qs, S, red, SWA_WINDOW + 1, [&](int j) { return (j < SWA_WINDOW ? wc + (size_t)j * 256 : newrow) + kvh * 64; }, [&](int j) { return (j < SWA_WINDOW ? wc + (size_t)j * 256 : newrow) + 128 + kvh * 64; }, false, ow); }
    if (tid < 384) { const int head = kvh * NSA_GROUP + tid / 64; const float* gt = P.GATES + (size_t)row * 64 + head * 3;
        P.ATTB[(size_t)row * 1024 + kvh * 384 + tid] = (bf16)f2bf(gt[0] * oc[0] + gt[1] * os[0] + gt[2] * ow[0]);
#ifdef NSA_DEBUG
        P.DBG[((size_t)0 * MP + row) * 768 + kvh * 384 + tid] = oc[0]; P.DBG[((size_t)1 * MP + row) * 768 + kvh * 384 + tid] = os[0]; P.DBG[((size_t)2 * MP + row) * 768 + kvh * 384 + tid] = ow[0];
#endif
    }
    __syncthreads();
}
DI void nsa_pairs(const FP& P, const Ctx& C, bool second) {
    LAS unsigned char* wl = C.lds + C.wave * NSA_WLDS;
    const int per = C.G / 4 > 0 ? C.G / 4 : 1, grp = (C.vcu / per) & 3, sub = C.vcu % per, n = grp >> 1, kvh = grp & 1;
#pragma unroll 1
    for (int pr = sub * NWAVES + C.wave; pr < SEQ / 2; pr += per * NWAVES) { if (second) nsa_pair_b(P, n, kvh, 2 * pr, C.lane, wl); else nsa_pair_a(P, n, kvh, 2 * pr, C.lane, wl); }
}
DI void nsa_phase_a(const FP& P, const Ctx& C) {
    for (int it = C.vcu; it < DEC_BATCH * NSA_KV_HEADS; it += C.G) nsa_sample_item(P, C, it / NSA_KV_HEADS, it % NSA_KV_HEADS);
    nsa_pairs(P, C, false);
    __syncthreads();
}
DI void nsa_phase_b(const FP& P, const Ctx& C) {
    const int lane = C.lane, w = C.wave;
    nsa_pairs(P, C, true);
    __syncthreads();
    { constexpr int NMT = (M0 / 16) * MEM_HEADS;
      for (int it = C.vcu * NWAVES + w; it < NMT; it += C.G * NWAVES) { const int h = it % MEM_HEADS, q16 = it / MEM_HEADS, row0 = q16 * 16, n = row0 / SEQ;
          mem_micro(P, P.MQB + h * 64, 256, row0, 1, n, h, P.ATTB + NSA_Q_COLS + h * 64, 1024, lane); }
      LAS float* qs = (LAS float*)(C.lds + 65536 + w * 256);
      for (int it = C.vcu * NWAVES + w; it < DEC_BATCH * MEM_HEADS; it += C.G * NWAVES) { const int h = it % MEM_HEADS, ns = it / MEM_HEADS, row = M0 + ns;
          Dec D; D.m = -INFINITY; D.l = 0.f; D.o = 0.f; qs[lane] = bf2f(P.MQB[(size_t)row * 256 + h * 64 + lane]); asm volatile("s_waitcnt lgkmcnt(0)" ::: "memory");
          const float* mk = P.cache_mem_kv + ((size_t)1 * DEC_BATCH + ns) * MEM_TOKENS * 512;
          for (int j0 = 0; j0 < MEM_TOKENS; j0 += 64) dec_chunk(D, qs, 64, [&](int j) { return mk + (size_t)(j0 + j) * 512 + h * 64; }, [&](int j) { return mk + (size_t)(j0 + j) * 512 + 256 + h * 64; }, lane);
          P.ATTB[(size_t)row * 1024 + NSA_Q_COLS + h * 64 + lane] = (bf16)f2bf(D.o / D.l); } }
    __syncthreads();
}
}
namespace fx {
enum { PH_PRO = 0, PH_G1, PH_ATTA, PH_G2, PH_LN1, PH_SC0, PH_TK0, PH_PU0, PH_PG0, PH_G3, PH_CMPG, PH_CMP2, PH_NSA, PH_NSB, PH_G4, PH_LN3, PH_SC1, PH_TK1, PH_PU1, PH_PG1, PH_COUNT };
template <class Epi> DI void run_gemm(const Ctx& C, const bf16* A, const bf16* Bt, int M, int N, int K, const Epi& E) {
    pg8::Gemm g{A, Bt, M, N, K}; pg8::StaticOrder S; S.init(M, N, C.G, (int)blockIdx.x);
    pg8::gemm_phase<Epi, pg8::StaticOrder, true, true>(C.lds, g, S, E);
}
template <class Epi> DI void skinny_gemm(const Ctx& C, const bf16* A, const bf16* Bt, int N, int K, const Epi& E) {
    static_assert(DEC_BATCH == 32 && M0 % 256 == 0, "skinny_gemm: 32 sample rows right after a whole number of 256-row tiles");
    const int lane = C.lane, fr = lane & 15, fq = lane >> 4, w = C.wave; const int NI = (N / 256) * 4, KW = K / NWAVES;
    LAS f32x4* red = (LAS f32x4*)C.lds;
#pragma unroll 1
    for (int item = C.vcu; item < NI; item += C.G) { const int pn = item >> 2, wc = item & 3;
        f32x4 pa[2][2][2];
#pragma unroll
        for (int i = 0; i < 8; ++i) (&pa[0][0][0])[i] = (f32x4){0.f, 0.f, 0.f, 0.f};
        const bf16* xa = A + (size_t)(M0 + fr) * K + w * KW + 8 * fq; const bf16* xb = xa + (size_t)16 * K;
        const bf16* wp[2][2];
#pragma unroll
        for (int bj = 0; bj < 2; ++bj)
#pragma unroll
            for (int n = 0; n < 2; ++n) wp[bj][n] = Bt + (size_t)(pn * 256 + bj * 128 + wc * 32 + 8 * (fr >> 2) + 4 * n + (fr & 3)) * K + w * KW + 8 * fq;
#pragma unroll 4
        for (int k0 = 0; k0 < KW; k0 += 32) { const bf16x8 x0 = *(const bf16x8*)(xa + k0), x1 = *(const bf16x8*)(xb + k0);
#pragma unroll
            for (int bj = 0; bj < 2; ++bj)
#pragma unroll
                for (int n = 0; n < 2; ++n) { const bf16x8 wf = *(const bf16x8*)(wp[bj][n] + k0);
                    pa[bj][0][n] = __builtin_amdgcn_mfma_f32_16x16x32_bf16(wf, x0, pa[bj][0][n], 0, 0, 0); pa[bj][1][n] = __builtin_amdgcn_mfma_f32_16x16x32_bf16(wf, x1, pa[bj][1][n], 0, 0, 0); } }
        __syncthreads();
#pragma unroll
        for (int bj = 0; bj < 2; ++bj)
#pragma unroll
            for (int mm = 0; mm < 2; ++mm)
#pragma unroll
                for (int n = 0; n < 2; ++n) red[(w * 8 + bj * 4 + mm * 2 + n) * 64 + lane] = pa[bj][mm][n];
        asm volatile("s_waitcnt lgkmcnt(0)" ::: "memory"); __syncthreads();
        if (w == 0) { f32x4 acc[2][2][4][2];
#pragma unroll
            for (int i = 0; i < 32; ++i) (&acc[0][0][0][0])[i] = (f32x4){0.f, 0.f, 0.f, 0.f};
#pragma unroll
            for (int bj = 0; bj < 2; ++bj)
#pragma unroll
                for (int mm = 0; mm < 2; ++mm)
#pragma unroll
                    for (int n = 0; n < 2; ++n) { f32x4 s = red[(bj * 4 + mm * 2 + n) * 64 + lane];
#pragma unroll 1
                        for (int ww = 1; ww < NWAVES; ++ww) s += red[(ww * 8 + bj * 4 + mm * 2 + n) * 64 + lane];
                        acc[0][bj][mm][n] = s; }
            E(acc, pg8::Unit{M0 / 256, pn}, 0, wc, fr, fq); }
    }
    __syncthreads();
}
__global__ void __launch_bounds__(NTHREADS, 2) mega(Args args) {
    extern __shared__ __attribute__((aligned(16))) unsigned char lds_raw[];
    Ctx C; C.lds = (LAS unsigned char*)lds_raw; C.tid = threadIdx.x; C.lane = C.tid & 63; C.wave = __builtin_amdgcn_readfirstlane(C.tid >> 6);
    C.G = gridDim.x; { const int bx = blockIdx.x; C.vcu = (C.G % 8 == 0) ? (bx % 8) * (C.G / 8) + bx / 8 : bx; }
    const FP& P = args.p;
    volatile LAS unsigned* MISC = (volatile LAS unsigned*)(C.lds + MISC_OFF);
    for (int u = C.tid; u < (LDS_BYTES - RING_BYTES) / 4; u += NTHREADS) ((LAS unsigned*)(C.lds + RING_BYTES))[u] = 0u;
    __syncthreads();
    const int lo = args.lo, hi = args.hi;
    XcdBarrier bar; bar.bar = P.ctl + 1024; bar.x = 0; bar.st = nullptr;
    if (hi - lo > 1) bar = xcd_barrier_post(P.ctl + 1024, MISC + 8);
#define IN(k) (lo <= (k) && (k) < hi)
#define SEAM(k) do { if (IN(k) && IN((k) + 1)) xcd_barrier(bar); } while (0)
#ifndef DUP_PHASE
#define DUP_PHASE -1
#endif
#define PHASE(k, ...) do { if (IN(k)) { __VA_ARGS__ if (DUP_PHASE == (k)) { __syncthreads(); __VA_ARGS__ } } SEAM(k); } while (0)
    PHASE(PH_PRO, p0_prologue(P, C); __syncthreads(); p0_wpk(P, C););
    PHASE(PH_G1, run_gemm(C, P.XB0, P.WA_T, M0, ACOLS, D_MODEL, EpiA{P}); run_gemm(C, P.MEMB, P.WMEM_T, BATCH * MEM_TOKENS, 1024, D_MODEL, EpiMem{P}); skinny_gemm(C, P.XB0, P.WA_T, ACOLS, D_MODEL, EpiA{P}););
    PHASE(PH_ATTA, atta_phase(P, C););
    PHASE(PH_G2, run_gemm(C, P.ATTA, P.WOA_T, M0, D_MODEL, 512, EpiPre{P.x_prompt, P.x_sample, P.PRE}); skinny_gemm(C, P.ATTA, P.WOA_T, D_MODEL, 512, EpiPre{P.x_prompt, P.x_sample, P.PRE}););
    PHASE(PH_LN1, ln_phase(P, C, P.PRE, P.ln_g, P.ln_b, P.X1, P.X1B, nullptr, nullptr););
    PHASE(PH_SC0, run_gemm(C, P.X1B, P.WPK_T, M0, NPK, D_MODEL, EpiF32{P.SCO, NPK, MP}); skinny_gemm(C, P.X1B, P.WPK_T, NPK, D_MODEL, EpiF32{P.SCO, NPK, MP}););
    PHASE(PH_TK0, topk_phase(P, C););
#ifdef PEER_SPLIT
    PHASE(PH_PU0, peer_u_phase(P, C, 0, P.X1B););
    PHASE(PH_PG0, peer_v_phase(P, C, 0, P.X1, P.X2, P.X2 + (size_t)M0 * D_MODEL, P.X2B););
#elif defined(PEER_SHARD2)
    PHASE(PH_PG0, peer_sharded2_phase(P, C, 0, P.X1, P.X1B, P.X2, P.X2B); __syncthreads(); peer_phase(P, C, 0, P.X1, P.X2, P.X2 + (size_t)M0 * D_MODEL, P.X2B););
#elif defined(PEER_SHARD)
    PHASE(PH_PG0, peer_sharded_phase(P, C, 0, P.X1, P.X1B, P.X2, P.X2 + (size_t)M0 * D_MODEL, P.X2B); __syncthreads(); peer_phase(P, C, 0, P.X1, P.X2, P.X2 + (size_t)M0 * D_MODEL, P.X2B););
#else
    PHASE(PH_PG0, peer_phase(P, C, 0, P.X1, P.X2, P.X2 + (size_t)M0 * D_MODEL, P.X2B););
#endif
    PHASE(PH_G3, run_gemm(C, P.X2B, P.WB_T, M0, NB_T, D_MODEL, EpiB{P}); skinny_gemm(C, P.X2B, P.WB_T, NB_T, D_MODEL, EpiB{P}););
    PHASE(PH_CMPG, run_gemm(C, P.AC, P.CW1_T, ACROWS, 256, 1024, EpiF32{P.UL, 256, ACROWS}); run_gemm(C, P.AC + (size_t)ACROWS * 1024, P.CW1_T + 256 * 1024, ACROWS, 256, 1024, EpiF32{P.UL + (size_t)ACROWS * 256, 256, ACROWS}););
    PHASE(PH_CMP2, cmp2_phase(P, C););
    PHASE(PH_NSA, nsa_phase_a(P, C););
    PHASE(PH_NSB, nsa_phase_b(P, C););
    PHASE(PH_G4, run_gemm(C, P.ATTB, P.WOB_T, M0, D_MODEL, 1024, EpiPre{P.X2, nullptr, P.PRE}); skinny_gemm(C, P.ATTB, P.WOB_T, D_MODEL, 1024, EpiPre{P.X2, nullptr, P.PRE}););
    PHASE(PH_LN3, ln_phase(P, C, P.PRE, P.ln_g + 2 * D_MODEL, P.ln_b + 2 * D_MODEL, P.X3, P.X3B, nullptr, nullptr););
    PHASE(PH_SC1, run_gemm(C, P.X3B, P.WPK_T + (size_t)NPK * D_MODEL, M0, NPK, D_MODEL, EpiF32{P.SCO, NPK, MP}); skinny_gemm(C, P.X3B, P.WPK_T + (size_t)NPK * D_MODEL, NPK, D_MODEL, EpiF32{P.SCO, NPK, MP}););
    PHASE(PH_TK1, topk_phase(P, C););
#ifdef PEER_SPLIT
    PHASE(PH_PU1, peer_u_phase(P, C, 1, P.X3B););
    PHASE(PH_PG1, peer_v_phase(P, C, 1, P.X3, P.y_prompt, P.y_sample, nullptr););
#elif defined(PEER_SHARD2)
    PHASE(PH_PG1, peer_sharded2_phase(P, C, 1, P.X3, P.X3B, P.y_prompt, nullptr); __syncthreads(); peer_phase(P, C, 1, P.X3, P.y_prompt, P.y_sample, nullptr););
#elif defined(PEER_SHARD)
    PHASE(PH_PG1, peer_sharded_phase(P, C, 1, P.X3, P.X3B, P.y_prompt, P.y_sample, nullptr); __syncthreads(); peer_phase(P, C, 1, P.X3, P.y_prompt, P.y_sample, nullptr););
#else
    PHASE(PH_PG1, peer_phase(P, C, 1, P.X3, P.y_prompt, P.y_sample, nullptr););
#endif
#undef IN
#undef SEAM
}
}
#ifndef ONE_LAUNCH
#define ONE_LAUNCH 1
#endif
extern "C" void kernel_launch(void* const* d_in, const int* in_sizes, int n_in, void* d_out, int out_size, void* d_ws, size_t ws_size, hipStream_t stream) {
    fx::Args a; memset(&a, 0, sizeof(a)); fx::bind_io(a.p, d_in, (float*)d_out);
    const size_t f_need = fx::carve(a.p, d_ws);
    if (f_need > ws_size) { fprintf(stderr, "kernel_launch: workspace too small: need %zu have %zu\n", f_need, ws_size); return; }
    static int grid = 0;
    if (!grid) { int dev = 0, cus = 0, per_cu = 0; (void)hipGetDevice(&dev); (void)hipDeviceGetAttribute(&cus, hipDeviceAttributeMultiprocessorCount, dev);
        (void)hipFuncSetAttribute((const void*)fx::mega, hipFuncAttributeMaxDynamicSharedMemorySize, fx::LDS_BYTES);
        if (hipOccupancyMaxActiveBlocksPerMultiprocessor(&per_cu, (const void*)fx::mega, fx::NTHREADS, fx::LDS_BYTES) != hipSuccess || per_cu < 1) { fprintf(stderr, "kernel_launch: occupancy query says %d blocks per CU\n", per_cu); (void)hipGetLastError(); }
        grid = cus; }
    (void)hipMemsetAsync(a.p.ctl, 0, fx::CTL_BYTES, stream);
#if ONE_LAUNCH
    a.lo = 0; a.hi = fx::PH_COUNT; hipLaunchKernelGGL(fx::mega, dim3(grid), dim3(fx::NTHREADS), fx::LDS_BYTES, stream, a);
#else
    for (int k = 0; k < fx::PH_COUNT; ++k) { a.lo = k; a.hi = k + 1; hipLaunchKernelGGL(fx::mega, dim3(grid), dim3(fx::NTHREADS), fx::LDS_BYTES, stream, a); }
#endif
}
```

```cpp
#define PEER_SHARD2 1
#define ONE_LAUNCH 1
#include <hip/hip_runtime.h>
#include <cstdio>
#include <cstring>
#include <cmath>
#ifdef CPU_TEST
#define HD inline
constexpr int D_MODEL = 128, BATCH = 2, SEQ = 512, DEPTH = 2, DEC_BATCH = 3, DEC_SEQ = 1, PAST_LEN = 512, PAGE_SIZE = 128;
constexpr int DIL_W[3] = {16, 64, 256}, DIL_D[3] = {1, 4, 16}, DIL_TAPS = 17;
constexpr int MEM_TOKENS = 32, SLC_TOPK = 4, SWA_WINDOW = 64, PEER_KEYS = 16, PEER_TOPK = 4;
#else
#define HD __host__ __device__ __forceinline__
constexpr int D_MODEL = 1024, BATCH = 2, SEQ = 8192, DEPTH = 2, DEC_BATCH = 32, DEC_SEQ = 1, PAST_LEN = 8192, PAGE_SIZE = 128;
constexpr int DIL_W[3] = {128, 512, 2048}, DIL_D[3] = {1, 4, 16}, DIL_TAPS = 129;
constexpr int MEM_TOKENS = 256, SLC_TOPK = 16, SWA_WINDOW = 512, PEER_KEYS = 128, PEER_TOPK = 16;
#endif
HD constexpr int dil_w(int g) { return g == 0 ? DIL_W[0] : (g == 1 ? DIL_W[1] : DIL_W[2]); }
HD constexpr int dil_d(int g) { return g == 0 ? DIL_D[0] : (g == 1 ? DIL_D[1] : DIL_D[2]); }
constexpr int HEAD_DIM = 64, N_A_LAYERS = DEPTH / 2, N_DIL = 3, DIL_HEADS = 4, DIL_COLS = N_DIL * 3 * DIL_HEADS * HEAD_DIM;
constexpr int MEM_HEADS = 4, MEM_COLS = MEM_HEADS * HEAD_DIM;
constexpr int NSA_HEADS = 12, NSA_KV_HEADS = 2, NSA_GROUP = 6, NSA_Q_COLS = NSA_HEADS * HEAD_DIM, NSA_GATE_COLS = NSA_HEADS * 3;
constexpr int CMP_BLOCK = 32, CMP_STRIDE = 16, CMP_HIDDEN = 128, SLC_BLOCK = 64;
constexpr int PEER_EXPERTS = PEER_KEYS * PEER_KEYS, PEER_HEADS = 8, PEER_KEY_DIM = 128;
constexpr float FORCE_SCORE = 1.0e9f, NEG = -1.0e30f, SCALE = 0.125f, LN_EPS = 1e-5f;
constexpr float ALPHA = 1.41421356237309515f;
constexpr float BETA = 0.5f;
#define LAS __attribute__((address_space(3)))
namespace pg8 {
#define PG8_LAS __attribute__((address_space(3)))
typedef unsigned short bf16_t;
typedef short bf16x8 __attribute__((ext_vector_type(8)));
typedef float f32x4 __attribute__((ext_vector_type(4)));
typedef unsigned u32x4 __attribute__((ext_vector_type(4)));
constexpr int BM = 256, BK = 64, HALF = 128, HTB = HALF * BK * 2  , STAGE_BYTES = 8 * HTB, NXCD = 8, WGM = 8;

__host__ __device__ __forceinline__ int lds_byte(int r, int c) { const int st = (r >> 4) * 2 + (c >> 5), rr = r & 15, cc = c & 31, ob = rr * 64 + cc * 2; return st * 1024 + (ob ^ (((ob >> 9) & 1) << 5)); }
__host__ __device__ __forceinline__ void stage_rc(int b, int& R, int& C) { const int st = b / 1024, sb = b % 1024, swz = sb ^ (((sb >> 9) & 1) << 5); R = (st >> 1) * 16 + swz / 64; C = (st & 1) * 32 + (swz % 64) / 2; }
__host__ __device__ __forceinline__ int perm32(int rho) { const int n = rho >> 4, i = rho & 15; return 8 * (i >> 2) + 4 * n + (i & 3); }

struct Unit { int pm, pn; };
struct Gemm { const bf16_t* A; const bf16_t* Bt; int M, N, K; };

struct StaticOrder {
    int nM, nN, nwg, G, c;
    __host__ __device__ void init(int M, int N, int G_, int c_) { nM = M / BM; nN = N / BM; nwg = nM * nN; G = G_; c = c_; }
    __host__ __device__ bool next(int i, Unit& u) const {
        const long L = (long)i * G + c; if (L >= nwg) return false;
        int wgid = (int)L; { const int q = nwg / NXCD, r = nwg % NXCD, xcd = wgid % NXCD, off = wgid / NXCD; wgid = (xcd < r ? xcd * (q + 1) : r * (q + 1) + (xcd - r) * q) + off; }
        const int nig = WGM * nN, gid = wgid / nig, fm = gid * WGM, gsz = (nM - fm) < WGM ? (nM - fm) : WGM;
        u.pm = fm + ((wgid % nig) % gsz); u.pn = (wgid % nig) / gsz; return true;
    }
    __device__ __forceinline__ void a_ready(const Unit&) const {}
    __device__ __forceinline__ void done(const Unit&) const {}
};

__device__ __forceinline__ unsigned cvt_pk_bf16(float lo, float hi) { unsigned r; asm volatile("v_cvt_pk_bf16_f32 %0, %1, %2" : "=v"(r) : "v"(lo), "v"(hi)); return r; }
typedef float f32x2 __attribute__((ext_vector_type(2)));
typedef float f32x2 __attribute__((ext_vector_type(2)));
template <class Epi, class Sched, bool ALIGN_EPI = false, bool SP2 = false>
__device__ __forceinline__ void gemm_phase(PG8_LAS unsigned char* lds, const Gemm g, const Sched& S, const Epi& E) {
    const int tid = threadIdx.x, wid = __builtin_amdgcn_readfirstlane(tid >> 6), lane = tid & 63, wr = wid >> 2, wc = wid & 3, fr = lane & 15, fq = lane >> 4;
    const int K = g.K, nt = K / BK;
    unsigned voffA[2], voffB[2];
#pragma unroll
    for (int i = 0; i < 2; ++i) { int R, C; stage_rc(tid * 16 + i * 8192, R, C); const int Rb = Epi::PERM ? ((R & ~31) + perm32(R & 31)) : R;
        voffA[i] = (unsigned)(R * K + C) * 2u; voffB[i] = (unsigned)(Rb * K + C) * 2u; }
    const size_t kstep = (size_t)(BK * 2);
    const size_t hstep = (size_t)HALF * K * 2;
    const size_t tstep = 2 * hstep;
    const unsigned ldsw = (unsigned)wid * 1024u;
    const int aoff = lds_byte(wr * 64 + fr, fq * 8), boff = lds_byte(wc * 32 + fr, fq * 8);
#define PG8_SA(b, h) (((b) * 2 + (h)) * HTB)
#define PG8_SB(b, h) ((4 + (b) * 2 + (h)) * HTB)
#define PG8_STAGE(bufoff, gbase, voff) do { _Pragma("unroll") for (int _i = 0; _i < 2; ++_i) \
        __builtin_amdgcn_global_load_lds((const unsigned*)((const char*)(gbase) + (voff)[_i]), (PG8_LAS unsigned*)(lds + (bufoff) + ldsw + _i * 8192), 16, 0, 0); } while (0)
#define PG8_LDA(dst, b, h) do { _Pragma("unroll") for (int m = 0; m < 4; ++m) _Pragma("unroll") for (int k = 0; k < 2; ++k) dst[m][k] = *(const PG8_LAS bf16x8*)(lds + PG8_SA(b, h) + aoff + m * 2048 + k * 1024); } while (0)
#define PG8_LDB(dst, b, h) do { _Pragma("unroll") for (int n = 0; n < 2; ++n) _Pragma("unroll") for (int k = 0; k < 2; ++k) dst[n][k] = *(const PG8_LAS bf16x8*)(lds + PG8_SB(b, h) + boff + n * 2048 + k * 1024); } while (0)
#define PG8_MMA(ai, bj, At, Bt) do { __builtin_amdgcn_s_setprio(1); _Pragma("unroll") for (int m = 0; m < 4; ++m) _Pragma("unroll") for (int n = 0; n < 2; ++n) _Pragma("unroll") for (int k = 0; k < 2; ++k) \
        acc[ai][bj][m][n] = __builtin_amdgcn_mfma_f32_16x16x32_bf16(Bt[n][k], At[m][k], acc[ai][bj][m][n], 0, 0, 0); __builtin_amdgcn_s_setprio(0); } while (0)
#define PG8_WAIT_V(n) asm volatile("s_waitcnt vmcnt(" #n ")" ::: "memory")
#define PG8_WAIT_L(n) asm volatile("s_waitcnt lgkmcnt(" #n ")" ::: "memory")
#define PG8_BAR __builtin_amdgcn_s_barrier()
#define PG8_SCHED __builtin_amdgcn_sched_barrier(0)
    Unit cur, nxt; int ui = 0;
    if (!S.next(0, cur)) return;
    f32x4 acc[2][2][4][2];
#pragma unroll
    for (int a = 0; a < 2; ++a)
#pragma unroll
        for (int b = 0; b < 2; ++b)
#pragma unroll
            for (int m = 0; m < 4; ++m)
#pragma unroll
                for (int n = 0; n < 2; ++n) acc[a][b][m][n] = (f32x4){0.f, 0.f, 0.f, 0.f};
    bf16x8 At[4][2], B0[2][2], B1[2][2];
    const char* cA = (const char*)g.A + (size_t)cur.pm * tstep; const char* cB = (const char*)g.Bt + (size_t)cur.pn * tstep;
    S.a_ready(cur);
    if constexpr (SP2) {
        PG8_STAGE(PG8_SB(0, 0), cB, voffB); PG8_STAGE(PG8_SB(0, 1), cB + hstep, voffB); PG8_STAGE(PG8_SA(0, 0), cA, voffA); PG8_STAGE(PG8_SA(0, 1), cA + hstep, voffA);
        if (wr == 1) PG8_BAR;
        PG8_WAIT_V(2); PG8_BAR;
        PG8_STAGE(PG8_SB(1, 0), cB + kstep, voffB); PG8_STAGE(PG8_SA(1, 0), cA + kstep, voffA); PG8_STAGE(PG8_SB(1, 1), cB + hstep + kstep, voffB);
        PG8_WAIT_V(6); PG8_BAR;
    } else {
        PG8_STAGE(PG8_SB(0, 0), cB, voffB); PG8_STAGE(PG8_SA(0, 0), cA, voffA); PG8_STAGE(PG8_SB(0, 1), cB + hstep, voffB); PG8_STAGE(PG8_SA(0, 1), cA + hstep, voffA);
        if (wr == 1) PG8_BAR;
        PG8_WAIT_V(4); PG8_BAR;
        PG8_STAGE(PG8_SB(1, 0), cB + kstep, voffB); PG8_STAGE(PG8_SA(1, 0), cA + kstep, voffA); PG8_STAGE(PG8_SB(1, 1), cB + hstep + kstep, voffB);
        PG8_WAIT_V(6); PG8_BAR;
    }
    for (;;) {
        const bool has_next = S.next(ui + 1, nxt);
        const char* nA = has_next ? (const char*)g.A + (size_t)nxt.pm * tstep : cA; const char* nB = has_next ? (const char*)g.Bt + (size_t)nxt.pn * tstep : cB;
        for (int t = 0; t < nt; t += 2) {
            const bool last = (t == nt - 2);
            const char* a1 = cA + (size_t)(t + 1) * kstep;
            const char* a2 = last ? nA : cA + (size_t)(t + 2) * kstep; const char* b2 = last ? nB : cB + (size_t)(t + 2) * kstep;
            const char* a3 = a2 + kstep; const char* b3 = b2 + kstep;
            if (last && has_next) S.a_ready(nxt);
            if constexpr (SP2) {
            PG8_LDB(B0, 0, 0); PG8_LDB(B1, 0, 1); PG8_SCHED; PG8_LDA(At, 0, 0); PG8_STAGE(PG8_SA(1, 1), a1 + hstep, voffA);
            PG8_WAIT_V(8); PG8_WAIT_L(0); PG8_BAR; PG8_MMA(0, 0, At, B0); PG8_MMA(0, 1, At, B1); PG8_BAR; PG8_SCHED;
            PG8_LDA(At, 0, 1); PG8_STAGE(PG8_SB(0, 0), b2, voffB); PG8_STAGE(PG8_SB(0, 1), b2 + hstep, voffB); PG8_STAGE(PG8_SA(0, 0), a2, voffA);
            PG8_WAIT_V(8); PG8_WAIT_L(0); PG8_BAR; PG8_MMA(1, 0, At, B0); PG8_MMA(1, 1, At, B1); PG8_BAR; PG8_SCHED;
            PG8_LDB(B0, 1, 0); PG8_LDB(B1, 1, 1); PG8_SCHED; PG8_LDA(At, 1, 0); PG8_STAGE(PG8_SA(0, 1), a2 + hstep, voffA);
            PG8_WAIT_V(8); PG8_WAIT_L(0); PG8_BAR; PG8_MMA(0, 0, At, B0); PG8_MMA(0, 1, At, B1); PG8_BAR; PG8_SCHED;
            PG8_LDA(At, 1, 1); PG8_STAGE(PG8_SB(1, 0), b3, voffB); PG8_STAGE(PG8_SB(1, 1), b3 + hstep, voffB); PG8_STAGE(PG8_SA(1, 0), a3, voffA);
            PG8_WAIT_V(8); PG8_WAIT_L(0); PG8_BAR; PG8_MMA(1, 0, At, B0); PG8_MMA(1, 1, At, B1); PG8_BAR; PG8_SCHED;
            } else {
            PG8_LDB(B0, 0, 0); PG8_SCHED; PG8_LDA(At, 0, 0); PG8_STAGE(PG8_SA(1, 1), a1 + hstep, voffA);
            PG8_WAIT_L(8); PG8_BAR; PG8_WAIT_L(0); PG8_MMA(0, 0, At, B0); PG8_BAR; PG8_SCHED;
            PG8_LDB(B1, 0, 1); PG8_STAGE(PG8_SB(0, 0), b2, voffB);
            PG8_BAR; PG8_WAIT_L(0); PG8_MMA(0, 1, At, B1); PG8_BAR;
            PG8_LDA(At, 0, 1); PG8_STAGE(PG8_SA(0, 0), a2, voffA);
            PG8_BAR; PG8_WAIT_L(0); PG8_MMA(1, 0, At, B0); PG8_BAR; PG8_SCHED;
            PG8_STAGE(PG8_SB(0, 1), b2 + hstep, voffB);
            PG8_WAIT_V(6); PG8_BAR; PG8_MMA(1, 1, At, B1); PG8_BAR;
            PG8_LDB(B0, 1, 0); PG8_SCHED; PG8_LDA(At, 1, 0); PG8_STAGE(PG8_SA(0, 1), a2 + hstep, voffA);
            PG8_WAIT_L(8); PG8_BAR; PG8_WAIT_L(0); PG8_MMA(0, 0, At, B0); PG8_BAR; PG8_SCHED;
            PG8_LDB(B1, 1, 1); PG8_STAGE(PG8_SB(1, 0), b3, voffB);
            PG8_BAR; PG8_WAIT_L(0); PG8_MMA(0, 1, At, B1); PG8_BAR;
            PG8_LDA(At, 1, 1); PG8_STAGE(PG8_SA(1, 0), a3, voffA);
            PG8_BAR; PG8_WAIT_L(0); PG8_MMA(1, 0, At, B0); PG8_BAR; PG8_SCHED;
            PG8_STAGE(PG8_SB(1, 1), b3 + hstep, voffB);
            PG8_WAIT_V(6); PG8_BAR; PG8_MMA(1, 1, At, B1); PG8_BAR;
            }
        }
        if constexpr (ALIGN_EPI) { if (wr == 0) PG8_BAR; }
        if constexpr (!Epi::AFTER_DRAIN) { E(acc, cur, wr, wc, fr, fq); S.done(cur); }
        if (!has_next) break;
#pragma unroll
        for (int a = 0; a < 2; ++a)
#pragma unroll
            for (int b = 0; b < 2; ++b)
#pragma unroll
                for (int m = 0; m < 4; ++m)
#pragma unroll
                    for (int n = 0; n < 2; ++n) acc[a][b][m][n] = (f32x4){0.f, 0.f, 0.f, 0.f};
        cur = nxt; cA = nA; cB = nB; ++ui;
        if constexpr (ALIGN_EPI) { if (wr == 1) PG8_BAR; }
    }
    PG8_WAIT_V(0);
    if constexpr (!ALIGN_EPI) { if (wr == 0) PG8_BAR; }
    PG8_BAR;
    if constexpr (Epi::AFTER_DRAIN) { E.fused(acc, cur, wr, wc, fr, fq, lds, wid, lane); S.done(cur); }
#undef PG8_SA
#undef PG8_SB
#undef PG8_STAGE
#undef PG8_LDA
#undef PG8_LDB
#undef PG8_MMA
#undef PG8_WAIT_V
#undef PG8_WAIT_L
#undef PG8_BAR
#undef PG8_SCHED
}
}
#define XB_TMO      128
#define XB_XCNT(j)  (256  + 64 * (j))
#define XB_XSUB(j)  (1280 + 64 * (j))
#define XB_XGEN(j)  (2304 + 64 * (j))
#define XB_TOP      3328
#define XB_TOPGEN   3392
#define XCD_BAR_WORDS 3456
#define XB_SPIN_CAP (1u << 18)

__device__ __forceinline__ unsigned xb_ld(unsigned* p)              { return __hip_atomic_load(p, __ATOMIC_RELAXED, __HIP_MEMORY_SCOPE_AGENT); }
__device__ __forceinline__ unsigned xb_add(unsigned* p, unsigned v) { return __hip_atomic_fetch_add(p, v, __ATOMIC_RELAXED, __HIP_MEMORY_SCOPE_AGENT); }
__device__ __forceinline__ unsigned xb_xcc_id() { return (unsigned)__builtin_amdgcn_s_getreg((3 << 11) | 20) & 0xFu; }
#define XB_SPIN(cond, bar) do { unsigned _sp = 0; while (cond) { __builtin_amdgcn_s_sleep(1); \
    if ((++_sp & 255u) == 0u) { if (xb_ld(&(bar)[XB_TMO])) break; if (_sp > XB_SPIN_CAP) { atomicAdd(&(bar)[XB_TMO], 1u); break; } } } } while (0)

struct XcdBarrier {
    unsigned* bar; unsigned x;
    volatile LAS unsigned* st;
};

__device__ __forceinline__ XcdBarrier xcd_barrier_post(unsigned* bar, volatile LAS unsigned* st) {
    XcdBarrier b; b.bar = bar; b.x = xb_xcc_id(); b.st = st;
    if (threadIdx.x == 0) (void)xb_add(&bar[XB_XCNT(b.x)], 1u);
    return b;
}
__device__ __forceinline__ void xcd_barrier_complete(unsigned* bar, unsigned x, unsigned& nloc, unsigned& nx) {
    const unsigned G = gridDim.x * gridDim.y * gridDim.z;
    unsigned sum, cnt, mine, sp = 0u;
    for (;;) {
        sum = 0u; cnt = 0u; mine = 0u;
#pragma unroll
        for (unsigned j = 0; j < 16; ++j) { const unsigned c = xb_ld(&bar[XB_XCNT(j)]); sum += c; cnt += (c > 0u) ? 1u : 0u; mine = (j == x) ? c : mine; }
        if (sum == G) break;
        __builtin_amdgcn_s_sleep(1);
        if ((++sp & 255u) == 0u) { if (xb_ld(&bar[XB_TMO])) break; if (sp > XB_SPIN_CAP) { atomicAdd(&bar[XB_TMO], 1u); break; } }
    }
    nloc = mine > 0u ? mine : 1u; nx = cnt > 0u ? cnt : 1u;
}

__device__ __forceinline__ void xcd_barrier(const XcdBarrier& b) {
    asm volatile("s_waitcnt vmcnt(0)" ::: "memory");
    __syncthreads();
    if (threadIdx.x == 0) {
        unsigned* bar = b.bar;
        __builtin_amdgcn_s_waitcnt(0);
        unsigned nloc = b.st[0], nx = b.st[1];
        if (nloc == 0u) { xcd_barrier_complete(bar, b.x, nloc, nx); b.st[0] = nloc; b.st[1] = nx; }
        const unsigned old = xb_add(&bar[XB_XSUB(b.x)], 1u);
        const unsigned gen = old / nloc;
        if (old + 1u == (gen + 1u) * nloc) {
            __builtin_amdgcn_fence(__ATOMIC_RELEASE, "agent");
            asm volatile("s_waitcnt vmcnt(0)" ::: "memory");
            const unsigned og = xb_add(&bar[XB_TOP], 1u);
            const unsigned tg = og / nx;
            if (og + 1u == (tg + 1u) * nx) xb_add(&bar[XB_TOPGEN], 1u);
            else XB_SPIN(xb_ld(&bar[XB_TOPGEN]) == tg, bar);
            __builtin_amdgcn_fence(__ATOMIC_ACQUIRE, "agent");
            xb_add(&bar[XB_XGEN(b.x)], 1u);
            asm volatile("s_waitcnt vmcnt(0)" ::: "memory");
        } else {
            XB_SPIN(xb_ld(&bar[XB_XGEN(b.x)]) == gen, bar);
            __builtin_amdgcn_fence(__ATOMIC_ACQUIRE, "agent");
            asm volatile("s_waitcnt vmcnt(0)" ::: "memory");
        }
    }
    __syncthreads();
}
namespace fx {
#define DI __device__ __forceinline__
typedef unsigned short bf16;
typedef short bf16x8 __attribute__((ext_vector_type(8)));
typedef float f32x4 __attribute__((ext_vector_type(4)));
typedef float f32x2 __attribute__((ext_vector_type(2)));
typedef unsigned u32x4 __attribute__((ext_vector_type(4)));
typedef unsigned u32x2 __attribute__((ext_vector_type(2)));
constexpr int M0 = BATCH * SEQ, MP = M0 + DEC_BATCH, MPAD = ((MP + 255) / 256) * 256;
constexpr int ACOLS = DIL_COLS + MEM_COLS, BCOLS = NSA_Q_COLS + NSA_GATE_COLS + MEM_COLS, KVCOLS = 6 * NSA_KV_HEADS * HEAD_DIM;
constexpr int NB_T = 2048;
constexpr int NPK = PEER_HEADS * 2 * PEER_KEYS;
constexpr int NCMP = (SEQ - CMP_BLOCK) / CMP_STRIDE + 1;
constexpr int NCH = SEQ / CMP_STRIDE;
constexpr int NCTX = BATCH + DEC_BATCH;
constexpr int ACROWS = NCTX * NSA_KV_HEADS * NCH;
constexpr int NPOS = PAST_LEN + 1;
constexpr float QSCALE = 0.125f * 1.4426950408889634f;
constexpr int NTHREADS = 512, NWAVES = 8, LDS_BYTES = 147456, RING_BYTES = 131072, MISC_OFF = RING_BYTES + 320;

struct FP {
    const float *x_prompt, *x_sample, *mem_prompt, *cache_dil[3], *cache_nsa_kv, *cache_nsa_win, *cache_mem_kv; const int* page_table;
    const float *w_in_a, *w_out_a, *w_in_b, *w_out_b, *w_mem_kv, *w_kv_b, *cmp_pe, *cmp_w1, *cmp_w2, *ln_g, *ln_b, *peer_wq, *peer_keys, *peer_u, *peer_v;
    float *y_prompt, *y_sample, *dil_p[3], *dil_s[3], *nsa_kv_p, *nsa_kv_s, *win_p, *win_s, *mem_kv_p;
    unsigned* ctl;
    bf16 *XB0, *X1B, *X2B, *X3B, *WA_T, *WMEM_T, *MEMB, *WOA_T, *WOB_T, *WPK_T, *WB_T, *CW1_T, *AC; unsigned char *UB8, *VB8;
    float *ROPE, *CBIAS;
    bf16 *QA, *KA, *VTA, *MQA, *MK, *MVT, *ATTA;
    float *DPART, *DML, *PRE, *X1, *X2, *X3, *SCO, *SELG; int* SELE;
    bf16 *SLK, *SLVT, *WNK, *WNVT, *QB, *MQB, *CK, *CVT, *ATTB;
    float *GATES, *UL, *CKF, *CVF;
    int* SELB;
    float* DBG;
};
struct Args { FP p; int lo, hi; };
struct Carve { size_t off = 0; template <class T> T* take(void* base, size_t n) { T* r = (T*)((char*)base + off); off += ((n * sizeof(T) + 255) / 256) * 256; return r; } };
constexpr size_t CTL_BYTES = 65536;
inline size_t carve(FP& p, void* base) {
    Carve c;
    p.ctl = c.take<unsigned>(base, CTL_BYTES / 4);
    p.XB0 = c.take<bf16>(base, (size_t)MPAD * D_MODEL); p.X1B = c.take<bf16>(base, (size_t)MPAD * D_MODEL); p.X2B = c.take<bf16>(base, (size_t)MPAD * D_MODEL); p.X3B = c.take<bf16>(base, (size_t)MPAD * D_MODEL);
    p.WA_T = c.take<bf16>(base, (size_t)ACOLS * D_MODEL); p.WMEM_T = c.take<bf16>(base, (size_t)DEPTH * 2 * MEM_COLS * D_MODEL); p.MEMB = c.take<bf16>(base, (size_t)BATCH * MEM_TOKENS * D_MODEL);
    p.WOA_T = c.take<bf16>(base, (size_t)D_MODEL * 2 * MEM_COLS); p.WOB_T = c.take<bf16>(base, (size_t)D_MODEL * (NSA_Q_COLS + MEM_COLS));
    p.WPK_T = c.take<bf16>(base, (size_t)DEPTH * NPK * D_MODEL); p.WB_T = c.take<bf16>(base, (size_t)NB_T * D_MODEL);
    p.UB8 = c.take<unsigned char>(base, (size_t)DEPTH * PEER_EXPERTS * D_MODEL); p.VB8 = c.take<unsigned char>(base, (size_t)DEPTH * PEER_EXPERTS * D_MODEL);
    p.CW1_T = c.take<bf16>(base, (size_t)2 * 256 * 1024); p.AC = c.take<bf16>(base, (size_t)2 * ACROWS * 1024);
    p.ROPE = c.take<float>(base, (size_t)NPOS * 64); p.CBIAS = c.take<float>(base, 2 * CMP_HIDDEN);
    p.QA = c.take<bf16>(base, (size_t)3 * MPAD * 256); p.KA = c.take<bf16>(base, (size_t)3 * MPAD * 256); p.VTA = c.take<bf16>(base, (size_t)3 * BATCH * DIL_HEADS * HEAD_DIM * SEQ + 4096);
    p.MQA = c.take<bf16>(base, (size_t)MPAD * 256); p.MK = c.take<bf16>(base, (size_t)DEPTH * BATCH * MEM_TOKENS * MEM_COLS); p.MVT = c.take<bf16>(base, (size_t)DEPTH * BATCH * MEM_COLS * MEM_TOKENS);
    p.ATTA = c.take<bf16>(base, (size_t)MPAD * 2 * MEM_COLS);
    p.DPART = c.take<float>(base, (size_t)3 * MP * DIL_HEADS * HEAD_DIM); p.DML = c.take<float>(base, (size_t)3 * MP * DIL_HEADS * 2);
    p.PRE = c.take<float>(base, (size_t)MPAD * D_MODEL); p.X1 = c.take<float>(base, (size_t)MPAD * D_MODEL); p.X2 = c.take<float>(base, (size_t)MPAD * D_MODEL); p.X3 = c.take<float>(base, (size_t)MPAD * D_MODEL);
    p.SCO = c.take<float>(base, (size_t)MPAD * NPK); p.SELG = c.take<float>(base, (size_t)MP * 128); p.SELE = c.take<int>(base, (size_t)MP * 128);
    p.SLK = c.take<bf16>(base, (size_t)BATCH * NSA_KV_HEADS * SEQ * HEAD_DIM); p.SLVT = c.take<bf16>(base, (size_t)BATCH * NSA_KV_HEADS * SEQ * HEAD_DIM);
    p.WNK = c.take<bf16>(base, (size_t)BATCH * NSA_KV_HEADS * SEQ * HEAD_DIM + 4096); p.WNVT = c.take<bf16>(base, (size_t)BATCH * NSA_KV_HEADS * SEQ * HEAD_DIM + 4096);
    p.QB = c.take<bf16>(base, (size_t)MPAD * NSA_Q_COLS); p.MQB = c.take<bf16>(base, (size_t)MPAD * 256);
    p.CK = c.take<bf16>(base, (size_t)NCTX * NSA_KV_HEADS * NCH * HEAD_DIM); p.CVT = c.take<bf16>(base, (size_t)NCTX * NSA_KV_HEADS * HEAD_DIM * NCH); p.ATTB = c.take<bf16>(base, (size_t)MPAD * (NSA_Q_COLS + MEM_COLS));
    p.GATES = c.take<float>(base, (size_t)MPAD * 64); p.UL = c.take<float>(base, (size_t)2 * ACROWS * 256);
    p.CKF = c.take<float>(base, (size_t)DEC_BATCH * NSA_KV_HEADS * NCH * HEAD_DIM); p.CVF = c.take<float>(base, (size_t)DEC_BATCH * NSA_KV_HEADS * NCH * HEAD_DIM);
    p.SELB = c.take<int>(base, (size_t)MP * NSA_KV_HEADS * 16);
#ifdef NSA_DEBUG
    p.DBG = c.take<float>(base, (size_t)3 * MP * 768);
#else
    p.DBG = nullptr;
#endif
    return c.off;
}
inline void bind_io(FP& p, void* const* d_in, float* out) {
    p.x_prompt = (const float*)d_in[0]; p.x_sample = (const float*)d_in[1]; p.mem_prompt = (const float*)d_in[2]; p.cache_dil[0] = (const float*)d_in[3]; p.cache_dil[1] = (const float*)d_in[4]; p.cache_dil[2] = (const float*)d_in[5];
    p.cache_nsa_kv = (const float*)d_in[6]; p.cache_nsa_win = (const float*)d_in[7]; p.cache_mem_kv = (const float*)d_in[8]; p.page_table = (const int*)d_in[9];
    p.w_in_a = (const float*)d_in[10]; p.w_out_a = (const float*)d_in[11]; p.w_in_b = (const float*)d_in[12]; p.w_out_b = (const float*)d_in[13]; p.w_mem_kv = (const float*)d_in[14]; p.w_kv_b = (const float*)d_in[15];
    p.cmp_pe = (const float*)d_in[16]; p.cmp_w1 = (const float*)d_in[17]; p.cmp_w2 = (const float*)d_in[18]; p.ln_g = (const float*)d_in[19]; p.ln_b = (const float*)d_in[20];
    p.peer_wq = (const float*)d_in[21]; p.peer_keys = (const float*)d_in[22]; p.peer_u = (const float*)d_in[23]; p.peer_v = (const float*)d_in[24];
    size_t o = 0; auto take = [&](size_t n) { float* r = out + o; o += n; return r; };
    p.y_prompt = take((size_t)M0 * D_MODEL); p.y_sample = take((size_t)DEC_BATCH * D_MODEL);
    for (int g = 0; g < 3; ++g) p.dil_p[g] = take((size_t)BATCH * DIL_W[g] * 2 * DIL_HEADS * HEAD_DIM);
    for (int g = 0; g < 3; ++g) p.dil_s[g] = take((size_t)DEC_BATCH * DIL_W[g] * 2 * DIL_HEADS * HEAD_DIM);
    p.nsa_kv_p = take((size_t)M0 * 4 * NSA_KV_HEADS * HEAD_DIM); p.nsa_kv_s = take((size_t)DEC_BATCH * 4 * NSA_KV_HEADS * HEAD_DIM);
    p.win_p = take((size_t)BATCH * SWA_WINDOW * 2 * NSA_KV_HEADS * HEAD_DIM); p.win_s = take((size_t)DEC_BATCH * SWA_WINDOW * 2 * NSA_KV_HEADS * HEAD_DIM);
    p.mem_kv_p = take((size_t)DEPTH * BATCH * MEM_TOKENS * 2 * MEM_COLS);
}
DI unsigned f2bf(float f) { unsigned u = __builtin_bit_cast(unsigned, f); return (u + 0x7fffu + ((u >> 16) & 1u)) >> 16; }
DI unsigned pk2(float lo, float hi) { return f2bf(lo) | (f2bf(hi) << 16); }
DI float bf2f(unsigned short b) { return __builtin_bit_cast(float, (unsigned)b << 16); }
DI float bflo(unsigned w) { return __builtin_bit_cast(float, w << 16); }
DI float bfhi(unsigned w) { return __builtin_bit_cast(float, w & 0xffff0000u); }
DI float wave_sum(float v) {
#pragma unroll
    for (int o = 1; o < 64; o <<= 1) v += __shfl_xor(v, o);
    return v; }
DI float wave_max(float v) {
#pragma unroll
    for (int o = 1; o < 64; o <<= 1) v = fmaxf(v, __shfl_xor(v, o));
    return v; }
DI float gelu_tanh(float x) { const float u = 0.7978845608028654f * (x + 0.044715f * x * x * x); const float e = __builtin_amdgcn_exp2f(u * 2.885390081777927f);   const float t = 1.0f - 2.0f / (e + 1.0f); return 0.5f * x * (1.0f + t); }
DI float* sel3(float* const (&a)[3], int g) { return g == 0 ? a[0] : (g == 1 ? a[1] : a[2]); }
DI const float* sel3c(const float* const (&a)[3], int g) { return g == 0 ? a[0] : (g == 1 ? a[1] : a[2]); }
__host__ DI size_t ktile_off(int t, int d) { const int blk = t >> 5, kk = t & 31, b = (kk >> 2) & 1, i = 4 * (kk >> 3) + (kk & 3), s = d >> 5, c = (d & 31) >> 3; return ((size_t)(blk * 4 + 2 * b + s) * 64 + i + 16 * c) * 8 + (d & 7); }
__host__ DI size_t vtile_off(int dim, int t) { const int blk = t >> 5, kk = t & 31; return ((size_t)(blk * 4 + (dim >> 4)) * 64 + (dim & 15) + 16 * (kk >> 3)) * 8 + (kk & 7); }
struct Ctx { LAS unsigned char* lds; int tid, lane, wave, vcu, G; };
DI int row_pos(int r) { return r < M0 ? (r & (SEQ - 1)) : PAST_LEN; }

struct ColSrc { const float* p; int ld; };
DI int rope_il(int e) { return (e >> 1) + 32 * (e & 1); }
DI ColSrc col_wa(const FP& P, int n) {
    const int t = n >> 8, ct = n & 255, h = ct >> 6, e = ct & 63; if (t >= 9) return ColSrc{P.w_in_a + DIL_COLS + ct, ACOLS};
    const int j = t % 3, d = (j < 2) ? rope_il(e) : e; return ColSrc{P.w_in_a + t * 256 + h * 64 + d, ACOLS}; }
DI ColSrc col_wb(const FP& P, int n) {
    const int t = n >> 8, ct = n & 255, e = ct & 63;
    if (t < 3) { const int ty = 2 * t + (ct >> 7), kvh = (ct >> 6) & 1; const bool rot = (ty == 2 || ty == 4); return ColSrc{P.w_kv_b + (ty * NSA_KV_HEADS + kvh) * 64 + (rot ? rope_il(e) : e), KVCOLS}; }
    if (t < 6) { const int h = (t - 3) * 4 + (ct >> 6); return ColSrc{P.w_in_b + h * 64 + rope_il(e), BCOLS}; }
    if (t == 6) return ColSrc{P.w_in_b + NSA_Q_COLS + NSA_GATE_COLS + ct, BCOLS};
    if (ct < NSA_GATE_COLS) return ColSrc{P.w_in_b + NSA_Q_COLS + ct, BCOLS};
    return ColSrc{nullptr, 0}; }
DI ColSrc col_wmem(const FP& P, int n) { const int l = n >> 9, c = n & 511; return ColSrc{P.w_mem_kv + (size_t)l * D_MODEL * 512 + c, 512}; }
DI ColSrc col_woa(const FP& P, int n) { return ColSrc{P.w_out_a + n, D_MODEL}; }
DI ColSrc col_wob(const FP& P, int n) { return ColSrc{P.w_out_b + n, D_MODEL}; }
DI ColSrc col_cw1(const FP& P, int n) {
    const int ty = n >> 8, half = (n >> 7) & 1, hid = n & 127; return ColSrc{P.cmp_w1 + (size_t)ty * CMP_BLOCK * HEAD_DIM * CMP_HIDDEN + (size_t)half * 16 * HEAD_DIM * CMP_HIDDEN + hid, CMP_HIDDEN}; }
template <class CF> DI void transpose_item(const FP& P, CF cf, int K, bf16* WT, LAS float* scr, int item, int nblk, int lane) {
    const int kb = item / nblk, nb = item % nblk, k0 = 64 * kb, n0 = 32 * nb;
    const ColSrc cs = cf(P, n0 + (lane & 31));
#pragma unroll 8
    for (int i = 0; i < 32; ++i) { const int kk = 2 * i + (lane >> 5); scr[kk * 33 + (lane & 31)] = cs.p ? cs.p[(size_t)(k0 + kk) * cs.ld] : 0.f; }
    asm volatile("s_waitcnt lgkmcnt(0)" ::: "memory");
    const int c = lane & 7;
#pragma unroll
    for (int j = 0; j < 4; ++j) { const int n = (lane >> 3) + 8 * j; const LAS float* s = scr + (8 * c) * 33 + n;
        u32x4 o; o.x = pk2(s[0 * 33], s[1 * 33]); o.y = pk2(s[2 * 33], s[3 * 33]); o.z = pk2(s[4 * 33], s[5 * 33]); o.w = pk2(s[6 * 33], s[7 * 33]);
        *(u32x4*)(WT + (size_t)(n0 + n) * K + k0 + 8 * c) = o; }
    asm volatile("s_waitcnt lgkmcnt(0)" ::: "memory");
}
DI void cvt_row1024(const float* src, bf16* dst, int lane) {
#pragma unroll
    for (int j = 0; j < 4; ++j) { f32x4 v = src ? *(const f32x4*)(src + 256 * j + 4 * lane) : (f32x4){0.f, 0.f, 0.f, 0.f}; u32x2 o; o.x = pk2(v.x, v.y); o.y = pk2(v.z, v.w); *(u32x2*)(dst + 256 * j + 4 * lane) = o; }
}
DI void cvt_row1024_fp8(const float* src, unsigned char* dst, float sc, int lane) { u32x4 o; unsigned w[4];
#pragma unroll
    for (int j = 0; j < 4; ++j) { const f32x4 v = *(const f32x4*)(src + 16 * lane + 4 * j) * sc; int t = __builtin_amdgcn_cvt_pk_fp8_f32(v.x, v.y, 0, false); t = __builtin_amdgcn_cvt_pk_fp8_f32(v.z, v.w, t, true); w[j] = (unsigned)t; }
    o.x = w[0]; o.y = w[1]; o.z = w[2]; o.w = w[3]; *(u32x4*)(dst + 16 * lane) = o; }
DI void p0_prologue(const FP& P, const Ctx& C) {
    LAS float* scr = (LAS float*)(C.lds + C.wave * 16384);
    const int gw = C.vcu * NWAVES + C.wave, NGW = C.G * NWAVES, lane = C.lane;
    { constexpr int IA = (D_MODEL / 64) * (ACOLS / 32), IM = (D_MODEL / 64) * (1024 / 32), IOA = (512 / 64) * (D_MODEL / 32), IOB = (1024 / 64) * (D_MODEL / 32), IB = (D_MODEL / 64) * (NB_T / 32), IC = (1024 / 64) * (512 / 32);
      constexpr int NIT = IA + IM + IOA + IOB + IB + IC;
      for (int it = gw; it < NIT; it += NGW) { int r = it;
          if (r < IA) { transpose_item(P, col_wa, D_MODEL, P.WA_T, scr, r, ACOLS / 32, lane); continue; } r -= IA;
          if (r < IM) { transpose_item(P, col_wmem, D_MODEL, P.WMEM_T, scr, r, 1024 / 32, lane); continue; } r -= IM;
          if (r < IOA) { transpose_item(P, col_woa, 512, P.WOA_T, scr, r, D_MODEL / 32, lane); continue; } r -= IOA;
          if (r < IOB) { transpose_item(P, col_wob, 1024, P.WOB_T, scr, r, D_MODEL / 32, lane); continue; } r -= IOB;
          if (r < IB) { transpose_item(P, col_wb, D_MODEL, P.WB_T, scr, r, NB_T / 32, lane); continue; } r -= IB;
          transpose_item(P, col_cw1, 1024, P.CW1_T, scr, r, 512 / 32, lane); } }
    for (int r = gw; r < MPAD; r += NGW) { cvt_row1024(r < M0 ? P.x_prompt + (size_t)r * D_MODEL : (r < MP ? P.x_sample + (size_t)(r - M0) * D_MODEL : nullptr), P.XB0 + (size_t)r * D_MODEL, lane);
        if (r >= MP) { cvt_row1024(nullptr, P.X1B + (size_t)r * D_MODEL, lane); cvt_row1024(nullptr, P.X2B + (size_t)r * D_MODEL, lane); cvt_row1024(nullptr, P.X3B + (size_t)r * D_MODEL, lane);
            for (int c = lane; c < 512; c += 64) { P.ATTA[(size_t)r * 512 + c] = 0; P.ATTB[(size_t)r * 1024 + c] = 0; P.ATTB[(size_t)r * 1024 + 512 + c] = 0; } } }
    for (int r = gw; r < BATCH * MEM_TOKENS; r += NGW) cvt_row1024(P.mem_prompt + (size_t)r * D_MODEL, P.MEMB + (size_t)r * D_MODEL, lane);
#pragma unroll 1
    for (int r = 2 * gw; r < DEPTH * PEER_EXPERTS; r += 2 * NGW) { f32x4 a[16];
#pragma unroll
        for (int q = 0; q < 4; ++q) { const float* s0 = (q < 2 ? P.peer_u : P.peer_v) + (size_t)(r + (q & 1)) * D_MODEL + 16 * lane;
#pragma unroll
            for (int j = 0; j < 4; ++j) a[4 * q + j] = *(const f32x4*)(s0 + 4 * j); }
#pragma unroll
        for (int q = 0; q < 4; ++q) { const float sc = q < 2 ? 256.f : 64.f; unsigned w[4];
#pragma unroll
            for (int j = 0; j < 4; ++j) { const f32x4 v = a[4 * q + j] * sc; int t = __builtin_amdgcn_cvt_pk_fp8_f32(v.x, v.y, 0, false); t = __builtin_amdgcn_cvt_pk_fp8_f32(v.z, v.w, t, true); w[j] = (unsigned)t; }
            u32x4 o; o.x = w[0]; o.y = w[1]; o.z = w[2]; o.w = w[3]; *(u32x4*)((q < 2 ? P.UB8 : P.VB8) + (size_t)(r + (q & 1)) * D_MODEL + 16 * lane) = o; } }
    for (int i = gw * 64 + lane; i < NPOS * 32; i += NGW * 64) { const int pos = i >> 5, d = i & 31; const double inv = exp2(-(double)d * (13.287712379549449 / 32.0)); const double turns = (double)pos * inv * 0.15915494309189535;
        const float fr = (float)(turns - floor(turns)); P.ROPE[pos * 64 + d] = __builtin_amdgcn_cosf(fr); P.ROPE[pos * 64 + 32 + d] = __builtin_amdgcn_sinf(fr); }
    for (int i = gw; i < 2 * CMP_HIDDEN; i += NGW) { const int ty = i / CMP_HIDDEN, hid = i % CMP_HIDDEN; float a = 0.f;
#pragma unroll 8
        for (int k = lane; k < CMP_BLOCK * HEAD_DIM; k += 64) a += P.cmp_pe[ty * CMP_BLOCK * HEAD_DIM + k] * P.cmp_w1[((size_t)ty * CMP_BLOCK * HEAD_DIM + k) * CMP_HIDDEN + hid];
        a = wave_sum(a); if (lane == 0) P.CBIAS[i] = a; }
    for (int it = gw; it < DEC_BATCH * (PAST_LEN / PAGE_SIZE); it += NGW) { const int n = it / (PAST_LEN / PAGE_SIZE), pi = it % (PAST_LEN / PAGE_SIZE); const int pg = P.page_table[it];
        const float* src = P.cache_nsa_kv + (size_t)pg * PAGE_SIZE * 512 + 4 * lane; const int ty = lane >> 5, kvh = (lane >> 4) & 1, d = (4 * lane) & 63;
        bf16* dst = P.AC + ((size_t)ty * ACROWS + ((size_t)(BATCH + n) * NSA_KV_HEADS + kvh) * NCH + pi * (PAGE_SIZE / 16)) * 1024 + d;
#pragma unroll 1
        for (int r0 = 0; r0 < PAGE_SIZE; r0 += 8) { f32x4 v[8];
#pragma unroll
            for (int u = 0; u < 8; ++u) v[u] = *(const f32x4*)(src + (size_t)(r0 + u) * 512);
#pragma unroll
            for (int u = 0; u < 8; ++u) { const int t = r0 + u; u32x2 o; o.x = pk2(v[u].x, v[u].y); o.y = pk2(v[u].z, v[u].w); *(u32x2*)(dst + (size_t)(t / 16) * 1024 + (t % 16) * 64) = o; } } }
    for (int g = 0; g < 4; ++g) { const int W = g < 3 ? dil_w(g) : SWA_WINDOW, RV = g < 3 ? 128 : 64;
        const f32x4* src = (const f32x4*)(g < 3 ? sel3c(P.cache_dil, g) : P.cache_nsa_win); f32x4* dst = (f32x4*)(g < 3 ? sel3(P.dil_s, g) : P.win_s);
        const long per = (long)(W - 1) * RV, nvec = (long)DEC_BATCH * per;
#pragma unroll 1
        for (long i0 = (long)gw * 512; i0 < nvec; i0 += (long)NGW * 512) { f32x4 v[8]; long idx[8];
#pragma unroll
            for (int u = 0; u < 8; ++u) { const long i = i0 + u * 64 + lane; const long ii = i < nvec ? i : nvec - 1; const long n = ii / per, o = ii % per; idx[u] = n * (per + RV) + o; v[u] = src[idx[u] + RV]; }
#pragma unroll
            for (int u = 0; u < 8; ++u) { const long i = i0 + u * 64 + lane; if (i < nvec) dst[idx[u]] = v[u]; } } }
}
DI void p0_wpk(const FP& P, const Ctx& C) {
    LAS float* sw = (LAS float*)C.lds;
    LAS float* sk = (LAS float*)(C.lds + 32768);
    constexpr int NIT = DEPTH * 16 * (D_MODEL / 64);
    for (int it = C.vcu; it < NIT; it += C.G) { const int l = it / (16 * (D_MODEL / 64)), rem = it % (16 * (D_MODEL / 64)), hc = rem / (D_MODEL / 64), kb = rem % (D_MODEL / 64);
        __syncthreads();
        for (int i = C.tid; i < 64 * 64; i += NTHREADS) { const int r = i >> 6, d = i & 63; sw[r * 65 + d] = P.peer_wq[((size_t)l * D_MODEL + kb * 64 + r) * 1024 + hc * 64 + d]; }
        for (int i = C.tid; i < 128 * 64; i += NTHREADS) { const int r = i >> 6, d = i & 63; sk[r * 65 + d] = P.peer_keys[(((size_t)l * 16 + hc) * PEER_KEYS + r) * 64 + d]; }
        __syncthreads();
        for (int o = C.tid; o < 128 * 64; o += NTHREADS) { const int kk = o >> 6, ki = o & 63; float a = 0.f;
#pragma unroll 16
            for (int d = 0; d < 64; ++d) a += sw[ki * 65 + d] * sk[kk * 65 + d];
            P.WPK_T[((size_t)l * NPK + hc * 128 + kk) * D_MODEL + kb * 64 + ki] = (bf16)f2bf(a); } }
    __syncthreads();
}

#define EPI_LOOP(...) int fr_l = fr, fq_l = fq; asm volatile("" : "+v"(fr_l), "+v"(fq_l));     \
    _Pragma("unroll") for (int ai = 0; ai < 2; ++ai) _Pragma("unroll") for (int m = 0; m < 4; ++m) { const int row = u.pm * 256 + ai * 128 + wr * 64 + m * 16 + fr_l; \
    _Pragma("unroll") for (int bj = 0; bj < 2; ++bj) { const int ct = bj * 128 + wc * 32 + fq_l * 8; const f32x4 v0 = acc[ai][bj][m][0], v1 = acc[ai][bj][m][1]; __VA_ARGS__ } asm volatile("" ::: "memory"); }
DI void rope4(const float* rope_row, int dp, const f32x4& v0, const f32x4& v1, f32x4& lo, f32x4& hi) {
    const f32x4 c = *(const f32x4*)(rope_row + dp), s = *(const f32x4*)(rope_row + 32 + dp);
    lo.x = v0.x * c.x - v0.y * s.x; hi.x = v0.y * c.x + v0.x * s.x; lo.y = v0.z * c.y - v0.w * s.y; hi.y = v0.w * c.y + v0.z * s.y;
    lo.z = v1.x * c.z - v1.y * s.z; hi.z = v1.y * c.z + v1.x * s.z; lo.w = v1.z * c.w - v1.w * s.w; hi.w = v1.w * c.w + v1.z * s.w; }
DI u32x2 pk4(const f32x4& v) { u32x2 o; o.x = pk2(v.x, v.y); o.y = pk2(v.z, v.w); return o; }
DI u32x4 pk8(const f32x4& a, const f32x4& b) { u32x4 o; o.x = pk2(a.x, a.y); o.y = pk2(a.z, a.w); o.z = pk2(b.x, b.y); o.w = pk2(b.z, b.w); return o; }
DI int dil_perm(int t, int d) { return (t % d) * (SEQ / d) + t / d; }
struct EpiA {
    static constexpr bool PERM = true, AFTER_DRAIN = false; const FP& P;
    DI void operator()(const f32x4 (&acc)[2][2][4][2], const pg8::Unit& u, int wr, int wc, int fr, int fq) const {
        const int t9 = u.pn; const int g = t9 / 3, j = t9 % 3;
        EPI_LOOP({ if (row < MP) { const int h = ct >> 6, e = ct & 63; const int pos = row_pos(row);
            if (t9 == 9) { *(u32x4*)(P.MQA + (size_t)row * 256 + ct) = pk8(v0 * QSCALE, v1 * QSCALE); }
            else if (j < 2) { f32x4 lo, hi; const int dp = e >> 1; rope4(P.ROPE + pos * 64, dp, v0, v1, lo, hi);
                if (j == 0) { bf16* q = P.QA + ((size_t)g * MPAD + row) * 256 + h * 64 + dp; *(u32x2*)q = pk4(lo * QSCALE); *(u32x2*)(q + 32) = pk4(hi * QSCALE); }
                else { if (row < M0) { bf16* kt = P.KA + ((size_t)(g * BATCH + row / SEQ) * DIL_HEADS + h) * 64 * SEQ; const int cm = dil_perm(pos, dil_d(g)); *(u32x2*)(kt + ktile_off(cm, dp)) = pk4(lo); *(u32x2*)(kt + ktile_off(cm, dp + 32)) = pk4(hi); }
                    const int W = dil_w(g); float* o = nullptr;
                    if (row >= M0) o = sel3(P.dil_s, g) + (((size_t)(row - M0) * W + W - 1) * 2 + 0) * 256; else if (pos >= SEQ - W) o = sel3(P.dil_p, g) + (((size_t)(row / SEQ) * W + pos - (SEQ - W)) * 2 + 0) * 256;
                    if (o) { *(f32x4*)(o + h * 64 + dp) = lo; *(f32x4*)(o + h * 64 + 32 + dp) = hi; } } }
            else { const int W = dil_w(g), d = dil_d(g); float* o = nullptr;
                if (row >= M0) o = sel3(P.dil_s, g) + (((size_t)(row - M0) * W + W - 1) * 2 + 1) * 256; else if (pos >= SEQ - W) o = sel3(P.dil_p, g) + (((size_t)(row / SEQ) * W + pos - (SEQ - W)) * 2 + 1) * 256;
                if (o) { *(f32x4*)(o + ct) = v0; *(f32x4*)(o + ct + 4) = v1; }
                if (row < M0) { bf16* vt = P.VTA + ((size_t)(g * BATCH + row / SEQ) * DIL_HEADS + h) * 64 * SEQ + vtile_off(e, dil_perm(pos, d));
                    vt[0] = (bf16)f2bf(v0.x); vt[8] = (bf16)f2bf(v0.y); vt[16] = (bf16)f2bf(v0.z); vt[24] = (bf16)f2bf(v0.w); vt[32] = (bf16)f2bf(v1.x); vt[40] = (bf16)f2bf(v1.y); vt[48] = (bf16)f2bf(v1.z); vt[56] = (bf16)f2bf(v1.w); } } } })
    }
};
struct EpiMem {
    static constexpr bool PERM = true, AFTER_DRAIN = false; const FP& P;
    DI void operator()(const f32x4 (&acc)[2][2][4][2], const pg8::Unit& u, int wr, int wc, int fr, int fq) const {
        const int l = u.pn >> 1, half = u.pn & 1;
        EPI_LOOP({ const int n = row / MEM_TOKENS, mt = row % MEM_TOKENS; float* o = P.mem_kv_p + (((size_t)l * BATCH + n) * MEM_TOKENS + mt) * 512 + half * 256 + ct; *(f32x4*)o = v0; *(f32x4*)(o + 4) = v1;
            if (half == 0) *(u32x4*)(P.MK + (((size_t)l * BATCH + n) * MEM_HEADS + (ct >> 6)) * MEM_TOKENS * 64 + ktile_off(mt, ct & 63)) = pk8(v0, v1);
            else { bf16* vt = P.MVT + (((size_t)l * BATCH + n) * MEM_HEADS + (ct >> 6)) * MEM_TOKENS * 64 + vtile_off(ct & 63, mt);
                vt[0] = (bf16)f2bf(v0.x); vt[8] = (bf16)f2bf(v0.y); vt[16] = (bf16)f2bf(v0.z); vt[24] = (bf16)f2bf(v0.w); vt[32] = (bf16)f2bf(v1.x); vt[40] = (bf16)f2bf(v1.y); vt[48] = (bf16)f2bf(v1.z); vt[56] = (bf16)f2bf(v1.w); } })
    }
};
struct EpiPre {
    static constexpr bool PERM = true, AFTER_DRAIN = false; const float* xa; const float* xb; float* pre;
    DI void operator()(const f32x4 (&acc)[2][2][4][2], const pg8::Unit& u, int wr, int wc, int fr, int fq) const {
        EPI_LOOP({ if (row < MP) { const int col = u.pn * 256 + ct; const float* x = (xb && row >= M0) ? xb + (size_t)(row - M0) * D_MODEL + col : xa + (size_t)row * D_MODEL + col;
            const f32x4 a = *(const f32x4*)x, b = *(const f32x4*)(x + 4); float* o = pre + (size_t)row * D_MODEL + col; *(f32x4*)o = a * ALPHA + v0; *(f32x4*)(o + 4) = b * ALPHA + v1; } })
    }
};
struct EpiF32 {
    static constexpr bool PERM = true, AFTER_DRAIN = false; float* out; int ldc; int nrows;
    DI void operator()(const f32x4 (&acc)[2][2][4][2], const pg8::Unit& u, int wr, int wc, int fr, int fq) const {
        EPI_LOOP({ if (row < nrows) { float* o = out + (size_t)row * ldc + u.pn * 256 + ct; *(f32x4*)o = v0; *(f32x4*)(o + 4) = v1; } })
    }
};
}
namespace fx {
struct Tile16 { f32x4 o[4]; float m, l; };
DI void tile_init(Tile16& T) { T.o[0] = T.o[1] = T.o[2] = T.o[3] = (f32x4){0.f, 0.f, 0.f, 0.f}; T.m = -INFINITY; T.l = 0.f; }
typedef __bf16 bf16x2_t __attribute__((ext_vector_type(2)));
DI unsigned cvtpk(float lo, float hi) { const f32x2 v = {lo, hi}; const bf16x2_t b = __builtin_convertvector(v, bf16x2_t); return __builtin_bit_cast(unsigned, b); }
struct KV8 { bf16x8 ka0, ka1, kb0, kb1, v0, v1, v2, v3; };
DI void kv_load(KV8& r, const bf16* k0, const bf16* k1, const bf16* v, long vs16) {
    r.ka0 = *(const bf16x8*)k0; r.ka1 = *(const bf16x8*)(k0 + 32); r.kb0 = *(const bf16x8*)k1; r.kb1 = *(const bf16x8*)(k1 + 32);
    r.v0 = *(const bf16x8*)v; r.v1 = *(const bf16x8*)(v + vs16); r.v2 = *(const bf16x8*)(v + 2 * vs16); r.v3 = *(const bf16x8*)(v + 3 * vs16); }
template <class MaskF> DI void tile_compute(Tile16& T, const bf16x8 (&qf)[2], const KV8& r, MaskF mask) {
    f32x4 s0 = (f32x4){0.f, 0.f, 0.f, 0.f}, s1 = (f32x4){0.f, 0.f, 0.f, 0.f};
    s0 = __builtin_amdgcn_mfma_f32_16x16x32_bf16(r.ka0, qf[0], s0, 0, 0, 0); s0 = __builtin_amdgcn_mfma_f32_16x16x32_bf16(r.ka1, qf[1], s0, 0, 0, 0);
    s1 = __builtin_amdgcn_mfma_f32_16x16x32_bf16(r.kb0, qf[0], s1, 0, 0, 0); s1 = __builtin_amdgcn_mfma_f32_16x16x32_bf16(r.kb1, qf[1], s1, 0, 0, 0);
    float s[8] = {s0.x, s0.y, s0.z, s0.w, s1.x, s1.y, s1.z, s1.w};
    float mx = -INFINITY;
#pragma unroll
    for (int e = 0; e < 8; ++e) { s[e] = mask(e) ? s[e] : -INFINITY; mx = fmaxf(mx, s[e]); }
    mx = fmaxf(mx, __shfl_xor(mx, 16)); mx = fmaxf(mx, __shfl_xor(mx, 32));
    const float mnew = fmaxf(T.m, mx), muse = (mnew == -INFINITY) ? 0.f : mnew;
    const float alpha = __builtin_amdgcn_exp2f(T.m - muse);
    float ls = 0.f;
#pragma unroll
    for (int e = 0; e < 8; ++e) { s[e] = __builtin_amdgcn_exp2f(s[e] - muse); ls += s[e]; }
    ls += __shfl_xor(ls, 16); ls += __shfl_xor(ls, 32);
    T.l = T.l * alpha + ls; T.m = mnew;
    u32x4 pw; pw.x = cvtpk(s[0], s[1]); pw.y = cvtpk(s[2], s[3]); pw.z = cvtpk(s[4], s[5]); pw.w = cvtpk(s[6], s[7]);
    const bf16x8 pf = __builtin_bit_cast(bf16x8, pw);
    T.o[0] = __builtin_amdgcn_mfma_f32_16x16x32_bf16(r.v0, pf, T.o[0] * alpha, 0, 0, 0); T.o[1] = __builtin_amdgcn_mfma_f32_16x16x32_bf16(r.v1, pf, T.o[1] * alpha, 0, 0, 0);
    T.o[2] = __builtin_amdgcn_mfma_f32_16x16x32_bf16(r.v2, pf, T.o[2] * alpha, 0, 0, 0); T.o[3] = __builtin_amdgcn_mfma_f32_16x16x32_bf16(r.v3, pf, T.o[3] * alpha, 0, 0, 0);
}
template <class BUF, class LD, class CP> DI void pipe2t(int n, LD ld, CP cp) { if (n <= 0) return; BUF A, B; ld(A, 0);
#pragma unroll 1
    for (int i = 0; i < n; i += 2) { ld(B, (i + 1 < n) ? i + 1 : i); cp(A, i); ld(A, (i + 2 < n) ? i + 2 : i); if (i + 1 < n) cp(B, i + 1); } }
template <class LD, class CP> DI void pipe2(int n, LD ld, CP cp) { if (n <= 0) return; KV8 A, B; ld(A, 0);
#pragma unroll 1
    for (int i = 0; i < n; i += 2) { ld(B, (i + 1 < n) ? i + 1 : i); cp(A, i); ld(A, (i + 2 < n) ? i + 2 : i); if (i + 1 < n) cp(B, i + 1); } }
DI void kv_load_t(KV8& r, const bf16* kt, const bf16* vt, int lane) {
    const bf16* k = kt + lane * 8; const bf16* v = vt + lane * 8;
    r.ka0 = *(const bf16x8*)k; r.ka1 = *(const bf16x8*)(k + 512); r.kb0 = *(const bf16x8*)(k + 1024); r.kb1 = *(const bf16x8*)(k + 1536);
    r.v0 = *(const bf16x8*)v; r.v1 = *(const bf16x8*)(v + 512); r.v2 = *(const bf16x8*)(v + 1024); r.v3 = *(const bf16x8*)(v + 1536); }
DI int krow_of(int i, int b) { return 8 * (i >> 2) + 4 * b + (i & 3); }

DI void dil_micro(const FP& P, int n, int h, int t0, int mt, int lane) {
    const int g = mt >> 4, idx = mt & 15, d = dil_d(g), per = 16 / d;
    const int r = idx / per, sub = idx % per, i0 = t0 / d + 16 * sub, ib = i0 - 128, NC = SEQ / d;
    const int q = lane & 15, c = lane >> 4;
    const bf16* Qb = P.QA + ((size_t)g * MPAD + (size_t)n * SEQ) * 256 + h * 64;
    const bf16* Kb = P.KA + ((size_t)(g * BATCH + n) * DIL_HEADS + h) * 64 * SEQ + (size_t)r * NC * 64; const bf16* Vb = P.VTA + ((size_t)(g * BATCH + n) * DIL_HEADS + h) * 64 * SEQ + (size_t)r * NC * 64;
    bf16x8 qf[2]; { const bf16* qp = Qb + (size_t)(r + d * (i0 + q)) * 256 + 8 * c; qf[0] = *(const bf16x8*)qp; qf[1] = *(const bf16x8*)(qp + 32); }
    Tile16 T; tile_init(T);
    const int qi = i0 + q; const int tb0 = ib >> 5  , nblk = ((i0 + 15) >> 5) - tb0 + 1;
    pipe2(nblk, [&](KV8& kv, int i) { int tb = tb0 + i; tb = tb < 0 ? 0 : tb; kv_load_t(kv, Kb + (size_t)tb * 2048, Vb + (size_t)tb * 2048, lane); },
          [&](const KV8& kv, int i) { const int kb = 32 * (tb0 + i); tile_compute(T, qf, kv, [&](int e) { const int ki = kb + 8 * c + e; return ki >= 0 && ki <= qi && qi - ki <= DIL_TAPS - 1; }); });
    const int row = n * SEQ + r + d * qi;
    float* op = P.DPART + (((size_t)g * MP + row) * DIL_HEADS + h) * 64 + 4 * c;
#pragma unroll
    for (int db = 0; db < 4; ++db) *(f32x4*)(op + 16 * db) = T.o[db];
    if (c == 0) { float* ml = P.DML + (((size_t)g * MP + row) * DIL_HEADS + h) * 2; ml[0] = T.m; ml[1] = T.l; }
}
DI void mem_micro(const FP& P, const bf16* Q  , int ldq, int row0, int layer, int n, int h, bf16* O  , int ldo, int lane) {
    const int q = lane & 15, c = lane >> 4;
    bf16x8 qf[2]; { const bf16* qp = Q + (size_t)(row0 + q) * ldq + 8 * c; qf[0] = *(const bf16x8*)qp; qf[1] = *(const bf16x8*)(qp + 32); }
    const bf16* Kb = P.MK + (((size_t)layer * BATCH + n) * MEM_HEADS + h) * MEM_TOKENS * 64; const bf16* Vb = P.MVT + (((size_t)layer * BATCH + n) * MEM_HEADS + h) * MEM_TOKENS * 64;
    Tile16 T; tile_init(T);
    pipe2(MEM_TOKENS / 32, [&](KV8& kv, int i) { kv_load_t(kv, Kb + (size_t)i * 2048, Vb + (size_t)i * 2048, lane); }, [&](const KV8& kv, int) { tile_compute(T, qf, kv, [&](int) { return true; }); });
    const float inv = 1.0f / T.l; bf16* op = O + (size_t)(row0 + q) * ldo + 4 * c;
#pragma unroll
    for (int db = 0; db < 4; ++db) *(u32x2*)(op + 16 * db) = pk4(T.o[db] * inv);
}
struct Dec { float m, l, o; };
template <class KF, class VF> DI void dec_chunk(Dec& D, const LAS float* q, int nk, KF kf, VF vf, int lane) {
    float s = -INFINITY;
    if (lane < nk) { const float* k = kf(lane); float a = 0.f;
#pragma unroll
        for (int d4 = 0; d4 < 16; ++d4) { const f32x4 kv = *(const f32x4*)(k + 4 * d4); a += kv.x * q[4 * d4] + kv.y * q[4 * d4 + 1] + kv.z * q[4 * d4 + 2] + kv.w * q[4 * d4 + 3]; }
        s = a; }
    const float mx = wave_max(s), mnew = fmaxf(D.m, mx), alpha = __builtin_amdgcn_exp2f(D.m - mnew);
    const float p = (lane < nk) ? __builtin_amdgcn_exp2f(s - mnew) : 0.f;
    D.l = D.l * alpha + wave_sum(p); D.m = mnew; float o = D.o * alpha;
    for (int j0 = 0; j0 < nk; j0 += 8) { float vv[8];
#pragma unroll
        for (int u = 0; u < 8; ++u) { const int jj = (j0 + u < nk) ? j0 + u : nk - 1; vv[u] = vf(jj)[lane]; }
#pragma unroll
        for (int u = 0; u < 8; ++u) { const float pj = (j0 + u < nk) ? __builtin_bit_cast(float, __builtin_amdgcn_readlane(__builtin_bit_cast(int, p), (j0 + u) & 63)) : 0.f; o += pj * vv[u]; } }
    D.o = o;
}
DI void atta_phase(const FP& P, const Ctx& C) {
    const int lane = C.lane, w = C.wave;
    constexpr int NT = SEQ / 256, NIT = BATCH * NT * DIL_HEADS;
    for (int it = C.vcu; it < NIT; it += C.G) { const int h = it % DIL_HEADS, tt = (it / DIL_HEADS) % NT, n = it / (DIL_HEADS * NT), t0 = tt * 256;
        for (int mt = w; mt < 48; mt += NWAVES) dil_micro(P, n, h, t0, mt, lane);
        asm volatile("s_waitcnt vmcnt(0)" ::: "memory"); __syncthreads();
        for (int i = C.tid; i < 256 * 16; i += NTHREADS) { const int tk = i >> 4, d4 = (i & 15) * 4; const int row = n * SEQ + t0 + tk;
            float mg[3], lg[3]; float M = -INFINITY;
#pragma unroll
            for (int g = 0; g < 3; ++g) { const float* ml = P.DML + (((size_t)g * MP + row) * DIL_HEADS + h) * 2; mg[g] = ml[0]; lg[g] = ml[1]; M = fmaxf(M, mg[g]); }
            f32x4 acc = (f32x4){0.f, 0.f, 0.f, 0.f}; float L = 0.f;
#pragma unroll
            for (int g = 0; g < 3; ++g) { const float wg = __builtin_amdgcn_exp2f(mg[g] - M); L += wg * lg[g]; acc += *(const f32x4*)(P.DPART + (((size_t)g * MP + row) * DIL_HEADS + h) * 64 + d4) * wg; }
            *(u32x2*)(P.ATTA + (size_t)row * 512 + h * 64 + d4) = pk4(acc * (1.0f / L)); }
        for (int mt = w; mt < 16; mt += NWAVES) mem_micro(P, P.MQA + h * 64, 256, n * SEQ + t0 + 16 * mt, 0, n, h, P.ATTA + 256 + h * 64, 512, lane);
        __syncthreads();
    }
    LAS float* qs = (LAS float*)(C.lds + w * 1024);
    const int gw = C.vcu * NWAVES + w, NGW = C.G * NWAVES;
    for (int it = gw; it < DEC_BATCH * DIL_HEADS * 2; it += NGW) { const int kind = it & 1, h = (it >> 1) % DIL_HEADS, ns = (it >> 1) / DIL_HEADS, row = M0 + ns;
        Dec D; D.m = -INFINITY; D.l = 0.f; D.o = 0.f;
        if (kind == 0) {
            for (int g = 0; g < 3; ++g) qs[g * 64 + lane] = bf2f(P.QA[((size_t)g * MPAD + row) * 256 + h * 64 + lane]);
            asm volatile("s_waitcnt lgkmcnt(0)" ::: "memory");
            for (int g = 0; g < 3; ++g) { const int W = dil_w(g), d = dil_d(g); const float* cache = sel3c(P.cache_dil, g) + (size_t)ns * W * 512; const float* newrow = sel3(P.dil_s, g) + ((size_t)ns * W + W - 1) * 512;
                for (int j0 = 0; j0 < DIL_TAPS; j0 += 64) { const int nk = (DIL_TAPS - j0) < 64 ? (DIL_TAPS - j0) : 64;
                    dec_chunk(D, qs + g * 64, nk, [&](int j) { const int tap = j0 + j; return (tap == 0 ? newrow : cache + (size_t)(W - d * tap) * 512) + h * 64; },
                              [&](int j) { const int tap = j0 + j; return (tap == 0 ? newrow : cache + (size_t)(W - d * tap) * 512) + 256 + h * 64; }, lane); } }
            P.ATTA[(size_t)row * 512 + h * 64 + lane] = (bf16)f2bf(D.o / D.l);
        } else {
            qs[lane] = bf2f(P.MQA[(size_t)row * 256 + h * 64 + lane]);
            asm volatile("s_waitcnt lgkmcnt(0)" ::: "memory");
            const float* mk = P.cache_mem_kv + ((size_t)0 * DEC_BATCH + ns) * MEM_TOKENS * 512;
            for (int j0 = 0; j0 < MEM_TOKENS; j0 += 64) dec_chunk(D, qs, 64, [&](int j) { return mk + (size_t)(j0 + j) * 512 + h * 64; }, [&](int j) { return mk + (size_t)(j0 + j) * 512 + 256 + h * 64; }, lane);
            P.ATTA[(size_t)row * 512 + 256 + h * 64 + lane] = (bf16)f2bf(D.o / D.l);
        }
    }
    __syncthreads();
}
DI void ln_phase(const FP& P, const Ctx& C, const float* pre, const float* gam, const float* bet, float* xo, bf16* xb, float* yp, float* ys) {
    const int gw = C.vcu * NWAVES + C.wave, NGW = C.G * NWAVES, lane = C.lane;
    for (int r = gw; r < MP; r += NGW) { const float* x = pre + (size_t)r * D_MODEL; f32x4 v[4]; float s = 0.f;
#pragma unroll
        for (int j = 0; j < 4; ++j) { v[j] = *(const f32x4*)(x + 256 * j + 4 * lane); s += (v[j].x + v[j].y) + (v[j].z + v[j].w); }
        const float mu = wave_sum(s) * (1.0f / D_MODEL); float s2 = 0.f;
#pragma unroll
        for (int j = 0; j < 4; ++j) { v[j] = v[j] - mu; s2 += (v[j].x * v[j].x + v[j].y * v[j].y) + (v[j].z * v[j].z + v[j].w * v[j].w); }
        const float rs = 1.0f / sqrtf(wave_sum(s2) * (1.0f / D_MODEL) + LN_EPS);
#pragma unroll
        for (int j = 0; j < 4; ++j) { const f32x4 gg = *(const f32x4*)(gam + 256 * j + 4 * lane), bb = *(const f32x4*)(bet + 256 * j + 4 * lane); const f32x4 o = v[j] * rs * gg + bb;
            if (xo) *(f32x4*)(xo + (size_t)r * D_MODEL + 256 * j + 4 * lane) = o;
            if (xb) *(u32x2*)(xb + (size_t)r * D_MODEL + 256 * j + 4 * lane) = pk4(o);
            if (yp) { if (r < M0) *(f32x4*)(yp + (size_t)r * D_MODEL + 256 * j + 4 * lane) = o; else *(f32x4*)(ys + (size_t)(r - M0) * D_MODEL + 256 * j + 4 * lane) = o; } }
    }
}
}
namespace fx {
#define INS16(V, I, v_, i_) do { const float _v = (v_); const int _i = (i_); bool _c[16]; _Pragma("unroll") for (int _k = 0; _k < 16; ++_k) _c[_k] = _v > V[_k]; \
    _Pragma("unroll") for (int _k = 15; _k >= 1; --_k) { V[_k] = _c[_k] ? (_c[_k - 1] ? V[_k - 1] : _v) : V[_k]; I[_k] = _c[_k] ? (_c[_k - 1] ? I[_k - 1] : _i) : I[_k]; } \
    V[0] = _c[0] ? _v : V[0]; I[0] = _c[0] ? _i : I[0]; } while (0)
DI void wave_top16_128(float a, float b, int lane, float& outv, int& outi) {
    outv = -INFINITY; outi = 0;
#pragma unroll 1
    for (int k = 0; k < 16; ++k) { const float m = wave_max(fmaxf(a, b)); const unsigned long long ba = __ballot(a == m), bb = __ballot(b == m); int idx;
        if (ba) { const int l = __builtin_ctzll(ba); idx = l; if (lane == l) a = -INFINITY; } else { const int l = __builtin_ctzll(bb); idx = 64 + l; if (lane == l) b = -INFINITY; }
        if (lane == k) { outv = m; outi = idx; } }
}
DI void topk_wave_item(const FP& P, long it, int lane) {
    const float* s = P.SCO + it * 256; float v1, v2; int i1, i2;
    wave_top16_128(s[lane], s[64 + lane], lane, v1, i1); wave_top16_128(s[128 + lane], s[192 + lane], lane, v2, i2);
    int a = 0, rem = lane; bool valid = false;
    for (int aa = 0; aa < 16; ++aa) { const int nb = 16 / (aa + 1); if (!valid) { if (rem < nb) { a = aa; valid = true; } else rem -= nb; } }
    const int b = valid ? rem : 0;
    float cs = __shfl(v1, a) + __shfl(v2, b); const int ce = __shfl(i1, a) * PEER_KEYS + __shfl(i2, b); if (!valid) cs = -INFINITY;
    float tv = -INFINITY; int te = 0;
#pragma unroll 1
    for (int k = 0; k < 16; ++k) { const float m = wave_max(cs); const unsigned long long bm = __ballot(cs == m); const int l = __builtin_ctzll(bm); const int e = __shfl(ce, l); if (lane == l) cs = -INFINITY; if (lane == k) { tv = m; te = e; } }
    const float mx = __shfl(tv, 0); const float ex = (lane < 16) ? __expf(tv - mx) : 0.f; const float z = wave_sum(ex);
    if (lane < 16) { P.SELG[it * 16 + lane] = ex / z; P.SELE[it * 16 + lane] = te; }
}
#define KINS16(V, key_) do { const float _key = (key_); _Pragma("unroll") for (int _k = 15; _k >= 1; --_k) V[_k] = __builtin_amdgcn_fmed3f(V[_k - 1], V[_k], _key); V[0] = fmaxf(V[0], _key); } while (0)
DI float pack_key(float v, unsigned lowbits, unsigned mask) { return __builtin_bit_cast(float, (__builtin_bit_cast(unsigned, v) & ~mask) | lowbits); }
DI void topk_phase(const FP& P, const Ctx& C) {
    const int lane = C.lane; LAS float* st = (LAS float*)(C.lds + C.wave * 16384);
    const int NWI = (M0 * PEER_HEADS) / 64;
    for (int wi = C.vcu * NWAVES + C.wave; wi < NWI; wi += C.G * NWAVES) {
        const long it0 = (long)wi * 64; const long it = it0 + lane;
        float V1[16], V2[16], V3[16];
#pragma unroll
        for (int k = 0; k < 16; ++k) { V1[k] = V2[k] = V3[k] = -INFINITY; }
#pragma unroll 1
        for (int ch = 0; ch < 8; ++ch) {
#pragma unroll
            for (int u = 0; u < 8; ++u) { const int f4 = u * 64 + lane, j = f4 >> 3, q = f4 & 7, hf = q >> 2, c4 = (q & 3) * 4; const long itj = it0 + j;
                const f32x4 v = *(const f32x4*)(P.SCO + itj * 256 + hf * 128 + ch * 16 + c4);
                st[j * 33 + hf * 16 + c4] = v.x; st[j * 33 + hf * 16 + c4 + 1] = v.y; st[j * 33 + hf * 16 + c4 + 2] = v.z; st[j * 33 + hf * 16 + c4 + 3] = v.w; }
            asm volatile("s_waitcnt lgkmcnt(0)" ::: "memory");
#pragma unroll 4
            for (int c = 0; c < 16; ++c) { const float va = st[lane * 33 + c], vb = st[lane * 33 + 16 + c]; const unsigned lb = 127u - (unsigned)(ch * 16 + c); KINS16(V1, pack_key(va, lb, 127u)); KINS16(V2, pack_key(vb, lb, 127u)); }
            asm volatile("s_waitcnt lgkmcnt(0)" ::: "memory");
        }
        LAS int* lc = (LAS int*)st;
        { int ord = 0;
#pragma unroll
          for (int a = 0; a < 16; ++a) { const unsigned ba = __builtin_bit_cast(unsigned, V1[a]); const float va = __builtin_bit_cast(float, ba & ~127u); const int ia = 127 - (int)(ba & 127u);
#pragma unroll
              for (int b = 0; b < 16; ++b) if ((a + 1) * (b + 1) <= 16) { const unsigned bb = __builtin_bit_cast(unsigned, V2[b]); const float vb = __builtin_bit_cast(float, bb & ~127u); const int ib = 127 - (int)(bb & 127u);
                  lc[lane * 51 + ord] = ia * PEER_KEYS + ib; KINS16(V3, pack_key(va + vb, 63u - (unsigned)ord, 63u)); ++ord; } } }
        asm volatile("s_waitcnt lgkmcnt(0)" ::: "memory");
        float g[16]; int e[16]; float z = 0.f; const float vmax = __builtin_bit_cast(float, __builtin_bit_cast(unsigned, V3[0]) & ~63u);
#pragma unroll
        for (int k = 0; k < 16; ++k) { const unsigned bk = __builtin_bit_cast(unsigned, V3[k]); e[k] = lc[lane * 51 + 63 - (int)(bk & 63u)]; g[k] = __expf(__builtin_bit_cast(float, bk & ~63u) - vmax); z += g[k]; }
        const float iz = 1.0f / z;
#pragma unroll
        for (int k4 = 0; k4 < 4; ++k4) { *(f32x4*)(P.SELG + it * 16 + 4 * k4) = (f32x4){g[4 * k4] * iz, g[4 * k4 + 1] * iz, g[4 * k4 + 2] * iz, g[4 * k4 + 3] * iz};
            *(int4*)(P.SELE + it * 16 + 4 * k4) = make_int4(e[4 * k4], e[4 * k4 + 1], e[4 * k4 + 2], e[4 * k4 + 3]); }
        asm volatile("s_waitcnt lgkmcnt(0)" ::: "memory");
    }
    for (int si = C.vcu * NWAVES + C.wave; si < DEC_BATCH * PEER_HEADS; si += C.G * NWAVES) topk_wave_item(P, (long)M0 * PEER_HEADS + si, lane);
    __syncthreads();
}
constexpr float PEER_SU = 256.f, PEER_SV = 64.f;
DI float dot16_fp8(const u32x4& w, const f32x2 (&x2)[8]) { f32x2 a = {0.f, 0.f};
    a += __builtin_amdgcn_cvt_pk_f32_fp8((int)w.x, false) * x2[0]; a += __builtin_amdgcn_cvt_pk_f32_fp8((int)w.x, true) * x2[1];
    a += __builtin_amdgcn_cvt_pk_f32_fp8((int)w.y, false) * x2[2]; a += __builtin_amdgcn_cvt_pk_f32_fp8((int)w.y, true) * x2[3];
    a += __builtin_amdgcn_cvt_pk_f32_fp8((int)w.z, false) * x2[4]; a += __builtin_amdgcn_cvt_pk_f32_fp8((int)w.z, true) * x2[5];
    a += __builtin_amdgcn_cvt_pk_f32_fp8((int)w.w, false) * x2[6]; a += __builtin_amdgcn_cvt_pk_f32_fp8((int)w.w, true) * x2[7];
    return a.x + a.y; }
DI void axpy16_fp8(const u32x4& w, float s, f32x2 (&o2)[8]) { const f32x2 s2 = {s, s};
    o2[0] += __builtin_amdgcn_cvt_pk_f32_fp8((int)w.x, false) * s2; o2[1] += __builtin_amdgcn_cvt_pk_f32_fp8((int)w.x, true) * s2;
    o2[2] += __builtin_amdgcn_cvt_pk_f32_fp8((int)w.y, false) * s2; o2[3] += __builtin_amdgcn_cvt_pk_f32_fp8((int)w.y, true) * s2;
    o2[4] += __builtin_amdgcn_cvt_pk_f32_fp8((int)w.z, false) * s2; o2[5] += __builtin_amdgcn_cvt_pk_f32_fp8((int)w.z, true) * s2;
    o2[6] += __builtin_amdgcn_cvt_pk_f32_fp8((int)w.w, false) * s2; o2[7] += __builtin_amdgcn_cvt_pk_f32_fp8((int)w.w, true) * s2; }
#if defined(PEER_SHARD) || defined(PEER_SHARD2)
#define PEER_FIRST_ROUND nrounds
#else
#define PEER_FIRST_ROUND 0
#endif
DI float rdlane(float v, int l) { return __builtin_bit_cast(float, __builtin_amdgcn_readlane(__builtin_bit_cast(int, v), l)); }
DI void peer_phase(const FP& P, const Ctx& C, int layer, const float* xin, float* fout, float* fout_s, bf16* xb, bool samples_only = false) {
    const int lane = C.lane; const unsigned char* U = P.UB8 + (size_t)layer * PEER_EXPERTS * D_MODEL; const unsigned char* Vt = P.VB8 + (size_t)layer * PEER_EXPERTS * D_MODEL;
    const float* gam = P.ln_g + ((size_t)layer * 2 + 1) * D_MODEL; const float* bet = P.ln_b + ((size_t)layer * 2 + 1) * D_MODEL;
    const int nrounds = (M0 + C.G * NWAVES - 1) / (C.G * NWAVES);
#pragma unroll 1
    for (int rd = samples_only ? nrounds : 0; rd <= nrounds; ++rd) {
        const bool smp = (rd == nrounds); int r = smp ? M0 + C.vcu : rd * C.G * NWAVES + C.vcu * NWAVES + C.wave; if (smp ? (C.vcu >= DEC_BATCH) : (r >= M0)) continue;
        const int pb = smp ? 16 * C.wave : 0, pe = smp ? pb + 16 : 128;
        f32x2 x2[8], o2[8];
#pragma unroll
        for (int j = 0; j < 4; ++j) { const f32x4 a = *(const f32x4*)(xin + (size_t)r * D_MODEL + 16 * lane + 4 * j); x2[2 * j] = (f32x2){a.x, a.y}; x2[2 * j + 1] = (f32x2){a.z, a.w}; }
#pragma unroll
        for (int k = 0; k < 8; ++k) o2[k] = (f32x2){0.f, 0.f};
        const int e_l = P.SELE[(size_t)r * 128 + lane], e_h = P.SELE[(size_t)r * 128 + 64 + lane]; const float g_l = P.SELG[(size_t)r * 128 + lane], g_h = P.SELG[(size_t)r * 128 + 64 + lane];
#pragma unroll 1
        for (int b0 = pb; b0 < pe; b0 += 8) {
            u32x4 uw[8], vw[8];
#pragma unroll
            for (int k = 0; k < 8; ++k) { const int hk = b0 + k; const int e = (hk < 64) ? __builtin_amdgcn_readlane(e_l, hk & 63) : __builtin_amdgcn_readlane(e_h, hk & 63);
                uw[k] = *(const u32x4*)(U + (size_t)e * D_MODEL + 16 * lane); vw[k] = *(const u32x4*)(Vt + (size_t)e * D_MODEL + 16 * lane); }
            float d[8];
#pragma unroll
            for (int k = 0; k < 8; ++k) d[k] = dot16_fp8(uw[k], x2);
            float e4[4], e2[2], e1;
            { const bool hi = lane & 1;
#pragma unroll
              for (int i = 0; i < 4; ++i) { const float keep = hi ? d[4 + i] : d[i], send = hi ? d[i] : d[4 + i]; e4[i] = keep + __shfl_xor(send, 1); } }
            { const bool hi = lane & 2;
#pragma unroll
              for (int i = 0; i < 2; ++i) { const float keep = hi ? e4[2 + i] : e4[i], send = hi ? e4[i] : e4[2 + i]; e2[i] = keep + __shfl_xor(send, 2); } }
            { const bool hi = lane & 4; const float keep = hi ? e2[1] : e2[0], send = hi ? e2[0] : e2[1]; e1 = keep + __shfl_xor(send, 4); }
            e1 += __shfl_xor(e1, 8); e1 += __shfl_xor(e1, 16); e1 += __shfl_xor(e1, 32);
            const int myk = 4 * (lane & 1) + (lane & 2) + ((lane >> 2) & 1); const int myhk = b0 + myk;
            const float myg = (myhk < 64) ? __shfl(g_l, myhk & 63) : __shfl(g_h, myhk & 63);
            const float act = myg * gelu_tanh(e1 * (1.0f / PEER_SU)) * (1.0f / PEER_SV);
#pragma unroll
            for (int k = 0; k < 8; ++k) { const int src = (k >> 2) | (((k >> 1) & 1) << 1) | ((k & 1) << 2); axpy16_fp8(vw[k], rdlane(act, src), o2); }
        }
        if (smp) {
            LAS float* red = (LAS float*)C.lds;
#pragma unroll
            for (int k = 0; k < 8; ++k) { red[C.wave * 1024 + 16 * lane + 2 * k] = o2[k].x; red[C.wave * 1024 + 16 * lane + 2 * k + 1] = o2[k].y; }
            asm volatile("s_waitcnt lgkmcnt(0)" ::: "memory"); __syncthreads();
            if (C.wave == 0) {
#pragma unroll
                for (int k = 0; k < 8; ++k) { float ax = 0.f, ay = 0.f;
#pragma unroll
                    for (int ww = 0; ww < NWAVES; ++ww) { ax += red[ww * 1024 + 16 * lane + 2 * k]; ay += red[ww * 1024 + 16 * lane + 2 * k + 1]; } o2[k] = (f32x2){ax, ay}; } }
            __syncthreads();
            if (C.wave != 0) continue; }
        float s = 0.f;
#pragma unroll
        for (int k = 0; k < 8; ++k) { o2[k] += x2[k] * ALPHA; s += o2[k].x + o2[k].y; }
        const float mu = wave_sum(s) * (1.0f / D_MODEL); float s2 = 0.f;
#pragma unroll
        for (int k = 0; k < 8; ++k) { o2[k] -= mu; s2 += o2[k].x * o2[k].x + o2[k].y * o2[k].y; }
        const float rs = 1.0f / sqrtf(wave_sum(s2) * (1.0f / D_MODEL) + LN_EPS);
        float* frow = (r < M0) ? fout + (size_t)r * D_MODEL : fout_s + (size_t)(r - M0) * D_MODEL;
#pragma unroll
        for (int j = 0; j < 4; ++j) { const int c0 = 16 * lane + 4 * j; const f32x4 gg = *(const f32x4*)(gam + c0), bb = *(const f32x4*)(bet + c0);
            const f32x4 y = (f32x4){o2[2 * j].x * rs, o2[2 * j].y * rs, o2[2 * j + 1].x * rs, o2[2 * j + 1].y * rs} * gg + bb;
            *(f32x4*)(frow + c0) = y; if (xb) *(u32x2*)(xb + (size_t)r * D_MODEL + c0) = pk4(y); }
    }
}
DI void peer_u_phase(const FP& P, const Ctx& C, int layer, const bf16* xb16) {
    const int lane = C.lane; const unsigned char* U = P.UB8 + (size_t)layer * PEER_EXPERTS * D_MODEL;
    const int s = (int)(blockIdx.x & 7), nw = (C.G >> 3) * NWAVES, widx = (int)(blockIdx.x >> 3) * NWAVES + C.wave;
#pragma unroll 1
    for (int r = widx; r < MP; r += nw) {
        const int e0 = P.SELE[(size_t)r * 128 + lane], e1 = P.SELE[(size_t)r * 128 + 64 + lane]; const float g0 = P.SELG[(size_t)r * 128 + lane], g1 = P.SELG[(size_t)r * 128 + 64 + lane];
        unsigned long long b0 = __ballot((e0 >> 11) == s), b1 = __ballot((e1 >> 11) == s);
        if ((b0 | b1) == 0ull) continue;
        f32x2 x2[8]; { const u32x4 xa = *(const u32x4*)(xb16 + (size_t)r * D_MODEL + 16 * lane), xc = *(const u32x4*)(xb16 + (size_t)r * D_MODEL + 16 * lane + 8);
            x2[0] = (f32x2){bflo(xa.x), bfhi(xa.x)}; x2[1] = (f32x2){bflo(xa.y), bfhi(xa.y)}; x2[2] = (f32x2){bflo(xa.z), bfhi(xa.z)}; x2[3] = (f32x2){bflo(xa.w), bfhi(xa.w)};
            x2[4] = (f32x2){bflo(xc.x), bfhi(xc.x)}; x2[5] = (f32x2){bflo(xc.y), bfhi(xc.y)}; x2[6] = (f32x2){bflo(xc.z), bfhi(xc.z)}; x2[7] = (f32x2){bflo(xc.w), bfhi(xc.w)}; }
#pragma unroll 1
        while ((b0 | b1) != 0ull) {
            int hk[8]; u32x4 uw[8]; int nv = 0;
#pragma unroll
            for (int k = 0; k < 8; ++k) { int h;
                if (b0) { h = __builtin_ctzll(b0); b0 &= b0 - 1; ++nv; } else if (b1) { h = 64 + __builtin_ctzll(b1); b1 &= b1 - 1; ++nv; } else h = hk[k > 0 ? k - 1 : 0];
                hk[k] = h; const int e = (h < 64) ? __builtin_amdgcn_readlane(e0, h & 63) : __builtin_amdgcn_readlane(e1, h & 63);
                uw[k] = *(const u32x4*)(U + (size_t)e * D_MODEL + 16 * lane); }
            float d[8];
#pragma unroll
            for (int k = 0; k < 8; ++k) d[k] = dot16_fp8(uw[k], x2);
            float e4[4], e2[2], e1s;
            { const bool hi = lane & 1;
#pragma unroll
              for (int i = 0; i < 4; ++i) { const float keep = hi ? d[4 + i] : d[i], send = hi ? d[i] : d[4 + i]; e4[i] = keep + __shfl_xor(send, 1); } }
            { const bool hi = lane & 2;
#pragma unroll
              for (int i = 0; i < 2; ++i) { const float keep = hi ? e4[2 + i] : e4[i], send = hi ? e4[i] : e4[2 + i]; e2[i] = keep + __shfl_xor(send, 2); } }
            { const bool hi = lane & 4; const float keep = hi ? e2[1] : e2[0], send = hi ? e2[0] : e2[1]; e1s = keep + __shfl_xor(send, 4); }
            e1s += __shfl_xor(e1s, 8); e1s += __shfl_xor(e1s, 16); e1s += __shfl_xor(e1s, 32);
            const int myk = 4 * (lane & 1) + (lane & 2) + ((lane >> 2) & 1);
            int myh = hk[0];
#pragma unroll
            for (int k = 1; k < 8; ++k) myh = (myk == k) ? hk[k] : myh;
            const float ga = __shfl(g0, myh & 63), gb = __shfl(g1, myh & 63); const float myg = (myh < 64) ? ga : gb;
            if (lane < 8 && myk < nv) P.SCO[(size_t)r * 128 + myh] = myg * gelu_tanh(e1s * (1.0f / PEER_SU)) * (1.0f / PEER_SV);
        }
    }
}
DI void peer_v_phase(const FP& P, const Ctx& C, int layer, const float* xin, float* fout, float* fout_s, bf16* xb) {
    const int lane = C.lane; const unsigned char* Vt = P.VB8 + (size_t)layer * PEER_EXPERTS * D_MODEL;
    const float* gam = P.ln_g + ((size_t)layer * 2 + 1) * D_MODEL; const float* bet = P.ln_b + ((size_t)layer * 2 + 1) * D_MODEL;
    const int nrounds = (M0 + C.G * NWAVES - 1) / (C.G * NWAVES);
#pragma unroll 1
    for (int rd = 0; rd <= nrounds; ++rd) {
        const bool smp = (rd == nrounds); int r = smp ? M0 + C.vcu : rd * C.G * NWAVES + C.vcu * NWAVES + C.wave; if (smp ? (C.vcu >= DEC_BATCH) : (r >= M0)) continue;
        const int pb = smp ? 16 * C.wave : 0, pe = smp ? pb + 16 : 128;
        f32x2 x2[8], o2[8];
#pragma unroll
        for (int j = 0; j < 4; ++j) { const f32x4 a = *(const f32x4*)(xin + (size_t)r * D_MODEL + 16 * lane + 4 * j); x2[2 * j] = (f32x2){a.x, a.y}; x2[2 * j + 1] = (f32x2){a.z, a.w}; }
#pragma unroll
        for (int k = 0; k < 8; ++k) o2[k] = (f32x2){0.f, 0.f};
        const int e_l = P.SELE[(size_t)r * 128 + lane], e_h = P.SELE[(size_t)r * 128 + 64 + lane]; const float a_l = P.SCO[(size_t)r * 128 + lane], a_h = P.SCO[(size_t)r * 128 + 64 + lane];
#pragma unroll 1
        for (int b0 = pb; b0 < pe; b0 += 16) { u32x4 vw[16];
#pragma unroll
            for (int k = 0; k < 16; ++k) { const int hk = b0 + k; const int e = (hk < 64) ? __builtin_amdgcn_readlane(e_l, hk & 63) : __builtin_amdgcn_readlane(e_h, hk & 63); vw[k] = *(const u32x4*)(Vt + (size_t)e * D_MODEL + 16 * lane); }
#pragma unroll
            for (int k = 0; k < 16; ++k) { const int hk = b0 + k; axpy16_fp8(vw[k], (hk < 64) ? rdlane(a_l, hk & 63) : rdlane(a_h, hk & 63), o2); } }
        if (smp) {
            LAS float* red = (LAS float*)C.lds;
#pragma unroll
            for (int k = 0; k < 8; ++k) { red[C.wave * 1024 + 16 * lane + 2 * k] = o2[k].x; red[C.wave * 1024 + 16 * lane + 2 * k + 1] = o2[k].y; }
            asm volatile("s_waitcnt lgkmcnt(0)" ::: "memory"); __syncthreads();
            if (C.wave == 0) {
#pragma unroll
                for (int k = 0; k < 8; ++k) { float ax = 0.f, ay = 0.f;
#pragma unroll
                    for (int ww = 0; ww < NWAVES; ++ww) { ax += red[ww * 1024 + 16 * lane + 2 * k]; ay += red[ww * 1024 + 16 * lane + 2 * k + 1]; } o2[k] = (f32x2){ax, ay}; } }
            __syncthreads();
            if (C.wave != 0) continue; }
        float s = 0.f;
#pragma unroll
        for (int k = 0; k < 8; ++k) { o2[k] += x2[k] * ALPHA; s += o2[k].x + o2[k].y; }
        const float mu = wave_sum(s) * (1.0f / D_MODEL); float s2 = 0.f;
#pragma unroll
        for (int k = 0; k < 8; ++k) { o2[k] -= mu; s2 += o2[k].x * o2[k].x + o2[k].y * o2[k].y; }
        const float rs = 1.0f / sqrtf(wave_sum(s2) * (1.0f / D_MODEL) + LN_EPS);
        float* frow = (r < M0) ? fout + (size_t)r * D_MODEL : fout_s + (size_t)(r - M0) * D_MODEL;
#pragma unroll
        for (int j = 0; j < 4; ++j) { const int c0 = 16 * lane + 4 * j; const f32x4 gg = *(const f32x4*)(gam + c0), bb = *(const f32x4*)(bet + c0);
            const f32x4 y = (f32x4){o2[2 * j].x * rs, o2[2 * j].y * rs, o2[2 * j + 1].x * rs, o2[2 * j + 1].y * rs} * gg + bb;
            *(f32x4*)(frow + c0) = y; if (xb) *(u32x2*)(xb + (size_t)r * D_MODEL + c0) = pk4(y); }
    }
}
constexpr int PSH_LIST = 512;
struct PG4 { u32x4 u[4], v[4]; };
DI void peer_sharded_phase(const FP& P, const Ctx& C, int layer, const float* xin, const bf16* xb16, float* fout, float* fout_s, bf16* xb) {
    const int lane = C.lane; const unsigned char* U = P.UB8 + (size_t)layer * PEER_EXPERTS * D_MODEL; const unsigned char* Vt = P.VB8 + (size_t)layer * PEER_EXPERTS * D_MODEL;
    const float* gam = P.ln_g + ((size_t)layer * 2 + 1) * D_MODEL; const float* bet = P.ln_b + ((size_t)layer * 2 + 1) * D_MODEL;
    LAS unsigned char* wl = C.lds + C.wave * 16384; LAS bf16* xs = (LAS bf16*)wl; LAS int* lst = (LAS int*)(wl + 8192);
    const int NW = C.G * NWAVES, gw = C.vcu * NWAVES + C.wave; const int nquads = (M0 / NW) / 4;
#pragma unroll 1
    for (int qd = 0; qd < nquads; ++qd) {
#define PSH_ROW(j) const int row##j = (qd * 4 + j) * NW + gw; const int el##j = P.SELE[(size_t)row##j * 128 + lane], eh##j = P.SELE[(size_t)row##j * 128 + 64 + lane]; const float gl##j = P.SELG[(size_t)row##j * 128 + lane], gh##j = P.SELG[(size_t)row##j * 128 + 64 + lane]; \
        { const u32x4 xa = *(const u32x4*)(xb16 + (size_t)row##j * D_MODEL + 16 * lane), xc = *(const u32x4*)(xb16 + (size_t)row##j * D_MODEL + 16 * lane + 8); *(LAS u32x4*)(xs + j * 1024 + 16 * lane) = xa; *(LAS u32x4*)(xs + j * 1024 + 16 * lane + 8) = xc; } \
        f32x2 oa##j[8]; _Pragma("unroll") for (int k = 0; k < 8; ++k) oa##j[k] = (f32x2){0.f, 0.f};
        PSH_ROW(0) PSH_ROW(1) PSH_ROW(2) PSH_ROW(3)
#pragma unroll 1
        for (int s = 0; s < 16; ++s) {
            int n = 0;
#define PSH_SCAN(j) { unsigned long long b0 = __ballot((el##j >> 10) == s), b1 = __ballot((eh##j >> 10) == s); \
                while (b0) { const int h = __builtin_ctzll(b0); b0 &= b0 - 1; const int e = __builtin_amdgcn_readlane(el##j, h); const int g = __builtin_amdgcn_readlane(__builtin_bit_cast(int, gl##j), h); \
                    if (lane == 0) { lst[4 * n] = e; lst[4 * n + 1] = g; lst[4 * n + 2] = j; } ++n; } \
                while (b1) { const int h = __builtin_ctzll(b1); b1 &= b1 - 1; const int e = __builtin_amdgcn_readlane(eh##j, h); const int g = __builtin_amdgcn_readlane(__builtin_bit_cast(int, gh##j), h); \
                    if (lane == 0) { lst[4 * n] = e; lst[4 * n + 1] = g; lst[4 * n + 2] = j; } ++n; } }
            PSH_SCAN(0) PSH_SCAN(1) PSH_SCAN(2) PSH_SCAN(3)
            asm volatile("s_waitcnt lgkmcnt(0)" ::: "memory");
            if (n == 0) continue;
            const int ngrp = (n + 3) >> 2;
#define PSH_LD(b, gi_) do { const int gi = (gi_); _Pragma("unroll") for (int k = 0; k < 4; ++k) { int i = 4 * gi + k; i = i < n ? i : n - 1; const int e = __builtin_amdgcn_readfirstlane(lst[4 * i]); \
                b.u[k] = *(const u32x4*)(U + (size_t)e * D_MODEL + 16 * lane); b.v[k] = *(const u32x4*)(Vt + (size_t)e * D_MODEL + 16 * lane); } } while (0)
#define PSH_CP(b, gi_) do { const int gi = (gi_); float d[4]; int jj[4]; float gg[4]; \
                _Pragma("unroll") for (int k = 0; k < 4; ++k) { int i = 4 * gi + k; const bool val = i < n; i = val ? i : n - 1; jj[k] = __builtin_amdgcn_readfirstlane(lst[4 * i + 2]); gg[k] = val ? __builtin_bit_cast(float, __builtin_amdgcn_readfirstlane(lst[4 * i + 1])) : 0.f; \
                    const u32x4 xa = *(const LAS u32x4*)(xs + jj[k] * 1024 + 16 * lane), xc = *(const LAS u32x4*)(xs + jj[k] * 1024 + 16 * lane + 8); \
                    const f32x2 x2[8] = {(f32x2){bflo(xa.x), bfhi(xa.x)}, (f32x2){bflo(xa.y), bfhi(xa.y)}, (f32x2){bflo(xa.z), bfhi(xa.z)}, (f32x2){bflo(xa.w), bfhi(xa.w)}, (f32x2){bflo(xc.x), bfhi(xc.x)}, (f32x2){bflo(xc.y), bfhi(xc.y)}, (f32x2){bflo(xc.z), bfhi(xc.z)}, (f32x2){bflo(xc.w), bfhi(xc.w)}}; \
                    d[k] = dot16_fp8(b.u[k], x2); } \
                float e2[2], e1; \
                { const bool hi = lane & 1; _Pragma("unroll") for (int i = 0; i < 2; ++i) { const float keep = hi ? d[2 + i] : d[i], send = hi ? d[i] : d[2 + i]; e2[i] = keep + __shfl_xor(send, 1); } } \
                { const bool hi = lane & 2; const float keep = hi ? e2[1] : e2[0], send = hi ? e2[0] : e2[1]; e1 = keep + __shfl_xor(send, 2); } \
                e1 += __shfl_xor(e1, 4); e1 += __shfl_xor(e1, 8); e1 += __shfl_xor(e1, 16); e1 += __shfl_xor(e1, 32); \
                const int myk = 2 * (lane & 1) + ((lane >> 1) & 1); \
                float myg = gg[0]; myg = (myk == 1) ? gg[1] : myg; myg = (myk == 2) ? gg[2] : myg; myg = (myk == 3) ? gg[3] : myg; \
                const float act = myg * gelu_tanh(e1 * (1.0f / PEER_SU)) * (1.0f / PEER_SV); \
                _Pragma("unroll") for (int k = 0; k < 4; ++k) { const float a = rdlane(act, (k >> 1) | ((k & 1) << 1)); \
                    if (jj[k] == 0) axpy16_fp8(b.v[k], a, oa0); else if (jj[k] == 1) axpy16_fp8(b.v[k], a, oa1); else if (jj[k] == 2) axpy16_fp8(b.v[k], a, oa2); else axpy16_fp8(b.v[k], a, oa3); } } while (0)
            { PG4 A, B; PSH_LD(A, 0);
#pragma unroll 1
              for (int g2 = 0; g2 < ngrp; g2 += 2) { PSH_LD(B, (g2 + 1 < ngrp) ? g2 + 1 : g2); PSH_CP(A, g2); PSH_LD(A, (g2 + 2 < ngrp) ? g2 + 2 : g2); if (g2 + 1 < ngrp) PSH_CP(B, g2 + 1); } }
            asm volatile("s_waitcnt lgkmcnt(0)" ::: "memory");
        }
#define PSH_LN(j) { const int r = row##j; f32x2 x2[8]; \
            _Pragma("unroll") for (int q = 0; q < 4; ++q) { const f32x4 a = *(const f32x4*)(xin + (size_t)r * D_MODEL + 16 * lane + 4 * q); x2[2 * q] = (f32x2){a.x, a.y}; x2[2 * q + 1] = (f32x2){a.z, a.w}; } \
            float sm = 0.f; _Pragma("unroll") for (int k = 0; k < 8; ++k) { oa##j[k] += x2[k] * ALPHA; sm += oa##j[k].x + oa##j[k].y; } \
            const float mu = wave_sum(sm) * (1.0f / D_MODEL); float s2 = 0.f; _Pragma("unroll") for (int k = 0; k < 8; ++k) { oa##j[k] -= mu; s2 += oa##j[k].x * oa##j[k].x + oa##j[k].y * oa##j[k].y; } \
            const float rs = 1.0f / sqrtf(wave_sum(s2) * (1.0f / D_MODEL) + LN_EPS); float* frow = fout + (size_t)r * D_MODEL; \
            _Pragma("unroll") for (int q = 0; q < 4; ++q) { const int c0 = 16 * lane + 4 * q; const f32x4 gv = *(const f32x4*)(gam + c0), bv = *(const f32x4*)(bet + c0); \
                const f32x4 y = (f32x4){oa##j[2 * q].x * rs, oa##j[2 * q].y * rs, oa##j[2 * q + 1].x * rs, oa##j[2 * q + 1].y * rs} * gv + bv; *(f32x4*)(frow + c0) = y; if (xb) *(u32x2*)(xb + (size_t)r * D_MODEL + c0) = pk4(y); } }
        PSH_LN(0) PSH_LN(1) PSH_LN(2) PSH_LN(3)
        asm volatile("s_waitcnt lgkmcnt(0)" ::: "memory");
    }
}
constexpr int PSH_LOG = 11, PSH_N = PEER_EXPERTS >> PSH_LOG;
#ifndef PS2_ROWS
#define PS2_ROWS 4
#endif
#define PS2_ROW(j) const int row##j = (qd * PS2_ROWS + j) * NW + gw; const int el##j = P.SELE[(size_t)row##j * 128 + lane], eh##j = P.SELE[(size_t)row##j * 128 + 64 + lane]; const float gl##j = P.SELG[(size_t)row##j * 128 + lane], gh##j = P.SELG[(size_t)row##j * 128 + 64 + lane]; \
    f32x2 oa##j[8]; _Pragma("unroll") for (int k = 0; k < 8; ++k) oa##j[k] = (f32x2){0.f, 0.f};
#define PS2_STEP(j) { unsigned long long b0 = __ballot((el##j >> PSH_LOG) == s), b1 = __ballot((eh##j >> PSH_LOG) == s); \
    if (b0 | b1) { const u32x4 xa##j = *(const u32x4*)(xb16 + (size_t)row##j * D_MODEL + 16 * lane), xc##j = *(const u32x4*)(xb16 + (size_t)row##j * D_MODEL + 16 * lane + 8);     \
      const f32x2 x2[8] = {(f32x2){bflo(xa##j.x), bfhi(xa##j.x)}, (f32x2){bflo(xa##j.y), bfhi(xa##j.y)}, (f32x2){bflo(xa##j.z), bfhi(xa##j.z)}, (f32x2){bflo(xa##j.w), bfhi(xa##j.w)}, (f32x2){bflo(xc##j.x), bfhi(xc##j.x)}, (f32x2){bflo(xc##j.y), bfhi(xc##j.y)}, (f32x2){bflo(xc##j.z), bfhi(xc##j.z)}, (f32x2){bflo(xc##j.w), bfhi(xc##j.w)}}; \
      _Pragma("unroll 1") while ((b0 | b1) != 0ull) { int hk[8]; u32x4 uw[8], vw[8]; int nv = 0; \
        _Pragma("unroll") for (int k = 0; k < 8; ++k) { int h; if (b0) { h = __builtin_ctzll(b0); b0 &= b0 - 1; ++nv; } else if (b1) { h = 64 + __builtin_ctzll(b1); b1 &= b1 - 1; ++nv; } else h = hk[k > 0 ? k - 1 : 0]; \
            hk[k] = h; const int e = (h < 64) ? __builtin_amdgcn_readlane(el##j, h & 63) : __builtin_amdgcn_readlane(eh##j, h & 63); \
            uw[k] = *(const u32x4*)(U + (size_t)e * D_MODEL + 16 * lane); vw[k] = *(const u32x4*)(Vt + (size_t)e * D_MODEL + 16 * lane); } \
        float d[8]; _Pragma("unroll") for (int k = 0; k < 8; ++k) d[k] = dot16_fp8(uw[k], x2); \
        float e4[4], e2[2], e1s; \
        { const bool hi = lane & 1; _Pragma("unroll") for (int i = 0; i < 4; ++i) { const float keep = hi ? d[4 + i] : d[i], send = hi ? d[i] : d[4 + i]; e4[i] = keep + __shfl_xor(send, 1); } } \
        { const bool hi = lane & 2; _Pragma("unroll") for (int i = 0; i < 2; ++i) { const float keep = hi ? e4[2 + i] : e4[i], send = hi ? e4[i] : e4[2 + i]; e2[i] = keep + __shfl_xor(send, 2); } } \
        { const bool hi = lane & 4; const float keep = hi ? e2[1] : e2[0], send = hi ? e2[0] : e2[1]; e1s = keep + __shfl_xor(send, 4); } \
        e1s += __shfl_xor(e1s, 8); e1s += __shfl_xor(e1s, 16); e1s += __shfl_xor(e1s, 32); \
        const int myk = 4 * (lane & 1) + (lane & 2) + ((lane >> 2) & 1); int myh = hk[0]; _Pragma("unroll") for (int k = 1; k < 8; ++k) myh = (myk == k) ? hk[k] : myh; \
        const float ga = __shfl(gl##j, myh & 63), gb = __shfl(gh##j, myh & 63); const float myg = (myk < nv) ? ((myh < 64) ? ga : gb) : 0.f;     \
        const float act = myg * gelu_tanh(e1s * (1.0f / PEER_SU)) * (1.0f / PEER_SV); \
        _Pragma("unroll") for (int k = 0; k < 8; ++k) { const int src = (k >> 2) | (((k >> 1) & 1) << 1) | ((k & 1) << 2); axpy16_fp8(vw[k], rdlane(act, src), oa##j); } } } }
#define PS2_LN(j) { const int r = row##j; f32x2 x2[8]; \
    _Pragma("unroll") for (int q = 0; q < 4; ++q) { const f32x4 a = *(const f32x4*)(xin + (size_t)r * D_MODEL + 16 * lane + 4 * q); x2[2 * q] = (f32x2){a.x, a.y}; x2[2 * q + 1] = (f32x2){a.z, a.w}; } \
    float sm = 0.f; _Pragma("unroll") for (int k = 0; k < 8; ++k) { oa##j[k] += x2[k] * ALPHA; sm += oa##j[k].x + oa##j[k].y; } \
    const float mu = wave_sum(sm) * (1.0f / D_MODEL); float s2 = 0.f; _Pragma("unroll") for (int k = 0; k < 8; ++k) { oa##j[k] -= mu; s2 += oa##j[k].x * oa##j[k].x + oa##j[k].y * oa##j[k].y; } \
    const float rs = 1.0f / sqrtf(wave_sum(s2) * (1.0f / D_MODEL) + LN_EPS); float* frow = fout + (size_t)r * D_MODEL; \
    _Pragma("unroll") for (int q = 0; q < 4; ++q) { const int c0 = 16 * lane + 4 * q; const f32x4 gv = *(const f32x4*)(gam + c0), bv = *(const f32x4*)(bet + c0); \
        const f32x4 y = (f32x4){oa##j[2 * q].x * rs, oa##j[2 * q].y * rs, oa##j[2 * q + 1].x * rs, oa##j[2 * q + 1].y * rs} * gv + bv; *(f32x4*)(frow + c0) = y; if (xb) *(u32x2*)(xb + (size_t)r * D_MODEL + c0) = pk4(y); } }
DI void peer_sharded2_phase(const FP& P, const Ctx& C, int layer, const float* xin, const bf16* xb16, float* fout, bf16* xb) {
    const int lane = C.lane; const unsigned char* U = P.UB8 + (size_t)layer * PEER_EXPERTS * D_MODEL; const unsigned char* Vt = P.VB8 + (size_t)layer * PEER_EXPERTS * D_MODEL;
    const float* gam = P.ln_g + ((size_t)layer * 2 + 1) * D_MODEL; const float* bet = P.ln_b + ((size_t)layer * 2 + 1) * D_MODEL;
    const int NW = C.G * NWAVES, gw = C.vcu * NWAVES + C.wave; const int nquads = (M0 / NW) / PS2_ROWS;
#pragma unroll 1
    for (int qd = 0; qd < nquads; ++qd) {
#if PS2_ROWS == 4
        PS2_ROW(0) PS2_ROW(1) PS2_ROW(2) PS2_ROW(3)
#pragma unroll 1
        for (int s = 0; s < PSH_N; ++s) { PS2_STEP(0) PS2_STEP(1) PS2_STEP(2) PS2_STEP(3) }
        PS2_LN(0) PS2_LN(1) PS2_LN(2) PS2_LN(3)
#else
        PS2_ROW(0) PS2_ROW(1)
#pragma unroll 1
        for (int s = 0; s < PSH_N; ++s) { PS2_STEP(0) PS2_STEP(1) }
        PS2_LN(0) PS2_LN(1)
#endif
    }
}
}
namespace fx {
struct EpiB {
    static constexpr bool PERM = true, AFTER_DRAIN = false; const FP& P;
    DI void operator()(const f32x4 (&acc)[2][2][4][2], const pg8::Unit& u, int wr, int wc, int fr, int fq) const {
        const int t = u.pn;
        EPI_LOOP({ if (row < MP) { const int pos = row_pos(row), n = row / SEQ, e = ct & 63, dp = e >> 1; const bool prm = row < M0;
            if (t < 3) { const int ty = 2 * t + (ct >> 7), kvh = (ct >> 6) & 1;
                if (ty == 2 || ty == 4) { f32x4 lo, hi; rope4(P.ROPE + pos * 64, dp, v0, v1, lo, hi);
                    if (ty == 2) { float* o = (prm ? P.nsa_kv_p + (size_t)row * 512 : P.nsa_kv_s + (size_t)(row - M0) * 512) + 256 + kvh * 64 + dp; *(f32x4*)o = lo; *(f32x4*)(o + 32) = hi;
                        if (prm) { bf16* kt = P.SLK + ((size_t)n * NSA_KV_HEADS + kvh) * SEQ * 64; *(u32x2*)(kt + ktile_off(pos, dp)) = pk4(lo); *(u32x2*)(kt + ktile_off(pos, dp + 32)) = pk4(hi); } }
                    else { float* o = nullptr; if (!prm) o = P.win_s + (((size_t)(row - M0) * SWA_WINDOW + SWA_WINDOW - 1) * 2 + 0) * 128; else if (pos >= SEQ - SWA_WINDOW) o = P.win_p + (((size_t)n * SWA_WINDOW + pos - (SEQ - SWA_WINDOW)) * 2 + 0) * 128;
                        if (o) { *(f32x4*)(o + kvh * 64 + dp) = lo; *(f32x4*)(o + kvh * 64 + 32 + dp) = hi; }
                        if (prm) { bf16* kt = P.WNK + ((size_t)n * NSA_KV_HEADS + kvh) * SEQ * 64; *(u32x2*)(kt + ktile_off(pos, dp)) = pk4(lo); *(u32x2*)(kt + ktile_off(pos, dp + 32)) = pk4(hi); } } }
                else if (ty < 4) { float* o = (prm ? P.nsa_kv_p + (size_t)row * 512 : P.nsa_kv_s + (size_t)(row - M0) * 512) + ty * 128 + kvh * 64 + e; *(f32x4*)o = v0; *(f32x4*)(o + 4) = v1;
                    if (prm) { if (ty < 2) *(u32x4*)(P.AC + ((size_t)ty * ACROWS + ((size_t)n * NSA_KV_HEADS + kvh) * NCH + pos / 16) * 1024 + (pos % 16) * 64 + e) = pk8(v0, v1);
                        else { bf16* vt = P.SLVT + ((size_t)n * NSA_KV_HEADS + kvh) * SEQ * 64 + vtile_off(e, pos);
                            vt[0] = (bf16)f2bf(v0.x); vt[8] = (bf16)f2bf(v0.y); vt[16] = (bf16)f2bf(v0.z); vt[24] = (bf16)f2bf(v0.w); vt[32] = (bf16)f2bf(v1.x); vt[40] = (bf16)f2bf(v1.y); vt[48] = (bf16)f2bf(v1.z); vt[56] = (bf16)f2bf(v1.w); } } }
                else { float* o = nullptr; if (!prm) o = P.win_s + (((size_t)(row - M0) * SWA_WINDOW + SWA_WINDOW - 1) * 2 + 1) * 128; else if (pos >= SEQ - SWA_WINDOW) o = P.win_p + (((size_t)n * SWA_WINDOW + pos - (SEQ - SWA_WINDOW)) * 2 + 1) * 128;
                    if (o) { *(f32x4*)(o + kvh * 64 + e) = v0; *(f32x4*)(o + kvh * 64 + e + 4) = v1; }
                    if (prm) { bf16* vt = P.WNVT + ((size_t)n * NSA_KV_HEADS + kvh) * SEQ * 64 + vtile_off(e, pos);
                        vt[0] = (bf16)f2bf(v0.x); vt[8] = (bf16)f2bf(v0.y); vt[16] = (bf16)f2bf(v0.z); vt[24] = (bf16)f2bf(v0.w); vt[32] = (bf16)f2bf(v1.x); vt[40] = (bf16)f2bf(v1.y); vt[48] = (bf16)f2bf(v1.z); vt[56] = (bf16)f2bf(v1.w); } } }
            else if (t < 6) { const int h = (t - 3) * 4 + (ct >> 6); f32x4 lo, hi; rope4(P.ROPE + pos * 64, dp, v0, v1, lo, hi); bf16* q = P.QB + (size_t)row * NSA_Q_COLS + h * 64 + dp; *(u32x2*)q = pk4(lo * QSCALE); *(u32x2*)(q + 32) = pk4(hi * QSCALE); }
            else if (t == 6) { *(u32x4*)(P.MQB + (size_t)row * 256 + ct) = pk8(v0 * QSCALE, v1 * QSCALE); }
            else if (ct < 40) { const float vv[8] = {v0.x, v0.y, v0.z, v0.w, v1.x, v1.y, v1.z, v1.w};
                _Pragma("unroll") for (int i = 0; i < 8; ++i) if (ct + i < NSA_GATE_COLS) P.GATES[(size_t)row * 64 + ct + i] = 1.0f / (1.0f + __expf(-vv[i])); } } })
    }
};
DI void cmp2_phase(const FP& P, const Ctx& C) {
    const int lane = C.lane; LAS float* hs = (LAS float*)(C.lds + C.wave * 1024);
    constexpr int NGRP = NCTX * 2 * NSA_KV_HEADS; const int NW = C.G * NWAVES, WPG = NW / NGRP > 0 ? NW / NGRP : 1; const int gw = C.vcu * NWAVES + C.wave;
#pragma unroll 1
    for (int grp = gw / WPG; grp < NGRP; grp += (NW + WPG - 1) / WPG) { const int slot = gw % WPG; if (gw >= (NW / WPG) * WPG && grp == gw / WPG) break;
        const int kvh = grp % NSA_KV_HEADS, ty = (grp / NSA_KV_HEADS) % 2, ctx = grp / (2 * NSA_KV_HEADS);
        const float* UL = P.UL + ((size_t)ty * ACROWS + ((size_t)ctx * NSA_KV_HEADS + kvh) * NCH) * 256; const float* w2 = P.cmp_w2 + (size_t)ty * CMP_HIDDEN * HEAD_DIM;
        float w2r[CMP_HIDDEN];
#pragma unroll
        for (int k = 0; k < CMP_HIDDEN; ++k) w2r[k] = w2[k * HEAD_DIM + lane];
        const float b0 = P.CBIAS[ty * CMP_HIDDEN + lane], b1 = P.CBIAS[ty * CMP_HIDDEN + 64 + lane];
        float u0, u1, l0, l1; int c = slot;
        if (c < NCMP) { u0 = UL[(size_t)c * 256 + lane]; u1 = UL[(size_t)c * 256 + 64 + lane]; l0 = UL[(size_t)(c + 1) * 256 + 128 + lane]; l1 = UL[(size_t)(c + 1) * 256 + 192 + lane]; }
#pragma unroll 1
        for (; c < NCMP; c += WPG) { const float h0 = gelu_tanh(u0 + l0 + b0), h1 = gelu_tanh(u1 + l1 + b1); const int cn = c + WPG;
            if (cn < NCMP) { u0 = UL[(size_t)cn * 256 + lane]; u1 = UL[(size_t)cn * 256 + 64 + lane]; l0 = UL[(size_t)(cn + 1) * 256 + 128 + lane]; l1 = UL[(size_t)(cn + 1) * 256 + 192 + lane]; }
            hs[lane] = h0; hs[64 + lane] = h1; asm volatile("s_waitcnt lgkmcnt(0)" ::: "memory");
            float a = 0.f;
#pragma unroll
            for (int k4 = 0; k4 < CMP_HIDDEN / 4; ++k4) { const f32x4 hv = *(const LAS f32x4*)(hs + 4 * k4); a += hv.x * w2r[4 * k4] + hv.y * w2r[4 * k4 + 1] + hv.z * w2r[4 * k4 + 2] + hv.w * w2r[4 * k4 + 3]; }
            if (ty == 0) { const float other = __shfl_xor(a, 32); const int pos = c * CMP_STRIDE + CMP_BLOCK - 1; const float cs = P.ROPE[pos * 64 + (lane & 31)], sn = P.ROPE[pos * 64 + 32 + (lane & 31)];
                a = (lane < 32) ? a * cs - other * sn : a * cs + other * sn; }
            if (ctx < BATCH) { if (ty == 0) P.CK[((size_t)ctx * NSA_KV_HEADS + kvh) * NCH * 64 + ktile_off(c, lane)] = (bf16)f2bf(a); else P.CVT[((size_t)ctx * NSA_KV_HEADS + kvh) * NCH * 64 + vtile_off(lane, c)] = (bf16)f2bf(a); }
            else { (ty == 0 ? P.CKF : P.CVF)[(((size_t)(ctx - BATCH) * NSA_KV_HEADS + kvh) * NCH + c) * 64 + lane] = a; }
            asm volatile("s_waitcnt lgkmcnt(0)" ::: "memory"); }
    }
    __syncthreads();
}
constexpr int NSA_WLDS = 8192;
DI void nsa_pair_a(const FP& P, int n, int kvh, int t, int lane, LAS unsigned char* wl) {
    LAS float* pn = (LAS float*)wl; LAS float* imp = (LAS float*)(wl + 2048); LAS float* sc = (LAS float*)(wl + 6144); LAS int* sel = (LAS int*)(wl + 7168);
    const int col = lane & 15, c = lane >> 4; const bool vcol = col < 12; const int qq = vcol ? col / 6 : 0, hh = vcol ? col % 6 : 0, tq = t + qq, head = kvh * NSA_GROUP + hh, row = n * SEQ + tq;
    bf16x8 qf[2]; { const bf16* qp = P.QB + (size_t)row * NSA_Q_COLS + head * 64 + 8 * c; qf[0] = *(const bf16x8*)qp; qf[1] = *(const bf16x8*)(qp + 32); }
    const float* gt = P.GATES + (size_t)row * 64 + head * 3;
    f32x4 oacc[4] = {(f32x4){0.f, 0.f, 0.f, 0.f}, (f32x4){0.f, 0.f, 0.f, 0.f}, (f32x4){0.f, 0.f, 0.f, 0.f}, (f32x4){0.f, 0.f, 0.f, 0.f}};
    const int lim = vcol ? ((tq >= CMP_BLOCK - 1) ? (tq - (CMP_BLOCK - 1)) / CMP_STRIDE : -1) : -1;
    const int limmax = (t + 1 >= CMP_BLOCK - 1) ? (t + 1 - (CMP_BLOCK - 1)) / CMP_STRIDE : -1; const int nblk = (limmax + 32) / 32;
    const bf16* CKb = P.CK + ((size_t)n * NSA_KV_HEADS + kvh) * NCH * 64; const bf16* CVb = P.CVT + ((size_t)n * NSA_KV_HEADS + kvh) * 64 * NCH;
    for (int i = lane; i < 1024; i += 64) imp[i] = 0.f;
    float m1 = -INFINITY, l1 = 0.f;
    { struct K4 { bf16x8 a0, a1, b0, b1; };
      auto ldk = [&](K4& k, int blk) { const bf16* kt = CKb + (size_t)blk * 2048 + lane * 8; k.a0 = *(const bf16x8*)kt; k.a1 = *(const bf16x8*)(kt + 512); k.b0 = *(const bf16x8*)(kt + 1024); k.b1 = *(const bf16x8*)(kt + 1536); };
      auto cp1 = [&](const K4& k, int blk) { const int kb = 32 * blk;
        f32x4 s0 = (f32x4){0.f, 0.f, 0.f, 0.f}, s1 = (f32x4){0.f, 0.f, 0.f, 0.f};
        s0 = __builtin_amdgcn_mfma_f32_16x16x32_bf16(k.a0, qf[0], s0, 0, 0, 0); s0 = __builtin_amdgcn_mfma_f32_16x16x32_bf16(k.a1, qf[1], s0, 0, 0, 0);
        s1 = __builtin_amdgcn_mfma_f32_16x16x32_bf16(k.b0, qf[0], s1, 0, 0, 0); s1 = __builtin_amdgcn_mfma_f32_16x16x32_bf16(k.b1, qf[1], s1, 0, 0, 0);
        float s[8] = {s0.x, s0.y, s0.z, s0.w, s1.x, s1.y, s1.z, s1.w}; float mx = -INFINITY;
#pragma unroll
        for (int e = 0; e < 8; ++e) { s[e] = (kb + 8 * c + e <= lim) ? s[e] : -INFINITY; mx = fmaxf(mx, s[e]); }
        mx = fmaxf(mx, __shfl_xor(mx, 16)); mx = fmaxf(mx, __shfl_xor(mx, 32));
        const float mnew = fmaxf(m1, mx), muse = (mnew == -INFINITY) ? 0.f : mnew; float ls = 0.f;
#pragma unroll
        for (int e = 0; e < 8; ++e) ls += __builtin_amdgcn_exp2f(s[e] - muse);
        ls += __shfl_xor(ls, 16); ls += __shfl_xor(ls, 32);
        l1 = l1 * __builtin_amdgcn_exp2f(m1 - muse) + ls; m1 = mnew; };
      if (nblk > 0) { K4 A, B; ldk(A, 0);
#pragma unroll 1
        for (int blk = 0; blk < nblk; blk += 2) { ldk(B, (blk + 1 < nblk) ? blk + 1 : blk); cp1(A, blk); ldk(A, (blk + 2 < nblk) ? blk + 2 : blk); if (blk + 1 < nblk) cp1(B, blk + 1); } } }
    asm volatile("s_waitcnt lgkmcnt(0)" ::: "memory");
    { const float muse = (m1 == -INFINITY) ? 0.f : m1, inv = (l1 > 0.f) ? 1.0f / l1 : 0.f;
      f32x4 oc[4] = {(f32x4){0.f, 0.f, 0.f, 0.f}, (f32x4){0.f, 0.f, 0.f, 0.f}, (f32x4){0.f, 0.f, 0.f, 0.f}, (f32x4){0.f, 0.f, 0.f, 0.f}};
      pipe2(nblk, [&](KV8& kv, int blk) { kv_load_t(kv, CKb + (size_t)blk * 2048, CVb + (size_t)blk * 2048, lane); }, [&](const KV8& kv, int blk) { const int kb = 32 * blk;
        f32x4 s0 = (f32x4){0.f, 0.f, 0.f, 0.f}, s1 = (f32x4){0.f, 0.f, 0.f, 0.f};
        s0 = __builtin_amdgcn_mfma_f32_16x16x32_bf16(kv.ka0, qf[0], s0, 0, 0, 0); s0 = __builtin_amdgcn_mfma_f32_16x16x32_bf16(kv.ka1, qf[1], s0, 0, 0, 0);
        s1 = __builtin_amdgcn_mfma_f32_16x16x32_bf16(kv.kb0, qf[0], s1, 0, 0, 0); s1 = __builtin_amdgcn_mfma_f32_16x16x32_bf16(kv.kb1, qf[1], s1, 0, 0, 0);
        float s[8] = {s0.x, s0.y, s0.z, s0.w, s1.x, s1.y, s1.z, s1.w};
#pragma unroll
        for (int e = 0; e < 8; ++e) s[e] = (kb + 8 * c + e <= lim) ? __builtin_amdgcn_exp2f(s[e] - muse) * inv : 0.f;
        *(f32x4*)(pn + col * 32 + 8 * c) = (f32x4){s[0], s[1], s[2], s[3]}; *(f32x4*)(pn + col * 32 + 8 * c + 4) = (f32x4){s[4], s[5], s[6], s[7]};
        u32x4 pw; pw.x = cvtpk(s[0], s[1]); pw.y = cvtpk(s[2], s[3]); pw.z = cvtpk(s[4], s[5]); pw.w = cvtpk(s[6], s[7]); const bf16x8 pf = __builtin_bit_cast(bf16x8, pw);
        oc[0] = __builtin_amdgcn_mfma_f32_16x16x32_bf16(kv.v0, pf, oc[0], 0, 0, 0); oc[1] = __builtin_amdgcn_mfma_f32_16x16x32_bf16(kv.v1, pf, oc[1], 0, 0, 0);
        oc[2] = __builtin_amdgcn_mfma_f32_16x16x32_bf16(kv.v2, pf, oc[2], 0, 0, 0); oc[3] = __builtin_amdgcn_mfma_f32_16x16x32_bf16(kv.v3, pf, oc[3], 0, 0, 0);
        asm volatile("s_waitcnt lgkmcnt(0)" ::: "memory");
        { const int q2 = lane >> 5, k = lane & 31; float a = 0.f;
#pragma unroll
          for (int h6 = 0; h6 < 6; ++h6) a += pn[(q2 * 6 + h6) * 32 + k];
          imp[q2 * 512 + kb + k] = a; }
        asm volatile("s_waitcnt lgkmcnt(0)" ::: "memory"); });
#ifdef NSA_DEBUG
      if (vcol) { for (int db = 0; db < 4; ++db) *(f32x4*)(P.DBG + ((size_t)0 * MP + row) * 768 + head * 64 + 16 * db + 4 * c) = oc[db]; }
#endif
      const float g0 = vcol ? gt[0] : 0.f;
#pragma unroll
      for (int db = 0; db < 4; ++db) oacc[db] += oc[db] * g0; }
#ifndef REP_SEL
#define REP_SEL 1
#endif
#pragma unroll 1
    for (int rep = 0; rep < REP_SEL; ++rep) {
    for (int i = lane; i < 256; i += 64) { const int q2 = i >> 7, b = i & 127, tq2 = t + q2, cur = tq2 / SLC_BLOCK; float sv;
        if (b > cur) sv = NEG; else if (b == 0 || b == cur || b == cur - 1) sv = FORCE_SCORE;
        else { const LAS float* ic = imp + q2 * 512 + 4 * b; sv = ic[-1] + 2.f * (ic[0] + ic[1] + ic[2]) + ic[3]; }
        sc[i] = sv; }
    asm volatile("s_waitcnt lgkmcnt(0)" ::: "memory");
    for (int i = lane; i < 256; i += 64) { const int q2 = i >> 7, b = i & 127; const float sv = sc[i]; int rank = 0;
        for (int j = 0; j < 128; j += 4) { const f32x4 o = *(const LAS f32x4*)(sc + q2 * 128 + j);
            rank += (o.x > sv || (o.x == sv && j < b)) ? 1 : 0; rank += (o.y > sv || (o.y == sv && j + 1 < b)) ? 1 : 0; rank += (o.z > sv || (o.z == sv && j + 2 < b)) ? 1 : 0; rank += (o.w > sv || (o.w == sv && j + 3 < b)) ? 1 : 0; }
        if (rank < SLC_TOPK) { const int v = (sv > 0.5f * NEG) ? b : -1; sel[q2 * 16 + rank] = v; P.SELB[((size_t)(n * SEQ + t + q2) * NSA_KV_HEADS + kvh) * 16 + rank] = v; } }
    asm volatile("s_waitcnt lgkmcnt(0)" ::: "memory");
    }
#ifndef REP_WIN
#define REP_WIN 1
#endif
#pragma unroll 1
    for (int rep = 0; rep < REP_WIN; ++rep) { Tile16 T; tile_init(T);
      const bf16* WKb = P.WNK + ((size_t)n * NSA_KV_HEADS + kvh) * SEQ * 64; const bf16* WVb = P.WNVT + ((size_t)n * NSA_KV_HEADS + kvh) * 64 * SEQ;
      const int blo = (t - SWA_WINDOW) >> 5, bhi = (t + 1) >> 5;
      auto ld = [&](KV8& kv, int blk) { const int bc = blk < 0 ? 0 : blk; kv_load_t(kv, WKb + (size_t)bc * 2048, WVb + (size_t)bc * 2048, lane); };
      pipe2(bhi - blo + 1, [&](KV8& kv, int i) { ld(kv, blo + i); }, [&](const KV8& kv, int i) { const int kb = 32 * (blo + i);
          tile_compute(T, qf, kv, [&](int e) { const int kp = kb + 8 * c + e; return vcol && kp >= 0 && kp <= tq && tq - kp <= SWA_WINDOW; }); });
      const float inv = (T.l > 0.f) ? 1.0f / T.l : 0.f, g2 = vcol ? gt[2] * inv : 0.f;
#ifdef NSA_DEBUG
      if (vcol) { for (int db = 0; db < 4; ++db) *(f32x4*)(P.DBG + ((size_t)2 * MP + row) * 768 + head * 64 + 16 * db + 4 * c) = T.o[db] * inv; }
#endif
#pragma unroll
      for (int db = 0; db < 4; ++db) if (rep == REP_WIN - 1) oacc[db] += T.o[db] * g2; }
    if (vcol) { float* op = P.DPART + (size_t)row * 768 + head * 64 + 4 * c;
#pragma unroll
        for (int db = 0; db < 4; ++db) *(f32x4*)(op + 16 * db) = oacc[db]; }
}
DI void nsa_pair_b(const FP& P, int n, int kvh, int t, int lane, LAS unsigned char* wl) {
    LAS int* steps = (LAS int*)wl;
    const int col = lane & 15, c = lane >> 4; const bool vcol = col < 12; const int qq = vcol ? col / 6 : 0, hh = vcol ? col % 6 : 0, tq = t + qq, head = kvh * NSA_GROUP + hh, row = n * SEQ + tq;
    bf16x8 qf[2]; { const bf16* qp = P.QB + (size_t)row * NSA_Q_COLS + head * 64 + 8 * c; qf[0] = *(const bf16x8*)qp; qf[1] = *(const bf16x8*)(qp + 32); }
    const float* gt = P.GATES + (size_t)row * 64 + head * 3;
    Tile16 T; tile_init(T);
    const bf16* SKb = P.SLK + ((size_t)n * NSA_KV_HEADS + kvh) * SEQ * 64; const bf16* SVb = P.SLVT + ((size_t)n * NSA_KV_HEADS + kvh) * SEQ * 64;
    int ns = 0;
    { const int mysel = (lane < 32) ? P.SELB[((size_t)(n * SEQ + t + (lane >> 4)) * NSA_KV_HEADS + kvh) * 16 + (lane & 15)] : -1;
      for (int i = 0; i < 32; ++i) { const int b = __builtin_amdgcn_readlane(mysel, i); if (b < 0) continue; int q2 = i >> 4;
          const unsigned long long other = __ballot(mysel == b && lane < 32 && (lane >> 4) != q2);
          if (other) { if (q2 == 1) continue; q2 = 2; }
          if (lane == 0) { steps[ns] = (b * SLC_BLOCK) | (q2 << 29); steps[ns + 1] = (b * SLC_BLOCK + 32) | (q2 << 29); } ns += 2; } }
    asm volatile("s_waitcnt lgkmcnt(0)" ::: "memory");
    auto ld = [&](KV8& kv, int i) { const int code = __builtin_amdgcn_readfirstlane(steps[i]); const int kb = code & 0x1fffffff;
        kv_load_t(kv, SKb + (size_t)(kb >> 5) * 2048, SVb + (size_t)(kb >> 5) * 2048, lane); };
#ifdef PROBE_DBLCOMP
    Tile16 T2; tile_init(T2);
#endif
    pipe2(ns, ld, [&](const KV8& kv, int i) { const int code = __builtin_amdgcn_readfirstlane(steps[i]); const int kb = code & 0x1fffffff, q2 = code >> 29;
        tile_compute(T, qf, kv, [&](int e) { return vcol && (q2 == 2 || qq == q2) && (kb + 8 * c + e) <= tq; });
#ifdef PROBE_DBLCOMP
        tile_compute(T2, qf, kv, [&](int e) { return vcol && qq == q2 && (kb + 8 * c + e + 1) <= tq; });
#endif
    });
#ifdef PROBE_DBLCOMP
    if (T2.l < 0.f) T.l = 0.f;
#endif
    const float inv = (T.l > 0.f) ? 1.0f / T.l : 0.f, g1 = vcol ? gt[1] * inv : 0.f;
#ifdef NSA_DEBUG
    if (vcol) { for (int db = 0; db < 4; ++db) *(f32x4*)(P.DBG + ((size_t)1 * MP + row) * 768 + head * 64 + 16 * db + 4 * c) = T.o[db] * inv; }
#endif
    if (vcol) { const float* pp = P.DPART + (size_t)row * 768 + head * 64 + 4 * c; bf16* op = P.ATTB + (size_t)row * 1024 + head * 64 + 4 * c;
#pragma unroll
        for (int db = 0; db < 4; ++db) *(u32x2*)(op + 16 * db) = pk4(*(const f32x4*)(pp + 16 * db) + T.o[db] * g1); }
}

constexpr int SMP_SK = 1088;
template <class KF, class VF> DI void smp_branch(const Ctx& C, LAS float* qs, LAS float* S, LAS float* red, int NK, KF kf, VF vf, bool keep_probs, float (&outh)[1]) {
    const int tid = C.tid, lane = C.lane, w = C.wave;
#pragma unroll 1
    for (int j = tid; j < NK; j += NTHREADS) { const float* k = kf(j); f32x4 kr[16];
#pragma unroll
        for (int d4 = 0; d4 < 16; ++d4) kr[d4] = *(const f32x4*)(k + 4 * d4);
#pragma unroll 1
        for (int h = 0; h < 6; ++h) { float a = 0.f;
#pragma unroll
            for (int d4 = 0; d4 < 16; ++d4) { const f32x4 qv = *(const LAS f32x4*)(qs + h * 64 + 4 * d4); a += kr[d4].x * qv.x + kr[d4].y * qv.y + kr[d4].z * qv.z + kr[d4].w * qv.w; }
            S[h * SMP_SK + j] = a; } }
    asm volatile("s_waitcnt lgkmcnt(0)" ::: "memory"); __syncthreads();
    if (w < 6) { float m = -INFINITY; for (int j = lane; j < NK; j += 64) m = fmaxf(m, S[w * SMP_SK + j]); m = wave_max(m);
        float l = 0.f; for (int j = lane; j < NK; j += 64) { const float p = __builtin_amdgcn_exp2f(S[w * SMP_SK + j] - m); S[w * SMP_SK + j] = p; l += p; } l = wave_sum(l);
        const float inv = 1.0f / l; for (int j = lane; j < NK; j += 64) S[w * SMP_SK + j] *= inv; }
    asm volatile("s_waitcnt lgkmcnt(0)" ::: "memory"); __syncthreads();
    { const int per = (NK + NWAVES - 1) / NWAVES, j0 = w * per, j1 = (j0 + per < NK) ? j0 + per : NK; float o[6] = {0.f, 0.f, 0.f, 0.f, 0.f, 0.f};
#pragma unroll 1
      for (int j = j0; j < j1; j += 8) { float vv[8];
#pragma unroll
          for (int u = 0; u < 8; ++u) { const int jj = (j + u < j1) ? j + u : j1 - 1; vv[u] = vf(jj)[lane]; }
#pragma unroll
          for (int u = 0; u < 8; ++u) if (j + u < j1) {
#pragma unroll
              for (int h = 0; h < 6; ++h) o[h] += S[h * SMP_SK + j + u] * vv[u]; } }
#pragma unroll
      for (int h = 0; h < 6; ++h) red[(w * 6 + h) * 64 + lane] = o[h]; }
    asm volatile("s_waitcnt lgkmcnt(0)" ::: "memory"); __syncthreads();
    outh[0] = 0.f;
    if (tid < 384) { float a = 0.f;
#pragma unroll
        for (int ww = 0; ww < NWAVES; ++ww) a += red[ww * 384 + tid]; outh[0] = a; }
    if (!keep_probs) { __syncthreads(); }
}
DI void nsa_sample_item(const FP& P, const Ctx& C, int ns, int kvh) {
    LAS float* qs = (LAS float*)C.lds; LAS float* S = qs + 384; LAS float* red = S + 6 * SMP_SK; LAS float* scs = red + 8 * 384; LAS int* sel = (LAS int*)(scs + 136);
    const int tid = C.tid, row = M0 + ns;
    if (tid < 384) qs[tid] = bf2f(P.QB[(size_t)row * NSA_Q_COLS + kvh * 384 + tid]);
    asm volatile("s_waitcnt lgkmcnt(0)" ::: "memory"); __syncthreads();
    const float* ckf = P.CKF + ((size_t)ns * NSA_KV_HEADS + kvh) * NCH * 64; const float* cvf = P.CVF + ((size_t)ns * NSA_KV_HEADS + kvh) * NCH * 64;
    float oc[1], os[1], ow[1];
    smp_branch(C, qs, S, red, NCMP, [&](int j) { return ckf + (size_t)j * 64; }, [&](int j) { return cvf + (size_t)j * 64; }, true, oc);
    constexpr int NBS = (PAST_LEN + 1 + SLC_BLOCK - 1) / SLC_BLOCK, CURS = PAST_LEN / SLC_BLOCK;
    for (int b = tid; b < 136; b += NTHREADS) { float sv = -3.0e38f;
        if (b < NBS) { if (b == 0 || b == CURS || b == CURS - 1) sv = FORCE_SCORE; else { float a = 0.f;
#pragma unroll
                for (int o = -1; o <= 3; ++o) { const int ci = 4 * b + o; if (ci >= 0 && ci < NCMP) { float sm = 0.f; for (int h6 = 0; h6 < 6; ++h6) sm += S[h6 * SMP_SK + ci]; a += ((o >= 0 && o <= 2) ? 2.f : 1.f) * sm; } }
                sv = a; } }
        scs[b] = sv; }
    asm volatile("s_waitcnt lgkmcnt(0)" ::: "memory"); __syncthreads();
    for (int b = tid; b < NBS; b += NTHREADS) { const float sv = scs[b]; int rank = 0; for (int j = 0; j < NBS; ++j) { const float o = scs[j]; rank += (o > sv || (o == sv && j < b)) ? 1 : 0; }
        if (rank < SLC_TOPK) { sel[rank] = b; P.SELB[((size_t)row * NSA_KV_HEADS + kvh) * 16 + rank] = b; } }
    asm volatile("s_waitcnt lgkmcnt(0)" ::: "memory"); __syncthreads();
    { const float* newrow = P.nsa_kv_s + (size_t)ns * 512; const int* pt = P.page_table + ns * (PAST_LEN / PAGE_SIZE);
      if (tid == 0) { int seen = 0; for (int x = 0; x < SLC_TOPK; ++x) { const int bx = sel[x]; if (bx != CURS && seen < 15) sel[16 + seen++] = bx; } }
      asm volatile("s_waitcnt lgkmcnt(0)" ::: "memory"); __syncthreads();
      auto krow = [&](int j, int ty) -> const float* { if (j >= 15 * 64) return newrow + ty * 128 + kvh * 64;
          const int t0 = sel[16 + (j >> 6)] * SLC_BLOCK + (j & 63); const int pg = pt[t0 / PAGE_SIZE]; return P.cache_nsa_kv + ((size_t)pg * PAGE_SIZE + t0 % PAGE_SIZE) * 512 + ty * 128 + kvh * 64; };
      smp_branch(C, qs, S, red, 15 * 64 + 1, [&](int j) { return krow(j, 2); }, [&](int j) { return krow(j, 3); }, false, os); }
    { const float* wc = P.cache_nsa_win + (size_t)ns * SWA_WINDOW * 256; const float* newrow = P.win_s + ((size_t)ns * SWA_WINDOW + SWA_WINDOW - 1) * 256;
      smp_branch(C, qs, S, red, SWA_WINDOW + 1, [&](int j) { return (j < SWA_WINDOW ? wc + (size_t)j * 256 : newrow) + kvh * 64; }, [&](int j) { return (j < SWA_WINDOW ? wc + (size_t)j * 256 : newrow) + 128 + kvh * 64; }, false, ow); }
    if (tid < 384) { const int head = kvh * NSA_GROUP + tid / 64; const float* gt = P.GATES + (size_t)row * 64 + head * 3;
        P.ATTB[(size_t)row * 1024 + kvh * 384 + tid] = (bf16)f2bf(gt[0] * oc[0] + gt[1] * os[0] + gt[2] * ow[0]);
#ifdef NSA_DEBUG
        P.DBG[((size_t)0 * MP + row) * 768 + kvh * 384 + tid] = oc[0]; P.DBG[((size_t)1 * MP + row) * 768 + kvh * 384 + tid] = os[0]; P.DBG[((size_t)2 * MP + row) * 768 + kvh * 384 + tid] = ow[0];
#endif
    }
    __syncthreads();
}
DI void nsa_pairs(const FP& P, const Ctx& C, bool second) {
    LAS unsigned char* wl = C.lds + C.wave * NSA_WLDS;
    const int per = C.G / 4 > 0 ? C.G / 4 : 1, grp = (C.vcu / per) & 3, sub = C.vcu % per, n = grp >> 1, kvh = grp & 1;
#pragma unroll 1
    for (int pr = sub * NWAVES + C.wave; pr < SEQ / 2; pr += per * NWAVES) { if (second) nsa_pair_b(P, n, kvh, 2 * pr, C.lane, wl); else nsa_pair_a(P, n, kvh, 2 * pr, C.lane, wl); }
}
DI void nsa_phase_a(const FP& P, const Ctx& C) {
    for (int it = C.vcu; it < DEC_BATCH * NSA_KV_HEADS; it += C.G) nsa_sample_item(P, C, it / NSA_KV_HEADS, it % NSA_KV_HEADS);
    nsa_pairs(P, C, false);
    __syncthreads();
}
DI void nsa_phase_b(const FP& P, const Ctx& C) {
    const int lane = C.lane, w = C.wave;
    nsa_pairs(P, C, true);
    __syncthreads();
    { constexpr int NMT = (M0 / 16) * MEM_HEADS;
      for (int it = C.vcu * NWAVES + w; it < NMT; it += C.G * NWAVES) { const int h = it % MEM_HEADS, q16 = it / MEM_HEADS, row0 = q16 * 16, n = row0 / SEQ;
          mem_micro(P, P.MQB + h * 64, 256, row0, 1, n, h, P.ATTB + NSA_Q_COLS + h * 64, 1024, lane); }
      LAS float* qs = (LAS float*)(C.lds + 65536 + w * 256);
      for (int it = C.vcu * NWAVES + w; it < DEC_BATCH * MEM_HEADS; it += C.G * NWAVES) { const int h = it % MEM_HEADS, ns = it / MEM_HEADS, row = M0 + ns;
          Dec D; D.m = -INFINITY; D.l = 0.f; D.o = 0.f; qs[lane] = bf2f(P.MQB[(size_t)row * 256 + h * 64 + lane]); asm volatile("s_waitcnt lgkmcnt(0)" ::: "memory");
          const float* mk = P.cache_mem_kv + ((size_t)1 * DEC_BATCH + ns) * MEM_TOKENS * 512;
          for (int j0 = 0; j0 < MEM_TOKENS; j0 += 64) dec_chunk(D, qs, 64, [&](int j) { return mk + (size_t)(j0 + j) * 512 + h * 64; }, [&](int j) { return mk + (size_t)(j0 + j) * 512 + 256 + h * 64; }, lane);
          P.ATTB[(size_t)row * 1024 + NSA_Q_COLS + h * 64 + lane] = (bf16)f2bf(D.o / D.l); } }
    __syncthreads();
}
}
namespace fx {
enum { PH_PRO = 0, PH_G1, PH_ATTA, PH_G2, PH_LN1, PH_SC0, PH_TK0, PH_PU0, PH_PG0, PH_G3, PH_CMPG, PH_CMP2, PH_NSA, PH_NSB, PH_G4, PH_LN3, PH_SC1, PH_TK1, PH_PU1, PH_PG1, PH_COUNT };
template <class Epi> DI void run_gemm(const Ctx& C, const bf16* A, const bf16* Bt, int M, int N, int K, const Epi& E) {
    pg8::Gemm g{A, Bt, M, N, K}; pg8::StaticOrder S; S.init(M, N, C.G, (int)blockIdx.x);
    pg8::gemm_phase<Epi, pg8::StaticOrder, true, true>(C.lds, g, S, E);
}
template <class Epi> DI void skinny_gemm(const Ctx& C, const bf16* A, const bf16* Bt, int N, int K, const Epi& E) {
    static_assert(DEC_BATCH == 32 && M0 % 256 == 0, "skinny_gemm: 32 sample rows right after a whole number of 256-row tiles");
    const int lane = C.lane, fr = lane & 15, fq = lane >> 4, w = C.wave; const int NI = (N / 256) * 4, KW = K / NWAVES;
    LAS f32x4* red = (LAS f32x4*)C.lds;
#pragma unroll 1
    for (int item = C.vcu; item < NI; item += C.G) { const int pn = item >> 2, wc = item & 3;
        f32x4 pa[2][2][2];
#pragma unroll
        for (int i = 0; i < 8; ++i) (&pa[0][0][0])[i] = (f32x4){0.f, 0.f, 0.f, 0.f};
        const bf16* xa = A + (size_t)(M0 + fr) * K + w * KW + 8 * fq; const bf16* xb = xa + (size_t)16 * K;
        const bf16* wp[2][2];
#pragma unroll
        for (int bj = 0; bj < 2; ++bj)
#pragma unroll
            for (int n = 0; n < 2; ++n) wp[bj][n] = Bt + (size_t)(pn * 256 + bj * 128 + wc * 32 + 8 * (fr >> 2) + 4 * n + (fr & 3)) * K + w * KW + 8 * fq;
#pragma unroll 4
        for (int k0 = 0; k0 < KW; k0 += 32) { const bf16x8 x0 = *(const bf16x8*)(xa + k0), x1 = *(const bf16x8*)(xb + k0);
#pragma unroll
            for (int bj = 0; bj < 2; ++bj)
#pragma unroll
                for (int n = 0; n < 2; ++n) { const bf16x8 wf = *(const bf16x8*)(wp[bj][n] + k0);
                    pa[bj][0][n] = __builtin_amdgcn_mfma_f32_16x16x32_bf16(wf, x0, pa[bj][0][n], 0, 0, 0); pa[bj][1][n] = __builtin_amdgcn_mfma_f32_16x16x32_bf16(wf, x1, pa[bj][1][n], 0, 0, 0); } }
        __syncthreads();
#pragma unroll
        for (int bj = 0; bj < 2; ++bj)
#pragma unroll
            for (int mm = 0; mm < 2; ++mm)
#pragma unroll
                for (int n = 0; n < 2; ++n) red[(w * 8 + bj * 4 + mm * 2 + n) * 64 + lane] = pa[bj][mm][n];
        asm volatile("s_waitcnt lgkmcnt(0)" ::: "memory"); __syncthreads();
        if (w == 0) { f32x4 acc[2][2][4][2];
#pragma unroll
            for (int i = 0; i < 32; ++i) (&acc[0][0][0][0])[i] = (f32x4){0.f, 0.f, 0.f, 0.f};
#pragma unroll
            for (int bj = 0; bj < 2; ++bj)
#pragma unroll
                for (int mm = 0; mm < 2; ++mm)
#pragma unroll
                    for (int n = 0; n < 2; ++n) { f32x4 s = red[(bj * 4 + mm * 2 + n) * 64 + lane];
#pragma unroll 1
                        for (int ww = 1; ww < NWAVES; ++ww) s += red[(ww * 8 + bj * 4 + mm * 2 + n) * 64 + lane];
                        acc[0][bj][mm][n] = s; }
            E(acc, pg8::Unit{M0 / 256, pn}, 0, wc, fr, fq); }
    }
    __syncthreads();
}
__global__ void __launch_bounds__(NTHREADS, 2) mega(Args args) {
    extern __shared__ __attribute__((aligned(16))) unsigned char lds_raw[];
    Ctx C; C.lds = (LAS unsigned char*)lds_raw; C.tid = threadIdx.x; C.lane = C.tid & 63; C.wave = __builtin_amdgcn_readfirstlane(C.tid >> 6);
    C.G = gridDim.x; { const int bx = blockIdx.x; C.vcu = (C.G % 8 == 0) ? (bx % 8) * (C.G / 8) + bx / 8 : bx; }
    const FP& P = args.p;
    volatile LAS unsigned* MISC = (volatile LAS unsigned*)(C.lds + MISC_OFF);
    for (int u = C.tid; u < (LDS_BYTES - RING_BYTES) / 4; u += NTHREADS) ((LAS unsigned*)(C.lds + RING_BYTES))[u] = 0u;
    __syncthreads();
    const int lo = args.lo, hi = args.hi;
    XcdBarrier bar; bar.bar = P.ctl + 1024; bar.x = 0; bar.st = nullptr;
    if (hi - lo > 1) bar = xcd_barrier_post(P.ctl + 1024, MISC + 8);
#define IN(k) (lo <= (k) && (k) < hi)
#define SEAM(k) do { if (IN(k) && IN((k) + 1)) xcd_barrier(bar); } while (0)
#ifndef DUP_PHASE
#define DUP_PHASE -1
#endif
#define PHASE(k, ...) do { if (IN(k)) { __VA_ARGS__ if (DUP_PHASE == (k)) { __syncthreads(); __VA_ARGS__ } } SEAM(k); } while (0)
    PHASE(PH_PRO, p0_prologue(P, C); __syncthreads(); p0_wpk(P, C););
    PHASE(PH_G1, run_gemm(C, P.XB0, P.WA_T, M0, ACOLS, D_MODEL, EpiA{P}); run_gemm(C, P.MEMB, P.WMEM_T, BATCH * MEM_TOKENS, 1024, D_MODEL, EpiMem{P}); skinny_gemm(C, P.XB0, P.WA_T, ACOLS, D_MODEL, EpiA{P}););
    PHASE(PH_ATTA, atta_phase(P, C););
    PHASE(PH_G2, run_gemm(C, P.ATTA, P.WOA_T, M0, D_MODEL, 512, EpiPre{P.x_prompt, P.x_sample, P.PRE}); skinny_gemm(C, P.ATTA, P.WOA_T, D_MODEL, 512, EpiPre{P.x_prompt, P.x_sample, P.PRE}););
    PHASE(PH_LN1, ln_phase(P, C, P.PRE, P.ln_g, P.ln_b, P.X1, P.X1B, nullptr, nullptr););
    PHASE(PH_SC0, run_gemm(C, P.X1B, P.WPK_T, M0, NPK, D_MODEL, EpiF32{P.SCO, NPK, MP}); skinny_gemm(C, P.X1B, P.WPK_T, NPK, D_MODEL, EpiF32{P.SCO, NPK, MP}););
    PHASE(PH_TK0, topk_phase(P, C););
#ifdef PEER_SPLIT
    PHASE(PH_PU0, peer_u_phase(P, C, 0, P.X1B););
    PHASE(PH_PG0, peer_v_phase(P, C, 0, P.X1, P.X2, P.X2 + (size_t)M0 * D_MODEL, P.X2B););
#elif defined(PEER_SHARD2)
    PHASE(PH_PG0, const bool shd = (M0 % (C.G * NWAVES * PS2_ROWS)) == 0; if (shd) { peer_sharded2_phase(P, C, 0, P.X1, P.X1B, P.X2, P.X2B); __syncthreads(); } peer_phase(P, C, 0, P.X1, P.X2, P.X2 + (size_t)M0 * D_MODEL, P.X2B, shd););
#elif defined(PEER_SHARD)
    PHASE(PH_PG0, peer_sharded_phase(P, C, 0, P.X1, P.X1B, P.X2, P.X2 + (size_t)M0 * D_MODEL, P.X2B); __syncthreads(); peer_phase(P, C, 0, P.X1, P.X2, P.X2 + (size_t)M0 * D_MODEL, P.X2B););
#else
    PHASE(PH_PG0, peer_phase(P, C, 0, P.X1, P.X2, P.X2 + (size_t)M0 * D_MODEL, P.X2B););
#endif
    PHASE(PH_G3, run_gemm(C, P.X2B, P.WB_T, M0, NB_T, D_MODEL, EpiB{P}); skinny_gemm(C, P.X2B, P.WB_T, NB_T, D_MODEL, EpiB{P}););
    PHASE(PH_CMPG, run_gemm(C, P.AC, P.CW1_T, ACROWS, 256, 1024, EpiF32{P.UL, 256, ACROWS}); run_gemm(C, P.AC + (size_t)ACROWS * 1024, P.CW1_T + 256 * 1024, ACROWS, 256, 1024, EpiF32{P.UL + (size_t)ACROWS * 256, 256, ACROWS}););
    PHASE(PH_CMP2, cmp2_phase(P, C););
    PHASE(PH_NSA, nsa_phase_a(P, C););
    PHASE(PH_NSB, nsa_phase_b(P, C););
    PHASE(PH_G4, run_gemm(C, P.ATTB, P.WOB_T, M0, D_MODEL, 1024, EpiPre{P.X2, nullptr, P.PRE}); skinny_gemm(C, P.ATTB, P.WOB_T, D_MODEL, 1024, EpiPre{P.X2, nullptr, P.PRE}););
    PHASE(PH_LN3, ln_phase(P, C, P.PRE, P.ln_g + 2 * D_MODEL, P.ln_b + 2 * D_MODEL, P.X3, P.X3B, nullptr, nullptr););
    PHASE(PH_SC1, run_gemm(C, P.X3B, P.WPK_T + (size_t)NPK * D_MODEL, M0, NPK, D_MODEL, EpiF32{P.SCO, NPK, MP}); skinny_gemm(C, P.X3B, P.WPK_T + (size_t)NPK * D_MODEL, NPK, D_MODEL, EpiF32{P.SCO, NPK, MP}););
    PHASE(PH_TK1, topk_phase(P, C););
#ifdef PEER_SPLIT
    PHASE(PH_PU1, peer_u_phase(P, C, 1, P.X3B););
    PHASE(PH_PG1, peer_v_phase(P, C, 1, P.X3, P.y_prompt, P.y_sample, nullptr););
#elif defined(PEER_SHARD2)
    PHASE(PH_PG1, const bool shd = (M0 % (C.G * NWAVES * PS2_ROWS)) == 0; if (shd) { peer_sharded2_phase(P, C, 1, P.X3, P.X3B, P.y_prompt, nullptr); __syncthreads(); } peer_phase(P, C, 1, P.X3, P.y_prompt, P.y_sample, nullptr, shd););
#elif defined(PEER_SHARD)
    PHASE(PH_PG1, peer_sharded_phase(P, C, 1, P.X3, P.X3B, P.y_prompt, P.y_sample, nullptr); __syncthreads(); peer_phase(P, C, 1, P.X3, P.y_prompt, P.y_sample, nullptr););
#else
    PHASE(PH_PG1, peer_phase(P, C, 1, P.X3, P.y_prompt, P.y_sample, nullptr););
#endif
#undef IN
#undef SEAM
}
}
#ifndef ONE_LAUNCH
#define ONE_LAUNCH 1
#endif
extern "C" void kernel_launch(void* const* d_in, const int* in_sizes, int n_in, void* d_out, int out_size, void* d_ws, size_t ws_size, hipStream_t stream) {
    fx::Args a; memset(&a, 0, sizeof(a)); fx::bind_io(a.p, d_in, (float*)d_out);
    const size_t f_need = fx::carve(a.p, d_ws);
    if (f_need > ws_size) { fprintf(stderr, "kernel_launch: workspace too small: need %zu have %zu\n", f_need, ws_size); return; }
    static int grid = 0;
    if (!grid) { int dev = 0, cus = 0, per_cu = 0; (void)hipGetDevice(&dev); (void)hipDeviceGetAttribute(&cus, hipDeviceAttributeMultiprocessorCount, dev);
        (void)hipFuncSetAttribute((const void*)fx::mega, hipFuncAttributeMaxDynamicSharedMemorySize, fx::LDS_BYTES);
        if (hipOccupancyMaxActiveBlocksPerMultiprocessor(&per_cu, (const void*)fx::mega, fx::NTHREADS, fx::LDS_BYTES) != hipSuccess || per_cu < 1) { fprintf(stderr, "kernel_launch: occupancy query says %d blocks per CU\n", per_cu); (void)hipGetLastError(); }
        grid = cus; }
    (void)hipMemsetAsync(a.p.ctl, 0, fx::CTL_BYTES, stream);
#if ONE_LAUNCH
    a.lo = 0; a.hi = fx::PH_COUNT; hipLaunchKernelGGL(fx::mega, dim3(grid), dim3(fx::NTHREADS), fx::LDS_BYTES, stream, a);
#else
    for (int k = 0; k < fx::PH_COUNT; ++k) { a.lo = k; a.hi = k + 1; hipLaunchKernelGGL(fx::mega, dim3(grid), dim3(fx::NTHREADS), fx::LDS_BYTES, stream, a); }
#endif
}
```

```cpp
#define PEER_SHARD2 1
#define ONE_LAUNCH 1
#include <hip/hip_runtime.h>
#include <cstdio>
#include <cstring>
#include <cmath>
#ifdef CPU_TEST
#define HD inline
constexpr int D_MODEL = 128, BATCH = 2, SEQ = 512, DEPTH = 2, DEC_BATCH = 3, DEC_SEQ = 1, PAST_LEN = 512, PAGE_SIZE = 128;
constexpr int DIL_W[3] = {16, 64, 256}, DIL_D[3] = {1, 4, 16}, DIL_TAPS = 17;
constexpr int MEM_TOKENS = 32, SLC_TOPK = 4, SWA_WINDOW = 64, PEER_KEYS = 16, PEER_TOPK = 4;
#else
#define HD __host__ __device__ __forceinline__
constexpr int D_MODEL = 1024, BATCH = 2, SEQ = 8192, DEPTH = 2, DEC_BATCH = 32, DEC_SEQ = 1, PAST_LEN = 8192, PAGE_SIZE = 128;
constexpr int DIL_W[3] = {128, 512, 2048}, DIL_D[3] = {1, 4, 16}, DIL_TAPS = 129;
constexpr int MEM_TOKENS = 256, SLC_TOPK = 16, SWA_WINDOW = 512, PEER_KEYS = 128, PEER_TOPK = 16;
#endif
HD constexpr int dil_w(int g) { return g == 0 ? DIL_W[0] : (g == 1 ? DIL_W[1] : DIL_W[2]); }
HD constexpr int dil_d(int g) { return g == 0 ? DIL_D[0] : (g == 1 ? DIL_D[1] : DIL_D[2]); }
constexpr int HEAD_DIM = 64, N_A_LAYERS = DEPTH / 2, N_DIL = 3, DIL_HEADS = 4, DIL_COLS = N_DIL * 3 * DIL_HEADS * HEAD_DIM;
constexpr int MEM_HEADS = 4, MEM_COLS = MEM_HEADS * HEAD_DIM;
constexpr int NSA_HEADS = 12, NSA_KV_HEADS = 2, NSA_GROUP = 6, NSA_Q_COLS = NSA_HEADS * HEAD_DIM, NSA_GATE_COLS = NSA_HEADS * 3;
constexpr int CMP_BLOCK = 32, CMP_STRIDE = 16, CMP_HIDDEN = 128, SLC_BLOCK = 64;
constexpr int PEER_EXPERTS = PEER_KEYS * PEER_KEYS, PEER_HEADS = 8, PEER_KEY_DIM = 128;
constexpr float FORCE_SCORE = 1.0e9f, NEG = -1.0e30f, SCALE = 0.125f, LN_EPS = 1e-5f;
constexpr float ALPHA = 1.41421356237309515f;
constexpr float BETA = 0.5f;
#define LAS __attribute__((address_space(3)))
namespace pg8 {
#define PG8_LAS __attribute__((address_space(3)))
typedef unsigned short bf16_t;
typedef short bf16x8 __attribute__((ext_vector_type(8)));
typedef float f32x4 __attribute__((ext_vector_type(4)));
typedef unsigned u32x4 __attribute__((ext_vector_type(4)));
constexpr int BM = 256, BK = 64, HALF = 128, HTB = HALF * BK * 2  , STAGE_BYTES = 8 * HTB, NXCD = 8, WGM = 8;

__host__ __device__ __forceinline__ int lds_byte(int r, int c) { const int st = (r >> 4) * 2 + (c >> 5), rr = r & 15, cc = c & 31, ob = rr * 64 + cc * 2; return st * 1024 + (ob ^ (((ob >> 9) & 1) << 5)); }
__host__ __device__ __forceinline__ void stage_rc(int b, int& R, int& C) { const int st = b / 1024, sb = b % 1024, swz = sb ^ (((sb >> 9) & 1) << 5); R = (st >> 1) * 16 + swz / 64; C = (st & 1) * 32 + (swz % 64) / 2; }
__host__ __device__ __forceinline__ int perm32(int rho) { const int n = rho >> 4, i = rho & 15; return 8 * (i >> 2) + 4 * n + (i & 3); }

struct Unit { int pm, pn; };
struct Gemm { const bf16_t* A; const bf16_t* Bt; int M, N, K; };

struct StaticOrder {
    int nM, nN, nwg, G, c;
    __host__ __device__ void init(int M, int N, int G_, int c_) { nM = M / BM; nN = N / BM; nwg = nM * nN; G = G_; c = c_; }
    __host__ __device__ bool next(int i, Unit& u) const {
        const long L = (long)i * G + c; if (L >= nwg) return false;
        int wgid = (int)L; { const int q = nwg / NXCD, r = nwg % NXCD, xcd = wgid % NXCD, off = wgid / NXCD; wgid = (xcd < r ? xcd * (q + 1) : r * (q + 1) + (xcd - r) * q) + off; }
        const int nig = WGM * nN, gid = wgid / nig, fm = gid * WGM, gsz = (nM - fm) < WGM ? (nM - fm) : WGM;
        u.pm = fm + ((wgid % nig) % gsz); u.pn = (wgid % nig) / gsz; return true;
    }
    __device__ __forceinline__ void a_ready(const Unit&) const {}
    __device__ __forceinline__ void done(const Unit&) const {}
};

__device__ __forceinline__ unsigned cvt_pk_bf16(float lo, float hi) { unsigned r; asm volatile("v_cvt_pk_bf16_f32 %0, %1, %2" : "=v"(r) : "v"(lo), "v"(hi)); return r; }
typedef float f32x2 __attribute__((ext_vector_type(2)));
typedef float f32x2 __attribute__((ext_vector_type(2)));
template <class Epi, class Sched, bool ALIGN_EPI = false, bool SP2 = false>
__device__ __forceinline__ void gemm_phase(PG8_LAS unsigned char* lds, const Gemm g, const Sched& S, const Epi& E) {
    const int tid = threadIdx.x, wid = __builtin_amdgcn_readfirstlane(tid >> 6), lane = tid & 63, wr = wid >> 2, wc = wid & 3, fr = lane & 15, fq = lane >> 4;
    const int K = g.K, nt = K / BK;
    unsigned voffA[2], voffB[2];
#pragma unroll
    for (int i = 0; i < 2; ++i) { int R, C; stage_rc(tid * 16 + i * 8192, R, C); const int Rb = Epi::PERM ? ((R & ~31) + perm32(R & 31)) : R;
        voffA[i] = (unsigned)(R * K + C) * 2u; voffB[i] = (unsigned)(Rb * K + C) * 2u; }
    const size_t kstep = (size_t)(BK * 2);
    const size_t hstep = (size_t)HALF * K * 2;
    const size_t tstep = 2 * hstep;
    const unsigned ldsw = (unsigned)wid * 1024u;
    const int aoff = lds_byte(wr * 64 + fr, fq * 8), boff = lds_byte(wc * 32 + fr, fq * 8);
#define PG8_SA(b, h) (((b) * 2 + (h)) * HTB)
#define PG8_SB(b, h) ((4 + (b) * 2 + (h)) * HTB)
#define PG8_STAGE(bufoff, gbase, voff) do { _Pragma("unroll") for (int _i = 0; _i < 2; ++_i) \
        __builtin_amdgcn_global_load_lds((const unsigned*)((const char*)(gbase) + (voff)[_i]), (PG8_LAS unsigned*)(lds + (bufoff) + ldsw + _i * 8192), 16, 0, 0); } while (0)
#define PG8_LDA(dst, b, h) do { _Pragma("unroll") for (int m = 0; m < 4; ++m) _Pragma("unroll") for (int k = 0; k < 2; ++k) dst[m][k] = *(const PG8_LAS bf16x8*)(lds + PG8_SA(b, h) + aoff + m * 2048 + k * 1024); } while (0)
#define PG8_LDB(dst, b, h) do { _Pragma("unroll") for (int n = 0; n < 2; ++n) _Pragma("unroll") for (int k = 0; k < 2; ++k) dst[n][k] = *(const PG8_LAS bf16x8*)(lds + PG8_SB(b, h) + boff + n * 2048 + k * 1024); } while (0)
#define PG8_MMA(ai, bj, At, Bt) do { __builtin_amdgcn_s_setprio(1); _Pragma("unroll") for (int m = 0; m < 4; ++m) _Pragma("unroll") for (int n = 0; n < 2; ++n) _Pragma("unroll") for (int k = 0; k < 2; ++k) \
        acc[ai][bj][m][n] = __builtin_amdgcn_mfma_f32_16x16x32_bf16(Bt[n][k], At[m][k], acc[ai][bj][m][n], 0, 0, 0); __builtin_amdgcn_s_setprio(0); } while (0)
#define PG8_WAIT_V(n) asm volatile("s_waitcnt vmcnt(" #n ")" ::: "memory")
#define PG8_WAIT_L(n) asm volatile("s_waitcnt lgkmcnt(" #n ")" ::: "memory")
#define PG8_BAR __builtin_amdgcn_s_barrier()
#define PG8_SCHED __builtin_amdgcn_sched_barrier(0)
    Unit cur, nxt; int ui = 0;
    if (!S.next(0, cur)) return;
    f32x4 acc[2][2][4][2];
#pragma unroll
    for (int a = 0; a < 2; ++a)
#pragma unroll
        for (int b = 0; b < 2; ++b)
#pragma unroll
            for (int m = 0; m < 4; ++m)
#pragma unroll
                for (int n = 0; n < 2; ++n) acc[a][b][m][n] = (f32x4){0.f, 0.f, 0.f, 0.f};
    bf16x8 At[4][2], B0[2][2], B1[2][2];
    const char* cA = (const char*)g.A + (size_t)cur.pm * tstep; const char* cB = (const char*)g.Bt + (size_t)cur.pn * tstep;
    S.a_ready(cur);
    if constexpr (SP2) {
        PG8_STAGE(PG8_SB(0, 0), cB, voffB); PG8_STAGE(PG8_SB(0, 1), cB + hstep, voffB); PG8_STAGE(PG8_SA(0, 0), cA, voffA); PG8_STAGE(PG8_SA(0, 1), cA + hstep, voffA);
        if (wr == 1) PG8_BAR;
        PG8_WAIT_V(2); PG8_BAR;
        PG8_STAGE(PG8_SB(1, 0), cB + kstep, voffB); PG8_STAGE(PG8_SA(1, 0), cA + kstep, voffA); PG8_STAGE(PG8_SB(1, 1), cB + hstep + kstep, voffB);
        PG8_WAIT_V(6); PG8_BAR;
    } else {
        PG8_STAGE(PG8_SB(0, 0), cB, voffB); PG8_STAGE(PG8_SA(0, 0), cA, voffA); PG8_STAGE(PG8_SB(0, 1), cB + hstep, voffB); PG8_STAGE(PG8_SA(0, 1), cA + hstep, voffA);
        if (wr == 1) PG8_BAR;
        PG8_WAIT_V(4); PG8_BAR;
        PG8_STAGE(PG8_SB(1, 0), cB + kstep, voffB); PG8_STAGE(PG8_SA(1, 0), cA + kstep, voffA); PG8_STAGE(PG8_SB(1, 1), cB + hstep + kstep, voffB);
        PG8_WAIT_V(6); PG8_BAR;
    }
    for (;;) {
        const bool has_next = S.next(ui + 1, nxt);
        const char* nA = has_next ? (const char*)g.A + (size_t)nxt.pm * tstep : cA; const char* nB = has_next ? (const char*)g.Bt + (size_t)nxt.pn * tstep : cB;
        for (int t = 0; t < nt; t += 2) {
            const bool last = (t == nt - 2);
            const char* a1 = cA + (size_t)(t + 1) * kstep;
            const char* a2 = last ? nA : cA + (size_t)(t + 2) * kstep; const char* b2 = last ? nB : cB + (size_t)(t + 2) * kstep;
            const char* a3 = a2 + kstep; const char* b3 = b2 + kstep;
            if (last && has_next) S.a_ready(nxt);
            if constexpr (SP2) {
            PG8_LDB(B0, 0, 0); PG8_LDB(B1, 0, 1); PG8_SCHED; PG8_LDA(At, 0, 0); PG8_STAGE(PG8_SA(1, 1), a1 + hstep, voffA);
            PG8_WAIT_V(8); PG8_WAIT_L(0); PG8_BAR; PG8_MMA(0, 0, At, B0); PG8_MMA(0, 1, At, B1); PG8_BAR; PG8_SCHED;
            PG8_LDA(At, 0, 1); PG8_STAGE(PG8_SB(0, 0), b2, voffB); PG8_STAGE(PG8_SB(0, 1), b2 + hstep, voffB); PG8_STAGE(PG8_SA(0, 0), a2, voffA);
            PG8_WAIT_V(8); PG8_WAIT_L(0); PG8_BAR; PG8_MMA(1, 0, At, B0); PG8_MMA(1, 1, At, B1); PG8_BAR; PG8_SCHED;
            PG8_LDB(B0, 1, 0); PG8_LDB(B1, 1, 1); PG8_SCHED; PG8_LDA(At, 1, 0); PG8_STAGE(PG8_SA(0, 1), a2 + hstep, voffA);
            PG8_WAIT_V(8); PG8_WAIT_L(0); PG8_BAR; PG8_MMA(0, 0, At, B0); PG8_MMA(0, 1, At, B1); PG8_BAR; PG8_SCHED;
            PG8_LDA(At, 1, 1); PG8_STAGE(PG8_SB(1, 0), b3, voffB); PG8_STAGE(PG8_SB(1, 1), b3 + hstep, voffB); PG8_STAGE(PG8_SA(1, 0), a3, voffA);
            PG8_WAIT_V(8); PG8_WAIT_L(0); PG8_BAR; PG8_MMA(1, 0, At, B0); PG8_MMA(1, 1, At, B1); PG8_BAR; PG8_SCHED;
            } else {
            PG8_LDB(B0, 0, 0); PG8_SCHED; PG8_LDA(At, 0, 0); PG8_STAGE(PG8_SA(1, 1), a1 + hstep, voffA);
            PG8_WAIT_L(8); PG8_BAR; PG8_WAIT_L(0); PG8_MMA(0, 0, At, B0); PG8_BAR; PG8_SCHED;
            PG8_LDB(B1, 0, 1); PG8_STAGE(PG8_SB(0, 0), b2, voffB);
            PG8_BAR; PG8_WAIT_L(0); PG8_MMA(0, 1, At, B1); PG8_BAR;
            PG8_LDA(At, 0, 1); PG8_STAGE(PG8_SA(0, 0), a2, voffA);
            PG8_BAR; PG8_WAIT_L(0); PG8_MMA(1, 0, At, B0); PG8_BAR; PG8_SCHED;
            PG8_STAGE(PG8_SB(0, 1), b2 + hstep, voffB);
            PG8_WAIT_V(6); PG8_BAR; PG8_MMA(1, 1, At, B1); PG8_BAR;
            PG8_LDB(B0, 1, 0); PG8_SCHED; PG8_LDA(At, 1, 0); PG8_STAGE(PG8_SA(0, 1), a2 + hstep, voffA);
            PG8_WAIT_L(8); PG8_BAR; PG8_WAIT_L(0); PG8_MMA(0, 0, At, B0); PG8_BAR; PG8_SCHED;
            PG8_LDB(B1, 1, 1); PG8_STAGE(PG8_SB(1, 0), b3, voffB);
            PG8_BAR; PG8_WAIT_L(0); PG8_MMA(0, 1, At, B1); PG8_BAR;
            PG8_LDA(At, 1, 1); PG8_STAGE(PG8_SA(1, 0), a3, voffA);
            PG8_BAR; PG8_WAIT_L(0); PG8_MMA(1, 0, At, B0); PG8_BAR; PG8_SCHED;
            PG8_STAGE(PG8_SB(1, 1), b3 + hstep, voffB);
            PG8_WAIT_V(6); PG8_BAR; PG8_MMA(1, 1, At, B1); PG8_BAR;
            }
        }
        if constexpr (ALIGN_EPI) { if (wr == 0) PG8_BAR; }
        if constexpr (!Epi::AFTER_DRAIN) { E(acc, cur, wr, wc, fr, fq); S.done(cur); }
        if (!has_next) break;
#pragma unroll
        for (int a = 0; a < 2; ++a)
#pragma unroll
            for (int b = 0; b < 2; ++b)
#pragma unroll
                for (int m = 0; m < 4; ++m)
#pragma unroll
                    for (int n = 0; n < 2; ++n) acc[a][b][m][n] = (f32x4){0.f, 0.f, 0.f, 0.f};
        cur = nxt; cA = nA; cB = nB; ++ui;
        if constexpr (ALIGN_EPI) { if (wr == 1) PG8_BAR; }
    }
    PG8_WAIT_V(0);
    if constexpr (!ALIGN_EPI) { if (wr == 0) PG8_BAR; }
    PG8_BAR;
    if constexpr (Epi::AFTER_DRAIN) { E.fused(acc, cur, wr, wc, fr, fq, lds, wid, lane); S.done(cur); }
#undef PG8_SA
#undef PG8_SB
#undef PG8_STAGE
#undef PG8_LDA
#undef PG8_LDB
#undef PG8_MMA
#undef PG8_WAIT_V
#undef PG8_WAIT_L
#undef PG8_BAR
#undef PG8_SCHED
}
}
#define XB_TMO      128
#define XB_XCNT(j)  (256  + 64 * (j))
#define XB_XSUB(j)  (1280 + 64 * (j))
#define XB_XGEN(j)  (2304 + 64 * (j))
#define XB_TOP      3328
#define XB_TOPGEN   3392
#define XCD_BAR_WORDS 3456
#define XB_SPIN_CAP (1u << 18)

__device__ __forceinline__ unsigned xb_ld(unsigned* p)              { return __hip_atomic_load(p, __ATOMIC_RELAXED, __HIP_MEMORY_SCOPE_AGENT); }
__device__ __forceinline__ unsigned xb_add(unsigned* p, unsigned v) { return __hip_atomic_fetch_add(p, v, __ATOMIC_RELAXED, __HIP_MEMORY_SCOPE_AGENT); }
__device__ __forceinline__ unsigned xb_xcc_id() { return (unsigned)__builtin_amdgcn_s_getreg((3 << 11) | 20) & 0xFu; }
#define XB_SPIN(cond, bar) do { unsigned _sp = 0; while (cond) { __builtin_amdgcn_s_sleep(1); \
    if ((++_sp & 255u) == 0u) { if (xb_ld(&(bar)[XB_TMO])) break; if (_sp > XB_SPIN_CAP) { atomicAdd(&(bar)[XB_TMO], 1u); break; } } } } while (0)

struct XcdBarrier {
    unsigned* bar; unsigned x;
    volatile LAS unsigned* st;
};

__device__ __forceinline__ XcdBarrier xcd_barrier_post(unsigned* bar, volatile LAS unsigned* st) {
    XcdBarrier b; b.bar = bar; b.x = xb_xcc_id(); b.st = st;
    if (threadIdx.x == 0) (void)xb_add(&bar[XB_XCNT(b.x)], 1u);
    return b;
}
__device__ __forceinline__ void xcd_barrier_complete(unsigned* bar, unsigned x, unsigned& nloc, unsigned& nx) {
    const unsigned G = gridDim.x * gridDim.y * gridDim.z;
    unsigned sum, cnt, mine, sp = 0u;
    for (;;) {
        sum = 0u; cnt = 0u; mine = 0u;
#pragma unroll
        for (unsigned j = 0; j < 16; ++j) { const unsigned c = xb_ld(&bar[XB_XCNT(j)]); sum += c; cnt += (c > 0u) ? 1u : 0u; mine = (j == x) ? c : mine; }
        if (sum == G) break;
        __builtin_amdgcn_s_sleep(1);
        if ((++sp & 255u) == 0u) { if (xb_ld(&bar[XB_TMO])) break; if (sp > XB_SPIN_CAP) { atomicAdd(&bar[XB_TMO], 1u); break; } }
    }
    nloc = mine > 0u ? mine : 1u; nx = cnt > 0u ? cnt : 1u;
}

__device__ __forceinline__ void xcd_barrier(const XcdBarrier& b) {
    asm volatile("s_waitcnt vmcnt(0)" ::: "memory");
    __syncthreads();
    if (threadIdx.x == 0) {
        unsigned* bar = b.bar;
        __builtin_amdgcn_s_waitcnt(0);
        unsigned nloc = b.st[0], nx = b.st[1];
        if (nloc == 0u) { xcd_barrier_complete(bar, b.x, nloc, nx); b.st[0] = nloc; b.st[1] = nx; }
        const unsigned old = xb_add(&bar[XB_XSUB(b.x)], 1u);
        const unsigned gen = old / nloc;
        if (old + 1u == (gen + 1u) * nloc) {
            __builtin_amdgcn_fence(__ATOMIC_RELEASE, "agent");
            asm volatile("s_waitcnt vmcnt(0)" ::: "memory");
            const unsigned og = xb_add(&bar[XB_TOP], 1u);
            const unsigned tg = og / nx;
            if (og + 1u == (tg + 1u) * nx) xb_add(&bar[XB_TOPGEN], 1u);
            else XB_SPIN(xb_ld(&bar[XB_TOPGEN]) == tg, bar);
            __builtin_amdgcn_fence(__ATOMIC_ACQUIRE, "agent");
            xb_add(&bar[XB_XGEN(b.x)], 1u);
            asm volatile("s_waitcnt vmcnt(0)" ::: "memory");
        } else {
            XB_SPIN(xb_ld(&bar[XB_XGEN(b.x)]) == gen, bar);
            __builtin_amdgcn_fence(__ATOMIC_ACQUIRE, "agent");
            asm volatile("s_waitcnt vmcnt(0)" ::: "memory");
        }
    }
    __syncthreads();
}
namespace fx {
#define DI __device__ __forceinline__
typedef unsigned short bf16;
typedef short bf16x8 __attribute__((ext_vector_type(8)));
typedef float f32x4 __attribute__((ext_vector_type(4)));
typedef float f32x2 __attribute__((ext_vector_type(2)));
typedef unsigned u32x4 __attribute__((ext_vector_type(4)));
typedef unsigned u32x2 __attribute__((ext_vector_type(2)));
constexpr int M0 = BATCH * SEQ, MP = M0 + DEC_BATCH, MPAD = ((MP + 255) / 256) * 256;
constexpr int ACOLS = DIL_COLS + MEM_COLS, BCOLS = NSA_Q_COLS + NSA_GATE_COLS + MEM_COLS, KVCOLS = 6 * NSA_KV_HEADS * HEAD_DIM;
constexpr int NB_T = 2048;
constexpr int NPK = PEER_HEADS * 2 * PEER_KEYS;
constexpr int NCMP = (SEQ - CMP_BLOCK) / CMP_STRIDE + 1;
constexpr int NCH = SEQ / CMP_STRIDE;
constexpr int NCTX = BATCH + DEC_BATCH;
constexpr int ACROWS = NCTX * NSA_KV_HEADS * NCH;
constexpr int NPOS = PAST_LEN + 1;
constexpr float QSCALE = 0.125f * 1.4426950408889634f;
constexpr int NTHREADS = 512, NWAVES = 8, LDS_BYTES = 147456, RING_BYTES = 131072, MISC_OFF = RING_BYTES + 320;

struct FP {
    const float *x_prompt, *x_sample, *mem_prompt, *cache_dil[3], *cache_nsa_kv, *cache_nsa_win, *cache_mem_kv; const int* page_table;
    const float *w_in_a, *w_out_a, *w_in_b, *w_out_b, *w_mem_kv, *w_kv_b, *cmp_pe, *cmp_w1, *cmp_w2, *ln_g, *ln_b, *peer_wq, *peer_keys, *peer_u, *peer_v;
    float *y_prompt, *y_sample, *dil_p[3], *dil_s[3], *nsa_kv_p, *nsa_kv_s, *win_p, *win_s, *mem_kv_p;
    unsigned* ctl;
    bf16 *XB0, *X1B, *X2B, *X3B, *WA_T, *WMEM_T, *MEMB, *WOA_T, *WOB_T, *WPK_T, *WB_T, *CW1_T, *AC; unsigned char *UB8, *VB8;
    float *ROPE, *CBIAS;
    bf16 *QA, *KA, *VTA, *MQA, *MK, *MVT, *ATTA;
    float *DPART, *DML, *PRE, *X1, *X2, *X3, *SCO, *SELG; int* SELE;
    bf16 *SLK, *SLVT, *WNK, *WNVT, *QB, *MQB, *CK, *CVT, *ATTB;
    float *GATES, *UL, *CKF, *CVF;
    int* SELB;
    float* DBG;
};
struct Args { FP p; int lo, hi; };
struct Carve { size_t off = 0; template <class T> T* take(void* base, size_t n) { T* r = (T*)((char*)base + off); off += ((n * sizeof(T) + 255) / 256) * 256; return r; } };
constexpr size_t CTL_BYTES = 65536;
inline size_t carve(FP& p, void* base) {
    Carve c;
    p.ctl = c.take<unsigned>(base, CTL_BYTES / 4);
    p.XB0 = c.take<bf16>(base, (size_t)MPAD * D_MODEL); p.X1B = c.take<bf16>(base, (size_t)MPAD * D_MODEL); p.X2B = c.take<bf16>(base, (size_t)MPAD * D_MODEL); p.X3B = c.take<bf16>(base, (size_t)MPAD * D_MODEL);
    p.WA_T = c.take<bf16>(base, (size_t)ACOLS * D_MODEL); p.WMEM_T = c.take<bf16>(base, (size_t)DEPTH * 2 * MEM_COLS * D_MODEL); p.MEMB = c.take<bf16>(base, (size_t)BATCH * MEM_TOKENS * D_MODEL);
    p.WOA_T = c.take<bf16>(base, (size_t)D_MODEL * 2 * MEM_COLS); p.WOB_T = c.take<bf16>(base, (size_t)D_MODEL * (NSA_Q_COLS + MEM_COLS));
    p.WPK_T = c.take<bf16>(base, (size_t)DEPTH * NPK * D_MODEL); p.WB_T = c.take<bf16>(base, (size_t)NB_T * D_MODEL);
    p.UB8 = c.take<unsigned char>(base, (size_t)DEPTH * PEER_EXPERTS * D_MODEL); p.VB8 = c.take<unsigned char>(base, (size_t)DEPTH * PEER_EXPERTS * D_MODEL);
    p.CW1_T = c.take<bf16>(base, (size_t)2 * 256 * 1024); p.AC = c.take<bf16>(base, (size_t)2 * ACROWS * 1024);
    p.ROPE = c.take<float>(base, (size_t)NPOS * 64); p.CBIAS = c.take<float>(base, 2 * CMP_HIDDEN);
    p.QA = c.take<bf16>(base, (size_t)3 * MPAD * 256); p.KA = c.take<bf16>(base, (size_t)3 * MPAD * 256); p.VTA = c.take<bf16>(base, (size_t)3 * BATCH * DIL_HEADS * HEAD_DIM * SEQ + 4096);
    p.MQA = c.take<bf16>(base, (size_t)MPAD * 256); p.MK = c.take<bf16>(base, (size_t)DEPTH * BATCH * MEM_TOKENS * MEM_COLS); p.MVT = c.take<bf16>(base, (size_t)DEPTH * BATCH * MEM_COLS * MEM_TOKENS);
    p.ATTA = c.take<bf16>(base, (size_t)MPAD * 2 * MEM_COLS);
    p.DPART = c.take<float>(base, (size_t)3 * MP * DIL_HEADS * HEAD_DIM); p.DML = c.take<float>(base, (size_t)3 * MP * DIL_HEADS * 2);
    p.PRE = c.take<float>(base, (size_t)MPAD * D_MODEL); p.X1 = c.take<float>(base, (size_t)MPAD * D_MODEL); p.X2 = c.take<float>(base, (size_t)MPAD * D_MODEL); p.X3 = c.take<float>(base, (size_t)MPAD * D_MODEL);
    p.SCO = c.take<float>(base, (size_t)MPAD * NPK); p.SELG = c.take<float>(base, (size_t)MP * 128); p.SELE = c.take<int>(base, (size_t)MP * 128);
    p.SLK = c.take<bf16>(base, (size_t)BATCH * NSA_KV_HEADS * SEQ * HEAD_DIM); p.SLVT = c.take<bf16>(base, (size_t)BATCH * NSA_KV_HEADS * SEQ * HEAD_DIM);
    p.WNK = c.take<bf16>(base, (size_t)BATCH * NSA_KV_HEADS * SEQ * HEAD_DIM + 4096); p.WNVT = c.take<bf16>(base, (size_t)BATCH * NSA_KV_HEADS * SEQ * HEAD_DIM + 4096);
    p.QB = c.take<bf16>(base, (size_t)MPAD * NSA_Q_COLS); p.MQB = c.take<bf16>(base, (size_t)MPAD * 256);
    p.CK = c.take<bf16>(base, (size_t)NCTX * NSA_KV_HEADS * NCH * HEAD_DIM); p.CVT = c.take<bf16>(base, (size_t)NCTX * NSA_KV_HEADS * HEAD_DIM * NCH); p.ATTB = c.take<bf16>(base, (size_t)MPAD * (NSA_Q_COLS + MEM_COLS));
    p.GATES = c.take<float>(base, (size_t)MPAD * 64); p.UL = c.take<float>(base, (size_t)2 * ACROWS * 256);
    p.CKF = c.take<float>(base, (size_t)DEC_BATCH * NSA_KV_HEADS * NCH * HEAD_DIM); p.CVF = c.take<float>(base, (size_t)DEC_BATCH * NSA_KV_HEADS * NCH * HEAD_DIM);
    p.SELB = c.take<int>(base, (size_t)MP * NSA_KV_HEADS * 16);
#ifdef NSA_DEBUG
    p.DBG = c.take<float>(base, (size_t)3 * MP * 768);
#else
    p.DBG = nullptr;
#endif
    return c.off;
}
inline void bind_io(FP& p, void* const* d_in, float* out) {
    p.x_prompt = (const float*)d_in[0]; p.x_sample = (const float*)d_in[1]; p.mem_prompt = (const float*)d_in[2]; p.cache_dil[0] = (const float*)d_in[3]; p.cache_dil[1] = (const float*)d_in[4]; p.cache_dil[2] = (const float*)d_in[5];
    p.cache_nsa_kv = (const float*)d_in[6]; p.cache_nsa_win = (const float*)d_in[7]; p.cache_mem_kv = (const float*)d_in[8]; p.page_table = (const int*)d_in[9];
    p.w_in_a = (const float*)d_in[10]; p.w_out_a = (const float*)d_in[11]; p.w_in_b = (const float*)d_in[12]; p.w_out_b = (const float*)d_in[13]; p.w_mem_kv = (const float*)d_in[14]; p.w_kv_b = (const float*)d_in[15];
    p.cmp_pe = (const float*)d_in[16]; p.cmp_w1 = (const float*)d_in[17]; p.cmp_w2 = (const float*)d_in[18]; p.ln_g = (const float*)d_in[19]; p.ln_b = (const float*)d_in[20];
    p.peer_wq = (const float*)d_in[21]; p.peer_keys = (const float*)d_in[22]; p.peer_u = (const float*)d_in[23]; p.peer_v = (const float*)d_in[24];
    size_t o = 0; auto take = [&](size_t n) { float* r = out + o; o += n; return r; };
    p.y_prompt = take((size_t)M0 * D_MODEL); p.y_sample = take((size_t)DEC_BATCH * D_MODEL);
    for (int g = 0; g < 3; ++g) p.dil_p[g] = take((size_t)BATCH * DIL_W[g] * 2 * DIL_HEADS * HEAD_DIM);
    for (int g = 0; g < 3; ++g) p.dil_s[g] = take((size_t)DEC_BATCH * DIL_W[g] * 2 * DIL_HEADS * HEAD_DIM);
    p.nsa_kv_p = take((size_t)M0 * 4 * NSA_KV_HEADS * HEAD_DIM); p.nsa_kv_s = take((size_t)DEC_BATCH * 4 * NSA_KV_HEADS * HEAD_DIM);
    p.win_p = take((size_t)BATCH * SWA_WINDOW * 2 * NSA_KV_HEADS * HEAD_DIM); p.win_s = take((size_t)DEC_BATCH * SWA_WINDOW * 2 * NSA_KV_HEADS * HEAD_DIM);
    p.mem_kv_p = take((size_t)DEPTH * BATCH * MEM_TOKENS * 2 * MEM_COLS);
}
DI unsigned f2bf(float f) { unsigned u = __builtin_bit_cast(unsigned, f); return (u + 0x7fffu + ((u >> 16) & 1u)) >> 16; }
DI unsigned pk2(float lo, float hi) { return f2bf(lo) | (f2bf(hi) << 16); }
DI float bf2f(unsigned short b) { return __builtin_bit_cast(float, (unsigned)b << 16); }
DI float bflo(unsigned w) { return __builtin_bit_cast(float, w << 16); }
DI float bfhi(unsigned w) { return __builtin_bit_cast(float, w & 0xffff0000u); }
DI float wave_sum(float v) {
#pragma unroll
    for (int o = 1; o < 64; o <<= 1) v += __shfl_xor(v, o);
    return v; }
DI float wave_max(float v) {
#pragma unroll
    for (int o = 1; o < 64; o <<= 1) v = fmaxf(v, __shfl_xor(v, o));
    return v; }
DI float gelu_tanh(float x) { const float u = 0.7978845608028654f * (x + 0.044715f * x * x * x); const float e = __builtin_amdgcn_exp2f(u * 2.885390081777927f);   const float t = 1.0f - 2.0f / (e + 1.0f); return 0.5f * x * (1.0f + t); }
DI float* sel3(float* const (&a)[3], int g) { return g == 0 ? a[0] : (g == 1 ? a[1] : a[2]); }
DI const float* sel3c(const float* const (&a)[3], int g) { return g == 0 ? a[0] : (g == 1 ? a[1] : a[2]); }
__host__ DI size_t ktile_off(int t, int d) { const int blk = t >> 5, kk = t & 31, b = (kk >> 2) & 1, i = 4 * (kk >> 3) + (kk & 3), s = d >> 5, c = (d & 31) >> 3; return ((size_t)(blk * 4 + 2 * b + s) * 64 + i + 16 * c) * 8 + (d & 7); }
__host__ DI size_t vtile_off(int dim, int t) { const int blk = t >> 5, kk = t & 31; return ((size_t)(blk * 4 + (dim >> 4)) * 64 + (dim & 15) + 16 * (kk >> 3)) * 8 + (kk & 7); }
struct Ctx { LAS unsigned char* lds; int tid, lane, wave, vcu, G; };
DI int row_pos(int r) { return r < M0 ? (r & (SEQ - 1)) : PAST_LEN; }

struct ColSrc { const float* p; int ld; };
DI int rope_il(int e) { return (e >> 1) + 32 * (e & 1); }
DI ColSrc col_wa(const FP& P, int n) {
    const int t = n >> 8, ct = n & 255, h = ct >> 6, e = ct & 63; if (t >= 9) return ColSrc{P.w_in_a + DIL_COLS + ct, ACOLS};
    const int j = t % 3, d = (j < 2) ? rope_il(e) : e; return ColSrc{P.w_in_a + t * 256 + h * 64 + d, ACOLS}; }
DI ColSrc col_wb(const FP& P, int n) {
    const int t = n >> 8, ct = n & 255, e = ct & 63;
    if (t < 3) { const int ty = 2 * t + (ct >> 7), kvh = (ct >> 6) & 1; const bool rot = (ty == 2 || ty == 4); return ColSrc{P.w_kv_b + (ty * NSA_KV_HEADS + kvh) * 64 + (rot ? rope_il(e) : e), KVCOLS}; }
    if (t < 6) { const int h = (t - 3) * 4 + (ct >> 6); return ColSrc{P.w_in_b + h * 64 + rope_il(e), BCOLS}; }
    if (t == 6) return ColSrc{P.w_in_b + NSA_Q_COLS + NSA_GATE_COLS + ct, BCOLS};
    if (ct < NSA_GATE_COLS) return ColSrc{P.w_in_b + NSA_Q_COLS + ct, BCOLS};
    return ColSrc{nullptr, 0}; }
DI ColSrc col_wmem(const FP& P, int n) { const int l = n >> 9, c = n & 511; return ColSrc{P.w_mem_kv + (size_t)l * D_MODEL * 512 + c, 512}; }
DI ColSrc col_woa(const FP& P, int n) { return ColSrc{P.w_out_a + n, D_MODEL}; }
DI ColSrc col_wob(const FP& P, int n) { return ColSrc{P.w_out_b + n, D_MODEL}; }
DI ColSrc col_cw1(const FP& P, int n) {
    const int ty = n >> 8, half = (n >> 7) & 1, hid = n & 127; return ColSrc{P.cmp_w1 + (size_t)ty * CMP_BLOCK * HEAD_DIM * CMP_HIDDEN + (size_t)half * 16 * HEAD_DIM * CMP_HIDDEN + hid, CMP_HIDDEN}; }
template <class CF> DI void transpose_item(const FP& P, CF cf, int K, bf16* WT, LAS float* scr, int item, int nblk, int lane) {
    const int kb = item / nblk, nb = item % nblk, k0 = 64 * kb, n0 = 32 * nb;
    const ColSrc cs = cf(P, n0 + (lane & 31));
#pragma unroll 8
    for (int i = 0; i < 32; ++i) { const int kk = 2 * i + (lane >> 5); scr[kk * 33 + (lane & 31)] = cs.p ? cs.p[(size_t)(k0 + kk) * cs.ld] : 0.f; }
    asm volatile("s_waitcnt lgkmcnt(0)" ::: "memory");
    const int c = lane & 7;
#pragma unroll
    for (int j = 0; j < 4; ++j) { const int n = (lane >> 3) + 8 * j; const LAS float* s = scr + (8 * c) * 33 + n;
        u32x4 o; o.x = pk2(s[0 * 33], s[1 * 33]); o.y = pk2(s[2 * 33], s[3 * 33]); o.z = pk2(s[4 * 33], s[5 * 33]); o.w = pk2(s[6 * 33], s[7 * 33]);
        *(u32x4*)(WT + (size_t)(n0 + n) * K + k0 + 8 * c) = o; }
    asm volatile("s_waitcnt lgkmcnt(0)" ::: "memory");
}
DI void cvt_row1024(const float* src, bf16* dst, int lane) {
#pragma unroll
    for (int j = 0; j < 4; ++j) { f32x4 v = src ? *(const f32x4*)(src + 256 * j + 4 * lane) : (f32x4){0.f, 0.f, 0.f, 0.f}; u32x2 o; o.x = pk2(v.x, v.y); o.y = pk2(v.z, v.w); *(u32x2*)(dst + 256 * j + 4 * lane) = o; }
}
DI void cvt_row1024_fp8(const float* src, unsigned char* dst, float sc, int lane) { u32x4 o; unsigned w[4];
#pragma unroll
    for (int j = 0; j < 4; ++j) { const f32x4 v = *(const f32x4*)(src + 16 * lane + 4 * j) * sc; int t = __builtin_amdgcn_cvt_pk_fp8_f32(v.x, v.y, 0, false); t = __builtin_amdgcn_cvt_pk_fp8_f32(v.z, v.w, t, true); w[j] = (unsigned)t; }
    o.x = w[0]; o.y = w[1]; o.z = w[2]; o.w = w[3]; *(u32x4*)(dst + 16 * lane) = o; }
DI void p0_prologue(const FP& P, const Ctx& C) {
    LAS float* scr = (LAS float*)(C.lds + C.wave * 16384);
    const int gw = C.vcu * NWAVES + C.wave, NGW = C.G * NWAVES, lane = C.lane;
    { constexpr int IA = (D_MODEL / 64) * (ACOLS / 32), IM = (D_MODEL / 64) * (1024 / 32), IOA = (512 / 64) * (D_MODEL / 32), IOB = (1024 / 64) * (D_MODEL / 32), IB = (D_MODEL / 64) * (NB_T / 32), IC = (1024 / 64) * (512 / 32);
      constexpr int NIT = IA + IM + IOA + IOB + IB + IC;
      for (int it = gw; it < NIT; it += NGW) { int r = it;
          if (r < IA) { transpose_item(P, col_wa, D_MODEL, P.WA_T, scr, r, ACOLS / 32, lane); continue; } r -= IA;
          if (r < IM) { transpose_item(P, col_wmem, D_MODEL, P.WMEM_T, scr, r, 1024 / 32, lane); continue; } r -= IM;
          if (r < IOA) { transpose_item(P, col_woa, 512, P.WOA_T, scr, r, D_MODEL / 32, lane); continue; } r -= IOA;
          if (r < IOB) { transpose_item(P, col_wob, 1024, P.WOB_T, scr, r, D_MODEL / 32, lane); continue; } r -= IOB;
          if (r < IB) { transpose_item(P, col_wb, D_MODEL, P.WB_T, scr, r, NB_T / 32, lane); continue; } r -= IB;
          transpose_item(P, col_cw1, 1024, P.CW1_T, scr, r, 512 / 32, lane); } }
    for (int r = gw; r < MPAD; r += NGW) { cvt_row1024(r < M0 ? P.x_prompt + (size_t)r * D_MODEL : (r < MP ? P.x_sample + (size_t)(r - M0) * D_MODEL : nullptr), P.XB0 + (size_t)r * D_MODEL, lane);
        if (r >= MP) { cvt_row1024(nullptr, P.X1B + (size_t)r * D_MODEL, lane); cvt_row1024(nullptr, P.X2B + (size_t)r * D_MODEL, lane); cvt_row1024(nullptr, P.X3B + (size_t)r * D_MODEL, lane);
            for (int c = lane; c < 512; c += 64) { P.ATTA[(size_t)r * 512 + c] = 0; P.ATTB[(size_t)r * 1024 + c] = 0; P.ATTB[(size_t)r * 1024 + 512 + c] = 0; } } }
    for (int r = gw; r < BATCH * MEM_TOKENS; r += NGW) cvt_row1024(P.mem_prompt + (size_t)r * D_MODEL, P.MEMB + (size_t)r * D_MODEL, lane);
#pragma unroll 1
    for (int r = 2 * gw; r < DEPTH * PEER_EXPERTS; r += 2 * NGW) { f32x4 a[16];
#pragma unroll
        for (int q = 0; q < 4; ++q) { const float* s0 = (q < 2 ? P.peer_u : P.peer_v) + (size_t)(r + (q & 1)) * D_MODEL + 16 * lane;
#pragma unroll
            for (int j = 0; j < 4; ++j) a[4 * q + j] = *(const f32x4*)(s0 + 4 * j); }
#pragma unroll
        for (int q = 0; q < 4; ++q) { const float sc = q < 2 ? 256.f : 64.f; unsigned w[4];
#pragma unroll
            for (int j = 0; j < 4; ++j) { const f32x4 v = a[4 * q + j] * sc; int t = __builtin_amdgcn_cvt_pk_fp8_f32(v.x, v.y, 0, false); t = __builtin_amdgcn_cvt_pk_fp8_f32(v.z, v.w, t, true); w[j] = (unsigned)t; }
            u32x4 o; o.x = w[0]; o.y = w[1]; o.z = w[2]; o.w = w[3]; *(u32x4*)((q < 2 ? P.UB8 : P.VB8) + (size_t)(r + (q & 1)) * D_MODEL + 16 * lane) = o; } }
    for (int i = gw * 64 + lane; i < NPOS * 32; i += NGW * 64) { const int pos = i >> 5, d = i & 31; const double inv = exp2(-(double)d * (13.287712379549449 / 32.0)); const double turns = (double)pos * inv * 0.15915494309189535;
        const float fr = (float)(turns - floor(turns)); P.ROPE[pos * 64 + d] = __builtin_amdgcn_cosf(fr); P.ROPE[pos * 64 + 32 + d] = __builtin_amdgcn_sinf(fr); }
    for (int i = gw; i < 2 * CMP_HIDDEN; i += NGW) { const int ty = i / CMP_HIDDEN, hid = i % CMP_HIDDEN; float a = 0.f;
#pragma unroll 8
        for (int k = lane; k < CMP_BLOCK * HEAD_DIM; k += 64) a += P.cmp_pe[ty * CMP_BLOCK * HEAD_DIM + k] * P.cmp_w1[((size_t)ty * CMP_BLOCK * HEAD_DIM + k) * CMP_HIDDEN + hid];
        a = wave_sum(a); if (lane == 0) P.CBIAS[i] = a; }
    for (int it = gw; it < DEC_BATCH * (PAST_LEN / PAGE_SIZE); it += NGW) { const int n = it / (PAST_LEN / PAGE_SIZE), pi = it % (PAST_LEN / PAGE_SIZE); const int pg = P.page_table[it];
        const float* src = P.cache_nsa_kv + (size_t)pg * PAGE_SIZE * 512 + 4 * lane; const int ty = lane >> 5, kvh = (lane >> 4) & 1, d = (4 * lane) & 63;
        bf16* dst = P.AC + ((size_t)ty * ACROWS + ((size_t)(BATCH + n) * NSA_KV_HEADS + kvh) * NCH + pi * (PAGE_SIZE / 16)) * 1024 + d;
#pragma unroll 1
        for (int r0 = 0; r0 < PAGE_SIZE; r0 += 8) { f32x4 v[8];
#pragma unroll
            for (int u = 0; u < 8; ++u) v[u] = *(const f32x4*)(src + (size_t)(r0 + u) * 512);
#pragma unroll
            for (int u = 0; u < 8; ++u) { const int t = r0 + u; u32x2 o; o.x = pk2(v[u].x, v[u].y); o.y = pk2(v[u].z, v[u].w); *(u32x2*)(dst + (size_t)(t / 16) * 1024 + (t % 16) * 64) = o; } } }
    for (int g = 0; g < 4; ++g) { const int W = g < 3 ? dil_w(g) : SWA_WINDOW, RV = g < 3 ? 128 : 64;
        const f32x4* src = (const f32x4*)(g < 3 ? sel3c(P.cache_dil, g) : P.cache_nsa_win); f32x4* dst = (f32x4*)(g < 3 ? sel3(P.dil_s, g) : P.win_s);
        const long per = (long)(W - 1) * RV, nvec = (long)DEC_BATCH * per;
#pragma unroll 1
        for (long i0 = (long)gw * 512; i0 < nvec; i0 += (long)NGW * 512) { f32x4 v[8]; long idx[8];
#pragma unroll
            for (int u = 0; u < 8; ++u) { const long i = i0 + u * 64 + lane; const long ii = i < nvec ? i : nvec - 1; const long n = ii / per, o = ii % per; idx[u] = n * (per + RV) + o; v[u] = src[idx[u] + RV]; }
#pragma unroll
            for (int u = 0; u < 8; ++u) { const long i = i0 + u * 64 + lane; if (i < nvec) dst[idx[u]] = v[u]; } } }
}
DI void p0_wpk(const FP& P, const Ctx& C) {
    LAS float* sw = (LAS float*)C.lds;
    LAS float* sk = (LAS float*)(C.lds + 32768);
    constexpr int NIT = DEPTH * 16 * (D_MODEL / 64);
    for (int it = C.vcu; it < NIT; it += C.G) { const int l = it / (16 * (D_MODEL / 64)), rem = it % (16 * (D_MODEL / 64)), hc = rem / (D_MODEL / 64), kb = rem % (D_MODEL / 64);
        __syncthreads();
        for (int i = C.tid; i < 64 * 64; i += NTHREADS) { const int r = i >> 6, d = i & 63; sw[r * 65 + d] = P.peer_wq[((size_t)l * D_MODEL + kb * 64 + r) * 1024 + hc * 64 + d]; }
        for (int i = C.tid; i < 128 * 64; i += NTHREADS) { const int r = i >> 6, d = i & 63; sk[r * 65 + d] = P.peer_keys[(((size_t)l * 16 + hc) * PEER_KEYS + r) * 64 + d]; }
        __syncthreads();
        for (int o = C.tid; o < 128 * 64; o += NTHREADS) { const int kk = o >> 6, ki = o & 63; float a = 0.f;
#pragma unroll 16
            for (int d = 0; d < 64; ++d) a += sw[ki * 65 + d] * sk[kk * 65 + d];
            P.WPK_T[((size_t)l * NPK + hc * 128 + kk) * D_MODEL + kb * 64 + ki] = (bf16)f2bf(a); } }
    __syncthreads();
}

#define EPI_LOOP(...) int fr_l = fr, fq_l = fq; asm volatile("" : "+v"(fr_l), "+v"(fq_l));     \
    _Pragma("unroll") for (int ai = 0; ai < 2; ++ai) _Pragma("unroll") for (int m = 0; m < 4; ++m) { const int row = u.pm * 256 + ai * 128 + wr * 64 + m * 16 + fr_l; \
    _Pragma("unroll") for (int bj = 0; bj < 2; ++bj) { const int ct = bj * 128 + wc * 32 + fq_l * 8; const f32x4 v0 = acc[ai][bj][m][0], v1 = acc[ai][bj][m][1]; __VA_ARGS__ } asm volatile("" ::: "memory"); }
DI void rope4(const float* rope_row, int dp, const f32x4& v0, const f32x4& v1, f32x4& lo, f32x4& hi) {
    const f32x4 c = *(const f32x4*)(rope_row + dp), s = *(const f32x4*)(rope_row + 32 + dp);
    lo.x = v0.x * c.x - v0.y * s.x; hi.x = v0.y * c.x + v0.x * s.x; lo.y = v0.z * c.y - v0.w * s.y; hi.y = v0.w * c.y + v0.z * s.y;
    lo.z = v1.x * c.z - v1.y * s.z; hi.z = v1.y * c.z + v1.x * s.z; lo.w = v1.z * c.w - v1.w * s.w; hi.w = v1.w * c.w + v1.z * s.w; }
DI u32x2 pk4(const f32x4& v) { u32x2 o; o.x = pk2(v.x, v.y); o.y = pk2(v.z, v.w); return o; }
DI u32x4 pk8(const f32x4& a, const f32x4& b) { u32x4 o; o.x = pk2(a.x, a.y); o.y = pk2(a.z, a.w); o.z = pk2(b.x, b.y); o.w = pk2(b.z, b.w); return o; }
DI int dil_perm(int t, int d) { return (t % d) * (SEQ / d) + t / d; }
struct EpiA {
    static constexpr bool PERM = true, AFTER_DRAIN = false; const FP& P;
    DI void operator()(const f32x4 (&acc)[2][2][4][2], const pg8::Unit& u, int wr, int wc, int fr, int fq) const {
        const int t9 = u.pn; const int g = t9 / 3, j = t9 % 3;
        EPI_LOOP({ if (row < MP) { const int h = ct >> 6, e = ct & 63; const int pos = row_pos(row);
            if (t9 == 9) { *(u32x4*)(P.MQA + (size_t)row * 256 + ct) = pk8(v0 * QSCALE, v1 * QSCALE); }
            else if (j < 2) { f32x4 lo, hi; const int dp = e >> 1; rope4(P.ROPE + pos * 64, dp, v0, v1, lo, hi);
                if (j == 0) { bf16* q = P.QA + ((size_t)g * MPAD + row) * 256 + h * 64 + dp; *(u32x2*)q = pk4(lo * QSCALE); *(u32x2*)(q + 32) = pk4(hi * QSCALE); }
                else { if (row < M0) { bf16* kt = P.KA + ((size_t)(g * BATCH + row / SEQ) * DIL_HEADS + h) * 64 * SEQ; const int cm = dil_perm(pos, dil_d(g)); *(u32x2*)(kt + ktile_off(cm, dp)) = pk4(lo); *(u32x2*)(kt + ktile_off(cm, dp + 32)) = pk4(hi); }
                    const int W = dil_w(g); float* o = nullptr;
                    if (row >= M0) o = sel3(P.dil_s, g) + (((size_t)(row - M0) * W + W - 1) * 2 + 0) * 256; else if (pos >= SEQ - W) o = sel3(P.dil_p, g) + (((size_t)(row / SEQ) * W + pos - (SEQ - W)) * 2 + 0) * 256;
                    if (o) { *(f32x4*)(o + h * 64 + dp) = lo; *(f32x4*)(o + h * 64 + 32 + dp) = hi; } } }
            else { const int W = dil_w(g), d = dil_d(g); float* o = nullptr;
                if (row >= M0) o = sel3(P.dil_s, g) + (((size_t)(row - M0) * W + W - 1) * 2 + 1) * 256; else if (pos >= SEQ - W) o = sel3(P.dil_p, g) + (((size_t)(row / SEQ) * W + pos - (SEQ - W)) * 2 + 1) * 256;
                if (o) { *(f32x4*)(o + ct) = v0; *(f32x4*)(o + ct + 4) = v1; }
                if (row < M0) { bf16* vt = P.VTA + ((size_t)(g * BATCH + row / SEQ) * DIL_HEADS + h) * 64 * SEQ + vtile_off(e, dil_perm(pos, d));
                    vt[0] = (bf16)f2bf(v0.x); vt[8] = (bf16)f2bf(v0.y); vt[16] = (bf16)f2bf(v0.z); vt[24] = (bf16)f2bf(v0.w); vt[32] = (bf16)f2bf(v1.x); vt[40] = (bf16)f2bf(v1.y); vt[48] = (bf16)f2bf(v1.z); vt[56] = (bf16)f2bf(v1.w); } } } })
    }
};
struct EpiMem {
    static constexpr bool PERM = true, AFTER_DRAIN = false; const FP& P;
    DI void operator()(const f32x4 (&acc)[2][2][4][2], const pg8::Unit& u, int wr, int wc, int fr, int fq) const {
        const int l = u.pn >> 1, half = u.pn & 1;
        EPI_LOOP({ const int n = row / MEM_TOKENS, mt = row % MEM_TOKENS; float* o = P.mem_kv_p + (((size_t)l * BATCH + n) * MEM_TOKENS + mt) * 512 + half * 256 + ct; *(f32x4*)o = v0; *(f32x4*)(o + 4) = v1;
            if (half == 0) *(u32x4*)(P.MK + (((size_t)l * BATCH + n) * MEM_HEADS + (ct >> 6)) * MEM_TOKENS * 64 + ktile_off(mt, ct & 63)) = pk8(v0, v1);
            else { bf16* vt = P.MVT + (((size_t)l * BATCH + n) * MEM_HEADS + (ct >> 6)) * MEM_TOKENS * 64 + vtile_off(ct & 63, mt);
                vt[0] = (bf16)f2bf(v0.x); vt[8] = (bf16)f2bf(v0.y); vt[16] = (bf16)f2bf(v0.z); vt[24] = (bf16)f2bf(v0.w); vt[32] = (bf16)f2bf(v1.x); vt[40] = (bf16)f2bf(v1.y); vt[48] = (bf16)f2bf(v1.z); vt[56] = (bf16)f2bf(v1.w); } })
    }
};
struct EpiPre {
    static constexpr bool PERM = true, AFTER_DRAIN = false; const float* xa; const float* xb; float* pre;
    DI void operator()(const f32x4 (&acc)[2][2][4][2], const pg8::Unit& u, int wr, int wc, int fr, int fq) const {
        EPI_LOOP({ if (row < MP) { const int col = u.pn * 256 + ct; const float* x = (xb && row >= M0) ? xb + (size_t)(row - M0) * D_MODEL + col : xa + (size_t)row * D_MODEL + col;
            const f32x4 a = *(const f32x4*)x, b = *(const f32x4*)(x + 4); float* o = pre + (size_t)row * D_MODEL + col; *(f32x4*)o = a * ALPHA + v0; *(f32x4*)(o + 4) = b * ALPHA + v1; } })
    }
};
struct EpiF32 {
    static constexpr bool PERM = true, AFTER_DRAIN = false; float* out; int ldc; int nrows;
    DI void operator()(const f32x4 (&acc)[2][2][4][2], const pg8::Unit& u, int wr, int wc, int fr, int fq) const {
        EPI_LOOP({ if (row < nrows) { float* o = out + (size_t)row * ldc + u.pn * 256 + ct; *(f32x4*)o = v0; *(f32x4*)(o + 4) = v1; } })
    }
};
}
namespace fx {
struct Tile16 { f32x4 o[4]; float m, l; };
DI void tile_init(Tile16& T) { T.o[0] = T.o[1] = T.o[2] = T.o[3] = (f32x4){0.f, 0.f, 0.f, 0.f}; T.m = -INFINITY; T.l = 0.f; }
typedef __bf16 bf16x2_t __attribute__((ext_vector_type(2)));
DI unsigned cvtpk(float lo, float hi) { const f32x2 v = {lo, hi}; const bf16x2_t b = __builtin_convertvector(v, bf16x2_t); return __builtin_bit_cast(unsigned, b); }
struct KV8 { bf16x8 ka0, ka1, kb0, kb1, v0, v1, v2, v3; };
DI void kv_load(KV8& r, const bf16* k0, const bf16* k1, const bf16* v, long vs16) {
    r.ka0 = *(const bf16x8*)k0; r.ka1 = *(const bf16x8*)(k0 + 32); r.kb0 = *(const bf16x8*)k1; r.kb1 = *(const bf16x8*)(k1 + 32);
    r.v0 = *(const bf16x8*)v; r.v1 = *(const bf16x8*)(v + vs16); r.v2 = *(const bf16x8*)(v + 2 * vs16); r.v3 = *(const bf16x8*)(v + 3 * vs16); }
template <class MaskF> DI void tile_compute(Tile16& T, const bf16x8 (&qf)[2], const KV8& r, MaskF mask) {
    f32x4 s0 = (f32x4){0.f, 0.f, 0.f, 0.f}, s1 = (f32x4){0.f, 0.f, 0.f, 0.f};
    s0 = __builtin_amdgcn_mfma_f32_16x16x32_bf16(r.ka0, qf[0], s0, 0, 0, 0); s0 = __builtin_amdgcn_mfma_f32_16x16x32_bf16(r.ka1, qf[1], s0, 0, 0, 0);
    s1 = __builtin_amdgcn_mfma_f32_16x16x32_bf16(r.kb0, qf[0], s1, 0, 0, 0); s1 = __builtin_amdgcn_mfma_f32_16x16x32_bf16(r.kb1, qf[1], s1, 0, 0, 0);
    float s[8] = {s0.x, s0.y, s0.z, s0.w, s1.x, s1.y, s1.z, s1.w};
    float mx = -INFINITY;
#pragma unroll
    for (int e = 0; e < 8; ++e) { s[e] = mask(e) ? s[e] : -INFINITY; mx = fmaxf(mx, s[e]); }
    mx = fmaxf(mx, __shfl_xor(mx, 16)); mx = fmaxf(mx, __shfl_xor(mx, 32));
    const float mnew = fmaxf(T.m, mx), muse = (mnew == -INFINITY) ? 0.f : mnew;
    const float alpha = __builtin_amdgcn_exp2f(T.m - muse);
    float ls = 0.f;
#pragma unroll
    for (int e = 0; e < 8; ++e) { s[e] = __builtin_amdgcn_exp2f(s[e] - muse); ls += s[e]; }
    ls += __shfl_xor(ls, 16); ls += __shfl_xor(ls, 32);
    T.l = T.l * alpha + ls; T.m = mnew;
    u32x4 pw; pw.x = cvtpk(s[0], s[1]); pw.y = cvtpk(s[2], s[3]); pw.z = cvtpk(s[4], s[5]); pw.w = cvtpk(s[6], s[7]);
    const bf16x8 pf = __builtin_bit_cast(bf16x8, pw);
    T.o[0] = __builtin_amdgcn_mfma_f32_16x16x32_bf16(r.v0, pf, T.o[0] * alpha, 0, 0, 0); T.o[1] = __builtin_amdgcn_mfma_f32_16x16x32_bf16(r.v1, pf, T.o[1] * alpha, 0, 0, 0);
    T.o[2] = __builtin_amdgcn_mfma_f32_16x16x32_bf16(r.v2, pf, T.o[2] * alpha, 0, 0, 0); T.o[3] = __builtin_amdgcn_mfma_f32_16x16x32_bf16(r.v3, pf, T.o[3] * alpha, 0, 0, 0);
}
template <class BUF, class LD, class CP> DI void pipe2t(int n, LD ld, CP cp) { if (n <= 0) return; BUF A, B; ld(A, 0);
#pragma unroll 1
    for (int i = 0; i < n; i += 2) { ld(B, (i + 1 < n) ? i + 1 : i); cp(A, i); ld(A, (i + 2 < n) ? i + 2 : i); if (i + 1 < n) cp(B, i + 1); } }
template <class LD, class CP> DI void pipe2(int n, LD ld, CP cp) { if (n <= 0) return; KV8 A, B; ld(A, 0);
#pragma unroll 1
    for (int i = 0; i < n; i += 2) { ld(B, (i + 1 < n) ? i + 1 : i); cp(A, i); ld(A, (i + 2 < n) ? i + 2 : i); if (i + 1 < n) cp(B, i + 1); } }
DI void kv_load_t(KV8& r, const bf16* kt, const bf16* vt, int lane) {
    const bf16* k = kt + lane * 8; const bf16* v = vt + lane * 8;
    r.ka0 = *(const bf16x8*)k; r.ka1 = *(const bf16x8*)(k + 512); r.kb0 = *(const bf16x8*)(k + 1024); r.kb1 = *(const bf16x8*)(k + 1536);
    r.v0 = *(const bf16x8*)v; r.v1 = *(const bf16x8*)(v + 512); r.v2 = *(const bf16x8*)(v + 1024); r.v3 = *(const bf16x8*)(v + 1536); }
DI int krow_of(int i, int b) { return 8 * (i >> 2) + 4 * b + (i & 3); }

DI void dil_micro(const FP& P, int n, int h, int t0, int mt, int lane) {
    const int g = mt >> 4, idx = mt & 15, d = dil_d(g), per = 16 / d;
    const int r = idx / per, sub = idx % per, i0 = t0 / d + 16 * sub, ib = i0 - 128, NC = SEQ / d;
    const int q = lane & 15, c = lane >> 4;
    const bf16* Qb = P.QA + ((size_t)g * MPAD + (size_t)n * SEQ) * 256 + h * 64;
    const bf16* Kb = P.KA + ((size_t)(g * BATCH + n) * DIL_HEADS + h) * 64 * SEQ + (size_t)r * NC * 64; const bf16* Vb = P.VTA + ((size_t)(g * BATCH + n) * DIL_HEADS + h) * 64 * SEQ + (size_t)r * NC * 64;
    bf16x8 qf[2]; { const bf16* qp = Qb + (size_t)(r + d * (i0 + q)) * 256 + 8 * c; qf[0] = *(const bf16x8*)qp; qf[1] = *(const bf16x8*)(qp + 32); }
    Tile16 T; tile_init(T);
    const int qi = i0 + q; const int tb0 = ib >> 5  , nblk = ((i0 + 15) >> 5) - tb0 + 1;
    pipe2(nblk, [&](KV8& kv, int i) { int tb = tb0 + i; tb = tb < 0 ? 0 : tb; kv_load_t(kv, Kb + (size_t)tb * 2048, Vb + (size_t)tb * 2048, lane); },
          [&](const KV8& kv, int i) { const int kb = 32 * (tb0 + i); tile_compute(T, qf, kv, [&](int e) { const int ki = kb + 8 * c + e; return ki >= 0 && ki <= qi && qi - ki <= DIL_TAPS - 1; }); });
    const int row = n * SEQ + r + d * qi;
    float* op = P.DPART + (((size_t)g * MP + row) * DIL_HEADS + h) * 64 + 4 * c;
#pragma unroll
    for (int db = 0; db < 4; ++db) *(f32x4*)(op + 16 * db) = T.o[db];
    if (c == 0) { float* ml = P.DML + (((size_t)g * MP + row) * DIL_HEADS + h) * 2; ml[0] = T.m; ml[1] = T.l; }
}
DI void mem_micro(const FP& P, const bf16* Q  , int ldq, int row0, int layer, int n, int h, bf16* O  , int ldo, int lane) {
    const int q = lane & 15, c = lane >> 4;
    bf16x8 qf[2]; { const bf16* qp = Q + (size_t)(row0 + q) * ldq + 8 * c; qf[0] = *(const bf16x8*)qp; qf[1] = *(const bf16x8*)(qp + 32); }
    const bf16* Kb = P.MK + (((size_t)layer * BATCH + n) * MEM_HEADS + h) * MEM_TOKENS * 64; const bf16* Vb = P.MVT + (((size_t)layer * BATCH + n) * MEM_HEADS + h) * MEM_TOKENS * 64;
    Tile16 T; tile_init(T);
    pipe2(MEM_TOKENS / 32, [&](KV8& kv, int i) { kv_load_t(kv, Kb + (size_t)i * 2048, Vb + (size_t)i * 2048, lane); }, [&](const KV8& kv, int) { tile_compute(T, qf, kv, [&](int) { return true; }); });
    const float inv = 1.0f / T.l; bf16* op = O + (size_t)(row0 + q) * ldo + 4 * c;
#pragma unroll
    for (int db = 0; db < 4; ++db) *(u32x2*)(op + 16 * db) = pk4(T.o[db] * inv);
}
struct Dec { float m, l, o; };
template <class KF, class VF> DI void dec_chunk(Dec& D, const LAS float* q, int nk, KF kf, VF vf, int lane) {
    float s = -INFINITY;
    if (lane < nk) { const float* k = kf(lane); float a = 0.f;
#pragma unroll
        for (int d4 = 0; d4 < 16; ++d4) { const f32x4 kv = *(const f32x4*)(k + 4 * d4); a += kv.x * q[4 * d4] + kv.y * q[4 * d4 + 1] + kv.z * q[4 * d4 + 2] + kv.w * q[4 * d4 + 3]; }
        s = a; }
    const float mx = wave_max(s), mnew = fmaxf(D.m, mx), alpha = __builtin_amdgcn_exp2f(D.m - mnew);
    const float p = (lane < nk) ? __builtin_amdgcn_exp2f(s - mnew) : 0.f;
    D.l = D.l * alpha + wave_sum(p); D.m = mnew; float o = D.o * alpha;
    for (int j0 = 0; j0 < nk; j0 += 8) { float vv[8];
#pragma unroll
        for (int u = 0; u < 8; ++u) { const int jj = (j0 + u < nk) ? j0 + u : nk - 1; vv[u] = vf(jj)[lane]; }
#pragma unroll
        for (int u = 0; u < 8; ++u) { const float pj = (j0 + u < nk) ? __builtin_bit_cast(float, __builtin_amdgcn_readlane(__builtin_bit_cast(int, p), (j0 + u) & 63)) : 0.f; o += pj * vv[u]; } }
    D.o = o;
}
DI float dec_combine(const Ctx& C, const Dec& D) {
    LAS float* cb = (LAS float*)(C.lds + 4096);
    cb[C.wave * 66 + C.lane] = D.o; if (C.lane == 0) { cb[C.wave * 66 + 64] = D.m; cb[C.wave * 66 + 65] = D.l; }
    asm volatile("s_waitcnt lgkmcnt(0)" ::: "memory"); __syncthreads();
    float M = -INFINITY;
#pragma unroll
    for (int ww = 0; ww < NWAVES; ++ww) M = fmaxf(M, cb[ww * 66 + 64]);
    float L = 0.f, o = 0.f;
#pragma unroll
    for (int ww = 0; ww < NWAVES; ++ww) { const float mw = cb[ww * 66 + 64]; const float f = (mw == -INFINITY) ? 0.f : __builtin_amdgcn_exp2f(mw - M); L += f * cb[ww * 66 + 65]; o += f * cb[ww * 66 + C.lane]; }
    return o / L;
}
DI void atta_phase(const FP& P, const Ctx& C) {
    const int lane = C.lane, w = C.wave;
    constexpr int NT = SEQ / 256, NIT = BATCH * NT * DIL_HEADS;
    for (int it = C.vcu; it < NIT; it += C.G) { const int h = it % DIL_HEADS, tt = (it / DIL_HEADS) % NT, n = it / (DIL_HEADS * NT), t0 = tt * 256;
        for (int mt = w; mt < 48; mt += NWAVES) dil_micro(P, n, h, t0, mt, lane);
        asm volatile("s_waitcnt vmcnt(0)" ::: "memory"); __syncthreads();
        for (int i = C.tid; i < 256 * 16; i += NTHREADS) { const int tk = i >> 4, d4 = (i & 15) * 4; const int row = n * SEQ + t0 + tk;
            float mg[3], lg[3]; float M = -INFINITY;
#pragma unroll
            for (int g = 0; g < 3; ++g) { const float* ml = P.DML + (((size_t)g * MP + row) * DIL_HEADS + h) * 2; mg[g] = ml[0]; lg[g] = ml[1]; M = fmaxf(M, mg[g]); }
            f32x4 acc = (f32x4){0.f, 0.f, 0.f, 0.f}; float L = 0.f;
#pragma unroll
            for (int g = 0; g < 3; ++g) { const float wg = __builtin_amdgcn_exp2f(mg[g] - M); L += wg * lg[g]; acc += *(const f32x4*)(P.DPART + (((size_t)g * MP + row) * DIL_HEADS + h) * 64 + d4) * wg; }
            *(u32x2*)(P.ATTA + (size_t)row * 512 + h * 64 + d4) = pk4(acc * (1.0f / L)); }
        for (int mt = w; mt < 16; mt += NWAVES) mem_micro(P, P.MQA + h * 64, 256, n * SEQ + t0 + 16 * mt, 0, n, h, P.ATTA + 256 + h * 64, 512, lane);
        __syncthreads();
    }
    LAS float* qs = (LAS float*)C.lds;
    for (int it = C.vcu; it < DEC_BATCH * DIL_HEADS * 2; it += C.G) { const int kind = it & 1, h = (it >> 1) % DIL_HEADS, ns = (it >> 1) / DIL_HEADS, row = M0 + ns;
        __syncthreads();
        if (kind == 0) { if (C.tid < 192) qs[C.tid] = bf2f(P.QA[((size_t)(C.tid >> 6) * MPAD + row) * 256 + h * 64 + (C.tid & 63)]); } else { if (C.tid < 64) qs[C.tid] = bf2f(P.MQA[(size_t)row * 256 + h * 64 + C.tid]); }
        asm volatile("s_waitcnt lgkmcnt(0)" ::: "memory"); __syncthreads();
        Dec D; D.m = -INFINITY; D.l = 0.f; D.o = 0.f;
        if (kind == 0) { constexpr int CPG = (DIL_TAPS + 63) / 64;
            for (int ck = w; ck < 3 * CPG; ck += NWAVES) { const int g = ck / CPG, j0 = (ck % CPG) * 64; const int W = dil_w(g), d = dil_d(g); const float* cache = sel3c(P.cache_dil, g) + (size_t)ns * W * 512; const float* newrow = sel3(P.dil_s, g) + ((size_t)ns * W + W - 1) * 512;
                const int nk = (DIL_TAPS - j0) < 64 ? (DIL_TAPS - j0) : 64;
                dec_chunk(D, qs + g * 64, nk, [&](int j) { const int tap = j0 + j; return (tap == 0 ? newrow : cache + (size_t)(W - d * tap) * 512) + h * 64; },
                          [&](int j) { const int tap = j0 + j; return (tap == 0 ? newrow : cache + (size_t)(W - d * tap) * 512) + 256 + h * 64; }, lane); } }
        else { const float* mk = P.cache_mem_kv + ((size_t)0 * DEC_BATCH + ns) * MEM_TOKENS * 512;
            for (int ck = w; ck < MEM_TOKENS / 64; ck += NWAVES) { const int j0 = ck * 64; dec_chunk(D, qs, 64, [&](int j) { return mk + (size_t)(j0 + j) * 512 + h * 64; }, [&](int j) { return mk + (size_t)(j0 + j) * 512 + 256 + h * 64; }, lane); } }
        const float o = dec_combine(C, D);
        if (w == 0) P.ATTA[(size_t)row * 512 + (kind == 0 ? 0 : 256) + h * 64 + lane] = (bf16)f2bf(o);
    }
    __syncthreads();
}
DI void ln_phase(const FP& P, const Ctx& C, const float* pre, const float* gam, const float* bet, float* xo, bf16* xb, float* yp, float* ys) {
    const int gw = C.vcu * NWAVES + C.wave, NGW = C.G * NWAVES, lane = C.lane;
    for (int r = gw; r < MP; r += NGW) { const float* x = pre + (size_t)r * D_MODEL; f32x4 v[4]; float s = 0.f;
#pragma unroll
        for (int j = 0; j < 4; ++j) { v[j] = *(const f32x4*)(x + 256 * j + 4 * lane); s += (v[j].x + v[j].y) + (v[j].z + v[j].w); }
        const float mu = wave_sum(s) * (1.0f / D_MODEL); float s2 = 0.f;
#pragma unroll
        for (int j = 0; j < 4; ++j) { v[j] = v[j] - mu; s2 += (v[j].x * v[j].x + v[j].y * v[j].y) + (v[j].z * v[j].z + v[j].w * v[j].w); }
        const float rs = 1.0f / sqrtf(wave_sum(s2) * (1.0f / D_MODEL) + LN_EPS);
#pragma unroll
        for (int j = 0; j < 4; ++j) { const f32x4 gg = *(const f32x4*)(gam + 256 * j + 4 * lane), bb = *(const f32x4*)(bet + 256 * j + 4 * lane); const f32x4 o = v[j] * rs * gg + bb;
            if (xo) *(f32x4*)(xo + (size_t)r * D_MODEL + 256 * j + 4 * lane) = o;
            if (xb) *(u32x2*)(xb + (size_t)r * D_MODEL + 256 * j + 4 * lane) = pk4(o);
            if (yp) { if (r < M0) *(f32x4*)(yp + (size_t)r * D_MODEL + 256 * j + 4 * lane) = o; else *(f32x4*)(ys + (size_t)(r - M0) * D_MODEL + 256 * j + 4 * lane) = o; } }
    }
}
}
namespace fx {
#define INS16(V, I, v_, i_) do { const float _v = (v_); const int _i = (i_); bool _c[16]; _Pragma("unroll") for (int _k = 0; _k < 16; ++_k) _c[_k] = _v > V[_k]; \
    _Pragma("unroll") for (int _k = 15; _k >= 1; --_k) { V[_k] = _c[_k] ? (_c[_k - 1] ? V[_k - 1] : _v) : V[_k]; I[_k] = _c[_k] ? (_c[_k - 1] ? I[_k - 1] : _i) : I[_k]; } \
    V[0] = _c[0] ? _v : V[0]; I[0] = _c[0] ? _i : I[0]; } while (0)
DI void wave_top16_128(float a, float b, int lane, float& outv, int& outi) {
    outv = -INFINITY; outi = 0;
#pragma unroll 1
    for (int k = 0; k < 16; ++k) { const float m = wave_max(fmaxf(a, b)); const unsigned long long ba = __ballot(a == m), bb = __ballot(b == m); int idx;
        if (ba) { const int l = __builtin_ctzll(ba); idx = l; if (lane == l) a = -INFINITY; } else { const int l = __builtin_ctzll(bb); idx = 64 + l; if (lane == l) b = -INFINITY; }
        if (lane == k) { outv = m; outi = idx; } }
}
DI void topk_wave_item(const FP& P, long it, int lane) {
    const float* s = P.SCO + it * 256; float v1, v2; int i1, i2;
    wave_top16_128(s[lane], s[64 + lane], lane, v1, i1); wave_top16_128(s[128 + lane], s[192 + lane], lane, v2, i2);
    int a = 0, rem = lane; bool valid = false;
    for (int aa = 0; aa < 16; ++aa) { const int nb = 16 / (aa + 1); if (!valid) { if (rem < nb) { a = aa; valid = true; } else rem -= nb; } }
    const int b = valid ? rem : 0;
    float cs = __shfl(v1, a) + __shfl(v2, b); const int ce = __shfl(i1, a) * PEER_KEYS + __shfl(i2, b); if (!valid) cs = -INFINITY;
    float tv = -INFINITY; int te = 0;
#pragma unroll 1
    for (int k = 0; k < 16; ++k) { const float m = wave_max(cs); const unsigned long long bm = __ballot(cs == m); const int l = __builtin_ctzll(bm); const int e = __shfl(ce, l); if (lane == l) cs = -INFINITY; if (lane == k) { tv = m; te = e; } }
    const float mx = __shfl(tv, 0); const float ex = (lane < 16) ? __expf(tv - mx) : 0.f; const float z = wave_sum(ex);
    if (lane < 16) { P.SELG[it * 16 + lane] = ex / z; P.SELE[it * 16 + lane] = te; }
}
#define KINS16(V, key_) do { const float _key = (key_); _Pragma("unroll") for (int _k = 15; _k >= 1; --_k) V[_k] = __builtin_amdgcn_fmed3f(V[_k - 1], V[_k], _key); V[0] = fmaxf(V[0], _key); } while (0)
DI float pack_key(float v, unsigned lowbits, unsigned mask) { return __builtin_bit_cast(float, (__builtin_bit_cast(unsigned, v) & ~mask) | lowbits); }
DI void topk_phase(const FP& P, const Ctx& C) {
    const int lane = C.lane; LAS float* st = (LAS float*)(C.lds + C.wave * 16384);
    const int NWI = (M0 * PEER_HEADS) / 64;
    for (int wi = C.vcu * NWAVES + C.wave; wi < NWI; wi += C.G * NWAVES) {
        const long it0 = (long)wi * 64; const long it = it0 + lane;
        float V1[16], V2[16], V3[16];
#pragma unroll
        for (int k = 0; k < 16; ++k) { V1[k] = V2[k] = V3[k] = -INFINITY; }
#pragma unroll 1
        for (int ch = 0; ch < 8; ++ch) {
#pragma unroll
            for (int u = 0; u < 8; ++u) { const int f4 = u * 64 + lane, j = f4 >> 3, q = f4 & 7, hf = q >> 2, c4 = (q & 3) * 4; const long itj = it0 + j;
                const f32x4 v = *(const f32x4*)(P.SCO + itj * 256 + hf * 128 + ch * 16 + c4);
                st[j * 33 + hf * 16 + c4] = v.x; st[j * 33 + hf * 16 + c4 + 1] = v.y; st[j * 33 + hf * 16 + c4 + 2] = v.z; st[j * 33 + hf * 16 + c4 + 3] = v.w; }
            asm volatile("s_waitcnt lgkmcnt(0)" ::: "memory");
#pragma unroll 4
            for (int c = 0; c < 16; ++c) { const float va = st[lane * 33 + c], vb = st[lane * 33 + 16 + c]; const unsigned lb = 127u - (unsigned)(ch * 16 + c); KINS16(V1, pack_key(va, lb, 127u)); KINS16(V2, pack_key(vb, lb, 127u)); }
            asm volatile("s_waitcnt lgkmcnt(0)" ::: "memory");
        }
        LAS int* lc = (LAS int*)st;
        { int ord = 0;
#pragma unroll
          for (int a = 0; a < 16; ++a) { const unsigned ba = __builtin_bit_cast(unsigned, V1[a]); const float va = __builtin_bit_cast(float, ba & ~127u); const int ia = 127 - (int)(ba & 127u);
#pragma unroll
              for (int b = 0; b < 16; ++b) if ((a + 1) * (b + 1) <= 16) { const unsigned bb = __builtin_bit_cast(unsigned, V2[b]); const float vb = __builtin_bit_cast(float, bb & ~127u); const int ib = 127 - (int)(bb & 127u);
                  lc[lane * 51 + ord] = ia * PEER_KEYS + ib; KINS16(V3, pack_key(va + vb, 63u - (unsigned)ord, 63u)); ++ord; } } }
        asm volatile("s_waitcnt lgkmcnt(0)" ::: "memory");
        float g[16]; int e[16]; float z = 0.f; const float vmax = __builtin_bit_cast(float, __builtin_bit_cast(unsigned, V3[0]) & ~63u);
#pragma unroll
        for (int k = 0; k < 16; ++k) { const unsigned bk = __builtin_bit_cast(unsigned, V3[k]); e[k] = lc[lane * 51 + 63 - (int)(bk & 63u)]; g[k] = __expf(__builtin_bit_cast(float, bk & ~63u) - vmax); z += g[k]; }
        const float iz = 1.0f / z;
#pragma unroll
        for (int k4 = 0; k4 < 4; ++k4) { *(f32x4*)(P.SELG + it * 16 + 4 * k4) = (f32x4){g[4 * k4] * iz, g[4 * k4 + 1] * iz, g[4 * k4 + 2] * iz, g[4 * k4 + 3] * iz};
            *(int4*)(P.SELE + it * 16 + 4 * k4) = make_int4(e[4 * k4], e[4 * k4 + 1], e[4 * k4 + 2], e[4 * k4 + 3]); }
        asm volatile("s_waitcnt lgkmcnt(0)" ::: "memory");
    }
    for (int si = C.vcu * NWAVES + C.wave; si < DEC_BATCH * PEER_HEADS; si += C.G * NWAVES) topk_wave_item(P, (long)M0 * PEER_HEADS + si, lane);
    __syncthreads();
}
constexpr float PEER_SU = 256.f, PEER_SV = 64.f;
DI float dot16_fp8(const u32x4& w, const f32x2 (&x2)[8]) { f32x2 a = {0.f, 0.f};
    a += __builtin_amdgcn_cvt_pk_f32_fp8((int)w.x, false) * x2[0]; a += __builtin_amdgcn_cvt_pk_f32_fp8((int)w.x, true) * x2[1];
    a += __builtin_amdgcn_cvt_pk_f32_fp8((int)w.y, false) * x2[2]; a += __builtin_amdgcn_cvt_pk_f32_fp8((int)w.y, true) * x2[3];
    a += __builtin_amdgcn_cvt_pk_f32_fp8((int)w.z, false) * x2[4]; a += __builtin_amdgcn_cvt_pk_f32_fp8((int)w.z, true) * x2[5];
    a += __builtin_amdgcn_cvt_pk_f32_fp8((int)w.w, false) * x2[6]; a += __builtin_amdgcn_cvt_pk_f32_fp8((int)w.w, true) * x2[7];
    return a.x + a.y; }
DI void axpy16_fp8(const u32x4& w, float s, f32x2 (&o2)[8]) { const f32x2 s2 = {s, s};
    o2[0] += __builtin_amdgcn_cvt_pk_f32_fp8((int)w.x, false) * s2; o2[1] += __builtin_amdgcn_cvt_pk_f32_fp8((int)w.x, true) * s2;
    o2[2] += __builtin_amdgcn_cvt_pk_f32_fp8((int)w.y, false) * s2; o2[3] += __builtin_amdgcn_cvt_pk_f32_fp8((int)w.y, true) * s2;
    o2[4] += __builtin_amdgcn_cvt_pk_f32_fp8((int)w.z, false) * s2; o2[5] += __builtin_amdgcn_cvt_pk_f32_fp8((int)w.z, true) * s2;
    o2[6] += __builtin_amdgcn_cvt_pk_f32_fp8((int)w.w, false) * s2; o2[7] += __builtin_amdgcn_cvt_pk_f32_fp8((int)w.w, true) * s2; }
#if defined(PEER_SHARD) || defined(PEER_SHARD2)
#define PEER_FIRST_ROUND nrounds
#else
#define PEER_FIRST_ROUND 0
#endif
DI float rdlane(float v, int l) { return __builtin_bit_cast(float, __builtin_amdgcn_readlane(__builtin_bit_cast(int, v), l)); }
DI void peer_phase(const FP& P, const Ctx& C, int layer, const float* xin, float* fout, float* fout_s, bf16* xb, bool samples_only = false) {
    const int lane = C.lane; const unsigned char* U = P.UB8 + (size_t)layer * PEER_EXPERTS * D_MODEL; const unsigned char* Vt = P.VB8 + (size_t)layer * PEER_EXPERTS * D_MODEL;
    const float* gam = P.ln_g + ((size_t)layer * 2 + 1) * D_MODEL; const float* bet = P.ln_b + ((size_t)layer * 2 + 1) * D_MODEL;
    const int nrounds = (M0 + C.G * NWAVES - 1) / (C.G * NWAVES);
#pragma unroll 1
    for (int rd = samples_only ? nrounds : 0; rd <= nrounds; ++rd) {
        const bool smp = (rd == nrounds); int r = smp ? M0 + C.vcu : rd * C.G * NWAVES + C.vcu * NWAVES + C.wave; if (smp ? (C.vcu >= DEC_BATCH) : (r >= M0)) continue;
        const int pb = smp ? 16 * C.wave : 0, pe = smp ? pb + 16 : 128;
        f32x2 x2[8], o2[8];
#pragma unroll
        for (int j = 0; j < 4; ++j) { const f32x4 a = *(const f32x4*)(xin + (size_t)r * D_MODEL + 16 * lane + 4 * j); x2[2 * j] = (f32x2){a.x, a.y}; x2[2 * j + 1] = (f32x2){a.z, a.w}; }
#pragma unroll
        for (int k = 0; k < 8; ++k) o2[k] = (f32x2){0.f, 0.f};
        const int e_l = P.SELE[(size_t)r * 128 + lane], e_h = P.SELE[(size_t)r * 128 + 64 + lane]; const float g_l = P.SELG[(size_t)r * 128 + lane], g_h = P.SELG[(size_t)r * 128 + 64 + lane];
#pragma unroll 1
        for (int b0 = pb; b0 < pe; b0 += 8) {
            u32x4 uw[8], vw[8];
#pragma unroll
            for (int k = 0; k < 8; ++k) { const int hk = b0 + k; const int e = (hk < 64) ? __builtin_amdgcn_readlane(e_l, hk & 63) : __builtin_amdgcn_readlane(e_h, hk & 63);
                uw[k] = *(const u32x4*)(U + (size_t)e * D_MODEL + 16 * lane); vw[k] = *(const u32x4*)(Vt + (size_t)e * D_MODEL + 16 * lane); }
            float d[8];
#pragma unroll
            for (int k = 0; k < 8; ++k) d[k] = dot16_fp8(uw[k], x2);
            float e4[4], e2[2], e1;
            { const bool hi = lane & 1;
#pragma unroll
              for (int i = 0; i < 4; ++i) { const float keep = hi ? d[4 + i] : d[i], send = hi ? d[i] : d[4 + i]; e4[i] = keep + __shfl_xor(send, 1); } }
            { const bool hi = lane & 2;
#pragma unroll
              for (int i = 0; i < 2; ++i) { const float keep = hi ? e4[2 + i] : e4[i], send = hi ? e4[i] : e4[2 + i]; e2[i] = keep + __shfl_xor(send, 2); } }
            { const bool hi = lane & 4; const float keep = hi ? e2[1] : e2[0], send = hi ? e2[0] : e2[1]; e1 = keep + __shfl_xor(send, 4); }
            e1 += __shfl_xor(e1, 8); e1 += __shfl_xor(e1, 16); e1 += __shfl_xor(e1, 32);
            const int myk = 4 * (lane & 1) + (lane & 2) + ((lane >> 2) & 1); const int myhk = b0 + myk;
            const float myg = (myhk < 64) ? __shfl(g_l, myhk & 63) : __shfl(g_h, myhk & 63);
            const float act = myg * gelu_tanh(e1 * (1.0f / PEER_SU)) * (1.0f / PEER_SV);
#pragma unroll
            for (int k = 0; k < 8; ++k) { const int src = (k >> 2) | (((k >> 1) & 1) << 1) | ((k & 1) << 2); axpy16_fp8(vw[k], rdlane(act, src), o2); }
        }
        if (smp) {
            LAS float* red = (LAS float*)C.lds;
#pragma unroll
            for (int k = 0; k < 8; ++k) { red[C.wave * 1024 + 16 * lane + 2 * k] = o2[k].x; red[C.wave * 1024 + 16 * lane + 2 * k + 1] = o2[k].y; }
            asm volatile("s_waitcnt lgkmcnt(0)" ::: "memory"); __syncthreads();
            if (C.wave == 0) {
#pragma unroll
                for (int k = 0; k < 8; ++k) { float ax = 0.f, ay = 0.f;
#pragma unroll
                    for (int ww = 0; ww < NWAVES; ++ww) { ax += red[ww * 1024 + 16 * lane + 2 * k]; ay += red[ww * 1024 + 16 * lane + 2 * k + 1]; } o2[k] = (f32x2){ax, ay}; } }
            __syncthreads();
            if (C.wave != 0) continue; }
        float s = 0.f;
#pragma unroll
        for (int k = 0; k < 8; ++k) { o2[k] += x2[k] * ALPHA; s += o2[k].x + o2[k].y; }
        const float mu = wave_sum(s) * (1.0f / D_MODEL); float s2 = 0.f;
#pragma unroll
        for (int k = 0; k < 8; ++k) { o2[k] -= mu; s2 += o2[k].x * o2[k].x + o2[k].y * o2[k].y; }
        const float rs = 1.0f / sqrtf(wave_sum(s2) * (1.0f / D_MODEL) + LN_EPS);
        float* frow = (r < M0) ? fout + (size_t)r * D_MODEL : fout_s + (size_t)(r - M0) * D_MODEL;
#pragma unroll
        for (int j = 0; j < 4; ++j) { const int c0 = 16 * lane + 4 * j; const f32x4 gg = *(const f32x4*)(gam + c0), bb = *(const f32x4*)(bet + c0);
            const f32x4 y = (f32x4){o2[2 * j].x * rs, o2[2 * j].y * rs, o2[2 * j + 1].x * rs, o2[2 * j + 1].y * rs} * gg + bb;
            *(f32x4*)(frow + c0) = y; if (xb) *(u32x2*)(xb + (size_t)r * D_MODEL + c0) = pk4(y); }
    }
}
DI void peer_u_phase(const FP& P, const Ctx& C, int layer, const bf16* xb16) {
    const int lane = C.lane; const unsigned char* U = P.UB8 + (size_t)layer * PEER_EXPERTS * D_MODEL;
    const int s = (int)(blockIdx.x & 7), nw = (C.G >> 3) * NWAVES, widx = (int)(blockIdx.x >> 3) * NWAVES + C.wave;
#pragma unroll 1
    for (int r = widx; r < MP; r += nw) {
        const int e0 = P.SELE[(size_t)r * 128 + lane], e1 = P.SELE[(size_t)r * 128 + 64 + lane]; const float g0 = P.SELG[(size_t)r * 128 + lane], g1 = P.SELG[(size_t)r * 128 + 64 + lane];
        unsigned long long b0 = __ballot((e0 >> 11) == s), b1 = __ballot((e1 >> 11) == s);
        if ((b0 | b1) == 0ull) continue;
        f32x2 x2[8]; { const u32x4 xa = *(const u32x4*)(xb16 + (size_t)r * D_MODEL + 16 * lane), xc = *(const u32x4*)(xb16 + (size_t)r * D_MODEL + 16 * lane + 8);
            x2[0] = (f32x2){bflo(xa.x), bfhi(xa.x)}; x2[1] = (f32x2){bflo(xa.y), bfhi(xa.y)}; x2[2] = (f32x2){bflo(xa.z), bfhi(xa.z)}; x2[3] = (f32x2){bflo(xa.w), bfhi(xa.w)};
            x2[4] = (f32x2){bflo(xc.x), bfhi(xc.x)}; x2[5] = (f32x2){bflo(xc.y), bfhi(xc.y)}; x2[6] = (f32x2){bflo(xc.z), bfhi(xc.z)}; x2[7] = (f32x2){bflo(xc.w), bfhi(xc.w)}; }
#pragma unroll 1
        while ((b0 | b1) != 0ull) {
            int hk[8]; u32x4 uw[8]; int nv = 0;
#pragma unroll
            for (int k = 0; k < 8; ++k) { int h;
                if (b0) { h = __builtin_ctzll(b0); b0 &= b0 - 1; ++nv; } else if (b1) { h = 64 + __builtin_ctzll(b1); b1 &= b1 - 1; ++nv; } else h = hk[k > 0 ? k - 1 : 0];
                hk[k] = h; const int e = (h < 64) ? __builtin_amdgcn_readlane(e0, h & 63) : __builtin_amdgcn_readlane(e1, h & 63);
                uw[k] = *(const u32x4*)(U + (size_t)e * D_MODEL + 16 * lane); }
            float d[8];
#pragma unroll
            for (int k = 0; k < 8; ++k) d[k] = dot16_fp8(uw[k], x2);
            float e4[4], e2[2], e1s;
            { const bool hi = lane & 1;
#pragma unroll
              for (int i = 0; i < 4; ++i) { const float keep = hi ? d[4 + i] : d[i], send = hi ? d[i] : d[4 + i]; e4[i] = keep + __shfl_xor(send, 1); } }
            { const bool hi = lane & 2;
#pragma unroll
              for (int i = 0; i < 2; ++i) { const float keep = hi ? e4[2 + i] : e4[i], send = hi ? e4[i] : e4[2 + i]; e2[i] = keep + __shfl_xor(send, 2); } }
            { const bool hi = lane & 4; const float keep = hi ? e2[1] : e2[0], send = hi ? e2[0] : e2[1]; e1s = keep + __shfl_xor(send, 4); }
            e1s += __shfl_xor(e1s, 8); e1s += __shfl_xor(e1s, 16); e1s += __shfl_xor(e1s, 32);
            const int myk = 4 * (lane & 1) + (lane & 2) + ((lane >> 2) & 1);
            int myh = hk[0];
#pragma unroll
            for (int k = 1; k < 8; ++k) myh = (myk == k) ? hk[k] : myh;
            const float ga = __shfl(g0, myh & 63), gb = __shfl(g1, myh & 63); const float myg = (myh < 64) ? ga : gb;
            if (lane < 8 && myk < nv) P.SCO[(size_t)r * 128 + myh] = myg * gelu_tanh(e1s * (1.0f / PEER_SU)) * (1.0f / PEER_SV);
        }
    }
}
DI void peer_v_phase(const FP& P, const Ctx& C, int layer, const float* xin, float* fout, float* fout_s, bf16* xb) {
    const int lane = C.lane; const unsigned char* Vt = P.VB8 + (size_t)layer * PEER_EXPERTS * D_MODEL;
    const float* gam = P.ln_g + ((size_t)layer * 2 + 1) * D_MODEL; const float* bet = P.ln_b + ((size_t)layer * 2 + 1) * D_MODEL;
    const int nrounds = (M0 + C.G * NWAVES - 1) / (C.G * NWAVES);
#pragma unroll 1
    for (int rd = 0; rd <= nrounds; ++rd) {
        const bool smp = (rd == nrounds); int r = smp ? M0 + C.vcu : rd * C.G * NWAVES + C.vcu * NWAVES + C.wave; if (smp ? (C.vcu >= DEC_BATCH) : (r >= M0)) continue;
        const int pb = smp ? 16 * C.wave : 0, pe = smp ? pb + 16 : 128;
        f32x2 x2[8], o2[8];
#pragma unroll
        for (int j = 0; j < 4; ++j) { const f32x4 a = *(const f32x4*)(xin + (size_t)r * D_MODEL + 16 * lane + 4 * j); x2[2 * j] = (f32x2){a.x, a.y}; x2[2 * j + 1] = (f32x2){a.z, a.w}; }
#pragma unroll
        for (int k = 0; k < 8; ++k) o2[k] = (f32x2){0.f, 0.f};
        const int e_l = P.SELE[(size_t)r * 128 + lane], e_h = P.SELE[(size_t)r * 128 + 64 + lane]; const float a_l = P.SCO[(size_t)r * 128 + lane], a_h = P.SCO[(size_t)r * 128 + 64 + lane];
#pragma unroll 1
        for (int b0 = pb; b0 < pe; b0 += 16) { u32x4 vw[16];
#pragma unroll
            for (int k = 0; k < 16; ++k) { const int hk = b0 + k; const int e = (hk < 64) ? __builtin_amdgcn_readlane(e_l, hk & 63) : __builtin_amdgcn_readlane(e_h, hk & 63); vw[k] = *(const u32x4*)(Vt + (size_t)e * D_MODEL + 16 * lane); }
#pragma unroll
            for (int k = 0; k < 16; ++k) { const int hk = b0 + k; axpy16_fp8(vw[k], (hk < 64) ? rdlane(a_l, hk & 63) : rdlane(a_h, hk & 63), o2); } }
        if (smp) {
            LAS float* red = (LAS float*)C.lds;
#pragma unroll
            for (int k = 0; k < 8; ++k) { red[C.wave * 1024 + 16 * lane + 2 * k] = o2[k].x; red[C.wave * 1024 + 16 * lane + 2 * k + 1] = o2[k].y; }
            asm volatile("s_waitcnt lgkmcnt(0)" ::: "memory"); __syncthreads();
            if (C.wave == 0) {
#pragma unroll
                for (int k = 0; k < 8; ++k) { float ax = 0.f, ay = 0.f;
#pragma unroll
                    for (int ww = 0; ww < NWAVES; ++ww) { ax += red[ww * 1024 + 16 * lane + 2 * k]; ay += red[ww * 1024 + 16 * lane + 2 * k + 1]; } o2[k] = (f32x2){ax, ay}; } }
            __syncthreads();
            if (C.wave != 0) continue; }
        float s = 0.f;
#pragma unroll
        for (int k = 0; k < 8; ++k) { o2[k] += x2[k] * ALPHA; s += o2[k].x + o2[k].y; }
        const float mu = wave_sum(s) * (1.0f / D_MODEL); float s2 = 0.f;
#pragma unroll
        for (int k = 0; k < 8; ++k) { o2[k] -= mu; s2 += o2[k].x * o2[k].x + o2[k].y * o2[k].y; }
        const float rs = 1.0f / sqrtf(wave_sum(s2) * (1.0f / D_MODEL) + LN_EPS);
        float* frow = (r < M0) ? fout + (size_t)r * D_MODEL : fout_s + (size_t)(r - M0) * D_MODEL;
#pragma unroll
        for (int j = 0; j < 4; ++j) { const int c0 = 16 * lane + 4 * j; const f32x4 gg = *(const f32x4*)(gam + c0), bb = *(const f32x4*)(bet + c0);
            const f32x4 y = (f32x4){o2[2 * j].x * rs, o2[2 * j].y * rs, o2[2 * j + 1].x * rs, o2[2 * j + 1].y * rs} * gg + bb;
            *(f32x4*)(frow + c0) = y; if (xb) *(u32x2*)(xb + (size_t)r * D_MODEL + c0) = pk4(y); }
    }
}
constexpr int PSH_LIST = 512;
struct PG4 { u32x4 u[4], v[4]; };
DI void peer_sharded_phase(const FP& P, const Ctx& C, int layer, const float* xin, const bf16* xb16, float* fout, float* fout_s, bf16* xb) {
    const int lane = C.lane; const unsigned char* U = P.UB8 + (size_t)layer * PEER_EXPERTS * D_MODEL; const unsigned char* Vt = P.VB8 + (size_t)layer * PEER_EXPERTS * D_MODEL;
    const float* gam = P.ln_g + ((size_t)layer * 2 + 1) * D_MODEL; const float* bet = P.ln_b + ((size_t)layer * 2 + 1) * D_MODEL;
    LAS unsigned char* wl = C.lds + C.wave * 16384; LAS bf16* xs = (LAS bf16*)wl; LAS int* lst = (LAS int*)(wl + 8192);
    const int NW = C.G * NWAVES, gw = C.vcu * NWAVES + C.wave; const int nquads = (M0 / NW) / 4;
#pragma unroll 1
    for (int qd = 0; qd < nquads; ++qd) {
#define PSH_ROW(j) const int row##j = (qd * 4 + j) * NW + gw; const int el##j = P.SELE[(size_t)row##j * 128 + lane], eh##j = P.SELE[(size_t)row##j * 128 + 64 + lane]; const float gl##j = P.SELG[(size_t)row##j * 128 + lane], gh##j = P.SELG[(size_t)row##j * 128 + 64 + lane]; \
        { const u32x4 xa = *(const u32x4*)(xb16 + (size_t)row##j * D_MODEL + 16 * lane), xc = *(const u32x4*)(xb16 + (size_t)row##j * D_MODEL + 16 * lane + 8); *(LAS u32x4*)(xs + j * 1024 + 16 * lane) = xa; *(LAS u32x4*)(xs + j * 1024 + 16 * lane + 8) = xc; } \
        f32x2 oa##j[8]; _Pragma("unroll") for (int k = 0; k < 8; ++k) oa##j[k] = (f32x2){0.f, 0.f};
        PSH_ROW(0) PSH_ROW(1) PSH_ROW(2) PSH_ROW(3)
#pragma unroll 1
        for (int s = 0; s < 16; ++s) {
            int n = 0;
#define PSH_SCAN(j) { unsigned long long b0 = __ballot((el##j >> 10) == s), b1 = __ballot((eh##j >> 10) == s); \
                while (b0) { const int h = __builtin_ctzll(b0); b0 &= b0 - 1; const int e = __builtin_amdgcn_readlane(el##j, h); const int g = __builtin_amdgcn_readlane(__builtin_bit_cast(int, gl##j), h); \
                    if (lane == 0) { lst[4 * n] = e; lst[4 * n + 1] = g; lst[4 * n + 2] = j; } ++n; } \
                while (b1) { const int h = __builtin_ctzll(b1); b1 &= b1 - 1; const int e = __builtin_amdgcn_readlane(eh##j, h); const int g = __builtin_amdgcn_readlane(__builtin_bit_cast(int, gh##j), h); \
                    if (lane == 0) { lst[4 * n] = e; lst[4 * n + 1] = g; lst[4 * n + 2] = j; } ++n; } }
            PSH_SCAN(0) PSH_SCAN(1) PSH_SCAN(2) PSH_SCAN(3)
            asm volatile("s_waitcnt lgkmcnt(0)" ::: "memory");
            if (n == 0) continue;
            const int ngrp = (n + 3) >> 2;
#define PSH_LD(b, gi_) do { const int gi = (gi_); _Pragma("unroll") for (int k = 0; k < 4; ++k) { int i = 4 * gi + k; i = i < n ? i : n - 1; const int e = __builtin_amdgcn_readfirstlane(lst[4 * i]); \
                b.u[k] = *(const u32x4*)(U + (size_t)e * D_MODEL + 16 * lane); b.v[k] = *(const u32x4*)(Vt + (size_t)e * D_MODEL + 16 * lane); } } while (0)
#define PSH_CP(b, gi_) do { const int gi = (gi_); float d[4]; int jj[4]; float gg[4]; \
                _Pragma("unroll") for (int k = 0; k < 4; ++k) { int i = 4 * gi + k; const bool val = i < n; i = val ? i : n - 1; jj[k] = __builtin_amdgcn_readfirstlane(lst[4 * i + 2]); gg[k] = val ? __builtin_bit_cast(float, __builtin_amdgcn_readfirstlane(lst[4 * i + 1])) : 0.f; \
                    const u32x4 xa = *(const LAS u32x4*)(xs + jj[k] * 1024 + 16 * lane), xc = *(const LAS u32x4*)(xs + jj[k] * 1024 + 16 * lane + 8); \
                    const f32x2 x2[8] = {(f32x2){bflo(xa.x), bfhi(xa.x)}, (f32x2){bflo(xa.y), bfhi(xa.y)}, (f32x2){bflo(xa.z), bfhi(xa.z)}, (f32x2){bflo(xa.w), bfhi(xa.w)}, (f32x2){bflo(xc.x), bfhi(xc.x)}, (f32x2){bflo(xc.y), bfhi(xc.y)}, (f32x2){bflo(xc.z), bfhi(xc.z)}, (f32x2){bflo(xc.w), bfhi(xc.w)}}; \
                    d[k] = dot16_fp8(b.u[k], x2); } \
                float e2[2], e1; \
                { const bool hi = lane & 1; _Pragma("unroll") for (int i = 0; i < 2; ++i) { const float keep = hi ? d[2 + i] : d[i], send = hi ? d[i] : d[2 + i]; e2[i] = keep + __shfl_xor(send, 1); } } \
                { const bool hi = lane & 2; const float keep = hi ? e2[1] : e2[0], send = hi ? e2[0] : e2[1]; e1 = keep + __shfl_xor(send, 2); } \
                e1 += __shfl_xor(e1, 4); e1 += __shfl_xor(e1, 8); e1 += __shfl_xor(e1, 16); e1 += __shfl_xor(e1, 32); \
                const int myk = 2 * (lane & 1) + ((lane >> 1) & 1); \
                float myg = gg[0]; myg = (myk == 1) ? gg[1] : myg; myg = (myk == 2) ? gg[2] : myg; myg = (myk == 3) ? gg[3] : myg; \
                const float act = myg * gelu_tanh(e1 * (1.0f / PEER_SU)) * (1.0f / PEER_SV); \
                _Pragma("unroll") for (int k = 0; k < 4; ++k) { const float a = rdlane(act, (k >> 1) | ((k & 1) << 1)); \
                    if (jj[k] == 0) axpy16_fp8(b.v[k], a, oa0); else if (jj[k] == 1) axpy16_fp8(b.v[k], a, oa1); else if (jj[k] == 2) axpy16_fp8(b.v[k], a, oa2); else axpy16_fp8(b.v[k], a, oa3); } } while (0)
            { PG4 A, B; PSH_LD(A, 0);
#pragma unroll 1
              for (int g2 = 0; g2 < ngrp; g2 += 2) { PSH_LD(B, (g2 + 1 < ngrp) ? g2 + 1 : g2); PSH_CP(A, g2); PSH_LD(A, (g2 + 2 < ngrp) ? g2 + 2 : g2); if (g2 + 1 < ngrp) PSH_CP(B, g2 + 1); } }
            asm volatile("s_waitcnt lgkmcnt(0)" ::: "memory");
        }
#define PSH_LN(j) { const int r = row##j; f32x2 x2[8]; \
            _Pragma("unroll") for (int q = 0; q < 4; ++q) { const f32x4 a = *(const f32x4*)(xin + (size_t)r * D_MODEL + 16 * lane + 4 * q); x2[2 * q] = (f32x2){a.x, a.y}; x2[2 * q + 1] = (f32x2){a.z, a.w}; } \
            float sm = 0.f; _Pragma("unroll") for (int k = 0; k < 8; ++k) { oa##j[k] += x2[k] * ALPHA; sm += oa##j[k].x + oa##j[k].y; } \
            const float mu = wave_sum(sm) * (1.0f / D_MODEL); float s2 = 0.f; _Pragma("unroll") for (int k = 0; k < 8; ++k) { oa##j[k] -= mu; s2 += oa##j[k].x * oa##j[k].x + oa##j[k].y * oa##j[k].y; } \
            const float rs = 1.0f / sqrtf(wave_sum(s2) * (1.0f / D_MODEL) + LN_EPS); float* frow = fout + (size_t)r * D_MODEL; \
            _Pragma("unroll") for (int q = 0; q < 4; ++q) { const int c0 = 16 * lane + 4 * q; const f32x4 gv = *(const f32x4*)(gam + c0), bv = *(const f32x4*)(bet + c0); \
                const f32x4 y = (f32x4){oa##j[2 * q].x * rs, oa##j[2 * q].y * rs, oa##j[2 * q + 1].x * rs, oa##j[2 * q + 1].y * rs} * gv + bv; *(f32x4*)(frow + c0) = y; if (xb) *(u32x2*)(xb + (size_t)r * D_MODEL + c0) = pk4(y); } }
        PSH_LN(0) PSH_LN(1) PSH_LN(2) PSH_LN(3)
        asm volatile("s_waitcnt lgkmcnt(0)" ::: "memory");
    }
}
constexpr int PSH_LOG = 11, PSH_N = PEER_EXPERTS >> PSH_LOG;
#ifndef PS2_ROWS
#define PS2_ROWS 4
#endif
#define PS2_ROW(j) const int row##j = (qd * PS2_ROWS + j) * NW + gw; const int el##j = P.SELE[(size_t)row##j * 128 + lane], eh##j = P.SELE[(size_t)row##j * 128 + 64 + lane]; const float gl##j = P.SELG[(size_t)row##j * 128 + lane], gh##j = P.SELG[(size_t)row##j * 128 + 64 + lane]; \
    f32x2 oa##j[8]; _Pragma("unroll") for (int k = 0; k < 8; ++k) oa##j[k] = (f32x2){0.f, 0.f};
#define PS2_STEP(j) { unsigned long long b0 = __ballot((el##j >> PSH_LOG) == s), b1 = __ballot((eh##j >> PSH_LOG) == s); \
    if (b0 | b1) { const u32x4 xa##j = *(const u32x4*)(xb16 + (size_t)row##j * D_MODEL + 16 * lane), xc##j = *(const u32x4*)(xb16 + (size_t)row##j * D_MODEL + 16 * lane + 8);     \
      const f32x2 x2[8] = {(f32x2){bflo(xa##j.x), bfhi(xa##j.x)}, (f32x2){bflo(xa##j.y), bfhi(xa##j.y)}, (f32x2){bflo(xa##j.z), bfhi(xa##j.z)}, (f32x2){bflo(xa##j.w), bfhi(xa##j.w)}, (f32x2){bflo(xc##j.x), bfhi(xc##j.x)}, (f32x2){bflo(xc##j.y), bfhi(xc##j.y)}, (f32x2){bflo(xc##j.z), bfhi(xc##j.z)}, (f32x2){bflo(xc##j.w), bfhi(xc##j.w)}}; \
      _Pragma("unroll 1") while ((b0 | b1) != 0ull) { int hk[8]; u32x4 uw[8], vw[8]; int nv = 0; \
        _Pragma("unroll") for (int k = 0; k < 8; ++k) { int h; if (b0) { h = __builtin_ctzll(b0); b0 &= b0 - 1; ++nv; } else if (b1) { h = 64 + __builtin_ctzll(b1); b1 &= b1 - 1; ++nv; } else h = hk[k > 0 ? k - 1 : 0]; \
            hk[k] = h; const int e = (h < 64) ? __builtin_amdgcn_readlane(el##j, h & 63) : __builtin_amdgcn_readlane(eh##j, h & 63); \
            uw[k] = *(const u32x4*)(U + (size_t)e * D_MODEL + 16 * lane); vw[k] = *(const u32x4*)(Vt + (size_t)e * D_MODEL + 16 * lane); } \
        float d[8]; _Pragma("unroll") for (int k = 0; k < 8; ++k) d[k] = dot16_fp8(uw[k], x2); \
        float e4[4], e2[2], e1s; \
        { const bool hi = lane & 1; _Pragma("unroll") for (int i = 0; i < 4; ++i) { const float keep = hi ? d[4 + i] : d[i], send = hi ? d[i] : d[4 + i]; e4[i] = keep + __shfl_xor(send, 1); } } \
        { const bool hi = lane & 2; _Pragma("unroll") for (int i = 0; i < 2; ++i) { const float keep = hi ? e4[2 + i] : e4[i], send = hi ? e4[i] : e4[2 + i]; e2[i] = keep + __shfl_xor(send, 2); } } \
        { const bool hi = lane & 4; const float keep = hi ? e2[1] : e2[0], send = hi ? e2[0] : e2[1]; e1s = keep + __shfl_xor(send, 4); } \
        e1s += __shfl_xor(e1s, 8); e1s += __shfl_xor(e1s, 16); e1s += __shfl_xor(e1s, 32); \
        const int myk = 4 * (lane & 1) + (lane & 2) + ((lane >> 2) & 1); int myh = hk[0]; _Pragma("unroll") for (int k = 1; k < 8; ++k) myh = (myk == k) ? hk[k] : myh; \
        const float ga = __shfl(gl##j, myh & 63), gb = __shfl(gh##j, myh & 63); const float myg = (myk < nv) ? ((myh < 64) ? ga : gb) : 0.f;     \
        const float act = myg * gelu_tanh(e1s * (1.0f / PEER_SU)) * (1.0f / PEER_SV); \
        _Pragma("unroll") for (int k = 0; k < 8; ++k) { const int src = (k >> 2) | (((k >> 1) & 1) << 1) | ((k & 1) << 2); axpy16_fp8(vw[k], rdlane(act, src), oa##j); } } } }
#define PS2_LN(j) { const int r = row##j; f32x2 x2[8]; int ll = lane; asm volatile("" : "+v"(ll));     \
    _Pragma("unroll") for (int q = 0; q < 4; ++q) { const f32x4 a = *(const f32x4*)(xin + (size_t)r * D_MODEL + 16 * ll + 4 * q); x2[2 * q] = (f32x2){a.x, a.y}; x2[2 * q + 1] = (f32x2){a.z, a.w}; } \
    float sm = 0.f; _Pragma("unroll") for (int k = 0; k < 8; ++k) { oa##j[k] += x2[k] * ALPHA; sm += oa##j[k].x + oa##j[k].y; } \
    const float mu = wave_sum(sm) * (1.0f / D_MODEL); float s2 = 0.f; _Pragma("unroll") for (int k = 0; k < 8; ++k) { oa##j[k] -= mu; s2 += oa##j[k].x * oa##j[k].x + oa##j[k].y * oa##j[k].y; } \
    const float rs = 1.0f / sqrtf(wave_sum(s2) * (1.0f / D_MODEL) + LN_EPS); float* frow = fout + (size_t)r * D_MODEL; \
    _Pragma("unroll") for (int q = 0; q < 4; ++q) { const int c0 = 16 * ll + 4 * q; const f32x4 gv = *(const f32x4*)(gam + c0), bv = *(const f32x4*)(bet + c0); \
        const f32x4 y = (f32x4){oa##j[2 * q].x * rs, oa##j[2 * q].y * rs, oa##j[2 * q + 1].x * rs, oa##j[2 * q + 1].y * rs} * gv + bv; *(f32x4*)(frow + c0) = y; if (xb) *(u32x2*)(xb + (size_t)r * D_MODEL + c0) = pk4(y); } }
DI void peer_sharded2_phase(const FP& P, const Ctx& C, int layer, const float* xin, const bf16* xb16, float* fout, bf16* xb) {
    const int lane = C.lane; const unsigned char* U = P.UB8 + (size_t)layer * PEER_EXPERTS * D_MODEL; const unsigned char* Vt = P.VB8 + (size_t)layer * PEER_EXPERTS * D_MODEL;
    const float* gam = P.ln_g + ((size_t)layer * 2 + 1) * D_MODEL; const float* bet = P.ln_b + ((size_t)layer * 2 + 1) * D_MODEL;
    const int NW = C.G * NWAVES, gw = C.vcu * NWAVES + C.wave; const int nquads = (M0 / NW) / PS2_ROWS;
#pragma unroll 1
    for (int qd = 0; qd < nquads; ++qd) {
#if PS2_ROWS == 4
        PS2_ROW(0) PS2_ROW(1) PS2_ROW(2) PS2_ROW(3)
#pragma unroll 1
        for (int s = 0; s < PSH_N; ++s) { PS2_STEP(0) PS2_STEP(1) PS2_STEP(2) PS2_STEP(3) }
        PS2_LN(0) PS2_LN(1) PS2_LN(2) PS2_LN(3)
#else
        PS2_ROW(0) PS2_ROW(1)
#pragma unroll 1
        for (int s = 0; s < PSH_N; ++s) { PS2_STEP(0) PS2_STEP(1) }
        PS2_LN(0) PS2_LN(1)
#endif
    }
}
#define PS3_ROW(j) const int row##j = (qd * 4 + j) * NW + gw; const int el##j = P.SELE[(size_t)row##j * 128 + lane], eh##j = P.SELE[(size_t)row##j * 128 + 64 + lane]; \
    { const u32x4 xa = *(const u32x4*)(xb16 + (size_t)row##j * D_MODEL + 16 * lane), xc = *(const u32x4*)(xb16 + (size_t)row##j * D_MODEL + 16 * lane + 8); *(LAS u32x4*)(xs + j * 1024 + 16 * lane) = xa; *(LAS u32x4*)(xs + j * 1024 + 16 * lane + 8) = xc; } \
    f32x2 oa##j[8]; _Pragma("unroll") for (int k = 0; k < 8; ++k) oa##j[k] = (f32x2){0.f, 0.f};
#define PS3_X2_UNUSED(j) const f32x2 x2[8] = {(f32x2){bflo(xa##j.x), bfhi(xa##j.x)}, (f32x2){bflo(xa##j.y), bfhi(xa##j.y)}, (f32x2){bflo(xa##j.z), bfhi(xa##j.z)}, (f32x2){bflo(xa##j.w), bfhi(xa##j.w)}, (f32x2){bflo(xc##j.x), bfhi(xc##j.x)}, (f32x2){bflo(xc##j.y), bfhi(xc##j.y)}, (f32x2){bflo(xc##j.z), bfhi(xc##j.z)}, (f32x2){bflo(xc##j.w), bfhi(xc##j.w)}};
#define PS3_TAKE(q, M, ELH, GOFF) if (!got && M) { const int h = __builtin_ctzll(M); M &= M - 1; qq[k] = q; ee = __builtin_amdgcn_readlane(ELH, h); gk[k] = P.SELG[GOFF + h];     got = true; ++nv; }
DI void peer_sharded3_phase(const FP& P, const Ctx& C, int layer, const float* xin, const bf16* xb16, float* fout, bf16* xb) {
    const int lane = C.lane; const unsigned char* U = P.UB8 + (size_t)layer * PEER_EXPERTS * D_MODEL; const unsigned char* Vt = P.VB8 + (size_t)layer * PEER_EXPERTS * D_MODEL;
    const float* gam = P.ln_g + ((size_t)layer * 2 + 1) * D_MODEL; const float* bet = P.ln_b + ((size_t)layer * 2 + 1) * D_MODEL;
    const int NW = C.G * NWAVES, gw = C.vcu * NWAVES + C.wave; const int nquads = (M0 / NW) / 4; LAS bf16* xs = (LAS bf16*)(C.lds + C.wave * 16384);
#pragma unroll 1
    for (int qd = 0; qd < nquads; ++qd) {
        PS3_ROW(0) PS3_ROW(1) PS3_ROW(2) PS3_ROW(3)
        asm volatile("s_waitcnt lgkmcnt(0)" ::: "memory");
#pragma unroll 1
        for (int s = 0; s < PSH_N; ++s) {
            unsigned long long m0 = __ballot((el0 >> PSH_LOG) == s), m1 = __ballot((eh0 >> PSH_LOG) == s), m2 = __ballot((el1 >> PSH_LOG) == s), m3 = __ballot((eh1 >> PSH_LOG) == s),
                               m4 = __ballot((el2 >> PSH_LOG) == s), m5 = __ballot((eh2 >> PSH_LOG) == s), m6 = __ballot((el3 >> PSH_LOG) == s), m7 = __ballot((eh3 >> PSH_LOG) == s);
#pragma unroll 1
            while ((m0 | m1 | m2 | m3 | m4 | m5 | m6 | m7) != 0ull) {
                int qq[8]; float gk[8]; int es[8]; u32x4 uw[8]; int nv = 0; int elast = 0;
#pragma unroll
                for (int k = 0; k < 8; ++k) { bool got = false; int ee = elast; qq[k] = k > 0 ? qq[k - 1] : 0; gk[k] = 0.f;
                    PS3_TAKE(0, m0, el0, (size_t)row0 * 128) PS3_TAKE(1, m1, eh0, (size_t)row0 * 128 + 64) PS3_TAKE(2, m2, el1, (size_t)row1 * 128) PS3_TAKE(3, m3, eh1, (size_t)row1 * 128 + 64) PS3_TAKE(4, m4, el2, (size_t)row2 * 128) PS3_TAKE(5, m5, eh2, (size_t)row2 * 128 + 64) PS3_TAKE(6, m6, el3, (size_t)row3 * 128) PS3_TAKE(7, m7, eh3, (size_t)row3 * 128 + 64)
                    elast = ee; es[k] = ee; uw[k] = *(const u32x4*)(U + (size_t)ee * D_MODEL + 16 * lane); }
                float d[8];
#pragma unroll
                for (int k = 0; k < 8; ++k) { const int j = qq[k] >> 1; const u32x4 xa = *(const LAS u32x4*)(xs + j * 1024 + 16 * lane), xc = *(const LAS u32x4*)(xs + j * 1024 + 16 * lane + 8);
                    const f32x2 x2[8] = {(f32x2){bflo(xa.x), bfhi(xa.x)}, (f32x2){bflo(xa.y), bfhi(xa.y)}, (f32x2){bflo(xa.z), bfhi(xa.z)}, (f32x2){bflo(xa.w), bfhi(xa.w)}, (f32x2){bflo(xc.x), bfhi(xc.x)}, (f32x2){bflo(xc.y), bfhi(xc.y)}, (f32x2){bflo(xc.z), bfhi(xc.z)}, (f32x2){bflo(xc.w), bfhi(xc.w)}};
                    d[k] = dot16_fp8(uw[k], x2); }
                u32x4 vw[8];
#pragma unroll
                for (int k = 0; k < 8; ++k) vw[k] = *(const u32x4*)(Vt + (size_t)es[k] * D_MODEL + 16 * lane);
                float e4[4], e2[2], e1s;
                { const bool hi = lane & 1;
#pragma unroll
                  for (int i = 0; i < 4; ++i) { const float keep = hi ? d[4 + i] : d[i], send = hi ? d[i] : d[4 + i]; e4[i] = keep + __shfl_xor(send, 1); } }
                { const bool hi = lane & 2;
#pragma unroll
                  for (int i = 0; i < 2; ++i) { const float keep = hi ? e4[2 + i] : e4[i], send = hi ? e4[i] : e4[2 + i]; e2[i] = keep + __shfl_xor(send, 2); } }
                { const bool hi = lane & 4; const float keep = hi ? e2[1] : e2[0], send = hi ? e2[0] : e2[1]; e1s = keep + __shfl_xor(send, 4); }
                e1s += __shfl_xor(e1s, 8); e1s += __shfl_xor(e1s, 16); e1s += __shfl_xor(e1s, 32);
                const int myk = 4 * (lane & 1) + (lane & 2) + ((lane >> 2) & 1); float myg = gk[0];
#pragma unroll
                for (int k = 1; k < 8; ++k) myg = (myk == k) ? gk[k] : myg;
                const float act = myg * gelu_tanh(e1s * (1.0f / PEER_SU)) * (1.0f / PEER_SV);
#pragma unroll
                for (int k = 0; k < 8; ++k) { const int src = (k >> 2) | (((k >> 1) & 1) << 1) | ((k & 1) << 2); const float a = rdlane(act, src); const int j = qq[k] >> 1;
                    if (j == 0) { asm volatile("" ::: "memory"); axpy16_fp8(vw[k], a, oa0); } else if (j == 1) { asm volatile("" ::: "memory"); axpy16_fp8(vw[k], a, oa1); } else if (j == 2) { asm volatile("" ::: "memory"); axpy16_fp8(vw[k], a, oa2); } else { asm volatile("" ::: "memory"); axpy16_fp8(vw[k], a, oa3); } }
            }
        }
        PS2_LN(0) PS2_LN(1) PS2_LN(2) PS2_LN(3)
    }
}
}
namespace fx {
struct EpiB {
    static constexpr bool PERM = true, AFTER_DRAIN = false; const FP& P;
    DI void operator()(const f32x4 (&acc)[2][2][4][2], const pg8::Unit& u, int wr, int wc, int fr, int fq) const {
        const int t = u.pn;
        EPI_LOOP({ if (row < MP) { const int pos = row_pos(row), n = row / SEQ, e = ct & 63, dp = e >> 1; const bool prm = row < M0;
            if (t < 3) { const int ty = 2 * t + (ct >> 7), kvh = (ct >> 6) & 1;
                if (ty == 2 || ty == 4) { f32x4 lo, hi; rope4(P.ROPE + pos * 64, dp, v0, v1, lo, hi);
                    if (ty == 2) { float* o = (prm ? P.nsa_kv_p + (size_t)row * 512 : P.nsa_kv_s + (size_t)(row - M0) * 512) + 256 + kvh * 64 + dp; *(f32x4*)o = lo; *(f32x4*)(o + 32) = hi;
                        if (prm) { bf16* kt = P.SLK + ((size_t)n * NSA_KV_HEADS + kvh) * SEQ * 64; *(u32x2*)(kt + ktile_off(pos, dp)) = pk4(lo); *(u32x2*)(kt + ktile_off(pos, dp + 32)) = pk4(hi); } }
                    else { float* o = nullptr; if (!prm) o = P.win_s + (((size_t)(row - M0) * SWA_WINDOW + SWA_WINDOW - 1) * 2 + 0) * 128; else if (pos >= SEQ - SWA_WINDOW) o = P.win_p + (((size_t)n * SWA_WINDOW + pos - (SEQ - SWA_WINDOW)) * 2 + 0) * 128;
                        if (o) { *(f32x4*)(o + kvh * 64 + dp) = lo; *(f32x4*)(o + kvh * 64 + 32 + dp) = hi; }
                        if (prm) { bf16* kt = P.WNK + ((size_t)n * NSA_KV_HEADS + kvh) * SEQ * 64; *(u32x2*)(kt + ktile_off(pos, dp)) = pk4(lo); *(u32x2*)(kt + ktile_off(pos, dp + 32)) = pk4(hi); } } }
                else if (ty < 4) { float* o = (prm ? P.nsa_kv_p + (size_t)row * 512 : P.nsa_kv_s + (size_t)(row - M0) * 512) + ty * 128 + kvh * 64 + e; *(f32x4*)o = v0; *(f32x4*)(o + 4) = v1;
                    if (prm) { if (ty < 2) *(u32x4*)(P.AC + ((size_t)ty * ACROWS + ((size_t)n * NSA_KV_HEADS + kvh) * NCH + pos / 16) * 1024 + (pos % 16) * 64 + e) = pk8(v0, v1);
                        else { bf16* vt = P.SLVT + ((size_t)n * NSA_KV_HEADS + kvh) * SEQ * 64 + vtile_off(e, pos);
                            vt[0] = (bf16)f2bf(v0.x); vt[8] = (bf16)f2bf(v0.y); vt[16] = (bf16)f2bf(v0.z); vt[24] = (bf16)f2bf(v0.w); vt[32] = (bf16)f2bf(v1.x); vt[40] = (bf16)f2bf(v1.y); vt[48] = (bf16)f2bf(v1.z); vt[56] = (bf16)f2bf(v1.w); } } }
                else { float* o = nullptr; if (!prm) o = P.win_s + (((size_t)(row - M0) * SWA_WINDOW + SWA_WINDOW - 1) * 2 + 1) * 128; else if (pos >= SEQ - SWA_WINDOW) o = P.win_p + (((size_t)n * SWA_WINDOW + pos - (SEQ - SWA_WINDOW)) * 2 + 1) * 128;
                    if (o) { *(f32x4*)(o + kvh * 64 + e) = v0; *(f32x4*)(o + kvh * 64 + e + 4) = v1; }
                    if (prm) { bf16* vt = P.WNVT + ((size_t)n * NSA_KV_HEADS + kvh) * SEQ * 64 + vtile_off(e, pos);
                        vt[0] = (bf16)f2bf(v0.x); vt[8] = (bf16)f2bf(v0.y); vt[16] = (bf16)f2bf(v0.z); vt[24] = (bf16)f2bf(v0.w); vt[32] = (bf16)f2bf(v1.x); vt[40] = (bf16)f2bf(v1.y); vt[48] = (bf16)f2bf(v1.z); vt[56] = (bf16)f2bf(v1.w); } } }
            else if (t < 6) { const int h = (t - 3) * 4 + (ct >> 6); f32x4 lo, hi; rope4(P.ROPE + pos * 64, dp, v0, v1, lo, hi); bf16* q = P.QB + (size_t)row * NSA_Q_COLS + h * 64 + dp; *(u32x2*)q = pk4(lo * QSCALE); *(u32x2*)(q + 32) = pk4(hi * QSCALE); }
            else if (t == 6) { *(u32x4*)(P.MQB + (size_t)row * 256 + ct) = pk8(v0 * QSCALE, v1 * QSCALE); }
            else if (ct < 40) { const float vv[8] = {v0.x, v0.y, v0.z, v0.w, v1.x, v1.y, v1.z, v1.w};
                _Pragma("unroll") for (int i = 0; i < 8; ++i) if (ct + i < NSA_GATE_COLS) P.GATES[(size_t)row * 64 + ct + i] = 1.0f / (1.0f + __expf(-vv[i])); } } })
    }
};
DI void cmp2_phase(const FP& P, const Ctx& C) {
    const int lane = C.lane; LAS float* hs = (LAS float*)(C.lds + C.wave * 1024);
    constexpr int NGRP = NCTX * 2 * NSA_KV_HEADS; const int NW = C.G * NWAVES, WPG = NW / NGRP > 0 ? NW / NGRP : 1; const int gw = C.vcu * NWAVES + C.wave;
#pragma unroll 1
    for (int grp = gw / WPG; grp < NGRP; grp += (NW + WPG - 1) / WPG) { const int slot = gw % WPG; if (gw >= (NW / WPG) * WPG && grp == gw / WPG) break;
        const int kvh = grp % NSA_KV_HEADS, ty = (grp / NSA_KV_HEADS) % 2, ctx = grp / (2 * NSA_KV_HEADS);
        const float* UL = P.UL + ((size_t)ty * ACROWS + ((size_t)ctx * NSA_KV_HEADS + kvh) * NCH) * 256; const float* w2 = P.cmp_w2 + (size_t)ty * CMP_HIDDEN * HEAD_DIM;
        float w2r[CMP_HIDDEN];
#pragma unroll
        for (int k = 0; k < CMP_HIDDEN; ++k) w2r[k] = w2[k * HEAD_DIM + lane];
        const float b0 = P.CBIAS[ty * CMP_HIDDEN + lane], b1 = P.CBIAS[ty * CMP_HIDDEN + 64 + lane];
        float u0, u1, l0, l1; int c = slot;
        if (c < NCMP) { u0 = UL[(size_t)c * 256 + lane]; u1 = UL[(size_t)c * 256 + 64 + lane]; l0 = UL[(size_t)(c + 1) * 256 + 128 + lane]; l1 = UL[(size_t)(c + 1) * 256 + 192 + lane]; }
#pragma unroll 1
        for (; c < NCMP; c += WPG) { const float h0 = gelu_tanh(u0 + l0 + b0), h1 = gelu_tanh(u1 + l1 + b1); const int cn = c + WPG;
            if (cn < NCMP) { u0 = UL[(size_t)cn * 256 + lane]; u1 = UL[(size_t)cn * 256 + 64 + lane]; l0 = UL[(size_t)(cn + 1) * 256 + 128 + lane]; l1 = UL[(size_t)(cn + 1) * 256 + 192 + lane]; }
            hs[lane] = h0; hs[64 + lane] = h1; asm volatile("s_waitcnt lgkmcnt(0)" ::: "memory");
            float a = 0.f;
#pragma unroll
            for (int k4 = 0; k4 < CMP_HIDDEN / 4; ++k4) { const f32x4 hv = *(const LAS f32x4*)(hs + 4 * k4); a += hv.x * w2r[4 * k4] + hv.y * w2r[4 * k4 + 1] + hv.z * w2r[4 * k4 + 2] + hv.w * w2r[4 * k4 + 3]; }
            if (ty == 0) { const float other = __shfl_xor(a, 32); const int pos = c * CMP_STRIDE + CMP_BLOCK - 1; const float cs = P.ROPE[pos * 64 + (lane & 31)], sn = P.ROPE[pos * 64 + 32 + (lane & 31)];
                a = (lane < 32) ? a * cs - other * sn : a * cs + other * sn; }
            if (ctx < BATCH) { if (ty == 0) P.CK[((size_t)ctx * NSA_KV_HEADS + kvh) * NCH * 64 + ktile_off(c, lane)] = (bf16)f2bf(a); else P.CVT[((size_t)ctx * NSA_KV_HEADS + kvh) * NCH * 64 + vtile_off(lane, c)] = (bf16)f2bf(a); }
            else { (ty == 0 ? P.CKF : P.CVF)[(((size_t)(ctx - BATCH) * NSA_KV_HEADS + kvh) * NCH + c) * 64 + lane] = a; }
            asm volatile("s_waitcnt lgkmcnt(0)" ::: "memory"); }
    }
    __syncthreads();
}
constexpr int NSA_WLDS = 8192;
DI void nsa_pair_a(const FP& P, int n, int kvh, int t, int lane, LAS unsigned char* wl) {
    LAS float* pn = (LAS float*)wl; LAS float* imp = (LAS float*)(wl + 2048); LAS float* sc = (LAS float*)(wl + 6144); LAS int* sel = (LAS int*)(wl + 7168);
    const int col = lane & 15, c = lane >> 4; const bool vcol = col < 12; const int qq = vcol ? col / 6 : 0, hh = vcol ? col % 6 : 0, tq = t + qq, head = kvh * NSA_GROUP + hh, row = n * SEQ + tq;
    bf16x8 qf[2]; { const bf16* qp = P.QB + (size_t)row * NSA_Q_COLS + head * 64 + 8 * c; qf[0] = *(const bf16x8*)qp; qf[1] = *(const bf16x8*)(qp + 32); }
    const float* gt = P.GATES + (size_t)row * 64 + head * 3;
    f32x4 oacc[4] = {(f32x4){0.f, 0.f, 0.f, 0.f}, (f32x4){0.f, 0.f, 0.f, 0.f}, (f32x4){0.f, 0.f, 0.f, 0.f}, (f32x4){0.f, 0.f, 0.f, 0.f}};
    const int lim = vcol ? ((tq >= CMP_BLOCK - 1) ? (tq - (CMP_BLOCK - 1)) / CMP_STRIDE : -1) : -1;
    const int limmax = (t + 1 >= CMP_BLOCK - 1) ? (t + 1 - (CMP_BLOCK - 1)) / CMP_STRIDE : -1; const int nblk = (limmax + 32) / 32;
    const bf16* CKb = P.CK + ((size_t)n * NSA_KV_HEADS + kvh) * NCH * 64; const bf16* CVb = P.CVT + ((size_t)n * NSA_KV_HEADS + kvh) * 64 * NCH;
    for (int i = lane; i < 1024; i += 64) imp[i] = 0.f;
    float m1 = -INFINITY, l1 = 0.f;
    { struct K4 { bf16x8 a0, a1, b0, b1; };
      auto ldk = [&](K4& k, int blk) { const bf16* kt = CKb + (size_t)blk * 2048 + lane * 8; k.a0 = *(const bf16x8*)kt; k.a1 = *(const bf16x8*)(kt + 512); k.b0 = *(const bf16x8*)(kt + 1024); k.b1 = *(const bf16x8*)(kt + 1536); };
      auto cp1 = [&](const K4& k, int blk) { const int kb = 32 * blk;
        f32x4 s0 = (f32x4){0.f, 0.f, 0.f, 0.f}, s1 = (f32x4){0.f, 0.f, 0.f, 0.f};
        s0 = __builtin_amdgcn_mfma_f32_16x16x32_bf16(k.a0, qf[0], s0, 0, 0, 0); s0 = __builtin_amdgcn_mfma_f32_16x16x32_bf16(k.a1, qf[1], s0, 0, 0, 0);
        s1 = __builtin_amdgcn_mfma_f32_16x16x32_bf16(k.b0, qf[0], s1, 0, 0, 0); s1 = __builtin_amdgcn_mfma_f32_16x16x32_bf16(k.b1, qf[1], s1, 0, 0, 0);
        float s[8] = {s0.x, s0.y, s0.z, s0.w, s1.x, s1.y, s1.z, s1.w}; float mx = -INFINITY;
#pragma unroll
        for (int e = 0; e < 8; ++e) { s[e] = (kb + 8 * c + e <= lim) ? s[e] : -INFINITY; mx = fmaxf(mx, s[e]); }
        mx = fmaxf(mx, __shfl_xor(mx, 16)); mx = fmaxf(mx, __shfl_xor(mx, 32));
        const float mnew = fmaxf(m1, mx), muse = (mnew == -INFINITY) ? 0.f : mnew; float ls = 0.f;
#pragma unroll
        for (int e = 0; e < 8; ++e) ls += __builtin_amdgcn_exp2f(s[e] - muse);
        ls += __shfl_xor(ls, 16); ls += __shfl_xor(ls, 32);
        l1 = l1 * __builtin_amdgcn_exp2f(m1 - muse) + ls; m1 = mnew; };
      if (nblk > 0) { K4 A, B; ldk(A, 0);
#pragma unroll 1
        for (int blk = 0; blk < nblk; blk += 2) { ldk(B, (blk + 1 < nblk) ? blk + 1 : blk); cp1(A, blk); ldk(A, (blk + 2 < nblk) ? blk + 2 : blk); if (blk + 1 < nblk) cp1(B, blk + 1); } } }
    asm volatile("s_waitcnt lgkmcnt(0)" ::: "memory");
    { const float muse = (m1 == -INFINITY) ? 0.f : m1, inv = (l1 > 0.f) ? 1.0f / l1 : 0.f;
      f32x4 oc[4] = {(f32x4){0.f, 0.f, 0.f, 0.f}, (f32x4){0.f, 0.f, 0.f, 0.f}, (f32x4){0.f, 0.f, 0.f, 0.f}, (f32x4){0.f, 0.f, 0.f, 0.f}};
      pipe2(nblk, [&](KV8& kv, int blk) { kv_load_t(kv, CKb + (size_t)blk * 2048, CVb + (size_t)blk * 2048, lane); }, [&](const KV8& kv, int blk) { const int kb = 32 * blk;
        f32x4 s0 = (f32x4){0.f, 0.f, 0.f, 0.f}, s1 = (f32x4){0.f, 0.f, 0.f, 0.f};
        s0 = __builtin_amdgcn_mfma_f32_16x16x32_bf16(kv.ka0, qf[0], s0, 0, 0, 0); s0 = __builtin_amdgcn_mfma_f32_16x16x32_bf16(kv.ka1, qf[1], s0, 0, 0, 0);
        s1 = __builtin_amdgcn_mfma_f32_16x16x32_bf16(kv.kb0, qf[0], s1, 0, 0, 0); s1 = __builtin_amdgcn_mfma_f32_16x16x32_bf16(kv.kb1, qf[1], s1, 0, 0, 0);
        float s[8] = {s0.x, s0.y, s0.z, s0.w, s1.x, s1.y, s1.z, s1.w};
#pragma unroll
        for (int e = 0; e < 8; ++e) s[e] = (kb + 8 * c + e <= lim) ? __builtin_amdgcn_exp2f(s[e] - muse) * inv : 0.f;
        *(f32x4*)(pn + col * 32 + 8 * c) = (f32x4){s[0], s[1], s[2], s[3]}; *(f32x4*)(pn + col * 32 + 8 * c + 4) = (f32x4){s[4], s[5], s[6], s[7]};
        u32x4 pw; pw.x = cvtpk(s[0], s[1]); pw.y = cvtpk(s[2], s[3]); pw.z = cvtpk(s[4], s[5]); pw.w = cvtpk(s[6], s[7]); const bf16x8 pf = __builtin_bit_cast(bf16x8, pw);
        oc[0] = __builtin_amdgcn_mfma_f32_16x16x32_bf16(kv.v0, pf, oc[0], 0, 0, 0); oc[1] = __builtin_amdgcn_mfma_f32_16x16x32_bf16(kv.v1, pf, oc[1], 0, 0, 0);
        oc[2] = __builtin_amdgcn_mfma_f32_16x16x32_bf16(kv.v2, pf, oc[2], 0, 0, 0); oc[3] = __builtin_amdgcn_mfma_f32_16x16x32_bf16(kv.v3, pf, oc[3], 0, 0, 0);
        asm volatile("s_waitcnt lgkmcnt(0)" ::: "memory");
        { const int q2 = lane >> 5, k = lane & 31; float a = 0.f;
#pragma unroll
          for (int h6 = 0; h6 < 6; ++h6) a += pn[(q2 * 6 + h6) * 32 + k];
          imp[q2 * 512 + kb + k] = a; }
        asm volatile("s_waitcnt lgkmcnt(0)" ::: "memory"); });
#ifdef NSA_DEBUG
      if (vcol) { for (int db = 0; db < 4; ++db) *(f32x4*)(P.DBG + ((size_t)0 * MP + row) * 768 + head * 64 + 16 * db + 4 * c) = oc[db]; }
#endif
      const float g0 = vcol ? gt[0] : 0.f;
#pragma unroll
      for (int db = 0; db < 4; ++db) oacc[db] += oc[db] * g0; }
#ifndef REP_SEL
#define REP_SEL 1
#endif
#pragma unroll 1
    for (int rep = 0; rep < REP_SEL; ++rep) {
    for (int i = lane; i < 256; i += 64) { const int q2 = i >> 7, b = i & 127, tq2 = t + q2, cur = tq2 / SLC_BLOCK; float sv;
        if (b > cur) sv = NEG; else if (b == 0 || b == cur || b == cur - 1) sv = FORCE_SCORE;
        else { const LAS float* ic = imp + q2 * 512 + 4 * b; sv = ic[-1] + 2.f * (ic[0] + ic[1] + ic[2]) + ic[3]; }
        sc[i] = sv; }
    asm volatile("s_waitcnt lgkmcnt(0)" ::: "memory");
    for (int i = lane; i < 256; i += 64) { const int q2 = i >> 7, b = i & 127; const float sv = sc[i]; int rank = 0;
        for (int j = 0; j < 128; j += 4) { const f32x4 o = *(const LAS f32x4*)(sc + q2 * 128 + j);
            rank += (o.x > sv || (o.x == sv && j < b)) ? 1 : 0; rank += (o.y > sv || (o.y == sv && j + 1 < b)) ? 1 : 0; rank += (o.z > sv || (o.z == sv && j + 2 < b)) ? 1 : 0; rank += (o.w > sv || (o.w == sv && j + 3 < b)) ? 1 : 0; }
        if (rank < SLC_TOPK) { const int v = (sv > 0.5f * NEG) ? b : -1; sel[q2 * 16 + rank] = v; P.SELB[((size_t)(n * SEQ + t + q2) * NSA_KV_HEADS + kvh) * 16 + rank] = v; } }
    asm volatile("s_waitcnt lgkmcnt(0)" ::: "memory");
    }
#ifndef REP_WIN
#define REP_WIN 1
#endif
#pragma unroll 1
    for (int rep = 0; rep < REP_WIN; ++rep) { Tile16 T; tile_init(T);
      const bf16* WKb = P.WNK + ((size_t)n * NSA_KV_HEADS + kvh) * SEQ * 64; const bf16* WVb = P.WNVT + ((size_t)n * NSA_KV_HEADS + kvh) * 64 * SEQ;
      const int blo = (t - SWA_WINDOW) >> 5, bhi = (t + 1) >> 5;
      auto ld = [&](KV8& kv, int blk) { const int bc = blk < 0 ? 0 : blk; kv_load_t(kv, WKb + (size_t)bc * 2048, WVb + (size_t)bc * 2048, lane); };
      pipe2(bhi - blo + 1, [&](KV8& kv, int i) { ld(kv, blo + i); }, [&](const KV8& kv, int i) { const int kb = 32 * (blo + i);
          tile_compute(T, qf, kv, [&](int e) { const int kp = kb + 8 * c + e; return vcol && kp >= 0 && kp <= tq && tq - kp <= SWA_WINDOW; }); });
      const float inv = (T.l > 0.f) ? 1.0f / T.l : 0.f, g2 = vcol ? gt[2] * inv : 0.f;
#ifdef NSA_DEBUG
      if (vcol) { for (int db = 0; db < 4; ++db) *(f32x4*)(P.DBG + ((size_t)2 * MP + row) * 768 + head * 64 + 16 * db + 4 * c) = T.o[db] * inv; }
#endif
#pragma unroll
      for (int db = 0; db < 4; ++db) if (rep == REP_WIN - 1) oacc[db] += T.o[db] * g2; }
    if (vcol) { float* op = P.DPART + (size_t)row * 768 + head * 64 + 4 * c;
#pragma unroll
        for (int db = 0; db < 4; ++db) *(f32x4*)(op + 16 * db) = oacc[db]; }
}
DI void nsa_pair_b(const FP& P, int n, int kvh, int t, int lane, LAS unsigned char* wl) {
    LAS int* steps = (LAS int*)wl;
    const int col = lane & 15, c = lane >> 4; const bool vcol = col < 12; const int qq = vcol ? col / 6 : 0, hh = vcol ? col % 6 : 0, tq = t + qq, head = kvh * NSA_GROUP + hh, row = n * SEQ + tq;
    bf16x8 qf[2]; { const bf16* qp = P.QB + (size_t)row * NSA_Q_COLS + head * 64 + 8 * c; qf[0] = *(const bf16x8*)qp; qf[1] = *(const bf16x8*)(qp + 32); }
    const float* gt = P.GATES + (size_t)row * 64 + head * 3;
    Tile16 T; tile_init(T);
    const bf16* SKb = P.SLK + ((size_t)n * NSA_KV_HEADS + kvh) * SEQ * 64; const bf16* SVb = P.SLVT + ((size_t)n * NSA_KV_HEADS + kvh) * SEQ * 64;
    int ns = 0;
    { const int mysel = (lane < 32) ? P.SELB[((size_t)(n * SEQ + t + (lane >> 4)) * NSA_KV_HEADS + kvh) * 16 + (lane & 15)] : -1;
      for (int i = 0; i < 32; ++i) { const int b = __builtin_amdgcn_readlane(mysel, i); if (b < 0) continue; int q2 = i >> 4;
          const unsigned long long other = __ballot(mysel == b && lane < 32 && (lane >> 4) != q2);
          if (other) { if (q2 == 1) continue; q2 = 2; }
          if (lane == 0) { steps[ns] = (b * SLC_BLOCK) | (q2 << 29); steps[ns + 1] = (b * SLC_BLOCK + 32) | (q2 << 29); } ns += 2; } }
    asm volatile("s_waitcnt lgkmcnt(0)" ::: "memory");
    auto ld = [&](KV8& kv, int i) { const int code = __builtin_amdgcn_readfirstlane(steps[i]); const int kb = code & 0x1fffffff;
        kv_load_t(kv, SKb + (size_t)(kb >> 5) * 2048, SVb + (size_t)(kb >> 5) * 2048, lane); };
#ifdef PROBE_DBLCOMP
    Tile16 T2; tile_init(T2);
#endif
    pipe2(ns, ld, [&](const KV8& kv, int i) { const int code = __builtin_amdgcn_readfirstlane(steps[i]); const int kb = code & 0x1fffffff, q2 = code >> 29;
        tile_compute(T, qf, kv, [&](int e) { return vcol && (q2 == 2 || qq == q2) && (kb + 8 * c + e) <= tq; });
#ifdef PROBE_DBLCOMP
        tile_compute(T2, qf, kv, [&](int e) { return vcol && qq == q2 && (kb + 8 * c + e + 1) <= tq; });
#endif
    });
#ifdef PROBE_DBLCOMP
    if (T2.l < 0.f) T.l = 0.f;
#endif
    const float inv = (T.l > 0.f) ? 1.0f / T.l : 0.f, g1 = vcol ? gt[1] * inv : 0.f;
#ifdef NSA_DEBUG
    if (vcol) { for (int db = 0; db < 4; ++db) *(f32x4*)(P.DBG + ((size_t)1 * MP + row) * 768 + head * 64 + 16 * db + 4 * c) = T.o[db] * inv; }
#endif
    if (vcol) { const float* pp = P.DPART + (size_t)row * 768 + head * 64 + 4 * c; bf16* op = P.ATTB + (size_t)row * 1024 + head * 64 + 4 * c;
#pragma unroll
        for (int db = 0; db < 4; ++db) *(u32x2*)(op + 16 * db) = pk4(*(const f32x4*)(pp + 16 * db) + T.o[db] * g1); }
}

constexpr int SMP_SK = 1088;
template <class KF, class VF> DI void smp_branch(const Ctx& C, LAS float* qs, LAS float* S, LAS float* red, int NK, KF kf, VF vf, bool keep_probs, float (&outh)[1]) {
    const int tid = C.tid, lane = C.lane, w = C.wave;
#pragma unroll 1
    for (int j = tid; j < NK; j += NTHREADS) { const float* k = kf(j); f32x4 kr[16];
#pragma unroll
        for (int d4 = 0; d4 < 16; ++d4) kr[d4] = *(const f32x4*)(k + 4 * d4);
#pragma unroll 1
        for (int h = 0; h < 6; ++h) { float a = 0.f;
#pragma unroll
            for (int d4 = 0; d4 < 16; ++d4) { const f32x4 qv = *(const LAS f32x4*)(qs + h * 64 + 4 * d4); a += kr[d4].x * qv.x + kr[d4].y * qv.y + kr[d4].z * qv.z + kr[d4].w * qv.w; }
            S[h * SMP_SK + j] = a; } }
    asm volatile("s_waitcnt lgkmcnt(0)" ::: "memory"); __syncthreads();
    if (w < 6) { float m = -INFINITY; for (int j = lane; j < NK; j += 64) m = fmaxf(m, S[w * SMP_SK + j]); m = wave_max(m);
        float l = 0.f; for (int j = lane; j < NK; j += 64) { const float p = __builtin_amdgcn_exp2f(S[w * SMP_SK + j] - m); S[w * SMP_SK + j] = p; l += p; } l = wave_sum(l);
        const float inv = 1.0f / l; for (int j = lane; j < NK; j += 64) S[w * SMP_SK + j] *= inv; }
    asm volatile("s_waitcnt lgkmcnt(0)" ::: "memory"); __syncthreads();
    { const int per = (NK + NWAVES - 1) / NWAVES, j0 = w * per, j1 = (j0 + per < NK) ? j0 + per : NK; float o[6] = {0.f, 0.f, 0.f, 0.f, 0.f, 0.f};
#pragma unroll 1
      for (int j = j0; j < j1; j += 8) { float vv[8];
#pragma unroll
          for (int u = 0; u < 8; ++u) { const int jj = (j + u < j1) ? j + u : j1 - 1; vv[u] = vf(jj)[lane]; }
#pragma unroll
          for (int u = 0; u < 8; ++u) if (j + u < j1) {
#pragma unroll
              for (int h = 0; h < 6; ++h) o[h] += S[h * SMP_SK + j + u] * vv[u]; } }
#pragma unroll
      for (int h = 0; h < 6; ++h) red[(w * 6 + h) * 64 + lane] = o[h]; }
    asm volatile("s_waitcnt lgkmcnt(0)" ::: "memory"); __syncthreads();
    outh[0] = 0.f;
    if (tid < 384) { float a = 0.f;
#pragma unroll
        for (int ww = 0; ww < NWAVES; ++ww) a += red[ww * 384 + tid]; outh[0] = a; }
    if (!keep_probs) { __syncthreads(); }
}
DI void nsa_sample_item(const FP& P, const Ctx& C, int ns, int kvh) {
    LAS float* qs = (LAS float*)C.lds; LAS float* S = qs + 384; LAS float* red = S + 6 * SMP_SK; LAS float* scs = red + 8 * 384; LAS int* sel = (LAS int*)(scs + 136);
    const int tid = C.tid, row = M0 + ns;
    if (tid < 384) qs[tid] = bf2f(P.QB[(size_t)row * NSA_Q_COLS + kvh * 384 + tid]);
    asm volatile("s_waitcnt lgkmcnt(0)" ::: "memory"); __syncthreads();
    const float* ckf = P.CKF + ((size_t)ns * NSA_KV_HEADS + kvh) * NCH * 64; const float* cvf = P.CVF + ((size_t)ns * NSA_KV_HEADS + kvh) * NCH * 64;
    float oc[1], os[1], ow[1];
    smp_branch(C, qs, S, red, NCMP, [&](int j) { return ckf + (size_t)j * 64; }, [&](int j) { return cvf + (size_t)j * 64; }, true, oc);
    constexpr int NBS = (PAST_LEN + 1 + SLC_BLOCK - 1) / SLC_BLOCK, CURS = PAST_LEN / SLC_BLOCK;
    for (int b = tid; b < 136; b += NTHREADS) { float sv = -3.0e38f;
        if (b < NBS) { if (b == 0 || b == CURS || b == CURS - 1) sv = FORCE_SCORE; else { float a = 0.f;
#pragma unroll
                for (int o = -1; o <= 3; ++o) { const int ci = 4 * b + o; if (ci >= 0 && ci < NCMP) { float sm = 0.f; for (int h6 = 0; h6 < 6; ++h6) sm += S[h6 * SMP_SK + ci]; a += ((o >= 0 && o <= 2) ? 2.f : 1.f) * sm; } }
                sv = a; } }
        scs[b] = sv; }
    asm volatile("s_waitcnt lgkmcnt(0)" ::: "memory"); __syncthreads();
    for (int b = tid; b < NBS; b += NTHREADS) { const float sv = scs[b]; int rank = 0; for (int j = 0; j < NBS; ++j) { const float o = scs[j]; rank += (o > sv || (o == sv && j < b)) ? 1 : 0; }
        if (rank < SLC_TOPK) { sel[rank] = b; P.SELB[((size_t)row * NSA_KV_HEADS + kvh) * 16 + rank] = b; } }
    asm volatile("s_waitcnt lgkmcnt(0)" ::: "memory"); __syncthreads();
    { const float* newrow = P.nsa_kv_s + (size_t)ns * 512; const int* pt = P.page_table + ns * (PAST_LEN / PAGE_SIZE);
      if (tid == 0) { int seen = 0; for (int x = 0; x < SLC_TOPK; ++x) { const int bx = sel[x]; if (bx != CURS && seen < 15) sel[16 + seen++] = bx; } }
      asm volatile("s_waitcnt lgkmcnt(0)" ::: "memory"); __syncthreads();
      auto krow = [&](int j, int ty) -> const float* { if (j >= 15 * 64) return newrow + ty * 128 + kvh * 64;
          const int t0 = sel[16 + (j >> 6)] * SLC_BLOCK + (j & 63); const int pg = pt[t0 / PAGE_SIZE]; return P.cache_nsa_kv + ((size_t)pg * PAGE_SIZE + t0 % PAGE_SIZE) * 512 + ty * 128 + kvh * 64; };
      smp_branch(C, qs, S, red, 15 * 64 + 1, [&](int j) { return krow(j, 2); }, [&](int j) { return krow(j, 3); }, false, os); }
    { const float* wc = P.cache_nsa_win + (size_t)ns * SWA_WINDOW * 256; const float* newrow = P.win_s + ((size_t)ns * SWA_WINDOW + SWA_WINDOW - 1) * 256;
      smp_branch(C, qs, S, red, SWA_WINDOW + 1, [&](int j) { return (j < SWA_WINDOW ? wc + (size_t)j * 256 : newrow) + kvh * 64; }, [&](int j) { return (j < SWA_WINDOW ? wc + (size_t)j * 256 : newrow) + 128 + kvh * 64; }, false, ow); }
    if (tid < 384) { const int head = kvh * NSA_GROUP + tid / 64; const float* gt = P.GATES + (size_t)row * 64 + head * 3;
        P.ATTB[(size_t)row * 1024 + kvh * 384 + tid] = (bf16)f2bf(gt[0] * oc[0] + gt[1] * os[0] + gt[2] * ow[0]);
#ifdef NSA_DEBUG
        P.DBG[((size_t)0 * MP + row) * 768 + kvh * 384 + tid] = oc[0]; P.DBG[((size_t)1 * MP + row) * 768 + kvh * 384 + tid] = os[0]; P.DBG[((size_t)2 * MP + row) * 768 + kvh * 384 + tid] = ow[0];
#endif
    }
    __syncthreads();
}
DI void nsa_pairs(const FP& P, const Ctx& C, bool second) {
    LAS unsigned char* wl = C.lds + C.wave * NSA_WLDS;
    const int per = C.G / 4 > 0 ? C.G / 4 : 1, grp = (C.vcu / per) & 3, sub = C.vcu % per, n = grp >> 1, kvh = grp & 1;
#pragma unroll 1
    for (int pr = sub * NWAVES + C.wave; pr < SEQ / 2; pr += per * NWAVES) { if (second) nsa_pair_b(P, n, kvh, 2 * pr, C.lane, wl); else nsa_pair_a(P, n, kvh, 2 * pr, C.lane, wl); }
}
DI void nsa_phase_a(const FP& P, const Ctx& C) {
    for (int it = C.vcu; it < DEC_BATCH * NSA_KV_HEADS; it += C.G) nsa_sample_item(P, C, it / NSA_KV_HEADS, it % NSA_KV_HEADS);
    nsa_pairs(P, C, false);
    __syncthreads();
}
DI void nsa_phase_b(const FP& P, const Ctx& C) {
    const int lane = C.lane, w = C.wave;
    nsa_pairs(P, C, true);
    __syncthreads();
    { constexpr int NMT = (M0 / 16) * MEM_HEADS;
      for (int it = C.vcu * NWAVES + w; it < NMT; it += C.G * NWAVES) { const int h = it % MEM_HEADS, q16 = it / MEM_HEADS, row0 = q16 * 16, n = row0 / SEQ;
          mem_micro(P, P.MQB + h * 64, 256, row0, 1, n, h, P.ATTB + NSA_Q_COLS + h * 64, 1024, lane); }
    }
    { LAS float* qs = (LAS float*)C.lds;
      for (int it = C.vcu; it < DEC_BATCH * MEM_HEADS; it += C.G) { const int h = it % MEM_HEADS, ns = it / MEM_HEADS, row = M0 + ns;
          __syncthreads(); if (C.tid < 64) qs[C.tid] = bf2f(P.MQB[(size_t)row * 256 + h * 64 + C.tid]); asm volatile("s_waitcnt lgkmcnt(0)" ::: "memory"); __syncthreads();
          Dec D; D.m = -INFINITY; D.l = 0.f; D.o = 0.f; const float* mk = P.cache_mem_kv + ((size_t)1 * DEC_BATCH + ns) * MEM_TOKENS * 512;
          for (int ck = w; ck < MEM_TOKENS / 64; ck += NWAVES) { const int j0 = ck * 64; dec_chunk(D, qs, 64, [&](int j) { return mk + (size_t)(j0 + j) * 512 + h * 64; }, [&](int j) { return mk + (size_t)(j0 + j) * 512 + 256 + h * 64; }, lane); }
          const float o = dec_combine(C, D);
          if (w == 0) P.ATTB[(size_t)row * 1024 + NSA_Q_COLS + h * 64 + lane] = (bf16)f2bf(o); } }
    __syncthreads();
}
}
namespace fx {
enum { PH_PRO = 0, PH_G1, PH_ATTA, PH_G2, PH_LN1, PH_SC0, PH_TK0, PH_PU0, PH_PG0, PH_G3, PH_CMPG, PH_CMP2, PH_NSA, PH_NSB, PH_G4, PH_LN3, PH_SC1, PH_TK1, PH_PU1, PH_PG1, PH_COUNT };
template <class Epi> DI void run_gemm(const Ctx& C, const bf16* A, const bf16* Bt, int M, int N, int K, const Epi& E) {
    pg8::Gemm g{A, Bt, M, N, K}; pg8::StaticOrder S; S.init(M, N, C.G, (int)blockIdx.x);
    pg8::gemm_phase<Epi, pg8::StaticOrder, true, true>(C.lds, g, S, E);
}
template <class Epi> DI void skinny_gemm(const Ctx& C, const bf16* A, const bf16* Bt, int N, int K, const Epi& E) {
    static_assert(DEC_BATCH == 32 && M0 % 256 == 0, "skinny_gemm: 32 sample rows right after a whole number of 256-row tiles");
    const int lane = C.lane, fr = lane & 15, fq = lane >> 4, w = C.wave; const int NI = (N / 256) * 4, KW = K / NWAVES;
    LAS f32x4* red = (LAS f32x4*)C.lds;
#pragma unroll 1
    for (int item = C.vcu; item < NI; item += C.G) { const int pn = item >> 2, wc = item & 3;
        f32x4 pa[2][2][2];
#pragma unroll
        for (int i = 0; i < 8; ++i) (&pa[0][0][0])[i] = (f32x4){0.f, 0.f, 0.f, 0.f};
        const bf16* xa = A + (size_t)(M0 + fr) * K + w * KW + 8 * fq; const bf16* xb = xa + (size_t)16 * K;
        const bf16* wp[2][2];
#pragma unroll
        for (int bj = 0; bj < 2; ++bj)
#pragma unroll
            for (int n = 0; n < 2; ++n) wp[bj][n] = Bt + (size_t)(pn * 256 + bj * 128 + wc * 32 + 8 * (fr >> 2) + 4 * n + (fr & 3)) * K + w * KW + 8 * fq;
#pragma unroll 4
        for (int k0 = 0; k0 < KW; k0 += 32) { const bf16x8 x0 = *(const bf16x8*)(xa + k0), x1 = *(const bf16x8*)(xb + k0);
#pragma unroll
            for (int bj = 0; bj < 2; ++bj)
#pragma unroll
                for (int n = 0; n < 2; ++n) { const bf16x8 wf = *(const bf16x8*)(wp[bj][n] + k0);
                    pa[bj][0][n] = __builtin_amdgcn_mfma_f32_16x16x32_bf16(wf, x0, pa[bj][0][n], 0, 0, 0); pa[bj][1][n] = __builtin_amdgcn_mfma_f32_16x16x32_bf16(wf, x1, pa[bj][1][n], 0, 0, 0); } }
        __syncthreads();
#pragma unroll
        for (int bj = 0; bj < 2; ++bj)
#pragma unroll
            for (int mm = 0; mm < 2; ++mm)
#pragma unroll
                for (int n = 0; n < 2; ++n) red[(w * 8 + bj * 4 + mm * 2 + n) * 64 + lane] = pa[bj][mm][n];
        asm volatile("s_waitcnt lgkmcnt(0)" ::: "memory"); __syncthreads();
        if (w == 0) { f32x4 acc[2][2][4][2];
#pragma unroll
            for (int i = 0; i < 32; ++i) (&acc[0][0][0][0])[i] = (f32x4){0.f, 0.f, 0.f, 0.f};
#pragma unroll
            for (int bj = 0; bj < 2; ++bj)
#pragma unroll
                for (int mm = 0; mm < 2; ++mm)
#pragma unroll
                    for (int n = 0; n < 2; ++n) { f32x4 s = red[(bj * 4 + mm * 2 + n) * 64 + lane];
#pragma unroll 1
                        for (int ww = 1; ww < NWAVES; ++ww) s += red[(ww * 8 + bj * 4 + mm * 2 + n) * 64 + lane];
                        acc[0][bj][mm][n] = s; }
            E(acc, pg8::Unit{M0 / 256, pn}, 0, wc, fr, fq); }
    }
    __syncthreads();
}
__global__ void __launch_bounds__(NTHREADS, 2) mega(Args args) {
    extern __shared__ __attribute__((aligned(16))) unsigned char lds_raw[];
    Ctx C; C.lds = (LAS unsigned char*)lds_raw; C.tid = threadIdx.x; C.lane = C.tid & 63; C.wave = __builtin_amdgcn_readfirstlane(C.tid >> 6);
    C.G = gridDim.x; { const int bx = blockIdx.x; C.vcu = (C.G % 8 == 0) ? (bx % 8) * (C.G / 8) + bx / 8 : bx; }
    const FP& P = args.p;
    volatile LAS unsigned* MISC = (volatile LAS unsigned*)(C.lds + MISC_OFF);
    for (int u = C.tid; u < (LDS_BYTES - RING_BYTES) / 4; u += NTHREADS) ((LAS unsigned*)(C.lds + RING_BYTES))[u] = 0u;
    __syncthreads();
    const int lo = args.lo, hi = args.hi;
    XcdBarrier bar; bar.bar = P.ctl + 1024; bar.x = 0; bar.st = nullptr;
    if (hi - lo > 1) bar = xcd_barrier_post(P.ctl + 1024, MISC + 8);
#define IN(k) (lo <= (k) && (k) < hi)
#define SEAM(k) do { if (IN(k) && IN((k) + 1)) xcd_barrier(bar); } while (0)
#ifndef DUP_PHASE
#define DUP_PHASE -1
#endif
#define PHASE(k, ...) do { if (IN(k)) { __VA_ARGS__ if (DUP_PHASE == (k)) { __syncthreads(); __VA_ARGS__ } } SEAM(k); } while (0)
    PHASE(PH_PRO, p0_prologue(P, C); __syncthreads(); p0_wpk(P, C););
    PHASE(PH_G1, run_gemm(C, P.XB0, P.WA_T, M0, ACOLS, D_MODEL, EpiA{P}); run_gemm(C, P.MEMB, P.WMEM_T, BATCH * MEM_TOKENS, 1024, D_MODEL, EpiMem{P}); skinny_gemm(C, P.XB0, P.WA_T, ACOLS, D_MODEL, EpiA{P}););
#ifdef PEER_SHARD3
#define PEER_SHARDED_FN peer_sharded3_phase
#else
#define PEER_SHARDED_FN peer_sharded2_phase
#endif
    PHASE(PH_ATTA, atta_phase(P, C););
    PHASE(PH_G2, run_gemm(C, P.ATTA, P.WOA_T, M0, D_MODEL, 512, EpiPre{P.x_prompt, P.x_sample, P.PRE}); skinny_gemm(C, P.ATTA, P.WOA_T, D_MODEL, 512, EpiPre{P.x_prompt, P.x_sample, P.PRE}););
    PHASE(PH_LN1, ln_phase(P, C, P.PRE, P.ln_g, P.ln_b, P.X1, P.X1B, nullptr, nullptr););
    PHASE(PH_SC0, run_gemm(C, P.X1B, P.WPK_T, M0, NPK, D_MODEL, EpiF32{P.SCO, NPK, MP}); skinny_gemm(C, P.X1B, P.WPK_T, NPK, D_MODEL, EpiF32{P.SCO, NPK, MP}););
    PHASE(PH_TK0, topk_phase(P, C););
#ifdef PEER_SPLIT
    PHASE(PH_PU0, peer_u_phase(P, C, 0, P.X1B););
    PHASE(PH_PG0, peer_v_phase(P, C, 0, P.X1, P.X2, P.X2 + (size_t)M0 * D_MODEL, P.X2B););
#elif defined(PEER_SHARD2)
    PHASE(PH_PG0, const bool shd = (M0 % (C.G * NWAVES * PS2_ROWS)) == 0; if (shd) { PEER_SHARDED_FN(P, C, 0, P.X1, P.X1B, P.X2, P.X2B); __syncthreads(); } peer_phase(P, C, 0, P.X1, P.X2, P.X2 + (size_t)M0 * D_MODEL, P.X2B, shd););
#elif defined(PEER_SHARD)
    PHASE(PH_PG0, peer_sharded_phase(P, C, 0, P.X1, P.X1B, P.X2, P.X2 + (size_t)M0 * D_MODEL, P.X2B); __syncthreads(); peer_phase(P, C, 0, P.X1, P.X2, P.X2 + (size_t)M0 * D_MODEL, P.X2B););
#else
    PHASE(PH_PG0, peer_phase(P, C, 0, P.X1, P.X2, P.X2 + (size_t)M0 * D_MODEL, P.X2B););
#endif
    PHASE(PH_G3, run_gemm(C, P.X2B, P.WB_T, M0, NB_T, D_MODEL, EpiB{P}); skinny_gemm(C, P.X2B, P.WB_T, NB_T, D_MODEL, EpiB{P}););
    PHASE(PH_CMPG, run_gemm(C, P.AC, P.CW1_T, ACROWS, 256, 1024, EpiF32{P.UL, 256, ACROWS}); run_gemm(C, P.AC + (size_t)ACROWS * 1024, P.CW1_T + 256 * 1024, ACROWS, 256, 1024, EpiF32{P.UL + (size_t)ACROWS * 256, 256, ACROWS}););
    PHASE(PH_CMP2, cmp2_phase(P, C););
    PHASE(PH_NSA, nsa_phase_a(P, C););
    PHASE(PH_NSB, nsa_phase_b(P, C););
    PHASE(PH_G4, run_gemm(C, P.ATTB, P.WOB_T, M0, D_MODEL, 1024, EpiPre{P.X2, nullptr, P.PRE}); skinny_gemm(C, P.ATTB, P.WOB_T, D_MODEL, 1024, EpiPre{P.X2, nullptr, P.PRE}););
    PHASE(PH_LN3, ln_phase(P, C, P.PRE, P.ln_g + 2 * D_MODEL, P.ln_b + 2 * D_MODEL, P.X3, P.X3B, nullptr, nullptr););
    PHASE(PH_SC1, run_gemm(C, P.X3B, P.WPK_T + (size_t)NPK * D_MODEL, M0, NPK, D_MODEL, EpiF32{P.SCO, NPK, MP}); skinny_gemm(C, P.X3B, P.WPK_T + (size_t)NPK * D_MODEL, NPK, D_MODEL, EpiF32{P.SCO, NPK, MP}););
    PHASE(PH_TK1, topk_phase(P, C););
#ifdef PEER_SPLIT
    PHASE(PH_PU1, peer_u_phase(P, C, 1, P.X3B););
    PHASE(PH_PG1, peer_v_phase(P, C, 1, P.X3, P.y_prompt, P.y_sample, nullptr););
#elif defined(PEER_SHARD2)
    PHASE(PH_PG1, const bool shd = (M0 % (C.G * NWAVES * PS2_ROWS)) == 0; if (shd) { PEER_SHARDED_FN(P, C, 1, P.X3, P.X3B, P.y_prompt, nullptr); __syncthreads(); } peer_phase(P, C, 1, P.X3, P.y_prompt, P.y_sample, nullptr, shd););
#elif defined(PEER_SHARD)
    PHASE(PH_PG1, peer_sharded_phase(P, C, 1, P.X3, P.X3B, P.y_prompt, P.y_sample, nullptr); __syncthreads(); peer_phase(P, C, 1, P.X3, P.y_prompt, P.y_sample, nullptr););
#else
    PHASE(PH_PG1, peer_phase(P, C, 1, P.X3, P.y_prompt, P.y_sample, nullptr););
#endif
#undef IN
#undef SEAM
}
}
#ifndef ONE_LAUNCH
#define ONE_LAUNCH 1
#endif
extern "C" void kernel_launch(void* const* d_in, const int* in_sizes, int n_in, void* d_out, int out_size, void* d_ws, size_t ws_size, hipStream_t stream) {
    fx::Args a; memset(&a, 0, sizeof(a)); fx::bind_io(a.p, d_in, (float*)d_out);
    const size_t f_need = fx::carve(a.p, d_ws);
    if (f_need > ws_size) { fprintf(stderr, "kernel_launch: workspace too small: need %zu have %zu\n", f_need, ws_size); return; }
    static int grid = 0;
    if (!grid) { int dev = 0, cus = 0, per_cu = 0; (void)hipGetDevice(&dev); (void)hipDeviceGetAttribute(&cus, hipDeviceAttributeMultiprocessorCount, dev);
        (void)hipFuncSetAttribute((const void*)fx::mega, hipFuncAttributeMaxDynamicSharedMemorySize, fx::LDS_BYTES);
        if (hipOccupancyMaxActiveBlocksPerMultiprocessor(&per_cu, (const void*)fx::mega, fx::NTHREADS, fx::LDS_BYTES) != hipSuccess || per_cu < 1) { fprintf(stderr, "kernel_launch: occupancy query says %d blocks per CU\n", per_cu); (void)hipGetLastError(); }
        grid = cus; }
    (void)hipMemsetAsync(a.p.ctl, 0, fx::CTL_BYTES, stream);
#if ONE_LAUNCH
    a.lo = 0; a.hi = fx::PH_COUNT; hipLaunchKernelGGL(fx::mega, dim3(grid), dim3(fx::NTHREADS), fx::LDS_BYTES, stream, a);
#else
    for (int k = 0; k < fx::PH_COUNT; ++k) { a.lo = k; a.hi = k + 1; hipLaunchKernelGGL(fx::mega, dim3(grid), dim3(fx::NTHREADS), fx::LDS_BYTES, stream, a); }
#endif
}
```

```cpp
#define PEER_SHARD2 1
#define ONE_LAUNCH 1
#include <hip/hip_runtime.h>
#include <cstdio>
#include <cstring>
#include <cmath>
#ifdef CPU_TEST
#define HD inline
constexpr int D_MODEL = 128, BATCH = 2, SEQ = 512, DEPTH = 2, DEC_BATCH = 3, DEC_SEQ = 1, PAST_LEN = 512, PAGE_SIZE = 128;
constexpr int DIL_W[3] = {16, 64, 256}, DIL_D[3] = {1, 4, 16}, DIL_TAPS = 17;
constexpr int MEM_TOKENS = 32, SLC_TOPK = 4, SWA_WINDOW = 64, PEER_KEYS = 16, PEER_TOPK = 4;
#else
#define HD __host__ __device__ __forceinline__
constexpr int D_MODEL = 1024, BATCH = 2, SEQ = 8192, DEPTH = 2, DEC_BATCH = 32, DEC_SEQ = 1, PAST_LEN = 8192, PAGE_SIZE = 128;
constexpr int DIL_W[3] = {128, 512, 2048}, DIL_D[3] = {1, 4, 16}, DIL_TAPS = 129;
constexpr int MEM_TOKENS = 256, SLC_TOPK = 16, SWA_WINDOW = 512, PEER_KEYS = 128, PEER_TOPK = 16;
#endif
HD constexpr int dil_w(int g) { return g == 0 ? DIL_W[0] : (g == 1 ? DIL_W[1] : DIL_W[2]); }
HD constexpr int dil_d(int g) { return g == 0 ? DIL_D[0] : (g == 1 ? DIL_D[1] : DIL_D[2]); }
constexpr int HEAD_DIM = 64, N_A_LAYERS = DEPTH / 2, N_DIL = 3, DIL_HEADS = 4, DIL_COLS = N_DIL * 3 * DIL_HEADS * HEAD_DIM;
constexpr int MEM_HEADS = 4, MEM_COLS = MEM_HEADS * HEAD_DIM;
constexpr int NSA_HEADS = 12, NSA_KV_HEADS = 2, NSA_GROUP = 6, NSA_Q_COLS = NSA_HEADS * HEAD_DIM, NSA_GATE_COLS = NSA_HEADS * 3;
constexpr int CMP_BLOCK = 32, CMP_STRIDE = 16, CMP_HIDDEN = 128, SLC_BLOCK = 64;
constexpr int PEER_EXPERTS = PEER_KEYS * PEER_KEYS, PEER_HEADS = 8, PEER_KEY_DIM = 128;
constexpr float FORCE_SCORE = 1.0e9f, NEG = -1.0e30f, SCALE = 0.125f, LN_EPS = 1e-5f;
constexpr float ALPHA = 1.41421356237309515f;
constexpr float BETA = 0.5f;
#define LAS __attribute__((address_space(3)))
namespace pg8 {
#define PG8_LAS __attribute__((address_space(3)))
typedef unsigned short bf16_t;
typedef short bf16x8 __attribute__((ext_vector_type(8)));
typedef float f32x4 __attribute__((ext_vector_type(4)));
typedef unsigned u32x4 __attribute__((ext_vector_type(4)));
constexpr int BM = 256, BK = 64, HALF = 128, HTB = HALF * BK * 2  , STAGE_BYTES = 8 * HTB, NXCD = 8, WGM = 8;

__host__ __device__ __forceinline__ int lds_byte(int r, int c) { const int st = (r >> 4) * 2 + (c >> 5), rr = r & 15, cc = c & 31, ob = rr * 64 + cc * 2; return st * 1024 + (ob ^ (((ob >> 9) & 1) << 5)); }
__host__ __device__ __forceinline__ void stage_rc(int b, int& R, int& C) { const int st = b / 1024, sb = b % 1024, swz = sb ^ (((sb >> 9) & 1) << 5); R = (st >> 1) * 16 + swz / 64; C = (st & 1) * 32 + (swz % 64) / 2; }
__host__ __device__ __forceinline__ int perm32(int rho) { const int n = rho >> 4, i = rho & 15; return 8 * (i >> 2) + 4 * n + (i & 3); }

struct Unit { int pm, pn; };
struct Gemm { const bf16_t* A; const bf16_t* Bt; int M, N, K; };

struct StaticOrder {
    int nM, nN, nwg, G, c;
    __host__ __device__ void init(int M, int N, int G_, int c_) { nM = M / BM; nN = N / BM; nwg = nM * nN; G = G_; c = c_; }
    __host__ __device__ bool next(int i, Unit& u) const {
        const long L = (long)i * G + c; if (L >= nwg) return false;
        int wgid = (int)L; { const int q = nwg / NXCD, r = nwg % NXCD, xcd = wgid % NXCD, off = wgid / NXCD; wgid = (xcd < r ? xcd * (q + 1) : r * (q + 1) + (xcd - r) * q) + off; }
        const int nig = WGM * nN, gid = wgid / nig, fm = gid * WGM, gsz = (nM - fm) < WGM ? (nM - fm) : WGM;
        u.pm = fm + ((wgid % nig) % gsz); u.pn = (wgid % nig) / gsz; return true;
    }
    __device__ __forceinline__ void a_ready(const Unit&) const {}
    __device__ __forceinline__ void done(const Unit&) const {}
};

__device__ __forceinline__ unsigned cvt_pk_bf16(float lo, float hi) { unsigned r; asm volatile("v_cvt_pk_bf16_f32 %0, %1, %2" : "=v"(r) : "v"(lo), "v"(hi)); return r; }
typedef float f32x2 __attribute__((ext_vector_type(2)));
typedef float f32x2 __attribute__((ext_vector_type(2)));
template <class Epi, class Sched, bool ALIGN_EPI = false, bool SP2 = false>
__device__ __forceinline__ void gemm_phase(PG8_LAS unsigned char* lds, const Gemm g, const Sched& S, const Epi& E) {
    const int tid = threadIdx.x, wid = __builtin_amdgcn_readfirstlane(tid >> 6), lane = tid & 63, wr = wid >> 2, wc = wid & 3, fr = lane & 15, fq = lane >> 4;
    const int K = g.K, nt = K / BK;
    unsigned voffA[2], voffB[2];
#pragma unroll
    for (int i = 0; i < 2; ++i) { int R, C; stage_rc(tid * 16 + i * 8192, R, C); const int Rb = Epi::PERM ? ((R & ~31) + perm32(R & 31)) : R;
        voffA[i] = (unsigned)(R * K + C) * 2u; voffB[i] = (unsigned)(Rb * K + C) * 2u; }
    const size_t kstep = (size_t)(BK * 2);
    const size_t hstep = (size_t)HALF * K * 2;
    const size_t tstep = 2 * hstep;
    const unsigned ldsw = (unsigned)wid * 1024u;
    const int aoff = lds_byte(wr * 64 + fr, fq * 8), boff = lds_byte(wc * 32 + fr, fq * 8);
#define PG8_SA(b, h) (((b) * 2 + (h)) * HTB)
#define PG8_SB(b, h) ((4 + (b) * 2 + (h)) * HTB)
#define PG8_STAGE(bufoff, gbase, voff) do { _Pragma("unroll") for (int _i = 0; _i < 2; ++_i) \
        __builtin_amdgcn_global_load_lds((const unsigned*)((const char*)(gbase) + (voff)[_i]), (PG8_LAS unsigned*)(lds + (bufoff) + ldsw + _i * 8192), 16, 0, 0); } while (0)
#define PG8_LDA(dst, b, h) do { _Pragma("unroll") for (int m = 0; m < 4; ++m) _Pragma("unroll") for (int k = 0; k < 2; ++k) dst[m][k] = *(const PG8_LAS bf16x8*)(lds + PG8_SA(b, h) + aoff + m * 2048 + k * 1024); } while (0)
#define PG8_LDB(dst, b, h) do { _Pragma("unroll") for (int n = 0; n < 2; ++n) _Pragma("unroll") for (int k = 0; k < 2; ++k) dst[n][k] = *(const PG8_LAS bf16x8*)(lds + PG8_SB(b, h) + boff + n * 2048 + k * 1024); } while (0)
#define PG8_MMA(ai, bj, At, Bt) do { __builtin_amdgcn_s_setprio(1); _Pragma("unroll") for (int m = 0; m < 4; ++m) _Pragma("unroll") for (int n = 0; n < 2; ++n) _Pragma("unroll") for (int k = 0; k < 2; ++k) \
        acc[ai][bj][m][n] = __builtin_amdgcn_mfma_f32_16x16x32_bf16(Bt[n][k], At[m][k], acc[ai][bj][m][n], 0, 0, 0); __builtin_amdgcn_s_setprio(0); } while (0)
#define PG8_WAIT_V(n) asm volatile("s_waitcnt vmcnt(" #n ")" ::: "memory")
#define PG8_WAIT_L(n) asm volatile("s_waitcnt lgkmcnt(" #n ")" ::: "memory")
#define PG8_BAR __builtin_amdgcn_s_barrier()
#define PG8_SCHED __builtin_amdgcn_sched_barrier(0)
    Unit cur, nxt; int ui = 0;
    if (!S.next(0, cur)) return;
    f32x4 acc[2][2][4][2];
#pragma unroll
    for (int a = 0; a < 2; ++a)
#pragma unroll
        for (int b = 0; b < 2; ++b)
#pragma unroll
            for (int m = 0; m < 4; ++m)
#pragma unroll
                for (int n = 0; n < 2; ++n) acc[a][b][m][n] = (f32x4){0.f, 0.f, 0.f, 0.f};
    bf16x8 At[4][2], B0[2][2], B1[2][2];
    const char* cA = (const char*)g.A + (size_t)cur.pm * tstep; const char* cB = (const char*)g.Bt + (size_t)cur.pn * tstep;
    S.a_ready(cur);
    if constexpr (SP2) {
        PG8_STAGE(PG8_SB(0, 0), cB, voffB); PG8_STAGE(PG8_SB(0, 1), cB + hstep, voffB); PG8_STAGE(PG8_SA(0, 0), cA, voffA); PG8_STAGE(PG8_SA(0, 1), cA + hstep, voffA);
        if (wr == 1) PG8_BAR;
        PG8_WAIT_V(2); PG8_BAR;
        PG8_STAGE(PG8_SB(1, 0), cB + kstep, voffB); PG8_STAGE(PG8_SA(1, 0), cA + kstep, voffA); PG8_STAGE(PG8_SB(1, 1), cB + hstep + kstep, voffB);
        PG8_WAIT_V(6); PG8_BAR;
    } else {
        PG8_STAGE(PG8_SB(0, 0), cB, voffB); PG8_STAGE(PG8_SA(0, 0), cA, voffA); PG8_STAGE(PG8_SB(0, 1), cB + hstep, voffB); PG8_STAGE(PG8_SA(0, 1), cA + hstep, voffA);
        if (wr == 1) PG8_BAR;
        PG8_WAIT_V(4); PG8_BAR;
        PG8_STAGE(PG8_SB(1, 0), cB + kstep, voffB); PG8_STAGE(PG8_SA(1, 0), cA + kstep, voffA); PG8_STAGE(PG8_SB(1, 1), cB + hstep + kstep, voffB);
        PG8_WAIT_V(6); PG8_BAR;
    }
    for (;;) {
        const bool has_next = S.next(ui + 1, nxt);
        const char* nA = has_next ? (const char*)g.A + (size_t)nxt.pm * tstep : cA; const char* nB = has_next ? (const char*)g.Bt + (size_t)nxt.pn * tstep : cB;
        for (int t = 0; t < nt; t += 2) {
            const bool last = (t == nt - 2);
            const char* a1 = cA + (size_t)(t + 1) * kstep;
            const char* a2 = last ? nA : cA + (size_t)(t + 2) * kstep; const char* b2 = last ? nB : cB + (size_t)(t + 2) * kstep;
            const char* a3 = a2 + kstep; const char* b3 = b2 + kstep;
            if (last && has_next) S.a_ready(nxt);
            if constexpr (SP2) {
            PG8_LDB(B0, 0, 0); PG8_LDB(B1, 0, 1); PG8_SCHED; PG8_LDA(At, 0, 0); PG8_STAGE(PG8_SA(1, 1), a1 + hstep, voffA);
            PG8_WAIT_V(8); PG8_WAIT_L(0); PG8_BAR; PG8_MMA(0, 0, At, B0); PG8_MMA(0, 1, At, B1); PG8_BAR; PG8_SCHED;
            PG8_LDA(At, 0, 1); PG8_STAGE(PG8_SB(0, 0), b2, voffB); PG8_STAGE(PG8_SB(0, 1), b2 + hstep, voffB); PG8_STAGE(PG8_SA(0, 0), a2, voffA);
            PG8_WAIT_V(8); PG8_WAIT_L(0); PG8_BAR; PG8_MMA(1, 0, At, B0); PG8_MMA(1, 1, At, B1); PG8_BAR; PG8_SCHED;
            PG8_LDB(B0, 1, 0); PG8_LDB(B1, 1, 1); PG8_SCHED; PG8_LDA(At, 1, 0); PG8_STAGE(PG8_SA(0, 1), a2 + hstep, voffA);
            PG8_WAIT_V(8); PG8_WAIT_L(0); PG8_BAR; PG8_MMA(0, 0, At, B0); PG8_MMA(0, 1, At, B1); PG8_BAR; PG8_SCHED;
            PG8_LDA(At, 1, 1); PG8_STAGE(PG8_SB(1, 0), b3, voffB); PG8_STAGE(PG8_SB(1, 1), b3 + hstep, voffB); PG8_STAGE(PG8_SA(1, 0), a3, voffA);
            PG8_WAIT_V(8); PG8_WAIT_L(0); PG8_BAR; PG8_MMA(1, 0, At, B0); PG8_MMA(1, 1, At, B1); PG8_BAR; PG8_SCHED;
            } else {
            PG8_LDB(B0, 0, 0); PG8_SCHED; PG8_LDA(At, 0, 0); PG8_STAGE(PG8_SA(1, 1), a1 + hstep, voffA);
            PG8_WAIT_L(8); PG8_BAR; PG8_WAIT_L(0); PG8_MMA(0, 0, At, B0); PG8_BAR; PG8_SCHED;
            PG8_LDB(B1, 0, 1); PG8_STAGE(PG8_SB(0, 0), b2, voffB);
            PG8_BAR; PG8_WAIT_L(0); PG8_MMA(0, 1, At, B1); PG8_BAR;
            PG8_LDA(At, 0, 1); PG8_STAGE(PG8_SA(0, 0), a2, voffA);
            PG8_BAR; PG8_WAIT_L(0); PG8_MMA(1, 0, At, B0); PG8_BAR; PG8_SCHED;
            PG8_STAGE(PG8_SB(0, 1), b2 + hstep, voffB);
            PG8_WAIT_V(6); PG8_BAR; PG8_MMA(1, 1, At, B1); PG8_BAR;
            PG8_LDB(B0, 1, 0); PG8_SCHED; PG8_LDA(At, 1, 0); PG8_STAGE(PG8_SA(0, 1), a2 + hstep, voffA);
            PG8_WAIT_L(8); PG8_BAR; PG8_WAIT_L(0); PG8_MMA(0, 0, At, B0); PG8_BAR; PG8_SCHED;
            PG8_LDB(B1, 1, 1); PG8_STAGE(PG8_SB(1, 0), b3, voffB);
            PG8_BAR; PG8_WAIT_L(0); PG8_MMA(0, 1, At, B1); PG8_BAR;
            PG8_LDA(At, 1, 1); PG8_STAGE(PG8_SA(1, 0), a3, voffA);
            PG8_BAR; PG8_WAIT_L(0); PG8_MMA(1, 0, At, B0); PG8_BAR; PG8_SCHED;
            PG8_STAGE(PG8_SB(1, 1), b3 + hstep, voffB);
            PG8_WAIT_V(6); PG8_BAR; PG8_MMA(1, 1, At, B1); PG8_BAR;
            }
        }
        if constexpr (ALIGN_EPI) { if (wr == 0) PG8_BAR; }
        if constexpr (!Epi::AFTER_DRAIN) { E(acc, cur, wr, wc, fr, fq); S.done(cur); }
        if (!has_next) break;
#pragma unroll
        for (int a = 0; a < 2; ++a)
#pragma unroll
            for (int b = 0; b < 2; ++b)
#pragma unroll
                for (int m = 0; m < 4; ++m)
#pragma unroll
                    for (int n = 0; n < 2; ++n) acc[a][b][m][n] = (f32x4){0.f, 0.f, 0.f, 0.f};
        cur = nxt; cA = nA; cB = nB; ++ui;
        if constexpr (ALIGN_EPI) { if (wr == 1) PG8_BAR; }
    }
    PG8_WAIT_V(0);
    if constexpr (!ALIGN_EPI) { if (wr == 0) PG8_BAR; }
    PG8_BAR;
    if constexpr (Epi::AFTER_DRAIN) { E.fused(acc, cur, wr, wc, fr, fq, lds, wid, lane); S.done(cur); }
#undef PG8_SA
#undef PG8_SB
#undef PG8_STAGE
#undef PG8_LDA
#undef PG8_LDB
#undef PG8_MMA
#undef PG8_WAIT_V
#undef PG8_WAIT_L
#undef PG8_BAR
#undef PG8_SCHED
}
}
#define XB_TMO      128
#define XB_XCNT(j)  (256  + 64 * (j))
#define XB_XSUB(j)  (1280 + 64 * (j))
#define XB_XGEN(j)  (2304 + 64 * (j))
#define XB_TOP      3328
#define XB_TOPGEN   3392
#define XCD_BAR_WORDS 3456
#define XB_SPIN_CAP (1u << 18)

__device__ __forceinline__ unsigned xb_ld(unsigned* p)              { return __hip_atomic_load(p, __ATOMIC_RELAXED, __HIP_MEMORY_SCOPE_AGENT); }
__device__ __forceinline__ unsigned xb_add(unsigned* p, unsigned v) { return __hip_atomic_fetch_add(p, v, __ATOMIC_RELAXED, __HIP_MEMORY_SCOPE_AGENT); }
__device__ __forceinline__ unsigned xb_xcc_id() { return (unsigned)__builtin_amdgcn_s_getreg((3 << 11) | 20) & 0xFu; }
#define XB_SPIN(cond, bar) do { unsigned _sp = 0; while (cond) { __builtin_amdgcn_s_sleep(1); \
    if ((++_sp & 255u) == 0u) { if (xb_ld(&(bar)[XB_TMO])) break; if (_sp > XB_SPIN_CAP) { atomicAdd(&(bar)[XB_TMO], 1u); break; } } } } while (0)

struct XcdBarrier {
    unsigned* bar; unsigned x;
    volatile LAS unsigned* st;
};

__device__ __forceinline__ XcdBarrier xcd_barrier_post(unsigned* bar, volatile LAS unsigned* st) {
    XcdBarrier b; b.bar = bar; b.x = xb_xcc_id(); b.st = st;
    if (threadIdx.x == 0) (void)xb_add(&bar[XB_XCNT(b.x)], 1u);
    return b;
}
__device__ __forceinline__ void xcd_barrier_complete(unsigned* bar, unsigned x, unsigned& nloc, unsigned& nx) {
    const unsigned G = gridDim.x * gridDim.y * gridDim.z;
    unsigned sum, cnt, mine, sp = 0u;
    for (;;) {
        sum = 0u; cnt = 0u; mine = 0u;
#pragma unroll
        for (unsigned j = 0; j < 16; ++j) { const unsigned c = xb_ld(&bar[XB_XCNT(j)]); sum += c; cnt += (c > 0u) ? 1u : 0u; mine = (j == x) ? c : mine; }
        if (sum == G) break;
        __builtin_amdgcn_s_sleep(1);
        if ((++sp & 255u) == 0u) { if (xb_ld(&bar[XB_TMO])) break; if (sp > XB_SPIN_CAP) { atomicAdd(&bar[XB_TMO], 1u); break; } }
    }
    nloc = mine > 0u ? mine : 1u; nx = cnt > 0u ? cnt : 1u;
}

__device__ __forceinline__ void xcd_barrier(const XcdBarrier& b) {
    asm volatile("s_waitcnt vmcnt(0)" ::: "memory");
    __syncthreads();
    if (threadIdx.x == 0) {
        unsigned* bar = b.bar;
        __builtin_amdgcn_s_waitcnt(0);
        unsigned nloc = b.st[0], nx = b.st[1];
        if (nloc == 0u) { xcd_barrier_complete(bar, b.x, nloc, nx); b.st[0] = nloc; b.st[1] = nx; }
        const unsigned old = xb_add(&bar[XB_XSUB(b.x)], 1u);
        const unsigned gen = old / nloc;
        if (old + 1u == (gen + 1u) * nloc) {
            __builtin_amdgcn_fence(__ATOMIC_RELEASE, "agent");
            asm volatile("s_waitcnt vmcnt(0)" ::: "memory");
            const unsigned og = xb_add(&bar[XB_TOP], 1u);
            const unsigned tg = og / nx;
            if (og + 1u == (tg + 1u) * nx) xb_add(&bar[XB_TOPGEN], 1u);
            else XB_SPIN(xb_ld(&bar[XB_TOPGEN]) == tg, bar);
            __builtin_amdgcn_fence(__ATOMIC_ACQUIRE, "agent");
            xb_add(&bar[XB_XGEN(b.x)], 1u);
            asm volatile("s_waitcnt vmcnt(0)" ::: "memory");
        } else {
            XB_SPIN(xb_ld(&bar[XB_XGEN(b.x)]) == gen, bar);
            __builtin_amdgcn_fence(__ATOMIC_ACQUIRE, "agent");
            asm volatile("s_waitcnt vmcnt(0)" ::: "memory");
        }
    }
    __syncthreads();
}
namespace fx {
#define DI __device__ __forceinline__
typedef unsigned short bf16;
typedef short bf16x8 __attribute__((ext_vector_type(8)));
typedef float f32x4 __attribute__((ext_vector_type(4)));
typedef float f32x2 __attribute__((ext_vector_type(2)));
typedef unsigned u32x4 __attribute__((ext_vector_type(4)));
typedef unsigned u32x2 __attribute__((ext_vector_type(2)));
constexpr int M0 = BATCH * SEQ, MP = M0 + DEC_BATCH, MPAD = ((MP + 255) / 256) * 256;
constexpr int ACOLS = DIL_COLS + MEM_COLS, BCOLS = NSA_Q_COLS + NSA_GATE_COLS + MEM_COLS, KVCOLS = 6 * NSA_KV_HEADS * HEAD_DIM;
constexpr int NB_T = 2048;
constexpr int NPK = PEER_HEADS * 2 * PEER_KEYS;
constexpr int NCMP = (SEQ - CMP_BLOCK) / CMP_STRIDE + 1;
constexpr int NCH = SEQ / CMP_STRIDE;
constexpr int NCTX = BATCH + DEC_BATCH;
constexpr int ACROWS = NCTX * NSA_KV_HEADS * NCH;
constexpr int NPOS = PAST_LEN + 1;
constexpr float QSCALE = 0.125f * 1.4426950408889634f;
constexpr int NTHREADS = 512, NWAVES = 8, LDS_BYTES = 147456, RING_BYTES = 131072, MISC_OFF = RING_BYTES + 320;

struct FP {
    const float *x_prompt, *x_sample, *mem_prompt, *cache_dil[3], *cache_nsa_kv, *cache_nsa_win, *cache_mem_kv; const int* page_table;
    const float *w_in_a, *w_out_a, *w_in_b, *w_out_b, *w_mem_kv, *w_kv_b, *cmp_pe, *cmp_w1, *cmp_w2, *ln_g, *ln_b, *peer_wq, *peer_keys, *peer_u, *peer_v;
    float *y_prompt, *y_sample, *dil_p[3], *dil_s[3], *nsa_kv_p, *nsa_kv_s, *win_p, *win_s, *mem_kv_p;
    unsigned* ctl;
    bf16 *XB0, *X1B, *X2B, *X3B, *WA_T, *WMEM_T, *MEMB, *WOA_T, *WOB_T, *WPK_T, *WB_T, *CW1_T, *AC; unsigned char *UB8, *VB8;
    float *ROPE, *CBIAS;
    bf16 *QA, *KA, *VTA, *MQA, *MK, *MVT, *ATTA;
    float *DPART, *DML, *PRE, *X1, *X2, *X3, *SCO, *SELG; int* SELE;
    bf16 *SLK, *SLVT, *WNK, *WNVT, *QB, *MQB, *CK, *CVT, *ATTB;
    float *GATES, *UL, *CKF, *CVF;
    int* SELB;
    float* DBG;
};
struct Args { FP p; int lo, hi; };
struct Carve { size_t off = 0; template <class T> T* take(void* base, size_t n) { T* r = (T*)((char*)base + off); off += ((n * sizeof(T) + 255) / 256) * 256; return r; } };
constexpr size_t CTL_BYTES = 65536;
inline size_t carve(FP& p, void* base) {
    Carve c;
    p.ctl = c.take<unsigned>(base, CTL_BYTES / 4);
    p.XB0 = c.take<bf16>(base, (size_t)MPAD * D_MODEL); p.X1B = c.take<bf16>(base, (size_t)MPAD * D_MODEL); p.X2B = c.take<bf16>(base, (size_t)MPAD * D_MODEL); p.X3B = c.take<bf16>(base, (size_t)MPAD * D_MODEL);
    p.WA_T = c.take<bf16>(base, (size_t)ACOLS * D_MODEL); p.WMEM_T = c.take<bf16>(base, (size_t)DEPTH * 2 * MEM_COLS * D_MODEL); p.MEMB = c.take<bf16>(base, (size_t)BATCH * MEM_TOKENS * D_MODEL);
    p.WOA_T = c.take<bf16>(base, (size_t)D_MODEL * 2 * MEM_COLS); p.WOB_T = c.take<bf16>(base, (size_t)D_MODEL * (NSA_Q_COLS + MEM_COLS));
    p.WPK_T = c.take<bf16>(base, (size_t)DEPTH * NPK * D_MODEL); p.WB_T = c.take<bf16>(base, (size_t)NB_T * D_MODEL);
    p.UB8 = c.take<unsigned char>(base, (size_t)DEPTH * PEER_EXPERTS * D_MODEL); p.VB8 = c.take<unsigned char>(base, (size_t)DEPTH * PEER_EXPERTS * D_MODEL);
    p.CW1_T = c.take<bf16>(base, (size_t)2 * 256 * 1024); p.AC = c.take<bf16>(base, (size_t)2 * ACROWS * 1024);
    p.ROPE = c.take<float>(base, (size_t)NPOS * 64); p.CBIAS = c.take<float>(base, 2 * CMP_HIDDEN);
    p.QA = c.take<bf16>(base, (size_t)3 * MPAD * 256); p.KA = c.take<bf16>(base, (size_t)3 * MPAD * 256); p.VTA = c.take<bf16>(base, (size_t)3 * BATCH * DIL_HEADS * HEAD_DIM * SEQ + 4096);
    p.MQA = c.take<bf16>(base, (size_t)MPAD * 256); p.MK = c.take<bf16>(base, (size_t)DEPTH * BATCH * MEM_TOKENS * MEM_COLS); p.MVT = c.take<bf16>(base, (size_t)DEPTH * BATCH * MEM_COLS * MEM_TOKENS);
    p.ATTA = c.take<bf16>(base, (size_t)MPAD * 2 * MEM_COLS);
    p.DPART = c.take<float>(base, (size_t)3 * MP * DIL_HEADS * HEAD_DIM); p.DML = c.take<float>(base, (size_t)3 * MP * DIL_HEADS * 2);
    p.PRE = c.take<float>(base, (size_t)MPAD * D_MODEL); p.X1 = c.take<float>(base, (size_t)MPAD * D_MODEL); p.X2 = c.take<float>(base, (size_t)MPAD * D_MODEL); p.X3 = c.take<float>(base, (size_t)MPAD * D_MODEL);
    p.SCO = c.take<float>(base, (size_t)MPAD * NPK); p.SELG = c.take<float>(base, (size_t)MP * 128); p.SELE = c.take<int>(base, (size_t)MP * 128);
    p.SLK = c.take<bf16>(base, (size_t)BATCH * NSA_KV_HEADS * SEQ * HEAD_DIM); p.SLVT = c.take<bf16>(base, (size_t)BATCH * NSA_KV_HEADS * SEQ * HEAD_DIM);
    p.WNK = c.take<bf16>(base, (size_t)BATCH * NSA_KV_HEADS * SEQ * HEAD_DIM + 4096); p.WNVT = c.take<bf16>(base, (size_t)BATCH * NSA_KV_HEADS * SEQ * HEAD_DIM + 4096);
    p.QB = c.take<bf16>(base, (size_t)MPAD * NSA_Q_COLS); p.MQB = c.take<bf16>(base, (size_t)MPAD * 256);
    p.CK = c.take<bf16>(base, (size_t)NCTX * NSA_KV_HEADS * NCH * HEAD_DIM); p.CVT = c.take<bf16>(base, (size_t)NCTX * NSA_KV_HEADS * HEAD_DIM * NCH); p.ATTB = c.take<bf16>(base, (size_t)MPAD * (NSA_Q_COLS + MEM_COLS));
    p.GATES = c.take<float>(base, (size_t)MPAD * 64); p.UL = c.take<float>(base, (size_t)2 * ACROWS * 256);
    p.CKF = c.take<float>(base, (size_t)DEC_BATCH * NSA_KV_HEADS * NCH * HEAD_DIM); p.CVF = c.take<float>(base, (size_t)DEC_BATCH * NSA_KV_HEADS * NCH * HEAD_DIM);
    p.SELB = c.take<int>(base, (size_t)MP * NSA_KV_HEADS * 16);
#ifdef NSA_DEBUG
    p.DBG = c.take<float>(base, (size_t)3 * MP * 768);
#else
    p.DBG = nullptr;
#endif
    return c.off;
}
inline void bind_io(FP& p, void* const* d_in, float* out) {
    p.x_prompt = (const float*)d_in[0]; p.x_sample = (const float*)d_in[1]; p.mem_prompt = (const float*)d_in[2]; p.cache_dil[0] = (const float*)d_in[3]; p.cache_dil[1] = (const float*)d_in[4]; p.cache_dil[2] = (const float*)d_in[5];
    p.cache_nsa_kv = (const float*)d_in[6]; p.cache_nsa_win = (const float*)d_in[7]; p.cache_mem_kv = (const float*)d_in[8]; p.page_table = (const int*)d_in[9];
    p.w_in_a = (const float*)d_in[10]; p.w_out_a = (const float*)d_in[11]; p.w_in_b = (const float*)d_in[12]; p.w_out_b = (const float*)d_in[13]; p.w_mem_kv = (const float*)d_in[14]; p.w_kv_b = (const float*)d_in[15];
    p.cmp_pe = (const float*)d_in[16]; p.cmp_w1 = (const float*)d_in[17]; p.cmp_w2 = (const float*)d_in[18]; p.ln_g = (const float*)d_in[19]; p.ln_b = (const float*)d_in[20];
    p.peer_wq = (const float*)d_in[21]; p.peer_keys = (const float*)d_in[22]; p.peer_u = (const float*)d_in[23]; p.peer_v = (const float*)d_in[24];
    size_t o = 0; auto take = [&](size_t n) { float* r = out + o; o += n; return r; };
    p.y_prompt = take((size_t)M0 * D_MODEL); p.y_sample = take((size_t)DEC_BATCH * D_MODEL);
    for (int g = 0; g < 3; ++g) p.dil_p[g] = take((size_t)BATCH * DIL_W[g] * 2 * DIL_HEADS * HEAD_DIM);
    for (int g = 0; g < 3; ++g) p.dil_s[g] = take((size_t)DEC_BATCH * DIL_W[g] * 2 * DIL_HEADS * HEAD_DIM);
    p.nsa_kv_p = take((size_t)M0 * 4 * NSA_KV_HEADS * HEAD_DIM); p.nsa_kv_s = take((size_t)DEC_BATCH * 4 * NSA_KV_HEADS * HEAD_DIM);
    p.win_p = take((size_t)BATCH * SWA_WINDOW * 2 * NSA_KV_HEADS * HEAD_DIM); p.win_s = take((size_t)DEC_BATCH * SWA_WINDOW * 2 * NSA_KV_HEADS * HEAD_DIM);
    p.mem_kv_p = take((size_t)DEPTH * BATCH * MEM_TOKENS * 2 * MEM_COLS);
}
DI unsigned f2bf(float f) { unsigned u = __builtin_bit_cast(unsigned, f); return (u + 0x7fffu + ((u >> 16) & 1u)) >> 16; }
DI unsigned pk2(float lo, float hi) { return f2bf(lo) | (f2bf(hi) << 16); }
DI float bf2f(unsigned short b) { return __builtin_bit_cast(float, (unsigned)b << 16); }
DI float bflo(unsigned w) { return __builtin_bit_cast(float, w << 16); }
DI float bfhi(unsigned w) { return __builtin_bit_cast(float, w & 0xffff0000u); }
DI float wave_sum(float v) {
#pragma unroll
    for (int o = 1; o < 64; o <<= 1) v += __shfl_xor(v, o);
    return v; }
DI float wave_max(float v) {
#pragma unroll
    for (int o = 1; o < 64; o <<= 1) v = fmaxf(v, __shfl_xor(v, o));
    return v; }
DI float gelu_tanh(float x) { const float u = 0.7978845608028654f * (x + 0.044715f * x * x * x); const float e = __builtin_amdgcn_exp2f(u * 2.885390081777927f);   const float t = 1.0f - 2.0f / (e + 1.0f); return 0.5f * x * (1.0f + t); }
DI float* sel3(float* const (&a)[3], int g) { return g == 0 ? a[0] : (g == 1 ? a[1] : a[2]); }
DI const float* sel3c(const float* const (&a)[3], int g) { return g == 0 ? a[0] : (g == 1 ? a[1] : a[2]); }
__host__ DI size_t ktile_off(int t, int d) { const int blk = t >> 5, kk = t & 31, b = (kk >> 2) & 1, i = 4 * (kk >> 3) + (kk & 3), s = d >> 5, c = (d & 31) >> 3; return ((size_t)(blk * 4 + 2 * b + s) * 64 + i + 16 * c) * 8 + (d & 7); }
__host__ DI size_t vtile_off(int dim, int t) { const int blk = t >> 5, kk = t & 31; return ((size_t)(blk * 4 + (dim >> 4)) * 64 + (dim & 15) + 16 * (kk >> 3)) * 8 + (kk & 7); }
struct Ctx { LAS unsigned char* lds; int tid, lane, wave, vcu, G; };
DI int row_pos(int r) { return r < M0 ? (r & (SEQ - 1)) : PAST_LEN; }

struct ColSrc { const float* p; int ld; };
DI int rope_il(int e) { return (e >> 1) + 32 * (e & 1); }
DI ColSrc col_wa(const FP& P, int n) {
    const int t = n >> 8, ct = n & 255, h = ct >> 6, e = ct & 63; if (t >= 9) return ColSrc{P.w_in_a + DIL_COLS + ct, ACOLS};
    const int j = t % 3, d = (j < 2) ? rope_il(e) : e; return ColSrc{P.w_in_a + t * 256 + h * 64 + d, ACOLS}; }
DI ColSrc col_wb(const FP& P, int n) {
    const int t = n >> 8, ct = n & 255, e = ct & 63;
    if (t < 3) { const int ty = 2 * t + (ct >> 7), kvh = (ct >> 6) & 1; const bool rot = (ty == 2 || ty == 4); return ColSrc{P.w_kv_b + (ty * NSA_KV_HEADS + kvh) * 64 + (rot ? rope_il(e) : e), KVCOLS}; }
    if (t < 6) { const int h = (t - 3) * 4 + (ct >> 6); return ColSrc{P.w_in_b + h * 64 + rope_il(e), BCOLS}; }
    if (t == 6) return ColSrc{P.w_in_b + NSA_Q_COLS + NSA_GATE_COLS + ct, BCOLS};
    if (ct < NSA_GATE_COLS) return ColSrc{P.w_in_b + NSA_Q_COLS + ct, BCOLS};
    return ColSrc{nullptr, 0}; }
DI ColSrc col_wmem(const FP& P, int n) { const int l = n >> 9, c = n & 511; return ColSrc{P.w_mem_kv + (size_t)l * D_MODEL * 512 + c, 512}; }
DI ColSrc col_woa(const FP& P, int n) { return ColSrc{P.w_out_a + n, D_MODEL}; }
DI ColSrc col_wob(const FP& P, int n) { return ColSrc{P.w_out_b + n, D_MODEL}; }
DI ColSrc col_cw1(const FP& P, int n) {
    const int ty = n >> 8, half = (n >> 7) & 1, hid = n & 127; return ColSrc{P.cmp_w1 + (size_t)ty * CMP_BLOCK * HEAD_DIM * CMP_HIDDEN + (size_t)half * 16 * HEAD_DIM * CMP_HIDDEN + hid, CMP_HIDDEN}; }
template <class CF> DI void transpose_item(const FP& P, CF cf, int K, bf16* WT, LAS float* scr, int item, int nblk, int lane) {
    const int kb = item / nblk, nb = item % nblk, k0 = 64 * kb, n0 = 32 * nb;
    const ColSrc cs = cf(P, n0 + (lane & 31));
#pragma unroll 8
    for (int i = 0; i < 32; ++i) { const int kk = 2 * i + (lane >> 5); scr[kk * 33 + (lane & 31)] = cs.p ? cs.p[(size_t)(k0 + kk) * cs.ld] : 0.f; }
    asm volatile("s_waitcnt lgkmcnt(0)" ::: "memory");
    const int c = lane & 7;
#pragma unroll
    for (int j = 0; j < 4; ++j) { const int n = (lane >> 3) + 8 * j; const LAS float* s = scr + (8 * c) * 33 + n;
        u32x4 o; o.x = pk2(s[0 * 33], s[1 * 33]); o.y = pk2(s[2 * 33], s[3 * 33]); o.z = pk2(s[4 * 33], s[5 * 33]); o.w = pk2(s[6 * 33], s[7 * 33]);
        *(u32x4*)(WT + (size_t)(n0 + n) * K + k0 + 8 * c) = o; }
    asm volatile("s_waitcnt lgkmcnt(0)" ::: "memory");
}
DI void cvt_row1024(const float* src, bf16* dst, int lane) {
#pragma unroll
    for (int j = 0; j < 4; ++j) { f32x4 v = src ? *(const f32x4*)(src + 256 * j + 4 * lane) : (f32x4){0.f, 0.f, 0.f, 0.f}; u32x2 o; o.x = pk2(v.x, v.y); o.y = pk2(v.z, v.w); *(u32x2*)(dst + 256 * j + 4 * lane) = o; }
}
DI void cvt_row1024_fp8(const float* src, unsigned char* dst, float sc, int lane) { u32x4 o; unsigned w[4];
#pragma unroll
    for (int j = 0; j < 4; ++j) { const f32x4 v = *(const f32x4*)(src + 16 * lane + 4 * j) * sc; int t = __builtin_amdgcn_cvt_pk_fp8_f32(v.x, v.y, 0, false); t = __builtin_amdgcn_cvt_pk_fp8_f32(v.z, v.w, t, true); w[j] = (unsigned)t; }
    o.x = w[0]; o.y = w[1]; o.z = w[2]; o.w = w[3]; *(u32x4*)(dst + 16 * lane) = o; }
DI void p0_prologue(const FP& P, const Ctx& C) {
    LAS float* scr = (LAS float*)(C.lds + C.wave * 16384);
    const int gw = C.vcu * NWAVES + C.wave, NGW = C.G * NWAVES, lane = C.lane;
    { constexpr int IA = (D_MODEL / 64) * (ACOLS / 32), IM = (D_MODEL / 64) * (1024 / 32), IOA = (512 / 64) * (D_MODEL / 32), IOB = (1024 / 64) * (D_MODEL / 32), IB = (D_MODEL / 64) * (NB_T / 32), IC = (1024 / 64) * (512 / 32);
      constexpr int NIT = IA + IM + IOA + IOB + IB + IC;
      for (int it = gw; it < NIT; it += NGW) { int r = it;
          if (r < IA) { transpose_item(P, col_wa, D_MODEL, P.WA_T, scr, r, ACOLS / 32, lane); continue; } r -= IA;
          if (r < IM) { transpose_item(P, col_wmem, D_MODEL, P.WMEM_T, scr, r, 1024 / 32, lane); continue; } r -= IM;
          if (r < IOA) { transpose_item(P, col_woa, 512, P.WOA_T, scr, r, D_MODEL / 32, lane); continue; } r -= IOA;
          if (r < IOB) { transpose_item(P, col_wob, 1024, P.WOB_T, scr, r, D_MODEL / 32, lane); continue; } r -= IOB;
          if (r < IB) { transpose_item(P, col_wb, D_MODEL, P.WB_T, scr, r, NB_T / 32, lane); continue; } r -= IB;
          transpose_item(P, col_cw1, 1024, P.CW1_T, scr, r, 512 / 32, lane); } }
    for (int r = gw; r < MPAD; r += NGW) { cvt_row1024(r < M0 ? P.x_prompt + (size_t)r * D_MODEL : (r < MP ? P.x_sample + (size_t)(r - M0) * D_MODEL : nullptr), P.XB0 + (size_t)r * D_MODEL, lane);
        if (r >= MP) { cvt_row1024(nullptr, P.X1B + (size_t)r * D_MODEL, lane); cvt_row1024(nullptr, P.X2B + (size_t)r * D_MODEL, lane); cvt_row1024(nullptr, P.X3B + (size_t)r * D_MODEL, lane);
            for (int c = lane; c < 512; c += 64) { P.ATTA[(size_t)r * 512 + c] = 0; P.ATTB[(size_t)r * 1024 + c] = 0; P.ATTB[(size_t)r * 1024 + 512 + c] = 0; } } }
    for (int r = gw; r < BATCH * MEM_TOKENS; r += NGW) cvt_row1024(P.mem_prompt + (size_t)r * D_MODEL, P.MEMB + (size_t)r * D_MODEL, lane);
#pragma unroll 1
    for (int r = 2 * gw; r < DEPTH * PEER_EXPERTS; r += 2 * NGW) { f32x4 a[16];
#pragma unroll
        for (int q = 0; q < 4; ++q) { const float* s0 = (q < 2 ? P.peer_u : P.peer_v) + (size_t)(r + (q & 1)) * D_MODEL + 16 * lane;
#pragma unroll
            for (int j = 0; j < 4; ++j) a[4 * q + j] = *(const f32x4*)(s0 + 4 * j); }
#pragma unroll
        for (int q = 0; q < 4; ++q) { const float sc = q < 2 ? 256.f : 64.f; unsigned w[4];
#pragma unroll
            for (int j = 0; j < 4; ++j) { const f32x4 v = a[4 * q + j] * sc; int t = __builtin_amdgcn_cvt_pk_fp8_f32(v.x, v.y, 0, false); t = __builtin_amdgcn_cvt_pk_fp8_f32(v.z, v.w, t, true); w[j] = (unsigned)t; }
            u32x4 o; o.x = w[0]; o.y = w[1]; o.z = w[2]; o.w = w[3]; *(u32x4*)((q < 2 ? P.UB8 : P.VB8) + (size_t)(r + (q & 1)) * D_MODEL + 16 * lane) = o; } }
    for (int i = gw * 64 + lane; i < NPOS * 32; i += NGW * 64) { const int pos = i >> 5, d = i & 31; const double inv = exp2(-(double)d * (13.287712379549449 / 32.0)); const double turns = (double)pos * inv * 0.15915494309189535;
        const float fr = (float)(turns - floor(turns)); P.ROPE[pos * 64 + d] = __builtin_amdgcn_cosf(fr); P.ROPE[pos * 64 + 32 + d] = __builtin_amdgcn_sinf(fr); }
    for (int i = gw; i < 2 * CMP_HIDDEN; i += NGW) { const int ty = i / CMP_HIDDEN, hid = i % CMP_HIDDEN; float a = 0.f;
#pragma unroll 8
        for (int k = lane; k < CMP_BLOCK * HEAD_DIM; k += 64) a += P.cmp_pe[ty * CMP_BLOCK * HEAD_DIM + k] * P.cmp_w1[((size_t)ty * CMP_BLOCK * HEAD_DIM + k) * CMP_HIDDEN + hid];
        a = wave_sum(a); if (lane == 0) P.CBIAS[i] = a; }
    for (int it = gw; it < DEC_BATCH * (PAST_LEN / PAGE_SIZE); it += NGW) { const int n = it / (PAST_LEN / PAGE_SIZE), pi = it % (PAST_LEN / PAGE_SIZE); const int pg = P.page_table[it];
        const float* src = P.cache_nsa_kv + (size_t)pg * PAGE_SIZE * 512 + 4 * lane; const int ty = lane >> 5, kvh = (lane >> 4) & 1, d = (4 * lane) & 63;
        bf16* dst = P.AC + ((size_t)ty * ACROWS + ((size_t)(BATCH + n) * NSA_KV_HEADS + kvh) * NCH + pi * (PAGE_SIZE / 16)) * 1024 + d;
#pragma unroll 1
        for (int r0 = 0; r0 < PAGE_SIZE; r0 += 8) { f32x4 v[8];
#pragma unroll
            for (int u = 0; u < 8; ++u) v[u] = *(const f32x4*)(src + (size_t)(r0 + u) * 512);
#pragma unroll
            for (int u = 0; u < 8; ++u) { const int t = r0 + u; u32x2 o; o.x = pk2(v[u].x, v[u].y); o.y = pk2(v[u].z, v[u].w); *(u32x2*)(dst + (size_t)(t / 16) * 1024 + (t % 16) * 64) = o; } } }
    for (int g = 0; g < 4; ++g) { const int W = g < 3 ? dil_w(g) : SWA_WINDOW, RV = g < 3 ? 128 : 64;
        const f32x4* src = (const f32x4*)(g < 3 ? sel3c(P.cache_dil, g) : P.cache_nsa_win); f32x4* dst = (f32x4*)(g < 3 ? sel3(P.dil_s, g) : P.win_s);
        const long per = (long)(W - 1) * RV, nvec = (long)DEC_BATCH * per;
#pragma unroll 1
        for (long i0 = (long)gw * 512; i0 < nvec; i0 += (long)NGW * 512) { f32x4 v[8]; long idx[8];
#pragma unroll
            for (int u = 0; u < 8; ++u) { const long i = i0 + u * 64 + lane; const long ii = i < nvec ? i : nvec - 1; const long n = ii / per, o = ii % per; idx[u] = n * (per + RV) + o; v[u] = src[idx[u] + RV]; }
#pragma unroll
            for (int u = 0; u < 8; ++u) { const long i = i0 + u * 64 + lane; if (i < nvec) dst[idx[u]] = v[u]; } } }
}
DI void p0_wpk(const FP& P, const Ctx& C) {
    LAS float* sw = (LAS float*)C.lds;
    LAS float* sk = (LAS float*)(C.lds + 32768);
    constexpr int NIT = DEPTH * 16 * (D_MODEL / 64);
    for (int it = C.vcu; it < NIT; it += C.G) { const int l = it / (16 * (D_MODEL / 64)), rem = it % (16 * (D_MODEL / 64)), hc = rem / (D_MODEL / 64), kb = rem % (D_MODEL / 64);
        __syncthreads();
        for (int i = C.tid; i < 64 * 64; i += NTHREADS) { const int r = i >> 6, d = i & 63; sw[r * 65 + d] = P.peer_wq[((size_t)l * D_MODEL + kb * 64 + r) * 1024 + hc * 64 + d]; }
        for (int i = C.tid; i < 128 * 64; i += NTHREADS) { const int r = i >> 6, d = i & 63; sk[r * 65 + d] = P.peer_keys[(((size_t)l * 16 + hc) * PEER_KEYS + r) * 64 + d]; }
        __syncthreads();
        for (int o = C.tid; o < 128 * 64; o += NTHREADS) { const int kk = o >> 6, ki = o & 63; float a = 0.f;
#pragma unroll 16
            for (int d = 0; d < 64; ++d) a += sw[ki * 65 + d] * sk[kk * 65 + d];
            P.WPK_T[((size_t)l * NPK + hc * 128 + kk) * D_MODEL + kb * 64 + ki] = (bf16)f2bf(a); } }
    __syncthreads();
}

#define EPI_LOOP(...) int fr_l = fr, fq_l = fq; asm volatile("" : "+v"(fr_l), "+v"(fq_l));     \
    _Pragma("unroll") for (int ai = 0; ai < 2; ++ai) _Pragma("unroll") for (int m = 0; m < 4; ++m) { const int row = u.pm * 256 + ai * 128 + wr * 64 + m * 16 + fr_l; \
    _Pragma("unroll") for (int bj = 0; bj < 2; ++bj) { const int ct = bj * 128 + wc * 32 + fq_l * 8; const f32x4 v0 = acc[ai][bj][m][0], v1 = acc[ai][bj][m][1]; __VA_ARGS__ } asm volatile("" ::: "memory"); }
DI void rope4(const float* rope_row, int dp, const f32x4& v0, const f32x4& v1, f32x4& lo, f32x4& hi) {
    const f32x4 c = *(const f32x4*)(rope_row + dp), s = *(const f32x4*)(rope_row + 32 + dp);
    lo.x = v0.x * c.x - v0.y * s.x; hi.x = v0.y * c.x + v0.x * s.x; lo.y = v0.z * c.y - v0.w * s.y; hi.y = v0.w * c.y + v0.z * s.y;
    lo.z = v1.x * c.z - v1.y * s.z; hi.z = v1.y * c.z + v1.x * s.z; lo.w = v1.z * c.w - v1.w * s.w; hi.w = v1.w * c.w + v1.z * s.w; }
DI u32x2 pk4(const f32x4& v) { u32x2 o; o.x = pk2(v.x, v.y); o.y = pk2(v.z, v.w); return o; }
DI u32x4 pk8(const f32x4& a, const f32x4& b) { u32x4 o; o.x = pk2(a.x, a.y); o.y = pk2(a.z, a.w); o.z = pk2(b.x, b.y); o.w = pk2(b.z, b.w); return o; }
DI int dil_perm(int t, int d) { return (t % d) * (SEQ / d) + t / d; }
struct EpiA {
    static constexpr bool PERM = true, AFTER_DRAIN = false; const FP& P;
    DI void operator()(const f32x4 (&acc)[2][2][4][2], const pg8::Unit& u, int wr, int wc, int fr, int fq) const {
        const int t9 = u.pn; const int g = t9 / 3, j = t9 % 3;
        EPI_LOOP({ if (row < MP) { const int h = ct >> 6, e = ct & 63; const int pos = row_pos(row);
            if (t9 == 9) { *(u32x4*)(P.MQA + (size_t)row * 256 + ct) = pk8(v0 * QSCALE, v1 * QSCALE); }
            else if (j < 2) { f32x4 lo, hi; const int dp = e >> 1; rope4(P.ROPE + pos * 64, dp, v0, v1, lo, hi);
                if (j == 0) { bf16* q = P.QA + ((size_t)g * MPAD + row) * 256 + h * 64 + dp; *(u32x2*)q = pk4(lo * QSCALE); *(u32x2*)(q + 32) = pk4(hi * QSCALE); }
                else { if (row < M0) { bf16* kt = P.KA + ((size_t)(g * BATCH + row / SEQ) * DIL_HEADS + h) * 64 * SEQ; const int cm = dil_perm(pos, dil_d(g)); *(u32x2*)(kt + ktile_off(cm, dp)) = pk4(lo); *(u32x2*)(kt + ktile_off(cm, dp + 32)) = pk4(hi); }
                    const int W = dil_w(g); float* o = nullptr;
                    if (row >= M0) o = sel3(P.dil_s, g) + (((size_t)(row - M0) * W + W - 1) * 2 + 0) * 256; else if (pos >= SEQ - W) o = sel3(P.dil_p, g) + (((size_t)(row / SEQ) * W + pos - (SEQ - W)) * 2 + 0) * 256;
                    if (o) { *(f32x4*)(o + h * 64 + dp) = lo; *(f32x4*)(o + h * 64 + 32 + dp) = hi; } } }
            else { const int W = dil_w(g), d = dil_d(g); float* o = nullptr;
                if (row >= M0) o = sel3(P.dil_s, g) + (((size_t)(row - M0) * W + W - 1) * 2 + 1) * 256; else if (pos >= SEQ - W) o = sel3(P.dil_p, g) + (((size_t)(row / SEQ) * W + pos - (SEQ - W)) * 2 + 1) * 256;
                if (o) { *(f32x4*)(o + ct) = v0; *(f32x4*)(o + ct + 4) = v1; }
                if (row < M0) { bf16* vt = P.VTA + ((size_t)(g * BATCH + row / SEQ) * DIL_HEADS + h) * 64 * SEQ + vtile_off(e, dil_perm(pos, d));
                    vt[0] = (bf16)f2bf(v0.x); vt[8] = (bf16)f2bf(v0.y); vt[16] = (bf16)f2bf(v0.z); vt[24] = (bf16)f2bf(v0.w); vt[32] = (bf16)f2bf(v1.x); vt[40] = (bf16)f2bf(v1.y); vt[48] = (bf16)f2bf(v1.z); vt[56] = (bf16)f2bf(v1.w); } } } })
    }
};
struct EpiMem {
    static constexpr bool PERM = true, AFTER_DRAIN = false; const FP& P;
    DI void operator()(const f32x4 (&acc)[2][2][4][2], const pg8::Unit& u, int wr, int wc, int fr, int fq) const {
        const int l = u.pn >> 1, half = u.pn & 1;
        EPI_LOOP({ const int n = row / MEM_TOKENS, mt = row % MEM_TOKENS; float* o = P.mem_kv_p + (((size_t)l * BATCH + n) * MEM_TOKENS + mt) * 512 + half * 256 + ct; *(f32x4*)o = v0; *(f32x4*)(o + 4) = v1;
            if (half == 0) *(u32x4*)(P.MK + (((size_t)l * BATCH + n) * MEM_HEADS + (ct >> 6)) * MEM_TOKENS * 64 + ktile_off(mt, ct & 63)) = pk8(v0, v1);
            else { bf16* vt = P.MVT + (((size_t)l * BATCH + n) * MEM_HEADS + (ct >> 6)) * MEM_TOKENS * 64 + vtile_off(ct & 63, mt);
                vt[0] = (bf16)f2bf(v0.x); vt[8] = (bf16)f2bf(v0.y); vt[16] = (bf16)f2bf(v0.z); vt[24] = (bf16)f2bf(v0.w); vt[32] = (bf16)f2bf(v1.x); vt[40] = (bf16)f2bf(v1.y); vt[48] = (bf16)f2bf(v1.z); vt[56] = (bf16)f2bf(v1.w); } })
    }
};
struct EpiPre {
    static constexpr bool PERM = true, AFTER_DRAIN = false; const float* xa; const float* xb; float* pre;
    DI void operator()(const f32x4 (&acc)[2][2][4][2], const pg8::Unit& u, int wr, int wc, int fr, int fq) const {
        EPI_LOOP({ if (row < MP) { const int col = u.pn * 256 + ct; const float* x = (xb && row >= M0) ? xb + (size_t)(row - M0) * D_MODEL + col : xa + (size_t)row * D_MODEL + col;
            const f32x4 a = *(const f32x4*)x, b = *(const f32x4*)(x + 4); float* o = pre + (size_t)row * D_MODEL + col; *(f32x4*)o = a * ALPHA + v0; *(f32x4*)(o + 4) = b * ALPHA + v1; } })
    }
};
struct EpiF32 {
    static constexpr bool PERM = true, AFTER_DRAIN = false; float* out; int ldc; int nrows;
    DI void operator()(const f32x4 (&acc)[2][2][4][2], const pg8::Unit& u, int wr, int wc, int fr, int fq) const {
        EPI_LOOP({ if (row < nrows) { float* o = out + (size_t)row * ldc + u.pn * 256 + ct; *(f32x4*)o = v0; *(f32x4*)(o + 4) = v1; } })
    }
};
}
namespace fx {
struct Tile16 { f32x4 o[4]; float m, l; };
DI void tile_init(Tile16& T) { T.o[0] = T.o[1] = T.o[2] = T.o[3] = (f32x4){0.f, 0.f, 0.f, 0.f}; T.m = -INFINITY; T.l = 0.f; }
typedef __bf16 bf16x2_t __attribute__((ext_vector_type(2)));
DI unsigned cvtpk(float lo, float hi) { const f32x2 v = {lo, hi}; const bf16x2_t b = __builtin_convertvector(v, bf16x2_t); return __builtin_bit_cast(unsigned, b); }
struct KV8 { bf16x8 ka0, ka1, kb0, kb1, v0, v1, v2, v3; };
DI void kv_load(KV8& r, const bf16* k0, const bf16* k1, const bf16* v, long vs16) {
    r.ka0 = *(const bf16x8*)k0; r.ka1 = *(const bf16x8*)(k0 + 32); r.kb0 = *(const bf16x8*)k1; r.kb1 = *(const bf16x8*)(k1 + 32);
    r.v0 = *(const bf16x8*)v; r.v1 = *(const bf16x8*)(v + vs16); r.v2 = *(const bf16x8*)(v + 2 * vs16); r.v3 = *(const bf16x8*)(v + 3 * vs16); }
template <class MaskF> DI void tile_compute(Tile16& T, const bf16x8 (&qf)[2], const KV8& r, MaskF mask) {
    f32x4 s0 = (f32x4){0.f, 0.f, 0.f, 0.f}, s1 = (f32x4){0.f, 0.f, 0.f, 0.f};
    s0 = __builtin_amdgcn_mfma_f32_16x16x32_bf16(r.ka0, qf[0], s0, 0, 0, 0); s0 = __builtin_amdgcn_mfma_f32_16x16x32_bf16(r.ka1, qf[1], s0, 0, 0, 0);
    s1 = __builtin_amdgcn_mfma_f32_16x16x32_bf16(r.kb0, qf[0], s1, 0, 0, 0); s1 = __builtin_amdgcn_mfma_f32_16x16x32_bf16(r.kb1, qf[1], s1, 0, 0, 0);
    float s[8] = {s0.x, s0.y, s0.z, s0.w, s1.x, s1.y, s1.z, s1.w};
    float mx = -INFINITY;
#pragma unroll
    for (int e = 0; e < 8; ++e) { s[e] = mask(e) ? s[e] : -INFINITY; mx = fmaxf(mx, s[e]); }
    mx = fmaxf(mx, __shfl_xor(mx, 16)); mx = fmaxf(mx, __shfl_xor(mx, 32));
    const float mnew = fmaxf(T.m, mx), muse = (mnew == -INFINITY) ? 0.f : mnew;
    const float alpha = __builtin_amdgcn_exp2f(T.m - muse);
    float ls = 0.f;
#pragma unroll
    for (int e = 0; e < 8; ++e) { s[e] = __builtin_amdgcn_exp2f(s[e] - muse); ls += s[e]; }
    ls += __shfl_xor(ls, 16); ls += __shfl_xor(ls, 32);
    T.l = T.l * alpha + ls; T.m = mnew;
    u32x4 pw; pw.x = cvtpk(s[0], s[1]); pw.y = cvtpk(s[2], s[3]); pw.z = cvtpk(s[4], s[5]); pw.w = cvtpk(s[6], s[7]);
    const bf16x8 pf = __builtin_bit_cast(bf16x8, pw);
    T.o[0] = __builtin_amdgcn_mfma_f32_16x16x32_bf16(r.v0, pf, T.o[0] * alpha, 0, 0, 0); T.o[1] = __builtin_amdgcn_mfma_f32_16x16x32_bf16(r.v1, pf, T.o[1] * alpha, 0, 0, 0);
    T.o[2] = __builtin_amdgcn_mfma_f32_16x16x32_bf16(r.v2, pf, T.o[2] * alpha, 0, 0, 0); T.o[3] = __builtin_amdgcn_mfma_f32_16x16x32_bf16(r.v3, pf, T.o[3] * alpha, 0, 0, 0);
}
template <class BUF, class LD, class CP> DI void pipe2t(int n, LD ld, CP cp) { if (n <= 0) return; BUF A, B; ld(A, 0);
#pragma unroll 1
    for (int i = 0; i < n; i += 2) { ld(B, (i + 1 < n) ? i + 1 : i); cp(A, i); ld(A, (i + 2 < n) ? i + 2 : i); if (i + 1 < n) cp(B, i + 1); } }
template <class LD, class CP> DI void pipe2(int n, LD ld, CP cp) { if (n <= 0) return; KV8 A, B; ld(A, 0);
#pragma unroll 1
    for (int i = 0; i < n; i += 2) { ld(B, (i + 1 < n) ? i + 1 : i); cp(A, i); ld(A, (i + 2 < n) ? i + 2 : i); if (i + 1 < n) cp(B, i + 1); } }
DI void kv_load_t(KV8& r, const bf16* kt, const bf16* vt, int lane) {
    const bf16* k = kt + lane * 8; const bf16* v = vt + lane * 8;
    r.ka0 = *(const bf16x8*)k; r.ka1 = *(const bf16x8*)(k + 512); r.kb0 = *(const bf16x8*)(k + 1024); r.kb1 = *(const bf16x8*)(k + 1536);
    r.v0 = *(const bf16x8*)v; r.v1 = *(const bf16x8*)(v + 512); r.v2 = *(const bf16x8*)(v + 1024); r.v3 = *(const bf16x8*)(v + 1536); }
DI int krow_of(int i, int b) { return 8 * (i >> 2) + 4 * b + (i & 3); }

DI void dil_micro(const FP& P, int n, int h, int t0, int mt, int lane) {
    const int g = mt >> 4, idx = mt & 15, d = dil_d(g), per = 16 / d;
    const int r = idx / per, sub = idx % per, i0 = t0 / d + 16 * sub, ib = i0 - 128, NC = SEQ / d;
    const int q = lane & 15, c = lane >> 4;
    const bf16* Qb = P.QA + ((size_t)g * MPAD + (size_t)n * SEQ) * 256 + h * 64;
    const bf16* Kb = P.KA + ((size_t)(g * BATCH + n) * DIL_HEADS + h) * 64 * SEQ + (size_t)r * NC * 64; const bf16* Vb = P.VTA + ((size_t)(g * BATCH + n) * DIL_HEADS + h) * 64 * SEQ + (size_t)r * NC * 64;
    bf16x8 qf[2]; { const bf16* qp = Qb + (size_t)(r + d * (i0 + q)) * 256 + 8 * c; qf[0] = *(const bf16x8*)qp; qf[1] = *(const bf16x8*)(qp + 32); }
    Tile16 T; tile_init(T);
    const int qi = i0 + q; const int tb0 = ib >> 5  , nblk = ((i0 + 15) >> 5) - tb0 + 1;
    pipe2(nblk, [&](KV8& kv, int i) { int tb = tb0 + i; tb = tb < 0 ? 0 : tb; kv_load_t(kv, Kb + (size_t)tb * 2048, Vb + (size_t)tb * 2048, lane); },
          [&](const KV8& kv, int i) { const int kb = 32 * (tb0 + i); tile_compute(T, qf, kv, [&](int e) { const int ki = kb + 8 * c + e; return ki >= 0 && ki <= qi && qi - ki <= DIL_TAPS - 1; }); });
    const int row = n * SEQ + r + d * qi;
    float* op = P.DPART + (((size_t)g * MP + row) * DIL_HEADS + h) * 64 + 4 * c;
#pragma unroll
    for (int db = 0; db < 4; ++db) *(f32x4*)(op + 16 * db) = T.o[db];
    if (c == 0) { float* ml = P.DML + (((size_t)g * MP + row) * DIL_HEADS + h) * 2; ml[0] = T.m; ml[1] = T.l; }
}
DI void mem_micro(const FP& P, const bf16* Q  , int ldq, int row0, int layer, int n, int h, bf16* O  , int ldo, int lane) {
    const int q = lane & 15, c = lane >> 4;
    bf16x8 qf[2]; { const bf16* qp = Q + (size_t)(row0 + q) * ldq + 8 * c; qf[0] = *(const bf16x8*)qp; qf[1] = *(const bf16x8*)(qp + 32); }
    const bf16* Kb = P.MK + (((size_t)layer * BATCH + n) * MEM_HEADS + h) * MEM_TOKENS * 64; const bf16* Vb = P.MVT + (((size_t)layer * BATCH + n) * MEM_HEADS + h) * MEM_TOKENS * 64;
    Tile16 T; tile_init(T);
    pipe2(MEM_TOKENS / 32, [&](KV8& kv, int i) { kv_load_t(kv, Kb + (size_t)i * 2048, Vb + (size_t)i * 2048, lane); }, [&](const KV8& kv, int) { tile_compute(T, qf, kv, [&](int) { return true; }); });
    const float inv = 1.0f / T.l; bf16* op = O + (size_t)(row0 + q) * ldo + 4 * c;
#pragma unroll
    for (int db = 0; db < 4; ++db) *(u32x2*)(op + 16 * db) = pk4(T.o[db] * inv);
}
struct Dec { float m, l, o; };
template <class KF, class VF> DI void dec_chunk(Dec& D, const LAS float* q, int nk, KF kf, VF vf, int lane) {
    float s = -INFINITY;
    if (lane < nk) { const float* k = kf(lane); float a = 0.f;
#pragma unroll
        for (int d4 = 0; d4 < 16; ++d4) { const f32x4 kv = *(const f32x4*)(k + 4 * d4); a += kv.x * q[4 * d4] + kv.y * q[4 * d4 + 1] + kv.z * q[4 * d4 + 2] + kv.w * q[4 * d4 + 3]; }
        s = a; }
    const float mx = wave_max(s), mnew = fmaxf(D.m, mx), alpha = __builtin_amdgcn_exp2f(D.m - mnew);
    const float p = (lane < nk) ? __builtin_amdgcn_exp2f(s - mnew) : 0.f;
    D.l = D.l * alpha + wave_sum(p); D.m = mnew; float o = D.o * alpha;
    for (int j0 = 0; j0 < nk; j0 += 8) { float vv[8];
#pragma unroll
        for (int u = 0; u < 8; ++u) { const int jj = (j0 + u < nk) ? j0 + u : nk - 1; vv[u] = vf(jj)[lane]; }
#pragma unroll
        for (int u = 0; u < 8; ++u) { const float pj = (j0 + u < nk) ? __builtin_bit_cast(float, __builtin_amdgcn_readlane(__builtin_bit_cast(int, p), (j0 + u) & 63)) : 0.f; o += pj * vv[u]; } }
    D.o = o;
}
DI float dec_combine(const Ctx& C, const Dec& D) {
    LAS float* cb = (LAS float*)(C.lds + 4096);
    cb[C.wave * 66 + C.lane] = D.o; if (C.lane == 0) { cb[C.wave * 66 + 64] = D.m; cb[C.wave * 66 + 65] = D.l; }
    asm volatile("s_waitcnt lgkmcnt(0)" ::: "memory"); __syncthreads();
    float M = -INFINITY;
#pragma unroll
    for (int ww = 0; ww < NWAVES; ++ww) M = fmaxf(M, cb[ww * 66 + 64]);
    float L = 0.f, o = 0.f;
#pragma unroll
    for (int ww = 0; ww < NWAVES; ++ww) { const float mw = cb[ww * 66 + 64]; const float f = (mw == -INFINITY) ? 0.f : __builtin_amdgcn_exp2f(mw - M); L += f * cb[ww * 66 + 65]; o += f * cb[ww * 66 + C.lane]; }
    return o / L;
}
DI void atta_phase(const FP& P, const Ctx& C) {
    const int lane = C.lane, w = C.wave;
    constexpr int NT = SEQ / 256, NIT = BATCH * NT * DIL_HEADS;
    for (int it = C.vcu; it < NIT; it += C.G) { const int h = it % DIL_HEADS, tt = (it / DIL_HEADS) % NT, n = it / (DIL_HEADS * NT), t0 = tt * 256;
        for (int mt = w; mt < 48; mt += NWAVES) dil_micro(P, n, h, t0, mt, lane);
        asm volatile("s_waitcnt vmcnt(0)" ::: "memory"); __syncthreads();
        for (int i = C.tid; i < 256 * 16; i += NTHREADS) { const int tk = i >> 4, d4 = (i & 15) * 4; const int row = n * SEQ + t0 + tk;
            float mg[3], lg[3]; float M = -INFINITY;
#pragma unroll
            for (int g = 0; g < 3; ++g) { const float* ml = P.DML + (((size_t)g * MP + row) * DIL_HEADS + h) * 2; mg[g] = ml[0]; lg[g] = ml[1]; M = fmaxf(M, mg[g]); }
            f32x4 acc = (f32x4){0.f, 0.f, 0.f, 0.f}; float L = 0.f;
#pragma unroll
            for (int g = 0; g < 3; ++g) { const float wg = __builtin_amdgcn_exp2f(mg[g] - M); L += wg * lg[g]; acc += *(const f32x4*)(P.DPART + (((size_t)g * MP + row) * DIL_HEADS + h) * 64 + d4) * wg; }
            *(u32x2*)(P.ATTA + (size_t)row * 512 + h * 64 + d4) = pk4(acc * (1.0f / L)); }
        for (int mt = w; mt < 16; mt += NWAVES) mem_micro(P, P.MQA + h * 64, 256, n * SEQ + t0 + 16 * mt, 0, n, h, P.ATTA + 256 + h * 64, 512, lane);
        __syncthreads();
    }
    LAS float* qs = (LAS float*)C.lds;
    for (int it = C.vcu; it < DEC_BATCH * DIL_HEADS * 2; it += C.G) { const int kind = it & 1, h = (it >> 1) % DIL_HEADS, ns = (it >> 1) / DIL_HEADS, row = M0 + ns;
        __syncthreads();
        if (kind == 0) { if (C.tid < 192) qs[C.tid] = bf2f(P.QA[((size_t)(C.tid >> 6) * MPAD + row) * 256 + h * 64 + (C.tid & 63)]); } else { if (C.tid < 64) qs[C.tid] = bf2f(P.MQA[(size_t)row * 256 + h * 64 + C.tid]); }
        asm volatile("s_waitcnt lgkmcnt(0)" ::: "memory"); __syncthreads();
        Dec D; D.m = -INFINITY; D.l = 0.f; D.o = 0.f;
        if (kind == 0) { constexpr int CPG = (DIL_TAPS + 63) / 64;
            for (int ck = w; ck < 3 * CPG; ck += NWAVES) { const int g = ck / CPG, j0 = (ck % CPG) * 64; const int W = dil_w(g), d = dil_d(g); const float* cache = sel3c(P.cache_dil, g) + (size_t)ns * W * 512; const float* newrow = sel3(P.dil_s, g) + ((size_t)ns * W + W - 1) * 512;
                const int nk = (DIL_TAPS - j0) < 64 ? (DIL_TAPS - j0) : 64;
                dec_chunk(D, qs + g * 64, nk, [&](int j) { const int tap = j0 + j; return (tap == 0 ? newrow : cache + (size_t)(W - d * tap) * 512) + h * 64; },
                          [&](int j) { const int tap = j0 + j; return (tap == 0 ? newrow : cache + (size_t)(W - d * tap) * 512) + 256 + h * 64; }, lane); } }
        else { const float* mk = P.cache_mem_kv + ((size_t)0 * DEC_BATCH + ns) * MEM_TOKENS * 512;
            for (int ck = w; ck < MEM_TOKENS / 64; ck += NWAVES) { const int j0 = ck * 64; dec_chunk(D, qs, 64, [&](int j) { return mk + (size_t)(j0 + j) * 512 + h * 64; }, [&](int j) { return mk + (size_t)(j0 + j) * 512 + 256 + h * 64; }, lane); } }
        const float o = dec_combine(C, D);
        if (w == 0) P.ATTA[(size_t)row * 512 + (kind == 0 ? 0 : 256) + h * 64 + lane] = (bf16)f2bf(o);
    }
    __syncthreads();
}
DI void ln_phase(const FP& P, const Ctx& C, const float* pre, const float* gam, const float* bet, float* xo, bf16* xb, float* yp, float* ys) {
    const int gw = C.vcu * NWAVES + C.wave, NGW = C.G * NWAVES, lane = C.lane;
    for (int r = gw; r < MP; r += NGW) { const float* x = pre + (size_t)r * D_MODEL; f32x4 v[4]; float s = 0.f;
#pragma unroll
        for (int j = 0; j < 4; ++j) { v[j] = *(const f32x4*)(x + 256 * j + 4 * lane); s += (v[j].x + v[j].y) + (v[j].z + v[j].w); }
        const float mu = wave_sum(s) * (1.0f / D_MODEL); float s2 = 0.f;
#pragma unroll
        for (int j = 0; j < 4; ++j) { v[j] = v[j] - mu; s2 += (v[j].x * v[j].x + v[j].y * v[j].y) + (v[j].z * v[j].z + v[j].w * v[j].w); }
        const float rs = 1.0f / sqrtf(wave_sum(s2) * (1.0f / D_MODEL) + LN_EPS);
#pragma unroll
        for (int j = 0; j < 4; ++j) { const f32x4 gg = *(const f32x4*)(gam + 256 * j + 4 * lane), bb = *(const f32x4*)(bet + 256 * j + 4 * lane); const f32x4 o = v[j] * rs * gg + bb;
            if (xo) *(f32x4*)(xo + (size_t)r * D_MODEL + 256 * j + 4 * lane) = o;
            if (xb) *(u32x2*)(xb + (size_t)r * D_MODEL + 256 * j + 4 * lane) = pk4(o);
            if (yp) { if (r < M0) *(f32x4*)(yp + (size_t)r * D_MODEL + 256 * j + 4 * lane) = o; else *(f32x4*)(ys + (size_t)(r - M0) * D_MODEL + 256 * j + 4 * lane) = o; } }
    }
}
}
namespace fx {
#define INS16(V, I, v_, i_) do { const float _v = (v_); const int _i = (i_); bool _c[16]; _Pragma("unroll") for (int _k = 0; _k < 16; ++_k) _c[_k] = _v > V[_k]; \
    _Pragma("unroll") for (int _k = 15; _k >= 1; --_k) { V[_k] = _c[_k] ? (_c[_k - 1] ? V[_k - 1] : _v) : V[_k]; I[_k] = _c[_k] ? (_c[_k - 1] ? I[_k - 1] : _i) : I[_k]; } \
    V[0] = _c[0] ? _v : V[0]; I[0] = _c[0] ? _i : I[0]; } while (0)
DI void wave_top16_128(float a, float b, int lane, float& outv, int& outi) {
    outv = -INFINITY; outi = 0;
#pragma unroll 1
    for (int k = 0; k < 16; ++k) { const float m = wave_max(fmaxf(a, b)); const unsigned long long ba = __ballot(a == m), bb = __ballot(b == m); int idx;
        if (ba) { const int l = __builtin_ctzll(ba); idx = l; if (lane == l) a = -INFINITY; } else { const int l = __builtin_ctzll(bb); idx = 64 + l; if (lane == l) b = -INFINITY; }
        if (lane == k) { outv = m; outi = idx; } }
}
DI void topk_wave_item(const FP& P, long it, int lane) {
    const float* s = P.SCO + it * 256; float v1, v2; int i1, i2;
    wave_top16_128(s[lane], s[64 + lane], lane, v1, i1); wave_top16_128(s[128 + lane], s[192 + lane], lane, v2, i2);
    int a = 0, rem = lane; bool valid = false;
    for (int aa = 0; aa < 16; ++aa) { const int nb = 16 / (aa + 1); if (!valid) { if (rem < nb) { a = aa; valid = true; } else rem -= nb; } }
    const int b = valid ? rem : 0;
    float cs = __shfl(v1, a) + __shfl(v2, b); const int ce = __shfl(i1, a) * PEER_KEYS + __shfl(i2, b); if (!valid) cs = -INFINITY;
    float tv = -INFINITY; int te = 0;
#pragma unroll 1
    for (int k = 0; k < 16; ++k) { const float m = wave_max(cs); const unsigned long long bm = __ballot(cs == m); const int l = __builtin_ctzll(bm); const int e = __shfl(ce, l); if (lane == l) cs = -INFINITY; if (lane == k) { tv = m; te = e; } }
    const float mx = __shfl(tv, 0); const float ex = (lane < 16) ? __expf(tv - mx) : 0.f; const float z = wave_sum(ex);
    if (lane < 16) { P.SELG[it * 16 + lane] = ex / z; P.SELE[it * 16 + lane] = te; }
}
#define KINS16(V, key_) do { const float _key = (key_); _Pragma("unroll") for (int _k = 15; _k >= 1; --_k) V[_k] = __builtin_amdgcn_fmed3f(V[_k - 1], V[_k], _key); V[0] = fmaxf(V[0], _key); } while (0)
DI float pack_key(float v, unsigned lowbits, unsigned mask) { return __builtin_bit_cast(float, (__builtin_bit_cast(unsigned, v) & ~mask) | lowbits); }
DI void topk_phase(const FP& P, const Ctx& C) {
    const int lane = C.lane; LAS float* st = (LAS float*)(C.lds + C.wave * 16384);
    const int NWI = (M0 * PEER_HEADS) / 64;
    for (int wi = C.vcu * NWAVES + C.wave; wi < NWI; wi += C.G * NWAVES) {
        const long it0 = (long)wi * 64; const long it = it0 + lane;
        float V1[16], V2[16], V3[16];
#pragma unroll
        for (int k = 0; k < 16; ++k) { V1[k] = V2[k] = V3[k] = -INFINITY; }
#pragma unroll 1
        for (int ch = 0; ch < 8; ++ch) {
#pragma unroll
            for (int u = 0; u < 8; ++u) { const int f4 = u * 64 + lane, j = f4 >> 3, q = f4 & 7, hf = q >> 2, c4 = (q & 3) * 4; const long itj = it0 + j;
                const f32x4 v = *(const f32x4*)(P.SCO + itj * 256 + hf * 128 + ch * 16 + c4);
                st[j * 33 + hf * 16 + c4] = v.x; st[j * 33 + hf * 16 + c4 + 1] = v.y; st[j * 33 + hf * 16 + c4 + 2] = v.z; st[j * 33 + hf * 16 + c4 + 3] = v.w; }
            asm volatile("s_waitcnt lgkmcnt(0)" ::: "memory");
#pragma unroll 4
            for (int c = 0; c < 16; ++c) { const float va = st[lane * 33 + c], vb = st[lane * 33 + 16 + c]; const unsigned lb = 127u - (unsigned)(ch * 16 + c); KINS16(V1, pack_key(va, lb, 127u)); KINS16(V2, pack_key(vb, lb, 127u)); }
            asm volatile("s_waitcnt lgkmcnt(0)" ::: "memory");
        }
        LAS int* lc = (LAS int*)st;
        { int ord = 0;
#pragma unroll
          for (int a = 0; a < 16; ++a) { const unsigned ba = __builtin_bit_cast(unsigned, V1[a]); const float va = __builtin_bit_cast(float, ba & ~127u); const int ia = 127 - (int)(ba & 127u);
#pragma unroll
              for (int b = 0; b < 16; ++b) if ((a + 1) * (b + 1) <= 16) { const unsigned bb = __builtin_bit_cast(unsigned, V2[b]); const float vb = __builtin_bit_cast(float, bb & ~127u); const int ib = 127 - (int)(bb & 127u);
                  lc[lane * 51 + ord] = ia * PEER_KEYS + ib; KINS16(V3, pack_key(va + vb, 63u - (unsigned)ord, 63u)); ++ord; } } }
        asm volatile("s_waitcnt lgkmcnt(0)" ::: "memory");
        float g[16]; int e[16]; float z = 0.f; const float vmax = __builtin_bit_cast(float, __builtin_bit_cast(unsigned, V3[0]) & ~63u);
#pragma unroll
        for (int k = 0; k < 16; ++k) { const unsigned bk = __builtin_bit_cast(unsigned, V3[k]); e[k] = lc[lane * 51 + 63 - (int)(bk & 63u)]; g[k] = __expf(__builtin_bit_cast(float, bk & ~63u) - vmax); z += g[k]; }
        const float iz = 1.0f / z;
#pragma unroll
        for (int k4 = 0; k4 < 4; ++k4) { *(f32x4*)(P.SELG + it * 16 + 4 * k4) = (f32x4){g[4 * k4] * iz, g[4 * k4 + 1] * iz, g[4 * k4 + 2] * iz, g[4 * k4 + 3] * iz};
            *(int4*)(P.SELE + it * 16 + 4 * k4) = make_int4(e[4 * k4], e[4 * k4 + 1], e[4 * k4 + 2], e[4 * k4 + 3]); }
        asm volatile("s_waitcnt lgkmcnt(0)" ::: "memory");
    }
    for (int si = C.vcu * NWAVES + C.wave; si < DEC_BATCH * PEER_HEADS; si += C.G * NWAVES) topk_wave_item(P, (long)M0 * PEER_HEADS + si, lane);
    __syncthreads();
}
constexpr float PEER_SU = 256.f, PEER_SV = 64.f;
DI float dot16_fp8(const u32x4& w, const f32x2 (&x2)[8]) { f32x2 a = {0.f, 0.f};
    a += __builtin_amdgcn_cvt_pk_f32_fp8((int)w.x, false) * x2[0]; a += __builtin_amdgcn_cvt_pk_f32_fp8((int)w.x, true) * x2[1];
    a += __builtin_amdgcn_cvt_pk_f32_fp8((int)w.y, false) * x2[2]; a += __builtin_amdgcn_cvt_pk_f32_fp8((int)w.y, true) * x2[3];
    a += __builtin_amdgcn_cvt_pk_f32_fp8((int)w.z, false) * x2[4]; a += __builtin_amdgcn_cvt_pk_f32_fp8((int)w.z, true) * x2[5];
    a += __builtin_amdgcn_cvt_pk_f32_fp8((int)w.w, false) * x2[6]; a += __builtin_amdgcn_cvt_pk_f32_fp8((int)w.w, true) * x2[7];
    return a.x + a.y; }
DI void axpy16_fp8(const u32x4& w, float s, f32x2 (&o2)[8]) { const f32x2 s2 = {s, s};
    o2[0] += __builtin_amdgcn_cvt_pk_f32_fp8((int)w.x, false) * s2; o2[1] += __builtin_amdgcn_cvt_pk_f32_fp8((int)w.x, true) * s2;
    o2[2] += __builtin_amdgcn_cvt_pk_f32_fp8((int)w.y, false) * s2; o2[3] += __builtin_amdgcn_cvt_pk_f32_fp8((int)w.y, true) * s2;
    o2[4] += __builtin_amdgcn_cvt_pk_f32_fp8((int)w.z, false) * s2; o2[5] += __builtin_amdgcn_cvt_pk_f32_fp8((int)w.z, true) * s2;
    o2[6] += __builtin_amdgcn_cvt_pk_f32_fp8((int)w.w, false) * s2; o2[7] += __builtin_amdgcn_cvt_pk_f32_fp8((int)w.w, true) * s2; }
#if defined(PEER_SHARD) || defined(PEER_SHARD2)
#define PEER_FIRST_ROUND nrounds
#else
#define PEER_FIRST_ROUND 0
#endif
DI float rdlane(float v, int l) { return __builtin_bit_cast(float, __builtin_amdgcn_readlane(__builtin_bit_cast(int, v), l)); }
DI void peer_phase(const FP& P, const Ctx& C, int layer, const float* xin, float* fout, float* fout_s, bf16* xb, bool samples_only = false) {
    const int lane = C.lane; const unsigned char* U = P.UB8 + (size_t)layer * PEER_EXPERTS * D_MODEL; const unsigned char* Vt = P.VB8 + (size_t)layer * PEER_EXPERTS * D_MODEL;
    const float* gam = P.ln_g + ((size_t)layer * 2 + 1) * D_MODEL; const float* bet = P.ln_b + ((size_t)layer * 2 + 1) * D_MODEL;
    const int nrounds = (M0 + C.G * NWAVES - 1) / (C.G * NWAVES);
#pragma unroll 1
    for (int rd = samples_only ? nrounds : 0; rd <= nrounds; ++rd) {
        const bool smp = (rd == nrounds); int r = smp ? M0 + C.vcu : rd * C.G * NWAVES + C.vcu * NWAVES + C.wave; if (smp ? (C.vcu >= DEC_BATCH) : (r >= M0)) continue;
        const int pb = smp ? 16 * C.wave : 0, pe = smp ? pb + 16 : 128;
        f32x2 x2[8], o2[8];
#pragma unroll
        for (int j = 0; j < 4; ++j) { const f32x4 a = *(const f32x4*)(xin + (size_t)r * D_MODEL + 16 * lane + 4 * j); x2[2 * j] = (f32x2){a.x, a.y}; x2[2 * j + 1] = (f32x2){a.z, a.w}; }
#pragma unroll
        for (int k = 0; k < 8; ++k) o2[k] = (f32x2){0.f, 0.f};
        const int e_l = P.SELE[(size_t)r * 128 + lane], e_h = P.SELE[(size_t)r * 128 + 64 + lane]; const float g_l = P.SELG[(size_t)r * 128 + lane], g_h = P.SELG[(size_t)r * 128 + 64 + lane];
#pragma unroll 1
        for (int b0 = pb; b0 < pe; b0 += 8) {
            u32x4 uw[8], vw[8];
#pragma unroll
            for (int k = 0; k < 8; ++k) { const int hk = b0 + k; const int e = (hk < 64) ? __builtin_amdgcn_readlane(e_l, hk & 63) : __builtin_amdgcn_readlane(e_h, hk & 63);
                uw[k] = *(const u32x4*)(U + (size_t)e * D_MODEL + 16 * lane); vw[k] = *(const u32x4*)(Vt + (size_t)e * D_MODEL + 16 * lane); }
            float d[8];
#pragma unroll
            for (int k = 0; k < 8; ++k) d[k] = dot16_fp8(uw[k], x2);
            float e4[4], e2[2], e1;
            { const bool hi = lane & 1;
#pragma unroll
              for (int i = 0; i < 4; ++i) { const float keep = hi ? d[4 + i] : d[i], send = hi ? d[i] : d[4 + i]; e4[i] = keep + __shfl_xor(send, 1); } }
            { const bool hi = lane & 2;
#pragma unroll
              for (int i = 0; i < 2; ++i) { const float keep = hi ? e4[2 + i] : e4[i], send = hi ? e4[i] : e4[2 + i]; e2[i] = keep + __shfl_xor(send, 2); } }
            { const bool hi = lane & 4; const float keep = hi ? e2[1] : e2[0], send = hi ? e2[0] : e2[1]; e1 = keep + __shfl_xor(send, 4); }
            e1 += __shfl_xor(e1, 8); e1 += __shfl_xor(e1, 16); e1 += __shfl_xor(e1, 32);
            const int myk = 4 * (lane & 1) + (lane & 2) + ((lane >> 2) & 1); const int myhk = b0 + myk;
            const float myg = (myhk < 64) ? __shfl(g_l, myhk & 63) : __shfl(g_h, myhk & 63);
            const float act = myg * gelu_tanh(e1 * (1.0f / PEER_SU)) * (1.0f / PEER_SV);
#pragma unroll
            for (int k = 0; k < 8; ++k) { const int src = (k >> 2) | (((k >> 1) & 1) << 1) | ((k & 1) << 2); axpy16_fp8(vw[k], rdlane(act, src), o2); }
        }
        if (smp) {
            LAS float* red = (LAS float*)C.lds;
#pragma unroll
            for (int k = 0; k < 8; ++k) { red[C.wave * 1024 + 16 * lane + 2 * k] = o2[k].x; red[C.wave * 1024 + 16 * lane + 2 * k + 1] = o2[k].y; }
            asm volatile("s_waitcnt lgkmcnt(0)" ::: "memory"); __syncthreads();
            if (C.wave == 0) {
#pragma unroll
                for (int k = 0; k < 8; ++k) { float ax = 0.f, ay = 0.f;
#pragma unroll
                    for (int ww = 0; ww < NWAVES; ++ww) { ax += red[ww * 1024 + 16 * lane + 2 * k]; ay += red[ww * 1024 + 16 * lane + 2 * k + 1]; } o2[k] = (f32x2){ax, ay}; } }
            __syncthreads();
            if (C.wave != 0) continue; }
        float s = 0.f;
#pragma unroll
        for (int k = 0; k < 8; ++k) { o2[k] += x2[k] * ALPHA; s += o2[k].x + o2[k].y; }
        const float mu = wave_sum(s) * (1.0f / D_MODEL); float s2 = 0.f;
#pragma unroll
        for (int k = 0; k < 8; ++k) { o2[k] -= mu; s2 += o2[k].x * o2[k].x + o2[k].y * o2[k].y; }
        const float rs = 1.0f / sqrtf(wave_sum(s2) * (1.0f / D_MODEL) + LN_EPS);
        float* frow = (r < M0) ? fout + (size_t)r * D_MODEL : fout_s + (size_t)(r - M0) * D_MODEL;
#pragma unroll
        for (int j = 0; j < 4; ++j) { const int c0 = 16 * lane + 4 * j; const f32x4 gg = *(const f32x4*)(gam + c0), bb = *(const f32x4*)(bet + c0);
            const f32x4 y = (f32x4){o2[2 * j].x * rs, o2[2 * j].y * rs, o2[2 * j + 1].x * rs, o2[2 * j + 1].y * rs} * gg + bb;
            *(f32x4*)(frow + c0) = y; if (xb) *(u32x2*)(xb + (size_t)r * D_MODEL + c0) = pk4(y); }
    }
}
DI void peer_u_phase(const FP& P, const Ctx& C, int layer, const bf16* xb16) {
    const int lane = C.lane; const unsigned char* U = P.UB8 + (size_t)layer * PEER_EXPERTS * D_MODEL;
    const int s = (int)(blockIdx.x & 7), nw = (C.G >> 3) * NWAVES, widx = (int)(blockIdx.x >> 3) * NWAVES + C.wave;
#pragma unroll 1
    for (int r = widx; r < MP; r += nw) {
        const int e0 = P.SELE[(size_t)r * 128 + lane], e1 = P.SELE[(size_t)r * 128 + 64 + lane]; const float g0 = P.SELG[(size_t)r * 128 + lane], g1 = P.SELG[(size_t)r * 128 + 64 + lane];
        unsigned long long b0 = __ballot((e0 >> 11) == s), b1 = __ballot((e1 >> 11) == s);
        if ((b0 | b1) == 0ull) continue;
        f32x2 x2[8]; { const u32x4 xa = *(const u32x4*)(xb16 + (size_t)r * D_MODEL + 16 * lane), xc = *(const u32x4*)(xb16 + (size_t)r * D_MODEL + 16 * lane + 8);
            x2[0] = (f32x2){bflo(xa.x), bfhi(xa.x)}; x2[1] = (f32x2){bflo(xa.y), bfhi(xa.y)}; x2[2] = (f32x2){bflo(xa.z), bfhi(xa.z)}; x2[3] = (f32x2){bflo(xa.w), bfhi(xa.w)};
            x2[4] = (f32x2){bflo(xc.x), bfhi(xc.x)}; x2[5] = (f32x2){bflo(xc.y), bfhi(xc.y)}; x2[6] = (f32x2){bflo(xc.z), bfhi(xc.z)}; x2[7] = (f32x2){bflo(xc.w), bfhi(xc.w)}; }
#pragma unroll 1
        while ((b0 | b1) != 0ull) {
            int hk[8]; u32x4 uw[8]; int nv = 0;
#pragma unroll
            for (int k = 0; k < 8; ++k) { int h;
                if (b0) { h = __builtin_ctzll(b0); b0 &= b0 - 1; ++nv; } else if (b1) { h = 64 + __builtin_ctzll(b1); b1 &= b1 - 1; ++nv; } else h = hk[k > 0 ? k - 1 : 0];
                hk[k] = h; const int e = (h < 64) ? __builtin_amdgcn_readlane(e0, h & 63) : __builtin_amdgcn_readlane(e1, h & 63);
                uw[k] = *(const u32x4*)(U + (size_t)e * D_MODEL + 16 * lane); }
            float d[8];
#pragma unroll
            for (int k = 0; k < 8; ++k) d[k] = dot16_fp8(uw[k], x2);
            float e4[4], e2[2], e1s;
            { const bool hi = lane & 1;
#pragma unroll
              for (int i = 0; i < 4; ++i) { const float keep = hi ? d[4 + i] : d[i], send = hi ? d[i] : d[4 + i]; e4[i] = keep + __shfl_xor(send, 1); } }
            { const bool hi = lane & 2;
#pragma unroll
              for (int i = 0; i < 2; ++i) { const float keep = hi ? e4[2 + i] : e4[i], send = hi ? e4[i] : e4[2 + i]; e2[i] = keep + __shfl_xor(send, 2); } }
            { const bool hi = lane & 4; const float keep = hi ? e2[1] : e2[0], send = hi ? e2[0] : e2[1]; e1s = keep + __shfl_xor(send, 4); }
            e1s += __shfl_xor(e1s, 8); e1s += __shfl_xor(e1s, 16); e1s += __shfl_xor(e1s, 32);
            const int myk = 4 * (lane & 1) + (lane & 2) + ((lane >> 2) & 1);
            int myh = hk[0];
#pragma unroll
            for (int k = 1; k < 8; ++k) myh = (myk == k) ? hk[k] : myh;
            const float ga = __shfl(g0, myh & 63), gb = __shfl(g1, myh & 63); const float myg = (myh < 64) ? ga : gb;
            if (lane < 8 && myk < nv) P.SCO[(size_t)r * 128 + myh] = myg * gelu_tanh(e1s * (1.0f / PEER_SU)) * (1.0f / PEER_SV);
        }
    }
}
DI void peer_v_phase(const FP& P, const Ctx& C, int layer, const float* xin, float* fout, float* fout_s, bf16* xb) {
    const int lane = C.lane; const unsigned char* Vt = P.VB8 + (size_t)layer * PEER_EXPERTS * D_MODEL;
    const float* gam = P.ln_g + ((size_t)layer * 2 + 1) * D_MODEL; const float* bet = P.ln_b + ((size_t)layer * 2 + 1) * D_MODEL;
    const int nrounds = (M0 + C.G * NWAVES - 1) / (C.G * NWAVES);
#pragma unroll 1
    for (int rd = 0; rd <= nrounds; ++rd) {
        const bool smp = (rd == nrounds); int r = smp ? M0 + C.vcu : rd * C.G * NWAVES + C.vcu * NWAVES + C.wave; if (smp ? (C.vcu >= DEC_BATCH) : (r >= M0)) continue;
        const int pb = smp ? 16 * C.wave : 0, pe = smp ? pb + 16 : 128;
        f32x2 x2[8], o2[8];
#pragma unroll
        for (int j = 0; j < 4; ++j) { const f32x4 a = *(const f32x4*)(xin + (size_t)r * D_MODEL + 16 * lane + 4 * j); x2[2 * j] = (f32x2){a.x, a.y}; x2[2 * j + 1] = (f32x2){a.z, a.w}; }
#pragma unroll
        for (int k = 0; k < 8; ++k) o2[k] = (f32x2){0.f, 0.f};
        const int e_l = P.SELE[(size_t)r * 128 + lane], e_h = P.SELE[(size_t)r * 128 + 64 + lane]; const float a_l = P.SCO[(size_t)r * 128 + lane], a_h = P.SCO[(size_t)r * 128 + 64 + lane];
#pragma unroll 1
        for (int b0 = pb; b0 < pe; b0 += 16) { u32x4 vw[16];
#pragma unroll
            for (int k = 0; k < 16; ++k) { const int hk = b0 + k; const int e = (hk < 64) ? __builtin_amdgcn_readlane(e_l, hk & 63) : __builtin_amdgcn_readlane(e_h, hk & 63); vw[k] = *(const u32x4*)(Vt + (size_t)e * D_MODEL + 16 * lane); }
#pragma unroll
            for (int k = 0; k < 16; ++k) { const int hk = b0 + k; axpy16_fp8(vw[k], (hk < 64) ? rdlane(a_l, hk & 63) : rdlane(a_h, hk & 63), o2); } }
        if (smp) {
            LAS float* red = (LAS float*)C.lds;
#pragma unroll
            for (int k = 0; k < 8; ++k) { red[C.wave * 1024 + 16 * lane + 2 * k] = o2[k].x; red[C.wave * 1024 + 16 * lane + 2 * k + 1] = o2[k].y; }
            asm volatile("s_waitcnt lgkmcnt(0)" ::: "memory"); __syncthreads();
            if (C.wave == 0) {
#pragma unroll
                for (int k = 0; k < 8; ++k) { float ax = 0.f, ay = 0.f;
#pragma unroll
                    for (int ww = 0; ww < NWAVES; ++ww) { ax += red[ww * 1024 + 16 * lane + 2 * k]; ay += red[ww * 1024 + 16 * lane + 2 * k + 1]; } o2[k] = (f32x2){ax, ay}; } }
            __syncthreads();
            if (C.wave != 0) continue; }
        float s = 0.f;
#pragma unroll
        for (int k = 0; k < 8; ++k) { o2[k] += x2[k] * ALPHA; s += o2[k].x + o2[k].y; }
        const float mu = wave_sum(s) * (1.0f / D_MODEL); float s2 = 0.f;
#pragma unroll
        for (int k = 0; k < 8; ++k) { o2[k] -= mu; s2 += o2[k].x * o2[k].x + o2[k].y * o2[k].y; }
        const float rs = 1.0f / sqrtf(wave_sum(s2) * (1.0f / D_MODEL) + LN_EPS);
        float* frow = (r < M0) ? fout + (size_t)r * D_MODEL : fout_s + (size_t)(r - M0) * D_MODEL;
#pragma unroll
        for (int j = 0; j < 4; ++j) { const int c0 = 16 * lane + 4 * j; const f32x4 gg = *(const f32x4*)(gam + c0), bb = *(const f32x4*)(bet + c0);
            const f32x4 y = (f32x4){o2[2 * j].x * rs, o2[2 * j].y * rs, o2[2 * j + 1].x * rs, o2[2 * j + 1].y * rs} * gg + bb;
            *(f32x4*)(frow + c0) = y; if (xb) *(u32x2*)(xb + (size_t)r * D_MODEL + c0) = pk4(y); }
    }
}
constexpr int PSH_LIST = 512;
struct PG4 { u32x4 u[4], v[4]; };
DI void peer_sharded_phase(const FP& P, const Ctx& C, int layer, const float* xin, const bf16* xb16, float* fout, float* fout_s, bf16* xb) {
    const int lane = C.lane; const unsigned char* U = P.UB8 + (size_t)layer * PEER_EXPERTS * D_MODEL; const unsigned char* Vt = P.VB8 + (size_t)layer * PEER_EXPERTS * D_MODEL;
    const float* gam = P.ln_g + ((size_t)layer * 2 + 1) * D_MODEL; const float* bet = P.ln_b + ((size_t)layer * 2 + 1) * D_MODEL;
    LAS unsigned char* wl = C.lds + C.wave * 16384; LAS bf16* xs = (LAS bf16*)wl; LAS int* lst = (LAS int*)(wl + 8192);
    const int NW = C.G * NWAVES, gw = C.vcu * NWAVES + C.wave; const int nquads = (M0 / NW) / 4;
#pragma unroll 1
    for (int qd = 0; qd < nquads; ++qd) {
#define PSH_ROW(j) const int row##j = (qd * 4 + j) * NW + gw; const int el##j = P.SELE[(size_t)row##j * 128 + lane], eh##j = P.SELE[(size_t)row##j * 128 + 64 + lane]; const float gl##j = P.SELG[(size_t)row##j * 128 + lane], gh##j = P.SELG[(size_t)row##j * 128 + 64 + lane]; \
        { const u32x4 xa = *(const u32x4*)(xb16 + (size_t)row##j * D_MODEL + 16 * lane), xc = *(const u32x4*)(xb16 + (size_t)row##j * D_MODEL + 16 * lane + 8); *(LAS u32x4*)(xs + j * 1024 + 16 * lane) = xa; *(LAS u32x4*)(xs + j * 1024 + 16 * lane + 8) = xc; } \
        f32x2 oa##j[8]; _Pragma("unroll") for (int k = 0; k < 8; ++k) oa##j[k] = (f32x2){0.f, 0.f};
        PSH_ROW(0) PSH_ROW(1) PSH_ROW(2) PSH_ROW(3)
#pragma unroll 1
        for (int s = 0; s < 16; ++s) {
            int n = 0;
#define PSH_SCAN(j) { unsigned long long b0 = __ballot((el##j >> 10) == s), b1 = __ballot((eh##j >> 10) == s); \
                while (b0) { const int h = __builtin_ctzll(b0); b0 &= b0 - 1; const int e = __builtin_amdgcn_readlane(el##j, h); const int g = __builtin_amdgcn_readlane(__builtin_bit_cast(int, gl##j), h); \
                    if (lane == 0) { lst[4 * n] = e; lst[4 * n + 1] = g; lst[4 * n + 2] = j; } ++n; } \
                while (b1) { const int h = __builtin_ctzll(b1); b1 &= b1 - 1; const int e = __builtin_amdgcn_readlane(eh##j, h); const int g = __builtin_amdgcn_readlane(__builtin_bit_cast(int, gh##j), h); \
                    if (lane == 0) { lst[4 * n] = e; lst[4 * n + 1] = g; lst[4 * n + 2] = j; } ++n; } }
            PSH_SCAN(0) PSH_SCAN(1) PSH_SCAN(2) PSH_SCAN(3)
            asm volatile("s_waitcnt lgkmcnt(0)" ::: "memory");
            if (n == 0) continue;
            const int ngrp = (n + 3) >> 2;
#define PSH_LD(b, gi_) do { const int gi = (gi_); _Pragma("unroll") for (int k = 0; k < 4; ++k) { int i = 4 * gi + k; i = i < n ? i : n - 1; const int e = __builtin_amdgcn_readfirstlane(lst[4 * i]); \
                b.u[k] = *(const u32x4*)(U + (size_t)e * D_MODEL + 16 * lane); b.v[k] = *(const u32x4*)(Vt + (size_t)e * D_MODEL + 16 * lane); } } while (0)
#define PSH_CP(b, gi_) do { const int gi = (gi_); float d[4]; int jj[4]; float gg[4]; \
                _Pragma("unroll") for (int k = 0; k < 4; ++k) { int i = 4 * gi + k; const bool val = i < n; i = val ? i : n - 1; jj[k] = __builtin_amdgcn_readfirstlane(lst[4 * i + 2]); gg[k] = val ? __builtin_bit_cast(float, __builtin_amdgcn_readfirstlane(lst[4 * i + 1])) : 0.f; \
                    const u32x4 xa = *(const LAS u32x4*)(xs + jj[k] * 1024 + 16 * lane), xc = *(const LAS u32x4*)(xs + jj[k] * 1024 + 16 * lane + 8); \
                    const f32x2 x2[8] = {(f32x2){bflo(xa.x), bfhi(xa.x)}, (f32x2){bflo(xa.y), bfhi(xa.y)}, (f32x2){bflo(xa.z), bfhi(xa.z)}, (f32x2){bflo(xa.w), bfhi(xa.w)}, (f32x2){bflo(xc.x), bfhi(xc.x)}, (f32x2){bflo(xc.y), bfhi(xc.y)}, (f32x2){bflo(xc.z), bfhi(xc.z)}, (f32x2){bflo(xc.w), bfhi(xc.w)}}; \
                    d[k] = dot16_fp8(b.u[k], x2); } \
                float e2[2], e1; \
                { const bool hi = lane & 1; _Pragma("unroll") for (int i = 0; i < 2; ++i) { const float keep = hi ? d[2 + i] : d[i], send = hi ? d[i] : d[2 + i]; e2[i] = keep + __shfl_xor(send, 1); } } \
                { const bool hi = lane & 2; const float keep = hi ? e2[1] : e2[0], send = hi ? e2[0] : e2[1]; e1 = keep + __shfl_xor(send, 2); } \
                e1 += __shfl_xor(e1, 4); e1 += __shfl_xor(e1, 8); e1 += __shfl_xor(e1, 16); e1 += __shfl_xor(e1, 32); \
                const int myk = 2 * (lane & 1) + ((lane >> 1) & 1); \
                float myg = gg[0]; myg = (myk == 1) ? gg[1] : myg; myg = (myk == 2) ? gg[2] : myg; myg = (myk == 3) ? gg[3] : myg; \
                const float act = myg * gelu_tanh(e1 * (1.0f / PEER_SU)) * (1.0f / PEER_SV); \
                _Pragma("unroll") for (int k = 0; k < 4; ++k) { const float a = rdlane(act, (k >> 1) | ((k & 1) << 1)); \
                    if (jj[k] == 0) axpy16_fp8(b.v[k], a, oa0); else if (jj[k] == 1) axpy16_fp8(b.v[k], a, oa1); else if (jj[k] == 2) axpy16_fp8(b.v[k], a, oa2); else axpy16_fp8(b.v[k], a, oa3); } } while (0)
            { PG4 A, B; PSH_LD(A, 0);
#pragma unroll 1
              for (int g2 = 0; g2 < ngrp; g2 += 2) { PSH_LD(B, (g2 + 1 < ngrp) ? g2 + 1 : g2); PSH_CP(A, g2); PSH_LD(A, (g2 + 2 < ngrp) ? g2 + 2 : g2); if (g2 + 1 < ngrp) PSH_CP(B, g2 + 1); } }
            asm volatile("s_waitcnt lgkmcnt(0)" ::: "memory");
        }
#define PSH_LN(j) { const int r = row##j; f32x2 x2[8]; \
            _Pragma("unroll") for (int q = 0; q < 4; ++q) { const f32x4 a = *(const f32x4*)(xin + (size_t)r * D_MODEL + 16 * lane + 4 * q); x2[2 * q] = (f32x2){a.x, a.y}; x2[2 * q + 1] = (f32x2){a.z, a.w}; } \
            float sm = 0.f; _Pragma("unroll") for (int k = 0; k < 8; ++k) { oa##j[k] += x2[k] * ALPHA; sm += oa##j[k].x + oa##j[k].y; } \
            const float mu = wave_sum(sm) * (1.0f / D_MODEL); float s2 = 0.f; _Pragma("unroll") for (int k = 0; k < 8; ++k) { oa##j[k] -= mu; s2 += oa##j[k].x * oa##j[k].x + oa##j[k].y * oa##j[k].y; } \
            const float rs = 1.0f / sqrtf(wave_sum(s2) * (1.0f / D_MODEL) + LN_EPS); float* frow = fout + (size_t)r * D_MODEL; \
            _Pragma("unroll") for (int q = 0; q < 4; ++q) { const int c0 = 16 * lane + 4 * q; const f32x4 gv = *(const f32x4*)(gam + c0), bv = *(const f32x4*)(bet + c0); \
                const f32x4 y = (f32x4){oa##j[2 * q].x * rs, oa##j[2 * q].y * rs, oa##j[2 * q + 1].x * rs, oa##j[2 * q + 1].y * rs} * gv + bv; *(f32x4*)(frow + c0) = y; if (xb) *(u32x2*)(xb + (size_t)r * D_MODEL + c0) = pk4(y); } }
        PSH_LN(0) PSH_LN(1) PSH_LN(2) PSH_LN(3)
        asm volatile("s_waitcnt lgkmcnt(0)" ::: "memory");
    }
}
constexpr int PSH_LOG = 11, PSH_N = PEER_EXPERTS >> PSH_LOG;
#ifndef PS2_ROWS
#define PS2_ROWS 4
#endif
#define PS2_ROW(j) const int row##j = (qd * PS2_ROWS + j) * NW + gw; const int el##j = P.SELE[(size_t)row##j * 128 + lane], eh##j = P.SELE[(size_t)row##j * 128 + 64 + lane]; const float gl##j = P.SELG[(size_t)row##j * 128 + lane], gh##j = P.SELG[(size_t)row##j * 128 + 64 + lane]; \
    f32x2 oa##j[8]; _Pragma("unroll") for (int k = 0; k < 8; ++k) oa##j[k] = (f32x2){0.f, 0.f};
#define PS2_STEP(j) { unsigned long long b0 = __ballot((el##j >> PSH_LOG) == s), b1 = __ballot((eh##j >> PSH_LOG) == s); \
    if (b0 | b1) { const u32x4 xa##j = *(const u32x4*)(xb16 + (size_t)row##j * D_MODEL + 16 * lane), xc##j = *(const u32x4*)(xb16 + (size_t)row##j * D_MODEL + 16 * lane + 8);     \
      const f32x2 x2[8] = {(f32x2){bflo(xa##j.x), bfhi(xa##j.x)}, (f32x2){bflo(xa##j.y), bfhi(xa##j.y)}, (f32x2){bflo(xa##j.z), bfhi(xa##j.z)}, (f32x2){bflo(xa##j.w), bfhi(xa##j.w)}, (f32x2){bflo(xc##j.x), bfhi(xc##j.x)}, (f32x2){bflo(xc##j.y), bfhi(xc##j.y)}, (f32x2){bflo(xc##j.z), bfhi(xc##j.z)}, (f32x2){bflo(xc##j.w), bfhi(xc##j.w)}}; \
      _Pragma("unroll 1") while ((b0 | b1) != 0ull) { int hk[8]; u32x4 uw[8], vw[8]; int nv = 0; \
        _Pragma("unroll") for (int k = 0; k < 8; ++k) { int h; if (b0) { h = __builtin_ctzll(b0); b0 &= b0 - 1; ++nv; } else if (b1) { h = 64 + __builtin_ctzll(b1); b1 &= b1 - 1; ++nv; } else h = hk[k > 0 ? k - 1 : 0]; \
            hk[k] = h; const int e = (h < 64) ? __builtin_amdgcn_readlane(el##j, h & 63) : __builtin_amdgcn_readlane(eh##j, h & 63); \
            uw[k] = *(const u32x4*)(U + (size_t)e * D_MODEL + 16 * lane); vw[k] = *(const u32x4*)(Vt + (size_t)e * D_MODEL + 16 * lane); } \
        float d[8]; _Pragma("unroll") for (int k = 0; k < 8; ++k) d[k] = dot16_fp8(uw[k], x2); \
        float e4[4], e2[2], e1s; \
        { const bool hi = lane & 1; _Pragma("unroll") for (int i = 0; i < 4; ++i) { const float keep = hi ? d[4 + i] : d[i], send = hi ? d[i] : d[4 + i]; e4[i] = keep + __shfl_xor(send, 1); } } \
        { const bool hi = lane & 2; _Pragma("unroll") for (int i = 0; i < 2; ++i) { const float keep = hi ? e4[2 + i] : e4[i], send = hi ? e4[i] : e4[2 + i]; e2[i] = keep + __shfl_xor(send, 2); } } \
        { const bool hi = lane & 4; const float keep = hi ? e2[1] : e2[0], send = hi ? e2[0] : e2[1]; e1s = keep + __shfl_xor(send, 4); } \
        e1s += __shfl_xor(e1s, 8); e1s += __shfl_xor(e1s, 16); e1s += __shfl_xor(e1s, 32); \
        const int myk = 4 * (lane & 1) + (lane & 2) + ((lane >> 2) & 1); int myh = hk[0]; _Pragma("unroll") for (int k = 1; k < 8; ++k) myh = (myk == k) ? hk[k] : myh; \
        const float ga = __shfl(gl##j, myh & 63), gb = __shfl(gh##j, myh & 63); const float myg = (myk < nv) ? ((myh < 64) ? ga : gb) : 0.f;     \
        const float act = myg * gelu_tanh(e1s * (1.0f / PEER_SU)) * (1.0f / PEER_SV); \
        _Pragma("unroll") for (int k = 0; k < 8; ++k) { const int src = (k >> 2) | (((k >> 1) & 1) << 1) | ((k & 1) << 2); axpy16_fp8(vw[k], rdlane(act, src), oa##j); } } } }
#define PS2_LN(j) { const int r = row##j; f32x2 x2[8]; int ll = lane; asm volatile("" : "+v"(ll));     \
    _Pragma("unroll") for (int q = 0; q < 4; ++q) { const f32x4 a = *(const f32x4*)(xin + (size_t)r * D_MODEL + 16 * ll + 4 * q); x2[2 * q] = (f32x2){a.x, a.y}; x2[2 * q + 1] = (f32x2){a.z, a.w}; } \
    float sm = 0.f; _Pragma("unroll") for (int k = 0; k < 8; ++k) { oa##j[k] += x2[k] * ALPHA; sm += oa##j[k].x + oa##j[k].y; } \
    const float mu = wave_sum(sm) * (1.0f / D_MODEL); float s2 = 0.f; _Pragma("unroll") for (int k = 0; k < 8; ++k) { oa##j[k] -= mu; s2 += oa##j[k].x * oa##j[k].x + oa##j[k].y * oa##j[k].y; } \
    const float rs = 1.0f / sqrtf(wave_sum(s2) * (1.0f / D_MODEL) + LN_EPS); float* frow = fout + (size_t)r * D_MODEL; \
    _Pragma("unroll") for (int q = 0; q < 4; ++q) { const int c0 = 16 * ll + 4 * q; const f32x4 gv = *(const f32x4*)(gam + c0), bv = *(const f32x4*)(bet + c0); \
        const f32x4 y = (f32x4){oa##j[2 * q].x * rs, oa##j[2 * q].y * rs, oa##j[2 * q + 1].x * rs, oa##j[2 * q + 1].y * rs} * gv + bv; *(f32x4*)(frow + c0) = y; if (xb) *(u32x2*)(xb + (size_t)r * D_MODEL + c0) = pk4(y); } }
DI void peer_sharded2_phase(const FP& P, const Ctx& C, int layer, const float* xin, const bf16* xb16, float* fout, bf16* xb) {
    const int lane = C.lane; const unsigned char* U = P.UB8 + (size_t)layer * PEER_EXPERTS * D_MODEL; const unsigned char* Vt = P.VB8 + (size_t)layer * PEER_EXPERTS * D_MODEL;
    const float* gam = P.ln_g + ((size_t)layer * 2 + 1) * D_MODEL; const float* bet = P.ln_b + ((size_t)layer * 2 + 1) * D_MODEL;
    const int NW = C.G * NWAVES, gw = C.vcu * NWAVES + C.wave; const int nquads = (M0 / NW) / PS2_ROWS;
#pragma unroll 1
    for (int qd = 0; qd < nquads; ++qd) {
#if PS2_ROWS == 4
        PS2_ROW(0) PS2_ROW(1) PS2_ROW(2) PS2_ROW(3)
#pragma unroll 1
        for (int s = 0; s < PSH_N; ++s) { PS2_STEP(0) PS2_STEP(1) PS2_STEP(2) PS2_STEP(3) }
        PS2_LN(0) PS2_LN(1) PS2_LN(2) PS2_LN(3)
#else
        PS2_ROW(0) PS2_ROW(1)
#pragma unroll 1
        for (int s = 0; s < PSH_N; ++s) { PS2_STEP(0) PS2_STEP(1) }
        PS2_LN(0) PS2_LN(1)
#endif
    }
}
#define PS3_ROW(j) const int row##j = (qd * 4 + j) * NW + gw; const int el##j = P.SELE[(size_t)row##j * 128 + lane], eh##j = P.SELE[(size_t)row##j * 128 + 64 + lane]; \
    { const u32x4 xa = *(const u32x4*)(xb16 + (size_t)row##j * D_MODEL + 16 * lane), xc = *(const u32x4*)(xb16 + (size_t)row##j * D_MODEL + 16 * lane + 8); *(LAS u32x4*)(xs + j * 1024 + 16 * lane) = xa; *(LAS u32x4*)(xs + j * 1024 + 16 * lane + 8) = xc; } \
    f32x2 oa##j[8]; _Pragma("unroll") for (int k = 0; k < 8; ++k) oa##j[k] = (f32x2){0.f, 0.f};
#define PS3_X2_UNUSED(j) const f32x2 x2[8] = {(f32x2){bflo(xa##j.x), bfhi(xa##j.x)}, (f32x2){bflo(xa##j.y), bfhi(xa##j.y)}, (f32x2){bflo(xa##j.z), bfhi(xa##j.z)}, (f32x2){bflo(xa##j.w), bfhi(xa##j.w)}, (f32x2){bflo(xc##j.x), bfhi(xc##j.x)}, (f32x2){bflo(xc##j.y), bfhi(xc##j.y)}, (f32x2){bflo(xc##j.z), bfhi(xc##j.z)}, (f32x2){bflo(xc##j.w), bfhi(xc##j.w)}};
#define PS3_TAKE(q, M, ELH, GOFF) if (!got && M) { const int h = __builtin_ctzll(M); M &= M - 1; qq[k] = q; ee = __builtin_amdgcn_readlane(ELH, h); gk[k] = P.SELG[GOFF + h];     got = true; ++nv; }
DI void peer_sharded3_phase(const FP& P, const Ctx& C, int layer, const float* xin, const bf16* xb16, float* fout, bf16* xb) {
    const int lane = C.lane; const unsigned char* U = P.UB8 + (size_t)layer * PEER_EXPERTS * D_MODEL; const unsigned char* Vt = P.VB8 + (size_t)layer * PEER_EXPERTS * D_MODEL;
    const float* gam = P.ln_g + ((size_t)layer * 2 + 1) * D_MODEL; const float* bet = P.ln_b + ((size_t)layer * 2 + 1) * D_MODEL;
    const int NW = C.G * NWAVES, gw = C.vcu * NWAVES + C.wave; const int nquads = (M0 / NW) / 4; LAS bf16* xs = (LAS bf16*)(C.lds + C.wave * 16384);
#pragma unroll 1
    for (int qd = 0; qd < nquads; ++qd) {
        PS3_ROW(0) PS3_ROW(1) PS3_ROW(2) PS3_ROW(3)
        asm volatile("s_waitcnt lgkmcnt(0)" ::: "memory");
#pragma unroll 1
        for (int s = 0; s < PSH_N; ++s) {
            unsigned long long m0 = __ballot((el0 >> PSH_LOG) == s), m1 = __ballot((eh0 >> PSH_LOG) == s), m2 = __ballot((el1 >> PSH_LOG) == s), m3 = __ballot((eh1 >> PSH_LOG) == s),
                               m4 = __ballot((el2 >> PSH_LOG) == s), m5 = __ballot((eh2 >> PSH_LOG) == s), m6 = __ballot((el3 >> PSH_LOG) == s), m7 = __ballot((eh3 >> PSH_LOG) == s);
#pragma unroll 1
            while ((m0 | m1 | m2 | m3 | m4 | m5 | m6 | m7) != 0ull) {
                int qq[8]; float gk[8]; int es[8]; u32x4 uw[8]; int nv = 0; int elast = 0;
#pragma unroll
                for (int k = 0; k < 8; ++k) { bool got = false; int ee = elast; qq[k] = k > 0 ? qq[k - 1] : 0; gk[k] = 0.f;
                    PS3_TAKE(0, m0, el0, (size_t)row0 * 128) PS3_TAKE(1, m1, eh0, (size_t)row0 * 128 + 64) PS3_TAKE(2, m2, el1, (size_t)row1 * 128) PS3_TAKE(3, m3, eh1, (size_t)row1 * 128 + 64) PS3_TAKE(4, m4, el2, (size_t)row2 * 128) PS3_TAKE(5, m5, eh2, (size_t)row2 * 128 + 64) PS3_TAKE(6, m6, el3, (size_t)row3 * 128) PS3_TAKE(7, m7, eh3, (size_t)row3 * 128 + 64)
                    elast = ee; es[k] = ee; uw[k] = *(const u32x4*)(U + (size_t)ee * D_MODEL + 16 * lane); }
                float d[8];
#pragma unroll
                for (int k = 0; k < 8; ++k) { const int j = qq[k] >> 1; const u32x4 xa = *(const LAS u32x4*)(xs + j * 1024 + 16 * lane), xc = *(const LAS u32x4*)(xs + j * 1024 + 16 * lane + 8);
                    const f32x2 x2[8] = {(f32x2){bflo(xa.x), bfhi(xa.x)}, (f32x2){bflo(xa.y), bfhi(xa.y)}, (f32x2){bflo(xa.z), bfhi(xa.z)}, (f32x2){bflo(xa.w), bfhi(xa.w)}, (f32x2){bflo(xc.x), bfhi(xc.x)}, (f32x2){bflo(xc.y), bfhi(xc.y)}, (f32x2){bflo(xc.z), bfhi(xc.z)}, (f32x2){bflo(xc.w), bfhi(xc.w)}};
                    d[k] = dot16_fp8(uw[k], x2); }
                u32x4 vw[8];
#pragma unroll
                for (int k = 0; k < 8; ++k) vw[k] = *(const u32x4*)(Vt + (size_t)es[k] * D_MODEL + 16 * lane);
                float e4[4], e2[2], e1s;
                { const bool hi = lane & 1;
#pragma unroll
                  for (int i = 0; i < 4; ++i) { const float keep = hi ? d[4 + i] : d[i], send = hi ? d[i] : d[4 + i]; e4[i] = keep + __shfl_xor(send, 1); } }
                { const bool hi = lane & 2;
#pragma unroll
                  for (int i = 0; i < 2; ++i) { const float keep = hi ? e4[2 + i] : e4[i], send = hi ? e4[i] : e4[2 + i]; e2[i] = keep + __shfl_xor(send, 2); } }
                { const bool hi = lane & 4; const float keep = hi ? e2[1] : e2[0], send = hi ? e2[0] : e2[1]; e1s = keep + __shfl_xor(send, 4); }
                e1s += __shfl_xor(e1s, 8); e1s += __shfl_xor(e1s, 16); e1s += __shfl_xor(e1s, 32);
                const int myk = 4 * (lane & 1) + (lane & 2) + ((lane >> 2) & 1); float myg = gk[0];
#pragma unroll
                for (int k = 1; k < 8; ++k) myg = (myk == k) ? gk[k] : myg;
                const float act = myg * gelu_tanh(e1s * (1.0f / PEER_SU)) * (1.0f / PEER_SV);
#pragma unroll
                for (int k = 0; k < 8; ++k) { const int src = (k >> 2) | (((k >> 1) & 1) << 1) | ((k & 1) << 2); const float a = rdlane(act, src); const int j = qq[k] >> 1;
                    if (j == 0) { asm volatile("" ::: "memory"); axpy16_fp8(vw[k], a, oa0); } else if (j == 1) { asm volatile("" ::: "memory"); axpy16_fp8(vw[k], a, oa1); } else if (j == 2) { asm volatile("" ::: "memory"); axpy16_fp8(vw[k], a, oa2); } else { asm volatile("" ::: "memory"); axpy16_fp8(vw[k], a, oa3); } }
            }
        }
        PS2_LN(0) PS2_LN(1) PS2_LN(2) PS2_LN(3)
    }
}
}
namespace fx {
struct EpiB {
    static constexpr bool PERM = true, AFTER_DRAIN = false; const FP& P;
    DI void operator()(const f32x4 (&acc)[2][2][4][2], const pg8::Unit& u, int wr, int wc, int fr, int fq) const {
        const int t = u.pn;
        EPI_LOOP({ if (row < MP) { const int pos = row_pos(row), n = row / SEQ, e = ct & 63, dp = e >> 1; const bool prm = row < M0;
            if (t < 3) { const int ty = 2 * t + (ct >> 7), kvh = (ct >> 6) & 1;
                if (ty == 2 || ty == 4) { f32x4 lo, hi; rope4(P.ROPE + pos * 64, dp, v0, v1, lo, hi);
                    if (ty == 2) { float* o = (prm ? P.nsa_kv_p + (size_t)row * 512 : P.nsa_kv_s + (size_t)(row - M0) * 512) + 256 + kvh * 64 + dp; *(f32x4*)o = lo; *(f32x4*)(o + 32) = hi;
                        if (prm) { bf16* kt = P.SLK + ((size_t)n * NSA_KV_HEADS + kvh) * SEQ * 64; *(u32x2*)(kt + ktile_off(pos, dp)) = pk4(lo); *(u32x2*)(kt + ktile_off(pos, dp + 32)) = pk4(hi); } }
                    else { float* o = nullptr; if (!prm) o = P.win_s + (((size_t)(row - M0) * SWA_WINDOW + SWA_WINDOW - 1) * 2 + 0) * 128; else if (pos >= SEQ - SWA_WINDOW) o = P.win_p + (((size_t)n * SWA_WINDOW + pos - (SEQ - SWA_WINDOW)) * 2 + 0) * 128;
                        if (o) { *(f32x4*)(o + kvh * 64 + dp) = lo; *(f32x4*)(o + kvh * 64 + 32 + dp) = hi; }
                        if (prm) { bf16* kt = P.WNK + ((size_t)n * NSA_KV_HEADS + kvh) * SEQ * 64; *(u32x2*)(kt + ktile_off(pos, dp)) = pk4(lo); *(u32x2*)(kt + ktile_off(pos, dp + 32)) = pk4(hi); } } }
                else if (ty < 4) { float* o = (prm ? P.nsa_kv_p + (size_t)row * 512 : P.nsa_kv_s + (size_t)(row - M0) * 512) + ty * 128 + kvh * 64 + e; *(f32x4*)o = v0; *(f32x4*)(o + 4) = v1;
                    if (prm) { if (ty < 2) *(u32x4*)(P.AC + ((size_t)ty * ACROWS + ((size_t)n * NSA_KV_HEADS + kvh) * NCH + pos / 16) * 1024 + (pos % 16) * 64 + e) = pk8(v0, v1);
                        else { bf16* vt = P.SLVT + ((size_t)n * NSA_KV_HEADS + kvh) * SEQ * 64 + vtile_off(e, pos);
                            vt[0] = (bf16)f2bf(v0.x); vt[8] = (bf16)f2bf(v0.y); vt[16] = (bf16)f2bf(v0.z); vt[24] = (bf16)f2bf(v0.w); vt[32] = (bf16)f2bf(v1.x); vt[40] = (bf16)f2bf(v1.y); vt[48] = (bf16)f2bf(v1.z); vt[56] = (bf16)f2bf(v1.w); } } }
                else { float* o = nullptr; if (!prm) o = P.win_s + (((size_t)(row - M0) * SWA_WINDOW + SWA_WINDOW - 1) * 2 + 1) * 128; else if (pos >= SEQ - SWA_WINDOW) o = P.win_p + (((size_t)n * SWA_WINDOW + pos - (SEQ - SWA_WINDOW)) * 2 + 1) * 128;
                    if (o) { *(f32x4*)(o + kvh * 64 + e) = v0; *(f32x4*)(o + kvh * 64 + e + 4) = v1; }
                    if (prm) { bf16* vt = P.WNVT + ((size_t)n * NSA_KV_HEADS + kvh) * SEQ * 64 + vtile_off(e, pos);
                        vt[0] = (bf16)f2bf(v0.x); vt[8] = (bf16)f2bf(v0.y); vt[16] = (bf16)f2bf(v0.z); vt[24] = (bf16)f2bf(v0.w); vt[32] = (bf16)f2bf(v1.x); vt[40] = (bf16)f2bf(v1.y); vt[48] = (bf16)f2bf(v1.z); vt[56] = (bf16)f2bf(v1.w); } } }
            else if (t < 6) { const int h = (t - 3) * 4 + (ct >> 6); f32x4 lo, hi; rope4(P.ROPE + pos * 64, dp, v0, v1, lo, hi); bf16* q = P.QB + (size_t)row * NSA_Q_COLS + h * 64 + dp; *(u32x2*)q = pk4(lo * QSCALE); *(u32x2*)(q + 32) = pk4(hi * QSCALE); }
            else if (t == 6) { *(u32x4*)(P.MQB + (size_t)row * 256 + ct) = pk8(v0 * QSCALE, v1 * QSCALE); }
            else if (ct < 40) { const float vv[8] = {v0.x, v0.y, v0.z, v0.w, v1.x, v1.y, v1.z, v1.w};
                _Pragma("unroll") for (int i = 0; i < 8; ++i) if (ct + i < NSA_GATE_COLS) P.GATES[(size_t)row * 64 + ct + i] = 1.0f / (1.0f + __expf(-vv[i])); } } })
    }
};
DI void cmp2_phase(const FP& P, const Ctx& C) {
    const int lane = C.lane; LAS float* hs = (LAS float*)(C.lds + C.wave * 1024);
    constexpr int NGRP = NCTX * 2 * NSA_KV_HEADS; const int NW = C.G * NWAVES, WPG = NW / NGRP > 0 ? NW / NGRP : 1; const int gw = C.vcu * NWAVES + C.wave;
#pragma unroll 1
    for (int grp = gw / WPG; grp < NGRP; grp += (NW + WPG - 1) / WPG) { const int slot = gw % WPG; if (gw >= (NW / WPG) * WPG && grp == gw / WPG) break;
        const int kvh = grp % NSA_KV_HEADS, ty = (grp / NSA_KV_HEADS) % 2, ctx = grp / (2 * NSA_KV_HEADS);
        const float* UL = P.UL + ((size_t)ty * ACROWS + ((size_t)ctx * NSA_KV_HEADS + kvh) * NCH) * 256; const float* w2 = P.cmp_w2 + (size_t)ty * CMP_HIDDEN * HEAD_DIM;
        float w2r[CMP_HIDDEN];
#pragma unroll
        for (int k = 0; k < CMP_HIDDEN; ++k) w2r[k] = w2[k * HEAD_DIM + lane];
        const float b0 = P.CBIAS[ty * CMP_HIDDEN + lane], b1 = P.CBIAS[ty * CMP_HIDDEN + 64 + lane];
        float u0, u1, l0, l1; int c = slot;
        if (c < NCMP) { u0 = UL[(size_t)c * 256 + lane]; u1 = UL[(size_t)c * 256 + 64 + lane]; l0 = UL[(size_t)(c + 1) * 256 + 128 + lane]; l1 = UL[(size_t)(c + 1) * 256 + 192 + lane]; }
#pragma unroll 1
        for (; c < NCMP; c += WPG) { const float h0 = gelu_tanh(u0 + l0 + b0), h1 = gelu_tanh(u1 + l1 + b1); const int cn = c + WPG;
            if (cn < NCMP) { u0 = UL[(size_t)cn * 256 + lane]; u1 = UL[(size_t)cn * 256 + 64 + lane]; l0 = UL[(size_t)(cn + 1) * 256 + 128 + lane]; l1 = UL[(size_t)(cn + 1) * 256 + 192 + lane]; }
            hs[lane] = h0; hs[64 + lane] = h1; asm volatile("s_waitcnt lgkmcnt(0)" ::: "memory");
            float a = 0.f;
#pragma unroll
            for (int k4 = 0; k4 < CMP_HIDDEN / 4; ++k4) { const f32x4 hv = *(const LAS f32x4*)(hs + 4 * k4); a += hv.x * w2r[4 * k4] + hv.y * w2r[4 * k4 + 1] + hv.z * w2r[4 * k4 + 2] + hv.w * w2r[4 * k4 + 3]; }
            if (ty == 0) { const float other = __shfl_xor(a, 32); const int pos = c * CMP_STRIDE + CMP_BLOCK - 1; const float cs = P.ROPE[pos * 64 + (lane & 31)], sn = P.ROPE[pos * 64 + 32 + (lane & 31)];
                a = (lane < 32) ? a * cs - other * sn : a * cs + other * sn; }
            if (ctx < BATCH) { if (ty == 0) P.CK[((size_t)ctx * NSA_KV_HEADS + kvh) * NCH * 64 + ktile_off(c, lane)] = (bf16)f2bf(a); else P.CVT[((size_t)ctx * NSA_KV_HEADS + kvh) * NCH * 64 + vtile_off(lane, c)] = (bf16)f2bf(a); }
            else { (ty == 0 ? P.CKF : P.CVF)[(((size_t)(ctx - BATCH) * NSA_KV_HEADS + kvh) * NCH + c) * 64 + lane] = a; }
            asm volatile("s_waitcnt lgkmcnt(0)" ::: "memory"); }
    }
    __syncthreads();
}
constexpr int NSA_WLDS = 8192;
DI void nsa_pair_a(const FP& P, int n, int kvh, int t, int lane, LAS unsigned char* wl) {
    LAS float* pn = (LAS float*)wl; LAS float* imp = (LAS float*)(wl + 2048); LAS float* sc = (LAS float*)(wl + 6144); LAS int* sel = (LAS int*)(wl + 7168);
    const int col = lane & 15, c = lane >> 4; const bool vcol = col < 12; const int qq = vcol ? col / 6 : 0, hh = vcol ? col % 6 : 0, tq = t + qq, head = kvh * NSA_GROUP + hh, row = n * SEQ + tq;
    bf16x8 qf[2]; { const bf16* qp = P.QB + (size_t)row * NSA_Q_COLS + head * 64 + 8 * c; qf[0] = *(const bf16x8*)qp; qf[1] = *(const bf16x8*)(qp + 32); }
    const float* gt = P.GATES + (size_t)row * 64 + head * 3;
    f32x4 oacc[4] = {(f32x4){0.f, 0.f, 0.f, 0.f}, (f32x4){0.f, 0.f, 0.f, 0.f}, (f32x4){0.f, 0.f, 0.f, 0.f}, (f32x4){0.f, 0.f, 0.f, 0.f}};
    const int lim = vcol ? ((tq >= CMP_BLOCK - 1) ? (tq - (CMP_BLOCK - 1)) / CMP_STRIDE : -1) : -1;
    const int limmax = (t + 1 >= CMP_BLOCK - 1) ? (t + 1 - (CMP_BLOCK - 1)) / CMP_STRIDE : -1; const int nblk = (limmax + 32) / 32;
    const bf16* CKb = P.CK + ((size_t)n * NSA_KV_HEADS + kvh) * NCH * 64; const bf16* CVb = P.CVT + ((size_t)n * NSA_KV_HEADS + kvh) * 64 * NCH;
    for (int i = lane; i < 1024; i += 64) imp[i] = 0.f;
    float m1 = -INFINITY, l1 = 0.f;
    { struct K4 { bf16x8 a0, a1, b0, b1; };
      auto ldk = [&](K4& k, int blk) { const bf16* kt = CKb + (size_t)blk * 2048 + lane * 8; k.a0 = *(const bf16x8*)kt; k.a1 = *(const bf16x8*)(kt + 512); k.b0 = *(const bf16x8*)(kt + 1024); k.b1 = *(const bf16x8*)(kt + 1536); };
      auto cp1 = [&](const K4& k, int blk) { const int kb = 32 * blk;
        f32x4 s0 = (f32x4){0.f, 0.f, 0.f, 0.f}, s1 = (f32x4){0.f, 0.f, 0.f, 0.f};
        s0 = __builtin_amdgcn_mfma_f32_16x16x32_bf16(k.a0, qf[0], s0, 0, 0, 0); s0 = __builtin_amdgcn_mfma_f32_16x16x32_bf16(k.a1, qf[1], s0, 0, 0, 0);
        s1 = __builtin_amdgcn_mfma_f32_16x16x32_bf16(k.b0, qf[0], s1, 0, 0, 0); s1 = __builtin_amdgcn_mfma_f32_16x16x32_bf16(k.b1, qf[1], s1, 0, 0, 0);
        float s[8] = {s0.x, s0.y, s0.z, s0.w, s1.x, s1.y, s1.z, s1.w}; float mx = -INFINITY;
#pragma unroll
        for (int e = 0; e < 8; ++e) { s[e] = (kb + 8 * c + e <= lim) ? s[e] : -INFINITY; mx = fmaxf(mx, s[e]); }
        mx = fmaxf(mx, __shfl_xor(mx, 16)); mx = fmaxf(mx, __shfl_xor(mx, 32));
        const float mnew = fmaxf(m1, mx), muse = (mnew == -INFINITY) ? 0.f : mnew; float ls = 0.f;
#pragma unroll
        for (int e = 0; e < 8; ++e) ls += __builtin_amdgcn_exp2f(s[e] - muse);
        ls += __shfl_xor(ls, 16); ls += __shfl_xor(ls, 32);
        l1 = l1 * __builtin_amdgcn_exp2f(m1 - muse) + ls; m1 = mnew; };
      if (nblk > 0) { K4 A, B; ldk(A, 0);
#pragma unroll 1
        for (int blk = 0; blk < nblk; blk += 2) { ldk(B, (blk + 1 < nblk) ? blk + 1 : blk); cp1(A, blk); ldk(A, (blk + 2 < nblk) ? blk + 2 : blk); if (blk + 1 < nblk) cp1(B, blk + 1); } } }
    asm volatile("s_waitcnt lgkmcnt(0)" ::: "memory");
    { const float muse = (m1 == -INFINITY) ? 0.f : m1, inv = (l1 > 0.f) ? 1.0f / l1 : 0.f;
      f32x4 oc[4] = {(f32x4){0.f, 0.f, 0.f, 0.f}, (f32x4){0.f, 0.f, 0.f, 0.f}, (f32x4){0.f, 0.f, 0.f, 0.f}, (f32x4){0.f, 0.f, 0.f, 0.f}};
      pipe2(nblk, [&](KV8& kv, int blk) { kv_load_t(kv, CKb + (size_t)blk * 2048, CVb + (size_t)blk * 2048, lane); }, [&](const KV8& kv, int blk) { const int kb = 32 * blk;
        f32x4 s0 = (f32x4){0.f, 0.f, 0.f, 0.f}, s1 = (f32x4){0.f, 0.f, 0.f, 0.f};
        s0 = __builtin_amdgcn_mfma_f32_16x16x32_bf16(kv.ka0, qf[0], s0, 0, 0, 0); s0 = __builtin_amdgcn_mfma_f32_16x16x32_bf16(kv.ka1, qf[1], s0, 0, 0, 0);
        s1 = __builtin_amdgcn_mfma_f32_16x16x32_bf16(kv.kb0, qf[0], s1, 0, 0, 0); s1 = __builtin_amdgcn_mfma_f32_16x16x32_bf16(kv.kb1, qf[1], s1, 0, 0, 0);
        float s[8] = {s0.x, s0.y, s0.z, s0.w, s1.x, s1.y, s1.z, s1.w};
#pragma unroll
        for (int e = 0; e < 8; ++e) s[e] = (kb + 8 * c + e <= lim) ? __builtin_amdgcn_exp2f(s[e] - muse) * inv : 0.f;
        *(f32x4*)(pn + col * 32 + 8 * c) = (f32x4){s[0], s[1], s[2], s[3]}; *(f32x4*)(pn + col * 32 + 8 * c + 4) = (f32x4){s[4], s[5], s[6], s[7]};
        u32x4 pw; pw.x = cvtpk(s[0], s[1]); pw.y = cvtpk(s[2], s[3]); pw.z = cvtpk(s[4], s[5]); pw.w = cvtpk(s[6], s[7]); const bf16x8 pf = __builtin_bit_cast(bf16x8, pw);
        oc[0] = __builtin_amdgcn_mfma_f32_16x16x32_bf16(kv.v0, pf, oc[0], 0, 0, 0); oc[1] = __builtin_amdgcn_mfma_f32_16x16x32_bf16(kv.v1, pf, oc[1], 0, 0, 0);
        oc[2] = __builtin_amdgcn_mfma_f32_16x16x32_bf16(kv.v2, pf, oc[2], 0, 0, 0); oc[3] = __builtin_amdgcn_mfma_f32_16x16x32_bf16(kv.v3, pf, oc[3], 0, 0, 0);
        asm volatile("s_waitcnt lgkmcnt(0)" ::: "memory");
        { const int q2 = lane >> 5, k = lane & 31; float a = 0.f;
#pragma unroll
          for (int h6 = 0; h6 < 6; ++h6) a += pn[(q2 * 6 + h6) * 32 + k];
          imp[q2 * 512 + kb + k] = a; }
        asm volatile("s_waitcnt lgkmcnt(0)" ::: "memory"); });
#ifdef NSA_DEBUG
      if (vcol) { for (int db = 0; db < 4; ++db) *(f32x4*)(P.DBG + ((size_t)0 * MP + row) * 768 + head * 64 + 16 * db + 4 * c) = oc[db]; }
#endif
      const float g0 = vcol ? gt[0] : 0.f;
#pragma unroll
      for (int db = 0; db < 4; ++db) oacc[db] += oc[db] * g0; }
#ifndef REP_SEL
#define REP_SEL 1
#endif
#pragma unroll 1
    for (int rep = 0; rep < REP_SEL; ++rep) {
    for (int i = lane; i < 256; i += 64) { const int q2 = i >> 7, b = i & 127, tq2 = t + q2, cur = tq2 / SLC_BLOCK; float sv;
        if (b > cur) sv = NEG; else if (b == 0 || b == cur || b == cur - 1) sv = FORCE_SCORE;
        else { const LAS float* ic = imp + q2 * 512 + 4 * b; sv = ic[-1] + 2.f * (ic[0] + ic[1] + ic[2]) + ic[3]; }
        sc[i] = pack_key(sv, 127u - (unsigned)b, 127u); }
    asm volatile("s_waitcnt lgkmcnt(0)" ::: "memory");
    for (int i = lane; i < 256; i += 64) { const int q2 = i >> 7, b = i & 127; const float sv = sc[i]; int rank = 0;
        for (int j = 0; j < 128; j += 4) { const f32x4 o = *(const LAS f32x4*)(sc + q2 * 128 + j);
            rank += (o.x > sv) ? 1 : 0; rank += (o.y > sv) ? 1 : 0; rank += (o.z > sv) ? 1 : 0; rank += (o.w > sv) ? 1 : 0; }
        if (rank < SLC_TOPK) { const int v = (sv > 0.5f * NEG) ? b : -1; sel[q2 * 16 + rank] = v; P.SELB[((size_t)(n * SEQ + t + q2) * NSA_KV_HEADS + kvh) * 16 + rank] = v; } }
    asm volatile("s_waitcnt lgkmcnt(0)" ::: "memory");
    }
#ifndef REP_WIN
#define REP_WIN 1
#endif
#pragma unroll 1
    for (int rep = 0; rep < REP_WIN; ++rep) { Tile16 T; tile_init(T);
      const bf16* WKb = P.WNK + ((size_t)n * NSA_KV_HEADS + kvh) * SEQ * 64; const bf16* WVb = P.WNVT + ((size_t)n * NSA_KV_HEADS + kvh) * 64 * SEQ;
      const int blo = (t - SWA_WINDOW) >> 5, bhi = (t + 1) >> 5;
      auto ld = [&](KV8& kv, int blk) { const int bc = blk < 0 ? 0 : blk; kv_load_t(kv, WKb + (size_t)bc * 2048, WVb + (size_t)bc * 2048, lane); };
      pipe2(bhi - blo + 1, [&](KV8& kv, int i) { ld(kv, blo + i); }, [&](const KV8& kv, int i) { const int kb = 32 * (blo + i);
          tile_compute(T, qf, kv, [&](int e) { const int kp = kb + 8 * c + e; return vcol && kp >= 0 && kp <= tq && tq - kp <= SWA_WINDOW; }); });
      const float inv = (T.l > 0.f) ? 1.0f / T.l : 0.f, g2 = vcol ? gt[2] * inv : 0.f;
#ifdef NSA_DEBUG
      if (vcol) { for (int db = 0; db < 4; ++db) *(f32x4*)(P.DBG + ((size_t)2 * MP + row) * 768 + head * 64 + 16 * db + 4 * c) = T.o[db] * inv; }
#endif
#pragma unroll
      for (int db = 0; db < 4; ++db) if (rep == REP_WIN - 1) oacc[db] += T.o[db] * g2; }
    if (vcol) { float* op = P.DPART + (size_t)row * 768 + head * 64 + 4 * c;
#pragma unroll
        for (int db = 0; db < 4; ++db) *(f32x4*)(op + 16 * db) = oacc[db]; }
}
DI void nsa_pair_b(const FP& P, int n, int kvh, int t, int lane, LAS unsigned char* wl) {
    LAS int* steps = (LAS int*)wl;
    const int col = lane & 15, c = lane >> 4; const bool vcol = col < 12; const int qq = vcol ? col / 6 : 0, hh = vcol ? col % 6 : 0, tq = t + qq, head = kvh * NSA_GROUP + hh, row = n * SEQ + tq;
    bf16x8 qf[2]; { const bf16* qp = P.QB + (size_t)row * NSA_Q_COLS + head * 64 + 8 * c; qf[0] = *(const bf16x8*)qp; qf[1] = *(const bf16x8*)(qp + 32); }
    const float* gt = P.GATES + (size_t)row * 64 + head * 3;
    Tile16 T; tile_init(T);
    const bf16* SKb = P.SLK + ((size_t)n * NSA_KV_HEADS + kvh) * SEQ * 64; const bf16* SVb = P.SLVT + ((size_t)n * NSA_KV_HEADS + kvh) * SEQ * 64;
    int ns = 0;
    { const int mysel = (lane < 32) ? P.SELB[((size_t)(n * SEQ + t + (lane >> 4)) * NSA_KV_HEADS + kvh) * 16 + (lane & 15)] : -1;
      for (int i = 0; i < 32; ++i) { const int b = __builtin_amdgcn_readlane(mysel, i); if (b < 0) continue; int q2 = i >> 4;
          const unsigned long long other = __ballot(mysel == b && lane < 32 && (lane >> 4) != q2);
          if (other) { if (q2 == 1) continue; q2 = 2; }
          if (lane == 0) { steps[ns] = (b * SLC_BLOCK) | (q2 << 29); steps[ns + 1] = (b * SLC_BLOCK + 32) | (q2 << 29); } ns += 2; } }
    asm volatile("s_waitcnt lgkmcnt(0)" ::: "memory");
    auto ld = [&](KV8& kv, int i) { const int code = __builtin_amdgcn_readfirstlane(steps[i]); const int kb = code & 0x1fffffff;
        kv_load_t(kv, SKb + (size_t)(kb >> 5) * 2048, SVb + (size_t)(kb >> 5) * 2048, lane); };
#ifdef PROBE_DBLCOMP
    Tile16 T2; tile_init(T2);
#endif
    pipe2(ns, ld, [&](const KV8& kv, int i) { const int code = __builtin_amdgcn_readfirstlane(steps[i]); const int kb = code & 0x1fffffff, q2 = code >> 29;
        tile_compute(T, qf, kv, [&](int e) { return vcol && (q2 == 2 || qq == q2) && (kb + 8 * c + e) <= tq; });
#ifdef PROBE_DBLCOMP
        tile_compute(T2, qf, kv, [&](int e) { return vcol && qq == q2 && (kb + 8 * c + e + 1) <= tq; });
#endif
    });
#ifdef PROBE_DBLCOMP
    if (T2.l < 0.f) T.l = 0.f;
#endif
    const float inv = (T.l > 0.f) ? 1.0f / T.l : 0.f, g1 = vcol ? gt[1] * inv : 0.f;
#ifdef NSA_DEBUG
    if (vcol) { for (int db = 0; db < 4; ++db) *(f32x4*)(P.DBG + ((size_t)1 * MP + row) * 768 + head * 64 + 16 * db + 4 * c) = T.o[db] * inv; }
#endif
    if (vcol) { const float* pp = P.DPART + (size_t)row * 768 + head * 64 + 4 * c; bf16* op = P.ATTB + (size_t)row * 1024 + head * 64 + 4 * c;
#pragma unroll
        for (int db = 0; db < 4; ++db) *(u32x2*)(op + 16 * db) = pk4(*(const f32x4*)(pp + 16 * db) + T.o[db] * g1); }
}

constexpr int SMP_SK = 1088;
template <class KF, class VF> DI void smp_branch(const Ctx& C, LAS float* qs, LAS float* S, LAS float* red, int NK, KF kf, VF vf, bool keep_probs, float (&outh)[1]) {
    const int tid = C.tid, lane = C.lane, w = C.wave;
#pragma unroll 1
    for (int j = tid; j < NK; j += NTHREADS) { const float* k = kf(j); f32x4 kr[16];
#pragma unroll
        for (int d4 = 0; d4 < 16; ++d4) kr[d4] = *(const f32x4*)(k + 4 * d4);
#pragma unroll 1
        for (int h = 0; h < 6; ++h) { float a = 0.f;
#pragma unroll
            for (int d4 = 0; d4 < 16; ++d4) { const f32x4 qv = *(const LAS f32x4*)(qs + h * 64 + 4 * d4); a += kr[d4].x * qv.x + kr[d4].y * qv.y + kr[d4].z * qv.z + kr[d4].w * qv.w; }
            S[h * SMP_SK + j] = a; } }
    asm volatile("s_waitcnt lgkmcnt(0)" ::: "memory"); __syncthreads();
    if (w < 6) { float m = -INFINITY; for (int j = lane; j < NK; j += 64) m = fmaxf(m, S[w * SMP_SK + j]); m = wave_max(m);
        float l = 0.f; for (int j = lane; j < NK; j += 64) { const float p = __builtin_amdgcn_exp2f(S[w * SMP_SK + j] - m); S[w * SMP_SK + j] = p; l += p; } l = wave_sum(l);
        const float inv = 1.0f / l; for (int j = lane; j < NK; j += 64) S[w * SMP_SK + j] *= inv; }
    asm volatile("s_waitcnt lgkmcnt(0)" ::: "memory"); __syncthreads();
    { const int per = (NK + NWAVES - 1) / NWAVES, j0 = w * per, j1 = (j0 + per < NK) ? j0 + per : NK; float o[6] = {0.f, 0.f, 0.f, 0.f, 0.f, 0.f};
#pragma unroll 1
      for (int j = j0; j < j1; j += 8) { float vv[8];
#pragma unroll
          for (int u = 0; u < 8; ++u) { const int jj = (j + u < j1) ? j + u : j1 - 1; vv[u] = vf(jj)[lane]; }
#pragma unroll
          for (int u = 0; u < 8; ++u) if (j + u < j1) {
#pragma unroll
              for (int h = 0; h < 6; ++h) o[h] += S[h * SMP_SK + j + u] * vv[u]; } }
#pragma unroll
      for (int h = 0; h < 6; ++h) red[(w * 6 + h) * 64 + lane] = o[h]; }
    asm volatile("s_waitcnt lgkmcnt(0)" ::: "memory"); __syncthreads();
    outh[0] = 0.f;
    if (tid < 384) { float a = 0.f;
#pragma unroll
        for (int ww = 0; ww < NWAVES; ++ww) a += red[ww * 384 + tid]; outh[0] = a; }
    if (!keep_probs) { __syncthreads(); }
}
DI void nsa_sample_item(const FP& P, const Ctx& C, int ns, int kvh) {
    LAS float* qs = (LAS float*)C.lds; LAS float* S = qs + 384; LAS float* red = S + 6 * SMP_SK; LAS float* scs = red + 8 * 384; LAS int* sel = (LAS int*)(scs + 136);
    const int tid = C.tid, row = M0 + ns;
    if (tid < 384) qs[tid] = bf2f(P.QB[(size_t)row * NSA_Q_COLS + kvh * 384 + tid]);
    asm volatile("s_waitcnt lgkmcnt(0)" ::: "memory"); __syncthreads();
    const float* ckf = P.CKF + ((size_t)ns * NSA_KV_HEADS + kvh) * NCH * 64; const float* cvf = P.CVF + ((size_t)ns * NSA_KV_HEADS + kvh) * NCH * 64;
    float oc[1], os[1], ow[1];
    smp_branch(C, qs, S, red, NCMP, [&](int j) { return ckf + (size_t)j * 64; }, [&](int j) { return cvf + (size_t)j * 64; }, true, oc);
    constexpr int NBS = (PAST_LEN + 1 + SLC_BLOCK - 1) / SLC_BLOCK, CURS = PAST_LEN / SLC_BLOCK;
    for (int b = tid; b < 136; b += NTHREADS) { float sv = -3.0e38f;
        if (b < NBS) { if (b == 0 || b == CURS || b == CURS - 1) sv = FORCE_SCORE; else { float a = 0.f;
#pragma unroll
                for (int o = -1; o <= 3; ++o) { const int ci = 4 * b + o; if (ci >= 0 && ci < NCMP) { float sm = 0.f; for (int h6 = 0; h6 < 6; ++h6) sm += S[h6 * SMP_SK + ci]; a += ((o >= 0 && o <= 2) ? 2.f : 1.f) * sm; } }
                sv = a; } }
        scs[b] = sv; }
    asm volatile("s_waitcnt lgkmcnt(0)" ::: "memory"); __syncthreads();
    for (int b = tid; b < NBS; b += NTHREADS) { const float sv = scs[b]; int rank = 0; for (int j = 0; j < NBS; ++j) { const float o = scs[j]; rank += (o > sv || (o == sv && j < b)) ? 1 : 0; }
        if (rank < SLC_TOPK) { sel[rank] = b; P.SELB[((size_t)row * NSA_KV_HEADS + kvh) * 16 + rank] = b; } }
    asm volatile("s_waitcnt lgkmcnt(0)" ::: "memory"); __syncthreads();
    { const float* newrow = P.nsa_kv_s + (size_t)ns * 512; const int* pt = P.page_table + ns * (PAST_LEN / PAGE_SIZE);
      if (tid == 0) { int seen = 0; for (int x = 0; x < SLC_TOPK; ++x) { const int bx = sel[x]; if (bx != CURS && seen < 15) sel[16 + seen++] = bx; } }
      asm volatile("s_waitcnt lgkmcnt(0)" ::: "memory"); __syncthreads();
      auto krow = [&](int j, int ty) -> const float* { if (j >= 15 * 64) return newrow + ty * 128 + kvh * 64;
          const int t0 = sel[16 + (j >> 6)] * SLC_BLOCK + (j & 63); const int pg = pt[t0 / PAGE_SIZE]; return P.cache_nsa_kv + ((size_t)pg * PAGE_SIZE + t0 % PAGE_SIZE) * 512 + ty * 128 + kvh * 64; };
      smp_branch(C, qs, S, red, 15 * 64 + 1, [&](int j) { return krow(j, 2); }, [&](int j) { return krow(j, 3); }, false, os); }
    { const float* wc = P.cache_nsa_win + (size_t)ns * SWA_WINDOW * 256; const float* newrow = P.win_s + ((size_t)ns * SWA_WINDOW + SWA_WINDOW - 1) * 256;
      smp_branch(C, qs, S, red, SWA_WINDOW + 1, [&](int j) { return (j < SWA_WINDOW ? wc + (size_t)j * 256 : newrow) + kvh * 64; }, [&](int j) { return (j < SWA_WINDOW ? wc + (size_t)j * 256 : newrow) + 128 + kvh * 64; }, false, ow); }
    if (tid < 384) { const int head = kvh * NSA_GROUP + tid / 64; const float* gt = P.GATES + (size_t)row * 64 + head * 3;
        P.ATTB[(size_t)row * 1024 + kvh * 384 + tid] = (bf16)f2bf(gt[0] * oc[0] + gt[1] * os[0] + gt[2] * ow[0]);
#ifdef NSA_DEBUG
        P.DBG[((size_t)0 * MP + row) * 768 + kvh * 384 + tid] = oc[0]; P.DBG[((size_t)1 * MP + row) * 768 + kvh * 384 + tid] = os[0]; P.DBG[((size_t)2 * MP + row) * 768 + kvh * 384 + tid] = ow[0];
#endif
    }
    __syncthreads();
}
DI void nsa_pairs(const FP& P, const Ctx& C, bool second) {
    LAS unsigned char* wl = C.lds + C.wave * NSA_WLDS;
    const int per = C.G / 4 > 0 ? C.G / 4 : 1, grp = (C.vcu / per) & 3, sub = C.vcu % per, n = grp >> 1, kvh = grp & 1;
#pragma unroll 1
    for (int pr = sub * NWAVES + C.wave; pr < SEQ / 2; pr += per * NWAVES) { if (second) nsa_pair_b(P, n, kvh, 2 * pr, C.lane, wl); else nsa_pair_a(P, n, kvh, 2 * pr, C.lane, wl); }
}
DI void nsa_phase_a(const FP& P, const Ctx& C) {
    for (int it = C.vcu; it < DEC_BATCH * NSA_KV_HEADS; it += C.G) nsa_sample_item(P, C, it / NSA_KV_HEADS, it % NSA_KV_HEADS);
    nsa_pairs(P, C, false);
    __syncthreads();
}
DI void nsa_phase_b(const FP& P, const Ctx& C) {
    const int lane = C.lane, w = C.wave;
    nsa_pairs(P, C, true);
    __syncthreads();
    { constexpr int NMT = (M0 / 16) * MEM_HEADS;
      for (int it = C.vcu * NWAVES + w; it < NMT; it += C.G * NWAVES) { const int h = it % MEM_HEADS, q16 = it / MEM_HEADS, row0 = q16 * 16, n = row0 / SEQ;
          mem_micro(P, P.MQB + h * 64, 256, row0, 1, n, h, P.ATTB + NSA_Q_COLS + h * 64, 1024, lane); }
    }
    { LAS float* qs = (LAS float*)C.lds;
      for (int it = C.vcu; it < DEC_BATCH * MEM_HEADS; it += C.G) { const int h = it % MEM_HEADS, ns = it / MEM_HEADS, row = M0 + ns;
          __syncthreads(); if (C.tid < 64) qs[C.tid] = bf2f(P.MQB[(size_t)row * 256 + h * 64 + C.tid]); asm volatile("s_waitcnt lgkmcnt(0)" ::: "memory"); __syncthreads();
          Dec D; D.m = -INFINITY; D.l = 0.f; D.o = 0.f; const float* mk = P.cache_mem_kv + ((size_t)1 * DEC_BATCH + ns) * MEM_TOKENS * 512;
          for (int ck = w; ck < MEM_TOKENS / 64; ck += NWAVES) { const int j0 = ck * 64; dec_chunk(D, qs, 64, [&](int j) { return mk + (size_t)(j0 + j) * 512 + h * 64; }, [&](int j) { return mk + (size_t)(j0 + j) * 512 + 256 + h * 64; }, lane); }
          const float o = dec_combine(C, D);
          if (w == 0) P.ATTB[(size_t)row * 1024 + NSA_Q_COLS + h * 64 + lane] = (bf16)f2bf(o); } }
    __syncthreads();
}
}
namespace fx {
enum { PH_PRO = 0, PH_G1, PH_ATTA, PH_G2, PH_LN1, PH_SC0, PH_TK0, PH_PU0, PH_PG0, PH_G3, PH_CMPG, PH_CMP2, PH_NSA, PH_NSB, PH_G4, PH_LN3, PH_SC1, PH_TK1, PH_PU1, PH_PG1, PH_COUNT };
template <class Epi> DI void run_gemm(const Ctx& C, const bf16* A, const bf16* Bt, int M, int N, int K, const Epi& E) {
    pg8::Gemm g{A, Bt, M, N, K}; pg8::StaticOrder S; S.init(M, N, C.G, (int)blockIdx.x);
    pg8::gemm_phase<Epi, pg8::StaticOrder, true, true>(C.lds, g, S, E);
}
template <class Epi> DI void skinny_gemm(const Ctx& C, const bf16* A, const bf16* Bt, int N, int K, const Epi& E) {
    static_assert(DEC_BATCH == 32 && M0 % 256 == 0, "skinny_gemm: 32 sample rows right after a whole number of 256-row tiles");
    const int lane = C.lane, fr = lane & 15, fq = lane >> 4, w = C.wave; const int NI = (N / 256) * 4, KW = K / NWAVES;
    LAS f32x4* red = (LAS f32x4*)C.lds;
#pragma unroll 1
    for (int item = C.vcu; item < NI; item += C.G) { const int pn = item >> 2, wc = item & 3;
        f32x4 pa[2][2][2];
#pragma unroll
        for (int i = 0; i < 8; ++i) (&pa[0][0][0])[i] = (f32x4){0.f, 0.f, 0.f, 0.f};
        const bf16* xa = A + (size_t)(M0 + fr) * K + w * KW + 8 * fq; const bf16* xb = xa + (size_t)16 * K;
        const bf16* wp[2][2];
#pragma unroll
        for (int bj = 0; bj < 2; ++bj)
#pragma unroll
            for (int n = 0; n < 2; ++n) wp[bj][n] = Bt + (size_t)(pn * 256 + bj * 128 + wc * 32 + 8 * (fr >> 2) + 4 * n + (fr & 3)) * K + w * KW + 8 * fq;
#pragma unroll 4
        for (int k0 = 0; k0 < KW; k0 += 32) { const bf16x8 x0 = *(const bf16x8*)(xa + k0), x1 = *(const bf16x8*)(xb + k0);
#pragma unroll
            for (int bj = 0; bj < 2; ++bj)
#pragma unroll
                for (int n = 0; n < 2; ++n) { const bf16x8 wf = *(const bf16x8*)(wp[bj][n] + k0);
                    pa[bj][0][n] = __builtin_amdgcn_mfma_f32_16x16x32_bf16(wf, x0, pa[bj][0][n], 0, 0, 0); pa[bj][1][n] = __builtin_amdgcn_mfma_f32_16x16x32_bf16(wf, x1, pa[bj][1][n], 0, 0, 0); } }
        __syncthreads();
#pragma unroll
        for (int bj = 0; bj < 2; ++bj)
#pragma unroll
            for (int mm = 0; mm < 2; ++mm)
#pragma unroll
                for (int n = 0; n < 2; ++n) red[(w * 8 + bj * 4 + mm * 2 + n) * 64 + lane] = pa[bj][mm][n];
        asm volatile("s_waitcnt lgkmcnt(0)" ::: "memory"); __syncthreads();
        if (w == 0) { f32x4 acc[2][2][4][2];
#pragma unroll
            for (int i = 0; i < 32; ++i) (&acc[0][0][0][0])[i] = (f32x4){0.f, 0.f, 0.f, 0.f};
#pragma unroll
            for (int bj = 0; bj < 2; ++bj)
#pragma unroll
                for (int mm = 0; mm < 2; ++mm)
#pragma unroll
                    for (int n = 0; n < 2; ++n) { f32x4 s = red[(bj * 4 + mm * 2 + n) * 64 + lane];
#pragma unroll 1
                        for (int ww = 1; ww < NWAVES; ++ww) s += red[(ww * 8 + bj * 4 + mm * 2 + n) * 64 + lane];
                        acc[0][bj][mm][n] = s; }
            E(acc, pg8::Unit{M0 / 256, pn}, 0, wc, fr, fq); }
    }
    __syncthreads();
}
__global__ void __launch_bounds__(NTHREADS, 2) mega(Args args) {
    extern __shared__ __attribute__((aligned(16))) unsigned char lds_raw[];
    Ctx C; C.lds = (LAS unsigned char*)lds_raw; C.tid = threadIdx.x; C.lane = C.tid & 63; C.wave = __builtin_amdgcn_readfirstlane(C.tid >> 6);
    C.G = gridDim.x; { const int bx = blockIdx.x; C.vcu = (C.G % 8 == 0) ? (bx % 8) * (C.G / 8) + bx / 8 : bx; }
    const FP& P = args.p;
    volatile LAS unsigned* MISC = (volatile LAS unsigned*)(C.lds + MISC_OFF);
    for (int u = C.tid; u < (LDS_BYTES - RING_BYTES) / 4; u += NTHREADS) ((LAS unsigned*)(C.lds + RING_BYTES))[u] = 0u;
    __syncthreads();
    const int lo = args.lo, hi = args.hi;
    XcdBarrier bar; bar.bar = P.ctl + 1024; bar.x = 0; bar.st = nullptr;
    if (hi - lo > 1) bar = xcd_barrier_post(P.ctl + 1024, MISC + 8);
#define IN(k) (lo <= (k) && (k) < hi)
#define SEAM(k) do { if (IN(k) && IN((k) + 1)) xcd_barrier(bar); } while (0)
#ifndef DUP_PHASE
#define DUP_PHASE -1
#endif
#define PHASE(k, ...) do { if (IN(k)) { __VA_ARGS__ if (DUP_PHASE == (k)) { __syncthreads(); __VA_ARGS__ } } SEAM(k); } while (0)
    PHASE(PH_PRO, p0_prologue(P, C); __syncthreads(); p0_wpk(P, C););
    PHASE(PH_G1, run_gemm(C, P.XB0, P.WA_T, M0, ACOLS, D_MODEL, EpiA{P}); run_gemm(C, P.MEMB, P.WMEM_T, BATCH * MEM_TOKENS, 1024, D_MODEL, EpiMem{P}); skinny_gemm(C, P.XB0, P.WA_T, ACOLS, D_MODEL, EpiA{P}););
#ifdef PEER_SHARD3
#define PEER_SHARDED_FN peer_sharded3_phase
#else
#define PEER_SHARDED_FN peer_sharded2_phase
#endif
    PHASE(PH_ATTA, atta_phase(P, C););
    PHASE(PH_G2, run_gemm(C, P.ATTA, P.WOA_T, M0, D_MODEL, 512, EpiPre{P.x_prompt, P.x_sample, P.PRE}); skinny_gemm(C, P.ATTA, P.WOA_T, D_MODEL, 512, EpiPre{P.x_prompt, P.x_sample, P.PRE}););
    PHASE(PH_LN1, ln_phase(P, C, P.PRE, P.ln_g, P.ln_b, P.X1, P.X1B, nullptr, nullptr););
    PHASE(PH_SC0, run_gemm(C, P.X1B, P.WPK_T, M0, NPK, D_MODEL, EpiF32{P.SCO, NPK, MP}); skinny_gemm(C, P.X1B, P.WPK_T, NPK, D_MODEL, EpiF32{P.SCO, NPK, MP}););
    PHASE(PH_TK0, topk_phase(P, C););
#ifdef PEER_SPLIT
    PHASE(PH_PU0, peer_u_phase(P, C, 0, P.X1B););
    PHASE(PH_PG0, peer_v_phase(P, C, 0, P.X1, P.X2, P.X2 + (size_t)M0 * D_MODEL, P.X2B););
#elif defined(PEER_SHARD2)
    PHASE(PH_PG0, const bool shd = (M0 % (C.G * NWAVES * PS2_ROWS)) == 0; if (shd) { PEER_SHARDED_FN(P, C, 0, P.X1, P.X1B, P.X2, P.X2B); __syncthreads(); } peer_phase(P, C, 0, P.X1, P.X2, P.X2 + (size_t)M0 * D_MODEL, P.X2B, shd););
#elif defined(PEER_SHARD)
    PHASE(PH_PG0, peer_sharded_phase(P, C, 0, P.X1, P.X1B, P.X2, P.X2 + (size_t)M0 * D_MODEL, P.X2B); __syncthreads(); peer_phase(P, C, 0, P.X1, P.X2, P.X2 + (size_t)M0 * D_MODEL, P.X2B););
#else
    PHASE(PH_PG0, peer_phase(P, C, 0, P.X1, P.X2, P.X2 + (size_t)M0 * D_MODEL, P.X2B););
#endif
    PHASE(PH_G3, run_gemm(C, P.X2B, P.WB_T, M0, NB_T, D_MODEL, EpiB{P}); skinny_gemm(C, P.X2B, P.WB_T, NB_T, D_MODEL, EpiB{P}););
    PHASE(PH_CMPG, run_gemm(C, P.AC, P.CW1_T, ACROWS, 256, 1024, EpiF32{P.UL, 256, ACROWS}); run_gemm(C, P.AC + (size_t)ACROWS * 1024, P.CW1_T + 256 * 1024, ACROWS, 256, 1024, EpiF32{P.UL + (size_t)ACROWS * 256, 256, ACROWS}););
    PHASE(PH_CMP2, cmp2_phase(P, C););
    PHASE(PH_NSA, nsa_phase_a(P, C););
    PHASE(PH_NSB, nsa_phase_b(P, C););
    PHASE(PH_G4, run_gemm(C, P.ATTB, P.WOB_T, M0, D_MODEL, 1024, EpiPre{P.X2, nullptr, P.PRE}); skinny_gemm(C, P.ATTB, P.WOB_T, D_MODEL, 1024, EpiPre{P.X2, nullptr, P.PRE}););
    PHASE(PH_LN3, ln_phase(P, C, P.PRE, P.ln_g + 2 * D_MODEL, P.ln_b + 2 * D_MODEL, P.X3, P.X3B, nullptr, nullptr););
    PHASE(PH_SC1, run_gemm(C, P.X3B, P.WPK_T + (size_t)NPK * D_MODEL, M0, NPK, D_MODEL, EpiF32{P.SCO, NPK, MP}); skinny_gemm(C, P.X3B, P.WPK_T + (size_t)NPK * D_MODEL, NPK, D_MODEL, EpiF32{P.SCO, NPK, MP}););
    PHASE(PH_TK1, topk_phase(P, C););
#ifdef PEER_SPLIT
    PHASE(PH_PU1, peer_u_phase(P, C, 1, P.X3B););
    PHASE(PH_PG1, peer_v_phase(P, C, 1, P.X3, P.y_prompt, P.y_sample, nullptr););
#elif defined(PEER_SHARD2)
    PHASE(PH_PG1, const bool shd = (M0 % (C.G * NWAVES * PS2_ROWS)) == 0; if (shd) { PEER_SHARDED_FN(P, C, 1, P.X3, P.X3B, P.y_prompt, nullptr); __syncthreads(); } peer_phase(P, C, 1, P.X3, P.y_prompt, P.y_sample, nullptr, shd););
#elif defined(PEER_SHARD)
    PHASE(PH_PG1, peer_sharded_phase(P, C, 1, P.X3, P.X3B, P.y_prompt, P.y_sample, nullptr); __syncthreads(); peer_phase(P, C, 1, P.X3, P.y_prompt, P.y_sample, nullptr););
#else
    PHASE(PH_PG1, peer_phase(P, C, 1, P.X3, P.y_prompt, P.y_sample, nullptr););
#endif
#undef IN
#undef SEAM
}
}
#ifndef ONE_LAUNCH
#define ONE_LAUNCH 1
#endif
extern "C" void kernel_launch(void* const* d_in, const int* in_sizes, int n_in, void* d_out, int out_size, void* d_ws, size_t ws_size, hipStream_t stream) {
    fx::Args a; memset(&a, 0, sizeof(a)); fx::bind_io(a.p, d_in, (float*)d_out);
    const size_t f_need = fx::carve(a.p, d_ws);
    if (f_need > ws_size) { fprintf(stderr, "kernel_launch: workspace too small: need %zu have %zu\n", f_need, ws_size); return; }
    static int grid = 0;
    if (!grid) { int dev = 0, cus = 0, per_cu = 0; (void)hipGetDevice(&dev); (void)hipDeviceGetAttribute(&cus, hipDeviceAttributeMultiprocessorCount, dev);
        (void)hipFuncSetAttribute((const void*)fx::mega, hipFuncAttributeMaxDynamicSharedMemorySize, fx::LDS_BYTES);
        if (hipOccupancyMaxActiveBlocksPerMultiprocessor(&per_cu, (const void*)fx::mega, fx::NTHREADS, fx::LDS_BYTES) != hipSuccess || per_cu < 1) { fprintf(stderr, "kernel_launch: occupancy query says %d blocks per CU\n", per_cu); (void)hipGetLastError(); }
        grid = cus; }
    (void)hipMemsetAsync(a.p.ctl, 0, fx::CTL_BYTES, stream);
#if ONE_LAUNCH
    a.lo = 0; a.hi = fx::PH_COUNT; hipLaunchKernelGGL(fx::mega, dim3(grid), dim3(fx::NTHREADS), fx::LDS_BYTES, stream, a);
#else
    for (int k = 0; k < fx::PH_COUNT; ++k) { a.lo = k; a.hi = k + 1; hipLaunchKernelGGL(fx::mega, dim3(grid), dim3(fx::NTHREADS), fx::LDS_BYTES, stream, a); }
#endif
}
```

```cpp
#define PEER_SHARD2 1
#define ONE_LAUNCH 1
#include <hip/hip_runtime.h>
#include <cstdio>
#include <cstring>
#include <cmath>
#ifdef CPU_TEST
#define HD inline
constexpr int D_MODEL = 128, BATCH = 2, SEQ = 512, DEPTH = 2, DEC_BATCH = 3, DEC_SEQ = 1, PAST_LEN = 512, PAGE_SIZE = 128;
constexpr int DIL_W[3] = {16, 64, 256}, DIL_D[3] = {1, 4, 16}, DIL_TAPS = 17;
constexpr int MEM_TOKENS = 32, SLC_TOPK = 4, SWA_WINDOW = 64, PEER_KEYS = 16, PEER_TOPK = 4;
#else
#define HD __host__ __device__ __forceinline__
constexpr int D_MODEL = 1024, BATCH = 2, SEQ = 8192, DEPTH = 2, DEC_BATCH = 32, DEC_SEQ = 1, PAST_LEN = 8192, PAGE_SIZE = 128;
constexpr int DIL_W[3] = {128, 512, 2048}, DIL_D[3] = {1, 4, 16}, DIL_TAPS = 129;
constexpr int MEM_TOKENS = 256, SLC_TOPK = 16, SWA_WINDOW = 512, PEER_KEYS = 128, PEER_TOPK = 16;
#endif
HD constexpr int dil_w(int g) { return g == 0 ? DIL_W[0] : (g == 1 ? DIL_W[1] : DIL_W[2]); }
HD constexpr int dil_d(int g) { return g == 0 ? DIL_D[0] : (g == 1 ? DIL_D[1] : DIL_D[2]); }
constexpr int HEAD_DIM = 64, N_A_LAYERS = DEPTH / 2, N_DIL = 3, DIL_HEADS = 4, DIL_COLS = N_DIL * 3 * DIL_HEADS * HEAD_DIM;
constexpr int MEM_HEADS = 4, MEM_COLS = MEM_HEADS * HEAD_DIM;
constexpr int NSA_HEADS = 12, NSA_KV_HEADS = 2, NSA_GROUP = 6, NSA_Q_COLS = NSA_HEADS * HEAD_DIM, NSA_GATE_COLS = NSA_HEADS * 3;
constexpr int CMP_BLOCK = 32, CMP_STRIDE = 16, CMP_HIDDEN = 128, SLC_BLOCK = 64;
constexpr int PEER_EXPERTS = PEER_KEYS * PEER_KEYS, PEER_HEADS = 8, PEER_KEY_DIM = 128;
constexpr float FORCE_SCORE = 1.0e9f, NEG = -1.0e30f, SCALE = 0.125f, LN_EPS = 1e-5f;
constexpr float ALPHA = 1.41421356237309515f;
constexpr float BETA = 0.5f;
#define LAS __attribute__((address_space(3)))
namespace pg8 {
#define PG8_LAS __attribute__((address_space(3)))
typedef unsigned short bf16_t;
typedef short bf16x8 __attribute__((ext_vector_type(8)));
typedef float f32x4 __attribute__((ext_vector_type(4)));
typedef unsigned u32x4 __attribute__((ext_vector_type(4)));
constexpr int BM = 256, BK = 64, HALF = 128, HTB = HALF * BK * 2  , STAGE_BYTES = 8 * HTB, NXCD = 8, WGM = 8;

__host__ __device__ __forceinline__ int lds_byte(int r, int c) { const int st = (r >> 4) * 2 + (c >> 5), rr = r & 15, cc = c & 31, ob = rr * 64 + cc * 2; return st * 1024 + (ob ^ (((ob >> 9) & 1) << 5)); }
__host__ __device__ __forceinline__ void stage_rc(int b, int& R, int& C) { const int st = b / 1024, sb = b % 1024, swz = sb ^ (((sb >> 9) & 1) << 5); R = (st >> 1) * 16 + swz / 64; C = (st & 1) * 32 + (swz % 64) / 2; }
__host__ __device__ __forceinline__ int perm32(int rho) { const int n = rho >> 4, i = rho & 15; return 8 * (i >> 2) + 4 * n + (i & 3); }

struct Unit { int pm, pn; };
struct Gemm { const bf16_t* A; const bf16_t* Bt; int M, N, K; };

struct StaticOrder {
    int nM, nN, nwg, G, c;
    __host__ __device__ void init(int M, int N, int G_, int c_) { nM = M / BM; nN = N / BM; nwg = nM * nN; G = G_; c = c_; }
    __host__ __device__ bool next(int i, Unit& u) const {
        const long L = (long)i * G + c; if (L >= nwg) return false;
        int wgid = (int)L; { const int q = nwg / NXCD, r = nwg % NXCD, xcd = wgid % NXCD, off = wgid / NXCD; wgid = (xcd < r ? xcd * (q + 1) : r * (q + 1) + (xcd - r) * q) + off; }
        const int nig = WGM * nN, gid = wgid / nig, fm = gid * WGM, gsz = (nM - fm) < WGM ? (nM - fm) : WGM;
        u.pm = fm + ((wgid % nig) % gsz); u.pn = (wgid % nig) / gsz; return true;
    }
    __device__ __forceinline__ void a_ready(const Unit&) const {}
    __device__ __forceinline__ void done(const Unit&) const {}
};

__device__ __forceinline__ unsigned cvt_pk_bf16(float lo, float hi) { unsigned r; asm volatile("v_cvt_pk_bf16_f32 %0, %1, %2" : "=v"(r) : "v"(lo), "v"(hi)); return r; }
typedef float f32x2 __attribute__((ext_vector_type(2)));
typedef float f32x2 __attribute__((ext_vector_type(2)));
template <class Epi, class Sched, bool ALIGN_EPI = false, bool SP2 = false>
__device__ __forceinline__ void gemm_phase(PG8_LAS unsigned char* lds, const Gemm g, const Sched& S, const Epi& E) {
    const int tid = threadIdx.x, wid = __builtin_amdgcn_readfirstlane(tid >> 6), lane = tid & 63, wr = wid >> 2, wc = wid & 3, fr = lane & 15, fq = lane >> 4;
    const int K = g.K, nt = K / BK;
    unsigned voffA[2], voffB[2];
#pragma unroll
    for (int i = 0; i < 2; ++i) { int R, C; stage_rc(tid * 16 + i * 8192, R, C); const int Rb = Epi::PERM ? ((R & ~31) + perm32(R & 31)) : R;
        voffA[i] = (unsigned)(R * K + C) * 2u; voffB[i] = (unsigned)(Rb * K + C) * 2u; }
    const size_t kstep = (size_t)(BK * 2);
    const size_t hstep = (size_t)HALF * K * 2;
    const size_t tstep = 2 * hstep;
    const unsigned ldsw = (unsigned)wid * 1024u;
    const int aoff = lds_byte(wr * 64 + fr, fq * 8), boff = lds_byte(wc * 32 + fr, fq * 8);
#define PG8_SA(b, h) (((b) * 2 + (h)) * HTB)
#define PG8_SB(b, h) ((4 + (b) * 2 + (h)) * HTB)
#define PG8_STAGE(bufoff, gbase, voff) do { _Pragma("unroll") for (int _i = 0; _i < 2; ++_i) \
        __builtin_amdgcn_global_load_lds((const unsigned*)((const char*)(gbase) + (voff)[_i]), (PG8_LAS unsigned*)(lds + (bufoff) + ldsw + _i * 8192), 16, 0, 0); } while (0)
#define PG8_LDA(dst, b, h) do { _Pragma("unroll") for (int m = 0; m < 4; ++m) _Pragma("unroll") for (int k = 0; k < 2; ++k) dst[m][k] = *(const PG8_LAS bf16x8*)(lds + PG8_SA(b, h) + aoff + m * 2048 + k * 1024); } while (0)
#define PG8_LDB(dst, b, h) do { _Pragma("unroll") for (int n = 0; n < 2; ++n) _Pragma("unroll") for (int k = 0; k < 2; ++k) dst[n][k] = *(const PG8_LAS bf16x8*)(lds + PG8_SB(b, h) + boff + n * 2048 + k * 1024); } while (0)
#define PG8_MMA(ai, bj, At, Bt) do { __builtin_amdgcn_s_setprio(1); _Pragma("unroll") for (int m = 0; m < 4; ++m) _Pragma("unroll") for (int n = 0; n < 2; ++n) _Pragma("unroll") for (int k = 0; k < 2; ++k) \
        acc[ai][bj][m][n] = __builtin_amdgcn_mfma_f32_16x16x32_bf16(Bt[n][k], At[m][k], acc[ai][bj][m][n], 0, 0, 0); __builtin_amdgcn_s_setprio(0); } while (0)
#define PG8_WAIT_V(n) asm volatile("s_waitcnt vmcnt(" #n ")" ::: "memory")
#define PG8_WAIT_L(n) asm volatile("s_waitcnt lgkmcnt(" #n ")" ::: "memory")
#define PG8_BAR __builtin_amdgcn_s_barrier()
#define PG8_SCHED __builtin_amdgcn_sched_barrier(0)
    Unit cur, nxt; int ui = 0;
    if (!S.next(0, cur)) return;
    f32x4 acc[2][2][4][2];
#pragma unroll
    for (int a = 0; a < 2; ++a)
#pragma unroll
        for (int b = 0; b < 2; ++b)
#pragma unroll
            for (int m = 0; m < 4; ++m)
#pragma unroll
                for (int n = 0; n < 2; ++n) acc[a][b][m][n] = (f32x4){0.f, 0.f, 0.f, 0.f};
    bf16x8 At[4][2], B0[2][2], B1[2][2];
    const char* cA = (const char*)g.A + (size_t)cur.pm * tstep; const char* cB = (const char*)g.Bt + (size_t)cur.pn * tstep;
    S.a_ready(cur);
    if constexpr (SP2) {
        PG8_STAGE(PG8_SB(0, 0), cB, voffB); PG8_STAGE(PG8_SB(0, 1), cB + hstep, voffB); PG8_STAGE(PG8_SA(0, 0), cA, voffA); PG8_STAGE(PG8_SA(0, 1), cA + hstep, voffA);
        if (wr == 1) PG8_BAR;
        PG8_WAIT_V(2); PG8_BAR;
        PG8_STAGE(PG8_SB(1, 0), cB + kstep, voffB); PG8_STAGE(PG8_SA(1, 0), cA + kstep, voffA); PG8_STAGE(PG8_SB(1, 1), cB + hstep + kstep, voffB);
        PG8_WAIT_V(6); PG8_BAR;
    } else {
        PG8_STAGE(PG8_SB(0, 0), cB, voffB); PG8_STAGE(PG8_SA(0, 0), cA, voffA); PG8_STAGE(PG8_SB(0, 1), cB + hstep, voffB); PG8_STAGE(PG8_SA(0, 1), cA + hstep, voffA);
        if (wr == 1) PG8_BAR;
        PG8_WAIT_V(4); PG8_BAR;
        PG8_STAGE(PG8_SB(1, 0), cB + kstep, voffB); PG8_STAGE(PG8_SA(1, 0), cA + kstep, voffA); PG8_STAGE(PG8_SB(1, 1), cB + hstep + kstep, voffB);
        PG8_WAIT_V(6); PG8_BAR;
    }
    for (;;) {
        const bool has_next = S.next(ui + 1, nxt);
        const char* nA = has_next ? (const char*)g.A + (size_t)nxt.pm * tstep : cA; const char* nB = has_next ? (const char*)g.Bt + (size_t)nxt.pn * tstep : cB;
        for (int t = 0; t < nt; t += 2) {
            const bool last = (t == nt - 2);
            const char* a1 = cA + (size_t)(t + 1) * kstep;
            const char* a2 = last ? nA : cA + (size_t)(t + 2) * kstep; const char* b2 = last ? nB : cB + (size_t)(t + 2) * kstep;
            const char* a3 = a2 + kstep; const char* b3 = b2 + kstep;
            if (last && has_next) S.a_ready(nxt);
            if constexpr (SP2) {
            PG8_LDB(B0, 0, 0); PG8_LDB(B1, 0, 1); PG8_SCHED; PG8_LDA(At, 0, 0); PG8_STAGE(PG8_SA(1, 1), a1 + hstep, voffA);
            PG8_WAIT_V(8); PG8_WAIT_L(0); PG8_BAR; PG8_MMA(0, 0, At, B0); PG8_MMA(0, 1, At, B1); PG8_BAR; PG8_SCHED;
            PG8_LDA(At, 0, 1); PG8_STAGE(PG8_SB(0, 0), b2, voffB); PG8_STAGE(PG8_SB(0, 1), b2 + hstep, voffB); PG8_STAGE(PG8_SA(0, 0), a2, voffA);
            PG8_WAIT_V(8); PG8_WAIT_L(0); PG8_BAR; PG8_MMA(1, 0, At, B0); PG8_MMA(1, 1, At, B1); PG8_BAR; PG8_SCHED;
            PG8_LDB(B0, 1, 0); PG8_LDB(B1, 1, 1); PG8_SCHED; PG8_LDA(At, 1, 0); PG8_STAGE(PG8_SA(0, 1), a2 + hstep, voffA);
            PG8_WAIT_V(8); PG8_WAIT_L(0); PG8_BAR; PG8_MMA(0, 0, At, B0); PG8_MMA(0, 1, At, B1); PG8_BAR; PG8_SCHED;
            PG8_LDA(At, 1, 1); PG8_STAGE(PG8_SB(1, 0), b3, voffB); PG8_STAGE(PG8_SB(1, 1), b3 + hstep, voffB); PG8_STAGE(PG8_SA(1, 0), a3, voffA);
            PG8_WAIT_V(8); PG8_WAIT_L(0); PG8_BAR; PG8_MMA(1, 0, At, B0); PG8_MMA(1, 1, At, B1); PG8_BAR; PG8_SCHED;
            } else {
            PG8_LDB(B0, 0, 0); PG8_SCHED; PG8_LDA(At, 0, 0); PG8_STAGE(PG8_SA(1, 1), a1 + hstep, voffA);
            PG8_WAIT_L(8); PG8_BAR; PG8_WAIT_L(0); PG8_MMA(0, 0, At, B0); PG8_BAR; PG8_SCHED;
            PG8_LDB(B1, 0, 1); PG8_STAGE(PG8_SB(0, 0), b2, voffB);
            PG8_BAR; PG8_WAIT_L(0); PG8_MMA(0, 1, At, B1); PG8_BAR;
            PG8_LDA(At, 0, 1); PG8_STAGE(PG8_SA(0, 0), a2, voffA);
            PG8_BAR; PG8_WAIT_L(0); PG8_MMA(1, 0, At, B0); PG8_BAR; PG8_SCHED;
            PG8_STAGE(PG8_SB(0, 1), b2 + hstep, voffB);
            PG8_WAIT_V(6); PG8_BAR; PG8_MMA(1, 1, At, B1); PG8_BAR;
            PG8_LDB(B0, 1, 0); PG8_SCHED; PG8_LDA(At, 1, 0); PG8_STAGE(PG8_SA(0, 1), a2 + hstep, voffA);
            PG8_WAIT_L(8); PG8_BAR; PG8_WAIT_L(0); PG8_MMA(0, 0, At, B0); PG8_BAR; PG8_SCHED;
            PG8_LDB(B1, 1, 1); PG8_STAGE(PG8_SB(1, 0), b3, voffB);
            PG8_BAR; PG8_WAIT_L(0); PG8_MMA(0, 1, At, B1); PG8_BAR;
            PG8_LDA(At, 1, 1); PG8_STAGE(PG8_SA(1, 0), a3, voffA);
            PG8_BAR; PG8_WAIT_L(0); PG8_MMA(1, 0, At, B0); PG8_BAR; PG8_SCHED;
            PG8_STAGE(PG8_SB(1, 1), b3 + hstep, voffB);
            PG8_WAIT_V(6); PG8_BAR; PG8_MMA(1, 1, At, B1); PG8_BAR;
            }
        }
        if constexpr (ALIGN_EPI) { if (wr == 0) PG8_BAR; }
        if constexpr (!Epi::AFTER_DRAIN) { E(acc, cur, wr, wc, fr, fq); S.done(cur); }
        if (!has_next) break;
#pragma unroll
        for (int a = 0; a < 2; ++a)
#pragma unroll
            for (int b = 0; b < 2; ++b)
#pragma unroll
                for (int m = 0; m < 4; ++m)
#pragma unroll
                    for (int n = 0; n < 2; ++n) acc[a][b][m][n] = (f32x4){0.f, 0.f, 0.f, 0.f};
        cur = nxt; cA = nA; cB = nB; ++ui;
        if constexpr (ALIGN_EPI) { if (wr == 1) PG8_BAR; }
    }
    PG8_WAIT_V(0);
    if constexpr (!ALIGN_EPI) { if (wr == 0) PG8_BAR; }
    PG8_BAR;
    if constexpr (Epi::AFTER_DRAIN) { E.fused(acc, cur, wr, wc, fr, fq, lds, wid, lane); S.done(cur); }
#undef PG8_SA
#undef PG8_SB
#undef PG8_STAGE
#undef PG8_LDA
#undef PG8_LDB
#undef PG8_MMA
#undef PG8_WAIT_V
#undef PG8_WAIT_L
#undef PG8_BAR
#undef PG8_SCHED
}
}
#define XB_TMO      128
#define XB_XCNT(j)  (256  + 64 * (j))
#define XB_XSUB(j)  (1280 + 64 * (j))
#define XB_XGEN(j)  (2304 + 64 * (j))
#define XB_TOP      3328
#define XB_TOPGEN   3392
#define XCD_BAR_WORDS 3456
#define XB_SPIN_CAP (1u << 18)

__device__ __forceinline__ unsigned xb_ld(unsigned* p)              { return __hip_atomic_load(p, __ATOMIC_RELAXED, __HIP_MEMORY_SCOPE_AGENT); }
__device__ __forceinline__ unsigned xb_add(unsigned* p, unsigned v) { return __hip_atomic_fetch_add(p, v, __ATOMIC_RELAXED, __HIP_MEMORY_SCOPE_AGENT); }
__device__ __forceinline__ unsigned xb_xcc_id() { return (unsigned)__builtin_amdgcn_s_getreg((3 << 11) | 20) & 0xFu; }
#define XB_SPIN(cond, bar) do { unsigned _sp = 0; while (cond) { __builtin_amdgcn_s_sleep(1); \
    if ((++_sp & 255u) == 0u) { if (xb_ld(&(bar)[XB_TMO])) break; if (_sp > XB_SPIN_CAP) { atomicAdd(&(bar)[XB_TMO], 1u); break; } } } } while (0)

struct XcdBarrier {
    unsigned* bar; unsigned x;
    volatile LAS unsigned* st;
};

__device__ __forceinline__ XcdBarrier xcd_barrier_post(unsigned* bar, volatile LAS unsigned* st) {
    XcdBarrier b; b.bar = bar; b.x = xb_xcc_id(); b.st = st;
    if (threadIdx.x == 0) (void)xb_add(&bar[XB_XCNT(b.x)], 1u);
    return b;
}
__device__ __forceinline__ void xcd_barrier_complete(unsigned* bar, unsigned x, unsigned& nloc, unsigned& nx) {
    const unsigned G = gridDim.x * gridDim.y * gridDim.z;
    unsigned sum, cnt, mine, sp = 0u;
    for (;;) {
        sum = 0u; cnt = 0u; mine = 0u;
#pragma unroll
        for (unsigned j = 0; j < 16; ++j) { const unsigned c = xb_ld(&bar[XB_XCNT(j)]); sum += c; cnt += (c > 0u) ? 1u : 0u; mine = (j == x) ? c : mine; }
        if (sum == G) break;
        __builtin_amdgcn_s_sleep(1);
        if ((++sp & 255u) == 0u) { if (xb_ld(&bar[XB_TMO])) break; if (sp > XB_SPIN_CAP) { atomicAdd(&bar[XB_TMO], 1u); break; } }
    }
    nloc = mine > 0u ? mine : 1u; nx = cnt > 0u ? cnt : 1u;
}

__device__ __forceinline__ void xcd_barrier(const XcdBarrier& b) {
    asm volatile("s_waitcnt vmcnt(0)" ::: "memory");
    __syncthreads();
    if (threadIdx.x == 0) {
        unsigned* bar = b.bar;
        __builtin_amdgcn_s_waitcnt(0);
        unsigned nloc = b.st[0], nx = b.st[1];
        if (nloc == 0u) { xcd_barrier_complete(bar, b.x, nloc, nx); b.st[0] = nloc; b.st[1] = nx; }
        const unsigned old = xb_add(&bar[XB_XSUB(b.x)], 1u);
        const unsigned gen = old / nloc;
        if (old + 1u == (gen + 1u) * nloc) {
            __builtin_amdgcn_fence(__ATOMIC_RELEASE, "agent");
            asm volatile("s_waitcnt vmcnt(0)" ::: "memory");
            const unsigned og = xb_add(&bar[XB_TOP], 1u);
            const unsigned tg = og / nx;
            if (og + 1u == (tg + 1u) * nx) xb_add(&bar[XB_TOPGEN], 1u);
            else XB_SPIN(xb_ld(&bar[XB_TOPGEN]) == tg, bar);
            __builtin_amdgcn_fence(__ATOMIC_ACQUIRE, "agent");
            xb_add(&bar[XB_XGEN(b.x)], 1u);
            asm volatile("s_waitcnt vmcnt(0)" ::: "memory");
        } else {
            XB_SPIN(xb_ld(&bar[XB_XGEN(b.x)]) == gen, bar);
            __builtin_amdgcn_fence(__ATOMIC_ACQUIRE, "agent");
            asm volatile("s_waitcnt vmcnt(0)" ::: "memory");
        }
    }
    __syncthreads();
}
namespace fx {
#define DI __device__ __forceinline__
typedef unsigned short bf16;
typedef short bf16x8 __attribute__((ext_vector_type(8)));
typedef float f32x4 __attribute__((ext_vector_type(4)));
typedef float f32x2 __attribute__((ext_vector_type(2)));
typedef unsigned u32x4 __attribute__((ext_vector_type(4)));
typedef unsigned u32x2 __attribute__((ext_vector_type(2)));
constexpr int M0 = BATCH * SEQ, MP = M0 + DEC_BATCH, MPAD = ((MP + 255) / 256) * 256;
constexpr int ACOLS = DIL_COLS + MEM_COLS, BCOLS = NSA_Q_COLS + NSA_GATE_COLS + MEM_COLS, KVCOLS = 6 * NSA_KV_HEADS * HEAD_DIM;
constexpr int NB_T = 2048;
constexpr int NPK = PEER_HEADS * 2 * PEER_KEYS;
constexpr int NCMP = (SEQ - CMP_BLOCK) / CMP_STRIDE + 1;
constexpr int NCH = SEQ / CMP_STRIDE;
constexpr int NCTX = BATCH + DEC_BATCH;
constexpr int ACROWS = NCTX * NSA_KV_HEADS * NCH;
constexpr int NPOS = PAST_LEN + 1;
constexpr float QSCALE = 0.125f * 1.4426950408889634f;
constexpr int NTHREADS = 512, NWAVES = 8, LDS_BYTES = 147456, RING_BYTES = 131072, MISC_OFF = RING_BYTES + 320;

struct FP {
    const float *x_prompt, *x_sample, *mem_prompt, *cache_dil[3], *cache_nsa_kv, *cache_nsa_win, *cache_mem_kv; const int* page_table;
    const float *w_in_a, *w_out_a, *w_in_b, *w_out_b, *w_mem_kv, *w_kv_b, *cmp_pe, *cmp_w1, *cmp_w2, *ln_g, *ln_b, *peer_wq, *peer_keys, *peer_u, *peer_v;
    float *y_prompt, *y_sample, *dil_p[3], *dil_s[3], *nsa_kv_p, *nsa_kv_s, *win_p, *win_s, *mem_kv_p;
    unsigned* ctl;
    bf16 *XB0, *X1B, *X2B, *X3B, *WA_T, *WMEM_T, *MEMB, *WOA_T, *WOB_T, *WPK_T, *WB_T, *CW1_T, *AC; unsigned char *UB8, *VB8;
    float *ROPE, *CBIAS;
    bf16 *QA, *KA, *VTA, *MQA, *MK, *MVT, *ATTA;
    float *DPART, *DML, *PRE, *X1, *X2, *X3, *SCO, *SELG; int* SELE;
    bf16 *SLK, *SLVT, *WNK, *WNVT, *QB, *MQB, *CK, *CVT, *ATTB;
    float *GATES, *UL, *CKF, *CVF;
    int* SELB;
    float* DBG;
};
struct Args { FP p; int lo, hi; };
struct Carve { size_t off = 0; template <class T> T* take(void* base, size_t n) { T* r = (T*)((char*)base + off); off += ((n * sizeof(T) + 255) / 256) * 256; return r; } };
constexpr size_t CTL_BYTES = 65536;
inline size_t carve(FP& p, void* base) {
    Carve c;
    p.ctl = c.take<unsigned>(base, CTL_BYTES / 4);
    p.XB0 = c.take<bf16>(base, (size_t)MPAD * D_MODEL); p.X1B = c.take<bf16>(base, (size_t)MPAD * D_MODEL); p.X2B = c.take<bf16>(base, (size_t)MPAD * D_MODEL); p.X3B = c.take<bf16>(base, (size_t)MPAD * D_MODEL);
    p.WA_T = c.take<bf16>(base, (size_t)ACOLS * D_MODEL); p.WMEM_T = c.take<bf16>(base, (size_t)DEPTH * 2 * MEM_COLS * D_MODEL); p.MEMB = c.take<bf16>(base, (size_t)BATCH * MEM_TOKENS * D_MODEL);
    p.WOA_T = c.take<bf16>(base, (size_t)D_MODEL * 2 * MEM_COLS); p.WOB_T = c.take<bf16>(base, (size_t)D_MODEL * (NSA_Q_COLS + MEM_COLS));
    p.WPK_T = c.take<bf16>(base, (size_t)DEPTH * NPK * D_MODEL); p.WB_T = c.take<bf16>(base, (size_t)NB_T * D_MODEL);
    p.UB8 = c.take<unsigned char>(base, (size_t)DEPTH * PEER_EXPERTS * D_MODEL); p.VB8 = c.take<unsigned char>(base, (size_t)DEPTH * PEER_EXPERTS * D_MODEL);
    p.CW1_T = c.take<bf16>(base, (size_t)2 * 256 * 1024); p.AC = c.take<bf16>(base, (size_t)2 * ACROWS * 1024);
    p.ROPE = c.take<float>(base, (size_t)NPOS * 64); p.CBIAS = c.take<float>(base, 2 * CMP_HIDDEN);
    p.QA = c.take<bf16>(base, (size_t)3 * MPAD * 256); p.KA = c.take<bf16>(base, (size_t)3 * MPAD * 256); p.VTA = c.take<bf16>(base, (size_t)3 * BATCH * DIL_HEADS * HEAD_DIM * SEQ + 4096);
    p.MQA = c.take<bf16>(base, (size_t)MPAD * 256); p.MK = c.take<bf16>(base, (size_t)DEPTH * BATCH * MEM_TOKENS * MEM_COLS); p.MVT = c.take<bf16>(base, (size_t)DEPTH * BATCH * MEM_COLS * MEM_TOKENS);
    p.ATTA = c.take<bf16>(base, (size_t)MPAD * 2 * MEM_COLS);
    p.DPART = c.take<float>(base, (size_t)3 * MP * DIL_HEADS * HEAD_DIM); p.DML = c.take<float>(base, (size_t)3 * MP * DIL_HEADS * 2);
    p.PRE = c.take<float>(base, (size_t)MPAD * D_MODEL); p.X1 = c.take<float>(base, (size_t)MPAD * D_MODEL); p.X2 = c.take<float>(base, (size_t)MPAD * D_MODEL); p.X3 = c.take<float>(base, (size_t)MPAD * D_MODEL);
    p.SCO = c.take<float>(base, (size_t)MPAD * NPK); p.SELG = c.take<float>(base, (size_t)MP * 128); p.SELE = c.take<int>(base, (size_t)MP * 128);
    p.SLK = c.take<bf16>(base, (size_t)BATCH * NSA_KV_HEADS * SEQ * HEAD_DIM); p.SLVT = c.take<bf16>(base, (size_t)BATCH * NSA_KV_HEADS * SEQ * HEAD_DIM);
    p.WNK = c.take<bf16>(base, (size_t)BATCH * NSA_KV_HEADS * SEQ * HEAD_DIM + 4096); p.WNVT = c.take<bf16>(base, (size_t)BATCH * NSA_KV_HEADS * SEQ * HEAD_DIM + 4096);
    p.QB = c.take<bf16>(base, (size_t)MPAD * NSA_Q_COLS); p.MQB = c.take<bf16>(base, (size_t)MPAD * 256);
    p.CK = c.take<bf16>(base, (size_t)NCTX * NSA_KV_HEADS * NCH * HEAD_DIM); p.CVT = c.take<bf16>(base, (size_t)NCTX * NSA_KV_HEADS * HEAD_DIM * NCH); p.ATTB = c.take<bf16>(base, (size_t)MPAD * (NSA_Q_COLS + MEM_COLS));
    p.GATES = c.take<float>(base, (size_t)MPAD * 64); p.UL = c.take<float>(base, (size_t)2 * ACROWS * 256);
    p.CKF = c.take<float>(base, (size_t)DEC_BATCH * NSA_KV_HEADS * NCH * HEAD_DIM); p.CVF = c.take<float>(base, (size_t)DEC_BATCH * NSA_KV_HEADS * NCH * HEAD_DIM);
    p.SELB = c.take<int>(base, (size_t)MP * NSA_KV_HEADS * 16);
#ifdef NSA_DEBUG
    p.DBG = c.take<float>(base, (size_t)3 * MP * 768);
#else
    p.DBG = nullptr;
#endif
    return c.off;
}
inline void bind_io(FP& p, void* const* d_in, float* out) {
    p.x_prompt = (const float*)d_in[0]; p.x_sample = (const float*)d_in[1]; p.mem_prompt = (const float*)d_in[2]; p.cache_dil[0] = (const float*)d_in[3]; p.cache_dil[1] = (const float*)d_in[4]; p.cache_dil[2] = (const float*)d_in[5];
    p.cache_nsa_kv = (const float*)d_in[6]; p.cache_nsa_win = (const float*)d_in[7]; p.cache_mem_kv = (const float*)d_in[8]; p.page_table = (const int*)d_in[9];
    p.w_in_a = (const float*)d_in[10]; p.w_out_a = (const float*)d_in[11]; p.w_in_b = (const float*)d_in[12]; p.w_out_b = (const float*)d_in[13]; p.w_mem_kv = (const float*)d_in[14]; p.w_kv_b = (const float*)d_in[15];
    p.cmp_pe = (const float*)d_in[16]; p.cmp_w1 = (const float*)d_in[17]; p.cmp_w2 = (const float*)d_in[18]; p.ln_g = (const float*)d_in[19]; p.ln_b = (const float*)d_in[20];
    p.peer_wq = (const float*)d_in[21]; p.peer_keys = (const float*)d_in[22]; p.peer_u = (const float*)d_in[23]; p.peer_v = (const float*)d_in[24];
    size_t o = 0; auto take = [&](size_t n) { float* r = out + o; o += n; return r; };
    p.y_prompt = take((size_t)M0 * D_MODEL); p.y_sample = take((size_t)DEC_BATCH * D_MODEL);
    for (int g = 0; g < 3; ++g) p.dil_p[g] = take((size_t)BATCH * DIL_W[g] * 2 * DIL_HEADS * HEAD_DIM);
    for (int g = 0; g < 3; ++g) p.dil_s[g] = take((size_t)DEC_BATCH * DIL_W[g] * 2 * DIL_HEADS * HEAD_DIM);
    p.nsa_kv_p = take((size_t)M0 * 4 * NSA_KV_HEADS * HEAD_DIM); p.nsa_kv_s = take((size_t)DEC_BATCH * 4 * NSA_KV_HEADS * HEAD_DIM);
    p.win_p = take((size_t)BATCH * SWA_WINDOW * 2 * NSA_KV_HEADS * HEAD_DIM); p.win_s = take((size_t)DEC_BATCH * SWA_WINDOW * 2 * NSA_KV_HEADS * HEAD_DIM);
    p.mem_kv_p = take((size_t)DEPTH * BATCH * MEM_TOKENS * 2 * MEM_COLS);
}
DI unsigned f2bf(float f) { unsigned u = __builtin_bit_cast(unsigned, f); return (u + 0x7fffu + ((u >> 16) & 1u)) >> 16; }
DI unsigned pk2(float lo, float hi) { return f2bf(lo) | (f2bf(hi) << 16); }
DI float bf2f(unsigned short b) { return __builtin_bit_cast(float, (unsigned)b << 16); }
DI float bflo(unsigned w) { return __builtin_bit_cast(float, w << 16); }
DI float bfhi(unsigned w) { return __builtin_bit_cast(float, w & 0xffff0000u); }
DI float wave_sum(float v) {
#pragma unroll
    for (int o = 1; o < 64; o <<= 1) v += __shfl_xor(v, o);
    return v; }
DI float wave_max(float v) {
#pragma unroll
    for (int o = 1; o < 64; o <<= 1) v = fmaxf(v, __shfl_xor(v, o));
    return v; }
DI float gelu_tanh(float x) { const float u = 0.7978845608028654f * (x + 0.044715f * x * x * x); const float e = __builtin_amdgcn_exp2f(u * 2.885390081777927f);   const float t = 1.0f - 2.0f / (e + 1.0f); return 0.5f * x * (1.0f + t); }
DI float* sel3(float* const (&a)[3], int g) { return g == 0 ? a[0] : (g == 1 ? a[1] : a[2]); }
DI const float* sel3c(const float* const (&a)[3], int g) { return g == 0 ? a[0] : (g == 1 ? a[1] : a[2]); }
__host__ DI size_t ktile_off(int t, int d) { const int blk = t >> 5, kk = t & 31, b = (kk >> 2) & 1, i = 4 * (kk >> 3) + (kk & 3), s = d >> 5, c = (d & 31) >> 3; return ((size_t)(blk * 4 + 2 * b + s) * 64 + i + 16 * c) * 8 + (d & 7); }
__host__ DI size_t vtile_off(int dim, int t) { const int blk = t >> 5, kk = t & 31; return ((size_t)(blk * 4 + (dim >> 4)) * 64 + (dim & 15) + 16 * (kk >> 3)) * 8 + (kk & 7); }
struct Ctx { LAS unsigned char* lds; int tid, lane, wave, vcu, G; };
DI int row_pos(int r) { return r < M0 ? (r & (SEQ - 1)) : PAST_LEN; }

struct ColSrc { const float* p; int ld; };
DI int rope_il(int e) { return (e >> 1) + 32 * (e & 1); }
DI ColSrc col_wa(const FP& P, int n) {
    const int t = n >> 8, ct = n & 255, h = ct >> 6, e = ct & 63; if (t >= 9) return ColSrc{P.w_in_a + DIL_COLS + ct, ACOLS};
    const int j = t % 3, d = (j < 2) ? rope_il(e) : e; return ColSrc{P.w_in_a + t * 256 + h * 64 + d, ACOLS}; }
DI ColSrc col_wb(const FP& P, int n) {
    const int t = n >> 8, ct = n & 255, e = ct & 63;
    if (t < 3) { const int ty = 2 * t + (ct >> 7), kvh = (ct >> 6) & 1; const bool rot = (ty == 2 || ty == 4); return ColSrc{P.w_kv_b + (ty * NSA_KV_HEADS + kvh) * 64 + (rot ? rope_il(e) : e), KVCOLS}; }
    if (t < 6) { const int h = (t - 3) * 4 + (ct >> 6); return ColSrc{P.w_in_b + h * 64 + rope_il(e), BCOLS}; }
    if (t == 6) return ColSrc{P.w_in_b + NSA_Q_COLS + NSA_GATE_COLS + ct, BCOLS};
    if (ct < NSA_GATE_COLS) return ColSrc{P.w_in_b + NSA_Q_COLS + ct, BCOLS};
    return ColSrc{nullptr, 0}; }
DI ColSrc col_wmem(const FP& P, int n) { const int l = n >> 9, c = n & 511; return ColSrc{P.w_mem_kv + (size_t)l * D_MODEL * 512 + c, 512}; }
DI ColSrc col_woa(const FP& P, int n) { return ColSrc{P.w_out_a + n, D_MODEL}; }
DI ColSrc col_wob(const FP& P, int n) { return ColSrc{P.w_out_b + n, D_MODEL}; }
DI ColSrc col_cw1(const FP& P, int n) {
    const int ty = n >> 8, half = (n >> 7) & 1, hid = n & 127; return ColSrc{P.cmp_w1 + (size_t)ty * CMP_BLOCK * HEAD_DIM * CMP_HIDDEN + (size_t)half * 16 * HEAD_DIM * CMP_HIDDEN + hid, CMP_HIDDEN}; }
template <class CF> DI void transpose_item(const FP& P, CF cf, int K, bf16* WT, LAS float* scr, int item, int nblk, int lane) {
    const int kb = item / nblk, nb = item % nblk, k0 = 64 * kb, n0 = 32 * nb;
    const ColSrc cs = cf(P, n0 + (lane & 31));
#pragma unroll 8
    for (int i = 0; i < 32; ++i) { const int kk = 2 * i + (lane >> 5); scr[kk * 33 + (lane & 31)] = cs.p ? cs.p[(size_t)(k0 + kk) * cs.ld] : 0.f; }
    asm volatile("s_waitcnt lgkmcnt(0)" ::: "memory");
    const int c = lane & 7;
#pragma unroll
    for (int j = 0; j < 4; ++j) { const int n = (lane >> 3) + 8 * j; const LAS float* s = scr + (8 * c) * 33 + n;
        u32x4 o; o.x = pk2(s[0 * 33], s[1 * 33]); o.y = pk2(s[2 * 33], s[3 * 33]); o.z = pk2(s[4 * 33], s[5 * 33]); o.w = pk2(s[6 * 33], s[7 * 33]);
        *(u32x4*)(WT + (size_t)(n0 + n) * K + k0 + 8 * c) = o; }
    asm volatile("s_waitcnt lgkmcnt(0)" ::: "memory");
}
DI void cvt_row1024(const float* src, bf16* dst, int lane) {
#pragma unroll
    for (int j = 0; j < 4; ++j) { f32x4 v = src ? *(const f32x4*)(src + 256 * j + 4 * lane) : (f32x4){0.f, 0.f, 0.f, 0.f}; u32x2 o; o.x = pk2(v.x, v.y); o.y = pk2(v.z, v.w); *(u32x2*)(dst + 256 * j + 4 * lane) = o; }
}
DI void cvt_row1024_fp8(const float* src, unsigned char* dst, float sc, int lane) { u32x4 o; unsigned w[4];
#pragma unroll
    for (int j = 0; j < 4; ++j) { const f32x4 v = *(const f32x4*)(src + 16 * lane + 4 * j) * sc; int t = __builtin_amdgcn_cvt_pk_fp8_f32(v.x, v.y, 0, false); t = __builtin_amdgcn_cvt_pk_fp8_f32(v.z, v.w, t, true); w[j] = (unsigned)t; }
    o.x = w[0]; o.y = w[1]; o.z = w[2]; o.w = w[3]; *(u32x4*)(dst + 16 * lane) = o; }
DI void p0_prologue(const FP& P, const Ctx& C) {
    LAS float* scr = (LAS float*)(C.lds + C.wave * 16384);
    const int gw = C.vcu * NWAVES + C.wave, NGW = C.G * NWAVES, lane = C.lane;
    { constexpr int IA = (D_MODEL / 64) * (ACOLS / 32), IM = (D_MODEL / 64) * (1024 / 32), IOA = (512 / 64) * (D_MODEL / 32), IOB = (1024 / 64) * (D_MODEL / 32), IB = (D_MODEL / 64) * (NB_T / 32), IC = (1024 / 64) * (512 / 32);
      constexpr int NIT = IA + IM + IOA + IOB + IB + IC;
      for (int it = gw; it < NIT; it += NGW) { int r = it;
          if (r < IA) { transpose_item(P, col_wa, D_MODEL, P.WA_T, scr, r, ACOLS / 32, lane); continue; } r -= IA;
          if (r < IM) { transpose_item(P, col_wmem, D_MODEL, P.WMEM_T, scr, r, 1024 / 32, lane); continue; } r -= IM;
          if (r < IOA) { transpose_item(P, col_woa, 512, P.WOA_T, scr, r, D_MODEL / 32, lane); continue; } r -= IOA;
          if (r < IOB) { transpose_item(P, col_wob, 1024, P.WOB_T, scr, r, D_MODEL / 32, lane); continue; } r -= IOB;
          if (r < IB) { transpose_item(P, col_wb, D_MODEL, P.WB_T, scr, r, NB_T / 32, lane); continue; } r -= IB;
          transpose_item(P, col_cw1, 1024, P.CW1_T, scr, r, 512 / 32, lane); } }
    for (int r = gw; r < MPAD; r += NGW) { cvt_row1024(r < M0 ? P.x_prompt + (size_t)r * D_MODEL : (r < MP ? P.x_sample + (size_t)(r - M0) * D_MODEL : nullptr), P.XB0 + (size_t)r * D_MODEL, lane);
        if (r >= MP) { cvt_row1024(nullptr, P.X1B + (size_t)r * D_MODEL, lane); cvt_row1024(nullptr, P.X2B + (size_t)r * D_MODEL, lane); cvt_row1024(nullptr, P.X3B + (size_t)r * D_MODEL, lane);
            for (int c = lane; c < 512; c += 64) { P.ATTA[(size_t)r * 512 + c] = 0; P.ATTB[(size_t)r * 1024 + c] = 0; P.ATTB[(size_t)r * 1024 + 512 + c] = 0; } } }
    for (int r = gw; r < BATCH * MEM_TOKENS; r += NGW) cvt_row1024(P.mem_prompt + (size_t)r * D_MODEL, P.MEMB + (size_t)r * D_MODEL, lane);
#pragma unroll 1
    for (int r = 2 * gw; r < DEPTH * PEER_EXPERTS; r += 2 * NGW) { f32x4 a[16];
#pragma unroll
        for (int q = 0; q < 4; ++q) { const float* s0 = (q < 2 ? P.peer_u : P.peer_v) + (size_t)(r + (q & 1)) * D_MODEL + 16 * lane;
#pragma unroll
            for (int j = 0; j < 4; ++j) a[4 * q + j] = *(const f32x4*)(s0 + 4 * j); }
#pragma unroll
        for (int q = 0; q < 4; ++q) { const float sc = q < 2 ? 256.f : 64.f; unsigned w[4];
#pragma unroll
            for (int j = 0; j < 4; ++j) { const f32x4 v = a[4 * q + j] * sc; int t = __builtin_amdgcn_cvt_pk_fp8_f32(v.x, v.y, 0, false); t = __builtin_amdgcn_cvt_pk_fp8_f32(v.z, v.w, t, true); w[j] = (unsigned)t; }
            u32x4 o; o.x = w[0]; o.y = w[1]; o.z = w[2]; o.w = w[3]; *(u32x4*)((q < 2 ? P.UB8 : P.VB8) + (size_t)(r + (q & 1)) * D_MODEL + 16 * lane) = o; } }
    for (int i = gw * 64 + lane; i < NPOS * 32; i += NGW * 64) { const int pos = i >> 5, d = i & 31; const double inv = exp2(-(double)d * (13.287712379549449 / 32.0)); const double turns = (double)pos * inv * 0.15915494309189535;
        const float fr = (float)(turns - floor(turns)); P.ROPE[pos * 64 + d] = __builtin_amdgcn_cosf(fr); P.ROPE[pos * 64 + 32 + d] = __builtin_amdgcn_sinf(fr); }
    for (int i = gw; i < 2 * CMP_HIDDEN; i += NGW) { const int ty = i / CMP_HIDDEN, hid = i % CMP_HIDDEN; float a = 0.f;
#pragma unroll 8
        for (int k = lane; k < CMP_BLOCK * HEAD_DIM; k += 64) a += P.cmp_pe[ty * CMP_BLOCK * HEAD_DIM + k] * P.cmp_w1[((size_t)ty * CMP_BLOCK * HEAD_DIM + k) * CMP_HIDDEN + hid];
        a = wave_sum(a); if (lane == 0) P.CBIAS[i] = a; }
    for (int it = gw; it < DEC_BATCH * (PAST_LEN / PAGE_SIZE); it += NGW) { const int n = it / (PAST_LEN / PAGE_SIZE), pi = it % (PAST_LEN / PAGE_SIZE); const int pg = P.page_table[it];
        const float* src = P.cache_nsa_kv + (size_t)pg * PAGE_SIZE * 512 + 4 * lane; const int ty = lane >> 5, kvh = (lane >> 4) & 1, d = (4 * lane) & 63;
        bf16* dst = P.AC + ((size_t)ty * ACROWS + ((size_t)(BATCH + n) * NSA_KV_HEADS + kvh) * NCH + pi * (PAGE_SIZE / 16)) * 1024 + d;
#pragma unroll 1
        for (int r0 = 0; r0 < PAGE_SIZE; r0 += 8) { f32x4 v[8];
#pragma unroll
            for (int u = 0; u < 8; ++u) v[u] = *(const f32x4*)(src + (size_t)(r0 + u) * 512);
#pragma unroll
            for (int u = 0; u < 8; ++u) { const int t = r0 + u; u32x2 o; o.x = pk2(v[u].x, v[u].y); o.y = pk2(v[u].z, v[u].w); *(u32x2*)(dst + (size_t)(t / 16) * 1024 + (t % 16) * 64) = o; } } }
    for (int g = 0; g < 4; ++g) { const int W = g < 3 ? dil_w(g) : SWA_WINDOW, RV = g < 3 ? 128 : 64;
        const f32x4* src = (const f32x4*)(g < 3 ? sel3c(P.cache_dil, g) : P.cache_nsa_win); f32x4* dst = (f32x4*)(g < 3 ? sel3(P.dil_s, g) : P.win_s);
        const long per = (long)(W - 1) * RV, nvec = (long)DEC_BATCH * per;
#pragma unroll 1
        for (long i0 = (long)gw * 512; i0 < nvec; i0 += (long)NGW * 512) { f32x4 v[8]; long idx[8];
#pragma unroll
            for (int u = 0; u < 8; ++u) { const long i = i0 + u * 64 + lane; const long ii = i < nvec ? i : nvec - 1; const long n = ii / per, o = ii % per; idx[u] = n * (per + RV) + o; v[u] = src[idx[u] + RV]; }
#pragma unroll
            for (int u = 0; u < 8; ++u) { const long i = i0 + u * 64 + lane; if (i < nvec) dst[idx[u]] = v[u]; } } }
}
DI void p0_wpk(const FP& P, const Ctx& C) {
    LAS float* sw = (LAS float*)C.lds;
    LAS float* sk = (LAS float*)(C.lds + 32768);
    constexpr int NIT = DEPTH * 16 * (D_MODEL / 64);
    for (int it = C.vcu; it < NIT; it += C.G) { const int l = it / (16 * (D_MODEL / 64)), rem = it % (16 * (D_MODEL / 64)), hc = rem / (D_MODEL / 64), kb = rem % (D_MODEL / 64);
        __syncthreads();
        for (int i = C.tid; i < 64 * 64; i += NTHREADS) { const int r = i >> 6, d = i & 63; sw[r * 65 + d] = P.peer_wq[((size_t)l * D_MODEL + kb * 64 + r) * 1024 + hc * 64 + d]; }
        for (int i = C.tid; i < 128 * 64; i += NTHREADS) { const int r = i >> 6, d = i & 63; sk[r * 65 + d] = P.peer_keys[(((size_t)l * 16 + hc) * PEER_KEYS + r) * 64 + d]; }
        __syncthreads();
        for (int o = C.tid; o < 128 * 64; o += NTHREADS) { const int kk = o >> 6, ki = o & 63; float a = 0.f;
#pragma unroll 16
            for (int d = 0; d < 64; ++d) a += sw[ki * 65 + d] * sk[kk * 65 + d];
            P.WPK_T[((size_t)l * NPK + hc * 128 + kk) * D_MODEL + kb * 64 + ki] = (bf16)f2bf(a); } }
    __syncthreads();
}

#define EPI_LOOP(...) int fr_l = fr, fq_l = fq; asm volatile("" : "+v"(fr_l), "+v"(fq_l));     \
    _Pragma("unroll") for (int ai = 0; ai < 2; ++ai) _Pragma("unroll") for (int m = 0; m < 4; ++m) { const int row = u.pm * 256 + ai * 128 + wr * 64 + m * 16 + fr_l; \
    _Pragma("unroll") for (int bj = 0; bj < 2; ++bj) { const int ct = bj * 128 + wc * 32 + fq_l * 8; const f32x4 v0 = acc[ai][bj][m][0], v1 = acc[ai][bj][m][1]; __VA_ARGS__ } asm volatile("" ::: "memory"); }
DI void rope4(const float* rope_row, int dp, const f32x4& v0, const f32x4& v1, f32x4& lo, f32x4& hi) {
    const f32x4 c = *(const f32x4*)(rope_row + dp), s = *(const f32x4*)(rope_row + 32 + dp);
    lo.x = v0.x * c.x - v0.y * s.x; hi.x = v0.y * c.x + v0.x * s.x; lo.y = v0.z * c.y - v0.w * s.y; hi.y = v0.w * c.y + v0.z * s.y;
    lo.z = v1.x * c.z - v1.y * s.z; hi.z = v1.y * c.z + v1.x * s.z; lo.w = v1.z * c.w - v1.w * s.w; hi.w = v1.w * c.w + v1.z * s.w; }
DI u32x2 pk4(const f32x4& v) { u32x2 o; o.x = pk2(v.x, v.y); o.y = pk2(v.z, v.w); return o; }
DI u32x4 pk8(const f32x4& a, const f32x4& b) { u32x4 o; o.x = pk2(a.x, a.y); o.y = pk2(a.z, a.w); o.z = pk2(b.x, b.y); o.w = pk2(b.z, b.w); return o; }
DI int dil_perm(int t, int d) { return (t % d) * (SEQ / d) + t / d; }
struct EpiA {
    static constexpr bool PERM = true, AFTER_DRAIN = false; const FP& P;
    DI void operator()(const f32x4 (&acc)[2][2][4][2], const pg8::Unit& u, int wr, int wc, int fr, int fq) const {
        const int t9 = u.pn; const int g = t9 / 3, j = t9 % 3;
        EPI_LOOP({ if (row < MP) { const int h = ct >> 6, e = ct & 63; const int pos = row_pos(row);
            if (t9 == 9) { *(u32x4*)(P.MQA + (size_t)row * 256 + ct) = pk8(v0 * QSCALE, v1 * QSCALE); }
            else if (j < 2) { f32x4 lo, hi; const int dp = e >> 1; rope4(P.ROPE + pos * 64, dp, v0, v1, lo, hi);
                if (j == 0) { bf16* q = P.QA + ((size_t)g * MPAD + row) * 256 + h * 64 + dp; *(u32x2*)q = pk4(lo * QSCALE); *(u32x2*)(q + 32) = pk4(hi * QSCALE); }
                else { if (row < M0) { bf16* kt = P.KA + ((size_t)(g * BATCH + row / SEQ) * DIL_HEADS + h) * 64 * SEQ; const int cm = dil_perm(pos, dil_d(g)); *(u32x2*)(kt + ktile_off(cm, dp)) = pk4(lo); *(u32x2*)(kt + ktile_off(cm, dp + 32)) = pk4(hi); }
                    const int W = dil_w(g); float* o = nullptr;
                    if (row >= M0) o = sel3(P.dil_s, g) + (((size_t)(row - M0) * W + W - 1) * 2 + 0) * 256; else if (pos >= SEQ - W) o = sel3(P.dil_p, g) + (((size_t)(row / SEQ) * W + pos - (SEQ - W)) * 2 + 0) * 256;
                    if (o) { *(f32x4*)(o + h * 64 + dp) = lo; *(f32x4*)(o + h * 64 + 32 + dp) = hi; } } }
            else { const int W = dil_w(g), d = dil_d(g); float* o = nullptr;
                if (row >= M0) o = sel3(P.dil_s, g) + (((size_t)(row - M0) * W + W - 1) * 2 + 1) * 256; else if (pos >= SEQ - W) o = sel3(P.dil_p, g) + (((size_t)(row / SEQ) * W + pos - (SEQ - W)) * 2 + 1) * 256;
                if (o) { *(f32x4*)(o + ct) = v0; *(f32x4*)(o + ct + 4) = v1; }
                if (row < M0) { bf16* vt = P.VTA + ((size_t)(g * BATCH + row / SEQ) * DIL_HEADS + h) * 64 * SEQ + vtile_off(e, dil_perm(pos, d));
                    vt[0] = (bf16)f2bf(v0.x); vt[8] = (bf16)f2bf(v0.y); vt[16] = (bf16)f2bf(v0.z); vt[24] = (bf16)f2bf(v0.w); vt[32] = (bf16)f2bf(v1.x); vt[40] = (bf16)f2bf(v1.y); vt[48] = (bf16)f2bf(v1.z); vt[56] = (bf16)f2bf(v1.w); } } } })
    }
};
struct EpiMem {
    static constexpr bool PERM = true, AFTER_DRAIN = false; const FP& P;
    DI void operator()(const f32x4 (&acc)[2][2][4][2], const pg8::Unit& u, int wr, int wc, int fr, int fq) const {
        const int l = u.pn >> 1, half = u.pn & 1;
        EPI_LOOP({ const int n = row / MEM_TOKENS, mt = row % MEM_TOKENS; float* o = P.mem_kv_p + (((size_t)l * BATCH + n) * MEM_TOKENS + mt) * 512 + half * 256 + ct; *(f32x4*)o = v0; *(f32x4*)(o + 4) = v1;
            if (half == 0) *(u32x4*)(P.MK + (((size_t)l * BATCH + n) * MEM_HEADS + (ct >> 6)) * MEM_TOKENS * 64 + ktile_off(mt, ct & 63)) = pk8(v0, v1);
            else { bf16* vt = P.MVT + (((size_t)l * BATCH + n) * MEM_HEADS + (ct >> 6)) * MEM_TOKENS * 64 + vtile_off(ct & 63, mt);
                vt[0] = (bf16)f2bf(v0.x); vt[8] = (bf16)f2bf(v0.y); vt[16] = (bf16)f2bf(v0.z); vt[24] = (bf16)f2bf(v0.w); vt[32] = (bf16)f2bf(v1.x); vt[40] = (bf16)f2bf(v1.y); vt[48] = (bf16)f2bf(v1.z); vt[56] = (bf16)f2bf(v1.w); } })
    }
};
struct EpiPre {
    static constexpr bool PERM = true, AFTER_DRAIN = false; const float* xa; const float* xb; float* pre;
    DI void operator()(const f32x4 (&acc)[2][2][4][2], const pg8::Unit& u, int wr, int wc, int fr, int fq) const {
        EPI_LOOP({ if (row < MP) { const int col = u.pn * 256 + ct; const float* x = (xb && row >= M0) ? xb + (size_t)(row - M0) * D_MODEL + col : xa + (size_t)row * D_MODEL + col;
            const f32x4 a = *(const f32x4*)x, b = *(const f32x4*)(x + 4); float* o = pre + (size_t)row * D_MODEL + col; *(f32x4*)o = a * ALPHA + v0; *(f32x4*)(o + 4) = b * ALPHA + v1; } })
    }
};
struct EpiF32 {
    static constexpr bool PERM = true, AFTER_DRAIN = false; float* out; int ldc; int nrows;
    DI void operator()(const f32x4 (&acc)[2][2][4][2], const pg8::Unit& u, int wr, int wc, int fr, int fq) const {
        EPI_LOOP({ if (row < nrows) { float* o = out + (size_t)row * ldc + u.pn * 256 + ct; *(f32x4*)o = v0; *(f32x4*)(o + 4) = v1; } })
    }
};
}
namespace fx {
struct Tile16 { f32x4 o[4]; float m, l; };
DI void tile_init(Tile16& T) { T.o[0] = T.o[1] = T.o[2] = T.o[3] = (f32x4){0.f, 0.f, 0.f, 0.f}; T.m = -INFINITY; T.l = 0.f; }
typedef __bf16 bf16x2_t __attribute__((ext_vector_type(2)));
DI unsigned cvtpk(float lo, float hi) { const f32x2 v = {lo, hi}; const bf16x2_t b = __builtin_convertvector(v, bf16x2_t); return __builtin_bit_cast(unsigned, b); }
struct KV8 { bf16x8 ka0, ka1, kb0, kb1, v0, v1, v2, v3; };
DI void kv_load(KV8& r, const bf16* k0, const bf16* k1, const bf16* v, long vs16) {
    r.ka0 = *(const bf16x8*)k0; r.ka1 = *(const bf16x8*)(k0 + 32); r.kb0 = *(const bf16x8*)k1; r.kb1 = *(const bf16x8*)(k1 + 32);
    r.v0 = *(const bf16x8*)v; r.v1 = *(const bf16x8*)(v + vs16); r.v2 = *(const bf16x8*)(v + 2 * vs16); r.v3 = *(const bf16x8*)(v + 3 * vs16); }
DI void mk_range(int a, int b, bool ok, int& lo, unsigned& rng) { const bool v = ok && b >= a; lo = v ? a : (1 << 20); rng = v ? (unsigned)(b - a) : 0u; }
DI void tile_compute(Tile16& T, const bf16x8 (&qf)[2], const KV8& r, int lo, unsigned rng) {
    f32x4 s0 = (f32x4){0.f, 0.f, 0.f, 0.f}, s1 = (f32x4){0.f, 0.f, 0.f, 0.f};
    s0 = __builtin_amdgcn_mfma_f32_16x16x32_bf16(r.ka0, qf[0], s0, 0, 0, 0); s0 = __builtin_amdgcn_mfma_f32_16x16x32_bf16(r.ka1, qf[1], s0, 0, 0, 0);
    s1 = __builtin_amdgcn_mfma_f32_16x16x32_bf16(r.kb0, qf[0], s1, 0, 0, 0); s1 = __builtin_amdgcn_mfma_f32_16x16x32_bf16(r.kb1, qf[1], s1, 0, 0, 0);
    float s[8] = {s0.x, s0.y, s0.z, s0.w, s1.x, s1.y, s1.z, s1.w};
    float mx = -INFINITY;
#pragma unroll
    for (int e = 0; e < 8; ++e) { s[e] = ((unsigned)(e - lo) <= rng) ? s[e] : -INFINITY; mx = fmaxf(mx, s[e]); }
    mx = fmaxf(mx, __shfl_xor(mx, 16)); mx = fmaxf(mx, __shfl_xor(mx, 32));
    const float mnew = fmaxf(T.m, mx), muse = (mnew == -INFINITY) ? 0.f : mnew;
    const float alpha = __builtin_amdgcn_exp2f(T.m - muse);
    float ls = 0.f;
#pragma unroll
    for (int e = 0; e < 8; ++e) { s[e] = __builtin_amdgcn_exp2f(s[e] - muse); ls += s[e]; }
    ls += __shfl_xor(ls, 16); ls += __shfl_xor(ls, 32);
    T.l = T.l * alpha + ls; T.m = mnew;
    u32x4 pw; pw.x = cvtpk(s[0], s[1]); pw.y = cvtpk(s[2], s[3]); pw.z = cvtpk(s[4], s[5]); pw.w = cvtpk(s[6], s[7]);
    const bf16x8 pf = __builtin_bit_cast(bf16x8, pw);
    T.o[0] = __builtin_amdgcn_mfma_f32_16x16x32_bf16(r.v0, pf, T.o[0] * alpha, 0, 0, 0); T.o[1] = __builtin_amdgcn_mfma_f32_16x16x32_bf16(r.v1, pf, T.o[1] * alpha, 0, 0, 0);
    T.o[2] = __builtin_amdgcn_mfma_f32_16x16x32_bf16(r.v2, pf, T.o[2] * alpha, 0, 0, 0); T.o[3] = __builtin_amdgcn_mfma_f32_16x16x32_bf16(r.v3, pf, T.o[3] * alpha, 0, 0, 0);
}
template <class BUF, class LD, class CP> DI void pipe2t(int n, LD ld, CP cp) { if (n <= 0) return; BUF A, B; ld(A, 0);
#pragma unroll 1
    for (int i = 0; i < n; i += 2) { ld(B, (i + 1 < n) ? i + 1 : i); cp(A, i); ld(A, (i + 2 < n) ? i + 2 : i); if (i + 1 < n) cp(B, i + 1); } }
template <class LD, class CP> DI void pipe2(int n, LD ld, CP cp) { if (n <= 0) return; KV8 A, B; ld(A, 0);
#pragma unroll 1
    for (int i = 0; i < n; i += 2) { ld(B, (i + 1 < n) ? i + 1 : i); cp(A, i); ld(A, (i + 2 < n) ? i + 2 : i); if (i + 1 < n) cp(B, i + 1); } }
DI void kv_load_t(KV8& r, const bf16* kt, const bf16* vt, int lane) {
    const bf16* k = kt + lane * 8; const bf16* v = vt + lane * 8;
    r.ka0 = *(const bf16x8*)k; r.ka1 = *(const bf16x8*)(k + 512); r.kb0 = *(const bf16x8*)(k + 1024); r.kb1 = *(const bf16x8*)(k + 1536);
    r.v0 = *(const bf16x8*)v; r.v1 = *(const bf16x8*)(v + 512); r.v2 = *(const bf16x8*)(v + 1024); r.v3 = *(const bf16x8*)(v + 1536); }
DI int krow_of(int i, int b) { return 8 * (i >> 2) + 4 * b + (i & 3); }

DI void dil_micro(const FP& P, int n, int h, int t0, int mt, int lane) {
    const int g = mt >> 4, idx = mt & 15, d = dil_d(g), per = 16 / d;
    const int r = idx / per, sub = idx % per, i0 = t0 / d + 16 * sub, ib = i0 - 128, NC = SEQ / d;
    const int q = lane & 15, c = lane >> 4;
    const bf16* Qb = P.QA + ((size_t)g * MPAD + (size_t)n * SEQ) * 256 + h * 64;
    const bf16* Kb = P.KA + ((size_t)(g * BATCH + n) * DIL_HEADS + h) * 64 * SEQ + (size_t)r * NC * 64; const bf16* Vb = P.VTA + ((size_t)(g * BATCH + n) * DIL_HEADS + h) * 64 * SEQ + (size_t)r * NC * 64;
    bf16x8 qf[2]; { const bf16* qp = Qb + (size_t)(r + d * (i0 + q)) * 256 + 8 * c; qf[0] = *(const bf16x8*)qp; qf[1] = *(const bf16x8*)(qp + 32); }
    Tile16 T; tile_init(T);
    const int qi = i0 + q; const int tb0 = ib >> 5  , nblk = ((i0 + 15) >> 5) - tb0 + 1;
    pipe2(nblk, [&](KV8& kv, int i) { int tb = tb0 + i; tb = tb < 0 ? 0 : tb; kv_load_t(kv, Kb + (size_t)tb * 2048, Vb + (size_t)tb * 2048, lane); },
          [&](const KV8& kv, int i) { const int k0 = 32 * (tb0 + i) + 8 * c; int lo; unsigned rng; const int a = qi - (DIL_TAPS - 1); mk_range((a > 0 ? a : 0) - k0, qi - k0, true, lo, rng); tile_compute(T, qf, kv, lo, rng); });
    const int row = n * SEQ + r + d * qi;
    float* op = P.DPART + (((size_t)g * MP + row) * DIL_HEADS + h) * 64 + 4 * c;
#pragma unroll
    for (int db = 0; db < 4; ++db) *(f32x4*)(op + 16 * db) = T.o[db];
    if (c == 0) { float* ml = P.DML + (((size_t)g * MP + row) * DIL_HEADS + h) * 2; ml[0] = T.m; ml[1] = T.l; }
}
DI void mem_micro(const FP& P, const bf16* Q  , int ldq, int row0, int layer, int n, int h, bf16* O  , int ldo, int lane) {
    const int q = lane & 15, c = lane >> 4;
    bf16x8 qf[2]; { const bf16* qp = Q + (size_t)(row0 + q) * ldq + 8 * c; qf[0] = *(const bf16x8*)qp; qf[1] = *(const bf16x8*)(qp + 32); }
    const bf16* Kb = P.MK + (((size_t)layer * BATCH + n) * MEM_HEADS + h) * MEM_TOKENS * 64; const bf16* Vb = P.MVT + (((size_t)layer * BATCH + n) * MEM_HEADS + h) * MEM_TOKENS * 64;
    Tile16 T; tile_init(T);
    pipe2(MEM_TOKENS / 32, [&](KV8& kv, int i) { kv_load_t(kv, Kb + (size_t)i * 2048, Vb + (size_t)i * 2048, lane); }, [&](const KV8& kv, int) { tile_compute(T, qf, kv, -8, 64u); });
    const float inv = 1.0f / T.l; bf16* op = O + (size_t)(row0 + q) * ldo + 4 * c;
#pragma unroll
    for (int db = 0; db < 4; ++db) *(u32x2*)(op + 16 * db) = pk4(T.o[db] * inv);
}
struct Dec { float m, l, o; };
template <class KF, class VF> DI void dec_chunk(Dec& D, const LAS float* q, int nk, KF kf, VF vf, int lane) {
    float s = -INFINITY;
    if (lane < nk) { const float* k = kf(lane); float a = 0.f;
#pragma unroll
        for (int d4 = 0; d4 < 16; ++d4) { const f32x4 kv = *(const f32x4*)(k + 4 * d4); a += kv.x * q[4 * d4] + kv.y * q[4 * d4 + 1] + kv.z * q[4 * d4 + 2] + kv.w * q[4 * d4 + 3]; }
        s = a; }
    const float mx = wave_max(s), mnew = fmaxf(D.m, mx), alpha = __builtin_amdgcn_exp2f(D.m - mnew);
    const float p = (lane < nk) ? __builtin_amdgcn_exp2f(s - mnew) : 0.f;
    D.l = D.l * alpha + wave_sum(p); D.m = mnew; float o = D.o * alpha;
    for (int j0 = 0; j0 < nk; j0 += 8) { float vv[8];
#pragma unroll
        for (int u = 0; u < 8; ++u) { const int jj = (j0 + u < nk) ? j0 + u : nk - 1; vv[u] = vf(jj)[lane]; }
#pragma unroll
        for (int u = 0; u < 8; ++u) { const float pj = (j0 + u < nk) ? __builtin_bit_cast(float, __builtin_amdgcn_readlane(__builtin_bit_cast(int, p), (j0 + u) & 63)) : 0.f; o += pj * vv[u]; } }
    D.o = o;
}
DI float dec_combine(const Ctx& C, const Dec& D) {
    LAS float* cb = (LAS float*)(C.lds + 4096);
    cb[C.wave * 66 + C.lane] = D.o; if (C.lane == 0) { cb[C.wave * 66 + 64] = D.m; cb[C.wave * 66 + 65] = D.l; }
    asm volatile("s_waitcnt lgkmcnt(0)" ::: "memory"); __syncthreads();
    float M = -INFINITY;
#pragma unroll
    for (int ww = 0; ww < NWAVES; ++ww) M = fmaxf(M, cb[ww * 66 + 64]);
    float L = 0.f, o = 0.f;
#pragma unroll
    for (int ww = 0; ww < NWAVES; ++ww) { const float mw = cb[ww * 66 + 64]; const float f = (mw == -INFINITY) ? 0.f : __builtin_amdgcn_exp2f(mw - M); L += f * cb[ww * 66 + 65]; o += f * cb[ww * 66 + C.lane]; }
    return o / L;
}
DI void atta_phase(const FP& P, const Ctx& C) {
    const int lane = C.lane, w = C.wave;
    constexpr int NT = SEQ / 256, NIT = BATCH * NT * DIL_HEADS;
    for (int it = C.vcu; it < NIT; it += C.G) { const int h = it % DIL_HEADS, tt = (it / DIL_HEADS) % NT, n = it / (DIL_HEADS * NT), t0 = tt * 256;
        for (int mt = w; mt < 48; mt += NWAVES) dil_micro(P, n, h, t0, mt, lane);
        asm volatile("s_waitcnt vmcnt(0)" ::: "memory"); __syncthreads();
        for (int i = C.tid; i < 256 * 16; i += NTHREADS) { const int tk = i >> 4, d4 = (i & 15) * 4; const int row = n * SEQ + t0 + tk;
            float mg[3], lg[3]; float M = -INFINITY;
#pragma unroll
            for (int g = 0; g < 3; ++g) { const float* ml = P.DML + (((size_t)g * MP + row) * DIL_HEADS + h) * 2; mg[g] = ml[0]; lg[g] = ml[1]; M = fmaxf(M, mg[g]); }
            f32x4 acc = (f32x4){0.f, 0.f, 0.f, 0.f}; float L = 0.f;
#pragma unroll
            for (int g = 0; g < 3; ++g) { const float wg = __builtin_amdgcn_exp2f(mg[g] - M); L += wg * lg[g]; acc += *(const f32x4*)(P.DPART + (((size_t)g * MP + row) * DIL_HEADS + h) * 64 + d4) * wg; }
            *(u32x2*)(P.ATTA + (size_t)row * 512 + h * 64 + d4) = pk4(acc * (1.0f / L)); }
        for (int mt = w; mt < 16; mt += NWAVES) mem_micro(P, P.MQA + h * 64, 256, n * SEQ + t0 + 16 * mt, 0, n, h, P.ATTA + 256 + h * 64, 512, lane);
        __syncthreads();
    }
    LAS float* qs = (LAS float*)C.lds;
    for (int it = C.vcu; it < DEC_BATCH * DIL_HEADS * 2; it += C.G) { const int kind = it & 1, h = (it >> 1) % DIL_HEADS, ns = (it >> 1) / DIL_HEADS, row = M0 + ns;
        __syncthreads();
        if (kind == 0) { if (C.tid < 192) qs[C.tid] = bf2f(P.QA[((size_t)(C.tid >> 6) * MPAD + row) * 256 + h * 64 + (C.tid & 63)]); } else { if (C.tid < 64) qs[C.tid] = bf2f(P.MQA[(size_t)row * 256 + h * 64 + C.tid]); }
        asm volatile("s_waitcnt lgkmcnt(0)" ::: "memory"); __syncthreads();
        Dec D; D.m = -INFINITY; D.l = 0.f; D.o = 0.f;
        if (kind == 0) { constexpr int CPG = (DIL_TAPS + 63) / 64;
            for (int ck = w; ck < 3 * CPG; ck += NWAVES) { const int g = ck / CPG, j0 = (ck % CPG) * 64; const int W = dil_w(g), d = dil_d(g); const float* cache = sel3c(P.cache_dil, g) + (size_t)ns * W * 512; const float* newrow = sel3(P.dil_s, g) + ((size_t)ns * W + W - 1) * 512;
                const int nk = (DIL_TAPS - j0) < 64 ? (DIL_TAPS - j0) : 64;
                dec_chunk(D, qs + g * 64, nk, [&](int j) { const int tap = j0 + j; return (tap == 0 ? newrow : cache + (size_t)(W - d * tap) * 512) + h * 64; },
                          [&](int j) { const int tap = j0 + j; return (tap == 0 ? newrow : cache + (size_t)(W - d * tap) * 512) + 256 + h * 64; }, lane); } }
        else { const float* mk = P.cache_mem_kv + ((size_t)0 * DEC_BATCH + ns) * MEM_TOKENS * 512;
            for (int ck = w; ck < MEM_TOKENS / 64; ck += NWAVES) { const int j0 = ck * 64; dec_chunk(D, qs, 64, [&](int j) { return mk + (size_t)(j0 + j) * 512 + h * 64; }, [&](int j) { return mk + (size_t)(j0 + j) * 512 + 256 + h * 64; }, lane); } }
        const float o = dec_combine(C, D);
        if (w == 0) P.ATTA[(size_t)row * 512 + (kind == 0 ? 0 : 256) + h * 64 + lane] = (bf16)f2bf(o);
    }
    __syncthreads();
}
DI void ln_phase(const FP& P, const Ctx& C, const float* pre, const float* gam, const float* bet, float* xo, bf16* xb, float* yp, float* ys) {
    const int gw = C.vcu * NWAVES + C.wave, NGW = C.G * NWAVES, lane = C.lane;
    for (int r = gw; r < MP; r += NGW) { const float* x = pre + (size_t)r * D_MODEL; f32x4 v[4]; float s = 0.f;
#pragma unroll
        for (int j = 0; j < 4; ++j) { v[j] = *(const f32x4*)(x + 256 * j + 4 * lane); s += (v[j].x + v[j].y) + (v[j].z + v[j].w); }
        const float mu = wave_sum(s) * (1.0f / D_MODEL); float s2 = 0.f;
#pragma unroll
        for (int j = 0; j < 4; ++j) { v[j] = v[j] - mu; s2 += (v[j].x * v[j].x + v[j].y * v[j].y) + (v[j].z * v[j].z + v[j].w * v[j].w); }
        const float rs = 1.0f / sqrtf(wave_sum(s2) * (1.0f / D_MODEL) + LN_EPS);
#pragma unroll
        for (int j = 0; j < 4; ++j) { const f32x4 gg = *(const f32x4*)(gam + 256 * j + 4 * lane), bb = *(const f32x4*)(bet + 256 * j + 4 * lane); const f32x4 o = v[j] * rs * gg + bb;
            if (xo) *(f32x4*)(xo + (size_t)r * D_MODEL + 256 * j + 4 * lane) = o;
            if (xb) *(u32x2*)(xb + (size_t)r * D_MODEL + 256 * j + 4 * lane) = pk4(o);
            if (yp) { if (r < M0) *(f32x4*)(yp + (size_t)r * D_MODEL + 256 * j + 4 * lane) = o; else *(f32x4*)(ys + (size_t)(r - M0) * D_MODEL + 256 * j + 4 * lane) = o; } }
    }
}
}
namespace fx {
#define INS16(V, I, v_, i_) do { const float _v = (v_); const int _i = (i_); bool _c[16]; _Pragma("unroll") for (int _k = 0; _k < 16; ++_k) _c[_k] = _v > V[_k]; \
    _Pragma("unroll") for (int _k = 15; _k >= 1; --_k) { V[_k] = _c[_k] ? (_c[_k - 1] ? V[_k - 1] : _v) : V[_k]; I[_k] = _c[_k] ? (_c[_k - 1] ? I[_k - 1] : _i) : I[_k]; } \
    V[0] = _c[0] ? _v : V[0]; I[0] = _c[0] ? _i : I[0]; } while (0)
DI void wave_top16_128(float a, float b, int lane, float& outv, int& outi) {
    outv = -INFINITY; outi = 0;
#pragma unroll 1
    for (int k = 0; k < 16; ++k) { const float m = wave_max(fmaxf(a, b)); const unsigned long long ba = __ballot(a == m), bb = __ballot(b == m); int idx;
        if (ba) { const int l = __builtin_ctzll(ba); idx = l; if (lane == l) a = -INFINITY; } else { const int l = __builtin_ctzll(bb); idx = 64 + l; if (lane == l) b = -INFINITY; }
        if (lane == k) { outv = m; outi = idx; } }
}
DI void topk_wave_item(const FP& P, long it, int lane) {
    const float* s = P.SCO + it * 256; float v1, v2; int i1, i2;
    wave_top16_128(s[lane], s[64 + lane], lane, v1, i1); wave_top16_128(s[128 + lane], s[192 + lane], lane, v2, i2);
    int a = 0, rem = lane; bool valid = false;
    for (int aa = 0; aa < 16; ++aa) { const int nb = 16 / (aa + 1); if (!valid) { if (rem < nb) { a = aa; valid = true; } else rem -= nb; } }
    const int b = valid ? rem : 0;
    float cs = __shfl(v1, a) + __shfl(v2, b); const int ce = __shfl(i1, a) * PEER_KEYS + __shfl(i2, b); if (!valid) cs = -INFINITY;
    float tv = -INFINITY; int te = 0;
#pragma unroll 1
    for (int k = 0; k < 16; ++k) { const float m = wave_max(cs); const unsigned long long bm = __ballot(cs == m); const int l = __builtin_ctzll(bm); const int e = __shfl(ce, l); if (lane == l) cs = -INFINITY; if (lane == k) { tv = m; te = e; } }
    const float mx = __shfl(tv, 0); const float ex = (lane < 16) ? __expf(tv - mx) : 0.f; const float z = wave_sum(ex);
    if (lane < 16) { P.SELG[it * 16 + lane] = ex / z; P.SELE[it * 16 + lane] = te; }
}
#define KINS16(V, key_) do { const float _key = (key_); _Pragma("unroll") for (int _k = 15; _k >= 1; --_k) V[_k] = __builtin_amdgcn_fmed3f(V[_k - 1], V[_k], _key); V[0] = fmaxf(V[0], _key); } while (0)
DI float pack_key(float v, unsigned lowbits, unsigned mask) { return __builtin_bit_cast(float, (__builtin_bit_cast(unsigned, v) & ~mask) | lowbits); }
DI void topk_phase(const FP& P, const Ctx& C) {
    const int lane = C.lane; LAS float* st = (LAS float*)(C.lds + C.wave * 16384);
    const int NWI = (M0 * PEER_HEADS) / 64;
    for (int wi = C.vcu * NWAVES + C.wave; wi < NWI; wi += C.G * NWAVES) {
        const long it0 = (long)wi * 64; const long it = it0 + lane;
        float V1[16], V2[16], V3[16];
#pragma unroll
        for (int k = 0; k < 16; ++k) { V1[k] = V2[k] = V3[k] = -INFINITY; }
#pragma unroll 1
        for (int ch = 0; ch < 8; ++ch) {
#pragma unroll
            for (int u = 0; u < 8; ++u) { const int f4 = u * 64 + lane, j = f4 >> 3, q = f4 & 7, hf = q >> 2, c4 = (q & 3) * 4; const long itj = it0 + j;
                const f32x4 v = *(const f32x4*)(P.SCO + itj * 256 + hf * 128 + ch * 16 + c4);
                st[j * 33 + hf * 16 + c4] = v.x; st[j * 33 + hf * 16 + c4 + 1] = v.y; st[j * 33 + hf * 16 + c4 + 2] = v.z; st[j * 33 + hf * 16 + c4 + 3] = v.w; }
            asm volatile("s_waitcnt lgkmcnt(0)" ::: "memory");
#pragma unroll 4
            for (int c = 0; c < 16; ++c) { const float va = st[lane * 33 + c], vb = st[lane * 33 + 16 + c]; const unsigned lb = 127u - (unsigned)(ch * 16 + c); KINS16(V1, pack_key(va, lb, 127u)); KINS16(V2, pack_key(vb, lb, 127u)); }
            asm volatile("s_waitcnt lgkmcnt(0)" ::: "memory");
        }
        LAS int* lc = (LAS int*)st;
        { int ord = 0;
#pragma unroll
          for (int a = 0; a < 16; ++a) { const unsigned ba = __builtin_bit_cast(unsigned, V1[a]); const float va = __builtin_bit_cast(float, ba & ~127u); const int ia = 127 - (int)(ba & 127u);
#pragma unroll
              for (int b = 0; b < 16; ++b) if ((a + 1) * (b + 1) <= 16) { const unsigned bb = __builtin_bit_cast(unsigned, V2[b]); const float vb = __builtin_bit_cast(float, bb & ~127u); const int ib = 127 - (int)(bb & 127u);
                  lc[lane * 51 + ord] = ia * PEER_KEYS + ib; KINS16(V3, pack_key(va + vb, 63u - (unsigned)ord, 63u)); ++ord; } } }
        asm volatile("s_waitcnt lgkmcnt(0)" ::: "memory");
        float g[16]; int e[16]; float z = 0.f; const float vmax = __builtin_bit_cast(float, __builtin_bit_cast(unsigned, V3[0]) & ~63u);
#pragma unroll
        for (int k = 0; k < 16; ++k) { const unsigned bk = __builtin_bit_cast(unsigned, V3[k]); e[k] = lc[lane * 51 + 63 - (int)(bk & 63u)]; g[k] = __expf(__builtin_bit_cast(float, bk & ~63u) - vmax); z += g[k]; }
        const float iz = 1.0f / z;
#pragma unroll
        for (int k4 = 0; k4 < 4; ++k4) { *(f32x4*)(P.SELG + it * 16 + 4 * k4) = (f32x4){g[4 * k4] * iz, g[4 * k4 + 1] * iz, g[4 * k4 + 2] * iz, g[4 * k4 + 3] * iz};
            *(int4*)(P.SELE + it * 16 + 4 * k4) = make_int4(e[4 * k4], e[4 * k4 + 1], e[4 * k4 + 2], e[4 * k4 + 3]); }
        asm volatile("s_waitcnt lgkmcnt(0)" ::: "memory");
    }
    for (int si = C.vcu * NWAVES + C.wave; si < DEC_BATCH * PEER_HEADS; si += C.G * NWAVES) topk_wave_item(P, (long)M0 * PEER_HEADS + si, lane);
    __syncthreads();
}
constexpr float PEER_SU = 256.f, PEER_SV = 64.f;
DI float dot16_fp8(const u32x4& w, const f32x2 (&x2)[8]) { f32x2 a = {0.f, 0.f};
    a += __builtin_amdgcn_cvt_pk_f32_fp8((int)w.x, false) * x2[0]; a += __builtin_amdgcn_cvt_pk_f32_fp8((int)w.x, true) * x2[1];
    a += __builtin_amdgcn_cvt_pk_f32_fp8((int)w.y, false) * x2[2]; a += __builtin_amdgcn_cvt_pk_f32_fp8((int)w.y, true) * x2[3];
    a += __builtin_amdgcn_cvt_pk_f32_fp8((int)w.z, false) * x2[4]; a += __builtin_amdgcn_cvt_pk_f32_fp8((int)w.z, true) * x2[5];
    a += __builtin_amdgcn_cvt_pk_f32_fp8((int)w.w, false) * x2[6]; a += __builtin_amdgcn_cvt_pk_f32_fp8((int)w.w, true) * x2[7];
    return a.x + a.y; }
DI void axpy16_fp8(const u32x4& w, float s, f32x2 (&o2)[8]) { const f32x2 s2 = {s, s};
    o2[0] += __builtin_amdgcn_cvt_pk_f32_fp8((int)w.x, false) * s2; o2[1] += __builtin_amdgcn_cvt_pk_f32_fp8((int)w.x, true) * s2;
    o2[2] += __builtin_amdgcn_cvt_pk_f32_fp8((int)w.y, false) * s2; o2[3] += __builtin_amdgcn_cvt_pk_f32_fp8((int)w.y, true) * s2;
    o2[4] += __builtin_amdgcn_cvt_pk_f32_fp8((int)w.z, false) * s2; o2[5] += __builtin_amdgcn_cvt_pk_f32_fp8((int)w.z, true) * s2;
    o2[6] += __builtin_amdgcn_cvt_pk_f32_fp8((int)w.w, false) * s2; o2[7] += __builtin_amdgcn_cvt_pk_f32_fp8((int)w.w, true) * s2; }
#if defined(PEER_SHARD) || defined(PEER_SHARD2)
#define PEER_FIRST_ROUND nrounds
#else
#define PEER_FIRST_ROUND 0
#endif
DI float rdlane(float v, int l) { return __builtin_bit_cast(float, __builtin_amdgcn_readlane(__builtin_bit_cast(int, v), l)); }
DI void peer_phase(const FP& P, const Ctx& C, int layer, const float* xin, float* fout, float* fout_s, bf16* xb, bool samples_only = false) {
    const int lane = C.lane; const unsigned char* U = P.UB8 + (size_t)layer * PEER_EXPERTS * D_MODEL; const unsigned char* Vt = P.VB8 + (size_t)layer * PEER_EXPERTS * D_MODEL;
    const float* gam = P.ln_g + ((size_t)layer * 2 + 1) * D_MODEL; const float* bet = P.ln_b + ((size_t)layer * 2 + 1) * D_MODEL;
    const int nrounds = (M0 + C.G * NWAVES - 1) / (C.G * NWAVES);
#pragma unroll 1
    for (int rd = samples_only ? nrounds : 0; rd <= nrounds; ++rd) {
        const bool smp = (rd == nrounds); int r = smp ? M0 + C.vcu : rd * C.G * NWAVES + C.vcu * NWAVES + C.wave; if (smp ? (C.vcu >= DEC_BATCH) : (r >= M0)) continue;
        const int pb = smp ? 16 * C.wave : 0, pe = smp ? pb + 16 : 128;
        f32x2 x2[8], o2[8];
#pragma unroll
        for (int j = 0; j < 4; ++j) { const f32x4 a = *(const f32x4*)(xin + (size_t)r * D_MODEL + 16 * lane + 4 * j); x2[2 * j] = (f32x2){a.x, a.y}; x2[2 * j + 1] = (f32x2){a.z, a.w}; }
#pragma unroll
        for (int k = 0; k < 8; ++k) o2[k] = (f32x2){0.f, 0.f};
        const int e_l = P.SELE[(size_t)r * 128 + lane], e_h = P.SELE[(size_t)r * 128 + 64 + lane]; const float g_l = P.SELG[(size_t)r * 128 + lane], g_h = P.SELG[(size_t)r * 128 + 64 + lane];
#pragma unroll 1
        for (int b0 = pb; b0 < pe; b0 += 8) {
            u32x4 uw[8], vw[8];
#pragma unroll
            for (int k = 0; k < 8; ++k) { const int hk = b0 + k; const int e = (hk < 64) ? __builtin_amdgcn_readlane(e_l, hk & 63) : __builtin_amdgcn_readlane(e_h, hk & 63);
                uw[k] = *(const u32x4*)(U + (size_t)e * D_MODEL + 16 * lane); vw[k] = *(const u32x4*)(Vt + (size_t)e * D_MODEL + 16 * lane); }
            float d[8];
#pragma unroll
            for (int k = 0; k < 8; ++k) d[k] = dot16_fp8(uw[k], x2);
            float e4[4], e2[2], e1;
            { const bool hi = lane & 1;
#pragma unroll
              for (int i = 0; i < 4; ++i) { const float keep = hi ? d[4 + i] : d[i], send = hi ? d[i] : d[4 + i]; e4[i] = keep + __shfl_xor(send, 1); } }
            { const bool hi = lane & 2;
#pragma unroll
              for (int i = 0; i < 2; ++i) { const float keep = hi ? e4[2 + i] : e4[i], send = hi ? e4[i] : e4[2 + i]; e2[i] = keep + __shfl_xor(send, 2); } }
            { const bool hi = lane & 4; const float keep = hi ? e2[1] : e2[0], send = hi ? e2[0] : e2[1]; e1 = keep + __shfl_xor(send, 4); }
            e1 += __shfl_xor(e1, 8); e1 += __shfl_xor(e1, 16); e1 += __shfl_xor(e1, 32);
            const int myk = 4 * (lane & 1) + (lane & 2) + ((lane >> 2) & 1); const int myhk = b0 + myk;
            const float myg = (myhk < 64) ? __shfl(g_l, myhk & 63) : __shfl(g_h, myhk & 63);
            const float act = myg * gelu_tanh(e1 * (1.0f / PEER_SU)) * (1.0f / PEER_SV);
#pragma unroll
            for (int k = 0; k < 8; ++k) { const int src = (k >> 2) | (((k >> 1) & 1) << 1) | ((k & 1) << 2); axpy16_fp8(vw[k], rdlane(act, src), o2); }
        }
        if (smp) {
            LAS float* red = (LAS float*)C.lds;
#pragma unroll
            for (int k = 0; k < 8; ++k) { red[C.wave * 1024 + 16 * lane + 2 * k] = o2[k].x; red[C.wave * 1024 + 16 * lane + 2 * k + 1] = o2[k].y; }
            asm volatile("s_waitcnt lgkmcnt(0)" ::: "memory"); __syncthreads();
            if (C.wave == 0) {
#pragma unroll
                for (int k = 0; k < 8; ++k) { float ax = 0.f, ay = 0.f;
#pragma unroll
                    for (int ww = 0; ww < NWAVES; ++ww) { ax += red[ww * 1024 + 16 * lane + 2 * k]; ay += red[ww * 1024 + 16 * lane + 2 * k + 1]; } o2[k] = (f32x2){ax, ay}; } }
            __syncthreads();
            if (C.wave != 0) continue; }
        float s = 0.f;
#pragma unroll
        for (int k = 0; k < 8; ++k) { o2[k] += x2[k] * ALPHA; s += o2[k].x + o2[k].y; }
        const float mu = wave_sum(s) * (1.0f / D_MODEL); float s2 = 0.f;
#pragma unroll
        for (int k = 0; k < 8; ++k) { o2[k] -= mu; s2 += o2[k].x * o2[k].x + o2[k].y * o2[k].y; }
        const float rs = 1.0f / sqrtf(wave_sum(s2) * (1.0f / D_MODEL) + LN_EPS);
        float* frow = (r < M0) ? fout + (size_t)r * D_MODEL : fout_s + (size_t)(r - M0) * D_MODEL;
#pragma unroll
        for (int j = 0; j < 4; ++j) { const int c0 = 16 * lane + 4 * j; const f32x4 gg = *(const f32x4*)(gam + c0), bb = *(const f32x4*)(bet + c0);
            const f32x4 y = (f32x4){o2[2 * j].x * rs, o2[2 * j].y * rs, o2[2 * j + 1].x * rs, o2[2 * j + 1].y * rs} * gg + bb;
            *(f32x4*)(frow + c0) = y; if (xb) *(u32x2*)(xb + (size_t)r * D_MODEL + c0) = pk4(y); }
    }
}
DI void peer_u_phase(const FP& P, const Ctx& C, int layer, const bf16* xb16) {
    const int lane = C.lane; const unsigned char* U = P.UB8 + (size_t)layer * PEER_EXPERTS * D_MODEL;
    const int s = (int)(blockIdx.x & 7), nw = (C.G >> 3) * NWAVES, widx = (int)(blockIdx.x >> 3) * NWAVES + C.wave;
#pragma unroll 1
    for (int r = widx; r < MP; r += nw) {
        const int e0 = P.SELE[(size_t)r * 128 + lane], e1 = P.SELE[(size_t)r * 128 + 64 + lane]; const float g0 = P.SELG[(size_t)r * 128 + lane], g1 = P.SELG[(size_t)r * 128 + 64 + lane];
        unsigned long long b0 = __ballot((e0 >> 11) == s), b1 = __ballot((e1 >> 11) == s);
        if ((b0 | b1) == 0ull) continue;
        f32x2 x2[8]; { const u32x4 xa = *(const u32x4*)(xb16 + (size_t)r * D_MODEL + 16 * lane), xc = *(const u32x4*)(xb16 + (size_t)r * D_MODEL + 16 * lane + 8);
            x2[0] = (f32x2){bflo(xa.x), bfhi(xa.x)}; x2[1] = (f32x2){bflo(xa.y), bfhi(xa.y)}; x2[2] = (f32x2){bflo(xa.z), bfhi(xa.z)}; x2[3] = (f32x2){bflo(xa.w), bfhi(xa.w)};
            x2[4] = (f32x2){bflo(xc.x), bfhi(xc.x)}; x2[5] = (f32x2){bflo(xc.y), bfhi(xc.y)}; x2[6] = (f32x2){bflo(xc.z), bfhi(xc.z)}; x2[7] = (f32x2){bflo(xc.w), bfhi(xc.w)}; }
#pragma unroll 1
        while ((b0 | b1) != 0ull) {
            int hk[8]; u32x4 uw[8]; int nv = 0;
#pragma unroll
            for (int k = 0; k < 8; ++k) { int h;
                if (b0) { h = __builtin_ctzll(b0); b0 &= b0 - 1; ++nv; } else if (b1) { h = 64 + __builtin_ctzll(b1); b1 &= b1 - 1; ++nv; } else h = hk[k > 0 ? k - 1 : 0];
                hk[k] = h; const int e = (h < 64) ? __builtin_amdgcn_readlane(e0, h & 63) : __builtin_amdgcn_readlane(e1, h & 63);
                uw[k] = *(const u32x4*)(U + (size_t)e * D_MODEL + 16 * lane); }
            float d[8];
#pragma unroll
            for (int k = 0; k < 8; ++k) d[k] = dot16_fp8(uw[k], x2);
            float e4[4], e2[2], e1s;
            { const bool hi = lane & 1;
#pragma unroll
              for (int i = 0; i < 4; ++i) { const float keep = hi ? d[4 + i] : d[i], send = hi ? d[i] : d[4 + i]; e4[i] = keep + __shfl_xor(send, 1); } }
            { const bool hi = lane & 2;
#pragma unroll
              for (int i = 0; i < 2; ++i) { const float keep = hi ? e4[2 + i] : e4[i], send = hi ? e4[i] : e4[2 + i]; e2[i] = keep + __shfl_xor(send, 2); } }
            { const bool hi = lane & 4; const float keep = hi ? e2[1] : e2[0], send = hi ? e2[0] : e2[1]; e1s = keep + __shfl_xor(send, 4); }
            e1s += __shfl_xor(e1s, 8); e1s += __shfl_xor(e1s, 16); e1s += __shfl_xor(e1s, 32);
            const int myk = 4 * (lane & 1) + (lane & 2) + ((lane >> 2) & 1);
            int myh = hk[0];
#pragma unroll
            for (int k = 1; k < 8; ++k) myh = (myk == k) ? hk[k] : myh;
            const float ga = __shfl(g0, myh & 63), gb = __shfl(g1, myh & 63); const float myg = (myh < 64) ? ga : gb;
            if (lane < 8 && myk < nv) P.SCO[(size_t)r * 128 + myh] = myg * gelu_tanh(e1s * (1.0f / PEER_SU)) * (1.0f / PEER_SV);
        }
    }
}
DI void peer_v_phase(const FP& P, const Ctx& C, int layer, const float* xin, float* fout, float* fout_s, bf16* xb) {
    const int lane = C.lane; const unsigned char* Vt = P.VB8 + (size_t)layer * PEER_EXPERTS * D_MODEL;
    const float* gam = P.ln_g + ((size_t)layer * 2 + 1) * D_MODEL; const float* bet = P.ln_b + ((size_t)layer * 2 + 1) * D_MODEL;
    const int nrounds = (M0 + C.G * NWAVES - 1) / (C.G * NWAVES);
#pragma unroll 1
    for (int rd = 0; rd <= nrounds; ++rd) {
        const bool smp = (rd == nrounds); int r = smp ? M0 + C.vcu : rd * C.G * NWAVES + C.vcu * NWAVES + C.wave; if (smp ? (C.vcu >= DEC_BATCH) : (r >= M0)) continue;
        const int pb = smp ? 16 * C.wave : 0, pe = smp ? pb + 16 : 128;
        f32x2 x2[8], o2[8];
#pragma unroll
        for (int j = 0; j < 4; ++j) { const f32x4 a = *(const f32x4*)(xin + (size_t)r * D_MODEL + 16 * lane + 4 * j); x2[2 * j] = (f32x2){a.x, a.y}; x2[2 * j + 1] = (f32x2){a.z, a.w}; }
#pragma unroll
        for (int k = 0; k < 8; ++k) o2[k] = (f32x2){0.f, 0.f};
        const int e_l = P.SELE[(size_t)r * 128 + lane], e_h = P.SELE[(size_t)r * 128 + 64 + lane]; const float a_l = P.SCO[(size_t)r * 128 + lane], a_h = P.SCO[(size_t)r * 128 + 64 + lane];
#pragma unroll 1
        for (int b0 = pb; b0 < pe; b0 += 16) { u32x4 vw[16];
#pragma unroll
            for (int k = 0; k < 16; ++k) { const int hk = b0 + k; const int e = (hk < 64) ? __builtin_amdgcn_readlane(e_l, hk & 63) : __builtin_amdgcn_readlane(e_h, hk & 63); vw[k] = *(const u32x4*)(Vt + (size_t)e * D_MODEL + 16 * lane); }
#pragma unroll
            for (int k = 0; k < 16; ++k) { const int hk = b0 + k; axpy16_fp8(vw[k], (hk < 64) ? rdlane(a_l, hk & 63) : rdlane(a_h, hk & 63), o2); } }
        if (smp) {
            LAS float* red = (LAS float*)C.lds;
#pragma unroll
            for (int k = 0; k < 8; ++k) { red[C.wave * 1024 + 16 * lane + 2 * k] = o2[k].x; red[C.wave * 1024 + 16 * lane + 2 * k + 1] = o2[k].y; }
            asm volatile("s_waitcnt lgkmcnt(0)" ::: "memory"); __syncthreads();
            if (C.wave == 0) {
#pragma unroll
                for (int k = 0; k < 8; ++k) { float ax = 0.f, ay = 0.f;
#pragma unroll
                    for (int ww = 0; ww < NWAVES; ++ww) { ax += red[ww * 1024 + 16 * lane + 2 * k]; ay += red[ww * 1024 + 16 * lane + 2 * k + 1]; } o2[k] = (f32x2){ax, ay}; } }
            __syncthreads();
            if (C.wave != 0) continue; }
        float s = 0.f;
#pragma unroll
        for (int k = 0; k < 8; ++k) { o2[k] += x2[k] * ALPHA; s += o2[k].x + o2[k].y; }
        const float mu = wave_sum(s) * (1.0f / D_MODEL); float s2 = 0.f;
#pragma unroll
        for (int k = 0; k < 8; ++k) { o2[k] -= mu; s2 += o2[k].x * o2[k].x + o2[k].y * o2[k].y; }
        const float rs = 1.0f / sqrtf(wave_sum(s2) * (1.0f / D_MODEL) + LN_EPS);
        float* frow = (r < M0) ? fout + (size_t)r * D_MODEL : fout_s + (size_t)(r - M0) * D_MODEL;
#pragma unroll
        for (int j = 0; j < 4; ++j) { const int c0 = 16 * lane + 4 * j; const f32x4 gg = *(const f32x4*)(gam + c0), bb = *(const f32x4*)(bet + c0);
            const f32x4 y = (f32x4){o2[2 * j].x * rs, o2[2 * j].y * rs, o2[2 * j + 1].x * rs, o2[2 * j + 1].y * rs} * gg + bb;
            *(f32x4*)(frow + c0) = y; if (xb) *(u32x2*)(xb + (size_t)r * D_MODEL + c0) = pk4(y); }
    }
}
constexpr int PSH_LIST = 512;
struct PG4 { u32x4 u[4], v[4]; };
DI void peer_sharded_phase(const FP& P, const Ctx& C, int layer, const float* xin, const bf16* xb16, float* fout, float* fout_s, bf16* xb) {
    const int lane = C.lane; const unsigned char* U = P.UB8 + (size_t)layer * PEER_EXPERTS * D_MODEL; const unsigned char* Vt = P.VB8 + (size_t)layer * PEER_EXPERTS * D_MODEL;
    const float* gam = P.ln_g + ((size_t)layer * 2 + 1) * D_MODEL; const float* bet = P.ln_b + ((size_t)layer * 2 + 1) * D_MODEL;
    LAS unsigned char* wl = C.lds + C.wave * 16384; LAS bf16* xs = (LAS bf16*)wl; LAS int* lst = (LAS int*)(wl + 8192);
    const int NW = C.G * NWAVES, gw = C.vcu * NWAVES + C.wave; const int nquads = (M0 / NW) / 4;
#pragma unroll 1
    for (int qd = 0; qd < nquads; ++qd) {
#define PSH_ROW(j) const int row##j = (qd * 4 + j) * NW + gw; const int el##j = P.SELE[(size_t)row##j * 128 + lane], eh##j = P.SELE[(size_t)row##j * 128 + 64 + lane]; const float gl##j = P.SELG[(size_t)row##j * 128 + lane], gh##j = P.SELG[(size_t)row##j * 128 + 64 + lane]; \
        { const u32x4 xa = *(const u32x4*)(xb16 + (size_t)row##j * D_MODEL + 16 * lane), xc = *(const u32x4*)(xb16 + (size_t)row##j * D_MODEL + 16 * lane + 8); *(LAS u32x4*)(xs + j * 1024 + 16 * lane) = xa; *(LAS u32x4*)(xs + j * 1024 + 16 * lane + 8) = xc; } \
        f32x2 oa##j[8]; _Pragma("unroll") for (int k = 0; k < 8; ++k) oa##j[k] = (f32x2){0.f, 0.f};
        PSH_ROW(0) PSH_ROW(1) PSH_ROW(2) PSH_ROW(3)
#pragma unroll 1
        for (int s = 0; s < 16; ++s) {
            int n = 0;
#define PSH_SCAN(j) { unsigned long long b0 = __ballot((el##j >> 10) == s), b1 = __ballot((eh##j >> 10) == s); \
                while (b0) { const int h = __builtin_ctzll(b0); b0 &= b0 - 1; const int e = __builtin_amdgcn_readlane(el##j, h); const int g = __builtin_amdgcn_readlane(__builtin_bit_cast(int, gl##j), h); \
                    if (lane == 0) { lst[4 * n] = e; lst[4 * n + 1] = g; lst[4 * n + 2] = j; } ++n; } \
                while (b1) { const int h = __builtin_ctzll(b1); b1 &= b1 - 1; const int e = __builtin_amdgcn_readlane(eh##j, h); const int g = __builtin_amdgcn_readlane(__builtin_bit_cast(int, gh##j), h); \
                    if (lane == 0) { lst[4 * n] = e; lst[4 * n + 1] = g; lst[4 * n + 2] = j; } ++n; } }
            PSH_SCAN(0) PSH_SCAN(1) PSH_SCAN(2) PSH_SCAN(3)
            asm volatile("s_waitcnt lgkmcnt(0)" ::: "memory");
            if (n == 0) continue;
            const int ngrp = (n + 3) >> 2;
#define PSH_LD(b, gi_) do { const int gi = (gi_); _Pragma("unroll") for (int k = 0; k < 4; ++k) { int i = 4 * gi + k; i = i < n ? i : n - 1; const int e = __builtin_amdgcn_readfirstlane(lst[4 * i]); \
                b.u[k] = *(const u32x4*)(U + (size_t)e * D_MODEL + 16 * lane); b.v[k] = *(const u32x4*)(Vt + (size_t)e * D_MODEL + 16 * lane); } } while (0)
#define PSH_CP(b, gi_) do { const int gi = (gi_); float d[4]; int jj[4]; float gg[4]; \
                _Pragma("unroll") for (int k = 0; k < 4; ++k) { int i = 4 * gi + k; const bool val = i < n; i = val ? i : n - 1; jj[k] = __builtin_amdgcn_readfirstlane(lst[4 * i + 2]); gg[k] = val ? __builtin_bit_cast(float, __builtin_amdgcn_readfirstlane(lst[4 * i + 1])) : 0.f; \
                    const u32x4 xa = *(const LAS u32x4*)(xs + jj[k] * 1024 + 16 * lane), xc = *(const LAS u32x4*)(xs + jj[k] * 1024 + 16 * lane + 8); \
                    const f32x2 x2[8] = {(f32x2){bflo(xa.x), bfhi(xa.x)}, (f32x2){bflo(xa.y), bfhi(xa.y)}, (f32x2){bflo(xa.z), bfhi(xa.z)}, (f32x2){bflo(xa.w), bfhi(xa.w)}, (f32x2){bflo(xc.x), bfhi(xc.x)}, (f32x2){bflo(xc.y), bfhi(xc.y)}, (f32x2){bflo(xc.z), bfhi(xc.z)}, (f32x2){bflo(xc.w), bfhi(xc.w)}}; \
                    d[k] = dot16_fp8(b.u[k], x2); } \
                float e2[2], e1; \
                { const bool hi = lane & 1; _Pragma("unroll") for (int i = 0; i < 2; ++i) { const float keep = hi ? d[2 + i] : d[i], send = hi ? d[i] : d[2 + i]; e2[i] = keep + __shfl_xor(send, 1); } } \
                { const bool hi = lane & 2; const float keep = hi ? e2[1] : e2[0], send = hi ? e2[0] : e2[1]; e1 = keep + __shfl_xor(send, 2); } \
                e1 += __shfl_xor(e1, 4); e1 += __shfl_xor(e1, 8); e1 += __shfl_xor(e1, 16); e1 += __shfl_xor(e1, 32); \
                const int myk = 2 * (lane & 1) + ((lane >> 1) & 1); \
                float myg = gg[0]; myg = (myk == 1) ? gg[1] : myg; myg = (myk == 2) ? gg[2] : myg; myg = (myk == 3) ? gg[3] : myg; \
                const float act = myg * gelu_tanh(e1 * (1.0f / PEER_SU)) * (1.0f / PEER_SV); \
                _Pragma("unroll") for (int k = 0; k < 4; ++k) { const float a = rdlane(act, (k >> 1) | ((k & 1) << 1)); \
                    if (jj[k] == 0) axpy16_fp8(b.v[k], a, oa0); else if (jj[k] == 1) axpy16_fp8(b.v[k], a, oa1); else if (jj[k] == 2) axpy16_fp8(b.v[k], a, oa2); else axpy16_fp8(b.v[k], a, oa3); } } while (0)
            { PG4 A, B; PSH_LD(A, 0);
#pragma unroll 1
              for (int g2 = 0; g2 < ngrp; g2 += 2) { PSH_LD(B, (g2 + 1 < ngrp) ? g2 + 1 : g2); PSH_CP(A, g2); PSH_LD(A, (g2 + 2 < ngrp) ? g2 + 2 : g2); if (g2 + 1 < ngrp) PSH_CP(B, g2 + 1); } }
            asm volatile("s_waitcnt lgkmcnt(0)" ::: "memory");
        }
#define PSH_LN(j) { const int r = row##j; f32x2 x2[8]; \
            _Pragma("unroll") for (int q = 0; q < 4; ++q) { const f32x4 a = *(const f32x4*)(xin + (size_t)r * D_MODEL + 16 * lane + 4 * q); x2[2 * q] = (f32x2){a.x, a.y}; x2[2 * q + 1] = (f32x2){a.z, a.w}; } \
            float sm = 0.f; _Pragma("unroll") for (int k = 0; k < 8; ++k) { oa##j[k] += x2[k] * ALPHA; sm += oa##j[k].x + oa##j[k].y; } \
            const float mu = wave_sum(sm) * (1.0f / D_MODEL); float s2 = 0.f; _Pragma("unroll") for (int k = 0; k < 8; ++k) { oa##j[k] -= mu; s2 += oa##j[k].x * oa##j[k].x + oa##j[k].y * oa##j[k].y; } \
            const float rs = 1.0f / sqrtf(wave_sum(s2) * (1.0f / D_MODEL) + LN_EPS); float* frow = fout + (size_t)r * D_MODEL; \
            _Pragma("unroll") for (int q = 0; q < 4; ++q) { const int c0 = 16 * lane + 4 * q; const f32x4 gv = *(const f32x4*)(gam + c0), bv = *(const f32x4*)(bet + c0); \
                const f32x4 y = (f32x4){oa##j[2 * q].x * rs, oa##j[2 * q].y * rs, oa##j[2 * q + 1].x * rs, oa##j[2 * q + 1].y * rs} * gv + bv; *(f32x4*)(frow + c0) = y; if (xb) *(u32x2*)(xb + (size_t)r * D_MODEL + c0) = pk4(y); } }
        PSH_LN(0) PSH_LN(1) PSH_LN(2) PSH_LN(3)
        asm volatile("s_waitcnt lgkmcnt(0)" ::: "memory");
    }
}
constexpr int PSH_LOG = 11, PSH_N = PEER_EXPERTS >> PSH_LOG;
#ifndef PS2_ROWS
#define PS2_ROWS 4
#endif
#define PS2_ROW(j) const int row##j = (qd * PS2_ROWS + j) * NW + gw; const int el##j = P.SELE[(size_t)row##j * 128 + lane], eh##j = P.SELE[(size_t)row##j * 128 + 64 + lane]; const float gl##j = P.SELG[(size_t)row##j * 128 + lane], gh##j = P.SELG[(size_t)row##j * 128 + 64 + lane]; \
    f32x2 oa##j[8]; _Pragma("unroll") for (int k = 0; k < 8; ++k) oa##j[k] = (f32x2){0.f, 0.f};
#define PS2_STEP(j) { unsigned long long b0 = __ballot((el##j >> PSH_LOG) == s), b1 = __ballot((eh##j >> PSH_LOG) == s); \
    if (b0 | b1) { const u32x4 xa##j = *(const u32x4*)(xb16 + (size_t)row##j * D_MODEL + 16 * lane), xc##j = *(const u32x4*)(xb16 + (size_t)row##j * D_MODEL + 16 * lane + 8);     \
      const f32x2 x2[8] = {(f32x2){bflo(xa##j.x), bfhi(xa##j.x)}, (f32x2){bflo(xa##j.y), bfhi(xa##j.y)}, (f32x2){bflo(xa##j.z), bfhi(xa##j.z)}, (f32x2){bflo(xa##j.w), bfhi(xa##j.w)}, (f32x2){bflo(xc##j.x), bfhi(xc##j.x)}, (f32x2){bflo(xc##j.y), bfhi(xc##j.y)}, (f32x2){bflo(xc##j.z), bfhi(xc##j.z)}, (f32x2){bflo(xc##j.w), bfhi(xc##j.w)}}; \
      _Pragma("unroll 1") while ((b0 | b1) != 0ull) { int hk[8]; u32x4 uw[8], vw[8]; int nv = 0; \
        _Pragma("unroll") for (int k = 0; k < 8; ++k) { int h; if (b0) { h = __builtin_ctzll(b0); b0 &= b0 - 1; ++nv; } else if (b1) { h = 64 + __builtin_ctzll(b1); b1 &= b1 - 1; ++nv; } else h = hk[k > 0 ? k - 1 : 0]; \
            hk[k] = h; const int e = (h < 64) ? __builtin_amdgcn_readlane(el##j, h & 63) : __builtin_amdgcn_readlane(eh##j, h & 63); \
            uw[k] = *(const u32x4*)(U + (size_t)e * D_MODEL + 16 * lane); vw[k] = *(const u32x4*)(Vt + (size_t)e * D_MODEL + 16 * lane); } \
        float d[8]; _Pragma("unroll") for (int k = 0; k < 8; ++k) d[k] = dot16_fp8(uw[k], x2); \
        float e4[4], e2[2], e1s; \
        { const bool hi = lane & 1; _Pragma("unroll") for (int i = 0; i < 4; ++i) { const float keep = hi ? d[4 + i] : d[i], send = hi ? d[i] : d[4 + i]; e4[i] = keep + __shfl_xor(send, 1); } } \
        { const bool hi = lane & 2; _Pragma("unroll") for (int i = 0; i < 2; ++i) { const float keep = hi ? e4[2 + i] : e4[i], send = hi ? e4[i] : e4[2 + i]; e2[i] = keep + __shfl_xor(send, 2); } } \
        { const bool hi = lane & 4; const float keep = hi ? e2[1] : e2[0], send = hi ? e2[0] : e2[1]; e1s = keep + __shfl_xor(send, 4); } \
        e1s += __shfl_xor(e1s, 8); e1s += __shfl_xor(e1s, 16); e1s += __shfl_xor(e1s, 32); \
        const int myk = 4 * (lane & 1) + (lane & 2) + ((lane >> 2) & 1); int myh = hk[0]; _Pragma("unroll") for (int k = 1; k < 8; ++k) myh = (myk == k) ? hk[k] : myh; \
        const float ga = __shfl(gl##j, myh & 63), gb = __shfl(gh##j, myh & 63); const float myg = (myk < nv) ? ((myh < 64) ? ga : gb) : 0.f;     \
        const float act = myg * gelu_tanh(e1s * (1.0f / PEER_SU)) * (1.0f / PEER_SV); \
        _Pragma("unroll") for (int k = 0; k < 8; ++k) { const int src = (k >> 2) | (((k >> 1) & 1) << 1) | ((k & 1) << 2); axpy16_fp8(vw[k], rdlane(act, src), oa##j); } } } }
#define PS2_LN(j) { const int r = row##j; f32x2 x2[8]; int ll = lane; asm volatile("" : "+v"(ll));     \
    _Pragma("unroll") for (int q = 0; q < 4; ++q) { const f32x4 a = *(const f32x4*)(xin + (size_t)r * D_MODEL + 16 * ll + 4 * q); x2[2 * q] = (f32x2){a.x, a.y}; x2[2 * q + 1] = (f32x2){a.z, a.w}; } \
    float sm = 0.f; _Pragma("unroll") for (int k = 0; k < 8; ++k) { oa##j[k] += x2[k] * ALPHA; sm += oa##j[k].x + oa##j[k].y; } \
    const float mu = wave_sum(sm) * (1.0f / D_MODEL); float s2 = 0.f; _Pragma("unroll") for (int k = 0; k < 8; ++k) { oa##j[k] -= mu; s2 += oa##j[k].x * oa##j[k].x + oa##j[k].y * oa##j[k].y; } \
    const float rs = 1.0f / sqrtf(wave_sum(s2) * (1.0f / D_MODEL) + LN_EPS); float* frow = fout + (size_t)r * D_MODEL; \
    _Pragma("unroll") for (int q = 0; q < 4; ++q) { const int c0 = 16 * ll + 4 * q; const f32x4 gv = *(const f32x4*)(gam + c0), bv = *(const f32x4*)(bet + c0); \
        const f32x4 y = (f32x4){oa##j[2 * q].x * rs, oa##j[2 * q].y * rs, oa##j[2 * q + 1].x * rs, oa##j[2 * q + 1].y * rs} * gv + bv; *(f32x4*)(frow + c0) = y; if (xb) *(u32x2*)(xb + (size_t)r * D_MODEL + c0) = pk4(y); } }
DI void peer_sharded2_phase(const FP& P, const Ctx& C, int layer, const float* xin, const bf16* xb16, float* fout, bf16* xb) {
    const int lane = C.lane; const unsigned char* U = P.UB8 + (size_t)layer * PEER_EXPERTS * D_MODEL; const unsigned char* Vt = P.VB8 + (size_t)layer * PEER_EXPERTS * D_MODEL;
    const float* gam = P.ln_g + ((size_t)layer * 2 + 1) * D_MODEL; const float* bet = P.ln_b + ((size_t)layer * 2 + 1) * D_MODEL;
    const int NW = C.G * NWAVES, gw = C.vcu * NWAVES + C.wave; const int nquads = (M0 / NW) / PS2_ROWS;
#pragma unroll 1
    for (int qd = 0; qd < nquads; ++qd) {
#if PS2_ROWS == 4
        PS2_ROW(0) PS2_ROW(1) PS2_ROW(2) PS2_ROW(3)
#pragma unroll 1
        for (int s = 0; s < PSH_N; ++s) { PS2_STEP(0) PS2_STEP(1) PS2_STEP(2) PS2_STEP(3) }
        PS2_LN(0) PS2_LN(1) PS2_LN(2) PS2_LN(3)
#else
        PS2_ROW(0) PS2_ROW(1)
#pragma unroll 1
        for (int s = 0; s < PSH_N; ++s) { PS2_STEP(0) PS2_STEP(1) }
        PS2_LN(0) PS2_LN(1)
#endif
    }
}
#define PS3_ROW(j) const int row##j = (qd * 4 + j) * NW + gw; const int el##j = P.SELE[(size_t)row##j * 128 + lane], eh##j = P.SELE[(size_t)row##j * 128 + 64 + lane]; \
    { const u32x4 xa = *(const u32x4*)(xb16 + (size_t)row##j * D_MODEL + 16 * lane), xc = *(const u32x4*)(xb16 + (size_t)row##j * D_MODEL + 16 * lane + 8); *(LAS u32x4*)(xs + j * 1024 + 16 * lane) = xa; *(LAS u32x4*)(xs + j * 1024 + 16 * lane + 8) = xc; } \
    f32x2 oa##j[8]; _Pragma("unroll") for (int k = 0; k < 8; ++k) oa##j[k] = (f32x2){0.f, 0.f};
#define PS3_X2_UNUSED(j) const f32x2 x2[8] = {(f32x2){bflo(xa##j.x), bfhi(xa##j.x)}, (f32x2){bflo(xa##j.y), bfhi(xa##j.y)}, (f32x2){bflo(xa##j.z), bfhi(xa##j.z)}, (f32x2){bflo(xa##j.w), bfhi(xa##j.w)}, (f32x2){bflo(xc##j.x), bfhi(xc##j.x)}, (f32x2){bflo(xc##j.y), bfhi(xc##j.y)}, (f32x2){bflo(xc##j.z), bfhi(xc##j.z)}, (f32x2){bflo(xc##j.w), bfhi(xc##j.w)}};
#define PS3_TAKE(q, M, ELH, GOFF) if (!got && M) { const int h = __builtin_ctzll(M); M &= M - 1; qq[k] = q; ee = __builtin_amdgcn_readlane(ELH, h); gk[k] = P.SELG[GOFF + h];     got = true; ++nv; }
DI void peer_sharded3_phase(const FP& P, const Ctx& C, int layer, const float* xin, const bf16* xb16, float* fout, bf16* xb) {
    const int lane = C.lane; const unsigned char* U = P.UB8 + (size_t)layer * PEER_EXPERTS * D_MODEL; const unsigned char* Vt = P.VB8 + (size_t)layer * PEER_EXPERTS * D_MODEL;
    const float* gam = P.ln_g + ((size_t)layer * 2 + 1) * D_MODEL; const float* bet = P.ln_b + ((size_t)layer * 2 + 1) * D_MODEL;
    const int NW = C.G * NWAVES, gw = C.vcu * NWAVES + C.wave; const int nquads = (M0 / NW) / 4; LAS bf16* xs = (LAS bf16*)(C.lds + C.wave * 16384);
#pragma unroll 1
    for (int qd = 0; qd < nquads; ++qd) {
        PS3_ROW(0) PS3_ROW(1) PS3_ROW(2) PS3_ROW(3)
        asm volatile("s_waitcnt lgkmcnt(0)" ::: "memory");
#pragma unroll 1
        for (int s = 0; s < PSH_N; ++s) {
            unsigned long long m0 = __ballot((el0 >> PSH_LOG) == s), m1 = __ballot((eh0 >> PSH_LOG) == s), m2 = __ballot((el1 >> PSH_LOG) == s), m3 = __ballot((eh1 >> PSH_LOG) == s),
                               m4 = __ballot((el2 >> PSH_LOG) == s), m5 = __ballot((eh2 >> PSH_LOG) == s), m6 = __ballot((el3 >> PSH_LOG) == s), m7 = __ballot((eh3 >> PSH_LOG) == s);
#pragma unroll 1
            while ((m0 | m1 | m2 | m3 | m4 | m5 | m6 | m7) != 0ull) {
                int qq[8]; float gk[8]; int es[8]; u32x4 uw[8]; int nv = 0; int elast = 0;
#pragma unroll
                for (int k = 0; k < 8; ++k) { bool got = false; int ee = elast; qq[k] = k > 0 ? qq[k - 1] : 0; gk[k] = 0.f;
                    PS3_TAKE(0, m0, el0, (size_t)row0 * 128) PS3_TAKE(1, m1, eh0, (size_t)row0 * 128 + 64) PS3_TAKE(2, m2, el1, (size_t)row1 * 128) PS3_TAKE(3, m3, eh1, (size_t)row1 * 128 + 64) PS3_TAKE(4, m4, el2, (size_t)row2 * 128) PS3_TAKE(5, m5, eh2, (size_t)row2 * 128 + 64) PS3_TAKE(6, m6, el3, (size_t)row3 * 128) PS3_TAKE(7, m7, eh3, (size_t)row3 * 128 + 64)
                    elast = ee; es[k] = ee; uw[k] = *(const u32x4*)(U + (size_t)ee * D_MODEL + 16 * lane); }
                float d[8];
#pragma unroll
                for (int k = 0; k < 8; ++k) { const int j = qq[k] >> 1; const u32x4 xa = *(const LAS u32x4*)(xs + j * 1024 + 16 * lane), xc = *(const LAS u32x4*)(xs + j * 1024 + 16 * lane + 8);
                    const f32x2 x2[8] = {(f32x2){bflo(xa.x), bfhi(xa.x)}, (f32x2){bflo(xa.y), bfhi(xa.y)}, (f32x2){bflo(xa.z), bfhi(xa.z)}, (f32x2){bflo(xa.w), bfhi(xa.w)}, (f32x2){bflo(xc.x), bfhi(xc.x)}, (f32x2){bflo(xc.y), bfhi(xc.y)}, (f32x2){bflo(xc.z), bfhi(xc.z)}, (f32x2){bflo(xc.w), bfhi(xc.w)}};
                    d[k] = dot16_fp8(uw[k], x2); }
                u32x4 vw[8];
#pragma unroll
                for (int k = 0; k < 8; ++k) vw[k] = *(const u32x4*)(Vt + (size_t)es[k] * D_MODEL + 16 * lane);
                float e4[4], e2[2], e1s;
                { const bool hi = lane & 1;
#pragma unroll
                  for (int i = 0; i < 4; ++i) { const float keep = hi ? d[4 + i] : d[i], send = hi ? d[i] : d[4 + i]; e4[i] = keep + __shfl_xor(send, 1); } }
                { const bool hi = lane & 2;
#pragma unroll
                  for (int i = 0; i < 2; ++i) { const float keep = hi ? e4[2 + i] : e4[i], send = hi ? e4[i] : e4[2 + i]; e2[i] = keep + __shfl_xor(send, 2); } }
                { const bool hi = lane & 4; const float keep = hi ? e2[1] : e2[0], send = hi ? e2[0] : e2[1]; e1s = keep + __shfl_xor(send, 4); }
                e1s += __shfl_xor(e1s, 8); e1s += __shfl_xor(e1s, 16); e1s += __shfl_xor(e1s, 32);
                const int myk = 4 * (lane & 1) + (lane & 2) + ((lane >> 2) & 1); float myg = gk[0];
#pragma unroll
                for (int k = 1; k < 8; ++k) myg = (myk == k) ? gk[k] : myg;
                const float act = myg * gelu_tanh(e1s * (1.0f / PEER_SU)) * (1.0f / PEER_SV);
#pragma unroll
                for (int k = 0; k < 8; ++k) { const int src = (k >> 2) | (((k >> 1) & 1) << 1) | ((k & 1) << 2); const float a = rdlane(act, src); const int j = qq[k] >> 1;
                    if (j == 0) { asm volatile("" ::: "memory"); axpy16_fp8(vw[k], a, oa0); } else if (j == 1) { asm volatile("" ::: "memory"); axpy16_fp8(vw[k], a, oa1); } else if (j == 2) { asm volatile("" ::: "memory"); axpy16_fp8(vw[k], a, oa2); } else { asm volatile("" ::: "memory"); axpy16_fp8(vw[k], a, oa3); } }
            }
        }
        PS2_LN(0) PS2_LN(1) PS2_LN(2) PS2_LN(3)
    }
}
}
namespace fx {
struct EpiB {
    static constexpr bool PERM = true, AFTER_DRAIN = false; const FP& P;
    DI void operator()(const f32x4 (&acc)[2][2][4][2], const pg8::Unit& u, int wr, int wc, int fr, int fq) const {
        const int t = u.pn;
        EPI_LOOP({ if (row < MP) { const int pos = row_pos(row), n = row / SEQ, e = ct & 63, dp = e >> 1; const bool prm = row < M0;
            if (t < 3) { const int ty = 2 * t + (ct >> 7), kvh = (ct >> 6) & 1;
                if (ty == 2 || ty == 4) { f32x4 lo, hi; rope4(P.ROPE + pos * 64, dp, v0, v1, lo, hi);
                    if (ty == 2) { float* o = (prm ? P.nsa_kv_p + (size_t)row * 512 : P.nsa_kv_s + (size_t)(row - M0) * 512) + 256 + kvh * 64 + dp; *(f32x4*)o = lo; *(f32x4*)(o + 32) = hi;
                        if (prm) { bf16* kt = P.SLK + ((size_t)n * NSA_KV_HEADS + kvh) * SEQ * 64; *(u32x2*)(kt + ktile_off(pos, dp)) = pk4(lo); *(u32x2*)(kt + ktile_off(pos, dp + 32)) = pk4(hi); } }
                    else { float* o = nullptr; if (!prm) o = P.win_s + (((size_t)(row - M0) * SWA_WINDOW + SWA_WINDOW - 1) * 2 + 0) * 128; else if (pos >= SEQ - SWA_WINDOW) o = P.win_p + (((size_t)n * SWA_WINDOW + pos - (SEQ - SWA_WINDOW)) * 2 + 0) * 128;
                        if (o) { *(f32x4*)(o + kvh * 64 + dp) = lo; *(f32x4*)(o + kvh * 64 + 32 + dp) = hi; }
                        if (prm) { bf16* kt = P.WNK + ((size_t)n * NSA_KV_HEADS + kvh) * SEQ * 64; *(u32x2*)(kt + ktile_off(pos, dp)) = pk4(lo); *(u32x2*)(kt + ktile_off(pos, dp + 32)) = pk4(hi); } } }
                else if (ty < 4) { float* o = (prm ? P.nsa_kv_p + (size_t)row * 512 : P.nsa_kv_s + (size_t)(row - M0) * 512) + ty * 128 + kvh * 64 + e; *(f32x4*)o = v0; *(f32x4*)(o + 4) = v1;
                    if (prm) { if (ty < 2) *(u32x4*)(P.AC + ((size_t)ty * ACROWS + ((size_t)n * NSA_KV_HEADS + kvh) * NCH + pos / 16) * 1024 + (pos % 16) * 64 + e) = pk8(v0, v1);
                        else { bf16* vt = P.SLVT + ((size_t)n * NSA_KV_HEADS + kvh) * SEQ * 64 + vtile_off(e, pos);
                            vt[0] = (bf16)f2bf(v0.x); vt[8] = (bf16)f2bf(v0.y); vt[16] = (bf16)f2bf(v0.z); vt[24] = (bf16)f2bf(v0.w); vt[32] = (bf16)f2bf(v1.x); vt[40] = (bf16)f2bf(v1.y); vt[48] = (bf16)f2bf(v1.z); vt[56] = (bf16)f2bf(v1.w); } } }
                else { float* o = nullptr; if (!prm) o = P.win_s + (((size_t)(row - M0) * SWA_WINDOW + SWA_WINDOW - 1) * 2 + 1) * 128; else if (pos >= SEQ - SWA_WINDOW) o = P.win_p + (((size_t)n * SWA_WINDOW + pos - (SEQ - SWA_WINDOW)) * 2 + 1) * 128;
                    if (o) { *(f32x4*)(o + kvh * 64 + e) = v0; *(f32x4*)(o + kvh * 64 + e + 4) = v1; }
                    if (prm) { bf16* vt = P.WNVT + ((size_t)n * NSA_KV_HEADS + kvh) * SEQ * 64 + vtile_off(e, pos);
                        vt[0] = (bf16)f2bf(v0.x); vt[8] = (bf16)f2bf(v0.y); vt[16] = (bf16)f2bf(v0.z); vt[24] = (bf16)f2bf(v0.w); vt[32] = (bf16)f2bf(v1.x); vt[40] = (bf16)f2bf(v1.y); vt[48] = (bf16)f2bf(v1.z); vt[56] = (bf16)f2bf(v1.w); } } }
            else if (t < 6) { const int h = (t - 3) * 4 + (ct >> 6); f32x4 lo, hi; rope4(P.ROPE + pos * 64, dp, v0, v1, lo, hi); bf16* q = P.QB + (size_t)row * NSA_Q_COLS + h * 64 + dp; *(u32x2*)q = pk4(lo * QSCALE); *(u32x2*)(q + 32) = pk4(hi * QSCALE); }
            else if (t == 6) { *(u32x4*)(P.MQB + (size_t)row * 256 + ct) = pk8(v0 * QSCALE, v1 * QSCALE); }
            else if (ct < 40) { const float vv[8] = {v0.x, v0.y, v0.z, v0.w, v1.x, v1.y, v1.z, v1.w};
                _Pragma("unroll") for (int i = 0; i < 8; ++i) if (ct + i < NSA_GATE_COLS) P.GATES[(size_t)row * 64 + ct + i] = 1.0f / (1.0f + __expf(-vv[i])); } } })
    }
};
DI void cmp2_phase(const FP& P, const Ctx& C) {
    const int lane = C.lane; LAS float* hs = (LAS float*)(C.lds + C.wave * 1024);
    constexpr int NGRP = NCTX * 2 * NSA_KV_HEADS; const int NW = C.G * NWAVES, WPG = NW / NGRP > 0 ? NW / NGRP : 1; const int gw = C.vcu * NWAVES + C.wave;
#pragma unroll 1
    for (int grp = gw / WPG; grp < NGRP; grp += (NW + WPG - 1) / WPG) { const int slot = gw % WPG; if (gw >= (NW / WPG) * WPG && grp == gw / WPG) break;
        const int kvh = grp % NSA_KV_HEADS, ty = (grp / NSA_KV_HEADS) % 2, ctx = grp / (2 * NSA_KV_HEADS);
        const float* UL = P.UL + ((size_t)ty * ACROWS + ((size_t)ctx * NSA_KV_HEADS + kvh) * NCH) * 256; const float* w2 = P.cmp_w2 + (size_t)ty * CMP_HIDDEN * HEAD_DIM;
        float w2r[CMP_HIDDEN];
#pragma unroll
        for (int k = 0; k < CMP_HIDDEN; ++k) w2r[k] = w2[k * HEAD_DIM + lane];
        const float b0 = P.CBIAS[ty * CMP_HIDDEN + lane], b1 = P.CBIAS[ty * CMP_HIDDEN + 64 + lane];
        float u0, u1, l0, l1; int c = slot;
        if (c < NCMP) { u0 = UL[(size_t)c * 256 + lane]; u1 = UL[(size_t)c * 256 + 64 + lane]; l0 = UL[(size_t)(c + 1) * 256 + 128 + lane]; l1 = UL[(size_t)(c + 1) * 256 + 192 + lane]; }
#pragma unroll 1
        for (; c < NCMP; c += WPG) { const float h0 = gelu_tanh(u0 + l0 + b0), h1 = gelu_tanh(u1 + l1 + b1); const int cn = c + WPG;
            if (cn < NCMP) { u0 = UL[(size_t)cn * 256 + lane]; u1 = UL[(size_t)cn * 256 + 64 + lane]; l0 = UL[(size_t)(cn + 1) * 256 + 128 + lane]; l1 = UL[(size_t)(cn + 1) * 256 + 192 + lane]; }
            hs[lane] = h0; hs[64 + lane] = h1; asm volatile("s_waitcnt lgkmcnt(0)" ::: "memory");
            float a = 0.f;
#pragma unroll
            for (int k4 = 0; k4 < CMP_HIDDEN / 4; ++k4) { const f32x4 hv = *(const LAS f32x4*)(hs + 4 * k4); a += hv.x * w2r[4 * k4] + hv.y * w2r[4 * k4 + 1] + hv.z * w2r[4 * k4 + 2] + hv.w * w2r[4 * k4 + 3]; }
            if (ty == 0) { const float other = __shfl_xor(a, 32); const int pos = c * CMP_STRIDE + CMP_BLOCK - 1; const float cs = P.ROPE[pos * 64 + (lane & 31)], sn = P.ROPE[pos * 64 + 32 + (lane & 31)];
                a = (lane < 32) ? a * cs - other * sn : a * cs + other * sn; }
            if (ctx < BATCH) { if (ty == 0) P.CK[((size_t)ctx * NSA_KV_HEADS + kvh) * NCH * 64 + ktile_off(c, lane)] = (bf16)f2bf(a); else P.CVT[((size_t)ctx * NSA_KV_HEADS + kvh) * NCH * 64 + vtile_off(lane, c)] = (bf16)f2bf(a); }
            else { (ty == 0 ? P.CKF : P.CVF)[(((size_t)(ctx - BATCH) * NSA_KV_HEADS + kvh) * NCH + c) * 64 + lane] = a; }
            asm volatile("s_waitcnt lgkmcnt(0)" ::: "memory"); }
    }
    __syncthreads();
}
constexpr int NSA_WLDS = 8192;
DI void nsa_pair_a(const FP& P, int n, int kvh, int t, int lane, LAS unsigned char* wl) {
    LAS float* pn = (LAS float*)wl; LAS float* imp = (LAS float*)(wl + 2048); LAS float* sc = (LAS float*)(wl + 6144); LAS int* sel = (LAS int*)(wl + 7168);
    const int col = lane & 15, c = lane >> 4; const bool vcol = col < 12; const int qq = vcol ? col / 6 : 0, hh = vcol ? col % 6 : 0, tq = t + qq, head = kvh * NSA_GROUP + hh, row = n * SEQ + tq;
    bf16x8 qf[2]; { const bf16* qp = P.QB + (size_t)row * NSA_Q_COLS + head * 64 + 8 * c; qf[0] = *(const bf16x8*)qp; qf[1] = *(const bf16x8*)(qp + 32); }
    const float* gt = P.GATES + (size_t)row * 64 + head * 3;
    f32x4 oacc[4] = {(f32x4){0.f, 0.f, 0.f, 0.f}, (f32x4){0.f, 0.f, 0.f, 0.f}, (f32x4){0.f, 0.f, 0.f, 0.f}, (f32x4){0.f, 0.f, 0.f, 0.f}};
    const int lim = vcol ? ((tq >= CMP_BLOCK - 1) ? (tq - (CMP_BLOCK - 1)) / CMP_STRIDE : -1) : -1;
    const int limmax = (t + 1 >= CMP_BLOCK - 1) ? (t + 1 - (CMP_BLOCK - 1)) / CMP_STRIDE : -1; const int nblk = (limmax + 32) / 32;
    const bf16* CKb = P.CK + ((size_t)n * NSA_KV_HEADS + kvh) * NCH * 64; const bf16* CVb = P.CVT + ((size_t)n * NSA_KV_HEADS + kvh) * 64 * NCH;
    for (int i = lane; i < 1024; i += 64) imp[i] = 0.f;
    float m1 = -INFINITY, l1 = 0.f;
    { struct K4 { bf16x8 a0, a1, b0, b1; };
      auto ldk = [&](K4& k, int blk) { const bf16* kt = CKb + (size_t)blk * 2048 + lane * 8; k.a0 = *(const bf16x8*)kt; k.a1 = *(const bf16x8*)(kt + 512); k.b0 = *(const bf16x8*)(kt + 1024); k.b1 = *(const bf16x8*)(kt + 1536); };
      auto cp1 = [&](const K4& k, int blk) { const int kb = 32 * blk;
        f32x4 s0 = (f32x4){0.f, 0.f, 0.f, 0.f}, s1 = (f32x4){0.f, 0.f, 0.f, 0.f};
        s0 = __builtin_amdgcn_mfma_f32_16x16x32_bf16(k.a0, qf[0], s0, 0, 0, 0); s0 = __builtin_amdgcn_mfma_f32_16x16x32_bf16(k.a1, qf[1], s0, 0, 0, 0);
        s1 = __builtin_amdgcn_mfma_f32_16x16x32_bf16(k.b0, qf[0], s1, 0, 0, 0); s1 = __builtin_amdgcn_mfma_f32_16x16x32_bf16(k.b1, qf[1], s1, 0, 0, 0);
        float s[8] = {s0.x, s0.y, s0.z, s0.w, s1.x, s1.y, s1.z, s1.w}; float mx = -INFINITY;
        const int hi1 = lim - (kb + 8 * c);
#pragma unroll
        for (int e = 0; e < 8; ++e) { s[e] = (e <= hi1) ? s[e] : -INFINITY; mx = fmaxf(mx, s[e]); }
        mx = fmaxf(mx, __shfl_xor(mx, 16)); mx = fmaxf(mx, __shfl_xor(mx, 32));
        const float mnew = fmaxf(m1, mx), muse = (mnew == -INFINITY) ? 0.f : mnew; float ls = 0.f;
#pragma unroll
        for (int e = 0; e < 8; ++e) ls += __builtin_amdgcn_exp2f(s[e] - muse);
        ls += __shfl_xor(ls, 16); ls += __shfl_xor(ls, 32);
        l1 = l1 * __builtin_amdgcn_exp2f(m1 - muse) + ls; m1 = mnew; };
      if (nblk > 0) { K4 A, B; ldk(A, 0);
#pragma unroll 1
        for (int blk = 0; blk < nblk; blk += 2) { ldk(B, (blk + 1 < nblk) ? blk + 1 : blk); cp1(A, blk); ldk(A, (blk + 2 < nblk) ? blk + 2 : blk); if (blk + 1 < nblk) cp1(B, blk + 1); } } }
    asm volatile("s_waitcnt lgkmcnt(0)" ::: "memory");
    { const float muse = (m1 == -INFINITY) ? 0.f : m1, inv = (l1 > 0.f) ? 1.0f / l1 : 0.f;
      f32x4 oc[4] = {(f32x4){0.f, 0.f, 0.f, 0.f}, (f32x4){0.f, 0.f, 0.f, 0.f}, (f32x4){0.f, 0.f, 0.f, 0.f}, (f32x4){0.f, 0.f, 0.f, 0.f}};
      pipe2(nblk, [&](KV8& kv, int blk) { kv_load_t(kv, CKb + (size_t)blk * 2048, CVb + (size_t)blk * 2048, lane); }, [&](const KV8& kv, int blk) { const int kb = 32 * blk;
        f32x4 s0 = (f32x4){0.f, 0.f, 0.f, 0.f}, s1 = (f32x4){0.f, 0.f, 0.f, 0.f};
        s0 = __builtin_amdgcn_mfma_f32_16x16x32_bf16(kv.ka0, qf[0], s0, 0, 0, 0); s0 = __builtin_amdgcn_mfma_f32_16x16x32_bf16(kv.ka1, qf[1], s0, 0, 0, 0);
        s1 = __builtin_amdgcn_mfma_f32_16x16x32_bf16(kv.kb0, qf[0], s1, 0, 0, 0); s1 = __builtin_amdgcn_mfma_f32_16x16x32_bf16(kv.kb1, qf[1], s1, 0, 0, 0);
        float s[8] = {s0.x, s0.y, s0.z, s0.w, s1.x, s1.y, s1.z, s1.w};
        const int hi2 = lim - (kb + 8 * c);
#pragma unroll
        for (int e = 0; e < 8; ++e) s[e] = (e <= hi2) ? __builtin_amdgcn_exp2f(s[e] - muse) * inv : 0.f;
        *(f32x4*)(pn + col * 32 + 8 * c) = (f32x4){s[0], s[1], s[2], s[3]}; *(f32x4*)(pn + col * 32 + 8 * c + 4) = (f32x4){s[4], s[5], s[6], s[7]};
        u32x4 pw; pw.x = cvtpk(s[0], s[1]); pw.y = cvtpk(s[2], s[3]); pw.z = cvtpk(s[4], s[5]); pw.w = cvtpk(s[6], s[7]); const bf16x8 pf = __builtin_bit_cast(bf16x8, pw);
        oc[0] = __builtin_amdgcn_mfma_f32_16x16x32_bf16(kv.v0, pf, oc[0], 0, 0, 0); oc[1] = __builtin_amdgcn_mfma_f32_16x16x32_bf16(kv.v1, pf, oc[1], 0, 0, 0);
        oc[2] = __builtin_amdgcn_mfma_f32_16x16x32_bf16(kv.v2, pf, oc[2], 0, 0, 0); oc[3] = __builtin_amdgcn_mfma_f32_16x16x32_bf16(kv.v3, pf, oc[3], 0, 0, 0);
        asm volatile("s_waitcnt lgkmcnt(0)" ::: "memory");
        { const int q2 = lane >> 5, k = lane & 31; float a = 0.f;
#pragma unroll
          for (int h6 = 0; h6 < 6; ++h6) a += pn[(q2 * 6 + h6) * 32 + k];
          imp[q2 * 512 + kb + k] = a; }
        asm volatile("s_waitcnt lgkmcnt(0)" ::: "memory"); });
#ifdef NSA_DEBUG
      if (vcol) { for (int db = 0; db < 4; ++db) *(f32x4*)(P.DBG + ((size_t)0 * MP + row) * 768 + head * 64 + 16 * db + 4 * c) = oc[db]; }
#endif
      const float g0 = vcol ? gt[0] : 0.f;
#pragma unroll
      for (int db = 0; db < 4; ++db) oacc[db] += oc[db] * g0; }
#ifndef REP_SEL
#define REP_SEL 1
#endif
#pragma unroll 1
    for (int rep = 0; rep < REP_SEL; ++rep) {
    for (int i = lane; i < 256; i += 64) { const int q2 = i >> 7, b = i & 127, tq2 = t + q2, cur = tq2 / SLC_BLOCK; float sv;
        if (b > cur) sv = NEG; else if (b == 0 || b == cur || b == cur - 1) sv = FORCE_SCORE;
        else { const LAS float* ic = imp + q2 * 512 + 4 * b; sv = ic[-1] + 2.f * (ic[0] + ic[1] + ic[2]) + ic[3]; }
        sc[i] = pack_key(sv, 127u - (unsigned)b, 127u); }
    asm volatile("s_waitcnt lgkmcnt(0)" ::: "memory");
    for (int i = lane; i < 256; i += 64) { const int q2 = i >> 7, b = i & 127; const float sv = sc[i]; int rank = 0;
        for (int j = 0; j < 128; j += 4) { const f32x4 o = *(const LAS f32x4*)(sc + q2 * 128 + j);
            rank += (o.x > sv) ? 1 : 0; rank += (o.y > sv) ? 1 : 0; rank += (o.z > sv) ? 1 : 0; rank += (o.w > sv) ? 1 : 0; }
        if (rank < SLC_TOPK) { const int v = (sv > 0.5f * NEG) ? b : -1; sel[q2 * 16 + rank] = v; P.SELB[((size_t)(n * SEQ + t + q2) * NSA_KV_HEADS + kvh) * 16 + rank] = v; } }
    asm volatile("s_waitcnt lgkmcnt(0)" ::: "memory");
    }
#ifndef REP_WIN
#define REP_WIN 1
#endif
#pragma unroll 1
    for (int rep = 0; rep < REP_WIN; ++rep) { Tile16 T; tile_init(T);
      const bf16* WKb = P.WNK + ((size_t)n * NSA_KV_HEADS + kvh) * SEQ * 64; const bf16* WVb = P.WNVT + ((size_t)n * NSA_KV_HEADS + kvh) * 64 * SEQ;
      const int blo = (t - SWA_WINDOW) >> 5, bhi = (t + 1) >> 5;
      auto ld = [&](KV8& kv, int blk) { const int bc = blk < 0 ? 0 : blk; kv_load_t(kv, WKb + (size_t)bc * 2048, WVb + (size_t)bc * 2048, lane); };
      pipe2(bhi - blo + 1, [&](KV8& kv, int i) { ld(kv, blo + i); }, [&](const KV8& kv, int i) { const int kb = 32 * (blo + i);
          const int k0 = kb + 8 * c; int lo; unsigned rng; const int a = tq - SWA_WINDOW; mk_range((a > 0 ? a : 0) - k0, tq - k0, vcol, lo, rng); tile_compute(T, qf, kv, lo, rng); });
      const float inv = (T.l > 0.f) ? 1.0f / T.l : 0.f, g2 = vcol ? gt[2] * inv : 0.f;
#ifdef NSA_DEBUG
      if (vcol) { for (int db = 0; db < 4; ++db) *(f32x4*)(P.DBG + ((size_t)2 * MP + row) * 768 + head * 64 + 16 * db + 4 * c) = T.o[db] * inv; }
#endif
#pragma unroll
      for (int db = 0; db < 4; ++db) if (rep == REP_WIN - 1) oacc[db] += T.o[db] * g2; }
    if (vcol) { float* op = P.DPART + (size_t)row * 768 + head * 64 + 4 * c;
#pragma unroll
        for (int db = 0; db < 4; ++db) *(f32x4*)(op + 16 * db) = oacc[db]; }
}
DI void nsa_pair_b(const FP& P, int n, int kvh, int t, int lane, LAS unsigned char* wl) {
    LAS int* steps = (LAS int*)wl;
    const int col = lane & 15, c = lane >> 4; const bool vcol = col < 12; const int qq = vcol ? col / 6 : 0, hh = vcol ? col % 6 : 0, tq = t + qq, head = kvh * NSA_GROUP + hh, row = n * SEQ + tq;
    bf16x8 qf[2]; { const bf16* qp = P.QB + (size_t)row * NSA_Q_COLS + head * 64 + 8 * c; qf[0] = *(const bf16x8*)qp; qf[1] = *(const bf16x8*)(qp + 32); }
    const float* gt = P.GATES + (size_t)row * 64 + head * 3;
    Tile16 T; tile_init(T);
    const bf16* SKb = P.SLK + ((size_t)n * NSA_KV_HEADS + kvh) * SEQ * 64; const bf16* SVb = P.SLVT + ((size_t)n * NSA_KV_HEADS + kvh) * SEQ * 64;
    int ns = 0;
    { const int mysel = (lane < 32) ? P.SELB[((size_t)(n * SEQ + t + (lane >> 4)) * NSA_KV_HEADS + kvh) * 16 + (lane & 15)] : -1;
      for (int i = 0; i < 32; ++i) { const int b = __builtin_amdgcn_readlane(mysel, i); if (b < 0) continue; int q2 = i >> 4;
          const unsigned long long other = __ballot(mysel == b && lane < 32 && (lane >> 4) != q2);
          if (other) { if (q2 == 1) continue; q2 = 2; }
          if (lane == 0) { steps[ns] = (b * SLC_BLOCK) | (q2 << 29); steps[ns + 1] = (b * SLC_BLOCK + 32) | (q2 << 29); } ns += 2; } }
    asm volatile("s_waitcnt lgkmcnt(0)" ::: "memory");
    auto ld = [&](KV8& kv, int i) { const int code = __builtin_amdgcn_readfirstlane(steps[i]); const int kb = code & 0x1fffffff;
        kv_load_t(kv, SKb + (size_t)(kb >> 5) * 2048, SVb + (size_t)(kb >> 5) * 2048, lane); };
#ifdef PROBE_DBLCOMP
    Tile16 T2; tile_init(T2);
#endif
    pipe2(ns, ld, [&](const KV8& kv, int i) { const int code = __builtin_amdgcn_readfirstlane(steps[i]); const int kb = code & 0x1fffffff, q2 = code >> 29;
        int lo; unsigned rng; mk_range(-64, tq - (kb + 8 * c), vcol && (q2 == 2 || qq == q2), lo, rng); tile_compute(T, qf, kv, lo, rng);
#ifdef PROBE_DBLCOMP
        tile_compute(T2, qf, kv, [&](int e) { return vcol && qq == q2 && (kb + 8 * c + e + 1) <= tq; });
#endif
    });
#ifdef PROBE_DBLCOMP
    if (T2.l < 0.f) T.l = 0.f;
#endif
    const float inv = (T.l > 0.f) ? 1.0f / T.l : 0.f, g1 = vcol ? gt[1] * inv : 0.f;
#ifdef NSA_DEBUG
    if (vcol) { for (int db = 0; db < 4; ++db) *(f32x4*)(P.DBG + ((size_t)1 * MP + row) * 768 + head * 64 + 16 * db + 4 * c) = T.o[db] * inv; }
#endif
    if (vcol) { const float* pp = P.DPART + (size_t)row * 768 + head * 64 + 4 * c; bf16* op = P.ATTB + (size_t)row * 1024 + head * 64 + 4 * c;
#pragma unroll
        for (int db = 0; db < 4; ++db) *(u32x2*)(op + 16 * db) = pk4(*(const f32x4*)(pp + 16 * db) + T.o[db] * g1); }
}

constexpr int SMP_SK = 1088;
template <class KF, class VF> DI void smp_branch(const Ctx& C, LAS float* qs, LAS float* S, LAS float* red, int NK, KF kf, VF vf, bool keep_probs, float (&outh)[1]) {
    const int tid = C.tid, lane = C.lane, w = C.wave;
#pragma unroll 1
    for (int j = tid; j < NK; j += NTHREADS) { const float* k = kf(j); f32x4 kr[16];
#pragma unroll
        for (int d4 = 0; d4 < 16; ++d4) kr[d4] = *(const f32x4*)(k + 4 * d4);
#pragma unroll 1
        for (int h = 0; h < 6; ++h) { float a = 0.f;
#pragma unroll
            for (int d4 = 0; d4 < 16; ++d4) { const f32x4 qv = *(const LAS f32x4*)(qs + h * 64 + 4 * d4); a += kr[d4].x * qv.x + kr[d4].y * qv.y + kr[d4].z * qv.z + kr[d4].w * qv.w; }
            S[h * SMP_SK + j] = a; } }
    asm volatile("s_waitcnt lgkmcnt(0)" ::: "memory"); __syncthreads();
    if (w < 6) { float m = -INFINITY; for (int j = lane; j < NK; j += 64) m = fmaxf(m, S[w * SMP_SK + j]); m = wave_max(m);
        float l = 0.f; for (int j = lane; j < NK; j += 64) { const float p = __builtin_amdgcn_exp2f(S[w * SMP_SK + j] - m); S[w * SMP_SK + j] = p; l += p; } l = wave_sum(l);
        const float inv = 1.0f / l; for (int j = lane; j < NK; j += 64) S[w * SMP_SK + j] *= inv; }
    asm volatile("s_waitcnt lgkmcnt(0)" ::: "memory"); __syncthreads();
    { const int per = (NK + NWAVES - 1) / NWAVES, j0 = w * per, j1 = (j0 + per < NK) ? j0 + per : NK; float o[6] = {0.f, 0.f, 0.f, 0.f, 0.f, 0.f};
#pragma unroll 1
      for (int j = j0; j < j1; j += 8) { float vv[8];
#pragma unroll
          for (int u = 0; u < 8; ++u) { const int jj = (j + u < j1) ? j + u : j1 - 1; vv[u] = vf(jj)[lane]; }
#pragma unroll
          for (int u = 0; u < 8; ++u) if (j + u < j1) {
#pragma unroll
              for (int h = 0; h < 6; ++h) o[h] += S[h * SMP_SK + j + u] * vv[u]; } }
#pragma unroll
      for (int h = 0; h < 6; ++h) red[(w * 6 + h) * 64 + lane] = o[h]; }
    asm volatile("s_waitcnt lgkmcnt(0)" ::: "memory"); __syncthreads();
    outh[0] = 0.f;
    if (tid < 384) { float a = 0.f;
#pragma unroll
        for (int ww = 0; ww < NWAVES; ++ww) a += red[ww * 384 + tid]; outh[0] = a; }
    if (!keep_probs) { __syncthreads(); }
}
DI void nsa_sample_item(const FP& P, const Ctx& C, int ns, int kvh) {
    LAS float* qs = (LAS float*)C.lds; LAS float* S = qs + 384; LAS float* red = S + 6 * SMP_SK; LAS float* scs = red + 8 * 384; LAS int* sel = (LAS int*)(scs + 136);
    const int tid = C.tid, row = M0 + ns;
    if (tid < 384) qs[tid] = bf2f(P.QB[(size_t)row * NSA_Q_COLS + kvh * 384 + tid]);
    asm volatile("s_waitcnt lgkmcnt(0)" ::: "memory"); __syncthreads();
    const float* ckf = P.CKF + ((size_t)ns * NSA_KV_HEADS + kvh) * NCH * 64; const float* cvf = P.CVF + ((size_t)ns * NSA_KV_HEADS + kvh) * NCH * 64;
    float oc[1], os[1], ow[1];
    smp_branch(C, qs, S, red, NCMP, [&](int j) { return ckf + (size_t)j * 64; }, [&](int j) { return cvf + (size_t)j * 64; }, true, oc);
    constexpr int NBS = (PAST_LEN + 1 + SLC_BLOCK - 1) / SLC_BLOCK, CURS = PAST_LEN / SLC_BLOCK;
    for (int b = tid; b < 136; b += NTHREADS) { float sv = -3.0e38f;
        if (b < NBS) { if (b == 0 || b == CURS || b == CURS - 1) sv = FORCE_SCORE; else { float a = 0.f;
#pragma unroll
                for (int o = -1; o <= 3; ++o) { const int ci = 4 * b + o; if (ci >= 0 && ci < NCMP) { float sm = 0.f; for (int h6 = 0; h6 < 6; ++h6) sm += S[h6 * SMP_SK + ci]; a += ((o >= 0 && o <= 2) ? 2.f : 1.f) * sm; } }
                sv = a; } }
        scs[b] = sv; }
    asm volatile("s_waitcnt lgkmcnt(0)" ::: "memory"); __syncthreads();
    for (int b = tid; b < NBS; b += NTHREADS) { const float sv = scs[b]; int rank = 0; for (int j = 0; j < NBS; ++j) { const float o = scs[j]; rank += (o > sv || (o == sv && j < b)) ? 1 : 0; }
        if (rank < SLC_TOPK) { sel[rank] = b; P.SELB[((size_t)row * NSA_KV_HEADS + kvh) * 16 + rank] = b; } }
    asm volatile("s_waitcnt lgkmcnt(0)" ::: "memory"); __syncthreads();
    { const float* newrow = P.nsa_kv_s + (size_t)ns * 512; const int* pt = P.page_table + ns * (PAST_LEN / PAGE_SIZE);
      if (tid == 0) { int seen = 0; for (int x = 0; x < SLC_TOPK; ++x) { const int bx = sel[x]; if (bx != CURS && seen < 15) sel[16 + seen++] = bx; } }
      asm volatile("s_waitcnt lgkmcnt(0)" ::: "memory"); __syncthreads();
      auto krow = [&](int j, int ty) -> const float* { if (j >= 15 * 64) return newrow + ty * 128 + kvh * 64;
          const int t0 = sel[16 + (j >> 6)] * SLC_BLOCK + (j & 63); const int pg = pt[t0 / PAGE_SIZE]; return P.cache_nsa_kv + ((size_t)pg * PAGE_SIZE + t0 % PAGE_SIZE) * 512 + ty * 128 + kvh * 64; };
      smp_branch(C, qs, S, red, 15 * 64 + 1, [&](int j) { return krow(j, 2); }, [&](int j) { return krow(j, 3); }, false, os); }
    { const float* wc = P.cache_nsa_win + (size_t)ns * SWA_WINDOW * 256; const float* newrow = P.win_s + ((size_t)ns * SWA_WINDOW + SWA_WINDOW - 1) * 256;
      smp_branch(C, qs, S, red, SWA_WINDOW + 1, [&](int j) { return (j < SWA_WINDOW ? wc + (size_t)j * 256 : newrow) + kvh * 64; }, [&](int j) { return (j < SWA_WINDOW ? wc + (size_t)j * 256 : newrow) + 128 + kvh * 64; }, false, ow); }
    if (tid < 384) { const int head = kvh * NSA_GROUP + tid / 64; const float* gt = P.GATES + (size_t)row * 64 + head * 3;
        P.ATTB[(size_t)row * 1024 + kvh * 384 + tid] = (bf16)f2bf(gt[0] * oc[0] + gt[1] * os[0] + gt[2] * ow[0]);
#ifdef NSA_DEBUG
        P.DBG[((size_t)0 * MP + row) * 768 + kvh * 384 + tid] = oc[0]; P.DBG[((size_t)1 * MP + row) * 768 + kvh * 384 + tid] = os[0]; P.DBG[((size_t)2 * MP + row) * 768 + kvh * 384 + tid] = ow[0];
#endif
    }
    __syncthreads();
}
DI void nsa_pairs(const FP& P, const Ctx& C, bool second) {
    LAS unsigned char* wl = C.lds + C.wave * NSA_WLDS;
    const int per = C.G / 4 > 0 ? C.G / 4 : 1, grp = (C.vcu / per) & 3, sub = C.vcu % per, n = grp >> 1, kvh = grp & 1;
#pragma unroll 1
    for (int pr = sub * NWAVES + C.wave; pr < SEQ / 2; pr += per * NWAVES) { if (second) nsa_pair_b(P, n, kvh, 2 * pr, C.lane, wl); else nsa_pair_a(P, n, kvh, 2 * pr, C.lane, wl); }
}
DI void nsa_phase_a(const FP& P, const Ctx& C) {
    for (int it = C.vcu; it < DEC_BATCH * NSA_KV_HEADS; it += C.G) nsa_sample_item(P, C, it / NSA_KV_HEADS, it % NSA_KV_HEADS);
    nsa_pairs(P, C, false);
    __syncthreads();
}
DI void nsa_phase_b(const FP& P, const Ctx& C) {
    const int lane = C.lane, w = C.wave;
    nsa_pairs(P, C, true);
    __syncthreads();
    { constexpr int NMT = (M0 / 16) * MEM_HEADS;
      for (int it = C.vcu * NWAVES + w; it < NMT; it += C.G * NWAVES) { const int h = it % MEM_HEADS, q16 = it / MEM_HEADS, row0 = q16 * 16, n = row0 / SEQ;
          mem_micro(P, P.MQB + h * 64, 256, row0, 1, n, h, P.ATTB + NSA_Q_COLS + h * 64, 1024, lane); }
    }
    { LAS float* qs = (LAS float*)C.lds;
      for (int it = C.vcu; it < DEC_BATCH * MEM_HEADS; it += C.G) { const int h = it % MEM_HEADS, ns = it / MEM_HEADS, row = M0 + ns;
          __syncthreads(); if (C.tid < 64) qs[C.tid] = bf2f(P.MQB[(size_t)row * 256 + h * 64 + C.tid]); asm volatile("s_waitcnt lgkmcnt(0)" ::: "memory"); __syncthreads();
          Dec D; D.m = -INFINITY; D.l = 0.f; D.o = 0.f; const float* mk = P.cache_mem_kv + ((size_t)1 * DEC_BATCH + ns) * MEM_TOKENS * 512;
          for (int ck = w; ck < MEM_TOKENS / 64; ck += NWAVES) { const int j0 = ck * 64; dec_chunk(D, qs, 64, [&](int j) { return mk + (size_t)(j0 + j) * 512 + h * 64; }, [&](int j) { return mk + (size_t)(j0 + j) * 512 + 256 + h * 64; }, lane); }
          const float o = dec_combine(C, D);
          if (w == 0) P.ATTB[(size_t)row * 1024 + NSA_Q_COLS + h * 64 + lane] = (bf16)f2bf(o); } }
    __syncthreads();
}
}
namespace fx {
enum { PH_PRO = 0, PH_G1, PH_ATTA, PH_G2, PH_LN1, PH_SC0, PH_TK0, PH_PU0, PH_PG0, PH_G3, PH_CMPG, PH_CMP2, PH_NSA, PH_NSB, PH_G4, PH_LN3, PH_SC1, PH_TK1, PH_PU1, PH_PG1, PH_COUNT };
template <class Epi> DI void run_gemm(const Ctx& C, const bf16* A, const bf16* Bt, int M, int N, int K, const Epi& E) {
    pg8::Gemm g{A, Bt, M, N, K}; pg8::StaticOrder S; S.init(M, N, C.G, (int)blockIdx.x);
    pg8::gemm_phase<Epi, pg8::StaticOrder, true, true>(C.lds, g, S, E);
}
template <class Epi> DI void skinny_gemm(const Ctx& C, const bf16* A, const bf16* Bt, int N, int K, const Epi& E) {
    static_assert(DEC_BATCH == 32 && M0 % 256 == 0, "skinny_gemm: 32 sample rows right after a whole number of 256-row tiles");
    const int lane = C.lane, fr = lane & 15, fq = lane >> 4, w = C.wave; const int NI = (N / 256) * 4, KW = K / NWAVES;
    LAS f32x4* red = (LAS f32x4*)C.lds;
#pragma unroll 1
    for (int item = C.vcu; item < NI; item += C.G) { const int pn = item >> 2, wc = item & 3;
        f32x4 pa[2][2][2];
#pragma unroll
        for (int i = 0; i < 8; ++i) (&pa[0][0][0])[i] = (f32x4){0.f, 0.f, 0.f, 0.f};
        const bf16* xa = A + (size_t)(M0 + fr) * K + w * KW + 8 * fq; const bf16* xb = xa + (size_t)16 * K;
        const bf16* wp[2][2];
#pragma unroll
        for (int bj = 0; bj < 2; ++bj)
#pragma unroll
            for (int n = 0; n < 2; ++n) wp[bj][n] = Bt + (size_t)(pn * 256 + bj * 128 + wc * 32 + 8 * (fr >> 2) + 4 * n + (fr & 3)) * K + w * KW + 8 * fq;
#pragma unroll 4
        for (int k0 = 0; k0 < KW; k0 += 32) { const bf16x8 x0 = *(const bf16x8*)(xa + k0), x1 = *(const bf16x8*)(xb + k0);
#pragma unroll
            for (int bj = 0; bj < 2; ++bj)
#pragma unroll
                for (int n = 0; n < 2; ++n) { const bf16x8 wf = *(const bf16x8*)(wp[bj][n] + k0);
                    pa[bj][0][n] = __builtin_amdgcn_mfma_f32_16x16x32_bf16(wf, x0, pa[bj][0][n], 0, 0, 0); pa[bj][1][n] = __builtin_amdgcn_mfma_f32_16x16x32_bf16(wf, x1, pa[bj][1][n], 0, 0, 0); } }
        __syncthreads();
#pragma unroll
        for (int bj = 0; bj < 2; ++bj)
#pragma unroll
            for (int mm = 0; mm < 2; ++mm)
#pragma unroll
                for (int n = 0; n < 2; ++n) red[(w * 8 + bj * 4 + mm * 2 + n) * 64 + lane] = pa[bj][mm][n];
        asm volatile("s_waitcnt lgkmcnt(0)" ::: "memory"); __syncthreads();
        if (w == 0) { f32x4 acc[2][2][4][2];
#pragma unroll
            for (int i = 0; i < 32; ++i) (&acc[0][0][0][0])[i] = (f32x4){0.f, 0.f, 0.f, 0.f};
#pragma unroll
            for (int bj = 0; bj < 2; ++bj)
#pragma unroll
                for (int mm = 0; mm < 2; ++mm)
#pragma unroll
                    for (int n = 0; n < 2; ++n) { f32x4 s = red[(bj * 4 + mm * 2 + n) * 64 + lane];
#pragma unroll 1
                        for (int ww = 1; ww < NWAVES; ++ww) s += red[(ww * 8 + bj * 4 + mm * 2 + n) * 64 + lane];
                        acc[0][bj][mm][n] = s; }
            E(acc, pg8::Unit{M0 / 256, pn}, 0, wc, fr, fq); }
    }
    __syncthreads();
}
__global__ void __launch_bounds__(NTHREADS, 2) mega(Args args) {
    extern __shared__ __attribute__((aligned(16))) unsigned char lds_raw[];
    Ctx C; C.lds = (LAS unsigned char*)lds_raw; C.tid = threadIdx.x; C.lane = C.tid & 63; C.wave = __builtin_amdgcn_readfirstlane(C.tid >> 6);
    C.G = gridDim.x; { const int bx = blockIdx.x; C.vcu = (C.G % 8 == 0) ? (bx % 8) * (C.G / 8) + bx / 8 : bx; }
    const FP& P = args.p;
    volatile LAS unsigned* MISC = (volatile LAS unsigned*)(C.lds + MISC_OFF);
    for (int u = C.tid; u < (LDS_BYTES - RING_BYTES) / 4; u += NTHREADS) ((LAS unsigned*)(C.lds + RING_BYTES))[u] = 0u;
    __syncthreads();
    const int lo = args.lo, hi = args.hi;
    XcdBarrier bar; bar.bar = P.ctl + 1024; bar.x = 0; bar.st = nullptr;
    if (hi - lo > 1) bar = xcd_barrier_post(P.ctl + 1024, MISC + 8);
#define IN(k) (lo <= (k) && (k) < hi)
#define SEAM(k) do { if (IN(k) && IN((k) + 1)) xcd_barrier(bar); } while (0)
#ifndef DUP_PHASE
#define DUP_PHASE -1
#endif
#define PHASE(k, ...) do { if (IN(k)) { __VA_ARGS__ if (DUP_PHASE == (k)) { __syncthreads(); __VA_ARGS__ } } SEAM(k); } while (0)
    PHASE(PH_PRO, p0_prologue(P, C); __syncthreads(); p0_wpk(P, C););
    PHASE(PH_G1, run_gemm(C, P.XB0, P.WA_T, M0, ACOLS, D_MODEL, EpiA{P}); run_gemm(C, P.MEMB, P.WMEM_T, BATCH * MEM_TOKENS, 1024, D_MODEL, EpiMem{P}); skinny_gemm(C, P.XB0, P.WA_T, ACOLS, D_MODEL, EpiA{P}););
#ifdef PEER_SHARD3
#define PEER_SHARDED_FN peer_sharded3_phase
#else
#define PEER_SHARDED_FN peer_sharded2_phase
#endif
    PHASE(PH_ATTA, atta_phase(P, C););
    PHASE(PH_G2, run_gemm(C, P.ATTA, P.WOA_T, M0, D_MODEL, 512, EpiPre{P.x_prompt, P.x_sample, P.PRE}); skinny_gemm(C, P.ATTA, P.WOA_T, D_MODEL, 512, EpiPre{P.x_prompt, P.x_sample, P.PRE}););
    PHASE(PH_LN1, ln_phase(P, C, P.PRE, P.ln_g, P.ln_b, P.X1, P.X1B, nullptr, nullptr););
    PHASE(PH_SC0, run_gemm(C, P.X1B, P.WPK_T, M0, NPK, D_MODEL, EpiF32{P.SCO, NPK, MP}); skinny_gemm(C, P.X1B, P.WPK_T, NPK, D_MODEL, EpiF32{P.SCO, NPK, MP}););
    PHASE(PH_TK0, topk_phase(P, C););
#ifdef PEER_SPLIT
    PHASE(PH_PU0, peer_u_phase(P, C, 0, P.X1B););
    PHASE(PH_PG0, peer_v_phase(P, C, 0, P.X1, P.X2, P.X2 + (size_t)M0 * D_MODEL, P.X2B););
#elif defined(PEER_SHARD2)
    PHASE(PH_PG0, const bool shd = (M0 % (C.G * NWAVES * PS2_ROWS)) == 0; if (shd) { PEER_SHARDED_FN(P, C, 0, P.X1, P.X1B, P.X2, P.X2B); __syncthreads(); } peer_phase(P, C, 0, P.X1, P.X2, P.X2 + (size_t)M0 * D_MODEL, P.X2B, shd););
#elif defined(PEER_SHARD)
    PHASE(PH_PG0, peer_sharded_phase(P, C, 0, P.X1, P.X1B, P.X2, P.X2 + (size_t)M0 * D_MODEL, P.X2B); __syncthreads(); peer_phase(P, C, 0, P.X1, P.X2, P.X2 + (size_t)M0 * D_MODEL, P.X2B););
#else
    PHASE(PH_PG0, peer_phase(P, C, 0, P.X1, P.X2, P.X2 + (size_t)M0 * D_MODEL, P.X2B););
#endif
    PHASE(PH_G3, run_gemm(C, P.X2B, P.WB_T, M0, NB_T, D_MODEL, EpiB{P}); skinny_gemm(C, P.X2B, P.WB_T, NB_T, D_MODEL, EpiB{P}););
    PHASE(PH_CMPG, run_gemm(C, P.AC, P.CW1_T, ACROWS, 256, 1024, EpiF32{P.UL, 256, ACROWS}); run_gemm(C, P.AC + (size_t)ACROWS * 1024, P.CW1_T + 256 * 1024, ACROWS, 256, 1024, EpiF32{P.UL + (size_t)ACROWS * 256, 256, ACROWS}););
    PHASE(PH_CMP2, cmp2_phase(P, C););
    PHASE(PH_NSA, nsa_phase_a(P, C););
    PHASE(PH_NSB, nsa_phase_b(P, C););
    PHASE(PH_G4, run_gemm(C, P.ATTB, P.WOB_T, M0, D_MODEL, 1024, EpiPre{P.X2, nullptr, P.PRE}); skinny_gemm(C, P.ATTB, P.WOB_T, D_MODEL, 1024, EpiPre{P.X2, nullptr, P.PRE}););
    PHASE(PH_LN3, ln_phase(P, C, P.PRE, P.ln_g + 2 * D_MODEL, P.ln_b + 2 * D_MODEL, P.X3, P.X3B, nullptr, nullptr););
    PHASE(PH_SC1, run_gemm(C, P.X3B, P.WPK_T + (size_t)NPK * D_MODEL, M0, NPK, D_MODEL, EpiF32{P.SCO, NPK, MP}); skinny_gemm(C, P.X3B, P.WPK_T + (size_t)NPK * D_MODEL, NPK, D_MODEL, EpiF32{P.SCO, NPK, MP}););
    PHASE(PH_TK1, topk_phase(P, C););
#ifdef PEER_SPLIT
    PHASE(PH_PU1, peer_u_phase(P, C, 1, P.X3B););
    PHASE(PH_PG1, peer_v_phase(P, C, 1, P.X3, P.y_prompt, P.y_sample, nullptr););
#elif defined(PEER_SHARD2)
    PHASE(PH_PG1, const bool shd = (M0 % (C.G * NWAVES * PS2_ROWS)) == 0; if (shd) { PEER_SHARDED_FN(P, C, 1, P.X3, P.X3B, P.y_prompt, nullptr); __syncthreads(); } peer_phase(P, C, 1, P.X3, P.y_prompt, P.y_sample, nullptr, shd););
#elif defined(PEER_SHARD)
    PHASE(PH_PG1, peer_sharded_phase(P, C, 1, P.X3, P.X3B, P.y_prompt, P.y_sample, nullptr); __syncthreads(); peer_phase(P, C, 1, P.X3, P.y_prompt, P.y_sample, nullptr););
#else
    PHASE(PH_PG1, peer_phase(P, C, 1, P.X3, P.y_prompt, P.y_sample, nullptr););
#endif
#undef IN
#undef SEAM
}
}
#ifndef ONE_LAUNCH
#define ONE_LAUNCH 1
#endif
extern "C" void kernel_launch(void* const* d_in, const int* in_sizes, int n_in, void* d_out, int out_size, void* d_ws, size_t ws_size, hipStream_t stream) {
    fx::Args a; memset(&a, 0, sizeof(a)); fx::bind_io(a.p, d_in, (float*)d_out);
    const size_t f_need = fx::carve(a.p, d_ws);
    if (f_need > ws_size) { fprintf(stderr, "kernel_launch: workspace too small: need %zu have %zu\n", f_need, ws_size); return; }
    static int grid = 0;
    if (!grid) { int dev = 0, cus = 0, per_cu = 0; (void)hipGetDevice(&dev); (void)hipDeviceGetAttribute(&cus, hipDeviceAttributeMultiprocessorCount, dev);
        (void)hipFuncSetAttribute((const void*)fx::mega, hipFuncAttributeMaxDynamicSharedMemorySize, fx::LDS_BYTES);
        if (hipOccupancyMaxActiveBlocksPerMultiprocessor(&per_cu, (const void*)fx::mega, fx::NTHREADS, fx::LDS_BYTES) != hipSuccess || per_cu < 1) { fprintf(stderr, "kernel_launch: occupancy query says %d blocks per CU\n", per_cu); (void)hipGetLastError(); }
        grid = cus; }
    (void)hipMemsetAsync(a.p.ctl, 0, fx::CTL_BYTES, stream);
#if ONE_LAUNCH
    a.lo = 0; a.hi = fx::PH_COUNT; hipLaunchKernelGGL(fx::mega, dim3(grid), dim3(fx::NTHREADS), fx::LDS_BYTES, stream, a);
#else
    for (int k = 0; k < fx::PH_COUNT; ++k) { a.lo = k; a.hi = k + 1; hipLaunchKernelGGL(fx::mega, dim3(grid), dim3(fx::NTHREADS), fx::LDS_BYTES, stream, a); }
#endif
}
```

```cpp
#define PEER_SHARD2 1
#define ONE_LAUNCH 1
#include <hip/hip_runtime.h>
#include <cstdio>
#include <cstring>
#include <cmath>
#ifdef CPU_TEST
#define HD inline
constexpr int D_MODEL = 128, BATCH = 2, SEQ = 512, DEPTH = 2, DEC_BATCH = 3, DEC_SEQ = 1, PAST_LEN = 512, PAGE_SIZE = 128;
constexpr int DIL_W[3] = {16, 64, 256}, DIL_D[3] = {1, 4, 16}, DIL_TAPS = 17;
constexpr int MEM_TOKENS = 32, SLC_TOPK = 4, SWA_WINDOW = 64, PEER_KEYS = 16, PEER_TOPK = 4;
#else
#define HD __host__ __device__ __forceinline__
constexpr int D_MODEL = 1024, BATCH = 2, SEQ = 8192, DEPTH = 2, DEC_BATCH = 32, DEC_SEQ = 1, PAST_LEN = 8192, PAGE_SIZE = 128;
constexpr int DIL_W[3] = {128, 512, 2048}, DIL_D[3] = {1, 4, 16}, DIL_TAPS = 129;
constexpr int MEM_TOKENS = 256, SLC_TOPK = 16, SWA_WINDOW = 512, PEER_KEYS = 128, PEER_TOPK = 16;
#endif
HD constexpr int dil_w(int g) { return g == 0 ? DIL_W[0] : (g == 1 ? DIL_W[1] : DIL_W[2]); }
HD constexpr int dil_d(int g) { return g == 0 ? DIL_D[0] : (g == 1 ? DIL_D[1] : DIL_D[2]); }
constexpr int HEAD_DIM = 64, N_A_LAYERS = DEPTH / 2, N_DIL = 3, DIL_HEADS = 4, DIL_COLS = N_DIL * 3 * DIL_HEADS * HEAD_DIM;
constexpr int MEM_HEADS = 4, MEM_COLS = MEM_HEADS * HEAD_DIM;
constexpr int NSA_HEADS = 12, NSA_KV_HEADS = 2, NSA_GROUP = 6, NSA_Q_COLS = NSA_HEADS * HEAD_DIM, NSA_GATE_COLS = NSA_HEADS * 3;
constexpr int CMP_BLOCK = 32, CMP_STRIDE = 16, CMP_HIDDEN = 128, SLC_BLOCK = 64;
constexpr int PEER_EXPERTS = PEER_KEYS * PEER_KEYS, PEER_HEADS = 8, PEER_KEY_DIM = 128;
constexpr float FORCE_SCORE = 1.0e9f, NEG = -1.0e30f, SCALE = 0.125f, LN_EPS = 1e-5f;
constexpr float ALPHA = 1.41421356237309515f;
constexpr float BETA = 0.5f;
#define LAS __attribute__((address_space(3)))
namespace pg8 {
#define PG8_LAS __attribute__((address_space(3)))
typedef unsigned short bf16_t;
typedef short bf16x8 __attribute__((ext_vector_type(8)));
typedef float f32x4 __attribute__((ext_vector_type(4)));
typedef unsigned u32x4 __attribute__((ext_vector_type(4)));
constexpr int BM = 256, BK = 64, HALF = 128, HTB = HALF * BK * 2  , STAGE_BYTES = 8 * HTB, NXCD = 8, WGM = 8;

__host__ __device__ __forceinline__ int lds_byte(int r, int c) { const int st = (r >> 4) * 2 + (c >> 5), rr = r & 15, cc = c & 31, ob = rr * 64 + cc * 2; return st * 1024 + (ob ^ (((ob >> 9) & 1) << 5)); }
__host__ __device__ __forceinline__ void stage_rc(int b, int& R, int& C) { const int st = b / 1024, sb = b % 1024, swz = sb ^ (((sb >> 9) & 1) << 5); R = (st >> 1) * 16 + swz / 64; C = (st & 1) * 32 + (swz % 64) / 2; }
__host__ __device__ __forceinline__ int perm32(int rho) { const int n = rho >> 4, i = rho & 15; return 8 * (i >> 2) + 4 * n + (i & 3); }

struct Unit { int pm, pn; };
struct Gemm { const bf16_t* A; const bf16_t* Bt; int M, N, K; };

struct StaticOrder {
    int nM, nN, nwg, G, c;
    __host__ __device__ void init(int M, int N, int G_, int c_) { nM = M / BM; nN = N / BM; nwg = nM * nN; G = G_; c = c_; }
    __host__ __device__ bool next(int i, Unit& u) const {
        const long L = (long)i * G + c; if (L >= nwg) return false;
        int wgid = (int)L; { const int q = nwg / NXCD, r = nwg % NXCD, xcd = wgid % NXCD, off = wgid / NXCD; wgid = (xcd < r ? xcd * (q + 1) : r * (q + 1) + (xcd - r) * q) + off; }
        const int nig = WGM * nN, gid = wgid / nig, fm = gid * WGM, gsz = (nM - fm) < WGM ? (nM - fm) : WGM;
        u.pm = fm + ((wgid % nig) % gsz); u.pn = (wgid % nig) / gsz; return true;
    }
    __device__ __forceinline__ void a_ready(const Unit&) const {}
    __device__ __forceinline__ void done(const Unit&) const {}
};

__device__ __forceinline__ unsigned cvt_pk_bf16(float lo, float hi) { unsigned r; asm volatile("v_cvt_pk_bf16_f32 %0, %1, %2" : "=v"(r) : "v"(lo), "v"(hi)); return r; }
typedef float f32x2 __attribute__((ext_vector_type(2)));
typedef float f32x2 __attribute__((ext_vector_type(2)));
template <class Epi, class Sched, bool ALIGN_EPI = false, bool SP2 = false>
__device__ __forceinline__ void gemm_phase(PG8_LAS unsigned char* lds, const Gemm g, const Sched& S, const Epi& E) {
    const int tid = threadIdx.x, wid = __builtin_amdgcn_readfirstlane(tid >> 6), lane = tid & 63, wr = wid >> 2, wc = wid & 3, fr = lane & 15, fq = lane >> 4;
    const int K = g.K, nt = K / BK;
    unsigned voffA[2], voffB[2];
#pragma unroll
    for (int i = 0; i < 2; ++i) { int R, C; stage_rc(tid * 16 + i * 8192, R, C); const int Rb = Epi::PERM ? ((R & ~31) + perm32(R & 31)) : R;
        voffA[i] = (unsigned)(R * K + C) * 2u; voffB[i] = (unsigned)(Rb * K + C) * 2u; }
    const size_t kstep = (size_t)(BK * 2);
    const size_t hstep = (size_t)HALF * K * 2;
    const size_t tstep = 2 * hstep;
    const unsigned ldsw = (unsigned)wid * 1024u;
    const int aoff = lds_byte(wr * 64 + fr, fq * 8), boff = lds_byte(wc * 32 + fr, fq * 8);
#define PG8_SA(b, h) (((b) * 2 + (h)) * HTB)
#define PG8_SB(b, h) ((4 + (b) * 2 + (h)) * HTB)
#define PG8_STAGE(bufoff, gbase, voff) do { _Pragma("unroll") for (int _i = 0; _i < 2; ++_i) \
        __builtin_amdgcn_global_load_lds((const unsigned*)((const char*)(gbase) + (voff)[_i]), (PG8_LAS unsigned*)(lds + (bufoff) + ldsw + _i * 8192), 16, 0, 0); } while (0)
#define PG8_LDA(dst, b, h) do { _Pragma("unroll") for (int m = 0; m < 4; ++m) _Pragma("unroll") for (int k = 0; k < 2; ++k) dst[m][k] = *(const PG8_LAS bf16x8*)(lds + PG8_SA(b, h) + aoff + m * 2048 + k * 1024); } while (0)
#define PG8_LDB(dst, b, h) do { _Pragma("unroll") for (int n = 0; n < 2; ++n) _Pragma("unroll") for (int k = 0; k < 2; ++k) dst[n][k] = *(const PG8_LAS bf16x8*)(lds + PG8_SB(b, h) + boff + n * 2048 + k * 1024); } while (0)
#define PG8_MMA(ai, bj, At, Bt) do { __builtin_amdgcn_s_setprio(1); _Pragma("unroll") for (int m = 0; m < 4; ++m) _Pragma("unroll") for (int n = 0; n < 2; ++n) _Pragma("unroll") for (int k = 0; k < 2; ++k) \
        acc[ai][bj][m][n] = __builtin_amdgcn_mfma_f32_16x16x32_bf16(Bt[n][k], At[m][k], acc[ai][bj][m][n], 0, 0, 0); __builtin_amdgcn_s_setprio(0); } while (0)
#define PG8_WAIT_V(n) asm volatile("s_waitcnt vmcnt(" #n ")" ::: "memory")
#define PG8_WAIT_L(n) asm volatile("s_waitcnt lgkmcnt(" #n ")" ::: "memory")
#define PG8_BAR __builtin_amdgcn_s_barrier()
#define PG8_SCHED __builtin_amdgcn_sched_barrier(0)
    Unit cur, nxt; int ui = 0;
    if (!S.next(0, cur)) return;
    f32x4 acc[2][2][4][2];
#pragma unroll
    for (int a = 0; a < 2; ++a)
#pragma unroll
        for (int b = 0; b < 2; ++b)
#pragma unroll
            for (int m = 0; m < 4; ++m)
#pragma unroll
                for (int n = 0; n < 2; ++n) acc[a][b][m][n] = (f32x4){0.f, 0.f, 0.f, 0.f};
    bf16x8 At[4][2], B0[2][2], B1[2][2];
    const char* cA = (const char*)g.A + (size_t)cur.pm * tstep; const char* cB = (const char*)g.Bt + (size_t)cur.pn * tstep;
    S.a_ready(cur);
    if constexpr (SP2) {
        PG8_STAGE(PG8_SB(0, 0), cB, voffB); PG8_STAGE(PG8_SB(0, 1), cB + hstep, voffB); PG8_STAGE(PG8_SA(0, 0), cA, voffA); PG8_STAGE(PG8_SA(0, 1), cA + hstep, voffA);
        if (wr == 1) PG8_BAR;
        PG8_WAIT_V(2); PG8_BAR;
        PG8_STAGE(PG8_SB(1, 0), cB + kstep, voffB); PG8_STAGE(PG8_SA(1, 0), cA + kstep, voffA); PG8_STAGE(PG8_SB(1, 1), cB + hstep + kstep, voffB);
        PG8_WAIT_V(6); PG8_BAR;
    } else {
        PG8_STAGE(PG8_SB(0, 0), cB, voffB); PG8_STAGE(PG8_SA(0, 0), cA, voffA); PG8_STAGE(PG8_SB(0, 1), cB + hstep, voffB); PG8_STAGE(PG8_SA(0, 1), cA + hstep, voffA);
        if (wr == 1) PG8_BAR;
        PG8_WAIT_V(4); PG8_BAR;
        PG8_STAGE(PG8_SB(1, 0), cB + kstep, voffB); PG8_STAGE(PG8_SA(1, 0), cA + kstep, voffA); PG8_STAGE(PG8_SB(1, 1), cB + hstep + kstep, voffB);
        PG8_WAIT_V(6); PG8_BAR;
    }
    for (;;) {
        const bool has_next = S.next(ui + 1, nxt);
        const char* nA = has_next ? (const char*)g.A + (size_t)nxt.pm * tstep : cA; const char* nB = has_next ? (const char*)g.Bt + (size_t)nxt.pn * tstep : cB;
        for (int t = 0; t < nt; t += 2) {
            const bool last = (t == nt - 2);
            const char* a1 = cA + (size_t)(t + 1) * kstep;
            const char* a2 = last ? nA : cA + (size_t)(t + 2) * kstep; const char* b2 = last ? nB : cB + (size_t)(t + 2) * kstep;
            const char* a3 = a2 + kstep; const char* b3 = b2 + kstep;
            if (last && has_next) S.a_ready(nxt);
            if constexpr (SP2) {
            PG8_LDB(B0, 0, 0); PG8_LDB(B1, 0, 1); PG8_SCHED; PG8_LDA(At, 0, 0); PG8_STAGE(PG8_SA(1, 1), a1 + hstep, voffA);
            PG8_WAIT_V(8); PG8_WAIT_L(0); PG8_BAR; PG8_MMA(0, 0, At, B0); PG8_MMA(0, 1, At, B1); PG8_BAR; PG8_SCHED;
            PG8_LDA(At, 0, 1); PG8_STAGE(PG8_SB(0, 0), b2, voffB); PG8_STAGE(PG8_SB(0, 1), b2 + hstep, voffB); PG8_STAGE(PG8_SA(0, 0), a2, voffA);
            PG8_WAIT_V(8); PG8_WAIT_L(0); PG8_BAR; PG8_MMA(1, 0, At, B0); PG8_MMA(1, 1, At, B1); PG8_BAR; PG8_SCHED;
            PG8_LDB(B0, 1, 0); PG8_LDB(B1, 1, 1); PG8_SCHED; PG8_LDA(At, 1, 0); PG8_STAGE(PG8_SA(0, 1), a2 + hstep, voffA);
            PG8_WAIT_V(8); PG8_WAIT_L(0); PG8_BAR; PG8_MMA(0, 0, At, B0); PG8_MMA(0, 1, At, B1); PG8_BAR; PG8_SCHED;
            PG8_LDA(At, 1, 1); PG8_STAGE(PG8_SB(1, 0), b3, voffB); PG8_STAGE(PG8_SB(1, 1), b3 + hstep, voffB); PG8_STAGE(PG8_SA(1, 0), a3, voffA);
            PG8_WAIT_V(8); PG8_WAIT_L(0); PG8_BAR; PG8_MMA(1, 0, At, B0); PG8_MMA(1, 1, At, B1); PG8_BAR; PG8_SCHED;
            } else {
            PG8_LDB(B0, 0, 0); PG8_SCHED; PG8_LDA(At, 0, 0); PG8_STAGE(PG8_SA(1, 1), a1 + hstep, voffA);
            PG8_WAIT_L(8); PG8_BAR; PG8_WAIT_L(0); PG8_MMA(0, 0, At, B0); PG8_BAR; PG8_SCHED;
            PG8_LDB(B1, 0, 1); PG8_STAGE(PG8_SB(0, 0), b2, voffB);
            PG8_BAR; PG8_WAIT_L(0); PG8_MMA(0, 1, At, B1); PG8_BAR;
            PG8_LDA(At, 0, 1); PG8_STAGE(PG8_SA(0, 0), a2, voffA);
            PG8_BAR; PG8_WAIT_L(0); PG8_MMA(1, 0, At, B0); PG8_BAR; PG8_SCHED;
            PG8_STAGE(PG8_SB(0, 1), b2 + hstep, voffB);
            PG8_WAIT_V(6); PG8_BAR; PG8_MMA(1, 1, At, B1); PG8_BAR;
            PG8_LDB(B0, 1, 0); PG8_SCHED; PG8_LDA(At, 1, 0); PG8_STAGE(PG8_SA(0, 1), a2 + hstep, voffA);
            PG8_WAIT_L(8); PG8_BAR; PG8_WAIT_L(0); PG8_MMA(0, 0, At, B0); PG8_BAR; PG8_SCHED;
            PG8_LDB(B1, 1, 1); PG8_STAGE(PG8_SB(1, 0), b3, voffB);
            PG8_BAR; PG8_WAIT_L(0); PG8_MMA(0, 1, At, B1); PG8_BAR;
            PG8_LDA(At, 1, 1); PG8_STAGE(PG8_SA(1, 0), a3, voffA);
            PG8_BAR; PG8_WAIT_L(0); PG8_MMA(1, 0, At, B0); PG8_BAR; PG8_SCHED;
            PG8_STAGE(PG8_SB(1, 1), b3 + hstep, voffB);
            PG8_WAIT_V(6); PG8_BAR; PG8_MMA(1, 1, At, B1); PG8_BAR;
            }
        }
        if constexpr (ALIGN_EPI) { if (wr == 0) PG8_BAR; }
        if constexpr (!Epi::AFTER_DRAIN) { E(acc, cur, wr, wc, fr, fq); S.done(cur); }
        if (!has_next) break;
#pragma unroll
        for (int a = 0; a < 2; ++a)
#pragma unroll
            for (int b = 0; b < 2; ++b)
#pragma unroll
                for (int m = 0; m < 4; ++m)
#pragma unroll
                    for (int n = 0; n < 2; ++n) acc[a][b][m][n] = (f32x4){0.f, 0.f, 0.f, 0.f};
        cur = nxt; cA = nA; cB = nB; ++ui;
        if constexpr (ALIGN_EPI) { if (wr == 1) PG8_BAR; }
    }
    PG8_WAIT_V(0);
    if constexpr (!ALIGN_EPI) { if (wr == 0) PG8_BAR; }
    PG8_BAR;
    if constexpr (Epi::AFTER_DRAIN) { E.fused(acc, cur, wr, wc, fr, fq, lds, wid, lane); S.done(cur); }
#undef PG8_SA
#undef PG8_SB
#undef PG8_STAGE
#undef PG8_LDA
#undef PG8_LDB
#undef PG8_MMA
#undef PG8_WAIT_V
#undef PG8_WAIT_L
#undef PG8_BAR
#undef PG8_SCHED
}
}
#define XB_TMO      128
#define XB_XCNT(j)  (256  + 64 * (j))
#define XB_XSUB(j)  (1280 + 64 * (j))
#define XB_XGEN(j)  (2304 + 64 * (j))
#define XB_TOP      3328
#define XB_TOPGEN   3392
#define XCD_BAR_WORDS 3456
#define XB_SPIN_CAP (1u << 18)

__device__ __forceinline__ unsigned xb_ld(unsigned* p)              { return __hip_atomic_load(p, __ATOMIC_RELAXED, __HIP_MEMORY_SCOPE_AGENT); }
__device__ __forceinline__ unsigned xb_add(unsigned* p, unsigned v) { return __hip_atomic_fetch_add(p, v, __ATOMIC_RELAXED, __HIP_MEMORY_SCOPE_AGENT); }
__device__ __forceinline__ unsigned xb_xcc_id() { return (unsigned)__builtin_amdgcn_s_getreg((3 << 11) | 20) & 0xFu; }
#define XB_SPIN(cond, bar) do { unsigned _sp = 0; while (cond) { __builtin_amdgcn_s_sleep(1); \
    if ((++_sp & 255u) == 0u) { if (xb_ld(&(bar)[XB_TMO])) break; if (_sp > XB_SPIN_CAP) { atomicAdd(&(bar)[XB_TMO], 1u); break; } } } } while (0)

struct XcdBarrier {
    unsigned* bar; unsigned x;
    volatile LAS unsigned* st;
};

__device__ __forceinline__ XcdBarrier xcd_barrier_post(unsigned* bar, volatile LAS unsigned* st) {
    XcdBarrier b; b.bar = bar; b.x = xb_xcc_id(); b.st = st;
    if (threadIdx.x == 0) (void)xb_add(&bar[XB_XCNT(b.x)], 1u);
    return b;
}
__device__ __forceinline__ void xcd_barrier_complete(unsigned* bar, unsigned x, unsigned& nloc, unsigned& nx) {
    const unsigned G = gridDim.x * gridDim.y * gridDim.z;
    unsigned sum, cnt, mine, sp = 0u;
    for (;;) {
        sum = 0u; cnt = 0u; mine = 0u;
#pragma unroll
        for (unsigned j = 0; j < 16; ++j) { const unsigned c = xb_ld(&bar[XB_XCNT(j)]); sum += c; cnt += (c > 0u) ? 1u : 0u; mine = (j == x) ? c : mine; }
        if (sum == G) break;
        __builtin_amdgcn_s_sleep(1);
        if ((++sp & 255u) == 0u) { if (xb_ld(&bar[XB_TMO])) break; if (sp > XB_SPIN_CAP) { atomicAdd(&bar[XB_TMO], 1u); break; } }
    }
    nloc = mine > 0u ? mine : 1u; nx = cnt > 0u ? cnt : 1u;
}

__device__ __forceinline__ void xcd_barrier(const XcdBarrier& b) {
    asm volatile("s_waitcnt vmcnt(0)" ::: "memory");
    __syncthreads();
    if (threadIdx.x == 0) {
        unsigned* bar = b.bar;
        __builtin_amdgcn_s_waitcnt(0);
        unsigned nloc = b.st[0], nx = b.st[1];
        if (nloc == 0u) { xcd_barrier_complete(bar, b.x, nloc, nx); b.st[0] = nloc; b.st[1] = nx; }
        const unsigned old = xb_add(&bar[XB_XSUB(b.x)], 1u);
        const unsigned gen = old / nloc;
        if (old + 1u == (gen + 1u) * nloc) {
            __builtin_amdgcn_fence(__ATOMIC_RELEASE, "agent");
            asm volatile("s_waitcnt vmcnt(0)" ::: "memory");
            const unsigned og = xb_add(&bar[XB_TOP], 1u);
            const unsigned tg = og / nx;
            if (og + 1u == (tg + 1u) * nx) xb_add(&bar[XB_TOPGEN], 1u);
            else XB_SPIN(xb_ld(&bar[XB_TOPGEN]) == tg, bar);
            __builtin_amdgcn_fence(__ATOMIC_ACQUIRE, "agent");
            xb_add(&bar[XB_XGEN(b.x)], 1u);
            asm volatile("s_waitcnt vmcnt(0)" ::: "memory");
        } else {
            XB_SPIN(xb_ld(&bar[XB_XGEN(b.x)]) == gen, bar);
            __builtin_amdgcn_fence(__ATOMIC_ACQUIRE, "agent");
            asm volatile("s_waitcnt vmcnt(0)" ::: "memory");
        }
    }
    __syncthreads();
}
namespace fx {
#define DI __device__ __forceinline__
typedef unsigned short bf16;
typedef short bf16x8 __attribute__((ext_vector_type(8)));
typedef float f32x4 __attribute__((ext_vector_type(4)));
typedef float f32x2 __attribute__((ext_vector_type(2)));
typedef unsigned u32x4 __attribute__((ext_vector_type(4)));
typedef unsigned u32x2 __attribute__((ext_vector_type(2)));
constexpr int M0 = BATCH * SEQ, MP = M0 + DEC_BATCH, MPAD = ((MP + 255) / 256) * 256;
constexpr int ACOLS = DIL_COLS + MEM_COLS, BCOLS = NSA_Q_COLS + NSA_GATE_COLS + MEM_COLS, KVCOLS = 6 * NSA_KV_HEADS * HEAD_DIM;
constexpr int NB_T = 2048;
constexpr int NPK = PEER_HEADS * 2 * PEER_KEYS;
constexpr int NCMP = (SEQ - CMP_BLOCK) / CMP_STRIDE + 1;
constexpr int NCH = SEQ / CMP_STRIDE;
constexpr int NCTX = BATCH + DEC_BATCH;
constexpr int ACROWS = NCTX * NSA_KV_HEADS * NCH;
constexpr int NPOS = PAST_LEN + 1;
constexpr float QSCALE = 0.125f * 1.4426950408889634f;
constexpr int NTHREADS = 512, NWAVES = 8, LDS_BYTES = 147456, RING_BYTES = 131072, MISC_OFF = RING_BYTES + 320;

struct FP {
    const float *x_prompt, *x_sample, *mem_prompt, *cache_dil[3], *cache_nsa_kv, *cache_nsa_win, *cache_mem_kv; const int* page_table;
    const float *w_in_a, *w_out_a, *w_in_b, *w_out_b, *w_mem_kv, *w_kv_b, *cmp_pe, *cmp_w1, *cmp_w2, *ln_g, *ln_b, *peer_wq, *peer_keys, *peer_u, *peer_v;
    float *y_prompt, *y_sample, *dil_p[3], *dil_s[3], *nsa_kv_p, *nsa_kv_s, *win_p, *win_s, *mem_kv_p;
    unsigned* ctl;
    bf16 *XB0, *X1B, *X2B, *X3B, *WA_T, *WMEM_T, *MEMB, *WOA_T, *WOB_T, *WPK_T, *WB_T, *CW1_T, *AC; unsigned char *UB8, *VB8;
    float *ROPE, *CBIAS;
    bf16 *QA, *KA, *VTA, *MQA, *MK, *MVT, *ATTA;
    float *DPART, *DML, *PRE, *X1, *X2, *X3, *SCO, *SELG; int* SELE;
    bf16 *SLK, *SLVT, *WNK, *WNVT, *QB, *MQB, *CK, *CVT, *ATTB;
    float *GATES, *UL, *CKF, *CVF;
    int* SELB;
    float* DBG;
};
struct Args { FP p; int lo, hi; };
struct Carve { size_t off = 0; template <class T> T* take(void* base, size_t n) { T* r = (T*)((char*)base + off); off += ((n * sizeof(T) + 255) / 256) * 256; return r; } };
constexpr size_t CTL_BYTES = 65536;
inline size_t carve(FP& p, void* base) {
    Carve c;
    p.ctl = c.take<unsigned>(base, CTL_BYTES / 4);
    p.XB0 = c.take<bf16>(base, (size_t)MPAD * D_MODEL); p.X1B = c.take<bf16>(base, (size_t)MPAD * D_MODEL); p.X2B = c.take<bf16>(base, (size_t)MPAD * D_MODEL); p.X3B = c.take<bf16>(base, (size_t)MPAD * D_MODEL);
    p.WA_T = c.take<bf16>(base, (size_t)ACOLS * D_MODEL); p.WMEM_T = c.take<bf16>(base, (size_t)DEPTH * 2 * MEM_COLS * D_MODEL); p.MEMB = c.take<bf16>(base, (size_t)BATCH * MEM_TOKENS * D_MODEL);
    p.WOA_T = c.take<bf16>(base, (size_t)D_MODEL * 2 * MEM_COLS); p.WOB_T = c.take<bf16>(base, (size_t)D_MODEL * (NSA_Q_COLS + MEM_COLS));
    p.WPK_T = c.take<bf16>(base, (size_t)DEPTH * NPK * D_MODEL); p.WB_T = c.take<bf16>(base, (size_t)NB_T * D_MODEL);
    p.UB8 = c.take<unsigned char>(base, (size_t)DEPTH * PEER_EXPERTS * D_MODEL); p.VB8 = c.take<unsigned char>(base, (size_t)DEPTH * PEER_EXPERTS * D_MODEL);
    p.CW1_T = c.take<bf16>(base, (size_t)2 * 256 * 1024); p.AC = c.take<bf16>(base, (size_t)2 * ACROWS * 1024);
    p.ROPE = c.take<float>(base, (size_t)NPOS * 64); p.CBIAS = c.take<float>(base, 2 * CMP_HIDDEN);
    p.QA = c.take<bf16>(base, (size_t)3 * MPAD * 256); p.KA = c.take<bf16>(base, (size_t)3 * MPAD * 256); p.VTA = c.take<bf16>(base, (size_t)3 * BATCH * DIL_HEADS * HEAD_DIM * SEQ + 4096);
    p.MQA = c.take<bf16>(base, (size_t)MPAD * 256); p.MK = c.take<bf16>(base, (size_t)DEPTH * BATCH * MEM_TOKENS * MEM_COLS); p.MVT = c.take<bf16>(base, (size_t)DEPTH * BATCH * MEM_COLS * MEM_TOKENS);
    p.ATTA = c.take<bf16>(base, (size_t)MPAD * 2 * MEM_COLS);
    p.DPART = c.take<float>(base, (size_t)3 * MP * DIL_HEADS * HEAD_DIM); p.DML = c.take<float>(base, (size_t)3 * MP * DIL_HEADS * 2);
    p.PRE = c.take<float>(base, (size_t)MPAD * D_MODEL); p.X1 = c.take<float>(base, (size_t)MPAD * D_MODEL); p.X2 = c.take<float>(base, (size_t)MPAD * D_MODEL); p.X3 = c.take<float>(base, (size_t)MPAD * D_MODEL);
    p.SCO = c.take<float>(base, (size_t)MPAD * NPK); p.SELG = c.take<float>(base, (size_t)MP * 128); p.SELE = c.take<int>(base, (size_t)MP * 128);
    p.SLK = c.take<bf16>(base, (size_t)BATCH * NSA_KV_HEADS * SEQ * HEAD_DIM); p.SLVT = c.take<bf16>(base, (size_t)BATCH * NSA_KV_HEADS * SEQ * HEAD_DIM);
    p.WNK = c.take<bf16>(base, (size_t)BATCH * NSA_KV_HEADS * SEQ * HEAD_DIM + 4096); p.WNVT = c.take<bf16>(base, (size_t)BATCH * NSA_KV_HEADS * SEQ * HEAD_DIM + 4096);
    p.QB = c.take<bf16>(base, (size_t)MPAD * NSA_Q_COLS); p.MQB = c.take<bf16>(base, (size_t)MPAD * 256);
    p.CK = c.take<bf16>(base, (size_t)NCTX * NSA_KV_HEADS * NCH * HEAD_DIM); p.CVT = c.take<bf16>(base, (size_t)NCTX * NSA_KV_HEADS * HEAD_DIM * NCH); p.ATTB = c.take<bf16>(base, (size_t)MPAD * (NSA_Q_COLS + MEM_COLS));
    p.GATES = c.take<float>(base, (size_t)MPAD * 64); p.UL = c.take<float>(base, (size_t)2 * ACROWS * 256);
    p.CKF = c.take<float>(base, (size_t)DEC_BATCH * NSA_KV_HEADS * NCH * HEAD_DIM); p.CVF = c.take<float>(base, (size_t)DEC_BATCH * NSA_KV_HEADS * NCH * HEAD_DIM);
    p.SELB = c.take<int>(base, (size_t)MP * NSA_KV_HEADS * 16);
#ifdef NSA_DEBUG
    p.DBG = c.take<float>(base, (size_t)3 * MP * 768);
#else
    p.DBG = nullptr;
#endif
    return c.off;
}
inline void bind_io(FP& p, void* const* d_in, float* out) {
    p.x_prompt = (const float*)d_in[0]; p.x_sample = (const float*)d_in[1]; p.mem_prompt = (const float*)d_in[2]; p.cache_dil[0] = (const float*)d_in[3]; p.cache_dil[1] = (const float*)d_in[4]; p.cache_dil[2] = (const float*)d_in[5];
    p.cache_nsa_kv = (const float*)d_in[6]; p.cache_nsa_win = (const float*)d_in[7]; p.cache_mem_kv = (const float*)d_in[8]; p.page_table = (const int*)d_in[9];
    p.w_in_a = (const float*)d_in[10]; p.w_out_a = (const float*)d_in[11]; p.w_in_b = (const float*)d_in[12]; p.w_out_b = (const float*)d_in[13]; p.w_mem_kv = (const float*)d_in[14]; p.w_kv_b = (const float*)d_in[15];
    p.cmp_pe = (const float*)d_in[16]; p.cmp_w1 = (const float*)d_in[17]; p.cmp_w2 = (const float*)d_in[18]; p.ln_g = (const float*)d_in[19]; p.ln_b = (const float*)d_in[20];
    p.peer_wq = (const float*)d_in[21]; p.peer_keys = (const float*)d_in[22]; p.peer_u = (const float*)d_in[23]; p.peer_v = (const float*)d_in[24];
    size_t o = 0; auto take = [&](size_t n) { float* r = out + o; o += n; return r; };
    p.y_prompt = take((size_t)M0 * D_MODEL); p.y_sample = take((size_t)DEC_BATCH * D_MODEL);
    for (int g = 0; g < 3; ++g) p.dil_p[g] = take((size_t)BATCH * DIL_W[g] * 2 * DIL_HEADS * HEAD_DIM);
    for (int g = 0; g < 3; ++g) p.dil_s[g] = take((size_t)DEC_BATCH * DIL_W[g] * 2 * DIL_HEADS * HEAD_DIM);
    p.nsa_kv_p = take((size_t)M0 * 4 * NSA_KV_HEADS * HEAD_DIM); p.nsa_kv_s = take((size_t)DEC_BATCH * 4 * NSA_KV_HEADS * HEAD_DIM);
    p.win_p = take((size_t)BATCH * SWA_WINDOW * 2 * NSA_KV_HEADS * HEAD_DIM); p.win_s = take((size_t)DEC_BATCH * SWA_WINDOW * 2 * NSA_KV_HEADS * HEAD_DIM);
    p.mem_kv_p = take((size_t)DEPTH * BATCH * MEM_TOKENS * 2 * MEM_COLS);
}
DI unsigned f2bf(float f) { unsigned u = __builtin_bit_cast(unsigned, f); return (u + 0x7fffu + ((u >> 16) & 1u)) >> 16; }
DI unsigned pk2(float lo, float hi) { return f2bf(lo) | (f2bf(hi) << 16); }
DI float bf2f(unsigned short b) { return __builtin_bit_cast(float, (unsigned)b << 16); }
DI float bflo(unsigned w) { return __builtin_bit_cast(float, w << 16); }
DI float bfhi(unsigned w) { return __builtin_bit_cast(float, w & 0xffff0000u); }
DI float wave_sum(float v) {
#pragma unroll
    for (int o = 1; o < 64; o <<= 1) v += __shfl_xor(v, o);
    return v; }
DI float wave_max(float v) {
#pragma unroll
    for (int o = 1; o < 64; o <<= 1) v = fmaxf(v, __shfl_xor(v, o));
    return v; }
DI float gelu_tanh(float x) { const float u = 0.7978845608028654f * (x + 0.044715f * x * x * x); const float e = __builtin_amdgcn_exp2f(u * 2.885390081777927f);   const float t = 1.0f - 2.0f / (e + 1.0f); return 0.5f * x * (1.0f + t); }
DI float* sel3(float* const (&a)[3], int g) { return g == 0 ? a[0] : (g == 1 ? a[1] : a[2]); }
DI const float* sel3c(const float* const (&a)[3], int g) { return g == 0 ? a[0] : (g == 1 ? a[1] : a[2]); }
__host__ DI size_t ktile_off(int t, int d) { const int blk = t >> 5, kk = t & 31, b = (kk >> 2) & 1, i = 4 * (kk >> 3) + (kk & 3), s = d >> 5, c = (d & 31) >> 3; return ((size_t)(blk * 4 + 2 * b + s) * 64 + i + 16 * c) * 8 + (d & 7); }
__host__ DI size_t vtile_off(int dim, int t) { const int blk = t >> 5, kk = t & 31; return ((size_t)(blk * 4 + (dim >> 4)) * 64 + (dim & 15) + 16 * (kk >> 3)) * 8 + (kk & 7); }
struct Ctx { LAS unsigned char* lds; int tid, lane, wave, vcu, G; };
DI int row_pos(int r) { return r < M0 ? (r & (SEQ - 1)) : PAST_LEN; }

struct ColSrc { const float* p; int ld; };
DI int rope_il(int e) { return (e >> 1) + 32 * (e & 1); }
DI ColSrc col_wa(const FP& P, int n) {
    const int t = n >> 8, ct = n & 255, h = ct >> 6, e = ct & 63; if (t >= 9) return ColSrc{P.w_in_a + DIL_COLS + ct, ACOLS};
    const int j = t % 3, d = (j < 2) ? rope_il(e) : e; return ColSrc{P.w_in_a + t * 256 + h * 64 + d, ACOLS}; }
DI ColSrc col_wb(const FP& P, int n) {
    const int t = n >> 8, ct = n & 255, e = ct & 63;
    if (t < 3) { const int ty = 2 * t + (ct >> 7), kvh = (ct >> 6) & 1; const bool rot = (ty == 2 || ty == 4); return ColSrc{P.w_kv_b + (ty * NSA_KV_HEADS + kvh) * 64 + (rot ? rope_il(e) : e), KVCOLS}; }
    if (t < 6) { const int h = (t - 3) * 4 + (ct >> 6); return ColSrc{P.w_in_b + h * 64 + rope_il(e), BCOLS}; }
    if (t == 6) return ColSrc{P.w_in_b + NSA_Q_COLS + NSA_GATE_COLS + ct, BCOLS};
    if (ct < NSA_GATE_COLS) return ColSrc{P.w_in_b + NSA_Q_COLS + ct, BCOLS};
    return ColSrc{nullptr, 0}; }
DI ColSrc col_wmem(const FP& P, int n) { const int l = n >> 9, c = n & 511; return ColSrc{P.w_mem_kv + (size_t)l * D_MODEL * 512 + c, 512}; }
DI ColSrc col_woa(const FP& P, int n) { return ColSrc{P.w_out_a + n, D_MODEL}; }
DI ColSrc col_wob(const FP& P, int n) { return ColSrc{P.w_out_b + n, D_MODEL}; }
DI ColSrc col_cw1(const FP& P, int n) {
    const int ty = n >> 8, half = (n >> 7) & 1, hid = n & 127; return ColSrc{P.cmp_w1 + (size_t)ty * CMP_BLOCK * HEAD_DIM * CMP_HIDDEN + (size_t)half * 16 * HEAD_DIM * CMP_HIDDEN + hid, CMP_HIDDEN}; }
template <class CF> DI void transpose_item(const FP& P, CF cf, int K, bf16* WT, LAS float* scr, int item, int nblk, int lane) {
    const int kb = item / nblk, nb = item % nblk, k0 = 64 * kb, n0 = 32 * nb;
    const ColSrc cs = cf(P, n0 + (lane & 31));
#pragma unroll 8
    for (int i = 0; i < 32; ++i) { const int kk = 2 * i + (lane >> 5); scr[kk * 33 + (lane & 31)] = cs.p ? cs.p[(size_t)(k0 + kk) * cs.ld] : 0.f; }
    asm volatile("s_waitcnt lgkmcnt(0)" ::: "memory");
    const int c = lane & 7;
#pragma unroll
    for (int j = 0; j < 4; ++j) { const int n = (lane >> 3) + 8 * j; const LAS float* s = scr + (8 * c) * 33 + n;
        u32x4 o; o.x = pk2(s[0 * 33], s[1 * 33]); o.y = pk2(s[2 * 33], s[3 * 33]); o.z = pk2(s[4 * 33], s[5 * 33]); o.w = pk2(s[6 * 33], s[7 * 33]);
        *(u32x4*)(WT + (size_t)(n0 + n) * K + k0 + 8 * c) = o; }
    asm volatile("s_waitcnt lgkmcnt(0)" ::: "memory");
}
DI void cvt_row1024(const float* src, bf16* dst, int lane) {
#pragma unroll
    for (int j = 0; j < 4; ++j) { f32x4 v = src ? *(const f32x4*)(src + 256 * j + 4 * lane) : (f32x4){0.f, 0.f, 0.f, 0.f}; u32x2 o; o.x = pk2(v.x, v.y); o.y = pk2(v.z, v.w); *(u32x2*)(dst + 256 * j + 4 * lane) = o; }
}
DI void cvt_row1024_fp8(const float* src, unsigned char* dst, float sc, int lane) { u32x4 o; unsigned w[4];
#pragma unroll
    for (int j = 0; j < 4; ++j) { const f32x4 v = *(const f32x4*)(src + 16 * lane + 4 * j) * sc; int t = __builtin_amdgcn_cvt_pk_fp8_f32(v.x, v.y, 0, false); t = __builtin_amdgcn_cvt_pk_fp8_f32(v.z, v.w, t, true); w[j] = (unsigned)t; }
    o.x = w[0]; o.y = w[1]; o.z = w[2]; o.w = w[3]; *(u32x4*)(dst + 16 * lane) = o; }
DI void p0_prologue(const FP& P, const Ctx& C) {
    LAS float* scr = (LAS float*)(C.lds + C.wave * 16384);
    const int gw = C.vcu * NWAVES + C.wave, NGW = C.G * NWAVES, lane = C.lane;
    { constexpr int IA = (D_MODEL / 64) * (ACOLS / 32), IM = (D_MODEL / 64) * (1024 / 32), IOA = (512 / 64) * (D_MODEL / 32), IOB = (1024 / 64) * (D_MODEL / 32), IB = (D_MODEL / 64) * (NB_T / 32), IC = (1024 / 64) * (512 / 32);
      constexpr int NIT = IA + IM + IOA + IOB + IB + IC;
      for (int it = gw; it < NIT; it += NGW) { int r = it;
          if (r < IA) { transpose_item(P, col_wa, D_MODEL, P.WA_T, scr, r, ACOLS / 32, lane); continue; } r -= IA;
          if (r < IM) { transpose_item(P, col_wmem, D_MODEL, P.WMEM_T, scr, r, 1024 / 32, lane); continue; } r -= IM;
          if (r < IOA) { transpose_item(P, col_woa, 512, P.WOA_T, scr, r, D_MODEL / 32, lane); continue; } r -= IOA;
          if (r < IOB) { transpose_item(P, col_wob, 1024, P.WOB_T, scr, r, D_MODEL / 32, lane); continue; } r -= IOB;
          if (r < IB) { transpose_item(P, col_wb, D_MODEL, P.WB_T, scr, r, NB_T / 32, lane); continue; } r -= IB;
          transpose_item(P, col_cw1, 1024, P.CW1_T, scr, r, 512 / 32, lane); } }
    for (int r = gw; r < MPAD; r += NGW) { cvt_row1024(r < M0 ? P.x_prompt + (size_t)r * D_MODEL : (r < MP ? P.x_sample + (size_t)(r - M0) * D_MODEL : nullptr), P.XB0 + (size_t)r * D_MODEL, lane);
        if (r >= MP) { cvt_row1024(nullptr, P.X1B + (size_t)r * D_MODEL, lane); cvt_row1024(nullptr, P.X2B + (size_t)r * D_MODEL, lane); cvt_row1024(nullptr, P.X3B + (size_t)r * D_MODEL, lane);
            for (int c = lane; c < 512; c += 64) { P.ATTA[(size_t)r * 512 + c] = 0; P.ATTB[(size_t)r * 1024 + c] = 0; P.ATTB[(size_t)r * 1024 + 512 + c] = 0; } } }
    for (int r = gw; r < BATCH * MEM_TOKENS; r += NGW) cvt_row1024(P.mem_prompt + (size_t)r * D_MODEL, P.MEMB + (size_t)r * D_MODEL, lane);
#pragma unroll 1
    for (int r = 2 * gw; r < DEPTH * PEER_EXPERTS; r += 2 * NGW) { f32x4 a[16];
#pragma unroll
        for (int q = 0; q < 4; ++q) { const float* s0 = (q < 2 ? P.peer_u : P.peer_v) + (size_t)(r + (q & 1)) * D_MODEL + 16 * lane;
#pragma unroll
            for (int j = 0; j < 4; ++j) a[4 * q + j] = *(const f32x4*)(s0 + 4 * j); }
#pragma unroll
        for (int q = 0; q < 4; ++q) { const float sc = q < 2 ? 256.f : 64.f; unsigned w[4];
#pragma unroll
            for (int j = 0; j < 4; ++j) { const f32x4 v = a[4 * q + j] * sc; int t = __builtin_amdgcn_cvt_pk_fp8_f32(v.x, v.y, 0, false); t = __builtin_amdgcn_cvt_pk_fp8_f32(v.z, v.w, t, true); w[j] = (unsigned)t; }
            u32x4 o; o.x = w[0]; o.y = w[1]; o.z = w[2]; o.w = w[3]; *(u32x4*)((q < 2 ? P.UB8 : P.VB8) + (size_t)(r + (q & 1)) * D_MODEL + 16 * lane) = o; } }
    for (int i = gw * 64 + lane; i < NPOS * 32; i += NGW * 64) { const int pos = i >> 5, d = i & 31; const double inv = exp2(-(double)d * (13.287712379549449 / 32.0)); const double turns = (double)pos * inv * 0.15915494309189535;
        const float fr = (float)(turns - floor(turns)); P.ROPE[pos * 64 + d] = __builtin_amdgcn_cosf(fr); P.ROPE[pos * 64 + 32 + d] = __builtin_amdgcn_sinf(fr); }
    for (int i = gw; i < 2 * CMP_HIDDEN; i += NGW) { const int ty = i / CMP_HIDDEN, hid = i % CMP_HIDDEN; float a = 0.f;
#pragma unroll 8
        for (int k = lane; k < CMP_BLOCK * HEAD_DIM; k += 64) a += P.cmp_pe[ty * CMP_BLOCK * HEAD_DIM + k] * P.cmp_w1[((size_t)ty * CMP_BLOCK * HEAD_DIM + k) * CMP_HIDDEN + hid];
        a = wave_sum(a); if (lane == 0) P.CBIAS[i] = a; }
    for (int it = gw; it < DEC_BATCH * (PAST_LEN / PAGE_SIZE); it += NGW) { const int n = it / (PAST_LEN / PAGE_SIZE), pi = it % (PAST_LEN / PAGE_SIZE); const int pg = P.page_table[it];
        const float* src = P.cache_nsa_kv + (size_t)pg * PAGE_SIZE * 512 + 4 * lane; const int ty = lane >> 5, kvh = (lane >> 4) & 1, d = (4 * lane) & 63;
        bf16* dst = P.AC + ((size_t)ty * ACROWS + ((size_t)(BATCH + n) * NSA_KV_HEADS + kvh) * NCH + pi * (PAGE_SIZE / 16)) * 1024 + d;
#pragma unroll 1
        for (int r0 = 0; r0 < PAGE_SIZE; r0 += 8) { f32x4 v[8];
#pragma unroll
            for (int u = 0; u < 8; ++u) v[u] = *(const f32x4*)(src + (size_t)(r0 + u) * 512);
#pragma unroll
            for (int u = 0; u < 8; ++u) { const int t = r0 + u; u32x2 o; o.x = pk2(v[u].x, v[u].y); o.y = pk2(v[u].z, v[u].w); *(u32x2*)(dst + (size_t)(t / 16) * 1024 + (t % 16) * 64) = o; } } }
    for (int g = 0; g < 4; ++g) { const int W = g < 3 ? dil_w(g) : SWA_WINDOW, RV = g < 3 ? 128 : 64;
        const f32x4* src = (const f32x4*)(g < 3 ? sel3c(P.cache_dil, g) : P.cache_nsa_win); f32x4* dst = (f32x4*)(g < 3 ? sel3(P.dil_s, g) : P.win_s);
        const long per = (long)(W - 1) * RV, nvec = (long)DEC_BATCH * per;
#pragma unroll 1
        for (long i0 = (long)gw * 512; i0 < nvec; i0 += (long)NGW * 512) { f32x4 v[8]; long idx[8];
#pragma unroll
            for (int u = 0; u < 8; ++u) { const long i = i0 + u * 64 + lane; const long ii = i < nvec ? i : nvec - 1; const long n = ii / per, o = ii % per; idx[u] = n * (per + RV) + o; v[u] = src[idx[u] + RV]; }
#pragma unroll
            for (int u = 0; u < 8; ++u) { const long i = i0 + u * 64 + lane; if (i < nvec) dst[idx[u]] = v[u]; } } }
}
DI void p0_wpk(const FP& P, const Ctx& C) {
    LAS float* sw = (LAS float*)C.lds;
    LAS float* sk = (LAS float*)(C.lds + 32768);
    constexpr int NIT = DEPTH * 16 * (D_MODEL / 64);
    for (int it = C.vcu; it < NIT; it += C.G) { const int l = it / (16 * (D_MODEL / 64)), rem = it % (16 * (D_MODEL / 64)), hc = rem / (D_MODEL / 64), kb = rem % (D_MODEL / 64);
        __syncthreads();
        for (int i = C.tid; i < 64 * 64; i += NTHREADS) { const int r = i >> 6, d = i & 63; sw[r * 65 + d] = P.peer_wq[((size_t)l * D_MODEL + kb * 64 + r) * 1024 + hc * 64 + d]; }
        for (int i = C.tid; i < 128 * 64; i += NTHREADS) { const int r = i >> 6, d = i & 63; sk[r * 65 + d] = P.peer_keys[(((size_t)l * 16 + hc) * PEER_KEYS + r) * 64 + d]; }
        __syncthreads();
        for (int o = C.tid; o < 128 * 64; o += NTHREADS) { const int kk = o >> 6, ki = o & 63; float a = 0.f;
#pragma unroll 16
            for (int d = 0; d < 64; ++d) a += sw[ki * 65 + d] * sk[kk * 65 + d];
            P.WPK_T[((size_t)l * NPK + hc * 128 + kk) * D_MODEL + kb * 64 + ki] = (bf16)f2bf(a); } }
    __syncthreads();
}

#define EPI_LOOP(...) int fr_l = fr, fq_l = fq; asm volatile("" : "+v"(fr_l), "+v"(fq_l));     \
    _Pragma("unroll") for (int ai = 0; ai < 2; ++ai) _Pragma("unroll") for (int m = 0; m < 4; ++m) { const int row = u.pm * 256 + ai * 128 + wr * 64 + m * 16 + fr_l; \
    _Pragma("unroll") for (int bj = 0; bj < 2; ++bj) { const int ct = bj * 128 + wc * 32 + fq_l * 8; const f32x4 v0 = acc[ai][bj][m][0], v1 = acc[ai][bj][m][1]; __VA_ARGS__ } asm volatile("" ::: "memory"); }
DI void rope4(const float* rope_row, int dp, const f32x4& v0, const f32x4& v1, f32x4& lo, f32x4& hi) {
    const f32x4 c = *(const f32x4*)(rope_row + dp), s = *(const f32x4*)(rope_row + 32 + dp);
    lo.x = v0.x * c.x - v0.y * s.x; hi.x = v0.y * c.x + v0.x * s.x; lo.y = v0.z * c.y - v0.w * s.y; hi.y = v0.w * c.y + v0.z * s.y;
    lo.z = v1.x * c.z - v1.y * s.z; hi.z = v1.y * c.z + v1.x * s.z; lo.w = v1.z * c.w - v1.w * s.w; hi.w = v1.w * c.w + v1.z * s.w; }
DI u32x2 pk4(const f32x4& v) { u32x2 o; o.x = pk2(v.x, v.y); o.y = pk2(v.z, v.w); return o; }
DI u32x4 pk8(const f32x4& a, const f32x4& b) { u32x4 o; o.x = pk2(a.x, a.y); o.y = pk2(a.z, a.w); o.z = pk2(b.x, b.y); o.w = pk2(b.z, b.w); return o; }
DI int dil_perm(int t, int d) { return (t % d) * (SEQ / d) + t / d; }
struct EpiA {
    static constexpr bool PERM = true, AFTER_DRAIN = false; const FP& P;
    DI void operator()(const f32x4 (&acc)[2][2][4][2], const pg8::Unit& u, int wr, int wc, int fr, int fq) const {
        const int t9 = u.pn; const int g = t9 / 3, j = t9 % 3;
        EPI_LOOP({ if (row < MP) { const int h = ct >> 6, e = ct & 63; const int pos = row_pos(row);
            if (t9 == 9) { *(u32x4*)(P.MQA + (size_t)row * 256 + ct) = pk8(v0 * QSCALE, v1 * QSCALE); }
            else if (j < 2) { f32x4 lo, hi; const int dp = e >> 1; rope4(P.ROPE + pos * 64, dp, v0, v1, lo, hi);
                if (j == 0) { bf16* q = P.QA + ((size_t)g * MPAD + row) * 256 + h * 64 + dp; *(u32x2*)q = pk4(lo * QSCALE); *(u32x2*)(q + 32) = pk4(hi * QSCALE); }
                else { if (row < M0) { bf16* kt = P.KA + ((size_t)(g * BATCH + row / SEQ) * DIL_HEADS + h) * 64 * SEQ; const int cm = dil_perm(pos, dil_d(g)); *(u32x2*)(kt + ktile_off(cm, dp)) = pk4(lo); *(u32x2*)(kt + ktile_off(cm, dp + 32)) = pk4(hi); }
                    const int W = dil_w(g); float* o = nullptr;
                    if (row >= M0) o = sel3(P.dil_s, g) + (((size_t)(row - M0) * W + W - 1) * 2 + 0) * 256; else if (pos >= SEQ - W) o = sel3(P.dil_p, g) + (((size_t)(row / SEQ) * W + pos - (SEQ - W)) * 2 + 0) * 256;
                    if (o) { *(f32x4*)(o + h * 64 + dp) = lo; *(f32x4*)(o + h * 64 + 32 + dp) = hi; } } }
            else { const int W = dil_w(g), d = dil_d(g); float* o = nullptr;
                if (row >= M0) o = sel3(P.dil_s, g) + (((size_t)(row - M0) * W + W - 1) * 2 + 1) * 256; else if (pos >= SEQ - W) o = sel3(P.dil_p, g) + (((size_t)(row / SEQ) * W + pos - (SEQ - W)) * 2 + 1) * 256;
                if (o) { *(f32x4*)(o + ct) = v0; *(f32x4*)(o + ct + 4) = v1; }
                if (row < M0) { bf16* vt = P.VTA + ((size_t)(g * BATCH + row / SEQ) * DIL_HEADS + h) * 64 * SEQ + vtile_off(e, dil_perm(pos, d));
                    vt[0] = (bf16)f2bf(v0.x); vt[8] = (bf16)f2bf(v0.y); vt[16] = (bf16)f2bf(v0.z); vt[24] = (bf16)f2bf(v0.w); vt[32] = (bf16)f2bf(v1.x); vt[40] = (bf16)f2bf(v1.y); vt[48] = (bf16)f2bf(v1.z); vt[56] = (bf16)f2bf(v1.w); } } } })
    }
};
struct EpiMem {
    static constexpr bool PERM = true, AFTER_DRAIN = false; const FP& P;
    DI void operator()(const f32x4 (&acc)[2][2][4][2], const pg8::Unit& u, int wr, int wc, int fr, int fq) const {
        const int l = u.pn >> 1, half = u.pn & 1;
        EPI_LOOP({ const int n = row / MEM_TOKENS, mt = row % MEM_TOKENS; float* o = P.mem_kv_p + (((size_t)l * BATCH + n) * MEM_TOKENS + mt) * 512 + half * 256 + ct; *(f32x4*)o = v0; *(f32x4*)(o + 4) = v1;
            if (half == 0) *(u32x4*)(P.MK + (((size_t)l * BATCH + n) * MEM_HEADS + (ct >> 6)) * MEM_TOKENS * 64 + ktile_off(mt, ct & 63)) = pk8(v0, v1);
            else { bf16* vt = P.MVT + (((size_t)l * BATCH + n) * MEM_HEADS + (ct >> 6)) * MEM_TOKENS * 64 + vtile_off(ct & 63, mt);
                vt[0] = (bf16)f2bf(v0.x); vt[8] = (bf16)f2bf(v0.y); vt[16] = (bf16)f2bf(v0.z); vt[24] = (bf16)f2bf(v0.w); vt[32] = (bf16)f2bf(v1.x); vt[40] = (bf16)f2bf(v1.y); vt[48] = (bf16)f2bf(v1.z); vt[56] = (bf16)f2bf(v1.w); } })
    }
};
struct EpiPre {
    static constexpr bool PERM = true, AFTER_DRAIN = false; const float* xa; const float* xb; float* pre;
    DI void operator()(const f32x4 (&acc)[2][2][4][2], const pg8::Unit& u, int wr, int wc, int fr, int fq) const {
        EPI_LOOP({ if (row < MP) { const int col = u.pn * 256 + ct; const float* x = (xb && row >= M0) ? xb + (size_t)(row - M0) * D_MODEL + col : xa + (size_t)row * D_MODEL + col;
            const f32x4 a = *(const f32x4*)x, b = *(const f32x4*)(x + 4); float* o = pre + (size_t)row * D_MODEL + col; *(f32x4*)o = a * ALPHA + v0; *(f32x4*)(o + 4) = b * ALPHA + v1; } })
    }
};
struct EpiF32 {
    static constexpr bool PERM = true, AFTER_DRAIN = false; float* out; int ldc; int nrows;
    DI void operator()(const f32x4 (&acc)[2][2][4][2], const pg8::Unit& u, int wr, int wc, int fr, int fq) const {
        EPI_LOOP({ if (row < nrows) { float* o = out + (size_t)row * ldc + u.pn * 256 + ct; *(f32x4*)o = v0; *(f32x4*)(o + 4) = v1; } })
    }
};
}
namespace fx {
struct Tile16 { f32x4 o[4]; float m, l; };
DI void tile_init(Tile16& T) { T.o[0] = T.o[1] = T.o[2] = T.o[3] = (f32x4){0.f, 0.f, 0.f, 0.f}; T.m = -INFINITY; T.l = 0.f; }
typedef __bf16 bf16x2_t __attribute__((ext_vector_type(2)));
DI unsigned cvtpk(float lo, float hi) { const f32x2 v = {lo, hi}; const bf16x2_t b = __builtin_convertvector(v, bf16x2_t); return __builtin_bit_cast(unsigned, b); }
struct KV8 { bf16x8 ka0, ka1, kb0, kb1, v0, v1, v2, v3; };
DI void kv_load(KV8& r, const bf16* k0, const bf16* k1, const bf16* v, long vs16) {
    r.ka0 = *(const bf16x8*)k0; r.ka1 = *(const bf16x8*)(k0 + 32); r.kb0 = *(const bf16x8*)k1; r.kb1 = *(const bf16x8*)(k1 + 32);
    r.v0 = *(const bf16x8*)v; r.v1 = *(const bf16x8*)(v + vs16); r.v2 = *(const bf16x8*)(v + 2 * vs16); r.v3 = *(const bf16x8*)(v + 3 * vs16); }
DI void mk_range(int a, int b, bool ok, int& lo, unsigned& rng) { const bool v = ok && b >= a; lo = v ? a : (1 << 20); rng = v ? (unsigned)(b - a) : 0u; }
DI float colmax(float x) { float a = x, b = x; asm volatile("s_nop 1\n\tv_permlane32_swap_b32 %0, %1" : "+v"(a), "+v"(b)); float m = fmaxf(a, b); a = m; b = m;
    asm volatile("s_nop 1\n\tv_permlane16_swap_b32 %0, %1" : "+v"(a), "+v"(b)); return fmaxf(a, b); }
DI float colsum(float x) { float a = x, b = x; asm volatile("s_nop 1\n\tv_permlane32_swap_b32 %0, %1" : "+v"(a), "+v"(b)); float m = a + b; a = m; b = m;
    asm volatile("s_nop 1\n\tv_permlane16_swap_b32 %0, %1" : "+v"(a), "+v"(b)); return a + b; }
DI void tile_compute(Tile16& T, const bf16x8 (&qf)[2], const KV8& r, int lo, unsigned rng) {
    f32x4 s0 = (f32x4){0.f, 0.f, 0.f, 0.f}, s1 = (f32x4){0.f, 0.f, 0.f, 0.f};
    s0 = __builtin_amdgcn_mfma_f32_16x16x32_bf16(r.ka0, qf[0], s0, 0, 0, 0); s0 = __builtin_amdgcn_mfma_f32_16x16x32_bf16(r.ka1, qf[1], s0, 0, 0, 0);
    s1 = __builtin_amdgcn_mfma_f32_16x16x32_bf16(r.kb0, qf[0], s1, 0, 0, 0); s1 = __builtin_amdgcn_mfma_f32_16x16x32_bf16(r.kb1, qf[1], s1, 0, 0, 0);
    float s[8] = {s0.x, s0.y, s0.z, s0.w, s1.x, s1.y, s1.z, s1.w};
    float mx = -INFINITY;
#pragma unroll
    for (int e = 0; e < 8; ++e) { s[e] = ((unsigned)(e - lo) <= rng) ? s[e] : -INFINITY; mx = fmaxf(mx, s[e]); }
    mx = colmax(mx);
    const float mnew = fmaxf(T.m, mx), muse = (mnew == -INFINITY) ? 0.f : mnew;
    const float alpha = __builtin_amdgcn_exp2f(T.m - muse);
    float ls = 0.f;
#pragma unroll
    for (int e = 0; e < 8; ++e) { s[e] = __builtin_amdgcn_exp2f(s[e] - muse); ls += s[e]; }
    T.l = T.l * alpha + ls; T.m = mnew;
    u32x4 pw; pw.x = cvtpk(s[0], s[1]); pw.y = cvtpk(s[2], s[3]); pw.z = cvtpk(s[4], s[5]); pw.w = cvtpk(s[6], s[7]);
    const bf16x8 pf = __builtin_bit_cast(bf16x8, pw);
    T.o[0] = __builtin_amdgcn_mfma_f32_16x16x32_bf16(r.v0, pf, T.o[0] * alpha, 0, 0, 0); T.o[1] = __builtin_amdgcn_mfma_f32_16x16x32_bf16(r.v1, pf, T.o[1] * alpha, 0, 0, 0);
    T.o[2] = __builtin_amdgcn_mfma_f32_16x16x32_bf16(r.v2, pf, T.o[2] * alpha, 0, 0, 0); T.o[3] = __builtin_amdgcn_mfma_f32_16x16x32_bf16(r.v3, pf, T.o[3] * alpha, 0, 0, 0);
}
template <class BUF, class LD, class CP> DI void pipe2t(int n, LD ld, CP cp) { if (n <= 0) return; BUF A, B; ld(A, 0);
#pragma unroll 1
    for (int i = 0; i < n; i += 2) { ld(B, (i + 1 < n) ? i + 1 : i); cp(A, i); ld(A, (i + 2 < n) ? i + 2 : i); if (i + 1 < n) cp(B, i + 1); } }
template <class LD, class CP> DI void pipe2(int n, LD ld, CP cp) { if (n <= 0) return; KV8 A, B; ld(A, 0);
#pragma unroll 1
    for (int i = 0; i < n; i += 2) { ld(B, (i + 1 < n) ? i + 1 : i); cp(A, i); ld(A, (i + 2 < n) ? i + 2 : i); if (i + 1 < n) cp(B, i + 1); } }
DI void kv_load_t(KV8& r, const bf16* kt, const bf16* vt, int lane) {
    const bf16* k = kt + lane * 8; const bf16* v = vt + lane * 8;
    r.ka0 = *(const bf16x8*)k; r.ka1 = *(const bf16x8*)(k + 512); r.kb0 = *(const bf16x8*)(k + 1024); r.kb1 = *(const bf16x8*)(k + 1536);
    r.v0 = *(const bf16x8*)v; r.v1 = *(const bf16x8*)(v + 512); r.v2 = *(const bf16x8*)(v + 1024); r.v3 = *(const bf16x8*)(v + 1536); }
DI int krow_of(int i, int b) { return 8 * (i >> 2) + 4 * b + (i & 3); }

DI void dil_micro(const FP& P, int n, int h, int t0, int mt, int lane) {
    const int g = mt >> 4, idx = mt & 15, d = dil_d(g), per = 16 / d;
    const int r = idx / per, sub = idx % per, i0 = t0 / d + 16 * sub, ib = i0 - 128, NC = SEQ / d;
    const int q = lane & 15, c = lane >> 4;
    const bf16* Qb = P.QA + ((size_t)g * MPAD + (size_t)n * SEQ) * 256 + h * 64;
    const bf16* Kb = P.KA + ((size_t)(g * BATCH + n) * DIL_HEADS + h) * 64 * SEQ + (size_t)r * NC * 64; const bf16* Vb = P.VTA + ((size_t)(g * BATCH + n) * DIL_HEADS + h) * 64 * SEQ + (size_t)r * NC * 64;
    bf16x8 qf[2]; { const bf16* qp = Qb + (size_t)(r + d * (i0 + q)) * 256 + 8 * c; qf[0] = *(const bf16x8*)qp; qf[1] = *(const bf16x8*)(qp + 32); }
    Tile16 T; tile_init(T);
    const int qi = i0 + q; const int tb0 = ib >> 5  , nblk = ((i0 + 15) >> 5) - tb0 + 1;
    pipe2(nblk, [&](KV8& kv, int i) { int tb = tb0 + i; tb = tb < 0 ? 0 : tb; kv_load_t(kv, Kb + (size_t)tb * 2048, Vb + (size_t)tb * 2048, lane); },
          [&](const KV8& kv, int i) { const int k0 = 32 * (tb0 + i) + 8 * c; int lo; unsigned rng; const int a = qi - (DIL_TAPS - 1); mk_range((a > 0 ? a : 0) - k0, qi - k0, true, lo, rng); tile_compute(T, qf, kv, lo, rng); });
    const int row = n * SEQ + r + d * qi;
    float* op = P.DPART + (((size_t)g * MP + row) * DIL_HEADS + h) * 64 + 4 * c;
#pragma unroll
    for (int db = 0; db < 4; ++db) *(f32x4*)(op + 16 * db) = T.o[db];
    T.l = colsum(T.l);
    if (c == 0) { float* ml = P.DML + (((size_t)g * MP + row) * DIL_HEADS + h) * 2; ml[0] = T.m; ml[1] = T.l; }
}
DI void mem_micro(const FP& P, const bf16* Q  , int ldq, int row0, int layer, int n, int h, bf16* O  , int ldo, int lane) {
    const int q = lane & 15, c = lane >> 4;
    bf16x8 qf[2]; { const bf16* qp = Q + (size_t)(row0 + q) * ldq + 8 * c; qf[0] = *(const bf16x8*)qp; qf[1] = *(const bf16x8*)(qp + 32); }
    const bf16* Kb = P.MK + (((size_t)layer * BATCH + n) * MEM_HEADS + h) * MEM_TOKENS * 64; const bf16* Vb = P.MVT + (((size_t)layer * BATCH + n) * MEM_HEADS + h) * MEM_TOKENS * 64;
    Tile16 T; tile_init(T);
    pipe2(MEM_TOKENS / 32, [&](KV8& kv, int i) { kv_load_t(kv, Kb + (size_t)i * 2048, Vb + (size_t)i * 2048, lane); }, [&](const KV8& kv, int) { tile_compute(T, qf, kv, -8, 64u); });
    const float inv = 1.0f / colsum(T.l); bf16* op = O + (size_t)(row0 + q) * ldo + 4 * c;
#pragma unroll
    for (int db = 0; db < 4; ++db) *(u32x2*)(op + 16 * db) = pk4(T.o[db] * inv);
}
struct Dec { float m, l, o; };
template <class KF, class VF> DI void dec_chunk(Dec& D, const LAS float* q, int nk, KF kf, VF vf, int lane) {
    float s = -INFINITY;
    if (lane < nk) { const float* k = kf(lane); float a = 0.f;
#pragma unroll
        for (int d4 = 0; d4 < 16; ++d4) { const f32x4 kv = *(const f32x4*)(k + 4 * d4); a += kv.x * q[4 * d4] + kv.y * q[4 * d4 + 1] + kv.z * q[4 * d4 + 2] + kv.w * q[4 * d4 + 3]; }
        s = a; }
    const float mx = wave_max(s), mnew = fmaxf(D.m, mx), alpha = __builtin_amdgcn_exp2f(D.m - mnew);
    const float p = (lane < nk) ? __builtin_amdgcn_exp2f(s - mnew) : 0.f;
    D.l = D.l * alpha + wave_sum(p); D.m = mnew; float o = D.o * alpha;
    for (int j0 = 0; j0 < nk; j0 += 8) { float vv[8];
#pragma unroll
        for (int u = 0; u < 8; ++u) { const int jj = (j0 + u < nk) ? j0 + u : nk - 1; vv[u] = vf(jj)[lane]; }
#pragma unroll
        for (int u = 0; u < 8; ++u) { const float pj = (j0 + u < nk) ? __builtin_bit_cast(float, __builtin_amdgcn_readlane(__builtin_bit_cast(int, p), (j0 + u) & 63)) : 0.f; o += pj * vv[u]; } }
    D.o = o;
}
DI float dec_combine(const Ctx& C, const Dec& D) {
    LAS float* cb = (LAS float*)(C.lds + 4096);
    cb[C.wave * 66 + C.lane] = D.o; if (C.lane == 0) { cb[C.wave * 66 + 64] = D.m; cb[C.wave * 66 + 65] = D.l; }
    asm volatile("s_waitcnt lgkmcnt(0)" ::: "memory"); __syncthreads();
    float M = -INFINITY;
#pragma unroll
    for (int ww = 0; ww < NWAVES; ++ww) M = fmaxf(M, cb[ww * 66 + 64]);
    float L = 0.f, o = 0.f;
#pragma unroll
    for (int ww = 0; ww < NWAVES; ++ww) { const float mw = cb[ww * 66 + 64]; const float f = (mw == -INFINITY) ? 0.f : __builtin_amdgcn_exp2f(mw - M); L += f * cb[ww * 66 + 65]; o += f * cb[ww * 66 + C.lane]; }
    return o / L;
}
DI void atta_phase(const FP& P, const Ctx& C) {
    const int lane = C.lane, w = C.wave;
    constexpr int NT = SEQ / 256, NIT = BATCH * NT * DIL_HEADS;
    for (int it = C.vcu; it < NIT; it += C.G) { const int h = it % DIL_HEADS, tt = (it / DIL_HEADS) % NT, n = it / (DIL_HEADS * NT), t0 = tt * 256;
        for (int mt = w; mt < 48; mt += NWAVES) dil_micro(P, n, h, t0, mt, lane);
        asm volatile("s_waitcnt vmcnt(0)" ::: "memory"); __syncthreads();
        for (int i = C.tid; i < 256 * 16; i += NTHREADS) { const int tk = i >> 4, d4 = (i & 15) * 4; const int row = n * SEQ + t0 + tk;
            float mg[3], lg[3]; float M = -INFINITY;
#pragma unroll
            for (int g = 0; g < 3; ++g) { const float* ml = P.DML + (((size_t)g * MP + row) * DIL_HEADS + h) * 2; mg[g] = ml[0]; lg[g] = ml[1]; M = fmaxf(M, mg[g]); }
            f32x4 acc = (f32x4){0.f, 0.f, 0.f, 0.f}; float L = 0.f;
#pragma unroll
            for (int g = 0; g < 3; ++g) { const float wg = __builtin_amdgcn_exp2f(mg[g] - M); L += wg * lg[g]; acc += *(const f32x4*)(P.DPART + (((size_t)g * MP + row) * DIL_HEADS + h) * 64 + d4) * wg; }
            *(u32x2*)(P.ATTA + (size_t)row * 512 + h * 64 + d4) = pk4(acc * (1.0f / L)); }
        for (int mt = w; mt < 16; mt += NWAVES) mem_micro(P, P.MQA + h * 64, 256, n * SEQ + t0 + 16 * mt, 0, n, h, P.ATTA + 256 + h * 64, 512, lane);
        __syncthreads();
    }
    LAS float* qs = (LAS float*)C.lds;
    for (int it = C.vcu; it < DEC_BATCH * DIL_HEADS * 2; it += C.G) { const int kind = it & 1, h = (it >> 1) % DIL_HEADS, ns = (it >> 1) / DIL_HEADS, row = M0 + ns;
        __syncthreads();
        if (kind == 0) { if (C.tid < 192) qs[C.tid] = bf2f(P.QA[((size_t)(C.tid >> 6) * MPAD + row) * 256 + h * 64 + (C.tid & 63)]); } else { if (C.tid < 64) qs[C.tid] = bf2f(P.MQA[(size_t)row * 256 + h * 64 + C.tid]); }
        asm volatile("s_waitcnt lgkmcnt(0)" ::: "memory"); __syncthreads();
        Dec D; D.m = -INFINITY; D.l = 0.f; D.o = 0.f;
        if (kind == 0) { constexpr int CPG = (DIL_TAPS + 63) / 64;
            for (int ck = w; ck < 3 * CPG; ck += NWAVES) { const int g = ck / CPG, j0 = (ck % CPG) * 64; const int W = dil_w(g), d = dil_d(g); const float* cache = sel3c(P.cache_dil, g) + (size_t)ns * W * 512; const float* newrow = sel3(P.dil_s, g) + ((size_t)ns * W + W - 1) * 512;
                const int nk = (DIL_TAPS - j0) < 64 ? (DIL_TAPS - j0) : 64;
                dec_chunk(D, qs + g * 64, nk, [&](int j) { const int tap = j0 + j; return (tap == 0 ? newrow : cache + (size_t)(W - d * tap) * 512) + h * 64; },
                          [&](int j) { const int tap = j0 + j; return (tap == 0 ? newrow : cache + (size_t)(W - d * tap) * 512) + 256 + h * 64; }, lane); } }
        else { const float* mk = P.cache_mem_kv + ((size_t)0 * DEC_BATCH + ns) * MEM_TOKENS * 512;
            for (int ck = w; ck < MEM_TOKENS / 64; ck += NWAVES) { const int j0 = ck * 64; dec_chunk(D, qs, 64, [&](int j) { return mk + (size_t)(j0 + j) * 512 + h * 64; }, [&](int j) { return mk + (size_t)(j0 + j) * 512 + 256 + h * 64; }, lane); } }
        const float o = dec_combine(C, D);
        if (w == 0) P.ATTA[(size_t)row * 512 + (kind == 0 ? 0 : 256) + h * 64 + lane] = (bf16)f2bf(o);
    }
    __syncthreads();
}
DI void ln_phase(const FP& P, const Ctx& C, const float* pre, const float* gam, const float* bet, float* xo, bf16* xb, float* yp, float* ys) {
    const int gw = C.vcu * NWAVES + C.wave, NGW = C.G * NWAVES, lane = C.lane;
    for (int r = gw; r < MP; r += NGW) { const float* x = pre + (size_t)r * D_MODEL; f32x4 v[4]; float s = 0.f;
#pragma unroll
        for (int j = 0; j < 4; ++j) { v[j] = *(const f32x4*)(x + 256 * j + 4 * lane); s += (v[j].x + v[j].y) + (v[j].z + v[j].w); }
        const float mu = wave_sum(s) * (1.0f / D_MODEL); float s2 = 0.f;
#pragma unroll
        for (int j = 0; j < 4; ++j) { v[j] = v[j] - mu; s2 += (v[j].x * v[j].x + v[j].y * v[j].y) + (v[j].z * v[j].z + v[j].w * v[j].w); }
        const float rs = 1.0f / sqrtf(wave_sum(s2) * (1.0f / D_MODEL) + LN_EPS);
#pragma unroll
        for (int j = 0; j < 4; ++j) { const f32x4 gg = *(const f32x4*)(gam + 256 * j + 4 * lane), bb = *(const f32x4*)(bet + 256 * j + 4 * lane); const f32x4 o = v[j] * rs * gg + bb;
            if (xo) *(f32x4*)(xo + (size_t)r * D_MODEL + 256 * j + 4 * lane) = o;
            if (xb) *(u32x2*)(xb + (size_t)r * D_MODEL + 256 * j + 4 * lane) = pk4(o);
            if (yp) { if (r < M0) *(f32x4*)(yp + (size_t)r * D_MODEL + 256 * j + 4 * lane) = o; else *(f32x4*)(ys + (size_t)(r - M0) * D_MODEL + 256 * j + 4 * lane) = o; } }
    }
}
}
namespace fx {
#define INS16(V, I, v_, i_) do { const float _v = (v_); const int _i = (i_); bool _c[16]; _Pragma("unroll") for (int _k = 0; _k < 16; ++_k) _c[_k] = _v > V[_k]; \
    _Pragma("unroll") for (int _k = 15; _k >= 1; --_k) { V[_k] = _c[_k] ? (_c[_k - 1] ? V[_k - 1] : _v) : V[_k]; I[_k] = _c[_k] ? (_c[_k - 1] ? I[_k - 1] : _i) : I[_k]; } \
    V[0] = _c[0] ? _v : V[0]; I[0] = _c[0] ? _i : I[0]; } while (0)
DI void wave_top16_128(float a, float b, int lane, float& outv, int& outi) {
    outv = -INFINITY; outi = 0;
#pragma unroll 1
    for (int k = 0; k < 16; ++k) { const float m = wave_max(fmaxf(a, b)); const unsigned long long ba = __ballot(a == m), bb = __ballot(b == m); int idx;
        if (ba) { const int l = __builtin_ctzll(ba); idx = l; if (lane == l) a = -INFINITY; } else { const int l = __builtin_ctzll(bb); idx = 64 + l; if (lane == l) b = -INFINITY; }
        if (lane == k) { outv = m; outi = idx; } }
}
DI void topk_wave_item(const FP& P, long it, int lane) {
    const float* s = P.SCO + it * 256; float v1, v2; int i1, i2;
    wave_top16_128(s[lane], s[64 + lane], lane, v1, i1); wave_top16_128(s[128 + lane], s[192 + lane], lane, v2, i2);
    int a = 0, rem = lane; bool valid = false;
    for (int aa = 0; aa < 16; ++aa) { const int nb = 16 / (aa + 1); if (!valid) { if (rem < nb) { a = aa; valid = true; } else rem -= nb; } }
    const int b = valid ? rem : 0;
    float cs = __shfl(v1, a) + __shfl(v2, b); const int ce = __shfl(i1, a) * PEER_KEYS + __shfl(i2, b); if (!valid) cs = -INFINITY;
    float tv = -INFINITY; int te = 0;
#pragma unroll 1
    for (int k = 0; k < 16; ++k) { const float m = wave_max(cs); const unsigned long long bm = __ballot(cs == m); const int l = __builtin_ctzll(bm); const int e = __shfl(ce, l); if (lane == l) cs = -INFINITY; if (lane == k) { tv = m; te = e; } }
    const float mx = __shfl(tv, 0); const float ex = (lane < 16) ? __expf(tv - mx) : 0.f; const float z = wave_sum(ex);
    if (lane < 16) { P.SELG[it * 16 + lane] = ex / z; P.SELE[it * 16 + lane] = te; }
}
#define KINS16(V, key_) do { const float _key = (key_); _Pragma("unroll") for (int _k = 15; _k >= 1; --_k) V[_k] = __builtin_amdgcn_fmed3f(V[_k - 1], V[_k], _key); V[0] = fmaxf(V[0], _key); } while (0)
DI float pack_key(float v, unsigned lowbits, unsigned mask) { return __builtin_bit_cast(float, (__builtin_bit_cast(unsigned, v) & ~mask) | lowbits); }
DI void topk_phase(const FP& P, const Ctx& C) {
    const int lane = C.lane; LAS float* st = (LAS float*)(C.lds + C.wave * 16384);
    const int NWI = (M0 * PEER_HEADS) / 64;
    for (int wi = C.vcu * NWAVES + C.wave; wi < NWI; wi += C.G * NWAVES) {
        const long it0 = (long)wi * 64; const long it = it0 + lane;
        float V1[16], V2[16], V3[16];
#pragma unroll
        for (int k = 0; k < 16; ++k) { V1[k] = V2[k] = V3[k] = -INFINITY; }
#pragma unroll 1
        for (int ch = 0; ch < 8; ++ch) {
#pragma unroll
            for (int u = 0; u < 8; ++u) { const int f4 = u * 64 + lane, j = f4 >> 3, q = f4 & 7, hf = q >> 2, c4 = (q & 3) * 4; const long itj = it0 + j;
                const f32x4 v = *(const f32x4*)(P.SCO + itj * 256 + hf * 128 + ch * 16 + c4);
                st[j * 33 + hf * 16 + c4] = v.x; st[j * 33 + hf * 16 + c4 + 1] = v.y; st[j * 33 + hf * 16 + c4 + 2] = v.z; st[j * 33 + hf * 16 + c4 + 3] = v.w; }
            asm volatile("s_waitcnt lgkmcnt(0)" ::: "memory");
#pragma unroll 4
            for (int c = 0; c < 16; ++c) { const float va = st[lane * 33 + c], vb = st[lane * 33 + 16 + c]; const unsigned lb = 127u - (unsigned)(ch * 16 + c); KINS16(V1, pack_key(va, lb, 127u)); KINS16(V2, pack_key(vb, lb, 127u)); }
            asm volatile("s_waitcnt lgkmcnt(0)" ::: "memory");
        }
        LAS int* lc = (LAS int*)st;
        { int ord = 0;
#pragma unroll
          for (int a = 0; a < 16; ++a) { const unsigned ba = __builtin_bit_cast(unsigned, V1[a]); const float va = __builtin_bit_cast(float, ba & ~127u); const int ia = 127 - (int)(ba & 127u);
#pragma unroll
              for (int b = 0; b < 16; ++b) if ((a + 1) * (b + 1) <= 16) { const unsigned bb = __builtin_bit_cast(unsigned, V2[b]); const float vb = __builtin_bit_cast(float, bb & ~127u); const int ib = 127 - (int)(bb & 127u);
                  lc[lane * 51 + ord] = ia * PEER_KEYS + ib; KINS16(V3, pack_key(va + vb, 63u - (unsigned)ord, 63u)); ++ord; } } }
        asm volatile("s_waitcnt lgkmcnt(0)" ::: "memory");
        float g[16]; int e[16]; float z = 0.f; const float vmax = __builtin_bit_cast(float, __builtin_bit_cast(unsigned, V3[0]) & ~63u);
#pragma unroll
        for (int k = 0; k < 16; ++k) { const unsigned bk = __builtin_bit_cast(unsigned, V3[k]); e[k] = lc[lane * 51 + 63 - (int)(bk & 63u)]; g[k] = __expf(__builtin_bit_cast(float, bk & ~63u) - vmax); z += g[k]; }
        const float iz = 1.0f / z;
#pragma unroll
        for (int k4 = 0; k4 < 4; ++k4) { *(f32x4*)(P.SELG + it * 16 + 4 * k4) = (f32x4){g[4 * k4] * iz, g[4 * k4 + 1] * iz, g[4 * k4 + 2] * iz, g[4 * k4 + 3] * iz};
            *(int4*)(P.SELE + it * 16 + 4 * k4) = make_int4(e[4 * k4], e[4 * k4 + 1], e[4 * k4 + 2], e[4 * k4 + 3]); }
        asm volatile("s_waitcnt lgkmcnt(0)" ::: "memory");
    }
    for (int si = C.vcu * NWAVES + C.wave; si < DEC_BATCH * PEER_HEADS; si += C.G * NWAVES) topk_wave_item(P, (long)M0 * PEER_HEADS + si, lane);
    __syncthreads();
}
constexpr float PEER_SU = 256.f, PEER_SV = 64.f;
DI float dot16_fp8(const u32x4& w, const f32x2 (&x2)[8]) { f32x2 a = {0.f, 0.f};
    a += __builtin_amdgcn_cvt_pk_f32_fp8((int)w.x, false) * x2[0]; a += __builtin_amdgcn_cvt_pk_f32_fp8((int)w.x, true) * x2[1];
    a += __builtin_amdgcn_cvt_pk_f32_fp8((int)w.y, false) * x2[2]; a += __builtin_amdgcn_cvt_pk_f32_fp8((int)w.y, true) * x2[3];
    a += __builtin_amdgcn_cvt_pk_f32_fp8((int)w.z, false) * x2[4]; a += __builtin_amdgcn_cvt_pk_f32_fp8((int)w.z, true) * x2[5];
    a += __builtin_amdgcn_cvt_pk_f32_fp8((int)w.w, false) * x2[6]; a += __builtin_amdgcn_cvt_pk_f32_fp8((int)w.w, true) * x2[7];
    return a.x + a.y; }
DI void axpy16_fp8(const u32x4& w, float s, f32x2 (&o2)[8]) { const f32x2 s2 = {s, s};
    o2[0] += __builtin_amdgcn_cvt_pk_f32_fp8((int)w.x, false) * s2; o2[1] += __builtin_amdgcn_cvt_pk_f32_fp8((int)w.x, true) * s2;
    o2[2] += __builtin_amdgcn_cvt_pk_f32_fp8((int)w.y, false) * s2; o2[3] += __builtin_amdgcn_cvt_pk_f32_fp8((int)w.y, true) * s2;
    o2[4] += __builtin_amdgcn_cvt_pk_f32_fp8((int)w.z, false) * s2; o2[5] += __builtin_amdgcn_cvt_pk_f32_fp8((int)w.z, true) * s2;
    o2[6] += __builtin_amdgcn_cvt_pk_f32_fp8((int)w.w, false) * s2; o2[7] += __builtin_amdgcn_cvt_pk_f32_fp8((int)w.w, true) * s2; }
#if defined(PEER_SHARD) || defined(PEER_SHARD2)
#define PEER_FIRST_ROUND nrounds
#else
#define PEER_FIRST_ROUND 0
#endif
DI float rdlane(float v, int l) { return __builtin_bit_cast(float, __builtin_amdgcn_readlane(__builtin_bit_cast(int, v), l)); }
DI void peer_phase(const FP& P, const Ctx& C, int layer, const float* xin, float* fout, float* fout_s, bf16* xb, bool samples_only = false) {
    const int lane = C.lane; const unsigned char* U = P.UB8 + (size_t)layer * PEER_EXPERTS * D_MODEL; const unsigned char* Vt = P.VB8 + (size_t)layer * PEER_EXPERTS * D_MODEL;
    const float* gam = P.ln_g + ((size_t)layer * 2 + 1) * D_MODEL; const float* bet = P.ln_b + ((size_t)layer * 2 + 1) * D_MODEL;
    const int nrounds = (M0 + C.G * NWAVES - 1) / (C.G * NWAVES);
#pragma unroll 1
    for (int rd = samples_only ? nrounds : 0; rd <= nrounds; ++rd) {
        const bool smp = (rd == nrounds); int r = smp ? M0 + C.vcu : rd * C.G * NWAVES + C.vcu * NWAVES + C.wave; if (smp ? (C.vcu >= DEC_BATCH) : (r >= M0)) continue;
        const int pb = smp ? 16 * C.wave : 0, pe = smp ? pb + 16 : 128;
        f32x2 x2[8], o2[8];
#pragma unroll
        for (int j = 0; j < 4; ++j) { const f32x4 a = *(const f32x4*)(xin + (size_t)r * D_MODEL + 16 * lane + 4 * j); x2[2 * j] = (f32x2){a.x, a.y}; x2[2 * j + 1] = (f32x2){a.z, a.w}; }
#pragma unroll
        for (int k = 0; k < 8; ++k) o2[k] = (f32x2){0.f, 0.f};
        const int e_l = P.SELE[(size_t)r * 128 + lane], e_h = P.SELE[(size_t)r * 128 + 64 + lane]; const float g_l = P.SELG[(size_t)r * 128 + lane], g_h = P.SELG[(size_t)r * 128 + 64 + lane];
#pragma unroll 1
        for (int b0 = pb; b0 < pe; b0 += 8) {
            u32x4 uw[8], vw[8];
#pragma unroll
            for (int k = 0; k < 8; ++k) { const int hk = b0 + k; const int e = (hk < 64) ? __builtin_amdgcn_readlane(e_l, hk & 63) : __builtin_amdgcn_readlane(e_h, hk & 63);
                uw[k] = *(const u32x4*)(U + (size_t)e * D_MODEL + 16 * lane); vw[k] = *(const u32x4*)(Vt + (size_t)e * D_MODEL + 16 * lane); }
            float d[8];
#pragma unroll
            for (int k = 0; k < 8; ++k) d[k] = dot16_fp8(uw[k], x2);
            float e4[4], e2[2], e1;
            { const bool hi = lane & 1;
#pragma unroll
              for (int i = 0; i < 4; ++i) { const float keep = hi ? d[4 + i] : d[i], send = hi ? d[i] : d[4 + i]; e4[i] = keep + __shfl_xor(send, 1); } }
            { const bool hi = lane & 2;
#pragma unroll
              for (int i = 0; i < 2; ++i) { const float keep = hi ? e4[2 + i] : e4[i], send = hi ? e4[i] : e4[2 + i]; e2[i] = keep + __shfl_xor(send, 2); } }
            { const bool hi = lane & 4; const float keep = hi ? e2[1] : e2[0], send = hi ? e2[0] : e2[1]; e1 = keep + __shfl_xor(send, 4); }
            e1 += __shfl_xor(e1, 8); e1 += __shfl_xor(e1, 16); e1 += __shfl_xor(e1, 32);
            const int myk = 4 * (lane & 1) + (lane & 2) + ((lane >> 2) & 1); const int myhk = b0 + myk;
            const float myg = (myhk < 64) ? __shfl(g_l, myhk & 63) : __shfl(g_h, myhk & 63);
            const float act = myg * gelu_tanh(e1 * (1.0f / PEER_SU)) * (1.0f / PEER_SV);
#pragma unroll
            for (int k = 0; k < 8; ++k) { const int src = (k >> 2) | (((k >> 1) & 1) << 1) | ((k & 1) << 2); axpy16_fp8(vw[k], rdlane(act, src), o2); }
        }
        if (smp) {
            LAS float* red = (LAS float*)C.lds;
#pragma unroll
            for (int k = 0; k < 8; ++k) { red[C.wave * 1024 + 16 * lane + 2 * k] = o2[k].x; red[C.wave * 1024 + 16 * lane + 2 * k + 1] = o2[k].y; }
            asm volatile("s_waitcnt lgkmcnt(0)" ::: "memory"); __syncthreads();
            if (C.wave == 0) {
#pragma unroll
                for (int k = 0; k < 8; ++k) { float ax = 0.f, ay = 0.f;
#pragma unroll
                    for (int ww = 0; ww < NWAVES; ++ww) { ax += red[ww * 1024 + 16 * lane + 2 * k]; ay += red[ww * 1024 + 16 * lane + 2 * k + 1]; } o2[k] = (f32x2){ax, ay}; } }
            __syncthreads();
            if (C.wave != 0) continue; }
        float s = 0.f;
#pragma unroll
        for (int k = 0; k < 8; ++k) { o2[k] += x2[k] * ALPHA; s += o2[k].x + o2[k].y; }
        const float mu = wave_sum(s) * (1.0f / D_MODEL); float s2 = 0.f;
#pragma unroll
        for (int k = 0; k < 8; ++k) { o2[k] -= mu; s2 += o2[k].x * o2[k].x + o2[k].y * o2[k].y; }
        const float rs = 1.0f / sqrtf(wave_sum(s2) * (1.0f / D_MODEL) + LN_EPS);
        float* frow = (r < M0) ? fout + (size_t)r * D_MODEL : fout_s + (size_t)(r - M0) * D_MODEL;
#pragma unroll
        for (int j = 0; j < 4; ++j) { const int c0 = 16 * lane + 4 * j; const f32x4 gg = *(const f32x4*)(gam + c0), bb = *(const f32x4*)(bet + c0);
            const f32x4 y = (f32x4){o2[2 * j].x * rs, o2[2 * j].y * rs, o2[2 * j + 1].x * rs, o2[2 * j + 1].y * rs} * gg + bb;
            *(f32x4*)(frow + c0) = y; if (xb) *(u32x2*)(xb + (size_t)r * D_MODEL + c0) = pk4(y); }
    }
}
DI void peer_u_phase(const FP& P, const Ctx& C, int layer, const bf16* xb16) {
    const int lane = C.lane; const unsigned char* U = P.UB8 + (size_t)layer * PEER_EXPERTS * D_MODEL;
    const int s = (int)(blockIdx.x & 7), nw = (C.G >> 3) * NWAVES, widx = (int)(blockIdx.x >> 3) * NWAVES + C.wave;
#pragma unroll 1
    for (int r = widx; r < MP; r += nw) {
        const int e0 = P.SELE[(size_t)r * 128 + lane], e1 = P.SELE[(size_t)r * 128 + 64 + lane]; const float g0 = P.SELG[(size_t)r * 128 + lane], g1 = P.SELG[(size_t)r * 128 + 64 + lane];
        unsigned long long b0 = __ballot((e0 >> 11) == s), b1 = __ballot((e1 >> 11) == s);
        if ((b0 | b1) == 0ull) continue;
        f32x2 x2[8]; { const u32x4 xa = *(const u32x4*)(xb16 + (size_t)r * D_MODEL + 16 * lane), xc = *(const u32x4*)(xb16 + (size_t)r * D_MODEL + 16 * lane + 8);
            x2[0] = (f32x2){bflo(xa.x), bfhi(xa.x)}; x2[1] = (f32x2){bflo(xa.y), bfhi(xa.y)}; x2[2] = (f32x2){bflo(xa.z), bfhi(xa.z)}; x2[3] = (f32x2){bflo(xa.w), bfhi(xa.w)};
            x2[4] = (f32x2){bflo(xc.x), bfhi(xc.x)}; x2[5] = (f32x2){bflo(xc.y), bfhi(xc.y)}; x2[6] = (f32x2){bflo(xc.z), bfhi(xc.z)}; x2[7] = (f32x2){bflo(xc.w), bfhi(xc.w)}; }
#pragma unroll 1
        while ((b0 | b1) != 0ull) {
            int hk[8]; u32x4 uw[8]; int nv = 0;
#pragma unroll
            for (int k = 0; k < 8; ++k) { int h;
                if (b0) { h = __builtin_ctzll(b0); b0 &= b0 - 1; ++nv; } else if (b1) { h = 64 + __builtin_ctzll(b1); b1 &= b1 - 1; ++nv; } else h = hk[k > 0 ? k - 1 : 0];
                hk[k] = h; const int e = (h < 64) ? __builtin_amdgcn_readlane(e0, h & 63) : __builtin_amdgcn_readlane(e1, h & 63);
                uw[k] = *(const u32x4*)(U + (size_t)e * D_MODEL + 16 * lane); }
            float d[8];
#pragma unroll
            for (int k = 0; k < 8; ++k) d[k] = dot16_fp8(uw[k], x2);
            float e4[4], e2[2], e1s;
            { const bool hi = lane & 1;
#pragma unroll
              for (int i = 0; i < 4; ++i) { const float keep = hi ? d[4 + i] : d[i], send = hi ? d[i] : d[4 + i]; e4[i] = keep + __shfl_xor(send, 1); } }
            { const bool hi = lane & 2;
#pragma unroll
              for (int i = 0; i < 2; ++i) { const float keep = hi ? e4[2 + i] : e4[i], send = hi ? e4[i] : e4[2 + i]; e2[i] = keep + __shfl_xor(send, 2); } }
            { const bool hi = lane & 4; const float keep = hi ? e2[1] : e2[0], send = hi ? e2[0] : e2[1]; e1s = keep + __shfl_xor(send, 4); }
            e1s += __shfl_xor(e1s, 8); e1s += __shfl_xor(e1s, 16); e1s += __shfl_xor(e1s, 32);
            const int myk = 4 * (lane & 1) + (lane & 2) + ((lane >> 2) & 1);
            int myh = hk[0];
#pragma unroll
            for (int k = 1; k < 8; ++k) myh = (myk == k) ? hk[k] : myh;
            const float ga = __shfl(g0, myh & 63), gb = __shfl(g1, myh & 63); const float myg = (myh < 64) ? ga : gb;
            if (lane < 8 && myk < nv) P.SCO[(size_t)r * 128 + myh] = myg * gelu_tanh(e1s * (1.0f / PEER_SU)) * (1.0f / PEER_SV);
        }
    }
}
DI void peer_v_phase(const FP& P, const Ctx& C, int layer, const float* xin, float* fout, float* fout_s, bf16* xb) {
    const int lane = C.lane; const unsigned char* Vt = P.VB8 + (size_t)layer * PEER_EXPERTS * D_MODEL;
    const float* gam = P.ln_g + ((size_t)layer * 2 + 1) * D_MODEL; const float* bet = P.ln_b + ((size_t)layer * 2 + 1) * D_MODEL;
    const int nrounds = (M0 + C.G * NWAVES - 1) / (C.G * NWAVES);
#pragma unroll 1
    for (int rd = 0; rd <= nrounds; ++rd) {
        const bool smp = (rd == nrounds); int r = smp ? M0 + C.vcu : rd * C.G * NWAVES + C.vcu * NWAVES + C.wave; if (smp ? (C.vcu >= DEC_BATCH) : (r >= M0)) continue;
        const int pb = smp ? 16 * C.wave : 0, pe = smp ? pb + 16 : 128;
        f32x2 x2[8], o2[8];
#pragma unroll
        for (int j = 0; j < 4; ++j) { const f32x4 a = *(const f32x4*)(xin + (size_t)r * D_MODEL + 16 * lane + 4 * j); x2[2 * j] = (f32x2){a.x, a.y}; x2[2 * j + 1] = (f32x2){a.z, a.w}; }
#pragma unroll
        for (int k = 0; k < 8; ++k) o2[k] = (f32x2){0.f, 0.f};
        const int e_l = P.SELE[(size_t)r * 128 + lane], e_h = P.SELE[(size_t)r * 128 + 64 + lane]; const float a_l = P.SCO[(size_t)r * 128 + lane], a_h = P.SCO[(size_t)r * 128 + 64 + lane];
#pragma unroll 1
        for (int b0 = pb; b0 < pe; b0 += 16) { u32x4 vw[16];
#pragma unroll
            for (int k = 0; k < 16; ++k) { const int hk = b0 + k; const int e = (hk < 64) ? __builtin_amdgcn_readlane(e_l, hk & 63) : __builtin_amdgcn_readlane(e_h, hk & 63); vw[k] = *(const u32x4*)(Vt + (size_t)e * D_MODEL + 16 * lane); }
#pragma unroll
            for (int k = 0; k < 16; ++k) { const int hk = b0 + k; axpy16_fp8(vw[k], (hk < 64) ? rdlane(a_l, hk & 63) : rdlane(a_h, hk & 63), o2); } }
        if (smp) {
            LAS float* red = (LAS float*)C.lds;
#pragma unroll
            for (int k = 0; k < 8; ++k) { red[C.wave * 1024 + 16 * lane + 2 * k] = o2[k].x; red[C.wave * 1024 + 16 * lane + 2 * k + 1] = o2[k].y; }
            asm volatile("s_waitcnt lgkmcnt(0)" ::: "memory"); __syncthreads();
            if (C.wave == 0) {
#pragma unroll
                for (int k = 0; k < 8; ++k) { float ax = 0.f, ay = 0.f;
#pragma unroll
                    for (int ww = 0; ww < NWAVES; ++ww) { ax += red[ww * 1024 + 16 * lane + 2 * k]; ay += red[ww * 1024 + 16 * lane + 2 * k + 1]; } o2[k] = (f32x2){ax, ay}; } }
            __syncthreads();
            if (C.wave != 0) continue; }
        float s = 0.f;
#pragma unroll
        for (int k = 0; k < 8; ++k) { o2[k] += x2[k] * ALPHA; s += o2[k].x + o2[k].y; }
        const float mu = wave_sum(s) * (1.0f / D_MODEL); float s2 = 0.f;
#pragma unroll
        for (int k = 0; k < 8; ++k) { o2[k] -= mu; s2 += o2[k].x * o2[k].x + o2[k].y * o2[k].y; }
        const float rs = 1.0f / sqrtf(wave_sum(s2) * (1.0f / D_MODEL) + LN_EPS);
        float* frow = (r < M0) ? fout + (size_t)r * D_MODEL : fout_s + (size_t)(r - M0) * D_MODEL;
#pragma unroll
        for (int j = 0; j < 4; ++j) { const int c0 = 16 * lane + 4 * j; const f32x4 gg = *(const f32x4*)(gam + c0), bb = *(const f32x4*)(bet + c0);
            const f32x4 y = (f32x4){o2[2 * j].x * rs, o2[2 * j].y * rs, o2[2 * j + 1].x * rs, o2[2 * j + 1].y * rs} * gg + bb;
            *(f32x4*)(frow + c0) = y; if (xb) *(u32x2*)(xb + (size_t)r * D_MODEL + c0) = pk4(y); }
    }
}
constexpr int PSH_LIST = 512;
struct PG4 { u32x4 u[4], v[4]; };
DI void peer_sharded_phase(const FP& P, const Ctx& C, int layer, const float* xin, const bf16* xb16, float* fout, float* fout_s, bf16* xb) {
    const int lane = C.lane; const unsigned char* U = P.UB8 + (size_t)layer * PEER_EXPERTS * D_MODEL; const unsigned char* Vt = P.VB8 + (size_t)layer * PEER_EXPERTS * D_MODEL;
    const float* gam = P.ln_g + ((size_t)layer * 2 + 1) * D_MODEL; const float* bet = P.ln_b + ((size_t)layer * 2 + 1) * D_MODEL;
    LAS unsigned char* wl = C.lds + C.wave * 16384; LAS bf16* xs = (LAS bf16*)wl; LAS int* lst = (LAS int*)(wl + 8192);
    const int NW = C.G * NWAVES, gw = C.vcu * NWAVES + C.wave; const int nquads = (M0 / NW) / 4;
#pragma unroll 1
    for (int qd = 0; qd < nquads; ++qd) {
#define PSH_ROW(j) const int row##j = (qd * 4 + j) * NW + gw; const int el##j = P.SELE[(size_t)row##j * 128 + lane], eh##j = P.SELE[(size_t)row##j * 128 + 64 + lane]; const float gl##j = P.SELG[(size_t)row##j * 128 + lane], gh##j = P.SELG[(size_t)row##j * 128 + 64 + lane]; \
        { const u32x4 xa = *(const u32x4*)(xb16 + (size_t)row##j * D_MODEL + 16 * lane), xc = *(const u32x4*)(xb16 + (size_t)row##j * D_MODEL + 16 * lane + 8); *(LAS u32x4*)(xs + j * 1024 + 16 * lane) = xa; *(LAS u32x4*)(xs + j * 1024 + 16 * lane + 8) = xc; } \
        f32x2 oa##j[8]; _Pragma("unroll") for (int k = 0; k < 8; ++k) oa##j[k] = (f32x2){0.f, 0.f};
        PSH_ROW(0) PSH_ROW(1) PSH_ROW(2) PSH_ROW(3)
#pragma unroll 1
        for (int s = 0; s < 16; ++s) {
            int n = 0;
#define PSH_SCAN(j) { unsigned long long b0 = __ballot((el##j >> 10) == s), b1 = __ballot((eh##j >> 10) == s); \
                while (b0) { const int h = __builtin_ctzll(b0); b0 &= b0 - 1; const int e = __builtin_amdgcn_readlane(el##j, h); const int g = __builtin_amdgcn_readlane(__builtin_bit_cast(int, gl##j), h); \
                    if (lane == 0) { lst[4 * n] = e; lst[4 * n + 1] = g; lst[4 * n + 2] = j; } ++n; } \
                while (b1) { const int h = __builtin_ctzll(b1); b1 &= b1 - 1; const int e = __builtin_amdgcn_readlane(eh##j, h); const int g = __builtin_amdgcn_readlane(__builtin_bit_cast(int, gh##j), h); \
                    if (lane == 0) { lst[4 * n] = e; lst[4 * n + 1] = g; lst[4 * n + 2] = j; } ++n; } }
            PSH_SCAN(0) PSH_SCAN(1) PSH_SCAN(2) PSH_SCAN(3)
            asm volatile("s_waitcnt lgkmcnt(0)" ::: "memory");
            if (n == 0) continue;
            const int ngrp = (n + 3) >> 2;
#define PSH_LD(b, gi_) do { const int gi = (gi_); _Pragma("unroll") for (int k = 0; k < 4; ++k) { int i = 4 * gi + k; i = i < n ? i : n - 1; const int e = __builtin_amdgcn_readfirstlane(lst[4 * i]); \
                b.u[k] = *(const u32x4*)(U + (size_t)e * D_MODEL + 16 * lane); b.v[k] = *(const u32x4*)(Vt + (size_t)e * D_MODEL + 16 * lane); } } while (0)
#define PSH_CP(b, gi_) do { const int gi = (gi_); float d[4]; int jj[4]; float gg[4]; \
                _Pragma("unroll") for (int k = 0; k < 4; ++k) { int i = 4 * gi + k; const bool val = i < n; i = val ? i : n - 1; jj[k] = __builtin_amdgcn_readfirstlane(lst[4 * i + 2]); gg[k] = val ? __builtin_bit_cast(float, __builtin_amdgcn_readfirstlane(lst[4 * i + 1])) : 0.f; \
                    const u32x4 xa = *(const LAS u32x4*)(xs + jj[k] * 1024 + 16 * lane), xc = *(const LAS u32x4*)(xs + jj[k] * 1024 + 16 * lane + 8); \
                    const f32x2 x2[8] = {(f32x2){bflo(xa.x), bfhi(xa.x)}, (f32x2){bflo(xa.y), bfhi(xa.y)}, (f32x2){bflo(xa.z), bfhi(xa.z)}, (f32x2){bflo(xa.w), bfhi(xa.w)}, (f32x2){bflo(xc.x), bfhi(xc.x)}, (f32x2){bflo(xc.y), bfhi(xc.y)}, (f32x2){bflo(xc.z), bfhi(xc.z)}, (f32x2){bflo(xc.w), bfhi(xc.w)}}; \
                    d[k] = dot16_fp8(b.u[k], x2); } \
                float e2[2], e1; \
                { const bool hi = lane & 1; _Pragma("unroll") for (int i = 0; i < 2; ++i) { const float keep = hi ? d[2 + i] : d[i], send = hi ? d[i] : d[2 + i]; e2[i] = keep + __shfl_xor(send, 1); } } \
                { const bool hi = lane & 2; const float keep = hi ? e2[1] : e2[0], send = hi ? e2[0] : e2[1]; e1 = keep + __shfl_xor(send, 2); } \
                e1 += __shfl_xor(e1, 4); e1 += __shfl_xor(e1, 8); e1 += __shfl_xor(e1, 16); e1 += __shfl_xor(e1, 32); \
                const int myk = 2 * (lane & 1) + ((lane >> 1) & 1); \
                float myg = gg[0]; myg = (myk == 1) ? gg[1] : myg; myg = (myk == 2) ? gg[2] : myg; myg = (myk == 3) ? gg[3] : myg; \
                const float act = myg * gelu_tanh(e1 * (1.0f / PEER_SU)) * (1.0f / PEER_SV); \
                _Pragma("unroll") for (int k = 0; k < 4; ++k) { const float a = rdlane(act, (k >> 1) | ((k & 1) << 1)); \
                    if (jj[k] == 0) axpy16_fp8(b.v[k], a, oa0); else if (jj[k] == 1) axpy16_fp8(b.v[k], a, oa1); else if (jj[k] == 2) axpy16_fp8(b.v[k], a, oa2); else axpy16_fp8(b.v[k], a, oa3); } } while (0)
            { PG4 A, B; PSH_LD(A, 0);
#pragma unroll 1
              for (int g2 = 0; g2 < ngrp; g2 += 2) { PSH_LD(B, (g2 + 1 < ngrp) ? g2 + 1 : g2); PSH_CP(A, g2); PSH_LD(A, (g2 + 2 < ngrp) ? g2 + 2 : g2); if (g2 + 1 < ngrp) PSH_CP(B, g2 + 1); } }
            asm volatile("s_waitcnt lgkmcnt(0)" ::: "memory");
        }
#define PSH_LN(j) { const int r = row##j; f32x2 x2[8]; \
            _Pragma("unroll") for (int q = 0; q < 4; ++q) { const f32x4 a = *(const f32x4*)(xin + (size_t)r * D_MODEL + 16 * lane + 4 * q); x2[2 * q] = (f32x2){a.x, a.y}; x2[2 * q + 1] = (f32x2){a.z, a.w}; } \
            float sm = 0.f; _Pragma("unroll") for (int k = 0; k < 8; ++k) { oa##j[k] += x2[k] * ALPHA; sm += oa##j[k].x + oa##j[k].y; } \
            const float mu = wave_sum(sm) * (1.0f / D_MODEL); float s2 = 0.f; _Pragma("unroll") for (int k = 0; k < 8; ++k) { oa##j[k] -= mu; s2 += oa##j[k].x * oa##j[k].x + oa##j[k].y * oa##j[k].y; } \
            const float rs = 1.0f / sqrtf(wave_sum(s2) * (1.0f / D_MODEL) + LN_EPS); float* frow = fout + (size_t)r * D_MODEL; \
            _Pragma("unroll") for (int q = 0; q < 4; ++q) { const int c0 = 16 * lane + 4 * q; const f32x4 gv = *(const f32x4*)(gam + c0), bv = *(const f32x4*)(bet + c0); \
                const f32x4 y = (f32x4){oa##j[2 * q].x * rs, oa##j[2 * q].y * rs, oa##j[2 * q + 1].x * rs, oa##j[2 * q + 1].y * rs} * gv + bv; *(f32x4*)(frow + c0) = y; if (xb) *(u32x2*)(xb + (size_t)r * D_MODEL + c0) = pk4(y); } }
        PSH_LN(0) PSH_LN(1) PSH_LN(2) PSH_LN(3)
        asm volatile("s_waitcnt lgkmcnt(0)" ::: "memory");
    }
}
constexpr int PSH_LOG = 11, PSH_N = PEER_EXPERTS >> PSH_LOG;
#ifndef PS2_ROWS
#define PS2_ROWS 4
#endif
#define PS2_ROW(j) const int row##j = (qd * PS2_ROWS + j) * NW + gw; const int el##j = P.SELE[(size_t)row##j * 128 + lane], eh##j = P.SELE[(size_t)row##j * 128 + 64 + lane]; const float gl##j = P.SELG[(size_t)row##j * 128 + lane], gh##j = P.SELG[(size_t)row##j * 128 + 64 + lane]; \
    f32x2 oa##j[8]; _Pragma("unroll") for (int k = 0; k < 8; ++k) oa##j[k] = (f32x2){0.f, 0.f};
#define PS2_STEP(j) { unsigned long long b0 = __ballot((el##j >> PSH_LOG) == s), b1 = __ballot((eh##j >> PSH_LOG) == s); \
    if (b0 | b1) { const u32x4 xa##j = *(const u32x4*)(xb16 + (size_t)row##j * D_MODEL + 16 * lane), xc##j = *(const u32x4*)(xb16 + (size_t)row##j * D_MODEL + 16 * lane + 8);     \
      const f32x2 x2[8] = {(f32x2){bflo(xa##j.x), bfhi(xa##j.x)}, (f32x2){bflo(xa##j.y), bfhi(xa##j.y)}, (f32x2){bflo(xa##j.z), bfhi(xa##j.z)}, (f32x2){bflo(xa##j.w), bfhi(xa##j.w)}, (f32x2){bflo(xc##j.x), bfhi(xc##j.x)}, (f32x2){bflo(xc##j.y), bfhi(xc##j.y)}, (f32x2){bflo(xc##j.z), bfhi(xc##j.z)}, (f32x2){bflo(xc##j.w), bfhi(xc##j.w)}}; \
      _Pragma("unroll 1") while ((b0 | b1) != 0ull) { int hk[8]; u32x4 uw[8], vw[8]; int nv = 0; \
        _Pragma("unroll") for (int k = 0; k < 8; ++k) { int h; if (b0) { h = __builtin_ctzll(b0); b0 &= b0 - 1; ++nv; } else if (b1) { h = 64 + __builtin_ctzll(b1); b1 &= b1 - 1; ++nv; } else h = hk[k > 0 ? k - 1 : 0]; \
            hk[k] = h; const int e = (h < 64) ? __builtin_amdgcn_readlane(el##j, h & 63) : __builtin_amdgcn_readlane(eh##j, h & 63); \
            uw[k] = *(const u32x4*)(U + (size_t)e * D_MODEL + 16 * lane); vw[k] = *(const u32x4*)(Vt + (size_t)e * D_MODEL + 16 * lane); } \
        float d[8]; _Pragma("unroll") for (int k = 0; k < 8; ++k) d[k] = dot16_fp8(uw[k], x2); \
        float e4[4], e2[2], e1s; \
        { const bool hi = lane & 1; _Pragma("unroll") for (int i = 0; i < 4; ++i) { const float keep = hi ? d[4 + i] : d[i], send = hi ? d[i] : d[4 + i]; e4[i] = keep + __shfl_xor(send, 1); } } \
        { const bool hi = lane & 2; _Pragma("unroll") for (int i = 0; i < 2; ++i) { const float keep = hi ? e4[2 + i] : e4[i], send = hi ? e4[i] : e4[2 + i]; e2[i] = keep + __shfl_xor(send, 2); } } \
        { const bool hi = lane & 4; const float keep = hi ? e2[1] : e2[0], send = hi ? e2[0] : e2[1]; e1s = keep + __shfl_xor(send, 4); } \
        e1s += __shfl_xor(e1s, 8); e1s += __shfl_xor(e1s, 16); e1s += __shfl_xor(e1s, 32); \
        const int myk = 4 * (lane & 1) + (lane & 2) + ((lane >> 2) & 1); int myh = hk[0]; _Pragma("unroll") for (int k = 1; k < 8; ++k) myh = (myk == k) ? hk[k] : myh; \
        const float ga = __shfl(gl##j, myh & 63), gb = __shfl(gh##j, myh & 63); const float myg = (myk < nv) ? ((myh < 64) ? ga : gb) : 0.f;     \
        const float act = myg * gelu_tanh(e1s * (1.0f / PEER_SU)) * (1.0f / PEER_SV); \
        _Pragma("unroll") for (int k = 0; k < 8; ++k) { const int src = (k >> 2) | (((k >> 1) & 1) << 1) | ((k & 1) << 2); axpy16_fp8(vw[k], rdlane(act, src), oa##j); } } } }
#define PS2_LN(j) { const int r = row##j; f32x2 x2[8]; int ll = lane; asm volatile("" : "+v"(ll));     \
    _Pragma("unroll") for (int q = 0; q < 4; ++q) { const f32x4 a = *(const f32x4*)(xin + (size_t)r * D_MODEL + 16 * ll + 4 * q); x2[2 * q] = (f32x2){a.x, a.y}; x2[2 * q + 1] = (f32x2){a.z, a.w}; } \
    float sm = 0.f; _Pragma("unroll") for (int k = 0; k < 8; ++k) { oa##j[k] += x2[k] * ALPHA; sm += oa##j[k].x + oa##j[k].y; } \
    const float mu = wave_sum(sm) * (1.0f / D_MODEL); float s2 = 0.f; _Pragma("unroll") for (int k = 0; k < 8; ++k) { oa##j[k] -= mu; s2 += oa##j[k].x * oa##j[k].x + oa##j[k].y * oa##j[k].y; } \
    const float rs = 1.0f / sqrtf(wave_sum(s2) * (1.0f / D_MODEL) + LN_EPS); float* frow = fout + (size_t)r * D_MODEL; \
    _Pragma("unroll") for (int q = 0; q < 4; ++q) { const int c0 = 16 * ll + 4 * q; const f32x4 gv = *(const f32x4*)(gam + c0), bv = *(const f32x4*)(bet + c0); \
        const f32x4 y = (f32x4){oa##j[2 * q].x * rs, oa##j[2 * q].y * rs, oa##j[2 * q + 1].x * rs, oa##j[2 * q + 1].y * rs} * gv + bv; *(f32x4*)(frow + c0) = y; if (xb) *(u32x2*)(xb + (size_t)r * D_MODEL + c0) = pk4(y); } }
DI void peer_sharded2_phase(const FP& P, const Ctx& C, int layer, const float* xin, const bf16* xb16, float* fout, bf16* xb) {
    const int lane = C.lane; const unsigned char* U = P.UB8 + (size_t)layer * PEER_EXPERTS * D_MODEL; const unsigned char* Vt = P.VB8 + (size_t)layer * PEER_EXPERTS * D_MODEL;
    const float* gam = P.ln_g + ((size_t)layer * 2 + 1) * D_MODEL; const float* bet = P.ln_b + ((size_t)layer * 2 + 1) * D_MODEL;
    const int NW = C.G * NWAVES, gw = C.vcu * NWAVES + C.wave; const int nquads = (M0 / NW) / PS2_ROWS;
#pragma unroll 1
    for (int qd = 0; qd < nquads; ++qd) {
#if PS2_ROWS == 4
        PS2_ROW(0) PS2_ROW(1) PS2_ROW(2) PS2_ROW(3)
#pragma unroll 1
        for (int s = 0; s < PSH_N; ++s) { PS2_STEP(0) PS2_STEP(1) PS2_STEP(2) PS2_STEP(3) }
        PS2_LN(0) PS2_LN(1) PS2_LN(2) PS2_LN(3)
#else
        PS2_ROW(0) PS2_ROW(1)
#pragma unroll 1
        for (int s = 0; s < PSH_N; ++s) { PS2_STEP(0) PS2_STEP(1) }
        PS2_LN(0) PS2_LN(1)
#endif
    }
}
#define PS3_ROW(j) const int row##j = (qd * 4 + j) * NW + gw; const int el##j = P.SELE[(size_t)row##j * 128 + lane], eh##j = P.SELE[(size_t)row##j * 128 + 64 + lane]; \
    { const u32x4 xa = *(const u32x4*)(xb16 + (size_t)row##j * D_MODEL + 16 * lane), xc = *(const u32x4*)(xb16 + (size_t)row##j * D_MODEL + 16 * lane + 8); *(LAS u32x4*)(xs + j * 1024 + 16 * lane) = xa; *(LAS u32x4*)(xs + j * 1024 + 16 * lane + 8) = xc; } \
    f32x2 oa##j[8]; _Pragma("unroll") for (int k = 0; k < 8; ++k) oa##j[k] = (f32x2){0.f, 0.f};
#define PS3_X2_UNUSED(j) const f32x2 x2[8] = {(f32x2){bflo(xa##j.x), bfhi(xa##j.x)}, (f32x2){bflo(xa##j.y), bfhi(xa##j.y)}, (f32x2){bflo(xa##j.z), bfhi(xa##j.z)}, (f32x2){bflo(xa##j.w), bfhi(xa##j.w)}, (f32x2){bflo(xc##j.x), bfhi(xc##j.x)}, (f32x2){bflo(xc##j.y), bfhi(xc##j.y)}, (f32x2){bflo(xc##j.z), bfhi(xc##j.z)}, (f32x2){bflo(xc##j.w), bfhi(xc##j.w)}};
#define PS3_TAKE(q, M, ELH, GOFF) if (!got && M) { const int h = __builtin_ctzll(M); M &= M - 1; qq[k] = q; ee = __builtin_amdgcn_readlane(ELH, h); gk[k] = P.SELG[GOFF + h];     got = true; ++nv; }
DI void peer_sharded3_phase(const FP& P, const Ctx& C, int layer, const float* xin, const bf16* xb16, float* fout, bf16* xb) {
    const int lane = C.lane; const unsigned char* U = P.UB8 + (size_t)layer * PEER_EXPERTS * D_MODEL; const unsigned char* Vt = P.VB8 + (size_t)layer * PEER_EXPERTS * D_MODEL;
    const float* gam = P.ln_g + ((size_t)layer * 2 + 1) * D_MODEL; const float* bet = P.ln_b + ((size_t)layer * 2 + 1) * D_MODEL;
    const int NW = C.G * NWAVES, gw = C.vcu * NWAVES + C.wave; const int nquads = (M0 / NW) / 4; LAS bf16* xs = (LAS bf16*)(C.lds + C.wave * 16384);
#pragma unroll 1
    for (int qd = 0; qd < nquads; ++qd) {
        PS3_ROW(0) PS3_ROW(1) PS3_ROW(2) PS3_ROW(3)
        asm volatile("s_waitcnt lgkmcnt(0)" ::: "memory");
#pragma unroll 1
        for (int s = 0; s < PSH_N; ++s) {
            unsigned long long m0 = __ballot((el0 >> PSH_LOG) == s), m1 = __ballot((eh0 >> PSH_LOG) == s), m2 = __ballot((el1 >> PSH_LOG) == s), m3 = __ballot((eh1 >> PSH_LOG) == s),
                               m4 = __ballot((el2 >> PSH_LOG) == s), m5 = __ballot((eh2 >> PSH_LOG) == s), m6 = __ballot((el3 >> PSH_LOG) == s), m7 = __ballot((eh3 >> PSH_LOG) == s);
#pragma unroll 1
            while ((m0 | m1 | m2 | m3 | m4 | m5 | m6 | m7) != 0ull) {
                int qq[8]; float gk[8]; int es[8]; u32x4 uw[8]; int nv = 0; int elast = 0;
#pragma unroll
                for (int k = 0; k < 8; ++k) { bool got = false; int ee = elast; qq[k] = k > 0 ? qq[k - 1] : 0; gk[k] = 0.f;
                    PS3_TAKE(0, m0, el0, (size_t)row0 * 128) PS3_TAKE(1, m1, eh0, (size_t)row0 * 128 + 64) PS3_TAKE(2, m2, el1, (size_t)row1 * 128) PS3_TAKE(3, m3, eh1, (size_t)row1 * 128 + 64) PS3_TAKE(4, m4, el2, (size_t)row2 * 128) PS3_TAKE(5, m5, eh2, (size_t)row2 * 128 + 64) PS3_TAKE(6, m6, el3, (size_t)row3 * 128) PS3_TAKE(7, m7, eh3, (size_t)row3 * 128 + 64)
                    elast = ee; es[k] = ee; uw[k] = *(const u32x4*)(U + (size_t)ee * D_MODEL + 16 * lane); }
                float d[8];
#pragma unroll
                for (int k = 0; k < 8; ++k) { const int j = qq[k] >> 1; const u32x4 xa = *(const LAS u32x4*)(xs + j * 1024 + 16 * lane), xc = *(const LAS u32x4*)(xs + j * 1024 + 16 * lane + 8);
                    const f32x2 x2[8] = {(f32x2){bflo(xa.x), bfhi(xa.x)}, (f32x2){bflo(xa.y), bfhi(xa.y)}, (f32x2){bflo(xa.z), bfhi(xa.z)}, (f32x2){bflo(xa.w), bfhi(xa.w)}, (f32x2){bflo(xc.x), bfhi(xc.x)}, (f32x2){bflo(xc.y), bfhi(xc.y)}, (f32x2){bflo(xc.z), bfhi(xc.z)}, (f32x2){bflo(xc.w), bfhi(xc.w)}};
                    d[k] = dot16_fp8(uw[k], x2); }
                u32x4 vw[8];
#pragma unroll
                for (int k = 0; k < 8; ++k) vw[k] = *(const u32x4*)(Vt + (size_t)es[k] * D_MODEL + 16 * lane);
                float e4[4], e2[2], e1s;
                { const bool hi = lane & 1;
#pragma unroll
                  for (int i = 0; i < 4; ++i) { const float keep = hi ? d[4 + i] : d[i], send = hi ? d[i] : d[4 + i]; e4[i] = keep + __shfl_xor(send, 1); } }
                { const bool hi = lane & 2;
#pragma unroll
                  for (int i = 0; i < 2; ++i) { const float keep = hi ? e4[2 + i] : e4[i], send = hi ? e4[i] : e4[2 + i]; e2[i] = keep + __shfl_xor(send, 2); } }
                { const bool hi = lane & 4; const float keep = hi ? e2[1] : e2[0], send = hi ? e2[0] : e2[1]; e1s = keep + __shfl_xor(send, 4); }
                e1s += __shfl_xor(e1s, 8); e1s += __shfl_xor(e1s, 16); e1s += __shfl_xor(e1s, 32);
                const int myk = 4 * (lane & 1) + (lane & 2) + ((lane >> 2) & 1); float myg = gk[0];
#pragma unroll
                for (int k = 1; k < 8; ++k) myg = (myk == k) ? gk[k] : myg;
                const float act = myg * gelu_tanh(e1s * (1.0f / PEER_SU)) * (1.0f / PEER_SV);
#pragma unroll
                for (int k = 0; k < 8; ++k) { const int src = (k >> 2) | (((k >> 1) & 1) << 1) | ((k & 1) << 2); const float a = rdlane(act, src); const int j = qq[k] >> 1;
                    if (j == 0) { asm volatile("" ::: "memory"); axpy16_fp8(vw[k], a, oa0); } else if (j == 1) { asm volatile("" ::: "memory"); axpy16_fp8(vw[k], a, oa1); } else if (j == 2) { asm volatile("" ::: "memory"); axpy16_fp8(vw[k], a, oa2); } else { asm volatile("" ::: "memory"); axpy16_fp8(vw[k], a, oa3); } }
            }
        }
        PS2_LN(0) PS2_LN(1) PS2_LN(2) PS2_LN(3)
    }
}
}
namespace fx {
struct EpiB {
    static constexpr bool PERM = true, AFTER_DRAIN = false; const FP& P;
    DI void operator()(const f32x4 (&acc)[2][2][4][2], const pg8::Unit& u, int wr, int wc, int fr, int fq) const {
        const int t = u.pn;
        EPI_LOOP({ if (row < MP) { const int pos = row_pos(row), n = row / SEQ, e = ct & 63, dp = e >> 1; const bool prm = row < M0;
            if (t < 3) { const int ty = 2 * t + (ct >> 7), kvh = (ct >> 6) & 1;
                if (ty == 2 || ty == 4) { f32x4 lo, hi; rope4(P.ROPE + pos * 64, dp, v0, v1, lo, hi);
                    if (ty == 2) { float* o = (prm ? P.nsa_kv_p + (size_t)row * 512 : P.nsa_kv_s + (size_t)(row - M0) * 512) + 256 + kvh * 64 + dp; *(f32x4*)o = lo; *(f32x4*)(o + 32) = hi;
                        if (prm) { bf16* kt = P.SLK + ((size_t)n * NSA_KV_HEADS + kvh) * SEQ * 64; *(u32x2*)(kt + ktile_off(pos, dp)) = pk4(lo); *(u32x2*)(kt + ktile_off(pos, dp + 32)) = pk4(hi); } }
                    else { float* o = nullptr; if (!prm) o = P.win_s + (((size_t)(row - M0) * SWA_WINDOW + SWA_WINDOW - 1) * 2 + 0) * 128; else if (pos >= SEQ - SWA_WINDOW) o = P.win_p + (((size_t)n * SWA_WINDOW + pos - (SEQ - SWA_WINDOW)) * 2 + 0) * 128;
                        if (o) { *(f32x4*)(o + kvh * 64 + dp) = lo; *(f32x4*)(o + kvh * 64 + 32 + dp) = hi; }
                        if (prm) { bf16* kt = P.WNK + ((size_t)n * NSA_KV_HEADS + kvh) * SEQ * 64; *(u32x2*)(kt + ktile_off(pos, dp)) = pk4(lo); *(u32x2*)(kt + ktile_off(pos, dp + 32)) = pk4(hi); } } }
                else if (ty < 4) { float* o = (prm ? P.nsa_kv_p + (size_t)row * 512 : P.nsa_kv_s + (size_t)(row - M0) * 512) + ty * 128 + kvh * 64 + e; *(f32x4*)o = v0; *(f32x4*)(o + 4) = v1;
                    if (prm) { if (ty < 2) *(u32x4*)(P.AC + ((size_t)ty * ACROWS + ((size_t)n * NSA_KV_HEADS + kvh) * NCH + pos / 16) * 1024 + (pos % 16) * 64 + e) = pk8(v0, v1);
                        else { bf16* vt = P.SLVT + ((size_t)n * NSA_KV_HEADS + kvh) * SEQ * 64 + vtile_off(e, pos);
                            vt[0] = (bf16)f2bf(v0.x); vt[8] = (bf16)f2bf(v0.y); vt[16] = (bf16)f2bf(v0.z); vt[24] = (bf16)f2bf(v0.w); vt[32] = (bf16)f2bf(v1.x); vt[40] = (bf16)f2bf(v1.y); vt[48] = (bf16)f2bf(v1.z); vt[56] = (bf16)f2bf(v1.w); } } }
                else { float* o = nullptr; if (!prm) o = P.win_s + (((size_t)(row - M0) * SWA_WINDOW + SWA_WINDOW - 1) * 2 + 1) * 128; else if (pos >= SEQ - SWA_WINDOW) o = P.win_p + (((size_t)n * SWA_WINDOW + pos - (SEQ - SWA_WINDOW)) * 2 + 1) * 128;
                    if (o) { *(f32x4*)(o + kvh * 64 + e) = v0; *(f32x4*)(o + kvh * 64 + e + 4) = v1; }
                    if (prm) { bf16* vt = P.WNVT + ((size_t)n * NSA_KV_HEADS + kvh) * SEQ * 64 + vtile_off(e, pos);
                        vt[0] = (bf16)f2bf(v0.x); vt[8] = (bf16)f2bf(v0.y); vt[16] = (bf16)f2bf(v0.z); vt[24] = (bf16)f2bf(v0.w); vt[32] = (bf16)f2bf(v1.x); vt[40] = (bf16)f2bf(v1.y); vt[48] = (bf16)f2bf(v1.z); vt[56] = (bf16)f2bf(v1.w); } } }
            else if (t < 6) { const int h = (t - 3) * 4 + (ct >> 6); f32x4 lo, hi; rope4(P.ROPE + pos * 64, dp, v0, v1, lo, hi); bf16* q = P.QB + (size_t)row * NSA_Q_COLS + h * 64 + dp; *(u32x2*)q = pk4(lo * QSCALE); *(u32x2*)(q + 32) = pk4(hi * QSCALE); }
            else if (t == 6) { *(u32x4*)(P.MQB + (size_t)row * 256 + ct) = pk8(v0 * QSCALE, v1 * QSCALE); }
            else if (ct < 40) { const float vv[8] = {v0.x, v0.y, v0.z, v0.w, v1.x, v1.y, v1.z, v1.w};
                _Pragma("unroll") for (int i = 0; i < 8; ++i) if (ct + i < NSA_GATE_COLS) P.GATES[(size_t)row * 64 + ct + i] = 1.0f / (1.0f + __expf(-vv[i])); } } })
    }
};
DI void cmp2_phase(const FP& P, const Ctx& C) {
    const int lane = C.lane; LAS float* hs = (LAS float*)(C.lds + C.wave * 1024);
    constexpr int NGRP = NCTX * 2 * NSA_KV_HEADS; const int NW = C.G * NWAVES, WPG = NW / NGRP > 0 ? NW / NGRP : 1; const int gw = C.vcu * NWAVES + C.wave;
#pragma unroll 1
    for (int grp = gw / WPG; grp < NGRP; grp += (NW + WPG - 1) / WPG) { const int slot = gw % WPG; if (gw >= (NW / WPG) * WPG && grp == gw / WPG) break;
        const int kvh = grp % NSA_KV_HEADS, ty = (grp / NSA_KV_HEADS) % 2, ctx = grp / (2 * NSA_KV_HEADS);
        const float* UL = P.UL + ((size_t)ty * ACROWS + ((size_t)ctx * NSA_KV_HEADS + kvh) * NCH) * 256; const float* w2 = P.cmp_w2 + (size_t)ty * CMP_HIDDEN * HEAD_DIM;
        float w2r[CMP_HIDDEN];
#pragma unroll
        for (int k = 0; k < CMP_HIDDEN; ++k) w2r[k] = w2[k * HEAD_DIM + lane];
        const float b0 = P.CBIAS[ty * CMP_HIDDEN + lane], b1 = P.CBIAS[ty * CMP_HIDDEN + 64 + lane];
        float u0, u1, l0, l1; int c = slot;
        if (c < NCMP) { u0 = UL[(size_t)c * 256 + lane]; u1 = UL[(size_t)c * 256 + 64 + lane]; l0 = UL[(size_t)(c + 1) * 256 + 128 + lane]; l1 = UL[(size_t)(c + 1) * 256 + 192 + lane]; }
#pragma unroll 1
        for (; c < NCMP; c += WPG) { const float h0 = gelu_tanh(u0 + l0 + b0), h1 = gelu_tanh(u1 + l1 + b1); const int cn = c + WPG;
            if (cn < NCMP) { u0 = UL[(size_t)cn * 256 + lane]; u1 = UL[(size_t)cn * 256 + 64 + lane]; l0 = UL[(size_t)(cn + 1) * 256 + 128 + lane]; l1 = UL[(size_t)(cn + 1) * 256 + 192 + lane]; }
            hs[lane] = h0; hs[64 + lane] = h1; asm volatile("s_waitcnt lgkmcnt(0)" ::: "memory");
            float a = 0.f;
#pragma unroll
            for (int k4 = 0; k4 < CMP_HIDDEN / 4; ++k4) { const f32x4 hv = *(const LAS f32x4*)(hs + 4 * k4); a += hv.x * w2r[4 * k4] + hv.y * w2r[4 * k4 + 1] + hv.z * w2r[4 * k4 + 2] + hv.w * w2r[4 * k4 + 3]; }
            if (ty == 0) { const float other = __shfl_xor(a, 32); const int pos = c * CMP_STRIDE + CMP_BLOCK - 1; const float cs = P.ROPE[pos * 64 + (lane & 31)], sn = P.ROPE[pos * 64 + 32 + (lane & 31)];
                a = (lane < 32) ? a * cs - other * sn : a * cs + other * sn; }
            if (ctx < BATCH) { if (ty == 0) P.CK[((size_t)ctx * NSA_KV_HEADS + kvh) * NCH * 64 + ktile_off(c, lane)] = (bf16)f2bf(a); else P.CVT[((size_t)ctx * NSA_KV_HEADS + kvh) * NCH * 64 + vtile_off(lane, c)] = (bf16)f2bf(a); }
            else { (ty == 0 ? P.CKF : P.CVF)[(((size_t)(ctx - BATCH) * NSA_KV_HEADS + kvh) * NCH + c) * 64 + lane] = a; }
            asm volatile("s_waitcnt lgkmcnt(0)" ::: "memory"); }
    }
    __syncthreads();
}
constexpr int NSA_WLDS = 8192;
DI void nsa_pair_a(const FP& P, int n, int kvh, int t, int lane, LAS unsigned char* wl) {
    LAS float* pn = (LAS float*)wl; LAS float* imp = (LAS float*)(wl + 2048); LAS float* sc = (LAS float*)(wl + 6144); LAS int* sel = (LAS int*)(wl + 7168);
    const int col = lane & 15, c = lane >> 4; const bool vcol = col < 12; const int qq = vcol ? col / 6 : 0, hh = vcol ? col % 6 : 0, tq = t + qq, head = kvh * NSA_GROUP + hh, row = n * SEQ + tq;
    bf16x8 qf[2]; { const bf16* qp = P.QB + (size_t)row * NSA_Q_COLS + head * 64 + 8 * c; qf[0] = *(const bf16x8*)qp; qf[1] = *(const bf16x8*)(qp + 32); }
    const float* gt = P.GATES + (size_t)row * 64 + head * 3;
    f32x4 oacc[4] = {(f32x4){0.f, 0.f, 0.f, 0.f}, (f32x4){0.f, 0.f, 0.f, 0.f}, (f32x4){0.f, 0.f, 0.f, 0.f}, (f32x4){0.f, 0.f, 0.f, 0.f}};
    const int lim = vcol ? ((tq >= CMP_BLOCK - 1) ? (tq - (CMP_BLOCK - 1)) / CMP_STRIDE : -1) : -1;
    const int limmax = (t + 1 >= CMP_BLOCK - 1) ? (t + 1 - (CMP_BLOCK - 1)) / CMP_STRIDE : -1; const int nblk = (limmax + 32) / 32;
    const bf16* CKb = P.CK + ((size_t)n * NSA_KV_HEADS + kvh) * NCH * 64; const bf16* CVb = P.CVT + ((size_t)n * NSA_KV_HEADS + kvh) * 64 * NCH;
    for (int i = lane; i < 1024; i += 64) imp[i] = 0.f;
    float m1 = -INFINITY, l1 = 0.f;
    { struct K4 { bf16x8 a0, a1, b0, b1; };
      auto ldk = [&](K4& k, int blk) { const bf16* kt = CKb + (size_t)blk * 2048 + lane * 8; k.a0 = *(const bf16x8*)kt; k.a1 = *(const bf16x8*)(kt + 512); k.b0 = *(const bf16x8*)(kt + 1024); k.b1 = *(const bf16x8*)(kt + 1536); };
      auto cp1 = [&](const K4& k, int blk) { const int kb = 32 * blk;
        f32x4 s0 = (f32x4){0.f, 0.f, 0.f, 0.f}, s1 = (f32x4){0.f, 0.f, 0.f, 0.f};
        s0 = __builtin_amdgcn_mfma_f32_16x16x32_bf16(k.a0, qf[0], s0, 0, 0, 0); s0 = __builtin_amdgcn_mfma_f32_16x16x32_bf16(k.a1, qf[1], s0, 0, 0, 0);
        s1 = __builtin_amdgcn_mfma_f32_16x16x32_bf16(k.b0, qf[0], s1, 0, 0, 0); s1 = __builtin_amdgcn_mfma_f32_16x16x32_bf16(k.b1, qf[1], s1, 0, 0, 0);
        float s[8] = {s0.x, s0.y, s0.z, s0.w, s1.x, s1.y, s1.z, s1.w}; float mx = -INFINITY;
        const int hi1 = lim - (kb + 8 * c);
#pragma unroll
        for (int e = 0; e < 8; ++e) { s[e] = (e <= hi1) ? s[e] : -INFINITY; mx = fmaxf(mx, s[e]); }
        mx = colmax(mx);
        const float mnew = fmaxf(m1, mx), muse = (mnew == -INFINITY) ? 0.f : mnew; float ls = 0.f;
#pragma unroll
        for (int e = 0; e < 8; ++e) ls += __builtin_amdgcn_exp2f(s[e] - muse);
        l1 = l1 * __builtin_amdgcn_exp2f(m1 - muse) + ls; m1 = mnew; };
      if (nblk > 0) { K4 A, B; ldk(A, 0);
#pragma unroll 1
        for (int blk = 0; blk < nblk; blk += 2) { ldk(B, (blk + 1 < nblk) ? blk + 1 : blk); cp1(A, blk); ldk(A, (blk + 2 < nblk) ? blk + 2 : blk); if (blk + 1 < nblk) cp1(B, blk + 1); } } }
    asm volatile("s_waitcnt lgkmcnt(0)" ::: "memory");
    { l1 = colsum(l1); const float muse = (m1 == -INFINITY) ? 0.f : m1, inv = (l1 > 0.f) ? 1.0f / l1 : 0.f;
      f32x4 oc[4] = {(f32x4){0.f, 0.f, 0.f, 0.f}, (f32x4){0.f, 0.f, 0.f, 0.f}, (f32x4){0.f, 0.f, 0.f, 0.f}, (f32x4){0.f, 0.f, 0.f, 0.f}};
      pipe2(nblk, [&](KV8& kv, int blk) { kv_load_t(kv, CKb + (size_t)blk * 2048, CVb + (size_t)blk * 2048, lane); }, [&](const KV8& kv, int blk) { const int kb = 32 * blk;
        f32x4 s0 = (f32x4){0.f, 0.f, 0.f, 0.f}, s1 = (f32x4){0.f, 0.f, 0.f, 0.f};
        s0 = __builtin_amdgcn_mfma_f32_16x16x32_bf16(kv.ka0, qf[0], s0, 0, 0, 0); s0 = __builtin_amdgcn_mfma_f32_16x16x32_bf16(kv.ka1, qf[1], s0, 0, 0, 0);
        s1 = __builtin_amdgcn_mfma_f32_16x16x32_bf16(kv.kb0, qf[0], s1, 0, 0, 0); s1 = __builtin_amdgcn_mfma_f32_16x16x32_bf16(kv.kb1, qf[1], s1, 0, 0, 0);
        float s[8] = {s0.x, s0.y, s0.z, s0.w, s1.x, s1.y, s1.z, s1.w};
        const int hi2 = lim - (kb + 8 * c);
#pragma unroll
        for (int e = 0; e < 8; ++e) s[e] = (e <= hi2) ? __builtin_amdgcn_exp2f(s[e] - muse) * inv : 0.f;
        *(f32x4*)(pn + col * 32 + 8 * c) = (f32x4){s[0], s[1], s[2], s[3]}; *(f32x4*)(pn + col * 32 + 8 * c + 4) = (f32x4){s[4], s[5], s[6], s[7]};
        u32x4 pw; pw.x = cvtpk(s[0], s[1]); pw.y = cvtpk(s[2], s[3]); pw.z = cvtpk(s[4], s[5]); pw.w = cvtpk(s[6], s[7]); const bf16x8 pf = __builtin_bit_cast(bf16x8, pw);
        oc[0] = __builtin_amdgcn_mfma_f32_16x16x32_bf16(kv.v0, pf, oc[0], 0, 0, 0); oc[1] = __builtin_amdgcn_mfma_f32_16x16x32_bf16(kv.v1, pf, oc[1], 0, 0, 0);
        oc[2] = __builtin_amdgcn_mfma_f32_16x16x32_bf16(kv.v2, pf, oc[2], 0, 0, 0); oc[3] = __builtin_amdgcn_mfma_f32_16x16x32_bf16(kv.v3, pf, oc[3], 0, 0, 0);
        asm volatile("s_waitcnt lgkmcnt(0)" ::: "memory");
        { const int q2 = lane >> 5, k = lane & 31; float a = 0.f;
#pragma unroll
          for (int h6 = 0; h6 < 6; ++h6) a += pn[(q2 * 6 + h6) * 32 + k];
          imp[q2 * 512 + kb + k] = a; }
        asm volatile("s_waitcnt lgkmcnt(0)" ::: "memory"); });
#ifdef NSA_DEBUG
      if (vcol) { for (int db = 0; db < 4; ++db) *(f32x4*)(P.DBG + ((size_t)0 * MP + row) * 768 + head * 64 + 16 * db + 4 * c) = oc[db]; }
#endif
      const float g0 = vcol ? gt[0] : 0.f;
#pragma unroll
      for (int db = 0; db < 4; ++db) oacc[db] += oc[db] * g0; }
#ifndef REP_SEL
#define REP_SEL 1
#endif
#pragma unroll 1
    for (int rep = 0; rep < REP_SEL; ++rep) {
    for (int i = lane; i < 256; i += 64) { const int q2 = i >> 7, b = i & 127, tq2 = t + q2, cur = tq2 / SLC_BLOCK; float sv;
        if (b > cur) sv = NEG; else if (b == 0 || b == cur || b == cur - 1) sv = FORCE_SCORE;
        else { const LAS float* ic = imp + q2 * 512 + 4 * b; sv = ic[-1] + 2.f * (ic[0] + ic[1] + ic[2]) + ic[3]; }
        sc[i] = pack_key(sv, 127u - (unsigned)b, 127u); }
    asm volatile("s_waitcnt lgkmcnt(0)" ::: "memory");
    for (int i = lane; i < 256; i += 64) { const int q2 = i >> 7, b = i & 127; const float sv = sc[i]; int rank = 0;
        for (int j = 0; j < 128; j += 4) { const f32x4 o = *(const LAS f32x4*)(sc + q2 * 128 + j);
            rank += (o.x > sv) ? 1 : 0; rank += (o.y > sv) ? 1 : 0; rank += (o.z > sv) ? 1 : 0; rank += (o.w > sv) ? 1 : 0; }
        if (rank < SLC_TOPK) { const int v = (sv > 0.5f * NEG) ? b : -1; sel[q2 * 16 + rank] = v; P.SELB[((size_t)(n * SEQ + t + q2) * NSA_KV_HEADS + kvh) * 16 + rank] = v; } }
    asm volatile("s_waitcnt lgkmcnt(0)" ::: "memory");
    }
#ifndef REP_WIN
#define REP_WIN 1
#endif
#pragma unroll 1
    for (int rep = 0; rep < REP_WIN; ++rep) { Tile16 T; tile_init(T);
      const bf16* WKb = P.WNK + ((size_t)n * NSA_KV_HEADS + kvh) * SEQ * 64; const bf16* WVb = P.WNVT + ((size_t)n * NSA_KV_HEADS + kvh) * 64 * SEQ;
      const int blo = (t - SWA_WINDOW) >> 5, bhi = (t + 1) >> 5;
      auto ld = [&](KV8& kv, int blk) { const int bc = blk < 0 ? 0 : blk; kv_load_t(kv, WKb + (size_t)bc * 2048, WVb + (size_t)bc * 2048, lane); };
      pipe2(bhi - blo + 1, [&](KV8& kv, int i) { ld(kv, blo + i); }, [&](const KV8& kv, int i) { const int kb = 32 * (blo + i);
          const int k0 = kb + 8 * c; int lo; unsigned rng; const int a = tq - SWA_WINDOW; mk_range((a > 0 ? a : 0) - k0, tq - k0, vcol, lo, rng); tile_compute(T, qf, kv, lo, rng); });
      T.l = colsum(T.l);
      const float inv = (T.l > 0.f) ? 1.0f / T.l : 0.f, g2 = vcol ? gt[2] * inv : 0.f;
#ifdef NSA_DEBUG
      if (vcol) { for (int db = 0; db < 4; ++db) *(f32x4*)(P.DBG + ((size_t)2 * MP + row) * 768 + head * 64 + 16 * db + 4 * c) = T.o[db] * inv; }
#endif
#pragma unroll
      for (int db = 0; db < 4; ++db) if (rep == REP_WIN - 1) oacc[db] += T.o[db] * g2; }
    if (vcol) { float* op = P.DPART + (size_t)row * 768 + head * 64 + 4 * c;
#pragma unroll
        for (int db = 0; db < 4; ++db) *(f32x4*)(op + 16 * db) = oacc[db]; }
}
DI void nsa_pair_b(const FP& P, int n, int kvh, int t, int lane, LAS unsigned char* wl) {
    LAS int* steps = (LAS int*)wl;
    const int col = lane & 15, c = lane >> 4; const bool vcol = col < 12; const int qq = vcol ? col / 6 : 0, hh = vcol ? col % 6 : 0, tq = t + qq, head = kvh * NSA_GROUP + hh, row = n * SEQ + tq;
    bf16x8 qf[2]; { const bf16* qp = P.QB + (size_t)row * NSA_Q_COLS + head * 64 + 8 * c; qf[0] = *(const bf16x8*)qp; qf[1] = *(const bf16x8*)(qp + 32); }
    const float* gt = P.GATES + (size_t)row * 64 + head * 3;
    Tile16 T; tile_init(T);
    const bf16* SKb = P.SLK + ((size_t)n * NSA_KV_HEADS + kvh) * SEQ * 64; const bf16* SVb = P.SLVT + ((size_t)n * NSA_KV_HEADS + kvh) * SEQ * 64;
    int ns = 0;
    { const int mysel = (lane < 32) ? P.SELB[((size_t)(n * SEQ + t + (lane >> 4)) * NSA_KV_HEADS + kvh) * 16 + (lane & 15)] : -1;
      for (int i = 0; i < 32; ++i) { const int b = __builtin_amdgcn_readlane(mysel, i); if (b < 0) continue; int q2 = i >> 4;
          const unsigned long long other = __ballot(mysel == b && lane < 32 && (lane >> 4) != q2);
          if (other) { if (q2 == 1) continue; q2 = 2; }
          if (lane == 0) { steps[ns] = (b * SLC_BLOCK) | (q2 << 29); steps[ns + 1] = (b * SLC_BLOCK + 32) | (q2 << 29); } ns += 2; } }
    asm volatile("s_waitcnt lgkmcnt(0)" ::: "memory");
    auto ld = [&](KV8& kv, int i) { const int code = __builtin_amdgcn_readfirstlane(steps[i]); const int kb = code & 0x1fffffff;
        kv_load_t(kv, SKb + (size_t)(kb >> 5) * 2048, SVb + (size_t)(kb >> 5) * 2048, lane); };
#ifdef PROBE_DBLCOMP
    Tile16 T2; tile_init(T2);
#endif
    pipe2(ns, ld, [&](const KV8& kv, int i) { const int code = __builtin_amdgcn_readfirstlane(steps[i]); const int kb = code & 0x1fffffff, q2 = code >> 29;
        int lo; unsigned rng; mk_range(-64, tq - (kb + 8 * c), vcol && (q2 == 2 || qq == q2), lo, rng); tile_compute(T, qf, kv, lo, rng);
#ifdef PROBE_DBLCOMP
        tile_compute(T2, qf, kv, [&](int e) { return vcol && qq == q2 && (kb + 8 * c + e + 1) <= tq; });
#endif
    });
#ifdef PROBE_DBLCOMP
    if (T2.l < 0.f) T.l = 0.f;
#endif
    T.l = colsum(T.l);
    const float inv = (T.l > 0.f) ? 1.0f / T.l : 0.f, g1 = vcol ? gt[1] * inv : 0.f;
#ifdef NSA_DEBUG
    if (vcol) { for (int db = 0; db < 4; ++db) *(f32x4*)(P.DBG + ((size_t)1 * MP + row) * 768 + head * 64 + 16 * db + 4 * c) = T.o[db] * inv; }
#endif
    if (vcol) { const float* pp = P.DPART + (size_t)row * 768 + head * 64 + 4 * c; bf16* op = P.ATTB + (size_t)row * 1024 + head * 64 + 4 * c;
#pragma unroll
        for (int db = 0; db < 4; ++db) *(u32x2*)(op + 16 * db) = pk4(*(const f32x4*)(pp + 16 * db) + T.o[db] * g1); }
}

constexpr int SMP_SK = 1088;
template <class KF, class VF> DI void smp_branch(const Ctx& C, LAS float* qs, LAS float* S, LAS float* red, int NK, KF kf, VF vf, bool keep_probs, float (&outh)[1]) {
    const int tid = C.tid, lane = C.lane, w = C.wave;
#pragma unroll 1
    for (int j = tid; j < NK; j += NTHREADS) { const float* k = kf(j); f32x4 kr[16];
#pragma unroll
        for (int d4 = 0; d4 < 16; ++d4) kr[d4] = *(const f32x4*)(k + 4 * d4);
#pragma unroll 1
        for (int h = 0; h < 6; ++h) { float a = 0.f;
#pragma unroll
            for (int d4 = 0; d4 < 16; ++d4) { const f32x4 qv = *(const LAS f32x4*)(qs + h * 64 + 4 * d4); a += kr[d4].x * qv.x + kr[d4].y * qv.y + kr[d4].z * qv.z + kr[d4].w * qv.w; }
            S[h * SMP_SK + j] = a; } }
    asm volatile("s_waitcnt lgkmcnt(0)" ::: "memory"); __syncthreads();
    if (w < 6) { float m = -INFINITY; for (int j = lane; j < NK; j += 64) m = fmaxf(m, S[w * SMP_SK + j]); m = wave_max(m);
        float l = 0.f; for (int j = lane; j < NK; j += 64) { const float p = __builtin_amdgcn_exp2f(S[w * SMP_SK + j] - m); S[w * SMP_SK + j] = p; l += p; } l = wave_sum(l);
        const float inv = 1.0f / l; for (int j = lane; j < NK; j += 64) S[w * SMP_SK + j] *= inv; }
    asm volatile("s_waitcnt lgkmcnt(0)" ::: "memory"); __syncthreads();
    { const int per = (NK + NWAVES - 1) / NWAVES, j0 = w * per, j1 = (j0 + per < NK) ? j0 + per : NK; float o[6] = {0.f, 0.f, 0.f, 0.f, 0.f, 0.f};
#pragma unroll 1
      for (int j = j0; j < j1; j += 8) { float vv[8];
#pragma unroll
          for (int u = 0; u < 8; ++u) { const int jj = (j + u < j1) ? j + u : j1 - 1; vv[u] = vf(jj)[lane]; }
#pragma unroll
          for (int u = 0; u < 8; ++u) if (j + u < j1) {
#pragma unroll
              for (int h = 0; h < 6; ++h) o[h] += S[h * SMP_SK + j + u] * vv[u]; } }
#pragma unroll
      for (int h = 0; h < 6; ++h) red[(w * 6 + h) * 64 + lane] = o[h]; }
    asm volatile("s_waitcnt lgkmcnt(0)" ::: "memory"); __syncthreads();
    outh[0] = 0.f;
    if (tid < 384) { float a = 0.f;
#pragma unroll
        for (int ww = 0; ww < NWAVES; ++ww) a += red[ww * 384 + tid]; outh[0] = a; }
    if (!keep_probs) { __syncthreads(); }
}
DI void nsa_sample_item(const FP& P, const Ctx& C, int ns, int kvh) {
    LAS float* qs = (LAS float*)C.lds; LAS float* S = qs + 384; LAS float* red = S + 6 * SMP_SK; LAS float* scs = red + 8 * 384; LAS int* sel = (LAS int*)(scs + 136);
    const int tid = C.tid, row = M0 + ns;
    if (tid < 384) qs[tid] = bf2f(P.QB[(size_t)row * NSA_Q_COLS + kvh * 384 + tid]);
    asm volatile("s_waitcnt lgkmcnt(0)" ::: "memory"); __syncthreads();
    const float* ckf = P.CKF + ((size_t)ns * NSA_KV_HEADS + kvh) * NCH * 64; const float* cvf = P.CVF + ((size_t)ns * NSA_KV_HEADS + kvh) * NCH * 64;
    float oc[1], os[1], ow[1];
    smp_branch(C, qs, S, red, NCMP, [&](int j) { return ckf + (size_t)j * 64; }, [&](int j) { return cvf + (size_t)j * 64; }, true, oc);
    constexpr int NBS = (PAST_LEN + 1 + SLC_BLOCK - 1) / SLC_BLOCK, CURS = PAST_LEN / SLC_BLOCK;
    for (int b = tid; b < 136; b += NTHREADS) { float sv = -3.0e38f;
        if (b < NBS) { if (b == 0 || b == CURS || b == CURS - 1) sv = FORCE_SCORE; else { float a = 0.f;
#pragma unroll
                for (int o = -1; o <= 3; ++o) { const int ci = 4 * b + o; if (ci >= 0 && ci < NCMP) { float sm = 0.f; for (int h6 = 0; h6 < 6; ++h6) sm += S[h6 * SMP_SK + ci]; a += ((o >= 0 && o <= 2) ? 2.f : 1.f) * sm; } }
                sv = a; } }
        scs[b] = sv; }
    asm volatile("s_waitcnt lgkmcnt(0)" ::: "memory"); __syncthreads();
    for (int b = tid; b < NBS; b += NTHREADS) { const float sv = scs[b]; int rank = 0; for (int j = 0; j < NBS; ++j) { const float o = scs[j]; rank += (o > sv || (o == sv && j < b)) ? 1 : 0; }
        if (rank < SLC_TOPK) { sel[rank] = b; P.SELB[((size_t)row * NSA_KV_HEADS + kvh) * 16 + rank] = b; } }
    asm volatile("s_waitcnt lgkmcnt(0)" ::: "memory"); __syncthreads();
    { const float* newrow = P.nsa_kv_s + (size_t)ns * 512; const int* pt = P.page_table + ns * (PAST_LEN / PAGE_SIZE);
      if (tid == 0) { int seen = 0; for (int x = 0; x < SLC_TOPK; ++x) { const int bx = sel[x]; if (bx != CURS && seen < 15) sel[16 + seen++] = bx; } }
      asm volatile("s_waitcnt lgkmcnt(0)" ::: "memory"); __syncthreads();
      auto krow = [&](int j, int ty) -> const float* { if (j >= 15 * 64) return newrow + ty * 128 + kvh * 64;
          const int t0 = sel[16 + (j >> 6)] * SLC_BLOCK + (j & 63); const int pg = pt[t0 / PAGE_SIZE]; return P.cache_nsa_kv + ((size_t)pg * PAGE_SIZE + t0 % PAGE_SIZE) * 512 + ty * 128 + kvh * 64; };
      smp_branch(C, qs, S, red, 15 * 64 + 1, [&](int j) { return krow(j, 2); }, [&](int j) { return krow(j, 3); }, false, os); }
    { const float* wc = P.cache_nsa_win + (size_t)ns * SWA_WINDOW * 256; const float* newrow = P.win_s + ((size_t)ns * SWA_WINDOW + SWA_WINDOW - 1) * 256;
      smp_branch(C, qs, S, red, SWA_WINDOW + 1, [&](int j) { return (j < SWA_WINDOW ? wc + (size_t)j * 256 : newrow) + kvh * 64; }, [&](int j) { return (j < SWA_WINDOW ? wc + (size_t)j * 256 : newrow) + 128 + kvh * 64; }, false, ow); }
    if (tid < 384) { const int head = kvh * NSA_GROUP + tid / 64; const float* gt = P.GATES + (size_t)row * 64 + head * 3;
        P.ATTB[(size_t)row * 1024 + kvh * 384 + tid] = (bf16)f2bf(gt[0] * oc[0] + gt[1] * os[0] + gt[2] * ow[0]);
#ifdef NSA_DEBUG
        P.DBG[((size_t)0 * MP + row) * 768 + kvh * 384 + tid] = oc[0]; P.DBG[((size_t)1 * MP + row) * 768 + kvh * 384 + tid] = os[0]; P.DBG[((size_t)2 * MP + row) * 768 + kvh * 384 + tid] = ow[0];
#endif
    }
    __syncthreads();
}
DI void nsa_pairs(const FP& P, const Ctx& C, bool second) {
    LAS unsigned char* wl = C.lds + C.wave * NSA_WLDS;
    const int per = C.G / 4 > 0 ? C.G / 4 : 1, grp = (C.vcu / per) & 3, sub = C.vcu % per, n = grp >> 1, kvh = grp & 1;
#pragma unroll 1
    for (int pr = sub * NWAVES + C.wave; pr < SEQ / 2; pr += per * NWAVES) { if (second) nsa_pair_b(P, n, kvh, 2 * pr, C.lane, wl); else nsa_pair_a(P, n, kvh, 2 * pr, C.lane, wl); }
}
DI void nsa_phase_a(const FP& P, const Ctx& C) {
    for (int it = C.vcu; it < DEC_BATCH * NSA_KV_HEADS; it += C.G) nsa_sample_item(P, C, it / NSA_KV_HEADS, it % NSA_KV_HEADS);
    nsa_pairs(P, C, false);
    __syncthreads();
}
DI void nsa_phase_b(const FP& P, const Ctx& C) {
    const int lane = C.lane, w = C.wave;
    nsa_pairs(P, C, true);
    __syncthreads();
    { constexpr int NMT = (M0 / 16) * MEM_HEADS;
      for (int it = C.vcu * NWAVES + w; it < NMT; it += C.G * NWAVES) { const int h = it % MEM_HEADS, q16 = it / MEM_HEADS, row0 = q16 * 16, n = row0 / SEQ;
          mem_micro(P, P.MQB + h * 64, 256, row0, 1, n, h, P.ATTB + NSA_Q_COLS + h * 64, 1024, lane); }
    }
    { LAS float* qs = (LAS float*)C.lds;
      for (int it = C.vcu; it < DEC_BATCH * MEM_HEADS; it += C.G) { const int h = it % MEM_HEADS, ns = it / MEM_HEADS, row = M0 + ns;
          __syncthreads(); if (C.tid < 64) qs[C.tid] = bf2f(P.MQB[(size_t)row * 256 + h * 64 + C.tid]); asm volatile("s_waitcnt lgkmcnt(0)" ::: "memory"); __syncthreads();
          Dec D; D.m = -INFINITY; D.l = 0.f; D.o = 0.f; const float* mk = P.cache_mem_kv + ((size_t)1 * DEC_BATCH + ns) * MEM_TOKENS * 512;
          for (int ck = w; ck < MEM_TOKENS / 64; ck += NWAVES) { const int j0 = ck * 64; dec_chunk(D, qs, 64, [&](int j) { return mk + (size_t)(j0 + j) * 512 + h * 64; }, [&](int j) { return mk + (size_t)(j0 + j) * 512 + 256 + h * 64; }, lane); }
          const float o = dec_combine(C, D);
          if (w == 0) P.ATTB[(size_t)row * 1024 + NSA_Q_COLS + h * 64 + lane] = (bf16)f2bf(o); } }
    __syncthreads();
}
}
namespace fx {
enum { PH_PRO = 0, PH_G1, PH_ATTA, PH_G2, PH_LN1, PH_SC0, PH_TK0, PH_PU0, PH_PG0, PH_G3, PH_CMPG, PH_CMP2, PH_NSA, PH_NSB, PH_G4, PH_LN3, PH_SC1, PH_TK1, PH_PU1, PH_PG1, PH_COUNT };
template <class Epi> DI void run_gemm(const Ctx& C, const bf16* A, const bf16* Bt, int M, int N, int K, const Epi& E) {
    pg8::Gemm g{A, Bt, M, N, K}; pg8::StaticOrder S; S.init(M, N, C.G, (int)blockIdx.x);
    pg8::gemm_phase<Epi, pg8::StaticOrder, true, true>(C.lds, g, S, E);
}
template <class Epi> DI void skinny_gemm(const Ctx& C, const bf16* A, const bf16* Bt, int N, int K, const Epi& E) {
    static_assert(DEC_BATCH == 32 && M0 % 256 == 0, "skinny_gemm: 32 sample rows right after a whole number of 256-row tiles");
    const int lane = C.lane, fr = lane & 15, fq = lane >> 4, w = C.wave; const int NI = (N / 256) * 4, KW = K / NWAVES;
    LAS f32x4* red = (LAS f32x4*)C.lds;
#pragma unroll 1
    for (int item = C.vcu; item < NI; item += C.G) { const int pn = item >> 2, wc = item & 3;
        f32x4 pa[2][2][2];
#pragma unroll
        for (int i = 0; i < 8; ++i) (&pa[0][0][0])[i] = (f32x4){0.f, 0.f, 0.f, 0.f};
        const bf16* xa = A + (size_t)(M0 + fr) * K + w * KW + 8 * fq; const bf16* xb = xa + (size_t)16 * K;
        const bf16* wp[2][2];
#pragma unroll
        for (int bj = 0; bj < 2; ++bj)
#pragma unroll
            for (int n = 0; n < 2; ++n) wp[bj][n] = Bt + (size_t)(pn * 256 + bj * 128 + wc * 32 + 8 * (fr >> 2) + 4 * n + (fr & 3)) * K + w * KW + 8 * fq;
#pragma unroll 4
        for (int k0 = 0; k0 < KW; k0 += 32) { const bf16x8 x0 = *(const bf16x8*)(xa + k0), x1 = *(const bf16x8*)(xb + k0);
#pragma unroll
            for (int bj = 0; bj < 2; ++bj)
#pragma unroll
                for (int n = 0; n < 2; ++n) { const bf16x8 wf = *(const bf16x8*)(wp[bj][n] + k0);
                    pa[bj][0][n] = __builtin_amdgcn_mfma_f32_16x16x32_bf16(wf, x0, pa[bj][0][n], 0, 0, 0); pa[bj][1][n] = __builtin_amdgcn_mfma_f32_16x16x32_bf16(wf, x1, pa[bj][1][n], 0, 0, 0); } }
        __syncthreads();
#pragma unroll
        for (int bj = 0; bj < 2; ++bj)
#pragma unroll
            for (int mm = 0; mm < 2; ++mm)
#pragma unroll
                for (int n = 0; n < 2; ++n) red[(w * 8 + bj * 4 + mm * 2 + n) * 64 + lane] = pa[bj][mm][n];
        asm volatile("s_waitcnt lgkmcnt(0)" ::: "memory"); __syncthreads();
        if (w == 0) { f32x4 acc[2][2][4][2];
#pragma unroll
            for (int i = 0; i < 32; ++i) (&acc[0][0][0][0])[i] = (f32x4){0.f, 0.f, 0.f, 0.f};
#pragma unroll
            for (int bj = 0; bj < 2; ++bj)
#pragma unroll
                for (int mm = 0; mm < 2; ++mm)
#pragma unroll
                    for (int n = 0; n < 2; ++n) { f32x4 s = red[(bj * 4 + mm * 2 + n) * 64 + lane];
#pragma unroll 1
                        for (int ww = 1; ww < NWAVES; ++ww) s += red[(ww * 8 + bj * 4 + mm * 2 + n) * 64 + lane];
                        acc[0][bj][mm][n] = s; }
            E(acc, pg8::Unit{M0 / 256, pn}, 0, wc, fr, fq); }
    }
    __syncthreads();
}
__global__ void __launch_bounds__(NTHREADS, 2) mega(Args args) {
    extern __shared__ __attribute__((aligned(16))) unsigned char lds_raw[];
    Ctx C; C.lds = (LAS unsigned char*)lds_raw; C.tid = threadIdx.x; C.lane = C.tid & 63; C.wave = __builtin_amdgcn_readfirstlane(C.tid >> 6);
    C.G = gridDim.x; { const int bx = blockIdx.x; C.vcu = (C.G % 8 == 0) ? (bx % 8) * (C.G / 8) + bx / 8 : bx; }
    const FP& P = args.p;
    volatile LAS unsigned* MISC = (volatile LAS unsigned*)(C.lds + MISC_OFF);
    for (int u = C.tid; u < (LDS_BYTES - RING_BYTES) / 4; u += NTHREADS) ((LAS unsigned*)(C.lds + RING_BYTES))[u] = 0u;
    __syncthreads();
    const int lo = args.lo, hi = args.hi;
    XcdBarrier bar; bar.bar = P.ctl + 1024; bar.x = 0; bar.st = nullptr;
    if (hi - lo > 1) bar = xcd_barrier_post(P.ctl + 1024, MISC + 8);
#define IN(k) (lo <= (k) && (k) < hi)
#define SEAM(k) do { if (IN(k) && IN((k) + 1)) xcd_barrier(bar); } while (0)
#ifndef DUP_PHASE
#define DUP_PHASE -1
#endif
#define PHASE(k, ...) do { if (IN(k)) { __VA_ARGS__ if (DUP_PHASE == (k)) { __syncthreads(); __VA_ARGS__ } } SEAM(k); } while (0)
    PHASE(PH_PRO, p0_prologue(P, C); __syncthreads(); p0_wpk(P, C););
    PHASE(PH_G1, run_gemm(C, P.XB0, P.WA_T, M0, ACOLS, D_MODEL, EpiA{P}); run_gemm(C, P.MEMB, P.WMEM_T, BATCH * MEM_TOKENS, 1024, D_MODEL, EpiMem{P}); skinny_gemm(C, P.XB0, P.WA_T, ACOLS, D_MODEL, EpiA{P}););
#ifdef PEER_SHARD3
#define PEER_SHARDED_FN peer_sharded3_phase
#else
#define PEER_SHARDED_FN peer_sharded2_phase
#endif
    PHASE(PH_ATTA, atta_phase(P, C););
    PHASE(PH_G2, run_gemm(C, P.ATTA, P.WOA_T, M0, D_MODEL, 512, EpiPre{P.x_prompt, P.x_sample, P.PRE}); skinny_gemm(C, P.ATTA, P.WOA_T, D_MODEL, 512, EpiPre{P.x_prompt, P.x_sample, P.PRE}););
    PHASE(PH_LN1, ln_phase(P, C, P.PRE, P.ln_g, P.ln_b, P.X1, P.X1B, nullptr, nullptr););
    PHASE(PH_SC0, run_gemm(C, P.X1B, P.WPK_T, M0, NPK, D_MODEL, EpiF32{P.SCO, NPK, MP}); skinny_gemm(C, P.X1B, P.WPK_T, NPK, D_MODEL, EpiF32{P.SCO, NPK, MP}););
    PHASE(PH_TK0, topk_phase(P, C););
#ifdef PEER_SPLIT
    PHASE(PH_PU0, peer_u_phase(P, C, 0, P.X1B););
    PHASE(PH_PG0, peer_v_phase(P, C, 0, P.X1, P.X2, P.X2 + (size_t)M0 * D_MODEL, P.X2B););
#elif defined(PEER_SHARD2)
    PHASE(PH_PG0, const bool shd = (M0 % (C.G * NWAVES * PS2_ROWS)) == 0; if (shd) { PEER_SHARDED_FN(P, C, 0, P.X1, P.X1B, P.X2, P.X2B); __syncthreads(); } peer_phase(P, C, 0, P.X1, P.X2, P.X2 + (size_t)M0 * D_MODEL, P.X2B, shd););
#elif defined(PEER_SHARD)
    PHASE(PH_PG0, peer_sharded_phase(P, C, 0, P.X1, P.X1B, P.X2, P.X2 + (size_t)M0 * D_MODEL, P.X2B); __syncthreads(); peer_phase(P, C, 0, P.X1, P.X2, P.X2 + (size_t)M0 * D_MODEL, P.X2B););
#else
    PHASE(PH_PG0, peer_phase(P, C, 0, P.X1, P.X2, P.X2 + (size_t)M0 * D_MODEL, P.X2B););
#endif
    PHASE(PH_G3, run_gemm(C, P.X2B, P.WB_T, M0, NB_T, D_MODEL, EpiB{P}); skinny_gemm(C, P.X2B, P.WB_T, NB_T, D_MODEL, EpiB{P}););
    PHASE(PH_CMPG, run_gemm(C, P.AC, P.CW1_T, ACROWS, 256, 1024, EpiF32{P.UL, 256, ACROWS}); run_gemm(C, P.AC + (size_t)ACROWS * 1024, P.CW1_T + 256 * 1024, ACROWS, 256, 1024, EpiF32{P.UL + (size_t)ACROWS * 256, 256, ACROWS}););
    PHASE(PH_CMP2, cmp2_phase(P, C););
    PHASE(PH_NSA, nsa_phase_a(P, C););
    PHASE(PH_NSB, nsa_phase_b(P, C););
    PHASE(PH_G4, run_gemm(C, P.ATTB, P.WOB_T, M0, D_MODEL, 1024, EpiPre{P.X2, nullptr, P.PRE}); skinny_gemm(C, P.ATTB, P.WOB_T, D_MODEL, 1024, EpiPre{P.X2, nullptr, P.PRE}););
    PHASE(PH_LN3, ln_phase(P, C, P.PRE, P.ln_g + 2 * D_MODEL, P.ln_b + 2 * D_MODEL, P.X3, P.X3B, nullptr, nullptr););
    PHASE(PH_SC1, run_gemm(C, P.X3B, P.WPK_T + (size_t)NPK * D_MODEL, M0, NPK, D_MODEL, EpiF32{P.SCO, NPK, MP}); skinny_gemm(C, P.X3B, P.WPK_T + (size_t)NPK * D_MODEL, NPK, D_MODEL, EpiF32{P.SCO, NPK, MP}););
    PHASE(PH_TK1, topk_phase(P, C););
#ifdef PEER_SPLIT
    PHASE(PH_PU1, peer_u_phase(P, C, 1, P.X3B););
    PHASE(PH_PG1, peer_v_phase(P, C, 1, P.X3, P.y_prompt, P.y_sample, nullptr););
#elif defined(PEER_SHARD2)
    PHASE(PH_PG1, const bool shd = (M0 % (C.G * NWAVES * PS2_ROWS)) == 0; if (shd) { PEER_SHARDED_FN(P, C, 1, P.X3, P.X3B, P.y_prompt, nullptr); __syncthreads(); } peer_phase(P, C, 1, P.X3, P.y_prompt, P.y_sample, nullptr, shd););
#elif defined(PEER_SHARD)
    PHASE(PH_PG1, peer_sharded_phase(P, C, 1, P.X3, P.X3B, P.y_prompt, P.y_sample, nullptr); __syncthreads(); peer_phase(P, C, 1, P.X3, P.y_prompt, P.y_sample, nullptr););
#else
    PHASE(PH_PG1, peer_phase(P, C, 1, P.X3, P.y_prompt, P.y_sample, nullptr););
#endif
#undef IN
#undef SEAM
}
}
#ifndef ONE_LAUNCH
#define ONE_LAUNCH 1
#endif
extern "C" void kernel_launch(void* const* d_in, const int* in_sizes, int n_in, void* d_out, int out_size, void* d_ws, size_t ws_size, hipStream_t stream) {
    fx::Args a; memset(&a, 0, sizeof(a)); fx::bind_io(a.p, d_in, (float*)d_out);
    const size_t f_need = fx::carve(a.p, d_ws);
    if (f_need > ws_size) { fprintf(stderr, "kernel_launch: workspace too small: need %zu have %zu\n", f_need, ws_size); return; }
    static int grid = 0;
    if (!grid) { int dev = 0, cus = 0, per_cu = 0; (void)hipGetDevice(&dev); (void)hipDeviceGetAttribute(&cus, hipDeviceAttributeMultiprocessorCount, dev);
        (void)hipFuncSetAttribute((const void*)fx::mega, hipFuncAttributeMaxDynamicSharedMemorySize, fx::LDS_BYTES);
        if (hipOccupancyMaxActiveBlocksPerMultiprocessor(&per_cu, (const void*)fx::mega, fx::NTHREADS, fx::LDS_BYTES) != hipSuccess || per_cu < 1) { fprintf(stderr, "kernel_launch: occupancy query says %d blocks per CU\n", per_cu); (void)hipGetLastError(); }
        grid = cus; }
    (void)hipMemsetAsync(a.p.ctl, 0, fx::CTL_BYTES, stream);
#if ONE_LAUNCH
    a.lo = 0; a.hi = fx::PH_COUNT; hipLaunchKernelGGL(fx::mega, dim3(grid), dim3(fx::NTHREADS), fx::LDS_BYTES, stream, a);
#else
    for (int k = 0; k < fx::PH_COUNT; ++k) { a.lo = k; a.hi = k + 1; hipLaunchKernelGGL(fx::mega, dim3(grid), dim3(fx::NTHREADS), fx::LDS_BYTES, stream, a); }
#endif
}
```

```cpp
#define PEER_SHARD2 1
#define ONE_LAUNCH 1
#include <hip/hip_runtime.h>
#include <cstdio>
#include <cstring>
#include <cmath>
#ifdef CPU_TEST
#define HD inline
constexpr int D_MODEL = 128, BATCH = 2, SEQ = 512, DEPTH = 2, DEC_BATCH = 3, DEC_SEQ = 1, PAST_LEN = 512, PAGE_SIZE = 128;
constexpr int DIL_W[3] = {16, 64, 256}, DIL_D[3] = {1, 4, 16}, DIL_TAPS = 17;
constexpr int MEM_TOKENS = 32, SLC_TOPK = 4, SWA_WINDOW = 64, PEER_KEYS = 16, PEER_TOPK = 4;
#else
#define HD __host__ __device__ __forceinline__
constexpr int D_MODEL = 1024, BATCH = 2, SEQ = 8192, DEPTH = 2, DEC_BATCH = 32, DEC_SEQ = 1, PAST_LEN = 8192, PAGE_SIZE = 128;
constexpr int DIL_W[3] = {128, 512, 2048}, DIL_D[3] = {1, 4, 16}, DIL_TAPS = 129;
constexpr int MEM_TOKENS = 256, SLC_TOPK = 16, SWA_WINDOW = 512, PEER_KEYS = 128, PEER_TOPK = 16;
#endif
HD constexpr int dil_w(int g) { return g == 0 ? DIL_W[0] : (g == 1 ? DIL_W[1] : DIL_W[2]); }
HD constexpr int dil_d(int g) { return g == 0 ? DIL_D[0] : (g == 1 ? DIL_D[1] : DIL_D[2]); }
constexpr int HEAD_DIM = 64, N_A_LAYERS = DEPTH / 2, N_DIL = 3, DIL_HEADS = 4, DIL_COLS = N_DIL * 3 * DIL_HEADS * HEAD_DIM;
constexpr int MEM_HEADS = 4, MEM_COLS = MEM_HEADS * HEAD_DIM;
constexpr int NSA_HEADS = 12, NSA_KV_HEADS = 2, NSA_GROUP = 6, NSA_Q_COLS = NSA_HEADS * HEAD_DIM, NSA_GATE_COLS = NSA_HEADS * 3;
constexpr int CMP_BLOCK = 32, CMP_STRIDE = 16, CMP_HIDDEN = 128, SLC_BLOCK = 64;
constexpr int PEER_EXPERTS = PEER_KEYS * PEER_KEYS, PEER_HEADS = 8, PEER_KEY_DIM = 128;
constexpr float FORCE_SCORE = 1.0e9f, NEG = -1.0e30f, SCALE = 0.125f, LN_EPS = 1e-5f;
constexpr float ALPHA = 1.41421356237309515f;
constexpr float BETA = 0.5f;
#define LAS __attribute__((address_space(3)))
namespace pg8 {
#define PG8_LAS __attribute__((address_space(3)))
typedef unsigned short bf16_t;
typedef short bf16x8 __attribute__((ext_vector_type(8)));
typedef float f32x4 __attribute__((ext_vector_type(4)));
typedef unsigned u32x4 __attribute__((ext_vector_type(4)));
constexpr int BM = 256, BK = 64, HALF = 128, HTB = HALF * BK * 2  , STAGE_BYTES = 8 * HTB, NXCD = 8, WGM = 8;

__host__ __device__ __forceinline__ int lds_byte(int r, int c) { const int st = (r >> 4) * 2 + (c >> 5), rr = r & 15, cc = c & 31, ob = rr * 64 + cc * 2; return st * 1024 + (ob ^ (((ob >> 9) & 1) << 5)); }
__host__ __device__ __forceinline__ void stage_rc(int b, int& R, int& C) { const int st = b / 1024, sb = b % 1024, swz = sb ^ (((sb >> 9) & 1) << 5); R = (st >> 1) * 16 + swz / 64; C = (st & 1) * 32 + (swz % 64) / 2; }
__host__ __device__ __forceinline__ int perm32(int rho) { const int n = rho >> 4, i = rho & 15; return 8 * (i >> 2) + 4 * n + (i & 3); }

struct Unit { int pm, pn; };
struct Gemm { const bf16_t* A; const bf16_t* Bt; int M, N, K; };

struct StaticOrder {
    int nM, nN, nwg, G, c;
    __host__ __device__ void init(int M, int N, int G_, int c_) { nM = M / BM; nN = N / BM; nwg = nM * nN; G = G_; c = c_; }
    __host__ __device__ bool next(int i, Unit& u) const {
        const long L = (long)i * G + c; if (L >= nwg) return false;
        int wgid = (int)L; { const int q = nwg / NXCD, r = nwg % NXCD, xcd = wgid % NXCD, off = wgid / NXCD; wgid = (xcd < r ? xcd * (q + 1) : r * (q + 1) + (xcd - r) * q) + off; }
        const int nig = WGM * nN, gid = wgid / nig, fm = gid * WGM, gsz = (nM - fm) < WGM ? (nM - fm) : WGM;
        u.pm = fm + ((wgid % nig) % gsz); u.pn = (wgid % nig) / gsz; return true;
    }
    __device__ __forceinline__ void a_ready(const Unit&) const {}
    __device__ __forceinline__ void done(const Unit&) const {}
};

__device__ __forceinline__ unsigned cvt_pk_bf16(float lo, float hi) { unsigned r; asm volatile("v_cvt_pk_bf16_f32 %0, %1, %2" : "=v"(r) : "v"(lo), "v"(hi)); return r; }
typedef float f32x2 __attribute__((ext_vector_type(2)));
typedef float f32x2 __attribute__((ext_vector_type(2)));
template <class Epi, class Sched, bool ALIGN_EPI = false, bool SP2 = false>
__device__ __forceinline__ void gemm_phase(PG8_LAS unsigned char* lds, const Gemm g, const Sched& S, const Epi& E) {
    const int tid = threadIdx.x, wid = __builtin_amdgcn_readfirstlane(tid >> 6), lane = tid & 63, wr = wid >> 2, wc = wid & 3, fr = lane & 15, fq = lane >> 4;
    const int K = g.K, nt = K / BK;
    unsigned voffA[2], voffB[2];
#pragma unroll
    for (int i = 0; i < 2; ++i) { int R, C; stage_rc(tid * 16 + i * 8192, R, C); const int Rb = Epi::PERM ? ((R & ~31) + perm32(R & 31)) : R;
        voffA[i] = (unsigned)(R * K + C) * 2u; voffB[i] = (unsigned)(Rb * K + C) * 2u; }
    const size_t kstep = (size_t)(BK * 2);
    const size_t hstep = (size_t)HALF * K * 2;
    const size_t tstep = 2 * hstep;
    const unsigned ldsw = (unsigned)wid * 1024u;
    const int aoff = lds_byte(wr * 64 + fr, fq * 8), boff = lds_byte(wc * 32 + fr, fq * 8);
#define PG8_SA(b, h) (((b) * 2 + (h)) * HTB)
#define PG8_SB(b, h) ((4 + (b) * 2 + (h)) * HTB)
#define PG8_STAGE(bufoff, gbase, voff) do { _Pragma("unroll") for (int _i = 0; _i < 2; ++_i) \
        __builtin_amdgcn_global_load_lds((const unsigned*)((const char*)(gbase) + (voff)[_i]), (PG8_LAS unsigned*)(lds + (bufoff) + ldsw + _i * 8192), 16, 0, 0); } while (0)
#define PG8_LDA(dst, b, h) do { _Pragma("unroll") for (int m = 0; m < 4; ++m) _Pragma("unroll") for (int k = 0; k < 2; ++k) dst[m][k] = *(const PG8_LAS bf16x8*)(lds + PG8_SA(b, h) + aoff + m * 2048 + k * 1024); } while (0)
#define PG8_LDB(dst, b, h) do { _Pragma("unroll") for (int n = 0; n < 2; ++n) _Pragma("unroll") for (int k = 0; k < 2; ++k) dst[n][k] = *(const PG8_LAS bf16x8*)(lds + PG8_SB(b, h) + boff + n * 2048 + k * 1024); } while (0)
#define PG8_MMA(ai, bj, At, Bt) do { __builtin_amdgcn_s_setprio(1); _Pragma("unroll") for (int m = 0; m < 4; ++m) _Pragma("unroll") for (int n = 0; n < 2; ++n) _Pragma("unroll") for (int k = 0; k < 2; ++k) \
        acc[ai][bj][m][n] = __builtin_amdgcn_mfma_f32_16x16x32_bf16(Bt[n][k], At[m][k], acc[ai][bj][m][n], 0, 0, 0); __builtin_amdgcn_s_setprio(0); } while (0)
#define PG8_WAIT_V(n) asm volatile("s_waitcnt vmcnt(" #n ")" ::: "memory")
#define PG8_WAIT_L(n) asm volatile("s_waitcnt lgkmcnt(" #n ")" ::: "memory")
#define PG8_BAR __builtin_amdgcn_s_barrier()
#define PG8_SCHED __builtin_amdgcn_sched_barrier(0)
    Unit cur, nxt; int ui = 0;
    if (!S.next(0, cur)) return;
    f32x4 acc[2][2][4][2];
#pragma unroll
    for (int a = 0; a < 2; ++a)
#pragma unroll
        for (int b = 0; b < 2; ++b)
#pragma unroll
            for (int m = 0; m < 4; ++m)
#pragma unroll
                for (int n = 0; n < 2; ++n) acc[a][b][m][n] = (f32x4){0.f, 0.f, 0.f, 0.f};
    bf16x8 At[4][2], B0[2][2], B1[2][2];
    const char* cA = (const char*)g.A + (size_t)cur.pm * tstep; const char* cB = (const char*)g.Bt + (size_t)cur.pn * tstep;
    S.a_ready(cur);
    if constexpr (SP2) {
        PG8_STAGE(PG8_SB(0, 0), cB, voffB); PG8_STAGE(PG8_SB(0, 1), cB + hstep, voffB); PG8_STAGE(PG8_SA(0, 0), cA, voffA); PG8_STAGE(PG8_SA(0, 1), cA + hstep, voffA);
        if (wr == 1) PG8_BAR;
        PG8_WAIT_V(2); PG8_BAR;
        PG8_STAGE(PG8_SB(1, 0), cB + kstep, voffB); PG8_STAGE(PG8_SA(1, 0), cA + kstep, voffA); PG8_STAGE(PG8_SB(1, 1), cB + hstep + kstep, voffB);
        PG8_WAIT_V(6); PG8_BAR;
    } else {
        PG8_STAGE(PG8_SB(0, 0), cB, voffB); PG8_STAGE(PG8_SA(0, 0), cA, voffA); PG8_STAGE(PG8_SB(0, 1), cB + hstep, voffB); PG8_STAGE(PG8_SA(0, 1), cA + hstep, voffA);
        if (wr == 1) PG8_BAR;
        PG8_WAIT_V(4); PG8_BAR;
        PG8_STAGE(PG8_SB(1, 0), cB + kstep, voffB); PG8_STAGE(PG8_SA(1, 0), cA + kstep, voffA); PG8_STAGE(PG8_SB(1, 1), cB + hstep + kstep, voffB);
        PG8_WAIT_V(6); PG8_BAR;
    }
    for (;;) {
        const bool has_next = S.next(ui + 1, nxt);
        const char* nA = has_next ? (const char*)g.A + (size_t)nxt.pm * tstep : cA; const char* nB = has_next ? (const char*)g.Bt + (size_t)nxt.pn * tstep : cB;
        for (int t = 0; t < nt; t += 2) {
            const bool last = (t == nt - 2);
            const char* a1 = cA + (size_t)(t + 1) * kstep;
            const char* a2 = last ? nA : cA + (size_t)(t + 2) * kstep; const char* b2 = last ? nB : cB + (size_t)(t + 2) * kstep;
            const char* a3 = a2 + kstep; const char* b3 = b2 + kstep;
            if (last && has_next) S.a_ready(nxt);
            if constexpr (SP2) {
            PG8_LDB(B0, 0, 0); PG8_LDB(B1, 0, 1); PG8_SCHED; PG8_LDA(At, 0, 0); PG8_STAGE(PG8_SA(1, 1), a1 + hstep, voffA);
            PG8_WAIT_V(8); PG8_WAIT_L(0); PG8_BAR; PG8_MMA(0, 0, At, B0); PG8_MMA(0, 1, At, B1); PG8_BAR; PG8_SCHED;
            PG8_LDA(At, 0, 1); PG8_STAGE(PG8_SB(0, 0), b2, voffB); PG8_STAGE(PG8_SB(0, 1), b2 + hstep, voffB); PG8_STAGE(PG8_SA(0, 0), a2, voffA);
            PG8_WAIT_V(8); PG8_WAIT_L(0); PG8_BAR; PG8_MMA(1, 0, At, B0); PG8_MMA(1, 1, At, B1); PG8_BAR; PG8_SCHED;
            PG8_LDB(B0, 1, 0); PG8_LDB(B1, 1, 1); PG8_SCHED; PG8_LDA(At, 1, 0); PG8_STAGE(PG8_SA(0, 1), a2 + hstep, voffA);
            PG8_WAIT_V(8); PG8_WAIT_L(0); PG8_BAR; PG8_MMA(0, 0, At, B0); PG8_MMA(0, 1, At, B1); PG8_BAR; PG8_SCHED;
            PG8_LDA(At, 1, 1); PG8_STAGE(PG8_SB(1, 0), b3, voffB); PG8_STAGE(PG8_SB(1, 1), b3 + hstep, voffB); PG8_STAGE(PG8_SA(1, 0), a3, voffA);
            PG8_WAIT_V(8); PG8_WAIT_L(0); PG8_BAR; PG8_MMA(1, 0, At, B0); PG8_MMA(1, 1, At, B1); PG8_BAR; PG8_SCHED;
            } else {
            PG8_LDB(B0, 0, 0); PG8_SCHED; PG8_LDA(At, 0, 0); PG8_STAGE(PG8_SA(1, 1), a1 + hstep, voffA);
            PG8_WAIT_L(8); PG8_BAR; PG8_WAIT_L(0); PG8_MMA(0, 0, At, B0); PG8_BAR; PG8_SCHED;
            PG8_LDB(B1, 0, 1); PG8_STAGE(PG8_SB(0, 0), b2, voffB);
            PG8_BAR; PG8_WAIT_L(0); PG8_MMA(0, 1, At, B1); PG8_BAR;
            PG8_LDA(At, 0, 1); PG8_STAGE(PG8_SA(0, 0), a2, voffA);
            PG8_BAR; PG8_WAIT_L(0); PG8_MMA(1, 0, At, B0); PG8_BAR; PG8_SCHED;
            PG8_STAGE(PG8_SB(0, 1), b2 + hstep, voffB);
            PG8_WAIT_V(6); PG8_BAR; PG8_MMA(1, 1, At, B1); PG8_BAR;
            PG8_LDB(B0, 1, 0); PG8_SCHED; PG8_LDA(At, 1, 0); PG8_STAGE(PG8_SA(0, 1), a2 + hstep, voffA);
            PG8_WAIT_L(8); PG8_BAR; PG8_WAIT_L(0); PG8_MMA(0, 0, At, B0); PG8_BAR; PG8_SCHED;
            PG8_LDB(B1, 1, 1); PG8_STAGE(PG8_SB(1, 0), b3, voffB);
            PG8_BAR; PG8_WAIT_L(0); PG8_MMA(0, 1, At, B1); PG8_BAR;
            PG8_LDA(At, 1, 1); PG8_STAGE(PG8_SA(1, 0), a3, voffA);
            PG8_BAR; PG8_WAIT_L(0); PG8_MMA(1, 0, At, B0); PG8_BAR; PG8_SCHED;
            PG8_STAGE(PG8_SB(1, 1), b3 + hstep, voffB);
            PG8_WAIT_V(6); PG8_BAR; PG8_MMA(1, 1, At, B1); PG8_BAR;
            }
        }
        if constexpr (ALIGN_EPI) { if (wr == 0) PG8_BAR; }
        if constexpr (!Epi::AFTER_DRAIN) { E(acc, cur, wr, wc, fr, fq); S.done(cur); }
        if (!has_next) break;
#pragma unroll
        for (int a = 0; a < 2; ++a)
#pragma unroll
            for (int b = 0; b < 2; ++b)
#pragma unroll
                for (int m = 0; m < 4; ++m)
#pragma unroll
                    for (int n = 0; n < 2; ++n) acc[a][b][m][n] = (f32x4){0.f, 0.f, 0.f, 0.f};
        cur = nxt; cA = nA; cB = nB; ++ui;
        if constexpr (ALIGN_EPI) { if (wr == 1) PG8_BAR; }
    }
    PG8_WAIT_V(0);
    if constexpr (!ALIGN_EPI) { if (wr == 0) PG8_BAR; }
    PG8_BAR;
    if constexpr (Epi::AFTER_DRAIN) { E.fused(acc, cur, wr, wc, fr, fq, lds, wid, lane); S.done(cur); }
#undef PG8_SA
#undef PG8_SB
#undef PG8_STAGE
#undef PG8_LDA
#undef PG8_LDB
#undef PG8_MMA
#undef PG8_WAIT_V
#undef PG8_WAIT_L
#undef PG8_BAR
#undef PG8_SCHED
}
}
#define XB_TMO      128
#define XB_XCNT(j)  (256  + 64 * (j))
#define XB_XSUB(j)  (1280 + 64 * (j))
#define XB_XGEN(j)  (2304 + 64 * (j))
#define XB_TOP      3328
#define XB_TOPGEN   3392
#define XCD_BAR_WORDS 3456
#define XB_SPIN_CAP (1u << 18)

__device__ __forceinline__ unsigned xb_ld(unsigned* p)              { return __hip_atomic_load(p, __ATOMIC_RELAXED, __HIP_MEMORY_SCOPE_AGENT); }
__device__ __forceinline__ unsigned xb_add(unsigned* p, unsigned v) { return __hip_atomic_fetch_add(p, v, __ATOMIC_RELAXED, __HIP_MEMORY_SCOPE_AGENT); }
__device__ __forceinline__ unsigned xb_xcc_id() { return (unsigned)__builtin_amdgcn_s_getreg((3 << 11) | 20) & 0xFu; }
#define XB_SPIN(cond, bar) do { unsigned _sp = 0; while (cond) { __builtin_amdgcn_s_sleep(1); \
    if ((++_sp & 255u) == 0u) { if (xb_ld(&(bar)[XB_TMO])) break; if (_sp > XB_SPIN_CAP) { atomicAdd(&(bar)[XB_TMO], 1u); break; } } } } while (0)

struct XcdBarrier {
    unsigned* bar; unsigned x;
    volatile LAS unsigned* st;
};

__device__ __forceinline__ XcdBarrier xcd_barrier_post(unsigned* bar, volatile LAS unsigned* st) {
    XcdBarrier b; b.bar = bar; b.x = xb_xcc_id(); b.st = st;
    if (threadIdx.x == 0) (void)xb_add(&bar[XB_XCNT(b.x)], 1u);
    return b;
}
__device__ __forceinline__ void xcd_barrier_complete(unsigned* bar, unsigned x, unsigned& nloc, unsigned& nx) {
    const unsigned G = gridDim.x * gridDim.y * gridDim.z;
    unsigned sum, cnt, mine, sp = 0u;
    for (;;) {
        sum = 0u; cnt = 0u; mine = 0u;
#pragma unroll
        for (unsigned j = 0; j < 16; ++j) { const unsigned c = xb_ld(&bar[XB_XCNT(j)]); sum += c; cnt += (c > 0u) ? 1u : 0u; mine = (j == x) ? c : mine; }
        if (sum == G) break;
        __builtin_amdgcn_s_sleep(1);
        if ((++sp & 255u) == 0u) { if (xb_ld(&bar[XB_TMO])) break; if (sp > XB_SPIN_CAP) { atomicAdd(&bar[XB_TMO], 1u); break; } }
    }
    nloc = mine > 0u ? mine : 1u; nx = cnt > 0u ? cnt : 1u;
}

__device__ __forceinline__ void xcd_barrier(const XcdBarrier& b) {
    asm volatile("s_waitcnt vmcnt(0)" ::: "memory");
    __syncthreads();
    if (threadIdx.x == 0) {
        unsigned* bar = b.bar;
        __builtin_amdgcn_s_waitcnt(0);
        unsigned nloc = b.st[0], nx = b.st[1];
        if (nloc == 0u) { xcd_barrier_complete(bar, b.x, nloc, nx); b.st[0] = nloc; b.st[1] = nx; }
        const unsigned old = xb_add(&bar[XB_XSUB(b.x)], 1u);
        const unsigned gen = old / nloc;
        if (old + 1u == (gen + 1u) * nloc) {
            __builtin_amdgcn_fence(__ATOMIC_RELEASE, "agent");
            asm volatile("s_waitcnt vmcnt(0)" ::: "memory");
            const unsigned og = xb_add(&bar[XB_TOP], 1u);
            const unsigned tg = og / nx;
            if (og + 1u == (tg + 1u) * nx) xb_add(&bar[XB_TOPGEN], 1u);
            else XB_SPIN(xb_ld(&bar[XB_TOPGEN]) == tg, bar);
            __builtin_amdgcn_fence(__ATOMIC_ACQUIRE, "agent");
            xb_add(&bar[XB_XGEN(b.x)], 1u);
            asm volatile("s_waitcnt vmcnt(0)" ::: "memory");
        } else {
            XB_SPIN(xb_ld(&bar[XB_XGEN(b.x)]) == gen, bar);
            __builtin_amdgcn_fence(__ATOMIC_ACQUIRE, "agent");
            asm volatile("s_waitcnt vmcnt(0)" ::: "memory");
        }
    }
    __syncthreads();
}
namespace fx {
#define DI __device__ __forceinline__
typedef unsigned short bf16;
typedef short bf16x8 __attribute__((ext_vector_type(8)));
typedef float f32x4 __attribute__((ext_vector_type(4)));
typedef float f32x2 __attribute__((ext_vector_type(2)));
typedef unsigned u32x4 __attribute__((ext_vector_type(4)));
typedef unsigned u32x2 __attribute__((ext_vector_type(2)));
constexpr int M0 = BATCH * SEQ, MP = M0 + DEC_BATCH, MPAD = ((MP + 255) / 256) * 256;
constexpr int ACOLS = DIL_COLS + MEM_COLS, BCOLS = NSA_Q_COLS + NSA_GATE_COLS + MEM_COLS, KVCOLS = 6 * NSA_KV_HEADS * HEAD_DIM;
constexpr int NB_T = 2048;
constexpr int NPK = PEER_HEADS * 2 * PEER_KEYS;
constexpr int NCMP = (SEQ - CMP_BLOCK) / CMP_STRIDE + 1;
constexpr int NCH = SEQ / CMP_STRIDE;
constexpr int NCTX = BATCH + DEC_BATCH;
constexpr int ACROWS = NCTX * NSA_KV_HEADS * NCH;
constexpr int NPOS = PAST_LEN + 1;
constexpr float QSCALE = 0.125f * 1.4426950408889634f;
constexpr int NTHREADS = 512, NWAVES = 8, LDS_BYTES = 147456, RING_BYTES = 131072, MISC_OFF = RING_BYTES + 320;

struct FP {
    const float *x_prompt, *x_sample, *mem_prompt, *cache_dil[3], *cache_nsa_kv, *cache_nsa_win, *cache_mem_kv; const int* page_table;
    const float *w_in_a, *w_out_a, *w_in_b, *w_out_b, *w_mem_kv, *w_kv_b, *cmp_pe, *cmp_w1, *cmp_w2, *ln_g, *ln_b, *peer_wq, *peer_keys, *peer_u, *peer_v;
    float *y_prompt, *y_sample, *dil_p[3], *dil_s[3], *nsa_kv_p, *nsa_kv_s, *win_p, *win_s, *mem_kv_p;
    unsigned* ctl;
    bf16 *XB0, *X1B, *X2B, *X3B, *WA_T, *WMEM_T, *MEMB, *WOA_T, *WOB_T, *WPK_T, *WB_T, *CW1_T, *AC; unsigned char *UB8, *VB8;
    float *ROPE, *CBIAS;
    bf16 *QA, *KA, *VTA, *MQA, *MK, *MVT, *ATTA;
    float *DPART, *DML, *PRE, *X1, *X2, *X3, *SCO, *SELG; int* SELE;
    bf16 *SLK, *SLVT, *WNK, *WNVT, *QB, *MQB, *CK, *CVT, *ATTB;
    float *GATES, *UL, *CKF, *CVF;
    int* SELB;
    float* DBG;
};
struct Args { FP p; int lo, hi; };
struct Carve { size_t off = 0; template <class T> T* take(void* base, size_t n) { T* r = (T*)((char*)base + off); off += ((n * sizeof(T) + 255) / 256) * 256; return r; } };
constexpr size_t CTL_BYTES = 65536;
inline size_t carve(FP& p, void* base) {
    Carve c;
    p.ctl = c.take<unsigned>(base, CTL_BYTES / 4);
    p.XB0 = c.take<bf16>(base, (size_t)MPAD * D_MODEL); p.X1B = c.take<bf16>(base, (size_t)MPAD * D_MODEL); p.X2B = c.take<bf16>(base, (size_t)MPAD * D_MODEL); p.X3B = c.take<bf16>(base, (size_t)MPAD * D_MODEL);
    p.WA_T = c.take<bf16>(base, (size_t)ACOLS * D_MODEL); p.WMEM_T = c.take<bf16>(base, (size_t)DEPTH * 2 * MEM_COLS * D_MODEL); p.MEMB = c.take<bf16>(base, (size_t)BATCH * MEM_TOKENS * D_MODEL);
    p.WOA_T = c.take<bf16>(base, (size_t)D_MODEL * 2 * MEM_COLS); p.WOB_T = c.take<bf16>(base, (size_t)D_MODEL * (NSA_Q_COLS + MEM_COLS));
    p.WPK_T = c.take<bf16>(base, (size_t)DEPTH * NPK * D_MODEL); p.WB_T = c.take<bf16>(base, (size_t)NB_T * D_MODEL);
    p.UB8 = c.take<unsigned char>(base, (size_t)DEPTH * PEER_EXPERTS * D_MODEL); p.VB8 = c.take<unsigned char>(base, (size_t)DEPTH * PEER_EXPERTS * D_MODEL);
    p.CW1_T = c.take<bf16>(base, (size_t)2 * 256 * 1024); p.AC = c.take<bf16>(base, (size_t)2 * ACROWS * 1024);
    p.ROPE = c.take<float>(base, (size_t)NPOS * 64); p.CBIAS = c.take<float>(base, 2 * CMP_HIDDEN);
    p.QA = c.take<bf16>(base, (size_t)3 * MPAD * 256); p.KA = c.take<bf16>(base, (size_t)3 * MPAD * 256); p.VTA = c.take<bf16>(base, (size_t)3 * BATCH * DIL_HEADS * HEAD_DIM * SEQ + 4096);
    p.MQA = c.take<bf16>(base, (size_t)MPAD * 256); p.MK = c.take<bf16>(base, (size_t)DEPTH * BATCH * MEM_TOKENS * MEM_COLS); p.MVT = c.take<bf16>(base, (size_t)DEPTH * BATCH * MEM_COLS * MEM_TOKENS);
    p.ATTA = c.take<bf16>(base, (size_t)MPAD * 2 * MEM_COLS);
    p.DPART = c.take<float>(base, (size_t)3 * MP * DIL_HEADS * HEAD_DIM); p.DML = c.take<float>(base, (size_t)3 * MP * DIL_HEADS * 2);
    p.PRE = c.take<float>(base, (size_t)MPAD * D_MODEL); p.X1 = c.take<float>(base, (size_t)MPAD * D_MODEL); p.X2 = c.take<float>(base, (size_t)MPAD * D_MODEL); p.X3 = c.take<float>(base, (size_t)MPAD * D_MODEL);
    p.SCO = c.take<float>(base, (size_t)MPAD * NPK); p.SELG = c.take<float>(base, (size_t)MP * 128); p.SELE = c.take<int>(base, (size_t)MP * 128);
    p.SLK = c.take<bf16>(base, (size_t)BATCH * NSA_KV_HEADS * SEQ * HEAD_DIM); p.SLVT = c.take<bf16>(base, (size_t)BATCH * NSA_KV_HEADS * SEQ * HEAD_DIM);
    p.WNK = c.take<bf16>(base, (size_t)BATCH * NSA_KV_HEADS * SEQ * HEAD_DIM + 4096); p.WNVT = c.take<bf16>(base, (size_t)BATCH * NSA_KV_HEADS * SEQ * HEAD_DIM + 4096);
    p.QB = c.take<bf16>(base, (size_t)MPAD * NSA_Q_COLS); p.MQB = c.take<bf16>(base, (size_t)MPAD * 256);
    p.CK = c.take<bf16>(base, (size_t)NCTX * NSA_KV_HEADS * NCH * HEAD_DIM); p.CVT = c.take<bf16>(base, (size_t)NCTX * NSA_KV_HEADS * HEAD_DIM * NCH); p.ATTB = c.take<bf16>(base, (size_t)MPAD * (NSA_Q_COLS + MEM_COLS));
    p.GATES = c.take<float>(base, (size_t)MPAD * 64); p.UL = c.take<float>(base, (size_t)2 * ACROWS * 256);
    p.CKF = c.take<float>(base, (size_t)DEC_BATCH * NSA_KV_HEADS * NCH * HEAD_DIM); p.CVF = c.take<float>(base, (size_t)DEC_BATCH * NSA_KV_HEADS * NCH * HEAD_DIM);
    p.SELB = c.take<int>(base, (size_t)MP * NSA_KV_HEADS * 16);
#ifdef NSA_DEBUG
    p.DBG = c.take<float>(base, (size_t)3 * MP * 768);
#else
    p.DBG = nullptr;
#endif
    return c.off;
}
inline void bind_io(FP& p, void* const* d_in, float* out) {
    p.x_prompt = (const float*)d_in[0]; p.x_sample = (const float*)d_in[1]; p.mem_prompt = (const float*)d_in[2]; p.cache_dil[0] = (const float*)d_in[3]; p.cache_dil[1] = (const float*)d_in[4]; p.cache_dil[2] = (const float*)d_in[5];
    p.cache_nsa_kv = (const float*)d_in[6]; p.cache_nsa_win = (const float*)d_in[7]; p.cache_mem_kv = (const float*)d_in[8]; p.page_table = (const int*)d_in[9];
    p.w_in_a = (const float*)d_in[10]; p.w_out_a = (const float*)d_in[11]; p.w_in_b = (const float*)d_in[12]; p.w_out_b = (const float*)d_in[13]; p.w_mem_kv = (const float*)d_in[14]; p.w_kv_b = (const float*)d_in[15];
    p.cmp_pe = (const float*)d_in[16]; p.cmp_w1 = (const float*)d_in[17]; p.cmp_w2 = (const float*)d_in[18]; p.ln_g = (const float*)d_in[19]; p.ln_b = (const float*)d_in[20];
    p.peer_wq = (const float*)d_in[21]; p.peer_keys = (const float*)d_in[22]; p.peer_u = (const float*)d_in[23]; p.peer_v = (const float*)d_in[24];
    size_t o = 0; auto take = [&](size_t n) { float* r = out + o; o += n; return r; };
    p.y_prompt = take((size_t)M0 * D_MODEL); p.y_sample = take((size_t)DEC_BATCH * D_MODEL);
    for (int g = 0; g < 3; ++g) p.dil_p[g] = take((size_t)BATCH * DIL_W[g] * 2 * DIL_HEADS * HEAD_DIM);
    for (int g = 0; g < 3; ++g) p.dil_s[g] = take((size_t)DEC_BATCH * DIL_W[g] * 2 * DIL_HEADS * HEAD_DIM);
    p.nsa_kv_p = take((size_t)M0 * 4 * NSA_KV_HEADS * HEAD_DIM); p.nsa_kv_s = take((size_t)DEC_BATCH * 4 * NSA_KV_HEADS * HEAD_DIM);
    p.win_p = take((size_t)BATCH * SWA_WINDOW * 2 * NSA_KV_HEADS * HEAD_DIM); p.win_s = take((size_t)DEC_BATCH * SWA_WINDOW * 2 * NSA_KV_HEADS * HEAD_DIM);
    p.mem_kv_p = take((size_t)DEPTH * BATCH * MEM_TOKENS * 2 * MEM_COLS);
}
DI unsigned f2bf(float f) { unsigned u = __builtin_bit_cast(unsigned, f); return (u + 0x7fffu + ((u >> 16) & 1u)) >> 16; }
DI unsigned pk2(float lo, float hi) { return f2bf(lo) | (f2bf(hi) << 16); }
DI float bf2f(unsigned short b) { return __builtin_bit_cast(float, (unsigned)b << 16); }
DI float bflo(unsigned w) { return __builtin_bit_cast(float, w << 16); }
DI float bfhi(unsigned w) { return __builtin_bit_cast(float, w & 0xffff0000u); }
DI float wave_sum(float v) {
#pragma unroll
    for (int o = 1; o < 64; o <<= 1) v += __shfl_xor(v, o);
    return v; }
DI float wave_max(float v) {
#pragma unroll
    for (int o = 1; o < 64; o <<= 1) v = fmaxf(v, __shfl_xor(v, o));
    return v; }
DI float gelu_tanh(float x) { const float u = 0.7978845608028654f * (x + 0.044715f * x * x * x); const float e = __builtin_amdgcn_exp2f(u * 2.885390081777927f);   const float t = 1.0f - 2.0f / (e + 1.0f); return 0.5f * x * (1.0f + t); }
DI float* sel3(float* const (&a)[3], int g) { return g == 0 ? a[0] : (g == 1 ? a[1] : a[2]); }
DI const float* sel3c(const float* const (&a)[3], int g) { return g == 0 ? a[0] : (g == 1 ? a[1] : a[2]); }
__host__ DI size_t ktile_off(int t, int d) { const int blk = t >> 5, kk = t & 31, b = (kk >> 2) & 1, i = 4 * (kk >> 3) + (kk & 3), s = d >> 5, c = (d & 31) >> 3; return ((size_t)(blk * 4 + 2 * b + s) * 64 + i + 16 * c) * 8 + (d & 7); }
__host__ DI size_t vtile_off(int dim, int t) { const int blk = t >> 5, kk = t & 31; return ((size_t)(blk * 4 + (dim >> 4)) * 64 + (dim & 15) + 16 * (kk >> 3)) * 8 + (kk & 7); }
struct Ctx { LAS unsigned char* lds; int tid, lane, wave, vcu, G; };
DI int row_pos(int r) { return r < M0 ? (r & (SEQ - 1)) : PAST_LEN; }

struct ColSrc { const float* p; int ld; };
DI int rope_il(int e) { return (e >> 1) + 32 * (e & 1); }
DI ColSrc col_wa(const FP& P, int n) {
    const int t = n >> 8, ct = n & 255, h = ct >> 6, e = ct & 63; if (t >= 9) return ColSrc{P.w_in_a + DIL_COLS + ct, ACOLS};
    const int j = t % 3, d = (j < 2) ? rope_il(e) : e; return ColSrc{P.w_in_a + t * 256 + h * 64 + d, ACOLS}; }
DI ColSrc col_wb(const FP& P, int n) {
    const int t = n >> 8, ct = n & 255, e = ct & 63;
    if (t < 3) { const int ty = 2 * t + (ct >> 7), kvh = (ct >> 6) & 1; const bool rot = (ty == 2 || ty == 4); return ColSrc{P.w_kv_b + (ty * NSA_KV_HEADS + kvh) * 64 + (rot ? rope_il(e) : e), KVCOLS}; }
    if (t < 6) { const int h = (t - 3) * 4 + (ct >> 6); return ColSrc{P.w_in_b + h * 64 + rope_il(e), BCOLS}; }
    if (t == 6) return ColSrc{P.w_in_b + NSA_Q_COLS + NSA_GATE_COLS + ct, BCOLS};
    if (ct < NSA_GATE_COLS) return ColSrc{P.w_in_b + NSA_Q_COLS + ct, BCOLS};
    return ColSrc{nullptr, 0}; }
DI ColSrc col_wmem(const FP& P, int n) { const int l = n >> 9, c = n & 511; return ColSrc{P.w_mem_kv + (size_t)l * D_MODEL * 512 + c, 512}; }
DI ColSrc col_woa(const FP& P, int n) { return ColSrc{P.w_out_a + n, D_MODEL}; }
DI ColSrc col_wob(const FP& P, int n) { return ColSrc{P.w_out_b + n, D_MODEL}; }
DI ColSrc col_cw1(const FP& P, int n) {
    const int ty = n >> 8, half = (n >> 7) & 1, hid = n & 127; return ColSrc{P.cmp_w1 + (size_t)ty * CMP_BLOCK * HEAD_DIM * CMP_HIDDEN + (size_t)half * 16 * HEAD_DIM * CMP_HIDDEN + hid, CMP_HIDDEN}; }
template <class CF> DI void transpose_item(const FP& P, CF cf, int K, bf16* WT, LAS float* scr, int item, int nblk, int lane) {
    const int kb = item / nblk, nb = item % nblk, k0 = 64 * kb, n0 = 32 * nb;
    const ColSrc cs = cf(P, n0 + (lane & 31));
#pragma unroll 8
    for (int i = 0; i < 32; ++i) { const int kk = 2 * i + (lane >> 5); scr[kk * 33 + (lane & 31)] = cs.p ? cs.p[(size_t)(k0 + kk) * cs.ld] : 0.f; }
    asm volatile("s_waitcnt lgkmcnt(0)" ::: "memory");
    const int c = lane & 7;
#pragma unroll
    for (int j = 0; j < 4; ++j) { const int n = (lane >> 3) + 8 * j; const LAS float* s = scr + (8 * c) * 33 + n;
        u32x4 o; o.x = pk2(s[0 * 33], s[1 * 33]); o.y = pk2(s[2 * 33], s[3 * 33]); o.z = pk2(s[4 * 33], s[5 * 33]); o.w = pk2(s[6 * 33], s[7 * 33]);
        *(u32x4*)(WT + (size_t)(n0 + n) * K + k0 + 8 * c) = o; }
    asm volatile("s_waitcnt lgkmcnt(0)" ::: "memory");
}
DI void cvt_row1024(const float* src, bf16* dst, int lane) {
#pragma unroll
    for (int j = 0; j < 4; ++j) { f32x4 v = src ? *(const f32x4*)(src + 256 * j + 4 * lane) : (f32x4){0.f, 0.f, 0.f, 0.f}; u32x2 o; o.x = pk2(v.x, v.y); o.y = pk2(v.z, v.w); *(u32x2*)(dst + 256 * j + 4 * lane) = o; }
}
DI void cvt_row1024_fp8(const float* src, unsigned char* dst, float sc, int lane) { u32x4 o; unsigned w[4];
#pragma unroll
    for (int j = 0; j < 4; ++j) { const f32x4 v = *(const f32x4*)(src + 16 * lane + 4 * j) * sc; int t = __builtin_amdgcn_cvt_pk_fp8_f32(v.x, v.y, 0, false); t = __builtin_amdgcn_cvt_pk_fp8_f32(v.z, v.w, t, true); w[j] = (unsigned)t; }
    o.x = w[0]; o.y = w[1]; o.z = w[2]; o.w = w[3]; *(u32x4*)(dst + 16 * lane) = o; }
DI void p0_prologue(const FP& P, const Ctx& C) {
    LAS float* scr = (LAS float*)(C.lds + C.wave * 16384);
    const int gw = C.vcu * NWAVES + C.wave, NGW = C.G * NWAVES, lane = C.lane;
    { constexpr int IA = (D_MODEL / 64) * (ACOLS / 32), IM = (D_MODEL / 64) * (1024 / 32), IOA = (512 / 64) * (D_MODEL / 32), IOB = (1024 / 64) * (D_MODEL / 32), IB = (D_MODEL / 64) * (NB_T / 32), IC = (1024 / 64) * (512 / 32);
      constexpr int NIT = IA + IM + IOA + IOB + IB + IC;
      for (int it = gw; it < NIT; it += NGW) { int r = it;
          if (r < IA) { transpose_item(P, col_wa, D_MODEL, P.WA_T, scr, r, ACOLS / 32, lane); continue; } r -= IA;
          if (r < IM) { transpose_item(P, col_wmem, D_MODEL, P.WMEM_T, scr, r, 1024 / 32, lane); continue; } r -= IM;
          if (r < IOA) { transpose_item(P, col_woa, 512, P.WOA_T, scr, r, D_MODEL / 32, lane); continue; } r -= IOA;
          if (r < IOB) { transpose_item(P, col_wob, 1024, P.WOB_T, scr, r, D_MODEL / 32, lane); continue; } r -= IOB;
          if (r < IB) { transpose_item(P, col_wb, D_MODEL, P.WB_T, scr, r, NB_T / 32, lane); continue; } r -= IB;
          transpose_item(P, col_cw1, 1024, P.CW1_T, scr, r, 512 / 32, lane); } }
    for (int r = gw; r < MPAD; r += NGW) { cvt_row1024(r < M0 ? P.x_prompt + (size_t)r * D_MODEL : (r < MP ? P.x_sample + (size_t)(r - M0) * D_MODEL : nullptr), P.XB0 + (size_t)r * D_MODEL, lane);
        if (r >= MP) { cvt_row1024(nullptr, P.X1B + (size_t)r * D_MODEL, lane); cvt_row1024(nullptr, P.X2B + (size_t)r * D_MODEL, lane); cvt_row1024(nullptr, P.X3B + (size_t)r * D_MODEL, lane);
            for (int c = lane; c < 512; c += 64) { P.ATTA[(size_t)r * 512 + c] = 0; P.ATTB[(size_t)r * 1024 + c] = 0; P.ATTB[(size_t)r * 1024 + 512 + c] = 0; } } }
    for (int r = gw; r < BATCH * MEM_TOKENS; r += NGW) cvt_row1024(P.mem_prompt + (size_t)r * D_MODEL, P.MEMB + (size_t)r * D_MODEL, lane);
#pragma unroll 1
    for (int r = 2 * gw; r < DEPTH * PEER_EXPERTS; r += 2 * NGW) { f32x4 a[16];
#pragma unroll
        for (int q = 0; q < 4; ++q) { const float* s0 = (q < 2 ? P.peer_u : P.peer_v) + (size_t)(r + (q & 1)) * D_MODEL + 16 * lane;
#pragma unroll
            for (int j = 0; j < 4; ++j) a[4 * q + j] = *(const f32x4*)(s0 + 4 * j); }
#pragma unroll
        for (int q = 0; q < 4; ++q) { const float sc = q < 2 ? 256.f : 64.f; unsigned w[4];
#pragma unroll
            for (int j = 0; j < 4; ++j) { const f32x4 v = a[4 * q + j] * sc; int t = __builtin_amdgcn_cvt_pk_fp8_f32(v.x, v.y, 0, false); t = __builtin_amdgcn_cvt_pk_fp8_f32(v.z, v.w, t, true); w[j] = (unsigned)t; }
            u32x4 o; o.x = w[0]; o.y = w[1]; o.z = w[2]; o.w = w[3]; *(u32x4*)((q < 2 ? P.UB8 : P.VB8) + (size_t)(r + (q & 1)) * D_MODEL + 16 * lane) = o; } }
    for (int i = gw * 64 + lane; i < NPOS * 32; i += NGW * 64) { const int pos = i >> 5, d = i & 31; const double inv = exp2(-(double)d * (13.287712379549449 / 32.0)); const double turns = (double)pos * inv * 0.15915494309189535;
        const float fr = (float)(turns - floor(turns)); P.ROPE[pos * 64 + d] = __builtin_amdgcn_cosf(fr); P.ROPE[pos * 64 + 32 + d] = __builtin_amdgcn_sinf(fr); }
    for (int i = gw; i < 2 * CMP_HIDDEN; i += NGW) { const int ty = i / CMP_HIDDEN, hid = i % CMP_HIDDEN; float a = 0.f;
#pragma unroll 8
        for (int k = lane; k < CMP_BLOCK * HEAD_DIM; k += 64) a += P.cmp_pe[ty * CMP_BLOCK * HEAD_DIM + k] * P.cmp_w1[((size_t)ty * CMP_BLOCK * HEAD_DIM + k) * CMP_HIDDEN + hid];
        a = wave_sum(a); if (lane == 0) P.CBIAS[i] = a; }
    for (int it = gw; it < DEC_BATCH * (PAST_LEN / PAGE_SIZE); it += NGW) { const int n = it / (PAST_LEN / PAGE_SIZE), pi = it % (PAST_LEN / PAGE_SIZE); const int pg = P.page_table[it];
        const float* src = P.cache_nsa_kv + (size_t)pg * PAGE_SIZE * 512 + 4 * lane; const int ty = lane >> 5, kvh = (lane >> 4) & 1, d = (4 * lane) & 63;
        bf16* dst = P.AC + ((size_t)ty * ACROWS + ((size_t)(BATCH + n) * NSA_KV_HEADS + kvh) * NCH + pi * (PAGE_SIZE / 16)) * 1024 + d;
#pragma unroll 1
        for (int r0 = 0; r0 < PAGE_SIZE; r0 += 8) { f32x4 v[8];
#pragma unroll
            for (int u = 0; u < 8; ++u) v[u] = *(const f32x4*)(src + (size_t)(r0 + u) * 512);
#pragma unroll
            for (int u = 0; u < 8; ++u) { const int t = r0 + u; u32x2 o; o.x = pk2(v[u].x, v[u].y); o.y = pk2(v[u].z, v[u].w); *(u32x2*)(dst + (size_t)(t / 16) * 1024 + (t % 16) * 64) = o; } } }
    for (int g = 0; g < 4; ++g) { const int W = g < 3 ? dil_w(g) : SWA_WINDOW, RV = g < 3 ? 128 : 64;
        const f32x4* src = (const f32x4*)(g < 3 ? sel3c(P.cache_dil, g) : P.cache_nsa_win); f32x4* dst = (f32x4*)(g < 3 ? sel3(P.dil_s, g) : P.win_s);
        const long per = (long)(W - 1) * RV, nvec = (long)DEC_BATCH * per;
#pragma unroll 1
        for (long i0 = (long)gw * 512; i0 < nvec; i0 += (long)NGW * 512) { f32x4 v[8]; long idx[8];
#pragma unroll
            for (int u = 0; u < 8; ++u) { const long i = i0 + u * 64 + lane; const long ii = i < nvec ? i : nvec - 1; const long n = ii / per, o = ii % per; idx[u] = n * (per + RV) + o; v[u] = src[idx[u] + RV]; }
#pragma unroll
            for (int u = 0; u < 8; ++u) { const long i = i0 + u * 64 + lane; if (i < nvec) dst[idx[u]] = v[u]; } } }
}
DI void p0_wpk(const FP& P, const Ctx& C) {
    LAS float* sw = (LAS float*)C.lds;
    LAS float* sk = (LAS float*)(C.lds + 32768);
    constexpr int NIT = DEPTH * 16 * (D_MODEL / 64);
    for (int it = C.vcu; it < NIT; it += C.G) { const int l = it / (16 * (D_MODEL / 64)), rem = it % (16 * (D_MODEL / 64)), hc = rem / (D_MODEL / 64), kb = rem % (D_MODEL / 64);
        __syncthreads();
        for (int i = C.tid; i < 64 * 64; i += NTHREADS) { const int r = i >> 6, d = i & 63; sw[r * 65 + d] = P.peer_wq[((size_t)l * D_MODEL + kb * 64 + r) * 1024 + hc * 64 + d]; }
        for (int i = C.tid; i < 128 * 64; i += NTHREADS) { const int r = i >> 6, d = i & 63; sk[r * 65 + d] = P.peer_keys[(((size_t)l * 16 + hc) * PEER_KEYS + r) * 64 + d]; }
        __syncthreads();
        for (int o = C.tid; o < 128 * 64; o += NTHREADS) { const int kk = o >> 6, ki = o & 63; float a = 0.f;
#pragma unroll 16
            for (int d = 0; d < 64; ++d) a += sw[ki * 65 + d] * sk[kk * 65 + d];
            P.WPK_T[((size_t)l * NPK + hc * 128 + kk) * D_MODEL + kb * 64 + ki] = (bf16)f2bf(a); } }
    __syncthreads();
}

#define EPI_LOOP(...) int fr_l = fr, fq_l = fq; asm volatile("" : "+v"(fr_l), "+v"(fq_l));     \
    _Pragma("unroll") for (int ai = 0; ai < 2; ++ai) _Pragma("unroll") for (int m = 0; m < 4; ++m) { const int row = u.pm * 256 + ai * 128 + wr * 64 + m * 16 + fr_l; \
    _Pragma("unroll") for (int bj = 0; bj < 2; ++bj) { const int ct = bj * 128 + wc * 32 + fq_l * 8; const f32x4 v0 = acc[ai][bj][m][0], v1 = acc[ai][bj][m][1]; __VA_ARGS__ } asm volatile("" ::: "memory"); }
DI void rope4(const float* rope_row, int dp, const f32x4& v0, const f32x4& v1, f32x4& lo, f32x4& hi) {
    const f32x4 c = *(const f32x4*)(rope_row + dp), s = *(const f32x4*)(rope_row + 32 + dp);
    lo.x = v0.x * c.x - v0.y * s.x; hi.x = v0.y * c.x + v0.x * s.x; lo.y = v0.z * c.y - v0.w * s.y; hi.y = v0.w * c.y + v0.z * s.y;
    lo.z = v1.x * c.z - v1.y * s.z; hi.z = v1.y * c.z + v1.x * s.z; lo.w = v1.z * c.w - v1.w * s.w; hi.w = v1.w * c.w + v1.z * s.w; }
DI u32x2 pk4(const f32x4& v) { u32x2 o; o.x = pk2(v.x, v.y); o.y = pk2(v.z, v.w); return o; }
DI u32x4 pk8(const f32x4& a, const f32x4& b) { u32x4 o; o.x = pk2(a.x, a.y); o.y = pk2(a.z, a.w); o.z = pk2(b.x, b.y); o.w = pk2(b.z, b.w); return o; }
DI int dil_perm(int t, int d) { return (t % d) * (SEQ / d) + t / d; }
struct EpiA {
    static constexpr bool PERM = true, AFTER_DRAIN = false; const FP& P;
    DI void operator()(const f32x4 (&acc)[2][2][4][2], const pg8::Unit& u, int wr, int wc, int fr, int fq) const {
        const int t9 = u.pn; const int g = t9 / 3, j = t9 % 3;
        EPI_LOOP({ if (row < MP) { const int h = ct >> 6, e = ct & 63; const int pos = row_pos(row);
            if (t9 == 9) { *(u32x4*)(P.MQA + (size_t)row * 256 + ct) = pk8(v0 * QSCALE, v1 * QSCALE); }
            else if (j < 2) { f32x4 lo, hi; const int dp = e >> 1; rope4(P.ROPE + pos * 64, dp, v0, v1, lo, hi);
                if (j == 0) { bf16* q = P.QA + ((size_t)g * MPAD + row) * 256 + h * 64 + dp; *(u32x2*)q = pk4(lo * QSCALE); *(u32x2*)(q + 32) = pk4(hi * QSCALE); }
                else { if (row < M0) { bf16* kt = P.KA + ((size_t)(g * BATCH + row / SEQ) * DIL_HEADS + h) * 64 * SEQ; const int cm = dil_perm(pos, dil_d(g)); *(u32x2*)(kt + ktile_off(cm, dp)) = pk4(lo); *(u32x2*)(kt + ktile_off(cm, dp + 32)) = pk4(hi); }
                    const int W = dil_w(g); float* o = nullptr;
                    if (row >= M0) o = sel3(P.dil_s, g) + (((size_t)(row - M0) * W + W - 1) * 2 + 0) * 256; else if (pos >= SEQ - W) o = sel3(P.dil_p, g) + (((size_t)(row / SEQ) * W + pos - (SEQ - W)) * 2 + 0) * 256;
                    if (o) { *(f32x4*)(o + h * 64 + dp) = lo; *(f32x4*)(o + h * 64 + 32 + dp) = hi; } } }
            else { const int W = dil_w(g), d = dil_d(g); float* o = nullptr;
                if (row >= M0) o = sel3(P.dil_s, g) + (((size_t)(row - M0) * W + W - 1) * 2 + 1) * 256; else if (pos >= SEQ - W) o = sel3(P.dil_p, g) + (((size_t)(row / SEQ) * W + pos - (SEQ - W)) * 2 + 1) * 256;
                if (o) { *(f32x4*)(o + ct) = v0; *(f32x4*)(o + ct + 4) = v1; }
                if (row < M0) { bf16* vt = P.VTA + ((size_t)(g * BATCH + row / SEQ) * DIL_HEADS + h) * 64 * SEQ + vtile_off(e, dil_perm(pos, d));
                    vt[0] = (bf16)f2bf(v0.x); vt[8] = (bf16)f2bf(v0.y); vt[16] = (bf16)f2bf(v0.z); vt[24] = (bf16)f2bf(v0.w); vt[32] = (bf16)f2bf(v1.x); vt[40] = (bf16)f2bf(v1.y); vt[48] = (bf16)f2bf(v1.z); vt[56] = (bf16)f2bf(v1.w); } } } })
    }
};
struct EpiMem {
    static constexpr bool PERM = true, AFTER_DRAIN = false; const FP& P;
    DI void operator()(const f32x4 (&acc)[2][2][4][2], const pg8::Unit& u, int wr, int wc, int fr, int fq) const {
        const int l = u.pn >> 1, half = u.pn & 1;
        EPI_LOOP({ const int n = row / MEM_TOKENS, mt = row % MEM_TOKENS; float* o = P.mem_kv_p + (((size_t)l * BATCH + n) * MEM_TOKENS + mt) * 512 + half * 256 + ct; *(f32x4*)o = v0; *(f32x4*)(o + 4) = v1;
            if (half == 0) *(u32x4*)(P.MK + (((size_t)l * BATCH + n) * MEM_HEADS + (ct >> 6)) * MEM_TOKENS * 64 + ktile_off(mt, ct & 63)) = pk8(v0, v1);
            else { bf16* vt = P.MVT + (((size_t)l * BATCH + n) * MEM_HEADS + (ct >> 6)) * MEM_TOKENS * 64 + vtile_off(ct & 63, mt);
                vt[0] = (bf16)f2bf(v0.x); vt[8] = (bf16)f2bf(v0.y); vt[16] = (bf16)f2bf(v0.z); vt[24] = (bf16)f2bf(v0.w); vt[32] = (bf16)f2bf(v1.x); vt[40] = (bf16)f2bf(v1.y); vt[48] = (bf16)f2bf(v1.z); vt[56] = (bf16)f2bf(v1.w); } })
    }
};
struct EpiPre {
    static constexpr bool PERM = true, AFTER_DRAIN = false; const float* xa; const float* xb; float* pre;
    DI void operator()(const f32x4 (&acc)[2][2][4][2], const pg8::Unit& u, int wr, int wc, int fr, int fq) const {
        EPI_LOOP({ if (row < MP) { const int col = u.pn * 256 + ct; const float* x = (xb && row >= M0) ? xb + (size_t)(row - M0) * D_MODEL + col : xa + (size_t)row * D_MODEL + col;
            const f32x4 a = *(const f32x4*)x, b = *(const f32x4*)(x + 4); float* o = pre + (size_t)row * D_MODEL + col; *(f32x4*)o = a * ALPHA + v0; *(f32x4*)(o + 4) = b * ALPHA + v1; } })
    }
};
struct EpiF32 {
    static constexpr bool PERM = true, AFTER_DRAIN = false; float* out; int ldc; int nrows;
    DI void operator()(const f32x4 (&acc)[2][2][4][2], const pg8::Unit& u, int wr, int wc, int fr, int fq) const {
        EPI_LOOP({ if (row < nrows) { float* o = out + (size_t)row * ldc + u.pn * 256 + ct; *(f32x4*)o = v0; *(f32x4*)(o + 4) = v1; } })
    }
};
}
namespace fx {
struct Tile16 { f32x4 o[4]; float m, l; };
DI void tile_init(Tile16& T) { T.o[0] = T.o[1] = T.o[2] = T.o[3] = (f32x4){0.f, 0.f, 0.f, 0.f}; T.m = -INFINITY; T.l = 0.f; }
typedef __bf16 bf16x2_t __attribute__((ext_vector_type(2)));
DI unsigned cvtpk(float lo, float hi) { const f32x2 v = {lo, hi}; const bf16x2_t b = __builtin_convertvector(v, bf16x2_t); return __builtin_bit_cast(unsigned, b); }
struct KV8 { bf16x8 ka0, ka1, kb0, kb1, v0, v1, v2, v3; };
DI void kv_load(KV8& r, const bf16* k0, const bf16* k1, const bf16* v, long vs16) {
    r.ka0 = *(const bf16x8*)k0; r.ka1 = *(const bf16x8*)(k0 + 32); r.kb0 = *(const bf16x8*)k1; r.kb1 = *(const bf16x8*)(k1 + 32);
    r.v0 = *(const bf16x8*)v; r.v1 = *(const bf16x8*)(v + vs16); r.v2 = *(const bf16x8*)(v + 2 * vs16); r.v3 = *(const bf16x8*)(v + 3 * vs16); }
DI void mk_range(int a, int b, bool ok, int& lo, unsigned& rng) { const bool v = ok && b >= a; lo = v ? a : (1 << 20); rng = v ? (unsigned)(b - a) : 0u; }
DI float colmax(float x) { float a = x, b = x; asm volatile("s_nop 1\n\tv_permlane32_swap_b32 %0, %1" : "+v"(a), "+v"(b)); float m = fmaxf(a, b); a = m; b = m;
    asm volatile("s_nop 1\n\tv_permlane16_swap_b32 %0, %1" : "+v"(a), "+v"(b)); return fmaxf(a, b); }
DI float colsum(float x) { float a = x, b = x; asm volatile("s_nop 1\n\tv_permlane32_swap_b32 %0, %1" : "+v"(a), "+v"(b)); float m = a + b; a = m; b = m;
    asm volatile("s_nop 1\n\tv_permlane16_swap_b32 %0, %1" : "+v"(a), "+v"(b)); return a + b; }
DI void tile_compute(Tile16& T, const bf16x8 (&qf)[2], const KV8& r, int lo, unsigned rng) {
    f32x4 s0 = (f32x4){0.f, 0.f, 0.f, 0.f}, s1 = (f32x4){0.f, 0.f, 0.f, 0.f};
    s0 = __builtin_amdgcn_mfma_f32_16x16x32_bf16(r.ka0, qf[0], s0, 0, 0, 0); s0 = __builtin_amdgcn_mfma_f32_16x16x32_bf16(r.ka1, qf[1], s0, 0, 0, 0);
    s1 = __builtin_amdgcn_mfma_f32_16x16x32_bf16(r.kb0, qf[0], s1, 0, 0, 0); s1 = __builtin_amdgcn_mfma_f32_16x16x32_bf16(r.kb1, qf[1], s1, 0, 0, 0);
    float s[8] = {s0.x, s0.y, s0.z, s0.w, s1.x, s1.y, s1.z, s1.w};
    float mx = -INFINITY;
#pragma unroll
    for (int e = 0; e < 8; ++e) { s[e] = ((unsigned)(e - lo) <= rng) ? s[e] : -INFINITY; mx = fmaxf(mx, s[e]); }
    mx = colmax(mx);
    const float mnew = fmaxf(T.m, mx), muse = (mnew == -INFINITY) ? 0.f : mnew;
    const float alpha = __builtin_amdgcn_exp2f(T.m - muse);
    float ls = 0.f;
#pragma unroll
    for (int e = 0; e < 8; ++e) { s[e] = __builtin_amdgcn_exp2f(s[e] - muse); ls += s[e]; }
    T.l = T.l * alpha + ls; T.m = mnew;
    u32x4 pw; pw.x = cvtpk(s[0], s[1]); pw.y = cvtpk(s[2], s[3]); pw.z = cvtpk(s[4], s[5]); pw.w = cvtpk(s[6], s[7]);
    const bf16x8 pf = __builtin_bit_cast(bf16x8, pw);
    T.o[0] = __builtin_amdgcn_mfma_f32_16x16x32_bf16(r.v0, pf, T.o[0] * alpha, 0, 0, 0); T.o[1] = __builtin_amdgcn_mfma_f32_16x16x32_bf16(r.v1, pf, T.o[1] * alpha, 0, 0, 0);
    T.o[2] = __builtin_amdgcn_mfma_f32_16x16x32_bf16(r.v2, pf, T.o[2] * alpha, 0, 0, 0); T.o[3] = __builtin_amdgcn_mfma_f32_16x16x32_bf16(r.v3, pf, T.o[3] * alpha, 0, 0, 0);
}
template <class BUF, class LD, class CP> DI void pipe2t(int n, LD ld, CP cp) { if (n <= 0) return; BUF A, B; ld(A, 0);
#pragma unroll 1
    for (int i = 0; i < n; i += 2) { ld(B, (i + 1 < n) ? i + 1 : i); cp(A, i); ld(A, (i + 2 < n) ? i + 2 : i); if (i + 1 < n) cp(B, i + 1); } }
template <class LD, class CP> DI void pipe2(int n, LD ld, CP cp) { if (n <= 0) return; KV8 A, B; ld(A, 0);
#pragma unroll 1
    for (int i = 0; i < n; i += 2) { ld(B, (i + 1 < n) ? i + 1 : i); cp(A, i); ld(A, (i + 2 < n) ? i + 2 : i); if (i + 1 < n) cp(B, i + 1); } }
DI void kv_load_t(KV8& r, const bf16* kt, const bf16* vt, int lane) {
    const bf16* k = kt + lane * 8; const bf16* v = vt + lane * 8;
    r.ka0 = *(const bf16x8*)k; r.ka1 = *(const bf16x8*)(k + 512); r.kb0 = *(const bf16x8*)(k + 1024); r.kb1 = *(const bf16x8*)(k + 1536);
    r.v0 = *(const bf16x8*)v; r.v1 = *(const bf16x8*)(v + 512); r.v2 = *(const bf16x8*)(v + 1024); r.v3 = *(const bf16x8*)(v + 1536); }
DI int krow_of(int i, int b) { return 8 * (i >> 2) + 4 * b + (i & 3); }

DI void dil_micro(const FP& P, int n, int h, int t0, int mt, int lane) {
    const int g = mt >> 4, idx = mt & 15, d = dil_d(g), per = 16 / d;
    const int r = idx / per, sub = idx % per, i0 = t0 / d + 16 * sub, ib = i0 - 128, NC = SEQ / d;
    const int q = lane & 15, c = lane >> 4;
    const bf16* Qb = P.QA + ((size_t)g * MPAD + (size_t)n * SEQ) * 256 + h * 64;
    const bf16* Kb = P.KA + ((size_t)(g * BATCH + n) * DIL_HEADS + h) * 64 * SEQ + (size_t)r * NC * 64; const bf16* Vb = P.VTA + ((size_t)(g * BATCH + n) * DIL_HEADS + h) * 64 * SEQ + (size_t)r * NC * 64;
    bf16x8 qf[2]; { const bf16* qp = Qb + (size_t)(r + d * (i0 + q)) * 256 + 8 * c; qf[0] = *(const bf16x8*)qp; qf[1] = *(const bf16x8*)(qp + 32); }
    Tile16 T; tile_init(T);
    const int qi = i0 + q; const int tb0 = ib >> 5  , nblk = ((i0 + 15) >> 5) - tb0 + 1;
    pipe2(nblk, [&](KV8& kv, int i) { int tb = tb0 + i; tb = tb < 0 ? 0 : tb; kv_load_t(kv, Kb + (size_t)tb * 2048, Vb + (size_t)tb * 2048, lane); },
          [&](const KV8& kv, int i) { const int k0 = 32 * (tb0 + i) + 8 * c; int lo; unsigned rng; const int a = qi - (DIL_TAPS - 1); mk_range((a > 0 ? a : 0) - k0, qi - k0, true, lo, rng); tile_compute(T, qf, kv, lo, rng); });
    const int row = n * SEQ + r + d * qi;
    float* op = P.DPART + (((size_t)g * MP + row) * DIL_HEADS + h) * 64 + 4 * c;
#pragma unroll
    for (int db = 0; db < 4; ++db) *(f32x4*)(op + 16 * db) = T.o[db];
    T.l = colsum(T.l);
    if (c == 0) { float* ml = P.DML + (((size_t)g * MP + row) * DIL_HEADS + h) * 2; ml[0] = T.m; ml[1] = T.l; }
}
DI void mem_micro(const FP& P, const bf16* Q  , int ldq, int row0, int layer, int n, int h, bf16* O  , int ldo, int lane) {
    const int q = lane & 15, c = lane >> 4;
    bf16x8 qf[2]; { const bf16* qp = Q + (size_t)(row0 + q) * ldq + 8 * c; qf[0] = *(const bf16x8*)qp; qf[1] = *(const bf16x8*)(qp + 32); }
    const bf16* Kb = P.MK + (((size_t)layer * BATCH + n) * MEM_HEADS + h) * MEM_TOKENS * 64; const bf16* Vb = P.MVT + (((size_t)layer * BATCH + n) * MEM_HEADS + h) * MEM_TOKENS * 64;
    Tile16 T; tile_init(T);
    pipe2(MEM_TOKENS / 32, [&](KV8& kv, int i) { kv_load_t(kv, Kb + (size_t)i * 2048, Vb + (size_t)i * 2048, lane); }, [&](const KV8& kv, int) { tile_compute(T, qf, kv, -8, 64u); });
    const float inv = 1.0f / colsum(T.l); bf16* op = O + (size_t)(row0 + q) * ldo + 4 * c;
#pragma unroll
    for (int db = 0; db < 4; ++db) *(u32x2*)(op + 16 * db) = pk4(T.o[db] * inv);
}
struct Dec { float m, l, o; };
template <class KF, class VF> DI void dec_chunk(Dec& D, const LAS float* q, int nk, KF kf, VF vf, int lane) {
    float s = -INFINITY;
    if (lane < nk) { const float* k = kf(lane); float a = 0.f;
#pragma unroll
        for (int d4 = 0; d4 < 16; ++d4) { const f32x4 kv = *(const f32x4*)(k + 4 * d4); a += kv.x * q[4 * d4] + kv.y * q[4 * d4 + 1] + kv.z * q[4 * d4 + 2] + kv.w * q[4 * d4 + 3]; }
        s = a; }
    const float mx = wave_max(s), mnew = fmaxf(D.m, mx), alpha = __builtin_amdgcn_exp2f(D.m - mnew);
    const float p = (lane < nk) ? __builtin_amdgcn_exp2f(s - mnew) : 0.f;
    D.l = D.l * alpha + wave_sum(p); D.m = mnew; float o = D.o * alpha;
    for (int j0 = 0; j0 < nk; j0 += 8) { float vv[8];
#pragma unroll
        for (int u = 0; u < 8; ++u) { const int jj = (j0 + u < nk) ? j0 + u : nk - 1; vv[u] = vf(jj)[lane]; }
#pragma unroll
        for (int u = 0; u < 8; ++u) { const float pj = (j0 + u < nk) ? __builtin_bit_cast(float, __builtin_amdgcn_readlane(__builtin_bit_cast(int, p), (j0 + u) & 63)) : 0.f; o += pj * vv[u]; } }
    D.o = o;
}
DI float dec_combine(const Ctx& C, const Dec& D) {
    LAS float* cb = (LAS float*)(C.lds + 4096);
    cb[C.wave * 66 + C.lane] = D.o; if (C.lane == 0) { cb[C.wave * 66 + 64] = D.m; cb[C.wave * 66 + 65] = D.l; }
    asm volatile("s_waitcnt lgkmcnt(0)" ::: "memory"); __syncthreads();
    float M = -INFINITY;
#pragma unroll
    for (int ww = 0; ww < NWAVES; ++ww) M = fmaxf(M, cb[ww * 66 + 64]);
    float L = 0.f, o = 0.f;
#pragma unroll
    for (int ww = 0; ww < NWAVES; ++ww) { const float mw = cb[ww * 66 + 64]; const float f = (mw == -INFINITY) ? 0.f : __builtin_amdgcn_exp2f(mw - M); L += f * cb[ww * 66 + 65]; o += f * cb[ww * 66 + C.lane]; }
    return o / L;
}
DI void atta_phase(const FP& P, const Ctx& C) {
    const int lane = C.lane, w = C.wave;
    constexpr int NT = SEQ / 256, NIT = BATCH * NT * DIL_HEADS;
    for (int it = C.vcu; it < NIT; it += C.G) { const int h = it % DIL_HEADS, tt = (it / DIL_HEADS) % NT, n = it / (DIL_HEADS * NT), t0 = tt * 256;
        for (int mt = w; mt < 48; mt += NWAVES) dil_micro(P, n, h, t0, mt, lane);
        asm volatile("s_waitcnt vmcnt(0)" ::: "memory"); __syncthreads();
        for (int i = C.tid; i < 256 * 16; i += NTHREADS) { const int tk = i >> 4, d4 = (i & 15) * 4; const int row = n * SEQ + t0 + tk;
            float mg[3], lg[3]; float M = -INFINITY;
#pragma unroll
            for (int g = 0; g < 3; ++g) { const float* ml = P.DML + (((size_t)g * MP + row) * DIL_HEADS + h) * 2; mg[g] = ml[0]; lg[g] = ml[1]; M = fmaxf(M, mg[g]); }
            f32x4 acc = (f32x4){0.f, 0.f, 0.f, 0.f}; float L = 0.f;
#pragma unroll
            for (int g = 0; g < 3; ++g) { const float wg = __builtin_amdgcn_exp2f(mg[g] - M); L += wg * lg[g]; acc += *(const f32x4*)(P.DPART + (((size_t)g * MP + row) * DIL_HEADS + h) * 64 + d4) * wg; }
            *(u32x2*)(P.ATTA + (size_t)row * 512 + h * 64 + d4) = pk4(acc * (1.0f / L)); }
        for (int mt = w; mt < 16; mt += NWAVES) mem_micro(P, P.MQA + h * 64, 256, n * SEQ + t0 + 16 * mt, 0, n, h, P.ATTA + 256 + h * 64, 512, lane);
        __syncthreads();
    }
    LAS float* qs = (LAS float*)C.lds;
    for (int it = C.vcu; it < DEC_BATCH * DIL_HEADS * 2; it += C.G) { const int kind = it & 1, h = (it >> 1) % DIL_HEADS, ns = (it >> 1) / DIL_HEADS, row = M0 + ns;
        __syncthreads();
        if (kind == 0) { if (C.tid < 192) qs[C.tid] = bf2f(P.QA[((size_t)(C.tid >> 6) * MPAD + row) * 256 + h * 64 + (C.tid & 63)]); } else { if (C.tid < 64) qs[C.tid] = bf2f(P.MQA[(size_t)row * 256 + h * 64 + C.tid]); }
        asm volatile("s_waitcnt lgkmcnt(0)" ::: "memory"); __syncthreads();
        Dec D; D.m = -INFINITY; D.l = 0.f; D.o = 0.f;
        if (kind == 0) { constexpr int CPG = (DIL_TAPS + 63) / 64;
            for (int ck = w; ck < 3 * CPG; ck += NWAVES) { const int g = ck / CPG, j0 = (ck % CPG) * 64; const int W = dil_w(g), d = dil_d(g); const float* cache = sel3c(P.cache_dil, g) + (size_t)ns * W * 512; const float* newrow = sel3(P.dil_s, g) + ((size_t)ns * W + W - 1) * 512;
                const int nk = (DIL_TAPS - j0) < 64 ? (DIL_TAPS - j0) : 64;
                dec_chunk(D, qs + g * 64, nk, [&](int j) { const int tap = j0 + j; return (tap == 0 ? newrow : cache + (size_t)(W - d * tap) * 512) + h * 64; },
                          [&](int j) { const int tap = j0 + j; return (tap == 0 ? newrow : cache + (size_t)(W - d * tap) * 512) + 256 + h * 64; }, lane); } }
        else { const float* mk = P.cache_mem_kv + ((size_t)0 * DEC_BATCH + ns) * MEM_TOKENS * 512;
            for (int ck = w; ck < MEM_TOKENS / 64; ck += NWAVES) { const int j0 = ck * 64; dec_chunk(D, qs, 64, [&](int j) { return mk + (size_t)(j0 + j) * 512 + h * 64; }, [&](int j) { return mk + (size_t)(j0 + j) * 512 + 256 + h * 64; }, lane); } }
        const float o = dec_combine(C, D);
        if (w == 0) P.ATTA[(size_t)row * 512 + (kind == 0 ? 0 : 256) + h * 64 + lane] = (bf16)f2bf(o);
    }
    __syncthreads();
}
DI void ln_phase(const FP& P, const Ctx& C, const float* pre, const float* gam, const float* bet, float* xo, bf16* xb, float* yp, float* ys) {
    const int gw = C.vcu * NWAVES + C.wave, NGW = C.G * NWAVES, lane = C.lane;
    for (int r = gw; r < MP; r += NGW) { const float* x = pre + (size_t)r * D_MODEL; f32x4 v[4]; float s = 0.f;
#pragma unroll
        for (int j = 0; j < 4; ++j) { v[j] = *(const f32x4*)(x + 256 * j + 4 * lane); s += (v[j].x + v[j].y) + (v[j].z + v[j].w); }
        const float mu = wave_sum(s) * (1.0f / D_MODEL); float s2 = 0.f;
#pragma unroll
        for (int j = 0; j < 4; ++j) { v[j] = v[j] - mu; s2 += (v[j].x * v[j].x + v[j].y * v[j].y) + (v[j].z * v[j].z + v[j].w * v[j].w); }
        const float rs = 1.0f / sqrtf(wave_sum(s2) * (1.0f / D_MODEL) + LN_EPS);
#pragma unroll
        for (int j = 0; j < 4; ++j) { const f32x4 gg = *(const f32x4*)(gam + 256 * j + 4 * lane), bb = *(const f32x4*)(bet + 256 * j + 4 * lane); const f32x4 o = v[j] * rs * gg + bb;
            if (xo) *(f32x4*)(xo + (size_t)r * D_MODEL + 256 * j + 4 * lane) = o;
            if (xb) *(u32x2*)(xb + (size_t)r * D_MODEL + 256 * j + 4 * lane) = pk4(o);
            if (yp) { if (r < M0) *(f32x4*)(yp + (size_t)r * D_MODEL + 256 * j + 4 * lane) = o; else *(f32x4*)(ys + (size_t)(r - M0) * D_MODEL + 256 * j + 4 * lane) = o; } }
    }
}
}
namespace fx {
#define INS16(V, I, v_, i_) do { const float _v = (v_); const int _i = (i_); bool _c[16]; _Pragma("unroll") for (int _k = 0; _k < 16; ++_k) _c[_k] = _v > V[_k]; \
    _Pragma("unroll") for (int _k = 15; _k >= 1; --_k) { V[_k] = _c[_k] ? (_c[_k - 1] ? V[_k - 1] : _v) : V[_k]; I[_k] = _c[_k] ? (_c[_k - 1] ? I[_k - 1] : _i) : I[_k]; } \
    V[0] = _c[0] ? _v : V[0]; I[0] = _c[0] ? _i : I[0]; } while (0)
DI void wave_top16_128(float a, float b, int lane, float& outv, int& outi) {
    outv = -INFINITY; outi = 0;
#pragma unroll 1
    for (int k = 0; k < 16; ++k) { const float m = wave_max(fmaxf(a, b)); const unsigned long long ba = __ballot(a == m), bb = __ballot(b == m); int idx;
        if (ba) { const int l = __builtin_ctzll(ba); idx = l; if (lane == l) a = -INFINITY; } else { const int l = __builtin_ctzll(bb); idx = 64 + l; if (lane == l) b = -INFINITY; }
        if (lane == k) { outv = m; outi = idx; } }
}
DI void topk_wave_item(const FP& P, long it, int lane) {
    const float* s = P.SCO + it * 256; float v1, v2; int i1, i2;
    wave_top16_128(s[lane], s[64 + lane], lane, v1, i1); wave_top16_128(s[128 + lane], s[192 + lane], lane, v2, i2);
    int a = 0, rem = lane; bool valid = false;
    for (int aa = 0; aa < 16; ++aa) { const int nb = 16 / (aa + 1); if (!valid) { if (rem < nb) { a = aa; valid = true; } else rem -= nb; } }
    const int b = valid ? rem : 0;
    float cs = __shfl(v1, a) + __shfl(v2, b); const int ce = __shfl(i1, a) * PEER_KEYS + __shfl(i2, b); if (!valid) cs = -INFINITY;
    float tv = -INFINITY; int te = 0;
#pragma unroll 1
    for (int k = 0; k < 16; ++k) { const float m = wave_max(cs); const unsigned long long bm = __ballot(cs == m); const int l = __builtin_ctzll(bm); const int e = __shfl(ce, l); if (lane == l) cs = -INFINITY; if (lane == k) { tv = m; te = e; } }
    const float mx = __shfl(tv, 0); const float ex = (lane < 16) ? __expf(tv - mx) : 0.f; const float z = wave_sum(ex);
    if (lane < 16) { P.SELG[it * 16 + lane] = ex / z; P.SELE[it * 16 + lane] = te; }
}
#define KINS16(V, key_) do { const float _key = (key_); _Pragma("unroll") for (int _k = 15; _k >= 1; --_k) V[_k] = __builtin_amdgcn_fmed3f(V[_k - 1], V[_k], _key); V[0] = fmaxf(V[0], _key); } while (0)
DI float pack_key(float v, unsigned lowbits, unsigned mask) { return __builtin_bit_cast(float, (__builtin_bit_cast(unsigned, v) & ~mask) | lowbits); }
DI void topk_phase(const FP& P, const Ctx& C) {
    const int lane = C.lane; LAS float* st = (LAS float*)(C.lds + C.wave * 16384);
    const int NWI = (M0 * PEER_HEADS) / 64;
    for (int wi = C.vcu * NWAVES + C.wave; wi < NWI; wi += C.G * NWAVES) {
        const long it0 = (long)wi * 64; const long it = it0 + lane;
        float V1[16], V2[16], V3[16];
#pragma unroll
        for (int k = 0; k < 16; ++k) { V1[k] = V2[k] = V3[k] = -INFINITY; }
#pragma unroll 1
        for (int ch = 0; ch < 8; ++ch) {
#pragma unroll
            for (int u = 0; u < 8; ++u) { const int f4 = u * 64 + lane, j = f4 >> 3, q = f4 & 7, hf = q >> 2, c4 = (q & 3) * 4; const long itj = it0 + j;
                const f32x4 v = *(const f32x4*)(P.SCO + itj * 256 + hf * 128 + ch * 16 + c4);
                st[j * 33 + hf * 16 + c4] = v.x; st[j * 33 + hf * 16 + c4 + 1] = v.y; st[j * 33 + hf * 16 + c4 + 2] = v.z; st[j * 33 + hf * 16 + c4 + 3] = v.w; }
            asm volatile("s_waitcnt lgkmcnt(0)" ::: "memory");
#pragma unroll 4
            for (int c = 0; c < 16; ++c) { const float va = st[lane * 33 + c], vb = st[lane * 33 + 16 + c]; const unsigned lb = 127u - (unsigned)(ch * 16 + c); KINS16(V1, pack_key(va, lb, 127u)); KINS16(V2, pack_key(vb, lb, 127u)); }
            asm volatile("s_waitcnt lgkmcnt(0)" ::: "memory");
        }
        LAS int* lc = (LAS int*)st;
        { int ord = 0;
#pragma unroll
          for (int a = 0; a < 16; ++a) { const unsigned ba = __builtin_bit_cast(unsigned, V1[a]); const float va = __builtin_bit_cast(float, ba & ~127u); const int ia = 127 - (int)(ba & 127u);
#pragma unroll
              for (int b = 0; b < 16; ++b) if ((a + 1) * (b + 1) <= 16) { const unsigned bb = __builtin_bit_cast(unsigned, V2[b]); const float vb = __builtin_bit_cast(float, bb & ~127u); const int ib = 127 - (int)(bb & 127u);
                  lc[lane * 51 + ord] = ia * PEER_KEYS + ib; KINS16(V3, pack_key(va + vb, 63u - (unsigned)ord, 63u)); ++ord; } } }
        asm volatile("s_waitcnt lgkmcnt(0)" ::: "memory");
        float g[16]; int e[16]; float z = 0.f; const float vmax = __builtin_bit_cast(float, __builtin_bit_cast(unsigned, V3[0]) & ~63u);
#pragma unroll
        for (int k = 0; k < 16; ++k) { const unsigned bk = __builtin_bit_cast(unsigned, V3[k]); e[k] = lc[lane * 51 + 63 - (int)(bk & 63u)]; g[k] = __expf(__builtin_bit_cast(float, bk & ~63u) - vmax); z += g[k]; }
        const float iz = 1.0f / z;
#pragma unroll
        for (int k4 = 0; k4 < 4; ++k4) { *(f32x4*)(P.SELG + it * 16 + 4 * k4) = (f32x4){g[4 * k4] * iz, g[4 * k4 + 1] * iz, g[4 * k4 + 2] * iz, g[4 * k4 + 3] * iz};
            *(int4*)(P.SELE + it * 16 + 4 * k4) = make_int4(e[4 * k4], e[4 * k4 + 1], e[4 * k4 + 2], e[4 * k4 + 3]); }
        asm volatile("s_waitcnt lgkmcnt(0)" ::: "memory");
    }
    for (int si = C.vcu * NWAVES + C.wave; si < DEC_BATCH * PEER_HEADS; si += C.G * NWAVES) topk_wave_item(P, (long)M0 * PEER_HEADS + si, lane);
    __syncthreads();
}
constexpr float PEER_SU = 256.f, PEER_SV = 64.f;
DI float dot16_fp8(const u32x4& w, const f32x2 (&x2)[8]) { f32x2 a = {0.f, 0.f};
    a += __builtin_amdgcn_cvt_pk_f32_fp8((int)w.x, false) * x2[0]; a += __builtin_amdgcn_cvt_pk_f32_fp8((int)w.x, true) * x2[1];
    a += __builtin_amdgcn_cvt_pk_f32_fp8((int)w.y, false) * x2[2]; a += __builtin_amdgcn_cvt_pk_f32_fp8((int)w.y, true) * x2[3];
    a += __builtin_amdgcn_cvt_pk_f32_fp8((int)w.z, false) * x2[4]; a += __builtin_amdgcn_cvt_pk_f32_fp8((int)w.z, true) * x2[5];
    a += __builtin_amdgcn_cvt_pk_f32_fp8((int)w.w, false) * x2[6]; a += __builtin_amdgcn_cvt_pk_f32_fp8((int)w.w, true) * x2[7];
    return a.x + a.y; }
DI void axpy16_fp8(const u32x4& w, float s, f32x2 (&o2)[8]) { const f32x2 s2 = {s, s};
    o2[0] += __builtin_amdgcn_cvt_pk_f32_fp8((int)w.x, false) * s2; o2[1] += __builtin_amdgcn_cvt_pk_f32_fp8((int)w.x, true) * s2;
    o2[2] += __builtin_amdgcn_cvt_pk_f32_fp8((int)w.y, false) * s2; o2[3] += __builtin_amdgcn_cvt_pk_f32_fp8((int)w.y, true) * s2;
    o2[4] += __builtin_amdgcn_cvt_pk_f32_fp8((int)w.z, false) * s2; o2[5] += __builtin_amdgcn_cvt_pk_f32_fp8((int)w.z, true) * s2;
    o2[6] += __builtin_amdgcn_cvt_pk_f32_fp8((int)w.w, false) * s2; o2[7] += __builtin_amdgcn_cvt_pk_f32_fp8((int)w.w, true) * s2; }
#if defined(PEER_SHARD) || defined(PEER_SHARD2)
#define PEER_FIRST_ROUND nrounds
#else
#define PEER_FIRST_ROUND 0
#endif
template <int CTRL> DI float dppf(float x) { return __builtin_bit_cast(float, __builtin_amdgcn_update_dpp(0, __builtin_bit_cast(int, x), CTRL, 0xF, 0xF, true)); }
DI float rdlane(float v, int l) { return __builtin_bit_cast(float, __builtin_amdgcn_readlane(__builtin_bit_cast(int, v), l)); }
DI void peer_phase(const FP& P, const Ctx& C, int layer, const float* xin, float* fout, float* fout_s, bf16* xb, bool samples_only = false) {
    const int lane = C.lane; const unsigned char* U = P.UB8 + (size_t)layer * PEER_EXPERTS * D_MODEL; const unsigned char* Vt = P.VB8 + (size_t)layer * PEER_EXPERTS * D_MODEL;
    const float* gam = P.ln_g + ((size_t)layer * 2 + 1) * D_MODEL; const float* bet = P.ln_b + ((size_t)layer * 2 + 1) * D_MODEL;
    const int nrounds = (M0 + C.G * NWAVES - 1) / (C.G * NWAVES);
#pragma unroll 1
    for (int rd = samples_only ? nrounds : 0; rd <= nrounds; ++rd) {
        const bool smp = (rd == nrounds); int r = smp ? M0 + C.vcu : rd * C.G * NWAVES + C.vcu * NWAVES + C.wave; if (smp ? (C.vcu >= DEC_BATCH) : (r >= M0)) continue;
        const int pb = smp ? 16 * C.wave : 0, pe = smp ? pb + 16 : 128;
        f32x2 x2[8], o2[8];
#pragma unroll
        for (int j = 0; j < 4; ++j) { const f32x4 a = *(const f32x4*)(xin + (size_t)r * D_MODEL + 16 * lane + 4 * j); x2[2 * j] = (f32x2){a.x, a.y}; x2[2 * j + 1] = (f32x2){a.z, a.w}; }
#pragma unroll
        for (int k = 0; k < 8; ++k) o2[k] = (f32x2){0.f, 0.f};
        const int e_l = P.SELE[(size_t)r * 128 + lane], e_h = P.SELE[(size_t)r * 128 + 64 + lane]; const float g_l = P.SELG[(size_t)r * 128 + lane], g_h = P.SELG[(size_t)r * 128 + 64 + lane];
#pragma unroll 1
        for (int b0 = pb; b0 < pe; b0 += 8) {
            u32x4 uw[8], vw[8];
#pragma unroll
            for (int k = 0; k < 8; ++k) { const int hk = b0 + k; const int e = (hk < 64) ? __builtin_amdgcn_readlane(e_l, hk & 63) : __builtin_amdgcn_readlane(e_h, hk & 63);
                uw[k] = *(const u32x4*)(U + (size_t)e * D_MODEL + 16 * lane); vw[k] = *(const u32x4*)(Vt + (size_t)e * D_MODEL + 16 * lane); }
            float d[8];
#pragma unroll
            for (int k = 0; k < 8; ++k) d[k] = dot16_fp8(uw[k], x2);
            float e4[4], e2[2], e1;
            { const bool hi = lane & 1;
#pragma unroll
              for (int i = 0; i < 4; ++i) { const float keep = hi ? d[4 + i] : d[i], send = hi ? d[i] : d[4 + i]; e4[i] = keep + __shfl_xor(send, 1); } }
            { const bool hi = lane & 2;
#pragma unroll
              for (int i = 0; i < 2; ++i) { const float keep = hi ? e4[2 + i] : e4[i], send = hi ? e4[i] : e4[2 + i]; e2[i] = keep + __shfl_xor(send, 2); } }
            { const bool hi = lane & 4; const float keep = hi ? e2[1] : e2[0], send = hi ? e2[0] : e2[1]; e1 = keep + __shfl_xor(send, 4); }
            e1 += __shfl_xor(e1, 8); e1 += __shfl_xor(e1, 16); e1 += __shfl_xor(e1, 32);
            const int myk = 4 * (lane & 1) + (lane & 2) + ((lane >> 2) & 1); const int myhk = b0 + myk;
            const float myg = (myhk < 64) ? __shfl(g_l, myhk & 63) : __shfl(g_h, myhk & 63);
            const float act = myg * gelu_tanh(e1 * (1.0f / PEER_SU)) * (1.0f / PEER_SV);
#pragma unroll
            for (int k = 0; k < 8; ++k) { const int src = (k >> 2) | (((k >> 1) & 1) << 1) | ((k & 1) << 2); axpy16_fp8(vw[k], rdlane(act, src), o2); }
        }
        if (smp) {
            LAS float* red = (LAS float*)C.lds;
#pragma unroll
            for (int k = 0; k < 8; ++k) { red[C.wave * 1024 + 16 * lane + 2 * k] = o2[k].x; red[C.wave * 1024 + 16 * lane + 2 * k + 1] = o2[k].y; }
            asm volatile("s_waitcnt lgkmcnt(0)" ::: "memory"); __syncthreads();
            if (C.wave == 0) {
#pragma unroll
                for (int k = 0; k < 8; ++k) { float ax = 0.f, ay = 0.f;
#pragma unroll
                    for (int ww = 0; ww < NWAVES; ++ww) { ax += red[ww * 1024 + 16 * lane + 2 * k]; ay += red[ww * 1024 + 16 * lane + 2 * k + 1]; } o2[k] = (f32x2){ax, ay}; } }
            __syncthreads();
            if (C.wave != 0) continue; }
        float s = 0.f;
#pragma unroll
        for (int k = 0; k < 8; ++k) { o2[k] += x2[k] * ALPHA; s += o2[k].x + o2[k].y; }
        const float mu = wave_sum(s) * (1.0f / D_MODEL); float s2 = 0.f;
#pragma unroll
        for (int k = 0; k < 8; ++k) { o2[k] -= mu; s2 += o2[k].x * o2[k].x + o2[k].y * o2[k].y; }
        const float rs = 1.0f / sqrtf(wave_sum(s2) * (1.0f / D_MODEL) + LN_EPS);
        float* frow = (r < M0) ? fout + (size_t)r * D_MODEL : fout_s + (size_t)(r - M0) * D_MODEL;
#pragma unroll
        for (int j = 0; j < 4; ++j) { const int c0 = 16 * lane + 4 * j; const f32x4 gg = *(const f32x4*)(gam + c0), bb = *(const f32x4*)(bet + c0);
            const f32x4 y = (f32x4){o2[2 * j].x * rs, o2[2 * j].y * rs, o2[2 * j + 1].x * rs, o2[2 * j + 1].y * rs} * gg + bb;
            *(f32x4*)(frow + c0) = y; if (xb) *(u32x2*)(xb + (size_t)r * D_MODEL + c0) = pk4(y); }
    }
}
DI void peer_u_phase(const FP& P, const Ctx& C, int layer, const bf16* xb16) {
    const int lane = C.lane; const unsigned char* U = P.UB8 + (size_t)layer * PEER_EXPERTS * D_MODEL;
    const int s = (int)(blockIdx.x & 7), nw = (C.G >> 3) * NWAVES, widx = (int)(blockIdx.x >> 3) * NWAVES + C.wave;
#pragma unroll 1
    for (int r = widx; r < MP; r += nw) {
        const int e0 = P.SELE[(size_t)r * 128 + lane], e1 = P.SELE[(size_t)r * 128 + 64 + lane]; const float g0 = P.SELG[(size_t)r * 128 + lane], g1 = P.SELG[(size_t)r * 128 + 64 + lane];
        unsigned long long b0 = __ballot((e0 >> 11) == s), b1 = __ballot((e1 >> 11) == s);
        if ((b0 | b1) == 0ull) continue;
        f32x2 x2[8]; { const u32x4 xa = *(const u32x4*)(xb16 + (size_t)r * D_MODEL + 16 * lane), xc = *(const u32x4*)(xb16 + (size_t)r * D_MODEL + 16 * lane + 8);
            x2[0] = (f32x2){bflo(xa.x), bfhi(xa.x)}; x2[1] = (f32x2){bflo(xa.y), bfhi(xa.y)}; x2[2] = (f32x2){bflo(xa.z), bfhi(xa.z)}; x2[3] = (f32x2){bflo(xa.w), bfhi(xa.w)};
            x2[4] = (f32x2){bflo(xc.x), bfhi(xc.x)}; x2[5] = (f32x2){bflo(xc.y), bfhi(xc.y)}; x2[6] = (f32x2){bflo(xc.z), bfhi(xc.z)}; x2[7] = (f32x2){bflo(xc.w), bfhi(xc.w)}; }
#pragma unroll 1
        while ((b0 | b1) != 0ull) {
            int hk[8]; u32x4 uw[8]; int nv = 0;
#pragma unroll
            for (int k = 0; k < 8; ++k) { int h;
                if (b0) { h = __builtin_ctzll(b0); b0 &= b0 - 1; ++nv; } else if (b1) { h = 64 + __builtin_ctzll(b1); b1 &= b1 - 1; ++nv; } else h = hk[k > 0 ? k - 1 : 0];
                hk[k] = h; const int e = (h < 64) ? __builtin_amdgcn_readlane(e0, h & 63) : __builtin_amdgcn_readlane(e1, h & 63);
                uw[k] = *(const u32x4*)(U + (size_t)e * D_MODEL + 16 * lane); }
            float d[8];
#pragma unroll
            for (int k = 0; k < 8; ++k) d[k] = dot16_fp8(uw[k], x2);
            float e4[4], e2[2], e1s;
            { const bool hi = lane & 1;
#pragma unroll
              for (int i = 0; i < 4; ++i) { const float keep = hi ? d[4 + i] : d[i], send = hi ? d[i] : d[4 + i]; e4[i] = keep + __shfl_xor(send, 1); } }
            { const bool hi = lane & 2;
#pragma unroll
              for (int i = 0; i < 2; ++i) { const float keep = hi ? e4[2 + i] : e4[i], send = hi ? e4[i] : e4[2 + i]; e2[i] = keep + __shfl_xor(send, 2); } }
            { const bool hi = lane & 4; const float keep = hi ? e2[1] : e2[0], send = hi ? e2[0] : e2[1]; e1s = keep + __shfl_xor(send, 4); }
            e1s += __shfl_xor(e1s, 8); e1s += __shfl_xor(e1s, 16); e1s += __shfl_xor(e1s, 32);
            const int myk = 4 * (lane & 1) + (lane & 2) + ((lane >> 2) & 1);
            int myh = hk[0];
#pragma unroll
            for (int k = 1; k < 8; ++k) myh = (myk == k) ? hk[k] : myh;
            const float ga = __shfl(g0, myh & 63), gb = __shfl(g1, myh & 63); const float myg = (myh < 64) ? ga : gb;
            if (lane < 8 && myk < nv) P.SCO[(size_t)r * 128 + myh] = myg * gelu_tanh(e1s * (1.0f / PEER_SU)) * (1.0f / PEER_SV);
        }
    }
}
DI void peer_v_phase(const FP& P, const Ctx& C, int layer, const float* xin, float* fout, float* fout_s, bf16* xb) {
    const int lane = C.lane; const unsigned char* Vt = P.VB8 + (size_t)layer * PEER_EXPERTS * D_MODEL;
    const float* gam = P.ln_g + ((size_t)layer * 2 + 1) * D_MODEL; const float* bet = P.ln_b + ((size_t)layer * 2 + 1) * D_MODEL;
    const int nrounds = (M0 + C.G * NWAVES - 1) / (C.G * NWAVES);
#pragma unroll 1
    for (int rd = 0; rd <= nrounds; ++rd) {
        const bool smp = (rd == nrounds); int r = smp ? M0 + C.vcu : rd * C.G * NWAVES + C.vcu * NWAVES + C.wave; if (smp ? (C.vcu >= DEC_BATCH) : (r >= M0)) continue;
        const int pb = smp ? 16 * C.wave : 0, pe = smp ? pb + 16 : 128;
        f32x2 x2[8], o2[8];
#pragma unroll
        for (int j = 0; j < 4; ++j) { const f32x4 a = *(const f32x4*)(xin + (size_t)r * D_MODEL + 16 * lane + 4 * j); x2[2 * j] = (f32x2){a.x, a.y}; x2[2 * j + 1] = (f32x2){a.z, a.w}; }
#pragma unroll
        for (int k = 0; k < 8; ++k) o2[k] = (f32x2){0.f, 0.f};
        const int e_l = P.SELE[(size_t)r * 128 + lane], e_h = P.SELE[(size_t)r * 128 + 64 + lane]; const float a_l = P.SCO[(size_t)r * 128 + lane], a_h = P.SCO[(size_t)r * 128 + 64 + lane];
#pragma unroll 1
        for (int b0 = pb; b0 < pe; b0 += 16) { u32x4 vw[16];
#pragma unroll
            for (int k = 0; k < 16; ++k) { const int hk = b0 + k; const int e = (hk < 64) ? __builtin_amdgcn_readlane(e_l, hk & 63) : __builtin_amdgcn_readlane(e_h, hk & 63); vw[k] = *(const u32x4*)(Vt + (size_t)e * D_MODEL + 16 * lane); }
#pragma unroll
            for (int k = 0; k < 16; ++k) { const int hk = b0 + k; axpy16_fp8(vw[k], (hk < 64) ? rdlane(a_l, hk & 63) : rdlane(a_h, hk & 63), o2); } }
        if (smp) {
            LAS float* red = (LAS float*)C.lds;
#pragma unroll
            for (int k = 0; k < 8; ++k) { red[C.wave * 1024 + 16 * lane + 2 * k] = o2[k].x; red[C.wave * 1024 + 16 * lane + 2 * k + 1] = o2[k].y; }
            asm volatile("s_waitcnt lgkmcnt(0)" ::: "memory"); __syncthreads();
            if (C.wave == 0) {
#pragma unroll
                for (int k = 0; k < 8; ++k) { float ax = 0.f, ay = 0.f;
#pragma unroll
                    for (int ww = 0; ww < NWAVES; ++ww) { ax += red[ww * 1024 + 16 * lane + 2 * k]; ay += red[ww * 1024 + 16 * lane + 2 * k + 1]; } o2[k] = (f32x2){ax, ay}; } }
            __syncthreads();
            if (C.wave != 0) continue; }
        float s = 0.f;
#pragma unroll
        for (int k = 0; k < 8; ++k) { o2[k] += x2[k] * ALPHA; s += o2[k].x + o2[k].y; }
        const float mu = wave_sum(s) * (1.0f / D_MODEL); float s2 = 0.f;
#pragma unroll
        for (int k = 0; k < 8; ++k) { o2[k] -= mu; s2 += o2[k].x * o2[k].x + o2[k].y * o2[k].y; }
        const float rs = 1.0f / sqrtf(wave_sum(s2) * (1.0f / D_MODEL) + LN_EPS);
        float* frow = (r < M0) ? fout + (size_t)r * D_MODEL : fout_s + (size_t)(r - M0) * D_MODEL;
#pragma unroll
        for (int j = 0; j < 4; ++j) { const int c0 = 16 * lane + 4 * j; const f32x4 gg = *(const f32x4*)(gam + c0), bb = *(const f32x4*)(bet + c0);
            const f32x4 y = (f32x4){o2[2 * j].x * rs, o2[2 * j].y * rs, o2[2 * j + 1].x * rs, o2[2 * j + 1].y * rs} * gg + bb;
            *(f32x4*)(frow + c0) = y; if (xb) *(u32x2*)(xb + (size_t)r * D_MODEL + c0) = pk4(y); }
    }
}
constexpr int PSH_LIST = 512;
struct PG4 { u32x4 u[4], v[4]; };
DI void peer_sharded_phase(const FP& P, const Ctx& C, int layer, const float* xin, const bf16* xb16, float* fout, float* fout_s, bf16* xb) {
    const int lane = C.lane; const unsigned char* U = P.UB8 + (size_t)layer * PEER_EXPERTS * D_MODEL; const unsigned char* Vt = P.VB8 + (size_t)layer * PEER_EXPERTS * D_MODEL;
    const float* gam = P.ln_g + ((size_t)layer * 2 + 1) * D_MODEL; const float* bet = P.ln_b + ((size_t)layer * 2 + 1) * D_MODEL;
    LAS unsigned char* wl = C.lds + C.wave * 16384; LAS bf16* xs = (LAS bf16*)wl; LAS int* lst = (LAS int*)(wl + 8192);
    const int NW = C.G * NWAVES, gw = C.vcu * NWAVES + C.wave; const int nquads = (M0 / NW) / 4;
#pragma unroll 1
    for (int qd = 0; qd < nquads; ++qd) {
#define PSH_ROW(j) const int row##j = (qd * 4 + j) * NW + gw; const int el##j = P.SELE[(size_t)row##j * 128 + lane], eh##j = P.SELE[(size_t)row##j * 128 + 64 + lane]; const float gl##j = P.SELG[(size_t)row##j * 128 + lane], gh##j = P.SELG[(size_t)row##j * 128 + 64 + lane]; \
        { const u32x4 xa = *(const u32x4*)(xb16 + (size_t)row##j * D_MODEL + 16 * lane), xc = *(const u32x4*)(xb16 + (size_t)row##j * D_MODEL + 16 * lane + 8); *(LAS u32x4*)(xs + j * 1024 + 16 * lane) = xa; *(LAS u32x4*)(xs + j * 1024 + 16 * lane + 8) = xc; } \
        f32x2 oa##j[8]; _Pragma("unroll") for (int k = 0; k < 8; ++k) oa##j[k] = (f32x2){0.f, 0.f};
        PSH_ROW(0) PSH_ROW(1) PSH_ROW(2) PSH_ROW(3)
#pragma unroll 1
        for (int s = 0; s < 16; ++s) {
            int n = 0;
#define PSH_SCAN(j) { unsigned long long b0 = __ballot((el##j >> 10) == s), b1 = __ballot((eh##j >> 10) == s); \
                while (b0) { const int h = __builtin_ctzll(b0); b0 &= b0 - 1; const int e = __builtin_amdgcn_readlane(el##j, h); const int g = __builtin_amdgcn_readlane(__builtin_bit_cast(int, gl##j), h); \
                    if (lane == 0) { lst[4 * n] = e; lst[4 * n + 1] = g; lst[4 * n + 2] = j; } ++n; } \
                while (b1) { const int h = __builtin_ctzll(b1); b1 &= b1 - 1; const int e = __builtin_amdgcn_readlane(eh##j, h); const int g = __builtin_amdgcn_readlane(__builtin_bit_cast(int, gh##j), h); \
                    if (lane == 0) { lst[4 * n] = e; lst[4 * n + 1] = g; lst[4 * n + 2] = j; } ++n; } }
            PSH_SCAN(0) PSH_SCAN(1) PSH_SCAN(2) PSH_SCAN(3)
            asm volatile("s_waitcnt lgkmcnt(0)" ::: "memory");
            if (n == 0) continue;
            const int ngrp = (n + 3) >> 2;
#define PSH_LD(b, gi_) do { const int gi = (gi_); _Pragma("unroll") for (int k = 0; k < 4; ++k) { int i = 4 * gi + k; i = i < n ? i : n - 1; const int e = __builtin_amdgcn_readfirstlane(lst[4 * i]); \
                b.u[k] = *(const u32x4*)(U + (size_t)e * D_MODEL + 16 * lane); b.v[k] = *(const u32x4*)(Vt + (size_t)e * D_MODEL + 16 * lane); } } while (0)
#define PSH_CP(b, gi_) do { const int gi = (gi_); float d[4]; int jj[4]; float gg[4]; \
                _Pragma("unroll") for (int k = 0; k < 4; ++k) { int i = 4 * gi + k; const bool val = i < n; i = val ? i : n - 1; jj[k] = __builtin_amdgcn_readfirstlane(lst[4 * i + 2]); gg[k] = val ? __builtin_bit_cast(float, __builtin_amdgcn_readfirstlane(lst[4 * i + 1])) : 0.f; \
                    const u32x4 xa = *(const LAS u32x4*)(xs + jj[k] * 1024 + 16 * lane), xc = *(const LAS u32x4*)(xs + jj[k] * 1024 + 16 * lane + 8); \
                    const f32x2 x2[8] = {(f32x2){bflo(xa.x), bfhi(xa.x)}, (f32x2){bflo(xa.y), bfhi(xa.y)}, (f32x2){bflo(xa.z), bfhi(xa.z)}, (f32x2){bflo(xa.w), bfhi(xa.w)}, (f32x2){bflo(xc.x), bfhi(xc.x)}, (f32x2){bflo(xc.y), bfhi(xc.y)}, (f32x2){bflo(xc.z), bfhi(xc.z)}, (f32x2){bflo(xc.w), bfhi(xc.w)}}; \
                    d[k] = dot16_fp8(b.u[k], x2); } \
                float e2[2], e1; \
                { const bool hi = lane & 1; _Pragma("unroll") for (int i = 0; i < 2; ++i) { const float keep = hi ? d[2 + i] : d[i], send = hi ? d[i] : d[2 + i]; e2[i] = keep + __shfl_xor(send, 1); } } \
                { const bool hi = lane & 2; const float keep = hi ? e2[1] : e2[0], send = hi ? e2[0] : e2[1]; e1 = keep + __shfl_xor(send, 2); } \
                e1 += __shfl_xor(e1, 4); e1 += __shfl_xor(e1, 8); e1 += __shfl_xor(e1, 16); e1 += __shfl_xor(e1, 32); \
                const int myk = 2 * (lane & 1) + ((lane >> 1) & 1); \
                float myg = gg[0]; myg = (myk == 1) ? gg[1] : myg; myg = (myk == 2) ? gg[2] : myg; myg = (myk == 3) ? gg[3] : myg; \
                const float act = myg * gelu_tanh(e1 * (1.0f / PEER_SU)) * (1.0f / PEER_SV); \
                _Pragma("unroll") for (int k = 0; k < 4; ++k) { const float a = rdlane(act, (k >> 1) | ((k & 1) << 1)); \
                    if (jj[k] == 0) axpy16_fp8(b.v[k], a, oa0); else if (jj[k] == 1) axpy16_fp8(b.v[k], a, oa1); else if (jj[k] == 2) axpy16_fp8(b.v[k], a, oa2); else axpy16_fp8(b.v[k], a, oa3); } } while (0)
            { PG4 A, B; PSH_LD(A, 0);
#pragma unroll 1
              for (int g2 = 0; g2 < ngrp; g2 += 2) { PSH_LD(B, (g2 + 1 < ngrp) ? g2 + 1 : g2); PSH_CP(A, g2); PSH_LD(A, (g2 + 2 < ngrp) ? g2 + 2 : g2); if (g2 + 1 < ngrp) PSH_CP(B, g2 + 1); } }
            asm volatile("s_waitcnt lgkmcnt(0)" ::: "memory");
        }
#define PSH_LN(j) { const int r = row##j; f32x2 x2[8]; \
            _Pragma("unroll") for (int q = 0; q < 4; ++q) { const f32x4 a = *(const f32x4*)(xin + (size_t)r * D_MODEL + 16 * lane + 4 * q); x2[2 * q] = (f32x2){a.x, a.y}; x2[2 * q + 1] = (f32x2){a.z, a.w}; } \
            float sm = 0.f; _Pragma("unroll") for (int k = 0; k < 8; ++k) { oa##j[k] += x2[k] * ALPHA; sm += oa##j[k].x + oa##j[k].y; } \
            const float mu = wave_sum(sm) * (1.0f / D_MODEL); float s2 = 0.f; _Pragma("unroll") for (int k = 0; k < 8; ++k) { oa##j[k] -= mu; s2 += oa##j[k].x * oa##j[k].x + oa##j[k].y * oa##j[k].y; } \
            const float rs = 1.0f / sqrtf(wave_sum(s2) * (1.0f / D_MODEL) + LN_EPS); float* frow = fout + (size_t)r * D_MODEL; \
            _Pragma("unroll") for (int q = 0; q < 4; ++q) { const int c0 = 16 * lane + 4 * q; const f32x4 gv = *(const f32x4*)(gam + c0), bv = *(const f32x4*)(bet + c0); \
                const f32x4 y = (f32x4){oa##j[2 * q].x * rs, oa##j[2 * q].y * rs, oa##j[2 * q + 1].x * rs, oa##j[2 * q + 1].y * rs} * gv + bv; *(f32x4*)(frow + c0) = y; if (xb) *(u32x2*)(xb + (size_t)r * D_MODEL + c0) = pk4(y); } }
        PSH_LN(0) PSH_LN(1) PSH_LN(2) PSH_LN(3)
        asm volatile("s_waitcnt lgkmcnt(0)" ::: "memory");
    }
}
constexpr int PSH_LOG = 11, PSH_N = PEER_EXPERTS >> PSH_LOG;
#ifndef PS2_ROWS
#define PS2_ROWS 4
#endif
#define PS2_ROW(j) const int row##j = (qd * PS2_ROWS + j) * NW + gw; const int el##j = P.SELE[(size_t)row##j * 128 + lane], eh##j = P.SELE[(size_t)row##j * 128 + 64 + lane]; const float gl##j = P.SELG[(size_t)row##j * 128 + lane], gh##j = P.SELG[(size_t)row##j * 128 + 64 + lane]; \
    f32x2 oa##j[8]; _Pragma("unroll") for (int k = 0; k < 8; ++k) oa##j[k] = (f32x2){0.f, 0.f};
#define PS2_STEP(j) { unsigned long long b0 = __ballot((el##j >> PSH_LOG) == s), b1 = __ballot((eh##j >> PSH_LOG) == s); \
    if (b0 | b1) { const u32x4 xa##j = *(const u32x4*)(xb16 + (size_t)row##j * D_MODEL + 16 * lane), xc##j = *(const u32x4*)(xb16 + (size_t)row##j * D_MODEL + 16 * lane + 8);     \
      const f32x2 x2[8] = {(f32x2){bflo(xa##j.x), bfhi(xa##j.x)}, (f32x2){bflo(xa##j.y), bfhi(xa##j.y)}, (f32x2){bflo(xa##j.z), bfhi(xa##j.z)}, (f32x2){bflo(xa##j.w), bfhi(xa##j.w)}, (f32x2){bflo(xc##j.x), bfhi(xc##j.x)}, (f32x2){bflo(xc##j.y), bfhi(xc##j.y)}, (f32x2){bflo(xc##j.z), bfhi(xc##j.z)}, (f32x2){bflo(xc##j.w), bfhi(xc##j.w)}}; \
      _Pragma("unroll 1") while ((b0 | b1) != 0ull) { int hk[8]; u32x4 uw[8], vw[8]; int nv = 0; \
        _Pragma("unroll") for (int k = 0; k < 8; ++k) { int h; if (b0) { h = __builtin_ctzll(b0); b0 &= b0 - 1; ++nv; } else if (b1) { h = 64 + __builtin_ctzll(b1); b1 &= b1 - 1; ++nv; } else h = hk[k > 0 ? k - 1 : 0]; \
            hk[k] = h; const int e = (h < 64) ? __builtin_amdgcn_readlane(el##j, h & 63) : __builtin_amdgcn_readlane(eh##j, h & 63); \
            uw[k] = *(const u32x4*)(U + (size_t)e * D_MODEL + 16 * lane); vw[k] = *(const u32x4*)(Vt + (size_t)e * D_MODEL + 16 * lane); } \
        float d[8]; _Pragma("unroll") for (int k = 0; k < 8; ++k) d[k] = dot16_fp8(uw[k], x2); \
        float e4[4], e2[2], e1s; \
          \
        { const bool hi = lane & 1; _Pragma("unroll") for (int i = 0; i < 4; ++i) { const float keep = hi ? d[4 + i] : d[i], send = hi ? d[i] : d[4 + i]; e4[i] = keep + dppf<0xB1>(send); } } \
        { const bool hi = lane & 2; _Pragma("unroll") for (int i = 0; i < 2; ++i) { const float keep = hi ? e4[2 + i] : e4[i], send = hi ? e4[i] : e4[2 + i]; e2[i] = keep + dppf<0x4E>(send); } } \
        { const bool hi = lane & 4; const float keep = hi ? e2[1] : e2[0], send = hi ? e2[0] : e2[1]; const float r4 = dppf<0x124>(send), r12 = dppf<0x12C>(send); e1s = keep + (hi ? r4 : r12); } \
        e1s += dppf<0x128>(e1s); e1s = colsum(e1s); \
        const int myk = 4 * (lane & 1) + (lane & 2) + ((lane >> 2) & 1); int myh = hk[0]; _Pragma("unroll") for (int k = 1; k < 8; ++k) myh = (myk == k) ? hk[k] : myh; \
        const float ga = __shfl(gl##j, myh & 63), gb = __shfl(gh##j, myh & 63); const float myg = (myk < nv) ? ((myh < 64) ? ga : gb) : 0.f;     \
        const float act = myg * gelu_tanh(e1s * (1.0f / PEER_SU)) * (1.0f / PEER_SV); \
        _Pragma("unroll") for (int k = 0; k < 8; ++k) { const int src = (k >> 2) | (((k >> 1) & 1) << 1) | ((k & 1) << 2); axpy16_fp8(vw[k], rdlane(act, src), oa##j); } } } }
#define PS2_LN(j) { const int r = row##j; f32x2 x2[8]; int ll = lane; asm volatile("" : "+v"(ll));     \
    _Pragma("unroll") for (int q = 0; q < 4; ++q) { const f32x4 a = *(const f32x4*)(xin + (size_t)r * D_MODEL + 16 * ll + 4 * q); x2[2 * q] = (f32x2){a.x, a.y}; x2[2 * q + 1] = (f32x2){a.z, a.w}; } \
    float sm = 0.f; _Pragma("unroll") for (int k = 0; k < 8; ++k) { oa##j[k] += x2[k] * ALPHA; sm += oa##j[k].x + oa##j[k].y; } \
    const float mu = wave_sum(sm) * (1.0f / D_MODEL); float s2 = 0.f; _Pragma("unroll") for (int k = 0; k < 8; ++k) { oa##j[k] -= mu; s2 += oa##j[k].x * oa##j[k].x + oa##j[k].y * oa##j[k].y; } \
    const float rs = 1.0f / sqrtf(wave_sum(s2) * (1.0f / D_MODEL) + LN_EPS); float* frow = fout + (size_t)r * D_MODEL; \
    _Pragma("unroll") for (int q = 0; q < 4; ++q) { const int c0 = 16 * ll + 4 * q; const f32x4 gv = *(const f32x4*)(gam + c0), bv = *(const f32x4*)(bet + c0); \
        const f32x4 y = (f32x4){oa##j[2 * q].x * rs, oa##j[2 * q].y * rs, oa##j[2 * q + 1].x * rs, oa##j[2 * q + 1].y * rs} * gv + bv; *(f32x4*)(frow + c0) = y; if (xb) *(u32x2*)(xb + (size_t)r * D_MODEL + c0) = pk4(y); } }
DI void peer_sharded2_phase(const FP& P, const Ctx& C, int layer, const float* xin, const bf16* xb16, float* fout, bf16* xb) {
    const int lane = C.lane; const unsigned char* U = P.UB8 + (size_t)layer * PEER_EXPERTS * D_MODEL; const unsigned char* Vt = P.VB8 + (size_t)layer * PEER_EXPERTS * D_MODEL;
    const float* gam = P.ln_g + ((size_t)layer * 2 + 1) * D_MODEL; const float* bet = P.ln_b + ((size_t)layer * 2 + 1) * D_MODEL;
    const int NW = C.G * NWAVES, gw = C.vcu * NWAVES + C.wave; const int nquads = (M0 / NW) / PS2_ROWS;
#pragma unroll 1
    for (int qd = 0; qd < nquads; ++qd) {
#if PS2_ROWS == 4
        PS2_ROW(0) PS2_ROW(1) PS2_ROW(2) PS2_ROW(3)
#pragma unroll 1
        for (int s = 0; s < PSH_N; ++s) { PS2_STEP(0) PS2_STEP(1) PS2_STEP(2) PS2_STEP(3) }
        PS2_LN(0) PS2_LN(1) PS2_LN(2) PS2_LN(3)
#else
        PS2_ROW(0) PS2_ROW(1)
#pragma unroll 1
        for (int s = 0; s < PSH_N; ++s) { PS2_STEP(0) PS2_STEP(1) }
        PS2_LN(0) PS2_LN(1)
#endif
    }
}
#define PS3_ROW(j) const int row##j = (qd * 4 + j) * NW + gw; const int el##j = P.SELE[(size_t)row##j * 128 + lane], eh##j = P.SELE[(size_t)row##j * 128 + 64 + lane]; \
    { const u32x4 xa = *(const u32x4*)(xb16 + (size_t)row##j * D_MODEL + 16 * lane), xc = *(const u32x4*)(xb16 + (size_t)row##j * D_MODEL + 16 * lane + 8); *(LAS u32x4*)(xs + j * 1024 + 16 * lane) = xa; *(LAS u32x4*)(xs + j * 1024 + 16 * lane + 8) = xc; } \
    f32x2 oa##j[8]; _Pragma("unroll") for (int k = 0; k < 8; ++k) oa##j[k] = (f32x2){0.f, 0.f};
#define PS3_X2_UNUSED(j) const f32x2 x2[8] = {(f32x2){bflo(xa##j.x), bfhi(xa##j.x)}, (f32x2){bflo(xa##j.y), bfhi(xa##j.y)}, (f32x2){bflo(xa##j.z), bfhi(xa##j.z)}, (f32x2){bflo(xa##j.w), bfhi(xa##j.w)}, (f32x2){bflo(xc##j.x), bfhi(xc##j.x)}, (f32x2){bflo(xc##j.y), bfhi(xc##j.y)}, (f32x2){bflo(xc##j.z), bfhi(xc##j.z)}, (f32x2){bflo(xc##j.w), bfhi(xc##j.w)}};
#define PS3_TAKE(q, M, ELH, GOFF) if (!got && M) { const int h = __builtin_ctzll(M); M &= M - 1; qq[k] = q; ee = __builtin_amdgcn_readlane(ELH, h); gk[k] = P.SELG[GOFF + h];     got = true; ++nv; }
DI void peer_sharded3_phase(const FP& P, const Ctx& C, int layer, const float* xin, const bf16* xb16, float* fout, bf16* xb) {
    const int lane = C.lane; const unsigned char* U = P.UB8 + (size_t)layer * PEER_EXPERTS * D_MODEL; const unsigned char* Vt = P.VB8 + (size_t)layer * PEER_EXPERTS * D_MODEL;
    const float* gam = P.ln_g + ((size_t)layer * 2 + 1) * D_MODEL; const float* bet = P.ln_b + ((size_t)layer * 2 + 1) * D_MODEL;
    const int NW = C.G * NWAVES, gw = C.vcu * NWAVES + C.wave; const int nquads = (M0 / NW) / 4; LAS bf16* xs = (LAS bf16*)(C.lds + C.wave * 16384);
#pragma unroll 1
    for (int qd = 0; qd < nquads; ++qd) {
        PS3_ROW(0) PS3_ROW(1) PS3_ROW(2) PS3_ROW(3)
        asm volatile("s_waitcnt lgkmcnt(0)" ::: "memory");
#pragma unroll 1
        for (int s = 0; s < PSH_N; ++s) {
            unsigned long long m0 = __ballot((el0 >> PSH_LOG) == s), m1 = __ballot((eh0 >> PSH_LOG) == s), m2 = __ballot((el1 >> PSH_LOG) == s), m3 = __ballot((eh1 >> PSH_LOG) == s),
                               m4 = __ballot((el2 >> PSH_LOG) == s), m5 = __ballot((eh2 >> PSH_LOG) == s), m6 = __ballot((el3 >> PSH_LOG) == s), m7 = __ballot((eh3 >> PSH_LOG) == s);
#pragma unroll 1
            while ((m0 | m1 | m2 | m3 | m4 | m5 | m6 | m7) != 0ull) {
                int qq[8]; float gk[8]; int es[8]; u32x4 uw[8]; int nv = 0; int elast = 0;
#pragma unroll
                for (int k = 0; k < 8; ++k) { bool got = false; int ee = elast; qq[k] = k > 0 ? qq[k - 1] : 0; gk[k] = 0.f;
                    PS3_TAKE(0, m0, el0, (size_t)row0 * 128) PS3_TAKE(1, m1, eh0, (size_t)row0 * 128 + 64) PS3_TAKE(2, m2, el1, (size_t)row1 * 128) PS3_TAKE(3, m3, eh1, (size_t)row1 * 128 + 64) PS3_TAKE(4, m4, el2, (size_t)row2 * 128) PS3_TAKE(5, m5, eh2, (size_t)row2 * 128 + 64) PS3_TAKE(6, m6, el3, (size_t)row3 * 128) PS3_TAKE(7, m7, eh3, (size_t)row3 * 128 + 64)
                    elast = ee; es[k] = ee; uw[k] = *(const u32x4*)(U + (size_t)ee * D_MODEL + 16 * lane); }
                float d[8];
#pragma unroll
                for (int k = 0; k < 8; ++k) { const int j = qq[k] >> 1; const u32x4 xa = *(const LAS u32x4*)(xs + j * 1024 + 16 * lane), xc = *(const LAS u32x4*)(xs + j * 1024 + 16 * lane + 8);
                    const f32x2 x2[8] = {(f32x2){bflo(xa.x), bfhi(xa.x)}, (f32x2){bflo(xa.y), bfhi(xa.y)}, (f32x2){bflo(xa.z), bfhi(xa.z)}, (f32x2){bflo(xa.w), bfhi(xa.w)}, (f32x2){bflo(xc.x), bfhi(xc.x)}, (f32x2){bflo(xc.y), bfhi(xc.y)}, (f32x2){bflo(xc.z), bfhi(xc.z)}, (f32x2){bflo(xc.w), bfhi(xc.w)}};
                    d[k] = dot16_fp8(uw[k], x2); }
                u32x4 vw[8];
#pragma unroll
                for (int k = 0; k < 8; ++k) vw[k] = *(const u32x4*)(Vt + (size_t)es[k] * D_MODEL + 16 * lane);
                float e4[4], e2[2], e1s;
                { const bool hi = lane & 1;
#pragma unroll
                  for (int i = 0; i < 4; ++i) { const float keep = hi ? d[4 + i] : d[i], send = hi ? d[i] : d[4 + i]; e4[i] = keep + __shfl_xor(send, 1); } }
                { const bool hi = lane & 2;
#pragma unroll
                  for (int i = 0; i < 2; ++i) { const float keep = hi ? e4[2 + i] : e4[i], send = hi ? e4[i] : e4[2 + i]; e2[i] = keep + __shfl_xor(send, 2); } }
                { const bool hi = lane & 4; const float keep = hi ? e2[1] : e2[0], send = hi ? e2[0] : e2[1]; e1s = keep + __shfl_xor(send, 4); }
                e1s += __shfl_xor(e1s, 8); e1s += __shfl_xor(e1s, 16); e1s += __shfl_xor(e1s, 32);
                const int myk = 4 * (lane & 1) + (lane & 2) + ((lane >> 2) & 1); float myg = gk[0];
#pragma unroll
                for (int k = 1; k < 8; ++k) myg = (myk == k) ? gk[k] : myg;
                const float act = myg * gelu_tanh(e1s * (1.0f / PEER_SU)) * (1.0f / PEER_SV);
#pragma unroll
                for (int k = 0; k < 8; ++k) { const int src = (k >> 2) | (((k >> 1) & 1) << 1) | ((k & 1) << 2); const float a = rdlane(act, src); const int j = qq[k] >> 1;
                    if (j == 0) { asm volatile("" ::: "memory"); axpy16_fp8(vw[k], a, oa0); } else if (j == 1) { asm volatile("" ::: "memory"); axpy16_fp8(vw[k], a, oa1); } else if (j == 2) { asm volatile("" ::: "memory"); axpy16_fp8(vw[k], a, oa2); } else { asm volatile("" ::: "memory"); axpy16_fp8(vw[k], a, oa3); } }
            }
        }
        PS2_LN(0) PS2_LN(1) PS2_LN(2) PS2_LN(3)
    }
}
}
namespace fx {
struct EpiB {
    static constexpr bool PERM = true, AFTER_DRAIN = false; const FP& P;
    DI void operator()(const f32x4 (&acc)[2][2][4][2], const pg8::Unit& u, int wr, int wc, int fr, int fq) const {
        const int t = u.pn;
        EPI_LOOP({ if (row < MP) { const int pos = row_pos(row), n = row / SEQ, e = ct & 63, dp = e >> 1; const bool prm = row < M0;
            if (t < 3) { const int ty = 2 * t + (ct >> 7), kvh = (ct >> 6) & 1;
                if (ty == 2 || ty == 4) { f32x4 lo, hi; rope4(P.ROPE + pos * 64, dp, v0, v1, lo, hi);
                    if (ty == 2) { float* o = (prm ? P.nsa_kv_p + (size_t)row * 512 : P.nsa_kv_s + (size_t)(row - M0) * 512) + 256 + kvh * 64 + dp; *(f32x4*)o = lo; *(f32x4*)(o + 32) = hi;
                        if (prm) { bf16* kt = P.SLK + ((size_t)n * NSA_KV_HEADS + kvh) * SEQ * 64; *(u32x2*)(kt + ktile_off(pos, dp)) = pk4(lo); *(u32x2*)(kt + ktile_off(pos, dp + 32)) = pk4(hi); } }
                    else { float* o = nullptr; if (!prm) o = P.win_s + (((size_t)(row - M0) * SWA_WINDOW + SWA_WINDOW - 1) * 2 + 0) * 128; else if (pos >= SEQ - SWA_WINDOW) o = P.win_p + (((size_t)n * SWA_WINDOW + pos - (SEQ - SWA_WINDOW)) * 2 + 0) * 128;
                        if (o) { *(f32x4*)(o + kvh * 64 + dp) = lo; *(f32x4*)(o + kvh * 64 + 32 + dp) = hi; }
                        if (prm) { bf16* kt = P.WNK + ((size_t)n * NSA_KV_HEADS + kvh) * SEQ * 64; *(u32x2*)(kt + ktile_off(pos, dp)) = pk4(lo); *(u32x2*)(kt + ktile_off(pos, dp + 32)) = pk4(hi); } } }
                else if (ty < 4) { float* o = (prm ? P.nsa_kv_p + (size_t)row * 512 : P.nsa_kv_s + (size_t)(row - M0) * 512) + ty * 128 + kvh * 64 + e; *(f32x4*)o = v0; *(f32x4*)(o + 4) = v1;
                    if (prm) { if (ty < 2) *(u32x4*)(P.AC + ((size_t)ty * ACROWS + ((size_t)n * NSA_KV_HEADS + kvh) * NCH + pos / 16) * 1024 + (pos % 16) * 64 + e) = pk8(v0, v1);
                        else { bf16* vt = P.SLVT + ((size_t)n * NSA_KV_HEADS + kvh) * SEQ * 64 + vtile_off(e, pos);
                            vt[0] = (bf16)f2bf(v0.x); vt[8] = (bf16)f2bf(v0.y); vt[16] = (bf16)f2bf(v0.z); vt[24] = (bf16)f2bf(v0.w); vt[32] = (bf16)f2bf(v1.x); vt[40] = (bf16)f2bf(v1.y); vt[48] = (bf16)f2bf(v1.z); vt[56] = (bf16)f2bf(v1.w); } } }
                else { float* o = nullptr; if (!prm) o = P.win_s + (((size_t)(row - M0) * SWA_WINDOW + SWA_WINDOW - 1) * 2 + 1) * 128; else if (pos >= SEQ - SWA_WINDOW) o = P.win_p + (((size_t)n * SWA_WINDOW + pos - (SEQ - SWA_WINDOW)) * 2 + 1) * 128;
                    if (o) { *(f32x4*)(o + kvh * 64 + e) = v0; *(f32x4*)(o + kvh * 64 + e + 4) = v1; }
                    if (prm) { bf16* vt = P.WNVT + ((size_t)n * NSA_KV_HEADS + kvh) * SEQ * 64 + vtile_off(e, pos);
                        vt[0] = (bf16)f2bf(v0.x); vt[8] = (bf16)f2bf(v0.y); vt[16] = (bf16)f2bf(v0.z); vt[24] = (bf16)f2bf(v0.w); vt[32] = (bf16)f2bf(v1.x); vt[40] = (bf16)f2bf(v1.y); vt[48] = (bf16)f2bf(v1.z); vt[56] = (bf16)f2bf(v1.w); } } }
            else if (t < 6) { const int h = (t - 3) * 4 + (ct >> 6); f32x4 lo, hi; rope4(P.ROPE + pos * 64, dp, v0, v1, lo, hi); bf16* q = P.QB + (size_t)row * NSA_Q_COLS + h * 64 + dp; *(u32x2*)q = pk4(lo * QSCALE); *(u32x2*)(q + 32) = pk4(hi * QSCALE); }
            else if (t == 6) { *(u32x4*)(P.MQB + (size_t)row * 256 + ct) = pk8(v0 * QSCALE, v1 * QSCALE); }
            else if (ct < 40) { const float vv[8] = {v0.x, v0.y, v0.z, v0.w, v1.x, v1.y, v1.z, v1.w};
                _Pragma("unroll") for (int i = 0; i < 8; ++i) if (ct + i < NSA_GATE_COLS) P.GATES[(size_t)row * 64 + ct + i] = 1.0f / (1.0f + __expf(-vv[i])); } } })
    }
};
DI void cmp2_phase(const FP& P, const Ctx& C) {
    const int lane = C.lane; LAS float* hs = (LAS float*)(C.lds + C.wave * 1024);
    constexpr int NGRP = NCTX * 2 * NSA_KV_HEADS; const int NW = C.G * NWAVES, WPG = NW / NGRP > 0 ? NW / NGRP : 1; const int gw = C.vcu * NWAVES + C.wave;
#pragma unroll 1
    for (int grp = gw / WPG; grp < NGRP; grp += (NW + WPG - 1) / WPG) { const int slot = gw % WPG; if (gw >= (NW / WPG) * WPG && grp == gw / WPG) break;
        const int kvh = grp % NSA_KV_HEADS, ty = (grp / NSA_KV_HEADS) % 2, ctx = grp / (2 * NSA_KV_HEADS);
        const float* UL = P.UL + ((size_t)ty * ACROWS + ((size_t)ctx * NSA_KV_HEADS + kvh) * NCH) * 256; const float* w2 = P.cmp_w2 + (size_t)ty * CMP_HIDDEN * HEAD_DIM;
        float w2r[CMP_HIDDEN];
#pragma unroll
        for (int k = 0; k < CMP_HIDDEN; ++k) w2r[k] = w2[k * HEAD_DIM + lane];
        const float b0 = P.CBIAS[ty * CMP_HIDDEN + lane], b1 = P.CBIAS[ty * CMP_HIDDEN + 64 + lane];
        float u0, u1, l0, l1; int c = slot;
        if (c < NCMP) { u0 = UL[(size_t)c * 256 + lane]; u1 = UL[(size_t)c * 256 + 64 + lane]; l0 = UL[(size_t)(c + 1) * 256 + 128 + lane]; l1 = UL[(size_t)(c + 1) * 256 + 192 + lane]; }
#pragma unroll 1
        for (; c < NCMP; c += WPG) { const float h0 = gelu_tanh(u0 + l0 + b0), h1 = gelu_tanh(u1 + l1 + b1); const int cn = c + WPG;
            if (cn < NCMP) { u0 = UL[(size_t)cn * 256 + lane]; u1 = UL[(size_t)cn * 256 + 64 + lane]; l0 = UL[(size_t)(cn + 1) * 256 + 128 + lane]; l1 = UL[(size_t)(cn + 1) * 256 + 192 + lane]; }
            hs[lane] = h0; hs[64 + lane] = h1; asm volatile("s_waitcnt lgkmcnt(0)" ::: "memory");
            float a = 0.f;
#pragma unroll
            for (int k4 = 0; k4 < CMP_HIDDEN / 4; ++k4) { const f32x4 hv = *(const LAS f32x4*)(hs + 4 * k4); a += hv.x * w2r[4 * k4] + hv.y * w2r[4 * k4 + 1] + hv.z * w2r[4 * k4 + 2] + hv.w * w2r[4 * k4 + 3]; }
            if (ty == 0) { const float other = __shfl_xor(a, 32); const int pos = c * CMP_STRIDE + CMP_BLOCK - 1; const float cs = P.ROPE[pos * 64 + (lane & 31)], sn = P.ROPE[pos * 64 + 32 + (lane & 31)];
                a = (lane < 32) ? a * cs - other * sn : a * cs + other * sn; }
            if (ctx < BATCH) { if (ty == 0) P.CK[((size_t)ctx * NSA_KV_HEADS + kvh) * NCH * 64 + ktile_off(c, lane)] = (bf16)f2bf(a); else P.CVT[((size_t)ctx * NSA_KV_HEADS + kvh) * NCH * 64 + vtile_off(lane, c)] = (bf16)f2bf(a); }
            else { (ty == 0 ? P.CKF : P.CVF)[(((size_t)(ctx - BATCH) * NSA_KV_HEADS + kvh) * NCH + c) * 64 + lane] = a; }
            asm volatile("s_waitcnt lgkmcnt(0)" ::: "memory"); }
    }
    __syncthreads();
}
constexpr int NSA_WLDS = 8192;
DI void nsa_pair_a(const FP& P, int n, int kvh, int t, int lane, LAS unsigned char* wl) {
    LAS float* pn = (LAS float*)wl; LAS float* imp = (LAS float*)(wl + 2048); LAS float* sc = (LAS float*)(wl + 6144); LAS int* sel = (LAS int*)(wl + 7168);
    const int col = lane & 15, c = lane >> 4; const bool vcol = col < 12; const int qq = vcol ? col / 6 : 0, hh = vcol ? col % 6 : 0, tq = t + qq, head = kvh * NSA_GROUP + hh, row = n * SEQ + tq;
    bf16x8 qf[2]; { const bf16* qp = P.QB + (size_t)row * NSA_Q_COLS + head * 64 + 8 * c; qf[0] = *(const bf16x8*)qp; qf[1] = *(const bf16x8*)(qp + 32); }
    const float* gt = P.GATES + (size_t)row * 64 + head * 3;
    f32x4 oacc[4] = {(f32x4){0.f, 0.f, 0.f, 0.f}, (f32x4){0.f, 0.f, 0.f, 0.f}, (f32x4){0.f, 0.f, 0.f, 0.f}, (f32x4){0.f, 0.f, 0.f, 0.f}};
    const int lim = vcol ? ((tq >= CMP_BLOCK - 1) ? (tq - (CMP_BLOCK - 1)) / CMP_STRIDE : -1) : -1;
    const int limmax = (t + 1 >= CMP_BLOCK - 1) ? (t + 1 - (CMP_BLOCK - 1)) / CMP_STRIDE : -1; const int nblk = (limmax + 32) / 32;
    const bf16* CKb = P.CK + ((size_t)n * NSA_KV_HEADS + kvh) * NCH * 64; const bf16* CVb = P.CVT + ((size_t)n * NSA_KV_HEADS + kvh) * 64 * NCH;
    for (int i = lane; i < 1024; i += 64) imp[i] = 0.f;
    float m1 = -INFINITY, l1 = 0.f;
    { struct K4 { bf16x8 a0, a1, b0, b1; };
      auto ldk = [&](K4& k, int blk) { const bf16* kt = CKb + (size_t)blk * 2048 + lane * 8; k.a0 = *(const bf16x8*)kt; k.a1 = *(const bf16x8*)(kt + 512); k.b0 = *(const bf16x8*)(kt + 1024); k.b1 = *(const bf16x8*)(kt + 1536); };
      auto cp1 = [&](const K4& k, int blk) { const int kb = 32 * blk;
        f32x4 s0 = (f32x4){0.f, 0.f, 0.f, 0.f}, s1 = (f32x4){0.f, 0.f, 0.f, 0.f};
        s0 = __builtin_amdgcn_mfma_f32_16x16x32_bf16(k.a0, qf[0], s0, 0, 0, 0); s0 = __builtin_amdgcn_mfma_f32_16x16x32_bf16(k.a1, qf[1], s0, 0, 0, 0);
        s1 = __builtin_amdgcn_mfma_f32_16x16x32_bf16(k.b0, qf[0], s1, 0, 0, 0); s1 = __builtin_amdgcn_mfma_f32_16x16x32_bf16(k.b1, qf[1], s1, 0, 0, 0);
        float s[8] = {s0.x, s0.y, s0.z, s0.w, s1.x, s1.y, s1.z, s1.w}; float mx = -INFINITY;
        const int hi1 = lim - (kb + 8 * c);
#pragma unroll
        for (int e = 0; e < 8; ++e) { s[e] = (e <= hi1) ? s[e] : -INFINITY; mx = fmaxf(mx, s[e]); }
        mx = colmax(mx);
        const float mnew = fmaxf(m1, mx), muse = (mnew == -INFINITY) ? 0.f : mnew; float ls = 0.f;
#pragma unroll
        for (int e = 0; e < 8; ++e) ls += __builtin_amdgcn_exp2f(s[e] - muse);
        l1 = l1 * __builtin_amdgcn_exp2f(m1 - muse) + ls; m1 = mnew; };
      if (nblk > 0) { K4 A, B; ldk(A, 0);
#pragma unroll 1
        for (int blk = 0; blk < nblk; blk += 2) { ldk(B, (blk + 1 < nblk) ? blk + 1 : blk); cp1(A, blk); ldk(A, (blk + 2 < nblk) ? blk + 2 : blk); if (blk + 1 < nblk) cp1(B, blk + 1); } } }
    asm volatile("s_waitcnt lgkmcnt(0)" ::: "memory");
    { l1 = colsum(l1); const float muse = (m1 == -INFINITY) ? 0.f : m1, inv = (l1 > 0.f) ? 1.0f / l1 : 0.f;
      f32x4 oc[4] = {(f32x4){0.f, 0.f, 0.f, 0.f}, (f32x4){0.f, 0.f, 0.f, 0.f}, (f32x4){0.f, 0.f, 0.f, 0.f}, (f32x4){0.f, 0.f, 0.f, 0.f}};
      pipe2(nblk, [&](KV8& kv, int blk) { kv_load_t(kv, CKb + (size_t)blk * 2048, CVb + (size_t)blk * 2048, lane); }, [&](const KV8& kv, int blk) { const int kb = 32 * blk;
        f32x4 s0 = (f32x4){0.f, 0.f, 0.f, 0.f}, s1 = (f32x4){0.f, 0.f, 0.f, 0.f};
        s0 = __builtin_amdgcn_mfma_f32_16x16x32_bf16(kv.ka0, qf[0], s0, 0, 0, 0); s0 = __builtin_amdgcn_mfma_f32_16x16x32_bf16(kv.ka1, qf[1], s0, 0, 0, 0);
        s1 = __builtin_amdgcn_mfma_f32_16x16x32_bf16(kv.kb0, qf[0], s1, 0, 0, 0); s1 = __builtin_amdgcn_mfma_f32_16x16x32_bf16(kv.kb1, qf[1], s1, 0, 0, 0);
        float s[8] = {s0.x, s0.y, s0.z, s0.w, s1.x, s1.y, s1.z, s1.w};
        const int hi2 = lim - (kb + 8 * c);
#pragma unroll
        for (int e = 0; e < 8; ++e) s[e] = (e <= hi2) ? __builtin_amdgcn_exp2f(s[e] - muse) * inv : 0.f;
        *(f32x4*)(pn + col * 32 + 8 * c) = (f32x4){s[0], s[1], s[2], s[3]}; *(f32x4*)(pn + col * 32 + 8 * c + 4) = (f32x4){s[4], s[5], s[6], s[7]};
        u32x4 pw; pw.x = cvtpk(s[0], s[1]); pw.y = cvtpk(s[2], s[3]); pw.z = cvtpk(s[4], s[5]); pw.w = cvtpk(s[6], s[7]); const bf16x8 pf = __builtin_bit_cast(bf16x8, pw);
        oc[0] = __builtin_amdgcn_mfma_f32_16x16x32_bf16(kv.v0, pf, oc[0], 0, 0, 0); oc[1] = __builtin_amdgcn_mfma_f32_16x16x32_bf16(kv.v1, pf, oc[1], 0, 0, 0);
        oc[2] = __builtin_amdgcn_mfma_f32_16x16x32_bf16(kv.v2, pf, oc[2], 0, 0, 0); oc[3] = __builtin_amdgcn_mfma_f32_16x16x32_bf16(kv.v3, pf, oc[3], 0, 0, 0);
        asm volatile("s_waitcnt lgkmcnt(0)" ::: "memory");
        { const int q2 = lane >> 5, k = lane & 31; float a = 0.f;
#pragma unroll
          for (int h6 = 0; h6 < 6; ++h6) a += pn[(q2 * 6 + h6) * 32 + k];
          imp[q2 * 512 + kb + k] = a; }
        asm volatile("s_waitcnt lgkmcnt(0)" ::: "memory"); });
#ifdef NSA_DEBUG
      if (vcol) { for (int db = 0; db < 4; ++db) *(f32x4*)(P.DBG + ((size_t)0 * MP + row) * 768 + head * 64 + 16 * db + 4 * c) = oc[db]; }
#endif
      const float g0 = vcol ? gt[0] : 0.f;
#pragma unroll
      for (int db = 0; db < 4; ++db) oacc[db] += oc[db] * g0; }
#ifndef REP_SEL
#define REP_SEL 1
#endif
#pragma unroll 1
    for (int rep = 0; rep < REP_SEL; ++rep) {
    for (int i = lane; i < 256; i += 64) { const int q2 = i >> 7, b = i & 127, tq2 = t + q2, cur = tq2 / SLC_BLOCK; float sv;
        if (b > cur) sv = NEG; else if (b == 0 || b == cur || b == cur - 1) sv = FORCE_SCORE;
        else { const LAS float* ic = imp + q2 * 512 + 4 * b; sv = ic[-1] + 2.f * (ic[0] + ic[1] + ic[2]) + ic[3]; }
        sc[i] = pack_key(sv, 127u - (unsigned)b, 127u); }
    asm volatile("s_waitcnt lgkmcnt(0)" ::: "memory");
    for (int i = lane; i < 256; i += 64) { const int q2 = i >> 7, b = i & 127; const float sv = sc[i]; int rank = 0;
        for (int j = 0; j < 128; j += 4) { const f32x4 o = *(const LAS f32x4*)(sc + q2 * 128 + j);
            rank += (o.x > sv) ? 1 : 0; rank += (o.y > sv) ? 1 : 0; rank += (o.z > sv) ? 1 : 0; rank += (o.w > sv) ? 1 : 0; }
        if (rank < SLC_TOPK) { const int v = (sv > 0.5f * NEG) ? b : -1; sel[q2 * 16 + rank] = v; P.SELB[((size_t)(n * SEQ + t + q2) * NSA_KV_HEADS + kvh) * 16 + rank] = v; } }
    asm volatile("s_waitcnt lgkmcnt(0)" ::: "memory");
    }
#ifndef REP_WIN
#define REP_WIN 1
#endif
#pragma unroll 1
    for (int rep = 0; rep < REP_WIN; ++rep) { Tile16 T; tile_init(T);
      const bf16* WKb = P.WNK + ((size_t)n * NSA_KV_HEADS + kvh) * SEQ * 64; const bf16* WVb = P.WNVT + ((size_t)n * NSA_KV_HEADS + kvh) * 64 * SEQ;
      const int blo = (t - SWA_WINDOW) >> 5, bhi = (t + 1) >> 5;
      auto ld = [&](KV8& kv, int blk) { const int bc = blk < 0 ? 0 : blk; kv_load_t(kv, WKb + (size_t)bc * 2048, WVb + (size_t)bc * 2048, lane); };
      pipe2(bhi - blo + 1, [&](KV8& kv, int i) { ld(kv, blo + i); }, [&](const KV8& kv, int i) { const int kb = 32 * (blo + i);
          const int k0 = kb + 8 * c; int lo; unsigned rng; const int a = tq - SWA_WINDOW; mk_range((a > 0 ? a : 0) - k0, tq - k0, vcol, lo, rng); tile_compute(T, qf, kv, lo, rng); });
      T.l = colsum(T.l);
      const float inv = (T.l > 0.f) ? 1.0f / T.l : 0.f, g2 = vcol ? gt[2] * inv : 0.f;
#ifdef NSA_DEBUG
      if (vcol) { for (int db = 0; db < 4; ++db) *(f32x4*)(P.DBG + ((size_t)2 * MP + row) * 768 + head * 64 + 16 * db + 4 * c) = T.o[db] * inv; }
#endif
#pragma unroll
      for (int db = 0; db < 4; ++db) if (rep == REP_WIN - 1) oacc[db] += T.o[db] * g2; }
    if (vcol) { float* op = P.DPART + (size_t)row * 768 + head * 64 + 4 * c;
#pragma unroll
        for (int db = 0; db < 4; ++db) *(f32x4*)(op + 16 * db) = oacc[db]; }
}
DI void nsa_pair_b(const FP& P, int n, int kvh, int t, int lane, LAS unsigned char* wl) {
    LAS int* steps = (LAS int*)wl;
    const int col = lane & 15, c = lane >> 4; const bool vcol = col < 12; const int qq = vcol ? col / 6 : 0, hh = vcol ? col % 6 : 0, tq = t + qq, head = kvh * NSA_GROUP + hh, row = n * SEQ + tq;
    bf16x8 qf[2]; { const bf16* qp = P.QB + (size_t)row * NSA_Q_COLS + head * 64 + 8 * c; qf[0] = *(const bf16x8*)qp; qf[1] = *(const bf16x8*)(qp + 32); }
    const float* gt = P.GATES + (size_t)row * 64 + head * 3;
    Tile16 T; tile_init(T);
    const bf16* SKb = P.SLK + ((size_t)n * NSA_KV_HEADS + kvh) * SEQ * 64; const bf16* SVb = P.SLVT + ((size_t)n * NSA_KV_HEADS + kvh) * SEQ * 64;
    int ns = 0;
    { const int mysel = (lane < 32) ? P.SELB[((size_t)(n * SEQ + t + (lane >> 4)) * NSA_KV_HEADS + kvh) * 16 + (lane & 15)] : -1;
      for (int i = 0; i < 32; ++i) { const int b = __builtin_amdgcn_readlane(mysel, i); if (b < 0) continue; int q2 = i >> 4;
          const unsigned long long other = __ballot(mysel == b && lane < 32 && (lane >> 4) != q2);
          if (other) { if (q2 == 1) continue; q2 = 2; }
          if (lane == 0) { steps[ns] = (b * SLC_BLOCK) | (q2 << 29); steps[ns + 1] = (b * SLC_BLOCK + 32) | (q2 << 29); } ns += 2; } }
    asm volatile("s_waitcnt lgkmcnt(0)" ::: "memory");
    auto ld = [&](KV8& kv, int i) { const int code = __builtin_amdgcn_readfirstlane(steps[i]); const int kb = code & 0x1fffffff;
        kv_load_t(kv, SKb + (size_t)(kb >> 5) * 2048, SVb + (size_t)(kb >> 5) * 2048, lane); };
#ifdef PROBE_DBLCOMP
    Tile16 T2; tile_init(T2);
#endif
    pipe2(ns, ld, [&](const KV8& kv, int i) { const int code = __builtin_amdgcn_readfirstlane(steps[i]); const int kb = code & 0x1fffffff, q2 = code >> 29;
        int lo; unsigned rng; mk_range(-64, tq - (kb + 8 * c), vcol && (q2 == 2 || qq == q2), lo, rng); tile_compute(T, qf, kv, lo, rng);
#ifdef PROBE_DBLCOMP
        tile_compute(T2, qf, kv, [&](int e) { return vcol && qq == q2 && (kb + 8 * c + e + 1) <= tq; });
#endif
    });
#ifdef PROBE_DBLCOMP
    if (T2.l < 0.f) T.l = 0.f;
#endif
    T.l = colsum(T.l);
    const float inv = (T.l > 0.f) ? 1.0f / T.l : 0.f, g1 = vcol ? gt[1] * inv : 0.f;
#ifdef NSA_DEBUG
    if (vcol) { for (int db = 0; db < 4; ++db) *(f32x4*)(P.DBG + ((size_t)1 * MP + row) * 768 + head * 64 + 16 * db + 4 * c) = T.o[db] * inv; }
#endif
    if (vcol) { const float* pp = P.DPART + (size_t)row * 768 + head * 64 + 4 * c; bf16* op = P.ATTB + (size_t)row * 1024 + head * 64 + 4 * c;
#pragma unroll
        for (int db = 0; db < 4; ++db) *(u32x2*)(op + 16 * db) = pk4(*(const f32x4*)(pp + 16 * db) + T.o[db] * g1); }
}

constexpr int SMP_SK = 1088;
template <class KF, class VF> DI void smp_branch(const Ctx& C, LAS float* qs, LAS float* S, LAS float* red, int NK, KF kf, VF vf, bool keep_probs, float (&outh)[1]) {
    const int tid = C.tid, lane = C.lane, w = C.wave;
#pragma unroll 1
    for (int j = tid; j < NK; j += NTHREADS) { const float* k = kf(j); f32x4 kr[16];
#pragma unroll
        for (int d4 = 0; d4 < 16; ++d4) kr[d4] = *(const f32x4*)(k + 4 * d4);
#pragma unroll 1
        for (int h = 0; h < 6; ++h) { float a = 0.f;
#pragma unroll
            for (int d4 = 0; d4 < 16; ++d4) { const f32x4 qv = *(const LAS f32x4*)(qs + h * 64 + 4 * d4); a += kr[d4].x * qv.x + kr[d4].y * qv.y + kr[d4].z * qv.z + kr[d4].w * qv.w; }
            S[h * SMP_SK + j] = a; } }
    asm volatile("s_waitcnt lgkmcnt(0)" ::: "memory"); __syncthreads();
    if (w < 6) { float m = -INFINITY; for (int j = lane; j < NK; j += 64) m = fmaxf(m, S[w * SMP_SK + j]); m = wave_max(m);
        float l = 0.f; for (int j = lane; j < NK; j += 64) { const float p = __builtin_amdgcn_exp2f(S[w * SMP_SK + j] - m); S[w * SMP_SK + j] = p; l += p; } l = wave_sum(l);
        const float inv = 1.0f / l; for (int j = lane; j < NK; j += 64) S[w * SMP_SK + j] *= inv; }
    asm volatile("s_waitcnt lgkmcnt(0)" ::: "memory"); __syncthreads();
    { const int per = (NK + NWAVES - 1) / NWAVES, j0 = w * per, j1 = (j0 + per < NK) ? j0 + per : NK; float o[6] = {0.f, 0.f, 0.f, 0.f, 0.f, 0.f};
#pragma unroll 1
      for (int j = j0; j < j1; j += 8) { float vv[8];
#pragma unroll
          for (int u = 0; u < 8; ++u) { const int jj = (j + u < j1) ? j + u : j1 - 1; vv[u] = vf(jj)[lane]; }
#pragma unroll
          for (int u = 0; u < 8; ++u) if (j + u < j1) {
#pragma unroll
              for (int h = 0; h < 6; ++h) o[h] += S[h * SMP_SK + j + u] * vv[u]; } }
#pragma unroll
      for (int h = 0; h < 6; ++h) red[(w * 6 + h) * 64 + lane] = o[h]; }
    asm volatile("s_waitcnt lgkmcnt(0)" ::: "memory"); __syncthreads();
    outh[0] = 0.f;
    if (tid < 384) { float a = 0.f;
#pragma unroll
        for (int ww = 0; ww < NWAVES; ++ww) a += red[ww * 384 + tid]; outh[0] = a; }
    if (!keep_probs) { __syncthreads(); }
}
DI void nsa_sample_item(const FP& P, const Ctx& C, int ns, int kvh) {
    LAS float* qs = (LAS float*)C.lds; LAS float* S = qs + 384; LAS float* red = S + 6 * SMP_SK; LAS float* scs = red + 8 * 384; LAS int* sel = (LAS int*)(scs + 136);
    const int tid = C.tid, row = M0 + ns;
    if (tid < 384) qs[tid] = bf2f(P.QB[(size_t)row * NSA_Q_COLS + kvh * 384 + tid]);
    asm volatile("s_waitcnt lgkmcnt(0)" ::: "memory"); __syncthreads();
    const float* ckf = P.CKF + ((size_t)ns * NSA_KV_HEADS + kvh) * NCH * 64; const float* cvf = P.CVF + ((size_t)ns * NSA_KV_HEADS + kvh) * NCH * 64;
    float oc[1], os[1], ow[1];
    smp_branch(C, qs, S, red, NCMP, [&](int j) { return ckf + (size_t)j * 64; }, [&](int j) { return cvf + (size_t)j * 64; }, true, oc);
    constexpr int NBS = (PAST_LEN + 1 + SLC_BLOCK - 1) / SLC_BLOCK, CURS = PAST_LEN / SLC_BLOCK;
    for (int b = tid; b < 136; b += NTHREADS) { float sv = -3.0e38f;
        if (b < NBS) { if (b == 0 || b == CURS || b == CURS - 1) sv = FORCE_SCORE; else { float a = 0.f;
#pragma unroll
                for (int o = -1; o <= 3; ++o) { const int ci = 4 * b + o; if (ci >= 0 && ci < NCMP) { float sm = 0.f; for (int h6 = 0; h6 < 6; ++h6) sm += S[h6 * SMP_SK + ci]; a += ((o >= 0 && o <= 2) ? 2.f : 1.f) * sm; } }
                sv = a; } }
        scs[b] = sv; }
    asm volatile("s_waitcnt lgkmcnt(0)" ::: "memory"); __syncthreads();
    for (int b = tid; b < NBS; b += NTHREADS) { const float sv = scs[b]; int rank = 0; for (int j = 0; j < NBS; ++j) { const float o = scs[j]; rank += (o > sv || (o == sv && j < b)) ? 1 : 0; }
        if (rank < SLC_TOPK) { sel[rank] = b; P.SELB[((size_t)row * NSA_KV_HEADS + kvh) * 16 + rank] = b; } }
    asm volatile("s_waitcnt lgkmcnt(0)" ::: "memory"); __syncthreads();
    { const float* newrow = P.nsa_kv_s + (size_t)ns * 512; const int* pt = P.page_table + ns * (PAST_LEN / PAGE_SIZE);
      if (tid == 0) { int seen = 0; for (int x = 0; x < SLC_TOPK; ++x) { const int bx = sel[x]; if (bx != CURS && seen < 15) sel[16 + seen++] = bx; } }
      asm volatile("s_waitcnt lgkmcnt(0)" ::: "memory"); __syncthreads();
      auto krow = [&](int j, int ty) -> const float* { if (j >= 15 * 64) return newrow + ty * 128 + kvh * 64;
          const int t0 = sel[16 + (j >> 6)] * SLC_BLOCK + (j & 63); const int pg = pt[t0 / PAGE_SIZE]; return P.cache_nsa_kv + ((size_t)pg * PAGE_SIZE + t0 % PAGE_SIZE) * 512 + ty * 128 + kvh * 64; };
      smp_branch(C, qs, S, red, 15 * 64 + 1, [&](int j) { return krow(j, 2); }, [&](int j) { return krow(j, 3); }, false, os); }
    { const float* wc = P.cache_nsa_win + (size_t)ns * SWA_WINDOW * 256; const float* newrow = P.win_s + ((size_t)ns * SWA_WINDOW + SWA_WINDOW - 1) * 256;
      smp_branch(C, qs, S, red, SWA_WINDOW + 1, [&](int j) { return (j < SWA_WINDOW ? wc + (size_t)j * 256 : newrow) + kvh * 64; }, [&](int j) { return (j < SWA_WINDOW ? wc + (size_t)j * 256 : newrow) + 128 + kvh * 64; }, false, ow); }
    if (tid < 384) { const int head = kvh * NSA_GROUP + tid / 64; const float* gt = P.GATES + (size_t)row * 64 + head * 3;
        P.ATTB[(size_t)row * 1024 + kvh * 384 + tid] = (bf16)f2bf(gt[0] * oc[0] + gt[1] * os[0] + gt[2] * ow[0]);
#ifdef NSA_DEBUG
        P.DBG[((size_t)0 * MP + row) * 768 + kvh * 384 + tid] = oc[0]; P.DBG[((size_t)1 * MP + row) * 768 + kvh * 384 + tid] = os[0]; P.DBG[((size_t)2 * MP + row) * 768 + kvh * 384 + tid] = ow[0];
#endif
    }
    __syncthreads();
}
DI void nsa_pairs(const FP& P, const Ctx& C, bool second) {
    LAS unsigned char* wl = C.lds + C.wave * NSA_WLDS;
    const int per = C.G / 4 > 0 ? C.G / 4 : 1, grp = (C.vcu / per) & 3, sub = C.vcu % per, n = grp >> 1, kvh = grp & 1;
#pragma unroll 1
    for (int pr = sub * NWAVES + C.wave; pr < SEQ / 2; pr += per * NWAVES) { if (second) nsa_pair_b(P, n, kvh, 2 * pr, C.lane, wl); else nsa_pair_a(P, n, kvh, 2 * pr, C.lane, wl); }
}
DI void nsa_phase_a(const FP& P, const Ctx& C) {
    for (int it = C.vcu; it < DEC_BATCH * NSA_KV_HEADS; it += C.G) nsa_sample_item(P, C, it / NSA_KV_HEADS, it % NSA_KV_HEADS);
    nsa_pairs(P, C, false);
    __syncthreads();
}
DI void nsa_phase_b(const FP& P, const Ctx& C) {
    const int lane = C.lane, w = C.wave;
    nsa_pairs(P, C, true);
    __syncthreads();
    { constexpr int NMT = (M0 / 16) * MEM_HEADS;
      for (int it = C.vcu * NWAVES + w; it < NMT; it += C.G * NWAVES) { const int h = it % MEM_HEADS, q16 = it / MEM_HEADS, row0 = q16 * 16, n = row0 / SEQ;
          mem_micro(P, P.MQB + h * 64, 256, row0, 1, n, h, P.ATTB + NSA_Q_COLS + h * 64, 1024, lane); }
    }
    { LAS float* qs = (LAS float*)C.lds;
      for (int it = C.vcu; it < DEC_BATCH * MEM_HEADS; it += C.G) { const int h = it % MEM_HEADS, ns = it / MEM_HEADS, row = M0 + ns;
          __syncthreads(); if (C.tid < 64) qs[C.tid] = bf2f(P.MQB[(size_t)row * 256 + h * 64 + C.tid]); asm volatile("s_waitcnt lgkmcnt(0)" ::: "memory"); __syncthreads();
          Dec D; D.m = -INFINITY; D.l = 0.f; D.o = 0.f; const float* mk = P.cache_mem_kv + ((size_t)1 * DEC_BATCH + ns) * MEM_TOKENS * 512;
          for (int ck = w; ck < MEM_TOKENS / 64; ck += NWAVES) { const int j0 = ck * 64; dec_chunk(D, qs, 64, [&](int j) { return mk + (size_t)(j0 + j) * 512 + h * 64; }, [&](int j) { return mk + (size_t)(j0 + j) * 512 + 256 + h * 64; }, lane); }
          const float o = dec_combine(C, D);
          if (w == 0) P.ATTB[(size_t)row * 1024 + NSA_Q_COLS + h * 64 + lane] = (bf16)f2bf(o); } }
    __syncthreads();
}
}
namespace fx {
enum { PH_PRO = 0, PH_G1, PH_ATTA, PH_G2, PH_LN1, PH_SC0, PH_TK0, PH_PU0, PH_PG0, PH_G3, PH_CMPG, PH_CMP2, PH_NSA, PH_NSB, PH_G4, PH_LN3, PH_SC1, PH_TK1, PH_PU1, PH_PG1, PH_COUNT };
template <class Epi> DI void run_gemm(const Ctx& C, const bf16* A, const bf16* Bt, int M, int N, int K, const Epi& E) {
    pg8::Gemm g{A, Bt, M, N, K}; pg8::StaticOrder S; S.init(M, N, C.G, (int)blockIdx.x);
    pg8::gemm_phase<Epi, pg8::StaticOrder, true, true>(C.lds, g, S, E);
}
template <class Epi> DI void skinny_gemm(const Ctx& C, const bf16* A, const bf16* Bt, int N, int K, const Epi& E) {
    static_assert(DEC_BATCH == 32 && M0 % 256 == 0, "skinny_gemm: 32 sample rows right after a whole number of 256-row tiles");
    const int lane = C.lane, fr = lane & 15, fq = lane >> 4, w = C.wave; const int NI = (N / 256) * 4, KW = K / NWAVES;
    LAS f32x4* red = (LAS f32x4*)C.lds;
#pragma unroll 1
    for (int item = C.vcu; item < NI; item += C.G) { const int pn = item >> 2, wc = item & 3;
        f32x4 pa[2][2][2];
#pragma unroll
        for (int i = 0; i < 8; ++i) (&pa[0][0][0])[i] = (f32x4){0.f, 0.f, 0.f, 0.f};
        const bf16* xa = A + (size_t)(M0 + fr) * K + w * KW + 8 * fq; const bf16* xb = xa + (size_t)16 * K;
        const bf16* wp[2][2];
#pragma unroll
        for (int bj = 0; bj < 2; ++bj)
#pragma unroll
            for (int n = 0; n < 2; ++n) wp[bj][n] = Bt + (size_t)(pn * 256 + bj * 128 + wc * 32 + 8 * (fr >> 2) + 4 * n + (fr & 3)) * K + w * KW + 8 * fq;
#pragma unroll 4
        for (int k0 = 0; k0 < KW; k0 += 32) { const bf16x8 x0 = *(const bf16x8*)(xa + k0), x1 = *(const bf16x8*)(xb + k0);
#pragma unroll
            for (int bj = 0; bj < 2; ++bj)
#pragma unroll
                for (int n = 0; n < 2; ++n) { const bf16x8 wf = *(const bf16x8*)(wp[bj][n] + k0);
                    pa[bj][0][n] = __builtin_amdgcn_mfma_f32_16x16x32_bf16(wf, x0, pa[bj][0][n], 0, 0, 0); pa[bj][1][n] = __builtin_amdgcn_mfma_f32_16x16x32_bf16(wf, x1, pa[bj][1][n], 0, 0, 0); } }
        __syncthreads();
#pragma unroll
        for (int bj = 0; bj < 2; ++bj)
#pragma unroll
            for (int mm = 0; mm < 2; ++mm)
#pragma unroll
                for (int n = 0; n < 2; ++n) red[(w * 8 + bj * 4 + mm * 2 + n) * 64 + lane] = pa[bj][mm][n];
        asm volatile("s_waitcnt lgkmcnt(0)" ::: "memory"); __syncthreads();
        if (w == 0) { f32x4 acc[2][2][4][2];
#pragma unroll
            for (int i = 0; i < 32; ++i) (&acc[0][0][0][0])[i] = (f32x4){0.f, 0.f, 0.f, 0.f};
#pragma unroll
            for (int bj = 0; bj < 2; ++bj)
#pragma unroll
                for (int mm = 0; mm < 2; ++mm)
#pragma unroll
                    for (int n = 0; n < 2; ++n) { f32x4 s = red[(bj * 4 + mm * 2 + n) * 64 + lane];
#pragma unroll 1
                        for (int ww = 1; ww < NWAVES; ++ww) s += red[(ww * 8 + bj * 4 + mm * 2 + n) * 64 + lane];
                        acc[0][bj][mm][n] = s; }
            E(acc, pg8::Unit{M0 / 256, pn}, 0, wc, fr, fq); }
    }
    __syncthreads();
}
__global__ void __launch_bounds__(NTHREADS, 2) mega(Args args) {
    extern __shared__ __attribute__((aligned(16))) unsigned char lds_raw[];
    Ctx C; C.lds = (LAS unsigned char*)lds_raw; C.tid = threadIdx.x; C.lane = C.tid & 63; C.wave = __builtin_amdgcn_readfirstlane(C.tid >> 6);
    C.G = gridDim.x; { const int bx = blockIdx.x; C.vcu = (C.G % 8 == 0) ? (bx % 8) * (C.G / 8) + bx / 8 : bx; }
    const FP& P = args.p;
    volatile LAS unsigned* MISC = (volatile LAS unsigned*)(C.lds + MISC_OFF);
    for (int u = C.tid; u < (LDS_BYTES - RING_BYTES) / 4; u += NTHREADS) ((LAS unsigned*)(C.lds + RING_BYTES))[u] = 0u;
    __syncthreads();
    const int lo = args.lo, hi = args.hi;
    XcdBarrier bar; bar.bar = P.ctl + 1024; bar.x = 0; bar.st = nullptr;
    if (hi - lo > 1) bar = xcd_barrier_post(P.ctl + 1024, MISC + 8);
#define IN(k) (lo <= (k) && (k) < hi)
#define SEAM(k) do { if (IN(k) && IN((k) + 1)) xcd_barrier(bar); } while (0)
#ifndef DUP_PHASE
#define DUP_PHASE -1
#endif
#define PHASE(k, ...) do { if (IN(k)) { __VA_ARGS__ if (DUP_PHASE == (k)) { __syncthreads(); __VA_ARGS__ } } SEAM(k); } while (0)
    PHASE(PH_PRO, p0_prologue(P, C); __syncthreads(); p0_wpk(P, C););
    PHASE(PH_G1, run_gemm(C, P.XB0, P.WA_T, M0, ACOLS, D_MODEL, EpiA{P}); run_gemm(C, P.MEMB, P.WMEM_T, BATCH * MEM_TOKENS, 1024, D_MODEL, EpiMem{P}); skinny_gemm(C, P.XB0, P.WA_T, ACOLS, D_MODEL, EpiA{P}););
#ifdef PEER_SHARD3
#define PEER_SHARDED_FN peer_sharded3_phase
#else
#define PEER_SHARDED_FN peer_sharded2_phase
#endif
    PHASE(PH_ATTA, atta_phase(P, C););
    PHASE(PH_G2, run_gemm(C, P.ATTA, P.WOA_T, M0, D_MODEL, 512, EpiPre{P.x_prompt, P.x_sample, P.PRE}); skinny_gemm(C, P.ATTA, P.WOA_T, D_MODEL, 512, EpiPre{P.x_prompt, P.x_sample, P.PRE}););
    PHASE(PH_LN1, ln_phase(P, C, P.PRE, P.ln_g, P.ln_b, P.X1, P.X1B, nullptr, nullptr););
    PHASE(PH_SC0, run_gemm(C, P.X1B, P.WPK_T, M0, NPK, D_MODEL, EpiF32{P.SCO, NPK, MP}); skinny_gemm(C, P.X1B, P.WPK_T, NPK, D_MODEL, EpiF32{P.SCO, NPK, MP}););
    PHASE(PH_TK0, topk_phase(P, C););
#ifdef PEER_SPLIT
    PHASE(PH_PU0, peer_u_phase(P, C, 0, P.X1B););
    PHASE(PH_PG0, peer_v_phase(P, C, 0, P.X1, P.X2, P.X2 + (size_t)M0 * D_MODEL, P.X2B););
#elif defined(PEER_SHARD2)
    PHASE(PH_PG0, const bool shd = (M0 % (C.G * NWAVES * PS2_ROWS)) == 0; if (shd) { PEER_SHARDED_FN(P, C, 0, P.X1, P.X1B, P.X2, P.X2B); __syncthreads(); } peer_phase(P, C, 0, P.X1, P.X2, P.X2 + (size_t)M0 * D_MODEL, P.X2B, shd););
#elif defined(PEER_SHARD)
    PHASE(PH_PG0, peer_sharded_phase(P, C, 0, P.X1, P.X1B, P.X2, P.X2 + (size_t)M0 * D_MODEL, P.X2B); __syncthreads(); peer_phase(P, C, 0, P.X1, P.X2, P.X2 + (size_t)M0 * D_MODEL, P.X2B););
#else
    PHASE(PH_PG0, peer_phase(P, C, 0, P.X1, P.X2, P.X2 + (size_t)M0 * D_MODEL, P.X2B););
#endif
    PHASE(PH_G3, run_gemm(C, P.X2B, P.WB_T, M0, NB_T, D_MODEL, EpiB{P}); skinny_gemm(C, P.X2B, P.WB_T, NB_T, D_MODEL, EpiB{P}););
    PHASE(PH_CMPG, run_gemm(C, P.AC, P.CW1_T, ACROWS, 256, 1024, EpiF32{P.UL, 256, ACROWS}); run_gemm(C, P.AC + (size_t)ACROWS * 1024, P.CW1_T + 256 * 1024, ACROWS, 256, 1024, EpiF32{P.UL + (size_t)ACROWS * 256, 256, ACROWS}););
    PHASE(PH_CMP2, cmp2_phase(P, C););
    PHASE(PH_NSA, nsa_phase_a(P, C););
    PHASE(PH_NSB, nsa_phase_b(P, C););
    PHASE(PH_G4, run_gemm(C, P.ATTB, P.WOB_T, M0, D_MODEL, 1024, EpiPre{P.X2, nullptr, P.PRE}); skinny_gemm(C, P.ATTB, P.WOB_T, D_MODEL, 1024, EpiPre{P.X2, nullptr, P.PRE}););
    PHASE(PH_LN3, ln_phase(P, C, P.PRE, P.ln_g + 2 * D_MODEL, P.ln_b + 2 * D_MODEL, P.X3, P.X3B, nullptr, nullptr););
    PHASE(PH_SC1, run_gemm(C, P.X3B, P.WPK_T + (size_t)NPK * D_MODEL, M0, NPK, D_MODEL, EpiF32{P.SCO, NPK, MP}); skinny_gemm(C, P.X3B, P.WPK_T + (size_t)NPK * D_MODEL, NPK, D_MODEL, EpiF32{P.SCO, NPK, MP}););
    PHASE(PH_TK1, topk_phase(P, C););
#ifdef PEER_SPLIT
    PHASE(PH_PU1, peer_u_phase(P, C, 1, P.X3B););
    PHASE(PH_PG1, peer_v_phase(P, C, 1, P.X3, P.y_prompt, P.y_sample, nullptr););
#elif defined(PEER_SHARD2)
    PHASE(PH_PG1, const bool shd = (M0 % (C.G * NWAVES * PS2_ROWS)) == 0; if (shd) { PEER_SHARDED_FN(P, C, 1, P.X3, P.X3B, P.y_prompt, nullptr); __syncthreads(); } peer_phase(P, C, 1, P.X3, P.y_prompt, P.y_sample, nullptr, shd););
#elif defined(PEER_SHARD)
    PHASE(PH_PG1, peer_sharded_phase(P, C, 1, P.X3, P.X3B, P.y_prompt, P.y_sample, nullptr); __syncthreads(); peer_phase(P, C, 1, P.X3, P.y_prompt, P.y_sample, nullptr););
#else
    PHASE(PH_PG1, peer_phase(P, C, 1, P.X3, P.y_prompt, P.y_sample, nullptr););
#endif
#undef IN
#undef SEAM
}
}
#ifndef ONE_LAUNCH
#define ONE_LAUNCH 1
#endif
extern "C" void kernel_launch(void* const* d_in, const int* in_sizes, int n_in, void* d_out, int out_size, void* d_ws, size_t ws_size, hipStream_t stream) {
    fx::Args a; memset(&a, 0, sizeof(a)); fx::bind_io(a.p, d_in, (float*)d_out);
    const size_t f_need = fx::carve(a.p, d_ws);
    if (f_need > ws_size) { fprintf(stderr, "kernel_launch: workspace too small: need %zu have %zu\n", f_need, ws_size); return; }
    static int grid = 0;
    if (!grid) { int dev = 0, cus = 0, per_cu = 0; (void)hipGetDevice(&dev); (void)hipDeviceGetAttribute(&cus, hipDeviceAttributeMultiprocessorCount, dev);
        (void)hipFuncSetAttribute((const void*)fx::mega, hipFuncAttributeMaxDynamicSharedMemorySize, fx::LDS_BYTES);
        if (hipOccupancyMaxActiveBlocksPerMultiprocessor(&per_cu, (const void*)fx::mega, fx::NTHREADS, fx::LDS_BYTES) != hipSuccess || per_cu < 1) { fprintf(stderr, "kernel_launch: occupancy query says %d blocks per CU\n", per_cu); (void)hipGetLastError(); }
        grid = cus; }
    (void)hipMemsetAsync(a.p.ctl, 0, fx::CTL_BYTES, stream);
#if ONE_LAUNCH
    a.lo = 0; a.hi = fx::PH_COUNT; hipLaunchKernelGGL(fx::mega, dim3(grid), dim3(fx::NTHREADS), fx::LDS_BYTES, stream, a);
#else
    for (int k = 0; k < fx::PH_COUNT; ++k) { a.lo = k; a.hi = k + 1; hipLaunchKernelGGL(fx::mega, dim3(grid), dim3(fx::NTHREADS), fx::LDS_BYTES, stream, a); }
#endif
}
```

```cpp
#define PEER_SHARD2 1
#define ONE_LAUNCH 1
#include <hip/hip_runtime.h>
#include <cstdio>
#include <cstring>
#include <cmath>
#ifdef CPU_TEST
#define HD inline
constexpr int D_MODEL = 128, BATCH = 2, SEQ = 512, DEPTH = 2, DEC_BATCH = 3, DEC_SEQ = 1, PAST_LEN = 512, PAGE_SIZE = 128;
constexpr int DIL_W[3] = {16, 64, 256}, DIL_D[3] = {1, 4, 16}, DIL_TAPS = 17;
constexpr int MEM_TOKENS = 32, SLC_TOPK = 4, SWA_WINDOW = 64, PEER_KEYS = 16, PEER_TOPK = 4;
#else
#define HD __host__ __device__ __forceinline__
constexpr int D_MODEL = 1024, BATCH = 2, SEQ = 8192, DEPTH = 2, DEC_BATCH = 32, DEC_SEQ = 1, PAST_LEN = 8192, PAGE_SIZE = 128;
constexpr int DIL_W[3] = {128, 512, 2048}, DIL_D[3] = {1, 4, 16}, DIL_TAPS = 129;
constexpr int MEM_TOKENS = 256, SLC_TOPK = 16, SWA_WINDOW = 512, PEER_KEYS = 128, PEER_TOPK = 16;
#endif
HD constexpr int dil_w(int g) { return g == 0 ? DIL_W[0] : (g == 1 ? DIL_W[1] : DIL_W[2]); }
HD constexpr int dil_d(int g) { return g == 0 ? DIL_D[0] : (g == 1 ? DIL_D[1] : DIL_D[2]); }
constexpr int HEAD_DIM = 64, N_A_LAYERS = DEPTH / 2, N_DIL = 3, DIL_HEADS = 4, DIL_COLS = N_DIL * 3 * DIL_HEADS * HEAD_DIM;
constexpr int MEM_HEADS = 4, MEM_COLS = MEM_HEADS * HEAD_DIM;
constexpr int NSA_HEADS = 12, NSA_KV_HEADS = 2, NSA_GROUP = 6, NSA_Q_COLS = NSA_HEADS * HEAD_DIM, NSA_GATE_COLS = NSA_HEADS * 3;
constexpr int CMP_BLOCK = 32, CMP_STRIDE = 16, CMP_HIDDEN = 128, SLC_BLOCK = 64;
constexpr int PEER_EXPERTS = PEER_KEYS * PEER_KEYS, PEER_HEADS = 8, PEER_KEY_DIM = 128;
constexpr float FORCE_SCORE = 1.0e9f, NEG = -1.0e30f, SCALE = 0.125f, LN_EPS = 1e-5f;
constexpr float ALPHA = 1.41421356237309515f;
constexpr float BETA = 0.5f;
#define LAS __attribute__((address_space(3)))
namespace pg8 {
#define PG8_LAS __attribute__((address_space(3)))
typedef unsigned short bf16_t;
typedef short bf16x8 __attribute__((ext_vector_type(8)));
typedef float f32x4 __attribute__((ext_vector_type(4)));
typedef unsigned u32x4 __attribute__((ext_vector_type(4)));
constexpr int BM = 256, BK = 64, HALF = 128, HTB = HALF * BK * 2  , STAGE_BYTES = 8 * HTB, NXCD = 8, WGM = 8;

__host__ __device__ __forceinline__ int lds_byte(int r, int c) { const int st = (r >> 4) * 2 + (c >> 5), rr = r & 15, cc = c & 31, ob = rr * 64 + cc * 2; return st * 1024 + (ob ^ (((ob >> 9) & 1) << 5)); }
__host__ __device__ __forceinline__ void stage_rc(int b, int& R, int& C) { const int st = b / 1024, sb = b % 1024, swz = sb ^ (((sb >> 9) & 1) << 5); R = (st >> 1) * 16 + swz / 64; C = (st & 1) * 32 + (swz % 64) / 2; }
__host__ __device__ __forceinline__ int perm32(int rho) { const int n = rho >> 4, i = rho & 15; return 8 * (i >> 2) + 4 * n + (i & 3); }

struct Unit { int pm, pn; };
struct Gemm { const bf16_t* A; const bf16_t* Bt; int M, N, K; };

struct StaticOrder {
    int nM, nN, nwg, G, c;
    __host__ __device__ void init(int M, int N, int G_, int c_) { nM = M / BM; nN = N / BM; nwg = nM * nN; G = G_; c = c_; }
    __host__ __device__ bool next(int i, Unit& u) const {
        const long L = (long)i * G + c; if (L >= nwg) return false;
        int wgid = (int)L; { const int q = nwg / NXCD, r = nwg % NXCD, xcd = wgid % NXCD, off = wgid / NXCD; wgid = (xcd < r ? xcd * (q + 1) : r * (q + 1) + (xcd - r) * q) + off; }
        const int nig = WGM * nN, gid = wgid / nig, fm = gid * WGM, gsz = (nM - fm) < WGM ? (nM - fm) : WGM;
        u.pm = fm + ((wgid % nig) % gsz); u.pn = (wgid % nig) / gsz; return true;
    }
    __device__ __forceinline__ void a_ready(const Unit&) const {}
    __device__ __forceinline__ void done(const Unit&) const {}
};

__device__ __forceinline__ unsigned cvt_pk_bf16(float lo, float hi) { unsigned r; asm volatile("v_cvt_pk_bf16_f32 %0, %1, %2" : "=v"(r) : "v"(lo), "v"(hi)); return r; }
typedef float f32x2 __attribute__((ext_vector_type(2)));
typedef float f32x2 __attribute__((ext_vector_type(2)));
template <class Epi, class Sched, bool ALIGN_EPI = false, bool SP2 = false>
__device__ __forceinline__ void gemm_phase(PG8_LAS unsigned char* lds, const Gemm g, const Sched& S, const Epi& E) {
    const int tid = threadIdx.x, wid = __builtin_amdgcn_readfirstlane(tid >> 6), lane = tid & 63, wr = wid >> 2, wc = wid & 3, fr = lane & 15, fq = lane >> 4;
    const int K = g.K, nt = K / BK;
    unsigned voffA[2], voffB[2];
#pragma unroll
    for (int i = 0; i < 2; ++i) { int R, C; stage_rc(tid * 16 + i * 8192, R, C); const int Rb = Epi::PERM ? ((R & ~31) + perm32(R & 31)) : R;
        voffA[i] = (unsigned)(R * K + C) * 2u; voffB[i] = (unsigned)(Rb * K + C) * 2u; }
    const size_t kstep = (size_t)(BK * 2);
    const size_t hstep = (size_t)HALF * K * 2;
    const size_t tstep = 2 * hstep;
    const unsigned ldsw = (unsigned)wid * 1024u;
    const int aoff = lds_byte(wr * 64 + fr, fq * 8), boff = lds_byte(wc * 32 + fr, fq * 8);
#define PG8_SA(b, h) (((b) * 2 + (h)) * HTB)
#define PG8_SB(b, h) ((4 + (b) * 2 + (h)) * HTB)
#define PG8_STAGE(bufoff, gbase, voff) do { _Pragma("unroll") for (int _i = 0; _i < 2; ++_i) \
        __builtin_amdgcn_global_load_lds((const unsigned*)((const char*)(gbase) + (voff)[_i]), (PG8_LAS unsigned*)(lds + (bufoff) + ldsw + _i * 8192), 16, 0, 0); } while (0)
#define PG8_LDA(dst, b, h) do { _Pragma("unroll") for (int m = 0; m < 4; ++m) _Pragma("unroll") for (int k = 0; k < 2; ++k) dst[m][k] = *(const PG8_LAS bf16x8*)(lds + PG8_SA(b, h) + aoff + m * 2048 + k * 1024); } while (0)
#define PG8_LDB(dst, b, h) do { _Pragma("unroll") for (int n = 0; n < 2; ++n) _Pragma("unroll") for (int k = 0; k < 2; ++k) dst[n][k] = *(const PG8_LAS bf16x8*)(lds + PG8_SB(b, h) + boff + n * 2048 + k * 1024); } while (0)
#define PG8_MMA(ai, bj, At, Bt) do { __builtin_amdgcn_s_setprio(1); _Pragma("unroll") for (int m = 0; m < 4; ++m) _Pragma("unroll") for (int n = 0; n < 2; ++n) _Pragma("unroll") for (int k = 0; k < 2; ++k) \
        acc[ai][bj][m][n] = __builtin_amdgcn_mfma_f32_16x16x32_bf16(Bt[n][k], At[m][k], acc[ai][bj][m][n], 0, 0, 0); __builtin_amdgcn_s_setprio(0); } while (0)
#define PG8_WAIT_V(n) asm volatile("s_waitcnt vmcnt(" #n ")" ::: "memory")
#define PG8_WAIT_L(n) asm volatile("s_waitcnt lgkmcnt(" #n ")" ::: "memory")
#define PG8_BAR __builtin_amdgcn_s_barrier()
#define PG8_SCHED __builtin_amdgcn_sched_barrier(0)
    Unit cur, nxt; int ui = 0;
    if (!S.next(0, cur)) return;
    f32x4 acc[2][2][4][2];
#pragma unroll
    for (int a = 0; a < 2; ++a)
#pragma unroll
        for (int b = 0; b < 2; ++b)
#pragma unroll
            for (int m = 0; m < 4; ++m)
#pragma unroll
                for (int n = 0; n < 2; ++n) acc[a][b][m][n] = (f32x4){0.f, 0.f, 0.f, 0.f};
    bf16x8 At[4][2], B0[2][2], B1[2][2];
    const char* cA = (const char*)g.A + (size_t)cur.pm * tstep; const char* cB = (const char*)g.Bt + (size_t)cur.pn * tstep;
    S.a_ready(cur);
    if constexpr (SP2) {
        PG8_STAGE(PG8_SB(0, 0), cB, voffB); PG8_STAGE(PG8_SB(0, 1), cB + hstep, voffB); PG8_STAGE(PG8_SA(0, 0), cA, voffA); PG8_STAGE(PG8_SA(0, 1), cA + hstep, voffA);
        if (wr == 1) PG8_BAR;
        PG8_WAIT_V(2); PG8_BAR;
        PG8_STAGE(PG8_SB(1, 0), cB + kstep, voffB); PG8_STAGE(PG8_SA(1, 0), cA + kstep, voffA); PG8_STAGE(PG8_SB(1, 1), cB + hstep + kstep, voffB);
        PG8_WAIT_V(6); PG8_BAR;
    } else {
        PG8_STAGE(PG8_SB(0, 0), cB, voffB); PG8_STAGE(PG8_SA(0, 0), cA, voffA); PG8_STAGE(PG8_SB(0, 1), cB + hstep, voffB); PG8_STAGE(PG8_SA(0, 1), cA + hstep, voffA);
        if (wr == 1) PG8_BAR;
        PG8_WAIT_V(4); PG8_BAR;
        PG8_STAGE(PG8_SB(1, 0), cB + kstep, voffB); PG8_STAGE(PG8_SA(1, 0), cA + kstep, voffA); PG8_STAGE(PG8_SB(1, 1), cB + hstep + kstep, voffB);
        PG8_WAIT_V(6); PG8_BAR;
    }
    for (;;) {
        const bool has_next = S.next(ui + 1, nxt);
        const char* nA = has_next ? (const char*)g.A + (size_t)nxt.pm * tstep : cA; const char* nB = has_next ? (const char*)g.Bt + (size_t)nxt.pn * tstep : cB;
        for (int t = 0; t < nt; t += 2) {
            const bool last = (t == nt - 2);
            const char* a1 = cA + (size_t)(t + 1) * kstep;
            const char* a2 = last ? nA : cA + (size_t)(t + 2) * kstep; const char* b2 = last ? nB : cB + (size_t)(t + 2) * kstep;
            const char* a3 = a2 + kstep; const char* b3 = b2 + kstep;
            if (last && has_next) S.a_ready(nxt);
            if constexpr (SP2) {
            PG8_LDB(B0, 0, 0); PG8_LDB(B1, 0, 1); PG8_SCHED; PG8_LDA(At, 0, 0); PG8_STAGE(PG8_SA(1, 1), a1 + hstep, voffA);
            PG8_WAIT_V(8); PG8_WAIT_L(0); PG8_BAR; PG8_MMA(0, 0, At, B0); PG8_MMA(0, 1, At, B1); PG8_BAR; PG8_SCHED;
            PG8_LDA(At, 0, 1); PG8_STAGE(PG8_SB(0, 0), b2, voffB); PG8_STAGE(PG8_SB(0, 1), b2 + hstep, voffB); PG8_STAGE(PG8_SA(0, 0), a2, voffA);
            PG8_WAIT_V(8); PG8_WAIT_L(0); PG8_BAR; PG8_MMA(1, 0, At, B0); PG8_MMA(1, 1, At, B1); PG8_BAR; PG8_SCHED;
            PG8_LDB(B0, 1, 0); PG8_LDB(B1, 1, 1); PG8_SCHED; PG8_LDA(At, 1, 0); PG8_STAGE(PG8_SA(0, 1), a2 + hstep, voffA);
            PG8_WAIT_V(8); PG8_WAIT_L(0); PG8_BAR; PG8_MMA(0, 0, At, B0); PG8_MMA(0, 1, At, B1); PG8_BAR; PG8_SCHED;
            PG8_LDA(At, 1, 1); PG8_STAGE(PG8_SB(1, 0), b3, voffB); PG8_STAGE(PG8_SB(1, 1), b3 + hstep, voffB); PG8_STAGE(PG8_SA(1, 0), a3, voffA);
            PG8_WAIT_V(8); PG8_WAIT_L(0); PG8_BAR; PG8_MMA(1, 0, At, B0); PG8_MMA(1, 1, At, B1); PG8_BAR; PG8_SCHED;
            } else {
            PG8_LDB(B0, 0, 0); PG8_SCHED; PG8_LDA(At, 0, 0); PG8_STAGE(PG8_SA(1, 1), a1 + hstep, voffA);
            PG8_WAIT_L(8); PG8_BAR; PG8_WAIT_L(0); PG8_MMA(0, 0, At, B0); PG8_BAR; PG8_SCHED;
            PG8_LDB(B1, 0, 1); PG8_STAGE(PG8_SB(0, 0), b2, voffB);
            PG8_BAR; PG8_WAIT_L(0); PG8_MMA(0, 1, At, B1); PG8_BAR;
            PG8_LDA(At, 0, 1); PG8_STAGE(PG8_SA(0, 0), a2, voffA);
            PG8_BAR; PG8_WAIT_L(0); PG8_MMA(1, 0, At, B0); PG8_BAR; PG8_SCHED;
            PG8_STAGE(PG8_SB(0, 1), b2 + hstep, voffB);
            PG8_WAIT_V(6); PG8_BAR; PG8_MMA(1, 1, At, B1); PG8_BAR;
            PG8_LDB(B0, 1, 0); PG8_SCHED; PG8_LDA(At, 1, 0); PG8_STAGE(PG8_SA(0, 1), a2 + hstep, voffA);
            PG8_WAIT_L(8); PG8_BAR; PG8_WAIT_L(0); PG8_MMA(0, 0, At, B0); PG8_BAR; PG8_SCHED;
            PG8_LDB(B1, 1, 1); PG8_STAGE(PG8_SB(1, 0), b3, voffB);
            PG8_BAR; PG8_WAIT_L(0); PG8_MMA(0, 1, At, B1); PG8_BAR;
            PG8_LDA(At, 1, 1); PG8_STAGE(PG8_SA(1, 0), a3, voffA);
            PG8_BAR; PG8_WAIT_L(0); PG8_MMA(1, 0, At, B0); PG8_BAR; PG8_SCHED;
            PG8_STAGE(PG8_SB(1, 1), b3 + hstep, voffB);
            PG8_WAIT_V(6); PG8_BAR; PG8_MMA(1, 1, At, B1); PG8_BAR;
            }
        }
        if constexpr (ALIGN_EPI) { if (wr == 0) PG8_BAR; }
        if constexpr (!Epi::AFTER_DRAIN) { E(acc, cur, wr, wc, fr, fq); S.done(cur); }
        if (!has_next) break;
#pragma unroll
        for (int a = 0; a < 2; ++a)
#pragma unroll
            for (int b = 0; b < 2; ++b)
#pragma unroll
                for (int m = 0; m < 4; ++m)
#pragma unroll
                    for (int n = 0; n < 2; ++n) acc[a][b][m][n] = (f32x4){0.f, 0.f, 0.f, 0.f};
        cur = nxt; cA = nA; cB = nB; ++ui;
        if constexpr (ALIGN_EPI) { if (wr == 1) PG8_BAR; }
    }
    PG8_WAIT_V(0);
    if constexpr (!ALIGN_EPI) { if (wr == 0) PG8_BAR; }
    PG8_BAR;
    if constexpr (Epi::AFTER_DRAIN) { E.fused(acc, cur, wr, wc, fr, fq, lds, wid, lane); S.done(cur); }
#undef PG8_SA
#undef PG8_SB
#undef PG8_STAGE
#undef PG8_LDA
#undef PG8_LDB
#undef PG8_MMA
#undef PG8_WAIT_V
#undef PG8_WAIT_L
#undef PG8_BAR
#undef PG8_SCHED
}
}
#define XB_TMO      128
#define XB_XCNT(j)  (256  + 64 * (j))
#define XB_XSUB(j)  (1280 + 64 * (j))
#define XB_XGEN(j)  (2304 + 64 * (j))
#define XB_TOP      3328
#define XB_TOPGEN   3392
#define XCD_BAR_WORDS 3456
#define XB_SPIN_CAP (1u << 18)

__device__ __forceinline__ unsigned xb_ld(unsigned* p)              { return __hip_atomic_load(p, __ATOMIC_RELAXED, __HIP_MEMORY_SCOPE_AGENT); }
__device__ __forceinline__ unsigned xb_add(unsigned* p, unsigned v) { return __hip_atomic_fetch_add(p, v, __ATOMIC_RELAXED, __HIP_MEMORY_SCOPE_AGENT); }
__device__ __forceinline__ unsigned xb_xcc_id() { return (unsigned)__builtin_amdgcn_s_getreg((3 << 11) | 20) & 0xFu; }
#define XB_SPIN(cond, bar) do { unsigned _sp = 0; while (cond) { __builtin_amdgcn_s_sleep(1); \
    if ((++_sp & 255u) == 0u) { if (xb_ld(&(bar)[XB_TMO])) break; if (_sp > XB_SPIN_CAP) { atomicAdd(&(bar)[XB_TMO], 1u); break; } } } } while (0)

struct XcdBarrier {
    unsigned* bar; unsigned x;
    volatile LAS unsigned* st;
};

__device__ __forceinline__ XcdBarrier xcd_barrier_post(unsigned* bar, volatile LAS unsigned* st) {
    XcdBarrier b; b.bar = bar; b.x = xb_xcc_id(); b.st = st;
    if (threadIdx.x == 0) (void)xb_add(&bar[XB_XCNT(b.x)], 1u);
    return b;
}
__device__ __forceinline__ void xcd_barrier_complete(unsigned* bar, unsigned x, unsigned& nloc, unsigned& nx) {
    const unsigned G = gridDim.x * gridDim.y * gridDim.z;
    unsigned sum, cnt, mine, sp = 0u;
    for (;;) {
        sum = 0u; cnt = 0u; mine = 0u;
#pragma unroll
        for (unsigned j = 0; j < 16; ++j) { const unsigned c = xb_ld(&bar[XB_XCNT(j)]); sum += c; cnt += (c > 0u) ? 1u : 0u; mine = (j == x) ? c : mine; }
        if (sum == G) break;
        __builtin_amdgcn_s_sleep(1);
        if ((++sp & 255u) == 0u) { if (xb_ld(&bar[XB_TMO])) break; if (sp > XB_SPIN_CAP) { atomicAdd(&bar[XB_TMO], 1u); break; } }
    }
    nloc = mine > 0u ? mine : 1u; nx = cnt > 0u ? cnt : 1u;
}

__device__ __forceinline__ void xcd_barrier(const XcdBarrier& b) {
    asm volatile("s_waitcnt vmcnt(0)" ::: "memory");
    __syncthreads();
    if (threadIdx.x == 0) {
        unsigned* bar = b.bar;
        __builtin_amdgcn_s_waitcnt(0);
        unsigned nloc = b.st[0], nx = b.st[1];
        if (nloc == 0u) { xcd_barrier_complete(bar, b.x, nloc, nx); b.st[0] = nloc; b.st[1] = nx; }
        const unsigned old = xb_add(&bar[XB_XSUB(b.x)], 1u);
        const unsigned gen = old / nloc;
        if (old + 1u == (gen + 1u) * nloc) {
            __builtin_amdgcn_fence(__ATOMIC_RELEASE, "agent");
            asm volatile("s_waitcnt vmcnt(0)" ::: "memory");
            const unsigned og = xb_add(&bar[XB_TOP], 1u);
            const unsigned tg = og / nx;
            if (og + 1u == (tg + 1u) * nx) xb_add(&bar[XB_TOPGEN], 1u);
            else XB_SPIN(xb_ld(&bar[XB_TOPGEN]) == tg, bar);
            __builtin_amdgcn_fence(__ATOMIC_ACQUIRE, "agent");
            xb_add(&bar[XB_XGEN(b.x)], 1u);
            asm volatile("s_waitcnt vmcnt(0)" ::: "memory");
        } else {
            XB_SPIN(xb_ld(&bar[XB_XGEN(b.x)]) == gen, bar);
            __builtin_amdgcn_fence(__ATOMIC_ACQUIRE, "agent");
            asm volatile("s_waitcnt vmcnt(0)" ::: "memory");
        }
    }
    __syncthreads();
}
namespace fx {
#define DI __device__ __forceinline__
typedef unsigned short bf16;
typedef short bf16x8 __attribute__((ext_vector_type(8)));
typedef float f32x4 __attribute__((ext_vector_type(4)));
typedef float f32x2 __attribute__((ext_vector_type(2)));
typedef unsigned u32x4 __attribute__((ext_vector_type(4)));
typedef unsigned u32x2 __attribute__((ext_vector_type(2)));
constexpr int M0 = BATCH * SEQ, MP = M0 + DEC_BATCH, MPAD = ((MP + 255) / 256) * 256;
constexpr int ACOLS = DIL_COLS + MEM_COLS, BCOLS = NSA_Q_COLS + NSA_GATE_COLS + MEM_COLS, KVCOLS = 6 * NSA_KV_HEADS * HEAD_DIM;
constexpr int NB_T = 2048;
constexpr int NPK = PEER_HEADS * 2 * PEER_KEYS;
constexpr int NCMP = (SEQ - CMP_BLOCK) / CMP_STRIDE + 1;
constexpr int NCH = SEQ / CMP_STRIDE;
constexpr int NCTX = BATCH + DEC_BATCH;
constexpr int ACROWS = NCTX * NSA_KV_HEADS * NCH;
constexpr int NPOS = PAST_LEN + 1;
constexpr float QSCALE = 0.125f * 1.4426950408889634f;
constexpr int NTHREADS = 512, NWAVES = 8, LDS_BYTES = 147456, RING_BYTES = 131072, MISC_OFF = RING_BYTES + 320;

struct FP {
    const float *x_prompt, *x_sample, *mem_prompt, *cache_dil[3], *cache_nsa_kv, *cache_nsa_win, *cache_mem_kv; const int* page_table;
    const float *w_in_a, *w_out_a, *w_in_b, *w_out_b, *w_mem_kv, *w_kv_b, *cmp_pe, *cmp_w1, *cmp_w2, *ln_g, *ln_b, *peer_wq, *peer_keys, *peer_u, *peer_v;
    float *y_prompt, *y_sample, *dil_p[3], *dil_s[3], *nsa_kv_p, *nsa_kv_s, *win_p, *win_s, *mem_kv_p;
    unsigned* ctl;
    bf16 *XB0, *X1B, *X2B, *X3B, *WA_T, *WMEM_T, *MEMB, *WOA_T, *WOB_T, *WPK_T, *WB_T, *CW1_T, *AC; unsigned char *UB8, *VB8;
    float *ROPE, *CBIAS;
    bf16 *QA, *KA, *VTA, *MQA, *MK, *MVT, *ATTA;
    float *DPART, *DML, *PRE, *X1, *X2, *X3, *SCO, *SELG; int* SELE;
    bf16 *SLK, *SLVT, *WNK, *WNVT, *QB, *MQB, *CK, *CVT, *ATTB;
    float *GATES, *UL, *CKF, *CVF;
    int* SELB;
    float* DBG;
};
struct Args { FP p; int lo, hi; };
struct Carve { size_t off = 0; template <class T> T* take(void* base, size_t n) { T* r = (T*)((char*)base + off); off += ((n * sizeof(T) + 255) / 256) * 256; return r; } };
constexpr size_t CTL_BYTES = 65536;
inline size_t carve(FP& p, void* base) {
    Carve c;
    p.ctl = c.take<unsigned>(base, CTL_BYTES / 4);
    p.XB0 = c.take<bf16>(base, (size_t)MPAD * D_MODEL); p.X1B = c.take<bf16>(base, (size_t)MPAD * D_MODEL); p.X2B = c.take<bf16>(base, (size_t)MPAD * D_MODEL); p.X3B = c.take<bf16>(base, (size_t)MPAD * D_MODEL);
    p.WA_T = c.take<bf16>(base, (size_t)ACOLS * D_MODEL); p.WMEM_T = c.take<bf16>(base, (size_t)DEPTH * 2 * MEM_COLS * D_MODEL); p.MEMB = c.take<bf16>(base, (size_t)BATCH * MEM_TOKENS * D_MODEL);
    p.WOA_T = c.take<bf16>(base, (size_t)D_MODEL * 2 * MEM_COLS); p.WOB_T = c.take<bf16>(base, (size_t)D_MODEL * (NSA_Q_COLS + MEM_COLS));
    p.WPK_T = c.take<bf16>(base, (size_t)DEPTH * NPK * D_MODEL); p.WB_T = c.take<bf16>(base, (size_t)NB_T * D_MODEL);
    p.UB8 = c.take<unsigned char>(base, (size_t)DEPTH * PEER_EXPERTS * D_MODEL); p.VB8 = c.take<unsigned char>(base, (size_t)DEPTH * PEER_EXPERTS * D_MODEL);
    p.CW1_T = c.take<bf16>(base, (size_t)2 * 256 * 1024); p.AC = c.take<bf16>(base, (size_t)2 * ACROWS * 1024);
    p.ROPE = c.take<float>(base, (size_t)NPOS * 64); p.CBIAS = c.take<float>(base, 2 * CMP_HIDDEN);
    p.QA = c.take<bf16>(base, (size_t)3 * MPAD * 256); p.KA = c.take<bf16>(base, (size_t)3 * MPAD * 256); p.VTA = c.take<bf16>(base, (size_t)3 * BATCH * DIL_HEADS * HEAD_DIM * SEQ + 4096);
    p.MQA = c.take<bf16>(base, (size_t)MPAD * 256); p.MK = c.take<bf16>(base, (size_t)DEPTH * BATCH * MEM_TOKENS * MEM_COLS); p.MVT = c.take<bf16>(base, (size_t)DEPTH * BATCH * MEM_COLS * MEM_TOKENS);
    p.ATTA = c.take<bf16>(base, (size_t)MPAD * 2 * MEM_COLS);
    p.DPART = c.take<float>(base, (size_t)3 * MP * DIL_HEADS * HEAD_DIM); p.DML = c.take<float>(base, (size_t)3 * MP * DIL_HEADS * 2);
    p.PRE = c.take<float>(base, (size_t)MPAD * D_MODEL); p.X1 = c.take<float>(base, (size_t)MPAD * D_MODEL); p.X2 = c.take<float>(base, (size_t)MPAD * D_MODEL); p.X3 = c.take<float>(base, (size_t)MPAD * D_MODEL);
    p.SCO = c.take<float>(base, (size_t)MPAD * NPK); p.SELG = c.take<float>(base, (size_t)MP * 128); p.SELE = c.take<int>(base, (size_t)MP * 128);
    p.SLK = c.take<bf16>(base, (size_t)BATCH * NSA_KV_HEADS * SEQ * HEAD_DIM); p.SLVT = c.take<bf16>(base, (size_t)BATCH * NSA_KV_HEADS * SEQ * HEAD_DIM);
    p.WNK = c.take<bf16>(base, (size_t)BATCH * NSA_KV_HEADS * SEQ * HEAD_DIM + 4096); p.WNVT = c.take<bf16>(base, (size_t)BATCH * NSA_KV_HEADS * SEQ * HEAD_DIM + 4096);
    p.QB = c.take<bf16>(base, (size_t)MPAD * NSA_Q_COLS); p.MQB = c.take<bf16>(base, (size_t)MPAD * 256);
    p.CK = c.take<bf16>(base, (size_t)NCTX * NSA_KV_HEADS * NCH * HEAD_DIM); p.CVT = c.take<bf16>(base, (size_t)NCTX * NSA_KV_HEADS * HEAD_DIM * NCH); p.ATTB = c.take<bf16>(base, (size_t)MPAD * (NSA_Q_COLS + MEM_COLS));
    p.GATES = c.take<float>(base, (size_t)MPAD * 64); p.UL = c.take<float>(base, (size_t)2 * ACROWS * 256);
    p.CKF = c.take<float>(base, (size_t)DEC_BATCH * NSA_KV_HEADS * NCH * HEAD_DIM); p.CVF = c.take<float>(base, (size_t)DEC_BATCH * NSA_KV_HEADS * NCH * HEAD_DIM);
    p.SELB = c.take<int>(base, (size_t)MP * NSA_KV_HEADS * 16);
#ifdef NSA_DEBUG
    p.DBG = c.take<float>(base, (size_t)3 * MP * 768);
#else
    p.DBG = nullptr;
#endif
    return c.off;
}
inline void bind_io(FP& p, void* const* d_in, float* out) {
    p.x_prompt = (const float*)d_in[0]; p.x_sample = (const float*)d_in[1]; p.mem_prompt = (const float*)d_in[2]; p.cache_dil[0] = (const float*)d_in[3]; p.cache_dil[1] = (const float*)d_in[4]; p.cache_dil[2] = (const float*)d_in[5];
    p.cache_nsa_kv = (const float*)d_in[6]; p.cache_nsa_win = (const float*)d_in[7]; p.cache_mem_kv = (const float*)d_in[8]; p.page_table = (const int*)d_in[9];
    p.w_in_a = (const float*)d_in[10]; p.w_out_a = (const float*)d_in[11]; p.w_in_b = (const float*)d_in[12]; p.w_out_b = (const float*)d_in[13]; p.w_mem_kv = (const float*)d_in[14]; p.w_kv_b = (const float*)d_in[15];
    p.cmp_pe = (const float*)d_in[16]; p.cmp_w1 = (const float*)d_in[17]; p.cmp_w2 = (const float*)d_in[18]; p.ln_g = (const float*)d_in[19]; p.ln_b = (const float*)d_in[20];
    p.peer_wq = (const float*)d_in[21]; p.peer_keys = (const float*)d_in[22]; p.peer_u = (const float*)d_in[23]; p.peer_v = (const float*)d_in[24];
    size_t o = 0; auto take = [&](size_t n) { float* r = out + o; o += n; return r; };
    p.y_prompt = take((size_t)M0 * D_MODEL); p.y_sample = take((size_t)DEC_BATCH * D_MODEL);
    for (int g = 0; g < 3; ++g) p.dil_p[g] = take((size_t)BATCH * DIL_W[g] * 2 * DIL_HEADS * HEAD_DIM);
    for (int g = 0; g < 3; ++g) p.dil_s[g] = take((size_t)DEC_BATCH * DIL_W[g] * 2 * DIL_HEADS * HEAD_DIM);
    p.nsa_kv_p = take((size_t)M0 * 4 * NSA_KV_HEADS * HEAD_DIM); p.nsa_kv_s = take((size_t)DEC_BATCH * 4 * NSA_KV_HEADS * HEAD_DIM);
    p.win_p = take((size_t)BATCH * SWA_WINDOW * 2 * NSA_KV_HEADS * HEAD_DIM); p.win_s = take((size_t)DEC_BATCH * SWA_WINDOW * 2 * NSA_KV_HEADS * HEAD_DIM);
    p.mem_kv_p = take((size_t)DEPTH * BATCH * MEM_TOKENS * 2 * MEM_COLS);
}
DI unsigned f2bf(float f) { unsigned u = __builtin_bit_cast(unsigned, f); return (u + 0x7fffu + ((u >> 16) & 1u)) >> 16; }
DI unsigned pk2(float lo, float hi) { return f2bf(lo) | (f2bf(hi) << 16); }
DI float bf2f(unsigned short b) { return __builtin_bit_cast(float, (unsigned)b << 16); }
DI float bflo(unsigned w) { return __builtin_bit_cast(float, w << 16); }
DI float bfhi(unsigned w) { return __builtin_bit_cast(float, w & 0xffff0000u); }
template <int CTRL> DI float dpp1(float x) { return __builtin_bit_cast(float, __builtin_amdgcn_update_dpp(0, __builtin_bit_cast(int, x), CTRL, 0xF, 0xF, true)); }
DI float wave_sum(float v) { v += dpp1<0xB1>(v); v += dpp1<0x4E>(v); v += dpp1<0x141>(v); v += dpp1<0x140>(v);
    float a = v, b = v; asm volatile("s_nop 1\n\tv_permlane16_swap_b32 %0, %1" : "+v"(a), "+v"(b)); v = a + b; a = v; b = v;
    asm volatile("s_nop 1\n\tv_permlane32_swap_b32 %0, %1" : "+v"(a), "+v"(b)); return a + b; }
DI float wave_max(float v) { v = fmaxf(v, dpp1<0xB1>(v)); v = fmaxf(v, dpp1<0x4E>(v)); v = fmaxf(v, dpp1<0x141>(v)); v = fmaxf(v, dpp1<0x140>(v));
    float a = v, b = v; asm volatile("s_nop 1\n\tv_permlane16_swap_b32 %0, %1" : "+v"(a), "+v"(b)); v = fmaxf(a, b); a = v; b = v;
    asm volatile("s_nop 1\n\tv_permlane32_swap_b32 %0, %1" : "+v"(a), "+v"(b)); return fmaxf(a, b); }
DI float gelu_tanh(float x) { const float u = 0.7978845608028654f * (x + 0.044715f * x * x * x); const float e = __builtin_amdgcn_exp2f(u * 2.885390081777927f);   const float t = 1.0f - 2.0f / (e + 1.0f); return 0.5f * x * (1.0f + t); }
DI float* sel3(float* const (&a)[3], int g) { return g == 0 ? a[0] : (g == 1 ? a[1] : a[2]); }
DI const float* sel3c(const float* const (&a)[3], int g) { return g == 0 ? a[0] : (g == 1 ? a[1] : a[2]); }
__host__ DI size_t ktile_off(int t, int d) { const int blk = t >> 5, kk = t & 31, b = (kk >> 2) & 1, i = 4 * (kk >> 3) + (kk & 3), s = d >> 5, c = (d & 31) >> 3; return ((size_t)(blk * 4 + 2 * b + s) * 64 + i + 16 * c) * 8 + (d & 7); }
__host__ DI size_t vtile_off(int dim, int t) { const int blk = t >> 5, kk = t & 31; return ((size_t)(blk * 4 + (dim >> 4)) * 64 + (dim & 15) + 16 * (kk >> 3)) * 8 + (kk & 7); }
struct Ctx { LAS unsigned char* lds; int tid, lane, wave, vcu, G; };
DI int row_pos(int r) { return r < M0 ? (r & (SEQ - 1)) : PAST_LEN; }

struct ColSrc { const float* p; int ld; };
DI int rope_il(int e) { return (e >> 1) + 32 * (e & 1); }
DI ColSrc col_wa(const FP& P, int n) {
    const int t = n >> 8, ct = n & 255, h = ct >> 6, e = ct & 63; if (t >= 9) return ColSrc{P.w_in_a + DIL_COLS + ct, ACOLS};
    const int j = t % 3, d = (j < 2) ? rope_il(e) : e; return ColSrc{P.w_in_a + t * 256 + h * 64 + d, ACOLS}; }
DI ColSrc col_wb(const FP& P, int n) {
    const int t = n >> 8, ct = n & 255, e = ct & 63;
    if (t < 3) { const int ty = 2 * t + (ct >> 7), kvh = (ct >> 6) & 1; const bool rot = (ty == 2 || ty == 4); return ColSrc{P.w_kv_b + (ty * NSA_KV_HEADS + kvh) * 64 + (rot ? rope_il(e) : e), KVCOLS}; }
    if (t < 6) { const int h = (t - 3) * 4 + (ct >> 6); return ColSrc{P.w_in_b + h * 64 + rope_il(e), BCOLS}; }
    if (t == 6) return ColSrc{P.w_in_b + NSA_Q_COLS + NSA_GATE_COLS + ct, BCOLS};
    if (ct < NSA_GATE_COLS) return ColSrc{P.w_in_b + NSA_Q_COLS + ct, BCOLS};
    return ColSrc{nullptr, 0}; }
DI ColSrc col_wmem(const FP& P, int n) { const int l = n >> 9, c = n & 511; return ColSrc{P.w_mem_kv + (size_t)l * D_MODEL * 512 + c, 512}; }
DI ColSrc col_woa(const FP& P, int n) { return ColSrc{P.w_out_a + n, D_MODEL}; }
DI ColSrc col_wob(const FP& P, int n) { return ColSrc{P.w_out_b + n, D_MODEL}; }
DI ColSrc col_cw1(const FP& P, int n) {
    const int ty = n >> 8, half = (n >> 7) & 1, hid = n & 127; return ColSrc{P.cmp_w1 + (size_t)ty * CMP_BLOCK * HEAD_DIM * CMP_HIDDEN + (size_t)half * 16 * HEAD_DIM * CMP_HIDDEN + hid, CMP_HIDDEN}; }
template <class CF> DI void transpose_item(const FP& P, CF cf, int K, bf16* WT, LAS float* scr, int item, int nblk, int lane) {
    const int kb = item / nblk, nb = item % nblk, k0 = 64 * kb, n0 = 32 * nb;
    const ColSrc cs = cf(P, n0 + (lane & 31));
#pragma unroll 8
    for (int i = 0; i < 32; ++i) { const int kk = 2 * i + (lane >> 5); scr[kk * 33 + (lane & 31)] = cs.p ? cs.p[(size_t)(k0 + kk) * cs.ld] : 0.f; }
    asm volatile("s_waitcnt lgkmcnt(0)" ::: "memory");
    const int c = lane & 7;
#pragma unroll
    for (int j = 0; j < 4; ++j) { const int n = (lane >> 3) + 8 * j; const LAS float* s = scr + (8 * c) * 33 + n;
        u32x4 o; o.x = pk2(s[0 * 33], s[1 * 33]); o.y = pk2(s[2 * 33], s[3 * 33]); o.z = pk2(s[4 * 33], s[5 * 33]); o.w = pk2(s[6 * 33], s[7 * 33]);
        *(u32x4*)(WT + (size_t)(n0 + n) * K + k0 + 8 * c) = o; }
    asm volatile("s_waitcnt lgkmcnt(0)" ::: "memory");
}
DI void cvt_row1024(const float* src, bf16* dst, int lane) {
#pragma unroll
    for (int j = 0; j < 4; ++j) { f32x4 v = src ? *(const f32x4*)(src + 256 * j + 4 * lane) : (f32x4){0.f, 0.f, 0.f, 0.f}; u32x2 o; o.x = pk2(v.x, v.y); o.y = pk2(v.z, v.w); *(u32x2*)(dst + 256 * j + 4 * lane) = o; }
}
DI void cvt_row1024_fp8(const float* src, unsigned char* dst, float sc, int lane) { u32x4 o; unsigned w[4];
#pragma unroll
    for (int j = 0; j < 4; ++j) { const f32x4 v = *(const f32x4*)(src + 16 * lane + 4 * j) * sc; int t = __builtin_amdgcn_cvt_pk_fp8_f32(v.x, v.y, 0, false); t = __builtin_amdgcn_cvt_pk_fp8_f32(v.z, v.w, t, true); w[j] = (unsigned)t; }
    o.x = w[0]; o.y = w[1]; o.z = w[2]; o.w = w[3]; *(u32x4*)(dst + 16 * lane) = o; }
DI void p0_prologue(const FP& P, const Ctx& C) {
    LAS float* scr = (LAS float*)(C.lds + C.wave * 16384);
    const int gw = C.vcu * NWAVES + C.wave, NGW = C.G * NWAVES, lane = C.lane;
    { constexpr int IA = (D_MODEL / 64) * (ACOLS / 32), IM = (D_MODEL / 64) * (1024 / 32), IOA = (512 / 64) * (D_MODEL / 32), IOB = (1024 / 64) * (D_MODEL / 32), IB = (D_MODEL / 64) * (NB_T / 32), IC = (1024 / 64) * (512 / 32);
      constexpr int NIT = IA + IM + IOA + IOB + IB + IC;
      for (int it = gw; it < NIT; it += NGW) { int r = it;
          if (r < IA) { transpose_item(P, col_wa, D_MODEL, P.WA_T, scr, r, ACOLS / 32, lane); continue; } r -= IA;
          if (r < IM) { transpose_item(P, col_wmem, D_MODEL, P.WMEM_T, scr, r, 1024 / 32, lane); continue; } r -= IM;
          if (r < IOA) { transpose_item(P, col_woa, 512, P.WOA_T, scr, r, D_MODEL / 32, lane); continue; } r -= IOA;
          if (r < IOB) { transpose_item(P, col_wob, 1024, P.WOB_T, scr, r, D_MODEL / 32, lane); continue; } r -= IOB;
          if (r < IB) { transpose_item(P, col_wb, D_MODEL, P.WB_T, scr, r, NB_T / 32, lane); continue; } r -= IB;
          transpose_item(P, col_cw1, 1024, P.CW1_T, scr, r, 512 / 32, lane); } }
    for (int r = gw; r < MPAD; r += NGW) { cvt_row1024(r < M0 ? P.x_prompt + (size_t)r * D_MODEL : (r < MP ? P.x_sample + (size_t)(r - M0) * D_MODEL : nullptr), P.XB0 + (size_t)r * D_MODEL, lane);
        if (r >= MP) { cvt_row1024(nullptr, P.X1B + (size_t)r * D_MODEL, lane); cvt_row1024(nullptr, P.X2B + (size_t)r * D_MODEL, lane); cvt_row1024(nullptr, P.X3B + (size_t)r * D_MODEL, lane);
            for (int c = lane; c < 512; c += 64) { P.ATTA[(size_t)r * 512 + c] = 0; P.ATTB[(size_t)r * 1024 + c] = 0; P.ATTB[(size_t)r * 1024 + 512 + c] = 0; } } }
    for (int r = gw; r < BATCH * MEM_TOKENS; r += NGW) cvt_row1024(P.mem_prompt + (size_t)r * D_MODEL, P.MEMB + (size_t)r * D_MODEL, lane);
#pragma unroll 1
    for (int r = 2 * gw; r < DEPTH * PEER_EXPERTS; r += 2 * NGW) { f32x4 a[16];
#pragma unroll
        for (int q = 0; q < 4; ++q) { const float* s0 = (q < 2 ? P.peer_u : P.peer_v) + (size_t)(r + (q & 1)) * D_MODEL + 16 * lane;
#pragma unroll
            for (int j = 0; j < 4; ++j) a[4 * q + j] = *(const f32x4*)(s0 + 4 * j); }
#pragma unroll
        for (int q = 0; q < 4; ++q) { const float sc = q < 2 ? 256.f : 64.f; unsigned w[4];
#pragma unroll
            for (int j = 0; j < 4; ++j) { const f32x4 v = a[4 * q + j] * sc; int t = __builtin_amdgcn_cvt_pk_fp8_f32(v.x, v.y, 0, false); t = __builtin_amdgcn_cvt_pk_fp8_f32(v.z, v.w, t, true); w[j] = (unsigned)t; }
            u32x4 o; o.x = w[0]; o.y = w[1]; o.z = w[2]; o.w = w[3]; *(u32x4*)((q < 2 ? P.UB8 : P.VB8) + (size_t)(r + (q & 1)) * D_MODEL + 16 * lane) = o; } }
    for (int i = gw * 64 + lane; i < NPOS * 32; i += NGW * 64) { const int pos = i >> 5, d = i & 31; const double inv = exp2(-(double)d * (13.287712379549449 / 32.0)); const double turns = (double)pos * inv * 0.15915494309189535;
        const float fr = (float)(turns - floor(turns)); P.ROPE[pos * 64 + d] = __builtin_amdgcn_cosf(fr); P.ROPE[pos * 64 + 32 + d] = __builtin_amdgcn_sinf(fr); }
    for (int i = gw; i < 2 * CMP_HIDDEN; i += NGW) { const int ty = i / CMP_HIDDEN, hid = i % CMP_HIDDEN; float a = 0.f;
#pragma unroll 8
        for (int k = lane; k < CMP_BLOCK * HEAD_DIM; k += 64) a += P.cmp_pe[ty * CMP_BLOCK * HEAD_DIM + k] * P.cmp_w1[((size_t)ty * CMP_BLOCK * HEAD_DIM + k) * CMP_HIDDEN + hid];
        a = wave_sum(a); if (lane == 0) P.CBIAS[i] = a; }
    for (int it = gw; it < DEC_BATCH * (PAST_LEN / PAGE_SIZE); it += NGW) { const int n = it / (PAST_LEN / PAGE_SIZE), pi = it % (PAST_LEN / PAGE_SIZE); const int pg = P.page_table[it];
        const float* src = P.cache_nsa_kv + (size_t)pg * PAGE_SIZE * 512 + 4 * lane; const int ty = lane >> 5, kvh = (lane >> 4) & 1, d = (4 * lane) & 63;
        bf16* dst = P.AC + ((size_t)ty * ACROWS + ((size_t)(BATCH + n) * NSA_KV_HEADS + kvh) * NCH + pi * (PAGE_SIZE / 16)) * 1024 + d;
#pragma unroll 1
        for (int r0 = 0; r0 < PAGE_SIZE; r0 += 8) { f32x4 v[8];
#pragma unroll
            for (int u = 0; u < 8; ++u) v[u] = *(const f32x4*)(src + (size_t)(r0 + u) * 512);
#pragma unroll
            for (int u = 0; u < 8; ++u) { const int t = r0 + u; u32x2 o; o.x = pk2(v[u].x, v[u].y); o.y = pk2(v[u].z, v[u].w); *(u32x2*)(dst + (size_t)(t / 16) * 1024 + (t % 16) * 64) = o; } } }
    for (int g = 0; g < 4; ++g) { const int W = g < 3 ? dil_w(g) : SWA_WINDOW, RV = g < 3 ? 128 : 64;
        const f32x4* src = (const f32x4*)(g < 3 ? sel3c(P.cache_dil, g) : P.cache_nsa_win); f32x4* dst = (f32x4*)(g < 3 ? sel3(P.dil_s, g) : P.win_s);
        const long per = (long)(W - 1) * RV, nvec = (long)DEC_BATCH * per;
#pragma unroll 1
        for (long i0 = (long)gw * 512; i0 < nvec; i0 += (long)NGW * 512) { f32x4 v[8]; long idx[8];
#pragma unroll
            for (int u = 0; u < 8; ++u) { const long i = i0 + u * 64 + lane; const long ii = i < nvec ? i : nvec - 1; const long n = ii / per, o = ii % per; idx[u] = n * (per + RV) + o; v[u] = src[idx[u] + RV]; }
#pragma unroll
            for (int u = 0; u < 8; ++u) { const long i = i0 + u * 64 + lane; if (i < nvec) dst[idx[u]] = v[u]; } } }
}
DI void p0_wpk(const FP& P, const Ctx& C) {
    LAS float* sw = (LAS float*)C.lds;
    LAS float* sk = (LAS float*)(C.lds + 32768);
    constexpr int NIT = DEPTH * 16 * (D_MODEL / 64);
    for (int it = C.vcu; it < NIT; it += C.G) { const int l = it / (16 * (D_MODEL / 64)), rem = it % (16 * (D_MODEL / 64)), hc = rem / (D_MODEL / 64), kb = rem % (D_MODEL / 64);
        __syncthreads();
        for (int i = C.tid; i < 64 * 64; i += NTHREADS) { const int r = i >> 6, d = i & 63; sw[r * 65 + d] = P.peer_wq[((size_t)l * D_MODEL + kb * 64 + r) * 1024 + hc * 64 + d]; }
        for (int i = C.tid; i < 128 * 64; i += NTHREADS) { const int r = i >> 6, d = i & 63; sk[r * 65 + d] = P.peer_keys[(((size_t)l * 16 + hc) * PEER_KEYS + r) * 64 + d]; }
        __syncthreads();
        for (int o = C.tid; o < 128 * 64; o += NTHREADS) { const int kk = o >> 6, ki = o & 63; float a = 0.f;
#pragma unroll 16
            for (int d = 0; d < 64; ++d) a += sw[ki * 65 + d] * sk[kk * 65 + d];
            P.WPK_T[((size_t)l * NPK + hc * 128 + kk) * D_MODEL + kb * 64 + ki] = (bf16)f2bf(a); } }
    __syncthreads();
}

#define EPI_LOOP(...) int fr_l = fr, fq_l = fq; asm volatile("" : "+v"(fr_l), "+v"(fq_l));     \
    _Pragma("unroll") for (int ai = 0; ai < 2; ++ai) _Pragma("unroll") for (int m = 0; m < 4; ++m) { const int row = u.pm * 256 + ai * 128 + wr * 64 + m * 16 + fr_l; \
    _Pragma("unroll") for (int bj = 0; bj < 2; ++bj) { const int ct = bj * 128 + wc * 32 + fq_l * 8; const f32x4 v0 = acc[ai][bj][m][0], v1 = acc[ai][bj][m][1]; __VA_ARGS__ } asm volatile("" ::: "memory"); }
DI void rope4(const float* rope_row, int dp, const f32x4& v0, const f32x4& v1, f32x4& lo, f32x4& hi) {
    const f32x4 c = *(const f32x4*)(rope_row + dp), s = *(const f32x4*)(rope_row + 32 + dp);
    lo.x = v0.x * c.x - v0.y * s.x; hi.x = v0.y * c.x + v0.x * s.x; lo.y = v0.z * c.y - v0.w * s.y; hi.y = v0.w * c.y + v0.z * s.y;
    lo.z = v1.x * c.z - v1.y * s.z; hi.z = v1.y * c.z + v1.x * s.z; lo.w = v1.z * c.w - v1.w * s.w; hi.w = v1.w * c.w + v1.z * s.w; }
DI u32x2 pk4(const f32x4& v) { u32x2 o; o.x = pk2(v.x, v.y); o.y = pk2(v.z, v.w); return o; }
DI u32x4 pk8(const f32x4& a, const f32x4& b) { u32x4 o; o.x = pk2(a.x, a.y); o.y = pk2(a.z, a.w); o.z = pk2(b.x, b.y); o.w = pk2(b.z, b.w); return o; }
DI int dil_perm(int t, int d) { return (t % d) * (SEQ / d) + t / d; }
struct EpiA {
    static constexpr bool PERM = true, AFTER_DRAIN = false; const FP& P;
    DI void operator()(const f32x4 (&acc)[2][2][4][2], const pg8::Unit& u, int wr, int wc, int fr, int fq) const {
        const int t9 = u.pn; const int g = t9 / 3, j = t9 % 3;
        EPI_LOOP({ if (row < MP) { const int h = ct >> 6, e = ct & 63; const int pos = row_pos(row);
            if (t9 == 9) { *(u32x4*)(P.MQA + (size_t)row * 256 + ct) = pk8(v0 * QSCALE, v1 * QSCALE); }
            else if (j < 2) { f32x4 lo, hi; const int dp = e >> 1; rope4(P.ROPE + pos * 64, dp, v0, v1, lo, hi);
                if (j == 0) { bf16* q = P.QA + ((size_t)g * MPAD + row) * 256 + h * 64 + dp; *(u32x2*)q = pk4(lo * QSCALE); *(u32x2*)(q + 32) = pk4(hi * QSCALE); }
                else { if (row < M0) { bf16* kt = P.KA + ((size_t)(g * BATCH + row / SEQ) * DIL_HEADS + h) * 64 * SEQ; const int cm = dil_perm(pos, dil_d(g)); *(u32x2*)(kt + ktile_off(cm, dp)) = pk4(lo); *(u32x2*)(kt + ktile_off(cm, dp + 32)) = pk4(hi); }
                    const int W = dil_w(g); float* o = nullptr;
                    if (row >= M0) o = sel3(P.dil_s, g) + (((size_t)(row - M0) * W + W - 1) * 2 + 0) * 256; else if (pos >= SEQ - W) o = sel3(P.dil_p, g) + (((size_t)(row / SEQ) * W + pos - (SEQ - W)) * 2 + 0) * 256;
                    if (o) { *(f32x4*)(o + h * 64 + dp) = lo; *(f32x4*)(o + h * 64 + 32 + dp) = hi; } } }
            else { const int W = dil_w(g), d = dil_d(g); float* o = nullptr;
                if (row >= M0) o = sel3(P.dil_s, g) + (((size_t)(row - M0) * W + W - 1) * 2 + 1) * 256; else if (pos >= SEQ - W) o = sel3(P.dil_p, g) + (((size_t)(row / SEQ) * W + pos - (SEQ - W)) * 2 + 1) * 256;
                if (o) { *(f32x4*)(o + ct) = v0; *(f32x4*)(o + ct + 4) = v1; }
                if (row < M0) { bf16* vt = P.VTA + ((size_t)(g * BATCH + row / SEQ) * DIL_HEADS + h) * 64 * SEQ + vtile_off(e, dil_perm(pos, d));
                    vt[0] = (bf16)f2bf(v0.x); vt[8] = (bf16)f2bf(v0.y); vt[16] = (bf16)f2bf(v0.z); vt[24] = (bf16)f2bf(v0.w); vt[32] = (bf16)f2bf(v1.x); vt[40] = (bf16)f2bf(v1.y); vt[48] = (bf16)f2bf(v1.z); vt[56] = (bf16)f2bf(v1.w); } } } })
    }
};
struct EpiMem {
    static constexpr bool PERM = true, AFTER_DRAIN = false; const FP& P;
    DI void operator()(const f32x4 (&acc)[2][2][4][2], const pg8::Unit& u, int wr, int wc, int fr, int fq) const {
        const int l = u.pn >> 1, half = u.pn & 1;
        EPI_LOOP({ const int n = row / MEM_TOKENS, mt = row % MEM_TOKENS; float* o = P.mem_kv_p + (((size_t)l * BATCH + n) * MEM_TOKENS + mt) * 512 + half * 256 + ct; *(f32x4*)o = v0; *(f32x4*)(o + 4) = v1;
            if (half == 0) *(u32x4*)(P.MK + (((size_t)l * BATCH + n) * MEM_HEADS + (ct >> 6)) * MEM_TOKENS * 64 + ktile_off(mt, ct & 63)) = pk8(v0, v1);
            else { bf16* vt = P.MVT + (((size_t)l * BATCH + n) * MEM_HEADS + (ct >> 6)) * MEM_TOKENS * 64 + vtile_off(ct & 63, mt);
                vt[0] = (bf16)f2bf(v0.x); vt[8] = (bf16)f2bf(v0.y); vt[16] = (bf16)f2bf(v0.z); vt[24] = (bf16)f2bf(v0.w); vt[32] = (bf16)f2bf(v1.x); vt[40] = (bf16)f2bf(v1.y); vt[48] = (bf16)f2bf(v1.z); vt[56] = (bf16)f2bf(v1.w); } })
    }
};
struct EpiPre {
    static constexpr bool PERM = true, AFTER_DRAIN = false; const float* xa; const float* xb; float* pre;
    DI void operator()(const f32x4 (&acc)[2][2][4][2], const pg8::Unit& u, int wr, int wc, int fr, int fq) const {
        EPI_LOOP({ if (row < MP) { const int col = u.pn * 256 + ct; const float* x = (xb && row >= M0) ? xb + (size_t)(row - M0) * D_MODEL + col : xa + (size_t)row * D_MODEL + col;
            const f32x4 a = *(const f32x4*)x, b = *(const f32x4*)(x + 4); float* o = pre + (size_t)row * D_MODEL + col; *(f32x4*)o = a * ALPHA + v0; *(f32x4*)(o + 4) = b * ALPHA + v1; } })
    }
};
struct EpiF32 {
    static constexpr bool PERM = true, AFTER_DRAIN = false; float* out; int ldc; int nrows;
    DI void operator()(const f32x4 (&acc)[2][2][4][2], const pg8::Unit& u, int wr, int wc, int fr, int fq) const {
        EPI_LOOP({ if (row < nrows) { float* o = out + (size_t)row * ldc + u.pn * 256 + ct; *(f32x4*)o = v0; *(f32x4*)(o + 4) = v1; } })
    }
};
}
namespace fx {
struct Tile16 { f32x4 o[4]; float m, l; };
DI void tile_init(Tile16& T) { T.o[0] = T.o[1] = T.o[2] = T.o[3] = (f32x4){0.f, 0.f, 0.f, 0.f}; T.m = -INFINITY; T.l = 0.f; }
typedef __bf16 bf16x2_t __attribute__((ext_vector_type(2)));
DI unsigned cvtpk(float lo, float hi) { const f32x2 v = {lo, hi}; const bf16x2_t b = __builtin_convertvector(v, bf16x2_t); return __builtin_bit_cast(unsigned, b); }
struct KV8 { bf16x8 ka0, ka1, kb0, kb1, v0, v1, v2, v3; };
DI void kv_load(KV8& r, const bf16* k0, const bf16* k1, const bf16* v, long vs16) {
    r.ka0 = *(const bf16x8*)k0; r.ka1 = *(const bf16x8*)(k0 + 32); r.kb0 = *(const bf16x8*)k1; r.kb1 = *(const bf16x8*)(k1 + 32);
    r.v0 = *(const bf16x8*)v; r.v1 = *(const bf16x8*)(v + vs16); r.v2 = *(const bf16x8*)(v + 2 * vs16); r.v3 = *(const bf16x8*)(v + 3 * vs16); }
DI void mk_range(int a, int b, bool ok, int& lo, unsigned& rng) { const bool v = ok && b >= a; lo = v ? a : (1 << 20); rng = v ? (unsigned)(b - a) : 0u; }
DI float colmax(float x) { float a = x, b = x; asm volatile("s_nop 1\n\tv_permlane32_swap_b32 %0, %1" : "+v"(a), "+v"(b)); float m = fmaxf(a, b); a = m; b = m;
    asm volatile("s_nop 1\n\tv_permlane16_swap_b32 %0, %1" : "+v"(a), "+v"(b)); return fmaxf(a, b); }
DI float colsum(float x) { float a = x, b = x; asm volatile("s_nop 1\n\tv_permlane32_swap_b32 %0, %1" : "+v"(a), "+v"(b)); float m = a + b; a = m; b = m;
    asm volatile("s_nop 1\n\tv_permlane16_swap_b32 %0, %1" : "+v"(a), "+v"(b)); return a + b; }
DI void tile_compute(Tile16& T, const bf16x8 (&qf)[2], const KV8& r, int lo, unsigned rng) {
    f32x4 s0 = (f32x4){0.f, 0.f, 0.f, 0.f}, s1 = (f32x4){0.f, 0.f, 0.f, 0.f};
    s0 = __builtin_amdgcn_mfma_f32_16x16x32_bf16(r.ka0, qf[0], s0, 0, 0, 0); s0 = __builtin_amdgcn_mfma_f32_16x16x32_bf16(r.ka1, qf[1], s0, 0, 0, 0);
    s1 = __builtin_amdgcn_mfma_f32_16x16x32_bf16(r.kb0, qf[0], s1, 0, 0, 0); s1 = __builtin_amdgcn_mfma_f32_16x16x32_bf16(r.kb1, qf[1], s1, 0, 0, 0);
    float s[8] = {s0.x, s0.y, s0.z, s0.w, s1.x, s1.y, s1.z, s1.w};
    float mx = -INFINITY;
#pragma unroll
    for (int e = 0; e < 8; ++e) { s[e] = ((unsigned)(e - lo) <= rng) ? s[e] : -INFINITY; mx = fmaxf(mx, s[e]); }
    mx = colmax(mx);
    const float mnew = fmaxf(T.m, mx), muse = (mnew == -INFINITY) ? 0.f : mnew;
    const float alpha = __builtin_amdgcn_exp2f(T.m - muse);
    float ls = 0.f;
#pragma unroll
    for (int e = 0; e < 8; ++e) { s[e] = __builtin_amdgcn_exp2f(s[e] - muse); ls += s[e]; }
    T.l = T.l * alpha + ls; T.m = mnew;
    u32x4 pw; pw.x = cvtpk(s[0], s[1]); pw.y = cvtpk(s[2], s[3]); pw.z = cvtpk(s[4], s[5]); pw.w = cvtpk(s[6], s[7]);
    const bf16x8 pf = __builtin_bit_cast(bf16x8, pw);
    T.o[0] = __builtin_amdgcn_mfma_f32_16x16x32_bf16(r.v0, pf, T.o[0] * alpha, 0, 0, 0); T.o[1] = __builtin_amdgcn_mfma_f32_16x16x32_bf16(r.v1, pf, T.o[1] * alpha, 0, 0, 0);
    T.o[2] = __builtin_amdgcn_mfma_f32_16x16x32_bf16(r.v2, pf, T.o[2] * alpha, 0, 0, 0); T.o[3] = __builtin_amdgcn_mfma_f32_16x16x32_bf16(r.v3, pf, T.o[3] * alpha, 0, 0, 0);
}
template <class BUF, class LD, class CP> DI void pipe2t(int n, LD ld, CP cp) { if (n <= 0) return; BUF A, B; ld(A, 0);
#pragma unroll 1
    for (int i = 0; i < n; i += 2) { ld(B, (i + 1 < n) ? i + 1 : i); cp(A, i); ld(A, (i + 2 < n) ? i + 2 : i); if (i + 1 < n) cp(B, i + 1); } }
template <class LD, class CP> DI void pipe2(int n, LD ld, CP cp) { if (n <= 0) return; KV8 A, B; ld(A, 0);
#pragma unroll 1
    for (int i = 0; i < n; i += 2) { ld(B, (i + 1 < n) ? i + 1 : i); cp(A, i); ld(A, (i + 2 < n) ? i + 2 : i); if (i + 1 < n) cp(B, i + 1); } }
DI void kv_load_t(KV8& r, const bf16* kt, const bf16* vt, int lane) {
    const bf16* k = kt + lane * 8; const bf16* v = vt + lane * 8;
    r.ka0 = *(const bf16x8*)k; r.ka1 = *(const bf16x8*)(k + 512); r.kb0 = *(const bf16x8*)(k + 1024); r.kb1 = *(const bf16x8*)(k + 1536);
    r.v0 = *(const bf16x8*)v; r.v1 = *(const bf16x8*)(v + 512); r.v2 = *(const bf16x8*)(v + 1024); r.v3 = *(const bf16x8*)(v + 1536); }
DI int krow_of(int i, int b) { return 8 * (i >> 2) + 4 * b + (i & 3); }

DI void dil_micro(const FP& P, int n, int h, int t0, int mt, int lane) {
    const int g = mt >> 4, idx = mt & 15, d = dil_d(g), per = 16 / d;
    const int r = idx / per, sub = idx % per, i0 = t0 / d + 16 * sub, ib = i0 - 128, NC = SEQ / d;
    const int q = lane & 15, c = lane >> 4;
    const bf16* Qb = P.QA + ((size_t)g * MPAD + (size_t)n * SEQ) * 256 + h * 64;
    const bf16* Kb = P.KA + ((size_t)(g * BATCH + n) * DIL_HEADS + h) * 64 * SEQ + (size_t)r * NC * 64; const bf16* Vb = P.VTA + ((size_t)(g * BATCH + n) * DIL_HEADS + h) * 64 * SEQ + (size_t)r * NC * 64;
    bf16x8 qf[2]; { const bf16* qp = Qb + (size_t)(r + d * (i0 + q)) * 256 + 8 * c; qf[0] = *(const bf16x8*)qp; qf[1] = *(const bf16x8*)(qp + 32); }
    Tile16 T; tile_init(T);
    const int qi = i0 + q; const int tb0 = ib >> 5  , nblk = ((i0 + 15) >> 5) - tb0 + 1;
    pipe2(nblk, [&](KV8& kv, int i) { int tb = tb0 + i; tb = tb < 0 ? 0 : tb; kv_load_t(kv, Kb + (size_t)tb * 2048, Vb + (size_t)tb * 2048, lane); },
          [&](const KV8& kv, int i) { const int k0 = 32 * (tb0 + i) + 8 * c; int lo; unsigned rng; const int a = qi - (DIL_TAPS - 1); mk_range((a > 0 ? a : 0) - k0, qi - k0, true, lo, rng); tile_compute(T, qf, kv, lo, rng); });
    const int row = n * SEQ + r + d * qi;
    float* op = P.DPART + (((size_t)g * MP + row) * DIL_HEADS + h) * 64 + 4 * c;
#pragma unroll
    for (int db = 0; db < 4; ++db) *(f32x4*)(op + 16 * db) = T.o[db];
    T.l = colsum(T.l);
    if (c == 0) { float* ml = P.DML + (((size_t)g * MP + row) * DIL_HEADS + h) * 2; ml[0] = T.m; ml[1] = T.l; }
}
DI void mem_micro(const FP& P, const bf16* Q  , int ldq, int row0, int layer, int n, int h, bf16* O  , int ldo, int lane) {
    const int q = lane & 15, c = lane >> 4;
    bf16x8 qf[2]; { const bf16* qp = Q + (size_t)(row0 + q) * ldq + 8 * c; qf[0] = *(const bf16x8*)qp; qf[1] = *(const bf16x8*)(qp + 32); }
    const bf16* Kb = P.MK + (((size_t)layer * BATCH + n) * MEM_HEADS + h) * MEM_TOKENS * 64; const bf16* Vb = P.MVT + (((size_t)layer * BATCH + n) * MEM_HEADS + h) * MEM_TOKENS * 64;
    Tile16 T; tile_init(T);
    pipe2(MEM_TOKENS / 32, [&](KV8& kv, int i) { kv_load_t(kv, Kb + (size_t)i * 2048, Vb + (size_t)i * 2048, lane); }, [&](const KV8& kv, int) { tile_compute(T, qf, kv, -8, 64u); });
    const float inv = 1.0f / colsum(T.l); bf16* op = O + (size_t)(row0 + q) * ldo + 4 * c;
#pragma unroll
    for (int db = 0; db < 4; ++db) *(u32x2*)(op + 16 * db) = pk4(T.o[db] * inv);
}
struct Dec { float m, l, o; };
template <class KF, class VF> DI void dec_chunk(Dec& D, const LAS float* q, int nk, KF kf, VF vf, int lane) {
    float s = -INFINITY;
    if (lane < nk) { const float* k = kf(lane); float a = 0.f;
#pragma unroll
        for (int d4 = 0; d4 < 16; ++d4) { const f32x4 kv = *(const f32x4*)(k + 4 * d4); a += kv.x * q[4 * d4] + kv.y * q[4 * d4 + 1] + kv.z * q[4 * d4 + 2] + kv.w * q[4 * d4 + 3]; }
        s = a; }
    const float mx = wave_max(s), mnew = fmaxf(D.m, mx), alpha = __builtin_amdgcn_exp2f(D.m - mnew);
    const float p = (lane < nk) ? __builtin_amdgcn_exp2f(s - mnew) : 0.f;
    D.l = D.l * alpha + wave_sum(p); D.m = mnew; float o = D.o * alpha;
    for (int j0 = 0; j0 < nk; j0 += 8) { float vv[8];
#pragma unroll
        for (int u = 0; u < 8; ++u) { const int jj = (j0 + u < nk) ? j0 + u : nk - 1; vv[u] = vf(jj)[lane]; }
#pragma unroll
        for (int u = 0; u < 8; ++u) { const float pj = (j0 + u < nk) ? __builtin_bit_cast(float, __builtin_amdgcn_readlane(__builtin_bit_cast(int, p), (j0 + u) & 63)) : 0.f; o += pj * vv[u]; } }
    D.o = o;
}
DI float dec_combine(const Ctx& C, const Dec& D) {
    LAS float* cb = (LAS float*)(C.lds + 4096);
    cb[C.wave * 66 + C.lane] = D.o; if (C.lane == 0) { cb[C.wave * 66 + 64] = D.m; cb[C.wave * 66 + 65] = D.l; }
    asm volatile("s_waitcnt lgkmcnt(0)" ::: "memory"); __syncthreads();
    float M = -INFINITY;
#pragma unroll
    for (int ww = 0; ww < NWAVES; ++ww) M = fmaxf(M, cb[ww * 66 + 64]);
    float L = 0.f, o = 0.f;
#pragma unroll
    for (int ww = 0; ww < NWAVES; ++ww) { const float mw = cb[ww * 66 + 64]; const float f = (mw == -INFINITY) ? 0.f : __builtin_amdgcn_exp2f(mw - M); L += f * cb[ww * 66 + 65]; o += f * cb[ww * 66 + C.lane]; }
    return o / L;
}
DI void atta_phase(const FP& P, const Ctx& C) {
    const int lane = C.lane, w = C.wave;
    constexpr int NT = SEQ / 256, NIT = BATCH * NT * DIL_HEADS;
    for (int it = C.vcu; it < NIT; it += C.G) { const int h = it % DIL_HEADS, tt = (it / DIL_HEADS) % NT, n = it / (DIL_HEADS * NT), t0 = tt * 256;
        for (int mt = w; mt < 48; mt += NWAVES) dil_micro(P, n, h, t0, mt, lane);
        asm volatile("s_waitcnt vmcnt(0)" ::: "memory"); __syncthreads();
        for (int i = C.tid; i < 256 * 16; i += NTHREADS) { const int tk = i >> 4, d4 = (i & 15) * 4; const int row = n * SEQ + t0 + tk;
            float mg[3], lg[3]; float M = -INFINITY;
#pragma unroll
            for (int g = 0; g < 3; ++g) { const float* ml = P.DML + (((size_t)g * MP + row) * DIL_HEADS + h) * 2; mg[g] = ml[0]; lg[g] = ml[1]; M = fmaxf(M, mg[g]); }
            f32x4 acc = (f32x4){0.f, 0.f, 0.f, 0.f}; float L = 0.f;
#pragma unroll
            for (int g = 0; g < 3; ++g) { const float wg = __builtin_amdgcn_exp2f(mg[g] - M); L += wg * lg[g]; acc += *(const f32x4*)(P.DPART + (((size_t)g * MP + row) * DIL_HEADS + h) * 64 + d4) * wg; }
            *(u32x2*)(P.ATTA + (size_t)row * 512 + h * 64 + d4) = pk4(acc * (1.0f / L)); }
        for (int mt = w; mt < 16; mt += NWAVES) mem_micro(P, P.MQA + h * 64, 256, n * SEQ + t0 + 16 * mt, 0, n, h, P.ATTA + 256 + h * 64, 512, lane);
        __syncthreads();
    }
    LAS float* qs = (LAS float*)C.lds;
    for (int it = C.vcu; it < DEC_BATCH * DIL_HEADS * 2; it += C.G) { const int kind = it & 1, h = (it >> 1) % DIL_HEADS, ns = (it >> 1) / DIL_HEADS, row = M0 + ns;
        __syncthreads();
        if (kind == 0) { if (C.tid < 192) qs[C.tid] = bf2f(P.QA[((size_t)(C.tid >> 6) * MPAD + row) * 256 + h * 64 + (C.tid & 63)]); } else { if (C.tid < 64) qs[C.tid] = bf2f(P.MQA[(size_t)row * 256 + h * 64 + C.tid]); }
        asm volatile("s_waitcnt lgkmcnt(0)" ::: "memory"); __syncthreads();
        Dec D; D.m = -INFINITY; D.l = 0.f; D.o = 0.f;
        if (kind == 0) { constexpr int CPG = (DIL_TAPS + 63) / 64;
            for (int ck = w; ck < 3 * CPG; ck += NWAVES) { const int g = ck / CPG, j0 = (ck % CPG) * 64; const int W = dil_w(g), d = dil_d(g); const float* cache = sel3c(P.cache_dil, g) + (size_t)ns * W * 512; const float* newrow = sel3(P.dil_s, g) + ((size_t)ns * W + W - 1) * 512;
                const int nk = (DIL_TAPS - j0) < 64 ? (DIL_TAPS - j0) : 64;
                dec_chunk(D, qs + g * 64, nk, [&](int j) { const int tap = j0 + j; return (tap == 0 ? newrow : cache + (size_t)(W - d * tap) * 512) + h * 64; },
                          [&](int j) { const int tap = j0 + j; return (tap == 0 ? newrow : cache + (size_t)(W - d * tap) * 512) + 256 + h * 64; }, lane); } }
        else { const float* mk = P.cache_mem_kv + ((size_t)0 * DEC_BATCH + ns) * MEM_TOKENS * 512;
            for (int ck = w; ck < MEM_TOKENS / 64; ck += NWAVES) { const int j0 = ck * 64; dec_chunk(D, qs, 64, [&](int j) { return mk + (size_t)(j0 + j) * 512 + h * 64; }, [&](int j) { return mk + (size_t)(j0 + j) * 512 + 256 + h * 64; }, lane); } }
        const float o = dec_combine(C, D);
        if (w == 0) P.ATTA[(size_t)row * 512 + (kind == 0 ? 0 : 256) + h * 64 + lane] = (bf16)f2bf(o);
    }
    __syncthreads();
}
DI void ln_phase(const FP& P, const Ctx& C, const float* pre, const float* gam, const float* bet, float* xo, bf16* xb, float* yp, float* ys) {
    const int gw = C.vcu * NWAVES + C.wave, NGW = C.G * NWAVES, lane = C.lane;
    for (int r = gw; r < MP; r += NGW) { const float* x = pre + (size_t)r * D_MODEL; f32x4 v[4]; float s = 0.f;
#pragma unroll
        for (int j = 0; j < 4; ++j) { v[j] = *(const f32x4*)(x + 256 * j + 4 * lane); s += (v[j].x + v[j].y) + (v[j].z + v[j].w); }
        const float mu = wave_sum(s) * (1.0f / D_MODEL); float s2 = 0.f;
#pragma unroll
        for (int j = 0; j < 4; ++j) { v[j] = v[j] - mu; s2 += (v[j].x * v[j].x + v[j].y * v[j].y) + (v[j].z * v[j].z + v[j].w * v[j].w); }
        const float rs = 1.0f / sqrtf(wave_sum(s2) * (1.0f / D_MODEL) + LN_EPS);
#pragma unroll
        for (int j = 0; j < 4; ++j) { const f32x4 gg = *(const f32x4*)(gam + 256 * j + 4 * lane), bb = *(const f32x4*)(bet + 256 * j + 4 * lane); const f32x4 o = v[j] * rs * gg + bb;
            if (xo) *(f32x4*)(xo + (size_t)r * D_MODEL + 256 * j + 4 * lane) = o;
            if (xb) *(u32x2*)(xb + (size_t)r * D_MODEL + 256 * j + 4 * lane) = pk4(o);
            if (yp) { if (r < M0) *(f32x4*)(yp + (size_t)r * D_MODEL + 256 * j + 4 * lane) = o; else *(f32x4*)(ys + (size_t)(r - M0) * D_MODEL + 256 * j + 4 * lane) = o; } }
    }
}
}
namespace fx {
#define INS16(V, I, v_, i_) do { const float _v = (v_); const int _i = (i_); bool _c[16]; _Pragma("unroll") for (int _k = 0; _k < 16; ++_k) _c[_k] = _v > V[_k]; \
    _Pragma("unroll") for (int _k = 15; _k >= 1; --_k) { V[_k] = _c[_k] ? (_c[_k - 1] ? V[_k - 1] : _v) : V[_k]; I[_k] = _c[_k] ? (_c[_k - 1] ? I[_k - 1] : _i) : I[_k]; } \
    V[0] = _c[0] ? _v : V[0]; I[0] = _c[0] ? _i : I[0]; } while (0)
DI void wave_top16_128(float a, float b, int lane, float& outv, int& outi) {
    outv = -INFINITY; outi = 0;
#pragma unroll 1
    for (int k = 0; k < 16; ++k) { const float m = wave_max(fmaxf(a, b)); const unsigned long long ba = __ballot(a == m), bb = __ballot(b == m); int idx;
        if (ba) { const int l = __builtin_ctzll(ba); idx = l; if (lane == l) a = -INFINITY; } else { const int l = __builtin_ctzll(bb); idx = 64 + l; if (lane == l) b = -INFINITY; }
        if (lane == k) { outv = m; outi = idx; } }
}
DI void topk_wave_item(const FP& P, long it, int lane) {
    const float* s = P.SCO + it * 256; float v1, v2; int i1, i2;
    wave_top16_128(s[lane], s[64 + lane], lane, v1, i1); wave_top16_128(s[128 + lane], s[192 + lane], lane, v2, i2);
    int a = 0, rem = lane; bool valid = false;
    for (int aa = 0; aa < 16; ++aa) { const int nb = 16 / (aa + 1); if (!valid) { if (rem < nb) { a = aa; valid = true; } else rem -= nb; } }
    const int b = valid ? rem : 0;
    float cs = __shfl(v1, a) + __shfl(v2, b); const int ce = __shfl(i1, a) * PEER_KEYS + __shfl(i2, b); if (!valid) cs = -INFINITY;
    float tv = -INFINITY; int te = 0;
#pragma unroll 1
    for (int k = 0; k < 16; ++k) { const float m = wave_max(cs); const unsigned long long bm = __ballot(cs == m); const int l = __builtin_ctzll(bm); const int e = __shfl(ce, l); if (lane == l) cs = -INFINITY; if (lane == k) { tv = m; te = e; } }
    const float mx = __shfl(tv, 0); const float ex = (lane < 16) ? __expf(tv - mx) : 0.f; const float z = wave_sum(ex);
    if (lane < 16) { P.SELG[it * 16 + lane] = ex / z; P.SELE[it * 16 + lane] = te; }
}
#define KINS16(V, key_) do { const float _key = (key_); _Pragma("unroll") for (int _k = 15; _k >= 1; --_k) V[_k] = __builtin_amdgcn_fmed3f(V[_k - 1], V[_k], _key); V[0] = fmaxf(V[0], _key); } while (0)
DI float pack_key(float v, unsigned lowbits, unsigned mask) { return __builtin_bit_cast(float, (__builtin_bit_cast(unsigned, v) & ~mask) | lowbits); }
DI void topk_phase(const FP& P, const Ctx& C) {
    const int lane = C.lane; LAS float* st = (LAS float*)(C.lds + C.wave * 16384);
    const int NWI = (M0 * PEER_HEADS) / 64;
    for (int wi = C.vcu * NWAVES + C.wave; wi < NWI; wi += C.G * NWAVES) {
        const long it0 = (long)wi * 64; const long it = it0 + lane;
        float V1[16], V2[16], V3[16];
#pragma unroll
        for (int k = 0; k < 16; ++k) { V1[k] = V2[k] = V3[k] = -INFINITY; }
#pragma unroll 1
        for (int ch = 0; ch < 8; ++ch) {
#pragma unroll
            for (int u = 0; u < 8; ++u) { const int f4 = u * 64 + lane, j = f4 >> 3, q = f4 & 7, hf = q >> 2, c4 = (q & 3) * 4; const long itj = it0 + j;
                const f32x4 v = *(const f32x4*)(P.SCO + itj * 256 + hf * 128 + ch * 16 + c4);
                st[j * 33 + hf * 16 + c4] = v.x; st[j * 33 + hf * 16 + c4 + 1] = v.y; st[j * 33 + hf * 16 + c4 + 2] = v.z; st[j * 33 + hf * 16 + c4 + 3] = v.w; }
            asm volatile("s_waitcnt lgkmcnt(0)" ::: "memory");
#pragma unroll 4
            for (int c = 0; c < 16; ++c) { const float va = st[lane * 33 + c], vb = st[lane * 33 + 16 + c]; const unsigned lb = 127u - (unsigned)(ch * 16 + c); KINS16(V1, pack_key(va, lb, 127u)); KINS16(V2, pack_key(vb, lb, 127u)); }
            asm volatile("s_waitcnt lgkmcnt(0)" ::: "memory");
        }
        LAS int* lc = (LAS int*)st;
        { int ord = 0;
#pragma unroll
          for (int a = 0; a < 16; ++a) { const unsigned ba = __builtin_bit_cast(unsigned, V1[a]); const float va = __builtin_bit_cast(float, ba & ~127u); const int ia = 127 - (int)(ba & 127u);
#pragma unroll
              for (int b = 0; b < 16; ++b) if ((a + 1) * (b + 1) <= 16) { const unsigned bb = __builtin_bit_cast(unsigned, V2[b]); const float vb = __builtin_bit_cast(float, bb & ~127u); const int ib = 127 - (int)(bb & 127u);
                  lc[lane * 51 + ord] = ia * PEER_KEYS + ib; KINS16(V3, pack_key(va + vb, 63u - (unsigned)ord, 63u)); ++ord; } } }
        asm volatile("s_waitcnt lgkmcnt(0)" ::: "memory");
        float g[16]; int e[16]; float z = 0.f; const float vmax = __builtin_bit_cast(float, __builtin_bit_cast(unsigned, V3[0]) & ~63u);
#pragma unroll
        for (int k = 0; k < 16; ++k) { const unsigned bk = __builtin_bit_cast(unsigned, V3[k]); e[k] = lc[lane * 51 + 63 - (int)(bk & 63u)]; g[k] = __expf(__builtin_bit_cast(float, bk & ~63u) - vmax); z += g[k]; }
        const float iz = 1.0f / z;
#pragma unroll
        for (int k4 = 0; k4 < 4; ++k4) { *(f32x4*)(P.SELG + it * 16 + 4 * k4) = (f32x4){g[4 * k4] * iz, g[4 * k4 + 1] * iz, g[4 * k4 + 2] * iz, g[4 * k4 + 3] * iz};
            *(int4*)(P.SELE + it * 16 + 4 * k4) = make_int4(e[4 * k4], e[4 * k4 + 1], e[4 * k4 + 2], e[4 * k4 + 3]); }
        asm volatile("s_waitcnt lgkmcnt(0)" ::: "memory");
    }
    for (int si = C.vcu * NWAVES + C.wave; si < DEC_BATCH * PEER_HEADS; si += C.G * NWAVES) topk_wave_item(P, (long)M0 * PEER_HEADS + si, lane);
    __syncthreads();
}
constexpr float PEER_SU = 256.f, PEER_SV = 64.f;
DI float dot16_fp8(const u32x4& w, const f32x2 (&x2)[8]) { f32x2 a = {0.f, 0.f};
    a += __builtin_amdgcn_cvt_pk_f32_fp8((int)w.x, false) * x2[0]; a += __builtin_amdgcn_cvt_pk_f32_fp8((int)w.x, true) * x2[1];
    a += __builtin_amdgcn_cvt_pk_f32_fp8((int)w.y, false) * x2[2]; a += __builtin_amdgcn_cvt_pk_f32_fp8((int)w.y, true) * x2[3];
    a += __builtin_amdgcn_cvt_pk_f32_fp8((int)w.z, false) * x2[4]; a += __builtin_amdgcn_cvt_pk_f32_fp8((int)w.z, true) * x2[5];
    a += __builtin_amdgcn_cvt_pk_f32_fp8((int)w.w, false) * x2[6]; a += __builtin_amdgcn_cvt_pk_f32_fp8((int)w.w, true) * x2[7];
    return a.x + a.y; }
DI void axpy16_fp8(const u32x4& w, float s, f32x2 (&o2)[8]) { const f32x2 s2 = {s, s};
    o2[0] += __builtin_amdgcn_cvt_pk_f32_fp8((int)w.x, false) * s2; o2[1] += __builtin_amdgcn_cvt_pk_f32_fp8((int)w.x, true) * s2;
    o2[2] += __builtin_amdgcn_cvt_pk_f32_fp8((int)w.y, false) * s2; o2[3] += __builtin_amdgcn_cvt_pk_f32_fp8((int)w.y, true) * s2;
    o2[4] += __builtin_amdgcn_cvt_pk_f32_fp8((int)w.z, false) * s2; o2[5] += __builtin_amdgcn_cvt_pk_f32_fp8((int)w.z, true) * s2;
    o2[6] += __builtin_amdgcn_cvt_pk_f32_fp8((int)w.w, false) * s2; o2[7] += __builtin_amdgcn_cvt_pk_f32_fp8((int)w.w, true) * s2; }
#if defined(PEER_SHARD) || defined(PEER_SHARD2)
#define PEER_FIRST_ROUND nrounds
#else
#define PEER_FIRST_ROUND 0
#endif
template <int CTRL> DI float dppf(float x) { return __builtin_bit_cast(float, __builtin_amdgcn_update_dpp(0, __builtin_bit_cast(int, x), CTRL, 0xF, 0xF, true)); }
DI float rdlane(float v, int l) { return __builtin_bit_cast(float, __builtin_amdgcn_readlane(__builtin_bit_cast(int, v), l)); }
DI void peer_phase(const FP& P, const Ctx& C, int layer, const float* xin, float* fout, float* fout_s, bf16* xb, bool samples_only = false) {
    const int lane = C.lane; const unsigned char* U = P.UB8 + (size_t)layer * PEER_EXPERTS * D_MODEL; const unsigned char* Vt = P.VB8 + (size_t)layer * PEER_EXPERTS * D_MODEL;
    const float* gam = P.ln_g + ((size_t)layer * 2 + 1) * D_MODEL; const float* bet = P.ln_b + ((size_t)layer * 2 + 1) * D_MODEL;
    const int nrounds = (M0 + C.G * NWAVES - 1) / (C.G * NWAVES);
#pragma unroll 1
    for (int rd = samples_only ? nrounds : 0; rd <= nrounds; ++rd) {
        const bool smp = (rd == nrounds); int r = smp ? M0 + C.vcu : rd * C.G * NWAVES + C.vcu * NWAVES + C.wave; if (smp ? (C.vcu >= DEC_BATCH) : (r >= M0)) continue;
        const int pb = smp ? 16 * C.wave : 0, pe = smp ? pb + 16 : 128;
        f32x2 x2[8], o2[8];
#pragma unroll
        for (int j = 0; j < 4; ++j) { const f32x4 a = *(const f32x4*)(xin + (size_t)r * D_MODEL + 16 * lane + 4 * j); x2[2 * j] = (f32x2){a.x, a.y}; x2[2 * j + 1] = (f32x2){a.z, a.w}; }
#pragma unroll
        for (int k = 0; k < 8; ++k) o2[k] = (f32x2){0.f, 0.f};
        const int e_l = P.SELE[(size_t)r * 128 + lane], e_h = P.SELE[(size_t)r * 128 + 64 + lane]; const float g_l = P.SELG[(size_t)r * 128 + lane], g_h = P.SELG[(size_t)r * 128 + 64 + lane];
#pragma unroll 1
        for (int b0 = pb; b0 < pe; b0 += 8) {
            u32x4 uw[8], vw[8];
#pragma unroll
            for (int k = 0; k < 8; ++k) { const int hk = b0 + k; const int e = (hk < 64) ? __builtin_amdgcn_readlane(e_l, hk & 63) : __builtin_amdgcn_readlane(e_h, hk & 63);
                uw[k] = *(const u32x4*)(U + (size_t)e * D_MODEL + 16 * lane); vw[k] = *(const u32x4*)(Vt + (size_t)e * D_MODEL + 16 * lane); }
            float d[8];
#pragma unroll
            for (int k = 0; k < 8; ++k) d[k] = dot16_fp8(uw[k], x2);
            float e4[4], e2[2], e1;
            { const bool hi = lane & 1;
#pragma unroll
              for (int i = 0; i < 4; ++i) { const float keep = hi ? d[4 + i] : d[i], send = hi ? d[i] : d[4 + i]; e4[i] = keep + __shfl_xor(send, 1); } }
            { const bool hi = lane & 2;
#pragma unroll
              for (int i = 0; i < 2; ++i) { const float keep = hi ? e4[2 + i] : e4[i], send = hi ? e4[i] : e4[2 + i]; e2[i] = keep + __shfl_xor(send, 2); } }
            { const bool hi = lane & 4; const float keep = hi ? e2[1] : e2[0], send = hi ? e2[0] : e2[1]; e1 = keep + __shfl_xor(send, 4); }
            e1 += __shfl_xor(e1, 8); e1 += __shfl_xor(e1, 16); e1 += __shfl_xor(e1, 32);
            const int myk = 4 * (lane & 1) + (lane & 2) + ((lane >> 2) & 1); const int myhk = b0 + myk;
            const float myg = (myhk < 64) ? __shfl(g_l, myhk & 63) : __shfl(g_h, myhk & 63);
            const float act = myg * gelu_tanh(e1 * (1.0f / PEER_SU)) * (1.0f / PEER_SV);
#pragma unroll
            for (int k = 0; k < 8; ++k) { const int src = (k >> 2) | (((k >> 1) & 1) << 1) | ((k & 1) << 2); axpy16_fp8(vw[k], rdlane(act, src), o2); }
        }
        if (smp) {
            LAS float* red = (LAS float*)C.lds;
#pragma unroll
            for (int k = 0; k < 8; ++k) { red[C.wave * 1024 + 16 * lane + 2 * k] = o2[k].x; red[C.wave * 1024 + 16 * lane + 2 * k + 1] = o2[k].y; }
            asm volatile("s_waitcnt lgkmcnt(0)" ::: "memory"); __syncthreads();
            if (C.wave == 0) {
#pragma unroll
                for (int k = 0; k < 8; ++k) { float ax = 0.f, ay = 0.f;
#pragma unroll
                    for (int ww = 0; ww < NWAVES; ++ww) { ax += red[ww * 1024 + 16 * lane + 2 * k]; ay += red[ww * 1024 + 16 * lane + 2 * k + 1]; } o2[k] = (f32x2){ax, ay}; } }
            __syncthreads();
            if (C.wave != 0) continue; }
        float s = 0.f;
#pragma unroll
        for (int k = 0; k < 8; ++k) { o2[k] += x2[k] * ALPHA; s += o2[k].x + o2[k].y; }
        const float mu = wave_sum(s) * (1.0f / D_MODEL); float s2 = 0.f;
#pragma unroll
        for (int k = 0; k < 8; ++k) { o2[k] -= mu; s2 += o2[k].x * o2[k].x + o2[k].y * o2[k].y; }
        const float rs = 1.0f / sqrtf(wave_sum(s2) * (1.0f / D_MODEL) + LN_EPS);
        float* frow = (r < M0) ? fout + (size_t)r * D_MODEL : fout_s + (size_t)(r - M0) * D_MODEL;
#pragma unroll
        for (int j = 0; j < 4; ++j) { const int c0 = 16 * lane + 4 * j; const f32x4 gg = *(const f32x4*)(gam + c0), bb = *(const f32x4*)(bet + c0);
            const f32x4 y = (f32x4){o2[2 * j].x * rs, o2[2 * j].y * rs, o2[2 * j + 1].x * rs, o2[2 * j + 1].y * rs} * gg + bb;
            *(f32x4*)(frow + c0) = y; if (xb) *(u32x2*)(xb + (size_t)r * D_MODEL + c0) = pk4(y); }
    }
}
DI void peer_u_phase(const FP& P, const Ctx& C, int layer, const bf16* xb16) {
    const int lane = C.lane; const unsigned char* U = P.UB8 + (size_t)layer * PEER_EXPERTS * D_MODEL;
    const int s = (int)(blockIdx.x & 7), nw = (C.G >> 3) * NWAVES, widx = (int)(blockIdx.x >> 3) * NWAVES + C.wave;
#pragma unroll 1
    for (int r = widx; r < MP; r += nw) {
        const int e0 = P.SELE[(size_t)r * 128 + lane], e1 = P.SELE[(size_t)r * 128 + 64 + lane]; const float g0 = P.SELG[(size_t)r * 128 + lane], g1 = P.SELG[(size_t)r * 128 + 64 + lane];
        unsigned long long b0 = __ballot((e0 >> 11) == s), b1 = __ballot((e1 >> 11) == s);
        if ((b0 | b1) == 0ull) continue;
        f32x2 x2[8]; { const u32x4 xa = *(const u32x4*)(xb16 + (size_t)r * D_MODEL + 16 * lane), xc = *(const u32x4*)(xb16 + (size_t)r * D_MODEL + 16 * lane + 8);
            x2[0] = (f32x2){bflo(xa.x), bfhi(xa.x)}; x2[1] = (f32x2){bflo(xa.y), bfhi(xa.y)}; x2[2] = (f32x2){bflo(xa.z), bfhi(xa.z)}; x2[3] = (f32x2){bflo(xa.w), bfhi(xa.w)};
            x2[4] = (f32x2){bflo(xc.x), bfhi(xc.x)}; x2[5] = (f32x2){bflo(xc.y), bfhi(xc.y)}; x2[6] = (f32x2){bflo(xc.z), bfhi(xc.z)}; x2[7] = (f32x2){bflo(xc.w), bfhi(xc.w)}; }
#pragma unroll 1
        while ((b0 | b1) != 0ull) {
            int hk[8]; u32x4 uw[8]; int nv = 0;
#pragma unroll
            for (int k = 0; k < 8; ++k) { int h;
                if (b0) { h = __builtin_ctzll(b0); b0 &= b0 - 1; ++nv; } else if (b1) { h = 64 + __builtin_ctzll(b1); b1 &= b1 - 1; ++nv; } else h = hk[k > 0 ? k - 1 : 0];
                hk[k] = h; const int e = (h < 64) ? __builtin_amdgcn_readlane(e0, h & 63) : __builtin_amdgcn_readlane(e1, h & 63);
                uw[k] = *(const u32x4*)(U + (size_t)e * D_MODEL + 16 * lane); }
            float d[8];
#pragma unroll
            for (int k = 0; k < 8; ++k) d[k] = dot16_fp8(uw[k], x2);
            float e4[4], e2[2], e1s;
            { const bool hi = lane & 1;
#pragma unroll
              for (int i = 0; i < 4; ++i) { const float keep = hi ? d[4 + i] : d[i], send = hi ? d[i] : d[4 + i]; e4[i] = keep + __shfl_xor(send, 1); } }
            { const bool hi = lane & 2;
#pragma unroll
              for (int i = 0; i < 2; ++i) { const float keep = hi ? e4[2 + i] : e4[i], send = hi ? e4[i] : e4[2 + i]; e2[i] = keep + __shfl_xor(send, 2); } }
            { const bool hi = lane & 4; const float keep = hi ? e2[1] : e2[0], send = hi ? e2[0] : e2[1]; e1s = keep + __shfl_xor(send, 4); }
            e1s += __shfl_xor(e1s, 8); e1s += __shfl_xor(e1s, 16); e1s += __shfl_xor(e1s, 32);
            const int myk = 4 * (lane & 1) + (lane & 2) + ((lane >> 2) & 1);
            int myh = hk[0];
#pragma unroll
            for (int k = 1; k < 8; ++k) myh = (myk == k) ? hk[k] : myh;
            const float ga = __shfl(g0, myh & 63), gb = __shfl(g1, myh & 63); const float myg = (myh < 64) ? ga : gb;
            if (lane < 8 && myk < nv) P.SCO[(size_t)r * 128 + myh] = myg * gelu_tanh(e1s * (1.0f / PEER_SU)) * (1.0f / PEER_SV);
        }
    }
}
DI void peer_v_phase(const FP& P, const Ctx& C, int layer, const float* xin, float* fout, float* fout_s, bf16* xb) {
    const int lane = C.lane; const unsigned char* Vt = P.VB8 + (size_t)layer * PEER_EXPERTS * D_MODEL;
    const float* gam = P.ln_g + ((size_t)layer * 2 + 1) * D_MODEL; const float* bet = P.ln_b + ((size_t)layer * 2 + 1) * D_MODEL;
    const int nrounds = (M0 + C.G * NWAVES - 1) / (C.G * NWAVES);
#pragma unroll 1
    for (int rd = 0; rd <= nrounds; ++rd) {
        const bool smp = (rd == nrounds); int r = smp ? M0 + C.vcu : rd * C.G * NWAVES + C.vcu * NWAVES + C.wave; if (smp ? (C.vcu >= DEC_BATCH) : (r >= M0)) continue;
        const int pb = smp ? 16 * C.wave : 0, pe = smp ? pb + 16 : 128;
        f32x2 x2[8], o2[8];
#pragma unroll
        for (int j = 0; j < 4; ++j) { const f32x4 a = *(const f32x4*)(xin + (size_t)r * D_MODEL + 16 * lane + 4 * j); x2[2 * j] = (f32x2){a.x, a.y}; x2[2 * j + 1] = (f32x2){a.z, a.w}; }
#pragma unroll
        for (int k = 0; k < 8; ++k) o2[k] = (f32x2){0.f, 0.f};
        const int e_l = P.SELE[(size_t)r * 128 + lane], e_h = P.SELE[(size_t)r * 128 + 64 + lane]; const float a_l = P.SCO[(size_t)r * 128 + lane], a_h = P.SCO[(size_t)r * 128 + 64 + lane];
#pragma unroll 1
        for (int b0 = pb; b0 < pe; b0 += 16) { u32x4 vw[16];
#pragma unroll
            for (int k = 0; k < 16; ++k) { const int hk = b0 + k; const int e = (hk < 64) ? __builtin_amdgcn_readlane(e_l, hk & 63) : __builtin_amdgcn_readlane(e_h, hk & 63); vw[k] = *(const u32x4*)(Vt + (size_t)e * D_MODEL + 16 * lane); }
#pragma unroll
            for (int k = 0; k < 16; ++k) { const int hk = b0 + k; axpy16_fp8(vw[k], (hk < 64) ? rdlane(a_l, hk & 63) : rdlane(a_h, hk & 63), o2); } }
        if (smp) {
            LAS float* red = (LAS float*)C.lds;
#pragma unroll
            for (int k = 0; k < 8; ++k) { red[C.wave * 1024 + 16 * lane + 2 * k] = o2[k].x; red[C.wave * 1024 + 16 * lane + 2 * k + 1] = o2[k].y; }
            asm volatile("s_waitcnt lgkmcnt(0)" ::: "memory"); __syncthreads();
            if (C.wave == 0) {
#pragma unroll
                for (int k = 0; k < 8; ++k) { float ax = 0.f, ay = 0.f;
#pragma unroll
                    for (int ww = 0; ww < NWAVES; ++ww) { ax += red[ww * 1024 + 16 * lane + 2 * k]; ay += red[ww * 1024 + 16 * lane + 2 * k + 1]; } o2[k] = (f32x2){ax, ay}; } }
            __syncthreads();
            if (C.wave != 0) continue; }
        float s = 0.f;
#pragma unroll
        for (int k = 0; k < 8; ++k) { o2[k] += x2[k] * ALPHA; s += o2[k].x + o2[k].y; }
        const float mu = wave_sum(s) * (1.0f / D_MODEL); float s2 = 0.f;
#pragma unroll
        for (int k = 0; k < 8; ++k) { o2[k] -= mu; s2 += o2[k].x * o2[k].x + o2[k].y * o2[k].y; }
        const float rs = 1.0f / sqrtf(wave_sum(s2) * (1.0f / D_MODEL) + LN_EPS);
        float* frow = (r < M0) ? fout + (size_t)r * D_MODEL : fout_s + (size_t)(r - M0) * D_MODEL;
#pragma unroll
        for (int j = 0; j < 4; ++j) { const int c0 = 16 * lane + 4 * j; const f32x4 gg = *(const f32x4*)(gam + c0), bb = *(const f32x4*)(bet + c0);
            const f32x4 y = (f32x4){o2[2 * j].x * rs, o2[2 * j].y * rs, o2[2 * j + 1].x * rs, o2[2 * j + 1].y * rs} * gg + bb;
            *(f32x4*)(frow + c0) = y; if (xb) *(u32x2*)(xb + (size_t)r * D_MODEL + c0) = pk4(y); }
    }
}
constexpr int PSH_LIST = 512;
struct PG4 { u32x4 u[4], v[4]; };
DI void peer_sharded_phase(const FP& P, const Ctx& C, int layer, const float* xin, const bf16* xb16, float* fout, float* fout_s, bf16* xb) {
    const int lane = C.lane; const unsigned char* U = P.UB8 + (size_t)layer * PEER_EXPERTS * D_MODEL; const unsigned char* Vt = P.VB8 + (size_t)layer * PEER_EXPERTS * D_MODEL;
    const float* gam = P.ln_g + ((size_t)layer * 2 + 1) * D_MODEL; const float* bet = P.ln_b + ((size_t)layer * 2 + 1) * D_MODEL;
    LAS unsigned char* wl = C.lds + C.wave * 16384; LAS bf16* xs = (LAS bf16*)wl; LAS int* lst = (LAS int*)(wl + 8192);
    const int NW = C.G * NWAVES, gw = C.vcu * NWAVES + C.wave; const int nquads = (M0 / NW) / 4;
#pragma unroll 1
    for (int qd = 0; qd < nquads; ++qd) {
#define PSH_ROW(j) const int row##j = (qd * 4 + j) * NW + gw; const int el##j = P.SELE[(size_t)row##j * 128 + lane], eh##j = P.SELE[(size_t)row##j * 128 + 64 + lane]; const float gl##j = P.SELG[(size_t)row##j * 128 + lane], gh##j = P.SELG[(size_t)row##j * 128 + 64 + lane]; \
        { const u32x4 xa = *(const u32x4*)(xb16 + (size_t)row##j * D_MODEL + 16 * lane), xc = *(const u32x4*)(xb16 + (size_t)row##j * D_MODEL + 16 * lane + 8); *(LAS u32x4*)(xs + j * 1024 + 16 * lane) = xa; *(LAS u32x4*)(xs + j * 1024 + 16 * lane + 8) = xc; } \
        f32x2 oa##j[8]; _Pragma("unroll") for (int k = 0; k < 8; ++k) oa##j[k] = (f32x2){0.f, 0.f};
        PSH_ROW(0) PSH_ROW(1) PSH_ROW(2) PSH_ROW(3)
#pragma unroll 1
        for (int s = 0; s < 16; ++s) {
            int n = 0;
#define PSH_SCAN(j) { unsigned long long b0 = __ballot((el##j >> 10) == s), b1 = __ballot((eh##j >> 10) == s); \
                while (b0) { const int h = __builtin_ctzll(b0); b0 &= b0 - 1; const int e = __builtin_amdgcn_readlane(el##j, h); const int g = __builtin_amdgcn_readlane(__builtin_bit_cast(int, gl##j), h); \
                    if (lane == 0) { lst[4 * n] = e; lst[4 * n + 1] = g; lst[4 * n + 2] = j; } ++n; } \
                while (b1) { const int h = __builtin_ctzll(b1); b1 &= b1 - 1; const int e = __builtin_amdgcn_readlane(eh##j, h); const int g = __builtin_amdgcn_readlane(__builtin_bit_cast(int, gh##j), h); \
                    if (lane == 0) { lst[4 * n] = e; lst[4 * n + 1] = g; lst[4 * n + 2] = j; } ++n; } }
            PSH_SCAN(0) PSH_SCAN(1) PSH_SCAN(2) PSH_SCAN(3)
            asm volatile("s_waitcnt lgkmcnt(0)" ::: "memory");
            if (n == 0) continue;
            const int ngrp = (n + 3) >> 2;
#define PSH_LD(b, gi_) do { const int gi = (gi_); _Pragma("unroll") for (int k = 0; k < 4; ++k) { int i = 4 * gi + k; i = i < n ? i : n - 1; const int e = __builtin_amdgcn_readfirstlane(lst[4 * i]); \
                b.u[k] = *(const u32x4*)(U + (size_t)e * D_MODEL + 16 * lane); b.v[k] = *(const u32x4*)(Vt + (size_t)e * D_MODEL + 16 * lane); } } while (0)
#define PSH_CP(b, gi_) do { const int gi = (gi_); float d[4]; int jj[4]; float gg[4]; \
                _Pragma("unroll") for (int k = 0; k < 4; ++k) { int i = 4 * gi + k; const bool val = i < n; i = val ? i : n - 1; jj[k] = __builtin_amdgcn_readfirstlane(lst[4 * i + 2]); gg[k] = val ? __builtin_bit_cast(float, __builtin_amdgcn_readfirstlane(lst[4 * i + 1])) : 0.f; \
                    const u32x4 xa = *(const LAS u32x4*)(xs + jj[k] * 1024 + 16 * lane), xc = *(const LAS u32x4*)(xs + jj[k] * 1024 + 16 * lane + 8); \
                    const f32x2 x2[8] = {(f32x2){bflo(xa.x), bfhi(xa.x)}, (f32x2){bflo(xa.y), bfhi(xa.y)}, (f32x2){bflo(xa.z), bfhi(xa.z)}, (f32x2){bflo(xa.w), bfhi(xa.w)}, (f32x2){bflo(xc.x), bfhi(xc.x)}, (f32x2){bflo(xc.y), bfhi(xc.y)}, (f32x2){bflo(xc.z), bfhi(xc.z)}, (f32x2){bflo(xc.w), bfhi(xc.w)}}; \
                    d[k] = dot16_fp8(b.u[k], x2); } \
                float e2[2], e1; \
                { const bool hi = lane & 1; _Pragma("unroll") for (int i = 0; i < 2; ++i) { const float keep = hi ? d[2 + i] : d[i], send = hi ? d[i] : d[2 + i]; e2[i] = keep + __shfl_xor(send, 1); } } \
                { const bool hi = lane & 2; const float keep = hi ? e2[1] : e2[0], send = hi ? e2[0] : e2[1]; e1 = keep + __shfl_xor(send, 2); } \
                e1 += __shfl_xor(e1, 4); e1 += __shfl_xor(e1, 8); e1 += __shfl_xor(e1, 16); e1 += __shfl_xor(e1, 32); \
                const int myk = 2 * (lane & 1) + ((lane >> 1) & 1); \
                float myg = gg[0]; myg = (myk == 1) ? gg[1] : myg; myg = (myk == 2) ? gg[2] : myg; myg = (myk == 3) ? gg[3] : myg; \
                const float act = myg * gelu_tanh(e1 * (1.0f / PEER_SU)) * (1.0f / PEER_SV); \
                _Pragma("unroll") for (int k = 0; k < 4; ++k) { const float a = rdlane(act, (k >> 1) | ((k & 1) << 1)); \
                    if (jj[k] == 0) axpy16_fp8(b.v[k], a, oa0); else if (jj[k] == 1) axpy16_fp8(b.v[k], a, oa1); else if (jj[k] == 2) axpy16_fp8(b.v[k], a, oa2); else axpy16_fp8(b.v[k], a, oa3); } } while (0)
            { PG4 A, B; PSH_LD(A, 0);
#pragma unroll 1
              for (int g2 = 0; g2 < ngrp; g2 += 2) { PSH_LD(B, (g2 + 1 < ngrp) ? g2 + 1 : g2); PSH_CP(A, g2); PSH_LD(A, (g2 + 2 < ngrp) ? g2 + 2 : g2); if (g2 + 1 < ngrp) PSH_CP(B, g2 + 1); } }
            asm volatile("s_waitcnt lgkmcnt(0)" ::: "memory");
        }
#define PSH_LN(j) { const int r = row##j; f32x2 x2[8]; \
            _Pragma("unroll") for (int q = 0; q < 4; ++q) { const f32x4 a = *(const f32x4*)(xin + (size_t)r * D_MODEL + 16 * lane + 4 * q); x2[2 * q] = (f32x2){a.x, a.y}; x2[2 * q + 1] = (f32x2){a.z, a.w}; } \
            float sm = 0.f; _Pragma("unroll") for (int k = 0; k < 8; ++k) { oa##j[k] += x2[k] * ALPHA; sm += oa##j[k].x + oa##j[k].y; } \
            const float mu = wave_sum(sm) * (1.0f / D_MODEL); float s2 = 0.f; _Pragma("unroll") for (int k = 0; k < 8; ++k) { oa##j[k] -= mu; s2 += oa##j[k].x * oa##j[k].x + oa##j[k].y * oa##j[k].y; } \
            const float rs = 1.0f / sqrtf(wave_sum(s2) * (1.0f / D_MODEL) + LN_EPS); float* frow = fout + (size_t)r * D_MODEL; \
            _Pragma("unroll") for (int q = 0; q < 4; ++q) { const int c0 = 16 * lane + 4 * q; const f32x4 gv = *(const f32x4*)(gam + c0), bv = *(const f32x4*)(bet + c0); \
                const f32x4 y = (f32x4){oa##j[2 * q].x * rs, oa##j[2 * q].y * rs, oa##j[2 * q + 1].x * rs, oa##j[2 * q + 1].y * rs} * gv + bv; *(f32x4*)(frow + c0) = y; if (xb) *(u32x2*)(xb + (size_t)r * D_MODEL + c0) = pk4(y); } }
        PSH_LN(0) PSH_LN(1) PSH_LN(2) PSH_LN(3)
        asm volatile("s_waitcnt lgkmcnt(0)" ::: "memory");
    }
}
constexpr int PSH_LOG = 11, PSH_N = PEER_EXPERTS >> PSH_LOG;
#ifndef PS2_ROWS
#define PS2_ROWS 4
#endif
#define PS2_ROW(j) const int row##j = (qd * PS2_ROWS + j) * NW + gw; const int el##j = P.SELE[(size_t)row##j * 128 + lane], eh##j = P.SELE[(size_t)row##j * 128 + 64 + lane]; const float gl##j = P.SELG[(size_t)row##j * 128 + lane], gh##j = P.SELG[(size_t)row##j * 128 + 64 + lane]; \
    f32x2 oa##j[8]; _Pragma("unroll") for (int k = 0; k < 8; ++k) oa##j[k] = (f32x2){0.f, 0.f};
#define PS2_STEP(j) { unsigned long long b0 = __ballot((el##j >> PSH_LOG) == s), b1 = __ballot((eh##j >> PSH_LOG) == s); \
    if (b0 | b1) { const u32x4 xa##j = *(const u32x4*)(xb16 + (size_t)row##j * D_MODEL + 16 * lane), xc##j = *(const u32x4*)(xb16 + (size_t)row##j * D_MODEL + 16 * lane + 8);     \
      const f32x2 x2[8] = {(f32x2){bflo(xa##j.x), bfhi(xa##j.x)}, (f32x2){bflo(xa##j.y), bfhi(xa##j.y)}, (f32x2){bflo(xa##j.z), bfhi(xa##j.z)}, (f32x2){bflo(xa##j.w), bfhi(xa##j.w)}, (f32x2){bflo(xc##j.x), bfhi(xc##j.x)}, (f32x2){bflo(xc##j.y), bfhi(xc##j.y)}, (f32x2){bflo(xc##j.z), bfhi(xc##j.z)}, (f32x2){bflo(xc##j.w), bfhi(xc##j.w)}}; \
      _Pragma("unroll 1") while ((b0 | b1) != 0ull) { int hk[8]; u32x4 uw[8], vw[8]; int nv = 0; \
        _Pragma("unroll") for (int k = 0; k < 8; ++k) { int h; if (b0) { h = __builtin_ctzll(b0); b0 &= b0 - 1; ++nv; } else if (b1) { h = 64 + __builtin_ctzll(b1); b1 &= b1 - 1; ++nv; } else h = hk[k > 0 ? k - 1 : 0]; \
            hk[k] = h; const int e = (h < 64) ? __builtin_amdgcn_readlane(el##j, h & 63) : __builtin_amdgcn_readlane(eh##j, h & 63); \
            uw[k] = *(const u32x4*)(U + (size_t)e * D_MODEL + 16 * lane); vw[k] = *(const u32x4*)(Vt + (size_t)e * D_MODEL + 16 * lane); } \
        float d[8]; _Pragma("unroll") for (int k = 0; k < 8; ++k) d[k] = dot16_fp8(uw[k], x2); \
        float e4[4], e2[2], e1s; \
          \
        { const bool hi = lane & 1; _Pragma("unroll") for (int i = 0; i < 4; ++i) { const float keep = hi ? d[4 + i] : d[i], send = hi ? d[i] : d[4 + i]; e4[i] = keep + dppf<0xB1>(send); } } \
        { const bool hi = lane & 2; _Pragma("unroll") for (int i = 0; i < 2; ++i) { const float keep = hi ? e4[2 + i] : e4[i], send = hi ? e4[i] : e4[2 + i]; e2[i] = keep + dppf<0x4E>(send); } } \
        { const bool hi = lane & 4; const float keep = hi ? e2[1] : e2[0], send = hi ? e2[0] : e2[1]; const float r4 = dppf<0x124>(send), r12 = dppf<0x12C>(send); e1s = keep + (hi ? r4 : r12); } \
        e1s += dppf<0x128>(e1s); e1s = colsum(e1s); \
        const int myk = 4 * (lane & 1) + (lane & 2) + ((lane >> 2) & 1); int myh = hk[0]; _Pragma("unroll") for (int k = 1; k < 8; ++k) myh = (myk == k) ? hk[k] : myh; \
        const float ga = __shfl(gl##j, myh & 63), gb = __shfl(gh##j, myh & 63); const float myg = (myk < nv) ? ((myh < 64) ? ga : gb) : 0.f;     \
        const float act = myg * gelu_tanh(e1s * (1.0f / PEER_SU)) * (1.0f / PEER_SV); \
        _Pragma("unroll") for (int k = 0; k < 8; ++k) { const int src = (k >> 2) | (((k >> 1) & 1) << 1) | ((k & 1) << 2); axpy16_fp8(vw[k], rdlane(act, src), oa##j); } } } }
#define PS2_LN(j) { const int r = row##j; f32x2 x2[8]; int ll = lane; asm volatile("" : "+v"(ll));     \
    _Pragma("unroll") for (int q = 0; q < 4; ++q) { const f32x4 a = *(const f32x4*)(xin + (size_t)r * D_MODEL + 16 * ll + 4 * q); x2[2 * q] = (f32x2){a.x, a.y}; x2[2 * q + 1] = (f32x2){a.z, a.w}; } \
    float sm = 0.f; _Pragma("unroll") for (int k = 0; k < 8; ++k) { oa##j[k] += x2[k] * ALPHA; sm += oa##j[k].x + oa##j[k].y; } \
    const float mu = wave_sum(sm) * (1.0f / D_MODEL); float s2 = 0.f; _Pragma("unroll") for (int k = 0; k < 8; ++k) { oa##j[k] -= mu; s2 += oa##j[k].x * oa##j[k].x + oa##j[k].y * oa##j[k].y; } \
    const float rs = 1.0f / sqrtf(wave_sum(s2) * (1.0f / D_MODEL) + LN_EPS); float* frow = fout + (size_t)r * D_MODEL; \
    _Pragma("unroll") for (int q = 0; q < 4; ++q) { const int c0 = 16 * ll + 4 * q; const f32x4 gv = *(const f32x4*)(gam + c0), bv = *(const f32x4*)(bet + c0); \
        const f32x4 y = (f32x4){oa##j[2 * q].x * rs, oa##j[2 * q].y * rs, oa##j[2 * q + 1].x * rs, oa##j[2 * q + 1].y * rs} * gv + bv; *(f32x4*)(frow + c0) = y; if (xb) *(u32x2*)(xb + (size_t)r * D_MODEL + c0) = pk4(y); } }
DI void peer_sharded2_phase(const FP& P, const Ctx& C, int layer, const float* xin, const bf16* xb16, float* fout, bf16* xb) {
    const int lane = C.lane; const unsigned char* U = P.UB8 + (size_t)layer * PEER_EXPERTS * D_MODEL; const unsigned char* Vt = P.VB8 + (size_t)layer * PEER_EXPERTS * D_MODEL;
    const float* gam = P.ln_g + ((size_t)layer * 2 + 1) * D_MODEL; const float* bet = P.ln_b + ((size_t)layer * 2 + 1) * D_MODEL;
    const int NW = C.G * NWAVES, gw = C.vcu * NWAVES + C.wave; const int nquads = (M0 / NW) / PS2_ROWS;
#pragma unroll 1
    for (int qd = 0; qd < nquads; ++qd) {
#if PS2_ROWS == 4
        PS2_ROW(0) PS2_ROW(1) PS2_ROW(2) PS2_ROW(3)
#pragma unroll 1
        for (int s = 0; s < PSH_N; ++s) { PS2_STEP(0) PS2_STEP(1) PS2_STEP(2) PS2_STEP(3) }
        PS2_LN(0) PS2_LN(1) PS2_LN(2) PS2_LN(3)
#else
        PS2_ROW(0) PS2_ROW(1)
#pragma unroll 1
        for (int s = 0; s < PSH_N; ++s) { PS2_STEP(0) PS2_STEP(1) }
        PS2_LN(0) PS2_LN(1)
#endif
    }
}
#define PS3_ROW(j) const int row##j = (qd * 4 + j) * NW + gw; const int el##j = P.SELE[(size_t)row##j * 128 + lane], eh##j = P.SELE[(size_t)row##j * 128 + 64 + lane]; \
    { const u32x4 xa = *(const u32x4*)(xb16 + (size_t)row##j * D_MODEL + 16 * lane), xc = *(const u32x4*)(xb16 + (size_t)row##j * D_MODEL + 16 * lane + 8); *(LAS u32x4*)(xs + j * 1024 + 16 * lane) = xa; *(LAS u32x4*)(xs + j * 1024 + 16 * lane + 8) = xc; } \
    f32x2 oa##j[8]; _Pragma("unroll") for (int k = 0; k < 8; ++k) oa##j[k] = (f32x2){0.f, 0.f};
#define PS3_X2_UNUSED(j) const f32x2 x2[8] = {(f32x2){bflo(xa##j.x), bfhi(xa##j.x)}, (f32x2){bflo(xa##j.y), bfhi(xa##j.y)}, (f32x2){bflo(xa##j.z), bfhi(xa##j.z)}, (f32x2){bflo(xa##j.w), bfhi(xa##j.w)}, (f32x2){bflo(xc##j.x), bfhi(xc##j.x)}, (f32x2){bflo(xc##j.y), bfhi(xc##j.y)}, (f32x2){bflo(xc##j.z), bfhi(xc##j.z)}, (f32x2){bflo(xc##j.w), bfhi(xc##j.w)}};
#define PS3_TAKE(q, M, ELH, GOFF) if (!got && M) { const int h = __builtin_ctzll(M); M &= M - 1; qq[k] = q; ee = __builtin_amdgcn_readlane(ELH, h); gk[k] = P.SELG[GOFF + h];     got = true; ++nv; }
DI void peer_sharded3_phase(const FP& P, const Ctx& C, int layer, const float* xin, const bf16* xb16, float* fout, bf16* xb) {
    const int lane = C.lane; const unsigned char* U = P.UB8 + (size_t)layer * PEER_EXPERTS * D_MODEL; const unsigned char* Vt = P.VB8 + (size_t)layer * PEER_EXPERTS * D_MODEL;
    const float* gam = P.ln_g + ((size_t)layer * 2 + 1) * D_MODEL; const float* bet = P.ln_b + ((size_t)layer * 2 + 1) * D_MODEL;
    const int NW = C.G * NWAVES, gw = C.vcu * NWAVES + C.wave; const int nquads = (M0 / NW) / 4; LAS bf16* xs = (LAS bf16*)(C.lds + C.wave * 16384);
#pragma unroll 1
    for (int qd = 0; qd < nquads; ++qd) {
        PS3_ROW(0) PS3_ROW(1) PS3_ROW(2) PS3_ROW(3)
        asm volatile("s_waitcnt lgkmcnt(0)" ::: "memory");
#pragma unroll 1
        for (int s = 0; s < PSH_N; ++s) {
            unsigned long long m0 = __ballot((el0 >> PSH_LOG) == s), m1 = __ballot((eh0 >> PSH_LOG) == s), m2 = __ballot((el1 >> PSH_LOG) == s), m3 = __ballot((eh1 >> PSH_LOG) == s),
                               m4 = __ballot((el2 >> PSH_LOG) == s), m5 = __ballot((eh2 >> PSH_LOG) == s), m6 = __ballot((el3 >> PSH_LOG) == s), m7 = __ballot((eh3 >> PSH_LOG) == s);
#pragma unroll 1
            while ((m0 | m1 | m2 | m3 | m4 | m5 | m6 | m7) != 0ull) {
                int qq[8]; float gk[8]; int es[8]; u32x4 uw[8]; int nv = 0; int elast = 0;
#pragma unroll
                for (int k = 0; k < 8; ++k) { bool got = false; int ee = elast; qq[k] = k > 0 ? qq[k - 1] : 0; gk[k] = 0.f;
                    PS3_TAKE(0, m0, el0, (size_t)row0 * 128) PS3_TAKE(1, m1, eh0, (size_t)row0 * 128 + 64) PS3_TAKE(2, m2, el1, (size_t)row1 * 128) PS3_TAKE(3, m3, eh1, (size_t)row1 * 128 + 64) PS3_TAKE(4, m4, el2, (size_t)row2 * 128) PS3_TAKE(5, m5, eh2, (size_t)row2 * 128 + 64) PS3_TAKE(6, m6, el3, (size_t)row3 * 128) PS3_TAKE(7, m7, eh3, (size_t)row3 * 128 + 64)
                    elast = ee; es[k] = ee; uw[k] = *(const u32x4*)(U + (size_t)ee * D_MODEL + 16 * lane); }
                float d[8];
#pragma unroll
                for (int k = 0; k < 8; ++k) { const int j = qq[k] >> 1; const u32x4 xa = *(const LAS u32x4*)(xs + j * 1024 + 16 * lane), xc = *(const LAS u32x4*)(xs + j * 1024 + 16 * lane + 8);
                    const f32x2 x2[8] = {(f32x2){bflo(xa.x), bfhi(xa.x)}, (f32x2){bflo(xa.y), bfhi(xa.y)}, (f32x2){bflo(xa.z), bfhi(xa.z)}, (f32x2){bflo(xa.w), bfhi(xa.w)}, (f32x2){bflo(xc.x), bfhi(xc.x)}, (f32x2){bflo(xc.y), bfhi(xc.y)}, (f32x2){bflo(xc.z), bfhi(xc.z)}, (f32x2){bflo(xc.w), bfhi(xc.w)}};
                    d[k] = dot16_fp8(uw[k], x2); }
                u32x4 vw[8];
#pragma unroll
                for (int k = 0; k < 8; ++k) vw[k] = *(const u32x4*)(Vt + (size_t)es[k] * D_MODEL + 16 * lane);
                float e4[4], e2[2], e1s;
                { const bool hi = lane & 1;
#pragma unroll
                  for (int i = 0; i < 4; ++i) { const float keep = hi ? d[4 + i] : d[i], send = hi ? d[i] : d[4 + i]; e4[i] = keep + __shfl_xor(send, 1); } }
                { const bool hi = lane & 2;
#pragma unroll
                  for (int i = 0; i < 2; ++i) { const float keep = hi ? e4[2 + i] : e4[i], send = hi ? e4[i] : e4[2 + i]; e2[i] = keep + __shfl_xor(send, 2); } }
                { const bool hi = lane & 4; const float keep = hi ? e2[1] : e2[0], send = hi ? e2[0] : e2[1]; e1s = keep + __shfl_xor(send, 4); }
                e1s += __shfl_xor(e1s, 8); e1s += __shfl_xor(e1s, 16); e1s += __shfl_xor(e1s, 32);
                const int myk = 4 * (lane & 1) + (lane & 2) + ((lane >> 2) & 1); float myg = gk[0];
#pragma unroll
                for (int k = 1; k < 8; ++k) myg = (myk == k) ? gk[k] : myg;
                const float act = myg * gelu_tanh(e1s * (1.0f / PEER_SU)) * (1.0f / PEER_SV);
#pragma unroll
                for (int k = 0; k < 8; ++k) { const int src = (k >> 2) | (((k >> 1) & 1) << 1) | ((k & 1) << 2); const float a = rdlane(act, src); const int j = qq[k] >> 1;
                    if (j == 0) { asm volatile("" ::: "memory"); axpy16_fp8(vw[k], a, oa0); } else if (j == 1) { asm volatile("" ::: "memory"); axpy16_fp8(vw[k], a, oa1); } else if (j == 2) { asm volatile("" ::: "memory"); axpy16_fp8(vw[k], a, oa2); } else { asm volatile("" ::: "memory"); axpy16_fp8(vw[k], a, oa3); } }
            }
        }
        PS2_LN(0) PS2_LN(1) PS2_LN(2) PS2_LN(3)
    }
}
}
namespace fx {
struct EpiB {
    static constexpr bool PERM = true, AFTER_DRAIN = false; const FP& P;
    DI void operator()(const f32x4 (&acc)[2][2][4][2], const pg8::Unit& u, int wr, int wc, int fr, int fq) const {
        const int t = u.pn;
        EPI_LOOP({ if (row < MP) { const int pos = row_pos(row), n = row / SEQ, e = ct & 63, dp = e >> 1; const bool prm = row < M0;
            if (t < 3) { const int ty = 2 * t + (ct >> 7), kvh = (ct >> 6) & 1;
                if (ty == 2 || ty == 4) { f32x4 lo, hi; rope4(P.ROPE + pos * 64, dp, v0, v1, lo, hi);
                    if (ty == 2) { float* o = (prm ? P.nsa_kv_p + (size_t)row * 512 : P.nsa_kv_s + (size_t)(row - M0) * 512) + 256 + kvh * 64 + dp; *(f32x4*)o = lo; *(f32x4*)(o + 32) = hi;
                        if (prm) { bf16* kt = P.SLK + ((size_t)n * NSA_KV_HEADS + kvh) * SEQ * 64; *(u32x2*)(kt + ktile_off(pos, dp)) = pk4(lo); *(u32x2*)(kt + ktile_off(pos, dp + 32)) = pk4(hi); } }
                    else { float* o = nullptr; if (!prm) o = P.win_s + (((size_t)(row - M0) * SWA_WINDOW + SWA_WINDOW - 1) * 2 + 0) * 128; else if (pos >= SEQ - SWA_WINDOW) o = P.win_p + (((size_t)n * SWA_WINDOW + pos - (SEQ - SWA_WINDOW)) * 2 + 0) * 128;
                        if (o) { *(f32x4*)(o + kvh * 64 + dp) = lo; *(f32x4*)(o + kvh * 64 + 32 + dp) = hi; }
                        if (prm) { bf16* kt = P.WNK + ((size_t)n * NSA_KV_HEADS + kvh) * SEQ * 64; *(u32x2*)(kt + ktile_off(pos, dp)) = pk4(lo); *(u32x2*)(kt + ktile_off(pos, dp + 32)) = pk4(hi); } } }
                else if (ty < 4) { float* o = (prm ? P.nsa_kv_p + (size_t)row * 512 : P.nsa_kv_s + (size_t)(row - M0) * 512) + ty * 128 + kvh * 64 + e; *(f32x4*)o = v0; *(f32x4*)(o + 4) = v1;
                    if (prm) { if (ty < 2) *(u32x4*)(P.AC + ((size_t)ty * ACROWS + ((size_t)n * NSA_KV_HEADS + kvh) * NCH + pos / 16) * 1024 + (pos % 16) * 64 + e) = pk8(v0, v1);
                        else { bf16* vt = P.SLVT + ((size_t)n * NSA_KV_HEADS + kvh) * SEQ * 64 + vtile_off(e, pos);
                            vt[0] = (bf16)f2bf(v0.x); vt[8] = (bf16)f2bf(v0.y); vt[16] = (bf16)f2bf(v0.z); vt[24] = (bf16)f2bf(v0.w); vt[32] = (bf16)f2bf(v1.x); vt[40] = (bf16)f2bf(v1.y); vt[48] = (bf16)f2bf(v1.z); vt[56] = (bf16)f2bf(v1.w); } } }
                else { float* o = nullptr; if (!prm) o = P.win_s + (((size_t)(row - M0) * SWA_WINDOW + SWA_WINDOW - 1) * 2 + 1) * 128; else if (pos >= SEQ - SWA_WINDOW) o = P.win_p + (((size_t)n * SWA_WINDOW + pos - (SEQ - SWA_WINDOW)) * 2 + 1) * 128;
                    if (o) { *(f32x4*)(o + kvh * 64 + e) = v0; *(f32x4*)(o + kvh * 64 + e + 4) = v1; }
                    if (prm) { bf16* vt = P.WNVT + ((size_t)n * NSA_KV_HEADS + kvh) * SEQ * 64 + vtile_off(e, pos);
                        vt[0] = (bf16)f2bf(v0.x); vt[8] = (bf16)f2bf(v0.y); vt[16] = (bf16)f2bf(v0.z); vt[24] = (bf16)f2bf(v0.w); vt[32] = (bf16)f2bf(v1.x); vt[40] = (bf16)f2bf(v1.y); vt[48] = (bf16)f2bf(v1.z); vt[56] = (bf16)f2bf(v1.w); } } }
            else if (t < 6) { const int h = (t - 3) * 4 + (ct >> 6); f32x4 lo, hi; rope4(P.ROPE + pos * 64, dp, v0, v1, lo, hi); bf16* q = P.QB + (size_t)row * NSA_Q_COLS + h * 64 + dp; *(u32x2*)q = pk4(lo * QSCALE); *(u32x2*)(q + 32) = pk4(hi * QSCALE); }
            else if (t == 6) { *(u32x4*)(P.MQB + (size_t)row * 256 + ct) = pk8(v0 * QSCALE, v1 * QSCALE); }
            else if (ct < 40) { const float vv[8] = {v0.x, v0.y, v0.z, v0.w, v1.x, v1.y, v1.z, v1.w};
                _Pragma("unroll") for (int i = 0; i < 8; ++i) if (ct + i < NSA_GATE_COLS) P.GATES[(size_t)row * 64 + ct + i] = 1.0f / (1.0f + __expf(-vv[i])); } } })
    }
};
DI void cmp2_phase(const FP& P, const Ctx& C) {
    const int lane = C.lane; LAS float* hs = (LAS float*)(C.lds + C.wave * 1024);
    constexpr int NGRP = NCTX * 2 * NSA_KV_HEADS; const int NW = C.G * NWAVES, WPG = NW / NGRP > 0 ? NW / NGRP : 1; const int gw = C.vcu * NWAVES + C.wave;
#pragma unroll 1
    for (int grp = gw / WPG; grp < NGRP; grp += (NW + WPG - 1) / WPG) { const int slot = gw % WPG; if (gw >= (NW / WPG) * WPG && grp == gw / WPG) break;
        const int kvh = grp % NSA_KV_HEADS, ty = (grp / NSA_KV_HEADS) % 2, ctx = grp / (2 * NSA_KV_HEADS);
        const float* UL = P.UL + ((size_t)ty * ACROWS + ((size_t)ctx * NSA_KV_HEADS + kvh) * NCH) * 256; const float* w2 = P.cmp_w2 + (size_t)ty * CMP_HIDDEN * HEAD_DIM;
        float w2r[CMP_HIDDEN];
#pragma unroll
        for (int k = 0; k < CMP_HIDDEN; ++k) w2r[k] = w2[k * HEAD_DIM + lane];
        const float b0 = P.CBIAS[ty * CMP_HIDDEN + lane], b1 = P.CBIAS[ty * CMP_HIDDEN + 64 + lane];
        float u0, u1, l0, l1; int c = slot;
        if (c < NCMP) { u0 = UL[(size_t)c * 256 + lane]; u1 = UL[(size_t)c * 256 + 64 + lane]; l0 = UL[(size_t)(c + 1) * 256 + 128 + lane]; l1 = UL[(size_t)(c + 1) * 256 + 192 + lane]; }
#pragma unroll 1
        for (; c < NCMP; c += WPG) { const float h0 = gelu_tanh(u0 + l0 + b0), h1 = gelu_tanh(u1 + l1 + b1); const int cn = c + WPG;
            if (cn < NCMP) { u0 = UL[(size_t)cn * 256 + lane]; u1 = UL[(size_t)cn * 256 + 64 + lane]; l0 = UL[(size_t)(cn + 1) * 256 + 128 + lane]; l1 = UL[(size_t)(cn + 1) * 256 + 192 + lane]; }
            hs[lane] = h0; hs[64 + lane] = h1; asm volatile("s_waitcnt lgkmcnt(0)" ::: "memory");
            float a = 0.f;
#pragma unroll
            for (int k4 = 0; k4 < CMP_HIDDEN / 4; ++k4) { const f32x4 hv = *(const LAS f32x4*)(hs + 4 * k4); a += hv.x * w2r[4 * k4] + hv.y * w2r[4 * k4 + 1] + hv.z * w2r[4 * k4 + 2] + hv.w * w2r[4 * k4 + 3]; }
            if (ty == 0) { const float other = __shfl_xor(a, 32); const int pos = c * CMP_STRIDE + CMP_BLOCK - 1; const float cs = P.ROPE[pos * 64 + (lane & 31)], sn = P.ROPE[pos * 64 + 32 + (lane & 31)];
                a = (lane < 32) ? a * cs - other * sn : a * cs + other * sn; }
            if (ctx < BATCH) { if (ty == 0) P.CK[((size_t)ctx * NSA_KV_HEADS + kvh) * NCH * 64 + ktile_off(c, lane)] = (bf16)f2bf(a); else P.CVT[((size_t)ctx * NSA_KV_HEADS + kvh) * NCH * 64 + vtile_off(lane, c)] = (bf16)f2bf(a); }
            else { (ty == 0 ? P.CKF : P.CVF)[(((size_t)(ctx - BATCH) * NSA_KV_HEADS + kvh) * NCH + c) * 64 + lane] = a; }
            asm volatile("s_waitcnt lgkmcnt(0)" ::: "memory"); }
    }
    __syncthreads();
}
constexpr int NSA_WLDS = 8192;
DI void nsa_pair_a(const FP& P, int n, int kvh, int t, int lane, LAS unsigned char* wl) {
    LAS float* pn = (LAS float*)wl; LAS float* imp = (LAS float*)(wl + 2048); LAS float* sc = (LAS float*)(wl + 6144); LAS int* sel = (LAS int*)(wl + 7168);
    const int col = lane & 15, c = lane >> 4; const bool vcol = col < 12; const int qq = vcol ? col / 6 : 0, hh = vcol ? col % 6 : 0, tq = t + qq, head = kvh * NSA_GROUP + hh, row = n * SEQ + tq;
    bf16x8 qf[2]; { const bf16* qp = P.QB + (size_t)row * NSA_Q_COLS + head * 64 + 8 * c; qf[0] = *(const bf16x8*)qp; qf[1] = *(const bf16x8*)(qp + 32); }
    const float* gt = P.GATES + (size_t)row * 64 + head * 3;
    f32x4 oacc[4] = {(f32x4){0.f, 0.f, 0.f, 0.f}, (f32x4){0.f, 0.f, 0.f, 0.f}, (f32x4){0.f, 0.f, 0.f, 0.f}, (f32x4){0.f, 0.f, 0.f, 0.f}};
    const int lim = vcol ? ((tq >= CMP_BLOCK - 1) ? (tq - (CMP_BLOCK - 1)) / CMP_STRIDE : -1) : -1;
    const int limmax = (t + 1 >= CMP_BLOCK - 1) ? (t + 1 - (CMP_BLOCK - 1)) / CMP_STRIDE : -1; const int nblk = (limmax + 32) / 32;
    const bf16* CKb = P.CK + ((size_t)n * NSA_KV_HEADS + kvh) * NCH * 64; const bf16* CVb = P.CVT + ((size_t)n * NSA_KV_HEADS + kvh) * 64 * NCH;
    for (int i = lane; i < 1024; i += 64) imp[i] = 0.f;
    float m1 = -INFINITY, l1 = 0.f;
    { struct K4 { bf16x8 a0, a1, b0, b1; };
      auto ldk = [&](K4& k, int blk) { const bf16* kt = CKb + (size_t)blk * 2048 + lane * 8; k.a0 = *(const bf16x8*)kt; k.a1 = *(const bf16x8*)(kt + 512); k.b0 = *(const bf16x8*)(kt + 1024); k.b1 = *(const bf16x8*)(kt + 1536); };
      auto cp1 = [&](const K4& k, int blk) { const int kb = 32 * blk;
        f32x4 s0 = (f32x4){0.f, 0.f, 0.f, 0.f}, s1 = (f32x4){0.f, 0.f, 0.f, 0.f};
        s0 = __builtin_amdgcn_mfma_f32_16x16x32_bf16(k.a0, qf[0], s0, 0, 0, 0); s0 = __builtin_amdgcn_mfma_f32_16x16x32_bf16(k.a1, qf[1], s0, 0, 0, 0);
        s1 = __builtin_amdgcn_mfma_f32_16x16x32_bf16(k.b0, qf[0], s1, 0, 0, 0); s1 = __builtin_amdgcn_mfma_f32_16x16x32_bf16(k.b1, qf[1], s1, 0, 0, 0);
        float s[8] = {s0.x, s0.y, s0.z, s0.w, s1.x, s1.y, s1.z, s1.w}; float mx = -INFINITY;
        const int hi1 = lim - (kb + 8 * c);
#pragma unroll
        for (int e = 0; e < 8; ++e) { s[e] = (e <= hi1) ? s[e] : -INFINITY; mx = fmaxf(mx, s[e]); }
        mx = colmax(mx);
        const float mnew = fmaxf(m1, mx), muse = (mnew == -INFINITY) ? 0.f : mnew; float ls = 0.f;
#pragma unroll
        for (int e = 0; e < 8; ++e) ls += __builtin_amdgcn_exp2f(s[e] - muse);
        l1 = l1 * __builtin_amdgcn_exp2f(m1 - muse) + ls; m1 = mnew; };
      if (nblk > 0) { K4 A, B; ldk(A, 0);
#pragma unroll 1
        for (int blk = 0; blk < nblk; blk += 2) { ldk(B, (blk + 1 < nblk) ? blk + 1 : blk); cp1(A, blk); ldk(A, (blk + 2 < nblk) ? blk + 2 : blk); if (blk + 1 < nblk) cp1(B, blk + 1); } } }
    asm volatile("s_waitcnt lgkmcnt(0)" ::: "memory");
    { l1 = colsum(l1); const float muse = (m1 == -INFINITY) ? 0.f : m1, inv = (l1 > 0.f) ? 1.0f / l1 : 0.f;
      f32x4 oc[4] = {(f32x4){0.f, 0.f, 0.f, 0.f}, (f32x4){0.f, 0.f, 0.f, 0.f}, (f32x4){0.f, 0.f, 0.f, 0.f}, (f32x4){0.f, 0.f, 0.f, 0.f}};
      pipe2(nblk, [&](KV8& kv, int blk) { kv_load_t(kv, CKb + (size_t)blk * 2048, CVb + (size_t)blk * 2048, lane); }, [&](const KV8& kv, int blk) { const int kb = 32 * blk;
        f32x4 s0 = (f32x4){0.f, 0.f, 0.f, 0.f}, s1 = (f32x4){0.f, 0.f, 0.f, 0.f};
        s0 = __builtin_amdgcn_mfma_f32_16x16x32_bf16(kv.ka0, qf[0], s0, 0, 0, 0); s0 = __builtin_amdgcn_mfma_f32_16x16x32_bf16(kv.ka1, qf[1], s0, 0, 0, 0);
        s1 = __builtin_amdgcn_mfma_f32_16x16x32_bf16(kv.kb0, qf[0], s1, 0, 0, 0); s1 = __builtin_amdgcn_mfma_f32_16x16x32_bf16(kv.kb1, qf[1], s1, 0, 0, 0);
        float s[8] = {s0.x, s0.y, s0.z, s0.w, s1.x, s1.y, s1.z, s1.w};
        const int hi2 = lim - (kb + 8 * c);
#pragma unroll
        for (int e = 0; e < 8; ++e) s[e] = (e <= hi2) ? __builtin_amdgcn_exp2f(s[e] - muse) * inv : 0.f;
        *(f32x4*)(pn + col * 32 + 8 * c) = (f32x4){s[0], s[1], s[2], s[3]}; *(f32x4*)(pn + col * 32 + 8 * c + 4) = (f32x4){s[4], s[5], s[6], s[7]};
        u32x4 pw; pw.x = cvtpk(s[0], s[1]); pw.y = cvtpk(s[2], s[3]); pw.z = cvtpk(s[4], s[5]); pw.w = cvtpk(s[6], s[7]); const bf16x8 pf = __builtin_bit_cast(bf16x8, pw);
        oc[0] = __builtin_amdgcn_mfma_f32_16x16x32_bf16(kv.v0, pf, oc[0], 0, 0, 0); oc[1] = __builtin_amdgcn_mfma_f32_16x16x32_bf16(kv.v1, pf, oc[1], 0, 0, 0);
        oc[2] = __builtin_amdgcn_mfma_f32_16x16x32_bf16(kv.v2, pf, oc[2], 0, 0, 0); oc[3] = __builtin_amdgcn_mfma_f32_16x16x32_bf16(kv.v3, pf, oc[3], 0, 0, 0);
        asm volatile("s_waitcnt lgkmcnt(0)" ::: "memory");
        { const int q2 = lane >> 5, k = lane & 31; float a = 0.f;
#pragma unroll
          for (int h6 = 0; h6 < 6; ++h6) a += pn[(q2 * 6 + h6) * 32 + k];
          imp[q2 * 512 + kb + k] = a; }
        asm volatile("s_waitcnt lgkmcnt(0)" ::: "memory"); });
#ifdef NSA_DEBUG
      if (vcol) { for (int db = 0; db < 4; ++db) *(f32x4*)(P.DBG + ((size_t)0 * MP + row) * 768 + head * 64 + 16 * db + 4 * c) = oc[db]; }
#endif
      const float g0 = vcol ? gt[0] : 0.f;
#pragma unroll
      for (int db = 0; db < 4; ++db) oacc[db] += oc[db] * g0; }
#ifndef REP_SEL
#define REP_SEL 1
#endif
#pragma unroll 1
    for (int rep = 0; rep < REP_SEL; ++rep) {
    for (int i = lane; i < 256; i += 64) { const int q2 = i >> 7, b = i & 127, tq2 = t + q2, cur = tq2 / SLC_BLOCK; float sv;
        if (b > cur) sv = NEG; else if (b == 0 || b == cur || b == cur - 1) sv = FORCE_SCORE;
        else { const LAS float* ic = imp + q2 * 512 + 4 * b; sv = ic[-1] + 2.f * (ic[0] + ic[1] + ic[2]) + ic[3]; }
        sc[i] = pack_key(sv, 127u - (unsigned)b, 127u); }
    asm volatile("s_waitcnt lgkmcnt(0)" ::: "memory");
    for (int i = lane; i < 256; i += 64) { const int q2 = i >> 7, b = i & 127; const float sv = sc[i]; int rank = 0;
        for (int j = 0; j < 128; j += 4) { const f32x4 o = *(const LAS f32x4*)(sc + q2 * 128 + j);
            rank += (o.x > sv) ? 1 : 0; rank += (o.y > sv) ? 1 : 0; rank += (o.z > sv) ? 1 : 0; rank += (o.w > sv) ? 1 : 0; }
        if (rank < SLC_TOPK) { const int v = (sv > 0.5f * NEG) ? b : -1; sel[q2 * 16 + rank] = v; P.SELB[((size_t)(n * SEQ + t + q2) * NSA_KV_HEADS + kvh) * 16 + rank] = v; } }
    asm volatile("s_waitcnt lgkmcnt(0)" ::: "memory");
    }
#ifndef REP_WIN
#define REP_WIN 1
#endif
#pragma unroll 1
    for (int rep = 0; rep < REP_WIN; ++rep) { Tile16 T; tile_init(T);
      const bf16* WKb = P.WNK + ((size_t)n * NSA_KV_HEADS + kvh) * SEQ * 64; const bf16* WVb = P.WNVT + ((size_t)n * NSA_KV_HEADS + kvh) * 64 * SEQ;
      const int blo = (t - SWA_WINDOW) >> 5, bhi = (t + 1) >> 5;
      auto ld = [&](KV8& kv, int blk) { const int bc = blk < 0 ? 0 : blk; kv_load_t(kv, WKb + (size_t)bc * 2048, WVb + (size_t)bc * 2048, lane); };
      pipe2(bhi - blo + 1, [&](KV8& kv, int i) { ld(kv, blo + i); }, [&](const KV8& kv, int i) { const int kb = 32 * (blo + i);
          const int k0 = kb + 8 * c; int lo; unsigned rng; const int a = tq - SWA_WINDOW; mk_range((a > 0 ? a : 0) - k0, tq - k0, vcol, lo, rng); tile_compute(T, qf, kv, lo, rng); });
      T.l = colsum(T.l);
      const float inv = (T.l > 0.f) ? 1.0f / T.l : 0.f, g2 = vcol ? gt[2] * inv : 0.f;
#ifdef NSA_DEBUG
      if (vcol) { for (int db = 0; db < 4; ++db) *(f32x4*)(P.DBG + ((size_t)2 * MP + row) * 768 + head * 64 + 16 * db + 4 * c) = T.o[db] * inv; }
#endif
#pragma unroll
      for (int db = 0; db < 4; ++db) if (rep == REP_WIN - 1) oacc[db] += T.o[db] * g2; }
    if (vcol) { float* op = P.DPART + (size_t)row * 768 + head * 64 + 4 * c;
#pragma unroll
        for (int db = 0; db < 4; ++db) *(f32x4*)(op + 16 * db) = oacc[db]; }
}
DI void nsa_pair_b(const FP& P, int n, int kvh, int t, int lane, LAS unsigned char* wl) {
    LAS int* steps = (LAS int*)wl;
    const int col = lane & 15, c = lane >> 4; const bool vcol = col < 12; const int qq = vcol ? col / 6 : 0, hh = vcol ? col % 6 : 0, tq = t + qq, head = kvh * NSA_GROUP + hh, row = n * SEQ + tq;
    bf16x8 qf[2]; { const bf16* qp = P.QB + (size_t)row * NSA_Q_COLS + head * 64 + 8 * c; qf[0] = *(const bf16x8*)qp; qf[1] = *(const bf16x8*)(qp + 32); }
    const float* gt = P.GATES + (size_t)row * 64 + head * 3;
    Tile16 T; tile_init(T);
    const bf16* SKb = P.SLK + ((size_t)n * NSA_KV_HEADS + kvh) * SEQ * 64; const bf16* SVb = P.SLVT + ((size_t)n * NSA_KV_HEADS + kvh) * SEQ * 64;
    int ns = 0;
    { const int mysel = (lane < 32) ? P.SELB[((size_t)(n * SEQ + t + (lane >> 4)) * NSA_KV_HEADS + kvh) * 16 + (lane & 15)] : -1;
      for (int i = 0; i < 32; ++i) { const int b = __builtin_amdgcn_readlane(mysel, i); if (b < 0) continue; int q2 = i >> 4;
          const unsigned long long other = __ballot(mysel == b && lane < 32 && (lane >> 4) != q2);
          if (other) { if (q2 == 1) continue; q2 = 2; }
          if (lane == 0) { steps[ns] = (b * SLC_BLOCK) | (q2 << 29); steps[ns + 1] = (b * SLC_BLOCK + 32) | (q2 << 29); } ns += 2; } }
    asm volatile("s_waitcnt lgkmcnt(0)" ::: "memory");
    auto ld = [&](KV8& kv, int i) { const int code = __builtin_amdgcn_readfirstlane(steps[i]); const int kb = code & 0x1fffffff;
        kv_load_t(kv, SKb + (size_t)(kb >> 5) * 2048, SVb + (size_t)(kb >> 5) * 2048, lane); };
#ifdef PROBE_DBLCOMP
    Tile16 T2; tile_init(T2);
#endif
    pipe2(ns, ld, [&](const KV8& kv, int i) { const int code = __builtin_amdgcn_readfirstlane(steps[i]); const int kb = code & 0x1fffffff, q2 = code >> 29;
        int lo; unsigned rng; mk_range(-64, tq - (kb + 8 * c), vcol && (q2 == 2 || qq == q2), lo, rng); tile_compute(T, qf, kv, lo, rng);
#ifdef PROBE_DBLCOMP
        tile_compute(T2, qf, kv, [&](int e) { return vcol && qq == q2 && (kb + 8 * c + e + 1) <= tq; });
#endif
    });
#ifdef PROBE_DBLCOMP
    if (T2.l < 0.f) T.l = 0.f;
#endif
    T.l = colsum(T.l);
    const float inv = (T.l > 0.f) ? 1.0f / T.l : 0.f, g1 = vcol ? gt[1] * inv : 0.f;
#ifdef NSA_DEBUG
    if (vcol) { for (int db = 0; db < 4; ++db) *(f32x4*)(P.DBG + ((size_t)1 * MP + row) * 768 + head * 64 + 16 * db + 4 * c) = T.o[db] * inv; }
#endif
    if (vcol) { const float* pp = P.DPART + (size_t)row * 768 + head * 64 + 4 * c; bf16* op = P.ATTB + (size_t)row * 1024 + head * 64 + 4 * c;
#pragma unroll
        for (int db = 0; db < 4; ++db) *(u32x2*)(op + 16 * db) = pk4(*(const f32x4*)(pp + 16 * db) + T.o[db] * g1); }
}

constexpr int SMP_SK = 1088;
template <class KF, class VF> DI void smp_branch(const Ctx& C, LAS float* qs, LAS float* S, LAS float* red, int NK, KF kf, VF vf, bool keep_probs, float (&outh)[1]) {
    const int tid = C.tid, lane = C.lane, w = C.wave;
#pragma unroll 1
    for (int j = tid; j < NK; j += NTHREADS) { const float* k = kf(j); f32x4 kr[16];
#pragma unroll
        for (int d4 = 0; d4 < 16; ++d4) kr[d4] = *(const f32x4*)(k + 4 * d4);
#pragma unroll 1
        for (int h = 0; h < 6; ++h) { float a = 0.f;
#pragma unroll
            for (int d4 = 0; d4 < 16; ++d4) { const f32x4 qv = *(const LAS f32x4*)(qs + h * 64 + 4 * d4); a += kr[d4].x * qv.x + kr[d4].y * qv.y + kr[d4].z * qv.z + kr[d4].w * qv.w; }
            S[h * SMP_SK + j] = a; } }
    asm volatile("s_waitcnt lgkmcnt(0)" ::: "memory"); __syncthreads();
    if (w < 6) { float m = -INFINITY; for (int j = lane; j < NK; j += 64) m = fmaxf(m, S[w * SMP_SK + j]); m = wave_max(m);
        float l = 0.f; for (int j = lane; j < NK; j += 64) { const float p = __builtin_amdgcn_exp2f(S[w * SMP_SK + j] - m); S[w * SMP_SK + j] = p; l += p; } l = wave_sum(l);
        const float inv = 1.0f / l; for (int j = lane; j < NK; j += 64) S[w * SMP_SK + j] *= inv; }
    asm volatile("s_waitcnt lgkmcnt(0)" ::: "memory"); __syncthreads();
    { const int per = (NK + NWAVES - 1) / NWAVES, j0 = w * per, j1 = (j0 + per < NK) ? j0 + per : NK; float o[6] = {0.f, 0.f, 0.f, 0.f, 0.f, 0.f};
#pragma unroll 1
      for (int j = j0; j < j1; j += 8) { float vv[8];
#pragma unroll
          for (int u = 0; u < 8; ++u) { const int jj = (j + u < j1) ? j + u : j1 - 1; vv[u] = vf(jj)[lane]; }
#pragma unroll
          for (int u = 0; u < 8; ++u) if (j + u < j1) {
#pragma unroll
              for (int h = 0; h < 6; ++h) o[h] += S[h * SMP_SK + j + u] * vv[u]; } }
#pragma unroll
      for (int h = 0; h < 6; ++h) red[(w * 6 + h) * 64 + lane] = o[h]; }
    asm volatile("s_waitcnt lgkmcnt(0)" ::: "memory"); __syncthreads();
    outh[0] = 0.f;
    if (tid < 384) { float a = 0.f;
#pragma unroll
        for (int ww = 0; ww < NWAVES; ++ww) a += red[ww * 384 + tid]; outh[0] = a; }
    if (!keep_probs) { __syncthreads(); }
}
DI void nsa_sample_item(const FP& P, const Ctx& C, int ns, int kvh) {
    LAS float* qs = (LAS float*)C.lds; LAS float* S = qs + 384; LAS float* red = S + 6 * SMP_SK; LAS float* scs = red + 8 * 384; LAS int* sel = (LAS int*)(scs + 136);
    const int tid = C.tid, row = M0 + ns;
    if (tid < 384) qs[tid] = bf2f(P.QB[(size_t)row * NSA_Q_COLS + kvh * 384 + tid]);
    asm volatile("s_waitcnt lgkmcnt(0)" ::: "memory"); __syncthreads();
    const float* ckf = P.CKF + ((size_t)ns * NSA_KV_HEADS + kvh) * NCH * 64; const float* cvf = P.CVF + ((size_t)ns * NSA_KV_HEADS + kvh) * NCH * 64;
    float oc[1], os[1], ow[1];
    smp_branch(C, qs, S, red, NCMP, [&](int j) { return ckf + (size_t)j * 64; }, [&](int j) { return cvf + (size_t)j * 64; }, true, oc);
    constexpr int NBS = (PAST_LEN + 1 + SLC_BLOCK - 1) / SLC_BLOCK, CURS = PAST_LEN / SLC_BLOCK;
    for (int b = tid; b < 136; b += NTHREADS) { float sv = -3.0e38f;
        if (b < NBS) { if (b == 0 || b == CURS || b == CURS - 1) sv = FORCE_SCORE; else { float a = 0.f;
#pragma unroll
                for (int o = -1; o <= 3; ++o) { const int ci = 4 * b + o; if (ci >= 0 && ci < NCMP) { float sm = 0.f; for (int h6 = 0; h6 < 6; ++h6) sm += S[h6 * SMP_SK + ci]; a += ((o >= 0 && o <= 2) ? 2.f : 1.f) * sm; } }
                sv = a; } }
        scs[b] = sv; }
    asm volatile("s_waitcnt lgkmcnt(0)" ::: "memory"); __syncthreads();
    for (int b = tid; b < NBS; b += NTHREADS) { const float sv = scs[b]; int rank = 0; for (int j = 0; j < NBS; ++j) { const float o = scs[j]; rank += (o > sv || (o == sv && j < b)) ? 1 : 0; }
        if (rank < SLC_TOPK) { sel[rank] = b; P.SELB[((size_t)row * NSA_KV_HEADS + kvh) * 16 + rank] = b; } }
    asm volatile("s_waitcnt lgkmcnt(0)" ::: "memory"); __syncthreads();
    { const float* newrow = P.nsa_kv_s + (size_t)ns * 512; const int* pt = P.page_table + ns * (PAST_LEN / PAGE_SIZE);
      if (tid == 0) { int seen = 0; for (int x = 0; x < SLC_TOPK; ++x) { const int bx = sel[x]; if (bx != CURS && seen < 15) sel[16 + seen++] = bx; } }
      asm volatile("s_waitcnt lgkmcnt(0)" ::: "memory"); __syncthreads();
      auto krow = [&](int j, int ty) -> const float* { if (j >= 15 * 64) return newrow + ty * 128 + kvh * 64;
          const int t0 = sel[16 + (j >> 6)] * SLC_BLOCK + (j & 63); const int pg = pt[t0 / PAGE_SIZE]; return P.cache_nsa_kv + ((size_t)pg * PAGE_SIZE + t0 % PAGE_SIZE) * 512 + ty * 128 + kvh * 64; };
      smp_branch(C, qs, S, red, 15 * 64 + 1, [&](int j) { return krow(j, 2); }, [&](int j) { return krow(j, 3); }, false, os); }
    { const float* wc = P.cache_nsa_win + (size_t)ns * SWA_WINDOW * 256; const float* newrow = P.win_s + ((size_t)ns * SWA_WINDOW + SWA_WINDOW - 1) * 256;
      smp_branch(C, qs, S, red, SWA_WINDOW + 1, [&](int j) { return (j < SWA_WINDOW ? wc + (size_t)j * 256 : newrow) + kvh * 64; }, [&](int j) { return (j < SWA_WINDOW ? wc + (size_t)j * 256 : newrow) + 128 + kvh * 64; }, false, ow); }
    if (tid < 384) { const int head = kvh * NSA_GROUP + tid / 64; const float* gt = P.GATES + (size_t)row * 64 + head * 3;
        P.ATTB[(size_t)row * 1024 + kvh * 384 + tid] = (bf16)f2bf(gt[0] * oc[0] + gt[1] * os[0] + gt[2] * ow[0]);
#ifdef NSA_DEBUG
        P.DBG[((size_t)0 * MP + row) * 768 + kvh * 384 + tid] = oc[0]; P.DBG[((size_t)1 * MP + row) * 768 + kvh * 384 + tid] = os[0]; P.DBG[((size_t)2 * MP + row) * 768 + kvh * 384 + tid] = ow[0];
#endif
    }
    __syncthreads();
}
DI void nsa_pairs(const FP& P, const Ctx& C, bool second) {
    LAS unsigned char* wl = C.lds + C.wave * NSA_WLDS;
    const int per = C.G / 4 > 0 ? C.G / 4 : 1, grp = (C.vcu / per) & 3, sub = C.vcu % per, n = grp >> 1, kvh = grp & 1;
#pragma unroll 1
    for (int pr = sub * NWAVES + C.wave; pr < SEQ / 2; pr += per * NWAVES) { if (second) nsa_pair_b(P, n, kvh, 2 * pr, C.lane, wl); else nsa_pair_a(P, n, kvh, 2 * pr, C.lane, wl); }
}
DI void nsa_phase_a(const FP& P, const Ctx& C) {
    for (int it = C.vcu; it < DEC_BATCH * NSA_KV_HEADS; it += C.G) nsa_sample_item(P, C, it / NSA_KV_HEADS, it % NSA_KV_HEADS);
    nsa_pairs(P, C, false);
    __syncthreads();
}
DI void nsa_phase_b(const FP& P, const Ctx& C) {
    const int lane = C.lane, w = C.wave;
    nsa_pairs(P, C, true);
    __syncthreads();
    { constexpr int NMT = (M0 / 16) * MEM_HEADS;
      for (int it = C.vcu * NWAVES + w; it < NMT; it += C.G * NWAVES) { const int h = it % MEM_HEADS, q16 = it / MEM_HEADS, row0 = q16 * 16, n = row0 / SEQ;
          mem_micro(P, P.MQB + h * 64, 256, row0, 1, n, h, P.ATTB + NSA_Q_COLS + h * 64, 1024, lane); }
    }
    { LAS float* qs = (LAS float*)C.lds;
      for (int it = C.vcu; it < DEC_BATCH * MEM_HEADS; it += C.G) { const int h = it % MEM_HEADS, ns = it / MEM_HEADS, row = M0 + ns;
          __syncthreads(); if (C.tid < 64) qs[C.tid] = bf2f(P.MQB[(size_t)row * 256 + h * 64 + C.tid]); asm volatile("s_waitcnt lgkmcnt(0)" ::: "memory"); __syncthreads();
          Dec D; D.m = -INFINITY; D.l = 0.f; D.o = 0.f; const float* mk = P.cache_mem_kv + ((size_t)1 * DEC_BATCH + ns) * MEM_TOKENS * 512;
          for (int ck = w; ck < MEM_TOKENS / 64; ck += NWAVES) { const int j0 = ck * 64; dec_chunk(D, qs, 64, [&](int j) { return mk + (size_t)(j0 + j) * 512 + h * 64; }, [&](int j) { return mk + (size_t)(j0 + j) * 512 + 256 + h * 64; }, lane); }
          const float o = dec_combine(C, D);
          if (w == 0) P.ATTB[(size_t)row * 1024 + NSA_Q_COLS + h * 64 + lane] = (bf16)f2bf(o); } }
    __syncthreads();
}
}
namespace fx {
enum { PH_PRO = 0, PH_G1, PH_ATTA, PH_G2, PH_LN1, PH_SC0, PH_TK0, PH_PU0, PH_PG0, PH_G3, PH_CMPG, PH_CMP2, PH_NSA, PH_NSB, PH_G4, PH_LN3, PH_SC1, PH_TK1, PH_PU1, PH_PG1, PH_COUNT };
template <class Epi> DI void run_gemm(const Ctx& C, const bf16* A, const bf16* Bt, int M, int N, int K, const Epi& E) {
    pg8::Gemm g{A, Bt, M, N, K}; pg8::StaticOrder S; S.init(M, N, C.G, (int)blockIdx.x);
    pg8::gemm_phase<Epi, pg8::StaticOrder, true, true>(C.lds, g, S, E);
}
template <class Epi> DI void skinny_gemm(const Ctx& C, const bf16* A, const bf16* Bt, int N, int K, const Epi& E) {
    static_assert(DEC_BATCH == 32 && M0 % 256 == 0, "skinny_gemm: 32 sample rows right after a whole number of 256-row tiles");
    const int lane = C.lane, fr = lane & 15, fq = lane >> 4, w = C.wave; const int NI = (N / 256) * 4, KW = K / NWAVES;
    LAS f32x4* red = (LAS f32x4*)C.lds;
#pragma unroll 1
    for (int item = C.vcu; item < NI; item += C.G) { const int pn = item >> 2, wc = item & 3;
        f32x4 pa[2][2][2];
#pragma unroll
        for (int i = 0; i < 8; ++i) (&pa[0][0][0])[i] = (f32x4){0.f, 0.f, 0.f, 0.f};
        const bf16* xa = A + (size_t)(M0 + fr) * K + w * KW + 8 * fq; const bf16* xb = xa + (size_t)16 * K;
        const bf16* wp[2][2];
#pragma unroll
        for (int bj = 0; bj < 2; ++bj)
#pragma unroll
            for (int n = 0; n < 2; ++n) wp[bj][n] = Bt + (size_t)(pn * 256 + bj * 128 + wc * 32 + 8 * (fr >> 2) + 4 * n + (fr & 3)) * K + w * KW + 8 * fq;
#pragma unroll 4
        for (int k0 = 0; k0 < KW; k0 += 32) { const bf16x8 x0 = *(const bf16x8*)(xa + k0), x1 = *(const bf16x8*)(xb + k0);
#pragma unroll
            for (int bj = 0; bj < 2; ++bj)
#pragma unroll
                for (int n = 0; n < 2; ++n) { const bf16x8 wf = *(const bf16x8*)(wp[bj][n] + k0);
                    pa[bj][0][n] = __builtin_amdgcn_mfma_f32_16x16x32_bf16(wf, x0, pa[bj][0][n], 0, 0, 0); pa[bj][1][n] = __builtin_amdgcn_mfma_f32_16x16x32_bf16(wf, x1, pa[bj][1][n], 0, 0, 0); } }
        __syncthreads();
#pragma unroll
        for (int bj = 0; bj < 2; ++bj)
#pragma unroll
            for (int mm = 0; mm < 2; ++mm)
#pragma unroll
                for (int n = 0; n < 2; ++n) red[(w * 8 + bj * 4 + mm * 2 + n) * 64 + lane] = pa[bj][mm][n];
        asm volatile("s_waitcnt lgkmcnt(0)" ::: "memory"); __syncthreads();
        if (w == 0) { f32x4 acc[2][2][4][2];
#pragma unroll
            for (int i = 0; i < 32; ++i) (&acc[0][0][0][0])[i] = (f32x4){0.f, 0.f, 0.f, 0.f};
#pragma unroll
            for (int bj = 0; bj < 2; ++bj)
#pragma unroll
                for (int mm = 0; mm < 2; ++mm)
#pragma unroll
                    for (int n = 0; n < 2; ++n) { f32x4 s = red[(bj * 4 + mm * 2 + n) * 64 + lane];
#pragma unroll 1
                        for (int ww = 1; ww < NWAVES; ++ww) s += red[(ww * 8 + bj * 4 + mm * 2 + n) * 64 + lane];
                        acc[0][bj][mm][n] = s; }
            E(acc, pg8::Unit{M0 / 256, pn}, 0, wc, fr, fq); }
    }
    __syncthreads();
}
__global__ void __launch_bounds__(NTHREADS, 2) mega(Args args) {
    extern __shared__ __attribute__((aligned(16))) unsigned char lds_raw[];
    Ctx C; C.lds = (LAS unsigned char*)lds_raw; C.tid = threadIdx.x; C.lane = C.tid & 63; C.wave = __builtin_amdgcn_readfirstlane(C.tid >> 6);
    C.G = gridDim.x; { const int bx = blockIdx.x; C.vcu = (C.G % 8 == 0) ? (bx % 8) * (C.G / 8) + bx / 8 : bx; }
    const FP& P = args.p;
    volatile LAS unsigned* MISC = (volatile LAS unsigned*)(C.lds + MISC_OFF);
    for (int u = C.tid; u < (LDS_BYTES - RING_BYTES) / 4; u += NTHREADS) ((LAS unsigned*)(C.lds + RING_BYTES))[u] = 0u;
    __syncthreads();
    const int lo = args.lo, hi = args.hi;
    XcdBarrier bar; bar.bar = P.ctl + 1024; bar.x = 0; bar.st = nullptr;
    if (hi - lo > 1) bar = xcd_barrier_post(P.ctl + 1024, MISC + 8);
#define IN(k) (lo <= (k) && (k) < hi)
#define SEAM(k) do { if (IN(k) && IN((k) + 1)) xcd_barrier(bar); } while (0)
#ifndef DUP_PHASE
#define DUP_PHASE -1
#endif
#define PHASE(k, ...) do { if (IN(k)) { __VA_ARGS__ if (DUP_PHASE == (k)) { __syncthreads(); __VA_ARGS__ } } SEAM(k); } while (0)
    PHASE(PH_PRO, p0_prologue(P, C); __syncthreads(); p0_wpk(P, C););
    PHASE(PH_G1, run_gemm(C, P.XB0, P.WA_T, M0, ACOLS, D_MODEL, EpiA{P}); run_gemm(C, P.MEMB, P.WMEM_T, BATCH * MEM_TOKENS, 1024, D_MODEL, EpiMem{P}); skinny_gemm(C, P.XB0, P.WA_T, ACOLS, D_MODEL, EpiA{P}););
#ifdef PEER_SHARD3
#define PEER_SHARDED_FN peer_sharded3_phase
#else
#define PEER_SHARDED_FN peer_sharded2_phase
#endif
    PHASE(PH_ATTA, atta_phase(P, C););
    PHASE(PH_G2, run_gemm(C, P.ATTA, P.WOA_T, M0, D_MODEL, 512, EpiPre{P.x_prompt, P.x_sample, P.PRE}); skinny_gemm(C, P.ATTA, P.WOA_T, D_MODEL, 512, EpiPre{P.x_prompt, P.x_sample, P.PRE}););
    PHASE(PH_LN1, ln_phase(P, C, P.PRE, P.ln_g, P.ln_b, P.X1, P.X1B, nullptr, nullptr););
    PHASE(PH_SC0, run_gemm(C, P.X1B, P.WPK_T, M0, NPK, D_MODEL, EpiF32{P.SCO, NPK, MP}); skinny_gemm(C, P.X1B, P.WPK_T, NPK, D_MODEL, EpiF32{P.SCO, NPK, MP}););
    PHASE(PH_TK0, topk_phase(P, C););
#ifdef PEER_SPLIT
    PHASE(PH_PU0, peer_u_phase(P, C, 0, P.X1B););
    PHASE(PH_PG0, peer_v_phase(P, C, 0, P.X1, P.X2, P.X2 + (size_t)M0 * D_MODEL, P.X2B););
#elif defined(PEER_SHARD2)
    PHASE(PH_PG0, const bool shd = (M0 % (C.G * NWAVES * PS2_ROWS)) == 0; if (shd) { PEER_SHARDED_FN(P, C, 0, P.X1, P.X1B, P.X2, P.X2B); __syncthreads(); } peer_phase(P, C, 0, P.X1, P.X2, P.X2 + (size_t)M0 * D_MODEL, P.X2B, shd););
#elif defined(PEER_SHARD)
    PHASE(PH_PG0, peer_sharded_phase(P, C, 0, P.X1, P.X1B, P.X2, P.X2 + (size_t)M0 * D_MODEL, P.X2B); __syncthreads(); peer_phase(P, C, 0, P.X1, P.X2, P.X2 + (size_t)M0 * D_MODEL, P.X2B););
#else
    PHASE(PH_PG0, peer_phase(P, C, 0, P.X1, P.X2, P.X2 + (size_t)M0 * D_MODEL, P.X2B););
#endif
    PHASE(PH_G3, run_gemm(C, P.X2B, P.WB_T, M0, NB_T, D_MODEL, EpiB{P}); skinny_gemm(C, P.X2B, P.WB_T, NB_T, D_MODEL, EpiB{P}););
    PHASE(PH_CMPG, run_gemm(C, P.AC, P.CW1_T, ACROWS, 256, 1024, EpiF32{P.UL, 256, ACROWS}); run_gemm(C, P.AC + (size_t)ACROWS * 1024, P.CW1_T + 256 * 1024, ACROWS, 256, 1024, EpiF32{P.UL + (size_t)ACROWS * 256, 256, ACROWS}););
    PHASE(PH_CMP2, cmp2_phase(P, C););
    PHASE(PH_NSA, nsa_phase_a(P, C););
    PHASE(PH_NSB, nsa_phase_b(P, C););
    PHASE(PH_G4, run_gemm(C, P.ATTB, P.WOB_T, M0, D_MODEL, 1024, EpiPre{P.X2, nullptr, P.PRE}); skinny_gemm(C, P.ATTB, P.WOB_T, D_MODEL, 1024, EpiPre{P.X2, nullptr, P.PRE}););
    PHASE(PH_LN3, ln_phase(P, C, P.PRE, P.ln_g + 2 * D_MODEL, P.ln_b + 2 * D_MODEL, P.X3, P.X3B, nullptr, nullptr););
    PHASE(PH_SC1, run_gemm(C, P.X3B, P.WPK_T + (size_t)NPK * D_MODEL, M0, NPK, D_MODEL, EpiF32{P.SCO, NPK, MP}); skinny_gemm(C, P.X3B, P.WPK_T + (size_t)NPK * D_MODEL, NPK, D_MODEL, EpiF32{P.SCO, NPK, MP}););
    PHASE(PH_TK1, topk_phase(P, C););
#ifdef PEER_SPLIT
    PHASE(PH_PU1, peer_u_phase(P, C, 1, P.X3B););
    PHASE(PH_PG1, peer_v_phase(P, C, 1, P.X3, P.y_prompt, P.y_sample, nullptr););
#elif defined(PEER_SHARD2)
    PHASE(PH_PG1, const bool shd = (M0 % (C.G * NWAVES * PS2_ROWS)) == 0; if (shd) { PEER_SHARDED_FN(P, C, 1, P.X3, P.X3B, P.y_prompt, nullptr); __syncthreads(); } peer_phase(P, C, 1, P.X3, P.y_prompt, P.y_sample, nullptr, shd););
#elif defined(PEER_SHARD)
    PHASE(PH_PG1, peer_sharded_phase(P, C, 1, P.X3, P.X3B, P.y_prompt, P.y_sample, nullptr); __syncthreads(); peer_phase(P, C, 1, P.X3, P.y_prompt, P.y_sample, nullptr););
#else
    PHASE(PH_PG1, peer_phase(P, C, 1, P.X3, P.y_prompt, P.y_sample, nullptr););
#endif
#undef IN
#undef SEAM
}
}
#ifndef ONE_LAUNCH
#define ONE_LAUNCH 1
#endif
extern "C" void kernel_launch(void* const* d_in, const int* in_sizes, int n_in, void* d_out, int out_size, void* d_ws, size_t ws_size, hipStream_t stream) {
    fx::Args a; memset(&a, 0, sizeof(a)); fx::bind_io(a.p, d_in, (float*)d_out);
    const size_t f_need = fx::carve(a.p, d_ws);
    if (f_need > ws_size) { fprintf(stderr, "kernel_launch: workspace too small: need %zu have %zu\n", f_need, ws_size); return; }
    static int grid = 0;
    if (!grid) { int dev = 0, cus = 0, per_cu = 0; (void)hipGetDevice(&dev); (void)hipDeviceGetAttribute(&cus, hipDeviceAttributeMultiprocessorCount, dev);
        (void)hipFuncSetAttribute((const void*)fx::mega, hipFuncAttributeMaxDynamicSharedMemorySize, fx::LDS_BYTES);
        if (hipOccupancyMaxActiveBlocksPerMultiprocessor(&per_cu, (const void*)fx::mega, fx::NTHREADS, fx::LDS_BYTES) != hipSuccess || per_cu < 1) { fprintf(stderr, "kernel_launch: occupancy query says %d blocks per CU\n", per_cu); (void)hipGetLastError(); }
        grid = cus; }
    (void)hipMemsetAsync(a.p.ctl, 0, fx::CTL_BYTES, stream);
#if ONE_LAUNCH
    a.lo = 0; a.hi = fx::PH_COUNT; hipLaunchKernelGGL(fx::mega, dim3(grid), dim3(fx::NTHREADS), fx::LDS_BYTES, stream, a);
#else
    for (int k = 0; k < fx::PH_COUNT; ++k) { a.lo = k; a.hi = k + 1; hipLaunchKernelGGL(fx::mega, dim3(grid), dim3(fx::NTHREADS), fx::LDS_BYTES, stream, a); }
#endif
}
```

```cpp
#define PEER_SHARD2 1
#define ONE_LAUNCH 1
#include <hip/hip_runtime.h>
#include <cstdio>
#include <cstring>
#include <cmath>
#ifdef CPU_TEST
#define HD inline
constexpr int D_MODEL = 128, BATCH = 2, SEQ = 512, DEPTH = 2, DEC_BATCH = 3, DEC_SEQ = 1, PAST_LEN = 512, PAGE_SIZE = 128;
constexpr int DIL_W[3] = {16, 64, 256}, DIL_D[3] = {1, 4, 16}, DIL_TAPS = 17;
constexpr int MEM_TOKENS = 32, SLC_TOPK = 4, SWA_WINDOW = 64, PEER_KEYS = 16, PEER_TOPK = 4;
#else
#define HD __host__ __device__ __forceinline__
constexpr int D_MODEL = 1024, BATCH = 2, SEQ = 8192, DEPTH = 2, DEC_BATCH = 32, DEC_SEQ = 1, PAST_LEN = 8192, PAGE_SIZE = 128;
constexpr int DIL_W[3] = {128, 512, 2048}, DIL_D[3] = {1, 4, 16}, DIL_TAPS = 129;
constexpr int MEM_TOKENS = 256, SLC_TOPK = 16, SWA_WINDOW = 512, PEER_KEYS = 128, PEER_TOPK = 16;
#endif
HD constexpr int dil_w(int g) { return g == 0 ? DIL_W[0] : (g == 1 ? DIL_W[1] : DIL_W[2]); }
HD constexpr int dil_d(int g) { return g == 0 ? DIL_D[0] : (g == 1 ? DIL_D[1] : DIL_D[2]); }
constexpr int HEAD_DIM = 64, N_A_LAYERS = DEPTH / 2, N_DIL = 3, DIL_HEADS = 4, DIL_COLS = N_DIL * 3 * DIL_HEADS * HEAD_DIM;
constexpr int MEM_HEADS = 4, MEM_COLS = MEM_HEADS * HEAD_DIM;
constexpr int NSA_HEADS = 12, NSA_KV_HEADS = 2, NSA_GROUP = 6, NSA_Q_COLS = NSA_HEADS * HEAD_DIM, NSA_GATE_COLS = NSA_HEADS * 3;
constexpr int CMP_BLOCK = 32, CMP_STRIDE = 16, CMP_HIDDEN = 128, SLC_BLOCK = 64;
constexpr int PEER_EXPERTS = PEER_KEYS * PEER_KEYS, PEER_HEADS = 8, PEER_KEY_DIM = 128;
constexpr float FORCE_SCORE = 1.0e9f, NEG = -1.0e30f, SCALE = 0.125f, LN_EPS = 1e-5f;
constexpr float ALPHA = 1.41421356237309515f;
constexpr float BETA = 0.5f;
#define LAS __attribute__((address_space(3)))
namespace pg8 {
#define PG8_LAS __attribute__((address_space(3)))
typedef unsigned short bf16_t;
typedef short bf16x8 __attribute__((ext_vector_type(8)));
typedef float f32x4 __attribute__((ext_vector_type(4)));
typedef unsigned u32x4 __attribute__((ext_vector_type(4)));
constexpr int BM = 256, BK = 64, HALF = 128, HTB = HALF * BK * 2  , STAGE_BYTES = 8 * HTB, NXCD = 8, WGM = 8;

__host__ __device__ __forceinline__ int lds_byte(int r, int c) { const int st = (r >> 4) * 2 + (c >> 5), rr = r & 15, cc = c & 31, ob = rr * 64 + cc * 2; return st * 1024 + (ob ^ (((ob >> 9) & 1) << 5)); }
__host__ __device__ __forceinline__ void stage_rc(int b, int& R, int& C) { const int st = b / 1024, sb = b % 1024, swz = sb ^ (((sb >> 9) & 1) << 5); R = (st >> 1) * 16 + swz / 64; C = (st & 1) * 32 + (swz % 64) / 2; }
__host__ __device__ __forceinline__ int perm32(int rho) { const int n = rho >> 4, i = rho & 15; return 8 * (i >> 2) + 4 * n + (i & 3); }

struct Unit { int pm, pn; };
struct Gemm { const bf16_t* A; const bf16_t* Bt; int M, N, K; };

struct StaticOrder {
    int nM, nN, nwg, G, c;
    __host__ __device__ void init(int M, int N, int G_, int c_) { nM = M / BM; nN = N / BM; nwg = nM * nN; G = G_; c = c_; }
    __host__ __device__ bool next(int i, Unit& u) const {
        const long L = (long)i * G + c; if (L >= nwg) return false;
        int wgid = (int)L; { const int q = nwg / NXCD, r = nwg % NXCD, xcd = wgid % NXCD, off = wgid / NXCD; wgid = (xcd < r ? xcd * (q + 1) : r * (q + 1) + (xcd - r) * q) + off; }
        const int nig = WGM * nN, gid = wgid / nig, fm = gid * WGM, gsz = (nM - fm) < WGM ? (nM - fm) : WGM;
        u.pm = fm + ((wgid % nig) % gsz); u.pn = (wgid % nig) / gsz; return true;
    }
    __device__ __forceinline__ void a_ready(const Unit&) const {}
    __device__ __forceinline__ void done(const Unit&) const {}
};

__device__ __forceinline__ unsigned cvt_pk_bf16(float lo, float hi) { unsigned r; asm volatile("v_cvt_pk_bf16_f32 %0, %1, %2" : "=v"(r) : "v"(lo), "v"(hi)); return r; }
typedef float f32x2 __attribute__((ext_vector_type(2)));
typedef float f32x2 __attribute__((ext_vector_type(2)));
template <class Epi, class Sched, bool ALIGN_EPI = false, bool SP2 = false>
__device__ __forceinline__ void gemm_phase(PG8_LAS unsigned char* lds, const Gemm g, const Sched& S, const Epi& E) {
    const int tid = threadIdx.x, wid = __builtin_amdgcn_readfirstlane(tid >> 6), lane = tid & 63, wr = wid >> 2, wc = wid & 3, fr = lane & 15, fq = lane >> 4;
    const int K = g.K, nt = K / BK;
    unsigned voffA[2], voffB[2];
#pragma unroll
    for (int i = 0; i < 2; ++i) { int R, C; stage_rc(tid * 16 + i * 8192, R, C); const int Rb = Epi::PERM ? ((R & ~31) + perm32(R & 31)) : R;
        voffA[i] = (unsigned)(R * K + C) * 2u; voffB[i] = (unsigned)(Rb * K + C) * 2u; }
    const size_t kstep = (size_t)(BK * 2);
    const size_t hstep = (size_t)HALF * K * 2;
    const size_t tstep = 2 * hstep;
    const unsigned ldsw = (unsigned)wid * 1024u;
    const int aoff = lds_byte(wr * 64 + fr, fq * 8), boff = lds_byte(wc * 32 + fr, fq * 8);
#define PG8_SA(b, h) (((b) * 2 + (h)) * HTB)
#define PG8_SB(b, h) ((4 + (b) * 2 + (h)) * HTB)
#define PG8_STAGE(bufoff, gbase, voff) do { _Pragma("unroll") for (int _i = 0; _i < 2; ++_i) \
        __builtin_amdgcn_global_load_lds((const unsigned*)((const char*)(gbase) + (voff)[_i]), (PG8_LAS unsigned*)(lds + (bufoff) + ldsw + _i * 8192), 16, 0, 0); } while (0)
#define PG8_LDA(dst, b, h) do { _Pragma("unroll") for (int m = 0; m < 4; ++m) _Pragma("unroll") for (int k = 0; k < 2; ++k) dst[m][k] = *(const PG8_LAS bf16x8*)(lds + PG8_SA(b, h) + aoff + m * 2048 + k * 1024); } while (0)
#define PG8_LDB(dst, b, h) do { _Pragma("unroll") for (int n = 0; n < 2; ++n) _Pragma("unroll") for (int k = 0; k < 2; ++k) dst[n][k] = *(const PG8_LAS bf16x8*)(lds + PG8_SB(b, h) + boff + n * 2048 + k * 1024); } while (0)
#define PG8_MMA(ai, bj, At, Bt) do { __builtin_amdgcn_s_setprio(1); _Pragma("unroll") for (int m = 0; m < 4; ++m) _Pragma("unroll") for (int n = 0; n < 2; ++n) _Pragma("unroll") for (int k = 0; k < 2; ++k) \
        acc[ai][bj][m][n] = __builtin_amdgcn_mfma_f32_16x16x32_bf16(Bt[n][k], At[m][k], acc[ai][bj][m][n], 0, 0, 0); __builtin_amdgcn_s_setprio(0); } while (0)
#define PG8_WAIT_V(n) asm volatile("s_waitcnt vmcnt(" #n ")" ::: "memory")
#define PG8_WAIT_L(n) asm volatile("s_waitcnt lgkmcnt(" #n ")" ::: "memory")
#define PG8_BAR __builtin_amdgcn_s_barrier()
#define PG8_SCHED __builtin_amdgcn_sched_barrier(0)
    Unit cur, nxt; int ui = 0;
    if (!S.next(0, cur)) return;
    f32x4 acc[2][2][4][2];
#pragma unroll
    for (int a = 0; a < 2; ++a)
#pragma unroll
        for (int b = 0; b < 2; ++b)
#pragma unroll
            for (int m = 0; m < 4; ++m)
#pragma unroll
                for (int n = 0; n < 2; ++n) acc[a][b][m][n] = (f32x4){0.f, 0.f, 0.f, 0.f};
    bf16x8 At[4][2], B0[2][2], B1[2][2];
    const char* cA = (const char*)g.A + (size_t)cur.pm * tstep; const char* cB = (const char*)g.Bt + (size_t)cur.pn * tstep;
    S.a_ready(cur);
    if constexpr (SP2) {
        PG8_STAGE(PG8_SB(0, 0), cB, voffB); PG8_STAGE(PG8_SB(0, 1), cB + hstep, voffB); PG8_STAGE(PG8_SA(0, 0), cA, voffA); PG8_STAGE(PG8_SA(0, 1), cA + hstep, voffA);
        if (wr == 1) PG8_BAR;
        PG8_WAIT_V(2); PG8_BAR;
        PG8_STAGE(PG8_SB(1, 0), cB + kstep, voffB); PG8_STAGE(PG8_SA(1, 0), cA + kstep, voffA); PG8_STAGE(PG8_SB(1, 1), cB + hstep + kstep, voffB);
        PG8_WAIT_V(6); PG8_BAR;
    } else {
        PG8_STAGE(PG8_SB(0, 0), cB, voffB); PG8_STAGE(PG8_SA(0, 0), cA, voffA); PG8_STAGE(PG8_SB(0, 1), cB + hstep, voffB); PG8_STAGE(PG8_SA(0, 1), cA + hstep, voffA);
        if (wr == 1) PG8_BAR;
        PG8_WAIT_V(4); PG8_BAR;
        PG8_STAGE(PG8_SB(1, 0), cB + kstep, voffB); PG8_STAGE(PG8_SA(1, 0), cA + kstep, voffA); PG8_STAGE(PG8_SB(1, 1), cB + hstep + kstep, voffB);
        PG8_WAIT_V(6); PG8_BAR;
    }
    for (;;) {
        const bool has_next = S.next(ui + 1, nxt);
        const char* nA = has_next ? (const char*)g.A + (size_t)nxt.pm * tstep : cA; const char* nB = has_next ? (const char*)g.Bt + (size_t)nxt.pn * tstep : cB;
        for (int t = 0; t < nt; t += 2) {
            const bool last = (t == nt - 2);
            const char* a1 = cA + (size_t)(t + 1) * kstep;
            const char* a2 = last ? nA : cA + (size_t)(t + 2) * kstep; const char* b2 = last ? nB : cB + (size_t)(t + 2) * kstep;
            const char* a3 = a2 + kstep; const char* b3 = b2 + kstep;
            if (last && has_next) S.a_ready(nxt);
            if constexpr (SP2) {
            PG8_LDB(B0, 0, 0); PG8_LDB(B1, 0, 1); PG8_SCHED; PG8_LDA(At, 0, 0); PG8_STAGE(PG8_SA(1, 1), a1 + hstep, voffA);
            PG8_WAIT_V(8); PG8_WAIT_L(0); PG8_BAR; PG8_MMA(0, 0, At, B0); PG8_MMA(0, 1, At, B1); PG8_BAR; PG8_SCHED;
            PG8_LDA(At, 0, 1); PG8_STAGE(PG8_SB(0, 0), b2, voffB); PG8_STAGE(PG8_SB(0, 1), b2 + hstep, voffB); PG8_STAGE(PG8_SA(0, 0), a2, voffA);
            PG8_WAIT_V(8); PG8_WAIT_L(0); PG8_BAR; PG8_MMA(1, 0, At, B0); PG8_MMA(1, 1, At, B1); PG8_BAR; PG8_SCHED;
            PG8_LDB(B0, 1, 0); PG8_LDB(B1, 1, 1); PG8_SCHED; PG8_LDA(At, 1, 0); PG8_STAGE(PG8_SA(0, 1), a2 + hstep, voffA);
            PG8_WAIT_V(8); PG8_WAIT_L(0); PG8_BAR; PG8_MMA(0, 0, At, B0); PG8_MMA(0, 1, At, B1); PG8_BAR; PG8_SCHED;
            PG8_LDA(At, 1, 1); PG8_STAGE(PG8_SB(1, 0), b3, voffB); PG8_STAGE(PG8_SB(1, 1), b3 + hstep, voffB); PG8_STAGE(PG8_SA(1, 0), a3, voffA);
            PG8_WAIT_V(8); PG8_WAIT_L(0); PG8_BAR; PG8_MMA(1, 0, At, B0); PG8_MMA(1, 1, At, B1); PG8_BAR; PG8_SCHED;
            } else {
            PG8_LDB(B0, 0, 0); PG8_SCHED; PG8_LDA(At, 0, 0); PG8_STAGE(PG8_SA(1, 1), a1 + hstep, voffA);
            PG8_WAIT_L(8); PG8_BAR; PG8_WAIT_L(0); PG8_MMA(0, 0, At, B0); PG8_BAR; PG8_SCHED;
            PG8_LDB(B1, 0, 1); PG8_STAGE(PG8_SB(0, 0), b2, voffB);
            PG8_BAR; PG8_WAIT_L(0); PG8_MMA(0, 1, At, B1); PG8_BAR;
            PG8_LDA(At, 0, 1); PG8_STAGE(PG8_SA(0, 0), a2, voffA);
            PG8_BAR; PG8_WAIT_L(0); PG8_MMA(1, 0, At, B0); PG8_BAR; PG8_SCHED;
            PG8_STAGE(PG8_SB(0, 1), b2 + hstep, voffB);
            PG8_WAIT_V(6); PG8_BAR; PG8_MMA(1, 1, At, B1); PG8_BAR;
            PG8_LDB(B0, 1, 0); PG8_SCHED; PG8_LDA(At, 1, 0); PG8_STAGE(PG8_SA(0, 1), a2 + hstep, voffA);
            PG8_WAIT_L(8); PG8_BAR; PG8_WAIT_L(0); PG8_MMA(0, 0, At, B0); PG8_BAR; PG8_SCHED;
            PG8_LDB(B1, 1, 1); PG8_STAGE(PG8_SB(1, 0), b3, voffB);
            PG8_BAR; PG8_WAIT_L(0); PG8_MMA(0, 1, At, B1); PG8_BAR;
            PG8_LDA(At, 1, 1); PG8_STAGE(PG8_SA(1, 0), a3, voffA);
            PG8_BAR; PG8_WAIT_L(0); PG8_MMA(1, 0, At, B0); PG8_BAR; PG8_SCHED;
            PG8_STAGE(PG8_SB(1, 1), b3 + hstep, voffB);
            PG8_WAIT_V(6); PG8_BAR; PG8_MMA(1, 1, At, B1); PG8_BAR;
            }
        }
        if constexpr (ALIGN_EPI) { if (wr == 0) PG8_BAR; }
        if constexpr (!Epi::AFTER_DRAIN) { E(acc, cur, wr, wc, fr, fq); S.done(cur); }
        if (!has_next) break;
#pragma unroll
        for (int a = 0; a < 2; ++a)
#pragma unroll
            for (int b = 0; b < 2; ++b)
#pragma unroll
                for (int m = 0; m < 4; ++m)
#pragma unroll
                    for (int n = 0; n < 2; ++n) acc[a][b][m][n] = (f32x4){0.f, 0.f, 0.f, 0.f};
        cur = nxt; cA = nA; cB = nB; ++ui;
        if constexpr (ALIGN_EPI) { if (wr == 1) PG8_BAR; }
    }
    PG8_WAIT_V(0);
    if constexpr (!ALIGN_EPI) { if (wr == 0) PG8_BAR; }
    PG8_BAR;
    if constexpr (Epi::AFTER_DRAIN) { E.fused(acc, cur, wr, wc, fr, fq, lds, wid, lane); S.done(cur); }
#undef PG8_SA
#undef PG8_SB
#undef PG8_STAGE
#undef PG8_LDA
#undef PG8_LDB
#undef PG8_MMA
#undef PG8_WAIT_V
#undef PG8_WAIT_L
#undef PG8_BAR
#undef PG8_SCHED
}
}
#define XB_TMO      128
#define XB_XCNT(j)  (256  + 64 * (j))
#define XB_XSUB(j)  (1280 + 64 * (j))
#define XB_XGEN(j)  (2304 + 64 * (j))
#define XB_TOP      3328
#define XB_TOPGEN   3392
#define XCD_BAR_WORDS 3456
#define XB_SPIN_CAP (1u << 18)

__device__ __forceinline__ unsigned xb_ld(unsigned* p)              { return __hip_atomic_load(p, __ATOMIC_RELAXED, __HIP_MEMORY_SCOPE_AGENT); }
__device__ __forceinline__ unsigned xb_add(unsigned* p, unsigned v) { return __hip_atomic_fetch_add(p, v, __ATOMIC_RELAXED, __HIP_MEMORY_SCOPE_AGENT); }
__device__ __forceinline__ unsigned xb_xcc_id() { return (unsigned)__builtin_amdgcn_s_getreg((3 << 11) | 20) & 0xFu; }
#define XB_SPIN(cond, bar) do { unsigned _sp = 0; while (cond) { __builtin_amdgcn_s_sleep(1); \
    if ((++_sp & 255u) == 0u) { if (xb_ld(&(bar)[XB_TMO])) break; if (_sp > XB_SPIN_CAP) { atomicAdd(&(bar)[XB_TMO], 1u); break; } } } } while (0)

struct XcdBarrier {
    unsigned* bar; unsigned x;
    volatile LAS unsigned* st;
};

__device__ __forceinline__ XcdBarrier xcd_barrier_post(unsigned* bar, volatile LAS unsigned* st) {
    XcdBarrier b; b.bar = bar; b.x = xb_xcc_id(); b.st = st;
    if (threadIdx.x == 0) (void)xb_add(&bar[XB_XCNT(b.x)], 1u);
    return b;
}
__device__ __forceinline__ void xcd_barrier_complete(unsigned* bar, unsigned x, unsigned& nloc, unsigned& nx) {
    const unsigned G = gridDim.x * gridDim.y * gridDim.z;
    unsigned sum, cnt, mine, sp = 0u;
    for (;;) {
        sum = 0u; cnt = 0u; mine = 0u;
#pragma unroll
        for (unsigned j = 0; j < 16; ++j) { const unsigned c = xb_ld(&bar[XB_XCNT(j)]); sum += c; cnt += (c > 0u) ? 1u : 0u; mine = (j == x) ? c : mine; }
        if (sum == G) break;
        __builtin_amdgcn_s_sleep(1);
        if ((++sp & 255u) == 0u) { if (xb_ld(&bar[XB_TMO])) break; if (sp > XB_SPIN_CAP) { atomicAdd(&bar[XB_TMO], 1u); break; } }
    }
    nloc = mine > 0u ? mine : 1u; nx = cnt > 0u ? cnt : 1u;
}

__device__ __forceinline__ void xcd_barrier(const XcdBarrier& b) {
    asm volatile("s_waitcnt vmcnt(0)" ::: "memory");
    __syncthreads();
    if (threadIdx.x == 0) {
        unsigned* bar = b.bar;
        __builtin_amdgcn_s_waitcnt(0);
        unsigned nloc = b.st[0], nx = b.st[1];
        if (nloc == 0u) { xcd_barrier_complete(bar, b.x, nloc, nx); b.st[0] = nloc; b.st[1] = nx; }
        const unsigned old = xb_add(&bar[XB_XSUB(b.x)], 1u);
        const unsigned gen = old / nloc;
        if (old + 1u == (gen + 1u) * nloc) {
            __builtin_amdgcn_fence(__ATOMIC_RELEASE, "agent");
            asm volatile("s_waitcnt vmcnt(0)" ::: "memory");
            const unsigned og = xb_add(&bar[XB_TOP], 1u);
            const unsigned tg = og / nx;
            if (og + 1u == (tg + 1u) * nx) xb_add(&bar[XB_TOPGEN], 1u);
            else XB_SPIN(xb_ld(&bar[XB_TOPGEN]) == tg, bar);
            __builtin_amdgcn_fence(__ATOMIC_ACQUIRE, "agent");
            xb_add(&bar[XB_XGEN(b.x)], 1u);
            asm volatile("s_waitcnt vmcnt(0)" ::: "memory");
        } else {
            XB_SPIN(xb_ld(&bar[XB_XGEN(b.x)]) == gen, bar);
            __builtin_amdgcn_fence(__ATOMIC_ACQUIRE, "agent");
            asm volatile("s_waitcnt vmcnt(0)" ::: "memory");
        }
    }
    __syncthreads();
}
namespace fx {
#define DI __device__ __forceinline__
typedef unsigned short bf16;
typedef short bf16x8 __attribute__((ext_vector_type(8)));
typedef float f32x4 __attribute__((ext_vector_type(4)));
typedef float f32x2 __attribute__((ext_vector_type(2)));
typedef unsigned u32x4 __attribute__((ext_vector_type(4)));
typedef unsigned u32x2 __attribute__((ext_vector_type(2)));
constexpr int M0 = BATCH * SEQ, MP = M0 + DEC_BATCH, MPAD = ((MP + 255) / 256) * 256;
constexpr int ACOLS = DIL_COLS + MEM_COLS, BCOLS = NSA_Q_COLS + NSA_GATE_COLS + MEM_COLS, KVCOLS = 6 * NSA_KV_HEADS * HEAD_DIM;
constexpr int NB_T = 2048;
constexpr int NPK = PEER_HEADS * 2 * PEER_KEYS;
constexpr int NCMP = (SEQ - CMP_BLOCK) / CMP_STRIDE + 1;
constexpr int NCH = SEQ / CMP_STRIDE;
constexpr int NCTX = BATCH + DEC_BATCH;
constexpr int ACROWS = NCTX * NSA_KV_HEADS * NCH;
constexpr int NPOS = PAST_LEN + 1;
constexpr float QSCALE = 0.125f * 1.4426950408889634f;
constexpr int NTHREADS = 512, NWAVES = 8, LDS_BYTES = 147456, RING_BYTES = 131072, MISC_OFF = RING_BYTES + 320;

struct FP {
    const float *x_prompt, *x_sample, *mem_prompt, *cache_dil[3], *cache_nsa_kv, *cache_nsa_win, *cache_mem_kv; const int* page_table;
    const float *w_in_a, *w_out_a, *w_in_b, *w_out_b, *w_mem_kv, *w_kv_b, *cmp_pe, *cmp_w1, *cmp_w2, *ln_g, *ln_b, *peer_wq, *peer_keys, *peer_u, *peer_v;
    float *y_prompt, *y_sample, *dil_p[3], *dil_s[3], *nsa_kv_p, *nsa_kv_s, *win_p, *win_s, *mem_kv_p;
    unsigned* ctl;
    bf16 *XB0, *X1B, *X2B, *X3B, *WA_T, *WMEM_T, *MEMB, *WOA_T, *WOB_T, *WPK_T, *WB_T, *CW1_T, *AC; unsigned char *UB8, *VB8;
    float *ROPE, *CBIAS;
    bf16 *QA, *KA, *VTA, *MQA, *MK, *MVT, *ATTA;
    float *DPART, *DML, *PRE, *X1, *X2, *X3, *SCO, *SELG; int* SELE;
    bf16 *SLK, *SLVT, *WNK, *WNVT, *QB, *MQB, *CK, *CVT, *ATTB;
    float *GATES, *UL, *CKF, *CVF;
    int* SELB;
    float* DBG;
};
struct Args { FP p; int lo, hi; };
struct Carve { size_t off = 0; template <class T> T* take(void* base, size_t n) { T* r = (T*)((char*)base + off); off += ((n * sizeof(T) + 255) / 256) * 256; return r; } };
constexpr size_t CTL_BYTES = 65536;
inline size_t carve(FP& p, void* base) {
    Carve c;
    p.ctl = c.take<unsigned>(base, CTL_BYTES / 4);
    p.XB0 = c.take<bf16>(base, (size_t)MPAD * D_MODEL); p.X1B = c.take<bf16>(base, (size_t)MPAD * D_MODEL); p.X2B = c.take<bf16>(base, (size_t)MPAD * D_MODEL); p.X3B = c.take<bf16>(base, (size_t)MPAD * D_MODEL);
    p.WA_T = c.take<bf16>(base, (size_t)ACOLS * D_MODEL); p.WMEM_T = c.take<bf16>(base, (size_t)DEPTH * 2 * MEM_COLS * D_MODEL); p.MEMB = c.take<bf16>(base, (size_t)BATCH * MEM_TOKENS * D_MODEL);
    p.WOA_T = c.take<bf16>(base, (size_t)D_MODEL * 2 * MEM_COLS); p.WOB_T = c.take<bf16>(base, (size_t)D_MODEL * (NSA_Q_COLS + MEM_COLS));
    p.WPK_T = c.take<bf16>(base, (size_t)DEPTH * NPK * D_MODEL); p.WB_T = c.take<bf16>(base, (size_t)NB_T * D_MODEL);
    p.UB8 = c.take<unsigned char>(base, (size_t)DEPTH * PEER_EXPERTS * D_MODEL); p.VB8 = c.take<unsigned char>(base, (size_t)DEPTH * PEER_EXPERTS * D_MODEL);
    p.CW1_T = c.take<bf16>(base, (size_t)2 * 256 * 1024); p.AC = c.take<bf16>(base, (size_t)2 * ACROWS * 1024);
    p.ROPE = c.take<float>(base, (size_t)NPOS * 64); p.CBIAS = c.take<float>(base, 2 * CMP_HIDDEN);
    p.QA = c.take<bf16>(base, (size_t)3 * MPAD * 256); p.KA = c.take<bf16>(base, (size_t)3 * MPAD * 256); p.VTA = c.take<bf16>(base, (size_t)3 * BATCH * DIL_HEADS * HEAD_DIM * SEQ + 4096);
    p.MQA = c.take<bf16>(base, (size_t)MPAD * 256); p.MK = c.take<bf16>(base, (size_t)DEPTH * BATCH * MEM_TOKENS * MEM_COLS); p.MVT = c.take<bf16>(base, (size_t)DEPTH * BATCH * MEM_COLS * MEM_TOKENS);
    p.ATTA = c.take<bf16>(base, (size_t)MPAD * 2 * MEM_COLS);
    p.DPART = c.take<float>(base, (size_t)3 * MP * DIL_HEADS * HEAD_DIM); p.DML = c.take<float>(base, (size_t)3 * MP * DIL_HEADS * 2);
    p.PRE = c.take<float>(base, (size_t)MPAD * D_MODEL); p.X1 = c.take<float>(base, (size_t)MPAD * D_MODEL); p.X2 = c.take<float>(base, (size_t)MPAD * D_MODEL); p.X3 = c.take<float>(base, (size_t)MPAD * D_MODEL);
    p.SCO = c.take<float>(base, (size_t)MPAD * NPK); p.SELG = c.take<float>(base, (size_t)MP * 128); p.SELE = c.take<int>(base, (size_t)MP * 128);
    p.SLK = c.take<bf16>(base, (size_t)BATCH * NSA_KV_HEADS * SEQ * HEAD_DIM); p.SLVT = c.take<bf16>(base, (size_t)BATCH * NSA_KV_HEADS * SEQ * HEAD_DIM);
    p.WNK = c.take<bf16>(base, (size_t)BATCH * NSA_KV_HEADS * SEQ * HEAD_DIM + 4096); p.WNVT = c.take<bf16>(base, (size_t)BATCH * NSA_KV_HEADS * SEQ * HEAD_DIM + 4096);
    p.QB = c.take<bf16>(base, (size_t)MPAD * NSA_Q_COLS); p.MQB = c.take<bf16>(base, (size_t)MPAD * 256);
    p.CK = c.take<bf16>(base, (size_t)NCTX * NSA_KV_HEADS * NCH * HEAD_DIM); p.CVT = c.take<bf16>(base, (size_t)NCTX * NSA_KV_HEADS * HEAD_DIM * NCH); p.ATTB = c.take<bf16>(base, (size_t)MPAD * (NSA_Q_COLS + MEM_COLS));
    p.GATES = c.take<float>(base, (size_t)MPAD * 64); p.UL = c.take<float>(base, (size_t)2 * ACROWS * 256);
    p.CKF = c.take<float>(base, (size_t)DEC_BATCH * NSA_KV_HEADS * NCH * HEAD_DIM); p.CVF = c.take<float>(base, (size_t)DEC_BATCH * NSA_KV_HEADS * NCH * HEAD_DIM);
    p.SELB = c.take<int>(base, (size_t)MP * NSA_KV_HEADS * 16);
#ifdef NSA_DEBUG
    p.DBG = c.take<float>(base, (size_t)3 * MP * 768);
#else
    p.DBG = nullptr;
#endif
    return c.off;
}
inline void bind_io(FP& p, void* const* d_in, float* out) {
    p.x_prompt = (const float*)d_in[0]; p.x_sample = (const float*)d_in[1]; p.mem_prompt = (const float*)d_in[2]; p.cache_dil[0] = (const float*)d_in[3]; p.cache_dil[1] = (const float*)d_in[4]; p.cache_dil[2] = (const float*)d_in[5];
    p.cache_nsa_kv = (const float*)d_in[6]; p.cache_nsa_win = (const float*)d_in[7]; p.cache_mem_kv = (const float*)d_in[8]; p.page_table = (const int*)d_in[9];
    p.w_in_a = (const float*)d_in[10]; p.w_out_a = (const float*)d_in[11]; p.w_in_b = (const float*)d_in[12]; p.w_out_b = (const float*)d_in[13]; p.w_mem_kv = (const float*)d_in[14]; p.w_kv_b = (const float*)d_in[15];
    p.cmp_pe = (const float*)d_in[16]; p.cmp_w1 = (const float*)d_in[17]; p.cmp_w2 = (const float*)d_in[18]; p.ln_g = (const float*)d_in[19]; p.ln_b = (const float*)d_in[20];
    p.peer_wq = (const float*)d_in[21]; p.peer_keys = (const float*)d_in[22]; p.peer_u = (const float*)d_in[23]; p.peer_v = (const float*)d_in[24];
    size_t o = 0; auto take = [&](size_t n) { float* r = out + o; o += n; return r; };
    p.y_prompt = take((size_t)M0 * D_MODEL); p.y_sample = take((size_t)DEC_BATCH * D_MODEL);
    for (int g = 0; g < 3; ++g) p.dil_p[g] = take((size_t)BATCH * DIL_W[g] * 2 * DIL_HEADS * HEAD_DIM);
    for (int g = 0; g < 3; ++g) p.dil_s[g] = take((size_t)DEC_BATCH * DIL_W[g] * 2 * DIL_HEADS * HEAD_DIM);
    p.nsa_kv_p = take((size_t)M0 * 4 * NSA_KV_HEADS * HEAD_DIM); p.nsa_kv_s = take((size_t)DEC_BATCH * 4 * NSA_KV_HEADS * HEAD_DIM);
    p.win_p = take((size_t)BATCH * SWA_WINDOW * 2 * NSA_KV_HEADS * HEAD_DIM); p.win_s = take((size_t)DEC_BATCH * SWA_WINDOW * 2 * NSA_KV_HEADS * HEAD_DIM);
    p.mem_kv_p = take((size_t)DEPTH * BATCH * MEM_TOKENS * 2 * MEM_COLS);
}
DI unsigned f2bf(float f) { unsigned u = __builtin_bit_cast(unsigned, f); return (u + 0x7fffu + ((u >> 16) & 1u)) >> 16; }
DI unsigned pk2(float lo, float hi) { return f2bf(lo) | (f2bf(hi) << 16); }
DI float bf2f(unsigned short b) { return __builtin_bit_cast(float, (unsigned)b << 16); }
DI float bflo(unsigned w) { return __builtin_bit_cast(float, w << 16); }
DI float bfhi(unsigned w) { return __builtin_bit_cast(float, w & 0xffff0000u); }
template <int CTRL> DI float dpp1(float x) { return __builtin_bit_cast(float, __builtin_amdgcn_update_dpp(0, __builtin_bit_cast(int, x), CTRL, 0xF, 0xF, true)); }
DI float wave_sum(float v) { v += dpp1<0xB1>(v); v += dpp1<0x4E>(v); v += dpp1<0x141>(v); v += dpp1<0x140>(v);
    float a = v, b = v; asm volatile("s_nop 1\n\tv_permlane16_swap_b32 %0, %1" : "+v"(a), "+v"(b)); v = a + b; a = v; b = v;
    asm volatile("s_nop 1\n\tv_permlane32_swap_b32 %0, %1" : "+v"(a), "+v"(b)); return a + b; }
DI float wave_max(float v) { v = fmaxf(v, dpp1<0xB1>(v)); v = fmaxf(v, dpp1<0x4E>(v)); v = fmaxf(v, dpp1<0x141>(v)); v = fmaxf(v, dpp1<0x140>(v));
    float a = v, b = v; asm volatile("s_nop 1\n\tv_permlane16_swap_b32 %0, %1" : "+v"(a), "+v"(b)); v = fmaxf(a, b); a = v; b = v;
    asm volatile("s_nop 1\n\tv_permlane32_swap_b32 %0, %1" : "+v"(a), "+v"(b)); return fmaxf(a, b); }
DI float gelu_tanh(float x) { const float u = 0.7978845608028654f * (x + 0.044715f * x * x * x); const float e = __builtin_amdgcn_exp2f(u * 2.885390081777927f);   const float t = 1.0f - 2.0f / (e + 1.0f); return 0.5f * x * (1.0f + t); }
DI float* sel3(float* const (&a)[3], int g) { return g == 0 ? a[0] : (g == 1 ? a[1] : a[2]); }
DI const float* sel3c(const float* const (&a)[3], int g) { return g == 0 ? a[0] : (g == 1 ? a[1] : a[2]); }
__host__ DI size_t ktile_off(int t, int d) { const int blk = t >> 5, kk = t & 31, b = (kk >> 2) & 1, i = 4 * (kk >> 3) + (kk & 3), s = d >> 5, c = (d & 31) >> 3; return ((size_t)(blk * 4 + 2 * b + s) * 64 + i + 16 * c) * 8 + (d & 7); }
__host__ DI size_t vtile_off(int dim, int t) { const int blk = t >> 5, kk = t & 31; return ((size_t)(blk * 4 + (dim >> 4)) * 64 + (dim & 15) + 16 * (kk >> 3)) * 8 + (kk & 7); }
struct Ctx { LAS unsigned char* lds; int tid, lane, wave, vcu, G; };
DI int row_pos(int r) { return r < M0 ? (r & (SEQ - 1)) : PAST_LEN; }

struct ColSrc { const float* p; int ld; };
DI int rope_il(int e) { return (e >> 1) + 32 * (e & 1); }
DI ColSrc col_wa(const FP& P, int n) {
    const int t = n >> 8, ct = n & 255, h = ct >> 6, e = ct & 63; if (t >= 9) return ColSrc{P.w_in_a + DIL_COLS + ct, ACOLS};
    const int j = t % 3, d = (j < 2) ? rope_il(e) : e; return ColSrc{P.w_in_a + t * 256 + h * 64 + d, ACOLS}; }
DI ColSrc col_wb(const FP& P, int n) {
    const int t = n >> 8, ct = n & 255, e = ct & 63;
    if (t < 3) { const int ty = 2 * t + (ct >> 7), kvh = (ct >> 6) & 1; const bool rot = (ty == 2 || ty == 4); return ColSrc{P.w_kv_b + (ty * NSA_KV_HEADS + kvh) * 64 + (rot ? rope_il(e) : e), KVCOLS}; }
    if (t < 6) { const int h = (t - 3) * 4 + (ct >> 6); return ColSrc{P.w_in_b + h * 64 + rope_il(e), BCOLS}; }
    if (t == 6) return ColSrc{P.w_in_b + NSA_Q_COLS + NSA_GATE_COLS + ct, BCOLS};
    if (ct < NSA_GATE_COLS) return ColSrc{P.w_in_b + NSA_Q_COLS + ct, BCOLS};
    return ColSrc{nullptr, 0}; }
DI ColSrc col_wmem(const FP& P, int n) { const int l = n >> 9, c = n & 511; return ColSrc{P.w_mem_kv + (size_t)l * D_MODEL * 512 + c, 512}; }
DI ColSrc col_woa(const FP& P, int n) { return ColSrc{P.w_out_a + n, D_MODEL}; }
DI ColSrc col_wob(const FP& P, int n) { return ColSrc{P.w_out_b + n, D_MODEL}; }
DI ColSrc col_cw1(const FP& P, int n) {
    const int ty = n >> 8, half = (n >> 7) & 1, hid = n & 127; return ColSrc{P.cmp_w1 + (size_t)ty * CMP_BLOCK * HEAD_DIM * CMP_HIDDEN + (size_t)half * 16 * HEAD_DIM * CMP_HIDDEN + hid, CMP_HIDDEN}; }
template <class CF> DI void transpose_item(const FP& P, CF cf, int K, bf16* WT, LAS float* scr, int item, int nblk, int lane) {
    const int kb = item / nblk, nb = item % nblk, k0 = 64 * kb, n0 = 32 * nb;
    const ColSrc cs = cf(P, n0 + (lane & 31));
#pragma unroll 8
    for (int i = 0; i < 32; ++i) { const int kk = 2 * i + (lane >> 5); scr[kk * 33 + (lane & 31)] = cs.p ? cs.p[(size_t)(k0 + kk) * cs.ld] : 0.f; }
    asm volatile("s_waitcnt lgkmcnt(0)" ::: "memory");
    const int c = lane & 7;
#pragma unroll
    for (int j = 0; j < 4; ++j) { const int n = (lane >> 3) + 8 * j; const LAS float* s = scr + (8 * c) * 33 + n;
        u32x4 o; o.x = pk2(s[0 * 33], s[1 * 33]); o.y = pk2(s[2 * 33], s[3 * 33]); o.z = pk2(s[4 * 33], s[5 * 33]); o.w = pk2(s[6 * 33], s[7 * 33]);
        *(u32x4*)(WT + (size_t)(n0 + n) * K + k0 + 8 * c) = o; }
    asm volatile("s_waitcnt lgkmcnt(0)" ::: "memory");
}
DI void cvt_row1024(const float* src, bf16* dst, int lane) {
#pragma unroll
    for (int j = 0; j < 4; ++j) { f32x4 v = src ? *(const f32x4*)(src + 256 * j + 4 * lane) : (f32x4){0.f, 0.f, 0.f, 0.f}; u32x2 o; o.x = pk2(v.x, v.y); o.y = pk2(v.z, v.w); *(u32x2*)(dst + 256 * j + 4 * lane) = o; }
}
DI void cvt_row1024_fp8(const float* src, unsigned char* dst, float sc, int lane) { u32x4 o; unsigned w[4];
#pragma unroll
    for (int j = 0; j < 4; ++j) { const f32x4 v = *(const f32x4*)(src + 16 * lane + 4 * j) * sc; int t = __builtin_amdgcn_cvt_pk_fp8_f32(v.x, v.y, 0, false); t = __builtin_amdgcn_cvt_pk_fp8_f32(v.z, v.w, t, true); w[j] = (unsigned)t; }
    o.x = w[0]; o.y = w[1]; o.z = w[2]; o.w = w[3]; *(u32x4*)(dst + 16 * lane) = o; }
DI void p0_prologue(const FP& P, const Ctx& C) {
    LAS float* scr = (LAS float*)(C.lds + C.wave * 16384);
    const int gw = C.vcu * NWAVES + C.wave, NGW = C.G * NWAVES, lane = C.lane;
    { constexpr int IA = (D_MODEL / 64) * (ACOLS / 32), IM = (D_MODEL / 64) * (1024 / 32), IOA = (512 / 64) * (D_MODEL / 32), IOB = (1024 / 64) * (D_MODEL / 32), IB = (D_MODEL / 64) * (NB_T / 32), IC = (1024 / 64) * (512 / 32);
      constexpr int NIT = IA + IM + IOA + IOB + IB + IC;
      for (int it = gw; it < NIT; it += NGW) { int r = it;
          if (r < IA) { transpose_item(P, col_wa, D_MODEL, P.WA_T, scr, r, ACOLS / 32, lane); continue; } r -= IA;
          if (r < IM) { transpose_item(P, col_wmem, D_MODEL, P.WMEM_T, scr, r, 1024 / 32, lane); continue; } r -= IM;
          if (r < IOA) { transpose_item(P, col_woa, 512, P.WOA_T, scr, r, D_MODEL / 32, lane); continue; } r -= IOA;
          if (r < IOB) { transpose_item(P, col_wob, 1024, P.WOB_T, scr, r, D_MODEL / 32, lane); continue; } r -= IOB;
          if (r < IB) { transpose_item(P, col_wb, D_MODEL, P.WB_T, scr, r, NB_T / 32, lane); continue; } r -= IB;
          transpose_item(P, col_cw1, 1024, P.CW1_T, scr, r, 512 / 32, lane); } }
    for (int r = gw; r < MPAD; r += NGW) { cvt_row1024(r < M0 ? P.x_prompt + (size_t)r * D_MODEL : (r < MP ? P.x_sample + (size_t)(r - M0) * D_MODEL : nullptr), P.XB0 + (size_t)r * D_MODEL, lane);
        if (r >= MP) { cvt_row1024(nullptr, P.X1B + (size_t)r * D_MODEL, lane); cvt_row1024(nullptr, P.X2B + (size_t)r * D_MODEL, lane); cvt_row1024(nullptr, P.X3B + (size_t)r * D_MODEL, lane);
            for (int c = lane; c < 512; c += 64) { P.ATTA[(size_t)r * 512 + c] = 0; P.ATTB[(size_t)r * 1024 + c] = 0; P.ATTB[(size_t)r * 1024 + 512 + c] = 0; } } }
    for (int r = gw; r < BATCH * MEM_TOKENS; r += NGW) cvt_row1024(P.mem_prompt + (size_t)r * D_MODEL, P.MEMB + (size_t)r * D_MODEL, lane);
#pragma unroll 1
    for (int r = 2 * gw; r < DEPTH * PEER_EXPERTS; r += 2 * NGW) { f32x4 a[16];
#pragma unroll
        for (int q = 0; q < 4; ++q) { const float* s0 = (q < 2 ? P.peer_u : P.peer_v) + (size_t)(r + (q & 1)) * D_MODEL + 16 * lane;
#pragma unroll
            for (int j = 0; j < 4; ++j) a[4 * q + j] = *(const f32x4*)(s0 + 4 * j); }
#pragma unroll
        for (int q = 0; q < 4; ++q) { const float sc = q < 2 ? 256.f : 64.f; unsigned w[4];
#pragma unroll
            for (int j = 0; j < 4; ++j) { const f32x4 v = a[4 * q + j] * sc; int t = __builtin_amdgcn_cvt_pk_fp8_f32(v.x, v.y, 0, false); t = __builtin_amdgcn_cvt_pk_fp8_f32(v.z, v.w, t, true); w[j] = (unsigned)t; }
            u32x4 o; o.x = w[0]; o.y = w[1]; o.z = w[2]; o.w = w[3]; *(u32x4*)((q < 2 ? P.UB8 : P.VB8) + (size_t)(r + (q & 1)) * D_MODEL + 16 * lane) = o; } }
    for (int i = gw * 64 + lane; i < NPOS * 32; i += NGW * 64) { const int pos = i >> 5, d = i & 31; const double inv = exp2(-(double)d * (13.287712379549449 / 32.0)); const double turns = (double)pos * inv * 0.15915494309189535;
        const float fr = (float)(turns - floor(turns)); P.ROPE[pos * 64 + d] = __builtin_amdgcn_cosf(fr); P.ROPE[pos * 64 + 32 + d] = __builtin_amdgcn_sinf(fr); }
    const int gwT = C.wave * C.G + C.vcu;
    for (int i = gwT; i < 2 * CMP_HIDDEN; i += NGW) { const int ty = i / CMP_HIDDEN, hid = i % CMP_HIDDEN; float a = 0.f;
#pragma unroll 8
        for (int k = lane; k < CMP_BLOCK * HEAD_DIM; k += 64) a += P.cmp_pe[ty * CMP_BLOCK * HEAD_DIM + k] * P.cmp_w1[((size_t)ty * CMP_BLOCK * HEAD_DIM + k) * CMP_HIDDEN + hid];
        a = wave_sum(a); if (lane == 0) P.CBIAS[i] = a; }
    for (int it2 = gwT; it2 < DEC_BATCH * (PAST_LEN / PAGE_SIZE) * (PAGE_SIZE / 8); it2 += NGW) { const int it = it2 / (PAGE_SIZE / 8), rg = it2 % (PAGE_SIZE / 8);
        const int n = it / (PAST_LEN / PAGE_SIZE), pi = it % (PAST_LEN / PAGE_SIZE); const int pg = P.page_table[it];
        const float* src = P.cache_nsa_kv + (size_t)pg * PAGE_SIZE * 512 + 4 * lane; const int ty = lane >> 5, kvh = (lane >> 4) & 1, d = (4 * lane) & 63;
        bf16* dst = P.AC + ((size_t)ty * ACROWS + ((size_t)(BATCH + n) * NSA_KV_HEADS + kvh) * NCH + pi * (PAGE_SIZE / 16)) * 1024 + d;
        { const int r0 = rg * 8; f32x4 v[8];
#pragma unroll
            for (int u = 0; u < 8; ++u) v[u] = *(const f32x4*)(src + (size_t)(r0 + u) * 512);
#pragma unroll
            for (int u = 0; u < 8; ++u) { const int t = r0 + u; u32x2 o; o.x = pk2(v[u].x, v[u].y); o.y = pk2(v[u].z, v[u].w); *(u32x2*)(dst + (size_t)(t / 16) * 1024 + (t % 16) * 64) = o; } } }
    for (int g = 0; g < 4; ++g) { const int W = g < 3 ? dil_w(g) : SWA_WINDOW, RV = g < 3 ? 128 : 64;
        const f32x4* src = (const f32x4*)(g < 3 ? sel3c(P.cache_dil, g) : P.cache_nsa_win); f32x4* dst = (f32x4*)(g < 3 ? sel3(P.dil_s, g) : P.win_s);
        const int per = (W - 1) * RV, nvec = DEC_BATCH * per;
#pragma unroll 1
        for (int i0 = gw * 512; i0 < nvec; i0 += NGW * 512) { f32x4 v[8]; int idx[8];
            const int n0 = __builtin_amdgcn_readfirstlane((int)((unsigned)i0 / (unsigned)per)), o0 = i0 - n0 * per;
#pragma unroll
            for (int u = 0; u < 8; ++u) { int o = o0 + u * 64 + lane, n = n0; if (o >= per) { o -= per; ++n; } if (n >= DEC_BATCH) { n = DEC_BATCH - 1; o = per - 1; } idx[u] = n * (per + RV) + o; v[u] = src[(size_t)idx[u] + RV]; }
#pragma unroll
            for (int u = 0; u < 8; ++u) { const int i = i0 + u * 64 + lane; if (i < nvec) dst[(size_t)idx[u]] = v[u]; } } }
}
DI void p0_wpk(const FP& P, const Ctx& C) {
    LAS float* sw = (LAS float*)C.lds;
    LAS float* sk = (LAS float*)(C.lds + 32768);
    constexpr int NIT = DEPTH * 16 * (D_MODEL / 64);
    for (int it = C.vcu; it < NIT; it += C.G) { const int l = it / (16 * (D_MODEL / 64)), rem = it % (16 * (D_MODEL / 64)), hc = rem / (D_MODEL / 64), kb = rem % (D_MODEL / 64);
        __syncthreads();
        for (int i = C.tid; i < 64 * 64; i += NTHREADS) { const int r = i >> 6, d = i & 63; sw[r * 65 + d] = P.peer_wq[((size_t)l * D_MODEL + kb * 64 + r) * 1024 + hc * 64 + d]; }
        for (int i = C.tid; i < 128 * 64; i += NTHREADS) { const int r = i >> 6, d = i & 63; sk[r * 68 + d] = P.peer_keys[(((size_t)l * 16 + hc) * PEER_KEYS + r) * 64 + d]; }
        __syncthreads();
        { const int ki = C.lane, kk0 = C.wave; float a[16];
#pragma unroll
          for (int j = 0; j < 16; ++j) a[j] = 0.f;
#pragma unroll 2
          for (int d = 0; d < 64; d += 4) { const float w0 = sw[ki * 65 + d], w1 = sw[ki * 65 + d + 1], w2 = sw[ki * 65 + d + 2], w3 = sw[ki * 65 + d + 3];
#pragma unroll
              for (int j = 0; j < 16; ++j) { const f32x4 kq = *(const LAS f32x4*)(sk + (kk0 + 8 * j) * 68 + d); a[j] += w0 * kq.x + w1 * kq.y + w2 * kq.z + w3 * kq.w; } }
#pragma unroll
          for (int j = 0; j < 16; ++j) P.WPK_T[((size_t)l * NPK + hc * 128 + kk0 + 8 * j) * D_MODEL + kb * 64 + ki] = (bf16)f2bf(a[j]); } }
    __syncthreads();
}

#define EPI_LOOP(...) int fr_l = fr, fq_l = fq; asm volatile("" : "+v"(fr_l), "+v"(fq_l));     \
    _Pragma("unroll") for (int ai = 0; ai < 2; ++ai) _Pragma("unroll") for (int m = 0; m < 4; ++m) { const int row = u.pm * 256 + ai * 128 + wr * 64 + m * 16 + fr_l; \
    _Pragma("unroll") for (int bj = 0; bj < 2; ++bj) { const int ct = bj * 128 + wc * 32 + fq_l * 8; const f32x4 v0 = acc[ai][bj][m][0], v1 = acc[ai][bj][m][1]; __VA_ARGS__ } asm volatile("" ::: "memory"); }
DI void rope4(const float* rope_row, int dp, const f32x4& v0, const f32x4& v1, f32x4& lo, f32x4& hi) {
    const f32x4 c = *(const f32x4*)(rope_row + dp), s = *(const f32x4*)(rope_row + 32 + dp);
    lo.x = v0.x * c.x - v0.y * s.x; hi.x = v0.y * c.x + v0.x * s.x; lo.y = v0.z * c.y - v0.w * s.y; hi.y = v0.w * c.y + v0.z * s.y;
    lo.z = v1.x * c.z - v1.y * s.z; hi.z = v1.y * c.z + v1.x * s.z; lo.w = v1.z * c.w - v1.w * s.w; hi.w = v1.w * c.w + v1.z * s.w; }
DI u32x2 pk4(const f32x4& v) { u32x2 o; o.x = pk2(v.x, v.y); o.y = pk2(v.z, v.w); return o; }
DI u32x4 pk8(const f32x4& a, const f32x4& b) { u32x4 o; o.x = pk2(a.x, a.y); o.y = pk2(a.z, a.w); o.z = pk2(b.x, b.y); o.w = pk2(b.z, b.w); return o; }
DI int dil_perm(int t, int d) { return (t % d) * (SEQ / d) + t / d; }
struct EpiA {
    static constexpr bool PERM = true, AFTER_DRAIN = false; const FP& P;
    DI void operator()(const f32x4 (&acc)[2][2][4][2], const pg8::Unit& u, int wr, int wc, int fr, int fq) const {
        const int t9 = u.pn; const int g = t9 / 3, j = t9 % 3;
        EPI_LOOP({ if (row < MP) { const int h = ct >> 6, e = ct & 63; const int pos = row_pos(row);
            if (t9 == 9) { *(u32x4*)(P.MQA + (size_t)row * 256 + ct) = pk8(v0 * QSCALE, v1 * QSCALE); }
            else if (j < 2) { f32x4 lo, hi; const int dp = e >> 1; rope4(P.ROPE + pos * 64, dp, v0, v1, lo, hi);
                if (j == 0) { bf16* q = P.QA + ((size_t)g * MPAD + row) * 256 + h * 64 + dp; *(u32x2*)q = pk4(lo * QSCALE); *(u32x2*)(q + 32) = pk4(hi * QSCALE); }
                else { if (row < M0) { bf16* kt = P.KA + ((size_t)(g * BATCH + row / SEQ) * DIL_HEADS + h) * 64 * SEQ; const int cm = dil_perm(pos, dil_d(g)); *(u32x2*)(kt + ktile_off(cm, dp)) = pk4(lo); *(u32x2*)(kt + ktile_off(cm, dp + 32)) = pk4(hi); }
                    const int W = dil_w(g); float* o = nullptr;
                    if (row >= M0) o = sel3(P.dil_s, g) + (((size_t)(row - M0) * W + W - 1) * 2 + 0) * 256; else if (pos >= SEQ - W) o = sel3(P.dil_p, g) + (((size_t)(row / SEQ) * W + pos - (SEQ - W)) * 2 + 0) * 256;
                    if (o) { *(f32x4*)(o + h * 64 + dp) = lo; *(f32x4*)(o + h * 64 + 32 + dp) = hi; } } }
            else { const int W = dil_w(g), d = dil_d(g); float* o = nullptr;
                if (row >= M0) o = sel3(P.dil_s, g) + (((size_t)(row - M0) * W + W - 1) * 2 + 1) * 256; else if (pos >= SEQ - W) o = sel3(P.dil_p, g) + (((size_t)(row / SEQ) * W + pos - (SEQ - W)) * 2 + 1) * 256;
                if (o) { *(f32x4*)(o + ct) = v0; *(f32x4*)(o + ct + 4) = v1; }
                if (row < M0) { bf16* vt = P.VTA + ((size_t)(g * BATCH + row / SEQ) * DIL_HEADS + h) * 64 * SEQ + vtile_off(e, dil_perm(pos, d));
                    vt[0] = (bf16)f2bf(v0.x); vt[8] = (bf16)f2bf(v0.y); vt[16] = (bf16)f2bf(v0.z); vt[24] = (bf16)f2bf(v0.w); vt[32] = (bf16)f2bf(v1.x); vt[40] = (bf16)f2bf(v1.y); vt[48] = (bf16)f2bf(v1.z); vt[56] = (bf16)f2bf(v1.w); } } } })
    }
};
struct EpiMem {
    static constexpr bool PERM = true, AFTER_DRAIN = false; const FP& P;
    DI void operator()(const f32x4 (&acc)[2][2][4][2], const pg8::Unit& u, int wr, int wc, int fr, int fq) const {
        const int l = u.pn >> 1, half = u.pn & 1;
        EPI_LOOP({ const int n = row / MEM_TOKENS, mt = row % MEM_TOKENS; float* o = P.mem_kv_p + (((size_t)l * BATCH + n) * MEM_TOKENS + mt) * 512 + half * 256 + ct; *(f32x4*)o = v0; *(f32x4*)(o + 4) = v1;
            if (half == 0) *(u32x4*)(P.MK + (((size_t)l * BATCH + n) * MEM_HEADS + (ct >> 6)) * MEM_TOKENS * 64 + ktile_off(mt, ct & 63)) = pk8(v0, v1);
            else { bf16* vt = P.MVT + (((size_t)l * BATCH + n) * MEM_HEADS + (ct >> 6)) * MEM_TOKENS * 64 + vtile_off(ct & 63, mt);
                vt[0] = (bf16)f2bf(v0.x); vt[8] = (bf16)f2bf(v0.y); vt[16] = (bf16)f2bf(v0.z); vt[24] = (bf16)f2bf(v0.w); vt[32] = (bf16)f2bf(v1.x); vt[40] = (bf16)f2bf(v1.y); vt[48] = (bf16)f2bf(v1.z); vt[56] = (bf16)f2bf(v1.w); } })
    }
};
struct EpiPre {
    static constexpr bool PERM = true, AFTER_DRAIN = false; const float* xa; const float* xb; float* pre;
    DI void operator()(const f32x4 (&acc)[2][2][4][2], const pg8::Unit& u, int wr, int wc, int fr, int fq) const {
        EPI_LOOP({ if (row < MP) { const int col = u.pn * 256 + ct; const float* x = (xb && row >= M0) ? xb + (size_t)(row - M0) * D_MODEL + col : xa + (size_t)row * D_MODEL + col;
            const f32x4 a = *(const f32x4*)x, b = *(const f32x4*)(x + 4); float* o = pre + (size_t)row * D_MODEL + col; *(f32x4*)o = a * ALPHA + v0; *(f32x4*)(o + 4) = b * ALPHA + v1; } })
    }
};
struct EpiF32 {
    static constexpr bool PERM = true, AFTER_DRAIN = false; float* out; int ldc; int nrows;
    DI void operator()(const f32x4 (&acc)[2][2][4][2], const pg8::Unit& u, int wr, int wc, int fr, int fq) const {
        EPI_LOOP({ if (row < nrows) { float* o = out + (size_t)row * ldc + u.pn * 256 + ct; *(f32x4*)o = v0; *(f32x4*)(o + 4) = v1; } })
    }
};
}
namespace fx {
struct Tile16 { f32x4 o[4]; float m, l; };
DI void tile_init(Tile16& T) { T.o[0] = T.o[1] = T.o[2] = T.o[3] = (f32x4){0.f, 0.f, 0.f, 0.f}; T.m = -INFINITY; T.l = 0.f; }
typedef __bf16 bf16x2_t __attribute__((ext_vector_type(2)));
DI unsigned cvtpk(float lo, float hi) { const f32x2 v = {lo, hi}; const bf16x2_t b = __builtin_convertvector(v, bf16x2_t); return __builtin_bit_cast(unsigned, b); }
struct KV8 { bf16x8 ka0, ka1, kb0, kb1, v0, v1, v2, v3; };
DI void kv_load(KV8& r, const bf16* k0, const bf16* k1, const bf16* v, long vs16) {
    r.ka0 = *(const bf16x8*)k0; r.ka1 = *(const bf16x8*)(k0 + 32); r.kb0 = *(const bf16x8*)k1; r.kb1 = *(const bf16x8*)(k1 + 32);
    r.v0 = *(const bf16x8*)v; r.v1 = *(const bf16x8*)(v + vs16); r.v2 = *(const bf16x8*)(v + 2 * vs16); r.v3 = *(const bf16x8*)(v + 3 * vs16); }
DI void mk_range(int a, int b, bool ok, int& lo, unsigned& rng) { const bool v = ok && b >= a; lo = v ? a : (1 << 20); rng = v ? (unsigned)(b - a) : 0u; }
DI float colmax(float x) { float a = x, b = x; asm volatile("s_nop 1\n\tv_permlane32_swap_b32 %0, %1" : "+v"(a), "+v"(b)); float m = fmaxf(a, b); a = m; b = m;
    asm volatile("s_nop 1\n\tv_permlane16_swap_b32 %0, %1" : "+v"(a), "+v"(b)); return fmaxf(a, b); }
DI float colsum(float x) { float a = x, b = x; asm volatile("s_nop 1\n\tv_permlane32_swap_b32 %0, %1" : "+v"(a), "+v"(b)); float m = a + b; a = m; b = m;
    asm volatile("s_nop 1\n\tv_permlane16_swap_b32 %0, %1" : "+v"(a), "+v"(b)); return a + b; }
DI void tile_compute(Tile16& T, const bf16x8 (&qf)[2], const KV8& r, int lo, unsigned rng) {
    f32x4 s0 = (f32x4){0.f, 0.f, 0.f, 0.f}, s1 = (f32x4){0.f, 0.f, 0.f, 0.f};
    s0 = __builtin_amdgcn_mfma_f32_16x16x32_bf16(r.ka0, qf[0], s0, 0, 0, 0); s0 = __builtin_amdgcn_mfma_f32_16x16x32_bf16(r.ka1, qf[1], s0, 0, 0, 0);
    s1 = __builtin_amdgcn_mfma_f32_16x16x32_bf16(r.kb0, qf[0], s1, 0, 0, 0); s1 = __builtin_amdgcn_mfma_f32_16x16x32_bf16(r.kb1, qf[1], s1, 0, 0, 0);
    float s[8] = {s0.x, s0.y, s0.z, s0.w, s1.x, s1.y, s1.z, s1.w};
    float mx = -INFINITY;
#pragma unroll
    for (int e = 0; e < 8; ++e) { s[e] = ((unsigned)(e - lo) <= rng) ? s[e] : -INFINITY; mx = fmaxf(mx, s[e]); }
    mx = colmax(mx);
    const float mnew = fmaxf(T.m, mx), muse = (mnew == -INFINITY) ? 0.f : mnew;
    const float alpha = __builtin_amdgcn_exp2f(T.m - muse);
    float ls = 0.f;
#pragma unroll
    for (int e = 0; e < 8; ++e) { s[e] = __builtin_amdgcn_exp2f(s[e] - muse); ls += s[e]; }
    T.l = T.l * alpha + ls; T.m = mnew;
    u32x4 pw; pw.x = cvtpk(s[0], s[1]); pw.y = cvtpk(s[2], s[3]); pw.z = cvtpk(s[4], s[5]); pw.w = cvtpk(s[6], s[7]);
    const bf16x8 pf = __builtin_bit_cast(bf16x8, pw);
    T.o[0] = __builtin_amdgcn_mfma_f32_16x16x32_bf16(r.v0, pf, T.o[0] * alpha, 0, 0, 0); T.o[1] = __builtin_amdgcn_mfma_f32_16x16x32_bf16(r.v1, pf, T.o[1] * alpha, 0, 0, 0);
    T.o[2] = __builtin_amdgcn_mfma_f32_16x16x32_bf16(r.v2, pf, T.o[2] * alpha, 0, 0, 0); T.o[3] = __builtin_amdgcn_mfma_f32_16x16x32_bf16(r.v3, pf, T.o[3] * alpha, 0, 0, 0);
}
template <class BUF, class LD, class CP> DI void pipe2t(int n, LD ld, CP cp) { if (n <= 0) return; BUF A, B; ld(A, 0);
#pragma unroll 1
    for (int i = 0; i < n; i += 2) { ld(B, (i + 1 < n) ? i + 1 : i); cp(A, i); ld(A, (i + 2 < n) ? i + 2 : i); if (i + 1 < n) cp(B, i + 1); } }
template <class LD, class CP> DI void pipe2(int n, LD ld, CP cp) { if (n <= 0) return; KV8 A, B; ld(A, 0);
#pragma unroll 1
    for (int i = 0; i < n; i += 2) { ld(B, (i + 1 < n) ? i + 1 : i); cp(A, i); ld(A, (i + 2 < n) ? i + 2 : i); if (i + 1 < n) cp(B, i + 1); } }
DI void kv_load_t(KV8& r, const bf16* kt, const bf16* vt, int lane) {
    const bf16* k = kt + lane * 8; const bf16* v = vt + lane * 8;
    r.ka0 = *(const bf16x8*)k; r.ka1 = *(const bf16x8*)(k + 512); r.kb0 = *(const bf16x8*)(k + 1024); r.kb1 = *(const bf16x8*)(k + 1536);
    r.v0 = *(const bf16x8*)v; r.v1 = *(const bf16x8*)(v + 512); r.v2 = *(const bf16x8*)(v + 1024); r.v3 = *(const bf16x8*)(v + 1536); }
DI int krow_of(int i, int b) { return 8 * (i >> 2) + 4 * b + (i & 3); }

DI void dil_micro(const FP& P, int n, int h, int t0, int mt, int lane) {
    const int g = mt >> 4, idx = mt & 15, d = dil_d(g), per = 16 / d;
    const int r = idx / per, sub = idx % per, i0 = t0 / d + 16 * sub, ib = i0 - 128, NC = SEQ / d;
    const int q = lane & 15, c = lane >> 4;
    const bf16* Qb = P.QA + ((size_t)g * MPAD + (size_t)n * SEQ) * 256 + h * 64;
    const bf16* Kb = P.KA + ((size_t)(g * BATCH + n) * DIL_HEADS + h) * 64 * SEQ + (size_t)r * NC * 64; const bf16* Vb = P.VTA + ((size_t)(g * BATCH + n) * DIL_HEADS + h) * 64 * SEQ + (size_t)r * NC * 64;
    bf16x8 qf[2]; { const bf16* qp = Qb + (size_t)(r + d * (i0 + q)) * 256 + 8 * c; qf[0] = *(const bf16x8*)qp; qf[1] = *(const bf16x8*)(qp + 32); }
    Tile16 T; tile_init(T);
    const int qi = i0 + q; const int tb0 = ib >> 5  , nblk = ((i0 + 15) >> 5) - tb0 + 1;
    pipe2(nblk, [&](KV8& kv, int i) { int tb = tb0 + i; tb = tb < 0 ? 0 : tb; kv_load_t(kv, Kb + (size_t)tb * 2048, Vb + (size_t)tb * 2048, lane); },
          [&](const KV8& kv, int i) { const int k0 = 32 * (tb0 + i) + 8 * c; int lo; unsigned rng; const int a = qi - (DIL_TAPS - 1); mk_range((a > 0 ? a : 0) - k0, qi - k0, true, lo, rng); tile_compute(T, qf, kv, lo, rng); });
    const int row = n * SEQ + r + d * qi;
    float* op = P.DPART + (((size_t)g * MP + row) * DIL_HEADS + h) * 64 + 4 * c;
#pragma unroll
    for (int db = 0; db < 4; ++db) *(f32x4*)(op + 16 * db) = T.o[db];
    T.l = colsum(T.l);
    if (c == 0) { float* ml = P.DML + (((size_t)g * MP + row) * DIL_HEADS + h) * 2; ml[0] = T.m; ml[1] = T.l; }
}
DI void mem_micro(const FP& P, const bf16* Q  , int ldq, int row0, int layer, int n, int h, bf16* O  , int ldo, int lane) {
    const int q = lane & 15, c = lane >> 4;
    bf16x8 qf[2]; { const bf16* qp = Q + (size_t)(row0 + q) * ldq + 8 * c; qf[0] = *(const bf16x8*)qp; qf[1] = *(const bf16x8*)(qp + 32); }
    const bf16* Kb = P.MK + (((size_t)layer * BATCH + n) * MEM_HEADS + h) * MEM_TOKENS * 64; const bf16* Vb = P.MVT + (((size_t)layer * BATCH + n) * MEM_HEADS + h) * MEM_TOKENS * 64;
    Tile16 T; tile_init(T);
    pipe2(MEM_TOKENS / 32, [&](KV8& kv, int i) { kv_load_t(kv, Kb + (size_t)i * 2048, Vb + (size_t)i * 2048, lane); }, [&](const KV8& kv, int) { tile_compute(T, qf, kv, -8, 64u); });
    const float inv = 1.0f / colsum(T.l); bf16* op = O + (size_t)(row0 + q) * ldo + 4 * c;
#pragma unroll
    for (int db = 0; db < 4; ++db) *(u32x2*)(op + 16 * db) = pk4(T.o[db] * inv);
}
struct Dec { float m, l, o; };
template <class KF, class VF> DI void dec_chunk(Dec& D, const LAS float* q, int nk, KF kf, VF vf, int lane) {
    float s = -INFINITY;
    if (lane < nk) { const float* k = kf(lane); float a = 0.f;
#pragma unroll
        for (int d4 = 0; d4 < 16; ++d4) { const f32x4 kv = *(const f32x4*)(k + 4 * d4); a += kv.x * q[4 * d4] + kv.y * q[4 * d4 + 1] + kv.z * q[4 * d4 + 2] + kv.w * q[4 * d4 + 3]; }
        s = a; }
    const float mx = wave_max(s), mnew = fmaxf(D.m, mx), alpha = __builtin_amdgcn_exp2f(D.m - mnew);
    const float p = (lane < nk) ? __builtin_amdgcn_exp2f(s - mnew) : 0.f;
    D.l = D.l * alpha + wave_sum(p); D.m = mnew; float o = D.o * alpha;
    for (int j0 = 0; j0 < nk; j0 += 8) { float vv[8];
#pragma unroll
        for (int u = 0; u < 8; ++u) { const int jj = (j0 + u < nk) ? j0 + u : nk - 1; vv[u] = vf(jj)[lane]; }
#pragma unroll
        for (int u = 0; u < 8; ++u) { const float pj = (j0 + u < nk) ? __builtin_bit_cast(float, __builtin_amdgcn_readlane(__builtin_bit_cast(int, p), (j0 + u) & 63)) : 0.f; o += pj * vv[u]; } }
    D.o = o;
}
DI float dec_combine(const Ctx& C, const Dec& D) {
    LAS float* cb = (LAS float*)(C.lds + 4096);
    cb[C.wave * 66 + C.lane] = D.o; if (C.lane == 0) { cb[C.wave * 66 + 64] = D.m; cb[C.wave * 66 + 65] = D.l; }
    asm volatile("s_waitcnt lgkmcnt(0)" ::: "memory"); __syncthreads();
    float M = -INFINITY;
#pragma unroll
    for (int ww = 0; ww < NWAVES; ++ww) M = fmaxf(M, cb[ww * 66 + 64]);
    float L = 0.f, o = 0.f;
#pragma unroll
    for (int ww = 0; ww < NWAVES; ++ww) { const float mw = cb[ww * 66 + 64]; const float f = (mw == -INFINITY) ? 0.f : __builtin_amdgcn_exp2f(mw - M); L += f * cb[ww * 66 + 65]; o += f * cb[ww * 66 + C.lane]; }
    return o / L;
}
DI void atta_phase(const FP& P, const Ctx& C) {
    const int lane = C.lane, w = C.wave;
    constexpr int NT = SEQ / 256, NIT = BATCH * NT * DIL_HEADS;
    for (int it = C.vcu; it < NIT; it += C.G) { const int h = it % DIL_HEADS, tt = (it / DIL_HEADS) % NT, n = it / (DIL_HEADS * NT), t0 = tt * 256;
        for (int mt = w; mt < 48; mt += NWAVES) dil_micro(P, n, h, t0, mt, lane);
        asm volatile("s_waitcnt vmcnt(0)" ::: "memory"); __syncthreads();
        for (int i = C.tid; i < 256 * 16; i += NTHREADS) { const int tk = i >> 4, d4 = (i & 15) * 4; const int row = n * SEQ + t0 + tk;
            float mg[3], lg[3]; float M = -INFINITY;
#pragma unroll
            for (int g = 0; g < 3; ++g) { const float* ml = P.DML + (((size_t)g * MP + row) * DIL_HEADS + h) * 2; mg[g] = ml[0]; lg[g] = ml[1]; M = fmaxf(M, mg[g]); }
            f32x4 acc = (f32x4){0.f, 0.f, 0.f, 0.f}; float L = 0.f;
#pragma unroll
            for (int g = 0; g < 3; ++g) { const float wg = __builtin_amdgcn_exp2f(mg[g] - M); L += wg * lg[g]; acc += *(const f32x4*)(P.DPART + (((size_t)g * MP + row) * DIL_HEADS + h) * 64 + d4) * wg; }
            *(u32x2*)(P.ATTA + (size_t)row * 512 + h * 64 + d4) = pk4(acc * (1.0f / L)); }
        for (int mt = w; mt < 16; mt += NWAVES) mem_micro(P, P.MQA + h * 64, 256, n * SEQ + t0 + 16 * mt, 0, n, h, P.ATTA + 256 + h * 64, 512, lane);
        __syncthreads();
    }
    LAS float* qs = (LAS float*)C.lds;
    for (int it = C.vcu; it < DEC_BATCH * DIL_HEADS * 2; it += C.G) { const int kind = it & 1, h = (it >> 1) % DIL_HEADS, ns = (it >> 1) / DIL_HEADS, row = M0 + ns;
        __syncthreads();
        if (kind == 0) { if (C.tid < 192) qs[C.tid] = bf2f(P.QA[((size_t)(C.tid >> 6) * MPAD + row) * 256 + h * 64 + (C.tid & 63)]); } else { if (C.tid < 64) qs[C.tid] = bf2f(P.MQA[(size_t)row * 256 + h * 64 + C.tid]); }
        asm volatile("s_waitcnt lgkmcnt(0)" ::: "memory"); __syncthreads();
        Dec D; D.m = -INFINITY; D.l = 0.f; D.o = 0.f;
        if (kind == 0) { constexpr int CPG = (DIL_TAPS + 63) / 64;
            for (int ck = w; ck < 3 * CPG; ck += NWAVES) { const int g = ck / CPG, j0 = (ck % CPG) * 64; const int W = dil_w(g), d = dil_d(g); const float* cache = sel3c(P.cache_dil, g) + (size_t)ns * W * 512; const float* newrow = sel3(P.dil_s, g) + ((size_t)ns * W + W - 1) * 512;
                const int nk = (DIL_TAPS - j0) < 64 ? (DIL_TAPS - j0) : 64;
                dec_chunk(D, qs + g * 64, nk, [&](int j) { const int tap = j0 + j; return (tap == 0 ? newrow : cache + (size_t)(W - d * tap) * 512) + h * 64; },
                          [&](int j) { const int tap = j0 + j; return (tap == 0 ? newrow : cache + (size_t)(W - d * tap) * 512) + 256 + h * 64; }, lane); } }
        else { const float* mk = P.cache_mem_kv + ((size_t)0 * DEC_BATCH + ns) * MEM_TOKENS * 512;
            for (int ck = w; ck < MEM_TOKENS / 64; ck += NWAVES) { const int j0 = ck * 64; dec_chunk(D, qs, 64, [&](int j) { return mk + (size_t)(j0 + j) * 512 + h * 64; }, [&](int j) { return mk + (size_t)(j0 + j) * 512 + 256 + h * 64; }, lane); } }
        const float o = dec_combine(C, D);
        if (w == 0) P.ATTA[(size_t)row * 512 + (kind == 0 ? 0 : 256) + h * 64 + lane] = (bf16)f2bf(o);
    }
    __syncthreads();
}
DI void ln_phase(const FP& P, const Ctx& C, const float* pre, const float* gam, const float* bet, float* xo, bf16* xb, float* yp, float* ys) {
    const int gw = C.vcu * NWAVES + C.wave, NGW = C.G * NWAVES, lane = C.lane;
    for (int r = gw; r < MP; r += NGW) { const float* x = pre + (size_t)r * D_MODEL; f32x4 v[4]; float s = 0.f;
#pragma unroll
        for (int j = 0; j < 4; ++j) { v[j] = *(const f32x4*)(x + 256 * j + 4 * lane); s += (v[j].x + v[j].y) + (v[j].z + v[j].w); }
        const float mu = wave_sum(s) * (1.0f / D_MODEL); float s2 = 0.f;
#pragma unroll
        for (int j = 0; j < 4; ++j) { v[j] = v[j] - mu; s2 += (v[j].x * v[j].x + v[j].y * v[j].y) + (v[j].z * v[j].z + v[j].w * v[j].w); }
        const float rs = 1.0f / sqrtf(wave_sum(s2) * (1.0f / D_MODEL) + LN_EPS);
#pragma unroll
        for (int j = 0; j < 4; ++j) { const f32x4 gg = *(const f32x4*)(gam + 256 * j + 4 * lane), bb = *(const f32x4*)(bet + 256 * j + 4 * lane); const f32x4 o = v[j] * rs * gg + bb;
            if (xo) *(f32x4*)(xo + (size_t)r * D_MODEL + 256 * j + 4 * lane) = o;
            if (xb) *(u32x2*)(xb + (size_t)r * D_MODEL + 256 * j + 4 * lane) = pk4(o);
            if (yp) { if (r < M0) *(f32x4*)(yp + (size_t)r * D_MODEL + 256 * j + 4 * lane) = o; else *(f32x4*)(ys + (size_t)(r - M0) * D_MODEL + 256 * j + 4 * lane) = o; } }
    }
}
}
namespace fx {
#define INS16(V, I, v_, i_) do { const float _v = (v_); const int _i = (i_); bool _c[16]; _Pragma("unroll") for (int _k = 0; _k < 16; ++_k) _c[_k] = _v > V[_k]; \
    _Pragma("unroll") for (int _k = 15; _k >= 1; --_k) { V[_k] = _c[_k] ? (_c[_k - 1] ? V[_k - 1] : _v) : V[_k]; I[_k] = _c[_k] ? (_c[_k - 1] ? I[_k - 1] : _i) : I[_k]; } \
    V[0] = _c[0] ? _v : V[0]; I[0] = _c[0] ? _i : I[0]; } while (0)
DI void wave_top16_128(float a, float b, int lane, float& outv, int& outi) {
    outv = -INFINITY; outi = 0;
#pragma unroll 1
    for (int k = 0; k < 16; ++k) { const float m = wave_max(fmaxf(a, b)); const unsigned long long ba = __ballot(a == m), bb = __ballot(b == m); int idx;
        if (ba) { const int l = __builtin_ctzll(ba); idx = l; if (lane == l) a = -INFINITY; } else { const int l = __builtin_ctzll(bb); idx = 64 + l; if (lane == l) b = -INFINITY; }
        if (lane == k) { outv = m; outi = idx; } }
}
DI void topk_wave_item(const FP& P, long it, int lane) {
    const float* s = P.SCO + it * 256; float v1, v2; int i1, i2;
    wave_top16_128(s[lane], s[64 + lane], lane, v1, i1); wave_top16_128(s[128 + lane], s[192 + lane], lane, v2, i2);
    int a = 0, rem = lane; bool valid = false;
    for (int aa = 0; aa < 16; ++aa) { const int nb = 16 / (aa + 1); if (!valid) { if (rem < nb) { a = aa; valid = true; } else rem -= nb; } }
    const int b = valid ? rem : 0;
    float cs = __shfl(v1, a) + __shfl(v2, b); const int ce = __shfl(i1, a) * PEER_KEYS + __shfl(i2, b); if (!valid) cs = -INFINITY;
    float tv = -INFINITY; int te = 0;
#pragma unroll 1
    for (int k = 0; k < 16; ++k) { const float m = wave_max(cs); const unsigned long long bm = __ballot(cs == m); const int l = __builtin_ctzll(bm); const int e = __shfl(ce, l); if (lane == l) cs = -INFINITY; if (lane == k) { tv = m; te = e; } }
    const float mx = __shfl(tv, 0); const float ex = (lane < 16) ? __expf(tv - mx) : 0.f; const float z = wave_sum(ex);
    if (lane < 16) { P.SELG[it * 16 + lane] = ex / z; P.SELE[it * 16 + lane] = te; }
}
#define KINS16(V, key_) do { const float _key = (key_); _Pragma("unroll") for (int _k = 15; _k >= 1; --_k) V[_k] = __builtin_amdgcn_fmed3f(V[_k - 1], V[_k], _key); V[0] = fmaxf(V[0], _key); } while (0)
DI float pack_key(float v, unsigned lowbits, unsigned mask) { return __builtin_bit_cast(float, (__builtin_bit_cast(unsigned, v) & ~mask) | lowbits); }
DI void topk_phase(const FP& P, const Ctx& C) {
    const int lane = C.lane; LAS float* st = (LAS float*)(C.lds + C.wave * 16384);
    const int NWI = (M0 * PEER_HEADS) / 64;
    for (int wi = C.vcu * NWAVES + C.wave; wi < NWI; wi += C.G * NWAVES) {
        const long it0 = (long)wi * 64; const long it = it0 + lane;
        float V1[16], V2[16], V3[16];
#pragma unroll
        for (int k = 0; k < 16; ++k) { V1[k] = V2[k] = V3[k] = -INFINITY; }
#pragma unroll 1
        for (int ch = 0; ch < 8; ++ch) {
#pragma unroll
            for (int u = 0; u < 8; ++u) { const int f4 = u * 64 + lane, j = f4 >> 3, q = f4 & 7, hf = q >> 2, c4 = (q & 3) * 4; const long itj = it0 + j;
                const f32x4 v = *(const f32x4*)(P.SCO + itj * 256 + hf * 128 + ch * 16 + c4);
                st[j * 33 + hf * 16 + c4] = v.x; st[j * 33 + hf * 16 + c4 + 1] = v.y; st[j * 33 + hf * 16 + c4 + 2] = v.z; st[j * 33 + hf * 16 + c4 + 3] = v.w; }
            asm volatile("s_waitcnt lgkmcnt(0)" ::: "memory");
#pragma unroll 4
            for (int c = 0; c < 16; ++c) { const float va = st[lane * 33 + c], vb = st[lane * 33 + 16 + c]; const unsigned lb = 127u - (unsigned)(ch * 16 + c); KINS16(V1, pack_key(va, lb, 127u)); KINS16(V2, pack_key(vb, lb, 127u)); }
            asm volatile("s_waitcnt lgkmcnt(0)" ::: "memory");
        }
        LAS int* lc = (LAS int*)st;
        { int ord = 0;
#pragma unroll
          for (int a = 0; a < 16; ++a) { const unsigned ba = __builtin_bit_cast(unsigned, V1[a]); const float va = __builtin_bit_cast(float, ba & ~127u); const int ia = 127 - (int)(ba & 127u);
#pragma unroll
              for (int b = 0; b < 16; ++b) if ((a + 1) * (b + 1) <= 16) { const unsigned bb = __builtin_bit_cast(unsigned, V2[b]); const float vb = __builtin_bit_cast(float, bb & ~127u); const int ib = 127 - (int)(bb & 127u);
                  lc[lane * 51 + ord] = ia * PEER_KEYS + ib; KINS16(V3, pack_key(va + vb, 63u - (unsigned)ord, 63u)); ++ord; } } }
        asm volatile("s_waitcnt lgkmcnt(0)" ::: "memory");
        float g[16]; int e[16]; float z = 0.f; const float vmax = __builtin_bit_cast(float, __builtin_bit_cast(unsigned, V3[0]) & ~63u);
#pragma unroll
        for (int k = 0; k < 16; ++k) { const unsigned bk = __builtin_bit_cast(unsigned, V3[k]); e[k] = lc[lane * 51 + 63 - (int)(bk & 63u)]; g[k] = __expf(__builtin_bit_cast(float, bk & ~63u) - vmax); z += g[k]; }
        const float iz = 1.0f / z;
#pragma unroll
        for (int k4 = 0; k4 < 4; ++k4) { *(f32x4*)(P.SELG + it * 16 + 4 * k4) = (f32x4){g[4 * k4] * iz, g[4 * k4 + 1] * iz, g[4 * k4 + 2] * iz, g[4 * k4 + 3] * iz};
            *(int4*)(P.SELE + it * 16 + 4 * k4) = make_int4(e[4 * k4], e[4 * k4 + 1], e[4 * k4 + 2], e[4 * k4 + 3]); }
        asm volatile("s_waitcnt lgkmcnt(0)" ::: "memory");
    }
    for (int si = C.vcu * NWAVES + C.wave; si < DEC_BATCH * PEER_HEADS; si += C.G * NWAVES) topk_wave_item(P, (long)M0 * PEER_HEADS + si, lane);
    __syncthreads();
}
constexpr float PEER_SU = 256.f, PEER_SV = 64.f;
DI float dot16_fp8(const u32x4& w, const f32x2 (&x2)[8]) { f32x2 a = {0.f, 0.f};
    a += __builtin_amdgcn_cvt_pk_f32_fp8((int)w.x, false) * x2[0]; a += __builtin_amdgcn_cvt_pk_f32_fp8((int)w.x, true) * x2[1];
    a += __builtin_amdgcn_cvt_pk_f32_fp8((int)w.y, false) * x2[2]; a += __builtin_amdgcn_cvt_pk_f32_fp8((int)w.y, true) * x2[3];
    a += __builtin_amdgcn_cvt_pk_f32_fp8((int)w.z, false) * x2[4]; a += __builtin_amdgcn_cvt_pk_f32_fp8((int)w.z, true) * x2[5];
    a += __builtin_amdgcn_cvt_pk_f32_fp8((int)w.w, false) * x2[6]; a += __builtin_amdgcn_cvt_pk_f32_fp8((int)w.w, true) * x2[7];
    return a.x + a.y; }
DI void axpy16_fp8(const u32x4& w, float s, f32x2 (&o2)[8]) { const f32x2 s2 = {s, s};
    o2[0] += __builtin_amdgcn_cvt_pk_f32_fp8((int)w.x, false) * s2; o2[1] += __builtin_amdgcn_cvt_pk_f32_fp8((int)w.x, true) * s2;
    o2[2] += __builtin_amdgcn_cvt_pk_f32_fp8((int)w.y, false) * s2; o2[3] += __builtin_amdgcn_cvt_pk_f32_fp8((int)w.y, true) * s2;
    o2[4] += __builtin_amdgcn_cvt_pk_f32_fp8((int)w.z, false) * s2; o2[5] += __builtin_amdgcn_cvt_pk_f32_fp8((int)w.z, true) * s2;
    o2[6] += __builtin_amdgcn_cvt_pk_f32_fp8((int)w.w, false) * s2; o2[7] += __builtin_amdgcn_cvt_pk_f32_fp8((int)w.w, true) * s2; }
#if defined(PEER_SHARD) || defined(PEER_SHARD2)
#define PEER_FIRST_ROUND nrounds
#else
#define PEER_FIRST_ROUND 0
#endif
template <int CTRL> DI float dppf(float x) { return __builtin_bit_cast(float, __builtin_amdgcn_update_dpp(0, __builtin_bit_cast(int, x), CTRL, 0xF, 0xF, true)); }
DI float rdlane(float v, int l) { return __builtin_bit_cast(float, __builtin_amdgcn_readlane(__builtin_bit_cast(int, v), l)); }
DI void peer_phase(const FP& P, const Ctx& C, int layer, const float* xin, float* fout, float* fout_s, bf16* xb, bool samples_only = false) {
    const int lane = C.lane; const unsigned char* U = P.UB8 + (size_t)layer * PEER_EXPERTS * D_MODEL; const unsigned char* Vt = P.VB8 + (size_t)layer * PEER_EXPERTS * D_MODEL;
    const float* gam = P.ln_g + ((size_t)layer * 2 + 1) * D_MODEL; const float* bet = P.ln_b + ((size_t)layer * 2 + 1) * D_MODEL;
    const int nrounds = (M0 + C.G * NWAVES - 1) / (C.G * NWAVES);
#pragma unroll 1
    for (int rd = samples_only ? nrounds : 0; rd <= nrounds; ++rd) {
        const bool smp = (rd == nrounds); int r = smp ? M0 + C.vcu : rd * C.G * NWAVES + C.vcu * NWAVES + C.wave; if (smp ? (C.vcu >= DEC_BATCH) : (r >= M0)) continue;
        const int pb = smp ? 16 * C.wave : 0, pe = smp ? pb + 16 : 128;
        f32x2 x2[8], o2[8];
#pragma unroll
        for (int j = 0; j < 4; ++j) { const f32x4 a = *(const f32x4*)(xin + (size_t)r * D_MODEL + 16 * lane + 4 * j); x2[2 * j] = (f32x2){a.x, a.y}; x2[2 * j + 1] = (f32x2){a.z, a.w}; }
#pragma unroll
        for (int k = 0; k < 8; ++k) o2[k] = (f32x2){0.f, 0.f};
        const int e_l = P.SELE[(size_t)r * 128 + lane], e_h = P.SELE[(size_t)r * 128 + 64 + lane]; const float g_l = P.SELG[(size_t)r * 128 + lane], g_h = P.SELG[(size_t)r * 128 + 64 + lane];
#pragma unroll 1
        for (int b0 = pb; b0 < pe; b0 += 8) {
            u32x4 uw[8], vw[8];
#pragma unroll
            for (int k = 0; k < 8; ++k) { const int hk = b0 + k; const int e = (hk < 64) ? __builtin_amdgcn_readlane(e_l, hk & 63) : __builtin_amdgcn_readlane(e_h, hk & 63);
                uw[k] = *(const u32x4*)(U + (size_t)e * D_MODEL + 16 * lane); vw[k] = *(const u32x4*)(Vt + (size_t)e * D_MODEL + 16 * lane); }
            float d[8];
#pragma unroll
            for (int k = 0; k < 8; ++k) d[k] = dot16_fp8(uw[k], x2);
            float e4[4], e2[2], e1;
            { const bool hi = lane & 1;
#pragma unroll
              for (int i = 0; i < 4; ++i) { const float keep = hi ? d[4 + i] : d[i], send = hi ? d[i] : d[4 + i]; e4[i] = keep + __shfl_xor(send, 1); } }
            { const bool hi = lane & 2;
#pragma unroll
              for (int i = 0; i < 2; ++i) { const float keep = hi ? e4[2 + i] : e4[i], send = hi ? e4[i] : e4[2 + i]; e2[i] = keep + __shfl_xor(send, 2); } }
            { const bool hi = lane & 4; const float keep = hi ? e2[1] : e2[0], send = hi ? e2[0] : e2[1]; e1 = keep + __shfl_xor(send, 4); }
            e1 += __shfl_xor(e1, 8); e1 += __shfl_xor(e1, 16); e1 += __shfl_xor(e1, 32);
            const int myk = 4 * (lane & 1) + (lane & 2) + ((lane >> 2) & 1); const int myhk = b0 + myk;
            const float myg = (myhk < 64) ? __shfl(g_l, myhk & 63) : __shfl(g_h, myhk & 63);
            const float act = myg * gelu_tanh(e1 * (1.0f / PEER_SU)) * (1.0f / PEER_SV);
#pragma unroll
            for (int k = 0; k < 8; ++k) { const int src = (k >> 2) | (((k >> 1) & 1) << 1) | ((k & 1) << 2); axpy16_fp8(vw[k], rdlane(act, src), o2); }
        }
        if (smp) {
            LAS float* red = (LAS float*)C.lds;
#pragma unroll
            for (int k = 0; k < 8; ++k) { red[C.wave * 1024 + 16 * lane + 2 * k] = o2[k].x; red[C.wave * 1024 + 16 * lane + 2 * k + 1] = o2[k].y; }
            asm volatile("s_waitcnt lgkmcnt(0)" ::: "memory"); __syncthreads();
            if (C.wave == 0) {
#pragma unroll
                for (int k = 0; k < 8; ++k) { float ax = 0.f, ay = 0.f;
#pragma unroll
                    for (int ww = 0; ww < NWAVES; ++ww) { ax += red[ww * 1024 + 16 * lane + 2 * k]; ay += red[ww * 1024 + 16 * lane + 2 * k + 1]; } o2[k] = (f32x2){ax, ay}; } }
            __syncthreads();
            if (C.wave != 0) continue; }
        float s = 0.f;
#pragma unroll
        for (int k = 0; k < 8; ++k) { o2[k] += x2[k] * ALPHA; s += o2[k].x + o2[k].y; }
        const float mu = wave_sum(s) * (1.0f / D_MODEL); float s2 = 0.f;
#pragma unroll
        for (int k = 0; k < 8; ++k) { o2[k] -= mu; s2 += o2[k].x * o2[k].x + o2[k].y * o2[k].y; }
        const float rs = 1.0f / sqrtf(wave_sum(s2) * (1.0f / D_MODEL) + LN_EPS);
        float* frow = (r < M0) ? fout + (size_t)r * D_MODEL : fout_s + (size_t)(r - M0) * D_MODEL;
#pragma unroll
        for (int j = 0; j < 4; ++j) { const int c0 = 16 * lane + 4 * j; const f32x4 gg = *(const f32x4*)(gam + c0), bb = *(const f32x4*)(bet + c0);
            const f32x4 y = (f32x4){o2[2 * j].x * rs, o2[2 * j].y * rs, o2[2 * j + 1].x * rs, o2[2 * j + 1].y * rs} * gg + bb;
            *(f32x4*)(frow + c0) = y; if (xb) *(u32x2*)(xb + (size_t)r * D_MODEL + c0) = pk4(y); }
    }
}
DI void peer_u_phase(const FP& P, const Ctx& C, int layer, const bf16* xb16) {
    const int lane = C.lane; const unsigned char* U = P.UB8 + (size_t)layer * PEER_EXPERTS * D_MODEL;
    const int s = (int)(blockIdx.x & 7), nw = (C.G >> 3) * NWAVES, widx = (int)(blockIdx.x >> 3) * NWAVES + C.wave;
#pragma unroll 1
    for (int r = widx; r < MP; r += nw) {
        const int e0 = P.SELE[(size_t)r * 128 + lane], e1 = P.SELE[(size_t)r * 128 + 64 + lane]; const float g0 = P.SELG[(size_t)r * 128 + lane], g1 = P.SELG[(size_t)r * 128 + 64 + lane];
        unsigned long long b0 = __ballot((e0 >> 11) == s), b1 = __ballot((e1 >> 11) == s);
        if ((b0 | b1) == 0ull) continue;
        f32x2 x2[8]; { const u32x4 xa = *(const u32x4*)(xb16 + (size_t)r * D_MODEL + 16 * lane), xc = *(const u32x4*)(xb16 + (size_t)r * D_MODEL + 16 * lane + 8);
            x2[0] = (f32x2){bflo(xa.x), bfhi(xa.x)}; x2[1] = (f32x2){bflo(xa.y), bfhi(xa.y)}; x2[2] = (f32x2){bflo(xa.z), bfhi(xa.z)}; x2[3] = (f32x2){bflo(xa.w), bfhi(xa.w)};
            x2[4] = (f32x2){bflo(xc.x), bfhi(xc.x)}; x2[5] = (f32x2){bflo(xc.y), bfhi(xc.y)}; x2[6] = (f32x2){bflo(xc.z), bfhi(xc.z)}; x2[7] = (f32x2){bflo(xc.w), bfhi(xc.w)}; }
#pragma unroll 1
        while ((b0 | b1) != 0ull) {
            int hk[8]; u32x4 uw[8]; int nv = 0;
#pragma unroll
            for (int k = 0; k < 8; ++k) { int h;
                if (b0) { h = __builtin_ctzll(b0); b0 &= b0 - 1; ++nv; } else if (b1) { h = 64 + __builtin_ctzll(b1); b1 &= b1 - 1; ++nv; } else h = hk[k > 0 ? k - 1 : 0];
                hk[k] = h; const int e = (h < 64) ? __builtin_amdgcn_readlane(e0, h & 63) : __builtin_amdgcn_readlane(e1, h & 63);
                uw[k] = *(const u32x4*)(U + (size_t)e * D_MODEL + 16 * lane); }
            float d[8];
#pragma unroll
            for (int k = 0; k < 8; ++k) d[k] = dot16_fp8(uw[k], x2);
            float e4[4], e2[2], e1s;
            { const bool hi = lane & 1;
#pragma unroll
              for (int i = 0; i < 4; ++i) { const float keep = hi ? d[4 + i] : d[i], send = hi ? d[i] : d[4 + i]; e4[i] = keep + __shfl_xor(send, 1); } }
            { const bool hi = lane & 2;
#pragma unroll
              for (int i = 0; i < 2; ++i) { const float keep = hi ? e4[2 + i] : e4[i], send = hi ? e4[i] : e4[2 + i]; e2[i] = keep + __shfl_xor(send, 2); } }
            { const bool hi = lane & 4; const float keep = hi ? e2[1] : e2[0], send = hi ? e2[0] : e2[1]; e1s = keep + __shfl_xor(send, 4); }
            e1s += __shfl_xor(e1s, 8); e1s += __shfl_xor(e1s, 16); e1s += __shfl_xor(e1s, 32);
            const int myk = 4 * (lane & 1) + (lane & 2) + ((lane >> 2) & 1);
            int myh = hk[0];
#pragma unroll
            for (int k = 1; k < 8; ++k) myh = (myk == k) ? hk[k] : myh;
            const float ga = __shfl(g0, myh & 63), gb = __shfl(g1, myh & 63); const float myg = (myh < 64) ? ga : gb;
            if (lane < 8 && myk < nv) P.SCO[(size_t)r * 128 + myh] = myg * gelu_tanh(e1s * (1.0f / PEER_SU)) * (1.0f / PEER_SV);
        }
    }
}
DI void peer_v_phase(const FP& P, const Ctx& C, int layer, const float* xin, float* fout, float* fout_s, bf16* xb) {
    const int lane = C.lane; const unsigned char* Vt = P.VB8 + (size_t)layer * PEER_EXPERTS * D_MODEL;
    const float* gam = P.ln_g + ((size_t)layer * 2 + 1) * D_MODEL; const float* bet = P.ln_b + ((size_t)layer * 2 + 1) * D_MODEL;
    const int nrounds = (M0 + C.G * NWAVES - 1) / (C.G * NWAVES);
#pragma unroll 1
    for (int rd = 0; rd <= nrounds; ++rd) {
        const bool smp = (rd == nrounds); int r = smp ? M0 + C.vcu : rd * C.G * NWAVES + C.vcu * NWAVES + C.wave; if (smp ? (C.vcu >= DEC_BATCH) : (r >= M0)) continue;
        const int pb = smp ? 16 * C.wave : 0, pe = smp ? pb + 16 : 128;
        f32x2 x2[8], o2[8];
#pragma unroll
        for (int j = 0; j < 4; ++j) { const f32x4 a = *(const f32x4*)(xin + (size_t)r * D_MODEL + 16 * lane + 4 * j); x2[2 * j] = (f32x2){a.x, a.y}; x2[2 * j + 1] = (f32x2){a.z, a.w}; }
#pragma unroll
        for (int k = 0; k < 8; ++k) o2[k] = (f32x2){0.f, 0.f};
        const int e_l = P.SELE[(size_t)r * 128 + lane], e_h = P.SELE[(size_t)r * 128 + 64 + lane]; const float a_l = P.SCO[(size_t)r * 128 + lane], a_h = P.SCO[(size_t)r * 128 + 64 + lane];
#pragma unroll 1
        for (int b0 = pb; b0 < pe; b0 += 16) { u32x4 vw[16];
#pragma unroll
            for (int k = 0; k < 16; ++k) { const int hk = b0 + k; const int e = (hk < 64) ? __builtin_amdgcn_readlane(e_l, hk & 63) : __builtin_amdgcn_readlane(e_h, hk & 63); vw[k] = *(const u32x4*)(Vt + (size_t)e * D_MODEL + 16 * lane); }
#pragma unroll
            for (int k = 0; k < 16; ++k) { const int hk = b0 + k; axpy16_fp8(vw[k], (hk < 64) ? rdlane(a_l, hk & 63) : rdlane(a_h, hk & 63), o2); } }
        if (smp) {
            LAS float* red = (LAS float*)C.lds;
#pragma unroll
            for (int k = 0; k < 8; ++k) { red[C.wave * 1024 + 16 * lane + 2 * k] = o2[k].x; red[C.wave * 1024 + 16 * lane + 2 * k + 1] = o2[k].y; }
            asm volatile("s_waitcnt lgkmcnt(0)" ::: "memory"); __syncthreads();
            if (C.wave == 0) {
#pragma unroll
                for (int k = 0; k < 8; ++k) { float ax = 0.f, ay = 0.f;
#pragma unroll
                    for (int ww = 0; ww < NWAVES; ++ww) { ax += red[ww * 1024 + 16 * lane + 2 * k]; ay += red[ww * 1024 + 16 * lane + 2 * k + 1]; } o2[k] = (f32x2){ax, ay}; } }
            __syncthreads();
            if (C.wave != 0) continue; }
        float s = 0.f;
#pragma unroll
        for (int k = 0; k < 8; ++k) { o2[k] += x2[k] * ALPHA; s += o2[k].x + o2[k].y; }
        const float mu = wave_sum(s) * (1.0f / D_MODEL); float s2 = 0.f;
#pragma unroll
        for (int k = 0; k < 8; ++k) { o2[k] -= mu; s2 += o2[k].x * o2[k].x + o2[k].y * o2[k].y; }
        const float rs = 1.0f / sqrtf(wave_sum(s2) * (1.0f / D_MODEL) + LN_EPS);
        float* frow = (r < M0) ? fout + (size_t)r * D_MODEL : fout_s + (size_t)(r - M0) * D_MODEL;
#pragma unroll
        for (int j = 0; j < 4; ++j) { const int c0 = 16 * lane + 4 * j; const f32x4 gg = *(const f32x4*)(gam + c0), bb = *(const f32x4*)(bet + c0);
            const f32x4 y = (f32x4){o2[2 * j].x * rs, o2[2 * j].y * rs, o2[2 * j + 1].x * rs, o2[2 * j + 1].y * rs} * gg + bb;
            *(f32x4*)(frow + c0) = y; if (xb) *(u32x2*)(xb + (size_t)r * D_MODEL + c0) = pk4(y); }
    }
}
constexpr int PSH_LIST = 512;
struct PG4 { u32x4 u[4], v[4]; };
DI void peer_sharded_phase(const FP& P, const Ctx& C, int layer, const float* xin, const bf16* xb16, float* fout, float* fout_s, bf16* xb) {
    const int lane = C.lane; const unsigned char* U = P.UB8 + (size_t)layer * PEER_EXPERTS * D_MODEL; const unsigned char* Vt = P.VB8 + (size_t)layer * PEER_EXPERTS * D_MODEL;
    const float* gam = P.ln_g + ((size_t)layer * 2 + 1) * D_MODEL; const float* bet = P.ln_b + ((size_t)layer * 2 + 1) * D_MODEL;
    LAS unsigned char* wl = C.lds + C.wave * 16384; LAS bf16* xs = (LAS bf16*)wl; LAS int* lst = (LAS int*)(wl + 8192);
    const int NW = C.G * NWAVES, gw = C.vcu * NWAVES + C.wave; const int nquads = (M0 / NW) / 4;
#pragma unroll 1
    for (int qd = 0; qd < nquads; ++qd) {
#define PSH_ROW(j) const int row##j = (qd * 4 + j) * NW + gw; const int el##j = P.SELE[(size_t)row##j * 128 + lane], eh##j = P.SELE[(size_t)row##j * 128 + 64 + lane]; const float gl##j = P.SELG[(size_t)row##j * 128 + lane], gh##j = P.SELG[(size_t)row##j * 128 + 64 + lane]; \
        { const u32x4 xa = *(const u32x4*)(xb16 + (size_t)row##j * D_MODEL + 16 * lane), xc = *(const u32x4*)(xb16 + (size_t)row##j * D_MODEL + 16 * lane + 8); *(LAS u32x4*)(xs + j * 1024 + 16 * lane) = xa; *(LAS u32x4*)(xs + j * 1024 + 16 * lane + 8) = xc; } \
        f32x2 oa##j[8]; _Pragma("unroll") for (int k = 0; k < 8; ++k) oa##j[k] = (f32x2){0.f, 0.f};
        PSH_ROW(0) PSH_ROW(1) PSH_ROW(2) PSH_ROW(3)
#pragma unroll 1
        for (int s = 0; s < 16; ++s) {
            int n = 0;
#define PSH_SCAN(j) { unsigned long long b0 = __ballot((el##j >> 10) == s), b1 = __ballot((eh##j >> 10) == s); \
                while (b0) { const int h = __builtin_ctzll(b0); b0 &= b0 - 1; const int e = __builtin_amdgcn_readlane(el##j, h); const int g = __builtin_amdgcn_readlane(__builtin_bit_cast(int, gl##j), h); \
                    if (lane == 0) { lst[4 * n] = e; lst[4 * n + 1] = g; lst[4 * n + 2] = j; } ++n; } \
                while (b1) { const int h = __builtin_ctzll(b1); b1 &= b1 - 1; const int e = __builtin_amdgcn_readlane(eh##j, h); const int g = __builtin_amdgcn_readlane(__builtin_bit_cast(int, gh##j), h); \
                    if (lane == 0) { lst[4 * n] = e; lst[4 * n + 1] = g; lst[4 * n + 2] = j; } ++n; } }
            PSH_SCAN(0) PSH_SCAN(1) PSH_SCAN(2) PSH_SCAN(3)
            asm volatile("s_waitcnt lgkmcnt(0)" ::: "memory");
            if (n == 0) continue;
            const int ngrp = (n + 3) >> 2;
#define PSH_LD(b, gi_) do { const int gi = (gi_); _Pragma("unroll") for (int k = 0; k < 4; ++k) { int i = 4 * gi + k; i = i < n ? i : n - 1; const int e = __builtin_amdgcn_readfirstlane(lst[4 * i]); \
                b.u[k] = *(const u32x4*)(U + (size_t)e * D_MODEL + 16 * lane); b.v[k] = *(const u32x4*)(Vt + (size_t)e * D_MODEL + 16 * lane); } } while (0)
#define PSH_CP(b, gi_) do { const int gi = (gi_); float d[4]; int jj[4]; float gg[4]; \
                _Pragma("unroll") for (int k = 0; k < 4; ++k) { int i = 4 * gi + k; const bool val = i < n; i = val ? i : n - 1; jj[k] = __builtin_amdgcn_readfirstlane(lst[4 * i + 2]); gg[k] = val ? __builtin_bit_cast(float, __builtin_amdgcn_readfirstlane(lst[4 * i + 1])) : 0.f; \
                    const u32x4 xa = *(const LAS u32x4*)(xs + jj[k] * 1024 + 16 * lane), xc = *(const LAS u32x4*)(xs + jj[k] * 1024 + 16 * lane + 8); \
                    const f32x2 x2[8] = {(f32x2){bflo(xa.x), bfhi(xa.x)}, (f32x2){bflo(xa.y), bfhi(xa.y)}, (f32x2){bflo(xa.z), bfhi(xa.z)}, (f32x2){bflo(xa.w), bfhi(xa.w)}, (f32x2){bflo(xc.x), bfhi(xc.x)}, (f32x2){bflo(xc.y), bfhi(xc.y)}, (f32x2){bflo(xc.z), bfhi(xc.z)}, (f32x2){bflo(xc.w), bfhi(xc.w)}}; \
                    d[k] = dot16_fp8(b.u[k], x2); } \
                float e2[2], e1; \
                { const bool hi = lane & 1; _Pragma("unroll") for (int i = 0; i < 2; ++i) { const float keep = hi ? d[2 + i] : d[i], send = hi ? d[i] : d[2 + i]; e2[i] = keep + __shfl_xor(send, 1); } } \
                { const bool hi = lane & 2; const float keep = hi ? e2[1] : e2[0], send = hi ? e2[0] : e2[1]; e1 = keep + __shfl_xor(send, 2); } \
                e1 += __shfl_xor(e1, 4); e1 += __shfl_xor(e1, 8); e1 += __shfl_xor(e1, 16); e1 += __shfl_xor(e1, 32); \
                const int myk = 2 * (lane & 1) + ((lane >> 1) & 1); \
                float myg = gg[0]; myg = (myk == 1) ? gg[1] : myg; myg = (myk == 2) ? gg[2] : myg; myg = (myk == 3) ? gg[3] : myg; \
                const float act = myg * gelu_tanh(e1 * (1.0f / PEER_SU)) * (1.0f / PEER_SV); \
                _Pragma("unroll") for (int k = 0; k < 4; ++k) { const float a = rdlane(act, (k >> 1) | ((k & 1) << 1)); \
                    if (jj[k] == 0) axpy16_fp8(b.v[k], a, oa0); else if (jj[k] == 1) axpy16_fp8(b.v[k], a, oa1); else if (jj[k] == 2) axpy16_fp8(b.v[k], a, oa2); else axpy16_fp8(b.v[k], a, oa3); } } while (0)
            { PG4 A, B; PSH_LD(A, 0);
#pragma unroll 1
              for (int g2 = 0; g2 < ngrp; g2 += 2) { PSH_LD(B, (g2 + 1 < ngrp) ? g2 + 1 : g2); PSH_CP(A, g2); PSH_LD(A, (g2 + 2 < ngrp) ? g2 + 2 : g2); if (g2 + 1 < ngrp) PSH_CP(B, g2 + 1); } }
            asm volatile("s_waitcnt lgkmcnt(0)" ::: "memory");
        }
#define PSH_LN(j) { const int r = row##j; f32x2 x2[8]; \
            _Pragma("unroll") for (int q = 0; q < 4; ++q) { const f32x4 a = *(const f32x4*)(xin + (size_t)r * D_MODEL + 16 * lane + 4 * q); x2[2 * q] = (f32x2){a.x, a.y}; x2[2 * q + 1] = (f32x2){a.z, a.w}; } \
            float sm = 0.f; _Pragma("unroll") for (int k = 0; k < 8; ++k) { oa##j[k] += x2[k] * ALPHA; sm += oa##j[k].x + oa##j[k].y; } \
            const float mu = wave_sum(sm) * (1.0f / D_MODEL); float s2 = 0.f; _Pragma("unroll") for (int k = 0; k < 8; ++k) { oa##j[k] -= mu; s2 += oa##j[k].x * oa##j[k].x + oa##j[k].y * oa##j[k].y; } \
            const float rs = 1.0f / sqrtf(wave_sum(s2) * (1.0f / D_MODEL) + LN_EPS); float* frow = fout + (size_t)r * D_MODEL; \
            _Pragma("unroll") for (int q = 0; q < 4; ++q) { const int c0 = 16 * lane + 4 * q; const f32x4 gv = *(const f32x4*)(gam + c0), bv = *(const f32x4*)(bet + c0); \
                const f32x4 y = (f32x4){oa##j[2 * q].x * rs, oa##j[2 * q].y * rs, oa##j[2 * q + 1].x * rs, oa##j[2 * q + 1].y * rs} * gv + bv; *(f32x4*)(frow + c0) = y; if (xb) *(u32x2*)(xb + (size_t)r * D_MODEL + c0) = pk4(y); } }
        PSH_LN(0) PSH_LN(1) PSH_LN(2) PSH_LN(3)
        asm volatile("s_waitcnt lgkmcnt(0)" ::: "memory");
    }
}
constexpr int PSH_LOG = 11, PSH_N = PEER_EXPERTS >> PSH_LOG;
#ifndef PS2_ROWS
#define PS2_ROWS 4
#endif
#define PS2_ROW(j) const int row##j = (qd * PS2_ROWS + j) * NW + gw; const int el##j = P.SELE[(size_t)row##j * 128 + lane], eh##j = P.SELE[(size_t)row##j * 128 + 64 + lane]; const float gl##j = P.SELG[(size_t)row##j * 128 + lane], gh##j = P.SELG[(size_t)row##j * 128 + 64 + lane]; \
    f32x2 oa##j[8]; _Pragma("unroll") for (int k = 0; k < 8; ++k) oa##j[k] = (f32x2){0.f, 0.f};
#define PS2_STEP(j) { unsigned long long b0 = __ballot((el##j >> PSH_LOG) == s), b1 = __ballot((eh##j >> PSH_LOG) == s); \
    if (b0 | b1) { const u32x4 xa##j = *(const u32x4*)(xb16 + (size_t)row##j * D_MODEL + 16 * lane), xc##j = *(const u32x4*)(xb16 + (size_t)row##j * D_MODEL + 16 * lane + 8);     \
      const f32x2 x2[8] = {(f32x2){bflo(xa##j.x), bfhi(xa##j.x)}, (f32x2){bflo(xa##j.y), bfhi(xa##j.y)}, (f32x2){bflo(xa##j.z), bfhi(xa##j.z)}, (f32x2){bflo(xa##j.w), bfhi(xa##j.w)}, (f32x2){bflo(xc##j.x), bfhi(xc##j.x)}, (f32x2){bflo(xc##j.y), bfhi(xc##j.y)}, (f32x2){bflo(xc##j.z), bfhi(xc##j.z)}, (f32x2){bflo(xc##j.w), bfhi(xc##j.w)}}; \
      _Pragma("unroll 1") while ((b0 | b1) != 0ull) { int hk[8]; u32x4 uw[8], vw[8]; int nv = 0; \
        _Pragma("unroll") for (int k = 0; k < 8; ++k) { int h; if (b0) { h = __builtin_ctzll(b0); b0 &= b0 - 1; ++nv; } else if (b1) { h = 64 + __builtin_ctzll(b1); b1 &= b1 - 1; ++nv; } else h = hk[k > 0 ? k - 1 : 0]; \
            hk[k] = h; const int e = (h < 64) ? __builtin_amdgcn_readlane(el##j, h & 63) : __builtin_amdgcn_readlane(eh##j, h & 63); \
            uw[k] = *(const u32x4*)(U + (size_t)e * D_MODEL + 16 * lane); vw[k] = *(const u32x4*)(Vt + (size_t)e * D_MODEL + 16 * lane); } \
        float d[8]; _Pragma("unroll") for (int k = 0; k < 8; ++k) d[k] = dot16_fp8(uw[k], x2); \
        float e4[4], e2[2], e1s; \
          \
        { const bool hi = lane & 1; _Pragma("unroll") for (int i = 0; i < 4; ++i) { const float keep = hi ? d[4 + i] : d[i], send = hi ? d[i] : d[4 + i]; e4[i] = keep + dppf<0xB1>(send); } } \
        { const bool hi = lane & 2; _Pragma("unroll") for (int i = 0; i < 2; ++i) { const float keep = hi ? e4[2 + i] : e4[i], send = hi ? e4[i] : e4[2 + i]; e2[i] = keep + dppf<0x4E>(send); } } \
        { const bool hi = lane & 4; const float keep = hi ? e2[1] : e2[0], send = hi ? e2[0] : e2[1]; const float r4 = dppf<0x124>(send), r12 = dppf<0x12C>(send); e1s = keep + (hi ? r4 : r12); } \
        e1s += dppf<0x128>(e1s); e1s = colsum(e1s); \
        const int myk = 4 * (lane & 1) + (lane & 2) + ((lane >> 2) & 1); int myh = hk[0]; _Pragma("unroll") for (int k = 1; k < 8; ++k) myh = (myk == k) ? hk[k] : myh; \
        const float ga = __shfl(gl##j, myh & 63), gb = __shfl(gh##j, myh & 63); const float myg = (myk < nv) ? ((myh < 64) ? ga : gb) : 0.f;     \
        const float act = myg * gelu_tanh(e1s * (1.0f / PEER_SU)) * (1.0f / PEER_SV); \
        _Pragma("unroll") for (int k = 0; k < 8; ++k) { const int src = (k >> 2) | (((k >> 1) & 1) << 1) | ((k & 1) << 2); axpy16_fp8(vw[k], rdlane(act, src), oa##j); } } } }
#define PS2_LN(j) { const int r = row##j; f32x2 x2[8]; int ll = lane; asm volatile("" : "+v"(ll));     \
    _Pragma("unroll") for (int q = 0; q < 4; ++q) { const f32x4 a = *(const f32x4*)(xin + (size_t)r * D_MODEL + 16 * ll + 4 * q); x2[2 * q] = (f32x2){a.x, a.y}; x2[2 * q + 1] = (f32x2){a.z, a.w}; } \
    float sm = 0.f; _Pragma("unroll") for (int k = 0; k < 8; ++k) { oa##j[k] += x2[k] * ALPHA; sm += oa##j[k].x + oa##j[k].y; } \
    const float mu = wave_sum(sm) * (1.0f / D_MODEL); float s2 = 0.f; _Pragma("unroll") for (int k = 0; k < 8; ++k) { oa##j[k] -= mu; s2 += oa##j[k].x * oa##j[k].x + oa##j[k].y * oa##j[k].y; } \
    const float rs = 1.0f / sqrtf(wave_sum(s2) * (1.0f / D_MODEL) + LN_EPS); float* frow = fout + (size_t)r * D_MODEL; \
    _Pragma("unroll") for (int q = 0; q < 4; ++q) { const int c0 = 16 * ll + 4 * q; const f32x4 gv = *(const f32x4*)(gam + c0), bv = *(const f32x4*)(bet + c0); \
        const f32x4 y = (f32x4){oa##j[2 * q].x * rs, oa##j[2 * q].y * rs, oa##j[2 * q + 1].x * rs, oa##j[2 * q + 1].y * rs} * gv + bv; *(f32x4*)(frow + c0) = y; if (xb) *(u32x2*)(xb + (size_t)r * D_MODEL + c0) = pk4(y); } }
DI void peer_sharded2_phase(const FP& P, const Ctx& C, int layer, const float* xin, const bf16* xb16, float* fout, bf16* xb) {
    const int lane = C.lane; const unsigned char* U = P.UB8 + (size_t)layer * PEER_EXPERTS * D_MODEL; const unsigned char* Vt = P.VB8 + (size_t)layer * PEER_EXPERTS * D_MODEL;
    const float* gam = P.ln_g + ((size_t)layer * 2 + 1) * D_MODEL; const float* bet = P.ln_b + ((size_t)layer * 2 + 1) * D_MODEL;
    const int NW = C.G * NWAVES, gw = C.vcu * NWAVES + C.wave; const int nquads = (M0 / NW) / PS2_ROWS;
#pragma unroll 1
    for (int qd = 0; qd < nquads; ++qd) {
#if PS2_ROWS == 4
        PS2_ROW(0) PS2_ROW(1) PS2_ROW(2) PS2_ROW(3)
#pragma unroll 1
        for (int s = 0; s < PSH_N; ++s) { PS2_STEP(0) PS2_STEP(1) PS2_STEP(2) PS2_STEP(3) }
        PS2_LN(0) PS2_LN(1) PS2_LN(2) PS2_LN(3)
#else
        PS2_ROW(0) PS2_ROW(1)
#pragma unroll 1
        for (int s = 0; s < PSH_N; ++s) { PS2_STEP(0) PS2_STEP(1) }
        PS2_LN(0) PS2_LN(1)
#endif
    }
}
#define PS3_ROW(j) const int row##j = (qd * 4 + j) * NW + gw; const int el##j = P.SELE[(size_t)row##j * 128 + lane], eh##j = P.SELE[(size_t)row##j * 128 + 64 + lane]; \
    { const u32x4 xa = *(const u32x4*)(xb16 + (size_t)row##j * D_MODEL + 16 * lane), xc = *(const u32x4*)(xb16 + (size_t)row##j * D_MODEL + 16 * lane + 8); *(LAS u32x4*)(xs + j * 1024 + 16 * lane) = xa; *(LAS u32x4*)(xs + j * 1024 + 16 * lane + 8) = xc; } \
    f32x2 oa##j[8]; _Pragma("unroll") for (int k = 0; k < 8; ++k) oa##j[k] = (f32x2){0.f, 0.f};
#define PS3_X2_UNUSED(j) const f32x2 x2[8] = {(f32x2){bflo(xa##j.x), bfhi(xa##j.x)}, (f32x2){bflo(xa##j.y), bfhi(xa##j.y)}, (f32x2){bflo(xa##j.z), bfhi(xa##j.z)}, (f32x2){bflo(xa##j.w), bfhi(xa##j.w)}, (f32x2){bflo(xc##j.x), bfhi(xc##j.x)}, (f32x2){bflo(xc##j.y), bfhi(xc##j.y)}, (f32x2){bflo(xc##j.z), bfhi(xc##j.z)}, (f32x2){bflo(xc##j.w), bfhi(xc##j.w)}};
#define PS3_TAKE(q, M, ELH, GOFF) if (!got && M) { const int h = __builtin_ctzll(M); M &= M - 1; qq[k] = q; ee = __builtin_amdgcn_readlane(ELH, h); gk[k] = P.SELG[GOFF + h];     got = true; ++nv; }
DI void peer_sharded3_phase(const FP& P, const Ctx& C, int layer, const float* xin, const bf16* xb16, float* fout, bf16* xb) {
    const int lane = C.lane; const unsigned char* U = P.UB8 + (size_t)layer * PEER_EXPERTS * D_MODEL; const unsigned char* Vt = P.VB8 + (size_t)layer * PEER_EXPERTS * D_MODEL;
    const float* gam = P.ln_g + ((size_t)layer * 2 + 1) * D_MODEL; const float* bet = P.ln_b + ((size_t)layer * 2 + 1) * D_MODEL;
    const int NW = C.G * NWAVES, gw = C.vcu * NWAVES + C.wave; const int nquads = (M0 / NW) / 4; LAS bf16* xs = (LAS bf16*)(C.lds + C.wave * 16384);
#pragma unroll 1
    for (int qd = 0; qd < nquads; ++qd) {
        PS3_ROW(0) PS3_ROW(1) PS3_ROW(2) PS3_ROW(3)
        asm volatile("s_waitcnt lgkmcnt(0)" ::: "memory");
#pragma unroll 1
        for (int s = 0; s < PSH_N; ++s) {
            unsigned long long m0 = __ballot((el0 >> PSH_LOG) == s), m1 = __ballot((eh0 >> PSH_LOG) == s), m2 = __ballot((el1 >> PSH_LOG) == s), m3 = __ballot((eh1 >> PSH_LOG) == s),
                               m4 = __ballot((el2 >> PSH_LOG) == s), m5 = __ballot((eh2 >> PSH_LOG) == s), m6 = __ballot((el3 >> PSH_LOG) == s), m7 = __ballot((eh3 >> PSH_LOG) == s);
#pragma unroll 1
            while ((m0 | m1 | m2 | m3 | m4 | m5 | m6 | m7) != 0ull) {
                int qq[8]; float gk[8]; int es[8]; u32x4 uw[8]; int nv = 0; int elast = 0;
#pragma unroll
                for (int k = 0; k < 8; ++k) { bool got = false; int ee = elast; qq[k] = k > 0 ? qq[k - 1] : 0; gk[k] = 0.f;
                    PS3_TAKE(0, m0, el0, (size_t)row0 * 128) PS3_TAKE(1, m1, eh0, (size_t)row0 * 128 + 64) PS3_TAKE(2, m2, el1, (size_t)row1 * 128) PS3_TAKE(3, m3, eh1, (size_t)row1 * 128 + 64) PS3_TAKE(4, m4, el2, (size_t)row2 * 128) PS3_TAKE(5, m5, eh2, (size_t)row2 * 128 + 64) PS3_TAKE(6, m6, el3, (size_t)row3 * 128) PS3_TAKE(7, m7, eh3, (size_t)row3 * 128 + 64)
                    elast = ee; es[k] = ee; uw[k] = *(const u32x4*)(U + (size_t)ee * D_MODEL + 16 * lane); }
                float d[8];
#pragma unroll
                for (int k = 0; k < 8; ++k) { const int j = qq[k] >> 1; const u32x4 xa = *(const LAS u32x4*)(xs + j * 1024 + 16 * lane), xc = *(const LAS u32x4*)(xs + j * 1024 + 16 * lane + 8);
                    const f32x2 x2[8] = {(f32x2){bflo(xa.x), bfhi(xa.x)}, (f32x2){bflo(xa.y), bfhi(xa.y)}, (f32x2){bflo(xa.z), bfhi(xa.z)}, (f32x2){bflo(xa.w), bfhi(xa.w)}, (f32x2){bflo(xc.x), bfhi(xc.x)}, (f32x2){bflo(xc.y), bfhi(xc.y)}, (f32x2){bflo(xc.z), bfhi(xc.z)}, (f32x2){bflo(xc.w), bfhi(xc.w)}};
                    d[k] = dot16_fp8(uw[k], x2); }
                u32x4 vw[8];
#pragma unroll
                for (int k = 0; k < 8; ++k) vw[k] = *(const u32x4*)(Vt + (size_t)es[k] * D_MODEL + 16 * lane);
                float e4[4], e2[2], e1s;
                { const bool hi = lane & 1;
#pragma unroll
                  for (int i = 0; i < 4; ++i) { const float keep = hi ? d[4 + i] : d[i], send = hi ? d[i] : d[4 + i]; e4[i] = keep + __shfl_xor(send, 1); } }
                { const bool hi = lane & 2;
#pragma unroll
                  for (int i = 0; i < 2; ++i) { const float keep = hi ? e4[2 + i] : e4[i], send = hi ? e4[i] : e4[2 + i]; e2[i] = keep + __shfl_xor(send, 2); } }
                { const bool hi = lane & 4; const float keep = hi ? e2[1] : e2[0], send = hi ? e2[0] : e2[1]; e1s = keep + __shfl_xor(send, 4); }
                e1s += __shfl_xor(e1s, 8); e1s += __shfl_xor(e1s, 16); e1s += __shfl_xor(e1s, 32);
                const int myk = 4 * (lane & 1) + (lane & 2) + ((lane >> 2) & 1); float myg = gk[0];
#pragma unroll
                for (int k = 1; k < 8; ++k) myg = (myk == k) ? gk[k] : myg;
                const float act = myg * gelu_tanh(e1s * (1.0f / PEER_SU)) * (1.0f / PEER_SV);
#pragma unroll
                for (int k = 0; k < 8; ++k) { const int src = (k >> 2) | (((k >> 1) & 1) << 1) | ((k & 1) << 2); const float a = rdlane(act, src); const int j = qq[k] >> 1;
                    if (j == 0) { asm volatile("" ::: "memory"); axpy16_fp8(vw[k], a, oa0); } else if (j == 1) { asm volatile("" ::: "memory"); axpy16_fp8(vw[k], a, oa1); } else if (j == 2) { asm volatile("" ::: "memory"); axpy16_fp8(vw[k], a, oa2); } else { asm volatile("" ::: "memory"); axpy16_fp8(vw[k], a, oa3); } }
            }
        }
        PS2_LN(0) PS2_LN(1) PS2_LN(2) PS2_LN(3)
    }
}
}
namespace fx {
struct EpiB {
    static constexpr bool PERM = true, AFTER_DRAIN = false; const FP& P;
    DI void operator()(const f32x4 (&acc)[2][2][4][2], const pg8::Unit& u, int wr, int wc, int fr, int fq) const {
        const int t = u.pn;
        EPI_LOOP({ if (row < MP) { const int pos = row_pos(row), n = row / SEQ, e = ct & 63, dp = e >> 1; const bool prm = row < M0;
            if (t < 3) { const int ty = 2 * t + (ct >> 7), kvh = (ct >> 6) & 1;
                if (ty == 2 || ty == 4) { f32x4 lo, hi; rope4(P.ROPE + pos * 64, dp, v0, v1, lo, hi);
                    if (ty == 2) { float* o = (prm ? P.nsa_kv_p + (size_t)row * 512 : P.nsa_kv_s + (size_t)(row - M0) * 512) + 256 + kvh * 64 + dp; *(f32x4*)o = lo; *(f32x4*)(o + 32) = hi;
                        if (prm) { bf16* kt = P.SLK + ((size_t)n * NSA_KV_HEADS + kvh) * SEQ * 64; *(u32x2*)(kt + ktile_off(pos, dp)) = pk4(lo); *(u32x2*)(kt + ktile_off(pos, dp + 32)) = pk4(hi); } }
                    else { float* o = nullptr; if (!prm) o = P.win_s + (((size_t)(row - M0) * SWA_WINDOW + SWA_WINDOW - 1) * 2 + 0) * 128; else if (pos >= SEQ - SWA_WINDOW) o = P.win_p + (((size_t)n * SWA_WINDOW + pos - (SEQ - SWA_WINDOW)) * 2 + 0) * 128;
                        if (o) { *(f32x4*)(o + kvh * 64 + dp) = lo; *(f32x4*)(o + kvh * 64 + 32 + dp) = hi; }
                        if (prm) { bf16* kt = P.WNK + ((size_t)n * NSA_KV_HEADS + kvh) * SEQ * 64; *(u32x2*)(kt + ktile_off(pos, dp)) = pk4(lo); *(u32x2*)(kt + ktile_off(pos, dp + 32)) = pk4(hi); } } }
                else if (ty < 4) { float* o = (prm ? P.nsa_kv_p + (size_t)row * 512 : P.nsa_kv_s + (size_t)(row - M0) * 512) + ty * 128 + kvh * 64 + e; *(f32x4*)o = v0; *(f32x4*)(o + 4) = v1;
                    if (prm) { if (ty < 2) *(u32x4*)(P.AC + ((size_t)ty * ACROWS + ((size_t)n * NSA_KV_HEADS + kvh) * NCH + pos / 16) * 1024 + (pos % 16) * 64 + e) = pk8(v0, v1);
                        else { bf16* vt = P.SLVT + ((size_t)n * NSA_KV_HEADS + kvh) * SEQ * 64 + vtile_off(e, pos);
                            vt[0] = (bf16)f2bf(v0.x); vt[8] = (bf16)f2bf(v0.y); vt[16] = (bf16)f2bf(v0.z); vt[24] = (bf16)f2bf(v0.w); vt[32] = (bf16)f2bf(v1.x); vt[40] = (bf16)f2bf(v1.y); vt[48] = (bf16)f2bf(v1.z); vt[56] = (bf16)f2bf(v1.w); } } }
                else { float* o = nullptr; if (!prm) o = P.win_s + (((size_t)(row - M0) * SWA_WINDOW + SWA_WINDOW - 1) * 2 + 1) * 128; else if (pos >= SEQ - SWA_WINDOW) o = P.win_p + (((size_t)n * SWA_WINDOW + pos - (SEQ - SWA_WINDOW)) * 2 + 1) * 128;
                    if (o) { *(f32x4*)(o + kvh * 64 + e) = v0; *(f32x4*)(o + kvh * 64 + e + 4) = v1; }
                    if (prm) { bf16* vt = P.WNVT + ((size_t)n * NSA_KV_HEADS + kvh) * SEQ * 64 + vtile_off(e, pos);
                        vt[0] = (bf16)f2bf(v0.x); vt[8] = (bf16)f2bf(v0.y); vt[16] = (bf16)f2bf(v0.z); vt[24] = (bf16)f2bf(v0.w); vt[32] = (bf16)f2bf(v1.x); vt[40] = (bf16)f2bf(v1.y); vt[48] = (bf16)f2bf(v1.z); vt[56] = (bf16)f2bf(v1.w); } } }
            else if (t < 6) { const int h = (t - 3) * 4 + (ct >> 6); f32x4 lo, hi; rope4(P.ROPE + pos * 64, dp, v0, v1, lo, hi); bf16* q = P.QB + (size_t)row * NSA_Q_COLS + h * 64 + dp; *(u32x2*)q = pk4(lo * QSCALE); *(u32x2*)(q + 32) = pk4(hi * QSCALE); }
            else if (t == 6) { *(u32x4*)(P.MQB + (size_t)row * 256 + ct) = pk8(v0 * QSCALE, v1 * QSCALE); }
            else if (ct < 40) { const float vv[8] = {v0.x, v0.y, v0.z, v0.w, v1.x, v1.y, v1.z, v1.w};
                _Pragma("unroll") for (int i = 0; i < 8; ++i) if (ct + i < NSA_GATE_COLS) P.GATES[(size_t)row * 64 + ct + i] = 1.0f / (1.0f + __expf(-vv[i])); } } })
    }
};
DI void cmp2_phase(const FP& P, const Ctx& C) {
    const int lane = C.lane; LAS float* hs = (LAS float*)(C.lds + C.wave * 1024);
    constexpr int NGRP = NCTX * 2 * NSA_KV_HEADS; const int NW = C.G * NWAVES, WPG = NW / NGRP > 0 ? NW / NGRP : 1; const int gw = C.vcu * NWAVES + C.wave;
#pragma unroll 1
    for (int grp = gw / WPG; grp < NGRP; grp += (NW + WPG - 1) / WPG) { const int slot = gw % WPG; if (gw >= (NW / WPG) * WPG && grp == gw / WPG) break;
        const int kvh = grp % NSA_KV_HEADS, ty = (grp / NSA_KV_HEADS) % 2, ctx = grp / (2 * NSA_KV_HEADS);
        const float* UL = P.UL + ((size_t)ty * ACROWS + ((size_t)ctx * NSA_KV_HEADS + kvh) * NCH) * 256; const float* w2 = P.cmp_w2 + (size_t)ty * CMP_HIDDEN * HEAD_DIM;
        float w2r[CMP_HIDDEN];
#pragma unroll
        for (int k = 0; k < CMP_HIDDEN; ++k) w2r[k] = w2[k * HEAD_DIM + lane];
        const float b0 = P.CBIAS[ty * CMP_HIDDEN + lane], b1 = P.CBIAS[ty * CMP_HIDDEN + 64 + lane];
        float u0, u1, l0, l1; int c = slot;
        if (c < NCMP) { u0 = UL[(size_t)c * 256 + lane]; u1 = UL[(size_t)c * 256 + 64 + lane]; l0 = UL[(size_t)(c + 1) * 256 + 128 + lane]; l1 = UL[(size_t)(c + 1) * 256 + 192 + lane]; }
#pragma unroll 1
        for (; c < NCMP; c += WPG) { const float h0 = gelu_tanh(u0 + l0 + b0), h1 = gelu_tanh(u1 + l1 + b1); const int cn = c + WPG;
            if (cn < NCMP) { u0 = UL[(size_t)cn * 256 + lane]; u1 = UL[(size_t)cn * 256 + 64 + lane]; l0 = UL[(size_t)(cn + 1) * 256 + 128 + lane]; l1 = UL[(size_t)(cn + 1) * 256 + 192 + lane]; }
            hs[lane] = h0; hs[64 + lane] = h1; asm volatile("s_waitcnt lgkmcnt(0)" ::: "memory");
            float a = 0.f;
#pragma unroll
            for (int k4 = 0; k4 < CMP_HIDDEN / 4; ++k4) { const f32x4 hv = *(const LAS f32x4*)(hs + 4 * k4); a += hv.x * w2r[4 * k4] + hv.y * w2r[4 * k4 + 1] + hv.z * w2r[4 * k4 + 2] + hv.w * w2r[4 * k4 + 3]; }
            if (ty == 0) { const float other = __shfl_xor(a, 32); const int pos = c * CMP_STRIDE + CMP_BLOCK - 1; const float cs = P.ROPE[pos * 64 + (lane & 31)], sn = P.ROPE[pos * 64 + 32 + (lane & 31)];
                a = (lane < 32) ? a * cs - other * sn : a * cs + other * sn; }
            if (ctx < BATCH) { if (ty == 0) P.CK[((size_t)ctx * NSA_KV_HEADS + kvh) * NCH * 64 + ktile_off(c, lane)] = (bf16)f2bf(a); else P.CVT[((size_t)ctx * NSA_KV_HEADS + kvh) * NCH * 64 + vtile_off(lane, c)] = (bf16)f2bf(a); }
            else { (ty == 0 ? P.CKF : P.CVF)[(((size_t)(ctx - BATCH) * NSA_KV_HEADS + kvh) * NCH + c) * 64 + lane] = a; }
            asm volatile("s_waitcnt lgkmcnt(0)" ::: "memory"); }
    }
    __syncthreads();
}
constexpr int NSA_WLDS = 8192;
DI void nsa_pair_a(const FP& P, int n, int kvh, int t, int lane, LAS unsigned char* wl) {
    LAS float* pn = (LAS float*)wl; LAS float* imp = (LAS float*)(wl + 2048); LAS float* sc = (LAS float*)(wl + 6144); LAS int* sel = (LAS int*)(wl + 7168);
    const int col = lane & 15, c = lane >> 4; const bool vcol = col < 12; const int qq = vcol ? col / 6 : 0, hh = vcol ? col % 6 : 0, tq = t + qq, head = kvh * NSA_GROUP + hh, row = n * SEQ + tq;
    bf16x8 qf[2]; { const bf16* qp = P.QB + (size_t)row * NSA_Q_COLS + head * 64 + 8 * c; qf[0] = *(const bf16x8*)qp; qf[1] = *(const bf16x8*)(qp + 32); }
    const float* gt = P.GATES + (size_t)row * 64 + head * 3;
    f32x4 oacc[4] = {(f32x4){0.f, 0.f, 0.f, 0.f}, (f32x4){0.f, 0.f, 0.f, 0.f}, (f32x4){0.f, 0.f, 0.f, 0.f}, (f32x4){0.f, 0.f, 0.f, 0.f}};
    const int lim = vcol ? ((tq >= CMP_BLOCK - 1) ? (tq - (CMP_BLOCK - 1)) / CMP_STRIDE : -1) : -1;
    const int limmax = (t + 1 >= CMP_BLOCK - 1) ? (t + 1 - (CMP_BLOCK - 1)) / CMP_STRIDE : -1; const int nblk = (limmax + 32) / 32;
    const bf16* CKb = P.CK + ((size_t)n * NSA_KV_HEADS + kvh) * NCH * 64; const bf16* CVb = P.CVT + ((size_t)n * NSA_KV_HEADS + kvh) * 64 * NCH;
    for (int i = lane; i < 1024; i += 64) imp[i] = 0.f;
    float m1 = -INFINITY, l1 = 0.f;
    { struct K4 { bf16x8 a0, a1, b0, b1; };
      auto ldk = [&](K4& k, int blk) { const bf16* kt = CKb + (size_t)blk * 2048 + lane * 8; k.a0 = *(const bf16x8*)kt; k.a1 = *(const bf16x8*)(kt + 512); k.b0 = *(const bf16x8*)(kt + 1024); k.b1 = *(const bf16x8*)(kt + 1536); };
      auto cp1 = [&](const K4& k, int blk) { const int kb = 32 * blk;
        f32x4 s0 = (f32x4){0.f, 0.f, 0.f, 0.f}, s1 = (f32x4){0.f, 0.f, 0.f, 0.f};
        s0 = __builtin_amdgcn_mfma_f32_16x16x32_bf16(k.a0, qf[0], s0, 0, 0, 0); s0 = __builtin_amdgcn_mfma_f32_16x16x32_bf16(k.a1, qf[1], s0, 0, 0, 0);
        s1 = __builtin_amdgcn_mfma_f32_16x16x32_bf16(k.b0, qf[0], s1, 0, 0, 0); s1 = __builtin_amdgcn_mfma_f32_16x16x32_bf16(k.b1, qf[1], s1, 0, 0, 0);
        float s[8] = {s0.x, s0.y, s0.z, s0.w, s1.x, s1.y, s1.z, s1.w}; float mx = -INFINITY;
        const int hi1 = lim - (kb + 8 * c);
#pragma unroll
        for (int e = 0; e < 8; ++e) { s[e] = (e <= hi1) ? s[e] : -INFINITY; mx = fmaxf(mx, s[e]); }
        mx = colmax(mx);
        const float mnew = fmaxf(m1, mx), muse = (mnew == -INFINITY) ? 0.f : mnew; float ls = 0.f;
#pragma unroll
        for (int e = 0; e < 8; ++e) ls += __builtin_amdgcn_exp2f(s[e] - muse);
        l1 = l1 * __builtin_amdgcn_exp2f(m1 - muse) + ls; m1 = mnew; };
      if (nblk > 0) { K4 A, B; ldk(A, 0);
#pragma unroll 1
        for (int blk = 0; blk < nblk; blk += 2) { ldk(B, (blk + 1 < nblk) ? blk + 1 : blk); cp1(A, blk); ldk(A, (blk + 2 < nblk) ? blk + 2 : blk); if (blk + 1 < nblk) cp1(B, blk + 1); } } }
    asm volatile("s_waitcnt lgkmcnt(0)" ::: "memory");
    { l1 = colsum(l1); const float muse = (m1 == -INFINITY) ? 0.f : m1, inv = (l1 > 0.f) ? 1.0f / l1 : 0.f;
      f32x4 oc[4] = {(f32x4){0.f, 0.f, 0.f, 0.f}, (f32x4){0.f, 0.f, 0.f, 0.f}, (f32x4){0.f, 0.f, 0.f, 0.f}, (f32x4){0.f, 0.f, 0.f, 0.f}};
      pipe2(nblk, [&](KV8& kv, int blk) { kv_load_t(kv, CKb + (size_t)blk * 2048, CVb + (size_t)blk * 2048, lane); }, [&](const KV8& kv, int blk) { const int kb = 32 * blk;
        f32x4 s0 = (f32x4){0.f, 0.f, 0.f, 0.f}, s1 = (f32x4){0.f, 0.f, 0.f, 0.f};
        s0 = __builtin_amdgcn_mfma_f32_16x16x32_bf16(kv.ka0, qf[0], s0, 0, 0, 0); s0 = __builtin_amdgcn_mfma_f32_16x16x32_bf16(kv.ka1, qf[1], s0, 0, 0, 0);
        s1 = __builtin_amdgcn_mfma_f32_16x16x32_bf16(kv.kb0, qf[0], s1, 0, 0, 0); s1 = __builtin_amdgcn_mfma_f32_16x16x32_bf16(kv.kb1, qf[1], s1, 0, 0, 0);
        float s[8] = {s0.x, s0.y, s0.z, s0.w, s1.x, s1.y, s1.z, s1.w};
        const int hi2 = lim - (kb + 8 * c);
#pragma unroll
        for (int e = 0; e < 8; ++e) s[e] = (e <= hi2) ? __builtin_amdgcn_exp2f(s[e] - muse) * inv : 0.f;
        *(f32x4*)(pn + col * 32 + 8 * c) = (f32x4){s[0], s[1], s[2], s[3]}; *(f32x4*)(pn + col * 32 + 8 * c + 4) = (f32x4){s[4], s[5], s[6], s[7]};
        u32x4 pw; pw.x = cvtpk(s[0], s[1]); pw.y = cvtpk(s[2], s[3]); pw.z = cvtpk(s[4], s[5]); pw.w = cvtpk(s[6], s[7]); const bf16x8 pf = __builtin_bit_cast(bf16x8, pw);
        oc[0] = __builtin_amdgcn_mfma_f32_16x16x32_bf16(kv.v0, pf, oc[0], 0, 0, 0); oc[1] = __builtin_amdgcn_mfma_f32_16x16x32_bf16(kv.v1, pf, oc[1], 0, 0, 0);
        oc[2] = __builtin_amdgcn_mfma_f32_16x16x32_bf16(kv.v2, pf, oc[2], 0, 0, 0); oc[3] = __builtin_amdgcn_mfma_f32_16x16x32_bf16(kv.v3, pf, oc[3], 0, 0, 0);
        asm volatile("s_waitcnt lgkmcnt(0)" ::: "memory");
        { const int q2 = lane >> 5, k = lane & 31; float a = 0.f;
#pragma unroll
          for (int h6 = 0; h6 < 6; ++h6) a += pn[(q2 * 6 + h6) * 32 + k];
          imp[q2 * 512 + kb + k] = a; }
        asm volatile("s_waitcnt lgkmcnt(0)" ::: "memory"); });
#ifdef NSA_DEBUG
      if (vcol) { for (int db = 0; db < 4; ++db) *(f32x4*)(P.DBG + ((size_t)0 * MP + row) * 768 + head * 64 + 16 * db + 4 * c) = oc[db]; }
#endif
      const float g0 = vcol ? gt[0] : 0.f;
#pragma unroll
      for (int db = 0; db < 4; ++db) oacc[db] += oc[db] * g0; }
#ifndef REP_SEL
#define REP_SEL 1
#endif
#pragma unroll 1
    for (int rep = 0; rep < REP_SEL; ++rep) {
    for (int i = lane; i < 256; i += 64) { const int q2 = i >> 7, b = i & 127, tq2 = t + q2, cur = tq2 / SLC_BLOCK; float sv;
        if (b > cur) sv = NEG; else if (b == 0 || b == cur || b == cur - 1) sv = FORCE_SCORE;
        else { const LAS float* ic = imp + q2 * 512 + 4 * b; sv = ic[-1] + 2.f * (ic[0] + ic[1] + ic[2]) + ic[3]; }
        sc[i] = pack_key(sv, 127u - (unsigned)b, 127u); }
    asm volatile("s_waitcnt lgkmcnt(0)" ::: "memory");
    for (int i = lane; i < 256; i += 64) { const int q2 = i >> 7, b = i & 127; const float sv = sc[i]; int rank = 0;
        for (int j = 0; j < 128; j += 4) { const f32x4 o = *(const LAS f32x4*)(sc + q2 * 128 + j);
            rank += (o.x > sv) ? 1 : 0; rank += (o.y > sv) ? 1 : 0; rank += (o.z > sv) ? 1 : 0; rank += (o.w > sv) ? 1 : 0; }
        if (rank < SLC_TOPK) { const int v = (sv > 0.5f * NEG) ? b : -1; sel[q2 * 16 + rank] = v; P.SELB[((size_t)(n * SEQ + t + q2) * NSA_KV_HEADS + kvh) * 16 + rank] = v; } }
    asm volatile("s_waitcnt lgkmcnt(0)" ::: "memory");
    }
#ifndef REP_WIN
#define REP_WIN 1
#endif
#pragma unroll 1
    for (int rep = 0; rep < REP_WIN; ++rep) { Tile16 T; tile_init(T);
      const bf16* WKb = P.WNK + ((size_t)n * NSA_KV_HEADS + kvh) * SEQ * 64; const bf16* WVb = P.WNVT + ((size_t)n * NSA_KV_HEADS + kvh) * 64 * SEQ;
      const int blo = (t - SWA_WINDOW) >> 5, bhi = (t + 1) >> 5;
      auto ld = [&](KV8& kv, int blk) { const int bc = blk < 0 ? 0 : blk; kv_load_t(kv, WKb + (size_t)bc * 2048, WVb + (size_t)bc * 2048, lane); };
      pipe2(bhi - blo + 1, [&](KV8& kv, int i) { ld(kv, blo + i); }, [&](const KV8& kv, int i) { const int kb = 32 * (blo + i);
          const int k0 = kb + 8 * c; int lo; unsigned rng; const int a = tq - SWA_WINDOW; mk_range((a > 0 ? a : 0) - k0, tq - k0, vcol, lo, rng); tile_compute(T, qf, kv, lo, rng); });
      T.l = colsum(T.l);
      const float inv = (T.l > 0.f) ? 1.0f / T.l : 0.f, g2 = vcol ? gt[2] * inv : 0.f;
#ifdef NSA_DEBUG
      if (vcol) { for (int db = 0; db < 4; ++db) *(f32x4*)(P.DBG + ((size_t)2 * MP + row) * 768 + head * 64 + 16 * db + 4 * c) = T.o[db] * inv; }
#endif
#pragma unroll
      for (int db = 0; db < 4; ++db) if (rep == REP_WIN - 1) oacc[db] += T.o[db] * g2; }
    if (vcol) { float* op = P.DPART + (size_t)row * 768 + head * 64 + 4 * c;
#pragma unroll
        for (int db = 0; db < 4; ++db) *(f32x4*)(op + 16 * db) = oacc[db]; }
}
DI void nsa_pair_b(const FP& P, int n, int kvh, int t, int lane, LAS unsigned char* wl) {
    LAS int* steps = (LAS int*)wl;
    const int col = lane & 15, c = lane >> 4; const bool vcol = col < 12; const int qq = vcol ? col / 6 : 0, hh = vcol ? col % 6 : 0, tq = t + qq, head = kvh * NSA_GROUP + hh, row = n * SEQ + tq;
    bf16x8 qf[2]; { const bf16* qp = P.QB + (size_t)row * NSA_Q_COLS + head * 64 + 8 * c; qf[0] = *(const bf16x8*)qp; qf[1] = *(const bf16x8*)(qp + 32); }
    const float* gt = P.GATES + (size_t)row * 64 + head * 3;
    Tile16 T; tile_init(T);
    const bf16* SKb = P.SLK + ((size_t)n * NSA_KV_HEADS + kvh) * SEQ * 64; const bf16* SVb = P.SLVT + ((size_t)n * NSA_KV_HEADS + kvh) * SEQ * 64;
    int ns = 0;
    { const int mysel = (lane < 32) ? P.SELB[((size_t)(n * SEQ + t + (lane >> 4)) * NSA_KV_HEADS + kvh) * 16 + (lane & 15)] : -1;
      for (int i = 0; i < 32; ++i) { const int b = __builtin_amdgcn_readlane(mysel, i); if (b < 0) continue; int q2 = i >> 4;
          const unsigned long long other = __ballot(mysel == b && lane < 32 && (lane >> 4) != q2);
          if (other) { if (q2 == 1) continue; q2 = 2; }
          if (lane == 0) { steps[ns] = (b * SLC_BLOCK) | (q2 << 29); steps[ns + 1] = (b * SLC_BLOCK + 32) | (q2 << 29); } ns += 2; } }
    asm volatile("s_waitcnt lgkmcnt(0)" ::: "memory");
    auto ld = [&](KV8& kv, int i) { const int code = __builtin_amdgcn_readfirstlane(steps[i]); const int kb = code & 0x1fffffff;
        kv_load_t(kv, SKb + (size_t)(kb >> 5) * 2048, SVb + (size_t)(kb >> 5) * 2048, lane); };
#ifdef PROBE_DBLCOMP
    Tile16 T2; tile_init(T2);
#endif
    pipe2(ns, ld, [&](const KV8& kv, int i) { const int code = __builtin_amdgcn_readfirstlane(steps[i]); const int kb = code & 0x1fffffff, q2 = code >> 29;
        int lo; unsigned rng; mk_range(-64, tq - (kb + 8 * c), vcol && (q2 == 2 || qq == q2), lo, rng); tile_compute(T, qf, kv, lo, rng);
#ifdef PROBE_DBLCOMP
        tile_compute(T2, qf, kv, [&](int e) { return vcol && qq == q2 && (kb + 8 * c + e + 1) <= tq; });
#endif
    });
#ifdef PROBE_DBLCOMP
    if (T2.l < 0.f) T.l = 0.f;
#endif
    T.l = colsum(T.l);
    const float inv = (T.l > 0.f) ? 1.0f / T.l : 0.f, g1 = vcol ? gt[1] * inv : 0.f;
#ifdef NSA_DEBUG
    if (vcol) { for (int db = 0; db < 4; ++db) *(f32x4*)(P.DBG + ((size_t)1 * MP + row) * 768 + head * 64 + 16 * db + 4 * c) = T.o[db] * inv; }
#endif
    if (vcol) { const float* pp = P.DPART + (size_t)row * 768 + head * 64 + 4 * c; bf16* op = P.ATTB + (size_t)row * 1024 + head * 64 + 4 * c;
#pragma unroll
        for (int db = 0; db < 4; ++db) *(u32x2*)(op + 16 * db) = pk4(*(const f32x4*)(pp + 16 * db) + T.o[db] * g1); }
}

constexpr int SMP_SK = 1088;
template <class KF, class VF> DI void smp_branch(const Ctx& C, LAS float* qs, LAS float* S, LAS float* red, int NK, KF kf, VF vf, bool keep_probs, float (&outh)[1]) {
    const int tid = C.tid, lane = C.lane, w = C.wave;
#pragma unroll 1
    for (int j = tid; j < NK; j += NTHREADS) { const float* k = kf(j); f32x4 kr[16];
#pragma unroll
        for (int d4 = 0; d4 < 16; ++d4) kr[d4] = *(const f32x4*)(k + 4 * d4);
#pragma unroll 1
        for (int h = 0; h < 6; ++h) { float a = 0.f;
#pragma unroll
            for (int d4 = 0; d4 < 16; ++d4) { const f32x4 qv = *(const LAS f32x4*)(qs + h * 64 + 4 * d4); a += kr[d4].x * qv.x + kr[d4].y * qv.y + kr[d4].z * qv.z + kr[d4].w * qv.w; }
            S[h * SMP_SK + j] = a; } }
    asm volatile("s_waitcnt lgkmcnt(0)" ::: "memory"); __syncthreads();
    if (w < 6) { float m = -INFINITY; for (int j = lane; j < NK; j += 64) m = fmaxf(m, S[w * SMP_SK + j]); m = wave_max(m);
        float l = 0.f; for (int j = lane; j < NK; j += 64) { const float p = __builtin_amdgcn_exp2f(S[w * SMP_SK + j] - m); S[w * SMP_SK + j] = p; l += p; } l = wave_sum(l);
        const float inv = 1.0f / l; for (int j = lane; j < NK; j += 64) S[w * SMP_SK + j] *= inv; }
    asm volatile("s_waitcnt lgkmcnt(0)" ::: "memory"); __syncthreads();
    { const int per = (NK + NWAVES - 1) / NWAVES, j0 = w * per, j1 = (j0 + per < NK) ? j0 + per : NK; float o[6] = {0.f, 0.f, 0.f, 0.f, 0.f, 0.f};
#pragma unroll 1
      for (int j = j0; j < j1; j += 8) { float vv[8];
#pragma unroll
          for (int u = 0; u < 8; ++u) { const int jj = (j + u < j1) ? j + u : j1 - 1; vv[u] = vf(jj)[lane]; }
#pragma unroll
          for (int u = 0; u < 8; ++u) if (j + u < j1) {
#pragma unroll
              for (int h = 0; h < 6; ++h) o[h] += S[h * SMP_SK + j + u] * vv[u]; } }
#pragma unroll
      for (int h = 0; h < 6; ++h) red[(w * 6 + h) * 64 + lane] = o[h]; }
    asm volatile("s_waitcnt lgkmcnt(0)" ::: "memory"); __syncthreads();
    outh[0] = 0.f;
    if (tid < 384) { float a = 0.f;
#pragma unroll
        for (int ww = 0; ww < NWAVES; ++ww) a += red[ww * 384 + tid]; outh[0] = a; }
    if (!keep_probs) { __syncthreads(); }
}
DI void nsa_sample_item(const FP& P, const Ctx& C, int ns, int kvh) {
    LAS float* qs = (LAS float*)C.lds; LAS float* S = qs + 384; LAS float* red = S + 6 * SMP_SK; LAS float* scs = red + 8 * 384; LAS int* sel = (LAS int*)(scs + 136);
    const int tid = C.tid, row = M0 + ns;
    if (tid < 384) qs[tid] = bf2f(P.QB[(size_t)row * NSA_Q_COLS + kvh * 384 + tid]);
    asm volatile("s_waitcnt lgkmcnt(0)" ::: "memory"); __syncthreads();
    const float* ckf = P.CKF + ((size_t)ns * NSA_KV_HEADS + kvh) * NCH * 64; const float* cvf = P.CVF + ((size_t)ns * NSA_KV_HEADS + kvh) * NCH * 64;
    float oc[1], os[1], ow[1];
    smp_branch(C, qs, S, red, NCMP, [&](int j) { return ckf + (size_t)j * 64; }, [&](int j) { return cvf + (size_t)j * 64; }, true, oc);
    constexpr int NBS = (PAST_LEN + 1 + SLC_BLOCK - 1) / SLC_BLOCK, CURS = PAST_LEN / SLC_BLOCK;
    for (int b = tid; b < 136; b += NTHREADS) { float sv = -3.0e38f;
        if (b < NBS) { if (b == 0 || b == CURS || b == CURS - 1) sv = FORCE_SCORE; else { float a = 0.f;
#pragma unroll
                for (int o = -1; o <= 3; ++o) { const int ci = 4 * b + o; if (ci >= 0 && ci < NCMP) { float sm = 0.f; for (int h6 = 0; h6 < 6; ++h6) sm += S[h6 * SMP_SK + ci]; a += ((o >= 0 && o <= 2) ? 2.f : 1.f) * sm; } }
                sv = a; } }
        scs[b] = sv; }
    asm volatile("s_waitcnt lgkmcnt(0)" ::: "memory"); __syncthreads();
    for (int b = tid; b < NBS; b += NTHREADS) { const float sv = scs[b]; int rank = 0; for (int j = 0; j < NBS; ++j) { const float o = scs[j]; rank += (o > sv || (o == sv && j < b)) ? 1 : 0; }
        if (rank < SLC_TOPK) { sel[rank] = b; P.SELB[((size_t)row * NSA_KV_HEADS + kvh) * 16 + rank] = b; } }
    asm volatile("s_waitcnt lgkmcnt(0)" ::: "memory"); __syncthreads();
    { const float* newrow = P.nsa_kv_s + (size_t)ns * 512; const int* pt = P.page_table + ns * (PAST_LEN / PAGE_SIZE);
      if (tid == 0) { int seen = 0; for (int x = 0; x < SLC_TOPK; ++x) { const int bx = sel[x]; if (bx != CURS && seen < 15) sel[16 + seen++] = bx; } }
      asm volatile("s_waitcnt lgkmcnt(0)" ::: "memory"); __syncthreads();
      auto krow = [&](int j, int ty) -> const float* { if (j >= 15 * 64) return newrow + ty * 128 + kvh * 64;
          const int t0 = sel[16 + (j >> 6)] * SLC_BLOCK + (j & 63); const int pg = pt[t0 / PAGE_SIZE]; return P.cache_nsa_kv + ((size_t)pg * PAGE_SIZE + t0 % PAGE_SIZE) * 512 + ty * 128 + kvh * 64; };
      smp_branch(C, qs, S, red, 15 * 64 + 1, [&](int j) { return krow(j, 2); }, [&](int j) { return krow(j, 3); }, false, os); }
    { const float* wc = P.cache_nsa_win + (size_t)ns * SWA_WINDOW * 256; const float* newrow = P.win_s + ((size_t)ns * SWA_WINDOW + SWA_WINDOW - 1) * 256;
      smp_branch(C, qs, S, red, SWA_WINDOW + 1, [&](int j) { return (j < SWA_WINDOW ? wc + (size_t)j * 256 : newrow) + kvh * 64; }, [&](int j) { return (j < SWA_WINDOW ? wc + (size_t)j * 256 : newrow) + 128 + kvh * 64; }, false, ow); }
    if (tid < 384) { const int head = kvh * NSA_GROUP + tid / 64; const float* gt = P.GATES + (size_t)row * 64 + head * 3;
        P.ATTB[(size_t)row * 1024 + kvh * 384 + tid] = (bf16)f2bf(gt[0] * oc[0] + gt[1] * os[0] + gt[2] * ow[0]);
#ifdef NSA_DEBUG
        P.DBG[((size_t)0 * MP + row) * 768 + kvh * 384 + tid] = oc[0]; P.DBG[((size_t)1 * MP + row) * 768 + kvh * 384 + tid] = os[0]; P.DBG[((size_t)2 * MP + row) * 768 + kvh * 384 + tid] = ow[0];
#endif
    }
    __syncthreads();
}
DI void nsa_pairs(const FP& P, const Ctx& C, bool second) {
    LAS unsigned char* wl = C.lds + C.wave * NSA_WLDS;
    const int per = C.G / 4 > 0 ? C.G / 4 : 1, grp = (C.vcu / per) & 3, sub = C.vcu % per, n = grp >> 1, kvh = grp & 1;
#pragma unroll 1
    for (int pr = sub * NWAVES + C.wave; pr < SEQ / 2; pr += per * NWAVES) { if (second) nsa_pair_b(P, n, kvh, 2 * pr, C.lane, wl); else nsa_pair_a(P, n, kvh, 2 * pr, C.lane, wl); }
}
DI void nsa_phase_a(const FP& P, const Ctx& C) {
    for (int it = C.vcu; it < DEC_BATCH * NSA_KV_HEADS; it += C.G) nsa_sample_item(P, C, it / NSA_KV_HEADS, it % NSA_KV_HEADS);
    nsa_pairs(P, C, false);
    __syncthreads();
}
DI void nsa_phase_b(const FP& P, const Ctx& C) {
    const int lane = C.lane, w = C.wave;
    nsa_pairs(P, C, true);
    __syncthreads();
    { constexpr int NMT = (M0 / 16) * MEM_HEADS;
      for (int it = C.vcu * NWAVES + w; it < NMT; it += C.G * NWAVES) { const int h = it % MEM_HEADS, q16 = it / MEM_HEADS, row0 = q16 * 16, n = row0 / SEQ;
          mem_micro(P, P.MQB + h * 64, 256, row0, 1, n, h, P.ATTB + NSA_Q_COLS + h * 64, 1024, lane); }
    }
    { LAS float* qs = (LAS float*)C.lds;
      for (int it = C.vcu; it < DEC_BATCH * MEM_HEADS; it += C.G) { const int h = it % MEM_HEADS, ns = it / MEM_HEADS, row = M0 + ns;
          __syncthreads(); if (C.tid < 64) qs[C.tid] = bf2f(P.MQB[(size_t)row * 256 + h * 64 + C.tid]); asm volatile("s_waitcnt lgkmcnt(0)" ::: "memory"); __syncthreads();
          Dec D; D.m = -INFINITY; D.l = 0.f; D.o = 0.f; const float* mk = P.cache_mem_kv + ((size_t)1 * DEC_BATCH + ns) * MEM_TOKENS * 512;
          for (int ck = w; ck < MEM_TOKENS / 64; ck += NWAVES) { const int j0 = ck * 64; dec_chunk(D, qs, 64, [&](int j) { return mk + (size_t)(j0 + j) * 512 + h * 64; }, [&](int j) { return mk + (size_t)(j0 + j) * 512 + 256 + h * 64; }, lane); }
          const float o = dec_combine(C, D);
          if (w == 0) P.ATTB[(size_t)row * 1024 + NSA_Q_COLS + h * 64 + lane] = (bf16)f2bf(o); } }
    __syncthreads();
}
}
namespace fx {
enum { PH_PRO = 0, PH_G1, PH_ATTA, PH_G2, PH_LN1, PH_SC0, PH_TK0, PH_PU0, PH_PG0, PH_G3, PH_CMPG, PH_CMP2, PH_NSA, PH_NSB, PH_G4, PH_LN3, PH_SC1, PH_TK1, PH_PU1, PH_PG1, PH_COUNT };
template <class Epi> DI void run_gemm(const Ctx& C, const bf16* A, const bf16* Bt, int M, int N, int K, const Epi& E) {
    pg8::Gemm g{A, Bt, M, N, K}; pg8::StaticOrder S; S.init(M, N, C.G, (int)blockIdx.x);
    pg8::gemm_phase<Epi, pg8::StaticOrder, true, true>(C.lds, g, S, E);
}
template <class Epi> DI void skinny_gemm(const Ctx& C, const bf16* A, const bf16* Bt, int N, int K, const Epi& E) {
    static_assert(DEC_BATCH == 32 && M0 % 256 == 0, "skinny_gemm: 32 sample rows right after a whole number of 256-row tiles");
    const int lane = C.lane, fr = lane & 15, fq = lane >> 4, w = C.wave; const int NI = (N / 256) * 4, KW = K / NWAVES;
    LAS f32x4* red = (LAS f32x4*)C.lds;
#pragma unroll 1
    for (int item = C.vcu; item < NI; item += C.G) { const int pn = item >> 2, wc = item & 3;
        f32x4 pa[2][2][2];
#pragma unroll
        for (int i = 0; i < 8; ++i) (&pa[0][0][0])[i] = (f32x4){0.f, 0.f, 0.f, 0.f};
        const bf16* xa = A + (size_t)(M0 + fr) * K + w * KW + 8 * fq; const bf16* xb = xa + (size_t)16 * K;
        const bf16* wp[2][2];
#pragma unroll
        for (int bj = 0; bj < 2; ++bj)
#pragma unroll
            for (int n = 0; n < 2; ++n) wp[bj][n] = Bt + (size_t)(pn * 256 + bj * 128 + wc * 32 + 8 * (fr >> 2) + 4 * n + (fr & 3)) * K + w * KW + 8 * fq;
#pragma unroll 4
        for (int k0 = 0; k0 < KW; k0 += 32) { const bf16x8 x0 = *(const bf16x8*)(xa + k0), x1 = *(const bf16x8*)(xb + k0);
#pragma unroll
            for (int bj = 0; bj < 2; ++bj)
#pragma unroll
                for (int n = 0; n < 2; ++n) { const bf16x8 wf = *(const bf16x8*)(wp[bj][n] + k0);
                    pa[bj][0][n] = __builtin_amdgcn_mfma_f32_16x16x32_bf16(wf, x0, pa[bj][0][n], 0, 0, 0); pa[bj][1][n] = __builtin_amdgcn_mfma_f32_16x16x32_bf16(wf, x1, pa[bj][1][n], 0, 0, 0); } }
        __syncthreads();
#pragma unroll
        for (int bj = 0; bj < 2; ++bj)
#pragma unroll
            for (int mm = 0; mm < 2; ++mm)
#pragma unroll
                for (int n = 0; n < 2; ++n) red[(w * 8 + bj * 4 + mm * 2 + n) * 64 + lane] = pa[bj][mm][n];
        asm volatile("s_waitcnt lgkmcnt(0)" ::: "memory"); __syncthreads();
        if (w == 0) { f32x4 acc[2][2][4][2];
#pragma unroll
            for (int i = 0; i < 32; ++i) (&acc[0][0][0][0])[i] = (f32x4){0.f, 0.f, 0.f, 0.f};
#pragma unroll
            for (int bj = 0; bj < 2; ++bj)
#pragma unroll
                for (int mm = 0; mm < 2; ++mm)
#pragma unroll
                    for (int n = 0; n < 2; ++n) { f32x4 s = red[(bj * 4 + mm * 2 + n) * 64 + lane];
#pragma unroll 1
                        for (int ww = 1; ww < NWAVES; ++ww) s += red[(ww * 8 + bj * 4 + mm * 2 + n) * 64 + lane];
                        acc[0][bj][mm][n] = s; }
            E(acc, pg8::Unit{M0 / 256, pn}, 0, wc, fr, fq); }
    }
    __syncthreads();
}
__global__ void __launch_bounds__(NTHREADS, 2) mega(Args args) {
    extern __shared__ __attribute__((aligned(16))) unsigned char lds_raw[];
    Ctx C; C.lds = (LAS unsigned char*)lds_raw; C.tid = threadIdx.x; C.lane = C.tid & 63; C.wave = __builtin_amdgcn_readfirstlane(C.tid >> 6);
    C.G = gridDim.x; { const int bx = blockIdx.x; C.vcu = (C.G % 8 == 0) ? (bx % 8) * (C.G / 8) + bx / 8 : bx; }
    const FP& P = args.p;
    volatile LAS unsigned* MISC = (volatile LAS unsigned*)(C.lds + MISC_OFF);
    for (int u = C.tid; u < (LDS_BYTES - RING_BYTES) / 4; u += NTHREADS) ((LAS unsigned*)(C.lds + RING_BYTES))[u] = 0u;
    __syncthreads();
    const int lo = args.lo, hi = args.hi;
    XcdBarrier bar; bar.bar = P.ctl + 1024; bar.x = 0; bar.st = nullptr;
    if (hi - lo > 1) bar = xcd_barrier_post(P.ctl + 1024, MISC + 8);
#define IN(k) (lo <= (k) && (k) < hi)
#define SEAM(k) do { if (IN(k) && IN((k) + 1)) xcd_barrier(bar); } while (0)
#ifndef DUP_PHASE
#define DUP_PHASE -1
#endif
#define PHASE(k, ...) do { if (IN(k)) { __VA_ARGS__ if (DUP_PHASE == (k)) { __syncthreads(); __VA_ARGS__ } } SEAM(k); } while (0)
    PHASE(PH_PRO, p0_prologue(P, C); __syncthreads(); p0_wpk(P, C););
    PHASE(PH_G1, run_gemm(C, P.XB0, P.WA_T, M0, ACOLS, D_MODEL, EpiA{P}); run_gemm(C, P.MEMB, P.WMEM_T, BATCH * MEM_TOKENS, 1024, D_MODEL, EpiMem{P}); skinny_gemm(C, P.XB0, P.WA_T, ACOLS, D_MODEL, EpiA{P}););
#ifdef PEER_SHARD3
#define PEER_SHARDED_FN peer_sharded3_phase
#else
#define PEER_SHARDED_FN peer_sharded2_phase
#endif
    PHASE(PH_ATTA, atta_phase(P, C););
    PHASE(PH_G2, run_gemm(C, P.ATTA, P.WOA_T, M0, D_MODEL, 512, EpiPre{P.x_prompt, P.x_sample, P.PRE}); skinny_gemm(C, P.ATTA, P.WOA_T, D_MODEL, 512, EpiPre{P.x_prompt, P.x_sample, P.PRE}););
    PHASE(PH_LN1, ln_phase(P, C, P.PRE, P.ln_g, P.ln_b, P.X1, P.X1B, nullptr, nullptr););
    PHASE(PH_SC0, run_gemm(C, P.X1B, P.WPK_T, M0, NPK, D_MODEL, EpiF32{P.SCO, NPK, MP}); skinny_gemm(C, P.X1B, P.WPK_T, NPK, D_MODEL, EpiF32{P.SCO, NPK, MP}););
    PHASE(PH_TK0, topk_phase(P, C););
#ifdef PEER_SPLIT
    PHASE(PH_PU0, peer_u_phase(P, C, 0, P.X1B););
    PHASE(PH_PG0, peer_v_phase(P, C, 0, P.X1, P.X2, P.X2 + (size_t)M0 * D_MODEL, P.X2B););
#elif defined(PEER_SHARD2)
    PHASE(PH_PG0, const bool shd = (M0 % (C.G * NWAVES * PS2_ROWS)) == 0; if (shd) { PEER_SHARDED_FN(P, C, 0, P.X1, P.X1B, P.X2, P.X2B); __syncthreads(); } peer_phase(P, C, 0, P.X1, P.X2, P.X2 + (size_t)M0 * D_MODEL, P.X2B, shd););
#elif defined(PEER_SHARD)
    PHASE(PH_PG0, peer_sharded_phase(P, C, 0, P.X1, P.X1B, P.X2, P.X2 + (size_t)M0 * D_MODEL, P.X2B); __syncthreads(); peer_phase(P, C, 0, P.X1, P.X2, P.X2 + (size_t)M0 * D_MODEL, P.X2B););
#else
    PHASE(PH_PG0, peer_phase(P, C, 0, P.X1, P.X2, P.X2 + (size_t)M0 * D_MODEL, P.X2B););
#endif
    PHASE(PH_G3, run_gemm(C, P.X2B, P.WB_T, M0, NB_T, D_MODEL, EpiB{P}); skinny_gemm(C, P.X2B, P.WB_T, NB_T, D_MODEL, EpiB{P}););
    PHASE(PH_CMPG, run_gemm(C, P.AC, P.CW1_T, ACROWS, 256, 1024, EpiF32{P.UL, 256, ACROWS}); run_gemm(C, P.AC + (size_t)ACROWS * 1024, P.CW1_T + 256 * 1024, ACROWS, 256, 1024, EpiF32{P.UL + (size_t)ACROWS * 256, 256, ACROWS}););
    PHASE(PH_CMP2, cmp2_phase(P, C););
    PHASE(PH_NSA, nsa_phase_a(P, C););
    PHASE(PH_NSB, nsa_phase_b(P, C););
    PHASE(PH_G4, run_gemm(C, P.ATTB, P.WOB_T, M0, D_MODEL, 1024, EpiPre{P.X2, nullptr, P.PRE}); skinny_gemm(C, P.ATTB, P.WOB_T, D_MODEL, 1024, EpiPre{P.X2, nullptr, P.PRE}););
    PHASE(PH_LN3, ln_phase(P, C, P.PRE, P.ln_g + 2 * D_MODEL, P.ln_b + 2 * D_MODEL, P.X3, P.X3B, nullptr, nullptr););
    PHASE(PH_SC1, run_gemm(C, P.X3B, P.WPK_T + (size_t)NPK * D_MODEL, M0, NPK, D_MODEL, EpiF32{P.SCO, NPK, MP}); skinny_gemm(C, P.X3B, P.WPK_T + (size_t)NPK * D_MODEL, NPK, D_MODEL, EpiF32{P.SCO, NPK, MP}););
    PHASE(PH_TK1, topk_phase(P, C););
#ifdef PEER_SPLIT
    PHASE(PH_PU1, peer_u_phase(P, C, 1, P.X3B););
    PHASE(PH_PG1, peer_v_phase(P, C, 1, P.X3, P.y_prompt, P.y_sample, nullptr););
#elif defined(PEER_SHARD2)
    PHASE(PH_PG1, const bool shd = (M0 % (C.G * NWAVES * PS2_ROWS)) == 0; if (shd) { PEER_SHARDED_FN(P, C, 1, P.X3, P.X3B, P.y_prompt, nullptr); __syncthreads(); } peer_phase(P, C, 1, P.X3, P.y_prompt, P.y_sample, nullptr, shd););
#elif defined(PEER_SHARD)
    PHASE(PH_PG1, peer_sharded_phase(P, C, 1, P.X3, P.X3B, P.y_prompt, P.y_sample, nullptr); __syncthreads(); peer_phase(P, C, 1, P.X3, P.y_prompt, P.y_sample, nullptr););
#else
    PHASE(PH_PG1, peer_phase(P, C, 1, P.X3, P.y_prompt, P.y_sample, nullptr););
#endif
#undef IN
#undef SEAM
}
}
#ifndef ONE_LAUNCH
#define ONE_LAUNCH 1
#endif
extern "C" void kernel_launch(void* const* d_in, const int* in_sizes, int n_in, void* d_out, int out_size, void* d_ws, size_t ws_size, hipStream_t stream) {
    fx::Args a; memset(&a, 0, sizeof(a)); fx::bind_io(a.p, d_in, (float*)d_out);
    const size_t f_need = fx::carve(a.p, d_ws);
    if (f_need > ws_size) { fprintf(stderr, "kernel_launch: workspace too small: need %zu have %zu\n", f_need, ws_size); return; }
    static int grid = 0;
    if (!grid) { int dev = 0, cus = 0, per_cu = 0; (void)hipGetDevice(&dev); (void)hipDeviceGetAttribute(&cus, hipDeviceAttributeMultiprocessorCount, dev);
        (void)hipFuncSetAttribute((const void*)fx::mega, hipFuncAttributeMaxDynamicSharedMemorySize, fx::LDS_BYTES);
        if (hipOccupancyMaxActiveBlocksPerMultiprocessor(&per_cu, (const void*)fx::mega, fx::NTHREADS, fx::LDS_BYTES) != hipSuccess || per_cu < 1) { fprintf(stderr, "kernel_launch: occupancy query says %d blocks per CU\n", per_cu); (void)hipGetLastError(); }
        grid = cus; }
    (void)hipMemsetAsync(a.p.ctl, 0, fx::CTL_BYTES, stream);
#if ONE_LAUNCH
    a.lo = 0; a.hi = fx::PH_COUNT; hipLaunchKernelGGL(fx::mega, dim3(grid), dim3(fx::NTHREADS), fx::LDS_BYTES, stream, a);
#else
    for (int k = 0; k < fx::PH_COUNT; ++k) { a.lo = k; a.hi = k + 1; hipLaunchKernelGGL(fx::mega, dim3(grid), dim3(fx::NTHREADS), fx::LDS_BYTES, stream, a); }
#endif
}
```

```cpp
#define PEER_SHARD2 1
#define ONE_LAUNCH 1
#include <hip/hip_runtime.h>
#include <cstdio>
#include <cstring>
#include <cmath>
#ifdef CPU_TEST
#define HD inline
constexpr int D_MODEL = 128, BATCH = 2, SEQ = 512, DEPTH = 2, DEC_BATCH = 3, DEC_SEQ = 1, PAST_LEN = 512, PAGE_SIZE = 128;
constexpr int DIL_W[3] = {16, 64, 256}, DIL_D[3] = {1, 4, 16}, DIL_TAPS = 17;
constexpr int MEM_TOKENS = 32, SLC_TOPK = 4, SWA_WINDOW = 64, PEER_KEYS = 16, PEER_TOPK = 4;
#else
#define HD __host__ __device__ __forceinline__
constexpr int D_MODEL = 1024, BATCH = 2, SEQ = 8192, DEPTH = 2, DEC_BATCH = 32, DEC_SEQ = 1, PAST_LEN = 8192, PAGE_SIZE = 128;
constexpr int DIL_W[3] = {128, 512, 2048}, DIL_D[3] = {1, 4, 16}, DIL_TAPS = 129;
constexpr int MEM_TOKENS = 256, SLC_TOPK = 16, SWA_WINDOW = 512, PEER_KEYS = 128, PEER_TOPK = 16;
#endif
HD constexpr int dil_w(int g) { return g == 0 ? DIL_W[0] : (g == 1 ? DIL_W[1] : DIL_W[2]); }
HD constexpr int dil_d(int g) { return g == 0 ? DIL_D[0] : (g == 1 ? DIL_D[1] : DIL_D[2]); }
constexpr int HEAD_DIM = 64, N_A_LAYERS = DEPTH / 2, N_DIL = 3, DIL_HEADS = 4, DIL_COLS = N_DIL * 3 * DIL_HEADS * HEAD_DIM;
constexpr int MEM_HEADS = 4, MEM_COLS = MEM_HEADS * HEAD_DIM;
constexpr int NSA_HEADS = 12, NSA_KV_HEADS = 2, NSA_GROUP = 6, NSA_Q_COLS = NSA_HEADS * HEAD_DIM, NSA_GATE_COLS = NSA_HEADS * 3;
constexpr int CMP_BLOCK = 32, CMP_STRIDE = 16, CMP_HIDDEN = 128, SLC_BLOCK = 64;
constexpr int PEER_EXPERTS = PEER_KEYS * PEER_KEYS, PEER_HEADS = 8, PEER_KEY_DIM = 128;
constexpr float FORCE_SCORE = 1.0e9f, NEG = -1.0e30f, SCALE = 0.125f, LN_EPS = 1e-5f;
constexpr float ALPHA = 1.41421356237309515f;
constexpr float BETA = 0.5f;
#define LAS __attribute__((address_space(3)))
namespace pg8 {
#define PG8_LAS __attribute__((address_space(3)))
typedef unsigned short bf16_t;
typedef short bf16x8 __attribute__((ext_vector_type(8)));
typedef float f32x4 __attribute__((ext_vector_type(4)));
typedef unsigned u32x4 __attribute__((ext_vector_type(4)));
constexpr int BM = 256, BK = 64, HALF = 128, HTB = HALF * BK * 2  , STAGE_BYTES = 8 * HTB, NXCD = 8, WGM = 8;

__host__ __device__ __forceinline__ int lds_byte(int r, int c) { const int st = (r >> 4) * 2 + (c >> 5), rr = r & 15, cc = c & 31, ob = rr * 64 + cc * 2; return st * 1024 + (ob ^ (((ob >> 9) & 1) << 5)); }
__host__ __device__ __forceinline__ void stage_rc(int b, int& R, int& C) { const int st = b / 1024, sb = b % 1024, swz = sb ^ (((sb >> 9) & 1) << 5); R = (st >> 1) * 16 + swz / 64; C = (st & 1) * 32 + (swz % 64) / 2; }
__host__ __device__ __forceinline__ int perm32(int rho) { const int n = rho >> 4, i = rho & 15; return 8 * (i >> 2) + 4 * n + (i & 3); }

struct Unit { int pm, pn; };
struct Gemm { const bf16_t* A; const bf16_t* Bt; int M, N, K; };

struct StaticOrder {
    int nM, nN, nwg, G, c;
    __host__ __device__ void init(int M, int N, int G_, int c_) { nM = M / BM; nN = N / BM; nwg = nM * nN; G = G_; c = c_; }
    __host__ __device__ bool next(int i, Unit& u) const {
        const long L = (long)i * G + c; if (L >= nwg) return false;
        int wgid = (int)L; { const int q = nwg / NXCD, r = nwg % NXCD, xcd = wgid % NXCD, off = wgid / NXCD; wgid = (xcd < r ? xcd * (q + 1) : r * (q + 1) + (xcd - r) * q) + off; }
        const int nig = WGM * nN, gid = wgid / nig, fm = gid * WGM, gsz = (nM - fm) < WGM ? (nM - fm) : WGM;
        u.pm = fm + ((wgid % nig) % gsz); u.pn = (wgid % nig) / gsz; return true;
    }
    __device__ __forceinline__ void a_ready(const Unit&) const {}
    __device__ __forceinline__ void done(const Unit&) const {}
};

__device__ __forceinline__ unsigned cvt_pk_bf16(float lo, float hi) { unsigned r; asm volatile("v_cvt_pk_bf16_f32 %0, %1, %2" : "=v"(r) : "v"(lo), "v"(hi)); return r; }
typedef float f32x2 __attribute__((ext_vector_type(2)));
typedef float f32x2 __attribute__((ext_vector_type(2)));
template <class Epi, class Sched, bool ALIGN_EPI = false, bool SP2 = false>
__device__ __forceinline__ void gemm_phase(PG8_LAS unsigned char* lds, const Gemm g, const Sched& S, const Epi& E) {
    const int tid = threadIdx.x, wid = __builtin_amdgcn_readfirstlane(tid >> 6), lane = tid & 63, wr = wid >> 2, wc = wid & 3, fr = lane & 15, fq = lane >> 4;
    const int K = g.K, nt = K / BK;
    unsigned voffA[2], voffB[2];
#pragma unroll
    for (int i = 0; i < 2; ++i) { int R, C; stage_rc(tid * 16 + i * 8192, R, C); const int Rb = Epi::PERM ? ((R & ~31) + perm32(R & 31)) : R;
        voffA[i] = (unsigned)(R * K + C) * 2u; voffB[i] = (unsigned)(Rb * K + C) * 2u; }
    const size_t kstep = (size_t)(BK * 2);
    const size_t hstep = (size_t)HALF * K * 2;
    const size_t tstep = 2 * hstep;
    const unsigned ldsw = (unsigned)wid * 1024u;
    const int aoff = lds_byte(wr * 64 + fr, fq * 8), boff = lds_byte(wc * 32 + fr, fq * 8);
#define PG8_SA(b, h) (((b) * 2 + (h)) * HTB)
#define PG8_SB(b, h) ((4 + (b) * 2 + (h)) * HTB)
#define PG8_STAGE(bufoff, gbase, voff) do { _Pragma("unroll") for (int _i = 0; _i < 2; ++_i) \
        __builtin_amdgcn_global_load_lds((const unsigned*)((const char*)(gbase) + (voff)[_i]), (PG8_LAS unsigned*)(lds + (bufoff) + ldsw + _i * 8192), 16, 0, 0); } while (0)
#define PG8_LDA(dst, b, h) do { _Pragma("unroll") for (int m = 0; m < 4; ++m) _Pragma("unroll") for (int k = 0; k < 2; ++k) dst[m][k] = *(const PG8_LAS bf16x8*)(lds + PG8_SA(b, h) + aoff + m * 2048 + k * 1024); } while (0)
#define PG8_LDB(dst, b, h) do { _Pragma("unroll") for (int n = 0; n < 2; ++n) _Pragma("unroll") for (int k = 0; k < 2; ++k) dst[n][k] = *(const PG8_LAS bf16x8*)(lds + PG8_SB(b, h) + boff + n * 2048 + k * 1024); } while (0)
#define PG8_MMA(ai, bj, At, Bt) do { __builtin_amdgcn_s_setprio(1); _Pragma("unroll") for (int m = 0; m < 4; ++m) _Pragma("unroll") for (int n = 0; n < 2; ++n) _Pragma("unroll") for (int k = 0; k < 2; ++k) \
        acc[ai][bj][m][n] = __builtin_amdgcn_mfma_f32_16x16x32_bf16(Bt[n][k], At[m][k], acc[ai][bj][m][n], 0, 0, 0); __builtin_amdgcn_s_setprio(0); } while (0)
#define PG8_WAIT_V(n) asm volatile("s_waitcnt vmcnt(" #n ")" ::: "memory")
#define PG8_WAIT_L(n) asm volatile("s_waitcnt lgkmcnt(" #n ")" ::: "memory")
#define PG8_BAR __builtin_amdgcn_s_barrier()
#define PG8_SCHED __builtin_amdgcn_sched_barrier(0)
    Unit cur, nxt; int ui = 0;
    if (!S.next(0, cur)) return;
    f32x4 acc[2][2][4][2];
#pragma unroll
    for (int a = 0; a < 2; ++a)
#pragma unroll
        for (int b = 0; b < 2; ++b)
#pragma unroll
            for (int m = 0; m < 4; ++m)
#pragma unroll
                for (int n = 0; n < 2; ++n) acc[a][b][m][n] = (f32x4){0.f, 0.f, 0.f, 0.f};
    bf16x8 At[4][2], B0[2][2], B1[2][2];
    const char* cA = (const char*)g.A + (size_t)cur.pm * tstep; const char* cB = (const char*)g.Bt + (size_t)cur.pn * tstep;
    S.a_ready(cur);
    if constexpr (SP2) {
        PG8_STAGE(PG8_SB(0, 0), cB, voffB); PG8_STAGE(PG8_SB(0, 1), cB + hstep, voffB); PG8_STAGE(PG8_SA(0, 0), cA, voffA); PG8_STAGE(PG8_SA(0, 1), cA + hstep, voffA);
        if (wr == 1) PG8_BAR;
        PG8_WAIT_V(2); PG8_BAR;
        PG8_STAGE(PG8_SB(1, 0), cB + kstep, voffB); PG8_STAGE(PG8_SA(1, 0), cA + kstep, voffA); PG8_STAGE(PG8_SB(1, 1), cB + hstep + kstep, voffB);
        PG8_WAIT_V(6); PG8_BAR;
    } else {
        PG8_STAGE(PG8_SB(0, 0), cB, voffB); PG8_STAGE(PG8_SA(0, 0), cA, voffA); PG8_STAGE(PG8_SB(0, 1), cB + hstep, voffB); PG8_STAGE(PG8_SA(0, 1), cA + hstep, voffA);
        if (wr == 1) PG8_BAR;
        PG8_WAIT_V(4); PG8_BAR;
        PG8_STAGE(PG8_SB(1, 0), cB + kstep, voffB); PG8_STAGE(PG8_SA(1, 0), cA + kstep, voffA); PG8_STAGE(PG8_SB(1, 1), cB + hstep + kstep, voffB);
        PG8_WAIT_V(6); PG8_BAR;
    }
    for (;;) {
        const bool has_next = S.next(ui + 1, nxt);
        const char* nA = has_next ? (const char*)g.A + (size_t)nxt.pm * tstep : cA; const char* nB = has_next ? (const char*)g.Bt + (size_t)nxt.pn * tstep : cB;
        for (int t = 0; t < nt; t += 2) {
            const bool last = (t == nt - 2);
            const char* a1 = cA + (size_t)(t + 1) * kstep;
            const char* a2 = last ? nA : cA + (size_t)(t + 2) * kstep; const char* b2 = last ? nB : cB + (size_t)(t + 2) * kstep;
            const char* a3 = a2 + kstep; const char* b3 = b2 + kstep;
            if (last && has_next) S.a_ready(nxt);
            if constexpr (SP2) {
            PG8_LDB(B0, 0, 0); PG8_LDB(B1, 0, 1); PG8_SCHED; PG8_LDA(At, 0, 0); PG8_STAGE(PG8_SA(1, 1), a1 + hstep, voffA);
            PG8_WAIT_V(8); PG8_WAIT_L(0); PG8_BAR; PG8_MMA(0, 0, At, B0); PG8_MMA(0, 1, At, B1); PG8_BAR; PG8_SCHED;
            PG8_LDA(At, 0, 1); PG8_STAGE(PG8_SB(0, 0), b2, voffB); PG8_STAGE(PG8_SB(0, 1), b2 + hstep, voffB); PG8_STAGE(PG8_SA(0, 0), a2, voffA);
            PG8_WAIT_V(8); PG8_WAIT_L(0); PG8_BAR; PG8_MMA(1, 0, At, B0); PG8_MMA(1, 1, At, B1); PG8_BAR; PG8_SCHED;
            PG8_LDB(B0, 1, 0); PG8_LDB(B1, 1, 1); PG8_SCHED; PG8_LDA(At, 1, 0); PG8_STAGE(PG8_SA(0, 1), a2 + hstep, voffA);
            PG8_WAIT_V(8); PG8_WAIT_L(0); PG8_BAR; PG8_MMA(0, 0, At, B0); PG8_MMA(0, 1, At, B1); PG8_BAR; PG8_SCHED;
            PG8_LDA(At, 1, 1); PG8_STAGE(PG8_SB(1, 0), b3, voffB); PG8_STAGE(PG8_SB(1, 1), b3 + hstep, voffB); PG8_STAGE(PG8_SA(1, 0), a3, voffA);
            PG8_WAIT_V(8); PG8_WAIT_L(0); PG8_BAR; PG8_MMA(1, 0, At, B0); PG8_MMA(1, 1, At, B1); PG8_BAR; PG8_SCHED;
            } else {
            PG8_LDB(B0, 0, 0); PG8_SCHED; PG8_LDA(At, 0, 0); PG8_STAGE(PG8_SA(1, 1), a1 + hstep, voffA);
            PG8_WAIT_L(8); PG8_BAR; PG8_WAIT_L(0); PG8_MMA(0, 0, At, B0); PG8_BAR; PG8_SCHED;
            PG8_LDB(B1, 0, 1); PG8_STAGE(PG8_SB(0, 0), b2, voffB);
            PG8_BAR; PG8_WAIT_L(0); PG8_MMA(0, 1, At, B1); PG8_BAR;
            PG8_LDA(At, 0, 1); PG8_STAGE(PG8_SA(0, 0), a2, voffA);
            PG8_BAR; PG8_WAIT_L(0); PG8_MMA(1, 0, At, B0); PG8_BAR; PG8_SCHED;
            PG8_STAGE(PG8_SB(0, 1), b2 + hstep, voffB);
            PG8_WAIT_V(6); PG8_BAR; PG8_MMA(1, 1, At, B1); PG8_BAR;
            PG8_LDB(B0, 1, 0); PG8_SCHED; PG8_LDA(At, 1, 0); PG8_STAGE(PG8_SA(0, 1), a2 + hstep, voffA);
            PG8_WAIT_L(8); PG8_BAR; PG8_WAIT_L(0); PG8_MMA(0, 0, At, B0); PG8_BAR; PG8_SCHED;
            PG8_LDB(B1, 1, 1); PG8_STAGE(PG8_SB(1, 0), b3, voffB);
            PG8_BAR; PG8_WAIT_L(0); PG8_MMA(0, 1, At, B1); PG8_BAR;
            PG8_LDA(At, 1, 1); PG8_STAGE(PG8_SA(1, 0), a3, voffA);
            PG8_BAR; PG8_WAIT_L(0); PG8_MMA(1, 0, At, B0); PG8_BAR; PG8_SCHED;
            PG8_STAGE(PG8_SB(1, 1), b3 + hstep, voffB);
            PG8_WAIT_V(6); PG8_BAR; PG8_MMA(1, 1, At, B1); PG8_BAR;
            }
        }
        if constexpr (ALIGN_EPI) { if (wr == 0) PG8_BAR; }
        if constexpr (!Epi::AFTER_DRAIN) { E(acc, cur, wr, wc, fr, fq); S.done(cur); }
        if (!has_next) break;
#pragma unroll
        for (int a = 0; a < 2; ++a)
#pragma unroll
            for (int b = 0; b < 2; ++b)
#pragma unroll
                for (int m = 0; m < 4; ++m)
#pragma unroll
                    for (int n = 0; n < 2; ++n) acc[a][b][m][n] = (f32x4){0.f, 0.f, 0.f, 0.f};
        cur = nxt; cA = nA; cB = nB; ++ui;
        if constexpr (ALIGN_EPI) { if (wr == 1) PG8_BAR; }
    }
    PG8_WAIT_V(0);
    if constexpr (!ALIGN_EPI) { if (wr == 0) PG8_BAR; }
    PG8_BAR;
    if constexpr (Epi::AFTER_DRAIN) { E.fused(acc, cur, wr, wc, fr, fq, lds, wid, lane); S.done(cur); }
#undef PG8_SA
#undef PG8_SB
#undef PG8_STAGE
#undef PG8_LDA
#undef PG8_LDB
#undef PG8_MMA
#undef PG8_WAIT_V
#undef PG8_WAIT_L
#undef PG8_BAR
#undef PG8_SCHED
}
}
#define XB_TMO      128
#define XB_XCNT(j)  (256  + 64 * (j))
#define XB_XSUB(j)  (1280 + 64 * (j))
#define XB_XGEN(j)  (2304 + 64 * (j))
#define XB_TOP      3328
#define XB_TOPGEN   3392
#define XCD_BAR_WORDS 3456
#define XB_SPIN_CAP (1u << 18)

__device__ __forceinline__ unsigned xb_ld(unsigned* p)              { return __hip_atomic_load(p, __ATOMIC_RELAXED, __HIP_MEMORY_SCOPE_AGENT); }
__device__ __forceinline__ unsigned xb_add(unsigned* p, unsigned v) { return __hip_atomic_fetch_add(p, v, __ATOMIC_RELAXED, __HIP_MEMORY_SCOPE_AGENT); }
__device__ __forceinline__ unsigned xb_xcc_id() { return (unsigned)__builtin_amdgcn_s_getreg((3 << 11) | 20) & 0xFu; }
#define XB_SPIN(cond, bar) do { unsigned _sp = 0; while (cond) { __builtin_amdgcn_s_sleep(1); \
    if ((++_sp & 255u) == 0u) { if (xb_ld(&(bar)[XB_TMO])) break; if (_sp > XB_SPIN_CAP) { atomicAdd(&(bar)[XB_TMO], 1u); break; } } } } while (0)

struct XcdBarrier {
    unsigned* bar; unsigned x;
    volatile LAS unsigned* st;
};

__device__ __forceinline__ XcdBarrier xcd_barrier_post(unsigned* bar, volatile LAS unsigned* st) {
    XcdBarrier b; b.bar = bar; b.x = xb_xcc_id(); b.st = st;
    if (threadIdx.x == 0) (void)xb_add(&bar[XB_XCNT(b.x)], 1u);
    return b;
}
__device__ __forceinline__ void xcd_barrier_complete(unsigned* bar, unsigned x, unsigned& nloc, unsigned& nx) {
    const unsigned G = gridDim.x * gridDim.y * gridDim.z;
    unsigned sum, cnt, mine, sp = 0u;
    for (;;) {
        sum = 0u; cnt = 0u; mine = 0u;
#pragma unroll
        for (unsigned j = 0; j < 16; ++j) { const unsigned c = xb_ld(&bar[XB_XCNT(j)]); sum += c; cnt += (c > 0u) ? 1u : 0u; mine = (j == x) ? c : mine; }
        if (sum == G) break;
        __builtin_amdgcn_s_sleep(1);
        if ((++sp & 255u) == 0u) { if (xb_ld(&bar[XB_TMO])) break; if (sp > XB_SPIN_CAP) { atomicAdd(&bar[XB_TMO], 1u); break; } }
    }
    nloc = mine > 0u ? mine : 1u; nx = cnt > 0u ? cnt : 1u;
}

__device__ __forceinline__ void xcd_barrier(const XcdBarrier& b) {
    asm volatile("s_waitcnt vmcnt(0)" ::: "memory");
    __syncthreads();
    if (threadIdx.x == 0) {
        unsigned* bar = b.bar;
        __builtin_amdgcn_s_waitcnt(0);
        unsigned nloc = b.st[0], nx = b.st[1];
        if (nloc == 0u) { xcd_barrier_complete(bar, b.x, nloc, nx); b.st[0] = nloc; b.st[1] = nx; }
        const unsigned old = xb_add(&bar[XB_XSUB(b.x)], 1u);
        const unsigned gen = old / nloc;
        if (old + 1u == (gen + 1u) * nloc) {
            __builtin_amdgcn_fence(__ATOMIC_RELEASE, "agent");
            asm volatile("s_waitcnt vmcnt(0)" ::: "memory");
            const unsigned og = xb_add(&bar[XB_TOP], 1u);
            const unsigned tg = og / nx;
            if (og + 1u == (tg + 1u) * nx) xb_add(&bar[XB_TOPGEN], 1u);
            else XB_SPIN(xb_ld(&bar[XB_TOPGEN]) == tg, bar);
            __builtin_amdgcn_fence(__ATOMIC_ACQUIRE, "agent");
            xb_add(&bar[XB_XGEN(b.x)], 1u);
            asm volatile("s_waitcnt vmcnt(0)" ::: "memory");
        } else {
            XB_SPIN(xb_ld(&bar[XB_XGEN(b.x)]) == gen, bar);
            __builtin_amdgcn_fence(__ATOMIC_ACQUIRE, "agent");
            asm volatile("s_waitcnt vmcnt(0)" ::: "memory");
        }
    }
    __syncthreads();
}
namespace fx {
#define DI __device__ __forceinline__
typedef unsigned short bf16;
typedef short bf16x8 __attribute__((ext_vector_type(8)));
typedef float f32x4 __attribute__((ext_vector_type(4)));
typedef float f32x2 __attribute__((ext_vector_type(2)));
typedef unsigned u32x4 __attribute__((ext_vector_type(4)));
typedef unsigned u32x2 __attribute__((ext_vector_type(2)));
constexpr int M0 = BATCH * SEQ, MP = M0 + DEC_BATCH, MPAD = ((MP + 255) / 256) * 256;
constexpr int ACOLS = DIL_COLS + MEM_COLS, BCOLS = NSA_Q_COLS + NSA_GATE_COLS + MEM_COLS, KVCOLS = 6 * NSA_KV_HEADS * HEAD_DIM;
constexpr int NB_T = 2048;
constexpr int NPK = PEER_HEADS * 2 * PEER_KEYS;
constexpr int NCMP = (SEQ - CMP_BLOCK) / CMP_STRIDE + 1;
constexpr int NCH = SEQ / CMP_STRIDE;
constexpr int NCTX = BATCH + DEC_BATCH;
constexpr int ACROWS = NCTX * NSA_KV_HEADS * NCH;
constexpr int NPOS = PAST_LEN + 1;
constexpr float QSCALE = 0.125f * 1.4426950408889634f;
constexpr int NTHREADS = 512, NWAVES = 8, LDS_BYTES = 147456, RING_BYTES = 131072, MISC_OFF = RING_BYTES + 320;

struct FP {
    const float *x_prompt, *x_sample, *mem_prompt, *cache_dil[3], *cache_nsa_kv, *cache_nsa_win, *cache_mem_kv; const int* page_table;
    const float *w_in_a, *w_out_a, *w_in_b, *w_out_b, *w_mem_kv, *w_kv_b, *cmp_pe, *cmp_w1, *cmp_w2, *ln_g, *ln_b, *peer_wq, *peer_keys, *peer_u, *peer_v;
    float *y_prompt, *y_sample, *dil_p[3], *dil_s[3], *nsa_kv_p, *nsa_kv_s, *win_p, *win_s, *mem_kv_p;
    unsigned* ctl;
    bf16 *XB0, *X1B, *X2B, *X3B, *WA_T, *WMEM_T, *MEMB, *WOA_T, *WOB_T, *WPK_T, *WB_T, *CW1_T, *AC; unsigned char *UB8, *VB8;
    float *ROPE, *CBIAS;
    bf16 *QA, *KA, *VTA, *MQA, *MK, *MVT, *ATTA;
    float *DPART, *DML, *PRE, *X1, *X2, *X3, *SCO, *SELG; int* SELE;
    bf16 *SLK, *SLVT, *WNK, *WNVT, *QB, *MQB, *CK, *CVT, *ATTB;
    float *GATES, *UL, *CKF, *CVF;
    int* SELB;
    float* DBG;
};
struct Args { FP p; int lo, hi; };
struct Carve { size_t off = 0; template <class T> T* take(void* base, size_t n) { T* r = (T*)((char*)base + off); off += ((n * sizeof(T) + 255) / 256) * 256; return r; } };
constexpr size_t CTL_BYTES = 65536;
inline size_t carve(FP& p, void* base) {
    Carve c;
    p.ctl = c.take<unsigned>(base, CTL_BYTES / 4);
    p.XB0 = c.take<bf16>(base, (size_t)MPAD * D_MODEL); p.X1B = c.take<bf16>(base, (size_t)MPAD * D_MODEL); p.X2B = c.take<bf16>(base, (size_t)MPAD * D_MODEL); p.X3B = c.take<bf16>(base, (size_t)MPAD * D_MODEL);
    p.WA_T = c.take<bf16>(base, (size_t)ACOLS * D_MODEL); p.WMEM_T = c.take<bf16>(base, (size_t)DEPTH * 2 * MEM_COLS * D_MODEL); p.MEMB = c.take<bf16>(base, (size_t)BATCH * MEM_TOKENS * D_MODEL);
    p.WOA_T = c.take<bf16>(base, (size_t)D_MODEL * 2 * MEM_COLS); p.WOB_T = c.take<bf16>(base, (size_t)D_MODEL * (NSA_Q_COLS + MEM_COLS));
    p.WPK_T = c.take<bf16>(base, (size_t)DEPTH * NPK * D_MODEL); p.WB_T = c.take<bf16>(base, (size_t)NB_T * D_MODEL);
    p.UB8 = c.take<unsigned char>(base, (size_t)DEPTH * PEER_EXPERTS * D_MODEL); p.VB8 = c.take<unsigned char>(base, (size_t)DEPTH * PEER_EXPERTS * D_MODEL);
    p.CW1_T = c.take<bf16>(base, (size_t)2 * 256 * 1024); p.AC = c.take<bf16>(base, (size_t)2 * ACROWS * 1024);
    p.ROPE = c.take<float>(base, (size_t)NPOS * 64); p.CBIAS = c.take<float>(base, 2 * CMP_HIDDEN);
    p.QA = c.take<bf16>(base, (size_t)3 * MPAD * 256); p.KA = c.take<bf16>(base, (size_t)3 * MPAD * 256); p.VTA = c.take<bf16>(base, (size_t)3 * BATCH * DIL_HEADS * HEAD_DIM * SEQ + 4096);
    p.MQA = c.take<bf16>(base, (size_t)MPAD * 256); p.MK = c.take<bf16>(base, (size_t)DEPTH * BATCH * MEM_TOKENS * MEM_COLS); p.MVT = c.take<bf16>(base, (size_t)DEPTH * BATCH * MEM_COLS * MEM_TOKENS);
    p.ATTA = c.take<bf16>(base, (size_t)MPAD * 2 * MEM_COLS);
    p.DPART = c.take<float>(base, (size_t)3 * MP * DIL_HEADS * HEAD_DIM); p.DML = c.take<float>(base, (size_t)3 * MP * DIL_HEADS * 2);
    p.PRE = c.take<float>(base, (size_t)MPAD * D_MODEL); p.X1 = c.take<float>(base, (size_t)MPAD * D_MODEL); p.X2 = c.take<float>(base, (size_t)MPAD * D_MODEL); p.X3 = c.take<float>(base, (size_t)MPAD * D_MODEL);
    p.SCO = c.take<float>(base, (size_t)MPAD * NPK); p.SELG = c.take<float>(base, (size_t)MP * 128); p.SELE = c.take<int>(base, (size_t)MP * 128);
    p.SLK = c.take<bf16>(base, (size_t)BATCH * NSA_KV_HEADS * SEQ * HEAD_DIM); p.SLVT = c.take<bf16>(base, (size_t)BATCH * NSA_KV_HEADS * SEQ * HEAD_DIM);
    p.WNK = c.take<bf16>(base, (size_t)BATCH * NSA_KV_HEADS * SEQ * HEAD_DIM + 4096); p.WNVT = c.take<bf16>(base, (size_t)BATCH * NSA_KV_HEADS * SEQ * HEAD_DIM + 4096);
    p.QB = c.take<bf16>(base, (size_t)MPAD * NSA_Q_COLS); p.MQB = c.take<bf16>(base, (size_t)MPAD * 256);
    p.CK = c.take<bf16>(base, (size_t)NCTX * NSA_KV_HEADS * NCH * HEAD_DIM); p.CVT = c.take<bf16>(base, (size_t)NCTX * NSA_KV_HEADS * HEAD_DIM * NCH); p.ATTB = c.take<bf16>(base, (size_t)MPAD * (NSA_Q_COLS + MEM_COLS));
    p.GATES = c.take<float>(base, (size_t)MPAD * 64); p.UL = c.take<float>(base, (size_t)2 * ACROWS * 256);
    p.CKF = c.take<float>(base, (size_t)DEC_BATCH * NSA_KV_HEADS * NCH * HEAD_DIM); p.CVF = c.take<float>(base, (size_t)DEC_BATCH * NSA_KV_HEADS * NCH * HEAD_DIM);
    p.SELB = c.take<int>(base, (size_t)MP * NSA_KV_HEADS * 16);
#ifdef NSA_DEBUG
    p.DBG = c.take<float>(base, (size_t)3 * MP * 768);
#else
    p.DBG = nullptr;
#endif
    return c.off;
}
inline void bind_io(FP& p, void* const* d_in, float* out) {
    p.x_prompt = (const float*)d_in[0]; p.x_sample = (const float*)d_in[1]; p.mem_prompt = (const float*)d_in[2]; p.cache_dil[0] = (const float*)d_in[3]; p.cache_dil[1] = (const float*)d_in[4]; p.cache_dil[2] = (const float*)d_in[5];
    p.cache_nsa_kv = (const float*)d_in[6]; p.cache_nsa_win = (const float*)d_in[7]; p.cache_mem_kv = (const float*)d_in[8]; p.page_table = (const int*)d_in[9];
    p.w_in_a = (const float*)d_in[10]; p.w_out_a = (const float*)d_in[11]; p.w_in_b = (const float*)d_in[12]; p.w_out_b = (const float*)d_in[13]; p.w_mem_kv = (const float*)d_in[14]; p.w_kv_b = (const float*)d_in[15];
    p.cmp_pe = (const float*)d_in[16]; p.cmp_w1 = (const float*)d_in[17]; p.cmp_w2 = (const float*)d_in[18]; p.ln_g = (const float*)d_in[19]; p.ln_b = (const float*)d_in[20];
    p.peer_wq = (const float*)d_in[21]; p.peer_keys = (const float*)d_in[22]; p.peer_u = (const float*)d_in[23]; p.peer_v = (const float*)d_in[24];
    size_t o = 0; auto take = [&](size_t n) { float* r = out + o; o += n; return r; };
    p.y_prompt = take((size_t)M0 * D_MODEL); p.y_sample = take((size_t)DEC_BATCH * D_MODEL);
    for (int g = 0; g < 3; ++g) p.dil_p[g] = take((size_t)BATCH * DIL_W[g] * 2 * DIL_HEADS * HEAD_DIM);
    for (int g = 0; g < 3; ++g) p.dil_s[g] = take((size_t)DEC_BATCH * DIL_W[g] * 2 * DIL_HEADS * HEAD_DIM);
    p.nsa_kv_p = take((size_t)M0 * 4 * NSA_KV_HEADS * HEAD_DIM); p.nsa_kv_s = take((size_t)DEC_BATCH * 4 * NSA_KV_HEADS * HEAD_DIM);
    p.win_p = take((size_t)BATCH * SWA_WINDOW * 2 * NSA_KV_HEADS * HEAD_DIM); p.win_s = take((size_t)DEC_BATCH * SWA_WINDOW * 2 * NSA_KV_HEADS * HEAD_DIM);
    p.mem_kv_p = take((size_t)DEPTH * BATCH * MEM_TOKENS * 2 * MEM_COLS);
}
DI unsigned f2bf(float f) { unsigned u = __builtin_bit_cast(unsigned, f); return (u + 0x7fffu + ((u >> 16) & 1u)) >> 16; }
DI unsigned pk2(float lo, float hi) { return f2bf(lo) | (f2bf(hi) << 16); }
DI float bf2f(unsigned short b) { return __builtin_bit_cast(float, (unsigned)b << 16); }
DI float bflo(unsigned w) { return __builtin_bit_cast(float, w << 16); }
DI float bfhi(unsigned w) { return __builtin_bit_cast(float, w & 0xffff0000u); }
template <int CTRL> DI float dpp1(float x) { return __builtin_bit_cast(float, __builtin_amdgcn_update_dpp(0, __builtin_bit_cast(int, x), CTRL, 0xF, 0xF, true)); }
DI float wave_sum(float v) { v += dpp1<0xB1>(v); v += dpp1<0x4E>(v); v += dpp1<0x141>(v); v += dpp1<0x140>(v);
    float a = v, b = v; asm volatile("s_nop 1\n\tv_permlane16_swap_b32 %0, %1" : "+v"(a), "+v"(b)); v = a + b; a = v; b = v;
    asm volatile("s_nop 1\n\tv_permlane32_swap_b32 %0, %1" : "+v"(a), "+v"(b)); return a + b; }
DI float wave_max(float v) { v = fmaxf(v, dpp1<0xB1>(v)); v = fmaxf(v, dpp1<0x4E>(v)); v = fmaxf(v, dpp1<0x141>(v)); v = fmaxf(v, dpp1<0x140>(v));
    float a = v, b = v; asm volatile("s_nop 1\n\tv_permlane16_swap_b32 %0, %1" : "+v"(a), "+v"(b)); v = fmaxf(a, b); a = v; b = v;
    asm volatile("s_nop 1\n\tv_permlane32_swap_b32 %0, %1" : "+v"(a), "+v"(b)); return fmaxf(a, b); }
DI float gelu_tanh(float x) { const float u = 0.7978845608028654f * (x + 0.044715f * x * x * x); const float e = __builtin_amdgcn_exp2f(u * 2.885390081777927f);   const float t = 1.0f - 2.0f / (e + 1.0f); return 0.5f * x * (1.0f + t); }
DI float* sel3(float* const (&a)[3], int g) { return g == 0 ? a[0] : (g == 1 ? a[1] : a[2]); }
DI const float* sel3c(const float* const (&a)[3], int g) { return g == 0 ? a[0] : (g == 1 ? a[1] : a[2]); }
__host__ DI size_t ktile_off(int t, int d) { const int blk = t >> 5, kk = t & 31, b = (kk >> 2) & 1, i = 4 * (kk >> 3) + (kk & 3), s = d >> 5, c = (d & 31) >> 3; return ((size_t)(blk * 4 + 2 * b + s) * 64 + i + 16 * c) * 8 + (d & 7); }
__host__ DI size_t vtile_off(int dim, int t) { const int blk = t >> 5, kk = t & 31; return ((size_t)(blk * 4 + (dim >> 4)) * 64 + (dim & 15) + 16 * (kk >> 3)) * 8 + (kk & 7); }
struct Ctx { LAS unsigned char* lds; int tid, lane, wave, vcu, G; };
DI int row_pos(int r) { return r < M0 ? (r & (SEQ - 1)) : PAST_LEN; }

struct ColSrc { const float* p; int ld; };
DI int rope_il(int e) { return (e >> 1) + 32 * (e & 1); }
DI ColSrc col_wa(const FP& P, int n) {
    const int t = n >> 8, ct = n & 255, h = ct >> 6, e = ct & 63; if (t >= 9) return ColSrc{P.w_in_a + DIL_COLS + ct, ACOLS};
    const int j = t % 3, d = (j < 2) ? rope_il(e) : e; return ColSrc{P.w_in_a + t * 256 + h * 64 + d, ACOLS}; }
DI ColSrc col_wb(const FP& P, int n) {
    const int t = n >> 8, ct = n & 255, e = ct & 63;
    if (t < 3) { const int ty = 2 * t + (ct >> 7), kvh = (ct >> 6) & 1; const bool rot = (ty == 2 || ty == 4); return ColSrc{P.w_kv_b + (ty * NSA_KV_HEADS + kvh) * 64 + (rot ? rope_il(e) : e), KVCOLS}; }
    if (t < 6) { const int h = (t - 3) * 4 + (ct >> 6); return ColSrc{P.w_in_b + h * 64 + rope_il(e), BCOLS}; }
    if (t == 6) return ColSrc{P.w_in_b + NSA_Q_COLS + NSA_GATE_COLS + ct, BCOLS};
    if (ct < NSA_GATE_COLS) return ColSrc{P.w_in_b + NSA_Q_COLS + ct, BCOLS};
    return ColSrc{nullptr, 0}; }
DI ColSrc col_wmem(const FP& P, int n) { const int l = n >> 9, c = n & 511; return ColSrc{P.w_mem_kv + (size_t)l * D_MODEL * 512 + c, 512}; }
DI ColSrc col_woa(const FP& P, int n) { return ColSrc{P.w_out_a + n, D_MODEL}; }
DI ColSrc col_wob(const FP& P, int n) { return ColSrc{P.w_out_b + n, D_MODEL}; }
DI ColSrc col_cw1(const FP& P, int n) {
    const int ty = n >> 8, half = (n >> 7) & 1, hid = n & 127; return ColSrc{P.cmp_w1 + (size_t)ty * CMP_BLOCK * HEAD_DIM * CMP_HIDDEN + (size_t)half * 16 * HEAD_DIM * CMP_HIDDEN + hid, CMP_HIDDEN}; }
template <class CF> DI void transpose_item(const FP& P, CF cf, int K, bf16* WT, LAS float* scr, int item, int nblk, int lane) {
    const int kb = item / nblk, nb = item % nblk, k0 = 64 * kb, n0 = 32 * nb;
    const ColSrc cs = cf(P, n0 + (lane & 31));
#pragma unroll 8
    for (int i = 0; i < 32; ++i) { const int kk = 2 * i + (lane >> 5); scr[kk * 33 + (lane & 31)] = cs.p ? cs.p[(size_t)(k0 + kk) * cs.ld] : 0.f; }
    asm volatile("s_waitcnt lgkmcnt(0)" ::: "memory");
    const int c = lane & 7;
#pragma unroll
    for (int j = 0; j < 4; ++j) { const int n = (lane >> 3) + 8 * j; const LAS float* s = scr + (8 * c) * 33 + n;
        u32x4 o; o.x = pk2(s[0 * 33], s[1 * 33]); o.y = pk2(s[2 * 33], s[3 * 33]); o.z = pk2(s[4 * 33], s[5 * 33]); o.w = pk2(s[6 * 33], s[7 * 33]);
        *(u32x4*)(WT + (size_t)(n0 + n) * K + k0 + 8 * c) = o; }
    asm volatile("s_waitcnt lgkmcnt(0)" ::: "memory");
}
DI void cvt_row1024(const float* src, bf16* dst, int lane) {
#pragma unroll
    for (int j = 0; j < 4; ++j) { f32x4 v = src ? *(const f32x4*)(src + 256 * j + 4 * lane) : (f32x4){0.f, 0.f, 0.f, 0.f}; u32x2 o; o.x = pk2(v.x, v.y); o.y = pk2(v.z, v.w); *(u32x2*)(dst + 256 * j + 4 * lane) = o; }
}
DI void cvt_row1024_fp8(const float* src, unsigned char* dst, float sc, int lane) { u32x4 o; unsigned w[4];
#pragma unroll
    for (int j = 0; j < 4; ++j) { const f32x4 v = *(const f32x4*)(src + 16 * lane + 4 * j) * sc; int t = __builtin_amdgcn_cvt_pk_fp8_f32(v.x, v.y, 0, false); t = __builtin_amdgcn_cvt_pk_fp8_f32(v.z, v.w, t, true); w[j] = (unsigned)t; }
    o.x = w[0]; o.y = w[1]; o.z = w[2]; o.w = w[3]; *(u32x4*)(dst + 16 * lane) = o; }
DI void p0_prologue(const FP& P, const Ctx& C) {
    LAS float* scr = (LAS float*)(C.lds + C.wave * 16384);
    const int gw = C.vcu * NWAVES + C.wave, NGW = C.G * NWAVES, lane = C.lane;
    { constexpr int IA = (D_MODEL / 64) * (ACOLS / 32), IM = (D_MODEL / 64) * (1024 / 32), IOA = (512 / 64) * (D_MODEL / 32), IOB = (1024 / 64) * (D_MODEL / 32), IB = (D_MODEL / 64) * (NB_T / 32), IC = (1024 / 64) * (512 / 32);
      constexpr int NIT = IA + IM + IOA + IOB + IB + IC;
      for (int it = gw; it < NIT; it += NGW) { int r = it;
          if (r < IA) { transpose_item(P, col_wa, D_MODEL, P.WA_T, scr, r, ACOLS / 32, lane); continue; } r -= IA;
          if (r < IM) { transpose_item(P, col_wmem, D_MODEL, P.WMEM_T, scr, r, 1024 / 32, lane); continue; } r -= IM;
          if (r < IOA) { transpose_item(P, col_woa, 512, P.WOA_T, scr, r, D_MODEL / 32, lane); continue; } r -= IOA;
          if (r < IOB) { transpose_item(P, col_wob, 1024, P.WOB_T, scr, r, D_MODEL / 32, lane); continue; } r -= IOB;
          if (r < IB) { transpose_item(P, col_wb, D_MODEL, P.WB_T, scr, r, NB_T / 32, lane); continue; } r -= IB;
          transpose_item(P, col_cw1, 1024, P.CW1_T, scr, r, 512 / 32, lane); } }
    for (int r = gw; r < M0 - NGW; r += 2 * NGW) {
        f32x4 v[8];
#pragma unroll
        for (int j = 0; j < 8; ++j) v[j] = *(const f32x4*)(P.x_prompt + (size_t)(r + (j >> 2) * NGW) * D_MODEL + 256 * (j & 3) + 4 * lane);
#pragma unroll
        for (int j = 0; j < 8; ++j) { u32x2 o; o.x = pk2(v[j].x, v[j].y); o.y = pk2(v[j].z, v[j].w); *(u32x2*)(P.XB0 + (size_t)(r + (j >> 2) * NGW) * D_MODEL + 256 * (j & 3) + 4 * lane) = o; } }
    for (int r = gw + ((M0 - NGW - gw + 2 * NGW - 1) / (2 * NGW)) * (2 * NGW); r < MPAD; r += NGW) { cvt_row1024(r < M0 ? P.x_prompt + (size_t)r * D_MODEL : (r < MP ? P.x_sample + (size_t)(r - M0) * D_MODEL : nullptr), P.XB0 + (size_t)r * D_MODEL, lane);
        if (r >= MP) { cvt_row1024(nullptr, P.X1B + (size_t)r * D_MODEL, lane); cvt_row1024(nullptr, P.X2B + (size_t)r * D_MODEL, lane); cvt_row1024(nullptr, P.X3B + (size_t)r * D_MODEL, lane);
            for (int c = lane; c < 512; c += 64) { P.ATTA[(size_t)r * 512 + c] = 0; P.ATTB[(size_t)r * 1024 + c] = 0; P.ATTB[(size_t)r * 1024 + 512 + c] = 0; } } }
    for (int r = gw; r < BATCH * MEM_TOKENS; r += NGW) cvt_row1024(P.mem_prompt + (size_t)r * D_MODEL, P.MEMB + (size_t)r * D_MODEL, lane);
#pragma unroll 1
    for (int r = 2 * gw; r < DEPTH * PEER_EXPERTS; r += 2 * NGW) { f32x4 a[16];
#pragma unroll
        for (int q = 0; q < 4; ++q) { const float* s0 = (q < 2 ? P.peer_u : P.peer_v) + (size_t)(r + (q & 1)) * D_MODEL + 16 * lane;
#pragma unroll
            for (int j = 0; j < 4; ++j) a[4 * q + j] = *(const f32x4*)(s0 + 4 * j); }
#pragma unroll
        for (int q = 0; q < 4; ++q) { const float sc = q < 2 ? 256.f : 64.f; unsigned w[4];
#pragma unroll
            for (int j = 0; j < 4; ++j) { const f32x4 v = a[4 * q + j] * sc; int t = __builtin_amdgcn_cvt_pk_fp8_f32(v.x, v.y, 0, false); t = __builtin_amdgcn_cvt_pk_fp8_f32(v.z, v.w, t, true); w[j] = (unsigned)t; }
            u32x4 o; o.x = w[0]; o.y = w[1]; o.z = w[2]; o.w = w[3]; *(u32x4*)((q < 2 ? P.UB8 : P.VB8) + (size_t)(r + (q & 1)) * D_MODEL + 16 * lane) = o; } }
    for (int i = gw * 64 + lane; i < NPOS * 32; i += NGW * 64) { const int pos = i >> 5, d = i & 31; const double inv = exp2(-(double)d * (13.287712379549449 / 32.0)); const double turns = (double)pos * inv * 0.15915494309189535;
        const float fr = (float)(turns - floor(turns)); P.ROPE[pos * 64 + d] = __builtin_amdgcn_cosf(fr); P.ROPE[pos * 64 + 32 + d] = __builtin_amdgcn_sinf(fr); }
    const int gwT = C.wave * C.G + C.vcu;
    for (int i = gwT; i < 2 * CMP_HIDDEN; i += NGW) { const int ty = i / CMP_HIDDEN, hid = i % CMP_HIDDEN; float a = 0.f;
#pragma unroll 8
        for (int k = lane; k < CMP_BLOCK * HEAD_DIM; k += 64) a += P.cmp_pe[ty * CMP_BLOCK * HEAD_DIM + k] * P.cmp_w1[((size_t)ty * CMP_BLOCK * HEAD_DIM + k) * CMP_HIDDEN + hid];
        a = wave_sum(a); if (lane == 0) P.CBIAS[i] = a; }
    for (int it2 = gwT; it2 < DEC_BATCH * (PAST_LEN / PAGE_SIZE) * (PAGE_SIZE / 8); it2 += NGW) { const int it = it2 / (PAGE_SIZE / 8), rg = it2 % (PAGE_SIZE / 8);
        const int n = it / (PAST_LEN / PAGE_SIZE), pi = it % (PAST_LEN / PAGE_SIZE); const int pg = P.page_table[it];
        const float* src = P.cache_nsa_kv + (size_t)pg * PAGE_SIZE * 512 + 4 * lane; const int ty = lane >> 5, kvh = (lane >> 4) & 1, d = (4 * lane) & 63;
        bf16* dst = P.AC + ((size_t)ty * ACROWS + ((size_t)(BATCH + n) * NSA_KV_HEADS + kvh) * NCH + pi * (PAGE_SIZE / 16)) * 1024 + d;
        { const int r0 = rg * 8; f32x4 v[8];
#pragma unroll
            for (int u = 0; u < 8; ++u) v[u] = *(const f32x4*)(src + (size_t)(r0 + u) * 512);
#pragma unroll
            for (int u = 0; u < 8; ++u) { const int t = r0 + u; u32x2 o; o.x = pk2(v[u].x, v[u].y); o.y = pk2(v[u].z, v[u].w); *(u32x2*)(dst + (size_t)(t / 16) * 1024 + (t % 16) * 64) = o; } } }
    for (int g = 0; g < 4; ++g) { const int W = g < 3 ? dil_w(g) : SWA_WINDOW, RV = g < 3 ? 128 : 64;
        const f32x4* src = (const f32x4*)(g < 3 ? sel3c(P.cache_dil, g) : P.cache_nsa_win); f32x4* dst = (f32x4*)(g < 3 ? sel3(P.dil_s, g) : P.win_s);
        const int per = (W - 1) * RV, nvec = DEC_BATCH * per;
#pragma unroll 1
        for (int i0 = gw * 1024; i0 < nvec; i0 += NGW * 1024) { f32x4 v[16]; int idx[16];
            const int n0 = __builtin_amdgcn_readfirstlane((int)((unsigned)i0 / (unsigned)per)), o0 = i0 - n0 * per;
#pragma unroll
            for (int u = 0; u < 16; ++u) { int o = o0 + u * 64 + lane, n = n0; if (o >= per) { o -= per; ++n; } if (n >= DEC_BATCH) { n = DEC_BATCH - 1; o = per - 1; } idx[u] = n * (per + RV) + o; v[u] = src[(size_t)idx[u] + RV]; }
#pragma unroll
            for (int u = 0; u < 16; ++u) { const int i = i0 + u * 64 + lane; if (i < nvec) dst[(size_t)idx[u]] = v[u]; } } }
}
DI void p0_wpk(const FP& P, const Ctx& C) {
    LAS float* sw = (LAS float*)C.lds;
    LAS float* sk = (LAS float*)(C.lds + 32768);
    constexpr int NIT = DEPTH * 16 * (D_MODEL / 64);
    for (int it = C.vcu; it < NIT; it += C.G) { const int l = it / (16 * (D_MODEL / 64)), rem = it % (16 * (D_MODEL / 64)), hc = rem / (D_MODEL / 64), kb = rem % (D_MODEL / 64);
        __syncthreads();
        for (int i = C.tid; i < 64 * 64; i += NTHREADS) { const int r = i >> 6, d = i & 63; sw[r * 65 + d] = P.peer_wq[((size_t)l * D_MODEL + kb * 64 + r) * 1024 + hc * 64 + d]; }
        for (int i = C.tid; i < 128 * 64; i += NTHREADS) { const int r = i >> 6, d = i & 63; sk[r * 68 + d] = P.peer_keys[(((size_t)l * 16 + hc) * PEER_KEYS + r) * 64 + d]; }
        __syncthreads();
        { const int ki = C.lane, kk0 = C.wave; float a[16];
#pragma unroll
          for (int j = 0; j < 16; ++j) a[j] = 0.f;
#pragma unroll 2
          for (int d = 0; d < 64; d += 4) { const float w0 = sw[ki * 65 + d], w1 = sw[ki * 65 + d + 1], w2 = sw[ki * 65 + d + 2], w3 = sw[ki * 65 + d + 3];
#pragma unroll
              for (int j = 0; j < 16; ++j) { const f32x4 kq = *(const LAS f32x4*)(sk + (kk0 + 8 * j) * 68 + d); a[j] += w0 * kq.x + w1 * kq.y + w2 * kq.z + w3 * kq.w; } }
#pragma unroll
          for (int j = 0; j < 16; ++j) P.WPK_T[((size_t)l * NPK + hc * 128 + kk0 + 8 * j) * D_MODEL + kb * 64 + ki] = (bf16)f2bf(a[j]); } }
    __syncthreads();
}

#define EPI_LOOP(...) int fr_l = fr, fq_l = fq; asm volatile("" : "+v"(fr_l), "+v"(fq_l));     \
    _Pragma("unroll") for (int ai = 0; ai < 2; ++ai) _Pragma("unroll") for (int m = 0; m < 4; ++m) { const int row = u.pm * 256 + ai * 128 + wr * 64 + m * 16 + fr_l; \
    _Pragma("unroll") for (int bj = 0; bj < 2; ++bj) { const int ct = bj * 128 + wc * 32 + fq_l * 8; const f32x4 v0 = acc[ai][bj][m][0], v1 = acc[ai][bj][m][1]; __VA_ARGS__ } asm volatile("" ::: "memory"); }
DI void rope4(const float* rope_row, int dp, const f32x4& v0, const f32x4& v1, f32x4& lo, f32x4& hi) {
    const f32x4 c = *(const f32x4*)(rope_row + dp), s = *(const f32x4*)(rope_row + 32 + dp);
    lo.x = v0.x * c.x - v0.y * s.x; hi.x = v0.y * c.x + v0.x * s.x; lo.y = v0.z * c.y - v0.w * s.y; hi.y = v0.w * c.y + v0.z * s.y;
    lo.z = v1.x * c.z - v1.y * s.z; hi.z = v1.y * c.z + v1.x * s.z; lo.w = v1.z * c.w - v1.w * s.w; hi.w = v1.w * c.w + v1.z * s.w; }
DI u32x2 pk4(const f32x4& v) { u32x2 o; o.x = pk2(v.x, v.y); o.y = pk2(v.z, v.w); return o; }
DI u32x4 pk8(const f32x4& a, const f32x4& b) { u32x4 o; o.x = pk2(a.x, a.y); o.y = pk2(a.z, a.w); o.z = pk2(b.x, b.y); o.w = pk2(b.z, b.w); return o; }
DI int dil_perm(int t, int d) { return (t % d) * (SEQ / d) + t / d; }
struct EpiA {
    static constexpr bool PERM = true, AFTER_DRAIN = false; const FP& P;
    DI void operator()(const f32x4 (&acc)[2][2][4][2], const pg8::Unit& u, int wr, int wc, int fr, int fq) const {
        const int t9 = u.pn; const int g = t9 / 3, j = t9 % 3;
        EPI_LOOP({ if (row < MP) { const int h = ct >> 6, e = ct & 63; const int pos = row_pos(row);
            if (t9 == 9) { *(u32x4*)(P.MQA + (size_t)row * 256 + ct) = pk8(v0 * QSCALE, v1 * QSCALE); }
            else if (j < 2) { f32x4 lo, hi; const int dp = e >> 1; rope4(P.ROPE + pos * 64, dp, v0, v1, lo, hi);
                if (j == 0) { bf16* q = P.QA + ((size_t)g * MPAD + row) * 256 + h * 64 + dp; *(u32x2*)q = pk4(lo * QSCALE); *(u32x2*)(q + 32) = pk4(hi * QSCALE); }
                else { if (row < M0) { bf16* kt = P.KA + ((size_t)(g * BATCH + row / SEQ) * DIL_HEADS + h) * 64 * SEQ; const int cm = dil_perm(pos, dil_d(g)); *(u32x2*)(kt + ktile_off(cm, dp)) = pk4(lo); *(u32x2*)(kt + ktile_off(cm, dp + 32)) = pk4(hi); }
                    const int W = dil_w(g); float* o = nullptr;
                    if (row >= M0) o = sel3(P.dil_s, g) + (((size_t)(row - M0) * W + W - 1) * 2 + 0) * 256; else if (pos >= SEQ - W) o = sel3(P.dil_p, g) + (((size_t)(row / SEQ) * W + pos - (SEQ - W)) * 2 + 0) * 256;
                    if (o) { *(f32x4*)(o + h * 64 + dp) = lo; *(f32x4*)(o + h * 64 + 32 + dp) = hi; } } }
            else { const int W = dil_w(g), d = dil_d(g); float* o = nullptr;
                if (row >= M0) o = sel3(P.dil_s, g) + (((size_t)(row - M0) * W + W - 1) * 2 + 1) * 256; else if (pos >= SEQ - W) o = sel3(P.dil_p, g) + (((size_t)(row / SEQ) * W + pos - (SEQ - W)) * 2 + 1) * 256;
                if (o) { *(f32x4*)(o + ct) = v0; *(f32x4*)(o + ct + 4) = v1; }
                if (row < M0) { bf16* vt = P.VTA + ((size_t)(g * BATCH + row / SEQ) * DIL_HEADS + h) * 64 * SEQ + vtile_off(e, dil_perm(pos, d));
                    vt[0] = (bf16)f2bf(v0.x); vt[8] = (bf16)f2bf(v0.y); vt[16] = (bf16)f2bf(v0.z); vt[24] = (bf16)f2bf(v0.w); vt[32] = (bf16)f2bf(v1.x); vt[40] = (bf16)f2bf(v1.y); vt[48] = (bf16)f2bf(v1.z); vt[56] = (bf16)f2bf(v1.w); } } } })
    }
};
struct EpiMem {
    static constexpr bool PERM = true, AFTER_DRAIN = false; const FP& P;
    DI void operator()(const f32x4 (&acc)[2][2][4][2], const pg8::Unit& u, int wr, int wc, int fr, int fq) const {
        const int l = u.pn >> 1, half = u.pn & 1;
        EPI_LOOP({ const int n = row / MEM_TOKENS, mt = row % MEM_TOKENS; float* o = P.mem_kv_p + (((size_t)l * BATCH + n) * MEM_TOKENS + mt) * 512 + half * 256 + ct; *(f32x4*)o = v0; *(f32x4*)(o + 4) = v1;
            if (half == 0) *(u32x4*)(P.MK + (((size_t)l * BATCH + n) * MEM_HEADS + (ct >> 6)) * MEM_TOKENS * 64 + ktile_off(mt, ct & 63)) = pk8(v0, v1);
            else { bf16* vt = P.MVT + (((size_t)l * BATCH + n) * MEM_HEADS + (ct >> 6)) * MEM_TOKENS * 64 + vtile_off(ct & 63, mt);
                vt[0] = (bf16)f2bf(v0.x); vt[8] = (bf16)f2bf(v0.y); vt[16] = (bf16)f2bf(v0.z); vt[24] = (bf16)f2bf(v0.w); vt[32] = (bf16)f2bf(v1.x); vt[40] = (bf16)f2bf(v1.y); vt[48] = (bf16)f2bf(v1.z); vt[56] = (bf16)f2bf(v1.w); } })
    }
};
struct EpiPre {
    static constexpr bool PERM = true, AFTER_DRAIN = false; const float* xa; const float* xb; float* pre;
    DI void operator()(const f32x4 (&acc)[2][2][4][2], const pg8::Unit& u, int wr, int wc, int fr, int fq) const {
        EPI_LOOP({ if (row < MP) { const int col = u.pn * 256 + ct; const float* x = (xb && row >= M0) ? xb + (size_t)(row - M0) * D_MODEL + col : xa + (size_t)row * D_MODEL + col;
            const f32x4 a = *(const f32x4*)x, b = *(const f32x4*)(x + 4); float* o = pre + (size_t)row * D_MODEL + col; *(f32x4*)o = a * ALPHA + v0; *(f32x4*)(o + 4) = b * ALPHA + v1; } })
    }
};
struct EpiF32 {
    static constexpr bool PERM = true, AFTER_DRAIN = false; float* out; int ldc; int nrows;
    DI void operator()(const f32x4 (&acc)[2][2][4][2], const pg8::Unit& u, int wr, int wc, int fr, int fq) const {
        EPI_LOOP({ if (row < nrows) { float* o = out + (size_t)row * ldc + u.pn * 256 + ct; *(f32x4*)o = v0; *(f32x4*)(o + 4) = v1; } })
    }
};
}
namespace fx {
struct Tile16 { f32x4 o[4]; float m, l; };
DI void tile_init(Tile16& T) { T.o[0] = T.o[1] = T.o[2] = T.o[3] = (f32x4){0.f, 0.f, 0.f, 0.f}; T.m = -INFINITY; T.l = 0.f; }
typedef __bf16 bf16x2_t __attribute__((ext_vector_type(2)));
DI unsigned cvtpk(float lo, float hi) { const f32x2 v = {lo, hi}; const bf16x2_t b = __builtin_convertvector(v, bf16x2_t); return __builtin_bit_cast(unsigned, b); }
struct KV8 { bf16x8 ka0, ka1, kb0, kb1, v0, v1, v2, v3; };
DI void kv_load(KV8& r, const bf16* k0, const bf16* k1, const bf16* v, long vs16) {
    r.ka0 = *(const bf16x8*)k0; r.ka1 = *(const bf16x8*)(k0 + 32); r.kb0 = *(const bf16x8*)k1; r.kb1 = *(const bf16x8*)(k1 + 32);
    r.v0 = *(const bf16x8*)v; r.v1 = *(const bf16x8*)(v + vs16); r.v2 = *(const bf16x8*)(v + 2 * vs16); r.v3 = *(const bf16x8*)(v + 3 * vs16); }
DI void mk_range(int a, int b, bool ok, int& lo, unsigned& rng) { const bool v = ok && b >= a; lo = v ? a : (1 << 20); rng = v ? (unsigned)(b - a) : 0u; }
DI float colmax(float x) { float a = x, b = x; asm volatile("s_nop 1\n\tv_permlane32_swap_b32 %0, %1" : "+v"(a), "+v"(b)); float m = fmaxf(a, b); a = m; b = m;
    asm volatile("s_nop 1\n\tv_permlane16_swap_b32 %0, %1" : "+v"(a), "+v"(b)); return fmaxf(a, b); }
DI float colsum(float x) { float a = x, b = x; asm volatile("s_nop 1\n\tv_permlane32_swap_b32 %0, %1" : "+v"(a), "+v"(b)); float m = a + b; a = m; b = m;
    asm volatile("s_nop 1\n\tv_permlane16_swap_b32 %0, %1" : "+v"(a), "+v"(b)); return a + b; }
DI void tile_compute(Tile16& T, const bf16x8 (&qf)[2], const KV8& r, int lo, unsigned rng) {
    f32x4 s0 = (f32x4){0.f, 0.f, 0.f, 0.f}, s1 = (f32x4){0.f, 0.f, 0.f, 0.f};
    s0 = __builtin_amdgcn_mfma_f32_16x16x32_bf16(r.ka0, qf[0], s0, 0, 0, 0); s0 = __builtin_amdgcn_mfma_f32_16x16x32_bf16(r.ka1, qf[1], s0, 0, 0, 0);
    s1 = __builtin_amdgcn_mfma_f32_16x16x32_bf16(r.kb0, qf[0], s1, 0, 0, 0); s1 = __builtin_amdgcn_mfma_f32_16x16x32_bf16(r.kb1, qf[1], s1, 0, 0, 0);
    float s[8] = {s0.x, s0.y, s0.z, s0.w, s1.x, s1.y, s1.z, s1.w};
    float mx = -INFINITY;
#pragma unroll
    for (int e = 0; e < 8; ++e) { s[e] = ((unsigned)(e - lo) <= rng) ? s[e] : -INFINITY; mx = fmaxf(mx, s[e]); }
    mx = colmax(mx);
    const float mnew = fmaxf(T.m, mx), muse = (mnew == -INFINITY) ? 0.f : mnew;
    const float alpha = __builtin_amdgcn_exp2f(T.m - muse);
    float ls = 0.f;
#pragma unroll
    for (int e = 0; e < 8; ++e) { s[e] = __builtin_amdgcn_exp2f(s[e] - muse); ls += s[e]; }
    T.l = T.l * alpha + ls; T.m = mnew;
    u32x4 pw; pw.x = cvtpk(s[0], s[1]); pw.y = cvtpk(s[2], s[3]); pw.z = cvtpk(s[4], s[5]); pw.w = cvtpk(s[6], s[7]);
    const bf16x8 pf = __builtin_bit_cast(bf16x8, pw);
    T.o[0] = __builtin_amdgcn_mfma_f32_16x16x32_bf16(r.v0, pf, T.o[0] * alpha, 0, 0, 0); T.o[1] = __builtin_amdgcn_mfma_f32_16x16x32_bf16(r.v1, pf, T.o[1] * alpha, 0, 0, 0);
    T.o[2] = __builtin_amdgcn_mfma_f32_16x16x32_bf16(r.v2, pf, T.o[2] * alpha, 0, 0, 0); T.o[3] = __builtin_amdgcn_mfma_f32_16x16x32_bf16(r.v3, pf, T.o[3] * alpha, 0, 0, 0);
}
template <class BUF, class LD, class CP> DI void pipe2t(int n, LD ld, CP cp) { if (n <= 0) return; BUF A, B; ld(A, 0);
#pragma unroll 1
    for (int i = 0; i < n; i += 2) { ld(B, (i + 1 < n) ? i + 1 : i); cp(A, i); ld(A, (i + 2 < n) ? i + 2 : i); if (i + 1 < n) cp(B, i + 1); } }
template <class LD, class CP> DI void pipe2(int n, LD ld, CP cp) { if (n <= 0) return; KV8 A, B; ld(A, 0);
#pragma unroll 1
    for (int i = 0; i < n; i += 2) { ld(B, (i + 1 < n) ? i + 1 : i); cp(A, i); ld(A, (i + 2 < n) ? i + 2 : i); if (i + 1 < n) cp(B, i + 1); } }
DI void kv_load_t(KV8& r, const bf16* kt, const bf16* vt, int lane) {
    const bf16* k = kt + lane * 8; const bf16* v = vt + lane * 8;
    r.ka0 = *(const bf16x8*)k; r.ka1 = *(const bf16x8*)(k + 512); r.kb0 = *(const bf16x8*)(k + 1024); r.kb1 = *(const bf16x8*)(k + 1536);
    r.v0 = *(const bf16x8*)v; r.v1 = *(const bf16x8*)(v + 512); r.v2 = *(const bf16x8*)(v + 1024); r.v3 = *(const bf16x8*)(v + 1536); }
DI int krow_of(int i, int b) { return 8 * (i >> 2) + 4 * b + (i & 3); }

DI void dil_micro(const FP& P, int n, int h, int t0, int mt, int lane) {
    const int g = mt >> 4, idx = mt & 15, d = dil_d(g), per = 16 / d;
    const int r = idx / per, sub = idx % per, i0 = t0 / d + 16 * sub, ib = i0 - 128, NC = SEQ / d;
    const int q = lane & 15, c = lane >> 4;
    const bf16* Qb = P.QA + ((size_t)g * MPAD + (size_t)n * SEQ) * 256 + h * 64;
    const bf16* Kb = P.KA + ((size_t)(g * BATCH + n) * DIL_HEADS + h) * 64 * SEQ + (size_t)r * NC * 64; const bf16* Vb = P.VTA + ((size_t)(g * BATCH + n) * DIL_HEADS + h) * 64 * SEQ + (size_t)r * NC * 64;
    bf16x8 qf[2]; { const bf16* qp = Qb + (size_t)(r + d * (i0 + q)) * 256 + 8 * c; qf[0] = *(const bf16x8*)qp; qf[1] = *(const bf16x8*)(qp + 32); }
    Tile16 T; tile_init(T);
    const int qi = i0 + q; const int tb0 = ib >> 5  , nblk = ((i0 + 15) >> 5) - tb0 + 1;
    pipe2(nblk, [&](KV8& kv, int i) { int tb = tb0 + i; tb = tb < 0 ? 0 : tb; kv_load_t(kv, Kb + (size_t)tb * 2048, Vb + (size_t)tb * 2048, lane); },
          [&](const KV8& kv, int i) { const int k0 = 32 * (tb0 + i) + 8 * c; int lo; unsigned rng; const int a = qi - (DIL_TAPS - 1); mk_range((a > 0 ? a : 0) - k0, qi - k0, true, lo, rng); tile_compute(T, qf, kv, lo, rng); });
    const int row = n * SEQ + r + d * qi;
    float* op = P.DPART + (((size_t)g * MP + row) * DIL_HEADS + h) * 64 + 4 * c;
#pragma unroll
    for (int db = 0; db < 4; ++db) *(f32x4*)(op + 16 * db) = T.o[db];
    T.l = colsum(T.l);
    if (c == 0) { float* ml = P.DML + (((size_t)g * MP + row) * DIL_HEADS + h) * 2; ml[0] = T.m; ml[1] = T.l; }
}
DI void mem_micro(const FP& P, const bf16* Q  , int ldq, int row0, int layer, int n, int h, bf16* O  , int ldo, int lane) {
    const int q = lane & 15, c = lane >> 4;
    bf16x8 qf[2]; { const bf16* qp = Q + (size_t)(row0 + q) * ldq + 8 * c; qf[0] = *(const bf16x8*)qp; qf[1] = *(const bf16x8*)(qp + 32); }
    const bf16* Kb = P.MK + (((size_t)layer * BATCH + n) * MEM_HEADS + h) * MEM_TOKENS * 64; const bf16* Vb = P.MVT + (((size_t)layer * BATCH + n) * MEM_HEADS + h) * MEM_TOKENS * 64;
    Tile16 T; tile_init(T);
    pipe2(MEM_TOKENS / 32, [&](KV8& kv, int i) { kv_load_t(kv, Kb + (size_t)i * 2048, Vb + (size_t)i * 2048, lane); }, [&](const KV8& kv, int) { tile_compute(T, qf, kv, -8, 64u); });
    const float inv = 1.0f / colsum(T.l); bf16* op = O + (size_t)(row0 + q) * ldo + 4 * c;
#pragma unroll
    for (int db = 0; db < 4; ++db) *(u32x2*)(op + 16 * db) = pk4(T.o[db] * inv);
}
struct Dec { float m, l, o; };
template <class KF, class VF> DI void dec_chunk(Dec& D, const LAS float* q, int nk, KF kf, VF vf, int lane) {
    float s = -INFINITY;
    if (lane < nk) { const float* k = kf(lane); float a = 0.f;
#pragma unroll
        for (int d4 = 0; d4 < 16; ++d4) { const f32x4 kv = *(const f32x4*)(k + 4 * d4); a += kv.x * q[4 * d4] + kv.y * q[4 * d4 + 1] + kv.z * q[4 * d4 + 2] + kv.w * q[4 * d4 + 3]; }
        s = a; }
    const float mx = wave_max(s), mnew = fmaxf(D.m, mx), alpha = __builtin_amdgcn_exp2f(D.m - mnew);
    const float p = (lane < nk) ? __builtin_amdgcn_exp2f(s - mnew) : 0.f;
    D.l = D.l * alpha + wave_sum(p); D.m = mnew; float o = D.o * alpha;
    for (int j0 = 0; j0 < nk; j0 += 8) { float vv[8];
#pragma unroll
        for (int u = 0; u < 8; ++u) { const int jj = (j0 + u < nk) ? j0 + u : nk - 1; vv[u] = vf(jj)[lane]; }
#pragma unroll
        for (int u = 0; u < 8; ++u) { const float pj = (j0 + u < nk) ? __builtin_bit_cast(float, __builtin_amdgcn_readlane(__builtin_bit_cast(int, p), (j0 + u) & 63)) : 0.f; o += pj * vv[u]; } }
    D.o = o;
}
DI float dec_combine(const Ctx& C, const Dec& D) {
    LAS float* cb = (LAS float*)(C.lds + 4096);
    cb[C.wave * 66 + C.lane] = D.o; if (C.lane == 0) { cb[C.wave * 66 + 64] = D.m; cb[C.wave * 66 + 65] = D.l; }
    asm volatile("s_waitcnt lgkmcnt(0)" ::: "memory"); __syncthreads();
    float M = -INFINITY;
#pragma unroll
    for (int ww = 0; ww < NWAVES; ++ww) M = fmaxf(M, cb[ww * 66 + 64]);
    float L = 0.f, o = 0.f;
#pragma unroll
    for (int ww = 0; ww < NWAVES; ++ww) { const float mw = cb[ww * 66 + 64]; const float f = (mw == -INFINITY) ? 0.f : __builtin_amdgcn_exp2f(mw - M); L += f * cb[ww * 66 + 65]; o += f * cb[ww * 66 + C.lane]; }
    return o / L;
}
DI void atta_phase(const FP& P, const Ctx& C) {
    const int lane = C.lane, w = C.wave;
    constexpr int NT = SEQ / 256, NIT = BATCH * NT * DIL_HEADS;
    for (int it = C.vcu; it < NIT; it += C.G) { const int h = it % DIL_HEADS, tt = (it / DIL_HEADS) % NT, n = it / (DIL_HEADS * NT), t0 = tt * 256;
        for (int mt = w; mt < 48; mt += NWAVES) dil_micro(P, n, h, t0, mt, lane);
        asm volatile("s_waitcnt vmcnt(0)" ::: "memory"); __syncthreads();
        for (int i = C.tid; i < 256 * 16; i += NTHREADS) { const int tk = i >> 4, d4 = (i & 15) * 4; const int row = n * SEQ + t0 + tk;
            float mg[3], lg[3]; float M = -INFINITY;
#pragma unroll
            for (int g = 0; g < 3; ++g) { const float* ml = P.DML + (((size_t)g * MP + row) * DIL_HEADS + h) * 2; mg[g] = ml[0]; lg[g] = ml[1]; M = fmaxf(M, mg[g]); }
            f32x4 acc = (f32x4){0.f, 0.f, 0.f, 0.f}; float L = 0.f;
#pragma unroll
            for (int g = 0; g < 3; ++g) { const float wg = __builtin_amdgcn_exp2f(mg[g] - M); L += wg * lg[g]; acc += *(const f32x4*)(P.DPART + (((size_t)g * MP + row) * DIL_HEADS + h) * 64 + d4) * wg; }
            *(u32x2*)(P.ATTA + (size_t)row * 512 + h * 64 + d4) = pk4(acc * (1.0f / L)); }
        for (int mt = w; mt < 16; mt += NWAVES) mem_micro(P, P.MQA + h * 64, 256, n * SEQ + t0 + 16 * mt, 0, n, h, P.ATTA + 256 + h * 64, 512, lane);
        __syncthreads();
    }
    LAS float* qs = (LAS float*)C.lds;
    for (int it = C.vcu; it < DEC_BATCH * DIL_HEADS * 2; it += C.G) { const int kind = it & 1, h = (it >> 1) % DIL_HEADS, ns = (it >> 1) / DIL_HEADS, row = M0 + ns;
        __syncthreads();
        if (kind == 0) { if (C.tid < 192) qs[C.tid] = bf2f(P.QA[((size_t)(C.tid >> 6) * MPAD + row) * 256 + h * 64 + (C.tid & 63)]); } else { if (C.tid < 64) qs[C.tid] = bf2f(P.MQA[(size_t)row * 256 + h * 64 + C.tid]); }
        asm volatile("s_waitcnt lgkmcnt(0)" ::: "memory"); __syncthreads();
        Dec D; D.m = -INFINITY; D.l = 0.f; D.o = 0.f;
        if (kind == 0) { constexpr int CPG = (DIL_TAPS + 63) / 64;
            for (int ck = w; ck < 3 * CPG; ck += NWAVES) { const int g = ck / CPG, j0 = (ck % CPG) * 64; const int W = dil_w(g), d = dil_d(g); const float* cache = sel3c(P.cache_dil, g) + (size_t)ns * W * 512; const float* newrow = sel3(P.dil_s, g) + ((size_t)ns * W + W - 1) * 512;
                const int nk = (DIL_TAPS - j0) < 64 ? (DIL_TAPS - j0) : 64;
                dec_chunk(D, qs + g * 64, nk, [&](int j) { const int tap = j0 + j; return (tap == 0 ? newrow : cache + (size_t)(W - d * tap) * 512) + h * 64; },
                          [&](int j) { const int tap = j0 + j; return (tap == 0 ? newrow : cache + (size_t)(W - d * tap) * 512) + 256 + h * 64; }, lane); } }
        else { const float* mk = P.cache_mem_kv + ((size_t)0 * DEC_BATCH + ns) * MEM_TOKENS * 512;
            for (int ck = w; ck < MEM_TOKENS / 64; ck += NWAVES) { const int j0 = ck * 64; dec_chunk(D, qs, 64, [&](int j) { return mk + (size_t)(j0 + j) * 512 + h * 64; }, [&](int j) { return mk + (size_t)(j0 + j) * 512 + 256 + h * 64; }, lane); } }
        const float o = dec_combine(C, D);
        if (w == 0) P.ATTA[(size_t)row * 512 + (kind == 0 ? 0 : 256) + h * 64 + lane] = (bf16)f2bf(o);
    }
    __syncthreads();
}
DI void ln_phase(const FP& P, const Ctx& C, const float* pre, const float* gam, const float* bet, float* xo, bf16* xb, float* yp, float* ys) {
    const int gw = C.vcu * NWAVES + C.wave, NGW = C.G * NWAVES, lane = C.lane;
    for (int r = gw; r < MP; r += NGW) { const float* x = pre + (size_t)r * D_MODEL; f32x4 v[4]; float s = 0.f;
#pragma unroll
        for (int j = 0; j < 4; ++j) { v[j] = *(const f32x4*)(x + 256 * j + 4 * lane); s += (v[j].x + v[j].y) + (v[j].z + v[j].w); }
        const float mu = wave_sum(s) * (1.0f / D_MODEL); float s2 = 0.f;
#pragma unroll
        for (int j = 0; j < 4; ++j) { v[j] = v[j] - mu; s2 += (v[j].x * v[j].x + v[j].y * v[j].y) + (v[j].z * v[j].z + v[j].w * v[j].w); }
        const float rs = 1.0f / sqrtf(wave_sum(s2) * (1.0f / D_MODEL) + LN_EPS);
#pragma unroll
        for (int j = 0; j < 4; ++j) { const f32x4 gg = *(const f32x4*)(gam + 256 * j + 4 * lane), bb = *(const f32x4*)(bet + 256 * j + 4 * lane); const f32x4 o = v[j] * rs * gg + bb;
            if (xo) *(f32x4*)(xo + (size_t)r * D_MODEL + 256 * j + 4 * lane) = o;
            if (xb) *(u32x2*)(xb + (size_t)r * D_MODEL + 256 * j + 4 * lane) = pk4(o);
            if (yp) { if (r < M0) *(f32x4*)(yp + (size_t)r * D_MODEL + 256 * j + 4 * lane) = o; else *(f32x4*)(ys + (size_t)(r - M0) * D_MODEL + 256 * j + 4 * lane) = o; } }
    }
}
}
namespace fx {
#define INS16(V, I, v_, i_) do { const float _v = (v_); const int _i = (i_); bool _c[16]; _Pragma("unroll") for (int _k = 0; _k < 16; ++_k) _c[_k] = _v > V[_k]; \
    _Pragma("unroll") for (int _k = 15; _k >= 1; --_k) { V[_k] = _c[_k] ? (_c[_k - 1] ? V[_k - 1] : _v) : V[_k]; I[_k] = _c[_k] ? (_c[_k - 1] ? I[_k - 1] : _i) : I[_k]; } \
    V[0] = _c[0] ? _v : V[0]; I[0] = _c[0] ? _i : I[0]; } while (0)
DI void wave_top16_128(float a, float b, int lane, float& outv, int& outi) {
    outv = -INFINITY; outi = 0;
#pragma unroll 1
    for (int k = 0; k < 16; ++k) { const float m = wave_max(fmaxf(a, b)); const unsigned long long ba = __ballot(a == m), bb = __ballot(b == m); int idx;
        if (ba) { const int l = __builtin_ctzll(ba); idx = l; if (lane == l) a = -INFINITY; } else { const int l = __builtin_ctzll(bb); idx = 64 + l; if (lane == l) b = -INFINITY; }
        if (lane == k) { outv = m; outi = idx; } }
}
DI void topk_wave_item(const FP& P, long it, int lane) {
    const float* s = P.SCO + it * 256; float v1, v2; int i1, i2;
    wave_top16_128(s[lane], s[64 + lane], lane, v1, i1); wave_top16_128(s[128 + lane], s[192 + lane], lane, v2, i2);
    int a = 0, rem = lane; bool valid = false;
    for (int aa = 0; aa < 16; ++aa) { const int nb = 16 / (aa + 1); if (!valid) { if (rem < nb) { a = aa; valid = true; } else rem -= nb; } }
    const int b = valid ? rem : 0;
    float cs = __shfl(v1, a) + __shfl(v2, b); const int ce = __shfl(i1, a) * PEER_KEYS + __shfl(i2, b); if (!valid) cs = -INFINITY;
    float tv = -INFINITY; int te = 0;
#pragma unroll 1
    for (int k = 0; k < 16; ++k) { const float m = wave_max(cs); const unsigned long long bm = __ballot(cs == m); const int l = __builtin_ctzll(bm); const int e = __shfl(ce, l); if (lane == l) cs = -INFINITY; if (lane == k) { tv = m; te = e; } }
    const float mx = __shfl(tv, 0); const float ex = (lane < 16) ? __expf(tv - mx) : 0.f; const float z = wave_sum(ex);
    if (lane < 16) { P.SELG[it * 16 + lane] = ex / z; P.SELE[it * 16 + lane] = te; }
}
#define KINS16(V, key_) do { const float _key = (key_); _Pragma("unroll") for (int _k = 15; _k >= 1; --_k) V[_k] = __builtin_amdgcn_fmed3f(V[_k - 1], V[_k], _key); V[0] = fmaxf(V[0], _key); } while (0)
DI float pack_key(float v, unsigned lowbits, unsigned mask) { return __builtin_bit_cast(float, (__builtin_bit_cast(unsigned, v) & ~mask) | lowbits); }
DI void topk_phase(const FP& P, const Ctx& C) {
    const int lane = C.lane; LAS float* st = (LAS float*)(C.lds + C.wave * 16384);
    const int NWI = (M0 * PEER_HEADS) / 64;
    for (int wi = C.vcu * NWAVES + C.wave; wi < NWI; wi += C.G * NWAVES) {
        const long it0 = (long)wi * 64; const long it = it0 + lane;
        float V1[16], V2[16], V3[16];
#pragma unroll
        for (int k = 0; k < 16; ++k) { V1[k] = V2[k] = V3[k] = -INFINITY; }
#pragma unroll 1
        for (int ch = 0; ch < 8; ++ch) {
#pragma unroll
            for (int u = 0; u < 8; ++u) { const int f4 = u * 64 + lane, j = f4 >> 3, q = f4 & 7, hf = q >> 2, c4 = (q & 3) * 4; const long itj = it0 + j;
                const f32x4 v = *(const f32x4*)(P.SCO + itj * 256 + hf * 128 + ch * 16 + c4);
                st[j * 33 + hf * 16 + c4] = v.x; st[j * 33 + hf * 16 + c4 + 1] = v.y; st[j * 33 + hf * 16 + c4 + 2] = v.z; st[j * 33 + hf * 16 + c4 + 3] = v.w; }
            asm volatile("s_waitcnt lgkmcnt(0)" ::: "memory");
#pragma unroll 4
            for (int c = 0; c < 16; ++c) { const float va = st[lane * 33 + c], vb = st[lane * 33 + 16 + c]; const unsigned lb = 127u - (unsigned)(ch * 16 + c); KINS16(V1, pack_key(va, lb, 127u)); KINS16(V2, pack_key(vb, lb, 127u)); }
            asm volatile("s_waitcnt lgkmcnt(0)" ::: "memory");
        }
        LAS int* lc = (LAS int*)st;
        { int ord = 0;
#pragma unroll
          for (int a = 0; a < 16; ++a) { const unsigned ba = __builtin_bit_cast(unsigned, V1[a]); const float va = __builtin_bit_cast(float, ba & ~127u); const int ia = 127 - (int)(ba & 127u);
#pragma unroll
              for (int b = 0; b < 16; ++b) if ((a + 1) * (b + 1) <= 16) { const unsigned bb = __builtin_bit_cast(unsigned, V2[b]); const float vb = __builtin_bit_cast(float, bb & ~127u); const int ib = 127 - (int)(bb & 127u);
                  lc[lane * 51 + ord] = ia * PEER_KEYS + ib; KINS16(V3, pack_key(va + vb, 63u - (unsigned)ord, 63u)); ++ord; } } }
        asm volatile("s_waitcnt lgkmcnt(0)" ::: "memory");
        float g[16]; int e[16]; float z = 0.f; const float vmax = __builtin_bit_cast(float, __builtin_bit_cast(unsigned, V3[0]) & ~63u);
#pragma unroll
        for (int k = 0; k < 16; ++k) { const unsigned bk = __builtin_bit_cast(unsigned, V3[k]); e[k] = lc[lane * 51 + 63 - (int)(bk & 63u)]; g[k] = __expf(__builtin_bit_cast(float, bk & ~63u) - vmax); z += g[k]; }
        const float iz = 1.0f / z;
#pragma unroll
        for (int k4 = 0; k4 < 4; ++k4) { *(f32x4*)(P.SELG + it * 16 + 4 * k4) = (f32x4){g[4 * k4] * iz, g[4 * k4 + 1] * iz, g[4 * k4 + 2] * iz, g[4 * k4 + 3] * iz};
            *(int4*)(P.SELE + it * 16 + 4 * k4) = make_int4(e[4 * k4], e[4 * k4 + 1], e[4 * k4 + 2], e[4 * k4 + 3]); }
        asm volatile("s_waitcnt lgkmcnt(0)" ::: "memory");
    }
    for (int si = C.vcu * NWAVES + C.wave; si < DEC_BATCH * PEER_HEADS; si += C.G * NWAVES) topk_wave_item(P, (long)M0 * PEER_HEADS + si, lane);
    __syncthreads();
}
constexpr float PEER_SU = 256.f, PEER_SV = 64.f;
DI float dot16_fp8(const u32x4& w, const f32x2 (&x2)[8]) { f32x2 a = {0.f, 0.f};
    a += __builtin_amdgcn_cvt_pk_f32_fp8((int)w.x, false) * x2[0]; a += __builtin_amdgcn_cvt_pk_f32_fp8((int)w.x, true) * x2[1];
    a += __builtin_amdgcn_cvt_pk_f32_fp8((int)w.y, false) * x2[2]; a += __builtin_amdgcn_cvt_pk_f32_fp8((int)w.y, true) * x2[3];
    a += __builtin_amdgcn_cvt_pk_f32_fp8((int)w.z, false) * x2[4]; a += __builtin_amdgcn_cvt_pk_f32_fp8((int)w.z, true) * x2[5];
    a += __builtin_amdgcn_cvt_pk_f32_fp8((int)w.w, false) * x2[6]; a += __builtin_amdgcn_cvt_pk_f32_fp8((int)w.w, true) * x2[7];
    return a.x + a.y; }
DI void axpy16_fp8(const u32x4& w, float s, f32x2 (&o2)[8]) { const f32x2 s2 = {s, s};
    o2[0] += __builtin_amdgcn_cvt_pk_f32_fp8((int)w.x, false) * s2; o2[1] += __builtin_amdgcn_cvt_pk_f32_fp8((int)w.x, true) * s2;
    o2[2] += __builtin_amdgcn_cvt_pk_f32_fp8((int)w.y, false) * s2; o2[3] += __builtin_amdgcn_cvt_pk_f32_fp8((int)w.y, true) * s2;
    o2[4] += __builtin_amdgcn_cvt_pk_f32_fp8((int)w.z, false) * s2; o2[5] += __builtin_amdgcn_cvt_pk_f32_fp8((int)w.z, true) * s2;
    o2[6] += __builtin_amdgcn_cvt_pk_f32_fp8((int)w.w, false) * s2; o2[7] += __builtin_amdgcn_cvt_pk_f32_fp8((int)w.w, true) * s2; }
#if defined(PEER_SHARD) || defined(PEER_SHARD2)
#define PEER_FIRST_ROUND nrounds
#else
#define PEER_FIRST_ROUND 0
#endif
template <int CTRL> DI float dppf(float x) { return __builtin_bit_cast(float, __builtin_amdgcn_update_dpp(0, __builtin_bit_cast(int, x), CTRL, 0xF, 0xF, true)); }
DI float rdlane(float v, int l) { return __builtin_bit_cast(float, __builtin_amdgcn_readlane(__builtin_bit_cast(int, v), l)); }
DI void peer_phase(const FP& P, const Ctx& C, int layer, const float* xin, float* fout, float* fout_s, bf16* xb, bool samples_only = false) {
    const int lane = C.lane; const unsigned char* U = P.UB8 + (size_t)layer * PEER_EXPERTS * D_MODEL; const unsigned char* Vt = P.VB8 + (size_t)layer * PEER_EXPERTS * D_MODEL;
    const float* gam = P.ln_g + ((size_t)layer * 2 + 1) * D_MODEL; const float* bet = P.ln_b + ((size_t)layer * 2 + 1) * D_MODEL;
    const int nrounds = (M0 + C.G * NWAVES - 1) / (C.G * NWAVES);
#pragma unroll 1
    for (int rd = samples_only ? nrounds : 0; rd <= nrounds; ++rd) {
        const bool smp = (rd == nrounds); int r = smp ? M0 + C.vcu : rd * C.G * NWAVES + C.vcu * NWAVES + C.wave; if (smp ? (C.vcu >= DEC_BATCH) : (r >= M0)) continue;
        const int pb = smp ? 16 * C.wave : 0, pe = smp ? pb + 16 : 128;
        f32x2 x2[8], o2[8];
#pragma unroll
        for (int j = 0; j < 4; ++j) { const f32x4 a = *(const f32x4*)(xin + (size_t)r * D_MODEL + 16 * lane + 4 * j); x2[2 * j] = (f32x2){a.x, a.y}; x2[2 * j + 1] = (f32x2){a.z, a.w}; }
#pragma unroll
        for (int k = 0; k < 8; ++k) o2[k] = (f32x2){0.f, 0.f};
        const int e_l = P.SELE[(size_t)r * 128 + lane], e_h = P.SELE[(size_t)r * 128 + 64 + lane]; const float g_l = P.SELG[(size_t)r * 128 + lane], g_h = P.SELG[(size_t)r * 128 + 64 + lane];
#pragma unroll 1
        for (int b0 = pb; b0 < pe; b0 += 8) {
            u32x4 uw[8], vw[8];
#pragma unroll
            for (int k = 0; k < 8; ++k) { const int hk = b0 + k; const int e = (hk < 64) ? __builtin_amdgcn_readlane(e_l, hk & 63) : __builtin_amdgcn_readlane(e_h, hk & 63);
                uw[k] = *(const u32x4*)(U + (size_t)e * D_MODEL + 16 * lane); vw[k] = *(const u32x4*)(Vt + (size_t)e * D_MODEL + 16 * lane); }
            float d[8];
#pragma unroll
            for (int k = 0; k < 8; ++k) d[k] = dot16_fp8(uw[k], x2);
            float e4[4], e2[2], e1;
            { const bool hi = lane & 1;
#pragma unroll
              for (int i = 0; i < 4; ++i) { const float keep = hi ? d[4 + i] : d[i], send = hi ? d[i] : d[4 + i]; e4[i] = keep + __shfl_xor(send, 1); } }
            { const bool hi = lane & 2;
#pragma unroll
              for (int i = 0; i < 2; ++i) { const float keep = hi ? e4[2 + i] : e4[i], send = hi ? e4[i] : e4[2 + i]; e2[i] = keep + __shfl_xor(send, 2); } }
            { const bool hi = lane & 4; const float keep = hi ? e2[1] : e2[0], send = hi ? e2[0] : e2[1]; e1 = keep + __shfl_xor(send, 4); }
            e1 += __shfl_xor(e1, 8); e1 += __shfl_xor(e1, 16); e1 += __shfl_xor(e1, 32);
            const int myk = 4 * (lane & 1) + (lane & 2) + ((lane >> 2) & 1); const int myhk = b0 + myk;
            const float myg = (myhk < 64) ? __shfl(g_l, myhk & 63) : __shfl(g_h, myhk & 63);
            const float act = myg * gelu_tanh(e1 * (1.0f / PEER_SU)) * (1.0f / PEER_SV);
#pragma unroll
            for (int k = 0; k < 8; ++k) { const int src = (k >> 2) | (((k >> 1) & 1) << 1) | ((k & 1) << 2); axpy16_fp8(vw[k], rdlane(act, src), o2); }
        }
        if (smp) {
            LAS float* red = (LAS float*)C.lds;
#pragma unroll
            for (int k = 0; k < 8; ++k) { red[C.wave * 1024 + 16 * lane + 2 * k] = o2[k].x; red[C.wave * 1024 + 16 * lane + 2 * k + 1] = o2[k].y; }
            asm volatile("s_waitcnt lgkmcnt(0)" ::: "memory"); __syncthreads();
            if (C.wave == 0) {
#pragma unroll
                for (int k = 0; k < 8; ++k) { float ax = 0.f, ay = 0.f;
#pragma unroll
                    for (int ww = 0; ww < NWAVES; ++ww) { ax += red[ww * 1024 + 16 * lane + 2 * k]; ay += red[ww * 1024 + 16 * lane + 2 * k + 1]; } o2[k] = (f32x2){ax, ay}; } }
            __syncthreads();
            if (C.wave != 0) continue; }
        float s = 0.f;
#pragma unroll
        for (int k = 0; k < 8; ++k) { o2[k] += x2[k] * ALPHA; s += o2[k].x + o2[k].y; }
        const float mu = wave_sum(s) * (1.0f / D_MODEL); float s2 = 0.f;
#pragma unroll
        for (int k = 0; k < 8; ++k) { o2[k] -= mu; s2 += o2[k].x * o2[k].x + o2[k].y * o2[k].y; }
        const float rs = 1.0f / sqrtf(wave_sum(s2) * (1.0f / D_MODEL) + LN_EPS);
        float* frow = (r < M0) ? fout + (size_t)r * D_MODEL : fout_s + (size_t)(r - M0) * D_MODEL;
#pragma unroll
        for (int j = 0; j < 4; ++j) { const int c0 = 16 * lane + 4 * j; const f32x4 gg = *(const f32x4*)(gam + c0), bb = *(const f32x4*)(bet + c0);
            const f32x4 y = (f32x4){o2[2 * j].x * rs, o2[2 * j].y * rs, o2[2 * j + 1].x * rs, o2[2 * j + 1].y * rs} * gg + bb;
            *(f32x4*)(frow + c0) = y; if (xb) *(u32x2*)(xb + (size_t)r * D_MODEL + c0) = pk4(y); }
    }
}
DI void peer_u_phase(const FP& P, const Ctx& C, int layer, const bf16* xb16) {
    const int lane = C.lane; const unsigned char* U = P.UB8 + (size_t)layer * PEER_EXPERTS * D_MODEL;
    const int s = (int)(blockIdx.x & 7), nw = (C.G >> 3) * NWAVES, widx = (int)(blockIdx.x >> 3) * NWAVES + C.wave;
#pragma unroll 1
    for (int r = widx; r < MP; r += nw) {
        const int e0 = P.SELE[(size_t)r * 128 + lane], e1 = P.SELE[(size_t)r * 128 + 64 + lane]; const float g0 = P.SELG[(size_t)r * 128 + lane], g1 = P.SELG[(size_t)r * 128 + 64 + lane];
        unsigned long long b0 = __ballot((e0 >> 11) == s), b1 = __ballot((e1 >> 11) == s);
        if ((b0 | b1) == 0ull) continue;
        f32x2 x2[8]; { const u32x4 xa = *(const u32x4*)(xb16 + (size_t)r * D_MODEL + 16 * lane), xc = *(const u32x4*)(xb16 + (size_t)r * D_MODEL + 16 * lane + 8);
            x2[0] = (f32x2){bflo(xa.x), bfhi(xa.x)}; x2[1] = (f32x2){bflo(xa.y), bfhi(xa.y)}; x2[2] = (f32x2){bflo(xa.z), bfhi(xa.z)}; x2[3] = (f32x2){bflo(xa.w), bfhi(xa.w)};
            x2[4] = (f32x2){bflo(xc.x), bfhi(xc.x)}; x2[5] = (f32x2){bflo(xc.y), bfhi(xc.y)}; x2[6] = (f32x2){bflo(xc.z), bfhi(xc.z)}; x2[7] = (f32x2){bflo(xc.w), bfhi(xc.w)}; }
#pragma unroll 1
        while ((b0 | b1) != 0ull) {
            int hk[8]; u32x4 uw[8]; int nv = 0;
#pragma unroll
            for (int k = 0; k < 8; ++k) { int h;
                if (b0) { h = __builtin_ctzll(b0); b0 &= b0 - 1; ++nv; } else if (b1) { h = 64 + __builtin_ctzll(b1); b1 &= b1 - 1; ++nv; } else h = hk[k > 0 ? k - 1 : 0];
                hk[k] = h; const int e = (h < 64) ? __builtin_amdgcn_readlane(e0, h & 63) : __builtin_amdgcn_readlane(e1, h & 63);
                uw[k] = *(const u32x4*)(U + (size_t)e * D_MODEL + 16 * lane); }
            float d[8];
#pragma unroll
            for (int k = 0; k < 8; ++k) d[k] = dot16_fp8(uw[k], x2);
            float e4[4], e2[2], e1s;
            { const bool hi = lane & 1;
#pragma unroll
              for (int i = 0; i < 4; ++i) { const float keep = hi ? d[4 + i] : d[i], send = hi ? d[i] : d[4 + i]; e4[i] = keep + __shfl_xor(send, 1); } }
            { const bool hi = lane & 2;
#pragma unroll
              for (int i = 0; i < 2; ++i) { const float keep = hi ? e4[2 + i] : e4[i], send = hi ? e4[i] : e4[2 + i]; e2[i] = keep + __shfl_xor(send, 2); } }
            { const bool hi = lane & 4; const float keep = hi ? e2[1] : e2[0], send = hi ? e2[0] : e2[1]; e1s = keep + __shfl_xor(send, 4); }
            e1s += __shfl_xor(e1s, 8); e1s += __shfl_xor(e1s, 16); e1s += __shfl_xor(e1s, 32);
            const int myk = 4 * (lane & 1) + (lane & 2) + ((lane >> 2) & 1);
            int myh = hk[0];
#pragma unroll
            for (int k = 1; k < 8; ++k) myh = (myk == k) ? hk[k] : myh;
            const float ga = __shfl(g0, myh & 63), gb = __shfl(g1, myh & 63); const float myg = (myh < 64) ? ga : gb;
            if (lane < 8 && myk < nv) P.SCO[(size_t)r * 128 + myh] = myg * gelu_tanh(e1s * (1.0f / PEER_SU)) * (1.0f / PEER_SV);
        }
    }
}
DI void peer_v_phase(const FP& P, const Ctx& C, int layer, const float* xin, float* fout, float* fout_s, bf16* xb) {
    const int lane = C.lane; const unsigned char* Vt = P.VB8 + (size_t)layer * PEER_EXPERTS * D_MODEL;
    const float* gam = P.ln_g + ((size_t)layer * 2 + 1) * D_MODEL; const float* bet = P.ln_b + ((size_t)layer * 2 + 1) * D_MODEL;
    const int nrounds = (M0 + C.G * NWAVES - 1) / (C.G * NWAVES);
#pragma unroll 1
    for (int rd = 0; rd <= nrounds; ++rd) {
        const bool smp = (rd == nrounds); int r = smp ? M0 + C.vcu : rd * C.G * NWAVES + C.vcu * NWAVES + C.wave; if (smp ? (C.vcu >= DEC_BATCH) : (r >= M0)) continue;
        const int pb = smp ? 16 * C.wave : 0, pe = smp ? pb + 16 : 128;
        f32x2 x2[8], o2[8];
#pragma unroll
        for (int j = 0; j < 4; ++j) { const f32x4 a = *(const f32x4*)(xin + (size_t)r * D_MODEL + 16 * lane + 4 * j); x2[2 * j] = (f32x2){a.x, a.y}; x2[2 * j + 1] = (f32x2){a.z, a.w}; }
#pragma unroll
        for (int k = 0; k < 8; ++k) o2[k] = (f32x2){0.f, 0.f};
        const int e_l = P.SELE[(size_t)r * 128 + lane], e_h = P.SELE[(size_t)r * 128 + 64 + lane]; const float a_l = P.SCO[(size_t)r * 128 + lane], a_h = P.SCO[(size_t)r * 128 + 64 + lane];
#pragma unroll 1
        for (int b0 = pb; b0 < pe; b0 += 16) { u32x4 vw[16];
#pragma unroll
            for (int k = 0; k < 16; ++k) { const int hk = b0 + k; const int e = (hk < 64) ? __builtin_amdgcn_readlane(e_l, hk & 63) : __builtin_amdgcn_readlane(e_h, hk & 63); vw[k] = *(const u32x4*)(Vt + (size_t)e * D_MODEL + 16 * lane); }
#pragma unroll
            for (int k = 0; k < 16; ++k) { const int hk = b0 + k; axpy16_fp8(vw[k], (hk < 64) ? rdlane(a_l, hk & 63) : rdlane(a_h, hk & 63), o2); } }
        if (smp) {
            LAS float* red = (LAS float*)C.lds;
#pragma unroll
            for (int k = 0; k < 8; ++k) { red[C.wave * 1024 + 16 * lane + 2 * k] = o2[k].x; red[C.wave * 1024 + 16 * lane + 2 * k + 1] = o2[k].y; }
            asm volatile("s_waitcnt lgkmcnt(0)" ::: "memory"); __syncthreads();
            if (C.wave == 0) {
#pragma unroll
                for (int k = 0; k < 8; ++k) { float ax = 0.f, ay = 0.f;
#pragma unroll
                    for (int ww = 0; ww < NWAVES; ++ww) { ax += red[ww * 1024 + 16 * lane + 2 * k]; ay += red[ww * 1024 + 16 * lane + 2 * k + 1]; } o2[k] = (f32x2){ax, ay}; } }
            __syncthreads();
            if (C.wave != 0) continue; }
        float s = 0.f;
#pragma unroll
        for (int k = 0; k < 8; ++k) { o2[k] += x2[k] * ALPHA; s += o2[k].x + o2[k].y; }
        const float mu = wave_sum(s) * (1.0f / D_MODEL); float s2 = 0.f;
#pragma unroll
        for (int k = 0; k < 8; ++k) { o2[k] -= mu; s2 += o2[k].x * o2[k].x + o2[k].y * o2[k].y; }
        const float rs = 1.0f / sqrtf(wave_sum(s2) * (1.0f / D_MODEL) + LN_EPS);
        float* frow = (r < M0) ? fout + (size_t)r * D_MODEL : fout_s + (size_t)(r - M0) * D_MODEL;
#pragma unroll
        for (int j = 0; j < 4; ++j) { const int c0 = 16 * lane + 4 * j; const f32x4 gg = *(const f32x4*)(gam + c0), bb = *(const f32x4*)(bet + c0);
            const f32x4 y = (f32x4){o2[2 * j].x * rs, o2[2 * j].y * rs, o2[2 * j + 1].x * rs, o2[2 * j + 1].y * rs} * gg + bb;
            *(f32x4*)(frow + c0) = y; if (xb) *(u32x2*)(xb + (size_t)r * D_MODEL + c0) = pk4(y); }
    }
}
constexpr int PSH_LIST = 512;
struct PG4 { u32x4 u[4], v[4]; };
DI void peer_sharded_phase(const FP& P, const Ctx& C, int layer, const float* xin, const bf16* xb16, float* fout, float* fout_s, bf16* xb) {
    const int lane = C.lane; const unsigned char* U = P.UB8 + (size_t)layer * PEER_EXPERTS * D_MODEL; const unsigned char* Vt = P.VB8 + (size_t)layer * PEER_EXPERTS * D_MODEL;
    const float* gam = P.ln_g + ((size_t)layer * 2 + 1) * D_MODEL; const float* bet = P.ln_b + ((size_t)layer * 2 + 1) * D_MODEL;
    LAS unsigned char* wl = C.lds + C.wave * 16384; LAS bf16* xs = (LAS bf16*)wl; LAS int* lst = (LAS int*)(wl + 8192);
    const int NW = C.G * NWAVES, gw = C.vcu * NWAVES + C.wave; const int nquads = (M0 / NW) / 4;
#pragma unroll 1
    for (int qd = 0; qd < nquads; ++qd) {
#define PSH_ROW(j) const int row##j = (qd * 4 + j) * NW + gw; const int el##j = P.SELE[(size_t)row##j * 128 + lane], eh##j = P.SELE[(size_t)row##j * 128 + 64 + lane]; const float gl##j = P.SELG[(size_t)row##j * 128 + lane], gh##j = P.SELG[(size_t)row##j * 128 + 64 + lane]; \
        { const u32x4 xa = *(const u32x4*)(xb16 + (size_t)row##j * D_MODEL + 16 * lane), xc = *(const u32x4*)(xb16 + (size_t)row##j * D_MODEL + 16 * lane + 8); *(LAS u32x4*)(xs + j * 1024 + 16 * lane) = xa; *(LAS u32x4*)(xs + j * 1024 + 16 * lane + 8) = xc; } \
        f32x2 oa##j[8]; _Pragma("unroll") for (int k = 0; k < 8; ++k) oa##j[k] = (f32x2){0.f, 0.f};
        PSH_ROW(0) PSH_ROW(1) PSH_ROW(2) PSH_ROW(3)
#pragma unroll 1
        for (int s = 0; s < 16; ++s) {
            int n = 0;
#define PSH_SCAN(j) { unsigned long long b0 = __ballot((el##j >> 10) == s), b1 = __ballot((eh##j >> 10) == s); \
                while (b0) { const int h = __builtin_ctzll(b0); b0 &= b0 - 1; const int e = __builtin_amdgcn_readlane(el##j, h); const int g = __builtin_amdgcn_readlane(__builtin_bit_cast(int, gl##j), h); \
                    if (lane == 0) { lst[4 * n] = e; lst[4 * n + 1] = g; lst[4 * n + 2] = j; } ++n; } \
                while (b1) { const int h = __builtin_ctzll(b1); b1 &= b1 - 1; const int e = __builtin_amdgcn_readlane(eh##j, h); const int g = __builtin_amdgcn_readlane(__builtin_bit_cast(int, gh##j), h); \
                    if (lane == 0) { lst[4 * n] = e; lst[4 * n + 1] = g; lst[4 * n + 2] = j; } ++n; } }
            PSH_SCAN(0) PSH_SCAN(1) PSH_SCAN(2) PSH_SCAN(3)
            asm volatile("s_waitcnt lgkmcnt(0)" ::: "memory");
            if (n == 0) continue;
            const int ngrp = (n + 3) >> 2;
#define PSH_LD(b, gi_) do { const int gi = (gi_); _Pragma("unroll") for (int k = 0; k < 4; ++k) { int i = 4 * gi + k; i = i < n ? i : n - 1; const int e = __builtin_amdgcn_readfirstlane(lst[4 * i]); \
                b.u[k] = *(const u32x4*)(U + (size_t)e * D_MODEL + 16 * lane); b.v[k] = *(const u32x4*)(Vt + (size_t)e * D_MODEL + 16 * lane); } } while (0)
#define PSH_CP(b, gi_) do { const int gi = (gi_); float d[4]; int jj[4]; float gg[4]; \
                _Pragma("unroll") for (int k = 0; k < 4; ++k) { int i = 4 * gi + k; const bool val = i < n; i = val ? i : n - 1; jj[k] = __builtin_amdgcn_readfirstlane(lst[4 * i + 2]); gg[k] = val ? __builtin_bit_cast(float, __builtin_amdgcn_readfirstlane(lst[4 * i + 1])) : 0.f; \
                    const u32x4 xa = *(const LAS u32x4*)(xs + jj[k] * 1024 + 16 * lane), xc = *(const LAS u32x4*)(xs + jj[k] * 1024 + 16 * lane + 8); \
                    const f32x2 x2[8] = {(f32x2){bflo(xa.x), bfhi(xa.x)}, (f32x2){bflo(xa.y), bfhi(xa.y)}, (f32x2){bflo(xa.z), bfhi(xa.z)}, (f32x2){bflo(xa.w), bfhi(xa.w)}, (f32x2){bflo(xc.x), bfhi(xc.x)}, (f32x2){bflo(xc.y), bfhi(xc.y)}, (f32x2){bflo(xc.z), bfhi(xc.z)}, (f32x2){bflo(xc.w), bfhi(xc.w)}}; \
                    d[k] = dot16_fp8(b.u[k], x2); } \
                float e2[2], e1; \
                { const bool hi = lane & 1; _Pragma("unroll") for (int i = 0; i < 2; ++i) { const float keep = hi ? d[2 + i] : d[i], send = hi ? d[i] : d[2 + i]; e2[i] = keep + __shfl_xor(send, 1); } } \
                { const bool hi = lane & 2; const float keep = hi ? e2[1] : e2[0], send = hi ? e2[0] : e2[1]; e1 = keep + __shfl_xor(send, 2); } \
                e1 += __shfl_xor(e1, 4); e1 += __shfl_xor(e1, 8); e1 += __shfl_xor(e1, 16); e1 += __shfl_xor(e1, 32); \
                const int myk = 2 * (lane & 1) + ((lane >> 1) & 1); \
                float myg = gg[0]; myg = (myk == 1) ? gg[1] : myg; myg = (myk == 2) ? gg[2] : myg; myg = (myk == 3) ? gg[3] : myg; \
                const float act = myg * gelu_tanh(e1 * (1.0f / PEER_SU)) * (1.0f / PEER_SV); \
                _Pragma("unroll") for (int k = 0; k < 4; ++k) { const float a = rdlane(act, (k >> 1) | ((k & 1) << 1)); \
                    if (jj[k] == 0) axpy16_fp8(b.v[k], a, oa0); else if (jj[k] == 1) axpy16_fp8(b.v[k], a, oa1); else if (jj[k] == 2) axpy16_fp8(b.v[k], a, oa2); else axpy16_fp8(b.v[k], a, oa3); } } while (0)
            { PG4 A, B; PSH_LD(A, 0);
#pragma unroll 1
              for (int g2 = 0; g2 < ngrp; g2 += 2) { PSH_LD(B, (g2 + 1 < ngrp) ? g2 + 1 : g2); PSH_CP(A, g2); PSH_LD(A, (g2 + 2 < ngrp) ? g2 + 2 : g2); if (g2 + 1 < ngrp) PSH_CP(B, g2 + 1); } }
            asm volatile("s_waitcnt lgkmcnt(0)" ::: "memory");
        }
#define PSH_LN(j) { const int r = row##j; f32x2 x2[8]; \
            _Pragma("unroll") for (int q = 0; q < 4; ++q) { const f32x4 a = *(const f32x4*)(xin + (size_t)r * D_MODEL + 16 * lane + 4 * q); x2[2 * q] = (f32x2){a.x, a.y}; x2[2 * q + 1] = (f32x2){a.z, a.w}; } \
            float sm = 0.f; _Pragma("unroll") for (int k = 0; k < 8; ++k) { oa##j[k] += x2[k] * ALPHA; sm += oa##j[k].x + oa##j[k].y; } \
            const float mu = wave_sum(sm) * (1.0f / D_MODEL); float s2 = 0.f; _Pragma("unroll") for (int k = 0; k < 8; ++k) { oa##j[k] -= mu; s2 += oa##j[k].x * oa##j[k].x + oa##j[k].y * oa##j[k].y; } \
            const float rs = 1.0f / sqrtf(wave_sum(s2) * (1.0f / D_MODEL) + LN_EPS); float* frow = fout + (size_t)r * D_MODEL; \
            _Pragma("unroll") for (int q = 0; q < 4; ++q) { const int c0 = 16 * lane + 4 * q; const f32x4 gv = *(const f32x4*)(gam + c0), bv = *(const f32x4*)(bet + c0); \
                const f32x4 y = (f32x4){oa##j[2 * q].x * rs, oa##j[2 * q].y * rs, oa##j[2 * q + 1].x * rs, oa##j[2 * q + 1].y * rs} * gv + bv; *(f32x4*)(frow + c0) = y; if (xb) *(u32x2*)(xb + (size_t)r * D_MODEL + c0) = pk4(y); } }
        PSH_LN(0) PSH_LN(1) PSH_LN(2) PSH_LN(3)
        asm volatile("s_waitcnt lgkmcnt(0)" ::: "memory");
    }
}
constexpr int PSH_LOG = 11, PSH_N = PEER_EXPERTS >> PSH_LOG;
#ifndef PS2_ROWS
#define PS2_ROWS 4
#endif
#define PS2_ROW(j) const int row##j = (qd * PS2_ROWS + j) * NW + gw; const int el##j = P.SELE[(size_t)row##j * 128 + lane], eh##j = P.SELE[(size_t)row##j * 128 + 64 + lane]; const float gl##j = P.SELG[(size_t)row##j * 128 + lane], gh##j = P.SELG[(size_t)row##j * 128 + 64 + lane]; \
    f32x2 oa##j[8]; _Pragma("unroll") for (int k = 0; k < 8; ++k) oa##j[k] = (f32x2){0.f, 0.f};
#define PS2_STEP(j) { unsigned long long b0 = __ballot((el##j >> PSH_LOG) == s), b1 = __ballot((eh##j >> PSH_LOG) == s); \
    if (b0 | b1) { const u32x4 xa##j = *(const u32x4*)(xb16 + (size_t)row##j * D_MODEL + 16 * lane), xc##j = *(const u32x4*)(xb16 + (size_t)row##j * D_MODEL + 16 * lane + 8);     \
      const f32x2 x2[8] = {(f32x2){bflo(xa##j.x), bfhi(xa##j.x)}, (f32x2){bflo(xa##j.y), bfhi(xa##j.y)}, (f32x2){bflo(xa##j.z), bfhi(xa##j.z)}, (f32x2){bflo(xa##j.w), bfhi(xa##j.w)}, (f32x2){bflo(xc##j.x), bfhi(xc##j.x)}, (f32x2){bflo(xc##j.y), bfhi(xc##j.y)}, (f32x2){bflo(xc##j.z), bfhi(xc##j.z)}, (f32x2){bflo(xc##j.w), bfhi(xc##j.w)}}; \
      _Pragma("unroll 1") while ((b0 | b1) != 0ull) { int hk[8]; u32x4 uw[8], vw[8]; int nv = 0; \
        _Pragma("unroll") for (int k = 0; k < 8; ++k) { int h; if (b0) { h = __builtin_ctzll(b0); b0 &= b0 - 1; ++nv; } else if (b1) { h = 64 + __builtin_ctzll(b1); b1 &= b1 - 1; ++nv; } else h = hk[k > 0 ? k - 1 : 0]; \
            hk[k] = h; const int e = (h < 64) ? __builtin_amdgcn_readlane(el##j, h & 63) : __builtin_amdgcn_readlane(eh##j, h & 63); \
            uw[k] = *(const u32x4*)(U + (size_t)e * D_MODEL + 16 * lane); vw[k] = *(const u32x4*)(Vt + (size_t)e * D_MODEL + 16 * lane); } \
        float d[8]; _Pragma("unroll") for (int k = 0; k < 8; ++k) d[k] = dot16_fp8(uw[k], x2); \
        float e4[4], e2[2], e1s; \
          \
        { const bool hi = lane & 1; _Pragma("unroll") for (int i = 0; i < 4; ++i) { const float keep = hi ? d[4 + i] : d[i], send = hi ? d[i] : d[4 + i]; e4[i] = keep + dppf<0xB1>(send); } } \
        { const bool hi = lane & 2; _Pragma("unroll") for (int i = 0; i < 2; ++i) { const float keep = hi ? e4[2 + i] : e4[i], send = hi ? e4[i] : e4[2 + i]; e2[i] = keep + dppf<0x4E>(send); } } \
        { const bool hi = lane & 4; const float keep = hi ? e2[1] : e2[0], send = hi ? e2[0] : e2[1]; const float r4 = dppf<0x124>(send), r12 = dppf<0x12C>(send); e1s = keep + (hi ? r4 : r12); } \
        e1s += dppf<0x128>(e1s); e1s = colsum(e1s); \
        const int myk = 4 * (lane & 1) + (lane & 2) + ((lane >> 2) & 1); int myh = hk[0]; _Pragma("unroll") for (int k = 1; k < 8; ++k) myh = (myk == k) ? hk[k] : myh; \
        const float ga = __shfl(gl##j, myh & 63), gb = __shfl(gh##j, myh & 63); const float myg = (myk < nv) ? ((myh < 64) ? ga : gb) : 0.f;     \
        const float act = myg * gelu_tanh(e1s * (1.0f / PEER_SU)) * (1.0f / PEER_SV); \
        _Pragma("unroll") for (int k = 0; k < 8; ++k) { const int src = (k >> 2) | (((k >> 1) & 1) << 1) | ((k & 1) << 2); axpy16_fp8(vw[k], rdlane(act, src), oa##j); } } } }
#define PS2_LN(j) { const int r = row##j; f32x2 x2[8]; int ll = lane; asm volatile("" : "+v"(ll));     \
    _Pragma("unroll") for (int q = 0; q < 4; ++q) { const f32x4 a = *(const f32x4*)(xin + (size_t)r * D_MODEL + 16 * ll + 4 * q); x2[2 * q] = (f32x2){a.x, a.y}; x2[2 * q + 1] = (f32x2){a.z, a.w}; } \
    float sm = 0.f; _Pragma("unroll") for (int k = 0; k < 8; ++k) { oa##j[k] += x2[k] * ALPHA; sm += oa##j[k].x + oa##j[k].y; } \
    const float mu = wave_sum(sm) * (1.0f / D_MODEL); float s2 = 0.f; _Pragma("unroll") for (int k = 0; k < 8; ++k) { oa##j[k] -= mu; s2 += oa##j[k].x * oa##j[k].x + oa##j[k].y * oa##j[k].y; } \
    const float rs = 1.0f / sqrtf(wave_sum(s2) * (1.0f / D_MODEL) + LN_EPS); float* frow = fout + (size_t)r * D_MODEL; \
    _Pragma("unroll") for (int q = 0; q < 4; ++q) { const int c0 = 16 * ll + 4 * q; const f32x4 gv = *(const f32x4*)(gam + c0), bv = *(const f32x4*)(bet + c0); \
        const f32x4 y = (f32x4){oa##j[2 * q].x * rs, oa##j[2 * q].y * rs, oa##j[2 * q + 1].x * rs, oa##j[2 * q + 1].y * rs} * gv + bv; *(f32x4*)(frow + c0) = y; if (xb) *(u32x2*)(xb + (size_t)r * D_MODEL + c0) = pk4(y); } }
DI void peer_sharded2_phase(const FP& P, const Ctx& C, int layer, const float* xin, const bf16* xb16, float* fout, bf16* xb) {
    const int lane = C.lane; const unsigned char* U = P.UB8 + (size_t)layer * PEER_EXPERTS * D_MODEL; const unsigned char* Vt = P.VB8 + (size_t)layer * PEER_EXPERTS * D_MODEL;
    const float* gam = P.ln_g + ((size_t)layer * 2 + 1) * D_MODEL; const float* bet = P.ln_b + ((size_t)layer * 2 + 1) * D_MODEL;
    const int NW = C.G * NWAVES, gw = C.vcu * NWAVES + C.wave; const int nquads = (M0 / NW) / PS2_ROWS;
#pragma unroll 1
    for (int qd = 0; qd < nquads; ++qd) {
#if PS2_ROWS == 4
        PS2_ROW(0) PS2_ROW(1) PS2_ROW(2) PS2_ROW(3)
#pragma unroll 1
        for (int s = 0; s < PSH_N; ++s) { PS2_STEP(0) PS2_STEP(1) PS2_STEP(2) PS2_STEP(3) }
        PS2_LN(0) PS2_LN(1) PS2_LN(2) PS2_LN(3)
#else
        PS2_ROW(0) PS2_ROW(1)
#pragma unroll 1
        for (int s = 0; s < PSH_N; ++s) { PS2_STEP(0) PS2_STEP(1) }
        PS2_LN(0) PS2_LN(1)
#endif
    }
}
#define PS3_ROW(j) const int row##j = (qd * 4 + j) * NW + gw; const int el##j = P.SELE[(size_t)row##j * 128 + lane], eh##j = P.SELE[(size_t)row##j * 128 + 64 + lane]; \
    { const u32x4 xa = *(const u32x4*)(xb16 + (size_t)row##j * D_MODEL + 16 * lane), xc = *(const u32x4*)(xb16 + (size_t)row##j * D_MODEL + 16 * lane + 8); *(LAS u32x4*)(xs + j * 1024 + 16 * lane) = xa; *(LAS u32x4*)(xs + j * 1024 + 16 * lane + 8) = xc; } \
    f32x2 oa##j[8]; _Pragma("unroll") for (int k = 0; k < 8; ++k) oa##j[k] = (f32x2){0.f, 0.f};
#define PS3_X2_UNUSED(j) const f32x2 x2[8] = {(f32x2){bflo(xa##j.x), bfhi(xa##j.x)}, (f32x2){bflo(xa##j.y), bfhi(xa##j.y)}, (f32x2){bflo(xa##j.z), bfhi(xa##j.z)}, (f32x2){bflo(xa##j.w), bfhi(xa##j.w)}, (f32x2){bflo(xc##j.x), bfhi(xc##j.x)}, (f32x2){bflo(xc##j.y), bfhi(xc##j.y)}, (f32x2){bflo(xc##j.z), bfhi(xc##j.z)}, (f32x2){bflo(xc##j.w), bfhi(xc##j.w)}};
#define PS3_TAKE(q, M, ELH, GOFF) if (!got && M) { const int h = __builtin_ctzll(M); M &= M - 1; qq[k] = q; ee = __builtin_amdgcn_readlane(ELH, h); gk[k] = P.SELG[GOFF + h];     got = true; ++nv; }
DI void peer_sharded3_phase(const FP& P, const Ctx& C, int layer, const float* xin, const bf16* xb16, float* fout, bf16* xb) {
    const int lane = C.lane; const unsigned char* U = P.UB8 + (size_t)layer * PEER_EXPERTS * D_MODEL; const unsigned char* Vt = P.VB8 + (size_t)layer * PEER_EXPERTS * D_MODEL;
    const float* gam = P.ln_g + ((size_t)layer * 2 + 1) * D_MODEL; const float* bet = P.ln_b + ((size_t)layer * 2 + 1) * D_MODEL;
    const int NW = C.G * NWAVES, gw = C.vcu * NWAVES + C.wave; const int nquads = (M0 / NW) / 4; LAS bf16* xs = (LAS bf16*)(C.lds + C.wave * 16384);
#pragma unroll 1
    for (int qd = 0; qd < nquads; ++qd) {
        PS3_ROW(0) PS3_ROW(1) PS3_ROW(2) PS3_ROW(3)
        asm volatile("s_waitcnt lgkmcnt(0)" ::: "memory");
#pragma unroll 1
        for (int s = 0; s < PSH_N; ++s) {
            unsigned long long m0 = __ballot((el0 >> PSH_LOG) == s), m1 = __ballot((eh0 >> PSH_LOG) == s), m2 = __ballot((el1 >> PSH_LOG) == s), m3 = __ballot((eh1 >> PSH_LOG) == s),
                               m4 = __ballot((el2 >> PSH_LOG) == s), m5 = __ballot((eh2 >> PSH_LOG) == s), m6 = __ballot((el3 >> PSH_LOG) == s), m7 = __ballot((eh3 >> PSH_LOG) == s);
#pragma unroll 1
            while ((m0 | m1 | m2 | m3 | m4 | m5 | m6 | m7) != 0ull) {
                int qq[8]; float gk[8]; int es[8]; u32x4 uw[8]; int nv = 0; int elast = 0;
#pragma unroll
                for (int k = 0; k < 8; ++k) { bool got = false; int ee = elast; qq[k] = k > 0 ? qq[k - 1] : 0; gk[k] = 0.f;
                    PS3_TAKE(0, m0, el0, (size_t)row0 * 128) PS3_TAKE(1, m1, eh0, (size_t)row0 * 128 + 64) PS3_TAKE(2, m2, el1, (size_t)row1 * 128) PS3_TAKE(3, m3, eh1, (size_t)row1 * 128 + 64) PS3_TAKE(4, m4, el2, (size_t)row2 * 128) PS3_TAKE(5, m5, eh2, (size_t)row2 * 128 + 64) PS3_TAKE(6, m6, el3, (size_t)row3 * 128) PS3_TAKE(7, m7, eh3, (size_t)row3 * 128 + 64)
                    elast = ee; es[k] = ee; uw[k] = *(const u32x4*)(U + (size_t)ee * D_MODEL + 16 * lane); }
                float d[8];
#pragma unroll
                for (int k = 0; k < 8; ++k) { const int j = qq[k] >> 1; const u32x4 xa = *(const LAS u32x4*)(xs + j * 1024 + 16 * lane), xc = *(const LAS u32x4*)(xs + j * 1024 + 16 * lane + 8);
                    const f32x2 x2[8] = {(f32x2){bflo(xa.x), bfhi(xa.x)}, (f32x2){bflo(xa.y), bfhi(xa.y)}, (f32x2){bflo(xa.z), bfhi(xa.z)}, (f32x2){bflo(xa.w), bfhi(xa.w)}, (f32x2){bflo(xc.x), bfhi(xc.x)}, (f32x2){bflo(xc.y), bfhi(xc.y)}, (f32x2){bflo(xc.z), bfhi(xc.z)}, (f32x2){bflo(xc.w), bfhi(xc.w)}};
                    d[k] = dot16_fp8(uw[k], x2); }
                u32x4 vw[8];
#pragma unroll
                for (int k = 0; k < 8; ++k) vw[k] = *(const u32x4*)(Vt + (size_t)es[k] * D_MODEL + 16 * lane);
                float e4[4], e2[2], e1s;
                { const bool hi = lane & 1;
#pragma unroll
                  for (int i = 0; i < 4; ++i) { const float keep = hi ? d[4 + i] : d[i], send = hi ? d[i] : d[4 + i]; e4[i] = keep + __shfl_xor(send, 1); } }
                { const bool hi = lane & 2;
#pragma unroll
                  for (int i = 0; i < 2; ++i) { const float keep = hi ? e4[2 + i] : e4[i], send = hi ? e4[i] : e4[2 + i]; e2[i] = keep + __shfl_xor(send, 2); } }
                { const bool hi = lane & 4; const float keep = hi ? e2[1] : e2[0], send = hi ? e2[0] : e2[1]; e1s = keep + __shfl_xor(send, 4); }
                e1s += __shfl_xor(e1s, 8); e1s += __shfl_xor(e1s, 16); e1s += __shfl_xor(e1s, 32);
                const int myk = 4 * (lane & 1) + (lane & 2) + ((lane >> 2) & 1); float myg = gk[0];
#pragma unroll
                for (int k = 1; k < 8; ++k) myg = (myk == k) ? gk[k] : myg;
                const float act = myg * gelu_tanh(e1s * (1.0f / PEER_SU)) * (1.0f / PEER_SV);
#pragma unroll
                for (int k = 0; k < 8; ++k) { const int src = (k >> 2) | (((k >> 1) & 1) << 1) | ((k & 1) << 2); const float a = rdlane(act, src); const int j = qq[k] >> 1;
                    if (j == 0) { asm volatile("" ::: "memory"); axpy16_fp8(vw[k], a, oa0); } else if (j == 1) { asm volatile("" ::: "memory"); axpy16_fp8(vw[k], a, oa1); } else if (j == 2) { asm volatile("" ::: "memory"); axpy16_fp8(vw[k], a, oa2); } else { asm volatile("" ::: "memory"); axpy16_fp8(vw[k], a, oa3); } }
            }
        }
        PS2_LN(0) PS2_LN(1) PS2_LN(2) PS2_LN(3)
    }
}
}
namespace fx {
struct EpiB {
    static constexpr bool PERM = true, AFTER_DRAIN = false; const FP& P;
    DI void operator()(const f32x4 (&acc)[2][2][4][2], const pg8::Unit& u, int wr, int wc, int fr, int fq) const {
        const int t = u.pn;
        EPI_LOOP({ if (row < MP) { const int pos = row_pos(row), n = row / SEQ, e = ct & 63, dp = e >> 1; const bool prm = row < M0;
            if (t < 3) { const int ty = 2 * t + (ct >> 7), kvh = (ct >> 6) & 1;
                if (ty == 2 || ty == 4) { f32x4 lo, hi; rope4(P.ROPE + pos * 64, dp, v0, v1, lo, hi);
                    if (ty == 2) { float* o = (prm ? P.nsa_kv_p + (size_t)row * 512 : P.nsa_kv_s + (size_t)(row - M0) * 512) + 256 + kvh * 64 + dp; *(f32x4*)o = lo; *(f32x4*)(o + 32) = hi;
                        if (prm) { bf16* kt = P.SLK + ((size_t)n * NSA_KV_HEADS + kvh) * SEQ * 64; *(u32x2*)(kt + ktile_off(pos, dp)) = pk4(lo); *(u32x2*)(kt + ktile_off(pos, dp + 32)) = pk4(hi); } }
                    else { float* o = nullptr; if (!prm) o = P.win_s + (((size_t)(row - M0) * SWA_WINDOW + SWA_WINDOW - 1) * 2 + 0) * 128; else if (pos >= SEQ - SWA_WINDOW) o = P.win_p + (((size_t)n * SWA_WINDOW + pos - (SEQ - SWA_WINDOW)) * 2 + 0) * 128;
                        if (o) { *(f32x4*)(o + kvh * 64 + dp) = lo; *(f32x4*)(o + kvh * 64 + 32 + dp) = hi; }
                        if (prm) { bf16* kt = P.WNK + ((size_t)n * NSA_KV_HEADS + kvh) * SEQ * 64; *(u32x2*)(kt + ktile_off(pos, dp)) = pk4(lo); *(u32x2*)(kt + ktile_off(pos, dp + 32)) = pk4(hi); } } }
                else if (ty < 4) { float* o = (prm ? P.nsa_kv_p + (size_t)row * 512 : P.nsa_kv_s + (size_t)(row - M0) * 512) + ty * 128 + kvh * 64 + e; *(f32x4*)o = v0; *(f32x4*)(o + 4) = v1;
                    if (prm) { if (ty < 2) *(u32x4*)(P.AC + ((size_t)ty * ACROWS + ((size_t)n * NSA_KV_HEADS + kvh) * NCH + pos / 16) * 1024 + (pos % 16) * 64 + e) = pk8(v0, v1);
                        else { bf16* vt = P.SLVT + ((size_t)n * NSA_KV_HEADS + kvh) * SEQ * 64 + vtile_off(e, pos);
                            vt[0] = (bf16)f2bf(v0.x); vt[8] = (bf16)f2bf(v0.y); vt[16] = (bf16)f2bf(v0.z); vt[24] = (bf16)f2bf(v0.w); vt[32] = (bf16)f2bf(v1.x); vt[40] = (bf16)f2bf(v1.y); vt[48] = (bf16)f2bf(v1.z); vt[56] = (bf16)f2bf(v1.w); } } }
                else { float* o = nullptr; if (!prm) o = P.win_s + (((size_t)(row - M0) * SWA_WINDOW + SWA_WINDOW - 1) * 2 + 1) * 128; else if (pos >= SEQ - SWA_WINDOW) o = P.win_p + (((size_t)n * SWA_WINDOW + pos - (SEQ - SWA_WINDOW)) * 2 + 1) * 128;
                    if (o) { *(f32x4*)(o + kvh * 64 + e) = v0; *(f32x4*)(o + kvh * 64 + e + 4) = v1; }
                    if (prm) { bf16* vt = P.WNVT + ((size_t)n * NSA_KV_HEADS + kvh) * SEQ * 64 + vtile_off(e, pos);
                        vt[0] = (bf16)f2bf(v0.x); vt[8] = (bf16)f2bf(v0.y); vt[16] = (bf16)f2bf(v0.z); vt[24] = (bf16)f2bf(v0.w); vt[32] = (bf16)f2bf(v1.x); vt[40] = (bf16)f2bf(v1.y); vt[48] = (bf16)f2bf(v1.z); vt[56] = (bf16)f2bf(v1.w); } } }
            else if (t < 6) { const int h = (t - 3) * 4 + (ct >> 6); f32x4 lo, hi; rope4(P.ROPE + pos * 64, dp, v0, v1, lo, hi); bf16* q = P.QB + (size_t)row * NSA_Q_COLS + h * 64 + dp; *(u32x2*)q = pk4(lo * QSCALE); *(u32x2*)(q + 32) = pk4(hi * QSCALE); }
            else if (t == 6) { *(u32x4*)(P.MQB + (size_t)row * 256 + ct) = pk8(v0 * QSCALE, v1 * QSCALE); }
            else if (ct < 40) { const float vv[8] = {v0.x, v0.y, v0.z, v0.w, v1.x, v1.y, v1.z, v1.w};
                _Pragma("unroll") for (int i = 0; i < 8; ++i) if (ct + i < NSA_GATE_COLS) P.GATES[(size_t)row * 64 + ct + i] = 1.0f / (1.0f + __expf(-vv[i])); } } })
    }
};
DI void cmp2_phase(const FP& P, const Ctx& C) {
    const int lane = C.lane; LAS float* hs = (LAS float*)(C.lds + C.wave * 1024);
    constexpr int NGRP = NCTX * 2 * NSA_KV_HEADS; const int NW = C.G * NWAVES, WPG = NW / NGRP > 0 ? NW / NGRP : 1; const int gw = C.vcu * NWAVES + C.wave;
#pragma unroll 1
    for (int grp = gw / WPG; grp < NGRP; grp += (NW + WPG - 1) / WPG) { const int slot = gw % WPG; if (gw >= (NW / WPG) * WPG && grp == gw / WPG) break;
        const int kvh = grp % NSA_KV_HEADS, ty = (grp / NSA_KV_HEADS) % 2, ctx = grp / (2 * NSA_KV_HEADS);
        const float* UL = P.UL + ((size_t)ty * ACROWS + ((size_t)ctx * NSA_KV_HEADS + kvh) * NCH) * 256; const float* w2 = P.cmp_w2 + (size_t)ty * CMP_HIDDEN * HEAD_DIM;
        float w2r[CMP_HIDDEN];
#pragma unroll
        for (int k = 0; k < CMP_HIDDEN; ++k) w2r[k] = w2[k * HEAD_DIM + lane];
        const float b0 = P.CBIAS[ty * CMP_HIDDEN + lane], b1 = P.CBIAS[ty * CMP_HIDDEN + 64 + lane];
        float u0, u1, l0, l1; int c = slot;
        if (c < NCMP) { u0 = UL[(size_t)c * 256 + lane]; u1 = UL[(size_t)c * 256 + 64 + lane]; l0 = UL[(size_t)(c + 1) * 256 + 128 + lane]; l1 = UL[(size_t)(c + 1) * 256 + 192 + lane]; }
#pragma unroll 1
        for (; c < NCMP; c += WPG) { const float h0 = gelu_tanh(u0 + l0 + b0), h1 = gelu_tanh(u1 + l1 + b1); const int cn = c + WPG;
            if (cn < NCMP) { u0 = UL[(size_t)cn * 256 + lane]; u1 = UL[(size_t)cn * 256 + 64 + lane]; l0 = UL[(size_t)(cn + 1) * 256 + 128 + lane]; l1 = UL[(size_t)(cn + 1) * 256 + 192 + lane]; }
            hs[lane] = h0; hs[64 + lane] = h1; asm volatile("s_waitcnt lgkmcnt(0)" ::: "memory");
            float a = 0.f;
#pragma unroll
            for (int k4 = 0; k4 < CMP_HIDDEN / 4; ++k4) { const f32x4 hv = *(const LAS f32x4*)(hs + 4 * k4); a += hv.x * w2r[4 * k4] + hv.y * w2r[4 * k4 + 1] + hv.z * w2r[4 * k4 + 2] + hv.w * w2r[4 * k4 + 3]; }
            if (ty == 0) { const float other = __shfl_xor(a, 32); const int pos = c * CMP_STRIDE + CMP_BLOCK - 1; const float cs = P.ROPE[pos * 64 + (lane & 31)], sn = P.ROPE[pos * 64 + 32 + (lane & 31)];
                a = (lane < 32) ? a * cs - other * sn : a * cs + other * sn; }
            if (ctx < BATCH) { if (ty == 0) P.CK[((size_t)ctx * NSA_KV_HEADS + kvh) * NCH * 64 + ktile_off(c, lane)] = (bf16)f2bf(a); else P.CVT[((size_t)ctx * NSA_KV_HEADS + kvh) * NCH * 64 + vtile_off(lane, c)] = (bf16)f2bf(a); }
            else { (ty == 0 ? P.CKF : P.CVF)[(((size_t)(ctx - BATCH) * NSA_KV_HEADS + kvh) * NCH + c) * 64 + lane] = a; }
            asm volatile("s_waitcnt lgkmcnt(0)" ::: "memory"); }
    }
    __syncthreads();
}
constexpr int NSA_WLDS = 8192;
DI void nsa_pair_a(const FP& P, int n, int kvh, int t, int lane, LAS unsigned char* wl) {
    LAS float* pn = (LAS float*)wl; LAS float* imp = (LAS float*)(wl + 2048); LAS float* sc = (LAS float*)(wl + 6144); LAS int* sel = (LAS int*)(wl + 7168);
    const int col = lane & 15, c = lane >> 4; const bool vcol = col < 12; const int qq = vcol ? col / 6 : 0, hh = vcol ? col % 6 : 0, tq = t + qq, head = kvh * NSA_GROUP + hh, row = n * SEQ + tq;
    bf16x8 qf[2]; { const bf16* qp = P.QB + (size_t)row * NSA_Q_COLS + head * 64 + 8 * c; qf[0] = *(const bf16x8*)qp; qf[1] = *(const bf16x8*)(qp + 32); }
    const float* gt = P.GATES + (size_t)row * 64 + head * 3;
    f32x4 oacc[4] = {(f32x4){0.f, 0.f, 0.f, 0.f}, (f32x4){0.f, 0.f, 0.f, 0.f}, (f32x4){0.f, 0.f, 0.f, 0.f}, (f32x4){0.f, 0.f, 0.f, 0.f}};
    const int lim = vcol ? ((tq >= CMP_BLOCK - 1) ? (tq - (CMP_BLOCK - 1)) / CMP_STRIDE : -1) : -1;
    const int limmax = (t + 1 >= CMP_BLOCK - 1) ? (t + 1 - (CMP_BLOCK - 1)) / CMP_STRIDE : -1; const int nblk = (limmax + 32) / 32;
    const bf16* CKb = P.CK + ((size_t)n * NSA_KV_HEADS + kvh) * NCH * 64; const bf16* CVb = P.CVT + ((size_t)n * NSA_KV_HEADS + kvh) * 64 * NCH;
    for (int i = lane; i < 1024; i += 64) imp[i] = 0.f;
    float m1 = -INFINITY, l1 = 0.f;
    { struct K4 { bf16x8 a0, a1, b0, b1; };
      auto ldk = [&](K4& k, int blk) { const bf16* kt = CKb + (size_t)blk * 2048 + lane * 8; k.a0 = *(const bf16x8*)kt; k.a1 = *(const bf16x8*)(kt + 512); k.b0 = *(const bf16x8*)(kt + 1024); k.b1 = *(const bf16x8*)(kt + 1536); };
      auto cp1 = [&](const K4& k, int blk) { const int kb = 32 * blk;
        f32x4 s0 = (f32x4){0.f, 0.f, 0.f, 0.f}, s1 = (f32x4){0.f, 0.f, 0.f, 0.f};
        s0 = __builtin_amdgcn_mfma_f32_16x16x32_bf16(k.a0, qf[0], s0, 0, 0, 0); s0 = __builtin_amdgcn_mfma_f32_16x16x32_bf16(k.a1, qf[1], s0, 0, 0, 0);
        s1 = __builtin_amdgcn_mfma_f32_16x16x32_bf16(k.b0, qf[0], s1, 0, 0, 0); s1 = __builtin_amdgcn_mfma_f32_16x16x32_bf16(k.b1, qf[1], s1, 0, 0, 0);
        float s[8] = {s0.x, s0.y, s0.z, s0.w, s1.x, s1.y, s1.z, s1.w}; float mx = -INFINITY;
        const int hi1 = lim - (kb + 8 * c);
#pragma unroll
        for (int e = 0; e < 8; ++e) { s[e] = (e <= hi1) ? s[e] : -INFINITY; mx = fmaxf(mx, s[e]); }
        mx = colmax(mx);
        const float mnew = fmaxf(m1, mx), muse = (mnew == -INFINITY) ? 0.f : mnew; float ls = 0.f;
#pragma unroll
        for (int e = 0; e < 8; ++e) ls += __builtin_amdgcn_exp2f(s[e] - muse);
        l1 = l1 * __builtin_amdgcn_exp2f(m1 - muse) + ls; m1 = mnew; };
      if (nblk > 0) { K4 A, B; ldk(A, 0);
#pragma unroll 1
        for (int blk = 0; blk < nblk; blk += 2) { ldk(B, (blk + 1 < nblk) ? blk + 1 : blk); cp1(A, blk); ldk(A, (blk + 2 < nblk) ? blk + 2 : blk); if (blk + 1 < nblk) cp1(B, blk + 1); } } }
    asm volatile("s_waitcnt lgkmcnt(0)" ::: "memory");
    { l1 = colsum(l1); const float muse = (m1 == -INFINITY) ? 0.f : m1, inv = (l1 > 0.f) ? 1.0f / l1 : 0.f;
      f32x4 oc[4] = {(f32x4){0.f, 0.f, 0.f, 0.f}, (f32x4){0.f, 0.f, 0.f, 0.f}, (f32x4){0.f, 0.f, 0.f, 0.f}, (f32x4){0.f, 0.f, 0.f, 0.f}};
      pipe2(nblk, [&](KV8& kv, int blk) { kv_load_t(kv, CKb + (size_t)blk * 2048, CVb + (size_t)blk * 2048, lane); }, [&](const KV8& kv, int blk) { const int kb = 32 * blk;
        f32x4 s0 = (f32x4){0.f, 0.f, 0.f, 0.f}, s1 = (f32x4){0.f, 0.f, 0.f, 0.f};
        s0 = __builtin_amdgcn_mfma_f32_16x16x32_bf16(kv.ka0, qf[0], s0, 0, 0, 0); s0 = __builtin_amdgcn_mfma_f32_16x16x32_bf16(kv.ka1, qf[1], s0, 0, 0, 0);
        s1 = __builtin_amdgcn_mfma_f32_16x16x32_bf16(kv.kb0, qf[0], s1, 0, 0, 0); s1 = __builtin_amdgcn_mfma_f32_16x16x32_bf16(kv.kb1, qf[1], s1, 0, 0, 0);
        float s[8] = {s0.x, s0.y, s0.z, s0.w, s1.x, s1.y, s1.z, s1.w};
        const int hi2 = lim - (kb + 8 * c);
#pragma unroll
        for (int e = 0; e < 8; ++e) s[e] = (e <= hi2) ? __builtin_amdgcn_exp2f(s[e] - muse) * inv : 0.f;
        *(f32x4*)(pn + col * 32 + 8 * c) = (f32x4){s[0], s[1], s[2], s[3]}; *(f32x4*)(pn + col * 32 + 8 * c + 4) = (f32x4){s[4], s[5], s[6], s[7]};
        u32x4 pw; pw.x = cvtpk(s[0], s[1]); pw.y = cvtpk(s[2], s[3]); pw.z = cvtpk(s[4], s[5]); pw.w = cvtpk(s[6], s[7]); const bf16x8 pf = __builtin_bit_cast(bf16x8, pw);
        oc[0] = __builtin_amdgcn_mfma_f32_16x16x32_bf16(kv.v0, pf, oc[0], 0, 0, 0); oc[1] = __builtin_amdgcn_mfma_f32_16x16x32_bf16(kv.v1, pf, oc[1], 0, 0, 0);
        oc[2] = __builtin_amdgcn_mfma_f32_16x16x32_bf16(kv.v2, pf, oc[2], 0, 0, 0); oc[3] = __builtin_amdgcn_mfma_f32_16x16x32_bf16(kv.v3, pf, oc[3], 0, 0, 0);
        asm volatile("s_waitcnt lgkmcnt(0)" ::: "memory");
        { const int q2 = lane >> 5, k = lane & 31; float a = 0.f;
#pragma unroll
          for (int h6 = 0; h6 < 6; ++h6) a += pn[(q2 * 6 + h6) * 32 + k];
          imp[q2 * 512 + kb + k] = a; }
        asm volatile("s_waitcnt lgkmcnt(0)" ::: "memory"); });
#ifdef NSA_DEBUG
      if (vcol) { for (int db = 0; db < 4; ++db) *(f32x4*)(P.DBG + ((size_t)0 * MP + row) * 768 + head * 64 + 16 * db + 4 * c) = oc[db]; }
#endif
      const float g0 = vcol ? gt[0] : 0.f;
#pragma unroll
      for (int db = 0; db < 4; ++db) oacc[db] += oc[db] * g0; }
#ifndef REP_SEL
#define REP_SEL 1
#endif
#pragma unroll 1
    for (int rep = 0; rep < REP_SEL; ++rep) {
    for (int i = lane; i < 256; i += 64) { const int q2 = i >> 7, b = i & 127, tq2 = t + q2, cur = tq2 / SLC_BLOCK; float sv;
        if (b > cur) sv = NEG; else if (b == 0 || b == cur || b == cur - 1) sv = FORCE_SCORE;
        else { const LAS float* ic = imp + q2 * 512 + 4 * b; sv = ic[-1] + 2.f * (ic[0] + ic[1] + ic[2]) + ic[3]; }
        sc[i] = pack_key(sv, 127u - (unsigned)b, 127u); }
    asm volatile("s_waitcnt lgkmcnt(0)" ::: "memory");
    for (int i = lane; i < 256; i += 64) { const int q2 = i >> 7, b = i & 127; const float sv = sc[i]; int rank = 0;
        for (int j = 0; j < 128; j += 4) { const f32x4 o = *(const LAS f32x4*)(sc + q2 * 128 + j);
            rank += (o.x > sv) ? 1 : 0; rank += (o.y > sv) ? 1 : 0; rank += (o.z > sv) ? 1 : 0; rank += (o.w > sv) ? 1 : 0; }
        if (rank < SLC_TOPK) { const int v = (sv > 0.5f * NEG) ? b : -1; sel[q2 * 16 + rank] = v; P.SELB[((size_t)(n * SEQ + t + q2) * NSA_KV_HEADS + kvh) * 16 + rank] = v; } }
    asm volatile("s_waitcnt lgkmcnt(0)" ::: "memory");
    }
#ifndef REP_WIN
#define REP_WIN 1
#endif
#pragma unroll 1
    for (int rep = 0; rep < REP_WIN; ++rep) { Tile16 T; tile_init(T);
      const bf16* WKb = P.WNK + ((size_t)n * NSA_KV_HEADS + kvh) * SEQ * 64; const bf16* WVb = P.WNVT + ((size_t)n * NSA_KV_HEADS + kvh) * 64 * SEQ;
      const int blo = (t - SWA_WINDOW) >> 5, bhi = (t + 1) >> 5;
      auto ld = [&](KV8& kv, int blk) { const int bc = blk < 0 ? 0 : blk; kv_load_t(kv, WKb + (size_t)bc * 2048, WVb + (size_t)bc * 2048, lane); };
      pipe2(bhi - blo + 1, [&](KV8& kv, int i) { ld(kv, blo + i); }, [&](const KV8& kv, int i) { const int kb = 32 * (blo + i);
          const int k0 = kb + 8 * c; int lo; unsigned rng; const int a = tq - SWA_WINDOW; mk_range((a > 0 ? a : 0) - k0, tq - k0, vcol, lo, rng); tile_compute(T, qf, kv, lo, rng); });
      T.l = colsum(T.l);
      const float inv = (T.l > 0.f) ? 1.0f / T.l : 0.f, g2 = vcol ? gt[2] * inv : 0.f;
#ifdef NSA_DEBUG
      if (vcol) { for (int db = 0; db < 4; ++db) *(f32x4*)(P.DBG + ((size_t)2 * MP + row) * 768 + head * 64 + 16 * db + 4 * c) = T.o[db] * inv; }
#endif
#pragma unroll
      for (int db = 0; db < 4; ++db) if (rep == REP_WIN - 1) oacc[db] += T.o[db] * g2; }
    if (vcol) { float* op = P.DPART + (size_t)row * 768 + head * 64 + 4 * c;
#pragma unroll
        for (int db = 0; db < 4; ++db) *(f32x4*)(op + 16 * db) = oacc[db]; }
}
DI void nsa_pair_b(const FP& P, int n, int kvh, int t, int lane, LAS unsigned char* wl) {
    LAS int* steps = (LAS int*)wl;
    const int col = lane & 15, c = lane >> 4; const bool vcol = col < 12; const int qq = vcol ? col / 6 : 0, hh = vcol ? col % 6 : 0, tq = t + qq, head = kvh * NSA_GROUP + hh, row = n * SEQ + tq;
    bf16x8 qf[2]; { const bf16* qp = P.QB + (size_t)row * NSA_Q_COLS + head * 64 + 8 * c; qf[0] = *(const bf16x8*)qp; qf[1] = *(const bf16x8*)(qp + 32); }
    const float* gt = P.GATES + (size_t)row * 64 + head * 3;
    Tile16 T; tile_init(T);
    const bf16* SKb = P.SLK + ((size_t)n * NSA_KV_HEADS + kvh) * SEQ * 64; const bf16* SVb = P.SLVT + ((size_t)n * NSA_KV_HEADS + kvh) * SEQ * 64;
    int ns = 0;
    { const int mysel = (lane < 32) ? P.SELB[((size_t)(n * SEQ + t + (lane >> 4)) * NSA_KV_HEADS + kvh) * 16 + (lane & 15)] : -1;
      for (int i = 0; i < 32; ++i) { const int b = __builtin_amdgcn_readlane(mysel, i); if (b < 0) continue; int q2 = i >> 4;
          const unsigned long long other = __ballot(mysel == b && lane < 32 && (lane >> 4) != q2);
          if (other) { if (q2 == 1) continue; q2 = 2; }
          if (lane == 0) { steps[ns] = (b * SLC_BLOCK) | (q2 << 29); steps[ns + 1] = (b * SLC_BLOCK + 32) | (q2 << 29); } ns += 2; } }
    asm volatile("s_waitcnt lgkmcnt(0)" ::: "memory");
    auto ld = [&](KV8& kv, int i) { const int code = __builtin_amdgcn_readfirstlane(steps[i]); const int kb = code & 0x1fffffff;
        kv_load_t(kv, SKb + (size_t)(kb >> 5) * 2048, SVb + (size_t)(kb >> 5) * 2048, lane); };
#ifdef PROBE_DBLCOMP
    Tile16 T2; tile_init(T2);
#endif
    pipe2(ns, ld, [&](const KV8& kv, int i) { const int code = __builtin_amdgcn_readfirstlane(steps[i]); const int kb = code & 0x1fffffff, q2 = code >> 29;
        int lo; unsigned rng; mk_range(-64, tq - (kb + 8 * c), vcol && (q2 == 2 || qq == q2), lo, rng); tile_compute(T, qf, kv, lo, rng);
#ifdef PROBE_DBLCOMP
        tile_compute(T2, qf, kv, [&](int e) { return vcol && qq == q2 && (kb + 8 * c + e + 1) <= tq; });
#endif
    });
#ifdef PROBE_DBLCOMP
    if (T2.l < 0.f) T.l = 0.f;
#endif
    T.l = colsum(T.l);
    const float inv = (T.l > 0.f) ? 1.0f / T.l : 0.f, g1 = vcol ? gt[1] * inv : 0.f;
#ifdef NSA_DEBUG
    if (vcol) { for (int db = 0; db < 4; ++db) *(f32x4*)(P.DBG + ((size_t)1 * MP + row) * 768 + head * 64 + 16 * db + 4 * c) = T.o[db] * inv; }
#endif
    if (vcol) { const float* pp = P.DPART + (size_t)row * 768 + head * 64 + 4 * c; bf16* op = P.ATTB + (size_t)row * 1024 + head * 64 + 4 * c;
#pragma unroll
        for (int db = 0; db < 4; ++db) *(u32x2*)(op + 16 * db) = pk4(*(const f32x4*)(pp + 16 * db) + T.o[db] * g1); }
}

constexpr int SMP_SK = 1088;
template <class KF, class VF> DI void smp_branch(const Ctx& C, LAS float* qs, LAS float* S, LAS float* red, int NK, KF kf, VF vf, bool keep_probs, float (&outh)[1]) {
    const int tid = C.tid, lane = C.lane, w = C.wave;
#pragma unroll 1
    for (int j = tid; j < NK; j += NTHREADS) { const float* k = kf(j); f32x4 kr[16];
#pragma unroll
        for (int d4 = 0; d4 < 16; ++d4) kr[d4] = *(const f32x4*)(k + 4 * d4);
#pragma unroll 1
        for (int h = 0; h < 6; ++h) { float a = 0.f;
#pragma unroll
            for (int d4 = 0; d4 < 16; ++d4) { const f32x4 qv = *(const LAS f32x4*)(qs + h * 64 + 4 * d4); a += kr[d4].x * qv.x + kr[d4].y * qv.y + kr[d4].z * qv.z + kr[d4].w * qv.w; }
            S[h * SMP_SK + j] = a; } }
    asm volatile("s_waitcnt lgkmcnt(0)" ::: "memory"); __syncthreads();
    if (w < 6) { float m = -INFINITY; for (int j = lane; j < NK; j += 64) m = fmaxf(m, S[w * SMP_SK + j]); m = wave_max(m);
        float l = 0.f; for (int j = lane; j < NK; j += 64) { const float p = __builtin_amdgcn_exp2f(S[w * SMP_SK + j] - m); S[w * SMP_SK + j] = p; l += p; } l = wave_sum(l);
        const float inv = 1.0f / l; for (int j = lane; j < NK; j += 64) S[w * SMP_SK + j] *= inv; }
    asm volatile("s_waitcnt lgkmcnt(0)" ::: "memory"); __syncthreads();
    { const int per = (NK + NWAVES - 1) / NWAVES, j0 = w * per, j1 = (j0 + per < NK) ? j0 + per : NK; float o[6] = {0.f, 0.f, 0.f, 0.f, 0.f, 0.f};
#pragma unroll 1
      for (int j = j0; j < j1; j += 8) { float vv[8];
#pragma unroll
          for (int u = 0; u < 8; ++u) { const int jj = (j + u < j1) ? j + u : j1 - 1; vv[u] = vf(jj)[lane]; }
#pragma unroll
          for (int u = 0; u < 8; ++u) if (j + u < j1) {
#pragma unroll
              for (int h = 0; h < 6; ++h) o[h] += S[h * SMP_SK + j + u] * vv[u]; } }
#pragma unroll
      for (int h = 0; h < 6; ++h) red[(w * 6 + h) * 64 + lane] = o[h]; }
    asm volatile("s_waitcnt lgkmcnt(0)" ::: "memory"); __syncthreads();
    outh[0] = 0.f;
    if (tid < 384) { float a = 0.f;
#pragma unroll
        for (int ww = 0; ww < NWAVES; ++ww) a += red[ww * 384 + tid]; outh[0] = a; }
    if (!keep_probs) { __syncthreads(); }
}
DI void nsa_sample_item(const FP& P, const Ctx& C, int ns, int kvh) {
    LAS float* qs = (LAS float*)C.lds; LAS float* S = qs + 384; LAS float* red = S + 6 * SMP_SK; LAS float* scs = red + 8 * 384; LAS int* sel = (LAS int*)(scs + 136);
    const int tid = C.tid, row = M0 + ns;
    if (tid < 384) qs[tid] = bf2f(P.QB[(size_t)row * NSA_Q_COLS + kvh * 384 + tid]);
    asm volatile("s_waitcnt lgkmcnt(0)" ::: "memory"); __syncthreads();
    const float* ckf = P.CKF + ((size_t)ns * NSA_KV_HEADS + kvh) * NCH * 64; const float* cvf = P.CVF + ((size_t)ns * NSA_KV_HEADS + kvh) * NCH * 64;
    float oc[1], os[1], ow[1];
    smp_branch(C, qs, S, red, NCMP, [&](int j) { return ckf + (size_t)j * 64; }, [&](int j) { return cvf + (size_t)j * 64; }, true, oc);
    constexpr int NBS = (PAST_LEN + 1 + SLC_BLOCK - 1) / SLC_BLOCK, CURS = PAST_LEN / SLC_BLOCK;
    for (int b = tid; b < 136; b += NTHREADS) { float sv = -3.0e38f;
        if (b < NBS) { if (b == 0 || b == CURS || b == CURS - 1) sv = FORCE_SCORE; else { float a = 0.f;
#pragma unroll
                for (int o = -1; o <= 3; ++o) { const int ci = 4 * b + o; if (ci >= 0 && ci < NCMP) { float sm = 0.f; for (int h6 = 0; h6 < 6; ++h6) sm += S[h6 * SMP_SK + ci]; a += ((o >= 0 && o <= 2) ? 2.f : 1.f) * sm; } }
                sv = a; } }
        scs[b] = sv; }
    asm volatile("s_waitcnt lgkmcnt(0)" ::: "memory"); __syncthreads();
    for (int b = tid; b < NBS; b += NTHREADS) { const float sv = scs[b]; int rank = 0; for (int j = 0; j < NBS; ++j) { const float o = scs[j]; rank += (o > sv || (o == sv && j < b)) ? 1 : 0; }
        if (rank < SLC_TOPK) { sel[rank] = b; P.SELB[((size_t)row * NSA_KV_HEADS + kvh) * 16 + rank] = b; } }
    asm volatile("s_waitcnt lgkmcnt(0)" ::: "memory"); __syncthreads();
    { const float* newrow = P.nsa_kv_s + (size_t)ns * 512; const int* pt = P.page_table + ns * (PAST_LEN / PAGE_SIZE);
      if (tid == 0) { int seen = 0; for (int x = 0; x < SLC_TOPK; ++x) { const int bx = sel[x]; if (bx != CURS && seen < 15) sel[16 + seen++] = bx; } }
      asm volatile("s_waitcnt lgkmcnt(0)" ::: "memory"); __syncthreads();
      auto krow = [&](int j, int ty) -> const float* { if (j >= 15 * 64) return newrow + ty * 128 + kvh * 64;
          const int t0 = sel[16 + (j >> 6)] * SLC_BLOCK + (j & 63); const int pg = pt[t0 / PAGE_SIZE]; return P.cache_nsa_kv + ((size_t)pg * PAGE_SIZE + t0 % PAGE_SIZE) * 512 + ty * 128 + kvh * 64; };
      smp_branch(C, qs, S, red, 15 * 64 + 1, [&](int j) { return krow(j, 2); }, [&](int j) { return krow(j, 3); }, false, os); }
    { const float* wc = P.cache_nsa_win + (size_t)ns * SWA_WINDOW * 256; const float* newrow = P.win_s + ((size_t)ns * SWA_WINDOW + SWA_WINDOW - 1) * 256;
      smp_branch(C, qs, S, red, SWA_WINDOW + 1, [&](int j) { return (j < SWA_WINDOW ? wc + (size_t)j * 256 : newrow) + kvh * 64; }, [&](int j) { return (j < SWA_WINDOW ? wc + (size_t)j * 256 : newrow) + 128 + kvh * 64; }, false, ow); }
    if (tid < 384) { const int head = kvh * NSA_GROUP + tid / 64; const float* gt = P.GATES + (size_t)row * 64 + head * 3;
        P.ATTB[(size_t)row * 1024 + kvh * 384 + tid] = (bf16)f2bf(gt[0] * oc[0] + gt[1] * os[0] + gt[2] * ow[0]);
#ifdef NSA_DEBUG
        P.DBG[((size_t)0 * MP + row) * 768 + kvh * 384 + tid] = oc[0]; P.DBG[((size_t)1 * MP + row) * 768 + kvh * 384 + tid] = os[0]; P.DBG[((size_t)2 * MP + row) * 768 + kvh * 384 + tid] = ow[0];
#endif
    }
    __syncthreads();
}
DI void nsa_pairs(const FP& P, const Ctx& C, bool second) {
    LAS unsigned char* wl = C.lds + C.wave * NSA_WLDS;
    const int per = C.G / 4 > 0 ? C.G / 4 : 1, grp = (C.vcu / per) & 3, sub = C.vcu % per, n = grp >> 1, kvh = grp & 1;
#pragma unroll 1
    for (int pr = sub * NWAVES + C.wave; pr < SEQ / 2; pr += per * NWAVES) { if (second) nsa_pair_b(P, n, kvh, 2 * pr, C.lane, wl); else nsa_pair_a(P, n, kvh, 2 * pr, C.lane, wl); }
}
DI void nsa_phase_a(const FP& P, const Ctx& C) {
    for (int it = C.vcu; it < DEC_BATCH * NSA_KV_HEADS; it += C.G) nsa_sample_item(P, C, it / NSA_KV_HEADS, it % NSA_KV_HEADS);
    nsa_pairs(P, C, false);
    __syncthreads();
}
DI void nsa_phase_b(const FP& P, const Ctx& C) {
    const int lane = C.lane, w = C.wave;
    nsa_pairs(P, C, true);
    __syncthreads();
    { constexpr int NMT = (M0 / 16) * MEM_HEADS;
      for (int it = C.vcu * NWAVES + w; it < NMT; it += C.G * NWAVES) { const int h = it % MEM_HEADS, q16 = it / MEM_HEADS, row0 = q16 * 16, n = row0 / SEQ;
          mem_micro(P, P.MQB + h * 64, 256, row0, 1, n, h, P.ATTB + NSA_Q_COLS + h * 64, 1024, lane); }
    }
    { LAS float* qs = (LAS float*)C.lds;
      for (int it = C.vcu; it < DEC_BATCH * MEM_HEADS; it += C.G) { const int h = it % MEM_HEADS, ns = it / MEM_HEADS, row = M0 + ns;
          __syncthreads(); if (C.tid < 64) qs[C.tid] = bf2f(P.MQB[(size_t)row * 256 + h * 64 + C.tid]); asm volatile("s_waitcnt lgkmcnt(0)" ::: "memory"); __syncthreads();
          Dec D; D.m = -INFINITY; D.l = 0.f; D.o = 0.f; const float* mk = P.cache_mem_kv + ((size_t)1 * DEC_BATCH + ns) * MEM_TOKENS * 512;
          for (int ck = w; ck < MEM_TOKENS / 64; ck += NWAVES) { const int j0 = ck * 64; dec_chunk(D, qs, 64, [&](int j) { return mk + (size_t)(j0 + j) * 512 + h * 64; }, [&](int j) { return mk + (size_t)(j0 + j) * 512 + 256 + h * 64; }, lane); }
          const float o = dec_combine(C, D);
          if (w == 0) P.ATTB[(size_t)row * 1024 + NSA_Q_COLS + h * 64 + lane] = (bf16)f2bf(o); } }
    __syncthreads();
}
}
namespace fx {
enum { PH_PRO = 0, PH_G1, PH_ATTA, PH_G2, PH_LN1, PH_SC0, PH_TK0, PH_PU0, PH_PG0, PH_G3, PH_CMPG, PH_CMP2, PH_NSA, PH_NSB, PH_G4, PH_LN3, PH_SC1, PH_TK1, PH_PU1, PH_PG1, PH_COUNT };
template <class Epi> DI void run_gemm(const Ctx& C, const bf16* A, const bf16* Bt, int M, int N, int K, const Epi& E) {
    pg8::Gemm g{A, Bt, M, N, K}; pg8::StaticOrder S; S.init(M, N, C.G, (int)blockIdx.x);
    pg8::gemm_phase<Epi, pg8::StaticOrder, true, true>(C.lds, g, S, E);
}
template <class Epi> DI void skinny_gemm(const Ctx& C, const bf16* A, const bf16* Bt, int N, int K, const Epi& E) {
    static_assert(DEC_BATCH == 32 && M0 % 256 == 0, "skinny_gemm: 32 sample rows right after a whole number of 256-row tiles");
    const int lane = C.lane, fr = lane & 15, fq = lane >> 4, w = C.wave; const int NI = (N / 256) * 4, KW = K / NWAVES;
    LAS f32x4* red = (LAS f32x4*)C.lds;
#pragma unroll 1
    for (int item = C.vcu; item < NI; item += C.G) { const int pn = item >> 2, wc = item & 3;
        f32x4 pa[2][2][2];
#pragma unroll
        for (int i = 0; i < 8; ++i) (&pa[0][0][0])[i] = (f32x4){0.f, 0.f, 0.f, 0.f};
        const bf16* xa = A + (size_t)(M0 + fr) * K + w * KW + 8 * fq; const bf16* xb = xa + (size_t)16 * K;
        const bf16* wp[2][2];
#pragma unroll
        for (int bj = 0; bj < 2; ++bj)
#pragma unroll
            for (int n = 0; n < 2; ++n) wp[bj][n] = Bt + (size_t)(pn * 256 + bj * 128 + wc * 32 + 8 * (fr >> 2) + 4 * n + (fr & 3)) * K + w * KW + 8 * fq;
#pragma unroll 4
        for (int k0 = 0; k0 < KW; k0 += 32) { const bf16x8 x0 = *(const bf16x8*)(xa + k0), x1 = *(const bf16x8*)(xb + k0);
#pragma unroll
            for (int bj = 0; bj < 2; ++bj)
#pragma unroll
                for (int n = 0; n < 2; ++n) { const bf16x8 wf = *(const bf16x8*)(wp[bj][n] + k0);
                    pa[bj][0][n] = __builtin_amdgcn_mfma_f32_16x16x32_bf16(wf, x0, pa[bj][0][n], 0, 0, 0); pa[bj][1][n] = __builtin_amdgcn_mfma_f32_16x16x32_bf16(wf, x1, pa[bj][1][n], 0, 0, 0); } }
        __syncthreads();
#pragma unroll
        for (int bj = 0; bj < 2; ++bj)
#pragma unroll
            for (int mm = 0; mm < 2; ++mm)
#pragma unroll
                for (int n = 0; n < 2; ++n) red[(w * 8 + bj * 4 + mm * 2 + n) * 64 + lane] = pa[bj][mm][n];
        asm volatile("s_waitcnt lgkmcnt(0)" ::: "memory"); __syncthreads();
        if (w == 0) { f32x4 acc[2][2][4][2];
#pragma unroll
            for (int i = 0; i < 32; ++i) (&acc[0][0][0][0])[i] = (f32x4){0.f, 0.f, 0.f, 0.f};
#pragma unroll
            for (int bj = 0; bj < 2; ++bj)
#pragma unroll
                for (int mm = 0; mm < 2; ++mm)
#pragma unroll
                    for (int n = 0; n < 2; ++n) { f32x4 s = red[(bj * 4 + mm * 2 + n) * 64 + lane];
#pragma unroll 1
                        for (int ww = 1; ww < NWAVES; ++ww) s += red[(ww * 8 + bj * 4 + mm * 2 + n) * 64 + lane];
                        acc[0][bj][mm][n] = s; }
            E(acc, pg8::Unit{M0 / 256, pn}, 0, wc, fr, fq); }
    }
    __syncthreads();
}
__global__ void __launch_bounds__(NTHREADS, 2) mega(Args args) {
    extern __shared__ __attribute__((aligned(16))) unsigned char lds_raw[];
    Ctx C; C.lds = (LAS unsigned char*)lds_raw; C.tid = threadIdx.x; C.lane = C.tid & 63; C.wave = __builtin_amdgcn_readfirstlane(C.tid >> 6);
    C.G = gridDim.x; { const int bx = blockIdx.x; C.vcu = (C.G % 8 == 0) ? (bx % 8) * (C.G / 8) + bx / 8 : bx; }
    const FP& P = args.p;
    volatile LAS unsigned* MISC = (volatile LAS unsigned*)(C.lds + MISC_OFF);
    for (int u = C.tid; u < (LDS_BYTES - RING_BYTES) / 4; u += NTHREADS) ((LAS unsigned*)(C.lds + RING_BYTES))[u] = 0u;
    __syncthreads();
    const int lo = args.lo, hi = args.hi;
    XcdBarrier bar; bar.bar = P.ctl + 1024; bar.x = 0; bar.st = nullptr;
    if (hi - lo > 1) bar = xcd_barrier_post(P.ctl + 1024, MISC + 8);
#define IN(k) (lo <= (k) && (k) < hi)
#define SEAM(k) do { if (IN(k) && IN((k) + 1)) xcd_barrier(bar); } while (0)
#ifndef DUP_PHASE
#define DUP_PHASE -1
#endif
#define PHASE(k, ...) do { if (IN(k)) { __VA_ARGS__ if (DUP_PHASE == (k)) { __syncthreads(); __VA_ARGS__ } } SEAM(k); } while (0)
    PHASE(PH_PRO, p0_prologue(P, C); __syncthreads(); p0_wpk(P, C););
    PHASE(PH_G1, run_gemm(C, P.XB0, P.WA_T, M0, ACOLS, D_MODEL, EpiA{P}); run_gemm(C, P.MEMB, P.WMEM_T, BATCH * MEM_TOKENS, 1024, D_MODEL, EpiMem{P}); skinny_gemm(C, P.XB0, P.WA_T, ACOLS, D_MODEL, EpiA{P}););
#ifdef PEER_SHARD3
#define PEER_SHARDED_FN peer_sharded3_phase
#else
#define PEER_SHARDED_FN peer_sharded2_phase
#endif
    PHASE(PH_ATTA, atta_phase(P, C););
    PHASE(PH_G2, run_gemm(C, P.ATTA, P.WOA_T, M0, D_MODEL, 512, EpiPre{P.x_prompt, P.x_sample, P.PRE}); skinny_gemm(C, P.ATTA, P.WOA_T, D_MODEL, 512, EpiPre{P.x_prompt, P.x_sample, P.PRE}););
    PHASE(PH_LN1, ln_phase(P, C, P.PRE, P.ln_g, P.ln_b, P.X1, P.X1B, nullptr, nullptr););
    PHASE(PH_SC0, run_gemm(C, P.X1B, P.WPK_T, M0, NPK, D_MODEL, EpiF32{P.SCO, NPK, MP}); skinny_gemm(C, P.X1B, P.WPK_T, NPK, D_MODEL, EpiF32{P.SCO, NPK, MP}););
    PHASE(PH_TK0, topk_phase(P, C););
#ifdef PEER_SPLIT
    PHASE(PH_PU0, peer_u_phase(P, C, 0, P.X1B););
    PHASE(PH_PG0, peer_v_phase(P, C, 0, P.X1, P.X2, P.X2 + (size_t)M0 * D_MODEL, P.X2B););
#elif defined(PEER_SHARD2)
    PHASE(PH_PG0, const bool shd = (M0 % (C.G * NWAVES * PS2_ROWS)) == 0; if (shd) { PEER_SHARDED_FN(P, C, 0, P.X1, P.X1B, P.X2, P.X2B); __syncthreads(); } peer_phase(P, C, 0, P.X1, P.X2, P.X2 + (size_t)M0 * D_MODEL, P.X2B, shd););
#elif defined(PEER_SHARD)
    PHASE(PH_PG0, peer_sharded_phase(P, C, 0, P.X1, P.X1B, P.X2, P.X2 + (size_t)M0 * D_MODEL, P.X2B); __syncthreads(); peer_phase(P, C, 0, P.X1, P.X2, P.X2 + (size_t)M0 * D_MODEL, P.X2B););
#else
    PHASE(PH_PG0, peer_phase(P, C, 0, P.X1, P.X2, P.X2 + (size_t)M0 * D_MODEL, P.X2B););
#endif
    PHASE(PH_G3, run_gemm(C, P.X2B, P.WB_T, M0, NB_T, D_MODEL, EpiB{P}); skinny_gemm(C, P.X2B, P.WB_T, NB_T, D_MODEL, EpiB{P}););
    PHASE(PH_CMPG, run_gemm(C, P.AC, P.CW1_T, ACROWS, 256, 1024, EpiF32{P.UL, 256, ACROWS}); run_gemm(C, P.AC + (size_t)ACROWS * 1024, P.CW1_T + 256 * 1024, ACROWS, 256, 1024, EpiF32{P.UL + (size_t)ACROWS * 256, 256, ACROWS}););
    PHASE(PH_CMP2, cmp2_phase(P, C););
    PHASE(PH_NSA, nsa_phase_a(P, C););
    PHASE(PH_NSB, nsa_phase_b(P, C););
    PHASE(PH_G4, run_gemm(C, P.ATTB, P.WOB_T, M0, D_MODEL, 1024, EpiPre{P.X2, nullptr, P.PRE}); skinny_gemm(C, P.ATTB, P.WOB_T, D_MODEL, 1024, EpiPre{P.X2, nullptr, P.PRE}););
    PHASE(PH_LN3, ln_phase(P, C, P.PRE, P.ln_g + 2 * D_MODEL, P.ln_b + 2 * D_MODEL, P.X3, P.X3B, nullptr, nullptr););
    PHASE(PH_SC1, run_gemm(C, P.X3B, P.WPK_T + (size_t)NPK * D_MODEL, M0, NPK, D_MODEL, EpiF32{P.SCO, NPK, MP}); skinny_gemm(C, P.X3B, P.WPK_T + (size_t)NPK * D_MODEL, NPK, D_MODEL, EpiF32{P.SCO, NPK, MP}););
    PHASE(PH_TK1, topk_phase(P, C););
#ifdef PEER_SPLIT
    PHASE(PH_PU1, peer_u_phase(P, C, 1, P.X3B););
    PHASE(PH_PG1, peer_v_phase(P, C, 1, P.X3, P.y_prompt, P.y_sample, nullptr););
#elif defined(PEER_SHARD2)
    PHASE(PH_PG1, const bool shd = (M0 % (C.G * NWAVES * PS2_ROWS)) == 0; if (shd) { PEER_SHARDED_FN(P, C, 1, P.X3, P.X3B, P.y_prompt, nullptr); __syncthreads(); } peer_phase(P, C, 1, P.X3, P.y_prompt, P.y_sample, nullptr, shd););
#elif defined(PEER_SHARD)
    PHASE(PH_PG1, peer_sharded_phase(P, C, 1, P.X3, P.X3B, P.y_prompt, P.y_sample, nullptr); __syncthreads(); peer_phase(P, C, 1, P.X3, P.y_prompt, P.y_sample, nullptr););
#else
    PHASE(PH_PG1, peer_phase(P, C, 1, P.X3, P.y_prompt, P.y_sample, nullptr););
#endif
#undef IN
#undef SEAM
}
}
#ifndef ONE_LAUNCH
#define ONE_LAUNCH 1
#endif
extern "C" void kernel_launch(void* const* d_in, const int* in_sizes, int n_in, void* d_out, int out_size, void* d_ws, size_t ws_size, hipStream_t stream) {
    fx::Args a; memset(&a, 0, sizeof(a)); fx::bind_io(a.p, d_in, (float*)d_out);
    const size_t f_need = fx::carve(a.p, d_ws);
    if (f_need > ws_size) { fprintf(stderr, "kernel_launch: workspace too small: need %zu have %zu\n", f_need, ws_size); return; }
    static int grid = 0;
    if (!grid) { int dev = 0, cus = 0, per_cu = 0; (void)hipGetDevice(&dev); (void)hipDeviceGetAttribute(&cus, hipDeviceAttributeMultiprocessorCount, dev);
        (void)hipFuncSetAttribute((const void*)fx::mega, hipFuncAttributeMaxDynamicSharedMemorySize, fx::LDS_BYTES);
        if (hipOccupancyMaxActiveBlocksPerMultiprocessor(&per_cu, (const void*)fx::mega, fx::NTHREADS, fx::LDS_BYTES) != hipSuccess || per_cu < 1) { fprintf(stderr, "kernel_launch: occupancy query says %d blocks per CU\n", per_cu); (void)hipGetLastError(); }
        grid = cus; }
    (void)hipMemsetAsync(a.p.ctl, 0, fx::CTL_BYTES, stream);
#if ONE_LAUNCH
    a.lo = 0; a.hi = fx::PH_COUNT; hipLaunchKernelGGL(fx::mega, dim3(grid), dim3(fx::NTHREADS), fx::LDS_BYTES, stream, a);
#else
    for (int k = 0; k < fx::PH_COUNT; ++k) { a.lo = k; a.hi = k + 1; hipLaunchKernelGGL(fx::mega, dim3(grid), dim3(fx::NTHREADS), fx::LDS_BYTES, stream, a); }
#endif
}
```

```cpp
#define PEER_SHARD2 1
#define ONE_LAUNCH 1
#include <hip/hip_runtime.h>
#include <cstdio>
#include <cstring>
#include <cmath>
#ifdef CPU_TEST
#define HD inline
constexpr int D_MODEL = 128, BATCH = 2, SEQ = 512, DEPTH = 2, DEC_BATCH = 3, DEC_SEQ = 1, PAST_LEN = 512, PAGE_SIZE = 128;
constexpr int DIL_W[3] = {16, 64, 256}, DIL_D[3] = {1, 4, 16}, DIL_TAPS = 17;
constexpr int MEM_TOKENS = 32, SLC_TOPK = 4, SWA_WINDOW = 64, PEER_KEYS = 16, PEER_TOPK = 4;
#else
#define HD __host__ __device__ __forceinline__
constexpr int D_MODEL = 1024, BATCH = 2, SEQ = 8192, DEPTH = 2, DEC_BATCH = 32, DEC_SEQ = 1, PAST_LEN = 8192, PAGE_SIZE = 128;
constexpr int DIL_W[3] = {128, 512, 2048}, DIL_D[3] = {1, 4, 16}, DIL_TAPS = 129;
constexpr int MEM_TOKENS = 256, SLC_TOPK = 16, SWA_WINDOW = 512, PEER_KEYS = 128, PEER_TOPK = 16;
#endif
HD constexpr int dil_w(int g) { return g == 0 ? DIL_W[0] : (g == 1 ? DIL_W[1] : DIL_W[2]); }
HD constexpr int dil_d(int g) { return g == 0 ? DIL_D[0] : (g == 1 ? DIL_D[1] : DIL_D[2]); }
constexpr int HEAD_DIM = 64, N_A_LAYERS = DEPTH / 2, N_DIL = 3, DIL_HEADS = 4, DIL_COLS = N_DIL * 3 * DIL_HEADS * HEAD_DIM;
constexpr int MEM_HEADS = 4, MEM_COLS = MEM_HEADS * HEAD_DIM;
constexpr int NSA_HEADS = 12, NSA_KV_HEADS = 2, NSA_GROUP = 6, NSA_Q_COLS = NSA_HEADS * HEAD_DIM, NSA_GATE_COLS = NSA_HEADS * 3;
constexpr int CMP_BLOCK = 32, CMP_STRIDE = 16, CMP_HIDDEN = 128, SLC_BLOCK = 64;
constexpr int PEER_EXPERTS = PEER_KEYS * PEER_KEYS, PEER_HEADS = 8, PEER_KEY_DIM = 128;
constexpr float FORCE_SCORE = 1.0e9f, NEG = -1.0e30f, SCALE = 0.125f, LN_EPS = 1e-5f;
constexpr float ALPHA = 1.41421356237309515f;
constexpr float BETA = 0.5f;
#define LAS __attribute__((address_space(3)))
namespace pg8 {
#define PG8_LAS __attribute__((address_space(3)))
typedef unsigned short bf16_t;
typedef short bf16x8 __attribute__((ext_vector_type(8)));
typedef float f32x4 __attribute__((ext_vector_type(4)));
typedef unsigned u32x4 __attribute__((ext_vector_type(4)));
constexpr int BM = 256, BK = 64, HALF = 128, HTB = HALF * BK * 2  , STAGE_BYTES = 8 * HTB, NXCD = 8, WGM = 8;

__host__ __device__ __forceinline__ int lds_byte(int r, int c) { const int st = (r >> 4) * 2 + (c >> 5), rr = r & 15, cc = c & 31, ob = rr * 64 + cc * 2; return st * 1024 + (ob ^ (((ob >> 9) & 1) << 5)); }
__host__ __device__ __forceinline__ void stage_rc(int b, int& R, int& C) { const int st = b / 1024, sb = b % 1024, swz = sb ^ (((sb >> 9) & 1) << 5); R = (st >> 1) * 16 + swz / 64; C = (st & 1) * 32 + (swz % 64) / 2; }
__host__ __device__ __forceinline__ int perm32(int rho) { const int n = rho >> 4, i = rho & 15; return 8 * (i >> 2) + 4 * n + (i & 3); }

struct Unit { int pm, pn; };
struct Gemm { const bf16_t* A; const bf16_t* Bt; int M, N, K; };

struct StaticOrder {
    int nM, nN, nwg, G, c;
    __host__ __device__ void init(int M, int N, int G_, int c_) { nM = M / BM; nN = N / BM; nwg = nM * nN; G = G_; c = c_; }
    __host__ __device__ bool next(int i, Unit& u) const {
        const long L = (long)i * G + c; if (L >= nwg) return false;
        int wgid = (int)L; { const int q = nwg / NXCD, r = nwg % NXCD, xcd = wgid % NXCD, off = wgid / NXCD; wgid = (xcd < r ? xcd * (q + 1) : r * (q + 1) + (xcd - r) * q) + off; }
        const int nig = WGM * nN, gid = wgid / nig, fm = gid * WGM, gsz = (nM - fm) < WGM ? (nM - fm) : WGM;
        u.pm = fm + ((wgid % nig) % gsz); u.pn = (wgid % nig) / gsz; return true;
    }
    __device__ __forceinline__ void a_ready(const Unit&) const {}
    __device__ __forceinline__ void done(const Unit&) const {}
};

__device__ __forceinline__ unsigned cvt_pk_bf16(float lo, float hi) { unsigned r; asm volatile("v_cvt_pk_bf16_f32 %0, %1, %2" : "=v"(r) : "v"(lo), "v"(hi)); return r; }
typedef float f32x2 __attribute__((ext_vector_type(2)));
typedef float f32x2 __attribute__((ext_vector_type(2)));
template <class Epi, class Sched, bool ALIGN_EPI = false, bool SP2 = false>
__device__ __forceinline__ void gemm_phase(PG8_LAS unsigned char* lds, const Gemm g, const Sched& S, const Epi& E) {
    const int tid = threadIdx.x, wid = __builtin_amdgcn_readfirstlane(tid >> 6), lane = tid & 63, wr = wid >> 2, wc = wid & 3, fr = lane & 15, fq = lane >> 4;
    const int K = g.K, nt = K / BK;
    unsigned voffA[2], voffB[2];
#pragma unroll
    for (int i = 0; i < 2; ++i) { int R, C; stage_rc(tid * 16 + i * 8192, R, C); const int Rb = Epi::PERM ? ((R & ~31) + perm32(R & 31)) : R;
        voffA[i] = (unsigned)(R * K + C) * 2u; voffB[i] = (unsigned)(Rb * K + C) * 2u; }
    const size_t kstep = (size_t)(BK * 2);
    const size_t hstep = (size_t)HALF * K * 2;
    const size_t tstep = 2 * hstep;
    const unsigned ldsw = (unsigned)wid * 1024u;
    const int aoff = lds_byte(wr * 64 + fr, fq * 8), boff = lds_byte(wc * 32 + fr, fq * 8);
#define PG8_SA(b, h) (((b) * 2 + (h)) * HTB)
#define PG8_SB(b, h) ((4 + (b) * 2 + (h)) * HTB)
#define PG8_STAGE(bufoff, gbase, voff) do { _Pragma("unroll") for (int _i = 0; _i < 2; ++_i) \
        __builtin_amdgcn_global_load_lds((const unsigned*)((const char*)(gbase) + (voff)[_i]), (PG8_LAS unsigned*)(lds + (bufoff) + ldsw + _i * 8192), 16, 0, 0); } while (0)
#define PG8_LDA(dst, b, h) do { _Pragma("unroll") for (int m = 0; m < 4; ++m) _Pragma("unroll") for (int k = 0; k < 2; ++k) dst[m][k] = *(const PG8_LAS bf16x8*)(lds + PG8_SA(b, h) + aoff + m * 2048 + k * 1024); } while (0)
#define PG8_LDB(dst, b, h) do { _Pragma("unroll") for (int n = 0; n < 2; ++n) _Pragma("unroll") for (int k = 0; k < 2; ++k) dst[n][k] = *(const PG8_LAS bf16x8*)(lds + PG8_SB(b, h) + boff + n * 2048 + k * 1024); } while (0)
#define PG8_MMA(ai, bj, At, Bt) do { __builtin_amdgcn_s_setprio(1); _Pragma("unroll") for (int m = 0; m < 4; ++m) _Pragma("unroll") for (int n = 0; n < 2; ++n) _Pragma("unroll") for (int k = 0; k < 2; ++k) \
        acc[ai][bj][m][n] = __builtin_amdgcn_mfma_f32_16x16x32_bf16(Bt[n][k], At[m][k], acc[ai][bj][m][n], 0, 0, 0); __builtin_amdgcn_s_setprio(0); } while (0)
#define PG8_WAIT_V(n) asm volatile("s_waitcnt vmcnt(" #n ")" ::: "memory")
#define PG8_WAIT_L(n) asm volatile("s_waitcnt lgkmcnt(" #n ")" ::: "memory")
#define PG8_BAR __builtin_amdgcn_s_barrier()
#define PG8_SCHED __builtin_amdgcn_sched_barrier(0)
    Unit cur, nxt; int ui = 0;
    if (!S.next(0, cur)) return;
    f32x4 acc[2][2][4][2];
#pragma unroll
    for (int a = 0; a < 2; ++a)
#pragma unroll
        for (int b = 0; b < 2; ++b)
#pragma unroll
            for (int m = 0; m < 4; ++m)
#pragma unroll
                for (int n = 0; n < 2; ++n) acc[a][b][m][n] = (f32x4){0.f, 0.f, 0.f, 0.f};
    bf16x8 At[4][2], B0[2][2], B1[2][2];
    const char* cA = (const char*)g.A + (size_t)cur.pm * tstep; const char* cB = (const char*)g.Bt + (size_t)cur.pn * tstep;
    S.a_ready(cur);
    if constexpr (SP2) {
        PG8_STAGE(PG8_SB(0, 0), cB, voffB); PG8_STAGE(PG8_SB(0, 1), cB + hstep, voffB); PG8_STAGE(PG8_SA(0, 0), cA, voffA); PG8_STAGE(PG8_SA(0, 1), cA + hstep, voffA);
        if (wr == 1) PG8_BAR;
        PG8_WAIT_V(2); PG8_BAR;
        PG8_STAGE(PG8_SB(1, 0), cB + kstep, voffB); PG8_STAGE(PG8_SA(1, 0), cA + kstep, voffA); PG8_STAGE(PG8_SB(1, 1), cB + hstep + kstep, voffB);
        PG8_WAIT_V(6); PG8_BAR;
    } else {
        PG8_STAGE(PG8_SB(0, 0), cB, voffB); PG8_STAGE(PG8_SA(0, 0), cA, voffA); PG8_STAGE(PG8_SB(0, 1), cB + hstep, voffB); PG8_STAGE(PG8_SA(0, 1), cA + hstep, voffA);
        if (wr == 1) PG8_BAR;
        PG8_WAIT_V(4); PG8_BAR;
        PG8_STAGE(PG8_SB(1, 0), cB + kstep, voffB); PG8_STAGE(PG8_SA(1, 0), cA + kstep, voffA); PG8_STAGE(PG8_SB(1, 1), cB + hstep + kstep, voffB);
        PG8_WAIT_V(6); PG8_BAR;
    }
    for (;;) {
        const bool has_next = S.next(ui + 1, nxt);
        const char* nA = has_next ? (const char*)g.A + (size_t)nxt.pm * tstep : cA; const char* nB = has_next ? (const char*)g.Bt + (size_t)nxt.pn * tstep : cB;
        for (int t = 0; t < nt; t += 2) {
            const bool last = (t == nt - 2);
            const char* a1 = cA + (size_t)(t + 1) * kstep;
            const char* a2 = last ? nA : cA + (size_t)(t + 2) * kstep; const char* b2 = last ? nB : cB + (size_t)(t + 2) * kstep;
            const char* a3 = a2 + kstep; const char* b3 = b2 + kstep;
            if (last && has_next) S.a_ready(nxt);
            if constexpr (SP2) {
            PG8_LDB(B0, 0, 0); PG8_LDB(B1, 0, 1); PG8_SCHED; PG8_LDA(At, 0, 0); PG8_STAGE(PG8_SA(1, 1), a1 + hstep, voffA);
            PG8_WAIT_V(8); PG8_WAIT_L(0); PG8_BAR; PG8_MMA(0, 0, At, B0); PG8_MMA(0, 1, At, B1); PG8_BAR; PG8_SCHED;
            PG8_LDA(At, 0, 1); PG8_STAGE(PG8_SB(0, 0), b2, voffB); PG8_STAGE(PG8_SB(0, 1), b2 + hstep, voffB); PG8_STAGE(PG8_SA(0, 0), a2, voffA);
            PG8_WAIT_V(8); PG8_WAIT_L(0); PG8_BAR; PG8_MMA(1, 0, At, B0); PG8_MMA(1, 1, At, B1); PG8_BAR; PG8_SCHED;
            PG8_LDB(B0, 1, 0); PG8_LDB(B1, 1, 1); PG8_SCHED; PG8_LDA(At, 1, 0); PG8_STAGE(PG8_SA(0, 1), a2 + hstep, voffA);
            PG8_WAIT_V(8); PG8_WAIT_L(0); PG8_BAR; PG8_MMA(0, 0, At, B0); PG8_MMA(0, 1, At, B1); PG8_BAR; PG8_SCHED;
            PG8_LDA(At, 1, 1); PG8_STAGE(PG8_SB(1, 0), b3, voffB); PG8_STAGE(PG8_SB(1, 1), b3 + hstep, voffB); PG8_STAGE(PG8_SA(1, 0), a3, voffA);
            PG8_WAIT_V(8); PG8_WAIT_L(0); PG8_BAR; PG8_MMA(1, 0, At, B0); PG8_MMA(1, 1, At, B1); PG8_BAR; PG8_SCHED;
            } else {
            PG8_LDB(B0, 0, 0); PG8_SCHED; PG8_LDA(At, 0, 0); PG8_STAGE(PG8_SA(1, 1), a1 + hstep, voffA);
            PG8_WAIT_L(8); PG8_BAR; PG8_WAIT_L(0); PG8_MMA(0, 0, At, B0); PG8_BAR; PG8_SCHED;
            PG8_LDB(B1, 0, 1); PG8_STAGE(PG8_SB(0, 0), b2, voffB);
            PG8_BAR; PG8_WAIT_L(0); PG8_MMA(0, 1, At, B1); PG8_BAR;
            PG8_LDA(At, 0, 1); PG8_STAGE(PG8_SA(0, 0), a2, voffA);
            PG8_BAR; PG8_WAIT_L(0); PG8_MMA(1, 0, At, B0); PG8_BAR; PG8_SCHED;
            PG8_STAGE(PG8_SB(0, 1), b2 + hstep, voffB);
            PG8_WAIT_V(6); PG8_BAR; PG8_MMA(1, 1, At, B1); PG8_BAR;
            PG8_LDB(B0, 1, 0); PG8_SCHED; PG8_LDA(At, 1, 0); PG8_STAGE(PG8_SA(0, 1), a2 + hstep, voffA);
            PG8_WAIT_L(8); PG8_BAR; PG8_WAIT_L(0); PG8_MMA(0, 0, At, B0); PG8_BAR; PG8_SCHED;
            PG8_LDB(B1, 1, 1); PG8_STAGE(PG8_SB(1, 0), b3, voffB);
            PG8_BAR; PG8_WAIT_L(0); PG8_MMA(0, 1, At, B1); PG8_BAR;
            PG8_LDA(At, 1, 1); PG8_STAGE(PG8_SA(1, 0), a3, voffA);
            PG8_BAR; PG8_WAIT_L(0); PG8_MMA(1, 0, At, B0); PG8_BAR; PG8_SCHED;
            PG8_STAGE(PG8_SB(1, 1), b3 + hstep, voffB);
            PG8_WAIT_V(6); PG8_BAR; PG8_MMA(1, 1, At, B1); PG8_BAR;
            }
        }
        if constexpr (ALIGN_EPI) { if (wr == 0) PG8_BAR; }
        if constexpr (!Epi::AFTER_DRAIN) { E(acc, cur, wr, wc, fr, fq); S.done(cur); }
        if (!has_next) break;
#pragma unroll
        for (int a = 0; a < 2; ++a)
#pragma unroll
            for (int b = 0; b < 2; ++b)
#pragma unroll
                for (int m = 0; m < 4; ++m)
#pragma unroll
                    for (int n = 0; n < 2; ++n) acc[a][b][m][n] = (f32x4){0.f, 0.f, 0.f, 0.f};
        cur = nxt; cA = nA; cB = nB; ++ui;
        if constexpr (ALIGN_EPI) { if (wr == 1) PG8_BAR; }
    }
    PG8_WAIT_V(0);
    if constexpr (!ALIGN_EPI) { if (wr == 0) PG8_BAR; }
    PG8_BAR;
    if constexpr (Epi::AFTER_DRAIN) { E.fused(acc, cur, wr, wc, fr, fq, lds, wid, lane); S.done(cur); }
#undef PG8_SA
#undef PG8_SB
#undef PG8_STAGE
#undef PG8_LDA
#undef PG8_LDB
#undef PG8_MMA
#undef PG8_WAIT_V
#undef PG8_WAIT_L
#undef PG8_BAR
#undef PG8_SCHED
}
}
#define XB_TMO      128
#define XB_XCNT(j)  (256  + 64 * (j))
#define XB_XSUB(j)  (1280 + 64 * (j))
#define XB_XGEN(j)  (2304 + 64 * (j))
#define XB_TOP      3328
#define XB_TOPGEN   3392
#define XCD_BAR_WORDS 3456
#define XB_SPIN_CAP (1u << 18)

__device__ __forceinline__ unsigned xb_ld(unsigned* p)              { return __hip_atomic_load(p, __ATOMIC_RELAXED, __HIP_MEMORY_SCOPE_AGENT); }
__device__ __forceinline__ unsigned xb_add(unsigned* p, unsigned v) { return __hip_atomic_fetch_add(p, v, __ATOMIC_RELAXED, __HIP_MEMORY_SCOPE_AGENT); }
__device__ __forceinline__ unsigned xb_xcc_id() { return (unsigned)__builtin_amdgcn_s_getreg((3 << 11) | 20) & 0xFu; }
#define XB_SPIN(cond, bar) do { unsigned _sp = 0; while (cond) { __builtin_amdgcn_s_sleep(1); \
    if ((++_sp & 255u) == 0u) { if (xb_ld(&(bar)[XB_TMO])) break; if (_sp > XB_SPIN_CAP) { atomicAdd(&(bar)[XB_TMO], 1u); break; } } } } while (0)

struct XcdBarrier {
    unsigned* bar; unsigned x;
    volatile LAS unsigned* st;
};

__device__ __forceinline__ XcdBarrier xcd_barrier_post(unsigned* bar, volatile LAS unsigned* st) {
    XcdBarrier b; b.bar = bar; b.x = xb_xcc_id(); b.st = st;
    if (threadIdx.x == 0) (void)xb_add(&bar[XB_XCNT(b.x)], 1u);
    return b;
}
__device__ __forceinline__ void xcd_barrier_complete(unsigned* bar, unsigned x, unsigned& nloc, unsigned& nx) {
    const unsigned G = gridDim.x * gridDim.y * gridDim.z;
    unsigned sum, cnt, mine, sp = 0u;
    for (;;) {
        sum = 0u; cnt = 0u; mine = 0u;
#pragma unroll
        for (unsigned j = 0; j < 16; ++j) { const unsigned c = xb_ld(&bar[XB_XCNT(j)]); sum += c; cnt += (c > 0u) ? 1u : 0u; mine = (j == x) ? c : mine; }
        if (sum == G) break;
        __builtin_amdgcn_s_sleep(1);
        if ((++sp & 255u) == 0u) { if (xb_ld(&bar[XB_TMO])) break; if (sp > XB_SPIN_CAP) { atomicAdd(&bar[XB_TMO], 1u); break; } }
    }
    nloc = mine > 0u ? mine : 1u; nx = cnt > 0u ? cnt : 1u;
}

__device__ __forceinline__ void xcd_barrier(const XcdBarrier& b) {
    asm volatile("s_waitcnt vmcnt(0)" ::: "memory");
    __syncthreads();
    if (threadIdx.x == 0) {
        unsigned* bar = b.bar;
        __builtin_amdgcn_s_waitcnt(0);
        unsigned nloc = b.st[0], nx = b.st[1];
        if (nloc == 0u) { xcd_barrier_complete(bar, b.x, nloc, nx); b.st[0] = nloc; b.st[1] = nx; }
        const unsigned old = xb_add(&bar[XB_XSUB(b.x)], 1u);
        const unsigned gen = old / nloc;
        if (old + 1u == (gen + 1u) * nloc) {
            __builtin_amdgcn_fence(__ATOMIC_RELEASE, "agent");
            asm volatile("s_waitcnt vmcnt(0)" ::: "memory");
            const unsigned og = xb_add(&bar[XB_TOP], 1u);
            const unsigned tg = og / nx;
            if (og + 1u == (tg + 1u) * nx) xb_add(&bar[XB_TOPGEN], 1u);
            else XB_SPIN(xb_ld(&bar[XB_TOPGEN]) == tg, bar);
            __builtin_amdgcn_fence(__ATOMIC_ACQUIRE, "agent");
            xb_add(&bar[XB_XGEN(b.x)], 1u);
            asm volatile("s_waitcnt vmcnt(0)" ::: "memory");
        } else {
            XB_SPIN(xb_ld(&bar[XB_XGEN(b.x)]) == gen, bar);
            __builtin_amdgcn_fence(__ATOMIC_ACQUIRE, "agent");
            asm volatile("s_waitcnt vmcnt(0)" ::: "memory");
        }
    }
    __syncthreads();
}
namespace fx {
#define DI __device__ __forceinline__
typedef unsigned short bf16;
typedef short bf16x8 __attribute__((ext_vector_type(8)));
typedef float f32x4 __attribute__((ext_vector_type(4)));
typedef float f32x2 __attribute__((ext_vector_type(2)));
typedef unsigned u32x4 __attribute__((ext_vector_type(4)));
typedef unsigned u32x2 __attribute__((ext_vector_type(2)));
constexpr int M0 = BATCH * SEQ, MP = M0 + DEC_BATCH, MPAD = ((MP + 255) / 256) * 256;
constexpr int ACOLS = DIL_COLS + MEM_COLS, BCOLS = NSA_Q_COLS + NSA_GATE_COLS + MEM_COLS, KVCOLS = 6 * NSA_KV_HEADS * HEAD_DIM;
constexpr int NB_T = 2048;
constexpr int NPK = PEER_HEADS * 2 * PEER_KEYS;
constexpr int NCMP = (SEQ - CMP_BLOCK) / CMP_STRIDE + 1;
constexpr int NCH = SEQ / CMP_STRIDE;
constexpr int NCTX = BATCH + DEC_BATCH;
constexpr int ACROWS = NCTX * NSA_KV_HEADS * NCH;
constexpr int NPOS = PAST_LEN + 1;
constexpr float QSCALE = 0.125f * 1.4426950408889634f;
constexpr int NTHREADS = 512, NWAVES = 8, LDS_BYTES = 147456, RING_BYTES = 131072, MISC_OFF = RING_BYTES + 320;

struct FP {
    const float *x_prompt, *x_sample, *mem_prompt, *cache_dil[3], *cache_nsa_kv, *cache_nsa_win, *cache_mem_kv; const int* page_table;
    const float *w_in_a, *w_out_a, *w_in_b, *w_out_b, *w_mem_kv, *w_kv_b, *cmp_pe, *cmp_w1, *cmp_w2, *ln_g, *ln_b, *peer_wq, *peer_keys, *peer_u, *peer_v;
    float *y_prompt, *y_sample, *dil_p[3], *dil_s[3], *nsa_kv_p, *nsa_kv_s, *win_p, *win_s, *mem_kv_p;
    unsigned* ctl;
    bf16 *XB0, *X1B, *X2B, *X3B, *WA_T, *WMEM_T, *MEMB, *WOA_T, *WOB_T, *WPK_T, *WB_T, *CW1_T, *AC; unsigned char *UB8, *VB8;
    float *ROPE, *CBIAS;
    bf16 *QA, *KA, *VTA, *MQA, *MK, *MVT, *ATTA;
    float *DPART, *DML, *PRE, *X1, *X2, *X3, *SCO, *SELG; int* SELE;
    bf16 *SLK, *SLVT, *WNK, *WNVT, *QB, *MQB, *CK, *CVT, *ATTB;
    float *GATES, *UL, *CKF, *CVF;
    int* SELB;
    float* DBG;
};
struct Args { FP p; int lo, hi; };
struct Carve { size_t off = 0; template <class T> T* take(void* base, size_t n) { T* r = (T*)((char*)base + off); off += ((n * sizeof(T) + 255) / 256) * 256; return r; } };
constexpr size_t CTL_BYTES = 65536;
inline size_t carve(FP& p, void* base) {
    Carve c;
    p.ctl = c.take<unsigned>(base, CTL_BYTES / 4);
    p.XB0 = c.take<bf16>(base, (size_t)MPAD * D_MODEL); p.X1B = c.take<bf16>(base, (size_t)MPAD * D_MODEL); p.X2B = c.take<bf16>(base, (size_t)MPAD * D_MODEL); p.X3B = c.take<bf16>(base, (size_t)MPAD * D_MODEL);
    p.WA_T = c.take<bf16>(base, (size_t)ACOLS * D_MODEL); p.WMEM_T = c.take<bf16>(base, (size_t)DEPTH * 2 * MEM_COLS * D_MODEL); p.MEMB = c.take<bf16>(base, (size_t)BATCH * MEM_TOKENS * D_MODEL);
    p.WOA_T = c.take<bf16>(base, (size_t)D_MODEL * 2 * MEM_COLS); p.WOB_T = c.take<bf16>(base, (size_t)D_MODEL * (NSA_Q_COLS + MEM_COLS));
    p.WPK_T = c.take<bf16>(base, (size_t)DEPTH * NPK * D_MODEL); p.WB_T = c.take<bf16>(base, (size_t)NB_T * D_MODEL);
    p.UB8 = c.take<unsigned char>(base, (size_t)DEPTH * PEER_EXPERTS * D_MODEL); p.VB8 = c.take<unsigned char>(base, (size_t)DEPTH * PEER_EXPERTS * D_MODEL);
    p.CW1_T = c.take<bf16>(base, (size_t)2 * 256 * 1024); p.AC = c.take<bf16>(base, (size_t)2 * ACROWS * 1024);
    p.ROPE = c.take<float>(base, (size_t)NPOS * 64); p.CBIAS = c.take<float>(base, 2 * CMP_HIDDEN);
    p.QA = c.take<bf16>(base, (size_t)3 * MPAD * 256); p.KA = c.take<bf16>(base, (size_t)3 * MPAD * 256); p.VTA = c.take<bf16>(base, (size_t)3 * BATCH * DIL_HEADS * HEAD_DIM * SEQ + 4096);
    p.MQA = c.take<bf16>(base, (size_t)MPAD * 256); p.MK = c.take<bf16>(base, (size_t)DEPTH * BATCH * MEM_TOKENS * MEM_COLS); p.MVT = c.take<bf16>(base, (size_t)DEPTH * BATCH * MEM_COLS * MEM_TOKENS);
    p.ATTA = c.take<bf16>(base, (size_t)MPAD * 2 * MEM_COLS);
    p.DPART = c.take<float>(base, (size_t)3 * MP * DIL_HEADS * HEAD_DIM); p.DML = c.take<float>(base, (size_t)3 * MP * DIL_HEADS * 2);
    p.PRE = c.take<float>(base, (size_t)MPAD * D_MODEL); p.X1 = c.take<float>(base, (size_t)MPAD * D_MODEL); p.X2 = c.take<float>(base, (size_t)MPAD * D_MODEL); p.X3 = c.take<float>(base, (size_t)MPAD * D_MODEL);
    p.SCO = c.take<float>(base, (size_t)MPAD * NPK); p.SELG = c.take<float>(base, (size_t)MP * 128); p.SELE = c.take<int>(base, (size_t)MP * 128);
    p.SLK = c.take<bf16>(base, (size_t)BATCH * NSA_KV_HEADS * SEQ * HEAD_DIM); p.SLVT = c.take<bf16>(base, (size_t)BATCH * NSA_KV_HEADS * SEQ * HEAD_DIM);
    p.WNK = c.take<bf16>(base, (size_t)BATCH * NSA_KV_HEADS * SEQ * HEAD_DIM + 4096); p.WNVT = c.take<bf16>(base, (size_t)BATCH * NSA_KV_HEADS * SEQ * HEAD_DIM + 4096);
    p.QB = c.take<bf16>(base, (size_t)MPAD * NSA_Q_COLS); p.MQB = c.take<bf16>(base, (size_t)MPAD * 256);
    p.CK = c.take<bf16>(base, (size_t)NCTX * NSA_KV_HEADS * NCH * HEAD_DIM); p.CVT = c.take<bf16>(base, (size_t)NCTX * NSA_KV_HEADS * HEAD_DIM * NCH); p.ATTB = c.take<bf16>(base, (size_t)MPAD * (NSA_Q_COLS + MEM_COLS));
    p.GATES = c.take<float>(base, (size_t)MPAD * 64); p.UL = c.take<float>(base, (size_t)2 * ACROWS * 256);
    p.CKF = c.take<float>(base, (size_t)DEC_BATCH * NSA_KV_HEADS * NCH * HEAD_DIM); p.CVF = c.take<float>(base, (size_t)DEC_BATCH * NSA_KV_HEADS * NCH * HEAD_DIM);
    p.SELB = c.take<int>(base, (size_t)MP * NSA_KV_HEADS * 16);
#ifdef NSA_DEBUG
    p.DBG = c.take<float>(base, (size_t)3 * MP * 768);
#else
    p.DBG = nullptr;
#endif
    return c.off;
}
inline void bind_io(FP& p, void* const* d_in, float* out) {
    p.x_prompt = (const float*)d_in[0]; p.x_sample = (const float*)d_in[1]; p.mem_prompt = (const float*)d_in[2]; p.cache_dil[0] = (const float*)d_in[3]; p.cache_dil[1] = (const float*)d_in[4]; p.cache_dil[2] = (const float*)d_in[5];
    p.cache_nsa_kv = (const float*)d_in[6]; p.cache_nsa_win = (const float*)d_in[7]; p.cache_mem_kv = (const float*)d_in[8]; p.page_table = (const int*)d_in[9];
    p.w_in_a = (const float*)d_in[10]; p.w_out_a = (const float*)d_in[11]; p.w_in_b = (const float*)d_in[12]; p.w_out_b = (const float*)d_in[13]; p.w_mem_kv = (const float*)d_in[14]; p.w_kv_b = (const float*)d_in[15];
    p.cmp_pe = (const float*)d_in[16]; p.cmp_w1 = (const float*)d_in[17]; p.cmp_w2 = (const float*)d_in[18]; p.ln_g = (const float*)d_in[19]; p.ln_b = (const float*)d_in[20];
    p.peer_wq = (const float*)d_in[21]; p.peer_keys = (const float*)d_in[22]; p.peer_u = (const float*)d_in[23]; p.peer_v = (const float*)d_in[24];
    size_t o = 0; auto take = [&](size_t n) { float* r = out + o; o += n; return r; };
    p.y_prompt = take((size_t)M0 * D_MODEL); p.y_sample = take((size_t)DEC_BATCH * D_MODEL);
    for (int g = 0; g < 3; ++g) p.dil_p[g] = take((size_t)BATCH * DIL_W[g] * 2 * DIL_HEADS * HEAD_DIM);
    for (int g = 0; g < 3; ++g) p.dil_s[g] = take((size_t)DEC_BATCH * DIL_W[g] * 2 * DIL_HEADS * HEAD_DIM);
    p.nsa_kv_p = take((size_t)M0 * 4 * NSA_KV_HEADS * HEAD_DIM); p.nsa_kv_s = take((size_t)DEC_BATCH * 4 * NSA_KV_HEADS * HEAD_DIM);
    p.win_p = take((size_t)BATCH * SWA_WINDOW * 2 * NSA_KV_HEADS * HEAD_DIM); p.win_s = take((size_t)DEC_BATCH * SWA_WINDOW * 2 * NSA_KV_HEADS * HEAD_DIM);
    p.mem_kv_p = take((size_t)DEPTH * BATCH * MEM_TOKENS * 2 * MEM_COLS);
}
DI unsigned f2bf(float f) { unsigned u = __builtin_bit_cast(unsigned, f); return (u + 0x7fffu + ((u >> 16) & 1u)) >> 16; }
DI unsigned pk2(float lo, float hi) { return f2bf(lo) | (f2bf(hi) << 16); }
DI float bf2f(unsigned short b) { return __builtin_bit_cast(float, (unsigned)b << 16); }
DI float bflo(unsigned w) { return __builtin_bit_cast(float, w << 16); }
DI float bfhi(unsigned w) { return __builtin_bit_cast(float, w & 0xffff0000u); }
template <int CTRL> DI float dpp1(float x) { return __builtin_bit_cast(float, __builtin_amdgcn_update_dpp(0, __builtin_bit_cast(int, x), CTRL, 0xF, 0xF, true)); }
DI float wave_sum(float v) { v += dpp1<0xB1>(v); v += dpp1<0x4E>(v); v += dpp1<0x141>(v); v += dpp1<0x140>(v);
    float a = v, b = v; asm volatile("s_nop 1\n\tv_permlane16_swap_b32 %0, %1" : "+v"(a), "+v"(b)); v = a + b; a = v; b = v;
    asm volatile("s_nop 1\n\tv_permlane32_swap_b32 %0, %1" : "+v"(a), "+v"(b)); return a + b; }
DI float wave_max(float v) { v = fmaxf(v, dpp1<0xB1>(v)); v = fmaxf(v, dpp1<0x4E>(v)); v = fmaxf(v, dpp1<0x141>(v)); v = fmaxf(v, dpp1<0x140>(v));
    float a = v, b = v; asm volatile("s_nop 1\n\tv_permlane16_swap_b32 %0, %1" : "+v"(a), "+v"(b)); v = fmaxf(a, b); a = v; b = v;
    asm volatile("s_nop 1\n\tv_permlane32_swap_b32 %0, %1" : "+v"(a), "+v"(b)); return fmaxf(a, b); }
DI float gelu_tanh(float x) { const float u = 0.7978845608028654f * (x + 0.044715f * x * x * x); const float e = __builtin_amdgcn_exp2f(u * 2.885390081777927f);   const float t = 1.0f - 2.0f / (e + 1.0f); return 0.5f * x * (1.0f + t); }
DI float* sel3(float* const (&a)[3], int g) { return g == 0 ? a[0] : (g == 1 ? a[1] : a[2]); }
DI const float* sel3c(const float* const (&a)[3], int g) { return g == 0 ? a[0] : (g == 1 ? a[1] : a[2]); }
__host__ DI size_t ktile_off(int t, int d) { const int blk = t >> 5, kk = t & 31, b = (kk >> 2) & 1, i = 4 * (kk >> 3) + (kk & 3), s = d >> 5, c = (d & 31) >> 3; return ((size_t)(blk * 4 + 2 * b + s) * 64 + i + 16 * c) * 8 + (d & 7); }
__host__ DI size_t vtile_off(int dim, int t) { const int blk = t >> 5, kk = t & 31; return ((size_t)(blk * 4 + (dim >> 4)) * 64 + (dim & 15) + 16 * (kk >> 3)) * 8 + (kk & 7); }
struct Ctx { LAS unsigned char* lds; int tid, lane, wave, vcu, G; };
DI int row_pos(int r) { return r < M0 ? (r & (SEQ - 1)) : PAST_LEN; }

struct ColSrc { const float* p; int ld; };
DI int rope_il(int e) { return (e >> 1) + 32 * (e & 1); }
DI ColSrc col_wa(const FP& P, int n) {
    const int t = n >> 8, ct = n & 255, h = ct >> 6, e = ct & 63; if (t >= 9) return ColSrc{P.w_in_a + DIL_COLS + ct, ACOLS};
    const int j = t % 3, d = (j < 2) ? rope_il(e) : e; return ColSrc{P.w_in_a + t * 256 + h * 64 + d, ACOLS}; }
DI ColSrc col_wb(const FP& P, int n) {
    const int t = n >> 8, ct = n & 255, e = ct & 63;
    if (t < 3) { const int ty = 2 * t + (ct >> 7), kvh = (ct >> 6) & 1; const bool rot = (ty == 2 || ty == 4); return ColSrc{P.w_kv_b + (ty * NSA_KV_HEADS + kvh) * 64 + (rot ? rope_il(e) : e), KVCOLS}; }
    if (t < 6) { const int h = (t - 3) * 4 + (ct >> 6); return ColSrc{P.w_in_b + h * 64 + rope_il(e), BCOLS}; }
    if (t == 6) return ColSrc{P.w_in_b + NSA_Q_COLS + NSA_GATE_COLS + ct, BCOLS};
    if (ct < NSA_GATE_COLS) return ColSrc{P.w_in_b + NSA_Q_COLS + ct, BCOLS};
    return ColSrc{nullptr, 0}; }
DI ColSrc col_wmem(const FP& P, int n) { const int l = n >> 9, c = n & 511; return ColSrc{P.w_mem_kv + (size_t)l * D_MODEL * 512 + c, 512}; }
DI ColSrc col_woa(const FP& P, int n) { return ColSrc{P.w_out_a + n, D_MODEL}; }
DI ColSrc col_wob(const FP& P, int n) { return ColSrc{P.w_out_b + n, D_MODEL}; }
DI ColSrc col_cw1(const FP& P, int n) {
    const int ty = n >> 8, half = (n >> 7) & 1, hid = n & 127; return ColSrc{P.cmp_w1 + (size_t)ty * CMP_BLOCK * HEAD_DIM * CMP_HIDDEN + (size_t)half * 16 * HEAD_DIM * CMP_HIDDEN + hid, CMP_HIDDEN}; }
template <class CF> DI void transpose_item(const FP& P, CF cf, int K, bf16* WT, LAS float* scr, int item, int nblk, int lane) {
    const int kb = item / nblk, nb = item % nblk, k0 = 64 * kb, n0 = 32 * nb;
    const ColSrc cs = cf(P, n0 + (lane & 31));
#pragma unroll 8
    for (int i = 0; i < 32; ++i) { const int kk = 2 * i + (lane >> 5); scr[kk * 33 + (lane & 31)] = cs.p ? cs.p[(size_t)(k0 + kk) * cs.ld] : 0.f; }
    asm volatile("s_waitcnt lgkmcnt(0)" ::: "memory");
    const int c = lane & 7;
#pragma unroll
    for (int j = 0; j < 4; ++j) { const int n = (lane >> 3) + 8 * j; const LAS float* s = scr + (8 * c) * 33 + n;
        u32x4 o; o.x = pk2(s[0 * 33], s[1 * 33]); o.y = pk2(s[2 * 33], s[3 * 33]); o.z = pk2(s[4 * 33], s[5 * 33]); o.w = pk2(s[6 * 33], s[7 * 33]);
        *(u32x4*)(WT + (size_t)(n0 + n) * K + k0 + 8 * c) = o; }
    asm volatile("s_waitcnt lgkmcnt(0)" ::: "memory");
}
DI void cvt_row1024(const float* src, bf16* dst, int lane) {
#pragma unroll
    for (int j = 0; j < 4; ++j) { f32x4 v = src ? *(const f32x4*)(src + 256 * j + 4 * lane) : (f32x4){0.f, 0.f, 0.f, 0.f}; u32x2 o; o.x = pk2(v.x, v.y); o.y = pk2(v.z, v.w); *(u32x2*)(dst + 256 * j + 4 * lane) = o; }
}
DI void cvt_row1024_fp8(const float* src, unsigned char* dst, float sc, int lane) { u32x4 o; unsigned w[4];
#pragma unroll
    for (int j = 0; j < 4; ++j) { const f32x4 v = *(const f32x4*)(src + 16 * lane + 4 * j) * sc; int t = __builtin_amdgcn_cvt_pk_fp8_f32(v.x, v.y, 0, false); t = __builtin_amdgcn_cvt_pk_fp8_f32(v.z, v.w, t, true); w[j] = (unsigned)t; }
    o.x = w[0]; o.y = w[1]; o.z = w[2]; o.w = w[3]; *(u32x4*)(dst + 16 * lane) = o; }
DI void p0_prologue(const FP& P, const Ctx& C) {
    LAS float* scr = (LAS float*)(C.lds + C.wave * 16384);
    const int gw = C.vcu * NWAVES + C.wave, NGW = C.G * NWAVES, lane = C.lane;
    { constexpr int IA = (D_MODEL / 64) * (ACOLS / 32), IM = (D_MODEL / 64) * (1024 / 32), IOA = (512 / 64) * (D_MODEL / 32), IOB = (1024 / 64) * (D_MODEL / 32), IB = (D_MODEL / 64) * (NB_T / 32), IC = (1024 / 64) * (512 / 32);
      constexpr int NIT = IA + IM + IOA + IOB + IB + IC;
      for (int it = gw; it < NIT; it += NGW) { int r = it;
          if (r < IA) { transpose_item(P, col_wa, D_MODEL, P.WA_T, scr, r, ACOLS / 32, lane); continue; } r -= IA;
          if (r < IM) { transpose_item(P, col_wmem, D_MODEL, P.WMEM_T, scr, r, 1024 / 32, lane); continue; } r -= IM;
          if (r < IOA) { transpose_item(P, col_woa, 512, P.WOA_T, scr, r, D_MODEL / 32, lane); continue; } r -= IOA;
          if (r < IOB) { transpose_item(P, col_wob, 1024, P.WOB_T, scr, r, D_MODEL / 32, lane); continue; } r -= IOB;
          if (r < IB) { transpose_item(P, col_wb, D_MODEL, P.WB_T, scr, r, NB_T / 32, lane); continue; } r -= IB;
          transpose_item(P, col_cw1, 1024, P.CW1_T, scr, r, 512 / 32, lane); } }
    for (int r = gw; r < M0 - NGW; r += 2 * NGW) {
        f32x4 v[8];
#pragma unroll
        for (int j = 0; j < 8; ++j) v[j] = *(const f32x4*)(P.x_prompt + (size_t)(r + (j >> 2) * NGW) * D_MODEL + 256 * (j & 3) + 4 * lane);
#pragma unroll
        for (int j = 0; j < 8; ++j) { u32x2 o; o.x = pk2(v[j].x, v[j].y); o.y = pk2(v[j].z, v[j].w); *(u32x2*)(P.XB0 + (size_t)(r + (j >> 2) * NGW) * D_MODEL + 256 * (j & 3) + 4 * lane) = o; } }
    for (int r = gw + ((M0 - NGW - gw + 2 * NGW - 1) / (2 * NGW)) * (2 * NGW); r < MPAD; r += NGW) { cvt_row1024(r < M0 ? P.x_prompt + (size_t)r * D_MODEL : (r < MP ? P.x_sample + (size_t)(r - M0) * D_MODEL : nullptr), P.XB0 + (size_t)r * D_MODEL, lane);
        if (r >= MP) { cvt_row1024(nullptr, P.X1B + (size_t)r * D_MODEL, lane); cvt_row1024(nullptr, P.X2B + (size_t)r * D_MODEL, lane); cvt_row1024(nullptr, P.X3B + (size_t)r * D_MODEL, lane);
            for (int c = lane; c < 512; c += 64) { P.ATTA[(size_t)r * 512 + c] = 0; P.ATTB[(size_t)r * 1024 + c] = 0; P.ATTB[(size_t)r * 1024 + 512 + c] = 0; } } }
    for (int r = gw; r < BATCH * MEM_TOKENS; r += NGW) cvt_row1024(P.mem_prompt + (size_t)r * D_MODEL, P.MEMB + (size_t)r * D_MODEL, lane);
#pragma unroll 1
    for (int r = 2 * gw; r < DEPTH * PEER_EXPERTS; r += 2 * NGW) { f32x4 a[16];
#pragma unroll
        for (int q = 0; q < 4; ++q) { const float* s0 = (q < 2 ? P.peer_u : P.peer_v) + (size_t)(r + (q & 1)) * D_MODEL + 16 * lane;
#pragma unroll
            for (int j = 0; j < 4; ++j) a[4 * q + j] = *(const f32x4*)(s0 + 4 * j); }
#pragma unroll
        for (int q = 0; q < 4; ++q) { const float sc = q < 2 ? 256.f : 64.f; unsigned w[4];
#pragma unroll
            for (int j = 0; j < 4; ++j) { const f32x4 v = a[4 * q + j] * sc; int t = __builtin_amdgcn_cvt_pk_fp8_f32(v.x, v.y, 0, false); t = __builtin_amdgcn_cvt_pk_fp8_f32(v.z, v.w, t, true); w[j] = (unsigned)t; }
            u32x4 o; o.x = w[0]; o.y = w[1]; o.z = w[2]; o.w = w[3]; *(u32x4*)((q < 2 ? P.UB8 : P.VB8) + (size_t)(r + (q & 1)) * D_MODEL + 16 * lane) = o; } }
    for (int i = gw * 64 + lane; i < NPOS * 32; i += NGW * 64) { const int pos = i >> 5, d = i & 31; const double inv = exp2(-(double)d * (13.287712379549449 / 32.0)); const double turns = (double)pos * inv * 0.15915494309189535;
        const float fr = (float)(turns - floor(turns)); P.ROPE[pos * 64 + d] = __builtin_amdgcn_cosf(fr); P.ROPE[pos * 64 + 32 + d] = __builtin_amdgcn_sinf(fr); }
    const int gwT = C.wave * C.G + C.vcu;
    for (int i = gwT; i < 2 * CMP_HIDDEN; i += NGW) { const int ty = i / CMP_HIDDEN, hid = i % CMP_HIDDEN; float a = 0.f;
#pragma unroll 8
        for (int k = lane; k < CMP_BLOCK * HEAD_DIM; k += 64) a += P.cmp_pe[ty * CMP_BLOCK * HEAD_DIM + k] * P.cmp_w1[((size_t)ty * CMP_BLOCK * HEAD_DIM + k) * CMP_HIDDEN + hid];
        a = wave_sum(a); if (lane == 0) P.CBIAS[i] = a; }
    for (int it2 = gwT; it2 < DEC_BATCH * (PAST_LEN / PAGE_SIZE) * (PAGE_SIZE / 8); it2 += NGW) { const int it = it2 / (PAGE_SIZE / 8), rg = it2 % (PAGE_SIZE / 8);
        const int n = it / (PAST_LEN / PAGE_SIZE), pi = it % (PAST_LEN / PAGE_SIZE); const int pg = P.page_table[it];
        const float* src = P.cache_nsa_kv + (size_t)pg * PAGE_SIZE * 512 + 4 * lane; const int ty = lane >> 5, kvh = (lane >> 4) & 1, d = (4 * lane) & 63;
        bf16* dst = P.AC + ((size_t)ty * ACROWS + ((size_t)(BATCH + n) * NSA_KV_HEADS + kvh) * NCH + pi * (PAGE_SIZE / 16)) * 1024 + d;
        { const int r0 = rg * 8; f32x4 v[8];
#pragma unroll
            for (int u = 0; u < 8; ++u) v[u] = *(const f32x4*)(src + (size_t)(r0 + u) * 512);
#pragma unroll
            for (int u = 0; u < 8; ++u) { const int t = r0 + u; u32x2 o; o.x = pk2(v[u].x, v[u].y); o.y = pk2(v[u].z, v[u].w); *(u32x2*)(dst + (size_t)(t / 16) * 1024 + (t % 16) * 64) = o; } } }
}
DI void cache_copy_queue(const FP& P, const Ctx& C, volatile LAS unsigned* slot) {
    const int lane = C.lane;
    int nch[4], tot = 0;
#pragma unroll
    for (int g = 0; g < 4; ++g) { const int W = g < 3 ? dil_w(g) : SWA_WINDOW, RV = g < 3 ? 128 : 64; nch[g] = (DEC_BATCH * (W - 1) * RV + 8191) / 8192; tot += nch[g]; }
#pragma unroll 1
    for (;;) {
        __syncthreads();
        if (C.tid == 0) *slot = atomicAdd(P.ctl + 12288, 1u);
        __syncthreads();
        int c = (int)*slot; if (c >= tot) break;
        int g = 0; if (c >= nch[0]) { c -= nch[0]; g = 1; if (c >= nch[1]) { c -= nch[1]; g = 2; if (c >= nch[2]) { c -= nch[2]; g = 3; } } }
        const int W = g < 3 ? dil_w(g) : SWA_WINDOW, RV = g < 3 ? 128 : 64;
        const f32x4* src = (const f32x4*)(g < 3 ? sel3c(P.cache_dil, g) : P.cache_nsa_win); f32x4* dst = (f32x4*)(g < 3 ? sel3(P.dil_s, g) : P.win_s);
        const int per = (W - 1) * RV, nvec = DEC_BATCH * per;
        const int i0 = c * 8192 + C.wave * 1024;
        if (i0 < nvec) { f32x4 v[16]; int idx[16];
            const int n0 = __builtin_amdgcn_readfirstlane((int)((unsigned)i0 / (unsigned)per)), o0 = i0 - n0 * per;
#pragma unroll
            for (int u = 0; u < 16; ++u) { int o = o0 + u * 64 + lane, n = n0; if (o >= per) { o -= per; ++n; } if (n >= DEC_BATCH) { n = DEC_BATCH - 1; o = per - 1; } idx[u] = n * (per + RV) + o; v[u] = src[(size_t)idx[u] + RV]; }
#pragma unroll
            for (int u = 0; u < 16; ++u) { const int i = i0 + u * 64 + lane; if (i < nvec) dst[(size_t)idx[u]] = v[u]; } }
    }
    __syncthreads();
}
DI void p0_wpk(const FP& P, const Ctx& C) {
    LAS float* sw = (LAS float*)C.lds;
    LAS float* sk = (LAS float*)(C.lds + 32768);
    constexpr int NIT = DEPTH * 16 * (D_MODEL / 64);
    for (int it = C.vcu; it < NIT; it += C.G) { const int l = it / (16 * (D_MODEL / 64)), rem = it % (16 * (D_MODEL / 64)), hc = rem / (D_MODEL / 64), kb = rem % (D_MODEL / 64);
        __syncthreads();
        for (int i = C.tid; i < 64 * 64; i += NTHREADS) { const int r = i >> 6, d = i & 63; sw[r * 65 + d] = P.peer_wq[((size_t)l * D_MODEL + kb * 64 + r) * 1024 + hc * 64 + d]; }
        for (int i = C.tid; i < 128 * 64; i += NTHREADS) { const int r = i >> 6, d = i & 63; sk[r * 68 + d] = P.peer_keys[(((size_t)l * 16 + hc) * PEER_KEYS + r) * 64 + d]; }
        __syncthreads();
        { const int ki = C.lane, kk0 = C.wave; float a[16];
#pragma unroll
          for (int j = 0; j < 16; ++j) a[j] = 0.f;
#pragma unroll 2
          for (int d = 0; d < 64; d += 4) { const float w0 = sw[ki * 65 + d], w1 = sw[ki * 65 + d + 1], w2 = sw[ki * 65 + d + 2], w3 = sw[ki * 65 + d + 3];
#pragma unroll
              for (int j = 0; j < 16; ++j) { const f32x4 kq = *(const LAS f32x4*)(sk + (kk0 + 8 * j) * 68 + d); a[j] += w0 * kq.x + w1 * kq.y + w2 * kq.z + w3 * kq.w; } }
#pragma unroll
          for (int j = 0; j < 16; ++j) P.WPK_T[((size_t)l * NPK + hc * 128 + kk0 + 8 * j) * D_MODEL + kb * 64 + ki] = (bf16)f2bf(a[j]); } }
    __syncthreads();
}

#define EPI_LOOP(...) int fr_l = fr, fq_l = fq; asm volatile("" : "+v"(fr_l), "+v"(fq_l));     \
    _Pragma("unroll") for (int ai = 0; ai < 2; ++ai) _Pragma("unroll") for (int m = 0; m < 4; ++m) { const int row = u.pm * 256 + ai * 128 + wr * 64 + m * 16 + fr_l; \
    _Pragma("unroll") for (int bj = 0; bj < 2; ++bj) { const int ct = bj * 128 + wc * 32 + fq_l * 8; const f32x4 v0 = acc[ai][bj][m][0], v1 = acc[ai][bj][m][1]; __VA_ARGS__ } asm volatile("" ::: "memory"); }
DI void rope4(const float* rope_row, int dp, const f32x4& v0, const f32x4& v1, f32x4& lo, f32x4& hi) {
    const f32x4 c = *(const f32x4*)(rope_row + dp), s = *(const f32x4*)(rope_row + 32 + dp);
    lo.x = v0.x * c.x - v0.y * s.x; hi.x = v0.y * c.x + v0.x * s.x; lo.y = v0.z * c.y - v0.w * s.y; hi.y = v0.w * c.y + v0.z * s.y;
    lo.z = v1.x * c.z - v1.y * s.z; hi.z = v1.y * c.z + v1.x * s.z; lo.w = v1.z * c.w - v1.w * s.w; hi.w = v1.w * c.w + v1.z * s.w; }
DI u32x2 pk4(const f32x4& v) { u32x2 o; o.x = pk2(v.x, v.y); o.y = pk2(v.z, v.w); return o; }
DI u32x4 pk8(const f32x4& a, const f32x4& b) { u32x4 o; o.x = pk2(a.x, a.y); o.y = pk2(a.z, a.w); o.z = pk2(b.x, b.y); o.w = pk2(b.z, b.w); return o; }
DI int dil_perm(int t, int d) { return (t % d) * (SEQ / d) + t / d; }
#ifdef EPIA_REP
#define EPIA_REP_BEGIN _Pragma("unroll 1") for (int rep_ = 0; rep_ < EPIA_REP; ++rep_) {
#define EPIA_REP_END }
#else
#define EPIA_REP_BEGIN
#define EPIA_REP_END
#endif
struct EpiA {
    static constexpr bool PERM = true, AFTER_DRAIN = false; const FP& P;
    DI void operator()(const f32x4 (&acc)[2][2][4][2], const pg8::Unit& u, int wr, int wc, int fr, int fq) const {
        const int t9 = u.pn; const int g = t9 / 3, j = t9 % 3;
        EPIA_REP_BEGIN EPI_LOOP({ if (row < MP) { const int h = ct >> 6, e = ct & 63; const int pos = row_pos(row);
            if (t9 == 9) { *(u32x4*)(P.MQA + (size_t)row * 256 + ct) = pk8(v0 * QSCALE, v1 * QSCALE); }
            else if (j < 2) { f32x4 lo, hi; const int dp = e >> 1; rope4(P.ROPE + pos * 64, dp, v0, v1, lo, hi);
                if (j == 0) { bf16* q = P.QA + ((size_t)g * MPAD + row) * 256 + h * 64 + dp; *(u32x2*)q = pk4(lo * QSCALE); *(u32x2*)(q + 32) = pk4(hi * QSCALE); }
                else { if (row < M0) { bf16* kt = P.KA + ((size_t)(g * BATCH + row / SEQ) * DIL_HEADS + h) * 64 * SEQ; const int cm = dil_perm(pos, dil_d(g)); *(u32x2*)(kt + ktile_off(cm, dp)) = pk4(lo); *(u32x2*)(kt + ktile_off(cm, dp + 32)) = pk4(hi); }
                    const int W = dil_w(g); float* o = nullptr;
                    if (row >= M0) o = sel3(P.dil_s, g) + (((size_t)(row - M0) * W + W - 1) * 2 + 0) * 256; else if (pos >= SEQ - W) o = sel3(P.dil_p, g) + (((size_t)(row / SEQ) * W + pos - (SEQ - W)) * 2 + 0) * 256;
                    if (o) { *(f32x4*)(o + h * 64 + dp) = lo; *(f32x4*)(o + h * 64 + 32 + dp) = hi; } } }
            else { const int W = dil_w(g), d = dil_d(g); float* o = nullptr;
                if (row >= M0) o = sel3(P.dil_s, g) + (((size_t)(row - M0) * W + W - 1) * 2 + 1) * 256; else if (pos >= SEQ - W) o = sel3(P.dil_p, g) + (((size_t)(row / SEQ) * W + pos - (SEQ - W)) * 2 + 1) * 256;
                if (o) { *(f32x4*)(o + ct) = v0; *(f32x4*)(o + ct + 4) = v1; }
                if (row < M0) { bf16* vt = P.VTA + ((size_t)(g * BATCH + row / SEQ) * DIL_HEADS + h) * 64 * SEQ + vtile_off(e, dil_perm(pos, d));
                    vt[0] = (bf16)f2bf(v0.x); vt[8] = (bf16)f2bf(v0.y); vt[16] = (bf16)f2bf(v0.z); vt[24] = (bf16)f2bf(v0.w); vt[32] = (bf16)f2bf(v1.x); vt[40] = (bf16)f2bf(v1.y); vt[48] = (bf16)f2bf(v1.z); vt[56] = (bf16)f2bf(v1.w); } } } }) EPIA_REP_END
    }
};
struct EpiMem {
    static constexpr bool PERM = true, AFTER_DRAIN = false; const FP& P;
    DI void operator()(const f32x4 (&acc)[2][2][4][2], const pg8::Unit& u, int wr, int wc, int fr, int fq) const {
        const int l = u.pn >> 1, half = u.pn & 1;
        EPI_LOOP({ const int n = row / MEM_TOKENS, mt = row % MEM_TOKENS; float* o = P.mem_kv_p + (((size_t)l * BATCH + n) * MEM_TOKENS + mt) * 512 + half * 256 + ct; *(f32x4*)o = v0; *(f32x4*)(o + 4) = v1;
            if (half == 0) *(u32x4*)(P.MK + (((size_t)l * BATCH + n) * MEM_HEADS + (ct >> 6)) * MEM_TOKENS * 64 + ktile_off(mt, ct & 63)) = pk8(v0, v1);
            else { bf16* vt = P.MVT + (((size_t)l * BATCH + n) * MEM_HEADS + (ct >> 6)) * MEM_TOKENS * 64 + vtile_off(ct & 63, mt);
                vt[0] = (bf16)f2bf(v0.x); vt[8] = (bf16)f2bf(v0.y); vt[16] = (bf16)f2bf(v0.z); vt[24] = (bf16)f2bf(v0.w); vt[32] = (bf16)f2bf(v1.x); vt[40] = (bf16)f2bf(v1.y); vt[48] = (bf16)f2bf(v1.z); vt[56] = (bf16)f2bf(v1.w); } })
    }
};
struct EpiPre {
    static constexpr bool PERM = true, AFTER_DRAIN = false; const float* xa; const float* xb; float* pre;
    DI void operator()(const f32x4 (&acc)[2][2][4][2], const pg8::Unit& u, int wr, int wc, int fr, int fq) const {
        EPI_LOOP({ if (row < MP) { const int col = u.pn * 256 + ct; const float* x = (xb && row >= M0) ? xb + (size_t)(row - M0) * D_MODEL + col : xa + (size_t)row * D_MODEL + col;
            const f32x4 a = *(const f32x4*)x, b = *(const f32x4*)(x + 4); float* o = pre + (size_t)row * D_MODEL + col; *(f32x4*)o = a * ALPHA + v0; *(f32x4*)(o + 4) = b * ALPHA + v1; } })
    }
};
struct EpiF32 {
    static constexpr bool PERM = true, AFTER_DRAIN = false; float* out; int ldc; int nrows;
    DI void operator()(const f32x4 (&acc)[2][2][4][2], const pg8::Unit& u, int wr, int wc, int fr, int fq) const {
        EPI_LOOP({ if (row < nrows) { float* o = out + (size_t)row * ldc + u.pn * 256 + ct; *(f32x4*)o = v0; *(f32x4*)(o + 4) = v1; } })
    }
};
}
namespace fx {
struct Tile16 { f32x4 o[4]; float m, l; };
DI void tile_init(Tile16& T) { T.o[0] = T.o[1] = T.o[2] = T.o[3] = (f32x4){0.f, 0.f, 0.f, 0.f}; T.m = -INFINITY; T.l = 0.f; }
typedef __bf16 bf16x2_t __attribute__((ext_vector_type(2)));
DI unsigned cvtpk(float lo, float hi) { const f32x2 v = {lo, hi}; const bf16x2_t b = __builtin_convertvector(v, bf16x2_t); return __builtin_bit_cast(unsigned, b); }
struct KV8 { bf16x8 ka0, ka1, kb0, kb1, v0, v1, v2, v3; };
DI void kv_load(KV8& r, const bf16* k0, const bf16* k1, const bf16* v, long vs16) {
    r.ka0 = *(const bf16x8*)k0; r.ka1 = *(const bf16x8*)(k0 + 32); r.kb0 = *(const bf16x8*)k1; r.kb1 = *(const bf16x8*)(k1 + 32);
    r.v0 = *(const bf16x8*)v; r.v1 = *(const bf16x8*)(v + vs16); r.v2 = *(const bf16x8*)(v + 2 * vs16); r.v3 = *(const bf16x8*)(v + 3 * vs16); }
DI void mk_range(int a, int b, bool ok, int& lo, unsigned& rng) { const bool v = ok && b >= a; lo = v ? a : (1 << 20); rng = v ? (unsigned)(b - a) : 0u; }
DI float colmax(float x) { float a = x, b = x; asm volatile("s_nop 1\n\tv_permlane32_swap_b32 %0, %1" : "+v"(a), "+v"(b)); float m = fmaxf(a, b); a = m; b = m;
    asm volatile("s_nop 1\n\tv_permlane16_swap_b32 %0, %1" : "+v"(a), "+v"(b)); return fmaxf(a, b); }
DI float colsum(float x) { float a = x, b = x; asm volatile("s_nop 1\n\tv_permlane32_swap_b32 %0, %1" : "+v"(a), "+v"(b)); float m = a + b; a = m; b = m;
    asm volatile("s_nop 1\n\tv_permlane16_swap_b32 %0, %1" : "+v"(a), "+v"(b)); return a + b; }
DI void tile_compute(Tile16& T, const bf16x8 (&qf)[2], const KV8& r, int lo, unsigned rng) {
    f32x4 s0 = (f32x4){0.f, 0.f, 0.f, 0.f}, s1 = (f32x4){0.f, 0.f, 0.f, 0.f};
    s0 = __builtin_amdgcn_mfma_f32_16x16x32_bf16(r.ka0, qf[0], s0, 0, 0, 0); s0 = __builtin_amdgcn_mfma_f32_16x16x32_bf16(r.ka1, qf[1], s0, 0, 0, 0);
    s1 = __builtin_amdgcn_mfma_f32_16x16x32_bf16(r.kb0, qf[0], s1, 0, 0, 0); s1 = __builtin_amdgcn_mfma_f32_16x16x32_bf16(r.kb1, qf[1], s1, 0, 0, 0);
    float s[8] = {s0.x, s0.y, s0.z, s0.w, s1.x, s1.y, s1.z, s1.w};
    float mx = -INFINITY;
#pragma unroll
    for (int e = 0; e < 8; ++e) { s[e] = ((unsigned)(e - lo) <= rng) ? s[e] : -INFINITY; mx = fmaxf(mx, s[e]); }
    mx = colmax(mx);
    const float mnew = fmaxf(T.m, mx), muse = (mnew == -INFINITY) ? 0.f : mnew;
    const float alpha = __builtin_amdgcn_exp2f(T.m - muse);
    float ls = 0.f;
#pragma unroll
    for (int e = 0; e < 8; ++e) { s[e] = __builtin_amdgcn_exp2f(s[e] - muse); ls += s[e]; }
    T.l = T.l * alpha + ls; T.m = mnew;
    u32x4 pw; pw.x = cvtpk(s[0], s[1]); pw.y = cvtpk(s[2], s[3]); pw.z = cvtpk(s[4], s[5]); pw.w = cvtpk(s[6], s[7]);
    const bf16x8 pf = __builtin_bit_cast(bf16x8, pw);
    T.o[0] = __builtin_amdgcn_mfma_f32_16x16x32_bf16(r.v0, pf, T.o[0] * alpha, 0, 0, 0); T.o[1] = __builtin_amdgcn_mfma_f32_16x16x32_bf16(r.v1, pf, T.o[1] * alpha, 0, 0, 0);
    T.o[2] = __builtin_amdgcn_mfma_f32_16x16x32_bf16(r.v2, pf, T.o[2] * alpha, 0, 0, 0); T.o[3] = __builtin_amdgcn_mfma_f32_16x16x32_bf16(r.v3, pf, T.o[3] * alpha, 0, 0, 0);
}
template <class BUF, class LD, class CP> DI void pipe2t(int n, LD ld, CP cp) { if (n <= 0) return; BUF A, B; ld(A, 0);
#pragma unroll 1
    for (int i = 0; i < n; i += 2) { ld(B, (i + 1 < n) ? i + 1 : i); cp(A, i); ld(A, (i + 2 < n) ? i + 2 : i); if (i + 1 < n) cp(B, i + 1); } }
template <class LD, class CP> DI void pipe2(int n, LD ld, CP cp) { if (n <= 0) return; KV8 A, B; ld(A, 0);
#pragma unroll 1
    for (int i = 0; i < n; i += 2) { ld(B, (i + 1 < n) ? i + 1 : i); cp(A, i); ld(A, (i + 2 < n) ? i + 2 : i); if (i + 1 < n) cp(B, i + 1); } }
DI void kv_load_t(KV8& r, const bf16* kt, const bf16* vt, int lane) {
    const bf16* k = kt + lane * 8; const bf16* v = vt + lane * 8;
    r.ka0 = *(const bf16x8*)k; r.ka1 = *(const bf16x8*)(k + 512); r.kb0 = *(const bf16x8*)(k + 1024); r.kb1 = *(const bf16x8*)(k + 1536);
    r.v0 = *(const bf16x8*)v; r.v1 = *(const bf16x8*)(v + 512); r.v2 = *(const bf16x8*)(v + 1024); r.v3 = *(const bf16x8*)(v + 1536); }
DI int krow_of(int i, int b) { return 8 * (i >> 2) + 4 * b + (i & 3); }

DI void dil_micro(const FP& P, int n, int h, int t0, int mt, int lane) {
    const int g = mt >> 4, idx = mt & 15, d = dil_d(g), per = 16 / d;
    const int r = idx / per, sub = idx % per, i0 = t0 / d + 16 * sub, ib = i0 - 128, NC = SEQ / d;
    const int q = lane & 15, c = lane >> 4;
    const bf16* Qb = P.QA + ((size_t)g * MPAD + (size_t)n * SEQ) * 256 + h * 64;
    const bf16* Kb = P.KA + ((size_t)(g * BATCH + n) * DIL_HEADS + h) * 64 * SEQ + (size_t)r * NC * 64; const bf16* Vb = P.VTA + ((size_t)(g * BATCH + n) * DIL_HEADS + h) * 64 * SEQ + (size_t)r * NC * 64;
    bf16x8 qf[2]; { const bf16* qp = Qb + (size_t)(r + d * (i0 + q)) * 256 + 8 * c; qf[0] = *(const bf16x8*)qp; qf[1] = *(const bf16x8*)(qp + 32); }
    Tile16 T; tile_init(T);
    const int qi = i0 + q; const int tb0 = ib >> 5  , nblk = ((i0 + 15) >> 5) - tb0 + 1;
    pipe2(nblk, [&](KV8& kv, int i) { int tb = tb0 + i; tb = tb < 0 ? 0 : tb; kv_load_t(kv, Kb + (size_t)tb * 2048, Vb + (size_t)tb * 2048, lane); },
          [&](const KV8& kv, int i) { const int k0 = 32 * (tb0 + i) + 8 * c; int lo; unsigned rng; const int a = qi - (DIL_TAPS - 1); mk_range((a > 0 ? a : 0) - k0, qi - k0, true, lo, rng); tile_compute(T, qf, kv, lo, rng); });
    const int row = n * SEQ + r + d * qi;
    float* op = P.DPART + (((size_t)g * MP + row) * DIL_HEADS + h) * 64 + 4 * c;
#pragma unroll
    for (int db = 0; db < 4; ++db) *(f32x4*)(op + 16 * db) = T.o[db];
    T.l = colsum(T.l);
    if (c == 0) { float* ml = P.DML + (((size_t)g * MP + row) * DIL_HEADS + h) * 2; ml[0] = T.m; ml[1] = T.l; }
}
DI void mem_micro(const FP& P, const bf16* Q  , int ldq, int row0, int layer, int n, int h, bf16* O  , int ldo, int lane) {
    const int q = lane & 15, c = lane >> 4;
    bf16x8 qf[2]; { const bf16* qp = Q + (size_t)(row0 + q) * ldq + 8 * c; qf[0] = *(const bf16x8*)qp; qf[1] = *(const bf16x8*)(qp + 32); }
    const bf16* Kb = P.MK + (((size_t)layer * BATCH + n) * MEM_HEADS + h) * MEM_TOKENS * 64; const bf16* Vb = P.MVT + (((size_t)layer * BATCH + n) * MEM_HEADS + h) * MEM_TOKENS * 64;
    Tile16 T; tile_init(T);
    pipe2(MEM_TOKENS / 32, [&](KV8& kv, int i) { kv_load_t(kv, Kb + (size_t)i * 2048, Vb + (size_t)i * 2048, lane); }, [&](const KV8& kv, int) { tile_compute(T, qf, kv, -8, 64u); });
    const float inv = 1.0f / colsum(T.l); bf16* op = O + (size_t)(row0 + q) * ldo + 4 * c;
#pragma unroll
    for (int db = 0; db < 4; ++db) *(u32x2*)(op + 16 * db) = pk4(T.o[db] * inv);
}
struct Dec { float m, l, o; };
template <class KF, class VF> DI void dec_chunk(Dec& D, const LAS float* q, int nk, KF kf, VF vf, int lane) {
    float s = -INFINITY;
    if (lane < nk) { const float* k = kf(lane); float a = 0.f;
#pragma unroll
        for (int d4 = 0; d4 < 16; ++d4) { const f32x4 kv = *(const f32x4*)(k + 4 * d4); a += kv.x * q[4 * d4] + kv.y * q[4 * d4 + 1] + kv.z * q[4 * d4 + 2] + kv.w * q[4 * d4 + 3]; }
        s = a; }
    const float mx = wave_max(s), mnew = fmaxf(D.m, mx), alpha = __builtin_amdgcn_exp2f(D.m - mnew);
    const float p = (lane < nk) ? __builtin_amdgcn_exp2f(s - mnew) : 0.f;
    D.l = D.l * alpha + wave_sum(p); D.m = mnew; float o = D.o * alpha;
    for (int j0 = 0; j0 < nk; j0 += 8) { float vv[8];
#pragma unroll
        for (int u = 0; u < 8; ++u) { const int jj = (j0 + u < nk) ? j0 + u : nk - 1; vv[u] = vf(jj)[lane]; }
#pragma unroll
        for (int u = 0; u < 8; ++u) { const float pj = (j0 + u < nk) ? __builtin_bit_cast(float, __builtin_amdgcn_readlane(__builtin_bit_cast(int, p), (j0 + u) & 63)) : 0.f; o += pj * vv[u]; } }
    D.o = o;
}
DI float dec_combine(const Ctx& C, const Dec& D) {
    LAS float* cb = (LAS float*)(C.lds + 4096);
    cb[C.wave * 66 + C.lane] = D.o; if (C.lane == 0) { cb[C.wave * 66 + 64] = D.m; cb[C.wave * 66 + 65] = D.l; }
    asm volatile("s_waitcnt lgkmcnt(0)" ::: "memory"); __syncthreads();
    float M = -INFINITY;
#pragma unroll
    for (int ww = 0; ww < NWAVES; ++ww) M = fmaxf(M, cb[ww * 66 + 64]);
    float L = 0.f, o = 0.f;
#pragma unroll
    for (int ww = 0; ww < NWAVES; ++ww) { const float mw = cb[ww * 66 + 64]; const float f = (mw == -INFINITY) ? 0.f : __builtin_amdgcn_exp2f(mw - M); L += f * cb[ww * 66 + 65]; o += f * cb[ww * 66 + C.lane]; }
    return o / L;
}
DI void atta_phase(const FP& P, const Ctx& C) {
    const int lane = C.lane, w = C.wave;
    constexpr int NT = SEQ / 256, NIT = BATCH * NT * DIL_HEADS;
    for (int it = C.vcu; it < NIT; it += C.G) { const int h = it % DIL_HEADS, tt = (it / DIL_HEADS) % NT, n = it / (DIL_HEADS * NT), t0 = tt * 256;
        for (int mt = w; mt < 48; mt += NWAVES) dil_micro(P, n, h, t0, mt, lane);
        asm volatile("s_waitcnt vmcnt(0)" ::: "memory"); __syncthreads();
        for (int i = C.tid; i < 256 * 16; i += NTHREADS) { const int tk = i >> 4, d4 = (i & 15) * 4; const int row = n * SEQ + t0 + tk;
            float mg[3], lg[3]; float M = -INFINITY;
#pragma unroll
            for (int g = 0; g < 3; ++g) { const float* ml = P.DML + (((size_t)g * MP + row) * DIL_HEADS + h) * 2; mg[g] = ml[0]; lg[g] = ml[1]; M = fmaxf(M, mg[g]); }
            f32x4 acc = (f32x4){0.f, 0.f, 0.f, 0.f}; float L = 0.f;
#pragma unroll
            for (int g = 0; g < 3; ++g) { const float wg = __builtin_amdgcn_exp2f(mg[g] - M); L += wg * lg[g]; acc += *(const f32x4*)(P.DPART + (((size_t)g * MP + row) * DIL_HEADS + h) * 64 + d4) * wg; }
            *(u32x2*)(P.ATTA + (size_t)row * 512 + h * 64 + d4) = pk4(acc * (1.0f / L)); }
        for (int mt = w; mt < 16; mt += NWAVES) mem_micro(P, P.MQA + h * 64, 256, n * SEQ + t0 + 16 * mt, 0, n, h, P.ATTA + 256 + h * 64, 512, lane);
        __syncthreads();
    }
    LAS float* qs = (LAS float*)C.lds;
    for (int it = C.vcu; it < DEC_BATCH * DIL_HEADS * 2; it += C.G) { const int kind = it & 1, h = (it >> 1) % DIL_HEADS, ns = (it >> 1) / DIL_HEADS, row = M0 + ns;
        __syncthreads();
        if (kind == 0) { if (C.tid < 192) qs[C.tid] = bf2f(P.QA[((size_t)(C.tid >> 6) * MPAD + row) * 256 + h * 64 + (C.tid & 63)]); } else { if (C.tid < 64) qs[C.tid] = bf2f(P.MQA[(size_t)row * 256 + h * 64 + C.tid]); }
        asm volatile("s_waitcnt lgkmcnt(0)" ::: "memory"); __syncthreads();
        Dec D; D.m = -INFINITY; D.l = 0.f; D.o = 0.f;
        if (kind == 0) { constexpr int CPG = (DIL_TAPS + 63) / 64;
            for (int ck = w; ck < 3 * CPG; ck += NWAVES) { const int g = ck / CPG, j0 = (ck % CPG) * 64; const int W = dil_w(g), d = dil_d(g); const float* cache = sel3c(P.cache_dil, g) + (size_t)ns * W * 512; const float* newrow = sel3(P.dil_s, g) + ((size_t)ns * W + W - 1) * 512;
                const int nk = (DIL_TAPS - j0) < 64 ? (DIL_TAPS - j0) : 64;
                dec_chunk(D, qs + g * 64, nk, [&](int j) { const int tap = j0 + j; return (tap == 0 ? newrow : cache + (size_t)(W - d * tap) * 512) + h * 64; },
                          [&](int j) { const int tap = j0 + j; return (tap == 0 ? newrow : cache + (size_t)(W - d * tap) * 512) + 256 + h * 64; }, lane); } }
        else { const float* mk = P.cache_mem_kv + ((size_t)0 * DEC_BATCH + ns) * MEM_TOKENS * 512;
            for (int ck = w; ck < MEM_TOKENS / 64; ck += NWAVES) { const int j0 = ck * 64; dec_chunk(D, qs, 64, [&](int j) { return mk + (size_t)(j0 + j) * 512 + h * 64; }, [&](int j) { return mk + (size_t)(j0 + j) * 512 + 256 + h * 64; }, lane); } }
        const float o = dec_combine(C, D);
        if (w == 0) P.ATTA[(size_t)row * 512 + (kind == 0 ? 0 : 256) + h * 64 + lane] = (bf16)f2bf(o);
    }
    __syncthreads();
}
DI void ln_phase(const FP& P, const Ctx& C, const float* pre, const float* gam, const float* bet, float* xo, bf16* xb, float* yp, float* ys) {
    const int gw = C.vcu * NWAVES + C.wave, NGW = C.G * NWAVES, lane = C.lane;
    for (int r = gw; r < MP; r += NGW) { const float* x = pre + (size_t)r * D_MODEL; f32x4 v[4]; float s = 0.f;
#pragma unroll
        for (int j = 0; j < 4; ++j) { v[j] = *(const f32x4*)(x + 256 * j + 4 * lane); s += (v[j].x + v[j].y) + (v[j].z + v[j].w); }
        const float mu = wave_sum(s) * (1.0f / D_MODEL); float s2 = 0.f;
#pragma unroll
        for (int j = 0; j < 4; ++j) { v[j] = v[j] - mu; s2 += (v[j].x * v[j].x + v[j].y * v[j].y) + (v[j].z * v[j].z + v[j].w * v[j].w); }
        const float rs = 1.0f / sqrtf(wave_sum(s2) * (1.0f / D_MODEL) + LN_EPS);
#pragma unroll
        for (int j = 0; j < 4; ++j) { const f32x4 gg = *(const f32x4*)(gam + 256 * j + 4 * lane), bb = *(const f32x4*)(bet + 256 * j + 4 * lane); const f32x4 o = v[j] * rs * gg + bb;
            if (xo) *(f32x4*)(xo + (size_t)r * D_MODEL + 256 * j + 4 * lane) = o;
            if (xb) *(u32x2*)(xb + (size_t)r * D_MODEL + 256 * j + 4 * lane) = pk4(o);
            if (yp) { if (r < M0) *(f32x4*)(yp + (size_t)r * D_MODEL + 256 * j + 4 * lane) = o; else *(f32x4*)(ys + (size_t)(r - M0) * D_MODEL + 256 * j + 4 * lane) = o; } }
    }
}
}
namespace fx {
#define INS16(V, I, v_, i_) do { const float _v = (v_); const int _i = (i_); bool _c[16]; _Pragma("unroll") for (int _k = 0; _k < 16; ++_k) _c[_k] = _v > V[_k]; \
    _Pragma("unroll") for (int _k = 15; _k >= 1; --_k) { V[_k] = _c[_k] ? (_c[_k - 1] ? V[_k - 1] : _v) : V[_k]; I[_k] = _c[_k] ? (_c[_k - 1] ? I[_k - 1] : _i) : I[_k]; } \
    V[0] = _c[0] ? _v : V[0]; I[0] = _c[0] ? _i : I[0]; } while (0)
DI void wave_top16_128(float a, float b, int lane, float& outv, int& outi) {
    outv = -INFINITY; outi = 0;
#pragma unroll 1
    for (int k = 0; k < 16; ++k) { const float m = wave_max(fmaxf(a, b)); const unsigned long long ba = __ballot(a == m), bb = __ballot(b == m); int idx;
        if (ba) { const int l = __builtin_ctzll(ba); idx = l; if (lane == l) a = -INFINITY; } else { const int l = __builtin_ctzll(bb); idx = 64 + l; if (lane == l) b = -INFINITY; }
        if (lane == k) { outv = m; outi = idx; } }
}
DI void topk_wave_item(const FP& P, long it, int lane) {
    const float* s = P.SCO + it * 256; float v1, v2; int i1, i2;
    wave_top16_128(s[lane], s[64 + lane], lane, v1, i1); wave_top16_128(s[128 + lane], s[192 + lane], lane, v2, i2);
    int a = 0, rem = lane; bool valid = false;
    for (int aa = 0; aa < 16; ++aa) { const int nb = 16 / (aa + 1); if (!valid) { if (rem < nb) { a = aa; valid = true; } else rem -= nb; } }
    const int b = valid ? rem : 0;
    float cs = __shfl(v1, a) + __shfl(v2, b); const int ce = __shfl(i1, a) * PEER_KEYS + __shfl(i2, b); if (!valid) cs = -INFINITY;
    float tv = -INFINITY; int te = 0;
#pragma unroll 1
    for (int k = 0; k < 16; ++k) { const float m = wave_max(cs); const unsigned long long bm = __ballot(cs == m); const int l = __builtin_ctzll(bm); const int e = __shfl(ce, l); if (lane == l) cs = -INFINITY; if (lane == k) { tv = m; te = e; } }
    const float mx = __shfl(tv, 0); const float ex = (lane < 16) ? __expf(tv - mx) : 0.f; const float z = wave_sum(ex);
    if (lane < 16) { P.SELG[it * 16 + lane] = ex / z; P.SELE[it * 16 + lane] = te; }
}
#define KINS16(V, key_) do { const float _key = (key_); _Pragma("unroll") for (int _k = 15; _k >= 1; --_k) V[_k] = __builtin_amdgcn_fmed3f(V[_k - 1], V[_k], _key); V[0] = fmaxf(V[0], _key); } while (0)
DI float pack_key(float v, unsigned lowbits, unsigned mask) { return __builtin_bit_cast(float, (__builtin_bit_cast(unsigned, v) & ~mask) | lowbits); }
DI void topk_phase(const FP& P, const Ctx& C) {
    const int lane = C.lane; LAS float* st = (LAS float*)(C.lds + C.wave * 16384);
    const int NWI = (M0 * PEER_HEADS) / 64;
    for (int wi = C.vcu * NWAVES + C.wave; wi < NWI; wi += C.G * NWAVES) {
        const long it0 = (long)wi * 64; const long it = it0 + lane;
        float V1[16], V2[16], V3[16];
#pragma unroll
        for (int k = 0; k < 16; ++k) { V1[k] = V2[k] = V3[k] = -INFINITY; }
#pragma unroll 1
        for (int ch = 0; ch < 8; ++ch) {
#pragma unroll
            for (int u = 0; u < 8; ++u) { const int f4 = u * 64 + lane, j = f4 >> 3, q = f4 & 7, hf = q >> 2, c4 = (q & 3) * 4; const long itj = it0 + j;
                const f32x4 v = *(const f32x4*)(P.SCO + itj * 256 + hf * 128 + ch * 16 + c4);
                st[j * 33 + hf * 16 + c4] = v.x; st[j * 33 + hf * 16 + c4 + 1] = v.y; st[j * 33 + hf * 16 + c4 + 2] = v.z; st[j * 33 + hf * 16 + c4 + 3] = v.w; }
            asm volatile("s_waitcnt lgkmcnt(0)" ::: "memory");
#pragma unroll 4
            for (int c = 0; c < 16; ++c) { const float va = st[lane * 33 + c], vb = st[lane * 33 + 16 + c]; const unsigned lb = 127u - (unsigned)(ch * 16 + c); KINS16(V1, pack_key(va, lb, 127u)); KINS16(V2, pack_key(vb, lb, 127u)); }
            asm volatile("s_waitcnt lgkmcnt(0)" ::: "memory");
        }
        LAS int* lc = (LAS int*)st;
        { int ord = 0;
#pragma unroll
          for (int a = 0; a < 16; ++a) { const unsigned ba = __builtin_bit_cast(unsigned, V1[a]); const float va = __builtin_bit_cast(float, ba & ~127u); const int ia = 127 - (int)(ba & 127u);
#pragma unroll
              for (int b = 0; b < 16; ++b) if ((a + 1) * (b + 1) <= 16) { const unsigned bb = __builtin_bit_cast(unsigned, V2[b]); const float vb = __builtin_bit_cast(float, bb & ~127u); const int ib = 127 - (int)(bb & 127u);
                  lc[lane * 51 + ord] = ia * PEER_KEYS + ib; KINS16(V3, pack_key(va + vb, 63u - (unsigned)ord, 63u)); ++ord; } } }
        asm volatile("s_waitcnt lgkmcnt(0)" ::: "memory");
        float g[16]; int e[16]; float z = 0.f; const float vmax = __builtin_bit_cast(float, __builtin_bit_cast(unsigned, V3[0]) & ~63u);
#pragma unroll
        for (int k = 0; k < 16; ++k) { const unsigned bk = __builtin_bit_cast(unsigned, V3[k]); e[k] = lc[lane * 51 + 63 - (int)(bk & 63u)]; g[k] = __expf(__builtin_bit_cast(float, bk & ~63u) - vmax); z += g[k]; }
        const float iz = 1.0f / z;
#pragma unroll
        for (int k4 = 0; k4 < 4; ++k4) { *(f32x4*)(P.SELG + it * 16 + 4 * k4) = (f32x4){g[4 * k4] * iz, g[4 * k4 + 1] * iz, g[4 * k4 + 2] * iz, g[4 * k4 + 3] * iz};
            *(int4*)(P.SELE + it * 16 + 4 * k4) = make_int4(e[4 * k4], e[4 * k4 + 1], e[4 * k4 + 2], e[4 * k4 + 3]); }
        asm volatile("s_waitcnt lgkmcnt(0)" ::: "memory");
    }
    for (int si = C.vcu * NWAVES + C.wave; si < DEC_BATCH * PEER_HEADS; si += C.G * NWAVES) topk_wave_item(P, (long)M0 * PEER_HEADS + si, lane);
    __syncthreads();
}
constexpr float PEER_SU = 256.f, PEER_SV = 64.f;
DI float dot16_fp8(const u32x4& w, const f32x2 (&x2)[8]) { f32x2 a = {0.f, 0.f};
    a += __builtin_amdgcn_cvt_pk_f32_fp8((int)w.x, false) * x2[0]; a += __builtin_amdgcn_cvt_pk_f32_fp8((int)w.x, true) * x2[1];
    a += __builtin_amdgcn_cvt_pk_f32_fp8((int)w.y, false) * x2[2]; a += __builtin_amdgcn_cvt_pk_f32_fp8((int)w.y, true) * x2[3];
    a += __builtin_amdgcn_cvt_pk_f32_fp8((int)w.z, false) * x2[4]; a += __builtin_amdgcn_cvt_pk_f32_fp8((int)w.z, true) * x2[5];
    a += __builtin_amdgcn_cvt_pk_f32_fp8((int)w.w, false) * x2[6]; a += __builtin_amdgcn_cvt_pk_f32_fp8((int)w.w, true) * x2[7];
    return a.x + a.y; }
DI void axpy16_fp8(const u32x4& w, float s, f32x2 (&o2)[8]) { const f32x2 s2 = {s, s};
    o2[0] += __builtin_amdgcn_cvt_pk_f32_fp8((int)w.x, false) * s2; o2[1] += __builtin_amdgcn_cvt_pk_f32_fp8((int)w.x, true) * s2;
    o2[2] += __builtin_amdgcn_cvt_pk_f32_fp8((int)w.y, false) * s2; o2[3] += __builtin_amdgcn_cvt_pk_f32_fp8((int)w.y, true) * s2;
    o2[4] += __builtin_amdgcn_cvt_pk_f32_fp8((int)w.z, false) * s2; o2[5] += __builtin_amdgcn_cvt_pk_f32_fp8((int)w.z, true) * s2;
    o2[6] += __builtin_amdgcn_cvt_pk_f32_fp8((int)w.w, false) * s2; o2[7] += __builtin_amdgcn_cvt_pk_f32_fp8((int)w.w, true) * s2; }
#if defined(PEER_SHARD) || defined(PEER_SHARD2)
#define PEER_FIRST_ROUND nrounds
#else
#define PEER_FIRST_ROUND 0
#endif
template <int CTRL> DI float dppf(float x) { return __builtin_bit_cast(float, __builtin_amdgcn_update_dpp(0, __builtin_bit_cast(int, x), CTRL, 0xF, 0xF, true)); }
DI float rdlane(float v, int l) { return __builtin_bit_cast(float, __builtin_amdgcn_readlane(__builtin_bit_cast(int, v), l)); }
DI void peer_phase(const FP& P, const Ctx& C, int layer, const float* xin, float* fout, float* fout_s, bf16* xb, bool samples_only = false) {
    const int lane = C.lane; const unsigned char* U = P.UB8 + (size_t)layer * PEER_EXPERTS * D_MODEL; const unsigned char* Vt = P.VB8 + (size_t)layer * PEER_EXPERTS * D_MODEL;
    const float* gam = P.ln_g + ((size_t)layer * 2 + 1) * D_MODEL; const float* bet = P.ln_b + ((size_t)layer * 2 + 1) * D_MODEL;
    const int nrounds = (M0 + C.G * NWAVES - 1) / (C.G * NWAVES);
#pragma unroll 1
    for (int rd = samples_only ? nrounds : 0; rd <= nrounds; ++rd) {
        const bool smp = (rd == nrounds); int r = smp ? M0 + C.vcu : rd * C.G * NWAVES + C.vcu * NWAVES + C.wave; if (smp ? (C.vcu >= DEC_BATCH) : (r >= M0)) continue;
        const int pb = smp ? 16 * C.wave : 0, pe = smp ? pb + 16 : 128;
        f32x2 x2[8], o2[8];
#pragma unroll
        for (int j = 0; j < 4; ++j) { const f32x4 a = *(const f32x4*)(xin + (size_t)r * D_MODEL + 16 * lane + 4 * j); x2[2 * j] = (f32x2){a.x, a.y}; x2[2 * j + 1] = (f32x2){a.z, a.w}; }
#pragma unroll
        for (int k = 0; k < 8; ++k) o2[k] = (f32x2){0.f, 0.f};
        const int e_l = P.SELE[(size_t)r * 128 + lane], e_h = P.SELE[(size_t)r * 128 + 64 + lane]; const float g_l = P.SELG[(size_t)r * 128 + lane], g_h = P.SELG[(size_t)r * 128 + 64 + lane];
#pragma unroll 1
        for (int b0 = pb; b0 < pe; b0 += 8) {
            u32x4 uw[8], vw[8];
#pragma unroll
            for (int k = 0; k < 8; ++k) { const int hk = b0 + k; const int e = (hk < 64) ? __builtin_amdgcn_readlane(e_l, hk & 63) : __builtin_amdgcn_readlane(e_h, hk & 63);
                uw[k] = *(const u32x4*)(U + (size_t)e * D_MODEL + 16 * lane); vw[k] = *(const u32x4*)(Vt + (size_t)e * D_MODEL + 16 * lane); }
            float d[8];
#pragma unroll
            for (int k = 0; k < 8; ++k) d[k] = dot16_fp8(uw[k], x2);
            float e4[4], e2[2], e1;
            { const bool hi = lane & 1;
#pragma unroll
              for (int i = 0; i < 4; ++i) { const float keep = hi ? d[4 + i] : d[i], send = hi ? d[i] : d[4 + i]; e4[i] = keep + __shfl_xor(send, 1); } }
            { const bool hi = lane & 2;
#pragma unroll
              for (int i = 0; i < 2; ++i) { const float keep = hi ? e4[2 + i] : e4[i], send = hi ? e4[i] : e4[2 + i]; e2[i] = keep + __shfl_xor(send, 2); } }
            { const bool hi = lane & 4; const float keep = hi ? e2[1] : e2[0], send = hi ? e2[0] : e2[1]; e1 = keep + __shfl_xor(send, 4); }
            e1 += __shfl_xor(e1, 8); e1 += __shfl_xor(e1, 16); e1 += __shfl_xor(e1, 32);
            const int myk = 4 * (lane & 1) + (lane & 2) + ((lane >> 2) & 1); const int myhk = b0 + myk;
            const float myg = (myhk < 64) ? __shfl(g_l, myhk & 63) : __shfl(g_h, myhk & 63);
            const float act = myg * gelu_tanh(e1 * (1.0f / PEER_SU)) * (1.0f / PEER_SV);
#pragma unroll
            for (int k = 0; k < 8; ++k) { const int src = (k >> 2) | (((k >> 1) & 1) << 1) | ((k & 1) << 2); axpy16_fp8(vw[k], rdlane(act, src), o2); }
        }
        if (smp) {
            LAS float* red = (LAS float*)C.lds;
#pragma unroll
            for (int k = 0; k < 8; ++k) { red[C.wave * 1024 + 16 * lane + 2 * k] = o2[k].x; red[C.wave * 1024 + 16 * lane + 2 * k + 1] = o2[k].y; }
            asm volatile("s_waitcnt lgkmcnt(0)" ::: "memory"); __syncthreads();
            if (C.wave == 0) {
#pragma unroll
                for (int k = 0; k < 8; ++k) { float ax = 0.f, ay = 0.f;
#pragma unroll
                    for (int ww = 0; ww < NWAVES; ++ww) { ax += red[ww * 1024 + 16 * lane + 2 * k]; ay += red[ww * 1024 + 16 * lane + 2 * k + 1]; } o2[k] = (f32x2){ax, ay}; } }
            __syncthreads();
            if (C.wave != 0) continue; }
        float s = 0.f;
#pragma unroll
        for (int k = 0; k < 8; ++k) { o2[k] += x2[k] * ALPHA; s += o2[k].x + o2[k].y; }
        const float mu = wave_sum(s) * (1.0f / D_MODEL); float s2 = 0.f;
#pragma unroll
        for (int k = 0; k < 8; ++k) { o2[k] -= mu; s2 += o2[k].x * o2[k].x + o2[k].y * o2[k].y; }
        const float rs = 1.0f / sqrtf(wave_sum(s2) * (1.0f / D_MODEL) + LN_EPS);
        float* frow = (r < M0) ? fout + (size_t)r * D_MODEL : fout_s + (size_t)(r - M0) * D_MODEL;
#pragma unroll
        for (int j = 0; j < 4; ++j) { const int c0 = 16 * lane + 4 * j; const f32x4 gg = *(const f32x4*)(gam + c0), bb = *(const f32x4*)(bet + c0);
            const f32x4 y = (f32x4){o2[2 * j].x * rs, o2[2 * j].y * rs, o2[2 * j + 1].x * rs, o2[2 * j + 1].y * rs} * gg + bb;
            *(f32x4*)(frow + c0) = y; if (xb) *(u32x2*)(xb + (size_t)r * D_MODEL + c0) = pk4(y); }
    }
}
DI void peer_u_phase(const FP& P, const Ctx& C, int layer, const bf16* xb16) {
    const int lane = C.lane; const unsigned char* U = P.UB8 + (size_t)layer * PEER_EXPERTS * D_MODEL;
    const int s = (int)(blockIdx.x & 7), nw = (C.G >> 3) * NWAVES, widx = (int)(blockIdx.x >> 3) * NWAVES + C.wave;
#pragma unroll 1
    for (int r = widx; r < MP; r += nw) {
        const int e0 = P.SELE[(size_t)r * 128 + lane], e1 = P.SELE[(size_t)r * 128 + 64 + lane]; const float g0 = P.SELG[(size_t)r * 128 + lane], g1 = P.SELG[(size_t)r * 128 + 64 + lane];
        unsigned long long b0 = __ballot((e0 >> 11) == s), b1 = __ballot((e1 >> 11) == s);
        if ((b0 | b1) == 0ull) continue;
        f32x2 x2[8]; { const u32x4 xa = *(const u32x4*)(xb16 + (size_t)r * D_MODEL + 16 * lane), xc = *(const u32x4*)(xb16 + (size_t)r * D_MODEL + 16 * lane + 8);
            x2[0] = (f32x2){bflo(xa.x), bfhi(xa.x)}; x2[1] = (f32x2){bflo(xa.y), bfhi(xa.y)}; x2[2] = (f32x2){bflo(xa.z), bfhi(xa.z)}; x2[3] = (f32x2){bflo(xa.w), bfhi(xa.w)};
            x2[4] = (f32x2){bflo(xc.x), bfhi(xc.x)}; x2[5] = (f32x2){bflo(xc.y), bfhi(xc.y)}; x2[6] = (f32x2){bflo(xc.z), bfhi(xc.z)}; x2[7] = (f32x2){bflo(xc.w), bfhi(xc.w)}; }
#pragma unroll 1
        while ((b0 | b1) != 0ull) {
            int hk[8]; u32x4 uw[8]; int nv = 0;
#pragma unroll
            for (int k = 0; k < 8; ++k) { int h;
                if (b0) { h = __builtin_ctzll(b0); b0 &= b0 - 1; ++nv; } else if (b1) { h = 64 + __builtin_ctzll(b1); b1 &= b1 - 1; ++nv; } else h = hk[k > 0 ? k - 1 : 0];
                hk[k] = h; const int e = (h < 64) ? __builtin_amdgcn_readlane(e0, h & 63) : __builtin_amdgcn_readlane(e1, h & 63);
                uw[k] = *(const u32x4*)(U + (size_t)e * D_MODEL + 16 * lane); }
            float d[8];
#pragma unroll
            for (int k = 0; k < 8; ++k) d[k] = dot16_fp8(uw[k], x2);
            float e4[4], e2[2], e1s;
            { const bool hi = lane & 1;
#pragma unroll
              for (int i = 0; i < 4; ++i) { const float keep = hi ? d[4 + i] : d[i], send = hi ? d[i] : d[4 + i]; e4[i] = keep + __shfl_xor(send, 1); } }
            { const bool hi = lane & 2;
#pragma unroll
              for (int i = 0; i < 2; ++i) { const float keep = hi ? e4[2 + i] : e4[i], send = hi ? e4[i] : e4[2 + i]; e2[i] = keep + __shfl_xor(send, 2); } }
            { const bool hi = lane & 4; const float keep = hi ? e2[1] : e2[0], send = hi ? e2[0] : e2[1]; e1s = keep + __shfl_xor(send, 4); }
            e1s += __shfl_xor(e1s, 8); e1s += __shfl_xor(e1s, 16); e1s += __shfl_xor(e1s, 32);
            const int myk = 4 * (lane & 1) + (lane & 2) + ((lane >> 2) & 1);
            int myh = hk[0];
#pragma unroll
            for (int k = 1; k < 8; ++k) myh = (myk == k) ? hk[k] : myh;
            const float ga = __shfl(g0, myh & 63), gb = __shfl(g1, myh & 63); const float myg = (myh < 64) ? ga : gb;
            if (lane < 8 && myk < nv) P.SCO[(size_t)r * 128 + myh] = myg * gelu_tanh(e1s * (1.0f / PEER_SU)) * (1.0f / PEER_SV);
        }
    }
}
DI void peer_v_phase(const FP& P, const Ctx& C, int layer, const float* xin, float* fout, float* fout_s, bf16* xb) {
    const int lane = C.lane; const unsigned char* Vt = P.VB8 + (size_t)layer * PEER_EXPERTS * D_MODEL;
    const float* gam = P.ln_g + ((size_t)layer * 2 + 1) * D_MODEL; const float* bet = P.ln_b + ((size_t)layer * 2 + 1) * D_MODEL;
    const int nrounds = (M0 + C.G * NWAVES - 1) / (C.G * NWAVES);
#pragma unroll 1
    for (int rd = 0; rd <= nrounds; ++rd) {
        const bool smp = (rd == nrounds); int r = smp ? M0 + C.vcu : rd * C.G * NWAVES + C.vcu * NWAVES + C.wave; if (smp ? (C.vcu >= DEC_BATCH) : (r >= M0)) continue;
        const int pb = smp ? 16 * C.wave : 0, pe = smp ? pb + 16 : 128;
        f32x2 x2[8], o2[8];
#pragma unroll
        for (int j = 0; j < 4; ++j) { const f32x4 a = *(const f32x4*)(xin + (size_t)r * D_MODEL + 16 * lane + 4 * j); x2[2 * j] = (f32x2){a.x, a.y}; x2[2 * j + 1] = (f32x2){a.z, a.w}; }
#pragma unroll
        for (int k = 0; k < 8; ++k) o2[k] = (f32x2){0.f, 0.f};
        const int e_l = P.SELE[(size_t)r * 128 + lane], e_h = P.SELE[(size_t)r * 128 + 64 + lane]; const float a_l = P.SCO[(size_t)r * 128 + lane], a_h = P.SCO[(size_t)r * 128 + 64 + lane];
#pragma unroll 1
        for (int b0 = pb; b0 < pe; b0 += 16) { u32x4 vw[16];
#pragma unroll
            for (int k = 0; k < 16; ++k) { const int hk = b0 + k; const int e = (hk < 64) ? __builtin_amdgcn_readlane(e_l, hk & 63) : __builtin_amdgcn_readlane(e_h, hk & 63); vw[k] = *(const u32x4*)(Vt + (size_t)e * D_MODEL + 16 * lane); }
#pragma unroll
            for (int k = 0; k < 16; ++k) { const int hk = b0 + k; axpy16_fp8(vw[k], (hk < 64) ? rdlane(a_l, hk & 63) : rdlane(a_h, hk & 63), o2); } }
        if (smp) {
            LAS float* red = (LAS float*)C.lds;
#pragma unroll
            for (int k = 0; k < 8; ++k) { red[C.wave * 1024 + 16 * lane + 2 * k] = o2[k].x; red[C.wave * 1024 + 16 * lane + 2 * k + 1] = o2[k].y; }
            asm volatile("s_waitcnt lgkmcnt(0)" ::: "memory"); __syncthreads();
            if (C.wave == 0) {
#pragma unroll
                for (int k = 0; k < 8; ++k) { float ax = 0.f, ay = 0.f;
#pragma unroll
                    for (int ww = 0; ww < NWAVES; ++ww) { ax += red[ww * 1024 + 16 * lane + 2 * k]; ay += red[ww * 1024 + 16 * lane + 2 * k + 1]; } o2[k] = (f32x2){ax, ay}; } }
            __syncthreads();
            if (C.wave != 0) continue; }
        float s = 0.f;
#pragma unroll
        for (int k = 0; k < 8; ++k) { o2[k] += x2[k] * ALPHA; s += o2[k].x + o2[k].y; }
        const float mu = wave_sum(s) * (1.0f / D_MODEL); float s2 = 0.f;
#pragma unroll
        for (int k = 0; k < 8; ++k) { o2[k] -= mu; s2 += o2[k].x * o2[k].x + o2[k].y * o2[k].y; }
        const float rs = 1.0f / sqrtf(wave_sum(s2) * (1.0f / D_MODEL) + LN_EPS);
        float* frow = (r < M0) ? fout + (size_t)r * D_MODEL : fout_s + (size_t)(r - M0) * D_MODEL;
#pragma unroll
        for (int j = 0; j < 4; ++j) { const int c0 = 16 * lane + 4 * j; const f32x4 gg = *(const f32x4*)(gam + c0), bb = *(const f32x4*)(bet + c0);
            const f32x4 y = (f32x4){o2[2 * j].x * rs, o2[2 * j].y * rs, o2[2 * j + 1].x * rs, o2[2 * j + 1].y * rs} * gg + bb;
            *(f32x4*)(frow + c0) = y; if (xb) *(u32x2*)(xb + (size_t)r * D_MODEL + c0) = pk4(y); }
    }
}
constexpr int PSH_LIST = 512;
struct PG4 { u32x4 u[4], v[4]; };
DI void peer_sharded_phase(const FP& P, const Ctx& C, int layer, const float* xin, const bf16* xb16, float* fout, float* fout_s, bf16* xb) {
    const int lane = C.lane; const unsigned char* U = P.UB8 + (size_t)layer * PEER_EXPERTS * D_MODEL; const unsigned char* Vt = P.VB8 + (size_t)layer * PEER_EXPERTS * D_MODEL;
    const float* gam = P.ln_g + ((size_t)layer * 2 + 1) * D_MODEL; const float* bet = P.ln_b + ((size_t)layer * 2 + 1) * D_MODEL;
    LAS unsigned char* wl = C.lds + C.wave * 16384; LAS bf16* xs = (LAS bf16*)wl; LAS int* lst = (LAS int*)(wl + 8192);
    const int NW = C.G * NWAVES, gw = C.vcu * NWAVES + C.wave; const int nquads = (M0 / NW) / 4;
#pragma unroll 1
    for (int qd = 0; qd < nquads; ++qd) {
#define PSH_ROW(j) const int row##j = (qd * 4 + j) * NW + gw; const int el##j = P.SELE[(size_t)row##j * 128 + lane], eh##j = P.SELE[(size_t)row##j * 128 + 64 + lane]; const float gl##j = P.SELG[(size_t)row##j * 128 + lane], gh##j = P.SELG[(size_t)row##j * 128 + 64 + lane]; \
        { const u32x4 xa = *(const u32x4*)(xb16 + (size_t)row##j * D_MODEL + 16 * lane), xc = *(const u32x4*)(xb16 + (size_t)row##j * D_MODEL + 16 * lane + 8); *(LAS u32x4*)(xs + j * 1024 + 16 * lane) = xa; *(LAS u32x4*)(xs + j * 1024 + 16 * lane + 8) = xc; } \
        f32x2 oa##j[8]; _Pragma("unroll") for (int k = 0; k < 8; ++k) oa##j[k] = (f32x2){0.f, 0.f};
        PSH_ROW(0) PSH_ROW(1) PSH_ROW(2) PSH_ROW(3)
#pragma unroll 1
        for (int s = 0; s < 16; ++s) {
            int n = 0;
#define PSH_SCAN(j) { unsigned long long b0 = __ballot((el##j >> 10) == s), b1 = __ballot((eh##j >> 10) == s); \
                while (b0) { const int h = __builtin_ctzll(b0); b0 &= b0 - 1; const int e = __builtin_amdgcn_readlane(el##j, h); const int g = __builtin_amdgcn_readlane(__builtin_bit_cast(int, gl##j), h); \
                    if (lane == 0) { lst[4 * n] = e; lst[4 * n + 1] = g; lst[4 * n + 2] = j; } ++n; } \
                while (b1) { const int h = __builtin_ctzll(b1); b1 &= b1 - 1; const int e = __builtin_amdgcn_readlane(eh##j, h); const int g = __builtin_amdgcn_readlane(__builtin_bit_cast(int, gh##j), h); \
                    if (lane == 0) { lst[4 * n] = e; lst[4 * n + 1] = g; lst[4 * n + 2] = j; } ++n; } }
            PSH_SCAN(0) PSH_SCAN(1) PSH_SCAN(2) PSH_SCAN(3)
            asm volatile("s_waitcnt lgkmcnt(0)" ::: "memory");
            if (n == 0) continue;
            const int ngrp = (n + 3) >> 2;
#define PSH_LD(b, gi_) do { const int gi = (gi_); _Pragma("unroll") for (int k = 0; k < 4; ++k) { int i = 4 * gi + k; i = i < n ? i : n - 1; const int e = __builtin_amdgcn_readfirstlane(lst[4 * i]); \
                b.u[k] = *(const u32x4*)(U + (size_t)e * D_MODEL + 16 * lane); b.v[k] = *(const u32x4*)(Vt + (size_t)e * D_MODEL + 16 * lane); } } while (0)
#define PSH_CP(b, gi_) do { const int gi = (gi_); float d[4]; int jj[4]; float gg[4]; \
                _Pragma("unroll") for (int k = 0; k < 4; ++k) { int i = 4 * gi + k; const bool val = i < n; i = val ? i : n - 1; jj[k] = __builtin_amdgcn_readfirstlane(lst[4 * i + 2]); gg[k] = val ? __builtin_bit_cast(float, __builtin_amdgcn_readfirstlane(lst[4 * i + 1])) : 0.f; \
                    const u32x4 xa = *(const LAS u32x4*)(xs + jj[k] * 1024 + 16 * lane), xc = *(const LAS u32x4*)(xs + jj[k] * 1024 + 16 * lane + 8); \
                    const f32x2 x2[8] = {(f32x2){bflo(xa.x), bfhi(xa.x)}, (f32x2){bflo(xa.y), bfhi(xa.y)}, (f32x2){bflo(xa.z), bfhi(xa.z)}, (f32x2){bflo(xa.w), bfhi(xa.w)}, (f32x2){bflo(xc.x), bfhi(xc.x)}, (f32x2){bflo(xc.y), bfhi(xc.y)}, (f32x2){bflo(xc.z), bfhi(xc.z)}, (f32x2){bflo(xc.w), bfhi(xc.w)}}; \
                    d[k] = dot16_fp8(b.u[k], x2); } \
                float e2[2], e1; \
                { const bool hi = lane & 1; _Pragma("unroll") for (int i = 0; i < 2; ++i) { const float keep = hi ? d[2 + i] : d[i], send = hi ? d[i] : d[2 + i]; e2[i] = keep + __shfl_xor(send, 1); } } \
                { const bool hi = lane & 2; const float keep = hi ? e2[1] : e2[0], send = hi ? e2[0] : e2[1]; e1 = keep + __shfl_xor(send, 2); } \
                e1 += __shfl_xor(e1, 4); e1 += __shfl_xor(e1, 8); e1 += __shfl_xor(e1, 16); e1 += __shfl_xor(e1, 32); \
                const int myk = 2 * (lane & 1) + ((lane >> 1) & 1); \
                float myg = gg[0]; myg = (myk == 1) ? gg[1] : myg; myg = (myk == 2) ? gg[2] : myg; myg = (myk == 3) ? gg[3] : myg; \
                const float act = myg * gelu_tanh(e1 * (1.0f / PEER_SU)) * (1.0f / PEER_SV); \
                _Pragma("unroll") for (int k = 0; k < 4; ++k) { const float a = rdlane(act, (k >> 1) | ((k & 1) << 1)); \
                    if (jj[k] == 0) axpy16_fp8(b.v[k], a, oa0); else if (jj[k] == 1) axpy16_fp8(b.v[k], a, oa1); else if (jj[k] == 2) axpy16_fp8(b.v[k], a, oa2); else axpy16_fp8(b.v[k], a, oa3); } } while (0)
            { PG4 A, B; PSH_LD(A, 0);
#pragma unroll 1
              for (int g2 = 0; g2 < ngrp; g2 += 2) { PSH_LD(B, (g2 + 1 < ngrp) ? g2 + 1 : g2); PSH_CP(A, g2); PSH_LD(A, (g2 + 2 < ngrp) ? g2 + 2 : g2); if (g2 + 1 < ngrp) PSH_CP(B, g2 + 1); } }
            asm volatile("s_waitcnt lgkmcnt(0)" ::: "memory");
        }
#define PSH_LN(j) { const int r = row##j; f32x2 x2[8]; \
            _Pragma("unroll") for (int q = 0; q < 4; ++q) { const f32x4 a = *(const f32x4*)(xin + (size_t)r * D_MODEL + 16 * lane + 4 * q); x2[2 * q] = (f32x2){a.x, a.y}; x2[2 * q + 1] = (f32x2){a.z, a.w}; } \
            float sm = 0.f; _Pragma("unroll") for (int k = 0; k < 8; ++k) { oa##j[k] += x2[k] * ALPHA; sm += oa##j[k].x + oa##j[k].y; } \
            const float mu = wave_sum(sm) * (1.0f / D_MODEL); float s2 = 0.f; _Pragma("unroll") for (int k = 0; k < 8; ++k) { oa##j[k] -= mu; s2 += oa##j[k].x * oa##j[k].x + oa##j[k].y * oa##j[k].y; } \
            const float rs = 1.0f / sqrtf(wave_sum(s2) * (1.0f / D_MODEL) + LN_EPS); float* frow = fout + (size_t)r * D_MODEL; \
            _Pragma("unroll") for (int q = 0; q < 4; ++q) { const int c0 = 16 * lane + 4 * q; const f32x4 gv = *(const f32x4*)(gam + c0), bv = *(const f32x4*)(bet + c0); \
                const f32x4 y = (f32x4){oa##j[2 * q].x * rs, oa##j[2 * q].y * rs, oa##j[2 * q + 1].x * rs, oa##j[2 * q + 1].y * rs} * gv + bv; *(f32x4*)(frow + c0) = y; if (xb) *(u32x2*)(xb + (size_t)r * D_MODEL + c0) = pk4(y); } }
        PSH_LN(0) PSH_LN(1) PSH_LN(2) PSH_LN(3)
        asm volatile("s_waitcnt lgkmcnt(0)" ::: "memory");
    }
}
#ifndef PSH_LOG_V
#define PSH_LOG_V 11
#endif
constexpr int PSH_LOG = PSH_LOG_V, PSH_N = PEER_EXPERTS >> PSH_LOG;
#ifndef PS2_ROWS
#define PS2_ROWS 4
#endif
#define PS2_ROW(j) const int row##j = (qd * PS2_ROWS + j) * NW + gw; const int el##j = P.SELE[(size_t)row##j * 128 + lane], eh##j = P.SELE[(size_t)row##j * 128 + 64 + lane]; const float gl##j = P.SELG[(size_t)row##j * 128 + lane], gh##j = P.SELG[(size_t)row##j * 128 + 64 + lane]; \
    f32x2 oa##j[8]; _Pragma("unroll") for (int k = 0; k < 8; ++k) oa##j[k] = (f32x2){0.f, 0.f};
#define PS2_STEP(j) { unsigned long long b0 = __ballot((el##j >> PSH_LOG) == s), b1 = __ballot((eh##j >> PSH_LOG) == s); \
    if (b0 | b1) { const u32x4 xa##j = *(const u32x4*)(xb16 + (size_t)row##j * D_MODEL + 16 * lane), xc##j = *(const u32x4*)(xb16 + (size_t)row##j * D_MODEL + 16 * lane + 8);     \
      const f32x2 x2[8] = {(f32x2){bflo(xa##j.x), bfhi(xa##j.x)}, (f32x2){bflo(xa##j.y), bfhi(xa##j.y)}, (f32x2){bflo(xa##j.z), bfhi(xa##j.z)}, (f32x2){bflo(xa##j.w), bfhi(xa##j.w)}, (f32x2){bflo(xc##j.x), bfhi(xc##j.x)}, (f32x2){bflo(xc##j.y), bfhi(xc##j.y)}, (f32x2){bflo(xc##j.z), bfhi(xc##j.z)}, (f32x2){bflo(xc##j.w), bfhi(xc##j.w)}}; \
      _Pragma("unroll 1") while ((b0 | b1) != 0ull) { int hk[8]; u32x4 uw[8], vw[8]; int nv = 0; \
        _Pragma("unroll") for (int k = 0; k < 8; ++k) { int h; if (b0) { h = __builtin_ctzll(b0); b0 &= b0 - 1; ++nv; } else if (b1) { h = 64 + __builtin_ctzll(b1); b1 &= b1 - 1; ++nv; } else h = hk[k > 0 ? k - 1 : 0]; \
            hk[k] = h; const int e = (h < 64) ? __builtin_amdgcn_readlane(el##j, h & 63) : __builtin_amdgcn_readlane(eh##j, h & 63); \
            uw[k] = *(const u32x4*)(U + (size_t)e * D_MODEL + 16 * lane); vw[k] = *(const u32x4*)(Vt + (size_t)e * D_MODEL + 16 * lane); } \
        float d[8]; _Pragma("unroll") for (int k = 0; k < 8; ++k) d[k] = dot16_fp8(uw[k], x2); \
        float e4[4], e2[2], e1s; \
          \
        { const bool hi = lane & 1; _Pragma("unroll") for (int i = 0; i < 4; ++i) { const float keep = hi ? d[4 + i] : d[i], send = hi ? d[i] : d[4 + i]; e4[i] = keep + dppf<0xB1>(send); } } \
        { const bool hi = lane & 2; _Pragma("unroll") for (int i = 0; i < 2; ++i) { const float keep = hi ? e4[2 + i] : e4[i], send = hi ? e4[i] : e4[2 + i]; e2[i] = keep + dppf<0x4E>(send); } } \
        { const bool hi = lane & 4; const float keep = hi ? e2[1] : e2[0], send = hi ? e2[0] : e2[1]; const float r4 = dppf<0x124>(send), r12 = dppf<0x12C>(send); e1s = keep + (hi ? r4 : r12); } \
        e1s += dppf<0x128>(e1s); e1s = colsum(e1s); \
        const int myk = 4 * (lane & 1) + (lane & 2) + ((lane >> 2) & 1); int myh = hk[0]; _Pragma("unroll") for (int k = 1; k < 8; ++k) myh = (myk == k) ? hk[k] : myh; \
        const float ga = __shfl(gl##j, myh & 63), gb = __shfl(gh##j, myh & 63); const float myg = (myk < nv) ? ((myh < 64) ? ga : gb) : 0.f;     \
        const float act = myg * gelu_tanh(e1s * (1.0f / PEER_SU)) * (1.0f / PEER_SV); \
        _Pragma("unroll") for (int k = 0; k < 8; ++k) { const int src = (k >> 2) | (((k >> 1) & 1) << 1) | ((k & 1) << 2); axpy16_fp8(vw[k], rdlane(act, src), oa##j); } } } }
#define PS2_LN(j) { const int r = row##j; f32x2 x2[8]; int ll = lane; asm volatile("" : "+v"(ll));     \
    _Pragma("unroll") for (int q = 0; q < 4; ++q) { const f32x4 a = *(const f32x4*)(xin + (size_t)r * D_MODEL + 16 * ll + 4 * q); x2[2 * q] = (f32x2){a.x, a.y}; x2[2 * q + 1] = (f32x2){a.z, a.w}; } \
    float sm = 0.f; _Pragma("unroll") for (int k = 0; k < 8; ++k) { oa##j[k] += x2[k] * ALPHA; sm += oa##j[k].x + oa##j[k].y; } \
    const float mu = wave_sum(sm) * (1.0f / D_MODEL); float s2 = 0.f; _Pragma("unroll") for (int k = 0; k < 8; ++k) { oa##j[k] -= mu; s2 += oa##j[k].x * oa##j[k].x + oa##j[k].y * oa##j[k].y; } \
    const float rs = 1.0f / sqrtf(wave_sum(s2) * (1.0f / D_MODEL) + LN_EPS); float* frow = fout + (size_t)r * D_MODEL; \
    _Pragma("unroll") for (int q = 0; q < 4; ++q) { const int c0 = 16 * ll + 4 * q; const f32x4 gv = *(const f32x4*)(gam + c0), bv = *(const f32x4*)(bet + c0); \
        const f32x4 y = (f32x4){oa##j[2 * q].x * rs, oa##j[2 * q].y * rs, oa##j[2 * q + 1].x * rs, oa##j[2 * q + 1].y * rs} * gv + bv; *(f32x4*)(frow + c0) = y; if (xb) *(u32x2*)(xb + (size_t)r * D_MODEL + c0) = pk4(y); } }
DI void xcd_soft_sync(unsigned* cnt, volatile LAS unsigned* st, unsigned x, unsigned& round) {
    if (!st) return;
    __syncthreads();
    if (threadIdx.x == 0) { const unsigned nloc = st[0];
        if (nloc) { unsigned* c = cnt + 64 * x; (void)xb_add(c, 1u); const unsigned target = (round + 1u) * nloc; unsigned sp = 0;
            while (xb_ld(c) < target && ++sp < 4096u) __builtin_amdgcn_s_sleep(1); } }
    __syncthreads(); ++round;
}
DI void peer_sharded2_phase(const FP& P, const Ctx& C, int layer, const float* xin, const bf16* xb16, float* fout, bf16* xb, volatile LAS unsigned* st = nullptr, unsigned xcc = 0) {
    unsigned round = 0; unsigned* hint = P.ctl + 8192 + layer * 1024;
    const int lane = C.lane; const unsigned char* U = P.UB8 + (size_t)layer * PEER_EXPERTS * D_MODEL; const unsigned char* Vt = P.VB8 + (size_t)layer * PEER_EXPERTS * D_MODEL;
    const float* gam = P.ln_g + ((size_t)layer * 2 + 1) * D_MODEL; const float* bet = P.ln_b + ((size_t)layer * 2 + 1) * D_MODEL;
    const int NW = C.G * NWAVES, gw = C.vcu * NWAVES + C.wave; const int nquads = (M0 / NW) / PS2_ROWS;
#pragma unroll 1
    for (int qd = 0; qd < nquads; ++qd) {
#if PS2_ROWS == 4
        PS2_ROW(0) PS2_ROW(1) PS2_ROW(2) PS2_ROW(3)
#pragma unroll 1
        for (int s = 0; s < PSH_N; ++s) {
#ifdef PEER_SOFTSYNC
            xcd_soft_sync(hint, st, xcc, round);
#endif
            PS2_STEP(0) PS2_STEP(1) PS2_STEP(2) PS2_STEP(3) }
        PS2_LN(0) PS2_LN(1) PS2_LN(2) PS2_LN(3)
#else
        PS2_ROW(0) PS2_ROW(1)
#pragma unroll 1
        for (int s = 0; s < PSH_N; ++s) { PS2_STEP(0) PS2_STEP(1) }
        PS2_LN(0) PS2_LN(1)
#endif
    }
}
#define PS3_ROW(j) const int row##j = (qd * 4 + j) * NW + gw; const int el##j = P.SELE[(size_t)row##j * 128 + lane], eh##j = P.SELE[(size_t)row##j * 128 + 64 + lane]; \
    { const u32x4 xa = *(const u32x4*)(xb16 + (size_t)row##j * D_MODEL + 16 * lane), xc = *(const u32x4*)(xb16 + (size_t)row##j * D_MODEL + 16 * lane + 8); *(LAS u32x4*)(xs + j * 1024 + 16 * lane) = xa; *(LAS u32x4*)(xs + j * 1024 + 16 * lane + 8) = xc; } \
    f32x2 oa##j[8]; _Pragma("unroll") for (int k = 0; k < 8; ++k) oa##j[k] = (f32x2){0.f, 0.f};
#define PS3_X2_UNUSED(j) const f32x2 x2[8] = {(f32x2){bflo(xa##j.x), bfhi(xa##j.x)}, (f32x2){bflo(xa##j.y), bfhi(xa##j.y)}, (f32x2){bflo(xa##j.z), bfhi(xa##j.z)}, (f32x2){bflo(xa##j.w), bfhi(xa##j.w)}, (f32x2){bflo(xc##j.x), bfhi(xc##j.x)}, (f32x2){bflo(xc##j.y), bfhi(xc##j.y)}, (f32x2){bflo(xc##j.z), bfhi(xc##j.z)}, (f32x2){bflo(xc##j.w), bfhi(xc##j.w)}};
#define PS3_TAKE(q, M, ELH, GOFF) if (!got && M) { const int h = __builtin_ctzll(M); M &= M - 1; qq[k] = q; ee = __builtin_amdgcn_readlane(ELH, h); gk[k] = P.SELG[GOFF + h];     got = true; ++nv; }
DI void peer_sharded3_phase(const FP& P, const Ctx& C, int layer, const float* xin, const bf16* xb16, float* fout, bf16* xb) {
    const int lane = C.lane; const unsigned char* U = P.UB8 + (size_t)layer * PEER_EXPERTS * D_MODEL; const unsigned char* Vt = P.VB8 + (size_t)layer * PEER_EXPERTS * D_MODEL;
    const float* gam = P.ln_g + ((size_t)layer * 2 + 1) * D_MODEL; const float* bet = P.ln_b + ((size_t)layer * 2 + 1) * D_MODEL;
    const int NW = C.G * NWAVES, gw = C.vcu * NWAVES + C.wave; const int nquads = (M0 / NW) / 4; LAS bf16* xs = (LAS bf16*)(C.lds + C.wave * 16384);
#pragma unroll 1
    for (int qd = 0; qd < nquads; ++qd) {
        PS3_ROW(0) PS3_ROW(1) PS3_ROW(2) PS3_ROW(3)
        asm volatile("s_waitcnt lgkmcnt(0)" ::: "memory");
#pragma unroll 1
        for (int s = 0; s < PSH_N; ++s) {
            unsigned long long m0 = __ballot((el0 >> PSH_LOG) == s), m1 = __ballot((eh0 >> PSH_LOG) == s), m2 = __ballot((el1 >> PSH_LOG) == s), m3 = __ballot((eh1 >> PSH_LOG) == s),
                               m4 = __ballot((el2 >> PSH_LOG) == s), m5 = __ballot((eh2 >> PSH_LOG) == s), m6 = __ballot((el3 >> PSH_LOG) == s), m7 = __ballot((eh3 >> PSH_LOG) == s);
#pragma unroll 1
            while ((m0 | m1 | m2 | m3 | m4 | m5 | m6 | m7) != 0ull) {
                int qq[8]; float gk[8]; int es[8]; u32x4 uw[8]; int nv = 0; int elast = 0;
#pragma unroll
                for (int k = 0; k < 8; ++k) { bool got = false; int ee = elast; qq[k] = k > 0 ? qq[k - 1] : 0; gk[k] = 0.f;
                    PS3_TAKE(0, m0, el0, (size_t)row0 * 128) PS3_TAKE(1, m1, eh0, (size_t)row0 * 128 + 64) PS3_TAKE(2, m2, el1, (size_t)row1 * 128) PS3_TAKE(3, m3, eh1, (size_t)row1 * 128 + 64) PS3_TAKE(4, m4, el2, (size_t)row2 * 128) PS3_TAKE(5, m5, eh2, (size_t)row2 * 128 + 64) PS3_TAKE(6, m6, el3, (size_t)row3 * 128) PS3_TAKE(7, m7, eh3, (size_t)row3 * 128 + 64)
                    elast = ee; es[k] = ee; uw[k] = *(const u32x4*)(U + (size_t)ee * D_MODEL + 16 * lane); }
                float d[8];
#pragma unroll
                for (int k = 0; k < 8; ++k) { const int j = qq[k] >> 1; const u32x4 xa = *(const LAS u32x4*)(xs + j * 1024 + 16 * lane), xc = *(const LAS u32x4*)(xs + j * 1024 + 16 * lane + 8);
                    const f32x2 x2[8] = {(f32x2){bflo(xa.x), bfhi(xa.x)}, (f32x2){bflo(xa.y), bfhi(xa.y)}, (f32x2){bflo(xa.z), bfhi(xa.z)}, (f32x2){bflo(xa.w), bfhi(xa.w)}, (f32x2){bflo(xc.x), bfhi(xc.x)}, (f32x2){bflo(xc.y), bfhi(xc.y)}, (f32x2){bflo(xc.z), bfhi(xc.z)}, (f32x2){bflo(xc.w), bfhi(xc.w)}};
                    d[k] = dot16_fp8(uw[k], x2); }
                u32x4 vw[8];
#pragma unroll
                for (int k = 0; k < 8; ++k) vw[k] = *(const u32x4*)(Vt + (size_t)es[k] * D_MODEL + 16 * lane);
                float e4[4], e2[2], e1s;
                { const bool hi = lane & 1;
#pragma unroll
                  for (int i = 0; i < 4; ++i) { const float keep = hi ? d[4 + i] : d[i], send = hi ? d[i] : d[4 + i]; e4[i] = keep + __shfl_xor(send, 1); } }
                { const bool hi = lane & 2;
#pragma unroll
                  for (int i = 0; i < 2; ++i) { const float keep = hi ? e4[2 + i] : e4[i], send = hi ? e4[i] : e4[2 + i]; e2[i] = keep + __shfl_xor(send, 2); } }
                { const bool hi = lane & 4; const float keep = hi ? e2[1] : e2[0], send = hi ? e2[0] : e2[1]; e1s = keep + __shfl_xor(send, 4); }
                e1s += __shfl_xor(e1s, 8); e1s += __shfl_xor(e1s, 16); e1s += __shfl_xor(e1s, 32);
                const int myk = 4 * (lane & 1) + (lane & 2) + ((lane >> 2) & 1); float myg = gk[0];
#pragma unroll
                for (int k = 1; k < 8; ++k) myg = (myk == k) ? gk[k] : myg;
                const float act = myg * gelu_tanh(e1s * (1.0f / PEER_SU)) * (1.0f / PEER_SV);
#pragma unroll
                for (int k = 0; k < 8; ++k) { const int src = (k >> 2) | (((k >> 1) & 1) << 1) | ((k & 1) << 2); const float a = rdlane(act, src); const int j = qq[k] >> 1;
                    if (j == 0) { asm volatile("" ::: "memory"); axpy16_fp8(vw[k], a, oa0); } else if (j == 1) { asm volatile("" ::: "memory"); axpy16_fp8(vw[k], a, oa1); } else if (j == 2) { asm volatile("" ::: "memory"); axpy16_fp8(vw[k], a, oa2); } else { asm volatile("" ::: "memory"); axpy16_fp8(vw[k], a, oa3); } }
            }
        }
        PS2_LN(0) PS2_LN(1) PS2_LN(2) PS2_LN(3)
    }
}
}
namespace fx {
struct EpiB {
    static constexpr bool PERM = true, AFTER_DRAIN = false; const FP& P;
    DI void operator()(const f32x4 (&acc)[2][2][4][2], const pg8::Unit& u, int wr, int wc, int fr, int fq) const {
        const int t = u.pn;
        EPI_LOOP({ if (row < MP) { const int pos = row_pos(row), n = row / SEQ, e = ct & 63, dp = e >> 1; const bool prm = row < M0;
            if (t < 3) { const int ty = 2 * t + (ct >> 7), kvh = (ct >> 6) & 1;
                if (ty == 2 || ty == 4) { f32x4 lo, hi; rope4(P.ROPE + pos * 64, dp, v0, v1, lo, hi);
                    if (ty == 2) { float* o = (prm ? P.nsa_kv_p + (size_t)row * 512 : P.nsa_kv_s + (size_t)(row - M0) * 512) + 256 + kvh * 64 + dp; *(f32x4*)o = lo; *(f32x4*)(o + 32) = hi;
                        if (prm) { bf16* kt = P.SLK + ((size_t)n * NSA_KV_HEADS + kvh) * SEQ * 64; *(u32x2*)(kt + ktile_off(pos, dp)) = pk4(lo); *(u32x2*)(kt + ktile_off(pos, dp + 32)) = pk4(hi); } }
                    else { float* o = nullptr; if (!prm) o = P.win_s + (((size_t)(row - M0) * SWA_WINDOW + SWA_WINDOW - 1) * 2 + 0) * 128; else if (pos >= SEQ - SWA_WINDOW) o = P.win_p + (((size_t)n * SWA_WINDOW + pos - (SEQ - SWA_WINDOW)) * 2 + 0) * 128;
                        if (o) { *(f32x4*)(o + kvh * 64 + dp) = lo; *(f32x4*)(o + kvh * 64 + 32 + dp) = hi; }
                        if (prm) { bf16* kt = P.WNK + ((size_t)n * NSA_KV_HEADS + kvh) * SEQ * 64; *(u32x2*)(kt + ktile_off(pos, dp)) = pk4(lo); *(u32x2*)(kt + ktile_off(pos, dp + 32)) = pk4(hi); } } }
                else if (ty < 4) { float* o = (prm ? P.nsa_kv_p + (size_t)row * 512 : P.nsa_kv_s + (size_t)(row - M0) * 512) + ty * 128 + kvh * 64 + e; *(f32x4*)o = v0; *(f32x4*)(o + 4) = v1;
                    if (prm) { if (ty < 2) *(u32x4*)(P.AC + ((size_t)ty * ACROWS + ((size_t)n * NSA_KV_HEADS + kvh) * NCH + pos / 16) * 1024 + (pos % 16) * 64 + e) = pk8(v0, v1);
                        else { bf16* vt = P.SLVT + ((size_t)n * NSA_KV_HEADS + kvh) * SEQ * 64 + vtile_off(e, pos);
                            vt[0] = (bf16)f2bf(v0.x); vt[8] = (bf16)f2bf(v0.y); vt[16] = (bf16)f2bf(v0.z); vt[24] = (bf16)f2bf(v0.w); vt[32] = (bf16)f2bf(v1.x); vt[40] = (bf16)f2bf(v1.y); vt[48] = (bf16)f2bf(v1.z); vt[56] = (bf16)f2bf(v1.w); } } }
                else { float* o = nullptr; if (!prm) o = P.win_s + (((size_t)(row - M0) * SWA_WINDOW + SWA_WINDOW - 1) * 2 + 1) * 128; else if (pos >= SEQ - SWA_WINDOW) o = P.win_p + (((size_t)n * SWA_WINDOW + pos - (SEQ - SWA_WINDOW)) * 2 + 1) * 128;
                    if (o) { *(f32x4*)(o + kvh * 64 + e) = v0; *(f32x4*)(o + kvh * 64 + e + 4) = v1; }
                    if (prm) { bf16* vt = P.WNVT + ((size_t)n * NSA_KV_HEADS + kvh) * SEQ * 64 + vtile_off(e, pos);
                        vt[0] = (bf16)f2bf(v0.x); vt[8] = (bf16)f2bf(v0.y); vt[16] = (bf16)f2bf(v0.z); vt[24] = (bf16)f2bf(v0.w); vt[32] = (bf16)f2bf(v1.x); vt[40] = (bf16)f2bf(v1.y); vt[48] = (bf16)f2bf(v1.z); vt[56] = (bf16)f2bf(v1.w); } } }
            else if (t < 6) { const int h = (t - 3) * 4 + (ct >> 6); f32x4 lo, hi; rope4(P.ROPE + pos * 64, dp, v0, v1, lo, hi); bf16* q = P.QB + (size_t)row * NSA_Q_COLS + h * 64 + dp; *(u32x2*)q = pk4(lo * QSCALE); *(u32x2*)(q + 32) = pk4(hi * QSCALE); }
            else if (t == 6) { *(u32x4*)(P.MQB + (size_t)row * 256 + ct) = pk8(v0 * QSCALE, v1 * QSCALE); }
            else if (ct < 40) { const float vv[8] = {v0.x, v0.y, v0.z, v0.w, v1.x, v1.y, v1.z, v1.w};
                _Pragma("unroll") for (int i = 0; i < 8; ++i) if (ct + i < NSA_GATE_COLS) P.GATES[(size_t)row * 64 + ct + i] = 1.0f / (1.0f + __expf(-vv[i])); } } })
    }
};
DI void cmp2_phase(const FP& P, const Ctx& C) {
    const int lane = C.lane; LAS float* hs = (LAS float*)(C.lds + C.wave * 1024);
    constexpr int NGRP = NCTX * 2 * NSA_KV_HEADS; const int NW = C.G * NWAVES, WPG = NW / NGRP > 0 ? NW / NGRP : 1; const int gw = C.vcu * NWAVES + C.wave;
#pragma unroll 1
    for (int grp = gw / WPG; grp < NGRP; grp += (NW + WPG - 1) / WPG) { const int slot = gw % WPG; if (gw >= (NW / WPG) * WPG && grp == gw / WPG) break;
        const int kvh = grp % NSA_KV_HEADS, ty = (grp / NSA_KV_HEADS) % 2, ctx = grp / (2 * NSA_KV_HEADS);
        const float* UL = P.UL + ((size_t)ty * ACROWS + ((size_t)ctx * NSA_KV_HEADS + kvh) * NCH) * 256; const float* w2 = P.cmp_w2 + (size_t)ty * CMP_HIDDEN * HEAD_DIM;
        float w2r[CMP_HIDDEN];
#pragma unroll
        for (int k = 0; k < CMP_HIDDEN; ++k) w2r[k] = w2[k * HEAD_DIM + lane];
        const float b0 = P.CBIAS[ty * CMP_HIDDEN + lane], b1 = P.CBIAS[ty * CMP_HIDDEN + 64 + lane];
        float u0, u1, l0, l1; int c = slot;
        if (c < NCMP) { u0 = UL[(size_t)c * 256 + lane]; u1 = UL[(size_t)c * 256 + 64 + lane]; l0 = UL[(size_t)(c + 1) * 256 + 128 + lane]; l1 = UL[(size_t)(c + 1) * 256 + 192 + lane]; }
#pragma unroll 1
        for (; c < NCMP; c += WPG) { const float h0 = gelu_tanh(u0 + l0 + b0), h1 = gelu_tanh(u1 + l1 + b1); const int cn = c + WPG;
            if (cn < NCMP) { u0 = UL[(size_t)cn * 256 + lane]; u1 = UL[(size_t)cn * 256 + 64 + lane]; l0 = UL[(size_t)(cn + 1) * 256 + 128 + lane]; l1 = UL[(size_t)(cn + 1) * 256 + 192 + lane]; }
            hs[lane] = h0; hs[64 + lane] = h1; asm volatile("s_waitcnt lgkmcnt(0)" ::: "memory");
            float a = 0.f;
#pragma unroll
            for (int k4 = 0; k4 < CMP_HIDDEN / 4; ++k4) { const f32x4 hv = *(const LAS f32x4*)(hs + 4 * k4); a += hv.x * w2r[4 * k4] + hv.y * w2r[4 * k4 + 1] + hv.z * w2r[4 * k4 + 2] + hv.w * w2r[4 * k4 + 3]; }
            if (ty == 0) { const float other = __shfl_xor(a, 32); const int pos = c * CMP_STRIDE + CMP_BLOCK - 1; const float cs = P.ROPE[pos * 64 + (lane & 31)], sn = P.ROPE[pos * 64 + 32 + (lane & 31)];
                a = (lane < 32) ? a * cs - other * sn : a * cs + other * sn; }
            if (ctx < BATCH) { if (ty == 0) P.CK[((size_t)ctx * NSA_KV_HEADS + kvh) * NCH * 64 + ktile_off(c, lane)] = (bf16)f2bf(a); else P.CVT[((size_t)ctx * NSA_KV_HEADS + kvh) * NCH * 64 + vtile_off(lane, c)] = (bf16)f2bf(a); }
            else { (ty == 0 ? P.CKF : P.CVF)[(((size_t)(ctx - BATCH) * NSA_KV_HEADS + kvh) * NCH + c) * 64 + lane] = a; }
            asm volatile("s_waitcnt lgkmcnt(0)" ::: "memory"); }
    }
    __syncthreads();
}
constexpr int NSA_WLDS = 8192;
DI void nsa_pair_a(const FP& P, int n, int kvh, int t, int lane, LAS unsigned char* wl) {
    LAS float* pn = (LAS float*)wl; LAS float* imp = (LAS float*)(wl + 2048); LAS float* sc = (LAS float*)(wl + 6144); LAS int* sel = (LAS int*)(wl + 7168);
    const int col = lane & 15, c = lane >> 4; const bool vcol = col < 12; const int qq = vcol ? col / 6 : 0, hh = vcol ? col % 6 : 0, tq = t + qq, head = kvh * NSA_GROUP + hh, row = n * SEQ + tq;
    bf16x8 qf[2]; { const bf16* qp = P.QB + (size_t)row * NSA_Q_COLS + head * 64 + 8 * c; qf[0] = *(const bf16x8*)qp; qf[1] = *(const bf16x8*)(qp + 32); }
    const float* gt = P.GATES + (size_t)row * 64 + head * 3;
    f32x4 oacc[4] = {(f32x4){0.f, 0.f, 0.f, 0.f}, (f32x4){0.f, 0.f, 0.f, 0.f}, (f32x4){0.f, 0.f, 0.f, 0.f}, (f32x4){0.f, 0.f, 0.f, 0.f}};
    const int lim = vcol ? ((tq >= CMP_BLOCK - 1) ? (tq - (CMP_BLOCK - 1)) / CMP_STRIDE : -1) : -1;
    const int limmax = (t + 1 >= CMP_BLOCK - 1) ? (t + 1 - (CMP_BLOCK - 1)) / CMP_STRIDE : -1; const int nblk = (limmax + 32) / 32;
    const bf16* CKb = P.CK + ((size_t)n * NSA_KV_HEADS + kvh) * NCH * 64; const bf16* CVb = P.CVT + ((size_t)n * NSA_KV_HEADS + kvh) * 64 * NCH;
    for (int i = lane; i < 1024; i += 64) imp[i] = 0.f;
    float m1 = -INFINITY, l1 = 0.f;
    { struct K4 { bf16x8 a0, a1, b0, b1; };
      auto ldk = [&](K4& k, int blk) { const bf16* kt = CKb + (size_t)blk * 2048 + lane * 8; k.a0 = *(const bf16x8*)kt; k.a1 = *(const bf16x8*)(kt + 512); k.b0 = *(const bf16x8*)(kt + 1024); k.b1 = *(const bf16x8*)(kt + 1536); };
      auto cp1 = [&](const K4& k, int blk) { const int kb = 32 * blk;
        f32x4 s0 = (f32x4){0.f, 0.f, 0.f, 0.f}, s1 = (f32x4){0.f, 0.f, 0.f, 0.f};
        s0 = __builtin_amdgcn_mfma_f32_16x16x32_bf16(k.a0, qf[0], s0, 0, 0, 0); s0 = __builtin_amdgcn_mfma_f32_16x16x32_bf16(k.a1, qf[1], s0, 0, 0, 0);
        s1 = __builtin_amdgcn_mfma_f32_16x16x32_bf16(k.b0, qf[0], s1, 0, 0, 0); s1 = __builtin_amdgcn_mfma_f32_16x16x32_bf16(k.b1, qf[1], s1, 0, 0, 0);
        float s[8] = {s0.x, s0.y, s0.z, s0.w, s1.x, s1.y, s1.z, s1.w}; float mx = -INFINITY;
        const int hi1 = lim - (kb + 8 * c);
#pragma unroll
        for (int e = 0; e < 8; ++e) { s[e] = (e <= hi1) ? s[e] : -INFINITY; mx = fmaxf(mx, s[e]); }
        mx = colmax(mx);
        const float mnew = fmaxf(m1, mx), muse = (mnew == -INFINITY) ? 0.f : mnew; float ls = 0.f;
#pragma unroll
        for (int e = 0; e < 8; ++e) ls += __builtin_amdgcn_exp2f(s[e] - muse);
        l1 = l1 * __builtin_amdgcn_exp2f(m1 - muse) + ls; m1 = mnew; };
      if (nblk > 0) { K4 A, B; ldk(A, 0);
#pragma unroll 1
        for (int blk = 0; blk < nblk; blk += 2) { ldk(B, (blk + 1 < nblk) ? blk + 1 : blk); cp1(A, blk); ldk(A, (blk + 2 < nblk) ? blk + 2 : blk); if (blk + 1 < nblk) cp1(B, blk + 1); } } }
    asm volatile("s_waitcnt lgkmcnt(0)" ::: "memory");
    { l1 = colsum(l1); const float muse = (m1 == -INFINITY) ? 0.f : m1, inv = (l1 > 0.f) ? 1.0f / l1 : 0.f;
      f32x4 oc[4] = {(f32x4){0.f, 0.f, 0.f, 0.f}, (f32x4){0.f, 0.f, 0.f, 0.f}, (f32x4){0.f, 0.f, 0.f, 0.f}, (f32x4){0.f, 0.f, 0.f, 0.f}};
      pipe2(nblk, [&](KV8& kv, int blk) { kv_load_t(kv, CKb + (size_t)blk * 2048, CVb + (size_t)blk * 2048, lane); }, [&](const KV8& kv, int blk) { const int kb = 32 * blk;
        f32x4 s0 = (f32x4){0.f, 0.f, 0.f, 0.f}, s1 = (f32x4){0.f, 0.f, 0.f, 0.f};
        s0 = __builtin_amdgcn_mfma_f32_16x16x32_bf16(kv.ka0, qf[0], s0, 0, 0, 0); s0 = __builtin_amdgcn_mfma_f32_16x16x32_bf16(kv.ka1, qf[1], s0, 0, 0, 0);
        s1 = __builtin_amdgcn_mfma_f32_16x16x32_bf16(kv.kb0, qf[0], s1, 0, 0, 0); s1 = __builtin_amdgcn_mfma_f32_16x16x32_bf16(kv.kb1, qf[1], s1, 0, 0, 0);
        float s[8] = {s0.x, s0.y, s0.z, s0.w, s1.x, s1.y, s1.z, s1.w};
        const int hi2 = lim - (kb + 8 * c);
#pragma unroll
        for (int e = 0; e < 8; ++e) s[e] = (e <= hi2) ? __builtin_amdgcn_exp2f(s[e] - muse) * inv : 0.f;
        *(f32x4*)(pn + col * 32 + 8 * c) = (f32x4){s[0], s[1], s[2], s[3]}; *(f32x4*)(pn + col * 32 + 8 * c + 4) = (f32x4){s[4], s[5], s[6], s[7]};
        u32x4 pw; pw.x = cvtpk(s[0], s[1]); pw.y = cvtpk(s[2], s[3]); pw.z = cvtpk(s[4], s[5]); pw.w = cvtpk(s[6], s[7]); const bf16x8 pf = __builtin_bit_cast(bf16x8, pw);
        oc[0] = __builtin_amdgcn_mfma_f32_16x16x32_bf16(kv.v0, pf, oc[0], 0, 0, 0); oc[1] = __builtin_amdgcn_mfma_f32_16x16x32_bf16(kv.v1, pf, oc[1], 0, 0, 0);
        oc[2] = __builtin_amdgcn_mfma_f32_16x16x32_bf16(kv.v2, pf, oc[2], 0, 0, 0); oc[3] = __builtin_amdgcn_mfma_f32_16x16x32_bf16(kv.v3, pf, oc[3], 0, 0, 0);
        asm volatile("s_waitcnt lgkmcnt(0)" ::: "memory");
        { const int q2 = lane >> 5, k = lane & 31; float a = 0.f;
#pragma unroll
          for (int h6 = 0; h6 < 6; ++h6) a += pn[(q2 * 6 + h6) * 32 + k];
          imp[q2 * 512 + kb + k] = a; }
        asm volatile("s_waitcnt lgkmcnt(0)" ::: "memory"); });
#ifdef NSA_DEBUG
      if (vcol) { for (int db = 0; db < 4; ++db) *(f32x4*)(P.DBG + ((size_t)0 * MP + row) * 768 + head * 64 + 16 * db + 4 * c) = oc[db]; }
#endif
      const float g0 = vcol ? gt[0] : 0.f;
#pragma unroll
      for (int db = 0; db < 4; ++db) oacc[db] += oc[db] * g0; }
#ifndef REP_SEL
#define REP_SEL 1
#endif
#pragma unroll 1
    for (int rep = 0; rep < REP_SEL; ++rep) {
    for (int i = lane; i < 256; i += 64) { const int q2 = i >> 7, b = i & 127, tq2 = t + q2, cur = tq2 / SLC_BLOCK; float sv;
        if (b > cur) sv = NEG; else if (b == 0 || b == cur || b == cur - 1) sv = FORCE_SCORE;
        else { const LAS float* ic = imp + q2 * 512 + 4 * b; sv = ic[-1] + 2.f * (ic[0] + ic[1] + ic[2]) + ic[3]; }
        sc[i] = pack_key(sv, 127u - (unsigned)b, 127u); }
    asm volatile("s_waitcnt lgkmcnt(0)" ::: "memory");
    for (int i = lane; i < 256; i += 64) { const int q2 = i >> 7, b = i & 127; const float sv = sc[i]; int rank = 0;
        for (int j = 0; j < 128; j += 4) { const f32x4 o = *(const LAS f32x4*)(sc + q2 * 128 + j);
            rank += (o.x > sv) ? 1 : 0; rank += (o.y > sv) ? 1 : 0; rank += (o.z > sv) ? 1 : 0; rank += (o.w > sv) ? 1 : 0; }
        if (rank < SLC_TOPK) { const int v = (sv > 0.5f * NEG) ? b : -1; sel[q2 * 16 + rank] = v; P.SELB[((size_t)(n * SEQ + t + q2) * NSA_KV_HEADS + kvh) * 16 + rank] = v; } }
    asm volatile("s_waitcnt lgkmcnt(0)" ::: "memory");
    }
#ifndef REP_WIN
#define REP_WIN 1
#endif
#pragma unroll 1
    for (int rep = 0; rep < REP_WIN; ++rep) { Tile16 T; tile_init(T);
      const bf16* WKb = P.WNK + ((size_t)n * NSA_KV_HEADS + kvh) * SEQ * 64; const bf16* WVb = P.WNVT + ((size_t)n * NSA_KV_HEADS + kvh) * 64 * SEQ;
      const int blo = (t - SWA_WINDOW) >> 5, bhi = (t + 1) >> 5;
      auto ld = [&](KV8& kv, int blk) { const int bc = blk < 0 ? 0 : blk; kv_load_t(kv, WKb + (size_t)bc * 2048, WVb + (size_t)bc * 2048, lane); };
      pipe2(bhi - blo + 1, [&](KV8& kv, int i) { ld(kv, blo + i); }, [&](const KV8& kv, int i) { const int kb = 32 * (blo + i);
          const int k0 = kb + 8 * c; int lo; unsigned rng; const int a = tq - SWA_WINDOW; mk_range((a > 0 ? a : 0) - k0, tq - k0, vcol, lo, rng); tile_compute(T, qf, kv, lo, rng); });
      T.l = colsum(T.l);
      const float inv = (T.l > 0.f) ? 1.0f / T.l : 0.f, g2 = vcol ? gt[2] * inv : 0.f;
#ifdef NSA_DEBUG
      if (vcol) { for (int db = 0; db < 4; ++db) *(f32x4*)(P.DBG + ((size_t)2 * MP + row) * 768 + head * 64 + 16 * db + 4 * c) = T.o[db] * inv; }
#endif
#pragma unroll
      for (int db = 0; db < 4; ++db) if (rep == REP_WIN - 1) oacc[db] += T.o[db] * g2; }
    if (vcol) { float* op = P.DPART + (size_t)row * 768 + head * 64 + 4 * c;
#pragma unroll
        for (int db = 0; db < 4; ++db) *(f32x4*)(op + 16 * db) = oacc[db]; }
}
DI void nsa_pair_b(const FP& P, int n, int kvh, int t, int lane, LAS unsigned char* wl) {
    LAS int* steps = (LAS int*)wl;
    const int col = lane & 15, c = lane >> 4; const bool vcol = col < 12; const int qq = vcol ? col / 6 : 0, hh = vcol ? col % 6 : 0, tq = t + qq, head = kvh * NSA_GROUP + hh, row = n * SEQ + tq;
    bf16x8 qf[2]; { const bf16* qp = P.QB + (size_t)row * NSA_Q_COLS + head * 64 + 8 * c; qf[0] = *(const bf16x8*)qp; qf[1] = *(const bf16x8*)(qp + 32); }
    const float* gt = P.GATES + (size_t)row * 64 + head * 3;
    Tile16 T; tile_init(T);
    const bf16* SKb = P.SLK + ((size_t)n * NSA_KV_HEADS + kvh) * SEQ * 64; const bf16* SVb = P.SLVT + ((size_t)n * NSA_KV_HEADS + kvh) * SEQ * 64;
    int ns = 0;
    { const int mysel = (lane < 32) ? P.SELB[((size_t)(n * SEQ + t + (lane >> 4)) * NSA_KV_HEADS + kvh) * 16 + (lane & 15)] : -1;
      for (int i = 0; i < 32; ++i) { const int b = __builtin_amdgcn_readlane(mysel, i); if (b < 0) continue; int q2 = i >> 4;
          const unsigned long long other = __ballot(mysel == b && lane < 32 && (lane >> 4) != q2);
          if (other) { if (q2 == 1) continue; q2 = 2; }
          if (lane == 0) { steps[ns] = (b * SLC_BLOCK) | (q2 << 29); steps[ns + 1] = (b * SLC_BLOCK + 32) | (q2 << 29); } ns += 2; } }
    asm volatile("s_waitcnt lgkmcnt(0)" ::: "memory");
    auto ld = [&](KV8& kv, int i) { const int code = __builtin_amdgcn_readfirstlane(steps[i]); const int kb = code & 0x1fffffff;
        kv_load_t(kv, SKb + (size_t)(kb >> 5) * 2048, SVb + (size_t)(kb >> 5) * 2048, lane); };
#ifdef PROBE_DBLCOMP
    Tile16 T2; tile_init(T2);
#endif
    pipe2(ns, ld, [&](const KV8& kv, int i) { const int code = __builtin_amdgcn_readfirstlane(steps[i]); const int kb = code & 0x1fffffff, q2 = code >> 29;
        int lo; unsigned rng; mk_range(-64, tq - (kb + 8 * c), vcol && (q2 == 2 || qq == q2), lo, rng); tile_compute(T, qf, kv, lo, rng);
#ifdef PROBE_DBLCOMP
        tile_compute(T2, qf, kv, [&](int e) { return vcol && qq == q2 && (kb + 8 * c + e + 1) <= tq; });
#endif
    });
#ifdef PROBE_DBLCOMP
    if (T2.l < 0.f) T.l = 0.f;
#endif
    T.l = colsum(T.l);
    const float inv = (T.l > 0.f) ? 1.0f / T.l : 0.f, g1 = vcol ? gt[1] * inv : 0.f;
#ifdef NSA_DEBUG
    if (vcol) { for (int db = 0; db < 4; ++db) *(f32x4*)(P.DBG + ((size_t)1 * MP + row) * 768 + head * 64 + 16 * db + 4 * c) = T.o[db] * inv; }
#endif
    if (vcol) { const float* pp = P.DPART + (size_t)row * 768 + head * 64 + 4 * c; bf16* op = P.ATTB + (size_t)row * 1024 + head * 64 + 4 * c;
#pragma unroll
        for (int db = 0; db < 4; ++db) *(u32x2*)(op + 16 * db) = pk4(*(const f32x4*)(pp + 16 * db) + T.o[db] * g1); }
}

constexpr int SMP_SK = 1088;
template <class KF, class VF> DI void smp_branch(const Ctx& C, LAS float* qs, LAS float* S, LAS float* red, int NK, KF kf, VF vf, bool keep_probs, float (&outh)[1]) {
    const int tid = C.tid, lane = C.lane, w = C.wave;
#pragma unroll 1
    for (int j = tid; j < NK; j += NTHREADS) { const float* k = kf(j); f32x4 kr[16];
#pragma unroll
        for (int d4 = 0; d4 < 16; ++d4) kr[d4] = *(const f32x4*)(k + 4 * d4);
#pragma unroll 1
        for (int h = 0; h < 6; ++h) { float a = 0.f;
#pragma unroll
            for (int d4 = 0; d4 < 16; ++d4) { const f32x4 qv = *(const LAS f32x4*)(qs + h * 64 + 4 * d4); a += kr[d4].x * qv.x + kr[d4].y * qv.y + kr[d4].z * qv.z + kr[d4].w * qv.w; }
            S[h * SMP_SK + j] = a; } }
    asm volatile("s_waitcnt lgkmcnt(0)" ::: "memory"); __syncthreads();
    if (w < 6) { float m = -INFINITY; for (int j = lane; j < NK; j += 64) m = fmaxf(m, S[w * SMP_SK + j]); m = wave_max(m);
        float l = 0.f; for (int j = lane; j < NK; j += 64) { const float p = __builtin_amdgcn_exp2f(S[w * SMP_SK + j] - m); S[w * SMP_SK + j] = p; l += p; } l = wave_sum(l);
        const float inv = 1.0f / l; for (int j = lane; j < NK; j += 64) S[w * SMP_SK + j] *= inv; }
    asm volatile("s_waitcnt lgkmcnt(0)" ::: "memory"); __syncthreads();
    { const int per = (NK + NWAVES - 1) / NWAVES, j0 = w * per, j1 = (j0 + per < NK) ? j0 + per : NK; float o[6] = {0.f, 0.f, 0.f, 0.f, 0.f, 0.f};
#pragma unroll 1
      for (int j = j0; j < j1; j += 8) { float vv[8];
#pragma unroll
          for (int u = 0; u < 8; ++u) { const int jj = (j + u < j1) ? j + u : j1 - 1; vv[u] = vf(jj)[lane]; }
#pragma unroll
          for (int u = 0; u < 8; ++u) if (j + u < j1) {
#pragma unroll
              for (int h = 0; h < 6; ++h) o[h] += S[h * SMP_SK + j + u] * vv[u]; } }
#pragma unroll
      for (int h = 0; h < 6; ++h) red[(w * 6 + h) * 64 + lane] = o[h]; }
    asm volatile("s_waitcnt lgkmcnt(0)" ::: "memory"); __syncthreads();
    outh[0] = 0.f;
    if (tid < 384) { float a = 0.f;
#pragma unroll
        for (int ww = 0; ww < NWAVES; ++ww) a += red[ww * 384 + tid]; outh[0] = a; }
    if (!keep_probs) { __syncthreads(); }
}
DI void nsa_sample_item(const FP& P, const Ctx& C, int ns, int kvh) {
    LAS float* qs = (LAS float*)C.lds; LAS float* S = qs + 384; LAS float* red = S + 6 * SMP_SK; LAS float* scs = red + 8 * 384; LAS int* sel = (LAS int*)(scs + 136);
    const int tid = C.tid, row = M0 + ns;
    if (tid < 384) qs[tid] = bf2f(P.QB[(size_t)row * NSA_Q_COLS + kvh * 384 + tid]);
    asm volatile("s_waitcnt lgkmcnt(0)" ::: "memory"); __syncthreads();
    const float* ckf = P.CKF + ((size_t)ns * NSA_KV_HEADS + kvh) * NCH * 64; const float* cvf = P.CVF + ((size_t)ns * NSA_KV_HEADS + kvh) * NCH * 64;
    float oc[1], os[1], ow[1];
    smp_branch(C, qs, S, red, NCMP, [&](int j) { return ckf + (size_t)j * 64; }, [&](int j) { return cvf + (size_t)j * 64; }, true, oc);
    constexpr int NBS = (PAST_LEN + 1 + SLC_BLOCK - 1) / SLC_BLOCK, CURS = PAST_LEN / SLC_BLOCK;
    for (int b = tid; b < 136; b += NTHREADS) { float sv = -3.0e38f;
        if (b < NBS) { if (b == 0 || b == CURS || b == CURS - 1) sv = FORCE_SCORE; else { float a = 0.f;
#pragma unroll
                for (int o = -1; o <= 3; ++o) { const int ci = 4 * b + o; if (ci >= 0 && ci < NCMP) { float sm = 0.f; for (int h6 = 0; h6 < 6; ++h6) sm += S[h6 * SMP_SK + ci]; a += ((o >= 0 && o <= 2) ? 2.f : 1.f) * sm; } }
                sv = a; } }
        scs[b] = sv; }
    asm volatile("s_waitcnt lgkmcnt(0)" ::: "memory"); __syncthreads();
    for (int b = tid; b < NBS; b += NTHREADS) { const float sv = scs[b]; int rank = 0; for (int j = 0; j < NBS; ++j) { const float o = scs[j]; rank += (o > sv || (o == sv && j < b)) ? 1 : 0; }
        if (rank < SLC_TOPK) { sel[rank] = b; P.SELB[((size_t)row * NSA_KV_HEADS + kvh) * 16 + rank] = b; } }
    asm volatile("s_waitcnt lgkmcnt(0)" ::: "memory"); __syncthreads();
    { const float* newrow = P.nsa_kv_s + (size_t)ns * 512; const int* pt = P.page_table + ns * (PAST_LEN / PAGE_SIZE);
      if (tid == 0) { int seen = 0; for (int x = 0; x < SLC_TOPK; ++x) { const int bx = sel[x]; if (bx != CURS && seen < 15) sel[16 + seen++] = bx; } }
      asm volatile("s_waitcnt lgkmcnt(0)" ::: "memory"); __syncthreads();
      auto krow = [&](int j, int ty) -> const float* { if (j >= 15 * 64) return newrow + ty * 128 + kvh * 64;
          const int t0 = sel[16 + (j >> 6)] * SLC_BLOCK + (j & 63); const int pg = pt[t0 / PAGE_SIZE]; return P.cache_nsa_kv + ((size_t)pg * PAGE_SIZE + t0 % PAGE_SIZE) * 512 + ty * 128 + kvh * 64; };
      smp_branch(C, qs, S, red, 15 * 64 + 1, [&](int j) { return krow(j, 2); }, [&](int j) { return krow(j, 3); }, false, os); }
    { const float* wc = P.cache_nsa_win + (size_t)ns * SWA_WINDOW * 256; const float* newrow = P.win_s + ((size_t)ns * SWA_WINDOW + SWA_WINDOW - 1) * 256;
      smp_branch(C, qs, S, red, SWA_WINDOW + 1, [&](int j) { return (j < SWA_WINDOW ? wc + (size_t)j * 256 : newrow) + kvh * 64; }, [&](int j) { return (j < SWA_WINDOW ? wc + (size_t)j * 256 : newrow) + 128 + kvh * 64; }, false, ow); }
    if (tid < 384) { const int head = kvh * NSA_GROUP + tid / 64; const float* gt = P.GATES + (size_t)row * 64 + head * 3;
        P.ATTB[(size_t)row * 1024 + kvh * 384 + tid] = (bf16)f2bf(gt[0] * oc[0] + gt[1] * os[0] + gt[2] * ow[0]);
#ifdef NSA_DEBUG
        P.DBG[((size_t)0 * MP + row) * 768 + kvh * 384 + tid] = oc[0]; P.DBG[((size_t)1 * MP + row) * 768 + kvh * 384 + tid] = os[0]; P.DBG[((size_t)2 * MP + row) * 768 + kvh * 384 + tid] = ow[0];
#endif
    }
    __syncthreads();
}
DI void nsa_pairs(const FP& P, const Ctx& C, bool second) {
    LAS unsigned char* wl = C.lds + C.wave * NSA_WLDS;
    const int per = C.G / 4 > 0 ? C.G / 4 : 1, grp = (C.vcu / per) & 3, sub = C.vcu % per, n = grp >> 1, kvh = grp & 1;
#pragma unroll 1
    for (int pr = sub * NWAVES + C.wave; pr < SEQ / 2; pr += per * NWAVES) { if (second) nsa_pair_b(P, n, kvh, 2 * pr, C.lane, wl); else nsa_pair_a(P, n, kvh, 2 * pr, C.lane, wl); }
}
DI void nsa_phase_a(const FP& P, const Ctx& C) {
    for (int it = C.vcu; it < DEC_BATCH * NSA_KV_HEADS; it += C.G) nsa_sample_item(P, C, it / NSA_KV_HEADS, it % NSA_KV_HEADS);
    nsa_pairs(P, C, false);
    __syncthreads();
}
DI void nsa_phase_b(const FP& P, const Ctx& C) {
    const int lane = C.lane, w = C.wave;
    nsa_pairs(P, C, true);
    __syncthreads();
    { constexpr int NMT = (M0 / 16) * MEM_HEADS;
      for (int it = C.vcu * NWAVES + w; it < NMT; it += C.G * NWAVES) { const int h = it % MEM_HEADS, q16 = it / MEM_HEADS, row0 = q16 * 16, n = row0 / SEQ;
          mem_micro(P, P.MQB + h * 64, 256, row0, 1, n, h, P.ATTB + NSA_Q_COLS + h * 64, 1024, lane); }
    }
    { LAS float* qs = (LAS float*)C.lds;
      for (int it = C.vcu; it < DEC_BATCH * MEM_HEADS; it += C.G) { const int h = it % MEM_HEADS, ns = it / MEM_HEADS, row = M0 + ns;
          __syncthreads(); if (C.tid < 64) qs[C.tid] = bf2f(P.MQB[(size_t)row * 256 + h * 64 + C.tid]); asm volatile("s_waitcnt lgkmcnt(0)" ::: "memory"); __syncthreads();
          Dec D; D.m = -INFINITY; D.l = 0.f; D.o = 0.f; const float* mk = P.cache_mem_kv + ((size_t)1 * DEC_BATCH + ns) * MEM_TOKENS * 512;
          for (int ck = w; ck < MEM_TOKENS / 64; ck += NWAVES) { const int j0 = ck * 64; dec_chunk(D, qs, 64, [&](int j) { return mk + (size_t)(j0 + j) * 512 + h * 64; }, [&](int j) { return mk + (size_t)(j0 + j) * 512 + 256 + h * 64; }, lane); }
          const float o = dec_combine(C, D);
          if (w == 0) P.ATTB[(size_t)row * 1024 + NSA_Q_COLS + h * 64 + lane] = (bf16)f2bf(o); } }
    __syncthreads();
}
}
namespace fx {
enum { PH_PRO = 0, PH_G1, PH_ATTA, PH_G2, PH_LN1, PH_SC0, PH_TK0, PH_PU0, PH_PG0, PH_G3, PH_CMPG, PH_CMP2, PH_NSA, PH_NSB, PH_G4, PH_LN3, PH_SC1, PH_TK1, PH_PU1, PH_PG1, PH_COUNT };
template <class Epi> DI void run_gemm(const Ctx& C, const bf16* A, const bf16* Bt, int M, int N, int K, const Epi& E) {
    pg8::Gemm g{A, Bt, M, N, K}; pg8::StaticOrder S; S.init(M, N, C.G, (int)blockIdx.x);
    pg8::gemm_phase<Epi, pg8::StaticOrder, true, true>(C.lds, g, S, E);
}
template <class Epi> DI void skinny_gemm(const Ctx& C, const bf16* A, const bf16* Bt, int N, int K, const Epi& E) {
    static_assert(DEC_BATCH == 32 && M0 % 256 == 0, "skinny_gemm: 32 sample rows right after a whole number of 256-row tiles");
    const int lane = C.lane, fr = lane & 15, fq = lane >> 4, w = C.wave; const int NI = (N / 256) * 4, KW = K / NWAVES;
    LAS f32x4* red = (LAS f32x4*)C.lds;
#pragma unroll 1
    for (int item = C.vcu; item < NI; item += C.G) { const int pn = item >> 2, wc = item & 3;
        f32x4 pa[2][2][2];
#pragma unroll
        for (int i = 0; i < 8; ++i) (&pa[0][0][0])[i] = (f32x4){0.f, 0.f, 0.f, 0.f};
        const bf16* xa = A + (size_t)(M0 + fr) * K + w * KW + 8 * fq; const bf16* xb = xa + (size_t)16 * K;
        const bf16* wp[2][2];
#pragma unroll
        for (int bj = 0; bj < 2; ++bj)
#pragma unroll
            for (int n = 0; n < 2; ++n) wp[bj][n] = Bt + (size_t)(pn * 256 + bj * 128 + wc * 32 + 8 * (fr >> 2) + 4 * n + (fr & 3)) * K + w * KW + 8 * fq;
#pragma unroll 4
        for (int k0 = 0; k0 < KW; k0 += 32) { const bf16x8 x0 = *(const bf16x8*)(xa + k0), x1 = *(const bf16x8*)(xb + k0);
#pragma unroll
            for (int bj = 0; bj < 2; ++bj)
#pragma unroll
                for (int n = 0; n < 2; ++n) { const bf16x8 wf = *(const bf16x8*)(wp[bj][n] + k0);
                    pa[bj][0][n] = __builtin_amdgcn_mfma_f32_16x16x32_bf16(wf, x0, pa[bj][0][n], 0, 0, 0); pa[bj][1][n] = __builtin_amdgcn_mfma_f32_16x16x32_bf16(wf, x1, pa[bj][1][n], 0, 0, 0); } }
        __syncthreads();
#pragma unroll
        for (int bj = 0; bj < 2; ++bj)
#pragma unroll
            for (int mm = 0; mm < 2; ++mm)
#pragma unroll
                for (int n = 0; n < 2; ++n) red[(w * 8 + bj * 4 + mm * 2 + n) * 64 + lane] = pa[bj][mm][n];
        asm volatile("s_waitcnt lgkmcnt(0)" ::: "memory"); __syncthreads();
        if (w == 0) { f32x4 acc[2][2][4][2];
#pragma unroll
            for (int i = 0; i < 32; ++i) (&acc[0][0][0][0])[i] = (f32x4){0.f, 0.f, 0.f, 0.f};
#pragma unroll
            for (int bj = 0; bj < 2; ++bj)
#pragma unroll
                for (int mm = 0; mm < 2; ++mm)
#pragma unroll
                    for (int n = 0; n < 2; ++n) { f32x4 s = red[(bj * 4 + mm * 2 + n) * 64 + lane];
#pragma unroll 1
                        for (int ww = 1; ww < NWAVES; ++ww) s += red[(ww * 8 + bj * 4 + mm * 2 + n) * 64 + lane];
                        acc[0][bj][mm][n] = s; }
            E(acc, pg8::Unit{M0 / 256, pn}, 0, wc, fr, fq); }
    }
    __syncthreads();
}
__global__ void __launch_bounds__(NTHREADS, 2) mega(Args args) {
    extern __shared__ __attribute__((aligned(16))) unsigned char lds_raw[];
    Ctx C; C.lds = (LAS unsigned char*)lds_raw; C.tid = threadIdx.x; C.lane = C.tid & 63; C.wave = __builtin_amdgcn_readfirstlane(C.tid >> 6);
    C.G = gridDim.x; { const int bx = blockIdx.x; C.vcu = (C.G % 8 == 0) ? (bx % 8) * (C.G / 8) + bx / 8 : bx; }
    const FP& P = args.p;
    volatile LAS unsigned* MISC = (volatile LAS unsigned*)(C.lds + MISC_OFF);
    for (int u = C.tid; u < (LDS_BYTES - RING_BYTES) / 4; u += NTHREADS) ((LAS unsigned*)(C.lds + RING_BYTES))[u] = 0u;
    __syncthreads();
    const int lo = args.lo, hi = args.hi;
    XcdBarrier bar; bar.bar = P.ctl + 1024; bar.x = 0; bar.st = nullptr;
    if (hi - lo > 1) bar = xcd_barrier_post(P.ctl + 1024, MISC + 8);
#define IN(k) (lo <= (k) && (k) < hi)
#define SEAM(k) do { if (IN(k) && IN((k) + 1)) xcd_barrier(bar); } while (0)
#ifndef DUP_PHASE
#define DUP_PHASE -1
#endif
#define PHASE(k, ...) do { if (IN(k)) { __VA_ARGS__ if (DUP_PHASE == (k)) { __syncthreads(); __VA_ARGS__ } } SEAM(k); } while (0)
    PHASE(PH_PRO, p0_prologue(P, C); __syncthreads(); p0_wpk(P, C););
    PHASE(PH_G1, run_gemm(C, P.XB0, P.WA_T, M0, ACOLS, D_MODEL, EpiA{P}); run_gemm(C, P.MEMB, P.WMEM_T, BATCH * MEM_TOKENS, 1024, D_MODEL, EpiMem{P}); skinny_gemm(C, P.XB0, P.WA_T, ACOLS, D_MODEL, EpiA{P}); cache_copy_queue(P, C, MISC + 12););
#ifdef PEER_SHARD3
#define PEER_SHARDED_FN peer_sharded3_phase
#else
#define PEER_SHARDED_FN peer_sharded2_phase
#endif
#if defined(PEER_SOFTSYNC) && !defined(PEER_SHARD3)
#define PEER_HINT_ARGS , bar.st, bar.x
#else
#define PEER_HINT_ARGS
#endif
    PHASE(PH_ATTA, atta_phase(P, C););
    PHASE(PH_G2, run_gemm(C, P.ATTA, P.WOA_T, M0, D_MODEL, 512, EpiPre{P.x_prompt, P.x_sample, P.PRE}); skinny_gemm(C, P.ATTA, P.WOA_T, D_MODEL, 512, EpiPre{P.x_prompt, P.x_sample, P.PRE}););
    PHASE(PH_LN1, ln_phase(P, C, P.PRE, P.ln_g, P.ln_b, P.X1, P.X1B, nullptr, nullptr););
    PHASE(PH_SC0, run_gemm(C, P.X1B, P.WPK_T, M0, NPK, D_MODEL, EpiF32{P.SCO, NPK, MP}); skinny_gemm(C, P.X1B, P.WPK_T, NPK, D_MODEL, EpiF32{P.SCO, NPK, MP}););
    PHASE(PH_TK0, topk_phase(P, C););
#ifdef PEER_SPLIT
    PHASE(PH_PU0, peer_u_phase(P, C, 0, P.X1B););
    PHASE(PH_PG0, peer_v_phase(P, C, 0, P.X1, P.X2, P.X2 + (size_t)M0 * D_MODEL, P.X2B););
#elif defined(PEER_SHARD2)
    PHASE(PH_PG0, const bool shd = (M0 % (C.G * NWAVES * PS2_ROWS)) == 0; if (shd) { PEER_SHARDED_FN(P, C, 0, P.X1, P.X1B, P.X2, P.X2B PEER_HINT_ARGS); __syncthreads(); } peer_phase(P, C, 0, P.X1, P.X2, P.X2 + (size_t)M0 * D_MODEL, P.X2B, shd););
#elif defined(PEER_SHARD)
    PHASE(PH_PG0, peer_sharded_phase(P, C, 0, P.X1, P.X1B, P.X2, P.X2 + (size_t)M0 * D_MODEL, P.X2B); __syncthreads(); peer_phase(P, C, 0, P.X1, P.X2, P.X2 + (size_t)M0 * D_MODEL, P.X2B););
#else
    PHASE(PH_PG0, peer_phase(P, C, 0, P.X1, P.X2, P.X2 + (size_t)M0 * D_MODEL, P.X2B););
#endif
    PHASE(PH_G3, run_gemm(C, P.X2B, P.WB_T, M0, NB_T, D_MODEL, EpiB{P}); skinny_gemm(C, P.X2B, P.WB_T, NB_T, D_MODEL, EpiB{P}););
    PHASE(PH_CMPG, run_gemm(C, P.AC, P.CW1_T, ACROWS, 256, 1024, EpiF32{P.UL, 256, ACROWS}); run_gemm(C, P.AC + (size_t)ACROWS * 1024, P.CW1_T + 256 * 1024, ACROWS, 256, 1024, EpiF32{P.UL + (size_t)ACROWS * 256, 256, ACROWS}););
    PHASE(PH_CMP2, cmp2_phase(P, C););
    PHASE(PH_NSA, nsa_phase_a(P, C););
    PHASE(PH_NSB, nsa_phase_b(P, C););
    PHASE(PH_G4, run_gemm(C, P.ATTB, P.WOB_T, M0, D_MODEL, 1024, EpiPre{P.X2, nullptr, P.PRE}); skinny_gemm(C, P.ATTB, P.WOB_T, D_MODEL, 1024, EpiPre{P.X2, nullptr, P.PRE}););
    PHASE(PH_LN3, ln_phase(P, C, P.PRE, P.ln_g + 2 * D_MODEL, P.ln_b + 2 * D_MODEL, P.X3, P.X3B, nullptr, nullptr););
    PHASE(PH_SC1, run_gemm(C, P.X3B, P.WPK_T + (size_t)NPK * D_MODEL, M0, NPK, D_MODEL, EpiF32{P.SCO, NPK, MP}); skinny_gemm(C, P.X3B, P.WPK_T + (size_t)NPK * D_MODEL, NPK, D_MODEL, EpiF32{P.SCO, NPK, MP}););
    PHASE(PH_TK1, topk_phase(P, C););
#ifdef PEER_SPLIT
    PHASE(PH_PU1, peer_u_phase(P, C, 1, P.X3B););
    PHASE(PH_PG1, peer_v_phase(P, C, 1, P.X3, P.y_prompt, P.y_sample, nullptr););
#elif defined(PEER_SHARD2)
    PHASE(PH_PG1, const bool shd = (M0 % (C.G * NWAVES * PS2_ROWS)) == 0; if (shd) { PEER_SHARDED_FN(P, C, 1, P.X3, P.X3B, P.y_prompt, nullptr PEER_HINT_ARGS); __syncthreads(); } peer_phase(P, C, 1, P.X3, P.y_prompt, P.y_sample, nullptr, shd););
#elif defined(PEER_SHARD)
    PHASE(PH_PG1, peer_sharded_phase(P, C, 1, P.X3, P.X3B, P.y_prompt, P.y_sample, nullptr); __syncthreads(); peer_phase(P, C, 1, P.X3, P.y_prompt, P.y_sample, nullptr););
#else
    PHASE(PH_PG1, peer_phase(P, C, 1, P.X3, P.y_prompt, P.y_sample, nullptr););
#endif
#undef IN
#undef SEAM
}
}
#ifndef ONE_LAUNCH
#define ONE_LAUNCH 1
#endif
extern "C" void kernel_launch(void* const* d_in, const int* in_sizes, int n_in, void* d_out, int out_size, void* d_ws, size_t ws_size, hipStream_t stream) {
    fx::Args a; memset(&a, 0, sizeof(a)); fx::bind_io(a.p, d_in, (float*)d_out);
    const size_t f_need = fx::carve(a.p, d_ws);
    if (f_need > ws_size) { fprintf(stderr, "kernel_launch: workspace too small: need %zu have %zu\n", f_need, ws_size); return; }
    static int grid = 0;
    if (!grid) { int dev = 0, cus = 0, per_cu = 0; (void)hipGetDevice(&dev); (void)hipDeviceGetAttribute(&cus, hipDeviceAttributeMultiprocessorCount, dev);
        (void)hipFuncSetAttribute((const void*)fx::mega, hipFuncAttributeMaxDynamicSharedMemorySize, fx::LDS_BYTES);
        if (hipOccupancyMaxActiveBlocksPerMultiprocessor(&per_cu, (const void*)fx::mega, fx::NTHREADS, fx::LDS_BYTES) != hipSuccess || per_cu < 1) { fprintf(stderr, "kernel_launch: occupancy query says %d blocks per CU\n", per_cu); (void)hipGetLastError(); }
        grid = cus; }
    (void)hipMemsetAsync(a.p.ctl, 0, fx::CTL_BYTES, stream);
#if ONE_LAUNCH
    a.lo = 0; a.hi = fx::PH_COUNT; hipLaunchKernelGGL(fx::mega, dim3(grid), dim3(fx::NTHREADS), fx::LDS_BYTES, stream, a);
#else
    for (int k = 0; k < fx::PH_COUNT; ++k) { a.lo = k; a.hi = k + 1; hipLaunchKernelGGL(fx::mega, dim3(grid), dim3(fx::NTHREADS), fx::LDS_BYTES, stream, a); }
#endif
}
```

```cpp
#define PEER_SHARD2 1
#define ONE_LAUNCH 1
#include <hip/hip_runtime.h>
#include <cstdio>
#include <cstring>
#include <cmath>
#ifdef CPU_TEST
#define HD inline
constexpr int D_MODEL = 128, BATCH = 2, SEQ = 512, DEPTH = 2, DEC_BATCH = 3, DEC_SEQ = 1, PAST_LEN = 512, PAGE_SIZE = 128;
constexpr int DIL_W[3] = {16, 64, 256}, DIL_D[3] = {1, 4, 16}, DIL_TAPS = 17;
constexpr int MEM_TOKENS = 32, SLC_TOPK = 4, SWA_WINDOW = 64, PEER_KEYS = 16, PEER_TOPK = 4;
#else
#define HD __host__ __device__ __forceinline__
constexpr int D_MODEL = 1024, BATCH = 2, SEQ = 8192, DEPTH = 2, DEC_BATCH = 32, DEC_SEQ = 1, PAST_LEN = 8192, PAGE_SIZE = 128;
constexpr int DIL_W[3] = {128, 512, 2048}, DIL_D[3] = {1, 4, 16}, DIL_TAPS = 129;
constexpr int MEM_TOKENS = 256, SLC_TOPK = 16, SWA_WINDOW = 512, PEER_KEYS = 128, PEER_TOPK = 16;
#endif
HD constexpr int dil_w(int g) { return g == 0 ? DIL_W[0] : (g == 1 ? DIL_W[1] : DIL_W[2]); }
HD constexpr int dil_d(int g) { return g == 0 ? DIL_D[0] : (g == 1 ? DIL_D[1] : DIL_D[2]); }
constexpr int HEAD_DIM = 64, N_A_LAYERS = DEPTH / 2, N_DIL = 3, DIL_HEADS = 4, DIL_COLS = N_DIL * 3 * DIL_HEADS * HEAD_DIM;
constexpr int MEM_HEADS = 4, MEM_COLS = MEM_HEADS * HEAD_DIM;
constexpr int NSA_HEADS = 12, NSA_KV_HEADS = 2, NSA_GROUP = 6, NSA_Q_COLS = NSA_HEADS * HEAD_DIM, NSA_GATE_COLS = NSA_HEADS * 3;
constexpr int CMP_BLOCK = 32, CMP_STRIDE = 16, CMP_HIDDEN = 128, SLC_BLOCK = 64;
constexpr int PEER_EXPERTS = PEER_KEYS * PEER_KEYS, PEER_HEADS = 8, PEER_KEY_DIM = 128;
constexpr float FORCE_SCORE = 1.0e9f, NEG = -1.0e30f, SCALE = 0.125f, LN_EPS = 1e-5f;
constexpr float ALPHA = 1.41421356237309515f;
constexpr float BETA = 0.5f;
#define LAS __attribute__((address_space(3)))
namespace pg8 {
#define PG8_LAS __attribute__((address_space(3)))
typedef unsigned short bf16_t;
typedef short bf16x8 __attribute__((ext_vector_type(8)));
typedef float f32x4 __attribute__((ext_vector_type(4)));
typedef unsigned u32x4 __attribute__((ext_vector_type(4)));
constexpr int BM = 256, BK = 64, HALF = 128, HTB = HALF * BK * 2  , STAGE_BYTES = 8 * HTB, NXCD = 8, WGM = 8;

__host__ __device__ __forceinline__ int lds_byte(int r, int c) { const int st = (r >> 4) * 2 + (c >> 5), rr = r & 15, cc = c & 31, ob = rr * 64 + cc * 2; return st * 1024 + (ob ^ (((ob >> 9) & 1) << 5)); }
__host__ __device__ __forceinline__ void stage_rc(int b, int& R, int& C) { const int st = b / 1024, sb = b % 1024, swz = sb ^ (((sb >> 9) & 1) << 5); R = (st >> 1) * 16 + swz / 64; C = (st & 1) * 32 + (swz % 64) / 2; }
__host__ __device__ __forceinline__ int perm32(int rho) { const int n = rho >> 4, i = rho & 15; return 8 * (i >> 2) + 4 * n + (i & 3); }

struct Unit { int pm, pn; };
struct Gemm { const bf16_t* A; const bf16_t* Bt; int M, N, K; };

struct StaticOrder {
    int nM, nN, nwg, G, c;
    __host__ __device__ void init(int M, int N, int G_, int c_) { nM = M / BM; nN = N / BM; nwg = nM * nN; G = G_; c = c_; }
    __host__ __device__ bool next(int i, Unit& u) const {
        const long L = (long)i * G + c; if (L >= nwg) return false;
        int wgid = (int)L; { const int q = nwg / NXCD, r = nwg % NXCD, xcd = wgid % NXCD, off = wgid / NXCD; wgid = (xcd < r ? xcd * (q + 1) : r * (q + 1) + (xcd - r) * q) + off; }
        const int nig = WGM * nN, gid = wgid / nig, fm = gid * WGM, gsz = (nM - fm) < WGM ? (nM - fm) : WGM;
        u.pm = fm + ((wgid % nig) % gsz); u.pn = (wgid % nig) / gsz; return true;
    }
    __device__ __forceinline__ void a_ready(const Unit&) const {}
    __device__ __forceinline__ void done(const Unit&) const {}
};

__device__ __forceinline__ unsigned cvt_pk_bf16(float lo, float hi) { unsigned r; asm volatile("v_cvt_pk_bf16_f32 %0, %1, %2" : "=v"(r) : "v"(lo), "v"(hi)); return r; }
typedef float f32x2 __attribute__((ext_vector_type(2)));
typedef float f32x2 __attribute__((ext_vector_type(2)));
template <class Epi, class Sched, bool ALIGN_EPI = false, bool SP2 = false>
__device__ __forceinline__ void gemm_phase(PG8_LAS unsigned char* lds, const Gemm g, const Sched& S, const Epi& E) {
    const int tid = threadIdx.x, wid = __builtin_amdgcn_readfirstlane(tid >> 6), lane = tid & 63, wr = wid >> 2, wc = wid & 3, fr = lane & 15, fq = lane >> 4;
    const int K = g.K, nt = K / BK;
    unsigned voffA[2], voffB[2];
#pragma unroll
    for (int i = 0; i < 2; ++i) { int R, C; stage_rc(tid * 16 + i * 8192, R, C); const int Rb = Epi::PERM ? ((R & ~31) + perm32(R & 31)) : R;
        voffA[i] = (unsigned)(R * K + C) * 2u; voffB[i] = (unsigned)(Rb * K + C) * 2u; }
    const size_t kstep = (size_t)(BK * 2);
    const size_t hstep = (size_t)HALF * K * 2;
    const size_t tstep = 2 * hstep;
    const unsigned ldsw = (unsigned)wid * 1024u;
    const int aoff = lds_byte(wr * 64 + fr, fq * 8), boff = lds_byte(wc * 32 + fr, fq * 8);
#define PG8_SA(b, h) (((b) * 2 + (h)) * HTB)
#define PG8_SB(b, h) ((4 + (b) * 2 + (h)) * HTB)
#define PG8_STAGE(bufoff, gbase, voff) do { _Pragma("unroll") for (int _i = 0; _i < 2; ++_i) \
        __builtin_amdgcn_global_load_lds((const unsigned*)((const char*)(gbase) + (voff)[_i]), (PG8_LAS unsigned*)(lds + (bufoff) + ldsw + _i * 8192), 16, 0, 0); } while (0)
#define PG8_LDA(dst, b, h) do { _Pragma("unroll") for (int m = 0; m < 4; ++m) _Pragma("unroll") for (int k = 0; k < 2; ++k) dst[m][k] = *(const PG8_LAS bf16x8*)(lds + PG8_SA(b, h) + aoff + m * 2048 + k * 1024); } while (0)
#define PG8_LDB(dst, b, h) do { _Pragma("unroll") for (int n = 0; n < 2; ++n) _Pragma("unroll") for (int k = 0; k < 2; ++k) dst[n][k] = *(const PG8_LAS bf16x8*)(lds + PG8_SB(b, h) + boff + n * 2048 + k * 1024); } while (0)
#define PG8_MMA(ai, bj, At, Bt) do { __builtin_amdgcn_s_setprio(1); _Pragma("unroll") for (int m = 0; m < 4; ++m) _Pragma("unroll") for (int n = 0; n < 2; ++n) _Pragma("unroll") for (int k = 0; k < 2; ++k) \
        acc[ai][bj][m][n] = __builtin_amdgcn_mfma_f32_16x16x32_bf16(Bt[n][k], At[m][k], acc[ai][bj][m][n], 0, 0, 0); __builtin_amdgcn_s_setprio(0); } while (0)
#define PG8_WAIT_V(n) asm volatile("s_waitcnt vmcnt(" #n ")" ::: "memory")
#define PG8_WAIT_L(n) asm volatile("s_waitcnt lgkmcnt(" #n ")" ::: "memory")
#define PG8_BAR __builtin_amdgcn_s_barrier()
#define PG8_SCHED __builtin_amdgcn_sched_barrier(0)
    Unit cur, nxt; int ui = 0;
    if (!S.next(0, cur)) return;
    f32x4 acc[2][2][4][2];
#pragma unroll
    for (int a = 0; a < 2; ++a)
#pragma unroll
        for (int b = 0; b < 2; ++b)
#pragma unroll
            for (int m = 0; m < 4; ++m)
#pragma unroll
                for (int n = 0; n < 2; ++n) acc[a][b][m][n] = (f32x4){0.f, 0.f, 0.f, 0.f};
    bf16x8 At[4][2], B0[2][2], B1[2][2];
    const char* cA = (const char*)g.A + (size_t)cur.pm * tstep; const char* cB = (const char*)g.Bt + (size_t)cur.pn * tstep;
    S.a_ready(cur);
    if constexpr (SP2) {
        PG8_STAGE(PG8_SB(0, 0), cB, voffB); PG8_STAGE(PG8_SB(0, 1), cB + hstep, voffB); PG8_STAGE(PG8_SA(0, 0), cA, voffA); PG8_STAGE(PG8_SA(0, 1), cA + hstep, voffA);
        if (wr == 1) PG8_BAR;
        PG8_WAIT_V(2); PG8_BAR;
        PG8_STAGE(PG8_SB(1, 0), cB + kstep, voffB); PG8_STAGE(PG8_SA(1, 0), cA + kstep, voffA); PG8_STAGE(PG8_SB(1, 1), cB + hstep + kstep, voffB);
        PG8_WAIT_V(6); PG8_BAR;
    } else {
        PG8_STAGE(PG8_SB(0, 0), cB, voffB); PG8_STAGE(PG8_SA(0, 0), cA, voffA); PG8_STAGE(PG8_SB(0, 1), cB + hstep, voffB); PG8_STAGE(PG8_SA(0, 1), cA + hstep, voffA);
        if (wr == 1) PG8_BAR;
        PG8_WAIT_V(4); PG8_BAR;
        PG8_STAGE(PG8_SB(1, 0), cB + kstep, voffB); PG8_STAGE(PG8_SA(1, 0), cA + kstep, voffA); PG8_STAGE(PG8_SB(1, 1), cB + hstep + kstep, voffB);
        PG8_WAIT_V(6); PG8_BAR;
    }
    for (;;) {
        const bool has_next = S.next(ui + 1, nxt);
        const char* nA = has_next ? (const char*)g.A + (size_t)nxt.pm * tstep : cA; const char* nB = has_next ? (const char*)g.Bt + (size_t)nxt.pn * tstep : cB;
        for (int t = 0; t < nt; t += 2) {
            const bool last = (t == nt - 2);
            const char* a1 = cA + (size_t)(t + 1) * kstep;
            const char* a2 = last ? nA : cA + (size_t)(t + 2) * kstep; const char* b2 = last ? nB : cB + (size_t)(t + 2) * kstep;
            const char* a3 = a2 + kstep; const char* b3 = b2 + kstep;
            if (last && has_next) S.a_ready(nxt);
            if constexpr (SP2) {
            PG8_LDB(B0, 0, 0); PG8_LDB(B1, 0, 1); PG8_SCHED; PG8_LDA(At, 0, 0); PG8_STAGE(PG8_SA(1, 1), a1 + hstep, voffA);
            PG8_WAIT_V(8); PG8_WAIT_L(0); PG8_BAR; PG8_MMA(0, 0, At, B0); PG8_MMA(0, 1, At, B1); PG8_BAR; PG8_SCHED;
            PG8_LDA(At, 0, 1); PG8_STAGE(PG8_SB(0, 0), b2, voffB); PG8_STAGE(PG8_SB(0, 1), b2 + hstep, voffB); PG8_STAGE(PG8_SA(0, 0), a2, voffA);
            PG8_WAIT_V(8); PG8_WAIT_L(0); PG8_BAR; PG8_MMA(1, 0, At, B0); PG8_MMA(1, 1, At, B1); PG8_BAR; PG8_SCHED;
            PG8_LDB(B0, 1, 0); PG8_LDB(B1, 1, 1); PG8_SCHED; PG8_LDA(At, 1, 0); PG8_STAGE(PG8_SA(0, 1), a2 + hstep, voffA);
            PG8_WAIT_V(8); PG8_WAIT_L(0); PG8_BAR; PG8_MMA(0, 0, At, B0); PG8_MMA(0, 1, At, B1); PG8_BAR; PG8_SCHED;
            PG8_LDA(At, 1, 1); PG8_STAGE(PG8_SB(1, 0), b3, voffB); PG8_STAGE(PG8_SB(1, 1), b3 + hstep, voffB); PG8_STAGE(PG8_SA(1, 0), a3, voffA);
            PG8_WAIT_V(8); PG8_WAIT_L(0); PG8_BAR; PG8_MMA(1, 0, At, B0); PG8_MMA(1, 1, At, B1); PG8_BAR; PG8_SCHED;
            } else {
            PG8_LDB(B0, 0, 0); PG8_SCHED; PG8_LDA(At, 0, 0); PG8_STAGE(PG8_SA(1, 1), a1 + hstep, voffA);
            PG8_WAIT_L(8); PG8_BAR; PG8_WAIT_L(0); PG8_MMA(0, 0, At, B0); PG8_BAR; PG8_SCHED;
            PG8_LDB(B1, 0, 1); PG8_STAGE(PG8_SB(0, 0), b2, voffB);
            PG8_BAR; PG8_WAIT_L(0); PG8_MMA(0, 1, At, B1); PG8_BAR;
            PG8_LDA(At, 0, 1); PG8_STAGE(PG8_SA(0, 0), a2, voffA);
            PG8_BAR; PG8_WAIT_L(0); PG8_MMA(1, 0, At, B0); PG8_BAR; PG8_SCHED;
            PG8_STAGE(PG8_SB(0, 1), b2 + hstep, voffB);
            PG8_WAIT_V(6); PG8_BAR; PG8_MMA(1, 1, At, B1); PG8_BAR;
            PG8_LDB(B0, 1, 0); PG8_SCHED; PG8_LDA(At, 1, 0); PG8_STAGE(PG8_SA(0, 1), a2 + hstep, voffA);
            PG8_WAIT_L(8); PG8_BAR; PG8_WAIT_L(0); PG8_MMA(0, 0, At, B0); PG8_BAR; PG8_SCHED;
            PG8_LDB(B1, 1, 1); PG8_STAGE(PG8_SB(1, 0), b3, voffB);
            PG8_BAR; PG8_WAIT_L(0); PG8_MMA(0, 1, At, B1); PG8_BAR;
            PG8_LDA(At, 1, 1); PG8_STAGE(PG8_SA(1, 0), a3, voffA);
            PG8_BAR; PG8_WAIT_L(0); PG8_MMA(1, 0, At, B0); PG8_BAR; PG8_SCHED;
            PG8_STAGE(PG8_SB(1, 1), b3 + hstep, voffB);
            PG8_WAIT_V(6); PG8_BAR; PG8_MMA(1, 1, At, B1); PG8_BAR;
            }
        }
        if constexpr (ALIGN_EPI) { if (wr == 0) PG8_BAR; }
        if constexpr (!Epi::AFTER_DRAIN) { E(acc, cur, wr, wc, fr, fq); S.done(cur); }
        if (!has_next) break;
#pragma unroll
        for (int a = 0; a < 2; ++a)
#pragma unroll
            for (int b = 0; b < 2; ++b)
#pragma unroll
                for (int m = 0; m < 4; ++m)
#pragma unroll
                    for (int n = 0; n < 2; ++n) acc[a][b][m][n] = (f32x4){0.f, 0.f, 0.f, 0.f};
        cur = nxt; cA = nA; cB = nB; ++ui;
        if constexpr (ALIGN_EPI) { if (wr == 1) PG8_BAR; }
    }
    PG8_WAIT_V(0);
    if constexpr (!ALIGN_EPI) { if (wr == 0) PG8_BAR; }
    PG8_BAR;
    if constexpr (Epi::AFTER_DRAIN) { E.fused(acc, cur, wr, wc, fr, fq, lds, wid, lane); S.done(cur); }
#undef PG8_SA
#undef PG8_SB
#undef PG8_STAGE
#undef PG8_LDA
#undef PG8_LDB
#undef PG8_MMA
#undef PG8_WAIT_V
#undef PG8_WAIT_L
#undef PG8_BAR
#undef PG8_SCHED
}
}
#define XB_TMO      128
#define XB_XCNT(j)  (256  + 64 * (j))
#define XB_XSUB(j)  (1280 + 64 * (j))
#define XB_XGEN(j)  (2304 + 64 * (j))
#define XB_TOP      3328
#define XB_TOPGEN   3392
#define XCD_BAR_WORDS 3456
#define XB_SPIN_CAP (1u << 18)

__device__ __forceinline__ unsigned xb_ld(unsigned* p)              { return __hip_atomic_load(p, __ATOMIC_RELAXED, __HIP_MEMORY_SCOPE_AGENT); }
__device__ __forceinline__ unsigned xb_add(unsigned* p, unsigned v) { return __hip_atomic_fetch_add(p, v, __ATOMIC_RELAXED, __HIP_MEMORY_SCOPE_AGENT); }
__device__ __forceinline__ unsigned xb_xcc_id() { return (unsigned)__builtin_amdgcn_s_getreg((3 << 11) | 20) & 0xFu; }
#define XB_SPIN(cond, bar) do { unsigned _sp = 0; while (cond) { __builtin_amdgcn_s_sleep(1); \
    if ((++_sp & 255u) == 0u) { if (xb_ld(&(bar)[XB_TMO])) break; if (_sp > XB_SPIN_CAP) { atomicAdd(&(bar)[XB_TMO], 1u); break; } } } } while (0)

struct XcdBarrier {
    unsigned* bar; unsigned x;
    volatile LAS unsigned* st;
};

__device__ __forceinline__ XcdBarrier xcd_barrier_post(unsigned* bar, volatile LAS unsigned* st) {
    XcdBarrier b; b.bar = bar; b.x = xb_xcc_id(); b.st = st;
    if (threadIdx.x == 0) (void)xb_add(&bar[XB_XCNT(b.x)], 1u);
    return b;
}
__device__ __forceinline__ void xcd_barrier_complete(unsigned* bar, unsigned x, unsigned& nloc, unsigned& nx) {
    const unsigned G = gridDim.x * gridDim.y * gridDim.z;
    unsigned sum, cnt, mine, sp = 0u;
    for (;;) {
        sum = 0u; cnt = 0u; mine = 0u;
#pragma unroll
        for (unsigned j = 0; j < 16; ++j) { const unsigned c = xb_ld(&bar[XB_XCNT(j)]); sum += c; cnt += (c > 0u) ? 1u : 0u; mine = (j == x) ? c : mine; }
        if (sum == G) break;
        __builtin_amdgcn_s_sleep(1);
        if ((++sp & 255u) == 0u) { if (xb_ld(&bar[XB_TMO])) break; if (sp > XB_SPIN_CAP) { atomicAdd(&bar[XB_TMO], 1u); break; } }
    }
    nloc = mine > 0u ? mine : 1u; nx = cnt > 0u ? cnt : 1u;
}

__device__ __forceinline__ void xcd_barrier(const XcdBarrier& b) {
    asm volatile("s_waitcnt vmcnt(0)" ::: "memory");
    __syncthreads();
    if (threadIdx.x == 0) {
        unsigned* bar = b.bar;
        __builtin_amdgcn_s_waitcnt(0);
        unsigned nloc = b.st[0], nx = b.st[1];
        if (nloc == 0u) { xcd_barrier_complete(bar, b.x, nloc, nx); b.st[0] = nloc; b.st[1] = nx; }
        const unsigned old = xb_add(&bar[XB_XSUB(b.x)], 1u);
        const unsigned gen = old / nloc;
        if (old + 1u == (gen + 1u) * nloc) {
            __builtin_amdgcn_fence(__ATOMIC_RELEASE, "agent");
            asm volatile("s_waitcnt vmcnt(0)" ::: "memory");
            const unsigned og = xb_add(&bar[XB_TOP], 1u);
            const unsigned tg = og / nx;
            if (og + 1u == (tg + 1u) * nx) xb_add(&bar[XB_TOPGEN], 1u);
            else XB_SPIN(xb_ld(&bar[XB_TOPGEN]) == tg, bar);
            __builtin_amdgcn_fence(__ATOMIC_ACQUIRE, "agent");
            xb_add(&bar[XB_XGEN(b.x)], 1u);
            asm volatile("s_waitcnt vmcnt(0)" ::: "memory");
        } else {
            XB_SPIN(xb_ld(&bar[XB_XGEN(b.x)]) == gen, bar);
            __builtin_amdgcn_fence(__ATOMIC_ACQUIRE, "agent");
            asm volatile("s_waitcnt vmcnt(0)" ::: "memory");
        }
    }
    __syncthreads();
}
namespace fx {
#define DI __device__ __forceinline__
typedef unsigned short bf16;
typedef short bf16x8 __attribute__((ext_vector_type(8)));
typedef float f32x4 __attribute__((ext_vector_type(4)));
typedef float f32x2 __attribute__((ext_vector_type(2)));
typedef unsigned u32x4 __attribute__((ext_vector_type(4)));
typedef unsigned u32x2 __attribute__((ext_vector_type(2)));
constexpr int M0 = BATCH * SEQ, MP = M0 + DEC_BATCH, MPAD = ((MP + 255) / 256) * 256;
constexpr int ACOLS = DIL_COLS + MEM_COLS, BCOLS = NSA_Q_COLS + NSA_GATE_COLS + MEM_COLS, KVCOLS = 6 * NSA_KV_HEADS * HEAD_DIM;
constexpr int NB_T = 2048;
constexpr int NPK = PEER_HEADS * 2 * PEER_KEYS;
constexpr int NCMP = (SEQ - CMP_BLOCK) / CMP_STRIDE + 1;
constexpr int NCH = SEQ / CMP_STRIDE;
constexpr int NCTX = BATCH + DEC_BATCH;
constexpr int ACROWS = NCTX * NSA_KV_HEADS * NCH;
constexpr int NPOS = PAST_LEN + 1;
constexpr float QSCALE = 0.125f * 1.4426950408889634f;
constexpr int NTHREADS = 512, NWAVES = 8, LDS_BYTES = 147456, RING_BYTES = 131072, MISC_OFF = RING_BYTES + 320;

struct FP {
    const float *x_prompt, *x_sample, *mem_prompt, *cache_dil[3], *cache_nsa_kv, *cache_nsa_win, *cache_mem_kv; const int* page_table;
    const float *w_in_a, *w_out_a, *w_in_b, *w_out_b, *w_mem_kv, *w_kv_b, *cmp_pe, *cmp_w1, *cmp_w2, *ln_g, *ln_b, *peer_wq, *peer_keys, *peer_u, *peer_v;
    float *y_prompt, *y_sample, *dil_p[3], *dil_s[3], *nsa_kv_p, *nsa_kv_s, *win_p, *win_s, *mem_kv_p;
    unsigned* ctl;
    bf16 *XB0, *X1B, *X2B, *X3B, *WA_T, *WMEM_T, *MEMB, *WOA_T, *WOB_T, *WPK_T, *WB_T, *CW1_T, *AC; unsigned char *UB8, *VB8;
    float *ROPE, *CBIAS;
    bf16 *QA, *KA, *VTA, *MQA, *MK, *MVT, *ATTA;
    float *DPART, *DML, *PRE, *X1, *X2, *X3, *SCO, *SELG; int* SELE;
    bf16 *SLK, *SLVT, *WNK, *WNVT, *QB, *MQB, *CK, *CVT, *ATTB;
    float *GATES, *UL, *CKF, *CVF;
    int* SELB;
    float* DBG;
};
struct Args { FP p; int lo, hi; };
struct Carve { size_t off = 0; template <class T> T* take(void* base, size_t n) { T* r = (T*)((char*)base + off); off += ((n * sizeof(T) + 255) / 256) * 256; return r; } };
constexpr size_t CTL_BYTES = 65536;
inline size_t carve(FP& p, void* base) {
    Carve c;
    p.ctl = c.take<unsigned>(base, CTL_BYTES / 4);
    p.XB0 = c.take<bf16>(base, (size_t)MPAD * D_MODEL); p.X1B = c.take<bf16>(base, (size_t)MPAD * D_MODEL); p.X2B = c.take<bf16>(base, (size_t)MPAD * D_MODEL); p.X3B = c.take<bf16>(base, (size_t)MPAD * D_MODEL);
    p.WA_T = c.take<bf16>(base, (size_t)ACOLS * D_MODEL); p.WMEM_T = c.take<bf16>(base, (size_t)DEPTH * 2 * MEM_COLS * D_MODEL); p.MEMB = c.take<bf16>(base, (size_t)BATCH * MEM_TOKENS * D_MODEL);
    p.WOA_T = c.take<bf16>(base, (size_t)D_MODEL * 2 * MEM_COLS); p.WOB_T = c.take<bf16>(base, (size_t)D_MODEL * (NSA_Q_COLS + MEM_COLS));
    p.WPK_T = c.take<bf16>(base, (size_t)DEPTH * NPK * D_MODEL); p.WB_T = c.take<bf16>(base, (size_t)NB_T * D_MODEL);
    p.UB8 = c.take<unsigned char>(base, (size_t)DEPTH * PEER_EXPERTS * D_MODEL); p.VB8 = c.take<unsigned char>(base, (size_t)DEPTH * PEER_EXPERTS * D_MODEL);
    p.CW1_T = c.take<bf16>(base, (size_t)2 * 256 * 1024); p.AC = c.take<bf16>(base, (size_t)2 * ACROWS * 1024);
    p.ROPE = c.take<float>(base, (size_t)NPOS * 64); p.CBIAS = c.take<float>(base, 2 * CMP_HIDDEN);
    p.QA = c.take<bf16>(base, (size_t)3 * MPAD * 256); p.KA = c.take<bf16>(base, (size_t)3 * MPAD * 256); p.VTA = c.take<bf16>(base, (size_t)3 * BATCH * DIL_HEADS * HEAD_DIM * SEQ + 4096);
    p.MQA = c.take<bf16>(base, (size_t)MPAD * 256); p.MK = c.take<bf16>(base, (size_t)DEPTH * BATCH * MEM_TOKENS * MEM_COLS); p.MVT = c.take<bf16>(base, (size_t)DEPTH * BATCH * MEM_COLS * MEM_TOKENS);
    p.ATTA = c.take<bf16>(base, (size_t)MPAD * 2 * MEM_COLS);
    p.DPART = c.take<float>(base, (size_t)3 * MP * DIL_HEADS * HEAD_DIM); p.DML = c.take<float>(base, (size_t)3 * MP * DIL_HEADS * 2);
    p.PRE = c.take<float>(base, (size_t)MPAD * D_MODEL); p.X1 = c.take<float>(base, (size_t)MPAD * D_MODEL); p.X2 = c.take<float>(base, (size_t)MPAD * D_MODEL); p.X3 = c.take<float>(base, (size_t)MPAD * D_MODEL);
    p.SCO = c.take<float>(base, (size_t)MPAD * NPK); p.SELG = c.take<float>(base, (size_t)MP * 128); p.SELE = c.take<int>(base, (size_t)MP * 128);
    p.SLK = c.take<bf16>(base, (size_t)BATCH * NSA_KV_HEADS * SEQ * HEAD_DIM); p.SLVT = c.take<bf16>(base, (size_t)BATCH * NSA_KV_HEADS * SEQ * HEAD_DIM);
    p.WNK = c.take<bf16>(base, (size_t)BATCH * NSA_KV_HEADS * SEQ * HEAD_DIM + 4096); p.WNVT = c.take<bf16>(base, (size_t)BATCH * NSA_KV_HEADS * SEQ * HEAD_DIM + 4096);
    p.QB = c.take<bf16>(base, (size_t)MPAD * NSA_Q_COLS); p.MQB = c.take<bf16>(base, (size_t)MPAD * 256);
    p.CK = c.take<bf16>(base, (size_t)NCTX * NSA_KV_HEADS * NCH * HEAD_DIM); p.CVT = c.take<bf16>(base, (size_t)NCTX * NSA_KV_HEADS * HEAD_DIM * NCH); p.ATTB = c.take<bf16>(base, (size_t)MPAD * (NSA_Q_COLS + MEM_COLS));
    p.GATES = c.take<float>(base, (size_t)MPAD * 64); p.UL = c.take<float>(base, (size_t)2 * ACROWS * 256);
    p.CKF = c.take<float>(base, (size_t)DEC_BATCH * NSA_KV_HEADS * NCH * HEAD_DIM); p.CVF = c.take<float>(base, (size_t)DEC_BATCH * NSA_KV_HEADS * NCH * HEAD_DIM);
    p.SELB = c.take<int>(base, (size_t)MP * NSA_KV_HEADS * 16);
#ifdef NSA_DEBUG
    p.DBG = c.take<float>(base, (size_t)3 * MP * 768);
#else
    p.DBG = nullptr;
#endif
    return c.off;
}
inline void bind_io(FP& p, void* const* d_in, float* out) {
    p.x_prompt = (const float*)d_in[0]; p.x_sample = (const float*)d_in[1]; p.mem_prompt = (const float*)d_in[2]; p.cache_dil[0] = (const float*)d_in[3]; p.cache_dil[1] = (const float*)d_in[4]; p.cache_dil[2] = (const float*)d_in[5];
    p.cache_nsa_kv = (const float*)d_in[6]; p.cache_nsa_win = (const float*)d_in[7]; p.cache_mem_kv = (const float*)d_in[8]; p.page_table = (const int*)d_in[9];
    p.w_in_a = (const float*)d_in[10]; p.w_out_a = (const float*)d_in[11]; p.w_in_b = (const float*)d_in[12]; p.w_out_b = (const float*)d_in[13]; p.w_mem_kv = (const float*)d_in[14]; p.w_kv_b = (const float*)d_in[15];
    p.cmp_pe = (const float*)d_in[16]; p.cmp_w1 = (const float*)d_in[17]; p.cmp_w2 = (const float*)d_in[18]; p.ln_g = (const float*)d_in[19]; p.ln_b = (const float*)d_in[20];
    p.peer_wq = (const float*)d_in[21]; p.peer_keys = (const float*)d_in[22]; p.peer_u = (const float*)d_in[23]; p.peer_v = (const float*)d_in[24];
    size_t o = 0; auto take = [&](size_t n) { float* r = out + o; o += n; return r; };
    p.y_prompt = take((size_t)M0 * D_MODEL); p.y_sample = take((size_t)DEC_BATCH * D_MODEL);
    for (int g = 0; g < 3; ++g) p.dil_p[g] = take((size_t)BATCH * DIL_W[g] * 2 * DIL_HEADS * HEAD_DIM);
    for (int g = 0; g < 3; ++g) p.dil_s[g] = take((size_t)DEC_BATCH * DIL_W[g] * 2 * DIL_HEADS * HEAD_DIM);
    p.nsa_kv_p = take((size_t)M0 * 4 * NSA_KV_HEADS * HEAD_DIM); p.nsa_kv_s = take((size_t)DEC_BATCH * 4 * NSA_KV_HEADS * HEAD_DIM);
    p.win_p = take((size_t)BATCH * SWA_WINDOW * 2 * NSA_KV_HEADS * HEAD_DIM); p.win_s = take((size_t)DEC_BATCH * SWA_WINDOW * 2 * NSA_KV_HEADS * HEAD_DIM);
    p.mem_kv_p = take((size_t)DEPTH * BATCH * MEM_TOKENS * 2 * MEM_COLS);
}
DI unsigned f2bf(float f) { unsigned u = __builtin_bit_cast(unsigned, f); return (u + 0x7fffu + ((u >> 16) & 1u)) >> 16; }
DI unsigned pk2(float lo, float hi) { return f2bf(lo) | (f2bf(hi) << 16); }
DI float bf2f(unsigned short b) { return __builtin_bit_cast(float, (unsigned)b << 16); }
DI float bflo(unsigned w) { return __builtin_bit_cast(float, w << 16); }
DI float bfhi(unsigned w) { return __builtin_bit_cast(float, w & 0xffff0000u); }
template <int CTRL> DI float dpp1(float x) { return __builtin_bit_cast(float, __builtin_amdgcn_update_dpp(0, __builtin_bit_cast(int, x), CTRL, 0xF, 0xF, true)); }
DI float wave_sum(float v) { v += dpp1<0xB1>(v); v += dpp1<0x4E>(v); v += dpp1<0x141>(v); v += dpp1<0x140>(v);
    float a = v, b = v; asm volatile("s_nop 1\n\tv_permlane16_swap_b32 %0, %1" : "+v"(a), "+v"(b)); v = a + b; a = v; b = v;
    asm volatile("s_nop 1\n\tv_permlane32_swap_b32 %0, %1" : "+v"(a), "+v"(b)); return a + b; }
DI float wave_max(float v) { v = fmaxf(v, dpp1<0xB1>(v)); v = fmaxf(v, dpp1<0x4E>(v)); v = fmaxf(v, dpp1<0x141>(v)); v = fmaxf(v, dpp1<0x140>(v));
    float a = v, b = v; asm volatile("s_nop 1\n\tv_permlane16_swap_b32 %0, %1" : "+v"(a), "+v"(b)); v = fmaxf(a, b); a = v; b = v;
    asm volatile("s_nop 1\n\tv_permlane32_swap_b32 %0, %1" : "+v"(a), "+v"(b)); return fmaxf(a, b); }
DI float gelu_tanh(float x) { const float u = 0.7978845608028654f * (x + 0.044715f * x * x * x); const float e = __builtin_amdgcn_exp2f(u * 2.885390081777927f);   const float t = 1.0f - 2.0f / (e + 1.0f); return 0.5f * x * (1.0f + t); }
DI float* sel3(float* const (&a)[3], int g) { return g == 0 ? a[0] : (g == 1 ? a[1] : a[2]); }
DI const float* sel3c(const float* const (&a)[3], int g) { return g == 0 ? a[0] : (g == 1 ? a[1] : a[2]); }
__host__ DI size_t ktile_off(int t, int d) { const int blk = t >> 5, kk = t & 31, b = (kk >> 2) & 1, i = 4 * (kk >> 3) + (kk & 3), s = d >> 5, c = (d & 31) >> 3; return ((size_t)(blk * 4 + 2 * b + s) * 64 + i + 16 * c) * 8 + (d & 7); }
__host__ DI size_t vtile_off(int dim, int t) { const int blk = t >> 5, kk = t & 31; return ((size_t)(blk * 4 + (dim >> 4)) * 64 + (dim & 15) + 16 * (kk >> 3)) * 8 + (kk & 7); }
struct Ctx { LAS unsigned char* lds; int tid, lane, wave, vcu, G; };
DI int row_pos(int r) { return r < M0 ? (r & (SEQ - 1)) : PAST_LEN; }

struct ColSrc { const float* p; int ld; };
DI int rope_il(int e) { return (e >> 1) + 32 * (e & 1); }
DI ColSrc col_wa(const FP& P, int n) {
    const int t = n >> 8, ct = n & 255, h = ct >> 6, e = ct & 63; if (t >= 9) return ColSrc{P.w_in_a + DIL_COLS + ct, ACOLS};
    const int j = t % 3, d = (j < 2) ? rope_il(e) : e; return ColSrc{P.w_in_a + t * 256 + h * 64 + d, ACOLS}; }
DI ColSrc col_wb(const FP& P, int n) {
    const int t = n >> 8, ct = n & 255, e = ct & 63;
    if (t < 3) { const int ty = 2 * t + (ct >> 7), kvh = (ct >> 6) & 1; const bool rot = (ty == 2 || ty == 4); return ColSrc{P.w_kv_b + (ty * NSA_KV_HEADS + kvh) * 64 + (rot ? rope_il(e) : e), KVCOLS}; }
    if (t < 6) { const int h = (t - 3) * 4 + (ct >> 6); return ColSrc{P.w_in_b + h * 64 + rope_il(e), BCOLS}; }
    if (t == 6) return ColSrc{P.w_in_b + NSA_Q_COLS + NSA_GATE_COLS + ct, BCOLS};
    if (ct < NSA_GATE_COLS) return ColSrc{P.w_in_b + NSA_Q_COLS + ct, BCOLS};
    return ColSrc{nullptr, 0}; }
DI ColSrc col_wmem(const FP& P, int n) { const int l = n >> 9, c = n & 511; return ColSrc{P.w_mem_kv + (size_t)l * D_MODEL * 512 + c, 512}; }
DI ColSrc col_woa(const FP& P, int n) { return ColSrc{P.w_out_a + n, D_MODEL}; }
DI ColSrc col_wob(const FP& P, int n) { return ColSrc{P.w_out_b + n, D_MODEL}; }
DI ColSrc col_cw1(const FP& P, int n) {
    const int ty = n >> 8, half = (n >> 7) & 1, hid = n & 127; return ColSrc{P.cmp_w1 + (size_t)ty * CMP_BLOCK * HEAD_DIM * CMP_HIDDEN + (size_t)half * 16 * HEAD_DIM * CMP_HIDDEN + hid, CMP_HIDDEN}; }
template <class CF> DI void transpose_item(const FP& P, CF cf, int K, bf16* WT, LAS float* scr, int item, int nblk, int lane) {
    const int kb = item / nblk, nb = item % nblk, k0 = 64 * kb, n0 = 32 * nb;
    const ColSrc cs = cf(P, n0 + (lane & 31));
#pragma unroll 8
    for (int i = 0; i < 32; ++i) { const int kk = 2 * i + (lane >> 5); scr[kk * 33 + (lane & 31)] = cs.p ? cs.p[(size_t)(k0 + kk) * cs.ld] : 0.f; }
    asm volatile("s_waitcnt lgkmcnt(0)" ::: "memory");
    const int c = lane & 7;
#pragma unroll
    for (int j = 0; j < 4; ++j) { const int n = (lane >> 3) + 8 * j; const LAS float* s = scr + (8 * c) * 33 + n;
        u32x4 o; o.x = pk2(s[0 * 33], s[1 * 33]); o.y = pk2(s[2 * 33], s[3 * 33]); o.z = pk2(s[4 * 33], s[5 * 33]); o.w = pk2(s[6 * 33], s[7 * 33]);
        *(u32x4*)(WT + (size_t)(n0 + n) * K + k0 + 8 * c) = o; }
    asm volatile("s_waitcnt lgkmcnt(0)" ::: "memory");
}
DI void cvt_row1024(const float* src, bf16* dst, int lane) {
#pragma unroll
    for (int j = 0; j < 4; ++j) { f32x4 v = src ? *(const f32x4*)(src + 256 * j + 4 * lane) : (f32x4){0.f, 0.f, 0.f, 0.f}; u32x2 o; o.x = pk2(v.x, v.y); o.y = pk2(v.z, v.w); *(u32x2*)(dst + 256 * j + 4 * lane) = o; }
}
DI void cvt_row1024_fp8(const float* src, unsigned char* dst, float sc, int lane) { u32x4 o; unsigned w[4];
#pragma unroll
    for (int j = 0; j < 4; ++j) { const f32x4 v = *(const f32x4*)(src + 16 * lane + 4 * j) * sc; int t = __builtin_amdgcn_cvt_pk_fp8_f32(v.x, v.y, 0, false); t = __builtin_amdgcn_cvt_pk_fp8_f32(v.z, v.w, t, true); w[j] = (unsigned)t; }
    o.x = w[0]; o.y = w[1]; o.z = w[2]; o.w = w[3]; *(u32x4*)(dst + 16 * lane) = o; }
DI void p0_prologue(const FP& P, const Ctx& C) {
    LAS float* scr = (LAS float*)(C.lds + C.wave * 16384);
    const int gw = C.vcu * NWAVES + C.wave, NGW = C.G * NWAVES, lane = C.lane;
    { constexpr int IA = (D_MODEL / 64) * (ACOLS / 32), IM = (D_MODEL / 64) * (1024 / 32), IOA = (512 / 64) * (D_MODEL / 32), IOB = (1024 / 64) * (D_MODEL / 32), IB = (D_MODEL / 64) * (NB_T / 32), IC = (1024 / 64) * (512 / 32);
      constexpr int NIT = IA + IM + IOA + IOB + IB + IC;
      for (int it = gw; it < NIT; it += NGW) { int r = it;
          if (r < IA) { transpose_item(P, col_wa, D_MODEL, P.WA_T, scr, r, ACOLS / 32, lane); continue; } r -= IA;
          if (r < IM) { transpose_item(P, col_wmem, D_MODEL, P.WMEM_T, scr, r, 1024 / 32, lane); continue; } r -= IM;
          if (r < IOA) { transpose_item(P, col_woa, 512, P.WOA_T, scr, r, D_MODEL / 32, lane); continue; } r -= IOA;
          if (r < IOB) { transpose_item(P, col_wob, 1024, P.WOB_T, scr, r, D_MODEL / 32, lane); continue; } r -= IOB;
          if (r < IB) { transpose_item(P, col_wb, D_MODEL, P.WB_T, scr, r, NB_T / 32, lane); continue; } r -= IB;
          transpose_item(P, col_cw1, 1024, P.CW1_T, scr, r, 512 / 32, lane); } }
    for (int r = gw; r < M0 - NGW; r += 2 * NGW) {
        f32x4 v[8];
#pragma unroll
        for (int j = 0; j < 8; ++j) v[j] = *(const f32x4*)(P.x_prompt + (size_t)(r + (j >> 2) * NGW) * D_MODEL + 256 * (j & 3) + 4 * lane);
#pragma unroll
        for (int j = 0; j < 8; ++j) { u32x2 o; o.x = pk2(v[j].x, v[j].y); o.y = pk2(v[j].z, v[j].w); *(u32x2*)(P.XB0 + (size_t)(r + (j >> 2) * NGW) * D_MODEL + 256 * (j & 3) + 4 * lane) = o; } }
    for (int r = gw + ((M0 - NGW - gw + 2 * NGW - 1) / (2 * NGW)) * (2 * NGW); r < MPAD; r += NGW) { cvt_row1024(r < M0 ? P.x_prompt + (size_t)r * D_MODEL : (r < MP ? P.x_sample + (size_t)(r - M0) * D_MODEL : nullptr), P.XB0 + (size_t)r * D_MODEL, lane);
        if (r >= MP) { cvt_row1024(nullptr, P.X1B + (size_t)r * D_MODEL, lane); cvt_row1024(nullptr, P.X2B + (size_t)r * D_MODEL, lane); cvt_row1024(nullptr, P.X3B + (size_t)r * D_MODEL, lane);
            for (int c = lane; c < 512; c += 64) { P.ATTA[(size_t)r * 512 + c] = 0; P.ATTB[(size_t)r * 1024 + c] = 0; P.ATTB[(size_t)r * 1024 + 512 + c] = 0; } } }
    for (int r = gw; r < BATCH * MEM_TOKENS; r += NGW) cvt_row1024(P.mem_prompt + (size_t)r * D_MODEL, P.MEMB + (size_t)r * D_MODEL, lane);
    for (int i = gw * 64 + lane; i < NPOS * 32; i += NGW * 64) { const int pos = i >> 5, d = i & 31; const double inv = exp2(-(double)d * (13.287712379549449 / 32.0)); const double turns = (double)pos * inv * 0.15915494309189535;
        const float fr = (float)(turns - floor(turns)); P.ROPE[pos * 64 + d] = __builtin_amdgcn_cosf(fr); P.ROPE[pos * 64 + 32 + d] = __builtin_amdgcn_sinf(fr); }
    const int gwT = C.wave * C.G + C.vcu;
    for (int i = gwT; i < 2 * CMP_HIDDEN; i += NGW) { const int ty = i / CMP_HIDDEN, hid = i % CMP_HIDDEN; float a = 0.f;
#pragma unroll 8
        for (int k = lane; k < CMP_BLOCK * HEAD_DIM; k += 64) a += P.cmp_pe[ty * CMP_BLOCK * HEAD_DIM + k] * P.cmp_w1[((size_t)ty * CMP_BLOCK * HEAD_DIM + k) * CMP_HIDDEN + hid];
        a = wave_sum(a); if (lane == 0) P.CBIAS[i] = a; }
    for (int it2 = gwT; it2 < DEC_BATCH * (PAST_LEN / PAGE_SIZE) * (PAGE_SIZE / 8); it2 += NGW) { const int it = it2 / (PAGE_SIZE / 8), rg = it2 % (PAGE_SIZE / 8);
        const int n = it / (PAST_LEN / PAGE_SIZE), pi = it % (PAST_LEN / PAGE_SIZE); const int pg = P.page_table[it];
        const float* src = P.cache_nsa_kv + (size_t)pg * PAGE_SIZE * 512 + 4 * lane; const int ty = lane >> 5, kvh = (lane >> 4) & 1, d = (4 * lane) & 63;
        bf16* dst = P.AC + ((size_t)ty * ACROWS + ((size_t)(BATCH + n) * NSA_KV_HEADS + kvh) * NCH + pi * (PAGE_SIZE / 16)) * 1024 + d;
        { const int r0 = rg * 8; f32x4 v[8];
#pragma unroll
            for (int u = 0; u < 8; ++u) v[u] = *(const f32x4*)(src + (size_t)(r0 + u) * 512);
#pragma unroll
            for (int u = 0; u < 8; ++u) { const int t = r0 + u; u32x2 o; o.x = pk2(v[u].x, v[u].y); o.y = pk2(v[u].z, v[u].w); *(u32x2*)(dst + (size_t)(t / 16) * 1024 + (t % 16) * 64) = o; } } }
}
constexpr int BGQ_UV = DEPTH * PEER_EXPERTS / 32;
constexpr int bgq_cache_n(int g) { return (DEC_BATCH * ((g < 3 ? dil_w(g) : SWA_WINDOW) - 1) * (g < 3 ? 128 : 64) + 8191) / 8192; }
constexpr int BGQ_TOTAL = BGQ_UV + bgq_cache_n(0) + bgq_cache_n(1) + bgq_cache_n(2) + bgq_cache_n(3);
constexpr int BGQ_CTR = 12288;
DI void bg_chunk(const FP& P, const Ctx& C, int c) {
    const int lane = C.lane;
    if (c < BGQ_UV) {
#pragma unroll 1
        for (int it = 0; it < 2; ++it) { const int r = c * 32 + C.wave * 4 + 2 * it; f32x4 a[16];
#pragma unroll
            for (int q = 0; q < 4; ++q) { const float* s0 = (q < 2 ? P.peer_u : P.peer_v) + (size_t)(r + (q & 1)) * D_MODEL + 16 * lane;
#pragma unroll
                for (int j = 0; j < 4; ++j) a[4 * q + j] = *(const f32x4*)(s0 + 4 * j); }
#pragma unroll
            for (int q = 0; q < 4; ++q) { const float sc = q < 2 ? 256.f : 64.f; unsigned w[4];
#pragma unroll
                for (int j = 0; j < 4; ++j) { const f32x4 v = a[4 * q + j] * sc; int t = __builtin_amdgcn_cvt_pk_fp8_f32(v.x, v.y, 0, false); t = __builtin_amdgcn_cvt_pk_fp8_f32(v.z, v.w, t, true); w[j] = (unsigned)t; }
                u32x4 o; o.x = w[0]; o.y = w[1]; o.z = w[2]; o.w = w[3]; *(u32x4*)((q < 2 ? P.UB8 : P.VB8) + (size_t)(r + (q & 1)) * D_MODEL + 16 * lane) = o; } }
        return; }
    c -= BGQ_UV;
    int g = 0; if (c >= bgq_cache_n(0)) { c -= bgq_cache_n(0); g = 1; if (c >= bgq_cache_n(1)) { c -= bgq_cache_n(1); g = 2; if (c >= bgq_cache_n(2)) { c -= bgq_cache_n(2); g = 3; } } }
    const int W = g < 3 ? dil_w(g) : SWA_WINDOW, RV = g < 3 ? 128 : 64;
    const f32x4* src = (const f32x4*)(g < 3 ? sel3c(P.cache_dil, g) : P.cache_nsa_win); f32x4* dst = (f32x4*)(g < 3 ? sel3(P.dil_s, g) : P.win_s);
    const int per = (W - 1) * RV, nvec = DEC_BATCH * per;
    const int i0 = c * 8192 + C.wave * 1024;
    if (i0 < nvec) { f32x4 v[16]; int idx[16];
        const int n0 = __builtin_amdgcn_readfirstlane((int)((unsigned)i0 / (unsigned)per)), o0 = i0 - n0 * per;
#pragma unroll
        for (int u = 0; u < 16; ++u) { int o = o0 + u * 64 + lane, n = n0; if (o >= per) { o -= per; ++n; } if (n >= DEC_BATCH) { n = DEC_BATCH - 1; o = per - 1; } idx[u] = n * (per + RV) + o; v[u] = src[(size_t)idx[u] + RV]; }
#pragma unroll
        for (int u = 0; u < 16; ++u) { const int i = i0 + u * 64 + lane; if (i < nvec) dst[(size_t)idx[u]] = v[u]; } }
}
DI void bgq_drain(const FP& P, const Ctx& C, volatile LAS unsigned* slot, int limit) {
#pragma unroll 1
    for (;;) {
        __syncthreads();
        if (C.tid == 0) *slot = atomicAdd(P.ctl + BGQ_CTR, 1u);
        __syncthreads();
        const int c = (int)*slot;
        if (c < BGQ_TOTAL) bg_chunk(P, C, c);
        if (c >= limit) break;
    }
    __syncthreads();
}
DI void xcd_barrier_bg(const XcdBarrier& b, const FP& P, const Ctx& C, volatile LAS unsigned* slot  ) {
    asm volatile("s_waitcnt vmcnt(0)" ::: "memory");
    __syncthreads();
    if (threadIdx.x == 0) {
        unsigned* bar = b.bar;
        __builtin_amdgcn_s_waitcnt(0);
        unsigned nloc = b.st[0], nx = b.st[1];
        if (nloc == 0u) { xcd_barrier_complete(bar, b.x, nloc, nx); b.st[0] = nloc; b.st[1] = nx; }
        const unsigned old = xb_add(&bar[XB_XSUB(b.x)], 1u);
        const unsigned gen = old / nloc;
        if (old + 1u == (gen + 1u) * nloc) {
            __builtin_amdgcn_fence(__ATOMIC_RELEASE, "agent");
            asm volatile("s_waitcnt vmcnt(0)" ::: "memory");
            const unsigned og = xb_add(&bar[XB_TOP], 1u);
            const unsigned tg = og / nx;
            if (og + 1u == (tg + 1u) * nx) xb_add(&bar[XB_TOPGEN], 1u);
            else XB_SPIN(xb_ld(&bar[XB_TOPGEN]) == tg, bar);
            __builtin_amdgcn_fence(__ATOMIC_ACQUIRE, "agent");
            xb_add(&bar[XB_XGEN(b.x)], 1u);
            asm volatile("s_waitcnt vmcnt(0)" ::: "memory");
            slot[2] = 1u;
        } else { slot[1] = gen; slot[2] = 0u; }
    }
    __syncthreads();
    unsigned spins = 0;
#pragma unroll 1
    while (slot[2] == 0u) {
        if (threadIdx.x == 0) {
            unsigned c = (unsigned)BGQ_TOTAL;
            if (xb_ld(&b.bar[XB_XGEN(b.x)]) != slot[1] || xb_ld(&b.bar[XB_TMO]) != 0u) {
                __builtin_amdgcn_fence(__ATOMIC_ACQUIRE, "agent");
                asm volatile("s_waitcnt vmcnt(0)" ::: "memory");
                slot[2] = 1u;
            } else if (xb_ld(P.ctl + BGQ_CTR) < (unsigned)BGQ_TOTAL) c = atomicAdd(P.ctl + BGQ_CTR, 1u);
            else { __builtin_amdgcn_s_sleep(1); if (++spins > XB_SPIN_CAP) { atomicAdd(&b.bar[XB_TMO], 1u); } }
            slot[0] = c;
        }
        __syncthreads();
        const bool rel = slot[2] != 0u; const int c = (int)slot[0];
        if (!rel && c < BGQ_TOTAL) bg_chunk(P, C, c);
        __syncthreads();
    }
}
DI void p0_wpk(const FP& P, const Ctx& C) {
    LAS float* sw = (LAS float*)C.lds;
    LAS float* sk = (LAS float*)(C.lds + 32768);
    constexpr int NIT = DEPTH * 16 * (D_MODEL / 64);
    for (int it = C.vcu; it < NIT; it += C.G) { const int l = it / (16 * (D_MODEL / 64)), rem = it % (16 * (D_MODEL / 64)), hc = rem / (D_MODEL / 64), kb = rem % (D_MODEL / 64);
        __syncthreads();
        for (int i = C.tid; i < 64 * 64; i += NTHREADS) { const int r = i >> 6, d = i & 63; sw[r * 65 + d] = P.peer_wq[((size_t)l * D_MODEL + kb * 64 + r) * 1024 + hc * 64 + d]; }
        for (int i = C.tid; i < 128 * 64; i += NTHREADS) { const int r = i >> 6, d = i & 63; sk[r * 68 + d] = P.peer_keys[(((size_t)l * 16 + hc) * PEER_KEYS + r) * 64 + d]; }
        __syncthreads();
        { const int ki = C.lane, kk0 = C.wave; float a[16];
#pragma unroll
          for (int j = 0; j < 16; ++j) a[j] = 0.f;
#pragma unroll 2
          for (int d = 0; d < 64; d += 4) { const float w0 = sw[ki * 65 + d], w1 = sw[ki * 65 + d + 1], w2 = sw[ki * 65 + d + 2], w3 = sw[ki * 65 + d + 3];
#pragma unroll
              for (int j = 0; j < 16; ++j) { const f32x4 kq = *(const LAS f32x4*)(sk + (kk0 + 8 * j) * 68 + d); a[j] += w0 * kq.x + w1 * kq.y + w2 * kq.z + w3 * kq.w; } }
#pragma unroll
          for (int j = 0; j < 16; ++j) P.WPK_T[((size_t)l * NPK + hc * 128 + kk0 + 8 * j) * D_MODEL + kb * 64 + ki] = (bf16)f2bf(a[j]); } }
    __syncthreads();
}

#define EPI_LOOP(...) int fr_l = fr, fq_l = fq; asm volatile("" : "+v"(fr_l), "+v"(fq_l));     \
    _Pragma("unroll") for (int ai = 0; ai < 2; ++ai) _Pragma("unroll") for (int m = 0; m < 4; ++m) { const int row = u.pm * 256 + ai * 128 + wr * 64 + m * 16 + fr_l; \
    _Pragma("unroll") for (int bj = 0; bj < 2; ++bj) { const int ct = bj * 128 + wc * 32 + fq_l * 8; const f32x4 v0 = acc[ai][bj][m][0], v1 = acc[ai][bj][m][1]; __VA_ARGS__ } asm volatile("" ::: "memory"); }
DI void rope4(const float* rope_row, int dp, const f32x4& v0, const f32x4& v1, f32x4& lo, f32x4& hi) {
    const f32x4 c = *(const f32x4*)(rope_row + dp), s = *(const f32x4*)(rope_row + 32 + dp);
    lo.x = v0.x * c.x - v0.y * s.x; hi.x = v0.y * c.x + v0.x * s.x; lo.y = v0.z * c.y - v0.w * s.y; hi.y = v0.w * c.y + v0.z * s.y;
    lo.z = v1.x * c.z - v1.y * s.z; hi.z = v1.y * c.z + v1.x * s.z; lo.w = v1.z * c.w - v1.w * s.w; hi.w = v1.w * c.w + v1.z * s.w; }
DI u32x2 pk4(const f32x4& v) { u32x2 o; o.x = pk2(v.x, v.y); o.y = pk2(v.z, v.w); return o; }
DI u32x4 pk8(const f32x4& a, const f32x4& b) { u32x4 o; o.x = pk2(a.x, a.y); o.y = pk2(a.z, a.w); o.z = pk2(b.x, b.y); o.w = pk2(b.z, b.w); return o; }
DI int dil_perm(int t, int d) { return (t % d) * (SEQ / d) + t / d; }
#ifdef EPIA_REP
#define EPIA_REP_BEGIN _Pragma("unroll 1") for (int rep_ = 0; rep_ < EPIA_REP; ++rep_) {
#define EPIA_REP_END }
#else
#define EPIA_REP_BEGIN
#define EPIA_REP_END
#endif
struct EpiA {
    static constexpr bool PERM = true, AFTER_DRAIN = false; const FP& P;
    DI void operator()(const f32x4 (&acc)[2][2][4][2], const pg8::Unit& u, int wr, int wc, int fr, int fq) const {
        const int t9 = u.pn; const int g = t9 / 3, j = t9 % 3;
        EPIA_REP_BEGIN EPI_LOOP({ if (row < MP) { const int h = ct >> 6, e = ct & 63; const int pos = row_pos(row);
            if (t9 == 9) { *(u32x4*)(P.MQA + (size_t)row * 256 + ct) = pk8(v0 * QSCALE, v1 * QSCALE); }
            else if (j < 2) { f32x4 lo, hi; const int dp = e >> 1; rope4(P.ROPE + pos * 64, dp, v0, v1, lo, hi);
                if (j == 0) { bf16* q = P.QA + ((size_t)g * MPAD + row) * 256 + h * 64 + dp; *(u32x2*)q = pk4(lo * QSCALE); *(u32x2*)(q + 32) = pk4(hi * QSCALE); }
                else { if (row < M0) { bf16* kt = P.KA + ((size_t)(g * BATCH + row / SEQ) * DIL_HEADS + h) * 64 * SEQ; const int cm = dil_perm(pos, dil_d(g)); *(u32x2*)(kt + ktile_off(cm, dp)) = pk4(lo); *(u32x2*)(kt + ktile_off(cm, dp + 32)) = pk4(hi); }
                    const int W = dil_w(g); float* o = nullptr;
                    if (row >= M0) o = sel3(P.dil_s, g) + (((size_t)(row - M0) * W + W - 1) * 2 + 0) * 256; else if (pos >= SEQ - W) o = sel3(P.dil_p, g) + (((size_t)(row / SEQ) * W + pos - (SEQ - W)) * 2 + 0) * 256;
                    if (o) { *(f32x4*)(o + h * 64 + dp) = lo; *(f32x4*)(o + h * 64 + 32 + dp) = hi; } } }
            else { const int W = dil_w(g), d = dil_d(g); float* o = nullptr;
                if (row >= M0) o = sel3(P.dil_s, g) + (((size_t)(row - M0) * W + W - 1) * 2 + 1) * 256; else if (pos >= SEQ - W) o = sel3(P.dil_p, g) + (((size_t)(row / SEQ) * W + pos - (SEQ - W)) * 2 + 1) * 256;
                if (o) { *(f32x4*)(o + ct) = v0; *(f32x4*)(o + ct + 4) = v1; }
                if (row < M0) { bf16* vt = P.VTA + ((size_t)(g * BATCH + row / SEQ) * DIL_HEADS + h) * 64 * SEQ + vtile_off(e, dil_perm(pos, d));
                    vt[0] = (bf16)f2bf(v0.x); vt[8] = (bf16)f2bf(v0.y); vt[16] = (bf16)f2bf(v0.z); vt[24] = (bf16)f2bf(v0.w); vt[32] = (bf16)f2bf(v1.x); vt[40] = (bf16)f2bf(v1.y); vt[48] = (bf16)f2bf(v1.z); vt[56] = (bf16)f2bf(v1.w); } } } }) EPIA_REP_END
    }
};
struct EpiMem {
    static constexpr bool PERM = true, AFTER_DRAIN = false; const FP& P;
    DI void operator()(const f32x4 (&acc)[2][2][4][2], const pg8::Unit& u, int wr, int wc, int fr, int fq) const {
        const int l = u.pn >> 1, half = u.pn & 1;
        EPI_LOOP({ const int n = row / MEM_TOKENS, mt = row % MEM_TOKENS; float* o = P.mem_kv_p + (((size_t)l * BATCH + n) * MEM_TOKENS + mt) * 512 + half * 256 + ct; *(f32x4*)o = v0; *(f32x4*)(o + 4) = v1;
            if (half == 0) *(u32x4*)(P.MK + (((size_t)l * BATCH + n) * MEM_HEADS + (ct >> 6)) * MEM_TOKENS * 64 + ktile_off(mt, ct & 63)) = pk8(v0, v1);
            else { bf16* vt = P.MVT + (((size_t)l * BATCH + n) * MEM_HEADS + (ct >> 6)) * MEM_TOKENS * 64 + vtile_off(ct & 63, mt);
                vt[0] = (bf16)f2bf(v0.x); vt[8] = (bf16)f2bf(v0.y); vt[16] = (bf16)f2bf(v0.z); vt[24] = (bf16)f2bf(v0.w); vt[32] = (bf16)f2bf(v1.x); vt[40] = (bf16)f2bf(v1.y); vt[48] = (bf16)f2bf(v1.z); vt[56] = (bf16)f2bf(v1.w); } })
    }
};
struct EpiPre {
    static constexpr bool PERM = true, AFTER_DRAIN = false; const float* xa; const float* xb; float* pre;
    DI void operator()(const f32x4 (&acc)[2][2][4][2], const pg8::Unit& u, int wr, int wc, int fr, int fq) const {
        EPI_LOOP({ if (row < MP) { const int col = u.pn * 256 + ct; const float* x = (xb && row >= M0) ? xb + (size_t)(row - M0) * D_MODEL + col : xa + (size_t)row * D_MODEL + col;
            const f32x4 a = *(const f32x4*)x, b = *(const f32x4*)(x + 4); float* o = pre + (size_t)row * D_MODEL + col; *(f32x4*)o = a * ALPHA + v0; *(f32x4*)(o + 4) = b * ALPHA + v1; } })
    }
};
struct EpiF32 {
    static constexpr bool PERM = true, AFTER_DRAIN = false; float* out; int ldc; int nrows;
    DI void operator()(const f32x4 (&acc)[2][2][4][2], const pg8::Unit& u, int wr, int wc, int fr, int fq) const {
        EPI_LOOP({ if (row < nrows) { float* o = out + (size_t)row * ldc + u.pn * 256 + ct; *(f32x4*)o = v0; *(f32x4*)(o + 4) = v1; } })
    }
};
}
namespace fx {
struct Tile16 { f32x4 o[4]; float m, l; };
DI void tile_init(Tile16& T) { T.o[0] = T.o[1] = T.o[2] = T.o[3] = (f32x4){0.f, 0.f, 0.f, 0.f}; T.m = -INFINITY; T.l = 0.f; }
typedef __bf16 bf16x2_t __attribute__((ext_vector_type(2)));
DI unsigned cvtpk(float lo, float hi) { const f32x2 v = {lo, hi}; const bf16x2_t b = __builtin_convertvector(v, bf16x2_t); return __builtin_bit_cast(unsigned, b); }
struct KV8 { bf16x8 ka0, ka1, kb0, kb1, v0, v1, v2, v3; };
DI void kv_load(KV8& r, const bf16* k0, const bf16* k1, const bf16* v, long vs16) {
    r.ka0 = *(const bf16x8*)k0; r.ka1 = *(const bf16x8*)(k0 + 32); r.kb0 = *(const bf16x8*)k1; r.kb1 = *(const bf16x8*)(k1 + 32);
    r.v0 = *(const bf16x8*)v; r.v1 = *(const bf16x8*)(v + vs16); r.v2 = *(const bf16x8*)(v + 2 * vs16); r.v3 = *(const bf16x8*)(v + 3 * vs16); }
DI void mk_range(int a, int b, bool ok, int& lo, unsigned& rng) { const bool v = ok && b >= a; lo = v ? a : (1 << 20); rng = v ? (unsigned)(b - a) : 0u; }
DI float colmax(float x) { float a = x, b = x; asm volatile("s_nop 1\n\tv_permlane32_swap_b32 %0, %1" : "+v"(a), "+v"(b)); float m = fmaxf(a, b); a = m; b = m;
    asm volatile("s_nop 1\n\tv_permlane16_swap_b32 %0, %1" : "+v"(a), "+v"(b)); return fmaxf(a, b); }
DI float colsum(float x) { float a = x, b = x; asm volatile("s_nop 1\n\tv_permlane32_swap_b32 %0, %1" : "+v"(a), "+v"(b)); float m = a + b; a = m; b = m;
    asm volatile("s_nop 1\n\tv_permlane16_swap_b32 %0, %1" : "+v"(a), "+v"(b)); return a + b; }
DI void tile_compute(Tile16& T, const bf16x8 (&qf)[2], const KV8& r, int lo, unsigned rng) {
    f32x4 s0 = (f32x4){0.f, 0.f, 0.f, 0.f}, s1 = (f32x4){0.f, 0.f, 0.f, 0.f};
    s0 = __builtin_amdgcn_mfma_f32_16x16x32_bf16(r.ka0, qf[0], s0, 0, 0, 0); s0 = __builtin_amdgcn_mfma_f32_16x16x32_bf16(r.ka1, qf[1], s0, 0, 0, 0);
    s1 = __builtin_amdgcn_mfma_f32_16x16x32_bf16(r.kb0, qf[0], s1, 0, 0, 0); s1 = __builtin_amdgcn_mfma_f32_16x16x32_bf16(r.kb1, qf[1], s1, 0, 0, 0);
    float s[8] = {s0.x, s0.y, s0.z, s0.w, s1.x, s1.y, s1.z, s1.w};
    float mx = -INFINITY;
#pragma unroll
    for (int e = 0; e < 8; ++e) { s[e] = ((unsigned)(e - lo) <= rng) ? s[e] : -INFINITY; mx = fmaxf(mx, s[e]); }
    mx = colmax(mx);
    const float mnew = fmaxf(T.m, mx), muse = (mnew == -INFINITY) ? 0.f : mnew;
    const float alpha = __builtin_amdgcn_exp2f(T.m - muse);
    float ls = 0.f;
#pragma unroll
    for (int e = 0; e < 8; ++e) { s[e] = __builtin_amdgcn_exp2f(s[e] - muse); ls += s[e]; }
    T.l = T.l * alpha + ls; T.m = mnew;
    u32x4 pw; pw.x = cvtpk(s[0], s[1]); pw.y = cvtpk(s[2], s[3]); pw.z = cvtpk(s[4], s[5]); pw.w = cvtpk(s[6], s[7]);
    const bf16x8 pf = __builtin_bit_cast(bf16x8, pw);
    T.o[0] = __builtin_amdgcn_mfma_f32_16x16x32_bf16(r.v0, pf, T.o[0] * alpha, 0, 0, 0); T.o[1] = __builtin_amdgcn_mfma_f32_16x16x32_bf16(r.v1, pf, T.o[1] * alpha, 0, 0, 0);
    T.o[2] = __builtin_amdgcn_mfma_f32_16x16x32_bf16(r.v2, pf, T.o[2] * alpha, 0, 0, 0); T.o[3] = __builtin_amdgcn_mfma_f32_16x16x32_bf16(r.v3, pf, T.o[3] * alpha, 0, 0, 0);
}
template <class BUF, class LD, class CP> DI void pipe2t(int n, LD ld, CP cp) { if (n <= 0) return; BUF A, B; ld(A, 0);
#pragma unroll 1
    for (int i = 0; i < n; i += 2) { ld(B, (i + 1 < n) ? i + 1 : i); cp(A, i); ld(A, (i + 2 < n) ? i + 2 : i); if (i + 1 < n) cp(B, i + 1); } }
template <class LD, class CP> DI void pipe2(int n, LD ld, CP cp) { if (n <= 0) return; KV8 A, B; ld(A, 0);
#pragma unroll 1
    for (int i = 0; i < n; i += 2) { ld(B, (i + 1 < n) ? i + 1 : i); cp(A, i); ld(A, (i + 2 < n) ? i + 2 : i); if (i + 1 < n) cp(B, i + 1); } }
DI void kv_load_t(KV8& r, const bf16* kt, const bf16* vt, int lane) {
    const bf16* k = kt + lane * 8; const bf16* v = vt + lane * 8;
    r.ka0 = *(const bf16x8*)k; r.ka1 = *(const bf16x8*)(k + 512); r.kb0 = *(const bf16x8*)(k + 1024); r.kb1 = *(const bf16x8*)(k + 1536);
    r.v0 = *(const bf16x8*)v; r.v1 = *(const bf16x8*)(v + 512); r.v2 = *(const bf16x8*)(v + 1024); r.v3 = *(const bf16x8*)(v + 1536); }
DI int krow_of(int i, int b) { return 8 * (i >> 2) + 4 * b + (i & 3); }

DI void dil_micro(const FP& P, int n, int h, int t0, int mt, int lane) {
    const int g = mt >> 4, idx = mt & 15, d = dil_d(g), per = 16 / d;
    const int r = idx / per, sub = idx % per, i0 = t0 / d + 16 * sub, ib = i0 - 128, NC = SEQ / d;
    const int q = lane & 15, c = lane >> 4;
    const bf16* Qb = P.QA + ((size_t)g * MPAD + (size_t)n * SEQ) * 256 + h * 64;
    const bf16* Kb = P.KA + ((size_t)(g * BATCH + n) * DIL_HEADS + h) * 64 * SEQ + (size_t)r * NC * 64; const bf16* Vb = P.VTA + ((size_t)(g * BATCH + n) * DIL_HEADS + h) * 64 * SEQ + (size_t)r * NC * 64;
    bf16x8 qf[2]; { const bf16* qp = Qb + (size_t)(r + d * (i0 + q)) * 256 + 8 * c; qf[0] = *(const bf16x8*)qp; qf[1] = *(const bf16x8*)(qp + 32); }
    Tile16 T; tile_init(T);
    const int qi = i0 + q; const int tb0 = ib >> 5  , nblk = ((i0 + 15) >> 5) - tb0 + 1;
    pipe2(nblk, [&](KV8& kv, int i) { int tb = tb0 + i; tb = tb < 0 ? 0 : tb; kv_load_t(kv, Kb + (size_t)tb * 2048, Vb + (size_t)tb * 2048, lane); },
          [&](const KV8& kv, int i) { const int k0 = 32 * (tb0 + i) + 8 * c; int lo; unsigned rng; const int a = qi - (DIL_TAPS - 1); mk_range((a > 0 ? a : 0) - k0, qi - k0, true, lo, rng); tile_compute(T, qf, kv, lo, rng); });
    const int row = n * SEQ + r + d * qi;
    float* op = P.DPART + (((size_t)g * MP + row) * DIL_HEADS + h) * 64 + 4 * c;
#pragma unroll
    for (int db = 0; db < 4; ++db) *(f32x4*)(op + 16 * db) = T.o[db];
    T.l = colsum(T.l);
    if (c == 0) { float* ml = P.DML + (((size_t)g * MP + row) * DIL_HEADS + h) * 2; ml[0] = T.m; ml[1] = T.l; }
}
DI void mem_micro(const FP& P, const bf16* Q  , int ldq, int row0, int layer, int n, int h, bf16* O  , int ldo, int lane) {
    const int q = lane & 15, c = lane >> 4;
    bf16x8 qf[2]; { const bf16* qp = Q + (size_t)(row0 + q) * ldq + 8 * c; qf[0] = *(const bf16x8*)qp; qf[1] = *(const bf16x8*)(qp + 32); }
    const bf16* Kb = P.MK + (((size_t)layer * BATCH + n) * MEM_HEADS + h) * MEM_TOKENS * 64; const bf16* Vb = P.MVT + (((size_t)layer * BATCH + n) * MEM_HEADS + h) * MEM_TOKENS * 64;
    Tile16 T; tile_init(T);
    pipe2(MEM_TOKENS / 32, [&](KV8& kv, int i) { kv_load_t(kv, Kb + (size_t)i * 2048, Vb + (size_t)i * 2048, lane); }, [&](const KV8& kv, int) { tile_compute(T, qf, kv, -8, 64u); });
    const float inv = 1.0f / colsum(T.l); bf16* op = O + (size_t)(row0 + q) * ldo + 4 * c;
#pragma unroll
    for (int db = 0; db < 4; ++db) *(u32x2*)(op + 16 * db) = pk4(T.o[db] * inv);
}
struct Dec { float m, l, o; };
template <class KF, class VF> DI void dec_chunk(Dec& D, const LAS float* q, int nk, KF kf, VF vf, int lane) {
    float s = -INFINITY;
    if (lane < nk) { const float* k = kf(lane); float a = 0.f;
#pragma unroll
        for (int d4 = 0; d4 < 16; ++d4) { const f32x4 kv = *(const f32x4*)(k + 4 * d4); a += kv.x * q[4 * d4] + kv.y * q[4 * d4 + 1] + kv.z * q[4 * d4 + 2] + kv.w * q[4 * d4 + 3]; }
        s = a; }
    const float mx = wave_max(s), mnew = fmaxf(D.m, mx), alpha = __builtin_amdgcn_exp2f(D.m - mnew);
    const float p = (lane < nk) ? __builtin_amdgcn_exp2f(s - mnew) : 0.f;
    D.l = D.l * alpha + wave_sum(p); D.m = mnew; float o = D.o * alpha;
    for (int j0 = 0; j0 < nk; j0 += 8) { float vv[8];
#pragma unroll
        for (int u = 0; u < 8; ++u) { const int jj = (j0 + u < nk) ? j0 + u : nk - 1; vv[u] = vf(jj)[lane]; }
#pragma unroll
        for (int u = 0; u < 8; ++u) { const float pj = (j0 + u < nk) ? __builtin_bit_cast(float, __builtin_amdgcn_readlane(__builtin_bit_cast(int, p), (j0 + u) & 63)) : 0.f; o += pj * vv[u]; } }
    D.o = o;
}
DI float dec_combine(const Ctx& C, const Dec& D) {
    LAS float* cb = (LAS float*)(C.lds + 4096);
    cb[C.wave * 66 + C.lane] = D.o; if (C.lane == 0) { cb[C.wave * 66 + 64] = D.m; cb[C.wave * 66 + 65] = D.l; }
    asm volatile("s_waitcnt lgkmcnt(0)" ::: "memory"); __syncthreads();
    float M = -INFINITY;
#pragma unroll
    for (int ww = 0; ww < NWAVES; ++ww) M = fmaxf(M, cb[ww * 66 + 64]);
    float L = 0.f, o = 0.f;
#pragma unroll
    for (int ww = 0; ww < NWAVES; ++ww) { const float mw = cb[ww * 66 + 64]; const float f = (mw == -INFINITY) ? 0.f : __builtin_amdgcn_exp2f(mw - M); L += f * cb[ww * 66 + 65]; o += f * cb[ww * 66 + C.lane]; }
    return o / L;
}
DI void atta_phase(const FP& P, const Ctx& C) {
    const int lane = C.lane, w = C.wave;
    constexpr int NT = SEQ / 256, NIT = BATCH * NT * DIL_HEADS;
    for (int it = C.vcu; it < NIT; it += C.G) { const int h = it % DIL_HEADS, tt = (it / DIL_HEADS) % NT, n = it / (DIL_HEADS * NT), t0 = tt * 256;
        for (int mt = w; mt < 48; mt += NWAVES) dil_micro(P, n, h, t0, mt, lane);
        asm volatile("s_waitcnt vmcnt(0)" ::: "memory"); __syncthreads();
        for (int i = C.tid; i < 256 * 16; i += NTHREADS) { const int tk = i >> 4, d4 = (i & 15) * 4; const int row = n * SEQ + t0 + tk;
            float mg[3], lg[3]; float M = -INFINITY;
#pragma unroll
            for (int g = 0; g < 3; ++g) { const float* ml = P.DML + (((size_t)g * MP + row) * DIL_HEADS + h) * 2; mg[g] = ml[0]; lg[g] = ml[1]; M = fmaxf(M, mg[g]); }
            f32x4 acc = (f32x4){0.f, 0.f, 0.f, 0.f}; float L = 0.f;
#pragma unroll
            for (int g = 0; g < 3; ++g) { const float wg = __builtin_amdgcn_exp2f(mg[g] - M); L += wg * lg[g]; acc += *(const f32x4*)(P.DPART + (((size_t)g * MP + row) * DIL_HEADS + h) * 64 + d4) * wg; }
            *(u32x2*)(P.ATTA + (size_t)row * 512 + h * 64 + d4) = pk4(acc * (1.0f / L)); }
        for (int mt = w; mt < 16; mt += NWAVES) mem_micro(P, P.MQA + h * 64, 256, n * SEQ + t0 + 16 * mt, 0, n, h, P.ATTA + 256 + h * 64, 512, lane);
        __syncthreads();
    }
    LAS float* qs = (LAS float*)C.lds;
    for (int it = C.vcu; it < DEC_BATCH * DIL_HEADS * 2; it += C.G) { const int kind = it & 1, h = (it >> 1) % DIL_HEADS, ns = (it >> 1) / DIL_HEADS, row = M0 + ns;
        __syncthreads();
        if (kind == 0) { if (C.tid < 192) qs[C.tid] = bf2f(P.QA[((size_t)(C.tid >> 6) * MPAD + row) * 256 + h * 64 + (C.tid & 63)]); } else { if (C.tid < 64) qs[C.tid] = bf2f(P.MQA[(size_t)row * 256 + h * 64 + C.tid]); }
        asm volatile("s_waitcnt lgkmcnt(0)" ::: "memory"); __syncthreads();
        Dec D; D.m = -INFINITY; D.l = 0.f; D.o = 0.f;
        if (kind == 0) { constexpr int CPG = (DIL_TAPS + 63) / 64;
            for (int ck = w; ck < 3 * CPG; ck += NWAVES) { const int g = ck / CPG, j0 = (ck % CPG) * 64; const int W = dil_w(g), d = dil_d(g); const float* cache = sel3c(P.cache_dil, g) + (size_t)ns * W * 512; const float* newrow = sel3(P.dil_s, g) + ((size_t)ns * W + W - 1) * 512;
                const int nk = (DIL_TAPS - j0) < 64 ? (DIL_TAPS - j0) : 64;
                dec_chunk(D, qs + g * 64, nk, [&](int j) { const int tap = j0 + j; return (tap == 0 ? newrow : cache + (size_t)(W - d * tap) * 512) + h * 64; },
                          [&](int j) { const int tap = j0 + j; return (tap == 0 ? newrow : cache + (size_t)(W - d * tap) * 512) + 256 + h * 64; }, lane); } }
        else { const float* mk = P.cache_mem_kv + ((size_t)0 * DEC_BATCH + ns) * MEM_TOKENS * 512;
            for (int ck = w; ck < MEM_TOKENS / 64; ck += NWAVES) { const int j0 = ck * 64; dec_chunk(D, qs, 64, [&](int j) { return mk + (size_t)(j0 + j) * 512 + h * 64; }, [&](int j) { return mk + (size_t)(j0 + j) * 512 + 256 + h * 64; }, lane); } }
        const float o = dec_combine(C, D);
        if (w == 0) P.ATTA[(size_t)row * 512 + (kind == 0 ? 0 : 256) + h * 64 + lane] = (bf16)f2bf(o);
    }
    __syncthreads();
}
DI void ln_phase(const FP& P, const Ctx& C, const float* pre, const float* gam, const float* bet, float* xo, bf16* xb, float* yp, float* ys) {
    const int gw = C.vcu * NWAVES + C.wave, NGW = C.G * NWAVES, lane = C.lane;
    for (int r = gw; r < MP; r += NGW) { const float* x = pre + (size_t)r * D_MODEL; f32x4 v[4]; float s = 0.f;
#pragma unroll
        for (int j = 0; j < 4; ++j) { v[j] = *(const f32x4*)(x + 256 * j + 4 * lane); s += (v[j].x + v[j].y) + (v[j].z + v[j].w); }
        const float mu = wave_sum(s) * (1.0f / D_MODEL); float s2 = 0.f;
#pragma unroll
        for (int j = 0; j < 4; ++j) { v[j] = v[j] - mu; s2 += (v[j].x * v[j].x + v[j].y * v[j].y) + (v[j].z * v[j].z + v[j].w * v[j].w); }
        const float rs = 1.0f / sqrtf(wave_sum(s2) * (1.0f / D_MODEL) + LN_EPS);
#pragma unroll
        for (int j = 0; j < 4; ++j) { const f32x4 gg = *(const f32x4*)(gam + 256 * j + 4 * lane), bb = *(const f32x4*)(bet + 256 * j + 4 * lane); const f32x4 o = v[j] * rs * gg + bb;
            if (xo) *(f32x4*)(xo + (size_t)r * D_MODEL + 256 * j + 4 * lane) = o;
            if (xb) *(u32x2*)(xb + (size_t)r * D_MODEL + 256 * j + 4 * lane) = pk4(o);
            if (yp) { if (r < M0) *(f32x4*)(yp + (size_t)r * D_MODEL + 256 * j + 4 * lane) = o; else *(f32x4*)(ys + (size_t)(r - M0) * D_MODEL + 256 * j + 4 * lane) = o; } }
    }
}
}
namespace fx {
#define INS16(V, I, v_, i_) do { const float _v = (v_); const int _i = (i_); bool _c[16]; _Pragma("unroll") for (int _k = 0; _k < 16; ++_k) _c[_k] = _v > V[_k]; \
    _Pragma("unroll") for (int _k = 15; _k >= 1; --_k) { V[_k] = _c[_k] ? (_c[_k - 1] ? V[_k - 1] : _v) : V[_k]; I[_k] = _c[_k] ? (_c[_k - 1] ? I[_k - 1] : _i) : I[_k]; } \
    V[0] = _c[0] ? _v : V[0]; I[0] = _c[0] ? _i : I[0]; } while (0)
DI void wave_top16_128(float a, float b, int lane, float& outv, int& outi) {
    outv = -INFINITY; outi = 0;
#pragma unroll 1
    for (int k = 0; k < 16; ++k) { const float m = wave_max(fmaxf(a, b)); const unsigned long long ba = __ballot(a == m), bb = __ballot(b == m); int idx;
        if (ba) { const int l = __builtin_ctzll(ba); idx = l; if (lane == l) a = -INFINITY; } else { const int l = __builtin_ctzll(bb); idx = 64 + l; if (lane == l) b = -INFINITY; }
        if (lane == k) { outv = m; outi = idx; } }
}
DI void topk_wave_item(const FP& P, long it, int lane) {
    const float* s = P.SCO + it * 256; float v1, v2; int i1, i2;
    wave_top16_128(s[lane], s[64 + lane], lane, v1, i1); wave_top16_128(s[128 + lane], s[192 + lane], lane, v2, i2);
    int a = 0, rem = lane; bool valid = false;
    for (int aa = 0; aa < 16; ++aa) { const int nb = 16 / (aa + 1); if (!valid) { if (rem < nb) { a = aa; valid = true; } else rem -= nb; } }
    const int b = valid ? rem : 0;
    float cs = __shfl(v1, a) + __shfl(v2, b); const int ce = __shfl(i1, a) * PEER_KEYS + __shfl(i2, b); if (!valid) cs = -INFINITY;
    float tv = -INFINITY; int te = 0;
#pragma unroll 1
    for (int k = 0; k < 16; ++k) { const float m = wave_max(cs); const unsigned long long bm = __ballot(cs == m); const int l = __builtin_ctzll(bm); const int e = __shfl(ce, l); if (lane == l) cs = -INFINITY; if (lane == k) { tv = m; te = e; } }
    const float mx = __shfl(tv, 0); const float ex = (lane < 16) ? __expf(tv - mx) : 0.f; const float z = wave_sum(ex);
    if (lane < 16) { P.SELG[it * 16 + lane] = ex / z; P.SELE[it * 16 + lane] = te; }
}
#define KINS16(V, key_) do { const float _key = (key_); _Pragma("unroll") for (int _k = 15; _k >= 1; --_k) V[_k] = __builtin_amdgcn_fmed3f(V[_k - 1], V[_k], _key); V[0] = fmaxf(V[0], _key); } while (0)
DI float pack_key(float v, unsigned lowbits, unsigned mask) { return __builtin_bit_cast(float, (__builtin_bit_cast(unsigned, v) & ~mask) | lowbits); }
DI void topk_phase(const FP& P, const Ctx& C) {
    const int lane = C.lane; LAS float* st = (LAS float*)(C.lds + C.wave * 16384);
    const int NWI = (M0 * PEER_HEADS) / 64;
    for (int wi = C.vcu * NWAVES + C.wave; wi < NWI; wi += C.G * NWAVES) {
        const long it0 = (long)wi * 64; const long it = it0 + lane;
        float V1[16], V2[16], V3[16];
#pragma unroll
        for (int k = 0; k < 16; ++k) { V1[k] = V2[k] = V3[k] = -INFINITY; }
#pragma unroll 1
        for (int ch = 0; ch < 8; ++ch) {
#pragma unroll
            for (int u = 0; u < 8; ++u) { const int f4 = u * 64 + lane, j = f4 >> 3, q = f4 & 7, hf = q >> 2, c4 = (q & 3) * 4; const long itj = it0 + j;
                const f32x4 v = *(const f32x4*)(P.SCO + itj * 256 + hf * 128 + ch * 16 + c4);
                st[j * 33 + hf * 16 + c4] = v.x; st[j * 33 + hf * 16 + c4 + 1] = v.y; st[j * 33 + hf * 16 + c4 + 2] = v.z; st[j * 33 + hf * 16 + c4 + 3] = v.w; }
            asm volatile("s_waitcnt lgkmcnt(0)" ::: "memory");
#pragma unroll 4
            for (int c = 0; c < 16; ++c) { const float va = st[lane * 33 + c], vb = st[lane * 33 + 16 + c]; const unsigned lb = 127u - (unsigned)(ch * 16 + c); KINS16(V1, pack_key(va, lb, 127u)); KINS16(V2, pack_key(vb, lb, 127u)); }
            asm volatile("s_waitcnt lgkmcnt(0)" ::: "memory");
        }
        LAS int* lc = (LAS int*)st;
        { int ord = 0;
#pragma unroll
          for (int a = 0; a < 16; ++a) { const unsigned ba = __builtin_bit_cast(unsigned, V1[a]); const float va = __builtin_bit_cast(float, ba & ~127u); const int ia = 127 - (int)(ba & 127u);
#pragma unroll
              for (int b = 0; b < 16; ++b) if ((a + 1) * (b + 1) <= 16) { const unsigned bb = __builtin_bit_cast(unsigned, V2[b]); const float vb = __builtin_bit_cast(float, bb & ~127u); const int ib = 127 - (int)(bb & 127u);
                  lc[lane * 51 + ord] = ia * PEER_KEYS + ib; KINS16(V3, pack_key(va + vb, 63u - (unsigned)ord, 63u)); ++ord; } } }
        asm volatile("s_waitcnt lgkmcnt(0)" ::: "memory");
        float g[16]; int e[16]; float z = 0.f; const float vmax = __builtin_bit_cast(float, __builtin_bit_cast(unsigned, V3[0]) & ~63u);
#pragma unroll
        for (int k = 0; k < 16; ++k) { const unsigned bk = __builtin_bit_cast(unsigned, V3[k]); e[k] = lc[lane * 51 + 63 - (int)(bk & 63u)]; g[k] = __expf(__builtin_bit_cast(float, bk & ~63u) - vmax); z += g[k]; }
        const float iz = 1.0f / z;
#pragma unroll
        for (int k4 = 0; k4 < 4; ++k4) { *(f32x4*)(P.SELG + it * 16 + 4 * k4) = (f32x4){g[4 * k4] * iz, g[4 * k4 + 1] * iz, g[4 * k4 + 2] * iz, g[4 * k4 + 3] * iz};
            *(int4*)(P.SELE + it * 16 + 4 * k4) = make_int4(e[4 * k4], e[4 * k4 + 1], e[4 * k4 + 2], e[4 * k4 + 3]); }
        asm volatile("s_waitcnt lgkmcnt(0)" ::: "memory");
    }
    for (int si = C.vcu * NWAVES + C.wave; si < DEC_BATCH * PEER_HEADS; si += C.G * NWAVES) topk_wave_item(P, (long)M0 * PEER_HEADS + si, lane);
    __syncthreads();
}
constexpr float PEER_SU = 256.f, PEER_SV = 64.f;
DI float dot16_fp8(const u32x4& w, const f32x2 (&x2)[8]) { f32x2 a = {0.f, 0.f};
    a += __builtin_amdgcn_cvt_pk_f32_fp8((int)w.x, false) * x2[0]; a += __builtin_amdgcn_cvt_pk_f32_fp8((int)w.x, true) * x2[1];
    a += __builtin_amdgcn_cvt_pk_f32_fp8((int)w.y, false) * x2[2]; a += __builtin_amdgcn_cvt_pk_f32_fp8((int)w.y, true) * x2[3];
    a += __builtin_amdgcn_cvt_pk_f32_fp8((int)w.z, false) * x2[4]; a += __builtin_amdgcn_cvt_pk_f32_fp8((int)w.z, true) * x2[5];
    a += __builtin_amdgcn_cvt_pk_f32_fp8((int)w.w, false) * x2[6]; a += __builtin_amdgcn_cvt_pk_f32_fp8((int)w.w, true) * x2[7];
    return a.x + a.y; }
DI void axpy16_fp8(const u32x4& w, float s, f32x2 (&o2)[8]) { const f32x2 s2 = {s, s};
    o2[0] += __builtin_amdgcn_cvt_pk_f32_fp8((int)w.x, false) * s2; o2[1] += __builtin_amdgcn_cvt_pk_f32_fp8((int)w.x, true) * s2;
    o2[2] += __builtin_amdgcn_cvt_pk_f32_fp8((int)w.y, false) * s2; o2[3] += __builtin_amdgcn_cvt_pk_f32_fp8((int)w.y, true) * s2;
    o2[4] += __builtin_amdgcn_cvt_pk_f32_fp8((int)w.z, false) * s2; o2[5] += __builtin_amdgcn_cvt_pk_f32_fp8((int)w.z, true) * s2;
    o2[6] += __builtin_amdgcn_cvt_pk_f32_fp8((int)w.w, false) * s2; o2[7] += __builtin_amdgcn_cvt_pk_f32_fp8((int)w.w, true) * s2; }
#if defined(PEER_SHARD) || defined(PEER_SHARD2)
#define PEER_FIRST_ROUND nrounds
#else
#define PEER_FIRST_ROUND 0
#endif
template <int CTRL> DI float dppf(float x) { return __builtin_bit_cast(float, __builtin_amdgcn_update_dpp(0, __builtin_bit_cast(int, x), CTRL, 0xF, 0xF, true)); }
DI float rdlane(float v, int l) { return __builtin_bit_cast(float, __builtin_amdgcn_readlane(__builtin_bit_cast(int, v), l)); }
DI void peer_phase(const FP& P, const Ctx& C, int layer, const float* xin, float* fout, float* fout_s, bf16* xb, bool samples_only = false) {
    const int lane = C.lane; const unsigned char* U = P.UB8 + (size_t)layer * PEER_EXPERTS * D_MODEL; const unsigned char* Vt = P.VB8 + (size_t)layer * PEER_EXPERTS * D_MODEL;
    const float* gam = P.ln_g + ((size_t)layer * 2 + 1) * D_MODEL; const float* bet = P.ln_b + ((size_t)layer * 2 + 1) * D_MODEL;
    const int nrounds = (M0 + C.G * NWAVES - 1) / (C.G * NWAVES);
#pragma unroll 1
    for (int rd = samples_only ? nrounds : 0; rd <= nrounds; ++rd) {
        const bool smp = (rd == nrounds); int r = smp ? M0 + C.vcu : rd * C.G * NWAVES + C.vcu * NWAVES + C.wave; if (smp ? (C.vcu >= DEC_BATCH) : (r >= M0)) continue;
        const int pb = smp ? 16 * C.wave : 0, pe = smp ? pb + 16 : 128;
        f32x2 x2[8], o2[8];
#pragma unroll
        for (int j = 0; j < 4; ++j) { const f32x4 a = *(const f32x4*)(xin + (size_t)r * D_MODEL + 16 * lane + 4 * j); x2[2 * j] = (f32x2){a.x, a.y}; x2[2 * j + 1] = (f32x2){a.z, a.w}; }
#pragma unroll
        for (int k = 0; k < 8; ++k) o2[k] = (f32x2){0.f, 0.f};
        const int e_l = P.SELE[(size_t)r * 128 + lane], e_h = P.SELE[(size_t)r * 128 + 64 + lane]; const float g_l = P.SELG[(size_t)r * 128 + lane], g_h = P.SELG[(size_t)r * 128 + 64 + lane];
#pragma unroll 1
        for (int b0 = pb; b0 < pe; b0 += 8) {
            u32x4 uw[8], vw[8];
#pragma unroll
            for (int k = 0; k < 8; ++k) { const int hk = b0 + k; const int e = (hk < 64) ? __builtin_amdgcn_readlane(e_l, hk & 63) : __builtin_amdgcn_readlane(e_h, hk & 63);
                uw[k] = *(const u32x4*)(U + (size_t)e * D_MODEL + 16 * lane); vw[k] = *(const u32x4*)(Vt + (size_t)e * D_MODEL + 16 * lane); }
            float d[8];
#pragma unroll
            for (int k = 0; k < 8; ++k) d[k] = dot16_fp8(uw[k], x2);
            float e4[4], e2[2], e1;
            { const bool hi = lane & 1;
#pragma unroll
              for (int i = 0; i < 4; ++i) { const float keep = hi ? d[4 + i] : d[i], send = hi ? d[i] : d[4 + i]; e4[i] = keep + __shfl_xor(send, 1); } }
            { const bool hi = lane & 2;
#pragma unroll
              for (int i = 0; i < 2; ++i) { const float keep = hi ? e4[2 + i] : e4[i], send = hi ? e4[i] : e4[2 + i]; e2[i] = keep + __shfl_xor(send, 2); } }
            { const bool hi = lane & 4; const float keep = hi ? e2[1] : e2[0], send = hi ? e2[0] : e2[1]; e1 = keep + __shfl_xor(send, 4); }
            e1 += __shfl_xor(e1, 8); e1 += __shfl_xor(e1, 16); e1 += __shfl_xor(e1, 32);
            const int myk = 4 * (lane & 1) + (lane & 2) + ((lane >> 2) & 1); const int myhk = b0 + myk;
            const float myg = (myhk < 64) ? __shfl(g_l, myhk & 63) : __shfl(g_h, myhk & 63);
            const float act = myg * gelu_tanh(e1 * (1.0f / PEER_SU)) * (1.0f / PEER_SV);
#pragma unroll
            for (int k = 0; k < 8; ++k) { const int src = (k >> 2) | (((k >> 1) & 1) << 1) | ((k & 1) << 2); axpy16_fp8(vw[k], rdlane(act, src), o2); }
        }
        if (smp) {
            LAS float* red = (LAS float*)C.lds;
#pragma unroll
            for (int k = 0; k < 8; ++k) { red[C.wave * 1024 + 16 * lane + 2 * k] = o2[k].x; red[C.wave * 1024 + 16 * lane + 2 * k + 1] = o2[k].y; }
            asm volatile("s_waitcnt lgkmcnt(0)" ::: "memory"); __syncthreads();
            if (C.wave == 0) {
#pragma unroll
                for (int k = 0; k < 8; ++k) { float ax = 0.f, ay = 0.f;
#pragma unroll
                    for (int ww = 0; ww < NWAVES; ++ww) { ax += red[ww * 1024 + 16 * lane + 2 * k]; ay += red[ww * 1024 + 16 * lane + 2 * k + 1]; } o2[k] = (f32x2){ax, ay}; } }
            __syncthreads();
            if (C.wave != 0) continue; }
        float s = 0.f;
#pragma unroll
        for (int k = 0; k < 8; ++k) { o2[k] += x2[k] * ALPHA; s += o2[k].x + o2[k].y; }
        const float mu = wave_sum(s) * (1.0f / D_MODEL); float s2 = 0.f;
#pragma unroll
        for (int k = 0; k < 8; ++k) { o2[k] -= mu; s2 += o2[k].x * o2[k].x + o2[k].y * o2[k].y; }
        const float rs = 1.0f / sqrtf(wave_sum(s2) * (1.0f / D_MODEL) + LN_EPS);
        float* frow = (r < M0) ? fout + (size_t)r * D_MODEL : fout_s + (size_t)(r - M0) * D_MODEL;
#pragma unroll
        for (int j = 0; j < 4; ++j) { const int c0 = 16 * lane + 4 * j; const f32x4 gg = *(const f32x4*)(gam + c0), bb = *(const f32x4*)(bet + c0);
            const f32x4 y = (f32x4){o2[2 * j].x * rs, o2[2 * j].y * rs, o2[2 * j + 1].x * rs, o2[2 * j + 1].y * rs} * gg + bb;
            *(f32x4*)(frow + c0) = y; if (xb) *(u32x2*)(xb + (size_t)r * D_MODEL + c0) = pk4(y); }
    }
}
DI void peer_u_phase(const FP& P, const Ctx& C, int layer, const bf16* xb16) {
    const int lane = C.lane; const unsigned char* U = P.UB8 + (size_t)layer * PEER_EXPERTS * D_MODEL;
    const int s = (int)(blockIdx.x & 7), nw = (C.G >> 3) * NWAVES, widx = (int)(blockIdx.x >> 3) * NWAVES + C.wave;
#pragma unroll 1
    for (int r = widx; r < MP; r += nw) {
        const int e0 = P.SELE[(size_t)r * 128 + lane], e1 = P.SELE[(size_t)r * 128 + 64 + lane]; const float g0 = P.SELG[(size_t)r * 128 + lane], g1 = P.SELG[(size_t)r * 128 + 64 + lane];
        unsigned long long b0 = __ballot((e0 >> 11) == s), b1 = __ballot((e1 >> 11) == s);
        if ((b0 | b1) == 0ull) continue;
        f32x2 x2[8]; { const u32x4 xa = *(const u32x4*)(xb16 + (size_t)r * D_MODEL + 16 * lane), xc = *(const u32x4*)(xb16 + (size_t)r * D_MODEL + 16 * lane + 8);
            x2[0] = (f32x2){bflo(xa.x), bfhi(xa.x)}; x2[1] = (f32x2){bflo(xa.y), bfhi(xa.y)}; x2[2] = (f32x2){bflo(xa.z), bfhi(xa.z)}; x2[3] = (f32x2){bflo(xa.w), bfhi(xa.w)};
            x2[4] = (f32x2){bflo(xc.x), bfhi(xc.x)}; x2[5] = (f32x2){bflo(xc.y), bfhi(xc.y)}; x2[6] = (f32x2){bflo(xc.z), bfhi(xc.z)}; x2[7] = (f32x2){bflo(xc.w), bfhi(xc.w)}; }
#pragma unroll 1
        while ((b0 | b1) != 0ull) {
            int hk[8]; u32x4 uw[8]; int nv = 0;
#pragma unroll
            for (int k = 0; k < 8; ++k) { int h;
                if (b0) { h = __builtin_ctzll(b0); b0 &= b0 - 1; ++nv; } else if (b1) { h = 64 + __builtin_ctzll(b1); b1 &= b1 - 1; ++nv; } else h = hk[k > 0 ? k - 1 : 0];
                hk[k] = h; const int e = (h < 64) ? __builtin_amdgcn_readlane(e0, h & 63) : __builtin_amdgcn_readlane(e1, h & 63);
                uw[k] = *(const u32x4*)(U + (size_t)e * D_MODEL + 16 * lane); }
            float d[8];
#pragma unroll
            for (int k = 0; k < 8; ++k) d[k] = dot16_fp8(uw[k], x2);
            float e4[4], e2[2], e1s;
            { const bool hi = lane & 1;
#pragma unroll
              for (int i = 0; i < 4; ++i) { const float keep = hi ? d[4 + i] : d[i], send = hi ? d[i] : d[4 + i]; e4[i] = keep + __shfl_xor(send, 1); } }
            { const bool hi = lane & 2;
#pragma unroll
              for (int i = 0; i < 2; ++i) { const float keep = hi ? e4[2 + i] : e4[i], send = hi ? e4[i] : e4[2 + i]; e2[i] = keep + __shfl_xor(send, 2); } }
            { const bool hi = lane & 4; const float keep = hi ? e2[1] : e2[0], send = hi ? e2[0] : e2[1]; e1s = keep + __shfl_xor(send, 4); }
            e1s += __shfl_xor(e1s, 8); e1s += __shfl_xor(e1s, 16); e1s += __shfl_xor(e1s, 32);
            const int myk = 4 * (lane & 1) + (lane & 2) + ((lane >> 2) & 1);
            int myh = hk[0];
#pragma unroll
            for (int k = 1; k < 8; ++k) myh = (myk == k) ? hk[k] : myh;
            const float ga = __shfl(g0, myh & 63), gb = __shfl(g1, myh & 63); const float myg = (myh < 64) ? ga : gb;
            if (lane < 8 && myk < nv) P.SCO[(size_t)r * 128 + myh] = myg * gelu_tanh(e1s * (1.0f / PEER_SU)) * (1.0f / PEER_SV);
        }
    }
}
DI void peer_v_phase(const FP& P, const Ctx& C, int layer, const float* xin, float* fout, float* fout_s, bf16* xb) {
    const int lane = C.lane; const unsigned char* Vt = P.VB8 + (size_t)layer * PEER_EXPERTS * D_MODEL;
    const float* gam = P.ln_g + ((size_t)layer * 2 + 1) * D_MODEL; const float* bet = P.ln_b + ((size_t)layer * 2 + 1) * D_MODEL;
    const int nrounds = (M0 + C.G * NWAVES - 1) / (C.G * NWAVES);
#pragma unroll 1
    for (int rd = 0; rd <= nrounds; ++rd) {
        const bool smp = (rd == nrounds); int r = smp ? M0 + C.vcu : rd * C.G * NWAVES + C.vcu * NWAVES + C.wave; if (smp ? (C.vcu >= DEC_BATCH) : (r >= M0)) continue;
        const int pb = smp ? 16 * C.wave : 0, pe = smp ? pb + 16 : 128;
        f32x2 x2[8], o2[8];
#pragma unroll
        for (int j = 0; j < 4; ++j) { const f32x4 a = *(const f32x4*)(xin + (size_t)r * D_MODEL + 16 * lane + 4 * j); x2[2 * j] = (f32x2){a.x, a.y}; x2[2 * j + 1] = (f32x2){a.z, a.w}; }
#pragma unroll
        for (int k = 0; k < 8; ++k) o2[k] = (f32x2){0.f, 0.f};
        const int e_l = P.SELE[(size_t)r * 128 + lane], e_h = P.SELE[(size_t)r * 128 + 64 + lane]; const float a_l = P.SCO[(size_t)r * 128 + lane], a_h = P.SCO[(size_t)r * 128 + 64 + lane];
#pragma unroll 1
        for (int b0 = pb; b0 < pe; b0 += 16) { u32x4 vw[16];
#pragma unroll
            for (int k = 0; k < 16; ++k) { const int hk = b0 + k; const int e = (hk < 64) ? __builtin_amdgcn_readlane(e_l, hk & 63) : __builtin_amdgcn_readlane(e_h, hk & 63); vw[k] = *(const u32x4*)(Vt + (size_t)e * D_MODEL + 16 * lane); }
#pragma unroll
            for (int k = 0; k < 16; ++k) { const int hk = b0 + k; axpy16_fp8(vw[k], (hk < 64) ? rdlane(a_l, hk & 63) : rdlane(a_h, hk & 63), o2); } }
        if (smp) {
            LAS float* red = (LAS float*)C.lds;
#pragma unroll
            for (int k = 0; k < 8; ++k) { red[C.wave * 1024 + 16 * lane + 2 * k] = o2[k].x; red[C.wave * 1024 + 16 * lane + 2 * k + 1] = o2[k].y; }
            asm volatile("s_waitcnt lgkmcnt(0)" ::: "memory"); __syncthreads();
            if (C.wave == 0) {
#pragma unroll
                for (int k = 0; k < 8; ++k) { float ax = 0.f, ay = 0.f;
#pragma unroll
                    for (int ww = 0; ww < NWAVES; ++ww) { ax += red[ww * 1024 + 16 * lane + 2 * k]; ay += red[ww * 1024 + 16 * lane + 2 * k + 1]; } o2[k] = (f32x2){ax, ay}; } }
            __syncthreads();
            if (C.wave != 0) continue; }
        float s = 0.f;
#pragma unroll
        for (int k = 0; k < 8; ++k) { o2[k] += x2[k] * ALPHA; s += o2[k].x + o2[k].y; }
        const float mu = wave_sum(s) * (1.0f / D_MODEL); float s2 = 0.f;
#pragma unroll
        for (int k = 0; k < 8; ++k) { o2[k] -= mu; s2 += o2[k].x * o2[k].x + o2[k].y * o2[k].y; }
        const float rs = 1.0f / sqrtf(wave_sum(s2) * (1.0f / D_MODEL) + LN_EPS);
        float* frow = (r < M0) ? fout + (size_t)r * D_MODEL : fout_s + (size_t)(r - M0) * D_MODEL;
#pragma unroll
        for (int j = 0; j < 4; ++j) { const int c0 = 16 * lane + 4 * j; const f32x4 gg = *(const f32x4*)(gam + c0), bb = *(const f32x4*)(bet + c0);
            const f32x4 y = (f32x4){o2[2 * j].x * rs, o2[2 * j].y * rs, o2[2 * j + 1].x * rs, o2[2 * j + 1].y * rs} * gg + bb;
            *(f32x4*)(frow + c0) = y; if (xb) *(u32x2*)(xb + (size_t)r * D_MODEL + c0) = pk4(y); }
    }
}
constexpr int PSH_LIST = 512;
struct PG4 { u32x4 u[4], v[4]; };
DI void peer_sharded_phase(const FP& P, const Ctx& C, int layer, const float* xin, const bf16* xb16, float* fout, float* fout_s, bf16* xb) {
    const int lane = C.lane; const unsigned char* U = P.UB8 + (size_t)layer * PEER_EXPERTS * D_MODEL; const unsigned char* Vt = P.VB8 + (size_t)layer * PEER_EXPERTS * D_MODEL;
    const float* gam = P.ln_g + ((size_t)layer * 2 + 1) * D_MODEL; const float* bet = P.ln_b + ((size_t)layer * 2 + 1) * D_MODEL;
    LAS unsigned char* wl = C.lds + C.wave * 16384; LAS bf16* xs = (LAS bf16*)wl; LAS int* lst = (LAS int*)(wl + 8192);
    const int NW = C.G * NWAVES, gw = C.vcu * NWAVES + C.wave; const int nquads = (M0 / NW) / 4;
#pragma unroll 1
    for (int qd = 0; qd < nquads; ++qd) {
#define PSH_ROW(j) const int row##j = (qd * 4 + j) * NW + gw; const int el##j = P.SELE[(size_t)row##j * 128 + lane], eh##j = P.SELE[(size_t)row##j * 128 + 64 + lane]; const float gl##j = P.SELG[(size_t)row##j * 128 + lane], gh##j = P.SELG[(size_t)row##j * 128 + 64 + lane]; \
        { const u32x4 xa = *(const u32x4*)(xb16 + (size_t)row##j * D_MODEL + 16 * lane), xc = *(const u32x4*)(xb16 + (size_t)row##j * D_MODEL + 16 * lane + 8); *(LAS u32x4*)(xs + j * 1024 + 16 * lane) = xa; *(LAS u32x4*)(xs + j * 1024 + 16 * lane + 8) = xc; } \
        f32x2 oa##j[8]; _Pragma("unroll") for (int k = 0; k < 8; ++k) oa##j[k] = (f32x2){0.f, 0.f};
        PSH_ROW(0) PSH_ROW(1) PSH_ROW(2) PSH_ROW(3)
#pragma unroll 1
        for (int s = 0; s < 16; ++s) {
            int n = 0;
#define PSH_SCAN(j) { unsigned long long b0 = __ballot((el##j >> 10) == s), b1 = __ballot((eh##j >> 10) == s); \
                while (b0) { const int h = __builtin_ctzll(b0); b0 &= b0 - 1; const int e = __builtin_amdgcn_readlane(el##j, h); const int g = __builtin_amdgcn_readlane(__builtin_bit_cast(int, gl##j), h); \
                    if (lane == 0) { lst[4 * n] = e; lst[4 * n + 1] = g; lst[4 * n + 2] = j; } ++n; } \
                while (b1) { const int h = __builtin_ctzll(b1); b1 &= b1 - 1; const int e = __builtin_amdgcn_readlane(eh##j, h); const int g = __builtin_amdgcn_readlane(__builtin_bit_cast(int, gh##j), h); \
                    if (lane == 0) { lst[4 * n] = e; lst[4 * n + 1] = g; lst[4 * n + 2] = j; } ++n; } }
            PSH_SCAN(0) PSH_SCAN(1) PSH_SCAN(2) PSH_SCAN(3)
            asm volatile("s_waitcnt lgkmcnt(0)" ::: "memory");
            if (n == 0) continue;
            const int ngrp = (n + 3) >> 2;
#define PSH_LD(b, gi_) do { const int gi = (gi_); _Pragma("unroll") for (int k = 0; k < 4; ++k) { int i = 4 * gi + k; i = i < n ? i : n - 1; const int e = __builtin_amdgcn_readfirstlane(lst[4 * i]); \
                b.u[k] = *(const u32x4*)(U + (size_t)e * D_MODEL + 16 * lane); b.v[k] = *(const u32x4*)(Vt + (size_t)e * D_MODEL + 16 * lane); } } while (0)
#define PSH_CP(b, gi_) do { const int gi = (gi_); float d[4]; int jj[4]; float gg[4]; \
                _Pragma("unroll") for (int k = 0; k < 4; ++k) { int i = 4 * gi + k; const bool val = i < n; i = val ? i : n - 1; jj[k] = __builtin_amdgcn_readfirstlane(lst[4 * i + 2]); gg[k] = val ? __builtin_bit_cast(float, __builtin_amdgcn_readfirstlane(lst[4 * i + 1])) : 0.f; \
                    const u32x4 xa = *(const LAS u32x4*)(xs + jj[k] * 1024 + 16 * lane), xc = *(const LAS u32x4*)(xs + jj[k] * 1024 + 16 * lane + 8); \
                    const f32x2 x2[8] = {(f32x2){bflo(xa.x), bfhi(xa.x)}, (f32x2){bflo(xa.y), bfhi(xa.y)}, (f32x2){bflo(xa.z), bfhi(xa.z)}, (f32x2){bflo(xa.w), bfhi(xa.w)}, (f32x2){bflo(xc.x), bfhi(xc.x)}, (f32x2){bflo(xc.y), bfhi(xc.y)}, (f32x2){bflo(xc.z), bfhi(xc.z)}, (f32x2){bflo(xc.w), bfhi(xc.w)}}; \
                    d[k] = dot16_fp8(b.u[k], x2); } \
                float e2[2], e1; \
                { const bool hi = lane & 1; _Pragma("unroll") for (int i = 0; i < 2; ++i) { const float keep = hi ? d[2 + i] : d[i], send = hi ? d[i] : d[2 + i]; e2[i] = keep + __shfl_xor(send, 1); } } \
                { const bool hi = lane & 2; const float keep = hi ? e2[1] : e2[0], send = hi ? e2[0] : e2[1]; e1 = keep + __shfl_xor(send, 2); } \
                e1 += __shfl_xor(e1, 4); e1 += __shfl_xor(e1, 8); e1 += __shfl_xor(e1, 16); e1 += __shfl_xor(e1, 32); \
                const int myk = 2 * (lane & 1) + ((lane >> 1) & 1); \
                float myg = gg[0]; myg = (myk == 1) ? gg[1] : myg; myg = (myk == 2) ? gg[2] : myg; myg = (myk == 3) ? gg[3] : myg; \
                const float act = myg * gelu_tanh(e1 * (1.0f / PEER_SU)) * (1.0f / PEER_SV); \
                _Pragma("unroll") for (int k = 0; k < 4; ++k) { const float a = rdlane(act, (k >> 1) | ((k & 1) << 1)); \
                    if (jj[k] == 0) axpy16_fp8(b.v[k], a, oa0); else if (jj[k] == 1) axpy16_fp8(b.v[k], a, oa1); else if (jj[k] == 2) axpy16_fp8(b.v[k], a, oa2); else axpy16_fp8(b.v[k], a, oa3); } } while (0)
            { PG4 A, B; PSH_LD(A, 0);
#pragma unroll 1
              for (int g2 = 0; g2 < ngrp; g2 += 2) { PSH_LD(B, (g2 + 1 < ngrp) ? g2 + 1 : g2); PSH_CP(A, g2); PSH_LD(A, (g2 + 2 < ngrp) ? g2 + 2 : g2); if (g2 + 1 < ngrp) PSH_CP(B, g2 + 1); } }
            asm volatile("s_waitcnt lgkmcnt(0)" ::: "memory");
        }
#define PSH_LN(j) { const int r = row##j; f32x2 x2[8]; \
            _Pragma("unroll") for (int q = 0; q < 4; ++q) { const f32x4 a = *(const f32x4*)(xin + (size_t)r * D_MODEL + 16 * lane + 4 * q); x2[2 * q] = (f32x2){a.x, a.y}; x2[2 * q + 1] = (f32x2){a.z, a.w}; } \
            float sm = 0.f; _Pragma("unroll") for (int k = 0; k < 8; ++k) { oa##j[k] += x2[k] * ALPHA; sm += oa##j[k].x + oa##j[k].y; } \
            const float mu = wave_sum(sm) * (1.0f / D_MODEL); float s2 = 0.f; _Pragma("unroll") for (int k = 0; k < 8; ++k) { oa##j[k] -= mu; s2 += oa##j[k].x * oa##j[k].x + oa##j[k].y * oa##j[k].y; } \
            const float rs = 1.0f / sqrtf(wave_sum(s2) * (1.0f / D_MODEL) + LN_EPS); float* frow = fout + (size_t)r * D_MODEL; \
            _Pragma("unroll") for (int q = 0; q < 4; ++q) { const int c0 = 16 * lane + 4 * q; const f32x4 gv = *(const f32x4*)(gam + c0), bv = *(const f32x4*)(bet + c0); \
                const f32x4 y = (f32x4){oa##j[2 * q].x * rs, oa##j[2 * q].y * rs, oa##j[2 * q + 1].x * rs, oa##j[2 * q + 1].y * rs} * gv + bv; *(f32x4*)(frow + c0) = y; if (xb) *(u32x2*)(xb + (size_t)r * D_MODEL + c0) = pk4(y); } }
        PSH_LN(0) PSH_LN(1) PSH_LN(2) PSH_LN(3)
        asm volatile("s_waitcnt lgkmcnt(0)" ::: "memory");
    }
}
#ifndef PSH_LOG_V
#define PSH_LOG_V 11
#endif
constexpr int PSH_LOG = PSH_LOG_V, PSH_N = PEER_EXPERTS >> PSH_LOG;
#ifndef PS2_ROWS
#define PS2_ROWS 4
#endif
#define PS2_ROW(j) const int row##j = (qd * PS2_ROWS + j) * NW + gw; const int el##j = P.SELE[(size_t)row##j * 128 + lane], eh##j = P.SELE[(size_t)row##j * 128 + 64 + lane]; const float gl##j = P.SELG[(size_t)row##j * 128 + lane], gh##j = P.SELG[(size_t)row##j * 128 + 64 + lane]; \
    f32x2 oa##j[8]; _Pragma("unroll") for (int k = 0; k < 8; ++k) oa##j[k] = (f32x2){0.f, 0.f};
#define PS2_STEP(j) { unsigned long long b0 = __ballot((el##j >> PSH_LOG) == s), b1 = __ballot((eh##j >> PSH_LOG) == s); \
    if (b0 | b1) { const u32x4 xa##j = *(const u32x4*)(xb16 + (size_t)row##j * D_MODEL + 16 * lane), xc##j = *(const u32x4*)(xb16 + (size_t)row##j * D_MODEL + 16 * lane + 8);     \
      const f32x2 x2[8] = {(f32x2){bflo(xa##j.x), bfhi(xa##j.x)}, (f32x2){bflo(xa##j.y), bfhi(xa##j.y)}, (f32x2){bflo(xa##j.z), bfhi(xa##j.z)}, (f32x2){bflo(xa##j.w), bfhi(xa##j.w)}, (f32x2){bflo(xc##j.x), bfhi(xc##j.x)}, (f32x2){bflo(xc##j.y), bfhi(xc##j.y)}, (f32x2){bflo(xc##j.z), bfhi(xc##j.z)}, (f32x2){bflo(xc##j.w), bfhi(xc##j.w)}}; \
      _Pragma("unroll 1") while ((b0 | b1) != 0ull) { int hk[8]; u32x4 uw[8], vw[8]; int nv = 0; \
        _Pragma("unroll") for (int k = 0; k < 8; ++k) { int h; if (b0) { h = __builtin_ctzll(b0); b0 &= b0 - 1; ++nv; } else if (b1) { h = 64 + __builtin_ctzll(b1); b1 &= b1 - 1; ++nv; } else h = hk[k > 0 ? k - 1 : 0]; \
            hk[k] = h; const int e = (h < 64) ? __builtin_amdgcn_readlane(el##j, h & 63) : __builtin_amdgcn_readlane(eh##j, h & 63); \
            uw[k] = *(const u32x4*)(U + (size_t)e * D_MODEL + 16 * lane); vw[k] = *(const u32x4*)(Vt + (size_t)e * D_MODEL + 16 * lane); } \
        float d[8]; _Pragma("unroll") for (int k = 0; k < 8; ++k) d[k] = dot16_fp8(uw[k], x2); \
        float e4[4], e2[2], e1s; \
          \
        { const bool hi = lane & 1; _Pragma("unroll") for (int i = 0; i < 4; ++i) { const float keep = hi ? d[4 + i] : d[i], send = hi ? d[i] : d[4 + i]; e4[i] = keep + dppf<0xB1>(send); } } \
        { const bool hi = lane & 2; _Pragma("unroll") for (int i = 0; i < 2; ++i) { const float keep = hi ? e4[2 + i] : e4[i], send = hi ? e4[i] : e4[2 + i]; e2[i] = keep + dppf<0x4E>(send); } } \
        { const bool hi = lane & 4; const float keep = hi ? e2[1] : e2[0], send = hi ? e2[0] : e2[1]; const float r4 = dppf<0x124>(send), r12 = dppf<0x12C>(send); e1s = keep + (hi ? r4 : r12); } \
        e1s += dppf<0x128>(e1s); e1s = colsum(e1s); \
        const int myk = 4 * (lane & 1) + (lane & 2) + ((lane >> 2) & 1); int myh = hk[0]; _Pragma("unroll") for (int k = 1; k < 8; ++k) myh = (myk == k) ? hk[k] : myh; \
        const float ga = __shfl(gl##j, myh & 63), gb = __shfl(gh##j, myh & 63); const float myg = (myk < nv) ? ((myh < 64) ? ga : gb) : 0.f;     \
        const float act = myg * gelu_tanh(e1s * (1.0f / PEER_SU)) * (1.0f / PEER_SV); \
        _Pragma("unroll") for (int k = 0; k < 8; ++k) { const int src = (k >> 2) | (((k >> 1) & 1) << 1) | ((k & 1) << 2); axpy16_fp8(vw[k], rdlane(act, src), oa##j); } } } }
#define PS2_LN(j) { const int r = row##j; f32x2 x2[8]; int ll = lane; asm volatile("" : "+v"(ll));     \
    _Pragma("unroll") for (int q = 0; q < 4; ++q) { const f32x4 a = *(const f32x4*)(xin + (size_t)r * D_MODEL + 16 * ll + 4 * q); x2[2 * q] = (f32x2){a.x, a.y}; x2[2 * q + 1] = (f32x2){a.z, a.w}; } \
    float sm = 0.f; _Pragma("unroll") for (int k = 0; k < 8; ++k) { oa##j[k] += x2[k] * ALPHA; sm += oa##j[k].x + oa##j[k].y; } \
    const float mu = wave_sum(sm) * (1.0f / D_MODEL); float s2 = 0.f; _Pragma("unroll") for (int k = 0; k < 8; ++k) { oa##j[k] -= mu; s2 += oa##j[k].x * oa##j[k].x + oa##j[k].y * oa##j[k].y; } \
    const float rs = 1.0f / sqrtf(wave_sum(s2) * (1.0f / D_MODEL) + LN_EPS); float* frow = fout + (size_t)r * D_MODEL; \
    _Pragma("unroll") for (int q = 0; q < 4; ++q) { const int c0 = 16 * ll + 4 * q; const f32x4 gv = *(const f32x4*)(gam + c0), bv = *(const f32x4*)(bet + c0); \
        const f32x4 y = (f32x4){oa##j[2 * q].x * rs, oa##j[2 * q].y * rs, oa##j[2 * q + 1].x * rs, oa##j[2 * q + 1].y * rs} * gv + bv; *(f32x4*)(frow + c0) = y; if (xb) *(u32x2*)(xb + (size_t)r * D_MODEL + c0) = pk4(y); } }
DI void xcd_soft_sync(unsigned* cnt, volatile LAS unsigned* st, unsigned x, unsigned& round) {
    if (!st) return;
    __syncthreads();
    if (threadIdx.x == 0) { const unsigned nloc = st[0];
        if (nloc) { unsigned* c = cnt + 64 * x; (void)xb_add(c, 1u); const unsigned target = (round + 1u) * nloc; unsigned sp = 0;
            while (xb_ld(c) < target && ++sp < 4096u) __builtin_amdgcn_s_sleep(1); } }
    __syncthreads(); ++round;
}
DI void peer_sharded2_phase(const FP& P, const Ctx& C, int layer, const float* xin, const bf16* xb16, float* fout, bf16* xb, volatile LAS unsigned* st = nullptr, unsigned xcc = 0) {
    unsigned round = 0; unsigned* hint = P.ctl + 8192 + layer * 1024;
    const int lane = C.lane; const unsigned char* U = P.UB8 + (size_t)layer * PEER_EXPERTS * D_MODEL; const unsigned char* Vt = P.VB8 + (size_t)layer * PEER_EXPERTS * D_MODEL;
    const float* gam = P.ln_g + ((size_t)layer * 2 + 1) * D_MODEL; const float* bet = P.ln_b + ((size_t)layer * 2 + 1) * D_MODEL;
    const int NW = C.G * NWAVES, gw = C.vcu * NWAVES + C.wave; const int nquads = (M0 / NW) / PS2_ROWS;
#pragma unroll 1
    for (int qd = 0; qd < nquads; ++qd) {
#if PS2_ROWS == 4
        PS2_ROW(0) PS2_ROW(1) PS2_ROW(2) PS2_ROW(3)
#pragma unroll 1
        for (int s = 0; s < PSH_N; ++s) {
#ifdef PEER_SOFTSYNC
            xcd_soft_sync(hint, st, xcc, round);
#endif
            PS2_STEP(0) PS2_STEP(1) PS2_STEP(2) PS2_STEP(3) }
        PS2_LN(0) PS2_LN(1) PS2_LN(2) PS2_LN(3)
#else
        PS2_ROW(0) PS2_ROW(1)
#pragma unroll 1
        for (int s = 0; s < PSH_N; ++s) { PS2_STEP(0) PS2_STEP(1) }
        PS2_LN(0) PS2_LN(1)
#endif
    }
}
#define PS3_ROW(j) const int row##j = (qd * 4 + j) * NW + gw; const int el##j = P.SELE[(size_t)row##j * 128 + lane], eh##j = P.SELE[(size_t)row##j * 128 + 64 + lane]; \
    { const u32x4 xa = *(const u32x4*)(xb16 + (size_t)row##j * D_MODEL + 16 * lane), xc = *(const u32x4*)(xb16 + (size_t)row##j * D_MODEL + 16 * lane + 8); *(LAS u32x4*)(xs + j * 1024 + 16 * lane) = xa; *(LAS u32x4*)(xs + j * 1024 + 16 * lane + 8) = xc; } \
    f32x2 oa##j[8]; _Pragma("unroll") for (int k = 0; k < 8; ++k) oa##j[k] = (f32x2){0.f, 0.f};
#define PS3_X2_UNUSED(j) const f32x2 x2[8] = {(f32x2){bflo(xa##j.x), bfhi(xa##j.x)}, (f32x2){bflo(xa##j.y), bfhi(xa##j.y)}, (f32x2){bflo(xa##j.z), bfhi(xa##j.z)}, (f32x2){bflo(xa##j.w), bfhi(xa##j.w)}, (f32x2){bflo(xc##j.x), bfhi(xc##j.x)}, (f32x2){bflo(xc##j.y), bfhi(xc##j.y)}, (f32x2){bflo(xc##j.z), bfhi(xc##j.z)}, (f32x2){bflo(xc##j.w), bfhi(xc##j.w)}};
#define PS3_TAKE(q, M, ELH, GOFF) if (!got && M) { const int h = __builtin_ctzll(M); M &= M - 1; qq[k] = q; ee = __builtin_amdgcn_readlane(ELH, h); gk[k] = P.SELG[GOFF + h];     got = true; ++nv; }
DI void peer_sharded3_phase(const FP& P, const Ctx& C, int layer, const float* xin, const bf16* xb16, float* fout, bf16* xb) {
    const int lane = C.lane; const unsigned char* U = P.UB8 + (size_t)layer * PEER_EXPERTS * D_MODEL; const unsigned char* Vt = P.VB8 + (size_t)layer * PEER_EXPERTS * D_MODEL;
    const float* gam = P.ln_g + ((size_t)layer * 2 + 1) * D_MODEL; const float* bet = P.ln_b + ((size_t)layer * 2 + 1) * D_MODEL;
    const int NW = C.G * NWAVES, gw = C.vcu * NWAVES + C.wave; const int nquads = (M0 / NW) / 4; LAS bf16* xs = (LAS bf16*)(C.lds + C.wave * 16384);
#pragma unroll 1
    for (int qd = 0; qd < nquads; ++qd) {
        PS3_ROW(0) PS3_ROW(1) PS3_ROW(2) PS3_ROW(3)
        asm volatile("s_waitcnt lgkmcnt(0)" ::: "memory");
#pragma unroll 1
        for (int s = 0; s < PSH_N; ++s) {
            unsigned long long m0 = __ballot((el0 >> PSH_LOG) == s), m1 = __ballot((eh0 >> PSH_LOG) == s), m2 = __ballot((el1 >> PSH_LOG) == s), m3 = __ballot((eh1 >> PSH_LOG) == s),
                               m4 = __ballot((el2 >> PSH_LOG) == s), m5 = __ballot((eh2 >> PSH_LOG) == s), m6 = __ballot((el3 >> PSH_LOG) == s), m7 = __ballot((eh3 >> PSH_LOG) == s);
#pragma unroll 1
            while ((m0 | m1 | m2 | m3 | m4 | m5 | m6 | m7) != 0ull) {
                int qq[8]; float gk[8]; int es[8]; u32x4 uw[8]; int nv = 0; int elast = 0;
#pragma unroll
                for (int k = 0; k < 8; ++k) { bool got = false; int ee = elast; qq[k] = k > 0 ? qq[k - 1] : 0; gk[k] = 0.f;
                    PS3_TAKE(0, m0, el0, (size_t)row0 * 128) PS3_TAKE(1, m1, eh0, (size_t)row0 * 128 + 64) PS3_TAKE(2, m2, el1, (size_t)row1 * 128) PS3_TAKE(3, m3, eh1, (size_t)row1 * 128 + 64) PS3_TAKE(4, m4, el2, (size_t)row2 * 128) PS3_TAKE(5, m5, eh2, (size_t)row2 * 128 + 64) PS3_TAKE(6, m6, el3, (size_t)row3 * 128) PS3_TAKE(7, m7, eh3, (size_t)row3 * 128 + 64)
                    elast = ee; es[k] = ee; uw[k] = *(const u32x4*)(U + (size_t)ee * D_MODEL + 16 * lane); }
                float d[8];
#pragma unroll
                for (int k = 0; k < 8; ++k) { const int j = qq[k] >> 1; const u32x4 xa = *(const LAS u32x4*)(xs + j * 1024 + 16 * lane), xc = *(const LAS u32x4*)(xs + j * 1024 + 16 * lane + 8);
                    const f32x2 x2[8] = {(f32x2){bflo(xa.x), bfhi(xa.x)}, (f32x2){bflo(xa.y), bfhi(xa.y)}, (f32x2){bflo(xa.z), bfhi(xa.z)}, (f32x2){bflo(xa.w), bfhi(xa.w)}, (f32x2){bflo(xc.x), bfhi(xc.x)}, (f32x2){bflo(xc.y), bfhi(xc.y)}, (f32x2){bflo(xc.z), bfhi(xc.z)}, (f32x2){bflo(xc.w), bfhi(xc.w)}};
                    d[k] = dot16_fp8(uw[k], x2); }
                u32x4 vw[8];
#pragma unroll
                for (int k = 0; k < 8; ++k) vw[k] = *(const u32x4*)(Vt + (size_t)es[k] * D_MODEL + 16 * lane);
                float e4[4], e2[2], e1s;
                { const bool hi = lane & 1;
#pragma unroll
                  for (int i = 0; i < 4; ++i) { const float keep = hi ? d[4 + i] : d[i], send = hi ? d[i] : d[4 + i]; e4[i] = keep + __shfl_xor(send, 1); } }
                { const bool hi = lane & 2;
#pragma unroll
                  for (int i = 0; i < 2; ++i) { const float keep = hi ? e4[2 + i] : e4[i], send = hi ? e4[i] : e4[2 + i]; e2[i] = keep + __shfl_xor(send, 2); } }
                { const bool hi = lane & 4; const float keep = hi ? e2[1] : e2[0], send = hi ? e2[0] : e2[1]; e1s = keep + __shfl_xor(send, 4); }
                e1s += __shfl_xor(e1s, 8); e1s += __shfl_xor(e1s, 16); e1s += __shfl_xor(e1s, 32);
                const int myk = 4 * (lane & 1) + (lane & 2) + ((lane >> 2) & 1); float myg = gk[0];
#pragma unroll
                for (int k = 1; k < 8; ++k) myg = (myk == k) ? gk[k] : myg;
                const float act = myg * gelu_tanh(e1s * (1.0f / PEER_SU)) * (1.0f / PEER_SV);
#pragma unroll
                for (int k = 0; k < 8; ++k) { const int src = (k >> 2) | (((k >> 1) & 1) << 1) | ((k & 1) << 2); const float a = rdlane(act, src); const int j = qq[k] >> 1;
                    if (j == 0) { asm volatile("" ::: "memory"); axpy16_fp8(vw[k], a, oa0); } else if (j == 1) { asm volatile("" ::: "memory"); axpy16_fp8(vw[k], a, oa1); } else if (j == 2) { asm volatile("" ::: "memory"); axpy16_fp8(vw[k], a, oa2); } else { asm volatile("" ::: "memory"); axpy16_fp8(vw[k], a, oa3); } }
            }
        }
        PS2_LN(0) PS2_LN(1) PS2_LN(2) PS2_LN(3)
    }
}
}
namespace fx {
struct EpiB {
    static constexpr bool PERM = true, AFTER_DRAIN = false; const FP& P;
    DI void operator()(const f32x4 (&acc)[2][2][4][2], const pg8::Unit& u, int wr, int wc, int fr, int fq) const {
        const int t = u.pn;
        EPI_LOOP({ if (row < MP) { const int pos = row_pos(row), n = row / SEQ, e = ct & 63, dp = e >> 1; const bool prm = row < M0;
            if (t < 3) { const int ty = 2 * t + (ct >> 7), kvh = (ct >> 6) & 1;
                if (ty == 2 || ty == 4) { f32x4 lo, hi; rope4(P.ROPE + pos * 64, dp, v0, v1, lo, hi);
                    if (ty == 2) { float* o = (prm ? P.nsa_kv_p + (size_t)row * 512 : P.nsa_kv_s + (size_t)(row - M0) * 512) + 256 + kvh * 64 + dp; *(f32x4*)o = lo; *(f32x4*)(o + 32) = hi;
                        if (prm) { bf16* kt = P.SLK + ((size_t)n * NSA_KV_HEADS + kvh) * SEQ * 64; *(u32x2*)(kt + ktile_off(pos, dp)) = pk4(lo); *(u32x2*)(kt + ktile_off(pos, dp + 32)) = pk4(hi); } }
                    else { float* o = nullptr; if (!prm) o = P.win_s + (((size_t)(row - M0) * SWA_WINDOW + SWA_WINDOW - 1) * 2 + 0) * 128; else if (pos >= SEQ - SWA_WINDOW) o = P.win_p + (((size_t)n * SWA_WINDOW + pos - (SEQ - SWA_WINDOW)) * 2 + 0) * 128;
                        if (o) { *(f32x4*)(o + kvh * 64 + dp) = lo; *(f32x4*)(o + kvh * 64 + 32 + dp) = hi; }
                        if (prm) { bf16* kt = P.WNK + ((size_t)n * NSA_KV_HEADS + kvh) * SEQ * 64; *(u32x2*)(kt + ktile_off(pos, dp)) = pk4(lo); *(u32x2*)(kt + ktile_off(pos, dp + 32)) = pk4(hi); } } }
                else if (ty < 4) { float* o = (prm ? P.nsa_kv_p + (size_t)row * 512 : P.nsa_kv_s + (size_t)(row - M0) * 512) + ty * 128 + kvh * 64 + e; *(f32x4*)o = v0; *(f32x4*)(o + 4) = v1;
                    if (prm) { if (ty < 2) *(u32x4*)(P.AC + ((size_t)ty * ACROWS + ((size_t)n * NSA_KV_HEADS + kvh) * NCH + pos / 16) * 1024 + (pos % 16) * 64 + e) = pk8(v0, v1);
                        else { bf16* vt = P.SLVT + ((size_t)n * NSA_KV_HEADS + kvh) * SEQ * 64 + vtile_off(e, pos);
                            vt[0] = (bf16)f2bf(v0.x); vt[8] = (bf16)f2bf(v0.y); vt[16] = (bf16)f2bf(v0.z); vt[24] = (bf16)f2bf(v0.w); vt[32] = (bf16)f2bf(v1.x); vt[40] = (bf16)f2bf(v1.y); vt[48] = (bf16)f2bf(v1.z); vt[56] = (bf16)f2bf(v1.w); } } }
                else { float* o = nullptr; if (!prm) o = P.win_s + (((size_t)(row - M0) * SWA_WINDOW + SWA_WINDOW - 1) * 2 + 1) * 128; else if (pos >= SEQ - SWA_WINDOW) o = P.win_p + (((size_t)n * SWA_WINDOW + pos - (SEQ - SWA_WINDOW)) * 2 + 1) * 128;
                    if (o) { *(f32x4*)(o + kvh * 64 + e) = v0; *(f32x4*)(o + kvh * 64 + e + 4) = v1; }
                    if (prm) { bf16* vt = P.WNVT + ((size_t)n * NSA_KV_HEADS + kvh) * SEQ * 64 + vtile_off(e, pos);
                        vt[0] = (bf16)f2bf(v0.x); vt[8] = (bf16)f2bf(v0.y); vt[16] = (bf16)f2bf(v0.z); vt[24] = (bf16)f2bf(v0.w); vt[32] = (bf16)f2bf(v1.x); vt[40] = (bf16)f2bf(v1.y); vt[48] = (bf16)f2bf(v1.z); vt[56] = (bf16)f2bf(v1.w); } } }
            else if (t < 6) { const int h = (t - 3) * 4 + (ct >> 6); f32x4 lo, hi; rope4(P.ROPE + pos * 64, dp, v0, v1, lo, hi); bf16* q = P.QB + (size_t)row * NSA_Q_COLS + h * 64 + dp; *(u32x2*)q = pk4(lo * QSCALE); *(u32x2*)(q + 32) = pk4(hi * QSCALE); }
            else if (t == 6) { *(u32x4*)(P.MQB + (size_t)row * 256 + ct) = pk8(v0 * QSCALE, v1 * QSCALE); }
            else if (ct < 40) { const float vv[8] = {v0.x, v0.y, v0.z, v0.w, v1.x, v1.y, v1.z, v1.w};
                _Pragma("unroll") for (int i = 0; i < 8; ++i) if (ct + i < NSA_GATE_COLS) P.GATES[(size_t)row * 64 + ct + i] = 1.0f / (1.0f + __expf(-vv[i])); } } })
    }
};
DI void cmp2_phase(const FP& P, const Ctx& C) {
    const int lane = C.lane; LAS float* hs = (LAS float*)(C.lds + C.wave * 1024);
    constexpr int NGRP = NCTX * 2 * NSA_KV_HEADS; const int NW = C.G * NWAVES, WPG = NW / NGRP > 0 ? NW / NGRP : 1; const int gw = C.vcu * NWAVES + C.wave;
#pragma unroll 1
    for (int grp = gw / WPG; grp < NGRP; grp += (NW + WPG - 1) / WPG) { const int slot = gw % WPG; if (gw >= (NW / WPG) * WPG && grp == gw / WPG) break;
        const int kvh = grp % NSA_KV_HEADS, ty = (grp / NSA_KV_HEADS) % 2, ctx = grp / (2 * NSA_KV_HEADS);
        const float* UL = P.UL + ((size_t)ty * ACROWS + ((size_t)ctx * NSA_KV_HEADS + kvh) * NCH) * 256; const float* w2 = P.cmp_w2 + (size_t)ty * CMP_HIDDEN * HEAD_DIM;
        float w2r[CMP_HIDDEN];
#pragma unroll
        for (int k = 0; k < CMP_HIDDEN; ++k) w2r[k] = w2[k * HEAD_DIM + lane];
        const float b0 = P.CBIAS[ty * CMP_HIDDEN + lane], b1 = P.CBIAS[ty * CMP_HIDDEN + 64 + lane];
        float u0, u1, l0, l1; int c = slot;
        if (c < NCMP) { u0 = UL[(size_t)c * 256 + lane]; u1 = UL[(size_t)c * 256 + 64 + lane]; l0 = UL[(size_t)(c + 1) * 256 + 128 + lane]; l1 = UL[(size_t)(c + 1) * 256 + 192 + lane]; }
#pragma unroll 1
        for (; c < NCMP; c += WPG) { const float h0 = gelu_tanh(u0 + l0 + b0), h1 = gelu_tanh(u1 + l1 + b1); const int cn = c + WPG;
            if (cn < NCMP) { u0 = UL[(size_t)cn * 256 + lane]; u1 = UL[(size_t)cn * 256 + 64 + lane]; l0 = UL[(size_t)(cn + 1) * 256 + 128 + lane]; l1 = UL[(size_t)(cn + 1) * 256 + 192 + lane]; }
            hs[lane] = h0; hs[64 + lane] = h1; asm volatile("s_waitcnt lgkmcnt(0)" ::: "memory");
            float a = 0.f;
#pragma unroll
            for (int k4 = 0; k4 < CMP_HIDDEN / 4; ++k4) { const f32x4 hv = *(const LAS f32x4*)(hs + 4 * k4); a += hv.x * w2r[4 * k4] + hv.y * w2r[4 * k4 + 1] + hv.z * w2r[4 * k4 + 2] + hv.w * w2r[4 * k4 + 3]; }
            if (ty == 0) { const float other = __shfl_xor(a, 32); const int pos = c * CMP_STRIDE + CMP_BLOCK - 1; const float cs = P.ROPE[pos * 64 + (lane & 31)], sn = P.ROPE[pos * 64 + 32 + (lane & 31)];
                a = (lane < 32) ? a * cs - other * sn : a * cs + other * sn; }
            if (ctx < BATCH) { if (ty == 0) P.CK[((size_t)ctx * NSA_KV_HEADS + kvh) * NCH * 64 + ktile_off(c, lane)] = (bf16)f2bf(a); else P.CVT[((size_t)ctx * NSA_KV_HEADS + kvh) * NCH * 64 + vtile_off(lane, c)] = (bf16)f2bf(a); }
            else { (ty == 0 ? P.CKF : P.CVF)[(((size_t)(ctx - BATCH) * NSA_KV_HEADS + kvh) * NCH + c) * 64 + lane] = a; }
            asm volatile("s_waitcnt lgkmcnt(0)" ::: "memory"); }
    }
    __syncthreads();
}
constexpr int NSA_WLDS = 8192;
DI void nsa_pair_a(const FP& P, int n, int kvh, int t, int lane, LAS unsigned char* wl) {
    LAS float* pn = (LAS float*)wl; LAS float* imp = (LAS float*)(wl + 2048); LAS float* sc = (LAS float*)(wl + 6144); LAS int* sel = (LAS int*)(wl + 7168);
    const int col = lane & 15, c = lane >> 4; const bool vcol = col < 12; const int qq = vcol ? col / 6 : 0, hh = vcol ? col % 6 : 0, tq = t + qq, head = kvh * NSA_GROUP + hh, row = n * SEQ + tq;
    bf16x8 qf[2]; { const bf16* qp = P.QB + (size_t)row * NSA_Q_COLS + head * 64 + 8 * c; qf[0] = *(const bf16x8*)qp; qf[1] = *(const bf16x8*)(qp + 32); }
    const float* gt = P.GATES + (size_t)row * 64 + head * 3;
    f32x4 oacc[4] = {(f32x4){0.f, 0.f, 0.f, 0.f}, (f32x4){0.f, 0.f, 0.f, 0.f}, (f32x4){0.f, 0.f, 0.f, 0.f}, (f32x4){0.f, 0.f, 0.f, 0.f}};
    const int lim = vcol ? ((tq >= CMP_BLOCK - 1) ? (tq - (CMP_BLOCK - 1)) / CMP_STRIDE : -1) : -1;
    const int limmax = (t + 1 >= CMP_BLOCK - 1) ? (t + 1 - (CMP_BLOCK - 1)) / CMP_STRIDE : -1; const int nblk = (limmax + 32) / 32;
    const bf16* CKb = P.CK + ((size_t)n * NSA_KV_HEADS + kvh) * NCH * 64; const bf16* CVb = P.CVT + ((size_t)n * NSA_KV_HEADS + kvh) * 64 * NCH;
    for (int i = lane; i < 1024; i += 64) imp[i] = 0.f;
    float m1 = -INFINITY, l1 = 0.f;
    { struct K4 { bf16x8 a0, a1, b0, b1; };
      auto ldk = [&](K4& k, int blk) { const bf16* kt = CKb + (size_t)blk * 2048 + lane * 8; k.a0 = *(const bf16x8*)kt; k.a1 = *(const bf16x8*)(kt + 512); k.b0 = *(const bf16x8*)(kt + 1024); k.b1 = *(const bf16x8*)(kt + 1536); };
      auto cp1 = [&](const K4& k, int blk) { const int kb = 32 * blk;
        f32x4 s0 = (f32x4){0.f, 0.f, 0.f, 0.f}, s1 = (f32x4){0.f, 0.f, 0.f, 0.f};
        s0 = __builtin_amdgcn_mfma_f32_16x16x32_bf16(k.a0, qf[0], s0, 0, 0, 0); s0 = __builtin_amdgcn_mfma_f32_16x16x32_bf16(k.a1, qf[1], s0, 0, 0, 0);
        s1 = __builtin_amdgcn_mfma_f32_16x16x32_bf16(k.b0, qf[0], s1, 0, 0, 0); s1 = __builtin_amdgcn_mfma_f32_16x16x32_bf16(k.b1, qf[1], s1, 0, 0, 0);
        float s[8] = {s0.x, s0.y, s0.z, s0.w, s1.x, s1.y, s1.z, s1.w}; float mx = -INFINITY;
        const int hi1 = lim - (kb + 8 * c);
#pragma unroll
        for (int e = 0; e < 8; ++e) { s[e] = (e <= hi1) ? s[e] : -INFINITY; mx = fmaxf(mx, s[e]); }
        mx = colmax(mx);
        const float mnew = fmaxf(m1, mx), muse = (mnew == -INFINITY) ? 0.f : mnew; float ls = 0.f;
#pragma unroll
        for (int e = 0; e < 8; ++e) ls += __builtin_amdgcn_exp2f(s[e] - muse);
        l1 = l1 * __builtin_amdgcn_exp2f(m1 - muse) + ls; m1 = mnew; };
      if (nblk > 0) { K4 A, B; ldk(A, 0);
#pragma unroll 1
        for (int blk = 0; blk < nblk; blk += 2) { ldk(B, (blk + 1 < nblk) ? blk + 1 : blk); cp1(A, blk); ldk(A, (blk + 2 < nblk) ? blk + 2 : blk); if (blk + 1 < nblk) cp1(B, blk + 1); } } }
    asm volatile("s_waitcnt lgkmcnt(0)" ::: "memory");
    { l1 = colsum(l1); const float muse = (m1 == -INFINITY) ? 0.f : m1, inv = (l1 > 0.f) ? 1.0f / l1 : 0.f;
      f32x4 oc[4] = {(f32x4){0.f, 0.f, 0.f, 0.f}, (f32x4){0.f, 0.f, 0.f, 0.f}, (f32x4){0.f, 0.f, 0.f, 0.f}, (f32x4){0.f, 0.f, 0.f, 0.f}};
      pipe2(nblk, [&](KV8& kv, int blk) { kv_load_t(kv, CKb + (size_t)blk * 2048, CVb + (size_t)blk * 2048, lane); }, [&](const KV8& kv, int blk) { const int kb = 32 * blk;
        f32x4 s0 = (f32x4){0.f, 0.f, 0.f, 0.f}, s1 = (f32x4){0.f, 0.f, 0.f, 0.f};
        s0 = __builtin_amdgcn_mfma_f32_16x16x32_bf16(kv.ka0, qf[0], s0, 0, 0, 0); s0 = __builtin_amdgcn_mfma_f32_16x16x32_bf16(kv.ka1, qf[1], s0, 0, 0, 0);
        s1 = __builtin_amdgcn_mfma_f32_16x16x32_bf16(kv.kb0, qf[0], s1, 0, 0, 0); s1 = __builtin_amdgcn_mfma_f32_16x16x32_bf16(kv.kb1, qf[1], s1, 0, 0, 0);
        float s[8] = {s0.x, s0.y, s0.z, s0.w, s1.x, s1.y, s1.z, s1.w};
        const int hi2 = lim - (kb + 8 * c);
#pragma unroll
        for (int e = 0; e < 8; ++e) s[e] = (e <= hi2) ? __builtin_amdgcn_exp2f(s[e] - muse) * inv : 0.f;
        *(f32x4*)(pn + col * 32 + 8 * c) = (f32x4){s[0], s[1], s[2], s[3]}; *(f32x4*)(pn + col * 32 + 8 * c + 4) = (f32x4){s[4], s[5], s[6], s[7]};
        u32x4 pw; pw.x = cvtpk(s[0], s[1]); pw.y = cvtpk(s[2], s[3]); pw.z = cvtpk(s[4], s[5]); pw.w = cvtpk(s[6], s[7]); const bf16x8 pf = __builtin_bit_cast(bf16x8, pw);
        oc[0] = __builtin_amdgcn_mfma_f32_16x16x32_bf16(kv.v0, pf, oc[0], 0, 0, 0); oc[1] = __builtin_amdgcn_mfma_f32_16x16x32_bf16(kv.v1, pf, oc[1], 0, 0, 0);
        oc[2] = __builtin_amdgcn_mfma_f32_16x16x32_bf16(kv.v2, pf, oc[2], 0, 0, 0); oc[3] = __builtin_amdgcn_mfma_f32_16x16x32_bf16(kv.v3, pf, oc[3], 0, 0, 0);
        asm volatile("s_waitcnt lgkmcnt(0)" ::: "memory");
        { const int q2 = lane >> 5, k = lane & 31; float a = 0.f;
#pragma unroll
          for (int h6 = 0; h6 < 6; ++h6) a += pn[(q2 * 6 + h6) * 32 + k];
          imp[q2 * 512 + kb + k] = a; }
        asm volatile("s_waitcnt lgkmcnt(0)" ::: "memory"); });
#ifdef NSA_DEBUG
      if (vcol) { for (int db = 0; db < 4; ++db) *(f32x4*)(P.DBG + ((size_t)0 * MP + row) * 768 + head * 64 + 16 * db + 4 * c) = oc[db]; }
#endif
      const float g0 = vcol ? gt[0] : 0.f;
#pragma unroll
      for (int db = 0; db < 4; ++db) oacc[db] += oc[db] * g0; }
#ifndef REP_SEL
#define REP_SEL 1
#endif
#pragma unroll 1
    for (int rep = 0; rep < REP_SEL; ++rep) {
    for (int i = lane; i < 256; i += 64) { const int q2 = i >> 7, b = i & 127, tq2 = t + q2, cur = tq2 / SLC_BLOCK; float sv;
        if (b > cur) sv = NEG; else if (b == 0 || b == cur || b == cur - 1) sv = FORCE_SCORE;
        else { const LAS float* ic = imp + q2 * 512 + 4 * b; sv = ic[-1] + 2.f * (ic[0] + ic[1] + ic[2]) + ic[3]; }
        sc[i] = pack_key(sv, 127u - (unsigned)b, 127u); }
    asm volatile("s_waitcnt lgkmcnt(0)" ::: "memory");
    for (int i = lane; i < 256; i += 64) { const int q2 = i >> 7, b = i & 127; const float sv = sc[i]; int rank = 0;
        for (int j = 0; j < 128; j += 4) { const f32x4 o = *(const LAS f32x4*)(sc + q2 * 128 + j);
            rank += (o.x > sv) ? 1 : 0; rank += (o.y > sv) ? 1 : 0; rank += (o.z > sv) ? 1 : 0; rank += (o.w > sv) ? 1 : 0; }
        if (rank < SLC_TOPK) { const int v = (sv > 0.5f * NEG) ? b : -1; sel[q2 * 16 + rank] = v; P.SELB[((size_t)(n * SEQ + t + q2) * NSA_KV_HEADS + kvh) * 16 + rank] = v; } }
    asm volatile("s_waitcnt lgkmcnt(0)" ::: "memory");
    }
#ifndef REP_WIN
#define REP_WIN 1
#endif
#pragma unroll 1
    for (int rep = 0; rep < REP_WIN; ++rep) { Tile16 T; tile_init(T);
      const bf16* WKb = P.WNK + ((size_t)n * NSA_KV_HEADS + kvh) * SEQ * 64; const bf16* WVb = P.WNVT + ((size_t)n * NSA_KV_HEADS + kvh) * 64 * SEQ;
      const int blo = (t - SWA_WINDOW) >> 5, bhi = (t + 1) >> 5;
      auto ld = [&](KV8& kv, int blk) { const int bc = blk < 0 ? 0 : blk; kv_load_t(kv, WKb + (size_t)bc * 2048, WVb + (size_t)bc * 2048, lane); };
      pipe2(bhi - blo + 1, [&](KV8& kv, int i) { ld(kv, blo + i); }, [&](const KV8& kv, int i) { const int kb = 32 * (blo + i);
          const int k0 = kb + 8 * c; int lo; unsigned rng; const int a = tq - SWA_WINDOW; mk_range((a > 0 ? a : 0) - k0, tq - k0, vcol, lo, rng); tile_compute(T, qf, kv, lo, rng); });
      T.l = colsum(T.l);
      const float inv = (T.l > 0.f) ? 1.0f / T.l : 0.f, g2 = vcol ? gt[2] * inv : 0.f;
#ifdef NSA_DEBUG
      if (vcol) { for (int db = 0; db < 4; ++db) *(f32x4*)(P.DBG + ((size_t)2 * MP + row) * 768 + head * 64 + 16 * db + 4 * c) = T.o[db] * inv; }
#endif
#pragma unroll
      for (int db = 0; db < 4; ++db) if (rep == REP_WIN - 1) oacc[db] += T.o[db] * g2; }
    if (vcol) { float* op = P.DPART + (size_t)row * 768 + head * 64 + 4 * c;
#pragma unroll
        for (int db = 0; db < 4; ++db) *(f32x4*)(op + 16 * db) = oacc[db]; }
}
DI void nsa_pair_b(const FP& P, int n, int kvh, int t, int lane, LAS unsigned char* wl) {
    LAS int* steps = (LAS int*)wl;
    const int col = lane & 15, c = lane >> 4; const bool vcol = col < 12; const int qq = vcol ? col / 6 : 0, hh = vcol ? col % 6 : 0, tq = t + qq, head = kvh * NSA_GROUP + hh, row = n * SEQ + tq;
    bf16x8 qf[2]; { const bf16* qp = P.QB + (size_t)row * NSA_Q_COLS + head * 64 + 8 * c; qf[0] = *(const bf16x8*)qp; qf[1] = *(const bf16x8*)(qp + 32); }
    const float* gt = P.GATES + (size_t)row * 64 + head * 3;
    Tile16 T; tile_init(T);
    const bf16* SKb = P.SLK + ((size_t)n * NSA_KV_HEADS + kvh) * SEQ * 64; const bf16* SVb = P.SLVT + ((size_t)n * NSA_KV_HEADS + kvh) * SEQ * 64;
    int ns = 0;
    { const int mysel = (lane < 32) ? P.SELB[((size_t)(n * SEQ + t + (lane >> 4)) * NSA_KV_HEADS + kvh) * 16 + (lane & 15)] : -1;
      for (int i = 0; i < 32; ++i) { const int b = __builtin_amdgcn_readlane(mysel, i); if (b < 0) continue; int q2 = i >> 4;
          const unsigned long long other = __ballot(mysel == b && lane < 32 && (lane >> 4) != q2);
          if (other) { if (q2 == 1) continue; q2 = 2; }
          if (lane == 0) { steps[ns] = (b * SLC_BLOCK) | (q2 << 29); steps[ns + 1] = (b * SLC_BLOCK + 32) | (q2 << 29); } ns += 2; } }
    asm volatile("s_waitcnt lgkmcnt(0)" ::: "memory");
    auto ld = [&](KV8& kv, int i) { const int code = __builtin_amdgcn_readfirstlane(steps[i]); const int kb = code & 0x1fffffff;
        kv_load_t(kv, SKb + (size_t)(kb >> 5) * 2048, SVb + (size_t)(kb >> 5) * 2048, lane); };
#ifdef PROBE_DBLCOMP
    Tile16 T2; tile_init(T2);
#endif
    pipe2(ns, ld, [&](const KV8& kv, int i) { const int code = __builtin_amdgcn_readfirstlane(steps[i]); const int kb = code & 0x1fffffff, q2 = code >> 29;
        int lo; unsigned rng; mk_range(-64, tq - (kb + 8 * c), vcol && (q2 == 2 || qq == q2), lo, rng); tile_compute(T, qf, kv, lo, rng);
#ifdef PROBE_DBLCOMP
        tile_compute(T2, qf, kv, [&](int e) { return vcol && qq == q2 && (kb + 8 * c + e + 1) <= tq; });
#endif
    });
#ifdef PROBE_DBLCOMP
    if (T2.l < 0.f) T.l = 0.f;
#endif
    T.l = colsum(T.l);
    const float inv = (T.l > 0.f) ? 1.0f / T.l : 0.f, g1 = vcol ? gt[1] * inv : 0.f;
#ifdef NSA_DEBUG
    if (vcol) { for (int db = 0; db < 4; ++db) *(f32x4*)(P.DBG + ((size_t)1 * MP + row) * 768 + head * 64 + 16 * db + 4 * c) = T.o[db] * inv; }
#endif
    if (vcol) { const float* pp = P.DPART + (size_t)row * 768 + head * 64 + 4 * c; bf16* op = P.ATTB + (size_t)row * 1024 + head * 64 + 4 * c;
#pragma unroll
        for (int db = 0; db < 4; ++db) *(u32x2*)(op + 16 * db) = pk4(*(const f32x4*)(pp + 16 * db) + T.o[db] * g1); }
}

constexpr int SMP_SK = 1088;
template <class KF, class VF> DI void smp_branch(const Ctx& C, LAS float* qs, LAS float* S, LAS float* red, int NK, KF kf, VF vf, bool keep_probs, float (&outh)[1]) {
    const int tid = C.tid, lane = C.lane, w = C.wave;
#pragma unroll 1
    for (int j = tid; j < NK; j += NTHREADS) { const float* k = kf(j); f32x4 kr[16];
#pragma unroll
        for (int d4 = 0; d4 < 16; ++d4) kr[d4] = *(const f32x4*)(k + 4 * d4);
#pragma unroll 1
        for (int h = 0; h < 6; ++h) { float a = 0.f;
#pragma unroll
            for (int d4 = 0; d4 < 16; ++d4) { const f32x4 qv = *(const LAS f32x4*)(qs + h * 64 + 4 * d4); a += kr[d4].x * qv.x + kr[d4].y * qv.y + kr[d4].z * qv.z + kr[d4].w * qv.w; }
            S[h * SMP_SK + j] = a; } }
    asm volatile("s_waitcnt lgkmcnt(0)" ::: "memory"); __syncthreads();
    if (w < 6) { float m = -INFINITY; for (int j = lane; j < NK; j += 64) m = fmaxf(m, S[w * SMP_SK + j]); m = wave_max(m);
        float l = 0.f; for (int j = lane; j < NK; j += 64) { const float p = __builtin_amdgcn_exp2f(S[w * SMP_SK + j] - m); S[w * SMP_SK + j] = p; l += p; } l = wave_sum(l);
        const float inv = 1.0f / l; for (int j = lane; j < NK; j += 64) S[w * SMP_SK + j] *= inv; }
    asm volatile("s_waitcnt lgkmcnt(0)" ::: "memory"); __syncthreads();
    { const int per = (NK + NWAVES - 1) / NWAVES, j0 = w * per, j1 = (j0 + per < NK) ? j0 + per : NK; float o[6] = {0.f, 0.f, 0.f, 0.f, 0.f, 0.f};
#pragma unroll 1
      for (int j = j0; j < j1; j += 8) { float vv[8];
#pragma unroll
          for (int u = 0; u < 8; ++u) { const int jj = (j + u < j1) ? j + u : j1 - 1; vv[u] = vf(jj)[lane]; }
#pragma unroll
          for (int u = 0; u < 8; ++u) if (j + u < j1) {
#pragma unroll
              for (int h = 0; h < 6; ++h) o[h] += S[h * SMP_SK + j + u] * vv[u]; } }
#pragma unroll
      for (int h = 0; h < 6; ++h) red[(w * 6 + h) * 64 + lane] = o[h]; }
    asm volatile("s_waitcnt lgkmcnt(0)" ::: "memory"); __syncthreads();
    outh[0] = 0.f;
    if (tid < 384) { float a = 0.f;
#pragma unroll
        for (int ww = 0; ww < NWAVES; ++ww) a += red[ww * 384 + tid]; outh[0] = a; }
    if (!keep_probs) { __syncthreads(); }
}
DI void nsa_sample_item(const FP& P, const Ctx& C, int ns, int kvh) {
    LAS float* qs = (LAS float*)C.lds; LAS float* S = qs + 384; LAS float* red = S + 6 * SMP_SK; LAS float* scs = red + 8 * 384; LAS int* sel = (LAS int*)(scs + 136);
    const int tid = C.tid, row = M0 + ns;
    if (tid < 384) qs[tid] = bf2f(P.QB[(size_t)row * NSA_Q_COLS + kvh * 384 + tid]);
    asm volatile("s_waitcnt lgkmcnt(0)" ::: "memory"); __syncthreads();
    const float* ckf = P.CKF + ((size_t)ns * NSA_KV_HEADS + kvh) * NCH * 64; const float* cvf = P.CVF + ((size_t)ns * NSA_KV_HEADS + kvh) * NCH * 64;
    float oc[1], os[1], ow[1];
    smp_branch(C, qs, S, red, NCMP, [&](int j) { return ckf + (size_t)j * 64; }, [&](int j) { return cvf + (size_t)j * 64; }, true, oc);
    constexpr int NBS = (PAST_LEN + 1 + SLC_BLOCK - 1) / SLC_BLOCK, CURS = PAST_LEN / SLC_BLOCK;
    for (int b = tid; b < 136; b += NTHREADS) { float sv = -3.0e38f;
        if (b < NBS) { if (b == 0 || b == CURS || b == CURS - 1) sv = FORCE_SCORE; else { float a = 0.f;
#pragma unroll
                for (int o = -1; o <= 3; ++o) { const int ci = 4 * b + o; if (ci >= 0 && ci < NCMP) { float sm = 0.f; for (int h6 = 0; h6 < 6; ++h6) sm += S[h6 * SMP_SK + ci]; a += ((o >= 0 && o <= 2) ? 2.f : 1.f) * sm; } }
                sv = a; } }
        scs[b] = sv; }
    asm volatile("s_waitcnt lgkmcnt(0)" ::: "memory"); __syncthreads();
    for (int b = tid; b < NBS; b += NTHREADS) { const float sv = scs[b]; int rank = 0; for (int j = 0; j < NBS; ++j) { const float o = scs[j]; rank += (o > sv || (o == sv && j < b)) ? 1 : 0; }
        if (rank < SLC_TOPK) { sel[rank] = b; P.SELB[((size_t)row * NSA_KV_HEADS + kvh) * 16 + rank] = b; } }
    asm volatile("s_waitcnt lgkmcnt(0)" ::: "memory"); __syncthreads();
    { const float* newrow = P.nsa_kv_s + (size_t)ns * 512; const int* pt = P.page_table + ns * (PAST_LEN / PAGE_SIZE);
      if (tid == 0) { int seen = 0; for (int x = 0; x < SLC_TOPK; ++x) { const int bx = sel[x]; if (bx != CURS && seen < 15) sel[16 + seen++] = bx; } }
      asm volatile("s_waitcnt lgkmcnt(0)" ::: "memory"); __syncthreads();
      auto krow = [&](int j, int ty) -> const float* { if (j >= 15 * 64) return newrow + ty * 128 + kvh * 64;
          const int t0 = sel[16 + (j >> 6)] * SLC_BLOCK + (j & 63); const int pg = pt[t0 / PAGE_SIZE]; return P.cache_nsa_kv + ((size_t)pg * PAGE_SIZE + t0 % PAGE_SIZE) * 512 + ty * 128 + kvh * 64; };
      smp_branch(C, qs, S, red, 15 * 64 + 1, [&](int j) { return krow(j, 2); }, [&](int j) { return krow(j, 3); }, false, os); }
    { const float* wc = P.cache_nsa_win + (size_t)ns * SWA_WINDOW * 256; const float* newrow = P.win_s + ((size_t)ns * SWA_WINDOW + SWA_WINDOW - 1) * 256;
      smp_branch(C, qs, S, red, SWA_WINDOW + 1, [&](int j) { return (j < SWA_WINDOW ? wc + (size_t)j * 256 : newrow) + kvh * 64; }, [&](int j) { return (j < SWA_WINDOW ? wc + (size_t)j * 256 : newrow) + 128 + kvh * 64; }, false, ow); }
    if (tid < 384) { const int head = kvh * NSA_GROUP + tid / 64; const float* gt = P.GATES + (size_t)row * 64 + head * 3;
        P.ATTB[(size_t)row * 1024 + kvh * 384 + tid] = (bf16)f2bf(gt[0] * oc[0] + gt[1] * os[0] + gt[2] * ow[0]);
#ifdef NSA_DEBUG
        P.DBG[((size_t)0 * MP + row) * 768 + kvh * 384 + tid] = oc[0]; P.DBG[((size_t)1 * MP + row) * 768 + kvh * 384 + tid] = os[0]; P.DBG[((size_t)2 * MP + row) * 768 + kvh * 384 + tid] = ow[0];
#endif
    }
    __syncthreads();
}
DI void nsa_pairs(const FP& P, const Ctx& C, bool second) {
    LAS unsigned char* wl = C.lds + C.wave * NSA_WLDS;
    const int per = C.G / 4 > 0 ? C.G / 4 : 1, grp = (C.vcu / per) & 3, sub = C.vcu % per, n = grp >> 1, kvh = grp & 1;
#pragma unroll 1
    for (int pr = sub * NWAVES + C.wave; pr < SEQ / 2; pr += per * NWAVES) { if (second) nsa_pair_b(P, n, kvh, 2 * pr, C.lane, wl); else nsa_pair_a(P, n, kvh, 2 * pr, C.lane, wl); }
}
DI void nsa_phase_a(const FP& P, const Ctx& C) {
    for (int it = C.vcu; it < DEC_BATCH * NSA_KV_HEADS; it += C.G) nsa_sample_item(P, C, it / NSA_KV_HEADS, it % NSA_KV_HEADS);
    nsa_pairs(P, C, false);
    __syncthreads();
}
DI void nsa_phase_b(const FP& P, const Ctx& C) {
    const int lane = C.lane, w = C.wave;
    nsa_pairs(P, C, true);
    __syncthreads();
    { constexpr int NMT = (M0 / 16) * MEM_HEADS;
      for (int it = C.vcu * NWAVES + w; it < NMT; it += C.G * NWAVES) { const int h = it % MEM_HEADS, q16 = it / MEM_HEADS, row0 = q16 * 16, n = row0 / SEQ;
          mem_micro(P, P.MQB + h * 64, 256, row0, 1, n, h, P.ATTB + NSA_Q_COLS + h * 64, 1024, lane); }
    }
    { LAS float* qs = (LAS float*)C.lds;
      for (int it = C.vcu; it < DEC_BATCH * MEM_HEADS; it += C.G) { const int h = it % MEM_HEADS, ns = it / MEM_HEADS, row = M0 + ns;
          __syncthreads(); if (C.tid < 64) qs[C.tid] = bf2f(P.MQB[(size_t)row * 256 + h * 64 + C.tid]); asm volatile("s_waitcnt lgkmcnt(0)" ::: "memory"); __syncthreads();
          Dec D; D.m = -INFINITY; D.l = 0.f; D.o = 0.f; const float* mk = P.cache_mem_kv + ((size_t)1 * DEC_BATCH + ns) * MEM_TOKENS * 512;
          for (int ck = w; ck < MEM_TOKENS / 64; ck += NWAVES) { const int j0 = ck * 64; dec_chunk(D, qs, 64, [&](int j) { return mk + (size_t)(j0 + j) * 512 + h * 64; }, [&](int j) { return mk + (size_t)(j0 + j) * 512 + 256 + h * 64; }, lane); }
          const float o = dec_combine(C, D);
          if (w == 0) P.ATTB[(size_t)row * 1024 + NSA_Q_COLS + h * 64 + lane] = (bf16)f2bf(o); } }
    __syncthreads();
}
}
namespace fx {
enum { PH_PRO = 0, PH_G1, PH_ATTA, PH_G2, PH_LN1, PH_SC0, PH_TK0, PH_PU0, PH_PG0, PH_G3, PH_CMPG, PH_CMP2, PH_NSA, PH_NSB, PH_G4, PH_LN3, PH_SC1, PH_TK1, PH_PU1, PH_PG1, PH_COUNT };
template <class Epi> DI void run_gemm(const Ctx& C, const bf16* A, const bf16* Bt, int M, int N, int K, const Epi& E) {
    pg8::Gemm g{A, Bt, M, N, K}; pg8::StaticOrder S; S.init(M, N, C.G, (int)blockIdx.x);
    pg8::gemm_phase<Epi, pg8::StaticOrder, true, true>(C.lds, g, S, E);
}
template <class Epi> DI void skinny_gemm(const Ctx& C, const bf16* A, const bf16* Bt, int N, int K, const Epi& E) {
    static_assert(DEC_BATCH == 32 && M0 % 256 == 0, "skinny_gemm: 32 sample rows right after a whole number of 256-row tiles");
    const int lane = C.lane, fr = lane & 15, fq = lane >> 4, w = C.wave; const int NI = (N / 256) * 4, KW = K / NWAVES;
    LAS f32x4* red = (LAS f32x4*)C.lds;
#pragma unroll 1
    for (int item = C.vcu; item < NI; item += C.G) { const int pn = item >> 2, wc = item & 3;
        f32x4 pa[2][2][2];
#pragma unroll
        for (int i = 0; i < 8; ++i) (&pa[0][0][0])[i] = (f32x4){0.f, 0.f, 0.f, 0.f};
        const bf16* xa = A + (size_t)(M0 + fr) * K + w * KW + 8 * fq; const bf16* xb = xa + (size_t)16 * K;
        const bf16* wp[2][2];
#pragma unroll
        for (int bj = 0; bj < 2; ++bj)
#pragma unroll
            for (int n = 0; n < 2; ++n) wp[bj][n] = Bt + (size_t)(pn * 256 + bj * 128 + wc * 32 + 8 * (fr >> 2) + 4 * n + (fr & 3)) * K + w * KW + 8 * fq;
#pragma unroll 4
        for (int k0 = 0; k0 < KW; k0 += 32) { const bf16x8 x0 = *(const bf16x8*)(xa + k0), x1 = *(const bf16x8*)(xb + k0);
#pragma unroll
            for (int bj = 0; bj < 2; ++bj)
#pragma unroll
                for (int n = 0; n < 2; ++n) { const bf16x8 wf = *(const bf16x8*)(wp[bj][n] + k0);
                    pa[bj][0][n] = __builtin_amdgcn_mfma_f32_16x16x32_bf16(wf, x0, pa[bj][0][n], 0, 0, 0); pa[bj][1][n] = __builtin_amdgcn_mfma_f32_16x16x32_bf16(wf, x1, pa[bj][1][n], 0, 0, 0); } }
        __syncthreads();
#pragma unroll
        for (int bj = 0; bj < 2; ++bj)
#pragma unroll
            for (int mm = 0; mm < 2; ++mm)
#pragma unroll
                for (int n = 0; n < 2; ++n) red[(w * 8 + bj * 4 + mm * 2 + n) * 64 + lane] = pa[bj][mm][n];
        asm volatile("s_waitcnt lgkmcnt(0)" ::: "memory"); __syncthreads();
        if (w == 0) { f32x4 acc[2][2][4][2];
#pragma unroll
            for (int i = 0; i < 32; ++i) (&acc[0][0][0][0])[i] = (f32x4){0.f, 0.f, 0.f, 0.f};
#pragma unroll
            for (int bj = 0; bj < 2; ++bj)
#pragma unroll
                for (int mm = 0; mm < 2; ++mm)
#pragma unroll
                    for (int n = 0; n < 2; ++n) { f32x4 s = red[(bj * 4 + mm * 2 + n) * 64 + lane];
#pragma unroll 1
                        for (int ww = 1; ww < NWAVES; ++ww) s += red[(ww * 8 + bj * 4 + mm * 2 + n) * 64 + lane];
                        acc[0][bj][mm][n] = s; }
            E(acc, pg8::Unit{M0 / 256, pn}, 0, wc, fr, fq); }
    }
    __syncthreads();
}
__global__ void __launch_bounds__(NTHREADS, 2) mega(Args args) {
    extern __shared__ __attribute__((aligned(16))) unsigned char lds_raw[];
    Ctx C; C.lds = (LAS unsigned char*)lds_raw; C.tid = threadIdx.x; C.lane = C.tid & 63; C.wave = __builtin_amdgcn_readfirstlane(C.tid >> 6);
    C.G = gridDim.x; { const int bx = blockIdx.x; C.vcu = (C.G % 8 == 0) ? (bx % 8) * (C.G / 8) + bx / 8 : bx; }
    const FP& P = args.p;
    volatile LAS unsigned* MISC = (volatile LAS unsigned*)(C.lds + MISC_OFF);
    for (int u = C.tid; u < (LDS_BYTES - RING_BYTES) / 4; u += NTHREADS) ((LAS unsigned*)(C.lds + RING_BYTES))[u] = 0u;
    __syncthreads();
    const int lo = args.lo, hi = args.hi;
    XcdBarrier bar; bar.bar = P.ctl + 1024; bar.x = 0; bar.st = nullptr;
    if (hi - lo > 1) bar = xcd_barrier_post(P.ctl + 1024, MISC + 8);
#define IN(k) (lo <= (k) && (k) < hi)
#define SEAM(k) do { if ((k) == PH_TK0 && IN(k)) bgq_drain(P, C, MISC + 12, BGQ_UV);     \
        if ((k) == PH_COUNT - 1 && IN(k)) bgq_drain(P, C, MISC + 12, BGQ_TOTAL); \
        if (IN(k) && IN((k) + 1)) xcd_barrier_bg(bar, P, C, MISC + 12); } while (0)
#ifndef DUP_PHASE
#define DUP_PHASE -1
#endif
#define PHASE(k, ...) do { if (IN(k)) { __VA_ARGS__ if (DUP_PHASE == (k)) { __syncthreads(); __VA_ARGS__ } } SEAM(k); } while (0)
    PHASE(PH_PRO, p0_prologue(P, C); __syncthreads(); p0_wpk(P, C););
    PHASE(PH_G1, run_gemm(C, P.XB0, P.WA_T, M0, ACOLS, D_MODEL, EpiA{P}); run_gemm(C, P.MEMB, P.WMEM_T, BATCH * MEM_TOKENS, 1024, D_MODEL, EpiMem{P}); skinny_gemm(C, P.XB0, P.WA_T, ACOLS, D_MODEL, EpiA{P}););
#ifdef PEER_SHARD3
#define PEER_SHARDED_FN peer_sharded3_phase
#else
#define PEER_SHARDED_FN peer_sharded2_phase
#endif
#if defined(PEER_SOFTSYNC) && !defined(PEER_SHARD3)
#define PEER_HINT_ARGS , bar.st, bar.x
#else
#define PEER_HINT_ARGS
#endif
    PHASE(PH_ATTA, atta_phase(P, C););
    PHASE(PH_G2, run_gemm(C, P.ATTA, P.WOA_T, M0, D_MODEL, 512, EpiPre{P.x_prompt, P.x_sample, P.PRE}); skinny_gemm(C, P.ATTA, P.WOA_T, D_MODEL, 512, EpiPre{P.x_prompt, P.x_sample, P.PRE}););
    PHASE(PH_LN1, ln_phase(P, C, P.PRE, P.ln_g, P.ln_b, P.X1, P.X1B, nullptr, nullptr););
    PHASE(PH_SC0, run_gemm(C, P.X1B, P.WPK_T, M0, NPK, D_MODEL, EpiF32{P.SCO, NPK, MP}); skinny_gemm(C, P.X1B, P.WPK_T, NPK, D_MODEL, EpiF32{P.SCO, NPK, MP}););
    PHASE(PH_TK0, topk_phase(P, C););
#ifdef PEER_SPLIT
    PHASE(PH_PU0, peer_u_phase(P, C, 0, P.X1B););
    PHASE(PH_PG0, peer_v_phase(P, C, 0, P.X1, P.X2, P.X2 + (size_t)M0 * D_MODEL, P.X2B););
#elif defined(PEER_SHARD2)
    PHASE(PH_PG0, const bool shd = (M0 % (C.G * NWAVES * PS2_ROWS)) == 0; if (shd) { PEER_SHARDED_FN(P, C, 0, P.X1, P.X1B, P.X2, P.X2B PEER_HINT_ARGS); __syncthreads(); } peer_phase(P, C, 0, P.X1, P.X2, P.X2 + (size_t)M0 * D_MODEL, P.X2B, shd););
#elif defined(PEER_SHARD)
    PHASE(PH_PG0, peer_sharded_phase(P, C, 0, P.X1, P.X1B, P.X2, P.X2 + (size_t)M0 * D_MODEL, P.X2B); __syncthreads(); peer_phase(P, C, 0, P.X1, P.X2, P.X2 + (size_t)M0 * D_MODEL, P.X2B););
#else
    PHASE(PH_PG0, peer_phase(P, C, 0, P.X1, P.X2, P.X2 + (size_t)M0 * D_MODEL, P.X2B););
#endif
    PHASE(PH_G3, run_gemm(C, P.X2B, P.WB_T, M0, NB_T, D_MODEL, EpiB{P}); skinny_gemm(C, P.X2B, P.WB_T, NB_T, D_MODEL, EpiB{P}););
    PHASE(PH_CMPG, run_gemm(C, P.AC, P.CW1_T, ACROWS, 256, 1024, EpiF32{P.UL, 256, ACROWS}); run_gemm(C, P.AC + (size_t)ACROWS * 1024, P.CW1_T + 256 * 1024, ACROWS, 256, 1024, EpiF32{P.UL + (size_t)ACROWS * 256, 256, ACROWS}););
    PHASE(PH_CMP2, cmp2_phase(P, C););
    PHASE(PH_NSA, nsa_phase_a(P, C););
    PHASE(PH_NSB, nsa_phase_b(P, C););
    PHASE(PH_G4, run_gemm(C, P.ATTB, P.WOB_T, M0, D_MODEL, 1024, EpiPre{P.X2, nullptr, P.PRE}); skinny_gemm(C, P.ATTB, P.WOB_T, D_MODEL, 1024, EpiPre{P.X2, nullptr, P.PRE}););
    PHASE(PH_LN3, ln_phase(P, C, P.PRE, P.ln_g + 2 * D_MODEL, P.ln_b + 2 * D_MODEL, P.X3, P.X3B, nullptr, nullptr););
    PHASE(PH_SC1, run_gemm(C, P.X3B, P.WPK_T + (size_t)NPK * D_MODEL, M0, NPK, D_MODEL, EpiF32{P.SCO, NPK, MP}); skinny_gemm(C, P.X3B, P.WPK_T + (size_t)NPK * D_MODEL, NPK, D_MODEL, EpiF32{P.SCO, NPK, MP}););
    PHASE(PH_TK1, topk_phase(P, C););
#ifdef PEER_SPLIT
    PHASE(PH_PU1, peer_u_phase(P, C, 1, P.X3B););
    PHASE(PH_PG1, peer_v_phase(P, C, 1, P.X3, P.y_prompt, P.y_sample, nullptr););
#elif defined(PEER_SHARD2)
    PHASE(PH_PG1, const bool shd = (M0 % (C.G * NWAVES * PS2_ROWS)) == 0; if (shd) { PEER_SHARDED_FN(P, C, 1, P.X3, P.X3B, P.y_prompt, nullptr PEER_HINT_ARGS); __syncthreads(); } peer_phase(P, C, 1, P.X3, P.y_prompt, P.y_sample, nullptr, shd););
#elif defined(PEER_SHARD)
    PHASE(PH_PG1, peer_sharded_phase(P, C, 1, P.X3, P.X3B, P.y_prompt, P.y_sample, nullptr); __syncthreads(); peer_phase(P, C, 1, P.X3, P.y_prompt, P.y_sample, nullptr););
#else
    PHASE(PH_PG1, peer_phase(P, C, 1, P.X3, P.y_prompt, P.y_sample, nullptr););
#endif
#undef IN
#undef SEAM
}
}
#ifndef ONE_LAUNCH
#define ONE_LAUNCH 1
#endif
extern "C" void kernel_launch(void* const* d_in, const int* in_sizes, int n_in, void* d_out, int out_size, void* d_ws, size_t ws_size, hipStream_t stream) {
    fx::Args a; memset(&a, 0, sizeof(a)); fx::bind_io(a.p, d_in, (float*)d_out);
    const size_t f_need = fx::carve(a.p, d_ws);
    if (f_need > ws_size) { fprintf(stderr, "kernel_launch: workspace too small: need %zu have %zu\n", f_need, ws_size); return; }
    static int grid = 0;
    if (!grid) { int dev = 0, cus = 0, per_cu = 0; (void)hipGetDevice(&dev); (void)hipDeviceGetAttribute(&cus, hipDeviceAttributeMultiprocessorCount, dev);
        (void)hipFuncSetAttribute((const void*)fx::mega, hipFuncAttributeMaxDynamicSharedMemorySize, fx::LDS_BYTES);
        if (hipOccupancyMaxActiveBlocksPerMultiprocessor(&per_cu, (const void*)fx::mega, fx::NTHREADS, fx::LDS_BYTES) != hipSuccess || per_cu < 1) { fprintf(stderr, "kernel_launch: occupancy query says %d blocks per CU\n", per_cu); (void)hipGetLastError(); }
        grid = cus; }
    (void)hipMemsetAsync(a.p.ctl, 0, fx::CTL_BYTES, stream);
#if ONE_LAUNCH
    a.lo = 0; a.hi = fx::PH_COUNT; hipLaunchKernelGGL(fx::mega, dim3(grid), dim3(fx::NTHREADS), fx::LDS_BYTES, stream, a);
#else
    for (int k = 0; k < fx::PH_COUNT; ++k) { a.lo = k; a.hi = k + 1; hipLaunchKernelGGL(fx::mega, dim3(grid), dim3(fx::NTHREADS), fx::LDS_BYTES, stream, a); }
#endif
}
```

```cpp
#define PEER_SHARD2 1
#define ONE_LAUNCH 1
#include <hip/hip_runtime.h>
#include <cstdio>
#include <cstring>
#include <cmath>
#ifdef CPU_TEST
#define HD inline
constexpr int D_MODEL = 128, BATCH = 2, SEQ = 512, DEPTH = 2, DEC_BATCH = 3, DEC_SEQ = 1, PAST_LEN = 512, PAGE_SIZE = 128;
constexpr int DIL_W[3] = {16, 64, 256}, DIL_D[3] = {1, 4, 16}, DIL_TAPS = 17;
constexpr int MEM_TOKENS = 32, SLC_TOPK = 4, SWA_WINDOW = 64, PEER_KEYS = 16, PEER_TOPK = 4;
#else
#define HD __host__ __device__ __forceinline__
constexpr int D_MODEL = 1024, BATCH = 2, SEQ = 8192, DEPTH = 2, DEC_BATCH = 32, DEC_SEQ = 1, PAST_LEN = 8192, PAGE_SIZE = 128;
constexpr int DIL_W[3] = {128, 512, 2048}, DIL_D[3] = {1, 4, 16}, DIL_TAPS = 129;
constexpr int MEM_TOKENS = 256, SLC_TOPK = 16, SWA_WINDOW = 512, PEER_KEYS = 128, PEER_TOPK = 16;
#endif
HD constexpr int dil_w(int g) { return g == 0 ? DIL_W[0] : (g == 1 ? DIL_W[1] : DIL_W[2]); }
HD constexpr int dil_d(int g) { return g == 0 ? DIL_D[0] : (g == 1 ? DIL_D[1] : DIL_D[2]); }
constexpr int HEAD_DIM = 64, N_A_LAYERS = DEPTH / 2, N_DIL = 3, DIL_HEADS = 4, DIL_COLS = N_DIL * 3 * DIL_HEADS * HEAD_DIM;
constexpr int MEM_HEADS = 4, MEM_COLS = MEM_HEADS * HEAD_DIM;
constexpr int NSA_HEADS = 12, NSA_KV_HEADS = 2, NSA_GROUP = 6, NSA_Q_COLS = NSA_HEADS * HEAD_DIM, NSA_GATE_COLS = NSA_HEADS * 3;
constexpr int CMP_BLOCK = 32, CMP_STRIDE = 16, CMP_HIDDEN = 128, SLC_BLOCK = 64;
constexpr int PEER_EXPERTS = PEER_KEYS * PEER_KEYS, PEER_HEADS = 8, PEER_KEY_DIM = 128;
constexpr float FORCE_SCORE = 1.0e9f, NEG = -1.0e30f, SCALE = 0.125f, LN_EPS = 1e-5f;
constexpr float ALPHA = 1.41421356237309515f;
constexpr float BETA = 0.5f;
#define LAS __attribute__((address_space(3)))
namespace pg8 {
#define PG8_LAS __attribute__((address_space(3)))
typedef unsigned short bf16_t;
typedef short bf16x8 __attribute__((ext_vector_type(8)));
typedef float f32x4 __attribute__((ext_vector_type(4)));
typedef unsigned u32x4 __attribute__((ext_vector_type(4)));
constexpr int BM = 256, BK = 64, HALF = 128, HTB = HALF * BK * 2  , STAGE_BYTES = 8 * HTB, NXCD = 8, WGM = 8;

__host__ __device__ __forceinline__ int lds_byte(int r, int c) { const int st = (r >> 4) * 2 + (c >> 5), rr = r & 15, cc = c & 31, ob = rr * 64 + cc * 2; return st * 1024 + (ob ^ (((ob >> 9) & 1) << 5)); }
__host__ __device__ __forceinline__ void stage_rc(int b, int& R, int& C) { const int st = b / 1024, sb = b % 1024, swz = sb ^ (((sb >> 9) & 1) << 5); R = (st >> 1) * 16 + swz / 64; C = (st & 1) * 32 + (swz % 64) / 2; }
__host__ __device__ __forceinline__ int perm32(int rho) { const int n = rho >> 4, i = rho & 15; return 8 * (i >> 2) + 4 * n + (i & 3); }

struct Unit { int pm, pn; };
struct Gemm { const bf16_t* A; const bf16_t* Bt; int M, N, K; };

struct StaticOrder {
    int nM, nN, nwg, G, c;
    __host__ __device__ void init(int M, int N, int G_, int c_) { nM = M / BM; nN = N / BM; nwg = nM * nN; G = G_; c = c_; }
    __host__ __device__ bool next(int i, Unit& u) const {
        const long L = (long)i * G + c; if (L >= nwg) return false;
        int wgid = (int)L; { const int q = nwg / NXCD, r = nwg % NXCD, xcd = wgid % NXCD, off = wgid / NXCD; wgid = (xcd < r ? xcd * (q + 1) : r * (q + 1) + (xcd - r) * q) + off; }
        const int nig = WGM * nN, gid = wgid / nig, fm = gid * WGM, gsz = (nM - fm) < WGM ? (nM - fm) : WGM;
        u.pm = fm + ((wgid % nig) % gsz); u.pn = (wgid % nig) / gsz; return true;
    }
    __device__ __forceinline__ void a_ready(const Unit&) const {}
    __device__ __forceinline__ void done(const Unit&) const {}
};

__device__ __forceinline__ unsigned cvt_pk_bf16(float lo, float hi) { unsigned r; asm volatile("v_cvt_pk_bf16_f32 %0, %1, %2" : "=v"(r) : "v"(lo), "v"(hi)); return r; }
typedef float f32x2 __attribute__((ext_vector_type(2)));
typedef float f32x2 __attribute__((ext_vector_type(2)));
template <class Epi, class Sched, bool ALIGN_EPI = false, bool SP2 = false>
__device__ __forceinline__ void gemm_phase(PG8_LAS unsigned char* lds, const Gemm g, const Sched& S, const Epi& E) {
    const int tid = threadIdx.x, wid = __builtin_amdgcn_readfirstlane(tid >> 6), lane = tid & 63, wr = wid >> 2, wc = wid & 3, fr = lane & 15, fq = lane >> 4;
    const int K = g.K, nt = K / BK;
    unsigned voffA[2], voffB[2];
#pragma unroll
    for (int i = 0; i < 2; ++i) { int R, C; stage_rc(tid * 16 + i * 8192, R, C); const int Rb = Epi::PERM ? ((R & ~31) + perm32(R & 31)) : R;
        voffA[i] = (unsigned)(R * K + C) * 2u; voffB[i] = (unsigned)(Rb * K + C) * 2u; }
    const size_t kstep = (size_t)(BK * 2);
    const size_t hstep = (size_t)HALF * K * 2;
    const size_t tstep = 2 * hstep;
    const unsigned ldsw = (unsigned)wid * 1024u;
    const int aoff = lds_byte(wr * 64 + fr, fq * 8), boff = lds_byte(wc * 32 + fr, fq * 8);
#define PG8_SA(b, h) (((b) * 2 + (h)) * HTB)
#define PG8_SB(b, h) ((4 + (b) * 2 + (h)) * HTB)
#define PG8_STAGE(bufoff, gbase, voff) do { _Pragma("unroll") for (int _i = 0; _i < 2; ++_i) \
        __builtin_amdgcn_global_load_lds((const unsigned*)((const char*)(gbase) + (voff)[_i]), (PG8_LAS unsigned*)(lds + (bufoff) + ldsw + _i * 8192), 16, 0, 0); } while (0)
#define PG8_LDA(dst, b, h) do { _Pragma("unroll") for (int m = 0; m < 4; ++m) _Pragma("unroll") for (int k = 0; k < 2; ++k) dst[m][k] = *(const PG8_LAS bf16x8*)(lds + PG8_SA(b, h) + aoff + m * 2048 + k * 1024); } while (0)
#define PG8_LDB(dst, b, h) do { _Pragma("unroll") for (int n = 0; n < 2; ++n) _Pragma("unroll") for (int k = 0; k < 2; ++k) dst[n][k] = *(const PG8_LAS bf16x8*)(lds + PG8_SB(b, h) + boff + n * 2048 + k * 1024); } while (0)
#define PG8_MMA(ai, bj, At, Bt) do { __builtin_amdgcn_s_setprio(1); _Pragma("unroll") for (int m = 0; m < 4; ++m) _Pragma("unroll") for (int n = 0; n < 2; ++n) _Pragma("unroll") for (int k = 0; k < 2; ++k) \
        acc[ai][bj][m][n] = __builtin_amdgcn_mfma_f32_16x16x32_bf16(Bt[n][k], At[m][k], acc[ai][bj][m][n], 0, 0, 0); __builtin_amdgcn_s_setprio(0); } while (0)
#define PG8_WAIT_V(n) asm volatile("s_waitcnt vmcnt(" #n ")" ::: "memory")
#define PG8_WAIT_L(n) asm volatile("s_waitcnt lgkmcnt(" #n ")" ::: "memory")
#define PG8_BAR __builtin_amdgcn_s_barrier()
#define PG8_SCHED __builtin_amdgcn_sched_barrier(0)
    Unit cur, nxt; int ui = 0;
    if (!S.next(0, cur)) return;
    f32x4 acc[2][2][4][2];
#pragma unroll
    for (int a = 0; a < 2; ++a)
#pragma unroll
        for (int b = 0; b < 2; ++b)
#pragma unroll
            for (int m = 0; m < 4; ++m)
#pragma unroll
                for (int n = 0; n < 2; ++n) acc[a][b][m][n] = (f32x4){0.f, 0.f, 0.f, 0.f};
    bf16x8 At[4][2], B0[2][2], B1[2][2];
    const char* cA = (const char*)g.A + (size_t)cur.pm * tstep; const char* cB = (const char*)g.Bt + (size_t)cur.pn * tstep;
    S.a_ready(cur);
    if constexpr (SP2) {
        PG8_STAGE(PG8_SB(0, 0), cB, voffB); PG8_STAGE(PG8_SB(0, 1), cB + hstep, voffB); PG8_STAGE(PG8_SA(0, 0), cA, voffA); PG8_STAGE(PG8_SA(0, 1), cA + hstep, voffA);
        if (wr == 1) PG8_BAR;
        PG8_WAIT_V(2); PG8_BAR;
        PG8_STAGE(PG8_SB(1, 0), cB + kstep, voffB); PG8_STAGE(PG8_SA(1, 0), cA + kstep, voffA); PG8_STAGE(PG8_SB(1, 1), cB + hstep + kstep, voffB);
        PG8_WAIT_V(6); PG8_BAR;
    } else {
        PG8_STAGE(PG8_SB(0, 0), cB, voffB); PG8_STAGE(PG8_SA(0, 0), cA, voffA); PG8_STAGE(PG8_SB(0, 1), cB + hstep, voffB); PG8_STAGE(PG8_SA(0, 1), cA + hstep, voffA);
        if (wr == 1) PG8_BAR;
        PG8_WAIT_V(4); PG8_BAR;
        PG8_STAGE(PG8_SB(1, 0), cB + kstep, voffB); PG8_STAGE(PG8_SA(1, 0), cA + kstep, voffA); PG8_STAGE(PG8_SB(1, 1), cB + hstep + kstep, voffB);
        PG8_WAIT_V(6); PG8_BAR;
    }
    for (;;) {
        const bool has_next = S.next(ui + 1, nxt);
        const char* nA = has_next ? (const char*)g.A + (size_t)nxt.pm * tstep : cA; const char* nB = has_next ? (const char*)g.Bt + (size_t)nxt.pn * tstep : cB;
        for (int t = 0; t < nt; t += 2) {
            const bool last = (t == nt - 2);
            const char* a1 = cA + (size_t)(t + 1) * kstep;
            const char* a2 = last ? nA : cA + (size_t)(t + 2) * kstep; const char* b2 = last ? nB : cB + (size_t)(t + 2) * kstep;
            const char* a3 = a2 + kstep; const char* b3 = b2 + kstep;
            if (last && has_next) S.a_ready(nxt);
            if constexpr (SP2) {
            PG8_LDB(B0, 0, 0); PG8_LDB(B1, 0, 1); PG8_SCHED; PG8_LDA(At, 0, 0); PG8_STAGE(PG8_SA(1, 1), a1 + hstep, voffA);
            PG8_WAIT_V(8); PG8_WAIT_L(0); PG8_BAR; PG8_MMA(0, 0, At, B0); PG8_MMA(0, 1, At, B1); PG8_BAR; PG8_SCHED;
            PG8_LDA(At, 0, 1); PG8_STAGE(PG8_SB(0, 0), b2, voffB); PG8_STAGE(PG8_SB(0, 1), b2 + hstep, voffB); PG8_STAGE(PG8_SA(0, 0), a2, voffA);
            PG8_WAIT_V(8); PG8_WAIT_L(0); PG8_BAR; PG8_MMA(1, 0, At, B0); PG8_MMA(1, 1, At, B1); PG8_BAR; PG8_SCHED;
            PG8_LDB(B0, 1, 0); PG8_LDB(B1, 1, 1); PG8_SCHED; PG8_LDA(At, 1, 0); PG8_STAGE(PG8_SA(0, 1), a2 + hstep, voffA);
            PG8_WAIT_V(8); PG8_WAIT_L(0); PG8_BAR; PG8_MMA(0, 0, At, B0); PG8_MMA(0, 1, At, B1); PG8_BAR; PG8_SCHED;
            PG8_LDA(At, 1, 1); PG8_STAGE(PG8_SB(1, 0), b3, voffB); PG8_STAGE(PG8_SB(1, 1), b3 + hstep, voffB); PG8_STAGE(PG8_SA(1, 0), a3, voffA);
            PG8_WAIT_V(8); PG8_WAIT_L(0); PG8_BAR; PG8_MMA(1, 0, At, B0); PG8_MMA(1, 1, At, B1); PG8_BAR; PG8_SCHED;
            } else {
            PG8_LDB(B0, 0, 0); PG8_SCHED; PG8_LDA(At, 0, 0); PG8_STAGE(PG8_SA(1, 1), a1 + hstep, voffA);
            PG8_WAIT_L(8); PG8_BAR; PG8_WAIT_L(0); PG8_MMA(0, 0, At, B0); PG8_BAR; PG8_SCHED;
            PG8_LDB(B1, 0, 1); PG8_STAGE(PG8_SB(0, 0), b2, voffB);
            PG8_BAR; PG8_WAIT_L(0); PG8_MMA(0, 1, At, B1); PG8_BAR;
            PG8_LDA(At, 0, 1); PG8_STAGE(PG8_SA(0, 0), a2, voffA);
            PG8_BAR; PG8_WAIT_L(0); PG8_MMA(1, 0, At, B0); PG8_BAR; PG8_SCHED;
            PG8_STAGE(PG8_SB(0, 1), b2 + hstep, voffB);
            PG8_WAIT_V(6); PG8_BAR; PG8_MMA(1, 1, At, B1); PG8_BAR;
            PG8_LDB(B0, 1, 0); PG8_SCHED; PG8_LDA(At, 1, 0); PG8_STAGE(PG8_SA(0, 1), a2 + hstep, voffA);
            PG8_WAIT_L(8); PG8_BAR; PG8_WAIT_L(0); PG8_MMA(0, 0, At, B0); PG8_BAR; PG8_SCHED;
            PG8_LDB(B1, 1, 1); PG8_STAGE(PG8_SB(1, 0), b3, voffB);
            PG8_BAR; PG8_WAIT_L(0); PG8_MMA(0, 1, At, B1); PG8_BAR;
            PG8_LDA(At, 1, 1); PG8_STAGE(PG8_SA(1, 0), a3, voffA);
            PG8_BAR; PG8_WAIT_L(0); PG8_MMA(1, 0, At, B0); PG8_BAR; PG8_SCHED;
            PG8_STAGE(PG8_SB(1, 1), b3 + hstep, voffB);
            PG8_WAIT_V(6); PG8_BAR; PG8_MMA(1, 1, At, B1); PG8_BAR;
            }
        }
        if constexpr (ALIGN_EPI) { if (wr == 0) PG8_BAR; }
        if constexpr (!Epi::AFTER_DRAIN) { E(acc, cur, wr, wc, fr, fq); S.done(cur); }
        if (!has_next) break;
#pragma unroll
        for (int a = 0; a < 2; ++a)
#pragma unroll
            for (int b = 0; b < 2; ++b)
#pragma unroll
                for (int m = 0; m < 4; ++m)
#pragma unroll
                    for (int n = 0; n < 2; ++n) acc[a][b][m][n] = (f32x4){0.f, 0.f, 0.f, 0.f};
        cur = nxt; cA = nA; cB = nB; ++ui;
        if constexpr (ALIGN_EPI) { if (wr == 1) PG8_BAR; }
    }
    PG8_WAIT_V(0);
    if constexpr (!ALIGN_EPI) { if (wr == 0) PG8_BAR; }
    PG8_BAR;
    if constexpr (Epi::AFTER_DRAIN) { E.fused(acc, cur, wr, wc, fr, fq, lds, wid, lane); S.done(cur); }
#undef PG8_SA
#undef PG8_SB
#undef PG8_STAGE
#undef PG8_LDA
#undef PG8_LDB
#undef PG8_MMA
#undef PG8_WAIT_V
#undef PG8_WAIT_L
#undef PG8_BAR
#undef PG8_SCHED
}
}
#define XB_TMO      128
#define XB_XCNT(j)  (256  + 64 * (j))
#define XB_XSUB(j)  (1280 + 64 * (j))
#define XB_XGEN(j)  (2304 + 64 * (j))
#define XB_TOP      3328
#define XB_TOPGEN   3392
#define XCD_BAR_WORDS 3456
#define XB_SPIN_CAP (1u << 18)

__device__ __forceinline__ unsigned xb_ld(unsigned* p)              { return __hip_atomic_load(p, __ATOMIC_RELAXED, __HIP_MEMORY_SCOPE_AGENT); }
__device__ __forceinline__ unsigned xb_add(unsigned* p, unsigned v) { return __hip_atomic_fetch_add(p, v, __ATOMIC_RELAXED, __HIP_MEMORY_SCOPE_AGENT); }
__device__ __forceinline__ unsigned xb_xcc_id() { return (unsigned)__builtin_amdgcn_s_getreg((3 << 11) | 20) & 0xFu; }
#define XB_SPIN(cond, bar) do { unsigned _sp = 0; while (cond) { __builtin_amdgcn_s_sleep(1); \
    if ((++_sp & 255u) == 0u) { if (xb_ld(&(bar)[XB_TMO])) break; if (_sp > XB_SPIN_CAP) { atomicAdd(&(bar)[XB_TMO], 1u); break; } } } } while (0)

struct XcdBarrier {
    unsigned* bar; unsigned x;
    volatile LAS unsigned* st;
};

__device__ __forceinline__ XcdBarrier xcd_barrier_post(unsigned* bar, volatile LAS unsigned* st) {
    XcdBarrier b; b.bar = bar; b.x = xb_xcc_id(); b.st = st;
    if (threadIdx.x == 0) (void)xb_add(&bar[XB_XCNT(b.x)], 1u);
    return b;
}
__device__ __forceinline__ void xcd_barrier_complete(unsigned* bar, unsigned x, unsigned& nloc, unsigned& nx) {
    const unsigned G = gridDim.x * gridDim.y * gridDim.z;
    unsigned sum, cnt, mine, sp = 0u;
    for (;;) {
        sum = 0u; cnt = 0u; mine = 0u;
#pragma unroll
        for (unsigned j = 0; j < 16; ++j) { const unsigned c = xb_ld(&bar[XB_XCNT(j)]); sum += c; cnt += (c > 0u) ? 1u : 0u; mine = (j == x) ? c : mine; }
        if (sum == G) break;
        __builtin_amdgcn_s_sleep(1);
        if ((++sp & 255u) == 0u) { if (xb_ld(&bar[XB_TMO])) break; if (sp > XB_SPIN_CAP) { atomicAdd(&bar[XB_TMO], 1u); break; } }
    }
    nloc = mine > 0u ? mine : 1u; nx = cnt > 0u ? cnt : 1u;
}

__device__ __forceinline__ void xcd_barrier(const XcdBarrier& b) {
    asm volatile("s_waitcnt vmcnt(0)" ::: "memory");
    __syncthreads();
    if (threadIdx.x == 0) {
        unsigned* bar = b.bar;
        __builtin_amdgcn_s_waitcnt(0);
        unsigned nloc = b.st[0], nx = b.st[1];
        if (nloc == 0u) { xcd_barrier_complete(bar, b.x, nloc, nx); b.st[0] = nloc; b.st[1] = nx; }
        const unsigned old = xb_add(&bar[XB_XSUB(b.x)], 1u);
        const unsigned gen = old / nloc;
        if (old + 1u == (gen + 1u) * nloc) {
            __builtin_amdgcn_fence(__ATOMIC_RELEASE, "agent");
            asm volatile("s_waitcnt vmcnt(0)" ::: "memory");
            const unsigned og = xb_add(&bar[XB_TOP], 1u);
            const unsigned tg = og / nx;
            if (og + 1u == (tg + 1u) * nx) xb_add(&bar[XB_TOPGEN], 1u);
            else XB_SPIN(xb_ld(&bar[XB_TOPGEN]) == tg, bar);
            __builtin_amdgcn_fence(__ATOMIC_ACQUIRE, "agent");
            xb_add(&bar[XB_XGEN(b.x)], 1u);
            asm volatile("s_waitcnt vmcnt(0)" ::: "memory");
        } else {
            XB_SPIN(xb_ld(&bar[XB_XGEN(b.x)]) == gen, bar);
            __builtin_amdgcn_fence(__ATOMIC_ACQUIRE, "agent");
            asm volatile("s_waitcnt vmcnt(0)" ::: "memory");
        }
    }
    __syncthreads();
}
namespace fx {
#define DI __device__ __forceinline__
typedef unsigned short bf16;
typedef short bf16x8 __attribute__((ext_vector_type(8)));
typedef float f32x4 __attribute__((ext_vector_type(4)));
typedef float f32x2 __attribute__((ext_vector_type(2)));
typedef unsigned u32x4 __attribute__((ext_vector_type(4)));
typedef unsigned u32x2 __attribute__((ext_vector_type(2)));
constexpr int M0 = BATCH * SEQ, MP = M0 + DEC_BATCH, MPAD = ((MP + 255) / 256) * 256;
constexpr int ACOLS = DIL_COLS + MEM_COLS, BCOLS = NSA_Q_COLS + NSA_GATE_COLS + MEM_COLS, KVCOLS = 6 * NSA_KV_HEADS * HEAD_DIM;
constexpr int NB_T = 2048;
constexpr int NPK = PEER_HEADS * 2 * PEER_KEYS;
constexpr int NCMP = (SEQ - CMP_BLOCK) / CMP_STRIDE + 1;
constexpr int NCH = SEQ / CMP_STRIDE;
constexpr int NCTX = BATCH + DEC_BATCH;
constexpr int ACROWS = NCTX * NSA_KV_HEADS * NCH;
constexpr int NPOS = PAST_LEN + 1;
constexpr float QSCALE = 0.125f * 1.4426950408889634f;
constexpr int NTHREADS = 512, NWAVES = 8, LDS_BYTES = 147456, RING_BYTES = 131072, MISC_OFF = RING_BYTES + 320;

struct FP {
    const float *x_prompt, *x_sample, *mem_prompt, *cache_dil[3], *cache_nsa_kv, *cache_nsa_win, *cache_mem_kv; const int* page_table;
    const float *w_in_a, *w_out_a, *w_in_b, *w_out_b, *w_mem_kv, *w_kv_b, *cmp_pe, *cmp_w1, *cmp_w2, *ln_g, *ln_b, *peer_wq, *peer_keys, *peer_u, *peer_v;
    float *y_prompt, *y_sample, *dil_p[3], *dil_s[3], *nsa_kv_p, *nsa_kv_s, *win_p, *win_s, *mem_kv_p;
    unsigned* ctl;
    bf16 *XB0, *X1B, *X2B, *X3B, *WA_T, *WMEM_T, *MEMB, *WOA_T, *WOB_T, *WPK_T, *WB_T, *CW1_T, *AC; unsigned char *UB8, *VB8;
    float *ROPE, *CBIAS;
    bf16 *QA, *KA, *VTA, *MQA, *MK, *MVT, *ATTA;
    float *DPART, *DML, *PRE, *X1, *X2, *X3, *SCO, *SELG; int* SELE;
    bf16 *SLK, *SLVT, *WNK, *WNVT, *QB, *MQB, *CK, *CVT, *ATTB;
    float *GATES, *UL, *CKF, *CVF;
    int* SELB;
    float* DBG;
};
struct Args { FP p; int lo, hi; };
struct Carve { size_t off = 0; template <class T> T* take(void* base, size_t n) { T* r = (T*)((char*)base + off); off += ((n * sizeof(T) + 255) / 256) * 256; return r; } };
constexpr size_t CTL_BYTES = 65536;
inline size_t carve(FP& p, void* base) {
    Carve c;
    p.ctl = c.take<unsigned>(base, CTL_BYTES / 4);
    p.XB0 = c.take<bf16>(base, (size_t)MPAD * D_MODEL); p.X1B = c.take<bf16>(base, (size_t)MPAD * D_MODEL); p.X2B = c.take<bf16>(base, (size_t)MPAD * D_MODEL); p.X3B = c.take<bf16>(base, (size_t)MPAD * D_MODEL);
    p.WA_T = c.take<bf16>(base, (size_t)ACOLS * D_MODEL); p.WMEM_T = c.take<bf16>(base, (size_t)DEPTH * 2 * MEM_COLS * D_MODEL); p.MEMB = c.take<bf16>(base, (size_t)BATCH * MEM_TOKENS * D_MODEL);
    p.WOA_T = c.take<bf16>(base, (size_t)D_MODEL * 2 * MEM_COLS); p.WOB_T = c.take<bf16>(base, (size_t)D_MODEL * (NSA_Q_COLS + MEM_COLS));
    p.WPK_T = c.take<bf16>(base, (size_t)DEPTH * NPK * D_MODEL); p.WB_T = c.take<bf16>(base, (size_t)NB_T * D_MODEL);
    p.UB8 = c.take<unsigned char>(base, (size_t)DEPTH * PEER_EXPERTS * D_MODEL); p.VB8 = c.take<unsigned char>(base, (size_t)DEPTH * PEER_EXPERTS * D_MODEL);
    p.CW1_T = c.take<bf16>(base, (size_t)2 * 256 * 1024); p.AC = c.take<bf16>(base, (size_t)2 * ACROWS * 1024);
    p.ROPE = c.take<float>(base, (size_t)NPOS * 64); p.CBIAS = c.take<float>(base, 2 * CMP_HIDDEN);
    p.QA = c.take<bf16>(base, (size_t)3 * MPAD * 256); p.KA = c.take<bf16>(base, (size_t)3 * MPAD * 256); p.VTA = c.take<bf16>(base, (size_t)3 * BATCH * DIL_HEADS * HEAD_DIM * SEQ + 4096);
    p.MQA = c.take<bf16>(base, (size_t)MPAD * 256); p.MK = c.take<bf16>(base, (size_t)DEPTH * BATCH * MEM_TOKENS * MEM_COLS); p.MVT = c.take<bf16>(base, (size_t)DEPTH * BATCH * MEM_COLS * MEM_TOKENS);
    p.ATTA = c.take<bf16>(base, (size_t)MPAD * 2 * MEM_COLS);
    p.DPART = c.take<float>(base, (size_t)3 * MP * DIL_HEADS * HEAD_DIM); p.DML = c.take<float>(base, (size_t)3 * MP * DIL_HEADS * 2);
    p.PRE = c.take<float>(base, (size_t)MPAD * D_MODEL); p.X1 = c.take<float>(base, (size_t)MPAD * D_MODEL); p.X2 = c.take<float>(base, (size_t)MPAD * D_MODEL); p.X3 = c.take<float>(base, (size_t)MPAD * D_MODEL);
    p.SCO = c.take<float>(base, (size_t)MPAD * NPK); p.SELG = c.take<float>(base, (size_t)MP * 128); p.SELE = c.take<int>(base, (size_t)MP * 128);
    p.SLK = c.take<bf16>(base, (size_t)BATCH * NSA_KV_HEADS * SEQ * HEAD_DIM); p.SLVT = c.take<bf16>(base, (size_t)BATCH * NSA_KV_HEADS * SEQ * HEAD_DIM);
    p.WNK = c.take<bf16>(base, (size_t)BATCH * NSA_KV_HEADS * SEQ * HEAD_DIM + 4096); p.WNVT = c.take<bf16>(base, (size_t)BATCH * NSA_KV_HEADS * SEQ * HEAD_DIM + 4096);
    p.QB = c.take<bf16>(base, (size_t)MPAD * NSA_Q_COLS); p.MQB = c.take<bf16>(base, (size_t)MPAD * 256);
    p.CK = c.take<bf16>(base, (size_t)NCTX * NSA_KV_HEADS * NCH * HEAD_DIM); p.CVT = c.take<bf16>(base, (size_t)NCTX * NSA_KV_HEADS * HEAD_DIM * NCH); p.ATTB = c.take<bf16>(base, (size_t)MPAD * (NSA_Q_COLS + MEM_COLS));
    p.GATES = c.take<float>(base, (size_t)MPAD * 64); p.UL = c.take<float>(base, (size_t)2 * ACROWS * 256);
    p.CKF = c.take<float>(base, (size_t)DEC_BATCH * NSA_KV_HEADS * NCH * HEAD_DIM); p.CVF = c.take<float>(base, (size_t)DEC_BATCH * NSA_KV_HEADS * NCH * HEAD_DIM);
    p.SELB = c.take<int>(base, (size_t)MP * NSA_KV_HEADS * 16);
#ifdef NSA_DEBUG
    p.DBG = c.take<float>(base, (size_t)3 * MP * 768);
#else
    p.DBG = nullptr;
#endif
    return c.off;
}
inline void bind_io(FP& p, void* const* d_in, float* out) {
    p.x_prompt = (const float*)d_in[0]; p.x_sample = (const float*)d_in[1]; p.mem_prompt = (const float*)d_in[2]; p.cache_dil[0] = (const float*)d_in[3]; p.cache_dil[1] = (const float*)d_in[4]; p.cache_dil[2] = (const float*)d_in[5];
    p.cache_nsa_kv = (const float*)d_in[6]; p.cache_nsa_win = (const float*)d_in[7]; p.cache_mem_kv = (const float*)d_in[8]; p.page_table = (const int*)d_in[9];
    p.w_in_a = (const float*)d_in[10]; p.w_out_a = (const float*)d_in[11]; p.w_in_b = (const float*)d_in[12]; p.w_out_b = (const float*)d_in[13]; p.w_mem_kv = (const float*)d_in[14]; p.w_kv_b = (const float*)d_in[15];
    p.cmp_pe = (const float*)d_in[16]; p.cmp_w1 = (const float*)d_in[17]; p.cmp_w2 = (const float*)d_in[18]; p.ln_g = (const float*)d_in[19]; p.ln_b = (const float*)d_in[20];
    p.peer_wq = (const float*)d_in[21]; p.peer_keys = (const float*)d_in[22]; p.peer_u = (const float*)d_in[23]; p.peer_v = (const float*)d_in[24];
    size_t o = 0; auto take = [&](size_t n) { float* r = out + o; o += n; return r; };
    p.y_prompt = take((size_t)M0 * D_MODEL); p.y_sample = take((size_t)DEC_BATCH * D_MODEL);
    for (int g = 0; g < 3; ++g) p.dil_p[g] = take((size_t)BATCH * DIL_W[g] * 2 * DIL_HEADS * HEAD_DIM);
    for (int g = 0; g < 3; ++g) p.dil_s[g] = take((size_t)DEC_BATCH * DIL_W[g] * 2 * DIL_HEADS * HEAD_DIM);
    p.nsa_kv_p = take((size_t)M0 * 4 * NSA_KV_HEADS * HEAD_DIM); p.nsa_kv_s = take((size_t)DEC_BATCH * 4 * NSA_KV_HEADS * HEAD_DIM);
    p.win_p = take((size_t)BATCH * SWA_WINDOW * 2 * NSA_KV_HEADS * HEAD_DIM); p.win_s = take((size_t)DEC_BATCH * SWA_WINDOW * 2 * NSA_KV_HEADS * HEAD_DIM);
    p.mem_kv_p = take((size_t)DEPTH * BATCH * MEM_TOKENS * 2 * MEM_COLS);
}
DI unsigned f2bf(float f) { unsigned u = __builtin_bit_cast(unsigned, f); return (u + 0x7fffu + ((u >> 16) & 1u)) >> 16; }
DI unsigned pk2(float lo, float hi) { return f2bf(lo) | (f2bf(hi) << 16); }
DI float bf2f(unsigned short b) { return __builtin_bit_cast(float, (unsigned)b << 16); }
DI float bflo(unsigned w) { return __builtin_bit_cast(float, w << 16); }
DI float bfhi(unsigned w) { return __builtin_bit_cast(float, w & 0xffff0000u); }
template <int CTRL> DI float dpp1(float x) { return __builtin_bit_cast(float, __builtin_amdgcn_update_dpp(0, __builtin_bit_cast(int, x), CTRL, 0xF, 0xF, true)); }
DI float wave_sum(float v) { v += dpp1<0xB1>(v); v += dpp1<0x4E>(v); v += dpp1<0x141>(v); v += dpp1<0x140>(v);
    float a = v, b = v; asm volatile("s_nop 1\n\tv_permlane16_swap_b32 %0, %1" : "+v"(a), "+v"(b)); v = a + b; a = v; b = v;
    asm volatile("s_nop 1\n\tv_permlane32_swap_b32 %0, %1" : "+v"(a), "+v"(b)); return a + b; }
DI float wave_max(float v) { v = fmaxf(v, dpp1<0xB1>(v)); v = fmaxf(v, dpp1<0x4E>(v)); v = fmaxf(v, dpp1<0x141>(v)); v = fmaxf(v, dpp1<0x140>(v));
    float a = v, b = v; asm volatile("s_nop 1\n\tv_permlane16_swap_b32 %0, %1" : "+v"(a), "+v"(b)); v = fmaxf(a, b); a = v; b = v;
    asm volatile("s_nop 1\n\tv_permlane32_swap_b32 %0, %1" : "+v"(a), "+v"(b)); return fmaxf(a, b); }
DI float gelu_tanh(float x) { const float u = 0.7978845608028654f * (x + 0.044715f * x * x * x); const float e = __builtin_amdgcn_exp2f(u * 2.885390081777927f);   const float t = 1.0f - 2.0f / (e + 1.0f); return 0.5f * x * (1.0f + t); }
DI float* sel3(float* const (&a)[3], int g) { return g == 0 ? a[0] : (g == 1 ? a[1] : a[2]); }
DI const float* sel3c(const float* const (&a)[3], int g) { return g == 0 ? a[0] : (g == 1 ? a[1] : a[2]); }
__host__ DI size_t ktile_off(int t, int d) { const int blk = t >> 5, kk = t & 31, b = (kk >> 2) & 1, i = 4 * (kk >> 3) + (kk & 3), s = d >> 5, c = (d & 31) >> 3; return ((size_t)(blk * 4 + 2 * b + s) * 64 + i + 16 * c) * 8 + (d & 7); }
__host__ DI size_t vtile_off(int dim, int t) { const int blk = t >> 5, kk = t & 31; return ((size_t)(blk * 4 + (dim >> 4)) * 64 + (dim & 15) + 16 * (kk >> 3)) * 8 + (kk & 7); }
struct Ctx { LAS unsigned char* lds; int tid, lane, wave, vcu, G; };
DI int row_pos(int r) { return r < M0 ? (r & (SEQ - 1)) : PAST_LEN; }

struct ColSrc { const float* p; int ld; };
DI int rope_il(int e) { return (e >> 1) + 32 * (e & 1); }
DI ColSrc col_wa(const FP& P, int n) {
    const int t = n >> 8, ct = n & 255, h = ct >> 6, e = ct & 63; if (t >= 9) return ColSrc{P.w_in_a + DIL_COLS + ct, ACOLS};
    const int j = t % 3, d = (j < 2) ? rope_il(e) : e; return ColSrc{P.w_in_a + t * 256 + h * 64 + d, ACOLS}; }
DI ColSrc col_wb(const FP& P, int n) {
    const int t = n >> 8, ct = n & 255, e = ct & 63;
    if (t < 3) { const int ty = 2 * t + (ct >> 7), kvh = (ct >> 6) & 1; const bool rot = (ty == 2 || ty == 4); return ColSrc{P.w_kv_b + (ty * NSA_KV_HEADS + kvh) * 64 + (rot ? rope_il(e) : e), KVCOLS}; }
    if (t < 6) { const int h = (t - 3) * 4 + (ct >> 6); return ColSrc{P.w_in_b + h * 64 + rope_il(e), BCOLS}; }
    if (t == 6) return ColSrc{P.w_in_b + NSA_Q_COLS + NSA_GATE_COLS + ct, BCOLS};
    if (ct < NSA_GATE_COLS) return ColSrc{P.w_in_b + NSA_Q_COLS + ct, BCOLS};
    return ColSrc{nullptr, 0}; }
DI ColSrc col_wmem(const FP& P, int n) { const int l = n >> 9, c = n & 511; return ColSrc{P.w_mem_kv + (size_t)l * D_MODEL * 512 + c, 512}; }
DI ColSrc col_woa(const FP& P, int n) { return ColSrc{P.w_out_a + n, D_MODEL}; }
DI ColSrc col_wob(const FP& P, int n) { return ColSrc{P.w_out_b + n, D_MODEL}; }
DI ColSrc col_cw1(const FP& P, int n) {
    const int ty = n >> 8, half = (n >> 7) & 1, hid = n & 127; return ColSrc{P.cmp_w1 + (size_t)ty * CMP_BLOCK * HEAD_DIM * CMP_HIDDEN + (size_t)half * 16 * HEAD_DIM * CMP_HIDDEN + hid, CMP_HIDDEN}; }
template <class CF> DI void transpose_item(const FP& P, CF cf, int K, bf16* WT, LAS float* scr, int item, int nblk, int lane) {
    const int kb = item / nblk, nb = item % nblk, k0 = 64 * kb, n0 = 32 * nb;
    const ColSrc cs = cf(P, n0 + (lane & 31));
#pragma unroll 8
    for (int i = 0; i < 32; ++i) { const int kk = 2 * i + (lane >> 5); scr[kk * 33 + (lane & 31)] = cs.p ? cs.p[(size_t)(k0 + kk) * cs.ld] : 0.f; }
    asm volatile("s_waitcnt lgkmcnt(0)" ::: "memory");
    const int c = lane & 7;
#pragma unroll
    for (int j = 0; j < 4; ++j) { const int n = (lane >> 3) + 8 * j; const LAS float* s = scr + (8 * c) * 33 + n;
        u32x4 o; o.x = pk2(s[0 * 33], s[1 * 33]); o.y = pk2(s[2 * 33], s[3 * 33]); o.z = pk2(s[4 * 33], s[5 * 33]); o.w = pk2(s[6 * 33], s[7 * 33]);
        *(u32x4*)(WT + (size_t)(n0 + n) * K + k0 + 8 * c) = o; }
    asm volatile("s_waitcnt lgkmcnt(0)" ::: "memory");
}
DI void cvt_row1024(const float* src, bf16* dst, int lane) {
#pragma unroll
    for (int j = 0; j < 4; ++j) { f32x4 v = src ? *(const f32x4*)(src + 256 * j + 4 * lane) : (f32x4){0.f, 0.f, 0.f, 0.f}; u32x2 o; o.x = pk2(v.x, v.y); o.y = pk2(v.z, v.w); *(u32x2*)(dst + 256 * j + 4 * lane) = o; }
}
DI void cvt_row1024_fp8(const float* src, unsigned char* dst, float sc, int lane) { u32x4 o; unsigned w[4];
#pragma unroll
    for (int j = 0; j < 4; ++j) { const f32x4 v = *(const f32x4*)(src + 16 * lane + 4 * j) * sc; int t = __builtin_amdgcn_cvt_pk_fp8_f32(v.x, v.y, 0, false); t = __builtin_amdgcn_cvt_pk_fp8_f32(v.z, v.w, t, true); w[j] = (unsigned)t; }
    o.x = w[0]; o.y = w[1]; o.z = w[2]; o.w = w[3]; *(u32x4*)(dst + 16 * lane) = o; }
DI void p0_prologue(const FP& P, const Ctx& C) {
    LAS float* scr = (LAS float*)(C.lds + C.wave * 16384);
    const int gw = C.vcu * NWAVES + C.wave, NGW = C.G * NWAVES, lane = C.lane; const int gwT0 = C.wave * C.G + C.vcu;
    { constexpr int IA = (D_MODEL / 64) * (ACOLS / 32), IM = (D_MODEL / 64) * (1024 / 32);
      for (int it = gwT0; it < IA + IM; it += NGW) { int r = it;
          if (r < IA) { transpose_item(P, col_wa, D_MODEL, P.WA_T, scr, r, ACOLS / 32, lane); continue; } r -= IA;
          transpose_item(P, col_wmem, D_MODEL, P.WMEM_T, scr, r, 1024 / 32, lane); } }
    for (int r = gw; r < M0 - NGW; r += 2 * NGW) {
        f32x4 v[8];
#pragma unroll
        for (int j = 0; j < 8; ++j) v[j] = *(const f32x4*)(P.x_prompt + (size_t)(r + (j >> 2) * NGW) * D_MODEL + 256 * (j & 3) + 4 * lane);
#pragma unroll
        for (int j = 0; j < 8; ++j) { u32x2 o; o.x = pk2(v[j].x, v[j].y); o.y = pk2(v[j].z, v[j].w); *(u32x2*)(P.XB0 + (size_t)(r + (j >> 2) * NGW) * D_MODEL + 256 * (j & 3) + 4 * lane) = o; } }
    for (int r = gw + ((M0 - NGW - gw + 2 * NGW - 1) / (2 * NGW)) * (2 * NGW); r < MPAD; r += NGW) { cvt_row1024(r < M0 ? P.x_prompt + (size_t)r * D_MODEL : (r < MP ? P.x_sample + (size_t)(r - M0) * D_MODEL : nullptr), P.XB0 + (size_t)r * D_MODEL, lane);
        if (r >= MP) { cvt_row1024(nullptr, P.X1B + (size_t)r * D_MODEL, lane); cvt_row1024(nullptr, P.X2B + (size_t)r * D_MODEL, lane); cvt_row1024(nullptr, P.X3B + (size_t)r * D_MODEL, lane);
            for (int c = lane; c < 512; c += 64) { P.ATTA[(size_t)r * 512 + c] = 0; P.ATTB[(size_t)r * 1024 + c] = 0; P.ATTB[(size_t)r * 1024 + 512 + c] = 0; } } }
    for (int r = gw; r < BATCH * MEM_TOKENS; r += NGW) cvt_row1024(P.mem_prompt + (size_t)r * D_MODEL, P.MEMB + (size_t)r * D_MODEL, lane);
    for (int i = gw * 64 + lane; i < NPOS * 32; i += NGW * 64) { const int pos = i >> 5, d = i & 31; const double inv = exp2(-(double)d * (13.287712379549449 / 32.0)); const double turns = (double)pos * inv * 0.15915494309189535;
        const float fr = (float)(turns - floor(turns)); P.ROPE[pos * 64 + d] = __builtin_amdgcn_cosf(fr); P.ROPE[pos * 64 + 32 + d] = __builtin_amdgcn_sinf(fr); }
}
constexpr int WPK_ITEMS = DEPTH * 16 * (D_MODEL / 64);
DI void wpk_item(const FP& P, const Ctx& C, int it) {
    LAS float* sw = (LAS float*)C.lds;
    LAS float* sk = (LAS float*)(C.lds + 32768);
    const int l = it / (16 * (D_MODEL / 64)), rem = it % (16 * (D_MODEL / 64)), hc = rem / (D_MODEL / 64), kb = rem % (D_MODEL / 64);
    __syncthreads();
    for (int i = C.tid; i < 64 * 64; i += NTHREADS) { const int r = i >> 6, d = i & 63; sw[r * 65 + d] = P.peer_wq[((size_t)l * D_MODEL + kb * 64 + r) * 1024 + hc * 64 + d]; }
    for (int i = C.tid; i < 128 * 64; i += NTHREADS) { const int r = i >> 6, d = i & 63; sk[r * 68 + d] = P.peer_keys[(((size_t)l * 16 + hc) * PEER_KEYS + r) * 64 + d]; }
    __syncthreads();
    { const int ki = C.lane, kk0 = C.wave; float a[16];
#pragma unroll
      for (int j = 0; j < 16; ++j) a[j] = 0.f;
#pragma unroll 2
      for (int d = 0; d < 64; d += 4) { const float w0 = sw[ki * 65 + d], w1 = sw[ki * 65 + d + 1], w2 = sw[ki * 65 + d + 2], w3 = sw[ki * 65 + d + 3];
#pragma unroll
          for (int j = 0; j < 16; ++j) { const f32x4 kq = *(const LAS f32x4*)(sk + (kk0 + 8 * j) * 68 + d); a[j] += w0 * kq.x + w1 * kq.y + w2 * kq.z + w3 * kq.w; } }
#pragma unroll
      for (int j = 0; j < 16; ++j) P.WPK_T[((size_t)l * NPK + hc * 128 + kk0 + 8 * j) * D_MODEL + kb * 64 + ki] = (bf16)f2bf(a[j]); }
    __syncthreads();
}
constexpr int T1_OA = (512 / 64) * (D_MODEL / 32), T1_OB = (1024 / 64) * (D_MODEL / 32), T1_B = (D_MODEL / 64) * (NB_T / 32), T1_C = (1024 / 64) * (512 / 32), T1_ITEMS = T1_OA + T1_OB + T1_B + T1_C;
constexpr int AC_ITEMS = DEC_BATCH * (PAST_LEN / PAGE_SIZE) * (PAGE_SIZE / 8), CB_ITEMS = 2 * CMP_HIDDEN;
constexpr int bgq_cache_n(int g) { return (DEC_BATCH * ((g < 3 ? dil_w(g) : SWA_WINDOW) - 1) * (g < 3 ? 128 : 64) + 8191) / 8192; }
constexpr int BGQ_T1 = (T1_ITEMS + 7) / 8, BGQ_L_A = BGQ_T1 + WPK_ITEMS, BGQ_UV = DEPTH * PEER_EXPERTS / 16, BGQ_L_UV = BGQ_L_A + BGQ_UV;
constexpr int BGQ_AC = (AC_ITEMS + 7) / 8, BGQ_CB = (CB_ITEMS + 7) / 8, BGQ_L_AC = BGQ_L_UV + BGQ_AC + BGQ_CB;
constexpr int BGQ_TOTAL = BGQ_L_AC + bgq_cache_n(0) + bgq_cache_n(1) + bgq_cache_n(2) + bgq_cache_n(3);
constexpr int BGQ_CTR = 12288;
DI void bg_chunk(const FP& P, const Ctx& C, int c) {
    const int lane = C.lane;
    if (c < BGQ_T1) { int r = c * 8 + C.wave; LAS float* scr = (LAS float*)(C.lds + C.wave * 16384);
        if (r < T1_ITEMS) {
            if (r < T1_OA) transpose_item(P, col_woa, 512, P.WOA_T, scr, r, D_MODEL / 32, lane);
            else if ((r -= T1_OA) < T1_OB) transpose_item(P, col_wob, 1024, P.WOB_T, scr, r, D_MODEL / 32, lane);
            else if ((r -= T1_OB) < T1_B) transpose_item(P, col_wb, D_MODEL, P.WB_T, scr, r, NB_T / 32, lane);
            else transpose_item(P, col_cw1, 1024, P.CW1_T, scr, r - T1_B, 512 / 32, lane); }
        return; }
    if (c < BGQ_L_A) { wpk_item(P, C, c - BGQ_T1); return; }
    c -= BGQ_L_A;
    if (c < BGQ_UV) {
        { const int r = c * 16 + C.wave * 2; f32x4 a[16];
#pragma unroll
            for (int q = 0; q < 4; ++q) { const float* s0 = (q < 2 ? P.peer_u : P.peer_v) + (size_t)(r + (q & 1)) * D_MODEL + 16 * lane;
#pragma unroll
                for (int j = 0; j < 4; ++j) a[4 * q + j] = *(const f32x4*)(s0 + 4 * j); }
#pragma unroll
            for (int q = 0; q < 4; ++q) { const float sc = q < 2 ? 256.f : 64.f; unsigned w[4];
#pragma unroll
                for (int j = 0; j < 4; ++j) { const f32x4 v = a[4 * q + j] * sc; int t = __builtin_amdgcn_cvt_pk_fp8_f32(v.x, v.y, 0, false); t = __builtin_amdgcn_cvt_pk_fp8_f32(v.z, v.w, t, true); w[j] = (unsigned)t; }
                u32x4 o; o.x = w[0]; o.y = w[1]; o.z = w[2]; o.w = w[3]; *(u32x4*)((q < 2 ? P.UB8 : P.VB8) + (size_t)(r + (q & 1)) * D_MODEL + 16 * lane) = o; } }
        return; }
    c -= BGQ_UV;
    if (c < BGQ_AC) { const int it2 = c * 8 + C.wave;
        if (it2 < AC_ITEMS) { const int it = it2 / (PAGE_SIZE / 8), rg = it2 % (PAGE_SIZE / 8);
            const int n = it / (PAST_LEN / PAGE_SIZE), pi = it % (PAST_LEN / PAGE_SIZE); const int pg = P.page_table[it];
            const float* src = P.cache_nsa_kv + (size_t)pg * PAGE_SIZE * 512 + 4 * lane; const int ty = lane >> 5, kvh = (lane >> 4) & 1, d = (4 * lane) & 63;
            bf16* dst = P.AC + ((size_t)ty * ACROWS + ((size_t)(BATCH + n) * NSA_KV_HEADS + kvh) * NCH + pi * (PAGE_SIZE / 16)) * 1024 + d;
            const int r0 = rg * 8; f32x4 v[8];
#pragma unroll
            for (int u = 0; u < 8; ++u) v[u] = *(const f32x4*)(src + (size_t)(r0 + u) * 512);
#pragma unroll
            for (int u = 0; u < 8; ++u) { const int t = r0 + u; u32x2 o; o.x = pk2(v[u].x, v[u].y); o.y = pk2(v[u].z, v[u].w); *(u32x2*)(dst + (size_t)(t / 16) * 1024 + (t % 16) * 64) = o; } }
        return; }
    c -= BGQ_AC;
    if (c < BGQ_CB) { const int i = c * 8 + C.wave;
        if (i < CB_ITEMS) { const int ty = i / CMP_HIDDEN, hid = i % CMP_HIDDEN; float a = 0.f;
#pragma unroll 8
            for (int k = lane; k < CMP_BLOCK * HEAD_DIM; k += 64) a += P.cmp_pe[ty * CMP_BLOCK * HEAD_DIM + k] * P.cmp_w1[((size_t)ty * CMP_BLOCK * HEAD_DIM + k) * CMP_HIDDEN + hid];
            a = wave_sum(a); if (lane == 0) P.CBIAS[i] = a; }
        return; }
    c -= BGQ_CB;
    int g = 0; if (c >= bgq_cache_n(0)) { c -= bgq_cache_n(0); g = 1; if (c >= bgq_cache_n(1)) { c -= bgq_cache_n(1); g = 2; if (c >= bgq_cache_n(2)) { c -= bgq_cache_n(2); g = 3; } } }
    const int W = g < 3 ? dil_w(g) : SWA_WINDOW, RV = g < 3 ? 128 : 64;
    const f32x4* src = (const f32x4*)(g < 3 ? sel3c(P.cache_dil, g) : P.cache_nsa_win); f32x4* dst = (f32x4*)(g < 3 ? sel3(P.dil_s, g) : P.win_s);
    const int per = (W - 1) * RV, nvec = DEC_BATCH * per;
    const int i0 = c * 8192 + C.wave * 1024;
    if (i0 < nvec) { f32x4 v[16]; int idx[16];
        const int n0 = __builtin_amdgcn_readfirstlane((int)((unsigned)i0 / (unsigned)per)), o0 = i0 - n0 * per;
#pragma unroll
        for (int u = 0; u < 16; ++u) { int o = o0 + u * 64 + lane, n = n0; if (o >= per) { o -= per; ++n; } if (n >= DEC_BATCH) { n = DEC_BATCH - 1; o = per - 1; } idx[u] = n * (per + RV) + o; v[u] = src[(size_t)idx[u] + RV]; }
#pragma unroll
        for (int u = 0; u < 16; ++u) { const int i = i0 + u * 64 + lane; if (i < nvec) dst[(size_t)idx[u]] = v[u]; } }
}
DI void bgq_drain(const FP& P, const Ctx& C, volatile LAS unsigned* slot, int limit) {
#pragma unroll 1
    for (;;) {
        __syncthreads();
        if (C.tid == 0) *slot = atomicAdd(P.ctl + BGQ_CTR, 1u);
        __syncthreads();
        const int c = (int)*slot;
        if (c < BGQ_TOTAL) bg_chunk(P, C, c);
        if (c >= limit) break;
    }
    __syncthreads();
}
DI void xcd_barrier_bg(const XcdBarrier& b, const FP& P, const Ctx& C, volatile LAS unsigned* slot  ) {
    asm volatile("s_waitcnt vmcnt(0)" ::: "memory");
    __syncthreads();
    if (threadIdx.x == 0) {
        unsigned* bar = b.bar;
        __builtin_amdgcn_s_waitcnt(0);
        unsigned nloc = b.st[0], nx = b.st[1];
        if (nloc == 0u) { xcd_barrier_complete(bar, b.x, nloc, nx); b.st[0] = nloc; b.st[1] = nx; }
        const unsigned old = xb_add(&bar[XB_XSUB(b.x)], 1u);
        const unsigned gen = old / nloc;
        if (old + 1u == (gen + 1u) * nloc) {
            __builtin_amdgcn_fence(__ATOMIC_RELEASE, "agent");
            asm volatile("s_waitcnt vmcnt(0)" ::: "memory");
            const unsigned og = xb_add(&bar[XB_TOP], 1u);
            const unsigned tg = og / nx;
            if (og + 1u == (tg + 1u) * nx) xb_add(&bar[XB_TOPGEN], 1u);
            else XB_SPIN(xb_ld(&bar[XB_TOPGEN]) == tg, bar);
            __builtin_amdgcn_fence(__ATOMIC_ACQUIRE, "agent");
            xb_add(&bar[XB_XGEN(b.x)], 1u);
            asm volatile("s_waitcnt vmcnt(0)" ::: "memory");
            slot[2] = 1u;
        } else { slot[1] = gen; slot[2] = 0u; }
    }
    __syncthreads();
    unsigned spins = 0;
#pragma unroll 1
    while (slot[2] == 0u) {
        if (threadIdx.x == 0) {
            unsigned c = (unsigned)BGQ_TOTAL;
            if (xb_ld(&b.bar[XB_XGEN(b.x)]) != slot[1] || xb_ld(&b.bar[XB_TMO]) != 0u) {
                __builtin_amdgcn_fence(__ATOMIC_ACQUIRE, "agent");
                asm volatile("s_waitcnt vmcnt(0)" ::: "memory");
                slot[2] = 1u;
            } else if (xb_ld(P.ctl + BGQ_CTR) < (unsigned)BGQ_TOTAL) {
                const unsigned nloc = b.st[0], nx = b.st[1], gen = slot[1];
                const unsigned arr = xb_ld(&b.bar[XB_XSUB(b.x)]) - gen * nloc, top = xb_ld(&b.bar[XB_TOP]) - gen * nx;
                if (arr + 3u <= nloc || (arr >= nloc && top + 2u <= nx)) c = atomicAdd(P.ctl + BGQ_CTR, 1u);
                else __builtin_amdgcn_s_sleep(1);
            }
            else { __builtin_amdgcn_s_sleep(1); if (++spins > XB_SPIN_CAP) { atomicAdd(&b.bar[XB_TMO], 1u); } }
            slot[0] = c;
        }
        __syncthreads();
        const bool rel = slot[2] != 0u; const int c = (int)slot[0];
        if (!rel && c < BGQ_TOTAL) bg_chunk(P, C, c);
        __syncthreads();
    }
}
#define EPI_LOOP(...) int fr_l = fr, fq_l = fq; asm volatile("" : "+v"(fr_l), "+v"(fq_l));     \
    _Pragma("unroll") for (int ai = 0; ai < 2; ++ai) _Pragma("unroll") for (int m = 0; m < 4; ++m) { const int row = u.pm * 256 + ai * 128 + wr * 64 + m * 16 + fr_l; \
    _Pragma("unroll") for (int bj = 0; bj < 2; ++bj) { const int ct = bj * 128 + wc * 32 + fq_l * 8; const f32x4 v0 = acc[ai][bj][m][0], v1 = acc[ai][bj][m][1]; __VA_ARGS__ } asm volatile("" ::: "memory"); }
DI void rope4(const float* rope_row, int dp, const f32x4& v0, const f32x4& v1, f32x4& lo, f32x4& hi) {
    const f32x4 c = *(const f32x4*)(rope_row + dp), s = *(const f32x4*)(rope_row + 32 + dp);
    lo.x = v0.x * c.x - v0.y * s.x; hi.x = v0.y * c.x + v0.x * s.x; lo.y = v0.z * c.y - v0.w * s.y; hi.y = v0.w * c.y + v0.z * s.y;
    lo.z = v1.x * c.z - v1.y * s.z; hi.z = v1.y * c.z + v1.x * s.z; lo.w = v1.z * c.w - v1.w * s.w; hi.w = v1.w * c.w + v1.z * s.w; }
DI u32x2 pk4(const f32x4& v) { u32x2 o; o.x = pk2(v.x, v.y); o.y = pk2(v.z, v.w); return o; }
DI u32x4 pk8(const f32x4& a, const f32x4& b) { u32x4 o; o.x = pk2(a.x, a.y); o.y = pk2(a.z, a.w); o.z = pk2(b.x, b.y); o.w = pk2(b.z, b.w); return o; }
DI int dil_perm(int t, int d) { return (t % d) * (SEQ / d) + t / d; }
#ifdef EPIA_REP
#define EPIA_REP_BEGIN _Pragma("unroll 1") for (int rep_ = 0; rep_ < EPIA_REP; ++rep_) {
#define EPIA_REP_END }
#else
#define EPIA_REP_BEGIN
#define EPIA_REP_END
#endif
struct EpiA {
    static constexpr bool PERM = true, AFTER_DRAIN = false; const FP& P;
    DI void operator()(const f32x4 (&acc)[2][2][4][2], const pg8::Unit& u, int wr, int wc, int fr, int fq) const {
        const int t9 = u.pn; const int g = t9 / 3, j = t9 % 3;
        EPIA_REP_BEGIN EPI_LOOP({ if (row < MP) { const int h = ct >> 6, e = ct & 63; const int pos = row_pos(row);
            if (t9 == 9) { *(u32x4*)(P.MQA + (size_t)row * 256 + ct) = pk8(v0 * QSCALE, v1 * QSCALE); }
            else if (j < 2) { f32x4 lo, hi; const int dp = e >> 1; rope4(P.ROPE + pos * 64, dp, v0, v1, lo, hi);
                if (j == 0) { bf16* q = P.QA + ((size_t)g * MPAD + row) * 256 + h * 64 + dp; *(u32x2*)q = pk4(lo * QSCALE); *(u32x2*)(q + 32) = pk4(hi * QSCALE); }
                else { if (row < M0) { bf16* kt = P.KA + ((size_t)(g * BATCH + row / SEQ) * DIL_HEADS + h) * 64 * SEQ; const int cm = dil_perm(pos, dil_d(g)); *(u32x2*)(kt + ktile_off(cm, dp)) = pk4(lo); *(u32x2*)(kt + ktile_off(cm, dp + 32)) = pk4(hi); }
                    const int W = dil_w(g); float* o = nullptr;
                    if (row >= M0) o = sel3(P.dil_s, g) + (((size_t)(row - M0) * W + W - 1) * 2 + 0) * 256; else if (pos >= SEQ - W) o = sel3(P.dil_p, g) + (((size_t)(row / SEQ) * W + pos - (SEQ - W)) * 2 + 0) * 256;
                    if (o) { *(f32x4*)(o + h * 64 + dp) = lo; *(f32x4*)(o + h * 64 + 32 + dp) = hi; } } }
            else { const int W = dil_w(g), d = dil_d(g); float* o = nullptr;
                if (row >= M0) o = sel3(P.dil_s, g) + (((size_t)(row - M0) * W + W - 1) * 2 + 1) * 256; else if (pos >= SEQ - W) o = sel3(P.dil_p, g) + (((size_t)(row / SEQ) * W + pos - (SEQ - W)) * 2 + 1) * 256;
                if (o) { *(f32x4*)(o + ct) = v0; *(f32x4*)(o + ct + 4) = v1; }
                if (row < M0) { bf16* vt = P.VTA + ((size_t)(g * BATCH + row / SEQ) * DIL_HEADS + h) * 64 * SEQ + vtile_off(e, dil_perm(pos, d));
                    vt[0] = (bf16)f2bf(v0.x); vt[8] = (bf16)f2bf(v0.y); vt[16] = (bf16)f2bf(v0.z); vt[24] = (bf16)f2bf(v0.w); vt[32] = (bf16)f2bf(v1.x); vt[40] = (bf16)f2bf(v1.y); vt[48] = (bf16)f2bf(v1.z); vt[56] = (bf16)f2bf(v1.w); } } } }) EPIA_REP_END
    }
};
struct EpiMem {
    static constexpr bool PERM = true, AFTER_DRAIN = false; const FP& P;
    DI void operator()(const f32x4 (&acc)[2][2][4][2], const pg8::Unit& u, int wr, int wc, int fr, int fq) const {
        const int l = u.pn >> 1, half = u.pn & 1;
        EPI_LOOP({ const int n = row / MEM_TOKENS, mt = row % MEM_TOKENS; float* o = P.mem_kv_p + (((size_t)l * BATCH + n) * MEM_TOKENS + mt) * 512 + half * 256 + ct; *(f32x4*)o = v0; *(f32x4*)(o + 4) = v1;
            if (half == 0) *(u32x4*)(P.MK + (((size_t)l * BATCH + n) * MEM_HEADS + (ct >> 6)) * MEM_TOKENS * 64 + ktile_off(mt, ct & 63)) = pk8(v0, v1);
            else { bf16* vt = P.MVT + (((size_t)l * BATCH + n) * MEM_HEADS + (ct >> 6)) * MEM_TOKENS * 64 + vtile_off(ct & 63, mt);
                vt[0] = (bf16)f2bf(v0.x); vt[8] = (bf16)f2bf(v0.y); vt[16] = (bf16)f2bf(v0.z); vt[24] = (bf16)f2bf(v0.w); vt[32] = (bf16)f2bf(v1.x); vt[40] = (bf16)f2bf(v1.y); vt[48] = (bf16)f2bf(v1.z); vt[56] = (bf16)f2bf(v1.w); } })
    }
};
struct EpiPre {
    static constexpr bool PERM = true, AFTER_DRAIN = false; const float* xa; const float* xb; float* pre;
    DI void operator()(const f32x4 (&acc)[2][2][4][2], const pg8::Unit& u, int wr, int wc, int fr, int fq) const {
        EPI_LOOP({ if (row < MP) { const int col = u.pn * 256 + ct; const float* x = (xb && row >= M0) ? xb + (size_t)(row - M0) * D_MODEL + col : xa + (size_t)row * D_MODEL + col;
            const f32x4 a = *(const f32x4*)x, b = *(const f32x4*)(x + 4); float* o = pre + (size_t)row * D_MODEL + col; *(f32x4*)o = a * ALPHA + v0; *(f32x4*)(o + 4) = b * ALPHA + v1; } })
    }
};
struct EpiF32 {
    static constexpr bool PERM = true, AFTER_DRAIN = false; float* out; int ldc; int nrows;
    DI void operator()(const f32x4 (&acc)[2][2][4][2], const pg8::Unit& u, int wr, int wc, int fr, int fq) const {
        EPI_LOOP({ if (row < nrows) { float* o = out + (size_t)row * ldc + u.pn * 256 + ct; *(f32x4*)o = v0; *(f32x4*)(o + 4) = v1; } })
    }
};
}
namespace fx {
struct Tile16 { f32x4 o[4]; float m, l; };
DI void tile_init(Tile16& T) { T.o[0] = T.o[1] = T.o[2] = T.o[3] = (f32x4){0.f, 0.f, 0.f, 0.f}; T.m = -INFINITY; T.l = 0.f; }
typedef __bf16 bf16x2_t __attribute__((ext_vector_type(2)));
DI unsigned cvtpk(float lo, float hi) { const f32x2 v = {lo, hi}; const bf16x2_t b = __builtin_convertvector(v, bf16x2_t); return __builtin_bit_cast(unsigned, b); }
struct KV8 { bf16x8 ka0, ka1, kb0, kb1, v0, v1, v2, v3; };
DI void kv_load(KV8& r, const bf16* k0, const bf16* k1, const bf16* v, long vs16) {
    r.ka0 = *(const bf16x8*)k0; r.ka1 = *(const bf16x8*)(k0 + 32); r.kb0 = *(const bf16x8*)k1; r.kb1 = *(const bf16x8*)(k1 + 32);
    r.v0 = *(const bf16x8*)v; r.v1 = *(const bf16x8*)(v + vs16); r.v2 = *(const bf16x8*)(v + 2 * vs16); r.v3 = *(const bf16x8*)(v + 3 * vs16); }
DI void mk_range(int a, int b, bool ok, int& lo, unsigned& rng) { const bool v = ok && b >= a; lo = v ? a : (1 << 20); rng = v ? (unsigned)(b - a) : 0u; }
DI float colmax(float x) { float a = x, b = x; asm volatile("s_nop 1\n\tv_permlane32_swap_b32 %0, %1" : "+v"(a), "+v"(b)); float m = fmaxf(a, b); a = m; b = m;
    asm volatile("s_nop 1\n\tv_permlane16_swap_b32 %0, %1" : "+v"(a), "+v"(b)); return fmaxf(a, b); }
DI float colsum(float x) { float a = x, b = x; asm volatile("s_nop 1\n\tv_permlane32_swap_b32 %0, %1" : "+v"(a), "+v"(b)); float m = a + b; a = m; b = m;
    asm volatile("s_nop 1\n\tv_permlane16_swap_b32 %0, %1" : "+v"(a), "+v"(b)); return a + b; }
DI void tile_compute(Tile16& T, const bf16x8 (&qf)[2], const KV8& r, int lo, unsigned rng) {
    f32x4 s0 = (f32x4){0.f, 0.f, 0.f, 0.f}, s1 = (f32x4){0.f, 0.f, 0.f, 0.f};
    s0 = __builtin_amdgcn_mfma_f32_16x16x32_bf16(r.ka0, qf[0], s0, 0, 0, 0); s0 = __builtin_amdgcn_mfma_f32_16x16x32_bf16(r.ka1, qf[1], s0, 0, 0, 0);
    s1 = __builtin_amdgcn_mfma_f32_16x16x32_bf16(r.kb0, qf[0], s1, 0, 0, 0); s1 = __builtin_amdgcn_mfma_f32_16x16x32_bf16(r.kb1, qf[1], s1, 0, 0, 0);
    float s[8] = {s0.x, s0.y, s0.z, s0.w, s1.x, s1.y, s1.z, s1.w};
    float mx = -INFINITY;
#pragma unroll
    for (int e = 0; e < 8; ++e) { s[e] = ((unsigned)(e - lo) <= rng) ? s[e] : -INFINITY; mx = fmaxf(mx, s[e]); }
    mx = colmax(mx);
    const float mnew = fmaxf(T.m, mx), muse = (mnew == -INFINITY) ? 0.f : mnew;
    const float alpha = __builtin_amdgcn_exp2f(T.m - muse);
    float ls = 0.f;
#pragma unroll
    for (int e = 0; e < 8; ++e) { s[e] = __builtin_amdgcn_exp2f(s[e] - muse); ls += s[e]; }
    T.l = T.l * alpha + ls; T.m = mnew;
    u32x4 pw; pw.x = cvtpk(s[0], s[1]); pw.y = cvtpk(s[2], s[3]); pw.z = cvtpk(s[4], s[5]); pw.w = cvtpk(s[6], s[7]);
    const bf16x8 pf = __builtin_bit_cast(bf16x8, pw);
    T.o[0] = __builtin_amdgcn_mfma_f32_16x16x32_bf16(r.v0, pf, T.o[0] * alpha, 0, 0, 0); T.o[1] = __builtin_amdgcn_mfma_f32_16x16x32_bf16(r.v1, pf, T.o[1] * alpha, 0, 0, 0);
    T.o[2] = __builtin_amdgcn_mfma_f32_16x16x32_bf16(r.v2, pf, T.o[2] * alpha, 0, 0, 0); T.o[3] = __builtin_amdgcn_mfma_f32_16x16x32_bf16(r.v3, pf, T.o[3] * alpha, 0, 0, 0);
}
template <class BUF, class LD, class CP> DI void pipe2t(int n, LD ld, CP cp) { if (n <= 0) return; BUF A, B; ld(A, 0);
#pragma unroll 1
    for (int i = 0; i < n; i += 2) { ld(B, (i + 1 < n) ? i + 1 : i); cp(A, i); ld(A, (i + 2 < n) ? i + 2 : i); if (i + 1 < n) cp(B, i + 1); } }
template <class LD, class CP> DI void pipe2(int n, LD ld, CP cp) { if (n <= 0) return; KV8 A, B; ld(A, 0);
#pragma unroll 1
    for (int i = 0; i < n; i += 2) { ld(B, (i + 1 < n) ? i + 1 : i); cp(A, i); ld(A, (i + 2 < n) ? i + 2 : i); if (i + 1 < n) cp(B, i + 1); } }
DI void kv_load_t(KV8& r, const bf16* kt, const bf16* vt, int lane) {
    const bf16* k = kt + lane * 8; const bf16* v = vt + lane * 8;
    r.ka0 = *(const bf16x8*)k; r.ka1 = *(const bf16x8*)(k + 512); r.kb0 = *(const bf16x8*)(k + 1024); r.kb1 = *(const bf16x8*)(k + 1536);
    r.v0 = *(const bf16x8*)v; r.v1 = *(const bf16x8*)(v + 512); r.v2 = *(const bf16x8*)(v + 1024); r.v3 = *(const bf16x8*)(v + 1536); }
DI int krow_of(int i, int b) { return 8 * (i >> 2) + 4 * b + (i & 3); }

DI void dil_micro(const FP& P, int n, int h, int t0, int mt, int lane) {
    const int g = mt >> 4, idx = mt & 15, d = dil_d(g), per = 16 / d;
    const int r = idx / per, sub = idx % per, i0 = t0 / d + 16 * sub, ib = i0 - 128, NC = SEQ / d;
    const int q = lane & 15, c = lane >> 4;
    const bf16* Qb = P.QA + ((size_t)g * MPAD + (size_t)n * SEQ) * 256 + h * 64;
    const bf16* Kb = P.KA + ((size_t)(g * BATCH + n) * DIL_HEADS + h) * 64 * SEQ + (size_t)r * NC * 64; const bf16* Vb = P.VTA + ((size_t)(g * BATCH + n) * DIL_HEADS + h) * 64 * SEQ + (size_t)r * NC * 64;
    bf16x8 qf[2]; { const bf16* qp = Qb + (size_t)(r + d * (i0 + q)) * 256 + 8 * c; qf[0] = *(const bf16x8*)qp; qf[1] = *(const bf16x8*)(qp + 32); }
    Tile16 T; tile_init(T);
    const int qi = i0 + q; const int tb0 = ib >> 5  , nblk = ((i0 + 15) >> 5) - tb0 + 1;
    pipe2(nblk, [&](KV8& kv, int i) { int tb = tb0 + i; tb = tb < 0 ? 0 : tb; kv_load_t(kv, Kb + (size_t)tb * 2048, Vb + (size_t)tb * 2048, lane); },
          [&](const KV8& kv, int i) { const int k0 = 32 * (tb0 + i) + 8 * c; int lo; unsigned rng; const int a = qi - (DIL_TAPS - 1); mk_range((a > 0 ? a : 0) - k0, qi - k0, true, lo, rng); tile_compute(T, qf, kv, lo, rng); });
    const int row = n * SEQ + r + d * qi;
    float* op = P.DPART + (((size_t)g * MP + row) * DIL_HEADS + h) * 64 + 4 * c;
#pragma unroll
    for (int db = 0; db < 4; ++db) *(f32x4*)(op + 16 * db) = T.o[db];
    T.l = colsum(T.l);
    if (c == 0) { float* ml = P.DML + (((size_t)g * MP + row) * DIL_HEADS + h) * 2; ml[0] = T.m; ml[1] = T.l; }
}
DI void mem_micro(const FP& P, const bf16* Q  , int ldq, int row0, int layer, int n, int h, bf16* O  , int ldo, int lane) {
    const int q = lane & 15, c = lane >> 4;
    bf16x8 qf[2]; { const bf16* qp = Q + (size_t)(row0 + q) * ldq + 8 * c; qf[0] = *(const bf16x8*)qp; qf[1] = *(const bf16x8*)(qp + 32); }
    const bf16* Kb = P.MK + (((size_t)layer * BATCH + n) * MEM_HEADS + h) * MEM_TOKENS * 64; const bf16* Vb = P.MVT + (((size_t)layer * BATCH + n) * MEM_HEADS + h) * MEM_TOKENS * 64;
    Tile16 T; tile_init(T);
    pipe2(MEM_TOKENS / 32, [&](KV8& kv, int i) { kv_load_t(kv, Kb + (size_t)i * 2048, Vb + (size_t)i * 2048, lane); }, [&](const KV8& kv, int) { tile_compute(T, qf, kv, -8, 64u); });
    const float inv = 1.0f / colsum(T.l); bf16* op = O + (size_t)(row0 + q) * ldo + 4 * c;
#pragma unroll
    for (int db = 0; db < 4; ++db) *(u32x2*)(op + 16 * db) = pk4(T.o[db] * inv);
}
struct Dec { float m, l, o; };
template <class KF, class VF> DI void dec_chunk(Dec& D, const LAS float* q, int nk, KF kf, VF vf, int lane) {
    float s = -INFINITY;
    if (lane < nk) { const float* k = kf(lane); float a = 0.f;
#pragma unroll
        for (int d4 = 0; d4 < 16; ++d4) { const f32x4 kv = *(const f32x4*)(k + 4 * d4); a += kv.x * q[4 * d4] + kv.y * q[4 * d4 + 1] + kv.z * q[4 * d4 + 2] + kv.w * q[4 * d4 + 3]; }
        s = a; }
    const float mx = wave_max(s), mnew = fmaxf(D.m, mx), alpha = __builtin_amdgcn_exp2f(D.m - mnew);
    const float p = (lane < nk) ? __builtin_amdgcn_exp2f(s - mnew) : 0.f;
    D.l = D.l * alpha + wave_sum(p); D.m = mnew; float o = D.o * alpha;
    for (int j0 = 0; j0 < nk; j0 += 8) { float vv[8];
#pragma unroll
        for (int u = 0; u < 8; ++u) { const int jj = (j0 + u < nk) ? j0 + u : nk - 1; vv[u] = vf(jj)[lane]; }
#pragma unroll
        for (int u = 0; u < 8; ++u) { const float pj = (j0 + u < nk) ? __builtin_bit_cast(float, __builtin_amdgcn_readlane(__builtin_bit_cast(int, p), (j0 + u) & 63)) : 0.f; o += pj * vv[u]; } }
    D.o = o;
}
DI float dec_combine(const Ctx& C, const Dec& D) {
    LAS float* cb = (LAS float*)(C.lds + 4096);
    cb[C.wave * 66 + C.lane] = D.o; if (C.lane == 0) { cb[C.wave * 66 + 64] = D.m; cb[C.wave * 66 + 65] = D.l; }
    asm volatile("s_waitcnt lgkmcnt(0)" ::: "memory"); __syncthreads();
    float M = -INFINITY;
#pragma unroll
    for (int ww = 0; ww < NWAVES; ++ww) M = fmaxf(M, cb[ww * 66 + 64]);
    float L = 0.f, o = 0.f;
#pragma unroll
    for (int ww = 0; ww < NWAVES; ++ww) { const float mw = cb[ww * 66 + 64]; const float f = (mw == -INFINITY) ? 0.f : __builtin_amdgcn_exp2f(mw - M); L += f * cb[ww * 66 + 65]; o += f * cb[ww * 66 + C.lane]; }
    return o / L;
}
DI void atta_phase(const FP& P, const Ctx& C) {
    const int lane = C.lane, w = C.wave;
    constexpr int NT = SEQ / 256, NIT = BATCH * NT * DIL_HEADS;
    for (int it = C.vcu; it < NIT; it += C.G) { const int h = it % DIL_HEADS, tt = (it / DIL_HEADS) % NT, n = it / (DIL_HEADS * NT), t0 = tt * 256;
        for (int mt = w; mt < 48; mt += NWAVES) dil_micro(P, n, h, t0, mt, lane);
        asm volatile("s_waitcnt vmcnt(0)" ::: "memory"); __syncthreads();
        for (int i = C.tid; i < 256 * 16; i += NTHREADS) { const int tk = i >> 4, d4 = (i & 15) * 4; const int row = n * SEQ + t0 + tk;
            float mg[3], lg[3]; float M = -INFINITY;
#pragma unroll
            for (int g = 0; g < 3; ++g) { const float* ml = P.DML + (((size_t)g * MP + row) * DIL_HEADS + h) * 2; mg[g] = ml[0]; lg[g] = ml[1]; M = fmaxf(M, mg[g]); }
            f32x4 acc = (f32x4){0.f, 0.f, 0.f, 0.f}; float L = 0.f;
#pragma unroll
            for (int g = 0; g < 3; ++g) { const float wg = __builtin_amdgcn_exp2f(mg[g] - M); L += wg * lg[g]; acc += *(const f32x4*)(P.DPART + (((size_t)g * MP + row) * DIL_HEADS + h) * 64 + d4) * wg; }
            *(u32x2*)(P.ATTA + (size_t)row * 512 + h * 64 + d4) = pk4(acc * (1.0f / L)); }
        for (int mt = w; mt < 16; mt += NWAVES) mem_micro(P, P.MQA + h * 64, 256, n * SEQ + t0 + 16 * mt, 0, n, h, P.ATTA + 256 + h * 64, 512, lane);
        __syncthreads();
    }
    LAS float* qs = (LAS float*)C.lds;
    for (int it = C.vcu; it < DEC_BATCH * DIL_HEADS * 2; it += C.G) { const int kind = it & 1, h = (it >> 1) % DIL_HEADS, ns = (it >> 1) / DIL_HEADS, row = M0 + ns;
        __syncthreads();
        if (kind == 0) { if (C.tid < 192) qs[C.tid] = bf2f(P.QA[((size_t)(C.tid >> 6) * MPAD + row) * 256 + h * 64 + (C.tid & 63)]); } else { if (C.tid < 64) qs[C.tid] = bf2f(P.MQA[(size_t)row * 256 + h * 64 + C.tid]); }
        asm volatile("s_waitcnt lgkmcnt(0)" ::: "memory"); __syncthreads();
        Dec D; D.m = -INFINITY; D.l = 0.f; D.o = 0.f;
        if (kind == 0) { constexpr int CPG = (DIL_TAPS + 63) / 64;
            for (int ck = w; ck < 3 * CPG; ck += NWAVES) { const int g = ck / CPG, j0 = (ck % CPG) * 64; const int W = dil_w(g), d = dil_d(g); const float* cache = sel3c(P.cache_dil, g) + (size_t)ns * W * 512; const float* newrow = sel3(P.dil_s, g) + ((size_t)ns * W + W - 1) * 512;
                const int nk = (DIL_TAPS - j0) < 64 ? (DIL_TAPS - j0) : 64;
                dec_chunk(D, qs + g * 64, nk, [&](int j) { const int tap = j0 + j; return (tap == 0 ? newrow : cache + (size_t)(W - d * tap) * 512) + h * 64; },
                          [&](int j) { const int tap = j0 + j; return (tap == 0 ? newrow : cache + (size_t)(W - d * tap) * 512) + 256 + h * 64; }, lane); } }
        else { const float* mk = P.cache_mem_kv + ((size_t)0 * DEC_BATCH + ns) * MEM_TOKENS * 512;
            for (int ck = w; ck < MEM_TOKENS / 64; ck += NWAVES) { const int j0 = ck * 64; dec_chunk(D, qs, 64, [&](int j) { return mk + (size_t)(j0 + j) * 512 + h * 64; }, [&](int j) { return mk + (size_t)(j0 + j) * 512 + 256 + h * 64; }, lane); } }
        const float o = dec_combine(C, D);
        if (w == 0) P.ATTA[(size_t)row * 512 + (kind == 0 ? 0 : 256) + h * 64 + lane] = (bf16)f2bf(o);
    }
    __syncthreads();
}
DI void ln_phase(const FP& P, const Ctx& C, const float* pre, const float* gam, const float* bet, float* xo, bf16* xb, float* yp, float* ys) {
    const int gw = C.vcu * NWAVES + C.wave, NGW = C.G * NWAVES, lane = C.lane;
    for (int r = gw; r < MP; r += NGW) { const float* x = pre + (size_t)r * D_MODEL; f32x4 v[4]; float s = 0.f;
#pragma unroll
        for (int j = 0; j < 4; ++j) { v[j] = *(const f32x4*)(x + 256 * j + 4 * lane); s += (v[j].x + v[j].y) + (v[j].z + v[j].w); }
        const float mu = wave_sum(s) * (1.0f / D_MODEL); float s2 = 0.f;
#pragma unroll
        for (int j = 0; j < 4; ++j) { v[j] = v[j] - mu; s2 += (v[j].x * v[j].x + v[j].y * v[j].y) + (v[j].z * v[j].z + v[j].w * v[j].w); }
        const float rs = 1.0f / sqrtf(wave_sum(s2) * (1.0f / D_MODEL) + LN_EPS);
#pragma unroll
        for (int j = 0; j < 4; ++j) { const f32x4 gg = *(const f32x4*)(gam + 256 * j + 4 * lane), bb = *(const f32x4*)(bet + 256 * j + 4 * lane); const f32x4 o = v[j] * rs * gg + bb;
            if (xo) *(f32x4*)(xo + (size_t)r * D_MODEL + 256 * j + 4 * lane) = o;
            if (xb) *(u32x2*)(xb + (size_t)r * D_MODEL + 256 * j + 4 * lane) = pk4(o);
            if (yp) { if (r < M0) *(f32x4*)(yp + (size_t)r * D_MODEL + 256 * j + 4 * lane) = o; else *(f32x4*)(ys + (size_t)(r - M0) * D_MODEL + 256 * j + 4 * lane) = o; } }
    }
}
}
namespace fx {
#define INS16(V, I, v_, i_) do { const float _v = (v_); const int _i = (i_); bool _c[16]; _Pragma("unroll") for (int _k = 0; _k < 16; ++_k) _c[_k] = _v > V[_k]; \
    _Pragma("unroll") for (int _k = 15; _k >= 1; --_k) { V[_k] = _c[_k] ? (_c[_k - 1] ? V[_k - 1] : _v) : V[_k]; I[_k] = _c[_k] ? (_c[_k - 1] ? I[_k - 1] : _i) : I[_k]; } \
    V[0] = _c[0] ? _v : V[0]; I[0] = _c[0] ? _i : I[0]; } while (0)
DI void wave_top16_128(float a, float b, int lane, float& outv, int& outi) {
    outv = -INFINITY; outi = 0;
#pragma unroll 1
    for (int k = 0; k < 16; ++k) { const float m = wave_max(fmaxf(a, b)); const unsigned long long ba = __ballot(a == m), bb = __ballot(b == m); int idx;
        if (ba) { const int l = __builtin_ctzll(ba); idx = l; if (lane == l) a = -INFINITY; } else { const int l = __builtin_ctzll(bb); idx = 64 + l; if (lane == l) b = -INFINITY; }
        if (lane == k) { outv = m; outi = idx; } }
}
DI void topk_wave_item(const FP& P, long it, int lane) {
    const float* s = P.SCO + it * 256; float v1, v2; int i1, i2;
    wave_top16_128(s[lane], s[64 + lane], lane, v1, i1); wave_top16_128(s[128 + lane], s[192 + lane], lane, v2, i2);
    int a = 0, rem = lane; bool valid = false;
    for (int aa = 0; aa < 16; ++aa) { const int nb = 16 / (aa + 1); if (!valid) { if (rem < nb) { a = aa; valid = true; } else rem -= nb; } }
    const int b = valid ? rem : 0;
    float cs = __shfl(v1, a) + __shfl(v2, b); const int ce = __shfl(i1, a) * PEER_KEYS + __shfl(i2, b); if (!valid) cs = -INFINITY;
    float tv = -INFINITY; int te = 0;
#pragma unroll 1
    for (int k = 0; k < 16; ++k) { const float m = wave_max(cs); const unsigned long long bm = __ballot(cs == m); const int l = __builtin_ctzll(bm); const int e = __shfl(ce, l); if (lane == l) cs = -INFINITY; if (lane == k) { tv = m; te = e; } }
    const float mx = __shfl(tv, 0); const float ex = (lane < 16) ? __expf(tv - mx) : 0.f; const float z = wave_sum(ex);
    if (lane < 16) { P.SELG[it * 16 + lane] = ex / z; P.SELE[it * 16 + lane] = te; }
}
#define KINS16(V, key_) do { const float _key = (key_); _Pragma("unroll") for (int _k = 15; _k >= 1; --_k) V[_k] = __builtin_amdgcn_fmed3f(V[_k - 1], V[_k], _key); V[0] = fmaxf(V[0], _key); } while (0)
DI float pack_key(float v, unsigned lowbits, unsigned mask) { return __builtin_bit_cast(float, (__builtin_bit_cast(unsigned, v) & ~mask) | lowbits); }
DI void topk_phase(const FP& P, const Ctx& C) {
    const int lane = C.lane; LAS float* st = (LAS float*)(C.lds + C.wave * 16384);
    const int NWI = (M0 * PEER_HEADS) / 64;
    for (int wi = C.vcu * NWAVES + C.wave; wi < NWI; wi += C.G * NWAVES) {
        const long it0 = (long)wi * 64; const long it = it0 + lane;
        float V1[16], V2[16], V3[16];
#pragma unroll
        for (int k = 0; k < 16; ++k) { V1[k] = V2[k] = V3[k] = -INFINITY; }
#pragma unroll 1
        for (int ch = 0; ch < 8; ++ch) {
#pragma unroll
            for (int u = 0; u < 8; ++u) { const int f4 = u * 64 + lane, j = f4 >> 3, q = f4 & 7, hf = q >> 2, c4 = (q & 3) * 4; const long itj = it0 + j;
                const f32x4 v = *(const f32x4*)(P.SCO + itj * 256 + hf * 128 + ch * 16 + c4);
                st[j * 33 + hf * 16 + c4] = v.x; st[j * 33 + hf * 16 + c4 + 1] = v.y; st[j * 33 + hf * 16 + c4 + 2] = v.z; st[j * 33 + hf * 16 + c4 + 3] = v.w; }
            asm volatile("s_waitcnt lgkmcnt(0)" ::: "memory");
#pragma unroll 4
            for (int c = 0; c < 16; ++c) { const float va = st[lane * 33 + c], vb = st[lane * 33 + 16 + c]; const unsigned lb = 127u - (unsigned)(ch * 16 + c); KINS16(V1, pack_key(va, lb, 127u)); KINS16(V2, pack_key(vb, lb, 127u)); }
            asm volatile("s_waitcnt lgkmcnt(0)" ::: "memory");
        }
        LAS int* lc = (LAS int*)st;
        { int ord = 0;
#pragma unroll
          for (int a = 0; a < 16; ++a) { const unsigned ba = __builtin_bit_cast(unsigned, V1[a]); const float va = __builtin_bit_cast(float, ba & ~127u); const int ia = 127 - (int)(ba & 127u);
#pragma unroll
              for (int b = 0; b < 16; ++b) if ((a + 1) * (b + 1) <= 16) { const unsigned bb = __builtin_bit_cast(unsigned, V2[b]); const float vb = __builtin_bit_cast(float, bb & ~127u); const int ib = 127 - (int)(bb & 127u);
                  lc[lane * 51 + ord] = ia * PEER_KEYS + ib; KINS16(V3, pack_key(va + vb, 63u - (unsigned)ord, 63u)); ++ord; } } }
        asm volatile("s_waitcnt lgkmcnt(0)" ::: "memory");
        float g[16]; int e[16]; float z = 0.f; const float vmax = __builtin_bit_cast(float, __builtin_bit_cast(unsigned, V3[0]) & ~63u);
#pragma unroll
        for (int k = 0; k < 16; ++k) { const unsigned bk = __builtin_bit_cast(unsigned, V3[k]); e[k] = lc[lane * 51 + 63 - (int)(bk & 63u)]; g[k] = __expf(__builtin_bit_cast(float, bk & ~63u) - vmax); z += g[k]; }
        const float iz = 1.0f / z;
#pragma unroll
        for (int k4 = 0; k4 < 4; ++k4) { *(f32x4*)(P.SELG + it * 16 + 4 * k4) = (f32x4){g[4 * k4] * iz, g[4 * k4 + 1] * iz, g[4 * k4 + 2] * iz, g[4 * k4 + 3] * iz};
            *(int4*)(P.SELE + it * 16 + 4 * k4) = make_int4(e[4 * k4], e[4 * k4 + 1], e[4 * k4 + 2], e[4 * k4 + 3]); }
        asm volatile("s_waitcnt lgkmcnt(0)" ::: "memory");
    }
    for (int si = C.vcu * NWAVES + C.wave; si < DEC_BATCH * PEER_HEADS; si += C.G * NWAVES) topk_wave_item(P, (long)M0 * PEER_HEADS + si, lane);
    __syncthreads();
}
constexpr float PEER_SU = 256.f, PEER_SV = 64.f;
DI float dot16_fp8(const u32x4& w, const f32x2 (&x2)[8]) { f32x2 a = {0.f, 0.f};
    a += __builtin_amdgcn_cvt_pk_f32_fp8((int)w.x, false) * x2[0]; a += __builtin_amdgcn_cvt_pk_f32_fp8((int)w.x, true) * x2[1];
    a += __builtin_amdgcn_cvt_pk_f32_fp8((int)w.y, false) * x2[2]; a += __builtin_amdgcn_cvt_pk_f32_fp8((int)w.y, true) * x2[3];
    a += __builtin_amdgcn_cvt_pk_f32_fp8((int)w.z, false) * x2[4]; a += __builtin_amdgcn_cvt_pk_f32_fp8((int)w.z, true) * x2[5];
    a += __builtin_amdgcn_cvt_pk_f32_fp8((int)w.w, false) * x2[6]; a += __builtin_amdgcn_cvt_pk_f32_fp8((int)w.w, true) * x2[7];
    return a.x + a.y; }
DI void axpy16_fp8(const u32x4& w, float s, f32x2 (&o2)[8]) { const f32x2 s2 = {s, s};
    o2[0] += __builtin_amdgcn_cvt_pk_f32_fp8((int)w.x, false) * s2; o2[1] += __builtin_amdgcn_cvt_pk_f32_fp8((int)w.x, true) * s2;
    o2[2] += __builtin_amdgcn_cvt_pk_f32_fp8((int)w.y, false) * s2; o2[3] += __builtin_amdgcn_cvt_pk_f32_fp8((int)w.y, true) * s2;
    o2[4] += __builtin_amdgcn_cvt_pk_f32_fp8((int)w.z, false) * s2; o2[5] += __builtin_amdgcn_cvt_pk_f32_fp8((int)w.z, true) * s2;
    o2[6] += __builtin_amdgcn_cvt_pk_f32_fp8((int)w.w, false) * s2; o2[7] += __builtin_amdgcn_cvt_pk_f32_fp8((int)w.w, true) * s2; }
#if defined(PEER_SHARD) || defined(PEER_SHARD2)
#define PEER_FIRST_ROUND nrounds
#else
#define PEER_FIRST_ROUND 0
#endif
template <int CTRL> DI float dppf(float x) { return __builtin_bit_cast(float, __builtin_amdgcn_update_dpp(0, __builtin_bit_cast(int, x), CTRL, 0xF, 0xF, true)); }
DI float rdlane(float v, int l) { return __builtin_bit_cast(float, __builtin_amdgcn_readlane(__builtin_bit_cast(int, v), l)); }
DI void peer_phase(const FP& P, const Ctx& C, int layer, const float* xin, float* fout, float* fout_s, bf16* xb, bool samples_only = false) {
    const int lane = C.lane; const unsigned char* U = P.UB8 + (size_t)layer * PEER_EXPERTS * D_MODEL; const unsigned char* Vt = P.VB8 + (size_t)layer * PEER_EXPERTS * D_MODEL;
    const float* gam = P.ln_g + ((size_t)layer * 2 + 1) * D_MODEL; const float* bet = P.ln_b + ((size_t)layer * 2 + 1) * D_MODEL;
    const int nrounds = (M0 + C.G * NWAVES - 1) / (C.G * NWAVES);
#pragma unroll 1
    for (int rd = samples_only ? nrounds : 0; rd <= nrounds; ++rd) {
        const bool smp = (rd == nrounds); int r = smp ? M0 + C.vcu : rd * C.G * NWAVES + C.vcu * NWAVES + C.wave; if (smp ? (C.vcu >= DEC_BATCH) : (r >= M0)) continue;
        const int pb = smp ? 16 * C.wave : 0, pe = smp ? pb + 16 : 128;
        f32x2 x2[8], o2[8];
#pragma unroll
        for (int j = 0; j < 4; ++j) { const f32x4 a = *(const f32x4*)(xin + (size_t)r * D_MODEL + 16 * lane + 4 * j); x2[2 * j] = (f32x2){a.x, a.y}; x2[2 * j + 1] = (f32x2){a.z, a.w}; }
#pragma unroll
        for (int k = 0; k < 8; ++k) o2[k] = (f32x2){0.f, 0.f};
        const int e_l = P.SELE[(size_t)r * 128 + lane], e_h = P.SELE[(size_t)r * 128 + 64 + lane]; const float g_l = P.SELG[(size_t)r * 128 + lane], g_h = P.SELG[(size_t)r * 128 + 64 + lane];
#pragma unroll 1
        for (int b0 = pb; b0 < pe; b0 += 8) {
            u32x4 uw[8], vw[8];
#pragma unroll
            for (int k = 0; k < 8; ++k) { const int hk = b0 + k; const int e = (hk < 64) ? __builtin_amdgcn_readlane(e_l, hk & 63) : __builtin_amdgcn_readlane(e_h, hk & 63);
                uw[k] = *(const u32x4*)(U + (size_t)e * D_MODEL + 16 * lane); vw[k] = *(const u32x4*)(Vt + (size_t)e * D_MODEL + 16 * lane); }
            float d[8];
#pragma unroll
            for (int k = 0; k < 8; ++k) d[k] = dot16_fp8(uw[k], x2);
            float e4[4], e2[2], e1;
            { const bool hi = lane & 1;
#pragma unroll
              for (int i = 0; i < 4; ++i) { const float keep = hi ? d[4 + i] : d[i], send = hi ? d[i] : d[4 + i]; e4[i] = keep + __shfl_xor(send, 1); } }
            { const bool hi = lane & 2;
#pragma unroll
              for (int i = 0; i < 2; ++i) { const float keep = hi ? e4[2 + i] : e4[i], send = hi ? e4[i] : e4[2 + i]; e2[i] = keep + __shfl_xor(send, 2); } }
            { const bool hi = lane & 4; const float keep = hi ? e2[1] : e2[0], send = hi ? e2[0] : e2[1]; e1 = keep + __shfl_xor(send, 4); }
            e1 += __shfl_xor(e1, 8); e1 += __shfl_xor(e1, 16); e1 += __shfl_xor(e1, 32);
            const int myk = 4 * (lane & 1) + (lane & 2) + ((lane >> 2) & 1); const int myhk = b0 + myk;
            const float myg = (myhk < 64) ? __shfl(g_l, myhk & 63) : __shfl(g_h, myhk & 63);
            const float act = myg * gelu_tanh(e1 * (1.0f / PEER_SU)) * (1.0f / PEER_SV);
#pragma unroll
            for (int k = 0; k < 8; ++k) { const int src = (k >> 2) | (((k >> 1) & 1) << 1) | ((k & 1) << 2); axpy16_fp8(vw[k], rdlane(act, src), o2); }
        }
        if (smp) {
            LAS float* red = (LAS float*)C.lds;
#pragma unroll
            for (int k = 0; k < 8; ++k) { red[C.wave * 1024 + 16 * lane + 2 * k] = o2[k].x; red[C.wave * 1024 + 16 * lane + 2 * k + 1] = o2[k].y; }
            asm volatile("s_waitcnt lgkmcnt(0)" ::: "memory"); __syncthreads();
            if (C.wave == 0) {
#pragma unroll
                for (int k = 0; k < 8; ++k) { float ax = 0.f, ay = 0.f;
#pragma unroll
                    for (int ww = 0; ww < NWAVES; ++ww) { ax += red[ww * 1024 + 16 * lane + 2 * k]; ay += red[ww * 1024 + 16 * lane + 2 * k + 1]; } o2[k] = (f32x2){ax, ay}; } }
            __syncthreads();
            if (C.wave != 0) continue; }
        float s = 0.f;
#pragma unroll
        for (int k = 0; k < 8; ++k) { o2[k] += x2[k] * ALPHA; s += o2[k].x + o2[k].y; }
        const float mu = wave_sum(s) * (1.0f / D_MODEL); float s2 = 0.f;
#pragma unroll
        for (int k = 0; k < 8; ++k) { o2[k] -= mu; s2 += o2[k].x * o2[k].x + o2[k].y * o2[k].y; }
        const float rs = 1.0f / sqrtf(wave_sum(s2) * (1.0f / D_MODEL) + LN_EPS);
        float* frow = (r < M0) ? fout + (size_t)r * D_MODEL : fout_s + (size_t)(r - M0) * D_MODEL;
#pragma unroll
        for (int j = 0; j < 4; ++j) { const int c0 = 16 * lane + 4 * j; const f32x4 gg = *(const f32x4*)(gam + c0), bb = *(const f32x4*)(bet + c0);
            const f32x4 y = (f32x4){o2[2 * j].x * rs, o2[2 * j].y * rs, o2[2 * j + 1].x * rs, o2[2 * j + 1].y * rs} * gg + bb;
            *(f32x4*)(frow + c0) = y; if (xb) *(u32x2*)(xb + (size_t)r * D_MODEL + c0) = pk4(y); }
    }
}
DI void peer_u_phase(const FP& P, const Ctx& C, int layer, const bf16* xb16) {
    const int lane = C.lane; const unsigned char* U = P.UB8 + (size_t)layer * PEER_EXPERTS * D_MODEL;
    const int s = (int)(blockIdx.x & 7), nw = (C.G >> 3) * NWAVES, widx = (int)(blockIdx.x >> 3) * NWAVES + C.wave;
#pragma unroll 1
    for (int r = widx; r < MP; r += nw) {
        const int e0 = P.SELE[(size_t)r * 128 + lane], e1 = P.SELE[(size_t)r * 128 + 64 + lane]; const float g0 = P.SELG[(size_t)r * 128 + lane], g1 = P.SELG[(size_t)r * 128 + 64 + lane];
        unsigned long long b0 = __ballot((e0 >> 11) == s), b1 = __ballot((e1 >> 11) == s);
        if ((b0 | b1) == 0ull) continue;
        f32x2 x2[8]; { const u32x4 xa = *(const u32x4*)(xb16 + (size_t)r * D_MODEL + 16 * lane), xc = *(const u32x4*)(xb16 + (size_t)r * D_MODEL + 16 * lane + 8);
            x2[0] = (f32x2){bflo(xa.x), bfhi(xa.x)}; x2[1] = (f32x2){bflo(xa.y), bfhi(xa.y)}; x2[2] = (f32x2){bflo(xa.z), bfhi(xa.z)}; x2[3] = (f32x2){bflo(xa.w), bfhi(xa.w)};
            x2[4] = (f32x2){bflo(xc.x), bfhi(xc.x)}; x2[5] = (f32x2){bflo(xc.y), bfhi(xc.y)}; x2[6] = (f32x2){bflo(xc.z), bfhi(xc.z)}; x2[7] = (f32x2){bflo(xc.w), bfhi(xc.w)}; }
#pragma unroll 1
        while ((b0 | b1) != 0ull) {
            int hk[8]; u32x4 uw[8]; int nv = 0;
#pragma unroll
            for (int k = 0; k < 8; ++k) { int h;
                if (b0) { h = __builtin_ctzll(b0); b0 &= b0 - 1; ++nv; } else if (b1) { h = 64 + __builtin_ctzll(b1); b1 &= b1 - 1; ++nv; } else h = hk[k > 0 ? k - 1 : 0];
                hk[k] = h; const int e = (h < 64) ? __builtin_amdgcn_readlane(e0, h & 63) : __builtin_amdgcn_readlane(e1, h & 63);
                uw[k] = *(const u32x4*)(U + (size_t)e * D_MODEL + 16 * lane); }
            float d[8];
#pragma unroll
            for (int k = 0; k < 8; ++k) d[k] = dot16_fp8(uw[k], x2);
            float e4[4], e2[2], e1s;
            { const bool hi = lane & 1;
#pragma unroll
              for (int i = 0; i < 4; ++i) { const float keep = hi ? d[4 + i] : d[i], send = hi ? d[i] : d[4 + i]; e4[i] = keep + __shfl_xor(send, 1); } }
            { const bool hi = lane & 2;
#pragma unroll
              for (int i = 0; i < 2; ++i) { const float keep = hi ? e4[2 + i] : e4[i], send = hi ? e4[i] : e4[2 + i]; e2[i] = keep + __shfl_xor(send, 2); } }
            { const bool hi = lane & 4; const float keep = hi ? e2[1] : e2[0], send = hi ? e2[0] : e2[1]; e1s = keep + __shfl_xor(send, 4); }
            e1s += __shfl_xor(e1s, 8); e1s += __shfl_xor(e1s, 16); e1s += __shfl_xor(e1s, 32);
            const int myk = 4 * (lane & 1) + (lane & 2) + ((lane >> 2) & 1);
            int myh = hk[0];
#pragma unroll
            for (int k = 1; k < 8; ++k) myh = (myk == k) ? hk[k] : myh;
            const float ga = __shfl(g0, myh & 63), gb = __shfl(g1, myh & 63); const float myg = (myh < 64) ? ga : gb;
            if (lane < 8 && myk < nv) P.SCO[(size_t)r * 128 + myh] = myg * gelu_tanh(e1s * (1.0f / PEER_SU)) * (1.0f / PEER_SV);
        }
    }
}
DI void peer_v_phase(const FP& P, const Ctx& C, int layer, const float* xin, float* fout, float* fout_s, bf16* xb) {
    const int lane = C.lane; const unsigned char* Vt = P.VB8 + (size_t)layer * PEER_EXPERTS * D_MODEL;
    const float* gam = P.ln_g + ((size_t)layer * 2 + 1) * D_MODEL; const float* bet = P.ln_b + ((size_t)layer * 2 + 1) * D_MODEL;
    const int nrounds = (M0 + C.G * NWAVES - 1) / (C.G * NWAVES);
#pragma unroll 1
    for (int rd = 0; rd <= nrounds; ++rd) {
        const bool smp = (rd == nrounds); int r = smp ? M0 + C.vcu : rd * C.G * NWAVES + C.vcu * NWAVES + C.wave; if (smp ? (C.vcu >= DEC_BATCH) : (r >= M0)) continue;
        const int pb = smp ? 16 * C.wave : 0, pe = smp ? pb + 16 : 128;
        f32x2 x2[8], o2[8];
#pragma unroll
        for (int j = 0; j < 4; ++j) { const f32x4 a = *(const f32x4*)(xin + (size_t)r * D_MODEL + 16 * lane + 4 * j); x2[2 * j] = (f32x2){a.x, a.y}; x2[2 * j + 1] = (f32x2){a.z, a.w}; }
#pragma unroll
        for (int k = 0; k < 8; ++k) o2[k] = (f32x2){0.f, 0.f};
        const int e_l = P.SELE[(size_t)r * 128 + lane], e_h = P.SELE[(size_t)r * 128 + 64 + lane]; const float a_l = P.SCO[(size_t)r * 128 + lane], a_h = P.SCO[(size_t)r * 128 + 64 + lane];
#pragma unroll 1
        for (int b0 = pb; b0 < pe; b0 += 16) { u32x4 vw[16];
#pragma unroll
            for (int k = 0; k < 16; ++k) { const int hk = b0 + k; const int e = (hk < 64) ? __builtin_amdgcn_readlane(e_l, hk & 63) : __builtin_amdgcn_readlane(e_h, hk & 63); vw[k] = *(const u32x4*)(Vt + (size_t)e * D_MODEL + 16 * lane); }
#pragma unroll
            for (int k = 0; k < 16; ++k) { const int hk = b0 + k; axpy16_fp8(vw[k], (hk < 64) ? rdlane(a_l, hk & 63) : rdlane(a_h, hk & 63), o2); } }
        if (smp) {
            LAS float* red = (LAS float*)C.lds;
#pragma unroll
            for (int k = 0; k < 8; ++k) { red[C.wave * 1024 + 16 * lane + 2 * k] = o2[k].x; red[C.wave * 1024 + 16 * lane + 2 * k + 1] = o2[k].y; }
            asm volatile("s_waitcnt lgkmcnt(0)" ::: "memory"); __syncthreads();
            if (C.wave == 0) {
#pragma unroll
                for (int k = 0; k < 8; ++k) { float ax = 0.f, ay = 0.f;
#pragma unroll
                    for (int ww = 0; ww < NWAVES; ++ww) { ax += red[ww * 1024 + 16 * lane + 2 * k]; ay += red[ww * 1024 + 16 * lane + 2 * k + 1]; } o2[k] = (f32x2){ax, ay}; } }
            __syncthreads();
            if (C.wave != 0) continue; }
        float s = 0.f;
#pragma unroll
        for (int k = 0; k < 8; ++k) { o2[k] += x2[k] * ALPHA; s += o2[k].x + o2[k].y; }
        const float mu = wave_sum(s) * (1.0f / D_MODEL); float s2 = 0.f;
#pragma unroll
        for (int k = 0; k < 8; ++k) { o2[k] -= mu; s2 += o2[k].x * o2[k].x + o2[k].y * o2[k].y; }
        const float rs = 1.0f / sqrtf(wave_sum(s2) * (1.0f / D_MODEL) + LN_EPS);
        float* frow = (r < M0) ? fout + (size_t)r * D_MODEL : fout_s + (size_t)(r - M0) * D_MODEL;
#pragma unroll
        for (int j = 0; j < 4; ++j) { const int c0 = 16 * lane + 4 * j; const f32x4 gg = *(const f32x4*)(gam + c0), bb = *(const f32x4*)(bet + c0);
            const f32x4 y = (f32x4){o2[2 * j].x * rs, o2[2 * j].y * rs, o2[2 * j + 1].x * rs, o2[2 * j + 1].y * rs} * gg + bb;
            *(f32x4*)(frow + c0) = y; if (xb) *(u32x2*)(xb + (size_t)r * D_MODEL + c0) = pk4(y); }
    }
}
constexpr int PSH_LIST = 512;
struct PG4 { u32x4 u[4], v[4]; };
DI void peer_sharded_phase(const FP& P, const Ctx& C, int layer, const float* xin, const bf16* xb16, float* fout, float* fout_s, bf16* xb) {
    const int lane = C.lane; const unsigned char* U = P.UB8 + (size_t)layer * PEER_EXPERTS * D_MODEL; const unsigned char* Vt = P.VB8 + (size_t)layer * PEER_EXPERTS * D_MODEL;
    const float* gam = P.ln_g + ((size_t)layer * 2 + 1) * D_MODEL; const float* bet = P.ln_b + ((size_t)layer * 2 + 1) * D_MODEL;
    LAS unsigned char* wl = C.lds + C.wave * 16384; LAS bf16* xs = (LAS bf16*)wl; LAS int* lst = (LAS int*)(wl + 8192);
    const int NW = C.G * NWAVES, gw = C.vcu * NWAVES + C.wave; const int nquads = (M0 / NW) / 4;
#pragma unroll 1
    for (int qd = 0; qd < nquads; ++qd) {
#define PSH_ROW(j) const int row##j = (qd * 4 + j) * NW + gw; const int el##j = P.SELE[(size_t)row##j * 128 + lane], eh##j = P.SELE[(size_t)row##j * 128 + 64 + lane]; const float gl##j = P.SELG[(size_t)row##j * 128 + lane], gh##j = P.SELG[(size_t)row##j * 128 + 64 + lane]; \
        { const u32x4 xa = *(const u32x4*)(xb16 + (size_t)row##j * D_MODEL + 16 * lane), xc = *(const u32x4*)(xb16 + (size_t)row##j * D_MODEL + 16 * lane + 8); *(LAS u32x4*)(xs + j * 1024 + 16 * lane) = xa; *(LAS u32x4*)(xs + j * 1024 + 16 * lane + 8) = xc; } \
        f32x2 oa##j[8]; _Pragma("unroll") for (int k = 0; k < 8; ++k) oa##j[k] = (f32x2){0.f, 0.f};
        PSH_ROW(0) PSH_ROW(1) PSH_ROW(2) PSH_ROW(3)
#pragma unroll 1
        for (int s = 0; s < 16; ++s) {
            int n = 0;
#define PSH_SCAN(j) { unsigned long long b0 = __ballot((el##j >> 10) == s), b1 = __ballot((eh##j >> 10) == s); \
                while (b0) { const int h = __builtin_ctzll(b0); b0 &= b0 - 1; const int e = __builtin_amdgcn_readlane(el##j, h); const int g = __builtin_amdgcn_readlane(__builtin_bit_cast(int, gl##j), h); \
                    if (lane == 0) { lst[4 * n] = e; lst[4 * n + 1] = g; lst[4 * n + 2] = j; } ++n; } \
                while (b1) { const int h = __builtin_ctzll(b1); b1 &= b1 - 1; const int e = __builtin_amdgcn_readlane(eh##j, h); const int g = __builtin_amdgcn_readlane(__builtin_bit_cast(int, gh##j), h); \
                    if (lane == 0) { lst[4 * n] = e; lst[4 * n + 1] = g; lst[4 * n + 2] = j; } ++n; } }
            PSH_SCAN(0) PSH_SCAN(1) PSH_SCAN(2) PSH_SCAN(3)
            asm volatile("s_waitcnt lgkmcnt(0)" ::: "memory");
            if (n == 0) continue;
            const int ngrp = (n + 3) >> 2;
#define PSH_LD(b, gi_) do { const int gi = (gi_); _Pragma("unroll") for (int k = 0; k < 4; ++k) { int i = 4 * gi + k; i = i < n ? i : n - 1; const int e = __builtin_amdgcn_readfirstlane(lst[4 * i]); \
                b.u[k] = *(const u32x4*)(U + (size_t)e * D_MODEL + 16 * lane); b.v[k] = *(const u32x4*)(Vt + (size_t)e * D_MODEL + 16 * lane); } } while (0)
#define PSH_CP(b, gi_) do { const int gi = (gi_); float d[4]; int jj[4]; float gg[4]; \
                _Pragma("unroll") for (int k = 0; k < 4; ++k) { int i = 4 * gi + k; const bool val = i < n; i = val ? i : n - 1; jj[k] = __builtin_amdgcn_readfirstlane(lst[4 * i + 2]); gg[k] = val ? __builtin_bit_cast(float, __builtin_amdgcn_readfirstlane(lst[4 * i + 1])) : 0.f; \
                    const u32x4 xa = *(const LAS u32x4*)(xs + jj[k] * 1024 + 16 * lane), xc = *(const LAS u32x4*)(xs + jj[k] * 1024 + 16 * lane + 8); \
                    const f32x2 x2[8] = {(f32x2){bflo(xa.x), bfhi(xa.x)}, (f32x2){bflo(xa.y), bfhi(xa.y)}, (f32x2){bflo(xa.z), bfhi(xa.z)}, (f32x2){bflo(xa.w), bfhi(xa.w)}, (f32x2){bflo(xc.x), bfhi(xc.x)}, (f32x2){bflo(xc.y), bfhi(xc.y)}, (f32x2){bflo(xc.z), bfhi(xc.z)}, (f32x2){bflo(xc.w), bfhi(xc.w)}}; \
                    d[k] = dot16_fp8(b.u[k], x2); } \
                float e2[2], e1; \
                { const bool hi = lane & 1; _Pragma("unroll") for (int i = 0; i < 2; ++i) { const float keep = hi ? d[2 + i] : d[i], send = hi ? d[i] : d[2 + i]; e2[i] = keep + __shfl_xor(send, 1); } } \
                { const bool hi = lane & 2; const float keep = hi ? e2[1] : e2[0], send = hi ? e2[0] : e2[1]; e1 = keep + __shfl_xor(send, 2); } \
                e1 += __shfl_xor(e1, 4); e1 += __shfl_xor(e1, 8); e1 += __shfl_xor(e1, 16); e1 += __shfl_xor(e1, 32); \
                const int myk = 2 * (lane & 1) + ((lane >> 1) & 1); \
                float myg = gg[0]; myg = (myk == 1) ? gg[1] : myg; myg = (myk == 2) ? gg[2] : myg; myg = (myk == 3) ? gg[3] : myg; \
                const float act = myg * gelu_tanh(e1 * (1.0f / PEER_SU)) * (1.0f / PEER_SV); \
                _Pragma("unroll") for (int k = 0; k < 4; ++k) { const float a = rdlane(act, (k >> 1) | ((k & 1) << 1)); \
                    if (jj[k] == 0) axpy16_fp8(b.v[k], a, oa0); else if (jj[k] == 1) axpy16_fp8(b.v[k], a, oa1); else if (jj[k] == 2) axpy16_fp8(b.v[k], a, oa2); else axpy16_fp8(b.v[k], a, oa3); } } while (0)
            { PG4 A, B; PSH_LD(A, 0);
#pragma unroll 1
              for (int g2 = 0; g2 < ngrp; g2 += 2) { PSH_LD(B, (g2 + 1 < ngrp) ? g2 + 1 : g2); PSH_CP(A, g2); PSH_LD(A, (g2 + 2 < ngrp) ? g2 + 2 : g2); if (g2 + 1 < ngrp) PSH_CP(B, g2 + 1); } }
            asm volatile("s_waitcnt lgkmcnt(0)" ::: "memory");
        }
#define PSH_LN(j) { const int r = row##j; f32x2 x2[8]; \
            _Pragma("unroll") for (int q = 0; q < 4; ++q) { const f32x4 a = *(const f32x4*)(xin + (size_t)r * D_MODEL + 16 * lane + 4 * q); x2[2 * q] = (f32x2){a.x, a.y}; x2[2 * q + 1] = (f32x2){a.z, a.w}; } \
            float sm = 0.f; _Pragma("unroll") for (int k = 0; k < 8; ++k) { oa##j[k] += x2[k] * ALPHA; sm += oa##j[k].x + oa##j[k].y; } \
            const float mu = wave_sum(sm) * (1.0f / D_MODEL); float s2 = 0.f; _Pragma("unroll") for (int k = 0; k < 8; ++k) { oa##j[k] -= mu; s2 += oa##j[k].x * oa##j[k].x + oa##j[k].y * oa##j[k].y; } \
            const float rs = 1.0f / sqrtf(wave_sum(s2) * (1.0f / D_MODEL) + LN_EPS); float* frow = fout + (size_t)r * D_MODEL; \
            _Pragma("unroll") for (int q = 0; q < 4; ++q) { const int c0 = 16 * lane + 4 * q; const f32x4 gv = *(const f32x4*)(gam + c0), bv = *(const f32x4*)(bet + c0); \
                const f32x4 y = (f32x4){oa##j[2 * q].x * rs, oa##j[2 * q].y * rs, oa##j[2 * q + 1].x * rs, oa##j[2 * q + 1].y * rs} * gv + bv; *(f32x4*)(frow + c0) = y; if (xb) *(u32x2*)(xb + (size_t)r * D_MODEL + c0) = pk4(y); } }
        PSH_LN(0) PSH_LN(1) PSH_LN(2) PSH_LN(3)
        asm volatile("s_waitcnt lgkmcnt(0)" ::: "memory");
    }
}
#ifndef PSH_LOG_V
#define PSH_LOG_V 11
#endif
constexpr int PSH_LOG = PSH_LOG_V, PSH_N = PEER_EXPERTS >> PSH_LOG;
#ifndef PS2_ROWS
#define PS2_ROWS 4
#endif
#define PS2_ROW(j) const int row##j = (qd * PS2_ROWS + j) * NW + gw; const int el##j = P.SELE[(size_t)row##j * 128 + lane], eh##j = P.SELE[(size_t)row##j * 128 + 64 + lane]; const float gl##j = P.SELG[(size_t)row##j * 128 + lane], gh##j = P.SELG[(size_t)row##j * 128 + 64 + lane]; \
    f32x2 oa##j[8]; _Pragma("unroll") for (int k = 0; k < 8; ++k) oa##j[k] = (f32x2){0.f, 0.f};
#define PS2_STEP(j) { unsigned long long b0 = __ballot((el##j >> PSH_LOG) == s), b1 = __ballot((eh##j >> PSH_LOG) == s); \
    if (b0 | b1) { const u32x4 xa##j = *(const u32x4*)(xb16 + (size_t)row##j * D_MODEL + 16 * lane), xc##j = *(const u32x4*)(xb16 + (size_t)row##j * D_MODEL + 16 * lane + 8);     \
      const f32x2 x2[8] = {(f32x2){bflo(xa##j.x), bfhi(xa##j.x)}, (f32x2){bflo(xa##j.y), bfhi(xa##j.y)}, (f32x2){bflo(xa##j.z), bfhi(xa##j.z)}, (f32x2){bflo(xa##j.w), bfhi(xa##j.w)}, (f32x2){bflo(xc##j.x), bfhi(xc##j.x)}, (f32x2){bflo(xc##j.y), bfhi(xc##j.y)}, (f32x2){bflo(xc##j.z), bfhi(xc##j.z)}, (f32x2){bflo(xc##j.w), bfhi(xc##j.w)}}; \
      _Pragma("unroll 1") while ((b0 | b1) != 0ull) { int hk[8]; u32x4 uw[8], vw[8]; int nv = 0; \
        _Pragma("unroll") for (int k = 0; k < 8; ++k) { int h; if (b0) { h = __builtin_ctzll(b0); b0 &= b0 - 1; ++nv; } else if (b1) { h = 64 + __builtin_ctzll(b1); b1 &= b1 - 1; ++nv; } else h = hk[k > 0 ? k - 1 : 0]; \
            hk[k] = h; const int e = (h < 64) ? __builtin_amdgcn_readlane(el##j, h & 63) : __builtin_amdgcn_readlane(eh##j, h & 63); \
            uw[k] = *(const u32x4*)(U + (size_t)e * D_MODEL + 16 * lane); vw[k] = *(const u32x4*)(Vt + (size_t)e * D_MODEL + 16 * lane); } \
        float d[8]; _Pragma("unroll") for (int k = 0; k < 8; ++k) d[k] = dot16_fp8(uw[k], x2); \
        float e4[4], e2[2], e1s; \
          \
        { const bool hi = lane & 1; _Pragma("unroll") for (int i = 0; i < 4; ++i) { const float keep = hi ? d[4 + i] : d[i], send = hi ? d[i] : d[4 + i]; e4[i] = keep + dppf<0xB1>(send); } } \
        { const bool hi = lane & 2; _Pragma("unroll") for (int i = 0; i < 2; ++i) { const float keep = hi ? e4[2 + i] : e4[i], send = hi ? e4[i] : e4[2 + i]; e2[i] = keep + dppf<0x4E>(send); } } \
        { const bool hi = lane & 4; const float keep = hi ? e2[1] : e2[0], send = hi ? e2[0] : e2[1]; const float r4 = dppf<0x124>(send), r12 = dppf<0x12C>(send); e1s = keep + (hi ? r4 : r12); } \
        e1s += dppf<0x128>(e1s); e1s = colsum(e1s); \
        const int myk = 4 * (lane & 1) + (lane & 2) + ((lane >> 2) & 1); int myh = hk[0]; _Pragma("unroll") for (int k = 1; k < 8; ++k) myh = (myk == k) ? hk[k] : myh; \
        const float ga = __shfl(gl##j, myh & 63), gb = __shfl(gh##j, myh & 63); const float myg = (myk < nv) ? ((myh < 64) ? ga : gb) : 0.f;     \
        const float act = myg * gelu_tanh(e1s * (1.0f / PEER_SU)) * (1.0f / PEER_SV); \
        _Pragma("unroll") for (int k = 0; k < 8; ++k) { const int src = (k >> 2) | (((k >> 1) & 1) << 1) | ((k & 1) << 2); axpy16_fp8(vw[k], rdlane(act, src), oa##j); } } } }
#define PS2_LN(j) { const int r = row##j; f32x2 x2[8]; int ll = lane; asm volatile("" : "+v"(ll));     \
    _Pragma("unroll") for (int q = 0; q < 4; ++q) { const f32x4 a = *(const f32x4*)(xin + (size_t)r * D_MODEL + 16 * ll + 4 * q); x2[2 * q] = (f32x2){a.x, a.y}; x2[2 * q + 1] = (f32x2){a.z, a.w}; } \
    float sm = 0.f; _Pragma("unroll") for (int k = 0; k < 8; ++k) { oa##j[k] += x2[k] * ALPHA; sm += oa##j[k].x + oa##j[k].y; } \
    const float mu = wave_sum(sm) * (1.0f / D_MODEL); float s2 = 0.f; _Pragma("unroll") for (int k = 0; k < 8; ++k) { oa##j[k] -= mu; s2 += oa##j[k].x * oa##j[k].x + oa##j[k].y * oa##j[k].y; } \
    const float rs = 1.0f / sqrtf(wave_sum(s2) * (1.0f / D_MODEL) + LN_EPS); float* frow = fout + (size_t)r * D_MODEL; \
    _Pragma("unroll") for (int q = 0; q < 4; ++q) { const int c0 = 16 * ll + 4 * q; const f32x4 gv = *(const f32x4*)(gam + c0), bv = *(const f32x4*)(bet + c0); \
        const f32x4 y = (f32x4){oa##j[2 * q].x * rs, oa##j[2 * q].y * rs, oa##j[2 * q + 1].x * rs, oa##j[2 * q + 1].y * rs} * gv + bv; *(f32x4*)(frow + c0) = y; if (xb) *(u32x2*)(xb + (size_t)r * D_MODEL + c0) = pk4(y); } }
DI void xcd_soft_sync(unsigned* cnt, volatile LAS unsigned* st, unsigned x, unsigned& round) {
    if (!st) return;
    __syncthreads();
    if (threadIdx.x == 0) { const unsigned nloc = st[0];
        if (nloc) { unsigned* c = cnt + 64 * x; (void)xb_add(c, 1u); const unsigned target = (round + 1u) * nloc; unsigned sp = 0;
            while (xb_ld(c) < target && ++sp < 4096u) __builtin_amdgcn_s_sleep(1); } }
    __syncthreads(); ++round;
}
DI void peer_sharded2_phase(const FP& P, const Ctx& C, int layer, const float* xin, const bf16* xb16, float* fout, bf16* xb, volatile LAS unsigned* st = nullptr, unsigned xcc = 0) {
    unsigned round = 0; unsigned* hint = P.ctl + 8192 + layer * 1024;
    const int lane = C.lane; const unsigned char* U = P.UB8 + (size_t)layer * PEER_EXPERTS * D_MODEL; const unsigned char* Vt = P.VB8 + (size_t)layer * PEER_EXPERTS * D_MODEL;
    const float* gam = P.ln_g + ((size_t)layer * 2 + 1) * D_MODEL; const float* bet = P.ln_b + ((size_t)layer * 2 + 1) * D_MODEL;
    const int NW = C.G * NWAVES, gw = C.vcu * NWAVES + C.wave; const int nquads = (M0 / NW) / PS2_ROWS;
#pragma unroll 1
    for (int qd = 0; qd < nquads; ++qd) {
#if PS2_ROWS == 4
        PS2_ROW(0) PS2_ROW(1) PS2_ROW(2) PS2_ROW(3)
#pragma unroll 1
        for (int s = 0; s < PSH_N; ++s) {
#ifdef PEER_SOFTSYNC
            xcd_soft_sync(hint, st, xcc, round);
#endif
            PS2_STEP(0) PS2_STEP(1) PS2_STEP(2) PS2_STEP(3) }
        PS2_LN(0) PS2_LN(1) PS2_LN(2) PS2_LN(3)
#else
        PS2_ROW(0) PS2_ROW(1)
#pragma unroll 1
        for (int s = 0; s < PSH_N; ++s) { PS2_STEP(0) PS2_STEP(1) }
        PS2_LN(0) PS2_LN(1)
#endif
    }
}
#define PS3_ROW(j) const int row##j = (qd * 4 + j) * NW + gw; const int el##j = P.SELE[(size_t)row##j * 128 + lane], eh##j = P.SELE[(size_t)row##j * 128 + 64 + lane]; \
    { const u32x4 xa = *(const u32x4*)(xb16 + (size_t)row##j * D_MODEL + 16 * lane), xc = *(const u32x4*)(xb16 + (size_t)row##j * D_MODEL + 16 * lane + 8); *(LAS u32x4*)(xs + j * 1024 + 16 * lane) = xa; *(LAS u32x4*)(xs + j * 1024 + 16 * lane + 8) = xc; } \
    f32x2 oa##j[8]; _Pragma("unroll") for (int k = 0; k < 8; ++k) oa##j[k] = (f32x2){0.f, 0.f};
#define PS3_X2_UNUSED(j) const f32x2 x2[8] = {(f32x2){bflo(xa##j.x), bfhi(xa##j.x)}, (f32x2){bflo(xa##j.y), bfhi(xa##j.y)}, (f32x2){bflo(xa##j.z), bfhi(xa##j.z)}, (f32x2){bflo(xa##j.w), bfhi(xa##j.w)}, (f32x2){bflo(xc##j.x), bfhi(xc##j.x)}, (f32x2){bflo(xc##j.y), bfhi(xc##j.y)}, (f32x2){bflo(xc##j.z), bfhi(xc##j.z)}, (f32x2){bflo(xc##j.w), bfhi(xc##j.w)}};
#define PS3_TAKE(q, M, ELH, GOFF) if (!got && M) { const int h = __builtin_ctzll(M); M &= M - 1; qq[k] = q; ee = __builtin_amdgcn_readlane(ELH, h); gk[k] = P.SELG[GOFF + h];     got = true; ++nv; }
DI void peer_sharded3_phase(const FP& P, const Ctx& C, int layer, const float* xin, const bf16* xb16, float* fout, bf16* xb) {
    const int lane = C.lane; const unsigned char* U = P.UB8 + (size_t)layer * PEER_EXPERTS * D_MODEL; const unsigned char* Vt = P.VB8 + (size_t)layer * PEER_EXPERTS * D_MODEL;
    const float* gam = P.ln_g + ((size_t)layer * 2 + 1) * D_MODEL; const float* bet = P.ln_b + ((size_t)layer * 2 + 1) * D_MODEL;
    const int NW = C.G * NWAVES, gw = C.vcu * NWAVES + C.wave; const int nquads = (M0 / NW) / 4; LAS bf16* xs = (LAS bf16*)(C.lds + C.wave * 16384);
#pragma unroll 1
    for (int qd = 0; qd < nquads; ++qd) {
        PS3_ROW(0) PS3_ROW(1) PS3_ROW(2) PS3_ROW(3)
        asm volatile("s_waitcnt lgkmcnt(0)" ::: "memory");
#pragma unroll 1
        for (int s = 0; s < PSH_N; ++s) {
            unsigned long long m0 = __ballot((el0 >> PSH_LOG) == s), m1 = __ballot((eh0 >> PSH_LOG) == s), m2 = __ballot((el1 >> PSH_LOG) == s), m3 = __ballot((eh1 >> PSH_LOG) == s),
                               m4 = __ballot((el2 >> PSH_LOG) == s), m5 = __ballot((eh2 >> PSH_LOG) == s), m6 = __ballot((el3 >> PSH_LOG) == s), m7 = __ballot((eh3 >> PSH_LOG) == s);
#pragma unroll 1
            while ((m0 | m1 | m2 | m3 | m4 | m5 | m6 | m7) != 0ull) {
                int qq[8]; float gk[8]; int es[8]; u32x4 uw[8]; int nv = 0; int elast = 0;
#pragma unroll
                for (int k = 0; k < 8; ++k) { bool got = false; int ee = elast; qq[k] = k > 0 ? qq[k - 1] : 0; gk[k] = 0.f;
                    PS3_TAKE(0, m0, el0, (size_t)row0 * 128) PS3_TAKE(1, m1, eh0, (size_t)row0 * 128 + 64) PS3_TAKE(2, m2, el1, (size_t)row1 * 128) PS3_TAKE(3, m3, eh1, (size_t)row1 * 128 + 64) PS3_TAKE(4, m4, el2, (size_t)row2 * 128) PS3_TAKE(5, m5, eh2, (size_t)row2 * 128 + 64) PS3_TAKE(6, m6, el3, (size_t)row3 * 128) PS3_TAKE(7, m7, eh3, (size_t)row3 * 128 + 64)
                    elast = ee; es[k] = ee; uw[k] = *(const u32x4*)(U + (size_t)ee * D_MODEL + 16 * lane); }
                float d[8];
#pragma unroll
                for (int k = 0; k < 8; ++k) { const int j = qq[k] >> 1; const u32x4 xa = *(const LAS u32x4*)(xs + j * 1024 + 16 * lane), xc = *(const LAS u32x4*)(xs + j * 1024 + 16 * lane + 8);
                    const f32x2 x2[8] = {(f32x2){bflo(xa.x), bfhi(xa.x)}, (f32x2){bflo(xa.y), bfhi(xa.y)}, (f32x2){bflo(xa.z), bfhi(xa.z)}, (f32x2){bflo(xa.w), bfhi(xa.w)}, (f32x2){bflo(xc.x), bfhi(xc.x)}, (f32x2){bflo(xc.y), bfhi(xc.y)}, (f32x2){bflo(xc.z), bfhi(xc.z)}, (f32x2){bflo(xc.w), bfhi(xc.w)}};
                    d[k] = dot16_fp8(uw[k], x2); }
                u32x4 vw[8];
#pragma unroll
                for (int k = 0; k < 8; ++k) vw[k] = *(const u32x4*)(Vt + (size_t)es[k] * D_MODEL + 16 * lane);
                float e4[4], e2[2], e1s;
                { const bool hi = lane & 1;
#pragma unroll
                  for (int i = 0; i < 4; ++i) { const float keep = hi ? d[4 + i] : d[i], send = hi ? d[i] : d[4 + i]; e4[i] = keep + __shfl_xor(send, 1); } }
                { const bool hi = lane & 2;
#pragma unroll
                  for (int i = 0; i < 2; ++i) { const float keep = hi ? e4[2 + i] : e4[i], send = hi ? e4[i] : e4[2 + i]; e2[i] = keep + __shfl_xor(send, 2); } }
                { const bool hi = lane & 4; const float keep = hi ? e2[1] : e2[0], send = hi ? e2[0] : e2[1]; e1s = keep + __shfl_xor(send, 4); }
                e1s += __shfl_xor(e1s, 8); e1s += __shfl_xor(e1s, 16); e1s += __shfl_xor(e1s, 32);
                const int myk = 4 * (lane & 1) + (lane & 2) + ((lane >> 2) & 1); float myg = gk[0];
#pragma unroll
                for (int k = 1; k < 8; ++k) myg = (myk == k) ? gk[k] : myg;
                const float act = myg * gelu_tanh(e1s * (1.0f / PEER_SU)) * (1.0f / PEER_SV);
#pragma unroll
                for (int k = 0; k < 8; ++k) { const int src = (k >> 2) | (((k >> 1) & 1) << 1) | ((k & 1) << 2); const float a = rdlane(act, src); const int j = qq[k] >> 1;
                    if (j == 0) { asm volatile("" ::: "memory"); axpy16_fp8(vw[k], a, oa0); } else if (j == 1) { asm volatile("" ::: "memory"); axpy16_fp8(vw[k], a, oa1); } else if (j == 2) { asm volatile("" ::: "memory"); axpy16_fp8(vw[k], a, oa2); } else { asm volatile("" ::: "memory"); axpy16_fp8(vw[k], a, oa3); } }
            }
        }
        PS2_LN(0) PS2_LN(1) PS2_LN(2) PS2_LN(3)
    }
}
}
namespace fx {
struct EpiB {
    static constexpr bool PERM = true, AFTER_DRAIN = false; const FP& P;
    DI void operator()(const f32x4 (&acc)[2][2][4][2], const pg8::Unit& u, int wr, int wc, int fr, int fq) const {
        const int t = u.pn;
        EPI_LOOP({ if (row < MP) { const int pos = row_pos(row), n = row / SEQ, e = ct & 63, dp = e >> 1; const bool prm = row < M0;
            if (t < 3) { const int ty = 2 * t + (ct >> 7), kvh = (ct >> 6) & 1;
                if (ty == 2 || ty == 4) { f32x4 lo, hi; rope4(P.ROPE + pos * 64, dp, v0, v1, lo, hi);
                    if (ty == 2) { float* o = (prm ? P.nsa_kv_p + (size_t)row * 512 : P.nsa_kv_s + (size_t)(row - M0) * 512) + 256 + kvh * 64 + dp; *(f32x4*)o = lo; *(f32x4*)(o + 32) = hi;
                        if (prm) { bf16* kt = P.SLK + ((size_t)n * NSA_KV_HEADS + kvh) * SEQ * 64; *(u32x2*)(kt + ktile_off(pos, dp)) = pk4(lo); *(u32x2*)(kt + ktile_off(pos, dp + 32)) = pk4(hi); } }
                    else { float* o = nullptr; if (!prm) o = P.win_s + (((size_t)(row - M0) * SWA_WINDOW + SWA_WINDOW - 1) * 2 + 0) * 128; else if (pos >= SEQ - SWA_WINDOW) o = P.win_p + (((size_t)n * SWA_WINDOW + pos - (SEQ - SWA_WINDOW)) * 2 + 0) * 128;
                        if (o) { *(f32x4*)(o + kvh * 64 + dp) = lo; *(f32x4*)(o + kvh * 64 + 32 + dp) = hi; }
                        if (prm) { bf16* kt = P.WNK + ((size_t)n * NSA_KV_HEADS + kvh) * SEQ * 64; *(u32x2*)(kt + ktile_off(pos, dp)) = pk4(lo); *(u32x2*)(kt + ktile_off(pos, dp + 32)) = pk4(hi); } } }
                else if (ty < 4) { float* o = (prm ? P.nsa_kv_p + (size_t)row * 512 : P.nsa_kv_s + (size_t)(row - M0) * 512) + ty * 128 + kvh * 64 + e; *(f32x4*)o = v0; *(f32x4*)(o + 4) = v1;
                    if (prm) { if (ty < 2) *(u32x4*)(P.AC + ((size_t)ty * ACROWS + ((size_t)n * NSA_KV_HEADS + kvh) * NCH + pos / 16) * 1024 + (pos % 16) * 64 + e) = pk8(v0, v1);
                        else { bf16* vt = P.SLVT + ((size_t)n * NSA_KV_HEADS + kvh) * SEQ * 64 + vtile_off(e, pos);
                            vt[0] = (bf16)f2bf(v0.x); vt[8] = (bf16)f2bf(v0.y); vt[16] = (bf16)f2bf(v0.z); vt[24] = (bf16)f2bf(v0.w); vt[32] = (bf16)f2bf(v1.x); vt[40] = (bf16)f2bf(v1.y); vt[48] = (bf16)f2bf(v1.z); vt[56] = (bf16)f2bf(v1.w); } } }
                else { float* o = nullptr; if (!prm) o = P.win_s + (((size_t)(row - M0) * SWA_WINDOW + SWA_WINDOW - 1) * 2 + 1) * 128; else if (pos >= SEQ - SWA_WINDOW) o = P.win_p + (((size_t)n * SWA_WINDOW + pos - (SEQ - SWA_WINDOW)) * 2 + 1) * 128;
                    if (o) { *(f32x4*)(o + kvh * 64 + e) = v0; *(f32x4*)(o + kvh * 64 + e + 4) = v1; }
                    if (prm) { bf16* vt = P.WNVT + ((size_t)n * NSA_KV_HEADS + kvh) * SEQ * 64 + vtile_off(e, pos);
                        vt[0] = (bf16)f2bf(v0.x); vt[8] = (bf16)f2bf(v0.y); vt[16] = (bf16)f2bf(v0.z); vt[24] = (bf16)f2bf(v0.w); vt[32] = (bf16)f2bf(v1.x); vt[40] = (bf16)f2bf(v1.y); vt[48] = (bf16)f2bf(v1.z); vt[56] = (bf16)f2bf(v1.w); } } }
            else if (t < 6) { const int h = (t - 3) * 4 + (ct >> 6); f32x4 lo, hi; rope4(P.ROPE + pos * 64, dp, v0, v1, lo, hi); bf16* q = P.QB + (size_t)row * NSA_Q_COLS + h * 64 + dp; *(u32x2*)q = pk4(lo * QSCALE); *(u32x2*)(q + 32) = pk4(hi * QSCALE); }
            else if (t == 6) { *(u32x4*)(P.MQB + (size_t)row * 256 + ct) = pk8(v0 * QSCALE, v1 * QSCALE); }
            else if (ct < 40) { const float vv[8] = {v0.x, v0.y, v0.z, v0.w, v1.x, v1.y, v1.z, v1.w};
                _Pragma("unroll") for (int i = 0; i < 8; ++i) if (ct + i < NSA_GATE_COLS) P.GATES[(size_t)row * 64 + ct + i] = 1.0f / (1.0f + __expf(-vv[i])); } } })
    }
};
DI void cmp2_phase(const FP& P, const Ctx& C) {
    const int lane = C.lane; LAS float* hs = (LAS float*)(C.lds + C.wave * 1024);
    constexpr int NGRP = NCTX * 2 * NSA_KV_HEADS; const int NW = C.G * NWAVES, WPG = NW / NGRP > 0 ? NW / NGRP : 1; const int gw = C.vcu * NWAVES + C.wave;
#pragma unroll 1
    for (int grp = gw / WPG; grp < NGRP; grp += (NW + WPG - 1) / WPG) { const int slot = gw % WPG; if (gw >= (NW / WPG) * WPG && grp == gw / WPG) break;
        const int kvh = grp % NSA_KV_HEADS, ty = (grp / NSA_KV_HEADS) % 2, ctx = grp / (2 * NSA_KV_HEADS);
        const float* UL = P.UL + ((size_t)ty * ACROWS + ((size_t)ctx * NSA_KV_HEADS + kvh) * NCH) * 256; const float* w2 = P.cmp_w2 + (size_t)ty * CMP_HIDDEN * HEAD_DIM;
        float w2r[CMP_HIDDEN];
#pragma unroll
        for (int k = 0; k < CMP_HIDDEN; ++k) w2r[k] = w2[k * HEAD_DIM + lane];
        const float b0 = P.CBIAS[ty * CMP_HIDDEN + lane], b1 = P.CBIAS[ty * CMP_HIDDEN + 64 + lane];
        float u0, u1, l0, l1; int c = slot;
        if (c < NCMP) { u0 = UL[(size_t)c * 256 + lane]; u1 = UL[(size_t)c * 256 + 64 + lane]; l0 = UL[(size_t)(c + 1) * 256 + 128 + lane]; l1 = UL[(size_t)(c + 1) * 256 + 192 + lane]; }
#pragma unroll 1
        for (; c < NCMP; c += WPG) { const float h0 = gelu_tanh(u0 + l0 + b0), h1 = gelu_tanh(u1 + l1 + b1); const int cn = c + WPG;
            if (cn < NCMP) { u0 = UL[(size_t)cn * 256 + lane]; u1 = UL[(size_t)cn * 256 + 64 + lane]; l0 = UL[(size_t)(cn + 1) * 256 + 128 + lane]; l1 = UL[(size_t)(cn + 1) * 256 + 192 + lane]; }
            hs[lane] = h0; hs[64 + lane] = h1; asm volatile("s_waitcnt lgkmcnt(0)" ::: "memory");
            float a = 0.f;
#pragma unroll
            for (int k4 = 0; k4 < CMP_HIDDEN / 4; ++k4) { const f32x4 hv = *(const LAS f32x4*)(hs + 4 * k4); a += hv.x * w2r[4 * k4] + hv.y * w2r[4 * k4 + 1] + hv.z * w2r[4 * k4 + 2] + hv.w * w2r[4 * k4 + 3]; }
            if (ty == 0) { const float other = __shfl_xor(a, 32); const int pos = c * CMP_STRIDE + CMP_BLOCK - 1; const float cs = P.ROPE[pos * 64 + (lane & 31)], sn = P.ROPE[pos * 64 + 32 + (lane & 31)];
                a = (lane < 32) ? a * cs - other * sn : a * cs + other * sn; }
            if (ctx < BATCH) { if (ty == 0) P.CK[((size_t)ctx * NSA_KV_HEADS + kvh) * NCH * 64 + ktile_off(c, lane)] = (bf16)f2bf(a); else P.CVT[((size_t)ctx * NSA_KV_HEADS + kvh) * NCH * 64 + vtile_off(lane, c)] = (bf16)f2bf(a); }
            else { (ty == 0 ? P.CKF : P.CVF)[(((size_t)(ctx - BATCH) * NSA_KV_HEADS + kvh) * NCH + c) * 64 + lane] = a; }
            asm volatile("s_waitcnt lgkmcnt(0)" ::: "memory"); }
    }
    __syncthreads();
}
constexpr int NSA_WLDS = 8192;
DI void nsa_pair_a(const FP& P, int n, int kvh, int t, int lane, LAS unsigned char* wl) {
    LAS float* pn = (LAS float*)wl; LAS float* imp = (LAS float*)(wl + 2048); LAS float* sc = (LAS float*)(wl + 6144); LAS int* sel = (LAS int*)(wl + 7168);
    const int col = lane & 15, c = lane >> 4; const bool vcol = col < 12; const int qq = vcol ? col / 6 : 0, hh = vcol ? col % 6 : 0, tq = t + qq, head = kvh * NSA_GROUP + hh, row = n * SEQ + tq;
    bf16x8 qf[2]; { const bf16* qp = P.QB + (size_t)row * NSA_Q_COLS + head * 64 + 8 * c; qf[0] = *(const bf16x8*)qp; qf[1] = *(const bf16x8*)(qp + 32); }
    const float* gt = P.GATES + (size_t)row * 64 + head * 3;
    f32x4 oacc[4] = {(f32x4){0.f, 0.f, 0.f, 0.f}, (f32x4){0.f, 0.f, 0.f, 0.f}, (f32x4){0.f, 0.f, 0.f, 0.f}, (f32x4){0.f, 0.f, 0.f, 0.f}};
    const int lim = vcol ? ((tq >= CMP_BLOCK - 1) ? (tq - (CMP_BLOCK - 1)) / CMP_STRIDE : -1) : -1;
    const int limmax = (t + 1 >= CMP_BLOCK - 1) ? (t + 1 - (CMP_BLOCK - 1)) / CMP_STRIDE : -1; const int nblk = (limmax + 32) / 32;
    const bf16* CKb = P.CK + ((size_t)n * NSA_KV_HEADS + kvh) * NCH * 64; const bf16* CVb = P.CVT + ((size_t)n * NSA_KV_HEADS + kvh) * 64 * NCH;
    for (int i = lane; i < 1024; i += 64) imp[i] = 0.f;
    float m1 = -INFINITY, l1 = 0.f;
    { struct K4 { bf16x8 a0, a1, b0, b1; };
      auto ldk = [&](K4& k, int blk) { const bf16* kt = CKb + (size_t)blk * 2048 + lane * 8; k.a0 = *(const bf16x8*)kt; k.a1 = *(const bf16x8*)(kt + 512); k.b0 = *(const bf16x8*)(kt + 1024); k.b1 = *(const bf16x8*)(kt + 1536); };
      auto cp1 = [&](const K4& k, int blk) { const int kb = 32 * blk;
        f32x4 s0 = (f32x4){0.f, 0.f, 0.f, 0.f}, s1 = (f32x4){0.f, 0.f, 0.f, 0.f};
        s0 = __builtin_amdgcn_mfma_f32_16x16x32_bf16(k.a0, qf[0], s0, 0, 0, 0); s0 = __builtin_amdgcn_mfma_f32_16x16x32_bf16(k.a1, qf[1], s0, 0, 0, 0);
        s1 = __builtin_amdgcn_mfma_f32_16x16x32_bf16(k.b0, qf[0], s1, 0, 0, 0); s1 = __builtin_amdgcn_mfma_f32_16x16x32_bf16(k.b1, qf[1], s1, 0, 0, 0);
        float s[8] = {s0.x, s0.y, s0.z, s0.w, s1.x, s1.y, s1.z, s1.w}; float mx = -INFINITY;
        const int hi1 = lim - (kb + 8 * c);
#pragma unroll
        for (int e = 0; e < 8; ++e) { s[e] = (e <= hi1) ? s[e] : -INFINITY; mx = fmaxf(mx, s[e]); }
        mx = colmax(mx);
        const float mnew = fmaxf(m1, mx), muse = (mnew == -INFINITY) ? 0.f : mnew; float ls = 0.f;
#pragma unroll
        for (int e = 0; e < 8; ++e) ls += __builtin_amdgcn_exp2f(s[e] - muse);
        l1 = l1 * __builtin_amdgcn_exp2f(m1 - muse) + ls; m1 = mnew; };
      if (nblk > 0) { K4 A, B; ldk(A, 0);
#pragma unroll 1
        for (int blk = 0; blk < nblk; blk += 2) { ldk(B, (blk + 1 < nblk) ? blk + 1 : blk); cp1(A, blk); ldk(A, (blk + 2 < nblk) ? blk + 2 : blk); if (blk + 1 < nblk) cp1(B, blk + 1); } } }
    asm volatile("s_waitcnt lgkmcnt(0)" ::: "memory");
    { l1 = colsum(l1); const float muse = (m1 == -INFINITY) ? 0.f : m1, inv = (l1 > 0.f) ? 1.0f / l1 : 0.f;
      f32x4 oc[4] = {(f32x4){0.f, 0.f, 0.f, 0.f}, (f32x4){0.f, 0.f, 0.f, 0.f}, (f32x4){0.f, 0.f, 0.f, 0.f}, (f32x4){0.f, 0.f, 0.f, 0.f}};
      pipe2(nblk, [&](KV8& kv, int blk) { kv_load_t(kv, CKb + (size_t)blk * 2048, CVb + (size_t)blk * 2048, lane); }, [&](const KV8& kv, int blk) { const int kb = 32 * blk;
        f32x4 s0 = (f32x4){0.f, 0.f, 0.f, 0.f}, s1 = (f32x4){0.f, 0.f, 0.f, 0.f};
        s0 = __builtin_amdgcn_mfma_f32_16x16x32_bf16(kv.ka0, qf[0], s0, 0, 0, 0); s0 = __builtin_amdgcn_mfma_f32_16x16x32_bf16(kv.ka1, qf[1], s0, 0, 0, 0);
        s1 = __builtin_amdgcn_mfma_f32_16x16x32_bf16(kv.kb0, qf[0], s1, 0, 0, 0); s1 = __builtin_amdgcn_mfma_f32_16x16x32_bf16(kv.kb1, qf[1], s1, 0, 0, 0);
        float s[8] = {s0.x, s0.y, s0.z, s0.w, s1.x, s1.y, s1.z, s1.w};
        const int hi2 = lim - (kb + 8 * c);
#pragma unroll
        for (int e = 0; e < 8; ++e) s[e] = (e <= hi2) ? __builtin_amdgcn_exp2f(s[e] - muse) * inv : 0.f;
        *(f32x4*)(pn + col * 32 + 8 * c) = (f32x4){s[0], s[1], s[2], s[3]}; *(f32x4*)(pn + col * 32 + 8 * c + 4) = (f32x4){s[4], s[5], s[6], s[7]};
        u32x4 pw; pw.x = cvtpk(s[0], s[1]); pw.y = cvtpk(s[2], s[3]); pw.z = cvtpk(s[4], s[5]); pw.w = cvtpk(s[6], s[7]); const bf16x8 pf = __builtin_bit_cast(bf16x8, pw);
        oc[0] = __builtin_amdgcn_mfma_f32_16x16x32_bf16(kv.v0, pf, oc[0], 0, 0, 0); oc[1] = __builtin_amdgcn_mfma_f32_16x16x32_bf16(kv.v1, pf, oc[1], 0, 0, 0);
        oc[2] = __builtin_amdgcn_mfma_f32_16x16x32_bf16(kv.v2, pf, oc[2], 0, 0, 0); oc[3] = __builtin_amdgcn_mfma_f32_16x16x32_bf16(kv.v3, pf, oc[3], 0, 0, 0);
        asm volatile("s_waitcnt lgkmcnt(0)" ::: "memory");
        { const int q2 = lane >> 5, k = lane & 31; float a = 0.f;
#pragma unroll
          for (int h6 = 0; h6 < 6; ++h6) a += pn[(q2 * 6 + h6) * 32 + k];
          imp[q2 * 512 + kb + k] = a; }
        asm volatile("s_waitcnt lgkmcnt(0)" ::: "memory"); });
#ifdef NSA_DEBUG
      if (vcol) { for (int db = 0; db < 4; ++db) *(f32x4*)(P.DBG + ((size_t)0 * MP + row) * 768 + head * 64 + 16 * db + 4 * c) = oc[db]; }
#endif
      const float g0 = vcol ? gt[0] : 0.f;
#pragma unroll
      for (int db = 0; db < 4; ++db) oacc[db] += oc[db] * g0; }
#ifndef REP_SEL
#define REP_SEL 1
#endif
#pragma unroll 1
    for (int rep = 0; rep < REP_SEL; ++rep) {
    for (int i = lane; i < 256; i += 64) { const int q2 = i >> 7, b = i & 127, tq2 = t + q2, cur = tq2 / SLC_BLOCK; float sv;
        if (b > cur) sv = NEG; else if (b == 0 || b == cur || b == cur - 1) sv = FORCE_SCORE;
        else { const LAS float* ic = imp + q2 * 512 + 4 * b; sv = ic[-1] + 2.f * (ic[0] + ic[1] + ic[2]) + ic[3]; }
        sc[i] = pack_key(sv, 127u - (unsigned)b, 127u); }
    asm volatile("s_waitcnt lgkmcnt(0)" ::: "memory");
    for (int i = lane; i < 256; i += 64) { const int q2 = i >> 7, b = i & 127; const float sv = sc[i]; int rank = 0;
        for (int j = 0; j < 128; j += 4) { const f32x4 o = *(const LAS f32x4*)(sc + q2 * 128 + j);
            rank += (o.x > sv) ? 1 : 0; rank += (o.y > sv) ? 1 : 0; rank += (o.z > sv) ? 1 : 0; rank += (o.w > sv) ? 1 : 0; }
        if (rank < SLC_TOPK) { const int v = (sv > 0.5f * NEG) ? b : -1; sel[q2 * 16 + rank] = v; P.SELB[((size_t)(n * SEQ + t + q2) * NSA_KV_HEADS + kvh) * 16 + rank] = v; } }
    asm volatile("s_waitcnt lgkmcnt(0)" ::: "memory");
    }
#ifndef REP_WIN
#define REP_WIN 1
#endif
#pragma unroll 1
    for (int rep = 0; rep < REP_WIN; ++rep) { Tile16 T; tile_init(T);
      const bf16* WKb = P.WNK + ((size_t)n * NSA_KV_HEADS + kvh) * SEQ * 64; const bf16* WVb = P.WNVT + ((size_t)n * NSA_KV_HEADS + kvh) * 64 * SEQ;
      const int blo = (t - SWA_WINDOW) >> 5, bhi = (t + 1) >> 5;
      auto ld = [&](KV8& kv, int blk) { const int bc = blk < 0 ? 0 : blk; kv_load_t(kv, WKb + (size_t)bc * 2048, WVb + (size_t)bc * 2048, lane); };
      pipe2(bhi - blo + 1, [&](KV8& kv, int i) { ld(kv, blo + i); }, [&](const KV8& kv, int i) { const int kb = 32 * (blo + i);
          const int k0 = kb + 8 * c; int lo; unsigned rng; const int a = tq - SWA_WINDOW; mk_range((a > 0 ? a : 0) - k0, tq - k0, vcol, lo, rng); tile_compute(T, qf, kv, lo, rng); });
      T.l = colsum(T.l);
      const float inv = (T.l > 0.f) ? 1.0f / T.l : 0.f, g2 = vcol ? gt[2] * inv : 0.f;
#ifdef NSA_DEBUG
      if (vcol) { for (int db = 0; db < 4; ++db) *(f32x4*)(P.DBG + ((size_t)2 * MP + row) * 768 + head * 64 + 16 * db + 4 * c) = T.o[db] * inv; }
#endif
#pragma unroll
      for (int db = 0; db < 4; ++db) if (rep == REP_WIN - 1) oacc[db] += T.o[db] * g2; }
    if (vcol) { float* op = P.DPART + (size_t)row * 768 + head * 64 + 4 * c;
#pragma unroll
        for (int db = 0; db < 4; ++db) *(f32x4*)(op + 16 * db) = oacc[db]; }
}
DI void nsa_pair_b(const FP& P, int n, int kvh, int t, int lane, LAS unsigned char* wl) {
    LAS int* steps = (LAS int*)wl;
    const int col = lane & 15, c = lane >> 4; const bool vcol = col < 12; const int qq = vcol ? col / 6 : 0, hh = vcol ? col % 6 : 0, tq = t + qq, head = kvh * NSA_GROUP + hh, row = n * SEQ + tq;
    bf16x8 qf[2]; { const bf16* qp = P.QB + (size_t)row * NSA_Q_COLS + head * 64 + 8 * c; qf[0] = *(const bf16x8*)qp; qf[1] = *(const bf16x8*)(qp + 32); }
    const float* gt = P.GATES + (size_t)row * 64 + head * 3;
    Tile16 T; tile_init(T);
    const bf16* SKb = P.SLK + ((size_t)n * NSA_KV_HEADS + kvh) * SEQ * 64; const bf16* SVb = P.SLVT + ((size_t)n * NSA_KV_HEADS + kvh) * SEQ * 64;
    int ns = 0;
    { const int mysel = (lane < 32) ? P.SELB[((size_t)(n * SEQ + t + (lane >> 4)) * NSA_KV_HEADS + kvh) * 16 + (lane & 15)] : -1;
      for (int i = 0; i < 32; ++i) { const int b = __builtin_amdgcn_readlane(mysel, i); if (b < 0) continue; int q2 = i >> 4;
          const unsigned long long other = __ballot(mysel == b && lane < 32 && (lane >> 4) != q2);
          if (other) { if (q2 == 1) continue; q2 = 2; }
          if (lane == 0) { steps[ns] = (b * SLC_BLOCK) | (q2 << 29); steps[ns + 1] = (b * SLC_BLOCK + 32) | (q2 << 29); } ns += 2; } }
    asm volatile("s_waitcnt lgkmcnt(0)" ::: "memory");
    auto ld = [&](KV8& kv, int i) { const int code = __builtin_amdgcn_readfirstlane(steps[i]); const int kb = code & 0x1fffffff;
        kv_load_t(kv, SKb + (size_t)(kb >> 5) * 2048, SVb + (size_t)(kb >> 5) * 2048, lane); };
#ifdef PROBE_DBLCOMP
    Tile16 T2; tile_init(T2);
#endif
    pipe2(ns, ld, [&](const KV8& kv, int i) { const int code = __builtin_amdgcn_readfirstlane(steps[i]); const int kb = code & 0x1fffffff, q2 = code >> 29;
        int lo; unsigned rng; mk_range(-64, tq - (kb + 8 * c), vcol && (q2 == 2 || qq == q2), lo, rng); tile_compute(T, qf, kv, lo, rng);
#ifdef PROBE_DBLCOMP
        tile_compute(T2, qf, kv, [&](int e) { return vcol && qq == q2 && (kb + 8 * c + e + 1) <= tq; });
#endif
    });
#ifdef PROBE_DBLCOMP
    if (T2.l < 0.f) T.l = 0.f;
#endif
    T.l = colsum(T.l);
    const float inv = (T.l > 0.f) ? 1.0f / T.l : 0.f, g1 = vcol ? gt[1] * inv : 0.f;
#ifdef NSA_DEBUG
    if (vcol) { for (int db = 0; db < 4; ++db) *(f32x4*)(P.DBG + ((size_t)1 * MP + row) * 768 + head * 64 + 16 * db + 4 * c) = T.o[db] * inv; }
#endif
    if (vcol) { const float* pp = P.DPART + (size_t)row * 768 + head * 64 + 4 * c; bf16* op = P.ATTB + (size_t)row * 1024 + head * 64 + 4 * c;
#pragma unroll
        for (int db = 0; db < 4; ++db) *(u32x2*)(op + 16 * db) = pk4(*(const f32x4*)(pp + 16 * db) + T.o[db] * g1); }
}

constexpr int SMP_SK = 1088;
template <class KF, class VF> DI void smp_branch(const Ctx& C, LAS float* qs, LAS float* S, LAS float* red, int NK, KF kf, VF vf, bool keep_probs, float (&outh)[1]) {
    const int tid = C.tid, lane = C.lane, w = C.wave;
#pragma unroll 1
    for (int j = tid; j < NK; j += NTHREADS) { const float* k = kf(j); f32x4 kr[16];
#pragma unroll
        for (int d4 = 0; d4 < 16; ++d4) kr[d4] = *(const f32x4*)(k + 4 * d4);
#pragma unroll 1
        for (int h = 0; h < 6; ++h) { float a = 0.f;
#pragma unroll
            for (int d4 = 0; d4 < 16; ++d4) { const f32x4 qv = *(const LAS f32x4*)(qs + h * 64 + 4 * d4); a += kr[d4].x * qv.x + kr[d4].y * qv.y + kr[d4].z * qv.z + kr[d4].w * qv.w; }
            S[h * SMP_SK + j] = a; } }
    asm volatile("s_waitcnt lgkmcnt(0)" ::: "memory"); __syncthreads();
    if (w < 6) { float m = -INFINITY; for (int j = lane; j < NK; j += 64) m = fmaxf(m, S[w * SMP_SK + j]); m = wave_max(m);
        float l = 0.f; for (int j = lane; j < NK; j += 64) { const float p = __builtin_amdgcn_exp2f(S[w * SMP_SK + j] - m); S[w * SMP_SK + j] = p; l += p; } l = wave_sum(l);
        const float inv = 1.0f / l; for (int j = lane; j < NK; j += 64) S[w * SMP_SK + j] *= inv; }
    asm volatile("s_waitcnt lgkmcnt(0)" ::: "memory"); __syncthreads();
    { const int per = (NK + NWAVES - 1) / NWAVES, j0 = w * per, j1 = (j0 + per < NK) ? j0 + per : NK; float o[6] = {0.f, 0.f, 0.f, 0.f, 0.f, 0.f};
#pragma unroll 1
      for (int j = j0; j < j1; j += 8) { float vv[8];
#pragma unroll
          for (int u = 0; u < 8; ++u) { const int jj = (j + u < j1) ? j + u : j1 - 1; vv[u] = vf(jj)[lane]; }
#pragma unroll
          for (int u = 0; u < 8; ++u) if (j + u < j1) {
#pragma unroll
              for (int h = 0; h < 6; ++h) o[h] += S[h * SMP_SK + j + u] * vv[u]; } }
#pragma unroll
      for (int h = 0; h < 6; ++h) red[(w * 6 + h) * 64 + lane] = o[h]; }
    asm volatile("s_waitcnt lgkmcnt(0)" ::: "memory"); __syncthreads();
    outh[0] = 0.f;
    if (tid < 384) { float a = 0.f;
#pragma unroll
        for (int ww = 0; ww < NWAVES; ++ww) a += red[ww * 384 + tid]; outh[0] = a; }
    if (!keep_probs) { __syncthreads(); }
}
DI void nsa_sample_item(const FP& P, const Ctx& C, int ns, int kvh) {
    LAS float* qs = (LAS float*)C.lds; LAS float* S = qs + 384; LAS float* red = S + 6 * SMP_SK; LAS float* scs = red + 8 * 384; LAS int* sel = (LAS int*)(scs + 136);
    const int tid = C.tid, row = M0 + ns;
    if (tid < 384) qs[tid] = bf2f(P.QB[(size_t)row * NSA_Q_COLS + kvh * 384 + tid]);
    asm volatile("s_waitcnt lgkmcnt(0)" ::: "memory"); __syncthreads();
    const float* ckf = P.CKF + ((size_t)ns * NSA_KV_HEADS + kvh) * NCH * 64; const float* cvf = P.CVF + ((size_t)ns * NSA_KV_HEADS + kvh) * NCH * 64;
    float oc[1], os[1], ow[1];
    smp_branch(C, qs, S, red, NCMP, [&](int j) { return ckf + (size_t)j * 64; }, [&](int j) { return cvf + (size_t)j * 64; }, true, oc);
    constexpr int NBS = (PAST_LEN + 1 + SLC_BLOCK - 1) / SLC_BLOCK, CURS = PAST_LEN / SLC_BLOCK;
    for (int b = tid; b < 136; b += NTHREADS) { float sv = -3.0e38f;
        if (b < NBS) { if (b == 0 || b == CURS || b == CURS - 1) sv = FORCE_SCORE; else { float a = 0.f;
#pragma unroll
                for (int o = -1; o <= 3; ++o) { const int ci = 4 * b + o; if (ci >= 0 && ci < NCMP) { float sm = 0.f; for (int h6 = 0; h6 < 6; ++h6) sm += S[h6 * SMP_SK + ci]; a += ((o >= 0 && o <= 2) ? 2.f : 1.f) * sm; } }
                sv = a; } }
        scs[b] = sv; }
    asm volatile("s_waitcnt lgkmcnt(0)" ::: "memory"); __syncthreads();
    for (int b = tid; b < NBS; b += NTHREADS) { const float sv = scs[b]; int rank = 0; for (int j = 0; j < NBS; ++j) { const float o = scs[j]; rank += (o > sv || (o == sv && j < b)) ? 1 : 0; }
        if (rank < SLC_TOPK) { sel[rank] = b; P.SELB[((size_t)row * NSA_KV_HEADS + kvh) * 16 + rank] = b; } }
    asm volatile("s_waitcnt lgkmcnt(0)" ::: "memory"); __syncthreads();
    { const float* newrow = P.nsa_kv_s + (size_t)ns * 512; const int* pt = P.page_table + ns * (PAST_LEN / PAGE_SIZE);
      if (tid == 0) { int seen = 0; for (int x = 0; x < SLC_TOPK; ++x) { const int bx = sel[x]; if (bx != CURS && seen < 15) sel[16 + seen++] = bx; } }
      asm volatile("s_waitcnt lgkmcnt(0)" ::: "memory"); __syncthreads();
      auto krow = [&](int j, int ty) -> const float* { if (j >= 15 * 64) return newrow + ty * 128 + kvh * 64;
          const int t0 = sel[16 + (j >> 6)] * SLC_BLOCK + (j & 63); const int pg = pt[t0 / PAGE_SIZE]; return P.cache_nsa_kv + ((size_t)pg * PAGE_SIZE + t0 % PAGE_SIZE) * 512 + ty * 128 + kvh * 64; };
      smp_branch(C, qs, S, red, 15 * 64 + 1, [&](int j) { return krow(j, 2); }, [&](int j) { return krow(j, 3); }, false, os); }
    { const float* wc = P.cache_nsa_win + (size_t)ns * SWA_WINDOW * 256; const float* newrow = P.win_s + ((size_t)ns * SWA_WINDOW + SWA_WINDOW - 1) * 256;
      smp_branch(C, qs, S, red, SWA_WINDOW + 1, [&](int j) { return (j < SWA_WINDOW ? wc + (size_t)j * 256 : newrow) + kvh * 64; }, [&](int j) { return (j < SWA_WINDOW ? wc + (size_t)j * 256 : newrow) + 128 + kvh * 64; }, false, ow); }
    if (tid < 384) { const int head = kvh * NSA_GROUP + tid / 64; const float* gt = P.GATES + (size_t)row * 64 + head * 3;
        P.ATTB[(size_t)row * 1024 + kvh * 384 + tid] = (bf16)f2bf(gt[0] * oc[0] + gt[1] * os[0] + gt[2] * ow[0]);
#ifdef NSA_DEBUG
        P.DBG[((size_t)0 * MP + row) * 768 + kvh * 384 + tid] = oc[0]; P.DBG[((size_t)1 * MP + row) * 768 + kvh * 384 + tid] = os[0]; P.DBG[((size_t)2 * MP + row) * 768 + kvh * 384 + tid] = ow[0];
#endif
    }
    __syncthreads();
}
DI void nsa_pairs(const FP& P, const Ctx& C, bool second) {
    LAS unsigned char* wl = C.lds + C.wave * NSA_WLDS;
    const int per = C.G / 4 > 0 ? C.G / 4 : 1, grp = (C.vcu / per) & 3, sub = C.vcu % per, n = grp >> 1, kvh = grp & 1;
#pragma unroll 1
    for (int pr = sub * NWAVES + C.wave; pr < SEQ / 2; pr += per * NWAVES) { if (second) nsa_pair_b(P, n, kvh, 2 * pr, C.lane, wl); else nsa_pair_a(P, n, kvh, 2 * pr, C.lane, wl); }
}
DI void nsa_phase_a(const FP& P, const Ctx& C) {
    for (int it = C.vcu; it < DEC_BATCH * NSA_KV_HEADS; it += C.G) nsa_sample_item(P, C, it / NSA_KV_HEADS, it % NSA_KV_HEADS);
    nsa_pairs(P, C, false);
    __syncthreads();
}
DI void nsa_phase_b(const FP& P, const Ctx& C) {
    const int lane = C.lane, w = C.wave;
    nsa_pairs(P, C, true);
    __syncthreads();
    { constexpr int NMT = (M0 / 16) * MEM_HEADS;
      for (int it = C.vcu * NWAVES + w; it < NMT; it += C.G * NWAVES) { const int h = it % MEM_HEADS, q16 = it / MEM_HEADS, row0 = q16 * 16, n = row0 / SEQ;
          mem_micro(P, P.MQB + h * 64, 256, row0, 1, n, h, P.ATTB + NSA_Q_COLS + h * 64, 1024, lane); }
    }
    { LAS float* qs = (LAS float*)C.lds;
      for (int it = C.vcu; it < DEC_BATCH * MEM_HEADS; it += C.G) { const int h = it % MEM_HEADS, ns = it / MEM_HEADS, row = M0 + ns;
          __syncthreads(); if (C.tid < 64) qs[C.tid] = bf2f(P.MQB[(size_t)row * 256 + h * 64 + C.tid]); asm volatile("s_waitcnt lgkmcnt(0)" ::: "memory"); __syncthreads();
          Dec D; D.m = -INFINITY; D.l = 0.f; D.o = 0.f; const float* mk = P.cache_mem_kv + ((size_t)1 * DEC_BATCH + ns) * MEM_TOKENS * 512;
          for (int ck = w; ck < MEM_TOKENS / 64; ck += NWAVES) { const int j0 = ck * 64; dec_chunk(D, qs, 64, [&](int j) { return mk + (size_t)(j0 + j) * 512 + h * 64; }, [&](int j) { return mk + (size_t)(j0 + j) * 512 + 256 + h * 64; }, lane); }
          const float o = dec_combine(C, D);
          if (w == 0) P.ATTB[(size_t)row * 1024 + NSA_Q_COLS + h * 64 + lane] = (bf16)f2bf(o); } }
    __syncthreads();
}
}
namespace fx {
enum { PH_PRO = 0, PH_G1, PH_ATTA, PH_G2, PH_LN1, PH_SC0, PH_TK0, PH_PU0, PH_PG0, PH_G3, PH_CMPG, PH_CMP2, PH_NSA, PH_NSB, PH_G4, PH_LN3, PH_SC1, PH_TK1, PH_PU1, PH_PG1, PH_COUNT };
template <class Epi> DI void run_gemm(const Ctx& C, const bf16* A, const bf16* Bt, int M, int N, int K, const Epi& E) {
    pg8::Gemm g{A, Bt, M, N, K}; pg8::StaticOrder S; S.init(M, N, C.G, (int)blockIdx.x);
    pg8::gemm_phase<Epi, pg8::StaticOrder, true, true>(C.lds, g, S, E);
}
template <class Epi> DI void skinny_gemm(const Ctx& C, const bf16* A, const bf16* Bt, int N, int K, const Epi& E) {
    static_assert(DEC_BATCH == 32 && M0 % 256 == 0, "skinny_gemm: 32 sample rows right after a whole number of 256-row tiles");
    const int lane = C.lane, fr = lane & 15, fq = lane >> 4, w = C.wave; const int NI = (N / 256) * 4, KW = K / NWAVES;
    LAS f32x4* red = (LAS f32x4*)C.lds;
#pragma unroll 1
    for (int item = C.vcu; item < NI; item += C.G) { const int pn = item >> 2, wc = item & 3;
        f32x4 pa[2][2][2];
#pragma unroll
        for (int i = 0; i < 8; ++i) (&pa[0][0][0])[i] = (f32x4){0.f, 0.f, 0.f, 0.f};
        const bf16* xa = A + (size_t)(M0 + fr) * K + w * KW + 8 * fq; const bf16* xb = xa + (size_t)16 * K;
        const bf16* wp[2][2];
#pragma unroll
        for (int bj = 0; bj < 2; ++bj)
#pragma unroll
            for (int n = 0; n < 2; ++n) wp[bj][n] = Bt + (size_t)(pn * 256 + bj * 128 + wc * 32 + 8 * (fr >> 2) + 4 * n + (fr & 3)) * K + w * KW + 8 * fq;
#pragma unroll 4
        for (int k0 = 0; k0 < KW; k0 += 32) { const bf16x8 x0 = *(const bf16x8*)(xa + k0), x1 = *(const bf16x8*)(xb + k0);
#pragma unroll
            for (int bj = 0; bj < 2; ++bj)
#pragma unroll
                for (int n = 0; n < 2; ++n) { const bf16x8 wf = *(const bf16x8*)(wp[bj][n] + k0);
                    pa[bj][0][n] = __builtin_amdgcn_mfma_f32_16x16x32_bf16(wf, x0, pa[bj][0][n], 0, 0, 0); pa[bj][1][n] = __builtin_amdgcn_mfma_f32_16x16x32_bf16(wf, x1, pa[bj][1][n], 0, 0, 0); } }
        __syncthreads();
#pragma unroll
        for (int bj = 0; bj < 2; ++bj)
#pragma unroll
            for (int mm = 0; mm < 2; ++mm)
#pragma unroll
                for (int n = 0; n < 2; ++n) red[(w * 8 + bj * 4 + mm * 2 + n) * 64 + lane] = pa[bj][mm][n];
        asm volatile("s_waitcnt lgkmcnt(0)" ::: "memory"); __syncthreads();
        if (w == 0) { f32x4 acc[2][2][4][2];
#pragma unroll
            for (int i = 0; i < 32; ++i) (&acc[0][0][0][0])[i] = (f32x4){0.f, 0.f, 0.f, 0.f};
#pragma unroll
            for (int bj = 0; bj < 2; ++bj)
#pragma unroll
                for (int mm = 0; mm < 2; ++mm)
#pragma unroll
                    for (int n = 0; n < 2; ++n) { f32x4 s = red[(bj * 4 + mm * 2 + n) * 64 + lane];
#pragma unroll 1
                        for (int ww = 1; ww < NWAVES; ++ww) s += red[(ww * 8 + bj * 4 + mm * 2 + n) * 64 + lane];
                        acc[0][bj][mm][n] = s; }
            E(acc, pg8::Unit{M0 / 256, pn}, 0, wc, fr, fq); }
    }
    __syncthreads();
}
__global__ void __launch_bounds__(NTHREADS, 2) mega(Args args) {
    extern __shared__ __attribute__((aligned(16))) unsigned char lds_raw[];
    Ctx C; C.lds = (LAS unsigned char*)lds_raw; C.tid = threadIdx.x; C.lane = C.tid & 63; C.wave = __builtin_amdgcn_readfirstlane(C.tid >> 6);
    C.G = gridDim.x; { const int bx = blockIdx.x; C.vcu = (C.G % 8 == 0) ? (bx % 8) * (C.G / 8) + bx / 8 : bx; }
    const FP& P = args.p;
    volatile LAS unsigned* MISC = (volatile LAS unsigned*)(C.lds + MISC_OFF);
    for (int u = C.tid; u < (LDS_BYTES - RING_BYTES) / 4; u += NTHREADS) ((LAS unsigned*)(C.lds + RING_BYTES))[u] = 0u;
    __syncthreads();
    const int lo = args.lo, hi = args.hi;
    XcdBarrier bar; bar.bar = P.ctl + 1024; bar.x = 0; bar.st = nullptr;
    if (hi - lo > 1) bar = xcd_barrier_post(P.ctl + 1024, MISC + 8);
#define IN(k) (lo <= (k) && (k) < hi)
#define SEAM(k) do { if ((k) == PH_ATTA && IN(k)) bgq_drain(P, C, MISC + 12, BGQ_L_A);     \
        if ((k) == PH_TK0 && IN(k)) bgq_drain(P, C, MISC + 12, BGQ_L_UV); \
        if ((k) == PH_G3 && IN(k)) bgq_drain(P, C, MISC + 12, BGQ_L_AC); \
        if ((k) == PH_COUNT - 1 && IN(k)) bgq_drain(P, C, MISC + 12, BGQ_TOTAL); \
        if (IN(k) && IN((k) + 1)) xcd_barrier_bg(bar, P, C, MISC + 12); } while (0)
#ifndef DUP_PHASE
#define DUP_PHASE -1
#endif
#define PHASE(k, ...) do { if (IN(k)) { __VA_ARGS__ if (DUP_PHASE == (k)) { __syncthreads(); __VA_ARGS__ } } SEAM(k); } while (0)
    PHASE(PH_PRO, p0_prologue(P, C););
    PHASE(PH_G1, run_gemm(C, P.XB0, P.WA_T, M0, ACOLS, D_MODEL, EpiA{P}); run_gemm(C, P.MEMB, P.WMEM_T, BATCH * MEM_TOKENS, 1024, D_MODEL, EpiMem{P}); skinny_gemm(C, P.XB0, P.WA_T, ACOLS, D_MODEL, EpiA{P}););
#ifdef PEER_SHARD3
#define PEER_SHARDED_FN peer_sharded3_phase
#else
#define PEER_SHARDED_FN peer_sharded2_phase
#endif
#if defined(PEER_SOFTSYNC) && !defined(PEER_SHARD3)
#define PEER_HINT_ARGS , bar.st, bar.x
#else
#define PEER_HINT_ARGS
#endif
    PHASE(PH_ATTA, atta_phase(P, C););
    PHASE(PH_G2, run_gemm(C, P.ATTA, P.WOA_T, M0, D_MODEL, 512, EpiPre{P.x_prompt, P.x_sample, P.PRE}); skinny_gemm(C, P.ATTA, P.WOA_T, D_MODEL, 512, EpiPre{P.x_prompt, P.x_sample, P.PRE}););
    PHASE(PH_LN1, ln_phase(P, C, P.PRE, P.ln_g, P.ln_b, P.X1, P.X1B, nullptr, nullptr););
    PHASE(PH_SC0, run_gemm(C, P.X1B, P.WPK_T, M0, NPK, D_MODEL, EpiF32{P.SCO, NPK, MP}); skinny_gemm(C, P.X1B, P.WPK_T, NPK, D_MODEL, EpiF32{P.SCO, NPK, MP}););
    PHASE(PH_TK0, topk_phase(P, C););
#ifdef PEER_SPLIT
    PHASE(PH_PU0, peer_u_phase(P, C, 0, P.X1B););
    PHASE(PH_PG0, peer_v_phase(P, C, 0, P.X1, P.X2, P.X2 + (size_t)M0 * D_MODEL, P.X2B););
#elif defined(PEER_SHARD2)
    PHASE(PH_PG0, const bool shd = (M0 % (C.G * NWAVES * PS2_ROWS)) == 0; if (shd) { PEER_SHARDED_FN(P, C, 0, P.X1, P.X1B, P.X2, P.X2B PEER_HINT_ARGS); __syncthreads(); } peer_phase(P, C, 0, P.X1, P.X2, P.X2 + (size_t)M0 * D_MODEL, P.X2B, shd););
#elif defined(PEER_SHARD)
    PHASE(PH_PG0, peer_sharded_phase(P, C, 0, P.X1, P.X1B, P.X2, P.X2 + (size_t)M0 * D_MODEL, P.X2B); __syncthreads(); peer_phase(P, C, 0, P.X1, P.X2, P.X2 + (size_t)M0 * D_MODEL, P.X2B););
#else
    PHASE(PH_PG0, peer_phase(P, C, 0, P.X1, P.X2, P.X2 + (size_t)M0 * D_MODEL, P.X2B););
#endif
    PHASE(PH_G3, run_gemm(C, P.X2B, P.WB_T, M0, NB_T, D_MODEL, EpiB{P}); skinny_gemm(C, P.X2B, P.WB_T, NB_T, D_MODEL, EpiB{P}););
    PHASE(PH_CMPG, run_gemm(C, P.AC, P.CW1_T, ACROWS, 256, 1024, EpiF32{P.UL, 256, ACROWS}); run_gemm(C, P.AC + (size_t)ACROWS * 1024, P.CW1_T + 256 * 1024, ACROWS, 256, 1024, EpiF32{P.UL + (size_t)ACROWS * 256, 256, ACROWS}););
    PHASE(PH_CMP2, cmp2_phase(P, C););
    PHASE(PH_NSA, nsa_phase_a(P, C););
    PHASE(PH_NSB, nsa_phase_b(P, C););
    PHASE(PH_G4, run_gemm(C, P.ATTB, P.WOB_T, M0, D_MODEL, 1024, EpiPre{P.X2, nullptr, P.PRE}); skinny_gemm(C, P.ATTB, P.WOB_T, D_MODEL, 1024, EpiPre{P.X2, nullptr, P.PRE}););
    PHASE(PH_LN3, ln_phase(P, C, P.PRE, P.ln_g + 2 * D_MODEL, P.ln_b + 2 * D_MODEL, P.X3, P.X3B, nullptr, nullptr););
    PHASE(PH_SC1, run_gemm(C, P.X3B, P.WPK_T + (size_t)NPK * D_MODEL, M0, NPK, D_MODEL, EpiF32{P.SCO, NPK, MP}); skinny_gemm(C, P.X3B, P.WPK_T + (size_t)NPK * D_MODEL, NPK, D_MODEL, EpiF32{P.SCO, NPK, MP}););
    PHASE(PH_TK1, topk_phase(P, C););
#ifdef PEER_SPLIT
    PHASE(PH_PU1, peer_u_phase(P, C, 1, P.X3B););
    PHASE(PH_PG1, peer_v_phase(P, C, 1, P.X3, P.y_prompt, P.y_sample, nullptr););
#elif defined(PEER_SHARD2)
    PHASE(PH_PG1, const bool shd = (M0 % (C.G * NWAVES * PS2_ROWS)) == 0; if (shd) { PEER_SHARDED_FN(P, C, 1, P.X3, P.X3B, P.y_prompt, nullptr PEER_HINT_ARGS); __syncthreads(); } peer_phase(P, C, 1, P.X3, P.y_prompt, P.y_sample, nullptr, shd););
#elif defined(PEER_SHARD)
    PHASE(PH_PG1, peer_sharded_phase(P, C, 1, P.X3, P.X3B, P.y_prompt, P.y_sample, nullptr); __syncthreads(); peer_phase(P, C, 1, P.X3, P.y_prompt, P.y_sample, nullptr););
#else
    PHASE(PH_PG1, peer_phase(P, C, 1, P.X3, P.y_prompt, P.y_sample, nullptr););
#endif
#undef IN
#undef SEAM
}
}
#ifndef ONE_LAUNCH
#define ONE_LAUNCH 1
#endif
extern "C" void kernel_launch(void* const* d_in, const int* in_sizes, int n_in, void* d_out, int out_size, void* d_ws, size_t ws_size, hipStream_t stream) {
    fx::Args a; memset(&a, 0, sizeof(a)); fx::bind_io(a.p, d_in, (float*)d_out);
    const size_t f_need = fx::carve(a.p, d_ws);
    if (f_need > ws_size) { fprintf(stderr, "kernel_launch: workspace too small: need %zu have %zu\n", f_need, ws_size); return; }
    static int grid = 0;
    if (!grid) { int dev = 0, cus = 0, per_cu = 0; (void)hipGetDevice(&dev); (void)hipDeviceGetAttribute(&cus, hipDeviceAttributeMultiprocessorCount, dev);
        (void)hipFuncSetAttribute((const void*)fx::mega, hipFuncAttributeMaxDynamicSharedMemorySize, fx::LDS_BYTES);
        if (hipOccupancyMaxActiveBlocksPerMultiprocessor(&per_cu, (const void*)fx::mega, fx::NTHREADS, fx::LDS_BYTES) != hipSuccess || per_cu < 1) { fprintf(stderr, "kernel_launch: occupancy query says %d blocks per CU\n", per_cu); (void)hipGetLastError(); }
        grid = cus; }
    (void)hipMemsetAsync(a.p.ctl, 0, fx::CTL_BYTES, stream);
#if ONE_LAUNCH
    a.lo = 0; a.hi = fx::PH_COUNT; hipLaunchKernelGGL(fx::mega, dim3(grid), dim3(fx::NTHREADS), fx::LDS_BYTES, stream, a);
#else
    for (int k = 0; k < fx::PH_COUNT; ++k) { a.lo = k; a.hi = k + 1; hipLaunchKernelGGL(fx::mega, dim3(grid), dim3(fx::NTHREADS), fx::LDS_BYTES, stream, a); }
#endif
}
```

```cpp
#define PEER_SHARD2 1
#define ONE_LAUNCH 1
#include <hip/hip_runtime.h>
#include <cstdio>
#include <cstring>
#include <cmath>
#ifdef CPU_TEST
#define HD inline
constexpr int D_MODEL = 128, BATCH = 2, SEQ = 512, DEPTH = 2, DEC_BATCH = 3, DEC_SEQ = 1, PAST_LEN = 512, PAGE_SIZE = 128;
constexpr int DIL_W[3] = {16, 64, 256}, DIL_D[3] = {1, 4, 16}, DIL_TAPS = 17;
constexpr int MEM_TOKENS = 32, SLC_TOPK = 4, SWA_WINDOW = 64, PEER_KEYS = 16, PEER_TOPK = 4;
#else
#define HD __host__ __device__ __forceinline__
constexpr int D_MODEL = 1024, BATCH = 2, SEQ = 8192, DEPTH = 2, DEC_BATCH = 32, DEC_SEQ = 1, PAST_LEN = 8192, PAGE_SIZE = 128;
constexpr int DIL_W[3] = {128, 512, 2048}, DIL_D[3] = {1, 4, 16}, DIL_TAPS = 129;
constexpr int MEM_TOKENS = 256, SLC_TOPK = 16, SWA_WINDOW = 512, PEER_KEYS = 128, PEER_TOPK = 16;
#endif
HD constexpr int dil_w(int g) { return g == 0 ? DIL_W[0] : (g == 1 ? DIL_W[1] : DIL_W[2]); }
HD constexpr int dil_d(int g) { return g == 0 ? DIL_D[0] : (g == 1 ? DIL_D[1] : DIL_D[2]); }
constexpr int HEAD_DIM = 64, N_A_LAYERS = DEPTH / 2, N_DIL = 3, DIL_HEADS = 4, DIL_COLS = N_DIL * 3 * DIL_HEADS * HEAD_DIM;
constexpr int MEM_HEADS = 4, MEM_COLS = MEM_HEADS * HEAD_DIM;
constexpr int NSA_HEADS = 12, NSA_KV_HEADS = 2, NSA_GROUP = 6, NSA_Q_COLS = NSA_HEADS * HEAD_DIM, NSA_GATE_COLS = NSA_HEADS * 3;
constexpr int CMP_BLOCK = 32, CMP_STRIDE = 16, CMP_HIDDEN = 128, SLC_BLOCK = 64;
constexpr int PEER_EXPERTS = PEER_KEYS * PEER_KEYS, PEER_HEADS = 8, PEER_KEY_DIM = 128;
constexpr float FORCE_SCORE = 1.0e9f, NEG = -1.0e30f, SCALE = 0.125f, LN_EPS = 1e-5f;
constexpr float ALPHA = 1.41421356237309515f;
constexpr float BETA = 0.5f;
#define LAS __attribute__((address_space(3)))
namespace pg8 {
#define PG8_LAS __attribute__((address_space(3)))
typedef unsigned short bf16_t;
typedef short bf16x8 __attribute__((ext_vector_type(8)));
typedef float f32x4 __attribute__((ext_vector_type(4)));
typedef unsigned u32x4 __attribute__((ext_vector_type(4)));
constexpr int BM = 256, BK = 64, HALF = 128, HTB = HALF * BK * 2  , STAGE_BYTES = 8 * HTB, NXCD = 8, WGM = 8;

__host__ __device__ __forceinline__ int lds_byte(int r, int c) { const int st = (r >> 4) * 2 + (c >> 5), rr = r & 15, cc = c & 31, ob = rr * 64 + cc * 2; return st * 1024 + (ob ^ (((ob >> 9) & 1) << 5)); }
__host__ __device__ __forceinline__ void stage_rc(int b, int& R, int& C) { const int st = b / 1024, sb = b % 1024, swz = sb ^ (((sb >> 9) & 1) << 5); R = (st >> 1) * 16 + swz / 64; C = (st & 1) * 32 + (swz % 64) / 2; }
__host__ __device__ __forceinline__ int perm32(int rho) { const int n = rho >> 4, i = rho & 15; return 8 * (i >> 2) + 4 * n + (i & 3); }

struct Unit { int pm, pn; };
struct Gemm { const bf16_t* A; const bf16_t* Bt; int M, N, K; };

struct StaticOrder {
    int nM, nN, nwg, G, c;
    __host__ __device__ void init(int M, int N, int G_, int c_) { nM = M / BM; nN = N / BM; nwg = nM * nN; G = G_; c = c_; }
    __host__ __device__ bool next(int i, Unit& u) const {
        const long L = (long)i * G + c; if (L >= nwg) return false;
        int wgid = (int)L; { const int q = nwg / NXCD, r = nwg % NXCD, xcd = wgid % NXCD, off = wgid / NXCD; wgid = (xcd < r ? xcd * (q + 1) : r * (q + 1) + (xcd - r) * q) + off; }
        const int nig = WGM * nN, gid = wgid / nig, fm = gid * WGM, gsz = (nM - fm) < WGM ? (nM - fm) : WGM;
        u.pm = fm + ((wgid % nig) % gsz); u.pn = (wgid % nig) / gsz; return true;
    }
    __device__ __forceinline__ void a_ready(const Unit&) const {}
    __device__ __forceinline__ void done(const Unit&) const {}
};

__device__ __forceinline__ unsigned cvt_pk_bf16(float lo, float hi) { unsigned r; asm volatile("v_cvt_pk_bf16_f32 %0, %1, %2" : "=v"(r) : "v"(lo), "v"(hi)); return r; }
typedef float f32x2 __attribute__((ext_vector_type(2)));
typedef float f32x2 __attribute__((ext_vector_type(2)));
template <class Epi, class Sched, bool ALIGN_EPI = false, bool SP2 = false>
__device__ __forceinline__ void gemm_phase(PG8_LAS unsigned char* lds, const Gemm g, const Sched& S, const Epi& E) {
    const int tid = threadIdx.x, wid = __builtin_amdgcn_readfirstlane(tid >> 6), lane = tid & 63, wr = wid >> 2, wc = wid & 3, fr = lane & 15, fq = lane >> 4;
    const int K = g.K, nt = K / BK;
    unsigned voffA[2], voffB[2];
#pragma unroll
    for (int i = 0; i < 2; ++i) { int R, C; stage_rc(tid * 16 + i * 8192, R, C); const int Rb = Epi::PERM ? ((R & ~31) + perm32(R & 31)) : R;
        voffA[i] = (unsigned)(R * K + C) * 2u; voffB[i] = (unsigned)(Rb * K + C) * 2u; }
    const size_t kstep = (size_t)(BK * 2);
    const size_t hstep = (size_t)HALF * K * 2;
    const size_t tstep = 2 * hstep;
    const unsigned ldsw = (unsigned)wid * 1024u;
    const int aoff = lds_byte(wr * 64 + fr, fq * 8), boff = lds_byte(wc * 32 + fr, fq * 8);
#define PG8_SA(b, h) (((b) * 2 + (h)) * HTB)
#define PG8_SB(b, h) ((4 + (b) * 2 + (h)) * HTB)
#define PG8_STAGE(bufoff, gbase, voff) do { _Pragma("unroll") for (int _i = 0; _i < 2; ++_i) \
        __builtin_amdgcn_global_load_lds((const unsigned*)((const char*)(gbase) + (voff)[_i]), (PG8_LAS unsigned*)(lds + (bufoff) + ldsw + _i * 8192), 16, 0, 0); } while (0)
#define PG8_LDA(dst, b, h) do { _Pragma("unroll") for (int m = 0; m < 4; ++m) _Pragma("unroll") for (int k = 0; k < 2; ++k) dst[m][k] = *(const PG8_LAS bf16x8*)(lds + PG8_SA(b, h) + aoff + m * 2048 + k * 1024); } while (0)
#define PG8_LDB(dst, b, h) do { _Pragma("unroll") for (int n = 0; n < 2; ++n) _Pragma("unroll") for (int k = 0; k < 2; ++k) dst[n][k] = *(const PG8_LAS bf16x8*)(lds + PG8_SB(b, h) + boff + n * 2048 + k * 1024); } while (0)
#define PG8_MMA(ai, bj, At, Bt) do { __builtin_amdgcn_s_setprio(1); _Pragma("unroll") for (int m = 0; m < 4; ++m) _Pragma("unroll") for (int n = 0; n < 2; ++n) _Pragma("unroll") for (int k = 0; k < 2; ++k) \
        acc[ai][bj][m][n] = __builtin_amdgcn_mfma_f32_16x16x32_bf16(Bt[n][k], At[m][k], acc[ai][bj][m][n], 0, 0, 0); __builtin_amdgcn_s_setprio(0); } while (0)
#define PG8_WAIT_V(n) asm volatile("s_waitcnt vmcnt(" #n ")" ::: "memory")
#define PG8_WAIT_L(n) asm volatile("s_waitcnt lgkmcnt(" #n ")" ::: "memory")
#define PG8_BAR __builtin_amdgcn_s_barrier()
#define PG8_SCHED __builtin_amdgcn_sched_barrier(0)
    Unit cur, nxt; int ui = 0;
    if (!S.next(0, cur)) return;
    f32x4 acc[2][2][4][2];
#pragma unroll
    for (int a = 0; a < 2; ++a)
#pragma unroll
        for (int b = 0; b < 2; ++b)
#pragma unroll
            for (int m = 0; m < 4; ++m)
#pragma unroll
                for (int n = 0; n < 2; ++n) acc[a][b][m][n] = (f32x4){0.f, 0.f, 0.f, 0.f};
    bf16x8 At[4][2], B0[2][2], B1[2][2];
    const char* cA = (const char*)g.A + (size_t)cur.pm * tstep; const char* cB = (const char*)g.Bt + (size_t)cur.pn * tstep;
    S.a_ready(cur);
    if constexpr (SP2) {
        PG8_STAGE(PG8_SB(0, 0), cB, voffB); PG8_STAGE(PG8_SB(0, 1), cB + hstep, voffB); PG8_STAGE(PG8_SA(0, 0), cA, voffA); PG8_STAGE(PG8_SA(0, 1), cA + hstep, voffA);
        if (wr == 1) PG8_BAR;
        PG8_WAIT_V(2); PG8_BAR;
        PG8_STAGE(PG8_SB(1, 0), cB + kstep, voffB); PG8_STAGE(PG8_SA(1, 0), cA + kstep, voffA); PG8_STAGE(PG8_SB(1, 1), cB + hstep + kstep, voffB);
        PG8_WAIT_V(6); PG8_BAR;
    } else {
        PG8_STAGE(PG8_SB(0, 0), cB, voffB); PG8_STAGE(PG8_SA(0, 0), cA, voffA); PG8_STAGE(PG8_SB(0, 1), cB + hstep, voffB); PG8_STAGE(PG8_SA(0, 1), cA + hstep, voffA);
        if (wr == 1) PG8_BAR;
        PG8_WAIT_V(4); PG8_BAR;
        PG8_STAGE(PG8_SB(1, 0), cB + kstep, voffB); PG8_STAGE(PG8_SA(1, 0), cA + kstep, voffA); PG8_STAGE(PG8_SB(1, 1), cB + hstep + kstep, voffB);
        PG8_WAIT_V(6); PG8_BAR;
    }
    for (;;) {
        const bool has_next = S.next(ui + 1, nxt);
        const char* nA = has_next ? (const char*)g.A + (size_t)nxt.pm * tstep : cA; const char* nB = has_next ? (const char*)g.Bt + (size_t)nxt.pn * tstep : cB;
        for (int t = 0; t < nt; t += 2) {
            const bool last = (t == nt - 2);
            const char* a1 = cA + (size_t)(t + 1) * kstep;
            const char* a2 = last ? nA : cA + (size_t)(t + 2) * kstep; const char* b2 = last ? nB : cB + (size_t)(t + 2) * kstep;
            const char* a3 = a2 + kstep; const char* b3 = b2 + kstep;
            if (last && has_next) S.a_ready(nxt);
            if constexpr (SP2) {
            PG8_LDB(B0, 0, 0); PG8_LDB(B1, 0, 1); PG8_SCHED; PG8_LDA(At, 0, 0); PG8_STAGE(PG8_SA(1, 1), a1 + hstep, voffA);
            PG8_WAIT_V(8); PG8_WAIT_L(0); PG8_BAR; PG8_MMA(0, 0, At, B0); PG8_MMA(0, 1, At, B1); PG8_BAR; PG8_SCHED;
            PG8_LDA(At, 0, 1); PG8_STAGE(PG8_SB(0, 0), b2, voffB); PG8_STAGE(PG8_SB(0, 1), b2 + hstep, voffB); PG8_STAGE(PG8_SA(0, 0), a2, voffA);
            PG8_WAIT_V(8); PG8_WAIT_L(0); PG8_BAR; PG8_MMA(1, 0, At, B0); PG8_MMA(1, 1, At, B1); PG8_BAR; PG8_SCHED;
            PG8_LDB(B0, 1, 0); PG8_LDB(B1, 1, 1); PG8_SCHED; PG8_LDA(At, 1, 0); PG8_STAGE(PG8_SA(0, 1), a2 + hstep, voffA);
            PG8_WAIT_V(8); PG8_WAIT_L(0); PG8_BAR; PG8_MMA(0, 0, At, B0); PG8_MMA(0, 1, At, B1); PG8_BAR; PG8_SCHED;
            PG8_LDA(At, 1, 1); PG8_STAGE(PG8_SB(1, 0), b3, voffB); PG8_STAGE(PG8_SB(1, 1), b3 + hstep, voffB); PG8_STAGE(PG8_SA(1, 0), a3, voffA);
            PG8_WAIT_V(8); PG8_WAIT_L(0); PG8_BAR; PG8_MMA(1, 0, At, B0); PG8_MMA(1, 1, At, B1); PG8_BAR; PG8_SCHED;
            } else {
            PG8_LDB(B0, 0, 0); PG8_SCHED; PG8_LDA(At, 0, 0); PG8_STAGE(PG8_SA(1, 1), a1 + hstep, voffA);
            PG8_WAIT_L(8); PG8_BAR; PG8_WAIT_L(0); PG8_MMA(0, 0, At, B0); PG8_BAR; PG8_SCHED;
            PG8_LDB(B1, 0, 1); PG8_STAGE(PG8_SB(0, 0), b2, voffB);
            PG8_BAR; PG8_WAIT_L(0); PG8_MMA(0, 1, At, B1); PG8_BAR;
            PG8_LDA(At, 0, 1); PG8_STAGE(PG8_SA(0, 0), a2, voffA);
            PG8_BAR; PG8_WAIT_L(0); PG8_MMA(1, 0, At, B0); PG8_BAR; PG8_SCHED;
            PG8_STAGE(PG8_SB(0, 1), b2 + hstep, voffB);
            PG8_WAIT_V(6); PG8_BAR; PG8_MMA(1, 1, At, B1); PG8_BAR;
            PG8_LDB(B0, 1, 0); PG8_SCHED; PG8_LDA(At, 1, 0); PG8_STAGE(PG8_SA(0, 1), a2 + hstep, voffA);
            PG8_WAIT_L(8); PG8_BAR; PG8_WAIT_L(0); PG8_MMA(0, 0, At, B0); PG8_BAR; PG8_SCHED;
            PG8_LDB(B1, 1, 1); PG8_STAGE(PG8_SB(1, 0), b3, voffB);
            PG8_BAR; PG8_WAIT_L(0); PG8_MMA(0, 1, At, B1); PG8_BAR;
            PG8_LDA(At, 1, 1); PG8_STAGE(PG8_SA(1, 0), a3, voffA);
            PG8_BAR; PG8_WAIT_L(0); PG8_MMA(1, 0, At, B0); PG8_BAR; PG8_SCHED;
            PG8_STAGE(PG8_SB(1, 1), b3 + hstep, voffB);
            PG8_WAIT_V(6); PG8_BAR; PG8_MMA(1, 1, At, B1); PG8_BAR;
            }
        }
        if constexpr (ALIGN_EPI) { if (wr == 0) PG8_BAR; }
        if constexpr (!Epi::AFTER_DRAIN) { E(acc, cur, wr, wc, fr, fq); S.done(cur); }
        if (!has_next) break;
#pragma unroll
        for (int a = 0; a < 2; ++a)
#pragma unroll
            for (int b = 0; b < 2; ++b)
#pragma unroll
                for (int m = 0; m < 4; ++m)
#pragma unroll
                    for (int n = 0; n < 2; ++n) acc[a][b][m][n] = (f32x4){0.f, 0.f, 0.f, 0.f};
        cur = nxt; cA = nA; cB = nB; ++ui;
        if constexpr (ALIGN_EPI) { if (wr == 1) PG8_BAR; }
    }
    PG8_WAIT_V(0);
    if constexpr (!ALIGN_EPI) { if (wr == 0) PG8_BAR; }
    PG8_BAR;
    if constexpr (Epi::AFTER_DRAIN) { E.fused(acc, cur, wr, wc, fr, fq, lds, wid, lane); S.done(cur); }
#undef PG8_SA
#undef PG8_SB
#undef PG8_STAGE
#undef PG8_LDA
#undef PG8_LDB
#undef PG8_MMA
#undef PG8_WAIT_V
#undef PG8_WAIT_L
#undef PG8_BAR
#undef PG8_SCHED
}
}
#define XB_TMO      128
#define XB_XCNT(j)  (256  + 64 * (j))
#define XB_XSUB(j)  (1280 + 64 * (j))
#define XB_XGEN(j)  (2304 + 64 * (j))
#define XB_TOP      3328
#define XB_TOPGEN   3392
#define XCD_BAR_WORDS 3456
#define XB_SPIN_CAP (1u << 18)

__device__ __forceinline__ unsigned xb_ld(unsigned* p)              { return __hip_atomic_load(p, __ATOMIC_RELAXED, __HIP_MEMORY_SCOPE_AGENT); }
__device__ __forceinline__ unsigned xb_add(unsigned* p, unsigned v) { return __hip_atomic_fetch_add(p, v, __ATOMIC_RELAXED, __HIP_MEMORY_SCOPE_AGENT); }
__device__ __forceinline__ unsigned xb_xcc_id() { return (unsigned)__builtin_amdgcn_s_getreg((3 << 11) | 20) & 0xFu; }
#define XB_SPIN(cond, bar) do { unsigned _sp = 0; while (cond) { __builtin_amdgcn_s_sleep(1); \
    if ((++_sp & 255u) == 0u) { if (xb_ld(&(bar)[XB_TMO])) break; if (_sp > XB_SPIN_CAP) { atomicAdd(&(bar)[XB_TMO], 1u); break; } } } } while (0)

struct XcdBarrier {
    unsigned* bar; unsigned x;
    volatile LAS unsigned* st;
};

__device__ __forceinline__ XcdBarrier xcd_barrier_post(unsigned* bar, volatile LAS unsigned* st) {
    XcdBarrier b; b.bar = bar; b.x = xb_xcc_id(); b.st = st;
    if (threadIdx.x == 0) (void)xb_add(&bar[XB_XCNT(b.x)], 1u);
    return b;
}
__device__ __forceinline__ void xcd_barrier_complete(unsigned* bar, unsigned x, unsigned& nloc, unsigned& nx) {
    const unsigned G = gridDim.x * gridDim.y * gridDim.z;
    unsigned sum, cnt, mine, sp = 0u;
    for (;;) {
        sum = 0u; cnt = 0u; mine = 0u;
#pragma unroll
        for (unsigned j = 0; j < 16; ++j) { const unsigned c = xb_ld(&bar[XB_XCNT(j)]); sum += c; cnt += (c > 0u) ? 1u : 0u; mine = (j == x) ? c : mine; }
        if (sum == G) break;
        __builtin_amdgcn_s_sleep(1);
        if ((++sp & 255u) == 0u) { if (xb_ld(&bar[XB_TMO])) break; if (sp > XB_SPIN_CAP) { atomicAdd(&bar[XB_TMO], 1u); break; } }
    }
    nloc = mine > 0u ? mine : 1u; nx = cnt > 0u ? cnt : 1u;
}

__device__ __forceinline__ void xcd_barrier(const XcdBarrier& b) {
    asm volatile("s_waitcnt vmcnt(0)" ::: "memory");
    __syncthreads();
    if (threadIdx.x == 0) {
        unsigned* bar = b.bar;
        __builtin_amdgcn_s_waitcnt(0);
        unsigned nloc = b.st[0], nx = b.st[1];
        if (nloc == 0u) { xcd_barrier_complete(bar, b.x, nloc, nx); b.st[0] = nloc; b.st[1] = nx; }
        const unsigned old = xb_add(&bar[XB_XSUB(b.x)], 1u);
        const unsigned gen = old / nloc;
        if (old + 1u == (gen + 1u) * nloc) {
            __builtin_amdgcn_fence(__ATOMIC_RELEASE, "agent");
            asm volatile("s_waitcnt vmcnt(0)" ::: "memory");
            const unsigned og = xb_add(&bar[XB_TOP], 1u);
            const unsigned tg = og / nx;
            if (og + 1u == (tg + 1u) * nx) xb_add(&bar[XB_TOPGEN], 1u);
            else XB_SPIN(xb_ld(&bar[XB_TOPGEN]) == tg, bar);
            __builtin_amdgcn_fence(__ATOMIC_ACQUIRE, "agent");
            xb_add(&bar[XB_XGEN(b.x)], 1u);
            asm volatile("s_waitcnt vmcnt(0)" ::: "memory");
        } else {
            XB_SPIN(xb_ld(&bar[XB_XGEN(b.x)]) == gen, bar);
            __builtin_amdgcn_fence(__ATOMIC_ACQUIRE, "agent");
            asm volatile("s_waitcnt vmcnt(0)" ::: "memory");
        }
    }
    __syncthreads();
}
namespace fx {
#define DI __device__ __forceinline__
typedef unsigned short bf16;
typedef short bf16x8 __attribute__((ext_vector_type(8)));
typedef float f32x4 __attribute__((ext_vector_type(4)));
typedef float f32x2 __attribute__((ext_vector_type(2)));
typedef unsigned u32x4 __attribute__((ext_vector_type(4)));
typedef unsigned u32x2 __attribute__((ext_vector_type(2)));
constexpr int M0 = BATCH * SEQ, MP = M0 + DEC_BATCH, MPAD = ((MP + 255) / 256) * 256;
constexpr int ACOLS = DIL_COLS + MEM_COLS, BCOLS = NSA_Q_COLS + NSA_GATE_COLS + MEM_COLS, KVCOLS = 6 * NSA_KV_HEADS * HEAD_DIM;
constexpr int NB_T = 2048;
constexpr int NPK = PEER_HEADS * 2 * PEER_KEYS;
constexpr int NCMP = (SEQ - CMP_BLOCK) / CMP_STRIDE + 1;
constexpr int NCH = SEQ / CMP_STRIDE;
constexpr int NCTX = BATCH + DEC_BATCH;
constexpr int ACROWS = NCTX * NSA_KV_HEADS * NCH;
constexpr int NPOS = PAST_LEN + 1;
constexpr float QSCALE = 0.125f * 1.4426950408889634f;
constexpr int NTHREADS = 512, NWAVES = 8, LDS_BYTES = 147456, RING_BYTES = 131072, MISC_OFF = RING_BYTES + 320;

struct FP {
    const float *x_prompt, *x_sample, *mem_prompt, *cache_dil[3], *cache_nsa_kv, *cache_nsa_win, *cache_mem_kv; const int* page_table;
    const float *w_in_a, *w_out_a, *w_in_b, *w_out_b, *w_mem_kv, *w_kv_b, *cmp_pe, *cmp_w1, *cmp_w2, *ln_g, *ln_b, *peer_wq, *peer_keys, *peer_u, *peer_v;
    float *y_prompt, *y_sample, *dil_p[3], *dil_s[3], *nsa_kv_p, *nsa_kv_s, *win_p, *win_s, *mem_kv_p;
    unsigned* ctl;
    bf16 *XB0, *X1B, *X2B, *X3B, *WA_T, *WMEM_T, *MEMB, *WOA_T, *WOB_T, *WPK_T, *WB_T, *CW1_T, *AC; unsigned char *UB8, *VB8;
    float *ROPE, *CBIAS;
    bf16 *QA, *KA, *VTA, *MQA, *MK, *MVT, *ATTA;
    float *DPART, *DML, *PRE, *X1, *X2, *X3, *SCO, *SELG; int* SELE;
    bf16 *SLK, *SLVT, *WNK, *WNVT, *QB, *MQB, *CK, *CVT, *ATTB;
    float *GATES, *UL, *CKF, *CVF;
    int* SELB;
    float* DBG;
};
struct Args { FP p; int lo, hi; };
struct Carve { size_t off = 0; template <class T> T* take(void* base, size_t n) { T* r = (T*)((char*)base + off); off += ((n * sizeof(T) + 255) / 256) * 256; return r; } };
constexpr size_t CTL_BYTES = 65536;
inline size_t carve(FP& p, void* base) {
    Carve c;
    p.ctl = c.take<unsigned>(base, CTL_BYTES / 4);
    p.XB0 = c.take<bf16>(base, (size_t)MPAD * D_MODEL); p.X1B = c.take<bf16>(base, (size_t)MPAD * D_MODEL); p.X2B = c.take<bf16>(base, (size_t)MPAD * D_MODEL); p.X3B = c.take<bf16>(base, (size_t)MPAD * D_MODEL);
    p.WA_T = c.take<bf16>(base, (size_t)ACOLS * D_MODEL); p.WMEM_T = c.take<bf16>(base, (size_t)DEPTH * 2 * MEM_COLS * D_MODEL); p.MEMB = c.take<bf16>(base, (size_t)BATCH * MEM_TOKENS * D_MODEL);
    p.WOA_T = c.take<bf16>(base, (size_t)D_MODEL * 2 * MEM_COLS); p.WOB_T = c.take<bf16>(base, (size_t)D_MODEL * (NSA_Q_COLS + MEM_COLS));
    p.WPK_T = c.take<bf16>(base, (size_t)DEPTH * NPK * D_MODEL); p.WB_T = c.take<bf16>(base, (size_t)NB_T * D_MODEL);
    p.UB8 = c.take<unsigned char>(base, (size_t)DEPTH * PEER_EXPERTS * D_MODEL); p.VB8 = c.take<unsigned char>(base, (size_t)DEPTH * PEER_EXPERTS * D_MODEL);
    p.CW1_T = c.take<bf16>(base, (size_t)2 * 256 * 1024); p.AC = c.take<bf16>(base, (size_t)2 * ACROWS * 1024);
    p.ROPE = c.take<float>(base, (size_t)NPOS * 64); p.CBIAS = c.take<float>(base, 2 * CMP_HIDDEN);
    p.QA = c.take<bf16>(base, (size_t)3 * MPAD * 256); p.KA = c.take<bf16>(base, (size_t)3 * MPAD * 256); p.VTA = c.take<bf16>(base, (size_t)3 * BATCH * DIL_HEADS * HEAD_DIM * SEQ + 4096);
    p.MQA = c.take<bf16>(base, (size_t)MPAD * 256); p.MK = c.take<bf16>(base, (size_t)DEPTH * BATCH * MEM_TOKENS * MEM_COLS); p.MVT = c.take<bf16>(base, (size_t)DEPTH * BATCH * MEM_COLS * MEM_TOKENS);
    p.ATTA = c.take<bf16>(base, (size_t)MPAD * 2 * MEM_COLS);
    p.DPART = c.take<float>(base, (size_t)3 * MP * DIL_HEADS * HEAD_DIM); p.DML = c.take<float>(base, (size_t)3 * MP * DIL_HEADS * 2);
    p.PRE = c.take<float>(base, (size_t)MPAD * D_MODEL); p.X1 = c.take<float>(base, (size_t)MPAD * D_MODEL); p.X2 = c.take<float>(base, (size_t)MPAD * D_MODEL); p.X3 = c.take<float>(base, (size_t)MPAD * D_MODEL);
    p.SCO = c.take<float>(base, (size_t)MPAD * NPK); p.SELG = c.take<float>(base, (size_t)MP * 128); p.SELE = c.take<int>(base, (size_t)MP * 128);
    p.SLK = c.take<bf16>(base, (size_t)BATCH * NSA_KV_HEADS * SEQ * HEAD_DIM); p.SLVT = c.take<bf16>(base, (size_t)BATCH * NSA_KV_HEADS * SEQ * HEAD_DIM);
    p.WNK = c.take<bf16>(base, (size_t)BATCH * NSA_KV_HEADS * SEQ * HEAD_DIM + 4096); p.WNVT = c.take<bf16>(base, (size_t)BATCH * NSA_KV_HEADS * SEQ * HEAD_DIM + 4096);
    p.QB = c.take<bf16>(base, (size_t)MPAD * NSA_Q_COLS); p.MQB = c.take<bf16>(base, (size_t)MPAD * 256);
    p.CK = c.take<bf16>(base, (size_t)NCTX * NSA_KV_HEADS * NCH * HEAD_DIM); p.CVT = c.take<bf16>(base, (size_t)NCTX * NSA_KV_HEADS * HEAD_DIM * NCH); p.ATTB = c.take<bf16>(base, (size_t)MPAD * (NSA_Q_COLS + MEM_COLS));
    p.GATES = c.take<float>(base, (size_t)MPAD * 64); p.UL = c.take<float>(base, (size_t)2 * ACROWS * 256);
    p.CKF = c.take<float>(base, (size_t)DEC_BATCH * NSA_KV_HEADS * NCH * HEAD_DIM); p.CVF = c.take<float>(base, (size_t)DEC_BATCH * NSA_KV_HEADS * NCH * HEAD_DIM);
    p.SELB = c.take<int>(base, (size_t)MP * NSA_KV_HEADS * 16);
#ifdef NSA_DEBUG
    p.DBG = c.take<float>(base, (size_t)3 * MP * 768);
#else
    p.DBG = nullptr;
#endif
    return c.off;
}
inline void bind_io(FP& p, void* const* d_in, float* out) {
    p.x_prompt = (const float*)d_in[0]; p.x_sample = (const float*)d_in[1]; p.mem_prompt = (const float*)d_in[2]; p.cache_dil[0] = (const float*)d_in[3]; p.cache_dil[1] = (const float*)d_in[4]; p.cache_dil[2] = (const float*)d_in[5];
    p.cache_nsa_kv = (const float*)d_in[6]; p.cache_nsa_win = (const float*)d_in[7]; p.cache_mem_kv = (const float*)d_in[8]; p.page_table = (const int*)d_in[9];
    p.w_in_a = (const float*)d_in[10]; p.w_out_a = (const float*)d_in[11]; p.w_in_b = (const float*)d_in[12]; p.w_out_b = (const float*)d_in[13]; p.w_mem_kv = (const float*)d_in[14]; p.w_kv_b = (const float*)d_in[15];
    p.cmp_pe = (const float*)d_in[16]; p.cmp_w1 = (const float*)d_in[17]; p.cmp_w2 = (const float*)d_in[18]; p.ln_g = (const float*)d_in[19]; p.ln_b = (const float*)d_in[20];
    p.peer_wq = (const float*)d_in[21]; p.peer_keys = (const float*)d_in[22]; p.peer_u = (const float*)d_in[23]; p.peer_v = (const float*)d_in[24];
    size_t o = 0; auto take = [&](size_t n) { float* r = out + o; o += n; return r; };
    p.y_prompt = take((size_t)M0 * D_MODEL); p.y_sample = take((size_t)DEC_BATCH * D_MODEL);
    for (int g = 0; g < 3; ++g) p.dil_p[g] = take((size_t)BATCH * DIL_W[g] * 2 * DIL_HEADS * HEAD_DIM);
    for (int g = 0; g < 3; ++g) p.dil_s[g] = take((size_t)DEC_BATCH * DIL_W[g] * 2 * DIL_HEADS * HEAD_DIM);
    p.nsa_kv_p = take((size_t)M0 * 4 * NSA_KV_HEADS * HEAD_DIM); p.nsa_kv_s = take((size_t)DEC_BATCH * 4 * NSA_KV_HEADS * HEAD_DIM);
    p.win_p = take((size_t)BATCH * SWA_WINDOW * 2 * NSA_KV_HEADS * HEAD_DIM); p.win_s = take((size_t)DEC_BATCH * SWA_WINDOW * 2 * NSA_KV_HEADS * HEAD_DIM);
    p.mem_kv_p = take((size_t)DEPTH * BATCH * MEM_TOKENS * 2 * MEM_COLS);
}
DI unsigned f2bf(float f) { unsigned u = __builtin_bit_cast(unsigned, f); return (u + 0x7fffu + ((u >> 16) & 1u)) >> 16; }
DI unsigned pk2(float lo, float hi) { return f2bf(lo) | (f2bf(hi) << 16); }
DI float bf2f(unsigned short b) { return __builtin_bit_cast(float, (unsigned)b << 16); }
DI float bflo(unsigned w) { return __builtin_bit_cast(float, w << 16); }
DI float bfhi(unsigned w) { return __builtin_bit_cast(float, w & 0xffff0000u); }
template <int CTRL> DI float dpp1(float x) { return __builtin_bit_cast(float, __builtin_amdgcn_update_dpp(0, __builtin_bit_cast(int, x), CTRL, 0xF, 0xF, true)); }
DI float wave_sum(float v) { v += dpp1<0xB1>(v); v += dpp1<0x4E>(v); v += dpp1<0x141>(v); v += dpp1<0x140>(v);
    float a = v, b = v; asm volatile("s_nop 1\n\tv_permlane16_swap_b32 %0, %1" : "+v"(a), "+v"(b)); v = a + b; a = v; b = v;
    asm volatile("s_nop 1\n\tv_permlane32_swap_b32 %0, %1" : "+v"(a), "+v"(b)); return a + b; }
DI float wave_max(float v) { v = fmaxf(v, dpp1<0xB1>(v)); v = fmaxf(v, dpp1<0x4E>(v)); v = fmaxf(v, dpp1<0x141>(v)); v = fmaxf(v, dpp1<0x140>(v));
    float a = v, b = v; asm volatile("s_nop 1\n\tv_permlane16_swap_b32 %0, %1" : "+v"(a), "+v"(b)); v = fmaxf(a, b); a = v; b = v;
    asm volatile("s_nop 1\n\tv_permlane32_swap_b32 %0, %1" : "+v"(a), "+v"(b)); return fmaxf(a, b); }
DI float gelu_tanh(float x) { const float u = 0.7978845608028654f * (x + 0.044715f * x * x * x); const float e = __builtin_amdgcn_exp2f(u * 2.885390081777927f);   const float t = 1.0f - 2.0f / (e + 1.0f); return 0.5f * x * (1.0f + t); }
DI float* sel3(float* const (&a)[3], int g) { return g == 0 ? a[0] : (g == 1 ? a[1] : a[2]); }
DI const float* sel3c(const float* const (&a)[3], int g) { return g == 0 ? a[0] : (g == 1 ? a[1] : a[2]); }
__host__ DI size_t ktile_off(int t, int d) { const int blk = t >> 5, kk = t & 31, b = (kk >> 2) & 1, i = 4 * (kk >> 3) + (kk & 3), s = d >> 5, c = (d & 31) >> 3; return ((size_t)(blk * 4 + 2 * b + s) * 64 + i + 16 * c) * 8 + (d & 7); }
__host__ DI size_t vtile_off(int dim, int t) { const int blk = t >> 5, kk = t & 31; return ((size_t)(blk * 4 + (dim >> 4)) * 64 + (dim & 15) + 16 * (kk >> 3)) * 8 + (kk & 7); }
struct Ctx { LAS unsigned char* lds; int tid, lane, wave, vcu, G; };
DI int row_pos(int r) { return r < M0 ? (r & (SEQ - 1)) : PAST_LEN; }

struct ColSrc { const float* p; int ld; };
DI int rope_il(int e) { return (e >> 1) + 32 * (e & 1); }
DI ColSrc col_wa(const FP& P, int n) {
    const int t = n >> 8, ct = n & 255, h = ct >> 6, e = ct & 63; if (t >= 9) return ColSrc{P.w_in_a + DIL_COLS + ct, ACOLS};
    const int j = t % 3, d = (j < 2) ? rope_il(e) : e; return ColSrc{P.w_in_a + t * 256 + h * 64 + d, ACOLS}; }
DI ColSrc col_wb(const FP& P, int n) {
    const int t = n >> 8, ct = n & 255, e = ct & 63;
    if (t < 3) { const int ty = 2 * t + (ct >> 7), kvh = (ct >> 6) & 1; const bool rot = (ty == 2 || ty == 4); return ColSrc{P.w_kv_b + (ty * NSA_KV_HEADS + kvh) * 64 + (rot ? rope_il(e) : e), KVCOLS}; }
    if (t < 6) { const int h = (t - 3) * 4 + (ct >> 6); return ColSrc{P.w_in_b + h * 64 + rope_il(e), BCOLS}; }
    if (t == 6) return ColSrc{P.w_in_b + NSA_Q_COLS + NSA_GATE_COLS + ct, BCOLS};
    if (ct < NSA_GATE_COLS) return ColSrc{P.w_in_b + NSA_Q_COLS + ct, BCOLS};
    return ColSrc{nullptr, 0}; }
DI ColSrc col_wmem(const FP& P, int n) { const int l = n >> 9, c = n & 511; return ColSrc{P.w_mem_kv + (size_t)l * D_MODEL * 512 + c, 512}; }
DI ColSrc col_woa(const FP& P, int n) { return ColSrc{P.w_out_a + n, D_MODEL}; }
DI ColSrc col_wob(const FP& P, int n) { return ColSrc{P.w_out_b + n, D_MODEL}; }
DI ColSrc col_cw1(const FP& P, int n) {
    const int ty = n >> 8, half = (n >> 7) & 1, hid = n & 127; return ColSrc{P.cmp_w1 + (size_t)ty * CMP_BLOCK * HEAD_DIM * CMP_HIDDEN + (size_t)half * 16 * HEAD_DIM * CMP_HIDDEN + hid, CMP_HIDDEN}; }
template <class CF> DI void transpose_item(const FP& P, CF cf, int K, bf16* WT, LAS float* scr, int item, int nblk, int lane) {
    const int kb = item / nblk, nb = item % nblk, k0 = 64 * kb, n0 = 32 * nb;
    const ColSrc cs = cf(P, n0 + (lane & 31));
#pragma unroll 8
    for (int i = 0; i < 32; ++i) { const int kk = 2 * i + (lane >> 5); scr[kk * 33 + (lane & 31)] = cs.p ? cs.p[(size_t)(k0 + kk) * cs.ld] : 0.f; }
    asm volatile("s_waitcnt lgkmcnt(0)" ::: "memory");
    const int c = lane & 7;
#pragma unroll
    for (int j = 0; j < 4; ++j) { const int n = (lane >> 3) + 8 * j; const LAS float* s = scr + (8 * c) * 33 + n;
        u32x4 o; o.x = pk2(s[0 * 33], s[1 * 33]); o.y = pk2(s[2 * 33], s[3 * 33]); o.z = pk2(s[4 * 33], s[5 * 33]); o.w = pk2(s[6 * 33], s[7 * 33]);
        *(u32x4*)(WT + (size_t)(n0 + n) * K + k0 + 8 * c) = o; }
    asm volatile("s_waitcnt lgkmcnt(0)" ::: "memory");
}
DI void cvt_row1024(const float* src, bf16* dst, int lane) {
#pragma unroll
    for (int j = 0; j < 4; ++j) { f32x4 v = src ? *(const f32x4*)(src + 256 * j + 4 * lane) : (f32x4){0.f, 0.f, 0.f, 0.f}; u32x2 o; o.x = pk2(v.x, v.y); o.y = pk2(v.z, v.w); *(u32x2*)(dst + 256 * j + 4 * lane) = o; }
}
DI void cvt_row1024_fp8(const float* src, unsigned char* dst, float sc, int lane) { u32x4 o; unsigned w[4];
#pragma unroll
    for (int j = 0; j < 4; ++j) { const f32x4 v = *(const f32x4*)(src + 16 * lane + 4 * j) * sc; int t = __builtin_amdgcn_cvt_pk_fp8_f32(v.x, v.y, 0, false); t = __builtin_amdgcn_cvt_pk_fp8_f32(v.z, v.w, t, true); w[j] = (unsigned)t; }
    o.x = w[0]; o.y = w[1]; o.z = w[2]; o.w = w[3]; *(u32x4*)(dst + 16 * lane) = o; }
DI void p0_prologue(const FP& P, const Ctx& C) {
    LAS float* scr = (LAS float*)(C.lds + C.wave * 16384);
    const int gw = C.vcu * NWAVES + C.wave, NGW = C.G * NWAVES, lane = C.lane; const int gwT0 = C.wave * C.G + C.vcu;
    { constexpr int IA = (D_MODEL / 64) * (ACOLS / 32), IM = (D_MODEL / 64) * (1024 / 32);
      for (int it = gwT0; it < IA + IM; it += NGW) { int r = it;
          if (r < IA) { transpose_item(P, col_wa, D_MODEL, P.WA_T, scr, r, ACOLS / 32, lane); continue; } r -= IA;
          transpose_item(P, col_wmem, D_MODEL, P.WMEM_T, scr, r, 1024 / 32, lane); } }
    for (int r = gw; r < M0 - NGW; r += 2 * NGW) {
        f32x4 v[8];
#pragma unroll
        for (int j = 0; j < 8; ++j) v[j] = *(const f32x4*)(P.x_prompt + (size_t)(r + (j >> 2) * NGW) * D_MODEL + 256 * (j & 3) + 4 * lane);
#pragma unroll
        for (int j = 0; j < 8; ++j) { u32x2 o; o.x = pk2(v[j].x, v[j].y); o.y = pk2(v[j].z, v[j].w); *(u32x2*)(P.XB0 + (size_t)(r + (j >> 2) * NGW) * D_MODEL + 256 * (j & 3) + 4 * lane) = o; } }
    for (int r = gw + ((M0 - NGW - gw + 2 * NGW - 1) / (2 * NGW)) * (2 * NGW); r < MPAD; r += NGW) { cvt_row1024(r < M0 ? P.x_prompt + (size_t)r * D_MODEL : (r < MP ? P.x_sample + (size_t)(r - M0) * D_MODEL : nullptr), P.XB0 + (size_t)r * D_MODEL, lane);
        if (r >= MP) { cvt_row1024(nullptr, P.X1B + (size_t)r * D_MODEL, lane); cvt_row1024(nullptr, P.X2B + (size_t)r * D_MODEL, lane); cvt_row1024(nullptr, P.X3B + (size_t)r * D_MODEL, lane);
            for (int c = lane; c < 512; c += 64) { P.ATTA[(size_t)r * 512 + c] = 0; P.ATTB[(size_t)r * 1024 + c] = 0; P.ATTB[(size_t)r * 1024 + 512 + c] = 0; } } }
    for (int r = gw; r < BATCH * MEM_TOKENS; r += NGW) cvt_row1024(P.mem_prompt + (size_t)r * D_MODEL, P.MEMB + (size_t)r * D_MODEL, lane);
    for (int i = gw * 64 + lane; i < NPOS * 32; i += NGW * 64) { const int pos = i >> 5, d = i & 31; const double inv = exp2(-(double)d * (13.287712379549449 / 32.0)); const double turns = (double)pos * inv * 0.15915494309189535;
        const float fr = (float)(turns - floor(turns)); P.ROPE[pos * 64 + d] = __builtin_amdgcn_cosf(fr); P.ROPE[pos * 64 + 32 + d] = __builtin_amdgcn_sinf(fr); }
}
constexpr int WPK_ITEMS = DEPTH * 16 * (D_MODEL / 64);
DI void wpk_item(const FP& P, const Ctx& C, int it) {
    LAS float* sw = (LAS float*)C.lds;
    LAS float* sk = (LAS float*)(C.lds + 32768);
    const int l = it / (16 * (D_MODEL / 64)), rem = it % (16 * (D_MODEL / 64)), hc = rem / (D_MODEL / 64), kb = rem % (D_MODEL / 64);
    __syncthreads();
    for (int i = C.tid; i < 64 * 64; i += NTHREADS) { const int r = i >> 6, d = i & 63; sw[r * 65 + d] = P.peer_wq[((size_t)l * D_MODEL + kb * 64 + r) * 1024 + hc * 64 + d]; }
    for (int i = C.tid; i < 128 * 64; i += NTHREADS) { const int r = i >> 6, d = i & 63; sk[r * 68 + d] = P.peer_keys[(((size_t)l * 16 + hc) * PEER_KEYS + r) * 64 + d]; }
    __syncthreads();
    { const int ki = C.lane, kk0 = C.wave; float a[16];
#pragma unroll
      for (int j = 0; j < 16; ++j) a[j] = 0.f;
#pragma unroll 2
      for (int d = 0; d < 64; d += 4) { const float w0 = sw[ki * 65 + d], w1 = sw[ki * 65 + d + 1], w2 = sw[ki * 65 + d + 2], w3 = sw[ki * 65 + d + 3];
#pragma unroll
          for (int j = 0; j < 16; ++j) { const f32x4 kq = *(const LAS f32x4*)(sk + (kk0 + 8 * j) * 68 + d); a[j] += w0 * kq.x + w1 * kq.y + w2 * kq.z + w3 * kq.w; } }
#pragma unroll
      for (int j = 0; j < 16; ++j) P.WPK_T[((size_t)l * NPK + hc * 128 + kk0 + 8 * j) * D_MODEL + kb * 64 + ki] = (bf16)f2bf(a[j]); }
    __syncthreads();
}
constexpr int T1_OA = (512 / 64) * (D_MODEL / 32), T1_OB = (1024 / 64) * (D_MODEL / 32), T1_B = (D_MODEL / 64) * (NB_T / 32), T1_C = (1024 / 64) * (512 / 32), T1_ITEMS = T1_OA + T1_OB + T1_B + T1_C;
constexpr int AC_ITEMS = DEC_BATCH * (PAST_LEN / PAGE_SIZE) * (PAGE_SIZE / 8), CB_ITEMS = 2 * CMP_HIDDEN;
constexpr int bgq_cache_n(int g) { return (DEC_BATCH * ((g < 3 ? dil_w(g) : SWA_WINDOW) - 1) * (g < 3 ? 128 : 64) + 8191) / 8192; }
constexpr int BGQ_T1 = (T1_ITEMS + 7) / 8, BGQ_L_A = BGQ_T1 + WPK_ITEMS, BGQ_UV = DEPTH * PEER_EXPERTS / 16, BGQ_L_UV = BGQ_L_A + BGQ_UV;
constexpr int BGQ_AC = (AC_ITEMS + 7) / 8, BGQ_CB = (CB_ITEMS + 7) / 8, BGQ_L_AC = BGQ_L_UV + BGQ_AC + BGQ_CB;
constexpr int BGQ_TOTAL = BGQ_L_AC + bgq_cache_n(0) + bgq_cache_n(1) + bgq_cache_n(2) + bgq_cache_n(3);
constexpr int BGQ_CTR = 12288;
DI void bg_chunk(const FP& P, const Ctx& C, int c) {
    const int lane = C.lane;
    if (c < BGQ_T1) { int r = c * 8 + C.wave; LAS float* scr = (LAS float*)(C.lds + C.wave * 16384);
        if (r < T1_ITEMS) {
            if (r < T1_OA) transpose_item(P, col_woa, 512, P.WOA_T, scr, r, D_MODEL / 32, lane);
            else if ((r -= T1_OA) < T1_OB) transpose_item(P, col_wob, 1024, P.WOB_T, scr, r, D_MODEL / 32, lane);
            else if ((r -= T1_OB) < T1_B) transpose_item(P, col_wb, D_MODEL, P.WB_T, scr, r, NB_T / 32, lane);
            else transpose_item(P, col_cw1, 1024, P.CW1_T, scr, r - T1_B, 512 / 32, lane); }
        return; }
    if (c < BGQ_L_A) { wpk_item(P, C, c - BGQ_T1); return; }
    c -= BGQ_L_A;
    if (c < BGQ_UV) {
        { const int r = c * 16 + C.wave * 2; f32x4 a[16];
#pragma unroll
            for (int q = 0; q < 4; ++q) { const float* s0 = (q < 2 ? P.peer_u : P.peer_v) + (size_t)(r + (q & 1)) * D_MODEL + 16 * lane;
#pragma unroll
                for (int j = 0; j < 4; ++j) a[4 * q + j] = *(const f32x4*)(s0 + 4 * j); }
#pragma unroll
            for (int q = 0; q < 4; ++q) { const float sc = q < 2 ? 256.f : 64.f; unsigned w[4];
#pragma unroll
                for (int j = 0; j < 4; ++j) { const f32x4 v = a[4 * q + j] * sc; int t = __builtin_amdgcn_cvt_pk_fp8_f32(v.x, v.y, 0, false); t = __builtin_amdgcn_cvt_pk_fp8_f32(v.z, v.w, t, true); w[j] = (unsigned)t; }
                u32x4 o; o.x = w[0]; o.y = w[1]; o.z = w[2]; o.w = w[3]; *(u32x4*)((q < 2 ? P.UB8 : P.VB8) + (size_t)(r + (q & 1)) * D_MODEL + 16 * lane) = o; } }
        return; }
    c -= BGQ_UV;
    if (c < BGQ_AC) { const int it2 = c * 8 + C.wave;
        if (it2 < AC_ITEMS) { const int it = it2 / (PAGE_SIZE / 8), rg = it2 % (PAGE_SIZE / 8);
            const int n = it / (PAST_LEN / PAGE_SIZE), pi = it % (PAST_LEN / PAGE_SIZE); const int pg = P.page_table[it];
            const float* src = P.cache_nsa_kv + (size_t)pg * PAGE_SIZE * 512 + 4 * lane; const int ty = lane >> 5, kvh = (lane >> 4) & 1, d = (4 * lane) & 63;
            bf16* dst = P.AC + ((size_t)ty * ACROWS + ((size_t)(BATCH + n) * NSA_KV_HEADS + kvh) * NCH + pi * (PAGE_SIZE / 16)) * 1024 + d;
            const int r0 = rg * 8; f32x4 v[8];
#pragma unroll
            for (int u = 0; u < 8; ++u) v[u] = *(const f32x4*)(src + (size_t)(r0 + u) * 512);
#pragma unroll
            for (int u = 0; u < 8; ++u) { const int t = r0 + u; u32x2 o; o.x = pk2(v[u].x, v[u].y); o.y = pk2(v[u].z, v[u].w); *(u32x2*)(dst + (size_t)(t / 16) * 1024 + (t % 16) * 64) = o; } }
        return; }
    c -= BGQ_AC;
    if (c < BGQ_CB) { const int i = c * 8 + C.wave;
        if (i < CB_ITEMS) { const int ty = i / CMP_HIDDEN, hid = i % CMP_HIDDEN; float a = 0.f;
#pragma unroll 8
            for (int k = lane; k < CMP_BLOCK * HEAD_DIM; k += 64) a += P.cmp_pe[ty * CMP_BLOCK * HEAD_DIM + k] * P.cmp_w1[((size_t)ty * CMP_BLOCK * HEAD_DIM + k) * CMP_HIDDEN + hid];
            a = wave_sum(a); if (lane == 0) P.CBIAS[i] = a; }
        return; }
    c -= BGQ_CB;
    int g = 0; if (c >= bgq_cache_n(0)) { c -= bgq_cache_n(0); g = 1; if (c >= bgq_cache_n(1)) { c -= bgq_cache_n(1); g = 2; if (c >= bgq_cache_n(2)) { c -= bgq_cache_n(2); g = 3; } } }
    const int W = g < 3 ? dil_w(g) : SWA_WINDOW, RV = g < 3 ? 128 : 64;
    const f32x4* src = (const f32x4*)(g < 3 ? sel3c(P.cache_dil, g) : P.cache_nsa_win); f32x4* dst = (f32x4*)(g < 3 ? sel3(P.dil_s, g) : P.win_s);
    const int per = (W - 1) * RV, nvec = DEC_BATCH * per;
    const int i0 = c * 8192 + C.wave * 1024;
    if (i0 < nvec) { f32x4 v[16]; int idx[16];
        const int n0 = __builtin_amdgcn_readfirstlane((int)((unsigned)i0 / (unsigned)per)), o0 = i0 - n0 * per;
#pragma unroll
        for (int u = 0; u < 16; ++u) { int o = o0 + u * 64 + lane, n = n0; if (o >= per) { o -= per; ++n; } if (n >= DEC_BATCH) { n = DEC_BATCH - 1; o = per - 1; } idx[u] = n * (per + RV) + o; v[u] = src[(size_t)idx[u] + RV]; }
#pragma unroll
        for (int u = 0; u < 16; ++u) { const int i = i0 + u * 64 + lane; if (i < nvec) dst[(size_t)idx[u]] = v[u]; } }
}
DI void bgq_drain(const FP& P, const Ctx& C, volatile LAS unsigned* slot, int limit) {
#pragma unroll 1
    for (;;) {
        __syncthreads();
        if (C.tid == 0) *slot = atomicAdd(P.ctl + BGQ_CTR, 1u);
        __syncthreads();
        const int c = (int)*slot;
        if (c < BGQ_TOTAL) bg_chunk(P, C, c);
        if (c >= limit) break;
    }
    __syncthreads();
}
DI void xcd_barrier_bg(const XcdBarrier& b, const FP& P, const Ctx& C, volatile LAS unsigned* slot  ) {
    asm volatile("s_waitcnt vmcnt(0)" ::: "memory");
    __syncthreads();
    if (threadIdx.x == 0) {
        unsigned* bar = b.bar;
        __builtin_amdgcn_s_waitcnt(0);
        unsigned nloc = b.st[0], nx = b.st[1];
        if (nloc == 0u) { xcd_barrier_complete(bar, b.x, nloc, nx); b.st[0] = nloc; b.st[1] = nx; }
        const unsigned old = xb_add(&bar[XB_XSUB(b.x)], 1u);
        const unsigned gen = old / nloc;
        if (old + 1u == (gen + 1u) * nloc) {
            __builtin_amdgcn_fence(__ATOMIC_RELEASE, "agent");
            asm volatile("s_waitcnt vmcnt(0)" ::: "memory");
            const unsigned og = xb_add(&bar[XB_TOP], 1u);
            const unsigned tg = og / nx;
            if (og + 1u == (tg + 1u) * nx) xb_add(&bar[XB_TOPGEN], 1u);
            else XB_SPIN(xb_ld(&bar[XB_TOPGEN]) == tg, bar);
            __builtin_amdgcn_fence(__ATOMIC_ACQUIRE, "agent");
            xb_add(&bar[XB_XGEN(b.x)], 1u);
            asm volatile("s_waitcnt vmcnt(0)" ::: "memory");
            slot[2] = 1u;
        } else { slot[1] = gen; slot[2] = 0u; }
    }
    __syncthreads();
    unsigned spins = 0;
#pragma unroll 1
    while (slot[2] == 0u) {
        if (threadIdx.x == 0) {
            unsigned c = (unsigned)BGQ_TOTAL;
            if (xb_ld(&b.bar[XB_XGEN(b.x)]) != slot[1] || xb_ld(&b.bar[XB_TMO]) != 0u) {
                __builtin_amdgcn_fence(__ATOMIC_ACQUIRE, "agent");
                asm volatile("s_waitcnt vmcnt(0)" ::: "memory");
                slot[2] = 1u;
            } else if (xb_ld(P.ctl + BGQ_CTR) < (unsigned)BGQ_TOTAL) {
                const unsigned nloc = b.st[0], nx = b.st[1], gen = slot[1];
                const unsigned arr = xb_ld(&b.bar[XB_XSUB(b.x)]) - gen * nloc, top = xb_ld(&b.bar[XB_TOP]) - gen * nx;
                if (arr + 3u <= nloc || (arr >= nloc && top + 2u <= nx)) c = atomicAdd(P.ctl + BGQ_CTR, 1u);
                else __builtin_amdgcn_s_sleep(1);
            }
            else { __builtin_amdgcn_s_sleep(1); if (++spins > XB_SPIN_CAP) { atomicAdd(&b.bar[XB_TMO], 1u); } }
            slot[0] = c;
        }
        __syncthreads();
        const bool rel = slot[2] != 0u; const int c = (int)slot[0];
        if (!rel && c < BGQ_TOTAL) bg_chunk(P, C, c);
        __syncthreads();
    }
}
#define EPI_LOOP(...) int fr_l = fr, fq_l = fq; asm volatile("" : "+v"(fr_l), "+v"(fq_l));     \
    _Pragma("unroll") for (int ai = 0; ai < 2; ++ai) _Pragma("unroll") for (int m = 0; m < 4; ++m) { const int row = u.pm * 256 + ai * 128 + wr * 64 + m * 16 + fr_l; \
    _Pragma("unroll") for (int bj = 0; bj < 2; ++bj) { const int ct = bj * 128 + wc * 32 + fq_l * 8; const f32x4 v0 = acc[ai][bj][m][0], v1 = acc[ai][bj][m][1]; __VA_ARGS__ } asm volatile("" ::: "memory"); }
DI void rope4(const float* rope_row, int dp, const f32x4& v0, const f32x4& v1, f32x4& lo, f32x4& hi) {
    const f32x4 c = *(const f32x4*)(rope_row + dp), s = *(const f32x4*)(rope_row + 32 + dp);
    lo.x = v0.x * c.x - v0.y * s.x; hi.x = v0.y * c.x + v0.x * s.x; lo.y = v0.z * c.y - v0.w * s.y; hi.y = v0.w * c.y + v0.z * s.y;
    lo.z = v1.x * c.z - v1.y * s.z; hi.z = v1.y * c.z + v1.x * s.z; lo.w = v1.z * c.w - v1.w * s.w; hi.w = v1.w * c.w + v1.z * s.w; }
DI u32x2 pk4(const f32x4& v) { u32x2 o; o.x = pk2(v.x, v.y); o.y = pk2(v.z, v.w); return o; }
DI u32x4 pk8(const f32x4& a, const f32x4& b) { u32x4 o; o.x = pk2(a.x, a.y); o.y = pk2(a.z, a.w); o.z = pk2(b.x, b.y); o.w = pk2(b.z, b.w); return o; }
DI int dil_perm(int t, int d) { return (t % d) * (SEQ / d) + t / d; }
#ifdef EPIA_REP
#define EPIA_REP_BEGIN _Pragma("unroll 1") for (int rep_ = 0; rep_ < EPIA_REP; ++rep_) {
#define EPIA_REP_END }
#else
#define EPIA_REP_BEGIN
#define EPIA_REP_END
#endif
struct EpiA {
    static constexpr bool PERM = true, AFTER_DRAIN = false; const FP& P;
    DI void operator()(const f32x4 (&acc)[2][2][4][2], const pg8::Unit& u, int wr, int wc, int fr, int fq) const {
        const int t9 = u.pn; const int g = t9 / 3, j = t9 % 3;
        EPIA_REP_BEGIN EPI_LOOP({ if (row < MP) { const int h = ct >> 6, e = ct & 63; const int pos = row_pos(row);
            if (t9 == 9) { *(u32x4*)(P.MQA + (size_t)row * 256 + ct) = pk8(v0 * QSCALE, v1 * QSCALE); }
            else if (j < 2) { f32x4 lo, hi; const int dp = e >> 1; rope4(P.ROPE + pos * 64, dp, v0, v1, lo, hi);
                if (j == 0) { bf16* q = P.QA + ((size_t)g * MPAD + row) * 256 + h * 64 + dp; *(u32x2*)q = pk4(lo * QSCALE); *(u32x2*)(q + 32) = pk4(hi * QSCALE); }
                else { if (row < M0) { bf16* kt = P.KA + ((size_t)(g * BATCH + row / SEQ) * DIL_HEADS + h) * 64 * SEQ; const int cm = dil_perm(pos, dil_d(g)); *(u32x2*)(kt + ktile_off(cm, dp)) = pk4(lo); *(u32x2*)(kt + ktile_off(cm, dp + 32)) = pk4(hi); }
                    const int W = dil_w(g); float* o = nullptr;
                    if (row >= M0) o = sel3(P.dil_s, g) + (((size_t)(row - M0) * W + W - 1) * 2 + 0) * 256; else if (pos >= SEQ - W) o = sel3(P.dil_p, g) + (((size_t)(row / SEQ) * W + pos - (SEQ - W)) * 2 + 0) * 256;
                    if (o) { *(f32x4*)(o + h * 64 + dp) = lo; *(f32x4*)(o + h * 64 + 32 + dp) = hi; } } }
            else { const int W = dil_w(g), d = dil_d(g); float* o = nullptr;
                if (row >= M0) o = sel3(P.dil_s, g) + (((size_t)(row - M0) * W + W - 1) * 2 + 1) * 256; else if (pos >= SEQ - W) o = sel3(P.dil_p, g) + (((size_t)(row / SEQ) * W + pos - (SEQ - W)) * 2 + 1) * 256;
                if (o) { *(f32x4*)(o + ct) = v0; *(f32x4*)(o + ct + 4) = v1; }
                if (row < M0) { bf16* vt = P.VTA + ((size_t)(g * BATCH + row / SEQ) * DIL_HEADS + h) * 64 * SEQ + vtile_off(e, dil_perm(pos, d));
                    vt[0] = (bf16)f2bf(v0.x); vt[8] = (bf16)f2bf(v0.y); vt[16] = (bf16)f2bf(v0.z); vt[24] = (bf16)f2bf(v0.w); vt[32] = (bf16)f2bf(v1.x); vt[40] = (bf16)f2bf(v1.y); vt[48] = (bf16)f2bf(v1.z); vt[56] = (bf16)f2bf(v1.w); } } } }) EPIA_REP_END
    }
};
struct EpiMem {
    static constexpr bool PERM = true, AFTER_DRAIN = false; const FP& P;
    DI void operator()(const f32x4 (&acc)[2][2][4][2], const pg8::Unit& u, int wr, int wc, int fr, int fq) const {
        const int l = u.pn >> 1, half = u.pn & 1;
        EPI_LOOP({ const int n = row / MEM_TOKENS, mt = row % MEM_TOKENS; float* o = P.mem_kv_p + (((size_t)l * BATCH + n) * MEM_TOKENS + mt) * 512 + half * 256 + ct; *(f32x4*)o = v0; *(f32x4*)(o + 4) = v1;
            if (half == 0) *(u32x4*)(P.MK + (((size_t)l * BATCH + n) * MEM_HEADS + (ct >> 6)) * MEM_TOKENS * 64 + ktile_off(mt, ct & 63)) = pk8(v0, v1);
            else { bf16* vt = P.MVT + (((size_t)l * BATCH + n) * MEM_HEADS + (ct >> 6)) * MEM_TOKENS * 64 + vtile_off(ct & 63, mt);
                vt[0] = (bf16)f2bf(v0.x); vt[8] = (bf16)f2bf(v0.y); vt[16] = (bf16)f2bf(v0.z); vt[24] = (bf16)f2bf(v0.w); vt[32] = (bf16)f2bf(v1.x); vt[40] = (bf16)f2bf(v1.y); vt[48] = (bf16)f2bf(v1.z); vt[56] = (bf16)f2bf(v1.w); } })
    }
};
struct EpiPre {
    static constexpr bool PERM = true, AFTER_DRAIN = false; const float* xa; const float* xb; float* pre;
    DI void operator()(const f32x4 (&acc)[2][2][4][2], const pg8::Unit& u, int wr, int wc, int fr, int fq) const {
        EPI_LOOP({ if (row < MP) { const int col = u.pn * 256 + ct; const float* x = (xb && row >= M0) ? xb + (size_t)(row - M0) * D_MODEL + col : xa + (size_t)row * D_MODEL + col;
            const f32x4 a = *(const f32x4*)x, b = *(const f32x4*)(x + 4); float* o = pre + (size_t)row * D_MODEL + col; *(f32x4*)o = a * ALPHA + v0; *(f32x4*)(o + 4) = b * ALPHA + v1; } })
    }
};
struct EpiF32 {
    static constexpr bool PERM = true, AFTER_DRAIN = false; float* out; int ldc; int nrows;
    DI void operator()(const f32x4 (&acc)[2][2][4][2], const pg8::Unit& u, int wr, int wc, int fr, int fq) const {
        EPI_LOOP({ if (row < nrows) { float* o = out + (size_t)row * ldc + u.pn * 256 + ct; *(f32x4*)o = v0; *(f32x4*)(o + 4) = v1; } })
    }
};
}
namespace fx {
struct Tile16 { f32x4 o[4]; float m, l; };
DI void tile_init(Tile16& T) { T.o[0] = T.o[1] = T.o[2] = T.o[3] = (f32x4){0.f, 0.f, 0.f, 0.f}; T.m = -INFINITY; T.l = 0.f; }
typedef __bf16 bf16x2_t __attribute__((ext_vector_type(2)));
DI unsigned cvtpk(float lo, float hi) { const f32x2 v = {lo, hi}; const bf16x2_t b = __builtin_convertvector(v, bf16x2_t); return __builtin_bit_cast(unsigned, b); }
struct KV8 { bf16x8 ka0, ka1, kb0, kb1, v0, v1, v2, v3; };
DI void kv_load(KV8& r, const bf16* k0, const bf16* k1, const bf16* v, long vs16) {
    r.ka0 = *(const bf16x8*)k0; r.ka1 = *(const bf16x8*)(k0 + 32); r.kb0 = *(const bf16x8*)k1; r.kb1 = *(const bf16x8*)(k1 + 32);
    r.v0 = *(const bf16x8*)v; r.v1 = *(const bf16x8*)(v + vs16); r.v2 = *(const bf16x8*)(v + 2 * vs16); r.v3 = *(const bf16x8*)(v + 3 * vs16); }
DI void mk_range(int a, int b, bool ok, int& lo, unsigned& rng) { const bool v = ok && b >= a; lo = v ? a : (1 << 20); rng = v ? (unsigned)(b - a) : 0u; }
DI float colmax(float x) { float a = x, b = x; asm volatile("s_nop 1\n\tv_permlane32_swap_b32 %0, %1" : "+v"(a), "+v"(b)); float m = fmaxf(a, b); a = m; b = m;
    asm volatile("s_nop 1\n\tv_permlane16_swap_b32 %0, %1" : "+v"(a), "+v"(b)); return fmaxf(a, b); }
DI float colsum(float x) { float a = x, b = x; asm volatile("s_nop 1\n\tv_permlane32_swap_b32 %0, %1" : "+v"(a), "+v"(b)); float m = a + b; a = m; b = m;
    asm volatile("s_nop 1\n\tv_permlane16_swap_b32 %0, %1" : "+v"(a), "+v"(b)); return a + b; }
DI void tile_compute(Tile16& T, const bf16x8 (&qf)[2], const KV8& r, int lo, unsigned rng) {
    f32x4 s0 = (f32x4){0.f, 0.f, 0.f, 0.f}, s1 = (f32x4){0.f, 0.f, 0.f, 0.f};
    s0 = __builtin_amdgcn_mfma_f32_16x16x32_bf16(r.ka0, qf[0], s0, 0, 0, 0); s0 = __builtin_amdgcn_mfma_f32_16x16x32_bf16(r.ka1, qf[1], s0, 0, 0, 0);
    s1 = __builtin_amdgcn_mfma_f32_16x16x32_bf16(r.kb0, qf[0], s1, 0, 0, 0); s1 = __builtin_amdgcn_mfma_f32_16x16x32_bf16(r.kb1, qf[1], s1, 0, 0, 0);
    float s[8] = {s0.x, s0.y, s0.z, s0.w, s1.x, s1.y, s1.z, s1.w};
    float mx = -INFINITY;
#pragma unroll
    for (int e = 0; e < 8; ++e) { s[e] = ((unsigned)(e - lo) <= rng) ? s[e] : -INFINITY; mx = fmaxf(mx, s[e]); }
    mx = colmax(mx);
    if (__builtin_amdgcn_ballot_w64(mx > T.m + 8.f) != 0ull) {
        const float mnew = fmaxf(T.m, mx), mu = (mnew == -INFINITY) ? 0.f : mnew; const float alpha = __builtin_amdgcn_exp2f(T.m - mu);
        T.l *= alpha; T.m = mnew; T.o[0] *= alpha; T.o[1] *= alpha; T.o[2] *= alpha; T.o[3] *= alpha; }
    const float muse = (T.m == -INFINITY) ? 0.f : T.m;
    float ls = 0.f;
#pragma unroll
    for (int e = 0; e < 8; ++e) { s[e] = __builtin_amdgcn_exp2f(s[e] - muse); ls += s[e]; }
    T.l += ls;
    u32x4 pw; pw.x = cvtpk(s[0], s[1]); pw.y = cvtpk(s[2], s[3]); pw.z = cvtpk(s[4], s[5]); pw.w = cvtpk(s[6], s[7]);
    const bf16x8 pf = __builtin_bit_cast(bf16x8, pw);
    T.o[0] = __builtin_amdgcn_mfma_f32_16x16x32_bf16(r.v0, pf, T.o[0], 0, 0, 0); T.o[1] = __builtin_amdgcn_mfma_f32_16x16x32_bf16(r.v1, pf, T.o[1], 0, 0, 0);
    T.o[2] = __builtin_amdgcn_mfma_f32_16x16x32_bf16(r.v2, pf, T.o[2], 0, 0, 0); T.o[3] = __builtin_amdgcn_mfma_f32_16x16x32_bf16(r.v3, pf, T.o[3], 0, 0, 0);
}
template <class BUF, class LD, class CP> DI void pipe2t(int n, LD ld, CP cp) { if (n <= 0) return; BUF A, B; ld(A, 0);
#pragma unroll 1
    for (int i = 0; i < n; i += 2) { ld(B, (i + 1 < n) ? i + 1 : i); cp(A, i); ld(A, (i + 2 < n) ? i + 2 : i); if (i + 1 < n) cp(B, i + 1); } }
template <class LD, class CP> DI void pipe2(int n, LD ld, CP cp) { if (n <= 0) return; KV8 A, B; ld(A, 0);
#pragma unroll 1
    for (int i = 0; i < n; i += 2) { ld(B, (i + 1 < n) ? i + 1 : i); cp(A, i); ld(A, (i + 2 < n) ? i + 2 : i); if (i + 1 < n) cp(B, i + 1); } }
DI void kv_load_t(KV8& r, const bf16* kt, const bf16* vt, int lane) {
    const bf16* k = kt + lane * 8; const bf16* v = vt + lane * 8;
    r.ka0 = *(const bf16x8*)k; r.ka1 = *(const bf16x8*)(k + 512); r.kb0 = *(const bf16x8*)(k + 1024); r.kb1 = *(const bf16x8*)(k + 1536);
    r.v0 = *(const bf16x8*)v; r.v1 = *(const bf16x8*)(v + 512); r.v2 = *(const bf16x8*)(v + 1024); r.v3 = *(const bf16x8*)(v + 1536); }
DI int krow_of(int i, int b) { return 8 * (i >> 2) + 4 * b + (i & 3); }

DI void dil_micro(const FP& P, int n, int h, int t0, int mt, int lane) {
    const int g = mt >> 4, idx = mt & 15, d = dil_d(g), per = 16 / d;
    const int r = idx / per, sub = idx % per, i0 = t0 / d + 16 * sub, ib = i0 - 128, NC = SEQ / d;
    const int q = lane & 15, c = lane >> 4;
    const bf16* Qb = P.QA + ((size_t)g * MPAD + (size_t)n * SEQ) * 256 + h * 64;
    const bf16* Kb = P.KA + ((size_t)(g * BATCH + n) * DIL_HEADS + h) * 64 * SEQ + (size_t)r * NC * 64; const bf16* Vb = P.VTA + ((size_t)(g * BATCH + n) * DIL_HEADS + h) * 64 * SEQ + (size_t)r * NC * 64;
    bf16x8 qf[2]; { const bf16* qp = Qb + (size_t)(r + d * (i0 + q)) * 256 + 8 * c; qf[0] = *(const bf16x8*)qp; qf[1] = *(const bf16x8*)(qp + 32); }
    Tile16 T; tile_init(T);
    const int qi = i0 + q; const int tb0 = ib >> 5  , nblk = ((i0 + 15) >> 5) - tb0 + 1;
    pipe2(nblk, [&](KV8& kv, int i) { int tb = tb0 + i; tb = tb < 0 ? 0 : tb; kv_load_t(kv, Kb + (size_t)tb * 2048, Vb + (size_t)tb * 2048, lane); },
          [&](const KV8& kv, int i) { const int k0 = 32 * (tb0 + i) + 8 * c; int lo; unsigned rng; const int a = qi - (DIL_TAPS - 1); mk_range((a > 0 ? a : 0) - k0, qi - k0, true, lo, rng); tile_compute(T, qf, kv, lo, rng); });
    const int row = n * SEQ + r + d * qi;
    float* op = P.DPART + (((size_t)g * MP + row) * DIL_HEADS + h) * 64 + 4 * c;
#pragma unroll
    for (int db = 0; db < 4; ++db) *(f32x4*)(op + 16 * db) = T.o[db];
    T.l = colsum(T.l);
    if (c == 0) { float* ml = P.DML + (((size_t)g * MP + row) * DIL_HEADS + h) * 2; ml[0] = T.m; ml[1] = T.l; }
}
DI void mem_micro(const FP& P, const bf16* Q  , int ldq, int row0, int layer, int n, int h, bf16* O  , int ldo, int lane) {
    const int q = lane & 15, c = lane >> 4;
    bf16x8 qf[2]; { const bf16* qp = Q + (size_t)(row0 + q) * ldq + 8 * c; qf[0] = *(const bf16x8*)qp; qf[1] = *(const bf16x8*)(qp + 32); }
    const bf16* Kb = P.MK + (((size_t)layer * BATCH + n) * MEM_HEADS + h) * MEM_TOKENS * 64; const bf16* Vb = P.MVT + (((size_t)layer * BATCH + n) * MEM_HEADS + h) * MEM_TOKENS * 64;
    Tile16 T; tile_init(T);
    pipe2(MEM_TOKENS / 32, [&](KV8& kv, int i) { kv_load_t(kv, Kb + (size_t)i * 2048, Vb + (size_t)i * 2048, lane); }, [&](const KV8& kv, int) { tile_compute(T, qf, kv, -8, 64u); });
    const float inv = 1.0f / colsum(T.l); bf16* op = O + (size_t)(row0 + q) * ldo + 4 * c;
#pragma unroll
    for (int db = 0; db < 4; ++db) *(u32x2*)(op + 16 * db) = pk4(T.o[db] * inv);
}
struct Dec { float m, l, o; };
template <class KF, class VF> DI void dec_chunk(Dec& D, const LAS float* q, int nk, KF kf, VF vf, int lane) {
    float s = -INFINITY;
    if (lane < nk) { const float* k = kf(lane); float a = 0.f;
#pragma unroll
        for (int d4 = 0; d4 < 16; ++d4) { const f32x4 kv = *(const f32x4*)(k + 4 * d4); a += kv.x * q[4 * d4] + kv.y * q[4 * d4 + 1] + kv.z * q[4 * d4 + 2] + kv.w * q[4 * d4 + 3]; }
        s = a; }
    const float mx = wave_max(s), mnew = fmaxf(D.m, mx), alpha = __builtin_amdgcn_exp2f(D.m - mnew);
    const float p = (lane < nk) ? __builtin_amdgcn_exp2f(s - mnew) : 0.f;
    D.l = D.l * alpha + wave_sum(p); D.m = mnew; float o = D.o * alpha;
    for (int j0 = 0; j0 < nk; j0 += 8) { float vv[8];
#pragma unroll
        for (int u = 0; u < 8; ++u) { const int jj = (j0 + u < nk) ? j0 + u : nk - 1; vv[u] = vf(jj)[lane]; }
#pragma unroll
        for (int u = 0; u < 8; ++u) { const float pj = (j0 + u < nk) ? __builtin_bit_cast(float, __builtin_amdgcn_readlane(__builtin_bit_cast(int, p), (j0 + u) & 63)) : 0.f; o += pj * vv[u]; } }
    D.o = o;
}
DI float dec_combine(const Ctx& C, const Dec& D) {
    LAS float* cb = (LAS float*)(C.lds + 4096);
    cb[C.wave * 66 + C.lane] = D.o; if (C.lane == 0) { cb[C.wave * 66 + 64] = D.m; cb[C.wave * 66 + 65] = D.l; }
    asm volatile("s_waitcnt lgkmcnt(0)" ::: "memory"); __syncthreads();
    float M = -INFINITY;
#pragma unroll
    for (int ww = 0; ww < NWAVES; ++ww) M = fmaxf(M, cb[ww * 66 + 64]);
    float L = 0.f, o = 0.f;
#pragma unroll
    for (int ww = 0; ww < NWAVES; ++ww) { const float mw = cb[ww * 66 + 64]; const float f = (mw == -INFINITY) ? 0.f : __builtin_amdgcn_exp2f(mw - M); L += f * cb[ww * 66 + 65]; o += f * cb[ww * 66 + C.lane]; }
    return o / L;
}
DI void atta_phase(const FP& P, const Ctx& C) {
    const int lane = C.lane, w = C.wave;
    constexpr int NT = SEQ / 256, NIT = BATCH * NT * DIL_HEADS;
    for (int it = C.vcu; it < NIT; it += C.G) { const int h = it % DIL_HEADS, tt = (it / DIL_HEADS) % NT, n = it / (DIL_HEADS * NT), t0 = tt * 256;
        for (int mt = w; mt < 48; mt += NWAVES) dil_micro(P, n, h, t0, mt, lane);
        asm volatile("s_waitcnt vmcnt(0)" ::: "memory"); __syncthreads();
        for (int i = C.tid; i < 256 * 16; i += NTHREADS) { const int tk = i >> 4, d4 = (i & 15) * 4; const int row = n * SEQ + t0 + tk;
            float mg[3], lg[3]; float M = -INFINITY;
#pragma unroll
            for (int g = 0; g < 3; ++g) { const float* ml = P.DML + (((size_t)g * MP + row) * DIL_HEADS + h) * 2; mg[g] = ml[0]; lg[g] = ml[1]; M = fmaxf(M, mg[g]); }
            f32x4 acc = (f32x4){0.f, 0.f, 0.f, 0.f}; float L = 0.f;
#pragma unroll
            for (int g = 0; g < 3; ++g) { const float wg = __builtin_amdgcn_exp2f(mg[g] - M); L += wg * lg[g]; acc += *(const f32x4*)(P.DPART + (((size_t)g * MP + row) * DIL_HEADS + h) * 64 + d4) * wg; }
            *(u32x2*)(P.ATTA + (size_t)row * 512 + h * 64 + d4) = pk4(acc * (1.0f / L)); }
        for (int mt = w; mt < 16; mt += NWAVES) mem_micro(P, P.MQA + h * 64, 256, n * SEQ + t0 + 16 * mt, 0, n, h, P.ATTA + 256 + h * 64, 512, lane);
        __syncthreads();
    }
    LAS float* qs = (LAS float*)C.lds;
    for (int it = C.vcu; it < DEC_BATCH * DIL_HEADS * 2; it += C.G) { const int kind = it & 1, h = (it >> 1) % DIL_HEADS, ns = (it >> 1) / DIL_HEADS, row = M0 + ns;
        __syncthreads();
        if (kind == 0) { if (C.tid < 192) qs[C.tid] = bf2f(P.QA[((size_t)(C.tid >> 6) * MPAD + row) * 256 + h * 64 + (C.tid & 63)]); } else { if (C.tid < 64) qs[C.tid] = bf2f(P.MQA[(size_t)row * 256 + h * 64 + C.tid]); }
        asm volatile("s_waitcnt lgkmcnt(0)" ::: "memory"); __syncthreads();
        Dec D; D.m = -INFINITY; D.l = 0.f; D.o = 0.f;
        if (kind == 0) { constexpr int CPG = (DIL_TAPS + 63) / 64;
            for (int ck = w; ck < 3 * CPG; ck += NWAVES) { const int g = ck / CPG, j0 = (ck % CPG) * 64; const int W = dil_w(g), d = dil_d(g); const float* cache = sel3c(P.cache_dil, g) + (size_t)ns * W * 512; const float* newrow = sel3(P.dil_s, g) + ((size_t)ns * W + W - 1) * 512;
                const int nk = (DIL_TAPS - j0) < 64 ? (DIL_TAPS - j0) : 64;
                dec_chunk(D, qs + g * 64, nk, [&](int j) { const int tap = j0 + j; return (tap == 0 ? newrow : cache + (size_t)(W - d * tap) * 512) + h * 64; },
                          [&](int j) { const int tap = j0 + j; return (tap == 0 ? newrow : cache + (size_t)(W - d * tap) * 512) + 256 + h * 64; }, lane); } }
        else { const float* mk = P.cache_mem_kv + ((size_t)0 * DEC_BATCH + ns) * MEM_TOKENS * 512;
            for (int ck = w; ck < MEM_TOKENS / 64; ck += NWAVES) { const int j0 = ck * 64; dec_chunk(D, qs, 64, [&](int j) { return mk + (size_t)(j0 + j) * 512 + h * 64; }, [&](int j) { return mk + (size_t)(j0 + j) * 512 + 256 + h * 64; }, lane); } }
        const float o = dec_combine(C, D);
        if (w == 0) P.ATTA[(size_t)row * 512 + (kind == 0 ? 0 : 256) + h * 64 + lane] = (bf16)f2bf(o);
    }
    __syncthreads();
}
DI void ln_phase(const FP& P, const Ctx& C, const float* pre, const float* gam, const float* bet, float* xo, bf16* xb, float* yp, float* ys) {
    const int gw = C.vcu * NWAVES + C.wave, NGW = C.G * NWAVES, lane = C.lane;
    for (int r = gw; r < MP; r += NGW) { const float* x = pre + (size_t)r * D_MODEL; f32x4 v[4]; float s = 0.f;
#pragma unroll
        for (int j = 0; j < 4; ++j) { v[j] = *(const f32x4*)(x + 256 * j + 4 * lane); s += (v[j].x + v[j].y) + (v[j].z + v[j].w); }
        const float mu = wave_sum(s) * (1.0f / D_MODEL); float s2 = 0.f;
#pragma unroll
        for (int j = 0; j < 4; ++j) { v[j] = v[j] - mu; s2 += (v[j].x * v[j].x + v[j].y * v[j].y) + (v[j].z * v[j].z + v[j].w * v[j].w); }
        const float rs = 1.0f / sqrtf(wave_sum(s2) * (1.0f / D_MODEL) + LN_EPS);
#pragma unroll
        for (int j = 0; j < 4; ++j) { const f32x4 gg = *(const f32x4*)(gam + 256 * j + 4 * lane), bb = *(const f32x4*)(bet + 256 * j + 4 * lane); const f32x4 o = v[j] * rs * gg + bb;
            if (xo) *(f32x4*)(xo + (size_t)r * D_MODEL + 256 * j + 4 * lane) = o;
            if (xb) *(u32x2*)(xb + (size_t)r * D_MODEL + 256 * j + 4 * lane) = pk4(o);
            if (yp) { if (r < M0) *(f32x4*)(yp + (size_t)r * D_MODEL + 256 * j + 4 * lane) = o; else *(f32x4*)(ys + (size_t)(r - M0) * D_MODEL + 256 * j + 4 * lane) = o; } }
    }
}
}
namespace fx {
#define INS16(V, I, v_, i_) do { const float _v = (v_); const int _i = (i_); bool _c[16]; _Pragma("unroll") for (int _k = 0; _k < 16; ++_k) _c[_k] = _v > V[_k]; \
    _Pragma("unroll") for (int _k = 15; _k >= 1; --_k) { V[_k] = _c[_k] ? (_c[_k - 1] ? V[_k - 1] : _v) : V[_k]; I[_k] = _c[_k] ? (_c[_k - 1] ? I[_k - 1] : _i) : I[_k]; } \
    V[0] = _c[0] ? _v : V[0]; I[0] = _c[0] ? _i : I[0]; } while (0)
DI void wave_top16_128(float a, float b, int lane, float& outv, int& outi) {
    outv = -INFINITY; outi = 0;
#pragma unroll 1
    for (int k = 0; k < 16; ++k) { const float m = wave_max(fmaxf(a, b)); const unsigned long long ba = __ballot(a == m), bb = __ballot(b == m); int idx;
        if (ba) { const int l = __builtin_ctzll(ba); idx = l; if (lane == l) a = -INFINITY; } else { const int l = __builtin_ctzll(bb); idx = 64 + l; if (lane == l) b = -INFINITY; }
        if (lane == k) { outv = m; outi = idx; } }
}
DI void topk_wave_item(const FP& P, long it, int lane) {
    const float* s = P.SCO + it * 256; float v1, v2; int i1, i2;
    wave_top16_128(s[lane], s[64 + lane], lane, v1, i1); wave_top16_128(s[128 + lane], s[192 + lane], lane, v2, i2);
    int a = 0, rem = lane; bool valid = false;
    for (int aa = 0; aa < 16; ++aa) { const int nb = 16 / (aa + 1); if (!valid) { if (rem < nb) { a = aa; valid = true; } else rem -= nb; } }
    const int b = valid ? rem : 0;
    float cs = __shfl(v1, a) + __shfl(v2, b); const int ce = __shfl(i1, a) * PEER_KEYS + __shfl(i2, b); if (!valid) cs = -INFINITY;
    float tv = -INFINITY; int te = 0;
#pragma unroll 1
    for (int k = 0; k < 16; ++k) { const float m = wave_max(cs); const unsigned long long bm = __ballot(cs == m); const int l = __builtin_ctzll(bm); const int e = __shfl(ce, l); if (lane == l) cs = -INFINITY; if (lane == k) { tv = m; te = e; } }
    const float mx = __shfl(tv, 0); const float ex = (lane < 16) ? __expf(tv - mx) : 0.f; const float z = wave_sum(ex);
    if (lane < 16) { P.SELG[it * 16 + lane] = ex / z; P.SELE[it * 16 + lane] = te; }
}
#define KINS16(V, key_) do { const float _key = (key_); _Pragma("unroll") for (int _k = 15; _k >= 1; --_k) V[_k] = __builtin_amdgcn_fmed3f(V[_k - 1], V[_k], _key); V[0] = fmaxf(V[0], _key); } while (0)
DI float pack_key(float v, unsigned lowbits, unsigned mask) { return __builtin_bit_cast(float, (__builtin_bit_cast(unsigned, v) & ~mask) | lowbits); }
DI void topk_phase(const FP& P, const Ctx& C) {
    const int lane = C.lane; LAS float* st = (LAS float*)(C.lds + C.wave * 16384);
    const int NWI = (M0 * PEER_HEADS) / 64;
    for (int wi = C.vcu * NWAVES + C.wave; wi < NWI; wi += C.G * NWAVES) {
        const long it0 = (long)wi * 64; const long it = it0 + lane;
        float V1[16], V2[16], V3[16];
#pragma unroll
        for (int k = 0; k < 16; ++k) { V1[k] = V2[k] = V3[k] = -INFINITY; }
#pragma unroll 1
        for (int ch = 0; ch < 8; ++ch) {
#pragma unroll
            for (int u = 0; u < 8; ++u) { const int f4 = u * 64 + lane, j = f4 >> 3, q = f4 & 7, hf = q >> 2, c4 = (q & 3) * 4; const long itj = it0 + j;
                const f32x4 v = *(const f32x4*)(P.SCO + itj * 256 + hf * 128 + ch * 16 + c4);
                st[j * 33 + hf * 16 + c4] = v.x; st[j * 33 + hf * 16 + c4 + 1] = v.y; st[j * 33 + hf * 16 + c4 + 2] = v.z; st[j * 33 + hf * 16 + c4 + 3] = v.w; }
            asm volatile("s_waitcnt lgkmcnt(0)" ::: "memory");
#pragma unroll 4
            for (int c = 0; c < 16; ++c) { const float va = st[lane * 33 + c], vb = st[lane * 33 + 16 + c]; const unsigned lb = 127u - (unsigned)(ch * 16 + c); KINS16(V1, pack_key(va, lb, 127u)); KINS16(V2, pack_key(vb, lb, 127u)); }
            asm volatile("s_waitcnt lgkmcnt(0)" ::: "memory");
        }
        LAS int* lc = (LAS int*)st;
        { int ord = 0;
#pragma unroll
          for (int a = 0; a < 16; ++a) { const unsigned ba = __builtin_bit_cast(unsigned, V1[a]); const float va = __builtin_bit_cast(float, ba & ~127u); const int ia = 127 - (int)(ba & 127u);
#pragma unroll
              for (int b = 0; b < 16; ++b) if ((a + 1) * (b + 1) <= 16) { const unsigned bb = __builtin_bit_cast(unsigned, V2[b]); const float vb = __builtin_bit_cast(float, bb & ~127u); const int ib = 127 - (int)(bb & 127u);
                  lc[lane * 51 + ord] = ia * PEER_KEYS + ib; KINS16(V3, pack_key(va + vb, 63u - (unsigned)ord, 63u)); ++ord; } } }
        asm volatile("s_waitcnt lgkmcnt(0)" ::: "memory");
        float g[16]; int e[16]; float z = 0.f; const float vmax = __builtin_bit_cast(float, __builtin_bit_cast(unsigned, V3[0]) & ~63u);
#pragma unroll
        for (int k = 0; k < 16; ++k) { const unsigned bk = __builtin_bit_cast(unsigned, V3[k]); e[k] = lc[lane * 51 + 63 - (int)(bk & 63u)]; g[k] = __expf(__builtin_bit_cast(float, bk & ~63u) - vmax); z += g[k]; }
        const float iz = 1.0f / z;
#pragma unroll
        for (int k4 = 0; k4 < 4; ++k4) { *(f32x4*)(P.SELG + it * 16 + 4 * k4) = (f32x4){g[4 * k4] * iz, g[4 * k4 + 1] * iz, g[4 * k4 + 2] * iz, g[4 * k4 + 3] * iz};
            *(int4*)(P.SELE + it * 16 + 4 * k4) = make_int4(e[4 * k4], e[4 * k4 + 1], e[4 * k4 + 2], e[4 * k4 + 3]); }
        asm volatile("s_waitcnt lgkmcnt(0)" ::: "memory");
    }
    for (int si = C.vcu * NWAVES + C.wave; si < DEC_BATCH * PEER_HEADS; si += C.G * NWAVES) topk_wave_item(P, (long)M0 * PEER_HEADS + si, lane);
    __syncthreads();
}
constexpr float PEER_SU = 256.f, PEER_SV = 64.f;
DI float dot16_fp8(const u32x4& w, const f32x2 (&x2)[8]) { f32x2 a = {0.f, 0.f};
    a += __builtin_amdgcn_cvt_pk_f32_fp8((int)w.x, false) * x2[0]; a += __builtin_amdgcn_cvt_pk_f32_fp8((int)w.x, true) * x2[1];
    a += __builtin_amdgcn_cvt_pk_f32_fp8((int)w.y, false) * x2[2]; a += __builtin_amdgcn_cvt_pk_f32_fp8((int)w.y, true) * x2[3];
    a += __builtin_amdgcn_cvt_pk_f32_fp8((int)w.z, false) * x2[4]; a += __builtin_amdgcn_cvt_pk_f32_fp8((int)w.z, true) * x2[5];
    a += __builtin_amdgcn_cvt_pk_f32_fp8((int)w.w, false) * x2[6]; a += __builtin_amdgcn_cvt_pk_f32_fp8((int)w.w, true) * x2[7];
    return a.x + a.y; }
DI void axpy16_fp8(const u32x4& w, float s, f32x2 (&o2)[8]) { const f32x2 s2 = {s, s};
    o2[0] += __builtin_amdgcn_cvt_pk_f32_fp8((int)w.x, false) * s2; o2[1] += __builtin_amdgcn_cvt_pk_f32_fp8((int)w.x, true) * s2;
    o2[2] += __builtin_amdgcn_cvt_pk_f32_fp8((int)w.y, false) * s2; o2[3] += __builtin_amdgcn_cvt_pk_f32_fp8((int)w.y, true) * s2;
    o2[4] += __builtin_amdgcn_cvt_pk_f32_fp8((int)w.z, false) * s2; o2[5] += __builtin_amdgcn_cvt_pk_f32_fp8((int)w.z, true) * s2;
    o2[6] += __builtin_amdgcn_cvt_pk_f32_fp8((int)w.w, false) * s2; o2[7] += __builtin_amdgcn_cvt_pk_f32_fp8((int)w.w, true) * s2; }
#if defined(PEER_SHARD) || defined(PEER_SHARD2)
#define PEER_FIRST_ROUND nrounds
#else
#define PEER_FIRST_ROUND 0
#endif
template <int CTRL> DI float dppf(float x) { return __builtin_bit_cast(float, __builtin_amdgcn_update_dpp(0, __builtin_bit_cast(int, x), CTRL, 0xF, 0xF, true)); }
DI float rdlane(float v, int l) { return __builtin_bit_cast(float, __builtin_amdgcn_readlane(__builtin_bit_cast(int, v), l)); }
DI void peer_phase(const FP& P, const Ctx& C, int layer, const float* xin, float* fout, float* fout_s, bf16* xb, bool samples_only = false) {
    const int lane = C.lane; const unsigned char* U = P.UB8 + (size_t)layer * PEER_EXPERTS * D_MODEL; const unsigned char* Vt = P.VB8 + (size_t)layer * PEER_EXPERTS * D_MODEL;
    const float* gam = P.ln_g + ((size_t)layer * 2 + 1) * D_MODEL; const float* bet = P.ln_b + ((size_t)layer * 2 + 1) * D_MODEL;
    const int nrounds = (M0 + C.G * NWAVES - 1) / (C.G * NWAVES);
#pragma unroll 1
    for (int rd = samples_only ? nrounds : 0; rd <= nrounds; ++rd) {
        const bool smp = (rd == nrounds); int r = smp ? M0 + C.vcu : rd * C.G * NWAVES + C.vcu * NWAVES + C.wave; if (smp ? (C.vcu >= DEC_BATCH) : (r >= M0)) continue;
        const int pb = smp ? 16 * C.wave : 0, pe = smp ? pb + 16 : 128;
        f32x2 x2[8], o2[8];
#pragma unroll
        for (int j = 0; j < 4; ++j) { const f32x4 a = *(const f32x4*)(xin + (size_t)r * D_MODEL + 16 * lane + 4 * j); x2[2 * j] = (f32x2){a.x, a.y}; x2[2 * j + 1] = (f32x2){a.z, a.w}; }
#pragma unroll
        for (int k = 0; k < 8; ++k) o2[k] = (f32x2){0.f, 0.f};
        const int e_l = P.SELE[(size_t)r * 128 + lane], e_h = P.SELE[(size_t)r * 128 + 64 + lane]; const float g_l = P.SELG[(size_t)r * 128 + lane], g_h = P.SELG[(size_t)r * 128 + 64 + lane];
#pragma unroll 1
        for (int b0 = pb; b0 < pe; b0 += 8) {
            u32x4 uw[8], vw[8];
#pragma unroll
            for (int k = 0; k < 8; ++k) { const int hk = b0 + k; const int e = (hk < 64) ? __builtin_amdgcn_readlane(e_l, hk & 63) : __builtin_amdgcn_readlane(e_h, hk & 63);
                uw[k] = *(const u32x4*)(U + (size_t)e * D_MODEL + 16 * lane); vw[k] = *(const u32x4*)(Vt + (size_t)e * D_MODEL + 16 * lane); }
            float d[8];
#pragma unroll
            for (int k = 0; k < 8; ++k) d[k] = dot16_fp8(uw[k], x2);
            float e4[4], e2[2], e1;
            { const bool hi = lane & 1;
#pragma unroll
              for (int i = 0; i < 4; ++i) { const float keep = hi ? d[4 + i] : d[i], send = hi ? d[i] : d[4 + i]; e4[i] = keep + __shfl_xor(send, 1); } }
            { const bool hi = lane & 2;
#pragma unroll
              for (int i = 0; i < 2; ++i) { const float keep = hi ? e4[2 + i] : e4[i], send = hi ? e4[i] : e4[2 + i]; e2[i] = keep + __shfl_xor(send, 2); } }
            { const bool hi = lane & 4; const float keep = hi ? e2[1] : e2[0], send = hi ? e2[0] : e2[1]; e1 = keep + __shfl_xor(send, 4); }
            e1 += __shfl_xor(e1, 8); e1 += __shfl_xor(e1, 16); e1 += __shfl_xor(e1, 32);
            const int myk = 4 * (lane & 1) + (lane & 2) + ((lane >> 2) & 1); const int myhk = b0 + myk;
            const float myg = (myhk < 64) ? __shfl(g_l, myhk & 63) : __shfl(g_h, myhk & 63);
            const float act = myg * gelu_tanh(e1 * (1.0f / PEER_SU)) * (1.0f / PEER_SV);
#pragma unroll
            for (int k = 0; k < 8; ++k) { const int src = (k >> 2) | (((k >> 1) & 1) << 1) | ((k & 1) << 2); axpy16_fp8(vw[k], rdlane(act, src), o2); }
        }
        if (smp) {
            LAS float* red = (LAS float*)C.lds;
#pragma unroll
            for (int k = 0; k < 8; ++k) { red[C.wave * 1024 + 16 * lane + 2 * k] = o2[k].x; red[C.wave * 1024 + 16 * lane + 2 * k + 1] = o2[k].y; }
            asm volatile("s_waitcnt lgkmcnt(0)" ::: "memory"); __syncthreads();
            if (C.wave == 0) {
#pragma unroll
                for (int k = 0; k < 8; ++k) { float ax = 0.f, ay = 0.f;
#pragma unroll
                    for (int ww = 0; ww < NWAVES; ++ww) { ax += red[ww * 1024 + 16 * lane + 2 * k]; ay += red[ww * 1024 + 16 * lane + 2 * k + 1]; } o2[k] = (f32x2){ax, ay}; } }
            __syncthreads();
            if (C.wave != 0) continue; }
        float s = 0.f;
#pragma unroll
        for (int k = 0; k < 8; ++k) { o2[k] += x2[k] * ALPHA; s += o2[k].x + o2[k].y; }
        const float mu = wave_sum(s) * (1.0f / D_MODEL); float s2 = 0.f;
#pragma unroll
        for (int k = 0; k < 8; ++k) { o2[k] -= mu; s2 += o2[k].x * o2[k].x + o2[k].y * o2[k].y; }
        const float rs = 1.0f / sqrtf(wave_sum(s2) * (1.0f / D_MODEL) + LN_EPS);
        float* frow = (r < M0) ? fout + (size_t)r * D_MODEL : fout_s + (size_t)(r - M0) * D_MODEL;
#pragma unroll
        for (int j = 0; j < 4; ++j) { const int c0 = 16 * lane + 4 * j; const f32x4 gg = *(const f32x4*)(gam + c0), bb = *(const f32x4*)(bet + c0);
            const f32x4 y = (f32x4){o2[2 * j].x * rs, o2[2 * j].y * rs, o2[2 * j + 1].x * rs, o2[2 * j + 1].y * rs} * gg + bb;
            *(f32x4*)(frow + c0) = y; if (xb) *(u32x2*)(xb + (size_t)r * D_MODEL + c0) = pk4(y); }
    }
}
DI void peer_u_phase(const FP& P, const Ctx& C, int layer, const bf16* xb16) {
    const int lane = C.lane; const unsigned char* U = P.UB8 + (size_t)layer * PEER_EXPERTS * D_MODEL;
    const int s = (int)(blockIdx.x & 7), nw = (C.G >> 3) * NWAVES, widx = (int)(blockIdx.x >> 3) * NWAVES + C.wave;
#pragma unroll 1
    for (int r = widx; r < MP; r += nw) {
        const int e0 = P.SELE[(size_t)r * 128 + lane], e1 = P.SELE[(size_t)r * 128 + 64 + lane]; const float g0 = P.SELG[(size_t)r * 128 + lane], g1 = P.SELG[(size_t)r * 128 + 64 + lane];
        unsigned long long b0 = __ballot((e0 >> 11) == s), b1 = __ballot((e1 >> 11) == s);
        if ((b0 | b1) == 0ull) continue;
        f32x2 x2[8]; { const u32x4 xa = *(const u32x4*)(xb16 + (size_t)r * D_MODEL + 16 * lane), xc = *(const u32x4*)(xb16 + (size_t)r * D_MODEL + 16 * lane + 8);
            x2[0] = (f32x2){bflo(xa.x), bfhi(xa.x)}; x2[1] = (f32x2){bflo(xa.y), bfhi(xa.y)}; x2[2] = (f32x2){bflo(xa.z), bfhi(xa.z)}; x2[3] = (f32x2){bflo(xa.w), bfhi(xa.w)};
            x2[4] = (f32x2){bflo(xc.x), bfhi(xc.x)}; x2[5] = (f32x2){bflo(xc.y), bfhi(xc.y)}; x2[6] = (f32x2){bflo(xc.z), bfhi(xc.z)}; x2[7] = (f32x2){bflo(xc.w), bfhi(xc.w)}; }
#pragma unroll 1
        while ((b0 | b1) != 0ull) {
            int hk[8]; u32x4 uw[8]; int nv = 0;
#pragma unroll
            for (int k = 0; k < 8; ++k) { int h;
                if (b0) { h = __builtin_ctzll(b0); b0 &= b0 - 1; ++nv; } else if (b1) { h = 64 + __builtin_ctzll(b1); b1 &= b1 - 1; ++nv; } else h = hk[k > 0 ? k - 1 : 0];
                hk[k] = h; const int e = (h < 64) ? __builtin_amdgcn_readlane(e0, h & 63) : __builtin_amdgcn_readlane(e1, h & 63);
                uw[k] = *(const u32x4*)(U + (size_t)e * D_MODEL + 16 * lane); }
            float d[8];
#pragma unroll
            for (int k = 0; k < 8; ++k) d[k] = dot16_fp8(uw[k], x2);
            float e4[4], e2[2], e1s;
            { const bool hi = lane & 1;
#pragma unroll
              for (int i = 0; i < 4; ++i) { const float keep = hi ? d[4 + i] : d[i], send = hi ? d[i] : d[4 + i]; e4[i] = keep + __shfl_xor(send, 1); } }
            { const bool hi = lane & 2;
#pragma unroll
              for (int i = 0; i < 2; ++i) { const float keep = hi ? e4[2 + i] : e4[i], send = hi ? e4[i] : e4[2 + i]; e2[i] = keep + __shfl_xor(send, 2); } }
            { const bool hi = lane & 4; const float keep = hi ? e2[1] : e2[0], send = hi ? e2[0] : e2[1]; e1s = keep + __shfl_xor(send, 4); }
            e1s += __shfl_xor(e1s, 8); e1s += __shfl_xor(e1s, 16); e1s += __shfl_xor(e1s, 32);
            const int myk = 4 * (lane & 1) + (lane & 2) + ((lane >> 2) & 1);
            int myh = hk[0];
#pragma unroll
            for (int k = 1; k < 8; ++k) myh = (myk == k) ? hk[k] : myh;
            const float ga = __shfl(g0, myh & 63), gb = __shfl(g1, myh & 63); const float myg = (myh < 64) ? ga : gb;
            if (lane < 8 && myk < nv) P.SCO[(size_t)r * 128 + myh] = myg * gelu_tanh(e1s * (1.0f / PEER_SU)) * (1.0f / PEER_SV);
        }
    }
}
DI void peer_v_phase(const FP& P, const Ctx& C, int layer, const float* xin, float* fout, float* fout_s, bf16* xb) {
    const int lane = C.lane; const unsigned char* Vt = P.VB8 + (size_t)layer * PEER_EXPERTS * D_MODEL;
    const float* gam = P.ln_g + ((size_t)layer * 2 + 1) * D_MODEL; const float* bet = P.ln_b + ((size_t)layer * 2 + 1) * D_MODEL;
    const int nrounds = (M0 + C.G * NWAVES - 1) / (C.G * NWAVES);
#pragma unroll 1
    for (int rd = 0; rd <= nrounds; ++rd) {
        const bool smp = (rd == nrounds); int r = smp ? M0 + C.vcu : rd * C.G * NWAVES + C.vcu * NWAVES + C.wave; if (smp ? (C.vcu >= DEC_BATCH) : (r >= M0)) continue;
        const int pb = smp ? 16 * C.wave : 0, pe = smp ? pb + 16 : 128;
        f32x2 x2[8], o2[8];
#pragma unroll
        for (int j = 0; j < 4; ++j) { const f32x4 a = *(const f32x4*)(xin + (size_t)r * D_MODEL + 16 * lane + 4 * j); x2[2 * j] = (f32x2){a.x, a.y}; x2[2 * j + 1] = (f32x2){a.z, a.w}; }
#pragma unroll
        for (int k = 0; k < 8; ++k) o2[k] = (f32x2){0.f, 0.f};
        const int e_l = P.SELE[(size_t)r * 128 + lane], e_h = P.SELE[(size_t)r * 128 + 64 + lane]; const float a_l = P.SCO[(size_t)r * 128 + lane], a_h = P.SCO[(size_t)r * 128 + 64 + lane];
#pragma unroll 1
        for (int b0 = pb; b0 < pe; b0 += 16) { u32x4 vw[16];
#pragma unroll
            for (int k = 0; k < 16; ++k) { const int hk = b0 + k; const int e = (hk < 64) ? __builtin_amdgcn_readlane(e_l, hk & 63) : __builtin_amdgcn_readlane(e_h, hk & 63); vw[k] = *(const u32x4*)(Vt + (size_t)e * D_MODEL + 16 * lane); }
#pragma unroll
            for (int k = 0; k < 16; ++k) { const int hk = b0 + k; axpy16_fp8(vw[k], (hk < 64) ? rdlane(a_l, hk & 63) : rdlane(a_h, hk & 63), o2); } }
        if (smp) {
            LAS float* red = (LAS float*)C.lds;
#pragma unroll
            for (int k = 0; k < 8; ++k) { red[C.wave * 1024 + 16 * lane + 2 * k] = o2[k].x; red[C.wave * 1024 + 16 * lane + 2 * k + 1] = o2[k].y; }
            asm volatile("s_waitcnt lgkmcnt(0)" ::: "memory"); __syncthreads();
            if (C.wave == 0) {
#pragma unroll
                for (int k = 0; k < 8; ++k) { float ax = 0.f, ay = 0.f;
#pragma unroll
                    for (int ww = 0; ww < NWAVES; ++ww) { ax += red[ww * 1024 + 16 * lane + 2 * k]; ay += red[ww * 1024 + 16 * lane + 2 * k + 1]; } o2[k] = (f32x2){ax, ay}; } }
            __syncthreads();
            if (C.wave != 0) continue; }
        float s = 0.f;
#pragma unroll
        for (int k = 0; k < 8; ++k) { o2[k] += x2[k] * ALPHA; s += o2[k].x + o2[k].y; }
        const float mu = wave_sum(s) * (1.0f / D_MODEL); float s2 = 0.f;
#pragma unroll
        for (int k = 0; k < 8; ++k) { o2[k] -= mu; s2 += o2[k].x * o2[k].x + o2[k].y * o2[k].y; }
        const float rs = 1.0f / sqrtf(wave_sum(s2) * (1.0f / D_MODEL) + LN_EPS);
        float* frow = (r < M0) ? fout + (size_t)r * D_MODEL : fout_s + (size_t)(r - M0) * D_MODEL;
#pragma unroll
        for (int j = 0; j < 4; ++j) { const int c0 = 16 * lane + 4 * j; const f32x4 gg = *(const f32x4*)(gam + c0), bb = *(const f32x4*)(bet + c0);
            const f32x4 y = (f32x4){o2[2 * j].x * rs, o2[2 * j].y * rs, o2[2 * j + 1].x * rs, o2[2 * j + 1].y * rs} * gg + bb;
            *(f32x4*)(frow + c0) = y; if (xb) *(u32x2*)(xb + (size_t)r * D_MODEL + c0) = pk4(y); }
    }
}
constexpr int PSH_LIST = 512;
struct PG4 { u32x4 u[4], v[4]; };
DI void peer_sharded_phase(const FP& P, const Ctx& C, int layer, const float* xin, const bf16* xb16, float* fout, float* fout_s, bf16* xb) {
    const int lane = C.lane; const unsigned char* U = P.UB8 + (size_t)layer * PEER_EXPERTS * D_MODEL; const unsigned char* Vt = P.VB8 + (size_t)layer * PEER_EXPERTS * D_MODEL;
    const float* gam = P.ln_g + ((size_t)layer * 2 + 1) * D_MODEL; const float* bet = P.ln_b + ((size_t)layer * 2 + 1) * D_MODEL;
    LAS unsigned char* wl = C.lds + C.wave * 16384; LAS bf16* xs = (LAS bf16*)wl; LAS int* lst = (LAS int*)(wl + 8192);
    const int NW = C.G * NWAVES, gw = C.vcu * NWAVES + C.wave; const int nquads = (M0 / NW) / 4;
#pragma unroll 1
    for (int qd = 0; qd < nquads; ++qd) {
#define PSH_ROW(j) const int row##j = (qd * 4 + j) * NW + gw; const int el##j = P.SELE[(size_t)row##j * 128 + lane], eh##j = P.SELE[(size_t)row##j * 128 + 64 + lane]; const float gl##j = P.SELG[(size_t)row##j * 128 + lane], gh##j = P.SELG[(size_t)row##j * 128 + 64 + lane]; \
        { const u32x4 xa = *(const u32x4*)(xb16 + (size_t)row##j * D_MODEL + 16 * lane), xc = *(const u32x4*)(xb16 + (size_t)row##j * D_MODEL + 16 * lane + 8); *(LAS u32x4*)(xs + j * 1024 + 16 * lane) = xa; *(LAS u32x4*)(xs + j * 1024 + 16 * lane + 8) = xc; } \
        f32x2 oa##j[8]; _Pragma("unroll") for (int k = 0; k < 8; ++k) oa##j[k] = (f32x2){0.f, 0.f};
        PSH_ROW(0) PSH_ROW(1) PSH_ROW(2) PSH_ROW(3)
#pragma unroll 1
        for (int s = 0; s < 16; ++s) {
            int n = 0;
#define PSH_SCAN(j) { unsigned long long b0 = __ballot((el##j >> 10) == s), b1 = __ballot((eh##j >> 10) == s); \
                while (b0) { const int h = __builtin_ctzll(b0); b0 &= b0 - 1; const int e = __builtin_amdgcn_readlane(el##j, h); const int g = __builtin_amdgcn_readlane(__builtin_bit_cast(int, gl##j), h); \
                    if (lane == 0) { lst[4 * n] = e; lst[4 * n + 1] = g; lst[4 * n + 2] = j; } ++n; } \
                while (b1) { const int h = __builtin_ctzll(b1); b1 &= b1 - 1; const int e = __builtin_amdgcn_readlane(eh##j, h); const int g = __builtin_amdgcn_readlane(__builtin_bit_cast(int, gh##j), h); \
                    if (lane == 0) { lst[4 * n] = e; lst[4 * n + 1] = g; lst[4 * n + 2] = j; } ++n; } }
            PSH_SCAN(0) PSH_SCAN(1) PSH_SCAN(2) PSH_SCAN(3)
            asm volatile("s_waitcnt lgkmcnt(0)" ::: "memory");
            if (n == 0) continue;
            const int ngrp = (n + 3) >> 2;
#define PSH_LD(b, gi_) do { const int gi = (gi_); _Pragma("unroll") for (int k = 0; k < 4; ++k) { int i = 4 * gi + k; i = i < n ? i : n - 1; const int e = __builtin_amdgcn_readfirstlane(lst[4 * i]); \
                b.u[k] = *(const u32x4*)(U + (size_t)e * D_MODEL + 16 * lane); b.v[k] = *(const u32x4*)(Vt + (size_t)e * D_MODEL + 16 * lane); } } while (0)
#define PSH_CP(b, gi_) do { const int gi = (gi_); float d[4]; int jj[4]; float gg[4]; \
                _Pragma("unroll") for (int k = 0; k < 4; ++k) { int i = 4 * gi + k; const bool val = i < n; i = val ? i : n - 1; jj[k] = __builtin_amdgcn_readfirstlane(lst[4 * i + 2]); gg[k] = val ? __builtin_bit_cast(float, __builtin_amdgcn_readfirstlane(lst[4 * i + 1])) : 0.f; \
                    const u32x4 xa = *(const LAS u32x4*)(xs + jj[k] * 1024 + 16 * lane), xc = *(const LAS u32x4*)(xs + jj[k] * 1024 + 16 * lane + 8); \
                    const f32x2 x2[8] = {(f32x2){bflo(xa.x), bfhi(xa.x)}, (f32x2){bflo(xa.y), bfhi(xa.y)}, (f32x2){bflo(xa.z), bfhi(xa.z)}, (f32x2){bflo(xa.w), bfhi(xa.w)}, (f32x2){bflo(xc.x), bfhi(xc.x)}, (f32x2){bflo(xc.y), bfhi(xc.y)}, (f32x2){bflo(xc.z), bfhi(xc.z)}, (f32x2){bflo(xc.w), bfhi(xc.w)}}; \
                    d[k] = dot16_fp8(b.u[k], x2); } \
                float e2[2], e1; \
                { const bool hi = lane & 1; _Pragma("unroll") for (int i = 0; i < 2; ++i) { const float keep = hi ? d[2 + i] : d[i], send = hi ? d[i] : d[2 + i]; e2[i] = keep + __shfl_xor(send, 1); } } \
                { const bool hi = lane & 2; const float keep = hi ? e2[1] : e2[0], send = hi ? e2[0] : e2[1]; e1 = keep + __shfl_xor(send, 2); } \
                e1 += __shfl_xor(e1, 4); e1 += __shfl_xor(e1, 8); e1 += __shfl_xor(e1, 16); e1 += __shfl_xor(e1, 32); \
                const int myk = 2 * (lane & 1) + ((lane >> 1) & 1); \
                float myg = gg[0]; myg = (myk == 1) ? gg[1] : myg; myg = (myk == 2) ? gg[2] : myg; myg = (myk == 3) ? gg[3] : myg; \
                const float act = myg * gelu_tanh(e1 * (1.0f / PEER_SU)) * (1.0f / PEER_SV); \
                _Pragma("unroll") for (int k = 0; k < 4; ++k) { const float a = rdlane(act, (k >> 1) | ((k & 1) << 1)); \
                    if (jj[k] == 0) axpy16_fp8(b.v[k], a, oa0); else if (jj[k] == 1) axpy16_fp8(b.v[k], a, oa1); else if (jj[k] == 2) axpy16_fp8(b.v[k], a, oa2); else axpy16_fp8(b.v[k], a, oa3); } } while (0)
            { PG4 A, B; PSH_LD(A, 0);
#pragma unroll 1
              for (int g2 = 0; g2 < ngrp; g2 += 2) { PSH_LD(B, (g2 + 1 < ngrp) ? g2 + 1 : g2); PSH_CP(A, g2); PSH_LD(A, (g2 + 2 < ngrp) ? g2 + 2 : g2); if (g2 + 1 < ngrp) PSH_CP(B, g2 + 1); } }
            asm volatile("s_waitcnt lgkmcnt(0)" ::: "memory");
        }
#define PSH_LN(j) { const int r = row##j; f32x2 x2[8]; \
            _Pragma("unroll") for (int q = 0; q < 4; ++q) { const f32x4 a = *(const f32x4*)(xin + (size_t)r * D_MODEL + 16 * lane + 4 * q); x2[2 * q] = (f32x2){a.x, a.y}; x2[2 * q + 1] = (f32x2){a.z, a.w}; } \
            float sm = 0.f; _Pragma("unroll") for (int k = 0; k < 8; ++k) { oa##j[k] += x2[k] * ALPHA; sm += oa##j[k].x + oa##j[k].y; } \
            const float mu = wave_sum(sm) * (1.0f / D_MODEL); float s2 = 0.f; _Pragma("unroll") for (int k = 0; k < 8; ++k) { oa##j[k] -= mu; s2 += oa##j[k].x * oa##j[k].x + oa##j[k].y * oa##j[k].y; } \
            const float rs = 1.0f / sqrtf(wave_sum(s2) * (1.0f / D_MODEL) + LN_EPS); float* frow = fout + (size_t)r * D_MODEL; \
            _Pragma("unroll") for (int q = 0; q < 4; ++q) { const int c0 = 16 * lane + 4 * q; const f32x4 gv = *(const f32x4*)(gam + c0), bv = *(const f32x4*)(bet + c0); \
                const f32x4 y = (f32x4){oa##j[2 * q].x * rs, oa##j[2 * q].y * rs, oa##j[2 * q + 1].x * rs, oa##j[2 * q + 1].y * rs} * gv + bv; *(f32x4*)(frow + c0) = y; if (xb) *(u32x2*)(xb + (size_t)r * D_MODEL + c0) = pk4(y); } }
        PSH_LN(0) PSH_LN(1) PSH_LN(2) PSH_LN(3)
        asm volatile("s_waitcnt lgkmcnt(0)" ::: "memory");
    }
}
#ifndef PSH_LOG_V
#define PSH_LOG_V 11
#endif
constexpr int PSH_LOG = PSH_LOG_V, PSH_N = PEER_EXPERTS >> PSH_LOG;
#ifndef PS2_ROWS
#define PS2_ROWS 4
#endif
#define PS2_ROW(j) const int row##j = (qd * PS2_ROWS + j) * NW + gw; const int el##j = P.SELE[(size_t)row##j * 128 + lane], eh##j = P.SELE[(size_t)row##j * 128 + 64 + lane]; const float gl##j = P.SELG[(size_t)row##j * 128 + lane], gh##j = P.SELG[(size_t)row##j * 128 + 64 + lane]; \
    f32x2 oa##j[8]; _Pragma("unroll") for (int k = 0; k < 8; ++k) oa##j[k] = (f32x2){0.f, 0.f};
#define PS2_STEP(j) { unsigned long long b0 = __ballot((el##j >> PSH_LOG) == s), b1 = __ballot((eh##j >> PSH_LOG) == s); \
    if (b0 | b1) { const u32x4 xa##j = *(const u32x4*)(xb16 + (size_t)row##j * D_MODEL + 16 * lane), xc##j = *(const u32x4*)(xb16 + (size_t)row##j * D_MODEL + 16 * lane + 8);     \
      const f32x2 x2[8] = {(f32x2){bflo(xa##j.x), bfhi(xa##j.x)}, (f32x2){bflo(xa##j.y), bfhi(xa##j.y)}, (f32x2){bflo(xa##j.z), bfhi(xa##j.z)}, (f32x2){bflo(xa##j.w), bfhi(xa##j.w)}, (f32x2){bflo(xc##j.x), bfhi(xc##j.x)}, (f32x2){bflo(xc##j.y), bfhi(xc##j.y)}, (f32x2){bflo(xc##j.z), bfhi(xc##j.z)}, (f32x2){bflo(xc##j.w), bfhi(xc##j.w)}}; \
      _Pragma("unroll 1") while ((b0 | b1) != 0ull) { int hk[8]; u32x4 uw[8], vw[8]; int nv = 0; \
        _Pragma("unroll") for (int k = 0; k < 8; ++k) { int h; if (b0) { h = __builtin_ctzll(b0); b0 &= b0 - 1; ++nv; } else if (b1) { h = 64 + __builtin_ctzll(b1); b1 &= b1 - 1; ++nv; } else h = hk[k > 0 ? k - 1 : 0]; \
            hk[k] = h; const int e = (h < 64) ? __builtin_amdgcn_readlane(el##j, h & 63) : __builtin_amdgcn_readlane(eh##j, h & 63); \
            uw[k] = *(const u32x4*)(U + (size_t)e * D_MODEL + 16 * lane); vw[k] = *(const u32x4*)(Vt + (size_t)e * D_MODEL + 16 * lane); } \
        float d[8]; _Pragma("unroll") for (int k = 0; k < 8; ++k) d[k] = dot16_fp8(uw[k], x2); \
        float e4[4], e2[2], e1s; \
          \
        { const bool hi = lane & 1; _Pragma("unroll") for (int i = 0; i < 4; ++i) { const float keep = hi ? d[4 + i] : d[i], send = hi ? d[i] : d[4 + i]; e4[i] = keep + dppf<0xB1>(send); } } \
        { const bool hi = lane & 2; _Pragma("unroll") for (int i = 0; i < 2; ++i) { const float keep = hi ? e4[2 + i] : e4[i], send = hi ? e4[i] : e4[2 + i]; e2[i] = keep + dppf<0x4E>(send); } } \
        { const bool hi = lane & 4; const float keep = hi ? e2[1] : e2[0], send = hi ? e2[0] : e2[1]; const float r4 = dppf<0x124>(send), r12 = dppf<0x12C>(send); e1s = keep + (hi ? r4 : r12); } \
        e1s += dppf<0x128>(e1s); e1s = colsum(e1s); \
        const int myk = 4 * (lane & 1) + (lane & 2) + ((lane >> 2) & 1); int myh = hk[0]; _Pragma("unroll") for (int k = 1; k < 8; ++k) myh = (myk == k) ? hk[k] : myh; \
        const float ga = __shfl(gl##j, myh & 63), gb = __shfl(gh##j, myh & 63); const float myg = (myk < nv) ? ((myh < 64) ? ga : gb) : 0.f;     \
        const float act = myg * gelu_tanh(e1s * (1.0f / PEER_SU)) * (1.0f / PEER_SV); \
        _Pragma("unroll") for (int k = 0; k < 8; ++k) { const int src = (k >> 2) | (((k >> 1) & 1) << 1) | ((k & 1) << 2); axpy16_fp8(vw[k], rdlane(act, src), oa##j); } } } }
#define PS2_LN(j) { const int r = row##j; f32x2 x2[8]; int ll = lane; asm volatile("" : "+v"(ll));     \
    _Pragma("unroll") for (int q = 0; q < 4; ++q) { const f32x4 a = *(const f32x4*)(xin + (size_t)r * D_MODEL + 16 * ll + 4 * q); x2[2 * q] = (f32x2){a.x, a.y}; x2[2 * q + 1] = (f32x2){a.z, a.w}; } \
    float sm = 0.f; _Pragma("unroll") for (int k = 0; k < 8; ++k) { oa##j[k] += x2[k] * ALPHA; sm += oa##j[k].x + oa##j[k].y; } \
    const float mu = wave_sum(sm) * (1.0f / D_MODEL); float s2 = 0.f; _Pragma("unroll") for (int k = 0; k < 8; ++k) { oa##j[k] -= mu; s2 += oa##j[k].x * oa##j[k].x + oa##j[k].y * oa##j[k].y; } \
    const float rs = 1.0f / sqrtf(wave_sum(s2) * (1.0f / D_MODEL) + LN_EPS); float* frow = fout + (size_t)r * D_MODEL; \
    _Pragma("unroll") for (int q = 0; q < 4; ++q) { const int c0 = 16 * ll + 4 * q; const f32x4 gv = *(const f32x4*)(gam + c0), bv = *(const f32x4*)(bet + c0); \
        const f32x4 y = (f32x4){oa##j[2 * q].x * rs, oa##j[2 * q].y * rs, oa##j[2 * q + 1].x * rs, oa##j[2 * q + 1].y * rs} * gv + bv; *(f32x4*)(frow + c0) = y; if (xb) *(u32x2*)(xb + (size_t)r * D_MODEL + c0) = pk4(y); } }
DI void xcd_soft_sync(unsigned* cnt, volatile LAS unsigned* st, unsigned x, unsigned& round) {
    if (!st) return;
    __syncthreads();
    if (threadIdx.x == 0) { const unsigned nloc = st[0];
        if (nloc) { unsigned* c = cnt + 64 * x; (void)xb_add(c, 1u); const unsigned target = (round + 1u) * nloc; unsigned sp = 0;
            while (xb_ld(c) < target && ++sp < 4096u) __builtin_amdgcn_s_sleep(1); } }
    __syncthreads(); ++round;
}
DI void peer_sharded2_phase(const FP& P, const Ctx& C, int layer, const float* xin, const bf16* xb16, float* fout, bf16* xb, volatile LAS unsigned* st = nullptr, unsigned xcc = 0) {
    unsigned round = 0; unsigned* hint = P.ctl + 8192 + layer * 1024;
    const int lane = C.lane; const unsigned char* U = P.UB8 + (size_t)layer * PEER_EXPERTS * D_MODEL; const unsigned char* Vt = P.VB8 + (size_t)layer * PEER_EXPERTS * D_MODEL;
    const float* gam = P.ln_g + ((size_t)layer * 2 + 1) * D_MODEL; const float* bet = P.ln_b + ((size_t)layer * 2 + 1) * D_MODEL;
    const int NW = C.G * NWAVES, gw = C.vcu * NWAVES + C.wave; const int nquads = (M0 / NW) / PS2_ROWS;
#pragma unroll 1
    for (int qd = 0; qd < nquads; ++qd) {
#if PS2_ROWS == 4
        PS2_ROW(0) PS2_ROW(1) PS2_ROW(2) PS2_ROW(3)
#pragma unroll 1
        for (int s = 0; s < PSH_N; ++s) {
#ifdef PEER_SOFTSYNC
            xcd_soft_sync(hint, st, xcc, round);
#endif
            PS2_STEP(0) PS2_STEP(1) PS2_STEP(2) PS2_STEP(3) }
        PS2_LN(0) PS2_LN(1) PS2_LN(2) PS2_LN(3)
#else
        PS2_ROW(0) PS2_ROW(1)
#pragma unroll 1
        for (int s = 0; s < PSH_N; ++s) { PS2_STEP(0) PS2_STEP(1) }
        PS2_LN(0) PS2_LN(1)
#endif
    }
}
#define PS3_ROW(j) const int row##j = (qd * 4 + j) * NW + gw; const int el##j = P.SELE[(size_t)row##j * 128 + lane], eh##j = P.SELE[(size_t)row##j * 128 + 64 + lane]; \
    { const u32x4 xa = *(const u32x4*)(xb16 + (size_t)row##j * D_MODEL + 16 * lane), xc = *(const u32x4*)(xb16 + (size_t)row##j * D_MODEL + 16 * lane + 8); *(LAS u32x4*)(xs + j * 1024 + 16 * lane) = xa; *(LAS u32x4*)(xs + j * 1024 + 16 * lane + 8) = xc; } \
    f32x2 oa##j[8]; _Pragma("unroll") for (int k = 0; k < 8; ++k) oa##j[k] = (f32x2){0.f, 0.f};
#define PS3_X2_UNUSED(j) const f32x2 x2[8] = {(f32x2){bflo(xa##j.x), bfhi(xa##j.x)}, (f32x2){bflo(xa##j.y), bfhi(xa##j.y)}, (f32x2){bflo(xa##j.z), bfhi(xa##j.z)}, (f32x2){bflo(xa##j.w), bfhi(xa##j.w)}, (f32x2){bflo(xc##j.x), bfhi(xc##j.x)}, (f32x2){bflo(xc##j.y), bfhi(xc##j.y)}, (f32x2){bflo(xc##j.z), bfhi(xc##j.z)}, (f32x2){bflo(xc##j.w), bfhi(xc##j.w)}};
#define PS3_TAKE(q, M, ELH, GOFF) if (!got && M) { const int h = __builtin_ctzll(M); M &= M - 1; qq[k] = q; ee = __builtin_amdgcn_readlane(ELH, h); gk[k] = P.SELG[GOFF + h];     got = true; ++nv; }
DI void peer_sharded3_phase(const FP& P, const Ctx& C, int layer, const float* xin, const bf16* xb16, float* fout, bf16* xb) {
    const int lane = C.lane; const unsigned char* U = P.UB8 + (size_t)layer * PEER_EXPERTS * D_MODEL; const unsigned char* Vt = P.VB8 + (size_t)layer * PEER_EXPERTS * D_MODEL;
    const float* gam = P.ln_g + ((size_t)layer * 2 + 1) * D_MODEL; const float* bet = P.ln_b + ((size_t)layer * 2 + 1) * D_MODEL;
    const int NW = C.G * NWAVES, gw = C.vcu * NWAVES + C.wave; const int nquads = (M0 / NW) / 4; LAS bf16* xs = (LAS bf16*)(C.lds + C.wave * 16384);
#pragma unroll 1
    for (int qd = 0; qd < nquads; ++qd) {
        PS3_ROW(0) PS3_ROW(1) PS3_ROW(2) PS3_ROW(3)
        asm volatile("s_waitcnt lgkmcnt(0)" ::: "memory");
#pragma unroll 1
        for (int s = 0; s < PSH_N; ++s) {
            unsigned long long m0 = __ballot((el0 >> PSH_LOG) == s), m1 = __ballot((eh0 >> PSH_LOG) == s), m2 = __ballot((el1 >> PSH_LOG) == s), m3 = __ballot((eh1 >> PSH_LOG) == s),
                               m4 = __ballot((el2 >> PSH_LOG) == s), m5 = __ballot((eh2 >> PSH_LOG) == s), m6 = __ballot((el3 >> PSH_LOG) == s), m7 = __ballot((eh3 >> PSH_LOG) == s);
#pragma unroll 1
            while ((m0 | m1 | m2 | m3 | m4 | m5 | m6 | m7) != 0ull) {
                int qq[8]; float gk[8]; int es[8]; u32x4 uw[8]; int nv = 0; int elast = 0;
#pragma unroll
                for (int k = 0; k < 8; ++k) { bool got = false; int ee = elast; qq[k] = k > 0 ? qq[k - 1] : 0; gk[k] = 0.f;
                    PS3_TAKE(0, m0, el0, (size_t)row0 * 128) PS3_TAKE(1, m1, eh0, (size_t)row0 * 128 + 64) PS3_TAKE(2, m2, el1, (size_t)row1 * 128) PS3_TAKE(3, m3, eh1, (size_t)row1 * 128 + 64) PS3_TAKE(4, m4, el2, (size_t)row2 * 128) PS3_TAKE(5, m5, eh2, (size_t)row2 * 128 + 64) PS3_TAKE(6, m6, el3, (size_t)row3 * 128) PS3_TAKE(7, m7, eh3, (size_t)row3 * 128 + 64)
                    elast = ee; es[k] = ee; uw[k] = *(const u32x4*)(U + (size_t)ee * D_MODEL + 16 * lane); }
                float d[8];
#pragma unroll
                for (int k = 0; k < 8; ++k) { const int j = qq[k] >> 1; const u32x4 xa = *(const LAS u32x4*)(xs + j * 1024 + 16 * lane), xc = *(const LAS u32x4*)(xs + j * 1024 + 16 * lane + 8);
                    const f32x2 x2[8] = {(f32x2){bflo(xa.x), bfhi(xa.x)}, (f32x2){bflo(xa.y), bfhi(xa.y)}, (f32x2){bflo(xa.z), bfhi(xa.z)}, (f32x2){bflo(xa.w), bfhi(xa.w)}, (f32x2){bflo(xc.x), bfhi(xc.x)}, (f32x2){bflo(xc.y), bfhi(xc.y)}, (f32x2){bflo(xc.z), bfhi(xc.z)}, (f32x2){bflo(xc.w), bfhi(xc.w)}};
                    d[k] = dot16_fp8(uw[k], x2); }
                u32x4 vw[8];
#pragma unroll
                for (int k = 0; k < 8; ++k) vw[k] = *(const u32x4*)(Vt + (size_t)es[k] * D_MODEL + 16 * lane);
                float e4[4], e2[2], e1s;
                { const bool hi = lane & 1;
#pragma unroll
                  for (int i = 0; i < 4; ++i) { const float keep = hi ? d[4 + i] : d[i], send = hi ? d[i] : d[4 + i]; e4[i] = keep + __shfl_xor(send, 1); } }
                { const bool hi = lane & 2;
#pragma unroll
                  for (int i = 0; i < 2; ++i) { const float keep = hi ? e4[2 + i] : e4[i], send = hi ? e4[i] : e4[2 + i]; e2[i] = keep + __shfl_xor(send, 2); } }
                { const bool hi = lane & 4; const float keep = hi ? e2[1] : e2[0], send = hi ? e2[0] : e2[1]; e1s = keep + __shfl_xor(send, 4); }
                e1s += __shfl_xor(e1s, 8); e1s += __shfl_xor(e1s, 16); e1s += __shfl_xor(e1s, 32);
                const int myk = 4 * (lane & 1) + (lane & 2) + ((lane >> 2) & 1); float myg = gk[0];
#pragma unroll
                for (int k = 1; k < 8; ++k) myg = (myk == k) ? gk[k] : myg;
                const float act = myg * gelu_tanh(e1s * (1.0f / PEER_SU)) * (1.0f / PEER_SV);
#pragma unroll
                for (int k = 0; k < 8; ++k) { const int src = (k >> 2) | (((k >> 1) & 1) << 1) | ((k & 1) << 2); const float a = rdlane(act, src); const int j = qq[k] >> 1;
                    if (j == 0) { asm volatile("" ::: "memory"); axpy16_fp8(vw[k], a, oa0); } else if (j == 1) { asm volatile("" ::: "memory"); axpy16_fp8(vw[k], a, oa1); } else if (j == 2) { asm volatile("" ::: "memory"); axpy16_fp8(vw[k], a, oa2); } else { asm volatile("" ::: "memory"); axpy16_fp8(vw[k], a, oa3); } }
            }
        }
        PS2_LN(0) PS2_LN(1) PS2_LN(2) PS2_LN(3)
    }
}
}
namespace fx {
struct EpiB {
    static constexpr bool PERM = true, AFTER_DRAIN = false; const FP& P;
    DI void operator()(const f32x4 (&acc)[2][2][4][2], const pg8::Unit& u, int wr, int wc, int fr, int fq) const {
        const int t = u.pn;
        EPI_LOOP({ if (row < MP) { const int pos = row_pos(row), n = row / SEQ, e = ct & 63, dp = e >> 1; const bool prm = row < M0;
            if (t < 3) { const int ty = 2 * t + (ct >> 7), kvh = (ct >> 6) & 1;
                if (ty == 2 || ty == 4) { f32x4 lo, hi; rope4(P.ROPE + pos * 64, dp, v0, v1, lo, hi);
                    if (ty == 2) { float* o = (prm ? P.nsa_kv_p + (size_t)row * 512 : P.nsa_kv_s + (size_t)(row - M0) * 512) + 256 + kvh * 64 + dp; *(f32x4*)o = lo; *(f32x4*)(o + 32) = hi;
                        if (prm) { bf16* kt = P.SLK + ((size_t)n * NSA_KV_HEADS + kvh) * SEQ * 64; *(u32x2*)(kt + ktile_off(pos, dp)) = pk4(lo); *(u32x2*)(kt + ktile_off(pos, dp + 32)) = pk4(hi); } }
                    else { float* o = nullptr; if (!prm) o = P.win_s + (((size_t)(row - M0) * SWA_WINDOW + SWA_WINDOW - 1) * 2 + 0) * 128; else if (pos >= SEQ - SWA_WINDOW) o = P.win_p + (((size_t)n * SWA_WINDOW + pos - (SEQ - SWA_WINDOW)) * 2 + 0) * 128;
                        if (o) { *(f32x4*)(o + kvh * 64 + dp) = lo; *(f32x4*)(o + kvh * 64 + 32 + dp) = hi; }
                        if (prm) { bf16* kt = P.WNK + ((size_t)n * NSA_KV_HEADS + kvh) * SEQ * 64; *(u32x2*)(kt + ktile_off(pos, dp)) = pk4(lo); *(u32x2*)(kt + ktile_off(pos, dp + 32)) = pk4(hi); } } }
                else if (ty < 4) { float* o = (prm ? P.nsa_kv_p + (size_t)row * 512 : P.nsa_kv_s + (size_t)(row - M0) * 512) + ty * 128 + kvh * 64 + e; *(f32x4*)o = v0; *(f32x4*)(o + 4) = v1;
                    if (prm) { if (ty < 2) *(u32x4*)(P.AC + ((size_t)ty * ACROWS + ((size_t)n * NSA_KV_HEADS + kvh) * NCH + pos / 16) * 1024 + (pos % 16) * 64 + e) = pk8(v0, v1);
                        else { bf16* vt = P.SLVT + ((size_t)n * NSA_KV_HEADS + kvh) * SEQ * 64 + vtile_off(e, pos);
                            vt[0] = (bf16)f2bf(v0.x); vt[8] = (bf16)f2bf(v0.y); vt[16] = (bf16)f2bf(v0.z); vt[24] = (bf16)f2bf(v0.w); vt[32] = (bf16)f2bf(v1.x); vt[40] = (bf16)f2bf(v1.y); vt[48] = (bf16)f2bf(v1.z); vt[56] = (bf16)f2bf(v1.w); } } }
                else { float* o = nullptr; if (!prm) o = P.win_s + (((size_t)(row - M0) * SWA_WINDOW + SWA_WINDOW - 1) * 2 + 1) * 128; else if (pos >= SEQ - SWA_WINDOW) o = P.win_p + (((size_t)n * SWA_WINDOW + pos - (SEQ - SWA_WINDOW)) * 2 + 1) * 128;
                    if (o) { *(f32x4*)(o + kvh * 64 + e) = v0; *(f32x4*)(o + kvh * 64 + e + 4) = v1; }
                    if (prm) { bf16* vt = P.WNVT + ((size_t)n * NSA_KV_HEADS + kvh) * SEQ * 64 + vtile_off(e, pos);
                        vt[0] = (bf16)f2bf(v0.x); vt[8] = (bf16)f2bf(v0.y); vt[16] = (bf16)f2bf(v0.z); vt[24] = (bf16)f2bf(v0.w); vt[32] = (bf16)f2bf(v1.x); vt[40] = (bf16)f2bf(v1.y); vt[48] = (bf16)f2bf(v1.z); vt[56] = (bf16)f2bf(v1.w); } } }
            else if (t < 6) { const int h = (t - 3) * 4 + (ct >> 6); f32x4 lo, hi; rope4(P.ROPE + pos * 64, dp, v0, v1, lo, hi); bf16* q = P.QB + (size_t)row * NSA_Q_COLS + h * 64 + dp; *(u32x2*)q = pk4(lo * QSCALE); *(u32x2*)(q + 32) = pk4(hi * QSCALE); }
            else if (t == 6) { *(u32x4*)(P.MQB + (size_t)row * 256 + ct) = pk8(v0 * QSCALE, v1 * QSCALE); }
            else if (ct < 40) { const float vv[8] = {v0.x, v0.y, v0.z, v0.w, v1.x, v1.y, v1.z, v1.w};
                _Pragma("unroll") for (int i = 0; i < 8; ++i) if (ct + i < NSA_GATE_COLS) P.GATES[(size_t)row * 64 + ct + i] = 1.0f / (1.0f + __expf(-vv[i])); } } })
    }
};
DI void cmp2_phase(const FP& P, const Ctx& C) {
    const int lane = C.lane; LAS float* hs = (LAS float*)(C.lds + C.wave * 1024);
    constexpr int NGRP = NCTX * 2 * NSA_KV_HEADS; const int NW = C.G * NWAVES, WPG = NW / NGRP > 0 ? NW / NGRP : 1; const int gw = C.vcu * NWAVES + C.wave;
#pragma unroll 1
    for (int grp = gw / WPG; grp < NGRP; grp += (NW + WPG - 1) / WPG) { const int slot = gw % WPG; if (gw >= (NW / WPG) * WPG && grp == gw / WPG) break;
        const int kvh = grp % NSA_KV_HEADS, ty = (grp / NSA_KV_HEADS) % 2, ctx = grp / (2 * NSA_KV_HEADS);
        const float* UL = P.UL + ((size_t)ty * ACROWS + ((size_t)ctx * NSA_KV_HEADS + kvh) * NCH) * 256; const float* w2 = P.cmp_w2 + (size_t)ty * CMP_HIDDEN * HEAD_DIM;
        float w2r[CMP_HIDDEN];
#pragma unroll
        for (int k = 0; k < CMP_HIDDEN; ++k) w2r[k] = w2[k * HEAD_DIM + lane];
        const float b0 = P.CBIAS[ty * CMP_HIDDEN + lane], b1 = P.CBIAS[ty * CMP_HIDDEN + 64 + lane];
        float u0, u1, l0, l1; int c = slot;
        if (c < NCMP) { u0 = UL[(size_t)c * 256 + lane]; u1 = UL[(size_t)c * 256 + 64 + lane]; l0 = UL[(size_t)(c + 1) * 256 + 128 + lane]; l1 = UL[(size_t)(c + 1) * 256 + 192 + lane]; }
#pragma unroll 1
        for (; c < NCMP; c += WPG) { const float h0 = gelu_tanh(u0 + l0 + b0), h1 = gelu_tanh(u1 + l1 + b1); const int cn = c + WPG;
            if (cn < NCMP) { u0 = UL[(size_t)cn * 256 + lane]; u1 = UL[(size_t)cn * 256 + 64 + lane]; l0 = UL[(size_t)(cn + 1) * 256 + 128 + lane]; l1 = UL[(size_t)(cn + 1) * 256 + 192 + lane]; }
            hs[lane] = h0; hs[64 + lane] = h1; asm volatile("s_waitcnt lgkmcnt(0)" ::: "memory");
            float a = 0.f;
#pragma unroll
            for (int k4 = 0; k4 < CMP_HIDDEN / 4; ++k4) { const f32x4 hv = *(const LAS f32x4*)(hs + 4 * k4); a += hv.x * w2r[4 * k4] + hv.y * w2r[4 * k4 + 1] + hv.z * w2r[4 * k4 + 2] + hv.w * w2r[4 * k4 + 3]; }
            if (ty == 0) { const float other = __shfl_xor(a, 32); const int pos = c * CMP_STRIDE + CMP_BLOCK - 1; const float cs = P.ROPE[pos * 64 + (lane & 31)], sn = P.ROPE[pos * 64 + 32 + (lane & 31)];
                a = (lane < 32) ? a * cs - other * sn : a * cs + other * sn; }
            if (ctx < BATCH) { if (ty == 0) P.CK[((size_t)ctx * NSA_KV_HEADS + kvh) * NCH * 64 + ktile_off(c, lane)] = (bf16)f2bf(a); else P.CVT[((size_t)ctx * NSA_KV_HEADS + kvh) * NCH * 64 + vtile_off(lane, c)] = (bf16)f2bf(a); }
            else { (ty == 0 ? P.CKF : P.CVF)[(((size_t)(ctx - BATCH) * NSA_KV_HEADS + kvh) * NCH + c) * 64 + lane] = a; }
            asm volatile("s_waitcnt lgkmcnt(0)" ::: "memory"); }
    }
    __syncthreads();
}
constexpr int NSA_WLDS = 8192;
DI void nsa_pair_a(const FP& P, int n, int kvh, int t, int lane, LAS unsigned char* wl) {
    LAS float* pn = (LAS float*)wl; LAS float* imp = (LAS float*)(wl + 2048); LAS float* sc = (LAS float*)(wl + 6144); LAS int* sel = (LAS int*)(wl + 7168);
    const int col = lane & 15, c = lane >> 4; const bool vcol = col < 12; const int qq = vcol ? col / 6 : 0, hh = vcol ? col % 6 : 0, tq = t + qq, head = kvh * NSA_GROUP + hh, row = n * SEQ + tq;
    bf16x8 qf[2]; { const bf16* qp = P.QB + (size_t)row * NSA_Q_COLS + head * 64 + 8 * c; qf[0] = *(const bf16x8*)qp; qf[1] = *(const bf16x8*)(qp + 32); }
    const float* gt = P.GATES + (size_t)row * 64 + head * 3;
    f32x4 oacc[4] = {(f32x4){0.f, 0.f, 0.f, 0.f}, (f32x4){0.f, 0.f, 0.f, 0.f}, (f32x4){0.f, 0.f, 0.f, 0.f}, (f32x4){0.f, 0.f, 0.f, 0.f}};
    const int lim = vcol ? ((tq >= CMP_BLOCK - 1) ? (tq - (CMP_BLOCK - 1)) / CMP_STRIDE : -1) : -1;
    const int limmax = (t + 1 >= CMP_BLOCK - 1) ? (t + 1 - (CMP_BLOCK - 1)) / CMP_STRIDE : -1; const int nblk = (limmax + 32) / 32;
    const bf16* CKb = P.CK + ((size_t)n * NSA_KV_HEADS + kvh) * NCH * 64; const bf16* CVb = P.CVT + ((size_t)n * NSA_KV_HEADS + kvh) * 64 * NCH;
    for (int i = lane; i < 1024; i += 64) imp[i] = 0.f;
    float m1 = -INFINITY, l1 = 0.f;
    { struct K4 { bf16x8 a0, a1, b0, b1; };
      auto ldk = [&](K4& k, int blk) { const bf16* kt = CKb + (size_t)blk * 2048 + lane * 8; k.a0 = *(const bf16x8*)kt; k.a1 = *(const bf16x8*)(kt + 512); k.b0 = *(const bf16x8*)(kt + 1024); k.b1 = *(const bf16x8*)(kt + 1536); };
      auto cp1 = [&](const K4& k, int blk) { const int kb = 32 * blk;
        f32x4 s0 = (f32x4){0.f, 0.f, 0.f, 0.f}, s1 = (f32x4){0.f, 0.f, 0.f, 0.f};
        s0 = __builtin_amdgcn_mfma_f32_16x16x32_bf16(k.a0, qf[0], s0, 0, 0, 0); s0 = __builtin_amdgcn_mfma_f32_16x16x32_bf16(k.a1, qf[1], s0, 0, 0, 0);
        s1 = __builtin_amdgcn_mfma_f32_16x16x32_bf16(k.b0, qf[0], s1, 0, 0, 0); s1 = __builtin_amdgcn_mfma_f32_16x16x32_bf16(k.b1, qf[1], s1, 0, 0, 0);
        float s[8] = {s0.x, s0.y, s0.z, s0.w, s1.x, s1.y, s1.z, s1.w}; float mx = -INFINITY;
        const int hi1 = lim - (kb + 8 * c);
#pragma unroll
        for (int e = 0; e < 8; ++e) { s[e] = (e <= hi1) ? s[e] : -INFINITY; mx = fmaxf(mx, s[e]); }
        mx = colmax(mx);
        const float mnew = fmaxf(m1, mx), muse = (mnew == -INFINITY) ? 0.f : mnew; float ls = 0.f;
#pragma unroll
        for (int e = 0; e < 8; ++e) ls += __builtin_amdgcn_exp2f(s[e] - muse);
        l1 = l1 * __builtin_amdgcn_exp2f(m1 - muse) + ls; m1 = mnew; };
      if (nblk > 0) { K4 A, B; ldk(A, 0);
#pragma unroll 1
        for (int blk = 0; blk < nblk; blk += 2) { ldk(B, (blk + 1 < nblk) ? blk + 1 : blk); cp1(A, blk); ldk(A, (blk + 2 < nblk) ? blk + 2 : blk); if (blk + 1 < nblk) cp1(B, blk + 1); } } }
    asm volatile("s_waitcnt lgkmcnt(0)" ::: "memory");
    { l1 = colsum(l1); const float muse = (m1 == -INFINITY) ? 0.f : m1, inv = (l1 > 0.f) ? 1.0f / l1 : 0.f;
      f32x4 oc[4] = {(f32x4){0.f, 0.f, 0.f, 0.f}, (f32x4){0.f, 0.f, 0.f, 0.f}, (f32x4){0.f, 0.f, 0.f, 0.f}, (f32x4){0.f, 0.f, 0.f, 0.f}};
      pipe2(nblk, [&](KV8& kv, int blk) { kv_load_t(kv, CKb + (size_t)blk * 2048, CVb + (size_t)blk * 2048, lane); }, [&](const KV8& kv, int blk) { const int kb = 32 * blk;
        f32x4 s0 = (f32x4){0.f, 0.f, 0.f, 0.f}, s1 = (f32x4){0.f, 0.f, 0.f, 0.f};
        s0 = __builtin_amdgcn_mfma_f32_16x16x32_bf16(kv.ka0, qf[0], s0, 0, 0, 0); s0 = __builtin_amdgcn_mfma_f32_16x16x32_bf16(kv.ka1, qf[1], s0, 0, 0, 0);
        s1 = __builtin_amdgcn_mfma_f32_16x16x32_bf16(kv.kb0, qf[0], s1, 0, 0, 0); s1 = __builtin_amdgcn_mfma_f32_16x16x32_bf16(kv.kb1, qf[1], s1, 0, 0, 0);
        float s[8] = {s0.x, s0.y, s0.z, s0.w, s1.x, s1.y, s1.z, s1.w};
        const int hi2 = lim - (kb + 8 * c);
#pragma unroll
        for (int e = 0; e < 8; ++e) s[e] = (e <= hi2) ? __builtin_amdgcn_exp2f(s[e] - muse) * inv : 0.f;
        *(f32x4*)(pn + col * 32 + 8 * c) = (f32x4){s[0], s[1], s[2], s[3]}; *(f32x4*)(pn + col * 32 + 8 * c + 4) = (f32x4){s[4], s[5], s[6], s[7]};
        u32x4 pw; pw.x = cvtpk(s[0], s[1]); pw.y = cvtpk(s[2], s[3]); pw.z = cvtpk(s[4], s[5]); pw.w = cvtpk(s[6], s[7]); const bf16x8 pf = __builtin_bit_cast(bf16x8, pw);
        oc[0] = __builtin_amdgcn_mfma_f32_16x16x32_bf16(kv.v0, pf, oc[0], 0, 0, 0); oc[1] = __builtin_amdgcn_mfma_f32_16x16x32_bf16(kv.v1, pf, oc[1], 0, 0, 0);
        oc[2] = __builtin_amdgcn_mfma_f32_16x16x32_bf16(kv.v2, pf, oc[2], 0, 0, 0); oc[3] = __builtin_amdgcn_mfma_f32_16x16x32_bf16(kv.v3, pf, oc[3], 0, 0, 0);
        asm volatile("s_waitcnt lgkmcnt(0)" ::: "memory");
        { const int q2 = lane >> 5, k = lane & 31; float a = 0.f;
#pragma unroll
          for (int h6 = 0; h6 < 6; ++h6) a += pn[(q2 * 6 + h6) * 32 + k];
          imp[q2 * 512 + kb + k] = a; }
        asm volatile("s_waitcnt lgkmcnt(0)" ::: "memory"); });
#ifdef NSA_DEBUG
      if (vcol) { for (int db = 0; db < 4; ++db) *(f32x4*)(P.DBG + ((size_t)0 * MP + row) * 768 + head * 64 + 16 * db + 4 * c) = oc[db]; }
#endif
      const float g0 = vcol ? gt[0] : 0.f;
#pragma unroll
      for (int db = 0; db < 4; ++db) oacc[db] += oc[db] * g0; }
#ifndef REP_SEL
#define REP_SEL 1
#endif
#pragma unroll 1
    for (int rep = 0; rep < REP_SEL; ++rep) {
    for (int i = lane; i < 256; i += 64) { const int q2 = i >> 7, b = i & 127, tq2 = t + q2, cur = tq2 / SLC_BLOCK; float sv;
        if (b > cur) sv = NEG; else if (b == 0 || b == cur || b == cur - 1) sv = FORCE_SCORE;
        else { const LAS float* ic = imp + q2 * 512 + 4 * b; sv = ic[-1] + 2.f * (ic[0] + ic[1] + ic[2]) + ic[3]; }
        sc[i] = pack_key(sv, 127u - (unsigned)b, 127u); }
    asm volatile("s_waitcnt lgkmcnt(0)" ::: "memory");
    for (int i = lane; i < 256; i += 64) { const int q2 = i >> 7, b = i & 127; const float sv = sc[i]; int rank = 0;
        for (int j = 0; j < 128; j += 4) { const f32x4 o = *(const LAS f32x4*)(sc + q2 * 128 + j);
            rank += (o.x > sv) ? 1 : 0; rank += (o.y > sv) ? 1 : 0; rank += (o.z > sv) ? 1 : 0; rank += (o.w > sv) ? 1 : 0; }
        if (rank < SLC_TOPK) { const int v = (sv > 0.5f * NEG) ? b : -1; sel[q2 * 16 + rank] = v; P.SELB[((size_t)(n * SEQ + t + q2) * NSA_KV_HEADS + kvh) * 16 + rank] = v; } }
    asm volatile("s_waitcnt lgkmcnt(0)" ::: "memory");
    }
#ifndef REP_WIN
#define REP_WIN 1
#endif
#pragma unroll 1
    for (int rep = 0; rep < REP_WIN; ++rep) { Tile16 T; tile_init(T);
      const bf16* WKb = P.WNK + ((size_t)n * NSA_KV_HEADS + kvh) * SEQ * 64; const bf16* WVb = P.WNVT + ((size_t)n * NSA_KV_HEADS + kvh) * 64 * SEQ;
      const int blo = (t - SWA_WINDOW) >> 5, bhi = (t + 1) >> 5;
      auto ld = [&](KV8& kv, int blk) { const int bc = blk < 0 ? 0 : blk; kv_load_t(kv, WKb + (size_t)bc * 2048, WVb + (size_t)bc * 2048, lane); };
      pipe2(bhi - blo + 1, [&](KV8& kv, int i) { ld(kv, blo + i); }, [&](const KV8& kv, int i) { const int kb = 32 * (blo + i);
          const int k0 = kb + 8 * c; int lo; unsigned rng; const int a = tq - SWA_WINDOW; mk_range((a > 0 ? a : 0) - k0, tq - k0, vcol, lo, rng); tile_compute(T, qf, kv, lo, rng); });
      T.l = colsum(T.l);
      const float inv = (T.l > 0.f) ? 1.0f / T.l : 0.f, g2 = vcol ? gt[2] * inv : 0.f;
#ifdef NSA_DEBUG
      if (vcol) { for (int db = 0; db < 4; ++db) *(f32x4*)(P.DBG + ((size_t)2 * MP + row) * 768 + head * 64 + 16 * db + 4 * c) = T.o[db] * inv; }
#endif
#pragma unroll
      for (int db = 0; db < 4; ++db) if (rep == REP_WIN - 1) oacc[db] += T.o[db] * g2; }
    if (vcol) { float* op = P.DPART + (size_t)row * 768 + head * 64 + 4 * c;
#pragma unroll
        for (int db = 0; db < 4; ++db) *(f32x4*)(op + 16 * db) = oacc[db]; }
}
DI void nsa_pair_b(const FP& P, int n, int kvh, int t, int lane, LAS unsigned char* wl) {
    LAS int* steps = (LAS int*)wl;
    const int col = lane & 15, c = lane >> 4; const bool vcol = col < 12; const int qq = vcol ? col / 6 : 0, hh = vcol ? col % 6 : 0, tq = t + qq, head = kvh * NSA_GROUP + hh, row = n * SEQ + tq;
    bf16x8 qf[2]; { const bf16* qp = P.QB + (size_t)row * NSA_Q_COLS + head * 64 + 8 * c; qf[0] = *(const bf16x8*)qp; qf[1] = *(const bf16x8*)(qp + 32); }
    const float* gt = P.GATES + (size_t)row * 64 + head * 3;
    Tile16 T; tile_init(T);
    const bf16* SKb = P.SLK + ((size_t)n * NSA_KV_HEADS + kvh) * SEQ * 64; const bf16* SVb = P.SLVT + ((size_t)n * NSA_KV_HEADS + kvh) * SEQ * 64;
    int ns = 0;
    { const int mysel = (lane < 32) ? P.SELB[((size_t)(n * SEQ + t + (lane >> 4)) * NSA_KV_HEADS + kvh) * 16 + (lane & 15)] : -1;
      for (int i = 0; i < 32; ++i) { const int b = __builtin_amdgcn_readlane(mysel, i); if (b < 0) continue; int q2 = i >> 4;
          const unsigned long long other = __ballot(mysel == b && lane < 32 && (lane >> 4) != q2);
          if (other) { if (q2 == 1) continue; q2 = 2; }
          if (lane == 0) { steps[ns] = (b * SLC_BLOCK) | (q2 << 29); steps[ns + 1] = (b * SLC_BLOCK + 32) | (q2 << 29); } ns += 2; } }
    asm volatile("s_waitcnt lgkmcnt(0)" ::: "memory");
    auto ld = [&](KV8& kv, int i) { const int code = __builtin_amdgcn_readfirstlane(steps[i]); const int kb = code & 0x1fffffff;
        kv_load_t(kv, SKb + (size_t)(kb >> 5) * 2048, SVb + (size_t)(kb >> 5) * 2048, lane); };
#ifdef PROBE_DBLCOMP
    Tile16 T2; tile_init(T2);
#endif
    pipe2(ns, ld, [&](const KV8& kv, int i) { const int code = __builtin_amdgcn_readfirstlane(steps[i]); const int kb = code & 0x1fffffff, q2 = code >> 29;
        int lo; unsigned rng; mk_range(-64, tq - (kb + 8 * c), vcol && (q2 == 2 || qq == q2), lo, rng); tile_compute(T, qf, kv, lo, rng);
#ifdef PROBE_DBLCOMP
        tile_compute(T2, qf, kv, [&](int e) { return vcol && qq == q2 && (kb + 8 * c + e + 1) <= tq; });
#endif
    });
#ifdef PROBE_DBLCOMP
    if (T2.l < 0.f) T.l = 0.f;
#endif
    T.l = colsum(T.l);
    const float inv = (T.l > 0.f) ? 1.0f / T.l : 0.f, g1 = vcol ? gt[1] * inv : 0.f;
#ifdef NSA_DEBUG
    if (vcol) { for (int db = 0; db < 4; ++db) *(f32x4*)(P.DBG + ((size_t)1 * MP + row) * 768 + head * 64 + 16 * db + 4 * c) = T.o[db] * inv; }
#endif
    if (vcol) { const float* pp = P.DPART + (size_t)row * 768 + head * 64 + 4 * c; bf16* op = P.ATTB + (size_t)row * 1024 + head * 64 + 4 * c;
#pragma unroll
        for (int db = 0; db < 4; ++db) *(u32x2*)(op + 16 * db) = pk4(*(const f32x4*)(pp + 16 * db) + T.o[db] * g1); }
}

constexpr int SMP_SK = 1088;
template <class KF, class VF> DI void smp_branch(const Ctx& C, LAS float* qs, LAS float* S, LAS float* red, int NK, KF kf, VF vf, bool keep_probs, float (&outh)[1]) {
    const int tid = C.tid, lane = C.lane, w = C.wave;
#pragma unroll 1
    for (int j = tid; j < NK; j += NTHREADS) { const float* k = kf(j); f32x4 kr[16];
#pragma unroll
        for (int d4 = 0; d4 < 16; ++d4) kr[d4] = *(const f32x4*)(k + 4 * d4);
#pragma unroll 1
        for (int h = 0; h < 6; ++h) { float a = 0.f;
#pragma unroll
            for (int d4 = 0; d4 < 16; ++d4) { const f32x4 qv = *(const LAS f32x4*)(qs + h * 64 + 4 * d4); a += kr[d4].x * qv.x + kr[d4].y * qv.y + kr[d4].z * qv.z + kr[d4].w * qv.w; }
            S[h * SMP_SK + j] = a; } }
    asm volatile("s_waitcnt lgkmcnt(0)" ::: "memory"); __syncthreads();
    if (w < 6) { float m = -INFINITY; for (int j = lane; j < NK; j += 64) m = fmaxf(m, S[w * SMP_SK + j]); m = wave_max(m);
        float l = 0.f; for (int j = lane; j < NK; j += 64) { const float p = __builtin_amdgcn_exp2f(S[w * SMP_SK + j] - m); S[w * SMP_SK + j] = p; l += p; } l = wave_sum(l);
        const float inv = 1.0f / l; for (int j = lane; j < NK; j += 64) S[w * SMP_SK + j] *= inv; }
    asm volatile("s_waitcnt lgkmcnt(0)" ::: "memory"); __syncthreads();
    { const int per = (NK + NWAVES - 1) / NWAVES, j0 = w * per, j1 = (j0 + per < NK) ? j0 + per : NK; float o[6] = {0.f, 0.f, 0.f, 0.f, 0.f, 0.f};
#pragma unroll 1
      for (int j = j0; j < j1; j += 8) { float vv[8];
#pragma unroll
          for (int u = 0; u < 8; ++u) { const int jj = (j + u < j1) ? j + u : j1 - 1; vv[u] = vf(jj)[lane]; }
#pragma unroll
          for (int u = 0; u < 8; ++u) if (j + u < j1) {
#pragma unroll
              for (int h = 0; h < 6; ++h) o[h] += S[h * SMP_SK + j + u] * vv[u]; } }
#pragma unroll
      for (int h = 0; h < 6; ++h) red[(w * 6 + h) * 64 + lane] = o[h]; }
    asm volatile("s_waitcnt lgkmcnt(0)" ::: "memory"); __syncthreads();
    outh[0] = 0.f;
    if (tid < 384) { float a = 0.f;
#pragma unroll
        for (int ww = 0; ww < NWAVES; ++ww) a += red[ww * 384 + tid]; outh[0] = a; }
    if (!keep_probs) { __syncthreads(); }
}
DI void nsa_sample_item(const FP& P, const Ctx& C, int ns, int kvh) {
    LAS float* qs = (LAS float*)C.lds; LAS float* S = qs + 384; LAS float* red = S + 6 * SMP_SK; LAS float* scs = red + 8 * 384; LAS int* sel = (LAS int*)(scs + 136);
    const int tid = C.tid, row = M0 + ns;
    if (tid < 384) qs[tid] = bf2f(P.QB[(size_t)row * NSA_Q_COLS + kvh * 384 + tid]);
    asm volatile("s_waitcnt lgkmcnt(0)" ::: "memory"); __syncthreads();
    const float* ckf = P.CKF + ((size_t)ns * NSA_KV_HEADS + kvh) * NCH * 64; const float* cvf = P.CVF + ((size_t)ns * NSA_KV_HEADS + kvh) * NCH * 64;
    float oc[1], os[1], ow[1];
    smp_branch(C, qs, S, red, NCMP, [&](int j) { return ckf + (size_t)j * 64; }, [&](int j) { return cvf + (size_t)j * 64; }, true, oc);
    constexpr int NBS = (PAST_LEN + 1 + SLC_BLOCK - 1) / SLC_BLOCK, CURS = PAST_LEN / SLC_BLOCK;
    for (int b = tid; b < 136; b += NTHREADS) { float sv = -3.0e38f;
        if (b < NBS) { if (b == 0 || b == CURS || b == CURS - 1) sv = FORCE_SCORE; else { float a = 0.f;
#pragma unroll
                for (int o = -1; o <= 3; ++o) { const int ci = 4 * b + o; if (ci >= 0 && ci < NCMP) { float sm = 0.f; for (int h6 = 0; h6 < 6; ++h6) sm += S[h6 * SMP_SK + ci]; a += ((o >= 0 && o <= 2) ? 2.f : 1.f) * sm; } }
                sv = a; } }
        scs[b] = sv; }
    asm volatile("s_waitcnt lgkmcnt(0)" ::: "memory"); __syncthreads();
    for (int b = tid; b < NBS; b += NTHREADS) { const float sv = scs[b]; int rank = 0; for (int j = 0; j < NBS; ++j) { const float o = scs[j]; rank += (o > sv || (o == sv && j < b)) ? 1 : 0; }
        if (rank < SLC_TOPK) { sel[rank] = b; P.SELB[((size_t)row * NSA_KV_HEADS + kvh) * 16 + rank] = b; } }
    asm volatile("s_waitcnt lgkmcnt(0)" ::: "memory"); __syncthreads();
    { const float* newrow = P.nsa_kv_s + (size_t)ns * 512; const int* pt = P.page_table + ns * (PAST_LEN / PAGE_SIZE);
      if (tid == 0) { int seen = 0; for (int x = 0; x < SLC_TOPK; ++x) { const int bx = sel[x]; if (bx != CURS && seen < 15) sel[16 + seen++] = bx; } }
      asm volatile("s_waitcnt lgkmcnt(0)" ::: "memory"); __syncthreads();
      auto krow = [&](int j, int ty) -> const float* { if (j >= 15 * 64) return newrow + ty * 128 + kvh * 64;
          const int t0 = sel[16 + (j >> 6)] * SLC_BLOCK + (j & 63); const int pg = pt[t0 / PAGE_SIZE]; return P.cache_nsa_kv + ((size_t)pg * PAGE_SIZE + t0 % PAGE_SIZE) * 512 + ty * 128 + kvh * 64; };
      smp_branch(C, qs, S, red, 15 * 64 + 1, [&](int j) { return krow(j, 2); }, [&](int j) { return krow(j, 3); }, false, os); }
    { const float* wc = P.cache_nsa_win + (size_t)ns * SWA_WINDOW * 256; const float* newrow = P.win_s + ((size_t)ns * SWA_WINDOW + SWA_WINDOW - 1) * 256;
      smp_branch(C, qs, S, red, SWA_WINDOW + 1, [&](int j) { return (j < SWA_WINDOW ? wc + (size_t)j * 256 : newrow) + kvh * 64; }, [&](int j) { return (j < SWA_WINDOW ? wc + (size_t)j * 256 : newrow) + 128 + kvh * 64; }, false, ow); }
    if (tid < 384) { const int head = kvh * NSA_GROUP + tid / 64; const float* gt = P.GATES + (size_t)row * 64 + head * 3;
        P.ATTB[(size_t)row * 1024 + kvh * 384 + tid] = (bf16)f2bf(gt[0] * oc[0] + gt[1] * os[0] + gt[2] * ow[0]);
#ifdef NSA_DEBUG
        P.DBG[((size_t)0 * MP + row) * 768 + kvh * 384 + tid] = oc[0]; P.DBG[((size_t)1 * MP + row) * 768 + kvh * 384 + tid] = os[0]; P.DBG[((size_t)2 * MP + row) * 768 + kvh * 384 + tid] = ow[0];
#endif
    }
    __syncthreads();
}
DI void nsa_pairs(const FP& P, const Ctx& C, bool second) {
    LAS unsigned char* wl = C.lds + C.wave * NSA_WLDS;
    const int per = C.G / 4 > 0 ? C.G / 4 : 1, grp = (C.vcu / per) & 3, sub = C.vcu % per, n = grp >> 1, kvh = grp & 1;
#pragma unroll 1
    for (int pr = sub * NWAVES + C.wave; pr < SEQ / 2; pr += per * NWAVES) { if (second) nsa_pair_b(P, n, kvh, 2 * pr, C.lane, wl); else nsa_pair_a(P, n, kvh, 2 * pr, C.lane, wl); }
}
DI void nsa_phase_a(const FP& P, const Ctx& C) {
    for (int it = C.vcu; it < DEC_BATCH * NSA_KV_HEADS; it += C.G) nsa_sample_item(P, C, it / NSA_KV_HEADS, it % NSA_KV_HEADS);
    nsa_pairs(P, C, false);
    __syncthreads();
}
DI void nsa_phase_b(const FP& P, const Ctx& C) {
    const int lane = C.lane, w = C.wave;
    nsa_pairs(P, C, true);
    __syncthreads();
    { constexpr int NMT = (M0 / 16) * MEM_HEADS;
      for (int it = C.vcu * NWAVES + w; it < NMT; it += C.G * NWAVES) { const int h = it % MEM_HEADS, q16 = it / MEM_HEADS, row0 = q16 * 16, n = row0 / SEQ;
          mem_micro(P, P.MQB + h * 64, 256, row0, 1, n, h, P.ATTB + NSA_Q_COLS + h * 64, 1024, lane); }
    }
    { LAS float* qs = (LAS float*)C.lds;
      for (int it = C.vcu; it < DEC_BATCH * MEM_HEADS; it += C.G) { const int h = it % MEM_HEADS, ns = it / MEM_HEADS, row = M0 + ns;
          __syncthreads(); if (C.tid < 64) qs[C.tid] = bf2f(P.MQB[(size_t)row * 256 + h * 64 + C.tid]); asm volatile("s_waitcnt lgkmcnt(0)" ::: "memory"); __syncthreads();
          Dec D; D.m = -INFINITY; D.l = 0.f; D.o = 0.f; const float* mk = P.cache_mem_kv + ((size_t)1 * DEC_BATCH + ns) * MEM_TOKENS * 512;
          for (int ck = w; ck < MEM_TOKENS / 64; ck += NWAVES) { const int j0 = ck * 64; dec_chunk(D, qs, 64, [&](int j) { return mk + (size_t)(j0 + j) * 512 + h * 64; }, [&](int j) { return mk + (size_t)(j0 + j) * 512 + 256 + h * 64; }, lane); }
          const float o = dec_combine(C, D);
          if (w == 0) P.ATTB[(size_t)row * 1024 + NSA_Q_COLS + h * 64 + lane] = (bf16)f2bf(o); } }
    __syncthreads();
}
}
namespace fx {
enum { PH_PRO = 0, PH_G1, PH_ATTA, PH_G2, PH_LN1, PH_SC0, PH_TK0, PH_PU0, PH_PG0, PH_G3, PH_CMPG, PH_CMP2, PH_NSA, PH_NSB, PH_G4, PH_LN3, PH_SC1, PH_TK1, PH_PU1, PH_PG1, PH_COUNT };
template <class Epi> DI void run_gemm(const Ctx& C, const bf16* A, const bf16* Bt, int M, int N, int K, const Epi& E) {
    pg8::Gemm g{A, Bt, M, N, K}; pg8::StaticOrder S; S.init(M, N, C.G, (int)blockIdx.x);
    pg8::gemm_phase<Epi, pg8::StaticOrder, true, true>(C.lds, g, S, E);
}
template <class Epi> DI void skinny_gemm(const Ctx& C, const bf16* A, const bf16* Bt, int N, int K, const Epi& E) {
    static_assert(DEC_BATCH == 32 && M0 % 256 == 0, "skinny_gemm: 32 sample rows right after a whole number of 256-row tiles");
    const int lane = C.lane, fr = lane & 15, fq = lane >> 4, w = C.wave; const int NI = (N / 256) * 4, KW = K / NWAVES;
    LAS f32x4* red = (LAS f32x4*)C.lds;
#pragma unroll 1
    for (int item = C.vcu; item < NI; item += C.G) { const int pn = item >> 2, wc = item & 3;
        f32x4 pa[2][2][2];
#pragma unroll
        for (int i = 0; i < 8; ++i) (&pa[0][0][0])[i] = (f32x4){0.f, 0.f, 0.f, 0.f};
        const bf16* xa = A + (size_t)(M0 + fr) * K + w * KW + 8 * fq; const bf16* xb = xa + (size_t)16 * K;
        const bf16* wp[2][2];
#pragma unroll
        for (int bj = 0; bj < 2; ++bj)
#pragma unroll
            for (int n = 0; n < 2; ++n) wp[bj][n] = Bt + (size_t)(pn * 256 + bj * 128 + wc * 32 + 8 * (fr >> 2) + 4 * n + (fr & 3)) * K + w * KW + 8 * fq;
#pragma unroll 4
        for (int k0 = 0; k0 < KW; k0 += 32) { const bf16x8 x0 = *(const bf16x8*)(xa + k0), x1 = *(const bf16x8*)(xb + k0);
#pragma unroll
            for (int bj = 0; bj < 2; ++bj)
#pragma unroll
                for (int n = 0; n < 2; ++n) { const bf16x8 wf = *(const bf16x8*)(wp[bj][n] + k0);
                    pa[bj][0][n] = __builtin_amdgcn_mfma_f32_16x16x32_bf16(wf, x0, pa[bj][0][n], 0, 0, 0); pa[bj][1][n] = __builtin_amdgcn_mfma_f32_16x16x32_bf16(wf, x1, pa[bj][1][n], 0, 0, 0); } }
        __syncthreads();
#pragma unroll
        for (int bj = 0; bj < 2; ++bj)
#pragma unroll
            for (int mm = 0; mm < 2; ++mm)
#pragma unroll
                for (int n = 0; n < 2; ++n) red[(w * 8 + bj * 4 + mm * 2 + n) * 64 + lane] = pa[bj][mm][n];
        asm volatile("s_waitcnt lgkmcnt(0)" ::: "memory"); __syncthreads();
        if (w == 0) { f32x4 acc[2][2][4][2];
#pragma unroll
            for (int i = 0; i < 32; ++i) (&acc[0][0][0][0])[i] = (f32x4){0.f, 0.f, 0.f, 0.f};
#pragma unroll
            for (int bj = 0; bj < 2; ++bj)
#pragma unroll
                for (int mm = 0; mm < 2; ++mm)
#pragma unroll
                    for (int n = 0; n < 2; ++n) { f32x4 s = red[(bj * 4 + mm * 2 + n) * 64 + lane];
#pragma unroll 1
                        for (int ww = 1; ww < NWAVES; ++ww) s += red[(ww * 8 + bj * 4 + mm * 2 + n) * 64 + lane];
                        acc[0][bj][mm][n] = s; }
            E(acc, pg8::Unit{M0 / 256, pn}, 0, wc, fr, fq); }
    }
    __syncthreads();
}
__global__ void __launch_bounds__(NTHREADS, 2) mega(Args args) {
    extern __shared__ __attribute__((aligned(16))) unsigned char lds_raw[];
    Ctx C; C.lds = (LAS unsigned char*)lds_raw; C.tid = threadIdx.x; C.lane = C.tid & 63; C.wave = __builtin_amdgcn_readfirstlane(C.tid >> 6);
    C.G = gridDim.x; { const int bx = blockIdx.x; C.vcu = (C.G % 8 == 0) ? (bx % 8) * (C.G / 8) + bx / 8 : bx; }
    const FP& P = args.p;
    volatile LAS unsigned* MISC = (volatile LAS unsigned*)(C.lds + MISC_OFF);
    for (int u = C.tid; u < (LDS_BYTES - RING_BYTES) / 4; u += NTHREADS) ((LAS unsigned*)(C.lds + RING_BYTES))[u] = 0u;
    __syncthreads();
    const int lo = args.lo, hi = args.hi;
    XcdBarrier bar; bar.bar = P.ctl + 1024; bar.x = 0; bar.st = nullptr;
    if (hi - lo > 1) bar = xcd_barrier_post(P.ctl + 1024, MISC + 8);
#define IN(k) (lo <= (k) && (k) < hi)
#define SEAM(k) do { if ((k) == PH_ATTA && IN(k)) bgq_drain(P, C, MISC + 12, BGQ_L_A);     \
        if ((k) == PH_TK0 && IN(k)) bgq_drain(P, C, MISC + 12, BGQ_L_UV); \
        if ((k) == PH_G3 && IN(k)) bgq_drain(P, C, MISC + 12, BGQ_L_AC); \
        if ((k) == PH_COUNT - 1 && IN(k)) bgq_drain(P, C, MISC + 12, BGQ_TOTAL); \
        if (IN(k) && IN((k) + 1)) xcd_barrier_bg(bar, P, C, MISC + 12); } while (0)
#ifndef DUP_PHASE
#define DUP_PHASE -1
#endif
#define PHASE(k, ...) do { if (IN(k)) { __VA_ARGS__ if (DUP_PHASE == (k)) { __syncthreads(); __VA_ARGS__ } } SEAM(k); } while (0)
    PHASE(PH_PRO, p0_prologue(P, C););
    PHASE(PH_G1, run_gemm(C, P.XB0, P.WA_T, M0, ACOLS, D_MODEL, EpiA{P}); run_gemm(C, P.MEMB, P.WMEM_T, BATCH * MEM_TOKENS, 1024, D_MODEL, EpiMem{P}); skinny_gemm(C, P.XB0, P.WA_T, ACOLS, D_MODEL, EpiA{P}););
#ifdef PEER_SHARD3
#define PEER_SHARDED_FN peer_sharded3_phase
#else
#define PEER_SHARDED_FN peer_sharded2_phase
#endif
#if defined(PEER_SOFTSYNC) && !defined(PEER_SHARD3)
#define PEER_HINT_ARGS , bar.st, bar.x
#else
#define PEER_HINT_ARGS
#endif
    PHASE(PH_ATTA, atta_phase(P, C););
    PHASE(PH_G2, run_gemm(C, P.ATTA, P.WOA_T, M0, D_MODEL, 512, EpiPre{P.x_prompt, P.x_sample, P.PRE}); skinny_gemm(C, P.ATTA, P.WOA_T, D_MODEL, 512, EpiPre{P.x_prompt, P.x_sample, P.PRE}););
    PHASE(PH_LN1, ln_phase(P, C, P.PRE, P.ln_g, P.ln_b, P.X1, P.X1B, nullptr, nullptr););
    PHASE(PH_SC0, run_gemm(C, P.X1B, P.WPK_T, M0, NPK, D_MODEL, EpiF32{P.SCO, NPK, MP}); skinny_gemm(C, P.X1B, P.WPK_T, NPK, D_MODEL, EpiF32{P.SCO, NPK, MP}););
    PHASE(PH_TK0, topk_phase(P, C););
#ifdef PEER_SPLIT
    PHASE(PH_PU0, peer_u_phase(P, C, 0, P.X1B););
    PHASE(PH_PG0, peer_v_phase(P, C, 0, P.X1, P.X2, P.X2 + (size_t)M0 * D_MODEL, P.X2B););
#elif defined(PEER_SHARD2)
    PHASE(PH_PG0, const bool shd = (M0 % (C.G * NWAVES * PS2_ROWS)) == 0; if (shd) { PEER_SHARDED_FN(P, C, 0, P.X1, P.X1B, P.X2, P.X2B PEER_HINT_ARGS); __syncthreads(); } peer_phase(P, C, 0, P.X1, P.X2, P.X2 + (size_t)M0 * D_MODEL, P.X2B, shd););
#elif defined(PEER_SHARD)
    PHASE(PH_PG0, peer_sharded_phase(P, C, 0, P.X1, P.X1B, P.X2, P.X2 + (size_t)M0 * D_MODEL, P.X2B); __syncthreads(); peer_phase(P, C, 0, P.X1, P.X2, P.X2 + (size_t)M0 * D_MODEL, P.X2B););
#else
    PHASE(PH_PG0, peer_phase(P, C, 0, P.X1, P.X2, P.X2 + (size_t)M0 * D_MODEL, P.X2B););
#endif
    PHASE(PH_G3, run_gemm(C, P.X2B, P.WB_T, M0, NB_T, D_MODEL, EpiB{P}); skinny_gemm(C, P.X2B, P.WB_T, NB_T, D_MODEL, EpiB{P}););
    PHASE(PH_CMPG, run_gemm(C, P.AC, P.CW1_T, ACROWS, 256, 1024, EpiF32{P.UL, 256, ACROWS}); run_gemm(C, P.AC + (size_t)ACROWS * 1024, P.CW1_T + 256 * 1024, ACROWS, 256, 1024, EpiF32{P.UL + (size_t)ACROWS * 256, 256, ACROWS}););
    PHASE(PH_CMP2, cmp2_phase(P, C););
    PHASE(PH_NSA, nsa_phase_a(P, C););
    PHASE(PH_NSB, nsa_phase_b(P, C););
    PHASE(PH_G4, run_gemm(C, P.ATTB, P.WOB_T, M0, D_MODEL, 1024, EpiPre{P.X2, nullptr, P.PRE}); skinny_gemm(C, P.ATTB, P.WOB_T, D_MODEL, 1024, EpiPre{P.X2, nullptr, P.PRE}););
    PHASE(PH_LN3, ln_phase(P, C, P.PRE, P.ln_g + 2 * D_MODEL, P.ln_b + 2 * D_MODEL, P.X3, P.X3B, nullptr, nullptr););
    PHASE(PH_SC1, run_gemm(C, P.X3B, P.WPK_T + (size_t)NPK * D_MODEL, M0, NPK, D_MODEL, EpiF32{P.SCO, NPK, MP}); skinny_gemm(C, P.X3B, P.WPK_T + (size_t)NPK * D_MODEL, NPK, D_MODEL, EpiF32{P.SCO, NPK, MP}););
    PHASE(PH_TK1, topk_phase(P, C););
#ifdef PEER_SPLIT
    PHASE(PH_PU1, peer_u_phase(P, C, 1, P.X3B););
    PHASE(PH_PG1, peer_v_phase(P, C, 1, P.X3, P.y_prompt, P.y_sample, nullptr););
#elif defined(PEER_SHARD2)
    PHASE(PH_PG1, const bool shd = (M0 % (C.G * NWAVES * PS2_ROWS)) == 0; if (shd) { PEER_SHARDED_FN(P, C, 1, P.X3, P.X3B, P.y_prompt, nullptr PEER_HINT_ARGS); __syncthreads(); } peer_phase(P, C, 1, P.X3, P.y_prompt, P.y_sample, nullptr, shd););
#elif defined(PEER_SHARD)
    PHASE(PH_PG1, peer_sharded_phase(P, C, 1, P.X3, P.X3B, P.y_prompt, P.y_sample, nullptr); __syncthreads(); peer_phase(P, C, 1, P.X3, P.y_prompt, P.y_sample, nullptr););
#else
    PHASE(PH_PG1, peer_phase(P, C, 1, P.X3, P.y_prompt, P.y_sample, nullptr););
#endif
#undef IN
#undef SEAM
}
}
#ifndef ONE_LAUNCH
#define ONE_LAUNCH 1
#endif
extern "C" void kernel_launch(void* const* d_in, const int* in_sizes, int n_in, void* d_out, int out_size, void* d_ws, size_t ws_size, hipStream_t stream) {
    fx::Args a; memset(&a, 0, sizeof(a)); fx::bind_io(a.p, d_in, (float*)d_out);
    const size_t f_need = fx::carve(a.p, d_ws);
    if (f_need > ws_size) { fprintf(stderr, "kernel_launch: workspace too small: need %zu have %zu\n", f_need, ws_size); return; }
    static int grid = 0;
    if (!grid) { int dev = 0, cus = 0, per_cu = 0; (void)hipGetDevice(&dev); (void)hipDeviceGetAttribute(&cus, hipDeviceAttributeMultiprocessorCount, dev);
        (void)hipFuncSetAttribute((const void*)fx::mega, hipFuncAttributeMaxDynamicSharedMemorySize, fx::LDS_BYTES);
        if (hipOccupancyMaxActiveBlocksPerMultiprocessor(&per_cu, (const void*)fx::mega, fx::NTHREADS, fx::LDS_BYTES) != hipSuccess || per_cu < 1) { fprintf(stderr, "kernel_launch: occupancy query says %d blocks per CU\n", per_cu); (void)hipGetLastError(); }
        grid = cus; }
    (void)hipMemsetAsync(a.p.ctl, 0, fx::CTL_BYTES, stream);
#if ONE_LAUNCH
    a.lo = 0; a.hi = fx::PH_COUNT; hipLaunchKernelGGL(fx::mega, dim3(grid), dim3(fx::NTHREADS), fx::LDS_BYTES, stream, a);
#else
    for (int k = 0; k < fx::PH_COUNT; ++k) { a.lo = k; a.hi = k + 1; hipLaunchKernelGGL(fx::mega, dim3(grid), dim3(fx::NTHREADS), fx::LDS_BYTES, stream, a); }
#endif
}
```

```cpp
#define PEER_SHARD2 1
#define ONE_LAUNCH 1
#include <hip/hip_runtime.h>
#include <cstdio>
#include <cstring>
#include <cmath>
#ifdef CPU_TEST
#define HD inline
constexpr int D_MODEL = 128, BATCH = 2, SEQ = 512, DEPTH = 2, DEC_BATCH = 3, DEC_SEQ = 1, PAST_LEN = 512, PAGE_SIZE = 128;
constexpr int DIL_W[3] = {16, 64, 256}, DIL_D[3] = {1, 4, 16}, DIL_TAPS = 17;
constexpr int MEM_TOKENS = 32, SLC_TOPK = 4, SWA_WINDOW = 64, PEER_KEYS = 16, PEER_TOPK = 4;
#else
#define HD __host__ __device__ __forceinline__
constexpr int D_MODEL = 1024, BATCH = 2, SEQ = 8192, DEPTH = 2, DEC_BATCH = 32, DEC_SEQ = 1, PAST_LEN = 8192, PAGE_SIZE = 128;
constexpr int DIL_W[3] = {128, 512, 2048}, DIL_D[3] = {1, 4, 16}, DIL_TAPS = 129;
constexpr int MEM_TOKENS = 256, SLC_TOPK = 16, SWA_WINDOW = 512, PEER_KEYS = 128, PEER_TOPK = 16;
#endif
HD constexpr int dil_w(int g) { return g == 0 ? DIL_W[0] : (g == 1 ? DIL_W[1] : DIL_W[2]); }
HD constexpr int dil_d(int g) { return g == 0 ? DIL_D[0] : (g == 1 ? DIL_D[1] : DIL_D[2]); }
constexpr int HEAD_DIM = 64, N_A_LAYERS = DEPTH / 2, N_DIL = 3, DIL_HEADS = 4, DIL_COLS = N_DIL * 3 * DIL_HEADS * HEAD_DIM;
constexpr int MEM_HEADS = 4, MEM_COLS = MEM_HEADS * HEAD_DIM;
constexpr int NSA_HEADS = 12, NSA_KV_HEADS = 2, NSA_GROUP = 6, NSA_Q_COLS = NSA_HEADS * HEAD_DIM, NSA_GATE_COLS = NSA_HEADS * 3;
constexpr int CMP_BLOCK = 32, CMP_STRIDE = 16, CMP_HIDDEN = 128, SLC_BLOCK = 64;
constexpr int PEER_EXPERTS = PEER_KEYS * PEER_KEYS, PEER_HEADS = 8, PEER_KEY_DIM = 128;
constexpr float FORCE_SCORE = 1.0e9f, NEG = -1.0e30f, SCALE = 0.125f, LN_EPS = 1e-5f;
constexpr float ALPHA = 1.41421356237309515f;
constexpr float BETA = 0.5f;
#define LAS __attribute__((address_space(3)))
namespace pg8 {
#define PG8_LAS __attribute__((address_space(3)))
typedef unsigned short bf16_t;
typedef short bf16x8 __attribute__((ext_vector_type(8)));
typedef float f32x4 __attribute__((ext_vector_type(4)));
typedef unsigned u32x4 __attribute__((ext_vector_type(4)));
constexpr int BM = 256, BK = 64, HALF = 128, HTB = HALF * BK * 2  , STAGE_BYTES = 8 * HTB, NXCD = 8, WGM = 8;

__host__ __device__ __forceinline__ int lds_byte(int r, int c) { const int st = (r >> 4) * 2 + (c >> 5), rr = r & 15, cc = c & 31, ob = rr * 64 + cc * 2; return st * 1024 + (ob ^ (((ob >> 9) & 1) << 5)); }
__host__ __device__ __forceinline__ void stage_rc(int b, int& R, int& C) { const int st = b / 1024, sb = b % 1024, swz = sb ^ (((sb >> 9) & 1) << 5); R = (st >> 1) * 16 + swz / 64; C = (st & 1) * 32 + (swz % 64) / 2; }
__host__ __device__ __forceinline__ int perm32(int rho) { const int n = rho >> 4, i = rho & 15; return 8 * (i >> 2) + 4 * n + (i & 3); }

struct Unit { int pm, pn; };
struct Gemm { const bf16_t* A; const bf16_t* Bt; int M, N, K; };

struct StaticOrder {
    int nM, nN, nwg, G, c;
    __host__ __device__ void init(int M, int N, int G_, int c_) { nM = M / BM; nN = N / BM; nwg = nM * nN; G = G_; c = c_; }
    __host__ __device__ bool next(int i, Unit& u) const {
        const long L = (long)i * G + c; if (L >= nwg) return false;
        int wgid = (int)L; { const int q = nwg / NXCD, r = nwg % NXCD, xcd = wgid % NXCD, off = wgid / NXCD; wgid = (xcd < r ? xcd * (q + 1) : r * (q + 1) + (xcd - r) * q) + off; }
        const int nig = WGM * nN, gid = wgid / nig, fm = gid * WGM, gsz = (nM - fm) < WGM ? (nM - fm) : WGM;
        u.pm = fm + ((wgid % nig) % gsz); u.pn = (wgid % nig) / gsz; return true;
    }
    __device__ __forceinline__ void a_ready(const Unit&) const {}
    __device__ __forceinline__ void done(const Unit&) const {}
};

__device__ __forceinline__ unsigned cvt_pk_bf16(float lo, float hi) { unsigned r; asm volatile("v_cvt_pk_bf16_f32 %0, %1, %2" : "=v"(r) : "v"(lo), "v"(hi)); return r; }
typedef float f32x2 __attribute__((ext_vector_type(2)));
typedef float f32x2 __attribute__((ext_vector_type(2)));
template <class Epi, class Sched, bool ALIGN_EPI = false, bool SP2 = false>
__device__ __forceinline__ void gemm_phase(PG8_LAS unsigned char* lds, const Gemm g, const Sched& S, const Epi& E) {
    const int tid = threadIdx.x, wid = __builtin_amdgcn_readfirstlane(tid >> 6), lane = tid & 63, wr = wid >> 2, wc = wid & 3, fr = lane & 15, fq = lane >> 4;
    const int K = g.K, nt = K / BK;
    unsigned voffA[2], voffB[2];
#pragma unroll
    for (int i = 0; i < 2; ++i) { int R, C; stage_rc(tid * 16 + i * 8192, R, C); const int Rb = Epi::PERM ? ((R & ~31) + perm32(R & 31)) : R;
        voffA[i] = (unsigned)(R * K + C) * 2u; voffB[i] = (unsigned)(Rb * K + C) * 2u; }
    const size_t kstep = (size_t)(BK * 2);
    const size_t hstep = (size_t)HALF * K * 2;
    const size_t tstep = 2 * hstep;
    const unsigned ldsw = (unsigned)wid * 1024u;
    const int aoff = lds_byte(wr * 64 + fr, fq * 8), boff = lds_byte(wc * 32 + fr, fq * 8);
#define PG8_SA(b, h) (((b) * 2 + (h)) * HTB)
#define PG8_SB(b, h) ((4 + (b) * 2 + (h)) * HTB)
#define PG8_STAGE(bufoff, gbase, voff) do { _Pragma("unroll") for (int _i = 0; _i < 2; ++_i) \
        __builtin_amdgcn_global_load_lds((const unsigned*)((const char*)(gbase) + (voff)[_i]), (PG8_LAS unsigned*)(lds + (bufoff) + ldsw + _i * 8192), 16, 0, 0); } while (0)
#define PG8_LDA(dst, b, h) do { _Pragma("unroll") for (int m = 0; m < 4; ++m) _Pragma("unroll") for (int k = 0; k < 2; ++k) dst[m][k] = *(const PG8_LAS bf16x8*)(lds + PG8_SA(b, h) + aoff + m * 2048 + k * 1024); } while (0)
#define PG8_LDB(dst, b, h) do { _Pragma("unroll") for (int n = 0; n < 2; ++n) _Pragma("unroll") for (int k = 0; k < 2; ++k) dst[n][k] = *(const PG8_LAS bf16x8*)(lds + PG8_SB(b, h) + boff + n * 2048 + k * 1024); } while (0)
#define PG8_MMA(ai, bj, At, Bt) do { __builtin_amdgcn_s_setprio(1); _Pragma("unroll") for (int m = 0; m < 4; ++m) _Pragma("unroll") for (int n = 0; n < 2; ++n) _Pragma("unroll") for (int k = 0; k < 2; ++k) \
        acc[ai][bj][m][n] = __builtin_amdgcn_mfma_f32_16x16x32_bf16(Bt[n][k], At[m][k], acc[ai][bj][m][n], 0, 0, 0); __builtin_amdgcn_s_setprio(0); } while (0)
#define PG8_WAIT_V(n) asm volatile("s_waitcnt vmcnt(" #n ")" ::: "memory")
#define PG8_WAIT_L(n) asm volatile("s_waitcnt lgkmcnt(" #n ")" ::: "memory")
#define PG8_BAR __builtin_amdgcn_s_barrier()
#define PG8_SCHED __builtin_amdgcn_sched_barrier(0)
    Unit cur, nxt; int ui = 0;
    if (!S.next(0, cur)) return;
    f32x4 acc[2][2][4][2];
#pragma unroll
    for (int a = 0; a < 2; ++a)
#pragma unroll
        for (int b = 0; b < 2; ++b)
#pragma unroll
            for (int m = 0; m < 4; ++m)
#pragma unroll
                for (int n = 0; n < 2; ++n) acc[a][b][m][n] = (f32x4){0.f, 0.f, 0.f, 0.f};
    bf16x8 At[4][2], B0[2][2], B1[2][2];
    const char* cA = (const char*)g.A + (size_t)cur.pm * tstep; const char* cB = (const char*)g.Bt + (size_t)cur.pn * tstep;
    S.a_ready(cur);
    if constexpr (SP2) {
        PG8_STAGE(PG8_SB(0, 0), cB, voffB); PG8_STAGE(PG8_SB(0, 1), cB + hstep, voffB); PG8_STAGE(PG8_SA(0, 0), cA, voffA); PG8_STAGE(PG8_SA(0, 1), cA + hstep, voffA);
        if (wr == 1) PG8_BAR;
        PG8_WAIT_V(2); PG8_BAR;
        PG8_STAGE(PG8_SB(1, 0), cB + kstep, voffB); PG8_STAGE(PG8_SA(1, 0), cA + kstep, voffA); PG8_STAGE(PG8_SB(1, 1), cB + hstep + kstep, voffB);
        PG8_WAIT_V(6); PG8_BAR;
    } else {
        PG8_STAGE(PG8_SB(0, 0), cB, voffB); PG8_STAGE(PG8_SA(0, 0), cA, voffA); PG8_STAGE(PG8_SB(0, 1), cB + hstep, voffB); PG8_STAGE(PG8_SA(0, 1), cA + hstep, voffA);
        if (wr == 1) PG8_BAR;
        PG8_WAIT_V(4); PG8_BAR;
        PG8_STAGE(PG8_SB(1, 0), cB + kstep, voffB); PG8_STAGE(PG8_SA(1, 0), cA + kstep, voffA); PG8_STAGE(PG8_SB(1, 1), cB + hstep + kstep, voffB);
        PG8_WAIT_V(6); PG8_BAR;
    }
    for (;;) {
        const bool has_next = S.next(ui + 1, nxt);
        const char* nA = has_next ? (const char*)g.A + (size_t)nxt.pm * tstep : cA; const char* nB = has_next ? (const char*)g.Bt + (size_t)nxt.pn * tstep : cB;
        for (int t = 0; t < nt; t += 2) {
            const bool last = (t == nt - 2);
            const char* a1 = cA + (size_t)(t + 1) * kstep;
            const char* a2 = last ? nA : cA + (size_t)(t + 2) * kstep; const char* b2 = last ? nB : cB + (size_t)(t + 2) * kstep;
            const char* a3 = a2 + kstep; const char* b3 = b2 + kstep;
            if (last && has_next) S.a_ready(nxt);
            if constexpr (SP2) {
            PG8_LDB(B0, 0, 0); PG8_LDB(B1, 0, 1); PG8_SCHED; PG8_LDA(At, 0, 0); PG8_STAGE(PG8_SA(1, 1), a1 + hstep, voffA);
            PG8_WAIT_V(8); PG8_WAIT_L(0); PG8_BAR; PG8_MMA(0, 0, At, B0); PG8_MMA(0, 1, At, B1); PG8_BAR; PG8_SCHED;
            PG8_LDA(At, 0, 1); PG8_STAGE(PG8_SB(0, 0), b2, voffB); PG8_STAGE(PG8_SB(0, 1), b2 + hstep, voffB); PG8_STAGE(PG8_SA(0, 0), a2, voffA);
            PG8_WAIT_V(8); PG8_WAIT_L(0); PG8_BAR; PG8_MMA(1, 0, At, B0); PG8_MMA(1, 1, At, B1); PG8_BAR; PG8_SCHED;
            PG8_LDB(B0, 1, 0); PG8_LDB(B1, 1, 1); PG8_SCHED; PG8_LDA(At, 1, 0); PG8_STAGE(PG8_SA(0, 1), a2 + hstep, voffA);
            PG8_WAIT_V(8); PG8_WAIT_L(0); PG8_BAR; PG8_MMA(0, 0, At, B0); PG8_MMA(0, 1, At, B1); PG8_BAR; PG8_SCHED;
            PG8_LDA(At, 1, 1); PG8_STAGE(PG8_SB(1, 0), b3, voffB); PG8_STAGE(PG8_SB(1, 1), b3 + hstep, voffB); PG8_STAGE(PG8_SA(1, 0), a3, voffA);
            PG8_WAIT_V(8); PG8_WAIT_L(0); PG8_BAR; PG8_MMA(1, 0, At, B0); PG8_MMA(1, 1, At, B1); PG8_BAR; PG8_SCHED;
            } else {
            PG8_LDB(B0, 0, 0); PG8_SCHED; PG8_LDA(At, 0, 0); PG8_STAGE(PG8_SA(1, 1), a1 + hstep, voffA);
            PG8_WAIT_L(8); PG8_BAR; PG8_WAIT_L(0); PG8_MMA(0, 0, At, B0); PG8_BAR; PG8_SCHED;
            PG8_LDB(B1, 0, 1); PG8_STAGE(PG8_SB(0, 0), b2, voffB);
            PG8_BAR; PG8_WAIT_L(0); PG8_MMA(0, 1, At, B1); PG8_BAR;
            PG8_LDA(At, 0, 1); PG8_STAGE(PG8_SA(0, 0), a2, voffA);
            PG8_BAR; PG8_WAIT_L(0); PG8_MMA(1, 0, At, B0); PG8_BAR; PG8_SCHED;
            PG8_STAGE(PG8_SB(0, 1), b2 + hstep, voffB);
            PG8_WAIT_V(6); PG8_BAR; PG8_MMA(1, 1, At, B1); PG8_BAR;
            PG8_LDB(B0, 1, 0); PG8_SCHED; PG8_LDA(At, 1, 0); PG8_STAGE(PG8_SA(0, 1), a2 + hstep, voffA);
            PG8_WAIT_L(8); PG8_BAR; PG8_WAIT_L(0); PG8_MMA(0, 0, At, B0); PG8_BAR; PG8_SCHED;
            PG8_LDB(B1, 1, 1); PG8_STAGE(PG8_SB(1, 0), b3, voffB);
            PG8_BAR; PG8_WAIT_L(0); PG8_MMA(0, 1, At, B1); PG8_BAR;
            PG8_LDA(At, 1, 1); PG8_STAGE(PG8_SA(1, 0), a3, voffA);
            PG8_BAR; PG8_WAIT_L(0); PG8_MMA(1, 0, At, B0); PG8_BAR; PG8_SCHED;
            PG8_STAGE(PG8_SB(1, 1), b3 + hstep, voffB);
            PG8_WAIT_V(6); PG8_BAR; PG8_MMA(1, 1, At, B1); PG8_BAR;
            }
        }
        if constexpr (ALIGN_EPI) { if (wr == 0) PG8_BAR; }
        if constexpr (!Epi::AFTER_DRAIN) { E(acc, cur, wr, wc, fr, fq); S.done(cur); }
        if (!has_next) break;
#pragma unroll
        for (int a = 0; a < 2; ++a)
#pragma unroll
            for (int b = 0; b < 2; ++b)
#pragma unroll
                for (int m = 0; m < 4; ++m)
#pragma unroll
                    for (int n = 0; n < 2; ++n) acc[a][b][m][n] = (f32x4){0.f, 0.f, 0.f, 0.f};
        cur = nxt; cA = nA; cB = nB; ++ui;
        if constexpr (ALIGN_EPI) { if (wr == 1) PG8_BAR; }
    }
    PG8_WAIT_V(0);
    if constexpr (!ALIGN_EPI) { if (wr == 0) PG8_BAR; }
    PG8_BAR;
    if constexpr (Epi::AFTER_DRAIN) { E.fused(acc, cur, wr, wc, fr, fq, lds, wid, lane); S.done(cur); }
#undef PG8_SA
#undef PG8_SB
#undef PG8_STAGE
#undef PG8_LDA
#undef PG8_LDB
#undef PG8_MMA
#undef PG8_WAIT_V
#undef PG8_WAIT_L
#undef PG8_BAR
#undef PG8_SCHED
}
}
#define XB_TMO      128
#define XB_XCNT(j)  (256  + 64 * (j))
#define XB_XSUB(j)  (1280 + 64 * (j))
#define XB_XGEN(j)  (2304 + 64 * (j))
#define XB_TOP      3328
#define XB_TOPGEN   3392
#define XCD_BAR_WORDS 3456
#define XB_SPIN_CAP (1u << 18)

__device__ __forceinline__ unsigned xb_ld(unsigned* p)              { return __hip_atomic_load(p, __ATOMIC_RELAXED, __HIP_MEMORY_SCOPE_AGENT); }
__device__ __forceinline__ unsigned xb_add(unsigned* p, unsigned v) { return __hip_atomic_fetch_add(p, v, __ATOMIC_RELAXED, __HIP_MEMORY_SCOPE_AGENT); }
__device__ __forceinline__ unsigned xb_xcc_id() { return (unsigned)__builtin_amdgcn_s_getreg((3 << 11) | 20) & 0xFu; }
#define XB_SPIN(cond, bar) do { unsigned _sp = 0; while (cond) { __builtin_amdgcn_s_sleep(1); \
    if ((++_sp & 255u) == 0u) { if (xb_ld(&(bar)[XB_TMO])) break; if (_sp > XB_SPIN_CAP) { atomicAdd(&(bar)[XB_TMO], 1u); break; } } } } while (0)

struct XcdBarrier {
    unsigned* bar; unsigned x;
    volatile LAS unsigned* st;
};

__device__ __forceinline__ XcdBarrier xcd_barrier_post(unsigned* bar, volatile LAS unsigned* st) {
    XcdBarrier b; b.bar = bar; b.x = xb_xcc_id(); b.st = st;
    if (threadIdx.x == 0) (void)xb_add(&bar[XB_XCNT(b.x)], 1u);
    return b;
}
__device__ __forceinline__ void xcd_barrier_complete(unsigned* bar, unsigned x, unsigned& nloc, unsigned& nx) {
    const unsigned G = gridDim.x * gridDim.y * gridDim.z;
    unsigned sum, cnt, mine, sp = 0u;
    for (;;) {
        sum = 0u; cnt = 0u; mine = 0u;
#pragma unroll
        for (unsigned j = 0; j < 16; ++j) { const unsigned c = xb_ld(&bar[XB_XCNT(j)]); sum += c; cnt += (c > 0u) ? 1u : 0u; mine = (j == x) ? c : mine; }
        if (sum == G) break;
        __builtin_amdgcn_s_sleep(1);
        if ((++sp & 255u) == 0u) { if (xb_ld(&bar[XB_TMO])) break; if (sp > XB_SPIN_CAP) { atomicAdd(&bar[XB_TMO], 1u); break; } }
    }
    nloc = mine > 0u ? mine : 1u; nx = cnt > 0u ? cnt : 1u;
}

__device__ __forceinline__ void xcd_barrier(const XcdBarrier& b) {
    asm volatile("s_waitcnt vmcnt(0)" ::: "memory");
    __syncthreads();
    if (threadIdx.x == 0) {
        unsigned* bar = b.bar;
        __builtin_amdgcn_s_waitcnt(0);
        unsigned nloc = b.st[0], nx = b.st[1];
        if (nloc == 0u) { xcd_barrier_complete(bar, b.x, nloc, nx); b.st[0] = nloc; b.st[1] = nx; }
        const unsigned old = xb_add(&bar[XB_XSUB(b.x)], 1u);
        const unsigned gen = old / nloc;
        if (old + 1u == (gen + 1u) * nloc) {
            __builtin_amdgcn_fence(__ATOMIC_RELEASE, "agent");
            asm volatile("s_waitcnt vmcnt(0)" ::: "memory");
            const unsigned og = xb_add(&bar[XB_TOP], 1u);
            const unsigned tg = og / nx;
            if (og + 1u == (tg + 1u) * nx) xb_add(&bar[XB_TOPGEN], 1u);
            else XB_SPIN(xb_ld(&bar[XB_TOPGEN]) == tg, bar);
            __builtin_amdgcn_fence(__ATOMIC_ACQUIRE, "agent");
            xb_add(&bar[XB_XGEN(b.x)], 1u);
            asm volatile("s_waitcnt vmcnt(0)" ::: "memory");
        } else {
            XB_SPIN(xb_ld(&bar[XB_XGEN(b.x)]) == gen, bar);
            __builtin_amdgcn_fence(__ATOMIC_ACQUIRE, "agent");
            asm volatile("s_waitcnt vmcnt(0)" ::: "memory");
        }
    }
    __syncthreads();
}
namespace fx {
#define DI __device__ __forceinline__
typedef unsigned short bf16;
typedef short bf16x8 __attribute__((ext_vector_type(8)));
typedef float f32x4 __attribute__((ext_vector_type(4)));
typedef float f32x2 __attribute__((ext_vector_type(2)));
typedef unsigned u32x4 __attribute__((ext_vector_type(4)));
typedef unsigned u32x2 __attribute__((ext_vector_type(2)));
constexpr int M0 = BATCH * SEQ, MP = M0 + DEC_BATCH, MPAD = ((MP + 255) / 256) * 256;
constexpr int ACOLS = DIL_COLS + MEM_COLS, BCOLS = NSA_Q_COLS + NSA_GATE_COLS + MEM_COLS, KVCOLS = 6 * NSA_KV_HEADS * HEAD_DIM;
constexpr int NB_T = 2048;
constexpr int NPK = PEER_HEADS * 2 * PEER_KEYS;
constexpr int NCMP = (SEQ - CMP_BLOCK) / CMP_STRIDE + 1;
constexpr int NCH = SEQ / CMP_STRIDE;
constexpr int NCTX = BATCH + DEC_BATCH;
constexpr int ACROWS = NCTX * NSA_KV_HEADS * NCH;
constexpr int NPOS = PAST_LEN + 1;
constexpr float QSCALE = 0.125f * 1.4426950408889634f;
constexpr int NTHREADS = 512, NWAVES = 8, LDS_BYTES = 147456, RING_BYTES = 131072, MISC_OFF = RING_BYTES + 320;

struct FP {
    const float *x_prompt, *x_sample, *mem_prompt, *cache_dil[3], *cache_nsa_kv, *cache_nsa_win, *cache_mem_kv; const int* page_table;
    const float *w_in_a, *w_out_a, *w_in_b, *w_out_b, *w_mem_kv, *w_kv_b, *cmp_pe, *cmp_w1, *cmp_w2, *ln_g, *ln_b, *peer_wq, *peer_keys, *peer_u, *peer_v;
    float *y_prompt, *y_sample, *dil_p[3], *dil_s[3], *nsa_kv_p, *nsa_kv_s, *win_p, *win_s, *mem_kv_p;
    unsigned* ctl;
    bf16 *XB0, *X1B, *X2B, *X3B, *WA_T, *WMEM_T, *MEMB, *WOA_T, *WOB_T, *WPK_T, *WB_T, *CW1_T, *AC; unsigned char *UB8, *VB8;
    float *ROPE, *CBIAS;
    bf16 *QA, *KA, *VTA, *MQA, *MK, *MVT, *ATTA;
    float *DPART, *DML, *PRE, *X1, *X2, *X3, *SCO, *SELG; int* SELE;
    bf16 *SLK, *SLVT, *WNK, *WNVT, *QB, *MQB, *CK, *CVT, *ATTB;
    float *GATES, *UL, *CKF, *CVF;
    int* SELB;
    float* DBG;
};
struct Args { FP p; int lo, hi; };
struct Carve { size_t off = 0; template <class T> T* take(void* base, size_t n) { T* r = (T*)((char*)base + off); off += ((n * sizeof(T) + 255) / 256) * 256; return r; } };
constexpr size_t CTL_BYTES = 65536;
inline size_t carve(FP& p, void* base) {
    Carve c;
    p.ctl = c.take<unsigned>(base, CTL_BYTES / 4);
    p.XB0 = c.take<bf16>(base, (size_t)MPAD * D_MODEL); p.X1B = c.take<bf16>(base, (size_t)MPAD * D_MODEL); p.X2B = c.take<bf16>(base, (size_t)MPAD * D_MODEL); p.X3B = c.take<bf16>(base, (size_t)MPAD * D_MODEL);
    p.WA_T = c.take<bf16>(base, (size_t)ACOLS * D_MODEL); p.WMEM_T = c.take<bf16>(base, (size_t)DEPTH * 2 * MEM_COLS * D_MODEL); p.MEMB = c.take<bf16>(base, (size_t)BATCH * MEM_TOKENS * D_MODEL);
    p.WOA_T = c.take<bf16>(base, (size_t)D_MODEL * 2 * MEM_COLS); p.WOB_T = c.take<bf16>(base, (size_t)D_MODEL * (NSA_Q_COLS + MEM_COLS));
    p.WPK_T = c.take<bf16>(base, (size_t)DEPTH * NPK * D_MODEL); p.WB_T = c.take<bf16>(base, (size_t)NB_T * D_MODEL);
    p.UB8 = c.take<unsigned char>(base, (size_t)DEPTH * PEER_EXPERTS * D_MODEL); p.VB8 = c.take<unsigned char>(base, (size_t)DEPTH * PEER_EXPERTS * D_MODEL);
    p.CW1_T = c.take<bf16>(base, (size_t)2 * 256 * 1024); p.AC = c.take<bf16>(base, (size_t)2 * ACROWS * 1024);
    p.ROPE = c.take<float>(base, (size_t)NPOS * 64); p.CBIAS = c.take<float>(base, 2 * CMP_HIDDEN);
    p.QA = c.take<bf16>(base, (size_t)3 * MPAD * 256); p.KA = c.take<bf16>(base, (size_t)3 * MPAD * 256); p.VTA = c.take<bf16>(base, (size_t)3 * BATCH * DIL_HEADS * HEAD_DIM * SEQ + 4096);
    p.MQA = c.take<bf16>(base, (size_t)MPAD * 256); p.MK = c.take<bf16>(base, (size_t)DEPTH * BATCH * MEM_TOKENS * MEM_COLS); p.MVT = c.take<bf16>(base, (size_t)DEPTH * BATCH * MEM_COLS * MEM_TOKENS);
    p.ATTA = c.take<bf16>(base, (size_t)MPAD * 2 * MEM_COLS);
    p.DPART = c.take<float>(base, (size_t)3 * MP * DIL_HEADS * HEAD_DIM); p.DML = c.take<float>(base, (size_t)3 * MP * DIL_HEADS * 2);
    p.PRE = c.take<float>(base, (size_t)MPAD * D_MODEL); p.X1 = c.take<float>(base, (size_t)MPAD * D_MODEL); p.X2 = c.take<float>(base, (size_t)MPAD * D_MODEL); p.X3 = c.take<float>(base, (size_t)MPAD * D_MODEL);
    p.SCO = c.take<float>(base, (size_t)MPAD * NPK); p.SELG = c.take<float>(base, (size_t)MP * 128); p.SELE = c.take<int>(base, (size_t)MP * 128);
    p.SLK = c.take<bf16>(base, (size_t)BATCH * NSA_KV_HEADS * SEQ * HEAD_DIM); p.SLVT = c.take<bf16>(base, (size_t)BATCH * NSA_KV_HEADS * SEQ * HEAD_DIM);
    p.WNK = c.take<bf16>(base, (size_t)BATCH * NSA_KV_HEADS * SEQ * HEAD_DIM + 4096); p.WNVT = c.take<bf16>(base, (size_t)BATCH * NSA_KV_HEADS * SEQ * HEAD_DIM + 4096);
    p.QB = c.take<bf16>(base, (size_t)MPAD * NSA_Q_COLS); p.MQB = c.take<bf16>(base, (size_t)MPAD * 256);
    p.CK = c.take<bf16>(base, (size_t)NCTX * NSA_KV_HEADS * NCH * HEAD_DIM); p.CVT = c.take<bf16>(base, (size_t)NCTX * NSA_KV_HEADS * HEAD_DIM * NCH); p.ATTB = c.take<bf16>(base, (size_t)MPAD * (NSA_Q_COLS + MEM_COLS));
    p.GATES = c.take<float>(base, (size_t)MPAD * 64); p.UL = c.take<float>(base, (size_t)2 * ACROWS * 256);
    p.CKF = c.take<float>(base, (size_t)DEC_BATCH * NSA_KV_HEADS * NCH * HEAD_DIM); p.CVF = c.take<float>(base, (size_t)DEC_BATCH * NSA_KV_HEADS * NCH * HEAD_DIM);
    p.SELB = c.take<int>(base, (size_t)MP * NSA_KV_HEADS * 16);
#ifdef NSA_DEBUG
    p.DBG = c.take<float>(base, (size_t)3 * MP * 768);
#else
    p.DBG = nullptr;
#endif
    return c.off;
}
inline void bind_io(FP& p, void* const* d_in, float* out) {
    p.x_prompt = (const float*)d_in[0]; p.x_sample = (const float*)d_in[1]; p.mem_prompt = (const float*)d_in[2]; p.cache_dil[0] = (const float*)d_in[3]; p.cache_dil[1] = (const float*)d_in[4]; p.cache_dil[2] = (const float*)d_in[5];
    p.cache_nsa_kv = (const float*)d_in[6]; p.cache_nsa_win = (const float*)d_in[7]; p.cache_mem_kv = (const float*)d_in[8]; p.page_table = (const int*)d_in[9];
    p.w_in_a = (const float*)d_in[10]; p.w_out_a = (const float*)d_in[11]; p.w_in_b = (const float*)d_in[12]; p.w_out_b = (const float*)d_in[13]; p.w_mem_kv = (const float*)d_in[14]; p.w_kv_b = (const float*)d_in[15];
    p.cmp_pe = (const float*)d_in[16]; p.cmp_w1 = (const float*)d_in[17]; p.cmp_w2 = (const float*)d_in[18]; p.ln_g = (const float*)d_in[19]; p.ln_b = (const float*)d_in[20];
    p.peer_wq = (const float*)d_in[21]; p.peer_keys = (const float*)d_in[22]; p.peer_u = (const float*)d_in[23]; p.peer_v = (const float*)d_in[24];
    size_t o = 0; auto take = [&](size_t n) { float* r = out + o; o += n; return r; };
    p.y_prompt = take((size_t)M0 * D_MODEL); p.y_sample = take((size_t)DEC_BATCH * D_MODEL);
    for (int g = 0; g < 3; ++g) p.dil_p[g] = take((size_t)BATCH * DIL_W[g] * 2 * DIL_HEADS * HEAD_DIM);
    for (int g = 0; g < 3; ++g) p.dil_s[g] = take((size_t)DEC_BATCH * DIL_W[g] * 2 * DIL_HEADS * HEAD_DIM);
    p.nsa_kv_p = take((size_t)M0 * 4 * NSA_KV_HEADS * HEAD_DIM); p.nsa_kv_s = take((size_t)DEC_BATCH * 4 * NSA_KV_HEADS * HEAD_DIM);
    p.win_p = take((size_t)BATCH * SWA_WINDOW * 2 * NSA_KV_HEADS * HEAD_DIM); p.win_s = take((size_t)DEC_BATCH * SWA_WINDOW * 2 * NSA_KV_HEADS * HEAD_DIM);
    p.mem_kv_p = take((size_t)DEPTH * BATCH * MEM_TOKENS * 2 * MEM_COLS);
}
DI unsigned f2bf(float f) { unsigned u = __builtin_bit_cast(unsigned, f); return (u + 0x7fffu + ((u >> 16) & 1u)) >> 16; }
DI unsigned pk2(float lo, float hi) { return f2bf(lo) | (f2bf(hi) << 16); }
DI float bf2f(unsigned short b) { return __builtin_bit_cast(float, (unsigned)b << 16); }
DI float bflo(unsigned w) { return __builtin_bit_cast(float, w << 16); }
DI float bfhi(unsigned w) { return __builtin_bit_cast(float, w & 0xffff0000u); }
template <int CTRL> DI float dpp1(float x) { return __builtin_bit_cast(float, __builtin_amdgcn_update_dpp(0, __builtin_bit_cast(int, x), CTRL, 0xF, 0xF, true)); }
DI float wave_sum(float v) { v += dpp1<0xB1>(v); v += dpp1<0x4E>(v); v += dpp1<0x141>(v); v += dpp1<0x140>(v);
    float a = v, b = v; asm volatile("s_nop 1\n\tv_permlane16_swap_b32 %0, %1" : "+v"(a), "+v"(b)); v = a + b; a = v; b = v;
    asm volatile("s_nop 1\n\tv_permlane32_swap_b32 %0, %1" : "+v"(a), "+v"(b)); return a + b; }
DI float wave_max(float v) { v = fmaxf(v, dpp1<0xB1>(v)); v = fmaxf(v, dpp1<0x4E>(v)); v = fmaxf(v, dpp1<0x141>(v)); v = fmaxf(v, dpp1<0x140>(v));
    float a = v, b = v; asm volatile("s_nop 1\n\tv_permlane16_swap_b32 %0, %1" : "+v"(a), "+v"(b)); v = fmaxf(a, b); a = v; b = v;
    asm volatile("s_nop 1\n\tv_permlane32_swap_b32 %0, %1" : "+v"(a), "+v"(b)); return fmaxf(a, b); }
DI float gelu_tanh(float x) { const float u = 0.7978845608028654f * (x + 0.044715f * x * x * x); const float e = __builtin_amdgcn_exp2f(u * 2.885390081777927f);   const float t = 1.0f - 2.0f / (e + 1.0f); return 0.5f * x * (1.0f + t); }
DI float* sel3(float* const (&a)[3], int g) { return g == 0 ? a[0] : (g == 1 ? a[1] : a[2]); }
DI const float* sel3c(const float* const (&a)[3], int g) { return g == 0 ? a[0] : (g == 1 ? a[1] : a[2]); }
__host__ DI size_t ktile_off(int t, int d) { const int blk = t >> 5, kk = t & 31, b = (kk >> 2) & 1, i = 4 * (kk >> 3) + (kk & 3), s = d >> 5, c = (d & 31) >> 3; return ((size_t)(blk * 4 + 2 * b + s) * 64 + i + 16 * c) * 8 + (d & 7); }
__host__ DI size_t vtile_off(int dim, int t) { const int blk = t >> 5, kk = t & 31; return ((size_t)(blk * 4 + (dim >> 4)) * 64 + (dim & 15) + 16 * (kk >> 3)) * 8 + (kk & 7); }
struct Ctx { LAS unsigned char* lds; int tid, lane, wave, vcu, G; };
DI int row_pos(int r) { return r < M0 ? (r & (SEQ - 1)) : PAST_LEN; }

struct ColSrc { const float* p; int ld; };
DI int rope_il(int e) { return (e >> 1) + 32 * (e & 1); }
DI ColSrc col_wa(const FP& P, int n) {
    const int t = n >> 8, ct = n & 255, h = ct >> 6, e = ct & 63; if (t >= 9) return ColSrc{P.w_in_a + DIL_COLS + ct, ACOLS};
    const int j = t % 3, d = (j < 2) ? rope_il(e) : e; return ColSrc{P.w_in_a + t * 256 + h * 64 + d, ACOLS}; }
DI ColSrc col_wb(const FP& P, int n) {
    const int t = n >> 8, ct = n & 255, e = ct & 63;
    if (t < 3) { const int ty = 2 * t + (ct >> 7), kvh = (ct >> 6) & 1; const bool rot = (ty == 2 || ty == 4); return ColSrc{P.w_kv_b + (ty * NSA_KV_HEADS + kvh) * 64 + (rot ? rope_il(e) : e), KVCOLS}; }
    if (t < 6) { const int h = (t - 3) * 4 + (ct >> 6); return ColSrc{P.w_in_b + h * 64 + rope_il(e), BCOLS}; }
    if (t == 6) return ColSrc{P.w_in_b + NSA_Q_COLS + NSA_GATE_COLS + ct, BCOLS};
    if (ct < NSA_GATE_COLS) return ColSrc{P.w_in_b + NSA_Q_COLS + ct, BCOLS};
    return ColSrc{nullptr, 0}; }
DI ColSrc col_wmem(const FP& P, int n) { const int l = n >> 9, c = n & 511; return ColSrc{P.w_mem_kv + (size_t)l * D_MODEL * 512 + c, 512}; }
DI ColSrc col_woa(const FP& P, int n) { return ColSrc{P.w_out_a + n, D_MODEL}; }
DI ColSrc col_wob(const FP& P, int n) { return ColSrc{P.w_out_b + n, D_MODEL}; }
DI ColSrc col_cw1(const FP& P, int n) {
    const int ty = n >> 8, half = (n >> 7) & 1, hid = n & 127; return ColSrc{P.cmp_w1 + (size_t)ty * CMP_BLOCK * HEAD_DIM * CMP_HIDDEN + (size_t)half * 16 * HEAD_DIM * CMP_HIDDEN + hid, CMP_HIDDEN}; }
template <class CF> DI void transpose_item(const FP& P, CF cf, int K, bf16* WT, LAS float* scr, int item, int nblk, int lane) {
    const int kb = item / nblk, nb = item % nblk, k0 = 64 * kb, n0 = 32 * nb;
    const ColSrc cs = cf(P, n0 + (lane & 31));
#pragma unroll 8
    for (int i = 0; i < 32; ++i) { const int kk = 2 * i + (lane >> 5); scr[kk * 33 + (lane & 31)] = cs.p ? cs.p[(size_t)(k0 + kk) * cs.ld] : 0.f; }
    asm volatile("s_waitcnt lgkmcnt(0)" ::: "memory");
    const int c = lane & 7;
#pragma unroll
    for (int j = 0; j < 4; ++j) { const int n = (lane >> 3) + 8 * j; const LAS float* s = scr + (8 * c) * 33 + n;
        u32x4 o; o.x = pk2(s[0 * 33], s[1 * 33]); o.y = pk2(s[2 * 33], s[3 * 33]); o.z = pk2(s[4 * 33], s[5 * 33]); o.w = pk2(s[6 * 33], s[7 * 33]);
        *(u32x4*)(WT + (size_t)(n0 + n) * K + k0 + 8 * c) = o; }
    asm volatile("s_waitcnt lgkmcnt(0)" ::: "memory");
}
DI void cvt_row1024(const float* src, bf16* dst, int lane) {
#pragma unroll
    for (int j = 0; j < 4; ++j) { f32x4 v = src ? *(const f32x4*)(src + 256 * j + 4 * lane) : (f32x4){0.f, 0.f, 0.f, 0.f}; u32x2 o; o.x = pk2(v.x, v.y); o.y = pk2(v.z, v.w); *(u32x2*)(dst + 256 * j + 4 * lane) = o; }
}
DI void cvt_row1024_fp8(const float* src, unsigned char* dst, float sc, int lane) { u32x4 o; unsigned w[4];
#pragma unroll
    for (int j = 0; j < 4; ++j) { const f32x4 v = *(const f32x4*)(src + 16 * lane + 4 * j) * sc; int t = __builtin_amdgcn_cvt_pk_fp8_f32(v.x, v.y, 0, false); t = __builtin_amdgcn_cvt_pk_fp8_f32(v.z, v.w, t, true); w[j] = (unsigned)t; }
    o.x = w[0]; o.y = w[1]; o.z = w[2]; o.w = w[3]; *(u32x4*)(dst + 16 * lane) = o; }
DI void p0_prologue(const FP& P, const Ctx& C) {
    LAS float* scr = (LAS float*)(C.lds + C.wave * 16384);
    const int gw = C.vcu * NWAVES + C.wave, NGW = C.G * NWAVES, lane = C.lane; const int gwT0 = C.wave * C.G + C.vcu;
    { constexpr int IA = (D_MODEL / 64) * (ACOLS / 32), IM = (D_MODEL / 64) * (1024 / 32);
      for (int it = gwT0; it < IA + IM; it += NGW) { int r = it;
          if (r < IA) { transpose_item(P, col_wa, D_MODEL, P.WA_T, scr, r, ACOLS / 32, lane); continue; } r -= IA;
          transpose_item(P, col_wmem, D_MODEL, P.WMEM_T, scr, r, 1024 / 32, lane); } }
    for (int r = gw; r < M0 - NGW; r += 2 * NGW) {
        f32x4 v[8];
#pragma unroll
        for (int j = 0; j < 8; ++j) v[j] = *(const f32x4*)(P.x_prompt + (size_t)(r + (j >> 2) * NGW) * D_MODEL + 256 * (j & 3) + 4 * lane);
#pragma unroll
        for (int j = 0; j < 8; ++j) { u32x2 o; o.x = pk2(v[j].x, v[j].y); o.y = pk2(v[j].z, v[j].w); *(u32x2*)(P.XB0 + (size_t)(r + (j >> 2) * NGW) * D_MODEL + 256 * (j & 3) + 4 * lane) = o; } }
    for (int r = gw + ((M0 - NGW - gw + 2 * NGW - 1) / (2 * NGW)) * (2 * NGW); r < MPAD; r += NGW) { cvt_row1024(r < M0 ? P.x_prompt + (size_t)r * D_MODEL : (r < MP ? P.x_sample + (size_t)(r - M0) * D_MODEL : nullptr), P.XB0 + (size_t)r * D_MODEL, lane);
        if (r >= MP) { cvt_row1024(nullptr, P.X1B + (size_t)r * D_MODEL, lane); cvt_row1024(nullptr, P.X2B + (size_t)r * D_MODEL, lane); cvt_row1024(nullptr, P.X3B + (size_t)r * D_MODEL, lane);
            for (int c = lane; c < 512; c += 64) { P.ATTA[(size_t)r * 512 + c] = 0; P.ATTB[(size_t)r * 1024 + c] = 0; P.ATTB[(size_t)r * 1024 + 512 + c] = 0; } } }
    for (int r = gw; r < BATCH * MEM_TOKENS; r += NGW) cvt_row1024(P.mem_prompt + (size_t)r * D_MODEL, P.MEMB + (size_t)r * D_MODEL, lane);
    for (int i = gw * 64 + lane; i < NPOS * 32; i += NGW * 64) { const int pos = i >> 5, d = i & 31; const double inv = exp2(-(double)d * (13.287712379549449 / 32.0)); const double turns = (double)pos * inv * 0.15915494309189535;
        const float fr = (float)(turns - floor(turns)); P.ROPE[pos * 64 + d] = __builtin_amdgcn_cosf(fr); P.ROPE[pos * 64 + 32 + d] = __builtin_amdgcn_sinf(fr); }
}
constexpr int WPK_ITEMS = DEPTH * 16 * (D_MODEL / 64);
DI void wpk_item(const FP& P, const Ctx& C, int it) {
    LAS float* sw = (LAS float*)C.lds;
    LAS float* sk = (LAS float*)(C.lds + 32768);
    const int l = it / (16 * (D_MODEL / 64)), rem = it % (16 * (D_MODEL / 64)), hc = rem / (D_MODEL / 64), kb = rem % (D_MODEL / 64);
    __syncthreads();
    for (int i = C.tid; i < 64 * 64; i += NTHREADS) { const int r = i >> 6, d = i & 63; sw[r * 65 + d] = P.peer_wq[((size_t)l * D_MODEL + kb * 64 + r) * 1024 + hc * 64 + d]; }
    for (int i = C.tid; i < 128 * 64; i += NTHREADS) { const int r = i >> 6, d = i & 63; sk[r * 68 + d] = P.peer_keys[(((size_t)l * 16 + hc) * PEER_KEYS + r) * 64 + d]; }
    __syncthreads();
    { const int ki = C.lane, kk0 = C.wave; float a[16];
#pragma unroll
      for (int j = 0; j < 16; ++j) a[j] = 0.f;
#pragma unroll 2
      for (int d = 0; d < 64; d += 4) { const float w0 = sw[ki * 65 + d], w1 = sw[ki * 65 + d + 1], w2 = sw[ki * 65 + d + 2], w3 = sw[ki * 65 + d + 3];
#pragma unroll
          for (int j = 0; j < 16; ++j) { const f32x4 kq = *(const LAS f32x4*)(sk + (kk0 + 8 * j) * 68 + d); a[j] += w0 * kq.x + w1 * kq.y + w2 * kq.z + w3 * kq.w; } }
#pragma unroll
      for (int j = 0; j < 16; ++j) P.WPK_T[((size_t)l * NPK + hc * 128 + kk0 + 8 * j) * D_MODEL + kb * 64 + ki] = (bf16)f2bf(a[j]); }
    __syncthreads();
}
constexpr int T1_OA = (512 / 64) * (D_MODEL / 32), T1_OB = (1024 / 64) * (D_MODEL / 32), T1_B = (D_MODEL / 64) * (NB_T / 32), T1_C = (1024 / 64) * (512 / 32), T1_ITEMS = T1_OA + T1_OB + T1_B + T1_C;
constexpr int AC_ITEMS = DEC_BATCH * (PAST_LEN / PAGE_SIZE) * (PAGE_SIZE / 8), CB_ITEMS = 2 * CMP_HIDDEN;
constexpr int bgq_cache_n(int g) { return (DEC_BATCH * ((g < 3 ? dil_w(g) : SWA_WINDOW) - 1) * (g < 3 ? 128 : 64) + 8191) / 8192; }
constexpr int BGQ_T1 = (T1_ITEMS + 7) / 8, BGQ_L_A = BGQ_T1 + WPK_ITEMS, BGQ_UV = DEPTH * PEER_EXPERTS / 16, BGQ_L_UV = BGQ_L_A + BGQ_UV;
constexpr int BGQ_AC = (AC_ITEMS + 7) / 8, BGQ_CB = (CB_ITEMS + 7) / 8, BGQ_L_AC = BGQ_L_UV + BGQ_AC + BGQ_CB;
constexpr int BGQ_TOTAL = BGQ_L_AC + bgq_cache_n(0) + bgq_cache_n(1) + bgq_cache_n(2) + bgq_cache_n(3);
constexpr int BGQ_CTR = 12288;
DI void bg_chunk(const FP& P, const Ctx& C, int c) {
    const int lane = C.lane;
    if (c < BGQ_T1) { int r = c * 8 + C.wave; LAS float* scr = (LAS float*)(C.lds + C.wave * 16384);
        if (r < T1_ITEMS) {
            if (r < T1_OA) transpose_item(P, col_woa, 512, P.WOA_T, scr, r, D_MODEL / 32, lane);
            else if ((r -= T1_OA) < T1_OB) transpose_item(P, col_wob, 1024, P.WOB_T, scr, r, D_MODEL / 32, lane);
            else if ((r -= T1_OB) < T1_B) transpose_item(P, col_wb, D_MODEL, P.WB_T, scr, r, NB_T / 32, lane);
            else transpose_item(P, col_cw1, 1024, P.CW1_T, scr, r - T1_B, 512 / 32, lane); }
        return; }
    if (c < BGQ_L_A) { wpk_item(P, C, c - BGQ_T1); return; }
    c -= BGQ_L_A;
    if (c < BGQ_UV) {
        { const int r = c * 16 + C.wave * 2; f32x4 a[16];
#pragma unroll
            for (int q = 0; q < 4; ++q) { const float* s0 = (q < 2 ? P.peer_u : P.peer_v) + (size_t)(r + (q & 1)) * D_MODEL + 16 * lane;
#pragma unroll
                for (int j = 0; j < 4; ++j) a[4 * q + j] = *(const f32x4*)(s0 + 4 * j); }
#pragma unroll
            for (int q = 0; q < 4; ++q) { const float sc = q < 2 ? 256.f : 64.f; unsigned w[4];
#pragma unroll
                for (int j = 0; j < 4; ++j) { const f32x4 v = a[4 * q + j] * sc; int t = __builtin_amdgcn_cvt_pk_fp8_f32(v.x, v.y, 0, false); t = __builtin_amdgcn_cvt_pk_fp8_f32(v.z, v.w, t, true); w[j] = (unsigned)t; }
                u32x4 o; o.x = w[0]; o.y = w[1]; o.z = w[2]; o.w = w[3]; *(u32x4*)((q < 2 ? P.UB8 : P.VB8) + (size_t)(r + (q & 1)) * D_MODEL + 16 * lane) = o; } }
        return; }
    c -= BGQ_UV;
    if (c < BGQ_AC) { const int it2 = c * 8 + C.wave;
        if (it2 < AC_ITEMS) { const int it = it2 / (PAGE_SIZE / 8), rg = it2 % (PAGE_SIZE / 8);
            const int n = it / (PAST_LEN / PAGE_SIZE), pi = it % (PAST_LEN / PAGE_SIZE); const int pg = P.page_table[it];
            const float* src = P.cache_nsa_kv + (size_t)pg * PAGE_SIZE * 512 + 4 * lane; const int ty = lane >> 5, kvh = (lane >> 4) & 1, d = (4 * lane) & 63;
            bf16* dst = P.AC + ((size_t)ty * ACROWS + ((size_t)(BATCH + n) * NSA_KV_HEADS + kvh) * NCH + pi * (PAGE_SIZE / 16)) * 1024 + d;
            const int r0 = rg * 8; f32x4 v[8];
#pragma unroll
            for (int u = 0; u < 8; ++u) v[u] = *(const f32x4*)(src + (size_t)(r0 + u) * 512);
#pragma unroll
            for (int u = 0; u < 8; ++u) { const int t = r0 + u; u32x2 o; o.x = pk2(v[u].x, v[u].y); o.y = pk2(v[u].z, v[u].w); *(u32x2*)(dst + (size_t)(t / 16) * 1024 + (t % 16) * 64) = o; } }
        return; }
    c -= BGQ_AC;
    if (c < BGQ_CB) { const int i = c * 8 + C.wave;
        if (i < CB_ITEMS) { const int ty = i / CMP_HIDDEN, hid = i % CMP_HIDDEN; float a = 0.f;
#pragma unroll 8
            for (int k = lane; k < CMP_BLOCK * HEAD_DIM; k += 64) a += P.cmp_pe[ty * CMP_BLOCK * HEAD_DIM + k] * P.cmp_w1[((size_t)ty * CMP_BLOCK * HEAD_DIM + k) * CMP_HIDDEN + hid];
            a = wave_sum(a); if (lane == 0) P.CBIAS[i] = a; }
        return; }
    c -= BGQ_CB;
    int g = 0; if (c >= bgq_cache_n(0)) { c -= bgq_cache_n(0); g = 1; if (c >= bgq_cache_n(1)) { c -= bgq_cache_n(1); g = 2; if (c >= bgq_cache_n(2)) { c -= bgq_cache_n(2); g = 3; } } }
    const int W = g < 3 ? dil_w(g) : SWA_WINDOW, RV = g < 3 ? 128 : 64;
    const f32x4* src = (const f32x4*)(g < 3 ? sel3c(P.cache_dil, g) : P.cache_nsa_win); f32x4* dst = (f32x4*)(g < 3 ? sel3(P.dil_s, g) : P.win_s);
    const int per = (W - 1) * RV, nvec = DEC_BATCH * per;
    const int i0 = c * 8192 + C.wave * 1024;
    if (i0 < nvec) { f32x4 v[16]; int idx[16];
        const int n0 = __builtin_amdgcn_readfirstlane((int)((unsigned)i0 / (unsigned)per)), o0 = i0 - n0 * per;
#pragma unroll
        for (int u = 0; u < 16; ++u) { int o = o0 + u * 64 + lane, n = n0; if (o >= per) { o -= per; ++n; } if (n >= DEC_BATCH) { n = DEC_BATCH - 1; o = per - 1; } idx[u] = n * (per + RV) + o; v[u] = src[(size_t)idx[u] + RV]; }
#pragma unroll
        for (int u = 0; u < 16; ++u) { const int i = i0 + u * 64 + lane; if (i < nvec) dst[(size_t)idx[u]] = v[u]; } }
}
DI void bgq_drain(const FP& P, const Ctx& C, volatile LAS unsigned* slot, int limit) {
#pragma unroll 1
    for (;;) {
        __syncthreads();
        if (C.tid == 0) *slot = atomicAdd(P.ctl + BGQ_CTR, 1u);
        __syncthreads();
        const int c = (int)*slot;
        if (c < BGQ_TOTAL) bg_chunk(P, C, c);
        if (c >= limit) break;
    }
    __syncthreads();
}
DI void xcd_barrier_bg(const XcdBarrier& b, const FP& P, const Ctx& C, volatile LAS unsigned* slot  ) {
    asm volatile("s_waitcnt vmcnt(0)" ::: "memory");
    __syncthreads();
    if (threadIdx.x == 0) {
        unsigned* bar = b.bar;
        __builtin_amdgcn_s_waitcnt(0);
        unsigned nloc = b.st[0], nx = b.st[1];
        if (nloc == 0u) { xcd_barrier_complete(bar, b.x, nloc, nx); b.st[0] = nloc; b.st[1] = nx; }
        const unsigned old = xb_add(&bar[XB_XSUB(b.x)], 1u);
        const unsigned gen = old / nloc;
        if (old + 1u == (gen + 1u) * nloc) {
            __builtin_amdgcn_fence(__ATOMIC_RELEASE, "agent");
            asm volatile("s_waitcnt vmcnt(0)" ::: "memory");
            const unsigned og = xb_add(&bar[XB_TOP], 1u);
            const unsigned tg = og / nx;
            if (og + 1u == (tg + 1u) * nx) xb_add(&bar[XB_TOPGEN], 1u);
            else XB_SPIN(xb_ld(&bar[XB_TOPGEN]) == tg, bar);
            __builtin_amdgcn_fence(__ATOMIC_ACQUIRE, "agent");
            xb_add(&bar[XB_XGEN(b.x)], 1u);
            asm volatile("s_waitcnt vmcnt(0)" ::: "memory");
            slot[2] = 1u;
        } else { slot[1] = gen; slot[2] = 0u; }
    }
    __syncthreads();
    unsigned spins = 0;
#pragma unroll 1
    while (slot[2] == 0u) {
        if (threadIdx.x == 0) {
            unsigned c = (unsigned)BGQ_TOTAL;
            if (xb_ld(&b.bar[XB_XGEN(b.x)]) != slot[1] || xb_ld(&b.bar[XB_TMO]) != 0u) {
                __builtin_amdgcn_fence(__ATOMIC_ACQUIRE, "agent");
                asm volatile("s_waitcnt vmcnt(0)" ::: "memory");
                slot[2] = 1u;
            } else if (xb_ld(P.ctl + BGQ_CTR) < (unsigned)BGQ_TOTAL) {
                const unsigned nloc = b.st[0], nx = b.st[1], gen = slot[1];
                const unsigned arr = xb_ld(&b.bar[XB_XSUB(b.x)]) - gen * nloc, top = xb_ld(&b.bar[XB_TOP]) - gen * nx;
                if (arr + 3u <= nloc || (arr >= nloc && top + 2u <= nx)) c = atomicAdd(P.ctl + BGQ_CTR, 1u);
                else __builtin_amdgcn_s_sleep(1);
            }
            else { __builtin_amdgcn_s_sleep(1); if (++spins > XB_SPIN_CAP) { atomicAdd(&b.bar[XB_TMO], 1u); } }
            slot[0] = c;
        }
        __syncthreads();
        const bool rel = slot[2] != 0u; const int c = (int)slot[0];
        if (!rel && c < BGQ_TOTAL) bg_chunk(P, C, c);
        __syncthreads();
    }
}
#define EPI_LOOP(...) int fr_l = fr, fq_l = fq; asm volatile("" : "+v"(fr_l), "+v"(fq_l));     \
    _Pragma("unroll") for (int ai = 0; ai < 2; ++ai) _Pragma("unroll") for (int m = 0; m < 4; ++m) { const int row = u.pm * 256 + ai * 128 + wr * 64 + m * 16 + fr_l; \
    _Pragma("unroll") for (int bj = 0; bj < 2; ++bj) { const int ct = bj * 128 + wc * 32 + fq_l * 8; const f32x4 v0 = acc[ai][bj][m][0], v1 = acc[ai][bj][m][1]; __VA_ARGS__ } asm volatile("" ::: "memory"); }
DI void rope4(const float* rope_row, int dp, const f32x4& v0, const f32x4& v1, f32x4& lo, f32x4& hi) {
    const f32x4 c = *(const f32x4*)(rope_row + dp), s = *(const f32x4*)(rope_row + 32 + dp);
    lo.x = v0.x * c.x - v0.y * s.x; hi.x = v0.y * c.x + v0.x * s.x; lo.y = v0.z * c.y - v0.w * s.y; hi.y = v0.w * c.y + v0.z * s.y;
    lo.z = v1.x * c.z - v1.y * s.z; hi.z = v1.y * c.z + v1.x * s.z; lo.w = v1.z * c.w - v1.w * s.w; hi.w = v1.w * c.w + v1.z * s.w; }
DI u32x2 pk4(const f32x4& v) { u32x2 o; o.x = pk2(v.x, v.y); o.y = pk2(v.z, v.w); return o; }
DI u32x4 pk8(const f32x4& a, const f32x4& b) { u32x4 o; o.x = pk2(a.x, a.y); o.y = pk2(a.z, a.w); o.z = pk2(b.x, b.y); o.w = pk2(b.z, b.w); return o; }
DI int dil_perm(int t, int d) { return (t % d) * (SEQ / d) + t / d; }
#ifdef EPIA_REP
#define EPIA_REP_BEGIN _Pragma("unroll 1") for (int rep_ = 0; rep_ < EPIA_REP; ++rep_) {
#define EPIA_REP_END }
#else
#define EPIA_REP_BEGIN
#define EPIA_REP_END
#endif
struct EpiA {
    static constexpr bool PERM = true, AFTER_DRAIN = false; const FP& P;
    DI void operator()(const f32x4 (&acc)[2][2][4][2], const pg8::Unit& u, int wr, int wc, int fr, int fq) const {
        const int t9 = u.pn; const int g = t9 / 3, j = t9 % 3;
        EPIA_REP_BEGIN EPI_LOOP({ if (row < MP) { const int h = ct >> 6, e = ct & 63; const int pos = row_pos(row);
            if (t9 == 9) { *(u32x4*)(P.MQA + (size_t)row * 256 + ct) = pk8(v0 * QSCALE, v1 * QSCALE); }
            else if (j < 2) { f32x4 lo, hi; const int dp = e >> 1; rope4(P.ROPE + pos * 64, dp, v0, v1, lo, hi);
                if (j == 0) { bf16* q = P.QA + ((size_t)g * MPAD + row) * 256 + h * 64 + dp; *(u32x2*)q = pk4(lo * QSCALE); *(u32x2*)(q + 32) = pk4(hi * QSCALE); }
                else { if (row < M0) { bf16* kt = P.KA + ((size_t)(g * BATCH + row / SEQ) * DIL_HEADS + h) * 64 * SEQ; const int cm = dil_perm(pos, dil_d(g)); *(u32x2*)(kt + ktile_off(cm, dp)) = pk4(lo); *(u32x2*)(kt + ktile_off(cm, dp + 32)) = pk4(hi); }
                    const int W = dil_w(g); float* o = nullptr;
                    if (row >= M0) o = sel3(P.dil_s, g) + (((size_t)(row - M0) * W + W - 1) * 2 + 0) * 256; else if (pos >= SEQ - W) o = sel3(P.dil_p, g) + (((size_t)(row / SEQ) * W + pos - (SEQ - W)) * 2 + 0) * 256;
                    if (o) { *(f32x4*)(o + h * 64 + dp) = lo; *(f32x4*)(o + h * 64 + 32 + dp) = hi; } } }
            else { const int W = dil_w(g), d = dil_d(g); float* o = nullptr;
                if (row >= M0) o = sel3(P.dil_s, g) + (((size_t)(row - M0) * W + W - 1) * 2 + 1) * 256; else if (pos >= SEQ - W) o = sel3(P.dil_p, g) + (((size_t)(row / SEQ) * W + pos - (SEQ - W)) * 2 + 1) * 256;
                if (o) { *(f32x4*)(o + ct) = v0; *(f32x4*)(o + ct + 4) = v1; }
                if (row < M0) { bf16* vt = P.VTA + ((size_t)(g * BATCH + row / SEQ) * DIL_HEADS + h) * 64 * SEQ + vtile_off(e, dil_perm(pos, d));
                    vt[0] = (bf16)f2bf(v0.x); vt[8] = (bf16)f2bf(v0.y); vt[16] = (bf16)f2bf(v0.z); vt[24] = (bf16)f2bf(v0.w); vt[32] = (bf16)f2bf(v1.x); vt[40] = (bf16)f2bf(v1.y); vt[48] = (bf16)f2bf(v1.z); vt[56] = (bf16)f2bf(v1.w); } } } }) EPIA_REP_END
    }
};
struct EpiMem {
    static constexpr bool PERM = true, AFTER_DRAIN = false; const FP& P;
    DI void operator()(const f32x4 (&acc)[2][2][4][2], const pg8::Unit& u, int wr, int wc, int fr, int fq) const {
        const int l = u.pn >> 1, half = u.pn & 1;
        EPI_LOOP({ const int n = row / MEM_TOKENS, mt = row % MEM_TOKENS; float* o = P.mem_kv_p + (((size_t)l * BATCH + n) * MEM_TOKENS + mt) * 512 + half * 256 + ct; *(f32x4*)o = v0; *(f32x4*)(o + 4) = v1;
            if (half == 0) *(u32x4*)(P.MK + (((size_t)l * BATCH + n) * MEM_HEADS + (ct >> 6)) * MEM_TOKENS * 64 + ktile_off(mt, ct & 63)) = pk8(v0, v1);
            else { bf16* vt = P.MVT + (((size_t)l * BATCH + n) * MEM_HEADS + (ct >> 6)) * MEM_TOKENS * 64 + vtile_off(ct & 63, mt);
                vt[0] = (bf16)f2bf(v0.x); vt[8] = (bf16)f2bf(v0.y); vt[16] = (bf16)f2bf(v0.z); vt[24] = (bf16)f2bf(v0.w); vt[32] = (bf16)f2bf(v1.x); vt[40] = (bf16)f2bf(v1.y); vt[48] = (bf16)f2bf(v1.z); vt[56] = (bf16)f2bf(v1.w); } })
    }
};
struct EpiPre {
    static constexpr bool PERM = true, AFTER_DRAIN = false; const float* xa; const float* xb; float* pre;
    DI void operator()(const f32x4 (&acc)[2][2][4][2], const pg8::Unit& u, int wr, int wc, int fr, int fq) const {
        EPI_LOOP({ if (row < MP) { const int col = u.pn * 256 + ct; const float* x = (xb && row >= M0) ? xb + (size_t)(row - M0) * D_MODEL + col : xa + (size_t)row * D_MODEL + col;
            const f32x4 a = *(const f32x4*)x, b = *(const f32x4*)(x + 4); float* o = pre + (size_t)row * D_MODEL + col; *(f32x4*)o = a * ALPHA + v0; *(f32x4*)(o + 4) = b * ALPHA + v1; } })
    }
};
struct EpiF32 {
    static constexpr bool PERM = true, AFTER_DRAIN = false; float* out; int ldc; int nrows;
    DI void operator()(const f32x4 (&acc)[2][2][4][2], const pg8::Unit& u, int wr, int wc, int fr, int fq) const {
        EPI_LOOP({ if (row < nrows) { float* o = out + (size_t)row * ldc + u.pn * 256 + ct; *(f32x4*)o = v0; *(f32x4*)(o + 4) = v1; } })
    }
};
}
namespace fx {
struct Tile16 { f32x4 o[4]; float m, l; };
DI void tile_init(Tile16& T) { T.o[0] = T.o[1] = T.o[2] = T.o[3] = (f32x4){0.f, 0.f, 0.f, 0.f}; T.m = -INFINITY; T.l = 0.f; }
typedef __bf16 bf16x2_t __attribute__((ext_vector_type(2)));
DI unsigned cvtpk(float lo, float hi) { const f32x2 v = {lo, hi}; const bf16x2_t b = __builtin_convertvector(v, bf16x2_t); return __builtin_bit_cast(unsigned, b); }
struct KV8 { bf16x8 ka0, ka1, kb0, kb1, v0, v1, v2, v3; };
DI void kv_load(KV8& r, const bf16* k0, const bf16* k1, const bf16* v, long vs16) {
    r.ka0 = *(const bf16x8*)k0; r.ka1 = *(const bf16x8*)(k0 + 32); r.kb0 = *(const bf16x8*)k1; r.kb1 = *(const bf16x8*)(k1 + 32);
    r.v0 = *(const bf16x8*)v; r.v1 = *(const bf16x8*)(v + vs16); r.v2 = *(const bf16x8*)(v + 2 * vs16); r.v3 = *(const bf16x8*)(v + 3 * vs16); }
DI void mk_range(int a, int b, bool ok, int& lo, unsigned& rng) { const bool v = ok && b >= a; lo = v ? a : (1 << 20); rng = v ? (unsigned)(b - a) : 0u; }
DI float colmax(float x) { float a = x, b = x; asm volatile("s_nop 1\n\tv_permlane32_swap_b32 %0, %1" : "+v"(a), "+v"(b)); float m = fmaxf(a, b); a = m; b = m;
    asm volatile("s_nop 1\n\tv_permlane16_swap_b32 %0, %1" : "+v"(a), "+v"(b)); return fmaxf(a, b); }
DI float colsum(float x) { float a = x, b = x; asm volatile("s_nop 1\n\tv_permlane32_swap_b32 %0, %1" : "+v"(a), "+v"(b)); float m = a + b; a = m; b = m;
    asm volatile("s_nop 1\n\tv_permlane16_swap_b32 %0, %1" : "+v"(a), "+v"(b)); return a + b; }
DI void tile_compute(Tile16& T, const bf16x8 (&qf)[2], const KV8& r, int lo, unsigned rng) {
    f32x4 s0 = (f32x4){0.f, 0.f, 0.f, 0.f}, s1 = (f32x4){0.f, 0.f, 0.f, 0.f};
    s0 = __builtin_amdgcn_mfma_f32_16x16x32_bf16(r.ka0, qf[0], s0, 0, 0, 0); s0 = __builtin_amdgcn_mfma_f32_16x16x32_bf16(r.ka1, qf[1], s0, 0, 0, 0);
    s1 = __builtin_amdgcn_mfma_f32_16x16x32_bf16(r.kb0, qf[0], s1, 0, 0, 0); s1 = __builtin_amdgcn_mfma_f32_16x16x32_bf16(r.kb1, qf[1], s1, 0, 0, 0);
    float s[8] = {s0.x, s0.y, s0.z, s0.w, s1.x, s1.y, s1.z, s1.w};
    float mx = -INFINITY;
#pragma unroll
    for (int e = 0; e < 8; ++e) { s[e] = ((unsigned)(e - lo) <= rng) ? s[e] : -INFINITY; mx = fmaxf(mx, s[e]); }
    mx = colmax(mx);
    if (__builtin_amdgcn_ballot_w64(mx > T.m + 8.f) != 0ull) {
        const float mnew = fmaxf(T.m, mx), mu = (mnew == -INFINITY) ? 0.f : mnew; const float alpha = __builtin_amdgcn_exp2f(T.m - mu);
        T.l *= alpha; T.m = mnew; T.o[0] *= alpha; T.o[1] *= alpha; T.o[2] *= alpha; T.o[3] *= alpha; }
    const float muse = (T.m == -INFINITY) ? 0.f : T.m;
    float ls = 0.f;
#pragma unroll
    for (int e = 0; e < 8; ++e) { s[e] = __builtin_amdgcn_exp2f(s[e] - muse); ls += s[e]; }
    T.l += ls;
    u32x4 pw; pw.x = cvtpk(s[0], s[1]); pw.y = cvtpk(s[2], s[3]); pw.z = cvtpk(s[4], s[5]); pw.w = cvtpk(s[6], s[7]);
    const bf16x8 pf = __builtin_bit_cast(bf16x8, pw);
    T.o[0] = __builtin_amdgcn_mfma_f32_16x16x32_bf16(r.v0, pf, T.o[0], 0, 0, 0); T.o[1] = __builtin_amdgcn_mfma_f32_16x16x32_bf16(r.v1, pf, T.o[1], 0, 0, 0);
    T.o[2] = __builtin_amdgcn_mfma_f32_16x16x32_bf16(r.v2, pf, T.o[2], 0, 0, 0); T.o[3] = __builtin_amdgcn_mfma_f32_16x16x32_bf16(r.v3, pf, T.o[3], 0, 0, 0);
}
template <class BUF, class LD, class CP> DI void pipe2t(int n, LD ld, CP cp) { if (n <= 0) return; BUF A, B; ld(A, 0);
#pragma unroll 1
    for (int i = 0; i < n; i += 2) { ld(B, (i + 1 < n) ? i + 1 : i); cp(A, i); ld(A, (i + 2 < n) ? i + 2 : i); if (i + 1 < n) cp(B, i + 1); } }
template <class LD, class CP> DI void pipe2(int n, LD ld, CP cp) { if (n <= 0) return; KV8 A, B; ld(A, 0);
#pragma unroll 1
    for (int i = 0; i < n; i += 2) { ld(B, (i + 1 < n) ? i + 1 : i); cp(A, i); ld(A, (i + 2 < n) ? i + 2 : i); if (i + 1 < n) cp(B, i + 1); } }
DI void kv_load_t(KV8& r, const bf16* kt, const bf16* vt, int lane) {
    const bf16* k = kt + lane * 8; const bf16* v = vt + lane * 8;
    r.ka0 = *(const bf16x8*)k; r.ka1 = *(const bf16x8*)(k + 512); r.kb0 = *(const bf16x8*)(k + 1024); r.kb1 = *(const bf16x8*)(k + 1536);
    r.v0 = *(const bf16x8*)v; r.v1 = *(const bf16x8*)(v + 512); r.v2 = *(const bf16x8*)(v + 1024); r.v3 = *(const bf16x8*)(v + 1536); }
DI int krow_of(int i, int b) { return 8 * (i >> 2) + 4 * b + (i & 3); }

DI void dil_micro(const FP& P, int n, int h, int t0, int mt, int lane) {
    const int g = mt >> 4, idx = mt & 15, d = dil_d(g), per = 16 / d;
    const int r = idx / per, sub = idx % per, i0 = t0 / d + 16 * sub, ib = i0 - 128, NC = SEQ / d;
    const int q = lane & 15, c = lane >> 4;
    const bf16* Qb = P.QA + ((size_t)g * MPAD + (size_t)n * SEQ) * 256 + h * 64;
    const bf16* Kb = P.KA + ((size_t)(g * BATCH + n) * DIL_HEADS + h) * 64 * SEQ + (size_t)r * NC * 64; const bf16* Vb = P.VTA + ((size_t)(g * BATCH + n) * DIL_HEADS + h) * 64 * SEQ + (size_t)r * NC * 64;
    bf16x8 qf[2]; { const bf16* qp = Qb + (size_t)(r + d * (i0 + q)) * 256 + 8 * c; qf[0] = *(const bf16x8*)qp; qf[1] = *(const bf16x8*)(qp + 32); }
    Tile16 T; tile_init(T);
    const int qi = i0 + q; const int tb0 = ib >> 5  , nblk = ((i0 + 15) >> 5) - tb0 + 1;
    pipe2(nblk, [&](KV8& kv, int i) { int tb = tb0 + i; tb = tb < 0 ? 0 : tb; kv_load_t(kv, Kb + (size_t)tb * 2048, Vb + (size_t)tb * 2048, lane); },
          [&](const KV8& kv, int i) { const int k0 = 32 * (tb0 + i) + 8 * c; int lo; unsigned rng; const int a = qi - (DIL_TAPS - 1); mk_range((a > 0 ? a : 0) - k0, qi - k0, true, lo, rng); tile_compute(T, qf, kv, lo, rng); });
    const int row = n * SEQ + r + d * qi;
    float* op = P.DPART + (((size_t)g * MP + row) * DIL_HEADS + h) * 64 + 4 * c;
#pragma unroll
    for (int db = 0; db < 4; ++db) *(f32x4*)(op + 16 * db) = T.o[db];
    T.l = colsum(T.l);
    if (c == 0) { float* ml = P.DML + (((size_t)g * MP + row) * DIL_HEADS + h) * 2; ml[0] = T.m; ml[1] = T.l; }
}
DI void mem_micro(const FP& P, const bf16* Q  , int ldq, int row0, int layer, int n, int h, bf16* O  , int ldo, int lane) {
    const int q = lane & 15, c = lane >> 4;
    bf16x8 qf[2]; { const bf16* qp = Q + (size_t)(row0 + q) * ldq + 8 * c; qf[0] = *(const bf16x8*)qp; qf[1] = *(const bf16x8*)(qp + 32); }
    const bf16* Kb = P.MK + (((size_t)layer * BATCH + n) * MEM_HEADS + h) * MEM_TOKENS * 64; const bf16* Vb = P.MVT + (((size_t)layer * BATCH + n) * MEM_HEADS + h) * MEM_TOKENS * 64;
    Tile16 T; tile_init(T);
    pipe2(MEM_TOKENS / 32, [&](KV8& kv, int i) { kv_load_t(kv, Kb + (size_t)i * 2048, Vb + (size_t)i * 2048, lane); }, [&](const KV8& kv, int) { tile_compute(T, qf, kv, -8, 64u); });
    const float inv = 1.0f / colsum(T.l); bf16* op = O + (size_t)(row0 + q) * ldo + 4 * c;
#pragma unroll
    for (int db = 0; db < 4; ++db) *(u32x2*)(op + 16 * db) = pk4(T.o[db] * inv);
}
struct Dec { float m, l, o; };
template <class KF, class VF> DI void dec_chunk(Dec& D, const LAS float* q, int nk, KF kf, VF vf, int lane) {
    float s = -INFINITY;
    if (lane < nk) { const float* k = kf(lane); float a = 0.f;
#pragma unroll
        for (int d4 = 0; d4 < 16; ++d4) { const f32x4 kv = *(const f32x4*)(k + 4 * d4); a += kv.x * q[4 * d4] + kv.y * q[4 * d4 + 1] + kv.z * q[4 * d4 + 2] + kv.w * q[4 * d4 + 3]; }
        s = a; }
    const float mx = wave_max(s), mnew = fmaxf(D.m, mx), alpha = __builtin_amdgcn_exp2f(D.m - mnew);
    const float p = (lane < nk) ? __builtin_amdgcn_exp2f(s - mnew) : 0.f;
    D.l = D.l * alpha + wave_sum(p); D.m = mnew; float o = D.o * alpha;
    for (int j0 = 0; j0 < nk; j0 += 8) { float vv[8];
#pragma unroll
        for (int u = 0; u < 8; ++u) { const int jj = (j0 + u < nk) ? j0 + u : nk - 1; vv[u] = vf(jj)[lane]; }
#pragma unroll
        for (int u = 0; u < 8; ++u) { const float pj = (j0 + u < nk) ? __builtin_bit_cast(float, __builtin_amdgcn_readlane(__builtin_bit_cast(int, p), (j0 + u) & 63)) : 0.f; o += pj * vv[u]; } }
    D.o = o;
}
DI float dec_combine(const Ctx& C, const Dec& D) {
    LAS float* cb = (LAS float*)(C.lds + 4096);
    cb[C.wave * 66 + C.lane] = D.o; if (C.lane == 0) { cb[C.wave * 66 + 64] = D.m; cb[C.wave * 66 + 65] = D.l; }
    asm volatile("s_waitcnt lgkmcnt(0)" ::: "memory"); __syncthreads();
    float M = -INFINITY;
#pragma unroll
    for (int ww = 0; ww < NWAVES; ++ww) M = fmaxf(M, cb[ww * 66 + 64]);
    float L = 0.f, o = 0.f;
#pragma unroll
    for (int ww = 0; ww < NWAVES; ++ww) { const float mw = cb[ww * 66 + 64]; const float f = (mw == -INFINITY) ? 0.f : __builtin_amdgcn_exp2f(mw - M); L += f * cb[ww * 66 + 65]; o += f * cb[ww * 66 + C.lane]; }
    return o / L;
}
DI void atta_phase(const FP& P, const Ctx& C) {
    const int lane = C.lane, w = C.wave;
    constexpr int NT = SEQ / 256, NIT = BATCH * NT * DIL_HEADS;
    for (int it = C.vcu; it < NIT; it += C.G) { const int h = it % DIL_HEADS, tt = (it / DIL_HEADS) % NT, n = it / (DIL_HEADS * NT), t0 = tt * 256;
        for (int mt = w; mt < 48; mt += NWAVES) dil_micro(P, n, h, t0, mt, lane);
        asm volatile("s_waitcnt vmcnt(0)" ::: "memory"); __syncthreads();
        for (int i = C.tid; i < 256 * 16; i += NTHREADS) { const int tk = i >> 4, d4 = (i & 15) * 4; const int row = n * SEQ + t0 + tk;
            float mg[3], lg[3]; float M = -INFINITY;
#pragma unroll
            for (int g = 0; g < 3; ++g) { const float* ml = P.DML + (((size_t)g * MP + row) * DIL_HEADS + h) * 2; mg[g] = ml[0]; lg[g] = ml[1]; M = fmaxf(M, mg[g]); }
            f32x4 acc = (f32x4){0.f, 0.f, 0.f, 0.f}; float L = 0.f;
#pragma unroll
            for (int g = 0; g < 3; ++g) { const float wg = __builtin_amdgcn_exp2f(mg[g] - M); L += wg * lg[g]; acc += *(const f32x4*)(P.DPART + (((size_t)g * MP + row) * DIL_HEADS + h) * 64 + d4) * wg; }
            *(u32x2*)(P.ATTA + (size_t)row * 512 + h * 64 + d4) = pk4(acc * (1.0f / L)); }
        for (int mt = w; mt < 16; mt += NWAVES) mem_micro(P, P.MQA + h * 64, 256, n * SEQ + t0 + 16 * mt, 0, n, h, P.ATTA + 256 + h * 64, 512, lane);
        __syncthreads();
    }
    LAS float* qs = (LAS float*)C.lds;
    for (int it = C.vcu; it < DEC_BATCH * DIL_HEADS * 2; it += C.G) { const int kind = it & 1, h = (it >> 1) % DIL_HEADS, ns = (it >> 1) / DIL_HEADS, row = M0 + ns;
        __syncthreads();
        if (kind == 0) { if (C.tid < 192) qs[C.tid] = bf2f(P.QA[((size_t)(C.tid >> 6) * MPAD + row) * 256 + h * 64 + (C.tid & 63)]); } else { if (C.tid < 64) qs[C.tid] = bf2f(P.MQA[(size_t)row * 256 + h * 64 + C.tid]); }
        asm volatile("s_waitcnt lgkmcnt(0)" ::: "memory"); __syncthreads();
        Dec D; D.m = -INFINITY; D.l = 0.f; D.o = 0.f;
        if (kind == 0) { constexpr int CPG = (DIL_TAPS + 63) / 64;
            for (int ck = w; ck < 3 * CPG; ck += NWAVES) { const int g = ck / CPG, j0 = (ck % CPG) * 64; const int W = dil_w(g), d = dil_d(g); const float* cache = sel3c(P.cache_dil, g) + (size_t)ns * W * 512; const float* newrow = sel3(P.dil_s, g) + ((size_t)ns * W + W - 1) * 512;
                const int nk = (DIL_TAPS - j0) < 64 ? (DIL_TAPS - j0) : 64;
                dec_chunk(D, qs + g * 64, nk, [&](int j) { const int tap = j0 + j; return (tap == 0 ? newrow : cache + (size_t)(W - d * tap) * 512) + h * 64; },
                          [&](int j) { const int tap = j0 + j; return (tap == 0 ? newrow : cache + (size_t)(W - d * tap) * 512) + 256 + h * 64; }, lane); } }
        else { const float* mk = P.cache_mem_kv + ((size_t)0 * DEC_BATCH + ns) * MEM_TOKENS * 512;
            for (int ck = w; ck < MEM_TOKENS / 64; ck += NWAVES) { const int j0 = ck * 64; dec_chunk(D, qs, 64, [&](int j) { return mk + (size_t)(j0 + j) * 512 + h * 64; }, [&](int j) { return mk + (size_t)(j0 + j) * 512 + 256 + h * 64; }, lane); } }
        const float o = dec_combine(C, D);
        if (w == 0) P.ATTA[(size_t)row * 512 + (kind == 0 ? 0 : 256) + h * 64 + lane] = (bf16)f2bf(o);
    }
    __syncthreads();
}
DI void ln_phase(const FP& P, const Ctx& C, const float* pre, const float* gam, const float* bet, float* xo, bf16* xb, float* yp, float* ys) {
    const int gw = C.vcu * NWAVES + C.wave, NGW = C.G * NWAVES, lane = C.lane;
    for (int r = gw; r < MP; r += NGW) { const float* x = pre + (size_t)r * D_MODEL; f32x4 v[4]; float s = 0.f;
#pragma unroll
        for (int j = 0; j < 4; ++j) { v[j] = *(const f32x4*)(x + 256 * j + 4 * lane); s += (v[j].x + v[j].y) + (v[j].z + v[j].w); }
        const float mu = wave_sum(s) * (1.0f / D_MODEL); float s2 = 0.f;
#pragma unroll
        for (int j = 0; j < 4; ++j) { v[j] = v[j] - mu; s2 += (v[j].x * v[j].x + v[j].y * v[j].y) + (v[j].z * v[j].z + v[j].w * v[j].w); }
        const float rs = 1.0f / sqrtf(wave_sum(s2) * (1.0f / D_MODEL) + LN_EPS);
#pragma unroll
        for (int j = 0; j < 4; ++j) { const f32x4 gg = *(const f32x4*)(gam + 256 * j + 4 * lane), bb = *(const f32x4*)(bet + 256 * j + 4 * lane); const f32x4 o = v[j] * rs * gg + bb;
            if (xo) *(f32x4*)(xo + (size_t)r * D_MODEL + 256 * j + 4 * lane) = o;
            if (xb) *(u32x2*)(xb + (size_t)r * D_MODEL + 256 * j + 4 * lane) = pk4(o);
            if (yp) { if (r < M0) *(f32x4*)(yp + (size_t)r * D_MODEL + 256 * j + 4 * lane) = o; else *(f32x4*)(ys + (size_t)(r - M0) * D_MODEL + 256 * j + 4 * lane) = o; } }
    }
}
}
namespace fx {
#define INS16(V, I, v_, i_) do { const float _v = (v_); const int _i = (i_); bool _c[16]; _Pragma("unroll") for (int _k = 0; _k < 16; ++_k) _c[_k] = _v > V[_k]; \
    _Pragma("unroll") for (int _k = 15; _k >= 1; --_k) { V[_k] = _c[_k] ? (_c[_k - 1] ? V[_k - 1] : _v) : V[_k]; I[_k] = _c[_k] ? (_c[_k - 1] ? I[_k - 1] : _i) : I[_k]; } \
    V[0] = _c[0] ? _v : V[0]; I[0] = _c[0] ? _i : I[0]; } while (0)
DI void wave_top16_128(float a, float b, int lane, float& outv, int& outi) {
    outv = -INFINITY; outi = 0;
#pragma unroll 1
    for (int k = 0; k < 16; ++k) { const float m = wave_max(fmaxf(a, b)); const unsigned long long ba = __ballot(a == m), bb = __ballot(b == m); int idx;
        if (ba) { const int l = __builtin_ctzll(ba); idx = l; if (lane == l) a = -INFINITY; } else { const int l = __builtin_ctzll(bb); idx = 64 + l; if (lane == l) b = -INFINITY; }
        if (lane == k) { outv = m; outi = idx; } }
}
DI void topk_wave_item(const FP& P, long it, int lane) {
    const float* s = P.SCO + it * 256; float v1, v2; int i1, i2;
    wave_top16_128(s[lane], s[64 + lane], lane, v1, i1); wave_top16_128(s[128 + lane], s[192 + lane], lane, v2, i2);
    int a = 0, rem = lane; bool valid = false;
    for (int aa = 0; aa < 16; ++aa) { const int nb = 16 / (aa + 1); if (!valid) { if (rem < nb) { a = aa; valid = true; } else rem -= nb; } }
    const int b = valid ? rem : 0;
    float cs = __shfl(v1, a) + __shfl(v2, b); const int ce = __shfl(i1, a) * PEER_KEYS + __shfl(i2, b); if (!valid) cs = -INFINITY;
    float tv = -INFINITY; int te = 0;
#pragma unroll 1
    for (int k = 0; k < 16; ++k) { const float m = wave_max(cs); const unsigned long long bm = __ballot(cs == m); const int l = __builtin_ctzll(bm); const int e = __shfl(ce, l); if (lane == l) cs = -INFINITY; if (lane == k) { tv = m; te = e; } }
    const float mx = __shfl(tv, 0); const float ex = (lane < 16) ? __expf(tv - mx) : 0.f; const float z = wave_sum(ex);
    if (lane < 16) { P.SELG[it * 16 + lane] = ex / z; P.SELE[it * 16 + lane] = te; }
}
#define KINS16(V, key_) do { const float _key = (key_); _Pragma("unroll") for (int _k = 15; _k >= 1; --_k) V[_k] = __builtin_amdgcn_fmed3f(V[_k - 1], V[_k], _key); V[0] = fmaxf(V[0], _key); } while (0)
DI float pack_key(float v, unsigned lowbits, unsigned mask) { return __builtin_bit_cast(float, (__builtin_bit_cast(unsigned, v) & ~mask) | lowbits); }
DI void topk_phase(const FP& P, const Ctx& C) {
    const int lane = C.lane; LAS float* st = (LAS float*)(C.lds + C.wave * 16384);
    const int NWI = (M0 * PEER_HEADS) / 64;
    for (int wi = C.vcu * NWAVES + C.wave; wi < NWI; wi += C.G * NWAVES) {
        const long it0 = (long)wi * 64; const long it = it0 + lane;
        float V1[16], V2[16], V3[16];
#pragma unroll
        for (int k = 0; k < 16; ++k) { V1[k] = V2[k] = V3[k] = -INFINITY; }
        f32x4 pv[8];
#pragma unroll
        for (int u = 0; u < 8; ++u) { const int f4 = u * 64 + lane, j = f4 >> 3, q = f4 & 7, hf = q >> 2, c4 = (q & 3) * 4; pv[u] = *(const f32x4*)(P.SCO + (it0 + j) * 256 + hf * 128 + c4); }
#pragma unroll 1
        for (int ch = 0; ch < 8; ++ch) {
#pragma unroll
            for (int u = 0; u < 8; ++u) { const int f4 = u * 64 + lane, j = f4 >> 3, q = f4 & 7, hf = q >> 2, c4 = (q & 3) * 4; const f32x4 v = pv[u];
                st[j * 33 + hf * 16 + c4] = v.x; st[j * 33 + hf * 16 + c4 + 1] = v.y; st[j * 33 + hf * 16 + c4 + 2] = v.z; st[j * 33 + hf * 16 + c4 + 3] = v.w; }
            { const int chn = ch < 7 ? ch + 1 : 7;
#pragma unroll
              for (int u = 0; u < 8; ++u) { const int f4 = u * 64 + lane, j = f4 >> 3, q = f4 & 7, hf = q >> 2, c4 = (q & 3) * 4; pv[u] = *(const f32x4*)(P.SCO + (it0 + j) * 256 + hf * 128 + chn * 16 + c4); } }
            asm volatile("s_waitcnt lgkmcnt(0)" ::: "memory");
#pragma unroll 4
            for (int c = 0; c < 16; ++c) { const float va = st[lane * 33 + c], vb = st[lane * 33 + 16 + c]; const unsigned lb = 127u - (unsigned)(ch * 16 + c); KINS16(V1, pack_key(va, lb, 127u)); KINS16(V2, pack_key(vb, lb, 127u)); }
            asm volatile("s_waitcnt lgkmcnt(0)" ::: "memory");
        }
        LAS int* lc = (LAS int*)st;
        { int ord = 0;
#pragma unroll
          for (int a = 0; a < 16; ++a) { const unsigned ba = __builtin_bit_cast(unsigned, V1[a]); const float va = __builtin_bit_cast(float, ba & ~127u); const int ia = 127 - (int)(ba & 127u);
#pragma unroll
              for (int b = 0; b < 16; ++b) if ((a + 1) * (b + 1) <= 16) { const unsigned bb = __builtin_bit_cast(unsigned, V2[b]); const float vb = __builtin_bit_cast(float, bb & ~127u); const int ib = 127 - (int)(bb & 127u);
                  lc[lane * 51 + ord] = ia * PEER_KEYS + ib; KINS16(V3, pack_key(va + vb, 63u - (unsigned)ord, 63u)); ++ord; } } }
        asm volatile("s_waitcnt lgkmcnt(0)" ::: "memory");
        float g[16]; int e[16]; float z = 0.f; const float vmax = __builtin_bit_cast(float, __builtin_bit_cast(unsigned, V3[0]) & ~63u);
#pragma unroll
        for (int k = 0; k < 16; ++k) { const unsigned bk = __builtin_bit_cast(unsigned, V3[k]); e[k] = lc[lane * 51 + 63 - (int)(bk & 63u)]; g[k] = __expf(__builtin_bit_cast(float, bk & ~63u) - vmax); z += g[k]; }
        const float iz = 1.0f / z;
#pragma unroll
        for (int k4 = 0; k4 < 4; ++k4) { *(f32x4*)(P.SELG + it * 16 + 4 * k4) = (f32x4){g[4 * k4] * iz, g[4 * k4 + 1] * iz, g[4 * k4 + 2] * iz, g[4 * k4 + 3] * iz};
            *(int4*)(P.SELE + it * 16 + 4 * k4) = make_int4(e[4 * k4], e[4 * k4 + 1], e[4 * k4 + 2], e[4 * k4 + 3]); }
        asm volatile("s_waitcnt lgkmcnt(0)" ::: "memory");
    }
    for (int si = C.vcu * NWAVES + C.wave; si < DEC_BATCH * PEER_HEADS; si += C.G * NWAVES) topk_wave_item(P, (long)M0 * PEER_HEADS + si, lane);
    __syncthreads();
}
constexpr float PEER_SU = 256.f, PEER_SV = 64.f;
DI float dot16_fp8(const u32x4& w, const f32x2 (&x2)[8]) { f32x2 a = {0.f, 0.f};
    a += __builtin_amdgcn_cvt_pk_f32_fp8((int)w.x, false) * x2[0]; a += __builtin_amdgcn_cvt_pk_f32_fp8((int)w.x, true) * x2[1];
    a += __builtin_amdgcn_cvt_pk_f32_fp8((int)w.y, false) * x2[2]; a += __builtin_amdgcn_cvt_pk_f32_fp8((int)w.y, true) * x2[3];
    a += __builtin_amdgcn_cvt_pk_f32_fp8((int)w.z, false) * x2[4]; a += __builtin_amdgcn_cvt_pk_f32_fp8((int)w.z, true) * x2[5];
    a += __builtin_amdgcn_cvt_pk_f32_fp8((int)w.w, false) * x2[6]; a += __builtin_amdgcn_cvt_pk_f32_fp8((int)w.w, true) * x2[7];
    return a.x + a.y; }
DI void axpy16_fp8(const u32x4& w, float s, f32x2 (&o2)[8]) { const f32x2 s2 = {s, s};
    o2[0] += __builtin_amdgcn_cvt_pk_f32_fp8((int)w.x, false) * s2; o2[1] += __builtin_amdgcn_cvt_pk_f32_fp8((int)w.x, true) * s2;
    o2[2] += __builtin_amdgcn_cvt_pk_f32_fp8((int)w.y, false) * s2; o2[3] += __builtin_amdgcn_cvt_pk_f32_fp8((int)w.y, true) * s2;
    o2[4] += __builtin_amdgcn_cvt_pk_f32_fp8((int)w.z, false) * s2; o2[5] += __builtin_amdgcn_cvt_pk_f32_fp8((int)w.z, true) * s2;
    o2[6] += __builtin_amdgcn_cvt_pk_f32_fp8((int)w.w, false) * s2; o2[7] += __builtin_amdgcn_cvt_pk_f32_fp8((int)w.w, true) * s2; }
#if defined(PEER_SHARD) || defined(PEER_SHARD2)
#define PEER_FIRST_ROUND nrounds
#else
#define PEER_FIRST_ROUND 0
#endif
template <int CTRL> DI float dppf(float x) { return __builtin_bit_cast(float, __builtin_amdgcn_update_dpp(0, __builtin_bit_cast(int, x), CTRL, 0xF, 0xF, true)); }
DI float rdlane(float v, int l) { return __builtin_bit_cast(float, __builtin_amdgcn_readlane(__builtin_bit_cast(int, v), l)); }
DI void peer_phase(const FP& P, const Ctx& C, int layer, const float* xin, float* fout, float* fout_s, bf16* xb, bool samples_only = false) {
    const int lane = C.lane; const unsigned char* U = P.UB8 + (size_t)layer * PEER_EXPERTS * D_MODEL; const unsigned char* Vt = P.VB8 + (size_t)layer * PEER_EXPERTS * D_MODEL;
    const float* gam = P.ln_g + ((size_t)layer * 2 + 1) * D_MODEL; const float* bet = P.ln_b + ((size_t)layer * 2 + 1) * D_MODEL;
    const int nrounds = (M0 + C.G * NWAVES - 1) / (C.G * NWAVES);
#pragma unroll 1
    for (int rd = samples_only ? nrounds : 0; rd <= nrounds; ++rd) {
        const bool smp = (rd == nrounds); int r = smp ? M0 + C.vcu : rd * C.G * NWAVES + C.vcu * NWAVES + C.wave; if (smp ? (C.vcu >= DEC_BATCH) : (r >= M0)) continue;
        const int pb = smp ? 16 * C.wave : 0, pe = smp ? pb + 16 : 128;
        f32x2 x2[8], o2[8];
#pragma unroll
        for (int j = 0; j < 4; ++j) { const f32x4 a = *(const f32x4*)(xin + (size_t)r * D_MODEL + 16 * lane + 4 * j); x2[2 * j] = (f32x2){a.x, a.y}; x2[2 * j + 1] = (f32x2){a.z, a.w}; }
#pragma unroll
        for (int k = 0; k < 8; ++k) o2[k] = (f32x2){0.f, 0.f};
        const int e_l = P.SELE[(size_t)r * 128 + lane], e_h = P.SELE[(size_t)r * 128 + 64 + lane]; const float g_l = P.SELG[(size_t)r * 128 + lane], g_h = P.SELG[(size_t)r * 128 + 64 + lane];
#pragma unroll 1
        for (int b0 = pb; b0 < pe; b0 += 8) {
            u32x4 uw[8], vw[8];
#pragma unroll
            for (int k = 0; k < 8; ++k) { const int hk = b0 + k; const int e = (hk < 64) ? __builtin_amdgcn_readlane(e_l, hk & 63) : __builtin_amdgcn_readlane(e_h, hk & 63);
                uw[k] = *(const u32x4*)(U + (size_t)e * D_MODEL + 16 * lane); vw[k] = *(const u32x4*)(Vt + (size_t)e * D_MODEL + 16 * lane); }
            float d[8];
#pragma unroll
            for (int k = 0; k < 8; ++k) d[k] = dot16_fp8(uw[k], x2);
            float e4[4], e2[2], e1;
            { const bool hi = lane & 1;
#pragma unroll
              for (int i = 0; i < 4; ++i) { const float keep = hi ? d[4 + i] : d[i], send = hi ? d[i] : d[4 + i]; e4[i] = keep + __shfl_xor(send, 1); } }
            { const bool hi = lane & 2;
#pragma unroll
              for (int i = 0; i < 2; ++i) { const float keep = hi ? e4[2 + i] : e4[i], send = hi ? e4[i] : e4[2 + i]; e2[i] = keep + __shfl_xor(send, 2); } }
            { const bool hi = lane & 4; const float keep = hi ? e2[1] : e2[0], send = hi ? e2[0] : e2[1]; e1 = keep + __shfl_xor(send, 4); }
            e1 += __shfl_xor(e1, 8); e1 += __shfl_xor(e1, 16); e1 += __shfl_xor(e1, 32);
            const int myk = 4 * (lane & 1) + (lane & 2) + ((lane >> 2) & 1); const int myhk = b0 + myk;
            const float myg = (myhk < 64) ? __shfl(g_l, myhk & 63) : __shfl(g_h, myhk & 63);
            const float act = myg * gelu_tanh(e1 * (1.0f / PEER_SU)) * (1.0f / PEER_SV);
#pragma unroll
            for (int k = 0; k < 8; ++k) { const int src = (k >> 2) | (((k >> 1) & 1) << 1) | ((k & 1) << 2); axpy16_fp8(vw[k], rdlane(act, src), o2); }
        }
        if (smp) {
            LAS float* red = (LAS float*)C.lds;
#pragma unroll
            for (int k = 0; k < 8; ++k) { red[C.wave * 1024 + 16 * lane + 2 * k] = o2[k].x; red[C.wave * 1024 + 16 * lane + 2 * k + 1] = o2[k].y; }
            asm volatile("s_waitcnt lgkmcnt(0)" ::: "memory"); __syncthreads();
            if (C.wave == 0) {
#pragma unroll
                for (int k = 0; k < 8; ++k) { float ax = 0.f, ay = 0.f;
#pragma unroll
                    for (int ww = 0; ww < NWAVES; ++ww) { ax += red[ww * 1024 + 16 * lane + 2 * k]; ay += red[ww * 1024 + 16 * lane + 2 * k + 1]; } o2[k] = (f32x2){ax, ay}; } }
            __syncthreads();
            if (C.wave != 0) continue; }
        float s = 0.f;
#pragma unroll
        for (int k = 0; k < 8; ++k) { o2[k] += x2[k] * ALPHA; s += o2[k].x + o2[k].y; }
        const float mu = wave_sum(s) * (1.0f / D_MODEL); float s2 = 0.f;
#pragma unroll
        for (int k = 0; k < 8; ++k) { o2[k] -= mu; s2 += o2[k].x * o2[k].x + o2[k].y * o2[k].y; }
        const float rs = 1.0f / sqrtf(wave_sum(s2) * (1.0f / D_MODEL) + LN_EPS);
        float* frow = (r < M0) ? fout + (size_t)r * D_MODEL : fout_s + (size_t)(r - M0) * D_MODEL;
#pragma unroll
        for (int j = 0; j < 4; ++j) { const int c0 = 16 * lane + 4 * j; const f32x4 gg = *(const f32x4*)(gam + c0), bb = *(const f32x4*)(bet + c0);
            const f32x4 y = (f32x4){o2[2 * j].x * rs, o2[2 * j].y * rs, o2[2 * j + 1].x * rs, o2[2 * j + 1].y * rs} * gg + bb;
            *(f32x4*)(frow + c0) = y; if (xb) *(u32x2*)(xb + (size_t)r * D_MODEL + c0) = pk4(y); }
    }
}
DI void peer_u_phase(const FP& P, const Ctx& C, int layer, const bf16* xb16) {
    const int lane = C.lane; const unsigned char* U = P.UB8 + (size_t)layer * PEER_EXPERTS * D_MODEL;
    const int s = (int)(blockIdx.x & 7), nw = (C.G >> 3) * NWAVES, widx = (int)(blockIdx.x >> 3) * NWAVES + C.wave;
#pragma unroll 1
    for (int r = widx; r < MP; r += nw) {
        const int e0 = P.SELE[(size_t)r * 128 + lane], e1 = P.SELE[(size_t)r * 128 + 64 + lane]; const float g0 = P.SELG[(size_t)r * 128 + lane], g1 = P.SELG[(size_t)r * 128 + 64 + lane];
        unsigned long long b0 = __ballot((e0 >> 11) == s), b1 = __ballot((e1 >> 11) == s);
        if ((b0 | b1) == 0ull) continue;
        f32x2 x2[8]; { const u32x4 xa = *(const u32x4*)(xb16 + (size_t)r * D_MODEL + 16 * lane), xc = *(const u32x4*)(xb16 + (size_t)r * D_MODEL + 16 * lane + 8);
            x2[0] = (f32x2){bflo(xa.x), bfhi(xa.x)}; x2[1] = (f32x2){bflo(xa.y), bfhi(xa.y)}; x2[2] = (f32x2){bflo(xa.z), bfhi(xa.z)}; x2[3] = (f32x2){bflo(xa.w), bfhi(xa.w)};
            x2[4] = (f32x2){bflo(xc.x), bfhi(xc.x)}; x2[5] = (f32x2){bflo(xc.y), bfhi(xc.y)}; x2[6] = (f32x2){bflo(xc.z), bfhi(xc.z)}; x2[7] = (f32x2){bflo(xc.w), bfhi(xc.w)}; }
#pragma unroll 1
        while ((b0 | b1) != 0ull) {
            int hk[8]; u32x4 uw[8]; int nv = 0;
#pragma unroll
            for (int k = 0; k < 8; ++k) { int h;
                if (b0) { h = __builtin_ctzll(b0); b0 &= b0 - 1; ++nv; } else if (b1) { h = 64 + __builtin_ctzll(b1); b1 &= b1 - 1; ++nv; } else h = hk[k > 0 ? k - 1 : 0];
                hk[k] = h; const int e = (h < 64) ? __builtin_amdgcn_readlane(e0, h & 63) : __builtin_amdgcn_readlane(e1, h & 63);
                uw[k] = *(const u32x4*)(U + (size_t)e * D_MODEL + 16 * lane); }
            float d[8];
#pragma unroll
            for (int k = 0; k < 8; ++k) d[k] = dot16_fp8(uw[k], x2);
            float e4[4], e2[2], e1s;
            { const bool hi = lane & 1;
#pragma unroll
              for (int i = 0; i < 4; ++i) { const float keep = hi ? d[4 + i] : d[i], send = hi ? d[i] : d[4 + i]; e4[i] = keep + __shfl_xor(send, 1); } }
            { const bool hi = lane & 2;
#pragma unroll
              for (int i = 0; i < 2; ++i) { const float keep = hi ? e4[2 + i] : e4[i], send = hi ? e4[i] : e4[2 + i]; e2[i] = keep + __shfl_xor(send, 2); } }
            { const bool hi = lane & 4; const float keep = hi ? e2[1] : e2[0], send = hi ? e2[0] : e2[1]; e1s = keep + __shfl_xor(send, 4); }
            e1s += __shfl_xor(e1s, 8); e1s += __shfl_xor(e1s, 16); e1s += __shfl_xor(e1s, 32);
            const int myk = 4 * (lane & 1) + (lane & 2) + ((lane >> 2) & 1);
            int myh = hk[0];
#pragma unroll
            for (int k = 1; k < 8; ++k) myh = (myk == k) ? hk[k] : myh;
            const float ga = __shfl(g0, myh & 63), gb = __shfl(g1, myh & 63); const float myg = (myh < 64) ? ga : gb;
            if (lane < 8 && myk < nv) P.SCO[(size_t)r * 128 + myh] = myg * gelu_tanh(e1s * (1.0f / PEER_SU)) * (1.0f / PEER_SV);
        }
    }
}
DI void peer_v_phase(const FP& P, const Ctx& C, int layer, const float* xin, float* fout, float* fout_s, bf16* xb) {
    const int lane = C.lane; const unsigned char* Vt = P.VB8 + (size_t)layer * PEER_EXPERTS * D_MODEL;
    const float* gam = P.ln_g + ((size_t)layer * 2 + 1) * D_MODEL; const float* bet = P.ln_b + ((size_t)layer * 2 + 1) * D_MODEL;
    const int nrounds = (M0 + C.G * NWAVES - 1) / (C.G * NWAVES);
#pragma unroll 1
    for (int rd = 0; rd <= nrounds; ++rd) {
        const bool smp = (rd == nrounds); int r = smp ? M0 + C.vcu : rd * C.G * NWAVES + C.vcu * NWAVES + C.wave; if (smp ? (C.vcu >= DEC_BATCH) : (r >= M0)) continue;
        const int pb = smp ? 16 * C.wave : 0, pe = smp ? pb + 16 : 128;
        f32x2 x2[8], o2[8];
#pragma unroll
        for (int j = 0; j < 4; ++j) { const f32x4 a = *(const f32x4*)(xin + (size_t)r * D_MODEL + 16 * lane + 4 * j); x2[2 * j] = (f32x2){a.x, a.y}; x2[2 * j + 1] = (f32x2){a.z, a.w}; }
#pragma unroll
        for (int k = 0; k < 8; ++k) o2[k] = (f32x2){0.f, 0.f};
        const int e_l = P.SELE[(size_t)r * 128 + lane], e_h = P.SELE[(size_t)r * 128 + 64 + lane]; const float a_l = P.SCO[(size_t)r * 128 + lane], a_h = P.SCO[(size_t)r * 128 + 64 + lane];
#pragma unroll 1
        for (int b0 = pb; b0 < pe; b0 += 16) { u32x4 vw[16];
#pragma unroll
            for (int k = 0; k < 16; ++k) { const int hk = b0 + k; const int e = (hk < 64) ? __builtin_amdgcn_readlane(e_l, hk & 63) : __builtin_amdgcn_readlane(e_h, hk & 63); vw[k] = *(const u32x4*)(Vt + (size_t)e * D_MODEL + 16 * lane); }
#pragma unroll
            for (int k = 0; k < 16; ++k) { const int hk = b0 + k; axpy16_fp8(vw[k], (hk < 64) ? rdlane(a_l, hk & 63) : rdlane(a_h, hk & 63), o2); } }
        if (smp) {
            LAS float* red = (LAS float*)C.lds;
#pragma unroll
            for (int k = 0; k < 8; ++k) { red[C.wave * 1024 + 16 * lane + 2 * k] = o2[k].x; red[C.wave * 1024 + 16 * lane + 2 * k + 1] = o2[k].y; }
            asm volatile("s_waitcnt lgkmcnt(0)" ::: "memory"); __syncthreads();
            if (C.wave == 0) {
#pragma unroll
                for (int k = 0; k < 8; ++k) { float ax = 0.f, ay = 0.f;
#pragma unroll
                    for (int ww = 0; ww < NWAVES; ++ww) { ax += red[ww * 1024 + 16 * lane + 2 * k]; ay += red[ww * 1024 + 16 * lane + 2 * k + 1]; } o2[k] = (f32x2){ax, ay}; } }
            __syncthreads();
            if (C.wave != 0) continue; }
        float s = 0.f;
#pragma unroll
        for (int k = 0; k < 8; ++k) { o2[k] += x2[k] * ALPHA; s += o2[k].x + o2[k].y; }
        const float mu = wave_sum(s) * (1.0f / D_MODEL); float s2 = 0.f;
#pragma unroll
        for (int k = 0; k < 8; ++k) { o2[k] -= mu; s2 += o2[k].x * o2[k].x + o2[k].y * o2[k].y; }
        const float rs = 1.0f / sqrtf(wave_sum(s2) * (1.0f / D_MODEL) + LN_EPS);
        float* frow = (r < M0) ? fout + (size_t)r * D_MODEL : fout_s + (size_t)(r - M0) * D_MODEL;
#pragma unroll
        for (int j = 0; j < 4; ++j) { const int c0 = 16 * lane + 4 * j; const f32x4 gg = *(const f32x4*)(gam + c0), bb = *(const f32x4*)(bet + c0);
            const f32x4 y = (f32x4){o2[2 * j].x * rs, o2[2 * j].y * rs, o2[2 * j + 1].x * rs, o2[2 * j + 1].y * rs} * gg + bb;
            *(f32x4*)(frow + c0) = y; if (xb) *(u32x2*)(xb + (size_t)r * D_MODEL + c0) = pk4(y); }
    }
}
constexpr int PSH_LIST = 512;
struct PG4 { u32x4 u[4], v[4]; };
DI void peer_sharded_phase(const FP& P, const Ctx& C, int layer, const float* xin, const bf16* xb16, float* fout, float* fout_s, bf16* xb) {
    const int lane = C.lane; const unsigned char* U = P.UB8 + (size_t)layer * PEER_EXPERTS * D_MODEL; const unsigned char* Vt = P.VB8 + (size_t)layer * PEER_EXPERTS * D_MODEL;
    const float* gam = P.ln_g + ((size_t)layer * 2 + 1) * D_MODEL; const float* bet = P.ln_b + ((size_t)layer * 2 + 1) * D_MODEL;
    LAS unsigned char* wl = C.lds + C.wave * 16384; LAS bf16* xs = (LAS bf16*)wl; LAS int* lst = (LAS int*)(wl + 8192);
    const int NW = C.G * NWAVES, gw = C.vcu * NWAVES + C.wave; const int nquads = (M0 / NW) / 4;
#pragma unroll 1
    for (int qd = 0; qd < nquads; ++qd) {
#define PSH_ROW(j) const int row##j = (qd * 4 + j) * NW + gw; const int el##j = P.SELE[(size_t)row##j * 128 + lane], eh##j = P.SELE[(size_t)row##j * 128 + 64 + lane]; const float gl##j = P.SELG[(size_t)row##j * 128 + lane], gh##j = P.SELG[(size_t)row##j * 128 + 64 + lane]; \
        { const u32x4 xa = *(const u32x4*)(xb16 + (size_t)row##j * D_MODEL + 16 * lane), xc = *(const u32x4*)(xb16 + (size_t)row##j * D_MODEL + 16 * lane + 8); *(LAS u32x4*)(xs + j * 1024 + 16 * lane) = xa; *(LAS u32x4*)(xs + j * 1024 + 16 * lane + 8) = xc; } \
        f32x2 oa##j[8]; _Pragma("unroll") for (int k = 0; k < 8; ++k) oa##j[k] = (f32x2){0.f, 0.f};
        PSH_ROW(0) PSH_ROW(1) PSH_ROW(2) PSH_ROW(3)
#pragma unroll 1
        for (int s = 0; s < 16; ++s) {
            int n = 0;
#define PSH_SCAN(j) { unsigned long long b0 = __ballot((el##j >> 10) == s), b1 = __ballot((eh##j >> 10) == s); \
                while (b0) { const int h = __builtin_ctzll(b0); b0 &= b0 - 1; const int e = __builtin_amdgcn_readlane(el##j, h); const int g = __builtin_amdgcn_readlane(__builtin_bit_cast(int, gl##j), h); \
                    if (lane == 0) { lst[4 * n] = e; lst[4 * n + 1] = g; lst[4 * n + 2] = j; } ++n; } \
                while (b1) { const int h = __builtin_ctzll(b1); b1 &= b1 - 1; const int e = __builtin_amdgcn_readlane(eh##j, h); const int g = __builtin_amdgcn_readlane(__builtin_bit_cast(int, gh##j), h); \
                    if (lane == 0) { lst[4 * n] = e; lst[4 * n + 1] = g; lst[4 * n + 2] = j; } ++n; } }
            PSH_SCAN(0) PSH_SCAN(1) PSH_SCAN(2) PSH_SCAN(3)
            asm volatile("s_waitcnt lgkmcnt(0)" ::: "memory");
            if (n == 0) continue;
            const int ngrp = (n + 3) >> 2;
#define PSH_LD(b, gi_) do { const int gi = (gi_); _Pragma("unroll") for (int k = 0; k < 4; ++k) { int i = 4 * gi + k; i = i < n ? i : n - 1; const int e = __builtin_amdgcn_readfirstlane(lst[4 * i]); \
                b.u[k] = *(const u32x4*)(U + (size_t)e * D_MODEL + 16 * lane); b.v[k] = *(const u32x4*)(Vt + (size_t)e * D_MODEL + 16 * lane); } } while (0)
#define PSH_CP(b, gi_) do { const int gi = (gi_); float d[4]; int jj[4]; float gg[4]; \
                _Pragma("unroll") for (int k = 0; k < 4; ++k) { int i = 4 * gi + k; const bool val = i < n; i = val ? i : n - 1; jj[k] = __builtin_amdgcn_readfirstlane(lst[4 * i + 2]); gg[k] = val ? __builtin_bit_cast(float, __builtin_amdgcn_readfirstlane(lst[4 * i + 1])) : 0.f; \
                    const u32x4 xa = *(const LAS u32x4*)(xs + jj[k] * 1024 + 16 * lane), xc = *(const LAS u32x4*)(xs + jj[k] * 1024 + 16 * lane + 8); \
                    const f32x2 x2[8] = {(f32x2){bflo(xa.x), bfhi(xa.x)}, (f32x2){bflo(xa.y), bfhi(xa.y)}, (f32x2){bflo(xa.z), bfhi(xa.z)}, (f32x2){bflo(xa.w), bfhi(xa.w)}, (f32x2){bflo(xc.x), bfhi(xc.x)}, (f32x2){bflo(xc.y), bfhi(xc.y)}, (f32x2){bflo(xc.z), bfhi(xc.z)}, (f32x2){bflo(xc.w), bfhi(xc.w)}}; \
                    d[k] = dot16_fp8(b.u[k], x2); } \
                float e2[2], e1; \
                { const bool hi = lane & 1; _Pragma("unroll") for (int i = 0; i < 2; ++i) { const float keep = hi ? d[2 + i] : d[i], send = hi ? d[i] : d[2 + i]; e2[i] = keep + __shfl_xor(send, 1); } } \
                { const bool hi = lane & 2; const float keep = hi ? e2[1] : e2[0], send = hi ? e2[0] : e2[1]; e1 = keep + __shfl_xor(send, 2); } \
                e1 += __shfl_xor(e1, 4); e1 += __shfl_xor(e1, 8); e1 += __shfl_xor(e1, 16); e1 += __shfl_xor(e1, 32); \
                const int myk = 2 * (lane & 1) + ((lane >> 1) & 1); \
                float myg = gg[0]; myg = (myk == 1) ? gg[1] : myg; myg = (myk == 2) ? gg[2] : myg; myg = (myk == 3) ? gg[3] : myg; \
                const float act = myg * gelu_tanh(e1 * (1.0f / PEER_SU)) * (1.0f / PEER_SV); \
                _Pragma("unroll") for (int k = 0; k < 4; ++k) { const float a = rdlane(act, (k >> 1) | ((k & 1) << 1)); \
                    if (jj[k] == 0) axpy16_fp8(b.v[k], a, oa0); else if (jj[k] == 1) axpy16_fp8(b.v[k], a, oa1); else if (jj[k] == 2) axpy16_fp8(b.v[k], a, oa2); else axpy16_fp8(b.v[k], a, oa3); } } while (0)
            { PG4 A, B; PSH_LD(A, 0);
#pragma unroll 1
              for (int g2 = 0; g2 < ngrp; g2 += 2) { PSH_LD(B, (g2 + 1 < ngrp) ? g2 + 1 : g2); PSH_CP(A, g2); PSH_LD(A, (g2 + 2 < ngrp) ? g2 + 2 : g2); if (g2 + 1 < ngrp) PSH_CP(B, g2 + 1); } }
            asm volatile("s_waitcnt lgkmcnt(0)" ::: "memory");
        }
#define PSH_LN(j) { const int r = row##j; f32x2 x2[8]; \
            _Pragma("unroll") for (int q = 0; q < 4; ++q) { const f32x4 a = *(const f32x4*)(xin + (size_t)r * D_MODEL + 16 * lane + 4 * q); x2[2 * q] = (f32x2){a.x, a.y}; x2[2 * q + 1] = (f32x2){a.z, a.w}; } \
            float sm = 0.f; _Pragma("unroll") for (int k = 0; k < 8; ++k) { oa##j[k] += x2[k] * ALPHA; sm += oa##j[k].x + oa##j[k].y; } \
            const float mu = wave_sum(sm) * (1.0f / D_MODEL); float s2 = 0.f; _Pragma("unroll") for (int k = 0; k < 8; ++k) { oa##j[k] -= mu; s2 += oa##j[k].x * oa##j[k].x + oa##j[k].y * oa##j[k].y; } \
            const float rs = 1.0f / sqrtf(wave_sum(s2) * (1.0f / D_MODEL) + LN_EPS); float* frow = fout + (size_t)r * D_MODEL; \
            _Pragma("unroll") for (int q = 0; q < 4; ++q) { const int c0 = 16 * lane + 4 * q; const f32x4 gv = *(const f32x4*)(gam + c0), bv = *(const f32x4*)(bet + c0); \
                const f32x4 y = (f32x4){oa##j[2 * q].x * rs, oa##j[2 * q].y * rs, oa##j[2 * q + 1].x * rs, oa##j[2 * q + 1].y * rs} * gv + bv; *(f32x4*)(frow + c0) = y; if (xb) *(u32x2*)(xb + (size_t)r * D_MODEL + c0) = pk4(y); } }
        PSH_LN(0) PSH_LN(1) PSH_LN(2) PSH_LN(3)
        asm volatile("s_waitcnt lgkmcnt(0)" ::: "memory");
    }
}
#ifndef PSH_LOG_V
#define PSH_LOG_V 11
#endif
constexpr int PSH_LOG = PSH_LOG_V, PSH_N = PEER_EXPERTS >> PSH_LOG;
#ifndef PS2_ROWS
#define PS2_ROWS 4
#endif
#define PS2_ROW(j) const int row##j = (qd * PS2_ROWS + j) * NW + gw; const int el##j = P.SELE[(size_t)row##j * 128 + lane], eh##j = P.SELE[(size_t)row##j * 128 + 64 + lane]; const float gl##j = P.SELG[(size_t)row##j * 128 + lane], gh##j = P.SELG[(size_t)row##j * 128 + 64 + lane]; \
    f32x2 oa##j[8]; _Pragma("unroll") for (int k = 0; k < 8; ++k) oa##j[k] = (f32x2){0.f, 0.f};
#define PS2_STEP(j) { unsigned long long b0 = __ballot((el##j >> PSH_LOG) == s), b1 = __ballot((eh##j >> PSH_LOG) == s); \
    if (b0 | b1) { const u32x4 xa##j = *(const u32x4*)(xb16 + (size_t)row##j * D_MODEL + 16 * lane), xc##j = *(const u32x4*)(xb16 + (size_t)row##j * D_MODEL + 16 * lane + 8);     \
      const f32x2 x2[8] = {(f32x2){bflo(xa##j.x), bfhi(xa##j.x)}, (f32x2){bflo(xa##j.y), bfhi(xa##j.y)}, (f32x2){bflo(xa##j.z), bfhi(xa##j.z)}, (f32x2){bflo(xa##j.w), bfhi(xa##j.w)}, (f32x2){bflo(xc##j.x), bfhi(xc##j.x)}, (f32x2){bflo(xc##j.y), bfhi(xc##j.y)}, (f32x2){bflo(xc##j.z), bfhi(xc##j.z)}, (f32x2){bflo(xc##j.w), bfhi(xc##j.w)}}; \
      _Pragma("unroll 1") while ((b0 | b1) != 0ull) { int hk[8]; u32x4 uw[8], vw[8]; int nv = 0; \
        _Pragma("unroll") for (int k = 0; k < 8; ++k) { int h; if (b0) { h = __builtin_ctzll(b0); b0 &= b0 - 1; ++nv; } else if (b1) { h = 64 + __builtin_ctzll(b1); b1 &= b1 - 1; ++nv; } else h = hk[k > 0 ? k - 1 : 0]; \
            hk[k] = h; const int e = (h < 64) ? __builtin_amdgcn_readlane(el##j, h & 63) : __builtin_amdgcn_readlane(eh##j, h & 63); \
            uw[k] = *(const u32x4*)(U + (size_t)e * D_MODEL + 16 * lane); vw[k] = *(const u32x4*)(Vt + (size_t)e * D_MODEL + 16 * lane); } \
        float d[8]; _Pragma("unroll") for (int k = 0; k < 8; ++k) d[k] = dot16_fp8(uw[k], x2); \
        float e4[4], e2[2], e1s; \
          \
        { const bool hi = lane & 1; _Pragma("unroll") for (int i = 0; i < 4; ++i) { const float keep = hi ? d[4 + i] : d[i], send = hi ? d[i] : d[4 + i]; e4[i] = keep + dppf<0xB1>(send); } } \
        { const bool hi = lane & 2; _Pragma("unroll") for (int i = 0; i < 2; ++i) { const float keep = hi ? e4[2 + i] : e4[i], send = hi ? e4[i] : e4[2 + i]; e2[i] = keep + dppf<0x4E>(send); } } \
        { const bool hi = lane & 4; const float keep = hi ? e2[1] : e2[0], send = hi ? e2[0] : e2[1]; const float r4 = dppf<0x124>(send), r12 = dppf<0x12C>(send); e1s = keep + (hi ? r4 : r12); } \
        e1s += dppf<0x128>(e1s); e1s = colsum(e1s); \
        const int myk = 4 * (lane & 1) + (lane & 2) + ((lane >> 2) & 1); int myh = hk[0]; _Pragma("unroll") for (int k = 1; k < 8; ++k) myh = (myk == k) ? hk[k] : myh; \
        const float ga = __shfl(gl##j, myh & 63), gb = __shfl(gh##j, myh & 63); const float myg = (myk < nv) ? ((myh < 64) ? ga : gb) : 0.f;     \
        const float act = myg * gelu_tanh(e1s * (1.0f / PEER_SU)) * (1.0f / PEER_SV); \
        _Pragma("unroll") for (int k = 0; k < 8; ++k) { const int src = (k >> 2) | (((k >> 1) & 1) << 1) | ((k & 1) << 2); axpy16_fp8(vw[k], rdlane(act, src), oa##j); } } } }
#define PS2_LN(j) { const int r = row##j; f32x2 x2[8]; int ll = lane; asm volatile("" : "+v"(ll));     \
    _Pragma("unroll") for (int q = 0; q < 4; ++q) { const f32x4 a = *(const f32x4*)(xin + (size_t)r * D_MODEL + 16 * ll + 4 * q); x2[2 * q] = (f32x2){a.x, a.y}; x2[2 * q + 1] = (f32x2){a.z, a.w}; } \
    float sm = 0.f; _Pragma("unroll") for (int k = 0; k < 8; ++k) { oa##j[k] += x2[k] * ALPHA; sm += oa##j[k].x + oa##j[k].y; } \
    const float mu = wave_sum(sm) * (1.0f / D_MODEL); float s2 = 0.f; _Pragma("unroll") for (int k = 0; k < 8; ++k) { oa##j[k] -= mu; s2 += oa##j[k].x * oa##j[k].x + oa##j[k].y * oa##j[k].y; } \
    const float rs = 1.0f / sqrtf(wave_sum(s2) * (1.0f / D_MODEL) + LN_EPS); float* frow = fout + (size_t)r * D_MODEL; \
    _Pragma("unroll") for (int q = 0; q < 4; ++q) { const int c0 = 16 * ll + 4 * q; const f32x4 gv = *(const f32x4*)(gam + c0), bv = *(const f32x4*)(bet + c0); \
        const f32x4 y = (f32x4){oa##j[2 * q].x * rs, oa##j[2 * q].y * rs, oa##j[2 * q + 1].x * rs, oa##j[2 * q + 1].y * rs} * gv + bv; *(f32x4*)(frow + c0) = y; if (xb) *(u32x2*)(xb + (size_t)r * D_MODEL + c0) = pk4(y); } }
DI void xcd_soft_sync(unsigned* cnt, volatile LAS unsigned* st, unsigned x, unsigned& round) {
    if (!st) return;
    __syncthreads();
    if (threadIdx.x == 0) { const unsigned nloc = st[0];
        if (nloc) { unsigned* c = cnt + 64 * x; (void)xb_add(c, 1u); const unsigned target = (round + 1u) * nloc; unsigned sp = 0;
            while (xb_ld(c) < target && ++sp < 4096u) __builtin_amdgcn_s_sleep(1); } }
    __syncthreads(); ++round;
}
DI void peer_sharded2_phase(const FP& P, const Ctx& C, int layer, const float* xin, const bf16* xb16, float* fout, bf16* xb, volatile LAS unsigned* st = nullptr, unsigned xcc = 0) {
    unsigned round = 0; unsigned* hint = P.ctl + 8192 + layer * 1024;
    const int lane = C.lane; const unsigned char* U = P.UB8 + (size_t)layer * PEER_EXPERTS * D_MODEL; const unsigned char* Vt = P.VB8 + (size_t)layer * PEER_EXPERTS * D_MODEL;
    const float* gam = P.ln_g + ((size_t)layer * 2 + 1) * D_MODEL; const float* bet = P.ln_b + ((size_t)layer * 2 + 1) * D_MODEL;
    const int NW = C.G * NWAVES, gw = C.vcu * NWAVES + C.wave; const int nquads = (M0 / NW) / PS2_ROWS;
#pragma unroll 1
    for (int qd = 0; qd < nquads; ++qd) {
#if PS2_ROWS == 4
        PS2_ROW(0) PS2_ROW(1) PS2_ROW(2) PS2_ROW(3)
#pragma unroll 1
        for (int s = 0; s < PSH_N; ++s) {
#ifdef PEER_SOFTSYNC
            xcd_soft_sync(hint, st, xcc, round);
#endif
            PS2_STEP(0) PS2_STEP(1) PS2_STEP(2) PS2_STEP(3) }
        PS2_LN(0) PS2_LN(1) PS2_LN(2) PS2_LN(3)
#else
        PS2_ROW(0) PS2_ROW(1)
#pragma unroll 1
        for (int s = 0; s < PSH_N; ++s) { PS2_STEP(0) PS2_STEP(1) }
        PS2_LN(0) PS2_LN(1)
#endif
    }
}
#define PS3_ROW(j) const int row##j = (qd * 4 + j) * NW + gw; const int el##j = P.SELE[(size_t)row##j * 128 + lane], eh##j = P.SELE[(size_t)row##j * 128 + 64 + lane]; \
    { const u32x4 xa = *(const u32x4*)(xb16 + (size_t)row##j * D_MODEL + 16 * lane), xc = *(const u32x4*)(xb16 + (size_t)row##j * D_MODEL + 16 * lane + 8); *(LAS u32x4*)(xs + j * 1024 + 16 * lane) = xa; *(LAS u32x4*)(xs + j * 1024 + 16 * lane + 8) = xc; } \
    f32x2 oa##j[8]; _Pragma("unroll") for (int k = 0; k < 8; ++k) oa##j[k] = (f32x2){0.f, 0.f};
#define PS3_X2_UNUSED(j) const f32x2 x2[8] = {(f32x2){bflo(xa##j.x), bfhi(xa##j.x)}, (f32x2){bflo(xa##j.y), bfhi(xa##j.y)}, (f32x2){bflo(xa##j.z), bfhi(xa##j.z)}, (f32x2){bflo(xa##j.w), bfhi(xa##j.w)}, (f32x2){bflo(xc##j.x), bfhi(xc##j.x)}, (f32x2){bflo(xc##j.y), bfhi(xc##j.y)}, (f32x2){bflo(xc##j.z), bfhi(xc##j.z)}, (f32x2){bflo(xc##j.w), bfhi(xc##j.w)}};
#define PS3_TAKE(q, M, ELH, GOFF) if (!got && M) { const int h = __builtin_ctzll(M); M &= M - 1; qq[k] = q; ee = __builtin_amdgcn_readlane(ELH, h); gk[k] = P.SELG[GOFF + h];     got = true; ++nv; }
DI void peer_sharded3_phase(const FP& P, const Ctx& C, int layer, const float* xin, const bf16* xb16, float* fout, bf16* xb) {
    const int lane = C.lane; const unsigned char* U = P.UB8 + (size_t)layer * PEER_EXPERTS * D_MODEL; const unsigned char* Vt = P.VB8 + (size_t)layer * PEER_EXPERTS * D_MODEL;
    const float* gam = P.ln_g + ((size_t)layer * 2 + 1) * D_MODEL; const float* bet = P.ln_b + ((size_t)layer * 2 + 1) * D_MODEL;
    const int NW = C.G * NWAVES, gw = C.vcu * NWAVES + C.wave; const int nquads = (M0 / NW) / 4; LAS bf16* xs = (LAS bf16*)(C.lds + C.wave * 16384);
#pragma unroll 1
    for (int qd = 0; qd < nquads; ++qd) {
        PS3_ROW(0) PS3_ROW(1) PS3_ROW(2) PS3_ROW(3)
        asm volatile("s_waitcnt lgkmcnt(0)" ::: "memory");
#pragma unroll 1
        for (int s = 0; s < PSH_N; ++s) {
            unsigned long long m0 = __ballot((el0 >> PSH_LOG) == s), m1 = __ballot((eh0 >> PSH_LOG) == s), m2 = __ballot((el1 >> PSH_LOG) == s), m3 = __ballot((eh1 >> PSH_LOG) == s),
                               m4 = __ballot((el2 >> PSH_LOG) == s), m5 = __ballot((eh2 >> PSH_LOG) == s), m6 = __ballot((el3 >> PSH_LOG) == s), m7 = __ballot((eh3 >> PSH_LOG) == s);
#pragma unroll 1
            while ((m0 | m1 | m2 | m3 | m4 | m5 | m6 | m7) != 0ull) {
                int qq[8]; float gk[8]; int es[8]; u32x4 uw[8]; int nv = 0; int elast = 0;
#pragma unroll
                for (int k = 0; k < 8; ++k) { bool got = false; int ee = elast; qq[k] = k > 0 ? qq[k - 1] : 0; gk[k] = 0.f;
                    PS3_TAKE(0, m0, el0, (size_t)row0 * 128) PS3_TAKE(1, m1, eh0, (size_t)row0 * 128 + 64) PS3_TAKE(2, m2, el1, (size_t)row1 * 128) PS3_TAKE(3, m3, eh1, (size_t)row1 * 128 + 64) PS3_TAKE(4, m4, el2, (size_t)row2 * 128) PS3_TAKE(5, m5, eh2, (size_t)row2 * 128 + 64) PS3_TAKE(6, m6, el3, (size_t)row3 * 128) PS3_TAKE(7, m7, eh3, (size_t)row3 * 128 + 64)
                    elast = ee; es[k] = ee; uw[k] = *(const u32x4*)(U + (size_t)ee * D_MODEL + 16 * lane); }
                float d[8];
#pragma unroll
                for (int k = 0; k < 8; ++k) { const int j = qq[k] >> 1; const u32x4 xa = *(const LAS u32x4*)(xs + j * 1024 + 16 * lane), xc = *(const LAS u32x4*)(xs + j * 1024 + 16 * lane + 8);
                    const f32x2 x2[8] = {(f32x2){bflo(xa.x), bfhi(xa.x)}, (f32x2){bflo(xa.y), bfhi(xa.y)}, (f32x2){bflo(xa.z), bfhi(xa.z)}, (f32x2){bflo(xa.w), bfhi(xa.w)}, (f32x2){bflo(xc.x), bfhi(xc.x)}, (f32x2){bflo(xc.y), bfhi(xc.y)}, (f32x2){bflo(xc.z), bfhi(xc.z)}, (f32x2){bflo(xc.w), bfhi(xc.w)}};
                    d[k] = dot16_fp8(uw[k], x2); }
                u32x4 vw[8];
#pragma unroll
                for (int k = 0; k < 8; ++k) vw[k] = *(const u32x4*)(Vt + (size_t)es[k] * D_MODEL + 16 * lane);
                float e4[4], e2[2], e1s;
                { const bool hi = lane & 1;
#pragma unroll
                  for (int i = 0; i < 4; ++i) { const float keep = hi ? d[4 + i] : d[i], send = hi ? d[i] : d[4 + i]; e4[i] = keep + __shfl_xor(send, 1); } }
                { const bool hi = lane & 2;
#pragma unroll
                  for (int i = 0; i < 2; ++i) { const float keep = hi ? e4[2 + i] : e4[i], send = hi ? e4[i] : e4[2 + i]; e2[i] = keep + __shfl_xor(send, 2); } }
                { const bool hi = lane & 4; const float keep = hi ? e2[1] : e2[0], send = hi ? e2[0] : e2[1]; e1s = keep + __shfl_xor(send, 4); }
                e1s += __shfl_xor(e1s, 8); e1s += __shfl_xor(e1s, 16); e1s += __shfl_xor(e1s, 32);
                const int myk = 4 * (lane & 1) + (lane & 2) + ((lane >> 2) & 1); float myg = gk[0];
#pragma unroll
                for (int k = 1; k < 8; ++k) myg = (myk == k) ? gk[k] : myg;
                const float act = myg * gelu_tanh(e1s * (1.0f / PEER_SU)) * (1.0f / PEER_SV);
#pragma unroll
                for (int k = 0; k < 8; ++k) { const int src = (k >> 2) | (((k >> 1) & 1) << 1) | ((k & 1) << 2); const float a = rdlane(act, src); const int j = qq[k] >> 1;
                    if (j == 0) { asm volatile("" ::: "memory"); axpy16_fp8(vw[k], a, oa0); } else if (j == 1) { asm volatile("" ::: "memory"); axpy16_fp8(vw[k], a, oa1); } else if (j == 2) { asm volatile("" ::: "memory"); axpy16_fp8(vw[k], a, oa2); } else { asm volatile("" ::: "memory"); axpy16_fp8(vw[k], a, oa3); } }
            }
        }
        PS2_LN(0) PS2_LN(1) PS2_LN(2) PS2_LN(3)
    }
}
}
namespace fx {
struct EpiB {
    static constexpr bool PERM = true, AFTER_DRAIN = false; const FP& P;
    DI void operator()(const f32x4 (&acc)[2][2][4][2], const pg8::Unit& u, int wr, int wc, int fr, int fq) const {
        const int t = u.pn;
        EPI_LOOP({ if (row < MP) { const int pos = row_pos(row), n = row / SEQ, e = ct & 63, dp = e >> 1; const bool prm = row < M0;
            if (t < 3) { const int ty = 2 * t + (ct >> 7), kvh = (ct >> 6) & 1;
                if (ty == 2 || ty == 4) { f32x4 lo, hi; rope4(P.ROPE + pos * 64, dp, v0, v1, lo, hi);
                    if (ty == 2) { float* o = (prm ? P.nsa_kv_p + (size_t)row * 512 : P.nsa_kv_s + (size_t)(row - M0) * 512) + 256 + kvh * 64 + dp; *(f32x4*)o = lo; *(f32x4*)(o + 32) = hi;
                        if (prm) { bf16* kt = P.SLK + ((size_t)n * NSA_KV_HEADS + kvh) * SEQ * 64; *(u32x2*)(kt + ktile_off(pos, dp)) = pk4(lo); *(u32x2*)(kt + ktile_off(pos, dp + 32)) = pk4(hi); } }
                    else { float* o = nullptr; if (!prm) o = P.win_s + (((size_t)(row - M0) * SWA_WINDOW + SWA_WINDOW - 1) * 2 + 0) * 128; else if (pos >= SEQ - SWA_WINDOW) o = P.win_p + (((size_t)n * SWA_WINDOW + pos - (SEQ - SWA_WINDOW)) * 2 + 0) * 128;
                        if (o) { *(f32x4*)(o + kvh * 64 + dp) = lo; *(f32x4*)(o + kvh * 64 + 32 + dp) = hi; }
                        if (prm) { bf16* kt = P.WNK + ((size_t)n * NSA_KV_HEADS + kvh) * SEQ * 64; *(u32x2*)(kt + ktile_off(pos, dp)) = pk4(lo); *(u32x2*)(kt + ktile_off(pos, dp + 32)) = pk4(hi); } } }
                else if (ty < 4) { float* o = (prm ? P.nsa_kv_p + (size_t)row * 512 : P.nsa_kv_s + (size_t)(row - M0) * 512) + ty * 128 + kvh * 64 + e; *(f32x4*)o = v0; *(f32x4*)(o + 4) = v1;
                    if (prm) { if (ty < 2) *(u32x4*)(P.AC + ((size_t)ty * ACROWS + ((size_t)n * NSA_KV_HEADS + kvh) * NCH + pos / 16) * 1024 + (pos % 16) * 64 + e) = pk8(v0, v1);
                        else { bf16* vt = P.SLVT + ((size_t)n * NSA_KV_HEADS + kvh) * SEQ * 64 + vtile_off(e, pos);
                            vt[0] = (bf16)f2bf(v0.x); vt[8] = (bf16)f2bf(v0.y); vt[16] = (bf16)f2bf(v0.z); vt[24] = (bf16)f2bf(v0.w); vt[32] = (bf16)f2bf(v1.x); vt[40] = (bf16)f2bf(v1.y); vt[48] = (bf16)f2bf(v1.z); vt[56] = (bf16)f2bf(v1.w); } } }
                else { float* o = nullptr; if (!prm) o = P.win_s + (((size_t)(row - M0) * SWA_WINDOW + SWA_WINDOW - 1) * 2 + 1) * 128; else if (pos >= SEQ - SWA_WINDOW) o = P.win_p + (((size_t)n * SWA_WINDOW + pos - (SEQ - SWA_WINDOW)) * 2 + 1) * 128;
                    if (o) { *(f32x4*)(o + kvh * 64 + e) = v0; *(f32x4*)(o + kvh * 64 + e + 4) = v1; }
                    if (prm) { bf16* vt = P.WNVT + ((size_t)n * NSA_KV_HEADS + kvh) * SEQ * 64 + vtile_off(e, pos);
                        vt[0] = (bf16)f2bf(v0.x); vt[8] = (bf16)f2bf(v0.y); vt[16] = (bf16)f2bf(v0.z); vt[24] = (bf16)f2bf(v0.w); vt[32] = (bf16)f2bf(v1.x); vt[40] = (bf16)f2bf(v1.y); vt[48] = (bf16)f2bf(v1.z); vt[56] = (bf16)f2bf(v1.w); } } }
            else if (t < 6) { const int h = (t - 3) * 4 + (ct >> 6); f32x4 lo, hi; rope4(P.ROPE + pos * 64, dp, v0, v1, lo, hi); bf16* q = P.QB + (size_t)row * NSA_Q_COLS + h * 64 + dp; *(u32x2*)q = pk4(lo * QSCALE); *(u32x2*)(q + 32) = pk4(hi * QSCALE); }
            else if (t == 6) { *(u32x4*)(P.MQB + (size_t)row * 256 + ct) = pk8(v0 * QSCALE, v1 * QSCALE); }
            else if (ct < 40) { const float vv[8] = {v0.x, v0.y, v0.z, v0.w, v1.x, v1.y, v1.z, v1.w};
                _Pragma("unroll") for (int i = 0; i < 8; ++i) if (ct + i < NSA_GATE_COLS) P.GATES[(size_t)row * 64 + ct + i] = 1.0f / (1.0f + __expf(-vv[i])); } } })
    }
};
DI void cmp2_phase(const FP& P, const Ctx& C) {
    const int lane = C.lane; LAS float* hs = (LAS float*)(C.lds + C.wave * 1024);
    constexpr int NGRP = NCTX * 2 * NSA_KV_HEADS; const int NW = C.G * NWAVES, WPG = NW / NGRP > 0 ? NW / NGRP : 1; const int gw = C.vcu * NWAVES + C.wave;
#pragma unroll 1
    for (int grp = gw / WPG; grp < NGRP; grp += (NW + WPG - 1) / WPG) { const int slot = gw % WPG; if (gw >= (NW / WPG) * WPG && grp == gw / WPG) break;
        const int kvh = grp % NSA_KV_HEADS, ty = (grp / NSA_KV_HEADS) % 2, ctx = grp / (2 * NSA_KV_HEADS);
        const float* UL = P.UL + ((size_t)ty * ACROWS + ((size_t)ctx * NSA_KV_HEADS + kvh) * NCH) * 256; const float* w2 = P.cmp_w2 + (size_t)ty * CMP_HIDDEN * HEAD_DIM;
        float w2r[CMP_HIDDEN];
#pragma unroll
        for (int k = 0; k < CMP_HIDDEN; ++k) w2r[k] = w2[k * HEAD_DIM + lane];
        const float b0 = P.CBIAS[ty * CMP_HIDDEN + lane], b1 = P.CBIAS[ty * CMP_HIDDEN + 64 + lane];
        float u0, u1, l0, l1; int c = slot;
        if (c < NCMP) { u0 = UL[(size_t)c * 256 + lane]; u1 = UL[(size_t)c * 256 + 64 + lane]; l0 = UL[(size_t)(c + 1) * 256 + 128 + lane]; l1 = UL[(size_t)(c + 1) * 256 + 192 + lane]; }
#pragma unroll 1
        for (; c < NCMP; c += WPG) { const float h0 = gelu_tanh(u0 + l0 + b0), h1 = gelu_tanh(u1 + l1 + b1); const int cn = c + WPG;
            if (cn < NCMP) { u0 = UL[(size_t)cn * 256 + lane]; u1 = UL[(size_t)cn * 256 + 64 + lane]; l0 = UL[(size_t)(cn + 1) * 256 + 128 + lane]; l1 = UL[(size_t)(cn + 1) * 256 + 192 + lane]; }
            hs[lane] = h0; hs[64 + lane] = h1; asm volatile("s_waitcnt lgkmcnt(0)" ::: "memory");
            float a = 0.f;
#pragma unroll
            for (int k4 = 0; k4 < CMP_HIDDEN / 4; ++k4) { const f32x4 hv = *(const LAS f32x4*)(hs + 4 * k4); a += hv.x * w2r[4 * k4] + hv.y * w2r[4 * k4 + 1] + hv.z * w2r[4 * k4 + 2] + hv.w * w2r[4 * k4 + 3]; }
            if (ty == 0) { const float other = __shfl_xor(a, 32); const int pos = c * CMP_STRIDE + CMP_BLOCK - 1; const float cs = P.ROPE[pos * 64 + (lane & 31)], sn = P.ROPE[pos * 64 + 32 + (lane & 31)];
                a = (lane < 32) ? a * cs - other * sn : a * cs + other * sn; }
            if (ctx < BATCH) { if (ty == 0) P.CK[((size_t)ctx * NSA_KV_HEADS + kvh) * NCH * 64 + ktile_off(c, lane)] = (bf16)f2bf(a); else P.CVT[((size_t)ctx * NSA_KV_HEADS + kvh) * NCH * 64 + vtile_off(lane, c)] = (bf16)f2bf(a); }
            else { (ty == 0 ? P.CKF : P.CVF)[(((size_t)(ctx - BATCH) * NSA_KV_HEADS + kvh) * NCH + c) * 64 + lane] = a; }
            asm volatile("s_waitcnt lgkmcnt(0)" ::: "memory"); }
    }
    __syncthreads();
}
constexpr int NSA_WLDS = 8192;
DI void nsa_pair_a(const FP& P, int n, int kvh, int t, int lane, LAS unsigned char* wl) {
    LAS float* pn = (LAS float*)wl; LAS float* imp = (LAS float*)(wl + 2048); LAS float* sc = (LAS float*)(wl + 6144); LAS int* sel = (LAS int*)(wl + 7168);
    const int col = lane & 15, c = lane >> 4; const bool vcol = col < 12; const int qq = vcol ? col / 6 : 0, hh = vcol ? col % 6 : 0, tq = t + qq, head = kvh * NSA_GROUP + hh, row = n * SEQ + tq;
    bf16x8 qf[2]; { const bf16* qp = P.QB + (size_t)row * NSA_Q_COLS + head * 64 + 8 * c; qf[0] = *(const bf16x8*)qp; qf[1] = *(const bf16x8*)(qp + 32); }
    const float* gt = P.GATES + (size_t)row * 64 + head * 3;
    f32x4 oacc[4] = {(f32x4){0.f, 0.f, 0.f, 0.f}, (f32x4){0.f, 0.f, 0.f, 0.f}, (f32x4){0.f, 0.f, 0.f, 0.f}, (f32x4){0.f, 0.f, 0.f, 0.f}};
    const int lim = vcol ? ((tq >= CMP_BLOCK - 1) ? (tq - (CMP_BLOCK - 1)) / CMP_STRIDE : -1) : -1;
    const int limmax = (t + 1 >= CMP_BLOCK - 1) ? (t + 1 - (CMP_BLOCK - 1)) / CMP_STRIDE : -1; const int nblk = (limmax + 32) / 32;
    const bf16* CKb = P.CK + ((size_t)n * NSA_KV_HEADS + kvh) * NCH * 64; const bf16* CVb = P.CVT + ((size_t)n * NSA_KV_HEADS + kvh) * 64 * NCH;
    for (int i = lane; i < 1024; i += 64) imp[i] = 0.f;
    float m1 = -INFINITY, l1 = 0.f;
    { struct K4 { bf16x8 a0, a1, b0, b1; };
      auto ldk = [&](K4& k, int blk) { const bf16* kt = CKb + (size_t)blk * 2048 + lane * 8; k.a0 = *(const bf16x8*)kt; k.a1 = *(const bf16x8*)(kt + 512); k.b0 = *(const bf16x8*)(kt + 1024); k.b1 = *(const bf16x8*)(kt + 1536); };
      auto cp1 = [&](const K4& k, int blk) { const int kb = 32 * blk;
        f32x4 s0 = (f32x4){0.f, 0.f, 0.f, 0.f}, s1 = (f32x4){0.f, 0.f, 0.f, 0.f};
        s0 = __builtin_amdgcn_mfma_f32_16x16x32_bf16(k.a0, qf[0], s0, 0, 0, 0); s0 = __builtin_amdgcn_mfma_f32_16x16x32_bf16(k.a1, qf[1], s0, 0, 0, 0);
        s1 = __builtin_amdgcn_mfma_f32_16x16x32_bf16(k.b0, qf[0], s1, 0, 0, 0); s1 = __builtin_amdgcn_mfma_f32_16x16x32_bf16(k.b1, qf[1], s1, 0, 0, 0);
        float s[8] = {s0.x, s0.y, s0.z, s0.w, s1.x, s1.y, s1.z, s1.w}; float mx = -INFINITY;
        const int hi1 = lim - (kb + 8 * c);
#pragma unroll
        for (int e = 0; e < 8; ++e) { s[e] = (e <= hi1) ? s[e] : -INFINITY; mx = fmaxf(mx, s[e]); }
        mx = colmax(mx);
        const float mnew = fmaxf(m1, mx), muse = (mnew == -INFINITY) ? 0.f : mnew; float ls = 0.f;
#pragma unroll
        for (int e = 0; e < 8; ++e) ls += __builtin_amdgcn_exp2f(s[e] - muse);
        l1 = l1 * __builtin_amdgcn_exp2f(m1 - muse) + ls; m1 = mnew; };
      if (nblk > 0) { K4 A, B; ldk(A, 0);
#pragma unroll 1
        for (int blk = 0; blk < nblk; blk += 2) { ldk(B, (blk + 1 < nblk) ? blk + 1 : blk); cp1(A, blk); ldk(A, (blk + 2 < nblk) ? blk + 2 : blk); if (blk + 1 < nblk) cp1(B, blk + 1); } } }
    asm volatile("s_waitcnt lgkmcnt(0)" ::: "memory");
    { l1 = colsum(l1); const float muse = (m1 == -INFINITY) ? 0.f : m1, inv = (l1 > 0.f) ? 1.0f / l1 : 0.f;
      f32x4 oc[4] = {(f32x4){0.f, 0.f, 0.f, 0.f}, (f32x4){0.f, 0.f, 0.f, 0.f}, (f32x4){0.f, 0.f, 0.f, 0.f}, (f32x4){0.f, 0.f, 0.f, 0.f}};
      pipe2(nblk, [&](KV8& kv, int blk) { kv_load_t(kv, CKb + (size_t)blk * 2048, CVb + (size_t)blk * 2048, lane); }, [&](const KV8& kv, int blk) { const int kb = 32 * blk;
        f32x4 s0 = (f32x4){0.f, 0.f, 0.f, 0.f}, s1 = (f32x4){0.f, 0.f, 0.f, 0.f};
        s0 = __builtin_amdgcn_mfma_f32_16x16x32_bf16(kv.ka0, qf[0], s0, 0, 0, 0); s0 = __builtin_amdgcn_mfma_f32_16x16x32_bf16(kv.ka1, qf[1], s0, 0, 0, 0);
        s1 = __builtin_amdgcn_mfma_f32_16x16x32_bf16(kv.kb0, qf[0], s1, 0, 0, 0); s1 = __builtin_amdgcn_mfma_f32_16x16x32_bf16(kv.kb1, qf[1], s1, 0, 0, 0);
        float s[8] = {s0.x, s0.y, s0.z, s0.w, s1.x, s1.y, s1.z, s1.w};
        const int hi2 = lim - (kb + 8 * c);
#pragma unroll
        for (int e = 0; e < 8; ++e) s[e] = (e <= hi2) ? __builtin_amdgcn_exp2f(s[e] - muse) * inv : 0.f;
        *(f32x4*)(pn + col * 32 + 8 * c) = (f32x4){s[0], s[1], s[2], s[3]}; *(f32x4*)(pn + col * 32 + 8 * c + 4) = (f32x4){s[4], s[5], s[6], s[7]};
        u32x4 pw; pw.x = cvtpk(s[0], s[1]); pw.y = cvtpk(s[2], s[3]); pw.z = cvtpk(s[4], s[5]); pw.w = cvtpk(s[6], s[7]); const bf16x8 pf = __builtin_bit_cast(bf16x8, pw);
        oc[0] = __builtin_amdgcn_mfma_f32_16x16x32_bf16(kv.v0, pf, oc[0], 0, 0, 0); oc[1] = __builtin_amdgcn_mfma_f32_16x16x32_bf16(kv.v1, pf, oc[1], 0, 0, 0);
        oc[2] = __builtin_amdgcn_mfma_f32_16x16x32_bf16(kv.v2, pf, oc[2], 0, 0, 0); oc[3] = __builtin_amdgcn_mfma_f32_16x16x32_bf16(kv.v3, pf, oc[3], 0, 0, 0);
        asm volatile("s_waitcnt lgkmcnt(0)" ::: "memory");
        { const int q2 = lane >> 5, k = lane & 31; float a = 0.f;
#pragma unroll
          for (int h6 = 0; h6 < 6; ++h6) a += pn[(q2 * 6 + h6) * 32 + k];
          imp[q2 * 512 + kb + k] = a; }
        asm volatile("s_waitcnt lgkmcnt(0)" ::: "memory"); });
#ifdef NSA_DEBUG
      if (vcol) { for (int db = 0; db < 4; ++db) *(f32x4*)(P.DBG + ((size_t)0 * MP + row) * 768 + head * 64 + 16 * db + 4 * c) = oc[db]; }
#endif
      const float g0 = vcol ? gt[0] : 0.f;
#pragma unroll
      for (int db = 0; db < 4; ++db) oacc[db] += oc[db] * g0; }
#ifndef REP_SEL
#define REP_SEL 1
#endif
#pragma unroll 1
    for (int rep = 0; rep < REP_SEL; ++rep) {
    for (int i = lane; i < 256; i += 64) { const int q2 = i >> 7, b = i & 127, tq2 = t + q2, cur = tq2 / SLC_BLOCK; float sv;
        if (b > cur) sv = NEG; else if (b == 0 || b == cur || b == cur - 1) sv = FORCE_SCORE;
        else { const LAS float* ic = imp + q2 * 512 + 4 * b; sv = ic[-1] + 2.f * (ic[0] + ic[1] + ic[2]) + ic[3]; }
        sc[i] = pack_key(sv, 127u - (unsigned)b, 127u); }
    asm volatile("s_waitcnt lgkmcnt(0)" ::: "memory");
    for (int i = lane; i < 256; i += 64) { const int q2 = i >> 7, b = i & 127; const float sv = sc[i]; int rank = 0;
        for (int j = 0; j < 128; j += 4) { const f32x4 o = *(const LAS f32x4*)(sc + q2 * 128 + j);
            rank += (o.x > sv) ? 1 : 0; rank += (o.y > sv) ? 1 : 0; rank += (o.z > sv) ? 1 : 0; rank += (o.w > sv) ? 1 : 0; }
        if (rank < SLC_TOPK) { const int v = (sv > 0.5f * NEG) ? b : -1; sel[q2 * 16 + rank] = v; P.SELB[((size_t)(n * SEQ + t + q2) * NSA_KV_HEADS + kvh) * 16 + rank] = v; } }
    asm volatile("s_waitcnt lgkmcnt(0)" ::: "memory");
    }
#ifndef REP_WIN
#define REP_WIN 1
#endif
#pragma unroll 1
    for (int rep = 0; rep < REP_WIN; ++rep) { Tile16 T; tile_init(T);
      const bf16* WKb = P.WNK + ((size_t)n * NSA_KV_HEADS + kvh) * SEQ * 64; const bf16* WVb = P.WNVT + ((size_t)n * NSA_KV_HEADS + kvh) * 64 * SEQ;
      const int blo = (t - SWA_WINDOW) >> 5, bhi = (t + 1) >> 5;
      auto ld = [&](KV8& kv, int blk) { const int bc = blk < 0 ? 0 : blk; kv_load_t(kv, WKb + (size_t)bc * 2048, WVb + (size_t)bc * 2048, lane); };
      pipe2(bhi - blo + 1, [&](KV8& kv, int i) { ld(kv, blo + i); }, [&](const KV8& kv, int i) { const int kb = 32 * (blo + i);
          const int k0 = kb + 8 * c; int lo; unsigned rng; const int a = tq - SWA_WINDOW; mk_range((a > 0 ? a : 0) - k0, tq - k0, vcol, lo, rng); tile_compute(T, qf, kv, lo, rng); });
      T.l = colsum(T.l);
      const float inv = (T.l > 0.f) ? 1.0f / T.l : 0.f, g2 = vcol ? gt[2] * inv : 0.f;
#ifdef NSA_DEBUG
      if (vcol) { for (int db = 0; db < 4; ++db) *(f32x4*)(P.DBG + ((size_t)2 * MP + row) * 768 + head * 64 + 16 * db + 4 * c) = T.o[db] * inv; }
#endif
#pragma unroll
      for (int db = 0; db < 4; ++db) if (rep == REP_WIN - 1) oacc[db] += T.o[db] * g2; }
    if (vcol) { float* op = P.DPART + (size_t)row * 768 + head * 64 + 4 * c;
#pragma unroll
        for (int db = 0; db < 4; ++db) *(f32x4*)(op + 16 * db) = oacc[db]; }
}
DI void nsa_pair_b(const FP& P, int n, int kvh, int t, int lane, LAS unsigned char* wl) {
    LAS int* steps = (LAS int*)wl;
    const int col = lane & 15, c = lane >> 4; const bool vcol = col < 12; const int qq = vcol ? col / 6 : 0, hh = vcol ? col % 6 : 0, tq = t + qq, head = kvh * NSA_GROUP + hh, row = n * SEQ + tq;
    bf16x8 qf[2]; { const bf16* qp = P.QB + (size_t)row * NSA_Q_COLS + head * 64 + 8 * c; qf[0] = *(const bf16x8*)qp; qf[1] = *(const bf16x8*)(qp + 32); }
    const float* gt = P.GATES + (size_t)row * 64 + head * 3;
    Tile16 T; tile_init(T);
    const bf16* SKb = P.SLK + ((size_t)n * NSA_KV_HEADS + kvh) * SEQ * 64; const bf16* SVb = P.SLVT + ((size_t)n * NSA_KV_HEADS + kvh) * SEQ * 64;
    int ns = 0;
    { const int mysel = (lane < 32) ? P.SELB[((size_t)(n * SEQ + t + (lane >> 4)) * NSA_KV_HEADS + kvh) * 16 + (lane & 15)] : -1;
      for (int i = 0; i < 32; ++i) { const int b = __builtin_amdgcn_readlane(mysel, i); if (b < 0) continue; int q2 = i >> 4;
          const unsigned long long other = __ballot(mysel == b && lane < 32 && (lane >> 4) != q2);
          if (other) { if (q2 == 1) continue; q2 = 2; }
          if (lane == 0) { steps[ns] = (b * SLC_BLOCK) | (q2 << 29); steps[ns + 1] = (b * SLC_BLOCK + 32) | (q2 << 29); } ns += 2; } }
    asm volatile("s_waitcnt lgkmcnt(0)" ::: "memory");
    auto ld = [&](KV8& kv, int i) { const int code = __builtin_amdgcn_readfirstlane(steps[i]); const int kb = code & 0x1fffffff;
        kv_load_t(kv, SKb + (size_t)(kb >> 5) * 2048, SVb + (size_t)(kb >> 5) * 2048, lane); };
#ifdef PROBE_DBLCOMP
    Tile16 T2; tile_init(T2);
#endif
    pipe2(ns, ld, [&](const KV8& kv, int i) { const int code = __builtin_amdgcn_readfirstlane(steps[i]); const int kb = code & 0x1fffffff, q2 = code >> 29;
        int lo; unsigned rng; mk_range(-64, tq - (kb + 8 * c), vcol && (q2 == 2 || qq == q2), lo, rng); tile_compute(T, qf, kv, lo, rng);
#ifdef PROBE_DBLCOMP
        tile_compute(T2, qf, kv, [&](int e) { return vcol && qq == q2 && (kb + 8 * c + e + 1) <= tq; });
#endif
    });
#ifdef PROBE_DBLCOMP
    if (T2.l < 0.f) T.l = 0.f;
#endif
    T.l = colsum(T.l);
    const float inv = (T.l > 0.f) ? 1.0f / T.l : 0.f, g1 = vcol ? gt[1] * inv : 0.f;
#ifdef NSA_DEBUG
    if (vcol) { for (int db = 0; db < 4; ++db) *(f32x4*)(P.DBG + ((size_t)1 * MP + row) * 768 + head * 64 + 16 * db + 4 * c) = T.o[db] * inv; }
#endif
    if (vcol) { const float* pp = P.DPART + (size_t)row * 768 + head * 64 + 4 * c; bf16* op = P.ATTB + (size_t)row * 1024 + head * 64 + 4 * c;
#pragma unroll
        for (int db = 0; db < 4; ++db) *(u32x2*)(op + 16 * db) = pk4(*(const f32x4*)(pp + 16 * db) + T.o[db] * g1); }
}

constexpr int SMP_SK = 1088;
template <class KF, class VF> DI void smp_branch(const Ctx& C, LAS float* qs, LAS float* S, LAS float* red, int NK, KF kf, VF vf, bool keep_probs, float (&outh)[1]) {
    const int tid = C.tid, lane = C.lane, w = C.wave;
#pragma unroll 1
    for (int j = tid; j < NK; j += NTHREADS) { const float* k = kf(j); f32x4 kr[16];
#pragma unroll
        for (int d4 = 0; d4 < 16; ++d4) kr[d4] = *(const f32x4*)(k + 4 * d4);
#pragma unroll 1
        for (int h = 0; h < 6; ++h) { float a = 0.f;
#pragma unroll
            for (int d4 = 0; d4 < 16; ++d4) { const f32x4 qv = *(const LAS f32x4*)(qs + h * 64 + 4 * d4); a += kr[d4].x * qv.x + kr[d4].y * qv.y + kr[d4].z * qv.z + kr[d4].w * qv.w; }
            S[h * SMP_SK + j] = a; } }
    asm volatile("s_waitcnt lgkmcnt(0)" ::: "memory"); __syncthreads();
    if (w < 6) { float m = -INFINITY; for (int j = lane; j < NK; j += 64) m = fmaxf(m, S[w * SMP_SK + j]); m = wave_max(m);
        float l = 0.f; for (int j = lane; j < NK; j += 64) { const float p = __builtin_amdgcn_exp2f(S[w * SMP_SK + j] - m); S[w * SMP_SK + j] = p; l += p; } l = wave_sum(l);
        const float inv = 1.0f / l; for (int j = lane; j < NK; j += 64) S[w * SMP_SK + j] *= inv; }
    asm volatile("s_waitcnt lgkmcnt(0)" ::: "memory"); __syncthreads();
    { const int per = (NK + NWAVES - 1) / NWAVES, j0 = w * per, j1 = (j0 + per < NK) ? j0 + per : NK; float o[6] = {0.f, 0.f, 0.f, 0.f, 0.f, 0.f};
#pragma unroll 1
      for (int j = j0; j < j1; j += 8) { float vv[8];
#pragma unroll
          for (int u = 0; u < 8; ++u) { const int jj = (j + u < j1) ? j + u : j1 - 1; vv[u] = vf(jj)[lane]; }
#pragma unroll
          for (int u = 0; u < 8; ++u) if (j + u < j1) {
#pragma unroll
              for (int h = 0; h < 6; ++h) o[h] += S[h * SMP_SK + j + u] * vv[u]; } }
#pragma unroll
      for (int h = 0; h < 6; ++h) red[(w * 6 + h) * 64 + lane] = o[h]; }
    asm volatile("s_waitcnt lgkmcnt(0)" ::: "memory"); __syncthreads();
    outh[0] = 0.f;
    if (tid < 384) { float a = 0.f;
#pragma unroll
        for (int ww = 0; ww < NWAVES; ++ww) a += red[ww * 384 + tid]; outh[0] = a; }
    if (!keep_probs) { __syncthreads(); }
}
DI void nsa_sample_item(const FP& P, const Ctx& C, int ns, int kvh) {
    LAS float* qs = (LAS float*)C.lds; LAS float* S = qs + 384; LAS float* red = S + 6 * SMP_SK; LAS float* scs = red + 8 * 384; LAS int* sel = (LAS int*)(scs + 136);
    const int tid = C.tid, row = M0 + ns;
    if (tid < 384) qs[tid] = bf2f(P.QB[(size_t)row * NSA_Q_COLS + kvh * 384 + tid]);
    asm volatile("s_waitcnt lgkmcnt(0)" ::: "memory"); __syncthreads();
    const float* ckf = P.CKF + ((size_t)ns * NSA_KV_HEADS + kvh) * NCH * 64; const float* cvf = P.CVF + ((size_t)ns * NSA_KV_HEADS + kvh) * NCH * 64;
    float oc[1], os[1], ow[1];
    smp_branch(C, qs, S, red, NCMP, [&](int j) { return ckf + (size_t)j * 64; }, [&](int j) { return cvf + (size_t)j * 64; }, true, oc);
    constexpr int NBS = (PAST_LEN + 1 + SLC_BLOCK - 1) / SLC_BLOCK, CURS = PAST_LEN / SLC_BLOCK;
    for (int b = tid; b < 136; b += NTHREADS) { float sv = -3.0e38f;
        if (b < NBS) { if (b == 0 || b == CURS || b == CURS - 1) sv = FORCE_SCORE; else { float a = 0.f;
#pragma unroll
                for (int o = -1; o <= 3; ++o) { const int ci = 4 * b + o; if (ci >= 0 && ci < NCMP) { float sm = 0.f; for (int h6 = 0; h6 < 6; ++h6) sm += S[h6 * SMP_SK + ci]; a += ((o >= 0 && o <= 2) ? 2.f : 1.f) * sm; } }
                sv = a; } }
        scs[b] = sv; }
    asm volatile("s_waitcnt lgkmcnt(0)" ::: "memory"); __syncthreads();
    for (int b = tid; b < NBS; b += NTHREADS) { const float sv = scs[b]; int rank = 0; for (int j = 0; j < NBS; ++j) { const float o = scs[j]; rank += (o > sv || (o == sv && j < b)) ? 1 : 0; }
        if (rank < SLC_TOPK) { sel[rank] = b; P.SELB[((size_t)row * NSA_KV_HEADS + kvh) * 16 + rank] = b; } }
    asm volatile("s_waitcnt lgkmcnt(0)" ::: "memory"); __syncthreads();
    { const float* newrow = P.nsa_kv_s + (size_t)ns * 512; const int* pt = P.page_table + ns * (PAST_LEN / PAGE_SIZE);
      if (tid == 0) { int seen = 0; for (int x = 0; x < SLC_TOPK; ++x) { const int bx = sel[x]; if (bx != CURS && seen < 15) sel[16 + seen++] = bx; } }
      asm volatile("s_waitcnt lgkmcnt(0)" ::: "memory"); __syncthreads();
      auto krow = [&](int j, int ty) -> const float* { if (j >= 15 * 64) return newrow + ty * 128 + kvh * 64;
          const int t0 = sel[16 + (j >> 6)] * SLC_BLOCK + (j & 63); const int pg = pt[t0 / PAGE_SIZE]; return P.cache_nsa_kv + ((size_t)pg * PAGE_SIZE + t0 % PAGE_SIZE) * 512 + ty * 128 + kvh * 64; };
      smp_branch(C, qs, S, red, 15 * 64 + 1, [&](int j) { return krow(j, 2); }, [&](int j) { return krow(j, 3); }, false, os); }
    { const float* wc = P.cache_nsa_win + (size_t)ns * SWA_WINDOW * 256; const float* newrow = P.win_s + ((size_t)ns * SWA_WINDOW + SWA_WINDOW - 1) * 256;
      smp_branch(C, qs, S, red, SWA_WINDOW + 1, [&](int j) { return (j < SWA_WINDOW ? wc + (size_t)j * 256 : newrow) + kvh * 64; }, [&](int j) { return (j < SWA_WINDOW ? wc + (size_t)j * 256 : newrow) + 128 + kvh * 64; }, false, ow); }
    if (tid < 384) { const int head = kvh * NSA_GROUP + tid / 64; const float* gt = P.GATES + (size_t)row * 64 + head * 3;
        P.ATTB[(size_t)row * 1024 + kvh * 384 + tid] = (bf16)f2bf(gt[0] * oc[0] + gt[1] * os[0] + gt[2] * ow[0]);
#ifdef NSA_DEBUG
        P.DBG[((size_t)0 * MP + row) * 768 + kvh * 384 + tid] = oc[0]; P.DBG[((size_t)1 * MP + row) * 768 + kvh * 384 + tid] = os[0]; P.DBG[((size_t)2 * MP + row) * 768 + kvh * 384 + tid] = ow[0];
#endif
    }
    __syncthreads();
}
DI void nsa_pairs(const FP& P, const Ctx& C, bool second) {
    LAS unsigned char* wl = C.lds + C.wave * NSA_WLDS;
    const int per = C.G / 4 > 0 ? C.G / 4 : 1, grp = (C.vcu / per) & 3, sub = C.vcu % per, n = grp >> 1, kvh = grp & 1;
#pragma unroll 1
    for (int pr = sub * NWAVES + C.wave; pr < SEQ / 2; pr += per * NWAVES) { if (second) nsa_pair_b(P, n, kvh, 2 * pr, C.lane, wl); else nsa_pair_a(P, n, kvh, 2 * pr, C.lane, wl); }
}
DI void nsa_phase_a(const FP& P, const Ctx& C) {
    for (int it = C.vcu; it < DEC_BATCH * NSA_KV_HEADS; it += C.G) nsa_sample_item(P, C, it / NSA_KV_HEADS, it % NSA_KV_HEADS);
    nsa_pairs(P, C, false);
    __syncthreads();
}
DI void nsa_phase_b(const FP& P, const Ctx& C) {
    const int lane = C.lane, w = C.wave;
    nsa_pairs(P, C, true);
    __syncthreads();
    { constexpr int NMT = (M0 / 16) * MEM_HEADS;
      for (int it = C.vcu * NWAVES + w; it < NMT; it += C.G * NWAVES) { const int h = it % MEM_HEADS, q16 = it / MEM_HEADS, row0 = q16 * 16, n = row0 / SEQ;
          mem_micro(P, P.MQB + h * 64, 256, row0, 1, n, h, P.ATTB + NSA_Q_COLS + h * 64, 1024, lane); }
    }
    { LAS float* qs = (LAS float*)C.lds;
      for (int it = C.vcu; it < DEC_BATCH * MEM_HEADS; it += C.G) { const int h = it % MEM_HEADS, ns = it / MEM_HEADS, row = M0 + ns;
          __syncthreads(); if (C.tid < 64) qs[C.tid] = bf2f(P.MQB[(size_t)row * 256 + h * 64 + C.tid]); asm volatile("s_waitcnt lgkmcnt(0)" ::: "memory"); __syncthreads();
          Dec D; D.m = -INFINITY; D.l = 0.f; D.o = 0.f; const float* mk = P.cache_mem_kv + ((size_t)1 * DEC_BATCH + ns) * MEM_TOKENS * 512;
          for (int ck = w; ck < MEM_TOKENS / 64; ck += NWAVES) { const int j0 = ck * 64; dec_chunk(D, qs, 64, [&](int j) { return mk + (size_t)(j0 + j) * 512 + h * 64; }, [&](int j) { return mk + (size_t)(j0 + j) * 512 + 256 + h * 64; }, lane); }
          const float o = dec_combine(C, D);
          if (w == 0) P.ATTB[(size_t)row * 1024 + NSA_Q_COLS + h * 64 + lane] = (bf16)f2bf(o); } }
    __syncthreads();
}
}
namespace fx {
enum { PH_PRO = 0, PH_G1, PH_ATTA, PH_G2, PH_LN1, PH_SC0, PH_TK0, PH_PU0, PH_PG0, PH_G3, PH_CMPG, PH_CMP2, PH_NSA, PH_NSB, PH_G4, PH_LN3, PH_SC1, PH_TK1, PH_PU1, PH_PG1, PH_COUNT };
template <class Epi> DI void run_gemm(const Ctx& C, const bf16* A, const bf16* Bt, int M, int N, int K, const Epi& E) {
    pg8::Gemm g{A, Bt, M, N, K}; pg8::StaticOrder S; S.init(M, N, C.G, (int)blockIdx.x);
    pg8::gemm_phase<Epi, pg8::StaticOrder, true, true>(C.lds, g, S, E);
}
template <class Epi> DI void skinny_gemm(const Ctx& C, const bf16* A, const bf16* Bt, int N, int K, const Epi& E) {
    static_assert(DEC_BATCH == 32 && M0 % 256 == 0, "skinny_gemm: 32 sample rows right after a whole number of 256-row tiles");
    const int lane = C.lane, fr = lane & 15, fq = lane >> 4, w = C.wave; const int NI = (N / 256) * 4, KW = K / NWAVES;
    LAS f32x4* red = (LAS f32x4*)C.lds;
#pragma unroll 1
    for (int item = C.vcu; item < NI; item += C.G) { const int pn = item >> 2, wc = item & 3;
        f32x4 pa[2][2][2];
#pragma unroll
        for (int i = 0; i < 8; ++i) (&pa[0][0][0])[i] = (f32x4){0.f, 0.f, 0.f, 0.f};
        const bf16* xa = A + (size_t)(M0 + fr) * K + w * KW + 8 * fq; const bf16* xb = xa + (size_t)16 * K;
        const bf16* wp[2][2];
#pragma unroll
        for (int bj = 0; bj < 2; ++bj)
#pragma unroll
            for (int n = 0; n < 2; ++n) wp[bj][n] = Bt + (size_t)(pn * 256 + bj * 128 + wc * 32 + 8 * (fr >> 2) + 4 * n + (fr & 3)) * K + w * KW + 8 * fq;
#pragma unroll 4
        for (int k0 = 0; k0 < KW; k0 += 32) { const bf16x8 x0 = *(const bf16x8*)(xa + k0), x1 = *(const bf16x8*)(xb + k0);
#pragma unroll
            for (int bj = 0; bj < 2; ++bj)
#pragma unroll
                for (int n = 0; n < 2; ++n) { const bf16x8 wf = *(const bf16x8*)(wp[bj][n] + k0);
                    pa[bj][0][n] = __builtin_amdgcn_mfma_f32_16x16x32_bf16(wf, x0, pa[bj][0][n], 0, 0, 0); pa[bj][1][n] = __builtin_amdgcn_mfma_f32_16x16x32_bf16(wf, x1, pa[bj][1][n], 0, 0, 0); } }
        __syncthreads();
#pragma unroll
        for (int bj = 0; bj < 2; ++bj)
#pragma unroll
            for (int mm = 0; mm < 2; ++mm)
#pragma unroll
                for (int n = 0; n < 2; ++n) red[(w * 8 + bj * 4 + mm * 2 + n) * 64 + lane] = pa[bj][mm][n];
        asm volatile("s_waitcnt lgkmcnt(0)" ::: "memory"); __syncthreads();
        if (w == 0) { f32x4 acc[2][2][4][2];
#pragma unroll
            for (int i = 0; i < 32; ++i) (&acc[0][0][0][0])[i] = (f32x4){0.f, 0.f, 0.f, 0.f};
#pragma unroll
            for (int bj = 0; bj < 2; ++bj)
#pragma unroll
                for (int mm = 0; mm < 2; ++mm)
#pragma unroll
                    for (int n = 0; n < 2; ++n) { f32x4 s = red[(bj * 4 + mm * 2 + n) * 64 + lane];
#pragma unroll 1
                        for (int ww = 1; ww < NWAVES; ++ww) s += red[(ww * 8 + bj * 4 + mm * 2 + n) * 64 + lane];
                        acc[0][bj][mm][n] = s; }
            E(acc, pg8::Unit{M0 / 256, pn}, 0, wc, fr, fq); }
    }
    __syncthreads();
}
__global__ void __launch_bounds__(NTHREADS, 2) mega(Args args) {
    extern __shared__ __attribute__((aligned(16))) unsigned char lds_raw[];
    Ctx C; C.lds = (LAS unsigned char*)lds_raw; C.tid = threadIdx.x; C.lane = C.tid & 63; C.wave = __builtin_amdgcn_readfirstlane(C.tid >> 6);
    C.G = gridDim.x; { const int bx = blockIdx.x; C.vcu = (C.G % 8 == 0) ? (bx % 8) * (C.G / 8) + bx / 8 : bx; }
    const FP& P = args.p;
    volatile LAS unsigned* MISC = (volatile LAS unsigned*)(C.lds + MISC_OFF);
    for (int u = C.tid; u < (LDS_BYTES - RING_BYTES) / 4; u += NTHREADS) ((LAS unsigned*)(C.lds + RING_BYTES))[u] = 0u;
    __syncthreads();
    const int lo = args.lo, hi = args.hi;
    XcdBarrier bar; bar.bar = P.ctl + 1024; bar.x = 0; bar.st = nullptr;
    if (hi - lo > 1) bar = xcd_barrier_post(P.ctl + 1024, MISC + 8);
#define IN(k) (lo <= (k) && (k) < hi)
#define SEAM(k) do { if ((k) == PH_ATTA && IN(k)) bgq_drain(P, C, MISC + 12, BGQ_L_A);     \
        if ((k) == PH_TK0 && IN(k)) bgq_drain(P, C, MISC + 12, BGQ_L_UV); \
        if ((k) == PH_G3 && IN(k)) bgq_drain(P, C, MISC + 12, BGQ_L_AC); \
        if ((k) == PH_COUNT - 1 && IN(k)) bgq_drain(P, C, MISC + 12, BGQ_TOTAL); \
        if (IN(k) && IN((k) + 1)) xcd_barrier_bg(bar, P, C, MISC + 12); } while (0)
#ifndef DUP_PHASE
#define DUP_PHASE -1
#endif
#define PHASE(k, ...) do { if (IN(k)) { __VA_ARGS__ if (DUP_PHASE == (k)) { __syncthreads(); __VA_ARGS__ } } SEAM(k); } while (0)
    PHASE(PH_PRO, p0_prologue(P, C););
    PHASE(PH_G1, run_gemm(C, P.XB0, P.WA_T, M0, ACOLS, D_MODEL, EpiA{P}); run_gemm(C, P.MEMB, P.WMEM_T, BATCH * MEM_TOKENS, 1024, D_MODEL, EpiMem{P}); skinny_gemm(C, P.XB0, P.WA_T, ACOLS, D_MODEL, EpiA{P}););
#ifdef PEER_SHARD3
#define PEER_SHARDED_FN peer_sharded3_phase
#else
#define PEER_SHARDED_FN peer_sharded2_phase
#endif
#if defined(PEER_SOFTSYNC) && !defined(PEER_SHARD3)
#define PEER_HINT_ARGS , bar.st, bar.x
#else
#define PEER_HINT_ARGS
#endif
    PHASE(PH_ATTA, atta_phase(P, C););
    PHASE(PH_G2, run_gemm(C, P.ATTA, P.WOA_T, M0, D_MODEL, 512, EpiPre{P.x_prompt, P.x_sample, P.PRE}); skinny_gemm(C, P.ATTA, P.WOA_T, D_MODEL, 512, EpiPre{P.x_prompt, P.x_sample, P.PRE}););
    PHASE(PH_LN1, ln_phase(P, C, P.PRE, P.ln_g, P.ln_b, P.X1, P.X1B, nullptr, nullptr););
    PHASE(PH_SC0, run_gemm(C, P.X1B, P.WPK_T, M0, NPK, D_MODEL, EpiF32{P.SCO, NPK, MP}); skinny_gemm(C, P.X1B, P.WPK_T, NPK, D_MODEL, EpiF32{P.SCO, NPK, MP}););
    PHASE(PH_TK0, topk_phase(P, C););
#ifdef PEER_SPLIT
    PHASE(PH_PU0, peer_u_phase(P, C, 0, P.X1B););
    PHASE(PH_PG0, peer_v_phase(P, C, 0, P.X1, P.X2, P.X2 + (size_t)M0 * D_MODEL, P.X2B););
#elif defined(PEER_SHARD2)
    PHASE(PH_PG0, const bool shd = (M0 % (C.G * NWAVES * PS2_ROWS)) == 0; if (shd) { PEER_SHARDED_FN(P, C, 0, P.X1, P.X1B, P.X2, P.X2B PEER_HINT_ARGS); __syncthreads(); } peer_phase(P, C, 0, P.X1, P.X2, P.X2 + (size_t)M0 * D_MODEL, P.X2B, shd););
#elif defined(PEER_SHARD)
    PHASE(PH_PG0, peer_sharded_phase(P, C, 0, P.X1, P.X1B, P.X2, P.X2 + (size_t)M0 * D_MODEL, P.X2B); __syncthreads(); peer_phase(P, C, 0, P.X1, P.X2, P.X2 + (size_t)M0 * D_MODEL, P.X2B););
#else
    PHASE(PH_PG0, peer_phase(P, C, 0, P.X1, P.X2, P.X2 + (size_t)M0 * D_MODEL, P.X2B););
#endif
    PHASE(PH_G3, run_gemm(C, P.X2B, P.WB_T, M0, NB_T, D_MODEL, EpiB{P}); skinny_gemm(C, P.X2B, P.WB_T, NB_T, D_MODEL, EpiB{P}););
    PHASE(PH_CMPG, run_gemm(C, P.AC, P.CW1_T, ACROWS, 256, 1024, EpiF32{P.UL, 256, ACROWS}); run_gemm(C, P.AC + (size_t)ACROWS * 1024, P.CW1_T + 256 * 1024, ACROWS, 256, 1024, EpiF32{P.UL + (size_t)ACROWS * 256, 256, ACROWS}););
    PHASE(PH_CMP2, cmp2_phase(P, C););
    PHASE(PH_NSA, nsa_phase_a(P, C););
    PHASE(PH_NSB, nsa_phase_b(P, C););
    PHASE(PH_G4, run_gemm(C, P.ATTB, P.WOB_T, M0, D_MODEL, 1024, EpiPre{P.X2, nullptr, P.PRE}); skinny_gemm(C, P.ATTB, P.WOB_T, D_MODEL, 1024, EpiPre{P.X2, nullptr, P.PRE}););
    PHASE(PH_LN3, ln_phase(P, C, P.PRE, P.ln_g + 2 * D_MODEL, P.ln_b + 2 * D_MODEL, P.X3, P.X3B, nullptr, nullptr););
    PHASE(PH_SC1, run_gemm(C, P.X3B, P.WPK_T + (size_t)NPK * D_MODEL, M0, NPK, D_MODEL, EpiF32{P.SCO, NPK, MP}); skinny_gemm(C, P.X3B, P.WPK_T + (size_t)NPK * D_MODEL, NPK, D_MODEL, EpiF32{P.SCO, NPK, MP}););
    PHASE(PH_TK1, topk_phase(P, C););
#ifdef PEER_SPLIT
    PHASE(PH_PU1, peer_u_phase(P, C, 1, P.X3B););
    PHASE(PH_PG1, peer_v_phase(P, C, 1, P.X3, P.y_prompt, P.y_sample, nullptr););
#elif defined(PEER_SHARD2)
    PHASE(PH_PG1, const bool shd = (M0 % (C.G * NWAVES * PS2_ROWS)) == 0; if (shd) { PEER_SHARDED_FN(P, C, 1, P.X3, P.X3B, P.y_prompt, nullptr PEER_HINT_ARGS); __syncthreads(); } peer_phase(P, C, 1, P.X3, P.y_prompt, P.y_sample, nullptr, shd););
#elif defined(PEER_SHARD)
    PHASE(PH_PG1, peer_sharded_phase(P, C, 1, P.X3, P.X3B, P.y_prompt, P.y_sample, nullptr); __syncthreads(); peer_phase(P, C, 1, P.X3, P.y_prompt, P.y_sample, nullptr););
#else
    PHASE(PH_PG1, peer_phase(P, C, 1, P.X3, P.y_prompt, P.y_sample, nullptr););
#endif
#undef IN
#undef SEAM
}
}
#ifndef ONE_LAUNCH
#define ONE_LAUNCH 1
#endif
extern "C" void kernel_launch(void* const* d_in, const int* in_sizes, int n_in, void* d_out, int out_size, void* d_ws, size_t ws_size, hipStream_t stream) {
    fx::Args a; memset(&a, 0, sizeof(a)); fx::bind_io(a.p, d_in, (float*)d_out);
    const size_t f_need = fx::carve(a.p, d_ws);
    if (f_need > ws_size) { fprintf(stderr, "kernel_launch: workspace too small: need %zu have %zu\n", f_need, ws_size); return; }
    static int grid = 0;
    if (!grid) { int dev = 0, cus = 0, per_cu = 0; (void)hipGetDevice(&dev); (void)hipDeviceGetAttribute(&cus, hipDeviceAttributeMultiprocessorCount, dev);
        (void)hipFuncSetAttribute((const void*)fx::mega, hipFuncAttributeMaxDynamicSharedMemorySize, fx::LDS_BYTES);
        if (hipOccupancyMaxActiveBlocksPerMultiprocessor(&per_cu, (const void*)fx::mega, fx::NTHREADS, fx::LDS_BYTES) != hipSuccess || per_cu < 1) { fprintf(stderr, "kernel_launch: occupancy query says %d blocks per CU\n", per_cu); (void)hipGetLastError(); }
        grid = cus; }
    (void)hipMemsetAsync(a.p.ctl, 0, fx::CTL_BYTES, stream);
#if ONE_LAUNCH
    a.lo = 0; a.hi = fx::PH_COUNT; hipLaunchKernelGGL(fx::mega, dim3(grid), dim3(fx::NTHREADS), fx::LDS_BYTES, stream, a);
#else
    for (int k = 0; k < fx::PH_COUNT; ++k) { a.lo = k; a.hi = k + 1; hipLaunchKernelGGL(fx::mega, dim3(grid), dim3(fx::NTHREADS), fx::LDS_BYTES, stream, a); }
#endif
}
```

```cpp
#define PEER_SHARD2 1
#define ONE_LAUNCH 1
#include <hip/hip_runtime.h>
#include <cstdio>
#include <cstring>
#include <cmath>
#ifdef CPU_TEST
#define HD inline
constexpr int D_MODEL = 128, BATCH = 2, SEQ = 512, DEPTH = 2, DEC_BATCH = 3, DEC_SEQ = 1, PAST_LEN = 512, PAGE_SIZE = 128;
constexpr int DIL_W[3] = {16, 64, 256}, DIL_D[3] = {1, 4, 16}, DIL_TAPS = 17;
constexpr int MEM_TOKENS = 32, SLC_TOPK = 4, SWA_WINDOW = 64, PEER_KEYS = 16, PEER_TOPK = 4;
#else
#define HD __host__ __device__ __forceinline__
constexpr int D_MODEL = 1024, BATCH = 2, SEQ = 8192, DEPTH = 2, DEC_BATCH = 32, DEC_SEQ = 1, PAST_LEN = 8192, PAGE_SIZE = 128;
constexpr int DIL_W[3] = {128, 512, 2048}, DIL_D[3] = {1, 4, 16}, DIL_TAPS = 129;
constexpr int MEM_TOKENS = 256, SLC_TOPK = 16, SWA_WINDOW = 512, PEER_KEYS = 128, PEER_TOPK = 16;
#endif
HD constexpr int dil_w(int g) { return g == 0 ? DIL_W[0] : (g == 1 ? DIL_W[1] : DIL_W[2]); }
HD constexpr int dil_d(int g) { return g == 0 ? DIL_D[0] : (g == 1 ? DIL_D[1] : DIL_D[2]); }
constexpr int HEAD_DIM = 64, N_A_LAYERS = DEPTH / 2, N_DIL = 3, DIL_HEADS = 4, DIL_COLS = N_DIL * 3 * DIL_HEADS * HEAD_DIM;
constexpr int MEM_HEADS = 4, MEM_COLS = MEM_HEADS * HEAD_DIM;
constexpr int NSA_HEADS = 12, NSA_KV_HEADS = 2, NSA_GROUP = 6, NSA_Q_COLS = NSA_HEADS * HEAD_DIM, NSA_GATE_COLS = NSA_HEADS * 3;
constexpr int CMP_BLOCK = 32, CMP_STRIDE = 16, CMP_HIDDEN = 128, SLC_BLOCK = 64;
constexpr int PEER_EXPERTS = PEER_KEYS * PEER_KEYS, PEER_HEADS = 8, PEER_KEY_DIM = 128;
constexpr float FORCE_SCORE = 1.0e9f, NEG = -1.0e30f, SCALE = 0.125f, LN_EPS = 1e-5f;
constexpr float ALPHA = 1.41421356237309515f;
constexpr float BETA = 0.5f;
#define LAS __attribute__((address_space(3)))
namespace pg8 {
#define PG8_LAS __attribute__((address_space(3)))
typedef unsigned short bf16_t;
typedef short bf16x8 __attribute__((ext_vector_type(8)));
typedef float f32x4 __attribute__((ext_vector_type(4)));
typedef unsigned u32x4 __attribute__((ext_vector_type(4)));
constexpr int BM = 256, BK = 64, HALF = 128, HTB = HALF * BK * 2  , STAGE_BYTES = 8 * HTB, NXCD = 8, WGM = 8;

__host__ __device__ __forceinline__ int lds_byte(int r, int c) { const int st = (r >> 4) * 2 + (c >> 5), rr = r & 15, cc = c & 31, ob = rr * 64 + cc * 2; return st * 1024 + (ob ^ (((ob >> 9) & 1) << 5)); }
__host__ __device__ __forceinline__ void stage_rc(int b, int& R, int& C) { const int st = b / 1024, sb = b % 1024, swz = sb ^ (((sb >> 9) & 1) << 5); R = (st >> 1) * 16 + swz / 64; C = (st & 1) * 32 + (swz % 64) / 2; }
__host__ __device__ __forceinline__ int perm32(int rho) { const int n = rho >> 4, i = rho & 15; return 8 * (i >> 2) + 4 * n + (i & 3); }

struct Unit { int pm, pn; };
struct Gemm { const bf16_t* A; const bf16_t* Bt; int M, N, K; };

struct StaticOrder {
    int nM, nN, nwg, G, c;
    __host__ __device__ void init(int M, int N, int G_, int c_) { nM = M / BM; nN = N / BM; nwg = nM * nN; G = G_; c = c_; }
    __host__ __device__ bool next(int i, Unit& u) const {
        const long L = (long)i * G + c; if (L >= nwg) return false;
        int wgid = (int)L; { const int q = nwg / NXCD, r = nwg % NXCD, xcd = wgid % NXCD, off = wgid / NXCD; wgid = (xcd < r ? xcd * (q + 1) : r * (q + 1) + (xcd - r) * q) + off; }
        const int nig = WGM * nN, gid = wgid / nig, fm = gid * WGM, gsz = (nM - fm) < WGM ? (nM - fm) : WGM;
        u.pm = fm + ((wgid % nig) % gsz); u.pn = (wgid % nig) / gsz; return true;
    }
    __device__ __forceinline__ void a_ready(const Unit&) const {}
    __device__ __forceinline__ void done(const Unit&) const {}
};

__device__ __forceinline__ unsigned cvt_pk_bf16(float lo, float hi) { unsigned r; asm volatile("v_cvt_pk_bf16_f32 %0, %1, %2" : "=v"(r) : "v"(lo), "v"(hi)); return r; }
typedef float f32x2 __attribute__((ext_vector_type(2)));
typedef float f32x2 __attribute__((ext_vector_type(2)));
template <class Epi, class Sched, bool ALIGN_EPI = false, bool SP2 = false>
__device__ __forceinline__ void gemm_phase(PG8_LAS unsigned char* lds, const Gemm g, const Sched& S, const Epi& E) {
    const int tid = threadIdx.x, wid = __builtin_amdgcn_readfirstlane(tid >> 6), lane = tid & 63, wr = wid >> 2, wc = wid & 3, fr = lane & 15, fq = lane >> 4;
    const int K = g.K, nt = K / BK;
    unsigned voffA[2], voffB[2];
#pragma unroll
    for (int i = 0; i < 2; ++i) { int R, C; stage_rc(tid * 16 + i * 8192, R, C); const int Rb = Epi::PERM ? ((R & ~31) + perm32(R & 31)) : R;
        voffA[i] = (unsigned)(R * K + C) * 2u; voffB[i] = (unsigned)(Rb * K + C) * 2u; }
    const size_t kstep = (size_t)(BK * 2);
    const size_t hstep = (size_t)HALF * K * 2;
    const size_t tstep = 2 * hstep;
    const unsigned ldsw = (unsigned)wid * 1024u;
    const int aoff = lds_byte(wr * 64 + fr, fq * 8), boff = lds_byte(wc * 32 + fr, fq * 8);
#define PG8_SA(b, h) (((b) * 2 + (h)) * HTB)
#define PG8_SB(b, h) ((4 + (b) * 2 + (h)) * HTB)
#define PG8_STAGE(bufoff, gbase, voff) do { _Pragma("unroll") for (int _i = 0; _i < 2; ++_i) \
        __builtin_amdgcn_global_load_lds((const unsigned*)((const char*)(gbase) + (voff)[_i]), (PG8_LAS unsigned*)(lds + (bufoff) + ldsw + _i * 8192), 16, 0, 0); } while (0)
#define PG8_LDA(dst, b, h) do { _Pragma("unroll") for (int m = 0; m < 4; ++m) _Pragma("unroll") for (int k = 0; k < 2; ++k) dst[m][k] = *(const PG8_LAS bf16x8*)(lds + PG8_SA(b, h) + aoff + m * 2048 + k * 1024); } while (0)
#define PG8_LDB(dst, b, h) do { _Pragma("unroll") for (int n = 0; n < 2; ++n) _Pragma("unroll") for (int k = 0; k < 2; ++k) dst[n][k] = *(const PG8_LAS bf16x8*)(lds + PG8_SB(b, h) + boff + n * 2048 + k * 1024); } while (0)
#define PG8_MMA(ai, bj, At, Bt) do { __builtin_amdgcn_s_setprio(1); _Pragma("unroll") for (int m = 0; m < 4; ++m) _Pragma("unroll") for (int n = 0; n < 2; ++n) _Pragma("unroll") for (int k = 0; k < 2; ++k) \
        acc[ai][bj][m][n] = __builtin_amdgcn_mfma_f32_16x16x32_bf16(Bt[n][k], At[m][k], acc[ai][bj][m][n], 0, 0, 0); __builtin_amdgcn_s_setprio(0); } while (0)
#define PG8_WAIT_V(n) asm volatile("s_waitcnt vmcnt(" #n ")" ::: "memory")
#define PG8_WAIT_L(n) asm volatile("s_waitcnt lgkmcnt(" #n ")" ::: "memory")
#define PG8_BAR __builtin_amdgcn_s_barrier()
#define PG8_SCHED __builtin_amdgcn_sched_barrier(0)
    Unit cur, nxt; int ui = 0;
    if (!S.next(0, cur)) return;
    f32x4 acc[2][2][4][2];
#pragma unroll
    for (int a = 0; a < 2; ++a)
#pragma unroll
        for (int b = 0; b < 2; ++b)
#pragma unroll
            for (int m = 0; m < 4; ++m)
#pragma unroll
                for (int n = 0; n < 2; ++n) acc[a][b][m][n] = (f32x4){0.f, 0.f, 0.f, 0.f};
    bf16x8 At[4][2], B0[2][2], B1[2][2];
    const char* cA = (const char*)g.A + (size_t)cur.pm * tstep; const char* cB = (const char*)g.Bt + (size_t)cur.pn * tstep;
    S.a_ready(cur);
    if constexpr (SP2) {
        PG8_STAGE(PG8_SB(0, 0), cB, voffB); PG8_STAGE(PG8_SB(0, 1), cB + hstep, voffB); PG8_STAGE(PG8_SA(0, 0), cA, voffA); PG8_STAGE(PG8_SA(0, 1), cA + hstep, voffA);
        if (wr == 1) PG8_BAR;
        PG8_WAIT_V(2); PG8_BAR;
        PG8_STAGE(PG8_SB(1, 0), cB + kstep, voffB); PG8_STAGE(PG8_SA(1, 0), cA + kstep, voffA); PG8_STAGE(PG8_SB(1, 1), cB + hstep + kstep, voffB);
        PG8_WAIT_V(6); PG8_BAR;
    } else {
        PG8_STAGE(PG8_SB(0, 0), cB, voffB); PG8_STAGE(PG8_SA(0, 0), cA, voffA); PG8_STAGE(PG8_SB(0, 1), cB + hstep, voffB); PG8_STAGE(PG8_SA(0, 1), cA + hstep, voffA);
        if (wr == 1) PG8_BAR;
        PG8_WAIT_V(4); PG8_BAR;
        PG8_STAGE(PG8_SB(1, 0), cB + kstep, voffB); PG8_STAGE(PG8_SA(1, 0), cA + kstep, voffA); PG8_STAGE(PG8_SB(1, 1), cB + hstep + kstep, voffB);
        PG8_WAIT_V(6); PG8_BAR;
    }
    for (;;) {
        const bool has_next = S.next(ui + 1, nxt);
        const char* nA = has_next ? (const char*)g.A + (size_t)nxt.pm * tstep : cA; const char* nB = has_next ? (const char*)g.Bt + (size_t)nxt.pn * tstep : cB;
        for (int t = 0; t < nt; t += 2) {
            const bool last = (t == nt - 2);
            const char* a1 = cA + (size_t)(t + 1) * kstep;
            const char* a2 = last ? nA : cA + (size_t)(t + 2) * kstep; const char* b2 = last ? nB : cB + (size_t)(t + 2) * kstep;
            const char* a3 = a2 + kstep; const char* b3 = b2 + kstep;
            if (last && has_next) S.a_ready(nxt);
            if constexpr (SP2) {
            PG8_LDB(B0, 0, 0); PG8_LDB(B1, 0, 1); PG8_SCHED; PG8_LDA(At, 0, 0); PG8_STAGE(PG8_SA(1, 1), a1 + hstep, voffA);
            PG8_WAIT_V(8); PG8_WAIT_L(0); PG8_BAR; PG8_MMA(0, 0, At, B0); PG8_MMA(0, 1, At, B1); PG8_BAR; PG8_SCHED;
            PG8_LDA(At, 0, 1); PG8_STAGE(PG8_SB(0, 0), b2, voffB); PG8_STAGE(PG8_SB(0, 1), b2 + hstep, voffB); PG8_STAGE(PG8_SA(0, 0), a2, voffA);
            PG8_WAIT_V(8); PG8_WAIT_L(0); PG8_BAR; PG8_MMA(1, 0, At, B0); PG8_MMA(1, 1, At, B1); PG8_BAR; PG8_SCHED;
            PG8_LDB(B0, 1, 0); PG8_LDB(B1, 1, 1); PG8_SCHED; PG8_LDA(At, 1, 0); PG8_STAGE(PG8_SA(0, 1), a2 + hstep, voffA);
            PG8_WAIT_V(8); PG8_WAIT_L(0); PG8_BAR; PG8_MMA(0, 0, At, B0); PG8_MMA(0, 1, At, B1); PG8_BAR; PG8_SCHED;
            PG8_LDA(At, 1, 1); PG8_STAGE(PG8_SB(1, 0), b3, voffB); PG8_STAGE(PG8_SB(1, 1), b3 + hstep, voffB); PG8_STAGE(PG8_SA(1, 0), a3, voffA);
            PG8_WAIT_V(8); PG8_WAIT_L(0); PG8_BAR; PG8_MMA(1, 0, At, B0); PG8_MMA(1, 1, At, B1); PG8_BAR; PG8_SCHED;
            } else {
            PG8_LDB(B0, 0, 0); PG8_SCHED; PG8_LDA(At, 0, 0); PG8_STAGE(PG8_SA(1, 1), a1 + hstep, voffA);
            PG8_WAIT_L(8); PG8_BAR; PG8_WAIT_L(0); PG8_MMA(0, 0, At, B0); PG8_BAR; PG8_SCHED;
            PG8_LDB(B1, 0, 1); PG8_STAGE(PG8_SB(0, 0), b2, voffB);
            PG8_BAR; PG8_WAIT_L(0); PG8_MMA(0, 1, At, B1); PG8_BAR;
            PG8_LDA(At, 0, 1); PG8_STAGE(PG8_SA(0, 0), a2, voffA);
            PG8_BAR; PG8_WAIT_L(0); PG8_MMA(1, 0, At, B0); PG8_BAR; PG8_SCHED;
            PG8_STAGE(PG8_SB(0, 1), b2 + hstep, voffB);
            PG8_WAIT_V(6); PG8_BAR; PG8_MMA(1, 1, At, B1); PG8_BAR;
            PG8_LDB(B0, 1, 0); PG8_SCHED; PG8_LDA(At, 1, 0); PG8_STAGE(PG8_SA(0, 1), a2 + hstep, voffA);
            PG8_WAIT_L(8); PG8_BAR; PG8_WAIT_L(0); PG8_MMA(0, 0, At, B0); PG8_BAR; PG8_SCHED;
            PG8_LDB(B1, 1, 1); PG8_STAGE(PG8_SB(1, 0), b3, voffB);
            PG8_BAR; PG8_WAIT_L(0); PG8_MMA(0, 1, At, B1); PG8_BAR;
            PG8_LDA(At, 1, 1); PG8_STAGE(PG8_SA(1, 0), a3, voffA);
            PG8_BAR; PG8_WAIT_L(0); PG8_MMA(1, 0, At, B0); PG8_BAR; PG8_SCHED;
            PG8_STAGE(PG8_SB(1, 1), b3 + hstep, voffB);
            PG8_WAIT_V(6); PG8_BAR; PG8_MMA(1, 1, At, B1); PG8_BAR;
            }
        }
        if constexpr (ALIGN_EPI) { if (wr == 0) PG8_BAR; }
        if constexpr (!Epi::AFTER_DRAIN) { E(acc, cur, wr, wc, fr, fq); S.done(cur); }
        if (!has_next) break;
#pragma unroll
        for (int a = 0; a < 2; ++a)
#pragma unroll
            for (int b = 0; b < 2; ++b)
#pragma unroll
                for (int m = 0; m < 4; ++m)
#pragma unroll
                    for (int n = 0; n < 2; ++n) acc[a][b][m][n] = (f32x4){0.f, 0.f, 0.f, 0.f};
        cur = nxt; cA = nA; cB = nB; ++ui;
        if constexpr (ALIGN_EPI) { if (wr == 1) PG8_BAR; }
    }
    PG8_WAIT_V(0);
    if constexpr (!ALIGN_EPI) { if (wr == 0) PG8_BAR; }
    PG8_BAR;
    if constexpr (Epi::AFTER_DRAIN) { E.fused(acc, cur, wr, wc, fr, fq, lds, wid, lane); S.done(cur); }
#undef PG8_SA
#undef PG8_SB
#undef PG8_STAGE
#undef PG8_LDA
#undef PG8_LDB
#undef PG8_MMA
#undef PG8_WAIT_V
#undef PG8_WAIT_L
#undef PG8_BAR
#undef PG8_SCHED
}
}
#define XB_TMO      128
#define XB_XCNT(j)  (256  + 64 * (j))
#define XB_XSUB(j)  (1280 + 64 * (j))
#define XB_XGEN(j)  (2304 + 64 * (j))
#define XB_TOP      3328
#define XB_TOPGEN   3392
#define XCD_BAR_WORDS 3456
#define XB_SPIN_CAP (1u << 18)

__device__ __forceinline__ unsigned xb_ld(unsigned* p)              { return __hip_atomic_load(p, __ATOMIC_RELAXED, __HIP_MEMORY_SCOPE_AGENT); }
__device__ __forceinline__ unsigned xb_add(unsigned* p, unsigned v) { return __hip_atomic_fetch_add(p, v, __ATOMIC_RELAXED, __HIP_MEMORY_SCOPE_AGENT); }
__device__ __forceinline__ unsigned xb_xcc_id() { return (unsigned)__builtin_amdgcn_s_getreg((3 << 11) | 20) & 0xFu; }
#define XB_SPIN(cond, bar) do { unsigned _sp = 0; while (cond) { __builtin_amdgcn_s_sleep(1); \
    if ((++_sp & 255u) == 0u) { if (xb_ld(&(bar)[XB_TMO])) break; if (_sp > XB_SPIN_CAP) { atomicAdd(&(bar)[XB_TMO], 1u); break; } } } } while (0)

struct XcdBarrier {
    unsigned* bar; unsigned x;
    volatile LAS unsigned* st;
};

__device__ __forceinline__ XcdBarrier xcd_barrier_post(unsigned* bar, volatile LAS unsigned* st) {
    XcdBarrier b; b.bar = bar; b.x = xb_xcc_id(); b.st = st;
    if (threadIdx.x == 0) (void)xb_add(&bar[XB_XCNT(b.x)], 1u);
    return b;
}
__device__ __forceinline__ void xcd_barrier_complete(unsigned* bar, unsigned x, unsigned& nloc, unsigned& nx) {
    const unsigned G = gridDim.x * gridDim.y * gridDim.z;
    unsigned sum, cnt, mine, sp = 0u;
    for (;;) {
        sum = 0u; cnt = 0u; mine = 0u;
#pragma unroll
        for (unsigned j = 0; j < 16; ++j) { const unsigned c = xb_ld(&bar[XB_XCNT(j)]); sum += c; cnt += (c > 0u) ? 1u : 0u; mine = (j == x) ? c : mine; }
        if (sum == G) break;
        __builtin_amdgcn_s_sleep(1);
        if ((++sp & 255u) == 0u) { if (xb_ld(&bar[XB_TMO])) break; if (sp > XB_SPIN_CAP) { atomicAdd(&bar[XB_TMO], 1u); break; } }
    }
    nloc = mine > 0u ? mine : 1u; nx = cnt > 0u ? cnt : 1u;
}

__device__ __forceinline__ void xcd_barrier(const XcdBarrier& b) {
    asm volatile("s_waitcnt vmcnt(0)" ::: "memory");
    __syncthreads();
    if (threadIdx.x == 0) {
        unsigned* bar = b.bar;
        __builtin_amdgcn_s_waitcnt(0);
        unsigned nloc = b.st[0], nx = b.st[1];
        if (nloc == 0u) { xcd_barrier_complete(bar, b.x, nloc, nx); b.st[0] = nloc; b.st[1] = nx; }
        const unsigned old = xb_add(&bar[XB_XSUB(b.x)], 1u);
        const unsigned gen = old / nloc;
        if (old + 1u == (gen + 1u) * nloc) {
            __builtin_amdgcn_fence(__ATOMIC_RELEASE, "agent");
            asm volatile("s_waitcnt vmcnt(0)" ::: "memory");
            const unsigned og = xb_add(&bar[XB_TOP], 1u);
            const unsigned tg = og / nx;
            if (og + 1u == (tg + 1u) * nx) xb_add(&bar[XB_TOPGEN], 1u);
            else XB_SPIN(xb_ld(&bar[XB_TOPGEN]) == tg, bar);
            __builtin_amdgcn_fence(__ATOMIC_ACQUIRE, "agent");
            xb_add(&bar[XB_XGEN(b.x)], 1u);
            asm volatile("s_waitcnt vmcnt(0)" ::: "memory");
        } else {
            XB_SPIN(xb_ld(&bar[XB_XGEN(b.x)]) == gen, bar);
            __builtin_amdgcn_fence(__ATOMIC_ACQUIRE, "agent");
            asm volatile("s_waitcnt vmcnt(0)" ::: "memory");
        }
    }
    __syncthreads();
}
namespace fx {
#define DI __device__ __forceinline__
typedef unsigned short bf16;
typedef short bf16x8 __attribute__((ext_vector_type(8)));
typedef float f32x4 __attribute__((ext_vector_type(4)));
typedef float f32x2 __attribute__((ext_vector_type(2)));
typedef unsigned u32x4 __attribute__((ext_vector_type(4)));
typedef unsigned u32x2 __attribute__((ext_vector_type(2)));
constexpr int M0 = BATCH * SEQ, MP = M0 + DEC_BATCH, MPAD = ((MP + 255) / 256) * 256;
constexpr int ACOLS = DIL_COLS + MEM_COLS, BCOLS = NSA_Q_COLS + NSA_GATE_COLS + MEM_COLS, KVCOLS = 6 * NSA_KV_HEADS * HEAD_DIM;
constexpr int NB_T = 2048;
constexpr int NPK = PEER_HEADS * 2 * PEER_KEYS;
constexpr int NCMP = (SEQ - CMP_BLOCK) / CMP_STRIDE + 1;
constexpr int NCH = SEQ / CMP_STRIDE;
constexpr int NCTX = BATCH + DEC_BATCH;
constexpr int ACROWS = NCTX * NSA_KV_HEADS * NCH;
constexpr int NPOS = PAST_LEN + 1;
constexpr float QSCALE = 0.125f * 1.4426950408889634f;
constexpr int NTHREADS = 512, NWAVES = 8, LDS_BYTES = 147456, RING_BYTES = 131072, MISC_OFF = RING_BYTES + 320;

struct FP {
    const float *x_prompt, *x_sample, *mem_prompt, *cache_dil[3], *cache_nsa_kv, *cache_nsa_win, *cache_mem_kv; const int* page_table;
    const float *w_in_a, *w_out_a, *w_in_b, *w_out_b, *w_mem_kv, *w_kv_b, *cmp_pe, *cmp_w1, *cmp_w2, *ln_g, *ln_b, *peer_wq, *peer_keys, *peer_u, *peer_v;
    float *y_prompt, *y_sample, *dil_p[3], *dil_s[3], *nsa_kv_p, *nsa_kv_s, *win_p, *win_s, *mem_kv_p;
    unsigned* ctl;
    bf16 *XB0, *X1B, *X2B, *X3B, *WA_T, *WMEM_T, *MEMB, *WOA_T, *WOB_T, *WPK_T, *WB_T, *CW1_T, *AC; unsigned char *UB8, *VB8;
    float *ROPE, *CBIAS;
    bf16 *QA, *KA, *VTA, *MQA, *MK, *MVT, *ATTA;
    float *DPART, *DML, *PRE, *X1, *X2, *X3, *SCO, *SELG; int* SELE;
    bf16 *SLK, *SLVT, *WNK, *WNVT, *QB, *MQB, *CK, *CVT, *ATTB;
    float *GATES, *UL, *CKF, *CVF;
    int* SELB;
    float* DBG;
};
struct Args { FP p; int lo, hi; };
struct Carve { size_t off = 0; template <class T> T* take(void* base, size_t n) { T* r = (T*)((char*)base + off); off += ((n * sizeof(T) + 255) / 256) * 256; return r; } };
constexpr size_t CTL_BYTES = 65536;
inline size_t carve(FP& p, void* base) {
    Carve c;
    p.ctl = c.take<unsigned>(base, CTL_BYTES / 4);
    p.XB0 = c.take<bf16>(base, (size_t)MPAD * D_MODEL); p.X1B = c.take<bf16>(base, (size_t)MPAD * D_MODEL); p.X2B = c.take<bf16>(base, (size_t)MPAD * D_MODEL); p.X3B = c.take<bf16>(base, (size_t)MPAD * D_MODEL);
    p.WA_T = c.take<bf16>(base, (size_t)ACOLS * D_MODEL); p.WMEM_T = c.take<bf16>(base, (size_t)DEPTH * 2 * MEM_COLS * D_MODEL); p.MEMB = c.take<bf16>(base, (size_t)BATCH * MEM_TOKENS * D_MODEL);
    p.WOA_T = c.take<bf16>(base, (size_t)D_MODEL * 2 * MEM_COLS); p.WOB_T = c.take<bf16>(base, (size_t)D_MODEL * (NSA_Q_COLS + MEM_COLS));
    p.WPK_T = c.take<bf16>(base, (size_t)DEPTH * NPK * D_MODEL); p.WB_T = c.take<bf16>(base, (size_t)NB_T * D_MODEL);
    p.UB8 = c.take<unsigned char>(base, (size_t)DEPTH * PEER_EXPERTS * D_MODEL); p.VB8 = c.take<unsigned char>(base, (size_t)DEPTH * PEER_EXPERTS * D_MODEL);
    p.CW1_T = c.take<bf16>(base, (size_t)2 * 256 * 1024); p.AC = c.take<bf16>(base, (size_t)2 * ACROWS * 1024);
    p.ROPE = c.take<float>(base, (size_t)NPOS * 64); p.CBIAS = c.take<float>(base, 2 * CMP_HIDDEN);
    p.QA = c.take<bf16>(base, (size_t)3 * MPAD * 256); p.KA = c.take<bf16>(base, (size_t)3 * MPAD * 256); p.VTA = c.take<bf16>(base, (size_t)3 * BATCH * DIL_HEADS * HEAD_DIM * SEQ + 4096);
    p.MQA = c.take<bf16>(base, (size_t)MPAD * 256); p.MK = c.take<bf16>(base, (size_t)DEPTH * BATCH * MEM_TOKENS * MEM_COLS); p.MVT = c.take<bf16>(base, (size_t)DEPTH * BATCH * MEM_COLS * MEM_TOKENS);
    p.ATTA = c.take<bf16>(base, (size_t)MPAD * 2 * MEM_COLS);
    p.DPART = c.take<float>(base, (size_t)3 * MP * DIL_HEADS * HEAD_DIM); p.DML = c.take<float>(base, (size_t)3 * MP * DIL_HEADS * 2);
    p.PRE = c.take<float>(base, (size_t)MPAD * D_MODEL); p.X1 = c.take<float>(base, (size_t)MPAD * D_MODEL); p.X2 = c.take<float>(base, (size_t)MPAD * D_MODEL); p.X3 = c.take<float>(base, (size_t)MPAD * D_MODEL);
    p.SCO = c.take<float>(base, (size_t)MPAD * NPK); p.SELG = c.take<float>(base, (size_t)MP * 128); p.SELE = c.take<int>(base, (size_t)MP * 128);
    p.SLK = c.take<bf16>(base, (size_t)BATCH * NSA_KV_HEADS * SEQ * HEAD_DIM); p.SLVT = c.take<bf16>(base, (size_t)BATCH * NSA_KV_HEADS * SEQ * HEAD_DIM);
    p.WNK = c.take<bf16>(base, (size_t)BATCH * NSA_KV_HEADS * SEQ * HEAD_DIM + 4096); p.WNVT = c.take<bf16>(base, (size_t)BATCH * NSA_KV_HEADS * SEQ * HEAD_DIM + 4096);
    p.QB = c.take<bf16>(base, (size_t)MPAD * NSA_Q_COLS); p.MQB = c.take<bf16>(base, (size_t)MPAD * 256);
    p.CK = c.take<bf16>(base, (size_t)NCTX * NSA_KV_HEADS * NCH * HEAD_DIM); p.CVT = c.take<bf16>(base, (size_t)NCTX * NSA_KV_HEADS * HEAD_DIM * NCH); p.ATTB = c.take<bf16>(base, (size_t)MPAD * (NSA_Q_COLS + MEM_COLS));
    p.GATES = c.take<float>(base, (size_t)MPAD * 64); p.UL = c.take<float>(base, (size_t)2 * ACROWS * 256);
    p.CKF = c.take<float>(base, (size_t)DEC_BATCH * NSA_KV_HEADS * NCH * HEAD_DIM); p.CVF = c.take<float>(base, (size_t)DEC_BATCH * NSA_KV_HEADS * NCH * HEAD_DIM);
    p.SELB = c.take<int>(base, (size_t)MP * NSA_KV_HEADS * 16);
#ifdef NSA_DEBUG
    p.DBG = c.take<float>(base, (size_t)3 * MP * 768);
#else
    p.DBG = nullptr;
#endif
    return c.off;
}
inline void bind_io(FP& p, void* const* d_in, float* out) {
    p.x_prompt = (const float*)d_in[0]; p.x_sample = (const float*)d_in[1]; p.mem_prompt = (const float*)d_in[2]; p.cache_dil[0] = (const float*)d_in[3]; p.cache_dil[1] = (const float*)d_in[4]; p.cache_dil[2] = (const float*)d_in[5];
    p.cache_nsa_kv = (const float*)d_in[6]; p.cache_nsa_win = (const float*)d_in[7]; p.cache_mem_kv = (const float*)d_in[8]; p.page_table = (const int*)d_in[9];
    p.w_in_a = (const float*)d_in[10]; p.w_out_a = (const float*)d_in[11]; p.w_in_b = (const float*)d_in[12]; p.w_out_b = (const float*)d_in[13]; p.w_mem_kv = (const float*)d_in[14]; p.w_kv_b = (const float*)d_in[15];
    p.cmp_pe = (const float*)d_in[16]; p.cmp_w1 = (const float*)d_in[17]; p.cmp_w2 = (const float*)d_in[18]; p.ln_g = (const float*)d_in[19]; p.ln_b = (const float*)d_in[20];
    p.peer_wq = (const float*)d_in[21]; p.peer_keys = (const float*)d_in[22]; p.peer_u = (const float*)d_in[23]; p.peer_v = (const float*)d_in[24];
    size_t o = 0; auto take = [&](size_t n) { float* r = out + o; o += n; return r; };
    p.y_prompt = take((size_t)M0 * D_MODEL); p.y_sample = take((size_t)DEC_BATCH * D_MODEL);
    for (int g = 0; g < 3; ++g) p.dil_p[g] = take((size_t)BATCH * DIL_W[g] * 2 * DIL_HEADS * HEAD_DIM);
    for (int g = 0; g < 3; ++g) p.dil_s[g] = take((size_t)DEC_BATCH * DIL_W[g] * 2 * DIL_HEADS * HEAD_DIM);
    p.nsa_kv_p = take((size_t)M0 * 4 * NSA_KV_HEADS * HEAD_DIM); p.nsa_kv_s = take((size_t)DEC_BATCH * 4 * NSA_KV_HEADS * HEAD_DIM);
    p.win_p = take((size_t)BATCH * SWA_WINDOW * 2 * NSA_KV_HEADS * HEAD_DIM); p.win_s = take((size_t)DEC_BATCH * SWA_WINDOW * 2 * NSA_KV_HEADS * HEAD_DIM);
    p.mem_kv_p = take((size_t)DEPTH * BATCH * MEM_TOKENS * 2 * MEM_COLS);
}
DI unsigned f2bf(float f) { unsigned u = __builtin_bit_cast(unsigned, f); return (u + 0x7fffu + ((u >> 16) & 1u)) >> 16; }
DI unsigned pk2(float lo, float hi) { return f2bf(lo) | (f2bf(hi) << 16); }
DI float bf2f(unsigned short b) { return __builtin_bit_cast(float, (unsigned)b << 16); }
DI float bflo(unsigned w) { return __builtin_bit_cast(float, w << 16); }
DI float bfhi(unsigned w) { return __builtin_bit_cast(float, w & 0xffff0000u); }
template <int CTRL> DI float dpp1(float x) { return __builtin_bit_cast(float, __builtin_amdgcn_update_dpp(0, __builtin_bit_cast(int, x), CTRL, 0xF, 0xF, true)); }
DI float wave_sum(float v) { v += dpp1<0xB1>(v); v += dpp1<0x4E>(v); v += dpp1<0x141>(v); v += dpp1<0x140>(v);
    float a = v, b = v; asm volatile("s_nop 1\n\tv_permlane16_swap_b32 %0, %1" : "+v"(a), "+v"(b)); v = a + b; a = v; b = v;
    asm volatile("s_nop 1\n\tv_permlane32_swap_b32 %0, %1" : "+v"(a), "+v"(b)); return a + b; }
DI float wave_max(float v) { v = fmaxf(v, dpp1<0xB1>(v)); v = fmaxf(v, dpp1<0x4E>(v)); v = fmaxf(v, dpp1<0x141>(v)); v = fmaxf(v, dpp1<0x140>(v));
    float a = v, b = v; asm volatile("s_nop 1\n\tv_permlane16_swap_b32 %0, %1" : "+v"(a), "+v"(b)); v = fmaxf(a, b); a = v; b = v;
    asm volatile("s_nop 1\n\tv_permlane32_swap_b32 %0, %1" : "+v"(a), "+v"(b)); return fmaxf(a, b); }
DI float gelu_tanh(float x) { const float u = 0.7978845608028654f * (x + 0.044715f * x * x * x); const float e = __builtin_amdgcn_exp2f(u * 2.885390081777927f);   const float t = 1.0f - 2.0f / (e + 1.0f); return 0.5f * x * (1.0f + t); }
DI float* sel3(float* const (&a)[3], int g) { return g == 0 ? a[0] : (g == 1 ? a[1] : a[2]); }
DI const float* sel3c(const float* const (&a)[3], int g) { return g == 0 ? a[0] : (g == 1 ? a[1] : a[2]); }
__host__ DI size_t ktile_off(int t, int d) { const int blk = t >> 5, kk = t & 31, b = (kk >> 2) & 1, i = 4 * (kk >> 3) + (kk & 3), s = d >> 5, c = (d & 31) >> 3; return ((size_t)(blk * 4 + 2 * b + s) * 64 + i + 16 * c) * 8 + (d & 7); }
__host__ DI size_t vtile_off(int dim, int t) { const int blk = t >> 5, kk = t & 31; return ((size_t)(blk * 4 + (dim >> 4)) * 64 + (dim & 15) + 16 * (kk >> 3)) * 8 + (kk & 7); }
struct Ctx { LAS unsigned char* lds; int tid, lane, wave, vcu, G; };
DI int row_pos(int r) { return r < M0 ? (r & (SEQ - 1)) : PAST_LEN; }

struct ColSrc { const float* p; int ld; };
DI int rope_il(int e) { return (e >> 1) + 32 * (e & 1); }
DI ColSrc col_wa(const FP& P, int n) {
    const int t = n >> 8, ct = n & 255, h = ct >> 6, e = ct & 63; if (t >= 9) return ColSrc{P.w_in_a + DIL_COLS + ct, ACOLS};
    const int j = t % 3, d = (j < 2) ? rope_il(e) : e; return ColSrc{P.w_in_a + t * 256 + h * 64 + d, ACOLS}; }
DI ColSrc col_wb(const FP& P, int n) {
    const int t = n >> 8, ct = n & 255, e = ct & 63;
    if (t < 3) { const int ty = 2 * t + (ct >> 7), kvh = (ct >> 6) & 1; const bool rot = (ty == 2 || ty == 4); return ColSrc{P.w_kv_b + (ty * NSA_KV_HEADS + kvh) * 64 + (rot ? rope_il(e) : e), KVCOLS}; }
    if (t < 6) { const int h = (t - 3) * 4 + (ct >> 6); return ColSrc{P.w_in_b + h * 64 + rope_il(e), BCOLS}; }
    if (t == 6) return ColSrc{P.w_in_b + NSA_Q_COLS + NSA_GATE_COLS + ct, BCOLS};
    if (ct < NSA_GATE_COLS) return ColSrc{P.w_in_b + NSA_Q_COLS + ct, BCOLS};
    return ColSrc{nullptr, 0}; }
DI ColSrc col_wmem(const FP& P, int n) { const int l = n >> 9, c = n & 511; return ColSrc{P.w_mem_kv + (size_t)l * D_MODEL * 512 + c, 512}; }
DI ColSrc col_woa(const FP& P, int n) { return ColSrc{P.w_out_a + n, D_MODEL}; }
DI ColSrc col_wob(const FP& P, int n) { return ColSrc{P.w_out_b + n, D_MODEL}; }
DI ColSrc col_cw1(const FP& P, int n) {
    const int ty = n >> 8, half = (n >> 7) & 1, hid = n & 127; return ColSrc{P.cmp_w1 + (size_t)ty * CMP_BLOCK * HEAD_DIM * CMP_HIDDEN + (size_t)half * 16 * HEAD_DIM * CMP_HIDDEN + hid, CMP_HIDDEN}; }
template <class CF> DI void transpose_item(const FP& P, CF cf, int K, bf16* WT, LAS float* scr, int item, int nblk, int lane) {
    const int kb = item / nblk, nb = item % nblk, k0 = 64 * kb, n0 = 32 * nb;
    const ColSrc cs = cf(P, n0 + (lane & 31));
#pragma unroll 8
    for (int i = 0; i < 32; ++i) { const int kk = 2 * i + (lane >> 5); scr[kk * 33 + (lane & 31)] = cs.p ? cs.p[(size_t)(k0 + kk) * cs.ld] : 0.f; }
    asm volatile("s_waitcnt lgkmcnt(0)" ::: "memory");
    const int c = lane & 7;
#pragma unroll
    for (int j = 0; j < 4; ++j) { const int n = (lane >> 3) + 8 * j; const LAS float* s = scr + (8 * c) * 33 + n;
        u32x4 o; o.x = pk2(s[0 * 33], s[1 * 33]); o.y = pk2(s[2 * 33], s[3 * 33]); o.z = pk2(s[4 * 33], s[5 * 33]); o.w = pk2(s[6 * 33], s[7 * 33]);
        *(u32x4*)(WT + (size_t)(n0 + n) * K + k0 + 8 * c) = o; }
    asm volatile("s_waitcnt lgkmcnt(0)" ::: "memory");
}
DI void cvt_row1024(const float* src, bf16* dst, int lane) {
#pragma unroll
    for (int j = 0; j < 4; ++j) { f32x4 v = src ? *(const f32x4*)(src + 256 * j + 4 * lane) : (f32x4){0.f, 0.f, 0.f, 0.f}; u32x2 o; o.x = pk2(v.x, v.y); o.y = pk2(v.z, v.w); *(u32x2*)(dst + 256 * j + 4 * lane) = o; }
}
DI void cvt_row1024_fp8(const float* src, unsigned char* dst, float sc, int lane) { u32x4 o; unsigned w[4];
#pragma unroll
    for (int j = 0; j < 4; ++j) { const f32x4 v = *(const f32x4*)(src + 16 * lane + 4 * j) * sc; int t = __builtin_amdgcn_cvt_pk_fp8_f32(v.x, v.y, 0, false); t = __builtin_amdgcn_cvt_pk_fp8_f32(v.z, v.w, t, true); w[j] = (unsigned)t; }
    o.x = w[0]; o.y = w[1]; o.z = w[2]; o.w = w[3]; *(u32x4*)(dst + 16 * lane) = o; }
DI void p0_prologue(const FP& P, const Ctx& C) {
    LAS float* scr = (LAS float*)(C.lds + C.wave * 16384);
    const int gw = C.vcu * NWAVES + C.wave, NGW = C.G * NWAVES, lane = C.lane; const int gwT0 = C.wave * C.G + C.vcu;
    { constexpr int IA = (D_MODEL / 64) * (ACOLS / 32), IM = (D_MODEL / 64) * (1024 / 32);
      for (int it = gwT0; it < IA + IM; it += NGW) { int r = it;
          if (r < IA) { transpose_item(P, col_wa, D_MODEL, P.WA_T, scr, r, ACOLS / 32, lane); continue; } r -= IA;
          transpose_item(P, col_wmem, D_MODEL, P.WMEM_T, scr, r, 1024 / 32, lane); } }
    for (int r = gw; r < M0 - NGW; r += 2 * NGW) {
        f32x4 v[8];
#pragma unroll
        for (int j = 0; j < 8; ++j) v[j] = *(const f32x4*)(P.x_prompt + (size_t)(r + (j >> 2) * NGW) * D_MODEL + 256 * (j & 3) + 4 * lane);
#pragma unroll
        for (int j = 0; j < 8; ++j) { u32x2 o; o.x = pk2(v[j].x, v[j].y); o.y = pk2(v[j].z, v[j].w); *(u32x2*)(P.XB0 + (size_t)(r + (j >> 2) * NGW) * D_MODEL + 256 * (j & 3) + 4 * lane) = o; } }
    for (int r = gw + ((M0 - NGW - gw + 2 * NGW - 1) / (2 * NGW)) * (2 * NGW); r < MPAD; r += NGW) { cvt_row1024(r < M0 ? P.x_prompt + (size_t)r * D_MODEL : (r < MP ? P.x_sample + (size_t)(r - M0) * D_MODEL : nullptr), P.XB0 + (size_t)r * D_MODEL, lane);
        if (r >= MP) { cvt_row1024(nullptr, P.X1B + (size_t)r * D_MODEL, lane); cvt_row1024(nullptr, P.X2B + (size_t)r * D_MODEL, lane); cvt_row1024(nullptr, P.X3B + (size_t)r * D_MODEL, lane);
            for (int c = lane; c < 512; c += 64) { P.ATTA[(size_t)r * 512 + c] = 0; P.ATTB[(size_t)r * 1024 + c] = 0; P.ATTB[(size_t)r * 1024 + 512 + c] = 0; } } }
    for (int r = gw; r < BATCH * MEM_TOKENS; r += NGW) cvt_row1024(P.mem_prompt + (size_t)r * D_MODEL, P.MEMB + (size_t)r * D_MODEL, lane);
    for (int i = gw * 64 + lane; i < NPOS * 32; i += NGW * 64) { const int pos = i >> 5, d = i & 31; const double inv = exp2(-(double)d * (13.287712379549449 / 32.0)); const double turns = (double)pos * inv * 0.15915494309189535;
        const float fr = (float)(turns - floor(turns)); P.ROPE[pos * 64 + d] = __builtin_amdgcn_cosf(fr); P.ROPE[pos * 64 + 32 + d] = __builtin_amdgcn_sinf(fr); }
}
constexpr int WPK_ITEMS = DEPTH * 16 * (D_MODEL / 64);
DI void wpk_item(const FP& P, const Ctx& C, int it) {
    LAS float* sw = (LAS float*)C.lds;
    LAS float* sk = (LAS float*)(C.lds + 32768);
    const int l = it / (16 * (D_MODEL / 64)), rem = it % (16 * (D_MODEL / 64)), hc = rem / (D_MODEL / 64), kb = rem % (D_MODEL / 64);
    __syncthreads();
    for (int i = C.tid; i < 64 * 64; i += NTHREADS) { const int r = i >> 6, d = i & 63; sw[r * 65 + d] = P.peer_wq[((size_t)l * D_MODEL + kb * 64 + r) * 1024 + hc * 64 + d]; }
    for (int i = C.tid; i < 128 * 64; i += NTHREADS) { const int r = i >> 6, d = i & 63; sk[r * 68 + d] = P.peer_keys[(((size_t)l * 16 + hc) * PEER_KEYS + r) * 64 + d]; }
    __syncthreads();
    { const int ki = C.lane, kk0 = C.wave; float a[16];
#pragma unroll
      for (int j = 0; j < 16; ++j) a[j] = 0.f;
#pragma unroll 2
      for (int d = 0; d < 64; d += 4) { const float w0 = sw[ki * 65 + d], w1 = sw[ki * 65 + d + 1], w2 = sw[ki * 65 + d + 2], w3 = sw[ki * 65 + d + 3];
#pragma unroll
          for (int j = 0; j < 16; ++j) { const f32x4 kq = *(const LAS f32x4*)(sk + (kk0 + 8 * j) * 68 + d); a[j] += w0 * kq.x + w1 * kq.y + w2 * kq.z + w3 * kq.w; } }
#pragma unroll
      for (int j = 0; j < 16; ++j) P.WPK_T[((size_t)l * NPK + hc * 128 + kk0 + 8 * j) * D_MODEL + kb * 64 + ki] = (bf16)f2bf(a[j]); }
    __syncthreads();
}
constexpr int T1_OA = (512 / 64) * (D_MODEL / 32), T1_OB = (1024 / 64) * (D_MODEL / 32), T1_B = (D_MODEL / 64) * (NB_T / 32), T1_C = (1024 / 64) * (512 / 32), T1_ITEMS = T1_OA + T1_OB + T1_B + T1_C;
constexpr int AC_ITEMS = DEC_BATCH * (PAST_LEN / PAGE_SIZE) * (PAGE_SIZE / 8), CB_ITEMS = 2 * CMP_HIDDEN;
constexpr int bgq_cache_n(int g) { return (DEC_BATCH * ((g < 3 ? dil_w(g) : SWA_WINDOW) - 1) * (g < 3 ? 128 : 64) + 8191) / 8192; }
constexpr int BGQ_T1 = (T1_ITEMS + 7) / 8, BGQ_L_A = BGQ_T1 + WPK_ITEMS, BGQ_UV = DEPTH * PEER_EXPERTS / 16, BGQ_L_UV = BGQ_L_A + BGQ_UV;
constexpr int BGQ_AC = (AC_ITEMS + 7) / 8, BGQ_CB = (CB_ITEMS + 7) / 8, BGQ_L_AC = BGQ_L_UV + BGQ_AC + BGQ_CB;
constexpr int BGQ_TOTAL = BGQ_L_AC + bgq_cache_n(0) + bgq_cache_n(1) + bgq_cache_n(2) + bgq_cache_n(3);
constexpr int BGQ_CTR = 12288;
DI void bg_chunk(const FP& P, const Ctx& C, int c) {
    const int lane = C.lane;
    if (c < BGQ_T1) { int r = c * 8 + C.wave; LAS float* scr = (LAS float*)(C.lds + C.wave * 16384);
        if (r < T1_ITEMS) {
            if (r < T1_OA) transpose_item(P, col_woa, 512, P.WOA_T, scr, r, D_MODEL / 32, lane);
            else if ((r -= T1_OA) < T1_OB) transpose_item(P, col_wob, 1024, P.WOB_T, scr, r, D_MODEL / 32, lane);
            else if ((r -= T1_OB) < T1_B) transpose_item(P, col_wb, D_MODEL, P.WB_T, scr, r, NB_T / 32, lane);
            else transpose_item(P, col_cw1, 1024, P.CW1_T, scr, r - T1_B, 512 / 32, lane); }
        return; }
    if (c < BGQ_L_A) { wpk_item(P, C, c - BGQ_T1); return; }
    c -= BGQ_L_A;
    if (c < BGQ_UV) {
        { const int r = c * 16 + C.wave * 2; f32x4 a[16];
#pragma unroll
            for (int q = 0; q < 4; ++q) { const float* s0 = (q < 2 ? P.peer_u : P.peer_v) + (size_t)(r + (q & 1)) * D_MODEL + 16 * lane;
#pragma unroll
                for (int j = 0; j < 4; ++j) a[4 * q + j] = *(const f32x4*)(s0 + 4 * j); }
#pragma unroll
            for (int q = 0; q < 4; ++q) { const float sc = q < 2 ? 256.f : 64.f; unsigned w[4];
#pragma unroll
                for (int j = 0; j < 4; ++j) { const f32x4 v = a[4 * q + j] * sc; int t = __builtin_amdgcn_cvt_pk_fp8_f32(v.x, v.y, 0, false); t = __builtin_amdgcn_cvt_pk_fp8_f32(v.z, v.w, t, true); w[j] = (unsigned)t; }
                u32x4 o; o.x = w[0]; o.y = w[1]; o.z = w[2]; o.w = w[3]; *(u32x4*)((q < 2 ? P.UB8 : P.VB8) + (size_t)(r + (q & 1)) * D_MODEL + 16 * lane) = o; } }
        return; }
    c -= BGQ_UV;
    if (c < BGQ_AC) { const int it2 = c * 8 + C.wave;
        if (it2 < AC_ITEMS) { const int it = it2 / (PAGE_SIZE / 8), rg = it2 % (PAGE_SIZE / 8);
            const int n = it / (PAST_LEN / PAGE_SIZE), pi = it % (PAST_LEN / PAGE_SIZE); const int pg = P.page_table[it];
            const float* src = P.cache_nsa_kv + (size_t)pg * PAGE_SIZE * 512 + 4 * lane; const int ty = lane >> 5, kvh = (lane >> 4) & 1, d = (4 * lane) & 63;
            bf16* dst = P.AC + ((size_t)ty * ACROWS + ((size_t)(BATCH + n) * NSA_KV_HEADS + kvh) * NCH + pi * (PAGE_SIZE / 16)) * 1024 + d;
            const int r0 = rg * 8; f32x4 v[8];
#pragma unroll
            for (int u = 0; u < 8; ++u) v[u] = *(const f32x4*)(src + (size_t)(r0 + u) * 512);
#pragma unroll
            for (int u = 0; u < 8; ++u) { const int t = r0 + u; u32x2 o; o.x = pk2(v[u].x, v[u].y); o.y = pk2(v[u].z, v[u].w); *(u32x2*)(dst + (size_t)(t / 16) * 1024 + (t % 16) * 64) = o; } }
        return; }
    c -= BGQ_AC;
    if (c < BGQ_CB) { const int i = c * 8 + C.wave;
        if (i < CB_ITEMS) { const int ty = i / CMP_HIDDEN, hid = i % CMP_HIDDEN; float a = 0.f;
#pragma unroll 8
            for (int k = lane; k < CMP_BLOCK * HEAD_DIM; k += 64) a += P.cmp_pe[ty * CMP_BLOCK * HEAD_DIM + k] * P.cmp_w1[((size_t)ty * CMP_BLOCK * HEAD_DIM + k) * CMP_HIDDEN + hid];
            a = wave_sum(a); if (lane == 0) P.CBIAS[i] = a; }
        return; }
    c -= BGQ_CB;
    int g = 0; if (c >= bgq_cache_n(0)) { c -= bgq_cache_n(0); g = 1; if (c >= bgq_cache_n(1)) { c -= bgq_cache_n(1); g = 2; if (c >= bgq_cache_n(2)) { c -= bgq_cache_n(2); g = 3; } } }
    const int W = g < 3 ? dil_w(g) : SWA_WINDOW, RV = g < 3 ? 128 : 64;
    const f32x4* src = (const f32x4*)(g < 3 ? sel3c(P.cache_dil, g) : P.cache_nsa_win); f32x4* dst = (f32x4*)(g < 3 ? sel3(P.dil_s, g) : P.win_s);
    const int per = (W - 1) * RV, nvec = DEC_BATCH * per;
    const int i0 = c * 8192 + C.wave * 1024;
    if (i0 < nvec) { f32x4 v[16]; int idx[16];
        const int n0 = __builtin_amdgcn_readfirstlane((int)((unsigned)i0 / (unsigned)per)), o0 = i0 - n0 * per;
#pragma unroll
        for (int u = 0; u < 16; ++u) { int o = o0 + u * 64 + lane, n = n0; if (o >= per) { o -= per; ++n; } if (n >= DEC_BATCH) { n = DEC_BATCH - 1; o = per - 1; } idx[u] = n * (per + RV) + o; v[u] = src[(size_t)idx[u] + RV]; }
#pragma unroll
        for (int u = 0; u < 16; ++u) { const int i = i0 + u * 64 + lane; if (i < nvec) dst[(size_t)idx[u]] = v[u]; } }
}
DI void bgq_drain(const FP& P, const Ctx& C, volatile LAS unsigned* slot, int limit) {
#pragma unroll 1
    for (;;) {
        __syncthreads();
        if (C.tid == 0) *slot = atomicAdd(P.ctl + BGQ_CTR, 1u);
        __syncthreads();
        const int c = (int)*slot;
        if (c < BGQ_TOTAL) bg_chunk(P, C, c);
        if (c >= limit) break;
    }
    __syncthreads();
}
DI void xcd_barrier_bg(const XcdBarrier& b, const FP& P, const Ctx& C, volatile LAS unsigned* slot  ) {
    asm volatile("s_waitcnt vmcnt(0)" ::: "memory");
    __syncthreads();
    if (threadIdx.x == 0) {
        unsigned* bar = b.bar;
        __builtin_amdgcn_s_waitcnt(0);
        unsigned nloc = b.st[0], nx = b.st[1];
        if (nloc == 0u) { xcd_barrier_complete(bar, b.x, nloc, nx); b.st[0] = nloc; b.st[1] = nx; }
        const unsigned old = xb_add(&bar[XB_XSUB(b.x)], 1u);
        const unsigned gen = old / nloc;
        if (old + 1u == (gen + 1u) * nloc) {
            __builtin_amdgcn_fence(__ATOMIC_RELEASE, "agent");
            asm volatile("s_waitcnt vmcnt(0)" ::: "memory");
            const unsigned og = xb_add(&bar[XB_TOP], 1u);
            const unsigned tg = og / nx;
            if (og + 1u == (tg + 1u) * nx) xb_add(&bar[XB_TOPGEN], 1u);
            else XB_SPIN(xb_ld(&bar[XB_TOPGEN]) == tg, bar);
            __builtin_amdgcn_fence(__ATOMIC_ACQUIRE, "agent");
            xb_add(&bar[XB_XGEN(b.x)], 1u);
            asm volatile("s_waitcnt vmcnt(0)" ::: "memory");
            slot[2] = 1u;
        } else { slot[1] = gen; slot[2] = 0u; }
    }
    __syncthreads();
    unsigned spins = 0;
#pragma unroll 1
    while (slot[2] == 0u) {
        if (threadIdx.x == 0) {
            unsigned c = (unsigned)BGQ_TOTAL;
            if (xb_ld(&b.bar[XB_XGEN(b.x)]) != slot[1] || xb_ld(&b.bar[XB_TMO]) != 0u) {
                __builtin_amdgcn_fence(__ATOMIC_ACQUIRE, "agent");
                asm volatile("s_waitcnt vmcnt(0)" ::: "memory");
                slot[2] = 1u;
            } else if (xb_ld(P.ctl + BGQ_CTR) < (unsigned)BGQ_TOTAL) {
                const unsigned nloc = b.st[0], nx = b.st[1], gen = slot[1];
                const unsigned arr = xb_ld(&b.bar[XB_XSUB(b.x)]) - gen * nloc, top = xb_ld(&b.bar[XB_TOP]) - gen * nx;
                if (arr + 3u <= nloc || (arr >= nloc && top + 2u <= nx)) c = atomicAdd(P.ctl + BGQ_CTR, 1u);
                else __builtin_amdgcn_s_sleep(1);
            }
            else { __builtin_amdgcn_s_sleep(1); if (++spins > XB_SPIN_CAP) { atomicAdd(&b.bar[XB_TMO], 1u); } }
            slot[0] = c;
        }
        __syncthreads();
        const bool rel = slot[2] != 0u; const int c = (int)slot[0];
        if (!rel && c < BGQ_TOTAL) bg_chunk(P, C, c);
        __syncthreads();
    }
}
#define EPI_LOOP(...) int fr_l = fr, fq_l = fq; asm volatile("" : "+v"(fr_l), "+v"(fq_l));     \
    _Pragma("unroll") for (int ai = 0; ai < 2; ++ai) _Pragma("unroll") for (int m = 0; m < 4; ++m) { const int row = u.pm * 256 + ai * 128 + wr * 64 + m * 16 + fr_l; \
    _Pragma("unroll") for (int bj = 0; bj < 2; ++bj) { const int ct = bj * 128 + wc * 32 + fq_l * 8; const f32x4 v0 = acc[ai][bj][m][0], v1 = acc[ai][bj][m][1]; __VA_ARGS__ } asm volatile("" ::: "memory"); }
DI void rope4(const float* rope_row, int dp, const f32x4& v0, const f32x4& v1, f32x4& lo, f32x4& hi) {
    const f32x4 c = *(const f32x4*)(rope_row + dp), s = *(const f32x4*)(rope_row + 32 + dp);
    lo.x = v0.x * c.x - v0.y * s.x; hi.x = v0.y * c.x + v0.x * s.x; lo.y = v0.z * c.y - v0.w * s.y; hi.y = v0.w * c.y + v0.z * s.y;
    lo.z = v1.x * c.z - v1.y * s.z; hi.z = v1.y * c.z + v1.x * s.z; lo.w = v1.z * c.w - v1.w * s.w; hi.w = v1.w * c.w + v1.z * s.w; }
DI u32x2 pk4(const f32x4& v) { u32x2 o; o.x = pk2(v.x, v.y); o.y = pk2(v.z, v.w); return o; }
DI u32x4 pk8(const f32x4& a, const f32x4& b) { u32x4 o; o.x = pk2(a.x, a.y); o.y = pk2(a.z, a.w); o.z = pk2(b.x, b.y); o.w = pk2(b.z, b.w); return o; }
DI int dil_perm(int t, int d) { return (t % d) * (SEQ / d) + t / d; }
#ifdef EPIA_REP
#define EPIA_REP_BEGIN _Pragma("unroll 1") for (int rep_ = 0; rep_ < EPIA_REP; ++rep_) {
#define EPIA_REP_END }
#else
#define EPIA_REP_BEGIN
#define EPIA_REP_END
#endif
struct EpiA {
    static constexpr bool PERM = true, AFTER_DRAIN = false; const FP& P;
    DI void operator()(const f32x4 (&acc)[2][2][4][2], const pg8::Unit& u, int wr, int wc, int fr, int fq) const {
        const int t9 = u.pn; const int g = t9 / 3, j = t9 % 3;
        EPIA_REP_BEGIN EPI_LOOP({ if (row < MP) { const int h = ct >> 6, e = ct & 63; const int pos = row_pos(row);
            if (t9 == 9) { *(u32x4*)(P.MQA + (size_t)row * 256 + ct) = pk8(v0 * QSCALE, v1 * QSCALE); }
            else if (j < 2) { f32x4 lo, hi; const int dp = e >> 1; rope4(P.ROPE + pos * 64, dp, v0, v1, lo, hi);
                if (j == 0) { bf16* q = P.QA + ((size_t)g * MPAD + row) * 256 + h * 64 + dp; *(u32x2*)q = pk4(lo * QSCALE); *(u32x2*)(q + 32) = pk4(hi * QSCALE); }
                else { if (row < M0) { bf16* kt = P.KA + ((size_t)(g * BATCH + row / SEQ) * DIL_HEADS + h) * 64 * SEQ; const int cm = dil_perm(pos, dil_d(g)); *(u32x2*)(kt + ktile_off(cm, dp)) = pk4(lo); *(u32x2*)(kt + ktile_off(cm, dp + 32)) = pk4(hi); }
                    const int W = dil_w(g); float* o = nullptr;
                    if (row >= M0) o = sel3(P.dil_s, g) + (((size_t)(row - M0) * W + W - 1) * 2 + 0) * 256; else if (pos >= SEQ - W) o = sel3(P.dil_p, g) + (((size_t)(row / SEQ) * W + pos - (SEQ - W)) * 2 + 0) * 256;
                    if (o) { *(f32x4*)(o + h * 64 + dp) = lo; *(f32x4*)(o + h * 64 + 32 + dp) = hi; } } }
            else { const int W = dil_w(g), d = dil_d(g); float* o = nullptr;
                if (row >= M0) o = sel3(P.dil_s, g) + (((size_t)(row - M0) * W + W - 1) * 2 + 1) * 256; else if (pos >= SEQ - W) o = sel3(P.dil_p, g) + (((size_t)(row / SEQ) * W + pos - (SEQ - W)) * 2 + 1) * 256;
                if (o) { *(f32x4*)(o + ct) = v0; *(f32x4*)(o + ct + 4) = v1; }
                if (row < M0) { bf16* vt = P.VTA + ((size_t)(g * BATCH + row / SEQ) * DIL_HEADS + h) * 64 * SEQ + vtile_off(e, dil_perm(pos, d));
                    vt[0] = (bf16)f2bf(v0.x); vt[8] = (bf16)f2bf(v0.y); vt[16] = (bf16)f2bf(v0.z); vt[24] = (bf16)f2bf(v0.w); vt[32] = (bf16)f2bf(v1.x); vt[40] = (bf16)f2bf(v1.y); vt[48] = (bf16)f2bf(v1.z); vt[56] = (bf16)f2bf(v1.w); } } } }) EPIA_REP_END
    }
};
struct EpiMem {
    static constexpr bool PERM = true, AFTER_DRAIN = false; const FP& P;
    DI void operator()(const f32x4 (&acc)[2][2][4][2], const pg8::Unit& u, int wr, int wc, int fr, int fq) const {
        const int l = u.pn >> 1, half = u.pn & 1;
        EPI_LOOP({ const int n = row / MEM_TOKENS, mt = row % MEM_TOKENS; float* o = P.mem_kv_p + (((size_t)l * BATCH + n) * MEM_TOKENS + mt) * 512 + half * 256 + ct; *(f32x4*)o = v0; *(f32x4*)(o + 4) = v1;
            if (half == 0) *(u32x4*)(P.MK + (((size_t)l * BATCH + n) * MEM_HEADS + (ct >> 6)) * MEM_TOKENS * 64 + ktile_off(mt, ct & 63)) = pk8(v0, v1);
            else { bf16* vt = P.MVT + (((size_t)l * BATCH + n) * MEM_HEADS + (ct >> 6)) * MEM_TOKENS * 64 + vtile_off(ct & 63, mt);
                vt[0] = (bf16)f2bf(v0.x); vt[8] = (bf16)f2bf(v0.y); vt[16] = (bf16)f2bf(v0.z); vt[24] = (bf16)f2bf(v0.w); vt[32] = (bf16)f2bf(v1.x); vt[40] = (bf16)f2bf(v1.y); vt[48] = (bf16)f2bf(v1.z); vt[56] = (bf16)f2bf(v1.w); } })
    }
};
struct EpiPre {
    static constexpr bool PERM = true, AFTER_DRAIN = false; const float* xa; const float* xb; float* pre;
    DI void operator()(const f32x4 (&acc)[2][2][4][2], const pg8::Unit& u, int wr, int wc, int fr, int fq) const {
        EPI_LOOP({ if (row < MP) { const int col = u.pn * 256 + ct; const float* x = (xb && row >= M0) ? xb + (size_t)(row - M0) * D_MODEL + col : xa + (size_t)row * D_MODEL + col;
            const f32x4 a = *(const f32x4*)x, b = *(const f32x4*)(x + 4); float* o = pre + (size_t)row * D_MODEL + col; *(f32x4*)o = a * ALPHA + v0; *(f32x4*)(o + 4) = b * ALPHA + v1; } })
    }
};
struct EpiF32 {
    static constexpr bool PERM = true, AFTER_DRAIN = false; float* out; int ldc; int nrows;
    DI void operator()(const f32x4 (&acc)[2][2][4][2], const pg8::Unit& u, int wr, int wc, int fr, int fq) const {
        EPI_LOOP({ if (row < nrows) { float* o = out + (size_t)row * ldc + u.pn * 256 + ct; *(f32x4*)o = v0; *(f32x4*)(o + 4) = v1; } })
    }
};
}
namespace fx {
struct Tile16 { f32x4 o[4]; float m, l; };
DI void tile_init(Tile16& T) { T.o[0] = T.o[1] = T.o[2] = T.o[3] = (f32x4){0.f, 0.f, 0.f, 0.f}; T.m = -INFINITY; T.l = 0.f; }
typedef __bf16 bf16x2_t __attribute__((ext_vector_type(2)));
DI unsigned cvtpk(float lo, float hi) { const f32x2 v = {lo, hi}; const bf16x2_t b = __builtin_convertvector(v, bf16x2_t); return __builtin_bit_cast(unsigned, b); }
struct KV8 { bf16x8 ka0, ka1, kb0, kb1, v0, v1, v2, v3; };
DI void kv_load(KV8& r, const bf16* k0, const bf16* k1, const bf16* v, long vs16) {
    r.ka0 = *(const bf16x8*)k0; r.ka1 = *(const bf16x8*)(k0 + 32); r.kb0 = *(const bf16x8*)k1; r.kb1 = *(const bf16x8*)(k1 + 32);
    r.v0 = *(const bf16x8*)v; r.v1 = *(const bf16x8*)(v + vs16); r.v2 = *(const bf16x8*)(v + 2 * vs16); r.v3 = *(const bf16x8*)(v + 3 * vs16); }
DI void mk_range(int a, int b, bool ok, int& lo, unsigned& rng) { const bool v = ok && b >= a; lo = v ? a : (1 << 20); rng = v ? (unsigned)(b - a) : 0u; }
DI float colmax(float x) { float a = x, b = x; asm volatile("s_nop 1\n\tv_permlane32_swap_b32 %0, %1" : "+v"(a), "+v"(b)); float m = fmaxf(a, b); a = m; b = m;
    asm volatile("s_nop 1\n\tv_permlane16_swap_b32 %0, %1" : "+v"(a), "+v"(b)); return fmaxf(a, b); }
DI float colsum(float x) { float a = x, b = x; asm volatile("s_nop 1\n\tv_permlane32_swap_b32 %0, %1" : "+v"(a), "+v"(b)); float m = a + b; a = m; b = m;
    asm volatile("s_nop 1\n\tv_permlane16_swap_b32 %0, %1" : "+v"(a), "+v"(b)); return a + b; }
DI void tile_compute(Tile16& T, const bf16x8 (&qf)[2], const KV8& r, int lo, unsigned rng) {
    f32x4 s0 = (f32x4){0.f, 0.f, 0.f, 0.f}, s1 = (f32x4){0.f, 0.f, 0.f, 0.f};
    s0 = __builtin_amdgcn_mfma_f32_16x16x32_bf16(r.ka0, qf[0], s0, 0, 0, 0); s0 = __builtin_amdgcn_mfma_f32_16x16x32_bf16(r.ka1, qf[1], s0, 0, 0, 0);
    s1 = __builtin_amdgcn_mfma_f32_16x16x32_bf16(r.kb0, qf[0], s1, 0, 0, 0); s1 = __builtin_amdgcn_mfma_f32_16x16x32_bf16(r.kb1, qf[1], s1, 0, 0, 0);
    float s[8] = {s0.x, s0.y, s0.z, s0.w, s1.x, s1.y, s1.z, s1.w};
    float mx = -INFINITY;
#pragma unroll
    for (int e = 0; e < 8; ++e) { s[e] = ((unsigned)(e - lo) <= rng) ? s[e] : -INFINITY; mx = fmaxf(mx, s[e]); }
    mx = colmax(mx);
    if (__builtin_amdgcn_ballot_w64(mx > T.m + 8.f) != 0ull) {
        const float mnew = fmaxf(T.m, mx), mu = (mnew == -INFINITY) ? 0.f : mnew; const float alpha = __builtin_amdgcn_exp2f(T.m - mu);
        T.l *= alpha; T.m = mnew; T.o[0] *= alpha; T.o[1] *= alpha; T.o[2] *= alpha; T.o[3] *= alpha; }
    const float muse = (T.m == -INFINITY) ? 0.f : T.m;
    float ls = 0.f;
#pragma unroll
    for (int e = 0; e < 8; ++e) { s[e] = __builtin_amdgcn_exp2f(s[e] - muse); ls += s[e]; }
    T.l += ls;
    u32x4 pw; pw.x = cvtpk(s[0], s[1]); pw.y = cvtpk(s[2], s[3]); pw.z = cvtpk(s[4], s[5]); pw.w = cvtpk(s[6], s[7]);
    const bf16x8 pf = __builtin_bit_cast(bf16x8, pw);
    T.o[0] = __builtin_amdgcn_mfma_f32_16x16x32_bf16(r.v0, pf, T.o[0], 0, 0, 0); T.o[1] = __builtin_amdgcn_mfma_f32_16x16x32_bf16(r.v1, pf, T.o[1], 0, 0, 0);
    T.o[2] = __builtin_amdgcn_mfma_f32_16x16x32_bf16(r.v2, pf, T.o[2], 0, 0, 0); T.o[3] = __builtin_amdgcn_mfma_f32_16x16x32_bf16(r.v3, pf, T.o[3], 0, 0, 0);
}
template <class BUF, class LD, class CP> DI void pipe2t(int n, LD ld, CP cp) { if (n <= 0) return; BUF A, B; ld(A, 0);
#pragma unroll 1
    for (int i = 0; i < n; i += 2) { ld(B, (i + 1 < n) ? i + 1 : i); cp(A, i); ld(A, (i + 2 < n) ? i + 2 : i); if (i + 1 < n) cp(B, i + 1); } }
template <class LD, class CP> DI void pipe2(int n, LD ld, CP cp) { if (n <= 0) return; KV8 A, B; ld(A, 0);
#pragma unroll 1
    for (int i = 0; i < n; i += 2) { ld(B, (i + 1 < n) ? i + 1 : i); cp(A, i); ld(A, (i + 2 < n) ? i + 2 : i); if (i + 1 < n) cp(B, i + 1); } }
DI void kv_load_t(KV8& r, const bf16* kt, const bf16* vt, int lane) {
    const bf16* k = kt + lane * 8; const bf16* v = vt + lane * 8;
    r.ka0 = *(const bf16x8*)k; r.ka1 = *(const bf16x8*)(k + 512); r.kb0 = *(const bf16x8*)(k + 1024); r.kb1 = *(const bf16x8*)(k + 1536);
    r.v0 = *(const bf16x8*)v; r.v1 = *(const bf16x8*)(v + 512); r.v2 = *(const bf16x8*)(v + 1024); r.v3 = *(const bf16x8*)(v + 1536); }
DI int krow_of(int i, int b) { return 8 * (i >> 2) + 4 * b + (i & 3); }

DI void dil_micro(const FP& P, int n, int h, int t0, int mt, int lane) {
    const int g = mt >> 4, idx = mt & 15, d = dil_d(g), per = 16 / d;
    const int r = idx / per, sub = idx % per, i0 = t0 / d + 16 * sub, ib = i0 - 128, NC = SEQ / d;
    const int q = lane & 15, c = lane >> 4;
    const bf16* Qb = P.QA + ((size_t)g * MPAD + (size_t)n * SEQ) * 256 + h * 64;
    const bf16* Kb = P.KA + ((size_t)(g * BATCH + n) * DIL_HEADS + h) * 64 * SEQ + (size_t)r * NC * 64; const bf16* Vb = P.VTA + ((size_t)(g * BATCH + n) * DIL_HEADS + h) * 64 * SEQ + (size_t)r * NC * 64;
    bf16x8 qf[2]; { const bf16* qp = Qb + (size_t)(r + d * (i0 + q)) * 256 + 8 * c; qf[0] = *(const bf16x8*)qp; qf[1] = *(const bf16x8*)(qp + 32); }
    Tile16 T; tile_init(T);
    const int qi = i0 + q; const int tb0 = ib >> 5  , nblk = ((i0 + 15) >> 5) - tb0 + 1;
    pipe2(nblk, [&](KV8& kv, int i) { int tb = tb0 + i; tb = tb < 0 ? 0 : tb; kv_load_t(kv, Kb + (size_t)tb * 2048, Vb + (size_t)tb * 2048, lane); },
          [&](const KV8& kv, int i) { const int k0 = 32 * (tb0 + i) + 8 * c; int lo; unsigned rng; const int a = qi - (DIL_TAPS - 1); mk_range((a > 0 ? a : 0) - k0, qi - k0, true, lo, rng); tile_compute(T, qf, kv, lo, rng); });
    const int row = n * SEQ + r + d * qi;
    float* op = P.DPART + (((size_t)g * MP + row) * DIL_HEADS + h) * 64 + 4 * c;
#pragma unroll
    for (int db = 0; db < 4; ++db) *(f32x4*)(op + 16 * db) = T.o[db];
    T.l = colsum(T.l);
    if (c == 0) { float* ml = P.DML + (((size_t)g * MP + row) * DIL_HEADS + h) * 2; ml[0] = T.m; ml[1] = T.l; }
}
DI void mem_micro(const FP& P, const bf16* Q  , int ldq, int row0, int layer, int n, int h, bf16* O  , int ldo, int lane) {
    const int q = lane & 15, c = lane >> 4;
    bf16x8 qf[2]; { const bf16* qp = Q + (size_t)(row0 + q) * ldq + 8 * c; qf[0] = *(const bf16x8*)qp; qf[1] = *(const bf16x8*)(qp + 32); }
    const bf16* Kb = P.MK + (((size_t)layer * BATCH + n) * MEM_HEADS + h) * MEM_TOKENS * 64; const bf16* Vb = P.MVT + (((size_t)layer * BATCH + n) * MEM_HEADS + h) * MEM_TOKENS * 64;
    Tile16 T; tile_init(T);
    pipe2(MEM_TOKENS / 32, [&](KV8& kv, int i) { kv_load_t(kv, Kb + (size_t)i * 2048, Vb + (size_t)i * 2048, lane); }, [&](const KV8& kv, int) { tile_compute(T, qf, kv, -8, 64u); });
    const float inv = 1.0f / colsum(T.l); bf16* op = O + (size_t)(row0 + q) * ldo + 4 * c;
#pragma unroll
    for (int db = 0; db < 4; ++db) *(u32x2*)(op + 16 * db) = pk4(T.o[db] * inv);
}
struct Dec { float m, l, o; };
template <class KF, class VF> DI void dec_chunk(Dec& D, const LAS float* q, int nk, KF kf, VF vf, int lane) {
    float s = -INFINITY;
    if (lane < nk) { const float* k = kf(lane); float a = 0.f;
#pragma unroll
        for (int d4 = 0; d4 < 16; ++d4) { const f32x4 kv = *(const f32x4*)(k + 4 * d4); a += kv.x * q[4 * d4] + kv.y * q[4 * d4 + 1] + kv.z * q[4 * d4 + 2] + kv.w * q[4 * d4 + 3]; }
        s = a; }
    const float mx = wave_max(s), mnew = fmaxf(D.m, mx), alpha = __builtin_amdgcn_exp2f(D.m - mnew);
    const float p = (lane < nk) ? __builtin_amdgcn_exp2f(s - mnew) : 0.f;
    D.l = D.l * alpha + wave_sum(p); D.m = mnew; float o = D.o * alpha;
    for (int j0 = 0; j0 < nk; j0 += 8) { float vv[8];
#pragma unroll
        for (int u = 0; u < 8; ++u) { const int jj = (j0 + u < nk) ? j0 + u : nk - 1; vv[u] = vf(jj)[lane]; }
#pragma unroll
        for (int u = 0; u < 8; ++u) { const float pj = (j0 + u < nk) ? __builtin_bit_cast(float, __builtin_amdgcn_readlane(__builtin_bit_cast(int, p), (j0 + u) & 63)) : 0.f; o += pj * vv[u]; } }
    D.o = o;
}
DI float dec_combine(const Ctx& C, const Dec& D) {
    LAS float* cb = (LAS float*)(C.lds + 4096);
    cb[C.wave * 66 + C.lane] = D.o; if (C.lane == 0) { cb[C.wave * 66 + 64] = D.m; cb[C.wave * 66 + 65] = D.l; }
    asm volatile("s_waitcnt lgkmcnt(0)" ::: "memory"); __syncthreads();
    float M = -INFINITY;
#pragma unroll
    for (int ww = 0; ww < NWAVES; ++ww) M = fmaxf(M, cb[ww * 66 + 64]);
    float L = 0.f, o = 0.f;
#pragma unroll
    for (int ww = 0; ww < NWAVES; ++ww) { const float mw = cb[ww * 66 + 64]; const float f = (mw == -INFINITY) ? 0.f : __builtin_amdgcn_exp2f(mw - M); L += f * cb[ww * 66 + 65]; o += f * cb[ww * 66 + C.lane]; }
    return o / L;
}
DI void atta_phase(const FP& P, const Ctx& C) {
    const int lane = C.lane, w = C.wave;
    constexpr int NT = SEQ / 256, NIT = BATCH * NT * DIL_HEADS;
    for (int it = C.vcu; it < NIT; it += C.G) { const int h = it % DIL_HEADS, tt = (it / DIL_HEADS) % NT, n = it / (DIL_HEADS * NT), t0 = tt * 256;
        for (int mt = w; mt < 48; mt += NWAVES) dil_micro(P, n, h, t0, mt, lane);
        asm volatile("s_waitcnt vmcnt(0)" ::: "memory"); __syncthreads();
        for (int i = C.tid; i < 256 * 16; i += NTHREADS) { const int tk = i >> 4, d4 = (i & 15) * 4; const int row = n * SEQ + t0 + tk;
            float mg[3], lg[3]; float M = -INFINITY;
#pragma unroll
            for (int g = 0; g < 3; ++g) { const float* ml = P.DML + (((size_t)g * MP + row) * DIL_HEADS + h) * 2; mg[g] = ml[0]; lg[g] = ml[1]; M = fmaxf(M, mg[g]); }
            f32x4 acc = (f32x4){0.f, 0.f, 0.f, 0.f}; float L = 0.f;
#pragma unroll
            for (int g = 0; g < 3; ++g) { const float wg = __builtin_amdgcn_exp2f(mg[g] - M); L += wg * lg[g]; acc += *(const f32x4*)(P.DPART + (((size_t)g * MP + row) * DIL_HEADS + h) * 64 + d4) * wg; }
            *(u32x2*)(P.ATTA + (size_t)row * 512 + h * 64 + d4) = pk4(acc * (1.0f / L)); }
        for (int mt = w; mt < 16; mt += NWAVES) mem_micro(P, P.MQA + h * 64, 256, n * SEQ + t0 + 16 * mt, 0, n, h, P.ATTA + 256 + h * 64, 512, lane);
        __syncthreads();
    }
    LAS float* qs = (LAS float*)C.lds;
    for (int it = C.vcu; it < DEC_BATCH * DIL_HEADS * 2; it += C.G) { const int kind = it & 1, h = (it >> 1) % DIL_HEADS, ns = (it >> 1) / DIL_HEADS, row = M0 + ns;
        __syncthreads();
        if (kind == 0) { if (C.tid < 192) qs[C.tid] = bf2f(P.QA[((size_t)(C.tid >> 6) * MPAD + row) * 256 + h * 64 + (C.tid & 63)]); } else { if (C.tid < 64) qs[C.tid] = bf2f(P.MQA[(size_t)row * 256 + h * 64 + C.tid]); }
        asm volatile("s_waitcnt lgkmcnt(0)" ::: "memory"); __syncthreads();
        Dec D; D.m = -INFINITY; D.l = 0.f; D.o = 0.f;
        if (kind == 0) { constexpr int CPG = (DIL_TAPS + 63) / 64;
            for (int ck = w; ck < 3 * CPG; ck += NWAVES) { const int g = ck / CPG, j0 = (ck % CPG) * 64; const int W = dil_w(g), d = dil_d(g); const float* cache = sel3c(P.cache_dil, g) + (size_t)ns * W * 512; const float* newrow = sel3(P.dil_s, g) + ((size_t)ns * W + W - 1) * 512;
                const int nk = (DIL_TAPS - j0) < 64 ? (DIL_TAPS - j0) : 64;
                dec_chunk(D, qs + g * 64, nk, [&](int j) { const int tap = j0 + j; return (tap == 0 ? newrow : cache + (size_t)(W - d * tap) * 512) + h * 64; },
                          [&](int j) { const int tap = j0 + j; return (tap == 0 ? newrow : cache + (size_t)(W - d * tap) * 512) + 256 + h * 64; }, lane); } }
        else { const float* mk = P.cache_mem_kv + ((size_t)0 * DEC_BATCH + ns) * MEM_TOKENS * 512;
            for (int ck = w; ck < MEM_TOKENS / 64; ck += NWAVES) { const int j0 = ck * 64; dec_chunk(D, qs, 64, [&](int j) { return mk + (size_t)(j0 + j) * 512 + h * 64; }, [&](int j) { return mk + (size_t)(j0 + j) * 512 + 256 + h * 64; }, lane); } }
        const float o = dec_combine(C, D);
        if (w == 0) P.ATTA[(size_t)row * 512 + (kind == 0 ? 0 : 256) + h * 64 + lane] = (bf16)f2bf(o);
    }
    __syncthreads();
}
DI void ln_phase(const FP& P, const Ctx& C, const float* pre, const float* gam, const float* bet, float* xo, bf16* xb, float* yp, float* ys) {
    const int gw = C.vcu * NWAVES + C.wave, NGW = C.G * NWAVES, lane = C.lane;
    f32x4 nx[4];
    if (gw < MP) {
#pragma unroll
        for (int j = 0; j < 4; ++j) nx[j] = *(const f32x4*)(pre + (size_t)gw * D_MODEL + 256 * j + 4 * lane); }
#pragma unroll 1
    for (int r = gw; r < MP; r += NGW) { f32x4 v[4]; float s = 0.f;
#pragma unroll
        for (int j = 0; j < 4; ++j) v[j] = nx[j];
        { const int rn = (r + NGW < MP) ? r + NGW : r;
#pragma unroll
          for (int j = 0; j < 4; ++j) nx[j] = *(const f32x4*)(pre + (size_t)rn * D_MODEL + 256 * j + 4 * lane); }
        asm volatile("" ::: "memory");
#pragma unroll
        for (int j = 0; j < 4; ++j) s += (v[j].x + v[j].y) + (v[j].z + v[j].w);
        const float mu = wave_sum(s) * (1.0f / D_MODEL); float s2 = 0.f;
#pragma unroll
        for (int j = 0; j < 4; ++j) { v[j] = v[j] - mu; s2 += (v[j].x * v[j].x + v[j].y * v[j].y) + (v[j].z * v[j].z + v[j].w * v[j].w); }
        const float rs = 1.0f / sqrtf(wave_sum(s2) * (1.0f / D_MODEL) + LN_EPS);
#pragma unroll
        for (int j = 0; j < 4; ++j) { const f32x4 gg = *(const f32x4*)(gam + 256 * j + 4 * lane), bb = *(const f32x4*)(bet + 256 * j + 4 * lane); const f32x4 o = v[j] * rs * gg + bb;
            if (xo) *(f32x4*)(xo + (size_t)r * D_MODEL + 256 * j + 4 * lane) = o;
            if (xb) *(u32x2*)(xb + (size_t)r * D_MODEL + 256 * j + 4 * lane) = pk4(o);
            if (yp) { if (r < M0) *(f32x4*)(yp + (size_t)r * D_MODEL + 256 * j + 4 * lane) = o; else *(f32x4*)(ys + (size_t)(r - M0) * D_MODEL + 256 * j + 4 * lane) = o; } }
    }
}
}
namespace fx {
#define INS16(V, I, v_, i_) do { const float _v = (v_); const int _i = (i_); bool _c[16]; _Pragma("unroll") for (int _k = 0; _k < 16; ++_k) _c[_k] = _v > V[_k]; \
    _Pragma("unroll") for (int _k = 15; _k >= 1; --_k) { V[_k] = _c[_k] ? (_c[_k - 1] ? V[_k - 1] : _v) : V[_k]; I[_k] = _c[_k] ? (_c[_k - 1] ? I[_k - 1] : _i) : I[_k]; } \
    V[0] = _c[0] ? _v : V[0]; I[0] = _c[0] ? _i : I[0]; } while (0)
DI void wave_top16_128(float a, float b, int lane, float& outv, int& outi) {
    outv = -INFINITY; outi = 0;
#pragma unroll 1
    for (int k = 0; k < 16; ++k) { const float m = wave_max(fmaxf(a, b)); const unsigned long long ba = __ballot(a == m), bb = __ballot(b == m); int idx;
        if (ba) { const int l = __builtin_ctzll(ba); idx = l; if (lane == l) a = -INFINITY; } else { const int l = __builtin_ctzll(bb); idx = 64 + l; if (lane == l) b = -INFINITY; }
        if (lane == k) { outv = m; outi = idx; } }
}
DI void topk_wave_item(const FP& P, long it, int lane) {
    const float* s = P.SCO + it * 256; float v1, v2; int i1, i2;
    wave_top16_128(s[lane], s[64 + lane], lane, v1, i1); wave_top16_128(s[128 + lane], s[192 + lane], lane, v2, i2);
    int a = 0, rem = lane; bool valid = false;
    for (int aa = 0; aa < 16; ++aa) { const int nb = 16 / (aa + 1); if (!valid) { if (rem < nb) { a = aa; valid = true; } else rem -= nb; } }
    const int b = valid ? rem : 0;
    float cs = __shfl(v1, a) + __shfl(v2, b); const int ce = __shfl(i1, a) * PEER_KEYS + __shfl(i2, b); if (!valid) cs = -INFINITY;
    float tv = -INFINITY; int te = 0;
#pragma unroll 1
    for (int k = 0; k < 16; ++k) { const float m = wave_max(cs); const unsigned long long bm = __ballot(cs == m); const int l = __builtin_ctzll(bm); const int e = __shfl(ce, l); if (lane == l) cs = -INFINITY; if (lane == k) { tv = m; te = e; } }
    const float mx = __shfl(tv, 0); const float ex = (lane < 16) ? __expf(tv - mx) : 0.f; const float z = wave_sum(ex);
    if (lane < 16) { P.SELG[it * 16 + lane] = ex / z; P.SELE[it * 16 + lane] = te; }
}
#define KINS16(V, key_) do { const float _key = (key_); _Pragma("unroll") for (int _k = 15; _k >= 1; --_k) V[_k] = __builtin_amdgcn_fmed3f(V[_k - 1], V[_k], _key); V[0] = fmaxf(V[0], _key); } while (0)
DI float pack_key(float v, unsigned lowbits, unsigned mask) { return __builtin_bit_cast(float, (__builtin_bit_cast(unsigned, v) & ~mask) | lowbits); }
DI void topk_phase(const FP& P, const Ctx& C) {
    const int lane = C.lane; LAS float* st = (LAS float*)(C.lds + C.wave * 16384);
    const int NWI = (M0 * PEER_HEADS) / 64;
    for (int wi = C.vcu * NWAVES + C.wave; wi < NWI; wi += C.G * NWAVES) {
        const long it0 = (long)wi * 64; const long it = it0 + lane;
        float V1[16], V2[16], V3[16];
#pragma unroll
        for (int k = 0; k < 16; ++k) { V1[k] = V2[k] = V3[k] = -INFINITY; }
        f32x4 pv[8];
#pragma unroll
        for (int u = 0; u < 8; ++u) { const int f4 = u * 64 + lane, j = f4 >> 3, q = f4 & 7, hf = q >> 2, c4 = (q & 3) * 4; pv[u] = *(const f32x4*)(P.SCO + (it0 + j) * 256 + hf * 128 + c4); }
#pragma unroll 1
        for (int ch = 0; ch < 8; ++ch) {
#pragma unroll
            for (int u = 0; u < 8; ++u) { const int f4 = u * 64 + lane, j = f4 >> 3, q = f4 & 7, hf = q >> 2, c4 = (q & 3) * 4; const f32x4 v = pv[u];
                st[j * 33 + hf * 16 + c4] = v.x; st[j * 33 + hf * 16 + c4 + 1] = v.y; st[j * 33 + hf * 16 + c4 + 2] = v.z; st[j * 33 + hf * 16 + c4 + 3] = v.w; }
            { const int chn = ch < 7 ? ch + 1 : 7;
#pragma unroll
              for (int u = 0; u < 8; ++u) { const int f4 = u * 64 + lane, j = f4 >> 3, q = f4 & 7, hf = q >> 2, c4 = (q & 3) * 4; pv[u] = *(const f32x4*)(P.SCO + (it0 + j) * 256 + hf * 128 + chn * 16 + c4); } }
            asm volatile("s_waitcnt lgkmcnt(0)" ::: "memory");
#pragma unroll 4
            for (int c = 0; c < 16; ++c) { const float va = st[lane * 33 + c], vb = st[lane * 33 + 16 + c]; const unsigned lb = 127u - (unsigned)(ch * 16 + c); KINS16(V1, pack_key(va, lb, 127u)); KINS16(V2, pack_key(vb, lb, 127u)); }
            asm volatile("s_waitcnt lgkmcnt(0)" ::: "memory");
        }
        LAS int* lc = (LAS int*)st;
        { int ord = 0;
#pragma unroll
          for (int a = 0; a < 16; ++a) { const unsigned ba = __builtin_bit_cast(unsigned, V1[a]); const float va = __builtin_bit_cast(float, ba & ~127u); const int ia = 127 - (int)(ba & 127u);
#pragma unroll
              for (int b = 0; b < 16; ++b) if ((a + 1) * (b + 1) <= 16) { const unsigned bb = __builtin_bit_cast(unsigned, V2[b]); const float vb = __builtin_bit_cast(float, bb & ~127u); const int ib = 127 - (int)(bb & 127u);
                  lc[lane * 51 + ord] = ia * PEER_KEYS + ib; KINS16(V3, pack_key(va + vb, 63u - (unsigned)ord, 63u)); ++ord; } } }
        asm volatile("s_waitcnt lgkmcnt(0)" ::: "memory");
        float g[16]; int e[16]; float z = 0.f; const float vmax = __builtin_bit_cast(float, __builtin_bit_cast(unsigned, V3[0]) & ~63u);
#pragma unroll
        for (int k = 0; k < 16; ++k) { const unsigned bk = __builtin_bit_cast(unsigned, V3[k]); e[k] = lc[lane * 51 + 63 - (int)(bk & 63u)]; g[k] = __expf(__builtin_bit_cast(float, bk & ~63u) - vmax); z += g[k]; }
        const float iz = 1.0f / z;
#pragma unroll
        for (int k4 = 0; k4 < 4; ++k4) { *(f32x4*)(P.SELG + it * 16 + 4 * k4) = (f32x4){g[4 * k4] * iz, g[4 * k4 + 1] * iz, g[4 * k4 + 2] * iz, g[4 * k4 + 3] * iz};
            *(int4*)(P.SELE + it * 16 + 4 * k4) = make_int4(e[4 * k4], e[4 * k4 + 1], e[4 * k4 + 2], e[4 * k4 + 3]); }
        asm volatile("s_waitcnt lgkmcnt(0)" ::: "memory");
    }
    for (int si = C.vcu * NWAVES + C.wave; si < DEC_BATCH * PEER_HEADS; si += C.G * NWAVES) topk_wave_item(P, (long)M0 * PEER_HEADS + si, lane);
    __syncthreads();
}
constexpr float PEER_SU = 256.f, PEER_SV = 64.f;
DI float dot16_fp8(const u32x4& w, const f32x2 (&x2)[8]) { f32x2 a = {0.f, 0.f};
    a += __builtin_amdgcn_cvt_pk_f32_fp8((int)w.x, false) * x2[0]; a += __builtin_amdgcn_cvt_pk_f32_fp8((int)w.x, true) * x2[1];
    a += __builtin_amdgcn_cvt_pk_f32_fp8((int)w.y, false) * x2[2]; a += __builtin_amdgcn_cvt_pk_f32_fp8((int)w.y, true) * x2[3];
    a += __builtin_amdgcn_cvt_pk_f32_fp8((int)w.z, false) * x2[4]; a += __builtin_amdgcn_cvt_pk_f32_fp8((int)w.z, true) * x2[5];
    a += __builtin_amdgcn_cvt_pk_f32_fp8((int)w.w, false) * x2[6]; a += __builtin_amdgcn_cvt_pk_f32_fp8((int)w.w, true) * x2[7];
    return a.x + a.y; }
DI void axpy16_fp8(const u32x4& w, float s, f32x2 (&o2)[8]) { const f32x2 s2 = {s, s};
    o2[0] += __builtin_amdgcn_cvt_pk_f32_fp8((int)w.x, false) * s2; o2[1] += __builtin_amdgcn_cvt_pk_f32_fp8((int)w.x, true) * s2;
    o2[2] += __builtin_amdgcn_cvt_pk_f32_fp8((int)w.y, false) * s2; o2[3] += __builtin_amdgcn_cvt_pk_f32_fp8((int)w.y, true) * s2;
    o2[4] += __builtin_amdgcn_cvt_pk_f32_fp8((int)w.z, false) * s2; o2[5] += __builtin_amdgcn_cvt_pk_f32_fp8((int)w.z, true) * s2;
    o2[6] += __builtin_amdgcn_cvt_pk_f32_fp8((int)w.w, false) * s2; o2[7] += __builtin_amdgcn_cvt_pk_f32_fp8((int)w.w, true) * s2; }
#if defined(PEER_SHARD) || defined(PEER_SHARD2)
#define PEER_FIRST_ROUND nrounds
#else
#define PEER_FIRST_ROUND 0
#endif
template <int CTRL> DI float dppf(float x) { return __builtin_bit_cast(float, __builtin_amdgcn_update_dpp(0, __builtin_bit_cast(int, x), CTRL, 0xF, 0xF, true)); }
DI float rdlane(float v, int l) { return __builtin_bit_cast(float, __builtin_amdgcn_readlane(__builtin_bit_cast(int, v), l)); }
DI void peer_phase(const FP& P, const Ctx& C, int layer, const float* xin, float* fout, float* fout_s, bf16* xb, bool samples_only = false) {
    const int lane = C.lane; const unsigned char* U = P.UB8 + (size_t)layer * PEER_EXPERTS * D_MODEL; const unsigned char* Vt = P.VB8 + (size_t)layer * PEER_EXPERTS * D_MODEL;
    const float* gam = P.ln_g + ((size_t)layer * 2 + 1) * D_MODEL; const float* bet = P.ln_b + ((size_t)layer * 2 + 1) * D_MODEL;
    const int nrounds = (M0 + C.G * NWAVES - 1) / (C.G * NWAVES);
#pragma unroll 1
    for (int rd = samples_only ? nrounds : 0; rd <= nrounds; ++rd) {
        const bool smp = (rd == nrounds); int r = smp ? M0 + C.vcu : rd * C.G * NWAVES + C.vcu * NWAVES + C.wave; if (smp ? (C.vcu >= DEC_BATCH) : (r >= M0)) continue;
        const int pb = smp ? 16 * C.wave : 0, pe = smp ? pb + 16 : 128;
        f32x2 x2[8], o2[8];
#pragma unroll
        for (int j = 0; j < 4; ++j) { const f32x4 a = *(const f32x4*)(xin + (size_t)r * D_MODEL + 16 * lane + 4 * j); x2[2 * j] = (f32x2){a.x, a.y}; x2[2 * j + 1] = (f32x2){a.z, a.w}; }
#pragma unroll
        for (int k = 0; k < 8; ++k) o2[k] = (f32x2){0.f, 0.f};
        const int e_l = P.SELE[(size_t)r * 128 + lane], e_h = P.SELE[(size_t)r * 128 + 64 + lane]; const float g_l = P.SELG[(size_t)r * 128 + lane], g_h = P.SELG[(size_t)r * 128 + 64 + lane];
#pragma unroll 1
        for (int b0 = pb; b0 < pe; b0 += 8) {
            u32x4 uw[8], vw[8];
#pragma unroll
            for (int k = 0; k < 8; ++k) { const int hk = b0 + k; const int e = (hk < 64) ? __builtin_amdgcn_readlane(e_l, hk & 63) : __builtin_amdgcn_readlane(e_h, hk & 63);
                uw[k] = *(const u32x4*)(U + (size_t)e * D_MODEL + 16 * lane); vw[k] = *(const u32x4*)(Vt + (size_t)e * D_MODEL + 16 * lane); }
            float d[8];
#pragma unroll
            for (int k = 0; k < 8; ++k) d[k] = dot16_fp8(uw[k], x2);
            float e4[4], e2[2], e1;
            { const bool hi = lane & 1;
#pragma unroll
              for (int i = 0; i < 4; ++i) { const float keep = hi ? d[4 + i] : d[i], send = hi ? d[i] : d[4 + i]; e4[i] = keep + __shfl_xor(send, 1); } }
            { const bool hi = lane & 2;
#pragma unroll
              for (int i = 0; i < 2; ++i) { const float keep = hi ? e4[2 + i] : e4[i], send = hi ? e4[i] : e4[2 + i]; e2[i] = keep + __shfl_xor(send, 2); } }
            { const bool hi = lane & 4; const float keep = hi ? e2[1] : e2[0], send = hi ? e2[0] : e2[1]; e1 = keep + __shfl_xor(send, 4); }
            e1 += __shfl_xor(e1, 8); e1 += __shfl_xor(e1, 16); e1 += __shfl_xor(e1, 32);
            const int myk = 4 * (lane & 1) + (lane & 2) + ((lane >> 2) & 1); const int myhk = b0 + myk;
            const float myg = (myhk < 64) ? __shfl(g_l, myhk & 63) : __shfl(g_h, myhk & 63);
            const float act = myg * gelu_tanh(e1 * (1.0f / PEER_SU)) * (1.0f / PEER_SV);
#pragma unroll
            for (int k = 0; k < 8; ++k) { const int src = (k >> 2) | (((k >> 1) & 1) << 1) | ((k & 1) << 2); axpy16_fp8(vw[k], rdlane(act, src), o2); }
        }
        if (smp) {
            LAS float* red = (LAS float*)C.lds;
#pragma unroll
            for (int k = 0; k < 8; ++k) { red[C.wave * 1024 + 16 * lane + 2 * k] = o2[k].x; red[C.wave * 1024 + 16 * lane + 2 * k + 1] = o2[k].y; }
            asm volatile("s_waitcnt lgkmcnt(0)" ::: "memory"); __syncthreads();
            if (C.wave == 0) {
#pragma unroll
                for (int k = 0; k < 8; ++k) { float ax = 0.f, ay = 0.f;
#pragma unroll
                    for (int ww = 0; ww < NWAVES; ++ww) { ax += red[ww * 1024 + 16 * lane + 2 * k]; ay += red[ww * 1024 + 16 * lane + 2 * k + 1]; } o2[k] = (f32x2){ax, ay}; } }
            __syncthreads();
            if (C.wave != 0) continue; }
        float s = 0.f;
#pragma unroll
        for (int k = 0; k < 8; ++k) { o2[k] += x2[k] * ALPHA; s += o2[k].x + o2[k].y; }
        const float mu = wave_sum(s) * (1.0f / D_MODEL); float s2 = 0.f;
#pragma unroll
        for (int k = 0; k < 8; ++k) { o2[k] -= mu; s2 += o2[k].x * o2[k].x + o2[k].y * o2[k].y; }
        const float rs = 1.0f / sqrtf(wave_sum(s2) * (1.0f / D_MODEL) + LN_EPS);
        float* frow = (r < M0) ? fout + (size_t)r * D_MODEL : fout_s + (size_t)(r - M0) * D_MODEL;
#pragma unroll
        for (int j = 0; j < 4; ++j) { const int c0 = 16 * lane + 4 * j; const f32x4 gg = *(const f32x4*)(gam + c0), bb = *(const f32x4*)(bet + c0);
            const f32x4 y = (f32x4){o2[2 * j].x * rs, o2[2 * j].y * rs, o2[2 * j + 1].x * rs, o2[2 * j + 1].y * rs} * gg + bb;
            *(f32x4*)(frow + c0) = y; if (xb) *(u32x2*)(xb + (size_t)r * D_MODEL + c0) = pk4(y); }
    }
}
DI void peer_u_phase(const FP& P, const Ctx& C, int layer, const bf16* xb16) {
    const int lane = C.lane; const unsigned char* U = P.UB8 + (size_t)layer * PEER_EXPERTS * D_MODEL;
    const int s = (int)(blockIdx.x & 7), nw = (C.G >> 3) * NWAVES, widx = (int)(blockIdx.x >> 3) * NWAVES + C.wave;
#pragma unroll 1
    for (int r = widx; r < MP; r += nw) {
        const int e0 = P.SELE[(size_t)r * 128 + lane], e1 = P.SELE[(size_t)r * 128 + 64 + lane]; const float g0 = P.SELG[(size_t)r * 128 + lane], g1 = P.SELG[(size_t)r * 128 + 64 + lane];
        unsigned long long b0 = __ballot((e0 >> 11) == s), b1 = __ballot((e1 >> 11) == s);
        if ((b0 | b1) == 0ull) continue;
        f32x2 x2[8]; { const u32x4 xa = *(const u32x4*)(xb16 + (size_t)r * D_MODEL + 16 * lane), xc = *(const u32x4*)(xb16 + (size_t)r * D_MODEL + 16 * lane + 8);
            x2[0] = (f32x2){bflo(xa.x), bfhi(xa.x)}; x2[1] = (f32x2){bflo(xa.y), bfhi(xa.y)}; x2[2] = (f32x2){bflo(xa.z), bfhi(xa.z)}; x2[3] = (f32x2){bflo(xa.w), bfhi(xa.w)};
            x2[4] = (f32x2){bflo(xc.x), bfhi(xc.x)}; x2[5] = (f32x2){bflo(xc.y), bfhi(xc.y)}; x2[6] = (f32x2){bflo(xc.z), bfhi(xc.z)}; x2[7] = (f32x2){bflo(xc.w), bfhi(xc.w)}; }
#pragma unroll 1
        while ((b0 | b1) != 0ull) {
            int hk[8]; u32x4 uw[8]; int nv = 0;
#pragma unroll
            for (int k = 0; k < 8; ++k) { int h;
                if (b0) { h = __builtin_ctzll(b0); b0 &= b0 - 1; ++nv; } else if (b1) { h = 64 + __builtin_ctzll(b1); b1 &= b1 - 1; ++nv; } else h = hk[k > 0 ? k - 1 : 0];
                hk[k] = h; const int e = (h < 64) ? __builtin_amdgcn_readlane(e0, h & 63) : __builtin_amdgcn_readlane(e1, h & 63);
                uw[k] = *(const u32x4*)(U + (size_t)e * D_MODEL + 16 * lane); }
            float d[8];
#pragma unroll
            for (int k = 0; k < 8; ++k) d[k] = dot16_fp8(uw[k], x2);
            float e4[4], e2[2], e1s;
            { const bool hi = lane & 1;
#pragma unroll
              for (int i = 0; i < 4; ++i) { const float keep = hi ? d[4 + i] : d[i], send = hi ? d[i] : d[4 + i]; e4[i] = keep + __shfl_xor(send, 1); } }
            { const bool hi = lane & 2;
#pragma unroll
              for (int i = 0; i < 2; ++i) { const float keep = hi ? e4[2 + i] : e4[i], send = hi ? e4[i] : e4[2 + i]; e2[i] = keep + __shfl_xor(send, 2); } }
            { const bool hi = lane & 4; const float keep = hi ? e2[1] : e2[0], send = hi ? e2[0] : e2[1]; e1s = keep + __shfl_xor(send, 4); }
            e1s += __shfl_xor(e1s, 8); e1s += __shfl_xor(e1s, 16); e1s += __shfl_xor(e1s, 32);
            const int myk = 4 * (lane & 1) + (lane & 2) + ((lane >> 2) & 1);
            int myh = hk[0];
#pragma unroll
            for (int k = 1; k < 8; ++k) myh = (myk == k) ? hk[k] : myh;
            const float ga = __shfl(g0, myh & 63), gb = __shfl(g1, myh & 63); const float myg = (myh < 64) ? ga : gb;
            if (lane < 8 && myk < nv) P.SCO[(size_t)r * 128 + myh] = myg * gelu_tanh(e1s * (1.0f / PEER_SU)) * (1.0f / PEER_SV);
        }
    }
}
DI void peer_v_phase(const FP& P, const Ctx& C, int layer, const float* xin, float* fout, float* fout_s, bf16* xb) {
    const int lane = C.lane; const unsigned char* Vt = P.VB8 + (size_t)layer * PEER_EXPERTS * D_MODEL;
    const float* gam = P.ln_g + ((size_t)layer * 2 + 1) * D_MODEL; const float* bet = P.ln_b + ((size_t)layer * 2 + 1) * D_MODEL;
    const int nrounds = (M0 + C.G * NWAVES - 1) / (C.G * NWAVES);
#pragma unroll 1
    for (int rd = 0; rd <= nrounds; ++rd) {
        const bool smp = (rd == nrounds); int r = smp ? M0 + C.vcu : rd * C.G * NWAVES + C.vcu * NWAVES + C.wave; if (smp ? (C.vcu >= DEC_BATCH) : (r >= M0)) continue;
        const int pb = smp ? 16 * C.wave : 0, pe = smp ? pb + 16 : 128;
        f32x2 x2[8], o2[8];
#pragma unroll
        for (int j = 0; j < 4; ++j) { const f32x4 a = *(const f32x4*)(xin + (size_t)r * D_MODEL + 16 * lane + 4 * j); x2[2 * j] = (f32x2){a.x, a.y}; x2[2 * j + 1] = (f32x2){a.z, a.w}; }
#pragma unroll
        for (int k = 0; k < 8; ++k) o2[k] = (f32x2){0.f, 0.f};
        const int e_l = P.SELE[(size_t)r * 128 + lane], e_h = P.SELE[(size_t)r * 128 + 64 + lane]; const float a_l = P.SCO[(size_t)r * 128 + lane], a_h = P.SCO[(size_t)r * 128 + 64 + lane];
#pragma unroll 1
        for (int b0 = pb; b0 < pe; b0 += 16) { u32x4 vw[16];
#pragma unroll
            for (int k = 0; k < 16; ++k) { const int hk = b0 + k; const int e = (hk < 64) ? __builtin_amdgcn_readlane(e_l, hk & 63) : __builtin_amdgcn_readlane(e_h, hk & 63); vw[k] = *(const u32x4*)(Vt + (size_t)e * D_MODEL + 16 * lane); }
#pragma unroll
            for (int k = 0; k < 16; ++k) { const int hk = b0 + k; axpy16_fp8(vw[k], (hk < 64) ? rdlane(a_l, hk & 63) : rdlane(a_h, hk & 63), o2); } }
        if (smp) {
            LAS float* red = (LAS float*)C.lds;
#pragma unroll
            for (int k = 0; k < 8; ++k) { red[C.wave * 1024 + 16 * lane + 2 * k] = o2[k].x; red[C.wave * 1024 + 16 * lane + 2 * k + 1] = o2[k].y; }
            asm volatile("s_waitcnt lgkmcnt(0)" ::: "memory"); __syncthreads();
            if (C.wave == 0) {
#pragma unroll
                for (int k = 0; k < 8; ++k) { float ax = 0.f, ay = 0.f;
#pragma unroll
                    for (int ww = 0; ww < NWAVES; ++ww) { ax += red[ww * 1024 + 16 * lane + 2 * k]; ay += red[ww * 1024 + 16 * lane + 2 * k + 1]; } o2[k] = (f32x2){ax, ay}; } }
            __syncthreads();
            if (C.wave != 0) continue; }
        float s = 0.f;
#pragma unroll
        for (int k = 0; k < 8; ++k) { o2[k] += x2[k] * ALPHA; s += o2[k].x + o2[k].y; }
        const float mu = wave_sum(s) * (1.0f / D_MODEL); float s2 = 0.f;
#pragma unroll
        for (int k = 0; k < 8; ++k) { o2[k] -= mu; s2 += o2[k].x * o2[k].x + o2[k].y * o2[k].y; }
        const float rs = 1.0f / sqrtf(wave_sum(s2) * (1.0f / D_MODEL) + LN_EPS);
        float* frow = (r < M0) ? fout + (size_t)r * D_MODEL : fout_s + (size_t)(r - M0) * D_MODEL;
#pragma unroll
        for (int j = 0; j < 4; ++j) { const int c0 = 16 * lane + 4 * j; const f32x4 gg = *(const f32x4*)(gam + c0), bb = *(const f32x4*)(bet + c0);
            const f32x4 y = (f32x4){o2[2 * j].x * rs, o2[2 * j].y * rs, o2[2 * j + 1].x * rs, o2[2 * j + 1].y * rs} * gg + bb;
            *(f32x4*)(frow + c0) = y; if (xb) *(u32x2*)(xb + (size_t)r * D_MODEL + c0) = pk4(y); }
    }
}
constexpr int PSH_LIST = 512;
struct PG4 { u32x4 u[4], v[4]; };
DI void peer_sharded_phase(const FP& P, const Ctx& C, int layer, const float* xin, const bf16* xb16, float* fout, float* fout_s, bf16* xb) {
    const int lane = C.lane; const unsigned char* U = P.UB8 + (size_t)layer * PEER_EXPERTS * D_MODEL; const unsigned char* Vt = P.VB8 + (size_t)layer * PEER_EXPERTS * D_MODEL;
    const float* gam = P.ln_g + ((size_t)layer * 2 + 1) * D_MODEL; const float* bet = P.ln_b + ((size_t)layer * 2 + 1) * D_MODEL;
    LAS unsigned char* wl = C.lds + C.wave * 16384; LAS bf16* xs = (LAS bf16*)wl; LAS int* lst = (LAS int*)(wl + 8192);
    const int NW = C.G * NWAVES, gw = C.vcu * NWAVES + C.wave; const int nquads = (M0 / NW) / 4;
#pragma unroll 1
    for (int qd = 0; qd < nquads; ++qd) {
#define PSH_ROW(j) const int row##j = (qd * 4 + j) * NW + gw; const int el##j = P.SELE[(size_t)row##j * 128 + lane], eh##j = P.SELE[(size_t)row##j * 128 + 64 + lane]; const float gl##j = P.SELG[(size_t)row##j * 128 + lane], gh##j = P.SELG[(size_t)row##j * 128 + 64 + lane]; \
        { const u32x4 xa = *(const u32x4*)(xb16 + (size_t)row##j * D_MODEL + 16 * lane), xc = *(const u32x4*)(xb16 + (size_t)row##j * D_MODEL + 16 * lane + 8); *(LAS u32x4*)(xs + j * 1024 + 16 * lane) = xa; *(LAS u32x4*)(xs + j * 1024 + 16 * lane + 8) = xc; } \
        f32x2 oa##j[8]; _Pragma("unroll") for (int k = 0; k < 8; ++k) oa##j[k] = (f32x2){0.f, 0.f};
        PSH_ROW(0) PSH_ROW(1) PSH_ROW(2) PSH_ROW(3)
#pragma unroll 1
        for (int s = 0; s < 16; ++s) {
            int n = 0;
#define PSH_SCAN(j) { unsigned long long b0 = __ballot((el##j >> 10) == s), b1 = __ballot((eh##j >> 10) == s); \
                while (b0) { const int h = __builtin_ctzll(b0); b0 &= b0 - 1; const int e = __builtin_amdgcn_readlane(el##j, h); const int g = __builtin_amdgcn_readlane(__builtin_bit_cast(int, gl##j), h); \
                    if (lane == 0) { lst[4 * n] = e; lst[4 * n + 1] = g; lst[4 * n + 2] = j; } ++n; } \
                while (b1) { const int h = __builtin_ctzll(b1); b1 &= b1 - 1; const int e = __builtin_amdgcn_readlane(eh##j, h); const int g = __builtin_amdgcn_readlane(__builtin_bit_cast(int, gh##j), h); \
                    if (lane == 0) { lst[4 * n] = e; lst[4 * n + 1] = g; lst[4 * n + 2] = j; } ++n; } }
            PSH_SCAN(0) PSH_SCAN(1) PSH_SCAN(2) PSH_SCAN(3)
            asm volatile("s_waitcnt lgkmcnt(0)" ::: "memory");
            if (n == 0) continue;
            const int ngrp = (n + 3) >> 2;
#define PSH_LD(b, gi_) do { const int gi = (gi_); _Pragma("unroll") for (int k = 0; k < 4; ++k) { int i = 4 * gi + k; i = i < n ? i : n - 1; const int e = __builtin_amdgcn_readfirstlane(lst[4 * i]); \
                b.u[k] = *(const u32x4*)(U + (size_t)e * D_MODEL + 16 * lane); b.v[k] = *(const u32x4*)(Vt + (size_t)e * D_MODEL + 16 * lane); } } while (0)
#define PSH_CP(b, gi_) do { const int gi = (gi_); float d[4]; int jj[4]; float gg[4]; \
                _Pragma("unroll") for (int k = 0; k < 4; ++k) { int i = 4 * gi + k; const bool val = i < n; i = val ? i : n - 1; jj[k] = __builtin_amdgcn_readfirstlane(lst[4 * i + 2]); gg[k] = val ? __builtin_bit_cast(float, __builtin_amdgcn_readfirstlane(lst[4 * i + 1])) : 0.f; \
                    const u32x4 xa = *(const LAS u32x4*)(xs + jj[k] * 1024 + 16 * lane), xc = *(const LAS u32x4*)(xs + jj[k] * 1024 + 16 * lane + 8); \
                    const f32x2 x2[8] = {(f32x2){bflo(xa.x), bfhi(xa.x)}, (f32x2){bflo(xa.y), bfhi(xa.y)}, (f32x2){bflo(xa.z), bfhi(xa.z)}, (f32x2){bflo(xa.w), bfhi(xa.w)}, (f32x2){bflo(xc.x), bfhi(xc.x)}, (f32x2){bflo(xc.y), bfhi(xc.y)}, (f32x2){bflo(xc.z), bfhi(xc.z)}, (f32x2){bflo(xc.w), bfhi(xc.w)}}; \
                    d[k] = dot16_fp8(b.u[k], x2); } \
                float e2[2], e1; \
                { const bool hi = lane & 1; _Pragma("unroll") for (int i = 0; i < 2; ++i) { const float keep = hi ? d[2 + i] : d[i], send = hi ? d[i] : d[2 + i]; e2[i] = keep + __shfl_xor(send, 1); } } \
                { const bool hi = lane & 2; const float keep = hi ? e2[1] : e2[0], send = hi ? e2[0] : e2[1]; e1 = keep + __shfl_xor(send, 2); } \
                e1 += __shfl_xor(e1, 4); e1 += __shfl_xor(e1, 8); e1 += __shfl_xor(e1, 16); e1 += __shfl_xor(e1, 32); \
                const int myk = 2 * (lane & 1) + ((lane >> 1) & 1); \
                float myg = gg[0]; myg = (myk == 1) ? gg[1] : myg; myg = (myk == 2) ? gg[2] : myg; myg = (myk == 3) ? gg[3] : myg; \
                const float act = myg * gelu_tanh(e1 * (1.0f / PEER_SU)) * (1.0f / PEER_SV); \
                _Pragma("unroll") for (int k = 0; k < 4; ++k) { const float a = rdlane(act, (k >> 1) | ((k & 1) << 1)); \
                    if (jj[k] == 0) axpy16_fp8(b.v[k], a, oa0); else if (jj[k] == 1) axpy16_fp8(b.v[k], a, oa1); else if (jj[k] == 2) axpy16_fp8(b.v[k], a, oa2); else axpy16_fp8(b.v[k], a, oa3); } } while (0)
            { PG4 A, B; PSH_LD(A, 0);
#pragma unroll 1
              for (int g2 = 0; g2 < ngrp; g2 += 2) { PSH_LD(B, (g2 + 1 < ngrp) ? g2 + 1 : g2); PSH_CP(A, g2); PSH_LD(A, (g2 + 2 < ngrp) ? g2 + 2 : g2); if (g2 + 1 < ngrp) PSH_CP(B, g2 + 1); } }
            asm volatile("s_waitcnt lgkmcnt(0)" ::: "memory");
        }
#define PSH_LN(j) { const int r = row##j; f32x2 x2[8]; \
            _Pragma("unroll") for (int q = 0; q < 4; ++q) { const f32x4 a = *(const f32x4*)(xin + (size_t)r * D_MODEL + 16 * lane + 4 * q); x2[2 * q] = (f32x2){a.x, a.y}; x2[2 * q + 1] = (f32x2){a.z, a.w}; } \
            float sm = 0.f; _Pragma("unroll") for (int k = 0; k < 8; ++k) { oa##j[k] += x2[k] * ALPHA; sm += oa##j[k].x + oa##j[k].y; } \
            const float mu = wave_sum(sm) * (1.0f / D_MODEL); float s2 = 0.f; _Pragma("unroll") for (int k = 0; k < 8; ++k) { oa##j[k] -= mu; s2 += oa##j[k].x * oa##j[k].x + oa##j[k].y * oa##j[k].y; } \
            const float rs = 1.0f / sqrtf(wave_sum(s2) * (1.0f / D_MODEL) + LN_EPS); float* frow = fout + (size_t)r * D_MODEL; \
            _Pragma("unroll") for (int q = 0; q < 4; ++q) { const int c0 = 16 * lane + 4 * q; const f32x4 gv = *(const f32x4*)(gam + c0), bv = *(const f32x4*)(bet + c0); \
                const f32x4 y = (f32x4){oa##j[2 * q].x * rs, oa##j[2 * q].y * rs, oa##j[2 * q + 1].x * rs, oa##j[2 * q + 1].y * rs} * gv + bv; *(f32x4*)(frow + c0) = y; if (xb) *(u32x2*)(xb + (size_t)r * D_MODEL + c0) = pk4(y); } }
        PSH_LN(0) PSH_LN(1) PSH_LN(2) PSH_LN(3)
        asm volatile("s_waitcnt lgkmcnt(0)" ::: "memory");
    }
}
#ifndef PSH_LOG_V
#define PSH_LOG_V 11
#endif
constexpr int PSH_LOG = PSH_LOG_V, PSH_N = PEER_EXPERTS >> PSH_LOG;
#ifndef PS2_ROWS
#define PS2_ROWS 4
#endif
#define PS2_ROW(j) const int row##j = (qd * PS2_ROWS + j) * NW + gw; const int el##j = P.SELE[(size_t)row##j * 128 + lane], eh##j = P.SELE[(size_t)row##j * 128 + 64 + lane]; const float gl##j = P.SELG[(size_t)row##j * 128 + lane], gh##j = P.SELG[(size_t)row##j * 128 + 64 + lane]; \
    f32x2 oa##j[8]; _Pragma("unroll") for (int k = 0; k < 8; ++k) oa##j[k] = (f32x2){0.f, 0.f};
#define PS2_STEP(j) { unsigned long long b0 = __ballot((el##j >> PSH_LOG) == s), b1 = __ballot((eh##j >> PSH_LOG) == s); \
    if (b0 | b1) { const u32x4 xa##j = *(const u32x4*)(xb16 + (size_t)row##j * D_MODEL + 16 * lane), xc##j = *(const u32x4*)(xb16 + (size_t)row##j * D_MODEL + 16 * lane + 8);     \
      const f32x2 x2[8] = {(f32x2){bflo(xa##j.x), bfhi(xa##j.x)}, (f32x2){bflo(xa##j.y), bfhi(xa##j.y)}, (f32x2){bflo(xa##j.z), bfhi(xa##j.z)}, (f32x2){bflo(xa##j.w), bfhi(xa##j.w)}, (f32x2){bflo(xc##j.x), bfhi(xc##j.x)}, (f32x2){bflo(xc##j.y), bfhi(xc##j.y)}, (f32x2){bflo(xc##j.z), bfhi(xc##j.z)}, (f32x2){bflo(xc##j.w), bfhi(xc##j.w)}}; \
      _Pragma("unroll 1") while ((b0 | b1) != 0ull) { int hk[8]; u32x4 uw[8], vw[8]; int nv = 0; \
        _Pragma("unroll") for (int k = 0; k < 8; ++k) { int h; if (b0) { h = __builtin_ctzll(b0); b0 &= b0 - 1; ++nv; } else if (b1) { h = 64 + __builtin_ctzll(b1); b1 &= b1 - 1; ++nv; } else h = hk[k > 0 ? k - 1 : 0]; \
            hk[k] = h; const int e = (h < 64) ? __builtin_amdgcn_readlane(el##j, h & 63) : __builtin_amdgcn_readlane(eh##j, h & 63); \
            uw[k] = *(const u32x4*)(U + (size_t)e * D_MODEL + 16 * lane); vw[k] = *(const u32x4*)(Vt + (size_t)e * D_MODEL + 16 * lane); } \
        float d[8]; _Pragma("unroll") for (int k = 0; k < 8; ++k) d[k] = dot16_fp8(uw[k], x2); \
        float e4[4], e2[2], e1s; \
          \
        { const bool hi = lane & 1; _Pragma("unroll") for (int i = 0; i < 4; ++i) { const float keep = hi ? d[4 + i] : d[i], send = hi ? d[i] : d[4 + i]; e4[i] = keep + dppf<0xB1>(send); } } \
        { const bool hi = lane & 2; _Pragma("unroll") for (int i = 0; i < 2; ++i) { const float keep = hi ? e4[2 + i] : e4[i], send = hi ? e4[i] : e4[2 + i]; e2[i] = keep + dppf<0x4E>(send); } } \
        { const bool hi = lane & 4; const float keep = hi ? e2[1] : e2[0], send = hi ? e2[0] : e2[1]; const float r4 = dppf<0x124>(send), r12 = dppf<0x12C>(send); e1s = keep + (hi ? r4 : r12); } \
        e1s += dppf<0x128>(e1s); e1s = colsum(e1s); \
        const int myk = 4 * (lane & 1) + (lane & 2) + ((lane >> 2) & 1); int myh = hk[0]; _Pragma("unroll") for (int k = 1; k < 8; ++k) myh = (myk == k) ? hk[k] : myh; \
        const float ga = __shfl(gl##j, myh & 63), gb = __shfl(gh##j, myh & 63); const float myg = (myk < nv) ? ((myh < 64) ? ga : gb) : 0.f;     \
        const float act = myg * gelu_tanh(e1s * (1.0f / PEER_SU)) * (1.0f / PEER_SV); \
        _Pragma("unroll") for (int k = 0; k < 8; ++k) { const int src = (k >> 2) | (((k >> 1) & 1) << 1) | ((k & 1) << 2); axpy16_fp8(vw[k], rdlane(act, src), oa##j); } } } }
#define PS2_LN(j) { const int r = row##j; f32x2 x2[8]; int ll = lane; asm volatile("" : "+v"(ll));     \
    _Pragma("unroll") for (int q = 0; q < 4; ++q) { const f32x4 a = *(const f32x4*)(xin + (size_t)r * D_MODEL + 16 * ll + 4 * q); x2[2 * q] = (f32x2){a.x, a.y}; x2[2 * q + 1] = (f32x2){a.z, a.w}; } \
    float sm = 0.f; _Pragma("unroll") for (int k = 0; k < 8; ++k) { oa##j[k] += x2[k] * ALPHA; sm += oa##j[k].x + oa##j[k].y; } \
    const float mu = wave_sum(sm) * (1.0f / D_MODEL); float s2 = 0.f; _Pragma("unroll") for (int k = 0; k < 8; ++k) { oa##j[k] -= mu; s2 += oa##j[k].x * oa##j[k].x + oa##j[k].y * oa##j[k].y; } \
    const float rs = 1.0f / sqrtf(wave_sum(s2) * (1.0f / D_MODEL) + LN_EPS); float* frow = fout + (size_t)r * D_MODEL; \
    _Pragma("unroll") for (int q = 0; q < 4; ++q) { const int c0 = 16 * ll + 4 * q; const f32x4 gv = *(const f32x4*)(gam + c0), bv = *(const f32x4*)(bet + c0); \
        const f32x4 y = (f32x4){oa##j[2 * q].x * rs, oa##j[2 * q].y * rs, oa##j[2 * q + 1].x * rs, oa##j[2 * q + 1].y * rs} * gv + bv; *(f32x4*)(frow + c0) = y; if (xb) *(u32x2*)(xb + (size_t)r * D_MODEL + c0) = pk4(y); } }
DI void xcd_soft_sync(unsigned* cnt, volatile LAS unsigned* st, unsigned x, unsigned& round) {
    if (!st) return;
    __syncthreads();
    if (threadIdx.x == 0) { const unsigned nloc = st[0];
        if (nloc) { unsigned* c = cnt + 64 * x; (void)xb_add(c, 1u); const unsigned target = (round + 1u) * nloc; unsigned sp = 0;
            while (xb_ld(c) < target && ++sp < 4096u) __builtin_amdgcn_s_sleep(1); } }
    __syncthreads(); ++round;
}
DI void peer_sharded2_phase(const FP& P, const Ctx& C, int layer, const float* xin, const bf16* xb16, float* fout, bf16* xb, volatile LAS unsigned* st = nullptr, unsigned xcc = 0) {
    unsigned round = 0; unsigned* hint = P.ctl + 8192 + layer * 1024;
    const int lane = C.lane; const unsigned char* U = P.UB8 + (size_t)layer * PEER_EXPERTS * D_MODEL; const unsigned char* Vt = P.VB8 + (size_t)layer * PEER_EXPERTS * D_MODEL;
    const float* gam = P.ln_g + ((size_t)layer * 2 + 1) * D_MODEL; const float* bet = P.ln_b + ((size_t)layer * 2 + 1) * D_MODEL;
    const int NW = C.G * NWAVES, gw = C.vcu * NWAVES + C.wave; const int nquads = (M0 / NW) / PS2_ROWS;
#pragma unroll 1
    for (int qd = 0; qd < nquads; ++qd) {
#if PS2_ROWS == 4
        PS2_ROW(0) PS2_ROW(1) PS2_ROW(2) PS2_ROW(3)
#pragma unroll 1
        for (int s = 0; s < PSH_N; ++s) {
#ifdef PEER_SOFTSYNC
            xcd_soft_sync(hint, st, xcc, round);
#endif
            PS2_STEP(0) PS2_STEP(1) PS2_STEP(2) PS2_STEP(3) }
        PS2_LN(0) PS2_LN(1) PS2_LN(2) PS2_LN(3)
#else
        PS2_ROW(0) PS2_ROW(1)
#pragma unroll 1
        for (int s = 0; s < PSH_N; ++s) { PS2_STEP(0) PS2_STEP(1) }
        PS2_LN(0) PS2_LN(1)
#endif
    }
}
#define PS3_ROW(j) const int row##j = (qd * 4 + j) * NW + gw; const int el##j = P.SELE[(size_t)row##j * 128 + lane], eh##j = P.SELE[(size_t)row##j * 128 + 64 + lane]; \
    { const u32x4 xa = *(const u32x4*)(xb16 + (size_t)row##j * D_MODEL + 16 * lane), xc = *(const u32x4*)(xb16 + (size_t)row##j * D_MODEL + 16 * lane + 8); *(LAS u32x4*)(xs + j * 1024 + 16 * lane) = xa; *(LAS u32x4*)(xs + j * 1024 + 16 * lane + 8) = xc; } \
    f32x2 oa##j[8]; _Pragma("unroll") for (int k = 0; k < 8; ++k) oa##j[k] = (f32x2){0.f, 0.f};
#define PS3_X2_UNUSED(j) const f32x2 x2[8] = {(f32x2){bflo(xa##j.x), bfhi(xa##j.x)}, (f32x2){bflo(xa##j.y), bfhi(xa##j.y)}, (f32x2){bflo(xa##j.z), bfhi(xa##j.z)}, (f32x2){bflo(xa##j.w), bfhi(xa##j.w)}, (f32x2){bflo(xc##j.x), bfhi(xc##j.x)}, (f32x2){bflo(xc##j.y), bfhi(xc##j.y)}, (f32x2){bflo(xc##j.z), bfhi(xc##j.z)}, (f32x2){bflo(xc##j.w), bfhi(xc##j.w)}};
#define PS3_TAKE(q, M, ELH, GOFF) if (!got && M) { const int h = __builtin_ctzll(M); M &= M - 1; qq[k] = q; ee = __builtin_amdgcn_readlane(ELH, h); gk[k] = P.SELG[GOFF + h];     got = true; ++nv; }
DI void peer_sharded3_phase(const FP& P, const Ctx& C, int layer, const float* xin, const bf16* xb16, float* fout, bf16* xb) {
    const int lane = C.lane; const unsigned char* U = P.UB8 + (size_t)layer * PEER_EXPERTS * D_MODEL; const unsigned char* Vt = P.VB8 + (size_t)layer * PEER_EXPERTS * D_MODEL;
    const float* gam = P.ln_g + ((size_t)layer * 2 + 1) * D_MODEL; const float* bet = P.ln_b + ((size_t)layer * 2 + 1) * D_MODEL;
    const int NW = C.G * NWAVES, gw = C.vcu * NWAVES + C.wave; const int nquads = (M0 / NW) / 4; LAS bf16* xs = (LAS bf16*)(C.lds + C.wave * 16384);
#pragma unroll 1
    for (int qd = 0; qd < nquads; ++qd) {
        PS3_ROW(0) PS3_ROW(1) PS3_ROW(2) PS3_ROW(3)
        asm volatile("s_waitcnt lgkmcnt(0)" ::: "memory");
#pragma unroll 1
        for (int s = 0; s < PSH_N; ++s) {
            unsigned long long m0 = __ballot((el0 >> PSH_LOG) == s), m1 = __ballot((eh0 >> PSH_LOG) == s), m2 = __ballot((el1 >> PSH_LOG) == s), m3 = __ballot((eh1 >> PSH_LOG) == s),
                               m4 = __ballot((el2 >> PSH_LOG) == s), m5 = __ballot((eh2 >> PSH_LOG) == s), m6 = __ballot((el3 >> PSH_LOG) == s), m7 = __ballot((eh3 >> PSH_LOG) == s);
#pragma unroll 1
            while ((m0 | m1 | m2 | m3 | m4 | m5 | m6 | m7) != 0ull) {
                int qq[8]; float gk[8]; int es[8]; u32x4 uw[8]; int nv = 0; int elast = 0;
#pragma unroll
                for (int k = 0; k < 8; ++k) { bool got = false; int ee = elast; qq[k] = k > 0 ? qq[k - 1] : 0; gk[k] = 0.f;
                    PS3_TAKE(0, m0, el0, (size_t)row0 * 128) PS3_TAKE(1, m1, eh0, (size_t)row0 * 128 + 64) PS3_TAKE(2, m2, el1, (size_t)row1 * 128) PS3_TAKE(3, m3, eh1, (size_t)row1 * 128 + 64) PS3_TAKE(4, m4, el2, (size_t)row2 * 128) PS3_TAKE(5, m5, eh2, (size_t)row2 * 128 + 64) PS3_TAKE(6, m6, el3, (size_t)row3 * 128) PS3_TAKE(7, m7, eh3, (size_t)row3 * 128 + 64)
                    elast = ee; es[k] = ee; uw[k] = *(const u32x4*)(U + (size_t)ee * D_MODEL + 16 * lane); }
                float d[8];
#pragma unroll
                for (int k = 0; k < 8; ++k) { const int j = qq[k] >> 1; const u32x4 xa = *(const LAS u32x4*)(xs + j * 1024 + 16 * lane), xc = *(const LAS u32x4*)(xs + j * 1024 + 16 * lane + 8);
                    const f32x2 x2[8] = {(f32x2){bflo(xa.x), bfhi(xa.x)}, (f32x2){bflo(xa.y), bfhi(xa.y)}, (f32x2){bflo(xa.z), bfhi(xa.z)}, (f32x2){bflo(xa.w), bfhi(xa.w)}, (f32x2){bflo(xc.x), bfhi(xc.x)}, (f32x2){bflo(xc.y), bfhi(xc.y)}, (f32x2){bflo(xc.z), bfhi(xc.z)}, (f32x2){bflo(xc.w), bfhi(xc.w)}};
                    d[k] = dot16_fp8(uw[k], x2); }
                u32x4 vw[8];
#pragma unroll
                for (int k = 0; k < 8; ++k) vw[k] = *(const u32x4*)(Vt + (size_t)es[k] * D_MODEL + 16 * lane);
                float e4[4], e2[2], e1s;
                { const bool hi = lane & 1;
#pragma unroll
                  for (int i = 0; i < 4; ++i) { const float keep = hi ? d[4 + i] : d[i], send = hi ? d[i] : d[4 + i]; e4[i] = keep + __shfl_xor(send, 1); } }
                { const bool hi = lane & 2;
#pragma unroll
                  for (int i = 0; i < 2; ++i) { const float keep = hi ? e4[2 + i] : e4[i], send = hi ? e4[i] : e4[2 + i]; e2[i] = keep + __shfl_xor(send, 2); } }
                { const bool hi = lane & 4; const float keep = hi ? e2[1] : e2[0], send = hi ? e2[0] : e2[1]; e1s = keep + __shfl_xor(send, 4); }
                e1s += __shfl_xor(e1s, 8); e1s += __shfl_xor(e1s, 16); e1s += __shfl_xor(e1s, 32);
                const int myk = 4 * (lane & 1) + (lane & 2) + ((lane >> 2) & 1); float myg = gk[0];
#pragma unroll
                for (int k = 1; k < 8; ++k) myg = (myk == k) ? gk[k] : myg;
                const float act = myg * gelu_tanh(e1s * (1.0f / PEER_SU)) * (1.0f / PEER_SV);
#pragma unroll
                for (int k = 0; k < 8; ++k) { const int src = (k >> 2) | (((k >> 1) & 1) << 1) | ((k & 1) << 2); const float a = rdlane(act, src); const int j = qq[k] >> 1;
                    if (j == 0) { asm volatile("" ::: "memory"); axpy16_fp8(vw[k], a, oa0); } else if (j == 1) { asm volatile("" ::: "memory"); axpy16_fp8(vw[k], a, oa1); } else if (j == 2) { asm volatile("" ::: "memory"); axpy16_fp8(vw[k], a, oa2); } else { asm volatile("" ::: "memory"); axpy16_fp8(vw[k], a, oa3); } }
            }
        }
        PS2_LN(0) PS2_LN(1) PS2_LN(2) PS2_LN(3)
    }
}
}
namespace fx {
struct EpiB {
    static constexpr bool PERM = true, AFTER_DRAIN = false; const FP& P;
    DI void operator()(const f32x4 (&acc)[2][2][4][2], const pg8::Unit& u, int wr, int wc, int fr, int fq) const {
        const int t = u.pn;
        EPI_LOOP({ if (row < MP) { const int pos = row_pos(row), n = row / SEQ, e = ct & 63, dp = e >> 1; const bool prm = row < M0;
            if (t < 3) { const int ty = 2 * t + (ct >> 7), kvh = (ct >> 6) & 1;
                if (ty == 2 || ty == 4) { f32x4 lo, hi; rope4(P.ROPE + pos * 64, dp, v0, v1, lo, hi);
                    if (ty == 2) { float* o = (prm ? P.nsa_kv_p + (size_t)row * 512 : P.nsa_kv_s + (size_t)(row - M0) * 512) + 256 + kvh * 64 + dp; *(f32x4*)o = lo; *(f32x4*)(o + 32) = hi;
                        if (prm) { bf16* kt = P.SLK + ((size_t)n * NSA_KV_HEADS + kvh) * SEQ * 64; *(u32x2*)(kt + ktile_off(pos, dp)) = pk4(lo); *(u32x2*)(kt + ktile_off(pos, dp + 32)) = pk4(hi); } }
                    else { float* o = nullptr; if (!prm) o = P.win_s + (((size_t)(row - M0) * SWA_WINDOW + SWA_WINDOW - 1) * 2 + 0) * 128; else if (pos >= SEQ - SWA_WINDOW) o = P.win_p + (((size_t)n * SWA_WINDOW + pos - (SEQ - SWA_WINDOW)) * 2 + 0) * 128;
                        if (o) { *(f32x4*)(o + kvh * 64 + dp) = lo; *(f32x4*)(o + kvh * 64 + 32 + dp) = hi; }
                        if (prm) { bf16* kt = P.WNK + ((size_t)n * NSA_KV_HEADS + kvh) * SEQ * 64; *(u32x2*)(kt + ktile_off(pos, dp)) = pk4(lo); *(u32x2*)(kt + ktile_off(pos, dp + 32)) = pk4(hi); } } }
                else if (ty < 4) { float* o = (prm ? P.nsa_kv_p + (size_t)row * 512 : P.nsa_kv_s + (size_t)(row - M0) * 512) + ty * 128 + kvh * 64 + e; *(f32x4*)o = v0; *(f32x4*)(o + 4) = v1;
                    if (prm) { if (ty < 2) *(u32x4*)(P.AC + ((size_t)ty * ACROWS + ((size_t)n * NSA_KV_HEADS + kvh) * NCH + pos / 16) * 1024 + (pos % 16) * 64 + e) = pk8(v0, v1);
                        else { bf16* vt = P.SLVT + ((size_t)n * NSA_KV_HEADS + kvh) * SEQ * 64 + vtile_off(e, pos);
                            vt[0] = (bf16)f2bf(v0.x); vt[8] = (bf16)f2bf(v0.y); vt[16] = (bf16)f2bf(v0.z); vt[24] = (bf16)f2bf(v0.w); vt[32] = (bf16)f2bf(v1.x); vt[40] = (bf16)f2bf(v1.y); vt[48] = (bf16)f2bf(v1.z); vt[56] = (bf16)f2bf(v1.w); } } }
                else { float* o = nullptr; if (!prm) o = P.win_s + (((size_t)(row - M0) * SWA_WINDOW + SWA_WINDOW - 1) * 2 + 1) * 128; else if (pos >= SEQ - SWA_WINDOW) o = P.win_p + (((size_t)n * SWA_WINDOW + pos - (SEQ - SWA_WINDOW)) * 2 + 1) * 128;
                    if (o) { *(f32x4*)(o + kvh * 64 + e) = v0; *(f32x4*)(o + kvh * 64 + e + 4) = v1; }
                    if (prm) { bf16* vt = P.WNVT + ((size_t)n * NSA_KV_HEADS + kvh) * SEQ * 64 + vtile_off(e, pos);
                        vt[0] = (bf16)f2bf(v0.x); vt[8] = (bf16)f2bf(v0.y); vt[16] = (bf16)f2bf(v0.z); vt[24] = (bf16)f2bf(v0.w); vt[32] = (bf16)f2bf(v1.x); vt[40] = (bf16)f2bf(v1.y); vt[48] = (bf16)f2bf(v1.z); vt[56] = (bf16)f2bf(v1.w); } } }
            else if (t < 6) { const int h = (t - 3) * 4 + (ct >> 6); f32x4 lo, hi; rope4(P.ROPE + pos * 64, dp, v0, v1, lo, hi); bf16* q = P.QB + (size_t)row * NSA_Q_COLS + h * 64 + dp; *(u32x2*)q = pk4(lo * QSCALE); *(u32x2*)(q + 32) = pk4(hi * QSCALE); }
            else if (t == 6) { *(u32x4*)(P.MQB + (size_t)row * 256 + ct) = pk8(v0 * QSCALE, v1 * QSCALE); }
            else if (ct < 40) { const float vv[8] = {v0.x, v0.y, v0.z, v0.w, v1.x, v1.y, v1.z, v1.w};
                _Pragma("unroll") for (int i = 0; i < 8; ++i) if (ct + i < NSA_GATE_COLS) P.GATES[(size_t)row * 64 + ct + i] = 1.0f / (1.0f + __expf(-vv[i])); } } })
    }
};
DI void cmp2_phase(const FP& P, const Ctx& C) {
    const int lane = C.lane; LAS float* hs = (LAS float*)(C.lds + C.wave * 1024);
    constexpr int NGRP = NCTX * 2 * NSA_KV_HEADS; const int NW = C.G * NWAVES, WPG = NW / NGRP > 0 ? NW / NGRP : 1; const int gw = C.vcu * NWAVES + C.wave;
#pragma unroll 1
    for (int grp = gw / WPG; grp < NGRP; grp += (NW + WPG - 1) / WPG) { const int slot = gw % WPG; if (gw >= (NW / WPG) * WPG && grp == gw / WPG) break;
        const int kvh = grp % NSA_KV_HEADS, ty = (grp / NSA_KV_HEADS) % 2, ctx = grp / (2 * NSA_KV_HEADS);
        const float* UL = P.UL + ((size_t)ty * ACROWS + ((size_t)ctx * NSA_KV_HEADS + kvh) * NCH) * 256; const float* w2 = P.cmp_w2 + (size_t)ty * CMP_HIDDEN * HEAD_DIM;
        float w2r[CMP_HIDDEN];
#pragma unroll
        for (int k = 0; k < CMP_HIDDEN; ++k) w2r[k] = w2[k * HEAD_DIM + lane];
        const float b0 = P.CBIAS[ty * CMP_HIDDEN + lane], b1 = P.CBIAS[ty * CMP_HIDDEN + 64 + lane];
        float u0, u1, l0, l1; int c = slot;
        if (c < NCMP) { u0 = UL[(size_t)c * 256 + lane]; u1 = UL[(size_t)c * 256 + 64 + lane]; l0 = UL[(size_t)(c + 1) * 256 + 128 + lane]; l1 = UL[(size_t)(c + 1) * 256 + 192 + lane]; }
#pragma unroll 1
        for (; c < NCMP; c += WPG) { const float h0 = gelu_tanh(u0 + l0 + b0), h1 = gelu_tanh(u1 + l1 + b1); const int cn = c + WPG;
            if (cn < NCMP) { u0 = UL[(size_t)cn * 256 + lane]; u1 = UL[(size_t)cn * 256 + 64 + lane]; l0 = UL[(size_t)(cn + 1) * 256 + 128 + lane]; l1 = UL[(size_t)(cn + 1) * 256 + 192 + lane]; }
            hs[lane] = h0; hs[64 + lane] = h1; asm volatile("s_waitcnt lgkmcnt(0)" ::: "memory");
            float a = 0.f;
#pragma unroll
            for (int k4 = 0; k4 < CMP_HIDDEN / 4; ++k4) { const f32x4 hv = *(const LAS f32x4*)(hs + 4 * k4); a += hv.x * w2r[4 * k4] + hv.y * w2r[4 * k4 + 1] + hv.z * w2r[4 * k4 + 2] + hv.w * w2r[4 * k4 + 3]; }
            if (ty == 0) { const float other = __shfl_xor(a, 32); const int pos = c * CMP_STRIDE + CMP_BLOCK - 1; const float cs = P.ROPE[pos * 64 + (lane & 31)], sn = P.ROPE[pos * 64 + 32 + (lane & 31)];
                a = (lane < 32) ? a * cs - other * sn : a * cs + other * sn; }
            if (ctx < BATCH) { if (ty == 0) P.CK[((size_t)ctx * NSA_KV_HEADS + kvh) * NCH * 64 + ktile_off(c, lane)] = (bf16)f2bf(a); else P.CVT[((size_t)ctx * NSA_KV_HEADS + kvh) * NCH * 64 + vtile_off(lane, c)] = (bf16)f2bf(a); }
            else { (ty == 0 ? P.CKF : P.CVF)[(((size_t)(ctx - BATCH) * NSA_KV_HEADS + kvh) * NCH + c) * 64 + lane] = a; }
            asm volatile("s_waitcnt lgkmcnt(0)" ::: "memory"); }
    }
    __syncthreads();
}
constexpr int NSA_WLDS = 8192;
DI void nsa_pair_a(const FP& P, int n, int kvh, int t, int lane, LAS unsigned char* wl) {
    LAS float* pn = (LAS float*)wl; LAS float* imp = (LAS float*)(wl + 2048); LAS float* sc = (LAS float*)(wl + 6144); LAS int* sel = (LAS int*)(wl + 7168);
    const int col = lane & 15, c = lane >> 4; const bool vcol = col < 12; const int qq = vcol ? col / 6 : 0, hh = vcol ? col % 6 : 0, tq = t + qq, head = kvh * NSA_GROUP + hh, row = n * SEQ + tq;
    bf16x8 qf[2]; { const bf16* qp = P.QB + (size_t)row * NSA_Q_COLS + head * 64 + 8 * c; qf[0] = *(const bf16x8*)qp; qf[1] = *(const bf16x8*)(qp + 32); }
    const float* gt = P.GATES + (size_t)row * 64 + head * 3;
    f32x4 oacc[4] = {(f32x4){0.f, 0.f, 0.f, 0.f}, (f32x4){0.f, 0.f, 0.f, 0.f}, (f32x4){0.f, 0.f, 0.f, 0.f}, (f32x4){0.f, 0.f, 0.f, 0.f}};
    const int lim = vcol ? ((tq >= CMP_BLOCK - 1) ? (tq - (CMP_BLOCK - 1)) / CMP_STRIDE : -1) : -1;
    const int limmax = (t + 1 >= CMP_BLOCK - 1) ? (t + 1 - (CMP_BLOCK - 1)) / CMP_STRIDE : -1; const int nblk = (limmax + 32) / 32;
    const bf16* CKb = P.CK + ((size_t)n * NSA_KV_HEADS + kvh) * NCH * 64; const bf16* CVb = P.CVT + ((size_t)n * NSA_KV_HEADS + kvh) * 64 * NCH;
    for (int i = lane; i < 1024; i += 64) imp[i] = 0.f;
    float m1 = -INFINITY, l1 = 0.f;
    { struct K4 { bf16x8 a0, a1, b0, b1; };
      auto ldk = [&](K4& k, int blk) { const bf16* kt = CKb + (size_t)blk * 2048 + lane * 8; k.a0 = *(const bf16x8*)kt; k.a1 = *(const bf16x8*)(kt + 512); k.b0 = *(const bf16x8*)(kt + 1024); k.b1 = *(const bf16x8*)(kt + 1536); };
      auto cp1 = [&](const K4& k, int blk) { const int kb = 32 * blk;
        f32x4 s0 = (f32x4){0.f, 0.f, 0.f, 0.f}, s1 = (f32x4){0.f, 0.f, 0.f, 0.f};
        s0 = __builtin_amdgcn_mfma_f32_16x16x32_bf16(k.a0, qf[0], s0, 0, 0, 0); s0 = __builtin_amdgcn_mfma_f32_16x16x32_bf16(k.a1, qf[1], s0, 0, 0, 0);
        s1 = __builtin_amdgcn_mfma_f32_16x16x32_bf16(k.b0, qf[0], s1, 0, 0, 0); s1 = __builtin_amdgcn_mfma_f32_16x16x32_bf16(k.b1, qf[1], s1, 0, 0, 0);
        float s[8] = {s0.x, s0.y, s0.z, s0.w, s1.x, s1.y, s1.z, s1.w}; float mx = -INFINITY;
        const int hi1 = lim - (kb + 8 * c);
#pragma unroll
        for (int e = 0; e < 8; ++e) { s[e] = (e <= hi1) ? s[e] : -INFINITY; mx = fmaxf(mx, s[e]); }
        mx = colmax(mx);
        const float mnew = fmaxf(m1, mx), muse = (mnew == -INFINITY) ? 0.f : mnew; float ls = 0.f;
#pragma unroll
        for (int e = 0; e < 8; ++e) ls += __builtin_amdgcn_exp2f(s[e] - muse);
        l1 = l1 * __builtin_amdgcn_exp2f(m1 - muse) + ls; m1 = mnew; };
      if (nblk > 0) { K4 A, B; ldk(A, 0);
#pragma unroll 1
        for (int blk = 0; blk < nblk; blk += 2) { ldk(B, (blk + 1 < nblk) ? blk + 1 : blk); cp1(A, blk); ldk(A, (blk + 2 < nblk) ? blk + 2 : blk); if (blk + 1 < nblk) cp1(B, blk + 1); } } }
    asm volatile("s_waitcnt lgkmcnt(0)" ::: "memory");
    { l1 = colsum(l1); const float muse = (m1 == -INFINITY) ? 0.f : m1, inv = (l1 > 0.f) ? 1.0f / l1 : 0.f;
      f32x4 oc[4] = {(f32x4){0.f, 0.f, 0.f, 0.f}, (f32x4){0.f, 0.f, 0.f, 0.f}, (f32x4){0.f, 0.f, 0.f, 0.f}, (f32x4){0.f, 0.f, 0.f, 0.f}};
      pipe2(nblk, [&](KV8& kv, int blk) { kv_load_t(kv, CKb + (size_t)blk * 2048, CVb + (size_t)blk * 2048, lane); }, [&](const KV8& kv, int blk) { const int kb = 32 * blk;
        f32x4 s0 = (f32x4){0.f, 0.f, 0.f, 0.f}, s1 = (f32x4){0.f, 0.f, 0.f, 0.f};
        s0 = __builtin_amdgcn_mfma_f32_16x16x32_bf16(kv.ka0, qf[0], s0, 0, 0, 0); s0 = __builtin_amdgcn_mfma_f32_16x16x32_bf16(kv.ka1, qf[1], s0, 0, 0, 0);
        s1 = __builtin_amdgcn_mfma_f32_16x16x32_bf16(kv.kb0, qf[0], s1, 0, 0, 0); s1 = __builtin_amdgcn_mfma_f32_16x16x32_bf16(kv.kb1, qf[1], s1, 0, 0, 0);
        float s[8] = {s0.x, s0.y, s0.z, s0.w, s1.x, s1.y, s1.z, s1.w};
        const int hi2 = lim - (kb + 8 * c);
#pragma unroll
        for (int e = 0; e < 8; ++e) s[e] = (e <= hi2) ? __builtin_amdgcn_exp2f(s[e] - muse) * inv : 0.f;
        *(f32x4*)(pn + col * 32 + 8 * c) = (f32x4){s[0], s[1], s[2], s[3]}; *(f32x4*)(pn + col * 32 + 8 * c + 4) = (f32x4){s[4], s[5], s[6], s[7]};
        u32x4 pw; pw.x = cvtpk(s[0], s[1]); pw.y = cvtpk(s[2], s[3]); pw.z = cvtpk(s[4], s[5]); pw.w = cvtpk(s[6], s[7]); const bf16x8 pf = __builtin_bit_cast(bf16x8, pw);
        oc[0] = __builtin_amdgcn_mfma_f32_16x16x32_bf16(kv.v0, pf, oc[0], 0, 0, 0); oc[1] = __builtin_amdgcn_mfma_f32_16x16x32_bf16(kv.v1, pf, oc[1], 0, 0, 0);
        oc[2] = __builtin_amdgcn_mfma_f32_16x16x32_bf16(kv.v2, pf, oc[2], 0, 0, 0); oc[3] = __builtin_amdgcn_mfma_f32_16x16x32_bf16(kv.v3, pf, oc[3], 0, 0, 0);
        asm volatile("s_waitcnt lgkmcnt(0)" ::: "memory");
        { const int q2 = lane >> 5, k = lane & 31; float a = 0.f;
#pragma unroll
          for (int h6 = 0; h6 < 6; ++h6) a += pn[(q2 * 6 + h6) * 32 + k];
          imp[q2 * 512 + kb + k] = a; }
        asm volatile("s_waitcnt lgkmcnt(0)" ::: "memory"); });
#ifdef NSA_DEBUG
      if (vcol) { for (int db = 0; db < 4; ++db) *(f32x4*)(P.DBG + ((size_t)0 * MP + row) * 768 + head * 64 + 16 * db + 4 * c) = oc[db]; }
#endif
      const float g0 = vcol ? gt[0] : 0.f;
#pragma unroll
      for (int db = 0; db < 4; ++db) oacc[db] += oc[db] * g0; }
#ifndef REP_SEL
#define REP_SEL 1
#endif
#pragma unroll 1
    for (int rep = 0; rep < REP_SEL; ++rep) {
    for (int i = lane; i < 256; i += 64) { const int q2 = i >> 7, b = i & 127, tq2 = t + q2, cur = tq2 / SLC_BLOCK; float sv;
        if (b > cur) sv = NEG; else if (b == 0 || b == cur || b == cur - 1) sv = FORCE_SCORE;
        else { const LAS float* ic = imp + q2 * 512 + 4 * b; sv = ic[-1] + 2.f * (ic[0] + ic[1] + ic[2]) + ic[3]; }
        sc[i] = pack_key(sv, 127u - (unsigned)b, 127u); }
    asm volatile("s_waitcnt lgkmcnt(0)" ::: "memory");
    for (int i = lane; i < 256; i += 64) { const int q2 = i >> 7, b = i & 127; const float sv = sc[i]; int rank = 0;
        for (int j = 0; j < 128; j += 4) { const f32x4 o = *(const LAS f32x4*)(sc + q2 * 128 + j);
            rank += (o.x > sv) ? 1 : 0; rank += (o.y > sv) ? 1 : 0; rank += (o.z > sv) ? 1 : 0; rank += (o.w > sv) ? 1 : 0; }
        if (rank < SLC_TOPK) { const int v = (sv > 0.5f * NEG) ? b : -1; sel[q2 * 16 + rank] = v; P.SELB[((size_t)(n * SEQ + t + q2) * NSA_KV_HEADS + kvh) * 16 + rank] = v; } }
    asm volatile("s_waitcnt lgkmcnt(0)" ::: "memory");
    }
#ifndef REP_WIN
#define REP_WIN 1
#endif
#pragma unroll 1
    for (int rep = 0; rep < REP_WIN; ++rep) { Tile16 T; tile_init(T);
      const bf16* WKb = P.WNK + ((size_t)n * NSA_KV_HEADS + kvh) * SEQ * 64; const bf16* WVb = P.WNVT + ((size_t)n * NSA_KV_HEADS + kvh) * 64 * SEQ;
      const int blo = (t - SWA_WINDOW) >> 5, bhi = (t + 1) >> 5;
      auto ld = [&](KV8& kv, int blk) { const int bc = blk < 0 ? 0 : blk; kv_load_t(kv, WKb + (size_t)bc * 2048, WVb + (size_t)bc * 2048, lane); };
      pipe2(bhi - blo + 1, [&](KV8& kv, int i) { ld(kv, blo + i); }, [&](const KV8& kv, int i) { const int kb = 32 * (blo + i);
          const int k0 = kb + 8 * c; int lo; unsigned rng; const int a = tq - SWA_WINDOW; mk_range((a > 0 ? a : 0) - k0, tq - k0, vcol, lo, rng); tile_compute(T, qf, kv, lo, rng); });
      T.l = colsum(T.l);
      const float inv = (T.l > 0.f) ? 1.0f / T.l : 0.f, g2 = vcol ? gt[2] * inv : 0.f;
#ifdef NSA_DEBUG
      if (vcol) { for (int db = 0; db < 4; ++db) *(f32x4*)(P.DBG + ((size_t)2 * MP + row) * 768 + head * 64 + 16 * db + 4 * c) = T.o[db] * inv; }
#endif
#pragma unroll
      for (int db = 0; db < 4; ++db) if (rep == REP_WIN - 1) oacc[db] += T.o[db] * g2; }
    if (vcol) { float* op = P.DPART + (size_t)row * 768 + head * 64 + 4 * c;
#pragma unroll
        for (int db = 0; db < 4; ++db) *(f32x4*)(op + 16 * db) = oacc[db]; }
}
DI void nsa_pair_b(const FP& P, int n, int kvh, int t, int lane, LAS unsigned char* wl) {
    LAS int* steps = (LAS int*)wl;
    const int col = lane & 15, c = lane >> 4; const bool vcol = col < 12; const int qq = vcol ? col / 6 : 0, hh = vcol ? col % 6 : 0, tq = t + qq, head = kvh * NSA_GROUP + hh, row = n * SEQ + tq;
    bf16x8 qf[2]; { const bf16* qp = P.QB + (size_t)row * NSA_Q_COLS + head * 64 + 8 * c; qf[0] = *(const bf16x8*)qp; qf[1] = *(const bf16x8*)(qp + 32); }
    const float* gt = P.GATES + (size_t)row * 64 + head * 3;
    Tile16 T; tile_init(T);
    const bf16* SKb = P.SLK + ((size_t)n * NSA_KV_HEADS + kvh) * SEQ * 64; const bf16* SVb = P.SLVT + ((size_t)n * NSA_KV_HEADS + kvh) * SEQ * 64;
    int ns = 0;
    { const int mysel = (lane < 32) ? P.SELB[((size_t)(n * SEQ + t + (lane >> 4)) * NSA_KV_HEADS + kvh) * 16 + (lane & 15)] : -1;
      for (int i = 0; i < 32; ++i) { const int b = __builtin_amdgcn_readlane(mysel, i); if (b < 0) continue; int q2 = i >> 4;
          const unsigned long long other = __ballot(mysel == b && lane < 32 && (lane >> 4) != q2);
          if (other) { if (q2 == 1) continue; q2 = 2; }
          if (lane == 0) { steps[ns] = (b * SLC_BLOCK) | (q2 << 29); steps[ns + 1] = (b * SLC_BLOCK + 32) | (q2 << 29); } ns += 2; } }
    asm volatile("s_waitcnt lgkmcnt(0)" ::: "memory");
    auto ld = [&](KV8& kv, int i) { const int code = __builtin_amdgcn_readfirstlane(steps[i]); const int kb = code & 0x1fffffff;
        kv_load_t(kv, SKb + (size_t)(kb >> 5) * 2048, SVb + (size_t)(kb >> 5) * 2048, lane); };
#ifdef PROBE_DBLCOMP
    Tile16 T2; tile_init(T2);
#endif
    pipe2(ns, ld, [&](const KV8& kv, int i) { const int code = __builtin_amdgcn_readfirstlane(steps[i]); const int kb = code & 0x1fffffff, q2 = code >> 29;
        int lo; unsigned rng; mk_range(-64, tq - (kb + 8 * c), vcol && (q2 == 2 || qq == q2), lo, rng); tile_compute(T, qf, kv, lo, rng);
#ifdef PROBE_DBLCOMP
        tile_compute(T2, qf, kv, [&](int e) { return vcol && qq == q2 && (kb + 8 * c + e + 1) <= tq; });
#endif
    });
#ifdef PROBE_DBLCOMP
    if (T2.l < 0.f) T.l = 0.f;
#endif
    T.l = colsum(T.l);
    const float inv = (T.l > 0.f) ? 1.0f / T.l : 0.f, g1 = vcol ? gt[1] * inv : 0.f;
#ifdef NSA_DEBUG
    if (vcol) { for (int db = 0; db < 4; ++db) *(f32x4*)(P.DBG + ((size_t)1 * MP + row) * 768 + head * 64 + 16 * db + 4 * c) = T.o[db] * inv; }
#endif
    if (vcol) { const float* pp = P.DPART + (size_t)row * 768 + head * 64 + 4 * c; bf16* op = P.ATTB + (size_t)row * 1024 + head * 64 + 4 * c;
#pragma unroll
        for (int db = 0; db < 4; ++db) *(u32x2*)(op + 16 * db) = pk4(*(const f32x4*)(pp + 16 * db) + T.o[db] * g1); }
}

constexpr int SMP_SK = 1088;
template <class KF, class VF> DI void smp_branch(const Ctx& C, LAS float* qs, LAS float* S, LAS float* red, int NK, KF kf, VF vf, bool keep_probs, float (&outh)[1]) {
    const int tid = C.tid, lane = C.lane, w = C.wave;
#pragma unroll 1
    for (int j = tid; j < NK; j += NTHREADS) { const float* k = kf(j); f32x4 kr[16];
#pragma unroll
        for (int d4 = 0; d4 < 16; ++d4) kr[d4] = *(const f32x4*)(k + 4 * d4);
#pragma unroll 1
        for (int h = 0; h < 6; ++h) { float a = 0.f;
#pragma unroll
            for (int d4 = 0; d4 < 16; ++d4) { const f32x4 qv = *(const LAS f32x4*)(qs + h * 64 + 4 * d4); a += kr[d4].x * qv.x + kr[d4].y * qv.y + kr[d4].z * qv.z + kr[d4].w * qv.w; }
            S[h * SMP_SK + j] = a; } }
    asm volatile("s_waitcnt lgkmcnt(0)" ::: "memory"); __syncthreads();
    if (w < 6) { float m = -INFINITY; for (int j = lane; j < NK; j += 64) m = fmaxf(m, S[w * SMP_SK + j]); m = wave_max(m);
        float l = 0.f; for (int j = lane; j < NK; j += 64) { const float p = __builtin_amdgcn_exp2f(S[w * SMP_SK + j] - m); S[w * SMP_SK + j] = p; l += p; } l = wave_sum(l);
        const float inv = 1.0f / l; for (int j = lane; j < NK; j += 64) S[w * SMP_SK + j] *= inv; }
    asm volatile("s_waitcnt lgkmcnt(0)" ::: "memory"); __syncthreads();
    { const int per = (NK + NWAVES - 1) / NWAVES, j0 = w * per, j1 = (j0 + per < NK) ? j0 + per : NK; float o[6] = {0.f, 0.f, 0.f, 0.f, 0.f, 0.f};
#pragma unroll 1
      for (int j = j0; j < j1; j += 8) { float vv[8];
#pragma unroll
          for (int u = 0; u < 8; ++u) { const int jj = (j + u < j1) ? j + u : j1 - 1; vv[u] = vf(jj)[lane]; }
#pragma unroll
          for (int u = 0; u < 8; ++u) if (j + u < j1) {
#pragma unroll
              for (int h = 0; h < 6; ++h) o[h] += S[h * SMP_SK + j + u] * vv[u]; } }
#pragma unroll
      for (int h = 0; h < 6; ++h) red[(w * 6 + h) * 64 + lane] = o[h]; }
    asm volatile("s_waitcnt lgkmcnt(0)" ::: "memory"); __syncthreads();
    outh[0] = 0.f;
    if (tid < 384) { float a = 0.f;
#pragma unroll
        for (int ww = 0; ww < NWAVES; ++ww) a += red[ww * 384 + tid]; outh[0] = a; }
    if (!keep_probs) { __syncthreads(); }
}
DI void nsa_sample_item(const FP& P, const Ctx& C, int ns, int kvh) {
    LAS float* qs = (LAS float*)C.lds; LAS float* S = qs + 384; LAS float* red = S + 6 * SMP_SK; LAS float* scs = red + 8 * 384; LAS int* sel = (LAS int*)(scs + 136);
    const int tid = C.tid, row = M0 + ns;
    if (tid < 384) qs[tid] = bf2f(P.QB[(size_t)row * NSA_Q_COLS + kvh * 384 + tid]);
    asm volatile("s_waitcnt lgkmcnt(0)" ::: "memory"); __syncthreads();
    const float* ckf = P.CKF + ((size_t)ns * NSA_KV_HEADS + kvh) * NCH * 64; const float* cvf = P.CVF + ((size_t)ns * NSA_KV_HEADS + kvh) * NCH * 64;
    float oc[1], os[1], ow[1];
    smp_branch(C, qs, S, red, NCMP, [&](int j) { return ckf + (size_t)j * 64; }, [&](int j) { return cvf + (size_t)j * 64; }, true, oc);
    constexpr int NBS = (PAST_LEN + 1 + SLC_BLOCK - 1) / SLC_BLOCK, CURS = PAST_LEN / SLC_BLOCK;
    for (int b = tid; b < 136; b += NTHREADS) { float sv = -3.0e38f;
        if (b < NBS) { if (b == 0 || b == CURS || b == CURS - 1) sv = FORCE_SCORE; else { float a = 0.f;
#pragma unroll
                for (int o = -1; o <= 3; ++o) { const int ci = 4 * b + o; if (ci >= 0 && ci < NCMP) { float sm = 0.f; for (int h6 = 0; h6 < 6; ++h6) sm += S[h6 * SMP_SK + ci]; a += ((o >= 0 && o <= 2) ? 2.f : 1.f) * sm; } }
                sv = a; } }
        scs[b] = sv; }
    asm volatile("s_waitcnt lgkmcnt(0)" ::: "memory"); __syncthreads();
    for (int b = tid; b < NBS; b += NTHREADS) { const float sv = scs[b]; int rank = 0; for (int j = 0; j < NBS; ++j) { const float o = scs[j]; rank += (o > sv || (o == sv && j < b)) ? 1 : 0; }
        if (rank < SLC_TOPK) { sel[rank] = b; P.SELB[((size_t)row * NSA_KV_HEADS + kvh) * 16 + rank] = b; } }
    asm volatile("s_waitcnt lgkmcnt(0)" ::: "memory"); __syncthreads();
    { const float* newrow = P.nsa_kv_s + (size_t)ns * 512; const int* pt = P.page_table + ns * (PAST_LEN / PAGE_SIZE);
      if (tid == 0) { int seen = 0; for (int x = 0; x < SLC_TOPK; ++x) { const int bx = sel[x]; if (bx != CURS && seen < 15) sel[16 + seen++] = bx; } }
      asm volatile("s_waitcnt lgkmcnt(0)" ::: "memory"); __syncthreads();
      auto krow = [&](int j, int ty) -> const float* { if (j >= 15 * 64) return newrow + ty * 128 + kvh * 64;
          const int t0 = sel[16 + (j >> 6)] * SLC_BLOCK + (j & 63); const int pg = pt[t0 / PAGE_SIZE]; return P.cache_nsa_kv + ((size_t)pg * PAGE_SIZE + t0 % PAGE_SIZE) * 512 + ty * 128 + kvh * 64; };
      smp_branch(C, qs, S, red, 15 * 64 + 1, [&](int j) { return krow(j, 2); }, [&](int j) { return krow(j, 3); }, false, os); }
    { const float* wc = P.cache_nsa_win + (size_t)ns * SWA_WINDOW * 256; const float* newrow = P.win_s + ((size_t)ns * SWA_WINDOW + SWA_WINDOW - 1) * 256;
      smp_branch(C, qs, S, red, SWA_WINDOW + 1, [&](int j) { return (j < SWA_WINDOW ? wc + (size_t)j * 256 : newrow) + kvh * 64; }, [&](int j) { return (j < SWA_WINDOW ? wc + (size_t)j * 256 : newrow) + 128 + kvh * 64; }, false, ow); }
    if (tid < 384) { const int head = kvh * NSA_GROUP + tid / 64; const float* gt = P.GATES + (size_t)row * 64 + head * 3;
        P.ATTB[(size_t)row * 1024 + kvh * 384 + tid] = (bf16)f2bf(gt[0] * oc[0] + gt[1] * os[0] + gt[2] * ow[0]);
#ifdef NSA_DEBUG
        P.DBG[((size_t)0 * MP + row) * 768 + kvh * 384 + tid] = oc[0]; P.DBG[((size_t)1 * MP + row) * 768 + kvh * 384 + tid] = os[0]; P.DBG[((size_t)2 * MP + row) * 768 + kvh * 384 + tid] = ow[0];
#endif
    }
    __syncthreads();
}
DI void nsa_pairs(const FP& P, const Ctx& C, bool second) {
    LAS unsigned char* wl = C.lds + C.wave * NSA_WLDS;
    const int per = C.G / 4 > 0 ? C.G / 4 : 1, grp = (C.vcu / per) & 3, sub = C.vcu % per, n = grp >> 1, kvh = grp & 1;
#pragma unroll 1
    for (int pr = sub * NWAVES + C.wave; pr < SEQ / 2; pr += per * NWAVES) { if (second) nsa_pair_b(P, n, kvh, 2 * pr, C.lane, wl); else nsa_pair_a(P, n, kvh, 2 * pr, C.lane, wl); }
}
DI void nsa_phase_a(const FP& P, const Ctx& C) {
    for (int it = C.vcu; it < DEC_BATCH * NSA_KV_HEADS; it += C.G) nsa_sample_item(P, C, it / NSA_KV_HEADS, it % NSA_KV_HEADS);
    nsa_pairs(P, C, false);
    __syncthreads();
}
DI void nsa_phase_b(const FP& P, const Ctx& C) {
    const int lane = C.lane, w = C.wave;
    nsa_pairs(P, C, true);
    __syncthreads();
    { constexpr int NMT = (M0 / 16) * MEM_HEADS;
      for (int it = C.vcu * NWAVES + w; it < NMT; it += C.G * NWAVES) { const int h = it % MEM_HEADS, q16 = it / MEM_HEADS, row0 = q16 * 16, n = row0 / SEQ;
          mem_micro(P, P.MQB + h * 64, 256, row0, 1, n, h, P.ATTB + NSA_Q_COLS + h * 64, 1024, lane); }
    }
    { LAS float* qs = (LAS float*)C.lds;
      for (int it = C.vcu; it < DEC_BATCH * MEM_HEADS; it += C.G) { const int h = it % MEM_HEADS, ns = it / MEM_HEADS, row = M0 + ns;
          __syncthreads(); if (C.tid < 64) qs[C.tid] = bf2f(P.MQB[(size_t)row * 256 + h * 64 + C.tid]); asm volatile("s_waitcnt lgkmcnt(0)" ::: "memory"); __syncthreads();
          Dec D; D.m = -INFINITY; D.l = 0.f; D.o = 0.f; const float* mk = P.cache_mem_kv + ((size_t)1 * DEC_BATCH + ns) * MEM_TOKENS * 512;
          for (int ck = w; ck < MEM_TOKENS / 64; ck += NWAVES) { const int j0 = ck * 64; dec_chunk(D, qs, 64, [&](int j) { return mk + (size_t)(j0 + j) * 512 + h * 64; }, [&](int j) { return mk + (size_t)(j0 + j) * 512 + 256 + h * 64; }, lane); }
          const float o = dec_combine(C, D);
          if (w == 0) P.ATTB[(size_t)row * 1024 + NSA_Q_COLS + h * 64 + lane] = (bf16)f2bf(o); } }
    __syncthreads();
}
}
namespace fx {
enum { PH_PRO = 0, PH_G1, PH_ATTA, PH_G2, PH_LN1, PH_SC0, PH_TK0, PH_PU0, PH_PG0, PH_G3, PH_CMPG, PH_CMP2, PH_NSA, PH_NSB, PH_G4, PH_LN3, PH_SC1, PH_TK1, PH_PU1, PH_PG1, PH_COUNT };
template <class Epi> DI void run_gemm(const Ctx& C, const bf16* A, const bf16* Bt, int M, int N, int K, const Epi& E) {
    pg8::Gemm g{A, Bt, M, N, K}; pg8::StaticOrder S; S.init(M, N, C.G, (int)blockIdx.x);
    pg8::gemm_phase<Epi, pg8::StaticOrder, true, true>(C.lds, g, S, E);
}
template <class Epi> DI void skinny_gemm(const Ctx& C, const bf16* A, const bf16* Bt, int N, int K, const Epi& E) {
    static_assert(DEC_BATCH == 32 && M0 % 256 == 0, "skinny_gemm: 32 sample rows right after a whole number of 256-row tiles");
    const int lane = C.lane, fr = lane & 15, fq = lane >> 4, w = C.wave; const int NI = (N / 256) * 4, KW = K / NWAVES;
    LAS f32x4* red = (LAS f32x4*)C.lds;
#pragma unroll 1
    for (int item = C.vcu; item < NI; item += C.G) { const int pn = item >> 2, wc = item & 3;
        f32x4 pa[2][2][2];
#pragma unroll
        for (int i = 0; i < 8; ++i) (&pa[0][0][0])[i] = (f32x4){0.f, 0.f, 0.f, 0.f};
        const bf16* xa = A + (size_t)(M0 + fr) * K + w * KW + 8 * fq; const bf16* xb = xa + (size_t)16 * K;
        const bf16* wp[2][2];
#pragma unroll
        for (int bj = 0; bj < 2; ++bj)
#pragma unroll
            for (int n = 0; n < 2; ++n) wp[bj][n] = Bt + (size_t)(pn * 256 + bj * 128 + wc * 32 + 8 * (fr >> 2) + 4 * n + (fr & 3)) * K + w * KW + 8 * fq;
#pragma unroll 4
        for (int k0 = 0; k0 < KW; k0 += 32) { const bf16x8 x0 = *(const bf16x8*)(xa + k0), x1 = *(const bf16x8*)(xb + k0);
#pragma unroll
            for (int bj = 0; bj < 2; ++bj)
#pragma unroll
                for (int n = 0; n < 2; ++n) { const bf16x8 wf = *(const bf16x8*)(wp[bj][n] + k0);
                    pa[bj][0][n] = __builtin_amdgcn_mfma_f32_16x16x32_bf16(wf, x0, pa[bj][0][n], 0, 0, 0); pa[bj][1][n] = __builtin_amdgcn_mfma_f32_16x16x32_bf16(wf, x1, pa[bj][1][n], 0, 0, 0); } }
        __syncthreads();
#pragma unroll
        for (int bj = 0; bj < 2; ++bj)
#pragma unroll
            for (int mm = 0; mm < 2; ++mm)
#pragma unroll
                for (int n = 0; n < 2; ++n) red[(w * 8 + bj * 4 + mm * 2 + n) * 64 + lane] = pa[bj][mm][n];
        asm volatile("s_waitcnt lgkmcnt(0)" ::: "memory"); __syncthreads();
        if (w == 0) { f32x4 acc[2][2][4][2];
#pragma unroll
            for (int i = 0; i < 32; ++i) (&acc[0][0][0][0])[i] = (f32x4){0.f, 0.f, 0.f, 0.f};
#pragma unroll
            for (int bj = 0; bj < 2; ++bj)
#pragma unroll
                for (int mm = 0; mm < 2; ++mm)
#pragma unroll
                    for (int n = 0; n < 2; ++n) { f32x4 s = red[(bj * 4 + mm * 2 + n) * 64 + lane];
#pragma unroll 1
                        for (int ww = 1; ww < NWAVES; ++ww) s += red[(ww * 8 + bj * 4 + mm * 2 + n) * 64 + lane];
                        acc[0][bj][mm][n] = s; }
            E(acc, pg8::Unit{M0 / 256, pn}, 0, wc, fr, fq); }
    }
    __syncthreads();
}
__global__ void __launch_bounds__(NTHREADS, 2) mega(Args args) {
    extern __shared__ __attribute__((aligned(16))) unsigned char lds_raw[];
    Ctx C; C.lds = (LAS unsigned char*)lds_raw; C.tid = threadIdx.x; C.lane = C.tid & 63; C.wave = __builtin_amdgcn_readfirstlane(C.tid >> 6);
    C.G = gridDim.x; { const int bx = blockIdx.x; C.vcu = (C.G % 8 == 0) ? (bx % 8) * (C.G / 8) + bx / 8 : bx; }
    const FP& P = args.p;
    volatile LAS unsigned* MISC = (volatile LAS unsigned*)(C.lds + MISC_OFF);
    for (int u = C.tid; u < (LDS_BYTES - RING_BYTES) / 4; u += NTHREADS) ((LAS unsigned*)(C.lds + RING_BYTES))[u] = 0u;
    __syncthreads();
    const int lo = args.lo, hi = args.hi;
    XcdBarrier bar; bar.bar = P.ctl + 1024; bar.x = 0; bar.st = nullptr;
    if (hi - lo > 1) bar = xcd_barrier_post(P.ctl + 1024, MISC + 8);
#define IN(k) (lo <= (k) && (k) < hi)
#define SEAM(k) do { if ((k) == PH_ATTA && IN(k)) bgq_drain(P, C, MISC + 12, BGQ_L_A);     \
        if ((k) == PH_TK0 && IN(k)) bgq_drain(P, C, MISC + 12, BGQ_L_UV); \
        if ((k) == PH_G3 && IN(k)) bgq_drain(P, C, MISC + 12, BGQ_L_AC); \
        if ((k) == PH_COUNT - 1 && IN(k)) bgq_drain(P, C, MISC + 12, BGQ_TOTAL); \
        if (IN(k) && IN((k) + 1)) xcd_barrier_bg(bar, P, C, MISC + 12); } while (0)
#ifndef DUP_PHASE
#define DUP_PHASE -1
#endif
#define PHASE(k, ...) do { if (IN(k)) { __VA_ARGS__ if (DUP_PHASE == (k)) { __syncthreads(); __VA_ARGS__ } } SEAM(k); } while (0)
    PHASE(PH_PRO, p0_prologue(P, C););
    PHASE(PH_G1, run_gemm(C, P.XB0, P.WA_T, M0, ACOLS, D_MODEL, EpiA{P}); run_gemm(C, P.MEMB, P.WMEM_T, BATCH * MEM_TOKENS, 1024, D_MODEL, EpiMem{P}); skinny_gemm(C, P.XB0, P.WA_T, ACOLS, D_MODEL, EpiA{P}););
#ifdef PEER_SHARD3
#define PEER_SHARDED_FN peer_sharded3_phase
#else
#define PEER_SHARDED_FN peer_sharded2_phase
#endif
#if defined(PEER_SOFTSYNC) && !defined(PEER_SHARD3)
#define PEER_HINT_ARGS , bar.st, bar.x
#else
#define PEER_HINT_ARGS
#endif
    PHASE(PH_ATTA, atta_phase(P, C););
    PHASE(PH_G2, run_gemm(C, P.ATTA, P.WOA_T, M0, D_MODEL, 512, EpiPre{P.x_prompt, P.x_sample, P.PRE}); skinny_gemm(C, P.ATTA, P.WOA_T, D_MODEL, 512, EpiPre{P.x_prompt, P.x_sample, P.PRE}););
    PHASE(PH_LN1, ln_phase(P, C, P.PRE, P.ln_g, P.ln_b, P.X1, P.X1B, nullptr, nullptr););
    PHASE(PH_SC0, run_gemm(C, P.X1B, P.WPK_T, M0, NPK, D_MODEL, EpiF32{P.SCO, NPK, MP}); skinny_gemm(C, P.X1B, P.WPK_T, NPK, D_MODEL, EpiF32{P.SCO, NPK, MP}););
    PHASE(PH_TK0, topk_phase(P, C););
#ifdef PEER_SPLIT
    PHASE(PH_PU0, peer_u_phase(P, C, 0, P.X1B););
    PHASE(PH_PG0, peer_v_phase(P, C, 0, P.X1, P.X2, P.X2 + (size_t)M0 * D_MODEL, P.X2B););
#elif defined(PEER_SHARD2)
    PHASE(PH_PG0, const bool shd = (M0 % (C.G * NWAVES * PS2_ROWS)) == 0; if (shd) { PEER_SHARDED_FN(P, C, 0, P.X1, P.X1B, P.X2, P.X2B PEER_HINT_ARGS); __syncthreads(); } peer_phase(P, C, 0, P.X1, P.X2, P.X2 + (size_t)M0 * D_MODEL, P.X2B, shd););
#elif defined(PEER_SHARD)
    PHASE(PH_PG0, peer_sharded_phase(P, C, 0, P.X1, P.X1B, P.X2, P.X2 + (size_t)M0 * D_MODEL, P.X2B); __syncthreads(); peer_phase(P, C, 0, P.X1, P.X2, P.X2 + (size_t)M0 * D_MODEL, P.X2B););
#else
    PHASE(PH_PG0, peer_phase(P, C, 0, P.X1, P.X2, P.X2 + (size_t)M0 * D_MODEL, P.X2B););
#endif
    PHASE(PH_G3, run_gemm(C, P.X2B, P.WB_T, M0, NB_T, D_MODEL, EpiB{P}); skinny_gemm(C, P.X2B, P.WB_T, NB_T, D_MODEL, EpiB{P}););
    PHASE(PH_CMPG, run_gemm(C, P.AC, P.CW1_T, ACROWS, 256, 1024, EpiF32{P.UL, 256, ACROWS}); run_gemm(C, P.AC + (size_t)ACROWS * 1024, P.CW1_T + 256 * 1024, ACROWS, 256, 1024, EpiF32{P.UL + (size_t)ACROWS * 256, 256, ACROWS}););
    PHASE(PH_CMP2, cmp2_phase(P, C););
    PHASE(PH_NSA, nsa_phase_a(P, C););
    PHASE(PH_NSB, nsa_phase_b(P, C););
    PHASE(PH_G4, run_gemm(C, P.ATTB, P.WOB_T, M0, D_MODEL, 1024, EpiPre{P.X2, nullptr, P.PRE}); skinny_gemm(C, P.ATTB, P.WOB_T, D_MODEL, 1024, EpiPre{P.X2, nullptr, P.PRE}););
    PHASE(PH_LN3, ln_phase(P, C, P.PRE, P.ln_g + 2 * D_MODEL, P.ln_b + 2 * D_MODEL, P.X3, P.X3B, nullptr, nullptr););
    PHASE(PH_SC1, run_gemm(C, P.X3B, P.WPK_T + (size_t)NPK * D_MODEL, M0, NPK, D_MODEL, EpiF32{P.SCO, NPK, MP}); skinny_gemm(C, P.X3B, P.WPK_T + (size_t)NPK * D_MODEL, NPK, D_MODEL, EpiF32{P.SCO, NPK, MP}););
    PHASE(PH_TK1, topk_phase(P, C););
#ifdef PEER_SPLIT
    PHASE(PH_PU1, peer_u_phase(P, C, 1, P.X3B););
    PHASE(PH_PG1, peer_v_phase(P, C, 1, P.X3, P.y_prompt, P.y_sample, nullptr););
#elif defined(PEER_SHARD2)
    PHASE(PH_PG1, const bool shd = (M0 % (C.G * NWAVES * PS2_ROWS)) == 0; if (shd) { PEER_SHARDED_FN(P, C, 1, P.X3, P.X3B, P.y_prompt, nullptr PEER_HINT_ARGS); __syncthreads(); } peer_phase(P, C, 1, P.X3, P.y_prompt, P.y_sample, nullptr, shd););
#elif defined(PEER_SHARD)
    PHASE(PH_PG1, peer_sharded_phase(P, C, 1, P.X3, P.X3B, P.y_prompt, P.y_sample, nullptr); __syncthreads(); peer_phase(P, C, 1, P.X3, P.y_prompt, P.y_sample, nullptr););
#else
    PHASE(PH_PG1, peer_phase(P, C, 1, P.X3, P.y_prompt, P.y_sample, nullptr););
#endif
#undef IN
#undef SEAM
}
}
#ifndef ONE_LAUNCH
#define ONE_LAUNCH 1
#endif
extern "C" void kernel_launch(void* const* d_in, const int* in_sizes, int n_in, void* d_out, int out_size, void* d_ws, size_t ws_size, hipStream_t stream) {
    fx::Args a; memset(&a, 0, sizeof(a)); fx::bind_io(a.p, d_in, (float*)d_out);
    const size_t f_need = fx::carve(a.p, d_ws);
    if (f_need > ws_size) { fprintf(stderr, "kernel_launch: workspace too small: need %zu have %zu\n", f_need, ws_size); return; }
    static int grid = 0;
    if (!grid) { int dev = 0, cus = 0, per_cu = 0; (void)hipGetDevice(&dev); (void)hipDeviceGetAttribute(&cus, hipDeviceAttributeMultiprocessorCount, dev);
        (void)hipFuncSetAttribute((const void*)fx::mega, hipFuncAttributeMaxDynamicSharedMemorySize, fx::LDS_BYTES);
        if (hipOccupancyMaxActiveBlocksPerMultiprocessor(&per_cu, (const void*)fx::mega, fx::NTHREADS, fx::LDS_BYTES) != hipSuccess || per_cu < 1) { fprintf(stderr, "kernel_launch: occupancy query says %d blocks per CU\n", per_cu); (void)hipGetLastError(); }
        grid = cus; }
    (void)hipMemsetAsync(a.p.ctl, 0, fx::CTL_BYTES, stream);
#if ONE_LAUNCH
    a.lo = 0; a.hi = fx::PH_COUNT; hipLaunchKernelGGL(fx::mega, dim3(grid), dim3(fx::NTHREADS), fx::LDS_BYTES, stream, a);
#else
    for (int k = 0; k < fx::PH_COUNT; ++k) { a.lo = k; a.hi = k + 1; hipLaunchKernelGGL(fx::mega, dim3(grid), dim3(fx::NTHREADS), fx::LDS_BYTES, stream, a); }
#endif
}
```

```cpp
#define PEER_SHARD2 1
#define ONE_LAUNCH 1
#include <hip/hip_runtime.h>
#include <cstdio>
#include <cstring>
#include <cmath>
#ifdef CPU_TEST
#define HD inline
constexpr int D_MODEL = 128, BATCH = 2, SEQ = 512, DEPTH = 2, DEC_BATCH = 3, DEC_SEQ = 1, PAST_LEN = 512, PAGE_SIZE = 128;
constexpr int DIL_W[3] = {16, 64, 256}, DIL_D[3] = {1, 4, 16}, DIL_TAPS = 17;
constexpr int MEM_TOKENS = 32, SLC_TOPK = 4, SWA_WINDOW = 64, PEER_KEYS = 16, PEER_TOPK = 4;
#else
#define HD __host__ __device__ __forceinline__
constexpr int D_MODEL = 1024, BATCH = 2, SEQ = 8192, DEPTH = 2, DEC_BATCH = 32, DEC_SEQ = 1, PAST_LEN = 8192, PAGE_SIZE = 128;
constexpr int DIL_W[3] = {128, 512, 2048}, DIL_D[3] = {1, 4, 16}, DIL_TAPS = 129;
constexpr int MEM_TOKENS = 256, SLC_TOPK = 16, SWA_WINDOW = 512, PEER_KEYS = 128, PEER_TOPK = 16;
#endif
HD constexpr int dil_w(int g) { return g == 0 ? DIL_W[0] : (g == 1 ? DIL_W[1] : DIL_W[2]); }
HD constexpr int dil_d(int g) { return g == 0 ? DIL_D[0] : (g == 1 ? DIL_D[1] : DIL_D[2]); }
constexpr int HEAD_DIM = 64, N_A_LAYERS = DEPTH / 2, N_DIL = 3, DIL_HEADS = 4, DIL_COLS = N_DIL * 3 * DIL_HEADS * HEAD_DIM;
constexpr int MEM_HEADS = 4, MEM_COLS = MEM_HEADS * HEAD_DIM;
constexpr int NSA_HEADS = 12, NSA_KV_HEADS = 2, NSA_GROUP = 6, NSA_Q_COLS = NSA_HEADS * HEAD_DIM, NSA_GATE_COLS = NSA_HEADS * 3;
constexpr int CMP_BLOCK = 32, CMP_STRIDE = 16, CMP_HIDDEN = 128, SLC_BLOCK = 64;
constexpr int PEER_EXPERTS = PEER_KEYS * PEER_KEYS, PEER_HEADS = 8, PEER_KEY_DIM = 128;
constexpr float FORCE_SCORE = 1.0e9f, NEG = -1.0e30f, SCALE = 0.125f, LN_EPS = 1e-5f;
constexpr float ALPHA = 1.41421356237309515f;
constexpr float BETA = 0.5f;
#define LAS __attribute__((address_space(3)))
namespace pg8 {
#define PG8_LAS __attribute__((address_space(3)))
typedef unsigned short bf16_t;
typedef short bf16x8 __attribute__((ext_vector_type(8)));
typedef float f32x4 __attribute__((ext_vector_type(4)));
typedef unsigned u32x4 __attribute__((ext_vector_type(4)));
constexpr int BM = 256, BK = 64, HALF = 128, HTB = HALF * BK * 2  , STAGE_BYTES = 8 * HTB, NXCD = 8, WGM = 8;

__host__ __device__ __forceinline__ int lds_byte(int r, int c) { const int st = (r >> 4) * 2 + (c >> 5), rr = r & 15, cc = c & 31, ob = rr * 64 + cc * 2; return st * 1024 + (ob ^ (((ob >> 9) & 1) << 5)); }
__host__ __device__ __forceinline__ void stage_rc(int b, int& R, int& C) { const int st = b / 1024, sb = b % 1024, swz = sb ^ (((sb >> 9) & 1) << 5); R = (st >> 1) * 16 + swz / 64; C = (st & 1) * 32 + (swz % 64) / 2; }
__host__ __device__ __forceinline__ int perm32(int rho) { const int n = rho >> 4, i = rho & 15; return 8 * (i >> 2) + 4 * n + (i & 3); }

struct Unit { int pm, pn; };
struct Gemm { const bf16_t* A; const bf16_t* Bt; int M, N, K; };

struct StaticOrder {
    int nM, nN, nwg, G, c;
    __host__ __device__ void init(int M, int N, int G_, int c_) { nM = M / BM; nN = N / BM; nwg = nM * nN; G = G_; c = c_; }
    __host__ __device__ bool next(int i, Unit& u) const {
        const long L = (long)i * G + c; if (L >= nwg) return false;
        int wgid = (int)L; { const int q = nwg / NXCD, r = nwg % NXCD, xcd = wgid % NXCD, off = wgid / NXCD; wgid = (xcd < r ? xcd * (q + 1) : r * (q + 1) + (xcd - r) * q) + off; }
        const int nig = WGM * nN, gid = wgid / nig, fm = gid * WGM, gsz = (nM - fm) < WGM ? (nM - fm) : WGM;
        u.pm = fm + ((wgid % nig) % gsz); u.pn = (wgid % nig) / gsz; return true;
    }
    __device__ __forceinline__ void a_ready(const Unit&) const {}
    __device__ __forceinline__ void done(const Unit&) const {}
};

__device__ __forceinline__ unsigned cvt_pk_bf16(float lo, float hi) { unsigned r; asm volatile("v_cvt_pk_bf16_f32 %0, %1, %2" : "=v"(r) : "v"(lo), "v"(hi)); return r; }
typedef float f32x2 __attribute__((ext_vector_type(2)));
typedef float f32x2 __attribute__((ext_vector_type(2)));
template <class Epi, class Sched, bool ALIGN_EPI = false, bool SP2 = false>
__device__ __forceinline__ void gemm_phase(PG8_LAS unsigned char* lds, const Gemm g, const Sched& S, const Epi& E) {
    const int tid = threadIdx.x, wid = __builtin_amdgcn_readfirstlane(tid >> 6), lane = tid & 63, wr = wid >> 2, wc = wid & 3, fr = lane & 15, fq = lane >> 4;
    const int K = g.K, nt = K / BK;
    unsigned voffA[2], voffB[2];
#pragma unroll
    for (int i = 0; i < 2; ++i) { int R, C; stage_rc(tid * 16 + i * 8192, R, C); const int Rb = Epi::PERM ? ((R & ~31) + perm32(R & 31)) : R;
        voffA[i] = (unsigned)(R * K + C) * 2u; voffB[i] = (unsigned)(Rb * K + C) * 2u; }
    const size_t kstep = (size_t)(BK * 2);
    const size_t hstep = (size_t)HALF * K * 2;
    const size_t tstep = 2 * hstep;
    const unsigned ldsw = (unsigned)wid * 1024u;
    const int aoff = lds_byte(wr * 64 + fr, fq * 8), boff = lds_byte(wc * 32 + fr, fq * 8);
#define PG8_SA(b, h) (((b) * 2 + (h)) * HTB)
#define PG8_SB(b, h) ((4 + (b) * 2 + (h)) * HTB)
#define PG8_STAGE(bufoff, gbase, voff) do { _Pragma("unroll") for (int _i = 0; _i < 2; ++_i) \
        __builtin_amdgcn_global_load_lds((const unsigned*)((const char*)(gbase) + (voff)[_i]), (PG8_LAS unsigned*)(lds + (bufoff) + ldsw + _i * 8192), 16, 0, 0); } while (0)
#define PG8_LDA(dst, b, h) do { _Pragma("unroll") for (int m = 0; m < 4; ++m) _Pragma("unroll") for (int k = 0; k < 2; ++k) dst[m][k] = *(const PG8_LAS bf16x8*)(lds + PG8_SA(b, h) + aoff + m * 2048 + k * 1024); } while (0)
#define PG8_LDB(dst, b, h) do { _Pragma("unroll") for (int n = 0; n < 2; ++n) _Pragma("unroll") for (int k = 0; k < 2; ++k) dst[n][k] = *(const PG8_LAS bf16x8*)(lds + PG8_SB(b, h) + boff + n * 2048 + k * 1024); } while (0)
#define PG8_MMA(ai, bj, At, Bt) do { __builtin_amdgcn_s_setprio(1); _Pragma("unroll") for (int m = 0; m < 4; ++m) _Pragma("unroll") for (int n = 0; n < 2; ++n) _Pragma("unroll") for (int k = 0; k < 2; ++k) \
        acc[ai][bj][m][n] = __builtin_amdgcn_mfma_f32_16x16x32_bf16(Bt[n][k], At[m][k], acc[ai][bj][m][n], 0, 0, 0); __builtin_amdgcn_s_setprio(0); } while (0)
#define PG8_WAIT_V(n) asm volatile("s_waitcnt vmcnt(" #n ")" ::: "memory")
#define PG8_WAIT_L(n) asm volatile("s_waitcnt lgkmcnt(" #n ")" ::: "memory")
#define PG8_BAR __builtin_amdgcn_s_barrier()
#define PG8_SCHED __builtin_amdgcn_sched_barrier(0)
    Unit cur, nxt; int ui = 0;
    if (!S.next(0, cur)) return;
    f32x4 acc[2][2][4][2];
#pragma unroll
    for (int a = 0; a < 2; ++a)
#pragma unroll
        for (int b = 0; b < 2; ++b)
#pragma unroll
            for (int m = 0; m < 4; ++m)
#pragma unroll
                for (int n = 0; n < 2; ++n) acc[a][b][m][n] = (f32x4){0.f, 0.f, 0.f, 0.f};
    bf16x8 At[4][2], B0[2][2], B1[2][2];
    const char* cA = (const char*)g.A + (size_t)cur.pm * tstep; const char* cB = (const char*)g.Bt + (size_t)cur.pn * tstep;
    S.a_ready(cur);
    if constexpr (SP2) {
        PG8_STAGE(PG8_SB(0, 0), cB, voffB); PG8_STAGE(PG8_SB(0, 1), cB + hstep, voffB); PG8_STAGE(PG8_SA(0, 0), cA, voffA); PG8_STAGE(PG8_SA(0, 1), cA + hstep, voffA);
        if (wr == 1) PG8_BAR;
        PG8_WAIT_V(2); PG8_BAR;
        PG8_STAGE(PG8_SB(1, 0), cB + kstep, voffB); PG8_STAGE(PG8_SA(1, 0), cA + kstep, voffA); PG8_STAGE(PG8_SB(1, 1), cB + hstep + kstep, voffB);
        PG8_WAIT_V(6); PG8_BAR;
    } else {
        PG8_STAGE(PG8_SB(0, 0), cB, voffB); PG8_STAGE(PG8_SA(0, 0), cA, voffA); PG8_STAGE(PG8_SB(0, 1), cB + hstep, voffB); PG8_STAGE(PG8_SA(0, 1), cA + hstep, voffA);
        if (wr == 1) PG8_BAR;
        PG8_WAIT_V(4); PG8_BAR;
        PG8_STAGE(PG8_SB(1, 0), cB + kstep, voffB); PG8_STAGE(PG8_SA(1, 0), cA + kstep, voffA); PG8_STAGE(PG8_SB(1, 1), cB + hstep + kstep, voffB);
        PG8_WAIT_V(6); PG8_BAR;
    }
    for (;;) {
        const bool has_next = S.next(ui + 1, nxt);
        const char* nA = has_next ? (const char*)g.A + (size_t)nxt.pm * tstep : cA; const char* nB = has_next ? (const char*)g.Bt + (size_t)nxt.pn * tstep : cB;
        for (int t = 0; t < nt; t += 2) {
            const bool last = (t == nt - 2);
            const char* a1 = cA + (size_t)(t + 1) * kstep;
            const char* a2 = last ? nA : cA + (size_t)(t + 2) * kstep; const char* b2 = last ? nB : cB + (size_t)(t + 2) * kstep;
            const char* a3 = a2 + kstep; const char* b3 = b2 + kstep;
            if (last && has_next) S.a_ready(nxt);
            if constexpr (SP2) {
            PG8_LDB(B0, 0, 0); PG8_LDB(B1, 0, 1); PG8_SCHED; PG8_LDA(At, 0, 0); PG8_STAGE(PG8_SA(1, 1), a1 + hstep, voffA);
            PG8_WAIT_V(8); PG8_WAIT_L(0); PG8_BAR; PG8_MMA(0, 0, At, B0); PG8_MMA(0, 1, At, B1); PG8_BAR; PG8_SCHED;
            PG8_LDA(At, 0, 1); PG8_STAGE(PG8_SB(0, 0), b2, voffB); PG8_STAGE(PG8_SB(0, 1), b2 + hstep, voffB); PG8_STAGE(PG8_SA(0, 0), a2, voffA);
            PG8_WAIT_V(8); PG8_WAIT_L(0); PG8_BAR; PG8_MMA(1, 0, At, B0); PG8_MMA(1, 1, At, B1); PG8_BAR; PG8_SCHED;
            PG8_LDB(B0, 1, 0); PG8_LDB(B1, 1, 1); PG8_SCHED; PG8_LDA(At, 1, 0); PG8_STAGE(PG8_SA(0, 1), a2 + hstep, voffA);
            PG8_WAIT_V(8); PG8_WAIT_L(0); PG8_BAR; PG8_MMA(0, 0, At, B0); PG8_MMA(0, 1, At, B1); PG8_BAR; PG8_SCHED;
            PG8_LDA(At, 1, 1); PG8_STAGE(PG8_SB(1, 0), b3, voffB); PG8_STAGE(PG8_SB(1, 1), b3 + hstep, voffB); PG8_STAGE(PG8_SA(1, 0), a3, voffA);
            PG8_WAIT_V(8); PG8_WAIT_L(0); PG8_BAR; PG8_MMA(1, 0, At, B0); PG8_MMA(1, 1, At, B1); PG8_BAR; PG8_SCHED;
            } else {
            PG8_LDB(B0, 0, 0); PG8_SCHED; PG8_LDA(At, 0, 0); PG8_STAGE(PG8_SA(1, 1), a1 + hstep, voffA);
            PG8_WAIT_L(8); PG8_BAR; PG8_WAIT_L(0); PG8_MMA(0, 0, At, B0); PG8_BAR; PG8_SCHED;
            PG8_LDB(B1, 0, 1); PG8_STAGE(PG8_SB(0, 0), b2, voffB);
            PG8_BAR; PG8_WAIT_L(0); PG8_MMA(0, 1, At, B1); PG8_BAR;
            PG8_LDA(At, 0, 1); PG8_STAGE(PG8_SA(0, 0), a2, voffA);
            PG8_BAR; PG8_WAIT_L(0); PG8_MMA(1, 0, At, B0); PG8_BAR; PG8_SCHED;
            PG8_STAGE(PG8_SB(0, 1), b2 + hstep, voffB);
            PG8_WAIT_V(6); PG8_BAR; PG8_MMA(1, 1, At, B1); PG8_BAR;
            PG8_LDB(B0, 1, 0); PG8_SCHED; PG8_LDA(At, 1, 0); PG8_STAGE(PG8_SA(0, 1), a2 + hstep, voffA);
            PG8_WAIT_L(8); PG8_BAR; PG8_WAIT_L(0); PG8_MMA(0, 0, At, B0); PG8_BAR; PG8_SCHED;
            PG8_LDB(B1, 1, 1); PG8_STAGE(PG8_SB(1, 0), b3, voffB);
            PG8_BAR; PG8_WAIT_L(0); PG8_MMA(0, 1, At, B1); PG8_BAR;
            PG8_LDA(At, 1, 1); PG8_STAGE(PG8_SA(1, 0), a3, voffA);
            PG8_BAR; PG8_WAIT_L(0); PG8_MMA(1, 0, At, B0); PG8_BAR; PG8_SCHED;
            PG8_STAGE(PG8_SB(1, 1), b3 + hstep, voffB);
            PG8_WAIT_V(6); PG8_BAR; PG8_MMA(1, 1, At, B1); PG8_BAR;
            }
        }
        if constexpr (ALIGN_EPI) { if (wr == 0) PG8_BAR; }
        if constexpr (!Epi::AFTER_DRAIN) { E(acc, cur, wr, wc, fr, fq); S.done(cur); }
        if (!has_next) break;
#pragma unroll
        for (int a = 0; a < 2; ++a)
#pragma unroll
            for (int b = 0; b < 2; ++b)
#pragma unroll
                for (int m = 0; m < 4; ++m)
#pragma unroll
                    for (int n = 0; n < 2; ++n) acc[a][b][m][n] = (f32x4){0.f, 0.f, 0.f, 0.f};
        cur = nxt; cA = nA; cB = nB; ++ui;
        if constexpr (ALIGN_EPI) { if (wr == 1) PG8_BAR; }
    }
    PG8_WAIT_V(0);
    if constexpr (!ALIGN_EPI) { if (wr == 0) PG8_BAR; }
    PG8_BAR;
    if constexpr (Epi::AFTER_DRAIN) { E.fused(acc, cur, wr, wc, fr, fq, lds, wid, lane); S.done(cur); }
#undef PG8_SA
#undef PG8_SB
#undef PG8_STAGE
#undef PG8_LDA
#undef PG8_LDB
#undef PG8_MMA
#undef PG8_WAIT_V
#undef PG8_WAIT_L
#undef PG8_BAR
#undef PG8_SCHED
}
}
#define XB_TMO      128
#define XB_XCNT(j)  (256  + 64 * (j))
#define XB_XSUB(j)  (1280 + 64 * (j))
#define XB_XGEN(j)  (2304 + 64 * (j))
#define XB_TOP      3328
#define XB_TOPGEN   3392
#define XCD_BAR_WORDS 3456
#define XB_SPIN_CAP (1u << 18)

__device__ __forceinline__ unsigned xb_ld(unsigned* p)              { return __hip_atomic_load(p, __ATOMIC_RELAXED, __HIP_MEMORY_SCOPE_AGENT); }
__device__ __forceinline__ unsigned xb_add(unsigned* p, unsigned v) { return __hip_atomic_fetch_add(p, v, __ATOMIC_RELAXED, __HIP_MEMORY_SCOPE_AGENT); }
__device__ __forceinline__ unsigned xb_xcc_id() { return (unsigned)__builtin_amdgcn_s_getreg((3 << 11) | 20) & 0xFu; }
#define XB_SPIN(cond, bar) do { unsigned _sp = 0; while (cond) { __builtin_amdgcn_s_sleep(1); \
    if ((++_sp & 255u) == 0u) { if (xb_ld(&(bar)[XB_TMO])) break; if (_sp > XB_SPIN_CAP) { atomicAdd(&(bar)[XB_TMO], 1u); break; } } } } while (0)

struct XcdBarrier {
    unsigned* bar; unsigned x;
    volatile LAS unsigned* st;
};

__device__ __forceinline__ XcdBarrier xcd_barrier_post(unsigned* bar, volatile LAS unsigned* st) {
    XcdBarrier b; b.bar = bar; b.x = xb_xcc_id(); b.st = st;
    if (threadIdx.x == 0) (void)xb_add(&bar[XB_XCNT(b.x)], 1u);
    return b;
}
__device__ __forceinline__ void xcd_barrier_complete(unsigned* bar, unsigned x, unsigned& nloc, unsigned& nx) {
    const unsigned G = gridDim.x * gridDim.y * gridDim.z;
    unsigned sum, cnt, mine, sp = 0u;
    for (;;) {
        sum = 0u; cnt = 0u; mine = 0u;
#pragma unroll
        for (unsigned j = 0; j < 16; ++j) { const unsigned c = xb_ld(&bar[XB_XCNT(j)]); sum += c; cnt += (c > 0u) ? 1u : 0u; mine = (j == x) ? c : mine; }
        if (sum == G) break;
        __builtin_amdgcn_s_sleep(1);
        if ((++sp & 255u) == 0u) { if (xb_ld(&bar[XB_TMO])) break; if (sp > XB_SPIN_CAP) { atomicAdd(&bar[XB_TMO], 1u); break; } }
    }
    nloc = mine > 0u ? mine : 1u; nx = cnt > 0u ? cnt : 1u;
}

__device__ __forceinline__ void xcd_barrier(const XcdBarrier& b) {
    asm volatile("s_waitcnt vmcnt(0)" ::: "memory");
    __syncthreads();
    if (threadIdx.x == 0) {
        unsigned* bar = b.bar;
        __builtin_amdgcn_s_waitcnt(0);
        unsigned nloc = b.st[0], nx = b.st[1];
        if (nloc == 0u) { xcd_barrier_complete(bar, b.x, nloc, nx); b.st[0] = nloc; b.st[1] = nx; }
        const unsigned old = xb_add(&bar[XB_XSUB(b.x)], 1u);
        const unsigned gen = old / nloc;
        if (old + 1u == (gen + 1u) * nloc) {
            __builtin_amdgcn_fence(__ATOMIC_RELEASE, "agent");
            asm volatile("s_waitcnt vmcnt(0)" ::: "memory");
            const unsigned og = xb_add(&bar[XB_TOP], 1u);
            const unsigned tg = og / nx;
            if (og + 1u == (tg + 1u) * nx) xb_add(&bar[XB_TOPGEN], 1u);
            else XB_SPIN(xb_ld(&bar[XB_TOPGEN]) == tg, bar);
            __builtin_amdgcn_fence(__ATOMIC_ACQUIRE, "agent");
            xb_add(&bar[XB_XGEN(b.x)], 1u);
            asm volatile("s_waitcnt vmcnt(0)" ::: "memory");
        } else {
            XB_SPIN(xb_ld(&bar[XB_XGEN(b.x)]) == gen, bar);
            __builtin_amdgcn_fence(__ATOMIC_ACQUIRE, "agent");
            asm volatile("s_waitcnt vmcnt(0)" ::: "memory");
        }
    }
    __syncthreads();
}
namespace fx {
#define DI __device__ __forceinline__
typedef unsigned short bf16;
typedef short bf16x8 __attribute__((ext_vector_type(8)));
typedef float f32x4 __attribute__((ext_vector_type(4)));
typedef float f32x2 __attribute__((ext_vector_type(2)));
typedef unsigned u32x4 __attribute__((ext_vector_type(4)));
typedef unsigned u32x2 __attribute__((ext_vector_type(2)));
constexpr int M0 = BATCH * SEQ, MP = M0 + DEC_BATCH, MPAD = ((MP + 255) / 256) * 256;
constexpr int ACOLS = DIL_COLS + MEM_COLS, BCOLS = NSA_Q_COLS + NSA_GATE_COLS + MEM_COLS, KVCOLS = 6 * NSA_KV_HEADS * HEAD_DIM;
constexpr int NB_T = 2048;
constexpr int NPK = PEER_HEADS * 2 * PEER_KEYS;
constexpr int NCMP = (SEQ - CMP_BLOCK) / CMP_STRIDE + 1;
constexpr int NCH = SEQ / CMP_STRIDE;
constexpr int NCTX = BATCH + DEC_BATCH;
constexpr int ACROWS = NCTX * NSA_KV_HEADS * NCH;
constexpr int NPOS = PAST_LEN + 1;
constexpr float QSCALE = 0.125f * 1.4426950408889634f;
constexpr int NTHREADS = 512, NWAVES = 8, LDS_BYTES = 147456, RING_BYTES = 131072, MISC_OFF = RING_BYTES + 320;

struct FP {
    const float *x_prompt, *x_sample, *mem_prompt, *cache_dil[3], *cache_nsa_kv, *cache_nsa_win, *cache_mem_kv; const int* page_table;
    const float *w_in_a, *w_out_a, *w_in_b, *w_out_b, *w_mem_kv, *w_kv_b, *cmp_pe, *cmp_w1, *cmp_w2, *ln_g, *ln_b, *peer_wq, *peer_keys, *peer_u, *peer_v;
    float *y_prompt, *y_sample, *dil_p[3], *dil_s[3], *nsa_kv_p, *nsa_kv_s, *win_p, *win_s, *mem_kv_p;
    unsigned* ctl;
    bf16 *XB0, *X1B, *X2B, *X3B, *WA_T, *WMEM_T, *MEMB, *WOA_T, *WOB_T, *WPK_T, *WB_T, *CW1_T, *AC; unsigned char *UB8, *VB8;
    float *ROPE, *CBIAS;
    bf16 *QA, *KA, *VTA, *MQA, *MK, *MVT, *ATTA;
    float *DPART, *DML, *PRE, *X1, *X2, *X3, *SCO, *SELG; int* SELE;
    bf16 *SLK, *SLVT, *WNK, *WNVT, *QB, *MQB, *CK, *CVT, *ATTB;
    float *GATES, *UL, *CKF, *CVF;
    int* SELB;
    float* DBG;
};
struct Args { FP p; int lo, hi; };
struct Carve { size_t off = 0; template <class T> T* take(void* base, size_t n) { T* r = (T*)((char*)base + off); off += ((n * sizeof(T) + 255) / 256) * 256; return r; } };
constexpr size_t CTL_BYTES = 65536;
inline size_t carve(FP& p, void* base) {
    Carve c;
    p.ctl = c.take<unsigned>(base, CTL_BYTES / 4);
    p.XB0 = c.take<bf16>(base, (size_t)MPAD * D_MODEL); p.X1B = c.take<bf16>(base, (size_t)MPAD * D_MODEL); p.X2B = c.take<bf16>(base, (size_t)MPAD * D_MODEL); p.X3B = c.take<bf16>(base, (size_t)MPAD * D_MODEL);
    p.WA_T = c.take<bf16>(base, (size_t)ACOLS * D_MODEL); p.WMEM_T = c.take<bf16>(base, (size_t)DEPTH * 2 * MEM_COLS * D_MODEL); p.MEMB = c.take<bf16>(base, (size_t)BATCH * MEM_TOKENS * D_MODEL);
    p.WOA_T = c.take<bf16>(base, (size_t)D_MODEL * 2 * MEM_COLS); p.WOB_T = c.take<bf16>(base, (size_t)D_MODEL * (NSA_Q_COLS + MEM_COLS));
    p.WPK_T = c.take<bf16>(base, (size_t)DEPTH * NPK * D_MODEL); p.WB_T = c.take<bf16>(base, (size_t)NB_T * D_MODEL);
    p.UB8 = c.take<unsigned char>(base, (size_t)DEPTH * PEER_EXPERTS * D_MODEL); p.VB8 = c.take<unsigned char>(base, (size_t)DEPTH * PEER_EXPERTS * D_MODEL);
    p.CW1_T = c.take<bf16>(base, (size_t)2 * 256 * 1024); p.AC = c.take<bf16>(base, (size_t)2 * ACROWS * 1024);
    p.ROPE = c.take<float>(base, (size_t)NPOS * 64); p.CBIAS = c.take<float>(base, 2 * CMP_HIDDEN);
    p.QA = c.take<bf16>(base, (size_t)3 * MPAD * 256); p.KA = c.take<bf16>(base, (size_t)3 * MPAD * 256); p.VTA = c.take<bf16>(base, (size_t)3 * BATCH * DIL_HEADS * HEAD_DIM * SEQ + 4096);
    p.MQA = c.take<bf16>(base, (size_t)MPAD * 256); p.MK = c.take<bf16>(base, (size_t)DEPTH * BATCH * MEM_TOKENS * MEM_COLS); p.MVT = c.take<bf16>(base, (size_t)DEPTH * BATCH * MEM_COLS * MEM_TOKENS);
    p.ATTA = c.take<bf16>(base, (size_t)MPAD * 2 * MEM_COLS);
    p.DPART = c.take<float>(base, (size_t)3 * MP * DIL_HEADS * HEAD_DIM); p.DML = c.take<float>(base, (size_t)3 * MP * DIL_HEADS * 2);
    p.PRE = c.take<float>(base, (size_t)MPAD * D_MODEL); p.X1 = c.take<float>(base, (size_t)MPAD * D_MODEL); p.X2 = c.take<float>(base, (size_t)MPAD * D_MODEL); p.X3 = c.take<float>(base, (size_t)MPAD * D_MODEL);
    p.SCO = c.take<float>(base, (size_t)MPAD * NPK); p.SELG = c.take<float>(base, (size_t)MP * 128); p.SELE = c.take<int>(base, (size_t)MP * 128);
    p.SLK = c.take<bf16>(base, (size_t)BATCH * NSA_KV_HEADS * SEQ * HEAD_DIM); p.SLVT = c.take<bf16>(base, (size_t)BATCH * NSA_KV_HEADS * SEQ * HEAD_DIM);
    p.WNK = c.take<bf16>(base, (size_t)BATCH * NSA_KV_HEADS * SEQ * HEAD_DIM + 4096); p.WNVT = c.take<bf16>(base, (size_t)BATCH * NSA_KV_HEADS * SEQ * HEAD_DIM + 4096);
    p.QB = c.take<bf16>(base, (size_t)MPAD * NSA_Q_COLS); p.MQB = c.take<bf16>(base, (size_t)MPAD * 256);
    p.CK = c.take<bf16>(base, (size_t)NCTX * NSA_KV_HEADS * NCH * HEAD_DIM); p.CVT = c.take<bf16>(base, (size_t)NCTX * NSA_KV_HEADS * HEAD_DIM * NCH); p.ATTB = c.take<bf16>(base, (size_t)MPAD * (NSA_Q_COLS + MEM_COLS));
    p.GATES = c.take<float>(base, (size_t)MPAD * 64); p.UL = c.take<float>(base, (size_t)2 * ACROWS * 256);
    p.CKF = c.take<float>(base, (size_t)DEC_BATCH * NSA_KV_HEADS * NCH * HEAD_DIM); p.CVF = c.take<float>(base, (size_t)DEC_BATCH * NSA_KV_HEADS * NCH * HEAD_DIM);
    p.SELB = c.take<int>(base, (size_t)MP * NSA_KV_HEADS * 16);
#ifdef NSA_DEBUG
    p.DBG = c.take<float>(base, (size_t)3 * MP * 768);
#else
    p.DBG = nullptr;
#endif
    return c.off;
}
inline void bind_io(FP& p, void* const* d_in, float* out) {
    p.x_prompt = (const float*)d_in[0]; p.x_sample = (const float*)d_in[1]; p.mem_prompt = (const float*)d_in[2]; p.cache_dil[0] = (const float*)d_in[3]; p.cache_dil[1] = (const float*)d_in[4]; p.cache_dil[2] = (const float*)d_in[5];
    p.cache_nsa_kv = (const float*)d_in[6]; p.cache_nsa_win = (const float*)d_in[7]; p.cache_mem_kv = (const float*)d_in[8]; p.page_table = (const int*)d_in[9];
    p.w_in_a = (const float*)d_in[10]; p.w_out_a = (const float*)d_in[11]; p.w_in_b = (const float*)d_in[12]; p.w_out_b = (const float*)d_in[13]; p.w_mem_kv = (const float*)d_in[14]; p.w_kv_b = (const float*)d_in[15];
    p.cmp_pe = (const float*)d_in[16]; p.cmp_w1 = (const float*)d_in[17]; p.cmp_w2 = (const float*)d_in[18]; p.ln_g = (const float*)d_in[19]; p.ln_b = (const float*)d_in[20];
    p.peer_wq = (const float*)d_in[21]; p.peer_keys = (const float*)d_in[22]; p.peer_u = (const float*)d_in[23]; p.peer_v = (const float*)d_in[24];
    size_t o = 0; auto take = [&](size_t n) { float* r = out + o; o += n; return r; };
    p.y_prompt = take((size_t)M0 * D_MODEL); p.y_sample = take((size_t)DEC_BATCH * D_MODEL);
    for (int g = 0; g < 3; ++g) p.dil_p[g] = take((size_t)BATCH * DIL_W[g] * 2 * DIL_HEADS * HEAD_DIM);
    for (int g = 0; g < 3; ++g) p.dil_s[g] = take((size_t)DEC_BATCH * DIL_W[g] * 2 * DIL_HEADS * HEAD_DIM);
    p.nsa_kv_p = take((size_t)M0 * 4 * NSA_KV_HEADS * HEAD_DIM); p.nsa_kv_s = take((size_t)DEC_BATCH * 4 * NSA_KV_HEADS * HEAD_DIM);
    p.win_p = take((size_t)BATCH * SWA_WINDOW * 2 * NSA_KV_HEADS * HEAD_DIM); p.win_s = take((size_t)DEC_BATCH * SWA_WINDOW * 2 * NSA_KV_HEADS * HEAD_DIM);
    p.mem_kv_p = take((size_t)DEPTH * BATCH * MEM_TOKENS * 2 * MEM_COLS);
}
DI unsigned f2bf(float f) { unsigned u = __builtin_bit_cast(unsigned, f); return (u + 0x7fffu + ((u >> 16) & 1u)) >> 16; }
DI unsigned pk2(float lo, float hi) { return f2bf(lo) | (f2bf(hi) << 16); }
DI float bf2f(unsigned short b) { return __builtin_bit_cast(float, (unsigned)b << 16); }
DI float bflo(unsigned w) { return __builtin_bit_cast(float, w << 16); }
DI float bfhi(unsigned w) { return __builtin_bit_cast(float, w & 0xffff0000u); }
template <int CTRL> DI float dpp1(float x) { return __builtin_bit_cast(float, __builtin_amdgcn_update_dpp(0, __builtin_bit_cast(int, x), CTRL, 0xF, 0xF, true)); }
DI float wave_sum(float v) { v += dpp1<0xB1>(v); v += dpp1<0x4E>(v); v += dpp1<0x141>(v); v += dpp1<0x140>(v);
    float a = v, b = v; asm volatile("s_nop 1\n\tv_permlane16_swap_b32 %0, %1" : "+v"(a), "+v"(b)); v = a + b; a = v; b = v;
    asm volatile("s_nop 1\n\tv_permlane32_swap_b32 %0, %1" : "+v"(a), "+v"(b)); return a + b; }
DI float wave_max(float v) { v = fmaxf(v, dpp1<0xB1>(v)); v = fmaxf(v, dpp1<0x4E>(v)); v = fmaxf(v, dpp1<0x141>(v)); v = fmaxf(v, dpp1<0x140>(v));
    float a = v, b = v; asm volatile("s_nop 1\n\tv_permlane16_swap_b32 %0, %1" : "+v"(a), "+v"(b)); v = fmaxf(a, b); a = v; b = v;
    asm volatile("s_nop 1\n\tv_permlane32_swap_b32 %0, %1" : "+v"(a), "+v"(b)); return fmaxf(a, b); }
DI float gelu_tanh(float x) { const float u = 0.7978845608028654f * (x + 0.044715f * x * x * x); const float e = __builtin_amdgcn_exp2f(u * 2.885390081777927f);   const float t = 1.0f - 2.0f / (e + 1.0f); return 0.5f * x * (1.0f + t); }
DI float* sel3(float* const (&a)[3], int g) { return g == 0 ? a[0] : (g == 1 ? a[1] : a[2]); }
DI const float* sel3c(const float* const (&a)[3], int g) { return g == 0 ? a[0] : (g == 1 ? a[1] : a[2]); }
__host__ DI size_t ktile_off(int t, int d) { const int blk = t >> 5, kk = t & 31, b = (kk >> 2) & 1, i = 4 * (kk >> 3) + (kk & 3), s = d >> 5, c = (d & 31) >> 3; return ((size_t)(blk * 4 + 2 * b + s) * 64 + i + 16 * c) * 8 + (d & 7); }
__host__ DI size_t vtile_off(int dim, int t) { const int blk = t >> 5, kk = t & 31; return ((size_t)(blk * 4 + (dim >> 4)) * 64 + (dim & 15) + 16 * (kk >> 3)) * 8 + (kk & 7); }
struct Ctx { LAS unsigned char* lds; int tid, lane, wave, vcu, G; };
DI int row_pos(int r) { return r < M0 ? (r & (SEQ - 1)) : PAST_LEN; }

struct ColSrc { const float* p; int ld; };
DI int rope_il(int e) { return (e >> 1) + 32 * (e & 1); }
DI ColSrc col_wa(const FP& P, int n) {
    const int t = n >> 8, ct = n & 255, h = ct >> 6, e = ct & 63; if (t >= 9) return ColSrc{P.w_in_a + DIL_COLS + ct, ACOLS};
    const int j = t % 3, d = (j < 2) ? rope_il(e) : e; return ColSrc{P.w_in_a + t * 256 + h * 64 + d, ACOLS}; }
DI ColSrc col_wb(const FP& P, int n) {
    const int t = n >> 8, ct = n & 255, e = ct & 63;
    if (t < 3) { const int ty = 2 * t + (ct >> 7), kvh = (ct >> 6) & 1; const bool rot = (ty == 2 || ty == 4); return ColSrc{P.w_kv_b + (ty * NSA_KV_HEADS + kvh) * 64 + (rot ? rope_il(e) : e), KVCOLS}; }
    if (t < 6) { const int h = (t - 3) * 4 + (ct >> 6); return ColSrc{P.w_in_b + h * 64 + rope_il(e), BCOLS}; }
    if (t == 6) return ColSrc{P.w_in_b + NSA_Q_COLS + NSA_GATE_COLS + ct, BCOLS};
    if (ct < NSA_GATE_COLS) return ColSrc{P.w_in_b + NSA_Q_COLS + ct, BCOLS};
    return ColSrc{nullptr, 0}; }
DI ColSrc col_wmem(const FP& P, int n) { const int l = n >> 9, c = n & 511; return ColSrc{P.w_mem_kv + (size_t)l * D_MODEL * 512 + c, 512}; }
DI ColSrc col_woa(const FP& P, int n) { return ColSrc{P.w_out_a + n, D_MODEL}; }
DI ColSrc col_wob(const FP& P, int n) { return ColSrc{P.w_out_b + n, D_MODEL}; }
DI ColSrc col_cw1(const FP& P, int n) {
    const int ty = n >> 8, half = (n >> 7) & 1, hid = n & 127; return ColSrc{P.cmp_w1 + (size_t)ty * CMP_BLOCK * HEAD_DIM * CMP_HIDDEN + (size_t)half * 16 * HEAD_DIM * CMP_HIDDEN + hid, CMP_HIDDEN}; }
template <class CF> DI void transpose_item(const FP& P, CF cf, int K, bf16* WT, LAS float* scr, int item, int nblk, int lane) {
    const int kb = item / nblk, nb = item % nblk, k0 = 64 * kb, n0 = 32 * nb;
    const ColSrc cs = cf(P, n0 + (lane & 31));
#pragma unroll 8
    for (int i = 0; i < 32; ++i) { const int kk = 2 * i + (lane >> 5); scr[kk * 33 + (lane & 31)] = cs.p ? cs.p[(size_t)(k0 + kk) * cs.ld] : 0.f; }
    asm volatile("s_waitcnt lgkmcnt(0)" ::: "memory");
    const int c = lane & 7;
#pragma unroll
    for (int j = 0; j < 4; ++j) { const int n = (lane >> 3) + 8 * j; const LAS float* s = scr + (8 * c) * 33 + n;
        u32x4 o; o.x = pk2(s[0 * 33], s[1 * 33]); o.y = pk2(s[2 * 33], s[3 * 33]); o.z = pk2(s[4 * 33], s[5 * 33]); o.w = pk2(s[6 * 33], s[7 * 33]);
        *(u32x4*)(WT + (size_t)(n0 + n) * K + k0 + 8 * c) = o; }
    asm volatile("s_waitcnt lgkmcnt(0)" ::: "memory");
}
DI void cvt_row1024(const float* src, bf16* dst, int lane) {
#pragma unroll
    for (int j = 0; j < 4; ++j) { f32x4 v = src ? *(const f32x4*)(src + 256 * j + 4 * lane) : (f32x4){0.f, 0.f, 0.f, 0.f}; u32x2 o; o.x = pk2(v.x, v.y); o.y = pk2(v.z, v.w); *(u32x2*)(dst + 256 * j + 4 * lane) = o; }
}
DI void cvt_row1024_fp8(const float* src, unsigned char* dst, float sc, int lane) { u32x4 o; unsigned w[4];
#pragma unroll
    for (int j = 0; j < 4; ++j) { const f32x4 v = *(const f32x4*)(src + 16 * lane + 4 * j) * sc; int t = __builtin_amdgcn_cvt_pk_fp8_f32(v.x, v.y, 0, false); t = __builtin_amdgcn_cvt_pk_fp8_f32(v.z, v.w, t, true); w[j] = (unsigned)t; }
    o.x = w[0]; o.y = w[1]; o.z = w[2]; o.w = w[3]; *(u32x4*)(dst + 16 * lane) = o; }
DI void p0_prologue(const FP& P, const Ctx& C) {
    LAS float* scr = (LAS float*)(C.lds + C.wave * 16384);
    const int gw = C.vcu * NWAVES + C.wave, NGW = C.G * NWAVES, lane = C.lane; const int gwT0 = C.wave * C.G + C.vcu;
    { constexpr int IA = (D_MODEL / 64) * (ACOLS / 32), IM = (D_MODEL / 64) * (1024 / 32);
      for (int it = gwT0; it < IA + IM; it += NGW) { int r = it;
          if (r < IA) { transpose_item(P, col_wa, D_MODEL, P.WA_T, scr, r, ACOLS / 32, lane); continue; } r -= IA;
          transpose_item(P, col_wmem, D_MODEL, P.WMEM_T, scr, r, 1024 / 32, lane); } }
    for (int r = gw; r < M0 - NGW; r += 2 * NGW) {
        f32x4 v[8];
#pragma unroll
        for (int j = 0; j < 8; ++j) v[j] = *(const f32x4*)(P.x_prompt + (size_t)(r + (j >> 2) * NGW) * D_MODEL + 256 * (j & 3) + 4 * lane);
#pragma unroll
        for (int j = 0; j < 8; ++j) { u32x2 o; o.x = pk2(v[j].x, v[j].y); o.y = pk2(v[j].z, v[j].w); *(u32x2*)(P.XB0 + (size_t)(r + (j >> 2) * NGW) * D_MODEL + 256 * (j & 3) + 4 * lane) = o; } }
    for (int r = gw + ((M0 - NGW - gw + 2 * NGW - 1) / (2 * NGW)) * (2 * NGW); r < MPAD; r += NGW) { cvt_row1024(r < M0 ? P.x_prompt + (size_t)r * D_MODEL : (r < MP ? P.x_sample + (size_t)(r - M0) * D_MODEL : nullptr), P.XB0 + (size_t)r * D_MODEL, lane);
        if (r >= MP) { cvt_row1024(nullptr, P.X1B + (size_t)r * D_MODEL, lane); cvt_row1024(nullptr, P.X2B + (size_t)r * D_MODEL, lane); cvt_row1024(nullptr, P.X3B + (size_t)r * D_MODEL, lane);
            for (int c = lane; c < 512; c += 64) { P.ATTA[(size_t)r * 512 + c] = 0; P.ATTB[(size_t)r * 1024 + c] = 0; P.ATTB[(size_t)r * 1024 + 512 + c] = 0; } } }
    for (int r = gw; r < BATCH * MEM_TOKENS; r += NGW) cvt_row1024(P.mem_prompt + (size_t)r * D_MODEL, P.MEMB + (size_t)r * D_MODEL, lane);
    for (int i = gw * 64 + lane; i < NPOS * 32; i += NGW * 64) { const int pos = i >> 5, d = i & 31; const double inv = exp2(-(double)d * (13.287712379549449 / 32.0)); const double turns = (double)pos * inv * 0.15915494309189535;
        const float fr = (float)(turns - floor(turns)); P.ROPE[pos * 64 + d] = __builtin_amdgcn_cosf(fr); P.ROPE[pos * 64 + 32 + d] = __builtin_amdgcn_sinf(fr); }
}
constexpr int WPK_ITEMS = DEPTH * 16 * (D_MODEL / 64);
DI void wpk_item(const FP& P, const Ctx& C, int it) {
    LAS float* sw = (LAS float*)C.lds;
    LAS float* sk = (LAS float*)(C.lds + 32768);
    const int l = it / (16 * (D_MODEL / 64)), rem = it % (16 * (D_MODEL / 64)), hc = rem / (D_MODEL / 64), kb = rem % (D_MODEL / 64);
    __syncthreads();
    for (int i = C.tid; i < 64 * 64; i += NTHREADS) { const int r = i >> 6, d = i & 63; sw[r * 65 + d] = P.peer_wq[((size_t)l * D_MODEL + kb * 64 + r) * 1024 + hc * 64 + d]; }
    for (int i = C.tid; i < 128 * 64; i += NTHREADS) { const int r = i >> 6, d = i & 63; sk[r * 68 + d] = P.peer_keys[(((size_t)l * 16 + hc) * PEER_KEYS + r) * 64 + d]; }
    __syncthreads();
    { const int ki = C.lane, kk0 = C.wave; float a[16];
#pragma unroll
      for (int j = 0; j < 16; ++j) a[j] = 0.f;
#pragma unroll 2
      for (int d = 0; d < 64; d += 4) { const float w0 = sw[ki * 65 + d], w1 = sw[ki * 65 + d + 1], w2 = sw[ki * 65 + d + 2], w3 = sw[ki * 65 + d + 3];
#pragma unroll
          for (int j = 0; j < 16; ++j) { const f32x4 kq = *(const LAS f32x4*)(sk + (kk0 + 8 * j) * 68 + d); a[j] += w0 * kq.x + w1 * kq.y + w2 * kq.z + w3 * kq.w; } }
#pragma unroll
      for (int j = 0; j < 16; ++j) P.WPK_T[((size_t)l * NPK + hc * 128 + kk0 + 8 * j) * D_MODEL + kb * 64 + ki] = (bf16)f2bf(a[j]); }
    __syncthreads();
}
constexpr int T1_OA = (512 / 64) * (D_MODEL / 32), T1_OB = (1024 / 64) * (D_MODEL / 32), T1_B = (D_MODEL / 64) * (NB_T / 32), T1_C = (1024 / 64) * (512 / 32), T1_ITEMS = T1_OA + T1_OB + T1_B + T1_C;
constexpr int AC_ITEMS = DEC_BATCH * (PAST_LEN / PAGE_SIZE) * (PAGE_SIZE / 8), CB_ITEMS = 2 * CMP_HIDDEN;
constexpr int bgq_cache_n(int g) { return (DEC_BATCH * ((g < 3 ? dil_w(g) : SWA_WINDOW) - 1) * (g < 3 ? 128 : 64) + 8191) / 8192; }
constexpr int BGQ_T1 = (T1_ITEMS + 7) / 8, BGQ_L_A = BGQ_T1 + WPK_ITEMS, BGQ_UV = DEPTH * PEER_EXPERTS / 16, BGQ_L_UV = BGQ_L_A + BGQ_UV;
constexpr int BGQ_AC = (AC_ITEMS + 7) / 8, BGQ_CB = (CB_ITEMS + 7) / 8, BGQ_L_AC = BGQ_L_UV + BGQ_AC + BGQ_CB;
constexpr int BGQ_TOTAL = BGQ_L_AC + bgq_cache_n(0) + bgq_cache_n(1) + bgq_cache_n(2) + bgq_cache_n(3);
constexpr int BGQ_CTR = 12288;
DI void bg_chunk(const FP& P, const Ctx& C, int c) {
    const int lane = C.lane;
    if (c < BGQ_T1) { int r = c * 8 + C.wave; LAS float* scr = (LAS float*)(C.lds + C.wave * 16384);
        if (r < T1_ITEMS) {
            if (r < T1_OA) transpose_item(P, col_woa, 512, P.WOA_T, scr, r, D_MODEL / 32, lane);
            else if ((r -= T1_OA) < T1_OB) transpose_item(P, col_wob, 1024, P.WOB_T, scr, r, D_MODEL / 32, lane);
            else if ((r -= T1_OB) < T1_B) transpose_item(P, col_wb, D_MODEL, P.WB_T, scr, r, NB_T / 32, lane);
            else transpose_item(P, col_cw1, 1024, P.CW1_T, scr, r - T1_B, 512 / 32, lane); }
        return; }
    if (c < BGQ_L_A) { wpk_item(P, C, c - BGQ_T1); return; }
    c -= BGQ_L_A;
    if (c < BGQ_UV) {
        { const int r = c * 16 + C.wave * 2; f32x4 a[16];
#pragma unroll
            for (int q = 0; q < 4; ++q) { const float* s0 = (q < 2 ? P.peer_u : P.peer_v) + (size_t)(r + (q & 1)) * D_MODEL + 16 * lane;
#pragma unroll
                for (int j = 0; j < 4; ++j) a[4 * q + j] = *(const f32x4*)(s0 + 4 * j); }
#pragma unroll
            for (int q = 0; q < 4; ++q) { const float sc = q < 2 ? 256.f : 64.f; unsigned w[4];
#pragma unroll
                for (int j = 0; j < 4; ++j) { const f32x4 v = a[4 * q + j] * sc; int t = __builtin_amdgcn_cvt_pk_fp8_f32(v.x, v.y, 0, false); t = __builtin_amdgcn_cvt_pk_fp8_f32(v.z, v.w, t, true); w[j] = (unsigned)t; }
                u32x4 o; o.x = w[0]; o.y = w[1]; o.z = w[2]; o.w = w[3]; *(u32x4*)((q < 2 ? P.UB8 : P.VB8) + (size_t)(r + (q & 1)) * D_MODEL + 16 * lane) = o; } }
        return; }
    c -= BGQ_UV;
    if (c < BGQ_AC) { const int it2 = c * 8 + C.wave;
        if (it2 < AC_ITEMS) { const int it = it2 / (PAGE_SIZE / 8), rg = it2 % (PAGE_SIZE / 8);
            const int n = it / (PAST_LEN / PAGE_SIZE), pi = it % (PAST_LEN / PAGE_SIZE); const int pg = P.page_table[it];
            const float* src = P.cache_nsa_kv + (size_t)pg * PAGE_SIZE * 512 + 4 * lane; const int ty = lane >> 5, kvh = (lane >> 4) & 1, d = (4 * lane) & 63;
            bf16* dst = P.AC + ((size_t)ty * ACROWS + ((size_t)(BATCH + n) * NSA_KV_HEADS + kvh) * NCH + pi * (PAGE_SIZE / 16)) * 1024 + d;
            const int r0 = rg * 8; f32x4 v[8];
#pragma unroll
            for (int u = 0; u < 8; ++u) v[u] = *(const f32x4*)(src + (size_t)(r0 + u) * 512);
#pragma unroll
            for (int u = 0; u < 8; ++u) { const int t = r0 + u; u32x2 o; o.x = pk2(v[u].x, v[u].y); o.y = pk2(v[u].z, v[u].w); *(u32x2*)(dst + (size_t)(t / 16) * 1024 + (t % 16) * 64) = o; } }
        return; }
    c -= BGQ_AC;
    if (c < BGQ_CB) { const int i = c * 8 + C.wave;
        if (i < CB_ITEMS) { const int ty = i / CMP_HIDDEN, hid = i % CMP_HIDDEN; float a = 0.f;
#pragma unroll 8
            for (int k = lane; k < CMP_BLOCK * HEAD_DIM; k += 64) a += P.cmp_pe[ty * CMP_BLOCK * HEAD_DIM + k] * P.cmp_w1[((size_t)ty * CMP_BLOCK * HEAD_DIM + k) * CMP_HIDDEN + hid];
            a = wave_sum(a); if (lane == 0) P.CBIAS[i] = a; }
        return; }
    c -= BGQ_CB;
    int g = 0; if (c >= bgq_cache_n(0)) { c -= bgq_cache_n(0); g = 1; if (c >= bgq_cache_n(1)) { c -= bgq_cache_n(1); g = 2; if (c >= bgq_cache_n(2)) { c -= bgq_cache_n(2); g = 3; } } }
    const int W = g < 3 ? dil_w(g) : SWA_WINDOW, RV = g < 3 ? 128 : 64;
    const f32x4* src = (const f32x4*)(g < 3 ? sel3c(P.cache_dil, g) : P.cache_nsa_win); f32x4* dst = (f32x4*)(g < 3 ? sel3(P.dil_s, g) : P.win_s);
    const int per = (W - 1) * RV, nvec = DEC_BATCH * per;
    const int i0 = c * 8192 + C.wave * 1024;
    if (i0 < nvec) { f32x4 v[16]; int idx[16];
        const int n0 = __builtin_amdgcn_readfirstlane((int)((unsigned)i0 / (unsigned)per)), o0 = i0 - n0 * per;
#pragma unroll
        for (int u = 0; u < 16; ++u) { int o = o0 + u * 64 + lane, n = n0; if (o >= per) { o -= per; ++n; } if (n >= DEC_BATCH) { n = DEC_BATCH - 1; o = per - 1; } idx[u] = n * (per + RV) + o; v[u] = src[(size_t)idx[u] + RV]; }
#pragma unroll
        for (int u = 0; u < 16; ++u) { const int i = i0 + u * 64 + lane; if (i < nvec) dst[(size_t)idx[u]] = v[u]; } }
}
DI void bgq_drain(const FP& P, const Ctx& C, volatile LAS unsigned* slot, int limit) {
#pragma unroll 1
    for (;;) {
        __syncthreads();
        if (C.tid == 0) *slot = atomicAdd(P.ctl + BGQ_CTR, 1u);
        __syncthreads();
        const int c = (int)*slot;
        if (c < BGQ_TOTAL) bg_chunk(P, C, c);
        if (c >= limit) break;
    }
    __syncthreads();
}
DI void xcd_barrier_bg(const XcdBarrier& b, const FP& P, const Ctx& C, volatile LAS unsigned* slot  ) {
    asm volatile("s_waitcnt vmcnt(0)" ::: "memory");
    __syncthreads();
    if (threadIdx.x == 0) {
        unsigned* bar = b.bar;
        __builtin_amdgcn_s_waitcnt(0);
        unsigned nloc = b.st[0], nx = b.st[1];
        if (nloc == 0u) { xcd_barrier_complete(bar, b.x, nloc, nx); b.st[0] = nloc; b.st[1] = nx; }
        const unsigned old = xb_add(&bar[XB_XSUB(b.x)], 1u);
        const unsigned gen = old / nloc;
        if (old + 1u == (gen + 1u) * nloc) {
            __builtin_amdgcn_fence(__ATOMIC_RELEASE, "agent");
            asm volatile("s_waitcnt vmcnt(0)" ::: "memory");
            const unsigned og = xb_add(&bar[XB_TOP], 1u);
            const unsigned tg = og / nx;
            if (og + 1u == (tg + 1u) * nx) xb_add(&bar[XB_TOPGEN], 1u);
            else XB_SPIN(xb_ld(&bar[XB_TOPGEN]) == tg, bar);
            __builtin_amdgcn_fence(__ATOMIC_ACQUIRE, "agent");
            xb_add(&bar[XB_XGEN(b.x)], 1u);
            asm volatile("s_waitcnt vmcnt(0)" ::: "memory");
            slot[2] = 1u;
        } else { slot[1] = gen; slot[2] = 0u; }
    }
    __syncthreads();
    unsigned spins = 0;
#pragma unroll 1
    while (slot[2] == 0u) {
        if (threadIdx.x == 0) {
            unsigned c = (unsigned)BGQ_TOTAL;
            if (xb_ld(&b.bar[XB_XGEN(b.x)]) != slot[1] || xb_ld(&b.bar[XB_TMO]) != 0u) {
                __builtin_amdgcn_fence(__ATOMIC_ACQUIRE, "agent");
                asm volatile("s_waitcnt vmcnt(0)" ::: "memory");
                slot[2] = 1u;
            } else if (xb_ld(P.ctl + BGQ_CTR) < (unsigned)BGQ_TOTAL) {
                const unsigned nloc = b.st[0], nx = b.st[1], gen = slot[1];
                const unsigned arr = xb_ld(&b.bar[XB_XSUB(b.x)]) - gen * nloc, top = xb_ld(&b.bar[XB_TOP]) - gen * nx;
                if (arr + 3u <= nloc || (arr >= nloc && top + 2u <= nx)) c = atomicAdd(P.ctl + BGQ_CTR, 1u);
                else __builtin_amdgcn_s_sleep(1);
            }
            else { __builtin_amdgcn_s_sleep(1); if (++spins > XB_SPIN_CAP) { atomicAdd(&b.bar[XB_TMO], 1u); } }
            slot[0] = c;
        }
        __syncthreads();
        const bool rel = slot[2] != 0u; const int c = (int)slot[0];
        if (!rel && c < BGQ_TOTAL) bg_chunk(P, C, c);
        __syncthreads();
    }
}
#define EPI_LOOP(...) int fr_l = fr, fq_l = fq; asm volatile("" : "+v"(fr_l), "+v"(fq_l));     \
    _Pragma("unroll") for (int ai = 0; ai < 2; ++ai) _Pragma("unroll") for (int m = 0; m < 4; ++m) { const int row = u.pm * 256 + ai * 128 + wr * 64 + m * 16 + fr_l; \
    _Pragma("unroll") for (int bj = 0; bj < 2; ++bj) { const int ct = bj * 128 + wc * 32 + fq_l * 8; const f32x4 v0 = acc[ai][bj][m][0], v1 = acc[ai][bj][m][1]; __VA_ARGS__ } asm volatile("" ::: "memory"); }
DI void rope4(const float* rope_row, int dp, const f32x4& v0, const f32x4& v1, f32x4& lo, f32x4& hi) {
    const f32x4 c = *(const f32x4*)(rope_row + dp), s = *(const f32x4*)(rope_row + 32 + dp);
    lo.x = v0.x * c.x - v0.y * s.x; hi.x = v0.y * c.x + v0.x * s.x; lo.y = v0.z * c.y - v0.w * s.y; hi.y = v0.w * c.y + v0.z * s.y;
    lo.z = v1.x * c.z - v1.y * s.z; hi.z = v1.y * c.z + v1.x * s.z; lo.w = v1.z * c.w - v1.w * s.w; hi.w = v1.w * c.w + v1.z * s.w; }
DI u32x2 pk4(const f32x4& v) { u32x2 o; o.x = pk2(v.x, v.y); o.y = pk2(v.z, v.w); return o; }
DI u32x4 pk8(const f32x4& a, const f32x4& b) { u32x4 o; o.x = pk2(a.x, a.y); o.y = pk2(a.z, a.w); o.z = pk2(b.x, b.y); o.w = pk2(b.z, b.w); return o; }
DI int dil_perm(int t, int d) { return (t % d) * (SEQ / d) + t / d; }
#ifdef EPIA_REP
#define EPIA_REP_BEGIN _Pragma("unroll 1") for (int rep_ = 0; rep_ < EPIA_REP; ++rep_) {
#define EPIA_REP_END }
#else
#define EPIA_REP_BEGIN
#define EPIA_REP_END
#endif
struct EpiA {
    static constexpr bool PERM = true, AFTER_DRAIN = false; const FP& P;
    DI void operator()(const f32x4 (&acc)[2][2][4][2], const pg8::Unit& u, int wr, int wc, int fr, int fq) const {
        const int t9 = u.pn; const int g = t9 / 3, j = t9 % 3;
        EPIA_REP_BEGIN EPI_LOOP({ if (row < MP) { const int h = ct >> 6, e = ct & 63; const int pos = row_pos(row);
            if (t9 == 9) { *(u32x4*)(P.MQA + (size_t)row * 256 + ct) = pk8(v0 * QSCALE, v1 * QSCALE); }
            else if (j < 2) { f32x4 lo, hi; const int dp = e >> 1; rope4(P.ROPE + pos * 64, dp, v0, v1, lo, hi);
                if (j == 0) { bf16* q = P.QA + ((size_t)g * MPAD + row) * 256 + h * 64 + dp; *(u32x2*)q = pk4(lo * QSCALE); *(u32x2*)(q + 32) = pk4(hi * QSCALE); }
                else { if (row < M0) { bf16* kt = P.KA + ((size_t)(g * BATCH + row / SEQ) * DIL_HEADS + h) * 64 * SEQ; const int cm = dil_perm(pos, dil_d(g)); *(u32x2*)(kt + ktile_off(cm, dp)) = pk4(lo); *(u32x2*)(kt + ktile_off(cm, dp + 32)) = pk4(hi); }
                    const int W = dil_w(g); float* o = nullptr;
                    if (row >= M0) o = sel3(P.dil_s, g) + (((size_t)(row - M0) * W + W - 1) * 2 + 0) * 256; else if (pos >= SEQ - W) o = sel3(P.dil_p, g) + (((size_t)(row / SEQ) * W + pos - (SEQ - W)) * 2 + 0) * 256;
                    if (o) { *(f32x4*)(o + h * 64 + dp) = lo; *(f32x4*)(o + h * 64 + 32 + dp) = hi; } } }
            else { const int W = dil_w(g), d = dil_d(g); float* o = nullptr;
                if (row >= M0) o = sel3(P.dil_s, g) + (((size_t)(row - M0) * W + W - 1) * 2 + 1) * 256; else if (pos >= SEQ - W) o = sel3(P.dil_p, g) + (((size_t)(row / SEQ) * W + pos - (SEQ - W)) * 2 + 1) * 256;
                if (o) { *(f32x4*)(o + ct) = v0; *(f32x4*)(o + ct + 4) = v1; }
                if (row < M0) { bf16* vt = P.VTA + ((size_t)(g * BATCH + row / SEQ) * DIL_HEADS + h) * 64 * SEQ + vtile_off(e, dil_perm(pos, d));
                    vt[0] = (bf16)f2bf(v0.x); vt[8] = (bf16)f2bf(v0.y); vt[16] = (bf16)f2bf(v0.z); vt[24] = (bf16)f2bf(v0.w); vt[32] = (bf16)f2bf(v1.x); vt[40] = (bf16)f2bf(v1.y); vt[48] = (bf16)f2bf(v1.z); vt[56] = (bf16)f2bf(v1.w); } } } }) EPIA_REP_END
    }
};
struct EpiMem {
    static constexpr bool PERM = true, AFTER_DRAIN = false; const FP& P;
    DI void operator()(const f32x4 (&acc)[2][2][4][2], const pg8::Unit& u, int wr, int wc, int fr, int fq) const {
        const int l = u.pn >> 1, half = u.pn & 1;
        EPI_LOOP({ const int n = row / MEM_TOKENS, mt = row % MEM_TOKENS; float* o = P.mem_kv_p + (((size_t)l * BATCH + n) * MEM_TOKENS + mt) * 512 + half * 256 + ct; *(f32x4*)o = v0; *(f32x4*)(o + 4) = v1;
            if (half == 0) *(u32x4*)(P.MK + (((size_t)l * BATCH + n) * MEM_HEADS + (ct >> 6)) * MEM_TOKENS * 64 + ktile_off(mt, ct & 63)) = pk8(v0, v1);
            else { bf16* vt = P.MVT + (((size_t)l * BATCH + n) * MEM_HEADS + (ct >> 6)) * MEM_TOKENS * 64 + vtile_off(ct & 63, mt);
                vt[0] = (bf16)f2bf(v0.x); vt[8] = (bf16)f2bf(v0.y); vt[16] = (bf16)f2bf(v0.z); vt[24] = (bf16)f2bf(v0.w); vt[32] = (bf16)f2bf(v1.x); vt[40] = (bf16)f2bf(v1.y); vt[48] = (bf16)f2bf(v1.z); vt[56] = (bf16)f2bf(v1.w); } })
    }
};
struct EpiPre {
    static constexpr bool PERM = true, AFTER_DRAIN = false; const float* xa; const float* xb; float* pre;
    DI void operator()(const f32x4 (&acc)[2][2][4][2], const pg8::Unit& u, int wr, int wc, int fr, int fq) const {
        EPI_LOOP({ if (row < MP) { const int col = u.pn * 256 + ct; const float* x = (xb && row >= M0) ? xb + (size_t)(row - M0) * D_MODEL + col : xa + (size_t)row * D_MODEL + col;
            const f32x4 a = *(const f32x4*)x, b = *(const f32x4*)(x + 4); float* o = pre + (size_t)row * D_MODEL + col; *(f32x4*)o = a * ALPHA + v0; *(f32x4*)(o + 4) = b * ALPHA + v1; } })
    }
};
struct EpiF32 {
    static constexpr bool PERM = true, AFTER_DRAIN = false; float* out; int ldc; int nrows;
    DI void operator()(const f32x4 (&acc)[2][2][4][2], const pg8::Unit& u, int wr, int wc, int fr, int fq) const {
        EPI_LOOP({ if (row < nrows) { float* o = out + (size_t)row * ldc + u.pn * 256 + ct; *(f32x4*)o = v0; *(f32x4*)(o + 4) = v1; } })
    }
};
}
namespace fx {
struct Tile16 { f32x4 o[4]; float m, l; };
DI void tile_init(Tile16& T) { T.o[0] = T.o[1] = T.o[2] = T.o[3] = (f32x4){0.f, 0.f, 0.f, 0.f}; T.m = -INFINITY; T.l = 0.f; }
typedef __bf16 bf16x2_t __attribute__((ext_vector_type(2)));
DI unsigned cvtpk(float lo, float hi) { const f32x2 v = {lo, hi}; const bf16x2_t b = __builtin_convertvector(v, bf16x2_t); return __builtin_bit_cast(unsigned, b); }
struct KV8 { bf16x8 ka0, ka1, kb0, kb1, v0, v1, v2, v3; };
DI void kv_load(KV8& r, const bf16* k0, const bf16* k1, const bf16* v, long vs16) {
    r.ka0 = *(const bf16x8*)k0; r.ka1 = *(const bf16x8*)(k0 + 32); r.kb0 = *(const bf16x8*)k1; r.kb1 = *(const bf16x8*)(k1 + 32);
    r.v0 = *(const bf16x8*)v; r.v1 = *(const bf16x8*)(v + vs16); r.v2 = *(const bf16x8*)(v + 2 * vs16); r.v3 = *(const bf16x8*)(v + 3 * vs16); }
DI void mk_range(int a, int b, bool ok, int& lo, unsigned& rng) { const bool v = ok && b >= a; lo = v ? a : (1 << 20); rng = v ? (unsigned)(b - a) : 0u; }
DI float colmax(float x) { float a = x, b = x; asm volatile("s_nop 1\n\tv_permlane32_swap_b32 %0, %1" : "+v"(a), "+v"(b)); float m = fmaxf(a, b); a = m; b = m;
    asm volatile("s_nop 1\n\tv_permlane16_swap_b32 %0, %1" : "+v"(a), "+v"(b)); return fmaxf(a, b); }
DI float colsum(float x) { float a = x, b = x; asm volatile("s_nop 1\n\tv_permlane32_swap_b32 %0, %1" : "+v"(a), "+v"(b)); float m = a + b; a = m; b = m;
    asm volatile("s_nop 1\n\tv_permlane16_swap_b32 %0, %1" : "+v"(a), "+v"(b)); return a + b; }
DI void tile_compute(Tile16& T, const bf16x8 (&qf)[2], const KV8& r, int lo, unsigned rng) {
    f32x4 s0 = (f32x4){0.f, 0.f, 0.f, 0.f}, s1 = (f32x4){0.f, 0.f, 0.f, 0.f};
    s0 = __builtin_amdgcn_mfma_f32_16x16x32_bf16(r.ka0, qf[0], s0, 0, 0, 0); s0 = __builtin_amdgcn_mfma_f32_16x16x32_bf16(r.ka1, qf[1], s0, 0, 0, 0);
    s1 = __builtin_amdgcn_mfma_f32_16x16x32_bf16(r.kb0, qf[0], s1, 0, 0, 0); s1 = __builtin_amdgcn_mfma_f32_16x16x32_bf16(r.kb1, qf[1], s1, 0, 0, 0);
    float s[8] = {s0.x, s0.y, s0.z, s0.w, s1.x, s1.y, s1.z, s1.w};
    float mx = -INFINITY;
#pragma unroll
    for (int e = 0; e < 8; ++e) { s[e] = ((unsigned)(e - lo) <= rng) ? s[e] : -INFINITY; mx = fmaxf(mx, s[e]); }
    mx = colmax(mx);
    if (__builtin_amdgcn_ballot_w64(mx > T.m + 8.f) != 0ull) {
        const float mnew = fmaxf(T.m, mx), mu = (mnew == -INFINITY) ? 0.f : mnew; const float alpha = __builtin_amdgcn_exp2f(T.m - mu);
        T.l *= alpha; T.m = mnew; T.o[0] *= alpha; T.o[1] *= alpha; T.o[2] *= alpha; T.o[3] *= alpha; }
    const float muse = (T.m == -INFINITY) ? 0.f : T.m;
    float ls = 0.f;
#pragma unroll
    for (int e = 0; e < 8; ++e) { s[e] = __builtin_amdgcn_exp2f(s[e] - muse); ls += s[e]; }
    T.l += ls;
    u32x4 pw; pw.x = cvtpk(s[0], s[1]); pw.y = cvtpk(s[2], s[3]); pw.z = cvtpk(s[4], s[5]); pw.w = cvtpk(s[6], s[7]);
    const bf16x8 pf = __builtin_bit_cast(bf16x8, pw);
    T.o[0] = __builtin_amdgcn_mfma_f32_16x16x32_bf16(r.v0, pf, T.o[0], 0, 0, 0); T.o[1] = __builtin_amdgcn_mfma_f32_16x16x32_bf16(r.v1, pf, T.o[1], 0, 0, 0);
    T.o[2] = __builtin_amdgcn_mfma_f32_16x16x32_bf16(r.v2, pf, T.o[2], 0, 0, 0); T.o[3] = __builtin_amdgcn_mfma_f32_16x16x32_bf16(r.v3, pf, T.o[3], 0, 0, 0);
}
template <class BUF, class LD, class CP> DI void pipe2t(int n, LD ld, CP cp) { if (n <= 0) return; BUF A, B; ld(A, 0);
#pragma unroll 1
    for (int i = 0; i < n; i += 2) { ld(B, (i + 1 < n) ? i + 1 : i); cp(A, i); ld(A, (i + 2 < n) ? i + 2 : i); if (i + 1 < n) cp(B, i + 1); } }
template <class LD, class CP> DI void pipe2(int n, LD ld, CP cp) { if (n <= 0) return; KV8 A, B; ld(A, 0);
#pragma unroll 1
    for (int i = 0; i < n; i += 2) { ld(B, (i + 1 < n) ? i + 1 : i); cp(A, i); ld(A, (i + 2 < n) ? i + 2 : i); if (i + 1 < n) cp(B, i + 1); } }
DI void kv_load_t(KV8& r, const bf16* kt, const bf16* vt, int lane) {
    const bf16* k = kt + lane * 8; const bf16* v = vt + lane * 8;
    r.ka0 = *(const bf16x8*)k; r.ka1 = *(const bf16x8*)(k + 512); r.kb0 = *(const bf16x8*)(k + 1024); r.kb1 = *(const bf16x8*)(k + 1536);
    r.v0 = *(const bf16x8*)v; r.v1 = *(const bf16x8*)(v + 512); r.v2 = *(const bf16x8*)(v + 1024); r.v3 = *(const bf16x8*)(v + 1536); }
DI int krow_of(int i, int b) { return 8 * (i >> 2) + 4 * b + (i & 3); }

DI void dil_micro(const FP& P, int n, int h, int t0, int mt, int lane) {
    const int g = mt >> 4, idx = mt & 15, d = dil_d(g), per = 16 / d;
    const int r = idx / per, sub = idx % per, i0 = t0 / d + 16 * sub, ib = i0 - 128, NC = SEQ / d;
    const int q = lane & 15, c = lane >> 4;
    const bf16* Qb = P.QA + ((size_t)g * MPAD + (size_t)n * SEQ) * 256 + h * 64;
    const bf16* Kb = P.KA + ((size_t)(g * BATCH + n) * DIL_HEADS + h) * 64 * SEQ + (size_t)r * NC * 64; const bf16* Vb = P.VTA + ((size_t)(g * BATCH + n) * DIL_HEADS + h) * 64 * SEQ + (size_t)r * NC * 64;
    bf16x8 qf[2]; { const bf16* qp = Qb + (size_t)(r + d * (i0 + q)) * 256 + 8 * c; qf[0] = *(const bf16x8*)qp; qf[1] = *(const bf16x8*)(qp + 32); }
    Tile16 T; tile_init(T);
    const int qi = i0 + q; const int tb0 = ib >> 5  , nblk = ((i0 + 15) >> 5) - tb0 + 1;
    pipe2(nblk, [&](KV8& kv, int i) { int tb = tb0 + i; tb = tb < 0 ? 0 : tb; kv_load_t(kv, Kb + (size_t)tb * 2048, Vb + (size_t)tb * 2048, lane); },
          [&](const KV8& kv, int i) { const int k0 = 32 * (tb0 + i) + 8 * c; int lo; unsigned rng; const int a = qi - (DIL_TAPS - 1); mk_range((a > 0 ? a : 0) - k0, qi - k0, true, lo, rng); tile_compute(T, qf, kv, lo, rng); });
    const int row = n * SEQ + r + d * qi;
    float* op = P.DPART + (((size_t)g * MP + row) * DIL_HEADS + h) * 64 + 4 * c;
#pragma unroll
    for (int db = 0; db < 4; ++db) *(f32x4*)(op + 16 * db) = T.o[db];
    T.l = colsum(T.l);
    if (c == 0) { float* ml = P.DML + (((size_t)g * MP + row) * DIL_HEADS + h) * 2; ml[0] = T.m; ml[1] = T.l; }
}
DI void mem_micro(const FP& P, const bf16* Q  , int ldq, int row0, int layer, int n, int h, bf16* O  , int ldo, int lane) {
    const int q = lane & 15, c = lane >> 4;
    bf16x8 qf[2]; { const bf16* qp = Q + (size_t)(row0 + q) * ldq + 8 * c; qf[0] = *(const bf16x8*)qp; qf[1] = *(const bf16x8*)(qp + 32); }
    const bf16* Kb = P.MK + (((size_t)layer * BATCH + n) * MEM_HEADS + h) * MEM_TOKENS * 64; const bf16* Vb = P.MVT + (((size_t)layer * BATCH + n) * MEM_HEADS + h) * MEM_TOKENS * 64;
    Tile16 T; tile_init(T);
    pipe2(MEM_TOKENS / 32, [&](KV8& kv, int i) { kv_load_t(kv, Kb + (size_t)i * 2048, Vb + (size_t)i * 2048, lane); }, [&](const KV8& kv, int) { tile_compute(T, qf, kv, -8, 64u); });
    const float inv = 1.0f / colsum(T.l); bf16* op = O + (size_t)(row0 + q) * ldo + 4 * c;
#pragma unroll
    for (int db = 0; db < 4; ++db) *(u32x2*)(op + 16 * db) = pk4(T.o[db] * inv);
}
struct Dec { float m, l, o; };
template <class KF, class VF> DI void dec_chunk(Dec& D, const LAS float* q, int nk, KF kf, VF vf, int lane) {
    float s = -INFINITY;
    if (lane < nk) { const float* k = kf(lane); float a = 0.f;
#pragma unroll
        for (int d4 = 0; d4 < 16; ++d4) { const f32x4 kv = *(const f32x4*)(k + 4 * d4); a += kv.x * q[4 * d4] + kv.y * q[4 * d4 + 1] + kv.z * q[4 * d4 + 2] + kv.w * q[4 * d4 + 3]; }
        s = a; }
    const float mx = wave_max(s), mnew = fmaxf(D.m, mx), alpha = __builtin_amdgcn_exp2f(D.m - mnew);
    const float p = (lane < nk) ? __builtin_amdgcn_exp2f(s - mnew) : 0.f;
    D.l = D.l * alpha + wave_sum(p); D.m = mnew; float o = D.o * alpha;
    for (int j0 = 0; j0 < nk; j0 += 8) { float vv[8];
#pragma unroll
        for (int u = 0; u < 8; ++u) { const int jj = (j0 + u < nk) ? j0 + u : nk - 1; vv[u] = vf(jj)[lane]; }
#pragma unroll
        for (int u = 0; u < 8; ++u) { const float pj = (j0 + u < nk) ? __builtin_bit_cast(float, __builtin_amdgcn_readlane(__builtin_bit_cast(int, p), (j0 + u) & 63)) : 0.f; o += pj * vv[u]; } }
    D.o = o;
}
DI float dec_combine(const Ctx& C, const Dec& D) {
    LAS float* cb = (LAS float*)(C.lds + 4096);
    cb[C.wave * 66 + C.lane] = D.o; if (C.lane == 0) { cb[C.wave * 66 + 64] = D.m; cb[C.wave * 66 + 65] = D.l; }
    asm volatile("s_waitcnt lgkmcnt(0)" ::: "memory"); __syncthreads();
    float M = -INFINITY;
#pragma unroll
    for (int ww = 0; ww < NWAVES; ++ww) M = fmaxf(M, cb[ww * 66 + 64]);
    float L = 0.f, o = 0.f;
#pragma unroll
    for (int ww = 0; ww < NWAVES; ++ww) { const float mw = cb[ww * 66 + 64]; const float f = (mw == -INFINITY) ? 0.f : __builtin_amdgcn_exp2f(mw - M); L += f * cb[ww * 66 + 65]; o += f * cb[ww * 66 + C.lane]; }
    return o / L;
}
DI void atta_phase(const FP& P, const Ctx& C) {
    const int lane = C.lane, w = C.wave;
    constexpr int NT = SEQ / 256, NIT = BATCH * NT * DIL_HEADS;
    for (int it = C.vcu; it < NIT; it += C.G) { const int h = it % DIL_HEADS, tt = (it / DIL_HEADS) % NT, n = it / (DIL_HEADS * NT), t0 = tt * 256;
        for (int mt = w; mt < 48; mt += NWAVES) dil_micro(P, n, h, t0, mt, lane);
        asm volatile("s_waitcnt vmcnt(0)" ::: "memory"); __syncthreads();
        for (int i = C.tid; i < 256 * 16; i += NTHREADS) { const int tk = i >> 4, d4 = (i & 15) * 4; const int row = n * SEQ + t0 + tk;
            float mg[3], lg[3]; float M = -INFINITY;
#pragma unroll
            for (int g = 0; g < 3; ++g) { const float* ml = P.DML + (((size_t)g * MP + row) * DIL_HEADS + h) * 2; mg[g] = ml[0]; lg[g] = ml[1]; M = fmaxf(M, mg[g]); }
            f32x4 acc = (f32x4){0.f, 0.f, 0.f, 0.f}; float L = 0.f;
#pragma unroll
            for (int g = 0; g < 3; ++g) { const float wg = __builtin_amdgcn_exp2f(mg[g] - M); L += wg * lg[g]; acc += *(const f32x4*)(P.DPART + (((size_t)g * MP + row) * DIL_HEADS + h) * 64 + d4) * wg; }
            *(u32x2*)(P.ATTA + (size_t)row * 512 + h * 64 + d4) = pk4(acc * (1.0f / L)); }
        for (int mt = w; mt < 16; mt += NWAVES) mem_micro(P, P.MQA + h * 64, 256, n * SEQ + t0 + 16 * mt, 0, n, h, P.ATTA + 256 + h * 64, 512, lane);
        __syncthreads();
    }
    LAS float* qs = (LAS float*)C.lds;
    for (int it = C.vcu; it < DEC_BATCH * DIL_HEADS * 2; it += C.G) { const int kind = it & 1, h = (it >> 1) % DIL_HEADS, ns = (it >> 1) / DIL_HEADS, row = M0 + ns;
        __syncthreads();
        if (kind == 0) { if (C.tid < 192) qs[C.tid] = bf2f(P.QA[((size_t)(C.tid >> 6) * MPAD + row) * 256 + h * 64 + (C.tid & 63)]); } else { if (C.tid < 64) qs[C.tid] = bf2f(P.MQA[(size_t)row * 256 + h * 64 + C.tid]); }
        asm volatile("s_waitcnt lgkmcnt(0)" ::: "memory"); __syncthreads();
        Dec D; D.m = -INFINITY; D.l = 0.f; D.o = 0.f;
        if (kind == 0) { constexpr int CPG = (DIL_TAPS + 63) / 64;
            for (int ck = w; ck < 3 * CPG; ck += NWAVES) { const int g = ck / CPG, j0 = (ck % CPG) * 64; const int W = dil_w(g), d = dil_d(g); const float* cache = sel3c(P.cache_dil, g) + (size_t)ns * W * 512; const float* newrow = sel3(P.dil_s, g) + ((size_t)ns * W + W - 1) * 512;
                const int nk = (DIL_TAPS - j0) < 64 ? (DIL_TAPS - j0) : 64;
                dec_chunk(D, qs + g * 64, nk, [&](int j) { const int tap = j0 + j; return (tap == 0 ? newrow : cache + (size_t)(W - d * tap) * 512) + h * 64; },
                          [&](int j) { const int tap = j0 + j; return (tap == 0 ? newrow : cache + (size_t)(W - d * tap) * 512) + 256 + h * 64; }, lane); } }
        else { const float* mk = P.cache_mem_kv + ((size_t)0 * DEC_BATCH + ns) * MEM_TOKENS * 512;
            for (int ck = w; ck < MEM_TOKENS / 64; ck += NWAVES) { const int j0 = ck * 64; dec_chunk(D, qs, 64, [&](int j) { return mk + (size_t)(j0 + j) * 512 + h * 64; }, [&](int j) { return mk + (size_t)(j0 + j) * 512 + 256 + h * 64; }, lane); } }
        const float o = dec_combine(C, D);
        if (w == 0) P.ATTA[(size_t)row * 512 + (kind == 0 ? 0 : 256) + h * 64 + lane] = (bf16)f2bf(o);
    }
    __syncthreads();
}
DI void ln_phase(const FP& P, const Ctx& C, const float* pre, const float* gam, const float* bet, float* xo, bf16* xb, float* yp, float* ys) {
    const int gw = C.vcu * NWAVES + C.wave, NGW = C.G * NWAVES, lane = C.lane;
    f32x4 nx[4];
    if (gw < MP) {
#pragma unroll
        for (int j = 0; j < 4; ++j) nx[j] = *(const f32x4*)(pre + (size_t)gw * D_MODEL + 256 * j + 4 * lane); }
#pragma unroll 1
    for (int r = gw; r < MP; r += NGW) { f32x4 v[4]; float s = 0.f;
#pragma unroll
        for (int j = 0; j < 4; ++j) v[j] = nx[j];
        { const int rn = (r + NGW < MP) ? r + NGW : r;
#pragma unroll
          for (int j = 0; j < 4; ++j) nx[j] = *(const f32x4*)(pre + (size_t)rn * D_MODEL + 256 * j + 4 * lane); }
        asm volatile("" ::: "memory");
#pragma unroll
        for (int j = 0; j < 4; ++j) s += (v[j].x + v[j].y) + (v[j].z + v[j].w);
        const float mu = wave_sum(s) * (1.0f / D_MODEL); float s2 = 0.f;
#pragma unroll
        for (int j = 0; j < 4; ++j) { v[j] = v[j] - mu; s2 += (v[j].x * v[j].x + v[j].y * v[j].y) + (v[j].z * v[j].z + v[j].w * v[j].w); }
        const float rs = 1.0f / sqrtf(wave_sum(s2) * (1.0f / D_MODEL) + LN_EPS);
#pragma unroll
        for (int j = 0; j < 4; ++j) { const f32x4 gg = *(const f32x4*)(gam + 256 * j + 4 * lane), bb = *(const f32x4*)(bet + 256 * j + 4 * lane); const f32x4 o = v[j] * rs * gg + bb;
            if (xo) *(f32x4*)(xo + (size_t)r * D_MODEL + 256 * j + 4 * lane) = o;
            if (xb) *(u32x2*)(xb + (size_t)r * D_MODEL + 256 * j + 4 * lane) = pk4(o);
            if (yp) { if (r < M0) *(f32x4*)(yp + (size_t)r * D_MODEL + 256 * j + 4 * lane) = o; else *(f32x4*)(ys + (size_t)(r - M0) * D_MODEL + 256 * j + 4 * lane) = o; } }
    }
}
}
namespace fx {
#define INS16(V, I, v_, i_) do { const float _v = (v_); const int _i = (i_); bool _c[16]; _Pragma("unroll") for (int _k = 0; _k < 16; ++_k) _c[_k] = _v > V[_k]; \
    _Pragma("unroll") for (int _k = 15; _k >= 1; --_k) { V[_k] = _c[_k] ? (_c[_k - 1] ? V[_k - 1] : _v) : V[_k]; I[_k] = _c[_k] ? (_c[_k - 1] ? I[_k - 1] : _i) : I[_k]; } \
    V[0] = _c[0] ? _v : V[0]; I[0] = _c[0] ? _i : I[0]; } while (0)
DI void wave_top16_128(float a, float b, int lane, float& outv, int& outi) {
    outv = -INFINITY; outi = 0;
#pragma unroll 1
    for (int k = 0; k < 16; ++k) { const float m = wave_max(fmaxf(a, b)); const unsigned long long ba = __ballot(a == m), bb = __ballot(b == m); int idx;
        if (ba) { const int l = __builtin_ctzll(ba); idx = l; if (lane == l) a = -INFINITY; } else { const int l = __builtin_ctzll(bb); idx = 64 + l; if (lane == l) b = -INFINITY; }
        if (lane == k) { outv = m; outi = idx; } }
}
DI void topk_wave_item(const FP& P, long it, int lane) {
    const float* s = P.SCO + it * 256; float v1, v2; int i1, i2;
    wave_top16_128(s[lane], s[64 + lane], lane, v1, i1); wave_top16_128(s[128 + lane], s[192 + lane], lane, v2, i2);
    int a = 0, rem = lane; bool valid = false;
    for (int aa = 0; aa < 16; ++aa) { const int nb = 16 / (aa + 1); if (!valid) { if (rem < nb) { a = aa; valid = true; } else rem -= nb; } }
    const int b = valid ? rem : 0;
    float cs = __shfl(v1, a) + __shfl(v2, b); const int ce = __shfl(i1, a) * PEER_KEYS + __shfl(i2, b); if (!valid) cs = -INFINITY;
    float tv = -INFINITY; int te = 0;
#pragma unroll 1
    for (int k = 0; k < 16; ++k) { const float m = wave_max(cs); const unsigned long long bm = __ballot(cs == m); const int l = __builtin_ctzll(bm); const int e = __shfl(ce, l); if (lane == l) cs = -INFINITY; if (lane == k) { tv = m; te = e; } }
    const float mx = __shfl(tv, 0); const float ex = (lane < 16) ? __expf(tv - mx) : 0.f; const float z = wave_sum(ex);
    if (lane < 16) { P.SELG[it * 16 + lane] = ex / z; P.SELE[it * 16 + lane] = te; }
}
#define KINS16(V, key_) do { const float _key = (key_); _Pragma("unroll") for (int _k = 15; _k >= 1; --_k) V[_k] = __builtin_amdgcn_fmed3f(V[_k - 1], V[_k], _key); V[0] = fmaxf(V[0], _key); } while (0)
DI float pack_key(float v, unsigned lowbits, unsigned mask) { return __builtin_bit_cast(float, (__builtin_bit_cast(unsigned, v) & ~mask) | lowbits); }
DI void topk_phase(const FP& P, const Ctx& C) {
    const int lane = C.lane; LAS float* st = (LAS float*)(C.lds + C.wave * 16384);
    const int NWI = (M0 * PEER_HEADS) / 64;
    for (int wi = C.vcu * NWAVES + C.wave; wi < NWI; wi += C.G * NWAVES) {
        const long it0 = (long)wi * 64; const long it = it0 + lane;
        float V1[16], V2[16], V3[16];
#pragma unroll
        for (int k = 0; k < 16; ++k) { V1[k] = V2[k] = V3[k] = -INFINITY; }
        f32x4 pv[8];
#pragma unroll
        for (int u = 0; u < 8; ++u) { const int f4 = u * 64 + lane, j = f4 >> 3, q = f4 & 7, hf = q >> 2, c4 = (q & 3) * 4; pv[u] = *(const f32x4*)(P.SCO + (it0 + j) * 256 + hf * 128 + c4); }
#pragma unroll 1
        for (int ch = 0; ch < 8; ++ch) {
#pragma unroll
            for (int u = 0; u < 8; ++u) { const int f4 = u * 64 + lane, j = f4 >> 3, q = f4 & 7, hf = q >> 2, c4 = (q & 3) * 4; const f32x4 v = pv[u];
                st[j * 33 + hf * 16 + c4] = v.x; st[j * 33 + hf * 16 + c4 + 1] = v.y; st[j * 33 + hf * 16 + c4 + 2] = v.z; st[j * 33 + hf * 16 + c4 + 3] = v.w; }
            { const int chn = ch < 7 ? ch + 1 : 7;
#pragma unroll
              for (int u = 0; u < 8; ++u) { const int f4 = u * 64 + lane, j = f4 >> 3, q = f4 & 7, hf = q >> 2, c4 = (q & 3) * 4; pv[u] = *(const f32x4*)(P.SCO + (it0 + j) * 256 + hf * 128 + chn * 16 + c4); } }
            asm volatile("s_waitcnt lgkmcnt(0)" ::: "memory");
#pragma unroll 4
            for (int c = 0; c < 16; ++c) { const float va = st[lane * 33 + c], vb = st[lane * 33 + 16 + c]; const unsigned lb = 127u - (unsigned)(ch * 16 + c); KINS16(V1, pack_key(va, lb, 127u)); KINS16(V2, pack_key(vb, lb, 127u)); }
            asm volatile("s_waitcnt lgkmcnt(0)" ::: "memory");
        }
        LAS int* lc = (LAS int*)st;
        { int ord = 0;
#pragma unroll
          for (int a = 0; a < 16; ++a) { const unsigned ba = __builtin_bit_cast(unsigned, V1[a]); const float va = __builtin_bit_cast(float, ba & ~127u); const int ia = 127 - (int)(ba & 127u);
#pragma unroll
              for (int b = 0; b < 16; ++b) if ((a + 1) * (b + 1) <= 16) { const unsigned bb = __builtin_bit_cast(unsigned, V2[b]); const float vb = __builtin_bit_cast(float, bb & ~127u); const int ib = 127 - (int)(bb & 127u);
                  lc[lane * 51 + ord] = ia * PEER_KEYS + ib; KINS16(V3, pack_key(va + vb, 63u - (unsigned)ord, 63u)); ++ord; } } }
        asm volatile("s_waitcnt lgkmcnt(0)" ::: "memory");
        float g[16]; int e[16]; float z = 0.f; const float vmax = __builtin_bit_cast(float, __builtin_bit_cast(unsigned, V3[0]) & ~63u);
#pragma unroll
        for (int k = 0; k < 16; ++k) { const unsigned bk = __builtin_bit_cast(unsigned, V3[k]); e[k] = lc[lane * 51 + 63 - (int)(bk & 63u)]; g[k] = __expf(__builtin_bit_cast(float, bk & ~63u) - vmax); z += g[k]; }
        const float iz = 1.0f / z;
#pragma unroll
        for (int k4 = 0; k4 < 4; ++k4) { *(f32x4*)(P.SELG + it * 16 + 4 * k4) = (f32x4){g[4 * k4] * iz, g[4 * k4 + 1] * iz, g[4 * k4 + 2] * iz, g[4 * k4 + 3] * iz};
            *(int4*)(P.SELE + it * 16 + 4 * k4) = make_int4(e[4 * k4], e[4 * k4 + 1], e[4 * k4 + 2], e[4 * k4 + 3]); }
        asm volatile("s_waitcnt lgkmcnt(0)" ::: "memory");
    }
    for (int si = C.vcu * NWAVES + C.wave; si < DEC_BATCH * PEER_HEADS; si += C.G * NWAVES) topk_wave_item(P, (long)M0 * PEER_HEADS + si, lane);
    __syncthreads();
}
constexpr float PEER_SU = 256.f, PEER_SV = 64.f;
DI float dot16_fp8(const u32x4& w, const f32x2 (&x2)[8]) { f32x2 a = {0.f, 0.f};
    a += __builtin_amdgcn_cvt_pk_f32_fp8((int)w.x, false) * x2[0]; a += __builtin_amdgcn_cvt_pk_f32_fp8((int)w.x, true) * x2[1];
    a += __builtin_amdgcn_cvt_pk_f32_fp8((int)w.y, false) * x2[2]; a += __builtin_amdgcn_cvt_pk_f32_fp8((int)w.y, true) * x2[3];
    a += __builtin_amdgcn_cvt_pk_f32_fp8((int)w.z, false) * x2[4]; a += __builtin_amdgcn_cvt_pk_f32_fp8((int)w.z, true) * x2[5];
    a += __builtin_amdgcn_cvt_pk_f32_fp8((int)w.w, false) * x2[6]; a += __builtin_amdgcn_cvt_pk_f32_fp8((int)w.w, true) * x2[7];
    return a.x + a.y; }
DI void axpy16_fp8(const u32x4& w, float s, f32x2 (&o2)[8]) { const f32x2 s2 = {s, s};
    o2[0] += __builtin_amdgcn_cvt_pk_f32_fp8((int)w.x, false) * s2; o2[1] += __builtin_amdgcn_cvt_pk_f32_fp8((int)w.x, true) * s2;
    o2[2] += __builtin_amdgcn_cvt_pk_f32_fp8((int)w.y, false) * s2; o2[3] += __builtin_amdgcn_cvt_pk_f32_fp8((int)w.y, true) * s2;
    o2[4] += __builtin_amdgcn_cvt_pk_f32_fp8((int)w.z, false) * s2; o2[5] += __builtin_amdgcn_cvt_pk_f32_fp8((int)w.z, true) * s2;
    o2[6] += __builtin_amdgcn_cvt_pk_f32_fp8((int)w.w, false) * s2; o2[7] += __builtin_amdgcn_cvt_pk_f32_fp8((int)w.w, true) * s2; }
#if defined(PEER_SHARD) || defined(PEER_SHARD2)
#define PEER_FIRST_ROUND nrounds
#else
#define PEER_FIRST_ROUND 0
#endif
template <int CTRL> DI float dppf(float x) { return __builtin_bit_cast(float, __builtin_amdgcn_update_dpp(0, __builtin_bit_cast(int, x), CTRL, 0xF, 0xF, true)); }
DI float rdlane(float v, int l) { return __builtin_bit_cast(float, __builtin_amdgcn_readlane(__builtin_bit_cast(int, v), l)); }
DI void peer_phase(const FP& P, const Ctx& C, int layer, const float* xin, float* fout, float* fout_s, bf16* xb, bool samples_only = false) {
    const int lane = C.lane; const unsigned char* U = P.UB8 + (size_t)layer * PEER_EXPERTS * D_MODEL; const unsigned char* Vt = P.VB8 + (size_t)layer * PEER_EXPERTS * D_MODEL;
    const float* gam = P.ln_g + ((size_t)layer * 2 + 1) * D_MODEL; const float* bet = P.ln_b + ((size_t)layer * 2 + 1) * D_MODEL;
    const int nrounds = (M0 + C.G * NWAVES - 1) / (C.G * NWAVES);
#pragma unroll 1
    for (int rd = samples_only ? nrounds : 0; rd <= nrounds; ++rd) {
        const bool smp = (rd == nrounds); int r = smp ? M0 + C.vcu : rd * C.G * NWAVES + C.vcu * NWAVES + C.wave; if (smp ? (C.vcu >= DEC_BATCH) : (r >= M0)) continue;
        const int pb = smp ? 16 * C.wave : 0, pe = smp ? pb + 16 : 128;
        f32x2 x2[8], o2[8];
#pragma unroll
        for (int j = 0; j < 4; ++j) { const f32x4 a = *(const f32x4*)(xin + (size_t)r * D_MODEL + 16 * lane + 4 * j); x2[2 * j] = (f32x2){a.x, a.y}; x2[2 * j + 1] = (f32x2){a.z, a.w}; }
#pragma unroll
        for (int k = 0; k < 8; ++k) o2[k] = (f32x2){0.f, 0.f};
        const int e_l = P.SELE[(size_t)r * 128 + lane], e_h = P.SELE[(size_t)r * 128 + 64 + lane]; const float g_l = P.SELG[(size_t)r * 128 + lane], g_h = P.SELG[(size_t)r * 128 + 64 + lane];
#pragma unroll 1
        for (int b0 = pb; b0 < pe; b0 += 8) {
            u32x4 uw[8], vw[8];
#pragma unroll
            for (int k = 0; k < 8; ++k) { const int hk = b0 + k; const int e = (hk < 64) ? __builtin_amdgcn_readlane(e_l, hk & 63) : __builtin_amdgcn_readlane(e_h, hk & 63);
                uw[k] = *(const u32x4*)(U + (size_t)e * D_MODEL + 16 * lane); vw[k] = *(const u32x4*)(Vt + (size_t)e * D_MODEL + 16 * lane); }
            float d[8];
#pragma unroll
            for (int k = 0; k < 8; ++k) d[k] = dot16_fp8(uw[k], x2);
            float e4[4], e2[2], e1;
            { const bool hi = lane & 1;
#pragma unroll
              for (int i = 0; i < 4; ++i) { const float keep = hi ? d[4 + i] : d[i], send = hi ? d[i] : d[4 + i]; e4[i] = keep + __shfl_xor(send, 1); } }
            { const bool hi = lane & 2;
#pragma unroll
              for (int i = 0; i < 2; ++i) { const float keep = hi ? e4[2 + i] : e4[i], send = hi ? e4[i] : e4[2 + i]; e2[i] = keep + __shfl_xor(send, 2); } }
            { const bool hi = lane & 4; const float keep = hi ? e2[1] : e2[0], send = hi ? e2[0] : e2[1]; e1 = keep + __shfl_xor(send, 4); }
            e1 += __shfl_xor(e1, 8); e1 += __shfl_xor(e1, 16); e1 += __shfl_xor(e1, 32);
            const int myk = 4 * (lane & 1) + (lane & 2) + ((lane >> 2) & 1); const int myhk = b0 + myk;
            const float myg = (myhk < 64) ? __shfl(g_l, myhk & 63) : __shfl(g_h, myhk & 63);
            const float act = myg * gelu_tanh(e1 * (1.0f / PEER_SU)) * (1.0f / PEER_SV);
#pragma unroll
            for (int k = 0; k < 8; ++k) { const int src = (k >> 2) | (((k >> 1) & 1) << 1) | ((k & 1) << 2); axpy16_fp8(vw[k], rdlane(act, src), o2); }
        }
        if (smp) {
            LAS float* red = (LAS float*)C.lds;
#pragma unroll
            for (int k = 0; k < 8; ++k) { red[C.wave * 1024 + 16 * lane + 2 * k] = o2[k].x; red[C.wave * 1024 + 16 * lane + 2 * k + 1] = o2[k].y; }
            asm volatile("s_waitcnt lgkmcnt(0)" ::: "memory"); __syncthreads();
            if (C.wave == 0) {
#pragma unroll
                for (int k = 0; k < 8; ++k) { float ax = 0.f, ay = 0.f;
#pragma unroll
                    for (int ww = 0; ww < NWAVES; ++ww) { ax += red[ww * 1024 + 16 * lane + 2 * k]; ay += red[ww * 1024 + 16 * lane + 2 * k + 1]; } o2[k] = (f32x2){ax, ay}; } }
            __syncthreads();
            if (C.wave != 0) continue; }
        float s = 0.f;
#pragma unroll
        for (int k = 0; k < 8; ++k) { o2[k] += x2[k] * ALPHA; s += o2[k].x + o2[k].y; }
        const float mu = wave_sum(s) * (1.0f / D_MODEL); float s2 = 0.f;
#pragma unroll
        for (int k = 0; k < 8; ++k) { o2[k] -= mu; s2 += o2[k].x * o2[k].x + o2[k].y * o2[k].y; }
        const float rs = 1.0f / sqrtf(wave_sum(s2) * (1.0f / D_MODEL) + LN_EPS);
        float* frow = (r < M0) ? fout + (size_t)r * D_MODEL : fout_s + (size_t)(r - M0) * D_MODEL;
#pragma unroll
        for (int j = 0; j < 4; ++j) { const int c0 = 16 * lane + 4 * j; const f32x4 gg = *(const f32x4*)(gam + c0), bb = *(const f32x4*)(bet + c0);
            const f32x4 y = (f32x4){o2[2 * j].x * rs, o2[2 * j].y * rs, o2[2 * j + 1].x * rs, o2[2 * j + 1].y * rs} * gg + bb;
            *(f32x4*)(frow + c0) = y; if (xb) *(u32x2*)(xb + (size_t)r * D_MODEL + c0) = pk4(y); }
    }
}
DI void peer_u_phase(const FP& P, const Ctx& C, int layer, const bf16* xb16) {
    const int lane = C.lane; const unsigned char* U = P.UB8 + (size_t)layer * PEER_EXPERTS * D_MODEL;
    const int s = (int)(blockIdx.x & 7), nw = (C.G >> 3) * NWAVES, widx = (int)(blockIdx.x >> 3) * NWAVES + C.wave;
#pragma unroll 1
    for (int r = widx; r < MP; r += nw) {
        const int e0 = P.SELE[(size_t)r * 128 + lane], e1 = P.SELE[(size_t)r * 128 + 64 + lane]; const float g0 = P.SELG[(size_t)r * 128 + lane], g1 = P.SELG[(size_t)r * 128 + 64 + lane];
        unsigned long long b0 = __ballot((e0 >> 11) == s), b1 = __ballot((e1 >> 11) == s);
        if ((b0 | b1) == 0ull) continue;
        f32x2 x2[8]; { const u32x4 xa = *(const u32x4*)(xb16 + (size_t)r * D_MODEL + 16 * lane), xc = *(const u32x4*)(xb16 + (size_t)r * D_MODEL + 16 * lane + 8);
            x2[0] = (f32x2){bflo(xa.x), bfhi(xa.x)}; x2[1] = (f32x2){bflo(xa.y), bfhi(xa.y)}; x2[2] = (f32x2){bflo(xa.z), bfhi(xa.z)}; x2[3] = (f32x2){bflo(xa.w), bfhi(xa.w)};
            x2[4] = (f32x2){bflo(xc.x), bfhi(xc.x)}; x2[5] = (f32x2){bflo(xc.y), bfhi(xc.y)}; x2[6] = (f32x2){bflo(xc.z), bfhi(xc.z)}; x2[7] = (f32x2){bflo(xc.w), bfhi(xc.w)}; }
#pragma unroll 1
        while ((b0 | b1) != 0ull) {
            int hk[8]; u32x4 uw[8]; int nv = 0;
#pragma unroll
            for (int k = 0; k < 8; ++k) { int h;
                if (b0) { h = __builtin_ctzll(b0); b0 &= b0 - 1; ++nv; } else if (b1) { h = 64 + __builtin_ctzll(b1); b1 &= b1 - 1; ++nv; } else h = hk[k > 0 ? k - 1 : 0];
                hk[k] = h; const int e = (h < 64) ? __builtin_amdgcn_readlane(e0, h & 63) : __builtin_amdgcn_readlane(e1, h & 63);
                uw[k] = *(const u32x4*)(U + (size_t)e * D_MODEL + 16 * lane); }
            float d[8];
#pragma unroll
            for (int k = 0; k < 8; ++k) d[k] = dot16_fp8(uw[k], x2);
            float e4[4], e2[2], e1s;
            { const bool hi = lane & 1;
#pragma unroll
              for (int i = 0; i < 4; ++i) { const float keep = hi ? d[4 + i] : d[i], send = hi ? d[i] : d[4 + i]; e4[i] = keep + __shfl_xor(send, 1); } }
            { const bool hi = lane & 2;
#pragma unroll
              for (int i = 0; i < 2; ++i) { const float keep = hi ? e4[2 + i] : e4[i], send = hi ? e4[i] : e4[2 + i]; e2[i] = keep + __shfl_xor(send, 2); } }
            { const bool hi = lane & 4; const float keep = hi ? e2[1] : e2[0], send = hi ? e2[0] : e2[1]; e1s = keep + __shfl_xor(send, 4); }
            e1s += __shfl_xor(e1s, 8); e1s += __shfl_xor(e1s, 16); e1s += __shfl_xor(e1s, 32);
            const int myk = 4 * (lane & 1) + (lane & 2) + ((lane >> 2) & 1);
            int myh = hk[0];
#pragma unroll
            for (int k = 1; k < 8; ++k) myh = (myk == k) ? hk[k] : myh;
            const float ga = __shfl(g0, myh & 63), gb = __shfl(g1, myh & 63); const float myg = (myh < 64) ? ga : gb;
            if (lane < 8 && myk < nv) P.SCO[(size_t)r * 128 + myh] = myg * gelu_tanh(e1s * (1.0f / PEER_SU)) * (1.0f / PEER_SV);
        }
    }
}
DI void peer_v_phase(const FP& P, const Ctx& C, int layer, const float* xin, float* fout, float* fout_s, bf16* xb) {
    const int lane = C.lane; const unsigned char* Vt = P.VB8 + (size_t)layer * PEER_EXPERTS * D_MODEL;
    const float* gam = P.ln_g + ((size_t)layer * 2 + 1) * D_MODEL; const float* bet = P.ln_b + ((size_t)layer * 2 + 1) * D_MODEL;
    const int nrounds = (M0 + C.G * NWAVES - 1) / (C.G * NWAVES);
#pragma unroll 1
    for (int rd = 0; rd <= nrounds; ++rd) {
        const bool smp = (rd == nrounds); int r = smp ? M0 + C.vcu : rd * C.G * NWAVES + C.vcu * NWAVES + C.wave; if (smp ? (C.vcu >= DEC_BATCH) : (r >= M0)) continue;
        const int pb = smp ? 16 * C.wave : 0, pe = smp ? pb + 16 : 128;
        f32x2 x2[8], o2[8];
#pragma unroll
        for (int j = 0; j < 4; ++j) { const f32x4 a = *(const f32x4*)(xin + (size_t)r * D_MODEL + 16 * lane + 4 * j); x2[2 * j] = (f32x2){a.x, a.y}; x2[2 * j + 1] = (f32x2){a.z, a.w}; }
#pragma unroll
        for (int k = 0; k < 8; ++k) o2[k] = (f32x2){0.f, 0.f};
        const int e_l = P.SELE[(size_t)r * 128 + lane], e_h = P.SELE[(size_t)r * 128 + 64 + lane]; const float a_l = P.SCO[(size_t)r * 128 + lane], a_h = P.SCO[(size_t)r * 128 + 64 + lane];
#pragma unroll 1
        for (int b0 = pb; b0 < pe; b0 += 16) { u32x4 vw[16];
#pragma unroll
            for (int k = 0; k < 16; ++k) { const int hk = b0 + k; const int e = (hk < 64) ? __builtin_amdgcn_readlane(e_l, hk & 63) : __builtin_amdgcn_readlane(e_h, hk & 63); vw[k] = *(const u32x4*)(Vt + (size_t)e * D_MODEL + 16 * lane); }
#pragma unroll
            for (int k = 0; k < 16; ++k) { const int hk = b0 + k; axpy16_fp8(vw[k], (hk < 64) ? rdlane(a_l, hk & 63) : rdlane(a_h, hk & 63), o2); } }
        if (smp) {
            LAS float* red = (LAS float*)C.lds;
#pragma unroll
            for (int k = 0; k < 8; ++k) { red[C.wave * 1024 + 16 * lane + 2 * k] = o2[k].x; red[C.wave * 1024 + 16 * lane + 2 * k + 1] = o2[k].y; }
            asm volatile("s_waitcnt lgkmcnt(0)" ::: "memory"); __syncthreads();
            if (C.wave == 0) {
#pragma unroll
                for (int k = 0; k < 8; ++k) { float ax = 0.f, ay = 0.f;
#pragma unroll
                    for (int ww = 0; ww < NWAVES; ++ww) { ax += red[ww * 1024 + 16 * lane + 2 * k]; ay += red[ww * 1024 + 16 * lane + 2 * k + 1]; } o2[k] = (f32x2){ax, ay}; } }
            __syncthreads();
            if (C.wave != 0) continue; }
        float s = 0.f;
#pragma unroll
        for (int k = 0; k < 8; ++k) { o2[k] += x2[k] * ALPHA; s += o2[k].x + o2[k].y; }
        const float mu = wave_sum(s) * (1.0f / D_MODEL); float s2 = 0.f;
#pragma unroll
        for (int k = 0; k < 8; ++k) { o2[k] -= mu; s2 += o2[k].x * o2[k].x + o2[k].y * o2[k].y; }
        const float rs = 1.0f / sqrtf(wave_sum(s2) * (1.0f / D_MODEL) + LN_EPS);
        float* frow = (r < M0) ? fout + (size_t)r * D_MODEL : fout_s + (size_t)(r - M0) * D_MODEL;
#pragma unroll
        for (int j = 0; j < 4; ++j) { const int c0 = 16 * lane + 4 * j; const f32x4 gg = *(const f32x4*)(gam + c0), bb = *(const f32x4*)(bet + c0);
            const f32x4 y = (f32x4){o2[2 * j].x * rs, o2[2 * j].y * rs, o2[2 * j + 1].x * rs, o2[2 * j + 1].y * rs} * gg + bb;
            *(f32x4*)(frow + c0) = y; if (xb) *(u32x2*)(xb + (size_t)r * D_MODEL + c0) = pk4(y); }
    }
}
constexpr int PSH_LIST = 512;
struct PG4 { u32x4 u[4], v[4]; };
DI void peer_sharded_phase(const FP& P, const Ctx& C, int layer, const float* xin, const bf16* xb16, float* fout, float* fout_s, bf16* xb) {
    const int lane = C.lane; const unsigned char* U = P.UB8 + (size_t)layer * PEER_EXPERTS * D_MODEL; const unsigned char* Vt = P.VB8 + (size_t)layer * PEER_EXPERTS * D_MODEL;
    const float* gam = P.ln_g + ((size_t)layer * 2 + 1) * D_MODEL; const float* bet = P.ln_b + ((size_t)layer * 2 + 1) * D_MODEL;
    LAS unsigned char* wl = C.lds + C.wave * 16384; LAS bf16* xs = (LAS bf16*)wl; LAS int* lst = (LAS int*)(wl + 8192);
    const int NW = C.G * NWAVES, gw = C.vcu * NWAVES + C.wave; const int nquads = (M0 / NW) / 4;
#pragma unroll 1
    for (int qd = 0; qd < nquads; ++qd) {
#define PSH_ROW(j) const int row##j = (qd * 4 + j) * NW + gw; const int el##j = P.SELE[(size_t)row##j * 128 + lane], eh##j = P.SELE[(size_t)row##j * 128 + 64 + lane]; const float gl##j = P.SELG[(size_t)row##j * 128 + lane], gh##j = P.SELG[(size_t)row##j * 128 + 64 + lane]; \
        { const u32x4 xa = *(const u32x4*)(xb16 + (size_t)row##j * D_MODEL + 16 * lane), xc = *(const u32x4*)(xb16 + (size_t)row##j * D_MODEL + 16 * lane + 8); *(LAS u32x4*)(xs + j * 1024 + 16 * lane) = xa; *(LAS u32x4*)(xs + j * 1024 + 16 * lane + 8) = xc; } \
        f32x2 oa##j[8]; _Pragma("unroll") for (int k = 0; k < 8; ++k) oa##j[k] = (f32x2){0.f, 0.f};
        PSH_ROW(0) PSH_ROW(1) PSH_ROW(2) PSH_ROW(3)
#pragma unroll 1
        for (int s = 0; s < 16; ++s) {
            int n = 0;
#define PSH_SCAN(j) { unsigned long long b0 = __ballot((el##j >> 10) == s), b1 = __ballot((eh##j >> 10) == s); \
                while (b0) { const int h = __builtin_ctzll(b0); b0 &= b0 - 1; const int e = __builtin_amdgcn_readlane(el##j, h); const int g = __builtin_amdgcn_readlane(__builtin_bit_cast(int, gl##j), h); \
                    if (lane == 0) { lst[4 * n] = e; lst[4 * n + 1] = g; lst[4 * n + 2] = j; } ++n; } \
                while (b1) { const int h = __builtin_ctzll(b1); b1 &= b1 - 1; const int e = __builtin_amdgcn_readlane(eh##j, h); const int g = __builtin_amdgcn_readlane(__builtin_bit_cast(int, gh##j), h); \
                    if (lane == 0) { lst[4 * n] = e; lst[4 * n + 1] = g; lst[4 * n + 2] = j; } ++n; } }
            PSH_SCAN(0) PSH_SCAN(1) PSH_SCAN(2) PSH_SCAN(3)
            asm volatile("s_waitcnt lgkmcnt(0)" ::: "memory");
            if (n == 0) continue;
            const int ngrp = (n + 3) >> 2;
#define PSH_LD(b, gi_) do { const int gi = (gi_); _Pragma("unroll") for (int k = 0; k < 4; ++k) { int i = 4 * gi + k; i = i < n ? i : n - 1; const int e = __builtin_amdgcn_readfirstlane(lst[4 * i]); \
                b.u[k] = *(const u32x4*)(U + (size_t)e * D_MODEL + 16 * lane); b.v[k] = *(const u32x4*)(Vt + (size_t)e * D_MODEL + 16 * lane); } } while (0)
#define PSH_CP(b, gi_) do { const int gi = (gi_); float d[4]; int jj[4]; float gg[4]; \
                _Pragma("unroll") for (int k = 0; k < 4; ++k) { int i = 4 * gi + k; const bool val = i < n; i = val ? i : n - 1; jj[k] = __builtin_amdgcn_readfirstlane(lst[4 * i + 2]); gg[k] = val ? __builtin_bit_cast(float, __builtin_amdgcn_readfirstlane(lst[4 * i + 1])) : 0.f; \
                    const u32x4 xa = *(const LAS u32x4*)(xs + jj[k] * 1024 + 16 * lane), xc = *(const LAS u32x4*)(xs + jj[k] * 1024 + 16 * lane + 8); \
                    const f32x2 x2[8] = {(f32x2){bflo(xa.x), bfhi(xa.x)}, (f32x2){bflo(xa.y), bfhi(xa.y)}, (f32x2){bflo(xa.z), bfhi(xa.z)}, (f32x2){bflo(xa.w), bfhi(xa.w)}, (f32x2){bflo(xc.x), bfhi(xc.x)}, (f32x2){bflo(xc.y), bfhi(xc.y)}, (f32x2){bflo(xc.z), bfhi(xc.z)}, (f32x2){bflo(xc.w), bfhi(xc.w)}}; \
                    d[k] = dot16_fp8(b.u[k], x2); } \
                float e2[2], e1; \
                { const bool hi = lane & 1; _Pragma("unroll") for (int i = 0; i < 2; ++i) { const float keep = hi ? d[2 + i] : d[i], send = hi ? d[i] : d[2 + i]; e2[i] = keep + __shfl_xor(send, 1); } } \
                { const bool hi = lane & 2; const float keep = hi ? e2[1] : e2[0], send = hi ? e2[0] : e2[1]; e1 = keep + __shfl_xor(send, 2); } \
                e1 += __shfl_xor(e1, 4); e1 += __shfl_xor(e1, 8); e1 += __shfl_xor(e1, 16); e1 += __shfl_xor(e1, 32); \
                const int myk = 2 * (lane & 1) + ((lane >> 1) & 1); \
                float myg = gg[0]; myg = (myk == 1) ? gg[1] : myg; myg = (myk == 2) ? gg[2] : myg; myg = (myk == 3) ? gg[3] : myg; \
                const float act = myg * gelu_tanh(e1 * (1.0f / PEER_SU)) * (1.0f / PEER_SV); \
                _Pragma("unroll") for (int k = 0; k < 4; ++k) { const float a = rdlane(act, (k >> 1) | ((k & 1) << 1)); \
                    if (jj[k] == 0) axpy16_fp8(b.v[k], a, oa0); else if (jj[k] == 1) axpy16_fp8(b.v[k], a, oa1); else if (jj[k] == 2) axpy16_fp8(b.v[k], a, oa2); else axpy16_fp8(b.v[k], a, oa3); } } while (0)
            { PG4 A, B; PSH_LD(A, 0);
#pragma unroll 1
              for (int g2 = 0; g2 < ngrp; g2 += 2) { PSH_LD(B, (g2 + 1 < ngrp) ? g2 + 1 : g2); PSH_CP(A, g2); PSH_LD(A, (g2 + 2 < ngrp) ? g2 + 2 : g2); if (g2 + 1 < ngrp) PSH_CP(B, g2 + 1); } }
            asm volatile("s_waitcnt lgkmcnt(0)" ::: "memory");
        }
#define PSH_LN(j) { const int r = row##j; f32x2 x2[8]; \
            _Pragma("unroll") for (int q = 0; q < 4; ++q) { const f32x4 a = *(const f32x4*)(xin + (size_t)r * D_MODEL + 16 * lane + 4 * q); x2[2 * q] = (f32x2){a.x, a.y}; x2[2 * q + 1] = (f32x2){a.z, a.w}; } \
            float sm = 0.f; _Pragma("unroll") for (int k = 0; k < 8; ++k) { oa##j[k] += x2[k] * ALPHA; sm += oa##j[k].x + oa##j[k].y; } \
            const float mu = wave_sum(sm) * (1.0f / D_MODEL); float s2 = 0.f; _Pragma("unroll") for (int k = 0; k < 8; ++k) { oa##j[k] -= mu; s2 += oa##j[k].x * oa##j[k].x + oa##j[k].y * oa##j[k].y; } \
            const float rs = 1.0f / sqrtf(wave_sum(s2) * (1.0f / D_MODEL) + LN_EPS); float* frow = fout + (size_t)r * D_MODEL; \
            _Pragma("unroll") for (int q = 0; q < 4; ++q) { const int c0 = 16 * lane + 4 * q; const f32x4 gv = *(const f32x4*)(gam + c0), bv = *(const f32x4*)(bet + c0); \
                const f32x4 y = (f32x4){oa##j[2 * q].x * rs, oa##j[2 * q].y * rs, oa##j[2 * q + 1].x * rs, oa##j[2 * q + 1].y * rs} * gv + bv; *(f32x4*)(frow + c0) = y; if (xb) *(u32x2*)(xb + (size_t)r * D_MODEL + c0) = pk4(y); } }
        PSH_LN(0) PSH_LN(1) PSH_LN(2) PSH_LN(3)
        asm volatile("s_waitcnt lgkmcnt(0)" ::: "memory");
    }
}
#ifndef PSH_LOG_V
#define PSH_LOG_V 11
#endif
constexpr int PSH_LOG = PSH_LOG_V, PSH_N = PEER_EXPERTS >> PSH_LOG;
#ifndef PS2_ROWS
#define PS2_ROWS 4
#endif
#define PS2_ROW(j) const int row##j = (qd * PS2_ROWS + j) * NW + gw; const int el##j = P.SELE[(size_t)row##j * 128 + lane], eh##j = P.SELE[(size_t)row##j * 128 + 64 + lane]; const float gl##j = P.SELG[(size_t)row##j * 128 + lane], gh##j = P.SELG[(size_t)row##j * 128 + 64 + lane]; \
    f32x2 oa##j[8]; _Pragma("unroll") for (int k = 0; k < 8; ++k) oa##j[k] = (f32x2){0.f, 0.f}; \
    const u32x4 xa##j = *(const u32x4*)(xb16 + (size_t)row##j * D_MODEL + 16 * lane), xc##j = *(const u32x4*)(xb16 + (size_t)row##j * D_MODEL + 16 * lane + 8);
#define PS2_STEP(j) { unsigned long long b0 = __ballot((el##j >> PSH_LOG) == s), b1 = __ballot((eh##j >> PSH_LOG) == s); \
    if (b0 | b1) { \
      const f32x2 x2[8] = {(f32x2){bflo(xa##j.x), bfhi(xa##j.x)}, (f32x2){bflo(xa##j.y), bfhi(xa##j.y)}, (f32x2){bflo(xa##j.z), bfhi(xa##j.z)}, (f32x2){bflo(xa##j.w), bfhi(xa##j.w)}, (f32x2){bflo(xc##j.x), bfhi(xc##j.x)}, (f32x2){bflo(xc##j.y), bfhi(xc##j.y)}, (f32x2){bflo(xc##j.z), bfhi(xc##j.z)}, (f32x2){bflo(xc##j.w), bfhi(xc##j.w)}}; \
      _Pragma("unroll 1") while ((b0 | b1) != 0ull) { int hk[8]; u32x4 uw[8], vw[8]; int nv = 0; \
        _Pragma("unroll") for (int k = 0; k < 8; ++k) { int h; if (b0) { h = __builtin_ctzll(b0); b0 &= b0 - 1; ++nv; } else if (b1) { h = 64 + __builtin_ctzll(b1); b1 &= b1 - 1; ++nv; } else h = hk[k > 0 ? k - 1 : 0]; \
            hk[k] = h; const int e = (h < 64) ? __builtin_amdgcn_readlane(el##j, h & 63) : __builtin_amdgcn_readlane(eh##j, h & 63); \
            uw[k] = *(const u32x4*)(U + (size_t)e * D_MODEL + 16 * lane); vw[k] = *(const u32x4*)(Vt + (size_t)e * D_MODEL + 16 * lane); } \
        float d[8]; _Pragma("unroll") for (int k = 0; k < 8; ++k) d[k] = dot16_fp8(uw[k], x2); \
        float e4[4], e2[2], e1s; \
          \
        { const bool hi = lane & 1; _Pragma("unroll") for (int i = 0; i < 4; ++i) { const float keep = hi ? d[4 + i] : d[i], send = hi ? d[i] : d[4 + i]; e4[i] = keep + dppf<0xB1>(send); } } \
        { const bool hi = lane & 2; _Pragma("unroll") for (int i = 0; i < 2; ++i) { const float keep = hi ? e4[2 + i] : e4[i], send = hi ? e4[i] : e4[2 + i]; e2[i] = keep + dppf<0x4E>(send); } } \
        { const bool hi = lane & 4; const float keep = hi ? e2[1] : e2[0], send = hi ? e2[0] : e2[1]; const float r4 = dppf<0x124>(send), r12 = dppf<0x12C>(send); e1s = keep + (hi ? r4 : r12); } \
        e1s += dppf<0x128>(e1s); e1s = colsum(e1s); \
        const int myk = 4 * (lane & 1) + (lane & 2) + ((lane >> 2) & 1); int myh = hk[0]; _Pragma("unroll") for (int k = 1; k < 8; ++k) myh = (myk == k) ? hk[k] : myh; \
        const float ga = __shfl(gl##j, myh & 63), gb = __shfl(gh##j, myh & 63); const float myg = (myk < nv) ? ((myh < 64) ? ga : gb) : 0.f;     \
        const float act = myg * gelu_tanh(e1s * (1.0f / PEER_SU)) * (1.0f / PEER_SV); \
        _Pragma("unroll") for (int k = 0; k < 8; ++k) { const int src = (k >> 2) | (((k >> 1) & 1) << 1) | ((k & 1) << 2); axpy16_fp8(vw[k], rdlane(act, src), oa##j); } } } }
#define PS2_LN(j) { const int r = row##j; f32x2 x2[8]; int ll = lane; asm volatile("" : "+v"(ll));     \
    _Pragma("unroll") for (int q = 0; q < 4; ++q) { const f32x4 a = *(const f32x4*)(xin + (size_t)r * D_MODEL + 16 * ll + 4 * q); x2[2 * q] = (f32x2){a.x, a.y}; x2[2 * q + 1] = (f32x2){a.z, a.w}; } \
    float sm = 0.f; _Pragma("unroll") for (int k = 0; k < 8; ++k) { oa##j[k] += x2[k] * ALPHA; sm += oa##j[k].x + oa##j[k].y; } \
    const float mu = wave_sum(sm) * (1.0f / D_MODEL); float s2 = 0.f; _Pragma("unroll") for (int k = 0; k < 8; ++k) { oa##j[k] -= mu; s2 += oa##j[k].x * oa##j[k].x + oa##j[k].y * oa##j[k].y; } \
    const float rs = 1.0f / sqrtf(wave_sum(s2) * (1.0f / D_MODEL) + LN_EPS); float* frow = fout + (size_t)r * D_MODEL; \
    _Pragma("unroll") for (int q = 0; q < 4; ++q) { const int c0 = 16 * ll + 4 * q; const f32x4 gv = *(const f32x4*)(gam + c0), bv = *(const f32x4*)(bet + c0); \
        const f32x4 y = (f32x4){oa##j[2 * q].x * rs, oa##j[2 * q].y * rs, oa##j[2 * q + 1].x * rs, oa##j[2 * q + 1].y * rs} * gv + bv; *(f32x4*)(frow + c0) = y; if (xb) *(u32x2*)(xb + (size_t)r * D_MODEL + c0) = pk4(y); } }
DI void xcd_soft_sync(unsigned* cnt, volatile LAS unsigned* st, unsigned x, unsigned& round) {
    if (!st) return;
    __syncthreads();
    if (threadIdx.x == 0) { const unsigned nloc = st[0];
        if (nloc) { unsigned* c = cnt + 64 * x; (void)xb_add(c, 1u); const unsigned target = (round + 1u) * nloc; unsigned sp = 0;
            while (xb_ld(c) < target && ++sp < 4096u) __builtin_amdgcn_s_sleep(1); } }
    __syncthreads(); ++round;
}
DI void peer_sharded2_phase(const FP& P, const Ctx& C, int layer, const float* xin, const bf16* xb16, float* fout, bf16* xb, volatile LAS unsigned* st = nullptr, unsigned xcc = 0) {
    unsigned round = 0; unsigned* hint = P.ctl + 8192 + layer * 1024;
    const int lane = C.lane; const unsigned char* U = P.UB8 + (size_t)layer * PEER_EXPERTS * D_MODEL; const unsigned char* Vt = P.VB8 + (size_t)layer * PEER_EXPERTS * D_MODEL;
    const float* gam = P.ln_g + ((size_t)layer * 2 + 1) * D_MODEL; const float* bet = P.ln_b + ((size_t)layer * 2 + 1) * D_MODEL;
    const int NW = C.G * NWAVES, gw = C.vcu * NWAVES + C.wave; const int nquads = (M0 / NW) / PS2_ROWS;
#pragma unroll 1
    for (int qd = 0; qd < nquads; ++qd) {
#if PS2_ROWS == 4
        PS2_ROW(0) PS2_ROW(1) PS2_ROW(2) PS2_ROW(3)
#pragma unroll 1
        for (int s = 0; s < PSH_N; ++s) {
#ifdef PEER_SOFTSYNC
            xcd_soft_sync(hint, st, xcc, round);
#endif
            PS2_STEP(0) PS2_STEP(1) PS2_STEP(2) PS2_STEP(3) }
        PS2_LN(0) PS2_LN(1) PS2_LN(2) PS2_LN(3)
#else
        PS2_ROW(0) PS2_ROW(1)
#pragma unroll 1
        for (int s = 0; s < PSH_N; ++s) { PS2_STEP(0) PS2_STEP(1) }
        PS2_LN(0) PS2_LN(1)
#endif
    }
}
#define PS3_ROW(j) const int row##j = (qd * 4 + j) * NW + gw; const int el##j = P.SELE[(size_t)row##j * 128 + lane], eh##j = P.SELE[(size_t)row##j * 128 + 64 + lane]; \
    { const u32x4 xa = *(const u32x4*)(xb16 + (size_t)row##j * D_MODEL + 16 * lane), xc = *(const u32x4*)(xb16 + (size_t)row##j * D_MODEL + 16 * lane + 8); *(LAS u32x4*)(xs + j * 1024 + 16 * lane) = xa; *(LAS u32x4*)(xs + j * 1024 + 16 * lane + 8) = xc; } \
    f32x2 oa##j[8]; _Pragma("unroll") for (int k = 0; k < 8; ++k) oa##j[k] = (f32x2){0.f, 0.f};
#define PS3_X2_UNUSED(j) const f32x2 x2[8] = {(f32x2){bflo(xa##j.x), bfhi(xa##j.x)}, (f32x2){bflo(xa##j.y), bfhi(xa##j.y)}, (f32x2){bflo(xa##j.z), bfhi(xa##j.z)}, (f32x2){bflo(xa##j.w), bfhi(xa##j.w)}, (f32x2){bflo(xc##j.x), bfhi(xc##j.x)}, (f32x2){bflo(xc##j.y), bfhi(xc##j.y)}, (f32x2){bflo(xc##j.z), bfhi(xc##j.z)}, (f32x2){bflo(xc##j.w), bfhi(xc##j.w)}};
#define PS3_TAKE(q, M, ELH, GOFF) if (!got && M) { const int h = __builtin_ctzll(M); M &= M - 1; qq[k] = q; ee = __builtin_amdgcn_readlane(ELH, h); gk[k] = P.SELG[GOFF + h];     got = true; ++nv; }
DI void peer_sharded3_phase(const FP& P, const Ctx& C, int layer, const float* xin, const bf16* xb16, float* fout, bf16* xb) {
    const int lane = C.lane; const unsigned char* U = P.UB8 + (size_t)layer * PEER_EXPERTS * D_MODEL; const unsigned char* Vt = P.VB8 + (size_t)layer * PEER_EXPERTS * D_MODEL;
    const float* gam = P.ln_g + ((size_t)layer * 2 + 1) * D_MODEL; const float* bet = P.ln_b + ((size_t)layer * 2 + 1) * D_MODEL;
    const int NW = C.G * NWAVES, gw = C.vcu * NWAVES + C.wave; const int nquads = (M0 / NW) / 4; LAS bf16* xs = (LAS bf16*)(C.lds + C.wave * 16384);
#pragma unroll 1
    for (int qd = 0; qd < nquads; ++qd) {
        PS3_ROW(0) PS3_ROW(1) PS3_ROW(2) PS3_ROW(3)
        asm volatile("s_waitcnt lgkmcnt(0)" ::: "memory");
#pragma unroll 1
        for (int s = 0; s < PSH_N; ++s) {
            unsigned long long m0 = __ballot((el0 >> PSH_LOG) == s), m1 = __ballot((eh0 >> PSH_LOG) == s), m2 = __ballot((el1 >> PSH_LOG) == s), m3 = __ballot((eh1 >> PSH_LOG) == s),
                               m4 = __ballot((el2 >> PSH_LOG) == s), m5 = __ballot((eh2 >> PSH_LOG) == s), m6 = __ballot((el3 >> PSH_LOG) == s), m7 = __ballot((eh3 >> PSH_LOG) == s);
#pragma unroll 1
            while ((m0 | m1 | m2 | m3 | m4 | m5 | m6 | m7) != 0ull) {
                int qq[8]; float gk[8]; int es[8]; u32x4 uw[8]; int nv = 0; int elast = 0;
#pragma unroll
                for (int k = 0; k < 8; ++k) { bool got = false; int ee = elast; qq[k] = k > 0 ? qq[k - 1] : 0; gk[k] = 0.f;
                    PS3_TAKE(0, m0, el0, (size_t)row0 * 128) PS3_TAKE(1, m1, eh0, (size_t)row0 * 128 + 64) PS3_TAKE(2, m2, el1, (size_t)row1 * 128) PS3_TAKE(3, m3, eh1, (size_t)row1 * 128 + 64) PS3_TAKE(4, m4, el2, (size_t)row2 * 128) PS3_TAKE(5, m5, eh2, (size_t)row2 * 128 + 64) PS3_TAKE(6, m6, el3, (size_t)row3 * 128) PS3_TAKE(7, m7, eh3, (size_t)row3 * 128 + 64)
                    elast = ee; es[k] = ee; uw[k] = *(const u32x4*)(U + (size_t)ee * D_MODEL + 16 * lane); }
                float d[8];
#pragma unroll
                for (int k = 0; k < 8; ++k) { const int j = qq[k] >> 1; const u32x4 xa = *(const LAS u32x4*)(xs + j * 1024 + 16 * lane), xc = *(const LAS u32x4*)(xs + j * 1024 + 16 * lane + 8);
                    const f32x2 x2[8] = {(f32x2){bflo(xa.x), bfhi(xa.x)}, (f32x2){bflo(xa.y), bfhi(xa.y)}, (f32x2){bflo(xa.z), bfhi(xa.z)}, (f32x2){bflo(xa.w), bfhi(xa.w)}, (f32x2){bflo(xc.x), bfhi(xc.x)}, (f32x2){bflo(xc.y), bfhi(xc.y)}, (f32x2){bflo(xc.z), bfhi(xc.z)}, (f32x2){bflo(xc.w), bfhi(xc.w)}};
                    d[k] = dot16_fp8(uw[k], x2); }
                u32x4 vw[8];
#pragma unroll
                for (int k = 0; k < 8; ++k) vw[k] = *(const u32x4*)(Vt + (size_t)es[k] * D_MODEL + 16 * lane);
                float e4[4], e2[2], e1s;
                { const bool hi = lane & 1;
#pragma unroll
                  for (int i = 0; i < 4; ++i) { const float keep = hi ? d[4 + i] : d[i], send = hi ? d[i] : d[4 + i]; e4[i] = keep + __shfl_xor(send, 1); } }
                { const bool hi = lane & 2;
#pragma unroll
                  for (int i = 0; i < 2; ++i) { const float keep = hi ? e4[2 + i] : e4[i], send = hi ? e4[i] : e4[2 + i]; e2[i] = keep + __shfl_xor(send, 2); } }
                { const bool hi = lane & 4; const float keep = hi ? e2[1] : e2[0], send = hi ? e2[0] : e2[1]; e1s = keep + __shfl_xor(send, 4); }
                e1s += __shfl_xor(e1s, 8); e1s += __shfl_xor(e1s, 16); e1s += __shfl_xor(e1s, 32);
                const int myk = 4 * (lane & 1) + (lane & 2) + ((lane >> 2) & 1); float myg = gk[0];
#pragma unroll
                for (int k = 1; k < 8; ++k) myg = (myk == k) ? gk[k] : myg;
                const float act = myg * gelu_tanh(e1s * (1.0f / PEER_SU)) * (1.0f / PEER_SV);
#pragma unroll
                for (int k = 0; k < 8; ++k) { const int src = (k >> 2) | (((k >> 1) & 1) << 1) | ((k & 1) << 2); const float a = rdlane(act, src); const int j = qq[k] >> 1;
                    if (j == 0) { asm volatile("" ::: "memory"); axpy16_fp8(vw[k], a, oa0); } else if (j == 1) { asm volatile("" ::: "memory"); axpy16_fp8(vw[k], a, oa1); } else if (j == 2) { asm volatile("" ::: "memory"); axpy16_fp8(vw[k], a, oa2); } else { asm volatile("" ::: "memory"); axpy16_fp8(vw[k], a, oa3); } }
            }
        }
        PS2_LN(0) PS2_LN(1) PS2_LN(2) PS2_LN(3)
    }
}
}
namespace fx {
struct EpiB {
    static constexpr bool PERM = true, AFTER_DRAIN = false; const FP& P;
    DI void operator()(const f32x4 (&acc)[2][2][4][2], const pg8::Unit& u, int wr, int wc, int fr, int fq) const {
        const int t = u.pn;
        EPI_LOOP({ if (row < MP) { const int pos = row_pos(row), n = row / SEQ, e = ct & 63, dp = e >> 1; const bool prm = row < M0;
            if (t < 3) { const int ty = 2 * t + (ct >> 7), kvh = (ct >> 6) & 1;
                if (ty == 2 || ty == 4) { f32x4 lo, hi; rope4(P.ROPE + pos * 64, dp, v0, v1, lo, hi);
                    if (ty == 2) { float* o = (prm ? P.nsa_kv_p + (size_t)row * 512 : P.nsa_kv_s + (size_t)(row - M0) * 512) + 256 + kvh * 64 + dp; *(f32x4*)o = lo; *(f32x4*)(o + 32) = hi;
                        if (prm) { bf16* kt = P.SLK + ((size_t)n * NSA_KV_HEADS + kvh) * SEQ * 64; *(u32x2*)(kt + ktile_off(pos, dp)) = pk4(lo); *(u32x2*)(kt + ktile_off(pos, dp + 32)) = pk4(hi); } }
                    else { float* o = nullptr; if (!prm) o = P.win_s + (((size_t)(row - M0) * SWA_WINDOW + SWA_WINDOW - 1) * 2 + 0) * 128; else if (pos >= SEQ - SWA_WINDOW) o = P.win_p + (((size_t)n * SWA_WINDOW + pos - (SEQ - SWA_WINDOW)) * 2 + 0) * 128;
                        if (o) { *(f32x4*)(o + kvh * 64 + dp) = lo; *(f32x4*)(o + kvh * 64 + 32 + dp) = hi; }
                        if (prm) { bf16* kt = P.WNK + ((size_t)n * NSA_KV_HEADS + kvh) * SEQ * 64; *(u32x2*)(kt + ktile_off(pos, dp)) = pk4(lo); *(u32x2*)(kt + ktile_off(pos, dp + 32)) = pk4(hi); } } }
                else if (ty < 4) { float* o = (prm ? P.nsa_kv_p + (size_t)row * 512 : P.nsa_kv_s + (size_t)(row - M0) * 512) + ty * 128 + kvh * 64 + e; *(f32x4*)o = v0; *(f32x4*)(o + 4) = v1;
                    if (prm) { if (ty < 2) *(u32x4*)(P.AC + ((size_t)ty * ACROWS + ((size_t)n * NSA_KV_HEADS + kvh) * NCH + pos / 16) * 1024 + (pos % 16) * 64 + e) = pk8(v0, v1);
                        else { bf16* vt = P.SLVT + ((size_t)n * NSA_KV_HEADS + kvh) * SEQ * 64 + vtile_off(e, pos);
                            vt[0] = (bf16)f2bf(v0.x); vt[8] = (bf16)f2bf(v0.y); vt[16] = (bf16)f2bf(v0.z); vt[24] = (bf16)f2bf(v0.w); vt[32] = (bf16)f2bf(v1.x); vt[40] = (bf16)f2bf(v1.y); vt[48] = (bf16)f2bf(v1.z); vt[56] = (bf16)f2bf(v1.w); } } }
                else { float* o = nullptr; if (!prm) o = P.win_s + (((size_t)(row - M0) * SWA_WINDOW + SWA_WINDOW - 1) * 2 + 1) * 128; else if (pos >= SEQ - SWA_WINDOW) o = P.win_p + (((size_t)n * SWA_WINDOW + pos - (SEQ - SWA_WINDOW)) * 2 + 1) * 128;
                    if (o) { *(f32x4*)(o + kvh * 64 + e) = v0; *(f32x4*)(o + kvh * 64 + e + 4) = v1; }
                    if (prm) { bf16* vt = P.WNVT + ((size_t)n * NSA_KV_HEADS + kvh) * SEQ * 64 + vtile_off(e, pos);
                        vt[0] = (bf16)f2bf(v0.x); vt[8] = (bf16)f2bf(v0.y); vt[16] = (bf16)f2bf(v0.z); vt[24] = (bf16)f2bf(v0.w); vt[32] = (bf16)f2bf(v1.x); vt[40] = (bf16)f2bf(v1.y); vt[48] = (bf16)f2bf(v1.z); vt[56] = (bf16)f2bf(v1.w); } } }
            else if (t < 6) { const int h = (t - 3) * 4 + (ct >> 6); f32x4 lo, hi; rope4(P.ROPE + pos * 64, dp, v0, v1, lo, hi); bf16* q = P.QB + (size_t)row * NSA_Q_COLS + h * 64 + dp; *(u32x2*)q = pk4(lo * QSCALE); *(u32x2*)(q + 32) = pk4(hi * QSCALE); }
            else if (t == 6) { *(u32x4*)(P.MQB + (size_t)row * 256 + ct) = pk8(v0 * QSCALE, v1 * QSCALE); }
            else if (ct < 40) { const float vv[8] = {v0.x, v0.y, v0.z, v0.w, v1.x, v1.y, v1.z, v1.w};
                _Pragma("unroll") for (int i = 0; i < 8; ++i) if (ct + i < NSA_GATE_COLS) P.GATES[(size_t)row * 64 + ct + i] = 1.0f / (1.0f + __expf(-vv[i])); } } })
    }
};
DI void cmp2_phase(const FP& P, const Ctx& C) {
    const int lane = C.lane; LAS float* hs = (LAS float*)(C.lds + C.wave * 1024);
    constexpr int NGRP = NCTX * 2 * NSA_KV_HEADS; const int NW = C.G * NWAVES, WPG = NW / NGRP > 0 ? NW / NGRP : 1; const int gw = C.vcu * NWAVES + C.wave;
#pragma unroll 1
    for (int grp = gw / WPG; grp < NGRP; grp += (NW + WPG - 1) / WPG) { const int slot = gw % WPG; if (gw >= (NW / WPG) * WPG && grp == gw / WPG) break;
        const int kvh = grp % NSA_KV_HEADS, ty = (grp / NSA_KV_HEADS) % 2, ctx = grp / (2 * NSA_KV_HEADS);
        const float* UL = P.UL + ((size_t)ty * ACROWS + ((size_t)ctx * NSA_KV_HEADS + kvh) * NCH) * 256; const float* w2 = P.cmp_w2 + (size_t)ty * CMP_HIDDEN * HEAD_DIM;
        float w2r[CMP_HIDDEN];
#pragma unroll
        for (int k = 0; k < CMP_HIDDEN; ++k) w2r[k] = w2[k * HEAD_DIM + lane];
        const float b0 = P.CBIAS[ty * CMP_HIDDEN + lane], b1 = P.CBIAS[ty * CMP_HIDDEN + 64 + lane];
        float u0, u1, l0, l1; int c = slot;
        if (c < NCMP) { u0 = UL[(size_t)c * 256 + lane]; u1 = UL[(size_t)c * 256 + 64 + lane]; l0 = UL[(size_t)(c + 1) * 256 + 128 + lane]; l1 = UL[(size_t)(c + 1) * 256 + 192 + lane]; }
#pragma unroll 1
        for (; c < NCMP; c += WPG) { const float h0 = gelu_tanh(u0 + l0 + b0), h1 = gelu_tanh(u1 + l1 + b1); const int cn = c + WPG;
            if (cn < NCMP) { u0 = UL[(size_t)cn * 256 + lane]; u1 = UL[(size_t)cn * 256 + 64 + lane]; l0 = UL[(size_t)(cn + 1) * 256 + 128 + lane]; l1 = UL[(size_t)(cn + 1) * 256 + 192 + lane]; }
            hs[lane] = h0; hs[64 + lane] = h1; asm volatile("s_waitcnt lgkmcnt(0)" ::: "memory");
            float a = 0.f;
#pragma unroll
            for (int k4 = 0; k4 < CMP_HIDDEN / 4; ++k4) { const f32x4 hv = *(const LAS f32x4*)(hs + 4 * k4); a += hv.x * w2r[4 * k4] + hv.y * w2r[4 * k4 + 1] + hv.z * w2r[4 * k4 + 2] + hv.w * w2r[4 * k4 + 3]; }
            if (ty == 0) { const float other = __shfl_xor(a, 32); const int pos = c * CMP_STRIDE + CMP_BLOCK - 1; const float cs = P.ROPE[pos * 64 + (lane & 31)], sn = P.ROPE[pos * 64 + 32 + (lane & 31)];
                a = (lane < 32) ? a * cs - other * sn : a * cs + other * sn; }
            if (ctx < BATCH) { if (ty == 0) P.CK[((size_t)ctx * NSA_KV_HEADS + kvh) * NCH * 64 + ktile_off(c, lane)] = (bf16)f2bf(a); else P.CVT[((size_t)ctx * NSA_KV_HEADS + kvh) * NCH * 64 + vtile_off(lane, c)] = (bf16)f2bf(a); }
            else { (ty == 0 ? P.CKF : P.CVF)[(((size_t)(ctx - BATCH) * NSA_KV_HEADS + kvh) * NCH + c) * 64 + lane] = a; }
            asm volatile("s_waitcnt lgkmcnt(0)" ::: "memory"); }
    }
    __syncthreads();
}
constexpr int NSA_WLDS = 8192;
DI void nsa_pair_a(const FP& P, int n, int kvh, int t, int lane, LAS unsigned char* wl) {
    LAS float* pn = (LAS float*)wl; LAS float* imp = (LAS float*)(wl + 2048); LAS float* sc = (LAS float*)(wl + 6144); LAS int* sel = (LAS int*)(wl + 7168);
    const int col = lane & 15, c = lane >> 4; const bool vcol = col < 12; const int qq = vcol ? col / 6 : 0, hh = vcol ? col % 6 : 0, tq = t + qq, head = kvh * NSA_GROUP + hh, row = n * SEQ + tq;
    bf16x8 qf[2]; { const bf16* qp = P.QB + (size_t)row * NSA_Q_COLS + head * 64 + 8 * c; qf[0] = *(const bf16x8*)qp; qf[1] = *(const bf16x8*)(qp + 32); }
    const float* gt = P.GATES + (size_t)row * 64 + head * 3;
    f32x4 oacc[4] = {(f32x4){0.f, 0.f, 0.f, 0.f}, (f32x4){0.f, 0.f, 0.f, 0.f}, (f32x4){0.f, 0.f, 0.f, 0.f}, (f32x4){0.f, 0.f, 0.f, 0.f}};
    const int lim = vcol ? ((tq >= CMP_BLOCK - 1) ? (tq - (CMP_BLOCK - 1)) / CMP_STRIDE : -1) : -1;
    const int limmax = (t + 1 >= CMP_BLOCK - 1) ? (t + 1 - (CMP_BLOCK - 1)) / CMP_STRIDE : -1; const int nblk = (limmax + 32) / 32;
    const bf16* CKb = P.CK + ((size_t)n * NSA_KV_HEADS + kvh) * NCH * 64; const bf16* CVb = P.CVT + ((size_t)n * NSA_KV_HEADS + kvh) * 64 * NCH;
    for (int i = lane; i < 1024; i += 64) imp[i] = 0.f;
    float m1 = -INFINITY, l1 = 0.f;
    { struct K4 { bf16x8 a0, a1, b0, b1; };
      auto ldk = [&](K4& k, int blk) { const bf16* kt = CKb + (size_t)blk * 2048 + lane * 8; k.a0 = *(const bf16x8*)kt; k.a1 = *(const bf16x8*)(kt + 512); k.b0 = *(const bf16x8*)(kt + 1024); k.b1 = *(const bf16x8*)(kt + 1536); };
      auto cp1 = [&](const K4& k, int blk) { const int kb = 32 * blk;
        f32x4 s0 = (f32x4){0.f, 0.f, 0.f, 0.f}, s1 = (f32x4){0.f, 0.f, 0.f, 0.f};
        s0 = __builtin_amdgcn_mfma_f32_16x16x32_bf16(k.a0, qf[0], s0, 0, 0, 0); s0 = __builtin_amdgcn_mfma_f32_16x16x32_bf16(k.a1, qf[1], s0, 0, 0, 0);
        s1 = __builtin_amdgcn_mfma_f32_16x16x32_bf16(k.b0, qf[0], s1, 0, 0, 0); s1 = __builtin_amdgcn_mfma_f32_16x16x32_bf16(k.b1, qf[1], s1, 0, 0, 0);
        float s[8] = {s0.x, s0.y, s0.z, s0.w, s1.x, s1.y, s1.z, s1.w}; float mx = -INFINITY;
        const int hi1 = lim - (kb + 8 * c);
#pragma unroll
        for (int e = 0; e < 8; ++e) { s[e] = (e <= hi1) ? s[e] : -INFINITY; mx = fmaxf(mx, s[e]); }
        mx = colmax(mx);
        const float mnew = fmaxf(m1, mx), muse = (mnew == -INFINITY) ? 0.f : mnew; float ls = 0.f;
#pragma unroll
        for (int e = 0; e < 8; ++e) ls += __builtin_amdgcn_exp2f(s[e] - muse);
        l1 = l1 * __builtin_amdgcn_exp2f(m1 - muse) + ls; m1 = mnew; };
      if (nblk > 0) { K4 A, B; ldk(A, 0);
#pragma unroll 1
        for (int blk = 0; blk < nblk; blk += 2) { ldk(B, (blk + 1 < nblk) ? blk + 1 : blk); cp1(A, blk); ldk(A, (blk + 2 < nblk) ? blk + 2 : blk); if (blk + 1 < nblk) cp1(B, blk + 1); } } }
    asm volatile("s_waitcnt lgkmcnt(0)" ::: "memory");
    { l1 = colsum(l1); const float muse = (m1 == -INFINITY) ? 0.f : m1, inv = (l1 > 0.f) ? 1.0f / l1 : 0.f;
      f32x4 oc[4] = {(f32x4){0.f, 0.f, 0.f, 0.f}, (f32x4){0.f, 0.f, 0.f, 0.f}, (f32x4){0.f, 0.f, 0.f, 0.f}, (f32x4){0.f, 0.f, 0.f, 0.f}};
      pipe2(nblk, [&](KV8& kv, int blk) { kv_load_t(kv, CKb + (size_t)blk * 2048, CVb + (size_t)blk * 2048, lane); }, [&](const KV8& kv, int blk) { const int kb = 32 * blk;
        f32x4 s0 = (f32x4){0.f, 0.f, 0.f, 0.f}, s1 = (f32x4){0.f, 0.f, 0.f, 0.f};
        s0 = __builtin_amdgcn_mfma_f32_16x16x32_bf16(kv.ka0, qf[0], s0, 0, 0, 0); s0 = __builtin_amdgcn_mfma_f32_16x16x32_bf16(kv.ka1, qf[1], s0, 0, 0, 0);
        s1 = __builtin_amdgcn_mfma_f32_16x16x32_bf16(kv.kb0, qf[0], s1, 0, 0, 0); s1 = __builtin_amdgcn_mfma_f32_16x16x32_bf16(kv.kb1, qf[1], s1, 0, 0, 0);
        float s[8] = {s0.x, s0.y, s0.z, s0.w, s1.x, s1.y, s1.z, s1.w};
        const int hi2 = lim - (kb + 8 * c);
#pragma unroll
        for (int e = 0; e < 8; ++e) s[e] = (e <= hi2) ? __builtin_amdgcn_exp2f(s[e] - muse) * inv : 0.f;
        *(f32x4*)(pn + col * 32 + 8 * c) = (f32x4){s[0], s[1], s[2], s[3]}; *(f32x4*)(pn + col * 32 + 8 * c + 4) = (f32x4){s[4], s[5], s[6], s[7]};
        u32x4 pw; pw.x = cvtpk(s[0], s[1]); pw.y = cvtpk(s[2], s[3]); pw.z = cvtpk(s[4], s[5]); pw.w = cvtpk(s[6], s[7]); const bf16x8 pf = __builtin_bit_cast(bf16x8, pw);
        oc[0] = __builtin_amdgcn_mfma_f32_16x16x32_bf16(kv.v0, pf, oc[0], 0, 0, 0); oc[1] = __builtin_amdgcn_mfma_f32_16x16x32_bf16(kv.v1, pf, oc[1], 0, 0, 0);
        oc[2] = __builtin_amdgcn_mfma_f32_16x16x32_bf16(kv.v2, pf, oc[2], 0, 0, 0); oc[3] = __builtin_amdgcn_mfma_f32_16x16x32_bf16(kv.v3, pf, oc[3], 0, 0, 0);
        asm volatile("s_waitcnt lgkmcnt(0)" ::: "memory");
        { const int q2 = lane >> 5, k = lane & 31; float a = 0.f;
#pragma unroll
          for (int h6 = 0; h6 < 6; ++h6) a += pn[(q2 * 6 + h6) * 32 + k];
          imp[q2 * 512 + kb + k] = a; }
        asm volatile("s_waitcnt lgkmcnt(0)" ::: "memory"); });
#ifdef NSA_DEBUG
      if (vcol) { for (int db = 0; db < 4; ++db) *(f32x4*)(P.DBG + ((size_t)0 * MP + row) * 768 + head * 64 + 16 * db + 4 * c) = oc[db]; }
#endif
      const float g0 = vcol ? gt[0] : 0.f;
#pragma unroll
      for (int db = 0; db < 4; ++db) oacc[db] += oc[db] * g0; }
#ifndef REP_SEL
#define REP_SEL 1
#endif
#pragma unroll 1
    for (int rep = 0; rep < REP_SEL; ++rep) {
    for (int i = lane; i < 256; i += 64) { const int q2 = i >> 7, b = i & 127, tq2 = t + q2, cur = tq2 / SLC_BLOCK; float sv;
        if (b > cur) sv = NEG; else if (b == 0 || b == cur || b == cur - 1) sv = FORCE_SCORE;
        else { const LAS float* ic = imp + q2 * 512 + 4 * b; sv = ic[-1] + 2.f * (ic[0] + ic[1] + ic[2]) + ic[3]; }
        sc[i] = pack_key(sv, 127u - (unsigned)b, 127u); }
    asm volatile("s_waitcnt lgkmcnt(0)" ::: "memory");
    for (int i = lane; i < 256; i += 64) { const int q2 = i >> 7, b = i & 127; const float sv = sc[i]; int rank = 0;
        for (int j = 0; j < 128; j += 4) { const f32x4 o = *(const LAS f32x4*)(sc + q2 * 128 + j);
            rank += (o.x > sv) ? 1 : 0; rank += (o.y > sv) ? 1 : 0; rank += (o.z > sv) ? 1 : 0; rank += (o.w > sv) ? 1 : 0; }
        if (rank < SLC_TOPK) { const int v = (sv > 0.5f * NEG) ? b : -1; sel[q2 * 16 + rank] = v; P.SELB[((size_t)(n * SEQ + t + q2) * NSA_KV_HEADS + kvh) * 16 + rank] = v; } }
    asm volatile("s_waitcnt lgkmcnt(0)" ::: "memory");
    }
#ifndef REP_WIN
#define REP_WIN 1
#endif
#pragma unroll 1
    for (int rep = 0; rep < REP_WIN; ++rep) { Tile16 T; tile_init(T);
      const bf16* WKb = P.WNK + ((size_t)n * NSA_KV_HEADS + kvh) * SEQ * 64; const bf16* WVb = P.WNVT + ((size_t)n * NSA_KV_HEADS + kvh) * 64 * SEQ;
      const int blo = (t - SWA_WINDOW) >> 5, bhi = (t + 1) >> 5;
      auto ld = [&](KV8& kv, int blk) { const int bc = blk < 0 ? 0 : blk; kv_load_t(kv, WKb + (size_t)bc * 2048, WVb + (size_t)bc * 2048, lane); };
      pipe2(bhi - blo + 1, [&](KV8& kv, int i) { ld(kv, blo + i); }, [&](const KV8& kv, int i) { const int kb = 32 * (blo + i);
          const int k0 = kb + 8 * c; int lo; unsigned rng; const int a = tq - SWA_WINDOW; mk_range((a > 0 ? a : 0) - k0, tq - k0, vcol, lo, rng); tile_compute(T, qf, kv, lo, rng); });
      T.l = colsum(T.l);
      const float inv = (T.l > 0.f) ? 1.0f / T.l : 0.f, g2 = vcol ? gt[2] * inv : 0.f;
#ifdef NSA_DEBUG
      if (vcol) { for (int db = 0; db < 4; ++db) *(f32x4*)(P.DBG + ((size_t)2 * MP + row) * 768 + head * 64 + 16 * db + 4 * c) = T.o[db] * inv; }
#endif
#pragma unroll
      for (int db = 0; db < 4; ++db) if (rep == REP_WIN - 1) oacc[db] += T.o[db] * g2; }
    if (vcol) { float* op = P.DPART + (size_t)row * 768 + head * 64 + 4 * c;
#pragma unroll
        for (int db = 0; db < 4; ++db) *(f32x4*)(op + 16 * db) = oacc[db]; }
}
DI void nsa_pair_b(const FP& P, int n, int kvh, int t, int lane, LAS unsigned char* wl) {
    LAS int* steps = (LAS int*)wl;
    const int col = lane & 15, c = lane >> 4; const bool vcol = col < 12; const int qq = vcol ? col / 6 : 0, hh = vcol ? col % 6 : 0, tq = t + qq, head = kvh * NSA_GROUP + hh, row = n * SEQ + tq;
    bf16x8 qf[2]; { const bf16* qp = P.QB + (size_t)row * NSA_Q_COLS + head * 64 + 8 * c; qf[0] = *(const bf16x8*)qp; qf[1] = *(const bf16x8*)(qp + 32); }
    const float* gt = P.GATES + (size_t)row * 64 + head * 3;
    Tile16 T; tile_init(T);
    const bf16* SKb = P.SLK + ((size_t)n * NSA_KV_HEADS + kvh) * SEQ * 64; const bf16* SVb = P.SLVT + ((size_t)n * NSA_KV_HEADS + kvh) * SEQ * 64;
    int ns = 0;
    { const int mysel = (lane < 32) ? P.SELB[((size_t)(n * SEQ + t + (lane >> 4)) * NSA_KV_HEADS + kvh) * 16 + (lane & 15)] : -1;
      for (int i = 0; i < 32; ++i) { const int b = __builtin_amdgcn_readlane(mysel, i); if (b < 0) continue; int q2 = i >> 4;
          const unsigned long long other = __ballot(mysel == b && lane < 32 && (lane >> 4) != q2);
          if (other) { if (q2 == 1) continue; q2 = 2; }
          if (lane == 0) { steps[ns] = (b * SLC_BLOCK) | (q2 << 29); steps[ns + 1] = (b * SLC_BLOCK + 32) | (q2 << 29); } ns += 2; } }
    asm volatile("s_waitcnt lgkmcnt(0)" ::: "memory");
    auto ld = [&](KV8& kv, int i) { const int code = __builtin_amdgcn_readfirstlane(steps[i]); const int kb = code & 0x1fffffff;
        kv_load_t(kv, SKb + (size_t)(kb >> 5) * 2048, SVb + (size_t)(kb >> 5) * 2048, lane); };
#ifdef PROBE_DBLCOMP
    Tile16 T2; tile_init(T2);
#endif
    pipe2(ns, ld, [&](const KV8& kv, int i) { const int code = __builtin_amdgcn_readfirstlane(steps[i]); const int kb = code & 0x1fffffff, q2 = code >> 29;
        int lo; unsigned rng; mk_range(-64, tq - (kb + 8 * c), vcol && (q2 == 2 || qq == q2), lo, rng); tile_compute(T, qf, kv, lo, rng);
#ifdef PROBE_DBLCOMP
        tile_compute(T2, qf, kv, [&](int e) { return vcol && qq == q2 && (kb + 8 * c + e + 1) <= tq; });
#endif
    });
#ifdef PROBE_DBLCOMP
    if (T2.l < 0.f) T.l = 0.f;
#endif
    T.l = colsum(T.l);
    const float inv = (T.l > 0.f) ? 1.0f / T.l : 0.f, g1 = vcol ? gt[1] * inv : 0.f;
#ifdef NSA_DEBUG
    if (vcol) { for (int db = 0; db < 4; ++db) *(f32x4*)(P.DBG + ((size_t)1 * MP + row) * 768 + head * 64 + 16 * db + 4 * c) = T.o[db] * inv; }
#endif
    if (vcol) { const float* pp = P.DPART + (size_t)row * 768 + head * 64 + 4 * c; bf16* op = P.ATTB + (size_t)row * 1024 + head * 64 + 4 * c;
#pragma unroll
        for (int db = 0; db < 4; ++db) *(u32x2*)(op + 16 * db) = pk4(*(const f32x4*)(pp + 16 * db) + T.o[db] * g1); }
}

constexpr int SMP_SK = 1088;
template <class KF, class VF> DI void smp_branch(const Ctx& C, LAS float* qs, LAS float* S, LAS float* red, int NK, KF kf, VF vf, bool keep_probs, float (&outh)[1]) {
    const int tid = C.tid, lane = C.lane, w = C.wave;
#pragma unroll 1
    for (int j = tid; j < NK; j += NTHREADS) { const float* k = kf(j); f32x4 kr[16];
#pragma unroll
        for (int d4 = 0; d4 < 16; ++d4) kr[d4] = *(const f32x4*)(k + 4 * d4);
#pragma unroll 1
        for (int h = 0; h < 6; ++h) { float a = 0.f;
#pragma unroll
            for (int d4 = 0; d4 < 16; ++d4) { const f32x4 qv = *(const LAS f32x4*)(qs + h * 64 + 4 * d4); a += kr[d4].x * qv.x + kr[d4].y * qv.y + kr[d4].z * qv.z + kr[d4].w * qv.w; }
            S[h * SMP_SK + j] = a; } }
    asm volatile("s_waitcnt lgkmcnt(0)" ::: "memory"); __syncthreads();
    if (w < 6) { float m = -INFINITY; for (int j = lane; j < NK; j += 64) m = fmaxf(m, S[w * SMP_SK + j]); m = wave_max(m);
        float l = 0.f; for (int j = lane; j < NK; j += 64) { const float p = __builtin_amdgcn_exp2f(S[w * SMP_SK + j] - m); S[w * SMP_SK + j] = p; l += p; } l = wave_sum(l);
        const float inv = 1.0f / l; for (int j = lane; j < NK; j += 64) S[w * SMP_SK + j] *= inv; }
    asm volatile("s_waitcnt lgkmcnt(0)" ::: "memory"); __syncthreads();
    { const int per = (NK + NWAVES - 1) / NWAVES, j0 = w * per, j1 = (j0 + per < NK) ? j0 + per : NK; float o[6] = {0.f, 0.f, 0.f, 0.f, 0.f, 0.f};
#pragma unroll 1
      for (int j = j0; j < j1; j += 8) { float vv[8];
#pragma unroll
          for (int u = 0; u < 8; ++u) { const int jj = (j + u < j1) ? j + u : j1 - 1; vv[u] = vf(jj)[lane]; }
#pragma unroll
          for (int u = 0; u < 8; ++u) if (j + u < j1) {
#pragma unroll
              for (int h = 0; h < 6; ++h) o[h] += S[h * SMP_SK + j + u] * vv[u]; } }
#pragma unroll
      for (int h = 0; h < 6; ++h) red[(w * 6 + h) * 64 + lane] = o[h]; }
    asm volatile("s_waitcnt lgkmcnt(0)" ::: "memory"); __syncthreads();
    outh[0] = 0.f;
    if (tid < 384) { float a = 0.f;
#pragma unroll
        for (int ww = 0; ww < NWAVES; ++ww) a += red[ww * 384 + tid]; outh[0] = a; }
    if (!keep_probs) { __syncthreads(); }
}
DI void nsa_sample_item(const FP& P, const Ctx& C, int ns, int kvh) {
    LAS float* qs = (LAS float*)C.lds; LAS float* S = qs + 384; LAS float* red = S + 6 * SMP_SK; LAS float* scs = red + 8 * 384; LAS int* sel = (LAS int*)(scs + 136);
    const int tid = C.tid, row = M0 + ns;
    if (tid < 384) qs[tid] = bf2f(P.QB[(size_t)row * NSA_Q_COLS + kvh * 384 + tid]);
    asm volatile("s_waitcnt lgkmcnt(0)" ::: "memory"); __syncthreads();
    const float* ckf = P.CKF + ((size_t)ns * NSA_KV_HEADS + kvh) * NCH * 64; const float* cvf = P.CVF + ((size_t)ns * NSA_KV_HEADS + kvh) * NCH * 64;
    float oc[1], os[1], ow[1];
    smp_branch(C, qs, S, red, NCMP, [&](int j) { return ckf + (size_t)j * 64; }, [&](int j) { return cvf + (size_t)j * 64; }, true, oc);
    constexpr int NBS = (PAST_LEN + 1 + SLC_BLOCK - 1) / SLC_BLOCK, CURS = PAST_LEN / SLC_BLOCK;
    for (int b = tid; b < 136; b += NTHREADS) { float sv = -3.0e38f;
        if (b < NBS) { if (b == 0 || b == CURS || b == CURS - 1) sv = FORCE_SCORE; else { float a = 0.f;
#pragma unroll
                for (int o = -1; o <= 3; ++o) { const int ci = 4 * b + o; if (ci >= 0 && ci < NCMP) { float sm = 0.f; for (int h6 = 0; h6 < 6; ++h6) sm += S[h6 * SMP_SK + ci]; a += ((o >= 0 && o <= 2) ? 2.f : 1.f) * sm; } }
                sv = a; } }
        scs[b] = sv; }
    asm volatile("s_waitcnt lgkmcnt(0)" ::: "memory"); __syncthreads();
    for (int b = tid; b < NBS; b += NTHREADS) { const float sv = scs[b]; int rank = 0; for (int j = 0; j < NBS; ++j) { const float o = scs[j]; rank += (o > sv || (o == sv && j < b)) ? 1 : 0; }
        if (rank < SLC_TOPK) { sel[rank] = b; P.SELB[((size_t)row * NSA_KV_HEADS + kvh) * 16 + rank] = b; } }
    asm volatile("s_waitcnt lgkmcnt(0)" ::: "memory"); __syncthreads();
    { const float* newrow = P.nsa_kv_s + (size_t)ns * 512; const int* pt = P.page_table + ns * (PAST_LEN / PAGE_SIZE);
      if (tid == 0) { int seen = 0; for (int x = 0; x < SLC_TOPK; ++x) { const int bx = sel[x]; if (bx != CURS && seen < 15) sel[16 + seen++] = bx; } }
      asm volatile("s_waitcnt lgkmcnt(0)" ::: "memory"); __syncthreads();
      auto krow = [&](int j, int ty) -> const float* { if (j >= 15 * 64) return newrow + ty * 128 + kvh * 64;
          const int t0 = sel[16 + (j >> 6)] * SLC_BLOCK + (j & 63); const int pg = pt[t0 / PAGE_SIZE]; return P.cache_nsa_kv + ((size_t)pg * PAGE_SIZE + t0 % PAGE_SIZE) * 512 + ty * 128 + kvh * 64; };
      smp_branch(C, qs, S, red, 15 * 64 + 1, [&](int j) { return krow(j, 2); }, [&](int j) { return krow(j, 3); }, false, os); }
    { const float* wc = P.cache_nsa_win + (size_t)ns * SWA_WINDOW * 256; const float* newrow = P.win_s + ((size_t)ns * SWA_WINDOW + SWA_WINDOW - 1) * 256;
      smp_branch(C, qs, S, red, SWA_WINDOW + 1, [&](int j) { return (j < SWA_WINDOW ? wc + (size_t)j * 256 : newrow) + kvh * 64; }, [&](int j) { return (j < SWA_WINDOW ? wc + (size_t)j * 256 : newrow) + 128 + kvh * 64; }, false, ow); }
    if (tid < 384) { const int head = kvh * NSA_GROUP + tid / 64; const float* gt = P.GATES + (size_t)row * 64 + head * 3;
        P.ATTB[(size_t)row * 1024 + kvh * 384 + tid] = (bf16)f2bf(gt[0] * oc[0] + gt[1] * os[0] + gt[2] * ow[0]);
#ifdef NSA_DEBUG
        P.DBG[((size_t)0 * MP + row) * 768 + kvh * 384 + tid] = oc[0]; P.DBG[((size_t)1 * MP + row) * 768 + kvh * 384 + tid] = os[0]; P.DBG[((size_t)2 * MP + row) * 768 + kvh * 384 + tid] = ow[0];
#endif
    }
    __syncthreads();
}
DI void nsa_pairs(const FP& P, const Ctx& C, bool second) {
    LAS unsigned char* wl = C.lds + C.wave * NSA_WLDS;
    const int per = C.G / 4 > 0 ? C.G / 4 : 1, grp = (C.vcu / per) & 3, sub = C.vcu % per, n = grp >> 1, kvh = grp & 1;
#pragma unroll 1
    for (int pr = sub * NWAVES + C.wave; pr < SEQ / 2; pr += per * NWAVES) { if (second) nsa_pair_b(P, n, kvh, 2 * pr, C.lane, wl); else nsa_pair_a(P, n, kvh, 2 * pr, C.lane, wl); }
}
DI void nsa_phase_a(const FP& P, const Ctx& C) {
    for (int it = C.vcu; it < DEC_BATCH * NSA_KV_HEADS; it += C.G) nsa_sample_item(P, C, it / NSA_KV_HEADS, it % NSA_KV_HEADS);
    nsa_pairs(P, C, false);
    __syncthreads();
}
DI void nsa_phase_b(const FP& P, const Ctx& C) {
    const int lane = C.lane, w = C.wave;
    nsa_pairs(P, C, true);
    __syncthreads();
    { constexpr int NMT = (M0 / 16) * MEM_HEADS;
      for (int it = C.vcu * NWAVES + w; it < NMT; it += C.G * NWAVES) { const int h = it % MEM_HEADS, q16 = it / MEM_HEADS, row0 = q16 * 16, n = row0 / SEQ;
          mem_micro(P, P.MQB + h * 64, 256, row0, 1, n, h, P.ATTB + NSA_Q_COLS + h * 64, 1024, lane); }
    }
    { LAS float* qs = (LAS float*)C.lds;
      for (int it = C.vcu; it < DEC_BATCH * MEM_HEADS; it += C.G) { const int h = it % MEM_HEADS, ns = it / MEM_HEADS, row = M0 + ns;
          __syncthreads(); if (C.tid < 64) qs[C.tid] = bf2f(P.MQB[(size_t)row * 256 + h * 64 + C.tid]); asm volatile("s_waitcnt lgkmcnt(0)" ::: "memory"); __syncthreads();
          Dec D; D.m = -INFINITY; D.l = 0.f; D.o = 0.f; const float* mk = P.cache_mem_kv + ((size_t)1 * DEC_BATCH + ns) * MEM_TOKENS * 512;
          for (int ck = w; ck < MEM_TOKENS / 64; ck += NWAVES) { const int j0 = ck * 64; dec_chunk(D, qs, 64, [&](int j) { return mk + (size_t)(j0 + j) * 512 + h * 64; }, [&](int j) { return mk + (size_t)(j0 + j) * 512 + 256 + h * 64; }, lane); }
          const float o = dec_combine(C, D);
          if (w == 0) P.ATTB[(size_t)row * 1024 + NSA_Q_COLS + h * 64 + lane] = (bf16)f2bf(o); } }
    __syncthreads();
}
}
namespace fx {
enum { PH_PRO = 0, PH_G1, PH_ATTA, PH_G2, PH_LN1, PH_SC0, PH_TK0, PH_PU0, PH_PG0, PH_G3, PH_CMPG, PH_CMP2, PH_NSA, PH_NSB, PH_G4, PH_LN3, PH_SC1, PH_TK1, PH_PU1, PH_PG1, PH_COUNT };
template <class Epi> DI void run_gemm(const Ctx& C, const bf16* A, const bf16* Bt, int M, int N, int K, const Epi& E) {
    pg8::Gemm g{A, Bt, M, N, K}; pg8::StaticOrder S; S.init(M, N, C.G, (int)blockIdx.x);
    pg8::gemm_phase<Epi, pg8::StaticOrder, true, true>(C.lds, g, S, E);
}
template <class Epi> DI void skinny_gemm(const Ctx& C, const bf16* A, const bf16* Bt, int N, int K, const Epi& E) {
    static_assert(DEC_BATCH == 32 && M0 % 256 == 0, "skinny_gemm: 32 sample rows right after a whole number of 256-row tiles");
    const int lane = C.lane, fr = lane & 15, fq = lane >> 4, w = C.wave; const int NI = (N / 256) * 4, KW = K / NWAVES;
    LAS f32x4* red = (LAS f32x4*)C.lds;
#pragma unroll 1
    for (int item = C.vcu; item < NI; item += C.G) { const int pn = item >> 2, wc = item & 3;
        f32x4 pa[2][2][2];
#pragma unroll
        for (int i = 0; i < 8; ++i) (&pa[0][0][0])[i] = (f32x4){0.f, 0.f, 0.f, 0.f};
        const bf16* xa = A + (size_t)(M0 + fr) * K + w * KW + 8 * fq; const bf16* xb = xa + (size_t)16 * K;
        const bf16* wp[2][2];
#pragma unroll
        for (int bj = 0; bj < 2; ++bj)
#pragma unroll
            for (int n = 0; n < 2; ++n) wp[bj][n] = Bt + (size_t)(pn * 256 + bj * 128 + wc * 32 + 8 * (fr >> 2) + 4 * n + (fr & 3)) * K + w * KW + 8 * fq;
#pragma unroll 4
        for (int k0 = 0; k0 < KW; k0 += 32) { const bf16x8 x0 = *(const bf16x8*)(xa + k0), x1 = *(const bf16x8*)(xb + k0);
#pragma unroll
            for (int bj = 0; bj < 2; ++bj)
#pragma unroll
                for (int n = 0; n < 2; ++n) { const bf16x8 wf = *(const bf16x8*)(wp[bj][n] + k0);
                    pa[bj][0][n] = __builtin_amdgcn_mfma_f32_16x16x32_bf16(wf, x0, pa[bj][0][n], 0, 0, 0); pa[bj][1][n] = __builtin_amdgcn_mfma_f32_16x16x32_bf16(wf, x1, pa[bj][1][n], 0, 0, 0); } }
        __syncthreads();
#pragma unroll
        for (int bj = 0; bj < 2; ++bj)
#pragma unroll
            for (int mm = 0; mm < 2; ++mm)
#pragma unroll
                for (int n = 0; n < 2; ++n) red[(w * 8 + bj * 4 + mm * 2 + n) * 64 + lane] = pa[bj][mm][n];
        asm volatile("s_waitcnt lgkmcnt(0)" ::: "memory"); __syncthreads();
        if (w == 0) { f32x4 acc[2][2][4][2];
#pragma unroll
            for (int i = 0; i < 32; ++i) (&acc[0][0][0][0])[i] = (f32x4){0.f, 0.f, 0.f, 0.f};
#pragma unroll
            for (int bj = 0; bj < 2; ++bj)
#pragma unroll
                for (int mm = 0; mm < 2; ++mm)
#pragma unroll
                    for (int n = 0; n < 2; ++n) { f32x4 s = red[(bj * 4 + mm * 2 + n) * 64 + lane];
#pragma unroll 1
                        for (int ww = 1; ww < NWAVES; ++ww) s += red[(ww * 8 + bj * 4 + mm * 2 + n) * 64 + lane];
                        acc[0][bj][mm][n] = s; }
            E(acc, pg8::Unit{M0 / 256, pn}, 0, wc, fr, fq); }
    }
    __syncthreads();
}
__global__ void __launch_bounds__(NTHREADS, 2) mega(Args args) {
    extern __shared__ __attribute__((aligned(16))) unsigned char lds_raw[];
    Ctx C; C.lds = (LAS unsigned char*)lds_raw; C.tid = threadIdx.x; C.lane = C.tid & 63; C.wave = __builtin_amdgcn_readfirstlane(C.tid >> 6);
    C.G = gridDim.x; { const int bx = blockIdx.x; C.vcu = (C.G % 8 == 0) ? (bx % 8) * (C.G / 8) + bx / 8 : bx; }
    const FP& P = args.p;
    volatile LAS unsigned* MISC = (volatile LAS unsigned*)(C.lds + MISC_OFF);
    for (int u = C.tid; u < (LDS_BYTES - RING_BYTES) / 4; u += NTHREADS) ((LAS unsigned*)(C.lds + RING_BYTES))[u] = 0u;
    __syncthreads();
    const int lo = args.lo, hi = args.hi;
    XcdBarrier bar; bar.bar = P.ctl + 1024; bar.x = 0; bar.st = nullptr;
    if (hi - lo > 1) bar = xcd_barrier_post(P.ctl + 1024, MISC + 8);
#define IN(k) (lo <= (k) && (k) < hi)
#define SEAM(k) do { if ((k) == PH_ATTA && IN(k)) bgq_drain(P, C, MISC + 12, BGQ_L_A);     \
        if ((k) == PH_TK0 && IN(k)) bgq_drain(P, C, MISC + 12, BGQ_L_UV); \
        if ((k) == PH_G3 && IN(k)) bgq_drain(P, C, MISC + 12, BGQ_L_AC); \
        if ((k) == PH_COUNT - 1 && IN(k)) bgq_drain(P, C, MISC + 12, BGQ_TOTAL); \
        if (IN(k) && IN((k) + 1)) xcd_barrier_bg(bar, P, C, MISC + 12); } while (0)
#ifndef DUP_PHASE
#define DUP_PHASE -1
#endif
#define PHASE(k, ...) do { if (IN(k)) { __VA_ARGS__ if (DUP_PHASE == (k)) { __syncthreads(); __VA_ARGS__ } } SEAM(k); } while (0)
    PHASE(PH_PRO, p0_prologue(P, C););
    PHASE(PH_G1, run_gemm(C, P.XB0, P.WA_T, M0, ACOLS, D_MODEL, EpiA{P}); run_gemm(C, P.MEMB, P.WMEM_T, BATCH * MEM_TOKENS, 1024, D_MODEL, EpiMem{P}); skinny_gemm(C, P.XB0, P.WA_T, ACOLS, D_MODEL, EpiA{P}););
#ifdef PEER_SHARD3
#define PEER_SHARDED_FN peer_sharded3_phase
#else
#define PEER_SHARDED_FN peer_sharded2_phase
#endif
#if defined(PEER_SOFTSYNC) && !defined(PEER_SHARD3)
#define PEER_HINT_ARGS , bar.st, bar.x
#else
#define PEER_HINT_ARGS
#endif
    PHASE(PH_ATTA, atta_phase(P, C););
    PHASE(PH_G2, run_gemm(C, P.ATTA, P.WOA_T, M0, D_MODEL, 512, EpiPre{P.x_prompt, P.x_sample, P.PRE}); skinny_gemm(C, P.ATTA, P.WOA_T, D_MODEL, 512, EpiPre{P.x_prompt, P.x_sample, P.PRE}););
    PHASE(PH_LN1, ln_phase(P, C, P.PRE, P.ln_g, P.ln_b, P.X1, P.X1B, nullptr, nullptr););
    PHASE(PH_SC0, run_gemm(C, P.X1B, P.WPK_T, M0, NPK, D_MODEL, EpiF32{P.SCO, NPK, MP}); skinny_gemm(C, P.X1B, P.WPK_T, NPK, D_MODEL, EpiF32{P.SCO, NPK, MP}););
    PHASE(PH_TK0, topk_phase(P, C););
#ifdef PEER_SPLIT
    PHASE(PH_PU0, peer_u_phase(P, C, 0, P.X1B););
    PHASE(PH_PG0, peer_v_phase(P, C, 0, P.X1, P.X2, P.X2 + (size_t)M0 * D_MODEL, P.X2B););
#elif defined(PEER_SHARD2)
    PHASE(PH_PG0, const bool shd = (M0 % (C.G * NWAVES * PS2_ROWS)) == 0; if (shd) { PEER_SHARDED_FN(P, C, 0, P.X1, P.X1B, P.X2, P.X2B PEER_HINT_ARGS); __syncthreads(); } peer_phase(P, C, 0, P.X1, P.X2, P.X2 + (size_t)M0 * D_MODEL, P.X2B, shd););
#elif defined(PEER_SHARD)
    PHASE(PH_PG0, peer_sharded_phase(P, C, 0, P.X1, P.X1B, P.X2, P.X2 + (size_t)M0 * D_MODEL, P.X2B); __syncthreads(); peer_phase(P, C, 0, P.X1, P.X2, P.X2 + (size_t)M0 * D_MODEL, P.X2B););
#else
    PHASE(PH_PG0, peer_phase(P, C, 0, P.X1, P.X2, P.X2 + (size_t)M0 * D_MODEL, P.X2B););
#endif
    PHASE(PH_G3, run_gemm(C, P.X2B, P.WB_T, M0, NB_T, D_MODEL, EpiB{P}); skinny_gemm(C, P.X2B, P.WB_T, NB_T, D_MODEL, EpiB{P}););
    PHASE(PH_CMPG, run_gemm(C, P.AC, P.CW1_T, ACROWS, 256, 1024, EpiF32{P.UL, 256, ACROWS}); run_gemm(C, P.AC + (size_t)ACROWS * 1024, P.CW1_T + 256 * 1024, ACROWS, 256, 1024, EpiF32{P.UL + (size_t)ACROWS * 256, 256, ACROWS}););
    PHASE(PH_CMP2, cmp2_phase(P, C););
    PHASE(PH_NSA, nsa_phase_a(P, C););
    PHASE(PH_NSB, nsa_phase_b(P, C););
    PHASE(PH_G4, run_gemm(C, P.ATTB, P.WOB_T, M0, D_MODEL, 1024, EpiPre{P.X2, nullptr, P.PRE}); skinny_gemm(C, P.ATTB, P.WOB_T, D_MODEL, 1024, EpiPre{P.X2, nullptr, P.PRE}););
    PHASE(PH_LN3, ln_phase(P, C, P.PRE, P.ln_g + 2 * D_MODEL, P.ln_b + 2 * D_MODEL, P.X3, P.X3B, nullptr, nullptr););
    PHASE(PH_SC1, run_gemm(C, P.X3B, P.WPK_T + (size_t)NPK * D_MODEL, M0, NPK, D_MODEL, EpiF32{P.SCO, NPK, MP}); skinny_gemm(C, P.X3B, P.WPK_T + (size_t)NPK * D_MODEL, NPK, D_MODEL, EpiF32{P.SCO, NPK, MP}););
    PHASE(PH_TK1, topk_phase(P, C););
#ifdef PEER_SPLIT
    PHASE(PH_PU1, peer_u_phase(P, C, 1, P.X3B););
    PHASE(PH_PG1, peer_v_phase(P, C, 1, P.X3, P.y_prompt, P.y_sample, nullptr););
#elif defined(PEER_SHARD2)
    PHASE(PH_PG1, const bool shd = (M0 % (C.G * NWAVES * PS2_ROWS)) == 0; if (shd) { PEER_SHARDED_FN(P, C, 1, P.X3, P.X3B, P.y_prompt, nullptr PEER_HINT_ARGS); __syncthreads(); } peer_phase(P, C, 1, P.X3, P.y_prompt, P.y_sample, nullptr, shd););
#elif defined(PEER_SHARD)
    PHASE(PH_PG1, peer_sharded_phase(P, C, 1, P.X3, P.X3B, P.y_prompt, P.y_sample, nullptr); __syncthreads(); peer_phase(P, C, 1, P.X3, P.y_prompt, P.y_sample, nullptr););
#else
    PHASE(PH_PG1, peer_phase(P, C, 1, P.X3, P.y_prompt, P.y_sample, nullptr););
#endif
#undef IN
#undef SEAM
}
}
#ifndef ONE_LAUNCH
#define ONE_LAUNCH 1
#endif
extern "C" void kernel_launch(void* const* d_in, const int* in_sizes, int n_in, void* d_out, int out_size, void* d_ws, size_t ws_size, hipStream_t stream) {
    fx::Args a; memset(&a, 0, sizeof(a)); fx::bind_io(a.p, d_in, (float*)d_out);
    const size_t f_need = fx::carve(a.p, d_ws);
    if (f_need > ws_size) { fprintf(stderr, "kernel_launch: workspace too small: need %zu have %zu\n", f_need, ws_size); return; }
    static int grid = 0;
    if (!grid) { int dev = 0, cus = 0, per_cu = 0; (void)hipGetDevice(&dev); (void)hipDeviceGetAttribute(&cus, hipDeviceAttributeMultiprocessorCount, dev);
        (void)hipFuncSetAttribute((const void*)fx::mega, hipFuncAttributeMaxDynamicSharedMemorySize, fx::LDS_BYTES);
        if (hipOccupancyMaxActiveBlocksPerMultiprocessor(&per_cu, (const void*)fx::mega, fx::NTHREADS, fx::LDS_BYTES) != hipSuccess || per_cu < 1) { fprintf(stderr, "kernel_launch: occupancy query says %d blocks per CU\n", per_cu); (void)hipGetLastError(); }
        grid = cus; }
    (void)hipMemsetAsync(a.p.ctl, 0, fx::CTL_BYTES, stream);
#if ONE_LAUNCH
    a.lo = 0; a.hi = fx::PH_COUNT; hipLaunchKernelGGL(fx::mega, dim3(grid), dim3(fx::NTHREADS), fx::LDS_BYTES, stream, a);
#else
    for (int k = 0; k < fx::PH_COUNT; ++k) { a.lo = k; a.hi = k + 1; hipLaunchKernelGGL(fx::mega, dim3(grid), dim3(fx::NTHREADS), fx::LDS_BYTES, stream, a); }
#endif
}
```
